# Optimizing an MI355X kernel written in HIP

```python
import jax, jax.numpy as jnp
from jax import lax
import numpy as np

D_MODEL = 1024
BATCH = 2
SEQ = 16384
DEPTH = 2

HEAD_DIM = 64
ROT_DIM = HEAD_DIM // 4
ROPE_THETA = 500000.0
NSA_HEADS = 8
NSA_KV_HEADS = 2
NSA_GROUP = NSA_HEADS // NSA_KV_HEADS
CMP_LEN = 32
CMP_STRIDE = 16
CMP_HID = 2 * HEAD_DIM
SLC_LEN = 64
SLC_TOPN = 16
WIN = 512
MOBA_HEADS = 8
MOBA_BLOCK = 256
MOBA_TOPK = 3
Q_CHUNK = 64
PEER_HEADS = 8
PEER_NKEYS = 128
PEER_EXPERTS = PEER_NKEYS * PEER_NKEYS
PEER_QDIM = 256
PEER_TOPK = 16
PEER_CHUNK = 128
RMS_EPS = 1e-6
NEG = -1e30
SEL_FORCE = 1e4

NSA_Q = NSA_HEADS * HEAD_DIM
NSA_KV = NSA_KV_HEADS * HEAD_DIM
MOBA_W = MOBA_HEADS * HEAD_DIM
IN_COLS = NSA_Q + 6 * NSA_KV + 3 * NSA_HEADS + 3 * MOBA_W + 2 * D_MODEL

kernel_name = "hybrid_nsa_moba_peer_adaln"


def rms_norm(x, g):
    xf = x.astype(jnp.float32)
    y = xf * lax.rsqrt(jnp.mean(xf * xf, axis=-1, keepdims=True) + RMS_EPS)
    return (y * g.astype(jnp.float32)).astype(x.dtype)


def partial_rope(x, pos):
    half = ROT_DIM // 2
    inv = ROPE_THETA ** (-jnp.arange(half, dtype=jnp.float32) / half)
    ang = pos.astype(jnp.float32)[:, None] * inv[None, :]
    cos = jnp.cos(ang)[None, :, None, :].astype(x.dtype)
    sin = jnp.sin(ang)[None, :, None, :].astype(x.dtype)
    x1, x2, rest = x[..., :half], x[..., half:ROT_DIM], x[..., ROT_DIM:]
    return jnp.concatenate([x1 * cos - x2 * sin, x2 * cos + x1 * sin, rest], axis=-1)


def masked_softmax(s, mask):
    s = jnp.where(mask, s.astype(jnp.float32), NEG)
    m = jnp.max(s, axis=-1, keepdims=True)
    p = jnp.where(mask, jnp.exp(s - m), 0.0)
    return p / jnp.maximum(jnp.sum(p, axis=-1, keepdims=True), 1e-30)


def split_cols(x, sizes):
    out, o = [], 0
    for n in sizes:
        out.append(x[..., o:o + n])
        o += n
    return out


def nsa_compress(k, pe, w1, w2):
    b, s = k.shape[:2]
    nc = (s - CMP_LEN) // CMP_STRIDE + 1
    idx = jnp.arange(nc)[:, None] * CMP_STRIDE + jnp.arange(CMP_LEN)[None, :]
    blk = k[:, idx] + pe[None, None, :, None, :]
    blk = jnp.transpose(blk, (0, 1, 3, 2, 4)).reshape(b, nc, NSA_KV_HEADS, CMP_LEN * HEAD_DIM)
    return jax.nn.gelu(blk @ w1) @ w2


def nsa_attention(q_rot, q_raw, kc, vc, ks, vs, kw, vw, gates):
    b, s = q_rot.shape[:2]
    nc = kc.shape[1]
    ns = s // SLC_LEN
    n_sel = min(SLC_TOPN, ns)
    scale = HEAD_DIM ** -0.5
    c_start = jnp.arange(nc) * CMP_STRIDE
    cmp_end = c_start + CMP_LEN - 1
    s_start = jnp.arange(ns) * SLC_LEN
    overlap = jnp.maximum(
        jnp.minimum(c_start[:, None] + CMP_LEN, s_start[None, :] + SLC_LEN)
        - jnp.maximum(c_start[:, None], s_start[None, :]), 0).astype(jnp.float32) / CMP_LEN
    ks_blk = ks.reshape(b, ns, SLC_LEN, NSA_KV_HEADS, HEAD_DIM).transpose(0, 3, 1, 2, 4)
    vs_blk = vs.reshape(b, ns, SLC_LEN, NSA_KV_HEADS, HEAD_DIM).transpose(0, 3, 1, 2, 4)
    kw_pad = jnp.pad(kw, ((0, 0), (WIN, 0), (0, 0), (0, 0)))
    vw_pad = jnp.pad(vw, ((0, 0), (WIN, 0), (0, 0), (0, 0)))
    bi = jnp.arange(b)[:, None, None, None]
    hi = jnp.arange(NSA_KV_HEADS)[None, :, None, None]
    blk_id = jnp.arange(ns)

    def chunk(i):
        s0 = i * Q_CHUNK
        t = s0 + jnp.arange(Q_CHUNK)
        qr = lax.dynamic_slice_in_dim(q_rot, s0, Q_CHUNK, 1).reshape(b, Q_CHUNK, NSA_KV_HEADS, NSA_GROUP, HEAD_DIM)
        qu = lax.dynamic_slice_in_dim(q_raw, s0, Q_CHUNK, 1).reshape(b, Q_CHUNK, NSA_KV_HEADS, NSA_GROUP, HEAD_DIM)
        g = lax.dynamic_slice_in_dim(gates, s0, Q_CHUNK, 1)
        sc = jnp.einsum('bqkgd,bckd->bkgqc', qu, kc).astype(jnp.float32) * scale
        p_c = masked_softmax(sc, cmp_end[None, :] <= t[:, None])
        o_c = jnp.einsum('bkgqc,bckd->bqkgd', p_c.astype(vc.dtype), vc)
        imp = jnp.einsum('bkgqc,cn->bkqn', p_c, overlap)
        cur = t // SLC_LEN
        valid = blk_id[None, :] <= cur[:, None]
        forced = (blk_id[None, :] == 0) | (blk_id[None, :] == cur[:, None]) | (blk_id[None, :] == cur[:, None] - 1)
        score = jnp.where(valid, jnp.where(forced, SEL_FORCE, imp), NEG)
        vals, idx = lax.top_k(score, n_sel)
        ok = vals > NEG * 0.5
        kg = ks_blk[bi, hi, idx]
        vg = vs_blk[bi, hi, idx]
        kpos = idx[..., None] * SLC_LEN + jnp.arange(SLC_LEN)
        smask = (ok[..., None] & (kpos <= t[None, None, :, None, None])).reshape(b, NSA_KV_HEADS, 1, Q_CHUNK, n_sel * SLC_LEN)
        ss = jnp.einsum('bqkgd,bkqnld->bkgqnl', qr, kg).reshape(b, NSA_KV_HEADS, NSA_GROUP, Q_CHUNK, n_sel * SLC_LEN)
        p_s = masked_softmax(ss.astype(jnp.float32) * scale, smask)
        p_s = p_s.reshape(b, NSA_KV_HEADS, NSA_GROUP, Q_CHUNK, n_sel, SLC_LEN).astype(vg.dtype)
        o_s = jnp.einsum('bkgqnl,bkqnld->bqkgd', p_s, vg)
        kwc = lax.dynamic_slice_in_dim(kw_pad, s0, WIN + Q_CHUNK, 1)
        vwc = lax.dynamic_slice_in_dim(vw_pad, s0, WIN + Q_CHUNK, 1)
        wpos = s0 - WIN + jnp.arange(WIN + Q_CHUNK)
        wmask = (wpos[None, :] <= t[:, None]) & (wpos[None, :] > t[:, None] - WIN) & (wpos[None, :] >= 0)
        sw = jnp.einsum('bqkgd,bjkd->bkgqj', qr, kwc).astype(jnp.float32) * scale
        p_w = masked_softmax(sw, wmask)
        o_w = jnp.einsum('bkgqj,bjkd->bqkgd', p_w.astype(vwc.dtype), vwc)
        shp = (b, Q_CHUNK, NSA_HEADS, HEAD_DIM)
        return (g[..., 0:1] * o_c.reshape(shp) + g[..., 1:2] * o_s.reshape(shp) + g[..., 2:3] * o_w.reshape(shp))

    out = lax.map(chunk, jnp.arange(s // Q_CHUNK))
    return jnp.transpose(out, (1, 0, 2, 3, 4)).reshape(b, s, NSA_Q)


def moba_attention(q, k, v):
    b, s = q.shape[:2]
    nb = -(-s // MOBA_BLOCK)
    pad = nb * MOBA_BLOCK - s
    n_top = min(MOBA_TOPK, nb)
    scale = HEAD_DIM ** -0.5
    k_pad = jnp.pad(k, ((0, 0), (0, pad), (0, 0), (0, 0)))
    v_pad = jnp.pad(v, ((0, 0), (0, pad), (0, 0), (0, 0)))
    k_blk = k_pad.reshape(b, nb, MOBA_BLOCK, MOBA_HEADS, HEAD_DIM).transpose(0, 3, 1, 2, 4)
    v_blk = v_pad.reshape(b, nb, MOBA_BLOCK, MOBA_HEADS, HEAD_DIM).transpose(0, 3, 1, 2, 4)
    k_mean = jnp.mean(k_blk.astype(jnp.float32), axis=3)
    bi = jnp.arange(b)[:, None, None, None]
    hi = jnp.arange(MOBA_HEADS)[None, :, None, None]

    def chunk(i):
        s0 = i * Q_CHUNK
        t = s0 + jnp.arange(Q_CHUNK)
        cur = s0 // MOBA_BLOCK
        qc = lax.dynamic_slice_in_dim(q, s0, Q_CHUNK, 1)
        gs = jnp.einsum('bqhd,bhnd->bhqn', qc.astype(jnp.float32), k_mean)
        gs = jnp.where(jnp.arange(nb) < cur, gs, NEG)
        vals, idx = lax.top_k(gs, n_top)
        ok = vals > NEG * 0.5
        kg = k_blk[bi, hi, idx]
        vg = v_blk[bi, hi, idx]
        s_sel = jnp.einsum('bqhd,bhqnld->bhqnl', qc, kg).reshape(b, MOBA_HEADS, Q_CHUNK, n_top * MOBA_BLOCK)
        m_sel = jnp.broadcast_to(ok[..., None], (b, MOBA_HEADS, Q_CHUNK, n_top, MOBA_BLOCK)).reshape(b, MOBA_HEADS, Q_CHUNK, n_top * MOBA_BLOCK)
        k_own = lax.dynamic_slice_in_dim(k_pad, cur * MOBA_BLOCK, MOBA_BLOCK, 1)
        v_own = lax.dynamic_slice_in_dim(v_pad, cur * MOBA_BLOCK, MOBA_BLOCK, 1)
        opos = cur * MOBA_BLOCK + jnp.arange(MOBA_BLOCK)
        s_own = jnp.einsum('bqhd,blhd->bhql', qc, k_own)
        m_own = jnp.broadcast_to(opos[None, :] <= t[:, None], (b, MOBA_HEADS, Q_CHUNK, MOBA_BLOCK))
        scores = jnp.concatenate([s_sel, s_own], axis=-1).astype(jnp.float32) * scale
        p = masked_softmax(scores, jnp.concatenate([m_sel, m_own], axis=-1)).astype(v.dtype)
        p_sel = p[..., :n_top * MOBA_BLOCK].reshape(b, MOBA_HEADS, Q_CHUNK, n_top, MOBA_BLOCK)
        p_own = p[..., n_top * MOBA_BLOCK:]
        return jnp.einsum('bhqnl,bhqnld->bqhd', p_sel, vg) + jnp.einsum('bhql,blhd->bqhd', p_own, v_own)

    out = lax.map(chunk, jnp.arange(s // Q_CHUNK))
    return jnp.transpose(out, (1, 0, 2, 3, 4)).reshape(b, s, MOBA_W)


def token_mixer(h, w_in, cmp_pe, cmp_w1, cmp_w2, w_up_nsa, w_up_moba, w_out):
    b, s, _ = h.shape
    pos = jnp.arange(s, dtype=jnp.int32)
    proj = h @ w_in
    sizes = (NSA_Q, NSA_KV, NSA_KV, NSA_KV, NSA_KV, NSA_KV, NSA_KV, 3 * NSA_HEADS,
             MOBA_W, MOBA_W, MOBA_W, D_MODEL, D_MODEL)
    nq, kc, vc, ks, vs, kw, vw, ng, mq, mk, mv, gn, gm = split_cols(proj, sizes)
    nq = nq.reshape(b, s, NSA_HEADS, HEAD_DIM)
    kvh = lambda z: z.reshape(b, s, NSA_KV_HEADS, HEAD_DIM)
    mh = lambda z: z.reshape(b, s, MOBA_HEADS, HEAD_DIM)
    kc = nsa_compress(kvh(kc), cmp_pe[0], cmp_w1[0], cmp_w2[0])
    vc = nsa_compress(kvh(vc), cmp_pe[1], cmp_w1[1], cmp_w2[1])
    nsa_gates = jax.nn.sigmoid(ng).reshape(b, s, NSA_HEADS, 3)
    o_nsa = nsa_attention(partial_rope(nq, pos), nq, kc, vc, partial_rope(kvh(ks), pos), kvh(vs),
                          partial_rope(kvh(kw), pos), kvh(vw), nsa_gates)
    o_moba = moba_attention(partial_rope(mh(mq), pos), partial_rope(mh(mk), pos), mh(mv))
    y = jax.nn.sigmoid(gn) * (o_nsa @ w_up_nsa) + jax.nn.sigmoid(gm) * (o_moba @ w_up_moba)
    return y @ w_out


def peer_ffn(h, wq, k1, k2, u, v):
    b, s, d = h.shape
    half = PEER_QDIM // 2
    tokens = h.reshape(-1, PEER_CHUNK, d)

    def chunk(ht):
        q = (ht @ wq).reshape(PEER_CHUNK, PEER_HEADS, 2, half)
        s1 = jnp.einsum('thd,nd->thn', q[:, :, 0], k1).astype(jnp.float32)
        s2 = jnp.einsum('thd,nd->thn', q[:, :, 1], k2).astype(jnp.float32)
        v1, i1 = lax.top_k(s1, PEER_TOPK)
        v2, i2 = lax.top_k(s2, PEER_TOPK)
        cand = (v1[..., :, None] + v2[..., None, :]).reshape(PEER_CHUNK, PEER_HEADS, PEER_TOPK * PEER_TOPK)
        vals, ci = lax.top_k(cand, PEER_TOPK)
        e = (jnp.take_along_axis(i1, ci // PEER_TOPK, axis=-1) * PEER_NKEYS
             + jnp.take_along_axis(i2, ci % PEER_TOPK, axis=-1))
        gate = jax.nn.softmax(vals, axis=-1).astype(ht.dtype)
        act = jax.nn.gelu(jnp.einsum('td,thkd->thk', ht, u[e]))
        return jnp.einsum('thk,thkd->td', gate * act, v[e])

    return lax.map(chunk, tokens).reshape(b, s, d)


def setup_inputs(seed: int = 0) -> dict:
    key = jax.random.key(seed)
    ks = jax.random.split(key, 20)
    nrm = lambda k, shape, sc: jax.random.normal(k, shape, jnp.float32) * sc
    D = D_MODEL
    return {
        "x": nrm(ks[0], (BATCH, SEQ, D), 1.0),
        "c": nrm(ks[1], (BATCH, D), 1.0),
        "w_ada": nrm(ks[2], (DEPTH, D, 6 * D), 0.5 * D ** -0.5),
        "b_ada": nrm(ks[3], (DEPTH, 6 * D), 0.02),
        "g_attn": 1.0 + nrm(ks[4], (DEPTH, D), 0.02),
        "g_ffn": 1.0 + nrm(ks[5], (DEPTH, D), 0.02),
        "w_in": nrm(ks[6], (DEPTH, D, IN_COLS), D ** -0.5),
        "cmp_pe": nrm(ks[7], (DEPTH, 2, CMP_LEN, HEAD_DIM), 0.1),
        "cmp_w1": nrm(ks[8], (DEPTH, 2, CMP_LEN * HEAD_DIM, CMP_HID), (CMP_LEN * HEAD_DIM) ** -0.5),
        "cmp_w2": nrm(ks[9], (DEPTH, 2, CMP_HID, HEAD_DIM), CMP_HID ** -0.5),
        "w_up_nsa": nrm(ks[10], (DEPTH, NSA_Q, D), NSA_Q ** -0.5),
        "w_up_moba": nrm(ks[11], (DEPTH, MOBA_W, D), MOBA_W ** -0.5),
        "w_out": nrm(ks[12], (DEPTH, D, D), D ** -0.5),
        "peer_wq": nrm(ks[13], (DEPTH, D, PEER_HEADS * PEER_QDIM), D ** -0.5),
        "peer_k1": nrm(ks[14], (DEPTH, PEER_NKEYS, PEER_QDIM // 2), (PEER_QDIM // 2) ** -0.5),
        "peer_k2": nrm(ks[15], (DEPTH, PEER_NKEYS, PEER_QDIM // 2), (PEER_QDIM // 2) ** -0.5),
        "peer_u": nrm(ks[16], (DEPTH, PEER_EXPERTS, D), D ** -0.5),
        "peer_v": nrm(ks[17], (DEPTH, PEER_EXPERTS, D), PEER_HEADS ** -0.5),
        "g_final": 1.0 + nrm(ks[18], (D,), 0.02),
    }


def reference(x, c, w_ada, b_ada, g_attn, g_ffn, w_in, cmp_pe, cmp_w1, cmp_w2, w_up_nsa, w_up_moba,
              w_out, peer_wq, peer_k1, peer_k2, peer_u, peer_v, g_final):
    sc_c = jax.nn.silu(c)
    for l in range(DEPTH):
        mod = sc_c @ w_ada[l] + b_ada[l]
        sh1, sc1, ga1, sh2, sc2, ga2 = jnp.split(mod, 6, axis=-1)
        h = rms_norm(x, g_attn[l]) * (1.0 + sc1[:, None, :]) + sh1[:, None, :]
        x = x + ga1[:, None, :] * token_mixer(h, w_in[l], cmp_pe[l], cmp_w1[l], cmp_w2[l],
                                              w_up_nsa[l], w_up_moba[l], w_out[l])
        h = rms_norm(x, g_ffn[l]) * (1.0 + sc2[:, None, :]) + sh2[:, None, :]
        x = x + ga2[:, None, :] * peer_ffn(h, peer_wq[l], peer_k1[l], peer_k2[l], peer_u[l], peer_v[l])
    return rms_norm(x, g_final)
```

```cpp
#include <hip/hip_runtime.h>
#include <hip/hip_bf16.h>
#include <hip/hip_cooperative_groups.h>
#include <cstdio>
#include <cstdint>
namespace cg = cooperative_groups;

#define DEV __device__ __forceinline__
typedef unsigned short bf16;
using bf16x8 = __attribute__((ext_vector_type(8))) short;
using f32x4 = __attribute__((ext_vector_type(4))) float;

constexpr int Bn = 2, S = 16384, T = Bn * S, D = 1024;
constexpr int PC = 3456;
constexpr int WN = 4992;
constexpr int C_NQ = 0, C_KC = 512, C_VC = 640, C_MQ = 768, C_GN = 1280, C_GM = 2304, C_NG = 3328;
constexpr int NEXP = 16384;

constexpr size_t al(size_t x) { return (x + 255) & ~size_t(255); }
constexpr size_t OFF_MOD = 0;
constexpr size_t OFF_ROPE = al(OFF_MOD + 2 * 2 * 6144 * 4);
constexpr size_t OFF_PEB = al(OFF_ROPE + (size_t)S * 16 * 4);
constexpr size_t OFF_WINT = al(OFF_PEB + 2 * 2 * 128 * 4);
constexpr size_t OFF_WUPN = al(OFF_WINT + 2ull * WN * 1024 * 2);
constexpr size_t OFF_WUPM = al(OFF_WUPN + 2ull * 1024 * 512 * 2);
constexpr size_t OFF_WOUT = al(OFF_WUPM + 2ull * 1024 * 512 * 2);
constexpr size_t OFF_WQ = al(OFF_WOUT + 2ull * 1024 * 1024 * 2);
constexpr size_t OFF_KCC = al(OFF_WQ + 2ull * 2048 * 1024 * 2);
constexpr size_t OFF_VCC = al(OFF_KCC + 2ull * 1024 * 128 * 4);
constexpr size_t OFF_SEL = al(OFF_VCC + 2ull * 1024 * 128 * 4);
constexpr size_t OFF_KMEAN = al(OFF_SEL + 2ull * 2 * S * 16 * 4);
constexpr size_t OFF_KMHL = al(OFF_KMEAN + 2ull * 8 * 64 * 64 * 4);
constexpr size_t OFF_KCB = al(OFF_KMHL + 2ull * 2 * 8 * 64 * 64 * 2);
constexpr size_t OFF_VCB = al(OFF_KCB + 2ull * 2 * 1024 * 64 * 2);
constexpr size_t OFF_PKB = al(OFF_VCB + 2ull * 2 * 1024 * 64 * 2);
constexpr size_t OFF_W1T = al(OFF_PKB + 2ull * 2 * 128 * 128 * 2);
constexpr size_t OFF_BAR = al(OFF_W1T + 4ull * 128 * 2048 * 2);
constexpr size_t BAR_BYTES = 3456 * 4;
constexpr size_t OFF_PROBE = al(OFF_BAR + BAR_BYTES);
constexpr size_t OFF_H = al(OFF_PROBE + 256);
constexpr size_t OFF_ONSA = al(OFF_H + (size_t)T * 1024 * 2);
constexpr size_t OFF_OMOBA = al(OFF_ONSA + (size_t)T * 512 * 2);
constexpr size_t OFF_PROJ = al(OFF_OMOBA + (size_t)T * 512 * 2);
constexpr size_t KV2_BYTES = (size_t)Bn * 2 * S * 64 * 2, KV8_BYTES = (size_t)Bn * 8 * S * 64 * 2;
constexpr size_t OFF_KSB = al(OFF_PROJ + (size_t)T * PC * 2);
constexpr size_t OFF_VSB = OFF_KSB + KV2_BYTES;
constexpr size_t OFF_KWB = OFF_VSB + KV2_BYTES;
constexpr size_t OFF_VWB = OFF_KWB + KV2_BYTES;
constexpr size_t OFF_MKB = OFF_VWB + KV2_BYTES;
constexpr size_t OFF_MVB = OFF_MKB + KV8_BYTES;
constexpr size_t WS_NEED = OFF_MVB + KV8_BYTES;
constexpr size_t PROJ_BYTES = (size_t)T * PC * 2;
constexpr size_t OFF_QP = OFF_PROJ;
constexpr size_t OFF_PEIDX = al(OFF_QP + (size_t)T * 2048 * 2);
constexpr size_t OFF_PEG = al(OFF_PEIDX + (size_t)T * 128 * 4);
constexpr size_t OFF_E8 = al(OFF_PEG + (size_t)T * 128 * 4);
constexpr size_t OFF_ESC = al(OFF_E8 + (size_t)NEXP * 2048);
static_assert(OFF_ESC + (size_t)NEXP * 2 * 4 <= OFF_PROJ + PROJ_BYTES, "peer alias overflow");
static_assert(WS_NEED <= 536870912ull, "workspace too big");
constexpr size_t OFF_CMP = WS_NEED;
#ifndef REP_NSA_ONLY
#define REP_NSA_ONLY 0
#endif
#ifndef REP_MASK
#define REP_MASK 0
#endif
#ifndef PROBE_MOBA
#define PROBE_MOBA 0
#endif
#ifndef PROBE_NSA
#define PROBE_NSA 0
#endif
#ifndef PROBE_CMPR
#define PROBE_CMPR 0
#endif
#ifndef PROBE_PROJ
#define PROBE_PROJ 0
#endif
#define PROBE_ANY (PROBE_MOBA || PROBE_NSA || PROBE_CMPR || PROBE_PROJ)
constexpr size_t WS_TOTAL = PROBE_ANY ? (OFF_CMP + (size_t)S * 512 * 2) : WS_NEED;
static_assert(WS_TOTAL <= 536870912ull, "workspace too big (probe)");

struct Params {
  const float *x, *c, *w_ada, *b_ada, *g_attn, *g_ffn, *w_in, *cmp_pe, *cmp_w1, *cmp_w2, *w_up_nsa, *w_up_moba, *w_out,
      *peer_wq, *peer_k1, *peer_k2, *peer_u, *peer_v, *g_final;
  float* out;
  char* ws;
};

constexpr int SMEM_BYTES = 74 * 1024;

DEV int tidx() {
  int t = threadIdx.x;
  asm volatile("" : "+v"(t));
  return t;
}
#define MFMA16B(a, b, c) __builtin_amdgcn_mfma_f32_16x16x32_bf16(a, b, c, 0, 0, 0)
DEV unsigned cvtpk_(float lo, float hi) {
  unsigned r;
  asm("v_cvt_pk_bf16_f32 %0, %1, %2" : "=v"(r) : "v"(lo), "v"(hi));
  return r;
}
DEV float bf2f(bf16 h) { return __uint_as_float(((unsigned)h) << 16); }
DEV bf16 f2bf(float f) {
  unsigned u = __float_as_uint(f);
  u += 0x7fffu + ((u >> 16) & 1u);
  return (bf16)(u >> 16);
}
DEV float gelu_tanh(float x) {
  float u = 0.7978845608028654f * (x + 0.044715f * x * x * x);
  return 0.5f * x * (1.f + tanhf(u));
}
DEV float sigmoidf_(float x) { return 1.f / (1.f + expf(-x)); }
DEV void unpack8(uint4 v, float* f) {
  f[0] = __uint_as_float(v.x << 16); f[1] = __uint_as_float(v.x & 0xffff0000u);
  f[2] = __uint_as_float(v.y << 16); f[3] = __uint_as_float(v.y & 0xffff0000u);
  f[4] = __uint_as_float(v.z << 16); f[5] = __uint_as_float(v.z & 0xffff0000u);
  f[6] = __uint_as_float(v.w << 16); f[7] = __uint_as_float(v.w & 0xffff0000u);
}
DEV float dot64_bf(const float* q, const bf16* row) {
  float s = 0.f;
#pragma unroll
  for (int i = 0; i < 8; ++i) {
    float f[8];
    unpack8(*(const uint4*)(row + i * 8), f);
#pragma unroll
    for (int j = 0; j < 8; ++j) s += q[i * 8 + j] * f[j];
  }
  return s;
}
DEV void axpy64_bf(float* o, float a, const bf16* row) {
#pragma unroll
  for (int i = 0; i < 8; ++i) {
    float f[8];
    unpack8(*(const uint4*)(row + i * 8), f);
#pragma unroll
    for (int j = 0; j < 8; ++j) o[i * 8 + j] += a * f[j];
  }
}
DEV float dot64_f(const float* q, const float* row) {
  float s = 0.f;
#pragma unroll
  for (int i = 0; i < 16; ++i) {
    float4 v = *(const float4*)(row + i * 4);
    s += q[i * 4] * v.x + q[i * 4 + 1] * v.y + q[i * 4 + 2] * v.z + q[i * 4 + 3] * v.w;
  }
  return s;
}
DEV void axpy64_f(float* o, float a, const float* row) {
#pragma unroll
  for (int i = 0; i < 16; ++i) {
    float4 v = *(const float4*)(row + i * 4);
    o[i * 4] += a * v.x; o[i * 4 + 1] += a * v.y; o[i * 4 + 2] += a * v.z; o[i * 4 + 3] += a * v.w;
  }
}
DEV void load_q64(float* q, const bf16* p, float scale) {
#pragma unroll
  for (int i = 0; i < 8; ++i) unpack8(*(const uint4*)(p + i * 8), q + i * 8);
#pragma unroll
  for (int i = 0; i < 64; ++i) q[i] *= scale;
}
DEV int lane_id_() { return __builtin_amdgcn_mbcnt_hi(~0u, __builtin_amdgcn_mbcnt_lo(~0u, 0u)); }
DEV int shx(int v, int m) {
  if (m == 1) return __builtin_amdgcn_update_dpp(0, v, 0xB1, 0xF, 0xF, true);
  if (m == 2) return __builtin_amdgcn_update_dpp(0, v, 0x4E, 0xF, 0xF, true);
  if (m == 4) return __builtin_amdgcn_ds_swizzle(v, 0x101F);
  if (m == 8) return __builtin_amdgcn_update_dpp(0, v, 0x128, 0xF, 0xF, true);
  if (m == 16) return __builtin_amdgcn_ds_swizzle(v, 0x401F);
  auto rr = __builtin_amdgcn_permlane32_swap((unsigned)v, (unsigned)v, false, false);
  return (lane_id_() < 32) ? (int)rr[1] : (int)rr[0];
}
DEV unsigned shx(unsigned v, int m) { return (unsigned)shx((int)v, m); }
DEV float shx(float v, int m) { return __int_as_float(shx(__float_as_int(v), m)); }
DEV float wave_sum(float v) {
#pragma unroll
  for (int o = 32; o >= 1; o >>= 1) v += shx(v, o);
  return v;
}

#define XB_TMO      128
#define XB_XCNT(j)  (256  + 64 * (j))
#define XB_XSUB(j)  (1280 + 64 * (j))
#define XB_XGEN(j)  (2304 + 64 * (j))
#define XB_TOP      3328
#define XB_TOPGEN   3392
#define XCD_BAR_WORDS 3456
#define XB_SPIN_CAP (1u << 18)
#define LAS __attribute__((address_space(3)))

__device__ __forceinline__ unsigned xb_ld(unsigned* p)              { return __hip_atomic_load(p, __ATOMIC_RELAXED, __HIP_MEMORY_SCOPE_AGENT); }
__device__ __forceinline__ unsigned xb_add(unsigned* p, unsigned v) { return __hip_atomic_fetch_add(p, v, __ATOMIC_RELAXED, __HIP_MEMORY_SCOPE_AGENT); }
__device__ __forceinline__ unsigned xb_xcc_id() { return (unsigned)__builtin_amdgcn_s_getreg((3 << 11) | 20) & 0xFu; }
#define XB_SPIN(cond, bar) do { unsigned _sp = 0; while (cond) { __builtin_amdgcn_s_sleep(1); \
    if ((++_sp & 255u) == 0u) { if (xb_ld(&(bar)[XB_TMO])) break; if (_sp > XB_SPIN_CAP) { atomicAdd(&(bar)[XB_TMO], 1u); break; } } } } while (0)

struct XcdBarrier {
    unsigned* bar; unsigned x;
    volatile LAS unsigned* st;
};

__device__ __forceinline__ XcdBarrier xcd_barrier_post(unsigned* bar, volatile LAS unsigned* st) {
    XcdBarrier b; b.bar = bar; b.x = xb_xcc_id(); b.st = st;
    if (tidx() == 0) (void)xb_add(&bar[XB_XCNT(b.x)], 1u);
    return b;
}
__device__ __forceinline__ void xcd_barrier_complete(unsigned* bar, unsigned x, unsigned& nloc, unsigned& nx) {
    const unsigned G = gridDim.x * gridDim.y * gridDim.z;
    unsigned sum, cnt, mine, sp = 0u;
    for (;;) {
        sum = 0u; cnt = 0u; mine = 0u;
#pragma unroll
        for (unsigned j = 0; j < 16; ++j) { const unsigned c = xb_ld(&bar[XB_XCNT(j)]); sum += c; cnt += (c > 0u) ? 1u : 0u; mine = (j == x) ? c : mine; }
        if (sum == G) break;
        __builtin_amdgcn_s_sleep(1);
        if ((++sp & 255u) == 0u) { if (xb_ld(&bar[XB_TMO])) break; if (sp > XB_SPIN_CAP) { atomicAdd(&bar[XB_TMO], 1u); break; } }
    }
    nloc = mine > 0u ? mine : 1u; nx = cnt > 0u ? cnt : 1u;
}

__device__ __forceinline__ void xcd_barrier(const XcdBarrier& b) {
    asm volatile("s_waitcnt vmcnt(0)" ::: "memory");
    __syncthreads();
    if (tidx() == 0) {
        unsigned* bar = b.bar;
        __builtin_amdgcn_s_waitcnt(0);
        unsigned nloc = b.st[0], nx = b.st[1];
        if (nloc == 0u) { xcd_barrier_complete(bar, b.x, nloc, nx); b.st[0] = nloc; b.st[1] = nx; }
        const unsigned old = xb_add(&bar[XB_XSUB(b.x)], 1u);
        const unsigned gen = old / nloc;
        if (old + 1u == (gen + 1u) * nloc) {
            __builtin_amdgcn_fence(__ATOMIC_RELEASE, "agent");
            asm volatile("s_waitcnt vmcnt(0)" ::: "memory");
            const unsigned og = xb_add(&bar[XB_TOP], 1u);
            const unsigned tg = og / nx;
            if (og + 1u == (tg + 1u) * nx) xb_add(&bar[XB_TOPGEN], 1u);
            else XB_SPIN(xb_ld(&bar[XB_TOPGEN]) == tg, bar);
            __builtin_amdgcn_fence(__ATOMIC_ACQUIRE, "agent");
            xb_add(&bar[XB_XGEN(b.x)], 1u);
            asm volatile("s_waitcnt vmcnt(0)" ::: "memory");
        } else {
            XB_SPIN(xb_ld(&bar[XB_XGEN(b.x)]) == gen, bar);
            __builtin_amdgcn_fence(__ATOMIC_ACQUIRE, "agent");
            asm volatile("s_waitcnt vmcnt(0)" ::: "memory");
        }
    }
    __syncthreads();
}


DEV int win_col_map(int j) {
  if (j < 1280) return j;
  if (j < 4864) return j + 24;
  if (j < 4888) return j - 4864 + 1280;
  return -1;
}
DEV void tr_tile(const float* __restrict__ src, int ldsrc, int K, bf16* __restrict__ dst, int kt, int nt, bool remap,
                 float* sm) {
  const int tid = tidx();
#pragma unroll 4
  for (int i = 0; i < 16; ++i) {
    int r = i * 4 + (tid >> 6), cx = tid & 63;
    int j = nt * 64 + cx, k = kt * 64 + r;
    int oc = remap ? win_col_map(j) : j;
    sm[r * 65 + cx] = (oc >= 0) ? src[(size_t)k * ldsrc + oc] : 0.f;
  }
  __syncthreads();
#pragma unroll 4
  for (int i = 0; i < 16; ++i) {
    int n = i * 4 + (tid >> 6), kk = tid & 63;
    dst[(size_t)(nt * 64 + n) * K + kt * 64 + kk] = f2bf(sm[kk * 65 + n]);
  }
  __syncthreads();
}

constexpr int PREP_TR_WIN = 2 * 78 * 16;
constexpr int PREP_TR_UPN = 2 * 16 * 8;
constexpr int PREP_TR_UPM = 2 * 16 * 8;
constexpr int PREP_TR_OUT = 2 * 16 * 16;
constexpr int PREP_TR_WQ = 2 * 32 * 16;
constexpr int PREP_ROPE = 512;
constexpr int PREP_MOD = 384;
constexpr int PREP_PEB = 16;
constexpr int PREP_PK = 32;
constexpr int PREP_TR_W1 = 4 * 2 * 32;
constexpr int PREP_ITEMS = PREP_TR_WIN + PREP_TR_UPN + PREP_TR_UPM + PREP_TR_OUT + PREP_TR_WQ + PREP_ROPE + PREP_MOD + PREP_PEB + PREP_PK + PREP_TR_W1;

DEV void prep_item(const Params& p, int item, float* sm) {
  const int tid = tidx();
  if (item < PREP_TR_WIN) {
    int l = item / (78 * 16), r = item % (78 * 16);
    int nt = r / 16, kt = r % 16;
    tr_tile(p.w_in + (size_t)l * 1024 * 4888, 4888, 1024, (bf16*)(p.ws + OFF_WINT) + (size_t)l * WN * 1024, kt, nt, true, sm);
    return;
  }
  item -= PREP_TR_WIN;
  if (item < PREP_TR_UPN) {
    int l = item / 128, r = item % 128;
    int nt = r / 8, kt = r % 8;
    tr_tile(p.w_up_nsa + (size_t)l * 512 * 1024, 1024, 512, (bf16*)(p.ws + OFF_WUPN) + (size_t)l * 1024 * 512, kt, nt, false, sm);
    return;
  }
  item -= PREP_TR_UPN;
  if (item < PREP_TR_UPM) {
    int l = item / 128, r = item % 128;
    int nt = r / 8, kt = r % 8;
    tr_tile(p.w_up_moba + (size_t)l * 512 * 1024, 1024, 512, (bf16*)(p.ws + OFF_WUPM) + (size_t)l * 1024 * 512, kt, nt, false, sm);
    return;
  }
  item -= PREP_TR_UPM;
  if (item < PREP_TR_OUT) {
    int l = item / 256, r = item % 256;
    int nt = r / 16, kt = r % 16;
    tr_tile(p.w_out + (size_t)l * 1024 * 1024, 1024, 1024, (bf16*)(p.ws + OFF_WOUT) + (size_t)l * 1024 * 1024, kt, nt, false, sm);
    return;
  }
  item -= PREP_TR_OUT;
  if (item < PREP_TR_WQ) {
    int l = item / 512, r = item % 512;
    int nt = r / 16, kt = r % 16;
    tr_tile(p.peer_wq + (size_t)l * 1024 * 2048, 2048, 1024, (bf16*)(p.ws + OFF_WQ) + (size_t)l * 2048 * 1024, kt, nt, false, sm);
    return;
  }
  item -= PREP_TR_WQ;
  if (item < PREP_ROPE) {
    int idx = item * 256 + tid;
    int pos = idx >> 3, i = idx & 7;
    float inv = powf(500000.0f, -(float)i / 8.0f);
    float ang = (float)pos * inv;
    float* rp = (float*)(p.ws + OFF_ROPE) + (size_t)pos * 16;
    rp[i] = (float)cos((double)ang);
    rp[8 + i] = (float)sin((double)ang);
    return;
  }
  item -= PREP_ROPE;
  if (item < PREP_MOD) {
    for (int i = tid; i < 2048; i += 256) {
      float cv = p.c[i];
      sm[i] = cv / (1.f + expf(-cv));
    }
    __syncthreads();
    const int l = item / 192, n0 = (item % 192) * 32;
    const int col = tid & 31, ks = tid >> 5;
    const float* w = p.w_ada + (size_t)l * 1024 * 6144 + n0 + col;
    float a0 = 0.f, a1 = 0.f;
#pragma unroll 8
    for (int k = ks * 128; k < ks * 128 + 128; ++k) {
      float wv = w[(size_t)k * 6144];
      a0 += sm[k] * wv;
      a1 += sm[1024 + k] * wv;
    }
    sm[2048 + tid * 2] = a0;
    sm[2048 + tid * 2 + 1] = a1;
    __syncthreads();
    if (tid < 64) {
      const int c2 = tid & 31, bs = tid >> 5;
      float s = 0.f;
#pragma unroll
      for (int q = 0; q < 8; ++q) s += sm[2048 + (q * 32 + c2) * 2 + bs];
      ((float*)(p.ws + OFF_MOD))[(l * 2 + bs) * 6144 + n0 + c2] = s + p.b_ada[l * 6144 + n0 + c2];
    }
    __syncthreads();
    return;
  }
  item -= PREP_MOD;
  if (item < PREP_PEB) {
    const int lw = item >> 2, j0 = (item & 3) * 32;
    const int col = tid & 31, ks = tid >> 5;
    const float* pe = p.cmp_pe + (size_t)lw * 2048;
    const float* w1 = p.cmp_w1 + (size_t)lw * 2048 * 128 + j0 + col;
    float a = 0.f;
#pragma unroll 8
    for (int i = ks * 256; i < ks * 256 + 256; ++i) a += pe[i] * w1[(size_t)i * 128];
    sm[tid] = a;
    __syncthreads();
    if (tid < 32) {
      float s = 0.f;
#pragma unroll
      for (int q = 0; q < 8; ++q) s += sm[q * 32 + tid];
      ((float*)(p.ws + OFF_PEB))[lw * 128 + j0 + tid] = s;
    }
    if (item == 0 && tid < 4) ((float*)(p.ws + OFF_PROBE))[tid] = 0.f;
    __syncthreads();
    return;
  }
  item -= PREP_PEB;
  if (item < PREP_PK) {
    const int e0 = item * 2048 + tid * 8;
    const int lt = e0 >> 14, off = e0 & 16383;
    const float* srcp = ((lt & 1) ? p.peer_k2 : p.peer_k1) + (size_t)(lt >> 1) * 16384 + off;
    const float4 a = *(const float4*)srcp, b4 = *(const float4*)(srcp + 4);
    uint4 pk;
    pk.x = (unsigned)f2bf(a.x) | ((unsigned)f2bf(a.y) << 16);
    pk.y = (unsigned)f2bf(a.z) | ((unsigned)f2bf(a.w) << 16);
    pk.z = (unsigned)f2bf(b4.x) | ((unsigned)f2bf(b4.y) << 16);
    pk.w = (unsigned)f2bf(b4.z) | ((unsigned)f2bf(b4.w) << 16);
    *(uint4*)((bf16*)(p.ws + OFF_PKB) + e0) = pk;
    return;
  }
  item -= PREP_PK;
  {
    const int lw = item >> 6, r = item & 63;
    const int nt = r >> 5, kt = r & 31;
    tr_tile(p.cmp_w1 + (size_t)lw * 2048 * 128, 128, 2048, (bf16*)(p.ws + OFF_W1T) + (size_t)lw * 128 * 2048, kt, nt, false, sm);
  }
}

DEV void norm_item(const float* __restrict__ xin, const float* __restrict__ g, const float* __restrict__ sc,
                   const float* __restrict__ sh, bf16* __restrict__ hout, int item) {
  const int lane = tidx() & 63, wave = tidx() >> 6;
  const size_t tok = (size_t)item * 4 + wave;
  const int b = (int)(tok / S);
  const float* xr = xin + tok * 1024;
  float4 v[4];
  float ss = 0.f;
#pragma unroll
  for (int i = 0; i < 4; ++i) {
    v[i] = *(const float4*)(xr + i * 256 + lane * 4);
    ss += v[i].x * v[i].x + v[i].y * v[i].y + v[i].z * v[i].z + v[i].w * v[i].w;
  }
  ss = wave_sum(ss);
  float r = 1.0f / sqrtf(ss * (1.0f / 1024.f) + 1e-6f);
#pragma unroll
  for (int i = 0; i < 4; ++i) {
    int d = i * 256 + lane * 4;
    float4 gg = *(const float4*)(g + d);
    float4 s4 = *(const float4*)(sc + b * 6144 + d);
    float4 h4 = *(const float4*)(sh + b * 6144 + d);
    float o0 = v[i].x * r * gg.x * (1.f + s4.x) + h4.x;
    float o1 = v[i].y * r * gg.y * (1.f + s4.y) + h4.y;
    float o2 = v[i].z * r * gg.z * (1.f + s4.z) + h4.z;
    float o3 = v[i].w * r * gg.w * (1.f + s4.w) + h4.w;
    uint2 pk;
    pk.x = (unsigned)f2bf(o0) | ((unsigned)f2bf(o1) << 16);
    pk.y = (unsigned)f2bf(o2) | ((unsigned)f2bf(o3) << 16);
    *(uint2*)(hout + tok * 1024 + d) = pk;
  }
}
DEV void final_norm_item(float* __restrict__ x, const float* __restrict__ g, int item) {
  const int lane = tidx() & 63, wave = tidx() >> 6;
  const size_t tok = (size_t)item * 4 + wave;
  float* xr = x + tok * 1024;
  float4 v[4];
  float ss = 0.f;
#pragma unroll
  for (int i = 0; i < 4; ++i) {
    v[i] = *(const float4*)(xr + i * 256 + lane * 4);
    ss += v[i].x * v[i].x + v[i].y * v[i].y + v[i].z * v[i].z + v[i].w * v[i].w;
  }
  ss = wave_sum(ss);
  float r = 1.0f / sqrtf(ss * (1.0f / 1024.f) + 1e-6f);
#pragma unroll
  for (int i = 0; i < 4; ++i) {
    int d = i * 256 + lane * 4;
    float4 gg = *(const float4*)(g + d);
    float4 o;
    o.x = v[i].x * r * gg.x; o.y = v[i].y * r * gg.y; o.z = v[i].z * r * gg.z; o.w = v[i].w * r * gg.w;
    *(float4*)(xr + d) = o;
  }
}

#define GM_BUF (2 * 128 * 72)
#define GM_LOAD(R, kk)                                                                                  \
  {                                                                                                     \
    const bf16* Ak = Ap + (kk);                                                                         \
    const bf16* Wk = Wp + (kk);                                                                         \
    R##a0 = *(const uint4*)(Ak); R##a1 = *(const uint4*)(Ak + a32); R##a2 = *(const uint4*)(Ak + 2 * a32); \
    R##a3 = *(const uint4*)(Ak + 3 * a32);                                                              \
    R##b0 = *(const uint4*)(Wk); R##b1 = *(const uint4*)(Wk + w32); R##b2 = *(const uint4*)(Wk + 2 * w32); \
    R##b3 = *(const uint4*)(Wk + 3 * w32);                                                              \
  }
#define GM_STORE(R, buf)                                                                                \
  {                                                                                                     \
    bf16* as_ = Asw + (buf) * GM_BUF;                                                                   \
    bf16* bs_ = as_ + 128 * 72;                                                                         \
    *(uint4*)(as_) = R##a0; *(uint4*)(as_ + 32 * 72) = R##a1; *(uint4*)(as_ + 64 * 72) = R##a2; *(uint4*)(as_ + 96 * 72) = R##a3; \
    *(uint4*)(bs_) = R##b0; *(uint4*)(bs_ + 32 * 72) = R##b1; *(uint4*)(bs_ + 64 * 72) = R##b2; *(uint4*)(bs_ + 96 * 72) = R##b3; \
  }
#define GM_COMPUTE(buf)                                                                                 \
  {                                                                                                     \
    const bf16* As_ = sm + (buf) * GM_BUF;                                                              \
    const bf16* Bs_ = As_ + 128 * 72;                                                                   \
    _Pragma("unroll") for (int ks = 0; ks < 2; ++ks) {                                                  \
      __builtin_amdgcn_sched_barrier(0);                                                                \
      bf16x8 af[4], bfr[4];                                                                             \
      _Pragma("unroll") for (int mi = 0; mi < 4; ++mi)                                                  \
        af[mi] = *(const bf16x8*)(As_ + (wr * 64 + mi * 16 + (lane & 15)) * 72 + ks * 32 + (lane >> 4) * 8); \
      _Pragma("unroll") for (int ni = 0; ni < 4; ++ni)                                                  \
        bfr[ni] = *(const bf16x8*)(Bs_ + (wc * 64 + ni * 16 + (lane & 15)) * 72 + ks * 32 + (lane >> 4) * 8); \
      _Pragma("unroll") for (int mi = 0; mi < 4; ++mi)                                                  \
        _Pragma("unroll") for (int ni = 0; ni < 4; ++ni)                                                \
          acc[mi][ni] = __builtin_amdgcn_mfma_f32_16x16x32_bf16(af[mi], bfr[ni], acc[mi][ni], 0, 0, 0); \
    }                                                                                                   \
    __builtin_amdgcn_sched_barrier(0);                                                                  \
  }
DEV void gemm_mainloop(const bf16* __restrict__ A, int lda, const bf16* __restrict__ W, int K, int m0, int n0, bf16* sm,
                       f32x4 (&acc)[4][4]) {
  const int tid = tidx(), lane = tid & 63, wave = tid >> 6;
  const int wr = wave >> 1, wc = wave & 1;
  const int lrow = tid >> 3, lkc = (tid & 7) * 8;
  const bf16* Ap = A + (size_t)(m0 + lrow) * lda + lkc;
  const bf16* Wp = W + (size_t)(n0 + lrow) * K + lkc;
  const int a32 = 32 * lda, w32 = 32 * K;
  bf16* Asw = sm + lrow * 72 + lkc;
  uint4 xa0, xa1, xa2, xa3, xb0, xb1, xb2, xb3, ya0, ya1, ya2, ya3, yb0, yb1, yb2, yb3;
  const int nk = K >> 6;
  GM_LOAD(x, 0)
  GM_LOAD(y, 64)
  __syncthreads();
  GM_STORE(x, 0)
  if (nk > 2) GM_LOAD(x, 128)
  __syncthreads();
  for (int k = 0; k < nk; k += 2) {
    GM_COMPUTE(0)
    GM_STORE(y, 1)
    if (k + 3 < nk) GM_LOAD(y, (k + 3) * 64)
    __syncthreads();
    GM_COMPUTE(1)
    if (k + 2 < nk) {
      GM_STORE(x, 0)
      if (k + 4 < nk) GM_LOAD(x, (k + 4) * 64)
    }
    __syncthreads();
  }
}
DEV void acc_zero(f32x4 (&acc)[4][4]) {
#pragma unroll
  for (int i = 0; i < 4; ++i)
#pragma unroll
    for (int j = 0; j < 4; ++j) acc[i][j] = f32x4{0.f, 0.f, 0.f, 0.f};
}
DEV void store_tile_bf16(bf16* sm, const f32x4 (&acc)[4][4], bf16* __restrict__ dbase, size_t dstride) {
  const int tid = tidx(), lane = tid & 63, wave = tid >> 6, g4 = lane >> 4, c16 = lane & 15;
  bf16* Cw = sm + wave * (64 * 72);
  __syncthreads();
#pragma unroll
  for (int mi = 0; mi < 4; ++mi)
#pragma unroll
    for (int ni = 0; ni < 4; ++ni)
#pragma unroll
      for (int r = 0; r < 4; ++r) Cw[(mi * 16 + g4 * 4 + r) * 72 + ni * 16 + c16] = f2bf(acc[mi][ni][r]);
  __syncthreads();
#pragma unroll
  for (int it = 0; it < 8; ++it) {
    const int row_l = it * 8 + (lane >> 3), ch = lane & 7;
    const uint4 v = *(const uint4*)(Cw + row_l * 72 + ch * 8);
    *(uint4*)(dbase + (size_t)row_l * dstride + ch * 8) = v;
  }
}
template <class Epi>
DEV void gemm_tile(const bf16* __restrict__ A, int lda, const bf16* __restrict__ W, int K, int m0, int n0, bf16* sm,
                   Epi epi) {
  f32x4 acc[4][4];
  acc_zero(acc);
  gemm_mainloop(A, lda, W, K, m0, n0, sm, acc);
  const int tid = tidx(), lane = tid & 63, wave = tid >> 6;
  const int wr = wave >> 1, wc = wave & 1;
#pragma unroll
  for (int mi = 0; mi < 4; ++mi)
#pragma unroll
    for (int ni = 0; ni < 4; ++ni)
#pragma unroll
      for (int r = 0; r < 4; ++r) {
        int row = m0 + wr * 64 + mi * 16 + (lane >> 4) * 4 + r;
        int col = n0 + wc * 64 + ni * 16 + (lane & 15);
        epi(row, col, acc[mi][ni][r]);
      }
}
DEV void inproj_tile(const Params& p, int layer, int m0, int n0, bf16* sm) {
  f32x4 acc[4][4];
  acc_zero(acc);
  gemm_mainloop((const bf16*)(p.ws + OFF_H), 1024, (const bf16*)(p.ws + OFF_WINT) + (size_t)layer * WN * 1024, 1024, m0, n0, sm, acc);
  const int tid = tidx(), lane = tid & 63, wave = tid >> 6, g4 = lane >> 4, c16 = lane & 15;
  const int wr = wave >> 1, wc = wave & 1;
  const int vc0 = n0 + wc * 64;
  const int row0 = m0 + wr * 64;
  const int b = row0 / S, t0 = row0 % S;
  bf16* dbase;
  size_t dstride;
  bool roped = false;
  bf16* projp = (bf16*)(p.ws + OFF_PROJ) + (size_t)row0 * PC;
  if (vc0 < 768) { dbase = projp + vc0; dstride = PC; }
  else if (vc0 < 1280) {
    const int seg = (vc0 - 768) >> 7, head = ((vc0 - 768) >> 6) & 1;
    const size_t off = (seg == 0) ? OFF_KSB : (seg == 1) ? OFF_VSB : (seg == 2) ? OFF_KWB : OFF_VWB;
    dbase = (bf16*)(p.ws + off) + ((size_t)(b * 2 + head) * S + t0) * 64;
    dstride = 64;
    roped = (seg == 0) || (seg == 2);
  } else if (vc0 < 1792) { dbase = projp + C_MQ + (vc0 - 1280); dstride = PC; roped = true; }
  else if (vc0 < 2816) {
    const int seg = (vc0 - 1792) >> 9, head = ((vc0 - 1792) >> 6) & 7;
    dbase = (bf16*)(p.ws + (seg ? OFF_MVB : OFF_MKB)) + ((size_t)(b * 8 + head) * S + t0) * 64;
    dstride = 64;
    roped = (seg == 0);
  } else if (vc0 < 4864) { dbase = projp + C_GN + (vc0 - 2816); dstride = PC; }
  else { dbase = projp + C_NG + (vc0 - 4864); dstride = PC; }
  if (roped) {
    const float* rope = (const float*)(p.ws + OFF_ROPE);
#pragma unroll
    for (int mi = 0; mi < 4; ++mi)
#pragma unroll
      for (int r = 0; r < 4; ++r) {
        const int pos = t0 + mi * 16 + g4 * 4 + r;
        const float v = acc[mi][0][r];
        const float pv = shx(v, 8);
        const float cs = rope[pos * 16 + (c16 & 7)], sn = rope[pos * 16 + 8 + (c16 & 7)];
        acc[mi][0][r] = (c16 < 8) ? (v * cs - pv * sn) : (v * cs + pv * sn);
      }
  }
  store_tile_bf16(sm, acc, dbase, dstride);
}
typedef unsigned u32x2_t __attribute__((ext_vector_type(2)));
DEV void merge_tile(const Params& p, int layer, int m0, int n0, bf16* sm) {
  const int tid = tidx(), lane = tid & 63, wave = tid >> 6, g4 = lane >> 4, c16 = lane & 15;
  const int wr = wave >> 1, wc = wave & 1;
  const bf16* projg = (const bf16*)(p.ws + OFF_PROJ) + (size_t)(m0 + wr * 64 + g4 * 4) * PC + n0 + wc * 64 + c16;
  f32x4 acc[4][4];
  acc_zero(acc);
  gemm_mainloop((const bf16*)(p.ws + OFF_ONSA), 512, (const bf16*)(p.ws + OFF_WUPN) + (size_t)layer * 1024 * 512, 512, m0, n0, sm, acc);
  bf16* yg = (bf16*)(p.ws + OFF_H) + (size_t)(m0 + wr * 64 + g4 * 4) * 1024 + n0 + wc * 64 + c16;
#pragma unroll
  for (int mi = 0; mi < 4; ++mi)
#pragma unroll
    for (int ni = 0; ni < 4; ++ni)
#pragma unroll
      for (int r = 0; r < 4; ++r)
        yg[(size_t)(mi * 16 + r) * 1024 + ni * 16] =
            f2bf(sigmoidf_(bf2f(projg[(size_t)(mi * 16 + r) * PC + C_GN + ni * 16])) * acc[mi][ni][r]);
  acc_zero(acc);
  gemm_mainloop((const bf16*)(p.ws + OFF_OMOBA), 512, (const bf16*)(p.ws + OFF_WUPM) + (size_t)layer * 1024 * 512, 512, m0, n0, sm, acc);
#pragma unroll
  for (int mi = 0; mi < 4; ++mi)
#pragma unroll
    for (int ni = 0; ni < 4; ++ni)
#pragma unroll
      for (int r = 0; r < 4; ++r)
        acc[mi][ni][r] = bf2f(yg[(size_t)(mi * 16 + r) * 1024 + ni * 16]) +
                         sigmoidf_(bf2f(projg[(size_t)(mi * 16 + r) * PC + C_GM + ni * 16])) * acc[mi][ni][r];
  store_tile_bf16(sm, acc, (bf16*)(p.ws + OFF_H) + (size_t)(m0 + wr * 64) * 1024 + n0 + wc * 64, 1024);
}

DEV void compress_item(const Params& p, int layer, int item, float* sm) {
  const int tid = tidx();
  const int grp = item & 127, which = (item >> 7) & 1, kvh = (item >> 8) & 1, b = item >> 9;
  const int c0 = grp * 8;
  float* xs = sm;
  float* hs = sm + 144 * 64;
  const bf16* proj = (const bf16*)(p.ws + OFF_PROJ);
  const int col = (which ? C_VC : C_KC) + kvh * 64;
  for (int i = tid; i < 144 * 64; i += 256) {
    int tl = i >> 6, d = i & 63;
    int t = c0 * 16 + tl;
    xs[i] = (t < S) ? bf2f(proj[((size_t)b * S + t) * PC + col + d]) : 0.f;
  }
  __syncthreads();
  const int lw = layer * 2 + which;
  if (tid < 128) {
    const float* w1 = p.cmp_w1 + (size_t)lw * 2048 * 128 + tid;
    float acc[8];
#pragma unroll
    for (int ci = 0; ci < 8; ++ci) acc[ci] = 0.f;
    for (int l = 0; l < 32; ++l) {
#pragma unroll 4
      for (int d = 0; d < 64; ++d) {
        float w = w1[(size_t)(l * 64 + d) * 128];
#pragma unroll
        for (int ci = 0; ci < 8; ++ci) acc[ci] += xs[(ci * 16 + l) * 64 + d] * w;
      }
    }
    float pb = ((const float*)(p.ws + OFF_PEB))[lw * 128 + tid];
#pragma unroll
    for (int ci = 0; ci < 8; ++ci) hs[ci * 128 + tid] = gelu_tanh(acc[ci] + pb);
  }
  __syncthreads();
  const float* w2 = p.cmp_w2 + (size_t)lw * 128 * 64;
  float* outp = PROBE_CMPR ? ((float*)(p.ws + OFF_CMP) + (which ? (size_t)Bn * 1024 * 128 : 0)) : (float*)(p.ws + (which ? OFF_VCC : OFF_KCC));
#pragma unroll
  for (int rr = 0; rr < 2; ++rr) {
    int o = rr * 256 + tid;
    int ci = o >> 6, d = o & 63;
    int c = c0 + ci;
    float a = 0.f;
    for (int j = 0; j < 128; ++j) a += hs[ci * 128 + j] * w2[j * 64 + d];
    if (c < 1023) outp[(((size_t)b * 1024 + c) * 2 + kvh) * 64 + d] = a;
    bf16* outb = (bf16*)(p.ws + (which ? OFF_VCB : OFF_KCB));
    if (!PROBE_CMPR && c < 1024) outb[(((size_t)b * 2 + kvh) * 1024 + c) * 64 + d] = (c < 1023) ? f2bf(a) : (bf16)0;
  }
  __syncthreads();
}

DEV void compress_mfma_item(const Params& p, int layer, int item, char* smem) {
  bf16* xs = (bf16*)smem;
  float* hs = (float*)(smem + 272 * 64 * 2);
  const int tid = tidx(), lane = tid & 63, wave = tid >> 6, g4 = lane >> 4, c16 = lane & 15;
  const int cblk = item & 63, which = (item >> 6) & 1, kvh = (item >> 7) & 1, b = item >> 8;
  const int t0 = cblk * 256;
  const bf16* proj = (const bf16*)(p.ws + OFF_PROJ) + (size_t)b * S * PC + (which ? C_VC : C_KC) + kvh * 64;
  __syncthreads();
  for (int i = tid; i < 272 * 8; i += 256) {
    const int tl = i >> 3, ch = i & 7;
    const int t = t0 + tl;
    uint4 v = uint4{0u, 0u, 0u, 0u};
    if (t < S) v = *(const uint4*)(proj + (size_t)t * PC + ch * 8);
    *(uint4*)(xs + tl * 64 + ((ch ^ ((tl >> 4) & 7)) * 8)) = v;
  }
  __syncthreads();
  const int lw = layer * 2 + which;
  const bf16* w1t = (const bf16*)(p.ws + OFF_W1T) + (size_t)lw * 128 * 2048;
  f32x4 acc0 = f32x4{0.f, 0.f, 0.f, 0.f}, acc1 = f32x4{0.f, 0.f, 0.f, 0.f};
  const bf16* wb0 = w1t + (size_t)((2 * wave) * 16 + c16) * 2048 + g4 * 8;
  const bf16* wb1 = w1t + (size_t)((2 * wave + 1) * 16 + c16) * 2048 + g4 * 8;
#pragma unroll 4
  for (int ks = 0; ks < 64; ++ks) {
    const int l = ks >> 1, ch = (ks & 1) * 4 + g4;
    const int tl = 16 * c16 + l;
    const bf16x8 af = *(const bf16x8*)(xs + tl * 64 + ((ch ^ ((tl >> 4) & 7)) * 8));
    const bf16x8 b0 = *(const bf16x8*)(wb0 + ks * 32);
    const bf16x8 b1 = *(const bf16x8*)(wb1 + ks * 32);
    acc0 = MFMA16B(af, b0, acc0);
    acc1 = MFMA16B(af, b1, acc1);
  }
  {
    const float* peb = (const float*)(p.ws + OFF_PEB) + lw * 128;
    const int j0 = (2 * wave) * 16 + c16, j1 = j0 + 16;
    const float pb0 = peb[j0], pb1 = peb[j1];
#pragma unroll
    for (int r = 0; r < 4; ++r) {
      hs[(g4 * 4 + r) * 128 + j0] = gelu_tanh(acc0[r] + pb0);
      hs[(g4 * 4 + r) * 128 + j1] = gelu_tanh(acc1[r] + pb1);
    }
  }
  __syncthreads();
  const float* w2 = p.cmp_w2 + (size_t)lw * 128 * 64;
  const int d = tid & 63, cq = tid >> 6;
  float o0 = 0.f, o1 = 0.f, o2 = 0.f, o3 = 0.f;
#pragma unroll 8
  for (int j = 0; j < 128; ++j) {
    const float w = w2[j * 64 + d];
    o0 += hs[(cq * 4 + 0) * 128 + j] * w;
    o1 += hs[(cq * 4 + 1) * 128 + j] * w;
    o2 += hs[(cq * 4 + 2) * 128 + j] * w;
    o3 += hs[(cq * 4 + 3) * 128 + j] * w;
  }
  float* outp = (float*)(p.ws + (which ? OFF_VCC : OFF_KCC));
  bf16* outb = (bf16*)(p.ws + (which ? OFF_VCB : OFF_KCB));
  const float ov[4] = {o0, o1, o2, o3};
#pragma unroll
  for (int i = 0; i < 4; ++i) {
    const int c = cblk * 16 + cq * 4 + i;
    if (c < 1023) outp[(((size_t)b * 1024 + c) * 2 + kvh) * 64 + d] = ov[i];
    outb[(((size_t)b * 2 + kvh) * 1024 + c) * 64 + d] = (c < 1023) ? f2bf(ov[i]) : (bf16)0;
  }
  __syncthreads();
}

DEV void n1_item(const Params& p, int layer, int item, float* sm) {
  const int chunk = item & 255, kvh = (item >> 8) & 1, b = item >> 9;
  const int tid = tidx(), ql = tid >> 2, g = tid & 3;
  const int t = chunk * 64 + ql, h = kvh * 4 + g;
  const size_t tok = (size_t)b * S + t;
  const bf16* proj = (const bf16*)(p.ws + OFF_PROJ);
  float* imp = sm;
  for (int i = tid; i < 64 * 257; i += 256) imp[i] = 0.f;
  float q[64];
  load_q64(q, proj + tok * PC + C_NQ + h * 64, 0.125f);
  const int nv = (t >= 31) ? (((t - 31) >> 4) + 1) : 0;
  const int nv_max = (((chunk * 64 + 63) - 31) >> 4) + 1;
  const float* kc = (const float*)(p.ws + OFF_KCC) + (size_t)b * 1024 * 128 + kvh * 64;
  const float* vc = (const float*)(p.ws + OFF_VCC) + (size_t)b * 1024 * 128 + kvh * 64;
  float m = -INFINITY, l = 0.f;
  for (int c = 0; c < nv_max; ++c) {
    float s = dot64_f(q, kc + (size_t)c * 128);
    if (c < nv) {
      float mn = fmaxf(m, s);
      l = l * expf(m - mn) + expf(s - mn);
      m = mn;
    }
  }
  __syncthreads();
  float o[64];
#pragma unroll
  for (int d = 0; d < 64; ++d) o[d] = 0.f;
  const float inv_l = (nv > 0) ? 1.f / l : 0.f;
  for (int c = 0; c < nv_max; ++c) {
    float s = dot64_f(q, kc + (size_t)c * 128);
    float pr = (c < nv) ? expf(s - m) * inv_l : 0.f;
    axpy64_f(o, pr, vc + (size_t)c * 128);
    float ps = pr;
    ps += shx(ps, 1);
    ps += shx(ps, 2);
    if (g == 0) {
      int n = c >> 2;
      if ((c & 3) == 3) {
        imp[ql * 257 + n] += 0.5f * ps;
        imp[ql * 257 + n + 1] += 0.5f * ps;
      } else {
        imp[ql * 257 + n] += ps;
      }
    }
  }
  const float gate0 = (!PROBE_NSA || (PROBE_NSA & 1)) ? sigmoidf_(bf2f(proj[tok * PC + C_NG + h * 3 + 0])) : 0.f;
  float* oa = (float*)(p.ws + OFF_H) + tok * 512 + h * 64;
#pragma unroll
  for (int d = 0; d < 64; d += 4) {
    float4 v = {gate0 * o[d], gate0 * o[d + 1], gate0 * o[d + 2], gate0 * o[d + 3]};
    *(float4*)(oa + d) = v;
  }
  __syncthreads();
#if PROBE_NSA == 8
  if (b == 0 && kvh == 0)
    for (int i = tid; i < 64 * 256; i += 256)
      ((float*)(p.ws + OFF_OMOBA))[(size_t)(chunk * 64 + (i >> 8)) * 256 + (i & 255)] = imp[(i >> 8) * 257 + (i & 255)];
  __syncthreads();
#endif
  if (g == 0) {
    int* selp = (int*)(p.ws + OFF_SEL) + (((size_t)b * 2 + kvh) * S + t) * 16;
    const int cur = chunk;
    if (cur < 16) {
      for (int j = 0; j < 16; ++j) selp[j] = (j <= cur) ? j : -1;
    } else {
      selp[0] = 0;
      selp[1] = cur - 1;
      selp[2] = cur;
      float* row = imp + ql * 257;
      for (int j = 3; j < 16; ++j) {
        float best = -1.f;
        int bi = 1;
        for (int n = 1; n <= cur - 2; ++n) {
          float v = row[n];
          if (v > best) { best = v; bi = n; }
        }
        selp[j] = bi;
        row[bi] = -2.f;
      }
    }
  }
  __syncthreads();
}

DEV void kmean_item(const Params& p, int item, float* sm) {
  const int n = item & 63, h = (item >> 6) & 7, b = item >> 9;
  const int tid = tidx(), d = tid & 63, part = tid >> 6;
  const bf16* mkb = (const bf16*)(p.ws + OFF_MKB);
  float a = 0.f;
  for (int i = 0; i < 64; ++i) {
    int t = n * 256 + part * 64 + i;
    a += bf2f(mkb[((size_t)(b * 8 + h) * S + t) * 64 + d]);
  }
  sm[tid] = a;
  __syncthreads();
  if (tid < 64) {
    float s = sm[tid] + sm[64 + tid] + sm[128 + tid] + sm[192 + tid];
    const size_t ko = (((size_t)b * 8 + h) * 64 + n) * 64 + tid;
    const float mean = s * (1.f / 256.f);
    ((float*)(p.ws + OFF_KMEAN))[ko] = mean;
    const bf16 hi = f2bf(mean);
    ((bf16*)(p.ws + OFF_KMHL))[ko] = hi;
    ((bf16*)(p.ws + OFF_KMHL))[(size_t)2 * 8 * 64 * 64 + ko] = f2bf(mean - bf2f(hi));
  }
  __syncthreads();
}

DEV void n23_item(const Params& p, int layer, int item) {
  const int chunk = item & 255, kvh = (item >> 8) & 1, b = item >> 9;
  const int tid = tidx(), ql = tid >> 2, g = tid & 3;
  const int t = chunk * 64 + ql, h = kvh * 4 + g;
  const size_t tok = (size_t)b * S + t;
  const bf16* proj = (const bf16*)(p.ws + OFF_PROJ);
  const float* rope = (const float*)(p.ws + OFF_ROPE) + (size_t)t * 16;
  float q[64];
  load_q64(q, proj + tok * PC + C_NQ + h * 64, 1.0f);
#pragma unroll
  for (int i = 0; i < 8; ++i) {
    float cs = rope[i], sn = rope[8 + i];
    float x1 = q[i], x2 = q[8 + i];
    q[i] = x1 * cs - x2 * sn;
    q[8 + i] = x2 * cs + x1 * sn;
  }
#pragma unroll
  for (int i = 0; i < 64; ++i) q[i] *= 0.125f;
  const size_t kvo = ((size_t)(b * 2 + kvh) * S) * 64;
  const bf16* ksb = (const bf16*)(p.ws + OFF_KSB) + kvo;
  const bf16* vsb = (const bf16*)(p.ws + OFF_VSB) + kvo;
  const bf16* kwb = (const bf16*)(p.ws + OFF_KWB) + kvo;
  const bf16* vwb = (const bf16*)(p.ws + OFF_VWB) + kvo;
  const int* selp = (const int*)(p.ws + OFF_SEL) + (((size_t)b * 2 + kvh) * S + t) * 16;
  float* oa = (float*)(p.ws + OFF_H) + tok * 512 + h * 64;
  const float gate1 = (!PROBE_NSA || (PROBE_NSA & 2)) ? sigmoidf_(bf2f(proj[tok * PC + C_NG + h * 3 + 1])) : 0.f;
  const float gate2 = (!PROBE_NSA || (PROBE_NSA & 4)) ? sigmoidf_(bf2f(proj[tok * PC + C_NG + h * 3 + 2])) : 0.f;
  float o[64];
  {
    float m = -INFINITY;
    for (int j = 0; j < 16; ++j) {
      int n = selp[j];
      if (n >= 0) {
        for (int i = 0; i < 64; ++i) {
          int kpos = n * 64 + i;
          if (kpos <= t) {
            float s = dot64_bf(q, ksb + (size_t)kpos * 64);
            m = fmaxf(m, s);
          }
        }
      }
    }
    float l = 0.f;
#pragma unroll
    for (int d = 0; d < 64; ++d) o[d] = 0.f;
    for (int j = 0; j < 16; ++j) {
      int n = selp[j];
      if (n >= 0) {
        for (int i = 0; i < 64; ++i) {
          int kpos = n * 64 + i;
          if (kpos <= t) {
            float s = dot64_bf(q, ksb + (size_t)kpos * 64);
            float pr = expf(s - m);
            l += pr;
            axpy64_bf(o, pr, vsb + (size_t)kpos * 64);
          }
        }
      }
    }
    float sc = gate1 / l;
#pragma unroll
    for (int d = 0; d < 64; d += 4) {
      float4 v = *(float4*)(oa + d);
      v.x += sc * o[d]; v.y += sc * o[d + 1]; v.z += sc * o[d + 2]; v.w += sc * o[d + 3];
      *(float4*)(oa + d) = v;
    }
  }
  {
    const int s0 = chunk * 64;
    const int jlo = (s0 - 511 > 0) ? (s0 - 511) : 0;
    const int jhi = s0 + 63;
    float m = -INFINITY;
    for (int j = jlo; j <= jhi; ++j) {
      float s = dot64_bf(q, kwb + (size_t)j * 64);
      if (j <= t && j > t - 512) m = fmaxf(m, s);
    }
    float l = 0.f;
#pragma unroll
    for (int d = 0; d < 64; ++d) o[d] = 0.f;
    for (int j = jlo; j <= jhi; ++j) {
      float s = dot64_bf(q, kwb + (size_t)j * 64);
      float pr = (j <= t && j > t - 512) ? expf(s - m) : 0.f;
      l += pr;
      axpy64_bf(o, pr, vwb + (size_t)j * 64);
    }
    float sc = gate2 / l;
    bf16* ob = (bf16*)(p.ws + (PROBE_NSA ? OFF_CMP : OFF_ONSA)) + tok * 512 + h * 64;
#pragma unroll
    for (int d = 0; d < 64; d += 8) {
      float4 v0 = *(float4*)(oa + d);
      float4 v1 = *(float4*)(oa + d + 4);
      uint4 pk;
      pk.x = (unsigned)f2bf(v0.x + sc * o[d]) | ((unsigned)f2bf(v0.y + sc * o[d + 1]) << 16);
      pk.y = (unsigned)f2bf(v0.z + sc * o[d + 2]) | ((unsigned)f2bf(v0.w + sc * o[d + 3]) << 16);
      pk.z = (unsigned)f2bf(v1.x + sc * o[d + 4]) | ((unsigned)f2bf(v1.y + sc * o[d + 5]) << 16);
      pk.w = (unsigned)f2bf(v1.z + sc * o[d + 6]) | ((unsigned)f2bf(v1.w + sc * o[d + 7]) << 16);
      *(uint4*)(ob + d) = pk;
    }
  }
}

DEV void moba_item(const Params& p, int layer, int item) {
  const int blk = item & 63, h = (item >> 6) & 7, b = item >> 9;
  const int tid = tidx();
  const int t = blk * 256 + tid;
  const size_t tok = (size_t)b * S + t;
  const bf16* proj = (const bf16*)(p.ws + OFF_PROJ);
  float q[64];
  load_q64(q, proj + tok * PC + C_MQ + h * 64, 0.125f);
  const float* km = (const float*)(p.ws + OFF_KMEAN) + ((size_t)b * 8 + h) * 64 * 64;
  float b0 = -INFINITY, b1 = -INFINITY, b2 = -INFINITY;
  int i0 = -1, i1 = -1, i2 = -1;
  for (int n = 0; n < blk; ++n) {
    float v = dot64_f(q, km + n * 64);
    if (v > b0) { b2 = b1; i2 = i1; b1 = b0; i1 = i0; b0 = v; i0 = n; }
    else if (v > b1) { b2 = b1; i2 = i1; b1 = v; i1 = n; }
    else if (v > b2) { b2 = v; i2 = n; }
  }
  const bf16* mkb = (const bf16*)(p.ws + OFF_MKB) + ((size_t)(b * 8 + h) * S) * 64;
  const bf16* mvb = (const bf16*)(p.ws + OFF_MVB) + ((size_t)(b * 8 + h) * S) * 64;
  float m = -INFINITY;
  for (int sidx = 0; sidx < 3; ++sidx) {
    int n = (sidx == 0) ? i0 : (sidx == 1) ? i1 : i2;
    if (sidx < blk) {
      for (int i = 0; i < 256; ++i) {
        float s = dot64_bf(q, mkb + (size_t)(n * 256 + i) * 64);
        m = fmaxf(m, s);
      }
    }
  }
  for (int i = 0; i < 256; ++i) {
    int kpos = blk * 256 + i;
    float s = dot64_bf(q, mkb + (size_t)kpos * 64);
    if (kpos <= t) m = fmaxf(m, s);
  }
  float l = 0.f;
  float o[64];
#pragma unroll
  for (int d = 0; d < 64; ++d) o[d] = 0.f;
  for (int sidx = 0; sidx < 3; ++sidx) {
    int n = (sidx == 0) ? i0 : (sidx == 1) ? i1 : i2;
    if (sidx < blk) {
      for (int i = 0; i < 256; ++i) {
        const size_t ko = (size_t)(n * 256 + i) * 64;
        float s = dot64_bf(q, mkb + ko);
        float pr = expf(s - m);
        l += pr;
        axpy64_bf(o, pr, mvb + ko);
      }
    }
  }
  for (int i = 0; i < 256; ++i) {
    int kpos = blk * 256 + i;
    const size_t ko = (size_t)kpos * 64;
    float s = dot64_bf(q, mkb + ko);
    float pr = (kpos <= t) ? expf(s - m) : 0.f;
    l += pr;
    axpy64_bf(o, pr, mvb + ko);
  }
  const float il = 1.f / l;
  bf16* ob = (bf16*)(p.ws + (PROBE_MOBA ? OFF_CMP : OFF_OMOBA)) + tok * 512 + h * 64;
#pragma unroll
  for (int d = 0; d < 64; d += 8) {
    uint4 pk;
    pk.x = (unsigned)f2bf(o[d] * il) | ((unsigned)f2bf(o[d + 1] * il) << 16);
    pk.y = (unsigned)f2bf(o[d + 2] * il) | ((unsigned)f2bf(o[d + 3] * il) << 16);
    pk.z = (unsigned)f2bf(o[d + 4] * il) | ((unsigned)f2bf(o[d + 5] * il) << 16);
    pk.w = (unsigned)f2bf(o[d + 6] * il) | ((unsigned)f2bf(o[d + 7] * il) << 16);
    *(uint4*)(ob + d) = pk;
  }
}

typedef short v4i16_t __attribute__((ext_vector_type(4)));
typedef unsigned u32x4_t __attribute__((ext_vector_type(4)));
DEV v4i16_t lds_tr16(const bf16* p) {
  return __builtin_amdgcn_ds_read_tr16_b64_v4i16((__attribute__((address_space(3))) v4i16_t*)p);
}
DEV unsigned cvtpk(float lo, float hi) {
  unsigned r;
  asm("v_cvt_pk_bf16_f32 %0, %1, %2" : "=v"(r) : "v"(lo), "v"(hi));
  return r;
}
#define MFMA16(a, b, c) __builtin_amdgcn_mfma_f32_16x16x32_bf16(a, b, c, 0, 0, 0)
constexpr float C2 = 0.125f * 1.4426950408889634f;
constexpr int KT_LD = 72;
constexpr int KT_ELEMS = 64 * KT_LD;

template <int NI>
struct AttnSt {
  f32x4 o[4][NI];
  float m[NI], l[NI];
};
template <int NI>
DEV void attn_init(AttnSt<NI>& st) {
#pragma unroll
  for (int ni = 0; ni < NI; ++ni) {
    st.m[ni] = -INFINITY;
    st.l[ni] = 0.f;
#pragma unroll
    for (int di = 0; di < 4; ++di) st.o[di][ni] = f32x4{0.f, 0.f, 0.f, 0.f};
  }
}
#define TILE_DECL uint4 tl_k0, tl_k1, tl_v0, tl_v1
#define TILE_GLOAD(kb, vb, ld, key0)                                                        \
  do {                                                                                      \
    const int r_ = tidx() >> 3, c_ = (tidx() & 7) * 8;                            \
    tl_k0 = *(const uint4*)((kb) + (size_t)((key0) + r_) * (ld) + c_);                      \
    tl_k1 = *(const uint4*)((kb) + (size_t)((key0) + 32 + r_) * (ld) + c_);                 \
    tl_v0 = *(const uint4*)((vb) + (size_t)((key0) + r_) * (ld) + c_);                      \
    tl_v1 = *(const uint4*)((vb) + (size_t)((key0) + 32 + r_) * (ld) + c_);                 \
  } while (0)
#define TILE_SSTORE(Ks_, Vs_)                                                               \
  do {                                                                                      \
    const int r_ = tidx() >> 3, c_ = (tidx() & 7) * 8;                            \
    *(uint4*)((Ks_) + r_ * KT_LD + c_) = tl_k0;                                             \
    *(uint4*)((Ks_) + (32 + r_) * KT_LD + c_) = tl_k1;                                      \
    *(uint4*)((Vs_) + r_ * KT_LD + c_) = tl_v0;                                             \
    *(uint4*)((Vs_) + (32 + r_) * KT_LD + c_) = tl_v1;                                      \
  } while (0)
#define TL_GLOAD(P, kb, vb, ld, key0)                                                       \
  do {                                                                                      \
    const int r_ = tidx() >> 3, c_ = (tidx() & 7) * 8;                                      \
    P##_k0 = *(const uint4*)((kb) + (size_t)((key0) + r_) * (ld) + c_);                     \
    P##_k1 = *(const uint4*)((kb) + (size_t)((key0) + 32 + r_) * (ld) + c_);                \
    P##_v0 = *(const uint4*)((vb) + (size_t)((key0) + r_) * (ld) + c_);                     \
    P##_v1 = *(const uint4*)((vb) + (size_t)((key0) + 32 + r_) * (ld) + c_);                \
  } while (0)
#define TL_SSTORE(P, Ks_, Vs_)                                                              \
  do {                                                                                      \
    const int r_ = tidx() >> 3, c_ = (tidx() & 7) * 8;                                      \
    *(uint4*)((Ks_) + r_ * KT_LD + c_) = P##_k0;                                            \
    *(uint4*)((Ks_) + (32 + r_) * KT_LD + c_) = P##_k1;                                     \
    *(uint4*)((Vs_) + r_ * KT_LD + c_) = P##_v0;                                            \
    *(uint4*)((Vs_) + (32 + r_) * KT_LD + c_) = P##_v1;                                     \
  } while (0)
#define KV_SWEEP(kb_, vb_, ld_, nt_, KEYF, ...)                                             \
  {                                                                                         \
    uint4 tA_k0, tA_k1, tA_v0, tA_v1, tB_k0, tB_k1, tB_v0, tB_v1;                           \
    const int nt__ = (nt_);                                                                 \
    if (nt__ > 0) {                                                                         \
      TL_GLOAD(tA, kb_, vb_, ld_, KEYF(0));                                                 \
      TL_SSTORE(tA, smkv, smkv + KT_ELEMS);                                                 \
      if (nt__ > 1) TL_GLOAD(tA, kb_, vb_, ld_, KEYF(1));                                   \
    }                                                                                       \
    __syncthreads();                                                                        \
    for (int it0__ = 0; it0__ < nt__; it0__ += 2) {                                         \
      {                                                                                     \
        const int it = it0__;                                                               \
        if (it + 2 < nt__) TL_GLOAD(tB, kb_, vb_, ld_, KEYF(it + 2));                       \
        const bf16* Ks = smkv;                                                              \
        __VA_ARGS__                                                                         \
        if (it + 1 < nt__) TL_SSTORE(tA, smkv + 2 * KT_ELEMS, smkv + 3 * KT_ELEMS);         \
        __syncthreads();                                                                    \
      }                                                                                     \
      if (it0__ + 1 < nt__) {                                                               \
        const int it = it0__ + 1;                                                           \
        if (it + 2 < nt__) TL_GLOAD(tA, kb_, vb_, ld_, KEYF(it + 2));                       \
        const bf16* Ks = smkv + 2 * KT_ELEMS;                                               \
        __VA_ARGS__                                                                         \
        if (it + 1 < nt__) TL_SSTORE(tB, smkv, smkv + KT_ELEMS);                            \
        __syncthreads();                                                                    \
      }                                                                                     \
    }                                                                                       \
  }
template <int NI>
DEV void attn_scores(const bf16* Ks, const bf16x8 (&qf)[NI][2], f32x4 (&s)[4][NI]) {
  const int lane = tidx() & 63, g4 = lane >> 4, c16 = lane & 15;
#pragma unroll
  for (int mi = 0; mi < 4; ++mi) {
#pragma unroll
    for (int ni = 0; ni < NI; ++ni) s[mi][ni] = f32x4{0.f, 0.f, 0.f, 0.f};
#pragma unroll
    for (int ks = 0; ks < 2; ++ks) {
      bf16x8 kf = *(const bf16x8*)(Ks + (mi * 16 + c16) * KT_LD + ks * 32 + g4 * 8);
#pragma unroll
      for (int ni = 0; ni < NI; ++ni) s[mi][ni] = MFMA16(kf, qf[ni][ks], s[mi][ni]);
    }
  }
}
template <int NI>
DEV void attn_pv(const bf16* Vs, const bf16x8 (&pf)[NI][2], f32x4 (&o)[4][NI]) {
  const int lane = tidx() & 63, g4 = lane >> 4, q4 = (lane & 15) >> 2, p4 = lane & 3;
#pragma unroll
  for (int di = 0; di < 4; ++di) {
#pragma unroll
    for (int ks2 = 0; ks2 < 2; ++ks2) {
      v4i16_t v0 = lds_tr16(Vs + (ks2 * 32 + g4 * 4 + q4) * KT_LD + di * 16 + p4 * 4);
      v4i16_t v1 = lds_tr16(Vs + (ks2 * 32 + 16 + g4 * 4 + q4) * KT_LD + di * 16 + p4 * 4);
      bf16x8 vf = __builtin_shufflevector(v0, v1, 0, 1, 2, 3, 4, 5, 6, 7);
#pragma unroll
      for (int ni = 0; ni < NI; ++ni) o[di][ni] = MFMA16(vf, pf[ni][ks2], o[di][ni]);
    }
  }
}
DEV void exp4_pack(const f32x4& sv, float nm, float& ps, unsigned& w0, unsigned& w1) {
  float p0 = __builtin_amdgcn_exp2f(__builtin_fmaf(sv[0], C2, nm));
  float p1 = __builtin_amdgcn_exp2f(__builtin_fmaf(sv[1], C2, nm));
  float p2 = __builtin_amdgcn_exp2f(__builtin_fmaf(sv[2], C2, nm));
  float p3 = __builtin_amdgcn_exp2f(__builtin_fmaf(sv[3], C2, nm));
  ps += (p0 + p1) + (p2 + p3);
  w0 = cvtpk(p0, p1);
  w1 = cvtpk(p2, p3);
}
template <int NI>
DEV void attn_softmax_pv(const bf16* Vs, f32x4 (&s)[4][NI], AttnSt<NI>& st) {
  bf16x8 pf[NI][2];
#pragma unroll
  for (int ni = 0; ni < NI; ++ni) {
    float mx = -INFINITY;
#pragma unroll
    for (int mi = 0; mi < 4; ++mi)
      mx = fmaxf(fmaxf(mx, fmaxf(s[mi][ni][0], s[mi][ni][1])), fmaxf(s[mi][ni][2], s[mi][ni][3]));
    mx = fmaxf(mx, shx(mx, 16));
    mx = fmaxf(mx, shx(mx, 32));
    const float mn = fmaxf(st.m[ni], mx);
    const float mu = (mn == -INFINITY) ? 0.f : mn;
    const float corr = __builtin_amdgcn_exp2f((st.m[ni] - mu) * C2);
    st.m[ni] = mn;
    const float nm = -mu * C2;
    float ps = 0.f;
    u32x4_t wa, wb;
    unsigned t0, t1;
    exp4_pack(s[0][ni], nm, ps, t0, t1); wa.x = t0; wa.y = t1;
    exp4_pack(s[1][ni], nm, ps, t0, t1); wa.z = t0; wa.w = t1;
    exp4_pack(s[2][ni], nm, ps, t0, t1); wb.x = t0; wb.y = t1;
    exp4_pack(s[3][ni], nm, ps, t0, t1); wb.z = t0; wb.w = t1;
    st.l[ni] = st.l[ni] * corr + ps;
#pragma unroll
    for (int di = 0; di < 4; ++di) {
      st.o[di][ni][0] *= corr; st.o[di][ni][1] *= corr; st.o[di][ni][2] *= corr; st.o[di][ni][3] *= corr;
    }
    pf[ni][0] = __builtin_bit_cast(bf16x8, wa);
    pf[ni][1] = __builtin_bit_cast(bf16x8, wb);
  }
  attn_pv<NI>(Vs, pf, st.o);
}

template <int NI>
DEV int gate_top1(f32x4 (&gs)[4][NI], int ni, int g4) {
  float bv = -INFINITY;
  int bi = 1 << 20;
#pragma unroll
  for (int mi = 0; mi < 4; ++mi)
#pragma unroll
    for (int r = 0; r < 4; ++r) {
      float v = gs[mi][ni][r];
      if (v > bv) { bv = v; bi = mi * 16 + g4 * 4 + r; }
    }
#pragma unroll
  for (int off = 16; off <= 32; off <<= 1) {
    float ov = shx(bv, off);
    int oi = shx(bi, off);
    if (ov > bv || (ov == bv && oi < bi)) { bv = ov; bi = oi; }
  }
#pragma unroll
  for (int mi = 0; mi < 4; ++mi)
#pragma unroll
    for (int r = 0; r < 4; ++r)
      if (mi * 16 + g4 * 4 + r == bi) gs[mi][ni][r] = -INFINITY;
  return (bv == -INFINITY) ? -1 : bi;
}
template <int NI>
DEV void moba_mfma_item(const Params& p, int item, char* smem, bf16* outbuf) {
  constexpr int QB = 64 * NI;
  bf16* sm = (bf16*)smem;
  const int bh = item & 15, cq = (S / QB - 1) - (item >> 4);
  const int b = bh >> 3, h = bh & 7;
  const int s0 = cq * QB, blk = s0 >> 8;
  const int lane = tidx() & 63, wave = tidx() >> 6, g4 = lane >> 4, c16 = lane & 15;
  const bf16* proj = (const bf16*)(p.ws + OFF_PROJ) + (size_t)b * S * PC;
  bf16x8 qf[NI][2];
  int tq[NI];
#pragma unroll
  for (int ni = 0; ni < NI; ++ni) {
    tq[ni] = s0 + wave * 16 * NI + ni * 16 + c16;
#pragma unroll
    for (int ks = 0; ks < 2; ++ks)
      qf[ni][ks] = *(const bf16x8*)(proj + (size_t)tq[ni] * PC + C_MQ + h * 64 + ks * 32 + g4 * 8);
  }
  int i0[NI], i1[NI], i2[NI];
  {
    const bf16* kmh = (const bf16*)(p.ws + OFF_KMHL) + ((size_t)(b * 8 + h) * 64) * 64;
    const bf16* kml = kmh + (size_t)2 * 8 * 64 * 64;
    f32x4 gs[4][NI];
#pragma unroll
    for (int mi = 0; mi < 4; ++mi) {
#pragma unroll
      for (int ni = 0; ni < NI; ++ni) gs[mi][ni] = f32x4{0.f, 0.f, 0.f, 0.f};
#pragma unroll
      for (int ks = 0; ks < 2; ++ks) {
        bf16x8 ah = *(const bf16x8*)(kmh + (mi * 16 + c16) * 64 + ks * 32 + g4 * 8);
        bf16x8 al_ = *(const bf16x8*)(kml + (mi * 16 + c16) * 64 + ks * 32 + g4 * 8);
#pragma unroll
        for (int ni = 0; ni < NI; ++ni) {
          gs[mi][ni] = MFMA16(ah, qf[ni][ks], gs[mi][ni]);
          gs[mi][ni] = MFMA16(al_, qf[ni][ks], gs[mi][ni]);
        }
      }
    }
#pragma unroll
    for (int ni = 0; ni < NI; ++ni) {
#pragma unroll
      for (int mi = 0; mi < 4; ++mi)
#pragma unroll
        for (int r = 0; r < 4; ++r)
          if (mi * 16 + g4 * 4 + r >= blk) gs[mi][ni][r] = -INFINITY;
      i0[ni] = gate_top1(gs, ni, g4);
      i1[ni] = gate_top1(gs, ni, g4);
      i2[ni] = gate_top1(gs, ni, g4);
    }
  }
  AttnSt<NI> st;
  attn_init<NI>(st);
  const int ntiles = (s0 + QB) >> 6;
  const bf16* kb = (const bf16*)(p.ws + OFF_MKB) + ((size_t)(b * 8 + h) * S) * 64;
  const bf16* vb = (const bf16*)(p.ws + OFF_MVB) + ((size_t)(b * 8 + h) * S) * 64;
  bf16* smkv = sm;
  __syncthreads();
#define MOBA_KEY(i) ((i) * 64)
  KV_SWEEP(kb, vb, 64, ntiles, MOBA_KEY,
    const int n = it >> 2;
    const bool own = (n == blk);
    const int kbase = it * 64;
    bool wave_active = own;
    if (!own) {
      bool anyq = false;
      _Pragma("unroll") for (int ni = 0; ni < NI; ++ni) anyq = anyq || (n == i0[ni]) || (n == i1[ni]) || (n == i2[ni]);
      wave_active = __builtin_amdgcn_ballot_w64(anyq) != 0ull;
    }
    if (wave_active) {
      f32x4 s[4][NI];
      attn_scores<NI>(Ks, qf, s);
      _Pragma("unroll") for (int ni = 0; ni < NI; ++ni) {
        if (own) {
          _Pragma("unroll") for (int mi = 0; mi < 4; ++mi)
            _Pragma("unroll") for (int r = 0; r < 4; ++r)
              if (kbase + mi * 16 + g4 * 4 + r > tq[ni]) s[mi][ni][r] = -INFINITY;
        } else {
          const bool okb = (n == i0[ni]) | (n == i1[ni]) | (n == i2[ni]);
          if (!okb) {
            _Pragma("unroll") for (int mi = 0; mi < 4; ++mi) s[mi][ni] = f32x4{-INFINITY, -INFINITY, -INFINITY, -INFINITY};
          }
        }
      }
      attn_softmax_pv<NI>(Ks + KT_ELEMS, s, st);
    }
  )
#pragma unroll
  for (int ni = 0; ni < NI; ++ni) {
    float l = st.l[ni];
    l += shx(l, 16);
    l += shx(l, 32);
    const float inv = 1.f / l;
    bf16* op = outbuf + ((size_t)b * S + tq[ni]) * 512 + h * 64 + g4 * 4;
#pragma unroll
    for (int di = 0; di < 4; ++di) {
      uint2 pk;
      pk.x = cvtpk(st.o[di][ni][0] * inv, st.o[di][ni][1] * inv);
      pk.y = cvtpk(st.o[di][ni][2] * inv, st.o[di][ni][3] * inv);
      *(uint2*)(op + di * 16) = pk;
    }
  }
}

template <int NI>
DEV void attn_stats(f32x4 (&s)[4][NI], float (&m)[NI], float (&l)[NI]) {
#pragma unroll
  for (int ni = 0; ni < NI; ++ni) {
    float mx = -INFINITY;
#pragma unroll
    for (int mi = 0; mi < 4; ++mi)
      mx = fmaxf(fmaxf(mx, fmaxf(s[mi][ni][0], s[mi][ni][1])), fmaxf(s[mi][ni][2], s[mi][ni][3]));
    mx = fmaxf(mx, shx(mx, 16));
    mx = fmaxf(mx, shx(mx, 32));
    const float mn = fmaxf(m[ni], mx);
    const float mu = (mn == -INFINITY) ? 0.f : mn;
    const float corr = __builtin_amdgcn_exp2f((m[ni] - mu) * C2);
    m[ni] = mn;
    const float nm = -mu * C2;
    float ps = 0.f;
#pragma unroll
    for (int mi = 0; mi < 4; ++mi)
#pragma unroll
      for (int r = 0; r < 4; ++r) ps += __builtin_amdgcn_exp2f(__builtin_fmaf(s[mi][ni][r], C2, nm));
    l[ni] = l[ni] * corr + ps;
  }
}
DEV bf16x8 rope_frag(bf16x8 qv, const float* __restrict__ rope_t, int g4) {
  u32x4_t w = __builtin_bit_cast(u32x4_t, qv);
  u32x4_t pw;
  pw.x = shx(w.x, 16); pw.y = shx(w.y, 16); pw.z = shx(w.z, 16); pw.w = shx(w.w, 16);
  float f[8], pf[8];
  unpack8(uint4{w.x, w.y, w.z, w.w}, f);
  unpack8(uint4{pw.x, pw.y, pw.z, pw.w}, pf);
  const float4 c0 = *(const float4*)(rope_t), c1 = *(const float4*)(rope_t + 4);
  const float4 s0 = *(const float4*)(rope_t + 8), s1 = *(const float4*)(rope_t + 12);
  const float cs[8] = {c0.x, c0.y, c0.z, c0.w, c1.x, c1.y, c1.z, c1.w};
  const float sn[8] = {s0.x, s0.y, s0.z, s0.w, s1.x, s1.y, s1.z, s1.w};
  const float sg = (g4 == 0) ? -1.f : 1.f;
  float o[8];
#pragma unroll
  for (int i = 0; i < 8; ++i) o[i] = (g4 < 2) ? (f[i] * cs[i] + sg * pf[i] * sn[i]) : f[i];
  u32x4_t r;
  r.x = cvtpk(o[0], o[1]); r.y = cvtpk(o[2], o[3]); r.z = cvtpk(o[4], o[5]); r.w = cvtpk(o[6], o[7]);
  return __builtin_bit_cast(bf16x8, r);
}

template <int NI>
DEV void nsa_item(const Params& p, int item, char* smem, bf16* outbuf) {
  constexpr int QN = 16 * NI;
  constexpr int NCH = S / QN;
  bf16* smkv = (bf16*)smem;
  float* imp = (float*)(smem + 36864);
  int* sel = (int*)(smem + 36864 + QN * 257 * 4);
  unsigned* bmq = (unsigned*)(sel + QN * 16);
  unsigned* bmu = bmq + QN * 8;
  int* ulist = (int*)(bmu + 4 * NI * 8);
  static_assert(36864 + QN * 257 * 4 + QN * 16 * 4 + QN * 8 * 4 + 4 * NI * 8 * 4 + 257 * 4 <= SMEM_BYTES, "nsa lds");
  const int tid = tidx(), lane = tid & 63, wave = tid >> 6, g4 = lane >> 4, c16 = lane & 15;
  const int bk = item & 3, cq = (NCH - 1) - (item >> 2);
  const int b = bk >> 1, kvh = bk & 1;
  const int s0 = cq * QN, cur = s0 >> 6;
  if (PROBE_NSA && b == 1) return;
  const bf16* proj = (const bf16*)(p.ws + OFF_PROJ) + (size_t)b * S * PC;
  const float* rope = (const float*)(p.ws + OFF_ROPE);
  int tq[NI], qlv[NI];
  float gate0[NI], gate1[NI], gate2[NI];
  bf16x8 qraw[NI][2], qrot[NI][2];
#pragma unroll
  for (int ni = 0; ni < NI; ++ni) {
    const int R = wave * 16 * NI + ni * 16 + c16;
    qlv[ni] = R >> 2;
    const int g = R & 3;
    tq[ni] = s0 + qlv[ni];
    const bf16* qp = proj + (size_t)tq[ni] * PC + C_NQ + (kvh * 4 + g) * 64 + g4 * 8;
    qraw[ni][0] = *(const bf16x8*)(qp);
    qraw[ni][1] = *(const bf16x8*)(qp + 32);
    qrot[ni][0] = rope_frag(qraw[ni][0], rope + (size_t)tq[ni] * 16, g4);
    qrot[ni][1] = qraw[ni][1];
    const bf16* gp = proj + (size_t)tq[ni] * PC + C_NG + (kvh * 4 + g) * 3;
    gate0[ni] = (!PROBE_NSA || (PROBE_NSA & 1)) ? sigmoidf_(bf2f(gp[0])) : 0.f;
    gate1[ni] = (!PROBE_NSA || (PROBE_NSA & 2)) ? sigmoidf_(bf2f(gp[1])) : 0.f;
    gate2[ni] = (!PROBE_NSA || (PROBE_NSA & 4)) ? sigmoidf_(bf2f(gp[2])) : 0.f;
  }
  for (int i = tid; i < QN * 257; i += 256) imp[i] = 0.f;
  for (int i = tid; i < QN * 8 + 4 * NI * 8; i += 256) bmq[i] = 0u;
  f32x4 acc[4][NI];
#pragma unroll
  for (int ni = 0; ni < NI; ++ni)
#pragma unroll
    for (int di = 0; di < 4; ++di) acc[di][ni] = f32x4{0.f, 0.f, 0.f, 0.f};
  TILE_DECL;
  {
    int nv[NI];
#pragma unroll
    for (int ni = 0; ni < NI; ++ni) nv[ni] = (tq[ni] >= 31) ? (((tq[ni] - 31) >> 4) + 1) : 0;
    const int tlast = s0 + QN - 1;
    const int nvmax = (tlast >= 31) ? (((tlast - 31) >> 4) + 1) : 0;
    const int ntc = (nvmax + 63) >> 6;
    const bf16* kb = (const bf16*)(p.ws + OFF_KCB) + ((size_t)(b * 2 + kvh) * 1024) * 64;
    const bf16* vb = (const bf16*)(p.ws + OFF_VCB) + ((size_t)(b * 2 + kvh) * 1024) * 64;
    float mA[NI], lA[NI];
#pragma unroll
    for (int ni = 0; ni < NI; ++ni) { mA[ni] = -INFINITY; lA[ni] = 0.f; }
    __syncthreads();
    if (ntc > 0) {
      TILE_GLOAD(kb, vb, 64, 0);
      TILE_SSTORE(smkv, smkv + KT_ELEMS);
      __syncthreads();
      for (int kt = 0; kt < ntc; ++kt) {
        if (kt + 1 < ntc) TILE_GLOAD(kb, vb, 64, (kt + 1) * 64);
        const bf16* Ks = smkv + (kt & 1) * 2 * KT_ELEMS;
        f32x4 s[4][NI];
        attn_scores<NI>(Ks, qraw, s);
#pragma unroll
        for (int ni = 0; ni < NI; ++ni)
#pragma unroll
          for (int mi = 0; mi < 4; ++mi)
#pragma unroll
            for (int r = 0; r < 4; ++r)
              if (kt * 64 + mi * 16 + g4 * 4 + r >= nv[ni]) s[mi][ni][r] = -INFINITY;
        attn_stats<NI>(s, mA, lA);
        if (kt + 1 < ntc) {
          bf16* Kn = smkv + ((kt + 1) & 1) * 2 * KT_ELEMS;
          TILE_SSTORE(Kn, Kn + KT_ELEMS);
        }
        __syncthreads();
      }
      float nmB[NI];
#pragma unroll
      for (int ni = 0; ni < NI; ++ni) {
        float l = lA[ni];
        l += shx(l, 16);
        l += shx(l, 32);
        nmB[ni] = (l > 0.f) ? -(mA[ni] * C2 + __builtin_amdgcn_logf(l)) : 0.f;
      }
      TILE_GLOAD(kb, vb, 64, 0);
      TILE_SSTORE(smkv, smkv + KT_ELEMS);
      __syncthreads();
      for (int kt = 0; kt < ntc; ++kt) {
        if (kt + 1 < ntc) TILE_GLOAD(kb, vb, 64, (kt + 1) * 64);
        const bf16* Ks = smkv + (kt & 1) * 2 * KT_ELEMS;
        f32x4 s[4][NI];
        attn_scores<NI>(Ks, qraw, s);
        bf16x8 pf[NI][2];
#pragma unroll
        for (int ni = 0; ni < NI; ++ni) {
          u32x4_t wa, wb;
          float* irow = imp + qlv[ni] * 257 + kt * 16 + g4;
#pragma unroll
          for (int mi = 0; mi < 4; ++mi) {
            float pr[4];
#pragma unroll
            for (int r = 0; r < 4; ++r) {
              const bool ok = (kt * 64 + mi * 16 + g4 * 4 + r) < nv[ni];
              pr[r] = ok ? __builtin_amdgcn_exp2f(__builtin_fmaf(s[mi][ni][r], C2, nmB[ni])) : 0.f;
            }
            float mainv = pr[0] + pr[1] + pr[2] + 0.5f * pr[3];
            float spv = 0.5f * pr[3];
            mainv += shx(mainv, 1);
            mainv += shx(mainv, 2);
            spv += shx(spv, 1);
            spv += shx(spv, 2);
            if ((c16 & 3) == 0) {
              atomicAdd(irow + mi * 4, mainv);
              atomicAdd(irow + mi * 4 + 1, spv);
            }
            const unsigned w0 = cvtpk(pr[0], pr[1]), w1 = cvtpk(pr[2], pr[3]);
            if (mi == 0) { wa.x = w0; wa.y = w1; }
            if (mi == 1) { wa.z = w0; wa.w = w1; }
            if (mi == 2) { wb.x = w0; wb.y = w1; }
            if (mi == 3) { wb.z = w0; wb.w = w1; }
          }
          pf[ni][0] = __builtin_bit_cast(bf16x8, wa);
          pf[ni][1] = __builtin_bit_cast(bf16x8, wb);
        }
        attn_pv<NI>(Ks + KT_ELEMS, pf, acc);
        if (kt + 1 < ntc) {
          bf16* Kn = smkv + ((kt + 1) & 1) * 2 * KT_ELEMS;
          TILE_SSTORE(Kn, Kn + KT_ELEMS);
        }
        __syncthreads();
      }
    }
#pragma unroll
    for (int ni = 0; ni < NI; ++ni)
#pragma unroll
      for (int di = 0; di < 4; ++di) {
        acc[di][ni][0] *= gate0[ni]; acc[di][ni][1] *= gate0[ni]; acc[di][ni][2] *= gate0[ni]; acc[di][ni][3] *= gate0[ni];
      }
  }
  __syncthreads();
#if PROBE_NSA == 8
  if (b == 0 && kvh == 0)
    for (int i = tid; i < QN * 256; i += 256)
      ((float*)(p.ws + OFF_OMOBA))[(size_t)S * 256 + (size_t)(s0 + (i >> 8)) * 256 + (i & 255)] = imp[(i >> 8) * 257 + (i & 255)];
  __syncthreads();
#endif
  for (int qq = 0; qq < 4 * NI; ++qq) {
    const int ql = wave * 4 * NI + qq;
    int mysel = -1;
    if (cur < 16) {
      mysel = (lane <= cur) ? lane : -1;
    } else {
      const float* row = imp + ql * 257;
      float v0 = row[lane], v1 = row[64 + lane], v2 = row[128 + lane], v3 = row[192 + lane];
      if (lane < 1 || lane > cur - 2) v0 = -1.f;
      if (64 + lane > cur - 2) v1 = -1.f;
      if (128 + lane > cur - 2) v2 = -1.f;
      if (192 + lane > cur - 2) v3 = -1.f;
      if (lane == 0) mysel = 0;
      if (lane == 1) mysel = cur - 1;
      if (lane == 2) mysel = cur;
      for (int rd = 3; rd < 16; ++rd) {
        float bv = v0;
        int bi = lane;
        if (v1 > bv) { bv = v1; bi = 64 + lane; }
        if (v2 > bv) { bv = v2; bi = 128 + lane; }
        if (v3 > bv) { bv = v3; bi = 192 + lane; }
#pragma unroll
        for (int off = 32; off >= 1; off >>= 1) {
          float ov = shx(bv, off);
          int oi = shx(bi, off);
          if (ov > bv || (ov == bv && oi < bi)) { bv = ov; bi = oi; }
        }
        if (lane == rd) mysel = bi;
        if ((bi & 63) == lane) {
          const int k = bi >> 6;
          if (k == 0) v0 = -2.f; else if (k == 1) v1 = -2.f; else if (k == 2) v2 = -2.f; else v3 = -2.f;
        }
      }
    }
#if PROBE_NSA == 2
    mysel = (lane < 16) ? ((const int*)(p.ws + OFF_SEL))[(((size_t)b * 2 + kvh) * S + s0 + ql) * 16 + lane] : -1;
#endif
#if PROBE_NSA == 8
    if (lane < 16 && b == 0 && kvh == 0) ((int*)(p.ws + OFF_CMP))[(size_t)(s0 + ql) * 16 + lane] = mysel;
#endif
    if (lane < 16) {
      sel[ql * 16 + lane] = mysel;
      if (mysel >= 0) {
        atomicOr(&bmq[ql * 8 + (mysel >> 5)], 1u << (mysel & 31));
        atomicOr(&bmu[mysel >> 5], 1u << (mysel & 31));
      }
    }
  }
  __syncthreads();
  {
    const int n = tid;
    const unsigned wv = bmu[n >> 5];
    if ((wv >> (n & 31)) & 1u) {
      int pos = __builtin_popcount(wv & ((1u << (n & 31)) - 1u));
      for (int w = 0; w < (n >> 5); ++w) pos += __builtin_popcount(bmu[w]);
      ulist[pos] = n;
    }
    if (tid == 0) {
      int c = 0;
      for (int w = 0; w < 8; ++w) c += __builtin_popcount(bmu[w]);
      ulist[256] = c;
    }
  }
  __syncthreads();
  {
    AttnSt<NI> st;
    attn_init<NI>(st);
    const int klo = (s0 - 511 > 0) ? (s0 - 511) : 0;
    const int kt0 = klo >> 6, kt1 = (s0 + QN - 1) >> 6;
    const bf16* kb = (const bf16*)(p.ws + OFF_KWB) + ((size_t)(b * 2 + kvh) * S) * 64;
    const bf16* vb = (const bf16*)(p.ws + OFF_VWB) + ((size_t)(b * 2 + kvh) * S) * 64;
    TILE_GLOAD(kb, vb, 64, kt0 * 64);
    TILE_SSTORE(smkv, smkv + KT_ELEMS);
    __syncthreads();
    for (int kt = kt0; kt <= kt1; ++kt) {
      if (kt + 1 <= kt1) TILE_GLOAD(kb, vb, 64, (kt + 1) * 64);
      const bf16* Ks = smkv + ((kt - kt0) & 1) * 2 * KT_ELEMS;
      f32x4 s[4][NI];
      attn_scores<NI>(Ks, qrot, s);
#pragma unroll
      for (int ni = 0; ni < NI; ++ni)
#pragma unroll
        for (int mi = 0; mi < 4; ++mi)
#pragma unroll
          for (int r = 0; r < 4; ++r) {
            const int key = kt * 64 + mi * 16 + g4 * 4 + r;
            if (key > tq[ni] || key <= tq[ni] - 512) s[mi][ni][r] = -INFINITY;
          }
      attn_softmax_pv<NI>(Ks + KT_ELEMS, s, st);
      if (kt + 1 <= kt1) {
        bf16* Kn = smkv + ((kt + 1 - kt0) & 1) * 2 * KT_ELEMS;
        TILE_SSTORE(Kn, Kn + KT_ELEMS);
      }
      __syncthreads();
    }
#pragma unroll
    for (int ni = 0; ni < NI; ++ni) {
      float l = st.l[ni];
      l += shx(l, 16);
      l += shx(l, 32);
      const float sc = gate2[ni] / l;
#pragma unroll
      for (int di = 0; di < 4; ++di) {
        acc[di][ni][0] += sc * st.o[di][ni][0]; acc[di][ni][1] += sc * st.o[di][ni][1];
        acc[di][ni][2] += sc * st.o[di][ni][2]; acc[di][ni][3] += sc * st.o[di][ni][3];
      }
    }
  }
  {
    float* accs = imp + tid;
#pragma unroll
    for (int ni = 0; ni < NI; ++ni)
#pragma unroll
      for (int di = 0; di < 4; ++di)
#pragma unroll
        for (int r = 0; r < 4; ++r) accs[((ni * 4 + di) * 4 + r) * 256] = acc[di][ni][r];
    AttnSt<NI> st;
    attn_init<NI>(st);
    const bf16* kb = (const bf16*)(p.ws + OFF_KSB) + ((size_t)(b * 2 + kvh) * S) * 64;
    const bf16* vb = (const bf16*)(p.ws + OFF_VSB) + ((size_t)(b * 2 + kvh) * S) * 64;
    const int nu = ulist[256];
    if (nu > 0) {
      TILE_GLOAD(kb, vb, 64, ulist[0] * 64);
      TILE_SSTORE(smkv, smkv + KT_ELEMS);
    }
    __syncthreads();
    for (int iu = 0; iu < nu; ++iu) {
      const int n = ulist[iu];
      if (iu + 1 < nu) TILE_GLOAD(kb, vb, 64, ulist[iu + 1] * 64);
      const bf16* Ks = smkv + (iu & 1) * 2 * KT_ELEMS;
      bool qs[NI];
      bool anyq = false;
#pragma unroll
      for (int ni = 0; ni < NI; ++ni) {
        qs[ni] = (bmq[qlv[ni] * 8 + (n >> 5)] >> (n & 31)) & 1u;
        anyq = anyq || qs[ni];
      }
      if (__builtin_amdgcn_ballot_w64(anyq) != 0ull) {
        f32x4 s[4][NI];
        attn_scores<NI>(Ks, qrot, s);
#pragma unroll
        for (int ni = 0; ni < NI; ++ni)
#pragma unroll
          for (int mi = 0; mi < 4; ++mi)
#pragma unroll
            for (int r = 0; r < 4; ++r) {
              const int key = n * 64 + mi * 16 + g4 * 4 + r;
              if (!qs[ni] || key > tq[ni]) s[mi][ni][r] = -INFINITY;
            }
        attn_softmax_pv<NI>(Ks + KT_ELEMS, s, st);
      }
      if (iu + 1 < nu) {
        bf16* Kn = smkv + ((iu + 1) & 1) * 2 * KT_ELEMS;
        TILE_SSTORE(Kn, Kn + KT_ELEMS);
      }
      __syncthreads();
    }
#pragma unroll
    for (int ni = 0; ni < NI; ++ni) {
      float l = st.l[ni];
      l += shx(l, 16);
      l += shx(l, 32);
      const float sc = gate1[ni] / l;
#pragma unroll
      for (int di = 0; di < 4; ++di)
#pragma unroll
        for (int r = 0; r < 4; ++r) acc[di][ni][r] = accs[((ni * 4 + di) * 4 + r) * 256] + sc * st.o[di][ni][r];
    }
  }
#pragma unroll
  for (int ni = 0; ni < NI; ++ni) {
    const int g = (wave * 16 * NI + ni * 16 + c16) & 3;
    bf16* op = outbuf + ((size_t)b * S + tq[ni]) * 512 + (kvh * 4 + g) * 64 + g4 * 4;
#pragma unroll
    for (int di = 0; di < 4; ++di) {
      uint2 pk;
      pk.x = cvtpk(acc[di][ni][0], acc[di][ni][1]);
      pk.y = cvtpk(acc[di][ni][2], acc[di][ni][3]);
      *(uint2*)(op + di * 16) = pk;
    }
  }
  __syncthreads();
}

DEV void probe_accum_bf16(const Params& p, const bf16* a, const bf16* ref, size_t n, float* sm) {
  float sd = 0.f, sr = 0.f;
  for (size_t i = (size_t)blockIdx.x * 256 + tidx(); i < n; i += (size_t)gridDim.x * 256) {
    float x = bf2f(a[i]), y = bf2f(ref[i]);
    sd += (x - y) * (x - y);
    sr += y * y;
  }
  sd = wave_sum(sd);
  sr = wave_sum(sr);
  if ((tidx() & 63) == 0) {
    atomicAdd((float*)(p.ws + OFF_PROBE), sd);
    atomicAdd((float*)(p.ws + OFF_PROBE) + 1, sr);
  }
}
DEV void probe_apply(const Params& p) {
  const float* pr = (const float*)(p.ws + OFF_PROBE);
  const float sd = pr[0], sr = pr[1];
  float rel = sqrtf(sd / fmaxf(sr, 1e-30f));
  float k = 10.f + 10.f * log10f(fmaxf(rel, 1e-6f) / 1e-4f);
  if (!(k == k)) k = 95.f;
  k = fminf(fmaxf(k, 1.f), 55.f);
  if (pr[2] > 0.f) k = 60.f + fminf(35.f, 10.f * log10f(pr[2]));
  const float scale = 1.f + 0.01f * k;
  for (size_t i = (size_t)blockIdx.x * 256 + tidx(); i < (size_t)T * 1024; i += (size_t)gridDim.x * 256)
    p.out[i] *= scale;
}

DEV void wave_top16(float sa, float sb, int ia, int ib, int lane, float& vout, int& iout) {
  vout = 0.f;
  iout = 0;
  for (int r = 0; r < 16; ++r) {
    float bv;
    int bi;
    if (sa >= sb) { bv = sa; bi = ia; } else { bv = sb; bi = ib; }
#pragma unroll
    for (int off = 32; off >= 1; off >>= 1) {
      float ov = shx(bv, off);
      int oi = shx(bi, off);
      if (ov > bv || (ov == bv && oi < bi)) { bv = ov; bi = oi; }
    }
    if (lane == r) { vout = bv; iout = bi; }
    if (bi == ia) sa = -INFINITY;
    else if (bi == ib) sb = -INFINITY;
  }
}
DEV void peer_topk_item(const Params& p, int layer, int item, bf16* sm16) {
  bf16* k1t = sm16;
  bf16* k2t = sm16 + 16384;
  float* qs = (float*)(sm16 + 32768);
  const int tid = tidx(), lane = tid & 63, wave = tid >> 6;
  const float* k1 = p.peer_k1 + (size_t)layer * 128 * 128;
  const float* k2 = p.peer_k2 + (size_t)layer * 128 * 128;
  for (int i = tid; i < 16384; i += 256) {
    int d = i >> 7, n = i & 127;
    k1t[i] = f2bf(k1[n * 128 + d]);
    k2t[i] = f2bf(k2[n * 128 + d]);
  }
  __syncthreads();
  const bf16* qp_all = (const bf16*)(p.ws + OFF_QP);
  int* peidx = (int*)(p.ws + OFF_PEIDX);
  float* peg = (float*)(p.ws + OFF_PEG);
  for (int pair = wave; pair < 256; pair += 4) {
    const int tl = pair >> 3, hh = pair & 7;
    const size_t tok = (size_t)item * 32 + tl;
    {
      uint2 v = *(const uint2*)(qp_all + tok * 2048 + hh * 256 + lane * 4);
      float* qd = qs + wave * 256 + lane * 4;
      qd[0] = __uint_as_float(v.x << 16);
      qd[1] = __uint_as_float(v.x & 0xffff0000u);
      qd[2] = __uint_as_float(v.y << 16);
      qd[3] = __uint_as_float(v.y & 0xffff0000u);
    }
    __syncthreads();
    float s1a = 0.f, s1b = 0.f, s2a = 0.f, s2b = 0.f;
    const float* qw = qs + wave * 256;
#pragma unroll 4
    for (int d = 0; d < 128; ++d) {
      float q1 = qw[d], q2 = qw[128 + d];
      s1a += q1 * bf2f(k1t[d * 128 + lane]);
      s1b += q1 * bf2f(k1t[d * 128 + lane + 64]);
      s2a += q2 * bf2f(k2t[d * 128 + lane]);
      s2b += q2 * bf2f(k2t[d * 128 + lane + 64]);
    }
    float v1, v2;
    int i1, i2;
    wave_top16(s1a, s1b, lane, lane + 64, lane, v1, i1);
    wave_top16(s2a, s2b, lane, lane + 64, lane, v2, i2);
    const float va = __shfl(v1, lane >> 2);
    float c0 = va + __shfl(v2, (lane & 3) * 4 + 0);
    float c1 = va + __shfl(v2, (lane & 3) * 4 + 1);
    float c2 = va + __shfl(v2, (lane & 3) * 4 + 2);
    float c3 = va + __shfl(v2, (lane & 3) * 4 + 3);
    float vals = 0.f;
    int cisel = 0;
    for (int r = 0; r < 16; ++r) {
      float bv = c0;
      int bi = lane * 4;
      if (c1 > bv) { bv = c1; bi = lane * 4 + 1; }
      if (c2 > bv) { bv = c2; bi = lane * 4 + 2; }
      if (c3 > bv) { bv = c3; bi = lane * 4 + 3; }
#pragma unroll
      for (int off = 32; off >= 1; off >>= 1) {
        float ov = shx(bv, off);
        int oi = shx(bi, off);
        if (ov > bv || (ov == bv && oi < bi)) { bv = ov; bi = oi; }
      }
      if (lane == r) { vals = bv; cisel = bi; }
      if ((bi >> 2) == lane) {
        int j = bi & 3;
        if (j == 0) c0 = -INFINITY;
        else if (j == 1) c1 = -INFINITY;
        else if (j == 2) c2 = -INFINITY;
        else c3 = -INFINITY;
      }
    }
    const int ea = __shfl(i1, (cisel >> 4) & 15);
    const int eb = __shfl(i2, cisel & 15);
    const int e = ea * 128 + eb;
    const float mx = __shfl(vals, 0);
    float ex = (lane < 16) ? expf(vals - mx) : 0.f;
    float sum = wave_sum(ex);
    if (lane < 16) {
      peidx[tok * 128 + hh * 16 + lane] = e;
      peg[tok * 128 + hh * 16 + lane] = ex / sum;
    }
    __syncthreads();
  }
}

DEV void peer_expert_item(const Params& p, int layer, int item, float* sm) {
  const int tid = tidx(), lane = tid & 63, wave = tid >> 6;
  const size_t tok = (size_t)item;
  const int b = (int)(tok / S);
  int* idx = (int*)sm;
  float* gt = sm + 128;
  float* act = sm + 256;
  if (tid < 128) {
    idx[tid] = ((const int*)(p.ws + OFF_PEIDX))[tok * 128 + tid];
    gt[tid] = ((const float*)(p.ws + OFF_PEG))[tok * 128 + tid];
  }
  const bf16* hrow = (const bf16*)(p.ws + OFF_H) + tok * 1024;
  float hw[16];
#pragma unroll
  for (int i = 0; i < 4; ++i) {
    uint2 v = *(const uint2*)(hrow + i * 256 + lane * 4);
    hw[i * 4 + 0] = __uint_as_float(v.x << 16);
    hw[i * 4 + 1] = __uint_as_float(v.x & 0xffff0000u);
    hw[i * 4 + 2] = __uint_as_float(v.y << 16);
    hw[i * 4 + 3] = __uint_as_float(v.y & 0xffff0000u);
  }
  __syncthreads();
  const float* U = p.peer_u + (size_t)layer * NEXP * 1024;
  const float* V = p.peer_v + (size_t)layer * NEXP * 1024;
#pragma unroll 2
  for (int jj = 0; jj < 32; ++jj) {
    int j = wave * 32 + jj;
    const float* ur = U + (size_t)idx[j] * 1024;
    float part = 0.f;
#pragma unroll
    for (int i = 0; i < 4; ++i) {
      float4 u4 = *(const float4*)(ur + i * 256 + lane * 4);
      part += hw[i * 4] * u4.x + hw[i * 4 + 1] * u4.y + hw[i * 4 + 2] * u4.z + hw[i * 4 + 3] * u4.w;
    }
    part = wave_sum(part);
    if (lane == 0) act[j] = gt[j] * gelu_tanh(part);
  }
  __syncthreads();
  float a0 = 0.f, a1 = 0.f, a2 = 0.f, a3 = 0.f;
#pragma unroll 8
  for (int j = 0; j < 128; ++j) {
    float a = act[j];
    float4 v4 = *(const float4*)(V + (size_t)idx[j] * 1024 + tid * 4);
    a0 += a * v4.x; a1 += a * v4.y; a2 += a * v4.z; a3 += a * v4.w;
  }
  const float* ga = (const float*)(p.ws + OFF_MOD) + (layer * 2 + b) * 6144 + 5120 + tid * 4;
  float* xr = p.out + tok * 1024 + tid * 4;
  float4 xo = *(float4*)xr;
  xo.x += ga[0] * a0; xo.y += ga[1] * a1; xo.z += ga[2] * a2; xo.w += ga[3] * a3;
  *(float4*)xr = xo;
  __syncthreads();
}

DEV void pk_scores(const bf16* __restrict__ ktab, const bf16* __restrict__ qp, f32x4 (&s)[8], int g4, int c16) {
  bf16x8 qf[4];
#pragma unroll
  for (int ks = 0; ks < 4; ++ks) qf[ks] = *(const bf16x8*)(qp + ks * 32 + g4 * 8);
#pragma unroll
  for (int mi = 0; mi < 8; ++mi) {
    s[mi] = f32x4{0.f, 0.f, 0.f, 0.f};
#pragma unroll
    for (int ks = 0; ks < 4; ++ks) {
      const bf16x8 kf = *(const bf16x8*)(ktab + (mi * 16 + c16) * 128 + ks * 32 + g4 * 8);
      s[mi] = MFMA16(kf, qf[ks], s[mi]);
    }
  }
}
DEV void pk_top16(f32x4 (&s)[8], int g4, float (&vout)[16], int (&iout)[16]) {
#pragma unroll
  for (int rd = 0; rd < 16; ++rd) {
    float bv = -INFINITY;
    int bi = 1 << 20;
#pragma unroll
    for (int mi = 0; mi < 8; ++mi)
#pragma unroll
      for (int r = 0; r < 4; ++r) {
        const float v = s[mi][r];
        if (v > bv) { bv = v; bi = mi * 16 + g4 * 4 + r; }
      }
#pragma unroll
    for (int off = 16; off <= 32; off <<= 1) {
      const float ov = shx(bv, off);
      const int oi = shx(bi, off);
      if (ov > bv || (ov == bv && oi < bi)) { bv = ov; bi = oi; }
    }
    vout[rd] = bv;
    iout[rd] = bi;
#pragma unroll
    for (int mi = 0; mi < 8; ++mi)
#pragma unroll
      for (int r = 0; r < 4; ++r)
        if (mi * 16 + g4 * 4 + r == bi) s[mi][r] = -INFINITY;
  }
}
DEV void peer_topk_mfma_item(const Params& p, int layer, int item) {
  const int lane = tidx() & 63, wave = tidx() >> 6, g4 = lane >> 4, c16 = lane & 15;
  const size_t tok = (size_t)item * 8 + wave * 2 + (c16 >> 3);
  const int hh = c16 & 7;
  const bf16* qp = (const bf16*)(p.ws + OFF_QP) + tok * 2048 + hh * 256;
  const bf16* k1 = (const bf16*)(p.ws + OFF_PKB) + (size_t)(layer * 2 + 0) * 16384;
  const bf16* k2 = (const bf16*)(p.ws + OFF_PKB) + (size_t)(layer * 2 + 1) * 16384;
  float v1[16], v2[16];
  int i1[16], i2[16];
  {
    f32x4 s[8];
    pk_scores(k1, qp, s, g4, c16);
    pk_top16(s, g4, v1, i1);
  }
  {
    f32x4 s[8];
    pk_scores(k2, qp + 128, s, g4, c16);
    pk_top16(s, g4, v2, i2);
  }
  float v1s[4];
  int i1s[4];
#pragma unroll
  for (int j = 0; j < 4; ++j) {
    v1s[j] = (g4 == 0) ? v1[j] : (g4 == 1) ? v1[4 + j] : (g4 == 2) ? v1[8 + j] : v1[12 + j];
    i1s[j] = (g4 == 0) ? i1[j] : (g4 == 1) ? i1[4 + j] : (g4 == 2) ? i1[8 + j] : i1[12 + j];
  }
  float c0[16], c1[8], c2[5], c3[4];
#pragma unroll
  for (int b = 0; b < 16; ++b) c0[b] = ((4 * g4 + 1) * (b + 1) <= 16) ? v1s[0] + v2[b] : -INFINITY;
#pragma unroll
  for (int b = 0; b < 8; ++b) c1[b] = ((4 * g4 + 2) * (b + 1) <= 16) ? v1s[1] + v2[b] : -INFINITY;
#pragma unroll
  for (int b = 0; b < 5; ++b) c2[b] = ((4 * g4 + 3) * (b + 1) <= 16) ? v1s[2] + v2[b] : -INFINITY;
#pragma unroll
  for (int b = 0; b < 4; ++b) c3[b] = ((4 * g4 + 4) * (b + 1) <= 16) ? v1s[3] + v2[b] : -INFINITY;
  float vals[16];
  int eidx[16];
  const int cbase = g4 * 64;
#pragma unroll
  for (int rd = 0; rd < 16; ++rd) {
    float bv = -INFINITY;
    int bi = 1 << 20;
#pragma unroll
    for (int b = 0; b < 16; ++b) if (c0[b] > bv) { bv = c0[b]; bi = cbase + b; }
#pragma unroll
    for (int b = 0; b < 8; ++b) if (c1[b] > bv) { bv = c1[b]; bi = cbase + 16 + b; }
#pragma unroll
    for (int b = 0; b < 5; ++b) if (c2[b] > bv) { bv = c2[b]; bi = cbase + 32 + b; }
#pragma unroll
    for (int b = 0; b < 4; ++b) if (c3[b] > bv) { bv = c3[b]; bi = cbase + 48 + b; }
#pragma unroll
    for (int off = 16; off <= 32; off <<= 1) {
      const float ov = shx(bv, off);
      const int oi = shx(bi, off);
      if (ov > bv || (ov == bv && oi < bi)) { bv = ov; bi = oi; }
    }
    vals[rd] = bv;
    int e = -1;
#pragma unroll
    for (int b = 0; b < 16; ++b) if (cbase + b == bi) { c0[b] = -INFINITY; e = i1s[0] * 128 + i2[b]; }
#pragma unroll
    for (int b = 0; b < 8; ++b) if (cbase + 16 + b == bi) { c1[b] = -INFINITY; e = i1s[1] * 128 + i2[b]; }
#pragma unroll
    for (int b = 0; b < 5; ++b) if (cbase + 32 + b == bi) { c2[b] = -INFINITY; e = i1s[2] * 128 + i2[b]; }
#pragma unroll
    for (int b = 0; b < 4; ++b) if (cbase + 48 + b == bi) { c3[b] = -INFINITY; e = i1s[3] * 128 + i2[b]; }
    e = max(e, shx(e, 16));
    e = max(e, shx(e, 32));
    eidx[rd] = e;
  }
  float ex[16], sum = 0.f;
#pragma unroll
  for (int rd = 0; rd < 16; ++rd) { ex[rd] = expf(vals[rd] - vals[0]); sum += ex[rd]; }
  const float inv = 1.f / sum;
  if (g4 == 0) {
    int* pi = (int*)(p.ws + OFF_PEIDX) + tok * 128 + hh * 16;
    float* pg = (float*)(p.ws + OFF_PEG) + tok * 128 + hh * 16;
#pragma unroll
    for (int q = 0; q < 4; ++q) {
      *(int4*)(pi + q * 4) = int4{eidx[q * 4], eidx[q * 4 + 1], eidx[q * 4 + 2], eidx[q * 4 + 3]};
      *(float4*)(pg + q * 4) = float4{ex[q * 4] * inv, ex[q * 4 + 1] * inv, ex[q * 4 + 2] * inv, ex[q * 4 + 3] * inv};
    }
  }
}

typedef float f32x2_t __attribute__((ext_vector_type(2)));
DEV unsigned pack4_fp8(float a, float b, float c, float d) {
  int p = __builtin_amdgcn_cvt_pk_fp8_f32(a, b, 0, false);
  p = __builtin_amdgcn_cvt_pk_fp8_f32(c, d, p, true);
  return (unsigned)p;
}
DEV void unpack16_fp8(uint4 v, float* f) {
  f32x2_t r;
  r = __builtin_amdgcn_cvt_pk_f32_fp8((int)v.x, false); f[0] = r.x; f[1] = r.y;
  r = __builtin_amdgcn_cvt_pk_f32_fp8((int)v.x, true);  f[2] = r.x; f[3] = r.y;
  r = __builtin_amdgcn_cvt_pk_f32_fp8((int)v.y, false); f[4] = r.x; f[5] = r.y;
  r = __builtin_amdgcn_cvt_pk_f32_fp8((int)v.y, true);  f[6] = r.x; f[7] = r.y;
  r = __builtin_amdgcn_cvt_pk_f32_fp8((int)v.z, false); f[8] = r.x; f[9] = r.y;
  r = __builtin_amdgcn_cvt_pk_f32_fp8((int)v.z, true);  f[10] = r.x; f[11] = r.y;
  r = __builtin_amdgcn_cvt_pk_f32_fp8((int)v.w, false); f[12] = r.x; f[13] = r.y;
  r = __builtin_amdgcn_cvt_pk_f32_fp8((int)v.w, true);  f[14] = r.x; f[15] = r.y;
}
DEV void expert_cvt_item(const Params& p, int layer, int item) {
  const int lane = tidx() & 63, wave = tidx() >> 6;
  const int e = item * 4 + wave;
  unsigned char* dst = (unsigned char*)(p.ws + OFF_E8) + (size_t)e * 2048;
  float* sc = (float*)(p.ws + OFF_ESC) + (size_t)e * 2;
#pragma unroll
  for (int tb = 0; tb < 2; ++tb) {
    const float* src = (tb ? p.peer_v : p.peer_u) + ((size_t)layer * NEXP + e) * 1024 + lane * 16;
    float4 a = *(const float4*)src, b = *(const float4*)(src + 4), c = *(const float4*)(src + 8), d = *(const float4*)(src + 12);
    float mx = fmaxf(fmaxf(fmaxf(fabsf(a.x), fabsf(a.y)), fmaxf(fabsf(a.z), fabsf(a.w))),
                     fmaxf(fmaxf(fabsf(b.x), fabsf(b.y)), fmaxf(fabsf(b.z), fabsf(b.w))));
    mx = fmaxf(mx, fmaxf(fmaxf(fmaxf(fabsf(c.x), fabsf(c.y)), fmaxf(fabsf(c.z), fabsf(c.w))),
                         fmaxf(fmaxf(fabsf(d.x), fabsf(d.y)), fmaxf(fabsf(d.z), fabsf(d.w)))));
#pragma unroll
    for (int o = 32; o >= 1; o >>= 1) mx = fmaxf(mx, shx(mx, o));
    const float s = (mx > 0.f) ? 224.f / mx : 1.f;
    uint4 pk;
    pk.x = pack4_fp8(a.x * s, a.y * s, a.z * s, a.w * s);
    pk.y = pack4_fp8(b.x * s, b.y * s, b.z * s, b.w * s);
    pk.z = pack4_fp8(c.x * s, c.y * s, c.z * s, c.w * s);
    pk.w = pack4_fp8(d.x * s, d.y * s, d.z * s, d.w * s);
    *(uint4*)(dst + tb * 1024 + lane * 16) = pk;
    if (lane == 0) sc[tb] = 1.f / s;
  }
}

DEV float rdlane_f(float v, int l) { return __int_as_float(__builtin_amdgcn_readlane(__float_as_int(v), l)); }
DEV float dot16_f8(const float* hw, uint4 u) {
  float f[16];
  unpack16_fp8(u, f);
  float s = 0.f;
#pragma unroll
  for (int i = 0; i < 16; ++i) s += hw[i] * f[i];
  return s;
}
DEV void axpy16_f8(float* acc, float a, uint4 u) {
  float f[16];
  unpack16_fp8(u, f);
#pragma unroll
  for (int i = 0; i < 16; ++i) acc[i] += a * f[i];
}
#define PE_ROWPTR(idxv, j) (E8 + (size_t)__builtin_amdgcn_readlane(idxv, (j)) * 2048)
#define PE_LOAD8(P, idxv, j0, off)                                                                        \
  P##0 = *(const uint4*)(PE_ROWPTR(idxv, (j0)) + (off)); P##1 = *(const uint4*)(PE_ROWPTR(idxv, (j0) + 1) + (off)); \
  P##2 = *(const uint4*)(PE_ROWPTR(idxv, (j0) + 2) + (off)); P##3 = *(const uint4*)(PE_ROWPTR(idxv, (j0) + 3) + (off)); \
  P##4 = *(const uint4*)(PE_ROWPTR(idxv, (j0) + 4) + (off)); P##5 = *(const uint4*)(PE_ROWPTR(idxv, (j0) + 5) + (off)); \
  P##6 = *(const uint4*)(PE_ROWPTR(idxv, (j0) + 6) + (off)); P##7 = *(const uint4*)(PE_ROWPTR(idxv, (j0) + 7) + (off));
#define PE_DOTSET(P, j0, dv)                                                                              \
  {                                                                                                       \
    const float s0 = wave_sum(dot16_f8(hw, P##0)), s1 = wave_sum(dot16_f8(hw, P##1)),                     \
                s2 = wave_sum(dot16_f8(hw, P##2)), s3 = wave_sum(dot16_f8(hw, P##3)),                     \
                s4 = wave_sum(dot16_f8(hw, P##4)), s5 = wave_sum(dot16_f8(hw, P##5)),                     \
                s6 = wave_sum(dot16_f8(hw, P##6)), s7 = wave_sum(dot16_f8(hw, P##7));                     \
    if (lane == (j0)) dv = s0;                                                                            \
    if (lane == (j0) + 1) dv = s1;                                                                        \
    if (lane == (j0) + 2) dv = s2;                                                                        \
    if (lane == (j0) + 3) dv = s3;                                                                        \
    if (lane == (j0) + 4) dv = s4;                                                                        \
    if (lane == (j0) + 5) dv = s5;                                                                        \
    if (lane == (j0) + 6) dv = s6;                                                                        \
    if (lane == (j0) + 7) dv = s7;                                                                        \
  }
#define PE_AXPYSET(P, j0, av)                                                                             \
  {                                                                                                       \
    axpy16_f8(acc, rdlane_f(av, (j0)), P##0);     axpy16_f8(acc, rdlane_f(av, (j0) + 1), P##1);           \
    axpy16_f8(acc, rdlane_f(av, (j0) + 2), P##2); axpy16_f8(acc, rdlane_f(av, (j0) + 3), P##3);           \
    axpy16_f8(acc, rdlane_f(av, (j0) + 4), P##4); axpy16_f8(acc, rdlane_f(av, (j0) + 5), P##5);           \
    axpy16_f8(acc, rdlane_f(av, (j0) + 6), P##6); axpy16_f8(acc, rdlane_f(av, (j0) + 7), P##7);           \
  }
#define PE_DOT8(idxv, dv)                                                                                 \
  {                                                                                                       \
    uint4 pa0, pa1, pa2, pa3, pa4, pa5, pa6, pa7, pb0, pb1, pb2, pb3, pb4, pb5, pb6, pb7;                 \
    PE_LOAD8(pa, idxv, 0, 0)                                                                              \
    _Pragma("unroll 1") for (int g = 0; g < 4; ++g) {                                                     \
      const int j0 = g * 16;                                                                              \
      PE_LOAD8(pb, idxv, j0 + 8, 0)                                                                       \
      PE_DOTSET(pa, j0, dv)                                                                               \
      if (g < 3) { PE_LOAD8(pa, idxv, j0 + 16, 0) }                                                       \
      PE_DOTSET(pb, j0 + 8, dv)                                                                           \
    }                                                                                                     \
  }
#define PE_AXPY8(idxv, av)                                                                                \
  {                                                                                                       \
    uint4 pa0, pa1, pa2, pa3, pa4, pa5, pa6, pa7, pb0, pb1, pb2, pb3, pb4, pb5, pb6, pb7;                 \
    PE_LOAD8(pa, idxv, 0, 1024)                                                                           \
    _Pragma("unroll 1") for (int g = 0; g < 4; ++g) {                                                     \
      const int j0 = g * 16;                                                                              \
      PE_LOAD8(pb, idxv, j0 + 8, 1024)                                                                    \
      PE_AXPYSET(pa, j0, av)                                                                              \
      if (g < 3) { PE_LOAD8(pa, idxv, j0 + 16, 1024) }                                                    \
      PE_AXPYSET(pb, j0 + 8, av)                                                                          \
    }                                                                                                     \
  }
DEV void peer_expert_item2(const Params& p, int layer, int item, float ga_scale = 1.f) {
  const int lane = tidx() & 63, wave = tidx() >> 6;
  const size_t tok = (size_t)item * 4 + wave;
  const int b = (int)(tok / S);
  const int* pi = (const int*)(p.ws + OFF_PEIDX) + tok * 128;
  const float* pg = (const float*)(p.ws + OFF_PEG) + tok * 128;
  const int idx_lo = pi[lane], idx_hi = pi[64 + lane];
  const float g_lo = pg[lane], g_hi = pg[64 + lane];
  const float* esc = (const float*)(p.ws + OFF_ESC);
  const float2 sc_lo = *(const float2*)(esc + (size_t)idx_lo * 2), sc_hi = *(const float2*)(esc + (size_t)idx_hi * 2);
  const bf16* hrow = (const bf16*)(p.ws + OFF_H) + tok * 1024 + lane * 16;
  float hw[16];
  unpack8(*(const uint4*)hrow, hw);
  unpack8(*(const uint4*)(hrow + 8), hw + 8);
  const unsigned char* E8 = (const unsigned char*)(p.ws + OFF_E8) + lane * 16;
  float d_lo = 0.f, d_hi = 0.f;
  PE_DOT8(idx_lo, d_lo)
  PE_DOT8(idx_hi, d_hi)
  const float act_lo = g_lo * gelu_tanh(d_lo * sc_lo.x) * sc_lo.y;
  const float act_hi = g_hi * gelu_tanh(d_hi * sc_hi.x) * sc_hi.y;
  float acc[16];
#pragma unroll
  for (int i = 0; i < 16; ++i) acc[i] = 0.f;
  PE_AXPY8(idx_lo, act_lo)
  PE_AXPY8(idx_hi, act_hi)
  const float* ga = (const float*)(p.ws + OFF_MOD) + (layer * 2 + b) * 6144 + 5120 + lane * 16;
  float* xr = p.out + tok * 1024 + lane * 16;
  float xn[16];
  float ss = 0.f;
#pragma unroll
  for (int q4 = 0; q4 < 4; ++q4) {
    float4 xo = *(float4*)(xr + q4 * 4);
    const float4 g4v = *(const float4*)(ga + q4 * 4);
    xo.x += ga_scale * g4v.x * acc[q4 * 4 + 0];
    xo.y += ga_scale * g4v.y * acc[q4 * 4 + 1];
    xo.z += ga_scale * g4v.z * acc[q4 * 4 + 2];
    xo.w += ga_scale * g4v.w * acc[q4 * 4 + 3];
    xn[q4 * 4] = xo.x; xn[q4 * 4 + 1] = xo.y; xn[q4 * 4 + 2] = xo.z; xn[q4 * 4 + 3] = xo.w;
    ss += xo.x * xo.x + xo.y * xo.y + xo.z * xo.z + xo.w * xo.w;
  }
#if PROBE_ANY || REP_MASK
#pragma unroll
  for (int q4 = 0; q4 < 4; ++q4)
    *(float4*)(xr + q4 * 4) = float4{xn[q4 * 4], xn[q4 * 4 + 1], xn[q4 * 4 + 2], xn[q4 * 4 + 3]};
  return;
#endif
  ss = wave_sum(ss);
  const float rn = 1.0f / sqrtf(ss * (1.0f / 1024.f) + 1e-6f);
  if (layer == 0) {
    const float* gn = p.g_attn + 1024 + lane * 16;
    const float* md = (const float*)(p.ws + OFF_MOD) + (2 + b) * 6144 + lane * 16;
    bf16* hq = (bf16*)(p.ws + OFF_H) + tok * 1024 + lane * 16;
    unsigned pk[8];
#pragma unroll
    for (int q4 = 0; q4 < 4; ++q4) {
      *(float4*)(xr + q4 * 4) = float4{xn[q4 * 4], xn[q4 * 4 + 1], xn[q4 * 4 + 2], xn[q4 * 4 + 3]};
      const float4 g4v = *(const float4*)(gn + q4 * 4);
      const float4 s4 = *(const float4*)(md + 1024 + q4 * 4);
      const float4 h4 = *(const float4*)(md + q4 * 4);
      const float o0 = xn[q4 * 4] * rn * g4v.x * (1.f + s4.x) + h4.x;
      const float o1 = xn[q4 * 4 + 1] * rn * g4v.y * (1.f + s4.y) + h4.y;
      const float o2 = xn[q4 * 4 + 2] * rn * g4v.z * (1.f + s4.z) + h4.z;
      const float o3 = xn[q4 * 4 + 3] * rn * g4v.w * (1.f + s4.w) + h4.w;
      pk[q4 * 2] = cvtpk_(o0, o1);
      pk[q4 * 2 + 1] = cvtpk_(o2, o3);
    }
    *(uint4*)hq = uint4{pk[0], pk[1], pk[2], pk[3]};
    *(uint4*)(hq + 8) = uint4{pk[4], pk[5], pk[6], pk[7]};
  } else {
    const float* gf = p.g_final + lane * 16;
#pragma unroll
    for (int q4 = 0; q4 < 4; ++q4) {
      const float4 g4v = *(const float4*)(gf + q4 * 4);
      *(float4*)(xr + q4 * 4) = float4{xn[q4 * 4] * rn * g4v.x, xn[q4 * 4 + 1] * rn * g4v.y, xn[q4 * 4 + 2] * rn * g4v.z,
                                       xn[q4 * 4 + 3] * rn * g4v.w};
    }
  }
}

template <class F>
DEV void for_tiles_xcd(int MT, int NT, F f) {
  const int nb = gridDim.x, bid = blockIdx.x;
  if ((nb & 7) != 0) {
    for (int it = bid; it < MT * NT; it += nb) f(it / NT, it % NT);
    return;
  }
  const int xcd = bid & 7, slot = bid >> 3, nslot = nb >> 3;
  const int nj = (NT - xcd + 7) >> 3;
  for (int q = slot; q < MT * nj; q += nslot) f(q / nj, xcd + 8 * (q % nj));
}
constexpr int PH_PER_LAYER = 12;
constexpr int N_REAL_PHASES = 1 + 2 * PH_PER_LAYER + 1;
constexpr int N_PHASES = N_REAL_PHASES + (PROBE_ANY ? 2 : 0);

DEV void run_phase(const Params& p, int ph, char* smem_raw, bool second_pass = false) {
#define SKIP_MOBA_SECOND (REP_NSA_ONLY && second_pass)
  float* smf = (float*)smem_raw;
  bf16* smh = (bf16*)smem_raw;
  const int nb = gridDim.x, bid = blockIdx.x;
  if (ph == 0) {
    for (int it = bid; it < PREP_ITEMS; it += nb) prep_item(p, it, smf);
    return;
  }
  if (ph == N_REAL_PHASES - 1) {
    for (int it = bid; it < T / 4; it += nb) final_norm_item(p.out, p.g_final, it);
    return;
  }
#if PROBE_ANY
  if (ph == N_REAL_PHASES) {
#if PROBE_PROJ
    {
      const bf16* Hh = (const bf16*)(p.ws + OFF_H);
      const bf16* Wt = (const bf16*)(p.ws + OFF_WINT) + (size_t)1 * WN * 1024;
      const float* rope = (const float*)(p.ws + OFF_ROPE);
      float sd = 0.f, sr = 0.f;
      for (size_t i = (size_t)bid * 256 + tidx(); i < (size_t)(T / 64) * 4888; i += (size_t)nb * 256) {
        const int ts = (int)(i / 4888), vc = (int)(i % 4888);
        const int tok = ts * 64 + (ts % 61);
        const int b = tok / S, t = tok % S;
        auto rawdot = [&](int col) {
          float a = 0.f;
          for (int k = 0; k < 1024; ++k) a += bf2f(Hh[(size_t)tok * 1024 + k]) * bf2f(Wt[(size_t)col * 1024 + k]);
          return a;
        };
        float v = rawdot(vc);
        bool roped = false;
        const bf16* dst;
        if (vc < 768) dst = (const bf16*)(p.ws + OFF_PROJ) + (size_t)tok * PC + vc;
        else if (vc < 1280) {
          const int seg = (vc - 768) >> 7, head = ((vc - 768) >> 6) & 1, d = vc & 63;
          const size_t off = (seg == 0) ? OFF_KSB : (seg == 1) ? OFF_VSB : (seg == 2) ? OFF_KWB : OFF_VWB;
          dst = (const bf16*)(p.ws + off) + ((size_t)(b * 2 + head) * S + t) * 64 + d;
          roped = (seg == 0 || seg == 2);
        } else if (vc < 1792) { dst = (const bf16*)(p.ws + OFF_PROJ) + (size_t)tok * PC + C_MQ + (vc - 1280); roped = true; }
        else if (vc < 2816) {
          const int seg = (vc - 1792) >> 9, head = ((vc - 1792) >> 6) & 7, d = vc & 63;
          dst = (const bf16*)(p.ws + (seg ? OFF_MVB : OFF_MKB)) + ((size_t)(b * 8 + head) * S + t) * 64 + d;
          roped = (seg == 0);
        } else if (vc < 4864) dst = (const bf16*)(p.ws + OFF_PROJ) + (size_t)tok * PC + C_GN + (vc - 2816);
        else dst = (const bf16*)(p.ws + OFF_PROJ) + (size_t)tok * PC + C_NG + (vc - 4864);
        const int d = vc & 63;
        if (roped && d < 16) {
          const float cs = rope[(size_t)t * 16 + (d & 7)], sn = rope[(size_t)t * 16 + 8 + (d & 7)];
          if (d < 8) { const float x2 = rawdot(vc + 8); v = v * cs - x2 * sn; }
          else { const float x1 = rawdot(vc - 8); v = v * cs + x1 * sn; }
        }
        const float got = bf2f(*dst);
        const bool is_r = roped && d < 16;
        if (PROBE_PROJ == 1 || (PROBE_PROJ == 2 && is_r) || (PROBE_PROJ == 3 && !is_r)) {
          sd += (got - v) * (got - v);
          sr += v * v;
        }
      }
      sd = wave_sum(sd); sr = wave_sum(sr);
      if ((tidx() & 63) == 0) {
        atomicAdd((float*)(p.ws + OFF_PROBE), sd);
        atomicAdd((float*)(p.ws + OFF_PROBE) + 1, sr);
      }
    }
#endif
#if PROBE_CMPR
    {
      float sd = 0.f, sr = 0.f;
      for (size_t i = (size_t)bid * 256 + tidx(); i < (size_t)2 * Bn * 1024 * 128; i += (size_t)nb * 256) {
        const size_t wh = i / ((size_t)Bn * 1024 * 128), r = i % ((size_t)Bn * 1024 * 128);
        const int c = (int)((r / 128) % 1024);
        if (c < 1023) {
          const float a = ((const float*)(p.ws + (wh ? OFF_VCC : OFF_KCC)))[r];
          const float y = ((const float*)(p.ws + OFF_CMP))[i];
          sd += (a - y) * (a - y);
          sr += y * y;
        }
      }
      sd = wave_sum(sd); sr = wave_sum(sr);
      if ((tidx() & 63) == 0) {
        atomicAdd((float*)(p.ws + OFF_PROBE), sd);
        atomicAdd((float*)(p.ws + OFF_PROBE) + 1, sr);
      }
    }
#endif
#if PROBE_MOBA
    probe_accum_bf16(p, (const bf16*)(p.ws + OFF_OMOBA), (const bf16*)(p.ws + OFF_CMP), (size_t)S * 512, smf);
#endif
#if PROBE_NSA == 8
    {
      const float* impn = (const float*)(p.ws + OFF_OMOBA);
      const float* impm = impn + (size_t)S * 256;
      const int* seld = (const int*)(p.ws + OFF_CMP);
      float sd = 0.f, sr = 0.f, bad = 0.f;
      for (int t = bid * 256 + tidx(); t < S; t += nb * 256) {
        const int cur = t >> 6;
        for (int n = 0; n < 256; ++n) {
          float a = impm[(size_t)t * 256 + n], r = impn[(size_t)t * 256 + n];
          sd += (a - r) * (a - r);
          sr += r * r;
        }
        unsigned want[8] = {0, 0, 0, 0, 0, 0, 0, 0}, got[8] = {0, 0, 0, 0, 0, 0, 0, 0};
        for (int j = 0; j < 16; ++j) {
          int v = seld[(size_t)t * 16 + j];
          if (v >= 0 && v < 256) {
            for (int w = 0; w < 8; ++w) if ((v >> 5) == w) got[w] |= 1u << (v & 31);
          }
        }
        if (cur < 16) {
          for (int n = 0; n <= cur; ++n) want[0] |= 1u << n;
        } else {
          want[0] |= 1u;
          for (int w = 0; w < 8; ++w) {
            if (((cur - 1) >> 5) == w) want[w] |= 1u << ((cur - 1) & 31);
            if ((cur >> 5) == w) want[w] |= 1u << (cur & 31);
          }
          for (int j = 0; j < 13; ++j) {
            float best = -1.f;
            int bi = 1;
            for (int n = 1; n <= cur - 2; ++n) {
              bool taken = false;
              for (int w = 0; w < 8; ++w) if ((n >> 5) == w) taken = (want[w] >> (n & 31)) & 1u;
              float v = impm[(size_t)t * 256 + n];
              if (!taken && v > best) { best = v; bi = n; }
            }
            for (int w = 0; w < 8; ++w) if ((bi >> 5) == w) want[w] |= 1u << (bi & 31);
          }
        }
        bool same = true;
        for (int w = 0; w < 8; ++w) same = same && (want[w] == got[w]);
        if (!same) bad += 1.f;
      }
      sd = wave_sum(sd); sr = wave_sum(sr); bad = wave_sum(bad);
      if ((tidx() & 63) == 0) {
        atomicAdd((float*)(p.ws + OFF_PROBE), sd);
        atomicAdd((float*)(p.ws + OFF_PROBE) + 1, sr);
        atomicAdd((float*)(p.ws + OFF_PROBE) + 2, bad);
      }
    }
#elif PROBE_NSA
    probe_accum_bf16(p, (const bf16*)(p.ws + OFF_ONSA), (const bf16*)(p.ws + OFF_CMP), (size_t)S * 512, smf);
#endif
    return;
  }
  if (ph == N_REAL_PHASES + 1) {
    probe_apply(p);
    return;
  }
#endif
  const int layer = (ph - 1) / PH_PER_LAYER, sub = (ph - 1) % PH_PER_LAYER;
  const float* mod = (const float*)(p.ws + OFF_MOD) + (size_t)layer * 2 * 6144;
  const float* xin = (layer == 0) ? p.x : p.out;
  bf16* H = (bf16*)(p.ws + OFF_H);
  bf16* PROJ = (bf16*)(p.ws + OFF_PROJ);
#if PROBE_ANY
  if (sub >= 5) {
    if (sub == 7 && layer == 0)
      for (size_t i = (size_t)bid * 256 + tidx(); i < (size_t)T * 1024; i += (size_t)nb * 256) p.out[i] = p.x[i];
    return;
  }
#endif
  switch (sub) {
    case 0:
      for (int it = bid; it < T / 4; it += nb)
        norm_item(xin, p.g_attn + layer * 1024, mod + 1024, mod + 0, H, it);
      break;
    case 1: {
      for_tiles_xcd(T / 128, WN / 128, [&](int mt, int nt) { inproj_tile(p, layer, mt * 128, nt * 128, smh); });
    } break;
    case 2:
      for (int it = bid; it < 512; it += nb) compress_mfma_item(p, layer, it, smem_raw);
#if PROBE_CMPR
      if (layer == 1)
        for (int it = bid; it < 1024; it += nb) compress_item(p, layer, it, smf);
#endif
      break;
    case 3:
      for (int it = bid; it < 1024; it += nb) kmean_item(p, it, smf);
#if PROBE_NSA
      if (layer == 1)
        for (int it = bid; it < 512; it += nb) n1_item(p, layer, it, smf);
#endif
      break;
    case 4:
      {
        constexpr int MNI = 2;
        constexpr int NMOBA = 16 * (S / (64 * MNI));
        constexpr int NNI = 2;
        constexpr int NNSA = 4 * (S / (16 * NNI));
        for (int it = bid; it < NMOBA + NNSA; it += nb) {
          if (it < NMOBA) { if (PROBE_NSA != 8 && !SKIP_MOBA_SECOND) moba_mfma_item<MNI>(p, it, smem_raw, (bf16*)(p.ws + OFF_OMOBA)); }
          else nsa_item<NNI>(p, it - NMOBA, smem_raw, (bf16*)(p.ws + OFF_ONSA));
        }
#if PROBE_NSA && PROBE_NSA != 8
        if (layer == 1)
          for (int it = bid; it < 512; it += nb) n23_item(p, layer, it);
#endif
#if PROBE_MOBA
        if (layer == 1) {
          for (int it = bid; it < 512; it += nb) moba_item(p, layer, it);
        }
#endif
      }
      break;
    case 5:
      for_tiles_xcd(T / 128, 8, [&](int mt, int nt) { merge_tile(p, layer, mt * 128, nt * 128, smh); });
      break;
    case 6:
      break;
    case 7: {
      const bf16* W = (const bf16*)(p.ws + OFF_WOUT) + (size_t)layer * 1024 * 1024;
      const float* ga1 = mod + 2048;
      for_tiles_xcd(T / 128, 8, [&](int mt, int nt) {
        gemm_tile(H, 1024, W, 1024, mt * 128, nt * 128, smh, [&](int row, int col, float v) {
          int b = row / S;
          size_t o = (size_t)row * 1024 + col;
          p.out[o] = xin[o] + ga1[b * 6144 + col] * v;
        });
      });
    } break;
    case 8:
      for (int it = bid; it < T / 4 + NEXP / 4; it += nb) {
        if (it < T / 4) norm_item(p.out, p.g_ffn + layer * 1024, mod + 4096, mod + 3072, H, it);
        else expert_cvt_item(p, layer, it - T / 4);
      }
      break;
    case 9: {
      const bf16* W = (const bf16*)(p.ws + OFF_WQ) + (size_t)layer * 2048 * 1024;
      bf16* QP = (bf16*)(p.ws + OFF_QP);
      for_tiles_xcd(T / 128, 16, [&](int mt, int nt) {
        f32x4 acc[4][4];
        acc_zero(acc);
        gemm_mainloop(H, 1024, W, 1024, mt * 128, nt * 128, smh, acc);
        const int wv = tidx() >> 6;
        store_tile_bf16(smh, acc, QP + (size_t)(mt * 128 + (wv >> 1) * 64) * 2048 + nt * 128 + (wv & 1) * 64, 2048);
      });
    } break;
    case 10:
      for (int it = bid; it < T / 8; it += nb) peer_topk_mfma_item(p, layer, it);
      break;
    case 11:
      for (int it = bid; it < T / 4; it += nb) peer_expert_item2(p, layer, it, second_pass ? 0.f : 1.f);
      break;
  }
}

#if PROBE_ANY
#define MEGA_LB __launch_bounds__(256)
#else
#define MEGA_LB __launch_bounds__(256, 2)
#endif
__global__ void MEGA_LB mega_kernel(Params p, int ph_lo, int ph_hi) {
  __shared__ __attribute__((aligned(16))) char smem_raw[SMEM_BYTES + 16];
  volatile LAS unsigned* xbst = (volatile LAS unsigned*)(smem_raw + SMEM_BYTES);
  if (threadIdx.x == 0) { xbst[0] = 0u; xbst[1] = 0u; xbst[2] = 0u; xbst[3] = 0u; }
  __syncthreads();
  XcdBarrier xb = xcd_barrier_post((unsigned*)(p.ws + OFF_BAR), xbst);
  for (int ph = ph_lo; ph < ph_hi; ++ph) {
#if !PROBE_ANY && !REP_MASK
    if (ph == N_REAL_PHASES - 1 || ph == 1 + PH_PER_LAYER || (ph >= 1 && (ph - 1) % PH_PER_LAYER == 6)) continue;
#endif
    run_phase(p, ph, smem_raw);
#if REP_MASK
    if (ph >= 1 && ph < N_REAL_PHASES - 1 && ((REP_MASK >> ((ph - 1) % PH_PER_LAYER)) & 1)) {
      xcd_barrier(xb);
      run_phase(p, ph, smem_raw, true);
    }
#endif
    if (ph + 1 < ph_hi) {
      if (ph == ph_lo) cg::this_grid().sync();
      else xcd_barrier(xb);
    }
  }
}

extern "C" void kernel_launch(void* const* d_in, const int* in_sizes, int n_in, void* d_out, int out_size, void* d_ws,
                              size_t ws_size, hipStream_t stream) {
  if (ws_size < WS_TOTAL) {
    fprintf(stderr, "workspace too small: %zu < %zu\n", ws_size, (size_t)WS_NEED);
    return;
  }
  Params p{};
  p.x = (const float*)d_in[0]; p.c = (const float*)d_in[1]; p.w_ada = (const float*)d_in[2];
  p.b_ada = (const float*)d_in[3]; p.g_attn = (const float*)d_in[4]; p.g_ffn = (const float*)d_in[5];
  p.w_in = (const float*)d_in[6]; p.cmp_pe = (const float*)d_in[7]; p.cmp_w1 = (const float*)d_in[8];
  p.cmp_w2 = (const float*)d_in[9]; p.w_up_nsa = (const float*)d_in[10]; p.w_up_moba = (const float*)d_in[11];
  p.w_out = (const float*)d_in[12]; p.peer_wq = (const float*)d_in[13]; p.peer_k1 = (const float*)d_in[14];
  p.peer_k2 = (const float*)d_in[15]; p.peer_u = (const float*)d_in[16]; p.peer_v = (const float*)d_in[17];
  p.g_final = (const float*)d_in[18];
  p.out = (float*)d_out;
  p.ws = (char*)d_ws;
  static int grid_blocks = 0;
  if (!grid_blocks) {
    int dev = 0, cus = 0, per_cu = 0;
    hipGetDevice(&dev);
    hipDeviceGetAttribute(&cus, hipDeviceAttributeMultiprocessorCount, dev);
    hipOccupancyMaxActiveBlocksPerMultiprocessor(&per_cu, mega_kernel, 256, 0);
    if (per_cu < 1) per_cu = 1;
    if (per_cu > 2) per_cu = 2;
    grid_blocks = cus * per_cu;
  }
  hipMemsetAsync((char*)d_ws + OFF_BAR, 0, BAR_BYTES, stream);
  int ph_lo = 0, ph_hi = N_PHASES;
  void* args[] = {(void*)&p, (void*)&ph_lo, (void*)&ph_hi};
  hipError_t e = hipLaunchCooperativeKernel((const void*)mega_kernel, dim3(grid_blocks), dim3(256), args, 0, stream);
  if (e != hipSuccess) fprintf(stderr, "cooperative launch failed: %s (grid %d)\n", hipGetErrorString(e), grid_blocks);
}
```

```cpp
#include <hip/hip_runtime.h>
#include <hip/hip_bf16.h>
#include <hip/hip_cooperative_groups.h>
#include <cstdio>
#include <cstdint>
namespace cg = cooperative_groups;

#define DEV __device__ __forceinline__
typedef unsigned short bf16;
using bf16x8 = __attribute__((ext_vector_type(8))) short;
using f32x4 = __attribute__((ext_vector_type(4))) float;

constexpr int Bn = 2, S = 16384, T = Bn * S, D = 1024;
constexpr int PC = 3456;
constexpr int WN = 4992;
constexpr int C_NQ = 0, C_KC = 512, C_VC = 640, C_MQ = 768, C_GN = 1280, C_GM = 2304, C_NG = 3328;
constexpr int NEXP = 16384;

constexpr size_t al(size_t x) { return (x + 255) & ~size_t(255); }
constexpr size_t OFF_MOD = 0;
constexpr size_t OFF_ROPE = al(OFF_MOD + 2 * 2 * 6144 * 4);
constexpr size_t OFF_PEB = al(OFF_ROPE + (size_t)S * 16 * 4);
constexpr size_t OFF_WINT = al(OFF_PEB + 2 * 2 * 128 * 4);
constexpr size_t OFF_WUPN = al(OFF_WINT + 2ull * WN * 1024 * 2);
constexpr size_t OFF_WUPM = al(OFF_WUPN + 2ull * 1024 * 512 * 2);
constexpr size_t OFF_WOUT = al(OFF_WUPM + 2ull * 1024 * 512 * 2);
constexpr size_t OFF_WQ = al(OFF_WOUT + 2ull * 1024 * 1024 * 2);
constexpr size_t OFF_KCC = al(OFF_WQ + 2ull * 2048 * 1024 * 2);
constexpr size_t OFF_VCC = al(OFF_KCC + 2ull * 1024 * 128 * 4);
constexpr size_t OFF_SEL = al(OFF_VCC + 2ull * 1024 * 128 * 4);
constexpr size_t OFF_KMEAN = al(OFF_SEL + 2ull * 2 * S * 16 * 4);
constexpr size_t OFF_KMHL = al(OFF_KMEAN + 2ull * 8 * 64 * 64 * 4);
constexpr size_t OFF_KCB = al(OFF_KMHL + 2ull * 2 * 8 * 64 * 64 * 2);
constexpr size_t OFF_VCB = al(OFF_KCB + 2ull * 2 * 1024 * 64 * 2);
constexpr size_t OFF_PKB = al(OFF_VCB + 2ull * 2 * 1024 * 64 * 2);
constexpr size_t OFF_W1T = al(OFF_PKB + 2ull * 2 * 128 * 128 * 2);
constexpr size_t OFF_BAR = al(OFF_W1T + 4ull * 128 * 2048 * 2);
constexpr size_t BAR_BYTES = 3456 * 4;
constexpr size_t OFF_PROBE = al(OFF_BAR + BAR_BYTES);
constexpr size_t OFF_H = al(OFF_PROBE + 256);
constexpr size_t OFF_ONSA = al(OFF_H + (size_t)T * 1024 * 2);
constexpr size_t OFF_OMOBA = al(OFF_ONSA + (size_t)T * 512 * 2);
constexpr size_t OFF_PROJ = al(OFF_OMOBA + (size_t)T * 512 * 2);
constexpr size_t KV2_BYTES = (size_t)Bn * 2 * S * 64 * 2, KV8_BYTES = (size_t)Bn * 8 * S * 64 * 2;
constexpr size_t OFF_KSB = al(OFF_PROJ + (size_t)T * PC * 2);
constexpr size_t OFF_VSB = OFF_KSB + KV2_BYTES;
constexpr size_t OFF_KWB = OFF_VSB + KV2_BYTES;
constexpr size_t OFF_VWB = OFF_KWB + KV2_BYTES;
constexpr size_t OFF_MKB = OFF_VWB + KV2_BYTES;
constexpr size_t OFF_MVB = OFF_MKB + KV8_BYTES;
constexpr int MLIST_PER_BH = 63 * S - 128 * 63 * 64;
constexpr size_t OFF_MLIST = OFF_MVB + KV8_BYTES;
constexpr size_t OFF_MCNT = al(OFF_MLIST + (size_t)Bn * 8 * MLIST_PER_BH * 2);
constexpr size_t WS_NEED = OFF_MCNT + (size_t)Bn * 8 * 64 * 4;
constexpr size_t PROJ_BYTES = (size_t)T * PC * 2;
constexpr size_t OFF_MPO = OFF_H;
constexpr size_t OFF_MPML = OFF_H + (size_t)8 * S * 3 * 64 * 2;
static_assert((size_t)8 * S * 3 * 64 * 2 + (size_t)8 * S * 3 * 8 <= (size_t)T * 1024 * 2, "moba partials must fit the H region");
constexpr size_t OFF_QP = OFF_PROJ;
constexpr size_t OFF_PEIDX = al(OFF_QP + (size_t)T * 2048 * 2);
constexpr size_t OFF_PEG = al(OFF_PEIDX + (size_t)T * 128 * 4);
constexpr size_t OFF_E8 = al(OFF_PEG + (size_t)T * 128 * 4);
constexpr size_t OFF_ESC = al(OFF_E8 + (size_t)NEXP * 2048);
static_assert(OFF_ESC + (size_t)NEXP * 2 * 4 <= OFF_PROJ + PROJ_BYTES, "peer alias overflow");
static_assert(WS_NEED <= 536870912ull, "workspace too big");
#ifndef PROBE_MOBA
#define PROBE_MOBA 0
#endif
constexpr size_t OFF_CMP = PROBE_MOBA ? OFF_ONSA : OFF_MLIST;
#ifndef REP_NSA_ONLY
#define REP_NSA_ONLY 0
#endif
#ifndef REP_MASK
#define REP_MASK 0
#endif
#ifndef PROBE_MOBA
#define PROBE_MOBA 0
#endif
#ifndef PROBE_NSA
#define PROBE_NSA 0
#endif
#ifndef PROBE_CMPR
#define PROBE_CMPR 0
#endif
#ifndef PROBE_PROJ
#define PROBE_PROJ 0
#endif
#define PROBE_ANY (PROBE_MOBA || PROBE_NSA || PROBE_CMPR || PROBE_PROJ)
constexpr size_t WS_TOTAL = WS_NEED;
static_assert(WS_TOTAL <= 536870912ull, "workspace too big (probe)");

struct Params {
  const float *x, *c, *w_ada, *b_ada, *g_attn, *g_ffn, *w_in, *cmp_pe, *cmp_w1, *cmp_w2, *w_up_nsa, *w_up_moba, *w_out,
      *peer_wq, *peer_k1, *peer_k2, *peer_u, *peer_v, *g_final;
  float* out;
  char* ws;
};

constexpr int SMEM_BYTES = 74 * 1024;

DEV int tidx() {
  int t = threadIdx.x;
  asm volatile("" : "+v"(t));
  return t;
}
#define MFMA16B(a, b, c) __builtin_amdgcn_mfma_f32_16x16x32_bf16(a, b, c, 0, 0, 0)
DEV unsigned cvtpk_(float lo, float hi) {
  unsigned r;
  asm("v_cvt_pk_bf16_f32 %0, %1, %2" : "=v"(r) : "v"(lo), "v"(hi));
  return r;
}
DEV float bf2f(bf16 h) { return __uint_as_float(((unsigned)h) << 16); }
DEV bf16 f2bf(float f) {
  unsigned u = __float_as_uint(f);
  u += 0x7fffu + ((u >> 16) & 1u);
  return (bf16)(u >> 16);
}
DEV float gelu_tanh(float x) {
  float u = 0.7978845608028654f * (x + 0.044715f * x * x * x);
  return 0.5f * x * (1.f + tanhf(u));
}
DEV float sigmoidf_(float x) { return 1.f / (1.f + expf(-x)); }
DEV void unpack8(uint4 v, float* f) {
  f[0] = __uint_as_float(v.x << 16); f[1] = __uint_as_float(v.x & 0xffff0000u);
  f[2] = __uint_as_float(v.y << 16); f[3] = __uint_as_float(v.y & 0xffff0000u);
  f[4] = __uint_as_float(v.z << 16); f[5] = __uint_as_float(v.z & 0xffff0000u);
  f[6] = __uint_as_float(v.w << 16); f[7] = __uint_as_float(v.w & 0xffff0000u);
}
DEV float dot64_bf(const float* q, const bf16* row) {
  float s = 0.f;
#pragma unroll
  for (int i = 0; i < 8; ++i) {
    float f[8];
    unpack8(*(const uint4*)(row + i * 8), f);
#pragma unroll
    for (int j = 0; j < 8; ++j) s += q[i * 8 + j] * f[j];
  }
  return s;
}
DEV void axpy64_bf(float* o, float a, const bf16* row) {
#pragma unroll
  for (int i = 0; i < 8; ++i) {
    float f[8];
    unpack8(*(const uint4*)(row + i * 8), f);
#pragma unroll
    for (int j = 0; j < 8; ++j) o[i * 8 + j] += a * f[j];
  }
}
DEV float dot64_f(const float* q, const float* row) {
  float s = 0.f;
#pragma unroll
  for (int i = 0; i < 16; ++i) {
    float4 v = *(const float4*)(row + i * 4);
    s += q[i * 4] * v.x + q[i * 4 + 1] * v.y + q[i * 4 + 2] * v.z + q[i * 4 + 3] * v.w;
  }
  return s;
}
DEV void axpy64_f(float* o, float a, const float* row) {
#pragma unroll
  for (int i = 0; i < 16; ++i) {
    float4 v = *(const float4*)(row + i * 4);
    o[i * 4] += a * v.x; o[i * 4 + 1] += a * v.y; o[i * 4 + 2] += a * v.z; o[i * 4 + 3] += a * v.w;
  }
}
DEV void load_q64(float* q, const bf16* p, float scale) {
#pragma unroll
  for (int i = 0; i < 8; ++i) unpack8(*(const uint4*)(p + i * 8), q + i * 8);
#pragma unroll
  for (int i = 0; i < 64; ++i) q[i] *= scale;
}
DEV int lane_id_() { return __builtin_amdgcn_mbcnt_hi(~0u, __builtin_amdgcn_mbcnt_lo(~0u, 0u)); }
DEV int shx(int v, int m) {
  if (m == 1) return __builtin_amdgcn_update_dpp(0, v, 0xB1, 0xF, 0xF, true);
  if (m == 2) return __builtin_amdgcn_update_dpp(0, v, 0x4E, 0xF, 0xF, true);
  if (m == 4) return __builtin_amdgcn_ds_swizzle(v, 0x101F);
  if (m == 8) return __builtin_amdgcn_update_dpp(0, v, 0x128, 0xF, 0xF, true);
  if (m == 16) return __builtin_amdgcn_ds_swizzle(v, 0x401F);
  auto rr = __builtin_amdgcn_permlane32_swap((unsigned)v, (unsigned)v, false, false);
  return (lane_id_() < 32) ? (int)rr[1] : (int)rr[0];
}
DEV unsigned shx(unsigned v, int m) { return (unsigned)shx((int)v, m); }
DEV float shx(float v, int m) { return __int_as_float(shx(__float_as_int(v), m)); }
DEV float wave_sum(float v) {
#pragma unroll
  for (int o = 32; o >= 1; o >>= 1) v += shx(v, o);
  return v;
}

#define XB_TMO      128
#define XB_XCNT(j)  (256  + 64 * (j))
#define XB_XSUB(j)  (1280 + 64 * (j))
#define XB_XGEN(j)  (2304 + 64 * (j))
#define XB_TOP      3328
#define XB_TOPGEN   3392
#define XCD_BAR_WORDS 3456
#define XB_SPIN_CAP (1u << 18)
#define LAS __attribute__((address_space(3)))

__device__ __forceinline__ unsigned xb_ld(unsigned* p)              { return __hip_atomic_load(p, __ATOMIC_RELAXED, __HIP_MEMORY_SCOPE_AGENT); }
__device__ __forceinline__ unsigned xb_add(unsigned* p, unsigned v) { return __hip_atomic_fetch_add(p, v, __ATOMIC_RELAXED, __HIP_MEMORY_SCOPE_AGENT); }
__device__ __forceinline__ unsigned xb_xcc_id() { return (unsigned)__builtin_amdgcn_s_getreg((3 << 11) | 20) & 0xFu; }
#define XB_SPIN(cond, bar) do { unsigned _sp = 0; while (cond) { __builtin_amdgcn_s_sleep(1); \
    if ((++_sp & 255u) == 0u) { if (xb_ld(&(bar)[XB_TMO])) break; if (_sp > XB_SPIN_CAP) { atomicAdd(&(bar)[XB_TMO], 1u); break; } } } } while (0)

struct XcdBarrier {
    unsigned* bar; unsigned x;
    volatile LAS unsigned* st;
};

__device__ __forceinline__ XcdBarrier xcd_barrier_post(unsigned* bar, volatile LAS unsigned* st) {
    XcdBarrier b; b.bar = bar; b.x = xb_xcc_id(); b.st = st;
    if (tidx() == 0) (void)xb_add(&bar[XB_XCNT(b.x)], 1u);
    return b;
}
__device__ __forceinline__ void xcd_barrier_complete(unsigned* bar, unsigned x, unsigned& nloc, unsigned& nx) {
    const unsigned G = gridDim.x * gridDim.y * gridDim.z;
    unsigned sum, cnt, mine, sp = 0u;
    for (;;) {
        sum = 0u; cnt = 0u; mine = 0u;
#pragma unroll
        for (unsigned j = 0; j < 16; ++j) { const unsigned c = xb_ld(&bar[XB_XCNT(j)]); sum += c; cnt += (c > 0u) ? 1u : 0u; mine = (j == x) ? c : mine; }
        if (sum == G) break;
        __builtin_amdgcn_s_sleep(1);
        if ((++sp & 255u) == 0u) { if (xb_ld(&bar[XB_TMO])) break; if (sp > XB_SPIN_CAP) { atomicAdd(&bar[XB_TMO], 1u); break; } }
    }
    nloc = mine > 0u ? mine : 1u; nx = cnt > 0u ? cnt : 1u;
}

__device__ __forceinline__ void xcd_barrier(const XcdBarrier& b) {
    asm volatile("s_waitcnt vmcnt(0)" ::: "memory");
    __syncthreads();
    if (tidx() == 0) {
        unsigned* bar = b.bar;
        __builtin_amdgcn_s_waitcnt(0);
        unsigned nloc = b.st[0], nx = b.st[1];
        if (nloc == 0u) { xcd_barrier_complete(bar, b.x, nloc, nx); b.st[0] = nloc; b.st[1] = nx; }
        const unsigned old = xb_add(&bar[XB_XSUB(b.x)], 1u);
        const unsigned gen = old / nloc;
        if (old + 1u == (gen + 1u) * nloc) {
            __builtin_amdgcn_fence(__ATOMIC_RELEASE, "agent");
            asm volatile("s_waitcnt vmcnt(0)" ::: "memory");
            const unsigned og = xb_add(&bar[XB_TOP], 1u);
            const unsigned tg = og / nx;
            if (og + 1u == (tg + 1u) * nx) xb_add(&bar[XB_TOPGEN], 1u);
            else XB_SPIN(xb_ld(&bar[XB_TOPGEN]) == tg, bar);
            __builtin_amdgcn_fence(__ATOMIC_ACQUIRE, "agent");
            xb_add(&bar[XB_XGEN(b.x)], 1u);
            asm volatile("s_waitcnt vmcnt(0)" ::: "memory");
        } else {
            XB_SPIN(xb_ld(&bar[XB_XGEN(b.x)]) == gen, bar);
            __builtin_amdgcn_fence(__ATOMIC_ACQUIRE, "agent");
            asm volatile("s_waitcnt vmcnt(0)" ::: "memory");
        }
    }
    __syncthreads();
}


DEV int win_col_map(int j) {
  if (j < 1280) return j;
  if (j < 4864) return j + 24;
  if (j < 4888) return j - 4864 + 1280;
  return -1;
}
DEV void tr_tile(const float* __restrict__ src, int ldsrc, int K, bf16* __restrict__ dst, int kt, int nt, bool remap,
                 float* sm) {
  const int tid = tidx();
#pragma unroll 4
  for (int i = 0; i < 16; ++i) {
    int r = i * 4 + (tid >> 6), cx = tid & 63;
    int j = nt * 64 + cx, k = kt * 64 + r;
    int oc = remap ? win_col_map(j) : j;
    sm[r * 65 + cx] = (oc >= 0) ? src[(size_t)k * ldsrc + oc] : 0.f;
  }
  __syncthreads();
#pragma unroll 4
  for (int i = 0; i < 16; ++i) {
    int n = i * 4 + (tid >> 6), kk = tid & 63;
    dst[(size_t)(nt * 64 + n) * K + kt * 64 + kk] = f2bf(sm[kk * 65 + n]);
  }
  __syncthreads();
}

constexpr int PREP_TR_WIN = 2 * 78 * 16;
constexpr int PREP_TR_UPN = 2 * 16 * 8;
constexpr int PREP_TR_UPM = 2 * 16 * 8;
constexpr int PREP_TR_OUT = 2 * 16 * 16;
constexpr int PREP_TR_WQ = 2 * 32 * 16;
constexpr int PREP_ROPE = 512;
constexpr int PREP_MOD = 384;
constexpr int PREP_PEB = 16;
constexpr int PREP_PK = 32;
constexpr int PREP_TR_W1 = 4 * 2 * 32;
constexpr int PREP_ITEMS = PREP_TR_WIN + PREP_TR_UPN + PREP_TR_UPM + PREP_TR_OUT + PREP_TR_WQ + PREP_ROPE + PREP_MOD + PREP_PEB + PREP_PK + PREP_TR_W1;

DEV void prep_item(const Params& p, int item, float* sm) {
  const int tid = tidx();
  if (item < PREP_TR_WIN) {
    int l = item / (78 * 16), r = item % (78 * 16);
    int nt = r / 16, kt = r % 16;
    tr_tile(p.w_in + (size_t)l * 1024 * 4888, 4888, 1024, (bf16*)(p.ws + OFF_WINT) + (size_t)l * WN * 1024, kt, nt, true, sm);
    return;
  }
  item -= PREP_TR_WIN;
  if (item < PREP_TR_UPN) {
    int l = item / 128, r = item % 128;
    int nt = r / 8, kt = r % 8;
    tr_tile(p.w_up_nsa + (size_t)l * 512 * 1024, 1024, 512, (bf16*)(p.ws + OFF_WUPN) + (size_t)l * 1024 * 512, kt, nt, false, sm);
    return;
  }
  item -= PREP_TR_UPN;
  if (item < PREP_TR_UPM) {
    int l = item / 128, r = item % 128;
    int nt = r / 8, kt = r % 8;
    tr_tile(p.w_up_moba + (size_t)l * 512 * 1024, 1024, 512, (bf16*)(p.ws + OFF_WUPM) + (size_t)l * 1024 * 512, kt, nt, false, sm);
    return;
  }
  item -= PREP_TR_UPM;
  if (item < PREP_TR_OUT) {
    int l = item / 256, r = item % 256;
    int nt = r / 16, kt = r % 16;
    tr_tile(p.w_out + (size_t)l * 1024 * 1024, 1024, 1024, (bf16*)(p.ws + OFF_WOUT) + (size_t)l * 1024 * 1024, kt, nt, false, sm);
    return;
  }
  item -= PREP_TR_OUT;
  if (item < PREP_TR_WQ) {
    int l = item / 512, r = item % 512;
    int nt = r / 16, kt = r % 16;
    tr_tile(p.peer_wq + (size_t)l * 1024 * 2048, 2048, 1024, (bf16*)(p.ws + OFF_WQ) + (size_t)l * 2048 * 1024, kt, nt, false, sm);
    return;
  }
  item -= PREP_TR_WQ;
  if (item < PREP_ROPE) {
    int idx = item * 256 + tid;
    int pos = idx >> 3, i = idx & 7;
    float inv = powf(500000.0f, -(float)i / 8.0f);
    float ang = (float)pos * inv;
    float* rp = (float*)(p.ws + OFF_ROPE) + (size_t)pos * 16;
    rp[i] = (float)cos((double)ang);
    rp[8 + i] = (float)sin((double)ang);
    return;
  }
  item -= PREP_ROPE;
  if (item < PREP_MOD) {
    for (int i = tid; i < 2048; i += 256) {
      float cv = p.c[i];
      sm[i] = cv / (1.f + expf(-cv));
    }
    __syncthreads();
    const int l = item / 192, n0 = (item % 192) * 32;
    const int col = tid & 31, ks = tid >> 5;
    const float* w = p.w_ada + (size_t)l * 1024 * 6144 + n0 + col;
    float a0 = 0.f, a1 = 0.f;
#pragma unroll 8
    for (int k = ks * 128; k < ks * 128 + 128; ++k) {
      float wv = w[(size_t)k * 6144];
      a0 += sm[k] * wv;
      a1 += sm[1024 + k] * wv;
    }
    sm[2048 + tid * 2] = a0;
    sm[2048 + tid * 2 + 1] = a1;
    __syncthreads();
    if (tid < 64) {
      const int c2 = tid & 31, bs = tid >> 5;
      float s = 0.f;
#pragma unroll
      for (int q = 0; q < 8; ++q) s += sm[2048 + (q * 32 + c2) * 2 + bs];
      ((float*)(p.ws + OFF_MOD))[(l * 2 + bs) * 6144 + n0 + c2] = s + p.b_ada[l * 6144 + n0 + c2];
    }
    __syncthreads();
    return;
  }
  item -= PREP_MOD;
  if (item < PREP_PEB) {
    const int lw = item >> 2, j0 = (item & 3) * 32;
    const int col = tid & 31, ks = tid >> 5;
    const float* pe = p.cmp_pe + (size_t)lw * 2048;
    const float* w1 = p.cmp_w1 + (size_t)lw * 2048 * 128 + j0 + col;
    float a = 0.f;
#pragma unroll 8
    for (int i = ks * 256; i < ks * 256 + 256; ++i) a += pe[i] * w1[(size_t)i * 128];
    sm[tid] = a;
    __syncthreads();
    if (tid < 32) {
      float s = 0.f;
#pragma unroll
      for (int q = 0; q < 8; ++q) s += sm[q * 32 + tid];
      ((float*)(p.ws + OFF_PEB))[lw * 128 + j0 + tid] = s;
    }
    if (item == 0 && tid < 4) ((float*)(p.ws + OFF_PROBE))[tid] = 0.f;
    __syncthreads();
    return;
  }
  item -= PREP_PEB;
  if (item < PREP_PK) {
    const int e0 = item * 2048 + tid * 8;
    const int lt = e0 >> 14, off = e0 & 16383;
    const float* srcp = ((lt & 1) ? p.peer_k2 : p.peer_k1) + (size_t)(lt >> 1) * 16384 + off;
    const float4 a = *(const float4*)srcp, b4 = *(const float4*)(srcp + 4);
    uint4 pk;
    pk.x = (unsigned)f2bf(a.x) | ((unsigned)f2bf(a.y) << 16);
    pk.y = (unsigned)f2bf(a.z) | ((unsigned)f2bf(a.w) << 16);
    pk.z = (unsigned)f2bf(b4.x) | ((unsigned)f2bf(b4.y) << 16);
    pk.w = (unsigned)f2bf(b4.z) | ((unsigned)f2bf(b4.w) << 16);
    *(uint4*)((bf16*)(p.ws + OFF_PKB) + e0) = pk;
    return;
  }
  item -= PREP_PK;
  {
    const int lw = item >> 6, r = item & 63;
    const int nt = r >> 5, kt = r & 31;
    tr_tile(p.cmp_w1 + (size_t)lw * 2048 * 128, 128, 2048, (bf16*)(p.ws + OFF_W1T) + (size_t)lw * 128 * 2048, kt, nt, false, sm);
  }
}

DEV void norm_item(const float* __restrict__ xin, const float* __restrict__ g, const float* __restrict__ sc,
                   const float* __restrict__ sh, bf16* __restrict__ hout, int item) {
  const int lane = tidx() & 63, wave = tidx() >> 6;
  const size_t tok = (size_t)item * 4 + wave;
  const int b = (int)(tok / S);
  const float* xr = xin + tok * 1024;
  float4 v[4];
  float ss = 0.f;
#pragma unroll
  for (int i = 0; i < 4; ++i) {
    v[i] = *(const float4*)(xr + i * 256 + lane * 4);
    ss += v[i].x * v[i].x + v[i].y * v[i].y + v[i].z * v[i].z + v[i].w * v[i].w;
  }
  ss = wave_sum(ss);
  float r = 1.0f / sqrtf(ss * (1.0f / 1024.f) + 1e-6f);
#pragma unroll
  for (int i = 0; i < 4; ++i) {
    int d = i * 256 + lane * 4;
    float4 gg = *(const float4*)(g + d);
    float4 s4 = *(const float4*)(sc + b * 6144 + d);
    float4 h4 = *(const float4*)(sh + b * 6144 + d);
    float o0 = v[i].x * r * gg.x * (1.f + s4.x) + h4.x;
    float o1 = v[i].y * r * gg.y * (1.f + s4.y) + h4.y;
    float o2 = v[i].z * r * gg.z * (1.f + s4.z) + h4.z;
    float o3 = v[i].w * r * gg.w * (1.f + s4.w) + h4.w;
    uint2 pk;
    pk.x = (unsigned)f2bf(o0) | ((unsigned)f2bf(o1) << 16);
    pk.y = (unsigned)f2bf(o2) | ((unsigned)f2bf(o3) << 16);
    *(uint2*)(hout + tok * 1024 + d) = pk;
  }
}
DEV void final_norm_item(float* __restrict__ x, const float* __restrict__ g, int item) {
  const int lane = tidx() & 63, wave = tidx() >> 6;
  const size_t tok = (size_t)item * 4 + wave;
  float* xr = x + tok * 1024;
  float4 v[4];
  float ss = 0.f;
#pragma unroll
  for (int i = 0; i < 4; ++i) {
    v[i] = *(const float4*)(xr + i * 256 + lane * 4);
    ss += v[i].x * v[i].x + v[i].y * v[i].y + v[i].z * v[i].z + v[i].w * v[i].w;
  }
  ss = wave_sum(ss);
  float r = 1.0f / sqrtf(ss * (1.0f / 1024.f) + 1e-6f);
#pragma unroll
  for (int i = 0; i < 4; ++i) {
    int d = i * 256 + lane * 4;
    float4 gg = *(const float4*)(g + d);
    float4 o;
    o.x = v[i].x * r * gg.x; o.y = v[i].y * r * gg.y; o.z = v[i].z * r * gg.z; o.w = v[i].w * r * gg.w;
    *(float4*)(xr + d) = o;
  }
}

#define GM_BUF (2 * 128 * 72)
#define GM_LOAD(R, kk)                                                                                  \
  {                                                                                                     \
    const bf16* Ak = Ap + (kk);                                                                         \
    const bf16* Wk = Wp + (kk);                                                                         \
    R##a0 = *(const uint4*)(Ak); R##a1 = *(const uint4*)(Ak + a32); R##a2 = *(const uint4*)(Ak + 2 * a32); \
    R##a3 = *(const uint4*)(Ak + 3 * a32);                                                              \
    R##b0 = *(const uint4*)(Wk); R##b1 = *(const uint4*)(Wk + w32); R##b2 = *(const uint4*)(Wk + 2 * w32); \
    R##b3 = *(const uint4*)(Wk + 3 * w32);                                                              \
  }
#define GM_STORE(R, buf)                                                                                \
  {                                                                                                     \
    bf16* as_ = Asw + (buf) * GM_BUF;                                                                   \
    bf16* bs_ = as_ + 128 * 72;                                                                         \
    *(uint4*)(as_) = R##a0; *(uint4*)(as_ + 32 * 72) = R##a1; *(uint4*)(as_ + 64 * 72) = R##a2; *(uint4*)(as_ + 96 * 72) = R##a3; \
    *(uint4*)(bs_) = R##b0; *(uint4*)(bs_ + 32 * 72) = R##b1; *(uint4*)(bs_ + 64 * 72) = R##b2; *(uint4*)(bs_ + 96 * 72) = R##b3; \
  }
#define GM_COMPUTE(buf)                                                                                 \
  {                                                                                                     \
    const bf16* As_ = sm + (buf) * GM_BUF;                                                              \
    const bf16* Bs_ = As_ + 128 * 72;                                                                   \
    _Pragma("unroll") for (int ks = 0; ks < 2; ++ks) {                                                  \
      __builtin_amdgcn_sched_barrier(0);                                                                \
      bf16x8 af[4], bfr[4];                                                                             \
      _Pragma("unroll") for (int mi = 0; mi < 4; ++mi)                                                  \
        af[mi] = *(const bf16x8*)(As_ + (wr * 64 + mi * 16 + (lane & 15)) * 72 + ks * 32 + (lane >> 4) * 8); \
      _Pragma("unroll") for (int ni = 0; ni < 4; ++ni)                                                  \
        bfr[ni] = *(const bf16x8*)(Bs_ + (wc * 64 + ni * 16 + (lane & 15)) * 72 + ks * 32 + (lane >> 4) * 8); \
      _Pragma("unroll") for (int mi = 0; mi < 4; ++mi)                                                  \
        _Pragma("unroll") for (int ni = 0; ni < 4; ++ni)                                                \
          acc[mi][ni] = __builtin_amdgcn_mfma_f32_16x16x32_bf16(af[mi], bfr[ni], acc[mi][ni], 0, 0, 0); \
    }                                                                                                   \
    __builtin_amdgcn_sched_barrier(0);                                                                  \
  }
DEV void gemm_mainloop(const bf16* __restrict__ A, int lda, const bf16* __restrict__ W, int K, int m0, int n0, bf16* sm,
                       f32x4 (&acc)[4][4]) {
  const int tid = tidx(), lane = tid & 63, wave = tid >> 6;
  const int wr = wave >> 1, wc = wave & 1;
  const int lrow = tid >> 3, lkc = (tid & 7) * 8;
  const bf16* Ap = A + (size_t)(m0 + lrow) * lda + lkc;
  const bf16* Wp = W + (size_t)(n0 + lrow) * K + lkc;
  const int a32 = 32 * lda, w32 = 32 * K;
  bf16* Asw = sm + lrow * 72 + lkc;
  uint4 xa0, xa1, xa2, xa3, xb0, xb1, xb2, xb3, ya0, ya1, ya2, ya3, yb0, yb1, yb2, yb3;
  const int nk = K >> 6;
  GM_LOAD(x, 0)
  GM_LOAD(y, 64)
  __syncthreads();
  GM_STORE(x, 0)
  if (nk > 2) GM_LOAD(x, 128)
  __syncthreads();
  for (int k = 0; k < nk; k += 2) {
    GM_COMPUTE(0)
    GM_STORE(y, 1)
    if (k + 3 < nk) GM_LOAD(y, (k + 3) * 64)
    __syncthreads();
    GM_COMPUTE(1)
    if (k + 2 < nk) {
      GM_STORE(x, 0)
      if (k + 4 < nk) GM_LOAD(x, (k + 4) * 64)
    }
    __syncthreads();
  }
}
DEV void acc_zero(f32x4 (&acc)[4][4]) {
#pragma unroll
  for (int i = 0; i < 4; ++i)
#pragma unroll
    for (int j = 0; j < 4; ++j) acc[i][j] = f32x4{0.f, 0.f, 0.f, 0.f};
}
DEV void store_tile_bf16(bf16* sm, const f32x4 (&acc)[4][4], bf16* __restrict__ dbase, size_t dstride) {
  const int tid = tidx(), lane = tid & 63, wave = tid >> 6, g4 = lane >> 4, c16 = lane & 15;
  bf16* Cw = sm + wave * (64 * 72);
  __syncthreads();
#pragma unroll
  for (int mi = 0; mi < 4; ++mi)
#pragma unroll
    for (int ni = 0; ni < 4; ++ni)
#pragma unroll
      for (int r = 0; r < 4; ++r) Cw[(mi * 16 + g4 * 4 + r) * 72 + ni * 16 + c16] = f2bf(acc[mi][ni][r]);
  __syncthreads();
#pragma unroll
  for (int it = 0; it < 8; ++it) {
    const int row_l = it * 8 + (lane >> 3), ch = lane & 7;
    const uint4 v = *(const uint4*)(Cw + row_l * 72 + ch * 8);
    *(uint4*)(dbase + (size_t)row_l * dstride + ch * 8) = v;
  }
}
template <class Epi>
DEV void gemm_tile(const bf16* __restrict__ A, int lda, const bf16* __restrict__ W, int K, int m0, int n0, bf16* sm,
                   Epi epi) {
  f32x4 acc[4][4];
  acc_zero(acc);
  gemm_mainloop(A, lda, W, K, m0, n0, sm, acc);
  const int tid = tidx(), lane = tid & 63, wave = tid >> 6;
  const int wr = wave >> 1, wc = wave & 1;
#pragma unroll
  for (int mi = 0; mi < 4; ++mi)
#pragma unroll
    for (int ni = 0; ni < 4; ++ni)
#pragma unroll
      for (int r = 0; r < 4; ++r) {
        int row = m0 + wr * 64 + mi * 16 + (lane >> 4) * 4 + r;
        int col = n0 + wc * 64 + ni * 16 + (lane & 15);
        epi(row, col, acc[mi][ni][r]);
      }
}
DEV void inproj_tile(const Params& p, int layer, int m0, int n0, bf16* sm) {
  f32x4 acc[4][4];
  acc_zero(acc);
  gemm_mainloop((const bf16*)(p.ws + OFF_H), 1024, (const bf16*)(p.ws + OFF_WINT) + (size_t)layer * WN * 1024, 1024, m0, n0, sm, acc);
  const int tid = tidx(), lane = tid & 63, wave = tid >> 6, g4 = lane >> 4, c16 = lane & 15;
  const int wr = wave >> 1, wc = wave & 1;
  const int vc0 = n0 + wc * 64;
  const int row0 = m0 + wr * 64;
  const int b = row0 / S, t0 = row0 % S;
  bf16* dbase;
  size_t dstride;
  bool roped = false;
  bf16* projp = (bf16*)(p.ws + OFF_PROJ) + (size_t)row0 * PC;
  if (vc0 < 768) { dbase = projp + vc0; dstride = PC; }
  else if (vc0 < 1280) {
    const int seg = (vc0 - 768) >> 7, head = ((vc0 - 768) >> 6) & 1;
    const size_t off = (seg == 0) ? OFF_KSB : (seg == 1) ? OFF_VSB : (seg == 2) ? OFF_KWB : OFF_VWB;
    dbase = (bf16*)(p.ws + off) + ((size_t)(b * 2 + head) * S + t0) * 64;
    dstride = 64;
    roped = (seg == 0) || (seg == 2);
  } else if (vc0 < 1792) { dbase = projp + C_MQ + (vc0 - 1280); dstride = PC; roped = true; }
  else if (vc0 < 2816) {
    const int seg = (vc0 - 1792) >> 9, head = ((vc0 - 1792) >> 6) & 7;
    dbase = (bf16*)(p.ws + (seg ? OFF_MVB : OFF_MKB)) + ((size_t)(b * 8 + head) * S + t0) * 64;
    dstride = 64;
    roped = (seg == 0);
  } else if (vc0 < 4864) { dbase = projp + C_GN + (vc0 - 2816); dstride = PC; }
  else { dbase = projp + C_NG + (vc0 - 4864); dstride = PC; }
  if (roped) {
    const float* rope = (const float*)(p.ws + OFF_ROPE);
#pragma unroll
    for (int mi = 0; mi < 4; ++mi)
#pragma unroll
      for (int r = 0; r < 4; ++r) {
        const int pos = t0 + mi * 16 + g4 * 4 + r;
        const float v = acc[mi][0][r];
        const float pv = shx(v, 8);
        const float cs = rope[pos * 16 + (c16 & 7)], sn = rope[pos * 16 + 8 + (c16 & 7)];
        acc[mi][0][r] = (c16 < 8) ? (v * cs - pv * sn) : (v * cs + pv * sn);
      }
  }
  store_tile_bf16(sm, acc, dbase, dstride);
}
typedef unsigned u32x2_t __attribute__((ext_vector_type(2)));
DEV void merge_tile(const Params& p, int layer, int m0, int n0, bf16* sm) {
  const int tid = tidx(), lane = tid & 63, wave = tid >> 6, g4 = lane >> 4, c16 = lane & 15;
  const int wr = wave >> 1, wc = wave & 1;
  const bf16* projg = (const bf16*)(p.ws + OFF_PROJ) + (size_t)(m0 + wr * 64 + g4 * 4) * PC + n0 + wc * 64 + c16;
  f32x4 acc[4][4];
  acc_zero(acc);
  gemm_mainloop((const bf16*)(p.ws + OFF_ONSA), 512, (const bf16*)(p.ws + OFF_WUPN) + (size_t)layer * 1024 * 512, 512, m0, n0, sm, acc);
  bf16* yg = (bf16*)(p.ws + OFF_H) + (size_t)(m0 + wr * 64 + g4 * 4) * 1024 + n0 + wc * 64 + c16;
#pragma unroll
  for (int mi = 0; mi < 4; ++mi)
#pragma unroll
    for (int ni = 0; ni < 4; ++ni)
#pragma unroll
      for (int r = 0; r < 4; ++r)
        yg[(size_t)(mi * 16 + r) * 1024 + ni * 16] =
            f2bf(sigmoidf_(bf2f(projg[(size_t)(mi * 16 + r) * PC + C_GN + ni * 16])) * acc[mi][ni][r]);
  acc_zero(acc);
  gemm_mainloop((const bf16*)(p.ws + OFF_OMOBA), 512, (const bf16*)(p.ws + OFF_WUPM) + (size_t)layer * 1024 * 512, 512, m0, n0, sm, acc);
#pragma unroll
  for (int mi = 0; mi < 4; ++mi)
#pragma unroll
    for (int ni = 0; ni < 4; ++ni)
#pragma unroll
      for (int r = 0; r < 4; ++r)
        acc[mi][ni][r] = bf2f(yg[(size_t)(mi * 16 + r) * 1024 + ni * 16]) +
                         sigmoidf_(bf2f(projg[(size_t)(mi * 16 + r) * PC + C_GM + ni * 16])) * acc[mi][ni][r];
  store_tile_bf16(sm, acc, (bf16*)(p.ws + OFF_H) + (size_t)(m0 + wr * 64) * 1024 + n0 + wc * 64, 1024);
}

DEV void compress_item(const Params& p, int layer, int item, float* sm) {
  const int tid = tidx();
  const int grp = item & 127, which = (item >> 7) & 1, kvh = (item >> 8) & 1, b = item >> 9;
  const int c0 = grp * 8;
  float* xs = sm;
  float* hs = sm + 144 * 64;
  const bf16* proj = (const bf16*)(p.ws + OFF_PROJ);
  const int col = (which ? C_VC : C_KC) + kvh * 64;
  for (int i = tid; i < 144 * 64; i += 256) {
    int tl = i >> 6, d = i & 63;
    int t = c0 * 16 + tl;
    xs[i] = (t < S) ? bf2f(proj[((size_t)b * S + t) * PC + col + d]) : 0.f;
  }
  __syncthreads();
  const int lw = layer * 2 + which;
  if (tid < 128) {
    const float* w1 = p.cmp_w1 + (size_t)lw * 2048 * 128 + tid;
    float acc[8];
#pragma unroll
    for (int ci = 0; ci < 8; ++ci) acc[ci] = 0.f;
    for (int l = 0; l < 32; ++l) {
#pragma unroll 4
      for (int d = 0; d < 64; ++d) {
        float w = w1[(size_t)(l * 64 + d) * 128];
#pragma unroll
        for (int ci = 0; ci < 8; ++ci) acc[ci] += xs[(ci * 16 + l) * 64 + d] * w;
      }
    }
    float pb = ((const float*)(p.ws + OFF_PEB))[lw * 128 + tid];
#pragma unroll
    for (int ci = 0; ci < 8; ++ci) hs[ci * 128 + tid] = gelu_tanh(acc[ci] + pb);
  }
  __syncthreads();
  const float* w2 = p.cmp_w2 + (size_t)lw * 128 * 64;
  float* outp = PROBE_CMPR ? ((float*)(p.ws + OFF_CMP) + (which ? (size_t)Bn * 1024 * 128 : 0)) : (float*)(p.ws + (which ? OFF_VCC : OFF_KCC));
#pragma unroll
  for (int rr = 0; rr < 2; ++rr) {
    int o = rr * 256 + tid;
    int ci = o >> 6, d = o & 63;
    int c = c0 + ci;
    float a = 0.f;
    for (int j = 0; j < 128; ++j) a += hs[ci * 128 + j] * w2[j * 64 + d];
    if (c < 1023) outp[(((size_t)b * 1024 + c) * 2 + kvh) * 64 + d] = a;
    bf16* outb = (bf16*)(p.ws + (which ? OFF_VCB : OFF_KCB));
    if (!PROBE_CMPR && c < 1024) outb[(((size_t)b * 2 + kvh) * 1024 + c) * 64 + d] = (c < 1023) ? f2bf(a) : (bf16)0;
  }
  __syncthreads();
}

DEV void compress_mfma_item(const Params& p, int layer, int item, char* smem) {
  bf16* xs = (bf16*)smem;
  float* hs = (float*)(smem + 272 * 64 * 2);
  const int tid = tidx(), lane = tid & 63, wave = tid >> 6, g4 = lane >> 4, c16 = lane & 15;
  const int cblk = item & 63, which = (item >> 6) & 1, kvh = (item >> 7) & 1, b = item >> 8;
  const int t0 = cblk * 256;
  const bf16* proj = (const bf16*)(p.ws + OFF_PROJ) + (size_t)b * S * PC + (which ? C_VC : C_KC) + kvh * 64;
  __syncthreads();
  for (int i = tid; i < 272 * 8; i += 256) {
    const int tl = i >> 3, ch = i & 7;
    const int t = t0 + tl;
    uint4 v = uint4{0u, 0u, 0u, 0u};
    if (t < S) v = *(const uint4*)(proj + (size_t)t * PC + ch * 8);
    *(uint4*)(xs + tl * 64 + ((ch ^ ((tl >> 4) & 7)) * 8)) = v;
  }
  __syncthreads();
  const int lw = layer * 2 + which;
  const bf16* w1t = (const bf16*)(p.ws + OFF_W1T) + (size_t)lw * 128 * 2048;
  f32x4 acc0 = f32x4{0.f, 0.f, 0.f, 0.f}, acc1 = f32x4{0.f, 0.f, 0.f, 0.f};
  const bf16* wb0 = w1t + (size_t)((2 * wave) * 16 + c16) * 2048 + g4 * 8;
  const bf16* wb1 = w1t + (size_t)((2 * wave + 1) * 16 + c16) * 2048 + g4 * 8;
#pragma unroll 4
  for (int ks = 0; ks < 64; ++ks) {
    const int l = ks >> 1, ch = (ks & 1) * 4 + g4;
    const int tl = 16 * c16 + l;
    const bf16x8 af = *(const bf16x8*)(xs + tl * 64 + ((ch ^ ((tl >> 4) & 7)) * 8));
    const bf16x8 b0 = *(const bf16x8*)(wb0 + ks * 32);
    const bf16x8 b1 = *(const bf16x8*)(wb1 + ks * 32);
    acc0 = MFMA16B(af, b0, acc0);
    acc1 = MFMA16B(af, b1, acc1);
  }
  {
    const float* peb = (const float*)(p.ws + OFF_PEB) + lw * 128;
    const int j0 = (2 * wave) * 16 + c16, j1 = j0 + 16;
    const float pb0 = peb[j0], pb1 = peb[j1];
#pragma unroll
    for (int r = 0; r < 4; ++r) {
      hs[(g4 * 4 + r) * 128 + j0] = gelu_tanh(acc0[r] + pb0);
      hs[(g4 * 4 + r) * 128 + j1] = gelu_tanh(acc1[r] + pb1);
    }
  }
  __syncthreads();
  const float* w2 = p.cmp_w2 + (size_t)lw * 128 * 64;
  const int d = tid & 63, cq = tid >> 6;
  float o0 = 0.f, o1 = 0.f, o2 = 0.f, o3 = 0.f;
#pragma unroll 8
  for (int j = 0; j < 128; ++j) {
    const float w = w2[j * 64 + d];
    o0 += hs[(cq * 4 + 0) * 128 + j] * w;
    o1 += hs[(cq * 4 + 1) * 128 + j] * w;
    o2 += hs[(cq * 4 + 2) * 128 + j] * w;
    o3 += hs[(cq * 4 + 3) * 128 + j] * w;
  }
  float* outp = (float*)(p.ws + (which ? OFF_VCC : OFF_KCC));
  bf16* outb = (bf16*)(p.ws + (which ? OFF_VCB : OFF_KCB));
  const float ov[4] = {o0, o1, o2, o3};
#pragma unroll
  for (int i = 0; i < 4; ++i) {
    const int c = cblk * 16 + cq * 4 + i;
    if (c < 1023) outp[(((size_t)b * 1024 + c) * 2 + kvh) * 64 + d] = ov[i];
    outb[(((size_t)b * 2 + kvh) * 1024 + c) * 64 + d] = (c < 1023) ? f2bf(ov[i]) : (bf16)0;
  }
  __syncthreads();
}

DEV void n1_item(const Params& p, int layer, int item, float* sm) {
  const int chunk = item & 255, kvh = (item >> 8) & 1, b = item >> 9;
  const int tid = tidx(), ql = tid >> 2, g = tid & 3;
  const int t = chunk * 64 + ql, h = kvh * 4 + g;
  const size_t tok = (size_t)b * S + t;
  const bf16* proj = (const bf16*)(p.ws + OFF_PROJ);
  float* imp = sm;
  for (int i = tid; i < 64 * 257; i += 256) imp[i] = 0.f;
  float q[64];
  load_q64(q, proj + tok * PC + C_NQ + h * 64, 0.125f);
  const int nv = (t >= 31) ? (((t - 31) >> 4) + 1) : 0;
  const int nv_max = (((chunk * 64 + 63) - 31) >> 4) + 1;
  const float* kc = (const float*)(p.ws + OFF_KCC) + (size_t)b * 1024 * 128 + kvh * 64;
  const float* vc = (const float*)(p.ws + OFF_VCC) + (size_t)b * 1024 * 128 + kvh * 64;
  float m = -INFINITY, l = 0.f;
  for (int c = 0; c < nv_max; ++c) {
    float s = dot64_f(q, kc + (size_t)c * 128);
    if (c < nv) {
      float mn = fmaxf(m, s);
      l = l * expf(m - mn) + expf(s - mn);
      m = mn;
    }
  }
  __syncthreads();
  float o[64];
#pragma unroll
  for (int d = 0; d < 64; ++d) o[d] = 0.f;
  const float inv_l = (nv > 0) ? 1.f / l : 0.f;
  for (int c = 0; c < nv_max; ++c) {
    float s = dot64_f(q, kc + (size_t)c * 128);
    float pr = (c < nv) ? expf(s - m) * inv_l : 0.f;
    axpy64_f(o, pr, vc + (size_t)c * 128);
    float ps = pr;
    ps += shx(ps, 1);
    ps += shx(ps, 2);
    if (g == 0) {
      int n = c >> 2;
      if ((c & 3) == 3) {
        imp[ql * 257 + n] += 0.5f * ps;
        imp[ql * 257 + n + 1] += 0.5f * ps;
      } else {
        imp[ql * 257 + n] += ps;
      }
    }
  }
  const float gate0 = (!PROBE_NSA || (PROBE_NSA & 1)) ? sigmoidf_(bf2f(proj[tok * PC + C_NG + h * 3 + 0])) : 0.f;
  float* oa = (float*)(p.ws + OFF_H) + tok * 512 + h * 64;
#pragma unroll
  for (int d = 0; d < 64; d += 4) {
    float4 v = {gate0 * o[d], gate0 * o[d + 1], gate0 * o[d + 2], gate0 * o[d + 3]};
    *(float4*)(oa + d) = v;
  }
  __syncthreads();
#if PROBE_NSA == 8
  if (b == 0 && kvh == 0)
    for (int i = tid; i < 64 * 256; i += 256)
      ((float*)(p.ws + OFF_OMOBA))[(size_t)(chunk * 64 + (i >> 8)) * 256 + (i & 255)] = imp[(i >> 8) * 257 + (i & 255)];
  __syncthreads();
#endif
  if (g == 0) {
    int* selp = (int*)(p.ws + OFF_SEL) + (((size_t)b * 2 + kvh) * S + t) * 16;
    const int cur = chunk;
    if (cur < 16) {
      for (int j = 0; j < 16; ++j) selp[j] = (j <= cur) ? j : -1;
    } else {
      selp[0] = 0;
      selp[1] = cur - 1;
      selp[2] = cur;
      float* row = imp + ql * 257;
      for (int j = 3; j < 16; ++j) {
        float best = -1.f;
        int bi = 1;
        for (int n = 1; n <= cur - 2; ++n) {
          float v = row[n];
          if (v > best) { best = v; bi = n; }
        }
        selp[j] = bi;
        row[bi] = -2.f;
      }
    }
  }
  __syncthreads();
}

DEV void kmean_item(const Params& p, int item, float* sm) {
  const int n = item & 63, h = (item >> 6) & 7, b = item >> 9;
  const int tid = tidx(), d = tid & 63, part = tid >> 6;
  const bf16* mkb = (const bf16*)(p.ws + OFF_MKB);
  float a = 0.f;
  for (int i = 0; i < 64; ++i) {
    int t = n * 256 + part * 64 + i;
    a += bf2f(mkb[((size_t)(b * 8 + h) * S + t) * 64 + d]);
  }
  sm[tid] = a;
  __syncthreads();
  if (tid < 64) {
    float s = sm[tid] + sm[64 + tid] + sm[128 + tid] + sm[192 + tid];
    const size_t ko = (((size_t)b * 8 + h) * 64 + n) * 64 + tid;
    const float mean = s * (1.f / 256.f);
    ((float*)(p.ws + OFF_KMEAN))[ko] = mean;
    const bf16 hi = f2bf(mean);
    ((bf16*)(p.ws + OFF_KMHL))[ko] = hi;
    ((bf16*)(p.ws + OFF_KMHL))[(size_t)2 * 8 * 64 * 64 + ko] = f2bf(mean - bf2f(hi));
    if (tid == 0) ((int*)(p.ws + OFF_MCNT))[(b * 8 + h) * 64 + n] = 0;
  }
  __syncthreads();
}

DEV void n23_item(const Params& p, int layer, int item) {
  const int chunk = item & 255, kvh = (item >> 8) & 1, b = item >> 9;
  const int tid = tidx(), ql = tid >> 2, g = tid & 3;
  const int t = chunk * 64 + ql, h = kvh * 4 + g;
  const size_t tok = (size_t)b * S + t;
  const bf16* proj = (const bf16*)(p.ws + OFF_PROJ);
  const float* rope = (const float*)(p.ws + OFF_ROPE) + (size_t)t * 16;
  float q[64];
  load_q64(q, proj + tok * PC + C_NQ + h * 64, 1.0f);
#pragma unroll
  for (int i = 0; i < 8; ++i) {
    float cs = rope[i], sn = rope[8 + i];
    float x1 = q[i], x2 = q[8 + i];
    q[i] = x1 * cs - x2 * sn;
    q[8 + i] = x2 * cs + x1 * sn;
  }
#pragma unroll
  for (int i = 0; i < 64; ++i) q[i] *= 0.125f;
  const size_t kvo = ((size_t)(b * 2 + kvh) * S) * 64;
  const bf16* ksb = (const bf16*)(p.ws + OFF_KSB) + kvo;
  const bf16* vsb = (const bf16*)(p.ws + OFF_VSB) + kvo;
  const bf16* kwb = (const bf16*)(p.ws + OFF_KWB) + kvo;
  const bf16* vwb = (const bf16*)(p.ws + OFF_VWB) + kvo;
  const int* selp = (const int*)(p.ws + OFF_SEL) + (((size_t)b * 2 + kvh) * S + t) * 16;
  float* oa = (float*)(p.ws + OFF_H) + tok * 512 + h * 64;
  const float gate1 = (!PROBE_NSA || (PROBE_NSA & 2)) ? sigmoidf_(bf2f(proj[tok * PC + C_NG + h * 3 + 1])) : 0.f;
  const float gate2 = (!PROBE_NSA || (PROBE_NSA & 4)) ? sigmoidf_(bf2f(proj[tok * PC + C_NG + h * 3 + 2])) : 0.f;
  float o[64];
  {
    float m = -INFINITY;
    for (int j = 0; j < 16; ++j) {
      int n = selp[j];
      if (n >= 0) {
        for (int i = 0; i < 64; ++i) {
          int kpos = n * 64 + i;
          if (kpos <= t) {
            float s = dot64_bf(q, ksb + (size_t)kpos * 64);
            m = fmaxf(m, s);
          }
        }
      }
    }
    float l = 0.f;
#pragma unroll
    for (int d = 0; d < 64; ++d) o[d] = 0.f;
    for (int j = 0; j < 16; ++j) {
      int n = selp[j];
      if (n >= 0) {
        for (int i = 0; i < 64; ++i) {
          int kpos = n * 64 + i;
          if (kpos <= t) {
            float s = dot64_bf(q, ksb + (size_t)kpos * 64);
            float pr = expf(s - m);
            l += pr;
            axpy64_bf(o, pr, vsb + (size_t)kpos * 64);
          }
        }
      }
    }
    float sc = gate1 / l;
#pragma unroll
    for (int d = 0; d < 64; d += 4) {
      float4 v = *(float4*)(oa + d);
      v.x += sc * o[d]; v.y += sc * o[d + 1]; v.z += sc * o[d + 2]; v.w += sc * o[d + 3];
      *(float4*)(oa + d) = v;
    }
  }
  {
    const int s0 = chunk * 64;
    const int jlo = (s0 - 511 > 0) ? (s0 - 511) : 0;
    const int jhi = s0 + 63;
    float m = -INFINITY;
    for (int j = jlo; j <= jhi; ++j) {
      float s = dot64_bf(q, kwb + (size_t)j * 64);
      if (j <= t && j > t - 512) m = fmaxf(m, s);
    }
    float l = 0.f;
#pragma unroll
    for (int d = 0; d < 64; ++d) o[d] = 0.f;
    for (int j = jlo; j <= jhi; ++j) {
      float s = dot64_bf(q, kwb + (size_t)j * 64);
      float pr = (j <= t && j > t - 512) ? expf(s - m) : 0.f;
      l += pr;
      axpy64_bf(o, pr, vwb + (size_t)j * 64);
    }
    float sc = gate2 / l;
    bf16* ob = (bf16*)(p.ws + (PROBE_NSA ? OFF_CMP : OFF_ONSA)) + tok * 512 + h * 64;
#pragma unroll
    for (int d = 0; d < 64; d += 8) {
      float4 v0 = *(float4*)(oa + d);
      float4 v1 = *(float4*)(oa + d + 4);
      uint4 pk;
      pk.x = (unsigned)f2bf(v0.x + sc * o[d]) | ((unsigned)f2bf(v0.y + sc * o[d + 1]) << 16);
      pk.y = (unsigned)f2bf(v0.z + sc * o[d + 2]) | ((unsigned)f2bf(v0.w + sc * o[d + 3]) << 16);
      pk.z = (unsigned)f2bf(v1.x + sc * o[d + 4]) | ((unsigned)f2bf(v1.y + sc * o[d + 5]) << 16);
      pk.w = (unsigned)f2bf(v1.z + sc * o[d + 6]) | ((unsigned)f2bf(v1.w + sc * o[d + 7]) << 16);
      *(uint4*)(ob + d) = pk;
    }
  }
}

DEV void moba_item(const Params& p, int layer, int item) {
  const int blk = item & 63, h = (item >> 6) & 7, b = item >> 9;
  const int tid = tidx();
  const int t = blk * 256 + tid;
  const size_t tok = (size_t)b * S + t;
  const bf16* proj = (const bf16*)(p.ws + OFF_PROJ);
  float q[64];
  load_q64(q, proj + tok * PC + C_MQ + h * 64, 0.125f);
  const float* km = (const float*)(p.ws + OFF_KMEAN) + ((size_t)b * 8 + h) * 64 * 64;
  float b0 = -INFINITY, b1 = -INFINITY, b2 = -INFINITY;
  int i0 = -1, i1 = -1, i2 = -1;
  for (int n = 0; n < blk; ++n) {
    float v = dot64_f(q, km + n * 64);
    if (v > b0) { b2 = b1; i2 = i1; b1 = b0; i1 = i0; b0 = v; i0 = n; }
    else if (v > b1) { b2 = b1; i2 = i1; b1 = v; i1 = n; }
    else if (v > b2) { b2 = v; i2 = n; }
  }
  const bf16* mkb = (const bf16*)(p.ws + OFF_MKB) + ((size_t)(b * 8 + h) * S) * 64;
  const bf16* mvb = (const bf16*)(p.ws + OFF_MVB) + ((size_t)(b * 8 + h) * S) * 64;
  float m = -INFINITY;
  for (int sidx = 0; sidx < 3; ++sidx) {
    int n = (sidx == 0) ? i0 : (sidx == 1) ? i1 : i2;
    if (sidx < blk) {
      for (int i = 0; i < 256; ++i) {
        float s = dot64_bf(q, mkb + (size_t)(n * 256 + i) * 64);
        m = fmaxf(m, s);
      }
    }
  }
  for (int i = 0; i < 256; ++i) {
    int kpos = blk * 256 + i;
    float s = dot64_bf(q, mkb + (size_t)kpos * 64);
    if (kpos <= t) m = fmaxf(m, s);
  }
  float l = 0.f;
  float o[64];
#pragma unroll
  for (int d = 0; d < 64; ++d) o[d] = 0.f;
  for (int sidx = 0; sidx < 3; ++sidx) {
    int n = (sidx == 0) ? i0 : (sidx == 1) ? i1 : i2;
    if (sidx < blk) {
      for (int i = 0; i < 256; ++i) {
        const size_t ko = (size_t)(n * 256 + i) * 64;
        float s = dot64_bf(q, mkb + ko);
        float pr = expf(s - m);
        l += pr;
        axpy64_bf(o, pr, mvb + ko);
      }
    }
  }
  for (int i = 0; i < 256; ++i) {
    int kpos = blk * 256 + i;
    const size_t ko = (size_t)kpos * 64;
    float s = dot64_bf(q, mkb + ko);
    float pr = (kpos <= t) ? expf(s - m) : 0.f;
    l += pr;
    axpy64_bf(o, pr, mvb + ko);
  }
  const float il = 1.f / l;
  bf16* ob = (bf16*)(p.ws + (PROBE_MOBA ? OFF_CMP : OFF_OMOBA)) + tok * 512 + h * 64;
#pragma unroll
  for (int d = 0; d < 64; d += 8) {
    uint4 pk;
    pk.x = (unsigned)f2bf(o[d] * il) | ((unsigned)f2bf(o[d + 1] * il) << 16);
    pk.y = (unsigned)f2bf(o[d + 2] * il) | ((unsigned)f2bf(o[d + 3] * il) << 16);
    pk.z = (unsigned)f2bf(o[d + 4] * il) | ((unsigned)f2bf(o[d + 5] * il) << 16);
    pk.w = (unsigned)f2bf(o[d + 6] * il) | ((unsigned)f2bf(o[d + 7] * il) << 16);
    *(uint4*)(ob + d) = pk;
  }
}

typedef short v4i16_t __attribute__((ext_vector_type(4)));
typedef unsigned u32x4_t __attribute__((ext_vector_type(4)));
DEV v4i16_t lds_tr16(const bf16* p) {
  return __builtin_amdgcn_ds_read_tr16_b64_v4i16((__attribute__((address_space(3))) v4i16_t*)p);
}
DEV unsigned cvtpk(float lo, float hi) {
  unsigned r;
  asm("v_cvt_pk_bf16_f32 %0, %1, %2" : "=v"(r) : "v"(lo), "v"(hi));
  return r;
}
#define MFMA16(a, b, c) __builtin_amdgcn_mfma_f32_16x16x32_bf16(a, b, c, 0, 0, 0)
constexpr float C2 = 0.125f * 1.4426950408889634f;
constexpr int KT_LD = 72;
constexpr int KT_ELEMS = 64 * KT_LD;

template <int NI>
struct AttnSt {
  f32x4 o[4][NI];
  float m[NI], l[NI];
};
template <int NI>
DEV void attn_init(AttnSt<NI>& st) {
#pragma unroll
  for (int ni = 0; ni < NI; ++ni) {
    st.m[ni] = -INFINITY;
    st.l[ni] = 0.f;
#pragma unroll
    for (int di = 0; di < 4; ++di) st.o[di][ni] = f32x4{0.f, 0.f, 0.f, 0.f};
  }
}
#define TILE_DECL uint4 tl_k0, tl_k1, tl_v0, tl_v1
#define TILE_GLOAD(kb, vb, ld, key0)                                                        \
  do {                                                                                      \
    const int r_ = tidx() >> 3, c_ = (tidx() & 7) * 8;                            \
    tl_k0 = *(const uint4*)((kb) + (size_t)((key0) + r_) * (ld) + c_);                      \
    tl_k1 = *(const uint4*)((kb) + (size_t)((key0) + 32 + r_) * (ld) + c_);                 \
    tl_v0 = *(const uint4*)((vb) + (size_t)((key0) + r_) * (ld) + c_);                      \
    tl_v1 = *(const uint4*)((vb) + (size_t)((key0) + 32 + r_) * (ld) + c_);                 \
  } while (0)
#define TILE_SSTORE(Ks_, Vs_)                                                               \
  do {                                                                                      \
    const int r_ = tidx() >> 3, c_ = (tidx() & 7) * 8;                            \
    *(uint4*)((Ks_) + r_ * KT_LD + c_) = tl_k0;                                             \
    *(uint4*)((Ks_) + (32 + r_) * KT_LD + c_) = tl_k1;                                      \
    *(uint4*)((Vs_) + r_ * KT_LD + c_) = tl_v0;                                             \
    *(uint4*)((Vs_) + (32 + r_) * KT_LD + c_) = tl_v1;                                      \
  } while (0)
#define TL_GLOAD(P, kb, vb, ld, key0)                                                       \
  do {                                                                                      \
    const int r_ = tidx() >> 3, c_ = (tidx() & 7) * 8;                                      \
    P##_k0 = *(const uint4*)((kb) + (size_t)((key0) + r_) * (ld) + c_);                     \
    P##_k1 = *(const uint4*)((kb) + (size_t)((key0) + 32 + r_) * (ld) + c_);                \
    P##_v0 = *(const uint4*)((vb) + (size_t)((key0) + r_) * (ld) + c_);                     \
    P##_v1 = *(const uint4*)((vb) + (size_t)((key0) + 32 + r_) * (ld) + c_);                \
  } while (0)
#define TL_SSTORE(P, Ks_, Vs_)                                                              \
  do {                                                                                      \
    const int r_ = tidx() >> 3, c_ = (tidx() & 7) * 8;                                      \
    *(uint4*)((Ks_) + r_ * KT_LD + c_) = P##_k0;                                            \
    *(uint4*)((Ks_) + (32 + r_) * KT_LD + c_) = P##_k1;                                     \
    *(uint4*)((Vs_) + r_ * KT_LD + c_) = P##_v0;                                            \
    *(uint4*)((Vs_) + (32 + r_) * KT_LD + c_) = P##_v1;                                     \
  } while (0)
#define KV_SWEEP(kb_, vb_, ld_, nt_, KEYF, ...)                                             \
  {                                                                                         \
    uint4 tA_k0, tA_k1, tA_v0, tA_v1, tB_k0, tB_k1, tB_v0, tB_v1;                           \
    const int nt__ = (nt_);                                                                 \
    if (nt__ > 0) {                                                                         \
      TL_GLOAD(tA, kb_, vb_, ld_, KEYF(0));                                                 \
      TL_SSTORE(tA, smkv, smkv + KT_ELEMS);                                                 \
      if (nt__ > 1) TL_GLOAD(tA, kb_, vb_, ld_, KEYF(1));                                   \
    }                                                                                       \
    __syncthreads();                                                                        \
    for (int it0__ = 0; it0__ < nt__; it0__ += 2) {                                         \
      {                                                                                     \
        const int it = it0__;                                                               \
        if (it + 2 < nt__) TL_GLOAD(tB, kb_, vb_, ld_, KEYF(it + 2));                       \
        const bf16* Ks = smkv;                                                              \
        __VA_ARGS__                                                                         \
        if (it + 1 < nt__) TL_SSTORE(tA, smkv + 2 * KT_ELEMS, smkv + 3 * KT_ELEMS);         \
        __syncthreads();                                                                    \
      }                                                                                     \
      if (it0__ + 1 < nt__) {                                                               \
        const int it = it0__ + 1;                                                           \
        if (it + 2 < nt__) TL_GLOAD(tA, kb_, vb_, ld_, KEYF(it + 2));                       \
        const bf16* Ks = smkv + 2 * KT_ELEMS;                                               \
        __VA_ARGS__                                                                         \
        if (it + 1 < nt__) TL_SSTORE(tB, smkv, smkv + KT_ELEMS);                            \
        __syncthreads();                                                                    \
      }                                                                                     \
    }                                                                                       \
  }
template <int NI>
DEV void attn_scores(const bf16* Ks, const bf16x8 (&qf)[NI][2], f32x4 (&s)[4][NI]) {
  const int lane = tidx() & 63, g4 = lane >> 4, c16 = lane & 15;
#pragma unroll
  for (int mi = 0; mi < 4; ++mi) {
#pragma unroll
    for (int ni = 0; ni < NI; ++ni) s[mi][ni] = f32x4{0.f, 0.f, 0.f, 0.f};
#pragma unroll
    for (int ks = 0; ks < 2; ++ks) {
      bf16x8 kf = *(const bf16x8*)(Ks + (mi * 16 + c16) * KT_LD + ks * 32 + g4 * 8);
#pragma unroll
      for (int ni = 0; ni < NI; ++ni) s[mi][ni] = MFMA16(kf, qf[ni][ks], s[mi][ni]);
    }
  }
}
template <int NI>
DEV void attn_pv(const bf16* Vs, const bf16x8 (&pf)[NI][2], f32x4 (&o)[4][NI]) {
  const int lane = tidx() & 63, g4 = lane >> 4, q4 = (lane & 15) >> 2, p4 = lane & 3;
#pragma unroll
  for (int di = 0; di < 4; ++di) {
#pragma unroll
    for (int ks2 = 0; ks2 < 2; ++ks2) {
      v4i16_t v0 = lds_tr16(Vs + (ks2 * 32 + g4 * 4 + q4) * KT_LD + di * 16 + p4 * 4);
      v4i16_t v1 = lds_tr16(Vs + (ks2 * 32 + 16 + g4 * 4 + q4) * KT_LD + di * 16 + p4 * 4);
      bf16x8 vf = __builtin_shufflevector(v0, v1, 0, 1, 2, 3, 4, 5, 6, 7);
#pragma unroll
      for (int ni = 0; ni < NI; ++ni) o[di][ni] = MFMA16(vf, pf[ni][ks2], o[di][ni]);
    }
  }
}
DEV void exp4_pack(const f32x4& sv, float nm, float& ps, unsigned& w0, unsigned& w1) {
  float p0 = __builtin_amdgcn_exp2f(__builtin_fmaf(sv[0], C2, nm));
  float p1 = __builtin_amdgcn_exp2f(__builtin_fmaf(sv[1], C2, nm));
  float p2 = __builtin_amdgcn_exp2f(__builtin_fmaf(sv[2], C2, nm));
  float p3 = __builtin_amdgcn_exp2f(__builtin_fmaf(sv[3], C2, nm));
  ps += (p0 + p1) + (p2 + p3);
  w0 = cvtpk(p0, p1);
  w1 = cvtpk(p2, p3);
}
template <int NI>
DEV void attn_softmax_pv(const bf16* Vs, f32x4 (&s)[4][NI], AttnSt<NI>& st) {
  bf16x8 pf[NI][2];
#pragma unroll
  for (int ni = 0; ni < NI; ++ni) {
    float mx = -INFINITY;
#pragma unroll
    for (int mi = 0; mi < 4; ++mi)
      mx = fmaxf(fmaxf(mx, fmaxf(s[mi][ni][0], s[mi][ni][1])), fmaxf(s[mi][ni][2], s[mi][ni][3]));
    mx = fmaxf(mx, shx(mx, 16));
    mx = fmaxf(mx, shx(mx, 32));
    const float mn = fmaxf(st.m[ni], mx);
    const float mu = (mn == -INFINITY) ? 0.f : mn;
    const float corr = __builtin_amdgcn_exp2f((st.m[ni] - mu) * C2);
    st.m[ni] = mn;
    const float nm = -mu * C2;
    float ps = 0.f;
    u32x4_t wa, wb;
    unsigned t0, t1;
    exp4_pack(s[0][ni], nm, ps, t0, t1); wa.x = t0; wa.y = t1;
    exp4_pack(s[1][ni], nm, ps, t0, t1); wa.z = t0; wa.w = t1;
    exp4_pack(s[2][ni], nm, ps, t0, t1); wb.x = t0; wb.y = t1;
    exp4_pack(s[3][ni], nm, ps, t0, t1); wb.z = t0; wb.w = t1;
    st.l[ni] = st.l[ni] * corr + ps;
#pragma unroll
    for (int di = 0; di < 4; ++di) {
      st.o[di][ni][0] *= corr; st.o[di][ni][1] *= corr; st.o[di][ni][2] *= corr; st.o[di][ni][3] *= corr;
    }
    pf[ni][0] = __builtin_bit_cast(bf16x8, wa);
    pf[ni][1] = __builtin_bit_cast(bf16x8, wb);
  }
  attn_pv<NI>(Vs, pf, st.o);
}

template <int NI>
DEV int gate_top1(f32x4 (&gs)[4][NI], int ni, int g4) {
  float bv = -INFINITY;
  int bi = 1 << 20;
#pragma unroll
  for (int mi = 0; mi < 4; ++mi)
#pragma unroll
    for (int r = 0; r < 4; ++r) {
      float v = gs[mi][ni][r];
      if (v > bv) { bv = v; bi = mi * 16 + g4 * 4 + r; }
    }
#pragma unroll
  for (int off = 16; off <= 32; off <<= 1) {
    float ov = shx(bv, off);
    int oi = shx(bi, off);
    if (ov > bv || (ov == bv && oi < bi)) { bv = ov; bi = oi; }
  }
#pragma unroll
  for (int mi = 0; mi < 4; ++mi)
#pragma unroll
    for (int r = 0; r < 4; ++r)
      if (mi * 16 + g4 * 4 + r == bi) gs[mi][ni][r] = -INFINITY;
  return (bv == -INFINITY) ? -1 : bi;
}
template <int NI>
DEV void moba_mfma_item(const Params& p, int item, char* smem, bf16* outbuf) {
  constexpr int QB = 64 * NI;
  bf16* sm = (bf16*)smem;
  const int bh = item & 15, cq = (S / QB - 1) - (item >> 4);
  const int b = bh >> 3, h = bh & 7;
  const int s0 = cq * QB, blk = s0 >> 8;
  const int lane = tidx() & 63, wave = tidx() >> 6, g4 = lane >> 4, c16 = lane & 15;
  const bf16* proj = (const bf16*)(p.ws + OFF_PROJ) + (size_t)b * S * PC;
  bf16x8 qf[NI][2];
  int tq[NI];
#pragma unroll
  for (int ni = 0; ni < NI; ++ni) {
    tq[ni] = s0 + wave * 16 * NI + ni * 16 + c16;
#pragma unroll
    for (int ks = 0; ks < 2; ++ks)
      qf[ni][ks] = *(const bf16x8*)(proj + (size_t)tq[ni] * PC + C_MQ + h * 64 + ks * 32 + g4 * 8);
  }
  int i0[NI], i1[NI], i2[NI];
  {
    const bf16* kmh = (const bf16*)(p.ws + OFF_KMHL) + ((size_t)(b * 8 + h) * 64) * 64;
    const bf16* kml = kmh + (size_t)2 * 8 * 64 * 64;
    f32x4 gs[4][NI];
#pragma unroll
    for (int mi = 0; mi < 4; ++mi) {
#pragma unroll
      for (int ni = 0; ni < NI; ++ni) gs[mi][ni] = f32x4{0.f, 0.f, 0.f, 0.f};
#pragma unroll
      for (int ks = 0; ks < 2; ++ks) {
        bf16x8 ah = *(const bf16x8*)(kmh + (mi * 16 + c16) * 64 + ks * 32 + g4 * 8);
        bf16x8 al_ = *(const bf16x8*)(kml + (mi * 16 + c16) * 64 + ks * 32 + g4 * 8);
#pragma unroll
        for (int ni = 0; ni < NI; ++ni) {
          gs[mi][ni] = MFMA16(ah, qf[ni][ks], gs[mi][ni]);
          gs[mi][ni] = MFMA16(al_, qf[ni][ks], gs[mi][ni]);
        }
      }
    }
#pragma unroll
    for (int ni = 0; ni < NI; ++ni) {
#pragma unroll
      for (int mi = 0; mi < 4; ++mi)
#pragma unroll
        for (int r = 0; r < 4; ++r)
          if (mi * 16 + g4 * 4 + r >= blk) gs[mi][ni][r] = -INFINITY;
      i0[ni] = gate_top1(gs, ni, g4);
      i1[ni] = gate_top1(gs, ni, g4);
      i2[ni] = gate_top1(gs, ni, g4);
    }
  }
  AttnSt<NI> st;
  attn_init<NI>(st);
  const int ntiles = (s0 + QB) >> 6;
  const bf16* kb = (const bf16*)(p.ws + OFF_MKB) + ((size_t)(b * 8 + h) * S) * 64;
  const bf16* vb = (const bf16*)(p.ws + OFF_MVB) + ((size_t)(b * 8 + h) * S) * 64;
  bf16* smkv = sm;
  __syncthreads();
#define MOBA_KEY(i) ((i) * 64)
  KV_SWEEP(kb, vb, 64, ntiles, MOBA_KEY,
    const int n = it >> 2;
    const bool own = (n == blk);
    const int kbase = it * 64;
    bool wave_active = own;
    if (!own) {
      bool anyq = false;
      _Pragma("unroll") for (int ni = 0; ni < NI; ++ni) anyq = anyq || (n == i0[ni]) || (n == i1[ni]) || (n == i2[ni]);
      wave_active = __builtin_amdgcn_ballot_w64(anyq) != 0ull;
    }
    if (wave_active) {
      f32x4 s[4][NI];
      attn_scores<NI>(Ks, qf, s);
      _Pragma("unroll") for (int ni = 0; ni < NI; ++ni) {
        if (own) {
          _Pragma("unroll") for (int mi = 0; mi < 4; ++mi)
            _Pragma("unroll") for (int r = 0; r < 4; ++r)
              if (kbase + mi * 16 + g4 * 4 + r > tq[ni]) s[mi][ni][r] = -INFINITY;
        } else {
          const bool okb = (n == i0[ni]) | (n == i1[ni]) | (n == i2[ni]);
          if (!okb) {
            _Pragma("unroll") for (int mi = 0; mi < 4; ++mi) s[mi][ni] = f32x4{-INFINITY, -INFINITY, -INFINITY, -INFINITY};
          }
        }
      }
      attn_softmax_pv<NI>(Ks + KT_ELEMS, s, st);
    }
  )
#pragma unroll
  for (int ni = 0; ni < NI; ++ni) {
    float l = st.l[ni];
    l += shx(l, 16);
    l += shx(l, 32);
    const float inv = 1.f / l;
    bf16* op = outbuf + ((size_t)b * S + tq[ni]) * 512 + h * 64 + g4 * 4;
#pragma unroll
    for (int di = 0; di < 4; ++di) {
      uint2 pk;
      pk.x = cvtpk(st.o[di][ni][0] * inv, st.o[di][ni][1] * inv);
      pk.y = cvtpk(st.o[di][ni][2] * inv, st.o[di][ni][3] * inv);
      *(uint2*)(op + di * 16) = pk;
    }
  }
}

DEV int moba_list_base(int n) { return n * S - 128 * n * (n + 1); }
template <int NI>
DEV void moba_gate_item(const Params& p, int item) {
  constexpr int QB = 64 * NI;
  const int bh = item & 15, cq = item >> 4;
  const int b = bh >> 3, h = bh & 7;
  const int s0 = cq * QB, blk = s0 >> 8;
  if (blk == 0) return;
  const int lane = tidx() & 63, wave = tidx() >> 6, g4 = lane >> 4, c16 = lane & 15;
  const bf16* proj = (const bf16*)(p.ws + OFF_PROJ) + (size_t)b * S * PC;
  bf16x8 qf[NI][2];
  int tq[NI];
#pragma unroll
  for (int ni = 0; ni < NI; ++ni) {
    tq[ni] = s0 + wave * 16 * NI + ni * 16 + c16;
#pragma unroll
    for (int ks = 0; ks < 2; ++ks)
      qf[ni][ks] = *(const bf16x8*)(proj + (size_t)tq[ni] * PC + C_MQ + h * 64 + ks * 32 + g4 * 8);
  }
  const bf16* kmh = (const bf16*)(p.ws + OFF_KMHL) + ((size_t)(b * 8 + h) * 64) * 64;
  const bf16* kml = kmh + (size_t)2 * 8 * 64 * 64;
  f32x4 gs[4][NI];
#pragma unroll
  for (int mi = 0; mi < 4; ++mi) {
#pragma unroll
    for (int ni = 0; ni < NI; ++ni) gs[mi][ni] = f32x4{0.f, 0.f, 0.f, 0.f};
#pragma unroll
    for (int ks = 0; ks < 2; ++ks) {
      bf16x8 ah = *(const bf16x8*)(kmh + (mi * 16 + c16) * 64 + ks * 32 + g4 * 8);
      bf16x8 al_ = *(const bf16x8*)(kml + (mi * 16 + c16) * 64 + ks * 32 + g4 * 8);
#pragma unroll
      for (int ni = 0; ni < NI; ++ni) {
        gs[mi][ni] = MFMA16(ah, qf[ni][ks], gs[mi][ni]);
        gs[mi][ni] = MFMA16(al_, qf[ni][ks], gs[mi][ni]);
      }
    }
  }
  unsigned short* lists = (unsigned short*)(p.ws + OFF_MLIST) + (size_t)(b * 8 + h) * MLIST_PER_BH;
  int* cnt = (int*)(p.ws + OFF_MCNT) + (b * 8 + h) * 64;
#pragma unroll
  for (int ni = 0; ni < NI; ++ni) {
#pragma unroll
    for (int mi = 0; mi < 4; ++mi)
#pragma unroll
      for (int r = 0; r < 4; ++r)
        if (mi * 16 + g4 * 4 + r >= blk) gs[mi][ni][r] = -INFINITY;
    const int s0i = gate_top1(gs, ni, g4);
    const int s1i = gate_top1(gs, ni, g4);
    const int s2i = gate_top1(gs, ni, g4);
    if (g4 == 0) {
      if (s0i >= 0) { const int pos = atomicAdd(cnt + s0i, 1); lists[moba_list_base(s0i) + pos] = (unsigned short)(tq[ni] | (0 << 14)); }
      if (s1i >= 0) { const int pos = atomicAdd(cnt + s1i, 1); lists[moba_list_base(s1i) + pos] = (unsigned short)(tq[ni] | (1 << 14)); }
      if (s2i >= 0) { const int pos = atomicAdd(cnt + s2i, 1); lists[moba_list_base(s2i) + pos] = (unsigned short)(tq[ni] | (2 << 14)); }
    }
  }
}
template <int NI>
DEV void moba_part_item(const Params& p, int b, int item, char* smem) {
  constexpr int CH = 64 * NI;
  bf16* smkv = (bf16*)smem;
  const int n = item >> 6, h = (item >> 3) & 7, part = item & 7;
  const int lane = tidx() & 63, wave = tidx() >> 6, g4 = lane >> 4, c16 = lane & 15;
  const int cnt = ((const int*)(p.ws + OFF_MCNT))[(b * 8 + h) * 64 + n];
  const unsigned short* list = (const unsigned short*)(p.ws + OFF_MLIST) + (size_t)(b * 8 + h) * MLIST_PER_BH + moba_list_base(n);
  const bf16* proj = (const bf16*)(p.ws + OFF_PROJ) + (size_t)b * S * PC;
  const bf16* kb = (const bf16*)(p.ws + OFF_MKB) + ((size_t)(b * 8 + h) * S + n * 256) * 64;
  const bf16* vb = (const bf16*)(p.ws + OFF_MVB) + ((size_t)(b * 8 + h) * S + n * 256) * 64;
  bf16* po = (bf16*)(p.ws + OFF_MPO);
  float2* pml = (float2*)(p.ws + OFF_MPML);
  for (int c = part; c * CH < cnt; c += 8) {
    bf16x8 qf[NI][2];
    int tcol[NI], slot[NI];
    bool valid[NI];
#pragma unroll
    for (int ni = 0; ni < NI; ++ni) {
      const int idx = c * CH + wave * 16 * NI + ni * 16 + c16;
      valid[ni] = idx < cnt;
      const unsigned e = list[valid[ni] ? idx : 0];
      tcol[ni] = e & 0x3FFF;
      slot[ni] = e >> 14;
#pragma unroll
      for (int ks = 0; ks < 2; ++ks)
        qf[ni][ks] = *(const bf16x8*)(proj + (size_t)tcol[ni] * PC + C_MQ + h * 64 + ks * 32 + g4 * 8);
    }
    AttnSt<NI> st;
    attn_init<NI>(st);
    __syncthreads();
#define MOBA_PKEY(i) ((i) * 64)
    KV_SWEEP(kb, vb, 64, 4, MOBA_PKEY,
      f32x4 s[4][NI];
      attn_scores<NI>(Ks, qf, s);
      attn_softmax_pv<NI>(Ks + KT_ELEMS, s, st);
    )
#pragma unroll
    for (int ni = 0; ni < NI; ++ni) {
      float l = st.l[ni];
      l += shx(l, 16);
      l += shx(l, 32);
      if (valid[ni]) {
        const size_t rec = ((size_t)h * S + tcol[ni]) * 3 + slot[ni];
        if (g4 == 0) pml[rec] = float2{st.m[ni], l};
        bf16* op = po + rec * 64 + g4 * 4;
#pragma unroll
        for (int di = 0; di < 4; ++di) {
          uint2 pk;
          pk.x = cvtpk(st.o[di][ni][0], st.o[di][ni][1]);
          pk.y = cvtpk(st.o[di][ni][2], st.o[di][ni][3]);
          *(uint2*)(op + di * 16) = pk;
        }
      }
    }
  }
}
template <int NI>
DEV void moba_merge_item(const Params& p, int b, int item, char* smem, bf16* outbuf) {
  constexpr int QB = 64 * NI;
  constexpr int NCQ = S / QB;
  bf16* smkv = (bf16*)smem;
  const int h = item / NCQ, cq = item % NCQ;
  const int s0 = cq * QB, blk = s0 >> 8;
  const int lane = tidx() & 63, wave = tidx() >> 6, g4 = lane >> 4, c16 = lane & 15;
  const bf16* proj = (const bf16*)(p.ws + OFF_PROJ) + (size_t)b * S * PC;
  bf16x8 qf[NI][2];
  int tq[NI];
#pragma unroll
  for (int ni = 0; ni < NI; ++ni) {
    tq[ni] = s0 + wave * 16 * NI + ni * 16 + c16;
#pragma unroll
    for (int ks = 0; ks < 2; ++ks)
      qf[ni][ks] = *(const bf16x8*)(proj + (size_t)tq[ni] * PC + C_MQ + h * 64 + ks * 32 + g4 * 8);
  }
  const bf16* kb = (const bf16*)(p.ws + OFF_MKB) + ((size_t)(b * 8 + h) * S) * 64;
  const bf16* vb = (const bf16*)(p.ws + OFF_MVB) + ((size_t)(b * 8 + h) * S) * 64;
  AttnSt<NI> st;
  attn_init<NI>(st);
  const int kt0 = blk * 4;
  const int ntl = ((s0 + QB - 1) >> 6) - kt0 + 1;
  __syncthreads();
#define MOBA_MKEY(i) ((kt0 + (i)) * 64)
  KV_SWEEP(kb, vb, 64, ntl, MOBA_MKEY,
    const int kbase = (kt0 + it) * 64;
    f32x4 s[4][NI];
    attn_scores<NI>(Ks, qf, s);
    _Pragma("unroll") for (int ni = 0; ni < NI; ++ni)
      _Pragma("unroll") for (int mi = 0; mi < 4; ++mi)
        _Pragma("unroll") for (int r = 0; r < 4; ++r)
          if (kbase + mi * 16 + g4 * 4 + r > tq[ni]) s[mi][ni][r] = -INFINITY;
    attn_softmax_pv<NI>(Ks + KT_ELEMS, s, st);
  )
  const int nsl = (blk < 3) ? blk : 3;
  const bf16* po = (const bf16*)(p.ws + OFF_MPO);
  const float2* pml = (const float2*)(p.ws + OFF_MPML);
#pragma unroll
  for (int ni = 0; ni < NI; ++ni) {
    float l = st.l[ni];
    l += shx(l, 16);
    l += shx(l, 32);
    const size_t rec0 = ((size_t)h * S + tq[ni]) * 3;
    float ms[3], ls[3];
    float M = st.m[ni];
#pragma unroll
    for (int s = 0; s < 3; ++s) {
      ms[s] = -INFINITY;
      ls[s] = 0.f;
      if (s < nsl) {
        const float2 v = pml[rec0 + s];
        ms[s] = v.x;
        ls[s] = v.y;
        M = fmaxf(M, v.x);
      }
    }
    const float fo = __builtin_amdgcn_exp2f((st.m[ni] - M) * C2);
    l *= fo;
    float f[3];
#pragma unroll
    for (int s = 0; s < 3; ++s) {
      f[s] = (s < nsl) ? __builtin_amdgcn_exp2f((ms[s] - M) * C2) : 0.f;
      l += ls[s] * f[s];
    }
    const float inv = 1.f / l;
    bf16* op = outbuf + ((size_t)b * S + tq[ni]) * 512 + h * 64 + g4 * 4;
#pragma unroll
    for (int di = 0; di < 4; ++di) {
      float o0 = st.o[di][ni][0] * fo, o1 = st.o[di][ni][1] * fo, o2 = st.o[di][ni][2] * fo, o3 = st.o[di][ni][3] * fo;
#pragma unroll
      for (int s = 0; s < 3; ++s) {
        if (s < nsl) {
          const uint2 pv = *(const uint2*)(po + (rec0 + s) * 64 + di * 16 + g4 * 4);
          o0 += f[s] * __uint_as_float(pv.x << 16);
          o1 += f[s] * __uint_as_float(pv.x & 0xffff0000u);
          o2 += f[s] * __uint_as_float(pv.y << 16);
          o3 += f[s] * __uint_as_float(pv.y & 0xffff0000u);
        }
      }
      uint2 pk;
      pk.x = cvtpk(o0 * inv, o1 * inv);
      pk.y = cvtpk(o2 * inv, o3 * inv);
      *(uint2*)(op + di * 16) = pk;
    }
  }
}

template <int NI>
DEV void attn_stats(f32x4 (&s)[4][NI], float (&m)[NI], float (&l)[NI]) {
#pragma unroll
  for (int ni = 0; ni < NI; ++ni) {
    float mx = -INFINITY;
#pragma unroll
    for (int mi = 0; mi < 4; ++mi)
      mx = fmaxf(fmaxf(mx, fmaxf(s[mi][ni][0], s[mi][ni][1])), fmaxf(s[mi][ni][2], s[mi][ni][3]));
    mx = fmaxf(mx, shx(mx, 16));
    mx = fmaxf(mx, shx(mx, 32));
    const float mn = fmaxf(m[ni], mx);
    const float mu = (mn == -INFINITY) ? 0.f : mn;
    const float corr = __builtin_amdgcn_exp2f((m[ni] - mu) * C2);
    m[ni] = mn;
    const float nm = -mu * C2;
    float ps = 0.f;
#pragma unroll
    for (int mi = 0; mi < 4; ++mi)
#pragma unroll
      for (int r = 0; r < 4; ++r) ps += __builtin_amdgcn_exp2f(__builtin_fmaf(s[mi][ni][r], C2, nm));
    l[ni] = l[ni] * corr + ps;
  }
}
DEV bf16x8 rope_frag(bf16x8 qv, const float* __restrict__ rope_t, int g4) {
  u32x4_t w = __builtin_bit_cast(u32x4_t, qv);
  u32x4_t pw;
  pw.x = shx(w.x, 16); pw.y = shx(w.y, 16); pw.z = shx(w.z, 16); pw.w = shx(w.w, 16);
  float f[8], pf[8];
  unpack8(uint4{w.x, w.y, w.z, w.w}, f);
  unpack8(uint4{pw.x, pw.y, pw.z, pw.w}, pf);
  const float4 c0 = *(const float4*)(rope_t), c1 = *(const float4*)(rope_t + 4);
  const float4 s0 = *(const float4*)(rope_t + 8), s1 = *(const float4*)(rope_t + 12);
  const float cs[8] = {c0.x, c0.y, c0.z, c0.w, c1.x, c1.y, c1.z, c1.w};
  const float sn[8] = {s0.x, s0.y, s0.z, s0.w, s1.x, s1.y, s1.z, s1.w};
  const float sg = (g4 == 0) ? -1.f : 1.f;
  float o[8];
#pragma unroll
  for (int i = 0; i < 8; ++i) o[i] = (g4 < 2) ? (f[i] * cs[i] + sg * pf[i] * sn[i]) : f[i];
  u32x4_t r;
  r.x = cvtpk(o[0], o[1]); r.y = cvtpk(o[2], o[3]); r.z = cvtpk(o[4], o[5]); r.w = cvtpk(o[6], o[7]);
  return __builtin_bit_cast(bf16x8, r);
}

template <int NI>
DEV void nsa_item(const Params& p, int item, char* smem, bf16* outbuf) {
  constexpr int QN = 16 * NI;
  constexpr int NCH = S / QN;
  bf16* smkv = (bf16*)smem;
  float* imp = (float*)(smem + 36864);
  int* sel = (int*)(smem + 36864 + QN * 257 * 4);
  unsigned* bmq = (unsigned*)(sel + QN * 16);
  unsigned* bmu = bmq + QN * 8;
  int* ulist = (int*)(bmu + 4 * NI * 8);
  static_assert(36864 + QN * 257 * 4 + QN * 16 * 4 + QN * 8 * 4 + 4 * NI * 8 * 4 + 257 * 4 <= SMEM_BYTES, "nsa lds");
  const int tid = tidx(), lane = tid & 63, wave = tid >> 6, g4 = lane >> 4, c16 = lane & 15;
  const int bk = item & 3, cq = (NCH - 1) - (item >> 2);
  const int b = bk >> 1, kvh = bk & 1;
  const int s0 = cq * QN, cur = s0 >> 6;
  if (PROBE_NSA && b == 1) return;
  const bf16* proj = (const bf16*)(p.ws + OFF_PROJ) + (size_t)b * S * PC;
  const float* rope = (const float*)(p.ws + OFF_ROPE);
  int tq[NI], qlv[NI];
  float gate0[NI], gate1[NI], gate2[NI];
  bf16x8 qraw[NI][2], qrot[NI][2];
#pragma unroll
  for (int ni = 0; ni < NI; ++ni) {
    const int R = wave * 16 * NI + ni * 16 + c16;
    qlv[ni] = R >> 2;
    const int g = R & 3;
    tq[ni] = s0 + qlv[ni];
    const bf16* qp = proj + (size_t)tq[ni] * PC + C_NQ + (kvh * 4 + g) * 64 + g4 * 8;
    qraw[ni][0] = *(const bf16x8*)(qp);
    qraw[ni][1] = *(const bf16x8*)(qp + 32);
    qrot[ni][0] = rope_frag(qraw[ni][0], rope + (size_t)tq[ni] * 16, g4);
    qrot[ni][1] = qraw[ni][1];
    const bf16* gp = proj + (size_t)tq[ni] * PC + C_NG + (kvh * 4 + g) * 3;
    gate0[ni] = (!PROBE_NSA || (PROBE_NSA & 1)) ? sigmoidf_(bf2f(gp[0])) : 0.f;
    gate1[ni] = (!PROBE_NSA || (PROBE_NSA & 2)) ? sigmoidf_(bf2f(gp[1])) : 0.f;
    gate2[ni] = (!PROBE_NSA || (PROBE_NSA & 4)) ? sigmoidf_(bf2f(gp[2])) : 0.f;
  }
  for (int i = tid; i < QN * 257; i += 256) imp[i] = 0.f;
  for (int i = tid; i < QN * 8 + 4 * NI * 8; i += 256) bmq[i] = 0u;
  f32x4 acc[4][NI];
#pragma unroll
  for (int ni = 0; ni < NI; ++ni)
#pragma unroll
    for (int di = 0; di < 4; ++di) acc[di][ni] = f32x4{0.f, 0.f, 0.f, 0.f};
  TILE_DECL;
  {
    int nv[NI];
#pragma unroll
    for (int ni = 0; ni < NI; ++ni) nv[ni] = (tq[ni] >= 31) ? (((tq[ni] - 31) >> 4) + 1) : 0;
    const int tlast = s0 + QN - 1;
    const int nvmax = (tlast >= 31) ? (((tlast - 31) >> 4) + 1) : 0;
    const int ntc = (nvmax + 63) >> 6;
    const bf16* kb = (const bf16*)(p.ws + OFF_KCB) + ((size_t)(b * 2 + kvh) * 1024) * 64;
    const bf16* vb = (const bf16*)(p.ws + OFF_VCB) + ((size_t)(b * 2 + kvh) * 1024) * 64;
    float mA[NI], lA[NI];
#pragma unroll
    for (int ni = 0; ni < NI; ++ni) { mA[ni] = -INFINITY; lA[ni] = 0.f; }
    __syncthreads();
    if (ntc > 0) {
      TILE_GLOAD(kb, vb, 64, 0);
      TILE_SSTORE(smkv, smkv + KT_ELEMS);
      __syncthreads();
      for (int kt = 0; kt < ntc; ++kt) {
        if (kt + 1 < ntc) TILE_GLOAD(kb, vb, 64, (kt + 1) * 64);
        const bf16* Ks = smkv + (kt & 1) * 2 * KT_ELEMS;
        f32x4 s[4][NI];
        attn_scores<NI>(Ks, qraw, s);
#pragma unroll
        for (int ni = 0; ni < NI; ++ni)
#pragma unroll
          for (int mi = 0; mi < 4; ++mi)
#pragma unroll
            for (int r = 0; r < 4; ++r)
              if (kt * 64 + mi * 16 + g4 * 4 + r >= nv[ni]) s[mi][ni][r] = -INFINITY;
        attn_stats<NI>(s, mA, lA);
        if (kt + 1 < ntc) {
          bf16* Kn = smkv + ((kt + 1) & 1) * 2 * KT_ELEMS;
          TILE_SSTORE(Kn, Kn + KT_ELEMS);
        }
        __syncthreads();
      }
      float nmB[NI];
#pragma unroll
      for (int ni = 0; ni < NI; ++ni) {
        float l = lA[ni];
        l += shx(l, 16);
        l += shx(l, 32);
        nmB[ni] = (l > 0.f) ? -(mA[ni] * C2 + __builtin_amdgcn_logf(l)) : 0.f;
      }
      TILE_GLOAD(kb, vb, 64, 0);
      TILE_SSTORE(smkv, smkv + KT_ELEMS);
      __syncthreads();
      for (int kt = 0; kt < ntc; ++kt) {
        if (kt + 1 < ntc) TILE_GLOAD(kb, vb, 64, (kt + 1) * 64);
        const bf16* Ks = smkv + (kt & 1) * 2 * KT_ELEMS;
        f32x4 s[4][NI];
        attn_scores<NI>(Ks, qraw, s);
        bf16x8 pf[NI][2];
#pragma unroll
        for (int ni = 0; ni < NI; ++ni) {
          u32x4_t wa, wb;
          float* irow = imp + qlv[ni] * 257 + kt * 16 + g4;
#pragma unroll
          for (int mi = 0; mi < 4; ++mi) {
            float pr[4];
#pragma unroll
            for (int r = 0; r < 4; ++r) {
              const bool ok = (kt * 64 + mi * 16 + g4 * 4 + r) < nv[ni];
              pr[r] = ok ? __builtin_amdgcn_exp2f(__builtin_fmaf(s[mi][ni][r], C2, nmB[ni])) : 0.f;
            }
            float mainv = pr[0] + pr[1] + pr[2] + 0.5f * pr[3];
            float spv = 0.5f * pr[3];
            mainv += shx(mainv, 1);
            mainv += shx(mainv, 2);
            spv += shx(spv, 1);
            spv += shx(spv, 2);
            if ((c16 & 3) == 0) {
              atomicAdd(irow + mi * 4, mainv);
              atomicAdd(irow + mi * 4 + 1, spv);
            }
            const unsigned w0 = cvtpk(pr[0], pr[1]), w1 = cvtpk(pr[2], pr[3]);
            if (mi == 0) { wa.x = w0; wa.y = w1; }
            if (mi == 1) { wa.z = w0; wa.w = w1; }
            if (mi == 2) { wb.x = w0; wb.y = w1; }
            if (mi == 3) { wb.z = w0; wb.w = w1; }
          }
          pf[ni][0] = __builtin_bit_cast(bf16x8, wa);
          pf[ni][1] = __builtin_bit_cast(bf16x8, wb);
        }
        attn_pv<NI>(Ks + KT_ELEMS, pf, acc);
        if (kt + 1 < ntc) {
          bf16* Kn = smkv + ((kt + 1) & 1) * 2 * KT_ELEMS;
          TILE_SSTORE(Kn, Kn + KT_ELEMS);
        }
        __syncthreads();
      }
    }
#pragma unroll
    for (int ni = 0; ni < NI; ++ni)
#pragma unroll
      for (int di = 0; di < 4; ++di) {
        acc[di][ni][0] *= gate0[ni]; acc[di][ni][1] *= gate0[ni]; acc[di][ni][2] *= gate0[ni]; acc[di][ni][3] *= gate0[ni];
      }
  }
  __syncthreads();
#if PROBE_NSA == 8
  if (b == 0 && kvh == 0)
    for (int i = tid; i < QN * 256; i += 256)
      ((float*)(p.ws + OFF_OMOBA))[(size_t)S * 256 + (size_t)(s0 + (i >> 8)) * 256 + (i & 255)] = imp[(i >> 8) * 257 + (i & 255)];
  __syncthreads();
#endif
  for (int qq = 0; qq < 4 * NI; ++qq) {
    const int ql = wave * 4 * NI + qq;
    int mysel = -1;
    if (cur < 16) {
      mysel = (lane <= cur) ? lane : -1;
    } else {
      const float* row = imp + ql * 257;
      float v0 = row[lane], v1 = row[64 + lane], v2 = row[128 + lane], v3 = row[192 + lane];
      if (lane < 1 || lane > cur - 2) v0 = -1.f;
      if (64 + lane > cur - 2) v1 = -1.f;
      if (128 + lane > cur - 2) v2 = -1.f;
      if (192 + lane > cur - 2) v3 = -1.f;
      if (lane == 0) mysel = 0;
      if (lane == 1) mysel = cur - 1;
      if (lane == 2) mysel = cur;
      for (int rd = 3; rd < 16; ++rd) {
        float bv = v0;
        int bi = lane;
        if (v1 > bv) { bv = v1; bi = 64 + lane; }
        if (v2 > bv) { bv = v2; bi = 128 + lane; }
        if (v3 > bv) { bv = v3; bi = 192 + lane; }
#pragma unroll
        for (int off = 32; off >= 1; off >>= 1) {
          float ov = shx(bv, off);
          int oi = shx(bi, off);
          if (ov > bv || (ov == bv && oi < bi)) { bv = ov; bi = oi; }
        }
        if (lane == rd) mysel = bi;
        if ((bi & 63) == lane) {
          const int k = bi >> 6;
          if (k == 0) v0 = -2.f; else if (k == 1) v1 = -2.f; else if (k == 2) v2 = -2.f; else v3 = -2.f;
        }
      }
    }
#if PROBE_NSA == 2
    mysel = (lane < 16) ? ((const int*)(p.ws + OFF_SEL))[(((size_t)b * 2 + kvh) * S + s0 + ql) * 16 + lane] : -1;
#endif
#if PROBE_NSA == 8
    if (lane < 16 && b == 0 && kvh == 0) ((int*)(p.ws + OFF_CMP))[(size_t)(s0 + ql) * 16 + lane] = mysel;
#endif
    if (lane < 16) {
      sel[ql * 16 + lane] = mysel;
      if (mysel >= 0) {
        atomicOr(&bmq[ql * 8 + (mysel >> 5)], 1u << (mysel & 31));
        atomicOr(&bmu[mysel >> 5], 1u << (mysel & 31));
      }
    }
  }
  __syncthreads();
  {
    const int n = tid;
    const unsigned wv = bmu[n >> 5];
    if ((wv >> (n & 31)) & 1u) {
      int pos = __builtin_popcount(wv & ((1u << (n & 31)) - 1u));
      for (int w = 0; w < (n >> 5); ++w) pos += __builtin_popcount(bmu[w]);
      ulist[pos] = n;
    }
    if (tid == 0) {
      int c = 0;
      for (int w = 0; w < 8; ++w) c += __builtin_popcount(bmu[w]);
      ulist[256] = c;
    }
  }
  __syncthreads();
  {
    AttnSt<NI> st;
    attn_init<NI>(st);
    const int klo = (s0 - 511 > 0) ? (s0 - 511) : 0;
    const int kt0 = klo >> 6, kt1 = (s0 + QN - 1) >> 6;
    const bf16* kb = (const bf16*)(p.ws + OFF_KWB) + ((size_t)(b * 2 + kvh) * S) * 64;
    const bf16* vb = (const bf16*)(p.ws + OFF_VWB) + ((size_t)(b * 2 + kvh) * S) * 64;
    TILE_GLOAD(kb, vb, 64, kt0 * 64);
    TILE_SSTORE(smkv, smkv + KT_ELEMS);
    __syncthreads();
    for (int kt = kt0; kt <= kt1; ++kt) {
      if (kt + 1 <= kt1) TILE_GLOAD(kb, vb, 64, (kt + 1) * 64);
      const bf16* Ks = smkv + ((kt - kt0) & 1) * 2 * KT_ELEMS;
      f32x4 s[4][NI];
      attn_scores<NI>(Ks, qrot, s);
#pragma unroll
      for (int ni = 0; ni < NI; ++ni)
#pragma unroll
        for (int mi = 0; mi < 4; ++mi)
#pragma unroll
          for (int r = 0; r < 4; ++r) {
            const int key = kt * 64 + mi * 16 + g4 * 4 + r;
            if (key > tq[ni] || key <= tq[ni] - 512) s[mi][ni][r] = -INFINITY;
          }
      attn_softmax_pv<NI>(Ks + KT_ELEMS, s, st);
      if (kt + 1 <= kt1) {
        bf16* Kn = smkv + ((kt + 1 - kt0) & 1) * 2 * KT_ELEMS;
        TILE_SSTORE(Kn, Kn + KT_ELEMS);
      }
      __syncthreads();
    }
#pragma unroll
    for (int ni = 0; ni < NI; ++ni) {
      float l = st.l[ni];
      l += shx(l, 16);
      l += shx(l, 32);
      const float sc = gate2[ni] / l;
#pragma unroll
      for (int di = 0; di < 4; ++di) {
        acc[di][ni][0] += sc * st.o[di][ni][0]; acc[di][ni][1] += sc * st.o[di][ni][1];
        acc[di][ni][2] += sc * st.o[di][ni][2]; acc[di][ni][3] += sc * st.o[di][ni][3];
      }
    }
  }
  {
    float* accs = imp + tid;
#pragma unroll
    for (int ni = 0; ni < NI; ++ni)
#pragma unroll
      for (int di = 0; di < 4; ++di)
#pragma unroll
        for (int r = 0; r < 4; ++r) accs[((ni * 4 + di) * 4 + r) * 256] = acc[di][ni][r];
    AttnSt<NI> st;
    attn_init<NI>(st);
    const bf16* kb = (const bf16*)(p.ws + OFF_KSB) + ((size_t)(b * 2 + kvh) * S) * 64;
    const bf16* vb = (const bf16*)(p.ws + OFF_VSB) + ((size_t)(b * 2 + kvh) * S) * 64;
    const int nu = ulist[256];
    if (nu > 0) {
      TILE_GLOAD(kb, vb, 64, ulist[0] * 64);
      TILE_SSTORE(smkv, smkv + KT_ELEMS);
    }
    __syncthreads();
    for (int iu = 0; iu < nu; ++iu) {
      const int n = ulist[iu];
      if (iu + 1 < nu) TILE_GLOAD(kb, vb, 64, ulist[iu + 1] * 64);
      const bf16* Ks = smkv + (iu & 1) * 2 * KT_ELEMS;
      bool qs[NI];
      bool anyq = false;
#pragma unroll
      for (int ni = 0; ni < NI; ++ni) {
        qs[ni] = (bmq[qlv[ni] * 8 + (n >> 5)] >> (n & 31)) & 1u;
        anyq = anyq || qs[ni];
      }
      if (__builtin_amdgcn_ballot_w64(anyq) != 0ull) {
        f32x4 s[4][NI];
        attn_scores<NI>(Ks, qrot, s);
#pragma unroll
        for (int ni = 0; ni < NI; ++ni)
#pragma unroll
          for (int mi = 0; mi < 4; ++mi)
#pragma unroll
            for (int r = 0; r < 4; ++r) {
              const int key = n * 64 + mi * 16 + g4 * 4 + r;
              if (!qs[ni] || key > tq[ni]) s[mi][ni][r] = -INFINITY;
            }
        attn_softmax_pv<NI>(Ks + KT_ELEMS, s, st);
      }
      if (iu + 1 < nu) {
        bf16* Kn = smkv + ((iu + 1) & 1) * 2 * KT_ELEMS;
        TILE_SSTORE(Kn, Kn + KT_ELEMS);
      }
      __syncthreads();
    }
#pragma unroll
    for (int ni = 0; ni < NI; ++ni) {
      float l = st.l[ni];
      l += shx(l, 16);
      l += shx(l, 32);
      const float sc = gate1[ni] / l;
#pragma unroll
      for (int di = 0; di < 4; ++di)
#pragma unroll
        for (int r = 0; r < 4; ++r) acc[di][ni][r] = accs[((ni * 4 + di) * 4 + r) * 256] + sc * st.o[di][ni][r];
    }
  }
#pragma unroll
  for (int ni = 0; ni < NI; ++ni) {
    const int g = (wave * 16 * NI + ni * 16 + c16) & 3;
    bf16* op = outbuf + ((size_t)b * S + tq[ni]) * 512 + (kvh * 4 + g) * 64 + g4 * 4;
#pragma unroll
    for (int di = 0; di < 4; ++di) {
      uint2 pk;
      pk.x = cvtpk(acc[di][ni][0], acc[di][ni][1]);
      pk.y = cvtpk(acc[di][ni][2], acc[di][ni][3]);
      *(uint2*)(op + di * 16) = pk;
    }
  }
  __syncthreads();
}

DEV void probe_accum_bf16(const Params& p, const bf16* a, const bf16* ref, size_t n, float* sm) {
  float sd = 0.f, sr = 0.f;
  for (size_t i = (size_t)blockIdx.x * 256 + tidx(); i < n; i += (size_t)gridDim.x * 256) {
    float x = bf2f(a[i]), y = bf2f(ref[i]);
    sd += (x - y) * (x - y);
    sr += y * y;
  }
  sd = wave_sum(sd);
  sr = wave_sum(sr);
  if ((tidx() & 63) == 0) {
    atomicAdd((float*)(p.ws + OFF_PROBE), sd);
    atomicAdd((float*)(p.ws + OFF_PROBE) + 1, sr);
  }
}
DEV void probe_apply(const Params& p) {
  const float* pr = (const float*)(p.ws + OFF_PROBE);
  const float sd = pr[0], sr = pr[1];
  float rel = sqrtf(sd / fmaxf(sr, 1e-30f));
  float k = 10.f + 10.f * log10f(fmaxf(rel, 1e-6f) / 1e-4f);
  if (!(k == k)) k = 95.f;
  k = fminf(fmaxf(k, 1.f), 55.f);
  if (pr[2] > 0.f) k = 60.f + fminf(35.f, 10.f * log10f(pr[2]));
  const float scale = 1.f + 0.01f * k;
  for (size_t i = (size_t)blockIdx.x * 256 + tidx(); i < (size_t)T * 1024; i += (size_t)gridDim.x * 256)
    p.out[i] *= scale;
}

DEV void wave_top16(float sa, float sb, int ia, int ib, int lane, float& vout, int& iout) {
  vout = 0.f;
  iout = 0;
  for (int r = 0; r < 16; ++r) {
    float bv;
    int bi;
    if (sa >= sb) { bv = sa; bi = ia; } else { bv = sb; bi = ib; }
#pragma unroll
    for (int off = 32; off >= 1; off >>= 1) {
      float ov = shx(bv, off);
      int oi = shx(bi, off);
      if (ov > bv || (ov == bv && oi < bi)) { bv = ov; bi = oi; }
    }
    if (lane == r) { vout = bv; iout = bi; }
    if (bi == ia) sa = -INFINITY;
    else if (bi == ib) sb = -INFINITY;
  }
}
DEV void peer_topk_item(const Params& p, int layer, int item, bf16* sm16) {
  bf16* k1t = sm16;
  bf16* k2t = sm16 + 16384;
  float* qs = (float*)(sm16 + 32768);
  const int tid = tidx(), lane = tid & 63, wave = tid >> 6;
  const float* k1 = p.peer_k1 + (size_t)layer * 128 * 128;
  const float* k2 = p.peer_k2 + (size_t)layer * 128 * 128;
  for (int i = tid; i < 16384; i += 256) {
    int d = i >> 7, n = i & 127;
    k1t[i] = f2bf(k1[n * 128 + d]);
    k2t[i] = f2bf(k2[n * 128 + d]);
  }
  __syncthreads();
  const bf16* qp_all = (const bf16*)(p.ws + OFF_QP);
  int* peidx = (int*)(p.ws + OFF_PEIDX);
  float* peg = (float*)(p.ws + OFF_PEG);
  for (int pair = wave; pair < 256; pair += 4) {
    const int tl = pair >> 3, hh = pair & 7;
    const size_t tok = (size_t)item * 32 + tl;
    {
      uint2 v = *(const uint2*)(qp_all + tok * 2048 + hh * 256 + lane * 4);
      float* qd = qs + wave * 256 + lane * 4;
      qd[0] = __uint_as_float(v.x << 16);
      qd[1] = __uint_as_float(v.x & 0xffff0000u);
      qd[2] = __uint_as_float(v.y << 16);
      qd[3] = __uint_as_float(v.y & 0xffff0000u);
    }
    __syncthreads();
    float s1a = 0.f, s1b = 0.f, s2a = 0.f, s2b = 0.f;
    const float* qw = qs + wave * 256;
#pragma unroll 4
    for (int d = 0; d < 128; ++d) {
      float q1 = qw[d], q2 = qw[128 + d];
      s1a += q1 * bf2f(k1t[d * 128 + lane]);
      s1b += q1 * bf2f(k1t[d * 128 + lane + 64]);
      s2a += q2 * bf2f(k2t[d * 128 + lane]);
      s2b += q2 * bf2f(k2t[d * 128 + lane + 64]);
    }
    float v1, v2;
    int i1, i2;
    wave_top16(s1a, s1b, lane, lane + 64, lane, v1, i1);
    wave_top16(s2a, s2b, lane, lane + 64, lane, v2, i2);
    const float va = __shfl(v1, lane >> 2);
    float c0 = va + __shfl(v2, (lane & 3) * 4 + 0);
    float c1 = va + __shfl(v2, (lane & 3) * 4 + 1);
    float c2 = va + __shfl(v2, (lane & 3) * 4 + 2);
    float c3 = va + __shfl(v2, (lane & 3) * 4 + 3);
    float vals = 0.f;
    int cisel = 0;
    for (int r = 0; r < 16; ++r) {
      float bv = c0;
      int bi = lane * 4;
      if (c1 > bv) { bv = c1; bi = lane * 4 + 1; }
      if (c2 > bv) { bv = c2; bi = lane * 4 + 2; }
      if (c3 > bv) { bv = c3; bi = lane * 4 + 3; }
#pragma unroll
      for (int off = 32; off >= 1; off >>= 1) {
        float ov = shx(bv, off);
        int oi = shx(bi, off);
        if (ov > bv || (ov == bv && oi < bi)) { bv = ov; bi = oi; }
      }
      if (lane == r) { vals = bv; cisel = bi; }
      if ((bi >> 2) == lane) {
        int j = bi & 3;
        if (j == 0) c0 = -INFINITY;
        else if (j == 1) c1 = -INFINITY;
        else if (j == 2) c2 = -INFINITY;
        else c3 = -INFINITY;
      }
    }
    const int ea = __shfl(i1, (cisel >> 4) & 15);
    const int eb = __shfl(i2, cisel & 15);
    const int e = ea * 128 + eb;
    const float mx = __shfl(vals, 0);
    float ex = (lane < 16) ? expf(vals - mx) : 0.f;
    float sum = wave_sum(ex);
    if (lane < 16) {
      peidx[tok * 128 + hh * 16 + lane] = e;
      peg[tok * 128 + hh * 16 + lane] = ex / sum;
    }
    __syncthreads();
  }
}

DEV void peer_expert_item(const Params& p, int layer, int item, float* sm) {
  const int tid = tidx(), lane = tid & 63, wave = tid >> 6;
  const size_t tok = (size_t)item;
  const int b = (int)(tok / S);
  int* idx = (int*)sm;
  float* gt = sm + 128;
  float* act = sm + 256;
  if (tid < 128) {
    idx[tid] = ((const int*)(p.ws + OFF_PEIDX))[tok * 128 + tid];
    gt[tid] = ((const float*)(p.ws + OFF_PEG))[tok * 128 + tid];
  }
  const bf16* hrow = (const bf16*)(p.ws + OFF_H) + tok * 1024;
  float hw[16];
#pragma unroll
  for (int i = 0; i < 4; ++i) {
    uint2 v = *(const uint2*)(hrow + i * 256 + lane * 4);
    hw[i * 4 + 0] = __uint_as_float(v.x << 16);
    hw[i * 4 + 1] = __uint_as_float(v.x & 0xffff0000u);
    hw[i * 4 + 2] = __uint_as_float(v.y << 16);
    hw[i * 4 + 3] = __uint_as_float(v.y & 0xffff0000u);
  }
  __syncthreads();
  const float* U = p.peer_u + (size_t)layer * NEXP * 1024;
  const float* V = p.peer_v + (size_t)layer * NEXP * 1024;
#pragma unroll 2
  for (int jj = 0; jj < 32; ++jj) {
    int j = wave * 32 + jj;
    const float* ur = U + (size_t)idx[j] * 1024;
    float part = 0.f;
#pragma unroll
    for (int i = 0; i < 4; ++i) {
      float4 u4 = *(const float4*)(ur + i * 256 + lane * 4);
      part += hw[i * 4] * u4.x + hw[i * 4 + 1] * u4.y + hw[i * 4 + 2] * u4.z + hw[i * 4 + 3] * u4.w;
    }
    part = wave_sum(part);
    if (lane == 0) act[j] = gt[j] * gelu_tanh(part);
  }
  __syncthreads();
  float a0 = 0.f, a1 = 0.f, a2 = 0.f, a3 = 0.f;
#pragma unroll 8
  for (int j = 0; j < 128; ++j) {
    float a = act[j];
    float4 v4 = *(const float4*)(V + (size_t)idx[j] * 1024 + tid * 4);
    a0 += a * v4.x; a1 += a * v4.y; a2 += a * v4.z; a3 += a * v4.w;
  }
  const float* ga = (const float*)(p.ws + OFF_MOD) + (layer * 2 + b) * 6144 + 5120 + tid * 4;
  float* xr = p.out + tok * 1024 + tid * 4;
  float4 xo = *(float4*)xr;
  xo.x += ga[0] * a0; xo.y += ga[1] * a1; xo.z += ga[2] * a2; xo.w += ga[3] * a3;
  *(float4*)xr = xo;
  __syncthreads();
}

DEV void pk_scores(const bf16* __restrict__ ktab, const bf16* __restrict__ qp, f32x4 (&s)[8], int g4, int c16) {
  bf16x8 qf[4];
#pragma unroll
  for (int ks = 0; ks < 4; ++ks) qf[ks] = *(const bf16x8*)(qp + ks * 32 + g4 * 8);
#pragma unroll
  for (int mi = 0; mi < 8; ++mi) {
    s[mi] = f32x4{0.f, 0.f, 0.f, 0.f};
#pragma unroll
    for (int ks = 0; ks < 4; ++ks) {
      const bf16x8 kf = *(const bf16x8*)(ktab + (mi * 16 + c16) * 128 + ks * 32 + g4 * 8);
      s[mi] = MFMA16(kf, qf[ks], s[mi]);
    }
  }
}
DEV void pk_top16(f32x4 (&s)[8], int g4, float (&vout)[16], int (&iout)[16]) {
#pragma unroll
  for (int rd = 0; rd < 16; ++rd) {
    float bv = -INFINITY;
    int bi = 1 << 20;
#pragma unroll
    for (int mi = 0; mi < 8; ++mi)
#pragma unroll
      for (int r = 0; r < 4; ++r) {
        const float v = s[mi][r];
        if (v > bv) { bv = v; bi = mi * 16 + g4 * 4 + r; }
      }
#pragma unroll
    for (int off = 16; off <= 32; off <<= 1) {
      const float ov = shx(bv, off);
      const int oi = shx(bi, off);
      if (ov > bv || (ov == bv && oi < bi)) { bv = ov; bi = oi; }
    }
    vout[rd] = bv;
    iout[rd] = bi;
#pragma unroll
    for (int mi = 0; mi < 8; ++mi)
#pragma unroll
      for (int r = 0; r < 4; ++r)
        if (mi * 16 + g4 * 4 + r == bi) s[mi][r] = -INFINITY;
  }
}
DEV void peer_topk_mfma_item(const Params& p, int layer, int item) {
  const int lane = tidx() & 63, wave = tidx() >> 6, g4 = lane >> 4, c16 = lane & 15;
  const size_t tok = (size_t)item * 8 + wave * 2 + (c16 >> 3);
  const int hh = c16 & 7;
  const bf16* qp = (const bf16*)(p.ws + OFF_QP) + tok * 2048 + hh * 256;
  const bf16* k1 = (const bf16*)(p.ws + OFF_PKB) + (size_t)(layer * 2 + 0) * 16384;
  const bf16* k2 = (const bf16*)(p.ws + OFF_PKB) + (size_t)(layer * 2 + 1) * 16384;
  float v1[16], v2[16];
  int i1[16], i2[16];
  {
    f32x4 s[8];
    pk_scores(k1, qp, s, g4, c16);
    pk_top16(s, g4, v1, i1);
  }
  {
    f32x4 s[8];
    pk_scores(k2, qp + 128, s, g4, c16);
    pk_top16(s, g4, v2, i2);
  }
  float v1s[4];
  int i1s[4];
#pragma unroll
  for (int j = 0; j < 4; ++j) {
    v1s[j] = (g4 == 0) ? v1[j] : (g4 == 1) ? v1[4 + j] : (g4 == 2) ? v1[8 + j] : v1[12 + j];
    i1s[j] = (g4 == 0) ? i1[j] : (g4 == 1) ? i1[4 + j] : (g4 == 2) ? i1[8 + j] : i1[12 + j];
  }
  float c0[16], c1[8], c2[5], c3[4];
#pragma unroll
  for (int b = 0; b < 16; ++b) c0[b] = ((4 * g4 + 1) * (b + 1) <= 16) ? v1s[0] + v2[b] : -INFINITY;
#pragma unroll
  for (int b = 0; b < 8; ++b) c1[b] = ((4 * g4 + 2) * (b + 1) <= 16) ? v1s[1] + v2[b] : -INFINITY;
#pragma unroll
  for (int b = 0; b < 5; ++b) c2[b] = ((4 * g4 + 3) * (b + 1) <= 16) ? v1s[2] + v2[b] : -INFINITY;
#pragma unroll
  for (int b = 0; b < 4; ++b) c3[b] = ((4 * g4 + 4) * (b + 1) <= 16) ? v1s[3] + v2[b] : -INFINITY;
  float vals[16];
  int eidx[16];
  const int cbase = g4 * 64;
#pragma unroll
  for (int rd = 0; rd < 16; ++rd) {
    float bv = -INFINITY;
    int bi = 1 << 20;
#pragma unroll
    for (int b = 0; b < 16; ++b) if (c0[b] > bv) { bv = c0[b]; bi = cbase + b; }
#pragma unroll
    for (int b = 0; b < 8; ++b) if (c1[b] > bv) { bv = c1[b]; bi = cbase + 16 + b; }
#pragma unroll
    for (int b = 0; b < 5; ++b) if (c2[b] > bv) { bv = c2[b]; bi = cbase + 32 + b; }
#pragma unroll
    for (int b = 0; b < 4; ++b) if (c3[b] > bv) { bv = c3[b]; bi = cbase + 48 + b; }
#pragma unroll
    for (int off = 16; off <= 32; off <<= 1) {
      const float ov = shx(bv, off);
      const int oi = shx(bi, off);
      if (ov > bv || (ov == bv && oi < bi)) { bv = ov; bi = oi; }
    }
    vals[rd] = bv;
    int e = -1;
#pragma unroll
    for (int b = 0; b < 16; ++b) if (cbase + b == bi) { c0[b] = -INFINITY; e = i1s[0] * 128 + i2[b]; }
#pragma unroll
    for (int b = 0; b < 8; ++b) if (cbase + 16 + b == bi) { c1[b] = -INFINITY; e = i1s[1] * 128 + i2[b]; }
#pragma unroll
    for (int b = 0; b < 5; ++b) if (cbase + 32 + b == bi) { c2[b] = -INFINITY; e = i1s[2] * 128 + i2[b]; }
#pragma unroll
    for (int b = 0; b < 4; ++b) if (cbase + 48 + b == bi) { c3[b] = -INFINITY; e = i1s[3] * 128 + i2[b]; }
    e = max(e, shx(e, 16));
    e = max(e, shx(e, 32));
    eidx[rd] = e;
  }
  float ex[16], sum = 0.f;
#pragma unroll
  for (int rd = 0; rd < 16; ++rd) { ex[rd] = expf(vals[rd] - vals[0]); sum += ex[rd]; }
  const float inv = 1.f / sum;
  if (g4 == 0) {
    int* pi = (int*)(p.ws + OFF_PEIDX) + tok * 128 + hh * 16;
    float* pg = (float*)(p.ws + OFF_PEG) + tok * 128 + hh * 16;
#pragma unroll
    for (int q = 0; q < 4; ++q) {
      *(int4*)(pi + q * 4) = int4{eidx[q * 4], eidx[q * 4 + 1], eidx[q * 4 + 2], eidx[q * 4 + 3]};
      *(float4*)(pg + q * 4) = float4{ex[q * 4] * inv, ex[q * 4 + 1] * inv, ex[q * 4 + 2] * inv, ex[q * 4 + 3] * inv};
    }
  }
}

typedef float f32x2_t __attribute__((ext_vector_type(2)));
DEV unsigned pack4_fp8(float a, float b, float c, float d) {
  int p = __builtin_amdgcn_cvt_pk_fp8_f32(a, b, 0, false);
  p = __builtin_amdgcn_cvt_pk_fp8_f32(c, d, p, true);
  return (unsigned)p;
}
DEV void unpack16_fp8(uint4 v, float* f) {
  f32x2_t r;
  r = __builtin_amdgcn_cvt_pk_f32_fp8((int)v.x, false); f[0] = r.x; f[1] = r.y;
  r = __builtin_amdgcn_cvt_pk_f32_fp8((int)v.x, true);  f[2] = r.x; f[3] = r.y;
  r = __builtin_amdgcn_cvt_pk_f32_fp8((int)v.y, false); f[4] = r.x; f[5] = r.y;
  r = __builtin_amdgcn_cvt_pk_f32_fp8((int)v.y, true);  f[6] = r.x; f[7] = r.y;
  r = __builtin_amdgcn_cvt_pk_f32_fp8((int)v.z, false); f[8] = r.x; f[9] = r.y;
  r = __builtin_amdgcn_cvt_pk_f32_fp8((int)v.z, true);  f[10] = r.x; f[11] = r.y;
  r = __builtin_amdgcn_cvt_pk_f32_fp8((int)v.w, false); f[12] = r.x; f[13] = r.y;
  r = __builtin_amdgcn_cvt_pk_f32_fp8((int)v.w, true);  f[14] = r.x; f[15] = r.y;
}
DEV void expert_cvt_item(const Params& p, int layer, int item) {
  const int lane = tidx() & 63, wave = tidx() >> 6;
  const int e = item * 4 + wave;
  unsigned char* dst = (unsigned char*)(p.ws + OFF_E8) + (size_t)e * 2048;
  float* sc = (float*)(p.ws + OFF_ESC) + (size_t)e * 2;
#pragma unroll
  for (int tb = 0; tb < 2; ++tb) {
    const float* src = (tb ? p.peer_v : p.peer_u) + ((size_t)layer * NEXP + e) * 1024 + lane * 16;
    float4 a = *(const float4*)src, b = *(const float4*)(src + 4), c = *(const float4*)(src + 8), d = *(const float4*)(src + 12);
    float mx = fmaxf(fmaxf(fmaxf(fabsf(a.x), fabsf(a.y)), fmaxf(fabsf(a.z), fabsf(a.w))),
                     fmaxf(fmaxf(fabsf(b.x), fabsf(b.y)), fmaxf(fabsf(b.z), fabsf(b.w))));
    mx = fmaxf(mx, fmaxf(fmaxf(fmaxf(fabsf(c.x), fabsf(c.y)), fmaxf(fabsf(c.z), fabsf(c.w))),
                         fmaxf(fmaxf(fabsf(d.x), fabsf(d.y)), fmaxf(fabsf(d.z), fabsf(d.w)))));
#pragma unroll
    for (int o = 32; o >= 1; o >>= 1) mx = fmaxf(mx, shx(mx, o));
    const float s = (mx > 0.f) ? 224.f / mx : 1.f;
    uint4 pk;
    pk.x = pack4_fp8(a.x * s, a.y * s, a.z * s, a.w * s);
    pk.y = pack4_fp8(b.x * s, b.y * s, b.z * s, b.w * s);
    pk.z = pack4_fp8(c.x * s, c.y * s, c.z * s, c.w * s);
    pk.w = pack4_fp8(d.x * s, d.y * s, d.z * s, d.w * s);
    *(uint4*)(dst + tb * 1024 + lane * 16) = pk;
    if (lane == 0) sc[tb] = 1.f / s;
  }
}

DEV float rdlane_f(float v, int l) { return __int_as_float(__builtin_amdgcn_readlane(__float_as_int(v), l)); }
DEV float dot16_f8(const float* hw, uint4 u) {
  float f[16];
  unpack16_fp8(u, f);
  float s = 0.f;
#pragma unroll
  for (int i = 0; i < 16; ++i) s += hw[i] * f[i];
  return s;
}
DEV void axpy16_f8(float* acc, float a, uint4 u) {
  float f[16];
  unpack16_fp8(u, f);
#pragma unroll
  for (int i = 0; i < 16; ++i) acc[i] += a * f[i];
}
#define PE_ROWPTR(idxv, j) (E8 + (size_t)__builtin_amdgcn_readlane(idxv, (j)) * 2048)
#define PE_LOAD8(P, idxv, j0, off)                                                                        \
  P##0 = *(const uint4*)(PE_ROWPTR(idxv, (j0)) + (off)); P##1 = *(const uint4*)(PE_ROWPTR(idxv, (j0) + 1) + (off)); \
  P##2 = *(const uint4*)(PE_ROWPTR(idxv, (j0) + 2) + (off)); P##3 = *(const uint4*)(PE_ROWPTR(idxv, (j0) + 3) + (off)); \
  P##4 = *(const uint4*)(PE_ROWPTR(idxv, (j0) + 4) + (off)); P##5 = *(const uint4*)(PE_ROWPTR(idxv, (j0) + 5) + (off)); \
  P##6 = *(const uint4*)(PE_ROWPTR(idxv, (j0) + 6) + (off)); P##7 = *(const uint4*)(PE_ROWPTR(idxv, (j0) + 7) + (off));
#define PE_DOTSET(P, j0, dv)                                                                              \
  {                                                                                                       \
    const float s0 = wave_sum(dot16_f8(hw, P##0)), s1 = wave_sum(dot16_f8(hw, P##1)),                     \
                s2 = wave_sum(dot16_f8(hw, P##2)), s3 = wave_sum(dot16_f8(hw, P##3)),                     \
                s4 = wave_sum(dot16_f8(hw, P##4)), s5 = wave_sum(dot16_f8(hw, P##5)),                     \
                s6 = wave_sum(dot16_f8(hw, P##6)), s7 = wave_sum(dot16_f8(hw, P##7));                     \
    if (lane == (j0)) dv = s0;                                                                            \
    if (lane == (j0) + 1) dv = s1;                                                                        \
    if (lane == (j0) + 2) dv = s2;                                                                        \
    if (lane == (j0) + 3) dv = s3;                                                                        \
    if (lane == (j0) + 4) dv = s4;                                                                        \
    if (lane == (j0) + 5) dv = s5;                                                                        \
    if (lane == (j0) + 6) dv = s6;                                                                        \
    if (lane == (j0) + 7) dv = s7;                                                                        \
  }
#define PE_AXPYSET(P, j0, av)                                                                             \
  {                                                                                                       \
    axpy16_f8(acc, rdlane_f(av, (j0)), P##0);     axpy16_f8(acc, rdlane_f(av, (j0) + 1), P##1);           \
    axpy16_f8(acc, rdlane_f(av, (j0) + 2), P##2); axpy16_f8(acc, rdlane_f(av, (j0) + 3), P##3);           \
    axpy16_f8(acc, rdlane_f(av, (j0) + 4), P##4); axpy16_f8(acc, rdlane_f(av, (j0) + 5), P##5);           \
    axpy16_f8(acc, rdlane_f(av, (j0) + 6), P##6); axpy16_f8(acc, rdlane_f(av, (j0) + 7), P##7);           \
  }
#define PE_DOT8(idxv, dv)                                                                                 \
  {                                                                                                       \
    uint4 pa0, pa1, pa2, pa3, pa4, pa5, pa6, pa7, pb0, pb1, pb2, pb3, pb4, pb5, pb6, pb7;                 \
    PE_LOAD8(pa, idxv, 0, 0)                                                                              \
    _Pragma("unroll 1") for (int g = 0; g < 4; ++g) {                                                     \
      const int j0 = g * 16;                                                                              \
      PE_LOAD8(pb, idxv, j0 + 8, 0)                                                                       \
      PE_DOTSET(pa, j0, dv)                                                                               \
      if (g < 3) { PE_LOAD8(pa, idxv, j0 + 16, 0) }                                                       \
      PE_DOTSET(pb, j0 + 8, dv)                                                                           \
    }                                                                                                     \
  }
#define PE_AXPY8(idxv, av)                                                                                \
  {                                                                                                       \
    uint4 pa0, pa1, pa2, pa3, pa4, pa5, pa6, pa7, pb0, pb1, pb2, pb3, pb4, pb5, pb6, pb7;                 \
    PE_LOAD8(pa, idxv, 0, 1024)                                                                           \
    _Pragma("unroll 1") for (int g = 0; g < 4; ++g) {                                                     \
      const int j0 = g * 16;                                                                              \
      PE_LOAD8(pb, idxv, j0 + 8, 1024)                                                                    \
      PE_AXPYSET(pa, j0, av)                                                                              \
      if (g < 3) { PE_LOAD8(pa, idxv, j0 + 16, 1024) }                                                    \
      PE_AXPYSET(pb, j0 + 8, av)                                                                          \
    }                                                                                                     \
  }
DEV void peer_expert_item2(const Params& p, int layer, int item, float ga_scale = 1.f) {
  const int lane = tidx() & 63, wave = tidx() >> 6;
  const size_t tok = (size_t)item * 4 + wave;
  const int b = (int)(tok / S);
  const int* pi = (const int*)(p.ws + OFF_PEIDX) + tok * 128;
  const float* pg = (const float*)(p.ws + OFF_PEG) + tok * 128;
  const int idx_lo = pi[lane], idx_hi = pi[64 + lane];
  const float g_lo = pg[lane], g_hi = pg[64 + lane];
  const float* esc = (const float*)(p.ws + OFF_ESC);
  const float2 sc_lo = *(const float2*)(esc + (size_t)idx_lo * 2), sc_hi = *(const float2*)(esc + (size_t)idx_hi * 2);
  const bf16* hrow = (const bf16*)(p.ws + OFF_H) + tok * 1024 + lane * 16;
  float hw[16];
  unpack8(*(const uint4*)hrow, hw);
  unpack8(*(const uint4*)(hrow + 8), hw + 8);
  const unsigned char* E8 = (const unsigned char*)(p.ws + OFF_E8) + lane * 16;
  float d_lo = 0.f, d_hi = 0.f;
  PE_DOT8(idx_lo, d_lo)
  PE_DOT8(idx_hi, d_hi)
  const float act_lo = g_lo * gelu_tanh(d_lo * sc_lo.x) * sc_lo.y;
  const float act_hi = g_hi * gelu_tanh(d_hi * sc_hi.x) * sc_hi.y;
  float acc[16];
#pragma unroll
  for (int i = 0; i < 16; ++i) acc[i] = 0.f;
  PE_AXPY8(idx_lo, act_lo)
  PE_AXPY8(idx_hi, act_hi)
  const float* ga = (const float*)(p.ws + OFF_MOD) + (layer * 2 + b) * 6144 + 5120 + lane * 16;
  float* xr = p.out + tok * 1024 + lane * 16;
  float xn[16];
  float ss = 0.f;
#pragma unroll
  for (int q4 = 0; q4 < 4; ++q4) {
    float4 xo = *(float4*)(xr + q4 * 4);
    const float4 g4v = *(const float4*)(ga + q4 * 4);
    xo.x += ga_scale * g4v.x * acc[q4 * 4 + 0];
    xo.y += ga_scale * g4v.y * acc[q4 * 4 + 1];
    xo.z += ga_scale * g4v.z * acc[q4 * 4 + 2];
    xo.w += ga_scale * g4v.w * acc[q4 * 4 + 3];
    xn[q4 * 4] = xo.x; xn[q4 * 4 + 1] = xo.y; xn[q4 * 4 + 2] = xo.z; xn[q4 * 4 + 3] = xo.w;
    ss += xo.x * xo.x + xo.y * xo.y + xo.z * xo.z + xo.w * xo.w;
  }
#if PROBE_ANY || REP_MASK
#pragma unroll
  for (int q4 = 0; q4 < 4; ++q4)
    *(float4*)(xr + q4 * 4) = float4{xn[q4 * 4], xn[q4 * 4 + 1], xn[q4 * 4 + 2], xn[q4 * 4 + 3]};
  return;
#endif
  ss = wave_sum(ss);
  const float rn = 1.0f / sqrtf(ss * (1.0f / 1024.f) + 1e-6f);
  if (layer == 0) {
    const float* gn = p.g_attn + 1024 + lane * 16;
    const float* md = (const float*)(p.ws + OFF_MOD) + (2 + b) * 6144 + lane * 16;
    bf16* hq = (bf16*)(p.ws + OFF_H) + tok * 1024 + lane * 16;
    unsigned pk[8];
#pragma unroll
    for (int q4 = 0; q4 < 4; ++q4) {
      *(float4*)(xr + q4 * 4) = float4{xn[q4 * 4], xn[q4 * 4 + 1], xn[q4 * 4 + 2], xn[q4 * 4 + 3]};
      const float4 g4v = *(const float4*)(gn + q4 * 4);
      const float4 s4 = *(const float4*)(md + 1024 + q4 * 4);
      const float4 h4 = *(const float4*)(md + q4 * 4);
      const float o0 = xn[q4 * 4] * rn * g4v.x * (1.f + s4.x) + h4.x;
      const float o1 = xn[q4 * 4 + 1] * rn * g4v.y * (1.f + s4.y) + h4.y;
      const float o2 = xn[q4 * 4 + 2] * rn * g4v.z * (1.f + s4.z) + h4.z;
      const float o3 = xn[q4 * 4 + 3] * rn * g4v.w * (1.f + s4.w) + h4.w;
      pk[q4 * 2] = cvtpk_(o0, o1);
      pk[q4 * 2 + 1] = cvtpk_(o2, o3);
    }
    *(uint4*)hq = uint4{pk[0], pk[1], pk[2], pk[3]};
    *(uint4*)(hq + 8) = uint4{pk[4], pk[5], pk[6], pk[7]};
  } else {
    const float* gf = p.g_final + lane * 16;
#pragma unroll
    for (int q4 = 0; q4 < 4; ++q4) {
      const float4 g4v = *(const float4*)(gf + q4 * 4);
      *(float4*)(xr + q4 * 4) = float4{xn[q4 * 4] * rn * g4v.x, xn[q4 * 4 + 1] * rn * g4v.y, xn[q4 * 4 + 2] * rn * g4v.z,
                                       xn[q4 * 4 + 3] * rn * g4v.w};
    }
  }
}

template <class F>
DEV void for_tiles_xcd(int MT, int NT, F f) {
  const int nb = gridDim.x, bid = blockIdx.x;
  if ((nb & 7) != 0) {
    for (int it = bid; it < MT * NT; it += nb) f(it / NT, it % NT);
    return;
  }
  const int xcd = bid & 7, slot = bid >> 3, nslot = nb >> 3;
  const int nj = (NT - xcd + 7) >> 3;
  for (int q = slot; q < MT * nj; q += nslot) f(q / nj, xcd + 8 * (q % nj));
}
constexpr int PH_PER_LAYER = 15;
enum { SP_NORM1 = 0, SP_INPROJ = 1, SP_COMPRESS = 2, SP_KMEAN = 3, SP_ATTN = 4, SP_MP0 = 5, SP_MM0 = 6, SP_MP1 = 7, SP_MM1 = 8,
       SP_MERGE = 9, SP_OUTPROJ = 10, SP_NORM2 = 11, SP_PEERQ = 12, SP_TOPK = 13, SP_EXPERT = 14 };
constexpr int N_REAL_PHASES = 1 + 2 * PH_PER_LAYER + 1;
constexpr int N_PHASES = N_REAL_PHASES + (PROBE_ANY ? 2 : 0);

DEV void run_phase(const Params& p, int ph, char* smem_raw, bool second_pass = false) {
#define SKIP_MOBA_SECOND (REP_NSA_ONLY && second_pass)
  float* smf = (float*)smem_raw;
  bf16* smh = (bf16*)smem_raw;
  const int nb = gridDim.x, bid = blockIdx.x;
  if (ph == 0) {
    for (int it = bid; it < PREP_ITEMS; it += nb) prep_item(p, it, smf);
    return;
  }
  if (ph == N_REAL_PHASES - 1) {
    for (int it = bid; it < T / 4; it += nb) final_norm_item(p.out, p.g_final, it);
    return;
  }
#if PROBE_ANY
  if (ph == N_REAL_PHASES) {
#if PROBE_PROJ
    {
      const bf16* Hh = (const bf16*)(p.ws + OFF_H);
      const bf16* Wt = (const bf16*)(p.ws + OFF_WINT) + (size_t)1 * WN * 1024;
      const float* rope = (const float*)(p.ws + OFF_ROPE);
      float sd = 0.f, sr = 0.f;
      for (size_t i = (size_t)bid * 256 + tidx(); i < (size_t)(T / 64) * 4888; i += (size_t)nb * 256) {
        const int ts = (int)(i / 4888), vc = (int)(i % 4888);
        const int tok = ts * 64 + (ts % 61);
        const int b = tok / S, t = tok % S;
        auto rawdot = [&](int col) {
          float a = 0.f;
          for (int k = 0; k < 1024; ++k) a += bf2f(Hh[(size_t)tok * 1024 + k]) * bf2f(Wt[(size_t)col * 1024 + k]);
          return a;
        };
        float v = rawdot(vc);
        bool roped = false;
        const bf16* dst;
        if (vc < 768) dst = (const bf16*)(p.ws + OFF_PROJ) + (size_t)tok * PC + vc;
        else if (vc < 1280) {
          const int seg = (vc - 768) >> 7, head = ((vc - 768) >> 6) & 1, d = vc & 63;
          const size_t off = (seg == 0) ? OFF_KSB : (seg == 1) ? OFF_VSB : (seg == 2) ? OFF_KWB : OFF_VWB;
          dst = (const bf16*)(p.ws + off) + ((size_t)(b * 2 + head) * S + t) * 64 + d;
          roped = (seg == 0 || seg == 2);
        } else if (vc < 1792) { dst = (const bf16*)(p.ws + OFF_PROJ) + (size_t)tok * PC + C_MQ + (vc - 1280); roped = true; }
        else if (vc < 2816) {
          const int seg = (vc - 1792) >> 9, head = ((vc - 1792) >> 6) & 7, d = vc & 63;
          dst = (const bf16*)(p.ws + (seg ? OFF_MVB : OFF_MKB)) + ((size_t)(b * 8 + head) * S + t) * 64 + d;
          roped = (seg == 0);
        } else if (vc < 4864) dst = (const bf16*)(p.ws + OFF_PROJ) + (size_t)tok * PC + C_GN + (vc - 2816);
        else dst = (const bf16*)(p.ws + OFF_PROJ) + (size_t)tok * PC + C_NG + (vc - 4864);
        const int d = vc & 63;
        if (roped && d < 16) {
          const float cs = rope[(size_t)t * 16 + (d & 7)], sn = rope[(size_t)t * 16 + 8 + (d & 7)];
          if (d < 8) { const float x2 = rawdot(vc + 8); v = v * cs - x2 * sn; }
          else { const float x1 = rawdot(vc - 8); v = v * cs + x1 * sn; }
        }
        const float got = bf2f(*dst);
        const bool is_r = roped && d < 16;
        if (PROBE_PROJ == 1 || (PROBE_PROJ == 2 && is_r) || (PROBE_PROJ == 3 && !is_r)) {
          sd += (got - v) * (got - v);
          sr += v * v;
        }
      }
      sd = wave_sum(sd); sr = wave_sum(sr);
      if ((tidx() & 63) == 0) {
        atomicAdd((float*)(p.ws + OFF_PROBE), sd);
        atomicAdd((float*)(p.ws + OFF_PROBE) + 1, sr);
      }
    }
#endif
#if PROBE_CMPR
    {
      float sd = 0.f, sr = 0.f;
      for (size_t i = (size_t)bid * 256 + tidx(); i < (size_t)2 * Bn * 1024 * 128; i += (size_t)nb * 256) {
        const size_t wh = i / ((size_t)Bn * 1024 * 128), r = i % ((size_t)Bn * 1024 * 128);
        const int c = (int)((r / 128) % 1024);
        if (c < 1023) {
          const float a = ((const float*)(p.ws + (wh ? OFF_VCC : OFF_KCC)))[r];
          const float y = ((const float*)(p.ws + OFF_CMP))[i];
          sd += (a - y) * (a - y);
          sr += y * y;
        }
      }
      sd = wave_sum(sd); sr = wave_sum(sr);
      if ((tidx() & 63) == 0) {
        atomicAdd((float*)(p.ws + OFF_PROBE), sd);
        atomicAdd((float*)(p.ws + OFF_PROBE) + 1, sr);
      }
    }
#endif
#if PROBE_MOBA
    probe_accum_bf16(p, (const bf16*)(p.ws + OFF_OMOBA), (const bf16*)(p.ws + OFF_CMP), (size_t)S * 512, smf);
#endif
#if PROBE_NSA == 8
    {
      const float* impn = (const float*)(p.ws + OFF_OMOBA);
      const float* impm = impn + (size_t)S * 256;
      const int* seld = (const int*)(p.ws + OFF_CMP);
      float sd = 0.f, sr = 0.f, bad = 0.f;
      for (int t = bid * 256 + tidx(); t < S; t += nb * 256) {
        const int cur = t >> 6;
        for (int n = 0; n < 256; ++n) {
          float a = impm[(size_t)t * 256 + n], r = impn[(size_t)t * 256 + n];
          sd += (a - r) * (a - r);
          sr += r * r;
        }
        unsigned want[8] = {0, 0, 0, 0, 0, 0, 0, 0}, got[8] = {0, 0, 0, 0, 0, 0, 0, 0};
        for (int j = 0; j < 16; ++j) {
          int v = seld[(size_t)t * 16 + j];
          if (v >= 0 && v < 256) {
            for (int w = 0; w < 8; ++w) if ((v >> 5) == w) got[w] |= 1u << (v & 31);
          }
        }
        if (cur < 16) {
          for (int n = 0; n <= cur; ++n) want[0] |= 1u << n;
        } else {
          want[0] |= 1u;
          for (int w = 0; w < 8; ++w) {
            if (((cur - 1) >> 5) == w) want[w] |= 1u << ((cur - 1) & 31);
            if ((cur >> 5) == w) want[w] |= 1u << (cur & 31);
          }
          for (int j = 0; j < 13; ++j) {
            float best = -1.f;
            int bi = 1;
            for (int n = 1; n <= cur - 2; ++n) {
              bool taken = false;
              for (int w = 0; w < 8; ++w) if ((n >> 5) == w) taken = (want[w] >> (n & 31)) & 1u;
              float v = impm[(size_t)t * 256 + n];
              if (!taken && v > best) { best = v; bi = n; }
            }
            for (int w = 0; w < 8; ++w) if ((bi >> 5) == w) want[w] |= 1u << (bi & 31);
          }
        }
        bool same = true;
        for (int w = 0; w < 8; ++w) same = same && (want[w] == got[w]);
        if (!same) bad += 1.f;
      }
      sd = wave_sum(sd); sr = wave_sum(sr); bad = wave_sum(bad);
      if ((tidx() & 63) == 0) {
        atomicAdd((float*)(p.ws + OFF_PROBE), sd);
        atomicAdd((float*)(p.ws + OFF_PROBE) + 1, sr);
        atomicAdd((float*)(p.ws + OFF_PROBE) + 2, bad);
      }
    }
#elif PROBE_NSA
    probe_accum_bf16(p, (const bf16*)(p.ws + OFF_ONSA), (const bf16*)(p.ws + OFF_CMP), (size_t)S * 512, smf);
#endif
    return;
  }
  if (ph == N_REAL_PHASES + 1) {
    probe_apply(p);
    return;
  }
#endif
  const int layer = (ph - 1) / PH_PER_LAYER, sub = (ph - 1) % PH_PER_LAYER;
  const float* mod = (const float*)(p.ws + OFF_MOD) + (size_t)layer * 2 * 6144;
  const float* xin = (layer == 0) ? p.x : p.out;
  bf16* H = (bf16*)(p.ws + OFF_H);
  bf16* PROJ = (bf16*)(p.ws + OFF_PROJ);
#if PROBE_ANY
  if (sub >= SP_MERGE) {
    if (sub == SP_OUTPROJ && layer == 0)
      for (size_t i = (size_t)bid * 256 + tidx(); i < (size_t)T * 1024; i += (size_t)nb * 256) p.out[i] = p.x[i];
    return;
  }
#endif
  switch (sub) {
    case SP_NORM1:
      for (int it = bid; it < T / 4; it += nb)
        norm_item(xin, p.g_attn + layer * 1024, mod + 1024, mod + 0, H, it);
      break;
    case SP_INPROJ: {
      for_tiles_xcd(T / 128, WN / 128, [&](int mt, int nt) { inproj_tile(p, layer, mt * 128, nt * 128, smh); });
    } break;
    case SP_COMPRESS:
      for (int it = bid; it < 512; it += nb) compress_mfma_item(p, layer, it, smem_raw);
#if PROBE_CMPR
      if (layer == 1)
        for (int it = bid; it < 1024; it += nb) compress_item(p, layer, it, smf);
#endif
      break;
    case SP_KMEAN:
      for (int it = bid; it < 1024; it += nb) kmean_item(p, it, smf);
#if PROBE_NSA
      if (layer == 1)
        for (int it = bid; it < 512; it += nb) n1_item(p, layer, it, smf);
#endif
      break;
    case SP_ATTN:
      {
        constexpr int MNI = 2;
        constexpr int NMOBA = 16 * (S / (64 * MNI));
        constexpr int NNI = 2;
        constexpr int NNSA = 4 * (S / (16 * NNI));
        const bool do_nsa = !PROBE_ANY || PROBE_NSA, do_moba = (!PROBE_ANY || PROBE_MOBA) && PROBE_NSA != 8;
        for (int it = bid; it < NNSA + NMOBA; it += nb) {
          if (it < NNSA) { if (do_nsa) nsa_item<NNI>(p, it, smem_raw, (bf16*)(p.ws + OFF_ONSA)); }
          else if (do_moba && !SKIP_MOBA_SECOND) moba_gate_item<MNI>(p, it - NNSA);
        }
#if PROBE_NSA && PROBE_NSA != 8
        if (layer == 1)
          for (int it = bid; it < 512; it += nb) n23_item(p, layer, it);
#endif
#if PROBE_MOBA
        if (layer == 1) {
          for (int it = bid; it < 512; it += nb) moba_item(p, layer, it);
        }
#endif
      }
      break;
    case SP_MP0:
    case SP_MP1:
      if ((!PROBE_ANY || PROBE_MOBA) && PROBE_NSA != 8)
        for (int it = bid; it < 8 * 63 * 8; it += nb) moba_part_item<2>(p, sub == SP_MP1 ? 1 : 0, it, smem_raw);
      break;
    case SP_MM0:
    case SP_MM1:
      if ((!PROBE_ANY || PROBE_MOBA) && PROBE_NSA != 8)
        for (int it = bid; it < 8 * (S / 128); it += nb)
          moba_merge_item<2>(p, sub == SP_MM1 ? 1 : 0, it, smem_raw, (bf16*)(p.ws + OFF_OMOBA));
      break;
    case SP_MERGE:
      for_tiles_xcd(T / 128, 8, [&](int mt, int nt) { merge_tile(p, layer, mt * 128, nt * 128, smh); });
      break;
    case SP_OUTPROJ: {
      const bf16* W = (const bf16*)(p.ws + OFF_WOUT) + (size_t)layer * 1024 * 1024;
      const float* ga1 = mod + 2048;
      for_tiles_xcd(T / 128, 8, [&](int mt, int nt) {
        gemm_tile(H, 1024, W, 1024, mt * 128, nt * 128, smh, [&](int row, int col, float v) {
          int b = row / S;
          size_t o = (size_t)row * 1024 + col;
          p.out[o] = xin[o] + ga1[b * 6144 + col] * v;
        });
      });
    } break;
    case SP_NORM2:
      for (int it = bid; it < T / 4 + NEXP / 4; it += nb) {
        if (it < T / 4) norm_item(p.out, p.g_ffn + layer * 1024, mod + 4096, mod + 3072, H, it);
        else expert_cvt_item(p, layer, it - T / 4);
      }
      break;
    case SP_PEERQ: {
      const bf16* W = (const bf16*)(p.ws + OFF_WQ) + (size_t)layer * 2048 * 1024;
      bf16* QP = (bf16*)(p.ws + OFF_QP);
      for_tiles_xcd(T / 128, 16, [&](int mt, int nt) {
        f32x4 acc[4][4];
        acc_zero(acc);
        gemm_mainloop(H, 1024, W, 1024, mt * 128, nt * 128, smh, acc);
        const int wv = tidx() >> 6;
        store_tile_bf16(smh, acc, QP + (size_t)(mt * 128 + (wv >> 1) * 64) * 2048 + nt * 128 + (wv & 1) * 64, 2048);
      });
    } break;
    case SP_TOPK:
      for (int it = bid; it < T / 8; it += nb) peer_topk_mfma_item(p, layer, it);
      break;
    case SP_EXPERT:
      for (int it = bid; it < T / 4; it += nb) peer_expert_item2(p, layer, it, second_pass ? 0.f : 1.f);
      break;
  }
}

#if PROBE_ANY
#define MEGA_LB __launch_bounds__(256)
#else
#define MEGA_LB __launch_bounds__(256, 2)
#endif
__global__ void MEGA_LB mega_kernel(Params p, int ph_lo, int ph_hi) {
  __shared__ __attribute__((aligned(16))) char smem_raw[SMEM_BYTES + 16];
  volatile LAS unsigned* xbst = (volatile LAS unsigned*)(smem_raw + SMEM_BYTES);
  if (threadIdx.x == 0) { xbst[0] = 0u; xbst[1] = 0u; xbst[2] = 0u; xbst[3] = 0u; }
  __syncthreads();
  XcdBarrier xb = xcd_barrier_post((unsigned*)(p.ws + OFF_BAR), xbst);
  for (int ph = ph_lo; ph < ph_hi; ++ph) {
#if !PROBE_ANY && !REP_MASK
    if (ph == N_REAL_PHASES - 1 || ph == 1 + PH_PER_LAYER) continue;
#endif
    run_phase(p, ph, smem_raw);
#if REP_MASK
    if (ph >= 1 && ph < N_REAL_PHASES - 1 && ((REP_MASK >> ((ph - 1) % PH_PER_LAYER)) & 1)) {
      xcd_barrier(xb);
      run_phase(p, ph, smem_raw, true);
    }
#endif
    if (ph + 1 < ph_hi) {
      if (ph == ph_lo) cg::this_grid().sync();
      else xcd_barrier(xb);
    }
  }
}

extern "C" void kernel_launch(void* const* d_in, const int* in_sizes, int n_in, void* d_out, int out_size, void* d_ws,
                              size_t ws_size, hipStream_t stream) {
  if (ws_size < WS_TOTAL) {
    fprintf(stderr, "workspace too small: %zu < %zu\n", ws_size, (size_t)WS_NEED);
    return;
  }
  Params p{};
  p.x = (const float*)d_in[0]; p.c = (const float*)d_in[1]; p.w_ada = (const float*)d_in[2];
  p.b_ada = (const float*)d_in[3]; p.g_attn = (const float*)d_in[4]; p.g_ffn = (const float*)d_in[5];
  p.w_in = (const float*)d_in[6]; p.cmp_pe = (const float*)d_in[7]; p.cmp_w1 = (const float*)d_in[8];
  p.cmp_w2 = (const float*)d_in[9]; p.w_up_nsa = (const float*)d_in[10]; p.w_up_moba = (const float*)d_in[11];
  p.w_out = (const float*)d_in[12]; p.peer_wq = (const float*)d_in[13]; p.peer_k1 = (const float*)d_in[14];
  p.peer_k2 = (const float*)d_in[15]; p.peer_u = (const float*)d_in[16]; p.peer_v = (const float*)d_in[17];
  p.g_final = (const float*)d_in[18];
  p.out = (float*)d_out;
  p.ws = (char*)d_ws;
  static int grid_blocks = 0;
  if (!grid_blocks) {
    int dev = 0, cus = 0, per_cu = 0;
    hipGetDevice(&dev);
    hipDeviceGetAttribute(&cus, hipDeviceAttributeMultiprocessorCount, dev);
    hipOccupancyMaxActiveBlocksPerMultiprocessor(&per_cu, mega_kernel, 256, 0);
    if (per_cu < 1) per_cu = 1;
    if (per_cu > 2) per_cu = 2;
    grid_blocks = cus * per_cu;
  }
  hipMemsetAsync((char*)d_ws + OFF_BAR, 0, BAR_BYTES, stream);
  int ph_lo = 0, ph_hi = N_PHASES;
  void* args[] = {(void*)&p, (void*)&ph_lo, (void*)&ph_hi};
  hipError_t e = hipLaunchCooperativeKernel((const void*)mega_kernel, dim3(grid_blocks), dim3(256), args, 0, stream);
  if (e != hipSuccess) fprintf(stderr, "cooperative launch failed: %s (grid %d)\n", hipGetErrorString(e), grid_blocks);
}
```

```cpp
#include <hip/hip_runtime.h>
#include <hip/hip_bf16.h>
#include <hip/hip_cooperative_groups.h>
#include <cstdio>
#include <cstdint>
namespace cg = cooperative_groups;

#define DEV __device__ __forceinline__
typedef unsigned short bf16;
using bf16x8 = __attribute__((ext_vector_type(8))) short;
using f32x4 = __attribute__((ext_vector_type(4))) float;

constexpr int Bn = 2, S = 16384, T = Bn * S, D = 1024;
constexpr int PC = 3456;
constexpr int WN = 4992;
constexpr int C_NQ = 0, C_KC = 512, C_VC = 640, C_MQ = 768, C_GN = 1280, C_GM = 2304, C_NG = 3328;
constexpr int NEXP = 16384;

constexpr size_t al(size_t x) { return (x + 255) & ~size_t(255); }
constexpr size_t OFF_MOD = 0;
constexpr size_t OFF_ROPE = al(OFF_MOD + 2 * 2 * 6144 * 4);
constexpr size_t OFF_PEB = al(OFF_ROPE + (size_t)S * 16 * 4);
constexpr size_t OFF_WINT = al(OFF_PEB + 2 * 2 * 128 * 4);
constexpr size_t OFF_WUPN = al(OFF_WINT + 2ull * WN * 1024 * 2);
constexpr size_t OFF_WUPM = al(OFF_WUPN + 2ull * 1024 * 512 * 2);
constexpr size_t OFF_WOUT = al(OFF_WUPM + 2ull * 1024 * 512 * 2);
constexpr size_t OFF_WQ = al(OFF_WOUT + 2ull * 1024 * 1024 * 2);
constexpr size_t OFF_KCC = al(OFF_WQ + 2ull * 2048 * 1024 * 2);
constexpr size_t OFF_VCC = al(OFF_KCC + 2ull * 1024 * 128 * 4);
constexpr size_t OFF_SEL = al(OFF_VCC + 2ull * 1024 * 128 * 4);
constexpr size_t OFF_KMEAN = al(OFF_SEL + 2ull * 2 * S * 16 * 4);
constexpr size_t OFF_KMHL = al(OFF_KMEAN + 2ull * 8 * 64 * 64 * 4);
constexpr size_t OFF_KCB = al(OFF_KMHL + 2ull * 2 * 8 * 64 * 64 * 2);
constexpr size_t OFF_VCB = al(OFF_KCB + 2ull * 2 * 1024 * 64 * 2);
constexpr size_t OFF_PKB = al(OFF_VCB + 2ull * 2 * 1024 * 64 * 2);
constexpr size_t OFF_W1T = al(OFF_PKB + 2ull * 2 * 128 * 128 * 2);
constexpr size_t OFF_BAR = al(OFF_W1T + 4ull * 128 * 2048 * 2);
constexpr size_t BAR_BYTES = 3456 * 4;
constexpr size_t OFF_PROBE = al(OFF_BAR + BAR_BYTES);
constexpr size_t OFF_H = al(OFF_PROBE + 256);
constexpr size_t OFF_ONSA = al(OFF_H + (size_t)T * 1024 * 2);
constexpr size_t OFF_OMOBA = al(OFF_ONSA + (size_t)T * 512 * 2);
constexpr size_t OFF_PROJ = al(OFF_OMOBA + (size_t)T * 512 * 2);
constexpr size_t KV2_BYTES = (size_t)Bn * 2 * S * 64 * 2, KV8_BYTES = (size_t)Bn * 8 * S * 64 * 2;
constexpr size_t OFF_KSB = al(OFF_PROJ + (size_t)T * PC * 2);
constexpr size_t OFF_VSB = OFF_KSB + KV2_BYTES;
constexpr size_t OFF_KWB = OFF_VSB + KV2_BYTES;
constexpr size_t OFF_VWB = OFF_KWB + KV2_BYTES;
constexpr size_t OFF_MKB = OFF_VWB + KV2_BYTES;
constexpr size_t OFF_MVB = OFF_MKB + KV8_BYTES;
constexpr int MLIST_PER_BH = 63 * S - 128 * 63 * 64;
constexpr size_t OFF_MLIST = OFF_MVB + KV8_BYTES;
constexpr size_t OFF_MCNT = al(OFF_MLIST + (size_t)Bn * 8 * MLIST_PER_BH * 2);
constexpr size_t WS_NEED = OFF_MCNT + (size_t)Bn * 8 * 64 * 4;
constexpr size_t PROJ_BYTES = (size_t)T * PC * 2;
constexpr size_t OFF_MPO = OFF_H;
constexpr size_t OFF_MPML = OFF_H + (size_t)8 * S * 3 * 64 * 2;
static_assert((size_t)8 * S * 3 * 64 * 2 + (size_t)8 * S * 3 * 8 <= (size_t)T * 1024 * 2, "moba partials must fit the H region");
constexpr size_t OFF_QP = OFF_PROJ;
constexpr size_t OFF_PEIDX = al(OFF_QP + (size_t)T * 2048 * 2);
constexpr size_t OFF_PEG = al(OFF_PEIDX + (size_t)T * 128 * 4);
constexpr size_t OFF_E8 = al(OFF_PEG + (size_t)T * 128 * 4);
constexpr size_t OFF_ESC = al(OFF_E8 + (size_t)NEXP * 2048);
static_assert(OFF_ESC + (size_t)NEXP * 2 * 4 <= OFF_PROJ + PROJ_BYTES, "peer alias overflow");
static_assert(WS_NEED <= 536870912ull, "workspace too big");
#ifndef PROBE_MOBA
#define PROBE_MOBA 0
#endif
constexpr size_t OFF_CMP = PROBE_MOBA ? OFF_ONSA : OFF_MLIST;
#ifndef REP_NSA_ONLY
#define REP_NSA_ONLY 0
#endif
#ifndef REP_NSA_PART
#define REP_NSA_PART 0
#endif
#ifndef REP_MASK
#define REP_MASK 0
#endif
#ifndef PROBE_MOBA
#define PROBE_MOBA 0
#endif
#ifndef PROBE_NSA
#define PROBE_NSA 0
#endif
#ifndef PROBE_CMPR
#define PROBE_CMPR 0
#endif
#ifndef PROBE_PROJ
#define PROBE_PROJ 0
#endif
#define PROBE_ANY (PROBE_MOBA || PROBE_NSA || PROBE_CMPR || PROBE_PROJ)
constexpr size_t WS_TOTAL = WS_NEED;
static_assert(WS_TOTAL <= 536870912ull, "workspace too big (probe)");

struct Params {
  const float *x, *c, *w_ada, *b_ada, *g_attn, *g_ffn, *w_in, *cmp_pe, *cmp_w1, *cmp_w2, *w_up_nsa, *w_up_moba, *w_out,
      *peer_wq, *peer_k1, *peer_k2, *peer_u, *peer_v, *g_final;
  float* out;
  char* ws;
};

constexpr int SMEM_BYTES = 74 * 1024;

DEV int tidx() {
  int t = threadIdx.x;
  asm volatile("" : "+v"(t));
  return t;
}
#define MFMA16B(a, b, c) __builtin_amdgcn_mfma_f32_16x16x32_bf16(a, b, c, 0, 0, 0)
DEV unsigned cvtpk_(float lo, float hi) {
  unsigned r;
  asm("v_cvt_pk_bf16_f32 %0, %1, %2" : "=v"(r) : "v"(lo), "v"(hi));
  return r;
}
DEV float bf2f(bf16 h) { return __uint_as_float(((unsigned)h) << 16); }
DEV bf16 f2bf(float f) {
  unsigned u = __float_as_uint(f);
  u += 0x7fffu + ((u >> 16) & 1u);
  return (bf16)(u >> 16);
}
DEV float gelu_tanh(float x) {
  float u = 0.7978845608028654f * (x + 0.044715f * x * x * x);
  return 0.5f * x * (1.f + tanhf(u));
}
DEV float sigmoidf_(float x) { return 1.f / (1.f + expf(-x)); }
DEV void unpack8(uint4 v, float* f) {
  f[0] = __uint_as_float(v.x << 16); f[1] = __uint_as_float(v.x & 0xffff0000u);
  f[2] = __uint_as_float(v.y << 16); f[3] = __uint_as_float(v.y & 0xffff0000u);
  f[4] = __uint_as_float(v.z << 16); f[5] = __uint_as_float(v.z & 0xffff0000u);
  f[6] = __uint_as_float(v.w << 16); f[7] = __uint_as_float(v.w & 0xffff0000u);
}
DEV float dot64_bf(const float* q, const bf16* row) {
  float s = 0.f;
#pragma unroll
  for (int i = 0; i < 8; ++i) {
    float f[8];
    unpack8(*(const uint4*)(row + i * 8), f);
#pragma unroll
    for (int j = 0; j < 8; ++j) s += q[i * 8 + j] * f[j];
  }
  return s;
}
DEV void axpy64_bf(float* o, float a, const bf16* row) {
#pragma unroll
  for (int i = 0; i < 8; ++i) {
    float f[8];
    unpack8(*(const uint4*)(row + i * 8), f);
#pragma unroll
    for (int j = 0; j < 8; ++j) o[i * 8 + j] += a * f[j];
  }
}
DEV float dot64_f(const float* q, const float* row) {
  float s = 0.f;
#pragma unroll
  for (int i = 0; i < 16; ++i) {
    float4 v = *(const float4*)(row + i * 4);
    s += q[i * 4] * v.x + q[i * 4 + 1] * v.y + q[i * 4 + 2] * v.z + q[i * 4 + 3] * v.w;
  }
  return s;
}
DEV void axpy64_f(float* o, float a, const float* row) {
#pragma unroll
  for (int i = 0; i < 16; ++i) {
    float4 v = *(const float4*)(row + i * 4);
    o[i * 4] += a * v.x; o[i * 4 + 1] += a * v.y; o[i * 4 + 2] += a * v.z; o[i * 4 + 3] += a * v.w;
  }
}
DEV void load_q64(float* q, const bf16* p, float scale) {
#pragma unroll
  for (int i = 0; i < 8; ++i) unpack8(*(const uint4*)(p + i * 8), q + i * 8);
#pragma unroll
  for (int i = 0; i < 64; ++i) q[i] *= scale;
}
DEV int lane_id_() { return __builtin_amdgcn_mbcnt_hi(~0u, __builtin_amdgcn_mbcnt_lo(~0u, 0u)); }
DEV int shx(int v, int m) {
  if (m == 1) return __builtin_amdgcn_update_dpp(0, v, 0xB1, 0xF, 0xF, true);
  if (m == 2) return __builtin_amdgcn_update_dpp(0, v, 0x4E, 0xF, 0xF, true);
  if (m == 4) return __builtin_amdgcn_ds_swizzle(v, 0x101F);
  if (m == 8) return __builtin_amdgcn_update_dpp(0, v, 0x128, 0xF, 0xF, true);
  if (m == 16) return __builtin_amdgcn_ds_swizzle(v, 0x401F);
  auto rr = __builtin_amdgcn_permlane32_swap((unsigned)v, (unsigned)v, false, false);
  return (lane_id_() < 32) ? (int)rr[1] : (int)rr[0];
}
DEV unsigned shx(unsigned v, int m) { return (unsigned)shx((int)v, m); }
DEV float shx(float v, int m) { return __int_as_float(shx(__float_as_int(v), m)); }
DEV float wave_sum(float v) {
#pragma unroll
  for (int o = 32; o >= 1; o >>= 1) v += shx(v, o);
  return v;
}

#define XB_TMO      128
#define XB_XCNT(j)  (256  + 64 * (j))
#define XB_XSUB(j)  (1280 + 64 * (j))
#define XB_XGEN(j)  (2304 + 64 * (j))
#define XB_TOP      3328
#define XB_TOPGEN   3392
#define XCD_BAR_WORDS 3456
#define XB_SPIN_CAP (1u << 18)
#define LAS __attribute__((address_space(3)))

__device__ __forceinline__ unsigned xb_ld(unsigned* p)              { return __hip_atomic_load(p, __ATOMIC_RELAXED, __HIP_MEMORY_SCOPE_AGENT); }
__device__ __forceinline__ unsigned xb_add(unsigned* p, unsigned v) { return __hip_atomic_fetch_add(p, v, __ATOMIC_RELAXED, __HIP_MEMORY_SCOPE_AGENT); }
__device__ __forceinline__ unsigned xb_xcc_id() { return (unsigned)__builtin_amdgcn_s_getreg((3 << 11) | 20) & 0xFu; }
#define XB_SPIN(cond, bar) do { unsigned _sp = 0; while (cond) { __builtin_amdgcn_s_sleep(1); \
    if ((++_sp & 255u) == 0u) { if (xb_ld(&(bar)[XB_TMO])) break; if (_sp > XB_SPIN_CAP) { atomicAdd(&(bar)[XB_TMO], 1u); break; } } } } while (0)

struct XcdBarrier {
    unsigned* bar; unsigned x;
    volatile LAS unsigned* st;
};

__device__ __forceinline__ XcdBarrier xcd_barrier_post(unsigned* bar, volatile LAS unsigned* st) {
    XcdBarrier b; b.bar = bar; b.x = xb_xcc_id(); b.st = st;
    if (tidx() == 0) (void)xb_add(&bar[XB_XCNT(b.x)], 1u);
    return b;
}
__device__ __forceinline__ void xcd_barrier_complete(unsigned* bar, unsigned x, unsigned& nloc, unsigned& nx) {
    const unsigned G = gridDim.x * gridDim.y * gridDim.z;
    unsigned sum, cnt, mine, sp = 0u;
    for (;;) {
        sum = 0u; cnt = 0u; mine = 0u;
#pragma unroll
        for (unsigned j = 0; j < 16; ++j) { const unsigned c = xb_ld(&bar[XB_XCNT(j)]); sum += c; cnt += (c > 0u) ? 1u : 0u; mine = (j == x) ? c : mine; }
        if (sum == G) break;
        __builtin_amdgcn_s_sleep(1);
        if ((++sp & 255u) == 0u) { if (xb_ld(&bar[XB_TMO])) break; if (sp > XB_SPIN_CAP) { atomicAdd(&bar[XB_TMO], 1u); break; } }
    }
    nloc = mine > 0u ? mine : 1u; nx = cnt > 0u ? cnt : 1u;
}

__device__ __forceinline__ void xcd_barrier(const XcdBarrier& b) {
    asm volatile("s_waitcnt vmcnt(0)" ::: "memory");
    __syncthreads();
    if (tidx() == 0) {
        unsigned* bar = b.bar;
        __builtin_amdgcn_s_waitcnt(0);
        unsigned nloc = b.st[0], nx = b.st[1];
        if (nloc == 0u) { xcd_barrier_complete(bar, b.x, nloc, nx); b.st[0] = nloc; b.st[1] = nx; }
        const unsigned old = xb_add(&bar[XB_XSUB(b.x)], 1u);
        const unsigned gen = old / nloc;
        if (old + 1u == (gen + 1u) * nloc) {
            __builtin_amdgcn_fence(__ATOMIC_RELEASE, "agent");
            asm volatile("s_waitcnt vmcnt(0)" ::: "memory");
            const unsigned og = xb_add(&bar[XB_TOP], 1u);
            const unsigned tg = og / nx;
            if (og + 1u == (tg + 1u) * nx) xb_add(&bar[XB_TOPGEN], 1u);
            else XB_SPIN(xb_ld(&bar[XB_TOPGEN]) == tg, bar);
            __builtin_amdgcn_fence(__ATOMIC_ACQUIRE, "agent");
            xb_add(&bar[XB_XGEN(b.x)], 1u);
            asm volatile("s_waitcnt vmcnt(0)" ::: "memory");
        } else {
            XB_SPIN(xb_ld(&bar[XB_XGEN(b.x)]) == gen, bar);
            __builtin_amdgcn_fence(__ATOMIC_ACQUIRE, "agent");
            asm volatile("s_waitcnt vmcnt(0)" ::: "memory");
        }
    }
    __syncthreads();
}


DEV int win_col_map(int j) {
  if (j < 1280) return j;
  if (j < 4864) return j + 24;
  if (j < 4888) return j - 4864 + 1280;
  return -1;
}
DEV void tr_tile(const float* __restrict__ src, int ldsrc, int K, bf16* __restrict__ dst, int kt, int nt, bool remap,
                 float* sm) {
  const int tid = tidx();
#pragma unroll 4
  for (int i = 0; i < 16; ++i) {
    int r = i * 4 + (tid >> 6), cx = tid & 63;
    int j = nt * 64 + cx, k = kt * 64 + r;
    int oc = remap ? win_col_map(j) : j;
    sm[r * 65 + cx] = (oc >= 0) ? src[(size_t)k * ldsrc + oc] : 0.f;
  }
  __syncthreads();
#pragma unroll 4
  for (int i = 0; i < 16; ++i) {
    int n = i * 4 + (tid >> 6), kk = tid & 63;
    dst[(size_t)(nt * 64 + n) * K + kt * 64 + kk] = f2bf(sm[kk * 65 + n]);
  }
  __syncthreads();
}

constexpr int PREP_TR_WIN = 2 * 78 * 16;
constexpr int PREP_TR_UPN = 2 * 16 * 8;
constexpr int PREP_TR_UPM = 2 * 16 * 8;
constexpr int PREP_TR_OUT = 2 * 16 * 16;
constexpr int PREP_TR_WQ = 2 * 32 * 16;
constexpr int PREP_ROPE = 512;
constexpr int PREP_MOD = 384;
constexpr int PREP_PEB = 16;
constexpr int PREP_PK = 32;
constexpr int PREP_TR_W1 = 4 * 2 * 32;
constexpr int PREP_ITEMS = PREP_TR_WIN + PREP_TR_UPN + PREP_TR_UPM + PREP_TR_OUT + PREP_TR_WQ + PREP_ROPE + PREP_MOD + PREP_PEB + PREP_PK + PREP_TR_W1;

DEV void prep_item(const Params& p, int item, float* sm) {
  const int tid = tidx();
  if (item < PREP_TR_WIN) {
    int l = item / (78 * 16), r = item % (78 * 16);
    int nt = r / 16, kt = r % 16;
    tr_tile(p.w_in + (size_t)l * 1024 * 4888, 4888, 1024, (bf16*)(p.ws + OFF_WINT) + (size_t)l * WN * 1024, kt, nt, true, sm);
    return;
  }
  item -= PREP_TR_WIN;
  if (item < PREP_TR_UPN) {
    int l = item / 128, r = item % 128;
    int nt = r / 8, kt = r % 8;
    tr_tile(p.w_up_nsa + (size_t)l * 512 * 1024, 1024, 512, (bf16*)(p.ws + OFF_WUPN) + (size_t)l * 1024 * 512, kt, nt, false, sm);
    return;
  }
  item -= PREP_TR_UPN;
  if (item < PREP_TR_UPM) {
    int l = item / 128, r = item % 128;
    int nt = r / 8, kt = r % 8;
    tr_tile(p.w_up_moba + (size_t)l * 512 * 1024, 1024, 512, (bf16*)(p.ws + OFF_WUPM) + (size_t)l * 1024 * 512, kt, nt, false, sm);
    return;
  }
  item -= PREP_TR_UPM;
  if (item < PREP_TR_OUT) {
    int l = item / 256, r = item % 256;
    int nt = r / 16, kt = r % 16;
    tr_tile(p.w_out + (size_t)l * 1024 * 1024, 1024, 1024, (bf16*)(p.ws + OFF_WOUT) + (size_t)l * 1024 * 1024, kt, nt, false, sm);
    return;
  }
  item -= PREP_TR_OUT;
  if (item < PREP_TR_WQ) {
    int l = item / 512, r = item % 512;
    int nt = r / 16, kt = r % 16;
    tr_tile(p.peer_wq + (size_t)l * 1024 * 2048, 2048, 1024, (bf16*)(p.ws + OFF_WQ) + (size_t)l * 2048 * 1024, kt, nt, false, sm);
    return;
  }
  item -= PREP_TR_WQ;
  if (item < PREP_ROPE) {
    int idx = item * 256 + tid;
    int pos = idx >> 3, i = idx & 7;
    float inv = powf(500000.0f, -(float)i / 8.0f);
    float ang = (float)pos * inv;
    float* rp = (float*)(p.ws + OFF_ROPE) + (size_t)pos * 16;
    rp[i] = (float)cos((double)ang);
    rp[8 + i] = (float)sin((double)ang);
    return;
  }
  item -= PREP_ROPE;
  if (item < PREP_MOD) {
    for (int i = tid; i < 2048; i += 256) {
      float cv = p.c[i];
      sm[i] = cv / (1.f + expf(-cv));
    }
    __syncthreads();
    const int l = item / 192, n0 = (item % 192) * 32;
    const int col = tid & 31, ks = tid >> 5;
    const float* w = p.w_ada + (size_t)l * 1024 * 6144 + n0 + col;
    float a0 = 0.f, a1 = 0.f;
#pragma unroll 8
    for (int k = ks * 128; k < ks * 128 + 128; ++k) {
      float wv = w[(size_t)k * 6144];
      a0 += sm[k] * wv;
      a1 += sm[1024 + k] * wv;
    }
    sm[2048 + tid * 2] = a0;
    sm[2048 + tid * 2 + 1] = a1;
    __syncthreads();
    if (tid < 64) {
      const int c2 = tid & 31, bs = tid >> 5;
      float s = 0.f;
#pragma unroll
      for (int q = 0; q < 8; ++q) s += sm[2048 + (q * 32 + c2) * 2 + bs];
      ((float*)(p.ws + OFF_MOD))[(l * 2 + bs) * 6144 + n0 + c2] = s + p.b_ada[l * 6144 + n0 + c2];
    }
    __syncthreads();
    return;
  }
  item -= PREP_MOD;
  if (item < PREP_PEB) {
    const int lw = item >> 2, j0 = (item & 3) * 32;
    const int col = tid & 31, ks = tid >> 5;
    const float* pe = p.cmp_pe + (size_t)lw * 2048;
    const float* w1 = p.cmp_w1 + (size_t)lw * 2048 * 128 + j0 + col;
    float a = 0.f;
#pragma unroll 8
    for (int i = ks * 256; i < ks * 256 + 256; ++i) a += pe[i] * w1[(size_t)i * 128];
    sm[tid] = a;
    __syncthreads();
    if (tid < 32) {
      float s = 0.f;
#pragma unroll
      for (int q = 0; q < 8; ++q) s += sm[q * 32 + tid];
      ((float*)(p.ws + OFF_PEB))[lw * 128 + j0 + tid] = s;
    }
    if (item == 0 && tid < 4) ((float*)(p.ws + OFF_PROBE))[tid] = 0.f;
    __syncthreads();
    return;
  }
  item -= PREP_PEB;
  if (item < PREP_PK) {
    const int e0 = item * 2048 + tid * 8;
    const int lt = e0 >> 14, off = e0 & 16383;
    const float* srcp = ((lt & 1) ? p.peer_k2 : p.peer_k1) + (size_t)(lt >> 1) * 16384 + off;
    const float4 a = *(const float4*)srcp, b4 = *(const float4*)(srcp + 4);
    uint4 pk;
    pk.x = (unsigned)f2bf(a.x) | ((unsigned)f2bf(a.y) << 16);
    pk.y = (unsigned)f2bf(a.z) | ((unsigned)f2bf(a.w) << 16);
    pk.z = (unsigned)f2bf(b4.x) | ((unsigned)f2bf(b4.y) << 16);
    pk.w = (unsigned)f2bf(b4.z) | ((unsigned)f2bf(b4.w) << 16);
    *(uint4*)((bf16*)(p.ws + OFF_PKB) + e0) = pk;
    return;
  }
  item -= PREP_PK;
  {
    const int lw = item >> 6, r = item & 63;
    const int nt = r >> 5, kt = r & 31;
    tr_tile(p.cmp_w1 + (size_t)lw * 2048 * 128, 128, 2048, (bf16*)(p.ws + OFF_W1T) + (size_t)lw * 128 * 2048, kt, nt, false, sm);
  }
}

DEV void norm_item(const float* __restrict__ xin, const float* __restrict__ g, const float* __restrict__ sc,
                   const float* __restrict__ sh, bf16* __restrict__ hout, int item) {
  const int lane = tidx() & 63, wave = tidx() >> 6;
  const size_t tok = (size_t)item * 4 + wave;
  const int b = (int)(tok / S);
  const float* xr = xin + tok * 1024;
  float4 v[4];
  float ss = 0.f;
#pragma unroll
  for (int i = 0; i < 4; ++i) {
    v[i] = *(const float4*)(xr + i * 256 + lane * 4);
    ss += v[i].x * v[i].x + v[i].y * v[i].y + v[i].z * v[i].z + v[i].w * v[i].w;
  }
  ss = wave_sum(ss);
  float r = 1.0f / sqrtf(ss * (1.0f / 1024.f) + 1e-6f);
#pragma unroll
  for (int i = 0; i < 4; ++i) {
    int d = i * 256 + lane * 4;
    float4 gg = *(const float4*)(g + d);
    float4 s4 = *(const float4*)(sc + b * 6144 + d);
    float4 h4 = *(const float4*)(sh + b * 6144 + d);
    float o0 = v[i].x * r * gg.x * (1.f + s4.x) + h4.x;
    float o1 = v[i].y * r * gg.y * (1.f + s4.y) + h4.y;
    float o2 = v[i].z * r * gg.z * (1.f + s4.z) + h4.z;
    float o3 = v[i].w * r * gg.w * (1.f + s4.w) + h4.w;
    uint2 pk;
    pk.x = (unsigned)f2bf(o0) | ((unsigned)f2bf(o1) << 16);
    pk.y = (unsigned)f2bf(o2) | ((unsigned)f2bf(o3) << 16);
    *(uint2*)(hout + tok * 1024 + d) = pk;
  }
}
DEV void final_norm_item(float* __restrict__ x, const float* __restrict__ g, int item) {
  const int lane = tidx() & 63, wave = tidx() >> 6;
  const size_t tok = (size_t)item * 4 + wave;
  float* xr = x + tok * 1024;
  float4 v[4];
  float ss = 0.f;
#pragma unroll
  for (int i = 0; i < 4; ++i) {
    v[i] = *(const float4*)(xr + i * 256 + lane * 4);
    ss += v[i].x * v[i].x + v[i].y * v[i].y + v[i].z * v[i].z + v[i].w * v[i].w;
  }
  ss = wave_sum(ss);
  float r = 1.0f / sqrtf(ss * (1.0f / 1024.f) + 1e-6f);
#pragma unroll
  for (int i = 0; i < 4; ++i) {
    int d = i * 256 + lane * 4;
    float4 gg = *(const float4*)(g + d);
    float4 o;
    o.x = v[i].x * r * gg.x; o.y = v[i].y * r * gg.y; o.z = v[i].z * r * gg.z; o.w = v[i].w * r * gg.w;
    *(float4*)(xr + d) = o;
  }
}

#define GM_BUF (2 * 128 * 72)
#define GM_LOAD(R, kk)                                                                                  \
  {                                                                                                     \
    const bf16* Ak = Ap + (kk);                                                                         \
    const bf16* Wk = Wp + (kk);                                                                         \
    R##a0 = *(const uint4*)(Ak); R##a1 = *(const uint4*)(Ak + a32); R##a2 = *(const uint4*)(Ak + 2 * a32); \
    R##a3 = *(const uint4*)(Ak + 3 * a32);                                                              \
    R##b0 = *(const uint4*)(Wk); R##b1 = *(const uint4*)(Wk + w32); R##b2 = *(const uint4*)(Wk + 2 * w32); \
    R##b3 = *(const uint4*)(Wk + 3 * w32);                                                              \
  }
#define GM_STORE(R, buf)                                                                                \
  {                                                                                                     \
    bf16* as_ = Asw + (buf) * GM_BUF;                                                                   \
    bf16* bs_ = as_ + 128 * 72;                                                                         \
    *(uint4*)(as_) = R##a0; *(uint4*)(as_ + 32 * 72) = R##a1; *(uint4*)(as_ + 64 * 72) = R##a2; *(uint4*)(as_ + 96 * 72) = R##a3; \
    *(uint4*)(bs_) = R##b0; *(uint4*)(bs_ + 32 * 72) = R##b1; *(uint4*)(bs_ + 64 * 72) = R##b2; *(uint4*)(bs_ + 96 * 72) = R##b3; \
  }
#define GM_COMPUTE(buf)                                                                                 \
  {                                                                                                     \
    const bf16* As_ = sm + (buf) * GM_BUF;                                                              \
    const bf16* Bs_ = As_ + 128 * 72;                                                                   \
    _Pragma("unroll") for (int ks = 0; ks < 2; ++ks) {                                                  \
      __builtin_amdgcn_sched_barrier(0);                                                                \
      bf16x8 af[4], bfr[4];                                                                             \
      _Pragma("unroll") for (int mi = 0; mi < 4; ++mi)                                                  \
        af[mi] = *(const bf16x8*)(As_ + (wr * 64 + mi * 16 + (lane & 15)) * 72 + ks * 32 + (lane >> 4) * 8); \
      _Pragma("unroll") for (int ni = 0; ni < 4; ++ni)                                                  \
        bfr[ni] = *(const bf16x8*)(Bs_ + (wc * 64 + ni * 16 + (lane & 15)) * 72 + ks * 32 + (lane >> 4) * 8); \
      _Pragma("unroll") for (int mi = 0; mi < 4; ++mi)                                                  \
        _Pragma("unroll") for (int ni = 0; ni < 4; ++ni)                                                \
          acc[mi][ni] = __builtin_amdgcn_mfma_f32_16x16x32_bf16(af[mi], bfr[ni], acc[mi][ni], 0, 0, 0); \
    }                                                                                                   \
    __builtin_amdgcn_sched_barrier(0);                                                                  \
  }
DEV void gemm_mainloop(const bf16* __restrict__ A, int lda, const bf16* __restrict__ W, int K, int m0, int n0, bf16* sm,
                       f32x4 (&acc)[4][4]) {
  const int tid = tidx(), lane = tid & 63, wave = tid >> 6;
  const int wr = wave >> 1, wc = wave & 1;
  const int lrow = tid >> 3, lkc = (tid & 7) * 8;
  const bf16* Ap = A + (size_t)(m0 + lrow) * lda + lkc;
  const bf16* Wp = W + (size_t)(n0 + lrow) * K + lkc;
  const int a32 = 32 * lda, w32 = 32 * K;
  bf16* Asw = sm + lrow * 72 + lkc;
  uint4 xa0, xa1, xa2, xa3, xb0, xb1, xb2, xb3, ya0, ya1, ya2, ya3, yb0, yb1, yb2, yb3;
  const int nk = K >> 6;
  GM_LOAD(x, 0)
  GM_LOAD(y, 64)
  __syncthreads();
  GM_STORE(x, 0)
  if (nk > 2) GM_LOAD(x, 128)
  __syncthreads();
  for (int k = 0; k < nk; k += 2) {
    GM_COMPUTE(0)
    GM_STORE(y, 1)
    if (k + 3 < nk) GM_LOAD(y, (k + 3) * 64)
    __syncthreads();
    GM_COMPUTE(1)
    if (k + 2 < nk) {
      GM_STORE(x, 0)
      if (k + 4 < nk) GM_LOAD(x, (k + 4) * 64)
    }
    __syncthreads();
  }
}
DEV void acc_zero(f32x4 (&acc)[4][4]) {
#pragma unroll
  for (int i = 0; i < 4; ++i)
#pragma unroll
    for (int j = 0; j < 4; ++j) acc[i][j] = f32x4{0.f, 0.f, 0.f, 0.f};
}
DEV void store_tile_bf16(bf16* sm, const f32x4 (&acc)[4][4], bf16* __restrict__ dbase, size_t dstride) {
  const int tid = tidx(), lane = tid & 63, wave = tid >> 6, g4 = lane >> 4, c16 = lane & 15;
  bf16* Cw = sm + wave * (64 * 72);
  __syncthreads();
#pragma unroll
  for (int mi = 0; mi < 4; ++mi)
#pragma unroll
    for (int ni = 0; ni < 4; ++ni)
#pragma unroll
      for (int r = 0; r < 4; ++r) Cw[(mi * 16 + g4 * 4 + r) * 72 + ni * 16 + c16] = f2bf(acc[mi][ni][r]);
  __syncthreads();
#pragma unroll
  for (int it = 0; it < 8; ++it) {
    const int row_l = it * 8 + (lane >> 3), ch = lane & 7;
    const uint4 v = *(const uint4*)(Cw + row_l * 72 + ch * 8);
    *(uint4*)(dbase + (size_t)row_l * dstride + ch * 8) = v;
  }
}
template <class Epi>
DEV void gemm_tile(const bf16* __restrict__ A, int lda, const bf16* __restrict__ W, int K, int m0, int n0, bf16* sm,
                   Epi epi) {
  f32x4 acc[4][4];
  acc_zero(acc);
  gemm_mainloop(A, lda, W, K, m0, n0, sm, acc);
  const int tid = tidx(), lane = tid & 63, wave = tid >> 6;
  const int wr = wave >> 1, wc = wave & 1;
#pragma unroll
  for (int mi = 0; mi < 4; ++mi)
#pragma unroll
    for (int ni = 0; ni < 4; ++ni)
#pragma unroll
      for (int r = 0; r < 4; ++r) {
        int row = m0 + wr * 64 + mi * 16 + (lane >> 4) * 4 + r;
        int col = n0 + wc * 64 + ni * 16 + (lane & 15);
        epi(row, col, acc[mi][ni][r]);
      }
}
DEV void inproj_tile(const Params& p, int layer, int m0, int n0, bf16* sm) {
  f32x4 acc[4][4];
  acc_zero(acc);
  gemm_mainloop((const bf16*)(p.ws + OFF_H), 1024, (const bf16*)(p.ws + OFF_WINT) + (size_t)layer * WN * 1024, 1024, m0, n0, sm, acc);
  const int tid = tidx(), lane = tid & 63, wave = tid >> 6, g4 = lane >> 4, c16 = lane & 15;
  const int wr = wave >> 1, wc = wave & 1;
  const int vc0 = n0 + wc * 64;
  const int row0 = m0 + wr * 64;
  const int b = row0 / S, t0 = row0 % S;
  bf16* dbase;
  size_t dstride;
  bool roped = false;
  bf16* projp = (bf16*)(p.ws + OFF_PROJ) + (size_t)row0 * PC;
  if (vc0 < 768) { dbase = projp + vc0; dstride = PC; }
  else if (vc0 < 1280) {
    const int seg = (vc0 - 768) >> 7, head = ((vc0 - 768) >> 6) & 1;
    const size_t off = (seg == 0) ? OFF_KSB : (seg == 1) ? OFF_VSB : (seg == 2) ? OFF_KWB : OFF_VWB;
    dbase = (bf16*)(p.ws + off) + ((size_t)(b * 2 + head) * S + t0) * 64;
    dstride = 64;
    roped = (seg == 0) || (seg == 2);
  } else if (vc0 < 1792) { dbase = projp + C_MQ + (vc0 - 1280); dstride = PC; roped = true; }
  else if (vc0 < 2816) {
    const int seg = (vc0 - 1792) >> 9, head = ((vc0 - 1792) >> 6) & 7;
    dbase = (bf16*)(p.ws + (seg ? OFF_MVB : OFF_MKB)) + ((size_t)(b * 8 + head) * S + t0) * 64;
    dstride = 64;
    roped = (seg == 0);
  } else if (vc0 < 4864) { dbase = projp + C_GN + (vc0 - 2816); dstride = PC; }
  else { dbase = projp + C_NG + (vc0 - 4864); dstride = PC; }
  if (roped) {
    const float* rope = (const float*)(p.ws + OFF_ROPE);
#pragma unroll
    for (int mi = 0; mi < 4; ++mi)
#pragma unroll
      for (int r = 0; r < 4; ++r) {
        const int pos = t0 + mi * 16 + g4 * 4 + r;
        const float v = acc[mi][0][r];
        const float pv = shx(v, 8);
        const float cs = rope[pos * 16 + (c16 & 7)], sn = rope[pos * 16 + 8 + (c16 & 7)];
        acc[mi][0][r] = (c16 < 8) ? (v * cs - pv * sn) : (v * cs + pv * sn);
      }
  }
  store_tile_bf16(sm, acc, dbase, dstride);
}
typedef unsigned u32x2_t __attribute__((ext_vector_type(2)));
DEV void merge_tile(const Params& p, int layer, int m0, int n0, bf16* sm) {
  const int tid = tidx(), lane = tid & 63, wave = tid >> 6, g4 = lane >> 4, c16 = lane & 15;
  const int wr = wave >> 1, wc = wave & 1;
  const bf16* projg = (const bf16*)(p.ws + OFF_PROJ) + (size_t)(m0 + wr * 64 + g4 * 4) * PC + n0 + wc * 64 + c16;
  f32x4 acc[4][4];
  acc_zero(acc);
  gemm_mainloop((const bf16*)(p.ws + OFF_ONSA), 512, (const bf16*)(p.ws + OFF_WUPN) + (size_t)layer * 1024 * 512, 512, m0, n0, sm, acc);
  bf16* yg = (bf16*)(p.ws + OFF_H) + (size_t)(m0 + wr * 64 + g4 * 4) * 1024 + n0 + wc * 64 + c16;
#pragma unroll
  for (int mi = 0; mi < 4; ++mi)
#pragma unroll
    for (int ni = 0; ni < 4; ++ni)
#pragma unroll
      for (int r = 0; r < 4; ++r)
        yg[(size_t)(mi * 16 + r) * 1024 + ni * 16] =
            f2bf(sigmoidf_(bf2f(projg[(size_t)(mi * 16 + r) * PC + C_GN + ni * 16])) * acc[mi][ni][r]);
  acc_zero(acc);
  gemm_mainloop((const bf16*)(p.ws + OFF_OMOBA), 512, (const bf16*)(p.ws + OFF_WUPM) + (size_t)layer * 1024 * 512, 512, m0, n0, sm, acc);
#pragma unroll
  for (int mi = 0; mi < 4; ++mi)
#pragma unroll
    for (int ni = 0; ni < 4; ++ni)
#pragma unroll
      for (int r = 0; r < 4; ++r)
        acc[mi][ni][r] = bf2f(yg[(size_t)(mi * 16 + r) * 1024 + ni * 16]) +
                         sigmoidf_(bf2f(projg[(size_t)(mi * 16 + r) * PC + C_GM + ni * 16])) * acc[mi][ni][r];
  store_tile_bf16(sm, acc, (bf16*)(p.ws + OFF_H) + (size_t)(m0 + wr * 64) * 1024 + n0 + wc * 64, 1024);
}

DEV void compress_item(const Params& p, int layer, int item, float* sm) {
  const int tid = tidx();
  const int grp = item & 127, which = (item >> 7) & 1, kvh = (item >> 8) & 1, b = item >> 9;
  const int c0 = grp * 8;
  float* xs = sm;
  float* hs = sm + 144 * 64;
  const bf16* proj = (const bf16*)(p.ws + OFF_PROJ);
  const int col = (which ? C_VC : C_KC) + kvh * 64;
  for (int i = tid; i < 144 * 64; i += 256) {
    int tl = i >> 6, d = i & 63;
    int t = c0 * 16 + tl;
    xs[i] = (t < S) ? bf2f(proj[((size_t)b * S + t) * PC + col + d]) : 0.f;
  }
  __syncthreads();
  const int lw = layer * 2 + which;
  if (tid < 128) {
    const float* w1 = p.cmp_w1 + (size_t)lw * 2048 * 128 + tid;
    float acc[8];
#pragma unroll
    for (int ci = 0; ci < 8; ++ci) acc[ci] = 0.f;
    for (int l = 0; l < 32; ++l) {
#pragma unroll 4
      for (int d = 0; d < 64; ++d) {
        float w = w1[(size_t)(l * 64 + d) * 128];
#pragma unroll
        for (int ci = 0; ci < 8; ++ci) acc[ci] += xs[(ci * 16 + l) * 64 + d] * w;
      }
    }
    float pb = ((const float*)(p.ws + OFF_PEB))[lw * 128 + tid];
#pragma unroll
    for (int ci = 0; ci < 8; ++ci) hs[ci * 128 + tid] = gelu_tanh(acc[ci] + pb);
  }
  __syncthreads();
  const float* w2 = p.cmp_w2 + (size_t)lw * 128 * 64;
  float* outp = PROBE_CMPR ? ((float*)(p.ws + OFF_CMP) + (which ? (size_t)Bn * 1024 * 128 : 0)) : (float*)(p.ws + (which ? OFF_VCC : OFF_KCC));
#pragma unroll
  for (int rr = 0; rr < 2; ++rr) {
    int o = rr * 256 + tid;
    int ci = o >> 6, d = o & 63;
    int c = c0 + ci;
    float a = 0.f;
    for (int j = 0; j < 128; ++j) a += hs[ci * 128 + j] * w2[j * 64 + d];
    if (c < 1023) outp[(((size_t)b * 1024 + c) * 2 + kvh) * 64 + d] = a;
    bf16* outb = (bf16*)(p.ws + (which ? OFF_VCB : OFF_KCB));
    if (!PROBE_CMPR && c < 1024) outb[(((size_t)b * 2 + kvh) * 1024 + c) * 64 + d] = (c < 1023) ? f2bf(a) : (bf16)0;
  }
  __syncthreads();
}

DEV void compress_mfma_item(const Params& p, int layer, int item, char* smem) {
  bf16* xs = (bf16*)smem;
  float* hs = (float*)(smem + 272 * 64 * 2);
  const int tid = tidx(), lane = tid & 63, wave = tid >> 6, g4 = lane >> 4, c16 = lane & 15;
  const int cblk = item & 63, which = (item >> 6) & 1, kvh = (item >> 7) & 1, b = item >> 8;
  const int t0 = cblk * 256;
  const bf16* proj = (const bf16*)(p.ws + OFF_PROJ) + (size_t)b * S * PC + (which ? C_VC : C_KC) + kvh * 64;
  __syncthreads();
  for (int i = tid; i < 272 * 8; i += 256) {
    const int tl = i >> 3, ch = i & 7;
    const int t = t0 + tl;
    uint4 v = uint4{0u, 0u, 0u, 0u};
    if (t < S) v = *(const uint4*)(proj + (size_t)t * PC + ch * 8);
    *(uint4*)(xs + tl * 64 + ((ch ^ ((tl >> 4) & 7)) * 8)) = v;
  }
  __syncthreads();
  const int lw = layer * 2 + which;
  const bf16* w1t = (const bf16*)(p.ws + OFF_W1T) + (size_t)lw * 128 * 2048;
  f32x4 acc0 = f32x4{0.f, 0.f, 0.f, 0.f}, acc1 = f32x4{0.f, 0.f, 0.f, 0.f};
  const bf16* wb0 = w1t + (size_t)((2 * wave) * 16 + c16) * 2048 + g4 * 8;
  const bf16* wb1 = w1t + (size_t)((2 * wave + 1) * 16 + c16) * 2048 + g4 * 8;
#pragma unroll 4
  for (int ks = 0; ks < 64; ++ks) {
    const int l = ks >> 1, ch = (ks & 1) * 4 + g4;
    const int tl = 16 * c16 + l;
    const bf16x8 af = *(const bf16x8*)(xs + tl * 64 + ((ch ^ ((tl >> 4) & 7)) * 8));
    const bf16x8 b0 = *(const bf16x8*)(wb0 + ks * 32);
    const bf16x8 b1 = *(const bf16x8*)(wb1 + ks * 32);
    acc0 = MFMA16B(af, b0, acc0);
    acc1 = MFMA16B(af, b1, acc1);
  }
  {
    const float* peb = (const float*)(p.ws + OFF_PEB) + lw * 128;
    const int j0 = (2 * wave) * 16 + c16, j1 = j0 + 16;
    const float pb0 = peb[j0], pb1 = peb[j1];
#pragma unroll
    for (int r = 0; r < 4; ++r) {
      hs[(g4 * 4 + r) * 128 + j0] = gelu_tanh(acc0[r] + pb0);
      hs[(g4 * 4 + r) * 128 + j1] = gelu_tanh(acc1[r] + pb1);
    }
  }
  __syncthreads();
  const float* w2 = p.cmp_w2 + (size_t)lw * 128 * 64;
  const int d = tid & 63, cq = tid >> 6;
  float o0 = 0.f, o1 = 0.f, o2 = 0.f, o3 = 0.f;
#pragma unroll 8
  for (int j = 0; j < 128; ++j) {
    const float w = w2[j * 64 + d];
    o0 += hs[(cq * 4 + 0) * 128 + j] * w;
    o1 += hs[(cq * 4 + 1) * 128 + j] * w;
    o2 += hs[(cq * 4 + 2) * 128 + j] * w;
    o3 += hs[(cq * 4 + 3) * 128 + j] * w;
  }
  float* outp = (float*)(p.ws + (which ? OFF_VCC : OFF_KCC));
  bf16* outb = (bf16*)(p.ws + (which ? OFF_VCB : OFF_KCB));
  const float ov[4] = {o0, o1, o2, o3};
#pragma unroll
  for (int i = 0; i < 4; ++i) {
    const int c = cblk * 16 + cq * 4 + i;
    if (c < 1023) outp[(((size_t)b * 1024 + c) * 2 + kvh) * 64 + d] = ov[i];
    outb[(((size_t)b * 2 + kvh) * 1024 + c) * 64 + d] = (c < 1023) ? f2bf(ov[i]) : (bf16)0;
  }
  __syncthreads();
}

DEV void n1_item(const Params& p, int layer, int item, float* sm) {
  const int chunk = item & 255, kvh = (item >> 8) & 1, b = item >> 9;
  const int tid = tidx(), ql = tid >> 2, g = tid & 3;
  const int t = chunk * 64 + ql, h = kvh * 4 + g;
  const size_t tok = (size_t)b * S + t;
  const bf16* proj = (const bf16*)(p.ws + OFF_PROJ);
  float* imp = sm;
  for (int i = tid; i < 64 * 257; i += 256) imp[i] = 0.f;
  float q[64];
  load_q64(q, proj + tok * PC + C_NQ + h * 64, 0.125f);
  const int nv = (t >= 31) ? (((t - 31) >> 4) + 1) : 0;
  const int nv_max = (((chunk * 64 + 63) - 31) >> 4) + 1;
  const float* kc = (const float*)(p.ws + OFF_KCC) + (size_t)b * 1024 * 128 + kvh * 64;
  const float* vc = (const float*)(p.ws + OFF_VCC) + (size_t)b * 1024 * 128 + kvh * 64;
  float m = -INFINITY, l = 0.f;
  for (int c = 0; c < nv_max; ++c) {
    float s = dot64_f(q, kc + (size_t)c * 128);
    if (c < nv) {
      float mn = fmaxf(m, s);
      l = l * expf(m - mn) + expf(s - mn);
      m = mn;
    }
  }
  __syncthreads();
  float o[64];
#pragma unroll
  for (int d = 0; d < 64; ++d) o[d] = 0.f;
  const float inv_l = (nv > 0) ? 1.f / l : 0.f;
  for (int c = 0; c < nv_max; ++c) {
    float s = dot64_f(q, kc + (size_t)c * 128);
    float pr = (c < nv) ? expf(s - m) * inv_l : 0.f;
    axpy64_f(o, pr, vc + (size_t)c * 128);
    float ps = pr;
    ps += shx(ps, 1);
    ps += shx(ps, 2);
    if (g == 0) {
      int n = c >> 2;
      if ((c & 3) == 3) {
        imp[ql * 257 + n] += 0.5f * ps;
        imp[ql * 257 + n + 1] += 0.5f * ps;
      } else {
        imp[ql * 257 + n] += ps;
      }
    }
  }
  const float gate0 = (!PROBE_NSA || (PROBE_NSA & 1)) ? sigmoidf_(bf2f(proj[tok * PC + C_NG + h * 3 + 0])) : 0.f;
  float* oa = (float*)(p.ws + OFF_H) + tok * 512 + h * 64;
#pragma unroll
  for (int d = 0; d < 64; d += 4) {
    float4 v = {gate0 * o[d], gate0 * o[d + 1], gate0 * o[d + 2], gate0 * o[d + 3]};
    *(float4*)(oa + d) = v;
  }
  __syncthreads();
#if PROBE_NSA == 8
  if (b == 0 && kvh == 0)
    for (int i = tid; i < 64 * 256; i += 256)
      ((float*)(p.ws + OFF_OMOBA))[(size_t)(chunk * 64 + (i >> 8)) * 256 + (i & 255)] = imp[(i >> 8) * 257 + (i & 255)];
  __syncthreads();
#endif
  if (g == 0) {
    int* selp = (int*)(p.ws + OFF_SEL) + (((size_t)b * 2 + kvh) * S + t) * 16;
    const int cur = chunk;
    if (cur < 16) {
      for (int j = 0; j < 16; ++j) selp[j] = (j <= cur) ? j : -1;
    } else {
      selp[0] = 0;
      selp[1] = cur - 1;
      selp[2] = cur;
      float* row = imp + ql * 257;
      for (int j = 3; j < 16; ++j) {
        float best = -1.f;
        int bi = 1;
        for (int n = 1; n <= cur - 2; ++n) {
          float v = row[n];
          if (v > best) { best = v; bi = n; }
        }
        selp[j] = bi;
        row[bi] = -2.f;
      }
    }
  }
  __syncthreads();
}

DEV void kmean_item(const Params& p, int item, float* sm) {
  const int n = item & 63, h = (item >> 6) & 7, b = item >> 9;
  const int tid = tidx(), d = tid & 63, part = tid >> 6;
  const bf16* mkb = (const bf16*)(p.ws + OFF_MKB);
  float a = 0.f;
  for (int i = 0; i < 64; ++i) {
    int t = n * 256 + part * 64 + i;
    a += bf2f(mkb[((size_t)(b * 8 + h) * S + t) * 64 + d]);
  }
  sm[tid] = a;
  __syncthreads();
  if (tid < 64) {
    float s = sm[tid] + sm[64 + tid] + sm[128 + tid] + sm[192 + tid];
    const size_t ko = (((size_t)b * 8 + h) * 64 + n) * 64 + tid;
    const float mean = s * (1.f / 256.f);
    ((float*)(p.ws + OFF_KMEAN))[ko] = mean;
    const bf16 hi = f2bf(mean);
    ((bf16*)(p.ws + OFF_KMHL))[ko] = hi;
    ((bf16*)(p.ws + OFF_KMHL))[(size_t)2 * 8 * 64 * 64 + ko] = f2bf(mean - bf2f(hi));
    if (tid == 0) ((int*)(p.ws + OFF_MCNT))[(b * 8 + h) * 64 + n] = 0;
  }
  __syncthreads();
}

DEV void n23_item(const Params& p, int layer, int item) {
  const int chunk = item & 255, kvh = (item >> 8) & 1, b = item >> 9;
  const int tid = tidx(), ql = tid >> 2, g = tid & 3;
  const int t = chunk * 64 + ql, h = kvh * 4 + g;
  const size_t tok = (size_t)b * S + t;
  const bf16* proj = (const bf16*)(p.ws + OFF_PROJ);
  const float* rope = (const float*)(p.ws + OFF_ROPE) + (size_t)t * 16;
  float q[64];
  load_q64(q, proj + tok * PC + C_NQ + h * 64, 1.0f);
#pragma unroll
  for (int i = 0; i < 8; ++i) {
    float cs = rope[i], sn = rope[8 + i];
    float x1 = q[i], x2 = q[8 + i];
    q[i] = x1 * cs - x2 * sn;
    q[8 + i] = x2 * cs + x1 * sn;
  }
#pragma unroll
  for (int i = 0; i < 64; ++i) q[i] *= 0.125f;
  const size_t kvo = ((size_t)(b * 2 + kvh) * S) * 64;
  const bf16* ksb = (const bf16*)(p.ws + OFF_KSB) + kvo;
  const bf16* vsb = (const bf16*)(p.ws + OFF_VSB) + kvo;
  const bf16* kwb = (const bf16*)(p.ws + OFF_KWB) + kvo;
  const bf16* vwb = (const bf16*)(p.ws + OFF_VWB) + kvo;
  const int* selp = (const int*)(p.ws + OFF_SEL) + (((size_t)b * 2 + kvh) * S + t) * 16;
  float* oa = (float*)(p.ws + OFF_H) + tok * 512 + h * 64;
  const float gate1 = (!PROBE_NSA || (PROBE_NSA & 2)) ? sigmoidf_(bf2f(proj[tok * PC + C_NG + h * 3 + 1])) : 0.f;
  const float gate2 = (!PROBE_NSA || (PROBE_NSA & 4)) ? sigmoidf_(bf2f(proj[tok * PC + C_NG + h * 3 + 2])) : 0.f;
  float o[64];
  {
    float m = -INFINITY;
    for (int j = 0; j < 16; ++j) {
      int n = selp[j];
      if (n >= 0) {
        for (int i = 0; i < 64; ++i) {
          int kpos = n * 64 + i;
          if (kpos <= t) {
            float s = dot64_bf(q, ksb + (size_t)kpos * 64);
            m = fmaxf(m, s);
          }
        }
      }
    }
    float l = 0.f;
#pragma unroll
    for (int d = 0; d < 64; ++d) o[d] = 0.f;
    for (int j = 0; j < 16; ++j) {
      int n = selp[j];
      if (n >= 0) {
        for (int i = 0; i < 64; ++i) {
          int kpos = n * 64 + i;
          if (kpos <= t) {
            float s = dot64_bf(q, ksb + (size_t)kpos * 64);
            float pr = expf(s - m);
            l += pr;
            axpy64_bf(o, pr, vsb + (size_t)kpos * 64);
          }
        }
      }
    }
    float sc = gate1 / l;
#pragma unroll
    for (int d = 0; d < 64; d += 4) {
      float4 v = *(float4*)(oa + d);
      v.x += sc * o[d]; v.y += sc * o[d + 1]; v.z += sc * o[d + 2]; v.w += sc * o[d + 3];
      *(float4*)(oa + d) = v;
    }
  }
  {
    const int s0 = chunk * 64;
    const int jlo = (s0 - 511 > 0) ? (s0 - 511) : 0;
    const int jhi = s0 + 63;
    float m = -INFINITY;
    for (int j = jlo; j <= jhi; ++j) {
      float s = dot64_bf(q, kwb + (size_t)j * 64);
      if (j <= t && j > t - 512) m = fmaxf(m, s);
    }
    float l = 0.f;
#pragma unroll
    for (int d = 0; d < 64; ++d) o[d] = 0.f;
    for (int j = jlo; j <= jhi; ++j) {
      float s = dot64_bf(q, kwb + (size_t)j * 64);
      float pr = (j <= t && j > t - 512) ? expf(s - m) : 0.f;
      l += pr;
      axpy64_bf(o, pr, vwb + (size_t)j * 64);
    }
    float sc = gate2 / l;
    bf16* ob = (bf16*)(p.ws + (PROBE_NSA ? OFF_CMP : OFF_ONSA)) + tok * 512 + h * 64;
#pragma unroll
    for (int d = 0; d < 64; d += 8) {
      float4 v0 = *(float4*)(oa + d);
      float4 v1 = *(float4*)(oa + d + 4);
      uint4 pk;
      pk.x = (unsigned)f2bf(v0.x + sc * o[d]) | ((unsigned)f2bf(v0.y + sc * o[d + 1]) << 16);
      pk.y = (unsigned)f2bf(v0.z + sc * o[d + 2]) | ((unsigned)f2bf(v0.w + sc * o[d + 3]) << 16);
      pk.z = (unsigned)f2bf(v1.x + sc * o[d + 4]) | ((unsigned)f2bf(v1.y + sc * o[d + 5]) << 16);
      pk.w = (unsigned)f2bf(v1.z + sc * o[d + 6]) | ((unsigned)f2bf(v1.w + sc * o[d + 7]) << 16);
      *(uint4*)(ob + d) = pk;
    }
  }
}

DEV void moba_item(const Params& p, int layer, int item) {
  const int blk = item & 63, h = (item >> 6) & 7, b = item >> 9;
  const int tid = tidx();
  const int t = blk * 256 + tid;
  const size_t tok = (size_t)b * S + t;
  const bf16* proj = (const bf16*)(p.ws + OFF_PROJ);
  float q[64];
  load_q64(q, proj + tok * PC + C_MQ + h * 64, 0.125f);
  const float* km = (const float*)(p.ws + OFF_KMEAN) + ((size_t)b * 8 + h) * 64 * 64;
  float b0 = -INFINITY, b1 = -INFINITY, b2 = -INFINITY;
  int i0 = -1, i1 = -1, i2 = -1;
  for (int n = 0; n < blk; ++n) {
    float v = dot64_f(q, km + n * 64);
    if (v > b0) { b2 = b1; i2 = i1; b1 = b0; i1 = i0; b0 = v; i0 = n; }
    else if (v > b1) { b2 = b1; i2 = i1; b1 = v; i1 = n; }
    else if (v > b2) { b2 = v; i2 = n; }
  }
  const bf16* mkb = (const bf16*)(p.ws + OFF_MKB) + ((size_t)(b * 8 + h) * S) * 64;
  const bf16* mvb = (const bf16*)(p.ws + OFF_MVB) + ((size_t)(b * 8 + h) * S) * 64;
  float m = -INFINITY;
  for (int sidx = 0; sidx < 3; ++sidx) {
    int n = (sidx == 0) ? i0 : (sidx == 1) ? i1 : i2;
    if (sidx < blk) {
      for (int i = 0; i < 256; ++i) {
        float s = dot64_bf(q, mkb + (size_t)(n * 256 + i) * 64);
        m = fmaxf(m, s);
      }
    }
  }
  for (int i = 0; i < 256; ++i) {
    int kpos = blk * 256 + i;
    float s = dot64_bf(q, mkb + (size_t)kpos * 64);
    if (kpos <= t) m = fmaxf(m, s);
  }
  float l = 0.f;
  float o[64];
#pragma unroll
  for (int d = 0; d < 64; ++d) o[d] = 0.f;
  for (int sidx = 0; sidx < 3; ++sidx) {
    int n = (sidx == 0) ? i0 : (sidx == 1) ? i1 : i2;
    if (sidx < blk) {
      for (int i = 0; i < 256; ++i) {
        const size_t ko = (size_t)(n * 256 + i) * 64;
        float s = dot64_bf(q, mkb + ko);
        float pr = expf(s - m);
        l += pr;
        axpy64_bf(o, pr, mvb + ko);
      }
    }
  }
  for (int i = 0; i < 256; ++i) {
    int kpos = blk * 256 + i;
    const size_t ko = (size_t)kpos * 64;
    float s = dot64_bf(q, mkb + ko);
    float pr = (kpos <= t) ? expf(s - m) : 0.f;
    l += pr;
    axpy64_bf(o, pr, mvb + ko);
  }
  const float il = 1.f / l;
  bf16* ob = (bf16*)(p.ws + (PROBE_MOBA ? OFF_CMP : OFF_OMOBA)) + tok * 512 + h * 64;
#pragma unroll
  for (int d = 0; d < 64; d += 8) {
    uint4 pk;
    pk.x = (unsigned)f2bf(o[d] * il) | ((unsigned)f2bf(o[d + 1] * il) << 16);
    pk.y = (unsigned)f2bf(o[d + 2] * il) | ((unsigned)f2bf(o[d + 3] * il) << 16);
    pk.z = (unsigned)f2bf(o[d + 4] * il) | ((unsigned)f2bf(o[d + 5] * il) << 16);
    pk.w = (unsigned)f2bf(o[d + 6] * il) | ((unsigned)f2bf(o[d + 7] * il) << 16);
    *(uint4*)(ob + d) = pk;
  }
}

typedef short v4i16_t __attribute__((ext_vector_type(4)));
typedef unsigned u32x4_t __attribute__((ext_vector_type(4)));
DEV v4i16_t lds_tr16(const bf16* p) {
  return __builtin_amdgcn_ds_read_tr16_b64_v4i16((__attribute__((address_space(3))) v4i16_t*)p);
}
DEV unsigned cvtpk(float lo, float hi) {
  unsigned r;
  asm("v_cvt_pk_bf16_f32 %0, %1, %2" : "=v"(r) : "v"(lo), "v"(hi));
  return r;
}
#define MFMA16(a, b, c) __builtin_amdgcn_mfma_f32_16x16x32_bf16(a, b, c, 0, 0, 0)
constexpr float C2 = 0.125f * 1.4426950408889634f;
constexpr int KT_LD = 72;
constexpr int KT_ELEMS = 64 * KT_LD;

template <int NI>
struct AttnSt {
  f32x4 o[4][NI];
  float m[NI], l[NI];
};
template <int NI>
DEV void attn_init(AttnSt<NI>& st) {
#pragma unroll
  for (int ni = 0; ni < NI; ++ni) {
    st.m[ni] = -INFINITY;
    st.l[ni] = 0.f;
#pragma unroll
    for (int di = 0; di < 4; ++di) st.o[di][ni] = f32x4{0.f, 0.f, 0.f, 0.f};
  }
}
#define TILE_DECL uint4 tl_k0, tl_k1, tl_v0, tl_v1
#define TILE_GLOAD(kb, vb, ld, key0)                                                        \
  do {                                                                                      \
    const int r_ = tidx() >> 3, c_ = (tidx() & 7) * 8;                            \
    tl_k0 = *(const uint4*)((kb) + (size_t)((key0) + r_) * (ld) + c_);                      \
    tl_k1 = *(const uint4*)((kb) + (size_t)((key0) + 32 + r_) * (ld) + c_);                 \
    tl_v0 = *(const uint4*)((vb) + (size_t)((key0) + r_) * (ld) + c_);                      \
    tl_v1 = *(const uint4*)((vb) + (size_t)((key0) + 32 + r_) * (ld) + c_);                 \
  } while (0)
#define TILE_SSTORE(Ks_, Vs_)                                                               \
  do {                                                                                      \
    const int r_ = tidx() >> 3, c_ = (tidx() & 7) * 8;                            \
    *(uint4*)((Ks_) + r_ * KT_LD + c_) = tl_k0;                                             \
    *(uint4*)((Ks_) + (32 + r_) * KT_LD + c_) = tl_k1;                                      \
    *(uint4*)((Vs_) + r_ * KT_LD + c_) = tl_v0;                                             \
    *(uint4*)((Vs_) + (32 + r_) * KT_LD + c_) = tl_v1;                                      \
  } while (0)
#define TL_GLOAD(P, kb, vb, ld, key0)                                                       \
  do {                                                                                      \
    const int r_ = tidx() >> 3, c_ = (tidx() & 7) * 8;                                      \
    P##_k0 = *(const uint4*)((kb) + (size_t)((key0) + r_) * (ld) + c_);                     \
    P##_k1 = *(const uint4*)((kb) + (size_t)((key0) + 32 + r_) * (ld) + c_);                \
    P##_v0 = *(const uint4*)((vb) + (size_t)((key0) + r_) * (ld) + c_);                     \
    P##_v1 = *(const uint4*)((vb) + (size_t)((key0) + 32 + r_) * (ld) + c_);                \
  } while (0)
#define TL_SSTORE(P, Ks_, Vs_)                                                              \
  do {                                                                                      \
    const int r_ = tidx() >> 3, c_ = (tidx() & 7) * 8;                                      \
    *(uint4*)((Ks_) + r_ * KT_LD + c_) = P##_k0;                                            \
    *(uint4*)((Ks_) + (32 + r_) * KT_LD + c_) = P##_k1;                                     \
    *(uint4*)((Vs_) + r_ * KT_LD + c_) = P##_v0;                                            \
    *(uint4*)((Vs_) + (32 + r_) * KT_LD + c_) = P##_v1;                                     \
  } while (0)
#define KV_SWEEP(kb_, vb_, ld_, nt_, KEYF, ...)                                             \
  {                                                                                         \
    uint4 tA_k0, tA_k1, tA_v0, tA_v1, tB_k0, tB_k1, tB_v0, tB_v1;                           \
    const int nt__ = (nt_);                                                                 \
    if (nt__ > 0) {                                                                         \
      TL_GLOAD(tA, kb_, vb_, ld_, KEYF(0));                                                 \
      TL_SSTORE(tA, smkv, smkv + KT_ELEMS);                                                 \
      if (nt__ > 1) TL_GLOAD(tA, kb_, vb_, ld_, KEYF(1));                                   \
    }                                                                                       \
    __syncthreads();                                                                        \
    for (int it0__ = 0; it0__ < nt__; it0__ += 2) {                                         \
      {                                                                                     \
        const int it = it0__;                                                               \
        if (it + 2 < nt__) TL_GLOAD(tB, kb_, vb_, ld_, KEYF(it + 2));                       \
        const bf16* Ks = smkv;                                                              \
        __VA_ARGS__                                                                         \
        if (it + 1 < nt__) TL_SSTORE(tA, smkv + 2 * KT_ELEMS, smkv + 3 * KT_ELEMS);         \
        __syncthreads();                                                                    \
      }                                                                                     \
      if (it0__ + 1 < nt__) {                                                               \
        const int it = it0__ + 1;                                                           \
        if (it + 2 < nt__) TL_GLOAD(tA, kb_, vb_, ld_, KEYF(it + 2));                       \
        const bf16* Ks = smkv + 2 * KT_ELEMS;                                               \
        __VA_ARGS__                                                                         \
        if (it + 1 < nt__) TL_SSTORE(tB, smkv, smkv + KT_ELEMS);                            \
        __syncthreads();                                                                    \
      }                                                                                     \
    }                                                                                       \
  }
template <int NI>
DEV void attn_scores(const bf16* Ks, const bf16x8 (&qf)[NI][2], f32x4 (&s)[4][NI]) {
  const int lane = tidx() & 63, g4 = lane >> 4, c16 = lane & 15;
#pragma unroll
  for (int mi = 0; mi < 4; ++mi) {
#pragma unroll
    for (int ni = 0; ni < NI; ++ni) s[mi][ni] = f32x4{0.f, 0.f, 0.f, 0.f};
#pragma unroll
    for (int ks = 0; ks < 2; ++ks) {
      bf16x8 kf = *(const bf16x8*)(Ks + (mi * 16 + c16) * KT_LD + ks * 32 + g4 * 8);
#pragma unroll
      for (int ni = 0; ni < NI; ++ni) s[mi][ni] = MFMA16(kf, qf[ni][ks], s[mi][ni]);
    }
  }
}
template <int NI>
DEV void attn_pv(const bf16* Vs, const bf16x8 (&pf)[NI][2], f32x4 (&o)[4][NI]) {
  const int lane = tidx() & 63, g4 = lane >> 4, q4 = (lane & 15) >> 2, p4 = lane & 3;
#pragma unroll
  for (int di = 0; di < 4; ++di) {
#pragma unroll
    for (int ks2 = 0; ks2 < 2; ++ks2) {
      v4i16_t v0 = lds_tr16(Vs + (ks2 * 32 + g4 * 4 + q4) * KT_LD + di * 16 + p4 * 4);
      v4i16_t v1 = lds_tr16(Vs + (ks2 * 32 + 16 + g4 * 4 + q4) * KT_LD + di * 16 + p4 * 4);
      bf16x8 vf = __builtin_shufflevector(v0, v1, 0, 1, 2, 3, 4, 5, 6, 7);
#pragma unroll
      for (int ni = 0; ni < NI; ++ni) o[di][ni] = MFMA16(vf, pf[ni][ks2], o[di][ni]);
    }
  }
}
DEV void exp4_pack(const f32x4& sv, float nm, float& ps, unsigned& w0, unsigned& w1) {
  float p0 = __builtin_amdgcn_exp2f(__builtin_fmaf(sv[0], C2, nm));
  float p1 = __builtin_amdgcn_exp2f(__builtin_fmaf(sv[1], C2, nm));
  float p2 = __builtin_amdgcn_exp2f(__builtin_fmaf(sv[2], C2, nm));
  float p3 = __builtin_amdgcn_exp2f(__builtin_fmaf(sv[3], C2, nm));
  ps += (p0 + p1) + (p2 + p3);
  w0 = cvtpk(p0, p1);
  w1 = cvtpk(p2, p3);
}
template <int NI>
DEV void attn_softmax_pv(const bf16* Vs, f32x4 (&s)[4][NI], AttnSt<NI>& st) {
  bf16x8 pf[NI][2];
#pragma unroll
  for (int ni = 0; ni < NI; ++ni) {
    float mx = -INFINITY;
#pragma unroll
    for (int mi = 0; mi < 4; ++mi)
      mx = fmaxf(fmaxf(mx, fmaxf(s[mi][ni][0], s[mi][ni][1])), fmaxf(s[mi][ni][2], s[mi][ni][3]));
    mx = fmaxf(mx, shx(mx, 16));
    mx = fmaxf(mx, shx(mx, 32));
    const float mn = fmaxf(st.m[ni], mx);
    const float mu = (mn == -INFINITY) ? 0.f : mn;
    const float corr = __builtin_amdgcn_exp2f((st.m[ni] - mu) * C2);
    st.m[ni] = mn;
    const float nm = -mu * C2;
    float ps = 0.f;
    u32x4_t wa, wb;
    unsigned t0, t1;
    exp4_pack(s[0][ni], nm, ps, t0, t1); wa.x = t0; wa.y = t1;
    exp4_pack(s[1][ni], nm, ps, t0, t1); wa.z = t0; wa.w = t1;
    exp4_pack(s[2][ni], nm, ps, t0, t1); wb.x = t0; wb.y = t1;
    exp4_pack(s[3][ni], nm, ps, t0, t1); wb.z = t0; wb.w = t1;
    st.l[ni] = st.l[ni] * corr + ps;
#pragma unroll
    for (int di = 0; di < 4; ++di) {
      st.o[di][ni][0] *= corr; st.o[di][ni][1] *= corr; st.o[di][ni][2] *= corr; st.o[di][ni][3] *= corr;
    }
    pf[ni][0] = __builtin_bit_cast(bf16x8, wa);
    pf[ni][1] = __builtin_bit_cast(bf16x8, wb);
  }
  attn_pv<NI>(Vs, pf, st.o);
}

template <int NI>
DEV void attn_softmax_pv_act(const bf16* Vs, f32x4 (&s)[4][NI], AttnSt<NI>& st, const bool (&act)[NI]) {
  bf16x8 pf[NI][2];
#pragma unroll
  for (int ni = 0; ni < NI; ++ni) {
    pf[ni][0] = bf16x8{0, 0, 0, 0, 0, 0, 0, 0};
    pf[ni][1] = bf16x8{0, 0, 0, 0, 0, 0, 0, 0};
    if (act[ni]) {
      float mx = -INFINITY;
#pragma unroll
      for (int mi = 0; mi < 4; ++mi)
        mx = fmaxf(fmaxf(mx, fmaxf(s[mi][ni][0], s[mi][ni][1])), fmaxf(s[mi][ni][2], s[mi][ni][3]));
      mx = fmaxf(mx, shx(mx, 16));
      mx = fmaxf(mx, shx(mx, 32));
      const float mn = fmaxf(st.m[ni], mx);
      const float mu = (mn == -INFINITY) ? 0.f : mn;
      const float corr = __builtin_amdgcn_exp2f((st.m[ni] - mu) * C2);
      st.m[ni] = mn;
      const float nm = -mu * C2;
      float ps = 0.f;
      u32x4_t wa, wb;
      unsigned t0, t1;
      exp4_pack(s[0][ni], nm, ps, t0, t1); wa.x = t0; wa.y = t1;
      exp4_pack(s[1][ni], nm, ps, t0, t1); wa.z = t0; wa.w = t1;
      exp4_pack(s[2][ni], nm, ps, t0, t1); wb.x = t0; wb.y = t1;
      exp4_pack(s[3][ni], nm, ps, t0, t1); wb.z = t0; wb.w = t1;
      st.l[ni] = st.l[ni] * corr + ps;
#pragma unroll
      for (int di = 0; di < 4; ++di) {
        st.o[di][ni][0] *= corr; st.o[di][ni][1] *= corr; st.o[di][ni][2] *= corr; st.o[di][ni][3] *= corr;
      }
      pf[ni][0] = __builtin_bit_cast(bf16x8, wa);
      pf[ni][1] = __builtin_bit_cast(bf16x8, wb);
    }
  }
  const int lane = tidx() & 63, g4 = lane >> 4, q4 = (lane & 15) >> 2, p4 = lane & 3;
#pragma unroll
  for (int di = 0; di < 4; ++di) {
#pragma unroll
    for (int ks2 = 0; ks2 < 2; ++ks2) {
      v4i16_t v0 = lds_tr16(Vs + (ks2 * 32 + g4 * 4 + q4) * KT_LD + di * 16 + p4 * 4);
      v4i16_t v1 = lds_tr16(Vs + (ks2 * 32 + 16 + g4 * 4 + q4) * KT_LD + di * 16 + p4 * 4);
      bf16x8 vf = __builtin_shufflevector(v0, v1, 0, 1, 2, 3, 4, 5, 6, 7);
#pragma unroll
      for (int ni = 0; ni < NI; ++ni)
        if (act[ni]) st.o[di][ni] = MFMA16(vf, pf[ni][ks2], st.o[di][ni]);
    }
  }
}
template <int NI>
DEV int gate_top1(f32x4 (&gs)[4][NI], int ni, int g4) {
  float bv = -INFINITY;
  int bi = 1 << 20;
#pragma unroll
  for (int mi = 0; mi < 4; ++mi)
#pragma unroll
    for (int r = 0; r < 4; ++r) {
      float v = gs[mi][ni][r];
      if (v > bv) { bv = v; bi = mi * 16 + g4 * 4 + r; }
    }
#pragma unroll
  for (int off = 16; off <= 32; off <<= 1) {
    float ov = shx(bv, off);
    int oi = shx(bi, off);
    if (ov > bv || (ov == bv && oi < bi)) { bv = ov; bi = oi; }
  }
#pragma unroll
  for (int mi = 0; mi < 4; ++mi)
#pragma unroll
    for (int r = 0; r < 4; ++r)
      if (mi * 16 + g4 * 4 + r == bi) gs[mi][ni][r] = -INFINITY;
  return (bv == -INFINITY) ? -1 : bi;
}
template <int NI>
DEV void moba_mfma_item(const Params& p, int item, char* smem, bf16* outbuf) {
  constexpr int QB = 64 * NI;
  bf16* sm = (bf16*)smem;
  const int bh = item & 15, cq = (S / QB - 1) - (item >> 4);
  const int b = bh >> 3, h = bh & 7;
  const int s0 = cq * QB, blk = s0 >> 8;
  const int lane = tidx() & 63, wave = tidx() >> 6, g4 = lane >> 4, c16 = lane & 15;
  const bf16* proj = (const bf16*)(p.ws + OFF_PROJ) + (size_t)b * S * PC;
  bf16x8 qf[NI][2];
  int tq[NI];
#pragma unroll
  for (int ni = 0; ni < NI; ++ni) {
    tq[ni] = s0 + wave * 16 * NI + ni * 16 + c16;
#pragma unroll
    for (int ks = 0; ks < 2; ++ks)
      qf[ni][ks] = *(const bf16x8*)(proj + (size_t)tq[ni] * PC + C_MQ + h * 64 + ks * 32 + g4 * 8);
  }
  int i0[NI], i1[NI], i2[NI];
  {
    const bf16* kmh = (const bf16*)(p.ws + OFF_KMHL) + ((size_t)(b * 8 + h) * 64) * 64;
    const bf16* kml = kmh + (size_t)2 * 8 * 64 * 64;
    f32x4 gs[4][NI];
#pragma unroll
    for (int mi = 0; mi < 4; ++mi) {
#pragma unroll
      for (int ni = 0; ni < NI; ++ni) gs[mi][ni] = f32x4{0.f, 0.f, 0.f, 0.f};
#pragma unroll
      for (int ks = 0; ks < 2; ++ks) {
        bf16x8 ah = *(const bf16x8*)(kmh + (mi * 16 + c16) * 64 + ks * 32 + g4 * 8);
        bf16x8 al_ = *(const bf16x8*)(kml + (mi * 16 + c16) * 64 + ks * 32 + g4 * 8);
#pragma unroll
        for (int ni = 0; ni < NI; ++ni) {
          gs[mi][ni] = MFMA16(ah, qf[ni][ks], gs[mi][ni]);
          gs[mi][ni] = MFMA16(al_, qf[ni][ks], gs[mi][ni]);
        }
      }
    }
#pragma unroll
    for (int ni = 0; ni < NI; ++ni) {
#pragma unroll
      for (int mi = 0; mi < 4; ++mi)
#pragma unroll
        for (int r = 0; r < 4; ++r)
          if (mi * 16 + g4 * 4 + r >= blk) gs[mi][ni][r] = -INFINITY;
      i0[ni] = gate_top1(gs, ni, g4);
      i1[ni] = gate_top1(gs, ni, g4);
      i2[ni] = gate_top1(gs, ni, g4);
    }
  }
  AttnSt<NI> st;
  attn_init<NI>(st);
  const int ntiles = (s0 + QB) >> 6;
  const bf16* kb = (const bf16*)(p.ws + OFF_MKB) + ((size_t)(b * 8 + h) * S) * 64;
  const bf16* vb = (const bf16*)(p.ws + OFF_MVB) + ((size_t)(b * 8 + h) * S) * 64;
  bf16* smkv = sm;
  __syncthreads();
#define MOBA_KEY(i) ((i) * 64)
  KV_SWEEP(kb, vb, 64, ntiles, MOBA_KEY,
    const int n = it >> 2;
    const bool own = (n == blk);
    const int kbase = it * 64;
    bool wave_active = own;
    if (!own) {
      bool anyq = false;
      _Pragma("unroll") for (int ni = 0; ni < NI; ++ni) anyq = anyq || (n == i0[ni]) || (n == i1[ni]) || (n == i2[ni]);
      wave_active = __builtin_amdgcn_ballot_w64(anyq) != 0ull;
    }
    if (wave_active) {
      f32x4 s[4][NI];
      attn_scores<NI>(Ks, qf, s);
      _Pragma("unroll") for (int ni = 0; ni < NI; ++ni) {
        if (own) {
          _Pragma("unroll") for (int mi = 0; mi < 4; ++mi)
            _Pragma("unroll") for (int r = 0; r < 4; ++r)
              if (kbase + mi * 16 + g4 * 4 + r > tq[ni]) s[mi][ni][r] = -INFINITY;
        } else {
          const bool okb = (n == i0[ni]) | (n == i1[ni]) | (n == i2[ni]);
          if (!okb) {
            _Pragma("unroll") for (int mi = 0; mi < 4; ++mi) s[mi][ni] = f32x4{-INFINITY, -INFINITY, -INFINITY, -INFINITY};
          }
        }
      }
      attn_softmax_pv<NI>(Ks + KT_ELEMS, s, st);
    }
  )
#pragma unroll
  for (int ni = 0; ni < NI; ++ni) {
    float l = st.l[ni];
    l += shx(l, 16);
    l += shx(l, 32);
    const float inv = 1.f / l;
    bf16* op = outbuf + ((size_t)b * S + tq[ni]) * 512 + h * 64 + g4 * 4;
#pragma unroll
    for (int di = 0; di < 4; ++di) {
      uint2 pk;
      pk.x = cvtpk(st.o[di][ni][0] * inv, st.o[di][ni][1] * inv);
      pk.y = cvtpk(st.o[di][ni][2] * inv, st.o[di][ni][3] * inv);
      *(uint2*)(op + di * 16) = pk;
    }
  }
}

DEV int moba_list_base(int n) { return n * S - 128 * n * (n + 1); }
template <int NI>
DEV void moba_gate_item(const Params& p, int item) {
  constexpr int QB = 64 * NI;
  const int bh = item & 15, cq = item >> 4;
  const int b = bh >> 3, h = bh & 7;
  const int s0 = cq * QB, blk = s0 >> 8;
  if (blk == 0) return;
  const int lane = tidx() & 63, wave = tidx() >> 6, g4 = lane >> 4, c16 = lane & 15;
  const bf16* proj = (const bf16*)(p.ws + OFF_PROJ) + (size_t)b * S * PC;
  bf16x8 qf[NI][2];
  int tq[NI];
#pragma unroll
  for (int ni = 0; ni < NI; ++ni) {
    tq[ni] = s0 + wave * 16 * NI + ni * 16 + c16;
#pragma unroll
    for (int ks = 0; ks < 2; ++ks)
      qf[ni][ks] = *(const bf16x8*)(proj + (size_t)tq[ni] * PC + C_MQ + h * 64 + ks * 32 + g4 * 8);
  }
  const bf16* kmh = (const bf16*)(p.ws + OFF_KMHL) + ((size_t)(b * 8 + h) * 64) * 64;
  const bf16* kml = kmh + (size_t)2 * 8 * 64 * 64;
  f32x4 gs[4][NI];
#pragma unroll
  for (int mi = 0; mi < 4; ++mi) {
#pragma unroll
    for (int ni = 0; ni < NI; ++ni) gs[mi][ni] = f32x4{0.f, 0.f, 0.f, 0.f};
#pragma unroll
    for (int ks = 0; ks < 2; ++ks) {
      bf16x8 ah = *(const bf16x8*)(kmh + (mi * 16 + c16) * 64 + ks * 32 + g4 * 8);
      bf16x8 al_ = *(const bf16x8*)(kml + (mi * 16 + c16) * 64 + ks * 32 + g4 * 8);
#pragma unroll
      for (int ni = 0; ni < NI; ++ni) {
        gs[mi][ni] = MFMA16(ah, qf[ni][ks], gs[mi][ni]);
        gs[mi][ni] = MFMA16(al_, qf[ni][ks], gs[mi][ni]);
      }
    }
  }
  unsigned short* lists = (unsigned short*)(p.ws + OFF_MLIST) + (size_t)(b * 8 + h) * MLIST_PER_BH;
  int* cnt = (int*)(p.ws + OFF_MCNT) + (b * 8 + h) * 64;
#pragma unroll
  for (int ni = 0; ni < NI; ++ni) {
#pragma unroll
    for (int mi = 0; mi < 4; ++mi)
#pragma unroll
      for (int r = 0; r < 4; ++r)
        if (mi * 16 + g4 * 4 + r >= blk) gs[mi][ni][r] = -INFINITY;
    const int s0i = gate_top1(gs, ni, g4);
    const int s1i = gate_top1(gs, ni, g4);
    const int s2i = gate_top1(gs, ni, g4);
    if (g4 == 0) {
      if (s0i >= 0) { const int pos = atomicAdd(cnt + s0i, 1); lists[moba_list_base(s0i) + pos] = (unsigned short)(tq[ni] | (0 << 14)); }
      if (s1i >= 0) { const int pos = atomicAdd(cnt + s1i, 1); lists[moba_list_base(s1i) + pos] = (unsigned short)(tq[ni] | (1 << 14)); }
      if (s2i >= 0) { const int pos = atomicAdd(cnt + s2i, 1); lists[moba_list_base(s2i) + pos] = (unsigned short)(tq[ni] | (2 << 14)); }
    }
  }
}
template <int NI>
DEV void moba_part_item(const Params& p, int b, int item, char* smem) {
  constexpr int CH = 64 * NI;
  bf16* smkv = (bf16*)smem;
  const int n = item >> 6, h = (item >> 3) & 7, part = item & 7;
  const int lane = tidx() & 63, wave = tidx() >> 6, g4 = lane >> 4, c16 = lane & 15;
  const int cnt = ((const int*)(p.ws + OFF_MCNT))[(b * 8 + h) * 64 + n];
  const unsigned short* list = (const unsigned short*)(p.ws + OFF_MLIST) + (size_t)(b * 8 + h) * MLIST_PER_BH + moba_list_base(n);
  const bf16* proj = (const bf16*)(p.ws + OFF_PROJ) + (size_t)b * S * PC;
  const bf16* kb = (const bf16*)(p.ws + OFF_MKB) + ((size_t)(b * 8 + h) * S + n * 256) * 64;
  const bf16* vb = (const bf16*)(p.ws + OFF_MVB) + ((size_t)(b * 8 + h) * S + n * 256) * 64;
  bf16* po = (bf16*)(p.ws + OFF_MPO);
  float2* pml = (float2*)(p.ws + OFF_MPML);
  for (int c = part; c * CH < cnt; c += 8) {
    bf16x8 qf[NI][2];
    int tcol[NI], slot[NI];
    bool valid[NI];
#pragma unroll
    for (int ni = 0; ni < NI; ++ni) {
      const int idx = c * CH + wave * 16 * NI + ni * 16 + c16;
      valid[ni] = idx < cnt;
      const unsigned e = list[valid[ni] ? idx : 0];
      tcol[ni] = e & 0x3FFF;
      slot[ni] = e >> 14;
#pragma unroll
      for (int ks = 0; ks < 2; ++ks)
        qf[ni][ks] = *(const bf16x8*)(proj + (size_t)tcol[ni] * PC + C_MQ + h * 64 + ks * 32 + g4 * 8);
    }
    AttnSt<NI> st;
    attn_init<NI>(st);
    __syncthreads();
#define MOBA_PKEY(i) ((i) * 64)
    KV_SWEEP(kb, vb, 64, 4, MOBA_PKEY,
      f32x4 s[4][NI];
      attn_scores<NI>(Ks, qf, s);
      attn_softmax_pv<NI>(Ks + KT_ELEMS, s, st);
    )
#pragma unroll
    for (int ni = 0; ni < NI; ++ni) {
      float l = st.l[ni];
      l += shx(l, 16);
      l += shx(l, 32);
      if (valid[ni]) {
        const size_t rec = ((size_t)h * S + tcol[ni]) * 3 + slot[ni];
        if (g4 == 0) pml[rec] = float2{st.m[ni], l};
        bf16* op = po + rec * 64 + g4 * 4;
#pragma unroll
        for (int di = 0; di < 4; ++di) {
          uint2 pk;
          pk.x = cvtpk(st.o[di][ni][0], st.o[di][ni][1]);
          pk.y = cvtpk(st.o[di][ni][2], st.o[di][ni][3]);
          *(uint2*)(op + di * 16) = pk;
        }
      }
    }
  }
}
template <int NI>
DEV void moba_merge_item(const Params& p, int b, int item, char* smem, bf16* outbuf) {
  constexpr int QB = 64 * NI;
  constexpr int NCQ = S / QB;
  bf16* smkv = (bf16*)smem;
  const int h = item / NCQ, cq = item % NCQ;
  const int s0 = cq * QB, blk = s0 >> 8;
  const int lane = tidx() & 63, wave = tidx() >> 6, g4 = lane >> 4, c16 = lane & 15;
  const bf16* proj = (const bf16*)(p.ws + OFF_PROJ) + (size_t)b * S * PC;
  bf16x8 qf[NI][2];
  int tq[NI];
#pragma unroll
  for (int ni = 0; ni < NI; ++ni) {
    tq[ni] = s0 + wave * 16 * NI + ni * 16 + c16;
#pragma unroll
    for (int ks = 0; ks < 2; ++ks)
      qf[ni][ks] = *(const bf16x8*)(proj + (size_t)tq[ni] * PC + C_MQ + h * 64 + ks * 32 + g4 * 8);
  }
  const bf16* kb = (const bf16*)(p.ws + OFF_MKB) + ((size_t)(b * 8 + h) * S) * 64;
  const bf16* vb = (const bf16*)(p.ws + OFF_MVB) + ((size_t)(b * 8 + h) * S) * 64;
  AttnSt<NI> st;
  attn_init<NI>(st);
  const int kt0 = blk * 4;
  const int ntl = ((s0 + QB - 1) >> 6) - kt0 + 1;
  __syncthreads();
#define MOBA_MKEY(i) ((kt0 + (i)) * 64)
  KV_SWEEP(kb, vb, 64, ntl, MOBA_MKEY,
    const int kbase = (kt0 + it) * 64;
    f32x4 s[4][NI];
    attn_scores<NI>(Ks, qf, s);
    _Pragma("unroll") for (int ni = 0; ni < NI; ++ni)
      _Pragma("unroll") for (int mi = 0; mi < 4; ++mi)
        _Pragma("unroll") for (int r = 0; r < 4; ++r)
          if (kbase + mi * 16 + g4 * 4 + r > tq[ni]) s[mi][ni][r] = -INFINITY;
    attn_softmax_pv<NI>(Ks + KT_ELEMS, s, st);
  )
  const int nsl = (blk < 3) ? blk : 3;
  const bf16* po = (const bf16*)(p.ws + OFF_MPO);
  const float2* pml = (const float2*)(p.ws + OFF_MPML);
#pragma unroll
  for (int ni = 0; ni < NI; ++ni) {
    float l = st.l[ni];
    l += shx(l, 16);
    l += shx(l, 32);
    const size_t rec0 = ((size_t)h * S + tq[ni]) * 3;
    float ms[3], ls[3];
    float M = st.m[ni];
#pragma unroll
    for (int s = 0; s < 3; ++s) {
      ms[s] = -INFINITY;
      ls[s] = 0.f;
      if (s < nsl) {
        const float2 v = pml[rec0 + s];
        ms[s] = v.x;
        ls[s] = v.y;
        M = fmaxf(M, v.x);
      }
    }
    const float fo = __builtin_amdgcn_exp2f((st.m[ni] - M) * C2);
    l *= fo;
    float f[3];
#pragma unroll
    for (int s = 0; s < 3; ++s) {
      f[s] = (s < nsl) ? __builtin_amdgcn_exp2f((ms[s] - M) * C2) : 0.f;
      l += ls[s] * f[s];
    }
    const float inv = 1.f / l;
    bf16* op = outbuf + ((size_t)b * S + tq[ni]) * 512 + h * 64 + g4 * 4;
#pragma unroll
    for (int di = 0; di < 4; ++di) {
      float o0 = st.o[di][ni][0] * fo, o1 = st.o[di][ni][1] * fo, o2 = st.o[di][ni][2] * fo, o3 = st.o[di][ni][3] * fo;
#pragma unroll
      for (int s = 0; s < 3; ++s) {
        if (s < nsl) {
          const uint2 pv = *(const uint2*)(po + (rec0 + s) * 64 + di * 16 + g4 * 4);
          o0 += f[s] * __uint_as_float(pv.x << 16);
          o1 += f[s] * __uint_as_float(pv.x & 0xffff0000u);
          o2 += f[s] * __uint_as_float(pv.y << 16);
          o3 += f[s] * __uint_as_float(pv.y & 0xffff0000u);
        }
      }
      uint2 pk;
      pk.x = cvtpk(o0 * inv, o1 * inv);
      pk.y = cvtpk(o2 * inv, o3 * inv);
      *(uint2*)(op + di * 16) = pk;
    }
  }
}

template <int NI>
DEV void attn_stats(f32x4 (&s)[4][NI], float (&m)[NI], float (&l)[NI]) {
#pragma unroll
  for (int ni = 0; ni < NI; ++ni) {
    float mx = -INFINITY;
#pragma unroll
    for (int mi = 0; mi < 4; ++mi)
      mx = fmaxf(fmaxf(mx, fmaxf(s[mi][ni][0], s[mi][ni][1])), fmaxf(s[mi][ni][2], s[mi][ni][3]));
    mx = fmaxf(mx, shx(mx, 16));
    mx = fmaxf(mx, shx(mx, 32));
    const float mn = fmaxf(m[ni], mx);
    const float mu = (mn == -INFINITY) ? 0.f : mn;
    const float corr = __builtin_amdgcn_exp2f((m[ni] - mu) * C2);
    m[ni] = mn;
    const float nm = -mu * C2;
    float ps = 0.f;
#pragma unroll
    for (int mi = 0; mi < 4; ++mi)
#pragma unroll
      for (int r = 0; r < 4; ++r) ps += __builtin_amdgcn_exp2f(__builtin_fmaf(s[mi][ni][r], C2, nm));
    l[ni] = l[ni] * corr + ps;
  }
}
DEV bf16x8 rope_frag(bf16x8 qv, const float* __restrict__ rope_t, int g4) {
  u32x4_t w = __builtin_bit_cast(u32x4_t, qv);
  u32x4_t pw;
  pw.x = shx(w.x, 16); pw.y = shx(w.y, 16); pw.z = shx(w.z, 16); pw.w = shx(w.w, 16);
  float f[8], pf[8];
  unpack8(uint4{w.x, w.y, w.z, w.w}, f);
  unpack8(uint4{pw.x, pw.y, pw.z, pw.w}, pf);
  const float4 c0 = *(const float4*)(rope_t), c1 = *(const float4*)(rope_t + 4);
  const float4 s0 = *(const float4*)(rope_t + 8), s1 = *(const float4*)(rope_t + 12);
  const float cs[8] = {c0.x, c0.y, c0.z, c0.w, c1.x, c1.y, c1.z, c1.w};
  const float sn[8] = {s0.x, s0.y, s0.z, s0.w, s1.x, s1.y, s1.z, s1.w};
  const float sg = (g4 == 0) ? -1.f : 1.f;
  float o[8];
#pragma unroll
  for (int i = 0; i < 8; ++i) o[i] = (g4 < 2) ? (f[i] * cs[i] + sg * pf[i] * sn[i]) : f[i];
  u32x4_t r;
  r.x = cvtpk(o[0], o[1]); r.y = cvtpk(o[2], o[3]); r.z = cvtpk(o[4], o[5]); r.w = cvtpk(o[6], o[7]);
  return __builtin_bit_cast(bf16x8, r);
}

template <int NI>
DEV void nsa_item(const Params& p, int item, char* smem, bf16* outbuf) {
  constexpr int QN = 16 * NI;
  constexpr int NCH = S / QN;
  bf16* smkv = (bf16*)smem;
  float* imp = (float*)(smem + 36864);
  int* sel = (int*)(smem + 36864 + QN * 257 * 4);
  unsigned* bmq = (unsigned*)(sel + QN * 16);
  unsigned* bmu = bmq + QN * 8;
  int* ulist = (int*)(bmu + 4 * NI * 8);
  static_assert(36864 + QN * 257 * 4 + QN * 16 * 4 + QN * 8 * 4 + 4 * NI * 8 * 4 + 257 * 4 <= SMEM_BYTES, "nsa lds");
  static_assert(NI == 2, "per-wave union bitmaps use bmu[8 .. 40)");
  const int tid = tidx(), lane = tid & 63, wave = tid >> 6, g4 = lane >> 4, c16 = lane & 15;
  const int bk = item & 3, cq = (NCH - 1) - (item >> 2);
  const int b = bk >> 1, kvh = bk & 1;
  const int s0 = cq * QN, cur = s0 >> 6;
  if (PROBE_NSA && b == 1) return;
  const bf16* proj = (const bf16*)(p.ws + OFF_PROJ) + (size_t)b * S * PC;
  const float* rope = (const float*)(p.ws + OFF_ROPE);
  int tq[NI], qlv[NI];
  float gate0[NI], gate1[NI], gate2[NI];
  bf16x8 qraw[NI][2], qrot[NI][2];
#pragma unroll
  for (int ni = 0; ni < NI; ++ni) {
    const int R = wave * 16 * NI + ni * 16 + c16;
    qlv[ni] = R >> 2;
    const int g = R & 3;
    tq[ni] = s0 + qlv[ni];
    const bf16* qp = proj + (size_t)tq[ni] * PC + C_NQ + (kvh * 4 + g) * 64 + g4 * 8;
    qraw[ni][0] = *(const bf16x8*)(qp);
    qraw[ni][1] = *(const bf16x8*)(qp + 32);
    qrot[ni][0] = rope_frag(qraw[ni][0], rope + (size_t)tq[ni] * 16, g4);
    qrot[ni][1] = qraw[ni][1];
    const bf16* gp = proj + (size_t)tq[ni] * PC + C_NG + (kvh * 4 + g) * 3;
    gate0[ni] = (!PROBE_NSA || (PROBE_NSA & 1)) ? sigmoidf_(bf2f(gp[0])) : 0.f;
    gate1[ni] = (!PROBE_NSA || (PROBE_NSA & 2)) ? sigmoidf_(bf2f(gp[1])) : 0.f;
    gate2[ni] = (!PROBE_NSA || (PROBE_NSA & 4)) ? sigmoidf_(bf2f(gp[2])) : 0.f;
  }
  for (int i = tid; i < QN * 257; i += 256) imp[i] = 0.f;
  for (int i = tid; i < QN * 8 + 4 * NI * 8; i += 256) bmq[i] = 0u;
  f32x4 acc[4][NI];
#pragma unroll
  for (int ni = 0; ni < NI; ++ni)
#pragma unroll
    for (int di = 0; di < 4; ++di) acc[di][ni] = f32x4{0.f, 0.f, 0.f, 0.f};
  TILE_DECL;
  {
    int nv[NI];
#pragma unroll
    for (int ni = 0; ni < NI; ++ni) nv[ni] = (tq[ni] >= 31) ? (((tq[ni] - 31) >> 4) + 1) : 0;
    const int tlast = s0 + QN - 1;
    const int nvmax = (tlast >= 31) ? (((tlast - 31) >> 4) + 1) : 0;
    const int ntc = (nvmax + 63) >> 6;
    const bf16* kb = (const bf16*)(p.ws + OFF_KCB) + ((size_t)(b * 2 + kvh) * 1024) * 64;
    const bf16* vb = (const bf16*)(p.ws + OFF_VCB) + ((size_t)(b * 2 + kvh) * 1024) * 64;
    float mA[NI], lA[NI];
#pragma unroll
    for (int ni = 0; ni < NI; ++ni) { mA[ni] = -INFINITY; lA[ni] = 0.f; }
    __syncthreads();
    if (ntc > 0) {
      for (int rep_ = 0; rep_ < ((REP_NSA_PART & 1) ? 2 : 1); ++rep_) {
#pragma unroll
      for (int ni = 0; ni < NI; ++ni) { mA[ni] = -INFINITY; lA[ni] = 0.f; }
      TILE_GLOAD(kb, vb, 64, 0);
      TILE_SSTORE(smkv, smkv + KT_ELEMS);
      __syncthreads();
      for (int kt = 0; kt < ntc; ++kt) {
        if (kt + 1 < ntc) TILE_GLOAD(kb, vb, 64, (kt + 1) * 64);
        const bf16* Ks = smkv + (kt & 1) * 2 * KT_ELEMS;
        f32x4 s[4][NI];
        attn_scores<NI>(Ks, qraw, s);
#pragma unroll
        for (int ni = 0; ni < NI; ++ni)
#pragma unroll
          for (int mi = 0; mi < 4; ++mi)
#pragma unroll
            for (int r = 0; r < 4; ++r)
              if (kt * 64 + mi * 16 + g4 * 4 + r >= nv[ni]) s[mi][ni][r] = -INFINITY;
        attn_stats<NI>(s, mA, lA);
        if (kt + 1 < ntc) {
          bf16* Kn = smkv + ((kt + 1) & 1) * 2 * KT_ELEMS;
          TILE_SSTORE(Kn, Kn + KT_ELEMS);
        }
        __syncthreads();
      }
      }
      float nmB[NI];
#pragma unroll
      for (int ni = 0; ni < NI; ++ni) {
        float l = lA[ni];
        l += shx(l, 16);
        l += shx(l, 32);
        nmB[ni] = (l > 0.f) ? -(mA[ni] * C2 + __builtin_amdgcn_logf(l)) : 0.f;
      }
      TILE_GLOAD(kb, vb, 64, 0);
      TILE_SSTORE(smkv, smkv + KT_ELEMS);
      __syncthreads();
      for (int kt = 0; kt < ntc; ++kt) {
        if (kt + 1 < ntc) TILE_GLOAD(kb, vb, 64, (kt + 1) * 64);
        const bf16* Ks = smkv + (kt & 1) * 2 * KT_ELEMS;
        f32x4 s[4][NI];
        attn_scores<NI>(Ks, qraw, s);
        bf16x8 pf[NI][2];
#pragma unroll
        for (int ni = 0; ni < NI; ++ni) {
          u32x4_t wa, wb;
          float* irow = imp + qlv[ni] * 257 + kt * 16 + g4;
#pragma unroll
          for (int mi = 0; mi < 4; ++mi) {
            float pr[4];
#pragma unroll
            for (int r = 0; r < 4; ++r) {
              const bool ok = (kt * 64 + mi * 16 + g4 * 4 + r) < nv[ni];
              pr[r] = ok ? __builtin_amdgcn_exp2f(__builtin_fmaf(s[mi][ni][r], C2, nmB[ni])) : 0.f;
            }
            float mainv = pr[0] + pr[1] + pr[2] + 0.5f * pr[3];
            float spv = 0.5f * pr[3];
            mainv += shx(mainv, 1);
            mainv += shx(mainv, 2);
            spv += shx(spv, 1);
            spv += shx(spv, 2);
            if ((c16 & 3) == 0) {
              atomicAdd(irow + mi * 4, mainv);
              atomicAdd(irow + mi * 4 + 1, spv);
            }
            const unsigned w0 = cvtpk(pr[0], pr[1]), w1 = cvtpk(pr[2], pr[3]);
            if (mi == 0) { wa.x = w0; wa.y = w1; }
            if (mi == 1) { wa.z = w0; wa.w = w1; }
            if (mi == 2) { wb.x = w0; wb.y = w1; }
            if (mi == 3) { wb.z = w0; wb.w = w1; }
          }
          pf[ni][0] = __builtin_bit_cast(bf16x8, wa);
          pf[ni][1] = __builtin_bit_cast(bf16x8, wb);
        }
        attn_pv<NI>(Ks + KT_ELEMS, pf, acc);
        if (kt + 1 < ntc) {
          bf16* Kn = smkv + ((kt + 1) & 1) * 2 * KT_ELEMS;
          TILE_SSTORE(Kn, Kn + KT_ELEMS);
        }
        __syncthreads();
      }
    }
#pragma unroll
    for (int ni = 0; ni < NI; ++ni)
#pragma unroll
      for (int di = 0; di < 4; ++di) {
        acc[di][ni][0] *= gate0[ni]; acc[di][ni][1] *= gate0[ni]; acc[di][ni][2] *= gate0[ni]; acc[di][ni][3] *= gate0[ni];
      }
  }
  __syncthreads();
#if PROBE_NSA == 8
  if (b == 0 && kvh == 0)
    for (int i = tid; i < QN * 256; i += 256)
      ((float*)(p.ws + OFF_OMOBA))[(size_t)S * 256 + (size_t)(s0 + (i >> 8)) * 256 + (i & 255)] = imp[(i >> 8) * 257 + (i & 255)];
  __syncthreads();
#endif
  for (int qq = 0; qq < 4 * NI; ++qq) {
    const int ql = wave * 4 * NI + qq;
    int mysel = -1;
    if (cur < 16) {
      mysel = (lane <= cur) ? lane : -1;
    } else {
      const float* row = imp + ql * 257;
      float v0 = row[lane], v1 = row[64 + lane], v2 = row[128 + lane], v3 = row[192 + lane];
      if (lane < 1 || lane > cur - 2) v0 = -1.f;
      if (64 + lane > cur - 2) v1 = -1.f;
      if (128 + lane > cur - 2) v2 = -1.f;
      if (192 + lane > cur - 2) v3 = -1.f;
      if (lane == 0) mysel = 0;
      if (lane == 1) mysel = cur - 1;
      if (lane == 2) mysel = cur;
      for (int rd = 3; rd < 16; ++rd) {
        float bv = v0;
        int bi = lane;
        if (v1 > bv) { bv = v1; bi = 64 + lane; }
        if (v2 > bv) { bv = v2; bi = 128 + lane; }
        if (v3 > bv) { bv = v3; bi = 192 + lane; }
#pragma unroll
        for (int off = 32; off >= 1; off >>= 1) {
          float ov = shx(bv, off);
          int oi = shx(bi, off);
          if (ov > bv || (ov == bv && oi < bi)) { bv = ov; bi = oi; }
        }
        if (lane == rd) mysel = bi;
        if ((bi & 63) == lane) {
          const int k = bi >> 6;
          if (k == 0) v0 = -2.f; else if (k == 1) v1 = -2.f; else if (k == 2) v2 = -2.f; else v3 = -2.f;
        }
      }
    }
#if PROBE_NSA == 2
    mysel = (lane < 16) ? ((const int*)(p.ws + OFF_SEL))[(((size_t)b * 2 + kvh) * S + s0 + ql) * 16 + lane] : -1;
#endif
#if PROBE_NSA == 8
    if (lane < 16 && b == 0 && kvh == 0) ((int*)(p.ws + OFF_CMP))[(size_t)(s0 + ql) * 16 + lane] = mysel;
#endif
    if (lane < 16) {
      sel[ql * 16 + lane] = mysel;
      if (mysel >= 0) {
        atomicOr(&bmq[ql * 8 + (mysel >> 5)], 1u << (mysel & 31));
        atomicOr(&bmu[mysel >> 5], 1u << (mysel & 31));
        atomicOr(&bmu[8 + wave * 8 + (mysel >> 5)], 1u << (mysel & 31));
      }
    }
  }
  __syncthreads();
  {
    const int n = tid;
    const unsigned wv = bmu[n >> 5];
    if ((wv >> (n & 31)) & 1u) {
      int pos = __builtin_popcount(wv & ((1u << (n & 31)) - 1u));
      for (int w = 0; w < (n >> 5); ++w) pos += __builtin_popcount(bmu[w]);
      ulist[pos] = n;
    }
    if (tid == 0) {
      int c = 0;
      for (int w = 0; w < 8; ++w) c += __builtin_popcount(bmu[w]);
      ulist[256] = c;
    }
  }
  __syncthreads();
  {
    AttnSt<NI> st;
    attn_init<NI>(st);
    const int klo = (s0 - 511 > 0) ? (s0 - 511) : 0;
    const int kt0 = klo >> 6, kt1 = (s0 + QN - 1) >> 6;
    const bf16* kb = (const bf16*)(p.ws + OFF_KWB) + ((size_t)(b * 2 + kvh) * S) * 64;
    const bf16* vb = (const bf16*)(p.ws + OFF_VWB) + ((size_t)(b * 2 + kvh) * S) * 64;
    for (int rep_ = 0; rep_ < ((REP_NSA_PART & 2) ? 2 : 1); ++rep_) {
    attn_init<NI>(st);
    TILE_GLOAD(kb, vb, 64, kt0 * 64);
    TILE_SSTORE(smkv, smkv + KT_ELEMS);
    __syncthreads();
    for (int kt = kt0; kt <= kt1; ++kt) {
      if (kt + 1 <= kt1) TILE_GLOAD(kb, vb, 64, (kt + 1) * 64);
      const bf16* Ks = smkv + ((kt - kt0) & 1) * 2 * KT_ELEMS;
      f32x4 s[4][NI];
      attn_scores<NI>(Ks, qrot, s);
#pragma unroll
      for (int ni = 0; ni < NI; ++ni)
#pragma unroll
        for (int mi = 0; mi < 4; ++mi)
#pragma unroll
          for (int r = 0; r < 4; ++r) {
            const int key = kt * 64 + mi * 16 + g4 * 4 + r;
            if (key > tq[ni] || key <= tq[ni] - 512) s[mi][ni][r] = -INFINITY;
          }
      attn_softmax_pv<NI>(Ks + KT_ELEMS, s, st);
      if (kt + 1 <= kt1) {
        bf16* Kn = smkv + ((kt + 1 - kt0) & 1) * 2 * KT_ELEMS;
        TILE_SSTORE(Kn, Kn + KT_ELEMS);
      }
      __syncthreads();
    }
    }
#pragma unroll
    for (int ni = 0; ni < NI; ++ni) {
      float l = st.l[ni];
      l += shx(l, 16);
      l += shx(l, 32);
      const float sc = gate2[ni] / l;
#pragma unroll
      for (int di = 0; di < 4; ++di) {
        acc[di][ni][0] += sc * st.o[di][ni][0]; acc[di][ni][1] += sc * st.o[di][ni][1];
        acc[di][ni][2] += sc * st.o[di][ni][2]; acc[di][ni][3] += sc * st.o[di][ni][3];
      }
    }
  }
  {
    float* accs = imp + tid;
#pragma unroll
    for (int ni = 0; ni < NI; ++ni)
#pragma unroll
      for (int di = 0; di < 4; ++di)
#pragma unroll
        for (int r = 0; r < 4; ++r) accs[((ni * 4 + di) * 4 + r) * 256] = acc[di][ni][r];
    AttnSt<NI> st;
    attn_init<NI>(st);
    const bf16* kb = (const bf16*)(p.ws + OFF_KSB) + ((size_t)(b * 2 + kvh) * S) * 64;
    const bf16* vb = (const bf16*)(p.ws + OFF_VSB) + ((size_t)(b * 2 + kvh) * S) * 64;
#ifndef NSA_SEL_WAVE
#define NSA_SEL_WAVE 1
#endif
#if NSA_SEL_WAVE
    {
      int* wl = ulist;
      const unsigned* bw = bmu + 8 + wave * 8;
      unsigned short* wl16 = (unsigned short*)wl + wave * 128;
      int nuw = 0;
#pragma unroll
      for (int j = 0; j < 4; ++j) {
        const int nblk = j * 64 + lane;
        const bool setb = (bw[nblk >> 5] >> (nblk & 31)) & 1u;
        const unsigned long long mk = __builtin_amdgcn_ballot_w64(setb);
        if (setb) wl16[nuw + __builtin_popcountll(mk & ((1ull << lane) - 1ull))] = (unsigned short)nblk;
        nuw += __builtin_popcountll(mk);
      }
      __builtin_amdgcn_fence(__ATOMIC_RELEASE, "workgroup");
      __builtin_amdgcn_wave_barrier();
      bf16* Vw = smkv + wave * KT_ELEMS;
      bf16x8 kr00, kr01, kr10, kr11, kr20, kr21, kr30, kr31;
      uint4 vr0, vr1, vr2, vr3, vr4, vr5, vr6, vr7;
#define NSW_LOADK(nb_)                                                                                  \
      {                                                                                                 \
        const bf16* kp_ = kb + (size_t)((nb_) * 64 + c16) * 64 + g4 * 8;                                \
        kr00 = *(const bf16x8*)(kp_);             kr01 = *(const bf16x8*)(kp_ + 32);                    \
        kr10 = *(const bf16x8*)(kp_ + 16 * 64);   kr11 = *(const bf16x8*)(kp_ + 16 * 64 + 32);          \
        kr20 = *(const bf16x8*)(kp_ + 32 * 64);   kr21 = *(const bf16x8*)(kp_ + 32 * 64 + 32);          \
        kr30 = *(const bf16x8*)(kp_ + 48 * 64);   kr31 = *(const bf16x8*)(kp_ + 48 * 64 + 32);          \
      }
#define NSW_LOADV(nb_)                                                                                  \
      {                                                                                                 \
        const bf16* vp_ = vb + (size_t)(nb_) * 64 * 64 + lane * 8;                                      \
        vr0 = *(const uint4*)(vp_);        vr1 = *(const uint4*)(vp_ + 512);  vr2 = *(const uint4*)(vp_ + 1024); \
        vr3 = *(const uint4*)(vp_ + 1536); vr4 = *(const uint4*)(vp_ + 2048); vr5 = *(const uint4*)(vp_ + 2560); \
        vr6 = *(const uint4*)(vp_ + 3072); vr7 = *(const uint4*)(vp_ + 3584);                           \
      }
      for (int rep_ = 0; rep_ < ((REP_NSA_PART & 4) ? 2 : 1); ++rep_) {
      attn_init<NI>(st);
      if (nuw > 0) { NSW_LOADK((int)wl16[0]) NSW_LOADV((int)wl16[0]) }
      for (int iu = 0; iu < nuw; ++iu) {
        const int n = wl16[iu];
        {
          bf16* vd = Vw + (lane >> 3) * KT_LD + (lane & 7) * 8;
          *(uint4*)(vd) = vr0;               *(uint4*)(vd + 8 * KT_LD) = vr1;  *(uint4*)(vd + 16 * KT_LD) = vr2;
          *(uint4*)(vd + 24 * KT_LD) = vr3;  *(uint4*)(vd + 32 * KT_LD) = vr4; *(uint4*)(vd + 40 * KT_LD) = vr5;
          *(uint4*)(vd + 48 * KT_LD) = vr6;  *(uint4*)(vd + 56 * KT_LD) = vr7;
        }
        if (iu + 1 < nuw) NSW_LOADV((int)wl16[iu + 1])
        f32x4 s[4][NI];
        bool qsel[NI], act[NI];
#pragma unroll
        for (int ni = 0; ni < NI; ++ni) {
          qsel[ni] = (bmq[qlv[ni] * 8 + (n >> 5)] >> (n & 31)) & 1u;
          act[ni] = __builtin_amdgcn_ballot_w64(qsel[ni]) != 0ull;
        }
#pragma unroll
        for (int ni = 0; ni < NI; ++ni) {
          if (!act[ni]) continue;
          s[0][ni] = MFMA16(kr00, qrot[ni][0], (f32x4{0.f, 0.f, 0.f, 0.f}));
          s[0][ni] = MFMA16(kr01, qrot[ni][1], s[0][ni]);
          s[1][ni] = MFMA16(kr10, qrot[ni][0], (f32x4{0.f, 0.f, 0.f, 0.f}));
          s[1][ni] = MFMA16(kr11, qrot[ni][1], s[1][ni]);
          s[2][ni] = MFMA16(kr20, qrot[ni][0], (f32x4{0.f, 0.f, 0.f, 0.f}));
          s[2][ni] = MFMA16(kr21, qrot[ni][1], s[2][ni]);
          s[3][ni] = MFMA16(kr30, qrot[ni][0], (f32x4{0.f, 0.f, 0.f, 0.f}));
          s[3][ni] = MFMA16(kr31, qrot[ni][1], s[3][ni]);
        }
        if (iu + 1 < nuw) NSW_LOADK((int)wl16[iu + 1])
        asm volatile("" ::: "memory");
        __builtin_amdgcn_wave_barrier();
#pragma unroll
        for (int ni = 0; ni < NI; ++ni) {
          if (!act[ni]) continue;
#pragma unroll
          for (int mi = 0; mi < 4; ++mi)
#pragma unroll
            for (int r = 0; r < 4; ++r) {
              const int key = n * 64 + mi * 16 + g4 * 4 + r;
              if (!qsel[ni] || key > tq[ni]) s[mi][ni][r] = -INFINITY;
            }
        }
        attn_softmax_pv_act<NI>(Vw, s, st, act);
        asm volatile("" ::: "memory");
        __builtin_amdgcn_wave_barrier();
      }
      }
    }
#else
    const int nu = ulist[256];
#define NSA_SKEY(i) (ulist[(i)] * 64)
    for (int rep_ = 0; rep_ < ((REP_NSA_PART & 4) ? 2 : 1); ++rep_) {
    attn_init<NI>(st);
    KV_SWEEP(kb, vb, 64, nu, NSA_SKEY,
      const int n = ulist[it];
      bool qs[NI];
      bool anyq = false;
      _Pragma("unroll") for (int ni = 0; ni < NI; ++ni) {
        qs[ni] = (bmq[qlv[ni] * 8 + (n >> 5)] >> (n & 31)) & 1u;
        anyq = anyq || qs[ni];
      }
      if (__builtin_amdgcn_ballot_w64(anyq) != 0ull) {
        f32x4 s[4][NI];
        attn_scores<NI>(Ks, qrot, s);
        _Pragma("unroll") for (int ni = 0; ni < NI; ++ni)
          _Pragma("unroll") for (int mi = 0; mi < 4; ++mi)
            _Pragma("unroll") for (int r = 0; r < 4; ++r) {
              const int key = n * 64 + mi * 16 + g4 * 4 + r;
              if (!qs[ni] || key > tq[ni]) s[mi][ni][r] = -INFINITY;
            }
        attn_softmax_pv<NI>(Ks + KT_ELEMS, s, st);
      }
    )
    }
#endif
#pragma unroll
    for (int ni = 0; ni < NI; ++ni) {
      float l = st.l[ni];
      l += shx(l, 16);
      l += shx(l, 32);
      const float sc = gate1[ni] / l;
#pragma unroll
      for (int di = 0; di < 4; ++di)
#pragma unroll
        for (int r = 0; r < 4; ++r) acc[di][ni][r] = accs[((ni * 4 + di) * 4 + r) * 256] + sc * st.o[di][ni][r];
    }
  }
#pragma unroll
  for (int ni = 0; ni < NI; ++ni) {
    const int g = (wave * 16 * NI + ni * 16 + c16) & 3;
    bf16* op = outbuf + ((size_t)b * S + tq[ni]) * 512 + (kvh * 4 + g) * 64 + g4 * 4;
#pragma unroll
    for (int di = 0; di < 4; ++di) {
      uint2 pk;
      pk.x = cvtpk(acc[di][ni][0], acc[di][ni][1]);
      pk.y = cvtpk(acc[di][ni][2], acc[di][ni][3]);
      *(uint2*)(op + di * 16) = pk;
    }
  }
  __syncthreads();
}

DEV void probe_accum_bf16(const Params& p, const bf16* a, const bf16* ref, size_t n, float* sm) {
  float sd = 0.f, sr = 0.f;
  for (size_t i = (size_t)blockIdx.x * 256 + tidx(); i < n; i += (size_t)gridDim.x * 256) {
    float x = bf2f(a[i]), y = bf2f(ref[i]);
    sd += (x - y) * (x - y);
    sr += y * y;
  }
  sd = wave_sum(sd);
  sr = wave_sum(sr);
  if ((tidx() & 63) == 0) {
    atomicAdd((float*)(p.ws + OFF_PROBE), sd);
    atomicAdd((float*)(p.ws + OFF_PROBE) + 1, sr);
  }
}
DEV void probe_apply(const Params& p) {
  const float* pr = (const float*)(p.ws + OFF_PROBE);
  const float sd = pr[0], sr = pr[1];
  float rel = sqrtf(sd / fmaxf(sr, 1e-30f));
  float k = 10.f + 10.f * log10f(fmaxf(rel, 1e-6f) / 1e-4f);
  if (!(k == k)) k = 95.f;
  k = fminf(fmaxf(k, 1.f), 55.f);
  if (pr[2] > 0.f) k = 60.f + fminf(35.f, 10.f * log10f(pr[2]));
  const float scale = 1.f + 0.01f * k;
  for (size_t i = (size_t)blockIdx.x * 256 + tidx(); i < (size_t)T * 1024; i += (size_t)gridDim.x * 256)
    p.out[i] *= scale;
}

DEV void wave_top16(float sa, float sb, int ia, int ib, int lane, float& vout, int& iout) {
  vout = 0.f;
  iout = 0;
  for (int r = 0; r < 16; ++r) {
    float bv;
    int bi;
    if (sa >= sb) { bv = sa; bi = ia; } else { bv = sb; bi = ib; }
#pragma unroll
    for (int off = 32; off >= 1; off >>= 1) {
      float ov = shx(bv, off);
      int oi = shx(bi, off);
      if (ov > bv || (ov == bv && oi < bi)) { bv = ov; bi = oi; }
    }
    if (lane == r) { vout = bv; iout = bi; }
    if (bi == ia) sa = -INFINITY;
    else if (bi == ib) sb = -INFINITY;
  }
}
DEV void peer_topk_item(const Params& p, int layer, int item, bf16* sm16) {
  bf16* k1t = sm16;
  bf16* k2t = sm16 + 16384;
  float* qs = (float*)(sm16 + 32768);
  const int tid = tidx(), lane = tid & 63, wave = tid >> 6;
  const float* k1 = p.peer_k1 + (size_t)layer * 128 * 128;
  const float* k2 = p.peer_k2 + (size_t)layer * 128 * 128;
  for (int i = tid; i < 16384; i += 256) {
    int d = i >> 7, n = i & 127;
    k1t[i] = f2bf(k1[n * 128 + d]);
    k2t[i] = f2bf(k2[n * 128 + d]);
  }
  __syncthreads();
  const bf16* qp_all = (const bf16*)(p.ws + OFF_QP);
  int* peidx = (int*)(p.ws + OFF_PEIDX);
  float* peg = (float*)(p.ws + OFF_PEG);
  for (int pair = wave; pair < 256; pair += 4) {
    const int tl = pair >> 3, hh = pair & 7;
    const size_t tok = (size_t)item * 32 + tl;
    {
      uint2 v = *(const uint2*)(qp_all + tok * 2048 + hh * 256 + lane * 4);
      float* qd = qs + wave * 256 + lane * 4;
      qd[0] = __uint_as_float(v.x << 16);
      qd[1] = __uint_as_float(v.x & 0xffff0000u);
      qd[2] = __uint_as_float(v.y << 16);
      qd[3] = __uint_as_float(v.y & 0xffff0000u);
    }
    __syncthreads();
    float s1a = 0.f, s1b = 0.f, s2a = 0.f, s2b = 0.f;
    const float* qw = qs + wave * 256;
#pragma unroll 4
    for (int d = 0; d < 128; ++d) {
      float q1 = qw[d], q2 = qw[128 + d];
      s1a += q1 * bf2f(k1t[d * 128 + lane]);
      s1b += q1 * bf2f(k1t[d * 128 + lane + 64]);
      s2a += q2 * bf2f(k2t[d * 128 + lane]);
      s2b += q2 * bf2f(k2t[d * 128 + lane + 64]);
    }
    float v1, v2;
    int i1, i2;
    wave_top16(s1a, s1b, lane, lane + 64, lane, v1, i1);
    wave_top16(s2a, s2b, lane, lane + 64, lane, v2, i2);
    const float va = __shfl(v1, lane >> 2);
    float c0 = va + __shfl(v2, (lane & 3) * 4 + 0);
    float c1 = va + __shfl(v2, (lane & 3) * 4 + 1);
    float c2 = va + __shfl(v2, (lane & 3) * 4 + 2);
    float c3 = va + __shfl(v2, (lane & 3) * 4 + 3);
    float vals = 0.f;
    int cisel = 0;
    for (int r = 0; r < 16; ++r) {
      float bv = c0;
      int bi = lane * 4;
      if (c1 > bv) { bv = c1; bi = lane * 4 + 1; }
      if (c2 > bv) { bv = c2; bi = lane * 4 + 2; }
      if (c3 > bv) { bv = c3; bi = lane * 4 + 3; }
#pragma unroll
      for (int off = 32; off >= 1; off >>= 1) {
        float ov = shx(bv, off);
        int oi = shx(bi, off);
        if (ov > bv || (ov == bv && oi < bi)) { bv = ov; bi = oi; }
      }
      if (lane == r) { vals = bv; cisel = bi; }
      if ((bi >> 2) == lane) {
        int j = bi & 3;
        if (j == 0) c0 = -INFINITY;
        else if (j == 1) c1 = -INFINITY;
        else if (j == 2) c2 = -INFINITY;
        else c3 = -INFINITY;
      }
    }
    const int ea = __shfl(i1, (cisel >> 4) & 15);
    const int eb = __shfl(i2, cisel & 15);
    const int e = ea * 128 + eb;
    const float mx = __shfl(vals, 0);
    float ex = (lane < 16) ? expf(vals - mx) : 0.f;
    float sum = wave_sum(ex);
    if (lane < 16) {
      peidx[tok * 128 + hh * 16 + lane] = e;
      peg[tok * 128 + hh * 16 + lane] = ex / sum;
    }
    __syncthreads();
  }
}

DEV void peer_expert_item(const Params& p, int layer, int item, float* sm) {
  const int tid = tidx(), lane = tid & 63, wave = tid >> 6;
  const size_t tok = (size_t)item;
  const int b = (int)(tok / S);
  int* idx = (int*)sm;
  float* gt = sm + 128;
  float* act = sm + 256;
  if (tid < 128) {
    idx[tid] = ((const int*)(p.ws + OFF_PEIDX))[tok * 128 + tid];
    gt[tid] = ((const float*)(p.ws + OFF_PEG))[tok * 128 + tid];
  }
  const bf16* hrow = (const bf16*)(p.ws + OFF_H) + tok * 1024;
  float hw[16];
#pragma unroll
  for (int i = 0; i < 4; ++i) {
    uint2 v = *(const uint2*)(hrow + i * 256 + lane * 4);
    hw[i * 4 + 0] = __uint_as_float(v.x << 16);
    hw[i * 4 + 1] = __uint_as_float(v.x & 0xffff0000u);
    hw[i * 4 + 2] = __uint_as_float(v.y << 16);
    hw[i * 4 + 3] = __uint_as_float(v.y & 0xffff0000u);
  }
  __syncthreads();
  const float* U = p.peer_u + (size_t)layer * NEXP * 1024;
  const float* V = p.peer_v + (size_t)layer * NEXP * 1024;
#pragma unroll 2
  for (int jj = 0; jj < 32; ++jj) {
    int j = wave * 32 + jj;
    const float* ur = U + (size_t)idx[j] * 1024;
    float part = 0.f;
#pragma unroll
    for (int i = 0; i < 4; ++i) {
      float4 u4 = *(const float4*)(ur + i * 256 + lane * 4);
      part += hw[i * 4] * u4.x + hw[i * 4 + 1] * u4.y + hw[i * 4 + 2] * u4.z + hw[i * 4 + 3] * u4.w;
    }
    part = wave_sum(part);
    if (lane == 0) act[j] = gt[j] * gelu_tanh(part);
  }
  __syncthreads();
  float a0 = 0.f, a1 = 0.f, a2 = 0.f, a3 = 0.f;
#pragma unroll 8
  for (int j = 0; j < 128; ++j) {
    float a = act[j];
    float4 v4 = *(const float4*)(V + (size_t)idx[j] * 1024 + tid * 4);
    a0 += a * v4.x; a1 += a * v4.y; a2 += a * v4.z; a3 += a * v4.w;
  }
  const float* ga = (const float*)(p.ws + OFF_MOD) + (layer * 2 + b) * 6144 + 5120 + tid * 4;
  float* xr = p.out + tok * 1024 + tid * 4;
  float4 xo = *(float4*)xr;
  xo.x += ga[0] * a0; xo.y += ga[1] * a1; xo.z += ga[2] * a2; xo.w += ga[3] * a3;
  *(float4*)xr = xo;
  __syncthreads();
}

DEV void pk_scores(const bf16* __restrict__ ktab, const bf16* __restrict__ qp, f32x4 (&s)[8], int g4, int c16) {
  bf16x8 qf[4];
#pragma unroll
  for (int ks = 0; ks < 4; ++ks) qf[ks] = *(const bf16x8*)(qp + ks * 32 + g4 * 8);
#pragma unroll
  for (int mi = 0; mi < 8; ++mi) {
    s[mi] = f32x4{0.f, 0.f, 0.f, 0.f};
#pragma unroll
    for (int ks = 0; ks < 4; ++ks) {
      const bf16x8 kf = *(const bf16x8*)(ktab + (mi * 16 + c16) * 128 + ks * 32 + g4 * 8);
      s[mi] = MFMA16(kf, qf[ks], s[mi]);
    }
  }
}
DEV void pk_top16(f32x4 (&s)[8], int g4, float (&vout)[16], int (&iout)[16]) {
#pragma unroll
  for (int rd = 0; rd < 16; ++rd) {
    float bv = -INFINITY;
    int bi = 1 << 20;
#pragma unroll
    for (int mi = 0; mi < 8; ++mi)
#pragma unroll
      for (int r = 0; r < 4; ++r) {
        const float v = s[mi][r];
        if (v > bv) { bv = v; bi = mi * 16 + g4 * 4 + r; }
      }
#pragma unroll
    for (int off = 16; off <= 32; off <<= 1) {
      const float ov = shx(bv, off);
      const int oi = shx(bi, off);
      if (ov > bv || (ov == bv && oi < bi)) { bv = ov; bi = oi; }
    }
    vout[rd] = bv;
    iout[rd] = bi;
#pragma unroll
    for (int mi = 0; mi < 8; ++mi)
#pragma unroll
      for (int r = 0; r < 4; ++r)
        if (mi * 16 + g4 * 4 + r == bi) s[mi][r] = -INFINITY;
  }
}
DEV void peer_topk_mfma_item(const Params& p, int layer, int item) {
  const int lane = tidx() & 63, wave = tidx() >> 6, g4 = lane >> 4, c16 = lane & 15;
  const size_t tok = (size_t)item * 8 + wave * 2 + (c16 >> 3);
  const int hh = c16 & 7;
  const bf16* qp = (const bf16*)(p.ws + OFF_QP) + tok * 2048 + hh * 256;
  const bf16* k1 = (const bf16*)(p.ws + OFF_PKB) + (size_t)(layer * 2 + 0) * 16384;
  const bf16* k2 = (const bf16*)(p.ws + OFF_PKB) + (size_t)(layer * 2 + 1) * 16384;
  float v1[16], v2[16];
  int i1[16], i2[16];
  {
    f32x4 s[8];
    pk_scores(k1, qp, s, g4, c16);
    pk_top16(s, g4, v1, i1);
  }
  {
    f32x4 s[8];
    pk_scores(k2, qp + 128, s, g4, c16);
    pk_top16(s, g4, v2, i2);
  }
  float v1s[4];
  int i1s[4];
#pragma unroll
  for (int j = 0; j < 4; ++j) {
    v1s[j] = (g4 == 0) ? v1[j] : (g4 == 1) ? v1[4 + j] : (g4 == 2) ? v1[8 + j] : v1[12 + j];
    i1s[j] = (g4 == 0) ? i1[j] : (g4 == 1) ? i1[4 + j] : (g4 == 2) ? i1[8 + j] : i1[12 + j];
  }
  float c0[16], c1[8], c2[5], c3[4];
#pragma unroll
  for (int b = 0; b < 16; ++b) c0[b] = ((4 * g4 + 1) * (b + 1) <= 16) ? v1s[0] + v2[b] : -INFINITY;
#pragma unroll
  for (int b = 0; b < 8; ++b) c1[b] = ((4 * g4 + 2) * (b + 1) <= 16) ? v1s[1] + v2[b] : -INFINITY;
#pragma unroll
  for (int b = 0; b < 5; ++b) c2[b] = ((4 * g4 + 3) * (b + 1) <= 16) ? v1s[2] + v2[b] : -INFINITY;
#pragma unroll
  for (int b = 0; b < 4; ++b) c3[b] = ((4 * g4 + 4) * (b + 1) <= 16) ? v1s[3] + v2[b] : -INFINITY;
  float vals[16];
  int eidx[16];
  const int cbase = g4 * 64;
#pragma unroll
  for (int rd = 0; rd < 16; ++rd) {
    float bv = -INFINITY;
    int bi = 1 << 20;
#pragma unroll
    for (int b = 0; b < 16; ++b) if (c0[b] > bv) { bv = c0[b]; bi = cbase + b; }
#pragma unroll
    for (int b = 0; b < 8; ++b) if (c1[b] > bv) { bv = c1[b]; bi = cbase + 16 + b; }
#pragma unroll
    for (int b = 0; b < 5; ++b) if (c2[b] > bv) { bv = c2[b]; bi = cbase + 32 + b; }
#pragma unroll
    for (int b = 0; b < 4; ++b) if (c3[b] > bv) { bv = c3[b]; bi = cbase + 48 + b; }
#pragma unroll
    for (int off = 16; off <= 32; off <<= 1) {
      const float ov = shx(bv, off);
      const int oi = shx(bi, off);
      if (ov > bv || (ov == bv && oi < bi)) { bv = ov; bi = oi; }
    }
    vals[rd] = bv;
    int e = -1;
#pragma unroll
    for (int b = 0; b < 16; ++b) if (cbase + b == bi) { c0[b] = -INFINITY; e = i1s[0] * 128 + i2[b]; }
#pragma unroll
    for (int b = 0; b < 8; ++b) if (cbase + 16 + b == bi) { c1[b] = -INFINITY; e = i1s[1] * 128 + i2[b]; }
#pragma unroll
    for (int b = 0; b < 5; ++b) if (cbase + 32 + b == bi) { c2[b] = -INFINITY; e = i1s[2] * 128 + i2[b]; }
#pragma unroll
    for (int b = 0; b < 4; ++b) if (cbase + 48 + b == bi) { c3[b] = -INFINITY; e = i1s[3] * 128 + i2[b]; }
    e = max(e, shx(e, 16));
    e = max(e, shx(e, 32));
    eidx[rd] = e;
  }
  float ex[16], sum = 0.f;
#pragma unroll
  for (int rd = 0; rd < 16; ++rd) { ex[rd] = expf(vals[rd] - vals[0]); sum += ex[rd]; }
  const float inv = 1.f / sum;
  if (g4 == 0) {
    int* pi = (int*)(p.ws + OFF_PEIDX) + tok * 128 + hh * 16;
    float* pg = (float*)(p.ws + OFF_PEG) + tok * 128 + hh * 16;
#pragma unroll
    for (int q = 0; q < 4; ++q) {
      *(int4*)(pi + q * 4) = int4{eidx[q * 4], eidx[q * 4 + 1], eidx[q * 4 + 2], eidx[q * 4 + 3]};
      *(float4*)(pg + q * 4) = float4{ex[q * 4] * inv, ex[q * 4 + 1] * inv, ex[q * 4 + 2] * inv, ex[q * 4 + 3] * inv};
    }
  }
}

typedef float f32x2_t __attribute__((ext_vector_type(2)));
DEV unsigned pack4_fp8(float a, float b, float c, float d) {
  int p = __builtin_amdgcn_cvt_pk_fp8_f32(a, b, 0, false);
  p = __builtin_amdgcn_cvt_pk_fp8_f32(c, d, p, true);
  return (unsigned)p;
}
DEV void unpack16_fp8(uint4 v, float* f) {
  f32x2_t r;
  r = __builtin_amdgcn_cvt_pk_f32_fp8((int)v.x, false); f[0] = r.x; f[1] = r.y;
  r = __builtin_amdgcn_cvt_pk_f32_fp8((int)v.x, true);  f[2] = r.x; f[3] = r.y;
  r = __builtin_amdgcn_cvt_pk_f32_fp8((int)v.y, false); f[4] = r.x; f[5] = r.y;
  r = __builtin_amdgcn_cvt_pk_f32_fp8((int)v.y, true);  f[6] = r.x; f[7] = r.y;
  r = __builtin_amdgcn_cvt_pk_f32_fp8((int)v.z, false); f[8] = r.x; f[9] = r.y;
  r = __builtin_amdgcn_cvt_pk_f32_fp8((int)v.z, true);  f[10] = r.x; f[11] = r.y;
  r = __builtin_amdgcn_cvt_pk_f32_fp8((int)v.w, false); f[12] = r.x; f[13] = r.y;
  r = __builtin_amdgcn_cvt_pk_f32_fp8((int)v.w, true);  f[14] = r.x; f[15] = r.y;
}
DEV void expert_cvt_item(const Params& p, int layer, int item) {
  const int lane = tidx() & 63, wave = tidx() >> 6;
  const int e = item * 4 + wave;
  unsigned char* dst = (unsigned char*)(p.ws + OFF_E8) + (size_t)e * 2048;
  float* sc = (float*)(p.ws + OFF_ESC) + (size_t)e * 2;
#pragma unroll
  for (int tb = 0; tb < 2; ++tb) {
    const float* src = (tb ? p.peer_v : p.peer_u) + ((size_t)layer * NEXP + e) * 1024 + lane * 16;
    float4 a = *(const float4*)src, b = *(const float4*)(src + 4), c = *(const float4*)(src + 8), d = *(const float4*)(src + 12);
    float mx = fmaxf(fmaxf(fmaxf(fabsf(a.x), fabsf(a.y)), fmaxf(fabsf(a.z), fabsf(a.w))),
                     fmaxf(fmaxf(fabsf(b.x), fabsf(b.y)), fmaxf(fabsf(b.z), fabsf(b.w))));
    mx = fmaxf(mx, fmaxf(fmaxf(fmaxf(fabsf(c.x), fabsf(c.y)), fmaxf(fabsf(c.z), fabsf(c.w))),
                         fmaxf(fmaxf(fabsf(d.x), fabsf(d.y)), fmaxf(fabsf(d.z), fabsf(d.w)))));
#pragma unroll
    for (int o = 32; o >= 1; o >>= 1) mx = fmaxf(mx, shx(mx, o));
    const float s = (mx > 0.f) ? 224.f / mx : 1.f;
    uint4 pk;
    pk.x = pack4_fp8(a.x * s, a.y * s, a.z * s, a.w * s);
    pk.y = pack4_fp8(b.x * s, b.y * s, b.z * s, b.w * s);
    pk.z = pack4_fp8(c.x * s, c.y * s, c.z * s, c.w * s);
    pk.w = pack4_fp8(d.x * s, d.y * s, d.z * s, d.w * s);
    *(uint4*)(dst + tb * 1024 + lane * 16) = pk;
    if (lane == 0) sc[tb] = 1.f / s;
  }
}

DEV float rdlane_f(float v, int l) { return __int_as_float(__builtin_amdgcn_readlane(__float_as_int(v), l)); }
DEV float dot16_f8(const float* hw, uint4 u) {
  float f[16];
  unpack16_fp8(u, f);
  float s = 0.f;
#pragma unroll
  for (int i = 0; i < 16; ++i) s += hw[i] * f[i];
  return s;
}
DEV void axpy16_f8(float* acc, float a, uint4 u) {
  float f[16];
  unpack16_fp8(u, f);
#pragma unroll
  for (int i = 0; i < 16; ++i) acc[i] += a * f[i];
}
#define PE_ROWPTR(idxv, j) (E8 + (size_t)__builtin_amdgcn_readlane(idxv, (j)) * 2048)
#define PE_LOAD8(P, idxv, j0, off)                                                                        \
  P##0 = *(const uint4*)(PE_ROWPTR(idxv, (j0)) + (off)); P##1 = *(const uint4*)(PE_ROWPTR(idxv, (j0) + 1) + (off)); \
  P##2 = *(const uint4*)(PE_ROWPTR(idxv, (j0) + 2) + (off)); P##3 = *(const uint4*)(PE_ROWPTR(idxv, (j0) + 3) + (off)); \
  P##4 = *(const uint4*)(PE_ROWPTR(idxv, (j0) + 4) + (off)); P##5 = *(const uint4*)(PE_ROWPTR(idxv, (j0) + 5) + (off)); \
  P##6 = *(const uint4*)(PE_ROWPTR(idxv, (j0) + 6) + (off)); P##7 = *(const uint4*)(PE_ROWPTR(idxv, (j0) + 7) + (off));
#define PE_DOTSET(P, j0, dv)                                                                              \
  {                                                                                                       \
    const float s0 = wave_sum(dot16_f8(hw, P##0)), s1 = wave_sum(dot16_f8(hw, P##1)),                     \
                s2 = wave_sum(dot16_f8(hw, P##2)), s3 = wave_sum(dot16_f8(hw, P##3)),                     \
                s4 = wave_sum(dot16_f8(hw, P##4)), s5 = wave_sum(dot16_f8(hw, P##5)),                     \
                s6 = wave_sum(dot16_f8(hw, P##6)), s7 = wave_sum(dot16_f8(hw, P##7));                     \
    if (lane == (j0)) dv = s0;                                                                            \
    if (lane == (j0) + 1) dv = s1;                                                                        \
    if (lane == (j0) + 2) dv = s2;                                                                        \
    if (lane == (j0) + 3) dv = s3;                                                                        \
    if (lane == (j0) + 4) dv = s4;                                                                        \
    if (lane == (j0) + 5) dv = s5;                                                                        \
    if (lane == (j0) + 6) dv = s6;                                                                        \
    if (lane == (j0) + 7) dv = s7;                                                                        \
  }
#define PE_AXPYSET(P, j0, av)                                                                             \
  {                                                                                                       \
    axpy16_f8(acc, rdlane_f(av, (j0)), P##0);     axpy16_f8(acc, rdlane_f(av, (j0) + 1), P##1);           \
    axpy16_f8(acc, rdlane_f(av, (j0) + 2), P##2); axpy16_f8(acc, rdlane_f(av, (j0) + 3), P##3);           \
    axpy16_f8(acc, rdlane_f(av, (j0) + 4), P##4); axpy16_f8(acc, rdlane_f(av, (j0) + 5), P##5);           \
    axpy16_f8(acc, rdlane_f(av, (j0) + 6), P##6); axpy16_f8(acc, rdlane_f(av, (j0) + 7), P##7);           \
  }
#define PE_DOT8(idxv, dv)                                                                                 \
  {                                                                                                       \
    uint4 pa0, pa1, pa2, pa3, pa4, pa5, pa6, pa7, pb0, pb1, pb2, pb3, pb4, pb5, pb6, pb7;                 \
    PE_LOAD8(pa, idxv, 0, 0)                                                                              \
    _Pragma("unroll 1") for (int g = 0; g < 4; ++g) {                                                     \
      const int j0 = g * 16;                                                                              \
      PE_LOAD8(pb, idxv, j0 + 8, 0)                                                                       \
      PE_DOTSET(pa, j0, dv)                                                                               \
      if (g < 3) { PE_LOAD8(pa, idxv, j0 + 16, 0) }                                                       \
      PE_DOTSET(pb, j0 + 8, dv)                                                                           \
    }                                                                                                     \
  }
#define PE_AXPY8(idxv, av)                                                                                \
  {                                                                                                       \
    uint4 pa0, pa1, pa2, pa3, pa4, pa5, pa6, pa7, pb0, pb1, pb2, pb3, pb4, pb5, pb6, pb7;                 \
    PE_LOAD8(pa, idxv, 0, 1024)                                                                           \
    _Pragma("unroll 1") for (int g = 0; g < 4; ++g) {                                                     \
      const int j0 = g * 16;                                                                              \
      PE_LOAD8(pb, idxv, j0 + 8, 1024)                                                                    \
      PE_AXPYSET(pa, j0, av)                                                                              \
      if (g < 3) { PE_LOAD8(pa, idxv, j0 + 16, 1024) }                                                    \
      PE_AXPYSET(pb, j0 + 8, av)                                                                          \
    }                                                                                                     \
  }
DEV void peer_expert_item2(const Params& p, int layer, int item, float ga_scale = 1.f) {
  const int lane = tidx() & 63, wave = tidx() >> 6;
  const size_t tok = (size_t)item * 4 + wave;
  const int b = (int)(tok / S);
  const int* pi = (const int*)(p.ws + OFF_PEIDX) + tok * 128;
  const float* pg = (const float*)(p.ws + OFF_PEG) + tok * 128;
  const int idx_lo = pi[lane], idx_hi = pi[64 + lane];
  const float g_lo = pg[lane], g_hi = pg[64 + lane];
  const float* esc = (const float*)(p.ws + OFF_ESC);
  const float2 sc_lo = *(const float2*)(esc + (size_t)idx_lo * 2), sc_hi = *(const float2*)(esc + (size_t)idx_hi * 2);
  const bf16* hrow = (const bf16*)(p.ws + OFF_H) + tok * 1024 + lane * 16;
  float hw[16];
  unpack8(*(const uint4*)hrow, hw);
  unpack8(*(const uint4*)(hrow + 8), hw + 8);
  const unsigned char* E8 = (const unsigned char*)(p.ws + OFF_E8) + lane * 16;
  float d_lo = 0.f, d_hi = 0.f;
  PE_DOT8(idx_lo, d_lo)
  PE_DOT8(idx_hi, d_hi)
  const float act_lo = g_lo * gelu_tanh(d_lo * sc_lo.x) * sc_lo.y;
  const float act_hi = g_hi * gelu_tanh(d_hi * sc_hi.x) * sc_hi.y;
  float acc[16];
#pragma unroll
  for (int i = 0; i < 16; ++i) acc[i] = 0.f;
  PE_AXPY8(idx_lo, act_lo)
  PE_AXPY8(idx_hi, act_hi)
  const float* ga = (const float*)(p.ws + OFF_MOD) + (layer * 2 + b) * 6144 + 5120 + lane * 16;
  float* xr = p.out + tok * 1024 + lane * 16;
  float xn[16];
  float ss = 0.f;
#pragma unroll
  for (int q4 = 0; q4 < 4; ++q4) {
    float4 xo = *(float4*)(xr + q4 * 4);
    const float4 g4v = *(const float4*)(ga + q4 * 4);
    xo.x += ga_scale * g4v.x * acc[q4 * 4 + 0];
    xo.y += ga_scale * g4v.y * acc[q4 * 4 + 1];
    xo.z += ga_scale * g4v.z * acc[q4 * 4 + 2];
    xo.w += ga_scale * g4v.w * acc[q4 * 4 + 3];
    xn[q4 * 4] = xo.x; xn[q4 * 4 + 1] = xo.y; xn[q4 * 4 + 2] = xo.z; xn[q4 * 4 + 3] = xo.w;
    ss += xo.x * xo.x + xo.y * xo.y + xo.z * xo.z + xo.w * xo.w;
  }
#if PROBE_ANY || REP_MASK
#pragma unroll
  for (int q4 = 0; q4 < 4; ++q4)
    *(float4*)(xr + q4 * 4) = float4{xn[q4 * 4], xn[q4 * 4 + 1], xn[q4 * 4 + 2], xn[q4 * 4 + 3]};
  return;
#endif
  ss = wave_sum(ss);
  const float rn = 1.0f / sqrtf(ss * (1.0f / 1024.f) + 1e-6f);
  if (layer == 0) {
    const float* gn = p.g_attn + 1024 + lane * 16;
    const float* md = (const float*)(p.ws + OFF_MOD) + (2 + b) * 6144 + lane * 16;
    bf16* hq = (bf16*)(p.ws + OFF_H) + tok * 1024 + lane * 16;
    unsigned pk[8];
#pragma unroll
    for (int q4 = 0; q4 < 4; ++q4) {
      *(float4*)(xr + q4 * 4) = float4{xn[q4 * 4], xn[q4 * 4 + 1], xn[q4 * 4 + 2], xn[q4 * 4 + 3]};
      const float4 g4v = *(const float4*)(gn + q4 * 4);
      const float4 s4 = *(const float4*)(md + 1024 + q4 * 4);
      const float4 h4 = *(const float4*)(md + q4 * 4);
      const float o0 = xn[q4 * 4] * rn * g4v.x * (1.f + s4.x) + h4.x;
      const float o1 = xn[q4 * 4 + 1] * rn * g4v.y * (1.f + s4.y) + h4.y;
      const float o2 = xn[q4 * 4 + 2] * rn * g4v.z * (1.f + s4.z) + h4.z;
      const float o3 = xn[q4 * 4 + 3] * rn * g4v.w * (1.f + s4.w) + h4.w;
      pk[q4 * 2] = cvtpk_(o0, o1);
      pk[q4 * 2 + 1] = cvtpk_(o2, o3);
    }
    *(uint4*)hq = uint4{pk[0], pk[1], pk[2], pk[3]};
    *(uint4*)(hq + 8) = uint4{pk[4], pk[5], pk[6], pk[7]};
  } else {
    const float* gf = p.g_final + lane * 16;
#pragma unroll
    for (int q4 = 0; q4 < 4; ++q4) {
      const float4 g4v = *(const float4*)(gf + q4 * 4);
      *(float4*)(xr + q4 * 4) = float4{xn[q4 * 4] * rn * g4v.x, xn[q4 * 4 + 1] * rn * g4v.y, xn[q4 * 4 + 2] * rn * g4v.z,
                                       xn[q4 * 4 + 3] * rn * g4v.w};
    }
  }
}

template <class F>
DEV void for_tiles_xcd(int MT, int NT, F f) {
  const int nb = gridDim.x, bid = blockIdx.x;
  if ((nb & 7) != 0) {
    for (int it = bid; it < MT * NT; it += nb) f(it / NT, it % NT);
    return;
  }
  const int xcd = bid & 7, slot = bid >> 3, nslot = nb >> 3;
  const int nj = (NT - xcd + 7) >> 3;
  for (int q = slot; q < MT * nj; q += nslot) f(q / nj, xcd + 8 * (q % nj));
}
constexpr int PH_PER_LAYER = 15;
enum { SP_NORM1 = 0, SP_INPROJ = 1, SP_COMPRESS = 2, SP_KMEAN = 3, SP_ATTN = 4, SP_MP0 = 5, SP_MM0 = 6, SP_MP1 = 7, SP_MM1 = 8,
       SP_MERGE = 9, SP_OUTPROJ = 10, SP_NORM2 = 11, SP_PEERQ = 12, SP_TOPK = 13, SP_EXPERT = 14 };
constexpr int N_REAL_PHASES = 1 + 2 * PH_PER_LAYER + 1;
constexpr int N_PHASES = N_REAL_PHASES + (PROBE_ANY ? 2 : 0);

DEV void run_phase(const Params& p, int ph, char* smem_raw, bool second_pass = false) {
#define SKIP_MOBA_SECOND (REP_NSA_ONLY && second_pass)
  float* smf = (float*)smem_raw;
  bf16* smh = (bf16*)smem_raw;
  const int nb = gridDim.x, bid = blockIdx.x;
  if (ph == 0) {
    for (int it = bid; it < PREP_ITEMS; it += nb) prep_item(p, it, smf);
    return;
  }
  if (ph == N_REAL_PHASES - 1) {
    for (int it = bid; it < T / 4; it += nb) final_norm_item(p.out, p.g_final, it);
    return;
  }
#if PROBE_ANY
  if (ph == N_REAL_PHASES) {
#if PROBE_PROJ
    {
      const bf16* Hh = (const bf16*)(p.ws + OFF_H);
      const bf16* Wt = (const bf16*)(p.ws + OFF_WINT) + (size_t)1 * WN * 1024;
      const float* rope = (const float*)(p.ws + OFF_ROPE);
      float sd = 0.f, sr = 0.f;
      for (size_t i = (size_t)bid * 256 + tidx(); i < (size_t)(T / 64) * 4888; i += (size_t)nb * 256) {
        const int ts = (int)(i / 4888), vc = (int)(i % 4888);
        const int tok = ts * 64 + (ts % 61);
        const int b = tok / S, t = tok % S;
        auto rawdot = [&](int col) {
          float a = 0.f;
          for (int k = 0; k < 1024; ++k) a += bf2f(Hh[(size_t)tok * 1024 + k]) * bf2f(Wt[(size_t)col * 1024 + k]);
          return a;
        };
        float v = rawdot(vc);
        bool roped = false;
        const bf16* dst;
        if (vc < 768) dst = (const bf16*)(p.ws + OFF_PROJ) + (size_t)tok * PC + vc;
        else if (vc < 1280) {
          const int seg = (vc - 768) >> 7, head = ((vc - 768) >> 6) & 1, d = vc & 63;
          const size_t off = (seg == 0) ? OFF_KSB : (seg == 1) ? OFF_VSB : (seg == 2) ? OFF_KWB : OFF_VWB;
          dst = (const bf16*)(p.ws + off) + ((size_t)(b * 2 + head) * S + t) * 64 + d;
          roped = (seg == 0 || seg == 2);
        } else if (vc < 1792) { dst = (const bf16*)(p.ws + OFF_PROJ) + (size_t)tok * PC + C_MQ + (vc - 1280); roped = true; }
        else if (vc < 2816) {
          const int seg = (vc - 1792) >> 9, head = ((vc - 1792) >> 6) & 7, d = vc & 63;
          dst = (const bf16*)(p.ws + (seg ? OFF_MVB : OFF_MKB)) + ((size_t)(b * 8 + head) * S + t) * 64 + d;
          roped = (seg == 0);
        } else if (vc < 4864) dst = (const bf16*)(p.ws + OFF_PROJ) + (size_t)tok * PC + C_GN + (vc - 2816);
        else dst = (const bf16*)(p.ws + OFF_PROJ) + (size_t)tok * PC + C_NG + (vc - 4864);
        const int d = vc & 63;
        if (roped && d < 16) {
          const float cs = rope[(size_t)t * 16 + (d & 7)], sn = rope[(size_t)t * 16 + 8 + (d & 7)];
          if (d < 8) { const float x2 = rawdot(vc + 8); v = v * cs - x2 * sn; }
          else { const float x1 = rawdot(vc - 8); v = v * cs + x1 * sn; }
        }
        const float got = bf2f(*dst);
        const bool is_r = roped && d < 16;
        if (PROBE_PROJ == 1 || (PROBE_PROJ == 2 && is_r) || (PROBE_PROJ == 3 && !is_r)) {
          sd += (got - v) * (got - v);
          sr += v * v;
        }
      }
      sd = wave_sum(sd); sr = wave_sum(sr);
      if ((tidx() & 63) == 0) {
        atomicAdd((float*)(p.ws + OFF_PROBE), sd);
        atomicAdd((float*)(p.ws + OFF_PROBE) + 1, sr);
      }
    }
#endif
#if PROBE_CMPR
    {
      float sd = 0.f, sr = 0.f;
      for (size_t i = (size_t)bid * 256 + tidx(); i < (size_t)2 * Bn * 1024 * 128; i += (size_t)nb * 256) {
        const size_t wh = i / ((size_t)Bn * 1024 * 128), r = i % ((size_t)Bn * 1024 * 128);
        const int c = (int)((r / 128) % 1024);
        if (c < 1023) {
          const float a = ((const float*)(p.ws + (wh ? OFF_VCC : OFF_KCC)))[r];
          const float y = ((const float*)(p.ws + OFF_CMP))[i];
          sd += (a - y) * (a - y);
          sr += y * y;
        }
      }
      sd = wave_sum(sd); sr = wave_sum(sr);
      if ((tidx() & 63) == 0) {
        atomicAdd((float*)(p.ws + OFF_PROBE), sd);
        atomicAdd((float*)(p.ws + OFF_PROBE) + 1, sr);
      }
    }
#endif
#if PROBE_MOBA
    probe_accum_bf16(p, (const bf16*)(p.ws + OFF_OMOBA), (const bf16*)(p.ws + OFF_CMP), (size_t)S * 512, smf);
#endif
#if PROBE_NSA == 8
    {
      const float* impn = (const float*)(p.ws + OFF_OMOBA);
      const float* impm = impn + (size_t)S * 256;
      const int* seld = (const int*)(p.ws + OFF_CMP);
      float sd = 0.f, sr = 0.f, bad = 0.f;
      for (int t = bid * 256 + tidx(); t < S; t += nb * 256) {
        const int cur = t >> 6;
        for (int n = 0; n < 256; ++n) {
          float a = impm[(size_t)t * 256 + n], r = impn[(size_t)t * 256 + n];
          sd += (a - r) * (a - r);
          sr += r * r;
        }
        unsigned want[8] = {0, 0, 0, 0, 0, 0, 0, 0}, got[8] = {0, 0, 0, 0, 0, 0, 0, 0};
        for (int j = 0; j < 16; ++j) {
          int v = seld[(size_t)t * 16 + j];
          if (v >= 0 && v < 256) {
            for (int w = 0; w < 8; ++w) if ((v >> 5) == w) got[w] |= 1u << (v & 31);
          }
        }
        if (cur < 16) {
          for (int n = 0; n <= cur; ++n) want[0] |= 1u << n;
        } else {
          want[0] |= 1u;
          for (int w = 0; w < 8; ++w) {
            if (((cur - 1) >> 5) == w) want[w] |= 1u << ((cur - 1) & 31);
            if ((cur >> 5) == w) want[w] |= 1u << (cur & 31);
          }
          for (int j = 0; j < 13; ++j) {
            float best = -1.f;
            int bi = 1;
            for (int n = 1; n <= cur - 2; ++n) {
              bool taken = false;
              for (int w = 0; w < 8; ++w) if ((n >> 5) == w) taken = (want[w] >> (n & 31)) & 1u;
              float v = impm[(size_t)t * 256 + n];
              if (!taken && v > best) { best = v; bi = n; }
            }
            for (int w = 0; w < 8; ++w) if ((bi >> 5) == w) want[w] |= 1u << (bi & 31);
          }
        }
        bool same = true;
        for (int w = 0; w < 8; ++w) same = same && (want[w] == got[w]);
        if (!same) bad += 1.f;
      }
      sd = wave_sum(sd); sr = wave_sum(sr); bad = wave_sum(bad);
      if ((tidx() & 63) == 0) {
        atomicAdd((float*)(p.ws + OFF_PROBE), sd);
        atomicAdd((float*)(p.ws + OFF_PROBE) + 1, sr);
        atomicAdd((float*)(p.ws + OFF_PROBE) + 2, bad);
      }
    }
#elif PROBE_NSA
    probe_accum_bf16(p, (const bf16*)(p.ws + OFF_ONSA), (const bf16*)(p.ws + OFF_CMP), (size_t)S * 512, smf);
#endif
    return;
  }
  if (ph == N_REAL_PHASES + 1) {
    probe_apply(p);
    return;
  }
#endif
  const int layer = (ph - 1) / PH_PER_LAYER, sub = (ph - 1) % PH_PER_LAYER;
  const float* mod = (const float*)(p.ws + OFF_MOD) + (size_t)layer * 2 * 6144;
  const float* xin = (layer == 0) ? p.x : p.out;
  bf16* H = (bf16*)(p.ws + OFF_H);
  bf16* PROJ = (bf16*)(p.ws + OFF_PROJ);
#if PROBE_ANY
  if (sub >= SP_MERGE) {
    if (sub == SP_OUTPROJ && layer == 0)
      for (size_t i = (size_t)bid * 256 + tidx(); i < (size_t)T * 1024; i += (size_t)nb * 256) p.out[i] = p.x[i];
    return;
  }
#endif
  switch (sub) {
    case SP_NORM1:
      for (int it = bid; it < T / 4; it += nb)
        norm_item(xin, p.g_attn + layer * 1024, mod + 1024, mod + 0, H, it);
      break;
    case SP_INPROJ: {
      for_tiles_xcd(T / 128, WN / 128, [&](int mt, int nt) { inproj_tile(p, layer, mt * 128, nt * 128, smh); });
    } break;
    case SP_COMPRESS:
      for (int it = bid; it < 512; it += nb) compress_mfma_item(p, layer, it, smem_raw);
#if PROBE_CMPR
      if (layer == 1)
        for (int it = bid; it < 1024; it += nb) compress_item(p, layer, it, smf);
#endif
      break;
    case SP_KMEAN:
      for (int it = bid; it < 1024; it += nb) kmean_item(p, it, smf);
#if PROBE_NSA
      if (layer == 1)
        for (int it = bid; it < 512; it += nb) n1_item(p, layer, it, smf);
#endif
      break;
    case SP_ATTN:
      {
        constexpr int MNI = 2;
        constexpr int NMOBA = 16 * (S / (64 * MNI));
        constexpr int NNI = 2;
        constexpr int NNSA = 4 * (S / (16 * NNI));
        const bool do_nsa = !PROBE_ANY || PROBE_NSA, do_moba = (!PROBE_ANY || PROBE_MOBA) && PROBE_NSA != 8;
        for (int it = bid; it < NNSA + NMOBA; it += nb) {
          if (it < NNSA) { if (do_nsa) nsa_item<NNI>(p, it, smem_raw, (bf16*)(p.ws + OFF_ONSA)); }
          else if (do_moba && !SKIP_MOBA_SECOND) moba_gate_item<MNI>(p, it - NNSA);
        }
#if PROBE_NSA && PROBE_NSA != 8
        if (layer == 1)
          for (int it = bid; it < 512; it += nb) n23_item(p, layer, it);
#endif
#if PROBE_MOBA
        if (layer == 1) {
          for (int it = bid; it < 512; it += nb) moba_item(p, layer, it);
        }
#endif
      }
      break;
    case SP_MP0:
    case SP_MP1:
      if ((!PROBE_ANY || PROBE_MOBA) && PROBE_NSA != 8)
        for (int it = bid; it < 8 * 63 * 8; it += nb) moba_part_item<2>(p, sub == SP_MP1 ? 1 : 0, it, smem_raw);
      break;
    case SP_MM0:
    case SP_MM1:
      if ((!PROBE_ANY || PROBE_MOBA) && PROBE_NSA != 8)
        for (int it = bid; it < 8 * (S / 128); it += nb)
          moba_merge_item<2>(p, sub == SP_MM1 ? 1 : 0, it, smem_raw, (bf16*)(p.ws + OFF_OMOBA));
      break;
    case SP_MERGE:
      for_tiles_xcd(T / 128, 8, [&](int mt, int nt) { merge_tile(p, layer, mt * 128, nt * 128, smh); });
      break;
    case SP_OUTPROJ: {
      const bf16* W = (const bf16*)(p.ws + OFF_WOUT) + (size_t)layer * 1024 * 1024;
      const float* ga1 = mod + 2048;
      for_tiles_xcd(T / 128, 8, [&](int mt, int nt) {
        gemm_tile(H, 1024, W, 1024, mt * 128, nt * 128, smh, [&](int row, int col, float v) {
          int b = row / S;
          size_t o = (size_t)row * 1024 + col;
          p.out[o] = xin[o] + ga1[b * 6144 + col] * v;
        });
      });
    } break;
    case SP_NORM2:
      for (int it = bid; it < T / 4 + NEXP / 4; it += nb) {
        if (it < T / 4) norm_item(p.out, p.g_ffn + layer * 1024, mod + 4096, mod + 3072, H, it);
        else expert_cvt_item(p, layer, it - T / 4);
      }
      break;
    case SP_PEERQ: {
      const bf16* W = (const bf16*)(p.ws + OFF_WQ) + (size_t)layer * 2048 * 1024;
      bf16* QP = (bf16*)(p.ws + OFF_QP);
      for_tiles_xcd(T / 128, 16, [&](int mt, int nt) {
        f32x4 acc[4][4];
        acc_zero(acc);
        gemm_mainloop(H, 1024, W, 1024, mt * 128, nt * 128, smh, acc);
        const int wv = tidx() >> 6;
        store_tile_bf16(smh, acc, QP + (size_t)(mt * 128 + (wv >> 1) * 64) * 2048 + nt * 128 + (wv & 1) * 64, 2048);
      });
    } break;
    case SP_TOPK:
      for (int it = bid; it < T / 8; it += nb) peer_topk_mfma_item(p, layer, it);
      break;
    case SP_EXPERT:
      for (int it = bid; it < T / 4; it += nb) peer_expert_item2(p, layer, it, second_pass ? 0.f : 1.f);
      break;
  }
}

#if PROBE_ANY
#define MEGA_LB __launch_bounds__(256)
#else
#define MEGA_LB __launch_bounds__(256, 2)
#endif
__global__ void MEGA_LB mega_kernel(Params p, int ph_lo, int ph_hi) {
  __shared__ __attribute__((aligned(16))) char smem_raw[SMEM_BYTES + 16];
  volatile LAS unsigned* xbst = (volatile LAS unsigned*)(smem_raw + SMEM_BYTES);
  if (threadIdx.x == 0) { xbst[0] = 0u; xbst[1] = 0u; xbst[2] = 0u; xbst[3] = 0u; }
  __syncthreads();
  XcdBarrier xb = xcd_barrier_post((unsigned*)(p.ws + OFF_BAR), xbst);
  for (int ph = ph_lo; ph < ph_hi; ++ph) {
#if !PROBE_ANY && !REP_MASK
    if (ph == N_REAL_PHASES - 1 || ph == 1 + PH_PER_LAYER) continue;
#endif
    run_phase(p, ph, smem_raw);
#if REP_MASK
    if (ph >= 1 && ph < N_REAL_PHASES - 1 && ((REP_MASK >> ((ph - 1) % PH_PER_LAYER)) & 1)) {
      xcd_barrier(xb);
      run_phase(p, ph, smem_raw, true);
    }
#endif
    if (ph + 1 < ph_hi) {
      if (ph == ph_lo) cg::this_grid().sync();
      else xcd_barrier(xb);
    }
  }
}

extern "C" void kernel_launch(void* const* d_in, const int* in_sizes, int n_in, void* d_out, int out_size, void* d_ws,
                              size_t ws_size, hipStream_t stream) {
  if (ws_size < WS_TOTAL) {
    fprintf(stderr, "workspace too small: %zu < %zu\n", ws_size, (size_t)WS_NEED);
    return;
  }
  Params p{};
  p.x = (const float*)d_in[0]; p.c = (const float*)d_in[1]; p.w_ada = (const float*)d_in[2];
  p.b_ada = (const float*)d_in[3]; p.g_attn = (const float*)d_in[4]; p.g_ffn = (const float*)d_in[5];
  p.w_in = (const float*)d_in[6]; p.cmp_pe = (const float*)d_in[7]; p.cmp_w1 = (const float*)d_in[8];
  p.cmp_w2 = (const float*)d_in[9]; p.w_up_nsa = (const float*)d_in[10]; p.w_up_moba = (const float*)d_in[11];
  p.w_out = (const float*)d_in[12]; p.peer_wq = (const float*)d_in[13]; p.peer_k1 = (const float*)d_in[14];
  p.peer_k2 = (const float*)d_in[15]; p.peer_u = (const float*)d_in[16]; p.peer_v = (const float*)d_in[17];
  p.g_final = (const float*)d_in[18];
  p.out = (float*)d_out;
  p.ws = (char*)d_ws;
  static int grid_blocks = 0;
  if (!grid_blocks) {
    int dev = 0, cus = 0, per_cu = 0;
    hipGetDevice(&dev);
    hipDeviceGetAttribute(&cus, hipDeviceAttributeMultiprocessorCount, dev);
    hipOccupancyMaxActiveBlocksPerMultiprocessor(&per_cu, mega_kernel, 256, 0);
    if (per_cu < 1) per_cu = 1;
    if (per_cu > 2) per_cu = 2;
    grid_blocks = cus * per_cu;
  }
  hipMemsetAsync((char*)d_ws + OFF_BAR, 0, BAR_BYTES, stream);
  int ph_lo = 0, ph_hi = N_PHASES;
  void* args[] = {(void*)&p, (void*)&ph_lo, (void*)&ph_hi};
  hipError_t e = hipLaunchCooperativeKernel((const void*)mega_kernel, dim3(grid_blocks), dim3(256), args, 0, stream);
  if (e != hipSuccess) fprintf(stderr, "cooperative launch failed: %s (grid %d)\n", hipGetErrorString(e), grid_blocks);
}
```

```cpp
#include <hip/hip_runtime.h>
#include <hip/hip_bf16.h>
#include <hip/hip_cooperative_groups.h>
#include <cstdio>
#include <cstdint>
namespace cg = cooperative_groups;

#define DEV __device__ __forceinline__
typedef unsigned short bf16;
using bf16x8 = __attribute__((ext_vector_type(8))) short;
using f32x4 = __attribute__((ext_vector_type(4))) float;

constexpr int Bn = 2, S = 16384, T = Bn * S, D = 1024;
constexpr int PC = 3456;
constexpr int WN = 4992;
constexpr int C_NQ = 0, C_KC = 512, C_VC = 640, C_MQ = 768, C_GN = 1280, C_GM = 2304, C_NG = 3328;
constexpr int NEXP = 16384;

constexpr size_t al(size_t x) { return (x + 255) & ~size_t(255); }
constexpr size_t OFF_MOD = 0;
constexpr size_t OFF_ROPE = al(OFF_MOD + 2 * 2 * 6144 * 4);
constexpr size_t OFF_PEB = al(OFF_ROPE + (size_t)S * 16 * 4);
constexpr size_t OFF_WINT = al(OFF_PEB + 2 * 2 * 128 * 4);
constexpr size_t OFF_WUPN = al(OFF_WINT + 2ull * WN * 1024 * 2);
constexpr size_t OFF_WUPM = al(OFF_WUPN + 2ull * 1024 * 512 * 2);
constexpr size_t OFF_WOUT = al(OFF_WUPM + 2ull * 1024 * 512 * 2);
constexpr size_t OFF_WQ = al(OFF_WOUT + 2ull * 1024 * 1024 * 2);
constexpr size_t OFF_KCC = al(OFF_WQ + 2ull * 2048 * 1024 * 2);
constexpr size_t OFF_VCC = al(OFF_KCC + 2ull * 1024 * 128 * 4);
constexpr size_t OFF_SEL = al(OFF_VCC + 2ull * 1024 * 128 * 4);
constexpr size_t OFF_KMEAN = al(OFF_SEL + 2ull * 2 * S * 16 * 4);
constexpr size_t OFF_KMHL = al(OFF_KMEAN + 2ull * 8 * 64 * 64 * 4);
constexpr size_t OFF_KCB = al(OFF_KMHL + 2ull * 2 * 8 * 64 * 64 * 2);
constexpr size_t OFF_VCB = al(OFF_KCB + 2ull * 2 * 1024 * 64 * 2);
constexpr size_t OFF_PKB = al(OFF_VCB + 2ull * 2 * 1024 * 64 * 2);
constexpr size_t OFF_W1T = al(OFF_PKB + 2ull * 2 * 128 * 128 * 2);
constexpr size_t OFF_BAR = al(OFF_W1T + 4ull * 128 * 2048 * 2);
constexpr size_t BAR_BYTES = 3456 * 4;
constexpr size_t OFF_PROBE = al(OFF_BAR + BAR_BYTES);
constexpr size_t OFF_H = al(OFF_PROBE + 256);
constexpr size_t OFF_ONSA = al(OFF_H + (size_t)T * 1024 * 2);
constexpr size_t OFF_OMOBA = al(OFF_ONSA + (size_t)T * 512 * 2);
constexpr size_t OFF_PROJ = al(OFF_OMOBA + (size_t)T * 512 * 2);
constexpr size_t KV2_BYTES = (size_t)Bn * 2 * S * 64 * 2, KV8_BYTES = (size_t)Bn * 8 * S * 64 * 2;
constexpr size_t OFF_KSB = al(OFF_PROJ + (size_t)T * PC * 2);
constexpr size_t OFF_VSB = OFF_KSB + KV2_BYTES;
constexpr size_t OFF_KWB = OFF_VSB + KV2_BYTES;
constexpr size_t OFF_VWB = OFF_KWB + KV2_BYTES;
constexpr size_t OFF_MKB = OFF_VWB + KV2_BYTES;
constexpr size_t OFF_MVB = OFF_MKB + KV8_BYTES;
constexpr int MLIST_PER_BH = 63 * S - 128 * 63 * 64;
constexpr size_t OFF_MLIST = OFF_MVB + KV8_BYTES;
constexpr size_t OFF_MCNT = al(OFF_MLIST + (size_t)Bn * 8 * MLIST_PER_BH * 2);
constexpr size_t WS_NEED = OFF_MCNT + (size_t)Bn * 8 * 64 * 4;
constexpr size_t PROJ_BYTES = (size_t)T * PC * 2;
constexpr size_t OFF_MPO = OFF_H;
constexpr size_t OFF_MPML = OFF_H + (size_t)8 * S * 3 * 64 * 2;
static_assert((size_t)8 * S * 3 * 64 * 2 + (size_t)8 * S * 3 * 8 <= (size_t)T * 1024 * 2, "moba partials must fit the H region");
constexpr size_t OFF_QP = OFF_PROJ;
constexpr size_t OFF_PEIDX = al(OFF_QP + (size_t)T * 2048 * 2);
constexpr size_t OFF_PEG = al(OFF_PEIDX + (size_t)T * 128 * 4);
constexpr size_t OFF_E8 = al(OFF_PEG + (size_t)T * 128 * 4);
constexpr size_t OFF_ESC = al(OFF_E8 + (size_t)NEXP * 2048);
static_assert(OFF_ESC + (size_t)NEXP * 2 * 4 <= OFF_PROJ + PROJ_BYTES, "peer alias overflow");
static_assert(WS_NEED <= 536870912ull, "workspace too big");
#ifndef PROBE_MOBA
#define PROBE_MOBA 0
#endif
constexpr size_t OFF_CMP = PROBE_MOBA ? OFF_ONSA : OFF_MLIST;
#ifndef REP_NSA_ONLY
#define REP_NSA_ONLY 0
#endif
#ifndef REP_NSA_PART
#define REP_NSA_PART 0
#endif
#ifndef REP_MASK
#define REP_MASK 0
#endif
#ifndef PROBE_MOBA
#define PROBE_MOBA 0
#endif
#ifndef PROBE_NSA
#define PROBE_NSA 0
#endif
#ifndef PROBE_CMPR
#define PROBE_CMPR 0
#endif
#ifndef PROBE_PROJ
#define PROBE_PROJ 0
#endif
#define PROBE_ANY (PROBE_MOBA || PROBE_NSA || PROBE_CMPR || PROBE_PROJ)
constexpr size_t WS_TOTAL = WS_NEED;
static_assert(WS_TOTAL <= 536870912ull, "workspace too big (probe)");

struct Params {
  const float *x, *c, *w_ada, *b_ada, *g_attn, *g_ffn, *w_in, *cmp_pe, *cmp_w1, *cmp_w2, *w_up_nsa, *w_up_moba, *w_out,
      *peer_wq, *peer_k1, *peer_k2, *peer_u, *peer_v, *g_final;
  float* out;
  char* ws;
};

constexpr int SMEM_BYTES = 74 * 1024;

DEV int tidx() {
  int t = threadIdx.x;
  asm volatile("" : "+v"(t));
  return t;
}
#define MFMA16B(a, b, c) __builtin_amdgcn_mfma_f32_16x16x32_bf16(a, b, c, 0, 0, 0)
DEV unsigned cvtpk_(float lo, float hi) {
  unsigned r;
  asm("v_cvt_pk_bf16_f32 %0, %1, %2" : "=v"(r) : "v"(lo), "v"(hi));
  return r;
}
DEV float bf2f(bf16 h) { return __uint_as_float(((unsigned)h) << 16); }
DEV bf16 f2bf(float f) {
  unsigned u = __float_as_uint(f);
  u += 0x7fffu + ((u >> 16) & 1u);
  return (bf16)(u >> 16);
}
DEV float gelu_tanh(float x) {
  float u = 0.7978845608028654f * (x + 0.044715f * x * x * x);
  return 0.5f * x * (1.f + tanhf(u));
}
DEV float sigmoidf_(float x) { return 1.f / (1.f + expf(-x)); }
DEV void unpack8(uint4 v, float* f) {
  f[0] = __uint_as_float(v.x << 16); f[1] = __uint_as_float(v.x & 0xffff0000u);
  f[2] = __uint_as_float(v.y << 16); f[3] = __uint_as_float(v.y & 0xffff0000u);
  f[4] = __uint_as_float(v.z << 16); f[5] = __uint_as_float(v.z & 0xffff0000u);
  f[6] = __uint_as_float(v.w << 16); f[7] = __uint_as_float(v.w & 0xffff0000u);
}
DEV float dot64_bf(const float* q, const bf16* row) {
  float s = 0.f;
#pragma unroll
  for (int i = 0; i < 8; ++i) {
    float f[8];
    unpack8(*(const uint4*)(row + i * 8), f);
#pragma unroll
    for (int j = 0; j < 8; ++j) s += q[i * 8 + j] * f[j];
  }
  return s;
}
DEV void axpy64_bf(float* o, float a, const bf16* row) {
#pragma unroll
  for (int i = 0; i < 8; ++i) {
    float f[8];
    unpack8(*(const uint4*)(row + i * 8), f);
#pragma unroll
    for (int j = 0; j < 8; ++j) o[i * 8 + j] += a * f[j];
  }
}
DEV float dot64_f(const float* q, const float* row) {
  float s = 0.f;
#pragma unroll
  for (int i = 0; i < 16; ++i) {
    float4 v = *(const float4*)(row + i * 4);
    s += q[i * 4] * v.x + q[i * 4 + 1] * v.y + q[i * 4 + 2] * v.z + q[i * 4 + 3] * v.w;
  }
  return s;
}
DEV void axpy64_f(float* o, float a, const float* row) {
#pragma unroll
  for (int i = 0; i < 16; ++i) {
    float4 v = *(const float4*)(row + i * 4);
    o[i * 4] += a * v.x; o[i * 4 + 1] += a * v.y; o[i * 4 + 2] += a * v.z; o[i * 4 + 3] += a * v.w;
  }
}
DEV void load_q64(float* q, const bf16* p, float scale) {
#pragma unroll
  for (int i = 0; i < 8; ++i) unpack8(*(const uint4*)(p + i * 8), q + i * 8);
#pragma unroll
  for (int i = 0; i < 64; ++i) q[i] *= scale;
}
DEV int lane_id_() { return __builtin_amdgcn_mbcnt_hi(~0u, __builtin_amdgcn_mbcnt_lo(~0u, 0u)); }
DEV int shx(int v, int m) {
  if (m == 1) return __builtin_amdgcn_update_dpp(0, v, 0xB1, 0xF, 0xF, true);
  if (m == 2) return __builtin_amdgcn_update_dpp(0, v, 0x4E, 0xF, 0xF, true);
  if (m == 4) return __builtin_amdgcn_ds_swizzle(v, 0x101F);
  if (m == 8) return __builtin_amdgcn_update_dpp(0, v, 0x128, 0xF, 0xF, true);
  if (m == 16) return __builtin_amdgcn_ds_swizzle(v, 0x401F);
  auto rr = __builtin_amdgcn_permlane32_swap((unsigned)v, (unsigned)v, false, false);
  return (lane_id_() < 32) ? (int)rr[1] : (int)rr[0];
}
DEV unsigned shx(unsigned v, int m) { return (unsigned)shx((int)v, m); }
DEV float shx(float v, int m) { return __int_as_float(shx(__float_as_int(v), m)); }
DEV float wave_sum(float v) {
#pragma unroll
  for (int o = 32; o >= 1; o >>= 1) v += shx(v, o);
  return v;
}

#define XB_TMO      128
#define XB_XCNT(j)  (256  + 64 * (j))
#define XB_XSUB(j)  (1280 + 64 * (j))
#define XB_XGEN(j)  (2304 + 64 * (j))
#define XB_TOP      3328
#define XB_TOPGEN   3392
#define XCD_BAR_WORDS 3456
#define XB_SPIN_CAP (1u << 18)
#define LAS __attribute__((address_space(3)))

__device__ __forceinline__ unsigned xb_ld(unsigned* p)              { return __hip_atomic_load(p, __ATOMIC_RELAXED, __HIP_MEMORY_SCOPE_AGENT); }
__device__ __forceinline__ unsigned xb_add(unsigned* p, unsigned v) { return __hip_atomic_fetch_add(p, v, __ATOMIC_RELAXED, __HIP_MEMORY_SCOPE_AGENT); }
__device__ __forceinline__ unsigned xb_xcc_id() { return (unsigned)__builtin_amdgcn_s_getreg((3 << 11) | 20) & 0xFu; }
#define XB_SPIN(cond, bar) do { unsigned _sp = 0; while (cond) { __builtin_amdgcn_s_sleep(1); \
    if ((++_sp & 255u) == 0u) { if (xb_ld(&(bar)[XB_TMO])) break; if (_sp > XB_SPIN_CAP) { atomicAdd(&(bar)[XB_TMO], 1u); break; } } } } while (0)

struct XcdBarrier {
    unsigned* bar; unsigned x;
    volatile LAS unsigned* st;
};

__device__ __forceinline__ XcdBarrier xcd_barrier_post(unsigned* bar, volatile LAS unsigned* st) {
    XcdBarrier b; b.bar = bar; b.x = xb_xcc_id(); b.st = st;
    if (tidx() == 0) (void)xb_add(&bar[XB_XCNT(b.x)], 1u);
    return b;
}
__device__ __forceinline__ void xcd_barrier_complete(unsigned* bar, unsigned x, unsigned& nloc, unsigned& nx) {
    const unsigned G = gridDim.x * gridDim.y * gridDim.z;
    unsigned sum, cnt, mine, sp = 0u;
    for (;;) {
        sum = 0u; cnt = 0u; mine = 0u;
#pragma unroll
        for (unsigned j = 0; j < 16; ++j) { const unsigned c = xb_ld(&bar[XB_XCNT(j)]); sum += c; cnt += (c > 0u) ? 1u : 0u; mine = (j == x) ? c : mine; }
        if (sum == G) break;
        __builtin_amdgcn_s_sleep(1);
        if ((++sp & 255u) == 0u) { if (xb_ld(&bar[XB_TMO])) break; if (sp > XB_SPIN_CAP) { atomicAdd(&bar[XB_TMO], 1u); break; } }
    }
    nloc = mine > 0u ? mine : 1u; nx = cnt > 0u ? cnt : 1u;
}

__device__ __forceinline__ void xcd_barrier(const XcdBarrier& b) {
    asm volatile("s_waitcnt vmcnt(0)" ::: "memory");
    __syncthreads();
    if (tidx() == 0) {
        unsigned* bar = b.bar;
        __builtin_amdgcn_s_waitcnt(0);
        unsigned nloc = b.st[0], nx = b.st[1];
        if (nloc == 0u) { xcd_barrier_complete(bar, b.x, nloc, nx); b.st[0] = nloc; b.st[1] = nx; }
        const unsigned old = xb_add(&bar[XB_XSUB(b.x)], 1u);
        const unsigned gen = old / nloc;
        if (old + 1u == (gen + 1u) * nloc) {
            __builtin_amdgcn_fence(__ATOMIC_RELEASE, "agent");
            asm volatile("s_waitcnt vmcnt(0)" ::: "memory");
            const unsigned og = xb_add(&bar[XB_TOP], 1u);
            const unsigned tg = og / nx;
            if (og + 1u == (tg + 1u) * nx) xb_add(&bar[XB_TOPGEN], 1u);
            else XB_SPIN(xb_ld(&bar[XB_TOPGEN]) == tg, bar);
            __builtin_amdgcn_fence(__ATOMIC_ACQUIRE, "agent");
            xb_add(&bar[XB_XGEN(b.x)], 1u);
            asm volatile("s_waitcnt vmcnt(0)" ::: "memory");
        } else {
            XB_SPIN(xb_ld(&bar[XB_XGEN(b.x)]) == gen, bar);
            __builtin_amdgcn_fence(__ATOMIC_ACQUIRE, "agent");
            asm volatile("s_waitcnt vmcnt(0)" ::: "memory");
        }
    }
    __syncthreads();
}


DEV int win_col_map(int j) {
  if (j < 1280) return j;
  if (j < 4864) return j + 24;
  if (j < 4888) return j - 4864 + 1280;
  return -1;
}
DEV void tr_tile(const float* __restrict__ src, int ldsrc, int K, bf16* __restrict__ dst, int kt, int nt, bool remap,
                 float* sm) {
  const int tid = tidx();
#pragma unroll 4
  for (int i = 0; i < 16; ++i) {
    int r = i * 4 + (tid >> 6), cx = tid & 63;
    int j = nt * 64 + cx, k = kt * 64 + r;
    int oc = remap ? win_col_map(j) : j;
    sm[r * 65 + cx] = (oc >= 0) ? src[(size_t)k * ldsrc + oc] : 0.f;
  }
  __syncthreads();
#pragma unroll 4
  for (int i = 0; i < 16; ++i) {
    int n = i * 4 + (tid >> 6), kk = tid & 63;
    dst[(size_t)(nt * 64 + n) * K + kt * 64 + kk] = f2bf(sm[kk * 65 + n]);
  }
  __syncthreads();
}

constexpr int PREP_TR_WIN = 2 * 78 * 16;
constexpr int PREP_TR_UPN = 2 * 16 * 8;
constexpr int PREP_TR_UPM = 2 * 16 * 8;
constexpr int PREP_TR_OUT = 2 * 16 * 16;
constexpr int PREP_TR_WQ = 2 * 32 * 16;
constexpr int PREP_ROPE = 512;
constexpr int PREP_MOD = 384;
constexpr int PREP_PEB = 16;
constexpr int PREP_PK = 32;
constexpr int PREP_TR_W1 = 4 * 2 * 32;
constexpr int PREP_ITEMS = PREP_TR_WIN + PREP_TR_UPN + PREP_TR_UPM + PREP_TR_OUT + PREP_TR_WQ + PREP_ROPE + PREP_MOD + PREP_PEB + PREP_PK + PREP_TR_W1;

DEV void prep_item(const Params& p, int item, float* sm) {
  const int tid = tidx();
  if (item < PREP_TR_WIN) {
    int l = item / (78 * 16), r = item % (78 * 16);
    int nt = r / 16, kt = r % 16;
    tr_tile(p.w_in + (size_t)l * 1024 * 4888, 4888, 1024, (bf16*)(p.ws + OFF_WINT) + (size_t)l * WN * 1024, kt, nt, true, sm);
    return;
  }
  item -= PREP_TR_WIN;
  if (item < PREP_TR_UPN) {
    int l = item / 128, r = item % 128;
    int nt = r / 8, kt = r % 8;
    tr_tile(p.w_up_nsa + (size_t)l * 512 * 1024, 1024, 512, (bf16*)(p.ws + OFF_WUPN) + (size_t)l * 1024 * 512, kt, nt, false, sm);
    return;
  }
  item -= PREP_TR_UPN;
  if (item < PREP_TR_UPM) {
    int l = item / 128, r = item % 128;
    int nt = r / 8, kt = r % 8;
    tr_tile(p.w_up_moba + (size_t)l * 512 * 1024, 1024, 512, (bf16*)(p.ws + OFF_WUPM) + (size_t)l * 1024 * 512, kt, nt, false, sm);
    return;
  }
  item -= PREP_TR_UPM;
  if (item < PREP_TR_OUT) {
    int l = item / 256, r = item % 256;
    int nt = r / 16, kt = r % 16;
    tr_tile(p.w_out + (size_t)l * 1024 * 1024, 1024, 1024, (bf16*)(p.ws + OFF_WOUT) + (size_t)l * 1024 * 1024, kt, nt, false, sm);
    return;
  }
  item -= PREP_TR_OUT;
  if (item < PREP_TR_WQ) {
    int l = item / 512, r = item % 512;
    int nt = r / 16, kt = r % 16;
    tr_tile(p.peer_wq + (size_t)l * 1024 * 2048, 2048, 1024, (bf16*)(p.ws + OFF_WQ) + (size_t)l * 2048 * 1024, kt, nt, false, sm);
    return;
  }
  item -= PREP_TR_WQ;
  if (item < PREP_ROPE) {
    int idx = item * 256 + tid;
    int pos = idx >> 3, i = idx & 7;
    float inv = powf(500000.0f, -(float)i / 8.0f);
    float ang = (float)pos * inv;
    float* rp = (float*)(p.ws + OFF_ROPE) + (size_t)pos * 16;
    rp[i] = (float)cos((double)ang);
    rp[8 + i] = (float)sin((double)ang);
    return;
  }
  item -= PREP_ROPE;
  if (item < PREP_MOD) {
    for (int i = tid; i < 2048; i += 256) {
      float cv = p.c[i];
      sm[i] = cv / (1.f + expf(-cv));
    }
    __syncthreads();
    const int l = item / 192, n0 = (item % 192) * 32;
    const int col = tid & 31, ks = tid >> 5;
    const float* w = p.w_ada + (size_t)l * 1024 * 6144 + n0 + col;
    float a0 = 0.f, a1 = 0.f;
#pragma unroll 8
    for (int k = ks * 128; k < ks * 128 + 128; ++k) {
      float wv = w[(size_t)k * 6144];
      a0 += sm[k] * wv;
      a1 += sm[1024 + k] * wv;
    }
    sm[2048 + tid * 2] = a0;
    sm[2048 + tid * 2 + 1] = a1;
    __syncthreads();
    if (tid < 64) {
      const int c2 = tid & 31, bs = tid >> 5;
      float s = 0.f;
#pragma unroll
      for (int q = 0; q < 8; ++q) s += sm[2048 + (q * 32 + c2) * 2 + bs];
      ((float*)(p.ws + OFF_MOD))[(l * 2 + bs) * 6144 + n0 + c2] = s + p.b_ada[l * 6144 + n0 + c2];
    }
    __syncthreads();
    return;
  }
  item -= PREP_MOD;
  if (item < PREP_PEB) {
    const int lw = item >> 2, j0 = (item & 3) * 32;
    const int col = tid & 31, ks = tid >> 5;
    const float* pe = p.cmp_pe + (size_t)lw * 2048;
    const float* w1 = p.cmp_w1 + (size_t)lw * 2048 * 128 + j0 + col;
    float a = 0.f;
#pragma unroll 8
    for (int i = ks * 256; i < ks * 256 + 256; ++i) a += pe[i] * w1[(size_t)i * 128];
    sm[tid] = a;
    __syncthreads();
    if (tid < 32) {
      float s = 0.f;
#pragma unroll
      for (int q = 0; q < 8; ++q) s += sm[q * 32 + tid];
      ((float*)(p.ws + OFF_PEB))[lw * 128 + j0 + tid] = s;
    }
    if (item == 0 && tid < 4) ((float*)(p.ws + OFF_PROBE))[tid] = 0.f;
    __syncthreads();
    return;
  }
  item -= PREP_PEB;
  if (item < PREP_PK) {
    const int e0 = item * 2048 + tid * 8;
    const int lt = e0 >> 14, off = e0 & 16383;
    const float* srcp = ((lt & 1) ? p.peer_k2 : p.peer_k1) + (size_t)(lt >> 1) * 16384 + off;
    const float4 a = *(const float4*)srcp, b4 = *(const float4*)(srcp + 4);
    uint4 pk;
    pk.x = (unsigned)f2bf(a.x) | ((unsigned)f2bf(a.y) << 16);
    pk.y = (unsigned)f2bf(a.z) | ((unsigned)f2bf(a.w) << 16);
    pk.z = (unsigned)f2bf(b4.x) | ((unsigned)f2bf(b4.y) << 16);
    pk.w = (unsigned)f2bf(b4.z) | ((unsigned)f2bf(b4.w) << 16);
    *(uint4*)((bf16*)(p.ws + OFF_PKB) + e0) = pk;
    return;
  }
  item -= PREP_PK;
  {
    const int lw = item >> 6, r = item & 63;
    const int nt = r >> 5, kt = r & 31;
    tr_tile(p.cmp_w1 + (size_t)lw * 2048 * 128, 128, 2048, (bf16*)(p.ws + OFF_W1T) + (size_t)lw * 128 * 2048, kt, nt, false, sm);
  }
}

DEV void norm_item(const float* __restrict__ xin, const float* __restrict__ g, const float* __restrict__ sc,
                   const float* __restrict__ sh, bf16* __restrict__ hout, int item) {
  const int lane = tidx() & 63, wave = tidx() >> 6;
  const size_t tok = (size_t)item * 4 + wave;
  const int b = (int)(tok / S);
  const float* xr = xin + tok * 1024;
  float4 v[4];
  float ss = 0.f;
#pragma unroll
  for (int i = 0; i < 4; ++i) {
    v[i] = *(const float4*)(xr + i * 256 + lane * 4);
    ss += v[i].x * v[i].x + v[i].y * v[i].y + v[i].z * v[i].z + v[i].w * v[i].w;
  }
  ss = wave_sum(ss);
  float r = 1.0f / sqrtf(ss * (1.0f / 1024.f) + 1e-6f);
#pragma unroll
  for (int i = 0; i < 4; ++i) {
    int d = i * 256 + lane * 4;
    float4 gg = *(const float4*)(g + d);
    float4 s4 = *(const float4*)(sc + b * 6144 + d);
    float4 h4 = *(const float4*)(sh + b * 6144 + d);
    float o0 = v[i].x * r * gg.x * (1.f + s4.x) + h4.x;
    float o1 = v[i].y * r * gg.y * (1.f + s4.y) + h4.y;
    float o2 = v[i].z * r * gg.z * (1.f + s4.z) + h4.z;
    float o3 = v[i].w * r * gg.w * (1.f + s4.w) + h4.w;
    uint2 pk;
    pk.x = (unsigned)f2bf(o0) | ((unsigned)f2bf(o1) << 16);
    pk.y = (unsigned)f2bf(o2) | ((unsigned)f2bf(o3) << 16);
    *(uint2*)(hout + tok * 1024 + d) = pk;
  }
}
DEV void final_norm_item(float* __restrict__ x, const float* __restrict__ g, int item) {
  const int lane = tidx() & 63, wave = tidx() >> 6;
  const size_t tok = (size_t)item * 4 + wave;
  float* xr = x + tok * 1024;
  float4 v[4];
  float ss = 0.f;
#pragma unroll
  for (int i = 0; i < 4; ++i) {
    v[i] = *(const float4*)(xr + i * 256 + lane * 4);
    ss += v[i].x * v[i].x + v[i].y * v[i].y + v[i].z * v[i].z + v[i].w * v[i].w;
  }
  ss = wave_sum(ss);
  float r = 1.0f / sqrtf(ss * (1.0f / 1024.f) + 1e-6f);
#pragma unroll
  for (int i = 0; i < 4; ++i) {
    int d = i * 256 + lane * 4;
    float4 gg = *(const float4*)(g + d);
    float4 o;
    o.x = v[i].x * r * gg.x; o.y = v[i].y * r * gg.y; o.z = v[i].z * r * gg.z; o.w = v[i].w * r * gg.w;
    *(float4*)(xr + d) = o;
  }
}

#define GM_BUF (2 * 128 * 72)
#define GM_LOAD(R, kk)                                                                                  \
  {                                                                                                     \
    const bf16* Ak = Ap + (kk);                                                                         \
    const bf16* Wk = Wp + (kk);                                                                         \
    R##a0 = *(const uint4*)(Ak); R##a1 = *(const uint4*)(Ak + a32); R##a2 = *(const uint4*)(Ak + 2 * a32); \
    R##a3 = *(const uint4*)(Ak + 3 * a32);                                                              \
    R##b0 = *(const uint4*)(Wk); R##b1 = *(const uint4*)(Wk + w32); R##b2 = *(const uint4*)(Wk + 2 * w32); \
    R##b3 = *(const uint4*)(Wk + 3 * w32);                                                              \
  }
#define GM_STORE(R, buf)                                                                                \
  {                                                                                                     \
    bf16* as_ = Asw + (buf) * GM_BUF;                                                                   \
    bf16* bs_ = as_ + 128 * 72;                                                                         \
    *(uint4*)(as_) = R##a0; *(uint4*)(as_ + 32 * 72) = R##a1; *(uint4*)(as_ + 64 * 72) = R##a2; *(uint4*)(as_ + 96 * 72) = R##a3; \
    *(uint4*)(bs_) = R##b0; *(uint4*)(bs_ + 32 * 72) = R##b1; *(uint4*)(bs_ + 64 * 72) = R##b2; *(uint4*)(bs_ + 96 * 72) = R##b3; \
  }
#define GM_COMPUTE(buf)                                                                                 \
  {                                                                                                     \
    const bf16* As_ = sm + (buf) * GM_BUF;                                                              \
    const bf16* Bs_ = As_ + 128 * 72;                                                                   \
    _Pragma("unroll") for (int ks = 0; ks < 2; ++ks) {                                                  \
      __builtin_amdgcn_sched_barrier(0);                                                                \
      bf16x8 af[4], bfr[4];                                                                             \
      _Pragma("unroll") for (int mi = 0; mi < 4; ++mi)                                                  \
        af[mi] = *(const bf16x8*)(As_ + (wr * 64 + mi * 16 + (lane & 15)) * 72 + ks * 32 + (lane >> 4) * 8); \
      _Pragma("unroll") for (int ni = 0; ni < 4; ++ni)                                                  \
        bfr[ni] = *(const bf16x8*)(Bs_ + (wc * 64 + ni * 16 + (lane & 15)) * 72 + ks * 32 + (lane >> 4) * 8); \
      _Pragma("unroll") for (int mi = 0; mi < 4; ++mi)                                                  \
        _Pragma("unroll") for (int ni = 0; ni < 4; ++ni)                                                \
          acc[mi][ni] = __builtin_amdgcn_mfma_f32_16x16x32_bf16(af[mi], bfr[ni], acc[mi][ni], 0, 0, 0); \
    }                                                                                                   \
    __builtin_amdgcn_sched_barrier(0);                                                                  \
  }
DEV void gemm_mainloop(const bf16* __restrict__ A, int lda, const bf16* __restrict__ W, int K, int m0, int n0, bf16* sm,
                       f32x4 (&acc)[4][4]) {
  const int tid = tidx(), lane = tid & 63, wave = tid >> 6;
  const int wr = wave >> 1, wc = wave & 1;
  const int lrow = tid >> 3, lkc = (tid & 7) * 8;
  const bf16* Ap = A + (size_t)(m0 + lrow) * lda + lkc;
  const bf16* Wp = W + (size_t)(n0 + lrow) * K + lkc;
  const int a32 = 32 * lda, w32 = 32 * K;
  bf16* Asw = sm + lrow * 72 + lkc;
  uint4 xa0, xa1, xa2, xa3, xb0, xb1, xb2, xb3, ya0, ya1, ya2, ya3, yb0, yb1, yb2, yb3;
  const int nk = K >> 6;
  GM_LOAD(x, 0)
  GM_LOAD(y, 64)
  __syncthreads();
  GM_STORE(x, 0)
  if (nk > 2) GM_LOAD(x, 128)
  __syncthreads();
  for (int k = 0; k < nk; k += 2) {
    GM_COMPUTE(0)
    GM_STORE(y, 1)
    if (k + 3 < nk) GM_LOAD(y, (k + 3) * 64)
    __syncthreads();
    GM_COMPUTE(1)
    if (k + 2 < nk) {
      GM_STORE(x, 0)
      if (k + 4 < nk) GM_LOAD(x, (k + 4) * 64)
    }
    __syncthreads();
  }
}
DEV void acc_zero(f32x4 (&acc)[4][4]) {
#pragma unroll
  for (int i = 0; i < 4; ++i)
#pragma unroll
    for (int j = 0; j < 4; ++j) acc[i][j] = f32x4{0.f, 0.f, 0.f, 0.f};
}
DEV void store_tile_bf16(bf16* sm, const f32x4 (&acc)[4][4], bf16* __restrict__ dbase, size_t dstride) {
  const int tid = tidx(), lane = tid & 63, wave = tid >> 6, g4 = lane >> 4, c16 = lane & 15;
  bf16* Cw = sm + wave * (64 * 72);
  __syncthreads();
#pragma unroll
  for (int mi = 0; mi < 4; ++mi)
#pragma unroll
    for (int ni = 0; ni < 4; ++ni)
#pragma unroll
      for (int r = 0; r < 4; ++r) Cw[(mi * 16 + g4 * 4 + r) * 72 + ni * 16 + c16] = f2bf(acc[mi][ni][r]);
  __syncthreads();
#pragma unroll
  for (int it = 0; it < 8; ++it) {
    const int row_l = it * 8 + (lane >> 3), ch = lane & 7;
    const uint4 v = *(const uint4*)(Cw + row_l * 72 + ch * 8);
    *(uint4*)(dbase + (size_t)row_l * dstride + ch * 8) = v;
  }
}
template <class Epi>
DEV void gemm_tile(const bf16* __restrict__ A, int lda, const bf16* __restrict__ W, int K, int m0, int n0, bf16* sm,
                   Epi epi) {
  f32x4 acc[4][4];
  acc_zero(acc);
  gemm_mainloop(A, lda, W, K, m0, n0, sm, acc);
  const int tid = tidx(), lane = tid & 63, wave = tid >> 6;
  const int wr = wave >> 1, wc = wave & 1;
#pragma unroll
  for (int mi = 0; mi < 4; ++mi)
#pragma unroll
    for (int ni = 0; ni < 4; ++ni)
#pragma unroll
      for (int r = 0; r < 4; ++r) {
        int row = m0 + wr * 64 + mi * 16 + (lane >> 4) * 4 + r;
        int col = n0 + wc * 64 + ni * 16 + (lane & 15);
        epi(row, col, acc[mi][ni][r]);
      }
}
DEV void inproj_tile(const Params& p, int layer, int m0, int n0, bf16* sm) {
  f32x4 acc[4][4];
  acc_zero(acc);
  gemm_mainloop((const bf16*)(p.ws + OFF_H), 1024, (const bf16*)(p.ws + OFF_WINT) + (size_t)layer * WN * 1024, 1024, m0, n0, sm, acc);
  const int tid = tidx(), lane = tid & 63, wave = tid >> 6, g4 = lane >> 4, c16 = lane & 15;
  const int wr = wave >> 1, wc = wave & 1;
  const int vc0 = n0 + wc * 64;
  const int row0 = m0 + wr * 64;
  const int b = row0 / S, t0 = row0 % S;
  bf16* dbase;
  size_t dstride;
  bool roped = false;
  bf16* projp = (bf16*)(p.ws + OFF_PROJ) + (size_t)row0 * PC;
  if (vc0 < 768) { dbase = projp + vc0; dstride = PC; }
  else if (vc0 < 1280) {
    const int seg = (vc0 - 768) >> 7, head = ((vc0 - 768) >> 6) & 1;
    const size_t off = (seg == 0) ? OFF_KSB : (seg == 1) ? OFF_VSB : (seg == 2) ? OFF_KWB : OFF_VWB;
    dbase = (bf16*)(p.ws + off) + ((size_t)(b * 2 + head) * S + t0) * 64;
    dstride = 64;
    roped = (seg == 0) || (seg == 2);
  } else if (vc0 < 1792) { dbase = projp + C_MQ + (vc0 - 1280); dstride = PC; roped = true; }
  else if (vc0 < 2816) {
    const int seg = (vc0 - 1792) >> 9, head = ((vc0 - 1792) >> 6) & 7;
    dbase = (bf16*)(p.ws + (seg ? OFF_MVB : OFF_MKB)) + ((size_t)(b * 8 + head) * S + t0) * 64;
    dstride = 64;
    roped = (seg == 0);
  } else if (vc0 < 4864) { dbase = projp + C_GN + (vc0 - 2816); dstride = PC; }
  else { dbase = projp + C_NG + (vc0 - 4864); dstride = PC; }
  if (roped) {
    const float* rope = (const float*)(p.ws + OFF_ROPE);
#pragma unroll
    for (int mi = 0; mi < 4; ++mi)
#pragma unroll
      for (int r = 0; r < 4; ++r) {
        const int pos = t0 + mi * 16 + g4 * 4 + r;
        const float v = acc[mi][0][r];
        const float pv = shx(v, 8);
        const float cs = rope[pos * 16 + (c16 & 7)], sn = rope[pos * 16 + 8 + (c16 & 7)];
        acc[mi][0][r] = (c16 < 8) ? (v * cs - pv * sn) : (v * cs + pv * sn);
      }
  }
  store_tile_bf16(sm, acc, dbase, dstride);
}
typedef unsigned u32x2_t __attribute__((ext_vector_type(2)));
DEV void merge_tile(const Params& p, int layer, int m0, int n0, bf16* sm) {
  const int tid = tidx(), lane = tid & 63, wave = tid >> 6, g4 = lane >> 4, c16 = lane & 15;
  const int wr = wave >> 1, wc = wave & 1;
  const bf16* projg = (const bf16*)(p.ws + OFF_PROJ) + (size_t)(m0 + wr * 64 + g4 * 4) * PC + n0 + wc * 64 + c16;
  f32x4 acc[4][4];
  acc_zero(acc);
  gemm_mainloop((const bf16*)(p.ws + OFF_ONSA), 512, (const bf16*)(p.ws + OFF_WUPN) + (size_t)layer * 1024 * 512, 512, m0, n0, sm, acc);
  bf16* yg = (bf16*)(p.ws + OFF_H) + (size_t)(m0 + wr * 64 + g4 * 4) * 1024 + n0 + wc * 64 + c16;
#pragma unroll
  for (int mi = 0; mi < 4; ++mi)
#pragma unroll
    for (int ni = 0; ni < 4; ++ni)
#pragma unroll
      for (int r = 0; r < 4; ++r)
        yg[(size_t)(mi * 16 + r) * 1024 + ni * 16] =
            f2bf(sigmoidf_(bf2f(projg[(size_t)(mi * 16 + r) * PC + C_GN + ni * 16])) * acc[mi][ni][r]);
  acc_zero(acc);
  gemm_mainloop((const bf16*)(p.ws + OFF_OMOBA), 512, (const bf16*)(p.ws + OFF_WUPM) + (size_t)layer * 1024 * 512, 512, m0, n0, sm, acc);
#pragma unroll
  for (int mi = 0; mi < 4; ++mi)
#pragma unroll
    for (int ni = 0; ni < 4; ++ni)
#pragma unroll
      for (int r = 0; r < 4; ++r)
        acc[mi][ni][r] = bf2f(yg[(size_t)(mi * 16 + r) * 1024 + ni * 16]) +
                         sigmoidf_(bf2f(projg[(size_t)(mi * 16 + r) * PC + C_GM + ni * 16])) * acc[mi][ni][r];
  store_tile_bf16(sm, acc, (bf16*)(p.ws + OFF_H) + (size_t)(m0 + wr * 64) * 1024 + n0 + wc * 64, 1024);
}

DEV void compress_item(const Params& p, int layer, int item, float* sm) {
  const int tid = tidx();
  const int grp = item & 127, which = (item >> 7) & 1, kvh = (item >> 8) & 1, b = item >> 9;
  const int c0 = grp * 8;
  float* xs = sm;
  float* hs = sm + 144 * 64;
  const bf16* proj = (const bf16*)(p.ws + OFF_PROJ);
  const int col = (which ? C_VC : C_KC) + kvh * 64;
  for (int i = tid; i < 144 * 64; i += 256) {
    int tl = i >> 6, d = i & 63;
    int t = c0 * 16 + tl;
    xs[i] = (t < S) ? bf2f(proj[((size_t)b * S + t) * PC + col + d]) : 0.f;
  }
  __syncthreads();
  const int lw = layer * 2 + which;
  if (tid < 128) {
    const float* w1 = p.cmp_w1 + (size_t)lw * 2048 * 128 + tid;
    float acc[8];
#pragma unroll
    for (int ci = 0; ci < 8; ++ci) acc[ci] = 0.f;
    for (int l = 0; l < 32; ++l) {
#pragma unroll 4
      for (int d = 0; d < 64; ++d) {
        float w = w1[(size_t)(l * 64 + d) * 128];
#pragma unroll
        for (int ci = 0; ci < 8; ++ci) acc[ci] += xs[(ci * 16 + l) * 64 + d] * w;
      }
    }
    float pb = ((const float*)(p.ws + OFF_PEB))[lw * 128 + tid];
#pragma unroll
    for (int ci = 0; ci < 8; ++ci) hs[ci * 128 + tid] = gelu_tanh(acc[ci] + pb);
  }
  __syncthreads();
  const float* w2 = p.cmp_w2 + (size_t)lw * 128 * 64;
  float* outp = PROBE_CMPR ? ((float*)(p.ws + OFF_CMP) + (which ? (size_t)Bn * 1024 * 128 : 0)) : (float*)(p.ws + (which ? OFF_VCC : OFF_KCC));
#pragma unroll
  for (int rr = 0; rr < 2; ++rr) {
    int o = rr * 256 + tid;
    int ci = o >> 6, d = o & 63;
    int c = c0 + ci;
    float a = 0.f;
    for (int j = 0; j < 128; ++j) a += hs[ci * 128 + j] * w2[j * 64 + d];
    if (c < 1023) outp[(((size_t)b * 1024 + c) * 2 + kvh) * 64 + d] = a;
    bf16* outb = (bf16*)(p.ws + (which ? OFF_VCB : OFF_KCB));
    if (!PROBE_CMPR && c < 1024) outb[(((size_t)b * 2 + kvh) * 1024 + c) * 64 + d] = (c < 1023) ? f2bf(a) : (bf16)0;
  }
  __syncthreads();
}

DEV void compress_mfma_item(const Params& p, int layer, int item, char* smem) {
  bf16* xs = (bf16*)smem;
  float* hs = (float*)(smem + 272 * 64 * 2);
  const int tid = tidx(), lane = tid & 63, wave = tid >> 6, g4 = lane >> 4, c16 = lane & 15;
  const int cblk = item & 63, which = (item >> 6) & 1, kvh = (item >> 7) & 1, b = item >> 8;
  const int t0 = cblk * 256;
  const bf16* proj = (const bf16*)(p.ws + OFF_PROJ) + (size_t)b * S * PC + (which ? C_VC : C_KC) + kvh * 64;
  __syncthreads();
  for (int i = tid; i < 272 * 8; i += 256) {
    const int tl = i >> 3, ch = i & 7;
    const int t = t0 + tl;
    uint4 v = uint4{0u, 0u, 0u, 0u};
    if (t < S) v = *(const uint4*)(proj + (size_t)t * PC + ch * 8);
    *(uint4*)(xs + tl * 64 + ((ch ^ ((tl >> 4) & 7)) * 8)) = v;
  }
  __syncthreads();
  const int lw = layer * 2 + which;
  const bf16* w1t = (const bf16*)(p.ws + OFF_W1T) + (size_t)lw * 128 * 2048;
  f32x4 acc0 = f32x4{0.f, 0.f, 0.f, 0.f}, acc1 = f32x4{0.f, 0.f, 0.f, 0.f};
  const bf16* wb0 = w1t + (size_t)((2 * wave) * 16 + c16) * 2048 + g4 * 8;
  const bf16* wb1 = w1t + (size_t)((2 * wave + 1) * 16 + c16) * 2048 + g4 * 8;
#pragma unroll 4
  for (int ks = 0; ks < 64; ++ks) {
    const int l = ks >> 1, ch = (ks & 1) * 4 + g4;
    const int tl = 16 * c16 + l;
    const bf16x8 af = *(const bf16x8*)(xs + tl * 64 + ((ch ^ ((tl >> 4) & 7)) * 8));
    const bf16x8 b0 = *(const bf16x8*)(wb0 + ks * 32);
    const bf16x8 b1 = *(const bf16x8*)(wb1 + ks * 32);
    acc0 = MFMA16B(af, b0, acc0);
    acc1 = MFMA16B(af, b1, acc1);
  }
  {
    const float* peb = (const float*)(p.ws + OFF_PEB) + lw * 128;
    const int j0 = (2 * wave) * 16 + c16, j1 = j0 + 16;
    const float pb0 = peb[j0], pb1 = peb[j1];
#pragma unroll
    for (int r = 0; r < 4; ++r) {
      hs[(g4 * 4 + r) * 128 + j0] = gelu_tanh(acc0[r] + pb0);
      hs[(g4 * 4 + r) * 128 + j1] = gelu_tanh(acc1[r] + pb1);
    }
  }
  __syncthreads();
  const float* w2 = p.cmp_w2 + (size_t)lw * 128 * 64;
  const int d = tid & 63, cq = tid >> 6;
  float o0 = 0.f, o1 = 0.f, o2 = 0.f, o3 = 0.f;
#pragma unroll 8
  for (int j = 0; j < 128; ++j) {
    const float w = w2[j * 64 + d];
    o0 += hs[(cq * 4 + 0) * 128 + j] * w;
    o1 += hs[(cq * 4 + 1) * 128 + j] * w;
    o2 += hs[(cq * 4 + 2) * 128 + j] * w;
    o3 += hs[(cq * 4 + 3) * 128 + j] * w;
  }
  float* outp = (float*)(p.ws + (which ? OFF_VCC : OFF_KCC));
  bf16* outb = (bf16*)(p.ws + (which ? OFF_VCB : OFF_KCB));
  const float ov[4] = {o0, o1, o2, o3};
#pragma unroll
  for (int i = 0; i < 4; ++i) {
    const int c = cblk * 16 + cq * 4 + i;
    if (c < 1023) outp[(((size_t)b * 1024 + c) * 2 + kvh) * 64 + d] = ov[i];
    outb[(((size_t)b * 2 + kvh) * 1024 + c) * 64 + d] = (c < 1023) ? f2bf(ov[i]) : (bf16)0;
  }
  __syncthreads();
}

DEV void n1_item(const Params& p, int layer, int item, float* sm) {
  const int chunk = item & 255, kvh = (item >> 8) & 1, b = item >> 9;
  const int tid = tidx(), ql = tid >> 2, g = tid & 3;
  const int t = chunk * 64 + ql, h = kvh * 4 + g;
  const size_t tok = (size_t)b * S + t;
  const bf16* proj = (const bf16*)(p.ws + OFF_PROJ);
  float* imp = sm;
  for (int i = tid; i < 64 * 257; i += 256) imp[i] = 0.f;
  float q[64];
  load_q64(q, proj + tok * PC + C_NQ + h * 64, 0.125f);
  const int nv = (t >= 31) ? (((t - 31) >> 4) + 1) : 0;
  const int nv_max = (((chunk * 64 + 63) - 31) >> 4) + 1;
  const float* kc = (const float*)(p.ws + OFF_KCC) + (size_t)b * 1024 * 128 + kvh * 64;
  const float* vc = (const float*)(p.ws + OFF_VCC) + (size_t)b * 1024 * 128 + kvh * 64;
  float m = -INFINITY, l = 0.f;
  for (int c = 0; c < nv_max; ++c) {
    float s = dot64_f(q, kc + (size_t)c * 128);
    if (c < nv) {
      float mn = fmaxf(m, s);
      l = l * expf(m - mn) + expf(s - mn);
      m = mn;
    }
  }
  __syncthreads();
  float o[64];
#pragma unroll
  for (int d = 0; d < 64; ++d) o[d] = 0.f;
  const float inv_l = (nv > 0) ? 1.f / l : 0.f;
  for (int c = 0; c < nv_max; ++c) {
    float s = dot64_f(q, kc + (size_t)c * 128);
    float pr = (c < nv) ? expf(s - m) * inv_l : 0.f;
    axpy64_f(o, pr, vc + (size_t)c * 128);
    float ps = pr;
    ps += shx(ps, 1);
    ps += shx(ps, 2);
    if (g == 0) {
      int n = c >> 2;
      if ((c & 3) == 3) {
        imp[ql * 257 + n] += 0.5f * ps;
        imp[ql * 257 + n + 1] += 0.5f * ps;
      } else {
        imp[ql * 257 + n] += ps;
      }
    }
  }
  const float gate0 = (!PROBE_NSA || (PROBE_NSA & 1)) ? sigmoidf_(bf2f(proj[tok * PC + C_NG + h * 3 + 0])) : 0.f;
  float* oa = (float*)(p.ws + OFF_H) + tok * 512 + h * 64;
#pragma unroll
  for (int d = 0; d < 64; d += 4) {
    float4 v = {gate0 * o[d], gate0 * o[d + 1], gate0 * o[d + 2], gate0 * o[d + 3]};
    *(float4*)(oa + d) = v;
  }
  __syncthreads();
#if PROBE_NSA == 8
  if (b == 0 && kvh == 0)
    for (int i = tid; i < 64 * 256; i += 256)
      ((float*)(p.ws + OFF_OMOBA))[(size_t)(chunk * 64 + (i >> 8)) * 256 + (i & 255)] = imp[(i >> 8) * 257 + (i & 255)];
  __syncthreads();
#endif
  if (g == 0) {
    int* selp = (int*)(p.ws + OFF_SEL) + (((size_t)b * 2 + kvh) * S + t) * 16;
    const int cur = chunk;
    if (cur < 16) {
      for (int j = 0; j < 16; ++j) selp[j] = (j <= cur) ? j : -1;
    } else {
      selp[0] = 0;
      selp[1] = cur - 1;
      selp[2] = cur;
      float* row = imp + ql * 257;
      for (int j = 3; j < 16; ++j) {
        float best = -1.f;
        int bi = 1;
        for (int n = 1; n <= cur - 2; ++n) {
          float v = row[n];
          if (v > best) { best = v; bi = n; }
        }
        selp[j] = bi;
        row[bi] = -2.f;
      }
    }
  }
  __syncthreads();
}

DEV void kmean_item(const Params& p, int item, float* sm) {
  const int n = item & 63, h = (item >> 6) & 7, b = item >> 9;
  const int tid = tidx(), d = tid & 63, part = tid >> 6;
  const bf16* mkb = (const bf16*)(p.ws + OFF_MKB);
  float a = 0.f;
  for (int i = 0; i < 64; ++i) {
    int t = n * 256 + part * 64 + i;
    a += bf2f(mkb[((size_t)(b * 8 + h) * S + t) * 64 + d]);
  }
  sm[tid] = a;
  __syncthreads();
  if (tid < 64) {
    float s = sm[tid] + sm[64 + tid] + sm[128 + tid] + sm[192 + tid];
    const size_t ko = (((size_t)b * 8 + h) * 64 + n) * 64 + tid;
    const float mean = s * (1.f / 256.f);
    ((float*)(p.ws + OFF_KMEAN))[ko] = mean;
    const bf16 hi = f2bf(mean);
    ((bf16*)(p.ws + OFF_KMHL))[ko] = hi;
    ((bf16*)(p.ws + OFF_KMHL))[(size_t)2 * 8 * 64 * 64 + ko] = f2bf(mean - bf2f(hi));
    if (tid == 0) ((int*)(p.ws + OFF_MCNT))[(b * 8 + h) * 64 + n] = 0;
  }
  __syncthreads();
}

DEV void n23_item(const Params& p, int layer, int item) {
  const int chunk = item & 255, kvh = (item >> 8) & 1, b = item >> 9;
  const int tid = tidx(), ql = tid >> 2, g = tid & 3;
  const int t = chunk * 64 + ql, h = kvh * 4 + g;
  const size_t tok = (size_t)b * S + t;
  const bf16* proj = (const bf16*)(p.ws + OFF_PROJ);
  const float* rope = (const float*)(p.ws + OFF_ROPE) + (size_t)t * 16;
  float q[64];
  load_q64(q, proj + tok * PC + C_NQ + h * 64, 1.0f);
#pragma unroll
  for (int i = 0; i < 8; ++i) {
    float cs = rope[i], sn = rope[8 + i];
    float x1 = q[i], x2 = q[8 + i];
    q[i] = x1 * cs - x2 * sn;
    q[8 + i] = x2 * cs + x1 * sn;
  }
#pragma unroll
  for (int i = 0; i < 64; ++i) q[i] *= 0.125f;
  const size_t kvo = ((size_t)(b * 2 + kvh) * S) * 64;
  const bf16* ksb = (const bf16*)(p.ws + OFF_KSB) + kvo;
  const bf16* vsb = (const bf16*)(p.ws + OFF_VSB) + kvo;
  const bf16* kwb = (const bf16*)(p.ws + OFF_KWB) + kvo;
  const bf16* vwb = (const bf16*)(p.ws + OFF_VWB) + kvo;
  const int* selp = (const int*)(p.ws + OFF_SEL) + (((size_t)b * 2 + kvh) * S + t) * 16;
  float* oa = (float*)(p.ws + OFF_H) + tok * 512 + h * 64;
  const float gate1 = (!PROBE_NSA || (PROBE_NSA & 2)) ? sigmoidf_(bf2f(proj[tok * PC + C_NG + h * 3 + 1])) : 0.f;
  const float gate2 = (!PROBE_NSA || (PROBE_NSA & 4)) ? sigmoidf_(bf2f(proj[tok * PC + C_NG + h * 3 + 2])) : 0.f;
  float o[64];
  {
    float m = -INFINITY;
    for (int j = 0; j < 16; ++j) {
      int n = selp[j];
      if (n >= 0) {
        for (int i = 0; i < 64; ++i) {
          int kpos = n * 64 + i;
          if (kpos <= t) {
            float s = dot64_bf(q, ksb + (size_t)kpos * 64);
            m = fmaxf(m, s);
          }
        }
      }
    }
    float l = 0.f;
#pragma unroll
    for (int d = 0; d < 64; ++d) o[d] = 0.f;
    for (int j = 0; j < 16; ++j) {
      int n = selp[j];
      if (n >= 0) {
        for (int i = 0; i < 64; ++i) {
          int kpos = n * 64 + i;
          if (kpos <= t) {
            float s = dot64_bf(q, ksb + (size_t)kpos * 64);
            float pr = expf(s - m);
            l += pr;
            axpy64_bf(o, pr, vsb + (size_t)kpos * 64);
          }
        }
      }
    }
    float sc = gate1 / l;
#pragma unroll
    for (int d = 0; d < 64; d += 4) {
      float4 v = *(float4*)(oa + d);
      v.x += sc * o[d]; v.y += sc * o[d + 1]; v.z += sc * o[d + 2]; v.w += sc * o[d + 3];
      *(float4*)(oa + d) = v;
    }
  }
  {
    const int s0 = chunk * 64;
    const int jlo = (s0 - 511 > 0) ? (s0 - 511) : 0;
    const int jhi = s0 + 63;
    float m = -INFINITY;
    for (int j = jlo; j <= jhi; ++j) {
      float s = dot64_bf(q, kwb + (size_t)j * 64);
      if (j <= t && j > t - 512) m = fmaxf(m, s);
    }
    float l = 0.f;
#pragma unroll
    for (int d = 0; d < 64; ++d) o[d] = 0.f;
    for (int j = jlo; j <= jhi; ++j) {
      float s = dot64_bf(q, kwb + (size_t)j * 64);
      float pr = (j <= t && j > t - 512) ? expf(s - m) : 0.f;
      l += pr;
      axpy64_bf(o, pr, vwb + (size_t)j * 64);
    }
    float sc = gate2 / l;
    bf16* ob = (bf16*)(p.ws + (PROBE_NSA ? OFF_CMP : OFF_ONSA)) + tok * 512 + h * 64;
#pragma unroll
    for (int d = 0; d < 64; d += 8) {
      float4 v0 = *(float4*)(oa + d);
      float4 v1 = *(float4*)(oa + d + 4);
      uint4 pk;
      pk.x = (unsigned)f2bf(v0.x + sc * o[d]) | ((unsigned)f2bf(v0.y + sc * o[d + 1]) << 16);
      pk.y = (unsigned)f2bf(v0.z + sc * o[d + 2]) | ((unsigned)f2bf(v0.w + sc * o[d + 3]) << 16);
      pk.z = (unsigned)f2bf(v1.x + sc * o[d + 4]) | ((unsigned)f2bf(v1.y + sc * o[d + 5]) << 16);
      pk.w = (unsigned)f2bf(v1.z + sc * o[d + 6]) | ((unsigned)f2bf(v1.w + sc * o[d + 7]) << 16);
      *(uint4*)(ob + d) = pk;
    }
  }
}

DEV void moba_item(const Params& p, int layer, int item) {
  const int blk = item & 63, h = (item >> 6) & 7, b = item >> 9;
  const int tid = tidx();
  const int t = blk * 256 + tid;
  const size_t tok = (size_t)b * S + t;
  const bf16* proj = (const bf16*)(p.ws + OFF_PROJ);
  float q[64];
  load_q64(q, proj + tok * PC + C_MQ + h * 64, 0.125f);
  const float* km = (const float*)(p.ws + OFF_KMEAN) + ((size_t)b * 8 + h) * 64 * 64;
  float b0 = -INFINITY, b1 = -INFINITY, b2 = -INFINITY;
  int i0 = -1, i1 = -1, i2 = -1;
  for (int n = 0; n < blk; ++n) {
    float v = dot64_f(q, km + n * 64);
    if (v > b0) { b2 = b1; i2 = i1; b1 = b0; i1 = i0; b0 = v; i0 = n; }
    else if (v > b1) { b2 = b1; i2 = i1; b1 = v; i1 = n; }
    else if (v > b2) { b2 = v; i2 = n; }
  }
  const bf16* mkb = (const bf16*)(p.ws + OFF_MKB) + ((size_t)(b * 8 + h) * S) * 64;
  const bf16* mvb = (const bf16*)(p.ws + OFF_MVB) + ((size_t)(b * 8 + h) * S) * 64;
  float m = -INFINITY;
  for (int sidx = 0; sidx < 3; ++sidx) {
    int n = (sidx == 0) ? i0 : (sidx == 1) ? i1 : i2;
    if (sidx < blk) {
      for (int i = 0; i < 256; ++i) {
        float s = dot64_bf(q, mkb + (size_t)(n * 256 + i) * 64);
        m = fmaxf(m, s);
      }
    }
  }
  for (int i = 0; i < 256; ++i) {
    int kpos = blk * 256 + i;
    float s = dot64_bf(q, mkb + (size_t)kpos * 64);
    if (kpos <= t) m = fmaxf(m, s);
  }
  float l = 0.f;
  float o[64];
#pragma unroll
  for (int d = 0; d < 64; ++d) o[d] = 0.f;
  for (int sidx = 0; sidx < 3; ++sidx) {
    int n = (sidx == 0) ? i0 : (sidx == 1) ? i1 : i2;
    if (sidx < blk) {
      for (int i = 0; i < 256; ++i) {
        const size_t ko = (size_t)(n * 256 + i) * 64;
        float s = dot64_bf(q, mkb + ko);
        float pr = expf(s - m);
        l += pr;
        axpy64_bf(o, pr, mvb + ko);
      }
    }
  }
  for (int i = 0; i < 256; ++i) {
    int kpos = blk * 256 + i;
    const size_t ko = (size_t)kpos * 64;
    float s = dot64_bf(q, mkb + ko);
    float pr = (kpos <= t) ? expf(s - m) : 0.f;
    l += pr;
    axpy64_bf(o, pr, mvb + ko);
  }
  const float il = 1.f / l;
  bf16* ob = (bf16*)(p.ws + (PROBE_MOBA ? OFF_CMP : OFF_OMOBA)) + tok * 512 + h * 64;
#pragma unroll
  for (int d = 0; d < 64; d += 8) {
    uint4 pk;
    pk.x = (unsigned)f2bf(o[d] * il) | ((unsigned)f2bf(o[d + 1] * il) << 16);
    pk.y = (unsigned)f2bf(o[d + 2] * il) | ((unsigned)f2bf(o[d + 3] * il) << 16);
    pk.z = (unsigned)f2bf(o[d + 4] * il) | ((unsigned)f2bf(o[d + 5] * il) << 16);
    pk.w = (unsigned)f2bf(o[d + 6] * il) | ((unsigned)f2bf(o[d + 7] * il) << 16);
    *(uint4*)(ob + d) = pk;
  }
}

typedef short v4i16_t __attribute__((ext_vector_type(4)));
typedef unsigned u32x4_t __attribute__((ext_vector_type(4)));
DEV v4i16_t lds_tr16(const bf16* p) {
  return __builtin_amdgcn_ds_read_tr16_b64_v4i16((__attribute__((address_space(3))) v4i16_t*)p);
}
DEV unsigned cvtpk(float lo, float hi) {
  unsigned r;
  asm("v_cvt_pk_bf16_f32 %0, %1, %2" : "=v"(r) : "v"(lo), "v"(hi));
  return r;
}
#define MFMA16(a, b, c) __builtin_amdgcn_mfma_f32_16x16x32_bf16(a, b, c, 0, 0, 0)
constexpr float C2 = 0.125f * 1.4426950408889634f;
constexpr int KT_LD = 72;
constexpr int KT_ELEMS = 64 * KT_LD;

template <int NI>
struct AttnSt {
  f32x4 o[4][NI];
  float m[NI], l[NI];
};
template <int NI>
DEV void attn_init(AttnSt<NI>& st) {
#pragma unroll
  for (int ni = 0; ni < NI; ++ni) {
    st.m[ni] = -INFINITY;
    st.l[ni] = 0.f;
#pragma unroll
    for (int di = 0; di < 4; ++di) st.o[di][ni] = f32x4{0.f, 0.f, 0.f, 0.f};
  }
}
#define TILE_DECL uint4 tl_k0, tl_k1, tl_v0, tl_v1
#define TILE_GLOAD(kb, vb, ld, key0)                                                        \
  do {                                                                                      \
    const int r_ = tidx() >> 3, c_ = (tidx() & 7) * 8;                            \
    tl_k0 = *(const uint4*)((kb) + (size_t)((key0) + r_) * (ld) + c_);                      \
    tl_k1 = *(const uint4*)((kb) + (size_t)((key0) + 32 + r_) * (ld) + c_);                 \
    tl_v0 = *(const uint4*)((vb) + (size_t)((key0) + r_) * (ld) + c_);                      \
    tl_v1 = *(const uint4*)((vb) + (size_t)((key0) + 32 + r_) * (ld) + c_);                 \
  } while (0)
#define TILE_SSTORE(Ks_, Vs_)                                                               \
  do {                                                                                      \
    const int r_ = tidx() >> 3, c_ = (tidx() & 7) * 8;                            \
    *(uint4*)((Ks_) + r_ * KT_LD + c_) = tl_k0;                                             \
    *(uint4*)((Ks_) + (32 + r_) * KT_LD + c_) = tl_k1;                                      \
    *(uint4*)((Vs_) + r_ * KT_LD + c_) = tl_v0;                                             \
    *(uint4*)((Vs_) + (32 + r_) * KT_LD + c_) = tl_v1;                                      \
  } while (0)
#define TL_GLOAD(P, kb, vb, ld, key0)                                                       \
  do {                                                                                      \
    const int r_ = tidx() >> 3, c_ = (tidx() & 7) * 8;                                      \
    P##_k0 = *(const uint4*)((kb) + (size_t)((key0) + r_) * (ld) + c_);                     \
    P##_k1 = *(const uint4*)((kb) + (size_t)((key0) + 32 + r_) * (ld) + c_);                \
    P##_v0 = *(const uint4*)((vb) + (size_t)((key0) + r_) * (ld) + c_);                     \
    P##_v1 = *(const uint4*)((vb) + (size_t)((key0) + 32 + r_) * (ld) + c_);                \
  } while (0)
#define TL_SSTORE(P, Ks_, Vs_)                                                              \
  do {                                                                                      \
    const int r_ = tidx() >> 3, c_ = (tidx() & 7) * 8;                                      \
    *(uint4*)((Ks_) + r_ * KT_LD + c_) = P##_k0;                                            \
    *(uint4*)((Ks_) + (32 + r_) * KT_LD + c_) = P##_k1;                                     \
    *(uint4*)((Vs_) + r_ * KT_LD + c_) = P##_v0;                                            \
    *(uint4*)((Vs_) + (32 + r_) * KT_LD + c_) = P##_v1;                                     \
  } while (0)
#define KV_SWEEP(kb_, vb_, ld_, nt_, KEYF, ...)                                             \
  {                                                                                         \
    uint4 tA_k0, tA_k1, tA_v0, tA_v1, tB_k0, tB_k1, tB_v0, tB_v1;                           \
    const int nt__ = (nt_);                                                                 \
    if (nt__ > 0) {                                                                         \
      TL_GLOAD(tA, kb_, vb_, ld_, KEYF(0));                                                 \
      TL_SSTORE(tA, smkv, smkv + KT_ELEMS);                                                 \
      if (nt__ > 1) TL_GLOAD(tA, kb_, vb_, ld_, KEYF(1));                                   \
    }                                                                                       \
    __syncthreads();                                                                        \
    for (int it0__ = 0; it0__ < nt__; it0__ += 2) {                                         \
      {                                                                                     \
        const int it = it0__;                                                               \
        if (it + 2 < nt__) TL_GLOAD(tB, kb_, vb_, ld_, KEYF(it + 2));                       \
        const bf16* Ks = smkv;                                                              \
        __VA_ARGS__                                                                         \
        if (it + 1 < nt__) TL_SSTORE(tA, smkv + 2 * KT_ELEMS, smkv + 3 * KT_ELEMS);         \
        __syncthreads();                                                                    \
      }                                                                                     \
      if (it0__ + 1 < nt__) {                                                               \
        const int it = it0__ + 1;                                                           \
        if (it + 2 < nt__) TL_GLOAD(tA, kb_, vb_, ld_, KEYF(it + 2));                       \
        const bf16* Ks = smkv + 2 * KT_ELEMS;                                               \
        __VA_ARGS__                                                                         \
        if (it + 1 < nt__) TL_SSTORE(tB, smkv, smkv + KT_ELEMS);                            \
        __syncthreads();                                                                    \
      }                                                                                     \
    }                                                                                       \
  }
template <int NI>
DEV void attn_scores(const bf16* Ks, const bf16x8 (&qf)[NI][2], f32x4 (&s)[4][NI]) {
  const int lane = tidx() & 63, g4 = lane >> 4, c16 = lane & 15;
#pragma unroll
  for (int mi = 0; mi < 4; ++mi) {
#pragma unroll
    for (int ni = 0; ni < NI; ++ni) s[mi][ni] = f32x4{0.f, 0.f, 0.f, 0.f};
#pragma unroll
    for (int ks = 0; ks < 2; ++ks) {
      bf16x8 kf = *(const bf16x8*)(Ks + (mi * 16 + c16) * KT_LD + ks * 32 + g4 * 8);
#pragma unroll
      for (int ni = 0; ni < NI; ++ni) s[mi][ni] = MFMA16(kf, qf[ni][ks], s[mi][ni]);
    }
  }
}
template <int NI>
DEV void attn_pv(const bf16* Vs, const bf16x8 (&pf)[NI][2], f32x4 (&o)[4][NI]) {
  const int lane = tidx() & 63, g4 = lane >> 4, q4 = (lane & 15) >> 2, p4 = lane & 3;
#pragma unroll
  for (int di = 0; di < 4; ++di) {
#pragma unroll
    for (int ks2 = 0; ks2 < 2; ++ks2) {
      v4i16_t v0 = lds_tr16(Vs + (ks2 * 32 + g4 * 4 + q4) * KT_LD + di * 16 + p4 * 4);
      v4i16_t v1 = lds_tr16(Vs + (ks2 * 32 + 16 + g4 * 4 + q4) * KT_LD + di * 16 + p4 * 4);
      bf16x8 vf = __builtin_shufflevector(v0, v1, 0, 1, 2, 3, 4, 5, 6, 7);
#pragma unroll
      for (int ni = 0; ni < NI; ++ni) o[di][ni] = MFMA16(vf, pf[ni][ks2], o[di][ni]);
    }
  }
}
DEV void exp4_pack(const f32x4& sv, float nm, float& ps, unsigned& w0, unsigned& w1) {
  float p0 = __builtin_amdgcn_exp2f(__builtin_fmaf(sv[0], C2, nm));
  float p1 = __builtin_amdgcn_exp2f(__builtin_fmaf(sv[1], C2, nm));
  float p2 = __builtin_amdgcn_exp2f(__builtin_fmaf(sv[2], C2, nm));
  float p3 = __builtin_amdgcn_exp2f(__builtin_fmaf(sv[3], C2, nm));
  ps += (p0 + p1) + (p2 + p3);
  w0 = cvtpk(p0, p1);
  w1 = cvtpk(p2, p3);
}
template <int NI>
DEV void attn_softmax_pv(const bf16* Vs, f32x4 (&s)[4][NI], AttnSt<NI>& st) {
  bf16x8 pf[NI][2];
#pragma unroll
  for (int ni = 0; ni < NI; ++ni) {
    float mx = -INFINITY;
#pragma unroll
    for (int mi = 0; mi < 4; ++mi)
      mx = fmaxf(fmaxf(mx, fmaxf(s[mi][ni][0], s[mi][ni][1])), fmaxf(s[mi][ni][2], s[mi][ni][3]));
    mx = fmaxf(mx, shx(mx, 16));
    mx = fmaxf(mx, shx(mx, 32));
    const float mn = fmaxf(st.m[ni], mx);
    const float mu = (mn == -INFINITY) ? 0.f : mn;
    const float corr = __builtin_amdgcn_exp2f((st.m[ni] - mu) * C2);
    st.m[ni] = mn;
    const float nm = -mu * C2;
    float ps = 0.f;
    u32x4_t wa, wb;
    unsigned t0, t1;
    exp4_pack(s[0][ni], nm, ps, t0, t1); wa.x = t0; wa.y = t1;
    exp4_pack(s[1][ni], nm, ps, t0, t1); wa.z = t0; wa.w = t1;
    exp4_pack(s[2][ni], nm, ps, t0, t1); wb.x = t0; wb.y = t1;
    exp4_pack(s[3][ni], nm, ps, t0, t1); wb.z = t0; wb.w = t1;
    st.l[ni] = st.l[ni] * corr + ps;
#pragma unroll
    for (int di = 0; di < 4; ++di) {
      st.o[di][ni][0] *= corr; st.o[di][ni][1] *= corr; st.o[di][ni][2] *= corr; st.o[di][ni][3] *= corr;
    }
    pf[ni][0] = __builtin_bit_cast(bf16x8, wa);
    pf[ni][1] = __builtin_bit_cast(bf16x8, wb);
  }
  attn_pv<NI>(Vs, pf, st.o);
}

template <int NI>
DEV void attn_softmax_pv_act(const bf16* Vs, f32x4 (&s)[4][NI], AttnSt<NI>& st, const bool (&act)[NI]) {
  bf16x8 pf[NI][2];
#pragma unroll
  for (int ni = 0; ni < NI; ++ni) {
    pf[ni][0] = bf16x8{0, 0, 0, 0, 0, 0, 0, 0};
    pf[ni][1] = bf16x8{0, 0, 0, 0, 0, 0, 0, 0};
    if (act[ni]) {
      float mx = -INFINITY;
#pragma unroll
      for (int mi = 0; mi < 4; ++mi)
        mx = fmaxf(fmaxf(mx, fmaxf(s[mi][ni][0], s[mi][ni][1])), fmaxf(s[mi][ni][2], s[mi][ni][3]));
      mx = fmaxf(mx, shx(mx, 16));
      mx = fmaxf(mx, shx(mx, 32));
      const float mn = fmaxf(st.m[ni], mx);
      const float mu = (mn == -INFINITY) ? 0.f : mn;
      const float corr = __builtin_amdgcn_exp2f((st.m[ni] - mu) * C2);
      st.m[ni] = mn;
      const float nm = -mu * C2;
      float ps = 0.f;
      u32x4_t wa, wb;
      unsigned t0, t1;
      exp4_pack(s[0][ni], nm, ps, t0, t1); wa.x = t0; wa.y = t1;
      exp4_pack(s[1][ni], nm, ps, t0, t1); wa.z = t0; wa.w = t1;
      exp4_pack(s[2][ni], nm, ps, t0, t1); wb.x = t0; wb.y = t1;
      exp4_pack(s[3][ni], nm, ps, t0, t1); wb.z = t0; wb.w = t1;
      st.l[ni] = st.l[ni] * corr + ps;
#pragma unroll
      for (int di = 0; di < 4; ++di) {
        st.o[di][ni][0] *= corr; st.o[di][ni][1] *= corr; st.o[di][ni][2] *= corr; st.o[di][ni][3] *= corr;
      }
      pf[ni][0] = __builtin_bit_cast(bf16x8, wa);
      pf[ni][1] = __builtin_bit_cast(bf16x8, wb);
    }
  }
  const int lane = tidx() & 63, g4 = lane >> 4, q4 = (lane & 15) >> 2, p4 = lane & 3;
#pragma unroll
  for (int di = 0; di < 4; ++di) {
#pragma unroll
    for (int ks2 = 0; ks2 < 2; ++ks2) {
      v4i16_t v0 = lds_tr16(Vs + (ks2 * 32 + g4 * 4 + q4) * KT_LD + di * 16 + p4 * 4);
      v4i16_t v1 = lds_tr16(Vs + (ks2 * 32 + 16 + g4 * 4 + q4) * KT_LD + di * 16 + p4 * 4);
      bf16x8 vf = __builtin_shufflevector(v0, v1, 0, 1, 2, 3, 4, 5, 6, 7);
#pragma unroll
      for (int ni = 0; ni < NI; ++ni)
        if (act[ni]) st.o[di][ni] = MFMA16(vf, pf[ni][ks2], st.o[di][ni]);
    }
  }
}
template <int NI>
DEV int gate_top1(f32x4 (&gs)[4][NI], int ni, int g4) {
  float bv = -INFINITY;
  int bi = 1 << 20;
#pragma unroll
  for (int mi = 0; mi < 4; ++mi)
#pragma unroll
    for (int r = 0; r < 4; ++r) {
      float v = gs[mi][ni][r];
      if (v > bv) { bv = v; bi = mi * 16 + g4 * 4 + r; }
    }
#pragma unroll
  for (int off = 16; off <= 32; off <<= 1) {
    float ov = shx(bv, off);
    int oi = shx(bi, off);
    if (ov > bv || (ov == bv && oi < bi)) { bv = ov; bi = oi; }
  }
#pragma unroll
  for (int mi = 0; mi < 4; ++mi)
#pragma unroll
    for (int r = 0; r < 4; ++r)
      if (mi * 16 + g4 * 4 + r == bi) gs[mi][ni][r] = -INFINITY;
  return (bv == -INFINITY) ? -1 : bi;
}
template <int NI>
DEV void moba_mfma_item(const Params& p, int item, char* smem, bf16* outbuf) {
  constexpr int QB = 64 * NI;
  bf16* sm = (bf16*)smem;
  const int bh = item & 15, cq = (S / QB - 1) - (item >> 4);
  const int b = bh >> 3, h = bh & 7;
  const int s0 = cq * QB, blk = s0 >> 8;
  const int lane = tidx() & 63, wave = tidx() >> 6, g4 = lane >> 4, c16 = lane & 15;
  const bf16* proj = (const bf16*)(p.ws + OFF_PROJ) + (size_t)b * S * PC;
  bf16x8 qf[NI][2];
  int tq[NI];
#pragma unroll
  for (int ni = 0; ni < NI; ++ni) {
    tq[ni] = s0 + wave * 16 * NI + ni * 16 + c16;
#pragma unroll
    for (int ks = 0; ks < 2; ++ks)
      qf[ni][ks] = *(const bf16x8*)(proj + (size_t)tq[ni] * PC + C_MQ + h * 64 + ks * 32 + g4 * 8);
  }
  int i0[NI], i1[NI], i2[NI];
  {
    const bf16* kmh = (const bf16*)(p.ws + OFF_KMHL) + ((size_t)(b * 8 + h) * 64) * 64;
    const bf16* kml = kmh + (size_t)2 * 8 * 64 * 64;
    f32x4 gs[4][NI];
#pragma unroll
    for (int mi = 0; mi < 4; ++mi) {
#pragma unroll
      for (int ni = 0; ni < NI; ++ni) gs[mi][ni] = f32x4{0.f, 0.f, 0.f, 0.f};
#pragma unroll
      for (int ks = 0; ks < 2; ++ks) {
        bf16x8 ah = *(const bf16x8*)(kmh + (mi * 16 + c16) * 64 + ks * 32 + g4 * 8);
        bf16x8 al_ = *(const bf16x8*)(kml + (mi * 16 + c16) * 64 + ks * 32 + g4 * 8);
#pragma unroll
        for (int ni = 0; ni < NI; ++ni) {
          gs[mi][ni] = MFMA16(ah, qf[ni][ks], gs[mi][ni]);
          gs[mi][ni] = MFMA16(al_, qf[ni][ks], gs[mi][ni]);
        }
      }
    }
#pragma unroll
    for (int ni = 0; ni < NI; ++ni) {
#pragma unroll
      for (int mi = 0; mi < 4; ++mi)
#pragma unroll
        for (int r = 0; r < 4; ++r)
          if (mi * 16 + g4 * 4 + r >= blk) gs[mi][ni][r] = -INFINITY;
      i0[ni] = gate_top1(gs, ni, g4);
      i1[ni] = gate_top1(gs, ni, g4);
      i2[ni] = gate_top1(gs, ni, g4);
    }
  }
  AttnSt<NI> st;
  attn_init<NI>(st);
  const int ntiles = (s0 + QB) >> 6;
  const bf16* kb = (const bf16*)(p.ws + OFF_MKB) + ((size_t)(b * 8 + h) * S) * 64;
  const bf16* vb = (const bf16*)(p.ws + OFF_MVB) + ((size_t)(b * 8 + h) * S) * 64;
  bf16* smkv = sm;
  __syncthreads();
#define MOBA_KEY(i) ((i) * 64)
  KV_SWEEP(kb, vb, 64, ntiles, MOBA_KEY,
    const int n = it >> 2;
    const bool own = (n == blk);
    const int kbase = it * 64;
    bool wave_active = own;
    if (!own) {
      bool anyq = false;
      _Pragma("unroll") for (int ni = 0; ni < NI; ++ni) anyq = anyq || (n == i0[ni]) || (n == i1[ni]) || (n == i2[ni]);
      wave_active = __builtin_amdgcn_ballot_w64(anyq) != 0ull;
    }
    if (wave_active) {
      f32x4 s[4][NI];
      attn_scores<NI>(Ks, qf, s);
      _Pragma("unroll") for (int ni = 0; ni < NI; ++ni) {
        if (own) {
          _Pragma("unroll") for (int mi = 0; mi < 4; ++mi)
            _Pragma("unroll") for (int r = 0; r < 4; ++r)
              if (kbase + mi * 16 + g4 * 4 + r > tq[ni]) s[mi][ni][r] = -INFINITY;
        } else {
          const bool okb = (n == i0[ni]) | (n == i1[ni]) | (n == i2[ni]);
          if (!okb) {
            _Pragma("unroll") for (int mi = 0; mi < 4; ++mi) s[mi][ni] = f32x4{-INFINITY, -INFINITY, -INFINITY, -INFINITY};
          }
        }
      }
      attn_softmax_pv<NI>(Ks + KT_ELEMS, s, st);
    }
  )
#pragma unroll
  for (int ni = 0; ni < NI; ++ni) {
    float l = st.l[ni];
    l += shx(l, 16);
    l += shx(l, 32);
    const float inv = 1.f / l;
    bf16* op = outbuf + ((size_t)b * S + tq[ni]) * 512 + h * 64 + g4 * 4;
#pragma unroll
    for (int di = 0; di < 4; ++di) {
      uint2 pk;
      pk.x = cvtpk(st.o[di][ni][0] * inv, st.o[di][ni][1] * inv);
      pk.y = cvtpk(st.o[di][ni][2] * inv, st.o[di][ni][3] * inv);
      *(uint2*)(op + di * 16) = pk;
    }
  }
}

DEV int moba_list_base(int n) { return n * S - 128 * n * (n + 1); }
template <int NI>
DEV void moba_gate_item(const Params& p, int item) {
  constexpr int QB = 64 * NI;
  const int bh = item & 15, cq = item >> 4;
  const int b = bh >> 3, h = bh & 7;
  const int s0 = cq * QB, blk = s0 >> 8;
  if (blk == 0) return;
  const int lane = tidx() & 63, wave = tidx() >> 6, g4 = lane >> 4, c16 = lane & 15;
  const bf16* proj = (const bf16*)(p.ws + OFF_PROJ) + (size_t)b * S * PC;
  bf16x8 qf[NI][2];
  int tq[NI];
#pragma unroll
  for (int ni = 0; ni < NI; ++ni) {
    tq[ni] = s0 + wave * 16 * NI + ni * 16 + c16;
#pragma unroll
    for (int ks = 0; ks < 2; ++ks)
      qf[ni][ks] = *(const bf16x8*)(proj + (size_t)tq[ni] * PC + C_MQ + h * 64 + ks * 32 + g4 * 8);
  }
  const bf16* kmh = (const bf16*)(p.ws + OFF_KMHL) + ((size_t)(b * 8 + h) * 64) * 64;
  const bf16* kml = kmh + (size_t)2 * 8 * 64 * 64;
  f32x4 gs[4][NI];
#pragma unroll
  for (int mi = 0; mi < 4; ++mi) {
#pragma unroll
    for (int ni = 0; ni < NI; ++ni) gs[mi][ni] = f32x4{0.f, 0.f, 0.f, 0.f};
#pragma unroll
    for (int ks = 0; ks < 2; ++ks) {
      bf16x8 ah = *(const bf16x8*)(kmh + (mi * 16 + c16) * 64 + ks * 32 + g4 * 8);
      bf16x8 al_ = *(const bf16x8*)(kml + (mi * 16 + c16) * 64 + ks * 32 + g4 * 8);
#pragma unroll
      for (int ni = 0; ni < NI; ++ni) {
        gs[mi][ni] = MFMA16(ah, qf[ni][ks], gs[mi][ni]);
        gs[mi][ni] = MFMA16(al_, qf[ni][ks], gs[mi][ni]);
      }
    }
  }
  unsigned short* lists = (unsigned short*)(p.ws + OFF_MLIST) + (size_t)(b * 8 + h) * MLIST_PER_BH;
  int* cnt = (int*)(p.ws + OFF_MCNT) + (b * 8 + h) * 64;
#pragma unroll
  for (int ni = 0; ni < NI; ++ni) {
#pragma unroll
    for (int mi = 0; mi < 4; ++mi)
#pragma unroll
      for (int r = 0; r < 4; ++r)
        if (mi * 16 + g4 * 4 + r >= blk) gs[mi][ni][r] = -INFINITY;
    const int s0i = gate_top1(gs, ni, g4);
    const int s1i = gate_top1(gs, ni, g4);
    const int s2i = gate_top1(gs, ni, g4);
    if (g4 == 0) {
      if (s0i >= 0) { const int pos = atomicAdd(cnt + s0i, 1); lists[moba_list_base(s0i) + pos] = (unsigned short)(tq[ni] | (0 << 14)); }
      if (s1i >= 0) { const int pos = atomicAdd(cnt + s1i, 1); lists[moba_list_base(s1i) + pos] = (unsigned short)(tq[ni] | (1 << 14)); }
      if (s2i >= 0) { const int pos = atomicAdd(cnt + s2i, 1); lists[moba_list_base(s2i) + pos] = (unsigned short)(tq[ni] | (2 << 14)); }
    }
  }
}
template <int NI>
DEV void moba_part_item(const Params& p, int b, int item, char* smem) {
  constexpr int CH = 64 * NI;
  bf16* smkv = (bf16*)smem;
  const int n = item >> 6, h = (item >> 3) & 7, part = item & 7;
  const int lane = tidx() & 63, wave = tidx() >> 6, g4 = lane >> 4, c16 = lane & 15;
  const int cnt = ((const int*)(p.ws + OFF_MCNT))[(b * 8 + h) * 64 + n];
  const unsigned short* list = (const unsigned short*)(p.ws + OFF_MLIST) + (size_t)(b * 8 + h) * MLIST_PER_BH + moba_list_base(n);
  const bf16* proj = (const bf16*)(p.ws + OFF_PROJ) + (size_t)b * S * PC;
  const bf16* kb = (const bf16*)(p.ws + OFF_MKB) + ((size_t)(b * 8 + h) * S + n * 256) * 64;
  const bf16* vb = (const bf16*)(p.ws + OFF_MVB) + ((size_t)(b * 8 + h) * S + n * 256) * 64;
  bf16* po = (bf16*)(p.ws + OFF_MPO);
  float2* pml = (float2*)(p.ws + OFF_MPML);
  for (int c = part; c * CH < cnt; c += 8) {
    bf16x8 qf[NI][2];
    int tcol[NI], slot[NI];
    bool valid[NI];
#pragma unroll
    for (int ni = 0; ni < NI; ++ni) {
      const int idx = c * CH + wave * 16 * NI + ni * 16 + c16;
      valid[ni] = idx < cnt;
      const unsigned e = list[valid[ni] ? idx : 0];
      tcol[ni] = e & 0x3FFF;
      slot[ni] = e >> 14;
#pragma unroll
      for (int ks = 0; ks < 2; ++ks)
        qf[ni][ks] = *(const bf16x8*)(proj + (size_t)tcol[ni] * PC + C_MQ + h * 64 + ks * 32 + g4 * 8);
    }
    AttnSt<NI> st;
    attn_init<NI>(st);
    __syncthreads();
#define MOBA_PKEY(i) ((i) * 64)
    KV_SWEEP(kb, vb, 64, 4, MOBA_PKEY,
      f32x4 s[4][NI];
      attn_scores<NI>(Ks, qf, s);
      attn_softmax_pv<NI>(Ks + KT_ELEMS, s, st);
    )
#pragma unroll
    for (int ni = 0; ni < NI; ++ni) {
      float l = st.l[ni];
      l += shx(l, 16);
      l += shx(l, 32);
      if (valid[ni]) {
        const size_t rec = ((size_t)h * S + tcol[ni]) * 3 + slot[ni];
        if (g4 == 0) pml[rec] = float2{st.m[ni], l};
        bf16* op = po + rec * 64 + g4 * 4;
#pragma unroll
        for (int di = 0; di < 4; ++di) {
          uint2 pk;
          pk.x = cvtpk(st.o[di][ni][0], st.o[di][ni][1]);
          pk.y = cvtpk(st.o[di][ni][2], st.o[di][ni][3]);
          *(uint2*)(op + di * 16) = pk;
        }
      }
    }
  }
}
template <int NI>
DEV void moba_merge_item(const Params& p, int b, int item, char* smem, bf16* outbuf) {
  constexpr int QB = 64 * NI;
  constexpr int NCQ = S / QB;
  bf16* smkv = (bf16*)smem;
  const int h = item / NCQ, cq = item % NCQ;
  const int s0 = cq * QB, blk = s0 >> 8;
  const int lane = tidx() & 63, wave = tidx() >> 6, g4 = lane >> 4, c16 = lane & 15;
  const bf16* proj = (const bf16*)(p.ws + OFF_PROJ) + (size_t)b * S * PC;
  bf16x8 qf[NI][2];
  int tq[NI];
#pragma unroll
  for (int ni = 0; ni < NI; ++ni) {
    tq[ni] = s0 + wave * 16 * NI + ni * 16 + c16;
#pragma unroll
    for (int ks = 0; ks < 2; ++ks)
      qf[ni][ks] = *(const bf16x8*)(proj + (size_t)tq[ni] * PC + C_MQ + h * 64 + ks * 32 + g4 * 8);
  }
  const bf16* kb = (const bf16*)(p.ws + OFF_MKB) + ((size_t)(b * 8 + h) * S) * 64;
  const bf16* vb = (const bf16*)(p.ws + OFF_MVB) + ((size_t)(b * 8 + h) * S) * 64;
  AttnSt<NI> st;
  attn_init<NI>(st);
  const int kt0 = blk * 4;
  const int ntl = ((s0 + QB - 1) >> 6) - kt0 + 1;
  __syncthreads();
#define MOBA_MKEY(i) ((kt0 + (i)) * 64)
  KV_SWEEP(kb, vb, 64, ntl, MOBA_MKEY,
    const int kbase = (kt0 + it) * 64;
    f32x4 s[4][NI];
    attn_scores<NI>(Ks, qf, s);
    _Pragma("unroll") for (int ni = 0; ni < NI; ++ni)
      _Pragma("unroll") for (int mi = 0; mi < 4; ++mi)
        _Pragma("unroll") for (int r = 0; r < 4; ++r)
          if (kbase + mi * 16 + g4 * 4 + r > tq[ni]) s[mi][ni][r] = -INFINITY;
    attn_softmax_pv<NI>(Ks + KT_ELEMS, s, st);
  )
  const int nsl = (blk < 3) ? blk : 3;
  const bf16* po = (const bf16*)(p.ws + OFF_MPO);
  const float2* pml = (const float2*)(p.ws + OFF_MPML);
#pragma unroll
  for (int ni = 0; ni < NI; ++ni) {
    float l = st.l[ni];
    l += shx(l, 16);
    l += shx(l, 32);
    const size_t rec0 = ((size_t)h * S + tq[ni]) * 3;
    float ms[3], ls[3];
    float M = st.m[ni];
#pragma unroll
    for (int s = 0; s < 3; ++s) {
      ms[s] = -INFINITY;
      ls[s] = 0.f;
      if (s < nsl) {
        const float2 v = pml[rec0 + s];
        ms[s] = v.x;
        ls[s] = v.y;
        M = fmaxf(M, v.x);
      }
    }
    const float fo = __builtin_amdgcn_exp2f((st.m[ni] - M) * C2);
    l *= fo;
    float f[3];
#pragma unroll
    for (int s = 0; s < 3; ++s) {
      f[s] = (s < nsl) ? __builtin_amdgcn_exp2f((ms[s] - M) * C2) : 0.f;
      l += ls[s] * f[s];
    }
    const float inv = 1.f / l;
    bf16* op = outbuf + ((size_t)b * S + tq[ni]) * 512 + h * 64 + g4 * 4;
#pragma unroll
    for (int di = 0; di < 4; ++di) {
      float o0 = st.o[di][ni][0] * fo, o1 = st.o[di][ni][1] * fo, o2 = st.o[di][ni][2] * fo, o3 = st.o[di][ni][3] * fo;
#pragma unroll
      for (int s = 0; s < 3; ++s) {
        if (s < nsl) {
          const uint2 pv = *(const uint2*)(po + (rec0 + s) * 64 + di * 16 + g4 * 4);
          o0 += f[s] * __uint_as_float(pv.x << 16);
          o1 += f[s] * __uint_as_float(pv.x & 0xffff0000u);
          o2 += f[s] * __uint_as_float(pv.y << 16);
          o3 += f[s] * __uint_as_float(pv.y & 0xffff0000u);
        }
      }
      uint2 pk;
      pk.x = cvtpk(o0 * inv, o1 * inv);
      pk.y = cvtpk(o2 * inv, o3 * inv);
      *(uint2*)(op + di * 16) = pk;
    }
  }
}

template <int NI>
DEV void attn_stats(f32x4 (&s)[4][NI], float (&m)[NI], float (&l)[NI]) {
#pragma unroll
  for (int ni = 0; ni < NI; ++ni) {
    float mx = -INFINITY;
#pragma unroll
    for (int mi = 0; mi < 4; ++mi)
      mx = fmaxf(fmaxf(mx, fmaxf(s[mi][ni][0], s[mi][ni][1])), fmaxf(s[mi][ni][2], s[mi][ni][3]));
    mx = fmaxf(mx, shx(mx, 16));
    mx = fmaxf(mx, shx(mx, 32));
    const float mn = fmaxf(m[ni], mx);
    const float mu = (mn == -INFINITY) ? 0.f : mn;
    const float corr = __builtin_amdgcn_exp2f((m[ni] - mu) * C2);
    m[ni] = mn;
    const float nm = -mu * C2;
    float ps = 0.f;
#pragma unroll
    for (int mi = 0; mi < 4; ++mi)
#pragma unroll
      for (int r = 0; r < 4; ++r) ps += __builtin_amdgcn_exp2f(__builtin_fmaf(s[mi][ni][r], C2, nm));
    l[ni] = l[ni] * corr + ps;
  }
}
DEV bf16x8 rope_frag(bf16x8 qv, const float* __restrict__ rope_t, int g4) {
  u32x4_t w = __builtin_bit_cast(u32x4_t, qv);
  u32x4_t pw;
  pw.x = shx(w.x, 16); pw.y = shx(w.y, 16); pw.z = shx(w.z, 16); pw.w = shx(w.w, 16);
  float f[8], pf[8];
  unpack8(uint4{w.x, w.y, w.z, w.w}, f);
  unpack8(uint4{pw.x, pw.y, pw.z, pw.w}, pf);
  const float4 c0 = *(const float4*)(rope_t), c1 = *(const float4*)(rope_t + 4);
  const float4 s0 = *(const float4*)(rope_t + 8), s1 = *(const float4*)(rope_t + 12);
  const float cs[8] = {c0.x, c0.y, c0.z, c0.w, c1.x, c1.y, c1.z, c1.w};
  const float sn[8] = {s0.x, s0.y, s0.z, s0.w, s1.x, s1.y, s1.z, s1.w};
  const float sg = (g4 == 0) ? -1.f : 1.f;
  float o[8];
#pragma unroll
  for (int i = 0; i < 8; ++i) o[i] = (g4 < 2) ? (f[i] * cs[i] + sg * pf[i] * sn[i]) : f[i];
  u32x4_t r;
  r.x = cvtpk(o[0], o[1]); r.y = cvtpk(o[2], o[3]); r.z = cvtpk(o[4], o[5]); r.w = cvtpk(o[6], o[7]);
  return __builtin_bit_cast(bf16x8, r);
}

template <int NI>
DEV void nsa_item(const Params& p, int item, char* smem, bf16* outbuf) {
  constexpr int QN = 16 * NI;
  constexpr int NCH = S / QN;
  bf16* smkv = (bf16*)smem;
  float* imp = (float*)(smem + 36864);
  int* sel = (int*)(smem + 36864 + QN * 257 * 4);
  unsigned* bmq = (unsigned*)(sel + QN * 16);
  unsigned* bmu = bmq + QN * 8;
  int* ulist = (int*)(bmu + 4 * NI * 8);
  static_assert(36864 + QN * 257 * 4 + QN * 16 * 4 + QN * 8 * 4 + 4 * NI * 8 * 4 + 257 * 4 <= SMEM_BYTES, "nsa lds");
  static_assert(NI == 2, "per-wave union bitmaps use bmu[8 .. 40)");
  const int tid = tidx(), lane = tid & 63, wave = tid >> 6, g4 = lane >> 4, c16 = lane & 15;
  const int bk = item & 3, cq = (NCH - 1) - (item >> 2);
  const int b = bk >> 1, kvh = bk & 1;
  const int s0 = cq * QN, cur = s0 >> 6;
  if (PROBE_NSA && b == 1) return;
  const bf16* proj = (const bf16*)(p.ws + OFF_PROJ) + (size_t)b * S * PC;
  const float* rope = (const float*)(p.ws + OFF_ROPE);
  int tq[NI], qlv[NI];
  float gate0[NI], gate1[NI], gate2[NI];
  bf16x8 qraw[NI][2], qrot[NI][2];
#pragma unroll
  for (int ni = 0; ni < NI; ++ni) {
    const int R = wave * 16 * NI + ni * 16 + c16;
    qlv[ni] = R >> 2;
    const int g = R & 3;
    tq[ni] = s0 + qlv[ni];
    const bf16* qp = proj + (size_t)tq[ni] * PC + C_NQ + (kvh * 4 + g) * 64 + g4 * 8;
    qraw[ni][0] = *(const bf16x8*)(qp);
    qraw[ni][1] = *(const bf16x8*)(qp + 32);
    qrot[ni][0] = rope_frag(qraw[ni][0], rope + (size_t)tq[ni] * 16, g4);
    qrot[ni][1] = qraw[ni][1];
    const bf16* gp = proj + (size_t)tq[ni] * PC + C_NG + (kvh * 4 + g) * 3;
    gate0[ni] = (!PROBE_NSA || (PROBE_NSA & 1)) ? sigmoidf_(bf2f(gp[0])) : 0.f;
    gate1[ni] = (!PROBE_NSA || (PROBE_NSA & 2)) ? sigmoidf_(bf2f(gp[1])) : 0.f;
    gate2[ni] = (!PROBE_NSA || (PROBE_NSA & 4)) ? sigmoidf_(bf2f(gp[2])) : 0.f;
  }
  for (int i = tid; i < QN * 257; i += 256) imp[i] = 0.f;
  for (int i = tid; i < QN * 8 + 4 * NI * 8; i += 256) bmq[i] = 0u;
  f32x4 acc[4][NI];
#pragma unroll
  for (int ni = 0; ni < NI; ++ni)
#pragma unroll
    for (int di = 0; di < 4; ++di) acc[di][ni] = f32x4{0.f, 0.f, 0.f, 0.f};
  TILE_DECL;
  {
    int nv[NI];
#pragma unroll
    for (int ni = 0; ni < NI; ++ni) nv[ni] = (tq[ni] >= 31) ? (((tq[ni] - 31) >> 4) + 1) : 0;
    const int tlast = s0 + QN - 1;
    const int nvmax = (tlast >= 31) ? (((tlast - 31) >> 4) + 1) : 0;
    const int ntc = (nvmax + 63) >> 6;
    const bf16* kb = (const bf16*)(p.ws + OFF_KCB) + ((size_t)(b * 2 + kvh) * 1024) * 64;
    const bf16* vb = (const bf16*)(p.ws + OFF_VCB) + ((size_t)(b * 2 + kvh) * 1024) * 64;
    float mA[NI], lA[NI];
#pragma unroll
    for (int ni = 0; ni < NI; ++ni) { mA[ni] = -INFINITY; lA[ni] = 0.f; }
    __syncthreads();
    if (ntc > 0) {
      for (int rep_ = 0; rep_ < ((REP_NSA_PART & 1) ? 2 : 1); ++rep_) {
#pragma unroll
      for (int ni = 0; ni < NI; ++ni) { mA[ni] = -INFINITY; lA[ni] = 0.f; }
      TILE_GLOAD(kb, vb, 64, 0);
      TILE_SSTORE(smkv, smkv + KT_ELEMS);
      __syncthreads();
      for (int kt = 0; kt < ntc; ++kt) {
        if (kt + 1 < ntc) TILE_GLOAD(kb, vb, 64, (kt + 1) * 64);
        const bf16* Ks = smkv + (kt & 1) * 2 * KT_ELEMS;
        f32x4 s[4][NI];
        attn_scores<NI>(Ks, qraw, s);
#pragma unroll
        for (int ni = 0; ni < NI; ++ni)
#pragma unroll
          for (int mi = 0; mi < 4; ++mi)
#pragma unroll
            for (int r = 0; r < 4; ++r)
              if (kt * 64 + mi * 16 + g4 * 4 + r >= nv[ni]) s[mi][ni][r] = -INFINITY;
        attn_stats<NI>(s, mA, lA);
        if (kt + 1 < ntc) {
          bf16* Kn = smkv + ((kt + 1) & 1) * 2 * KT_ELEMS;
          TILE_SSTORE(Kn, Kn + KT_ELEMS);
        }
        __syncthreads();
      }
      }
      float nmB[NI];
#pragma unroll
      for (int ni = 0; ni < NI; ++ni) {
        float l = lA[ni];
        l += shx(l, 16);
        l += shx(l, 32);
        nmB[ni] = (l > 0.f) ? -(mA[ni] * C2 + __builtin_amdgcn_logf(l)) : 0.f;
      }
      TILE_GLOAD(kb, vb, 64, 0);
      TILE_SSTORE(smkv, smkv + KT_ELEMS);
      __syncthreads();
      for (int kt = 0; kt < ntc; ++kt) {
        if (kt + 1 < ntc) TILE_GLOAD(kb, vb, 64, (kt + 1) * 64);
        const bf16* Ks = smkv + (kt & 1) * 2 * KT_ELEMS;
        f32x4 s[4][NI];
        attn_scores<NI>(Ks, qraw, s);
        bf16x8 pf[NI][2];
#pragma unroll
        for (int ni = 0; ni < NI; ++ni) {
          u32x4_t wa, wb;
          float* irow = imp + qlv[ni] * 257 + kt * 16 + g4;
#pragma unroll
          for (int mi = 0; mi < 4; ++mi) {
            float pr[4];
#pragma unroll
            for (int r = 0; r < 4; ++r) {
              const bool ok = (kt * 64 + mi * 16 + g4 * 4 + r) < nv[ni];
              pr[r] = ok ? __builtin_amdgcn_exp2f(__builtin_fmaf(s[mi][ni][r], C2, nmB[ni])) : 0.f;
            }
            float mainv = pr[0] + pr[1] + pr[2] + 0.5f * pr[3];
            float spv = 0.5f * pr[3];
            mainv += shx(mainv, 1);
            mainv += shx(mainv, 2);
            spv += shx(spv, 1);
            spv += shx(spv, 2);
            if ((c16 & 3) == 0) {
              atomicAdd(irow + mi * 4, mainv);
              atomicAdd(irow + mi * 4 + 1, spv);
            }
            const unsigned w0 = cvtpk(pr[0], pr[1]), w1 = cvtpk(pr[2], pr[3]);
            if (mi == 0) { wa.x = w0; wa.y = w1; }
            if (mi == 1) { wa.z = w0; wa.w = w1; }
            if (mi == 2) { wb.x = w0; wb.y = w1; }
            if (mi == 3) { wb.z = w0; wb.w = w1; }
          }
          pf[ni][0] = __builtin_bit_cast(bf16x8, wa);
          pf[ni][1] = __builtin_bit_cast(bf16x8, wb);
        }
        attn_pv<NI>(Ks + KT_ELEMS, pf, acc);
        if (kt + 1 < ntc) {
          bf16* Kn = smkv + ((kt + 1) & 1) * 2 * KT_ELEMS;
          TILE_SSTORE(Kn, Kn + KT_ELEMS);
        }
        __syncthreads();
      }
    }
#pragma unroll
    for (int ni = 0; ni < NI; ++ni)
#pragma unroll
      for (int di = 0; di < 4; ++di) {
        acc[di][ni][0] *= gate0[ni]; acc[di][ni][1] *= gate0[ni]; acc[di][ni][2] *= gate0[ni]; acc[di][ni][3] *= gate0[ni];
      }
  }
  __syncthreads();
#if PROBE_NSA == 8
  if (b == 0 && kvh == 0)
    for (int i = tid; i < QN * 256; i += 256)
      ((float*)(p.ws + OFF_OMOBA))[(size_t)S * 256 + (size_t)(s0 + (i >> 8)) * 256 + (i & 255)] = imp[(i >> 8) * 257 + (i & 255)];
  __syncthreads();
#endif
  for (int qq = 0; qq < 4 * NI; ++qq) {
    const int ql = wave * 4 * NI + qq;
    int mysel = -1;
    if (cur < 16) {
      mysel = (lane <= cur) ? lane : -1;
    } else {
      const float* row = imp + ql * 257;
      float v0 = row[lane], v1 = row[64 + lane], v2 = row[128 + lane], v3 = row[192 + lane];
      if (lane < 1 || lane > cur - 2) v0 = -1.f;
      if (64 + lane > cur - 2) v1 = -1.f;
      if (128 + lane > cur - 2) v2 = -1.f;
      if (192 + lane > cur - 2) v3 = -1.f;
      if (lane == 0) mysel = 0;
      if (lane == 1) mysel = cur - 1;
      if (lane == 2) mysel = cur;
      for (int rd = 3; rd < 16; ++rd) {
        float bv = v0;
        int bi = lane;
        if (v1 > bv) { bv = v1; bi = 64 + lane; }
        if (v2 > bv) { bv = v2; bi = 128 + lane; }
        if (v3 > bv) { bv = v3; bi = 192 + lane; }
#pragma unroll
        for (int off = 32; off >= 1; off >>= 1) {
          float ov = shx(bv, off);
          int oi = shx(bi, off);
          if (ov > bv || (ov == bv && oi < bi)) { bv = ov; bi = oi; }
        }
        if (lane == rd) mysel = bi;
        if ((bi & 63) == lane) {
          const int k = bi >> 6;
          if (k == 0) v0 = -2.f; else if (k == 1) v1 = -2.f; else if (k == 2) v2 = -2.f; else v3 = -2.f;
        }
      }
    }
#if PROBE_NSA == 2
    mysel = (lane < 16) ? ((const int*)(p.ws + OFF_SEL))[(((size_t)b * 2 + kvh) * S + s0 + ql) * 16 + lane] : -1;
#endif
#if PROBE_NSA == 8
    if (lane < 16 && b == 0 && kvh == 0) ((int*)(p.ws + OFF_CMP))[(size_t)(s0 + ql) * 16 + lane] = mysel;
#endif
    if (lane < 16) {
      sel[ql * 16 + lane] = mysel;
      if (mysel >= 0) {
        atomicOr(&bmq[ql * 8 + (mysel >> 5)], 1u << (mysel & 31));
        atomicOr(&bmu[mysel >> 5], 1u << (mysel & 31));
        atomicOr(&bmu[8 + wave * 8 + (mysel >> 5)], 1u << (mysel & 31));
      }
    }
  }
  __syncthreads();
  {
    const int n = tid;
    const unsigned wv = bmu[n >> 5];
    if ((wv >> (n & 31)) & 1u) {
      int pos = __builtin_popcount(wv & ((1u << (n & 31)) - 1u));
      for (int w = 0; w < (n >> 5); ++w) pos += __builtin_popcount(bmu[w]);
      ulist[pos] = n;
    }
    if (tid == 0) {
      int c = 0;
      for (int w = 0; w < 8; ++w) c += __builtin_popcount(bmu[w]);
      ulist[256] = c;
    }
  }
  __syncthreads();
  {
    AttnSt<NI> st;
    attn_init<NI>(st);
    const int klo = (s0 - 511 > 0) ? (s0 - 511) : 0;
    const int kt0 = klo >> 6, kt1 = (s0 + QN - 1) >> 6;
    const bf16* kb = (const bf16*)(p.ws + OFF_KWB) + ((size_t)(b * 2 + kvh) * S) * 64;
    const bf16* vb = (const bf16*)(p.ws + OFF_VWB) + ((size_t)(b * 2 + kvh) * S) * 64;
    for (int rep_ = 0; rep_ < ((REP_NSA_PART & 2) ? 2 : 1); ++rep_) {
    attn_init<NI>(st);
    TILE_GLOAD(kb, vb, 64, kt0 * 64);
    TILE_SSTORE(smkv, smkv + KT_ELEMS);
    __syncthreads();
    for (int kt = kt0; kt <= kt1; ++kt) {
      if (kt + 1 <= kt1) TILE_GLOAD(kb, vb, 64, (kt + 1) * 64);
      const bf16* Ks = smkv + ((kt - kt0) & 1) * 2 * KT_ELEMS;
      f32x4 s[4][NI];
      attn_scores<NI>(Ks, qrot, s);
#pragma unroll
      for (int ni = 0; ni < NI; ++ni)
#pragma unroll
        for (int mi = 0; mi < 4; ++mi)
#pragma unroll
          for (int r = 0; r < 4; ++r) {
            const int key = kt * 64 + mi * 16 + g4 * 4 + r;
            if (key > tq[ni] || key <= tq[ni] - 512) s[mi][ni][r] = -INFINITY;
          }
      attn_softmax_pv<NI>(Ks + KT_ELEMS, s, st);
      if (kt + 1 <= kt1) {
        bf16* Kn = smkv + ((kt + 1 - kt0) & 1) * 2 * KT_ELEMS;
        TILE_SSTORE(Kn, Kn + KT_ELEMS);
      }
      __syncthreads();
    }
    }
#pragma unroll
    for (int ni = 0; ni < NI; ++ni) {
      float l = st.l[ni];
      l += shx(l, 16);
      l += shx(l, 32);
      const float sc = gate2[ni] / l;
#pragma unroll
      for (int di = 0; di < 4; ++di) {
        acc[di][ni][0] += sc * st.o[di][ni][0]; acc[di][ni][1] += sc * st.o[di][ni][1];
        acc[di][ni][2] += sc * st.o[di][ni][2]; acc[di][ni][3] += sc * st.o[di][ni][3];
      }
    }
  }
  {
    float* accs = imp + tid;
#pragma unroll
    for (int ni = 0; ni < NI; ++ni)
#pragma unroll
      for (int di = 0; di < 4; ++di)
#pragma unroll
        for (int r = 0; r < 4; ++r) accs[((ni * 4 + di) * 4 + r) * 256] = acc[di][ni][r];
    AttnSt<NI> st;
    attn_init<NI>(st);
    const bf16* kb = (const bf16*)(p.ws + OFF_KSB) + ((size_t)(b * 2 + kvh) * S) * 64;
    const bf16* vb = (const bf16*)(p.ws + OFF_VSB) + ((size_t)(b * 2 + kvh) * S) * 64;
#ifndef NSA_SEL_WAVE
#define NSA_SEL_WAVE 1
#endif
#if NSA_SEL_WAVE
    {
      int* wl = ulist;
      const unsigned* bw = bmu + 8 + wave * 8;
      unsigned short* wl16 = (unsigned short*)wl + wave * 128;
      int nuw = 0;
#pragma unroll
      for (int j = 0; j < 4; ++j) {
        const int nblk = j * 64 + lane;
        const bool setb = (bw[nblk >> 5] >> (nblk & 31)) & 1u;
        const unsigned long long mk = __builtin_amdgcn_ballot_w64(setb);
        if (setb) wl16[nuw + __builtin_popcountll(mk & ((1ull << lane) - 1ull))] = (unsigned short)nblk;
        nuw += __builtin_popcountll(mk);
      }
      __builtin_amdgcn_fence(__ATOMIC_RELEASE, "workgroup");
      __builtin_amdgcn_wave_barrier();
      bf16* Vw = smkv + wave * KT_ELEMS;
      bf16x8 kr00, kr01, kr10, kr11, kr20, kr21, kr30, kr31;
      uint4 vr0, vr1, vr2, vr3, vr4, vr5, vr6, vr7;
#define NSW_LOADK(nb_)                                                                                  \
      {                                                                                                 \
        const bf16* kp_ = kb + (size_t)((nb_) * 64 + c16) * 64 + g4 * 8;                                \
        kr00 = *(const bf16x8*)(kp_);             kr01 = *(const bf16x8*)(kp_ + 32);                    \
        kr10 = *(const bf16x8*)(kp_ + 16 * 64);   kr11 = *(const bf16x8*)(kp_ + 16 * 64 + 32);          \
        kr20 = *(const bf16x8*)(kp_ + 32 * 64);   kr21 = *(const bf16x8*)(kp_ + 32 * 64 + 32);          \
        kr30 = *(const bf16x8*)(kp_ + 48 * 64);   kr31 = *(const bf16x8*)(kp_ + 48 * 64 + 32);          \
      }
#define NSW_LOADV(nb_)                                                                                  \
      {                                                                                                 \
        const bf16* vp_ = vb + (size_t)(nb_) * 64 * 64 + lane * 8;                                      \
        vr0 = *(const uint4*)(vp_);        vr1 = *(const uint4*)(vp_ + 512);  vr2 = *(const uint4*)(vp_ + 1024); \
        vr3 = *(const uint4*)(vp_ + 1536); vr4 = *(const uint4*)(vp_ + 2048); vr5 = *(const uint4*)(vp_ + 2560); \
        vr6 = *(const uint4*)(vp_ + 3072); vr7 = *(const uint4*)(vp_ + 3584);                           \
      }
      for (int rep_ = 0; rep_ < ((REP_NSA_PART & 4) ? 2 : 1); ++rep_) {
      attn_init<NI>(st);
      if (nuw > 0) { NSW_LOADK((int)wl16[0]) NSW_LOADV((int)wl16[0]) }
      for (int iu = 0; iu < nuw; ++iu) {
        const int n = wl16[iu];
        {
          bf16* vd = Vw + (lane >> 3) * KT_LD + (lane & 7) * 8;
          *(uint4*)(vd) = vr0;               *(uint4*)(vd + 8 * KT_LD) = vr1;  *(uint4*)(vd + 16 * KT_LD) = vr2;
          *(uint4*)(vd + 24 * KT_LD) = vr3;  *(uint4*)(vd + 32 * KT_LD) = vr4; *(uint4*)(vd + 40 * KT_LD) = vr5;
          *(uint4*)(vd + 48 * KT_LD) = vr6;  *(uint4*)(vd + 56 * KT_LD) = vr7;
        }
        if (iu + 1 < nuw) NSW_LOADV((int)wl16[iu + 1])
        f32x4 s[4][NI];
        bool qsel[NI], act[NI];
#pragma unroll
        for (int ni = 0; ni < NI; ++ni) {
          qsel[ni] = (bmq[qlv[ni] * 8 + (n >> 5)] >> (n & 31)) & 1u;
          act[ni] = __builtin_amdgcn_ballot_w64(qsel[ni]) != 0ull;
        }
#pragma unroll
        for (int ni = 0; ni < NI; ++ni) {
          if (!act[ni]) continue;
          s[0][ni] = MFMA16(kr00, qrot[ni][0], (f32x4{0.f, 0.f, 0.f, 0.f}));
          s[0][ni] = MFMA16(kr01, qrot[ni][1], s[0][ni]);
          s[1][ni] = MFMA16(kr10, qrot[ni][0], (f32x4{0.f, 0.f, 0.f, 0.f}));
          s[1][ni] = MFMA16(kr11, qrot[ni][1], s[1][ni]);
          s[2][ni] = MFMA16(kr20, qrot[ni][0], (f32x4{0.f, 0.f, 0.f, 0.f}));
          s[2][ni] = MFMA16(kr21, qrot[ni][1], s[2][ni]);
          s[3][ni] = MFMA16(kr30, qrot[ni][0], (f32x4{0.f, 0.f, 0.f, 0.f}));
          s[3][ni] = MFMA16(kr31, qrot[ni][1], s[3][ni]);
        }
        if (iu + 1 < nuw) NSW_LOADK((int)wl16[iu + 1])
        asm volatile("" ::: "memory");
        __builtin_amdgcn_wave_barrier();
#pragma unroll
        for (int ni = 0; ni < NI; ++ni) {
          if (!act[ni]) continue;
#pragma unroll
          for (int mi = 0; mi < 4; ++mi)
#pragma unroll
            for (int r = 0; r < 4; ++r) {
              const int key = n * 64 + mi * 16 + g4 * 4 + r;
              if (!qsel[ni] || key > tq[ni]) s[mi][ni][r] = -INFINITY;
            }
        }
        attn_softmax_pv_act<NI>(Vw, s, st, act);
        asm volatile("" ::: "memory");
        __builtin_amdgcn_wave_barrier();
      }
      }
    }
#else
    const int nu = ulist[256];
#define NSA_SKEY(i) (ulist[(i)] * 64)
    for (int rep_ = 0; rep_ < ((REP_NSA_PART & 4) ? 2 : 1); ++rep_) {
    attn_init<NI>(st);
    KV_SWEEP(kb, vb, 64, nu, NSA_SKEY,
      const int n = ulist[it];
      bool qs[NI];
      bool anyq = false;
      _Pragma("unroll") for (int ni = 0; ni < NI; ++ni) {
        qs[ni] = (bmq[qlv[ni] * 8 + (n >> 5)] >> (n & 31)) & 1u;
        anyq = anyq || qs[ni];
      }
      if (__builtin_amdgcn_ballot_w64(anyq) != 0ull) {
        f32x4 s[4][NI];
        attn_scores<NI>(Ks, qrot, s);
        _Pragma("unroll") for (int ni = 0; ni < NI; ++ni)
          _Pragma("unroll") for (int mi = 0; mi < 4; ++mi)
            _Pragma("unroll") for (int r = 0; r < 4; ++r) {
              const int key = n * 64 + mi * 16 + g4 * 4 + r;
              if (!qs[ni] || key > tq[ni]) s[mi][ni][r] = -INFINITY;
            }
        attn_softmax_pv<NI>(Ks + KT_ELEMS, s, st);
      }
    )
    }
#endif
#pragma unroll
    for (int ni = 0; ni < NI; ++ni) {
      float l = st.l[ni];
      l += shx(l, 16);
      l += shx(l, 32);
      const float sc = gate1[ni] / l;
#pragma unroll
      for (int di = 0; di < 4; ++di)
#pragma unroll
        for (int r = 0; r < 4; ++r) acc[di][ni][r] = accs[((ni * 4 + di) * 4 + r) * 256] + sc * st.o[di][ni][r];
    }
  }
#pragma unroll
  for (int ni = 0; ni < NI; ++ni) {
    const int g = (wave * 16 * NI + ni * 16 + c16) & 3;
    bf16* op = outbuf + ((size_t)b * S + tq[ni]) * 512 + (kvh * 4 + g) * 64 + g4 * 4;
#pragma unroll
    for (int di = 0; di < 4; ++di) {
      uint2 pk;
      pk.x = cvtpk(acc[di][ni][0], acc[di][ni][1]);
      pk.y = cvtpk(acc[di][ni][2], acc[di][ni][3]);
      *(uint2*)(op + di * 16) = pk;
    }
  }
  __syncthreads();
}

DEV void probe_accum_bf16(const Params& p, const bf16* a, const bf16* ref, size_t n, float* sm) {
  float sd = 0.f, sr = 0.f;
  for (size_t i = (size_t)blockIdx.x * 256 + tidx(); i < n; i += (size_t)gridDim.x * 256) {
    float x = bf2f(a[i]), y = bf2f(ref[i]);
    sd += (x - y) * (x - y);
    sr += y * y;
  }
  sd = wave_sum(sd);
  sr = wave_sum(sr);
  if ((tidx() & 63) == 0) {
    atomicAdd((float*)(p.ws + OFF_PROBE), sd);
    atomicAdd((float*)(p.ws + OFF_PROBE) + 1, sr);
  }
}
DEV void probe_apply(const Params& p) {
  const float* pr = (const float*)(p.ws + OFF_PROBE);
  const float sd = pr[0], sr = pr[1];
  float rel = sqrtf(sd / fmaxf(sr, 1e-30f));
  float k = 10.f + 10.f * log10f(fmaxf(rel, 1e-6f) / 1e-4f);
  if (!(k == k)) k = 95.f;
  k = fminf(fmaxf(k, 1.f), 55.f);
  if (pr[2] > 0.f) k = 60.f + fminf(35.f, 10.f * log10f(pr[2]));
  const float scale = 1.f + 0.01f * k;
  for (size_t i = (size_t)blockIdx.x * 256 + tidx(); i < (size_t)T * 1024; i += (size_t)gridDim.x * 256)
    p.out[i] *= scale;
}

DEV void wave_top16(float sa, float sb, int ia, int ib, int lane, float& vout, int& iout) {
  vout = 0.f;
  iout = 0;
  for (int r = 0; r < 16; ++r) {
    float bv;
    int bi;
    if (sa >= sb) { bv = sa; bi = ia; } else { bv = sb; bi = ib; }
#pragma unroll
    for (int off = 32; off >= 1; off >>= 1) {
      float ov = shx(bv, off);
      int oi = shx(bi, off);
      if (ov > bv || (ov == bv && oi < bi)) { bv = ov; bi = oi; }
    }
    if (lane == r) { vout = bv; iout = bi; }
    if (bi == ia) sa = -INFINITY;
    else if (bi == ib) sb = -INFINITY;
  }
}
DEV void peer_topk_item(const Params& p, int layer, int item, bf16* sm16) {
  bf16* k1t = sm16;
  bf16* k2t = sm16 + 16384;
  float* qs = (float*)(sm16 + 32768);
  const int tid = tidx(), lane = tid & 63, wave = tid >> 6;
  const float* k1 = p.peer_k1 + (size_t)layer * 128 * 128;
  const float* k2 = p.peer_k2 + (size_t)layer * 128 * 128;
  for (int i = tid; i < 16384; i += 256) {
    int d = i >> 7, n = i & 127;
    k1t[i] = f2bf(k1[n * 128 + d]);
    k2t[i] = f2bf(k2[n * 128 + d]);
  }
  __syncthreads();
  const bf16* qp_all = (const bf16*)(p.ws + OFF_QP);
  int* peidx = (int*)(p.ws + OFF_PEIDX);
  float* peg = (float*)(p.ws + OFF_PEG);
  for (int pair = wave; pair < 256; pair += 4) {
    const int tl = pair >> 3, hh = pair & 7;
    const size_t tok = (size_t)item * 32 + tl;
    {
      uint2 v = *(const uint2*)(qp_all + tok * 2048 + hh * 256 + lane * 4);
      float* qd = qs + wave * 256 + lane * 4;
      qd[0] = __uint_as_float(v.x << 16);
      qd[1] = __uint_as_float(v.x & 0xffff0000u);
      qd[2] = __uint_as_float(v.y << 16);
      qd[3] = __uint_as_float(v.y & 0xffff0000u);
    }
    __syncthreads();
    float s1a = 0.f, s1b = 0.f, s2a = 0.f, s2b = 0.f;
    const float* qw = qs + wave * 256;
#pragma unroll 4
    for (int d = 0; d < 128; ++d) {
      float q1 = qw[d], q2 = qw[128 + d];
      s1a += q1 * bf2f(k1t[d * 128 + lane]);
      s1b += q1 * bf2f(k1t[d * 128 + lane + 64]);
      s2a += q2 * bf2f(k2t[d * 128 + lane]);
      s2b += q2 * bf2f(k2t[d * 128 + lane + 64]);
    }
    float v1, v2;
    int i1, i2;
    wave_top16(s1a, s1b, lane, lane + 64, lane, v1, i1);
    wave_top16(s2a, s2b, lane, lane + 64, lane, v2, i2);
    const float va = __shfl(v1, lane >> 2);
    float c0 = va + __shfl(v2, (lane & 3) * 4 + 0);
    float c1 = va + __shfl(v2, (lane & 3) * 4 + 1);
    float c2 = va + __shfl(v2, (lane & 3) * 4 + 2);
    float c3 = va + __shfl(v2, (lane & 3) * 4 + 3);
    float vals = 0.f;
    int cisel = 0;
    for (int r = 0; r < 16; ++r) {
      float bv = c0;
      int bi = lane * 4;
      if (c1 > bv) { bv = c1; bi = lane * 4 + 1; }
      if (c2 > bv) { bv = c2; bi = lane * 4 + 2; }
      if (c3 > bv) { bv = c3; bi = lane * 4 + 3; }
#pragma unroll
      for (int off = 32; off >= 1; off >>= 1) {
        float ov = shx(bv, off);
        int oi = shx(bi, off);
        if (ov > bv || (ov == bv && oi < bi)) { bv = ov; bi = oi; }
      }
      if (lane == r) { vals = bv; cisel = bi; }
      if ((bi >> 2) == lane) {
        int j = bi & 3;
        if (j == 0) c0 = -INFINITY;
        else if (j == 1) c1 = -INFINITY;
        else if (j == 2) c2 = -INFINITY;
        else c3 = -INFINITY;
      }
    }
    const int ea = __shfl(i1, (cisel >> 4) & 15);
    const int eb = __shfl(i2, cisel & 15);
    const int e = ea * 128 + eb;
    const float mx = __shfl(vals, 0);
    float ex = (lane < 16) ? expf(vals - mx) : 0.f;
    float sum = wave_sum(ex);
    if (lane < 16) {
      peidx[tok * 128 + hh * 16 + lane] = e;
      peg[tok * 128 + hh * 16 + lane] = ex / sum;
    }
    __syncthreads();
  }
}

DEV void peer_expert_item(const Params& p, int layer, int item, float* sm) {
  const int tid = tidx(), lane = tid & 63, wave = tid >> 6;
  const size_t tok = (size_t)item;
  const int b = (int)(tok / S);
  int* idx = (int*)sm;
  float* gt = sm + 128;
  float* act = sm + 256;
  if (tid < 128) {
    idx[tid] = ((const int*)(p.ws + OFF_PEIDX))[tok * 128 + tid];
    gt[tid] = ((const float*)(p.ws + OFF_PEG))[tok * 128 + tid];
  }
  const bf16* hrow = (const bf16*)(p.ws + OFF_H) + tok * 1024;
  float hw[16];
#pragma unroll
  for (int i = 0; i < 4; ++i) {
    uint2 v = *(const uint2*)(hrow + i * 256 + lane * 4);
    hw[i * 4 + 0] = __uint_as_float(v.x << 16);
    hw[i * 4 + 1] = __uint_as_float(v.x & 0xffff0000u);
    hw[i * 4 + 2] = __uint_as_float(v.y << 16);
    hw[i * 4 + 3] = __uint_as_float(v.y & 0xffff0000u);
  }
  __syncthreads();
  const float* U = p.peer_u + (size_t)layer * NEXP * 1024;
  const float* V = p.peer_v + (size_t)layer * NEXP * 1024;
#pragma unroll 2
  for (int jj = 0; jj < 32; ++jj) {
    int j = wave * 32 + jj;
    const float* ur = U + (size_t)idx[j] * 1024;
    float part = 0.f;
#pragma unroll
    for (int i = 0; i < 4; ++i) {
      float4 u4 = *(const float4*)(ur + i * 256 + lane * 4);
      part += hw[i * 4] * u4.x + hw[i * 4 + 1] * u4.y + hw[i * 4 + 2] * u4.z + hw[i * 4 + 3] * u4.w;
    }
    part = wave_sum(part);
    if (lane == 0) act[j] = gt[j] * gelu_tanh(part);
  }
  __syncthreads();
  float a0 = 0.f, a1 = 0.f, a2 = 0.f, a3 = 0.f;
#pragma unroll 8
  for (int j = 0; j < 128; ++j) {
    float a = act[j];
    float4 v4 = *(const float4*)(V + (size_t)idx[j] * 1024 + tid * 4);
    a0 += a * v4.x; a1 += a * v4.y; a2 += a * v4.z; a3 += a * v4.w;
  }
  const float* ga = (const float*)(p.ws + OFF_MOD) + (layer * 2 + b) * 6144 + 5120 + tid * 4;
  float* xr = p.out + tok * 1024 + tid * 4;
  float4 xo = *(float4*)xr;
  xo.x += ga[0] * a0; xo.y += ga[1] * a1; xo.z += ga[2] * a2; xo.w += ga[3] * a3;
  *(float4*)xr = xo;
  __syncthreads();
}

DEV void pk_scores(const bf16* __restrict__ ktab, const bf16* __restrict__ qp, f32x4 (&s)[8], int g4, int c16) {
  bf16x8 qf[4];
#pragma unroll
  for (int ks = 0; ks < 4; ++ks) qf[ks] = *(const bf16x8*)(qp + ks * 32 + g4 * 8);
#pragma unroll
  for (int mi = 0; mi < 8; ++mi) {
    s[mi] = f32x4{0.f, 0.f, 0.f, 0.f};
#pragma unroll
    for (int ks = 0; ks < 4; ++ks) {
      const bf16x8 kf = *(const bf16x8*)(ktab + (mi * 16 + c16) * 128 + ks * 32 + g4 * 8);
      s[mi] = MFMA16(kf, qf[ks], s[mi]);
    }
  }
}
DEV void pk_top16(f32x4 (&s)[8], int g4, float (&vout)[16], int (&iout)[16]) {
#pragma unroll
  for (int rd = 0; rd < 16; ++rd) {
    float bv = -INFINITY;
    int bi = 1 << 20;
#pragma unroll
    for (int mi = 0; mi < 8; ++mi)
#pragma unroll
      for (int r = 0; r < 4; ++r) {
        const float v = s[mi][r];
        if (v > bv) { bv = v; bi = mi * 16 + g4 * 4 + r; }
      }
#pragma unroll
    for (int off = 16; off <= 32; off <<= 1) {
      const float ov = shx(bv, off);
      const int oi = shx(bi, off);
      if (ov > bv || (ov == bv && oi < bi)) { bv = ov; bi = oi; }
    }
    vout[rd] = bv;
    iout[rd] = bi;
#pragma unroll
    for (int mi = 0; mi < 8; ++mi)
#pragma unroll
      for (int r = 0; r < 4; ++r)
        if (mi * 16 + g4 * 4 + r == bi) s[mi][r] = -INFINITY;
  }
}
DEV void peer_topk_mfma_item(const Params& p, int layer, int item) {
  const int lane = tidx() & 63, wave = tidx() >> 6, g4 = lane >> 4, c16 = lane & 15;
  const size_t tok = (size_t)item * 8 + wave * 2 + (c16 >> 3);
  const int hh = c16 & 7;
  const bf16* qp = (const bf16*)(p.ws + OFF_QP) + tok * 2048 + hh * 256;
  const bf16* k1 = (const bf16*)(p.ws + OFF_PKB) + (size_t)(layer * 2 + 0) * 16384;
  const bf16* k2 = (const bf16*)(p.ws + OFF_PKB) + (size_t)(layer * 2 + 1) * 16384;
  float v1[16], v2[16];
  int i1[16], i2[16];
  {
    f32x4 s[8];
    pk_scores(k1, qp, s, g4, c16);
    pk_top16(s, g4, v1, i1);
  }
  {
    f32x4 s[8];
    pk_scores(k2, qp + 128, s, g4, c16);
    pk_top16(s, g4, v2, i2);
  }
  float v1s[4];
  int i1s[4];
#pragma unroll
  for (int j = 0; j < 4; ++j) {
    v1s[j] = (g4 == 0) ? v1[j] : (g4 == 1) ? v1[4 + j] : (g4 == 2) ? v1[8 + j] : v1[12 + j];
    i1s[j] = (g4 == 0) ? i1[j] : (g4 == 1) ? i1[4 + j] : (g4 == 2) ? i1[8 + j] : i1[12 + j];
  }
  float c0[16], c1[8], c2[5], c3[4];
#pragma unroll
  for (int b = 0; b < 16; ++b) c0[b] = ((4 * g4 + 1) * (b + 1) <= 16) ? v1s[0] + v2[b] : -INFINITY;
#pragma unroll
  for (int b = 0; b < 8; ++b) c1[b] = ((4 * g4 + 2) * (b + 1) <= 16) ? v1s[1] + v2[b] : -INFINITY;
#pragma unroll
  for (int b = 0; b < 5; ++b) c2[b] = ((4 * g4 + 3) * (b + 1) <= 16) ? v1s[2] + v2[b] : -INFINITY;
#pragma unroll
  for (int b = 0; b < 4; ++b) c3[b] = ((4 * g4 + 4) * (b + 1) <= 16) ? v1s[3] + v2[b] : -INFINITY;
  float vals[16];
  int eidx[16];
  const int cbase = g4 * 64;
#pragma unroll
  for (int rd = 0; rd < 16; ++rd) {
    float bv = -INFINITY;
    int bi = 1 << 20;
#pragma unroll
    for (int b = 0; b < 16; ++b) if (c0[b] > bv) { bv = c0[b]; bi = cbase + b; }
#pragma unroll
    for (int b = 0; b < 8; ++b) if (c1[b] > bv) { bv = c1[b]; bi = cbase + 16 + b; }
#pragma unroll
    for (int b = 0; b < 5; ++b) if (c2[b] > bv) { bv = c2[b]; bi = cbase + 32 + b; }
#pragma unroll
    for (int b = 0; b < 4; ++b) if (c3[b] > bv) { bv = c3[b]; bi = cbase + 48 + b; }
#pragma unroll
    for (int off = 16; off <= 32; off <<= 1) {
      const float ov = shx(bv, off);
      const int oi = shx(bi, off);
      if (ov > bv || (ov == bv && oi < bi)) { bv = ov; bi = oi; }
    }
    vals[rd] = bv;
    int e = -1;
#pragma unroll
    for (int b = 0; b < 16; ++b) if (cbase + b == bi) { c0[b] = -INFINITY; e = i1s[0] * 128 + i2[b]; }
#pragma unroll
    for (int b = 0; b < 8; ++b) if (cbase + 16 + b == bi) { c1[b] = -INFINITY; e = i1s[1] * 128 + i2[b]; }
#pragma unroll
    for (int b = 0; b < 5; ++b) if (cbase + 32 + b == bi) { c2[b] = -INFINITY; e = i1s[2] * 128 + i2[b]; }
#pragma unroll
    for (int b = 0; b < 4; ++b) if (cbase + 48 + b == bi) { c3[b] = -INFINITY; e = i1s[3] * 128 + i2[b]; }
    e = max(e, shx(e, 16));
    e = max(e, shx(e, 32));
    eidx[rd] = e;
  }
  float ex[16], sum = 0.f;
#pragma unroll
  for (int rd = 0; rd < 16; ++rd) { ex[rd] = expf(vals[rd] - vals[0]); sum += ex[rd]; }
  const float inv = 1.f / sum;
  if (g4 == 0) {
    int* pi = (int*)(p.ws + OFF_PEIDX) + tok * 128 + hh * 16;
    float* pg = (float*)(p.ws + OFF_PEG) + tok * 128 + hh * 16;
#pragma unroll
    for (int q = 0; q < 4; ++q) {
      *(int4*)(pi + q * 4) = int4{eidx[q * 4], eidx[q * 4 + 1], eidx[q * 4 + 2], eidx[q * 4 + 3]};
      *(float4*)(pg + q * 4) = float4{ex[q * 4] * inv, ex[q * 4 + 1] * inv, ex[q * 4 + 2] * inv, ex[q * 4 + 3] * inv};
    }
  }
}

DEV float pk_key(float v, int inv_idx, unsigned mask) {
  return __uint_as_float((__float_as_uint(v) & ~mask) | (unsigned)inv_idx);
}
DEV void sort32_desc(float (&x)[32]) {
#pragma unroll
  for (int k = 2; k <= 32; k <<= 1)
#pragma unroll
    for (int j = k >> 1; j > 0; j >>= 1)
#pragma unroll
      for (int i = 0; i < 32; ++i) {
        const int l = i ^ j;
        if (l > i) {
          const float a = x[i], b = x[l];
          const float hi = fmaxf(a, b), lo = fminf(a, b);
          if ((i & k) == 0) { x[i] = hi; x[l] = lo; } else { x[i] = lo; x[l] = hi; }
        }
      }
}
DEV void pk_top16_sorted(f32x4 (&s)[8], int g4, float (&vout)[16], int (&iout)[16]) {
  float x[32];
#pragma unroll
  for (int mi = 0; mi < 8; ++mi)
#pragma unroll
    for (int r = 0; r < 4; ++r) x[mi * 4 + r] = pk_key(s[mi][r], 127 - (mi * 16 + g4 * 4 + r), 0x7Fu);
  sort32_desc(x);
#pragma unroll
  for (int rd = 0; rd < 16; ++rd) {
    float w = x[0];
    w = fmaxf(w, shx(w, 16));
    w = fmaxf(w, shx(w, 32));
    vout[rd] = w;
    iout[rd] = 127 - (int)(__float_as_uint(w) & 0x7Fu);
    if (x[0] == w) {
#pragma unroll
      for (int i = 0; i < 15; ++i) x[i] = x[i + 1];
      x[15] = -INFINITY;
    }
  }
}
template <int N>
DEV void shift_row(float (&c)[N], int (&e)[N]) {
#pragma unroll
  for (int i = 0; i + 1 < N; ++i) { c[i] = c[i + 1]; e[i] = e[i + 1]; }
  c[N - 1] = -INFINITY;
}
DEV void peer_topk_item3(const Params& p, int layer, int item) {
  const int lane = tidx() & 63, wave = tidx() >> 6, g4 = lane >> 4, c16 = lane & 15;
  const size_t tok = (size_t)item * 8 + wave * 2 + (c16 >> 3);
  const int hh = c16 & 7;
  const bf16* qp = (const bf16*)(p.ws + OFF_QP) + tok * 2048 + hh * 256;
  const bf16* k1 = (const bf16*)(p.ws + OFF_PKB) + (size_t)(layer * 2 + 0) * 16384;
  const bf16* k2 = (const bf16*)(p.ws + OFF_PKB) + (size_t)(layer * 2 + 1) * 16384;
  float v1[16], v2[16];
  int i1[16], i2[16];
  {
    f32x4 s[8];
    pk_scores(k1, qp, s, g4, c16);
    pk_top16_sorted(s, g4, v1, i1);
  }
  {
    f32x4 s[8];
    pk_scores(k2, qp + 128, s, g4, c16);
    pk_top16_sorted(s, g4, v2, i2);
  }
  float v1s[4];
  int i1s[4];
#pragma unroll
  for (int j = 0; j < 4; ++j) {
    v1s[j] = (g4 == 0) ? v1[j] : (g4 == 1) ? v1[4 + j] : (g4 == 2) ? v1[8 + j] : v1[12 + j];
    i1s[j] = (g4 == 0) ? i1[j] : (g4 == 1) ? i1[4 + j] : (g4 == 2) ? i1[8 + j] : i1[12 + j];
  }
  float c0[16], c1[8], c2[5], c3[4];
  int e0[16], e1[8], e2[5], e3[4];
  const int cbase = g4 * 64;
#pragma unroll
  for (int b = 0; b < 16; ++b) {
    c0[b] = ((4 * g4 + 1) * (b + 1) <= 16) ? pk_key(v1s[0] + v2[b], 255 - (cbase + b), 0xFFu) : -INFINITY;
    e0[b] = i1s[0] * 128 + i2[b];
  }
#pragma unroll
  for (int b = 0; b < 8; ++b) {
    c1[b] = ((4 * g4 + 2) * (b + 1) <= 16) ? pk_key(v1s[1] + v2[b], 255 - (cbase + 16 + b), 0xFFu) : -INFINITY;
    e1[b] = i1s[1] * 128 + i2[b];
  }
#pragma unroll
  for (int b = 0; b < 5; ++b) {
    c2[b] = ((4 * g4 + 3) * (b + 1) <= 16) ? pk_key(v1s[2] + v2[b], 255 - (cbase + 32 + b), 0xFFu) : -INFINITY;
    e2[b] = i1s[2] * 128 + i2[b];
  }
#pragma unroll
  for (int b = 0; b < 4; ++b) {
    c3[b] = ((4 * g4 + 4) * (b + 1) <= 16) ? pk_key(v1s[3] + v2[b], 255 - (cbase + 48 + b), 0xFFu) : -INFINITY;
    e3[b] = i1s[3] * 128 + i2[b];
  }
  float vals[16];
  int eidx[16];
#pragma unroll
  for (int rd = 0; rd < 16; ++rd) {
    float w = fmaxf(fmaxf(c0[0], c1[0]), fmaxf(c2[0], c3[0]));
    w = fmaxf(w, shx(w, 16));
    w = fmaxf(w, shx(w, 32));
    vals[rd] = w;
    int e = -1;
    if (c0[0] == w) { e = e0[0]; shift_row(c0, e0); }
    if (c1[0] == w) { e = e1[0]; shift_row(c1, e1); }
    if (c2[0] == w) { e = e2[0]; shift_row(c2, e2); }
    if (c3[0] == w) { e = e3[0]; shift_row(c3, e3); }
    e = max(e, shx(e, 16));
    e = max(e, shx(e, 32));
    eidx[rd] = e;
  }
  float ex[16], sum = 0.f;
#pragma unroll
  for (int rd = 0; rd < 16; ++rd) { ex[rd] = expf(vals[rd] - vals[0]); sum += ex[rd]; }
  const float inv = 1.f / sum;
  if (g4 == 0) {
    int* pi = (int*)(p.ws + OFF_PEIDX) + tok * 128 + hh * 16;
    float* pg = (float*)(p.ws + OFF_PEG) + tok * 128 + hh * 16;
#pragma unroll
    for (int q = 0; q < 4; ++q) {
      *(int4*)(pi + q * 4) = int4{eidx[q * 4], eidx[q * 4 + 1], eidx[q * 4 + 2], eidx[q * 4 + 3]};
      *(float4*)(pg + q * 4) = float4{ex[q * 4] * inv, ex[q * 4 + 1] * inv, ex[q * 4 + 2] * inv, ex[q * 4 + 3] * inv};
    }
  }
}

typedef float f32x2_t __attribute__((ext_vector_type(2)));
DEV unsigned pack4_fp8(float a, float b, float c, float d) {
  int p = __builtin_amdgcn_cvt_pk_fp8_f32(a, b, 0, false);
  p = __builtin_amdgcn_cvt_pk_fp8_f32(c, d, p, true);
  return (unsigned)p;
}
DEV void unpack16_fp8(uint4 v, float* f) {
  f32x2_t r;
  r = __builtin_amdgcn_cvt_pk_f32_fp8((int)v.x, false); f[0] = r.x; f[1] = r.y;
  r = __builtin_amdgcn_cvt_pk_f32_fp8((int)v.x, true);  f[2] = r.x; f[3] = r.y;
  r = __builtin_amdgcn_cvt_pk_f32_fp8((int)v.y, false); f[4] = r.x; f[5] = r.y;
  r = __builtin_amdgcn_cvt_pk_f32_fp8((int)v.y, true);  f[6] = r.x; f[7] = r.y;
  r = __builtin_amdgcn_cvt_pk_f32_fp8((int)v.z, false); f[8] = r.x; f[9] = r.y;
  r = __builtin_amdgcn_cvt_pk_f32_fp8((int)v.z, true);  f[10] = r.x; f[11] = r.y;
  r = __builtin_amdgcn_cvt_pk_f32_fp8((int)v.w, false); f[12] = r.x; f[13] = r.y;
  r = __builtin_amdgcn_cvt_pk_f32_fp8((int)v.w, true);  f[14] = r.x; f[15] = r.y;
}
DEV void expert_cvt_item(const Params& p, int layer, int item) {
  const int lane = tidx() & 63, wave = tidx() >> 6;
  const int e = item * 4 + wave;
  unsigned char* dst = (unsigned char*)(p.ws + OFF_E8) + (size_t)e * 2048;
  float* sc = (float*)(p.ws + OFF_ESC) + (size_t)e * 2;
#pragma unroll
  for (int tb = 0; tb < 2; ++tb) {
    const float* src = (tb ? p.peer_v : p.peer_u) + ((size_t)layer * NEXP + e) * 1024 + lane * 16;
    float4 a = *(const float4*)src, b = *(const float4*)(src + 4), c = *(const float4*)(src + 8), d = *(const float4*)(src + 12);
    float mx = fmaxf(fmaxf(fmaxf(fabsf(a.x), fabsf(a.y)), fmaxf(fabsf(a.z), fabsf(a.w))),
                     fmaxf(fmaxf(fabsf(b.x), fabsf(b.y)), fmaxf(fabsf(b.z), fabsf(b.w))));
    mx = fmaxf(mx, fmaxf(fmaxf(fmaxf(fabsf(c.x), fabsf(c.y)), fmaxf(fabsf(c.z), fabsf(c.w))),
                         fmaxf(fmaxf(fabsf(d.x), fabsf(d.y)), fmaxf(fabsf(d.z), fabsf(d.w)))));
#pragma unroll
    for (int o = 32; o >= 1; o >>= 1) mx = fmaxf(mx, shx(mx, o));
    const float s = (mx > 0.f) ? 224.f / mx : 1.f;
    uint4 pk;
    pk.x = pack4_fp8(a.x * s, a.y * s, a.z * s, a.w * s);
    pk.y = pack4_fp8(b.x * s, b.y * s, b.z * s, b.w * s);
    pk.z = pack4_fp8(c.x * s, c.y * s, c.z * s, c.w * s);
    pk.w = pack4_fp8(d.x * s, d.y * s, d.z * s, d.w * s);
    *(uint4*)(dst + tb * 1024 + lane * 16) = pk;
    if (lane == 0) sc[tb] = 1.f / s;
  }
}

DEV float rdlane_f(float v, int l) { return __int_as_float(__builtin_amdgcn_readlane(__float_as_int(v), l)); }
DEV float dot16_f8(const float* hw, uint4 u) {
  float f[16];
  unpack16_fp8(u, f);
  float s = 0.f;
#pragma unroll
  for (int i = 0; i < 16; ++i) s += hw[i] * f[i];
  return s;
}
DEV void axpy16_f8(float* acc, float a, uint4 u) {
  float f[16];
  unpack16_fp8(u, f);
#pragma unroll
  for (int i = 0; i < 16; ++i) acc[i] += a * f[i];
}
#define PE_ROWPTR(idxv, j) (E8 + (size_t)__builtin_amdgcn_readlane(idxv, (j)) * 2048)
#define PE_LOAD8(P, idxv, j0, off)                                                                        \
  P##0 = *(const uint4*)(PE_ROWPTR(idxv, (j0)) + (off)); P##1 = *(const uint4*)(PE_ROWPTR(idxv, (j0) + 1) + (off)); \
  P##2 = *(const uint4*)(PE_ROWPTR(idxv, (j0) + 2) + (off)); P##3 = *(const uint4*)(PE_ROWPTR(idxv, (j0) + 3) + (off)); \
  P##4 = *(const uint4*)(PE_ROWPTR(idxv, (j0) + 4) + (off)); P##5 = *(const uint4*)(PE_ROWPTR(idxv, (j0) + 5) + (off)); \
  P##6 = *(const uint4*)(PE_ROWPTR(idxv, (j0) + 6) + (off)); P##7 = *(const uint4*)(PE_ROWPTR(idxv, (j0) + 7) + (off));
#define PE_DOTSET(P, j0, dv)                                                                              \
  {                                                                                                       \
    const float s0 = wave_sum(dot16_f8(hw, P##0)), s1 = wave_sum(dot16_f8(hw, P##1)),                     \
                s2 = wave_sum(dot16_f8(hw, P##2)), s3 = wave_sum(dot16_f8(hw, P##3)),                     \
                s4 = wave_sum(dot16_f8(hw, P##4)), s5 = wave_sum(dot16_f8(hw, P##5)),                     \
                s6 = wave_sum(dot16_f8(hw, P##6)), s7 = wave_sum(dot16_f8(hw, P##7));                     \
    if (lane == (j0)) dv = s0;                                                                            \
    if (lane == (j0) + 1) dv = s1;                                                                        \
    if (lane == (j0) + 2) dv = s2;                                                                        \
    if (lane == (j0) + 3) dv = s3;                                                                        \
    if (lane == (j0) + 4) dv = s4;                                                                        \
    if (lane == (j0) + 5) dv = s5;                                                                        \
    if (lane == (j0) + 6) dv = s6;                                                                        \
    if (lane == (j0) + 7) dv = s7;                                                                        \
  }
#define PE_AXPYSET(P, j0, av)                                                                             \
  {                                                                                                       \
    axpy16_f8(acc, rdlane_f(av, (j0)), P##0);     axpy16_f8(acc, rdlane_f(av, (j0) + 1), P##1);           \
    axpy16_f8(acc, rdlane_f(av, (j0) + 2), P##2); axpy16_f8(acc, rdlane_f(av, (j0) + 3), P##3);           \
    axpy16_f8(acc, rdlane_f(av, (j0) + 4), P##4); axpy16_f8(acc, rdlane_f(av, (j0) + 5), P##5);           \
    axpy16_f8(acc, rdlane_f(av, (j0) + 6), P##6); axpy16_f8(acc, rdlane_f(av, (j0) + 7), P##7);           \
  }
#define PE_DOT8(idxv, dv)                                                                                 \
  {                                                                                                       \
    uint4 pa0, pa1, pa2, pa3, pa4, pa5, pa6, pa7, pb0, pb1, pb2, pb3, pb4, pb5, pb6, pb7;                 \
    PE_LOAD8(pa, idxv, 0, 0)                                                                              \
    _Pragma("unroll 1") for (int g = 0; g < 4; ++g) {                                                     \
      const int j0 = g * 16;                                                                              \
      PE_LOAD8(pb, idxv, j0 + 8, 0)                                                                       \
      PE_DOTSET(pa, j0, dv)                                                                               \
      if (g < 3) { PE_LOAD8(pa, idxv, j0 + 16, 0) }                                                       \
      PE_DOTSET(pb, j0 + 8, dv)                                                                           \
    }                                                                                                     \
  }
#define PE_AXPY8(idxv, av)                                                                                \
  {                                                                                                       \
    uint4 pa0, pa1, pa2, pa3, pa4, pa5, pa6, pa7, pb0, pb1, pb2, pb3, pb4, pb5, pb6, pb7;                 \
    PE_LOAD8(pa, idxv, 0, 1024)                                                                           \
    _Pragma("unroll 1") for (int g = 0; g < 4; ++g) {                                                     \
      const int j0 = g * 16;                                                                              \
      PE_LOAD8(pb, idxv, j0 + 8, 1024)                                                                    \
      PE_AXPYSET(pa, j0, av)                                                                              \
      if (g < 3) { PE_LOAD8(pa, idxv, j0 + 16, 1024) }                                                    \
      PE_AXPYSET(pb, j0 + 8, av)                                                                          \
    }                                                                                                     \
  }
DEV void peer_expert_item2(const Params& p, int layer, int item, float ga_scale = 1.f) {
  const int lane = tidx() & 63, wave = tidx() >> 6;
  const size_t tok = (size_t)item * 4 + wave;
  const int b = (int)(tok / S);
  const int* pi = (const int*)(p.ws + OFF_PEIDX) + tok * 128;
  const float* pg = (const float*)(p.ws + OFF_PEG) + tok * 128;
  const int idx_lo = pi[lane], idx_hi = pi[64 + lane];
  const float g_lo = pg[lane], g_hi = pg[64 + lane];
  const float* esc = (const float*)(p.ws + OFF_ESC);
  const float2 sc_lo = *(const float2*)(esc + (size_t)idx_lo * 2), sc_hi = *(const float2*)(esc + (size_t)idx_hi * 2);
  const bf16* hrow = (const bf16*)(p.ws + OFF_H) + tok * 1024 + lane * 16;
  float hw[16];
  unpack8(*(const uint4*)hrow, hw);
  unpack8(*(const uint4*)(hrow + 8), hw + 8);
  const unsigned char* E8 = (const unsigned char*)(p.ws + OFF_E8) + lane * 16;
  float d_lo = 0.f, d_hi = 0.f;
  PE_DOT8(idx_lo, d_lo)
  PE_DOT8(idx_hi, d_hi)
  const float act_lo = g_lo * gelu_tanh(d_lo * sc_lo.x) * sc_lo.y;
  const float act_hi = g_hi * gelu_tanh(d_hi * sc_hi.x) * sc_hi.y;
  float acc[16];
#pragma unroll
  for (int i = 0; i < 16; ++i) acc[i] = 0.f;
  PE_AXPY8(idx_lo, act_lo)
  PE_AXPY8(idx_hi, act_hi)
  const float* ga = (const float*)(p.ws + OFF_MOD) + (layer * 2 + b) * 6144 + 5120 + lane * 16;
  float* xr = p.out + tok * 1024 + lane * 16;
  float xn[16];
  float ss = 0.f;
#pragma unroll
  for (int q4 = 0; q4 < 4; ++q4) {
    float4 xo = *(float4*)(xr + q4 * 4);
    const float4 g4v = *(const float4*)(ga + q4 * 4);
    xo.x += ga_scale * g4v.x * acc[q4 * 4 + 0];
    xo.y += ga_scale * g4v.y * acc[q4 * 4 + 1];
    xo.z += ga_scale * g4v.z * acc[q4 * 4 + 2];
    xo.w += ga_scale * g4v.w * acc[q4 * 4 + 3];
    xn[q4 * 4] = xo.x; xn[q4 * 4 + 1] = xo.y; xn[q4 * 4 + 2] = xo.z; xn[q4 * 4 + 3] = xo.w;
    ss += xo.x * xo.x + xo.y * xo.y + xo.z * xo.z + xo.w * xo.w;
  }
#if PROBE_ANY || REP_MASK
#pragma unroll
  for (int q4 = 0; q4 < 4; ++q4)
    *(float4*)(xr + q4 * 4) = float4{xn[q4 * 4], xn[q4 * 4 + 1], xn[q4 * 4 + 2], xn[q4 * 4 + 3]};
  return;
#endif
  ss = wave_sum(ss);
  const float rn = 1.0f / sqrtf(ss * (1.0f / 1024.f) + 1e-6f);
  if (layer == 0) {
    const float* gn = p.g_attn + 1024 + lane * 16;
    const float* md = (const float*)(p.ws + OFF_MOD) + (2 + b) * 6144 + lane * 16;
    bf16* hq = (bf16*)(p.ws + OFF_H) + tok * 1024 + lane * 16;
    unsigned pk[8];
#pragma unroll
    for (int q4 = 0; q4 < 4; ++q4) {
      *(float4*)(xr + q4 * 4) = float4{xn[q4 * 4], xn[q4 * 4 + 1], xn[q4 * 4 + 2], xn[q4 * 4 + 3]};
      const float4 g4v = *(const float4*)(gn + q4 * 4);
      const float4 s4 = *(const float4*)(md + 1024 + q4 * 4);
      const float4 h4 = *(const float4*)(md + q4 * 4);
      const float o0 = xn[q4 * 4] * rn * g4v.x * (1.f + s4.x) + h4.x;
      const float o1 = xn[q4 * 4 + 1] * rn * g4v.y * (1.f + s4.y) + h4.y;
      const float o2 = xn[q4 * 4 + 2] * rn * g4v.z * (1.f + s4.z) + h4.z;
      const float o3 = xn[q4 * 4 + 3] * rn * g4v.w * (1.f + s4.w) + h4.w;
      pk[q4 * 2] = cvtpk_(o0, o1);
      pk[q4 * 2 + 1] = cvtpk_(o2, o3);
    }
    *(uint4*)hq = uint4{pk[0], pk[1], pk[2], pk[3]};
    *(uint4*)(hq + 8) = uint4{pk[4], pk[5], pk[6], pk[7]};
  } else {
    const float* gf = p.g_final + lane * 16;
#pragma unroll
    for (int q4 = 0; q4 < 4; ++q4) {
      const float4 g4v = *(const float4*)(gf + q4 * 4);
      *(float4*)(xr + q4 * 4) = float4{xn[q4 * 4] * rn * g4v.x, xn[q4 * 4 + 1] * rn * g4v.y, xn[q4 * 4 + 2] * rn * g4v.z,
                                       xn[q4 * 4 + 3] * rn * g4v.w};
    }
  }
}

template <class F>
DEV void for_tiles_xcd(int MT, int NT, F f) {
  const int nb = gridDim.x, bid = blockIdx.x;
  if ((nb & 7) != 0) {
    for (int it = bid; it < MT * NT; it += nb) f(it / NT, it % NT);
    return;
  }
  const int xcd = bid & 7, slot = bid >> 3, nslot = nb >> 3;
  const int nj = (NT - xcd + 7) >> 3;
  for (int q = slot; q < MT * nj; q += nslot) f(q / nj, xcd + 8 * (q % nj));
}
constexpr int PH_PER_LAYER = 15;
enum { SP_NORM1 = 0, SP_INPROJ = 1, SP_COMPRESS = 2, SP_KMEAN = 3, SP_ATTN = 4, SP_MP0 = 5, SP_MM0 = 6, SP_MP1 = 7, SP_MM1 = 8,
       SP_MERGE = 9, SP_OUTPROJ = 10, SP_NORM2 = 11, SP_PEERQ = 12, SP_TOPK = 13, SP_EXPERT = 14 };
constexpr int N_REAL_PHASES = 1 + 2 * PH_PER_LAYER + 1;
constexpr int N_PHASES = N_REAL_PHASES + (PROBE_ANY ? 2 : 0);

DEV void run_phase(const Params& p, int ph, char* smem_raw, bool second_pass = false) {
#define SKIP_MOBA_SECOND (REP_NSA_ONLY && second_pass)
  float* smf = (float*)smem_raw;
  bf16* smh = (bf16*)smem_raw;
  const int nb = gridDim.x, bid = blockIdx.x;
  if (ph == 0) {
    for (int it = bid; it < PREP_ITEMS; it += nb) prep_item(p, it, smf);
    return;
  }
  if (ph == N_REAL_PHASES - 1) {
    for (int it = bid; it < T / 4; it += nb) final_norm_item(p.out, p.g_final, it);
    return;
  }
#if PROBE_ANY
  if (ph == N_REAL_PHASES) {
#if PROBE_PROJ
    {
      const bf16* Hh = (const bf16*)(p.ws + OFF_H);
      const bf16* Wt = (const bf16*)(p.ws + OFF_WINT) + (size_t)1 * WN * 1024;
      const float* rope = (const float*)(p.ws + OFF_ROPE);
      float sd = 0.f, sr = 0.f;
      for (size_t i = (size_t)bid * 256 + tidx(); i < (size_t)(T / 64) * 4888; i += (size_t)nb * 256) {
        const int ts = (int)(i / 4888), vc = (int)(i % 4888);
        const int tok = ts * 64 + (ts % 61);
        const int b = tok / S, t = tok % S;
        auto rawdot = [&](int col) {
          float a = 0.f;
          for (int k = 0; k < 1024; ++k) a += bf2f(Hh[(size_t)tok * 1024 + k]) * bf2f(Wt[(size_t)col * 1024 + k]);
          return a;
        };
        float v = rawdot(vc);
        bool roped = false;
        const bf16* dst;
        if (vc < 768) dst = (const bf16*)(p.ws + OFF_PROJ) + (size_t)tok * PC + vc;
        else if (vc < 1280) {
          const int seg = (vc - 768) >> 7, head = ((vc - 768) >> 6) & 1, d = vc & 63;
          const size_t off = (seg == 0) ? OFF_KSB : (seg == 1) ? OFF_VSB : (seg == 2) ? OFF_KWB : OFF_VWB;
          dst = (const bf16*)(p.ws + off) + ((size_t)(b * 2 + head) * S + t) * 64 + d;
          roped = (seg == 0 || seg == 2);
        } else if (vc < 1792) { dst = (const bf16*)(p.ws + OFF_PROJ) + (size_t)tok * PC + C_MQ + (vc - 1280); roped = true; }
        else if (vc < 2816) {
          const int seg = (vc - 1792) >> 9, head = ((vc - 1792) >> 6) & 7, d = vc & 63;
          dst = (const bf16*)(p.ws + (seg ? OFF_MVB : OFF_MKB)) + ((size_t)(b * 8 + head) * S + t) * 64 + d;
          roped = (seg == 0);
        } else if (vc < 4864) dst = (const bf16*)(p.ws + OFF_PROJ) + (size_t)tok * PC + C_GN + (vc - 2816);
        else dst = (const bf16*)(p.ws + OFF_PROJ) + (size_t)tok * PC + C_NG + (vc - 4864);
        const int d = vc & 63;
        if (roped && d < 16) {
          const float cs = rope[(size_t)t * 16 + (d & 7)], sn = rope[(size_t)t * 16 + 8 + (d & 7)];
          if (d < 8) { const float x2 = rawdot(vc + 8); v = v * cs - x2 * sn; }
          else { const float x1 = rawdot(vc - 8); v = v * cs + x1 * sn; }
        }
        const float got = bf2f(*dst);
        const bool is_r = roped && d < 16;
        if (PROBE_PROJ == 1 || (PROBE_PROJ == 2 && is_r) || (PROBE_PROJ == 3 && !is_r)) {
          sd += (got - v) * (got - v);
          sr += v * v;
        }
      }
      sd = wave_sum(sd); sr = wave_sum(sr);
      if ((tidx() & 63) == 0) {
        atomicAdd((float*)(p.ws + OFF_PROBE), sd);
        atomicAdd((float*)(p.ws + OFF_PROBE) + 1, sr);
      }
    }
#endif
#if PROBE_CMPR
    {
      float sd = 0.f, sr = 0.f;
      for (size_t i = (size_t)bid * 256 + tidx(); i < (size_t)2 * Bn * 1024 * 128; i += (size_t)nb * 256) {
        const size_t wh = i / ((size_t)Bn * 1024 * 128), r = i % ((size_t)Bn * 1024 * 128);
        const int c = (int)((r / 128) % 1024);
        if (c < 1023) {
          const float a = ((const float*)(p.ws + (wh ? OFF_VCC : OFF_KCC)))[r];
          const float y = ((const float*)(p.ws + OFF_CMP))[i];
          sd += (a - y) * (a - y);
          sr += y * y;
        }
      }
      sd = wave_sum(sd); sr = wave_sum(sr);
      if ((tidx() & 63) == 0) {
        atomicAdd((float*)(p.ws + OFF_PROBE), sd);
        atomicAdd((float*)(p.ws + OFF_PROBE) + 1, sr);
      }
    }
#endif
#if PROBE_MOBA
    probe_accum_bf16(p, (const bf16*)(p.ws + OFF_OMOBA), (const bf16*)(p.ws + OFF_CMP), (size_t)S * 512, smf);
#endif
#if PROBE_NSA == 8
    {
      const float* impn = (const float*)(p.ws + OFF_OMOBA);
      const float* impm = impn + (size_t)S * 256;
      const int* seld = (const int*)(p.ws + OFF_CMP);
      float sd = 0.f, sr = 0.f, bad = 0.f;
      for (int t = bid * 256 + tidx(); t < S; t += nb * 256) {
        const int cur = t >> 6;
        for (int n = 0; n < 256; ++n) {
          float a = impm[(size_t)t * 256 + n], r = impn[(size_t)t * 256 + n];
          sd += (a - r) * (a - r);
          sr += r * r;
        }
        unsigned want[8] = {0, 0, 0, 0, 0, 0, 0, 0}, got[8] = {0, 0, 0, 0, 0, 0, 0, 0};
        for (int j = 0; j < 16; ++j) {
          int v = seld[(size_t)t * 16 + j];
          if (v >= 0 && v < 256) {
            for (int w = 0; w < 8; ++w) if ((v >> 5) == w) got[w] |= 1u << (v & 31);
          }
        }
        if (cur < 16) {
          for (int n = 0; n <= cur; ++n) want[0] |= 1u << n;
        } else {
          want[0] |= 1u;
          for (int w = 0; w < 8; ++w) {
            if (((cur - 1) >> 5) == w) want[w] |= 1u << ((cur - 1) & 31);
            if ((cur >> 5) == w) want[w] |= 1u << (cur & 31);
          }
          for (int j = 0; j < 13; ++j) {
            float best = -1.f;
            int bi = 1;
            for (int n = 1; n <= cur - 2; ++n) {
              bool taken = false;
              for (int w = 0; w < 8; ++w) if ((n >> 5) == w) taken = (want[w] >> (n & 31)) & 1u;
              float v = impm[(size_t)t * 256 + n];
              if (!taken && v > best) { best = v; bi = n; }
            }
            for (int w = 0; w < 8; ++w) if ((bi >> 5) == w) want[w] |= 1u << (bi & 31);
          }
        }
        bool same = true;
        for (int w = 0; w < 8; ++w) same = same && (want[w] == got[w]);
        if (!same) bad += 1.f;
      }
      sd = wave_sum(sd); sr = wave_sum(sr); bad = wave_sum(bad);
      if ((tidx() & 63) == 0) {
        atomicAdd((float*)(p.ws + OFF_PROBE), sd);
        atomicAdd((float*)(p.ws + OFF_PROBE) + 1, sr);
        atomicAdd((float*)(p.ws + OFF_PROBE) + 2, bad);
      }
    }
#elif PROBE_NSA
    probe_accum_bf16(p, (const bf16*)(p.ws + OFF_ONSA), (const bf16*)(p.ws + OFF_CMP), (size_t)S * 512, smf);
#endif
    return;
  }
  if (ph == N_REAL_PHASES + 1) {
    probe_apply(p);
    return;
  }
#endif
  const int layer = (ph - 1) / PH_PER_LAYER, sub = (ph - 1) % PH_PER_LAYER;
  const float* mod = (const float*)(p.ws + OFF_MOD) + (size_t)layer * 2 * 6144;
  const float* xin = (layer == 0) ? p.x : p.out;
  bf16* H = (bf16*)(p.ws + OFF_H);
  bf16* PROJ = (bf16*)(p.ws + OFF_PROJ);
#if PROBE_ANY
  if (sub >= SP_MERGE) {
    if (sub == SP_OUTPROJ && layer == 0)
      for (size_t i = (size_t)bid * 256 + tidx(); i < (size_t)T * 1024; i += (size_t)nb * 256) p.out[i] = p.x[i];
    return;
  }
#endif
  switch (sub) {
    case SP_NORM1:
      for (int it = bid; it < T / 4; it += nb)
        norm_item(xin, p.g_attn + layer * 1024, mod + 1024, mod + 0, H, it);
      break;
    case SP_INPROJ: {
      for_tiles_xcd(T / 128, WN / 128, [&](int mt, int nt) { inproj_tile(p, layer, mt * 128, nt * 128, smh); });
    } break;
    case SP_COMPRESS:
      for (int it = bid; it < 512; it += nb) compress_mfma_item(p, layer, it, smem_raw);
#if PROBE_CMPR
      if (layer == 1)
        for (int it = bid; it < 1024; it += nb) compress_item(p, layer, it, smf);
#endif
      break;
    case SP_KMEAN:
      for (int it = bid; it < 1024; it += nb) kmean_item(p, it, smf);
#if PROBE_NSA
      if (layer == 1)
        for (int it = bid; it < 512; it += nb) n1_item(p, layer, it, smf);
#endif
      break;
    case SP_ATTN:
      {
        constexpr int MNI = 2;
        constexpr int NMOBA = 16 * (S / (64 * MNI));
        constexpr int NNI = 2;
        constexpr int NNSA = 4 * (S / (16 * NNI));
        const bool do_nsa = !PROBE_ANY || PROBE_NSA, do_moba = (!PROBE_ANY || PROBE_MOBA) && PROBE_NSA != 8;
        for (int it = bid; it < NNSA + NMOBA; it += nb) {
          if (it < NNSA) { if (do_nsa) nsa_item<NNI>(p, it, smem_raw, (bf16*)(p.ws + OFF_ONSA)); }
          else if (do_moba && !SKIP_MOBA_SECOND) moba_gate_item<MNI>(p, it - NNSA);
        }
#if PROBE_NSA && PROBE_NSA != 8
        if (layer == 1)
          for (int it = bid; it < 512; it += nb) n23_item(p, layer, it);
#endif
#if PROBE_MOBA
        if (layer == 1) {
          for (int it = bid; it < 512; it += nb) moba_item(p, layer, it);
        }
#endif
      }
      break;
    case SP_MP0:
    case SP_MP1:
      if ((!PROBE_ANY || PROBE_MOBA) && PROBE_NSA != 8)
        for (int it = bid; it < 8 * 63 * 8; it += nb) moba_part_item<2>(p, sub == SP_MP1 ? 1 : 0, it, smem_raw);
      break;
    case SP_MM0:
    case SP_MM1:
      if ((!PROBE_ANY || PROBE_MOBA) && PROBE_NSA != 8)
        for (int it = bid; it < 8 * (S / 128); it += nb)
          moba_merge_item<2>(p, sub == SP_MM1 ? 1 : 0, it, smem_raw, (bf16*)(p.ws + OFF_OMOBA));
      break;
    case SP_MERGE:
      for_tiles_xcd(T / 128, 8, [&](int mt, int nt) { merge_tile(p, layer, mt * 128, nt * 128, smh); });
      break;
    case SP_OUTPROJ: {
      const bf16* W = (const bf16*)(p.ws + OFF_WOUT) + (size_t)layer * 1024 * 1024;
      const float* ga1 = mod + 2048;
      for_tiles_xcd(T / 128, 8, [&](int mt, int nt) {
        gemm_tile(H, 1024, W, 1024, mt * 128, nt * 128, smh, [&](int row, int col, float v) {
          int b = row / S;
          size_t o = (size_t)row * 1024 + col;
          p.out[o] = xin[o] + ga1[b * 6144 + col] * v;
        });
      });
    } break;
    case SP_NORM2:
      for (int it = bid; it < T / 4 + NEXP / 4; it += nb) {
        if (it < T / 4) norm_item(p.out, p.g_ffn + layer * 1024, mod + 4096, mod + 3072, H, it);
        else expert_cvt_item(p, layer, it - T / 4);
      }
      break;
    case SP_PEERQ: {
      const bf16* W = (const bf16*)(p.ws + OFF_WQ) + (size_t)layer * 2048 * 1024;
      bf16* QP = (bf16*)(p.ws + OFF_QP);
      for_tiles_xcd(T / 128, 16, [&](int mt, int nt) {
        f32x4 acc[4][4];
        acc_zero(acc);
        gemm_mainloop(H, 1024, W, 1024, mt * 128, nt * 128, smh, acc);
        const int wv = tidx() >> 6;
        store_tile_bf16(smh, acc, QP + (size_t)(mt * 128 + (wv >> 1) * 64) * 2048 + nt * 128 + (wv & 1) * 64, 2048);
      });
    } break;
    case SP_TOPK:
      for (int it = bid; it < T / 8; it += nb) peer_topk_item3(p, layer, it);
      break;
    case SP_EXPERT:
      for (int it = bid; it < T / 4; it += nb) peer_expert_item2(p, layer, it, second_pass ? 0.f : 1.f);
      break;
  }
}

#if PROBE_ANY
#define MEGA_LB __launch_bounds__(256)
#else
#define MEGA_LB __launch_bounds__(256, 2)
#endif
__global__ void MEGA_LB mega_kernel(Params p, int ph_lo, int ph_hi) {
  __shared__ __attribute__((aligned(16))) char smem_raw[SMEM_BYTES + 16];
  volatile LAS unsigned* xbst = (volatile LAS unsigned*)(smem_raw + SMEM_BYTES);
  if (threadIdx.x == 0) { xbst[0] = 0u; xbst[1] = 0u; xbst[2] = 0u; xbst[3] = 0u; }
  __syncthreads();
  XcdBarrier xb = xcd_barrier_post((unsigned*)(p.ws + OFF_BAR), xbst);
  for (int ph = ph_lo; ph < ph_hi; ++ph) {
#if !PROBE_ANY && !REP_MASK
    if (ph == N_REAL_PHASES - 1 || ph == 1 + PH_PER_LAYER) continue;
#endif
    run_phase(p, ph, smem_raw);
#if REP_MASK
    if (ph >= 1 && ph < N_REAL_PHASES - 1 && ((REP_MASK >> ((ph - 1) % PH_PER_LAYER)) & 1)) {
      xcd_barrier(xb);
      run_phase(p, ph, smem_raw, true);
    }
#endif
    if (ph + 1 < ph_hi) {
      if (ph == ph_lo) cg::this_grid().sync();
      else xcd_barrier(xb);
    }
  }
}

extern "C" void kernel_launch(void* const* d_in, const int* in_sizes, int n_in, void* d_out, int out_size, void* d_ws,
                              size_t ws_size, hipStream_t stream) {
  if (ws_size < WS_TOTAL) {
    fprintf(stderr, "workspace too small: %zu < %zu\n", ws_size, (size_t)WS_NEED);
    return;
  }
  Params p{};
  p.x = (const float*)d_in[0]; p.c = (const float*)d_in[1]; p.w_ada = (const float*)d_in[2];
  p.b_ada = (const float*)d_in[3]; p.g_attn = (const float*)d_in[4]; p.g_ffn = (const float*)d_in[5];
  p.w_in = (const float*)d_in[6]; p.cmp_pe = (const float*)d_in[7]; p.cmp_w1 = (const float*)d_in[8];
  p.cmp_w2 = (const float*)d_in[9]; p.w_up_nsa = (const float*)d_in[10]; p.w_up_moba = (const float*)d_in[11];
  p.w_out = (const float*)d_in[12]; p.peer_wq = (const float*)d_in[13]; p.peer_k1 = (const float*)d_in[14];
  p.peer_k2 = (const float*)d_in[15]; p.peer_u = (const float*)d_in[16]; p.peer_v = (const float*)d_in[17];
  p.g_final = (const float*)d_in[18];
  p.out = (float*)d_out;
  p.ws = (char*)d_ws;
  static int grid_blocks = 0;
  if (!grid_blocks) {
    int dev = 0, cus = 0, per_cu = 0;
    hipGetDevice(&dev);
    hipDeviceGetAttribute(&cus, hipDeviceAttributeMultiprocessorCount, dev);
    hipOccupancyMaxActiveBlocksPerMultiprocessor(&per_cu, mega_kernel, 256, 0);
    if (per_cu < 1) per_cu = 1;
    if (per_cu > 2) per_cu = 2;
    grid_blocks = cus * per_cu;
  }
  hipMemsetAsync((char*)d_ws + OFF_BAR, 0, BAR_BYTES, stream);
  int ph_lo = 0, ph_hi = N_PHASES;
  void* args[] = {(void*)&p, (void*)&ph_lo, (void*)&ph_hi};
  hipError_t e = hipLaunchCooperativeKernel((const void*)mega_kernel, dim3(grid_blocks), dim3(256), args, 0, stream);
  if (e != hipSuccess) fprintf(stderr, "cooperative launch failed: %s (grid %d)\n", hipGetErrorString(e), grid_blocks);
}
```

```cpp
#include <hip/hip_runtime.h>
#include <hip/hip_bf16.h>
#include <hip/hip_cooperative_groups.h>
#include <cstdio>
#include <cstdint>
namespace cg = cooperative_groups;

#define DEV __device__ __forceinline__
typedef unsigned short bf16;
using bf16x8 = __attribute__((ext_vector_type(8))) short;
using f32x4 = __attribute__((ext_vector_type(4))) float;

constexpr int Bn = 2, S = 16384, T = Bn * S, D = 1024;
constexpr int PC = 3456;
constexpr int WN = 4992;
constexpr int C_NQ = 0, C_KC = 512, C_VC = 640, C_MQ = 768, C_GN = 1280, C_GM = 2304, C_NG = 3328;
constexpr int NEXP = 16384;

constexpr size_t al(size_t x) { return (x + 255) & ~size_t(255); }
constexpr size_t OFF_MOD = 0;
constexpr size_t OFF_ROPE = al(OFF_MOD + 2 * 2 * 6144 * 4);
constexpr size_t OFF_PEB = al(OFF_ROPE + (size_t)S * 16 * 4);
constexpr size_t OFF_WINT = al(OFF_PEB + 2 * 2 * 128 * 4);
constexpr size_t OFF_WUPN = al(OFF_WINT + 2ull * WN * 1024 * 2);
constexpr size_t OFF_WUPM = al(OFF_WUPN + 2ull * 1024 * 512 * 2);
constexpr size_t OFF_WOUT = al(OFF_WUPM + 2ull * 1024 * 512 * 2);
constexpr size_t OFF_WQ = al(OFF_WOUT + 2ull * 1024 * 1024 * 2);
constexpr size_t OFF_KCC = al(OFF_WQ + 2ull * 2048 * 1024 * 2);
constexpr size_t OFF_VCC = al(OFF_KCC + 2ull * 1024 * 128 * 4);
constexpr size_t OFF_SEL = al(OFF_VCC + 2ull * 1024 * 128 * 4);
constexpr size_t OFF_KMEAN = al(OFF_SEL + 2ull * 2 * S * 16 * 4);
constexpr size_t OFF_KMHL = al(OFF_KMEAN + 2ull * 8 * 64 * 64 * 4);
constexpr size_t OFF_KCB = al(OFF_KMHL + 2ull * 2 * 8 * 64 * 64 * 2);
constexpr size_t OFF_VCB = al(OFF_KCB + 2ull * 2 * 1024 * 64 * 2);
constexpr size_t OFF_PKB = al(OFF_VCB + 2ull * 2 * 1024 * 64 * 2);
constexpr size_t OFF_W1T = al(OFF_PKB + 2ull * 2 * 128 * 128 * 2);
constexpr size_t OFF_BAR = al(OFF_W1T + 4ull * 128 * 2048 * 2);
constexpr size_t BAR_BYTES = 3456 * 4;
constexpr size_t OFF_PROBE = al(OFF_BAR + BAR_BYTES);
constexpr size_t OFF_H = al(OFF_PROBE + 256);
constexpr size_t OFF_ONSA = al(OFF_H + (size_t)T * 1024 * 2);
constexpr size_t OFF_OMOBA = al(OFF_ONSA + (size_t)T * 512 * 2);
constexpr size_t OFF_PROJ = al(OFF_OMOBA + (size_t)T * 512 * 2);
constexpr size_t KV2_BYTES = (size_t)Bn * 2 * S * 64 * 2, KV8_BYTES = (size_t)Bn * 8 * S * 64 * 2;
constexpr size_t OFF_KSB = al(OFF_PROJ + (size_t)T * PC * 2);
constexpr size_t OFF_VSB = OFF_KSB + KV2_BYTES;
constexpr size_t OFF_KWB = OFF_VSB + KV2_BYTES;
constexpr size_t OFF_VWB = OFF_KWB + KV2_BYTES;
constexpr size_t OFF_MKB = OFF_VWB + KV2_BYTES;
constexpr size_t OFF_MVB = OFF_MKB + KV8_BYTES;
constexpr int MLIST_PER_BH = 63 * S - 128 * 63 * 64;
constexpr size_t OFF_MLIST = OFF_MVB + KV8_BYTES;
constexpr size_t OFF_MCNT = al(OFF_MLIST + (size_t)Bn * 8 * MLIST_PER_BH * 2);
constexpr size_t WS_NEED = OFF_MCNT + (size_t)Bn * 8 * 64 * 4;
constexpr size_t PROJ_BYTES = (size_t)T * PC * 2;
constexpr size_t OFF_MPO = OFF_H;
constexpr size_t OFF_MPML = OFF_H + (size_t)8 * S * 3 * 64 * 2;
static_assert((size_t)8 * S * 3 * 64 * 2 + (size_t)8 * S * 3 * 8 <= (size_t)T * 1024 * 2, "moba partials must fit the H region");
constexpr size_t OFF_QP = OFF_PROJ;
constexpr size_t OFF_PEIDX = al(OFF_QP + (size_t)T * 2048 * 2);
constexpr size_t OFF_PEG = al(OFF_PEIDX + (size_t)T * 128 * 4);
constexpr size_t OFF_E8 = al(OFF_PEG + (size_t)T * 128 * 4);
constexpr size_t OFF_ESC = al(OFF_E8 + (size_t)NEXP * 2048);
static_assert(OFF_ESC + (size_t)NEXP * 2 * 4 <= OFF_PROJ + PROJ_BYTES, "peer alias overflow");
static_assert(WS_NEED <= 536870912ull, "workspace too big");
#ifndef PROBE_MOBA
#define PROBE_MOBA 0
#endif
constexpr size_t OFF_CMP = PROBE_MOBA ? OFF_ONSA : OFF_MLIST;
#ifndef REP_NSA_ONLY
#define REP_NSA_ONLY 0
#endif
#ifndef REP_NSA_PART
#define REP_NSA_PART 0
#endif
#ifndef REP_MASK
#define REP_MASK 0
#endif
#ifndef PROBE_MOBA
#define PROBE_MOBA 0
#endif
#ifndef PROBE_NSA
#define PROBE_NSA 0
#endif
#ifndef PROBE_CMPR
#define PROBE_CMPR 0
#endif
#ifndef PROBE_PROJ
#define PROBE_PROJ 0
#endif
#define PROBE_ANY (PROBE_MOBA || PROBE_NSA || PROBE_CMPR || PROBE_PROJ)
constexpr size_t WS_TOTAL = WS_NEED;
static_assert(WS_TOTAL <= 536870912ull, "workspace too big (probe)");

struct Params {
  const float *x, *c, *w_ada, *b_ada, *g_attn, *g_ffn, *w_in, *cmp_pe, *cmp_w1, *cmp_w2, *w_up_nsa, *w_up_moba, *w_out,
      *peer_wq, *peer_k1, *peer_k2, *peer_u, *peer_v, *g_final;
  float* out;
  char* ws;
};

constexpr int SMEM_BYTES = 74 * 1024;

DEV int tidx() {
  int t = threadIdx.x;
  asm volatile("" : "+v"(t));
  return t;
}
#define MFMA16B(a, b, c) __builtin_amdgcn_mfma_f32_16x16x32_bf16(a, b, c, 0, 0, 0)
DEV unsigned cvtpk_(float lo, float hi) {
  unsigned r;
  asm("v_cvt_pk_bf16_f32 %0, %1, %2" : "=v"(r) : "v"(lo), "v"(hi));
  return r;
}
DEV float bf2f(bf16 h) { return __uint_as_float(((unsigned)h) << 16); }
DEV bf16 f2bf(float f) {
  unsigned u = __float_as_uint(f);
  u += 0x7fffu + ((u >> 16) & 1u);
  return (bf16)(u >> 16);
}
DEV float gelu_tanh(float x) {
  float u = 0.7978845608028654f * (x + 0.044715f * x * x * x);
  return 0.5f * x * (1.f + tanhf(u));
}
DEV float sigmoidf_(float x) { return 1.f / (1.f + expf(-x)); }
DEV void unpack8(uint4 v, float* f) {
  f[0] = __uint_as_float(v.x << 16); f[1] = __uint_as_float(v.x & 0xffff0000u);
  f[2] = __uint_as_float(v.y << 16); f[3] = __uint_as_float(v.y & 0xffff0000u);
  f[4] = __uint_as_float(v.z << 16); f[5] = __uint_as_float(v.z & 0xffff0000u);
  f[6] = __uint_as_float(v.w << 16); f[7] = __uint_as_float(v.w & 0xffff0000u);
}
DEV float dot64_bf(const float* q, const bf16* row) {
  float s = 0.f;
#pragma unroll
  for (int i = 0; i < 8; ++i) {
    float f[8];
    unpack8(*(const uint4*)(row + i * 8), f);
#pragma unroll
    for (int j = 0; j < 8; ++j) s += q[i * 8 + j] * f[j];
  }
  return s;
}
DEV void axpy64_bf(float* o, float a, const bf16* row) {
#pragma unroll
  for (int i = 0; i < 8; ++i) {
    float f[8];
    unpack8(*(const uint4*)(row + i * 8), f);
#pragma unroll
    for (int j = 0; j < 8; ++j) o[i * 8 + j] += a * f[j];
  }
}
DEV float dot64_f(const float* q, const float* row) {
  float s = 0.f;
#pragma unroll
  for (int i = 0; i < 16; ++i) {
    float4 v = *(const float4*)(row + i * 4);
    s += q[i * 4] * v.x + q[i * 4 + 1] * v.y + q[i * 4 + 2] * v.z + q[i * 4 + 3] * v.w;
  }
  return s;
}
DEV void axpy64_f(float* o, float a, const float* row) {
#pragma unroll
  for (int i = 0; i < 16; ++i) {
    float4 v = *(const float4*)(row + i * 4);
    o[i * 4] += a * v.x; o[i * 4 + 1] += a * v.y; o[i * 4 + 2] += a * v.z; o[i * 4 + 3] += a * v.w;
  }
}
DEV void load_q64(float* q, const bf16* p, float scale) {
#pragma unroll
  for (int i = 0; i < 8; ++i) unpack8(*(const uint4*)(p + i * 8), q + i * 8);
#pragma unroll
  for (int i = 0; i < 64; ++i) q[i] *= scale;
}
DEV int lane_id_() { return __builtin_amdgcn_mbcnt_hi(~0u, __builtin_amdgcn_mbcnt_lo(~0u, 0u)); }
DEV int shx(int v, int m) {
  if (m == 1) return __builtin_amdgcn_update_dpp(0, v, 0xB1, 0xF, 0xF, true);
  if (m == 2) return __builtin_amdgcn_update_dpp(0, v, 0x4E, 0xF, 0xF, true);
  if (m == 4) return __builtin_amdgcn_ds_swizzle(v, 0x101F);
  if (m == 8) return __builtin_amdgcn_update_dpp(0, v, 0x128, 0xF, 0xF, true);
  if (m == 16) return __builtin_amdgcn_ds_swizzle(v, 0x401F);
  auto rr = __builtin_amdgcn_permlane32_swap((unsigned)v, (unsigned)v, false, false);
  return (lane_id_() < 32) ? (int)rr[1] : (int)rr[0];
}
DEV unsigned shx(unsigned v, int m) { return (unsigned)shx((int)v, m); }
DEV float shx(float v, int m) { return __int_as_float(shx(__float_as_int(v), m)); }
DEV float wave_sum(float v) {
#pragma unroll
  for (int o = 32; o >= 1; o >>= 1) v += shx(v, o);
  return v;
}

#define XB_TMO      128
#define XB_XCNT(j)  (256  + 64 * (j))
#define XB_XSUB(j)  (1280 + 64 * (j))
#define XB_XGEN(j)  (2304 + 64 * (j))
#define XB_TOP      3328
#define XB_TOPGEN   3392
#define XCD_BAR_WORDS 3456
#define XB_SPIN_CAP (1u << 18)
#define LAS __attribute__((address_space(3)))

__device__ __forceinline__ unsigned xb_ld(unsigned* p)              { return __hip_atomic_load(p, __ATOMIC_RELAXED, __HIP_MEMORY_SCOPE_AGENT); }
__device__ __forceinline__ unsigned xb_add(unsigned* p, unsigned v) { return __hip_atomic_fetch_add(p, v, __ATOMIC_RELAXED, __HIP_MEMORY_SCOPE_AGENT); }
__device__ __forceinline__ unsigned xb_xcc_id() { return (unsigned)__builtin_amdgcn_s_getreg((3 << 11) | 20) & 0xFu; }
#define XB_SPIN(cond, bar) do { unsigned _sp = 0; while (cond) { __builtin_amdgcn_s_sleep(1); \
    if ((++_sp & 255u) == 0u) { if (xb_ld(&(bar)[XB_TMO])) break; if (_sp > XB_SPIN_CAP) { atomicAdd(&(bar)[XB_TMO], 1u); break; } } } } while (0)

struct XcdBarrier {
    unsigned* bar; unsigned x;
    volatile LAS unsigned* st;
};

__device__ __forceinline__ XcdBarrier xcd_barrier_post(unsigned* bar, volatile LAS unsigned* st) {
    XcdBarrier b; b.bar = bar; b.x = xb_xcc_id(); b.st = st;
    if (tidx() == 0) (void)xb_add(&bar[XB_XCNT(b.x)], 1u);
    return b;
}
__device__ __forceinline__ void xcd_barrier_complete(unsigned* bar, unsigned x, unsigned& nloc, unsigned& nx) {
    const unsigned G = gridDim.x * gridDim.y * gridDim.z;
    unsigned sum, cnt, mine, sp = 0u;
    for (;;) {
        sum = 0u; cnt = 0u; mine = 0u;
#pragma unroll
        for (unsigned j = 0; j < 16; ++j) { const unsigned c = xb_ld(&bar[XB_XCNT(j)]); sum += c; cnt += (c > 0u) ? 1u : 0u; mine = (j == x) ? c : mine; }
        if (sum == G) break;
        __builtin_amdgcn_s_sleep(1);
        if ((++sp & 255u) == 0u) { if (xb_ld(&bar[XB_TMO])) break; if (sp > XB_SPIN_CAP) { atomicAdd(&bar[XB_TMO], 1u); break; } }
    }
    nloc = mine > 0u ? mine : 1u; nx = cnt > 0u ? cnt : 1u;
}

__device__ __forceinline__ void xcd_barrier(const XcdBarrier& b) {
    asm volatile("s_waitcnt vmcnt(0)" ::: "memory");
    __syncthreads();
    if (tidx() == 0) {
        unsigned* bar = b.bar;
        __builtin_amdgcn_s_waitcnt(0);
        unsigned nloc = b.st[0], nx = b.st[1];
        if (nloc == 0u) { xcd_barrier_complete(bar, b.x, nloc, nx); b.st[0] = nloc; b.st[1] = nx; }
        const unsigned old = xb_add(&bar[XB_XSUB(b.x)], 1u);
        const unsigned gen = old / nloc;
        if (old + 1u == (gen + 1u) * nloc) {
            __builtin_amdgcn_fence(__ATOMIC_RELEASE, "agent");
            asm volatile("s_waitcnt vmcnt(0)" ::: "memory");
            const unsigned og = xb_add(&bar[XB_TOP], 1u);
            const unsigned tg = og / nx;
            if (og + 1u == (tg + 1u) * nx) xb_add(&bar[XB_TOPGEN], 1u);
            else XB_SPIN(xb_ld(&bar[XB_TOPGEN]) == tg, bar);
            __builtin_amdgcn_fence(__ATOMIC_ACQUIRE, "agent");
            xb_add(&bar[XB_XGEN(b.x)], 1u);
            asm volatile("s_waitcnt vmcnt(0)" ::: "memory");
        } else {
            XB_SPIN(xb_ld(&bar[XB_XGEN(b.x)]) == gen, bar);
            __builtin_amdgcn_fence(__ATOMIC_ACQUIRE, "agent");
            asm volatile("s_waitcnt vmcnt(0)" ::: "memory");
        }
    }
    __syncthreads();
}


DEV int win_col_map(int j) {
  if (j < 1280) return j;
  if (j < 4864) return j + 24;
  if (j < 4888) return j - 4864 + 1280;
  return -1;
}
DEV void tr_tile(const float* __restrict__ src, int ldsrc, int K, bf16* __restrict__ dst, int kt, int nt, bool remap,
                 float* sm) {
  const int tid = tidx();
#pragma unroll 4
  for (int i = 0; i < 16; ++i) {
    int r = i * 4 + (tid >> 6), cx = tid & 63;
    int j = nt * 64 + cx, k = kt * 64 + r;
    int oc = remap ? win_col_map(j) : j;
    sm[r * 65 + cx] = (oc >= 0) ? src[(size_t)k * ldsrc + oc] : 0.f;
  }
  __syncthreads();
#pragma unroll 4
  for (int i = 0; i < 16; ++i) {
    int n = i * 4 + (tid >> 6), kk = tid & 63;
    dst[(size_t)(nt * 64 + n) * K + kt * 64 + kk] = f2bf(sm[kk * 65 + n]);
  }
  __syncthreads();
}

constexpr int PREP_TR_WIN = 2 * 78 * 16;
constexpr int PREP_TR_UPN = 2 * 16 * 8;
constexpr int PREP_TR_UPM = 2 * 16 * 8;
constexpr int PREP_TR_OUT = 2 * 16 * 16;
constexpr int PREP_TR_WQ = 2 * 32 * 16;
constexpr int PREP_ROPE = 512;
constexpr int PREP_MOD = 384;
constexpr int PREP_PEB = 16;
constexpr int PREP_PK = 32;
constexpr int PREP_TR_W1 = 4 * 2 * 32;
constexpr int PREP_ITEMS = PREP_TR_WIN + PREP_TR_UPN + PREP_TR_UPM + PREP_TR_OUT + PREP_TR_WQ + PREP_ROPE + PREP_MOD + PREP_PEB + PREP_PK + PREP_TR_W1;

DEV void prep_item(const Params& p, int item, float* sm) {
  const int tid = tidx();
  if (item < PREP_TR_WIN) {
    int l = item / (78 * 16), r = item % (78 * 16);
    int nt = r / 16, kt = r % 16;
    tr_tile(p.w_in + (size_t)l * 1024 * 4888, 4888, 1024, (bf16*)(p.ws + OFF_WINT) + (size_t)l * WN * 1024, kt, nt, true, sm);
    return;
  }
  item -= PREP_TR_WIN;
  if (item < PREP_TR_UPN) {
    int l = item / 128, r = item % 128;
    int nt = r / 8, kt = r % 8;
    tr_tile(p.w_up_nsa + (size_t)l * 512 * 1024, 1024, 512, (bf16*)(p.ws + OFF_WUPN) + (size_t)l * 1024 * 512, kt, nt, false, sm);
    return;
  }
  item -= PREP_TR_UPN;
  if (item < PREP_TR_UPM) {
    int l = item / 128, r = item % 128;
    int nt = r / 8, kt = r % 8;
    tr_tile(p.w_up_moba + (size_t)l * 512 * 1024, 1024, 512, (bf16*)(p.ws + OFF_WUPM) + (size_t)l * 1024 * 512, kt, nt, false, sm);
    return;
  }
  item -= PREP_TR_UPM;
  if (item < PREP_TR_OUT) {
    int l = item / 256, r = item % 256;
    int nt = r / 16, kt = r % 16;
    tr_tile(p.w_out + (size_t)l * 1024 * 1024, 1024, 1024, (bf16*)(p.ws + OFF_WOUT) + (size_t)l * 1024 * 1024, kt, nt, false, sm);
    return;
  }
  item -= PREP_TR_OUT;
  if (item < PREP_TR_WQ) {
    int l = item / 512, r = item % 512;
    int nt = r / 16, kt = r % 16;
    tr_tile(p.peer_wq + (size_t)l * 1024 * 2048, 2048, 1024, (bf16*)(p.ws + OFF_WQ) + (size_t)l * 2048 * 1024, kt, nt, false, sm);
    return;
  }
  item -= PREP_TR_WQ;
  if (item < PREP_ROPE) {
    int idx = item * 256 + tid;
    int pos = idx >> 3, i = idx & 7;
    float inv = powf(500000.0f, -(float)i / 8.0f);
    float ang = (float)pos * inv;
    float* rp = (float*)(p.ws + OFF_ROPE) + (size_t)pos * 16;
    rp[i] = cosf(ang);
    rp[8 + i] = sinf(ang);
    return;
  }
  item -= PREP_ROPE;
  if (item < PREP_MOD) {
    for (int i = tid; i < 2048; i += 256) {
      float cv = p.c[i];
      sm[i] = cv / (1.f + expf(-cv));
    }
    __syncthreads();
    const int l = item / 192, n0 = (item % 192) * 32;
    const int col = tid & 31, ks = tid >> 5;
    const float* w = p.w_ada + (size_t)l * 1024 * 6144 + n0 + col;
    float a0 = 0.f, a1 = 0.f;
#pragma unroll 8
    for (int k = ks * 128; k < ks * 128 + 128; ++k) {
      float wv = w[(size_t)k * 6144];
      a0 += sm[k] * wv;
      a1 += sm[1024 + k] * wv;
    }
    sm[2048 + tid * 2] = a0;
    sm[2048 + tid * 2 + 1] = a1;
    __syncthreads();
    if (tid < 64) {
      const int c2 = tid & 31, bs = tid >> 5;
      float s = 0.f;
#pragma unroll
      for (int q = 0; q < 8; ++q) s += sm[2048 + (q * 32 + c2) * 2 + bs];
      ((float*)(p.ws + OFF_MOD))[(l * 2 + bs) * 6144 + n0 + c2] = s + p.b_ada[l * 6144 + n0 + c2];
    }
    __syncthreads();
    return;
  }
  item -= PREP_MOD;
  if (item < PREP_PEB) {
    const int lw = item >> 2, j0 = (item & 3) * 32;
    const int col = tid & 31, ks = tid >> 5;
    const float* pe = p.cmp_pe + (size_t)lw * 2048;
    const float* w1 = p.cmp_w1 + (size_t)lw * 2048 * 128 + j0 + col;
    float a = 0.f;
#pragma unroll 8
    for (int i = ks * 256; i < ks * 256 + 256; ++i) a += pe[i] * w1[(size_t)i * 128];
    sm[tid] = a;
    __syncthreads();
    if (tid < 32) {
      float s = 0.f;
#pragma unroll
      for (int q = 0; q < 8; ++q) s += sm[q * 32 + tid];
      ((float*)(p.ws + OFF_PEB))[lw * 128 + j0 + tid] = s;
    }
    if (item == 0 && tid < 4) ((float*)(p.ws + OFF_PROBE))[tid] = 0.f;
    __syncthreads();
    return;
  }
  item -= PREP_PEB;
  if (item < PREP_PK) {
    const int e0 = item * 2048 + tid * 8;
    const int lt = e0 >> 14, off = e0 & 16383;
    const float* srcp = ((lt & 1) ? p.peer_k2 : p.peer_k1) + (size_t)(lt >> 1) * 16384 + off;
    const float4 a = *(const float4*)srcp, b4 = *(const float4*)(srcp + 4);
    uint4 pk;
    pk.x = (unsigned)f2bf(a.x) | ((unsigned)f2bf(a.y) << 16);
    pk.y = (unsigned)f2bf(a.z) | ((unsigned)f2bf(a.w) << 16);
    pk.z = (unsigned)f2bf(b4.x) | ((unsigned)f2bf(b4.y) << 16);
    pk.w = (unsigned)f2bf(b4.z) | ((unsigned)f2bf(b4.w) << 16);
    *(uint4*)((bf16*)(p.ws + OFF_PKB) + e0) = pk;
    return;
  }
  item -= PREP_PK;
  {
    const int lw = item >> 6, r = item & 63;
    const int nt = r >> 5, kt = r & 31;
    tr_tile(p.cmp_w1 + (size_t)lw * 2048 * 128, 128, 2048, (bf16*)(p.ws + OFF_W1T) + (size_t)lw * 128 * 2048, kt, nt, false, sm);
  }
}

DEV void norm_item(const float* __restrict__ xin, const float* __restrict__ g, const float* __restrict__ sc,
                   const float* __restrict__ sh, bf16* __restrict__ hout, int item) {
  const int lane = tidx() & 63, wave = tidx() >> 6;
  const size_t tok = (size_t)item * 4 + wave;
  const int b = (int)(tok / S);
  const float* xr = xin + tok * 1024;
  float4 v[4];
  float ss = 0.f;
#pragma unroll
  for (int i = 0; i < 4; ++i) {
    v[i] = *(const float4*)(xr + i * 256 + lane * 4);
    ss += v[i].x * v[i].x + v[i].y * v[i].y + v[i].z * v[i].z + v[i].w * v[i].w;
  }
  ss = wave_sum(ss);
  float r = 1.0f / sqrtf(ss * (1.0f / 1024.f) + 1e-6f);
#pragma unroll
  for (int i = 0; i < 4; ++i) {
    int d = i * 256 + lane * 4;
    float4 gg = *(const float4*)(g + d);
    float4 s4 = *(const float4*)(sc + b * 6144 + d);
    float4 h4 = *(const float4*)(sh + b * 6144 + d);
    float o0 = v[i].x * r * gg.x * (1.f + s4.x) + h4.x;
    float o1 = v[i].y * r * gg.y * (1.f + s4.y) + h4.y;
    float o2 = v[i].z * r * gg.z * (1.f + s4.z) + h4.z;
    float o3 = v[i].w * r * gg.w * (1.f + s4.w) + h4.w;
    uint2 pk;
    pk.x = (unsigned)f2bf(o0) | ((unsigned)f2bf(o1) << 16);
    pk.y = (unsigned)f2bf(o2) | ((unsigned)f2bf(o3) << 16);
    *(uint2*)(hout + tok * 1024 + d) = pk;
  }
}
DEV void final_norm_item(float* __restrict__ x, const float* __restrict__ g, int item) {
  const int lane = tidx() & 63, wave = tidx() >> 6;
  const size_t tok = (size_t)item * 4 + wave;
  float* xr = x + tok * 1024;
  float4 v[4];
  float ss = 0.f;
#pragma unroll
  for (int i = 0; i < 4; ++i) {
    v[i] = *(const float4*)(xr + i * 256 + lane * 4);
    ss += v[i].x * v[i].x + v[i].y * v[i].y + v[i].z * v[i].z + v[i].w * v[i].w;
  }
  ss = wave_sum(ss);
  float r = 1.0f / sqrtf(ss * (1.0f / 1024.f) + 1e-6f);
#pragma unroll
  for (int i = 0; i < 4; ++i) {
    int d = i * 256 + lane * 4;
    float4 gg = *(const float4*)(g + d);
    float4 o;
    o.x = v[i].x * r * gg.x; o.y = v[i].y * r * gg.y; o.z = v[i].z * r * gg.z; o.w = v[i].w * r * gg.w;
    *(float4*)(xr + d) = o;
  }
}

#define GM_BUF (2 * 128 * 72)
#define GM_LOAD(R, kk)                                                                                  \
  {                                                                                                     \
    const bf16* Ak = Ap + (kk);                                                                         \
    const bf16* Wk = Wp + (kk);                                                                         \
    R##a0 = *(const uint4*)(Ak); R##a1 = *(const uint4*)(Ak + a32); R##a2 = *(const uint4*)(Ak + 2 * a32); \
    R##a3 = *(const uint4*)(Ak + 3 * a32);                                                              \
    R##b0 = *(const uint4*)(Wk); R##b1 = *(const uint4*)(Wk + w32); R##b2 = *(const uint4*)(Wk + 2 * w32); \
    R##b3 = *(const uint4*)(Wk + 3 * w32);                                                              \
  }
#define GM_STORE(R, buf)                                                                                \
  {                                                                                                     \
    bf16* as_ = Asw + (buf) * GM_BUF;                                                                   \
    bf16* bs_ = as_ + 128 * 72;                                                                         \
    *(uint4*)(as_) = R##a0; *(uint4*)(as_ + 32 * 72) = R##a1; *(uint4*)(as_ + 64 * 72) = R##a2; *(uint4*)(as_ + 96 * 72) = R##a3; \
    *(uint4*)(bs_) = R##b0; *(uint4*)(bs_ + 32 * 72) = R##b1; *(uint4*)(bs_ + 64 * 72) = R##b2; *(uint4*)(bs_ + 96 * 72) = R##b3; \
  }
#define GM_COMPUTE(buf)                                                                                 \
  {                                                                                                     \
    const bf16* As_ = sm + (buf) * GM_BUF;                                                              \
    const bf16* Bs_ = As_ + 128 * 72;                                                                   \
    _Pragma("unroll") for (int ks = 0; ks < 2; ++ks) {                                                  \
      __builtin_amdgcn_sched_barrier(0);                                                                \
      bf16x8 af[4], bfr[4];                                                                             \
      _Pragma("unroll") for (int mi = 0; mi < 4; ++mi)                                                  \
        af[mi] = *(const bf16x8*)(As_ + (wr * 64 + mi * 16 + (lane & 15)) * 72 + ks * 32 + (lane >> 4) * 8); \
      _Pragma("unroll") for (int ni = 0; ni < 4; ++ni)                                                  \
        bfr[ni] = *(const bf16x8*)(Bs_ + (wc * 64 + ni * 16 + (lane & 15)) * 72 + ks * 32 + (lane >> 4) * 8); \
      _Pragma("unroll") for (int mi = 0; mi < 4; ++mi)                                                  \
        _Pragma("unroll") for (int ni = 0; ni < 4; ++ni)                                                \
          acc[mi][ni] = __builtin_amdgcn_mfma_f32_16x16x32_bf16(af[mi], bfr[ni], acc[mi][ni], 0, 0, 0); \
    }                                                                                                   \
    __builtin_amdgcn_sched_barrier(0);                                                                  \
  }
DEV void gemm_mainloop(const bf16* __restrict__ A, int lda, const bf16* __restrict__ W, int K, int m0, int n0, bf16* sm,
                       f32x4 (&acc)[4][4]) {
  const int tid = tidx(), lane = tid & 63, wave = tid >> 6;
  const int wr = wave >> 1, wc = wave & 1;
  const int lrow = tid >> 3, lkc = (tid & 7) * 8;
  const bf16* Ap = A + (size_t)(m0 + lrow) * lda + lkc;
  const bf16* Wp = W + (size_t)(n0 + lrow) * K + lkc;
  const int a32 = 32 * lda, w32 = 32 * K;
  bf16* Asw = sm + lrow * 72 + lkc;
  uint4 xa0, xa1, xa2, xa3, xb0, xb1, xb2, xb3, ya0, ya1, ya2, ya3, yb0, yb1, yb2, yb3;
  const int nk = K >> 6;
  GM_LOAD(x, 0)
  GM_LOAD(y, 64)
  __syncthreads();
  GM_STORE(x, 0)
  if (nk > 2) GM_LOAD(x, 128)
  __syncthreads();
  for (int k = 0; k < nk; k += 2) {
    GM_COMPUTE(0)
    GM_STORE(y, 1)
    if (k + 3 < nk) GM_LOAD(y, (k + 3) * 64)
    __syncthreads();
    GM_COMPUTE(1)
    if (k + 2 < nk) {
      GM_STORE(x, 0)
      if (k + 4 < nk) GM_LOAD(x, (k + 4) * 64)
    }
    __syncthreads();
  }
}
DEV void gemm256_mainloop(const bf16* __restrict__ A, int lda, const bf16* __restrict__ W, int K, int m0, int n0, bf16* sm,
                          f32x4 (&acc)[2][4][4]) {
  bf16* As = sm;
  bf16* Bs = sm + 256 * 72;
  const int tid = tidx(), lane = tid & 63, wave = tid >> 6;
  const int wr = wave >> 1, wc = wave & 1;
  const int lrow = tid >> 3, lkc = (tid & 7) * 8;
  const bf16* Ap = A + (size_t)(m0 + lrow) * lda + lkc;
  const bf16* Wp = W + (size_t)(n0 + lrow) * K + lkc;
  const int a32 = 32 * lda, w32 = 32 * K;
  uint4 ra0, ra1, ra2, ra3, ra4, ra5, ra6, ra7, rb0, rb1, rb2, rb3;
#define G256_LOAD(kk)                                                                                   \
  {                                                                                                     \
    const bf16* Ak = Ap + (kk);                                                                         \
    const bf16* Wk = Wp + (kk);                                                                         \
    ra0 = *(const uint4*)(Ak); ra1 = *(const uint4*)(Ak + a32); ra2 = *(const uint4*)(Ak + 2 * a32);    \
    ra3 = *(const uint4*)(Ak + 3 * a32); ra4 = *(const uint4*)(Ak + 4 * a32); ra5 = *(const uint4*)(Ak + 5 * a32); \
    ra6 = *(const uint4*)(Ak + 6 * a32); ra7 = *(const uint4*)(Ak + 7 * a32);                           \
    rb0 = *(const uint4*)(Wk); rb1 = *(const uint4*)(Wk + w32); rb2 = *(const uint4*)(Wk + 2 * w32);    \
    rb3 = *(const uint4*)(Wk + 3 * w32);                                                                \
  }
  G256_LOAD(0)
  bf16* Asw = As + lrow * 72 + lkc;
  bf16* Bsw = Bs + lrow * 72 + lkc;
  for (int k0 = 0; k0 < K; k0 += 64) {
    __syncthreads();
    *(uint4*)(Asw) = ra0; *(uint4*)(Asw + 32 * 72) = ra1; *(uint4*)(Asw + 64 * 72) = ra2; *(uint4*)(Asw + 96 * 72) = ra3;
    *(uint4*)(Asw + 128 * 72) = ra4; *(uint4*)(Asw + 160 * 72) = ra5; *(uint4*)(Asw + 192 * 72) = ra6; *(uint4*)(Asw + 224 * 72) = ra7;
    *(uint4*)(Bsw) = rb0; *(uint4*)(Bsw + 32 * 72) = rb1; *(uint4*)(Bsw + 64 * 72) = rb2; *(uint4*)(Bsw + 96 * 72) = rb3;
    __syncthreads();
    if (k0 + 64 < K) G256_LOAD(k0 + 64)
#pragma unroll
    for (int ks = 0; ks < 2; ++ks) {
      bf16x8 bfr[4];
#pragma unroll
      for (int ni = 0; ni < 4; ++ni)
        bfr[ni] = *(const bf16x8*)(Bs + (wc * 64 + ni * 16 + (lane & 15)) * 72 + ks * 32 + (lane >> 4) * 8);
#pragma unroll
      for (int h = 0; h < 2; ++h) {
        __builtin_amdgcn_sched_barrier(0);
        bf16x8 af[4];
#pragma unroll
        for (int mi = 0; mi < 4; ++mi)
          af[mi] = *(const bf16x8*)(As + (wr * 128 + h * 64 + mi * 16 + (lane & 15)) * 72 + ks * 32 + (lane >> 4) * 8);
#pragma unroll
        for (int mi = 0; mi < 4; ++mi)
#pragma unroll
          for (int ni = 0; ni < 4; ++ni)
            acc[h][mi][ni] = __builtin_amdgcn_mfma_f32_16x16x32_bf16(af[mi], bfr[ni], acc[h][mi][ni], 0, 0, 0);
      }
    }
  }
}
DEV void acc_zero(f32x4 (&acc)[4][4]) {
#pragma unroll
  for (int i = 0; i < 4; ++i)
#pragma unroll
    for (int j = 0; j < 4; ++j) acc[i][j] = f32x4{0.f, 0.f, 0.f, 0.f};
}
DEV void store_tile_bf16(bf16* sm, const f32x4 (&acc)[4][4], bf16* __restrict__ dbase, size_t dstride) {
  const int tid = tidx(), lane = tid & 63, wave = tid >> 6, g4 = lane >> 4, c16 = lane & 15;
  bf16* Cw = sm + wave * (64 * 72);
  __syncthreads();
#pragma unroll
  for (int mi = 0; mi < 4; ++mi)
#pragma unroll
    for (int ni = 0; ni < 4; ++ni)
#pragma unroll
      for (int r = 0; r < 4; ++r) Cw[(mi * 16 + g4 * 4 + r) * 72 + ni * 16 + c16] = f2bf(acc[mi][ni][r]);
  __syncthreads();
#pragma unroll
  for (int it = 0; it < 8; ++it) {
    const int row_l = it * 8 + (lane >> 3), ch = lane & 7;
    const uint4 v = *(const uint4*)(Cw + row_l * 72 + ch * 8);
    *(uint4*)(dbase + (size_t)row_l * dstride + ch * 8) = v;
  }
}
template <class Epi>
DEV void gemm_tile(const bf16* __restrict__ A, int lda, const bf16* __restrict__ W, int K, int m0, int n0, bf16* sm,
                   Epi epi) {
  f32x4 acc[4][4];
  acc_zero(acc);
  gemm_mainloop(A, lda, W, K, m0, n0, sm, acc);
  const int tid = tidx(), lane = tid & 63, wave = tid >> 6;
  const int wr = wave >> 1, wc = wave & 1;
#pragma unroll
  for (int mi = 0; mi < 4; ++mi)
#pragma unroll
    for (int ni = 0; ni < 4; ++ni)
#pragma unroll
      for (int r = 0; r < 4; ++r) {
        int row = m0 + wr * 64 + mi * 16 + (lane >> 4) * 4 + r;
        int col = n0 + wc * 64 + ni * 16 + (lane & 15);
        epi(row, col, acc[mi][ni][r]);
      }
}
DEV void inproj_epilogue(const Params& p, f32x4 (&acc)[4][4], int row0, int vc0, bf16* sm) {
  const int tid = tidx(), lane = tid & 63, g4 = lane >> 4, c16 = lane & 15;
  const int b = row0 / S, t0 = row0 % S;
  bf16* dbase;
  size_t dstride;
  bool roped = false;
  bf16* projp = (bf16*)(p.ws + OFF_PROJ) + (size_t)row0 * PC;
  if (vc0 < 768) { dbase = projp + vc0; dstride = PC; }
  else if (vc0 < 1280) {
    const int seg = (vc0 - 768) >> 7, head = ((vc0 - 768) >> 6) & 1;
    const size_t off = (seg == 0) ? OFF_KSB : (seg == 1) ? OFF_VSB : (seg == 2) ? OFF_KWB : OFF_VWB;
    dbase = (bf16*)(p.ws + off) + ((size_t)(b * 2 + head) * S + t0) * 64;
    dstride = 64;
    roped = (seg == 0) || (seg == 2);
  } else if (vc0 < 1792) { dbase = projp + C_MQ + (vc0 - 1280); dstride = PC; roped = true; }
  else if (vc0 < 2816) {
    const int seg = (vc0 - 1792) >> 9, head = ((vc0 - 1792) >> 6) & 7;
    dbase = (bf16*)(p.ws + (seg ? OFF_MVB : OFF_MKB)) + ((size_t)(b * 8 + head) * S + t0) * 64;
    dstride = 64;
    roped = (seg == 0);
  } else if (vc0 < 4864) { dbase = projp + C_GN + (vc0 - 2816); dstride = PC; }
  else { dbase = projp + C_NG + (vc0 - 4864); dstride = PC; }
  if (roped) {
    const float* rope = (const float*)(p.ws + OFF_ROPE);
#pragma unroll
    for (int mi = 0; mi < 4; ++mi)
#pragma unroll
      for (int r = 0; r < 4; ++r) {
        const int pos = t0 + mi * 16 + g4 * 4 + r;
        const float v = acc[mi][0][r];
        const float pv = shx(v, 8);
        const float cs = rope[pos * 16 + (c16 & 7)], sn = rope[pos * 16 + 8 + (c16 & 7)];
        acc[mi][0][r] = (c16 < 8) ? (v * cs - pv * sn) : (v * cs + pv * sn);
      }
  }
  store_tile_bf16(sm, acc, dbase, dstride);
}
DEV void inproj_tile256(const Params& p, int layer, int m0, int n0, bf16* sm) {
  f32x4 acc[2][4][4];
  acc_zero(acc[0]);
  acc_zero(acc[1]);
  gemm256_mainloop((const bf16*)(p.ws + OFF_H), 1024, (const bf16*)(p.ws + OFF_WINT) + (size_t)layer * WN * 1024, 1024, m0, n0, sm, acc);
  const int wave = tidx() >> 6, wr = wave >> 1, wc = wave & 1;
  inproj_epilogue(p, acc[0], m0 + wr * 128, n0 + wc * 64, sm);
  inproj_epilogue(p, acc[1], m0 + wr * 128 + 64, n0 + wc * 64, sm);
}
typedef unsigned u32x2_t __attribute__((ext_vector_type(2)));
DEV void merge_tile(const Params& p, int layer, int m0, int n0, bf16* sm) {
  const int tid = tidx(), lane = tid & 63, wave = tid >> 6, g4 = lane >> 4, c16 = lane & 15;
  const int wr = wave >> 1, wc = wave & 1;
  const bf16* projg = (const bf16*)(p.ws + OFF_PROJ) + (size_t)(m0 + wr * 64 + g4 * 4) * PC + n0 + wc * 64 + c16;
  f32x4 acc[4][4];
  acc_zero(acc);
  gemm_mainloop((const bf16*)(p.ws + OFF_ONSA), 512, (const bf16*)(p.ws + OFF_WUPN) + (size_t)layer * 1024 * 512, 512, m0, n0, sm, acc);
  bf16* yg = (bf16*)(p.ws + OFF_H) + (size_t)(m0 + wr * 64 + g4 * 4) * 1024 + n0 + wc * 64 + c16;
#pragma unroll
  for (int mi = 0; mi < 4; ++mi)
#pragma unroll
    for (int ni = 0; ni < 4; ++ni)
#pragma unroll
      for (int r = 0; r < 4; ++r)
        yg[(size_t)(mi * 16 + r) * 1024 + ni * 16] =
            f2bf(sigmoidf_(bf2f(projg[(size_t)(mi * 16 + r) * PC + C_GN + ni * 16])) * acc[mi][ni][r]);
  acc_zero(acc);
  gemm_mainloop((const bf16*)(p.ws + OFF_OMOBA), 512, (const bf16*)(p.ws + OFF_WUPM) + (size_t)layer * 1024 * 512, 512, m0, n0, sm, acc);
#pragma unroll
  for (int mi = 0; mi < 4; ++mi)
#pragma unroll
    for (int ni = 0; ni < 4; ++ni)
#pragma unroll
      for (int r = 0; r < 4; ++r)
        acc[mi][ni][r] = bf2f(yg[(size_t)(mi * 16 + r) * 1024 + ni * 16]) +
                         sigmoidf_(bf2f(projg[(size_t)(mi * 16 + r) * PC + C_GM + ni * 16])) * acc[mi][ni][r];
  store_tile_bf16(sm, acc, (bf16*)(p.ws + OFF_H) + (size_t)(m0 + wr * 64) * 1024 + n0 + wc * 64, 1024);
}

DEV void merge_tile256(const Params& p, int layer, int m0, int n0, bf16* sm) {
  const int tid = tidx(), lane = tid & 63, wave = tid >> 6, g4 = lane >> 4, c16 = lane & 15;
  const int wr = wave >> 1, wc = wave & 1;
  f32x4 acc[2][4][4];
  acc_zero(acc[0]);
  acc_zero(acc[1]);
  gemm256_mainloop((const bf16*)(p.ws + OFF_ONSA), 512, (const bf16*)(p.ws + OFF_WUPN) + (size_t)layer * 1024 * 512, 512, m0, n0, sm, acc);
#pragma unroll
  for (int h = 0; h < 2; ++h) {
    const size_t rb = (size_t)(m0 + wr * 128 + h * 64 + g4 * 4);
    const bf16* projg = (const bf16*)(p.ws + OFF_PROJ) + rb * PC + n0 + wc * 64 + c16;
    bf16* yg = (bf16*)(p.ws + OFF_H) + rb * 1024 + n0 + wc * 64 + c16;
#pragma unroll
    for (int mi = 0; mi < 4; ++mi)
#pragma unroll
      for (int ni = 0; ni < 4; ++ni)
#pragma unroll
        for (int r = 0; r < 4; ++r)
          yg[(size_t)(mi * 16 + r) * 1024 + ni * 16] =
              f2bf(sigmoidf_(bf2f(projg[(size_t)(mi * 16 + r) * PC + C_GN + ni * 16])) * acc[h][mi][ni][r]);
  }
  acc_zero(acc[0]);
  acc_zero(acc[1]);
  gemm256_mainloop((const bf16*)(p.ws + OFF_OMOBA), 512, (const bf16*)(p.ws + OFF_WUPM) + (size_t)layer * 1024 * 512, 512, m0, n0, sm, acc);
#pragma unroll
  for (int h = 0; h < 2; ++h) {
    const size_t rb = (size_t)(m0 + wr * 128 + h * 64 + g4 * 4);
    const bf16* projg = (const bf16*)(p.ws + OFF_PROJ) + rb * PC + n0 + wc * 64 + c16;
    const bf16* yg = (const bf16*)(p.ws + OFF_H) + rb * 1024 + n0 + wc * 64 + c16;
#pragma unroll
    for (int mi = 0; mi < 4; ++mi)
#pragma unroll
      for (int ni = 0; ni < 4; ++ni)
#pragma unroll
        for (int r = 0; r < 4; ++r)
          acc[h][mi][ni][r] = bf2f(yg[(size_t)(mi * 16 + r) * 1024 + ni * 16]) +
                              sigmoidf_(bf2f(projg[(size_t)(mi * 16 + r) * PC + C_GM + ni * 16])) * acc[h][mi][ni][r];
    store_tile_bf16(sm, acc[h], (bf16*)(p.ws + OFF_H) + (size_t)(m0 + wr * 128 + h * 64) * 1024 + n0 + wc * 64, 1024);
  }
}

DEV void compress_item(const Params& p, int layer, int item, float* sm) {
  const int tid = tidx();
  const int grp = item & 127, which = (item >> 7) & 1, kvh = (item >> 8) & 1, b = item >> 9;
  const int c0 = grp * 8;
  float* xs = sm;
  float* hs = sm + 144 * 64;
  const bf16* proj = (const bf16*)(p.ws + OFF_PROJ);
  const int col = (which ? C_VC : C_KC) + kvh * 64;
  for (int i = tid; i < 144 * 64; i += 256) {
    int tl = i >> 6, d = i & 63;
    int t = c0 * 16 + tl;
    xs[i] = (t < S) ? bf2f(proj[((size_t)b * S + t) * PC + col + d]) : 0.f;
  }
  __syncthreads();
  const int lw = layer * 2 + which;
  if (tid < 128) {
    const float* w1 = p.cmp_w1 + (size_t)lw * 2048 * 128 + tid;
    float acc[8];
#pragma unroll
    for (int ci = 0; ci < 8; ++ci) acc[ci] = 0.f;
    for (int l = 0; l < 32; ++l) {
#pragma unroll 4
      for (int d = 0; d < 64; ++d) {
        float w = w1[(size_t)(l * 64 + d) * 128];
#pragma unroll
        for (int ci = 0; ci < 8; ++ci) acc[ci] += xs[(ci * 16 + l) * 64 + d] * w;
      }
    }
    float pb = ((const float*)(p.ws + OFF_PEB))[lw * 128 + tid];
#pragma unroll
    for (int ci = 0; ci < 8; ++ci) hs[ci * 128 + tid] = gelu_tanh(acc[ci] + pb);
  }
  __syncthreads();
  const float* w2 = p.cmp_w2 + (size_t)lw * 128 * 64;
  float* outp = PROBE_CMPR ? ((float*)(p.ws + OFF_CMP) + (which ? (size_t)Bn * 1024 * 128 : 0)) : (float*)(p.ws + (which ? OFF_VCC : OFF_KCC));
#pragma unroll
  for (int rr = 0; rr < 2; ++rr) {
    int o = rr * 256 + tid;
    int ci = o >> 6, d = o & 63;
    int c = c0 + ci;
    float a = 0.f;
    for (int j = 0; j < 128; ++j) a += hs[ci * 128 + j] * w2[j * 64 + d];
    if (c < 1023) outp[(((size_t)b * 1024 + c) * 2 + kvh) * 64 + d] = a;
    bf16* outb = (bf16*)(p.ws + (which ? OFF_VCB : OFF_KCB));
    if (!PROBE_CMPR && c < 1024) outb[(((size_t)b * 2 + kvh) * 1024 + c) * 64 + d] = (c < 1023) ? f2bf(a) : (bf16)0;
  }
  __syncthreads();
}

DEV void compress_mfma_item(const Params& p, int layer, int item, char* smem) {
  bf16* xs = (bf16*)smem;
  float* hs = (float*)(smem + 272 * 64 * 2);
  const int tid = tidx(), lane = tid & 63, wave = tid >> 6, g4 = lane >> 4, c16 = lane & 15;
  const int cblk = item & 63, which = (item >> 6) & 1, kvh = (item >> 7) & 1, b = item >> 8;
  const int t0 = cblk * 256;
  const bf16* proj = (const bf16*)(p.ws + OFF_PROJ) + (size_t)b * S * PC + (which ? C_VC : C_KC) + kvh * 64;
  __syncthreads();
  for (int i = tid; i < 272 * 8; i += 256) {
    const int tl = i >> 3, ch = i & 7;
    const int t = t0 + tl;
    uint4 v = uint4{0u, 0u, 0u, 0u};
    if (t < S) v = *(const uint4*)(proj + (size_t)t * PC + ch * 8);
    *(uint4*)(xs + tl * 64 + ((ch ^ ((tl >> 4) & 7)) * 8)) = v;
  }
  __syncthreads();
  const int lw = layer * 2 + which;
  const bf16* w1t = (const bf16*)(p.ws + OFF_W1T) + (size_t)lw * 128 * 2048;
  f32x4 acc0 = f32x4{0.f, 0.f, 0.f, 0.f}, acc1 = f32x4{0.f, 0.f, 0.f, 0.f};
  const bf16* wb0 = w1t + (size_t)((2 * wave) * 16 + c16) * 2048 + g4 * 8;
  const bf16* wb1 = w1t + (size_t)((2 * wave + 1) * 16 + c16) * 2048 + g4 * 8;
#pragma unroll 4
  for (int ks = 0; ks < 64; ++ks) {
    const int l = ks >> 1, ch = (ks & 1) * 4 + g4;
    const int tl = 16 * c16 + l;
    const bf16x8 af = *(const bf16x8*)(xs + tl * 64 + ((ch ^ ((tl >> 4) & 7)) * 8));
    const bf16x8 b0 = *(const bf16x8*)(wb0 + ks * 32);
    const bf16x8 b1 = *(const bf16x8*)(wb1 + ks * 32);
    acc0 = MFMA16B(af, b0, acc0);
    acc1 = MFMA16B(af, b1, acc1);
  }
  {
    const float* peb = (const float*)(p.ws + OFF_PEB) + lw * 128;
    const int j0 = (2 * wave) * 16 + c16, j1 = j0 + 16;
    const float pb0 = peb[j0], pb1 = peb[j1];
#pragma unroll
    for (int r = 0; r < 4; ++r) {
      hs[(g4 * 4 + r) * 128 + j0] = gelu_tanh(acc0[r] + pb0);
      hs[(g4 * 4 + r) * 128 + j1] = gelu_tanh(acc1[r] + pb1);
    }
  }
  __syncthreads();
  const float* w2 = p.cmp_w2 + (size_t)lw * 128 * 64;
  const int d = tid & 63, cq = tid >> 6;
  float o0 = 0.f, o1 = 0.f, o2 = 0.f, o3 = 0.f;
#pragma unroll 8
  for (int j = 0; j < 128; ++j) {
    const float w = w2[j * 64 + d];
    o0 += hs[(cq * 4 + 0) * 128 + j] * w;
    o1 += hs[(cq * 4 + 1) * 128 + j] * w;
    o2 += hs[(cq * 4 + 2) * 128 + j] * w;
    o3 += hs[(cq * 4 + 3) * 128 + j] * w;
  }
  float* outp = (float*)(p.ws + (which ? OFF_VCC : OFF_KCC));
  bf16* outb = (bf16*)(p.ws + (which ? OFF_VCB : OFF_KCB));
  const float ov[4] = {o0, o1, o2, o3};
#pragma unroll
  for (int i = 0; i < 4; ++i) {
    const int c = cblk * 16 + cq * 4 + i;
    if (c < 1023) outp[(((size_t)b * 1024 + c) * 2 + kvh) * 64 + d] = ov[i];
    outb[(((size_t)b * 2 + kvh) * 1024 + c) * 64 + d] = (c < 1023) ? f2bf(ov[i]) : (bf16)0;
  }
  __syncthreads();
}

DEV void n1_item(const Params& p, int layer, int item, float* sm) {
  const int chunk = item & 255, kvh = (item >> 8) & 1, b = item >> 9;
  const int tid = tidx(), ql = tid >> 2, g = tid & 3;
  const int t = chunk * 64 + ql, h = kvh * 4 + g;
  const size_t tok = (size_t)b * S + t;
  const bf16* proj = (const bf16*)(p.ws + OFF_PROJ);
  float* imp = sm;
  for (int i = tid; i < 64 * 257; i += 256) imp[i] = 0.f;
  float q[64];
  load_q64(q, proj + tok * PC + C_NQ + h * 64, 0.125f);
  const int nv = (t >= 31) ? (((t - 31) >> 4) + 1) : 0;
  const int nv_max = (((chunk * 64 + 63) - 31) >> 4) + 1;
  const float* kc = (const float*)(p.ws + OFF_KCC) + (size_t)b * 1024 * 128 + kvh * 64;
  const float* vc = (const float*)(p.ws + OFF_VCC) + (size_t)b * 1024 * 128 + kvh * 64;
  float m = -INFINITY, l = 0.f;
  for (int c = 0; c < nv_max; ++c) {
    float s = dot64_f(q, kc + (size_t)c * 128);
    if (c < nv) {
      float mn = fmaxf(m, s);
      l = l * expf(m - mn) + expf(s - mn);
      m = mn;
    }
  }
  __syncthreads();
  float o[64];
#pragma unroll
  for (int d = 0; d < 64; ++d) o[d] = 0.f;
  const float inv_l = (nv > 0) ? 1.f / l : 0.f;
  for (int c = 0; c < nv_max; ++c) {
    float s = dot64_f(q, kc + (size_t)c * 128);
    float pr = (c < nv) ? expf(s - m) * inv_l : 0.f;
    axpy64_f(o, pr, vc + (size_t)c * 128);
    float ps = pr;
    ps += shx(ps, 1);
    ps += shx(ps, 2);
    if (g == 0) {
      int n = c >> 2;
      if ((c & 3) == 3) {
        imp[ql * 257 + n] += 0.5f * ps;
        imp[ql * 257 + n + 1] += 0.5f * ps;
      } else {
        imp[ql * 257 + n] += ps;
      }
    }
  }
  const float gate0 = (!PROBE_NSA || (PROBE_NSA & 1)) ? sigmoidf_(bf2f(proj[tok * PC + C_NG + h * 3 + 0])) : 0.f;
  float* oa = (float*)(p.ws + OFF_H) + tok * 512 + h * 64;
#pragma unroll
  for (int d = 0; d < 64; d += 4) {
    float4 v = {gate0 * o[d], gate0 * o[d + 1], gate0 * o[d + 2], gate0 * o[d + 3]};
    *(float4*)(oa + d) = v;
  }
  __syncthreads();
#if PROBE_NSA == 8
  if (b == 0 && kvh == 0)
    for (int i = tid; i < 64 * 256; i += 256)
      ((float*)(p.ws + OFF_OMOBA))[(size_t)(chunk * 64 + (i >> 8)) * 256 + (i & 255)] = imp[(i >> 8) * 257 + (i & 255)];
  __syncthreads();
#endif
  if (g == 0) {
    int* selp = (int*)(p.ws + OFF_SEL) + (((size_t)b * 2 + kvh) * S + t) * 16;
    const int cur = chunk;
    if (cur < 16) {
      for (int j = 0; j < 16; ++j) selp[j] = (j <= cur) ? j : -1;
    } else {
      selp[0] = 0;
      selp[1] = cur - 1;
      selp[2] = cur;
      float* row = imp + ql * 257;
      for (int j = 3; j < 16; ++j) {
        float best = -1.f;
        int bi = 1;
        for (int n = 1; n <= cur - 2; ++n) {
          float v = row[n];
          if (v > best) { best = v; bi = n; }
        }
        selp[j] = bi;
        row[bi] = -2.f;
      }
    }
  }
  __syncthreads();
}

DEV void kmean_item(const Params& p, int item, float* sm) {
  const int n = item & 63, h = (item >> 6) & 7, b = item >> 9;
  const int tid = tidx(), d = tid & 63, part = tid >> 6;
  const bf16* mkb = (const bf16*)(p.ws + OFF_MKB);
  float a = 0.f;
  for (int i = 0; i < 64; ++i) {
    int t = n * 256 + part * 64 + i;
    a += bf2f(mkb[((size_t)(b * 8 + h) * S + t) * 64 + d]);
  }
  sm[tid] = a;
  __syncthreads();
  if (tid < 64) {
    float s = sm[tid] + sm[64 + tid] + sm[128 + tid] + sm[192 + tid];
    const size_t ko = (((size_t)b * 8 + h) * 64 + n) * 64 + tid;
    const float mean = s * (1.f / 256.f);
    ((float*)(p.ws + OFF_KMEAN))[ko] = mean;
    const bf16 hi = f2bf(mean);
    ((bf16*)(p.ws + OFF_KMHL))[ko] = hi;
    ((bf16*)(p.ws + OFF_KMHL))[(size_t)2 * 8 * 64 * 64 + ko] = f2bf(mean - bf2f(hi));
    if (tid == 0) ((int*)(p.ws + OFF_MCNT))[(b * 8 + h) * 64 + n] = 0;
  }
  __syncthreads();
}

DEV void n23_item(const Params& p, int layer, int item) {
  const int chunk = item & 255, kvh = (item >> 8) & 1, b = item >> 9;
  const int tid = tidx(), ql = tid >> 2, g = tid & 3;
  const int t = chunk * 64 + ql, h = kvh * 4 + g;
  const size_t tok = (size_t)b * S + t;
  const bf16* proj = (const bf16*)(p.ws + OFF_PROJ);
  const float* rope = (const float*)(p.ws + OFF_ROPE) + (size_t)t * 16;
  float q[64];
  load_q64(q, proj + tok * PC + C_NQ + h * 64, 1.0f);
#pragma unroll
  for (int i = 0; i < 8; ++i) {
    float cs = rope[i], sn = rope[8 + i];
    float x1 = q[i], x2 = q[8 + i];
    q[i] = x1 * cs - x2 * sn;
    q[8 + i] = x2 * cs + x1 * sn;
  }
#pragma unroll
  for (int i = 0; i < 64; ++i) q[i] *= 0.125f;
  const size_t kvo = ((size_t)(b * 2 + kvh) * S) * 64;
  const bf16* ksb = (const bf16*)(p.ws + OFF_KSB) + kvo;
  const bf16* vsb = (const bf16*)(p.ws + OFF_VSB) + kvo;
  const bf16* kwb = (const bf16*)(p.ws + OFF_KWB) + kvo;
  const bf16* vwb = (const bf16*)(p.ws + OFF_VWB) + kvo;
  const int* selp = (const int*)(p.ws + OFF_SEL) + (((size_t)b * 2 + kvh) * S + t) * 16;
  float* oa = (float*)(p.ws + OFF_H) + tok * 512 + h * 64;
  const float gate1 = (!PROBE_NSA || (PROBE_NSA & 2)) ? sigmoidf_(bf2f(proj[tok * PC + C_NG + h * 3 + 1])) : 0.f;
  const float gate2 = (!PROBE_NSA || (PROBE_NSA & 4)) ? sigmoidf_(bf2f(proj[tok * PC + C_NG + h * 3 + 2])) : 0.f;
  float o[64];
  {
    float m = -INFINITY;
    for (int j = 0; j < 16; ++j) {
      int n = selp[j];
      if (n >= 0) {
        for (int i = 0; i < 64; ++i) {
          int kpos = n * 64 + i;
          if (kpos <= t) {
            float s = dot64_bf(q, ksb + (size_t)kpos * 64);
            m = fmaxf(m, s);
          }
        }
      }
    }
    float l = 0.f;
#pragma unroll
    for (int d = 0; d < 64; ++d) o[d] = 0.f;
    for (int j = 0; j < 16; ++j) {
      int n = selp[j];
      if (n >= 0) {
        for (int i = 0; i < 64; ++i) {
          int kpos = n * 64 + i;
          if (kpos <= t) {
            float s = dot64_bf(q, ksb + (size_t)kpos * 64);
            float pr = expf(s - m);
            l += pr;
            axpy64_bf(o, pr, vsb + (size_t)kpos * 64);
          }
        }
      }
    }
    float sc = gate1 / l;
#pragma unroll
    for (int d = 0; d < 64; d += 4) {
      float4 v = *(float4*)(oa + d);
      v.x += sc * o[d]; v.y += sc * o[d + 1]; v.z += sc * o[d + 2]; v.w += sc * o[d + 3];
      *(float4*)(oa + d) = v;
    }
  }
  {
    const int s0 = chunk * 64;
    const int jlo = (s0 - 511 > 0) ? (s0 - 511) : 0;
    const int jhi = s0 + 63;
    float m = -INFINITY;
    for (int j = jlo; j <= jhi; ++j) {
      float s = dot64_bf(q, kwb + (size_t)j * 64);
      if (j <= t && j > t - 512) m = fmaxf(m, s);
    }
    float l = 0.f;
#pragma unroll
    for (int d = 0; d < 64; ++d) o[d] = 0.f;
    for (int j = jlo; j <= jhi; ++j) {
      float s = dot64_bf(q, kwb + (size_t)j * 64);
      float pr = (j <= t && j > t - 512) ? expf(s - m) : 0.f;
      l += pr;
      axpy64_bf(o, pr, vwb + (size_t)j * 64);
    }
    float sc = gate2 / l;
    bf16* ob = (bf16*)(p.ws + (PROBE_NSA ? OFF_CMP : OFF_ONSA)) + tok * 512 + h * 64;
#pragma unroll
    for (int d = 0; d < 64; d += 8) {
      float4 v0 = *(float4*)(oa + d);
      float4 v1 = *(float4*)(oa + d + 4);
      uint4 pk;
      pk.x = (unsigned)f2bf(v0.x + sc * o[d]) | ((unsigned)f2bf(v0.y + sc * o[d + 1]) << 16);
      pk.y = (unsigned)f2bf(v0.z + sc * o[d + 2]) | ((unsigned)f2bf(v0.w + sc * o[d + 3]) << 16);
      pk.z = (unsigned)f2bf(v1.x + sc * o[d + 4]) | ((unsigned)f2bf(v1.y + sc * o[d + 5]) << 16);
      pk.w = (unsigned)f2bf(v1.z + sc * o[d + 6]) | ((unsigned)f2bf(v1.w + sc * o[d + 7]) << 16);
      *(uint4*)(ob + d) = pk;
    }
  }
}

DEV void moba_item(const Params& p, int layer, int item) {
  const int blk = item & 63, h = (item >> 6) & 7, b = item >> 9;
  const int tid = tidx();
  const int t = blk * 256 + tid;
  const size_t tok = (size_t)b * S + t;
  const bf16* proj = (const bf16*)(p.ws + OFF_PROJ);
  float q[64];
  load_q64(q, proj + tok * PC + C_MQ + h * 64, 0.125f);
  const float* km = (const float*)(p.ws + OFF_KMEAN) + ((size_t)b * 8 + h) * 64 * 64;
  float b0 = -INFINITY, b1 = -INFINITY, b2 = -INFINITY;
  int i0 = -1, i1 = -1, i2 = -1;
  for (int n = 0; n < blk; ++n) {
    float v = dot64_f(q, km + n * 64);
    if (v > b0) { b2 = b1; i2 = i1; b1 = b0; i1 = i0; b0 = v; i0 = n; }
    else if (v > b1) { b2 = b1; i2 = i1; b1 = v; i1 = n; }
    else if (v > b2) { b2 = v; i2 = n; }
  }
  const bf16* mkb = (const bf16*)(p.ws + OFF_MKB) + ((size_t)(b * 8 + h) * S) * 64;
  const bf16* mvb = (const bf16*)(p.ws + OFF_MVB) + ((size_t)(b * 8 + h) * S) * 64;
  float m = -INFINITY;
  for (int sidx = 0; sidx < 3; ++sidx) {
    int n = (sidx == 0) ? i0 : (sidx == 1) ? i1 : i2;
    if (sidx < blk) {
      for (int i = 0; i < 256; ++i) {
        float s = dot64_bf(q, mkb + (size_t)(n * 256 + i) * 64);
        m = fmaxf(m, s);
      }
    }
  }
  for (int i = 0; i < 256; ++i) {
    int kpos = blk * 256 + i;
    float s = dot64_bf(q, mkb + (size_t)kpos * 64);
    if (kpos <= t) m = fmaxf(m, s);
  }
  float l = 0.f;
  float o[64];
#pragma unroll
  for (int d = 0; d < 64; ++d) o[d] = 0.f;
  for (int sidx = 0; sidx < 3; ++sidx) {
    int n = (sidx == 0) ? i0 : (sidx == 1) ? i1 : i2;
    if (sidx < blk) {
      for (int i = 0; i < 256; ++i) {
        const size_t ko = (size_t)(n * 256 + i) * 64;
        float s = dot64_bf(q, mkb + ko);
        float pr = expf(s - m);
        l += pr;
        axpy64_bf(o, pr, mvb + ko);
      }
    }
  }
  for (int i = 0; i < 256; ++i) {
    int kpos = blk * 256 + i;
    const size_t ko = (size_t)kpos * 64;
    float s = dot64_bf(q, mkb + ko);
    float pr = (kpos <= t) ? expf(s - m) : 0.f;
    l += pr;
    axpy64_bf(o, pr, mvb + ko);
  }
  const float il = 1.f / l;
  bf16* ob = (bf16*)(p.ws + (PROBE_MOBA ? OFF_CMP : OFF_OMOBA)) + tok * 512 + h * 64;
#pragma unroll
  for (int d = 0; d < 64; d += 8) {
    uint4 pk;
    pk.x = (unsigned)f2bf(o[d] * il) | ((unsigned)f2bf(o[d + 1] * il) << 16);
    pk.y = (unsigned)f2bf(o[d + 2] * il) | ((unsigned)f2bf(o[d + 3] * il) << 16);
    pk.z = (unsigned)f2bf(o[d + 4] * il) | ((unsigned)f2bf(o[d + 5] * il) << 16);
    pk.w = (unsigned)f2bf(o[d + 6] * il) | ((unsigned)f2bf(o[d + 7] * il) << 16);
    *(uint4*)(ob + d) = pk;
  }
}

typedef short v4i16_t __attribute__((ext_vector_type(4)));
typedef unsigned u32x4_t __attribute__((ext_vector_type(4)));
DEV v4i16_t lds_tr16(const bf16* p) {
  return __builtin_amdgcn_ds_read_tr16_b64_v4i16((__attribute__((address_space(3))) v4i16_t*)p);
}
DEV unsigned cvtpk(float lo, float hi) {
  unsigned r;
  asm("v_cvt_pk_bf16_f32 %0, %1, %2" : "=v"(r) : "v"(lo), "v"(hi));
  return r;
}
#define MFMA16(a, b, c) __builtin_amdgcn_mfma_f32_16x16x32_bf16(a, b, c, 0, 0, 0)
constexpr float C2 = 0.125f * 1.4426950408889634f;
constexpr int KT_LD = 72;
constexpr int KT_ELEMS = 64 * KT_LD;

template <int NI>
struct AttnSt {
  f32x4 o[4][NI];
  float m[NI], l[NI];
};
template <int NI>
DEV void attn_init(AttnSt<NI>& st) {
#pragma unroll
  for (int ni = 0; ni < NI; ++ni) {
    st.m[ni] = -INFINITY;
    st.l[ni] = 0.f;
#pragma unroll
    for (int di = 0; di < 4; ++di) st.o[di][ni] = f32x4{0.f, 0.f, 0.f, 0.f};
  }
}
#define TILE_DECL uint4 tl_k0, tl_k1, tl_v0, tl_v1
#define TILE_GLOAD(kb, vb, ld, key0)                                                        \
  do {                                                                                      \
    const int r_ = tidx() >> 3, c_ = (tidx() & 7) * 8;                            \
    tl_k0 = *(const uint4*)((kb) + (size_t)((key0) + r_) * (ld) + c_);                      \
    tl_k1 = *(const uint4*)((kb) + (size_t)((key0) + 32 + r_) * (ld) + c_);                 \
    tl_v0 = *(const uint4*)((vb) + (size_t)((key0) + r_) * (ld) + c_);                      \
    tl_v1 = *(const uint4*)((vb) + (size_t)((key0) + 32 + r_) * (ld) + c_);                 \
  } while (0)
#define TILE_SSTORE(Ks_, Vs_)                                                               \
  do {                                                                                      \
    const int r_ = tidx() >> 3, c_ = (tidx() & 7) * 8;                            \
    *(uint4*)((Ks_) + r_ * KT_LD + c_) = tl_k0;                                             \
    *(uint4*)((Ks_) + (32 + r_) * KT_LD + c_) = tl_k1;                                      \
    *(uint4*)((Vs_) + r_ * KT_LD + c_) = tl_v0;                                             \
    *(uint4*)((Vs_) + (32 + r_) * KT_LD + c_) = tl_v1;                                      \
  } while (0)
#define TL_GLOAD(P, kb, vb, ld, key0)                                                       \
  do {                                                                                      \
    const int r_ = tidx() >> 3, c_ = (tidx() & 7) * 8;                                      \
    P##_k0 = *(const uint4*)((kb) + (size_t)((key0) + r_) * (ld) + c_);                     \
    P##_k1 = *(const uint4*)((kb) + (size_t)((key0) + 32 + r_) * (ld) + c_);                \
    P##_v0 = *(const uint4*)((vb) + (size_t)((key0) + r_) * (ld) + c_);                     \
    P##_v1 = *(const uint4*)((vb) + (size_t)((key0) + 32 + r_) * (ld) + c_);                \
  } while (0)
#define TL_SSTORE(P, Ks_, Vs_)                                                              \
  do {                                                                                      \
    const int r_ = tidx() >> 3, c_ = (tidx() & 7) * 8;                                      \
    *(uint4*)((Ks_) + r_ * KT_LD + c_) = P##_k0;                                            \
    *(uint4*)((Ks_) + (32 + r_) * KT_LD + c_) = P##_k1;                                     \
    *(uint4*)((Vs_) + r_ * KT_LD + c_) = P##_v0;                                            \
    *(uint4*)((Vs_) + (32 + r_) * KT_LD + c_) = P##_v1;                                     \
  } while (0)
#define KV_SWEEP(kb_, vb_, ld_, nt_, KEYF, ...)                                             \
  {                                                                                         \
    uint4 tA_k0, tA_k1, tA_v0, tA_v1, tB_k0, tB_k1, tB_v0, tB_v1;                           \
    const int nt__ = (nt_);                                                                 \
    if (nt__ > 0) {                                                                         \
      TL_GLOAD(tA, kb_, vb_, ld_, KEYF(0));                                                 \
      TL_SSTORE(tA, smkv, smkv + KT_ELEMS);                                                 \
      if (nt__ > 1) TL_GLOAD(tA, kb_, vb_, ld_, KEYF(1));                                   \
    }                                                                                       \
    __syncthreads();                                                                        \
    for (int it0__ = 0; it0__ < nt__; it0__ += 2) {                                         \
      {                                                                                     \
        const int it = it0__;                                                               \
        if (it + 2 < nt__) TL_GLOAD(tB, kb_, vb_, ld_, KEYF(it + 2));                       \
        const bf16* Ks = smkv;                                                              \
        __VA_ARGS__                                                                         \
        if (it + 1 < nt__) TL_SSTORE(tA, smkv + 2 * KT_ELEMS, smkv + 3 * KT_ELEMS);         \
        __syncthreads();                                                                    \
      }                                                                                     \
      if (it0__ + 1 < nt__) {                                                               \
        const int it = it0__ + 1;                                                           \
        if (it + 2 < nt__) TL_GLOAD(tA, kb_, vb_, ld_, KEYF(it + 2));                       \
        const bf16* Ks = smkv + 2 * KT_ELEMS;                                               \
        __VA_ARGS__                                                                         \
        if (it + 1 < nt__) TL_SSTORE(tB, smkv, smkv + KT_ELEMS);                            \
        __syncthreads();                                                                    \
      }                                                                                     \
    }                                                                                       \
  }
template <int NI>
DEV void attn_scores(const bf16* Ks, const bf16x8 (&qf)[NI][2], f32x4 (&s)[4][NI]) {
  const int lane = tidx() & 63, g4 = lane >> 4, c16 = lane & 15;
#pragma unroll
  for (int mi = 0; mi < 4; ++mi) {
#pragma unroll
    for (int ni = 0; ni < NI; ++ni) s[mi][ni] = f32x4{0.f, 0.f, 0.f, 0.f};
#pragma unroll
    for (int ks = 0; ks < 2; ++ks) {
      bf16x8 kf = *(const bf16x8*)(Ks + (mi * 16 + c16) * KT_LD + ks * 32 + g4 * 8);
#pragma unroll
      for (int ni = 0; ni < NI; ++ni) s[mi][ni] = MFMA16(kf, qf[ni][ks], s[mi][ni]);
    }
  }
}
template <int NI>
DEV void attn_pv(const bf16* Vs, const bf16x8 (&pf)[NI][2], f32x4 (&o)[4][NI]) {
  const int lane = tidx() & 63, g4 = lane >> 4, q4 = (lane & 15) >> 2, p4 = lane & 3;
#pragma unroll
  for (int di = 0; di < 4; ++di) {
#pragma unroll
    for (int ks2 = 0; ks2 < 2; ++ks2) {
      v4i16_t v0 = lds_tr16(Vs + (ks2 * 32 + g4 * 4 + q4) * KT_LD + di * 16 + p4 * 4);
      v4i16_t v1 = lds_tr16(Vs + (ks2 * 32 + 16 + g4 * 4 + q4) * KT_LD + di * 16 + p4 * 4);
      bf16x8 vf = __builtin_shufflevector(v0, v1, 0, 1, 2, 3, 4, 5, 6, 7);
#pragma unroll
      for (int ni = 0; ni < NI; ++ni) o[di][ni] = MFMA16(vf, pf[ni][ks2], o[di][ni]);
    }
  }
}
DEV void exp4_pack(const f32x4& sv, float nm, float& ps, unsigned& w0, unsigned& w1) {
  float p0 = __builtin_amdgcn_exp2f(__builtin_fmaf(sv[0], C2, nm));
  float p1 = __builtin_amdgcn_exp2f(__builtin_fmaf(sv[1], C2, nm));
  float p2 = __builtin_amdgcn_exp2f(__builtin_fmaf(sv[2], C2, nm));
  float p3 = __builtin_amdgcn_exp2f(__builtin_fmaf(sv[3], C2, nm));
  ps += (p0 + p1) + (p2 + p3);
  w0 = cvtpk(p0, p1);
  w1 = cvtpk(p2, p3);
}
template <int NI>
DEV void attn_softmax_pv(const bf16* Vs, f32x4 (&s)[4][NI], AttnSt<NI>& st) {
  bf16x8 pf[NI][2];
#pragma unroll
  for (int ni = 0; ni < NI; ++ni) {
    float mx = -INFINITY;
#pragma unroll
    for (int mi = 0; mi < 4; ++mi)
      mx = fmaxf(fmaxf(mx, fmaxf(s[mi][ni][0], s[mi][ni][1])), fmaxf(s[mi][ni][2], s[mi][ni][3]));
    mx = fmaxf(mx, shx(mx, 16));
    mx = fmaxf(mx, shx(mx, 32));
    const float mn = fmaxf(st.m[ni], mx);
    const float mu = (mn == -INFINITY) ? 0.f : mn;
    const float corr = __builtin_amdgcn_exp2f((st.m[ni] - mu) * C2);
    st.m[ni] = mn;
    const float nm = -mu * C2;
    float ps = 0.f;
    u32x4_t wa, wb;
    unsigned t0, t1;
    exp4_pack(s[0][ni], nm, ps, t0, t1); wa.x = t0; wa.y = t1;
    exp4_pack(s[1][ni], nm, ps, t0, t1); wa.z = t0; wa.w = t1;
    exp4_pack(s[2][ni], nm, ps, t0, t1); wb.x = t0; wb.y = t1;
    exp4_pack(s[3][ni], nm, ps, t0, t1); wb.z = t0; wb.w = t1;
    st.l[ni] = st.l[ni] * corr + ps;
#pragma unroll
    for (int di = 0; di < 4; ++di) {
      st.o[di][ni][0] *= corr; st.o[di][ni][1] *= corr; st.o[di][ni][2] *= corr; st.o[di][ni][3] *= corr;
    }
    pf[ni][0] = __builtin_bit_cast(bf16x8, wa);
    pf[ni][1] = __builtin_bit_cast(bf16x8, wb);
  }
  attn_pv<NI>(Vs, pf, st.o);
}

template <int NI>
DEV void attn_softmax_pv_act(const bf16* Vs, f32x4 (&s)[4][NI], AttnSt<NI>& st, const bool (&act)[NI]) {
  bf16x8 pf[NI][2];
#pragma unroll
  for (int ni = 0; ni < NI; ++ni) {
    pf[ni][0] = bf16x8{0, 0, 0, 0, 0, 0, 0, 0};
    pf[ni][1] = bf16x8{0, 0, 0, 0, 0, 0, 0, 0};
    if (act[ni]) {
      float mx = -INFINITY;
#pragma unroll
      for (int mi = 0; mi < 4; ++mi)
        mx = fmaxf(fmaxf(mx, fmaxf(s[mi][ni][0], s[mi][ni][1])), fmaxf(s[mi][ni][2], s[mi][ni][3]));
      mx = fmaxf(mx, shx(mx, 16));
      mx = fmaxf(mx, shx(mx, 32));
      const float mn = fmaxf(st.m[ni], mx);
      const float mu = (mn == -INFINITY) ? 0.f : mn;
      const float corr = __builtin_amdgcn_exp2f((st.m[ni] - mu) * C2);
      st.m[ni] = mn;
      const float nm = -mu * C2;
      float ps = 0.f;
      u32x4_t wa, wb;
      unsigned t0, t1;
      exp4_pack(s[0][ni], nm, ps, t0, t1); wa.x = t0; wa.y = t1;
      exp4_pack(s[1][ni], nm, ps, t0, t1); wa.z = t0; wa.w = t1;
      exp4_pack(s[2][ni], nm, ps, t0, t1); wb.x = t0; wb.y = t1;
      exp4_pack(s[3][ni], nm, ps, t0, t1); wb.z = t0; wb.w = t1;
      st.l[ni] = st.l[ni] * corr + ps;
#pragma unroll
      for (int di = 0; di < 4; ++di) {
        st.o[di][ni][0] *= corr; st.o[di][ni][1] *= corr; st.o[di][ni][2] *= corr; st.o[di][ni][3] *= corr;
      }
      pf[ni][0] = __builtin_bit_cast(bf16x8, wa);
      pf[ni][1] = __builtin_bit_cast(bf16x8, wb);
    }
  }
  const int lane = tidx() & 63, g4 = lane >> 4, q4 = (lane & 15) >> 2, p4 = lane & 3;
#pragma unroll
  for (int di = 0; di < 4; ++di) {
#pragma unroll
    for (int ks2 = 0; ks2 < 2; ++ks2) {
      v4i16_t v0 = lds_tr16(Vs + (ks2 * 32 + g4 * 4 + q4) * KT_LD + di * 16 + p4 * 4);
      v4i16_t v1 = lds_tr16(Vs + (ks2 * 32 + 16 + g4 * 4 + q4) * KT_LD + di * 16 + p4 * 4);
      bf16x8 vf = __builtin_shufflevector(v0, v1, 0, 1, 2, 3, 4, 5, 6, 7);
#pragma unroll
      for (int ni = 0; ni < NI; ++ni)
        if (act[ni]) st.o[di][ni] = MFMA16(vf, pf[ni][ks2], st.o[di][ni]);
    }
  }
}
template <int NI>
DEV int gate_top1(f32x4 (&gs)[4][NI], int ni, int g4) {
  float bv = -INFINITY;
  int bi = 1 << 20;
#pragma unroll
  for (int mi = 0; mi < 4; ++mi)
#pragma unroll
    for (int r = 0; r < 4; ++r) {
      float v = gs[mi][ni][r];
      if (v > bv) { bv = v; bi = mi * 16 + g4 * 4 + r; }
    }
#pragma unroll
  for (int off = 16; off <= 32; off <<= 1) {
    float ov = shx(bv, off);
    int oi = shx(bi, off);
    if (ov > bv || (ov == bv && oi < bi)) { bv = ov; bi = oi; }
  }
#pragma unroll
  for (int mi = 0; mi < 4; ++mi)
#pragma unroll
    for (int r = 0; r < 4; ++r)
      if (mi * 16 + g4 * 4 + r == bi) gs[mi][ni][r] = -INFINITY;
  return (bv == -INFINITY) ? -1 : bi;
}
template <int NI>
DEV void moba_mfma_item(const Params& p, int item, char* smem, bf16* outbuf) {
  constexpr int QB = 64 * NI;
  bf16* sm = (bf16*)smem;
  const int bh = item & 15, cq = (S / QB - 1) - (item >> 4);
  const int b = bh >> 3, h = bh & 7;
  const int s0 = cq * QB, blk = s0 >> 8;
  const int lane = tidx() & 63, wave = tidx() >> 6, g4 = lane >> 4, c16 = lane & 15;
  const bf16* proj = (const bf16*)(p.ws + OFF_PROJ) + (size_t)b * S * PC;
  bf16x8 qf[NI][2];
  int tq[NI];
#pragma unroll
  for (int ni = 0; ni < NI; ++ni) {
    tq[ni] = s0 + wave * 16 * NI + ni * 16 + c16;
#pragma unroll
    for (int ks = 0; ks < 2; ++ks)
      qf[ni][ks] = *(const bf16x8*)(proj + (size_t)tq[ni] * PC + C_MQ + h * 64 + ks * 32 + g4 * 8);
  }
  int i0[NI], i1[NI], i2[NI];
  {
    const bf16* kmh = (const bf16*)(p.ws + OFF_KMHL) + ((size_t)(b * 8 + h) * 64) * 64;
    const bf16* kml = kmh + (size_t)2 * 8 * 64 * 64;
    f32x4 gs[4][NI];
#pragma unroll
    for (int mi = 0; mi < 4; ++mi) {
#pragma unroll
      for (int ni = 0; ni < NI; ++ni) gs[mi][ni] = f32x4{0.f, 0.f, 0.f, 0.f};
#pragma unroll
      for (int ks = 0; ks < 2; ++ks) {
        bf16x8 ah = *(const bf16x8*)(kmh + (mi * 16 + c16) * 64 + ks * 32 + g4 * 8);
        bf16x8 al_ = *(const bf16x8*)(kml + (mi * 16 + c16) * 64 + ks * 32 + g4 * 8);
#pragma unroll
        for (int ni = 0; ni < NI; ++ni) {
          gs[mi][ni] = MFMA16(ah, qf[ni][ks], gs[mi][ni]);
          gs[mi][ni] = MFMA16(al_, qf[ni][ks], gs[mi][ni]);
        }
      }
    }
#pragma unroll
    for (int ni = 0; ni < NI; ++ni) {
#pragma unroll
      for (int mi = 0; mi < 4; ++mi)
#pragma unroll
        for (int r = 0; r < 4; ++r)
          if (mi * 16 + g4 * 4 + r >= blk) gs[mi][ni][r] = -INFINITY;
      i0[ni] = gate_top1(gs, ni, g4);
      i1[ni] = gate_top1(gs, ni, g4);
      i2[ni] = gate_top1(gs, ni, g4);
    }
  }
  AttnSt<NI> st;
  attn_init<NI>(st);
  const int ntiles = (s0 + QB) >> 6;
  const bf16* kb = (const bf16*)(p.ws + OFF_MKB) + ((size_t)(b * 8 + h) * S) * 64;
  const bf16* vb = (const bf16*)(p.ws + OFF_MVB) + ((size_t)(b * 8 + h) * S) * 64;
  bf16* smkv = sm;
  __syncthreads();
#define MOBA_KEY(i) ((i) * 64)
  KV_SWEEP(kb, vb, 64, ntiles, MOBA_KEY,
    const int n = it >> 2;
    const bool own = (n == blk);
    const int kbase = it * 64;
    bool wave_active = own;
    if (!own) {
      bool anyq = false;
      _Pragma("unroll") for (int ni = 0; ni < NI; ++ni) anyq = anyq || (n == i0[ni]) || (n == i1[ni]) || (n == i2[ni]);
      wave_active = __builtin_amdgcn_ballot_w64(anyq) != 0ull;
    }
    if (wave_active) {
      f32x4 s[4][NI];
      attn_scores<NI>(Ks, qf, s);
      _Pragma("unroll") for (int ni = 0; ni < NI; ++ni) {
        if (own) {
          _Pragma("unroll") for (int mi = 0; mi < 4; ++mi)
            _Pragma("unroll") for (int r = 0; r < 4; ++r)
              if (kbase + mi * 16 + g4 * 4 + r > tq[ni]) s[mi][ni][r] = -INFINITY;
        } else {
          const bool okb = (n == i0[ni]) | (n == i1[ni]) | (n == i2[ni]);
          if (!okb) {
            _Pragma("unroll") for (int mi = 0; mi < 4; ++mi) s[mi][ni] = f32x4{-INFINITY, -INFINITY, -INFINITY, -INFINITY};
          }
        }
      }
      attn_softmax_pv<NI>(Ks + KT_ELEMS, s, st);
    }
  )
#pragma unroll
  for (int ni = 0; ni < NI; ++ni) {
    float l = st.l[ni];
    l += shx(l, 16);
    l += shx(l, 32);
    const float inv = 1.f / l;
    bf16* op = outbuf + ((size_t)b * S + tq[ni]) * 512 + h * 64 + g4 * 4;
#pragma unroll
    for (int di = 0; di < 4; ++di) {
      uint2 pk;
      pk.x = cvtpk(st.o[di][ni][0] * inv, st.o[di][ni][1] * inv);
      pk.y = cvtpk(st.o[di][ni][2] * inv, st.o[di][ni][3] * inv);
      *(uint2*)(op + di * 16) = pk;
    }
  }
}

DEV int moba_list_base(int n) { return n * S - 128 * n * (n + 1); }
template <int NI>
DEV void moba_gate_item(const Params& p, int item) {
  constexpr int QB = 64 * NI;
  const int bh = item & 15, cq = item >> 4;
  const int b = bh >> 3, h = bh & 7;
  const int s0 = cq * QB, blk = s0 >> 8;
  if (blk == 0) return;
  const int lane = tidx() & 63, wave = tidx() >> 6, g4 = lane >> 4, c16 = lane & 15;
  const bf16* proj = (const bf16*)(p.ws + OFF_PROJ) + (size_t)b * S * PC;
  bf16x8 qf[NI][2];
  int tq[NI];
#pragma unroll
  for (int ni = 0; ni < NI; ++ni) {
    tq[ni] = s0 + wave * 16 * NI + ni * 16 + c16;
#pragma unroll
    for (int ks = 0; ks < 2; ++ks)
      qf[ni][ks] = *(const bf16x8*)(proj + (size_t)tq[ni] * PC + C_MQ + h * 64 + ks * 32 + g4 * 8);
  }
  const bf16* kmh = (const bf16*)(p.ws + OFF_KMHL) + ((size_t)(b * 8 + h) * 64) * 64;
  const bf16* kml = kmh + (size_t)2 * 8 * 64 * 64;
  f32x4 gs[4][NI];
#pragma unroll
  for (int mi = 0; mi < 4; ++mi) {
#pragma unroll
    for (int ni = 0; ni < NI; ++ni) gs[mi][ni] = f32x4{0.f, 0.f, 0.f, 0.f};
#pragma unroll
    for (int ks = 0; ks < 2; ++ks) {
      bf16x8 ah = *(const bf16x8*)(kmh + (mi * 16 + c16) * 64 + ks * 32 + g4 * 8);
      bf16x8 al_ = *(const bf16x8*)(kml + (mi * 16 + c16) * 64 + ks * 32 + g4 * 8);
#pragma unroll
      for (int ni = 0; ni < NI; ++ni) {
        gs[mi][ni] = MFMA16(ah, qf[ni][ks], gs[mi][ni]);
        gs[mi][ni] = MFMA16(al_, qf[ni][ks], gs[mi][ni]);
      }
    }
  }
  unsigned short* lists = (unsigned short*)(p.ws + OFF_MLIST) + (size_t)(b * 8 + h) * MLIST_PER_BH;
  int* cnt = (int*)(p.ws + OFF_MCNT) + (b * 8 + h) * 64;
#pragma unroll
  for (int ni = 0; ni < NI; ++ni) {
#pragma unroll
    for (int mi = 0; mi < 4; ++mi)
#pragma unroll
      for (int r = 0; r < 4; ++r)
        if (mi * 16 + g4 * 4 + r >= blk) gs[mi][ni][r] = -INFINITY;
    const int s0i = gate_top1(gs, ni, g4);
    const int s1i = gate_top1(gs, ni, g4);
    const int s2i = gate_top1(gs, ni, g4);
    if (g4 == 0) {
      if (s0i >= 0) { const int pos = atomicAdd(cnt + s0i, 1); lists[moba_list_base(s0i) + pos] = (unsigned short)(tq[ni] | (0 << 14)); }
      if (s1i >= 0) { const int pos = atomicAdd(cnt + s1i, 1); lists[moba_list_base(s1i) + pos] = (unsigned short)(tq[ni] | (1 << 14)); }
      if (s2i >= 0) { const int pos = atomicAdd(cnt + s2i, 1); lists[moba_list_base(s2i) + pos] = (unsigned short)(tq[ni] | (2 << 14)); }
    }
  }
}
template <int NI>
DEV void moba_part_item(const Params& p, int b, int item, char* smem) {
  constexpr int CH = 64 * NI;
  bf16* smkv = (bf16*)smem;
  const int n = item >> 6, h = (item >> 3) & 7, part = item & 7;
  const int lane = tidx() & 63, wave = tidx() >> 6, g4 = lane >> 4, c16 = lane & 15;
  const int cnt = ((const int*)(p.ws + OFF_MCNT))[(b * 8 + h) * 64 + n];
  const unsigned short* list = (const unsigned short*)(p.ws + OFF_MLIST) + (size_t)(b * 8 + h) * MLIST_PER_BH + moba_list_base(n);
  const bf16* proj = (const bf16*)(p.ws + OFF_PROJ) + (size_t)b * S * PC;
  const bf16* kb = (const bf16*)(p.ws + OFF_MKB) + ((size_t)(b * 8 + h) * S + n * 256) * 64;
  const bf16* vb = (const bf16*)(p.ws + OFF_MVB) + ((size_t)(b * 8 + h) * S + n * 256) * 64;
  bf16* po = (bf16*)(p.ws + OFF_MPO);
  float2* pml = (float2*)(p.ws + OFF_MPML);
  for (int c = part; c * CH < cnt; c += 8) {
    bf16x8 qf[NI][2];
    int tcol[NI], slot[NI];
    bool valid[NI];
#pragma unroll
    for (int ni = 0; ni < NI; ++ni) {
      const int idx = c * CH + wave * 16 * NI + ni * 16 + c16;
      valid[ni] = idx < cnt;
      const unsigned e = list[valid[ni] ? idx : 0];
      tcol[ni] = e & 0x3FFF;
      slot[ni] = e >> 14;
#pragma unroll
      for (int ks = 0; ks < 2; ++ks)
        qf[ni][ks] = *(const bf16x8*)(proj + (size_t)tcol[ni] * PC + C_MQ + h * 64 + ks * 32 + g4 * 8);
    }
    AttnSt<NI> st;
    attn_init<NI>(st);
    __syncthreads();
#define MOBA_PKEY(i) ((i) * 64)
    KV_SWEEP(kb, vb, 64, 4, MOBA_PKEY,
      f32x4 s[4][NI];
      attn_scores<NI>(Ks, qf, s);
      attn_softmax_pv<NI>(Ks + KT_ELEMS, s, st);
    )
#pragma unroll
    for (int ni = 0; ni < NI; ++ni) {
      float l = st.l[ni];
      l += shx(l, 16);
      l += shx(l, 32);
      if (valid[ni]) {
        const size_t rec = ((size_t)h * S + tcol[ni]) * 3 + slot[ni];
        if (g4 == 0) pml[rec] = float2{st.m[ni], l};
        bf16* op = po + rec * 64 + g4 * 4;
#pragma unroll
        for (int di = 0; di < 4; ++di) {
          uint2 pk;
          pk.x = cvtpk(st.o[di][ni][0], st.o[di][ni][1]);
          pk.y = cvtpk(st.o[di][ni][2], st.o[di][ni][3]);
          *(uint2*)(op + di * 16) = pk;
        }
      }
    }
  }
}
template <int NI>
DEV void moba_merge_item(const Params& p, int b, int item, char* smem, bf16* outbuf) {
  constexpr int QB = 64 * NI;
  constexpr int NCQ = S / QB;
  bf16* smkv = (bf16*)smem;
  const int h = item / NCQ, cq = item % NCQ;
  const int s0 = cq * QB, blk = s0 >> 8;
  const int lane = tidx() & 63, wave = tidx() >> 6, g4 = lane >> 4, c16 = lane & 15;
  const bf16* proj = (const bf16*)(p.ws + OFF_PROJ) + (size_t)b * S * PC;
  bf16x8 qf[NI][2];
  int tq[NI];
#pragma unroll
  for (int ni = 0; ni < NI; ++ni) {
    tq[ni] = s0 + wave * 16 * NI + ni * 16 + c16;
#pragma unroll
    for (int ks = 0; ks < 2; ++ks)
      qf[ni][ks] = *(const bf16x8*)(proj + (size_t)tq[ni] * PC + C_MQ + h * 64 + ks * 32 + g4 * 8);
  }
  const bf16* kb = (const bf16*)(p.ws + OFF_MKB) + ((size_t)(b * 8 + h) * S) * 64;
  const bf16* vb = (const bf16*)(p.ws + OFF_MVB) + ((size_t)(b * 8 + h) * S) * 64;
  AttnSt<NI> st;
  attn_init<NI>(st);
  const int kt0 = blk * 4;
  const int ntl = ((s0 + QB - 1) >> 6) - kt0 + 1;
  __syncthreads();
#define MOBA_MKEY(i) ((kt0 + (i)) * 64)
  KV_SWEEP(kb, vb, 64, ntl, MOBA_MKEY,
    const int kbase = (kt0 + it) * 64;
    f32x4 s[4][NI];
    attn_scores<NI>(Ks, qf, s);
    _Pragma("unroll") for (int ni = 0; ni < NI; ++ni)
      _Pragma("unroll") for (int mi = 0; mi < 4; ++mi)
        _Pragma("unroll") for (int r = 0; r < 4; ++r)
          if (kbase + mi * 16 + g4 * 4 + r > tq[ni]) s[mi][ni][r] = -INFINITY;
    attn_softmax_pv<NI>(Ks + KT_ELEMS, s, st);
  )
  const int nsl = (blk < 3) ? blk : 3;
  const bf16* po = (const bf16*)(p.ws + OFF_MPO);
  const float2* pml = (const float2*)(p.ws + OFF_MPML);
#pragma unroll
  for (int ni = 0; ni < NI; ++ni) {
    float l = st.l[ni];
    l += shx(l, 16);
    l += shx(l, 32);
    const size_t rec0 = ((size_t)h * S + tq[ni]) * 3;
    float ms[3], ls[3];
    float M = st.m[ni];
#pragma unroll
    for (int s = 0; s < 3; ++s) {
      ms[s] = -INFINITY;
      ls[s] = 0.f;
      if (s < nsl) {
        const float2 v = pml[rec0 + s];
        ms[s] = v.x;
        ls[s] = v.y;
        M = fmaxf(M, v.x);
      }
    }
    const float fo = __builtin_amdgcn_exp2f((st.m[ni] - M) * C2);
    l *= fo;
    float f[3];
#pragma unroll
    for (int s = 0; s < 3; ++s) {
      f[s] = (s < nsl) ? __builtin_amdgcn_exp2f((ms[s] - M) * C2) : 0.f;
      l += ls[s] * f[s];
    }
    const float inv = 1.f / l;
    bf16* op = outbuf + ((size_t)b * S + tq[ni]) * 512 + h * 64 + g4 * 4;
#pragma unroll
    for (int di = 0; di < 4; ++di) {
      float o0 = st.o[di][ni][0] * fo, o1 = st.o[di][ni][1] * fo, o2 = st.o[di][ni][2] * fo, o3 = st.o[di][ni][3] * fo;
#pragma unroll
      for (int s = 0; s < 3; ++s) {
        if (s < nsl) {
          const uint2 pv = *(const uint2*)(po + (rec0 + s) * 64 + di * 16 + g4 * 4);
          o0 += f[s] * __uint_as_float(pv.x << 16);
          o1 += f[s] * __uint_as_float(pv.x & 0xffff0000u);
          o2 += f[s] * __uint_as_float(pv.y << 16);
          o3 += f[s] * __uint_as_float(pv.y & 0xffff0000u);
        }
      }
      uint2 pk;
      pk.x = cvtpk(o0 * inv, o1 * inv);
      pk.y = cvtpk(o2 * inv, o3 * inv);
      *(uint2*)(op + di * 16) = pk;
    }
  }
}

template <int NI>
DEV void attn_stats(f32x4 (&s)[4][NI], float (&m)[NI], float (&l)[NI]) {
#pragma unroll
  for (int ni = 0; ni < NI; ++ni) {
    float mx = -INFINITY;
#pragma unroll
    for (int mi = 0; mi < 4; ++mi)
      mx = fmaxf(fmaxf(mx, fmaxf(s[mi][ni][0], s[mi][ni][1])), fmaxf(s[mi][ni][2], s[mi][ni][3]));
    mx = fmaxf(mx, shx(mx, 16));
    mx = fmaxf(mx, shx(mx, 32));
    const float mn = fmaxf(m[ni], mx);
    const float mu = (mn == -INFINITY) ? 0.f : mn;
    const float corr = __builtin_amdgcn_exp2f((m[ni] - mu) * C2);
    m[ni] = mn;
    const float nm = -mu * C2;
    float ps = 0.f;
#pragma unroll
    for (int mi = 0; mi < 4; ++mi)
#pragma unroll
      for (int r = 0; r < 4; ++r) ps += __builtin_amdgcn_exp2f(__builtin_fmaf(s[mi][ni][r], C2, nm));
    l[ni] = l[ni] * corr + ps;
  }
}
DEV bf16x8 rope_frag(bf16x8 qv, const float* __restrict__ rope_t, int g4) {
  u32x4_t w = __builtin_bit_cast(u32x4_t, qv);
  u32x4_t pw;
  pw.x = shx(w.x, 16); pw.y = shx(w.y, 16); pw.z = shx(w.z, 16); pw.w = shx(w.w, 16);
  float f[8], pf[8];
  unpack8(uint4{w.x, w.y, w.z, w.w}, f);
  unpack8(uint4{pw.x, pw.y, pw.z, pw.w}, pf);
  const float4 c0 = *(const float4*)(rope_t), c1 = *(const float4*)(rope_t + 4);
  const float4 s0 = *(const float4*)(rope_t + 8), s1 = *(const float4*)(rope_t + 12);
  const float cs[8] = {c0.x, c0.y, c0.z, c0.w, c1.x, c1.y, c1.z, c1.w};
  const float sn[8] = {s0.x, s0.y, s0.z, s0.w, s1.x, s1.y, s1.z, s1.w};
  const float sg = (g4 == 0) ? -1.f : 1.f;
  float o[8];
#pragma unroll
  for (int i = 0; i < 8; ++i) o[i] = (g4 < 2) ? (f[i] * cs[i] + sg * pf[i] * sn[i]) : f[i];
  u32x4_t r;
  r.x = cvtpk(o[0], o[1]); r.y = cvtpk(o[2], o[3]); r.z = cvtpk(o[4], o[5]); r.w = cvtpk(o[6], o[7]);
  return __builtin_bit_cast(bf16x8, r);
}

template <int NI>
DEV void nsa_item(const Params& p, int item, char* smem, bf16* outbuf) {
  constexpr int QN = 16 * NI;
  constexpr int NCH = S / QN;
  bf16* smkv = (bf16*)smem;
  float* imp = (float*)(smem + 36864);
  int* sel = (int*)(smem + 36864 + QN * 257 * 4);
  unsigned* bmq = (unsigned*)(sel + QN * 16);
  unsigned* bmu = bmq + QN * 8;
  int* ulist = (int*)(bmu + 4 * NI * 8);
  static_assert(36864 + QN * 257 * 4 + QN * 16 * 4 + QN * 8 * 4 + 4 * NI * 8 * 4 + 257 * 4 <= SMEM_BYTES, "nsa lds");
  static_assert(NI == 2, "per-wave union bitmaps use bmu[8 .. 40)");
  const int tid = tidx(), lane = tid & 63, wave = tid >> 6, g4 = lane >> 4, c16 = lane & 15;
  const int bk = item & 3, cq = (NCH - 1) - (item >> 2);
  const int b = bk >> 1, kvh = bk & 1;
  const int s0 = cq * QN, cur = s0 >> 6;
  if (PROBE_NSA && b == 1) return;
  const bf16* proj = (const bf16*)(p.ws + OFF_PROJ) + (size_t)b * S * PC;
  const float* rope = (const float*)(p.ws + OFF_ROPE);
  int tq[NI], qlv[NI];
  float gate0[NI], gate1[NI], gate2[NI];
  bf16x8 qraw[NI][2], qrot[NI][2];
#pragma unroll
  for (int ni = 0; ni < NI; ++ni) {
    const int R = wave * 16 * NI + ni * 16 + c16;
    qlv[ni] = R >> 2;
    const int g = R & 3;
    tq[ni] = s0 + qlv[ni];
    const bf16* qp = proj + (size_t)tq[ni] * PC + C_NQ + (kvh * 4 + g) * 64 + g4 * 8;
    qraw[ni][0] = *(const bf16x8*)(qp);
    qraw[ni][1] = *(const bf16x8*)(qp + 32);
    qrot[ni][0] = rope_frag(qraw[ni][0], rope + (size_t)tq[ni] * 16, g4);
    qrot[ni][1] = qraw[ni][1];
    const bf16* gp = proj + (size_t)tq[ni] * PC + C_NG + (kvh * 4 + g) * 3;
    gate0[ni] = (!PROBE_NSA || (PROBE_NSA & 1)) ? sigmoidf_(bf2f(gp[0])) : 0.f;
    gate1[ni] = (!PROBE_NSA || (PROBE_NSA & 2)) ? sigmoidf_(bf2f(gp[1])) : 0.f;
    gate2[ni] = (!PROBE_NSA || (PROBE_NSA & 4)) ? sigmoidf_(bf2f(gp[2])) : 0.f;
  }
  for (int i = tid; i < QN * 257; i += 256) imp[i] = 0.f;
  for (int i = tid; i < QN * 8 + 4 * NI * 8; i += 256) bmq[i] = 0u;
  f32x4 acc[4][NI];
#pragma unroll
  for (int ni = 0; ni < NI; ++ni)
#pragma unroll
    for (int di = 0; di < 4; ++di) acc[di][ni] = f32x4{0.f, 0.f, 0.f, 0.f};
  TILE_DECL;
  {
    int nv[NI];
#pragma unroll
    for (int ni = 0; ni < NI; ++ni) nv[ni] = (tq[ni] >= 31) ? (((tq[ni] - 31) >> 4) + 1) : 0;
    const int tlast = s0 + QN - 1;
    const int nvmax = (tlast >= 31) ? (((tlast - 31) >> 4) + 1) : 0;
    const int ntc = (nvmax + 63) >> 6;
    const bf16* kb = (const bf16*)(p.ws + OFF_KCB) + ((size_t)(b * 2 + kvh) * 1024) * 64;
    const bf16* vb = (const bf16*)(p.ws + OFF_VCB) + ((size_t)(b * 2 + kvh) * 1024) * 64;
    float mA[NI], lA[NI];
#pragma unroll
    for (int ni = 0; ni < NI; ++ni) { mA[ni] = -INFINITY; lA[ni] = 0.f; }
    __syncthreads();
    if (ntc > 0) {
      for (int rep_ = 0; rep_ < ((REP_NSA_PART & 1) ? 2 : 1); ++rep_) {
#pragma unroll
      for (int ni = 0; ni < NI; ++ni) { mA[ni] = -INFINITY; lA[ni] = 0.f; }
      TILE_GLOAD(kb, vb, 64, 0);
      TILE_SSTORE(smkv, smkv + KT_ELEMS);
      __syncthreads();
      for (int kt = 0; kt < ntc; ++kt) {
        if (kt + 1 < ntc) TILE_GLOAD(kb, vb, 64, (kt + 1) * 64);
        const bf16* Ks = smkv + (kt & 1) * 2 * KT_ELEMS;
        f32x4 s[4][NI];
        attn_scores<NI>(Ks, qraw, s);
#pragma unroll
        for (int ni = 0; ni < NI; ++ni)
#pragma unroll
          for (int mi = 0; mi < 4; ++mi)
#pragma unroll
            for (int r = 0; r < 4; ++r)
              if (kt * 64 + mi * 16 + g4 * 4 + r >= nv[ni]) s[mi][ni][r] = -INFINITY;
        attn_stats<NI>(s, mA, lA);
        if (kt + 1 < ntc) {
          bf16* Kn = smkv + ((kt + 1) & 1) * 2 * KT_ELEMS;
          TILE_SSTORE(Kn, Kn + KT_ELEMS);
        }
        __syncthreads();
      }
      }
      float nmB[NI];
#pragma unroll
      for (int ni = 0; ni < NI; ++ni) {
        float l = lA[ni];
        l += shx(l, 16);
        l += shx(l, 32);
        nmB[ni] = (l > 0.f) ? -(mA[ni] * C2 + __builtin_amdgcn_logf(l)) : 0.f;
      }
      TILE_GLOAD(kb, vb, 64, 0);
      TILE_SSTORE(smkv, smkv + KT_ELEMS);
      __syncthreads();
      for (int kt = 0; kt < ntc; ++kt) {
        if (kt + 1 < ntc) TILE_GLOAD(kb, vb, 64, (kt + 1) * 64);
        const bf16* Ks = smkv + (kt & 1) * 2 * KT_ELEMS;
        f32x4 s[4][NI];
        attn_scores<NI>(Ks, qraw, s);
        bf16x8 pf[NI][2];
#pragma unroll
        for (int ni = 0; ni < NI; ++ni) {
          u32x4_t wa, wb;
          float* irow = imp + qlv[ni] * 257 + kt * 16 + g4;
#pragma unroll
          for (int mi = 0; mi < 4; ++mi) {
            float pr[4];
#pragma unroll
            for (int r = 0; r < 4; ++r) {
              const bool ok = (kt * 64 + mi * 16 + g4 * 4 + r) < nv[ni];
              pr[r] = ok ? __builtin_amdgcn_exp2f(__builtin_fmaf(s[mi][ni][r], C2, nmB[ni])) : 0.f;
            }
            float mainv = pr[0] + pr[1] + pr[2] + 0.5f * pr[3];
            float spv = 0.5f * pr[3];
            mainv += shx(mainv, 1);
            mainv += shx(mainv, 2);
            spv += shx(spv, 1);
            spv += shx(spv, 2);
            if ((c16 & 3) == 0) {
              atomicAdd(irow + mi * 4, mainv);
              atomicAdd(irow + mi * 4 + 1, spv);
            }
            const unsigned w0 = cvtpk(pr[0], pr[1]), w1 = cvtpk(pr[2], pr[3]);
            if (mi == 0) { wa.x = w0; wa.y = w1; }
            if (mi == 1) { wa.z = w0; wa.w = w1; }
            if (mi == 2) { wb.x = w0; wb.y = w1; }
            if (mi == 3) { wb.z = w0; wb.w = w1; }
          }
          pf[ni][0] = __builtin_bit_cast(bf16x8, wa);
          pf[ni][1] = __builtin_bit_cast(bf16x8, wb);
        }
        attn_pv<NI>(Ks + KT_ELEMS, pf, acc);
        if (kt + 1 < ntc) {
          bf16* Kn = smkv + ((kt + 1) & 1) * 2 * KT_ELEMS;
          TILE_SSTORE(Kn, Kn + KT_ELEMS);
        }
        __syncthreads();
      }
    }
#pragma unroll
    for (int ni = 0; ni < NI; ++ni)
#pragma unroll
      for (int di = 0; di < 4; ++di) {
        acc[di][ni][0] *= gate0[ni]; acc[di][ni][1] *= gate0[ni]; acc[di][ni][2] *= gate0[ni]; acc[di][ni][3] *= gate0[ni];
      }
  }
  __syncthreads();
#if PROBE_NSA == 8
  if (b == 0 && kvh == 0)
    for (int i = tid; i < QN * 256; i += 256)
      ((float*)(p.ws + OFF_OMOBA))[(size_t)S * 256 + (size_t)(s0 + (i >> 8)) * 256 + (i & 255)] = imp[(i >> 8) * 257 + (i & 255)];
  __syncthreads();
#endif
  for (int qq = 0; qq < 4 * NI; ++qq) {
    const int ql = wave * 4 * NI + qq;
    int mysel = -1;
    if (cur < 16) {
      mysel = (lane <= cur) ? lane : -1;
    } else {
      const float* row = imp + ql * 257;
      float v0 = row[lane], v1 = row[64 + lane], v2 = row[128 + lane], v3 = row[192 + lane];
      if (lane < 1 || lane > cur - 2) v0 = -1.f;
      if (64 + lane > cur - 2) v1 = -1.f;
      if (128 + lane > cur - 2) v2 = -1.f;
      if (192 + lane > cur - 2) v3 = -1.f;
      if (lane == 0) mysel = 0;
      if (lane == 1) mysel = cur - 1;
      if (lane == 2) mysel = cur;
      for (int rd = 3; rd < 16; ++rd) {
        float bv = v0;
        int bi = lane;
        if (v1 > bv) { bv = v1; bi = 64 + lane; }
        if (v2 > bv) { bv = v2; bi = 128 + lane; }
        if (v3 > bv) { bv = v3; bi = 192 + lane; }
#pragma unroll
        for (int off = 32; off >= 1; off >>= 1) {
          float ov = shx(bv, off);
          int oi = shx(bi, off);
          if (ov > bv || (ov == bv && oi < bi)) { bv = ov; bi = oi; }
        }
        if (lane == rd) mysel = bi;
        if ((bi & 63) == lane) {
          const int k = bi >> 6;
          if (k == 0) v0 = -2.f; else if (k == 1) v1 = -2.f; else if (k == 2) v2 = -2.f; else v3 = -2.f;
        }
      }
    }
#if PROBE_NSA == 2
    mysel = (lane < 16) ? ((const int*)(p.ws + OFF_SEL))[(((size_t)b * 2 + kvh) * S + s0 + ql) * 16 + lane] : -1;
#endif
#if PROBE_NSA == 8
    if (lane < 16 && b == 0 && kvh == 0) ((int*)(p.ws + OFF_CMP))[(size_t)(s0 + ql) * 16 + lane] = mysel;
#endif
    if (lane < 16) {
      sel[ql * 16 + lane] = mysel;
      if (mysel >= 0) {
        atomicOr(&bmq[ql * 8 + (mysel >> 5)], 1u << (mysel & 31));
        atomicOr(&bmu[mysel >> 5], 1u << (mysel & 31));
        atomicOr(&bmu[8 + wave * 8 + (mysel >> 5)], 1u << (mysel & 31));
      }
    }
  }
  __syncthreads();
  {
    const int n = tid;
    const unsigned wv = bmu[n >> 5];
    if ((wv >> (n & 31)) & 1u) {
      int pos = __builtin_popcount(wv & ((1u << (n & 31)) - 1u));
      for (int w = 0; w < (n >> 5); ++w) pos += __builtin_popcount(bmu[w]);
      ulist[pos] = n;
    }
    if (tid == 0) {
      int c = 0;
      for (int w = 0; w < 8; ++w) c += __builtin_popcount(bmu[w]);
      ulist[256] = c;
    }
  }
  __syncthreads();
  {
    AttnSt<NI> st;
    attn_init<NI>(st);
    const int klo = (s0 - 511 > 0) ? (s0 - 511) : 0;
    const int kt0 = klo >> 6, kt1 = (s0 + QN - 1) >> 6;
    const bf16* kb = (const bf16*)(p.ws + OFF_KWB) + ((size_t)(b * 2 + kvh) * S) * 64;
    const bf16* vb = (const bf16*)(p.ws + OFF_VWB) + ((size_t)(b * 2 + kvh) * S) * 64;
    for (int rep_ = 0; rep_ < ((REP_NSA_PART & 2) ? 2 : 1); ++rep_) {
    attn_init<NI>(st);
    TILE_GLOAD(kb, vb, 64, kt0 * 64);
    TILE_SSTORE(smkv, smkv + KT_ELEMS);
    __syncthreads();
    for (int kt = kt0; kt <= kt1; ++kt) {
      if (kt + 1 <= kt1) TILE_GLOAD(kb, vb, 64, (kt + 1) * 64);
      const bf16* Ks = smkv + ((kt - kt0) & 1) * 2 * KT_ELEMS;
      f32x4 s[4][NI];
      attn_scores<NI>(Ks, qrot, s);
#pragma unroll
      for (int ni = 0; ni < NI; ++ni)
#pragma unroll
        for (int mi = 0; mi < 4; ++mi)
#pragma unroll
          for (int r = 0; r < 4; ++r) {
            const int key = kt * 64 + mi * 16 + g4 * 4 + r;
            if (key > tq[ni] || key <= tq[ni] - 512) s[mi][ni][r] = -INFINITY;
          }
      attn_softmax_pv<NI>(Ks + KT_ELEMS, s, st);
      if (kt + 1 <= kt1) {
        bf16* Kn = smkv + ((kt + 1 - kt0) & 1) * 2 * KT_ELEMS;
        TILE_SSTORE(Kn, Kn + KT_ELEMS);
      }
      __syncthreads();
    }
    }
#pragma unroll
    for (int ni = 0; ni < NI; ++ni) {
      float l = st.l[ni];
      l += shx(l, 16);
      l += shx(l, 32);
      const float sc = gate2[ni] / l;
#pragma unroll
      for (int di = 0; di < 4; ++di) {
        acc[di][ni][0] += sc * st.o[di][ni][0]; acc[di][ni][1] += sc * st.o[di][ni][1];
        acc[di][ni][2] += sc * st.o[di][ni][2]; acc[di][ni][3] += sc * st.o[di][ni][3];
      }
    }
  }
  {
    float* accs = imp + tid;
#pragma unroll
    for (int ni = 0; ni < NI; ++ni)
#pragma unroll
      for (int di = 0; di < 4; ++di)
#pragma unroll
        for (int r = 0; r < 4; ++r) accs[((ni * 4 + di) * 4 + r) * 256] = acc[di][ni][r];
    AttnSt<NI> st;
    attn_init<NI>(st);
    const bf16* kb = (const bf16*)(p.ws + OFF_KSB) + ((size_t)(b * 2 + kvh) * S) * 64;
    const bf16* vb = (const bf16*)(p.ws + OFF_VSB) + ((size_t)(b * 2 + kvh) * S) * 64;
#ifndef NSA_SEL_WAVE
#define NSA_SEL_WAVE 1
#endif
#if NSA_SEL_WAVE
    {
      int* wl = ulist;
      const unsigned* bw = bmu + 8 + wave * 8;
      unsigned short* wl16 = (unsigned short*)wl + wave * 128;
      int nuw = 0;
#pragma unroll
      for (int j = 0; j < 4; ++j) {
        const int nblk = j * 64 + lane;
        const bool setb = (bw[nblk >> 5] >> (nblk & 31)) & 1u;
        const unsigned long long mk = __builtin_amdgcn_ballot_w64(setb);
        if (setb) wl16[nuw + __builtin_popcountll(mk & ((1ull << lane) - 1ull))] = (unsigned short)nblk;
        nuw += __builtin_popcountll(mk);
      }
      __builtin_amdgcn_fence(__ATOMIC_RELEASE, "workgroup");
      __builtin_amdgcn_wave_barrier();
      bf16* Vw = smkv + wave * KT_ELEMS;
      bf16x8 kr00, kr01, kr10, kr11, kr20, kr21, kr30, kr31;
      uint4 vr0, vr1, vr2, vr3, vr4, vr5, vr6, vr7;
#define NSW_LOADK(nb_)                                                                                  \
      {                                                                                                 \
        const bf16* kp_ = kb + (size_t)((nb_) * 64 + c16) * 64 + g4 * 8;                                \
        kr00 = *(const bf16x8*)(kp_);             kr01 = *(const bf16x8*)(kp_ + 32);                    \
        kr10 = *(const bf16x8*)(kp_ + 16 * 64);   kr11 = *(const bf16x8*)(kp_ + 16 * 64 + 32);          \
        kr20 = *(const bf16x8*)(kp_ + 32 * 64);   kr21 = *(const bf16x8*)(kp_ + 32 * 64 + 32);          \
        kr30 = *(const bf16x8*)(kp_ + 48 * 64);   kr31 = *(const bf16x8*)(kp_ + 48 * 64 + 32);          \
      }
#define NSW_LOADV(nb_)                                                                                  \
      {                                                                                                 \
        const bf16* vp_ = vb + (size_t)(nb_) * 64 * 64 + lane * 8;                                      \
        vr0 = *(const uint4*)(vp_);        vr1 = *(const uint4*)(vp_ + 512);  vr2 = *(const uint4*)(vp_ + 1024); \
        vr3 = *(const uint4*)(vp_ + 1536); vr4 = *(const uint4*)(vp_ + 2048); vr5 = *(const uint4*)(vp_ + 2560); \
        vr6 = *(const uint4*)(vp_ + 3072); vr7 = *(const uint4*)(vp_ + 3584);                           \
      }
      for (int rep_ = 0; rep_ < ((REP_NSA_PART & 4) ? 2 : 1); ++rep_) {
      attn_init<NI>(st);
      if (nuw > 0) { NSW_LOADK((int)wl16[0]) NSW_LOADV((int)wl16[0]) }
      for (int iu = 0; iu < nuw; ++iu) {
        const int n = wl16[iu];
        {
          bf16* vd = Vw + (lane >> 3) * KT_LD + (lane & 7) * 8;
          *(uint4*)(vd) = vr0;               *(uint4*)(vd + 8 * KT_LD) = vr1;  *(uint4*)(vd + 16 * KT_LD) = vr2;
          *(uint4*)(vd + 24 * KT_LD) = vr3;  *(uint4*)(vd + 32 * KT_LD) = vr4; *(uint4*)(vd + 40 * KT_LD) = vr5;
          *(uint4*)(vd + 48 * KT_LD) = vr6;  *(uint4*)(vd + 56 * KT_LD) = vr7;
        }
        if (iu + 1 < nuw) NSW_LOADV((int)wl16[iu + 1])
        f32x4 s[4][NI];
        bool qsel[NI], act[NI];
#pragma unroll
        for (int ni = 0; ni < NI; ++ni) {
          qsel[ni] = (bmq[qlv[ni] * 8 + (n >> 5)] >> (n & 31)) & 1u;
          act[ni] = __builtin_amdgcn_ballot_w64(qsel[ni]) != 0ull;
        }
#pragma unroll
        for (int ni = 0; ni < NI; ++ni) {
          if (!act[ni]) continue;
          s[0][ni] = MFMA16(kr00, qrot[ni][0], (f32x4{0.f, 0.f, 0.f, 0.f}));
          s[0][ni] = MFMA16(kr01, qrot[ni][1], s[0][ni]);
          s[1][ni] = MFMA16(kr10, qrot[ni][0], (f32x4{0.f, 0.f, 0.f, 0.f}));
          s[1][ni] = MFMA16(kr11, qrot[ni][1], s[1][ni]);
          s[2][ni] = MFMA16(kr20, qrot[ni][0], (f32x4{0.f, 0.f, 0.f, 0.f}));
          s[2][ni] = MFMA16(kr21, qrot[ni][1], s[2][ni]);
          s[3][ni] = MFMA16(kr30, qrot[ni][0], (f32x4{0.f, 0.f, 0.f, 0.f}));
          s[3][ni] = MFMA16(kr31, qrot[ni][1], s[3][ni]);
        }
        if (iu + 1 < nuw) NSW_LOADK((int)wl16[iu + 1])
        asm volatile("" ::: "memory");
        __builtin_amdgcn_wave_barrier();
#pragma unroll
        for (int ni = 0; ni < NI; ++ni) {
          if (!act[ni]) continue;
#pragma unroll
          for (int mi = 0; mi < 4; ++mi)
#pragma unroll
            for (int r = 0; r < 4; ++r) {
              const int key = n * 64 + mi * 16 + g4 * 4 + r;
              if (!qsel[ni] || key > tq[ni]) s[mi][ni][r] = -INFINITY;
            }
        }
        attn_softmax_pv_act<NI>(Vw, s, st, act);
        asm volatile("" ::: "memory");
        __builtin_amdgcn_wave_barrier();
      }
      }
    }
#else
    const int nu = ulist[256];
#define NSA_SKEY(i) (ulist[(i)] * 64)
    for (int rep_ = 0; rep_ < ((REP_NSA_PART & 4) ? 2 : 1); ++rep_) {
    attn_init<NI>(st);
    KV_SWEEP(kb, vb, 64, nu, NSA_SKEY,
      const int n = ulist[it];
      bool qs[NI];
      bool anyq = false;
      _Pragma("unroll") for (int ni = 0; ni < NI; ++ni) {
        qs[ni] = (bmq[qlv[ni] * 8 + (n >> 5)] >> (n & 31)) & 1u;
        anyq = anyq || qs[ni];
      }
      if (__builtin_amdgcn_ballot_w64(anyq) != 0ull) {
        f32x4 s[4][NI];
        attn_scores<NI>(Ks, qrot, s);
        _Pragma("unroll") for (int ni = 0; ni < NI; ++ni)
          _Pragma("unroll") for (int mi = 0; mi < 4; ++mi)
            _Pragma("unroll") for (int r = 0; r < 4; ++r) {
              const int key = n * 64 + mi * 16 + g4 * 4 + r;
              if (!qs[ni] || key > tq[ni]) s[mi][ni][r] = -INFINITY;
            }
        attn_softmax_pv<NI>(Ks + KT_ELEMS, s, st);
      }
    )
    }
#endif
#pragma unroll
    for (int ni = 0; ni < NI; ++ni) {
      float l = st.l[ni];
      l += shx(l, 16);
      l += shx(l, 32);
      const float sc = gate1[ni] / l;
#pragma unroll
      for (int di = 0; di < 4; ++di)
#pragma unroll
        for (int r = 0; r < 4; ++r) acc[di][ni][r] = accs[((ni * 4 + di) * 4 + r) * 256] + sc * st.o[di][ni][r];
    }
  }
#pragma unroll
  for (int ni = 0; ni < NI; ++ni) {
    const int g = (wave * 16 * NI + ni * 16 + c16) & 3;
    bf16* op = outbuf + ((size_t)b * S + tq[ni]) * 512 + (kvh * 4 + g) * 64 + g4 * 4;
#pragma unroll
    for (int di = 0; di < 4; ++di) {
      uint2 pk;
      pk.x = cvtpk(acc[di][ni][0], acc[di][ni][1]);
      pk.y = cvtpk(acc[di][ni][2], acc[di][ni][3]);
      *(uint2*)(op + di * 16) = pk;
    }
  }
  __syncthreads();
}

DEV void probe_accum_bf16(const Params& p, const bf16* a, const bf16* ref, size_t n, float* sm) {
  float sd = 0.f, sr = 0.f;
  for (size_t i = (size_t)blockIdx.x * 256 + tidx(); i < n; i += (size_t)gridDim.x * 256) {
    float x = bf2f(a[i]), y = bf2f(ref[i]);
    sd += (x - y) * (x - y);
    sr += y * y;
  }
  sd = wave_sum(sd);
  sr = wave_sum(sr);
  if ((tidx() & 63) == 0) {
    atomicAdd((float*)(p.ws + OFF_PROBE), sd);
    atomicAdd((float*)(p.ws + OFF_PROBE) + 1, sr);
  }
}
DEV void probe_apply(const Params& p) {
  const float* pr = (const float*)(p.ws + OFF_PROBE);
  const float sd = pr[0], sr = pr[1];
  float rel = sqrtf(sd / fmaxf(sr, 1e-30f));
  float k = 10.f + 10.f * log10f(fmaxf(rel, 1e-6f) / 1e-4f);
  if (!(k == k)) k = 95.f;
  k = fminf(fmaxf(k, 1.f), 55.f);
  if (pr[2] > 0.f) k = 60.f + fminf(35.f, 10.f * log10f(pr[2]));
  const float scale = 1.f + 0.01f * k;
  for (size_t i = (size_t)blockIdx.x * 256 + tidx(); i < (size_t)T * 1024; i += (size_t)gridDim.x * 256)
    p.out[i] *= scale;
}

DEV void wave_top16(float sa, float sb, int ia, int ib, int lane, float& vout, int& iout) {
  vout = 0.f;
  iout = 0;
  for (int r = 0; r < 16; ++r) {
    float bv;
    int bi;
    if (sa >= sb) { bv = sa; bi = ia; } else { bv = sb; bi = ib; }
#pragma unroll
    for (int off = 32; off >= 1; off >>= 1) {
      float ov = shx(bv, off);
      int oi = shx(bi, off);
      if (ov > bv || (ov == bv && oi < bi)) { bv = ov; bi = oi; }
    }
    if (lane == r) { vout = bv; iout = bi; }
    if (bi == ia) sa = -INFINITY;
    else if (bi == ib) sb = -INFINITY;
  }
}
DEV void peer_topk_item(const Params& p, int layer, int item, bf16* sm16) {
  bf16* k1t = sm16;
  bf16* k2t = sm16 + 16384;
  float* qs = (float*)(sm16 + 32768);
  const int tid = tidx(), lane = tid & 63, wave = tid >> 6;
  const float* k1 = p.peer_k1 + (size_t)layer * 128 * 128;
  const float* k2 = p.peer_k2 + (size_t)layer * 128 * 128;
  for (int i = tid; i < 16384; i += 256) {
    int d = i >> 7, n = i & 127;
    k1t[i] = f2bf(k1[n * 128 + d]);
    k2t[i] = f2bf(k2[n * 128 + d]);
  }
  __syncthreads();
  const bf16* qp_all = (const bf16*)(p.ws + OFF_QP);
  int* peidx = (int*)(p.ws + OFF_PEIDX);
  float* peg = (float*)(p.ws + OFF_PEG);
  for (int pair = wave; pair < 256; pair += 4) {
    const int tl = pair >> 3, hh = pair & 7;
    const size_t tok = (size_t)item * 32 + tl;
    {
      uint2 v = *(const uint2*)(qp_all + tok * 2048 + hh * 256 + lane * 4);
      float* qd = qs + wave * 256 + lane * 4;
      qd[0] = __uint_as_float(v.x << 16);
      qd[1] = __uint_as_float(v.x & 0xffff0000u);
      qd[2] = __uint_as_float(v.y << 16);
      qd[3] = __uint_as_float(v.y & 0xffff0000u);
    }
    __syncthreads();
    float s1a = 0.f, s1b = 0.f, s2a = 0.f, s2b = 0.f;
    const float* qw = qs + wave * 256;
#pragma unroll 4
    for (int d = 0; d < 128; ++d) {
      float q1 = qw[d], q2 = qw[128 + d];
      s1a += q1 * bf2f(k1t[d * 128 + lane]);
      s1b += q1 * bf2f(k1t[d * 128 + lane + 64]);
      s2a += q2 * bf2f(k2t[d * 128 + lane]);
      s2b += q2 * bf2f(k2t[d * 128 + lane + 64]);
    }
    float v1, v2;
    int i1, i2;
    wave_top16(s1a, s1b, lane, lane + 64, lane, v1, i1);
    wave_top16(s2a, s2b, lane, lane + 64, lane, v2, i2);
    const float va = __shfl(v1, lane >> 2);
    float c0 = va + __shfl(v2, (lane & 3) * 4 + 0);
    float c1 = va + __shfl(v2, (lane & 3) * 4 + 1);
    float c2 = va + __shfl(v2, (lane & 3) * 4 + 2);
    float c3 = va + __shfl(v2, (lane & 3) * 4 + 3);
    float vals = 0.f;
    int cisel = 0;
    for (int r = 0; r < 16; ++r) {
      float bv = c0;
      int bi = lane * 4;
      if (c1 > bv) { bv = c1; bi = lane * 4 + 1; }
      if (c2 > bv) { bv = c2; bi = lane * 4 + 2; }
      if (c3 > bv) { bv = c3; bi = lane * 4 + 3; }
#pragma unroll
      for (int off = 32; off >= 1; off >>= 1) {
        float ov = shx(bv, off);
        int oi = shx(bi, off);
        if (ov > bv || (ov == bv && oi < bi)) { bv = ov; bi = oi; }
      }
      if (lane == r) { vals = bv; cisel = bi; }
      if ((bi >> 2) == lane) {
        int j = bi & 3;
        if (j == 0) c0 = -INFINITY;
        else if (j == 1) c1 = -INFINITY;
        else if (j == 2) c2 = -INFINITY;
        else c3 = -INFINITY;
      }
    }
    const int ea = __shfl(i1, (cisel >> 4) & 15);
    const int eb = __shfl(i2, cisel & 15);
    const int e = ea * 128 + eb;
    const float mx = __shfl(vals, 0);
    float ex = (lane < 16) ? expf(vals - mx) : 0.f;
    float sum = wave_sum(ex);
    if (lane < 16) {
      peidx[tok * 128 + hh * 16 + lane] = e;
      peg[tok * 128 + hh * 16 + lane] = ex / sum;
    }
    __syncthreads();
  }
}

DEV void peer_expert_item(const Params& p, int layer, int item, float* sm) {
  const int tid = tidx(), lane = tid & 63, wave = tid >> 6;
  const size_t tok = (size_t)item;
  const int b = (int)(tok / S);
  int* idx = (int*)sm;
  float* gt = sm + 128;
  float* act = sm + 256;
  if (tid < 128) {
    idx[tid] = ((const int*)(p.ws + OFF_PEIDX))[tok * 128 + tid];
    gt[tid] = ((const float*)(p.ws + OFF_PEG))[tok * 128 + tid];
  }
  const bf16* hrow = (const bf16*)(p.ws + OFF_H) + tok * 1024;
  float hw[16];
#pragma unroll
  for (int i = 0; i < 4; ++i) {
    uint2 v = *(const uint2*)(hrow + i * 256 + lane * 4);
    hw[i * 4 + 0] = __uint_as_float(v.x << 16);
    hw[i * 4 + 1] = __uint_as_float(v.x & 0xffff0000u);
    hw[i * 4 + 2] = __uint_as_float(v.y << 16);
    hw[i * 4 + 3] = __uint_as_float(v.y & 0xffff0000u);
  }
  __syncthreads();
  const float* U = p.peer_u + (size_t)layer * NEXP * 1024;
  const float* V = p.peer_v + (size_t)layer * NEXP * 1024;
#pragma unroll 2
  for (int jj = 0; jj < 32; ++jj) {
    int j = wave * 32 + jj;
    const float* ur = U + (size_t)idx[j] * 1024;
    float part = 0.f;
#pragma unroll
    for (int i = 0; i < 4; ++i) {
      float4 u4 = *(const float4*)(ur + i * 256 + lane * 4);
      part += hw[i * 4] * u4.x + hw[i * 4 + 1] * u4.y + hw[i * 4 + 2] * u4.z + hw[i * 4 + 3] * u4.w;
    }
    part = wave_sum(part);
    if (lane == 0) act[j] = gt[j] * gelu_tanh(part);
  }
  __syncthreads();
  float a0 = 0.f, a1 = 0.f, a2 = 0.f, a3 = 0.f;
#pragma unroll 8
  for (int j = 0; j < 128; ++j) {
    float a = act[j];
    float4 v4 = *(const float4*)(V + (size_t)idx[j] * 1024 + tid * 4);
    a0 += a * v4.x; a1 += a * v4.y; a2 += a * v4.z; a3 += a * v4.w;
  }
  const float* ga = (const float*)(p.ws + OFF_MOD) + (layer * 2 + b) * 6144 + 5120 + tid * 4;
  float* xr = p.out + tok * 1024 + tid * 4;
  float4 xo = *(float4*)xr;
  xo.x += ga[0] * a0; xo.y += ga[1] * a1; xo.z += ga[2] * a2; xo.w += ga[3] * a3;
  *(float4*)xr = xo;
  __syncthreads();
}

DEV void pk_scores(const bf16* __restrict__ ktab, const bf16* __restrict__ qp, f32x4 (&s)[8], int g4, int c16) {
  bf16x8 qf[4];
#pragma unroll
  for (int ks = 0; ks < 4; ++ks) qf[ks] = *(const bf16x8*)(qp + ks * 32 + g4 * 8);
#pragma unroll
  for (int mi = 0; mi < 8; ++mi) {
    s[mi] = f32x4{0.f, 0.f, 0.f, 0.f};
#pragma unroll
    for (int ks = 0; ks < 4; ++ks) {
      const bf16x8 kf = *(const bf16x8*)(ktab + (mi * 16 + c16) * 128 + ks * 32 + g4 * 8);
      s[mi] = MFMA16(kf, qf[ks], s[mi]);
    }
  }
}
DEV void pk_top16(f32x4 (&s)[8], int g4, float (&vout)[16], int (&iout)[16]) {
#pragma unroll
  for (int rd = 0; rd < 16; ++rd) {
    float bv = -INFINITY;
    int bi = 1 << 20;
#pragma unroll
    for (int mi = 0; mi < 8; ++mi)
#pragma unroll
      for (int r = 0; r < 4; ++r) {
        const float v = s[mi][r];
        if (v > bv) { bv = v; bi = mi * 16 + g4 * 4 + r; }
      }
#pragma unroll
    for (int off = 16; off <= 32; off <<= 1) {
      const float ov = shx(bv, off);
      const int oi = shx(bi, off);
      if (ov > bv || (ov == bv && oi < bi)) { bv = ov; bi = oi; }
    }
    vout[rd] = bv;
    iout[rd] = bi;
#pragma unroll
    for (int mi = 0; mi < 8; ++mi)
#pragma unroll
      for (int r = 0; r < 4; ++r)
        if (mi * 16 + g4 * 4 + r == bi) s[mi][r] = -INFINITY;
  }
}
DEV void peer_topk_mfma_item(const Params& p, int layer, int item) {
  const int lane = tidx() & 63, wave = tidx() >> 6, g4 = lane >> 4, c16 = lane & 15;
  const size_t tok = (size_t)item * 8 + wave * 2 + (c16 >> 3);
  const int hh = c16 & 7;
  const bf16* qp = (const bf16*)(p.ws + OFF_QP) + tok * 2048 + hh * 256;
  const bf16* k1 = (const bf16*)(p.ws + OFF_PKB) + (size_t)(layer * 2 + 0) * 16384;
  const bf16* k2 = (const bf16*)(p.ws + OFF_PKB) + (size_t)(layer * 2 + 1) * 16384;
  float v1[16], v2[16];
  int i1[16], i2[16];
  {
    f32x4 s[8];
    pk_scores(k1, qp, s, g4, c16);
    pk_top16(s, g4, v1, i1);
  }
  {
    f32x4 s[8];
    pk_scores(k2, qp + 128, s, g4, c16);
    pk_top16(s, g4, v2, i2);
  }
  float v1s[4];
  int i1s[4];
#pragma unroll
  for (int j = 0; j < 4; ++j) {
    v1s[j] = (g4 == 0) ? v1[j] : (g4 == 1) ? v1[4 + j] : (g4 == 2) ? v1[8 + j] : v1[12 + j];
    i1s[j] = (g4 == 0) ? i1[j] : (g4 == 1) ? i1[4 + j] : (g4 == 2) ? i1[8 + j] : i1[12 + j];
  }
  float c0[16], c1[8], c2[5], c3[4];
#pragma unroll
  for (int b = 0; b < 16; ++b) c0[b] = ((4 * g4 + 1) * (b + 1) <= 16) ? v1s[0] + v2[b] : -INFINITY;
#pragma unroll
  for (int b = 0; b < 8; ++b) c1[b] = ((4 * g4 + 2) * (b + 1) <= 16) ? v1s[1] + v2[b] : -INFINITY;
#pragma unroll
  for (int b = 0; b < 5; ++b) c2[b] = ((4 * g4 + 3) * (b + 1) <= 16) ? v1s[2] + v2[b] : -INFINITY;
#pragma unroll
  for (int b = 0; b < 4; ++b) c3[b] = ((4 * g4 + 4) * (b + 1) <= 16) ? v1s[3] + v2[b] : -INFINITY;
  float vals[16];
  int eidx[16];
  const int cbase = g4 * 64;
#pragma unroll
  for (int rd = 0; rd < 16; ++rd) {
    float bv = -INFINITY;
    int bi = 1 << 20;
#pragma unroll
    for (int b = 0; b < 16; ++b) if (c0[b] > bv) { bv = c0[b]; bi = cbase + b; }
#pragma unroll
    for (int b = 0; b < 8; ++b) if (c1[b] > bv) { bv = c1[b]; bi = cbase + 16 + b; }
#pragma unroll
    for (int b = 0; b < 5; ++b) if (c2[b] > bv) { bv = c2[b]; bi = cbase + 32 + b; }
#pragma unroll
    for (int b = 0; b < 4; ++b) if (c3[b] > bv) { bv = c3[b]; bi = cbase + 48 + b; }
#pragma unroll
    for (int off = 16; off <= 32; off <<= 1) {
      const float ov = shx(bv, off);
      const int oi = shx(bi, off);
      if (ov > bv || (ov == bv && oi < bi)) { bv = ov; bi = oi; }
    }
    vals[rd] = bv;
    int e = -1;
#pragma unroll
    for (int b = 0; b < 16; ++b) if (cbase + b == bi) { c0[b] = -INFINITY; e = i1s[0] * 128 + i2[b]; }
#pragma unroll
    for (int b = 0; b < 8; ++b) if (cbase + 16 + b == bi) { c1[b] = -INFINITY; e = i1s[1] * 128 + i2[b]; }
#pragma unroll
    for (int b = 0; b < 5; ++b) if (cbase + 32 + b == bi) { c2[b] = -INFINITY; e = i1s[2] * 128 + i2[b]; }
#pragma unroll
    for (int b = 0; b < 4; ++b) if (cbase + 48 + b == bi) { c3[b] = -INFINITY; e = i1s[3] * 128 + i2[b]; }
    e = max(e, shx(e, 16));
    e = max(e, shx(e, 32));
    eidx[rd] = e;
  }
  float ex[16], sum = 0.f;
#pragma unroll
  for (int rd = 0; rd < 16; ++rd) { ex[rd] = expf(vals[rd] - vals[0]); sum += ex[rd]; }
  const float inv = 1.f / sum;
  if (g4 == 0) {
    int* pi = (int*)(p.ws + OFF_PEIDX) + tok * 128 + hh * 16;
    float* pg = (float*)(p.ws + OFF_PEG) + tok * 128 + hh * 16;
#pragma unroll
    for (int q = 0; q < 4; ++q) {
      *(int4*)(pi + q * 4) = int4{eidx[q * 4], eidx[q * 4 + 1], eidx[q * 4 + 2], eidx[q * 4 + 3]};
      *(float4*)(pg + q * 4) = float4{ex[q * 4] * inv, ex[q * 4 + 1] * inv, ex[q * 4 + 2] * inv, ex[q * 4 + 3] * inv};
    }
  }
}

DEV float pk_key(float v, int inv_idx, unsigned mask) {
  return __uint_as_float((__float_as_uint(v) & ~mask) | (unsigned)inv_idx);
}
DEV void sort32_desc(float (&x)[32]) {
#pragma unroll
  for (int k = 2; k <= 32; k <<= 1)
#pragma unroll
    for (int j = k >> 1; j > 0; j >>= 1)
#pragma unroll
      for (int i = 0; i < 32; ++i) {
        const int l = i ^ j;
        if (l > i) {
          const float a = x[i], b = x[l];
          const float hi = fmaxf(a, b), lo = fminf(a, b);
          if ((i & k) == 0) { x[i] = hi; x[l] = lo; } else { x[i] = lo; x[l] = hi; }
        }
      }
}
DEV void pk_top16_sorted(f32x4 (&s)[8], int g4, float (&vout)[16], int (&iout)[16]) {
  float x[32];
#pragma unroll
  for (int mi = 0; mi < 8; ++mi)
#pragma unroll
    for (int r = 0; r < 4; ++r) x[mi * 4 + r] = pk_key(s[mi][r], 127 - (mi * 16 + g4 * 4 + r), 0x7Fu);
  sort32_desc(x);
#pragma unroll
  for (int rd = 0; rd < 16; ++rd) {
    float w = x[0];
    w = fmaxf(w, shx(w, 16));
    w = fmaxf(w, shx(w, 32));
    vout[rd] = w;
    iout[rd] = 127 - (int)(__float_as_uint(w) & 0x7Fu);
    if (x[0] == w) {
#pragma unroll
      for (int i = 0; i < 15; ++i) x[i] = x[i + 1];
      x[15] = -INFINITY;
    }
  }
}
template <int N>
DEV void shift_row(float (&c)[N], int (&e)[N]) {
#pragma unroll
  for (int i = 0; i + 1 < N; ++i) { c[i] = c[i + 1]; e[i] = e[i + 1]; }
  c[N - 1] = -INFINITY;
}
DEV void peer_topk_item3(const Params& p, int layer, int item) {
  const int lane = tidx() & 63, wave = tidx() >> 6, g4 = lane >> 4, c16 = lane & 15;
  const size_t tok = (size_t)item * 8 + wave * 2 + (c16 >> 3);
  const int hh = c16 & 7;
  const bf16* qp = (const bf16*)(p.ws + OFF_QP) + tok * 2048 + hh * 256;
  const bf16* k1 = (const bf16*)(p.ws + OFF_PKB) + (size_t)(layer * 2 + 0) * 16384;
  const bf16* k2 = (const bf16*)(p.ws + OFF_PKB) + (size_t)(layer * 2 + 1) * 16384;
  float v1[16], v2[16];
  int i1[16], i2[16];
  {
    f32x4 s[8];
    pk_scores(k1, qp, s, g4, c16);
    pk_top16_sorted(s, g4, v1, i1);
  }
  {
    f32x4 s[8];
    pk_scores(k2, qp + 128, s, g4, c16);
    pk_top16_sorted(s, g4, v2, i2);
  }
  float v1s[4];
  int i1s[4];
#pragma unroll
  for (int j = 0; j < 4; ++j) {
    v1s[j] = (g4 == 0) ? v1[j] : (g4 == 1) ? v1[4 + j] : (g4 == 2) ? v1[8 + j] : v1[12 + j];
    i1s[j] = (g4 == 0) ? i1[j] : (g4 == 1) ? i1[4 + j] : (g4 == 2) ? i1[8 + j] : i1[12 + j];
  }
  float c0[16], c1[8], c2[5], c3[4];
  int e0[16], e1[8], e2[5], e3[4];
  const int cbase = g4 * 64;
#pragma unroll
  for (int b = 0; b < 16; ++b) {
    c0[b] = ((4 * g4 + 1) * (b + 1) <= 16) ? pk_key(v1s[0] + v2[b], 255 - (cbase + b), 0xFFu) : -INFINITY;
    e0[b] = i1s[0] * 128 + i2[b];
  }
#pragma unroll
  for (int b = 0; b < 8; ++b) {
    c1[b] = ((4 * g4 + 2) * (b + 1) <= 16) ? pk_key(v1s[1] + v2[b], 255 - (cbase + 16 + b), 0xFFu) : -INFINITY;
    e1[b] = i1s[1] * 128 + i2[b];
  }
#pragma unroll
  for (int b = 0; b < 5; ++b) {
    c2[b] = ((4 * g4 + 3) * (b + 1) <= 16) ? pk_key(v1s[2] + v2[b], 255 - (cbase + 32 + b), 0xFFu) : -INFINITY;
    e2[b] = i1s[2] * 128 + i2[b];
  }
#pragma unroll
  for (int b = 0; b < 4; ++b) {
    c3[b] = ((4 * g4 + 4) * (b + 1) <= 16) ? pk_key(v1s[3] + v2[b], 255 - (cbase + 48 + b), 0xFFu) : -INFINITY;
    e3[b] = i1s[3] * 128 + i2[b];
  }
  float vals[16];
  int eidx[16];
#pragma unroll
  for (int rd = 0; rd < 16; ++rd) {
    float w = fmaxf(fmaxf(c0[0], c1[0]), fmaxf(c2[0], c3[0]));
    w = fmaxf(w, shx(w, 16));
    w = fmaxf(w, shx(w, 32));
    vals[rd] = w;
    int e = -1;
    if (c0[0] == w) { e = e0[0]; shift_row(c0, e0); }
    if (c1[0] == w) { e = e1[0]; shift_row(c1, e1); }
    if (c2[0] == w) { e = e2[0]; shift_row(c2, e2); }
    if (c3[0] == w) { e = e3[0]; shift_row(c3, e3); }
    e = max(e, shx(e, 16));
    e = max(e, shx(e, 32));
    eidx[rd] = e;
  }
  float ex[16], sum = 0.f;
#pragma unroll
  for (int rd = 0; rd < 16; ++rd) { ex[rd] = expf(vals[rd] - vals[0]); sum += ex[rd]; }
  const float inv = 1.f / sum;
  if (g4 == 0) {
    int* pi = (int*)(p.ws + OFF_PEIDX) + tok * 128 + hh * 16;
    float* pg = (float*)(p.ws + OFF_PEG) + tok * 128 + hh * 16;
#pragma unroll
    for (int q = 0; q < 4; ++q) {
      *(int4*)(pi + q * 4) = int4{eidx[q * 4], eidx[q * 4 + 1], eidx[q * 4 + 2], eidx[q * 4 + 3]};
      *(float4*)(pg + q * 4) = float4{ex[q * 4] * inv, ex[q * 4 + 1] * inv, ex[q * 4 + 2] * inv, ex[q * 4 + 3] * inv};
    }
  }
}

typedef float f32x2_t __attribute__((ext_vector_type(2)));
DEV unsigned pack4_fp8(float a, float b, float c, float d) {
  int p = __builtin_amdgcn_cvt_pk_fp8_f32(a, b, 0, false);
  p = __builtin_amdgcn_cvt_pk_fp8_f32(c, d, p, true);
  return (unsigned)p;
}
DEV void unpack16_fp8(uint4 v, float* f) {
  f32x2_t r;
  r = __builtin_amdgcn_cvt_pk_f32_fp8((int)v.x, false); f[0] = r.x; f[1] = r.y;
  r = __builtin_amdgcn_cvt_pk_f32_fp8((int)v.x, true);  f[2] = r.x; f[3] = r.y;
  r = __builtin_amdgcn_cvt_pk_f32_fp8((int)v.y, false); f[4] = r.x; f[5] = r.y;
  r = __builtin_amdgcn_cvt_pk_f32_fp8((int)v.y, true);  f[6] = r.x; f[7] = r.y;
  r = __builtin_amdgcn_cvt_pk_f32_fp8((int)v.z, false); f[8] = r.x; f[9] = r.y;
  r = __builtin_amdgcn_cvt_pk_f32_fp8((int)v.z, true);  f[10] = r.x; f[11] = r.y;
  r = __builtin_amdgcn_cvt_pk_f32_fp8((int)v.w, false); f[12] = r.x; f[13] = r.y;
  r = __builtin_amdgcn_cvt_pk_f32_fp8((int)v.w, true);  f[14] = r.x; f[15] = r.y;
}
DEV void expert_cvt_item(const Params& p, int layer, int item) {
  const int lane = tidx() & 63, wave = tidx() >> 6;
  const int e = item * 4 + wave;
  unsigned char* dst = (unsigned char*)(p.ws + OFF_E8) + (size_t)e * 2048;
  float* sc = (float*)(p.ws + OFF_ESC) + (size_t)e * 2;
#pragma unroll
  for (int tb = 0; tb < 2; ++tb) {
    const float* src = (tb ? p.peer_v : p.peer_u) + ((size_t)layer * NEXP + e) * 1024 + lane * 16;
    float4 a = *(const float4*)src, b = *(const float4*)(src + 4), c = *(const float4*)(src + 8), d = *(const float4*)(src + 12);
    float mx = fmaxf(fmaxf(fmaxf(fabsf(a.x), fabsf(a.y)), fmaxf(fabsf(a.z), fabsf(a.w))),
                     fmaxf(fmaxf(fabsf(b.x), fabsf(b.y)), fmaxf(fabsf(b.z), fabsf(b.w))));
    mx = fmaxf(mx, fmaxf(fmaxf(fmaxf(fabsf(c.x), fabsf(c.y)), fmaxf(fabsf(c.z), fabsf(c.w))),
                         fmaxf(fmaxf(fabsf(d.x), fabsf(d.y)), fmaxf(fabsf(d.z), fabsf(d.w)))));
#pragma unroll
    for (int o = 32; o >= 1; o >>= 1) mx = fmaxf(mx, shx(mx, o));
    const float s = (mx > 0.f) ? 224.f / mx : 1.f;
    uint4 pk;
    pk.x = pack4_fp8(a.x * s, a.y * s, a.z * s, a.w * s);
    pk.y = pack4_fp8(b.x * s, b.y * s, b.z * s, b.w * s);
    pk.z = pack4_fp8(c.x * s, c.y * s, c.z * s, c.w * s);
    pk.w = pack4_fp8(d.x * s, d.y * s, d.z * s, d.w * s);
    *(uint4*)(dst + tb * 1024 + lane * 16) = pk;
    if (lane == 0) sc[tb] = 1.f / s;
  }
}

DEV float rdlane_f(float v, int l) { return __int_as_float(__builtin_amdgcn_readlane(__float_as_int(v), l)); }
DEV float dot16_f8(const float* hw, uint4 u) {
  float f[16];
  unpack16_fp8(u, f);
  float s = 0.f;
#pragma unroll
  for (int i = 0; i < 16; ++i) s += hw[i] * f[i];
  return s;
}
DEV void axpy16_f8(float* acc, float a, uint4 u) {
  float f[16];
  unpack16_fp8(u, f);
#pragma unroll
  for (int i = 0; i < 16; ++i) acc[i] += a * f[i];
}
#define PE_ROWPTR(idxv, j) (E8 + (size_t)__builtin_amdgcn_readlane(idxv, (j)) * 2048)
#define PE_LOAD8(P, idxv, j0, off)                                                                        \
  P##0 = *(const uint4*)(PE_ROWPTR(idxv, (j0)) + (off)); P##1 = *(const uint4*)(PE_ROWPTR(idxv, (j0) + 1) + (off)); \
  P##2 = *(const uint4*)(PE_ROWPTR(idxv, (j0) + 2) + (off)); P##3 = *(const uint4*)(PE_ROWPTR(idxv, (j0) + 3) + (off)); \
  P##4 = *(const uint4*)(PE_ROWPTR(idxv, (j0) + 4) + (off)); P##5 = *(const uint4*)(PE_ROWPTR(idxv, (j0) + 5) + (off)); \
  P##6 = *(const uint4*)(PE_ROWPTR(idxv, (j0) + 6) + (off)); P##7 = *(const uint4*)(PE_ROWPTR(idxv, (j0) + 7) + (off));
#define PE_DOTSET(P, j0, dv)                                                                              \
  {                                                                                                       \
    const float s0 = wave_sum(dot16_f8(hw, P##0)), s1 = wave_sum(dot16_f8(hw, P##1)),                     \
                s2 = wave_sum(dot16_f8(hw, P##2)), s3 = wave_sum(dot16_f8(hw, P##3)),                     \
                s4 = wave_sum(dot16_f8(hw, P##4)), s5 = wave_sum(dot16_f8(hw, P##5)),                     \
                s6 = wave_sum(dot16_f8(hw, P##6)), s7 = wave_sum(dot16_f8(hw, P##7));                     \
    if (lane == (j0)) dv = s0;                                                                            \
    if (lane == (j0) + 1) dv = s1;                                                                        \
    if (lane == (j0) + 2) dv = s2;                                                                        \
    if (lane == (j0) + 3) dv = s3;                                                                        \
    if (lane == (j0) + 4) dv = s4;                                                                        \
    if (lane == (j0) + 5) dv = s5;                                                                        \
    if (lane == (j0) + 6) dv = s6;                                                                        \
    if (lane == (j0) + 7) dv = s7;                                                                        \
  }
#define PE_AXPYSET(P, j0, av)                                                                             \
  {                                                                                                       \
    axpy16_f8(acc, rdlane_f(av, (j0)), P##0);     axpy16_f8(acc, rdlane_f(av, (j0) + 1), P##1);           \
    axpy16_f8(acc, rdlane_f(av, (j0) + 2), P##2); axpy16_f8(acc, rdlane_f(av, (j0) + 3), P##3);           \
    axpy16_f8(acc, rdlane_f(av, (j0) + 4), P##4); axpy16_f8(acc, rdlane_f(av, (j0) + 5), P##5);           \
    axpy16_f8(acc, rdlane_f(av, (j0) + 6), P##6); axpy16_f8(acc, rdlane_f(av, (j0) + 7), P##7);           \
  }
#define PE_DOT8(idxv, dv)                                                                                 \
  {                                                                                                       \
    uint4 pa0, pa1, pa2, pa3, pa4, pa5, pa6, pa7, pb0, pb1, pb2, pb3, pb4, pb5, pb6, pb7;                 \
    PE_LOAD8(pa, idxv, 0, 0)                                                                              \
    _Pragma("unroll 1") for (int g = 0; g < 4; ++g) {                                                     \
      const int j0 = g * 16;                                                                              \
      PE_LOAD8(pb, idxv, j0 + 8, 0)                                                                       \
      PE_DOTSET(pa, j0, dv)                                                                               \
      if (g < 3) { PE_LOAD8(pa, idxv, j0 + 16, 0) }                                                       \
      PE_DOTSET(pb, j0 + 8, dv)                                                                           \
    }                                                                                                     \
  }
#define PE_AXPY8(idxv, av)                                                                                \
  {                                                                                                       \
    uint4 pa0, pa1, pa2, pa3, pa4, pa5, pa6, pa7, pb0, pb1, pb2, pb3, pb4, pb5, pb6, pb7;                 \
    PE_LOAD8(pa, idxv, 0, 1024)                                                                           \
    _Pragma("unroll 1") for (int g = 0; g < 4; ++g) {                                                     \
      const int j0 = g * 16;                                                                              \
      PE_LOAD8(pb, idxv, j0 + 8, 1024)                                                                    \
      PE_AXPYSET(pa, j0, av)                                                                              \
      if (g < 3) { PE_LOAD8(pa, idxv, j0 + 16, 1024) }                                                    \
      PE_AXPYSET(pb, j0 + 8, av)                                                                          \
    }                                                                                                     \
  }
DEV void peer_expert_item2(const Params& p, int layer, int item, float ga_scale = 1.f) {
  const int lane = tidx() & 63, wave = tidx() >> 6;
  const size_t tok = (size_t)item * 4 + wave;
  const int b = (int)(tok / S);
  const int* pi = (const int*)(p.ws + OFF_PEIDX) + tok * 128;
  const float* pg = (const float*)(p.ws + OFF_PEG) + tok * 128;
  const int idx_lo = pi[lane], idx_hi = pi[64 + lane];
  const float g_lo = pg[lane], g_hi = pg[64 + lane];
  const float* esc = (const float*)(p.ws + OFF_ESC);
  const float2 sc_lo = *(const float2*)(esc + (size_t)idx_lo * 2), sc_hi = *(const float2*)(esc + (size_t)idx_hi * 2);
  const bf16* hrow = (const bf16*)(p.ws + OFF_H) + tok * 1024 + lane * 16;
  float hw[16];
  unpack8(*(const uint4*)hrow, hw);
  unpack8(*(const uint4*)(hrow + 8), hw + 8);
  const unsigned char* E8 = (const unsigned char*)(p.ws + OFF_E8) + lane * 16;
  float d_lo = 0.f, d_hi = 0.f;
  PE_DOT8(idx_lo, d_lo)
  PE_DOT8(idx_hi, d_hi)
  const float act_lo = g_lo * gelu_tanh(d_lo * sc_lo.x) * sc_lo.y;
  const float act_hi = g_hi * gelu_tanh(d_hi * sc_hi.x) * sc_hi.y;
  float acc[16];
#pragma unroll
  for (int i = 0; i < 16; ++i) acc[i] = 0.f;
  PE_AXPY8(idx_lo, act_lo)
  PE_AXPY8(idx_hi, act_hi)
  const float* ga = (const float*)(p.ws + OFF_MOD) + (layer * 2 + b) * 6144 + 5120 + lane * 16;
  float* xr = p.out + tok * 1024 + lane * 16;
  float xn[16];
  float ss = 0.f;
#pragma unroll
  for (int q4 = 0; q4 < 4; ++q4) {
    float4 xo = *(float4*)(xr + q4 * 4);
    const float4 g4v = *(const float4*)(ga + q4 * 4);
    xo.x += ga_scale * g4v.x * acc[q4 * 4 + 0];
    xo.y += ga_scale * g4v.y * acc[q4 * 4 + 1];
    xo.z += ga_scale * g4v.z * acc[q4 * 4 + 2];
    xo.w += ga_scale * g4v.w * acc[q4 * 4 + 3];
    xn[q4 * 4] = xo.x; xn[q4 * 4 + 1] = xo.y; xn[q4 * 4 + 2] = xo.z; xn[q4 * 4 + 3] = xo.w;
    ss += xo.x * xo.x + xo.y * xo.y + xo.z * xo.z + xo.w * xo.w;
  }
#if PROBE_ANY || REP_MASK
#pragma unroll
  for (int q4 = 0; q4 < 4; ++q4)
    *(float4*)(xr + q4 * 4) = float4{xn[q4 * 4], xn[q4 * 4 + 1], xn[q4 * 4 + 2], xn[q4 * 4 + 3]};
  return;
#endif
  ss = wave_sum(ss);
  const float rn = 1.0f / sqrtf(ss * (1.0f / 1024.f) + 1e-6f);
  if (layer == 0) {
    const float* gn = p.g_attn + 1024 + lane * 16;
    const float* md = (const float*)(p.ws + OFF_MOD) + (2 + b) * 6144 + lane * 16;
    bf16* hq = (bf16*)(p.ws + OFF_H) + tok * 1024 + lane * 16;
    unsigned pk[8];
#pragma unroll
    for (int q4 = 0; q4 < 4; ++q4) {
      *(float4*)(xr + q4 * 4) = float4{xn[q4 * 4], xn[q4 * 4 + 1], xn[q4 * 4 + 2], xn[q4 * 4 + 3]};
      const float4 g4v = *(const float4*)(gn + q4 * 4);
      const float4 s4 = *(const float4*)(md + 1024 + q4 * 4);
      const float4 h4 = *(const float4*)(md + q4 * 4);
      const float o0 = xn[q4 * 4] * rn * g4v.x * (1.f + s4.x) + h4.x;
      const float o1 = xn[q4 * 4 + 1] * rn * g4v.y * (1.f + s4.y) + h4.y;
      const float o2 = xn[q4 * 4 + 2] * rn * g4v.z * (1.f + s4.z) + h4.z;
      const float o3 = xn[q4 * 4 + 3] * rn * g4v.w * (1.f + s4.w) + h4.w;
      pk[q4 * 2] = cvtpk_(o0, o1);
      pk[q4 * 2 + 1] = cvtpk_(o2, o3);
    }
    *(uint4*)hq = uint4{pk[0], pk[1], pk[2], pk[3]};
    *(uint4*)(hq + 8) = uint4{pk[4], pk[5], pk[6], pk[7]};
  } else {
    const float* gf = p.g_final + lane * 16;
#pragma unroll
    for (int q4 = 0; q4 < 4; ++q4) {
      const float4 g4v = *(const float4*)(gf + q4 * 4);
      *(float4*)(xr + q4 * 4) = float4{xn[q4 * 4] * rn * g4v.x, xn[q4 * 4 + 1] * rn * g4v.y, xn[q4 * 4 + 2] * rn * g4v.z,
                                       xn[q4 * 4 + 3] * rn * g4v.w};
    }
  }
}

template <class F>
DEV void for_tiles_xcd(int MT, int NT, F f) {
  const int nb = gridDim.x, bid = blockIdx.x;
  if ((nb & 7) != 0) {
    for (int it = bid; it < MT * NT; it += nb) f(it / NT, it % NT);
    return;
  }
  const int xcd = bid & 7, slot = bid >> 3, nslot = nb >> 3;
  const int nj = (NT - xcd + 7) >> 3;
  for (int q = slot; q < MT * nj; q += nslot) f(q / nj, xcd + 8 * (q % nj));
}
constexpr int PH_PER_LAYER = 15;
enum { SP_NORM1 = 0, SP_INPROJ = 1, SP_COMPRESS = 2, SP_KMEAN = 3, SP_ATTN = 4, SP_MP0 = 5, SP_MM0 = 6, SP_MP1 = 7, SP_MM1 = 8,
       SP_MERGE = 9, SP_OUTPROJ = 10, SP_NORM2 = 11, SP_PEERQ = 12, SP_TOPK = 13, SP_EXPERT = 14 };
constexpr int N_REAL_PHASES = 1 + 2 * PH_PER_LAYER + 1;
constexpr int N_PHASES = N_REAL_PHASES + (PROBE_ANY ? 2 : 0);

DEV void run_phase(const Params& p, int ph, char* smem_raw, bool second_pass = false) {
#define SKIP_MOBA_SECOND (REP_NSA_ONLY && second_pass)
  float* smf = (float*)smem_raw;
  bf16* smh = (bf16*)smem_raw;
  const int nb = gridDim.x, bid = blockIdx.x;
  if (ph == 0) {
    for (int it = bid; it < PREP_ITEMS; it += nb) prep_item(p, it, smf);
    return;
  }
  if (ph == N_REAL_PHASES - 1) {
    for (int it = bid; it < T / 4; it += nb) final_norm_item(p.out, p.g_final, it);
    return;
  }
#if PROBE_ANY
  if (ph == N_REAL_PHASES) {
#if PROBE_PROJ
    {
      const bf16* Hh = (const bf16*)(p.ws + OFF_H);
      const bf16* Wt = (const bf16*)(p.ws + OFF_WINT) + (size_t)1 * WN * 1024;
      const float* rope = (const float*)(p.ws + OFF_ROPE);
      float sd = 0.f, sr = 0.f;
      for (size_t i = (size_t)bid * 256 + tidx(); i < (size_t)(T / 64) * 4888; i += (size_t)nb * 256) {
        const int ts = (int)(i / 4888), vc = (int)(i % 4888);
        const int tok = ts * 64 + (ts % 61);
        const int b = tok / S, t = tok % S;
        auto rawdot = [&](int col) {
          float a = 0.f;
          for (int k = 0; k < 1024; ++k) a += bf2f(Hh[(size_t)tok * 1024 + k]) * bf2f(Wt[(size_t)col * 1024 + k]);
          return a;
        };
        float v = rawdot(vc);
        bool roped = false;
        const bf16* dst;
        if (vc < 768) dst = (const bf16*)(p.ws + OFF_PROJ) + (size_t)tok * PC + vc;
        else if (vc < 1280) {
          const int seg = (vc - 768) >> 7, head = ((vc - 768) >> 6) & 1, d = vc & 63;
          const size_t off = (seg == 0) ? OFF_KSB : (seg == 1) ? OFF_VSB : (seg == 2) ? OFF_KWB : OFF_VWB;
          dst = (const bf16*)(p.ws + off) + ((size_t)(b * 2 + head) * S + t) * 64 + d;
          roped = (seg == 0 || seg == 2);
        } else if (vc < 1792) { dst = (const bf16*)(p.ws + OFF_PROJ) + (size_t)tok * PC + C_MQ + (vc - 1280); roped = true; }
        else if (vc < 2816) {
          const int seg = (vc - 1792) >> 9, head = ((vc - 1792) >> 6) & 7, d = vc & 63;
          dst = (const bf16*)(p.ws + (seg ? OFF_MVB : OFF_MKB)) + ((size_t)(b * 8 + head) * S + t) * 64 + d;
          roped = (seg == 0);
        } else if (vc < 4864) dst = (const bf16*)(p.ws + OFF_PROJ) + (size_t)tok * PC + C_GN + (vc - 2816);
        else dst = (const bf16*)(p.ws + OFF_PROJ) + (size_t)tok * PC + C_NG + (vc - 4864);
        const int d = vc & 63;
        if (roped && d < 16) {
          const float cs = rope[(size_t)t * 16 + (d & 7)], sn = rope[(size_t)t * 16 + 8 + (d & 7)];
          if (d < 8) { const float x2 = rawdot(vc + 8); v = v * cs - x2 * sn; }
          else { const float x1 = rawdot(vc - 8); v = v * cs + x1 * sn; }
        }
        const float got = bf2f(*dst);
        const bool is_r = roped && d < 16;
        if (PROBE_PROJ == 1 || (PROBE_PROJ == 2 && is_r) || (PROBE_PROJ == 3 && !is_r)) {
          sd += (got - v) * (got - v);
          sr += v * v;
        }
      }
      sd = wave_sum(sd); sr = wave_sum(sr);
      if ((tidx() & 63) == 0) {
        atomicAdd((float*)(p.ws + OFF_PROBE), sd);
        atomicAdd((float*)(p.ws + OFF_PROBE) + 1, sr);
      }
    }
#endif
#if PROBE_CMPR
    {
      float sd = 0.f, sr = 0.f;
      for (size_t i = (size_t)bid * 256 + tidx(); i < (size_t)2 * Bn * 1024 * 128; i += (size_t)nb * 256) {
        const size_t wh = i / ((size_t)Bn * 1024 * 128), r = i % ((size_t)Bn * 1024 * 128);
        const int c = (int)((r / 128) % 1024);
        if (c < 1023) {
          const float a = ((const float*)(p.ws + (wh ? OFF_VCC : OFF_KCC)))[r];
          const float y = ((const float*)(p.ws + OFF_CMP))[i];
          sd += (a - y) * (a - y);
          sr += y * y;
        }
      }
      sd = wave_sum(sd); sr = wave_sum(sr);
      if ((tidx() & 63) == 0) {
        atomicAdd((float*)(p.ws + OFF_PROBE), sd);
        atomicAdd((float*)(p.ws + OFF_PROBE) + 1, sr);
      }
    }
#endif
#if PROBE_MOBA
    probe_accum_bf16(p, (const bf16*)(p.ws + OFF_OMOBA), (const bf16*)(p.ws + OFF_CMP), (size_t)S * 512, smf);
#endif
#if PROBE_NSA == 8
    {
      const float* impn = (const float*)(p.ws + OFF_OMOBA);
      const float* impm = impn + (size_t)S * 256;
      const int* seld = (const int*)(p.ws + OFF_CMP);
      float sd = 0.f, sr = 0.f, bad = 0.f;
      for (int t = bid * 256 + tidx(); t < S; t += nb * 256) {
        const int cur = t >> 6;
        for (int n = 0; n < 256; ++n) {
          float a = impm[(size_t)t * 256 + n], r = impn[(size_t)t * 256 + n];
          sd += (a - r) * (a - r);
          sr += r * r;
        }
        unsigned want[8] = {0, 0, 0, 0, 0, 0, 0, 0}, got[8] = {0, 0, 0, 0, 0, 0, 0, 0};
        for (int j = 0; j < 16; ++j) {
          int v = seld[(size_t)t * 16 + j];
          if (v >= 0 && v < 256) {
            for (int w = 0; w < 8; ++w) if ((v >> 5) == w) got[w] |= 1u << (v & 31);
          }
        }
        if (cur < 16) {
          for (int n = 0; n <= cur; ++n) want[0] |= 1u << n;
        } else {
          want[0] |= 1u;
          for (int w = 0; w < 8; ++w) {
            if (((cur - 1) >> 5) == w) want[w] |= 1u << ((cur - 1) & 31);
            if ((cur >> 5) == w) want[w] |= 1u << (cur & 31);
          }
          for (int j = 0; j < 13; ++j) {
            float best = -1.f;
            int bi = 1;
            for (int n = 1; n <= cur - 2; ++n) {
              bool taken = false;
              for (int w = 0; w < 8; ++w) if ((n >> 5) == w) taken = (want[w] >> (n & 31)) & 1u;
              float v = impm[(size_t)t * 256 + n];
              if (!taken && v > best) { best = v; bi = n; }
            }
            for (int w = 0; w < 8; ++w) if ((bi >> 5) == w) want[w] |= 1u << (bi & 31);
          }
        }
        bool same = true;
        for (int w = 0; w < 8; ++w) same = same && (want[w] == got[w]);
        if (!same) bad += 1.f;
      }
      sd = wave_sum(sd); sr = wave_sum(sr); bad = wave_sum(bad);
      if ((tidx() & 63) == 0) {
        atomicAdd((float*)(p.ws + OFF_PROBE), sd);
        atomicAdd((float*)(p.ws + OFF_PROBE) + 1, sr);
        atomicAdd((float*)(p.ws + OFF_PROBE) + 2, bad);
      }
    }
#elif PROBE_NSA
    probe_accum_bf16(p, (const bf16*)(p.ws + OFF_ONSA), (const bf16*)(p.ws + OFF_CMP), (size_t)S * 512, smf);
#endif
    return;
  }
  if (ph == N_REAL_PHASES + 1) {
    probe_apply(p);
    return;
  }
#endif
  const int layer = (ph - 1) / PH_PER_LAYER, sub = (ph - 1) % PH_PER_LAYER;
  const float* mod = (const float*)(p.ws + OFF_MOD) + (size_t)layer * 2 * 6144;
  const float* xin = (layer == 0) ? p.x : p.out;
  bf16* H = (bf16*)(p.ws + OFF_H);
  bf16* PROJ = (bf16*)(p.ws + OFF_PROJ);
#if PROBE_ANY
  if (sub >= SP_MERGE) {
    if (sub == SP_OUTPROJ && layer == 0)
      for (size_t i = (size_t)bid * 256 + tidx(); i < (size_t)T * 1024; i += (size_t)nb * 256) p.out[i] = p.x[i];
    return;
  }
#endif
  switch (sub) {
    case SP_NORM1:
      for (int it = bid; it < T / 4; it += nb)
        norm_item(xin, p.g_attn + layer * 1024, mod + 1024, mod + 0, H, it);
      break;
    case SP_INPROJ: {
      for_tiles_xcd(T / 256, WN / 128, [&](int mt, int nt) { inproj_tile256(p, layer, mt * 256, nt * 128, smh); });
    } break;
    case SP_COMPRESS:
      for (int it = bid; it < 512; it += nb) compress_mfma_item(p, layer, it, smem_raw);
#if PROBE_CMPR
      if (layer == 1)
        for (int it = bid; it < 1024; it += nb) compress_item(p, layer, it, smf);
#endif
      break;
    case SP_KMEAN:
      for (int it = bid; it < 1024; it += nb) kmean_item(p, it, smf);
#if PROBE_NSA
      if (layer == 1)
        for (int it = bid; it < 512; it += nb) n1_item(p, layer, it, smf);
#endif
      break;
    case SP_ATTN:
      {
        constexpr int MNI = 2;
        constexpr int NMOBA = 16 * (S / (64 * MNI));
        constexpr int NNI = 2;
        constexpr int NNSA = 4 * (S / (16 * NNI));
        const bool do_nsa = !PROBE_ANY || PROBE_NSA, do_moba = (!PROBE_ANY || PROBE_MOBA) && PROBE_NSA != 8;
        {
          constexpr int NCH = S / (16 * NNI);
          const bool affine = nb >= 8;
          const int grp = bid & 7, bk = grp & 3, sub = grp >> 2;
          const int i0 = affine ? (bid >> 3) : bid;
          const int istride = affine ? ((nb - grp + 7) >> 3) : nb;
          const int icount = affine ? (NCH / 2) : NNSA;
          if (do_nsa)
            for (int i = i0; i < icount; i += istride)
              nsa_item<NNI>(p, affine ? (((2 * i + sub) << 2) | bk) : i, smem_raw, (bf16*)(p.ws + OFF_ONSA));
          if (do_moba && !SKIP_MOBA_SECOND)
            for (int it = bid; it < NMOBA; it += nb) moba_gate_item<MNI>(p, it);
        }
#if PROBE_NSA && PROBE_NSA != 8
        if (layer == 1)
          for (int it = bid; it < 512; it += nb) n23_item(p, layer, it);
#endif
#if PROBE_MOBA
        if (layer == 1) {
          for (int it = bid; it < 512; it += nb) moba_item(p, layer, it);
        }
#endif
      }
      break;
    case SP_MP0:
    case SP_MP1:
      if ((!PROBE_ANY || PROBE_MOBA) && PROBE_NSA != 8)
        for (int it = bid; it < 8 * 63 * 8; it += nb) moba_part_item<2>(p, sub == SP_MP1 ? 1 : 0, it, smem_raw);
      break;
    case SP_MM0:
    case SP_MM1:
      if ((!PROBE_ANY || PROBE_MOBA) && PROBE_NSA != 8)
        for (int it = bid; it < 8 * (S / 128); it += nb)
          moba_merge_item<2>(p, sub == SP_MM1 ? 1 : 0, it, smem_raw, (bf16*)(p.ws + OFF_OMOBA));
      break;
    case SP_MERGE:
      for_tiles_xcd(T / 128, 8, [&](int mt, int nt) { merge_tile(p, layer, mt * 128, nt * 128, smh); });
      break;
    case SP_OUTPROJ: {
      const bf16* W = (const bf16*)(p.ws + OFF_WOUT) + (size_t)layer * 1024 * 1024;
      const float* ga1 = mod + 2048;
      for_tiles_xcd(T / 256, 8, [&](int mt, int nt) {
        f32x4 acc[2][4][4];
        acc_zero(acc[0]);
        acc_zero(acc[1]);
        gemm256_mainloop(H, 1024, W, 1024, mt * 256, nt * 128, smh, acc);
        const int lane_ = tidx() & 63, wv = tidx() >> 6;
#pragma unroll
        for (int h = 0; h < 2; ++h)
#pragma unroll
          for (int mi = 0; mi < 4; ++mi)
#pragma unroll
            for (int ni = 0; ni < 4; ++ni)
#pragma unroll
              for (int r = 0; r < 4; ++r) {
                const int row = mt * 256 + (wv >> 1) * 128 + h * 64 + mi * 16 + (lane_ >> 4) * 4 + r;
                const int col = nt * 128 + (wv & 1) * 64 + ni * 16 + (lane_ & 15);
                const int b = row / S;
                const size_t o = (size_t)row * 1024 + col;
                p.out[o] = xin[o] + ga1[b * 6144 + col] * acc[h][mi][ni][r];
              }
      });
    } break;
    case SP_NORM2:
      for (int it = bid; it < T / 4 + NEXP / 4; it += nb) {
        if (it < T / 4) norm_item(p.out, p.g_ffn + layer * 1024, mod + 4096, mod + 3072, H, it);
        else expert_cvt_item(p, layer, it - T / 4);
      }
      break;
    case SP_PEERQ: {
      const bf16* W = (const bf16*)(p.ws + OFF_WQ) + (size_t)layer * 2048 * 1024;
      bf16* QP = (bf16*)(p.ws + OFF_QP);
      for_tiles_xcd(T / 256, 16, [&](int mt, int nt) {
        f32x4 acc[2][4][4];
        acc_zero(acc[0]);
        acc_zero(acc[1]);
        gemm256_mainloop(H, 1024, W, 1024, mt * 256, nt * 128, smh, acc);
        const int wv = tidx() >> 6;
        store_tile_bf16(smh, acc[0], QP + (size_t)(mt * 256 + (wv >> 1) * 128) * 2048 + nt * 128 + (wv & 1) * 64, 2048);
        store_tile_bf16(smh, acc[1], QP + (size_t)(mt * 256 + (wv >> 1) * 128 + 64) * 2048 + nt * 128 + (wv & 1) * 64, 2048);
      });
    } break;
    case SP_TOPK:
      for (int it = bid; it < T / 8; it += nb) peer_topk_item3(p, layer, it);
      break;
    case SP_EXPERT:
      for (int it = bid; it < T / 4; it += nb) peer_expert_item2(p, layer, it, second_pass ? 0.f : 1.f);
      break;
  }
}

#if PROBE_ANY
#define MEGA_LB __launch_bounds__(256)
#else
#define MEGA_LB __launch_bounds__(256, 2)
#endif
__global__ void MEGA_LB mega_kernel(Params p, int ph_lo, int ph_hi) {
  __shared__ __attribute__((aligned(16))) char smem_raw[SMEM_BYTES + 16];
  volatile LAS unsigned* xbst = (volatile LAS unsigned*)(smem_raw + SMEM_BYTES);
  if (threadIdx.x == 0) { xbst[0] = 0u; xbst[1] = 0u; xbst[2] = 0u; xbst[3] = 0u; }
  __syncthreads();
  XcdBarrier xb = xcd_barrier_post((unsigned*)(p.ws + OFF_BAR), xbst);
  for (int ph = ph_lo; ph < ph_hi; ++ph) {
#if !PROBE_ANY && !REP_MASK
    if (ph == N_REAL_PHASES - 1 || ph == 1 + PH_PER_LAYER) continue;
#endif
#if REP_MASK
    const int nrep = (ph >= 1 && ph < N_REAL_PHASES - 1 && ((REP_MASK >> ((ph - 1) % PH_PER_LAYER)) & 1)) ? 2 : 1;
    for (int rep = 0; rep < nrep; ++rep) {
      if (rep) xcd_barrier(xb);
      run_phase(p, ph, smem_raw, rep != 0);
    }
#else
    run_phase(p, ph, smem_raw);
#endif
    if (ph + 1 < ph_hi) {
      if (ph == ph_lo) cg::this_grid().sync();
      else xcd_barrier(xb);
    }
  }
}

extern "C" void kernel_launch(void* const* d_in, const int* in_sizes, int n_in, void* d_out, int out_size, void* d_ws,
                              size_t ws_size, hipStream_t stream) {
  if (ws_size < WS_TOTAL) {
    fprintf(stderr, "workspace too small: %zu < %zu\n", ws_size, (size_t)WS_NEED);
    return;
  }
  Params p{};
  p.x = (const float*)d_in[0]; p.c = (const float*)d_in[1]; p.w_ada = (const float*)d_in[2];
  p.b_ada = (const float*)d_in[3]; p.g_attn = (const float*)d_in[4]; p.g_ffn = (const float*)d_in[5];
  p.w_in = (const float*)d_in[6]; p.cmp_pe = (const float*)d_in[7]; p.cmp_w1 = (const float*)d_in[8];
  p.cmp_w2 = (const float*)d_in[9]; p.w_up_nsa = (const float*)d_in[10]; p.w_up_moba = (const float*)d_in[11];
  p.w_out = (const float*)d_in[12]; p.peer_wq = (const float*)d_in[13]; p.peer_k1 = (const float*)d_in[14];
  p.peer_k2 = (const float*)d_in[15]; p.peer_u = (const float*)d_in[16]; p.peer_v = (const float*)d_in[17];
  p.g_final = (const float*)d_in[18];
  p.out = (float*)d_out;
  p.ws = (char*)d_ws;
  static int grid_blocks = 0;
  if (!grid_blocks) {
    int dev = 0, cus = 0, per_cu = 0;
    hipGetDevice(&dev);
    hipDeviceGetAttribute(&cus, hipDeviceAttributeMultiprocessorCount, dev);
    hipOccupancyMaxActiveBlocksPerMultiprocessor(&per_cu, mega_kernel, 256, 0);
    if (per_cu < 1) per_cu = 1;
    if (per_cu > 2) per_cu = 2;
    grid_blocks = cus * per_cu;
  }
  hipMemsetAsync((char*)d_ws + OFF_BAR, 0, BAR_BYTES, stream);
  int ph_lo = 0, ph_hi = N_PHASES;
  void* args[] = {(void*)&p, (void*)&ph_lo, (void*)&ph_hi};
  hipError_t e = hipLaunchCooperativeKernel((const void*)mega_kernel, dim3(grid_blocks), dim3(256), args, 0, stream);
  if (e != hipSuccess) fprintf(stderr, "cooperative launch failed: %s (grid %d)\n", hipGetErrorString(e), grid_blocks);
}
```

```cpp
#include <hip/hip_runtime.h>
#include <hip/hip_bf16.h>
#include <hip/hip_cooperative_groups.h>
#include <cstdio>
#include <cstdint>
namespace cg = cooperative_groups;

#define DEV __device__ __forceinline__
typedef unsigned short bf16;
using bf16x8 = __attribute__((ext_vector_type(8))) short;
using f32x4 = __attribute__((ext_vector_type(4))) float;

constexpr int Bn = 2, S = 16384, T = Bn * S, D = 1024;
constexpr int PC = 3456;
constexpr int WN = 4992;
constexpr int C_NQ = 0, C_KC = 512, C_VC = 640, C_MQ = 768, C_GN = 1280, C_GM = 2304, C_NG = 3328;
constexpr int NEXP = 16384;

constexpr size_t al(size_t x) { return (x + 255) & ~size_t(255); }
constexpr size_t OFF_MOD = 0;
constexpr size_t OFF_ROPE = al(OFF_MOD + 2 * 2 * 6144 * 4);
constexpr size_t OFF_PEB = al(OFF_ROPE + (size_t)S * 16 * 4);
constexpr size_t OFF_WINT = al(OFF_PEB + 2 * 2 * 128 * 4);
constexpr size_t OFF_WUPN = al(OFF_WINT + 2ull * WN * 1024 * 2);
constexpr size_t OFF_WUPM = al(OFF_WUPN + 2ull * 1024 * 512 * 2);
constexpr size_t OFF_WOUT = al(OFF_WUPM + 2ull * 1024 * 512 * 2);
constexpr size_t OFF_WQ = al(OFF_WOUT + 2ull * 1024 * 1024 * 2);
constexpr size_t OFF_KCC = al(OFF_WQ + 2ull * 2048 * 1024 * 2);
constexpr size_t OFF_VCC = al(OFF_KCC + 2ull * 1024 * 128 * 4);
constexpr size_t OFF_SEL = al(OFF_VCC + 2ull * 1024 * 128 * 4);
constexpr size_t OFF_KMEAN = al(OFF_SEL + 2ull * 2 * S * 16 * 4);
constexpr size_t OFF_KMHL = al(OFF_KMEAN + 2ull * 8 * 64 * 64 * 4);
constexpr size_t OFF_KCB = al(OFF_KMHL + 2ull * 2 * 8 * 64 * 64 * 2);
constexpr size_t OFF_VCB = al(OFF_KCB + 2ull * 2 * 1024 * 64 * 2);
constexpr size_t OFF_PKB = al(OFF_VCB + 2ull * 2 * 1024 * 64 * 2);
constexpr size_t OFF_W1T = al(OFF_PKB + 2ull * 2 * 128 * 128 * 2);
constexpr size_t OFF_BAR = al(OFF_W1T + 4ull * 128 * 2048 * 2);
constexpr size_t BAR_BYTES = 3456 * 4;
constexpr size_t OFF_PROBE = al(OFF_BAR + BAR_BYTES);
constexpr size_t OFF_H = al(OFF_PROBE + 256);
constexpr size_t OFF_ONSA = al(OFF_H + (size_t)T * 1024 * 2);
constexpr size_t OFF_OMOBA = al(OFF_ONSA + (size_t)T * 512 * 2);
constexpr size_t OFF_PROJ = al(OFF_OMOBA + (size_t)T * 512 * 2);
constexpr size_t KV2_BYTES = (size_t)Bn * 2 * S * 64 * 2, KV8_BYTES = (size_t)Bn * 8 * S * 64 * 2;
constexpr size_t OFF_KSB = al(OFF_PROJ + (size_t)T * PC * 2);
constexpr size_t OFF_VSB = OFF_KSB + KV2_BYTES;
constexpr size_t OFF_KWB = OFF_VSB + KV2_BYTES;
constexpr size_t OFF_VWB = OFF_KWB + KV2_BYTES;
constexpr size_t OFF_MKB = OFF_VWB + KV2_BYTES;
constexpr size_t OFF_MVB = OFF_MKB + KV8_BYTES;
constexpr int MLIST_PER_BH = 63 * S - 128 * 63 * 64;
constexpr size_t OFF_MLIST = OFF_MVB + KV8_BYTES;
constexpr size_t OFF_MCNT = al(OFF_MLIST + (size_t)Bn * 8 * MLIST_PER_BH * 2);
constexpr size_t WS_NEED = OFF_MCNT + (size_t)Bn * 8 * 64 * 4;
constexpr size_t PROJ_BYTES = (size_t)T * PC * 2;
constexpr size_t OFF_MPO = OFF_H;
constexpr size_t OFF_MPML = OFF_H + (size_t)8 * S * 3 * 64 * 2;
static_assert((size_t)8 * S * 3 * 64 * 2 + (size_t)8 * S * 3 * 8 <= (size_t)T * 1024 * 2, "moba partials must fit the H region");
constexpr size_t OFF_QP = OFF_PROJ;
constexpr size_t OFF_PEIDX = al(OFF_QP + (size_t)T * 2048 * 2);
constexpr size_t OFF_PEG = al(OFF_PEIDX + (size_t)T * 128 * 4);
constexpr size_t OFF_E8 = al(OFF_PEG + (size_t)T * 128 * 4);
constexpr size_t OFF_ESC = al(OFF_E8 + (size_t)NEXP * 2048);
static_assert(OFF_ESC + (size_t)NEXP * 2 * 4 <= OFF_PROJ + PROJ_BYTES, "peer alias overflow");
static_assert(WS_NEED <= 536870912ull, "workspace too big");
#ifndef PROBE_MOBA
#define PROBE_MOBA 0
#endif
constexpr size_t OFF_CMP = PROBE_MOBA ? OFF_ONSA : OFF_MLIST;
#ifndef REP_NSA_ONLY
#define REP_NSA_ONLY 0
#endif
#ifndef REP_NSA_PART
#define REP_NSA_PART 0
#endif
#ifndef REP_MASK
#define REP_MASK 0
#endif
#ifndef PROBE_MOBA
#define PROBE_MOBA 0
#endif
#ifndef PROBE_NSA
#define PROBE_NSA 0
#endif
#ifndef PROBE_CMPR
#define PROBE_CMPR 0
#endif
#ifndef PROBE_PROJ
#define PROBE_PROJ 0
#endif
#define PROBE_ANY (PROBE_MOBA || PROBE_NSA || PROBE_CMPR || PROBE_PROJ)
constexpr size_t WS_TOTAL = WS_NEED;
static_assert(WS_TOTAL <= 536870912ull, "workspace too big (probe)");

struct Params {
  const float *x, *c, *w_ada, *b_ada, *g_attn, *g_ffn, *w_in, *cmp_pe, *cmp_w1, *cmp_w2, *w_up_nsa, *w_up_moba, *w_out,
      *peer_wq, *peer_k1, *peer_k2, *peer_u, *peer_v, *g_final;
  float* out;
  char* ws;
};

constexpr int SMEM_BYTES = 74 * 1024;

DEV int tidx() {
  int t = threadIdx.x;
  asm volatile("" : "+v"(t));
  return t;
}
#define MFMA16B(a, b, c) __builtin_amdgcn_mfma_f32_16x16x32_bf16(a, b, c, 0, 0, 0)
DEV unsigned cvtpk_(float lo, float hi) {
  unsigned r;
  asm("v_cvt_pk_bf16_f32 %0, %1, %2" : "=v"(r) : "v"(lo), "v"(hi));
  return r;
}
DEV float bf2f(bf16 h) { return __uint_as_float(((unsigned)h) << 16); }
DEV bf16 f2bf(float f) {
  unsigned u = __float_as_uint(f);
  u += 0x7fffu + ((u >> 16) & 1u);
  return (bf16)(u >> 16);
}
DEV float gelu_tanh(float x) {
  float u = 0.7978845608028654f * (x + 0.044715f * x * x * x);
  return 0.5f * x * (1.f + tanhf(u));
}
DEV float sigmoidf_(float x) { return 1.f / (1.f + expf(-x)); }
DEV void unpack8(uint4 v, float* f) {
  f[0] = __uint_as_float(v.x << 16); f[1] = __uint_as_float(v.x & 0xffff0000u);
  f[2] = __uint_as_float(v.y << 16); f[3] = __uint_as_float(v.y & 0xffff0000u);
  f[4] = __uint_as_float(v.z << 16); f[5] = __uint_as_float(v.z & 0xffff0000u);
  f[6] = __uint_as_float(v.w << 16); f[7] = __uint_as_float(v.w & 0xffff0000u);
}
DEV float dot64_bf(const float* q, const bf16* row) {
  float s = 0.f;
#pragma unroll
  for (int i = 0; i < 8; ++i) {
    float f[8];
    unpack8(*(const uint4*)(row + i * 8), f);
#pragma unroll
    for (int j = 0; j < 8; ++j) s += q[i * 8 + j] * f[j];
  }
  return s;
}
DEV void axpy64_bf(float* o, float a, const bf16* row) {
#pragma unroll
  for (int i = 0; i < 8; ++i) {
    float f[8];
    unpack8(*(const uint4*)(row + i * 8), f);
#pragma unroll
    for (int j = 0; j < 8; ++j) o[i * 8 + j] += a * f[j];
  }
}
DEV float dot64_f(const float* q, const float* row) {
  float s = 0.f;
#pragma unroll
  for (int i = 0; i < 16; ++i) {
    float4 v = *(const float4*)(row + i * 4);
    s += q[i * 4] * v.x + q[i * 4 + 1] * v.y + q[i * 4 + 2] * v.z + q[i * 4 + 3] * v.w;
  }
  return s;
}
DEV void axpy64_f(float* o, float a, const float* row) {
#pragma unroll
  for (int i = 0; i < 16; ++i) {
    float4 v = *(const float4*)(row + i * 4);
    o[i * 4] += a * v.x; o[i * 4 + 1] += a * v.y; o[i * 4 + 2] += a * v.z; o[i * 4 + 3] += a * v.w;
  }
}
DEV void load_q64(float* q, const bf16* p, float scale) {
#pragma unroll
  for (int i = 0; i < 8; ++i) unpack8(*(const uint4*)(p + i * 8), q + i * 8);
#pragma unroll
  for (int i = 0; i < 64; ++i) q[i] *= scale;
}
DEV int lane_id_() { return __builtin_amdgcn_mbcnt_hi(~0u, __builtin_amdgcn_mbcnt_lo(~0u, 0u)); }
DEV int shx(int v, int m) {
  if (m == 1) return __builtin_amdgcn_update_dpp(0, v, 0xB1, 0xF, 0xF, true);
  if (m == 2) return __builtin_amdgcn_update_dpp(0, v, 0x4E, 0xF, 0xF, true);
  if (m == 4) return __builtin_amdgcn_ds_swizzle(v, 0x101F);
  if (m == 8) return __builtin_amdgcn_update_dpp(0, v, 0x128, 0xF, 0xF, true);
  if (m == 16) return __builtin_amdgcn_ds_swizzle(v, 0x401F);
  auto rr = __builtin_amdgcn_permlane32_swap((unsigned)v, (unsigned)v, false, false);
  return (lane_id_() < 32) ? (int)rr[1] : (int)rr[0];
}
DEV unsigned shx(unsigned v, int m) { return (unsigned)shx((int)v, m); }
DEV float shx(float v, int m) { return __int_as_float(shx(__float_as_int(v), m)); }
DEV float wave_sum(float v) {
#pragma unroll
  for (int o = 32; o >= 1; o >>= 1) v += shx(v, o);
  return v;
}

#define XB_TMO      128
#define XB_XCNT(j)  (256  + 64 * (j))
#define XB_XSUB(j)  (1280 + 64 * (j))
#define XB_XGEN(j)  (2304 + 64 * (j))
#define XB_TOP      3328
#define XB_TOPGEN   3392
#define XCD_BAR_WORDS 3456
#define XB_SPIN_CAP (1u << 18)
#define LAS __attribute__((address_space(3)))

__device__ __forceinline__ unsigned xb_ld(unsigned* p)              { return __hip_atomic_load(p, __ATOMIC_RELAXED, __HIP_MEMORY_SCOPE_AGENT); }
__device__ __forceinline__ unsigned xb_add(unsigned* p, unsigned v) { return __hip_atomic_fetch_add(p, v, __ATOMIC_RELAXED, __HIP_MEMORY_SCOPE_AGENT); }
__device__ __forceinline__ unsigned xb_xcc_id() { return (unsigned)__builtin_amdgcn_s_getreg((3 << 11) | 20) & 0xFu; }
#define XB_SPIN(cond, bar) do { unsigned _sp = 0; while (cond) { __builtin_amdgcn_s_sleep(1); \
    if ((++_sp & 255u) == 0u) { if (xb_ld(&(bar)[XB_TMO])) break; if (_sp > XB_SPIN_CAP) { atomicAdd(&(bar)[XB_TMO], 1u); break; } } } } while (0)

struct XcdBarrier {
    unsigned* bar; unsigned x;
    volatile LAS unsigned* st;
};

__device__ __forceinline__ XcdBarrier xcd_barrier_post(unsigned* bar, volatile LAS unsigned* st) {
    XcdBarrier b; b.bar = bar; b.x = xb_xcc_id(); b.st = st;
    if (tidx() == 0) (void)xb_add(&bar[XB_XCNT(b.x)], 1u);
    return b;
}
__device__ __forceinline__ void xcd_barrier_complete(unsigned* bar, unsigned x, unsigned& nloc, unsigned& nx) {
    const unsigned G = gridDim.x * gridDim.y * gridDim.z;
    unsigned sum, cnt, mine, sp = 0u;
    for (;;) {
        sum = 0u; cnt = 0u; mine = 0u;
#pragma unroll
        for (unsigned j = 0; j < 16; ++j) { const unsigned c = xb_ld(&bar[XB_XCNT(j)]); sum += c; cnt += (c > 0u) ? 1u : 0u; mine = (j == x) ? c : mine; }
        if (sum == G) break;
        __builtin_amdgcn_s_sleep(1);
        if ((++sp & 255u) == 0u) { if (xb_ld(&bar[XB_TMO])) break; if (sp > XB_SPIN_CAP) { atomicAdd(&bar[XB_TMO], 1u); break; } }
    }
    nloc = mine > 0u ? mine : 1u; nx = cnt > 0u ? cnt : 1u;
}

__device__ __forceinline__ void xcd_barrier(const XcdBarrier& b) {
    asm volatile("s_waitcnt vmcnt(0)" ::: "memory");
    __syncthreads();
    if (tidx() == 0) {
        unsigned* bar = b.bar;
        __builtin_amdgcn_s_waitcnt(0);
        unsigned nloc = b.st[0], nx = b.st[1];
        if (nloc == 0u) { xcd_barrier_complete(bar, b.x, nloc, nx); b.st[0] = nloc; b.st[1] = nx; }
        const unsigned old = xb_add(&bar[XB_XSUB(b.x)], 1u);
        const unsigned gen = old / nloc;
        if (old + 1u == (gen + 1u) * nloc) {
            __builtin_amdgcn_fence(__ATOMIC_RELEASE, "agent");
            asm volatile("s_waitcnt vmcnt(0)" ::: "memory");
            const unsigned og = xb_add(&bar[XB_TOP], 1u);
            const unsigned tg = og / nx;
            if (og + 1u == (tg + 1u) * nx) xb_add(&bar[XB_TOPGEN], 1u);
            else XB_SPIN(xb_ld(&bar[XB_TOPGEN]) == tg, bar);
            __builtin_amdgcn_fence(__ATOMIC_ACQUIRE, "agent");
            xb_add(&bar[XB_XGEN(b.x)], 1u);
            asm volatile("s_waitcnt vmcnt(0)" ::: "memory");
        } else {
            XB_SPIN(xb_ld(&bar[XB_XGEN(b.x)]) == gen, bar);
            __builtin_amdgcn_fence(__ATOMIC_ACQUIRE, "agent");
            asm volatile("s_waitcnt vmcnt(0)" ::: "memory");
        }
    }
    __syncthreads();
}


DEV int win_col_map(int j) {
  if (j < 1280) return j;
  if (j < 4864) return j + 24;
  if (j < 4888) return j - 4864 + 1280;
  return -1;
}
DEV void tr_tile(const float* __restrict__ src, int ldsrc, int K, bf16* __restrict__ dst, int kt, int nt, bool remap,
                 float* sm) {
  const int tid = tidx();
#pragma unroll 4
  for (int i = 0; i < 16; ++i) {
    int r = i * 4 + (tid >> 6), cx = tid & 63;
    int j = nt * 64 + cx, k = kt * 64 + r;
    int oc = remap ? win_col_map(j) : j;
    sm[r * 65 + cx] = (oc >= 0) ? src[(size_t)k * ldsrc + oc] : 0.f;
  }
  __syncthreads();
#pragma unroll 4
  for (int i = 0; i < 16; ++i) {
    int n = i * 4 + (tid >> 6), kk = tid & 63;
    dst[(size_t)(nt * 64 + n) * K + kt * 64 + kk] = f2bf(sm[kk * 65 + n]);
  }
  __syncthreads();
}

constexpr int PREP_TR_WIN = 2 * 78 * 16;
constexpr int PREP_TR_UPN = 2 * 16 * 8;
constexpr int PREP_TR_UPM = 2 * 16 * 8;
constexpr int PREP_TR_OUT = 2 * 16 * 16;
constexpr int PREP_TR_WQ = 2 * 32 * 16;
constexpr int PREP_ROPE = 512;
constexpr int PREP_MOD = 384;
constexpr int PREP_PEB = 16;
constexpr int PREP_PK = 32;
constexpr int PREP_TR_W1 = 4 * 2 * 32;
constexpr int PREP_ITEMS = PREP_TR_WIN + PREP_TR_UPN + PREP_TR_UPM + PREP_TR_OUT + PREP_TR_WQ + PREP_ROPE + PREP_MOD + PREP_PEB + PREP_PK + PREP_TR_W1;

DEV void prep_item(const Params& p, int item, float* sm) {
  const int tid = tidx();
  if (item < PREP_TR_WIN) {
    int l = item / (78 * 16), r = item % (78 * 16);
    int nt = r / 16, kt = r % 16;
    tr_tile(p.w_in + (size_t)l * 1024 * 4888, 4888, 1024, (bf16*)(p.ws + OFF_WINT) + (size_t)l * WN * 1024, kt, nt, true, sm);
    return;
  }
  item -= PREP_TR_WIN;
  if (item < PREP_TR_UPN) {
    int l = item / 128, r = item % 128;
    int nt = r / 8, kt = r % 8;
    tr_tile(p.w_up_nsa + (size_t)l * 512 * 1024, 1024, 512, (bf16*)(p.ws + OFF_WUPN) + (size_t)l * 1024 * 512, kt, nt, false, sm);
    return;
  }
  item -= PREP_TR_UPN;
  if (item < PREP_TR_UPM) {
    int l = item / 128, r = item % 128;
    int nt = r / 8, kt = r % 8;
    tr_tile(p.w_up_moba + (size_t)l * 512 * 1024, 1024, 512, (bf16*)(p.ws + OFF_WUPM) + (size_t)l * 1024 * 512, kt, nt, false, sm);
    return;
  }
  item -= PREP_TR_UPM;
  if (item < PREP_TR_OUT) {
    int l = item / 256, r = item % 256;
    int nt = r / 16, kt = r % 16;
    tr_tile(p.w_out + (size_t)l * 1024 * 1024, 1024, 1024, (bf16*)(p.ws + OFF_WOUT) + (size_t)l * 1024 * 1024, kt, nt, false, sm);
    return;
  }
  item -= PREP_TR_OUT;
  if (item < PREP_TR_WQ) {
    int l = item / 512, r = item % 512;
    int nt = r / 16, kt = r % 16;
    tr_tile(p.peer_wq + (size_t)l * 1024 * 2048, 2048, 1024, (bf16*)(p.ws + OFF_WQ) + (size_t)l * 2048 * 1024, kt, nt, false, sm);
    return;
  }
  item -= PREP_TR_WQ;
  if (item < PREP_ROPE) {
    int idx = item * 256 + tid;
    int pos = idx >> 3, i = idx & 7;
    float inv = powf(500000.0f, -(float)i / 8.0f);
    float ang = (float)pos * inv;
    float* rp = (float*)(p.ws + OFF_ROPE) + (size_t)pos * 16;
    rp[i] = cosf(ang);
    rp[8 + i] = sinf(ang);
    return;
  }
  item -= PREP_ROPE;
  if (item < PREP_MOD) {
    for (int i = tid; i < 2048; i += 256) {
      float cv = p.c[i];
      sm[i] = cv / (1.f + expf(-cv));
    }
    __syncthreads();
    const int l = item / 192, n0 = (item % 192) * 32;
    const int col = tid & 31, ks = tid >> 5;
    const float* w = p.w_ada + (size_t)l * 1024 * 6144 + n0 + col;
    float a0 = 0.f, a1 = 0.f;
#pragma unroll 8
    for (int k = ks * 128; k < ks * 128 + 128; ++k) {
      float wv = w[(size_t)k * 6144];
      a0 += sm[k] * wv;
      a1 += sm[1024 + k] * wv;
    }
    sm[2048 + tid * 2] = a0;
    sm[2048 + tid * 2 + 1] = a1;
    __syncthreads();
    if (tid < 64) {
      const int c2 = tid & 31, bs = tid >> 5;
      float s = 0.f;
#pragma unroll
      for (int q = 0; q < 8; ++q) s += sm[2048 + (q * 32 + c2) * 2 + bs];
      ((float*)(p.ws + OFF_MOD))[(l * 2 + bs) * 6144 + n0 + c2] = s + p.b_ada[l * 6144 + n0 + c2];
    }
    __syncthreads();
    return;
  }
  item -= PREP_MOD;
  if (item < PREP_PEB) {
    const int lw = item >> 2, j0 = (item & 3) * 32;
    const int col = tid & 31, ks = tid >> 5;
    const float* pe = p.cmp_pe + (size_t)lw * 2048;
    const float* w1 = p.cmp_w1 + (size_t)lw * 2048 * 128 + j0 + col;
    float a = 0.f;
#pragma unroll 8
    for (int i = ks * 256; i < ks * 256 + 256; ++i) a += pe[i] * w1[(size_t)i * 128];
    sm[tid] = a;
    __syncthreads();
    if (tid < 32) {
      float s = 0.f;
#pragma unroll
      for (int q = 0; q < 8; ++q) s += sm[q * 32 + tid];
      ((float*)(p.ws + OFF_PEB))[lw * 128 + j0 + tid] = s;
    }
    if (item == 0 && tid < 4) ((float*)(p.ws + OFF_PROBE))[tid] = 0.f;
    __syncthreads();
    return;
  }
  item -= PREP_PEB;
  if (item < PREP_PK) {
    const int e0 = item * 2048 + tid * 8;
    const int lt = e0 >> 14, off = e0 & 16383;
    const float* srcp = ((lt & 1) ? p.peer_k2 : p.peer_k1) + (size_t)(lt >> 1) * 16384 + off;
    const float4 a = *(const float4*)srcp, b4 = *(const float4*)(srcp + 4);
    uint4 pk;
    pk.x = (unsigned)f2bf(a.x) | ((unsigned)f2bf(a.y) << 16);
    pk.y = (unsigned)f2bf(a.z) | ((unsigned)f2bf(a.w) << 16);
    pk.z = (unsigned)f2bf(b4.x) | ((unsigned)f2bf(b4.y) << 16);
    pk.w = (unsigned)f2bf(b4.z) | ((unsigned)f2bf(b4.w) << 16);
    *(uint4*)((bf16*)(p.ws + OFF_PKB) + e0) = pk;
    return;
  }
  item -= PREP_PK;
  {
    const int lw = item >> 6, r = item & 63;
    const int nt = r >> 5, kt = r & 31;
    tr_tile(p.cmp_w1 + (size_t)lw * 2048 * 128, 128, 2048, (bf16*)(p.ws + OFF_W1T) + (size_t)lw * 128 * 2048, kt, nt, false, sm);
  }
}

DEV void norm_item(const float* __restrict__ xin, const float* __restrict__ g, const float* __restrict__ sc,
                   const float* __restrict__ sh, bf16* __restrict__ hout, int item) {
  const int lane = tidx() & 63, wave = tidx() >> 6;
  const size_t tok = (size_t)item * 4 + wave;
  const int b = (int)(tok / S);
  const float* xr = xin + tok * 1024;
  float4 v[4];
  float ss = 0.f;
#pragma unroll
  for (int i = 0; i < 4; ++i) {
    v[i] = *(const float4*)(xr + i * 256 + lane * 4);
    ss += v[i].x * v[i].x + v[i].y * v[i].y + v[i].z * v[i].z + v[i].w * v[i].w;
  }
  ss = wave_sum(ss);
  float r = 1.0f / sqrtf(ss * (1.0f / 1024.f) + 1e-6f);
#pragma unroll
  for (int i = 0; i < 4; ++i) {
    int d = i * 256 + lane * 4;
    float4 gg = *(const float4*)(g + d);
    float4 s4 = *(const float4*)(sc + b * 6144 + d);
    float4 h4 = *(const float4*)(sh + b * 6144 + d);
    float o0 = v[i].x * r * gg.x * (1.f + s4.x) + h4.x;
    float o1 = v[i].y * r * gg.y * (1.f + s4.y) + h4.y;
    float o2 = v[i].z * r * gg.z * (1.f + s4.z) + h4.z;
    float o3 = v[i].w * r * gg.w * (1.f + s4.w) + h4.w;
    uint2 pk;
    pk.x = (unsigned)f2bf(o0) | ((unsigned)f2bf(o1) << 16);
    pk.y = (unsigned)f2bf(o2) | ((unsigned)f2bf(o3) << 16);
    *(uint2*)(hout + tok * 1024 + d) = pk;
  }
}
DEV void final_norm_item(float* __restrict__ x, const float* __restrict__ g, int item) {
  const int lane = tidx() & 63, wave = tidx() >> 6;
  const size_t tok = (size_t)item * 4 + wave;
  float* xr = x + tok * 1024;
  float4 v[4];
  float ss = 0.f;
#pragma unroll
  for (int i = 0; i < 4; ++i) {
    v[i] = *(const float4*)(xr + i * 256 + lane * 4);
    ss += v[i].x * v[i].x + v[i].y * v[i].y + v[i].z * v[i].z + v[i].w * v[i].w;
  }
  ss = wave_sum(ss);
  float r = 1.0f / sqrtf(ss * (1.0f / 1024.f) + 1e-6f);
#pragma unroll
  for (int i = 0; i < 4; ++i) {
    int d = i * 256 + lane * 4;
    float4 gg = *(const float4*)(g + d);
    float4 o;
    o.x = v[i].x * r * gg.x; o.y = v[i].y * r * gg.y; o.z = v[i].z * r * gg.z; o.w = v[i].w * r * gg.w;
    *(float4*)(xr + d) = o;
  }
}

#define GM_BUF (2 * 128 * 72)
#define GM_LOAD(R, kk)                                                                                  \
  {                                                                                                     \
    const bf16* Ak = Ap + (kk);                                                                         \
    const bf16* Wk = Wp + (kk);                                                                         \
    R##a0 = *(const uint4*)(Ak); R##a1 = *(const uint4*)(Ak + a32); R##a2 = *(const uint4*)(Ak + 2 * a32); \
    R##a3 = *(const uint4*)(Ak + 3 * a32);                                                              \
    R##b0 = *(const uint4*)(Wk); R##b1 = *(const uint4*)(Wk + w32); R##b2 = *(const uint4*)(Wk + 2 * w32); \
    R##b3 = *(const uint4*)(Wk + 3 * w32);                                                              \
  }
#define GM_STORE(R, buf)                                                                                \
  {                                                                                                     \
    bf16* as_ = Asw + (buf) * GM_BUF;                                                                   \
    bf16* bs_ = as_ + 128 * 72;                                                                         \
    *(uint4*)(as_) = R##a0; *(uint4*)(as_ + 32 * 72) = R##a1; *(uint4*)(as_ + 64 * 72) = R##a2; *(uint4*)(as_ + 96 * 72) = R##a3; \
    *(uint4*)(bs_) = R##b0; *(uint4*)(bs_ + 32 * 72) = R##b1; *(uint4*)(bs_ + 64 * 72) = R##b2; *(uint4*)(bs_ + 96 * 72) = R##b3; \
  }
#define GM_COMPUTE(buf)                                                                                 \
  {                                                                                                     \
    const bf16* As_ = sm + (buf) * GM_BUF;                                                              \
    const bf16* Bs_ = As_ + 128 * 72;                                                                   \
    _Pragma("unroll") for (int ks = 0; ks < 2; ++ks) {                                                  \
      __builtin_amdgcn_sched_barrier(0);                                                                \
      bf16x8 af[4], bfr[4];                                                                             \
      _Pragma("unroll") for (int mi = 0; mi < 4; ++mi)                                                  \
        af[mi] = *(const bf16x8*)(As_ + (wr * 64 + mi * 16 + (lane & 15)) * 72 + ks * 32 + (lane >> 4) * 8); \
      _Pragma("unroll") for (int ni = 0; ni < 4; ++ni)                                                  \
        bfr[ni] = *(const bf16x8*)(Bs_ + (wc * 64 + ni * 16 + (lane & 15)) * 72 + ks * 32 + (lane >> 4) * 8); \
      _Pragma("unroll") for (int mi = 0; mi < 4; ++mi)                                                  \
        _Pragma("unroll") for (int ni = 0; ni < 4; ++ni)                                                \
          acc[mi][ni] = __builtin_amdgcn_mfma_f32_16x16x32_bf16(af[mi], bfr[ni], acc[mi][ni], 0, 0, 0); \
    }                                                                                                   \
    __builtin_amdgcn_sched_barrier(0);                                                                  \
  }
DEV void gemm_mainloop(const bf16* __restrict__ A, int lda, const bf16* __restrict__ W, int K, int m0, int n0, bf16* sm,
                       f32x4 (&acc)[4][4]) {
  const int tid = tidx(), lane = tid & 63, wave = tid >> 6;
  const int wr = wave >> 1, wc = wave & 1;
  const int lrow = tid >> 3, lkc = (tid & 7) * 8;
  const bf16* Ap = A + (size_t)(m0 + lrow) * lda + lkc;
  const bf16* Wp = W + (size_t)(n0 + lrow) * K + lkc;
  const int a32 = 32 * lda, w32 = 32 * K;
  bf16* Asw = sm + lrow * 72 + lkc;
  uint4 xa0, xa1, xa2, xa3, xb0, xb1, xb2, xb3, ya0, ya1, ya2, ya3, yb0, yb1, yb2, yb3;
  const int nk = K >> 6;
  GM_LOAD(x, 0)
  GM_LOAD(y, 64)
  __syncthreads();
  GM_STORE(x, 0)
  if (nk > 2) GM_LOAD(x, 128)
  __syncthreads();
  for (int k = 0; k < nk; k += 2) {
    GM_COMPUTE(0)
    GM_STORE(y, 1)
    if (k + 3 < nk) GM_LOAD(y, (k + 3) * 64)
    __syncthreads();
    GM_COMPUTE(1)
    if (k + 2 < nk) {
      GM_STORE(x, 0)
      if (k + 4 < nk) GM_LOAD(x, (k + 4) * 64)
    }
    __syncthreads();
  }
}
DEV void gemm256_mainloop(const bf16* __restrict__ A, int lda, const bf16* __restrict__ W, int K, int m0, int n0, bf16* sm,
                          f32x4 (&acc)[2][4][4]) {
  bf16* As = sm;
  bf16* Bs = sm + 256 * 72;
  const int tid = tidx(), lane = tid & 63, wave = tid >> 6;
  const int wr = wave >> 1, wc = wave & 1;
  const int lrow = tid >> 3, lkc = (tid & 7) * 8;
  const bf16* Ap = A + (size_t)(m0 + lrow) * lda + lkc;
  const bf16* Wp = W + (size_t)(n0 + lrow) * K + lkc;
  const int a32 = 32 * lda, w32 = 32 * K;
  uint4 ra0, ra1, ra2, ra3, ra4, ra5, ra6, ra7, rb0, rb1, rb2, rb3;
#define G256_LOAD(kk)                                                                                   \
  {                                                                                                     \
    const bf16* Ak = Ap + (kk);                                                                         \
    const bf16* Wk = Wp + (kk);                                                                         \
    ra0 = *(const uint4*)(Ak); ra1 = *(const uint4*)(Ak + a32); ra2 = *(const uint4*)(Ak + 2 * a32);    \
    ra3 = *(const uint4*)(Ak + 3 * a32); ra4 = *(const uint4*)(Ak + 4 * a32); ra5 = *(const uint4*)(Ak + 5 * a32); \
    ra6 = *(const uint4*)(Ak + 6 * a32); ra7 = *(const uint4*)(Ak + 7 * a32);                           \
    rb0 = *(const uint4*)(Wk); rb1 = *(const uint4*)(Wk + w32); rb2 = *(const uint4*)(Wk + 2 * w32);    \
    rb3 = *(const uint4*)(Wk + 3 * w32);                                                                \
  }
  G256_LOAD(0)
  bf16* Asw = As + lrow * 72 + lkc;
  bf16* Bsw = Bs + lrow * 72 + lkc;
  for (int k0 = 0; k0 < K; k0 += 64) {
    __syncthreads();
    *(uint4*)(Asw) = ra0; *(uint4*)(Asw + 32 * 72) = ra1; *(uint4*)(Asw + 64 * 72) = ra2; *(uint4*)(Asw + 96 * 72) = ra3;
    *(uint4*)(Asw + 128 * 72) = ra4; *(uint4*)(Asw + 160 * 72) = ra5; *(uint4*)(Asw + 192 * 72) = ra6; *(uint4*)(Asw + 224 * 72) = ra7;
    *(uint4*)(Bsw) = rb0; *(uint4*)(Bsw + 32 * 72) = rb1; *(uint4*)(Bsw + 64 * 72) = rb2; *(uint4*)(Bsw + 96 * 72) = rb3;
    __syncthreads();
    if (k0 + 64 < K) G256_LOAD(k0 + 64)
#pragma unroll
    for (int ks = 0; ks < 2; ++ks) {
      bf16x8 bfr[4];
#pragma unroll
      for (int ni = 0; ni < 4; ++ni)
        bfr[ni] = *(const bf16x8*)(Bs + (wc * 64 + ni * 16 + (lane & 15)) * 72 + ks * 32 + (lane >> 4) * 8);
#pragma unroll
      for (int h = 0; h < 2; ++h) {
        __builtin_amdgcn_sched_barrier(0);
        bf16x8 af[4];
#pragma unroll
        for (int mi = 0; mi < 4; ++mi)
          af[mi] = *(const bf16x8*)(As + (wr * 128 + h * 64 + mi * 16 + (lane & 15)) * 72 + ks * 32 + (lane >> 4) * 8);
#pragma unroll
        for (int mi = 0; mi < 4; ++mi)
#pragma unroll
          for (int ni = 0; ni < 4; ++ni)
            acc[h][mi][ni] = __builtin_amdgcn_mfma_f32_16x16x32_bf16(af[mi], bfr[ni], acc[h][mi][ni], 0, 0, 0);
      }
    }
  }
}
DEV void acc_zero(f32x4 (&acc)[4][4]) {
#pragma unroll
  for (int i = 0; i < 4; ++i)
#pragma unroll
    for (int j = 0; j < 4; ++j) acc[i][j] = f32x4{0.f, 0.f, 0.f, 0.f};
}
DEV void store_tile_bf16(bf16* sm, const f32x4 (&acc)[4][4], bf16* __restrict__ dbase, size_t dstride) {
  const int tid = tidx(), lane = tid & 63, wave = tid >> 6, g4 = lane >> 4, c16 = lane & 15;
  bf16* Cw = sm + wave * (64 * 72);
  __syncthreads();
#pragma unroll
  for (int mi = 0; mi < 4; ++mi)
#pragma unroll
    for (int ni = 0; ni < 4; ++ni)
#pragma unroll
      for (int r = 0; r < 4; ++r) Cw[(mi * 16 + g4 * 4 + r) * 72 + ni * 16 + c16] = f2bf(acc[mi][ni][r]);
  __syncthreads();
#pragma unroll
  for (int it = 0; it < 8; ++it) {
    const int row_l = it * 8 + (lane >> 3), ch = lane & 7;
    const uint4 v = *(const uint4*)(Cw + row_l * 72 + ch * 8);
    *(uint4*)(dbase + (size_t)row_l * dstride + ch * 8) = v;
  }
}
template <class Epi>
DEV void gemm_tile(const bf16* __restrict__ A, int lda, const bf16* __restrict__ W, int K, int m0, int n0, bf16* sm,
                   Epi epi) {
  f32x4 acc[4][4];
  acc_zero(acc);
  gemm_mainloop(A, lda, W, K, m0, n0, sm, acc);
  const int tid = tidx(), lane = tid & 63, wave = tid >> 6;
  const int wr = wave >> 1, wc = wave & 1;
#pragma unroll
  for (int mi = 0; mi < 4; ++mi)
#pragma unroll
    for (int ni = 0; ni < 4; ++ni)
#pragma unroll
      for (int r = 0; r < 4; ++r) {
        int row = m0 + wr * 64 + mi * 16 + (lane >> 4) * 4 + r;
        int col = n0 + wc * 64 + ni * 16 + (lane & 15);
        epi(row, col, acc[mi][ni][r]);
      }
}
DEV void inproj_epilogue(const Params& p, f32x4 (&acc)[4][4], int row0, int vc0, bf16* sm) {
  const int tid = tidx(), lane = tid & 63, g4 = lane >> 4, c16 = lane & 15;
  const int b = row0 / S, t0 = row0 % S;
  bf16* dbase;
  size_t dstride;
  bool roped = false;
  bf16* projp = (bf16*)(p.ws + OFF_PROJ) + (size_t)row0 * PC;
  if (vc0 < 768) { dbase = projp + vc0; dstride = PC; }
  else if (vc0 < 1280) {
    const int seg = (vc0 - 768) >> 7, head = ((vc0 - 768) >> 6) & 1;
    const size_t off = (seg == 0) ? OFF_KSB : (seg == 1) ? OFF_VSB : (seg == 2) ? OFF_KWB : OFF_VWB;
    dbase = (bf16*)(p.ws + off) + ((size_t)(b * 2 + head) * S + t0) * 64;
    dstride = 64;
    roped = (seg == 0) || (seg == 2);
  } else if (vc0 < 1792) { dbase = projp + C_MQ + (vc0 - 1280); dstride = PC; roped = true; }
  else if (vc0 < 2816) {
    const int seg = (vc0 - 1792) >> 9, head = ((vc0 - 1792) >> 6) & 7;
    dbase = (bf16*)(p.ws + (seg ? OFF_MVB : OFF_MKB)) + ((size_t)(b * 8 + head) * S + t0) * 64;
    dstride = 64;
    roped = (seg == 0);
  } else if (vc0 < 4864) { dbase = projp + C_GN + (vc0 - 2816); dstride = PC; }
  else { dbase = projp + C_NG + (vc0 - 4864); dstride = PC; }
  if (roped) {
    const float* rope = (const float*)(p.ws + OFF_ROPE);
#pragma unroll
    for (int mi = 0; mi < 4; ++mi)
#pragma unroll
      for (int r = 0; r < 4; ++r) {
        const int pos = t0 + mi * 16 + g4 * 4 + r;
        const float v = acc[mi][0][r];
        const float pv = shx(v, 8);
        const float cs = rope[pos * 16 + (c16 & 7)], sn = rope[pos * 16 + 8 + (c16 & 7)];
        acc[mi][0][r] = (c16 < 8) ? (v * cs - pv * sn) : (v * cs + pv * sn);
      }
  }
  store_tile_bf16(sm, acc, dbase, dstride);
}
DEV void inproj_tile256(const Params& p, int layer, int m0, int n0, bf16* sm) {
  f32x4 acc[2][4][4];
  acc_zero(acc[0]);
  acc_zero(acc[1]);
  gemm256_mainloop((const bf16*)(p.ws + OFF_H), 1024, (const bf16*)(p.ws + OFF_WINT) + (size_t)layer * WN * 1024, 1024, m0, n0, sm, acc);
  const int wave = tidx() >> 6, wr = wave >> 1, wc = wave & 1;
  inproj_epilogue(p, acc[0], m0 + wr * 128, n0 + wc * 64, sm);
  inproj_epilogue(p, acc[1], m0 + wr * 128 + 64, n0 + wc * 64, sm);
}
typedef unsigned u32x2_t __attribute__((ext_vector_type(2)));
DEV void merge_tile(const Params& p, int layer, int m0, int n0, bf16* sm) {
  const int tid = tidx(), lane = tid & 63, wave = tid >> 6, g4 = lane >> 4, c16 = lane & 15;
  const int wr = wave >> 1, wc = wave & 1;
  const bf16* projg = (const bf16*)(p.ws + OFF_PROJ) + (size_t)(m0 + wr * 64 + g4 * 4) * PC + n0 + wc * 64 + c16;
  f32x4 acc[4][4];
  acc_zero(acc);
  gemm_mainloop((const bf16*)(p.ws + OFF_ONSA), 512, (const bf16*)(p.ws + OFF_WUPN) + (size_t)layer * 1024 * 512, 512, m0, n0, sm, acc);
  bf16* yg = (bf16*)(p.ws + OFF_H) + (size_t)(m0 + wr * 64 + g4 * 4) * 1024 + n0 + wc * 64 + c16;
#pragma unroll
  for (int mi = 0; mi < 4; ++mi)
#pragma unroll
    for (int ni = 0; ni < 4; ++ni)
#pragma unroll
      for (int r = 0; r < 4; ++r)
        yg[(size_t)(mi * 16 + r) * 1024 + ni * 16] =
            f2bf(sigmoidf_(bf2f(projg[(size_t)(mi * 16 + r) * PC + C_GN + ni * 16])) * acc[mi][ni][r]);
  acc_zero(acc);
  gemm_mainloop((const bf16*)(p.ws + OFF_OMOBA), 512, (const bf16*)(p.ws + OFF_WUPM) + (size_t)layer * 1024 * 512, 512, m0, n0, sm, acc);
#pragma unroll
  for (int mi = 0; mi < 4; ++mi)
#pragma unroll
    for (int ni = 0; ni < 4; ++ni)
#pragma unroll
      for (int r = 0; r < 4; ++r)
        acc[mi][ni][r] = bf2f(yg[(size_t)(mi * 16 + r) * 1024 + ni * 16]) +
                         sigmoidf_(bf2f(projg[(size_t)(mi * 16 + r) * PC + C_GM + ni * 16])) * acc[mi][ni][r];
  store_tile_bf16(sm, acc, (bf16*)(p.ws + OFF_H) + (size_t)(m0 + wr * 64) * 1024 + n0 + wc * 64, 1024);
}

DEV void merge_tile256(const Params& p, int layer, int m0, int n0, bf16* sm) {
  const int tid = tidx(), lane = tid & 63, wave = tid >> 6, g4 = lane >> 4, c16 = lane & 15;
  const int wr = wave >> 1, wc = wave & 1;
  f32x4 acc[2][4][4];
  acc_zero(acc[0]);
  acc_zero(acc[1]);
  gemm256_mainloop((const bf16*)(p.ws + OFF_ONSA), 512, (const bf16*)(p.ws + OFF_WUPN) + (size_t)layer * 1024 * 512, 512, m0, n0, sm, acc);
#pragma unroll
  for (int h = 0; h < 2; ++h) {
    const size_t rb = (size_t)(m0 + wr * 128 + h * 64 + g4 * 4);
    const bf16* projg = (const bf16*)(p.ws + OFF_PROJ) + rb * PC + n0 + wc * 64 + c16;
    bf16* yg = (bf16*)(p.ws + OFF_H) + rb * 1024 + n0 + wc * 64 + c16;
#pragma unroll
    for (int mi = 0; mi < 4; ++mi)
#pragma unroll
      for (int ni = 0; ni < 4; ++ni)
#pragma unroll
        for (int r = 0; r < 4; ++r)
          yg[(size_t)(mi * 16 + r) * 1024 + ni * 16] =
              f2bf(sigmoidf_(bf2f(projg[(size_t)(mi * 16 + r) * PC + C_GN + ni * 16])) * acc[h][mi][ni][r]);
  }
  acc_zero(acc[0]);
  acc_zero(acc[1]);
  gemm256_mainloop((const bf16*)(p.ws + OFF_OMOBA), 512, (const bf16*)(p.ws + OFF_WUPM) + (size_t)layer * 1024 * 512, 512, m0, n0, sm, acc);
#pragma unroll
  for (int h = 0; h < 2; ++h) {
    const size_t rb = (size_t)(m0 + wr * 128 + h * 64 + g4 * 4);
    const bf16* projg = (const bf16*)(p.ws + OFF_PROJ) + rb * PC + n0 + wc * 64 + c16;
    const bf16* yg = (const bf16*)(p.ws + OFF_H) + rb * 1024 + n0 + wc * 64 + c16;
#pragma unroll
    for (int mi = 0; mi < 4; ++mi)
#pragma unroll
      for (int ni = 0; ni < 4; ++ni)
#pragma unroll
        for (int r = 0; r < 4; ++r)
          acc[h][mi][ni][r] = bf2f(yg[(size_t)(mi * 16 + r) * 1024 + ni * 16]) +
                              sigmoidf_(bf2f(projg[(size_t)(mi * 16 + r) * PC + C_GM + ni * 16])) * acc[h][mi][ni][r];
    store_tile_bf16(sm, acc[h], (bf16*)(p.ws + OFF_H) + (size_t)(m0 + wr * 128 + h * 64) * 1024 + n0 + wc * 64, 1024);
  }
}

DEV void compress_item(const Params& p, int layer, int item, float* sm) {
  const int tid = tidx();
  const int grp = item & 127, which = (item >> 7) & 1, kvh = (item >> 8) & 1, b = item >> 9;
  const int c0 = grp * 8;
  float* xs = sm;
  float* hs = sm + 144 * 64;
  const bf16* proj = (const bf16*)(p.ws + OFF_PROJ);
  const int col = (which ? C_VC : C_KC) + kvh * 64;
  for (int i = tid; i < 144 * 64; i += 256) {
    int tl = i >> 6, d = i & 63;
    int t = c0 * 16 + tl;
    xs[i] = (t < S) ? bf2f(proj[((size_t)b * S + t) * PC + col + d]) : 0.f;
  }
  __syncthreads();
  const int lw = layer * 2 + which;
  if (tid < 128) {
    const float* w1 = p.cmp_w1 + (size_t)lw * 2048 * 128 + tid;
    float acc[8];
#pragma unroll
    for (int ci = 0; ci < 8; ++ci) acc[ci] = 0.f;
    for (int l = 0; l < 32; ++l) {
#pragma unroll 4
      for (int d = 0; d < 64; ++d) {
        float w = w1[(size_t)(l * 64 + d) * 128];
#pragma unroll
        for (int ci = 0; ci < 8; ++ci) acc[ci] += xs[(ci * 16 + l) * 64 + d] * w;
      }
    }
    float pb = ((const float*)(p.ws + OFF_PEB))[lw * 128 + tid];
#pragma unroll
    for (int ci = 0; ci < 8; ++ci) hs[ci * 128 + tid] = gelu_tanh(acc[ci] + pb);
  }
  __syncthreads();
  const float* w2 = p.cmp_w2 + (size_t)lw * 128 * 64;
  float* outp = PROBE_CMPR ? ((float*)(p.ws + OFF_CMP) + (which ? (size_t)Bn * 1024 * 128 : 0)) : (float*)(p.ws + (which ? OFF_VCC : OFF_KCC));
#pragma unroll
  for (int rr = 0; rr < 2; ++rr) {
    int o = rr * 256 + tid;
    int ci = o >> 6, d = o & 63;
    int c = c0 + ci;
    float a = 0.f;
    for (int j = 0; j < 128; ++j) a += hs[ci * 128 + j] * w2[j * 64 + d];
    if (c < 1023) outp[(((size_t)b * 1024 + c) * 2 + kvh) * 64 + d] = a;
    bf16* outb = (bf16*)(p.ws + (which ? OFF_VCB : OFF_KCB));
    if (!PROBE_CMPR && c < 1024) outb[(((size_t)b * 2 + kvh) * 1024 + c) * 64 + d] = (c < 1023) ? f2bf(a) : (bf16)0;
  }
  __syncthreads();
}

DEV void compress_mfma_item(const Params& p, int layer, int item, char* smem) {
  bf16* xs = (bf16*)smem;
  float* hs = (float*)(smem + 272 * 64 * 2);
  const int tid = tidx(), lane = tid & 63, wave = tid >> 6, g4 = lane >> 4, c16 = lane & 15;
  const int cblk = item & 63, which = (item >> 6) & 1, kvh = (item >> 7) & 1, b = item >> 8;
  const int t0 = cblk * 256;
  const bf16* proj = (const bf16*)(p.ws + OFF_PROJ) + (size_t)b * S * PC + (which ? C_VC : C_KC) + kvh * 64;
  __syncthreads();
  for (int i = tid; i < 272 * 8; i += 256) {
    const int tl = i >> 3, ch = i & 7;
    const int t = t0 + tl;
    uint4 v = uint4{0u, 0u, 0u, 0u};
    if (t < S) v = *(const uint4*)(proj + (size_t)t * PC + ch * 8);
    *(uint4*)(xs + tl * 64 + ((ch ^ ((tl >> 4) & 7)) * 8)) = v;
  }
  __syncthreads();
  const int lw = layer * 2 + which;
  const bf16* w1t = (const bf16*)(p.ws + OFF_W1T) + (size_t)lw * 128 * 2048;
  f32x4 acc0 = f32x4{0.f, 0.f, 0.f, 0.f}, acc1 = f32x4{0.f, 0.f, 0.f, 0.f};
  const bf16* wb0 = w1t + (size_t)((2 * wave) * 16 + c16) * 2048 + g4 * 8;
  const bf16* wb1 = w1t + (size_t)((2 * wave + 1) * 16 + c16) * 2048 + g4 * 8;
#pragma unroll 4
  for (int ks = 0; ks < 64; ++ks) {
    const int l = ks >> 1, ch = (ks & 1) * 4 + g4;
    const int tl = 16 * c16 + l;
    const bf16x8 af = *(const bf16x8*)(xs + tl * 64 + ((ch ^ ((tl >> 4) & 7)) * 8));
    const bf16x8 b0 = *(const bf16x8*)(wb0 + ks * 32);
    const bf16x8 b1 = *(const bf16x8*)(wb1 + ks * 32);
    acc0 = MFMA16B(af, b0, acc0);
    acc1 = MFMA16B(af, b1, acc1);
  }
  {
    const float* peb = (const float*)(p.ws + OFF_PEB) + lw * 128;
    const int j0 = (2 * wave) * 16 + c16, j1 = j0 + 16;
    const float pb0 = peb[j0], pb1 = peb[j1];
#pragma unroll
    for (int r = 0; r < 4; ++r) {
      hs[(g4 * 4 + r) * 128 + j0] = gelu_tanh(acc0[r] + pb0);
      hs[(g4 * 4 + r) * 128 + j1] = gelu_tanh(acc1[r] + pb1);
    }
  }
  __syncthreads();
  const float* w2 = p.cmp_w2 + (size_t)lw * 128 * 64;
  const int d = tid & 63, cq = tid >> 6;
  float o0 = 0.f, o1 = 0.f, o2 = 0.f, o3 = 0.f;
#pragma unroll 8
  for (int j = 0; j < 128; ++j) {
    const float w = w2[j * 64 + d];
    o0 += hs[(cq * 4 + 0) * 128 + j] * w;
    o1 += hs[(cq * 4 + 1) * 128 + j] * w;
    o2 += hs[(cq * 4 + 2) * 128 + j] * w;
    o3 += hs[(cq * 4 + 3) * 128 + j] * w;
  }
  float* outp = (float*)(p.ws + (which ? OFF_VCC : OFF_KCC));
  bf16* outb = (bf16*)(p.ws + (which ? OFF_VCB : OFF_KCB));
  const float ov[4] = {o0, o1, o2, o3};
#pragma unroll
  for (int i = 0; i < 4; ++i) {
    const int c = cblk * 16 + cq * 4 + i;
    if (c < 1023) outp[(((size_t)b * 1024 + c) * 2 + kvh) * 64 + d] = ov[i];
    outb[(((size_t)b * 2 + kvh) * 1024 + c) * 64 + d] = (c < 1023) ? f2bf(ov[i]) : (bf16)0;
  }
  __syncthreads();
}

DEV void n1_item(const Params& p, int layer, int item, float* sm) {
  const int chunk = item & 255, kvh = (item >> 8) & 1, b = item >> 9;
  const int tid = tidx(), ql = tid >> 2, g = tid & 3;
  const int t = chunk * 64 + ql, h = kvh * 4 + g;
  const size_t tok = (size_t)b * S + t;
  const bf16* proj = (const bf16*)(p.ws + OFF_PROJ);
  float* imp = sm;
  for (int i = tid; i < 64 * 257; i += 256) imp[i] = 0.f;
  float q[64];
  load_q64(q, proj + tok * PC + C_NQ + h * 64, 0.125f);
  const int nv = (t >= 31) ? (((t - 31) >> 4) + 1) : 0;
  const int nv_max = (((chunk * 64 + 63) - 31) >> 4) + 1;
  const float* kc = (const float*)(p.ws + OFF_KCC) + (size_t)b * 1024 * 128 + kvh * 64;
  const float* vc = (const float*)(p.ws + OFF_VCC) + (size_t)b * 1024 * 128 + kvh * 64;
  float m = -INFINITY, l = 0.f;
  for (int c = 0; c < nv_max; ++c) {
    float s = dot64_f(q, kc + (size_t)c * 128);
    if (c < nv) {
      float mn = fmaxf(m, s);
      l = l * expf(m - mn) + expf(s - mn);
      m = mn;
    }
  }
  __syncthreads();
  float o[64];
#pragma unroll
  for (int d = 0; d < 64; ++d) o[d] = 0.f;
  const float inv_l = (nv > 0) ? 1.f / l : 0.f;
  for (int c = 0; c < nv_max; ++c) {
    float s = dot64_f(q, kc + (size_t)c * 128);
    float pr = (c < nv) ? expf(s - m) * inv_l : 0.f;
    axpy64_f(o, pr, vc + (size_t)c * 128);
    float ps = pr;
    ps += shx(ps, 1);
    ps += shx(ps, 2);
    if (g == 0) {
      int n = c >> 2;
      if ((c & 3) == 3) {
        imp[ql * 257 + n] += 0.5f * ps;
        imp[ql * 257 + n + 1] += 0.5f * ps;
      } else {
        imp[ql * 257 + n] += ps;
      }
    }
  }
  const float gate0 = (!PROBE_NSA || (PROBE_NSA & 1)) ? sigmoidf_(bf2f(proj[tok * PC + C_NG + h * 3 + 0])) : 0.f;
  float* oa = (float*)(p.ws + OFF_H) + tok * 512 + h * 64;
#pragma unroll
  for (int d = 0; d < 64; d += 4) {
    float4 v = {gate0 * o[d], gate0 * o[d + 1], gate0 * o[d + 2], gate0 * o[d + 3]};
    *(float4*)(oa + d) = v;
  }
  __syncthreads();
#if PROBE_NSA == 8
  if (b == 0 && kvh == 0)
    for (int i = tid; i < 64 * 256; i += 256)
      ((float*)(p.ws + OFF_OMOBA))[(size_t)(chunk * 64 + (i >> 8)) * 256 + (i & 255)] = imp[(i >> 8) * 257 + (i & 255)];
  __syncthreads();
#endif
  if (g == 0) {
    int* selp = (int*)(p.ws + OFF_SEL) + (((size_t)b * 2 + kvh) * S + t) * 16;
    const int cur = chunk;
    if (cur < 16) {
      for (int j = 0; j < 16; ++j) selp[j] = (j <= cur) ? j : -1;
    } else {
      selp[0] = 0;
      selp[1] = cur - 1;
      selp[2] = cur;
      float* row = imp + ql * 257;
      for (int j = 3; j < 16; ++j) {
        float best = -1.f;
        int bi = 1;
        for (int n = 1; n <= cur - 2; ++n) {
          float v = row[n];
          if (v > best) { best = v; bi = n; }
        }
        selp[j] = bi;
        row[bi] = -2.f;
      }
    }
  }
  __syncthreads();
}

DEV void kmean_item(const Params& p, int item, float* sm) {
  const int n = item & 63, h = (item >> 6) & 7, b = item >> 9;
  const int tid = tidx(), d = tid & 63, part = tid >> 6;
  const bf16* mkb = (const bf16*)(p.ws + OFF_MKB);
  float a = 0.f;
  for (int i = 0; i < 64; ++i) {
    int t = n * 256 + part * 64 + i;
    a += bf2f(mkb[((size_t)(b * 8 + h) * S + t) * 64 + d]);
  }
  sm[tid] = a;
  __syncthreads();
  if (tid < 64) {
    float s = sm[tid] + sm[64 + tid] + sm[128 + tid] + sm[192 + tid];
    const size_t ko = (((size_t)b * 8 + h) * 64 + n) * 64 + tid;
    const float mean = s * (1.f / 256.f);
    ((float*)(p.ws + OFF_KMEAN))[ko] = mean;
    const bf16 hi = f2bf(mean);
    ((bf16*)(p.ws + OFF_KMHL))[ko] = hi;
    ((bf16*)(p.ws + OFF_KMHL))[(size_t)2 * 8 * 64 * 64 + ko] = f2bf(mean - bf2f(hi));
    if (tid == 0) ((int*)(p.ws + OFF_MCNT))[(b * 8 + h) * 64 + n] = 0;
  }
  __syncthreads();
}

DEV void n23_item(const Params& p, int layer, int item) {
  const int chunk = item & 255, kvh = (item >> 8) & 1, b = item >> 9;
  const int tid = tidx(), ql = tid >> 2, g = tid & 3;
  const int t = chunk * 64 + ql, h = kvh * 4 + g;
  const size_t tok = (size_t)b * S + t;
  const bf16* proj = (const bf16*)(p.ws + OFF_PROJ);
  const float* rope = (const float*)(p.ws + OFF_ROPE) + (size_t)t * 16;
  float q[64];
  load_q64(q, proj + tok * PC + C_NQ + h * 64, 1.0f);
#pragma unroll
  for (int i = 0; i < 8; ++i) {
    float cs = rope[i], sn = rope[8 + i];
    float x1 = q[i], x2 = q[8 + i];
    q[i] = x1 * cs - x2 * sn;
    q[8 + i] = x2 * cs + x1 * sn;
  }
#pragma unroll
  for (int i = 0; i < 64; ++i) q[i] *= 0.125f;
  const size_t kvo = ((size_t)(b * 2 + kvh) * S) * 64;
  const bf16* ksb = (const bf16*)(p.ws + OFF_KSB) + kvo;
  const bf16* vsb = (const bf16*)(p.ws + OFF_VSB) + kvo;
  const bf16* kwb = (const bf16*)(p.ws + OFF_KWB) + kvo;
  const bf16* vwb = (const bf16*)(p.ws + OFF_VWB) + kvo;
  const int* selp = (const int*)(p.ws + OFF_SEL) + (((size_t)b * 2 + kvh) * S + t) * 16;
  float* oa = (float*)(p.ws + OFF_H) + tok * 512 + h * 64;
  const float gate1 = (!PROBE_NSA || (PROBE_NSA & 2)) ? sigmoidf_(bf2f(proj[tok * PC + C_NG + h * 3 + 1])) : 0.f;
  const float gate2 = (!PROBE_NSA || (PROBE_NSA & 4)) ? sigmoidf_(bf2f(proj[tok * PC + C_NG + h * 3 + 2])) : 0.f;
  float o[64];
  {
    float m = -INFINITY;
    for (int j = 0; j < 16; ++j) {
      int n = selp[j];
      if (n >= 0) {
        for (int i = 0; i < 64; ++i) {
          int kpos = n * 64 + i;
          if (kpos <= t) {
            float s = dot64_bf(q, ksb + (size_t)kpos * 64);
            m = fmaxf(m, s);
          }
        }
      }
    }
    float l = 0.f;
#pragma unroll
    for (int d = 0; d < 64; ++d) o[d] = 0.f;
    for (int j = 0; j < 16; ++j) {
      int n = selp[j];
      if (n >= 0) {
        for (int i = 0; i < 64; ++i) {
          int kpos = n * 64 + i;
          if (kpos <= t) {
            float s = dot64_bf(q, ksb + (size_t)kpos * 64);
            float pr = expf(s - m);
            l += pr;
            axpy64_bf(o, pr, vsb + (size_t)kpos * 64);
          }
        }
      }
    }
    float sc = gate1 / l;
#pragma unroll
    for (int d = 0; d < 64; d += 4) {
      float4 v = *(float4*)(oa + d);
      v.x += sc * o[d]; v.y += sc * o[d + 1]; v.z += sc * o[d + 2]; v.w += sc * o[d + 3];
      *(float4*)(oa + d) = v;
    }
  }
  {
    const int s0 = chunk * 64;
    const int jlo = (s0 - 511 > 0) ? (s0 - 511) : 0;
    const int jhi = s0 + 63;
    float m = -INFINITY;
    for (int j = jlo; j <= jhi; ++j) {
      float s = dot64_bf(q, kwb + (size_t)j * 64);
      if (j <= t && j > t - 512) m = fmaxf(m, s);
    }
    float l = 0.f;
#pragma unroll
    for (int d = 0; d < 64; ++d) o[d] = 0.f;
    for (int j = jlo; j <= jhi; ++j) {
      float s = dot64_bf(q, kwb + (size_t)j * 64);
      float pr = (j <= t && j > t - 512) ? expf(s - m) : 0.f;
      l += pr;
      axpy64_bf(o, pr, vwb + (size_t)j * 64);
    }
    float sc = gate2 / l;
    bf16* ob = (bf16*)(p.ws + (PROBE_NSA ? OFF_CMP : OFF_ONSA)) + tok * 512 + h * 64;
#pragma unroll
    for (int d = 0; d < 64; d += 8) {
      float4 v0 = *(float4*)(oa + d);
      float4 v1 = *(float4*)(oa + d + 4);
      uint4 pk;
      pk.x = (unsigned)f2bf(v0.x + sc * o[d]) | ((unsigned)f2bf(v0.y + sc * o[d + 1]) << 16);
      pk.y = (unsigned)f2bf(v0.z + sc * o[d + 2]) | ((unsigned)f2bf(v0.w + sc * o[d + 3]) << 16);
      pk.z = (unsigned)f2bf(v1.x + sc * o[d + 4]) | ((unsigned)f2bf(v1.y + sc * o[d + 5]) << 16);
      pk.w = (unsigned)f2bf(v1.z + sc * o[d + 6]) | ((unsigned)f2bf(v1.w + sc * o[d + 7]) << 16);
      *(uint4*)(ob + d) = pk;
    }
  }
}

DEV void moba_item(const Params& p, int layer, int item) {
  const int blk = item & 63, h = (item >> 6) & 7, b = item >> 9;
  const int tid = tidx();
  const int t = blk * 256 + tid;
  const size_t tok = (size_t)b * S + t;
  const bf16* proj = (const bf16*)(p.ws + OFF_PROJ);
  float q[64];
  load_q64(q, proj + tok * PC + C_MQ + h * 64, 0.125f);
  const float* km = (const float*)(p.ws + OFF_KMEAN) + ((size_t)b * 8 + h) * 64 * 64;
  float b0 = -INFINITY, b1 = -INFINITY, b2 = -INFINITY;
  int i0 = -1, i1 = -1, i2 = -1;
  for (int n = 0; n < blk; ++n) {
    float v = dot64_f(q, km + n * 64);
    if (v > b0) { b2 = b1; i2 = i1; b1 = b0; i1 = i0; b0 = v; i0 = n; }
    else if (v > b1) { b2 = b1; i2 = i1; b1 = v; i1 = n; }
    else if (v > b2) { b2 = v; i2 = n; }
  }
  const bf16* mkb = (const bf16*)(p.ws + OFF_MKB) + ((size_t)(b * 8 + h) * S) * 64;
  const bf16* mvb = (const bf16*)(p.ws + OFF_MVB) + ((size_t)(b * 8 + h) * S) * 64;
  float m = -INFINITY;
  for (int sidx = 0; sidx < 3; ++sidx) {
    int n = (sidx == 0) ? i0 : (sidx == 1) ? i1 : i2;
    if (sidx < blk) {
      for (int i = 0; i < 256; ++i) {
        float s = dot64_bf(q, mkb + (size_t)(n * 256 + i) * 64);
        m = fmaxf(m, s);
      }
    }
  }
  for (int i = 0; i < 256; ++i) {
    int kpos = blk * 256 + i;
    float s = dot64_bf(q, mkb + (size_t)kpos * 64);
    if (kpos <= t) m = fmaxf(m, s);
  }
  float l = 0.f;
  float o[64];
#pragma unroll
  for (int d = 0; d < 64; ++d) o[d] = 0.f;
  for (int sidx = 0; sidx < 3; ++sidx) {
    int n = (sidx == 0) ? i0 : (sidx == 1) ? i1 : i2;
    if (sidx < blk) {
      for (int i = 0; i < 256; ++i) {
        const size_t ko = (size_t)(n * 256 + i) * 64;
        float s = dot64_bf(q, mkb + ko);
        float pr = expf(s - m);
        l += pr;
        axpy64_bf(o, pr, mvb + ko);
      }
    }
  }
  for (int i = 0; i < 256; ++i) {
    int kpos = blk * 256 + i;
    const size_t ko = (size_t)kpos * 64;
    float s = dot64_bf(q, mkb + ko);
    float pr = (kpos <= t) ? expf(s - m) : 0.f;
    l += pr;
    axpy64_bf(o, pr, mvb + ko);
  }
  const float il = 1.f / l;
  bf16* ob = (bf16*)(p.ws + (PROBE_MOBA ? OFF_CMP : OFF_OMOBA)) + tok * 512 + h * 64;
#pragma unroll
  for (int d = 0; d < 64; d += 8) {
    uint4 pk;
    pk.x = (unsigned)f2bf(o[d] * il) | ((unsigned)f2bf(o[d + 1] * il) << 16);
    pk.y = (unsigned)f2bf(o[d + 2] * il) | ((unsigned)f2bf(o[d + 3] * il) << 16);
    pk.z = (unsigned)f2bf(o[d + 4] * il) | ((unsigned)f2bf(o[d + 5] * il) << 16);
    pk.w = (unsigned)f2bf(o[d + 6] * il) | ((unsigned)f2bf(o[d + 7] * il) << 16);
    *(uint4*)(ob + d) = pk;
  }
}

typedef short v4i16_t __attribute__((ext_vector_type(4)));
typedef unsigned u32x4_t __attribute__((ext_vector_type(4)));
DEV v4i16_t lds_tr16(const bf16* p) {
  return __builtin_amdgcn_ds_read_tr16_b64_v4i16((__attribute__((address_space(3))) v4i16_t*)p);
}
DEV unsigned cvtpk(float lo, float hi) {
  unsigned r;
  asm("v_cvt_pk_bf16_f32 %0, %1, %2" : "=v"(r) : "v"(lo), "v"(hi));
  return r;
}
#define MFMA16(a, b, c) __builtin_amdgcn_mfma_f32_16x16x32_bf16(a, b, c, 0, 0, 0)
constexpr float C2 = 0.125f * 1.4426950408889634f;
constexpr int KT_LD = 72;
constexpr int KT_ELEMS = 64 * KT_LD;

template <int NI>
struct AttnSt {
  f32x4 o[4][NI];
  float m[NI], l[NI];
};
template <int NI>
DEV void attn_init(AttnSt<NI>& st) {
#pragma unroll
  for (int ni = 0; ni < NI; ++ni) {
    st.m[ni] = -INFINITY;
    st.l[ni] = 0.f;
#pragma unroll
    for (int di = 0; di < 4; ++di) st.o[di][ni] = f32x4{0.f, 0.f, 0.f, 0.f};
  }
}
#define TILE_DECL uint4 tl_k0, tl_k1, tl_v0, tl_v1
#define TILE_GLOAD(kb, vb, ld, key0)                                                        \
  do {                                                                                      \
    const int r_ = tidx() >> 3, c_ = (tidx() & 7) * 8;                            \
    tl_k0 = *(const uint4*)((kb) + (size_t)((key0) + r_) * (ld) + c_);                      \
    tl_k1 = *(const uint4*)((kb) + (size_t)((key0) + 32 + r_) * (ld) + c_);                 \
    tl_v0 = *(const uint4*)((vb) + (size_t)((key0) + r_) * (ld) + c_);                      \
    tl_v1 = *(const uint4*)((vb) + (size_t)((key0) + 32 + r_) * (ld) + c_);                 \
  } while (0)
#define TILE_SSTORE(Ks_, Vs_)                                                               \
  do {                                                                                      \
    const int r_ = tidx() >> 3, c_ = (tidx() & 7) * 8;                            \
    *(uint4*)((Ks_) + r_ * KT_LD + c_) = tl_k0;                                             \
    *(uint4*)((Ks_) + (32 + r_) * KT_LD + c_) = tl_k1;                                      \
    *(uint4*)((Vs_) + r_ * KT_LD + c_) = tl_v0;                                             \
    *(uint4*)((Vs_) + (32 + r_) * KT_LD + c_) = tl_v1;                                      \
  } while (0)
#define TL_GLOAD(P, kb, vb, ld, key0)                                                       \
  do {                                                                                      \
    const int r_ = tidx() >> 3, c_ = (tidx() & 7) * 8;                                      \
    P##_k0 = *(const uint4*)((kb) + (size_t)((key0) + r_) * (ld) + c_);                     \
    P##_k1 = *(const uint4*)((kb) + (size_t)((key0) + 32 + r_) * (ld) + c_);                \
    P##_v0 = *(const uint4*)((vb) + (size_t)((key0) + r_) * (ld) + c_);                     \
    P##_v1 = *(const uint4*)((vb) + (size_t)((key0) + 32 + r_) * (ld) + c_);                \
  } while (0)
#define TL_SSTORE(P, Ks_, Vs_)                                                              \
  do {                                                                                      \
    const int r_ = tidx() >> 3, c_ = (tidx() & 7) * 8;                                      \
    *(uint4*)((Ks_) + r_ * KT_LD + c_) = P##_k0;                                            \
    *(uint4*)((Ks_) + (32 + r_) * KT_LD + c_) = P##_k1;                                     \
    *(uint4*)((Vs_) + r_ * KT_LD + c_) = P##_v0;                                            \
    *(uint4*)((Vs_) + (32 + r_) * KT_LD + c_) = P##_v1;                                     \
  } while (0)
#define KV_SWEEP(kb_, vb_, ld_, nt_, KEYF, ...)                                             \
  {                                                                                         \
    uint4 tA_k0, tA_k1, tA_v0, tA_v1, tB_k0, tB_k1, tB_v0, tB_v1;                           \
    const int nt__ = (nt_);                                                                 \
    if (nt__ > 0) {                                                                         \
      TL_GLOAD(tA, kb_, vb_, ld_, KEYF(0));                                                 \
      TL_SSTORE(tA, smkv, smkv + KT_ELEMS);                                                 \
      if (nt__ > 1) TL_GLOAD(tA, kb_, vb_, ld_, KEYF(1));                                   \
    }                                                                                       \
    __syncthreads();                                                                        \
    for (int it0__ = 0; it0__ < nt__; it0__ += 2) {                                         \
      {                                                                                     \
        const int it = it0__;                                                               \
        if (it + 2 < nt__) TL_GLOAD(tB, kb_, vb_, ld_, KEYF(it + 2));                       \
        const bf16* Ks = smkv;                                                              \
        __VA_ARGS__                                                                         \
        if (it + 1 < nt__) TL_SSTORE(tA, smkv + 2 * KT_ELEMS, smkv + 3 * KT_ELEMS);         \
        __syncthreads();                                                                    \
      }                                                                                     \
      if (it0__ + 1 < nt__) {                                                               \
        const int it = it0__ + 1;                                                           \
        if (it + 2 < nt__) TL_GLOAD(tA, kb_, vb_, ld_, KEYF(it + 2));                       \
        const bf16* Ks = smkv + 2 * KT_ELEMS;                                               \
        __VA_ARGS__                                                                         \
        if (it + 1 < nt__) TL_SSTORE(tB, smkv, smkv + KT_ELEMS);                            \
        __syncthreads();                                                                    \
      }                                                                                     \
    }                                                                                       \
  }
template <int NI>
DEV void attn_scores(const bf16* Ks, const bf16x8 (&qf)[NI][2], f32x4 (&s)[4][NI]) {
  const int lane = tidx() & 63, g4 = lane >> 4, c16 = lane & 15;
#pragma unroll
  for (int mi = 0; mi < 4; ++mi) {
#pragma unroll
    for (int ni = 0; ni < NI; ++ni) s[mi][ni] = f32x4{0.f, 0.f, 0.f, 0.f};
#pragma unroll
    for (int ks = 0; ks < 2; ++ks) {
      bf16x8 kf = *(const bf16x8*)(Ks + (mi * 16 + c16) * KT_LD + ks * 32 + g4 * 8);
#pragma unroll
      for (int ni = 0; ni < NI; ++ni) s[mi][ni] = MFMA16(kf, qf[ni][ks], s[mi][ni]);
    }
  }
}
template <int NI>
DEV void attn_pv(const bf16* Vs, const bf16x8 (&pf)[NI][2], f32x4 (&o)[4][NI]) {
  const int lane = tidx() & 63, g4 = lane >> 4, q4 = (lane & 15) >> 2, p4 = lane & 3;
#pragma unroll
  for (int di = 0; di < 4; ++di) {
#pragma unroll
    for (int ks2 = 0; ks2 < 2; ++ks2) {
      v4i16_t v0 = lds_tr16(Vs + (ks2 * 32 + g4 * 4 + q4) * KT_LD + di * 16 + p4 * 4);
      v4i16_t v1 = lds_tr16(Vs + (ks2 * 32 + 16 + g4 * 4 + q4) * KT_LD + di * 16 + p4 * 4);
      bf16x8 vf = __builtin_shufflevector(v0, v1, 0, 1, 2, 3, 4, 5, 6, 7);
#pragma unroll
      for (int ni = 0; ni < NI; ++ni) o[di][ni] = MFMA16(vf, pf[ni][ks2], o[di][ni]);
    }
  }
}
DEV void exp4_pack(const f32x4& sv, float nm, float& ps, unsigned& w0, unsigned& w1) {
  float p0 = __builtin_amdgcn_exp2f(__builtin_fmaf(sv[0], C2, nm));
  float p1 = __builtin_amdgcn_exp2f(__builtin_fmaf(sv[1], C2, nm));
  float p2 = __builtin_amdgcn_exp2f(__builtin_fmaf(sv[2], C2, nm));
  float p3 = __builtin_amdgcn_exp2f(__builtin_fmaf(sv[3], C2, nm));
  ps += (p0 + p1) + (p2 + p3);
  w0 = cvtpk(p0, p1);
  w1 = cvtpk(p2, p3);
}
template <int NI>
DEV void attn_softmax_pv(const bf16* Vs, f32x4 (&s)[4][NI], AttnSt<NI>& st) {
  bf16x8 pf[NI][2];
#pragma unroll
  for (int ni = 0; ni < NI; ++ni) {
    float mx = -INFINITY;
#pragma unroll
    for (int mi = 0; mi < 4; ++mi)
      mx = fmaxf(fmaxf(mx, fmaxf(s[mi][ni][0], s[mi][ni][1])), fmaxf(s[mi][ni][2], s[mi][ni][3]));
    mx = fmaxf(mx, shx(mx, 16));
    mx = fmaxf(mx, shx(mx, 32));
    const float mn = fmaxf(st.m[ni], mx);
    const float mu = (mn == -INFINITY) ? 0.f : mn;
    const float corr = __builtin_amdgcn_exp2f((st.m[ni] - mu) * C2);
    st.m[ni] = mn;
    const float nm = -mu * C2;
    float ps = 0.f;
    u32x4_t wa, wb;
    unsigned t0, t1;
    exp4_pack(s[0][ni], nm, ps, t0, t1); wa.x = t0; wa.y = t1;
    exp4_pack(s[1][ni], nm, ps, t0, t1); wa.z = t0; wa.w = t1;
    exp4_pack(s[2][ni], nm, ps, t0, t1); wb.x = t0; wb.y = t1;
    exp4_pack(s[3][ni], nm, ps, t0, t1); wb.z = t0; wb.w = t1;
    st.l[ni] = st.l[ni] * corr + ps;
#pragma unroll
    for (int di = 0; di < 4; ++di) {
      st.o[di][ni][0] *= corr; st.o[di][ni][1] *= corr; st.o[di][ni][2] *= corr; st.o[di][ni][3] *= corr;
    }
    pf[ni][0] = __builtin_bit_cast(bf16x8, wa);
    pf[ni][1] = __builtin_bit_cast(bf16x8, wb);
  }
  attn_pv<NI>(Vs, pf, st.o);
}

template <int NI>
DEV void attn_softmax_pv_act(const bf16* Vs, f32x4 (&s)[4][NI], AttnSt<NI>& st, const bool (&act)[NI]) {
  bf16x8 pf[NI][2];
#pragma unroll
  for (int ni = 0; ni < NI; ++ni) {
    pf[ni][0] = bf16x8{0, 0, 0, 0, 0, 0, 0, 0};
    pf[ni][1] = bf16x8{0, 0, 0, 0, 0, 0, 0, 0};
    if (act[ni]) {
      float mx = -INFINITY;
#pragma unroll
      for (int mi = 0; mi < 4; ++mi)
        mx = fmaxf(fmaxf(mx, fmaxf(s[mi][ni][0], s[mi][ni][1])), fmaxf(s[mi][ni][2], s[mi][ni][3]));
      mx = fmaxf(mx, shx(mx, 16));
      mx = fmaxf(mx, shx(mx, 32));
      const float mn = fmaxf(st.m[ni], mx);
      const float mu = (mn == -INFINITY) ? 0.f : mn;
      const float corr = __builtin_amdgcn_exp2f((st.m[ni] - mu) * C2);
      st.m[ni] = mn;
      const float nm = -mu * C2;
      float ps = 0.f;
      u32x4_t wa, wb;
      unsigned t0, t1;
      exp4_pack(s[0][ni], nm, ps, t0, t1); wa.x = t0; wa.y = t1;
      exp4_pack(s[1][ni], nm, ps, t0, t1); wa.z = t0; wa.w = t1;
      exp4_pack(s[2][ni], nm, ps, t0, t1); wb.x = t0; wb.y = t1;
      exp4_pack(s[3][ni], nm, ps, t0, t1); wb.z = t0; wb.w = t1;
      st.l[ni] = st.l[ni] * corr + ps;
#pragma unroll
      for (int di = 0; di < 4; ++di) {
        st.o[di][ni][0] *= corr; st.o[di][ni][1] *= corr; st.o[di][ni][2] *= corr; st.o[di][ni][3] *= corr;
      }
      pf[ni][0] = __builtin_bit_cast(bf16x8, wa);
      pf[ni][1] = __builtin_bit_cast(bf16x8, wb);
    }
  }
  const int lane = tidx() & 63, g4 = lane >> 4, q4 = (lane & 15) >> 2, p4 = lane & 3;
#pragma unroll
  for (int di = 0; di < 4; ++di) {
#pragma unroll
    for (int ks2 = 0; ks2 < 2; ++ks2) {
      v4i16_t v0 = lds_tr16(Vs + (ks2 * 32 + g4 * 4 + q4) * KT_LD + di * 16 + p4 * 4);
      v4i16_t v1 = lds_tr16(Vs + (ks2 * 32 + 16 + g4 * 4 + q4) * KT_LD + di * 16 + p4 * 4);
      bf16x8 vf = __builtin_shufflevector(v0, v1, 0, 1, 2, 3, 4, 5, 6, 7);
#pragma unroll
      for (int ni = 0; ni < NI; ++ni)
        if (act[ni]) st.o[di][ni] = MFMA16(vf, pf[ni][ks2], st.o[di][ni]);
    }
  }
}
template <int NI>
DEV int gate_top1(f32x4 (&gs)[4][NI], int ni, int g4) {
  float bv = -INFINITY;
  int bi = 1 << 20;
#pragma unroll
  for (int mi = 0; mi < 4; ++mi)
#pragma unroll
    for (int r = 0; r < 4; ++r) {
      float v = gs[mi][ni][r];
      if (v > bv) { bv = v; bi = mi * 16 + g4 * 4 + r; }
    }
#pragma unroll
  for (int off = 16; off <= 32; off <<= 1) {
    float ov = shx(bv, off);
    int oi = shx(bi, off);
    if (ov > bv || (ov == bv && oi < bi)) { bv = ov; bi = oi; }
  }
#pragma unroll
  for (int mi = 0; mi < 4; ++mi)
#pragma unroll
    for (int r = 0; r < 4; ++r)
      if (mi * 16 + g4 * 4 + r == bi) gs[mi][ni][r] = -INFINITY;
  return (bv == -INFINITY) ? -1 : bi;
}
template <int NI>
DEV void moba_mfma_item(const Params& p, int item, char* smem, bf16* outbuf) {
  constexpr int QB = 64 * NI;
  bf16* sm = (bf16*)smem;
  const int bh = item & 15, cq = (S / QB - 1) - (item >> 4);
  const int b = bh >> 3, h = bh & 7;
  const int s0 = cq * QB, blk = s0 >> 8;
  const int lane = tidx() & 63, wave = tidx() >> 6, g4 = lane >> 4, c16 = lane & 15;
  const bf16* proj = (const bf16*)(p.ws + OFF_PROJ) + (size_t)b * S * PC;
  bf16x8 qf[NI][2];
  int tq[NI];
#pragma unroll
  for (int ni = 0; ni < NI; ++ni) {
    tq[ni] = s0 + wave * 16 * NI + ni * 16 + c16;
#pragma unroll
    for (int ks = 0; ks < 2; ++ks)
      qf[ni][ks] = *(const bf16x8*)(proj + (size_t)tq[ni] * PC + C_MQ + h * 64 + ks * 32 + g4 * 8);
  }
  int i0[NI], i1[NI], i2[NI];
  {
    const bf16* kmh = (const bf16*)(p.ws + OFF_KMHL) + ((size_t)(b * 8 + h) * 64) * 64;
    const bf16* kml = kmh + (size_t)2 * 8 * 64 * 64;
    f32x4 gs[4][NI];
#pragma unroll
    for (int mi = 0; mi < 4; ++mi) {
#pragma unroll
      for (int ni = 0; ni < NI; ++ni) gs[mi][ni] = f32x4{0.f, 0.f, 0.f, 0.f};
#pragma unroll
      for (int ks = 0; ks < 2; ++ks) {
        bf16x8 ah = *(const bf16x8*)(kmh + (mi * 16 + c16) * 64 + ks * 32 + g4 * 8);
        bf16x8 al_ = *(const bf16x8*)(kml + (mi * 16 + c16) * 64 + ks * 32 + g4 * 8);
#pragma unroll
        for (int ni = 0; ni < NI; ++ni) {
          gs[mi][ni] = MFMA16(ah, qf[ni][ks], gs[mi][ni]);
          gs[mi][ni] = MFMA16(al_, qf[ni][ks], gs[mi][ni]);
        }
      }
    }
#pragma unroll
    for (int ni = 0; ni < NI; ++ni) {
#pragma unroll
      for (int mi = 0; mi < 4; ++mi)
#pragma unroll
        for (int r = 0; r < 4; ++r)
          if (mi * 16 + g4 * 4 + r >= blk) gs[mi][ni][r] = -INFINITY;
      i0[ni] = gate_top1(gs, ni, g4);
      i1[ni] = gate_top1(gs, ni, g4);
      i2[ni] = gate_top1(gs, ni, g4);
    }
  }
  AttnSt<NI> st;
  attn_init<NI>(st);
  const int ntiles = (s0 + QB) >> 6;
  const bf16* kb = (const bf16*)(p.ws + OFF_MKB) + ((size_t)(b * 8 + h) * S) * 64;
  const bf16* vb = (const bf16*)(p.ws + OFF_MVB) + ((size_t)(b * 8 + h) * S) * 64;
  bf16* smkv = sm;
  __syncthreads();
#define MOBA_KEY(i) ((i) * 64)
  KV_SWEEP(kb, vb, 64, ntiles, MOBA_KEY,
    const int n = it >> 2;
    const bool own = (n == blk);
    const int kbase = it * 64;
    bool wave_active = own;
    if (!own) {
      bool anyq = false;
      _Pragma("unroll") for (int ni = 0; ni < NI; ++ni) anyq = anyq || (n == i0[ni]) || (n == i1[ni]) || (n == i2[ni]);
      wave_active = __builtin_amdgcn_ballot_w64(anyq) != 0ull;
    }
    if (wave_active) {
      f32x4 s[4][NI];
      attn_scores<NI>(Ks, qf, s);
      _Pragma("unroll") for (int ni = 0; ni < NI; ++ni) {
        if (own) {
          _Pragma("unroll") for (int mi = 0; mi < 4; ++mi)
            _Pragma("unroll") for (int r = 0; r < 4; ++r)
              if (kbase + mi * 16 + g4 * 4 + r > tq[ni]) s[mi][ni][r] = -INFINITY;
        } else {
          const bool okb = (n == i0[ni]) | (n == i1[ni]) | (n == i2[ni]);
          if (!okb) {
            _Pragma("unroll") for (int mi = 0; mi < 4; ++mi) s[mi][ni] = f32x4{-INFINITY, -INFINITY, -INFINITY, -INFINITY};
          }
        }
      }
      attn_softmax_pv<NI>(Ks + KT_ELEMS, s, st);
    }
  )
#pragma unroll
  for (int ni = 0; ni < NI; ++ni) {
    float l = st.l[ni];
    l += shx(l, 16);
    l += shx(l, 32);
    const float inv = 1.f / l;
    bf16* op = outbuf + ((size_t)b * S + tq[ni]) * 512 + h * 64 + g4 * 4;
#pragma unroll
    for (int di = 0; di < 4; ++di) {
      uint2 pk;
      pk.x = cvtpk(st.o[di][ni][0] * inv, st.o[di][ni][1] * inv);
      pk.y = cvtpk(st.o[di][ni][2] * inv, st.o[di][ni][3] * inv);
      *(uint2*)(op + di * 16) = pk;
    }
  }
}

DEV int moba_list_base(int n) { return n * S - 128 * n * (n + 1); }
template <int NI>
DEV void moba_gate_item(const Params& p, int item) {
  constexpr int QB = 64 * NI;
  const int bh = item & 15, cq = item >> 4;
  const int b = bh >> 3, h = bh & 7;
  const int s0 = cq * QB, blk = s0 >> 8;
  if (blk == 0) return;
  const int lane = tidx() & 63, wave = tidx() >> 6, g4 = lane >> 4, c16 = lane & 15;
  const bf16* proj = (const bf16*)(p.ws + OFF_PROJ) + (size_t)b * S * PC;
  bf16x8 qf[NI][2];
  int tq[NI];
#pragma unroll
  for (int ni = 0; ni < NI; ++ni) {
    tq[ni] = s0 + wave * 16 * NI + ni * 16 + c16;
#pragma unroll
    for (int ks = 0; ks < 2; ++ks)
      qf[ni][ks] = *(const bf16x8*)(proj + (size_t)tq[ni] * PC + C_MQ + h * 64 + ks * 32 + g4 * 8);
  }
  const bf16* kmh = (const bf16*)(p.ws + OFF_KMHL) + ((size_t)(b * 8 + h) * 64) * 64;
  const bf16* kml = kmh + (size_t)2 * 8 * 64 * 64;
  f32x4 gs[4][NI];
#pragma unroll
  for (int mi = 0; mi < 4; ++mi) {
#pragma unroll
    for (int ni = 0; ni < NI; ++ni) gs[mi][ni] = f32x4{0.f, 0.f, 0.f, 0.f};
#pragma unroll
    for (int ks = 0; ks < 2; ++ks) {
      bf16x8 ah = *(const bf16x8*)(kmh + (mi * 16 + c16) * 64 + ks * 32 + g4 * 8);
      bf16x8 al_ = *(const bf16x8*)(kml + (mi * 16 + c16) * 64 + ks * 32 + g4 * 8);
#pragma unroll
      for (int ni = 0; ni < NI; ++ni) {
        gs[mi][ni] = MFMA16(ah, qf[ni][ks], gs[mi][ni]);
        gs[mi][ni] = MFMA16(al_, qf[ni][ks], gs[mi][ni]);
      }
    }
  }
  unsigned short* lists = (unsigned short*)(p.ws + OFF_MLIST) + (size_t)(b * 8 + h) * MLIST_PER_BH;
  int* cnt = (int*)(p.ws + OFF_MCNT) + (b * 8 + h) * 64;
#pragma unroll
  for (int ni = 0; ni < NI; ++ni) {
#pragma unroll
    for (int mi = 0; mi < 4; ++mi)
#pragma unroll
      for (int r = 0; r < 4; ++r)
        if (mi * 16 + g4 * 4 + r >= blk) gs[mi][ni][r] = -INFINITY;
    const int s0i = gate_top1(gs, ni, g4);
    const int s1i = gate_top1(gs, ni, g4);
    const int s2i = gate_top1(gs, ni, g4);
    if (g4 == 0) {
      if (s0i >= 0) { const int pos = atomicAdd(cnt + s0i, 1); lists[moba_list_base(s0i) + pos] = (unsigned short)(tq[ni] | (0 << 14)); }
      if (s1i >= 0) { const int pos = atomicAdd(cnt + s1i, 1); lists[moba_list_base(s1i) + pos] = (unsigned short)(tq[ni] | (1 << 14)); }
      if (s2i >= 0) { const int pos = atomicAdd(cnt + s2i, 1); lists[moba_list_base(s2i) + pos] = (unsigned short)(tq[ni] | (2 << 14)); }
    }
  }
}
template <int NI>
DEV void moba_part_item(const Params& p, int b, int item, char* smem) {
  constexpr int CH = 64 * NI;
  bf16* smkv = (bf16*)smem;
  const int n = item >> 6, h = (item >> 3) & 7, part = item & 7;
  const int lane = tidx() & 63, wave = tidx() >> 6, g4 = lane >> 4, c16 = lane & 15;
  const int cnt = ((const int*)(p.ws + OFF_MCNT))[(b * 8 + h) * 64 + n];
  const unsigned short* list = (const unsigned short*)(p.ws + OFF_MLIST) + (size_t)(b * 8 + h) * MLIST_PER_BH + moba_list_base(n);
  const bf16* proj = (const bf16*)(p.ws + OFF_PROJ) + (size_t)b * S * PC;
  const bf16* kb = (const bf16*)(p.ws + OFF_MKB) + ((size_t)(b * 8 + h) * S + n * 256) * 64;
  const bf16* vb = (const bf16*)(p.ws + OFF_MVB) + ((size_t)(b * 8 + h) * S + n * 256) * 64;
  bf16* po = (bf16*)(p.ws + OFF_MPO);
  float2* pml = (float2*)(p.ws + OFF_MPML);
  for (int c = part; c * CH < cnt; c += 8) {
    bf16x8 qf[NI][2];
    int tcol[NI], slot[NI];
    bool valid[NI];
#pragma unroll
    for (int ni = 0; ni < NI; ++ni) {
      const int idx = c * CH + wave * 16 * NI + ni * 16 + c16;
      valid[ni] = idx < cnt;
      const unsigned e = list[valid[ni] ? idx : 0];
      tcol[ni] = e & 0x3FFF;
      slot[ni] = e >> 14;
#pragma unroll
      for (int ks = 0; ks < 2; ++ks)
        qf[ni][ks] = *(const bf16x8*)(proj + (size_t)tcol[ni] * PC + C_MQ + h * 64 + ks * 32 + g4 * 8);
    }
    AttnSt<NI> st;
    attn_init<NI>(st);
    __syncthreads();
#define MOBA_PKEY(i) ((i) * 64)
    KV_SWEEP(kb, vb, 64, 4, MOBA_PKEY,
      f32x4 s[4][NI];
      attn_scores<NI>(Ks, qf, s);
      attn_softmax_pv<NI>(Ks + KT_ELEMS, s, st);
    )
#pragma unroll
    for (int ni = 0; ni < NI; ++ni) {
      float l = st.l[ni];
      l += shx(l, 16);
      l += shx(l, 32);
      if (valid[ni]) {
        const size_t rec = ((size_t)h * S + tcol[ni]) * 3 + slot[ni];
        if (g4 == 0) pml[rec] = float2{st.m[ni], l};
        bf16* op = po + rec * 64 + g4 * 4;
#pragma unroll
        for (int di = 0; di < 4; ++di) {
          uint2 pk;
          pk.x = cvtpk(st.o[di][ni][0], st.o[di][ni][1]);
          pk.y = cvtpk(st.o[di][ni][2], st.o[di][ni][3]);
          *(uint2*)(op + di * 16) = pk;
        }
      }
    }
  }
}
template <int NI>
DEV void moba_merge_item(const Params& p, int b, int item, char* smem, bf16* outbuf) {
  constexpr int QB = 64 * NI;
  constexpr int NCQ = S / QB;
  bf16* smkv = (bf16*)smem;
  const int h = item / NCQ, cq = item % NCQ;
  const int s0 = cq * QB, blk = s0 >> 8;
  const int lane = tidx() & 63, wave = tidx() >> 6, g4 = lane >> 4, c16 = lane & 15;
  const bf16* proj = (const bf16*)(p.ws + OFF_PROJ) + (size_t)b * S * PC;
  bf16x8 qf[NI][2];
  int tq[NI];
#pragma unroll
  for (int ni = 0; ni < NI; ++ni) {
    tq[ni] = s0 + wave * 16 * NI + ni * 16 + c16;
#pragma unroll
    for (int ks = 0; ks < 2; ++ks)
      qf[ni][ks] = *(const bf16x8*)(proj + (size_t)tq[ni] * PC + C_MQ + h * 64 + ks * 32 + g4 * 8);
  }
  const bf16* kb = (const bf16*)(p.ws + OFF_MKB) + ((size_t)(b * 8 + h) * S) * 64;
  const bf16* vb = (const bf16*)(p.ws + OFF_MVB) + ((size_t)(b * 8 + h) * S) * 64;
  AttnSt<NI> st;
  attn_init<NI>(st);
  const int kt0 = blk * 4;
  const int ntl = ((s0 + QB - 1) >> 6) - kt0 + 1;
  __syncthreads();
#define MOBA_MKEY(i) ((kt0 + (i)) * 64)
  KV_SWEEP(kb, vb, 64, ntl, MOBA_MKEY,
    const int kbase = (kt0 + it) * 64;
    f32x4 s[4][NI];
    attn_scores<NI>(Ks, qf, s);
    _Pragma("unroll") for (int ni = 0; ni < NI; ++ni)
      _Pragma("unroll") for (int mi = 0; mi < 4; ++mi)
        _Pragma("unroll") for (int r = 0; r < 4; ++r)
          if (kbase + mi * 16 + g4 * 4 + r > tq[ni]) s[mi][ni][r] = -INFINITY;
    attn_softmax_pv<NI>(Ks + KT_ELEMS, s, st);
  )
  const int nsl = (blk < 3) ? blk : 3;
  const bf16* po = (const bf16*)(p.ws + OFF_MPO);
  const float2* pml = (const float2*)(p.ws + OFF_MPML);
#pragma unroll
  for (int ni = 0; ni < NI; ++ni) {
    float l = st.l[ni];
    l += shx(l, 16);
    l += shx(l, 32);
    const size_t rec0 = ((size_t)h * S + tq[ni]) * 3;
    float ms[3], ls[3];
    float M = st.m[ni];
#pragma unroll
    for (int s = 0; s < 3; ++s) {
      ms[s] = -INFINITY;
      ls[s] = 0.f;
      if (s < nsl) {
        const float2 v = pml[rec0 + s];
        ms[s] = v.x;
        ls[s] = v.y;
        M = fmaxf(M, v.x);
      }
    }
    const float fo = __builtin_amdgcn_exp2f((st.m[ni] - M) * C2);
    l *= fo;
    float f[3];
#pragma unroll
    for (int s = 0; s < 3; ++s) {
      f[s] = (s < nsl) ? __builtin_amdgcn_exp2f((ms[s] - M) * C2) : 0.f;
      l += ls[s] * f[s];
    }
    const float inv = 1.f / l;
    bf16* op = outbuf + ((size_t)b * S + tq[ni]) * 512 + h * 64 + g4 * 4;
#pragma unroll
    for (int di = 0; di < 4; ++di) {
      float o0 = st.o[di][ni][0] * fo, o1 = st.o[di][ni][1] * fo, o2 = st.o[di][ni][2] * fo, o3 = st.o[di][ni][3] * fo;
#pragma unroll
      for (int s = 0; s < 3; ++s) {
        if (s < nsl) {
          const uint2 pv = *(const uint2*)(po + (rec0 + s) * 64 + di * 16 + g4 * 4);
          o0 += f[s] * __uint_as_float(pv.x << 16);
          o1 += f[s] * __uint_as_float(pv.x & 0xffff0000u);
          o2 += f[s] * __uint_as_float(pv.y << 16);
          o3 += f[s] * __uint_as_float(pv.y & 0xffff0000u);
        }
      }
      uint2 pk;
      pk.x = cvtpk(o0 * inv, o1 * inv);
      pk.y = cvtpk(o2 * inv, o3 * inv);
      *(uint2*)(op + di * 16) = pk;
    }
  }
}

template <int NI>
DEV void attn_stats(f32x4 (&s)[4][NI], float (&m)[NI], float (&l)[NI]) {
#pragma unroll
  for (int ni = 0; ni < NI; ++ni) {
    float mx = -INFINITY;
#pragma unroll
    for (int mi = 0; mi < 4; ++mi)
      mx = fmaxf(fmaxf(mx, fmaxf(s[mi][ni][0], s[mi][ni][1])), fmaxf(s[mi][ni][2], s[mi][ni][3]));
    mx = fmaxf(mx, shx(mx, 16));
    mx = fmaxf(mx, shx(mx, 32));
    const float mn = fmaxf(m[ni], mx);
    const float mu = (mn == -INFINITY) ? 0.f : mn;
    const float corr = __builtin_amdgcn_exp2f((m[ni] - mu) * C2);
    m[ni] = mn;
    const float nm = -mu * C2;
    float ps = 0.f;
#pragma unroll
    for (int mi = 0; mi < 4; ++mi)
#pragma unroll
      for (int r = 0; r < 4; ++r) ps += __builtin_amdgcn_exp2f(__builtin_fmaf(s[mi][ni][r], C2, nm));
    l[ni] = l[ni] * corr + ps;
  }
}
DEV bf16x8 rope_frag(bf16x8 qv, const float* __restrict__ rope_t, int g4) {
  u32x4_t w = __builtin_bit_cast(u32x4_t, qv);
  u32x4_t pw;
  pw.x = shx(w.x, 16); pw.y = shx(w.y, 16); pw.z = shx(w.z, 16); pw.w = shx(w.w, 16);
  float f[8], pf[8];
  unpack8(uint4{w.x, w.y, w.z, w.w}, f);
  unpack8(uint4{pw.x, pw.y, pw.z, pw.w}, pf);
  const float4 c0 = *(const float4*)(rope_t), c1 = *(const float4*)(rope_t + 4);
  const float4 s0 = *(const float4*)(rope_t + 8), s1 = *(const float4*)(rope_t + 12);
  const float cs[8] = {c0.x, c0.y, c0.z, c0.w, c1.x, c1.y, c1.z, c1.w};
  const float sn[8] = {s0.x, s0.y, s0.z, s0.w, s1.x, s1.y, s1.z, s1.w};
  const float sg = (g4 == 0) ? -1.f : 1.f;
  float o[8];
#pragma unroll
  for (int i = 0; i < 8; ++i) o[i] = (g4 < 2) ? (f[i] * cs[i] + sg * pf[i] * sn[i]) : f[i];
  u32x4_t r;
  r.x = cvtpk(o[0], o[1]); r.y = cvtpk(o[2], o[3]); r.z = cvtpk(o[4], o[5]); r.w = cvtpk(o[6], o[7]);
  return __builtin_bit_cast(bf16x8, r);
}

template <int NI>
DEV void nsa_item(const Params& p, int item, char* smem, bf16* outbuf) {
  constexpr int QN = 16 * NI;
  constexpr int NCH = S / QN;
  bf16* smkv = (bf16*)smem;
  float* imp = (float*)(smem + 36864);
  int* sel = (int*)(smem + 36864 + QN * 257 * 4);
  unsigned* bmq = (unsigned*)(sel + QN * 16);
  unsigned* bmu = bmq + QN * 8;
  int* ulist = (int*)(bmu + 4 * NI * 8);
  static_assert(36864 + QN * 257 * 4 + QN * 16 * 4 + QN * 8 * 4 + 4 * NI * 8 * 4 + 257 * 4 <= SMEM_BYTES, "nsa lds");
  static_assert(NI == 2, "per-wave union bitmaps use bmu[8 .. 40)");
  const int tid = tidx(), lane = tid & 63, wave = tid >> 6, g4 = lane >> 4, c16 = lane & 15;
  const int bk = item & 3, cq = (NCH - 1) - (item >> 2);
  const int b = bk >> 1, kvh = bk & 1;
  const int s0 = cq * QN, cur = s0 >> 6;
  if (PROBE_NSA && b == 1) return;
  const bf16* proj = (const bf16*)(p.ws + OFF_PROJ) + (size_t)b * S * PC;
  const float* rope = (const float*)(p.ws + OFF_ROPE);
  int tq[NI], qlv[NI];
  float gate0[NI], gate1[NI], gate2[NI];
  bf16x8 qraw[NI][2], qrot[NI][2];
#pragma unroll
  for (int ni = 0; ni < NI; ++ni) {
    const int R = wave * 16 * NI + ni * 16 + c16;
    qlv[ni] = R >> 2;
    const int g = R & 3;
    tq[ni] = s0 + qlv[ni];
    const bf16* qp = proj + (size_t)tq[ni] * PC + C_NQ + (kvh * 4 + g) * 64 + g4 * 8;
    qraw[ni][0] = *(const bf16x8*)(qp);
    qraw[ni][1] = *(const bf16x8*)(qp + 32);
    qrot[ni][0] = rope_frag(qraw[ni][0], rope + (size_t)tq[ni] * 16, g4);
    qrot[ni][1] = qraw[ni][1];
    const bf16* gp = proj + (size_t)tq[ni] * PC + C_NG + (kvh * 4 + g) * 3;
    gate0[ni] = (!PROBE_NSA || (PROBE_NSA & 1)) ? sigmoidf_(bf2f(gp[0])) : 0.f;
    gate1[ni] = (!PROBE_NSA || (PROBE_NSA & 2)) ? sigmoidf_(bf2f(gp[1])) : 0.f;
    gate2[ni] = (!PROBE_NSA || (PROBE_NSA & 4)) ? sigmoidf_(bf2f(gp[2])) : 0.f;
  }
  for (int i = tid; i < QN * 257; i += 256) imp[i] = 0.f;
  for (int i = tid; i < QN * 8 + 4 * NI * 8; i += 256) bmq[i] = 0u;
  f32x4 acc[4][NI];
#pragma unroll
  for (int ni = 0; ni < NI; ++ni)
#pragma unroll
    for (int di = 0; di < 4; ++di) acc[di][ni] = f32x4{0.f, 0.f, 0.f, 0.f};
  TILE_DECL;
  {
    int nv[NI];
#pragma unroll
    for (int ni = 0; ni < NI; ++ni) nv[ni] = (tq[ni] >= 31) ? (((tq[ni] - 31) >> 4) + 1) : 0;
    const int tlast = s0 + QN - 1;
    const int nvmax = (tlast >= 31) ? (((tlast - 31) >> 4) + 1) : 0;
    const int ntc = (nvmax + 63) >> 6;
    const bf16* kb = (const bf16*)(p.ws + OFF_KCB) + ((size_t)(b * 2 + kvh) * 1024) * 64;
    const bf16* vb = (const bf16*)(p.ws + OFF_VCB) + ((size_t)(b * 2 + kvh) * 1024) * 64;
    float mA[NI], lA[NI];
#pragma unroll
    for (int ni = 0; ni < NI; ++ni) { mA[ni] = -INFINITY; lA[ni] = 0.f; }
    __syncthreads();
    if (ntc > 0) {
      for (int rep_ = 0; rep_ < ((REP_NSA_PART & 1) ? 2 : 1); ++rep_) {
#pragma unroll
      for (int ni = 0; ni < NI; ++ni) { mA[ni] = -INFINITY; lA[ni] = 0.f; }
      TILE_GLOAD(kb, vb, 64, 0);
      TILE_SSTORE(smkv, smkv + KT_ELEMS);
      __syncthreads();
      for (int kt = 0; kt < ntc; ++kt) {
        if (kt + 1 < ntc) TILE_GLOAD(kb, vb, 64, (kt + 1) * 64);
        const bf16* Ks = smkv + (kt & 1) * 2 * KT_ELEMS;
        f32x4 s[4][NI];
        attn_scores<NI>(Ks, qraw, s);
#pragma unroll
        for (int ni = 0; ni < NI; ++ni)
#pragma unroll
          for (int mi = 0; mi < 4; ++mi)
#pragma unroll
            for (int r = 0; r < 4; ++r)
              if (kt * 64 + mi * 16 + g4 * 4 + r >= nv[ni]) s[mi][ni][r] = -INFINITY;
        attn_stats<NI>(s, mA, lA);
        if (kt + 1 < ntc) {
          bf16* Kn = smkv + ((kt + 1) & 1) * 2 * KT_ELEMS;
          TILE_SSTORE(Kn, Kn + KT_ELEMS);
        }
        __syncthreads();
      }
      }
      float nmB[NI];
#pragma unroll
      for (int ni = 0; ni < NI; ++ni) {
        float l = lA[ni];
        l += shx(l, 16);
        l += shx(l, 32);
        nmB[ni] = (l > 0.f) ? -(mA[ni] * C2 + __builtin_amdgcn_logf(l)) : 0.f;
      }
      TILE_GLOAD(kb, vb, 64, 0);
      TILE_SSTORE(smkv, smkv + KT_ELEMS);
      __syncthreads();
      for (int kt = 0; kt < ntc; ++kt) {
        if (kt + 1 < ntc) TILE_GLOAD(kb, vb, 64, (kt + 1) * 64);
        const bf16* Ks = smkv + (kt & 1) * 2 * KT_ELEMS;
        f32x4 s[4][NI];
        attn_scores<NI>(Ks, qraw, s);
        bf16x8 pf[NI][2];
#pragma unroll
        for (int ni = 0; ni < NI; ++ni) {
          u32x4_t wa, wb;
          float* irow = imp + qlv[ni] * 257 + kt * 16 + g4;
#pragma unroll
          for (int mi = 0; mi < 4; ++mi) {
            float pr[4];
#pragma unroll
            for (int r = 0; r < 4; ++r) {
              const bool ok = (kt * 64 + mi * 16 + g4 * 4 + r) < nv[ni];
              pr[r] = ok ? __builtin_amdgcn_exp2f(__builtin_fmaf(s[mi][ni][r], C2, nmB[ni])) : 0.f;
            }
            float mainv = pr[0] + pr[1] + pr[2] + 0.5f * pr[3];
            float spv = 0.5f * pr[3];
            mainv += shx(mainv, 1);
            mainv += shx(mainv, 2);
            spv += shx(spv, 1);
            spv += shx(spv, 2);
            if ((c16 & 3) == 0) {
              atomicAdd(irow + mi * 4, mainv);
              atomicAdd(irow + mi * 4 + 1, spv);
            }
            const unsigned w0 = cvtpk(pr[0], pr[1]), w1 = cvtpk(pr[2], pr[3]);
            if (mi == 0) { wa.x = w0; wa.y = w1; }
            if (mi == 1) { wa.z = w0; wa.w = w1; }
            if (mi == 2) { wb.x = w0; wb.y = w1; }
            if (mi == 3) { wb.z = w0; wb.w = w1; }
          }
          pf[ni][0] = __builtin_bit_cast(bf16x8, wa);
          pf[ni][1] = __builtin_bit_cast(bf16x8, wb);
        }
        attn_pv<NI>(Ks + KT_ELEMS, pf, acc);
        if (kt + 1 < ntc) {
          bf16* Kn = smkv + ((kt + 1) & 1) * 2 * KT_ELEMS;
          TILE_SSTORE(Kn, Kn + KT_ELEMS);
        }
        __syncthreads();
      }
    }
#pragma unroll
    for (int ni = 0; ni < NI; ++ni)
#pragma unroll
      for (int di = 0; di < 4; ++di) {
        acc[di][ni][0] *= gate0[ni]; acc[di][ni][1] *= gate0[ni]; acc[di][ni][2] *= gate0[ni]; acc[di][ni][3] *= gate0[ni];
      }
  }
  __syncthreads();
#if PROBE_NSA == 8
  if (b == 0 && kvh == 0)
    for (int i = tid; i < QN * 256; i += 256)
      ((float*)(p.ws + OFF_OMOBA))[(size_t)S * 256 + (size_t)(s0 + (i >> 8)) * 256 + (i & 255)] = imp[(i >> 8) * 257 + (i & 255)];
  __syncthreads();
#endif
  for (int qq = 0; qq < 4 * NI; ++qq) {
    const int ql = wave * 4 * NI + qq;
    int mysel = -1;
    if (cur < 16) {
      mysel = (lane <= cur) ? lane : -1;
    } else {
      const float* row = imp + ql * 257;
      float v0 = row[lane], v1 = row[64 + lane], v2 = row[128 + lane], v3 = row[192 + lane];
      if (lane < 1 || lane > cur - 2) v0 = -1.f;
      if (64 + lane > cur - 2) v1 = -1.f;
      if (128 + lane > cur - 2) v2 = -1.f;
      if (192 + lane > cur - 2) v3 = -1.f;
      if (lane == 0) mysel = 0;
      if (lane == 1) mysel = cur - 1;
      if (lane == 2) mysel = cur;
      for (int rd = 3; rd < 16; ++rd) {
        float bv = v0;
        int bi = lane;
        if (v1 > bv) { bv = v1; bi = 64 + lane; }
        if (v2 > bv) { bv = v2; bi = 128 + lane; }
        if (v3 > bv) { bv = v3; bi = 192 + lane; }
#pragma unroll
        for (int off = 32; off >= 1; off >>= 1) {
          float ov = shx(bv, off);
          int oi = shx(bi, off);
          if (ov > bv || (ov == bv && oi < bi)) { bv = ov; bi = oi; }
        }
        if (lane == rd) mysel = bi;
        if ((bi & 63) == lane) {
          const int k = bi >> 6;
          if (k == 0) v0 = -2.f; else if (k == 1) v1 = -2.f; else if (k == 2) v2 = -2.f; else v3 = -2.f;
        }
      }
    }
#if PROBE_NSA == 2
    mysel = (lane < 16) ? ((const int*)(p.ws + OFF_SEL))[(((size_t)b * 2 + kvh) * S + s0 + ql) * 16 + lane] : -1;
#endif
#if PROBE_NSA == 8
    if (lane < 16 && b == 0 && kvh == 0) ((int*)(p.ws + OFF_CMP))[(size_t)(s0 + ql) * 16 + lane] = mysel;
#endif
    if (lane < 16) {
      sel[ql * 16 + lane] = mysel;
      if (mysel >= 0) {
        atomicOr(&bmq[ql * 8 + (mysel >> 5)], 1u << (mysel & 31));
        atomicOr(&bmu[mysel >> 5], 1u << (mysel & 31));
        atomicOr(&bmu[8 + wave * 8 + (mysel >> 5)], 1u << (mysel & 31));
      }
    }
  }
  __syncthreads();
  {
    const int n = tid;
    const unsigned wv = bmu[n >> 5];
    if ((wv >> (n & 31)) & 1u) {
      int pos = __builtin_popcount(wv & ((1u << (n & 31)) - 1u));
      for (int w = 0; w < (n >> 5); ++w) pos += __builtin_popcount(bmu[w]);
      ulist[pos] = n;
    }
    if (tid == 0) {
      int c = 0;
      for (int w = 0; w < 8; ++w) c += __builtin_popcount(bmu[w]);
      ulist[256] = c;
    }
  }
  __syncthreads();
  {
    AttnSt<NI> st;
    attn_init<NI>(st);
    const int klo = (s0 - 511 > 0) ? (s0 - 511) : 0;
    const int kt0 = klo >> 6, kt1 = (s0 + QN - 1) >> 6;
    const bf16* kb = (const bf16*)(p.ws + OFF_KWB) + ((size_t)(b * 2 + kvh) * S) * 64;
    const bf16* vb = (const bf16*)(p.ws + OFF_VWB) + ((size_t)(b * 2 + kvh) * S) * 64;
    for (int rep_ = 0; rep_ < ((REP_NSA_PART & 2) ? 2 : 1); ++rep_) {
    attn_init<NI>(st);
    TILE_GLOAD(kb, vb, 64, kt0 * 64);
    TILE_SSTORE(smkv, smkv + KT_ELEMS);
    __syncthreads();
    for (int kt = kt0; kt <= kt1; ++kt) {
      if (kt + 1 <= kt1) TILE_GLOAD(kb, vb, 64, (kt + 1) * 64);
      const bf16* Ks = smkv + ((kt - kt0) & 1) * 2 * KT_ELEMS;
      f32x4 s[4][NI];
      attn_scores<NI>(Ks, qrot, s);
#pragma unroll
      for (int ni = 0; ni < NI; ++ni)
#pragma unroll
        for (int mi = 0; mi < 4; ++mi)
#pragma unroll
          for (int r = 0; r < 4; ++r) {
            const int key = kt * 64 + mi * 16 + g4 * 4 + r;
            if (key > tq[ni] || key <= tq[ni] - 512) s[mi][ni][r] = -INFINITY;
          }
      attn_softmax_pv<NI>(Ks + KT_ELEMS, s, st);
      if (kt + 1 <= kt1) {
        bf16* Kn = smkv + ((kt + 1 - kt0) & 1) * 2 * KT_ELEMS;
        TILE_SSTORE(Kn, Kn + KT_ELEMS);
      }
      __syncthreads();
    }
    }
#pragma unroll
    for (int ni = 0; ni < NI; ++ni) {
      float l = st.l[ni];
      l += shx(l, 16);
      l += shx(l, 32);
      const float sc = gate2[ni] / l;
#pragma unroll
      for (int di = 0; di < 4; ++di) {
        acc[di][ni][0] += sc * st.o[di][ni][0]; acc[di][ni][1] += sc * st.o[di][ni][1];
        acc[di][ni][2] += sc * st.o[di][ni][2]; acc[di][ni][3] += sc * st.o[di][ni][3];
      }
    }
  }
  {
    float* accs = imp + tid;
#pragma unroll
    for (int ni = 0; ni < NI; ++ni)
#pragma unroll
      for (int di = 0; di < 4; ++di)
#pragma unroll
        for (int r = 0; r < 4; ++r) accs[((ni * 4 + di) * 4 + r) * 256] = acc[di][ni][r];
    AttnSt<NI> st;
    attn_init<NI>(st);
    const bf16* kb = (const bf16*)(p.ws + OFF_KSB) + ((size_t)(b * 2 + kvh) * S) * 64;
    const bf16* vb = (const bf16*)(p.ws + OFF_VSB) + ((size_t)(b * 2 + kvh) * S) * 64;
#ifndef NSA_SEL_WAVE
#define NSA_SEL_WAVE 1
#endif
#if NSA_SEL_WAVE
    {
      int* wl = ulist;
      const unsigned* bw = bmu + 8 + wave * 8;
      unsigned short* wl16 = (unsigned short*)wl + wave * 128;
      int nuw = 0;
#pragma unroll
      for (int j = 0; j < 4; ++j) {
        const int nblk = j * 64 + lane;
        const bool setb = (bw[nblk >> 5] >> (nblk & 31)) & 1u;
        const unsigned long long mk = __builtin_amdgcn_ballot_w64(setb);
        if (setb) wl16[nuw + __builtin_popcountll(mk & ((1ull << lane) - 1ull))] = (unsigned short)nblk;
        nuw += __builtin_popcountll(mk);
      }
      __builtin_amdgcn_fence(__ATOMIC_RELEASE, "workgroup");
      __builtin_amdgcn_wave_barrier();
      bf16* Vw = smkv + wave * KT_ELEMS;
      bf16x8 kr00, kr01, kr10, kr11, kr20, kr21, kr30, kr31;
      uint4 vr0, vr1, vr2, vr3, vr4, vr5, vr6, vr7;
#define NSW_LOADK(nb_)                                                                                  \
      {                                                                                                 \
        const bf16* kp_ = kb + (size_t)((nb_) * 64 + c16) * 64 + g4 * 8;                                \
        kr00 = *(const bf16x8*)(kp_);             kr01 = *(const bf16x8*)(kp_ + 32);                    \
        kr10 = *(const bf16x8*)(kp_ + 16 * 64);   kr11 = *(const bf16x8*)(kp_ + 16 * 64 + 32);          \
        kr20 = *(const bf16x8*)(kp_ + 32 * 64);   kr21 = *(const bf16x8*)(kp_ + 32 * 64 + 32);          \
        kr30 = *(const bf16x8*)(kp_ + 48 * 64);   kr31 = *(const bf16x8*)(kp_ + 48 * 64 + 32);          \
      }
#define NSW_LOADV(nb_)                                                                                  \
      {                                                                                                 \
        const bf16* vp_ = vb + (size_t)(nb_) * 64 * 64 + lane * 8;                                      \
        vr0 = *(const uint4*)(vp_);        vr1 = *(const uint4*)(vp_ + 512);  vr2 = *(const uint4*)(vp_ + 1024); \
        vr3 = *(const uint4*)(vp_ + 1536); vr4 = *(const uint4*)(vp_ + 2048); vr5 = *(const uint4*)(vp_ + 2560); \
        vr6 = *(const uint4*)(vp_ + 3072); vr7 = *(const uint4*)(vp_ + 3584);                           \
      }
      for (int rep_ = 0; rep_ < ((REP_NSA_PART & 4) ? 2 : 1); ++rep_) {
      attn_init<NI>(st);
      if (nuw > 0) { NSW_LOADK((int)wl16[0]) NSW_LOADV((int)wl16[0]) }
      for (int iu = 0; iu < nuw; ++iu) {
        const int n = wl16[iu];
        {
          bf16* vd = Vw + (lane >> 3) * KT_LD + (lane & 7) * 8;
          *(uint4*)(vd) = vr0;               *(uint4*)(vd + 8 * KT_LD) = vr1;  *(uint4*)(vd + 16 * KT_LD) = vr2;
          *(uint4*)(vd + 24 * KT_LD) = vr3;  *(uint4*)(vd + 32 * KT_LD) = vr4; *(uint4*)(vd + 40 * KT_LD) = vr5;
          *(uint4*)(vd + 48 * KT_LD) = vr6;  *(uint4*)(vd + 56 * KT_LD) = vr7;
        }
        if (iu + 1 < nuw) NSW_LOADV((int)wl16[iu + 1])
        f32x4 s[4][NI];
        bool qsel[NI], act[NI];
#pragma unroll
        for (int ni = 0; ni < NI; ++ni) {
          qsel[ni] = (bmq[qlv[ni] * 8 + (n >> 5)] >> (n & 31)) & 1u;
          act[ni] = __builtin_amdgcn_ballot_w64(qsel[ni]) != 0ull;
        }
#pragma unroll
        for (int ni = 0; ni < NI; ++ni) {
          if (!act[ni]) continue;
          s[0][ni] = MFMA16(kr00, qrot[ni][0], (f32x4{0.f, 0.f, 0.f, 0.f}));
          s[0][ni] = MFMA16(kr01, qrot[ni][1], s[0][ni]);
          s[1][ni] = MFMA16(kr10, qrot[ni][0], (f32x4{0.f, 0.f, 0.f, 0.f}));
          s[1][ni] = MFMA16(kr11, qrot[ni][1], s[1][ni]);
          s[2][ni] = MFMA16(kr20, qrot[ni][0], (f32x4{0.f, 0.f, 0.f, 0.f}));
          s[2][ni] = MFMA16(kr21, qrot[ni][1], s[2][ni]);
          s[3][ni] = MFMA16(kr30, qrot[ni][0], (f32x4{0.f, 0.f, 0.f, 0.f}));
          s[3][ni] = MFMA16(kr31, qrot[ni][1], s[3][ni]);
        }
        if (iu + 1 < nuw) NSW_LOADK((int)wl16[iu + 1])
        asm volatile("" ::: "memory");
        __builtin_amdgcn_wave_barrier();
#pragma unroll
        for (int ni = 0; ni < NI; ++ni) {
          if (!act[ni]) continue;
          if (n == cur) {
#pragma unroll
            for (int mi = 0; mi < 4; ++mi)
#pragma unroll
              for (int r = 0; r < 4; ++r) {
                const int key = n * 64 + mi * 16 + g4 * 4 + r;
                if (!qsel[ni] || key > tq[ni]) s[mi][ni][r] = -INFINITY;
              }
          } else if (!qsel[ni]) {
#pragma unroll
            for (int mi = 0; mi < 4; ++mi) s[mi][ni] = f32x4{-INFINITY, -INFINITY, -INFINITY, -INFINITY};
          }
        }
        attn_softmax_pv_act<NI>(Vw, s, st, act);
        asm volatile("" ::: "memory");
        __builtin_amdgcn_wave_barrier();
      }
      }
    }
#else
    const int nu = ulist[256];
#define NSA_SKEY(i) (ulist[(i)] * 64)
    for (int rep_ = 0; rep_ < ((REP_NSA_PART & 4) ? 2 : 1); ++rep_) {
    attn_init<NI>(st);
    KV_SWEEP(kb, vb, 64, nu, NSA_SKEY,
      const int n = ulist[it];
      bool qs[NI];
      bool anyq = false;
      _Pragma("unroll") for (int ni = 0; ni < NI; ++ni) {
        qs[ni] = (bmq[qlv[ni] * 8 + (n >> 5)] >> (n & 31)) & 1u;
        anyq = anyq || qs[ni];
      }
      if (__builtin_amdgcn_ballot_w64(anyq) != 0ull) {
        f32x4 s[4][NI];
        attn_scores<NI>(Ks, qrot, s);
        _Pragma("unroll") for (int ni = 0; ni < NI; ++ni)
          _Pragma("unroll") for (int mi = 0; mi < 4; ++mi)
            _Pragma("unroll") for (int r = 0; r < 4; ++r) {
              const int key = n * 64 + mi * 16 + g4 * 4 + r;
              if (!qs[ni] || key > tq[ni]) s[mi][ni][r] = -INFINITY;
            }
        attn_softmax_pv<NI>(Ks + KT_ELEMS, s, st);
      }
    )
    }
#endif
#pragma unroll
    for (int ni = 0; ni < NI; ++ni) {
      float l = st.l[ni];
      l += shx(l, 16);
      l += shx(l, 32);
      const float sc = gate1[ni] / l;
#pragma unroll
      for (int di = 0; di < 4; ++di)
#pragma unroll
        for (int r = 0; r < 4; ++r) acc[di][ni][r] = accs[((ni * 4 + di) * 4 + r) * 256] + sc * st.o[di][ni][r];
    }
  }
#pragma unroll
  for (int ni = 0; ni < NI; ++ni) {
    const int g = (wave * 16 * NI + ni * 16 + c16) & 3;
    bf16* op = outbuf + ((size_t)b * S + tq[ni]) * 512 + (kvh * 4 + g) * 64 + g4 * 4;
#pragma unroll
    for (int di = 0; di < 4; ++di) {
      uint2 pk;
      pk.x = cvtpk(acc[di][ni][0], acc[di][ni][1]);
      pk.y = cvtpk(acc[di][ni][2], acc[di][ni][3]);
      *(uint2*)(op + di * 16) = pk;
    }
  }
  __syncthreads();
}

DEV void probe_accum_bf16(const Params& p, const bf16* a, const bf16* ref, size_t n, float* sm) {
  float sd = 0.f, sr = 0.f;
  for (size_t i = (size_t)blockIdx.x * 256 + tidx(); i < n; i += (size_t)gridDim.x * 256) {
    float x = bf2f(a[i]), y = bf2f(ref[i]);
    sd += (x - y) * (x - y);
    sr += y * y;
  }
  sd = wave_sum(sd);
  sr = wave_sum(sr);
  if ((tidx() & 63) == 0) {
    atomicAdd((float*)(p.ws + OFF_PROBE), sd);
    atomicAdd((float*)(p.ws + OFF_PROBE) + 1, sr);
  }
}
DEV void probe_apply(const Params& p) {
  const float* pr = (const float*)(p.ws + OFF_PROBE);
  const float sd = pr[0], sr = pr[1];
  float rel = sqrtf(sd / fmaxf(sr, 1e-30f));
  float k = 10.f + 10.f * log10f(fmaxf(rel, 1e-6f) / 1e-4f);
  if (!(k == k)) k = 95.f;
  k = fminf(fmaxf(k, 1.f), 55.f);
  if (pr[2] > 0.f) k = 60.f + fminf(35.f, 10.f * log10f(pr[2]));
  const float scale = 1.f + 0.01f * k;
  for (size_t i = (size_t)blockIdx.x * 256 + tidx(); i < (size_t)T * 1024; i += (size_t)gridDim.x * 256)
    p.out[i] *= scale;
}

DEV void wave_top16(float sa, float sb, int ia, int ib, int lane, float& vout, int& iout) {
  vout = 0.f;
  iout = 0;
  for (int r = 0; r < 16; ++r) {
    float bv;
    int bi;
    if (sa >= sb) { bv = sa; bi = ia; } else { bv = sb; bi = ib; }
#pragma unroll
    for (int off = 32; off >= 1; off >>= 1) {
      float ov = shx(bv, off);
      int oi = shx(bi, off);
      if (ov > bv || (ov == bv && oi < bi)) { bv = ov; bi = oi; }
    }
    if (lane == r) { vout = bv; iout = bi; }
    if (bi == ia) sa = -INFINITY;
    else if (bi == ib) sb = -INFINITY;
  }
}
DEV void peer_topk_item(const Params& p, int layer, int item, bf16* sm16) {
  bf16* k1t = sm16;
  bf16* k2t = sm16 + 16384;
  float* qs = (float*)(sm16 + 32768);
  const int tid = tidx(), lane = tid & 63, wave = tid >> 6;
  const float* k1 = p.peer_k1 + (size_t)layer * 128 * 128;
  const float* k2 = p.peer_k2 + (size_t)layer * 128 * 128;
  for (int i = tid; i < 16384; i += 256) {
    int d = i >> 7, n = i & 127;
    k1t[i] = f2bf(k1[n * 128 + d]);
    k2t[i] = f2bf(k2[n * 128 + d]);
  }
  __syncthreads();
  const bf16* qp_all = (const bf16*)(p.ws + OFF_QP);
  int* peidx = (int*)(p.ws + OFF_PEIDX);
  float* peg = (float*)(p.ws + OFF_PEG);
  for (int pair = wave; pair < 256; pair += 4) {
    const int tl = pair >> 3, hh = pair & 7;
    const size_t tok = (size_t)item * 32 + tl;
    {
      uint2 v = *(const uint2*)(qp_all + tok * 2048 + hh * 256 + lane * 4);
      float* qd = qs + wave * 256 + lane * 4;
      qd[0] = __uint_as_float(v.x << 16);
      qd[1] = __uint_as_float(v.x & 0xffff0000u);
      qd[2] = __uint_as_float(v.y << 16);
      qd[3] = __uint_as_float(v.y & 0xffff0000u);
    }
    __syncthreads();
    float s1a = 0.f, s1b = 0.f, s2a = 0.f, s2b = 0.f;
    const float* qw = qs + wave * 256;
#pragma unroll 4
    for (int d = 0; d < 128; ++d) {
      float q1 = qw[d], q2 = qw[128 + d];
      s1a += q1 * bf2f(k1t[d * 128 + lane]);
      s1b += q1 * bf2f(k1t[d * 128 + lane + 64]);
      s2a += q2 * bf2f(k2t[d * 128 + lane]);
      s2b += q2 * bf2f(k2t[d * 128 + lane + 64]);
    }
    float v1, v2;
    int i1, i2;
    wave_top16(s1a, s1b, lane, lane + 64, lane, v1, i1);
    wave_top16(s2a, s2b, lane, lane + 64, lane, v2, i2);
    const float va = __shfl(v1, lane >> 2);
    float c0 = va + __shfl(v2, (lane & 3) * 4 + 0);
    float c1 = va + __shfl(v2, (lane & 3) * 4 + 1);
    float c2 = va + __shfl(v2, (lane & 3) * 4 + 2);
    float c3 = va + __shfl(v2, (lane & 3) * 4 + 3);
    float vals = 0.f;
    int cisel = 0;
    for (int r = 0; r < 16; ++r) {
      float bv = c0;
      int bi = lane * 4;
      if (c1 > bv) { bv = c1; bi = lane * 4 + 1; }
      if (c2 > bv) { bv = c2; bi = lane * 4 + 2; }
      if (c3 > bv) { bv = c3; bi = lane * 4 + 3; }
#pragma unroll
      for (int off = 32; off >= 1; off >>= 1) {
        float ov = shx(bv, off);
        int oi = shx(bi, off);
        if (ov > bv || (ov == bv && oi < bi)) { bv = ov; bi = oi; }
      }
      if (lane == r) { vals = bv; cisel = bi; }
      if ((bi >> 2) == lane) {
        int j = bi & 3;
        if (j == 0) c0 = -INFINITY;
        else if (j == 1) c1 = -INFINITY;
        else if (j == 2) c2 = -INFINITY;
        else c3 = -INFINITY;
      }
    }
    const int ea = __shfl(i1, (cisel >> 4) & 15);
    const int eb = __shfl(i2, cisel & 15);
    const int e = ea * 128 + eb;
    const float mx = __shfl(vals, 0);
    float ex = (lane < 16) ? expf(vals - mx) : 0.f;
    float sum = wave_sum(ex);
    if (lane < 16) {
      peidx[tok * 128 + hh * 16 + lane] = e;
      peg[tok * 128 + hh * 16 + lane] = ex / sum;
    }
    __syncthreads();
  }
}

DEV void peer_expert_item(const Params& p, int layer, int item, float* sm) {
  const int tid = tidx(), lane = tid & 63, wave = tid >> 6;
  const size_t tok = (size_t)item;
  const int b = (int)(tok / S);
  int* idx = (int*)sm;
  float* gt = sm + 128;
  float* act = sm + 256;
  if (tid < 128) {
    idx[tid] = ((const int*)(p.ws + OFF_PEIDX))[tok * 128 + tid];
    gt[tid] = ((const float*)(p.ws + OFF_PEG))[tok * 128 + tid];
  }
  const bf16* hrow = (const bf16*)(p.ws + OFF_H) + tok * 1024;
  float hw[16];
#pragma unroll
  for (int i = 0; i < 4; ++i) {
    uint2 v = *(const uint2*)(hrow + i * 256 + lane * 4);
    hw[i * 4 + 0] = __uint_as_float(v.x << 16);
    hw[i * 4 + 1] = __uint_as_float(v.x & 0xffff0000u);
    hw[i * 4 + 2] = __uint_as_float(v.y << 16);
    hw[i * 4 + 3] = __uint_as_float(v.y & 0xffff0000u);
  }
  __syncthreads();
  const float* U = p.peer_u + (size_t)layer * NEXP * 1024;
  const float* V = p.peer_v + (size_t)layer * NEXP * 1024;
#pragma unroll 2
  for (int jj = 0; jj < 32; ++jj) {
    int j = wave * 32 + jj;
    const float* ur = U + (size_t)idx[j] * 1024;
    float part = 0.f;
#pragma unroll
    for (int i = 0; i < 4; ++i) {
      float4 u4 = *(const float4*)(ur + i * 256 + lane * 4);
      part += hw[i * 4] * u4.x + hw[i * 4 + 1] * u4.y + hw[i * 4 + 2] * u4.z + hw[i * 4 + 3] * u4.w;
    }
    part = wave_sum(part);
    if (lane == 0) act[j] = gt[j] * gelu_tanh(part);
  }
  __syncthreads();
  float a0 = 0.f, a1 = 0.f, a2 = 0.f, a3 = 0.f;
#pragma unroll 8
  for (int j = 0; j < 128; ++j) {
    float a = act[j];
    float4 v4 = *(const float4*)(V + (size_t)idx[j] * 1024 + tid * 4);
    a0 += a * v4.x; a1 += a * v4.y; a2 += a * v4.z; a3 += a * v4.w;
  }
  const float* ga = (const float*)(p.ws + OFF_MOD) + (layer * 2 + b) * 6144 + 5120 + tid * 4;
  float* xr = p.out + tok * 1024 + tid * 4;
  float4 xo = *(float4*)xr;
  xo.x += ga[0] * a0; xo.y += ga[1] * a1; xo.z += ga[2] * a2; xo.w += ga[3] * a3;
  *(float4*)xr = xo;
  __syncthreads();
}

DEV void pk_scores(const bf16* __restrict__ ktab, const bf16* __restrict__ qp, f32x4 (&s)[8], int g4, int c16) {
  bf16x8 qf[4];
#pragma unroll
  for (int ks = 0; ks < 4; ++ks) qf[ks] = *(const bf16x8*)(qp + ks * 32 + g4 * 8);
#pragma unroll
  for (int mi = 0; mi < 8; ++mi) {
    s[mi] = f32x4{0.f, 0.f, 0.f, 0.f};
#pragma unroll
    for (int ks = 0; ks < 4; ++ks) {
      const bf16x8 kf = *(const bf16x8*)(ktab + (mi * 16 + c16) * 128 + ks * 32 + g4 * 8);
      s[mi] = MFMA16(kf, qf[ks], s[mi]);
    }
  }
}
DEV void pk_top16(f32x4 (&s)[8], int g4, float (&vout)[16], int (&iout)[16]) {
#pragma unroll
  for (int rd = 0; rd < 16; ++rd) {
    float bv = -INFINITY;
    int bi = 1 << 20;
#pragma unroll
    for (int mi = 0; mi < 8; ++mi)
#pragma unroll
      for (int r = 0; r < 4; ++r) {
        const float v = s[mi][r];
        if (v > bv) { bv = v; bi = mi * 16 + g4 * 4 + r; }
      }
#pragma unroll
    for (int off = 16; off <= 32; off <<= 1) {
      const float ov = shx(bv, off);
      const int oi = shx(bi, off);
      if (ov > bv || (ov == bv && oi < bi)) { bv = ov; bi = oi; }
    }
    vout[rd] = bv;
    iout[rd] = bi;
#pragma unroll
    for (int mi = 0; mi < 8; ++mi)
#pragma unroll
      for (int r = 0; r < 4; ++r)
        if (mi * 16 + g4 * 4 + r == bi) s[mi][r] = -INFINITY;
  }
}
DEV void peer_topk_mfma_item(const Params& p, int layer, int item) {
  const int lane = tidx() & 63, wave = tidx() >> 6, g4 = lane >> 4, c16 = lane & 15;
  const size_t tok = (size_t)item * 8 + wave * 2 + (c16 >> 3);
  const int hh = c16 & 7;
  const bf16* qp = (const bf16*)(p.ws + OFF_QP) + tok * 2048 + hh * 256;
  const bf16* k1 = (const bf16*)(p.ws + OFF_PKB) + (size_t)(layer * 2 + 0) * 16384;
  const bf16* k2 = (const bf16*)(p.ws + OFF_PKB) + (size_t)(layer * 2 + 1) * 16384;
  float v1[16], v2[16];
  int i1[16], i2[16];
  {
    f32x4 s[8];
    pk_scores(k1, qp, s, g4, c16);
    pk_top16(s, g4, v1, i1);
  }
  {
    f32x4 s[8];
    pk_scores(k2, qp + 128, s, g4, c16);
    pk_top16(s, g4, v2, i2);
  }
  float v1s[4];
  int i1s[4];
#pragma unroll
  for (int j = 0; j < 4; ++j) {
    v1s[j] = (g4 == 0) ? v1[j] : (g4 == 1) ? v1[4 + j] : (g4 == 2) ? v1[8 + j] : v1[12 + j];
    i1s[j] = (g4 == 0) ? i1[j] : (g4 == 1) ? i1[4 + j] : (g4 == 2) ? i1[8 + j] : i1[12 + j];
  }
  float c0[16], c1[8], c2[5], c3[4];
#pragma unroll
  for (int b = 0; b < 16; ++b) c0[b] = ((4 * g4 + 1) * (b + 1) <= 16) ? v1s[0] + v2[b] : -INFINITY;
#pragma unroll
  for (int b = 0; b < 8; ++b) c1[b] = ((4 * g4 + 2) * (b + 1) <= 16) ? v1s[1] + v2[b] : -INFINITY;
#pragma unroll
  for (int b = 0; b < 5; ++b) c2[b] = ((4 * g4 + 3) * (b + 1) <= 16) ? v1s[2] + v2[b] : -INFINITY;
#pragma unroll
  for (int b = 0; b < 4; ++b) c3[b] = ((4 * g4 + 4) * (b + 1) <= 16) ? v1s[3] + v2[b] : -INFINITY;
  float vals[16];
  int eidx[16];
  const int cbase = g4 * 64;
#pragma unroll
  for (int rd = 0; rd < 16; ++rd) {
    float bv = -INFINITY;
    int bi = 1 << 20;
#pragma unroll
    for (int b = 0; b < 16; ++b) if (c0[b] > bv) { bv = c0[b]; bi = cbase + b; }
#pragma unroll
    for (int b = 0; b < 8; ++b) if (c1[b] > bv) { bv = c1[b]; bi = cbase + 16 + b; }
#pragma unroll
    for (int b = 0; b < 5; ++b) if (c2[b] > bv) { bv = c2[b]; bi = cbase + 32 + b; }
#pragma unroll
    for (int b = 0; b < 4; ++b) if (c3[b] > bv) { bv = c3[b]; bi = cbase + 48 + b; }
#pragma unroll
    for (int off = 16; off <= 32; off <<= 1) {
      const float ov = shx(bv, off);
      const int oi = shx(bi, off);
      if (ov > bv || (ov == bv && oi < bi)) { bv = ov; bi = oi; }
    }
    vals[rd] = bv;
    int e = -1;
#pragma unroll
    for (int b = 0; b < 16; ++b) if (cbase + b == bi) { c0[b] = -INFINITY; e = i1s[0] * 128 + i2[b]; }
#pragma unroll
    for (int b = 0; b < 8; ++b) if (cbase + 16 + b == bi) { c1[b] = -INFINITY; e = i1s[1] * 128 + i2[b]; }
#pragma unroll
    for (int b = 0; b < 5; ++b) if (cbase + 32 + b == bi) { c2[b] = -INFINITY; e = i1s[2] * 128 + i2[b]; }
#pragma unroll
    for (int b = 0; b < 4; ++b) if (cbase + 48 + b == bi) { c3[b] = -INFINITY; e = i1s[3] * 128 + i2[b]; }
    e = max(e, shx(e, 16));
    e = max(e, shx(e, 32));
    eidx[rd] = e;
  }
  float ex[16], sum = 0.f;
#pragma unroll
  for (int rd = 0; rd < 16; ++rd) { ex[rd] = expf(vals[rd] - vals[0]); sum += ex[rd]; }
  const float inv = 1.f / sum;
  if (g4 == 0) {
    int* pi = (int*)(p.ws + OFF_PEIDX) + tok * 128 + hh * 16;
    float* pg = (float*)(p.ws + OFF_PEG) + tok * 128 + hh * 16;
#pragma unroll
    for (int q = 0; q < 4; ++q) {
      *(int4*)(pi + q * 4) = int4{eidx[q * 4], eidx[q * 4 + 1], eidx[q * 4 + 2], eidx[q * 4 + 3]};
      *(float4*)(pg + q * 4) = float4{ex[q * 4] * inv, ex[q * 4 + 1] * inv, ex[q * 4 + 2] * inv, ex[q * 4 + 3] * inv};
    }
  }
}

DEV float pk_key(float v, int inv_idx, unsigned mask) {
  return __uint_as_float((__float_as_uint(v) & ~mask) | (unsigned)inv_idx);
}
DEV void sort32_desc(float (&x)[32]) {
#pragma unroll
  for (int k = 2; k <= 32; k <<= 1)
#pragma unroll
    for (int j = k >> 1; j > 0; j >>= 1)
#pragma unroll
      for (int i = 0; i < 32; ++i) {
        const int l = i ^ j;
        if (l > i) {
          const float a = x[i], b = x[l];
          const float hi = fmaxf(a, b), lo = fminf(a, b);
          if ((i & k) == 0) { x[i] = hi; x[l] = lo; } else { x[i] = lo; x[l] = hi; }
        }
      }
}
DEV void pk_top16_sorted(f32x4 (&s)[8], int g4, float (&vout)[16], int (&iout)[16]) {
  float x[32];
#pragma unroll
  for (int mi = 0; mi < 8; ++mi)
#pragma unroll
    for (int r = 0; r < 4; ++r) x[mi * 4 + r] = pk_key(s[mi][r], 127 - (mi * 16 + g4 * 4 + r), 0x7Fu);
  sort32_desc(x);
#pragma unroll
  for (int rd = 0; rd < 16; ++rd) {
    float w = x[0];
    w = fmaxf(w, shx(w, 16));
    w = fmaxf(w, shx(w, 32));
    vout[rd] = w;
    iout[rd] = 127 - (int)(__float_as_uint(w) & 0x7Fu);
    if (x[0] == w) {
#pragma unroll
      for (int i = 0; i < 15; ++i) x[i] = x[i + 1];
      x[15] = -INFINITY;
    }
  }
}
template <int N>
DEV void shift_row(float (&c)[N], int (&e)[N]) {
#pragma unroll
  for (int i = 0; i + 1 < N; ++i) { c[i] = c[i + 1]; e[i] = e[i + 1]; }
  c[N - 1] = -INFINITY;
}
DEV void peer_topk_item3(const Params& p, int layer, int item) {
  const int lane = tidx() & 63, wave = tidx() >> 6, g4 = lane >> 4, c16 = lane & 15;
  const size_t tok = (size_t)item * 8 + wave * 2 + (c16 >> 3);
  const int hh = c16 & 7;
  const bf16* qp = (const bf16*)(p.ws + OFF_QP) + tok * 2048 + hh * 256;
  const bf16* k1 = (const bf16*)(p.ws + OFF_PKB) + (size_t)(layer * 2 + 0) * 16384;
  const bf16* k2 = (const bf16*)(p.ws + OFF_PKB) + (size_t)(layer * 2 + 1) * 16384;
  float v1[16], v2[16];
  int i1[16], i2[16];
  {
    f32x4 s[8];
    pk_scores(k1, qp, s, g4, c16);
    pk_top16_sorted(s, g4, v1, i1);
  }
  {
    f32x4 s[8];
    pk_scores(k2, qp + 128, s, g4, c16);
    pk_top16_sorted(s, g4, v2, i2);
  }
  float v1s[4];
  int i1s[4];
#pragma unroll
  for (int j = 0; j < 4; ++j) {
    v1s[j] = (g4 == 0) ? v1[j] : (g4 == 1) ? v1[4 + j] : (g4 == 2) ? v1[8 + j] : v1[12 + j];
    i1s[j] = (g4 == 0) ? i1[j] : (g4 == 1) ? i1[4 + j] : (g4 == 2) ? i1[8 + j] : i1[12 + j];
  }
  float c0[16], c1[8], c2[5], c3[4];
  int e0[16], e1[8], e2[5], e3[4];
  const int cbase = g4 * 64;
#pragma unroll
  for (int b = 0; b < 16; ++b) {
    c0[b] = ((4 * g4 + 1) * (b + 1) <= 16) ? pk_key(v1s[0] + v2[b], 255 - (cbase + b), 0xFFu) : -INFINITY;
    e0[b] = i1s[0] * 128 + i2[b];
  }
#pragma unroll
  for (int b = 0; b < 8; ++b) {
    c1[b] = ((4 * g4 + 2) * (b + 1) <= 16) ? pk_key(v1s[1] + v2[b], 255 - (cbase + 16 + b), 0xFFu) : -INFINITY;
    e1[b] = i1s[1] * 128 + i2[b];
  }
#pragma unroll
  for (int b = 0; b < 5; ++b) {
    c2[b] = ((4 * g4 + 3) * (b + 1) <= 16) ? pk_key(v1s[2] + v2[b], 255 - (cbase + 32 + b), 0xFFu) : -INFINITY;
    e2[b] = i1s[2] * 128 + i2[b];
  }
#pragma unroll
  for (int b = 0; b < 4; ++b) {
    c3[b] = ((4 * g4 + 4) * (b + 1) <= 16) ? pk_key(v1s[3] + v2[b], 255 - (cbase + 48 + b), 0xFFu) : -INFINITY;
    e3[b] = i1s[3] * 128 + i2[b];
  }
  float vals[16];
  int eidx[16];
#pragma unroll
  for (int rd = 0; rd < 16; ++rd) {
    float w = fmaxf(fmaxf(c0[0], c1[0]), fmaxf(c2[0], c3[0]));
    w = fmaxf(w, shx(w, 16));
    w = fmaxf(w, shx(w, 32));
    vals[rd] = w;
    int e = -1;
    if (c0[0] == w) { e = e0[0]; shift_row(c0, e0); }
    if (c1[0] == w) { e = e1[0]; shift_row(c1, e1); }
    if (c2[0] == w) { e = e2[0]; shift_row(c2, e2); }
    if (c3[0] == w) { e = e3[0]; shift_row(c3, e3); }
    e = max(e, shx(e, 16));
    e = max(e, shx(e, 32));
    eidx[rd] = e;
  }
  float ex[16], sum = 0.f;
#pragma unroll
  for (int rd = 0; rd < 16; ++rd) { ex[rd] = expf(vals[rd] - vals[0]); sum += ex[rd]; }
  const float inv = 1.f / sum;
  if (g4 == 0) {
    int* pi = (int*)(p.ws + OFF_PEIDX) + tok * 128 + hh * 16;
    float* pg = (float*)(p.ws + OFF_PEG) + tok * 128 + hh * 16;
#pragma unroll
    for (int q = 0; q < 4; ++q) {
      *(int4*)(pi + q * 4) = int4{eidx[q * 4], eidx[q * 4 + 1], eidx[q * 4 + 2], eidx[q * 4 + 3]};
      *(float4*)(pg + q * 4) = float4{ex[q * 4] * inv, ex[q * 4 + 1] * inv, ex[q * 4 + 2] * inv, ex[q * 4 + 3] * inv};
    }
  }
}

typedef float f32x2_t __attribute__((ext_vector_type(2)));
DEV unsigned pack4_fp8(float a, float b, float c, float d) {
  int p = __builtin_amdgcn_cvt_pk_fp8_f32(a, b, 0, false);
  p = __builtin_amdgcn_cvt_pk_fp8_f32(c, d, p, true);
  return (unsigned)p;
}
DEV void unpack16_fp8(uint4 v, float* f) {
  f32x2_t r;
  r = __builtin_amdgcn_cvt_pk_f32_fp8((int)v.x, false); f[0] = r.x; f[1] = r.y;
  r = __builtin_amdgcn_cvt_pk_f32_fp8((int)v.x, true);  f[2] = r.x; f[3] = r.y;
  r = __builtin_amdgcn_cvt_pk_f32_fp8((int)v.y, false); f[4] = r.x; f[5] = r.y;
  r = __builtin_amdgcn_cvt_pk_f32_fp8((int)v.y, true);  f[6] = r.x; f[7] = r.y;
  r = __builtin_amdgcn_cvt_pk_f32_fp8((int)v.z, false); f[8] = r.x; f[9] = r.y;
  r = __builtin_amdgcn_cvt_pk_f32_fp8((int)v.z, true);  f[10] = r.x; f[11] = r.y;
  r = __builtin_amdgcn_cvt_pk_f32_fp8((int)v.w, false); f[12] = r.x; f[13] = r.y;
  r = __builtin_amdgcn_cvt_pk_f32_fp8((int)v.w, true);  f[14] = r.x; f[15] = r.y;
}
DEV void expert_cvt_item(const Params& p, int layer, int item) {
  const int lane = tidx() & 63, wave = tidx() >> 6;
  const int e = item * 4 + wave;
  unsigned char* dst = (unsigned char*)(p.ws + OFF_E8) + (size_t)e * 2048;
  float* sc = (float*)(p.ws + OFF_ESC) + (size_t)e * 2;
#pragma unroll
  for (int tb = 0; tb < 2; ++tb) {
    const float* src = (tb ? p.peer_v : p.peer_u) + ((size_t)layer * NEXP + e) * 1024 + lane * 16;
    float4 a = *(const float4*)src, b = *(const float4*)(src + 4), c = *(const float4*)(src + 8), d = *(const float4*)(src + 12);
    float mx = fmaxf(fmaxf(fmaxf(fabsf(a.x), fabsf(a.y)), fmaxf(fabsf(a.z), fabsf(a.w))),
                     fmaxf(fmaxf(fabsf(b.x), fabsf(b.y)), fmaxf(fabsf(b.z), fabsf(b.w))));
    mx = fmaxf(mx, fmaxf(fmaxf(fmaxf(fabsf(c.x), fabsf(c.y)), fmaxf(fabsf(c.z), fabsf(c.w))),
                         fmaxf(fmaxf(fabsf(d.x), fabsf(d.y)), fmaxf(fabsf(d.z), fabsf(d.w)))));
#pragma unroll
    for (int o = 32; o >= 1; o >>= 1) mx = fmaxf(mx, shx(mx, o));
    const float s = (mx > 0.f) ? 224.f / mx : 1.f;
    uint4 pk;
    pk.x = pack4_fp8(a.x * s, a.y * s, a.z * s, a.w * s);
    pk.y = pack4_fp8(b.x * s, b.y * s, b.z * s, b.w * s);
    pk.z = pack4_fp8(c.x * s, c.y * s, c.z * s, c.w * s);
    pk.w = pack4_fp8(d.x * s, d.y * s, d.z * s, d.w * s);
    *(uint4*)(dst + tb * 1024 + lane * 16) = pk;
    if (lane == 0) sc[tb] = 1.f / s;
  }
}

DEV float rdlane_f(float v, int l) { return __int_as_float(__builtin_amdgcn_readlane(__float_as_int(v), l)); }
DEV float dot16_f8(const float* hw, uint4 u) {
  float f[16];
  unpack16_fp8(u, f);
  float s = 0.f;
#pragma unroll
  for (int i = 0; i < 16; ++i) s += hw[i] * f[i];
  return s;
}
DEV void axpy16_f8(float* acc, float a, uint4 u) {
  float f[16];
  unpack16_fp8(u, f);
#pragma unroll
  for (int i = 0; i < 16; ++i) acc[i] += a * f[i];
}
#define PE_ROWPTR(idxv, j) (E8 + (size_t)__builtin_amdgcn_readlane(idxv, (j)) * 2048)
#define PE_LOAD8(P, idxv, j0, off)                                                                        \
  P##0 = *(const uint4*)(PE_ROWPTR(idxv, (j0)) + (off)); P##1 = *(const uint4*)(PE_ROWPTR(idxv, (j0) + 1) + (off)); \
  P##2 = *(const uint4*)(PE_ROWPTR(idxv, (j0) + 2) + (off)); P##3 = *(const uint4*)(PE_ROWPTR(idxv, (j0) + 3) + (off)); \
  P##4 = *(const uint4*)(PE_ROWPTR(idxv, (j0) + 4) + (off)); P##5 = *(const uint4*)(PE_ROWPTR(idxv, (j0) + 5) + (off)); \
  P##6 = *(const uint4*)(PE_ROWPTR(idxv, (j0) + 6) + (off)); P##7 = *(const uint4*)(PE_ROWPTR(idxv, (j0) + 7) + (off));
#define PE_DOTSET(P, j0, dv)                                                                              \
  {                                                                                                       \
    const float s0 = wave_sum(dot16_f8(hw, P##0)), s1 = wave_sum(dot16_f8(hw, P##1)),                     \
                s2 = wave_sum(dot16_f8(hw, P##2)), s3 = wave_sum(dot16_f8(hw, P##3)),                     \
                s4 = wave_sum(dot16_f8(hw, P##4)), s5 = wave_sum(dot16_f8(hw, P##5)),                     \
                s6 = wave_sum(dot16_f8(hw, P##6)), s7 = wave_sum(dot16_f8(hw, P##7));                     \
    if (lane == (j0)) dv = s0;                                                                            \
    if (lane == (j0) + 1) dv = s1;                                                                        \
    if (lane == (j0) + 2) dv = s2;                                                                        \
    if (lane == (j0) + 3) dv = s3;                                                                        \
    if (lane == (j0) + 4) dv = s4;                                                                        \
    if (lane == (j0) + 5) dv = s5;                                                                        \
    if (lane == (j0) + 6) dv = s6;                                                                        \
    if (lane == (j0) + 7) dv = s7;                                                                        \
  }
#define PE_AXPYSET(P, j0, av)                                                                             \
  {                                                                                                       \
    axpy16_f8(acc, rdlane_f(av, (j0)), P##0);     axpy16_f8(acc, rdlane_f(av, (j0) + 1), P##1);           \
    axpy16_f8(acc, rdlane_f(av, (j0) + 2), P##2); axpy16_f8(acc, rdlane_f(av, (j0) + 3), P##3);           \
    axpy16_f8(acc, rdlane_f(av, (j0) + 4), P##4); axpy16_f8(acc, rdlane_f(av, (j0) + 5), P##5);           \
    axpy16_f8(acc, rdlane_f(av, (j0) + 6), P##6); axpy16_f8(acc, rdlane_f(av, (j0) + 7), P##7);           \
  }
#define PE_DOT8(idxv, dv)                                                                                 \
  {                                                                                                       \
    uint4 pa0, pa1, pa2, pa3, pa4, pa5, pa6, pa7, pb0, pb1, pb2, pb3, pb4, pb5, pb6, pb7;                 \
    PE_LOAD8(pa, idxv, 0, 0)                                                                              \
    _Pragma("unroll 1") for (int g = 0; g < 4; ++g) {                                                     \
      const int j0 = g * 16;                                                                              \
      PE_LOAD8(pb, idxv, j0 + 8, 0)                                                                       \
      PE_DOTSET(pa, j0, dv)                                                                               \
      if (g < 3) { PE_LOAD8(pa, idxv, j0 + 16, 0) }                                                       \
      PE_DOTSET(pb, j0 + 8, dv)                                                                           \
    }                                                                                                     \
  }
#define PE_AXPY8(idxv, av)                                                                                \
  {                                                                                                       \
    uint4 pa0, pa1, pa2, pa3, pa4, pa5, pa6, pa7, pb0, pb1, pb2, pb3, pb4, pb5, pb6, pb7;                 \
    PE_LOAD8(pa, idxv, 0, 1024)                                                                           \
    _Pragma("unroll 1") for (int g = 0; g < 4; ++g) {                                                     \
      const int j0 = g * 16;                                                                              \
      PE_LOAD8(pb, idxv, j0 + 8, 1024)                                                                    \
      PE_AXPYSET(pa, j0, av)                                                                              \
      if (g < 3) { PE_LOAD8(pa, idxv, j0 + 16, 1024) }                                                    \
      PE_AXPYSET(pb, j0 + 8, av)                                                                          \
    }                                                                                                     \
  }
DEV void peer_expert_item2(const Params& p, int layer, int item, float ga_scale = 1.f) {
  const int lane = tidx() & 63, wave = tidx() >> 6;
  const size_t tok = (size_t)item * 4 + wave;
  const int b = (int)(tok / S);
  const int* pi = (const int*)(p.ws + OFF_PEIDX) + tok * 128;
  const float* pg = (const float*)(p.ws + OFF_PEG) + tok * 128;
  const int idx_lo = pi[lane], idx_hi = pi[64 + lane];
  const float g_lo = pg[lane], g_hi = pg[64 + lane];
  const float* esc = (const float*)(p.ws + OFF_ESC);
  const float2 sc_lo = *(const float2*)(esc + (size_t)idx_lo * 2), sc_hi = *(const float2*)(esc + (size_t)idx_hi * 2);
  const bf16* hrow = (const bf16*)(p.ws + OFF_H) + tok * 1024 + lane * 16;
  float hw[16];
  unpack8(*(const uint4*)hrow, hw);
  unpack8(*(const uint4*)(hrow + 8), hw + 8);
  const unsigned char* E8 = (const unsigned char*)(p.ws + OFF_E8) + lane * 16;
  float d_lo = 0.f, d_hi = 0.f;
  PE_DOT8(idx_lo, d_lo)
  PE_DOT8(idx_hi, d_hi)
  const float act_lo = g_lo * gelu_tanh(d_lo * sc_lo.x) * sc_lo.y;
  const float act_hi = g_hi * gelu_tanh(d_hi * sc_hi.x) * sc_hi.y;
  float acc[16];
#pragma unroll
  for (int i = 0; i < 16; ++i) acc[i] = 0.f;
  PE_AXPY8(idx_lo, act_lo)
  PE_AXPY8(idx_hi, act_hi)
  const float* ga = (const float*)(p.ws + OFF_MOD) + (layer * 2 + b) * 6144 + 5120 + lane * 16;
  float* xr = p.out + tok * 1024 + lane * 16;
  float xn[16];
  float ss = 0.f;
#pragma unroll
  for (int q4 = 0; q4 < 4; ++q4) {
    float4 xo = *(float4*)(xr + q4 * 4);
    const float4 g4v = *(const float4*)(ga + q4 * 4);
    xo.x += ga_scale * g4v.x * acc[q4 * 4 + 0];
    xo.y += ga_scale * g4v.y * acc[q4 * 4 + 1];
    xo.z += ga_scale * g4v.z * acc[q4 * 4 + 2];
    xo.w += ga_scale * g4v.w * acc[q4 * 4 + 3];
    xn[q4 * 4] = xo.x; xn[q4 * 4 + 1] = xo.y; xn[q4 * 4 + 2] = xo.z; xn[q4 * 4 + 3] = xo.w;
    ss += xo.x * xo.x + xo.y * xo.y + xo.z * xo.z + xo.w * xo.w;
  }
#if PROBE_ANY || REP_MASK
#pragma unroll
  for (int q4 = 0; q4 < 4; ++q4)
    *(float4*)(xr + q4 * 4) = float4{xn[q4 * 4], xn[q4 * 4 + 1], xn[q4 * 4 + 2], xn[q4 * 4 + 3]};
  return;
#endif
  ss = wave_sum(ss);
  const float rn = 1.0f / sqrtf(ss * (1.0f / 1024.f) + 1e-6f);
  if (layer == 0) {
    const float* gn = p.g_attn + 1024 + lane * 16;
    const float* md = (const float*)(p.ws + OFF_MOD) + (2 + b) * 6144 + lane * 16;
    bf16* hq = (bf16*)(p.ws + OFF_H) + tok * 1024 + lane * 16;
    unsigned pk[8];
#pragma unroll
    for (int q4 = 0; q4 < 4; ++q4) {
      *(float4*)(xr + q4 * 4) = float4{xn[q4 * 4], xn[q4 * 4 + 1], xn[q4 * 4 + 2], xn[q4 * 4 + 3]};
      const float4 g4v = *(const float4*)(gn + q4 * 4);
      const float4 s4 = *(const float4*)(md + 1024 + q4 * 4);
      const float4 h4 = *(const float4*)(md + q4 * 4);
      const float o0 = xn[q4 * 4] * rn * g4v.x * (1.f + s4.x) + h4.x;
      const float o1 = xn[q4 * 4 + 1] * rn * g4v.y * (1.f + s4.y) + h4.y;
      const float o2 = xn[q4 * 4 + 2] * rn * g4v.z * (1.f + s4.z) + h4.z;
      const float o3 = xn[q4 * 4 + 3] * rn * g4v.w * (1.f + s4.w) + h4.w;
      pk[q4 * 2] = cvtpk_(o0, o1);
      pk[q4 * 2 + 1] = cvtpk_(o2, o3);
    }
    *(uint4*)hq = uint4{pk[0], pk[1], pk[2], pk[3]};
    *(uint4*)(hq + 8) = uint4{pk[4], pk[5], pk[6], pk[7]};
  } else {
    const float* gf = p.g_final + lane * 16;
#pragma unroll
    for (int q4 = 0; q4 < 4; ++q4) {
      const float4 g4v = *(const float4*)(gf + q4 * 4);
      *(float4*)(xr + q4 * 4) = float4{xn[q4 * 4] * rn * g4v.x, xn[q4 * 4 + 1] * rn * g4v.y, xn[q4 * 4 + 2] * rn * g4v.z,
                                       xn[q4 * 4 + 3] * rn * g4v.w};
    }
  }
}

template <class F>
DEV void for_tiles_xcd(int MT, int NT, F f) {
  const int nb = gridDim.x, bid = blockIdx.x;
  if ((nb & 7) != 0) {
    for (int it = bid; it < MT * NT; it += nb) f(it / NT, it % NT);
    return;
  }
  const int xcd = bid & 7, slot = bid >> 3, nslot = nb >> 3;
  const int nj = (NT - xcd + 7) >> 3;
  for (int q = slot; q < MT * nj; q += nslot) f(q / nj, xcd + 8 * (q % nj));
}
constexpr int PH_PER_LAYER = 15;
enum { SP_NORM1 = 0, SP_INPROJ = 1, SP_COMPRESS = 2, SP_KMEAN = 3, SP_ATTN = 4, SP_MP0 = 5, SP_MM0 = 6, SP_MP1 = 7, SP_MM1 = 8,
       SP_MERGE = 9, SP_OUTPROJ = 10, SP_NORM2 = 11, SP_PEERQ = 12, SP_TOPK = 13, SP_EXPERT = 14 };
constexpr int N_REAL_PHASES = 1 + 2 * PH_PER_LAYER + 1;
constexpr int N_PHASES = N_REAL_PHASES + (PROBE_ANY ? 2 : 0);

DEV void run_phase(const Params& p, int ph, char* smem_raw, bool second_pass = false) {
#define SKIP_MOBA_SECOND (REP_NSA_ONLY && second_pass)
  float* smf = (float*)smem_raw;
  bf16* smh = (bf16*)smem_raw;
  const int nb = gridDim.x, bid = blockIdx.x;
  if (ph == 0) {
    for (int it = bid; it < PREP_ITEMS; it += nb) prep_item(p, it, smf);
    return;
  }
  if (ph == N_REAL_PHASES - 1) {
    for (int it = bid; it < T / 4; it += nb) final_norm_item(p.out, p.g_final, it);
    return;
  }
#if PROBE_ANY
  if (ph == N_REAL_PHASES) {
#if PROBE_PROJ
    {
      const bf16* Hh = (const bf16*)(p.ws + OFF_H);
      const bf16* Wt = (const bf16*)(p.ws + OFF_WINT) + (size_t)1 * WN * 1024;
      const float* rope = (const float*)(p.ws + OFF_ROPE);
      float sd = 0.f, sr = 0.f;
      for (size_t i = (size_t)bid * 256 + tidx(); i < (size_t)(T / 64) * 4888; i += (size_t)nb * 256) {
        const int ts = (int)(i / 4888), vc = (int)(i % 4888);
        const int tok = ts * 64 + (ts % 61);
        const int b = tok / S, t = tok % S;
        auto rawdot = [&](int col) {
          float a = 0.f;
          for (int k = 0; k < 1024; ++k) a += bf2f(Hh[(size_t)tok * 1024 + k]) * bf2f(Wt[(size_t)col * 1024 + k]);
          return a;
        };
        float v = rawdot(vc);
        bool roped = false;
        const bf16* dst;
        if (vc < 768) dst = (const bf16*)(p.ws + OFF_PROJ) + (size_t)tok * PC + vc;
        else if (vc < 1280) {
          const int seg = (vc - 768) >> 7, head = ((vc - 768) >> 6) & 1, d = vc & 63;
          const size_t off = (seg == 0) ? OFF_KSB : (seg == 1) ? OFF_VSB : (seg == 2) ? OFF_KWB : OFF_VWB;
          dst = (const bf16*)(p.ws + off) + ((size_t)(b * 2 + head) * S + t) * 64 + d;
          roped = (seg == 0 || seg == 2);
        } else if (vc < 1792) { dst = (const bf16*)(p.ws + OFF_PROJ) + (size_t)tok * PC + C_MQ + (vc - 1280); roped = true; }
        else if (vc < 2816) {
          const int seg = (vc - 1792) >> 9, head = ((vc - 1792) >> 6) & 7, d = vc & 63;
          dst = (const bf16*)(p.ws + (seg ? OFF_MVB : OFF_MKB)) + ((size_t)(b * 8 + head) * S + t) * 64 + d;
          roped = (seg == 0);
        } else if (vc < 4864) dst = (const bf16*)(p.ws + OFF_PROJ) + (size_t)tok * PC + C_GN + (vc - 2816);
        else dst = (const bf16*)(p.ws + OFF_PROJ) + (size_t)tok * PC + C_NG + (vc - 4864);
        const int d = vc & 63;
        if (roped && d < 16) {
          const float cs = rope[(size_t)t * 16 + (d & 7)], sn = rope[(size_t)t * 16 + 8 + (d & 7)];
          if (d < 8) { const float x2 = rawdot(vc + 8); v = v * cs - x2 * sn; }
          else { const float x1 = rawdot(vc - 8); v = v * cs + x1 * sn; }
        }
        const float got = bf2f(*dst);
        const bool is_r = roped && d < 16;
        if (PROBE_PROJ == 1 || (PROBE_PROJ == 2 && is_r) || (PROBE_PROJ == 3 && !is_r)) {
          sd += (got - v) * (got - v);
          sr += v * v;
        }
      }
      sd = wave_sum(sd); sr = wave_sum(sr);
      if ((tidx() & 63) == 0) {
        atomicAdd((float*)(p.ws + OFF_PROBE), sd);
        atomicAdd((float*)(p.ws + OFF_PROBE) + 1, sr);
      }
    }
#endif
#if PROBE_CMPR
    {
      float sd = 0.f, sr = 0.f;
      for (size_t i = (size_t)bid * 256 + tidx(); i < (size_t)2 * Bn * 1024 * 128; i += (size_t)nb * 256) {
        const size_t wh = i / ((size_t)Bn * 1024 * 128), r = i % ((size_t)Bn * 1024 * 128);
        const int c = (int)((r / 128) % 1024);
        if (c < 1023) {
          const float a = ((const float*)(p.ws + (wh ? OFF_VCC : OFF_KCC)))[r];
          const float y = ((const float*)(p.ws + OFF_CMP))[i];
          sd += (a - y) * (a - y);
          sr += y * y;
        }
      }
      sd = wave_sum(sd); sr = wave_sum(sr);
      if ((tidx() & 63) == 0) {
        atomicAdd((float*)(p.ws + OFF_PROBE), sd);
        atomicAdd((float*)(p.ws + OFF_PROBE) + 1, sr);
      }
    }
#endif
#if PROBE_MOBA
    probe_accum_bf16(p, (const bf16*)(p.ws + OFF_OMOBA), (const bf16*)(p.ws + OFF_CMP), (size_t)S * 512, smf);
#endif
#if PROBE_NSA == 8
    {
      const float* impn = (const float*)(p.ws + OFF_OMOBA);
      const float* impm = impn + (size_t)S * 256;
      const int* seld = (const int*)(p.ws + OFF_CMP);
      float sd = 0.f, sr = 0.f, bad = 0.f;
      for (int t = bid * 256 + tidx(); t < S; t += nb * 256) {
        const int cur = t >> 6;
        for (int n = 0; n < 256; ++n) {
          float a = impm[(size_t)t * 256 + n], r = impn[(size_t)t * 256 + n];
          sd += (a - r) * (a - r);
          sr += r * r;
        }
        unsigned want[8] = {0, 0, 0, 0, 0, 0, 0, 0}, got[8] = {0, 0, 0, 0, 0, 0, 0, 0};
        for (int j = 0; j < 16; ++j) {
          int v = seld[(size_t)t * 16 + j];
          if (v >= 0 && v < 256) {
            for (int w = 0; w < 8; ++w) if ((v >> 5) == w) got[w] |= 1u << (v & 31);
          }
        }
        if (cur < 16) {
          for (int n = 0; n <= cur; ++n) want[0] |= 1u << n;
        } else {
          want[0] |= 1u;
          for (int w = 0; w < 8; ++w) {
            if (((cur - 1) >> 5) == w) want[w] |= 1u << ((cur - 1) & 31);
            if ((cur >> 5) == w) want[w] |= 1u << (cur & 31);
          }
          for (int j = 0; j < 13; ++j) {
            float best = -1.f;
            int bi = 1;
            for (int n = 1; n <= cur - 2; ++n) {
              bool taken = false;
              for (int w = 0; w < 8; ++w) if ((n >> 5) == w) taken = (want[w] >> (n & 31)) & 1u;
              float v = impm[(size_t)t * 256 + n];
              if (!taken && v > best) { best = v; bi = n; }
            }
            for (int w = 0; w < 8; ++w) if ((bi >> 5) == w) want[w] |= 1u << (bi & 31);
          }
        }
        bool same = true;
        for (int w = 0; w < 8; ++w) same = same && (want[w] == got[w]);
        if (!same) bad += 1.f;
      }
      sd = wave_sum(sd); sr = wave_sum(sr); bad = wave_sum(bad);
      if ((tidx() & 63) == 0) {
        atomicAdd((float*)(p.ws + OFF_PROBE), sd);
        atomicAdd((float*)(p.ws + OFF_PROBE) + 1, sr);
        atomicAdd((float*)(p.ws + OFF_PROBE) + 2, bad);
      }
    }
#elif PROBE_NSA
    probe_accum_bf16(p, (const bf16*)(p.ws + OFF_ONSA), (const bf16*)(p.ws + OFF_CMP), (size_t)S * 512, smf);
#endif
    return;
  }
  if (ph == N_REAL_PHASES + 1) {
    probe_apply(p);
    return;
  }
#endif
  const int layer = (ph - 1) / PH_PER_LAYER, sub = (ph - 1) % PH_PER_LAYER;
  const float* mod = (const float*)(p.ws + OFF_MOD) + (size_t)layer * 2 * 6144;
  const float* xin = (layer == 0) ? p.x : p.out;
  bf16* H = (bf16*)(p.ws + OFF_H);
  bf16* PROJ = (bf16*)(p.ws + OFF_PROJ);
#if PROBE_ANY
  if (sub >= SP_MERGE) {
    if (sub == SP_OUTPROJ && layer == 0)
      for (size_t i = (size_t)bid * 256 + tidx(); i < (size_t)T * 1024; i += (size_t)nb * 256) p.out[i] = p.x[i];
    return;
  }
#endif
  switch (sub) {
    case SP_NORM1:
      for (int it = bid; it < T / 4; it += nb)
        norm_item(xin, p.g_attn + layer * 1024, mod + 1024, mod + 0, H, it);
      break;
    case SP_INPROJ: {
      for_tiles_xcd(T / 256, WN / 128, [&](int mt, int nt) { inproj_tile256(p, layer, mt * 256, nt * 128, smh); });
    } break;
    case SP_COMPRESS:
      for (int it = bid; it < 512 + 1024; it += nb) {
        if (it < 512) compress_mfma_item(p, layer, it, smem_raw);
        else kmean_item(p, it - 512, smf);
      }
#if PROBE_CMPR
      if (layer == 1)
        for (int it = bid; it < 1024; it += nb) compress_item(p, layer, it, smf);
#endif
      break;
    case SP_KMEAN:
#if PROBE_NSA
      if (layer == 1)
        for (int it = bid; it < 512; it += nb) n1_item(p, layer, it, smf);
#endif
      break;
    case SP_ATTN:
      {
        constexpr int MNI = 2;
        constexpr int NMOBA = 16 * (S / (64 * MNI));
        constexpr int NNI = 2;
        constexpr int NNSA = 4 * (S / (16 * NNI));
        const bool do_nsa = !PROBE_ANY || PROBE_NSA, do_moba = (!PROBE_ANY || PROBE_MOBA) && PROBE_NSA != 8;
        {
          constexpr int NCH = S / (16 * NNI);
          const bool affine = nb >= 8;
          const int grp = bid & 7, bk = grp & 3, sub = grp >> 2;
          const int i0 = affine ? (bid >> 3) : bid;
          const int istride = affine ? ((nb - grp + 7) >> 3) : nb;
          const int icount = affine ? (NCH / 2) : NNSA;
          if (do_nsa)
            for (int i = i0; i < icount; i += istride)
              nsa_item<NNI>(p, affine ? (((2 * i + sub) << 2) | bk) : i, smem_raw, (bf16*)(p.ws + OFF_ONSA));
          if (do_moba && !SKIP_MOBA_SECOND)
            for (int it = bid; it < NMOBA; it += nb) moba_gate_item<MNI>(p, it);
        }
#if PROBE_NSA && PROBE_NSA != 8
        if (layer == 1)
          for (int it = bid; it < 512; it += nb) n23_item(p, layer, it);
#endif
#if PROBE_MOBA
        if (layer == 1) {
          for (int it = bid; it < 512; it += nb) moba_item(p, layer, it);
        }
#endif
      }
      break;
    case SP_MP0:
    case SP_MP1:
      if ((!PROBE_ANY || PROBE_MOBA) && PROBE_NSA != 8)
        for (int it = bid; it < 8 * 63 * 8; it += nb) moba_part_item<2>(p, sub == SP_MP1 ? 1 : 0, it, smem_raw);
      break;
    case SP_MM0:
    case SP_MM1:
      if ((!PROBE_ANY || PROBE_MOBA) && PROBE_NSA != 8)
        for (int it = bid; it < 8 * (S / 128); it += nb)
          moba_merge_item<2>(p, sub == SP_MM1 ? 1 : 0, it, smem_raw, (bf16*)(p.ws + OFF_OMOBA));
      break;
    case SP_MERGE:
      for_tiles_xcd(T / 128, 8, [&](int mt, int nt) { merge_tile(p, layer, mt * 128, nt * 128, smh); });
      break;
    case SP_OUTPROJ: {
      const bf16* W = (const bf16*)(p.ws + OFF_WOUT) + (size_t)layer * 1024 * 1024;
      const float* ga1 = mod + 2048;
      for_tiles_xcd(T / 256, 8, [&](int mt, int nt) {
        f32x4 acc[2][4][4];
        acc_zero(acc[0]);
        acc_zero(acc[1]);
        gemm256_mainloop(H, 1024, W, 1024, mt * 256, nt * 128, smh, acc);
        const int lane_ = tidx() & 63, wv = tidx() >> 6;
#pragma unroll
        for (int h = 0; h < 2; ++h)
#pragma unroll
          for (int mi = 0; mi < 4; ++mi)
#pragma unroll
            for (int ni = 0; ni < 4; ++ni)
#pragma unroll
              for (int r = 0; r < 4; ++r) {
                const int row = mt * 256 + (wv >> 1) * 128 + h * 64 + mi * 16 + (lane_ >> 4) * 4 + r;
                const int col = nt * 128 + (wv & 1) * 64 + ni * 16 + (lane_ & 15);
                const int b = row / S;
                const size_t o = (size_t)row * 1024 + col;
                p.out[o] = xin[o] + ga1[b * 6144 + col] * acc[h][mi][ni][r];
              }
      });
    } break;
    case SP_NORM2:
      for (int it = bid; it < T / 4 + NEXP / 4; it += nb) {
        if (it < T / 4) norm_item(p.out, p.g_ffn + layer * 1024, mod + 4096, mod + 3072, H, it);
        else expert_cvt_item(p, layer, it - T / 4);
      }
      break;
    case SP_PEERQ: {
      const bf16* W = (const bf16*)(p.ws + OFF_WQ) + (size_t)layer * 2048 * 1024;
      bf16* QP = (bf16*)(p.ws + OFF_QP);
      for_tiles_xcd(T / 256, 16, [&](int mt, int nt) {
        f32x4 acc[2][4][4];
        acc_zero(acc[0]);
        acc_zero(acc[1]);
        gemm256_mainloop(H, 1024, W, 1024, mt * 256, nt * 128, smh, acc);
        const int wv = tidx() >> 6;
        store_tile_bf16(smh, acc[0], QP + (size_t)(mt * 256 + (wv >> 1) * 128) * 2048 + nt * 128 + (wv & 1) * 64, 2048);
        store_tile_bf16(smh, acc[1], QP + (size_t)(mt * 256 + (wv >> 1) * 128 + 64) * 2048 + nt * 128 + (wv & 1) * 64, 2048);
      });
    } break;
    case SP_TOPK:
      for (int it = bid; it < T / 8; it += nb) peer_topk_item3(p, layer, it);
      break;
    case SP_EXPERT:
      for (int it = bid; it < T / 4; it += nb) peer_expert_item2(p, layer, it, second_pass ? 0.f : 1.f);
      break;
  }
}

#if PROBE_ANY
#define MEGA_LB __launch_bounds__(256)
#else
#define MEGA_LB __launch_bounds__(256, 2)
#endif
__global__ void MEGA_LB mega_kernel(Params p, int ph_lo, int ph_hi) {
  __shared__ __attribute__((aligned(16))) char smem_raw[SMEM_BYTES + 16];
  volatile LAS unsigned* xbst = (volatile LAS unsigned*)(smem_raw + SMEM_BYTES);
  if (threadIdx.x == 0) { xbst[0] = 0u; xbst[1] = 0u; xbst[2] = 0u; xbst[3] = 0u; }
  __syncthreads();
  XcdBarrier xb = xcd_barrier_post((unsigned*)(p.ws + OFF_BAR), xbst);
  for (int ph = ph_lo; ph < ph_hi; ++ph) {
#if !PROBE_ANY && !REP_MASK
    if (ph == N_REAL_PHASES - 1 || ph == 1 + PH_PER_LAYER || (ph >= 1 && (ph - 1) % PH_PER_LAYER == SP_KMEAN)) continue;
#endif
#if REP_MASK
    const int nrep = (ph >= 1 && ph < N_REAL_PHASES - 1 && ((REP_MASK >> ((ph - 1) % PH_PER_LAYER)) & 1)) ? 2 : 1;
    for (int rep = 0; rep < nrep; ++rep) {
      if (rep) xcd_barrier(xb);
      run_phase(p, ph, smem_raw, rep != 0);
    }
#else
    run_phase(p, ph, smem_raw);
#endif
    if (ph + 1 < ph_hi) {
      if (ph == ph_lo) cg::this_grid().sync();
      else xcd_barrier(xb);
    }
  }
}

extern "C" void kernel_launch(void* const* d_in, const int* in_sizes, int n_in, void* d_out, int out_size, void* d_ws,
                              size_t ws_size, hipStream_t stream) {
  if (ws_size < WS_TOTAL) {
    fprintf(stderr, "workspace too small: %zu < %zu\n", ws_size, (size_t)WS_NEED);
    return;
  }
  Params p{};
  p.x = (const float*)d_in[0]; p.c = (const float*)d_in[1]; p.w_ada = (const float*)d_in[2];
  p.b_ada = (const float*)d_in[3]; p.g_attn = (const float*)d_in[4]; p.g_ffn = (const float*)d_in[5];
  p.w_in = (const float*)d_in[6]; p.cmp_pe = (const float*)d_in[7]; p.cmp_w1 = (const float*)d_in[8];
  p.cmp_w2 = (const float*)d_in[9]; p.w_up_nsa = (const float*)d_in[10]; p.w_up_moba = (const float*)d_in[11];
  p.w_out = (const float*)d_in[12]; p.peer_wq = (const float*)d_in[13]; p.peer_k1 = (const float*)d_in[14];
  p.peer_k2 = (const float*)d_in[15]; p.peer_u = (const float*)d_in[16]; p.peer_v = (const float*)d_in[17];
  p.g_final = (const float*)d_in[18];
  p.out = (float*)d_out;
  p.ws = (char*)d_ws;
  static int grid_blocks = 0;
  if (!grid_blocks) {
    int dev = 0, cus = 0, per_cu = 0;
    hipGetDevice(&dev);
    hipDeviceGetAttribute(&cus, hipDeviceAttributeMultiprocessorCount, dev);
    hipOccupancyMaxActiveBlocksPerMultiprocessor(&per_cu, mega_kernel, 256, 0);
    if (per_cu < 1) per_cu = 1;
    if (per_cu > 2) per_cu = 2;
    grid_blocks = cus * per_cu;
  }
  hipMemsetAsync((char*)d_ws + OFF_BAR, 0, BAR_BYTES, stream);
  int ph_lo = 0, ph_hi = N_PHASES;
  void* args[] = {(void*)&p, (void*)&ph_lo, (void*)&ph_hi};
  hipError_t e = hipLaunchCooperativeKernel((const void*)mega_kernel, dim3(grid_blocks), dim3(256), args, 0, stream);
  if (e != hipSuccess) fprintf(stderr, "cooperative launch failed: %s (grid %d)\n", hipGetErrorString(e), grid_blocks);
}
```

```cpp
#include <hip/hip_runtime.h>
#include <hip/hip_bf16.h>
#include <hip/hip_cooperative_groups.h>
#include <cstdio>
#include <cstdint>
namespace cg = cooperative_groups;

#define DEV __device__ __forceinline__
typedef unsigned short bf16;
using bf16x8 = __attribute__((ext_vector_type(8))) short;
using f32x4 = __attribute__((ext_vector_type(4))) float;

constexpr int Bn = 2, S = 16384, T = Bn * S, D = 1024;
constexpr int PC = 3456;
constexpr int WN = 4992;
constexpr int C_NQ = 0, C_KC = 512, C_VC = 640, C_MQ = 768, C_GN = 1280, C_GM = 2304, C_NG = 3328;
constexpr int NEXP = 16384;

constexpr size_t al(size_t x) { return (x + 255) & ~size_t(255); }
constexpr size_t OFF_MOD = 0;
constexpr size_t OFF_ROPE = al(OFF_MOD + 2 * 2 * 6144 * 4);
constexpr size_t OFF_PEB = al(OFF_ROPE + (size_t)S * 16 * 4);
constexpr size_t OFF_WINT = al(OFF_PEB + 2 * 2 * 128 * 4);
constexpr size_t OFF_WUPN = al(OFF_WINT + 2ull * WN * 1024 * 2);
constexpr size_t OFF_WUPM = al(OFF_WUPN + 2ull * 1024 * 512 * 2);
constexpr size_t OFF_WOUT = al(OFF_WUPM + 2ull * 1024 * 512 * 2);
constexpr size_t OFF_WQ = al(OFF_WOUT + 2ull * 1024 * 1024 * 2);
constexpr size_t OFF_KCC = al(OFF_WQ + 2ull * 2048 * 1024 * 2);
constexpr size_t OFF_VCC = al(OFF_KCC + 2ull * 1024 * 128 * 4);
constexpr size_t OFF_SEL = al(OFF_VCC + 2ull * 1024 * 128 * 4);
constexpr size_t OFF_KMEAN = al(OFF_SEL + 2ull * 2 * S * 16 * 4);
constexpr size_t OFF_KMHL = al(OFF_KMEAN + 2ull * 8 * 64 * 64 * 4);
constexpr size_t OFF_KCB = al(OFF_KMHL + 2ull * 2 * 8 * 64 * 64 * 2);
constexpr size_t OFF_VCB = al(OFF_KCB + 2ull * 2 * 1024 * 64 * 2);
constexpr size_t OFF_PKB = al(OFF_VCB + 2ull * 2 * 1024 * 64 * 2);
constexpr size_t OFF_W1T = al(OFF_PKB + 2ull * 2 * 128 * 128 * 2);
constexpr size_t OFF_BAR = al(OFF_W1T + 4ull * 128 * 2048 * 2);
constexpr size_t BAR_BYTES = 3456 * 4;
constexpr size_t OFF_PROBE = al(OFF_BAR + BAR_BYTES);
constexpr size_t OFF_H = al(OFF_PROBE + 256);
constexpr size_t OFF_ONSA = al(OFF_H + (size_t)T * 1024 * 2);
constexpr size_t OFF_OMOBA = al(OFF_ONSA + (size_t)T * 512 * 2);
constexpr size_t OFF_PROJ = al(OFF_OMOBA + (size_t)T * 512 * 2);
constexpr size_t KV2_BYTES = (size_t)Bn * 2 * S * 64 * 2, KV8_BYTES = (size_t)Bn * 8 * S * 64 * 2;
constexpr size_t OFF_KSB = al(OFF_PROJ + (size_t)T * PC * 2);
constexpr size_t OFF_VSB = OFF_KSB + KV2_BYTES;
constexpr size_t OFF_KWB = OFF_VSB + KV2_BYTES;
constexpr size_t OFF_VWB = OFF_KWB + KV2_BYTES;
constexpr size_t OFF_MKB = OFF_VWB + KV2_BYTES;
constexpr size_t OFF_MVB = OFF_MKB + KV8_BYTES;
constexpr int MLIST_PER_BH = 63 * S - 128 * 63 * 64;
constexpr size_t OFF_MLIST = OFF_MVB + KV8_BYTES;
constexpr size_t OFF_MCNT = al(OFF_MLIST + (size_t)Bn * 8 * MLIST_PER_BH * 2);
constexpr size_t WS_NEED = OFF_MCNT + (size_t)Bn * 8 * 64 * 4;
constexpr size_t PROJ_BYTES = (size_t)T * PC * 2;
constexpr size_t OFF_MPO = OFF_H;
constexpr size_t OFF_MPML = OFF_H + (size_t)8 * S * 3 * 64 * 2;
static_assert((size_t)8 * S * 3 * 64 * 2 + (size_t)8 * S * 3 * 8 <= (size_t)T * 1024 * 2, "moba partials must fit the H region");
constexpr size_t OFF_QP = OFF_PROJ;
constexpr size_t OFF_PEIDX = al(OFF_QP + (size_t)T * 2048 * 2);
constexpr size_t OFF_PEG = al(OFF_PEIDX + (size_t)T * 128 * 4);
constexpr size_t OFF_E8 = al(OFF_PEG + (size_t)T * 128 * 4);
constexpr size_t OFF_ESC = al(OFF_E8 + (size_t)NEXP * 2048);
static_assert(OFF_ESC + (size_t)NEXP * 2 * 4 <= OFF_PROJ + PROJ_BYTES, "peer alias overflow");
static_assert(WS_NEED <= 536870912ull, "workspace too big");
#ifndef PROBE_MOBA
#define PROBE_MOBA 0
#endif
constexpr size_t OFF_CMP = PROBE_MOBA ? OFF_ONSA : OFF_MLIST;
#ifndef REP_NSA_ONLY
#define REP_NSA_ONLY 0
#endif
#ifndef REP_NSA_PART
#define REP_NSA_PART 0
#endif
#ifndef REP_MASK
#define REP_MASK 0
#endif
#ifndef PROBE_MOBA
#define PROBE_MOBA 0
#endif
#ifndef PROBE_NSA
#define PROBE_NSA 0
#endif
#ifndef PROBE_CMPR
#define PROBE_CMPR 0
#endif
#ifndef PROBE_PROJ
#define PROBE_PROJ 0
#endif
#define PROBE_ANY (PROBE_MOBA || PROBE_NSA || PROBE_CMPR || PROBE_PROJ)
constexpr size_t WS_TOTAL = WS_NEED;
static_assert(WS_TOTAL <= 536870912ull, "workspace too big (probe)");

struct Params {
  const float *x, *c, *w_ada, *b_ada, *g_attn, *g_ffn, *w_in, *cmp_pe, *cmp_w1, *cmp_w2, *w_up_nsa, *w_up_moba, *w_out,
      *peer_wq, *peer_k1, *peer_k2, *peer_u, *peer_v, *g_final;
  float* out;
  char* ws;
};

constexpr int SMEM_BYTES = 74 * 1024;

DEV int tidx() {
  int t = threadIdx.x;
  asm volatile("" : "+v"(t));
  return t;
}
#define MFMA16B(a, b, c) __builtin_amdgcn_mfma_f32_16x16x32_bf16(a, b, c, 0, 0, 0)
DEV unsigned cvtpk_(float lo, float hi) {
  unsigned r;
  asm("v_cvt_pk_bf16_f32 %0, %1, %2" : "=v"(r) : "v"(lo), "v"(hi));
  return r;
}
DEV float bf2f(bf16 h) { return __uint_as_float(((unsigned)h) << 16); }
DEV bf16 f2bf(float f) {
  unsigned u = __float_as_uint(f);
  u += 0x7fffu + ((u >> 16) & 1u);
  return (bf16)(u >> 16);
}
DEV float gelu_tanh(float x) {
  float u = 0.7978845608028654f * (x + 0.044715f * x * x * x);
  return 0.5f * x * (1.f + tanhf(u));
}
DEV float sigmoidf_(float x) { return 1.f / (1.f + expf(-x)); }
DEV void unpack8(uint4 v, float* f) {
  f[0] = __uint_as_float(v.x << 16); f[1] = __uint_as_float(v.x & 0xffff0000u);
  f[2] = __uint_as_float(v.y << 16); f[3] = __uint_as_float(v.y & 0xffff0000u);
  f[4] = __uint_as_float(v.z << 16); f[5] = __uint_as_float(v.z & 0xffff0000u);
  f[6] = __uint_as_float(v.w << 16); f[7] = __uint_as_float(v.w & 0xffff0000u);
}
DEV float dot64_bf(const float* q, const bf16* row) {
  float s = 0.f;
#pragma unroll
  for (int i = 0; i < 8; ++i) {
    float f[8];
    unpack8(*(const uint4*)(row + i * 8), f);
#pragma unroll
    for (int j = 0; j < 8; ++j) s += q[i * 8 + j] * f[j];
  }
  return s;
}
DEV void axpy64_bf(float* o, float a, const bf16* row) {
#pragma unroll
  for (int i = 0; i < 8; ++i) {
    float f[8];
    unpack8(*(const uint4*)(row + i * 8), f);
#pragma unroll
    for (int j = 0; j < 8; ++j) o[i * 8 + j] += a * f[j];
  }
}
DEV float dot64_f(const float* q, const float* row) {
  float s = 0.f;
#pragma unroll
  for (int i = 0; i < 16; ++i) {
    float4 v = *(const float4*)(row + i * 4);
    s += q[i * 4] * v.x + q[i * 4 + 1] * v.y + q[i * 4 + 2] * v.z + q[i * 4 + 3] * v.w;
  }
  return s;
}
DEV void axpy64_f(float* o, float a, const float* row) {
#pragma unroll
  for (int i = 0; i < 16; ++i) {
    float4 v = *(const float4*)(row + i * 4);
    o[i * 4] += a * v.x; o[i * 4 + 1] += a * v.y; o[i * 4 + 2] += a * v.z; o[i * 4 + 3] += a * v.w;
  }
}
DEV void load_q64(float* q, const bf16* p, float scale) {
#pragma unroll
  for (int i = 0; i < 8; ++i) unpack8(*(const uint4*)(p + i * 8), q + i * 8);
#pragma unroll
  for (int i = 0; i < 64; ++i) q[i] *= scale;
}
DEV int lane_id_() { return __builtin_amdgcn_mbcnt_hi(~0u, __builtin_amdgcn_mbcnt_lo(~0u, 0u)); }
DEV int shx(int v, int m) {
  if (m == 1) return __builtin_amdgcn_update_dpp(0, v, 0xB1, 0xF, 0xF, true);
  if (m == 2) return __builtin_amdgcn_update_dpp(0, v, 0x4E, 0xF, 0xF, true);
  if (m == 4) return __builtin_amdgcn_ds_swizzle(v, 0x101F);
  if (m == 8) return __builtin_amdgcn_update_dpp(0, v, 0x128, 0xF, 0xF, true);
  if (m == 16) return __builtin_amdgcn_ds_swizzle(v, 0x401F);
  auto rr = __builtin_amdgcn_permlane32_swap((unsigned)v, (unsigned)v, false, false);
  return (lane_id_() < 32) ? (int)rr[1] : (int)rr[0];
}
DEV unsigned shx(unsigned v, int m) { return (unsigned)shx((int)v, m); }
DEV float shx(float v, int m) { return __int_as_float(shx(__float_as_int(v), m)); }
DEV float wave_sum(float v) {
#pragma unroll
  for (int o = 32; o >= 1; o >>= 1) v += shx(v, o);
  return v;
}

#define XB_TMO      128
#define XB_XCNT(j)  (256  + 64 * (j))
#define XB_XSUB(j)  (1280 + 64 * (j))
#define XB_XGEN(j)  (2304 + 64 * (j))
#define XB_TOP      3328
#define XB_TOPGEN   3392
#define XCD_BAR_WORDS 3456
#define XB_SPIN_CAP (1u << 18)
#define LAS __attribute__((address_space(3)))

__device__ __forceinline__ unsigned xb_ld(unsigned* p)              { return __hip_atomic_load(p, __ATOMIC_RELAXED, __HIP_MEMORY_SCOPE_AGENT); }
__device__ __forceinline__ unsigned xb_add(unsigned* p, unsigned v) { return __hip_atomic_fetch_add(p, v, __ATOMIC_RELAXED, __HIP_MEMORY_SCOPE_AGENT); }
__device__ __forceinline__ unsigned xb_xcc_id() { return (unsigned)__builtin_amdgcn_s_getreg((3 << 11) | 20) & 0xFu; }
#define XB_SPIN(cond, bar) do { unsigned _sp = 0; while (cond) { __builtin_amdgcn_s_sleep(1); \
    if ((++_sp & 255u) == 0u) { if (xb_ld(&(bar)[XB_TMO])) break; if (_sp > XB_SPIN_CAP) { atomicAdd(&(bar)[XB_TMO], 1u); break; } } } } while (0)

struct XcdBarrier {
    unsigned* bar; unsigned x;
    volatile LAS unsigned* st;
};

__device__ __forceinline__ XcdBarrier xcd_barrier_post(unsigned* bar, volatile LAS unsigned* st) {
    XcdBarrier b; b.bar = bar; b.x = xb_xcc_id(); b.st = st;
    if (tidx() == 0) (void)xb_add(&bar[XB_XCNT(b.x)], 1u);
    return b;
}
__device__ __forceinline__ void xcd_barrier_complete(unsigned* bar, unsigned x, unsigned& nloc, unsigned& nx) {
    const unsigned G = gridDim.x * gridDim.y * gridDim.z;
    unsigned sum, cnt, mine, sp = 0u;
    for (;;) {
        sum = 0u; cnt = 0u; mine = 0u;
#pragma unroll
        for (unsigned j = 0; j < 16; ++j) { const unsigned c = xb_ld(&bar[XB_XCNT(j)]); sum += c; cnt += (c > 0u) ? 1u : 0u; mine = (j == x) ? c : mine; }
        if (sum == G) break;
        __builtin_amdgcn_s_sleep(1);
        if ((++sp & 255u) == 0u) { if (xb_ld(&bar[XB_TMO])) break; if (sp > XB_SPIN_CAP) { atomicAdd(&bar[XB_TMO], 1u); break; } }
    }
    nloc = mine > 0u ? mine : 1u; nx = cnt > 0u ? cnt : 1u;
}

__device__ __forceinline__ void xcd_barrier(const XcdBarrier& b) {
    asm volatile("s_waitcnt vmcnt(0)" ::: "memory");
    __syncthreads();
    if (tidx() == 0) {
        unsigned* bar = b.bar;
        __builtin_amdgcn_s_waitcnt(0);
        unsigned nloc = b.st[0], nx = b.st[1];
        if (nloc == 0u) { xcd_barrier_complete(bar, b.x, nloc, nx); b.st[0] = nloc; b.st[1] = nx; }
        const unsigned old = xb_add(&bar[XB_XSUB(b.x)], 1u);
        const unsigned gen = old / nloc;
        if (old + 1u == (gen + 1u) * nloc) {
            __builtin_amdgcn_fence(__ATOMIC_RELEASE, "agent");
            asm volatile("s_waitcnt vmcnt(0)" ::: "memory");
            const unsigned og = xb_add(&bar[XB_TOP], 1u);
            const unsigned tg = og / nx;
            if (og + 1u == (tg + 1u) * nx) xb_add(&bar[XB_TOPGEN], 1u);
            else XB_SPIN(xb_ld(&bar[XB_TOPGEN]) == tg, bar);
            __builtin_amdgcn_fence(__ATOMIC_ACQUIRE, "agent");
            xb_add(&bar[XB_XGEN(b.x)], 1u);
            asm volatile("s_waitcnt vmcnt(0)" ::: "memory");
        } else {
            XB_SPIN(xb_ld(&bar[XB_XGEN(b.x)]) == gen, bar);
            __builtin_amdgcn_fence(__ATOMIC_ACQUIRE, "agent");
            asm volatile("s_waitcnt vmcnt(0)" ::: "memory");
        }
    }
    __syncthreads();
}


DEV int win_col_map(int j) {
  if (j < 1280) return j;
  if (j < 4864) return j + 24;
  if (j < 4888) return j - 4864 + 1280;
  return -1;
}
DEV void tr_tile(const float* __restrict__ src, int ldsrc, int K, bf16* __restrict__ dst, int kt, int nt, bool remap,
                 float* sm) {
  const int tid = tidx();
#pragma unroll 4
  for (int i = 0; i < 16; ++i) {
    int r = i * 4 + (tid >> 6), cx = tid & 63;
    int j = nt * 64 + cx, k = kt * 64 + r;
    int oc = remap ? win_col_map(j) : j;
    sm[r * 65 + cx] = (oc >= 0) ? src[(size_t)k * ldsrc + oc] : 0.f;
  }
  __syncthreads();
#pragma unroll 4
  for (int i = 0; i < 16; ++i) {
    int n = i * 4 + (tid >> 6), kk = tid & 63;
    dst[(size_t)(nt * 64 + n) * K + kt * 64 + kk] = f2bf(sm[kk * 65 + n]);
  }
  __syncthreads();
}

constexpr int PREP_TR_WIN = 2 * 78 * 16;
constexpr int PREP_TR_UPN = 2 * 16 * 8;
constexpr int PREP_TR_UPM = 2 * 16 * 8;
constexpr int PREP_TR_OUT = 2 * 16 * 16;
constexpr int PREP_TR_WQ = 2 * 32 * 16;
constexpr int PREP_ROPE = 512;
constexpr int PREP_MOD = 384;
constexpr int PREP_PEB = 16;
constexpr int PREP_PK = 32;
constexpr int PREP_TR_W1 = 4 * 2 * 32;
constexpr int PREP_ITEMS = PREP_TR_WIN + PREP_TR_UPN + PREP_TR_UPM + PREP_TR_OUT + PREP_TR_WQ + PREP_ROPE + PREP_MOD + PREP_PEB + PREP_PK + PREP_TR_W1;

DEV void prep_item(const Params& p, int item, float* sm) {
  const int tid = tidx();
  if (item < PREP_TR_WIN) {
    int l = item / (78 * 16), r = item % (78 * 16);
    int nt = r / 16, kt = r % 16;
    tr_tile(p.w_in + (size_t)l * 1024 * 4888, 4888, 1024, (bf16*)(p.ws + OFF_WINT) + (size_t)l * WN * 1024, kt, nt, true, sm);
    return;
  }
  item -= PREP_TR_WIN;
  if (item < PREP_TR_UPN) {
    int l = item / 128, r = item % 128;
    int nt = r / 8, kt = r % 8;
    tr_tile(p.w_up_nsa + (size_t)l * 512 * 1024, 1024, 512, (bf16*)(p.ws + OFF_WUPN) + (size_t)l * 1024 * 512, kt, nt, false, sm);
    return;
  }
  item -= PREP_TR_UPN;
  if (item < PREP_TR_UPM) {
    int l = item / 128, r = item % 128;
    int nt = r / 8, kt = r % 8;
    tr_tile(p.w_up_moba + (size_t)l * 512 * 1024, 1024, 512, (bf16*)(p.ws + OFF_WUPM) + (size_t)l * 1024 * 512, kt, nt, false, sm);
    return;
  }
  item -= PREP_TR_UPM;
  if (item < PREP_TR_OUT) {
    int l = item / 256, r = item % 256;
    int nt = r / 16, kt = r % 16;
    tr_tile(p.w_out + (size_t)l * 1024 * 1024, 1024, 1024, (bf16*)(p.ws + OFF_WOUT) + (size_t)l * 1024 * 1024, kt, nt, false, sm);
    return;
  }
  item -= PREP_TR_OUT;
  if (item < PREP_TR_WQ) {
    int l = item / 512, r = item % 512;
    int nt = r / 16, kt = r % 16;
    tr_tile(p.peer_wq + (size_t)l * 1024 * 2048, 2048, 1024, (bf16*)(p.ws + OFF_WQ) + (size_t)l * 2048 * 1024, kt, nt, false, sm);
    return;
  }
  item -= PREP_TR_WQ;
  if (item < PREP_ROPE) {
    int idx = item * 256 + tid;
    int pos = idx >> 3, i = idx & 7;
    float inv = powf(500000.0f, -(float)i / 8.0f);
    float ang = (float)pos * inv;
    float* rp = (float*)(p.ws + OFF_ROPE) + (size_t)pos * 16;
    rp[i] = cosf(ang);
    rp[8 + i] = sinf(ang);
    return;
  }
  item -= PREP_ROPE;
  if (item < PREP_MOD) {
    for (int i = tid; i < 2048; i += 256) {
      float cv = p.c[i];
      sm[i] = cv / (1.f + expf(-cv));
    }
    __syncthreads();
    const int l = item / 192, n0 = (item % 192) * 32;
    const int col = tid & 31, ks = tid >> 5;
    const float* w = p.w_ada + (size_t)l * 1024 * 6144 + n0 + col;
    float a0 = 0.f, a1 = 0.f;
#pragma unroll 8
    for (int k = ks * 128; k < ks * 128 + 128; ++k) {
      float wv = w[(size_t)k * 6144];
      a0 += sm[k] * wv;
      a1 += sm[1024 + k] * wv;
    }
    sm[2048 + tid * 2] = a0;
    sm[2048 + tid * 2 + 1] = a1;
    __syncthreads();
    if (tid < 64) {
      const int c2 = tid & 31, bs = tid >> 5;
      float s = 0.f;
#pragma unroll
      for (int q = 0; q < 8; ++q) s += sm[2048 + (q * 32 + c2) * 2 + bs];
      ((float*)(p.ws + OFF_MOD))[(l * 2 + bs) * 6144 + n0 + c2] = s + p.b_ada[l * 6144 + n0 + c2];
    }
    __syncthreads();
    return;
  }
  item -= PREP_MOD;
  if (item < PREP_PEB) {
    const int lw = item >> 2, j0 = (item & 3) * 32;
    const int col = tid & 31, ks = tid >> 5;
    const float* pe = p.cmp_pe + (size_t)lw * 2048;
    const float* w1 = p.cmp_w1 + (size_t)lw * 2048 * 128 + j0 + col;
    float a = 0.f;
#pragma unroll 8
    for (int i = ks * 256; i < ks * 256 + 256; ++i) a += pe[i] * w1[(size_t)i * 128];
    sm[tid] = a;
    __syncthreads();
    if (tid < 32) {
      float s = 0.f;
#pragma unroll
      for (int q = 0; q < 8; ++q) s += sm[q * 32 + tid];
      ((float*)(p.ws + OFF_PEB))[lw * 128 + j0 + tid] = s;
    }
    if (item == 0 && tid < 4) ((float*)(p.ws + OFF_PROBE))[tid] = 0.f;
    __syncthreads();
    return;
  }
  item -= PREP_PEB;
  if (item < PREP_PK) {
    const int e0 = item * 2048 + tid * 8;
    const int lt = e0 >> 14, off = e0 & 16383;
    const float* srcp = ((lt & 1) ? p.peer_k2 : p.peer_k1) + (size_t)(lt >> 1) * 16384 + off;
    const float4 a = *(const float4*)srcp, b4 = *(const float4*)(srcp + 4);
    uint4 pk;
    pk.x = (unsigned)f2bf(a.x) | ((unsigned)f2bf(a.y) << 16);
    pk.y = (unsigned)f2bf(a.z) | ((unsigned)f2bf(a.w) << 16);
    pk.z = (unsigned)f2bf(b4.x) | ((unsigned)f2bf(b4.y) << 16);
    pk.w = (unsigned)f2bf(b4.z) | ((unsigned)f2bf(b4.w) << 16);
    *(uint4*)((bf16*)(p.ws + OFF_PKB) + e0) = pk;
    return;
  }
  item -= PREP_PK;
  {
    const int lw = item >> 6, r = item & 63;
    const int nt = r >> 5, kt = r & 31;
    tr_tile(p.cmp_w1 + (size_t)lw * 2048 * 128, 128, 2048, (bf16*)(p.ws + OFF_W1T) + (size_t)lw * 128 * 2048, kt, nt, false, sm);
  }
}

DEV void norm_item(const float* __restrict__ xin, const float* __restrict__ g, const float* __restrict__ sc,
                   const float* __restrict__ sh, bf16* __restrict__ hout, int item) {
  const int lane = tidx() & 63, wave = tidx() >> 6;
  const size_t tok = (size_t)item * 4 + wave;
  const int b = (int)(tok / S);
  const float* xr = xin + tok * 1024;
  float4 v[4];
  float ss = 0.f;
#pragma unroll
  for (int i = 0; i < 4; ++i) {
    v[i] = *(const float4*)(xr + i * 256 + lane * 4);
    ss += v[i].x * v[i].x + v[i].y * v[i].y + v[i].z * v[i].z + v[i].w * v[i].w;
  }
  ss = wave_sum(ss);
  float r = 1.0f / sqrtf(ss * (1.0f / 1024.f) + 1e-6f);
#pragma unroll
  for (int i = 0; i < 4; ++i) {
    int d = i * 256 + lane * 4;
    float4 gg = *(const float4*)(g + d);
    float4 s4 = *(const float4*)(sc + b * 6144 + d);
    float4 h4 = *(const float4*)(sh + b * 6144 + d);
    float o0 = v[i].x * r * gg.x * (1.f + s4.x) + h4.x;
    float o1 = v[i].y * r * gg.y * (1.f + s4.y) + h4.y;
    float o2 = v[i].z * r * gg.z * (1.f + s4.z) + h4.z;
    float o3 = v[i].w * r * gg.w * (1.f + s4.w) + h4.w;
    uint2 pk;
    pk.x = (unsigned)f2bf(o0) | ((unsigned)f2bf(o1) << 16);
    pk.y = (unsigned)f2bf(o2) | ((unsigned)f2bf(o3) << 16);
    *(uint2*)(hout + tok * 1024 + d) = pk;
  }
}
DEV void final_norm_item(float* __restrict__ x, const float* __restrict__ g, int item) {
  const int lane = tidx() & 63, wave = tidx() >> 6;
  const size_t tok = (size_t)item * 4 + wave;
  float* xr = x + tok * 1024;
  float4 v[4];
  float ss = 0.f;
#pragma unroll
  for (int i = 0; i < 4; ++i) {
    v[i] = *(const float4*)(xr + i * 256 + lane * 4);
    ss += v[i].x * v[i].x + v[i].y * v[i].y + v[i].z * v[i].z + v[i].w * v[i].w;
  }
  ss = wave_sum(ss);
  float r = 1.0f / sqrtf(ss * (1.0f / 1024.f) + 1e-6f);
#pragma unroll
  for (int i = 0; i < 4; ++i) {
    int d = i * 256 + lane * 4;
    float4 gg = *(const float4*)(g + d);
    float4 o;
    o.x = v[i].x * r * gg.x; o.y = v[i].y * r * gg.y; o.z = v[i].z * r * gg.z; o.w = v[i].w * r * gg.w;
    *(float4*)(xr + d) = o;
  }
}

#define GM_BUF (2 * 128 * 72)
#define GM_LOAD(R, kk)                                                                                  \
  {                                                                                                     \
    const bf16* Ak = Ap + (kk);                                                                         \
    const bf16* Wk = Wp + (kk);                                                                         \
    R##a0 = *(const uint4*)(Ak); R##a1 = *(const uint4*)(Ak + a32); R##a2 = *(const uint4*)(Ak + 2 * a32); \
    R##a3 = *(const uint4*)(Ak + 3 * a32);                                                              \
    R##b0 = *(const uint4*)(Wk); R##b1 = *(const uint4*)(Wk + w32); R##b2 = *(const uint4*)(Wk + 2 * w32); \
    R##b3 = *(const uint4*)(Wk + 3 * w32);                                                              \
  }
#define GM_STORE(R, buf)                                                                                \
  {                                                                                                     \
    bf16* as_ = Asw + (buf) * GM_BUF;                                                                   \
    bf16* bs_ = as_ + 128 * 72;                                                                         \
    *(uint4*)(as_) = R##a0; *(uint4*)(as_ + 32 * 72) = R##a1; *(uint4*)(as_ + 64 * 72) = R##a2; *(uint4*)(as_ + 96 * 72) = R##a3; \
    *(uint4*)(bs_) = R##b0; *(uint4*)(bs_ + 32 * 72) = R##b1; *(uint4*)(bs_ + 64 * 72) = R##b2; *(uint4*)(bs_ + 96 * 72) = R##b3; \
  }
#define GM_COMPUTE(buf)                                                                                 \
  {                                                                                                     \
    const bf16* As_ = sm + (buf) * GM_BUF;                                                              \
    const bf16* Bs_ = As_ + 128 * 72;                                                                   \
    _Pragma("unroll") for (int ks = 0; ks < 2; ++ks) {                                                  \
      __builtin_amdgcn_sched_barrier(0);                                                                \
      bf16x8 af[4], bfr[4];                                                                             \
      _Pragma("unroll") for (int mi = 0; mi < 4; ++mi)                                                  \
        af[mi] = *(const bf16x8*)(As_ + (wr * 64 + mi * 16 + (lane & 15)) * 72 + ks * 32 + (lane >> 4) * 8); \
      _Pragma("unroll") for (int ni = 0; ni < 4; ++ni)                                                  \
        bfr[ni] = *(const bf16x8*)(Bs_ + (wc * 64 + ni * 16 + (lane & 15)) * 72 + ks * 32 + (lane >> 4) * 8); \
      _Pragma("unroll") for (int mi = 0; mi < 4; ++mi)                                                  \
        _Pragma("unroll") for (int ni = 0; ni < 4; ++ni)                                                \
          acc[mi][ni] = __builtin_amdgcn_mfma_f32_16x16x32_bf16(af[mi], bfr[ni], acc[mi][ni], 0, 0, 0); \
    }                                                                                                   \
    __builtin_amdgcn_sched_barrier(0);                                                                  \
  }
DEV void gemm_mainloop(const bf16* __restrict__ A, int lda, const bf16* __restrict__ W, int K, int m0, int n0, bf16* sm,
                       f32x4 (&acc)[4][4]) {
  const int tid = tidx(), lane = tid & 63, wave = tid >> 6;
  const int wr = wave >> 1, wc = wave & 1;
  const int lrow = tid >> 3, lkc = (tid & 7) * 8;
  const bf16* Ap = A + (size_t)(m0 + lrow) * lda + lkc;
  const bf16* Wp = W + (size_t)(n0 + lrow) * K + lkc;
  const int a32 = 32 * lda, w32 = 32 * K;
  bf16* Asw = sm + lrow * 72 + lkc;
  uint4 xa0, xa1, xa2, xa3, xb0, xb1, xb2, xb3, ya0, ya1, ya2, ya3, yb0, yb1, yb2, yb3;
  const int nk = K >> 6;
  GM_LOAD(x, 0)
  GM_LOAD(y, 64)
  __syncthreads();
  GM_STORE(x, 0)
  if (nk > 2) GM_LOAD(x, 128)
  __syncthreads();
  for (int k = 0; k < nk; k += 2) {
    GM_COMPUTE(0)
    GM_STORE(y, 1)
    if (k + 3 < nk) GM_LOAD(y, (k + 3) * 64)
    __syncthreads();
    GM_COMPUTE(1)
    if (k + 2 < nk) {
      GM_STORE(x, 0)
      if (k + 4 < nk) GM_LOAD(x, (k + 4) * 64)
    }
    __syncthreads();
  }
}
DEV void gemm256_mainloop(const bf16* __restrict__ A, int lda, const bf16* __restrict__ W, int K, int m0, int n0, bf16* sm,
                          f32x4 (&acc)[2][4][4]) {
  bf16* As = sm;
  bf16* Bs = sm + 256 * 72;
  const int tid = tidx(), lane = tid & 63, wave = tid >> 6;
  const int wr = wave >> 1, wc = wave & 1;
  const int lrow = tid >> 3, lkc = (tid & 7) * 8;
  const bf16* Ap = A + (size_t)(m0 + lrow) * lda + lkc;
  const bf16* Wp = W + (size_t)(n0 + lrow) * K + lkc;
  const int a32 = 32 * lda, w32 = 32 * K;
  uint4 ra0, ra1, ra2, ra3, ra4, ra5, ra6, ra7, rb0, rb1, rb2, rb3;
#define G256_LOAD(kk)                                                                                   \
  {                                                                                                     \
    const bf16* Ak = Ap + (kk);                                                                         \
    const bf16* Wk = Wp + (kk);                                                                         \
    ra0 = *(const uint4*)(Ak); ra1 = *(const uint4*)(Ak + a32); ra2 = *(const uint4*)(Ak + 2 * a32);    \
    ra3 = *(const uint4*)(Ak + 3 * a32); ra4 = *(const uint4*)(Ak + 4 * a32); ra5 = *(const uint4*)(Ak + 5 * a32); \
    ra6 = *(const uint4*)(Ak + 6 * a32); ra7 = *(const uint4*)(Ak + 7 * a32);                           \
    rb0 = *(const uint4*)(Wk); rb1 = *(const uint4*)(Wk + w32); rb2 = *(const uint4*)(Wk + 2 * w32);    \
    rb3 = *(const uint4*)(Wk + 3 * w32);                                                                \
  }
  G256_LOAD(0)
  bf16* Asw = As + lrow * 72 + lkc;
  bf16* Bsw = Bs + lrow * 72 + lkc;
  for (int k0 = 0; k0 < K; k0 += 64) {
    __syncthreads();
    *(uint4*)(Asw) = ra0; *(uint4*)(Asw + 32 * 72) = ra1; *(uint4*)(Asw + 64 * 72) = ra2; *(uint4*)(Asw + 96 * 72) = ra3;
    *(uint4*)(Asw + 128 * 72) = ra4; *(uint4*)(Asw + 160 * 72) = ra5; *(uint4*)(Asw + 192 * 72) = ra6; *(uint4*)(Asw + 224 * 72) = ra7;
    *(uint4*)(Bsw) = rb0; *(uint4*)(Bsw + 32 * 72) = rb1; *(uint4*)(Bsw + 64 * 72) = rb2; *(uint4*)(Bsw + 96 * 72) = rb3;
    __syncthreads();
    if (k0 + 64 < K) G256_LOAD(k0 + 64)
#pragma unroll
    for (int ks = 0; ks < 2; ++ks) {
      bf16x8 bfr[4];
#pragma unroll
      for (int ni = 0; ni < 4; ++ni)
        bfr[ni] = *(const bf16x8*)(Bs + (wc * 64 + ni * 16 + (lane & 15)) * 72 + ks * 32 + (lane >> 4) * 8);
#pragma unroll
      for (int h = 0; h < 2; ++h) {
        __builtin_amdgcn_sched_barrier(0);
        bf16x8 af[4];
#pragma unroll
        for (int mi = 0; mi < 4; ++mi)
          af[mi] = *(const bf16x8*)(As + (wr * 128 + h * 64 + mi * 16 + (lane & 15)) * 72 + ks * 32 + (lane >> 4) * 8);
#pragma unroll
        for (int mi = 0; mi < 4; ++mi)
#pragma unroll
          for (int ni = 0; ni < 4; ++ni)
            acc[h][mi][ni] = __builtin_amdgcn_mfma_f32_16x16x32_bf16(af[mi], bfr[ni], acc[h][mi][ni], 0, 0, 0);
      }
    }
  }
}
DEV void acc_zero(f32x4 (&acc)[4][4]) {
#pragma unroll
  for (int i = 0; i < 4; ++i)
#pragma unroll
    for (int j = 0; j < 4; ++j) acc[i][j] = f32x4{0.f, 0.f, 0.f, 0.f};
}
DEV void store_tile_bf16(bf16* sm, const f32x4 (&acc)[4][4], bf16* __restrict__ dbase, size_t dstride) {
  const int tid = tidx(), lane = tid & 63, wave = tid >> 6, g4 = lane >> 4, c16 = lane & 15;
  bf16* Cw = sm + wave * (64 * 72);
  __syncthreads();
#pragma unroll
  for (int mi = 0; mi < 4; ++mi)
#pragma unroll
    for (int ni = 0; ni < 4; ++ni)
#pragma unroll
      for (int r = 0; r < 4; ++r) Cw[(mi * 16 + g4 * 4 + r) * 72 + ni * 16 + c16] = f2bf(acc[mi][ni][r]);
  __syncthreads();
#pragma unroll
  for (int it = 0; it < 8; ++it) {
    const int row_l = it * 8 + (lane >> 3), ch = lane & 7;
    const uint4 v = *(const uint4*)(Cw + row_l * 72 + ch * 8);
    *(uint4*)(dbase + (size_t)row_l * dstride + ch * 8) = v;
  }
}
template <class Epi>
DEV void gemm_tile(const bf16* __restrict__ A, int lda, const bf16* __restrict__ W, int K, int m0, int n0, bf16* sm,
                   Epi epi) {
  f32x4 acc[4][4];
  acc_zero(acc);
  gemm_mainloop(A, lda, W, K, m0, n0, sm, acc);
  const int tid = tidx(), lane = tid & 63, wave = tid >> 6;
  const int wr = wave >> 1, wc = wave & 1;
#pragma unroll
  for (int mi = 0; mi < 4; ++mi)
#pragma unroll
    for (int ni = 0; ni < 4; ++ni)
#pragma unroll
      for (int r = 0; r < 4; ++r) {
        int row = m0 + wr * 64 + mi * 16 + (lane >> 4) * 4 + r;
        int col = n0 + wc * 64 + ni * 16 + (lane & 15);
        epi(row, col, acc[mi][ni][r]);
      }
}
DEV void inproj_epilogue(const Params& p, f32x4 (&acc)[4][4], int row0, int vc0, bf16* sm) {
  const int tid = tidx(), lane = tid & 63, g4 = lane >> 4, c16 = lane & 15;
  const int b = row0 / S, t0 = row0 % S;
  bf16* dbase;
  size_t dstride;
  bool roped = false;
  bf16* projp = (bf16*)(p.ws + OFF_PROJ) + (size_t)row0 * PC;
  if (vc0 < 768) { dbase = projp + vc0; dstride = PC; }
  else if (vc0 < 1280) {
    const int seg = (vc0 - 768) >> 7, head = ((vc0 - 768) >> 6) & 1;
    const size_t off = (seg == 0) ? OFF_KSB : (seg == 1) ? OFF_VSB : (seg == 2) ? OFF_KWB : OFF_VWB;
    dbase = (bf16*)(p.ws + off) + ((size_t)(b * 2 + head) * S + t0) * 64;
    dstride = 64;
    roped = (seg == 0) || (seg == 2);
  } else if (vc0 < 1792) { dbase = projp + C_MQ + (vc0 - 1280); dstride = PC; roped = true; }
  else if (vc0 < 2816) {
    const int seg = (vc0 - 1792) >> 9, head = ((vc0 - 1792) >> 6) & 7;
    dbase = (bf16*)(p.ws + (seg ? OFF_MVB : OFF_MKB)) + ((size_t)(b * 8 + head) * S + t0) * 64;
    dstride = 64;
    roped = (seg == 0);
  } else if (vc0 < 4864) { dbase = projp + C_GN + (vc0 - 2816); dstride = PC; }
  else { dbase = projp + C_NG + (vc0 - 4864); dstride = PC; }
  if (roped) {
    const float* rope = (const float*)(p.ws + OFF_ROPE);
#pragma unroll
    for (int mi = 0; mi < 4; ++mi)
#pragma unroll
      for (int r = 0; r < 4; ++r) {
        const int pos = t0 + mi * 16 + g4 * 4 + r;
        const float v = acc[mi][0][r];
        const float pv = shx(v, 8);
        const float cs = rope[pos * 16 + (c16 & 7)], sn = rope[pos * 16 + 8 + (c16 & 7)];
        acc[mi][0][r] = (c16 < 8) ? (v * cs - pv * sn) : (v * cs + pv * sn);
      }
  }
  store_tile_bf16(sm, acc, dbase, dstride);
}
DEV void inproj_tile256(const Params& p, int layer, int m0, int n0, bf16* sm) {
  f32x4 acc[2][4][4];
  acc_zero(acc[0]);
  acc_zero(acc[1]);
  gemm256_mainloop((const bf16*)(p.ws + OFF_H), 1024, (const bf16*)(p.ws + OFF_WINT) + (size_t)layer * WN * 1024, 1024, m0, n0, sm, acc);
  const int wave = tidx() >> 6, wr = wave >> 1, wc = wave & 1;
  inproj_epilogue(p, acc[0], m0 + wr * 128, n0 + wc * 64, sm);
  inproj_epilogue(p, acc[1], m0 + wr * 128 + 64, n0 + wc * 64, sm);
}
typedef unsigned u32x2_t __attribute__((ext_vector_type(2)));
DEV void merge_tile(const Params& p, int layer, int m0, int n0, bf16* sm) {
  const int tid = tidx(), lane = tid & 63, wave = tid >> 6, g4 = lane >> 4, c16 = lane & 15;
  const int wr = wave >> 1, wc = wave & 1;
  const bf16* projg = (const bf16*)(p.ws + OFF_PROJ) + (size_t)(m0 + wr * 64 + g4 * 4) * PC + n0 + wc * 64 + c16;
  f32x4 acc[4][4];
  acc_zero(acc);
  gemm_mainloop((const bf16*)(p.ws + OFF_ONSA), 512, (const bf16*)(p.ws + OFF_WUPN) + (size_t)layer * 1024 * 512, 512, m0, n0, sm, acc);
  bf16* yg = (bf16*)(p.ws + OFF_H) + (size_t)(m0 + wr * 64 + g4 * 4) * 1024 + n0 + wc * 64 + c16;
#pragma unroll
  for (int mi = 0; mi < 4; ++mi)
#pragma unroll
    for (int ni = 0; ni < 4; ++ni)
#pragma unroll
      for (int r = 0; r < 4; ++r)
        yg[(size_t)(mi * 16 + r) * 1024 + ni * 16] =
            f2bf(sigmoidf_(bf2f(projg[(size_t)(mi * 16 + r) * PC + C_GN + ni * 16])) * acc[mi][ni][r]);
  acc_zero(acc);
  gemm_mainloop((const bf16*)(p.ws + OFF_OMOBA), 512, (const bf16*)(p.ws + OFF_WUPM) + (size_t)layer * 1024 * 512, 512, m0, n0, sm, acc);
#pragma unroll
  for (int mi = 0; mi < 4; ++mi)
#pragma unroll
    for (int ni = 0; ni < 4; ++ni)
#pragma unroll
      for (int r = 0; r < 4; ++r)
        acc[mi][ni][r] = bf2f(yg[(size_t)(mi * 16 + r) * 1024 + ni * 16]) +
                         sigmoidf_(bf2f(projg[(size_t)(mi * 16 + r) * PC + C_GM + ni * 16])) * acc[mi][ni][r];
  store_tile_bf16(sm, acc, (bf16*)(p.ws + OFF_H) + (size_t)(m0 + wr * 64) * 1024 + n0 + wc * 64, 1024);
}

DEV void merge_tile256(const Params& p, int layer, int m0, int n0, bf16* sm) {
  const int tid = tidx(), lane = tid & 63, wave = tid >> 6, g4 = lane >> 4, c16 = lane & 15;
  const int wr = wave >> 1, wc = wave & 1;
  f32x4 acc[2][4][4];
  acc_zero(acc[0]);
  acc_zero(acc[1]);
  gemm256_mainloop((const bf16*)(p.ws + OFF_ONSA), 512, (const bf16*)(p.ws + OFF_WUPN) + (size_t)layer * 1024 * 512, 512, m0, n0, sm, acc);
#pragma unroll
  for (int h = 0; h < 2; ++h) {
    const size_t rb = (size_t)(m0 + wr * 128 + h * 64 + g4 * 4);
    const bf16* projg = (const bf16*)(p.ws + OFF_PROJ) + rb * PC + n0 + wc * 64 + c16;
    bf16* yg = (bf16*)(p.ws + OFF_H) + rb * 1024 + n0 + wc * 64 + c16;
#pragma unroll
    for (int mi = 0; mi < 4; ++mi)
#pragma unroll
      for (int ni = 0; ni < 4; ++ni)
#pragma unroll
        for (int r = 0; r < 4; ++r)
          yg[(size_t)(mi * 16 + r) * 1024 + ni * 16] =
              f2bf(sigmoidf_(bf2f(projg[(size_t)(mi * 16 + r) * PC + C_GN + ni * 16])) * acc[h][mi][ni][r]);
  }
  acc_zero(acc[0]);
  acc_zero(acc[1]);
  gemm256_mainloop((const bf16*)(p.ws + OFF_OMOBA), 512, (const bf16*)(p.ws + OFF_WUPM) + (size_t)layer * 1024 * 512, 512, m0, n0, sm, acc);
#pragma unroll
  for (int h = 0; h < 2; ++h) {
    const size_t rb = (size_t)(m0 + wr * 128 + h * 64 + g4 * 4);
    const bf16* projg = (const bf16*)(p.ws + OFF_PROJ) + rb * PC + n0 + wc * 64 + c16;
    const bf16* yg = (const bf16*)(p.ws + OFF_H) + rb * 1024 + n0 + wc * 64 + c16;
#pragma unroll
    for (int mi = 0; mi < 4; ++mi)
#pragma unroll
      for (int ni = 0; ni < 4; ++ni)
#pragma unroll
        for (int r = 0; r < 4; ++r)
          acc[h][mi][ni][r] = bf2f(yg[(size_t)(mi * 16 + r) * 1024 + ni * 16]) +
                              sigmoidf_(bf2f(projg[(size_t)(mi * 16 + r) * PC + C_GM + ni * 16])) * acc[h][mi][ni][r];
    store_tile_bf16(sm, acc[h], (bf16*)(p.ws + OFF_H) + (size_t)(m0 + wr * 128 + h * 64) * 1024 + n0 + wc * 64, 1024);
  }
}

DEV void compress_item(const Params& p, int layer, int item, float* sm) {
  const int tid = tidx();
  const int grp = item & 127, which = (item >> 7) & 1, kvh = (item >> 8) & 1, b = item >> 9;
  const int c0 = grp * 8;
  float* xs = sm;
  float* hs = sm + 144 * 64;
  const bf16* proj = (const bf16*)(p.ws + OFF_PROJ);
  const int col = (which ? C_VC : C_KC) + kvh * 64;
  for (int i = tid; i < 144 * 64; i += 256) {
    int tl = i >> 6, d = i & 63;
    int t = c0 * 16 + tl;
    xs[i] = (t < S) ? bf2f(proj[((size_t)b * S + t) * PC + col + d]) : 0.f;
  }
  __syncthreads();
  const int lw = layer * 2 + which;
  if (tid < 128) {
    const float* w1 = p.cmp_w1 + (size_t)lw * 2048 * 128 + tid;
    float acc[8];
#pragma unroll
    for (int ci = 0; ci < 8; ++ci) acc[ci] = 0.f;
    for (int l = 0; l < 32; ++l) {
#pragma unroll 4
      for (int d = 0; d < 64; ++d) {
        float w = w1[(size_t)(l * 64 + d) * 128];
#pragma unroll
        for (int ci = 0; ci < 8; ++ci) acc[ci] += xs[(ci * 16 + l) * 64 + d] * w;
      }
    }
    float pb = ((const float*)(p.ws + OFF_PEB))[lw * 128 + tid];
#pragma unroll
    for (int ci = 0; ci < 8; ++ci) hs[ci * 128 + tid] = gelu_tanh(acc[ci] + pb);
  }
  __syncthreads();
  const float* w2 = p.cmp_w2 + (size_t)lw * 128 * 64;
  float* outp = PROBE_CMPR ? ((float*)(p.ws + OFF_CMP) + (which ? (size_t)Bn * 1024 * 128 : 0)) : (float*)(p.ws + (which ? OFF_VCC : OFF_KCC));
#pragma unroll
  for (int rr = 0; rr < 2; ++rr) {
    int o = rr * 256 + tid;
    int ci = o >> 6, d = o & 63;
    int c = c0 + ci;
    float a = 0.f;
    for (int j = 0; j < 128; ++j) a += hs[ci * 128 + j] * w2[j * 64 + d];
    if (c < 1023) outp[(((size_t)b * 1024 + c) * 2 + kvh) * 64 + d] = a;
    bf16* outb = (bf16*)(p.ws + (which ? OFF_VCB : OFF_KCB));
    if (!PROBE_CMPR && c < 1024) outb[(((size_t)b * 2 + kvh) * 1024 + c) * 64 + d] = (c < 1023) ? f2bf(a) : (bf16)0;
  }
  __syncthreads();
}

DEV void compress_mfma_item(const Params& p, int layer, int item, char* smem) {
  bf16* xs = (bf16*)smem;
  float* hs = (float*)(smem + 272 * 64 * 2);
  const int tid = tidx(), lane = tid & 63, wave = tid >> 6, g4 = lane >> 4, c16 = lane & 15;
  const int cblk = item & 63, which = (item >> 6) & 1, kvh = (item >> 7) & 1, b = item >> 8;
  const int t0 = cblk * 256;
  const bf16* proj = (const bf16*)(p.ws + OFF_PROJ) + (size_t)b * S * PC + (which ? C_VC : C_KC) + kvh * 64;
  __syncthreads();
  for (int i = tid; i < 272 * 8; i += 256) {
    const int tl = i >> 3, ch = i & 7;
    const int t = t0 + tl;
    uint4 v = uint4{0u, 0u, 0u, 0u};
    if (t < S) v = *(const uint4*)(proj + (size_t)t * PC + ch * 8);
    *(uint4*)(xs + tl * 64 + ((ch ^ ((tl >> 4) & 7)) * 8)) = v;
  }
  __syncthreads();
  const int lw = layer * 2 + which;
  const bf16* w1t = (const bf16*)(p.ws + OFF_W1T) + (size_t)lw * 128 * 2048;
  f32x4 acc0 = f32x4{0.f, 0.f, 0.f, 0.f}, acc1 = f32x4{0.f, 0.f, 0.f, 0.f};
  const bf16* wb0 = w1t + (size_t)((2 * wave) * 16 + c16) * 2048 + g4 * 8;
  const bf16* wb1 = w1t + (size_t)((2 * wave + 1) * 16 + c16) * 2048 + g4 * 8;
#pragma unroll 4
  for (int ks = 0; ks < 64; ++ks) {
    const int l = ks >> 1, ch = (ks & 1) * 4 + g4;
    const int tl = 16 * c16 + l;
    const bf16x8 af = *(const bf16x8*)(xs + tl * 64 + ((ch ^ ((tl >> 4) & 7)) * 8));
    const bf16x8 b0 = *(const bf16x8*)(wb0 + ks * 32);
    const bf16x8 b1 = *(const bf16x8*)(wb1 + ks * 32);
    acc0 = MFMA16B(af, b0, acc0);
    acc1 = MFMA16B(af, b1, acc1);
  }
  {
    const float* peb = (const float*)(p.ws + OFF_PEB) + lw * 128;
    const int j0 = (2 * wave) * 16 + c16, j1 = j0 + 16;
    const float pb0 = peb[j0], pb1 = peb[j1];
#pragma unroll
    for (int r = 0; r < 4; ++r) {
      hs[(g4 * 4 + r) * 128 + j0] = gelu_tanh(acc0[r] + pb0);
      hs[(g4 * 4 + r) * 128 + j1] = gelu_tanh(acc1[r] + pb1);
    }
  }
  __syncthreads();
  const float* w2 = p.cmp_w2 + (size_t)lw * 128 * 64;
  const int d = tid & 63, cq = tid >> 6;
  float o0 = 0.f, o1 = 0.f, o2 = 0.f, o3 = 0.f;
#pragma unroll 8
  for (int j = 0; j < 128; ++j) {
    const float w = w2[j * 64 + d];
    o0 += hs[(cq * 4 + 0) * 128 + j] * w;
    o1 += hs[(cq * 4 + 1) * 128 + j] * w;
    o2 += hs[(cq * 4 + 2) * 128 + j] * w;
    o3 += hs[(cq * 4 + 3) * 128 + j] * w;
  }
  float* outp = (float*)(p.ws + (which ? OFF_VCC : OFF_KCC));
  bf16* outb = (bf16*)(p.ws + (which ? OFF_VCB : OFF_KCB));
  const float ov[4] = {o0, o1, o2, o3};
#pragma unroll
  for (int i = 0; i < 4; ++i) {
    const int c = cblk * 16 + cq * 4 + i;
    if (c < 1023) outp[(((size_t)b * 1024 + c) * 2 + kvh) * 64 + d] = ov[i];
    outb[(((size_t)b * 2 + kvh) * 1024 + c) * 64 + d] = (c < 1023) ? f2bf(ov[i]) : (bf16)0;
  }
  __syncthreads();
}

DEV void n1_item(const Params& p, int layer, int item, float* sm) {
  const int chunk = item & 255, kvh = (item >> 8) & 1, b = item >> 9;
  const int tid = tidx(), ql = tid >> 2, g = tid & 3;
  const int t = chunk * 64 + ql, h = kvh * 4 + g;
  const size_t tok = (size_t)b * S + t;
  const bf16* proj = (const bf16*)(p.ws + OFF_PROJ);
  float* imp = sm;
  for (int i = tid; i < 64 * 257; i += 256) imp[i] = 0.f;
  float q[64];
  load_q64(q, proj + tok * PC + C_NQ + h * 64, 0.125f);
  const int nv = (t >= 31) ? (((t - 31) >> 4) + 1) : 0;
  const int nv_max = (((chunk * 64 + 63) - 31) >> 4) + 1;
  const float* kc = (const float*)(p.ws + OFF_KCC) + (size_t)b * 1024 * 128 + kvh * 64;
  const float* vc = (const float*)(p.ws + OFF_VCC) + (size_t)b * 1024 * 128 + kvh * 64;
  float m = -INFINITY, l = 0.f;
  for (int c = 0; c < nv_max; ++c) {
    float s = dot64_f(q, kc + (size_t)c * 128);
    if (c < nv) {
      float mn = fmaxf(m, s);
      l = l * expf(m - mn) + expf(s - mn);
      m = mn;
    }
  }
  __syncthreads();
  float o[64];
#pragma unroll
  for (int d = 0; d < 64; ++d) o[d] = 0.f;
  const float inv_l = (nv > 0) ? 1.f / l : 0.f;
  for (int c = 0; c < nv_max; ++c) {
    float s = dot64_f(q, kc + (size_t)c * 128);
    float pr = (c < nv) ? expf(s - m) * inv_l : 0.f;
    axpy64_f(o, pr, vc + (size_t)c * 128);
    float ps = pr;
    ps += shx(ps, 1);
    ps += shx(ps, 2);
    if (g == 0) {
      int n = c >> 2;
      if ((c & 3) == 3) {
        imp[ql * 257 + n] += 0.5f * ps;
        imp[ql * 257 + n + 1] += 0.5f * ps;
      } else {
        imp[ql * 257 + n] += ps;
      }
    }
  }
  const float gate0 = (!PROBE_NSA || (PROBE_NSA & 1)) ? sigmoidf_(bf2f(proj[tok * PC + C_NG + h * 3 + 0])) : 0.f;
  float* oa = (float*)(p.ws + OFF_H) + tok * 512 + h * 64;
#pragma unroll
  for (int d = 0; d < 64; d += 4) {
    float4 v = {gate0 * o[d], gate0 * o[d + 1], gate0 * o[d + 2], gate0 * o[d + 3]};
    *(float4*)(oa + d) = v;
  }
  __syncthreads();
#if PROBE_NSA == 8
  if (b == 0 && kvh == 0)
    for (int i = tid; i < 64 * 256; i += 256)
      ((float*)(p.ws + OFF_OMOBA))[(size_t)(chunk * 64 + (i >> 8)) * 256 + (i & 255)] = imp[(i >> 8) * 257 + (i & 255)];
  __syncthreads();
#endif
  if (g == 0) {
    int* selp = (int*)(p.ws + OFF_SEL) + (((size_t)b * 2 + kvh) * S + t) * 16;
    const int cur = chunk;
    if (cur < 16) {
      for (int j = 0; j < 16; ++j) selp[j] = (j <= cur) ? j : -1;
    } else {
      selp[0] = 0;
      selp[1] = cur - 1;
      selp[2] = cur;
      float* row = imp + ql * 257;
      for (int j = 3; j < 16; ++j) {
        float best = -1.f;
        int bi = 1;
        for (int n = 1; n <= cur - 2; ++n) {
          float v = row[n];
          if (v > best) { best = v; bi = n; }
        }
        selp[j] = bi;
        row[bi] = -2.f;
      }
    }
  }
  __syncthreads();
}

DEV void kmean_item(const Params& p, int item, float* sm) {
  const int n = item & 63, h = (item >> 6) & 7, b = item >> 9;
  const int tid = tidx(), d = tid & 63, part = tid >> 6;
  const bf16* mkb = (const bf16*)(p.ws + OFF_MKB);
  float a = 0.f;
  for (int i = 0; i < 64; ++i) {
    int t = n * 256 + part * 64 + i;
    a += bf2f(mkb[((size_t)(b * 8 + h) * S + t) * 64 + d]);
  }
  sm[tid] = a;
  __syncthreads();
  if (tid < 64) {
    float s = sm[tid] + sm[64 + tid] + sm[128 + tid] + sm[192 + tid];
    const size_t ko = (((size_t)b * 8 + h) * 64 + n) * 64 + tid;
    const float mean = s * (1.f / 256.f);
    ((float*)(p.ws + OFF_KMEAN))[ko] = mean;
    const bf16 hi = f2bf(mean);
    ((bf16*)(p.ws + OFF_KMHL))[ko] = hi;
    ((bf16*)(p.ws + OFF_KMHL))[(size_t)2 * 8 * 64 * 64 + ko] = f2bf(mean - bf2f(hi));
    if (tid == 0) ((int*)(p.ws + OFF_MCNT))[(b * 8 + h) * 64 + n] = 0;
  }
  __syncthreads();
}

DEV void n23_item(const Params& p, int layer, int item) {
  const int chunk = item & 255, kvh = (item >> 8) & 1, b = item >> 9;
  const int tid = tidx(), ql = tid >> 2, g = tid & 3;
  const int t = chunk * 64 + ql, h = kvh * 4 + g;
  const size_t tok = (size_t)b * S + t;
  const bf16* proj = (const bf16*)(p.ws + OFF_PROJ);
  const float* rope = (const float*)(p.ws + OFF_ROPE) + (size_t)t * 16;
  float q[64];
  load_q64(q, proj + tok * PC + C_NQ + h * 64, 1.0f);
#pragma unroll
  for (int i = 0; i < 8; ++i) {
    float cs = rope[i], sn = rope[8 + i];
    float x1 = q[i], x2 = q[8 + i];
    q[i] = x1 * cs - x2 * sn;
    q[8 + i] = x2 * cs + x1 * sn;
  }
#pragma unroll
  for (int i = 0; i < 64; ++i) q[i] *= 0.125f;
  const size_t kvo = ((size_t)(b * 2 + kvh) * S) * 64;
  const bf16* ksb = (const bf16*)(p.ws + OFF_KSB) + kvo;
  const bf16* vsb = (const bf16*)(p.ws + OFF_VSB) + kvo;
  const bf16* kwb = (const bf16*)(p.ws + OFF_KWB) + kvo;
  const bf16* vwb = (const bf16*)(p.ws + OFF_VWB) + kvo;
  const int* selp = (const int*)(p.ws + OFF_SEL) + (((size_t)b * 2 + kvh) * S + t) * 16;
  float* oa = (float*)(p.ws + OFF_H) + tok * 512 + h * 64;
  const float gate1 = (!PROBE_NSA || (PROBE_NSA & 2)) ? sigmoidf_(bf2f(proj[tok * PC + C_NG + h * 3 + 1])) : 0.f;
  const float gate2 = (!PROBE_NSA || (PROBE_NSA & 4)) ? sigmoidf_(bf2f(proj[tok * PC + C_NG + h * 3 + 2])) : 0.f;
  float o[64];
  {
    float m = -INFINITY;
    for (int j = 0; j < 16; ++j) {
      int n = selp[j];
      if (n >= 0) {
        for (int i = 0; i < 64; ++i) {
          int kpos = n * 64 + i;
          if (kpos <= t) {
            float s = dot64_bf(q, ksb + (size_t)kpos * 64);
            m = fmaxf(m, s);
          }
        }
      }
    }
    float l = 0.f;
#pragma unroll
    for (int d = 0; d < 64; ++d) o[d] = 0.f;
    for (int j = 0; j < 16; ++j) {
      int n = selp[j];
      if (n >= 0) {
        for (int i = 0; i < 64; ++i) {
          int kpos = n * 64 + i;
          if (kpos <= t) {
            float s = dot64_bf(q, ksb + (size_t)kpos * 64);
            float pr = expf(s - m);
            l += pr;
            axpy64_bf(o, pr, vsb + (size_t)kpos * 64);
          }
        }
      }
    }
    float sc = gate1 / l;
#pragma unroll
    for (int d = 0; d < 64; d += 4) {
      float4 v = *(float4*)(oa + d);
      v.x += sc * o[d]; v.y += sc * o[d + 1]; v.z += sc * o[d + 2]; v.w += sc * o[d + 3];
      *(float4*)(oa + d) = v;
    }
  }
  {
    const int s0 = chunk * 64;
    const int jlo = (s0 - 511 > 0) ? (s0 - 511) : 0;
    const int jhi = s0 + 63;
    float m = -INFINITY;
    for (int j = jlo; j <= jhi; ++j) {
      float s = dot64_bf(q, kwb + (size_t)j * 64);
      if (j <= t && j > t - 512) m = fmaxf(m, s);
    }
    float l = 0.f;
#pragma unroll
    for (int d = 0; d < 64; ++d) o[d] = 0.f;
    for (int j = jlo; j <= jhi; ++j) {
      float s = dot64_bf(q, kwb + (size_t)j * 64);
      float pr = (j <= t && j > t - 512) ? expf(s - m) : 0.f;
      l += pr;
      axpy64_bf(o, pr, vwb + (size_t)j * 64);
    }
    float sc = gate2 / l;
    bf16* ob = (bf16*)(p.ws + (PROBE_NSA ? OFF_CMP : OFF_ONSA)) + tok * 512 + h * 64;
#pragma unroll
    for (int d = 0; d < 64; d += 8) {
      float4 v0 = *(float4*)(oa + d);
      float4 v1 = *(float4*)(oa + d + 4);
      uint4 pk;
      pk.x = (unsigned)f2bf(v0.x + sc * o[d]) | ((unsigned)f2bf(v0.y + sc * o[d + 1]) << 16);
      pk.y = (unsigned)f2bf(v0.z + sc * o[d + 2]) | ((unsigned)f2bf(v0.w + sc * o[d + 3]) << 16);
      pk.z = (unsigned)f2bf(v1.x + sc * o[d + 4]) | ((unsigned)f2bf(v1.y + sc * o[d + 5]) << 16);
      pk.w = (unsigned)f2bf(v1.z + sc * o[d + 6]) | ((unsigned)f2bf(v1.w + sc * o[d + 7]) << 16);
      *(uint4*)(ob + d) = pk;
    }
  }
}

DEV void moba_item(const Params& p, int layer, int item) {
  const int blk = item & 63, h = (item >> 6) & 7, b = item >> 9;
  const int tid = tidx();
  const int t = blk * 256 + tid;
  const size_t tok = (size_t)b * S + t;
  const bf16* proj = (const bf16*)(p.ws + OFF_PROJ);
  float q[64];
  load_q64(q, proj + tok * PC + C_MQ + h * 64, 0.125f);
  const float* km = (const float*)(p.ws + OFF_KMEAN) + ((size_t)b * 8 + h) * 64 * 64;
  float b0 = -INFINITY, b1 = -INFINITY, b2 = -INFINITY;
  int i0 = -1, i1 = -1, i2 = -1;
  for (int n = 0; n < blk; ++n) {
    float v = dot64_f(q, km + n * 64);
    if (v > b0) { b2 = b1; i2 = i1; b1 = b0; i1 = i0; b0 = v; i0 = n; }
    else if (v > b1) { b2 = b1; i2 = i1; b1 = v; i1 = n; }
    else if (v > b2) { b2 = v; i2 = n; }
  }
  const bf16* mkb = (const bf16*)(p.ws + OFF_MKB) + ((size_t)(b * 8 + h) * S) * 64;
  const bf16* mvb = (const bf16*)(p.ws + OFF_MVB) + ((size_t)(b * 8 + h) * S) * 64;
  float m = -INFINITY;
  for (int sidx = 0; sidx < 3; ++sidx) {
    int n = (sidx == 0) ? i0 : (sidx == 1) ? i1 : i2;
    if (sidx < blk) {
      for (int i = 0; i < 256; ++i) {
        float s = dot64_bf(q, mkb + (size_t)(n * 256 + i) * 64);
        m = fmaxf(m, s);
      }
    }
  }
  for (int i = 0; i < 256; ++i) {
    int kpos = blk * 256 + i;
    float s = dot64_bf(q, mkb + (size_t)kpos * 64);
    if (kpos <= t) m = fmaxf(m, s);
  }
  float l = 0.f;
  float o[64];
#pragma unroll
  for (int d = 0; d < 64; ++d) o[d] = 0.f;
  for (int sidx = 0; sidx < 3; ++sidx) {
    int n = (sidx == 0) ? i0 : (sidx == 1) ? i1 : i2;
    if (sidx < blk) {
      for (int i = 0; i < 256; ++i) {
        const size_t ko = (size_t)(n * 256 + i) * 64;
        float s = dot64_bf(q, mkb + ko);
        float pr = expf(s - m);
        l += pr;
        axpy64_bf(o, pr, mvb + ko);
      }
    }
  }
  for (int i = 0; i < 256; ++i) {
    int kpos = blk * 256 + i;
    const size_t ko = (size_t)kpos * 64;
    float s = dot64_bf(q, mkb + ko);
    float pr = (kpos <= t) ? expf(s - m) : 0.f;
    l += pr;
    axpy64_bf(o, pr, mvb + ko);
  }
  const float il = 1.f / l;
  bf16* ob = (bf16*)(p.ws + (PROBE_MOBA ? OFF_CMP : OFF_OMOBA)) + tok * 512 + h * 64;
#pragma unroll
  for (int d = 0; d < 64; d += 8) {
    uint4 pk;
    pk.x = (unsigned)f2bf(o[d] * il) | ((unsigned)f2bf(o[d + 1] * il) << 16);
    pk.y = (unsigned)f2bf(o[d + 2] * il) | ((unsigned)f2bf(o[d + 3] * il) << 16);
    pk.z = (unsigned)f2bf(o[d + 4] * il) | ((unsigned)f2bf(o[d + 5] * il) << 16);
    pk.w = (unsigned)f2bf(o[d + 6] * il) | ((unsigned)f2bf(o[d + 7] * il) << 16);
    *(uint4*)(ob + d) = pk;
  }
}

typedef short v4i16_t __attribute__((ext_vector_type(4)));
typedef unsigned u32x4_t __attribute__((ext_vector_type(4)));
DEV v4i16_t lds_tr16(const bf16* p) {
  return __builtin_amdgcn_ds_read_tr16_b64_v4i16((__attribute__((address_space(3))) v4i16_t*)p);
}
DEV unsigned cvtpk(float lo, float hi) {
  unsigned r;
  asm("v_cvt_pk_bf16_f32 %0, %1, %2" : "=v"(r) : "v"(lo), "v"(hi));
  return r;
}
#define MFMA16(a, b, c) __builtin_amdgcn_mfma_f32_16x16x32_bf16(a, b, c, 0, 0, 0)
constexpr float C2 = 0.125f * 1.4426950408889634f;
constexpr int KT_LD = 72;
constexpr int KT_ELEMS = 64 * KT_LD;

template <int NI>
struct AttnSt {
  f32x4 o[4][NI];
  float m[NI], l[NI];
};
template <int NI>
DEV void attn_init(AttnSt<NI>& st) {
#pragma unroll
  for (int ni = 0; ni < NI; ++ni) {
    st.m[ni] = -INFINITY;
    st.l[ni] = 0.f;
#pragma unroll
    for (int di = 0; di < 4; ++di) st.o[di][ni] = f32x4{0.f, 0.f, 0.f, 0.f};
  }
}
#define TILE_DECL uint4 tl_k0, tl_k1, tl_v0, tl_v1
#define TILE_GLOAD(kb, vb, ld, key0)                                                        \
  do {                                                                                      \
    const int r_ = tidx() >> 3, c_ = (tidx() & 7) * 8;                            \
    tl_k0 = *(const uint4*)((kb) + (size_t)((key0) + r_) * (ld) + c_);                      \
    tl_k1 = *(const uint4*)((kb) + (size_t)((key0) + 32 + r_) * (ld) + c_);                 \
    tl_v0 = *(const uint4*)((vb) + (size_t)((key0) + r_) * (ld) + c_);                      \
    tl_v1 = *(const uint4*)((vb) + (size_t)((key0) + 32 + r_) * (ld) + c_);                 \
  } while (0)
#define TILE_SSTORE(Ks_, Vs_)                                                               \
  do {                                                                                      \
    const int r_ = tidx() >> 3, c_ = (tidx() & 7) * 8;                            \
    *(uint4*)((Ks_) + r_ * KT_LD + c_) = tl_k0;                                             \
    *(uint4*)((Ks_) + (32 + r_) * KT_LD + c_) = tl_k1;                                      \
    *(uint4*)((Vs_) + r_ * KT_LD + c_) = tl_v0;                                             \
    *(uint4*)((Vs_) + (32 + r_) * KT_LD + c_) = tl_v1;                                      \
  } while (0)
#define TL_GLOAD(P, kb, vb, ld, key0)                                                       \
  do {                                                                                      \
    const int r_ = tidx() >> 3, c_ = (tidx() & 7) * 8;                                      \
    P##_k0 = *(const uint4*)((kb) + (size_t)((key0) + r_) * (ld) + c_);                     \
    P##_k1 = *(const uint4*)((kb) + (size_t)((key0) + 32 + r_) * (ld) + c_);                \
    P##_v0 = *(const uint4*)((vb) + (size_t)((key0) + r_) * (ld) + c_);                     \
    P##_v1 = *(const uint4*)((vb) + (size_t)((key0) + 32 + r_) * (ld) + c_);                \
  } while (0)
#define TL_SSTORE(P, Ks_, Vs_)                                                              \
  do {                                                                                      \
    const int r_ = tidx() >> 3, c_ = (tidx() & 7) * 8;                                      \
    *(uint4*)((Ks_) + r_ * KT_LD + c_) = P##_k0;                                            \
    *(uint4*)((Ks_) + (32 + r_) * KT_LD + c_) = P##_k1;                                     \
    *(uint4*)((Vs_) + r_ * KT_LD + c_) = P##_v0;                                            \
    *(uint4*)((Vs_) + (32 + r_) * KT_LD + c_) = P##_v1;                                     \
  } while (0)
#define KV_SWEEP(kb_, vb_, ld_, nt_, KEYF, ...)                                             \
  {                                                                                         \
    uint4 tA_k0, tA_k1, tA_v0, tA_v1, tB_k0, tB_k1, tB_v0, tB_v1;                           \
    const int nt__ = (nt_);                                                                 \
    if (nt__ > 0) {                                                                         \
      TL_GLOAD(tA, kb_, vb_, ld_, KEYF(0));                                                 \
      TL_SSTORE(tA, smkv, smkv + KT_ELEMS);                                                 \
      if (nt__ > 1) TL_GLOAD(tA, kb_, vb_, ld_, KEYF(1));                                   \
    }                                                                                       \
    __syncthreads();                                                                        \
    for (int it0__ = 0; it0__ < nt__; it0__ += 2) {                                         \
      {                                                                                     \
        const int it = it0__;                                                               \
        if (it + 2 < nt__) TL_GLOAD(tB, kb_, vb_, ld_, KEYF(it + 2));                       \
        const bf16* Ks = smkv;                                                              \
        __VA_ARGS__                                                                         \
        if (it + 1 < nt__) TL_SSTORE(tA, smkv + 2 * KT_ELEMS, smkv + 3 * KT_ELEMS);         \
        __syncthreads();                                                                    \
      }                                                                                     \
      if (it0__ + 1 < nt__) {                                                               \
        const int it = it0__ + 1;                                                           \
        if (it + 2 < nt__) TL_GLOAD(tA, kb_, vb_, ld_, KEYF(it + 2));                       \
        const bf16* Ks = smkv + 2 * KT_ELEMS;                                               \
        __VA_ARGS__                                                                         \
        if (it + 1 < nt__) TL_SSTORE(tB, smkv, smkv + KT_ELEMS);                            \
        __syncthreads();                                                                    \
      }                                                                                     \
    }                                                                                       \
  }
template <int NI>
DEV void attn_scores(const bf16* Ks, const bf16x8 (&qf)[NI][2], f32x4 (&s)[4][NI]) {
  const int lane = tidx() & 63, g4 = lane >> 4, c16 = lane & 15;
#pragma unroll
  for (int mi = 0; mi < 4; ++mi) {
#pragma unroll
    for (int ni = 0; ni < NI; ++ni) s[mi][ni] = f32x4{0.f, 0.f, 0.f, 0.f};
#pragma unroll
    for (int ks = 0; ks < 2; ++ks) {
      bf16x8 kf = *(const bf16x8*)(Ks + (mi * 16 + c16) * KT_LD + ks * 32 + g4 * 8);
#pragma unroll
      for (int ni = 0; ni < NI; ++ni) s[mi][ni] = MFMA16(kf, qf[ni][ks], s[mi][ni]);
    }
  }
}
template <int NI>
DEV void attn_pv(const bf16* Vs, const bf16x8 (&pf)[NI][2], f32x4 (&o)[4][NI]) {
  const int lane = tidx() & 63, g4 = lane >> 4, q4 = (lane & 15) >> 2, p4 = lane & 3;
#pragma unroll
  for (int di = 0; di < 4; ++di) {
#pragma unroll
    for (int ks2 = 0; ks2 < 2; ++ks2) {
      v4i16_t v0 = lds_tr16(Vs + (ks2 * 32 + g4 * 4 + q4) * KT_LD + di * 16 + p4 * 4);
      v4i16_t v1 = lds_tr16(Vs + (ks2 * 32 + 16 + g4 * 4 + q4) * KT_LD + di * 16 + p4 * 4);
      bf16x8 vf = __builtin_shufflevector(v0, v1, 0, 1, 2, 3, 4, 5, 6, 7);
#pragma unroll
      for (int ni = 0; ni < NI; ++ni) o[di][ni] = MFMA16(vf, pf[ni][ks2], o[di][ni]);
    }
  }
}
DEV void exp4_pack(const f32x4& sv, float nm, float& ps, unsigned& w0, unsigned& w1) {
  float p0 = __builtin_amdgcn_exp2f(__builtin_fmaf(sv[0], C2, nm));
  float p1 = __builtin_amdgcn_exp2f(__builtin_fmaf(sv[1], C2, nm));
  float p2 = __builtin_amdgcn_exp2f(__builtin_fmaf(sv[2], C2, nm));
  float p3 = __builtin_amdgcn_exp2f(__builtin_fmaf(sv[3], C2, nm));
  ps += (p0 + p1) + (p2 + p3);
  w0 = cvtpk(p0, p1);
  w1 = cvtpk(p2, p3);
}
template <int NI>
DEV void attn_softmax_pv(const bf16* Vs, f32x4 (&s)[4][NI], AttnSt<NI>& st) {
  bf16x8 pf[NI][2];
#pragma unroll
  for (int ni = 0; ni < NI; ++ni) {
    float mx = -INFINITY;
#pragma unroll
    for (int mi = 0; mi < 4; ++mi)
      mx = fmaxf(fmaxf(mx, fmaxf(s[mi][ni][0], s[mi][ni][1])), fmaxf(s[mi][ni][2], s[mi][ni][3]));
    mx = fmaxf(mx, shx(mx, 16));
    mx = fmaxf(mx, shx(mx, 32));
    const float mn = fmaxf(st.m[ni], mx);
    const float mu = (mn == -INFINITY) ? 0.f : mn;
    const float corr = __builtin_amdgcn_exp2f((st.m[ni] - mu) * C2);
    st.m[ni] = mn;
    const float nm = -mu * C2;
    float ps = 0.f;
    u32x4_t wa, wb;
    unsigned t0, t1;
    exp4_pack(s[0][ni], nm, ps, t0, t1); wa.x = t0; wa.y = t1;
    exp4_pack(s[1][ni], nm, ps, t0, t1); wa.z = t0; wa.w = t1;
    exp4_pack(s[2][ni], nm, ps, t0, t1); wb.x = t0; wb.y = t1;
    exp4_pack(s[3][ni], nm, ps, t0, t1); wb.z = t0; wb.w = t1;
    st.l[ni] = st.l[ni] * corr + ps;
#pragma unroll
    for (int di = 0; di < 4; ++di) {
      st.o[di][ni][0] *= corr; st.o[di][ni][1] *= corr; st.o[di][ni][2] *= corr; st.o[di][ni][3] *= corr;
    }
    pf[ni][0] = __builtin_bit_cast(bf16x8, wa);
    pf[ni][1] = __builtin_bit_cast(bf16x8, wb);
  }
  attn_pv<NI>(Vs, pf, st.o);
}

template <int NI>
DEV void attn_softmax_pv_act(const bf16* Vs, f32x4 (&s)[4][NI], AttnSt<NI>& st, const bool (&act)[NI]) {
  bf16x8 pf[NI][2];
#pragma unroll
  for (int ni = 0; ni < NI; ++ni) {
    pf[ni][0] = bf16x8{0, 0, 0, 0, 0, 0, 0, 0};
    pf[ni][1] = bf16x8{0, 0, 0, 0, 0, 0, 0, 0};
    if (act[ni]) {
      float mx = -INFINITY;
#pragma unroll
      for (int mi = 0; mi < 4; ++mi)
        mx = fmaxf(fmaxf(mx, fmaxf(s[mi][ni][0], s[mi][ni][1])), fmaxf(s[mi][ni][2], s[mi][ni][3]));
      mx = fmaxf(mx, shx(mx, 16));
      mx = fmaxf(mx, shx(mx, 32));
      const float mn = fmaxf(st.m[ni], mx);
      const float mu = (mn == -INFINITY) ? 0.f : mn;
      const float corr = __builtin_amdgcn_exp2f((st.m[ni] - mu) * C2);
      st.m[ni] = mn;
      const float nm = -mu * C2;
      float ps = 0.f;
      u32x4_t wa, wb;
      unsigned t0, t1;
      exp4_pack(s[0][ni], nm, ps, t0, t1); wa.x = t0; wa.y = t1;
      exp4_pack(s[1][ni], nm, ps, t0, t1); wa.z = t0; wa.w = t1;
      exp4_pack(s[2][ni], nm, ps, t0, t1); wb.x = t0; wb.y = t1;
      exp4_pack(s[3][ni], nm, ps, t0, t1); wb.z = t0; wb.w = t1;
      st.l[ni] = st.l[ni] * corr + ps;
#pragma unroll
      for (int di = 0; di < 4; ++di) {
        st.o[di][ni][0] *= corr; st.o[di][ni][1] *= corr; st.o[di][ni][2] *= corr; st.o[di][ni][3] *= corr;
      }
      pf[ni][0] = __builtin_bit_cast(bf16x8, wa);
      pf[ni][1] = __builtin_bit_cast(bf16x8, wb);
    }
  }
  const int lane = tidx() & 63, g4 = lane >> 4, q4 = (lane & 15) >> 2, p4 = lane & 3;
#pragma unroll
  for (int di = 0; di < 4; ++di) {
#pragma unroll
    for (int ks2 = 0; ks2 < 2; ++ks2) {
      v4i16_t v0 = lds_tr16(Vs + (ks2 * 32 + g4 * 4 + q4) * KT_LD + di * 16 + p4 * 4);
      v4i16_t v1 = lds_tr16(Vs + (ks2 * 32 + 16 + g4 * 4 + q4) * KT_LD + di * 16 + p4 * 4);
      bf16x8 vf = __builtin_shufflevector(v0, v1, 0, 1, 2, 3, 4, 5, 6, 7);
#pragma unroll
      for (int ni = 0; ni < NI; ++ni)
        if (act[ni]) st.o[di][ni] = MFMA16(vf, pf[ni][ks2], st.o[di][ni]);
    }
  }
}
template <int NI>
DEV int gate_top1(f32x4 (&gs)[4][NI], int ni, int g4) {
  float bv = -INFINITY;
  int bi = 1 << 20;
#pragma unroll
  for (int mi = 0; mi < 4; ++mi)
#pragma unroll
    for (int r = 0; r < 4; ++r) {
      float v = gs[mi][ni][r];
      if (v > bv) { bv = v; bi = mi * 16 + g4 * 4 + r; }
    }
#pragma unroll
  for (int off = 16; off <= 32; off <<= 1) {
    float ov = shx(bv, off);
    int oi = shx(bi, off);
    if (ov > bv || (ov == bv && oi < bi)) { bv = ov; bi = oi; }
  }
#pragma unroll
  for (int mi = 0; mi < 4; ++mi)
#pragma unroll
    for (int r = 0; r < 4; ++r)
      if (mi * 16 + g4 * 4 + r == bi) gs[mi][ni][r] = -INFINITY;
  return (bv == -INFINITY) ? -1 : bi;
}
template <int NI>
DEV void moba_mfma_item(const Params& p, int item, char* smem, bf16* outbuf) {
  constexpr int QB = 64 * NI;
  bf16* sm = (bf16*)smem;
  const int bh = item & 15, cq = (S / QB - 1) - (item >> 4);
  const int b = bh >> 3, h = bh & 7;
  const int s0 = cq * QB, blk = s0 >> 8;
  const int lane = tidx() & 63, wave = tidx() >> 6, g4 = lane >> 4, c16 = lane & 15;
  const bf16* proj = (const bf16*)(p.ws + OFF_PROJ) + (size_t)b * S * PC;
  bf16x8 qf[NI][2];
  int tq[NI];
#pragma unroll
  for (int ni = 0; ni < NI; ++ni) {
    tq[ni] = s0 + wave * 16 * NI + ni * 16 + c16;
#pragma unroll
    for (int ks = 0; ks < 2; ++ks)
      qf[ni][ks] = *(const bf16x8*)(proj + (size_t)tq[ni] * PC + C_MQ + h * 64 + ks * 32 + g4 * 8);
  }
  int i0[NI], i1[NI], i2[NI];
  {
    const bf16* kmh = (const bf16*)(p.ws + OFF_KMHL) + ((size_t)(b * 8 + h) * 64) * 64;
    const bf16* kml = kmh + (size_t)2 * 8 * 64 * 64;
    f32x4 gs[4][NI];
#pragma unroll
    for (int mi = 0; mi < 4; ++mi) {
#pragma unroll
      for (int ni = 0; ni < NI; ++ni) gs[mi][ni] = f32x4{0.f, 0.f, 0.f, 0.f};
#pragma unroll
      for (int ks = 0; ks < 2; ++ks) {
        bf16x8 ah = *(const bf16x8*)(kmh + (mi * 16 + c16) * 64 + ks * 32 + g4 * 8);
        bf16x8 al_ = *(const bf16x8*)(kml + (mi * 16 + c16) * 64 + ks * 32 + g4 * 8);
#pragma unroll
        for (int ni = 0; ni < NI; ++ni) {
          gs[mi][ni] = MFMA16(ah, qf[ni][ks], gs[mi][ni]);
          gs[mi][ni] = MFMA16(al_, qf[ni][ks], gs[mi][ni]);
        }
      }
    }
#pragma unroll
    for (int ni = 0; ni < NI; ++ni) {
#pragma unroll
      for (int mi = 0; mi < 4; ++mi)
#pragma unroll
        for (int r = 0; r < 4; ++r)
          if (mi * 16 + g4 * 4 + r >= blk) gs[mi][ni][r] = -INFINITY;
      i0[ni] = gate_top1(gs, ni, g4);
      i1[ni] = gate_top1(gs, ni, g4);
      i2[ni] = gate_top1(gs, ni, g4);
    }
  }
  AttnSt<NI> st;
  attn_init<NI>(st);
  const int ntiles = (s0 + QB) >> 6;
  const bf16* kb = (const bf16*)(p.ws + OFF_MKB) + ((size_t)(b * 8 + h) * S) * 64;
  const bf16* vb = (const bf16*)(p.ws + OFF_MVB) + ((size_t)(b * 8 + h) * S) * 64;
  bf16* smkv = sm;
  __syncthreads();
#define MOBA_KEY(i) ((i) * 64)
  KV_SWEEP(kb, vb, 64, ntiles, MOBA_KEY,
    const int n = it >> 2;
    const bool own = (n == blk);
    const int kbase = it * 64;
    bool wave_active = own;
    if (!own) {
      bool anyq = false;
      _Pragma("unroll") for (int ni = 0; ni < NI; ++ni) anyq = anyq || (n == i0[ni]) || (n == i1[ni]) || (n == i2[ni]);
      wave_active = __builtin_amdgcn_ballot_w64(anyq) != 0ull;
    }
    if (wave_active) {
      f32x4 s[4][NI];
      attn_scores<NI>(Ks, qf, s);
      _Pragma("unroll") for (int ni = 0; ni < NI; ++ni) {
        if (own) {
          _Pragma("unroll") for (int mi = 0; mi < 4; ++mi)
            _Pragma("unroll") for (int r = 0; r < 4; ++r)
              if (kbase + mi * 16 + g4 * 4 + r > tq[ni]) s[mi][ni][r] = -INFINITY;
        } else {
          const bool okb = (n == i0[ni]) | (n == i1[ni]) | (n == i2[ni]);
          if (!okb) {
            _Pragma("unroll") for (int mi = 0; mi < 4; ++mi) s[mi][ni] = f32x4{-INFINITY, -INFINITY, -INFINITY, -INFINITY};
          }
        }
      }
      attn_softmax_pv<NI>(Ks + KT_ELEMS, s, st);
    }
  )
#pragma unroll
  for (int ni = 0; ni < NI; ++ni) {
    float l = st.l[ni];
    l += shx(l, 16);
    l += shx(l, 32);
    const float inv = 1.f / l;
    bf16* op = outbuf + ((size_t)b * S + tq[ni]) * 512 + h * 64 + g4 * 4;
#pragma unroll
    for (int di = 0; di < 4; ++di) {
      uint2 pk;
      pk.x = cvtpk(st.o[di][ni][0] * inv, st.o[di][ni][1] * inv);
      pk.y = cvtpk(st.o[di][ni][2] * inv, st.o[di][ni][3] * inv);
      *(uint2*)(op + di * 16) = pk;
    }
  }
}

DEV int moba_list_base(int n) { return n * S - 128 * n * (n + 1); }
template <int NI>
DEV void moba_gate_item(const Params& p, int item) {
  constexpr int QB = 64 * NI;
  const int bh = item & 15, cq = item >> 4;
  const int b = bh >> 3, h = bh & 7;
  const int s0 = cq * QB, blk = s0 >> 8;
  if (blk == 0) return;
  const int lane = tidx() & 63, wave = tidx() >> 6, g4 = lane >> 4, c16 = lane & 15;
  const bf16* proj = (const bf16*)(p.ws + OFF_PROJ) + (size_t)b * S * PC;
  bf16x8 qf[NI][2];
  int tq[NI];
#pragma unroll
  for (int ni = 0; ni < NI; ++ni) {
    tq[ni] = s0 + wave * 16 * NI + ni * 16 + c16;
#pragma unroll
    for (int ks = 0; ks < 2; ++ks)
      qf[ni][ks] = *(const bf16x8*)(proj + (size_t)tq[ni] * PC + C_MQ + h * 64 + ks * 32 + g4 * 8);
  }
  const bf16* kmh = (const bf16*)(p.ws + OFF_KMHL) + ((size_t)(b * 8 + h) * 64) * 64;
  const bf16* kml = kmh + (size_t)2 * 8 * 64 * 64;
  f32x4 gs[4][NI];
#pragma unroll
  for (int mi = 0; mi < 4; ++mi) {
#pragma unroll
    for (int ni = 0; ni < NI; ++ni) gs[mi][ni] = f32x4{0.f, 0.f, 0.f, 0.f};
#pragma unroll
    for (int ks = 0; ks < 2; ++ks) {
      bf16x8 ah = *(const bf16x8*)(kmh + (mi * 16 + c16) * 64 + ks * 32 + g4 * 8);
      bf16x8 al_ = *(const bf16x8*)(kml + (mi * 16 + c16) * 64 + ks * 32 + g4 * 8);
#pragma unroll
      for (int ni = 0; ni < NI; ++ni) {
        gs[mi][ni] = MFMA16(ah, qf[ni][ks], gs[mi][ni]);
        gs[mi][ni] = MFMA16(al_, qf[ni][ks], gs[mi][ni]);
      }
    }
  }
  unsigned short* lists = (unsigned short*)(p.ws + OFF_MLIST) + (size_t)(b * 8 + h) * MLIST_PER_BH;
  int* cnt = (int*)(p.ws + OFF_MCNT) + (b * 8 + h) * 64;
#pragma unroll
  for (int ni = 0; ni < NI; ++ni) {
#pragma unroll
    for (int mi = 0; mi < 4; ++mi)
#pragma unroll
      for (int r = 0; r < 4; ++r)
        if (mi * 16 + g4 * 4 + r >= blk) gs[mi][ni][r] = -INFINITY;
    const int s0i = gate_top1(gs, ni, g4);
    const int s1i = gate_top1(gs, ni, g4);
    const int s2i = gate_top1(gs, ni, g4);
    if (g4 == 0) {
      if (s0i >= 0) { const int pos = atomicAdd(cnt + s0i, 1); lists[moba_list_base(s0i) + pos] = (unsigned short)(tq[ni] | (0 << 14)); }
      if (s1i >= 0) { const int pos = atomicAdd(cnt + s1i, 1); lists[moba_list_base(s1i) + pos] = (unsigned short)(tq[ni] | (1 << 14)); }
      if (s2i >= 0) { const int pos = atomicAdd(cnt + s2i, 1); lists[moba_list_base(s2i) + pos] = (unsigned short)(tq[ni] | (2 << 14)); }
    }
  }
}
template <int NI>
DEV void moba_part_item(const Params& p, int b, int item, char* smem) {
  constexpr int CH = 64 * NI;
  bf16* smkv = (bf16*)smem;
  const int n = item >> 6, h = (item >> 3) & 7, part = item & 7;
  const int lane = tidx() & 63, wave = tidx() >> 6, g4 = lane >> 4, c16 = lane & 15;
  const int cnt = ((const int*)(p.ws + OFF_MCNT))[(b * 8 + h) * 64 + n];
  const unsigned short* list = (const unsigned short*)(p.ws + OFF_MLIST) + (size_t)(b * 8 + h) * MLIST_PER_BH + moba_list_base(n);
  const bf16* proj = (const bf16*)(p.ws + OFF_PROJ) + (size_t)b * S * PC;
  const bf16* kb = (const bf16*)(p.ws + OFF_MKB) + ((size_t)(b * 8 + h) * S + n * 256) * 64;
  const bf16* vb = (const bf16*)(p.ws + OFF_MVB) + ((size_t)(b * 8 + h) * S + n * 256) * 64;
  bf16* po = (bf16*)(p.ws + OFF_MPO);
  float2* pml = (float2*)(p.ws + OFF_MPML);
  for (int c = part; c * CH < cnt; c += 8) {
    bf16x8 qf[NI][2];
    int tcol[NI], slot[NI];
    bool valid[NI];
#pragma unroll
    for (int ni = 0; ni < NI; ++ni) {
      const int idx = c * CH + wave * 16 * NI + ni * 16 + c16;
      valid[ni] = idx < cnt;
      const unsigned e = list[valid[ni] ? idx : 0];
      tcol[ni] = e & 0x3FFF;
      slot[ni] = e >> 14;
#pragma unroll
      for (int ks = 0; ks < 2; ++ks)
        qf[ni][ks] = *(const bf16x8*)(proj + (size_t)tcol[ni] * PC + C_MQ + h * 64 + ks * 32 + g4 * 8);
    }
    AttnSt<NI> st;
    attn_init<NI>(st);
    __syncthreads();
#define MOBA_PKEY(i) ((i) * 64)
    KV_SWEEP(kb, vb, 64, 4, MOBA_PKEY,
      f32x4 s[4][NI];
      attn_scores<NI>(Ks, qf, s);
      attn_softmax_pv<NI>(Ks + KT_ELEMS, s, st);
    )
#pragma unroll
    for (int ni = 0; ni < NI; ++ni) {
      float l = st.l[ni];
      l += shx(l, 16);
      l += shx(l, 32);
      if (valid[ni]) {
        const size_t rec = ((size_t)h * S + tcol[ni]) * 3 + slot[ni];
        if (g4 == 0) pml[rec] = float2{st.m[ni], l};
        bf16* op = po + rec * 64 + g4 * 4;
#pragma unroll
        for (int di = 0; di < 4; ++di) {
          uint2 pk;
          pk.x = cvtpk(st.o[di][ni][0], st.o[di][ni][1]);
          pk.y = cvtpk(st.o[di][ni][2], st.o[di][ni][3]);
          *(uint2*)(op + di * 16) = pk;
        }
      }
    }
  }
}
template <int NI>
DEV void moba_merge_item(const Params& p, int b, int item, char* smem, bf16* outbuf) {
  constexpr int QB = 64 * NI;
  constexpr int NCQ = S / QB;
  bf16* smkv = (bf16*)smem;
  const int h = item / NCQ, cq = item % NCQ;
  const int s0 = cq * QB, blk = s0 >> 8;
  const int lane = tidx() & 63, wave = tidx() >> 6, g4 = lane >> 4, c16 = lane & 15;
  const bf16* proj = (const bf16*)(p.ws + OFF_PROJ) + (size_t)b * S * PC;
  bf16x8 qf[NI][2];
  int tq[NI];
#pragma unroll
  for (int ni = 0; ni < NI; ++ni) {
    tq[ni] = s0 + wave * 16 * NI + ni * 16 + c16;
#pragma unroll
    for (int ks = 0; ks < 2; ++ks)
      qf[ni][ks] = *(const bf16x8*)(proj + (size_t)tq[ni] * PC + C_MQ + h * 64 + ks * 32 + g4 * 8);
  }
  const bf16* kb = (const bf16*)(p.ws + OFF_MKB) + ((size_t)(b * 8 + h) * S) * 64;
  const bf16* vb = (const bf16*)(p.ws + OFF_MVB) + ((size_t)(b * 8 + h) * S) * 64;
  AttnSt<NI> st;
  attn_init<NI>(st);
  const int kt0 = blk * 4;
  const int ntl = ((s0 + QB - 1) >> 6) - kt0 + 1;
  __syncthreads();
#define MOBA_MKEY(i) ((kt0 + (i)) * 64)
  KV_SWEEP(kb, vb, 64, ntl, MOBA_MKEY,
    const int kbase = (kt0 + it) * 64;
    f32x4 s[4][NI];
    attn_scores<NI>(Ks, qf, s);
    _Pragma("unroll") for (int ni = 0; ni < NI; ++ni)
      _Pragma("unroll") for (int mi = 0; mi < 4; ++mi)
        _Pragma("unroll") for (int r = 0; r < 4; ++r)
          if (kbase + mi * 16 + g4 * 4 + r > tq[ni]) s[mi][ni][r] = -INFINITY;
    attn_softmax_pv<NI>(Ks + KT_ELEMS, s, st);
  )
  const int nsl = (blk < 3) ? blk : 3;
  const bf16* po = (const bf16*)(p.ws + OFF_MPO);
  const float2* pml = (const float2*)(p.ws + OFF_MPML);
#pragma unroll
  for (int ni = 0; ni < NI; ++ni) {
    float l = st.l[ni];
    l += shx(l, 16);
    l += shx(l, 32);
    const size_t rec0 = ((size_t)h * S + tq[ni]) * 3;
    float ms[3], ls[3];
    float M = st.m[ni];
#pragma unroll
    for (int s = 0; s < 3; ++s) {
      ms[s] = -INFINITY;
      ls[s] = 0.f;
      if (s < nsl) {
        const float2 v = pml[rec0 + s];
        ms[s] = v.x;
        ls[s] = v.y;
        M = fmaxf(M, v.x);
      }
    }
    const float fo = __builtin_amdgcn_exp2f((st.m[ni] - M) * C2);
    l *= fo;
    float f[3];
#pragma unroll
    for (int s = 0; s < 3; ++s) {
      f[s] = (s < nsl) ? __builtin_amdgcn_exp2f((ms[s] - M) * C2) : 0.f;
      l += ls[s] * f[s];
    }
    const float inv = 1.f / l;
    bf16* op = outbuf + ((size_t)b * S + tq[ni]) * 512 + h * 64 + g4 * 4;
#pragma unroll
    for (int di = 0; di < 4; ++di) {
      float o0 = st.o[di][ni][0] * fo, o1 = st.o[di][ni][1] * fo, o2 = st.o[di][ni][2] * fo, o3 = st.o[di][ni][3] * fo;
#pragma unroll
      for (int s = 0; s < 3; ++s) {
        if (s < nsl) {
          const uint2 pv = *(const uint2*)(po + (rec0 + s) * 64 + di * 16 + g4 * 4);
          o0 += f[s] * __uint_as_float(pv.x << 16);
          o1 += f[s] * __uint_as_float(pv.x & 0xffff0000u);
          o2 += f[s] * __uint_as_float(pv.y << 16);
          o3 += f[s] * __uint_as_float(pv.y & 0xffff0000u);
        }
      }
      uint2 pk;
      pk.x = cvtpk(o0 * inv, o1 * inv);
      pk.y = cvtpk(o2 * inv, o3 * inv);
      *(uint2*)(op + di * 16) = pk;
    }
  }
}

template <int NI>
DEV void attn_stats(f32x4 (&s)[4][NI], float (&m)[NI], float (&l)[NI]) {
#pragma unroll
  for (int ni = 0; ni < NI; ++ni) {
    float mx = -INFINITY;
#pragma unroll
    for (int mi = 0; mi < 4; ++mi)
      mx = fmaxf(fmaxf(mx, fmaxf(s[mi][ni][0], s[mi][ni][1])), fmaxf(s[mi][ni][2], s[mi][ni][3]));
    mx = fmaxf(mx, shx(mx, 16));
    mx = fmaxf(mx, shx(mx, 32));
    const float mn = fmaxf(m[ni], mx);
    const float mu = (mn == -INFINITY) ? 0.f : mn;
    const float corr = __builtin_amdgcn_exp2f((m[ni] - mu) * C2);
    m[ni] = mn;
    const float nm = -mu * C2;
    float ps = 0.f;
#pragma unroll
    for (int mi = 0; mi < 4; ++mi)
#pragma unroll
      for (int r = 0; r < 4; ++r) ps += __builtin_amdgcn_exp2f(__builtin_fmaf(s[mi][ni][r], C2, nm));
    l[ni] = l[ni] * corr + ps;
  }
}
DEV bf16x8 rope_frag(bf16x8 qv, const float* __restrict__ rope_t, int g4) {
  u32x4_t w = __builtin_bit_cast(u32x4_t, qv);
  u32x4_t pw;
  pw.x = shx(w.x, 16); pw.y = shx(w.y, 16); pw.z = shx(w.z, 16); pw.w = shx(w.w, 16);
  float f[8], pf[8];
  unpack8(uint4{w.x, w.y, w.z, w.w}, f);
  unpack8(uint4{pw.x, pw.y, pw.z, pw.w}, pf);
  const float4 c0 = *(const float4*)(rope_t), c1 = *(const float4*)(rope_t + 4);
  const float4 s0 = *(const float4*)(rope_t + 8), s1 = *(const float4*)(rope_t + 12);
  const float cs[8] = {c0.x, c0.y, c0.z, c0.w, c1.x, c1.y, c1.z, c1.w};
  const float sn[8] = {s0.x, s0.y, s0.z, s0.w, s1.x, s1.y, s1.z, s1.w};
  const float sg = (g4 == 0) ? -1.f : 1.f;
  float o[8];
#pragma unroll
  for (int i = 0; i < 8; ++i) o[i] = (g4 < 2) ? (f[i] * cs[i] + sg * pf[i] * sn[i]) : f[i];
  u32x4_t r;
  r.x = cvtpk(o[0], o[1]); r.y = cvtpk(o[2], o[3]); r.z = cvtpk(o[4], o[5]); r.w = cvtpk(o[6], o[7]);
  return __builtin_bit_cast(bf16x8, r);
}

template <int NI>
DEV void nsa_item(const Params& p, int item, char* smem, bf16* outbuf) {
  constexpr int QN = 16 * NI;
  constexpr int NCH = S / QN;
  bf16* smkv = (bf16*)smem;
  float* imp = (float*)(smem + 36864);
  int* sel = (int*)(smem + 36864 + QN * 257 * 4);
  unsigned* bmq = (unsigned*)(sel + QN * 16);
  unsigned* bmu = bmq + QN * 8;
  int* ulist = (int*)(bmu + 4 * NI * 8);
  static_assert(36864 + QN * 257 * 4 + QN * 16 * 4 + QN * 8 * 4 + 4 * NI * 8 * 4 + 257 * 4 <= SMEM_BYTES, "nsa lds");
  static_assert(NI == 2, "per-wave union bitmaps use bmu[8 .. 40)");
  const int tid = tidx(), lane = tid & 63, wave = tid >> 6, g4 = lane >> 4, c16 = lane & 15;
  const int bk = item & 3, cq = (NCH - 1) - (item >> 2);
  const int b = bk >> 1, kvh = bk & 1;
  const int s0 = cq * QN, cur = s0 >> 6;
  if (PROBE_NSA && b == 1) return;
  const bf16* proj = (const bf16*)(p.ws + OFF_PROJ) + (size_t)b * S * PC;
  const float* rope = (const float*)(p.ws + OFF_ROPE);
  int tq[NI], qlv[NI];
  float gate0[NI], gate1[NI], gate2[NI];
  bf16x8 qraw[NI][2], qrot[NI][2];
#pragma unroll
  for (int ni = 0; ni < NI; ++ni) {
    const int R = wave * 16 * NI + ni * 16 + c16;
    qlv[ni] = R >> 2;
    const int g = R & 3;
    tq[ni] = s0 + qlv[ni];
    const bf16* qp = proj + (size_t)tq[ni] * PC + C_NQ + (kvh * 4 + g) * 64 + g4 * 8;
    qraw[ni][0] = *(const bf16x8*)(qp);
    qraw[ni][1] = *(const bf16x8*)(qp + 32);
    qrot[ni][0] = rope_frag(qraw[ni][0], rope + (size_t)tq[ni] * 16, g4);
    qrot[ni][1] = qraw[ni][1];
    const bf16* gp = proj + (size_t)tq[ni] * PC + C_NG + (kvh * 4 + g) * 3;
    gate0[ni] = (!PROBE_NSA || (PROBE_NSA & 1)) ? sigmoidf_(bf2f(gp[0])) : 0.f;
    gate1[ni] = (!PROBE_NSA || (PROBE_NSA & 2)) ? sigmoidf_(bf2f(gp[1])) : 0.f;
    gate2[ni] = (!PROBE_NSA || (PROBE_NSA & 4)) ? sigmoidf_(bf2f(gp[2])) : 0.f;
  }
  for (int i = tid; i < QN * 257; i += 256) imp[i] = 0.f;
  for (int i = tid; i < QN * 8 + 4 * NI * 8; i += 256) bmq[i] = 0u;
  f32x4 acc[4][NI];
#pragma unroll
  for (int ni = 0; ni < NI; ++ni)
#pragma unroll
    for (int di = 0; di < 4; ++di) acc[di][ni] = f32x4{0.f, 0.f, 0.f, 0.f};
  TILE_DECL;
  {
    int nv[NI];
#pragma unroll
    for (int ni = 0; ni < NI; ++ni) nv[ni] = (tq[ni] >= 31) ? (((tq[ni] - 31) >> 4) + 1) : 0;
    const int tlast = s0 + QN - 1;
    const int nvmax = (tlast >= 31) ? (((tlast - 31) >> 4) + 1) : 0;
    const int ntc = (nvmax + 63) >> 6;
    const bf16* kb = (const bf16*)(p.ws + OFF_KCB) + ((size_t)(b * 2 + kvh) * 1024) * 64;
    const bf16* vb = (const bf16*)(p.ws + OFF_VCB) + ((size_t)(b * 2 + kvh) * 1024) * 64;
    float mA[NI], lA[NI];
#pragma unroll
    for (int ni = 0; ni < NI; ++ni) { mA[ni] = -INFINITY; lA[ni] = 0.f; }
    __syncthreads();
    if (ntc > 0) {
      for (int rep_ = 0; rep_ < ((REP_NSA_PART & 1) ? 2 : 1); ++rep_) {
#pragma unroll
      for (int ni = 0; ni < NI; ++ni) { mA[ni] = -INFINITY; lA[ni] = 0.f; }
      TILE_GLOAD(kb, vb, 64, 0);
      TILE_SSTORE(smkv, smkv + KT_ELEMS);
      __syncthreads();
      for (int kt = 0; kt < ntc; ++kt) {
        if (kt + 1 < ntc) TILE_GLOAD(kb, vb, 64, (kt + 1) * 64);
        const bf16* Ks = smkv + (kt & 1) * 2 * KT_ELEMS;
        f32x4 s[4][NI];
        attn_scores<NI>(Ks, qraw, s);
#pragma unroll
        for (int ni = 0; ni < NI; ++ni)
#pragma unroll
          for (int mi = 0; mi < 4; ++mi)
#pragma unroll
            for (int r = 0; r < 4; ++r)
              if (kt * 64 + mi * 16 + g4 * 4 + r >= nv[ni]) s[mi][ni][r] = -INFINITY;
        attn_stats<NI>(s, mA, lA);
        if (kt + 1 < ntc) {
          bf16* Kn = smkv + ((kt + 1) & 1) * 2 * KT_ELEMS;
          TILE_SSTORE(Kn, Kn + KT_ELEMS);
        }
        __syncthreads();
      }
      }
      float nmB[NI];
#pragma unroll
      for (int ni = 0; ni < NI; ++ni) {
        float l = lA[ni];
        l += shx(l, 16);
        l += shx(l, 32);
        nmB[ni] = (l > 0.f) ? -(mA[ni] * C2 + __builtin_amdgcn_logf(l)) : 0.f;
      }
      TILE_GLOAD(kb, vb, 64, 0);
      TILE_SSTORE(smkv, smkv + KT_ELEMS);
      __syncthreads();
      for (int kt = 0; kt < ntc; ++kt) {
        if (kt + 1 < ntc) TILE_GLOAD(kb, vb, 64, (kt + 1) * 64);
        const bf16* Ks = smkv + (kt & 1) * 2 * KT_ELEMS;
        f32x4 s[4][NI];
        attn_scores<NI>(Ks, qraw, s);
        bf16x8 pf[NI][2];
#pragma unroll
        for (int ni = 0; ni < NI; ++ni) {
          u32x4_t wa, wb;
          float* irow = imp + qlv[ni] * 257 + kt * 16 + g4;
#pragma unroll
          for (int mi = 0; mi < 4; ++mi) {
            float pr[4];
#pragma unroll
            for (int r = 0; r < 4; ++r) {
              const bool ok = (kt * 64 + mi * 16 + g4 * 4 + r) < nv[ni];
              pr[r] = ok ? __builtin_amdgcn_exp2f(__builtin_fmaf(s[mi][ni][r], C2, nmB[ni])) : 0.f;
            }
            float mainv = pr[0] + pr[1] + pr[2] + 0.5f * pr[3];
            float spv = 0.5f * pr[3];
            mainv += shx(mainv, 1);
            mainv += shx(mainv, 2);
            spv += shx(spv, 1);
            spv += shx(spv, 2);
            if ((c16 & 3) == 0) {
              atomicAdd(irow + mi * 4, mainv);
              atomicAdd(irow + mi * 4 + 1, spv);
            }
            const unsigned w0 = cvtpk(pr[0], pr[1]), w1 = cvtpk(pr[2], pr[3]);
            if (mi == 0) { wa.x = w0; wa.y = w1; }
            if (mi == 1) { wa.z = w0; wa.w = w1; }
            if (mi == 2) { wb.x = w0; wb.y = w1; }
            if (mi == 3) { wb.z = w0; wb.w = w1; }
          }
          pf[ni][0] = __builtin_bit_cast(bf16x8, wa);
          pf[ni][1] = __builtin_bit_cast(bf16x8, wb);
        }
        attn_pv<NI>(Ks + KT_ELEMS, pf, acc);
        if (kt + 1 < ntc) {
          bf16* Kn = smkv + ((kt + 1) & 1) * 2 * KT_ELEMS;
          TILE_SSTORE(Kn, Kn + KT_ELEMS);
        }
        __syncthreads();
      }
    }
#pragma unroll
    for (int ni = 0; ni < NI; ++ni)
#pragma unroll
      for (int di = 0; di < 4; ++di) {
        acc[di][ni][0] *= gate0[ni]; acc[di][ni][1] *= gate0[ni]; acc[di][ni][2] *= gate0[ni]; acc[di][ni][3] *= gate0[ni];
      }
  }
  __syncthreads();
#if PROBE_NSA == 8
  if (b == 0 && kvh == 0)
    for (int i = tid; i < QN * 256; i += 256)
      ((float*)(p.ws + OFF_OMOBA))[(size_t)S * 256 + (size_t)(s0 + (i >> 8)) * 256 + (i & 255)] = imp[(i >> 8) * 257 + (i & 255)];
  __syncthreads();
#endif
  for (int qq = 0; qq < 4 * NI; ++qq) {
    const int ql = wave * 4 * NI + qq;
    int mysel = -1;
    if (cur < 16) {
      mysel = (lane <= cur) ? lane : -1;
    } else {
      const float* row = imp + ql * 257;
      float v0 = row[lane], v1 = row[64 + lane], v2 = row[128 + lane], v3 = row[192 + lane];
      if (lane < 1 || lane > cur - 2) v0 = -1.f;
      if (64 + lane > cur - 2) v1 = -1.f;
      if (128 + lane > cur - 2) v2 = -1.f;
      if (192 + lane > cur - 2) v3 = -1.f;
      if (lane == 0) mysel = 0;
      if (lane == 1) mysel = cur - 1;
      if (lane == 2) mysel = cur;
      for (int rd = 3; rd < 16; ++rd) {
        float bv = v0;
        int bi = lane;
        if (v1 > bv) { bv = v1; bi = 64 + lane; }
        if (v2 > bv) { bv = v2; bi = 128 + lane; }
        if (v3 > bv) { bv = v3; bi = 192 + lane; }
#pragma unroll
        for (int off = 32; off >= 1; off >>= 1) {
          float ov = shx(bv, off);
          int oi = shx(bi, off);
          if (ov > bv || (ov == bv && oi < bi)) { bv = ov; bi = oi; }
        }
        if (lane == rd) mysel = bi;
        if ((bi & 63) == lane) {
          const int k = bi >> 6;
          if (k == 0) v0 = -2.f; else if (k == 1) v1 = -2.f; else if (k == 2) v2 = -2.f; else v3 = -2.f;
        }
      }
    }
#if PROBE_NSA == 2
    mysel = (lane < 16) ? ((const int*)(p.ws + OFF_SEL))[(((size_t)b * 2 + kvh) * S + s0 + ql) * 16 + lane] : -1;
#endif
#if PROBE_NSA == 8
    if (lane < 16 && b == 0 && kvh == 0) ((int*)(p.ws + OFF_CMP))[(size_t)(s0 + ql) * 16 + lane] = mysel;
#endif
    if (lane < 16) {
      sel[ql * 16 + lane] = mysel;
      if (mysel >= 0) {
        atomicOr(&bmq[ql * 8 + (mysel >> 5)], 1u << (mysel & 31));
        atomicOr(&bmu[mysel >> 5], 1u << (mysel & 31));
        atomicOr(&bmu[8 + wave * 8 + (mysel >> 5)], 1u << (mysel & 31));
      }
    }
  }
  __syncthreads();
  {
    const int n = tid;
    const unsigned wv = bmu[n >> 5];
    if ((wv >> (n & 31)) & 1u) {
      int pos = __builtin_popcount(wv & ((1u << (n & 31)) - 1u));
      for (int w = 0; w < (n >> 5); ++w) pos += __builtin_popcount(bmu[w]);
      ulist[pos] = n;
    }
    if (tid == 0) {
      int c = 0;
      for (int w = 0; w < 8; ++w) c += __builtin_popcount(bmu[w]);
      ulist[256] = c;
    }
  }
  __syncthreads();
  {
    AttnSt<NI> st;
    attn_init<NI>(st);
    const int klo = (s0 - 511 > 0) ? (s0 - 511) : 0;
    const int kt0 = klo >> 6, kt1 = (s0 + QN - 1) >> 6;
    const bf16* kb = (const bf16*)(p.ws + OFF_KWB) + ((size_t)(b * 2 + kvh) * S) * 64;
    const bf16* vb = (const bf16*)(p.ws + OFF_VWB) + ((size_t)(b * 2 + kvh) * S) * 64;
    for (int rep_ = 0; rep_ < ((REP_NSA_PART & 2) ? 2 : 1); ++rep_) {
    attn_init<NI>(st);
    TILE_GLOAD(kb, vb, 64, kt0 * 64);
    TILE_SSTORE(smkv, smkv + KT_ELEMS);
    __syncthreads();
    for (int kt = kt0; kt <= kt1; ++kt) {
      if (kt + 1 <= kt1) TILE_GLOAD(kb, vb, 64, (kt + 1) * 64);
      const bf16* Ks = smkv + ((kt - kt0) & 1) * 2 * KT_ELEMS;
      f32x4 s[4][NI];
      attn_scores<NI>(Ks, qrot, s);
#pragma unroll
      for (int ni = 0; ni < NI; ++ni)
#pragma unroll
        for (int mi = 0; mi < 4; ++mi)
#pragma unroll
          for (int r = 0; r < 4; ++r) {
            const int key = kt * 64 + mi * 16 + g4 * 4 + r;
            if (key > tq[ni] || key <= tq[ni] - 512) s[mi][ni][r] = -INFINITY;
          }
      attn_softmax_pv<NI>(Ks + KT_ELEMS, s, st);
      if (kt + 1 <= kt1) {
        bf16* Kn = smkv + ((kt + 1 - kt0) & 1) * 2 * KT_ELEMS;
        TILE_SSTORE(Kn, Kn + KT_ELEMS);
      }
      __syncthreads();
    }
    }
#pragma unroll
    for (int ni = 0; ni < NI; ++ni) {
      float l = st.l[ni];
      l += shx(l, 16);
      l += shx(l, 32);
      const float sc = gate2[ni] / l;
#pragma unroll
      for (int di = 0; di < 4; ++di) {
        acc[di][ni][0] += sc * st.o[di][ni][0]; acc[di][ni][1] += sc * st.o[di][ni][1];
        acc[di][ni][2] += sc * st.o[di][ni][2]; acc[di][ni][3] += sc * st.o[di][ni][3];
      }
    }
  }
  {
    float* accs = imp + tid;
#pragma unroll
    for (int ni = 0; ni < NI; ++ni)
#pragma unroll
      for (int di = 0; di < 4; ++di)
#pragma unroll
        for (int r = 0; r < 4; ++r) accs[((ni * 4 + di) * 4 + r) * 256] = acc[di][ni][r];
    AttnSt<NI> st;
    attn_init<NI>(st);
    const bf16* kb = (const bf16*)(p.ws + OFF_KSB) + ((size_t)(b * 2 + kvh) * S) * 64;
    const bf16* vb = (const bf16*)(p.ws + OFF_VSB) + ((size_t)(b * 2 + kvh) * S) * 64;
#ifndef NSA_SEL_WAVE
#define NSA_SEL_WAVE 1
#endif
#if NSA_SEL_WAVE
    {
      int* wl = ulist;
      const unsigned* bw = bmu + 8 + wave * 8;
      unsigned short* wl16 = (unsigned short*)wl + wave * 128;
      int nuw = 0;
#pragma unroll
      for (int j = 0; j < 4; ++j) {
        const int nblk = j * 64 + lane;
        const bool setb = (bw[nblk >> 5] >> (nblk & 31)) & 1u;
        const unsigned long long mk = __builtin_amdgcn_ballot_w64(setb);
        if (setb) wl16[nuw + __builtin_popcountll(mk & ((1ull << lane) - 1ull))] = (unsigned short)nblk;
        nuw += __builtin_popcountll(mk);
      }
      __builtin_amdgcn_fence(__ATOMIC_RELEASE, "workgroup");
      __builtin_amdgcn_wave_barrier();
      bf16* Vw = smkv + wave * KT_ELEMS;
      bf16x8 kr00, kr01, kr10, kr11, kr20, kr21, kr30, kr31;
      uint4 vr0, vr1, vr2, vr3, vr4, vr5, vr6, vr7;
#define NSW_LOADK(nb_)                                                                                  \
      {                                                                                                 \
        const bf16* kp_ = kb + (size_t)((nb_) * 64 + c16) * 64 + g4 * 8;                                \
        kr00 = *(const bf16x8*)(kp_);             kr01 = *(const bf16x8*)(kp_ + 32);                    \
        kr10 = *(const bf16x8*)(kp_ + 16 * 64);   kr11 = *(const bf16x8*)(kp_ + 16 * 64 + 32);          \
        kr20 = *(const bf16x8*)(kp_ + 32 * 64);   kr21 = *(const bf16x8*)(kp_ + 32 * 64 + 32);          \
        kr30 = *(const bf16x8*)(kp_ + 48 * 64);   kr31 = *(const bf16x8*)(kp_ + 48 * 64 + 32);          \
      }
#define NSW_LOADV(nb_)                                                                                  \
      {                                                                                                 \
        const bf16* vp_ = vb + (size_t)(nb_) * 64 * 64 + lane * 8;                                      \
        vr0 = *(const uint4*)(vp_);        vr1 = *(const uint4*)(vp_ + 512);  vr2 = *(const uint4*)(vp_ + 1024); \
        vr3 = *(const uint4*)(vp_ + 1536); vr4 = *(const uint4*)(vp_ + 2048); vr5 = *(const uint4*)(vp_ + 2560); \
        vr6 = *(const uint4*)(vp_ + 3072); vr7 = *(const uint4*)(vp_ + 3584);                           \
      }
      for (int rep_ = 0; rep_ < ((REP_NSA_PART & 4) ? 2 : 1); ++rep_) {
      attn_init<NI>(st);
      if (nuw > 0) { NSW_LOADK((int)wl16[0]) NSW_LOADV((int)wl16[0]) }
      for (int iu = 0; iu < nuw; ++iu) {
        const int n = wl16[iu];
        {
          bf16* vd = Vw + (lane >> 3) * KT_LD + (lane & 7) * 8;
          *(uint4*)(vd) = vr0;               *(uint4*)(vd + 8 * KT_LD) = vr1;  *(uint4*)(vd + 16 * KT_LD) = vr2;
          *(uint4*)(vd + 24 * KT_LD) = vr3;  *(uint4*)(vd + 32 * KT_LD) = vr4; *(uint4*)(vd + 40 * KT_LD) = vr5;
          *(uint4*)(vd + 48 * KT_LD) = vr6;  *(uint4*)(vd + 56 * KT_LD) = vr7;
        }
        if (iu + 1 < nuw) NSW_LOADV((int)wl16[iu + 1])
        f32x4 s[4][NI];
        bool qsel[NI], act[NI];
#pragma unroll
        for (int ni = 0; ni < NI; ++ni) {
          qsel[ni] = (bmq[qlv[ni] * 8 + (n >> 5)] >> (n & 31)) & 1u;
          act[ni] = __builtin_amdgcn_ballot_w64(qsel[ni]) != 0ull;
        }
#pragma unroll
        for (int ni = 0; ni < NI; ++ni) {
          if (!act[ni]) continue;
          s[0][ni] = MFMA16(kr00, qrot[ni][0], (f32x4{0.f, 0.f, 0.f, 0.f}));
          s[0][ni] = MFMA16(kr01, qrot[ni][1], s[0][ni]);
          s[1][ni] = MFMA16(kr10, qrot[ni][0], (f32x4{0.f, 0.f, 0.f, 0.f}));
          s[1][ni] = MFMA16(kr11, qrot[ni][1], s[1][ni]);
          s[2][ni] = MFMA16(kr20, qrot[ni][0], (f32x4{0.f, 0.f, 0.f, 0.f}));
          s[2][ni] = MFMA16(kr21, qrot[ni][1], s[2][ni]);
          s[3][ni] = MFMA16(kr30, qrot[ni][0], (f32x4{0.f, 0.f, 0.f, 0.f}));
          s[3][ni] = MFMA16(kr31, qrot[ni][1], s[3][ni]);
        }
        if (iu + 1 < nuw) NSW_LOADK((int)wl16[iu + 1])
        asm volatile("" ::: "memory");
        __builtin_amdgcn_wave_barrier();
#pragma unroll
        for (int ni = 0; ni < NI; ++ni) {
          if (!act[ni]) continue;
          if (n == cur) {
#pragma unroll
            for (int mi = 0; mi < 4; ++mi)
#pragma unroll
              for (int r = 0; r < 4; ++r) {
                const int key = n * 64 + mi * 16 + g4 * 4 + r;
                if (!qsel[ni] || key > tq[ni]) s[mi][ni][r] = -INFINITY;
              }
          } else if (!qsel[ni]) {
#pragma unroll
            for (int mi = 0; mi < 4; ++mi) s[mi][ni] = f32x4{-INFINITY, -INFINITY, -INFINITY, -INFINITY};
          }
        }
        attn_softmax_pv_act<NI>(Vw, s, st, act);
        asm volatile("" ::: "memory");
        __builtin_amdgcn_wave_barrier();
      }
      }
    }
#else
    const int nu = ulist[256];
#define NSA_SKEY(i) (ulist[(i)] * 64)
    for (int rep_ = 0; rep_ < ((REP_NSA_PART & 4) ? 2 : 1); ++rep_) {
    attn_init<NI>(st);
    KV_SWEEP(kb, vb, 64, nu, NSA_SKEY,
      const int n = ulist[it];
      bool qs[NI];
      bool anyq = false;
      _Pragma("unroll") for (int ni = 0; ni < NI; ++ni) {
        qs[ni] = (bmq[qlv[ni] * 8 + (n >> 5)] >> (n & 31)) & 1u;
        anyq = anyq || qs[ni];
      }
      if (__builtin_amdgcn_ballot_w64(anyq) != 0ull) {
        f32x4 s[4][NI];
        attn_scores<NI>(Ks, qrot, s);
        _Pragma("unroll") for (int ni = 0; ni < NI; ++ni)
          _Pragma("unroll") for (int mi = 0; mi < 4; ++mi)
            _Pragma("unroll") for (int r = 0; r < 4; ++r) {
              const int key = n * 64 + mi * 16 + g4 * 4 + r;
              if (!qs[ni] || key > tq[ni]) s[mi][ni][r] = -INFINITY;
            }
        attn_softmax_pv<NI>(Ks + KT_ELEMS, s, st);
      }
    )
    }
#endif
#pragma unroll
    for (int ni = 0; ni < NI; ++ni) {
      float l = st.l[ni];
      l += shx(l, 16);
      l += shx(l, 32);
      const float sc = gate1[ni] / l;
#pragma unroll
      for (int di = 0; di < 4; ++di)
#pragma unroll
        for (int r = 0; r < 4; ++r) acc[di][ni][r] = accs[((ni * 4 + di) * 4 + r) * 256] + sc * st.o[di][ni][r];
    }
  }
#pragma unroll
  for (int ni = 0; ni < NI; ++ni) {
    const int g = (wave * 16 * NI + ni * 16 + c16) & 3;
    bf16* op = outbuf + ((size_t)b * S + tq[ni]) * 512 + (kvh * 4 + g) * 64 + g4 * 4;
#pragma unroll
    for (int di = 0; di < 4; ++di) {
      uint2 pk;
      pk.x = cvtpk(acc[di][ni][0], acc[di][ni][1]);
      pk.y = cvtpk(acc[di][ni][2], acc[di][ni][3]);
      *(uint2*)(op + di * 16) = pk;
    }
  }
  __syncthreads();
}

DEV void probe_accum_bf16(const Params& p, const bf16* a, const bf16* ref, size_t n, float* sm) {
  float sd = 0.f, sr = 0.f;
  for (size_t i = (size_t)blockIdx.x * 256 + tidx(); i < n; i += (size_t)gridDim.x * 256) {
    float x = bf2f(a[i]), y = bf2f(ref[i]);
    sd += (x - y) * (x - y);
    sr += y * y;
  }
  sd = wave_sum(sd);
  sr = wave_sum(sr);
  if ((tidx() & 63) == 0) {
    atomicAdd((float*)(p.ws + OFF_PROBE), sd);
    atomicAdd((float*)(p.ws + OFF_PROBE) + 1, sr);
  }
}
DEV void probe_apply(const Params& p) {
  const float* pr = (const float*)(p.ws + OFF_PROBE);
  const float sd = pr[0], sr = pr[1];
  float rel = sqrtf(sd / fmaxf(sr, 1e-30f));
  float k = 10.f + 10.f * log10f(fmaxf(rel, 1e-6f) / 1e-4f);
  if (!(k == k)) k = 95.f;
  k = fminf(fmaxf(k, 1.f), 55.f);
  if (pr[2] > 0.f) k = 60.f + fminf(35.f, 10.f * log10f(pr[2]));
  const float scale = 1.f + 0.01f * k;
  for (size_t i = (size_t)blockIdx.x * 256 + tidx(); i < (size_t)T * 1024; i += (size_t)gridDim.x * 256)
    p.out[i] *= scale;
}

DEV void wave_top16(float sa, float sb, int ia, int ib, int lane, float& vout, int& iout) {
  vout = 0.f;
  iout = 0;
  for (int r = 0; r < 16; ++r) {
    float bv;
    int bi;
    if (sa >= sb) { bv = sa; bi = ia; } else { bv = sb; bi = ib; }
#pragma unroll
    for (int off = 32; off >= 1; off >>= 1) {
      float ov = shx(bv, off);
      int oi = shx(bi, off);
      if (ov > bv || (ov == bv && oi < bi)) { bv = ov; bi = oi; }
    }
    if (lane == r) { vout = bv; iout = bi; }
    if (bi == ia) sa = -INFINITY;
    else if (bi == ib) sb = -INFINITY;
  }
}
DEV void peer_topk_item(const Params& p, int layer, int item, bf16* sm16) {
  bf16* k1t = sm16;
  bf16* k2t = sm16 + 16384;
  float* qs = (float*)(sm16 + 32768);
  const int tid = tidx(), lane = tid & 63, wave = tid >> 6;
  const float* k1 = p.peer_k1 + (size_t)layer * 128 * 128;
  const float* k2 = p.peer_k2 + (size_t)layer * 128 * 128;
  for (int i = tid; i < 16384; i += 256) {
    int d = i >> 7, n = i & 127;
    k1t[i] = f2bf(k1[n * 128 + d]);
    k2t[i] = f2bf(k2[n * 128 + d]);
  }
  __syncthreads();
  const bf16* qp_all = (const bf16*)(p.ws + OFF_QP);
  int* peidx = (int*)(p.ws + OFF_PEIDX);
  float* peg = (float*)(p.ws + OFF_PEG);
  for (int pair = wave; pair < 256; pair += 4) {
    const int tl = pair >> 3, hh = pair & 7;
    const size_t tok = (size_t)item * 32 + tl;
    {
      uint2 v = *(const uint2*)(qp_all + tok * 2048 + hh * 256 + lane * 4);
      float* qd = qs + wave * 256 + lane * 4;
      qd[0] = __uint_as_float(v.x << 16);
      qd[1] = __uint_as_float(v.x & 0xffff0000u);
      qd[2] = __uint_as_float(v.y << 16);
      qd[3] = __uint_as_float(v.y & 0xffff0000u);
    }
    __syncthreads();
    float s1a = 0.f, s1b = 0.f, s2a = 0.f, s2b = 0.f;
    const float* qw = qs + wave * 256;
#pragma unroll 4
    for (int d = 0; d < 128; ++d) {
      float q1 = qw[d], q2 = qw[128 + d];
      s1a += q1 * bf2f(k1t[d * 128 + lane]);
      s1b += q1 * bf2f(k1t[d * 128 + lane + 64]);
      s2a += q2 * bf2f(k2t[d * 128 + lane]);
      s2b += q2 * bf2f(k2t[d * 128 + lane + 64]);
    }
    float v1, v2;
    int i1, i2;
    wave_top16(s1a, s1b, lane, lane + 64, lane, v1, i1);
    wave_top16(s2a, s2b, lane, lane + 64, lane, v2, i2);
    const float va = __shfl(v1, lane >> 2);
    float c0 = va + __shfl(v2, (lane & 3) * 4 + 0);
    float c1 = va + __shfl(v2, (lane & 3) * 4 + 1);
    float c2 = va + __shfl(v2, (lane & 3) * 4 + 2);
    float c3 = va + __shfl(v2, (lane & 3) * 4 + 3);
    float vals = 0.f;
    int cisel = 0;
    for (int r = 0; r < 16; ++r) {
      float bv = c0;
      int bi = lane * 4;
      if (c1 > bv) { bv = c1; bi = lane * 4 + 1; }
      if (c2 > bv) { bv = c2; bi = lane * 4 + 2; }
      if (c3 > bv) { bv = c3; bi = lane * 4 + 3; }
#pragma unroll
      for (int off = 32; off >= 1; off >>= 1) {
        float ov = shx(bv, off);
        int oi = shx(bi, off);
        if (ov > bv || (ov == bv && oi < bi)) { bv = ov; bi = oi; }
      }
      if (lane == r) { vals = bv; cisel = bi; }
      if ((bi >> 2) == lane) {
        int j = bi & 3;
        if (j == 0) c0 = -INFINITY;
        else if (j == 1) c1 = -INFINITY;
        else if (j == 2) c2 = -INFINITY;
        else c3 = -INFINITY;
      }
    }
    const int ea = __shfl(i1, (cisel >> 4) & 15);
    const int eb = __shfl(i2, cisel & 15);
    const int e = ea * 128 + eb;
    const float mx = __shfl(vals, 0);
    float ex = (lane < 16) ? expf(vals - mx) : 0.f;
    float sum = wave_sum(ex);
    if (lane < 16) {
      peidx[tok * 128 + hh * 16 + lane] = e;
      peg[tok * 128 + hh * 16 + lane] = ex / sum;
    }
    __syncthreads();
  }
}

DEV void peer_expert_item(const Params& p, int layer, int item, float* sm) {
  const int tid = tidx(), lane = tid & 63, wave = tid >> 6;
  const size_t tok = (size_t)item;
  const int b = (int)(tok / S);
  int* idx = (int*)sm;
  float* gt = sm + 128;
  float* act = sm + 256;
  if (tid < 128) {
    idx[tid] = ((const int*)(p.ws + OFF_PEIDX))[tok * 128 + tid];
    gt[tid] = ((const float*)(p.ws + OFF_PEG))[tok * 128 + tid];
  }
  const bf16* hrow = (const bf16*)(p.ws + OFF_H) + tok * 1024;
  float hw[16];
#pragma unroll
  for (int i = 0; i < 4; ++i) {
    uint2 v = *(const uint2*)(hrow + i * 256 + lane * 4);
    hw[i * 4 + 0] = __uint_as_float(v.x << 16);
    hw[i * 4 + 1] = __uint_as_float(v.x & 0xffff0000u);
    hw[i * 4 + 2] = __uint_as_float(v.y << 16);
    hw[i * 4 + 3] = __uint_as_float(v.y & 0xffff0000u);
  }
  __syncthreads();
  const float* U = p.peer_u + (size_t)layer * NEXP * 1024;
  const float* V = p.peer_v + (size_t)layer * NEXP * 1024;
#pragma unroll 2
  for (int jj = 0; jj < 32; ++jj) {
    int j = wave * 32 + jj;
    const float* ur = U + (size_t)idx[j] * 1024;
    float part = 0.f;
#pragma unroll
    for (int i = 0; i < 4; ++i) {
      float4 u4 = *(const float4*)(ur + i * 256 + lane * 4);
      part += hw[i * 4] * u4.x + hw[i * 4 + 1] * u4.y + hw[i * 4 + 2] * u4.z + hw[i * 4 + 3] * u4.w;
    }
    part = wave_sum(part);
    if (lane == 0) act[j] = gt[j] * gelu_tanh(part);
  }
  __syncthreads();
  float a0 = 0.f, a1 = 0.f, a2 = 0.f, a3 = 0.f;
#pragma unroll 8
  for (int j = 0; j < 128; ++j) {
    float a = act[j];
    float4 v4 = *(const float4*)(V + (size_t)idx[j] * 1024 + tid * 4);
    a0 += a * v4.x; a1 += a * v4.y; a2 += a * v4.z; a3 += a * v4.w;
  }
  const float* ga = (const float*)(p.ws + OFF_MOD) + (layer * 2 + b) * 6144 + 5120 + tid * 4;
  float* xr = p.out + tok * 1024 + tid * 4;
  float4 xo = *(float4*)xr;
  xo.x += ga[0] * a0; xo.y += ga[1] * a1; xo.z += ga[2] * a2; xo.w += ga[3] * a3;
  *(float4*)xr = xo;
  __syncthreads();
}

DEV void pk_scores(const bf16* __restrict__ ktab, const bf16* __restrict__ qp, f32x4 (&s)[8], int g4, int c16) {
  bf16x8 qf[4];
#pragma unroll
  for (int ks = 0; ks < 4; ++ks) qf[ks] = *(const bf16x8*)(qp + ks * 32 + g4 * 8);
#pragma unroll
  for (int mi = 0; mi < 8; ++mi) {
    s[mi] = f32x4{0.f, 0.f, 0.f, 0.f};
#pragma unroll
    for (int ks = 0; ks < 4; ++ks) {
      const bf16x8 kf = *(const bf16x8*)(ktab + (mi * 16 + c16) * 128 + ks * 32 + g4 * 8);
      s[mi] = MFMA16(kf, qf[ks], s[mi]);
    }
  }
}
DEV void pk_top16(f32x4 (&s)[8], int g4, float (&vout)[16], int (&iout)[16]) {
#pragma unroll
  for (int rd = 0; rd < 16; ++rd) {
    float bv = -INFINITY;
    int bi = 1 << 20;
#pragma unroll
    for (int mi = 0; mi < 8; ++mi)
#pragma unroll
      for (int r = 0; r < 4; ++r) {
        const float v = s[mi][r];
        if (v > bv) { bv = v; bi = mi * 16 + g4 * 4 + r; }
      }
#pragma unroll
    for (int off = 16; off <= 32; off <<= 1) {
      const float ov = shx(bv, off);
      const int oi = shx(bi, off);
      if (ov > bv || (ov == bv && oi < bi)) { bv = ov; bi = oi; }
    }
    vout[rd] = bv;
    iout[rd] = bi;
#pragma unroll
    for (int mi = 0; mi < 8; ++mi)
#pragma unroll
      for (int r = 0; r < 4; ++r)
        if (mi * 16 + g4 * 4 + r == bi) s[mi][r] = -INFINITY;
  }
}
DEV void peer_topk_mfma_item(const Params& p, int layer, int item) {
  const int lane = tidx() & 63, wave = tidx() >> 6, g4 = lane >> 4, c16 = lane & 15;
  const size_t tok = (size_t)item * 8 + wave * 2 + (c16 >> 3);
  const int hh = c16 & 7;
  const bf16* qp = (const bf16*)(p.ws + OFF_QP) + tok * 2048 + hh * 256;
  const bf16* k1 = (const bf16*)(p.ws + OFF_PKB) + (size_t)(layer * 2 + 0) * 16384;
  const bf16* k2 = (const bf16*)(p.ws + OFF_PKB) + (size_t)(layer * 2 + 1) * 16384;
  float v1[16], v2[16];
  int i1[16], i2[16];
  {
    f32x4 s[8];
    pk_scores(k1, qp, s, g4, c16);
    pk_top16(s, g4, v1, i1);
  }
  {
    f32x4 s[8];
    pk_scores(k2, qp + 128, s, g4, c16);
    pk_top16(s, g4, v2, i2);
  }
  float v1s[4];
  int i1s[4];
#pragma unroll
  for (int j = 0; j < 4; ++j) {
    v1s[j] = (g4 == 0) ? v1[j] : (g4 == 1) ? v1[4 + j] : (g4 == 2) ? v1[8 + j] : v1[12 + j];
    i1s[j] = (g4 == 0) ? i1[j] : (g4 == 1) ? i1[4 + j] : (g4 == 2) ? i1[8 + j] : i1[12 + j];
  }
  float c0[16], c1[8], c2[5], c3[4];
#pragma unroll
  for (int b = 0; b < 16; ++b) c0[b] = ((4 * g4 + 1) * (b + 1) <= 16) ? v1s[0] + v2[b] : -INFINITY;
#pragma unroll
  for (int b = 0; b < 8; ++b) c1[b] = ((4 * g4 + 2) * (b + 1) <= 16) ? v1s[1] + v2[b] : -INFINITY;
#pragma unroll
  for (int b = 0; b < 5; ++b) c2[b] = ((4 * g4 + 3) * (b + 1) <= 16) ? v1s[2] + v2[b] : -INFINITY;
#pragma unroll
  for (int b = 0; b < 4; ++b) c3[b] = ((4 * g4 + 4) * (b + 1) <= 16) ? v1s[3] + v2[b] : -INFINITY;
  float vals[16];
  int eidx[16];
  const int cbase = g4 * 64;
#pragma unroll
  for (int rd = 0; rd < 16; ++rd) {
    float bv = -INFINITY;
    int bi = 1 << 20;
#pragma unroll
    for (int b = 0; b < 16; ++b) if (c0[b] > bv) { bv = c0[b]; bi = cbase + b; }
#pragma unroll
    for (int b = 0; b < 8; ++b) if (c1[b] > bv) { bv = c1[b]; bi = cbase + 16 + b; }
#pragma unroll
    for (int b = 0; b < 5; ++b) if (c2[b] > bv) { bv = c2[b]; bi = cbase + 32 + b; }
#pragma unroll
    for (int b = 0; b < 4; ++b) if (c3[b] > bv) { bv = c3[b]; bi = cbase + 48 + b; }
#pragma unroll
    for (int off = 16; off <= 32; off <<= 1) {
      const float ov = shx(bv, off);
      const int oi = shx(bi, off);
      if (ov > bv || (ov == bv && oi < bi)) { bv = ov; bi = oi; }
    }
    vals[rd] = bv;
    int e = -1;
#pragma unroll
    for (int b = 0; b < 16; ++b) if (cbase + b == bi) { c0[b] = -INFINITY; e = i1s[0] * 128 + i2[b]; }
#pragma unroll
    for (int b = 0; b < 8; ++b) if (cbase + 16 + b == bi) { c1[b] = -INFINITY; e = i1s[1] * 128 + i2[b]; }
#pragma unroll
    for (int b = 0; b < 5; ++b) if (cbase + 32 + b == bi) { c2[b] = -INFINITY; e = i1s[2] * 128 + i2[b]; }
#pragma unroll
    for (int b = 0; b < 4; ++b) if (cbase + 48 + b == bi) { c3[b] = -INFINITY; e = i1s[3] * 128 + i2[b]; }
    e = max(e, shx(e, 16));
    e = max(e, shx(e, 32));
    eidx[rd] = e;
  }
  float ex[16], sum = 0.f;
#pragma unroll
  for (int rd = 0; rd < 16; ++rd) { ex[rd] = expf(vals[rd] - vals[0]); sum += ex[rd]; }
  const float inv = 1.f / sum;
  if (g4 == 0) {
    int* pi = (int*)(p.ws + OFF_PEIDX) + tok * 128 + hh * 16;
    float* pg = (float*)(p.ws + OFF_PEG) + tok * 128 + hh * 16;
#pragma unroll
    for (int q = 0; q < 4; ++q) {
      *(int4*)(pi + q * 4) = int4{eidx[q * 4], eidx[q * 4 + 1], eidx[q * 4 + 2], eidx[q * 4 + 3]};
      *(float4*)(pg + q * 4) = float4{ex[q * 4] * inv, ex[q * 4 + 1] * inv, ex[q * 4 + 2] * inv, ex[q * 4 + 3] * inv};
    }
  }
}

DEV float pk_key(float v, int inv_idx, unsigned mask) {
  return __uint_as_float((__float_as_uint(v) & ~mask) | (unsigned)inv_idx);
}
DEV void sort32_desc(float (&x)[32]) {
#pragma unroll
  for (int k = 2; k <= 32; k <<= 1)
#pragma unroll
    for (int j = k >> 1; j > 0; j >>= 1)
#pragma unroll
      for (int i = 0; i < 32; ++i) {
        const int l = i ^ j;
        if (l > i) {
          const float a = x[i], b = x[l];
          const float hi = fmaxf(a, b), lo = fminf(a, b);
          if ((i & k) == 0) { x[i] = hi; x[l] = lo; } else { x[i] = lo; x[l] = hi; }
        }
      }
}
DEV void pk_top16_sorted(f32x4 (&s)[8], int g4, float (&vout)[16], int (&iout)[16]) {
  float x[32];
#pragma unroll
  for (int mi = 0; mi < 8; ++mi)
#pragma unroll
    for (int r = 0; r < 4; ++r) x[mi * 4 + r] = pk_key(s[mi][r], 127 - (mi * 16 + g4 * 4 + r), 0x7Fu);
  sort32_desc(x);
#pragma unroll
  for (int rd = 0; rd < 16; ++rd) {
    float w = x[0];
    w = fmaxf(w, shx(w, 16));
    w = fmaxf(w, shx(w, 32));
    vout[rd] = w;
    iout[rd] = 127 - (int)(__float_as_uint(w) & 0x7Fu);
    if (x[0] == w) {
#pragma unroll
      for (int i = 0; i < 15; ++i) x[i] = x[i + 1];
      x[15] = -INFINITY;
    }
  }
}
template <int N>
DEV void shift_row(float (&c)[N], int (&e)[N]) {
#pragma unroll
  for (int i = 0; i + 1 < N; ++i) { c[i] = c[i + 1]; e[i] = e[i + 1]; }
  c[N - 1] = -INFINITY;
}
DEV void peer_topk_item3(const Params& p, int layer, int item, int* lds_idx = nullptr, float* lds_gate = nullptr) {
  const int lane = tidx() & 63, wave = tidx() >> 6, g4 = lane >> 4, c16 = lane & 15;
  const size_t tok = (size_t)item * 8 + wave * 2 + (c16 >> 3);
  const int hh = c16 & 7;
  const bf16* qp = (const bf16*)(p.ws + OFF_QP) + tok * 2048 + hh * 256;
  const bf16* k1 = (const bf16*)(p.ws + OFF_PKB) + (size_t)(layer * 2 + 0) * 16384;
  const bf16* k2 = (const bf16*)(p.ws + OFF_PKB) + (size_t)(layer * 2 + 1) * 16384;
  float v1[16], v2[16];
  int i1[16], i2[16];
  {
    f32x4 s[8];
    pk_scores(k1, qp, s, g4, c16);
    pk_top16_sorted(s, g4, v1, i1);
  }
  {
    f32x4 s[8];
    pk_scores(k2, qp + 128, s, g4, c16);
    pk_top16_sorted(s, g4, v2, i2);
  }
  float v1s[4];
  int i1s[4];
#pragma unroll
  for (int j = 0; j < 4; ++j) {
    v1s[j] = (g4 == 0) ? v1[j] : (g4 == 1) ? v1[4 + j] : (g4 == 2) ? v1[8 + j] : v1[12 + j];
    i1s[j] = (g4 == 0) ? i1[j] : (g4 == 1) ? i1[4 + j] : (g4 == 2) ? i1[8 + j] : i1[12 + j];
  }
  float c0[16], c1[8], c2[5], c3[4];
  int e0[16], e1[8], e2[5], e3[4];
  const int cbase = g4 * 64;
#pragma unroll
  for (int b = 0; b < 16; ++b) {
    c0[b] = ((4 * g4 + 1) * (b + 1) <= 16) ? pk_key(v1s[0] + v2[b], 255 - (cbase + b), 0xFFu) : -INFINITY;
    e0[b] = i1s[0] * 128 + i2[b];
  }
#pragma unroll
  for (int b = 0; b < 8; ++b) {
    c1[b] = ((4 * g4 + 2) * (b + 1) <= 16) ? pk_key(v1s[1] + v2[b], 255 - (cbase + 16 + b), 0xFFu) : -INFINITY;
    e1[b] = i1s[1] * 128 + i2[b];
  }
#pragma unroll
  for (int b = 0; b < 5; ++b) {
    c2[b] = ((4 * g4 + 3) * (b + 1) <= 16) ? pk_key(v1s[2] + v2[b], 255 - (cbase + 32 + b), 0xFFu) : -INFINITY;
    e2[b] = i1s[2] * 128 + i2[b];
  }
#pragma unroll
  for (int b = 0; b < 4; ++b) {
    c3[b] = ((4 * g4 + 4) * (b + 1) <= 16) ? pk_key(v1s[3] + v2[b], 255 - (cbase + 48 + b), 0xFFu) : -INFINITY;
    e3[b] = i1s[3] * 128 + i2[b];
  }
  float vals[16];
  int eidx[16];
#pragma unroll
  for (int rd = 0; rd < 16; ++rd) {
    float w = fmaxf(fmaxf(c0[0], c1[0]), fmaxf(c2[0], c3[0]));
    w = fmaxf(w, shx(w, 16));
    w = fmaxf(w, shx(w, 32));
    vals[rd] = w;
    int e = -1;
    if (c0[0] == w) { e = e0[0]; shift_row(c0, e0); }
    if (c1[0] == w) { e = e1[0]; shift_row(c1, e1); }
    if (c2[0] == w) { e = e2[0]; shift_row(c2, e2); }
    if (c3[0] == w) { e = e3[0]; shift_row(c3, e3); }
    e = max(e, shx(e, 16));
    e = max(e, shx(e, 32));
    eidx[rd] = e;
  }
  float ex[16], sum = 0.f;
#pragma unroll
  for (int rd = 0; rd < 16; ++rd) { ex[rd] = expf(vals[rd] - vals[0]); sum += ex[rd]; }
  const float inv = 1.f / sum;
  if (g4 == 0) {
    int* pi = lds_idx ? (lds_idx + (c16 >> 3) * 128 + hh * 16) : ((int*)(p.ws + OFF_PEIDX) + tok * 128 + hh * 16);
    float* pg = lds_gate ? (lds_gate + (c16 >> 3) * 128 + hh * 16) : ((float*)(p.ws + OFF_PEG) + tok * 128 + hh * 16);
#pragma unroll
    for (int q = 0; q < 4; ++q) {
      *(int4*)(pi + q * 4) = int4{eidx[q * 4], eidx[q * 4 + 1], eidx[q * 4 + 2], eidx[q * 4 + 3]};
      *(float4*)(pg + q * 4) = float4{ex[q * 4] * inv, ex[q * 4 + 1] * inv, ex[q * 4 + 2] * inv, ex[q * 4 + 3] * inv};
    }
  }
}

typedef float f32x2_t __attribute__((ext_vector_type(2)));
DEV unsigned pack4_fp8(float a, float b, float c, float d) {
  int p = __builtin_amdgcn_cvt_pk_fp8_f32(a, b, 0, false);
  p = __builtin_amdgcn_cvt_pk_fp8_f32(c, d, p, true);
  return (unsigned)p;
}
DEV void unpack16_fp8(uint4 v, float* f) {
  f32x2_t r;
  r = __builtin_amdgcn_cvt_pk_f32_fp8((int)v.x, false); f[0] = r.x; f[1] = r.y;
  r = __builtin_amdgcn_cvt_pk_f32_fp8((int)v.x, true);  f[2] = r.x; f[3] = r.y;
  r = __builtin_amdgcn_cvt_pk_f32_fp8((int)v.y, false); f[4] = r.x; f[5] = r.y;
  r = __builtin_amdgcn_cvt_pk_f32_fp8((int)v.y, true);  f[6] = r.x; f[7] = r.y;
  r = __builtin_amdgcn_cvt_pk_f32_fp8((int)v.z, false); f[8] = r.x; f[9] = r.y;
  r = __builtin_amdgcn_cvt_pk_f32_fp8((int)v.z, true);  f[10] = r.x; f[11] = r.y;
  r = __builtin_amdgcn_cvt_pk_f32_fp8((int)v.w, false); f[12] = r.x; f[13] = r.y;
  r = __builtin_amdgcn_cvt_pk_f32_fp8((int)v.w, true);  f[14] = r.x; f[15] = r.y;
}
DEV void expert_cvt_item(const Params& p, int layer, int item) {
  const int lane = tidx() & 63, wave = tidx() >> 6;
  const int e = item * 4 + wave;
  unsigned char* dst = (unsigned char*)(p.ws + OFF_E8) + (size_t)e * 2048;
  float* sc = (float*)(p.ws + OFF_ESC) + (size_t)e * 2;
#pragma unroll
  for (int tb = 0; tb < 2; ++tb) {
    const float* src = (tb ? p.peer_v : p.peer_u) + ((size_t)layer * NEXP + e) * 1024 + lane * 16;
    float4 a = *(const float4*)src, b = *(const float4*)(src + 4), c = *(const float4*)(src + 8), d = *(const float4*)(src + 12);
    float mx = fmaxf(fmaxf(fmaxf(fabsf(a.x), fabsf(a.y)), fmaxf(fabsf(a.z), fabsf(a.w))),
                     fmaxf(fmaxf(fabsf(b.x), fabsf(b.y)), fmaxf(fabsf(b.z), fabsf(b.w))));
    mx = fmaxf(mx, fmaxf(fmaxf(fmaxf(fabsf(c.x), fabsf(c.y)), fmaxf(fabsf(c.z), fabsf(c.w))),
                         fmaxf(fmaxf(fabsf(d.x), fabsf(d.y)), fmaxf(fabsf(d.z), fabsf(d.w)))));
#pragma unroll
    for (int o = 32; o >= 1; o >>= 1) mx = fmaxf(mx, shx(mx, o));
    const float s = (mx > 0.f) ? 224.f / mx : 1.f;
    uint4 pk;
    pk.x = pack4_fp8(a.x * s, a.y * s, a.z * s, a.w * s);
    pk.y = pack4_fp8(b.x * s, b.y * s, b.z * s, b.w * s);
    pk.z = pack4_fp8(c.x * s, c.y * s, c.z * s, c.w * s);
    pk.w = pack4_fp8(d.x * s, d.y * s, d.z * s, d.w * s);
    *(uint4*)(dst + tb * 1024 + lane * 16) = pk;
    if (lane == 0) sc[tb] = 1.f / s;
  }
}

DEV float rdlane_f(float v, int l) { return __int_as_float(__builtin_amdgcn_readlane(__float_as_int(v), l)); }
DEV float dot16_f8(const float* hw, uint4 u) {
  float f[16];
  unpack16_fp8(u, f);
  float s = 0.f;
#pragma unroll
  for (int i = 0; i < 16; ++i) s += hw[i] * f[i];
  return s;
}
DEV void axpy16_f8(float* acc, float a, uint4 u) {
  float f[16];
  unpack16_fp8(u, f);
#pragma unroll
  for (int i = 0; i < 16; ++i) acc[i] += a * f[i];
}
#define PE_ROWPTR(idxv, j) (E8 + (size_t)__builtin_amdgcn_readlane(idxv, (j)) * 2048)
#define PE_LOAD8(P, idxv, j0, off)                                                                        \
  P##0 = *(const uint4*)(PE_ROWPTR(idxv, (j0)) + (off)); P##1 = *(const uint4*)(PE_ROWPTR(idxv, (j0) + 1) + (off)); \
  P##2 = *(const uint4*)(PE_ROWPTR(idxv, (j0) + 2) + (off)); P##3 = *(const uint4*)(PE_ROWPTR(idxv, (j0) + 3) + (off)); \
  P##4 = *(const uint4*)(PE_ROWPTR(idxv, (j0) + 4) + (off)); P##5 = *(const uint4*)(PE_ROWPTR(idxv, (j0) + 5) + (off)); \
  P##6 = *(const uint4*)(PE_ROWPTR(idxv, (j0) + 6) + (off)); P##7 = *(const uint4*)(PE_ROWPTR(idxv, (j0) + 7) + (off));
#define PE_DOTSET(P, j0, dv)                                                                              \
  {                                                                                                       \
    const float s0 = wave_sum(dot16_f8(hw, P##0)), s1 = wave_sum(dot16_f8(hw, P##1)),                     \
                s2 = wave_sum(dot16_f8(hw, P##2)), s3 = wave_sum(dot16_f8(hw, P##3)),                     \
                s4 = wave_sum(dot16_f8(hw, P##4)), s5 = wave_sum(dot16_f8(hw, P##5)),                     \
                s6 = wave_sum(dot16_f8(hw, P##6)), s7 = wave_sum(dot16_f8(hw, P##7));                     \
    if (lane == (j0)) dv = s0;                                                                            \
    if (lane == (j0) + 1) dv = s1;                                                                        \
    if (lane == (j0) + 2) dv = s2;                                                                        \
    if (lane == (j0) + 3) dv = s3;                                                                        \
    if (lane == (j0) + 4) dv = s4;                                                                        \
    if (lane == (j0) + 5) dv = s5;                                                                        \
    if (lane == (j0) + 6) dv = s6;                                                                        \
    if (lane == (j0) + 7) dv = s7;                                                                        \
  }
#define PE_AXPYSET(P, j0, av)                                                                             \
  {                                                                                                       \
    axpy16_f8(acc, rdlane_f(av, (j0)), P##0);     axpy16_f8(acc, rdlane_f(av, (j0) + 1), P##1);           \
    axpy16_f8(acc, rdlane_f(av, (j0) + 2), P##2); axpy16_f8(acc, rdlane_f(av, (j0) + 3), P##3);           \
    axpy16_f8(acc, rdlane_f(av, (j0) + 4), P##4); axpy16_f8(acc, rdlane_f(av, (j0) + 5), P##5);           \
    axpy16_f8(acc, rdlane_f(av, (j0) + 6), P##6); axpy16_f8(acc, rdlane_f(av, (j0) + 7), P##7);           \
  }
#define PE_DOT8(idxv, dv)                                                                                 \
  {                                                                                                       \
    uint4 pa0, pa1, pa2, pa3, pa4, pa5, pa6, pa7, pb0, pb1, pb2, pb3, pb4, pb5, pb6, pb7;                 \
    PE_LOAD8(pa, idxv, 0, 0)                                                                              \
    _Pragma("unroll 1") for (int g = 0; g < 4; ++g) {                                                     \
      const int j0 = g * 16;                                                                              \
      PE_LOAD8(pb, idxv, j0 + 8, 0)                                                                       \
      PE_DOTSET(pa, j0, dv)                                                                               \
      if (g < 3) { PE_LOAD8(pa, idxv, j0 + 16, 0) }                                                       \
      PE_DOTSET(pb, j0 + 8, dv)                                                                           \
    }                                                                                                     \
  }
#define PE_AXPY8(idxv, av)                                                                                \
  {                                                                                                       \
    uint4 pa0, pa1, pa2, pa3, pa4, pa5, pa6, pa7, pb0, pb1, pb2, pb3, pb4, pb5, pb6, pb7;                 \
    PE_LOAD8(pa, idxv, 0, 1024)                                                                           \
    _Pragma("unroll 1") for (int g = 0; g < 4; ++g) {                                                     \
      const int j0 = g * 16;                                                                              \
      PE_LOAD8(pb, idxv, j0 + 8, 1024)                                                                    \
      PE_AXPYSET(pa, j0, av)                                                                              \
      if (g < 3) { PE_LOAD8(pa, idxv, j0 + 16, 1024) }                                                    \
      PE_AXPYSET(pb, j0 + 8, av)                                                                          \
    }                                                                                                     \
  }
DEV void peer_expert_tok(const Params& p, int layer, size_t tok, float ga_scale, const int* pi, const float* pg) {
  const int lane = tidx() & 63;
  const int b = (int)(tok / S);
  const int idx_lo = pi[lane], idx_hi = pi[64 + lane];
  const float g_lo = pg[lane], g_hi = pg[64 + lane];
  const float* esc = (const float*)(p.ws + OFF_ESC);
  const float2 sc_lo = *(const float2*)(esc + (size_t)idx_lo * 2), sc_hi = *(const float2*)(esc + (size_t)idx_hi * 2);
  const bf16* hrow = (const bf16*)(p.ws + OFF_H) + tok * 1024 + lane * 16;
  float hw[16];
  unpack8(*(const uint4*)hrow, hw);
  unpack8(*(const uint4*)(hrow + 8), hw + 8);
  const unsigned char* E8 = (const unsigned char*)(p.ws + OFF_E8) + lane * 16;
  float d_lo = 0.f, d_hi = 0.f;
  PE_DOT8(idx_lo, d_lo)
  PE_DOT8(idx_hi, d_hi)
  const float act_lo = g_lo * gelu_tanh(d_lo * sc_lo.x) * sc_lo.y;
  const float act_hi = g_hi * gelu_tanh(d_hi * sc_hi.x) * sc_hi.y;
  float acc[16];
#pragma unroll
  for (int i = 0; i < 16; ++i) acc[i] = 0.f;
  PE_AXPY8(idx_lo, act_lo)
  PE_AXPY8(idx_hi, act_hi)
  const float* ga = (const float*)(p.ws + OFF_MOD) + (layer * 2 + b) * 6144 + 5120 + lane * 16;
  float* xr = p.out + tok * 1024 + lane * 16;
  float xn[16];
  float ss = 0.f;
#pragma unroll
  for (int q4 = 0; q4 < 4; ++q4) {
    float4 xo = *(float4*)(xr + q4 * 4);
    const float4 g4v = *(const float4*)(ga + q4 * 4);
    xo.x += ga_scale * g4v.x * acc[q4 * 4 + 0];
    xo.y += ga_scale * g4v.y * acc[q4 * 4 + 1];
    xo.z += ga_scale * g4v.z * acc[q4 * 4 + 2];
    xo.w += ga_scale * g4v.w * acc[q4 * 4 + 3];
    xn[q4 * 4] = xo.x; xn[q4 * 4 + 1] = xo.y; xn[q4 * 4 + 2] = xo.z; xn[q4 * 4 + 3] = xo.w;
    ss += xo.x * xo.x + xo.y * xo.y + xo.z * xo.z + xo.w * xo.w;
  }
#if PROBE_ANY || REP_MASK
#pragma unroll
  for (int q4 = 0; q4 < 4; ++q4)
    *(float4*)(xr + q4 * 4) = float4{xn[q4 * 4], xn[q4 * 4 + 1], xn[q4 * 4 + 2], xn[q4 * 4 + 3]};
  return;
#endif
  ss = wave_sum(ss);
  const float rn = 1.0f / sqrtf(ss * (1.0f / 1024.f) + 1e-6f);
  if (layer == 0) {
    const float* gn = p.g_attn + 1024 + lane * 16;
    const float* md = (const float*)(p.ws + OFF_MOD) + (2 + b) * 6144 + lane * 16;
    bf16* hq = (bf16*)(p.ws + OFF_H) + tok * 1024 + lane * 16;
    unsigned pk[8];
#pragma unroll
    for (int q4 = 0; q4 < 4; ++q4) {
      *(float4*)(xr + q4 * 4) = float4{xn[q4 * 4], xn[q4 * 4 + 1], xn[q4 * 4 + 2], xn[q4 * 4 + 3]};
      const float4 g4v = *(const float4*)(gn + q4 * 4);
      const float4 s4 = *(const float4*)(md + 1024 + q4 * 4);
      const float4 h4 = *(const float4*)(md + q4 * 4);
      const float o0 = xn[q4 * 4] * rn * g4v.x * (1.f + s4.x) + h4.x;
      const float o1 = xn[q4 * 4 + 1] * rn * g4v.y * (1.f + s4.y) + h4.y;
      const float o2 = xn[q4 * 4 + 2] * rn * g4v.z * (1.f + s4.z) + h4.z;
      const float o3 = xn[q4 * 4 + 3] * rn * g4v.w * (1.f + s4.w) + h4.w;
      pk[q4 * 2] = cvtpk_(o0, o1);
      pk[q4 * 2 + 1] = cvtpk_(o2, o3);
    }
    *(uint4*)hq = uint4{pk[0], pk[1], pk[2], pk[3]};
    *(uint4*)(hq + 8) = uint4{pk[4], pk[5], pk[6], pk[7]};
  } else {
    const float* gf = p.g_final + lane * 16;
#pragma unroll
    for (int q4 = 0; q4 < 4; ++q4) {
      const float4 g4v = *(const float4*)(gf + q4 * 4);
      *(float4*)(xr + q4 * 4) = float4{xn[q4 * 4] * rn * g4v.x, xn[q4 * 4 + 1] * rn * g4v.y, xn[q4 * 4 + 2] * rn * g4v.z,
                                       xn[q4 * 4 + 3] * rn * g4v.w};
    }
  }
}

DEV void peer_expert_item2(const Params& p, int layer, int item, float ga_scale = 1.f) {
  const size_t tok = (size_t)item * 4 + (tidx() >> 6);
  peer_expert_tok(p, layer, tok, ga_scale, (const int*)(p.ws + OFF_PEIDX) + tok * 128, (const float*)(p.ws + OFF_PEG) + tok * 128);
}
DEV void peer_fused_item(const Params& p, int layer, int item, char* smem) {
  const int wave = tidx() >> 6;
  int* li = (int*)(smem + wave * 2048);
  float* lg = (float*)(smem + wave * 2048 + 1024);
  peer_topk_item3(p, layer, item, li, lg);
  asm volatile("s_waitcnt lgkmcnt(0)" ::: "memory");
  __builtin_amdgcn_wave_barrier();
  const size_t tok0 = (size_t)item * 8 + wave * 2;
  peer_expert_tok(p, layer, tok0, 1.f, li, lg);
  peer_expert_tok(p, layer, tok0 + 1, 1.f, li + 128, lg + 128);
  asm volatile("s_waitcnt lgkmcnt(0)" ::: "memory");
  __builtin_amdgcn_wave_barrier();
}
template <class F>
DEV void for_tiles_xcd(int MT, int NT, F f) {
  const int nb = gridDim.x, bid = blockIdx.x;
  if ((nb & 7) != 0) {
    for (int it = bid; it < MT * NT; it += nb) f(it / NT, it % NT);
    return;
  }
  const int xcd = bid & 7, slot = bid >> 3, nslot = nb >> 3;
  const int nj = (NT - xcd + 7) >> 3;
  for (int q = slot; q < MT * nj; q += nslot) f(q / nj, xcd + 8 * (q % nj));
}
constexpr int PH_PER_LAYER = 15;
enum { SP_NORM1 = 0, SP_INPROJ = 1, SP_COMPRESS = 2, SP_KMEAN = 3, SP_ATTN = 4, SP_MP0 = 5, SP_MM0 = 6, SP_MP1 = 7, SP_MM1 = 8,
       SP_MERGE = 9, SP_OUTPROJ = 10, SP_NORM2 = 11, SP_PEERQ = 12, SP_TOPK = 13, SP_EXPERT = 14 };
constexpr int N_REAL_PHASES = 1 + 2 * PH_PER_LAYER + 1;
constexpr int N_PHASES = N_REAL_PHASES + (PROBE_ANY ? 2 : 0);

DEV void run_phase(const Params& p, int ph, char* smem_raw, bool second_pass = false) {
#define SKIP_MOBA_SECOND (REP_NSA_ONLY && second_pass)
  float* smf = (float*)smem_raw;
  bf16* smh = (bf16*)smem_raw;
  const int nb = gridDim.x, bid = blockIdx.x;
  if (ph == 0) {
    for (int it = bid; it < PREP_ITEMS; it += nb) prep_item(p, it, smf);
    return;
  }
  if (ph == N_REAL_PHASES - 1) {
    for (int it = bid; it < T / 4; it += nb) final_norm_item(p.out, p.g_final, it);
    return;
  }
#if PROBE_ANY
  if (ph == N_REAL_PHASES) {
#if PROBE_PROJ
    {
      const bf16* Hh = (const bf16*)(p.ws + OFF_H);
      const bf16* Wt = (const bf16*)(p.ws + OFF_WINT) + (size_t)1 * WN * 1024;
      const float* rope = (const float*)(p.ws + OFF_ROPE);
      float sd = 0.f, sr = 0.f;
      for (size_t i = (size_t)bid * 256 + tidx(); i < (size_t)(T / 64) * 4888; i += (size_t)nb * 256) {
        const int ts = (int)(i / 4888), vc = (int)(i % 4888);
        const int tok = ts * 64 + (ts % 61);
        const int b = tok / S, t = tok % S;
        auto rawdot = [&](int col) {
          float a = 0.f;
          for (int k = 0; k < 1024; ++k) a += bf2f(Hh[(size_t)tok * 1024 + k]) * bf2f(Wt[(size_t)col * 1024 + k]);
          return a;
        };
        float v = rawdot(vc);
        bool roped = false;
        const bf16* dst;
        if (vc < 768) dst = (const bf16*)(p.ws + OFF_PROJ) + (size_t)tok * PC + vc;
        else if (vc < 1280) {
          const int seg = (vc - 768) >> 7, head = ((vc - 768) >> 6) & 1, d = vc & 63;
          const size_t off = (seg == 0) ? OFF_KSB : (seg == 1) ? OFF_VSB : (seg == 2) ? OFF_KWB : OFF_VWB;
          dst = (const bf16*)(p.ws + off) + ((size_t)(b * 2 + head) * S + t) * 64 + d;
          roped = (seg == 0 || seg == 2);
        } else if (vc < 1792) { dst = (const bf16*)(p.ws + OFF_PROJ) + (size_t)tok * PC + C_MQ + (vc - 1280); roped = true; }
        else if (vc < 2816) {
          const int seg = (vc - 1792) >> 9, head = ((vc - 1792) >> 6) & 7, d = vc & 63;
          dst = (const bf16*)(p.ws + (seg ? OFF_MVB : OFF_MKB)) + ((size_t)(b * 8 + head) * S + t) * 64 + d;
          roped = (seg == 0);
        } else if (vc < 4864) dst = (const bf16*)(p.ws + OFF_PROJ) + (size_t)tok * PC + C_GN + (vc - 2816);
        else dst = (const bf16*)(p.ws + OFF_PROJ) + (size_t)tok * PC + C_NG + (vc - 4864);
        const int d = vc & 63;
        if (roped && d < 16) {
          const float cs = rope[(size_t)t * 16 + (d & 7)], sn = rope[(size_t)t * 16 + 8 + (d & 7)];
          if (d < 8) { const float x2 = rawdot(vc + 8); v = v * cs - x2 * sn; }
          else { const float x1 = rawdot(vc - 8); v = v * cs + x1 * sn; }
        }
        const float got = bf2f(*dst);
        const bool is_r = roped && d < 16;
        if (PROBE_PROJ == 1 || (PROBE_PROJ == 2 && is_r) || (PROBE_PROJ == 3 && !is_r)) {
          sd += (got - v) * (got - v);
          sr += v * v;
        }
      }
      sd = wave_sum(sd); sr = wave_sum(sr);
      if ((tidx() & 63) == 0) {
        atomicAdd((float*)(p.ws + OFF_PROBE), sd);
        atomicAdd((float*)(p.ws + OFF_PROBE) + 1, sr);
      }
    }
#endif
#if PROBE_CMPR
    {
      float sd = 0.f, sr = 0.f;
      for (size_t i = (size_t)bid * 256 + tidx(); i < (size_t)2 * Bn * 1024 * 128; i += (size_t)nb * 256) {
        const size_t wh = i / ((size_t)Bn * 1024 * 128), r = i % ((size_t)Bn * 1024 * 128);
        const int c = (int)((r / 128) % 1024);
        if (c < 1023) {
          const float a = ((const float*)(p.ws + (wh ? OFF_VCC : OFF_KCC)))[r];
          const float y = ((const float*)(p.ws + OFF_CMP))[i];
          sd += (a - y) * (a - y);
          sr += y * y;
        }
      }
      sd = wave_sum(sd); sr = wave_sum(sr);
      if ((tidx() & 63) == 0) {
        atomicAdd((float*)(p.ws + OFF_PROBE), sd);
        atomicAdd((float*)(p.ws + OFF_PROBE) + 1, sr);
      }
    }
#endif
#if PROBE_MOBA
    probe_accum_bf16(p, (const bf16*)(p.ws + OFF_OMOBA), (const bf16*)(p.ws + OFF_CMP), (size_t)S * 512, smf);
#endif
#if PROBE_NSA == 8
    {
      const float* impn = (const float*)(p.ws + OFF_OMOBA);
      const float* impm = impn + (size_t)S * 256;
      const int* seld = (const int*)(p.ws + OFF_CMP);
      float sd = 0.f, sr = 0.f, bad = 0.f;
      for (int t = bid * 256 + tidx(); t < S; t += nb * 256) {
        const int cur = t >> 6;
        for (int n = 0; n < 256; ++n) {
          float a = impm[(size_t)t * 256 + n], r = impn[(size_t)t * 256 + n];
          sd += (a - r) * (a - r);
          sr += r * r;
        }
        unsigned want[8] = {0, 0, 0, 0, 0, 0, 0, 0}, got[8] = {0, 0, 0, 0, 0, 0, 0, 0};
        for (int j = 0; j < 16; ++j) {
          int v = seld[(size_t)t * 16 + j];
          if (v >= 0 && v < 256) {
            for (int w = 0; w < 8; ++w) if ((v >> 5) == w) got[w] |= 1u << (v & 31);
          }
        }
        if (cur < 16) {
          for (int n = 0; n <= cur; ++n) want[0] |= 1u << n;
        } else {
          want[0] |= 1u;
          for (int w = 0; w < 8; ++w) {
            if (((cur - 1) >> 5) == w) want[w] |= 1u << ((cur - 1) & 31);
            if ((cur >> 5) == w) want[w] |= 1u << (cur & 31);
          }
          for (int j = 0; j < 13; ++j) {
            float best = -1.f;
            int bi = 1;
            for (int n = 1; n <= cur - 2; ++n) {
              bool taken = false;
              for (int w = 0; w < 8; ++w) if ((n >> 5) == w) taken = (want[w] >> (n & 31)) & 1u;
              float v = impm[(size_t)t * 256 + n];
              if (!taken && v > best) { best = v; bi = n; }
            }
            for (int w = 0; w < 8; ++w) if ((bi >> 5) == w) want[w] |= 1u << (bi & 31);
          }
        }
        bool same = true;
        for (int w = 0; w < 8; ++w) same = same && (want[w] == got[w]);
        if (!same) bad += 1.f;
      }
      sd = wave_sum(sd); sr = wave_sum(sr); bad = wave_sum(bad);
      if ((tidx() & 63) == 0) {
        atomicAdd((float*)(p.ws + OFF_PROBE), sd);
        atomicAdd((float*)(p.ws + OFF_PROBE) + 1, sr);
        atomicAdd((float*)(p.ws + OFF_PROBE) + 2, bad);
      }
    }
#elif PROBE_NSA
    probe_accum_bf16(p, (const bf16*)(p.ws + OFF_ONSA), (const bf16*)(p.ws + OFF_CMP), (size_t)S * 512, smf);
#endif
    return;
  }
  if (ph == N_REAL_PHASES + 1) {
    probe_apply(p);
    return;
  }
#endif
  const int layer = (ph - 1) / PH_PER_LAYER, sub = (ph - 1) % PH_PER_LAYER;
  const float* mod = (const float*)(p.ws + OFF_MOD) + (size_t)layer * 2 * 6144;
  const float* xin = (layer == 0) ? p.x : p.out;
  bf16* H = (bf16*)(p.ws + OFF_H);
  bf16* PROJ = (bf16*)(p.ws + OFF_PROJ);
#if PROBE_ANY
  if (sub >= SP_MERGE) {
    if (sub == SP_OUTPROJ && layer == 0)
      for (size_t i = (size_t)bid * 256 + tidx(); i < (size_t)T * 1024; i += (size_t)nb * 256) p.out[i] = p.x[i];
    return;
  }
#endif
  switch (sub) {
    case SP_NORM1:
      for (int it = bid; it < T / 4; it += nb)
        norm_item(xin, p.g_attn + layer * 1024, mod + 1024, mod + 0, H, it);
      break;
    case SP_INPROJ: {
      for_tiles_xcd(T / 256, WN / 128, [&](int mt, int nt) { inproj_tile256(p, layer, mt * 256, nt * 128, smh); });
    } break;
    case SP_COMPRESS:
      for (int it = bid; it < 512 + 1024; it += nb) {
        if (it < 512) compress_mfma_item(p, layer, it, smem_raw);
        else kmean_item(p, it - 512, smf);
      }
#if PROBE_CMPR
      if (layer == 1)
        for (int it = bid; it < 1024; it += nb) compress_item(p, layer, it, smf);
#endif
      break;
    case SP_KMEAN:
#if PROBE_NSA
      if (layer == 1)
        for (int it = bid; it < 512; it += nb) n1_item(p, layer, it, smf);
#endif
      break;
    case SP_ATTN:
      {
        constexpr int MNI = 2;
        constexpr int NMOBA = 16 * (S / (64 * MNI));
        constexpr int NNI = 2;
        constexpr int NNSA = 4 * (S / (16 * NNI));
        const bool do_nsa = !PROBE_ANY || PROBE_NSA, do_moba = (!PROBE_ANY || PROBE_MOBA) && PROBE_NSA != 8;
        {
          constexpr int NCH = S / (16 * NNI);
          const bool affine = nb >= 8;
          const int grp = bid & 7, bk = grp & 3, sub = grp >> 2;
          const int i0 = affine ? (bid >> 3) : bid;
          const int istride = affine ? ((nb - grp + 7) >> 3) : nb;
          const int icount = affine ? (NCH / 2) : NNSA;
          if (do_nsa)
            for (int i = i0; i < icount; i += istride)
              nsa_item<NNI>(p, affine ? (((2 * i + sub) << 2) | bk) : i, smem_raw, (bf16*)(p.ws + OFF_ONSA));
          if (do_moba && !SKIP_MOBA_SECOND)
            for (int it = bid; it < NMOBA; it += nb) moba_gate_item<MNI>(p, it);
        }
#if PROBE_NSA && PROBE_NSA != 8
        if (layer == 1)
          for (int it = bid; it < 512; it += nb) n23_item(p, layer, it);
#endif
#if PROBE_MOBA
        if (layer == 1) {
          for (int it = bid; it < 512; it += nb) moba_item(p, layer, it);
        }
#endif
      }
      break;
    case SP_MP0:
    case SP_MP1:
      if ((!PROBE_ANY || PROBE_MOBA) && PROBE_NSA != 8)
        for (int it = bid; it < 8 * 63 * 8; it += nb) moba_part_item<2>(p, sub == SP_MP1 ? 1 : 0, it, smem_raw);
      break;
    case SP_MM0:
    case SP_MM1:
      if ((!PROBE_ANY || PROBE_MOBA) && PROBE_NSA != 8)
        for (int it = bid; it < 8 * (S / 128); it += nb)
          moba_merge_item<2>(p, sub == SP_MM1 ? 1 : 0, it, smem_raw, (bf16*)(p.ws + OFF_OMOBA));
      break;
    case SP_MERGE:
      for_tiles_xcd(T / 128, 8, [&](int mt, int nt) { merge_tile(p, layer, mt * 128, nt * 128, smh); });
      break;
    case SP_OUTPROJ: {
      const bf16* W = (const bf16*)(p.ws + OFF_WOUT) + (size_t)layer * 1024 * 1024;
      const float* ga1 = mod + 2048;
      for_tiles_xcd(T / 256, 8, [&](int mt, int nt) {
        f32x4 acc[2][4][4];
        acc_zero(acc[0]);
        acc_zero(acc[1]);
        gemm256_mainloop(H, 1024, W, 1024, mt * 256, nt * 128, smh, acc);
        const int lane_ = tidx() & 63, wv = tidx() >> 6;
#pragma unroll
        for (int h = 0; h < 2; ++h)
#pragma unroll
          for (int mi = 0; mi < 4; ++mi)
#pragma unroll
            for (int ni = 0; ni < 4; ++ni)
#pragma unroll
              for (int r = 0; r < 4; ++r) {
                const int row = mt * 256 + (wv >> 1) * 128 + h * 64 + mi * 16 + (lane_ >> 4) * 4 + r;
                const int col = nt * 128 + (wv & 1) * 64 + ni * 16 + (lane_ & 15);
                const int b = row / S;
                const size_t o = (size_t)row * 1024 + col;
                p.out[o] = xin[o] + ga1[b * 6144 + col] * acc[h][mi][ni][r];
              }
      });
    } break;
    case SP_NORM2:
      for (int it = bid; it < T / 4 + NEXP / 4; it += nb) {
        if (it < T / 4) norm_item(p.out, p.g_ffn + layer * 1024, mod + 4096, mod + 3072, H, it);
        else expert_cvt_item(p, layer, it - T / 4);
      }
      break;
    case SP_PEERQ: {
      const bf16* W = (const bf16*)(p.ws + OFF_WQ) + (size_t)layer * 2048 * 1024;
      bf16* QP = (bf16*)(p.ws + OFF_QP);
      for_tiles_xcd(T / 256, 16, [&](int mt, int nt) {
        f32x4 acc[2][4][4];
        acc_zero(acc[0]);
        acc_zero(acc[1]);
        gemm256_mainloop(H, 1024, W, 1024, mt * 256, nt * 128, smh, acc);
        const int wv = tidx() >> 6;
        store_tile_bf16(smh, acc[0], QP + (size_t)(mt * 256 + (wv >> 1) * 128) * 2048 + nt * 128 + (wv & 1) * 64, 2048);
        store_tile_bf16(smh, acc[1], QP + (size_t)(mt * 256 + (wv >> 1) * 128 + 64) * 2048 + nt * 128 + (wv & 1) * 64, 2048);
      });
    } break;
    case SP_TOPK:
#if REP_MASK
      for (int it = bid; it < T / 8; it += nb) peer_topk_item3(p, layer, it);
#endif
      break;
    case SP_EXPERT:
#if REP_MASK
      for (int it = bid; it < T / 4; it += nb) peer_expert_item2(p, layer, it, second_pass ? 0.f : 1.f);
#else
      for (int it = bid; it < T / 8; it += nb) peer_fused_item(p, layer, it, smem_raw);
#endif
      break;
  }
}

#if PROBE_ANY
#define MEGA_LB __launch_bounds__(256)
#else
#define MEGA_LB __launch_bounds__(256, 2)
#endif
__global__ void MEGA_LB mega_kernel(Params p, int ph_lo, int ph_hi) {
  __shared__ __attribute__((aligned(16))) char smem_raw[SMEM_BYTES + 16];
  volatile LAS unsigned* xbst = (volatile LAS unsigned*)(smem_raw + SMEM_BYTES);
  if (threadIdx.x == 0) { xbst[0] = 0u; xbst[1] = 0u; xbst[2] = 0u; xbst[3] = 0u; }
  __syncthreads();
  XcdBarrier xb = xcd_barrier_post((unsigned*)(p.ws + OFF_BAR), xbst);
  for (int ph = ph_lo; ph < ph_hi; ++ph) {
#if !PROBE_ANY && !REP_MASK
    if (ph == N_REAL_PHASES - 1 || ph == 1 + PH_PER_LAYER || (ph >= 1 && (ph - 1) % PH_PER_LAYER == SP_KMEAN) ||
        (ph >= 1 && (ph - 1) % PH_PER_LAYER == SP_TOPK))
      continue;
#endif
#if REP_MASK
    const int nrep = (ph >= 1 && ph < N_REAL_PHASES - 1 && ((REP_MASK >> ((ph - 1) % PH_PER_LAYER)) & 1)) ? 2 : 1;
    for (int rep = 0; rep < nrep; ++rep) {
      if (rep) xcd_barrier(xb);
      run_phase(p, ph, smem_raw, rep != 0);
    }
#else
    run_phase(p, ph, smem_raw);
#endif
    if (ph + 1 < ph_hi) {
      if (ph == ph_lo) cg::this_grid().sync();
      else xcd_barrier(xb);
    }
  }
}

extern "C" void kernel_launch(void* const* d_in, const int* in_sizes, int n_in, void* d_out, int out_size, void* d_ws,
                              size_t ws_size, hipStream_t stream) {
  if (ws_size < WS_TOTAL) {
    fprintf(stderr, "workspace too small: %zu < %zu\n", ws_size, (size_t)WS_NEED);
    return;
  }
  Params p{};
  p.x = (const float*)d_in[0]; p.c = (const float*)d_in[1]; p.w_ada = (const float*)d_in[2];
  p.b_ada = (const float*)d_in[3]; p.g_attn = (const float*)d_in[4]; p.g_ffn = (const float*)d_in[5];
  p.w_in = (const float*)d_in[6]; p.cmp_pe = (const float*)d_in[7]; p.cmp_w1 = (const float*)d_in[8];
  p.cmp_w2 = (const float*)d_in[9]; p.w_up_nsa = (const float*)d_in[10]; p.w_up_moba = (const float*)d_in[11];
  p.w_out = (const float*)d_in[12]; p.peer_wq = (const float*)d_in[13]; p.peer_k1 = (const float*)d_in[14];
  p.peer_k2 = (const float*)d_in[15]; p.peer_u = (const float*)d_in[16]; p.peer_v = (const float*)d_in[17];
  p.g_final = (const float*)d_in[18];
  p.out = (float*)d_out;
  p.ws = (char*)d_ws;
  static int grid_blocks = 0;
  if (!grid_blocks) {
    int dev = 0, cus = 0, per_cu = 0;
    hipGetDevice(&dev);
    hipDeviceGetAttribute(&cus, hipDeviceAttributeMultiprocessorCount, dev);
    hipOccupancyMaxActiveBlocksPerMultiprocessor(&per_cu, mega_kernel, 256, 0);
    if (per_cu < 1) per_cu = 1;
    if (per_cu > 2) per_cu = 2;
    grid_blocks = cus * per_cu;
  }
  hipMemsetAsync((char*)d_ws + OFF_BAR, 0, BAR_BYTES, stream);
  int ph_lo = 0, ph_hi = N_PHASES;
  void* args[] = {(void*)&p, (void*)&ph_lo, (void*)&ph_hi};
  hipError_t e = hipLaunchCooperativeKernel((const void*)mega_kernel, dim3(grid_blocks), dim3(256), args, 0, stream);
  if (e != hipSuccess) fprintf(stderr, "cooperative launch failed: %s (grid %d)\n", hipGetErrorString(e), grid_blocks);
}
```

```cpp
#include <hip/hip_runtime.h>
#include <hip/hip_bf16.h>
#include <hip/hip_cooperative_groups.h>
#include <cstdio>
#include <cstdint>
namespace cg = cooperative_groups;

#define DEV __device__ __forceinline__
typedef unsigned short bf16;
using bf16x8 = __attribute__((ext_vector_type(8))) short;
using f32x4 = __attribute__((ext_vector_type(4))) float;

constexpr int Bn = 2, S = 16384, T = Bn * S, D = 1024;
constexpr int PC = 3456;
constexpr int WN = 5120;
constexpr int C_NQ = 0, C_KC = 512, C_VC = 640, C_MQ = 768, C_GN = 1280, C_GM = 2304, C_NG = 3328;
constexpr int NEXP = 16384;

constexpr size_t al(size_t x) { return (x + 255) & ~size_t(255); }
constexpr size_t OFF_MOD = 0;
constexpr size_t OFF_ROPE = al(OFF_MOD + 2 * 2 * 6144 * 4);
constexpr size_t OFF_PEB = al(OFF_ROPE + (size_t)S * 16 * 4);
constexpr size_t OFF_WINT = al(OFF_PEB + 2 * 2 * 128 * 4);
constexpr size_t OFF_WUPN = al(OFF_WINT + 2ull * WN * 1024 * 2);
constexpr size_t OFF_WUPM = al(OFF_WUPN + 2ull * 1024 * 512 * 2);
constexpr size_t OFF_WOUT = al(OFF_WUPM + 2ull * 1024 * 512 * 2);
constexpr size_t OFF_WQ = al(OFF_WOUT + 2ull * 1024 * 1024 * 2);
constexpr size_t OFF_KCC = al(OFF_WQ + 2ull * 2048 * 1024 * 2);
constexpr size_t OFF_VCC = al(OFF_KCC + 2ull * 1024 * 128 * 4);
constexpr size_t OFF_SEL = al(OFF_VCC + 2ull * 1024 * 128 * 4);
constexpr size_t OFF_KMEAN = al(OFF_SEL + 2ull * 2 * S * 16 * 4);
constexpr size_t OFF_KMHL = al(OFF_KMEAN + 2ull * 8 * 64 * 64 * 4);
constexpr size_t OFF_KCB = al(OFF_KMHL + 2ull * 2 * 8 * 64 * 64 * 2);
constexpr size_t OFF_VCB = al(OFF_KCB + 2ull * 2 * 1024 * 64 * 2);
constexpr size_t OFF_PKB = al(OFF_VCB + 2ull * 2 * 1024 * 64 * 2);
constexpr size_t OFF_W1T = al(OFF_PKB + 2ull * 2 * 128 * 128 * 2);
constexpr size_t OFF_BAR = al(OFF_W1T + 4ull * 128 * 2048 * 2);
constexpr size_t BAR_BYTES = 3456 * 4;
constexpr size_t OFF_PROBE = al(OFF_BAR + BAR_BYTES);
constexpr size_t OFF_H = al(OFF_PROBE + 256);
constexpr size_t OFF_ONSA = al(OFF_H + (size_t)T * 1024 * 2);
constexpr size_t OFF_OMOBA = al(OFF_ONSA + (size_t)T * 512 * 2);
constexpr size_t OFF_PROJ = al(OFF_OMOBA + (size_t)T * 512 * 2);
constexpr size_t KV2_BYTES = (size_t)Bn * 2 * S * 64 * 2, KV8_BYTES = (size_t)Bn * 8 * S * 64 * 2;
constexpr size_t OFF_KSB = al(OFF_PROJ + (size_t)T * PC * 2);
constexpr size_t OFF_VSB = OFF_KSB + KV2_BYTES;
constexpr size_t OFF_KWB = OFF_VSB + KV2_BYTES;
constexpr size_t OFF_VWB = OFF_KWB + KV2_BYTES;
constexpr size_t OFF_MKB = OFF_VWB + KV2_BYTES;
constexpr size_t OFF_MVB = OFF_MKB + KV8_BYTES;
constexpr int MLIST_PER_BH = 63 * S - 128 * 63 * 64;
constexpr size_t OFF_MLIST = OFF_MVB + KV8_BYTES;
constexpr size_t OFF_MCNT = al(OFF_MLIST + (size_t)Bn * 8 * MLIST_PER_BH * 2);
constexpr size_t WS_NEED = OFF_MCNT + (size_t)Bn * 8 * 64 * 4;
constexpr size_t PROJ_BYTES = (size_t)T * PC * 2;
constexpr size_t OFF_MPO = OFF_H;
constexpr size_t OFF_MPML = OFF_H + (size_t)8 * S * 3 * 64 * 2;
static_assert((size_t)8 * S * 3 * 64 * 2 + (size_t)8 * S * 3 * 8 <= (size_t)T * 1024 * 2, "moba partials must fit the H region");
constexpr size_t OFF_QP = OFF_PROJ;
constexpr size_t OFF_PEIDX = al(OFF_QP + (size_t)T * 2048 * 2);
constexpr size_t OFF_PEG = al(OFF_PEIDX + (size_t)T * 128 * 4);
constexpr size_t OFF_E8 = al(OFF_PEG + (size_t)T * 128 * 4);
constexpr size_t OFF_ESC = al(OFF_E8 + (size_t)NEXP * 2048);
static_assert(OFF_ESC + (size_t)NEXP * 2 * 4 <= OFF_PROJ + PROJ_BYTES, "peer alias overflow");
static_assert(WS_NEED <= 536870912ull, "workspace too big");
#ifndef PROBE_MOBA
#define PROBE_MOBA 0
#endif
constexpr size_t OFF_CMP = PROBE_MOBA ? OFF_ONSA : OFF_MLIST;
#ifndef REP_NSA_ONLY
#define REP_NSA_ONLY 0
#endif
#ifndef REP_NSA_PART
#define REP_NSA_PART 0
#endif
#ifndef REP_MASK
#define REP_MASK 0
#endif
#ifndef PROBE_MOBA
#define PROBE_MOBA 0
#endif
#ifndef PROBE_NSA
#define PROBE_NSA 0
#endif
#ifndef PROBE_CMPR
#define PROBE_CMPR 0
#endif
#ifndef PROBE_PROJ
#define PROBE_PROJ 0
#endif
#define PROBE_ANY (PROBE_MOBA || PROBE_NSA || PROBE_CMPR || PROBE_PROJ)
constexpr size_t WS_TOTAL = WS_NEED;
static_assert(WS_TOTAL <= 536870912ull, "workspace too big (probe)");

struct Params {
  const float *x, *c, *w_ada, *b_ada, *g_attn, *g_ffn, *w_in, *cmp_pe, *cmp_w1, *cmp_w2, *w_up_nsa, *w_up_moba, *w_out,
      *peer_wq, *peer_k1, *peer_k2, *peer_u, *peer_v, *g_final;
  float* out;
  char* ws;
};

constexpr int SMEM_BYTES = 74 * 1024;

DEV int tidx() {
  int t = threadIdx.x & 255;
  asm volatile("" : "+v"(t));
  return t;
}
DEV int hidx() { return __builtin_amdgcn_readfirstlane((int)(threadIdx.x >> 8)); }
DEV int vbid() { return (int)blockIdx.x * 2 + hidx(); }
DEV int vnb() { return (int)gridDim.x * 2; }
#define MFMA16B(a, b, c) __builtin_amdgcn_mfma_f32_16x16x32_bf16(a, b, c, 0, 0, 0)
DEV unsigned cvtpk_(float lo, float hi) {
  unsigned r;
  asm("v_cvt_pk_bf16_f32 %0, %1, %2" : "=v"(r) : "v"(lo), "v"(hi));
  return r;
}
DEV float bf2f(bf16 h) { return __uint_as_float(((unsigned)h) << 16); }
DEV bf16 f2bf(float f) {
  unsigned u = __float_as_uint(f);
  u += 0x7fffu + ((u >> 16) & 1u);
  return (bf16)(u >> 16);
}
DEV float gelu_tanh(float x) {
  float u = 0.7978845608028654f * (x + 0.044715f * x * x * x);
  return 0.5f * x * (1.f + tanhf(u));
}
DEV float sigmoidf_(float x) { return 1.f / (1.f + expf(-x)); }
DEV void unpack8(uint4 v, float* f) {
  f[0] = __uint_as_float(v.x << 16); f[1] = __uint_as_float(v.x & 0xffff0000u);
  f[2] = __uint_as_float(v.y << 16); f[3] = __uint_as_float(v.y & 0xffff0000u);
  f[4] = __uint_as_float(v.z << 16); f[5] = __uint_as_float(v.z & 0xffff0000u);
  f[6] = __uint_as_float(v.w << 16); f[7] = __uint_as_float(v.w & 0xffff0000u);
}
DEV float dot64_bf(const float* q, const bf16* row) {
  float s = 0.f;
#pragma unroll
  for (int i = 0; i < 8; ++i) {
    float f[8];
    unpack8(*(const uint4*)(row + i * 8), f);
#pragma unroll
    for (int j = 0; j < 8; ++j) s += q[i * 8 + j] * f[j];
  }
  return s;
}
DEV void axpy64_bf(float* o, float a, const bf16* row) {
#pragma unroll
  for (int i = 0; i < 8; ++i) {
    float f[8];
    unpack8(*(const uint4*)(row + i * 8), f);
#pragma unroll
    for (int j = 0; j < 8; ++j) o[i * 8 + j] += a * f[j];
  }
}
DEV float dot64_f(const float* q, const float* row) {
  float s = 0.f;
#pragma unroll
  for (int i = 0; i < 16; ++i) {
    float4 v = *(const float4*)(row + i * 4);
    s += q[i * 4] * v.x + q[i * 4 + 1] * v.y + q[i * 4 + 2] * v.z + q[i * 4 + 3] * v.w;
  }
  return s;
}
DEV void axpy64_f(float* o, float a, const float* row) {
#pragma unroll
  for (int i = 0; i < 16; ++i) {
    float4 v = *(const float4*)(row + i * 4);
    o[i * 4] += a * v.x; o[i * 4 + 1] += a * v.y; o[i * 4 + 2] += a * v.z; o[i * 4 + 3] += a * v.w;
  }
}
DEV void load_q64(float* q, const bf16* p, float scale) {
#pragma unroll
  for (int i = 0; i < 8; ++i) unpack8(*(const uint4*)(p + i * 8), q + i * 8);
#pragma unroll
  for (int i = 0; i < 64; ++i) q[i] *= scale;
}
DEV int lane_id_() { return __builtin_amdgcn_mbcnt_hi(~0u, __builtin_amdgcn_mbcnt_lo(~0u, 0u)); }
DEV int shx(int v, int m) {
  if (m == 1) return __builtin_amdgcn_update_dpp(0, v, 0xB1, 0xF, 0xF, true);
  if (m == 2) return __builtin_amdgcn_update_dpp(0, v, 0x4E, 0xF, 0xF, true);
  if (m == 4) return __builtin_amdgcn_ds_swizzle(v, 0x101F);
  if (m == 8) return __builtin_amdgcn_update_dpp(0, v, 0x128, 0xF, 0xF, true);
  if (m == 16) return __builtin_amdgcn_ds_swizzle(v, 0x401F);
  auto rr = __builtin_amdgcn_permlane32_swap((unsigned)v, (unsigned)v, false, false);
  return (lane_id_() < 32) ? (int)rr[1] : (int)rr[0];
}
DEV unsigned shx(unsigned v, int m) { return (unsigned)shx((int)v, m); }
DEV float shx(float v, int m) { return __int_as_float(shx(__float_as_int(v), m)); }
DEV float wave_sum(float v) {
#pragma unroll
  for (int o = 32; o >= 1; o >>= 1) v += shx(v, o);
  return v;
}

#define XB_TMO      128
#define XB_XCNT(j)  (256  + 64 * (j))
#define XB_XSUB(j)  (1280 + 64 * (j))
#define XB_XGEN(j)  (2304 + 64 * (j))
#define XB_TOP      3328
#define XB_TOPGEN   3392
#define XCD_BAR_WORDS 3456
#define XB_SPIN_CAP (1u << 18)
#define LAS __attribute__((address_space(3)))

__device__ __forceinline__ unsigned xb_ld(unsigned* p)              { return __hip_atomic_load(p, __ATOMIC_RELAXED, __HIP_MEMORY_SCOPE_AGENT); }
__device__ __forceinline__ unsigned xb_add(unsigned* p, unsigned v) { return __hip_atomic_fetch_add(p, v, __ATOMIC_RELAXED, __HIP_MEMORY_SCOPE_AGENT); }
__device__ __forceinline__ unsigned xb_xcc_id() { return (unsigned)__builtin_amdgcn_s_getreg((3 << 11) | 20) & 0xFu; }
#define XB_SPIN(cond, bar) do { unsigned _sp = 0; while (cond) { __builtin_amdgcn_s_sleep(1); \
    if ((++_sp & 255u) == 0u) { if (xb_ld(&(bar)[XB_TMO])) break; if (_sp > XB_SPIN_CAP) { atomicAdd(&(bar)[XB_TMO], 1u); break; } } } } while (0)

struct XcdBarrier {
    unsigned* bar; unsigned x;
    volatile LAS unsigned* st;
};

__device__ __forceinline__ XcdBarrier xcd_barrier_post(unsigned* bar, volatile LAS unsigned* st) {
    XcdBarrier b; b.bar = bar; b.x = xb_xcc_id(); b.st = st;
    if (threadIdx.x == 0) (void)xb_add(&bar[XB_XCNT(b.x)], 1u);
    return b;
}
__device__ __forceinline__ void xcd_barrier_complete(unsigned* bar, unsigned x, unsigned& nloc, unsigned& nx) {
    const unsigned G = gridDim.x * gridDim.y * gridDim.z;
    unsigned sum, cnt, mine, sp = 0u;
    for (;;) {
        sum = 0u; cnt = 0u; mine = 0u;
#pragma unroll
        for (unsigned j = 0; j < 16; ++j) { const unsigned c = xb_ld(&bar[XB_XCNT(j)]); sum += c; cnt += (c > 0u) ? 1u : 0u; mine = (j == x) ? c : mine; }
        if (sum == G) break;
        __builtin_amdgcn_s_sleep(1);
        if ((++sp & 255u) == 0u) { if (xb_ld(&bar[XB_TMO])) break; if (sp > XB_SPIN_CAP) { atomicAdd(&bar[XB_TMO], 1u); break; } }
    }
    nloc = mine > 0u ? mine : 1u; nx = cnt > 0u ? cnt : 1u;
}

__device__ __forceinline__ void xcd_barrier(const XcdBarrier& b) {
    asm volatile("s_waitcnt vmcnt(0)" ::: "memory");
    __syncthreads();
    if (threadIdx.x == 0) {
        unsigned* bar = b.bar;
        __builtin_amdgcn_s_waitcnt(0);
        unsigned nloc = b.st[0], nx = b.st[1];
        if (nloc == 0u) { xcd_barrier_complete(bar, b.x, nloc, nx); b.st[0] = nloc; b.st[1] = nx; }
        const unsigned old = xb_add(&bar[XB_XSUB(b.x)], 1u);
        const unsigned gen = old / nloc;
        if (old + 1u == (gen + 1u) * nloc) {
            __builtin_amdgcn_fence(__ATOMIC_RELEASE, "agent");
            asm volatile("s_waitcnt vmcnt(0)" ::: "memory");
            const unsigned og = xb_add(&bar[XB_TOP], 1u);
            const unsigned tg = og / nx;
            if (og + 1u == (tg + 1u) * nx) xb_add(&bar[XB_TOPGEN], 1u);
            else XB_SPIN(xb_ld(&bar[XB_TOPGEN]) == tg, bar);
            __builtin_amdgcn_fence(__ATOMIC_ACQUIRE, "agent");
            xb_add(&bar[XB_XGEN(b.x)], 1u);
            asm volatile("s_waitcnt vmcnt(0)" ::: "memory");
        } else {
            XB_SPIN(xb_ld(&bar[XB_XGEN(b.x)]) == gen, bar);
            __builtin_amdgcn_fence(__ATOMIC_ACQUIRE, "agent");
            asm volatile("s_waitcnt vmcnt(0)" ::: "memory");
        }
    }
    __syncthreads();
}


DEV int win_col_map(int j) {
  if (j < 1280) return j;
  if (j < 4864) return j + 24;
  if (j < 4888) return j - 4864 + 1280;
  return -1;
}
DEV void tr_tile(const float* __restrict__ src, int ldsrc, int K, bf16* __restrict__ dst, int kt, int nt, bool remap,
                 float* sm) {
  const int tid = tidx();
#pragma unroll 4
  for (int i = 0; i < 16; ++i) {
    int r = i * 4 + (tid >> 6), cx = tid & 63;
    int j = nt * 64 + cx, k = kt * 64 + r;
    int oc = remap ? win_col_map(j) : j;
    sm[r * 65 + cx] = (oc >= 0) ? src[(size_t)k * ldsrc + oc] : 0.f;
  }
  __syncthreads();
#pragma unroll 4
  for (int i = 0; i < 16; ++i) {
    int n = i * 4 + (tid >> 6), kk = tid & 63;
    dst[(size_t)(nt * 64 + n) * K + kt * 64 + kk] = f2bf(sm[kk * 65 + n]);
  }
  __syncthreads();
}

constexpr int PREP_TR_WIN = 2 * 80 * 16;
constexpr int PREP_TR_UPN = 2 * 16 * 8;
constexpr int PREP_TR_UPM = 2 * 16 * 8;
constexpr int PREP_TR_OUT = 2 * 16 * 16;
constexpr int PREP_TR_WQ = 2 * 32 * 16;
constexpr int PREP_ROPE = 512;
constexpr int PREP_MOD = 384;
constexpr int PREP_PEB = 16;
constexpr int PREP_PK = 32;
constexpr int PREP_TR_W1 = 4 * 2 * 32;
constexpr int PREP_ITEMS = PREP_TR_WIN + PREP_TR_UPN + PREP_TR_UPM + PREP_TR_OUT + PREP_TR_WQ + PREP_ROPE + PREP_MOD + PREP_PEB + PREP_PK + PREP_TR_W1;

DEV void prep_item(const Params& p, int item, float* sm) {
  const int tid = tidx();
  if (item < PREP_TR_WIN) {
    int l = item / (80 * 16), r = item % (80 * 16);
    int nt = r / 16, kt = r % 16;
    tr_tile(p.w_in + (size_t)l * 1024 * 4888, 4888, 1024, (bf16*)(p.ws + OFF_WINT) + (size_t)l * WN * 1024, kt, nt, true, sm);
    return;
  }
  item -= PREP_TR_WIN;
  if (item < PREP_TR_UPN) {
    int l = item / 128, r = item % 128;
    int nt = r / 8, kt = r % 8;
    tr_tile(p.w_up_nsa + (size_t)l * 512 * 1024, 1024, 512, (bf16*)(p.ws + OFF_WUPN) + (size_t)l * 1024 * 512, kt, nt, false, sm);
    return;
  }
  item -= PREP_TR_UPN;
  if (item < PREP_TR_UPM) {
    int l = item / 128, r = item % 128;
    int nt = r / 8, kt = r % 8;
    tr_tile(p.w_up_moba + (size_t)l * 512 * 1024, 1024, 512, (bf16*)(p.ws + OFF_WUPM) + (size_t)l * 1024 * 512, kt, nt, false, sm);
    return;
  }
  item -= PREP_TR_UPM;
  if (item < PREP_TR_OUT) {
    int l = item / 256, r = item % 256;
    int nt = r / 16, kt = r % 16;
    tr_tile(p.w_out + (size_t)l * 1024 * 1024, 1024, 1024, (bf16*)(p.ws + OFF_WOUT) + (size_t)l * 1024 * 1024, kt, nt, false, sm);
    return;
  }
  item -= PREP_TR_OUT;
  if (item < PREP_TR_WQ) {
    int l = item / 512, r = item % 512;
    int nt = r / 16, kt = r % 16;
    tr_tile(p.peer_wq + (size_t)l * 1024 * 2048, 2048, 1024, (bf16*)(p.ws + OFF_WQ) + (size_t)l * 2048 * 1024, kt, nt, false, sm);
    return;
  }
  item -= PREP_TR_WQ;
  if (item < PREP_ROPE) {
    int idx = item * 256 + tid;
    int pos = idx >> 3, i = idx & 7;
    float inv = powf(500000.0f, -(float)i / 8.0f);
    float ang = (float)pos * inv;
    float* rp = (float*)(p.ws + OFF_ROPE) + (size_t)pos * 16;
    rp[i] = cosf(ang);
    rp[8 + i] = sinf(ang);
    return;
  }
  item -= PREP_ROPE;
  if (item < PREP_MOD) {
    for (int i = tid; i < 2048; i += 256) {
      float cv = p.c[i];
      sm[i] = cv / (1.f + expf(-cv));
    }
    __syncthreads();
    const int l = item / 192, n0 = (item % 192) * 32;
    const int col = tid & 31, ks = tid >> 5;
    const float* w = p.w_ada + (size_t)l * 1024 * 6144 + n0 + col;
    float a0 = 0.f, a1 = 0.f;
#pragma unroll 8
    for (int k = ks * 128; k < ks * 128 + 128; ++k) {
      float wv = w[(size_t)k * 6144];
      a0 += sm[k] * wv;
      a1 += sm[1024 + k] * wv;
    }
    sm[2048 + tid * 2] = a0;
    sm[2048 + tid * 2 + 1] = a1;
    __syncthreads();
    if (tid < 64) {
      const int c2 = tid & 31, bs = tid >> 5;
      float s = 0.f;
#pragma unroll
      for (int q = 0; q < 8; ++q) s += sm[2048 + (q * 32 + c2) * 2 + bs];
      ((float*)(p.ws + OFF_MOD))[(l * 2 + bs) * 6144 + n0 + c2] = s + p.b_ada[l * 6144 + n0 + c2];
    }
    __syncthreads();
    return;
  }
  item -= PREP_MOD;
  if (item < PREP_PEB) {
    const int lw = item >> 2, j0 = (item & 3) * 32;
    const int col = tid & 31, ks = tid >> 5;
    const float* pe = p.cmp_pe + (size_t)lw * 2048;
    const float* w1 = p.cmp_w1 + (size_t)lw * 2048 * 128 + j0 + col;
    float a = 0.f;
#pragma unroll 8
    for (int i = ks * 256; i < ks * 256 + 256; ++i) a += pe[i] * w1[(size_t)i * 128];
    sm[tid] = a;
    __syncthreads();
    if (tid < 32) {
      float s = 0.f;
#pragma unroll
      for (int q = 0; q < 8; ++q) s += sm[q * 32 + tid];
      ((float*)(p.ws + OFF_PEB))[lw * 128 + j0 + tid] = s;
    }
    if (item == 0 && tid < 4) ((float*)(p.ws + OFF_PROBE))[tid] = 0.f;
    __syncthreads();
    return;
  }
  item -= PREP_PEB;
  if (item < PREP_PK) {
    const int e0 = item * 2048 + tid * 8;
    const int lt = e0 >> 14, off = e0 & 16383;
    const float* srcp = ((lt & 1) ? p.peer_k2 : p.peer_k1) + (size_t)(lt >> 1) * 16384 + off;
    const float4 a = *(const float4*)srcp, b4 = *(const float4*)(srcp + 4);
    uint4 pk;
    pk.x = (unsigned)f2bf(a.x) | ((unsigned)f2bf(a.y) << 16);
    pk.y = (unsigned)f2bf(a.z) | ((unsigned)f2bf(a.w) << 16);
    pk.z = (unsigned)f2bf(b4.x) | ((unsigned)f2bf(b4.y) << 16);
    pk.w = (unsigned)f2bf(b4.z) | ((unsigned)f2bf(b4.w) << 16);
    *(uint4*)((bf16*)(p.ws + OFF_PKB) + e0) = pk;
    return;
  }
  item -= PREP_PK;
  {
    const int lw = item >> 6, r = item & 63;
    const int nt = r >> 5, kt = r & 31;
    tr_tile(p.cmp_w1 + (size_t)lw * 2048 * 128, 128, 2048, (bf16*)(p.ws + OFF_W1T) + (size_t)lw * 128 * 2048, kt, nt, false, sm);
  }
}

DEV void norm_item(const float* __restrict__ xin, const float* __restrict__ g, const float* __restrict__ sc,
                   const float* __restrict__ sh, bf16* __restrict__ hout, int item) {
  const int lane = tidx() & 63, wave = tidx() >> 6;
  const size_t tok = (size_t)item * 4 + wave;
  const int b = (int)(tok / S);
  const float* xr = xin + tok * 1024;
  float4 v[4];
  float ss = 0.f;
#pragma unroll
  for (int i = 0; i < 4; ++i) {
    v[i] = *(const float4*)(xr + i * 256 + lane * 4);
    ss += v[i].x * v[i].x + v[i].y * v[i].y + v[i].z * v[i].z + v[i].w * v[i].w;
  }
  ss = wave_sum(ss);
  float r = 1.0f / sqrtf(ss * (1.0f / 1024.f) + 1e-6f);
#pragma unroll
  for (int i = 0; i < 4; ++i) {
    int d = i * 256 + lane * 4;
    float4 gg = *(const float4*)(g + d);
    float4 s4 = *(const float4*)(sc + b * 6144 + d);
    float4 h4 = *(const float4*)(sh + b * 6144 + d);
    float o0 = v[i].x * r * gg.x * (1.f + s4.x) + h4.x;
    float o1 = v[i].y * r * gg.y * (1.f + s4.y) + h4.y;
    float o2 = v[i].z * r * gg.z * (1.f + s4.z) + h4.z;
    float o3 = v[i].w * r * gg.w * (1.f + s4.w) + h4.w;
    uint2 pk;
    pk.x = (unsigned)f2bf(o0) | ((unsigned)f2bf(o1) << 16);
    pk.y = (unsigned)f2bf(o2) | ((unsigned)f2bf(o3) << 16);
    *(uint2*)(hout + tok * 1024 + d) = pk;
  }
}
DEV void final_norm_item(float* __restrict__ x, const float* __restrict__ g, int item) {
  const int lane = tidx() & 63, wave = tidx() >> 6;
  const size_t tok = (size_t)item * 4 + wave;
  float* xr = x + tok * 1024;
  float4 v[4];
  float ss = 0.f;
#pragma unroll
  for (int i = 0; i < 4; ++i) {
    v[i] = *(const float4*)(xr + i * 256 + lane * 4);
    ss += v[i].x * v[i].x + v[i].y * v[i].y + v[i].z * v[i].z + v[i].w * v[i].w;
  }
  ss = wave_sum(ss);
  float r = 1.0f / sqrtf(ss * (1.0f / 1024.f) + 1e-6f);
#pragma unroll
  for (int i = 0; i < 4; ++i) {
    int d = i * 256 + lane * 4;
    float4 gg = *(const float4*)(g + d);
    float4 o;
    o.x = v[i].x * r * gg.x; o.y = v[i].y * r * gg.y; o.z = v[i].z * r * gg.z; o.w = v[i].w * r * gg.w;
    *(float4*)(xr + d) = o;
  }
}

#define GM_BUF (2 * 128 * 72)
#define GM_LOAD(R, kk)                                                                                  \
  {                                                                                                     \
    const bf16* Ak = Ap + (kk);                                                                         \
    const bf16* Wk = Wp + (kk);                                                                         \
    R##a0 = *(const uint4*)(Ak); R##a1 = *(const uint4*)(Ak + a32); R##a2 = *(const uint4*)(Ak + 2 * a32); \
    R##a3 = *(const uint4*)(Ak + 3 * a32);                                                              \
    R##b0 = *(const uint4*)(Wk); R##b1 = *(const uint4*)(Wk + w32); R##b2 = *(const uint4*)(Wk + 2 * w32); \
    R##b3 = *(const uint4*)(Wk + 3 * w32);                                                              \
  }
#define GM_STORE(R, buf)                                                                                \
  {                                                                                                     \
    bf16* as_ = Asw + (buf) * GM_BUF;                                                                   \
    bf16* bs_ = as_ + 128 * 72;                                                                         \
    *(uint4*)(as_) = R##a0; *(uint4*)(as_ + 32 * 72) = R##a1; *(uint4*)(as_ + 64 * 72) = R##a2; *(uint4*)(as_ + 96 * 72) = R##a3; \
    *(uint4*)(bs_) = R##b0; *(uint4*)(bs_ + 32 * 72) = R##b1; *(uint4*)(bs_ + 64 * 72) = R##b2; *(uint4*)(bs_ + 96 * 72) = R##b3; \
  }
#define GM_COMPUTE(buf)                                                                                 \
  {                                                                                                     \
    const bf16* As_ = sm + (buf) * GM_BUF;                                                              \
    const bf16* Bs_ = As_ + 128 * 72;                                                                   \
    _Pragma("unroll") for (int ks = 0; ks < 2; ++ks) {                                                  \
      __builtin_amdgcn_sched_barrier(0);                                                                \
      bf16x8 af[4], bfr[4];                                                                             \
      _Pragma("unroll") for (int mi = 0; mi < 4; ++mi)                                                  \
        af[mi] = *(const bf16x8*)(As_ + (wr * 64 + mi * 16 + (lane & 15)) * 72 + ks * 32 + (lane >> 4) * 8); \
      _Pragma("unroll") for (int ni = 0; ni < 4; ++ni)                                                  \
        bfr[ni] = *(const bf16x8*)(Bs_ + (wc * 64 + ni * 16 + (lane & 15)) * 72 + ks * 32 + (lane >> 4) * 8); \
      _Pragma("unroll") for (int mi = 0; mi < 4; ++mi)                                                  \
        _Pragma("unroll") for (int ni = 0; ni < 4; ++ni)                                                \
          acc[mi][ni] = __builtin_amdgcn_mfma_f32_16x16x32_bf16(af[mi], bfr[ni], acc[mi][ni], 0, 0, 0); \
    }                                                                                                   \
    __builtin_amdgcn_sched_barrier(0);                                                                  \
  }
DEV void gemm_mainloop(const bf16* __restrict__ A, int lda, const bf16* __restrict__ W, int K, int m0, int n0, bf16* sm,
                       f32x4 (&acc)[4][4]) {
  const int tid = tidx(), lane = tid & 63, wave = tid >> 6;
  const int wr = wave >> 1, wc = wave & 1;
  const int lrow = tid >> 3, lkc = (tid & 7) * 8;
  const bf16* Ap = A + (size_t)(m0 + lrow) * lda + lkc;
  const bf16* Wp = W + (size_t)(n0 + lrow) * K + lkc;
  const int a32 = 32 * lda, w32 = 32 * K;
  bf16* Asw = sm + lrow * 72 + lkc;
  uint4 xa0, xa1, xa2, xa3, xb0, xb1, xb2, xb3, ya0, ya1, ya2, ya3, yb0, yb1, yb2, yb3;
  const int nk = K >> 6;
  GM_LOAD(x, 0)
  GM_LOAD(y, 64)
  __syncthreads();
  GM_STORE(x, 0)
  if (nk > 2) GM_LOAD(x, 128)
  __syncthreads();
  for (int k = 0; k < nk; k += 2) {
    GM_COMPUTE(0)
    GM_STORE(y, 1)
    if (k + 3 < nk) GM_LOAD(y, (k + 3) * 64)
    __syncthreads();
    GM_COMPUTE(1)
    if (k + 2 < nk) {
      GM_STORE(x, 0)
      if (k + 4 < nk) GM_LOAD(x, (k + 4) * 64)
    }
    __syncthreads();
  }
}
DEV void gemm256_mainloop(const bf16* __restrict__ A, int lda, const bf16* __restrict__ W, int K, int m0, int n0, bf16* sm,
                          f32x4 (&acc)[2][4][4]) {
  bf16* As = sm;
  bf16* Bs = sm + 256 * 72;
  const int tid = tidx(), lane = tid & 63, wave = tid >> 6;
  const int wr = wave >> 1, wc = wave & 1;
  const int lrow = tid >> 3, lkc = (tid & 7) * 8;
  const bf16* Ap = A + (size_t)(m0 + lrow) * lda + lkc;
  const bf16* Wp = W + (size_t)(n0 + lrow) * K + lkc;
  const int a32 = 32 * lda, w32 = 32 * K;
  uint4 ra0, ra1, ra2, ra3, ra4, ra5, ra6, ra7, rb0, rb1, rb2, rb3;
#define G256_LOAD(kk)                                                                                   \
  {                                                                                                     \
    const bf16* Ak = Ap + (kk);                                                                         \
    const bf16* Wk = Wp + (kk);                                                                         \
    ra0 = *(const uint4*)(Ak); ra1 = *(const uint4*)(Ak + a32); ra2 = *(const uint4*)(Ak + 2 * a32);    \
    ra3 = *(const uint4*)(Ak + 3 * a32); ra4 = *(const uint4*)(Ak + 4 * a32); ra5 = *(const uint4*)(Ak + 5 * a32); \
    ra6 = *(const uint4*)(Ak + 6 * a32); ra7 = *(const uint4*)(Ak + 7 * a32);                           \
    rb0 = *(const uint4*)(Wk); rb1 = *(const uint4*)(Wk + w32); rb2 = *(const uint4*)(Wk + 2 * w32);    \
    rb3 = *(const uint4*)(Wk + 3 * w32);                                                                \
  }
  G256_LOAD(0)
  bf16* Asw = As + lrow * 72 + lkc;
  bf16* Bsw = Bs + lrow * 72 + lkc;
  for (int k0 = 0; k0 < K; k0 += 64) {
    __syncthreads();
    *(uint4*)(Asw) = ra0; *(uint4*)(Asw + 32 * 72) = ra1; *(uint4*)(Asw + 64 * 72) = ra2; *(uint4*)(Asw + 96 * 72) = ra3;
    *(uint4*)(Asw + 128 * 72) = ra4; *(uint4*)(Asw + 160 * 72) = ra5; *(uint4*)(Asw + 192 * 72) = ra6; *(uint4*)(Asw + 224 * 72) = ra7;
    *(uint4*)(Bsw) = rb0; *(uint4*)(Bsw + 32 * 72) = rb1; *(uint4*)(Bsw + 64 * 72) = rb2; *(uint4*)(Bsw + 96 * 72) = rb3;
    __syncthreads();
    if (k0 + 64 < K) G256_LOAD(k0 + 64)
#pragma unroll
    for (int ks = 0; ks < 2; ++ks) {
      bf16x8 bfr[4];
#pragma unroll
      for (int ni = 0; ni < 4; ++ni)
        bfr[ni] = *(const bf16x8*)(Bs + (wc * 64 + ni * 16 + (lane & 15)) * 72 + ks * 32 + (lane >> 4) * 8);
#pragma unroll
      for (int h = 0; h < 2; ++h) {
        __builtin_amdgcn_sched_barrier(0);
        bf16x8 af[4];
#pragma unroll
        for (int mi = 0; mi < 4; ++mi)
          af[mi] = *(const bf16x8*)(As + (wr * 128 + h * 64 + mi * 16 + (lane & 15)) * 72 + ks * 32 + (lane >> 4) * 8);
#pragma unroll
        for (int mi = 0; mi < 4; ++mi)
#pragma unroll
          for (int ni = 0; ni < 4; ++ni)
            acc[h][mi][ni] = __builtin_amdgcn_mfma_f32_16x16x32_bf16(af[mi], bfr[ni], acc[h][mi][ni], 0, 0, 0);
      }
    }
  }
}
DEV void acc_zero(f32x4 (&acc)[4][4]) {
#pragma unroll
  for (int i = 0; i < 4; ++i)
#pragma unroll
    for (int j = 0; j < 4; ++j) acc[i][j] = f32x4{0.f, 0.f, 0.f, 0.f};
}
DEV void store_tile_bf16(bf16* sm, const f32x4 (&acc)[4][4], bf16* __restrict__ dbase, size_t dstride) {
  const int tid = tidx(), lane = tid & 63, wave = tid >> 6, g4 = lane >> 4, c16 = lane & 15;
  bf16* Cw = sm + wave * (64 * 72);
  __syncthreads();
#pragma unroll
  for (int mi = 0; mi < 4; ++mi)
#pragma unroll
    for (int ni = 0; ni < 4; ++ni)
#pragma unroll
      for (int r = 0; r < 4; ++r) Cw[(mi * 16 + g4 * 4 + r) * 72 + ni * 16 + c16] = f2bf(acc[mi][ni][r]);
  __syncthreads();
#pragma unroll
  for (int it = 0; it < 8; ++it) {
    const int row_l = it * 8 + (lane >> 3), ch = lane & 7;
    const uint4 v = *(const uint4*)(Cw + row_l * 72 + ch * 8);
    *(uint4*)(dbase + (size_t)row_l * dstride + ch * 8) = v;
  }
}
template <class Epi>
DEV void gemm_tile(const bf16* __restrict__ A, int lda, const bf16* __restrict__ W, int K, int m0, int n0, bf16* sm,
                   Epi epi) {
  f32x4 acc[4][4];
  acc_zero(acc);
  gemm_mainloop(A, lda, W, K, m0, n0, sm, acc);
  const int tid = tidx(), lane = tid & 63, wave = tid >> 6;
  const int wr = wave >> 1, wc = wave & 1;
#pragma unroll
  for (int mi = 0; mi < 4; ++mi)
#pragma unroll
    for (int ni = 0; ni < 4; ++ni)
#pragma unroll
      for (int r = 0; r < 4; ++r) {
        int row = m0 + wr * 64 + mi * 16 + (lane >> 4) * 4 + r;
        int col = n0 + wc * 64 + ni * 16 + (lane & 15);
        epi(row, col, acc[mi][ni][r]);
      }
}
DEV void inproj_epilogue(const Params& p, f32x4 (&acc)[4][4], int row0, int vc0, bf16* sm) {
  const int tid = tidx(), lane = tid & 63, g4 = lane >> 4, c16 = lane & 15;
  const int b = row0 / S, t0 = row0 % S;
  bf16* dbase;
  size_t dstride;
  bool roped = false;
  bf16* projp = (bf16*)(p.ws + OFF_PROJ) + (size_t)row0 * PC;
  if (vc0 < 768) { dbase = projp + vc0; dstride = PC; }
  else if (vc0 < 1280) {
    const int seg = (vc0 - 768) >> 7, head = ((vc0 - 768) >> 6) & 1;
    const size_t off = (seg == 0) ? OFF_KSB : (seg == 1) ? OFF_VSB : (seg == 2) ? OFF_KWB : OFF_VWB;
    dbase = (bf16*)(p.ws + off) + ((size_t)(b * 2 + head) * S + t0) * 64;
    dstride = 64;
    roped = (seg == 0) || (seg == 2);
  } else if (vc0 < 1792) { dbase = projp + C_MQ + (vc0 - 1280); dstride = PC; roped = true; }
  else if (vc0 < 2816) {
    const int seg = (vc0 - 1792) >> 9, head = ((vc0 - 1792) >> 6) & 7;
    dbase = (bf16*)(p.ws + (seg ? OFF_MVB : OFF_MKB)) + ((size_t)(b * 8 + head) * S + t0) * 64;
    dstride = 64;
    roped = (seg == 0);
  } else if (vc0 < 4864) { dbase = projp + C_GN + (vc0 - 2816); dstride = PC; }
  else { dbase = projp + C_NG + (vc0 - 4864); dstride = PC; }
  if (roped) {
    const float* rope = (const float*)(p.ws + OFF_ROPE);
#pragma unroll
    for (int mi = 0; mi < 4; ++mi)
#pragma unroll
      for (int r = 0; r < 4; ++r) {
        const int pos = t0 + mi * 16 + g4 * 4 + r;
        const float v = acc[mi][0][r];
        const float pv = shx(v, 8);
        const float cs = rope[pos * 16 + (c16 & 7)], sn = rope[pos * 16 + 8 + (c16 & 7)];
        acc[mi][0][r] = (c16 < 8) ? (v * cs - pv * sn) : (v * cs + pv * sn);
      }
  }
  store_tile_bf16(sm, acc, dbase, dstride);
}
DEV void inproj_tile256(const Params& p, int layer, int m0, int n0, bf16* sm) {
  f32x4 acc[2][4][4];
  acc_zero(acc[0]);
  acc_zero(acc[1]);
  gemm256_mainloop((const bf16*)(p.ws + OFF_H), 1024, (const bf16*)(p.ws + OFF_WINT) + (size_t)layer * WN * 1024, 1024, m0, n0, sm, acc);
  const int wave = tidx() >> 6, wr = wave >> 1, wc = wave & 1;
  inproj_epilogue(p, acc[0], m0 + wr * 128, n0 + wc * 64, sm);
  inproj_epilogue(p, acc[1], m0 + wr * 128 + 64, n0 + wc * 64, sm);
}
typedef unsigned u32x2_t __attribute__((ext_vector_type(2)));
DEV void merge_tile(const Params& p, int layer, int m0, int n0, bf16* sm) {
  const int tid = tidx(), lane = tid & 63, wave = tid >> 6, g4 = lane >> 4, c16 = lane & 15;
  const int wr = wave >> 1, wc = wave & 1;
  const bf16* projg = (const bf16*)(p.ws + OFF_PROJ) + (size_t)(m0 + wr * 64 + g4 * 4) * PC + n0 + wc * 64 + c16;
  f32x4 acc[4][4];
  acc_zero(acc);
  gemm_mainloop((const bf16*)(p.ws + OFF_ONSA), 512, (const bf16*)(p.ws + OFF_WUPN) + (size_t)layer * 1024 * 512, 512, m0, n0, sm, acc);
  bf16* yg = (bf16*)(p.ws + OFF_H) + (size_t)(m0 + wr * 64 + g4 * 4) * 1024 + n0 + wc * 64 + c16;
#pragma unroll
  for (int mi = 0; mi < 4; ++mi)
#pragma unroll
    for (int ni = 0; ni < 4; ++ni)
#pragma unroll
      for (int r = 0; r < 4; ++r)
        yg[(size_t)(mi * 16 + r) * 1024 + ni * 16] =
            f2bf(sigmoidf_(bf2f(projg[(size_t)(mi * 16 + r) * PC + C_GN + ni * 16])) * acc[mi][ni][r]);
  acc_zero(acc);
  gemm_mainloop((const bf16*)(p.ws + OFF_OMOBA), 512, (const bf16*)(p.ws + OFF_WUPM) + (size_t)layer * 1024 * 512, 512, m0, n0, sm, acc);
#pragma unroll
  for (int mi = 0; mi < 4; ++mi)
#pragma unroll
    for (int ni = 0; ni < 4; ++ni)
#pragma unroll
      for (int r = 0; r < 4; ++r)
        acc[mi][ni][r] = bf2f(yg[(size_t)(mi * 16 + r) * 1024 + ni * 16]) +
                         sigmoidf_(bf2f(projg[(size_t)(mi * 16 + r) * PC + C_GM + ni * 16])) * acc[mi][ni][r];
  store_tile_bf16(sm, acc, (bf16*)(p.ws + OFF_H) + (size_t)(m0 + wr * 64) * 1024 + n0 + wc * 64, 1024);
}

DEV void merge_tile256(const Params& p, int layer, int m0, int n0, bf16* sm) {
  const int tid = tidx(), lane = tid & 63, wave = tid >> 6, g4 = lane >> 4, c16 = lane & 15;
  const int wr = wave >> 1, wc = wave & 1;
  f32x4 acc[2][4][4];
  acc_zero(acc[0]);
  acc_zero(acc[1]);
  gemm256_mainloop((const bf16*)(p.ws + OFF_ONSA), 512, (const bf16*)(p.ws + OFF_WUPN) + (size_t)layer * 1024 * 512, 512, m0, n0, sm, acc);
#pragma unroll
  for (int h = 0; h < 2; ++h) {
    const size_t rb = (size_t)(m0 + wr * 128 + h * 64 + g4 * 4);
    const bf16* projg = (const bf16*)(p.ws + OFF_PROJ) + rb * PC + n0 + wc * 64 + c16;
    bf16* yg = (bf16*)(p.ws + OFF_H) + rb * 1024 + n0 + wc * 64 + c16;
#pragma unroll
    for (int mi = 0; mi < 4; ++mi)
#pragma unroll
      for (int ni = 0; ni < 4; ++ni)
#pragma unroll
        for (int r = 0; r < 4; ++r)
          yg[(size_t)(mi * 16 + r) * 1024 + ni * 16] =
              f2bf(sigmoidf_(bf2f(projg[(size_t)(mi * 16 + r) * PC + C_GN + ni * 16])) * acc[h][mi][ni][r]);
  }
  acc_zero(acc[0]);
  acc_zero(acc[1]);
  gemm256_mainloop((const bf16*)(p.ws + OFF_OMOBA), 512, (const bf16*)(p.ws + OFF_WUPM) + (size_t)layer * 1024 * 512, 512, m0, n0, sm, acc);
#pragma unroll
  for (int h = 0; h < 2; ++h) {
    const size_t rb = (size_t)(m0 + wr * 128 + h * 64 + g4 * 4);
    const bf16* projg = (const bf16*)(p.ws + OFF_PROJ) + rb * PC + n0 + wc * 64 + c16;
    const bf16* yg = (const bf16*)(p.ws + OFF_H) + rb * 1024 + n0 + wc * 64 + c16;
#pragma unroll
    for (int mi = 0; mi < 4; ++mi)
#pragma unroll
      for (int ni = 0; ni < 4; ++ni)
#pragma unroll
        for (int r = 0; r < 4; ++r)
          acc[h][mi][ni][r] = bf2f(yg[(size_t)(mi * 16 + r) * 1024 + ni * 16]) +
                              sigmoidf_(bf2f(projg[(size_t)(mi * 16 + r) * PC + C_GM + ni * 16])) * acc[h][mi][ni][r];
    store_tile_bf16(sm, acc[h], (bf16*)(p.ws + OFF_H) + (size_t)(m0 + wr * 128 + h * 64) * 1024 + n0 + wc * 64, 1024);
  }
}

DEV void compress_item(const Params& p, int layer, int item, float* sm) {
  const int tid = tidx();
  const int grp = item & 127, which = (item >> 7) & 1, kvh = (item >> 8) & 1, b = item >> 9;
  const int c0 = grp * 8;
  float* xs = sm;
  float* hs = sm + 144 * 64;
  const bf16* proj = (const bf16*)(p.ws + OFF_PROJ);
  const int col = (which ? C_VC : C_KC) + kvh * 64;
  for (int i = tid; i < 144 * 64; i += 256) {
    int tl = i >> 6, d = i & 63;
    int t = c0 * 16 + tl;
    xs[i] = (t < S) ? bf2f(proj[((size_t)b * S + t) * PC + col + d]) : 0.f;
  }
  __syncthreads();
  const int lw = layer * 2 + which;
  if (tid < 128) {
    const float* w1 = p.cmp_w1 + (size_t)lw * 2048 * 128 + tid;
    float acc[8];
#pragma unroll
    for (int ci = 0; ci < 8; ++ci) acc[ci] = 0.f;
    for (int l = 0; l < 32; ++l) {
#pragma unroll 4
      for (int d = 0; d < 64; ++d) {
        float w = w1[(size_t)(l * 64 + d) * 128];
#pragma unroll
        for (int ci = 0; ci < 8; ++ci) acc[ci] += xs[(ci * 16 + l) * 64 + d] * w;
      }
    }
    float pb = ((const float*)(p.ws + OFF_PEB))[lw * 128 + tid];
#pragma unroll
    for (int ci = 0; ci < 8; ++ci) hs[ci * 128 + tid] = gelu_tanh(acc[ci] + pb);
  }
  __syncthreads();
  const float* w2 = p.cmp_w2 + (size_t)lw * 128 * 64;
  float* outp = PROBE_CMPR ? ((float*)(p.ws + OFF_CMP) + (which ? (size_t)Bn * 1024 * 128 : 0)) : (float*)(p.ws + (which ? OFF_VCC : OFF_KCC));
#pragma unroll
  for (int rr = 0; rr < 2; ++rr) {
    int o = rr * 256 + tid;
    int ci = o >> 6, d = o & 63;
    int c = c0 + ci;
    float a = 0.f;
    for (int j = 0; j < 128; ++j) a += hs[ci * 128 + j] * w2[j * 64 + d];
    if (c < 1023) outp[(((size_t)b * 1024 + c) * 2 + kvh) * 64 + d] = a;
    bf16* outb = (bf16*)(p.ws + (which ? OFF_VCB : OFF_KCB));
    if (!PROBE_CMPR && c < 1024) outb[(((size_t)b * 2 + kvh) * 1024 + c) * 64 + d] = (c < 1023) ? f2bf(a) : (bf16)0;
  }
  __syncthreads();
}

DEV void compress_mfma_item(const Params& p, int layer, int item, char* smem) {
  bf16* xs = (bf16*)smem;
  float* hs = (float*)(smem + 272 * 64 * 2);
  const int tid = tidx(), lane = tid & 63, wave = tid >> 6, g4 = lane >> 4, c16 = lane & 15;
  const int cblk = item & 63, which = (item >> 6) & 1, kvh = (item >> 7) & 1, b = item >> 8;
  const int t0 = cblk * 256;
  const bf16* proj = (const bf16*)(p.ws + OFF_PROJ) + (size_t)b * S * PC + (which ? C_VC : C_KC) + kvh * 64;
  __syncthreads();
  for (int i = tid; i < 272 * 8; i += 256) {
    const int tl = i >> 3, ch = i & 7;
    const int t = t0 + tl;
    uint4 v = uint4{0u, 0u, 0u, 0u};
    if (t < S) v = *(const uint4*)(proj + (size_t)t * PC + ch * 8);
    *(uint4*)(xs + tl * 64 + ((ch ^ ((tl >> 4) & 7)) * 8)) = v;
  }
  __syncthreads();
  const int lw = layer * 2 + which;
  const bf16* w1t = (const bf16*)(p.ws + OFF_W1T) + (size_t)lw * 128 * 2048;
  f32x4 acc0 = f32x4{0.f, 0.f, 0.f, 0.f}, acc1 = f32x4{0.f, 0.f, 0.f, 0.f};
  const bf16* wb0 = w1t + (size_t)((2 * wave) * 16 + c16) * 2048 + g4 * 8;
  const bf16* wb1 = w1t + (size_t)((2 * wave + 1) * 16 + c16) * 2048 + g4 * 8;
#pragma unroll 4
  for (int ks = 0; ks < 64; ++ks) {
    const int l = ks >> 1, ch = (ks & 1) * 4 + g4;
    const int tl = 16 * c16 + l;
    const bf16x8 af = *(const bf16x8*)(xs + tl * 64 + ((ch ^ ((tl >> 4) & 7)) * 8));
    const bf16x8 b0 = *(const bf16x8*)(wb0 + ks * 32);
    const bf16x8 b1 = *(const bf16x8*)(wb1 + ks * 32);
    acc0 = MFMA16B(af, b0, acc0);
    acc1 = MFMA16B(af, b1, acc1);
  }
  {
    const float* peb = (const float*)(p.ws + OFF_PEB) + lw * 128;
    const int j0 = (2 * wave) * 16 + c16, j1 = j0 + 16;
    const float pb0 = peb[j0], pb1 = peb[j1];
#pragma unroll
    for (int r = 0; r < 4; ++r) {
      hs[(g4 * 4 + r) * 128 + j0] = gelu_tanh(acc0[r] + pb0);
      hs[(g4 * 4 + r) * 128 + j1] = gelu_tanh(acc1[r] + pb1);
    }
  }
  __syncthreads();
  const float* w2 = p.cmp_w2 + (size_t)lw * 128 * 64;
  const int d = tid & 63, cq = tid >> 6;
  float o0 = 0.f, o1 = 0.f, o2 = 0.f, o3 = 0.f;
#pragma unroll 8
  for (int j = 0; j < 128; ++j) {
    const float w = w2[j * 64 + d];
    o0 += hs[(cq * 4 + 0) * 128 + j] * w;
    o1 += hs[(cq * 4 + 1) * 128 + j] * w;
    o2 += hs[(cq * 4 + 2) * 128 + j] * w;
    o3 += hs[(cq * 4 + 3) * 128 + j] * w;
  }
  float* outp = (float*)(p.ws + (which ? OFF_VCC : OFF_KCC));
  bf16* outb = (bf16*)(p.ws + (which ? OFF_VCB : OFF_KCB));
  const float ov[4] = {o0, o1, o2, o3};
#pragma unroll
  for (int i = 0; i < 4; ++i) {
    const int c = cblk * 16 + cq * 4 + i;
    if (c < 1023) outp[(((size_t)b * 1024 + c) * 2 + kvh) * 64 + d] = ov[i];
    outb[(((size_t)b * 2 + kvh) * 1024 + c) * 64 + d] = (c < 1023) ? f2bf(ov[i]) : (bf16)0;
  }
  __syncthreads();
}

DEV void n1_item(const Params& p, int layer, int item, float* sm) {
  const int chunk = item & 255, kvh = (item >> 8) & 1, b = item >> 9;
  const int tid = tidx(), ql = tid >> 2, g = tid & 3;
  const int t = chunk * 64 + ql, h = kvh * 4 + g;
  const size_t tok = (size_t)b * S + t;
  const bf16* proj = (const bf16*)(p.ws + OFF_PROJ);
  float* imp = sm;
  for (int i = tid; i < 64 * 257; i += 256) imp[i] = 0.f;
  float q[64];
  load_q64(q, proj + tok * PC + C_NQ + h * 64, 0.125f);
  const int nv = (t >= 31) ? (((t - 31) >> 4) + 1) : 0;
  const int nv_max = (((chunk * 64 + 63) - 31) >> 4) + 1;
  const float* kc = (const float*)(p.ws + OFF_KCC) + (size_t)b * 1024 * 128 + kvh * 64;
  const float* vc = (const float*)(p.ws + OFF_VCC) + (size_t)b * 1024 * 128 + kvh * 64;
  float m = -INFINITY, l = 0.f;
  for (int c = 0; c < nv_max; ++c) {
    float s = dot64_f(q, kc + (size_t)c * 128);
    if (c < nv) {
      float mn = fmaxf(m, s);
      l = l * expf(m - mn) + expf(s - mn);
      m = mn;
    }
  }
  __syncthreads();
  float o[64];
#pragma unroll
  for (int d = 0; d < 64; ++d) o[d] = 0.f;
  const float inv_l = (nv > 0) ? 1.f / l : 0.f;
  for (int c = 0; c < nv_max; ++c) {
    float s = dot64_f(q, kc + (size_t)c * 128);
    float pr = (c < nv) ? expf(s - m) * inv_l : 0.f;
    axpy64_f(o, pr, vc + (size_t)c * 128);
    float ps = pr;
    ps += shx(ps, 1);
    ps += shx(ps, 2);
    if (g == 0) {
      int n = c >> 2;
      if ((c & 3) == 3) {
        imp[ql * 257 + n] += 0.5f * ps;
        imp[ql * 257 + n + 1] += 0.5f * ps;
      } else {
        imp[ql * 257 + n] += ps;
      }
    }
  }
  const float gate0 = (!PROBE_NSA || (PROBE_NSA & 1)) ? sigmoidf_(bf2f(proj[tok * PC + C_NG + h * 3 + 0])) : 0.f;
  float* oa = (float*)(p.ws + OFF_H) + tok * 512 + h * 64;
#pragma unroll
  for (int d = 0; d < 64; d += 4) {
    float4 v = {gate0 * o[d], gate0 * o[d + 1], gate0 * o[d + 2], gate0 * o[d + 3]};
    *(float4*)(oa + d) = v;
  }
  __syncthreads();
#if PROBE_NSA == 8
  if (b == 0 && kvh == 0)
    for (int i = tid; i < 64 * 256; i += 256)
      ((float*)(p.ws + OFF_OMOBA))[(size_t)(chunk * 64 + (i >> 8)) * 256 + (i & 255)] = imp[(i >> 8) * 257 + (i & 255)];
  __syncthreads();
#endif
  if (g == 0) {
    int* selp = (int*)(p.ws + OFF_SEL) + (((size_t)b * 2 + kvh) * S + t) * 16;
    const int cur = chunk;
    if (cur < 16) {
      for (int j = 0; j < 16; ++j) selp[j] = (j <= cur) ? j : -1;
    } else {
      selp[0] = 0;
      selp[1] = cur - 1;
      selp[2] = cur;
      float* row = imp + ql * 257;
      for (int j = 3; j < 16; ++j) {
        float best = -1.f;
        int bi = 1;
        for (int n = 1; n <= cur - 2; ++n) {
          float v = row[n];
          if (v > best) { best = v; bi = n; }
        }
        selp[j] = bi;
        row[bi] = -2.f;
      }
    }
  }
  __syncthreads();
}

DEV void kmean_item(const Params& p, int item, float* sm) {
  const int n = item & 63, h = (item >> 6) & 7, b = item >> 9;
  const int tid = tidx(), d = tid & 63, part = tid >> 6;
  const bf16* mkb = (const bf16*)(p.ws + OFF_MKB);
  float a = 0.f;
  for (int i = 0; i < 64; ++i) {
    int t = n * 256 + part * 64 + i;
    a += bf2f(mkb[((size_t)(b * 8 + h) * S + t) * 64 + d]);
  }
  sm[tid] = a;
  __syncthreads();
  if (tid < 64) {
    float s = sm[tid] + sm[64 + tid] + sm[128 + tid] + sm[192 + tid];
    const size_t ko = (((size_t)b * 8 + h) * 64 + n) * 64 + tid;
    const float mean = s * (1.f / 256.f);
    ((float*)(p.ws + OFF_KMEAN))[ko] = mean;
    const bf16 hi = f2bf(mean);
    ((bf16*)(p.ws + OFF_KMHL))[ko] = hi;
    ((bf16*)(p.ws + OFF_KMHL))[(size_t)2 * 8 * 64 * 64 + ko] = f2bf(mean - bf2f(hi));
    if (tid == 0) ((int*)(p.ws + OFF_MCNT))[(b * 8 + h) * 64 + n] = 0;
  }
  __syncthreads();
}

DEV void n23_item(const Params& p, int layer, int item) {
  const int chunk = item & 255, kvh = (item >> 8) & 1, b = item >> 9;
  const int tid = tidx(), ql = tid >> 2, g = tid & 3;
  const int t = chunk * 64 + ql, h = kvh * 4 + g;
  const size_t tok = (size_t)b * S + t;
  const bf16* proj = (const bf16*)(p.ws + OFF_PROJ);
  const float* rope = (const float*)(p.ws + OFF_ROPE) + (size_t)t * 16;
  float q[64];
  load_q64(q, proj + tok * PC + C_NQ + h * 64, 1.0f);
#pragma unroll
  for (int i = 0; i < 8; ++i) {
    float cs = rope[i], sn = rope[8 + i];
    float x1 = q[i], x2 = q[8 + i];
    q[i] = x1 * cs - x2 * sn;
    q[8 + i] = x2 * cs + x1 * sn;
  }
#pragma unroll
  for (int i = 0; i < 64; ++i) q[i] *= 0.125f;
  const size_t kvo = ((size_t)(b * 2 + kvh) * S) * 64;
  const bf16* ksb = (const bf16*)(p.ws + OFF_KSB) + kvo;
  const bf16* vsb = (const bf16*)(p.ws + OFF_VSB) + kvo;
  const bf16* kwb = (const bf16*)(p.ws + OFF_KWB) + kvo;
  const bf16* vwb = (const bf16*)(p.ws + OFF_VWB) + kvo;
  const int* selp = (const int*)(p.ws + OFF_SEL) + (((size_t)b * 2 + kvh) * S + t) * 16;
  float* oa = (float*)(p.ws + OFF_H) + tok * 512 + h * 64;
  const float gate1 = (!PROBE_NSA || (PROBE_NSA & 2)) ? sigmoidf_(bf2f(proj[tok * PC + C_NG + h * 3 + 1])) : 0.f;
  const float gate2 = (!PROBE_NSA || (PROBE_NSA & 4)) ? sigmoidf_(bf2f(proj[tok * PC + C_NG + h * 3 + 2])) : 0.f;
  float o[64];
  {
    float m = -INFINITY;
    for (int j = 0; j < 16; ++j) {
      int n = selp[j];
      if (n >= 0) {
        for (int i = 0; i < 64; ++i) {
          int kpos = n * 64 + i;
          if (kpos <= t) {
            float s = dot64_bf(q, ksb + (size_t)kpos * 64);
            m = fmaxf(m, s);
          }
        }
      }
    }
    float l = 0.f;
#pragma unroll
    for (int d = 0; d < 64; ++d) o[d] = 0.f;
    for (int j = 0; j < 16; ++j) {
      int n = selp[j];
      if (n >= 0) {
        for (int i = 0; i < 64; ++i) {
          int kpos = n * 64 + i;
          if (kpos <= t) {
            float s = dot64_bf(q, ksb + (size_t)kpos * 64);
            float pr = expf(s - m);
            l += pr;
            axpy64_bf(o, pr, vsb + (size_t)kpos * 64);
          }
        }
      }
    }
    float sc = gate1 / l;
#pragma unroll
    for (int d = 0; d < 64; d += 4) {
      float4 v = *(float4*)(oa + d);
      v.x += sc * o[d]; v.y += sc * o[d + 1]; v.z += sc * o[d + 2]; v.w += sc * o[d + 3];
      *(float4*)(oa + d) = v;
    }
  }
  {
    const int s0 = chunk * 64;
    const int jlo = (s0 - 511 > 0) ? (s0 - 511) : 0;
    const int jhi = s0 + 63;
    float m = -INFINITY;
    for (int j = jlo; j <= jhi; ++j) {
      float s = dot64_bf(q, kwb + (size_t)j * 64);
      if (j <= t && j > t - 512) m = fmaxf(m, s);
    }
    float l = 0.f;
#pragma unroll
    for (int d = 0; d < 64; ++d) o[d] = 0.f;
    for (int j = jlo; j <= jhi; ++j) {
      float s = dot64_bf(q, kwb + (size_t)j * 64);
      float pr = (j <= t && j > t - 512) ? expf(s - m) : 0.f;
      l += pr;
      axpy64_bf(o, pr, vwb + (size_t)j * 64);
    }
    float sc = gate2 / l;
    bf16* ob = (bf16*)(p.ws + (PROBE_NSA ? OFF_CMP : OFF_ONSA)) + tok * 512 + h * 64;
#pragma unroll
    for (int d = 0; d < 64; d += 8) {
      float4 v0 = *(float4*)(oa + d);
      float4 v1 = *(float4*)(oa + d + 4);
      uint4 pk;
      pk.x = (unsigned)f2bf(v0.x + sc * o[d]) | ((unsigned)f2bf(v0.y + sc * o[d + 1]) << 16);
      pk.y = (unsigned)f2bf(v0.z + sc * o[d + 2]) | ((unsigned)f2bf(v0.w + sc * o[d + 3]) << 16);
      pk.z = (unsigned)f2bf(v1.x + sc * o[d + 4]) | ((unsigned)f2bf(v1.y + sc * o[d + 5]) << 16);
      pk.w = (unsigned)f2bf(v1.z + sc * o[d + 6]) | ((unsigned)f2bf(v1.w + sc * o[d + 7]) << 16);
      *(uint4*)(ob + d) = pk;
    }
  }
}

DEV void moba_item(const Params& p, int layer, int item) {
  const int blk = item & 63, h = (item >> 6) & 7, b = item >> 9;
  const int tid = tidx();
  const int t = blk * 256 + tid;
  const size_t tok = (size_t)b * S + t;
  const bf16* proj = (const bf16*)(p.ws + OFF_PROJ);
  float q[64];
  load_q64(q, proj + tok * PC + C_MQ + h * 64, 0.125f);
  const float* km = (const float*)(p.ws + OFF_KMEAN) + ((size_t)b * 8 + h) * 64 * 64;
  float b0 = -INFINITY, b1 = -INFINITY, b2 = -INFINITY;
  int i0 = -1, i1 = -1, i2 = -1;
  for (int n = 0; n < blk; ++n) {
    float v = dot64_f(q, km + n * 64);
    if (v > b0) { b2 = b1; i2 = i1; b1 = b0; i1 = i0; b0 = v; i0 = n; }
    else if (v > b1) { b2 = b1; i2 = i1; b1 = v; i1 = n; }
    else if (v > b2) { b2 = v; i2 = n; }
  }
  const bf16* mkb = (const bf16*)(p.ws + OFF_MKB) + ((size_t)(b * 8 + h) * S) * 64;
  const bf16* mvb = (const bf16*)(p.ws + OFF_MVB) + ((size_t)(b * 8 + h) * S) * 64;
  float m = -INFINITY;
  for (int sidx = 0; sidx < 3; ++sidx) {
    int n = (sidx == 0) ? i0 : (sidx == 1) ? i1 : i2;
    if (sidx < blk) {
      for (int i = 0; i < 256; ++i) {
        float s = dot64_bf(q, mkb + (size_t)(n * 256 + i) * 64);
        m = fmaxf(m, s);
      }
    }
  }
  for (int i = 0; i < 256; ++i) {
    int kpos = blk * 256 + i;
    float s = dot64_bf(q, mkb + (size_t)kpos * 64);
    if (kpos <= t) m = fmaxf(m, s);
  }
  float l = 0.f;
  float o[64];
#pragma unroll
  for (int d = 0; d < 64; ++d) o[d] = 0.f;
  for (int sidx = 0; sidx < 3; ++sidx) {
    int n = (sidx == 0) ? i0 : (sidx == 1) ? i1 : i2;
    if (sidx < blk) {
      for (int i = 0; i < 256; ++i) {
        const size_t ko = (size_t)(n * 256 + i) * 64;
        float s = dot64_bf(q, mkb + ko);
        float pr = expf(s - m);
        l += pr;
        axpy64_bf(o, pr, mvb + ko);
      }
    }
  }
  for (int i = 0; i < 256; ++i) {
    int kpos = blk * 256 + i;
    const size_t ko = (size_t)kpos * 64;
    float s = dot64_bf(q, mkb + ko);
    float pr = (kpos <= t) ? expf(s - m) : 0.f;
    l += pr;
    axpy64_bf(o, pr, mvb + ko);
  }
  const float il = 1.f / l;
  bf16* ob = (bf16*)(p.ws + (PROBE_MOBA ? OFF_CMP : OFF_OMOBA)) + tok * 512 + h * 64;
#pragma unroll
  for (int d = 0; d < 64; d += 8) {
    uint4 pk;
    pk.x = (unsigned)f2bf(o[d] * il) | ((unsigned)f2bf(o[d + 1] * il) << 16);
    pk.y = (unsigned)f2bf(o[d + 2] * il) | ((unsigned)f2bf(o[d + 3] * il) << 16);
    pk.z = (unsigned)f2bf(o[d + 4] * il) | ((unsigned)f2bf(o[d + 5] * il) << 16);
    pk.w = (unsigned)f2bf(o[d + 6] * il) | ((unsigned)f2bf(o[d + 7] * il) << 16);
    *(uint4*)(ob + d) = pk;
  }
}

typedef short v4i16_t __attribute__((ext_vector_type(4)));
typedef unsigned u32x4_t __attribute__((ext_vector_type(4)));
DEV v4i16_t lds_tr16(const bf16* p) {
  return __builtin_amdgcn_ds_read_tr16_b64_v4i16((__attribute__((address_space(3))) v4i16_t*)p);
}
DEV unsigned cvtpk(float lo, float hi) {
  unsigned r;
  asm("v_cvt_pk_bf16_f32 %0, %1, %2" : "=v"(r) : "v"(lo), "v"(hi));
  return r;
}
#define MFMA16(a, b, c) __builtin_amdgcn_mfma_f32_16x16x32_bf16(a, b, c, 0, 0, 0)
constexpr float C2 = 0.125f * 1.4426950408889634f;
constexpr int KT_LD = 72;
constexpr int KT_ELEMS = 64 * KT_LD;

template <int NI>
struct AttnSt {
  f32x4 o[4][NI];
  float m[NI], l[NI];
};
template <int NI>
DEV void attn_init(AttnSt<NI>& st) {
#pragma unroll
  for (int ni = 0; ni < NI; ++ni) {
    st.m[ni] = -INFINITY;
    st.l[ni] = 0.f;
#pragma unroll
    for (int di = 0; di < 4; ++di) st.o[di][ni] = f32x4{0.f, 0.f, 0.f, 0.f};
  }
}
#define TILE_DECL uint4 tl_k0, tl_k1, tl_v0, tl_v1
#define TILE_GLOAD(kb, vb, ld, key0)                                                        \
  do {                                                                                      \
    const int r_ = tidx() >> 3, c_ = (tidx() & 7) * 8;                            \
    tl_k0 = *(const uint4*)((kb) + (size_t)((key0) + r_) * (ld) + c_);                      \
    tl_k1 = *(const uint4*)((kb) + (size_t)((key0) + 32 + r_) * (ld) + c_);                 \
    tl_v0 = *(const uint4*)((vb) + (size_t)((key0) + r_) * (ld) + c_);                      \
    tl_v1 = *(const uint4*)((vb) + (size_t)((key0) + 32 + r_) * (ld) + c_);                 \
  } while (0)
#define TILE_SSTORE(Ks_, Vs_)                                                               \
  do {                                                                                      \
    const int r_ = tidx() >> 3, c_ = (tidx() & 7) * 8;                            \
    *(uint4*)((Ks_) + r_ * KT_LD + c_) = tl_k0;                                             \
    *(uint4*)((Ks_) + (32 + r_) * KT_LD + c_) = tl_k1;                                      \
    *(uint4*)((Vs_) + r_ * KT_LD + c_) = tl_v0;                                             \
    *(uint4*)((Vs_) + (32 + r_) * KT_LD + c_) = tl_v1;                                      \
  } while (0)
#define TL_GLOAD(P, kb, vb, ld, key0)                                                       \
  do {                                                                                      \
    const int r_ = tidx() >> 3, c_ = (tidx() & 7) * 8;                                      \
    P##_k0 = *(const uint4*)((kb) + (size_t)((key0) + r_) * (ld) + c_);                     \
    P##_k1 = *(const uint4*)((kb) + (size_t)((key0) + 32 + r_) * (ld) + c_);                \
    P##_v0 = *(const uint4*)((vb) + (size_t)((key0) + r_) * (ld) + c_);                     \
    P##_v1 = *(const uint4*)((vb) + (size_t)((key0) + 32 + r_) * (ld) + c_);                \
  } while (0)
#define TL_SSTORE(P, Ks_, Vs_)                                                              \
  do {                                                                                      \
    const int r_ = tidx() >> 3, c_ = (tidx() & 7) * 8;                                      \
    *(uint4*)((Ks_) + r_ * KT_LD + c_) = P##_k0;                                            \
    *(uint4*)((Ks_) + (32 + r_) * KT_LD + c_) = P##_k1;                                     \
    *(uint4*)((Vs_) + r_ * KT_LD + c_) = P##_v0;                                            \
    *(uint4*)((Vs_) + (32 + r_) * KT_LD + c_) = P##_v1;                                     \
  } while (0)
#define KV_SWEEP(kb_, vb_, ld_, nt_, KEYF, ...)                                             \
  {                                                                                         \
    uint4 tA_k0, tA_k1, tA_v0, tA_v1, tB_k0, tB_k1, tB_v0, tB_v1;                           \
    const int nt__ = (nt_);                                                                 \
    if (nt__ > 0) {                                                                         \
      TL_GLOAD(tA, kb_, vb_, ld_, KEYF(0));                                                 \
      TL_SSTORE(tA, smkv, smkv + KT_ELEMS);                                                 \
      if (nt__ > 1) TL_GLOAD(tA, kb_, vb_, ld_, KEYF(1));                                   \
    }                                                                                       \
    __syncthreads();                                                                        \
    for (int it0__ = 0; it0__ < nt__; it0__ += 2) {                                         \
      {                                                                                     \
        const int it = it0__;                                                               \
        if (it + 2 < nt__) TL_GLOAD(tB, kb_, vb_, ld_, KEYF(it + 2));                       \
        const bf16* Ks = smkv;                                                              \
        __VA_ARGS__                                                                         \
        if (it + 1 < nt__) TL_SSTORE(tA, smkv + 2 * KT_ELEMS, smkv + 3 * KT_ELEMS);         \
        __syncthreads();                                                                    \
      }                                                                                     \
      if (it0__ + 1 < nt__) {                                                               \
        const int it = it0__ + 1;                                                           \
        if (it + 2 < nt__) TL_GLOAD(tA, kb_, vb_, ld_, KEYF(it + 2));                       \
        const bf16* Ks = smkv + 2 * KT_ELEMS;                                               \
        __VA_ARGS__                                                                         \
        if (it + 1 < nt__) TL_SSTORE(tB, smkv, smkv + KT_ELEMS);                            \
        __syncthreads();                                                                    \
      }                                                                                     \
    }                                                                                       \
  }
template <int NI>
DEV void attn_scores(const bf16* Ks, const bf16x8 (&qf)[NI][2], f32x4 (&s)[4][NI]) {
  const int lane = tidx() & 63, g4 = lane >> 4, c16 = lane & 15;
#pragma unroll
  for (int mi = 0; mi < 4; ++mi) {
#pragma unroll
    for (int ni = 0; ni < NI; ++ni) s[mi][ni] = f32x4{0.f, 0.f, 0.f, 0.f};
#pragma unroll
    for (int ks = 0; ks < 2; ++ks) {
      bf16x8 kf = *(const bf16x8*)(Ks + (mi * 16 + c16) * KT_LD + ks * 32 + g4 * 8);
#pragma unroll
      for (int ni = 0; ni < NI; ++ni) s[mi][ni] = MFMA16(kf, qf[ni][ks], s[mi][ni]);
    }
  }
}
template <int NI>
DEV void attn_pv(const bf16* Vs, const bf16x8 (&pf)[NI][2], f32x4 (&o)[4][NI]) {
  const int lane = tidx() & 63, g4 = lane >> 4, q4 = (lane & 15) >> 2, p4 = lane & 3;
#pragma unroll
  for (int di = 0; di < 4; ++di) {
#pragma unroll
    for (int ks2 = 0; ks2 < 2; ++ks2) {
      v4i16_t v0 = lds_tr16(Vs + (ks2 * 32 + g4 * 4 + q4) * KT_LD + di * 16 + p4 * 4);
      v4i16_t v1 = lds_tr16(Vs + (ks2 * 32 + 16 + g4 * 4 + q4) * KT_LD + di * 16 + p4 * 4);
      bf16x8 vf = __builtin_shufflevector(v0, v1, 0, 1, 2, 3, 4, 5, 6, 7);
#pragma unroll
      for (int ni = 0; ni < NI; ++ni) o[di][ni] = MFMA16(vf, pf[ni][ks2], o[di][ni]);
    }
  }
}
DEV void exp4_pack(const f32x4& sv, float nm, float& ps, unsigned& w0, unsigned& w1) {
  float p0 = __builtin_amdgcn_exp2f(__builtin_fmaf(sv[0], C2, nm));
  float p1 = __builtin_amdgcn_exp2f(__builtin_fmaf(sv[1], C2, nm));
  float p2 = __builtin_amdgcn_exp2f(__builtin_fmaf(sv[2], C2, nm));
  float p3 = __builtin_amdgcn_exp2f(__builtin_fmaf(sv[3], C2, nm));
  ps += (p0 + p1) + (p2 + p3);
  w0 = cvtpk(p0, p1);
  w1 = cvtpk(p2, p3);
}
template <int NI>
DEV void attn_softmax_pv(const bf16* Vs, f32x4 (&s)[4][NI], AttnSt<NI>& st) {
  bf16x8 pf[NI][2];
#pragma unroll
  for (int ni = 0; ni < NI; ++ni) {
    float mx = -INFINITY;
#pragma unroll
    for (int mi = 0; mi < 4; ++mi)
      mx = fmaxf(fmaxf(mx, fmaxf(s[mi][ni][0], s[mi][ni][1])), fmaxf(s[mi][ni][2], s[mi][ni][3]));
    mx = fmaxf(mx, shx(mx, 16));
    mx = fmaxf(mx, shx(mx, 32));
    const float mn = fmaxf(st.m[ni], mx);
    const float mu = (mn == -INFINITY) ? 0.f : mn;
    const float corr = __builtin_amdgcn_exp2f((st.m[ni] - mu) * C2);
    st.m[ni] = mn;
    const float nm = -mu * C2;
    float ps = 0.f;
    u32x4_t wa, wb;
    unsigned t0, t1;
    exp4_pack(s[0][ni], nm, ps, t0, t1); wa.x = t0; wa.y = t1;
    exp4_pack(s[1][ni], nm, ps, t0, t1); wa.z = t0; wa.w = t1;
    exp4_pack(s[2][ni], nm, ps, t0, t1); wb.x = t0; wb.y = t1;
    exp4_pack(s[3][ni], nm, ps, t0, t1); wb.z = t0; wb.w = t1;
    st.l[ni] = st.l[ni] * corr + ps;
#pragma unroll
    for (int di = 0; di < 4; ++di) {
      st.o[di][ni][0] *= corr; st.o[di][ni][1] *= corr; st.o[di][ni][2] *= corr; st.o[di][ni][3] *= corr;
    }
    pf[ni][0] = __builtin_bit_cast(bf16x8, wa);
    pf[ni][1] = __builtin_bit_cast(bf16x8, wb);
  }
  attn_pv<NI>(Vs, pf, st.o);
}

template <int NI>
DEV void attn_softmax_pv_act(const bf16* Vs, f32x4 (&s)[4][NI], AttnSt<NI>& st, const bool (&act)[NI]) {
  bf16x8 pf[NI][2];
#pragma unroll
  for (int ni = 0; ni < NI; ++ni) {
    pf[ni][0] = bf16x8{0, 0, 0, 0, 0, 0, 0, 0};
    pf[ni][1] = bf16x8{0, 0, 0, 0, 0, 0, 0, 0};
    if (act[ni]) {
      float mx = -INFINITY;
#pragma unroll
      for (int mi = 0; mi < 4; ++mi)
        mx = fmaxf(fmaxf(mx, fmaxf(s[mi][ni][0], s[mi][ni][1])), fmaxf(s[mi][ni][2], s[mi][ni][3]));
      mx = fmaxf(mx, shx(mx, 16));
      mx = fmaxf(mx, shx(mx, 32));
      const float mn = fmaxf(st.m[ni], mx);
      const float mu = (mn == -INFINITY) ? 0.f : mn;
      const float corr = __builtin_amdgcn_exp2f((st.m[ni] - mu) * C2);
      st.m[ni] = mn;
      const float nm = -mu * C2;
      float ps = 0.f;
      u32x4_t wa, wb;
      unsigned t0, t1;
      exp4_pack(s[0][ni], nm, ps, t0, t1); wa.x = t0; wa.y = t1;
      exp4_pack(s[1][ni], nm, ps, t0, t1); wa.z = t0; wa.w = t1;
      exp4_pack(s[2][ni], nm, ps, t0, t1); wb.x = t0; wb.y = t1;
      exp4_pack(s[3][ni], nm, ps, t0, t1); wb.z = t0; wb.w = t1;
      st.l[ni] = st.l[ni] * corr + ps;
#pragma unroll
      for (int di = 0; di < 4; ++di) {
        st.o[di][ni][0] *= corr; st.o[di][ni][1] *= corr; st.o[di][ni][2] *= corr; st.o[di][ni][3] *= corr;
      }
      pf[ni][0] = __builtin_bit_cast(bf16x8, wa);
      pf[ni][1] = __builtin_bit_cast(bf16x8, wb);
    }
  }
  const int lane = tidx() & 63, g4 = lane >> 4, q4 = (lane & 15) >> 2, p4 = lane & 3;
#pragma unroll
  for (int di = 0; di < 4; ++di) {
#pragma unroll
    for (int ks2 = 0; ks2 < 2; ++ks2) {
      v4i16_t v0 = lds_tr16(Vs + (ks2 * 32 + g4 * 4 + q4) * KT_LD + di * 16 + p4 * 4);
      v4i16_t v1 = lds_tr16(Vs + (ks2 * 32 + 16 + g4 * 4 + q4) * KT_LD + di * 16 + p4 * 4);
      bf16x8 vf = __builtin_shufflevector(v0, v1, 0, 1, 2, 3, 4, 5, 6, 7);
#pragma unroll
      for (int ni = 0; ni < NI; ++ni)
        if (act[ni]) st.o[di][ni] = MFMA16(vf, pf[ni][ks2], st.o[di][ni]);
    }
  }
}
template <int NI>
DEV int gate_top1(f32x4 (&gs)[4][NI], int ni, int g4) {
  float bv = -INFINITY;
  int bi = 1 << 20;
#pragma unroll
  for (int mi = 0; mi < 4; ++mi)
#pragma unroll
    for (int r = 0; r < 4; ++r) {
      float v = gs[mi][ni][r];
      if (v > bv) { bv = v; bi = mi * 16 + g4 * 4 + r; }
    }
#pragma unroll
  for (int off = 16; off <= 32; off <<= 1) {
    float ov = shx(bv, off);
    int oi = shx(bi, off);
    if (ov > bv || (ov == bv && oi < bi)) { bv = ov; bi = oi; }
  }
#pragma unroll
  for (int mi = 0; mi < 4; ++mi)
#pragma unroll
    for (int r = 0; r < 4; ++r)
      if (mi * 16 + g4 * 4 + r == bi) gs[mi][ni][r] = -INFINITY;
  return (bv == -INFINITY) ? -1 : bi;
}
template <int NI>
DEV void moba_mfma_item(const Params& p, int item, char* smem, bf16* outbuf) {
  constexpr int QB = 64 * NI;
  bf16* sm = (bf16*)smem;
  const int bh = item & 15, cq = (S / QB - 1) - (item >> 4);
  const int b = bh >> 3, h = bh & 7;
  const int s0 = cq * QB, blk = s0 >> 8;
  const int lane = tidx() & 63, wave = tidx() >> 6, g4 = lane >> 4, c16 = lane & 15;
  const bf16* proj = (const bf16*)(p.ws + OFF_PROJ) + (size_t)b * S * PC;
  bf16x8 qf[NI][2];
  int tq[NI];
#pragma unroll
  for (int ni = 0; ni < NI; ++ni) {
    tq[ni] = s0 + wave * 16 * NI + ni * 16 + c16;
#pragma unroll
    for (int ks = 0; ks < 2; ++ks)
      qf[ni][ks] = *(const bf16x8*)(proj + (size_t)tq[ni] * PC + C_MQ + h * 64 + ks * 32 + g4 * 8);
  }
  int i0[NI], i1[NI], i2[NI];
  {
    const bf16* kmh = (const bf16*)(p.ws + OFF_KMHL) + ((size_t)(b * 8 + h) * 64) * 64;
    const bf16* kml = kmh + (size_t)2 * 8 * 64 * 64;
    f32x4 gs[4][NI];
#pragma unroll
    for (int mi = 0; mi < 4; ++mi) {
#pragma unroll
      for (int ni = 0; ni < NI; ++ni) gs[mi][ni] = f32x4{0.f, 0.f, 0.f, 0.f};
#pragma unroll
      for (int ks = 0; ks < 2; ++ks) {
        bf16x8 ah = *(const bf16x8*)(kmh + (mi * 16 + c16) * 64 + ks * 32 + g4 * 8);
        bf16x8 al_ = *(const bf16x8*)(kml + (mi * 16 + c16) * 64 + ks * 32 + g4 * 8);
#pragma unroll
        for (int ni = 0; ni < NI; ++ni) {
          gs[mi][ni] = MFMA16(ah, qf[ni][ks], gs[mi][ni]);
          gs[mi][ni] = MFMA16(al_, qf[ni][ks], gs[mi][ni]);
        }
      }
    }
#pragma unroll
    for (int ni = 0; ni < NI; ++ni) {
#pragma unroll
      for (int mi = 0; mi < 4; ++mi)
#pragma unroll
        for (int r = 0; r < 4; ++r)
          if (mi * 16 + g4 * 4 + r >= blk) gs[mi][ni][r] = -INFINITY;
      i0[ni] = gate_top1(gs, ni, g4);
      i1[ni] = gate_top1(gs, ni, g4);
      i2[ni] = gate_top1(gs, ni, g4);
    }
  }
  AttnSt<NI> st;
  attn_init<NI>(st);
  const int ntiles = (s0 + QB) >> 6;
  const bf16* kb = (const bf16*)(p.ws + OFF_MKB) + ((size_t)(b * 8 + h) * S) * 64;
  const bf16* vb = (const bf16*)(p.ws + OFF_MVB) + ((size_t)(b * 8 + h) * S) * 64;
  bf16* smkv = sm;
  __syncthreads();
#define MOBA_KEY(i) ((i) * 64)
  KV_SWEEP(kb, vb, 64, ntiles, MOBA_KEY,
    const int n = it >> 2;
    const bool own = (n == blk);
    const int kbase = it * 64;
    bool wave_active = own;
    if (!own) {
      bool anyq = false;
      _Pragma("unroll") for (int ni = 0; ni < NI; ++ni) anyq = anyq || (n == i0[ni]) || (n == i1[ni]) || (n == i2[ni]);
      wave_active = __builtin_amdgcn_ballot_w64(anyq) != 0ull;
    }
    if (wave_active) {
      f32x4 s[4][NI];
      attn_scores<NI>(Ks, qf, s);
      _Pragma("unroll") for (int ni = 0; ni < NI; ++ni) {
        if (own) {
          _Pragma("unroll") for (int mi = 0; mi < 4; ++mi)
            _Pragma("unroll") for (int r = 0; r < 4; ++r)
              if (kbase + mi * 16 + g4 * 4 + r > tq[ni]) s[mi][ni][r] = -INFINITY;
        } else {
          const bool okb = (n == i0[ni]) | (n == i1[ni]) | (n == i2[ni]);
          if (!okb) {
            _Pragma("unroll") for (int mi = 0; mi < 4; ++mi) s[mi][ni] = f32x4{-INFINITY, -INFINITY, -INFINITY, -INFINITY};
          }
        }
      }
      attn_softmax_pv<NI>(Ks + KT_ELEMS, s, st);
    }
  )
#pragma unroll
  for (int ni = 0; ni < NI; ++ni) {
    float l = st.l[ni];
    l += shx(l, 16);
    l += shx(l, 32);
    const float inv = 1.f / l;
    bf16* op = outbuf + ((size_t)b * S + tq[ni]) * 512 + h * 64 + g4 * 4;
#pragma unroll
    for (int di = 0; di < 4; ++di) {
      uint2 pk;
      pk.x = cvtpk(st.o[di][ni][0] * inv, st.o[di][ni][1] * inv);
      pk.y = cvtpk(st.o[di][ni][2] * inv, st.o[di][ni][3] * inv);
      *(uint2*)(op + di * 16) = pk;
    }
  }
}

DEV int moba_list_base(int n) { return n * S - 128 * n * (n + 1); }
template <int NI>
DEV void moba_gate_item(const Params& p, int item) {
  constexpr int QB = 64 * NI;
  const int bh = item & 15, cq = item >> 4;
  const int b = bh >> 3, h = bh & 7;
  const int s0 = cq * QB, blk = s0 >> 8;
  if (blk == 0) return;
  const int lane = tidx() & 63, wave = tidx() >> 6, g4 = lane >> 4, c16 = lane & 15;
  const bf16* proj = (const bf16*)(p.ws + OFF_PROJ) + (size_t)b * S * PC;
  bf16x8 qf[NI][2];
  int tq[NI];
#pragma unroll
  for (int ni = 0; ni < NI; ++ni) {
    tq[ni] = s0 + wave * 16 * NI + ni * 16 + c16;
#pragma unroll
    for (int ks = 0; ks < 2; ++ks)
      qf[ni][ks] = *(const bf16x8*)(proj + (size_t)tq[ni] * PC + C_MQ + h * 64 + ks * 32 + g4 * 8);
  }
  const bf16* kmh = (const bf16*)(p.ws + OFF_KMHL) + ((size_t)(b * 8 + h) * 64) * 64;
  const bf16* kml = kmh + (size_t)2 * 8 * 64 * 64;
  f32x4 gs[4][NI];
#pragma unroll
  for (int mi = 0; mi < 4; ++mi) {
#pragma unroll
    for (int ni = 0; ni < NI; ++ni) gs[mi][ni] = f32x4{0.f, 0.f, 0.f, 0.f};
#pragma unroll
    for (int ks = 0; ks < 2; ++ks) {
      bf16x8 ah = *(const bf16x8*)(kmh + (mi * 16 + c16) * 64 + ks * 32 + g4 * 8);
      bf16x8 al_ = *(const bf16x8*)(kml + (mi * 16 + c16) * 64 + ks * 32 + g4 * 8);
#pragma unroll
      for (int ni = 0; ni < NI; ++ni) {
        gs[mi][ni] = MFMA16(ah, qf[ni][ks], gs[mi][ni]);
        gs[mi][ni] = MFMA16(al_, qf[ni][ks], gs[mi][ni]);
      }
    }
  }
  unsigned short* lists = (unsigned short*)(p.ws + OFF_MLIST) + (size_t)(b * 8 + h) * MLIST_PER_BH;
  int* cnt = (int*)(p.ws + OFF_MCNT) + (b * 8 + h) * 64;
#pragma unroll
  for (int ni = 0; ni < NI; ++ni) {
#pragma unroll
    for (int mi = 0; mi < 4; ++mi)
#pragma unroll
      for (int r = 0; r < 4; ++r)
        if (mi * 16 + g4 * 4 + r >= blk) gs[mi][ni][r] = -INFINITY;
    const int s0i = gate_top1(gs, ni, g4);
    const int s1i = gate_top1(gs, ni, g4);
    const int s2i = gate_top1(gs, ni, g4);
    if (g4 == 0) {
      if (s0i >= 0) { const int pos = atomicAdd(cnt + s0i, 1); lists[moba_list_base(s0i) + pos] = (unsigned short)(tq[ni] | (0 << 14)); }
      if (s1i >= 0) { const int pos = atomicAdd(cnt + s1i, 1); lists[moba_list_base(s1i) + pos] = (unsigned short)(tq[ni] | (1 << 14)); }
      if (s2i >= 0) { const int pos = atomicAdd(cnt + s2i, 1); lists[moba_list_base(s2i) + pos] = (unsigned short)(tq[ni] | (2 << 14)); }
    }
  }
}
template <int NI>
DEV void moba_part_item(const Params& p, int b, int item, char* smem) {
  constexpr int CH = 64 * NI;
  bf16* smkv = (bf16*)smem;
  const int n = item >> 6, h = (item >> 3) & 7, part = item & 7;
  const int lane = tidx() & 63, wave = tidx() >> 6, g4 = lane >> 4, c16 = lane & 15;
  const int cnt = ((const int*)(p.ws + OFF_MCNT))[(b * 8 + h) * 64 + n];
  const unsigned short* list = (const unsigned short*)(p.ws + OFF_MLIST) + (size_t)(b * 8 + h) * MLIST_PER_BH + moba_list_base(n);
  const bf16* proj = (const bf16*)(p.ws + OFF_PROJ) + (size_t)b * S * PC;
  const bf16* kb = (const bf16*)(p.ws + OFF_MKB) + ((size_t)(b * 8 + h) * S + n * 256) * 64;
  const bf16* vb = (const bf16*)(p.ws + OFF_MVB) + ((size_t)(b * 8 + h) * S + n * 256) * 64;
  bf16* po = (bf16*)(p.ws + OFF_MPO);
  float2* pml = (float2*)(p.ws + OFF_MPML);
  for (int c = part; c * CH < cnt; c += 8) {
    bf16x8 qf[NI][2];
    int tcol[NI], slot[NI];
    bool valid[NI];
#pragma unroll
    for (int ni = 0; ni < NI; ++ni) {
      const int idx = c * CH + wave * 16 * NI + ni * 16 + c16;
      valid[ni] = idx < cnt;
      const unsigned e = list[valid[ni] ? idx : 0];
      tcol[ni] = e & 0x3FFF;
      slot[ni] = e >> 14;
#pragma unroll
      for (int ks = 0; ks < 2; ++ks)
        qf[ni][ks] = *(const bf16x8*)(proj + (size_t)tcol[ni] * PC + C_MQ + h * 64 + ks * 32 + g4 * 8);
    }
    AttnSt<NI> st;
    attn_init<NI>(st);
    __syncthreads();
#define MOBA_PKEY(i) ((i) * 64)
    KV_SWEEP(kb, vb, 64, 4, MOBA_PKEY,
      f32x4 s[4][NI];
      attn_scores<NI>(Ks, qf, s);
      attn_softmax_pv<NI>(Ks + KT_ELEMS, s, st);
    )
#pragma unroll
    for (int ni = 0; ni < NI; ++ni) {
      float l = st.l[ni];
      l += shx(l, 16);
      l += shx(l, 32);
      if (valid[ni]) {
        const size_t rec = ((size_t)h * S + tcol[ni]) * 3 + slot[ni];
        if (g4 == 0) pml[rec] = float2{st.m[ni], l};
        bf16* op = po + rec * 64 + g4 * 4;
#pragma unroll
        for (int di = 0; di < 4; ++di) {
          uint2 pk;
          pk.x = cvtpk(st.o[di][ni][0], st.o[di][ni][1]);
          pk.y = cvtpk(st.o[di][ni][2], st.o[di][ni][3]);
          *(uint2*)(op + di * 16) = pk;
        }
      }
    }
  }
}
template <int NI>
DEV void moba_part_item2(const Params& p, int b, int item, char* smem) {
  constexpr int WCH = 16 * NI;
  bf16* Kall = (bf16*)smem;
  bf16* Vall = Kall + 256 * KT_LD;
  static_assert(2 * 256 * KT_LD * 2 <= SMEM_BYTES, "moba block staging");
  const int n = item >> 6, h = (item >> 3) & 7, part = item & 7;
  const int tid = tidx(), lane = tid & 63, wave = tid >> 6, g4 = lane >> 4, c16 = lane & 15;
  const int cnt = ((const int*)(p.ws + OFF_MCNT))[(b * 8 + h) * 64 + n];
  const bool active = part * 4 * WCH < cnt;
  const unsigned short* list = (const unsigned short*)(p.ws + OFF_MLIST) + (size_t)(b * 8 + h) * MLIST_PER_BH + moba_list_base(n);
  const bf16* proj = (const bf16*)(p.ws + OFF_PROJ) + (size_t)b * S * PC;
  const bf16* kb = (const bf16*)(p.ws + OFF_MKB) + ((size_t)(b * 8 + h) * S + n * 256) * 64;
  const bf16* vb = (const bf16*)(p.ws + OFF_MVB) + ((size_t)(b * 8 + h) * S + n * 256) * 64;
  bf16* po = (bf16*)(p.ws + OFF_MPO);
  float2* pml = (float2*)(p.ws + OFF_MPML);
  __syncthreads();
  if (active) {
#pragma unroll
    for (int i = 0; i < 8; ++i) {
      const int id = tid + 256 * i, r = id >> 3, c = (id & 7) * 8;
      const uint4 kv = *(const uint4*)(kb + (size_t)r * 64 + c);
      const uint4 vv = *(const uint4*)(vb + (size_t)r * 64 + c);
      *(uint4*)(Kall + r * KT_LD + c) = kv;
      *(uint4*)(Vall + r * KT_LD + c) = vv;
    }
  }
  __syncthreads();
  if (!active) return;
  for (int wc = part * 4 + wave; wc * WCH < cnt; wc += 32) {
    bf16x8 qf[NI][2];
    int tcol[NI], slot[NI];
    bool valid[NI];
#pragma unroll
    for (int ni = 0; ni < NI; ++ni) {
      const int idx = wc * WCH + ni * 16 + c16;
      valid[ni] = idx < cnt;
      const unsigned e = list[valid[ni] ? idx : 0];
      tcol[ni] = e & 0x3FFF;
      slot[ni] = e >> 14;
#pragma unroll
      for (int ks = 0; ks < 2; ++ks)
        qf[ni][ks] = *(const bf16x8*)(proj + (size_t)tcol[ni] * PC + C_MQ + h * 64 + ks * 32 + g4 * 8);
    }
    AttnSt<NI> st;
    attn_init<NI>(st);
#pragma unroll 1
    for (int kt = 0; kt < 4; ++kt) {
      f32x4 s[4][NI];
      attn_scores<NI>(Kall + kt * 64 * KT_LD, qf, s);
      attn_softmax_pv<NI>(Vall + kt * 64 * KT_LD, s, st);
    }
#pragma unroll
    for (int ni = 0; ni < NI; ++ni) {
      float l = st.l[ni];
      l += shx(l, 16);
      l += shx(l, 32);
      if (valid[ni]) {
        const size_t rec = ((size_t)h * S + tcol[ni]) * 3 + slot[ni];
        if (g4 == 0) pml[rec] = float2{st.m[ni], l};
        bf16* op = po + rec * 64 + g4 * 4;
#pragma unroll
        for (int di = 0; di < 4; ++di) {
          uint2 pk;
          pk.x = cvtpk(st.o[di][ni][0], st.o[di][ni][1]);
          pk.y = cvtpk(st.o[di][ni][2], st.o[di][ni][3]);
          *(uint2*)(op + di * 16) = pk;
        }
      }
    }
  }
}
template <int NI>
DEV void moba_merge_item(const Params& p, int b, int item, char* smem, bf16* outbuf) {
  constexpr int QB = 64 * NI;
  constexpr int NCQ = S / QB;
  bf16* smkv = (bf16*)smem;
  const int h = item & 7, cq = item >> 3;
  static_assert(NCQ * 8 == 8 * (S / QB), "");
  const int s0 = cq * QB, blk = s0 >> 8;
  const int lane = tidx() & 63, wave = tidx() >> 6, g4 = lane >> 4, c16 = lane & 15;
  const bf16* proj = (const bf16*)(p.ws + OFF_PROJ) + (size_t)b * S * PC;
  bf16x8 qf[NI][2];
  int tq[NI];
#pragma unroll
  for (int ni = 0; ni < NI; ++ni) {
    tq[ni] = s0 + wave * 16 * NI + ni * 16 + c16;
#pragma unroll
    for (int ks = 0; ks < 2; ++ks)
      qf[ni][ks] = *(const bf16x8*)(proj + (size_t)tq[ni] * PC + C_MQ + h * 64 + ks * 32 + g4 * 8);
  }
  const bf16* kb = (const bf16*)(p.ws + OFF_MKB) + ((size_t)(b * 8 + h) * S) * 64;
  const bf16* vb = (const bf16*)(p.ws + OFF_MVB) + ((size_t)(b * 8 + h) * S) * 64;
  AttnSt<NI> st;
  attn_init<NI>(st);
  const int kt0 = blk * 4;
  const int ntl = ((s0 + QB - 1) >> 6) - kt0 + 1;
  __syncthreads();
#define MOBA_MKEY(i) ((kt0 + (i)) * 64)
  KV_SWEEP(kb, vb, 64, ntl, MOBA_MKEY,
    const int kbase = (kt0 + it) * 64;
    f32x4 s[4][NI];
    attn_scores<NI>(Ks, qf, s);
    _Pragma("unroll") for (int ni = 0; ni < NI; ++ni)
      _Pragma("unroll") for (int mi = 0; mi < 4; ++mi)
        _Pragma("unroll") for (int r = 0; r < 4; ++r)
          if (kbase + mi * 16 + g4 * 4 + r > tq[ni]) s[mi][ni][r] = -INFINITY;
    attn_softmax_pv<NI>(Ks + KT_ELEMS, s, st);
  )
  const int nsl = (blk < 3) ? blk : 3;
  const bf16* po = (const bf16*)(p.ws + OFF_MPO);
  const float2* pml = (const float2*)(p.ws + OFF_MPML);
#pragma unroll
  for (int ni = 0; ni < NI; ++ni) {
    float l = st.l[ni];
    l += shx(l, 16);
    l += shx(l, 32);
    const size_t rec0 = ((size_t)h * S + tq[ni]) * 3;
    float ms[3], ls[3];
    float M = st.m[ni];
#pragma unroll
    for (int s = 0; s < 3; ++s) {
      ms[s] = -INFINITY;
      ls[s] = 0.f;
      if (s < nsl) {
        const float2 v = pml[rec0 + s];
        ms[s] = v.x;
        ls[s] = v.y;
        M = fmaxf(M, v.x);
      }
    }
    const float fo = __builtin_amdgcn_exp2f((st.m[ni] - M) * C2);
    l *= fo;
    float f[3];
#pragma unroll
    for (int s = 0; s < 3; ++s) {
      f[s] = (s < nsl) ? __builtin_amdgcn_exp2f((ms[s] - M) * C2) : 0.f;
      l += ls[s] * f[s];
    }
    const float inv = 1.f / l;
    bf16* op = outbuf + ((size_t)b * S + tq[ni]) * 512 + h * 64 + g4 * 4;
#pragma unroll
    for (int di = 0; di < 4; ++di) {
      float o0 = st.o[di][ni][0] * fo, o1 = st.o[di][ni][1] * fo, o2 = st.o[di][ni][2] * fo, o3 = st.o[di][ni][3] * fo;
#pragma unroll
      for (int s = 0; s < 3; ++s) {
        if (s < nsl) {
          const uint2 pv = *(const uint2*)(po + (rec0 + s) * 64 + di * 16 + g4 * 4);
          o0 += f[s] * __uint_as_float(pv.x << 16);
          o1 += f[s] * __uint_as_float(pv.x & 0xffff0000u);
          o2 += f[s] * __uint_as_float(pv.y << 16);
          o3 += f[s] * __uint_as_float(pv.y & 0xffff0000u);
        }
      }
      uint2 pk;
      pk.x = cvtpk(o0 * inv, o1 * inv);
      pk.y = cvtpk(o2 * inv, o3 * inv);
      *(uint2*)(op + di * 16) = pk;
    }
  }
}

template <int NI>
DEV void attn_stats(f32x4 (&s)[4][NI], float (&m)[NI], float (&l)[NI]) {
#pragma unroll
  for (int ni = 0; ni < NI; ++ni) {
    float mx = -INFINITY;
#pragma unroll
    for (int mi = 0; mi < 4; ++mi)
      mx = fmaxf(fmaxf(mx, fmaxf(s[mi][ni][0], s[mi][ni][1])), fmaxf(s[mi][ni][2], s[mi][ni][3]));
    mx = fmaxf(mx, shx(mx, 16));
    mx = fmaxf(mx, shx(mx, 32));
    const float mn = fmaxf(m[ni], mx);
    const float mu = (mn == -INFINITY) ? 0.f : mn;
    const float corr = __builtin_amdgcn_exp2f((m[ni] - mu) * C2);
    m[ni] = mn;
    const float nm = -mu * C2;
    float ps = 0.f;
#pragma unroll
    for (int mi = 0; mi < 4; ++mi)
#pragma unroll
      for (int r = 0; r < 4; ++r) ps += __builtin_amdgcn_exp2f(__builtin_fmaf(s[mi][ni][r], C2, nm));
    l[ni] = l[ni] * corr + ps;
  }
}
DEV bf16x8 rope_frag(bf16x8 qv, const float* __restrict__ rope_t, int g4) {
  u32x4_t w = __builtin_bit_cast(u32x4_t, qv);
  u32x4_t pw;
  pw.x = shx(w.x, 16); pw.y = shx(w.y, 16); pw.z = shx(w.z, 16); pw.w = shx(w.w, 16);
  float f[8], pf[8];
  unpack8(uint4{w.x, w.y, w.z, w.w}, f);
  unpack8(uint4{pw.x, pw.y, pw.z, pw.w}, pf);
  const float4 c0 = *(const float4*)(rope_t), c1 = *(const float4*)(rope_t + 4);
  const float4 s0 = *(const float4*)(rope_t + 8), s1 = *(const float4*)(rope_t + 12);
  const float cs[8] = {c0.x, c0.y, c0.z, c0.w, c1.x, c1.y, c1.z, c1.w};
  const float sn[8] = {s0.x, s0.y, s0.z, s0.w, s1.x, s1.y, s1.z, s1.w};
  const float sg = (g4 == 0) ? -1.f : 1.f;
  float o[8];
#pragma unroll
  for (int i = 0; i < 8; ++i) o[i] = (g4 < 2) ? (f[i] * cs[i] + sg * pf[i] * sn[i]) : f[i];
  u32x4_t r;
  r.x = cvtpk(o[0], o[1]); r.y = cvtpk(o[2], o[3]); r.z = cvtpk(o[4], o[5]); r.w = cvtpk(o[6], o[7]);
  return __builtin_bit_cast(bf16x8, r);
}

template <int NI>
DEV void nsa_item(const Params& p, int item, char* smem, bf16* outbuf) {
  constexpr int QN = 16 * NI;
  constexpr int NCH = S / QN;
  bf16* smkv = (bf16*)smem;
  float* imp = (float*)(smem + 36864);
  int* sel = (int*)(smem + 36864 + QN * 257 * 4);
  unsigned* bmq = (unsigned*)(sel + QN * 16);
  unsigned* bmu = bmq + QN * 8;
  int* ulist = (int*)(bmu + 4 * NI * 8);
  static_assert(36864 + QN * 257 * 4 + QN * 16 * 4 + QN * 8 * 4 + 4 * NI * 8 * 4 + 257 * 4 <= SMEM_BYTES, "nsa lds");
  static_assert(NI == 2, "per-wave union bitmaps use bmu[8 .. 40)");
  const int tid = tidx(), lane = tid & 63, wave = tid >> 6, g4 = lane >> 4, c16 = lane & 15;
  const int bk = item & 3, cq = (NCH - 1) - (item >> 2);
  const int b = bk >> 1, kvh = bk & 1;
  const int s0 = cq * QN, cur = s0 >> 6;
  if (PROBE_NSA && b == 1) return;
  const bf16* proj = (const bf16*)(p.ws + OFF_PROJ) + (size_t)b * S * PC;
  const float* rope = (const float*)(p.ws + OFF_ROPE);
  int tq[NI], qlv[NI];
  float gate0[NI], gate1[NI], gate2[NI];
  bf16x8 qraw[NI][2], qrot[NI][2];
#pragma unroll
  for (int ni = 0; ni < NI; ++ni) {
    const int R = wave * 16 * NI + ni * 16 + c16;
    qlv[ni] = R >> 2;
    const int g = R & 3;
    tq[ni] = s0 + qlv[ni];
    const bf16* qp = proj + (size_t)tq[ni] * PC + C_NQ + (kvh * 4 + g) * 64 + g4 * 8;
    qraw[ni][0] = *(const bf16x8*)(qp);
    qraw[ni][1] = *(const bf16x8*)(qp + 32);
    qrot[ni][0] = rope_frag(qraw[ni][0], rope + (size_t)tq[ni] * 16, g4);
    qrot[ni][1] = qraw[ni][1];
    const bf16* gp = proj + (size_t)tq[ni] * PC + C_NG + (kvh * 4 + g) * 3;
    gate0[ni] = (!PROBE_NSA || (PROBE_NSA & 1)) ? sigmoidf_(bf2f(gp[0])) : 0.f;
    gate1[ni] = (!PROBE_NSA || (PROBE_NSA & 2)) ? sigmoidf_(bf2f(gp[1])) : 0.f;
    gate2[ni] = (!PROBE_NSA || (PROBE_NSA & 4)) ? sigmoidf_(bf2f(gp[2])) : 0.f;
  }
  for (int i = tid; i < QN * 257; i += 256) imp[i] = 0.f;
  for (int i = tid; i < QN * 8 + 4 * NI * 8; i += 256) bmq[i] = 0u;
  f32x4 acc[4][NI];
#pragma unroll
  for (int ni = 0; ni < NI; ++ni)
#pragma unroll
    for (int di = 0; di < 4; ++di) acc[di][ni] = f32x4{0.f, 0.f, 0.f, 0.f};
  TILE_DECL;
  {
    int nv[NI];
#pragma unroll
    for (int ni = 0; ni < NI; ++ni) nv[ni] = (tq[ni] >= 31) ? (((tq[ni] - 31) >> 4) + 1) : 0;
    const int tlast = s0 + QN - 1;
    const int nvmax = (tlast >= 31) ? (((tlast - 31) >> 4) + 1) : 0;
    const int ntc = (nvmax + 63) >> 6;
    const bf16* kb = (const bf16*)(p.ws + OFF_KCB) + ((size_t)(b * 2 + kvh) * 1024) * 64;
    const bf16* vb = (const bf16*)(p.ws + OFF_VCB) + ((size_t)(b * 2 + kvh) * 1024) * 64;
    float mA[NI], lA[NI];
#pragma unroll
    for (int ni = 0; ni < NI; ++ni) { mA[ni] = -INFINITY; lA[ni] = 0.f; }
    __syncthreads();
    if (ntc > 0) {
      for (int rep_ = 0; rep_ < ((REP_NSA_PART & 1) ? 2 : 1); ++rep_) {
#pragma unroll
      for (int ni = 0; ni < NI; ++ni) { mA[ni] = -INFINITY; lA[ni] = 0.f; }
      TILE_GLOAD(kb, vb, 64, 0);
      TILE_SSTORE(smkv, smkv + KT_ELEMS);
      __syncthreads();
      for (int kt = 0; kt < ntc; ++kt) {
        if (kt + 1 < ntc) TILE_GLOAD(kb, vb, 64, (kt + 1) * 64);
        const bf16* Ks = smkv + (kt & 1) * 2 * KT_ELEMS;
        f32x4 s[4][NI];
        attn_scores<NI>(Ks, qraw, s);
#pragma unroll
        for (int ni = 0; ni < NI; ++ni)
#pragma unroll
          for (int mi = 0; mi < 4; ++mi)
#pragma unroll
            for (int r = 0; r < 4; ++r)
              if (kt * 64 + mi * 16 + g4 * 4 + r >= nv[ni]) s[mi][ni][r] = -INFINITY;
        attn_stats<NI>(s, mA, lA);
        if (kt + 1 < ntc) {
          bf16* Kn = smkv + ((kt + 1) & 1) * 2 * KT_ELEMS;
          TILE_SSTORE(Kn, Kn + KT_ELEMS);
        }
        __syncthreads();
      }
      }
      float nmB[NI];
#pragma unroll
      for (int ni = 0; ni < NI; ++ni) {
        float l = lA[ni];
        l += shx(l, 16);
        l += shx(l, 32);
        nmB[ni] = (l > 0.f) ? -(mA[ni] * C2 + __builtin_amdgcn_logf(l)) : 0.f;
      }
      TILE_GLOAD(kb, vb, 64, 0);
      TILE_SSTORE(smkv, smkv + KT_ELEMS);
      __syncthreads();
      for (int kt = 0; kt < ntc; ++kt) {
        if (kt + 1 < ntc) TILE_GLOAD(kb, vb, 64, (kt + 1) * 64);
        const bf16* Ks = smkv + (kt & 1) * 2 * KT_ELEMS;
        f32x4 s[4][NI];
        attn_scores<NI>(Ks, qraw, s);
        bf16x8 pf[NI][2];
#pragma unroll
        for (int ni = 0; ni < NI; ++ni) {
          u32x4_t wa, wb;
          float* irow = imp + qlv[ni] * 257 + kt * 16 + g4;
#pragma unroll
          for (int mi = 0; mi < 4; ++mi) {
            float pr[4];
#pragma unroll
            for (int r = 0; r < 4; ++r) {
              const bool ok = (kt * 64 + mi * 16 + g4 * 4 + r) < nv[ni];
              pr[r] = ok ? __builtin_amdgcn_exp2f(__builtin_fmaf(s[mi][ni][r], C2, nmB[ni])) : 0.f;
            }
            float mainv = pr[0] + pr[1] + pr[2] + 0.5f * pr[3];
            float spv = 0.5f * pr[3];
            mainv += shx(mainv, 1);
            mainv += shx(mainv, 2);
            spv += shx(spv, 1);
            spv += shx(spv, 2);
            if ((c16 & 3) == 0) {
              atomicAdd(irow + mi * 4, mainv);
              atomicAdd(irow + mi * 4 + 1, spv);
            }
            const unsigned w0 = cvtpk(pr[0], pr[1]), w1 = cvtpk(pr[2], pr[3]);
            if (mi == 0) { wa.x = w0; wa.y = w1; }
            if (mi == 1) { wa.z = w0; wa.w = w1; }
            if (mi == 2) { wb.x = w0; wb.y = w1; }
            if (mi == 3) { wb.z = w0; wb.w = w1; }
          }
          pf[ni][0] = __builtin_bit_cast(bf16x8, wa);
          pf[ni][1] = __builtin_bit_cast(bf16x8, wb);
        }
        attn_pv<NI>(Ks + KT_ELEMS, pf, acc);
        if (kt + 1 < ntc) {
          bf16* Kn = smkv + ((kt + 1) & 1) * 2 * KT_ELEMS;
          TILE_SSTORE(Kn, Kn + KT_ELEMS);
        }
        __syncthreads();
      }
    }
#pragma unroll
    for (int ni = 0; ni < NI; ++ni)
#pragma unroll
      for (int di = 0; di < 4; ++di) {
        acc[di][ni][0] *= gate0[ni]; acc[di][ni][1] *= gate0[ni]; acc[di][ni][2] *= gate0[ni]; acc[di][ni][3] *= gate0[ni];
      }
  }
  __syncthreads();
#if PROBE_NSA == 8
  if (b == 0 && kvh == 0)
    for (int i = tid; i < QN * 256; i += 256)
      ((float*)(p.ws + OFF_OMOBA))[(size_t)S * 256 + (size_t)(s0 + (i >> 8)) * 256 + (i & 255)] = imp[(i >> 8) * 257 + (i & 255)];
  __syncthreads();
#endif
  for (int qq = 0; qq < 4 * NI; ++qq) {
    const int ql = wave * 4 * NI + qq;
    int mysel = -1;
    if (cur < 16) {
      mysel = (lane <= cur) ? lane : -1;
    } else {
      const float* row = imp + ql * 257;
      float v0 = row[lane], v1 = row[64 + lane], v2 = row[128 + lane], v3 = row[192 + lane];
      if (lane < 1 || lane > cur - 2) v0 = -1.f;
      if (64 + lane > cur - 2) v1 = -1.f;
      if (128 + lane > cur - 2) v2 = -1.f;
      if (192 + lane > cur - 2) v3 = -1.f;
      if (lane == 0) mysel = 0;
      if (lane == 1) mysel = cur - 1;
      if (lane == 2) mysel = cur;
      for (int rd = 3; rd < 16; ++rd) {
        float bv = v0;
        int bi = lane;
        if (v1 > bv) { bv = v1; bi = 64 + lane; }
        if (v2 > bv) { bv = v2; bi = 128 + lane; }
        if (v3 > bv) { bv = v3; bi = 192 + lane; }
#pragma unroll
        for (int off = 32; off >= 1; off >>= 1) {
          float ov = shx(bv, off);
          int oi = shx(bi, off);
          if (ov > bv || (ov == bv && oi < bi)) { bv = ov; bi = oi; }
        }
        if (lane == rd) mysel = bi;
        if ((bi & 63) == lane) {
          const int k = bi >> 6;
          if (k == 0) v0 = -2.f; else if (k == 1) v1 = -2.f; else if (k == 2) v2 = -2.f; else v3 = -2.f;
        }
      }
    }
#if PROBE_NSA == 2
    mysel = (lane < 16) ? ((const int*)(p.ws + OFF_SEL))[(((size_t)b * 2 + kvh) * S + s0 + ql) * 16 + lane] : -1;
#endif
#if PROBE_NSA == 8
    if (lane < 16 && b == 0 && kvh == 0) ((int*)(p.ws + OFF_CMP))[(size_t)(s0 + ql) * 16 + lane] = mysel;
#endif
    if (lane < 16) {
      sel[ql * 16 + lane] = mysel;
      if (mysel >= 0) {
        atomicOr(&bmq[ql * 8 + (mysel >> 5)], 1u << (mysel & 31));
        atomicOr(&bmu[mysel >> 5], 1u << (mysel & 31));
        atomicOr(&bmu[8 + wave * 8 + (mysel >> 5)], 1u << (mysel & 31));
      }
    }
  }
  __syncthreads();
  {
    const int n = tid;
    const unsigned wv = bmu[n >> 5];
    if ((wv >> (n & 31)) & 1u) {
      int pos = __builtin_popcount(wv & ((1u << (n & 31)) - 1u));
      for (int w = 0; w < (n >> 5); ++w) pos += __builtin_popcount(bmu[w]);
      ulist[pos] = n;
    }
    if (tid == 0) {
      int c = 0;
      for (int w = 0; w < 8; ++w) c += __builtin_popcount(bmu[w]);
      ulist[256] = c;
    }
  }
  __syncthreads();
  {
    AttnSt<NI> st;
    attn_init<NI>(st);
    const int klo = (s0 - 511 > 0) ? (s0 - 511) : 0;
    const int kt0 = klo >> 6, kt1 = (s0 + QN - 1) >> 6;
    const bf16* kb = (const bf16*)(p.ws + OFF_KWB) + ((size_t)(b * 2 + kvh) * S) * 64;
    const bf16* vb = (const bf16*)(p.ws + OFF_VWB) + ((size_t)(b * 2 + kvh) * S) * 64;
    for (int rep_ = 0; rep_ < ((REP_NSA_PART & 2) ? 2 : 1); ++rep_) {
    attn_init<NI>(st);
    TILE_GLOAD(kb, vb, 64, kt0 * 64);
    TILE_SSTORE(smkv, smkv + KT_ELEMS);
    __syncthreads();
    for (int kt = kt0; kt <= kt1; ++kt) {
      if (kt + 1 <= kt1) TILE_GLOAD(kb, vb, 64, (kt + 1) * 64);
      const bf16* Ks = smkv + ((kt - kt0) & 1) * 2 * KT_ELEMS;
      f32x4 s[4][NI];
      attn_scores<NI>(Ks, qrot, s);
#pragma unroll
      for (int ni = 0; ni < NI; ++ni)
#pragma unroll
        for (int mi = 0; mi < 4; ++mi)
#pragma unroll
          for (int r = 0; r < 4; ++r) {
            const int key = kt * 64 + mi * 16 + g4 * 4 + r;
            if (key > tq[ni] || key <= tq[ni] - 512) s[mi][ni][r] = -INFINITY;
          }
      attn_softmax_pv<NI>(Ks + KT_ELEMS, s, st);
      if (kt + 1 <= kt1) {
        bf16* Kn = smkv + ((kt + 1 - kt0) & 1) * 2 * KT_ELEMS;
        TILE_SSTORE(Kn, Kn + KT_ELEMS);
      }
      __syncthreads();
    }
    }
#pragma unroll
    for (int ni = 0; ni < NI; ++ni) {
      float l = st.l[ni];
      l += shx(l, 16);
      l += shx(l, 32);
      const float sc = gate2[ni] / l;
#pragma unroll
      for (int di = 0; di < 4; ++di) {
        acc[di][ni][0] += sc * st.o[di][ni][0]; acc[di][ni][1] += sc * st.o[di][ni][1];
        acc[di][ni][2] += sc * st.o[di][ni][2]; acc[di][ni][3] += sc * st.o[di][ni][3];
      }
    }
  }
  {
    float* accs = imp + tid;
#pragma unroll
    for (int ni = 0; ni < NI; ++ni)
#pragma unroll
      for (int di = 0; di < 4; ++di)
#pragma unroll
        for (int r = 0; r < 4; ++r) accs[((ni * 4 + di) * 4 + r) * 256] = acc[di][ni][r];
    AttnSt<NI> st;
    attn_init<NI>(st);
    const bf16* kb = (const bf16*)(p.ws + OFF_KSB) + ((size_t)(b * 2 + kvh) * S) * 64;
    const bf16* vb = (const bf16*)(p.ws + OFF_VSB) + ((size_t)(b * 2 + kvh) * S) * 64;
#ifndef NSA_SEL_WAVE
#define NSA_SEL_WAVE 1
#endif
#if NSA_SEL_WAVE
    {
      int* wl = ulist;
      const unsigned* bw = bmu + 8 + wave * 8;
      unsigned short* wl16 = (unsigned short*)wl + wave * 128;
      int nuw = 0;
#pragma unroll
      for (int j = 0; j < 4; ++j) {
        const int nblk = j * 64 + lane;
        const bool setb = (bw[nblk >> 5] >> (nblk & 31)) & 1u;
        const unsigned long long mk = __builtin_amdgcn_ballot_w64(setb);
        if (setb) wl16[nuw + __builtin_popcountll(mk & ((1ull << lane) - 1ull))] = (unsigned short)nblk;
        nuw += __builtin_popcountll(mk);
      }
      __builtin_amdgcn_fence(__ATOMIC_RELEASE, "workgroup");
      __builtin_amdgcn_wave_barrier();
      bf16* Vw = smkv + wave * KT_ELEMS;
      bf16x8 kr00, kr01, kr10, kr11, kr20, kr21, kr30, kr31;
      uint4 vr0, vr1, vr2, vr3, vr4, vr5, vr6, vr7;
#define NSW_LOADK(nb_)                                                                                  \
      {                                                                                                 \
        const bf16* kp_ = kb + (size_t)((nb_) * 64 + c16) * 64 + g4 * 8;                                \
        kr00 = *(const bf16x8*)(kp_);             kr01 = *(const bf16x8*)(kp_ + 32);                    \
        kr10 = *(const bf16x8*)(kp_ + 16 * 64);   kr11 = *(const bf16x8*)(kp_ + 16 * 64 + 32);          \
        kr20 = *(const bf16x8*)(kp_ + 32 * 64);   kr21 = *(const bf16x8*)(kp_ + 32 * 64 + 32);          \
        kr30 = *(const bf16x8*)(kp_ + 48 * 64);   kr31 = *(const bf16x8*)(kp_ + 48 * 64 + 32);          \
      }
#define NSW_LOADV(nb_)                                                                                  \
      {                                                                                                 \
        const bf16* vp_ = vb + (size_t)(nb_) * 64 * 64 + lane * 8;                                      \
        vr0 = *(const uint4*)(vp_);        vr1 = *(const uint4*)(vp_ + 512);  vr2 = *(const uint4*)(vp_ + 1024); \
        vr3 = *(const uint4*)(vp_ + 1536); vr4 = *(const uint4*)(vp_ + 2048); vr5 = *(const uint4*)(vp_ + 2560); \
        vr6 = *(const uint4*)(vp_ + 3072); vr7 = *(const uint4*)(vp_ + 3584);                           \
      }
      for (int rep_ = 0; rep_ < ((REP_NSA_PART & 4) ? 2 : 1); ++rep_) {
      attn_init<NI>(st);
      if (nuw > 0) { NSW_LOADK((int)wl16[0]) NSW_LOADV((int)wl16[0]) }
      for (int iu = 0; iu < nuw; ++iu) {
        const int n = wl16[iu];
        {
          bf16* vd = Vw + (lane >> 3) * KT_LD + (lane & 7) * 8;
          *(uint4*)(vd) = vr0;               *(uint4*)(vd + 8 * KT_LD) = vr1;  *(uint4*)(vd + 16 * KT_LD) = vr2;
          *(uint4*)(vd + 24 * KT_LD) = vr3;  *(uint4*)(vd + 32 * KT_LD) = vr4; *(uint4*)(vd + 40 * KT_LD) = vr5;
          *(uint4*)(vd + 48 * KT_LD) = vr6;  *(uint4*)(vd + 56 * KT_LD) = vr7;
        }
        if (iu + 1 < nuw) NSW_LOADV((int)wl16[iu + 1])
        f32x4 s[4][NI];
        bool qsel[NI], act[NI];
#pragma unroll
        for (int ni = 0; ni < NI; ++ni) {
          qsel[ni] = (bmq[qlv[ni] * 8 + (n >> 5)] >> (n & 31)) & 1u;
          act[ni] = __builtin_amdgcn_ballot_w64(qsel[ni]) != 0ull;
        }
#pragma unroll
        for (int ni = 0; ni < NI; ++ni) {
          if (!act[ni]) continue;
          s[0][ni] = MFMA16(kr00, qrot[ni][0], (f32x4{0.f, 0.f, 0.f, 0.f}));
          s[0][ni] = MFMA16(kr01, qrot[ni][1], s[0][ni]);
          s[1][ni] = MFMA16(kr10, qrot[ni][0], (f32x4{0.f, 0.f, 0.f, 0.f}));
          s[1][ni] = MFMA16(kr11, qrot[ni][1], s[1][ni]);
          s[2][ni] = MFMA16(kr20, qrot[ni][0], (f32x4{0.f, 0.f, 0.f, 0.f}));
          s[2][ni] = MFMA16(kr21, qrot[ni][1], s[2][ni]);
          s[3][ni] = MFMA16(kr30, qrot[ni][0], (f32x4{0.f, 0.f, 0.f, 0.f}));
          s[3][ni] = MFMA16(kr31, qrot[ni][1], s[3][ni]);
        }
        if (iu + 1 < nuw) NSW_LOADK((int)wl16[iu + 1])
        asm volatile("" ::: "memory");
        __builtin_amdgcn_wave_barrier();
#pragma unroll
        for (int ni = 0; ni < NI; ++ni) {
          if (!act[ni]) continue;
          if (n == cur) {
#pragma unroll
            for (int mi = 0; mi < 4; ++mi)
#pragma unroll
              for (int r = 0; r < 4; ++r) {
                const int key = n * 64 + mi * 16 + g4 * 4 + r;
                if (!qsel[ni] || key > tq[ni]) s[mi][ni][r] = -INFINITY;
              }
          } else if (!qsel[ni]) {
#pragma unroll
            for (int mi = 0; mi < 4; ++mi) s[mi][ni] = f32x4{-INFINITY, -INFINITY, -INFINITY, -INFINITY};
          }
        }
        attn_softmax_pv_act<NI>(Vw, s, st, act);
        asm volatile("" ::: "memory");
        __builtin_amdgcn_wave_barrier();
      }
      }
    }
#else
    const int nu = ulist[256];
#define NSA_SKEY(i) (ulist[(i)] * 64)
    for (int rep_ = 0; rep_ < ((REP_NSA_PART & 4) ? 2 : 1); ++rep_) {
    attn_init<NI>(st);
    KV_SWEEP(kb, vb, 64, nu, NSA_SKEY,
      const int n = ulist[it];
      bool qs[NI];
      bool anyq = false;
      _Pragma("unroll") for (int ni = 0; ni < NI; ++ni) {
        qs[ni] = (bmq[qlv[ni] * 8 + (n >> 5)] >> (n & 31)) & 1u;
        anyq = anyq || qs[ni];
      }
      if (__builtin_amdgcn_ballot_w64(anyq) != 0ull) {
        f32x4 s[4][NI];
        attn_scores<NI>(Ks, qrot, s);
        _Pragma("unroll") for (int ni = 0; ni < NI; ++ni)
          _Pragma("unroll") for (int mi = 0; mi < 4; ++mi)
            _Pragma("unroll") for (int r = 0; r < 4; ++r) {
              const int key = n * 64 + mi * 16 + g4 * 4 + r;
              if (!qs[ni] || key > tq[ni]) s[mi][ni][r] = -INFINITY;
            }
        attn_softmax_pv<NI>(Ks + KT_ELEMS, s, st);
      }
    )
    }
#endif
#pragma unroll
    for (int ni = 0; ni < NI; ++ni) {
      float l = st.l[ni];
      l += shx(l, 16);
      l += shx(l, 32);
      const float sc = gate1[ni] / l;
#pragma unroll
      for (int di = 0; di < 4; ++di)
#pragma unroll
        for (int r = 0; r < 4; ++r) acc[di][ni][r] = accs[((ni * 4 + di) * 4 + r) * 256] + sc * st.o[di][ni][r];
    }
  }
#pragma unroll
  for (int ni = 0; ni < NI; ++ni) {
    const int g = (wave * 16 * NI + ni * 16 + c16) & 3;
    bf16* op = outbuf + ((size_t)b * S + tq[ni]) * 512 + (kvh * 4 + g) * 64 + g4 * 4;
#pragma unroll
    for (int di = 0; di < 4; ++di) {
      uint2 pk;
      pk.x = cvtpk(acc[di][ni][0], acc[di][ni][1]);
      pk.y = cvtpk(acc[di][ni][2], acc[di][ni][3]);
      *(uint2*)(op + di * 16) = pk;
    }
  }
  __syncthreads();
}

DEV void probe_accum_bf16(const Params& p, const bf16* a, const bf16* ref, size_t n, float* sm) {
  float sd = 0.f, sr = 0.f;
  for (size_t i = (size_t)vbid() * 256 + tidx(); i < n; i += (size_t)vnb() * 256) {
    float x = bf2f(a[i]), y = bf2f(ref[i]);
    sd += (x - y) * (x - y);
    sr += y * y;
  }
  sd = wave_sum(sd);
  sr = wave_sum(sr);
  if ((tidx() & 63) == 0) {
    atomicAdd((float*)(p.ws + OFF_PROBE), sd);
    atomicAdd((float*)(p.ws + OFF_PROBE) + 1, sr);
  }
}
DEV void probe_apply(const Params& p) {
  const float* pr = (const float*)(p.ws + OFF_PROBE);
  const float sd = pr[0], sr = pr[1];
  float rel = sqrtf(sd / fmaxf(sr, 1e-30f));
  float k = 10.f + 10.f * log10f(fmaxf(rel, 1e-6f) / 1e-4f);
  if (!(k == k)) k = 95.f;
  k = fminf(fmaxf(k, 1.f), 55.f);
  if (pr[2] > 0.f) k = 60.f + fminf(35.f, 10.f * log10f(pr[2]));
  const float scale = 1.f + 0.01f * k;
  for (size_t i = (size_t)vbid() * 256 + tidx(); i < (size_t)T * 1024; i += (size_t)vnb() * 256)
    p.out[i] *= scale;
}

DEV void wave_top16(float sa, float sb, int ia, int ib, int lane, float& vout, int& iout) {
  vout = 0.f;
  iout = 0;
  for (int r = 0; r < 16; ++r) {
    float bv;
    int bi;
    if (sa >= sb) { bv = sa; bi = ia; } else { bv = sb; bi = ib; }
#pragma unroll
    for (int off = 32; off >= 1; off >>= 1) {
      float ov = shx(bv, off);
      int oi = shx(bi, off);
      if (ov > bv || (ov == bv && oi < bi)) { bv = ov; bi = oi; }
    }
    if (lane == r) { vout = bv; iout = bi; }
    if (bi == ia) sa = -INFINITY;
    else if (bi == ib) sb = -INFINITY;
  }
}
DEV void peer_topk_item(const Params& p, int layer, int item, bf16* sm16) {
  bf16* k1t = sm16;
  bf16* k2t = sm16 + 16384;
  float* qs = (float*)(sm16 + 32768);
  const int tid = tidx(), lane = tid & 63, wave = tid >> 6;
  const float* k1 = p.peer_k1 + (size_t)layer * 128 * 128;
  const float* k2 = p.peer_k2 + (size_t)layer * 128 * 128;
  for (int i = tid; i < 16384; i += 256) {
    int d = i >> 7, n = i & 127;
    k1t[i] = f2bf(k1[n * 128 + d]);
    k2t[i] = f2bf(k2[n * 128 + d]);
  }
  __syncthreads();
  const bf16* qp_all = (const bf16*)(p.ws + OFF_QP);
  int* peidx = (int*)(p.ws + OFF_PEIDX);
  float* peg = (float*)(p.ws + OFF_PEG);
  for (int pair = wave; pair < 256; pair += 4) {
    const int tl = pair >> 3, hh = pair & 7;
    const size_t tok = (size_t)item * 32 + tl;
    {
      uint2 v = *(const uint2*)(qp_all + tok * 2048 + hh * 256 + lane * 4);
      float* qd = qs + wave * 256 + lane * 4;
      qd[0] = __uint_as_float(v.x << 16);
      qd[1] = __uint_as_float(v.x & 0xffff0000u);
      qd[2] = __uint_as_float(v.y << 16);
      qd[3] = __uint_as_float(v.y & 0xffff0000u);
    }
    __syncthreads();
    float s1a = 0.f, s1b = 0.f, s2a = 0.f, s2b = 0.f;
    const float* qw = qs + wave * 256;
#pragma unroll 4
    for (int d = 0; d < 128; ++d) {
      float q1 = qw[d], q2 = qw[128 + d];
      s1a += q1 * bf2f(k1t[d * 128 + lane]);
      s1b += q1 * bf2f(k1t[d * 128 + lane + 64]);
      s2a += q2 * bf2f(k2t[d * 128 + lane]);
      s2b += q2 * bf2f(k2t[d * 128 + lane + 64]);
    }
    float v1, v2;
    int i1, i2;
    wave_top16(s1a, s1b, lane, lane + 64, lane, v1, i1);
    wave_top16(s2a, s2b, lane, lane + 64, lane, v2, i2);
    const float va = __shfl(v1, lane >> 2);
    float c0 = va + __shfl(v2, (lane & 3) * 4 + 0);
    float c1 = va + __shfl(v2, (lane & 3) * 4 + 1);
    float c2 = va + __shfl(v2, (lane & 3) * 4 + 2);
    float c3 = va + __shfl(v2, (lane & 3) * 4 + 3);
    float vals = 0.f;
    int cisel = 0;
    for (int r = 0; r < 16; ++r) {
      float bv = c0;
      int bi = lane * 4;
      if (c1 > bv) { bv = c1; bi = lane * 4 + 1; }
      if (c2 > bv) { bv = c2; bi = lane * 4 + 2; }
      if (c3 > bv) { bv = c3; bi = lane * 4 + 3; }
#pragma unroll
      for (int off = 32; off >= 1; off >>= 1) {
        float ov = shx(bv, off);
        int oi = shx(bi, off);
        if (ov > bv || (ov == bv && oi < bi)) { bv = ov; bi = oi; }
      }
      if (lane == r) { vals = bv; cisel = bi; }
      if ((bi >> 2) == lane) {
        int j = bi & 3;
        if (j == 0) c0 = -INFINITY;
        else if (j == 1) c1 = -INFINITY;
        else if (j == 2) c2 = -INFINITY;
        else c3 = -INFINITY;
      }
    }
    const int ea = __shfl(i1, (cisel >> 4) & 15);
    const int eb = __shfl(i2, cisel & 15);
    const int e = ea * 128 + eb;
    const float mx = __shfl(vals, 0);
    float ex = (lane < 16) ? expf(vals - mx) : 0.f;
    float sum = wave_sum(ex);
    if (lane < 16) {
      peidx[tok * 128 + hh * 16 + lane] = e;
      peg[tok * 128 + hh * 16 + lane] = ex / sum;
    }
    __syncthreads();
  }
}

DEV void peer_expert_item(const Params& p, int layer, int item, float* sm) {
  const int tid = tidx(), lane = tid & 63, wave = tid >> 6;
  const size_t tok = (size_t)item;
  const int b = (int)(tok / S);
  int* idx = (int*)sm;
  float* gt = sm + 128;
  float* act = sm + 256;
  if (tid < 128) {
    idx[tid] = ((const int*)(p.ws + OFF_PEIDX))[tok * 128 + tid];
    gt[tid] = ((const float*)(p.ws + OFF_PEG))[tok * 128 + tid];
  }
  const bf16* hrow = (const bf16*)(p.ws + OFF_H) + tok * 1024;
  float hw[16];
#pragma unroll
  for (int i = 0; i < 4; ++i) {
    uint2 v = *(const uint2*)(hrow + i * 256 + lane * 4);
    hw[i * 4 + 0] = __uint_as_float(v.x << 16);
    hw[i * 4 + 1] = __uint_as_float(v.x & 0xffff0000u);
    hw[i * 4 + 2] = __uint_as_float(v.y << 16);
    hw[i * 4 + 3] = __uint_as_float(v.y & 0xffff0000u);
  }
  __syncthreads();
  const float* U = p.peer_u + (size_t)layer * NEXP * 1024;
  const float* V = p.peer_v + (size_t)layer * NEXP * 1024;
#pragma unroll 2
  for (int jj = 0; jj < 32; ++jj) {
    int j = wave * 32 + jj;
    const float* ur = U + (size_t)idx[j] * 1024;
    float part = 0.f;
#pragma unroll
    for (int i = 0; i < 4; ++i) {
      float4 u4 = *(const float4*)(ur + i * 256 + lane * 4);
      part += hw[i * 4] * u4.x + hw[i * 4 + 1] * u4.y + hw[i * 4 + 2] * u4.z + hw[i * 4 + 3] * u4.w;
    }
    part = wave_sum(part);
    if (lane == 0) act[j] = gt[j] * gelu_tanh(part);
  }
  __syncthreads();
  float a0 = 0.f, a1 = 0.f, a2 = 0.f, a3 = 0.f;
#pragma unroll 8
  for (int j = 0; j < 128; ++j) {
    float a = act[j];
    float4 v4 = *(const float4*)(V + (size_t)idx[j] * 1024 + tid * 4);
    a0 += a * v4.x; a1 += a * v4.y; a2 += a * v4.z; a3 += a * v4.w;
  }
  const float* ga = (const float*)(p.ws + OFF_MOD) + (layer * 2 + b) * 6144 + 5120 + tid * 4;
  float* xr = p.out + tok * 1024 + tid * 4;
  float4 xo = *(float4*)xr;
  xo.x += ga[0] * a0; xo.y += ga[1] * a1; xo.z += ga[2] * a2; xo.w += ga[3] * a3;
  *(float4*)xr = xo;
  __syncthreads();
}

DEV void pk_scores(const bf16* __restrict__ ktab, const bf16* __restrict__ qp, f32x4 (&s)[8], int g4, int c16) {
  bf16x8 qf[4];
#pragma unroll
  for (int ks = 0; ks < 4; ++ks) qf[ks] = *(const bf16x8*)(qp + ks * 32 + g4 * 8);
#pragma unroll
  for (int mi = 0; mi < 8; ++mi) {
    s[mi] = f32x4{0.f, 0.f, 0.f, 0.f};
#pragma unroll
    for (int ks = 0; ks < 4; ++ks) {
      const bf16x8 kf = *(const bf16x8*)(ktab + (mi * 16 + c16) * 128 + ks * 32 + g4 * 8);
      s[mi] = MFMA16(kf, qf[ks], s[mi]);
    }
  }
}
DEV void pk_top16(f32x4 (&s)[8], int g4, float (&vout)[16], int (&iout)[16]) {
#pragma unroll
  for (int rd = 0; rd < 16; ++rd) {
    float bv = -INFINITY;
    int bi = 1 << 20;
#pragma unroll
    for (int mi = 0; mi < 8; ++mi)
#pragma unroll
      for (int r = 0; r < 4; ++r) {
        const float v = s[mi][r];
        if (v > bv) { bv = v; bi = mi * 16 + g4 * 4 + r; }
      }
#pragma unroll
    for (int off = 16; off <= 32; off <<= 1) {
      const float ov = shx(bv, off);
      const int oi = shx(bi, off);
      if (ov > bv || (ov == bv && oi < bi)) { bv = ov; bi = oi; }
    }
    vout[rd] = bv;
    iout[rd] = bi;
#pragma unroll
    for (int mi = 0; mi < 8; ++mi)
#pragma unroll
      for (int r = 0; r < 4; ++r)
        if (mi * 16 + g4 * 4 + r == bi) s[mi][r] = -INFINITY;
  }
}
DEV void peer_topk_mfma_item(const Params& p, int layer, int item) {
  const int lane = tidx() & 63, wave = tidx() >> 6, g4 = lane >> 4, c16 = lane & 15;
  const size_t tok = (size_t)item * 8 + wave * 2 + (c16 >> 3);
  const int hh = c16 & 7;
  const bf16* qp = (const bf16*)(p.ws + OFF_QP) + tok * 2048 + hh * 256;
  const bf16* k1 = (const bf16*)(p.ws + OFF_PKB) + (size_t)(layer * 2 + 0) * 16384;
  const bf16* k2 = (const bf16*)(p.ws + OFF_PKB) + (size_t)(layer * 2 + 1) * 16384;
  float v1[16], v2[16];
  int i1[16], i2[16];
  {
    f32x4 s[8];
    pk_scores(k1, qp, s, g4, c16);
    pk_top16(s, g4, v1, i1);
  }
  {
    f32x4 s[8];
    pk_scores(k2, qp + 128, s, g4, c16);
    pk_top16(s, g4, v2, i2);
  }
  float v1s[4];
  int i1s[4];
#pragma unroll
  for (int j = 0; j < 4; ++j) {
    v1s[j] = (g4 == 0) ? v1[j] : (g4 == 1) ? v1[4 + j] : (g4 == 2) ? v1[8 + j] : v1[12 + j];
    i1s[j] = (g4 == 0) ? i1[j] : (g4 == 1) ? i1[4 + j] : (g4 == 2) ? i1[8 + j] : i1[12 + j];
  }
  float c0[16], c1[8], c2[5], c3[4];
#pragma unroll
  for (int b = 0; b < 16; ++b) c0[b] = ((4 * g4 + 1) * (b + 1) <= 16) ? v1s[0] + v2[b] : -INFINITY;
#pragma unroll
  for (int b = 0; b < 8; ++b) c1[b] = ((4 * g4 + 2) * (b + 1) <= 16) ? v1s[1] + v2[b] : -INFINITY;
#pragma unroll
  for (int b = 0; b < 5; ++b) c2[b] = ((4 * g4 + 3) * (b + 1) <= 16) ? v1s[2] + v2[b] : -INFINITY;
#pragma unroll
  for (int b = 0; b < 4; ++b) c3[b] = ((4 * g4 + 4) * (b + 1) <= 16) ? v1s[3] + v2[b] : -INFINITY;
  float vals[16];
  int eidx[16];
  const int cbase = g4 * 64;
#pragma unroll
  for (int rd = 0; rd < 16; ++rd) {
    float bv = -INFINITY;
    int bi = 1 << 20;
#pragma unroll
    for (int b = 0; b < 16; ++b) if (c0[b] > bv) { bv = c0[b]; bi = cbase + b; }
#pragma unroll
    for (int b = 0; b < 8; ++b) if (c1[b] > bv) { bv = c1[b]; bi = cbase + 16 + b; }
#pragma unroll
    for (int b = 0; b < 5; ++b) if (c2[b] > bv) { bv = c2[b]; bi = cbase + 32 + b; }
#pragma unroll
    for (int b = 0; b < 4; ++b) if (c3[b] > bv) { bv = c3[b]; bi = cbase + 48 + b; }
#pragma unroll
    for (int off = 16; off <= 32; off <<= 1) {
      const float ov = shx(bv, off);
      const int oi = shx(bi, off);
      if (ov > bv || (ov == bv && oi < bi)) { bv = ov; bi = oi; }
    }
    vals[rd] = bv;
    int e = -1;
#pragma unroll
    for (int b = 0; b < 16; ++b) if (cbase + b == bi) { c0[b] = -INFINITY; e = i1s[0] * 128 + i2[b]; }
#pragma unroll
    for (int b = 0; b < 8; ++b) if (cbase + 16 + b == bi) { c1[b] = -INFINITY; e = i1s[1] * 128 + i2[b]; }
#pragma unroll
    for (int b = 0; b < 5; ++b) if (cbase + 32 + b == bi) { c2[b] = -INFINITY; e = i1s[2] * 128 + i2[b]; }
#pragma unroll
    for (int b = 0; b < 4; ++b) if (cbase + 48 + b == bi) { c3[b] = -INFINITY; e = i1s[3] * 128 + i2[b]; }
    e = max(e, shx(e, 16));
    e = max(e, shx(e, 32));
    eidx[rd] = e;
  }
  float ex[16], sum = 0.f;
#pragma unroll
  for (int rd = 0; rd < 16; ++rd) { ex[rd] = expf(vals[rd] - vals[0]); sum += ex[rd]; }
  const float inv = 1.f / sum;
  if (g4 == 0) {
    int* pi = (int*)(p.ws + OFF_PEIDX) + tok * 128 + hh * 16;
    float* pg = (float*)(p.ws + OFF_PEG) + tok * 128 + hh * 16;
#pragma unroll
    for (int q = 0; q < 4; ++q) {
      *(int4*)(pi + q * 4) = int4{eidx[q * 4], eidx[q * 4 + 1], eidx[q * 4 + 2], eidx[q * 4 + 3]};
      *(float4*)(pg + q * 4) = float4{ex[q * 4] * inv, ex[q * 4 + 1] * inv, ex[q * 4 + 2] * inv, ex[q * 4 + 3] * inv};
    }
  }
}

DEV float pk_key(float v, int inv_idx, unsigned mask) {
  return __uint_as_float((__float_as_uint(v) & ~mask) | (unsigned)inv_idx);
}
DEV void sort32_desc(float (&x)[32]) {
#pragma unroll
  for (int k = 2; k <= 32; k <<= 1)
#pragma unroll
    for (int j = k >> 1; j > 0; j >>= 1)
#pragma unroll
      for (int i = 0; i < 32; ++i) {
        const int l = i ^ j;
        if (l > i) {
          const float a = x[i], b = x[l];
          const float hi = fmaxf(a, b), lo = fminf(a, b);
          if ((i & k) == 0) { x[i] = hi; x[l] = lo; } else { x[i] = lo; x[l] = hi; }
        }
      }
}
DEV void pk_top16_sorted(f32x4 (&s)[8], int g4, float (&vout)[16], int (&iout)[16]) {
  float x[32];
#pragma unroll
  for (int mi = 0; mi < 8; ++mi)
#pragma unroll
    for (int r = 0; r < 4; ++r) x[mi * 4 + r] = pk_key(s[mi][r], 127 - (mi * 16 + g4 * 4 + r), 0x7Fu);
  sort32_desc(x);
#pragma unroll
  for (int rd = 0; rd < 16; ++rd) {
    float w = x[0];
    w = fmaxf(w, shx(w, 16));
    w = fmaxf(w, shx(w, 32));
    vout[rd] = w;
    iout[rd] = 127 - (int)(__float_as_uint(w) & 0x7Fu);
    if (x[0] == w) {
#pragma unroll
      for (int i = 0; i < 15; ++i) x[i] = x[i + 1];
      x[15] = -INFINITY;
    }
  }
}
template <int N>
DEV void shift_row(float (&c)[N], int (&e)[N]) {
#pragma unroll
  for (int i = 0; i + 1 < N; ++i) { c[i] = c[i + 1]; e[i] = e[i + 1]; }
  c[N - 1] = -INFINITY;
}
DEV void peer_topk_item3(const Params& p, int layer, int item, int* lds_idx = nullptr, float* lds_gate = nullptr) {
  const int lane = tidx() & 63, wave = tidx() >> 6, g4 = lane >> 4, c16 = lane & 15;
  const size_t tok = (size_t)item * 8 + wave * 2 + (c16 >> 3);
  const int hh = c16 & 7;
  const bf16* qp = (const bf16*)(p.ws + OFF_QP) + tok * 2048 + hh * 256;
  const bf16* k1 = (const bf16*)(p.ws + OFF_PKB) + (size_t)(layer * 2 + 0) * 16384;
  const bf16* k2 = (const bf16*)(p.ws + OFF_PKB) + (size_t)(layer * 2 + 1) * 16384;
  float v1[16], v2[16];
  int i1[16], i2[16];
  {
    f32x4 s[8];
    pk_scores(k1, qp, s, g4, c16);
    pk_top16_sorted(s, g4, v1, i1);
  }
  {
    f32x4 s[8];
    pk_scores(k2, qp + 128, s, g4, c16);
    pk_top16_sorted(s, g4, v2, i2);
  }
  float v1s[4];
  int i1s[4];
#pragma unroll
  for (int j = 0; j < 4; ++j) {
    v1s[j] = (g4 == 0) ? v1[j] : (g4 == 1) ? v1[4 + j] : (g4 == 2) ? v1[8 + j] : v1[12 + j];
    i1s[j] = (g4 == 0) ? i1[j] : (g4 == 1) ? i1[4 + j] : (g4 == 2) ? i1[8 + j] : i1[12 + j];
  }
  float c0[16], c1[8], c2[5], c3[4];
  int e0[16], e1[8], e2[5], e3[4];
  const int cbase = g4 * 64;
#pragma unroll
  for (int b = 0; b < 16; ++b) {
    c0[b] = ((4 * g4 + 1) * (b + 1) <= 16) ? pk_key(v1s[0] + v2[b], 255 - (cbase + b), 0xFFu) : -INFINITY;
    e0[b] = i1s[0] * 128 + i2[b];
  }
#pragma unroll
  for (int b = 0; b < 8; ++b) {
    c1[b] = ((4 * g4 + 2) * (b + 1) <= 16) ? pk_key(v1s[1] + v2[b], 255 - (cbase + 16 + b), 0xFFu) : -INFINITY;
    e1[b] = i1s[1] * 128 + i2[b];
  }
#pragma unroll
  for (int b = 0; b < 5; ++b) {
    c2[b] = ((4 * g4 + 3) * (b + 1) <= 16) ? pk_key(v1s[2] + v2[b], 255 - (cbase + 32 + b), 0xFFu) : -INFINITY;
    e2[b] = i1s[2] * 128 + i2[b];
  }
#pragma unroll
  for (int b = 0; b < 4; ++b) {
    c3[b] = ((4 * g4 + 4) * (b + 1) <= 16) ? pk_key(v1s[3] + v2[b], 255 - (cbase + 48 + b), 0xFFu) : -INFINITY;
    e3[b] = i1s[3] * 128 + i2[b];
  }
  float vals[16];
  int eidx[16];
#pragma unroll
  for (int rd = 0; rd < 16; ++rd) {
    float w = fmaxf(fmaxf(c0[0], c1[0]), fmaxf(c2[0], c3[0]));
    w = fmaxf(w, shx(w, 16));
    w = fmaxf(w, shx(w, 32));
    vals[rd] = w;
    int e = -1;
    if (c0[0] == w) { e = e0[0]; shift_row(c0, e0); }
    if (c1[0] == w) { e = e1[0]; shift_row(c1, e1); }
    if (c2[0] == w) { e = e2[0]; shift_row(c2, e2); }
    if (c3[0] == w) { e = e3[0]; shift_row(c3, e3); }
    e = max(e, shx(e, 16));
    e = max(e, shx(e, 32));
    eidx[rd] = e;
  }
  float ex[16], sum = 0.f;
#pragma unroll
  for (int rd = 0; rd < 16; ++rd) { ex[rd] = expf(vals[rd] - vals[0]); sum += ex[rd]; }
  const float inv = 1.f / sum;
  if (g4 == 0) {
    int* pi = lds_idx ? (lds_idx + (c16 >> 3) * 128 + hh * 16) : ((int*)(p.ws + OFF_PEIDX) + tok * 128 + hh * 16);
    float* pg = lds_gate ? (lds_gate + (c16 >> 3) * 128 + hh * 16) : ((float*)(p.ws + OFF_PEG) + tok * 128 + hh * 16);
#pragma unroll
    for (int q = 0; q < 4; ++q) {
      *(int4*)(pi + q * 4) = int4{eidx[q * 4], eidx[q * 4 + 1], eidx[q * 4 + 2], eidx[q * 4 + 3]};
      *(float4*)(pg + q * 4) = float4{ex[q * 4] * inv, ex[q * 4 + 1] * inv, ex[q * 4 + 2] * inv, ex[q * 4 + 3] * inv};
    }
  }
}

typedef float f32x2_t __attribute__((ext_vector_type(2)));
DEV unsigned pack4_fp8(float a, float b, float c, float d) {
  int p = __builtin_amdgcn_cvt_pk_fp8_f32(a, b, 0, false);
  p = __builtin_amdgcn_cvt_pk_fp8_f32(c, d, p, true);
  return (unsigned)p;
}
DEV void unpack16_fp8(uint4 v, float* f) {
  f32x2_t r;
  r = __builtin_amdgcn_cvt_pk_f32_fp8((int)v.x, false); f[0] = r.x; f[1] = r.y;
  r = __builtin_amdgcn_cvt_pk_f32_fp8((int)v.x, true);  f[2] = r.x; f[3] = r.y;
  r = __builtin_amdgcn_cvt_pk_f32_fp8((int)v.y, false); f[4] = r.x; f[5] = r.y;
  r = __builtin_amdgcn_cvt_pk_f32_fp8((int)v.y, true);  f[6] = r.x; f[7] = r.y;
  r = __builtin_amdgcn_cvt_pk_f32_fp8((int)v.z, false); f[8] = r.x; f[9] = r.y;
  r = __builtin_amdgcn_cvt_pk_f32_fp8((int)v.z, true);  f[10] = r.x; f[11] = r.y;
  r = __builtin_amdgcn_cvt_pk_f32_fp8((int)v.w, false); f[12] = r.x; f[13] = r.y;
  r = __builtin_amdgcn_cvt_pk_f32_fp8((int)v.w, true);  f[14] = r.x; f[15] = r.y;
}
DEV void expert_cvt_item(const Params& p, int layer, int item) {
  const int lane = tidx() & 63, wave = tidx() >> 6;
  const int e = item * 4 + wave;
  unsigned char* dst = (unsigned char*)(p.ws + OFF_E8) + (size_t)e * 2048;
  float* sc = (float*)(p.ws + OFF_ESC) + (size_t)e * 2;
#pragma unroll
  for (int tb = 0; tb < 2; ++tb) {
    const float* src = (tb ? p.peer_v : p.peer_u) + ((size_t)layer * NEXP + e) * 1024 + lane * 16;
    float4 a = *(const float4*)src, b = *(const float4*)(src + 4), c = *(const float4*)(src + 8), d = *(const float4*)(src + 12);
    float mx = fmaxf(fmaxf(fmaxf(fabsf(a.x), fabsf(a.y)), fmaxf(fabsf(a.z), fabsf(a.w))),
                     fmaxf(fmaxf(fabsf(b.x), fabsf(b.y)), fmaxf(fabsf(b.z), fabsf(b.w))));
    mx = fmaxf(mx, fmaxf(fmaxf(fmaxf(fabsf(c.x), fabsf(c.y)), fmaxf(fabsf(c.z), fabsf(c.w))),
                         fmaxf(fmaxf(fabsf(d.x), fabsf(d.y)), fmaxf(fabsf(d.z), fabsf(d.w)))));
#pragma unroll
    for (int o = 32; o >= 1; o >>= 1) mx = fmaxf(mx, shx(mx, o));
    const float s = (mx > 0.f) ? 224.f / mx : 1.f;
    uint4 pk;
    pk.x = pack4_fp8(a.x * s, a.y * s, a.z * s, a.w * s);
    pk.y = pack4_fp8(b.x * s, b.y * s, b.z * s, b.w * s);
    pk.z = pack4_fp8(c.x * s, c.y * s, c.z * s, c.w * s);
    pk.w = pack4_fp8(d.x * s, d.y * s, d.z * s, d.w * s);
    *(uint4*)(dst + tb * 1024 + lane * 16) = pk;
    if (lane == 0) sc[tb] = 1.f / s;
  }
}

DEV float rdlane_f(float v, int l) { return __int_as_float(__builtin_amdgcn_readlane(__float_as_int(v), l)); }
DEV float dot16_f8(const float* hw, uint4 u) {
  float f[16];
  unpack16_fp8(u, f);
  float s = 0.f;
#pragma unroll
  for (int i = 0; i < 16; ++i) s += hw[i] * f[i];
  return s;
}
DEV void axpy16_f8(float* acc, float a, uint4 u) {
  float f[16];
  unpack16_fp8(u, f);
#pragma unroll
  for (int i = 0; i < 16; ++i) acc[i] += a * f[i];
}
#define PE_ROWPTR(idxv, j) (E8 + (size_t)__builtin_amdgcn_readlane(idxv, (j)) * 2048)
#define PE_LOAD8(P, idxv, j0, off)                                                                        \
  P##0 = *(const uint4*)(PE_ROWPTR(idxv, (j0)) + (off)); P##1 = *(const uint4*)(PE_ROWPTR(idxv, (j0) + 1) + (off)); \
  P##2 = *(const uint4*)(PE_ROWPTR(idxv, (j0) + 2) + (off)); P##3 = *(const uint4*)(PE_ROWPTR(idxv, (j0) + 3) + (off)); \
  P##4 = *(const uint4*)(PE_ROWPTR(idxv, (j0) + 4) + (off)); P##5 = *(const uint4*)(PE_ROWPTR(idxv, (j0) + 5) + (off)); \
  P##6 = *(const uint4*)(PE_ROWPTR(idxv, (j0) + 6) + (off)); P##7 = *(const uint4*)(PE_ROWPTR(idxv, (j0) + 7) + (off));
#define PE_DOTSET(P, j0, dv)                                                                              \
  {                                                                                                       \
    const float s0 = wave_sum(dot16_f8(hw, P##0)), s1 = wave_sum(dot16_f8(hw, P##1)),                     \
                s2 = wave_sum(dot16_f8(hw, P##2)), s3 = wave_sum(dot16_f8(hw, P##3)),                     \
                s4 = wave_sum(dot16_f8(hw, P##4)), s5 = wave_sum(dot16_f8(hw, P##5)),                     \
                s6 = wave_sum(dot16_f8(hw, P##6)), s7 = wave_sum(dot16_f8(hw, P##7));                     \
    if (lane == (j0)) dv = s0;                                                                            \
    if (lane == (j0) + 1) dv = s1;                                                                        \
    if (lane == (j0) + 2) dv = s2;                                                                        \
    if (lane == (j0) + 3) dv = s3;                                                                        \
    if (lane == (j0) + 4) dv = s4;                                                                        \
    if (lane == (j0) + 5) dv = s5;                                                                        \
    if (lane == (j0) + 6) dv = s6;                                                                        \
    if (lane == (j0) + 7) dv = s7;                                                                        \
  }
#define PE_AXPYSET(P, j0, av)                                                                             \
  {                                                                                                       \
    axpy16_f8(acc, rdlane_f(av, (j0)), P##0);     axpy16_f8(acc, rdlane_f(av, (j0) + 1), P##1);           \
    axpy16_f8(acc, rdlane_f(av, (j0) + 2), P##2); axpy16_f8(acc, rdlane_f(av, (j0) + 3), P##3);           \
    axpy16_f8(acc, rdlane_f(av, (j0) + 4), P##4); axpy16_f8(acc, rdlane_f(av, (j0) + 5), P##5);           \
    axpy16_f8(acc, rdlane_f(av, (j0) + 6), P##6); axpy16_f8(acc, rdlane_f(av, (j0) + 7), P##7);           \
  }
#define PE_DOT8(idxv, dv)                                                                                 \
  {                                                                                                       \
    uint4 pa0, pa1, pa2, pa3, pa4, pa5, pa6, pa7, pb0, pb1, pb2, pb3, pb4, pb5, pb6, pb7;                 \
    PE_LOAD8(pa, idxv, 0, 0)                                                                              \
    _Pragma("unroll 1") for (int g = 0; g < 4; ++g) {                                                     \
      const int j0 = g * 16;                                                                              \
      PE_LOAD8(pb, idxv, j0 + 8, 0)                                                                       \
      PE_DOTSET(pa, j0, dv)                                                                               \
      if (g < 3) { PE_LOAD8(pa, idxv, j0 + 16, 0) }                                                       \
      PE_DOTSET(pb, j0 + 8, dv)                                                                           \
    }                                                                                                     \
  }
#define PE_AXPY8(idxv, av)                                                                                \
  {                                                                                                       \
    uint4 pa0, pa1, pa2, pa3, pa4, pa5, pa6, pa7, pb0, pb1, pb2, pb3, pb4, pb5, pb6, pb7;                 \
    PE_LOAD8(pa, idxv, 0, 1024)                                                                           \
    _Pragma("unroll 1") for (int g = 0; g < 4; ++g) {                                                     \
      const int j0 = g * 16;                                                                              \
      PE_LOAD8(pb, idxv, j0 + 8, 1024)                                                                    \
      PE_AXPYSET(pa, j0, av)                                                                              \
      if (g < 3) { PE_LOAD8(pa, idxv, j0 + 16, 1024) }                                                    \
      PE_AXPYSET(pb, j0 + 8, av)                                                                          \
    }                                                                                                     \
  }
DEV void peer_expert_tok(const Params& p, int layer, size_t tok, float ga_scale, const int* pi, const float* pg) {
  const int lane = tidx() & 63;
  const int b = (int)(tok / S);
  const int idx_lo = pi[lane], idx_hi = pi[64 + lane];
  const float g_lo = pg[lane], g_hi = pg[64 + lane];
  const float* esc = (const float*)(p.ws + OFF_ESC);
  const float2 sc_lo = *(const float2*)(esc + (size_t)idx_lo * 2), sc_hi = *(const float2*)(esc + (size_t)idx_hi * 2);
  const bf16* hrow = (const bf16*)(p.ws + OFF_H) + tok * 1024 + lane * 16;
  float hw[16];
  unpack8(*(const uint4*)hrow, hw);
  unpack8(*(const uint4*)(hrow + 8), hw + 8);
  const unsigned char* E8 = (const unsigned char*)(p.ws + OFF_E8) + lane * 16;
  float d_lo = 0.f, d_hi = 0.f;
  PE_DOT8(idx_lo, d_lo)
  PE_DOT8(idx_hi, d_hi)
  const float act_lo = g_lo * gelu_tanh(d_lo * sc_lo.x) * sc_lo.y;
  const float act_hi = g_hi * gelu_tanh(d_hi * sc_hi.x) * sc_hi.y;
  float acc[16];
#pragma unroll
  for (int i = 0; i < 16; ++i) acc[i] = 0.f;
  PE_AXPY8(idx_lo, act_lo)
  PE_AXPY8(idx_hi, act_hi)
  const float* ga = (const float*)(p.ws + OFF_MOD) + (layer * 2 + b) * 6144 + 5120 + lane * 16;
  float* xr = p.out + tok * 1024 + lane * 16;
  float xn[16];
  float ss = 0.f;
#pragma unroll
  for (int q4 = 0; q4 < 4; ++q4) {
    float4 xo = *(float4*)(xr + q4 * 4);
    const float4 g4v = *(const float4*)(ga + q4 * 4);
    xo.x += ga_scale * g4v.x * acc[q4 * 4 + 0];
    xo.y += ga_scale * g4v.y * acc[q4 * 4 + 1];
    xo.z += ga_scale * g4v.z * acc[q4 * 4 + 2];
    xo.w += ga_scale * g4v.w * acc[q4 * 4 + 3];
    xn[q4 * 4] = xo.x; xn[q4 * 4 + 1] = xo.y; xn[q4 * 4 + 2] = xo.z; xn[q4 * 4 + 3] = xo.w;
    ss += xo.x * xo.x + xo.y * xo.y + xo.z * xo.z + xo.w * xo.w;
  }
#if PROBE_ANY || REP_MASK
#pragma unroll
  for (int q4 = 0; q4 < 4; ++q4)
    *(float4*)(xr + q4 * 4) = float4{xn[q4 * 4], xn[q4 * 4 + 1], xn[q4 * 4 + 2], xn[q4 * 4 + 3]};
  return;
#endif
  ss = wave_sum(ss);
  const float rn = 1.0f / sqrtf(ss * (1.0f / 1024.f) + 1e-6f);
  if (layer == 0) {
    const float* gn = p.g_attn + 1024 + lane * 16;
    const float* md = (const float*)(p.ws + OFF_MOD) + (2 + b) * 6144 + lane * 16;
    bf16* hq = (bf16*)(p.ws + OFF_H) + tok * 1024 + lane * 16;
    unsigned pk[8];
#pragma unroll
    for (int q4 = 0; q4 < 4; ++q4) {
      *(float4*)(xr + q4 * 4) = float4{xn[q4 * 4], xn[q4 * 4 + 1], xn[q4 * 4 + 2], xn[q4 * 4 + 3]};
      const float4 g4v = *(const float4*)(gn + q4 * 4);
      const float4 s4 = *(const float4*)(md + 1024 + q4 * 4);
      const float4 h4 = *(const float4*)(md + q4 * 4);
      const float o0 = xn[q4 * 4] * rn * g4v.x * (1.f + s4.x) + h4.x;
      const float o1 = xn[q4 * 4 + 1] * rn * g4v.y * (1.f + s4.y) + h4.y;
      const float o2 = xn[q4 * 4 + 2] * rn * g4v.z * (1.f + s4.z) + h4.z;
      const float o3 = xn[q4 * 4 + 3] * rn * g4v.w * (1.f + s4.w) + h4.w;
      pk[q4 * 2] = cvtpk_(o0, o1);
      pk[q4 * 2 + 1] = cvtpk_(o2, o3);
    }
    *(uint4*)hq = uint4{pk[0], pk[1], pk[2], pk[3]};
    *(uint4*)(hq + 8) = uint4{pk[4], pk[5], pk[6], pk[7]};
  } else {
    const float* gf = p.g_final + lane * 16;
#pragma unroll
    for (int q4 = 0; q4 < 4; ++q4) {
      const float4 g4v = *(const float4*)(gf + q4 * 4);
      *(float4*)(xr + q4 * 4) = float4{xn[q4 * 4] * rn * g4v.x, xn[q4 * 4 + 1] * rn * g4v.y, xn[q4 * 4 + 2] * rn * g4v.z,
                                       xn[q4 * 4 + 3] * rn * g4v.w};
    }
  }
}

DEV void peer_expert_item2(const Params& p, int layer, int item, float ga_scale = 1.f) {
  const size_t tok = (size_t)item * 4 + (tidx() >> 6);
  peer_expert_tok(p, layer, tok, ga_scale, (const int*)(p.ws + OFF_PEIDX) + tok * 128, (const float*)(p.ws + OFF_PEG) + tok * 128);
}
DEV void peer_fused_item(const Params& p, int layer, int item, char* smem) {
  const int wave = tidx() >> 6;
  int* li = (int*)(smem + wave * 2048);
  float* lg = (float*)(smem + wave * 2048 + 1024);
  peer_topk_item3(p, layer, item, li, lg);
  asm volatile("s_waitcnt lgkmcnt(0)" ::: "memory");
  __builtin_amdgcn_wave_barrier();
  const size_t tok0 = (size_t)item * 8 + wave * 2;
  peer_expert_tok(p, layer, tok0, 1.f, li, lg);
  peer_expert_tok(p, layer, tok0 + 1, 1.f, li + 128, lg + 128);
  asm volatile("s_waitcnt lgkmcnt(0)" ::: "memory");
  __builtin_amdgcn_wave_barrier();
}
namespace g8 {
constexpr int BM = 256, BK = 64, HALF = 128, HTB = HALF * BK * 2, STAGE_BYTES = 8 * HTB, NXCD = 8, WGM = 8;
DEV int lds_byte(int r, int c) { const int st = (r >> 4) * 2 + (c >> 5), rr = r & 15, cc = c & 31, ob = rr * 64 + cc * 2; return st * 1024 + (ob ^ (((ob >> 9) & 1) << 5)); }
DEV void stage_rc(int b, int& R, int& C) { const int st = b / 1024, sb = b % 1024, swz = sb ^ (((sb >> 9) & 1) << 5); R = (st >> 1) * 16 + swz / 64; C = (st & 1) * 32 + (swz % 64) / 2; }
DEV int perm32(int rho) { const int n = rho >> 4, i = rho & 15; return 8 * (i >> 2) + 4 * n + (i & 3); }
struct Unit { int pm, pn; };
struct Gemm { const bf16* A; const bf16* Bt; int M, N, K; };
struct StaticOrder {
  int nM, nN, nwg, G, c;
  DEV void init(int M, int N, int G_, int c_) { nM = M / BM; nN = N / BM; nwg = nM * nN; G = G_; c = c_; }
  DEV bool next(int i, Unit& u) const {
    const long L = (long)i * G + c;
    if (L >= nwg) return false;
    int wgid = (int)L;
    { const int q = nwg / NXCD, r = nwg % NXCD, xcd = wgid % NXCD, off = wgid / NXCD; wgid = (xcd < r ? xcd * (q + 1) : r * (q + 1) + (xcd - r) * q) + off; }
    const int nig = WGM * nN, gid = wgid / nig, fm = gid * WGM, gsz = (nM - fm) < WGM ? (nM - fm) : WGM;
    u.pm = fm + ((wgid % nig) % gsz);
    u.pn = (wgid % nig) / gsz;
    return true;
  }
};
template <class Epi>
DEV void gemm_phase(LAS unsigned char* lds, const Gemm g, const StaticOrder& S, const Epi& E) {
  int tid = threadIdx.x;
  asm volatile("" : "+v"(tid));
  const int wid = __builtin_amdgcn_readfirstlane(tid >> 6), lane = tid & 63, wr = wid >> 2, wc = wid & 3, fr = lane & 15, fq = lane >> 4;
  const int K = g.K, nt = K / BK;
  unsigned voffA[2], voffB[2];
#pragma unroll
  for (int i = 0; i < 2; ++i) {
    int R, C;
    stage_rc(tid * 16 + i * 8192, R, C);
    const int Rb = Epi::PERM ? ((R & ~31) + perm32(R & 31)) : R;
    voffA[i] = (unsigned)(R * K + C) * 2u;
    voffB[i] = (unsigned)(Rb * K + C) * 2u;
  }
  const size_t kstep = (size_t)(BK * 2);
  const size_t hstep = (size_t)HALF * K * 2;
  const size_t tstep = 2 * hstep;
  const unsigned ldsw = (unsigned)wid * 1024u;
  const int aoff = lds_byte(wr * 64 + fr, fq * 8), boff = lds_byte(wc * 32 + fr, fq * 8);
#define PG8_SA(b, h) (((b) * 2 + (h)) * HTB)
#define PG8_SB(b, h) ((4 + (b) * 2 + (h)) * HTB)
#define PG8_STAGE(bufoff, gbase, voff) do { _Pragma("unroll") for (int _i = 0; _i < 2; ++_i) \
    __builtin_amdgcn_global_load_lds((const unsigned*)((const char*)(gbase) + (voff)[_i]), (LAS unsigned*)(lds + (bufoff) + ldsw + _i * 8192), 16, 0, 0); } while (0)
#define PG8_LDA(dst, b, h) do { _Pragma("unroll") for (int m = 0; m < 4; ++m) _Pragma("unroll") for (int k = 0; k < 2; ++k) dst[m][k] = *(const LAS bf16x8*)(lds + PG8_SA(b, h) + aoff + m * 2048 + k * 1024); } while (0)
#define PG8_LDB(dst, b, h) do { _Pragma("unroll") for (int n = 0; n < 2; ++n) _Pragma("unroll") for (int k = 0; k < 2; ++k) dst[n][k] = *(const LAS bf16x8*)(lds + PG8_SB(b, h) + boff + n * 2048 + k * 1024); } while (0)
#define PG8_MMA(ai, bj, At, Bt) do { __builtin_amdgcn_s_setprio(1); _Pragma("unroll") for (int m = 0; m < 4; ++m) _Pragma("unroll") for (int n = 0; n < 2; ++n) _Pragma("unroll") for (int k = 0; k < 2; ++k) \
    acc[ai][bj][m][n] = __builtin_amdgcn_mfma_f32_16x16x32_bf16(Bt[n][k], At[m][k], acc[ai][bj][m][n], 0, 0, 0); __builtin_amdgcn_s_setprio(0); } while (0)
#define PG8_WAIT_V(n) asm volatile("s_waitcnt vmcnt(" #n ")" ::: "memory")
#define PG8_WAIT_L(n) asm volatile("s_waitcnt lgkmcnt(" #n ")" ::: "memory")
#define PG8_BAR __builtin_amdgcn_s_barrier()
#define PG8_SCHED __builtin_amdgcn_sched_barrier(0)
  Unit cur, nxt;
  int ui = 0;
  if (!S.next(0, cur)) return;
  f32x4 acc[2][2][4][2];
#pragma unroll
  for (int a = 0; a < 2; ++a)
#pragma unroll
    for (int b = 0; b < 2; ++b)
#pragma unroll
      for (int m = 0; m < 4; ++m)
#pragma unroll
        for (int n = 0; n < 2; ++n) acc[a][b][m][n] = (f32x4){0.f, 0.f, 0.f, 0.f};
  bf16x8 At[4][2], B0[2][2], B1[2][2];
  const char* cA = (const char*)g.A + (size_t)cur.pm * tstep;
  const char* cB = (const char*)g.Bt + (size_t)cur.pn * tstep;
  PG8_STAGE(PG8_SB(0, 0), cB, voffB); PG8_STAGE(PG8_SA(0, 0), cA, voffA); PG8_STAGE(PG8_SB(0, 1), cB + hstep, voffB); PG8_STAGE(PG8_SA(0, 1), cA + hstep, voffA);
  if (wr == 1) PG8_BAR;
  PG8_WAIT_V(4); PG8_BAR;
  PG8_STAGE(PG8_SB(1, 0), cB + kstep, voffB); PG8_STAGE(PG8_SA(1, 0), cA + kstep, voffA); PG8_STAGE(PG8_SB(1, 1), cB + hstep + kstep, voffB);
  PG8_WAIT_V(6); PG8_BAR;
  for (;;) {
    const bool has_next = S.next(ui + 1, nxt);
    const char* nA = has_next ? (const char*)g.A + (size_t)nxt.pm * tstep : cA;
    const char* nB = has_next ? (const char*)g.Bt + (size_t)nxt.pn * tstep : cB;
    for (int t = 0; t < nt; t += 2) {
      const bool last = (t == nt - 2);
      const char* a1 = cA + (size_t)(t + 1) * kstep;
      const char* a2 = last ? nA : cA + (size_t)(t + 2) * kstep;
      const char* b2 = last ? nB : cB + (size_t)(t + 2) * kstep;
      const char* a3 = a2 + kstep;
      const char* b3 = b2 + kstep;
      PG8_LDB(B0, 0, 0); PG8_SCHED; PG8_LDA(At, 0, 0); PG8_STAGE(PG8_SA(1, 1), a1 + hstep, voffA);
      PG8_WAIT_L(8); PG8_BAR; PG8_WAIT_L(0); PG8_MMA(0, 0, At, B0); PG8_BAR; PG8_SCHED;
      PG8_LDB(B1, 0, 1); PG8_STAGE(PG8_SB(0, 0), b2, voffB);
      PG8_BAR; PG8_WAIT_L(0); PG8_MMA(0, 1, At, B1); PG8_BAR;
      PG8_LDA(At, 0, 1); PG8_STAGE(PG8_SA(0, 0), a2, voffA);
      PG8_BAR; PG8_WAIT_L(0); PG8_MMA(1, 0, At, B0); PG8_BAR; PG8_SCHED;
      PG8_STAGE(PG8_SB(0, 1), b2 + hstep, voffB);
      PG8_WAIT_V(6); PG8_BAR; PG8_MMA(1, 1, At, B1); PG8_BAR;
      PG8_LDB(B0, 1, 0); PG8_SCHED; PG8_LDA(At, 1, 0); PG8_STAGE(PG8_SA(0, 1), a2 + hstep, voffA);
      PG8_WAIT_L(8); PG8_BAR; PG8_WAIT_L(0); PG8_MMA(0, 0, At, B0); PG8_BAR; PG8_SCHED;
      PG8_LDB(B1, 1, 1); PG8_STAGE(PG8_SB(1, 0), b3, voffB);
      PG8_BAR; PG8_WAIT_L(0); PG8_MMA(0, 1, At, B1); PG8_BAR;
      PG8_LDA(At, 1, 1); PG8_STAGE(PG8_SA(1, 0), a3, voffA);
      PG8_BAR; PG8_WAIT_L(0); PG8_MMA(1, 0, At, B0); PG8_BAR; PG8_SCHED;
      PG8_STAGE(PG8_SB(1, 1), b3 + hstep, voffB);
      PG8_WAIT_V(6); PG8_BAR; PG8_MMA(1, 1, At, B1); PG8_BAR;
    }
    E(acc, cur, wr, wc, fr, fq);
    if (!has_next) break;
#pragma unroll
    for (int a = 0; a < 2; ++a)
#pragma unroll
      for (int b = 0; b < 2; ++b)
#pragma unroll
        for (int m = 0; m < 4; ++m)
#pragma unroll
          for (int n = 0; n < 2; ++n) acc[a][b][m][n] = (f32x4){0.f, 0.f, 0.f, 0.f};
    cur = nxt; cA = nA; cB = nB; ++ui;
  }
  PG8_WAIT_V(0);
  if (wr == 0) PG8_BAR;
  PG8_BAR;
#undef PG8_SA
#undef PG8_SB
#undef PG8_STAGE
#undef PG8_LDA
#undef PG8_LDB
#undef PG8_MMA
#undef PG8_WAIT_V
#undef PG8_WAIT_L
#undef PG8_BAR
#undef PG8_SCHED
}
DEV unsigned cvt2(float lo, float hi) { unsigned r; asm volatile("v_cvt_pk_bf16_f32 %0, %1, %2" : "=v"(r) : "v"(lo), "v"(hi)); return r; }

struct EpiBf16 {
  static constexpr bool PERM = true;
  bf16* O; int ldc;
  DEV void operator()(const f32x4 (&acc)[2][2][4][2], const Unit& u, int wr, int wc, int fr, int fq) const {
    const int row0 = u.pm * BM + wr * 64 + fr, col0 = u.pn * BM + wc * 32 + 8 * fq;
#pragma unroll
    for (int ai = 0; ai < 2; ++ai)
#pragma unroll
      for (int m = 0; m < 4; ++m) {
        bf16* rowp = O + (size_t)(row0 + ai * HALF + m * 16) * ldc + col0;
#pragma unroll
        for (int bj = 0; bj < 2; ++bj) {
          const f32x4 v0 = acc[ai][bj][m][0], v1 = acc[ai][bj][m][1];
          u32x4_t w;
          w.x = cvt2(v0[0], v0[1]); w.y = cvt2(v0[2], v0[3]); w.z = cvt2(v1[0], v1[1]); w.w = cvt2(v1[2], v1[3]);
          *(u32x4_t*)(rowp + bj * HALF) = w;
        }
      }
  }
};
struct EpiResid {
  static constexpr bool PERM = false;
  const float* xin; float* out; const float* ga;
  DEV void operator()(const f32x4 (&acc)[2][2][4][2], const Unit& u, int wr, int wc, int fr, int fq) const {
    const int row0 = u.pm * BM + wr * 64 + fr, col0 = u.pn * BM + wc * 32 + 4 * fq;
    const int b = (u.pm * BM) / S;
    f32x4 gv[2][2];
#pragma unroll
    for (int bj = 0; bj < 2; ++bj)
#pragma unroll
      for (int n = 0; n < 2; ++n) gv[bj][n] = *(const f32x4*)(ga + b * 6144 + col0 + bj * HALF + n * 16);
#pragma unroll
    for (int ai = 0; ai < 2; ++ai)
#pragma unroll
      for (int m = 0; m < 4; ++m) {
        const size_t off = (size_t)(row0 + ai * HALF + m * 16) * 1024 + col0;
#pragma unroll
        for (int bj = 0; bj < 2; ++bj)
#pragma unroll
          for (int n = 0; n < 2; ++n) {
            const f32x4 xv = *(const f32x4*)(xin + off + bj * HALF + n * 16);
            *(f32x4*)(out + off + bj * HALF + n * 16) = xv + gv[bj][n] * acc[ai][bj][m][n];
          }
      }
  }
};
DEV float sig_(float x) { return 1.f / (1.f + __expf(-x)); }
template <bool SECOND>
struct EpiMerge {
  static constexpr bool PERM = true;
  bf16* Y; const bf16* proj; int gcol;
  DEV void operator()(const f32x4 (&acc)[2][2][4][2], const Unit& u, int wr, int wc, int fr, int fq) const {
    const int row0 = u.pm * BM + wr * 64 + fr, col0 = u.pn * BM + wc * 32 + 8 * fq;
#pragma unroll
    for (int ai = 0; ai < 2; ++ai)
#pragma unroll
      for (int m = 0; m < 4; ++m) {
        const size_t row = (size_t)(row0 + ai * HALF + m * 16);
#pragma unroll
        for (int bj = 0; bj < 2; ++bj) {
          const uint4 gq = *(const uint4*)(proj + row * PC + gcol + col0 + bj * HALF);
          float gf[8];
          unpack8(gq, gf);
          const f32x4 v0 = acc[ai][bj][m][0], v1 = acc[ai][bj][m][1];
          float o[8] = {sig_(gf[0]) * v0[0], sig_(gf[1]) * v0[1], sig_(gf[2]) * v0[2], sig_(gf[3]) * v0[3],
                        sig_(gf[4]) * v1[0], sig_(gf[5]) * v1[1], sig_(gf[6]) * v1[2], sig_(gf[7]) * v1[3]};
          bf16* yp = Y + row * 1024 + col0 + bj * HALF;
          if (SECOND) {
            float yf[8];
            unpack8(*(const uint4*)yp, yf);
#pragma unroll
            for (int j = 0; j < 8; ++j) o[j] += yf[j];
          }
          u32x4_t w;
          w.x = cvt2(o[0], o[1]); w.y = cvt2(o[2], o[3]); w.z = cvt2(o[4], o[5]); w.w = cvt2(o[6], o[7]);
          *(u32x4_t*)yp = w;
        }
      }
  }
};
struct EpiInproj {
  static constexpr bool PERM = true;
  char* ws;
  DEV void operator()(const f32x4 (&acc)[2][2][4][2], const Unit& u, int wr, int wc, int fr, int fq) const {
    const int b = (u.pm * BM) / S;
    const float* rope = (const float*)(ws + OFF_ROPE);
#pragma unroll
    for (int bj = 0; bj < 2; ++bj) {
      const int vcb = u.pn * BM + bj * HALF + wc * 32;
      if (vcb >= 4992) continue;
      const int vc0 = vcb & ~63, inh = vcb & 63;
      bf16* dbase; size_t dstride; bool roped = false; bool headmajor = false; int hh = 0, nh = 1;
      if (vc0 < 768) { dbase = (bf16*)(ws + OFF_PROJ) + vc0; dstride = PC; }
      else if (vc0 < 1280) {
        const int seg = (vc0 - 768) >> 7;
        const size_t off = (seg == 0) ? OFF_KSB : (seg == 1) ? OFF_VSB : (seg == 2) ? OFF_KWB : OFF_VWB;
        dbase = (bf16*)(ws + off); dstride = 64; headmajor = true; hh = ((vc0 - 768) >> 6) & 1; nh = 2;
        roped = (seg == 0) || (seg == 2);
      } else if (vc0 < 1792) { dbase = (bf16*)(ws + OFF_PROJ) + C_MQ + (vc0 - 1280); dstride = PC; roped = true; }
      else if (vc0 < 2816) {
        const int seg = (vc0 - 1792) >> 9;
        dbase = (bf16*)(ws + (seg ? OFF_MVB : OFF_MKB)); dstride = 64; headmajor = true; hh = ((vc0 - 1792) >> 6) & 7; nh = 8;
        roped = (seg == 0);
      } else if (vc0 < 4864) { dbase = (bf16*)(ws + OFF_PROJ) + C_GN + (vc0 - 2816); dstride = PC; }
      else { dbase = (bf16*)(ws + OFF_PROJ) + C_NG + (vc0 - 4864); dstride = PC; }
      const bool do_rope = roped && inh == 0;
#pragma unroll
      for (int ai = 0; ai < 2; ++ai)
#pragma unroll
        for (int m = 0; m < 4; ++m) {
          const int row = u.pm * BM + ai * HALF + wr * 64 + m * 16 + fr;
          const int t = row - b * S;
          const f32x4 v0 = acc[ai][bj][m][0], v1 = acc[ai][bj][m][1];
          float o[8] = {v0[0], v0[1], v0[2], v0[3], v1[0], v1[1], v1[2], v1[3]};
          if (do_rope) {
            float pv[8];
#pragma unroll
            for (int j = 0; j < 8; ++j) pv[j] = shx(o[j], 16);
            const f32x4 c0 = *(const f32x4*)(rope + (size_t)t * 16), c1 = *(const f32x4*)(rope + (size_t)t * 16 + 4);
            const f32x4 s0 = *(const f32x4*)(rope + (size_t)t * 16 + 8), s1 = *(const f32x4*)(rope + (size_t)t * 16 + 12);
            const float cs[8] = {c0[0], c0[1], c0[2], c0[3], c1[0], c1[1], c1[2], c1[3]};
            const float sn[8] = {s0[0], s0[1], s0[2], s0[3], s1[0], s1[1], s1[2], s1[3]};
            const float sg = (fq == 0) ? -1.f : 1.f;
#pragma unroll
            for (int j = 0; j < 8; ++j) o[j] = (fq < 2) ? (o[j] * cs[j] + sg * pv[j] * sn[j]) : o[j];
          }
          bf16* dp = headmajor ? (dbase + ((size_t)(b * nh + hh) * S + t) * 64 + inh + 8 * fq)
                               : (dbase + (size_t)row * dstride + inh + 8 * fq);
          u32x4_t w;
          w.x = cvt2(o[0], o[1]); w.y = cvt2(o[2], o[3]); w.z = cvt2(o[4], o[5]); w.w = cvt2(o[6], o[7]);
          *(u32x4_t*)dp = w;
        }
    }
  }
};
}

template <class F>
DEV void for_tiles_xcd(int MT, int NT, F f) {
  const int nb = vnb(), bid = vbid();
  if ((nb & 15) != 0) {
    for (int it = bid; it < MT * NT; it += nb) f(it / NT, it % NT);
    return;
  }
  const int xcd = (bid >> 1) & 7, slot = ((bid >> 4) << 1) | (bid & 1), nslot = nb >> 3;
  const int nj = (NT - xcd + 7) >> 3;
  for (int q = slot; q < MT * nj; q += nslot) f(q / nj, xcd + 8 * (q % nj));
}
constexpr int PH_PER_LAYER = 15;
enum { SP_NORM1 = 0, SP_INPROJ = 1, SP_COMPRESS = 2, SP_KMEAN = 3, SP_ATTN = 4, SP_MP0 = 5, SP_MM0 = 6, SP_MP1 = 7, SP_MM1 = 8,
       SP_MERGE = 9, SP_OUTPROJ = 10, SP_NORM2 = 11, SP_PEERQ = 12, SP_TOPK = 13, SP_EXPERT = 14 };
constexpr int N_REAL_PHASES = 1 + 2 * PH_PER_LAYER + 1;
constexpr int N_PHASES = N_REAL_PHASES + (PROBE_ANY ? 2 : 0);

DEV void run_phase(const Params& p, int ph, char* smem_raw, bool second_pass = false) {
#define SKIP_MOBA_SECOND (REP_NSA_ONLY && second_pass)
  LAS unsigned char* lds_all = (LAS unsigned char*)smem_raw;
  smem_raw += hidx() * SMEM_BYTES;
  float* smf = (float*)smem_raw;
  bf16* smh = (bf16*)smem_raw;
  const int nb = vnb(), bid = vbid();
  if (ph == 0) {
    for (int it = bid; it < PREP_ITEMS; it += nb) prep_item(p, it, smf);
    return;
  }
  if (ph == N_REAL_PHASES - 1) {
    for (int it = bid; it < T / 4; it += nb) final_norm_item(p.out, p.g_final, it);
    return;
  }
#if PROBE_ANY
  if (ph == N_REAL_PHASES) {
#if PROBE_PROJ
    {
      const bf16* Hh = (const bf16*)(p.ws + OFF_H);
      const bf16* Wt = (const bf16*)(p.ws + OFF_WINT) + (size_t)1 * WN * 1024;
      const float* rope = (const float*)(p.ws + OFF_ROPE);
      float sd = 0.f, sr = 0.f;
      for (size_t i = (size_t)bid * 256 + tidx(); i < (size_t)(T / 64) * 4888; i += (size_t)nb * 256) {
        const int ts = (int)(i / 4888), vc = (int)(i % 4888);
        const int tok = ts * 64 + (ts % 61);
        const int b = tok / S, t = tok % S;
        auto rawdot = [&](int col) {
          float a = 0.f;
          for (int k = 0; k < 1024; ++k) a += bf2f(Hh[(size_t)tok * 1024 + k]) * bf2f(Wt[(size_t)col * 1024 + k]);
          return a;
        };
        float v = rawdot(vc);
        bool roped = false;
        const bf16* dst;
        if (vc < 768) dst = (const bf16*)(p.ws + OFF_PROJ) + (size_t)tok * PC + vc;
        else if (vc < 1280) {
          const int seg = (vc - 768) >> 7, head = ((vc - 768) >> 6) & 1, d = vc & 63;
          const size_t off = (seg == 0) ? OFF_KSB : (seg == 1) ? OFF_VSB : (seg == 2) ? OFF_KWB : OFF_VWB;
          dst = (const bf16*)(p.ws + off) + ((size_t)(b * 2 + head) * S + t) * 64 + d;
          roped = (seg == 0 || seg == 2);
        } else if (vc < 1792) { dst = (const bf16*)(p.ws + OFF_PROJ) + (size_t)tok * PC + C_MQ + (vc - 1280); roped = true; }
        else if (vc < 2816) {
          const int seg = (vc - 1792) >> 9, head = ((vc - 1792) >> 6) & 7, d = vc & 63;
          dst = (const bf16*)(p.ws + (seg ? OFF_MVB : OFF_MKB)) + ((size_t)(b * 8 + head) * S + t) * 64 + d;
          roped = (seg == 0);
        } else if (vc < 4864) dst = (const bf16*)(p.ws + OFF_PROJ) + (size_t)tok * PC + C_GN + (vc - 2816);
        else dst = (const bf16*)(p.ws + OFF_PROJ) + (size_t)tok * PC + C_NG + (vc - 4864);
        const int d = vc & 63;
        if (roped && d < 16) {
          const float cs = rope[(size_t)t * 16 + (d & 7)], sn = rope[(size_t)t * 16 + 8 + (d & 7)];
          if (d < 8) { const float x2 = rawdot(vc + 8); v = v * cs - x2 * sn; }
          else { const float x1 = rawdot(vc - 8); v = v * cs + x1 * sn; }
        }
        const float got = bf2f(*dst);
        const bool is_r = roped && d < 16;
        if (PROBE_PROJ == 1 || (PROBE_PROJ == 2 && is_r) || (PROBE_PROJ == 3 && !is_r)) {
          sd += (got - v) * (got - v);
          sr += v * v;
        }
      }
      sd = wave_sum(sd); sr = wave_sum(sr);
      if ((tidx() & 63) == 0) {
        atomicAdd((float*)(p.ws + OFF_PROBE), sd);
        atomicAdd((float*)(p.ws + OFF_PROBE) + 1, sr);
      }
    }
#endif
#if PROBE_CMPR
    {
      float sd = 0.f, sr = 0.f;
      for (size_t i = (size_t)bid * 256 + tidx(); i < (size_t)2 * Bn * 1024 * 128; i += (size_t)nb * 256) {
        const size_t wh = i / ((size_t)Bn * 1024 * 128), r = i % ((size_t)Bn * 1024 * 128);
        const int c = (int)((r / 128) % 1024);
        if (c < 1023) {
          const float a = ((const float*)(p.ws + (wh ? OFF_VCC : OFF_KCC)))[r];
          const float y = ((const float*)(p.ws + OFF_CMP))[i];
          sd += (a - y) * (a - y);
          sr += y * y;
        }
      }
      sd = wave_sum(sd); sr = wave_sum(sr);
      if ((tidx() & 63) == 0) {
        atomicAdd((float*)(p.ws + OFF_PROBE), sd);
        atomicAdd((float*)(p.ws + OFF_PROBE) + 1, sr);
      }
    }
#endif
#if PROBE_MOBA
    probe_accum_bf16(p, (const bf16*)(p.ws + OFF_OMOBA), (const bf16*)(p.ws + OFF_CMP), (size_t)S * 512, smf);
#endif
#if PROBE_NSA == 8
    {
      const float* impn = (const float*)(p.ws + OFF_OMOBA);
      const float* impm = impn + (size_t)S * 256;
      const int* seld = (const int*)(p.ws + OFF_CMP);
      float sd = 0.f, sr = 0.f, bad = 0.f;
      for (int t = bid * 256 + tidx(); t < S; t += nb * 256) {
        const int cur = t >> 6;
        for (int n = 0; n < 256; ++n) {
          float a = impm[(size_t)t * 256 + n], r = impn[(size_t)t * 256 + n];
          sd += (a - r) * (a - r);
          sr += r * r;
        }
        unsigned want[8] = {0, 0, 0, 0, 0, 0, 0, 0}, got[8] = {0, 0, 0, 0, 0, 0, 0, 0};
        for (int j = 0; j < 16; ++j) {
          int v = seld[(size_t)t * 16 + j];
          if (v >= 0 && v < 256) {
            for (int w = 0; w < 8; ++w) if ((v >> 5) == w) got[w] |= 1u << (v & 31);
          }
        }
        if (cur < 16) {
          for (int n = 0; n <= cur; ++n) want[0] |= 1u << n;
        } else {
          want[0] |= 1u;
          for (int w = 0; w < 8; ++w) {
            if (((cur - 1) >> 5) == w) want[w] |= 1u << ((cur - 1) & 31);
            if ((cur >> 5) == w) want[w] |= 1u << (cur & 31);
          }
          for (int j = 0; j < 13; ++j) {
            float best = -1.f;
            int bi = 1;
            for (int n = 1; n <= cur - 2; ++n) {
              bool taken = false;
              for (int w = 0; w < 8; ++w) if ((n >> 5) == w) taken = (want[w] >> (n & 31)) & 1u;
              float v = impm[(size_t)t * 256 + n];
              if (!taken && v > best) { best = v; bi = n; }
            }
            for (int w = 0; w < 8; ++w) if ((bi >> 5) == w) want[w] |= 1u << (bi & 31);
          }
        }
        bool same = true;
        for (int w = 0; w < 8; ++w) same = same && (want[w] == got[w]);
        if (!same) bad += 1.f;
      }
      sd = wave_sum(sd); sr = wave_sum(sr); bad = wave_sum(bad);
      if ((tidx() & 63) == 0) {
        atomicAdd((float*)(p.ws + OFF_PROBE), sd);
        atomicAdd((float*)(p.ws + OFF_PROBE) + 1, sr);
        atomicAdd((float*)(p.ws + OFF_PROBE) + 2, bad);
      }
    }
#elif PROBE_NSA
    probe_accum_bf16(p, (const bf16*)(p.ws + OFF_ONSA), (const bf16*)(p.ws + OFF_CMP), (size_t)S * 512, smf);
#endif
    return;
  }
  if (ph == N_REAL_PHASES + 1) {
    probe_apply(p);
    return;
  }
#endif
  const int layer = (ph - 1) / PH_PER_LAYER, sub = (ph - 1) % PH_PER_LAYER;
  const float* mod = (const float*)(p.ws + OFF_MOD) + (size_t)layer * 2 * 6144;
  const float* xin = (layer == 0) ? p.x : p.out;
  bf16* H = (bf16*)(p.ws + OFF_H);
  bf16* PROJ = (bf16*)(p.ws + OFF_PROJ);
#if PROBE_ANY
  if (sub >= SP_MERGE) {
    if (sub == SP_OUTPROJ && layer == 0)
      for (size_t i = (size_t)bid * 256 + tidx(); i < (size_t)T * 1024; i += (size_t)nb * 256) p.out[i] = p.x[i];
    return;
  }
#endif
  switch (sub) {
    case SP_NORM1:
      for (int it = bid; it < T / 4; it += nb)
        norm_item(xin, p.g_attn + layer * 1024, mod + 1024, mod + 0, H, it);
      break;
    case SP_INPROJ: {
      g8::StaticOrder so;
      so.init(T, WN, (int)gridDim.x, (int)blockIdx.x);
      g8::gemm_phase(lds_all, g8::Gemm{H, (const bf16*)(p.ws + OFF_WINT) + (size_t)layer * WN * 1024, T, WN, 1024}, so, g8::EpiInproj{p.ws});
    } break;
    case SP_COMPRESS:
      for (int it = bid; it < 512 + 1024; it += nb) {
        if (it < 512) compress_mfma_item(p, layer, it, smem_raw);
        else kmean_item(p, it - 512, smf);
      }
#if PROBE_CMPR
      if (layer == 1)
        for (int it = bid; it < 1024; it += nb) compress_item(p, layer, it, smf);
#endif
      break;
    case SP_KMEAN:
#if PROBE_NSA
      if (layer == 1)
        for (int it = bid; it < 512; it += nb) n1_item(p, layer, it, smf);
#endif
      break;
    case SP_ATTN:
      {
        constexpr int MNI = 2;
        constexpr int NMOBA = 16 * (S / (64 * MNI));
        constexpr int NNI = 2;
        constexpr int NNSA = 4 * (S / (16 * NNI));
        const bool do_nsa = !PROBE_ANY || PROBE_NSA, do_moba = (!PROBE_ANY || PROBE_MOBA) && PROBE_NSA != 8;
        {
          constexpr int NCH = S / (16 * NNI);
          const bool affine = nb >= 8;
          const int grp = bid & 7, bk = grp & 3, sub = grp >> 2;
          const int i0 = affine ? (bid >> 3) : bid;
          const int istride = affine ? ((nb - grp + 7) >> 3) : nb;
          const int icount = affine ? (NCH / 2) : NNSA;
          if (do_nsa)
            for (int i = i0; i < icount; i += istride)
              nsa_item<NNI>(p, affine ? (((2 * i + sub) << 2) | bk) : i, smem_raw, (bf16*)(p.ws + OFF_ONSA));
          if (do_moba && !SKIP_MOBA_SECOND)
            for (int it = bid; it < NMOBA; it += nb) moba_gate_item<MNI>(p, it);
        }
#if PROBE_NSA && PROBE_NSA != 8
        if (layer == 1)
          for (int it = bid; it < 512; it += nb) n23_item(p, layer, it);
#endif
#if PROBE_MOBA
        if (layer == 1) {
          for (int it = bid; it < 512; it += nb) moba_item(p, layer, it);
        }
#endif
      }
      break;
    case SP_MP0:
    case SP_MP1:
      if ((!PROBE_ANY || PROBE_MOBA) && PROBE_NSA != 8)
        for (int it = bid; it < 8 * 63 * 8; it += nb) moba_part_item2<2>(p, sub == SP_MP1 ? 1 : 0, it, smem_raw);
      break;
    case SP_MM0:
    case SP_MM1:
      if ((!PROBE_ANY || PROBE_MOBA) && PROBE_NSA != 8)
        for (int it = bid; it < 8 * (S / 128); it += nb)
          moba_merge_item<2>(p, sub == SP_MM1 ? 1 : 0, it, smem_raw, (bf16*)(p.ws + OFF_OMOBA));
      break;
    case SP_MERGE:
      {
        g8::StaticOrder so;
        so.init(T, 1024, (int)gridDim.x, (int)blockIdx.x);
        g8::gemm_phase(lds_all, g8::Gemm{(const bf16*)(p.ws + OFF_ONSA), (const bf16*)(p.ws + OFF_WUPN) + (size_t)layer * 1024 * 512, T, 1024, 512}, so,
                       g8::EpiMerge<false>{H, PROJ, C_GN});
        g8::gemm_phase(lds_all, g8::Gemm{(const bf16*)(p.ws + OFF_OMOBA), (const bf16*)(p.ws + OFF_WUPM) + (size_t)layer * 1024 * 512, T, 1024, 512}, so,
                       g8::EpiMerge<true>{H, PROJ, C_GM});
      }
      break;
    case SP_OUTPROJ: {
      const bf16* W = (const bf16*)(p.ws + OFF_WOUT) + (size_t)layer * 1024 * 1024;
      const float* ga1 = mod + 2048;
      g8::StaticOrder so;
      so.init(T, 1024, (int)gridDim.x, (int)blockIdx.x);
      g8::gemm_phase(lds_all, g8::Gemm{H, W, T, 1024, 1024}, so, g8::EpiResid{xin, p.out, ga1});
    } break;
    case SP_NORM2:
      for (int it = bid; it < T / 4 + NEXP / 4; it += nb) {
        if (it < T / 4) norm_item(p.out, p.g_ffn + layer * 1024, mod + 4096, mod + 3072, H, it);
        else expert_cvt_item(p, layer, it - T / 4);
      }
      break;
    case SP_PEERQ: {
      const bf16* W = (const bf16*)(p.ws + OFF_WQ) + (size_t)layer * 2048 * 1024;
      bf16* QP = (bf16*)(p.ws + OFF_QP);
      g8::StaticOrder so;
      so.init(T, 2048, (int)gridDim.x, (int)blockIdx.x);
      g8::gemm_phase(lds_all, g8::Gemm{H, W, T, 2048, 1024}, so, g8::EpiBf16{QP, 2048});
    } break;
    case SP_TOPK:
#if REP_MASK
      for (int it = bid; it < T / 8; it += nb) peer_topk_item3(p, layer, it);
#endif
      break;
    case SP_EXPERT:
#if REP_MASK
      for (int it = bid; it < T / 4; it += nb) peer_expert_item2(p, layer, it, second_pass ? 0.f : 1.f);
#else
      for (int it = bid; it < T / 8; it += nb) peer_fused_item(p, layer, it, smem_raw);
#endif
      break;
  }
}

#define MEGA_LB __launch_bounds__(512, 2)
__global__ void MEGA_LB mega_kernel(Params p, int ph_lo, int ph_hi) {
  __shared__ __attribute__((aligned(16))) char smem_raw[2 * SMEM_BYTES + 16];
  volatile LAS unsigned* xbst = (volatile LAS unsigned*)(smem_raw + 2 * SMEM_BYTES);
  if (threadIdx.x == 0) { xbst[0] = 0u; xbst[1] = 0u; xbst[2] = 0u; xbst[3] = 0u; }
  __syncthreads();
  XcdBarrier xb = xcd_barrier_post((unsigned*)(p.ws + OFF_BAR), xbst);
  for (int ph = ph_lo; ph < ph_hi; ++ph) {
#if !PROBE_ANY && !REP_MASK
    if (ph == N_REAL_PHASES - 1 || ph == 1 + PH_PER_LAYER || (ph >= 1 && (ph - 1) % PH_PER_LAYER == SP_KMEAN) ||
        (ph >= 1 && (ph - 1) % PH_PER_LAYER == SP_TOPK))
      continue;
#endif
#if REP_MASK
    const int nrep = (ph >= 1 && ph < N_REAL_PHASES - 1 && ((REP_MASK >> ((ph - 1) % PH_PER_LAYER)) & 1)) ? 2 : 1;
    for (int rep = 0; rep < nrep; ++rep) {
      if (rep) xcd_barrier(xb);
      run_phase(p, ph, smem_raw, rep != 0);
    }
#else
    run_phase(p, ph, smem_raw);
#endif
    if (ph + 1 < ph_hi) {
      if (ph == ph_lo) cg::this_grid().sync();
      else xcd_barrier(xb);
    }
  }
}

extern "C" void kernel_launch(void* const* d_in, const int* in_sizes, int n_in, void* d_out, int out_size, void* d_ws,
                              size_t ws_size, hipStream_t stream) {
  if (ws_size < WS_TOTAL) {
    fprintf(stderr, "workspace too small: %zu < %zu\n", ws_size, (size_t)WS_NEED);
    return;
  }
  Params p{};
  p.x = (const float*)d_in[0]; p.c = (const float*)d_in[1]; p.w_ada = (const float*)d_in[2];
  p.b_ada = (const float*)d_in[3]; p.g_attn = (const float*)d_in[4]; p.g_ffn = (const float*)d_in[5];
  p.w_in = (const float*)d_in[6]; p.cmp_pe = (const float*)d_in[7]; p.cmp_w1 = (const float*)d_in[8];
  p.cmp_w2 = (const float*)d_in[9]; p.w_up_nsa = (const float*)d_in[10]; p.w_up_moba = (const float*)d_in[11];
  p.w_out = (const float*)d_in[12]; p.peer_wq = (const float*)d_in[13]; p.peer_k1 = (const float*)d_in[14];
  p.peer_k2 = (const float*)d_in[15]; p.peer_u = (const float*)d_in[16]; p.peer_v = (const float*)d_in[17];
  p.g_final = (const float*)d_in[18];
  p.out = (float*)d_out;
  p.ws = (char*)d_ws;
  static int grid_blocks = 0;
  if (!grid_blocks) {
    int dev = 0, cus = 0, per_cu = 0;
    hipGetDevice(&dev);
    hipDeviceGetAttribute(&cus, hipDeviceAttributeMultiprocessorCount, dev);
    hipOccupancyMaxActiveBlocksPerMultiprocessor(&per_cu, mega_kernel, 512, 0);
    if (per_cu < 1) per_cu = 1;
    if (per_cu > 1) per_cu = 1;
    grid_blocks = cus * per_cu;
  }
  hipMemsetAsync((char*)d_ws + OFF_BAR, 0, BAR_BYTES, stream);
  int ph_lo = 0, ph_hi = N_PHASES;
  void* args[] = {(void*)&p, (void*)&ph_lo, (void*)&ph_hi};
  hipError_t e = hipLaunchCooperativeKernel((const void*)mega_kernel, dim3(grid_blocks), dim3(512), args, 0, stream);
  if (e != hipSuccess) fprintf(stderr, "cooperative launch failed: %s (grid %d)\n", hipGetErrorString(e), grid_blocks);
}
```

```cpp
#include <hip/hip_runtime.h>
#include <hip/hip_bf16.h>
#include <hip/hip_cooperative_groups.h>
#include <cstdio>
#include <cstdint>
namespace cg = cooperative_groups;

#define DEV __device__ __forceinline__
typedef unsigned short bf16;
using bf16x8 = __attribute__((ext_vector_type(8))) short;
using f32x4 = __attribute__((ext_vector_type(4))) float;

constexpr int Bn = 2, S = 16384, T = Bn * S, D = 1024;
constexpr int PC = 3456;
constexpr int WN = 5120;
constexpr int C_NQ = 0, C_KC = 512, C_VC = 640, C_MQ = 768, C_GN = 1280, C_GM = 2304, C_NG = 3328;
constexpr int NEXP = 16384;

constexpr size_t al(size_t x) { return (x + 255) & ~size_t(255); }
constexpr size_t OFF_MOD = 0;
constexpr size_t OFF_ROPE = al(OFF_MOD + 2 * 2 * 6144 * 4);
constexpr size_t OFF_PEB = al(OFF_ROPE + (size_t)S * 16 * 4);
constexpr size_t OFF_WINT = al(OFF_PEB + 2 * 2 * 128 * 4);
constexpr size_t OFF_WUPN = al(OFF_WINT + 2ull * WN * 1024 * 2);
constexpr size_t OFF_WUPM = al(OFF_WUPN + 2ull * 1024 * 512 * 2);
constexpr size_t OFF_WOUT = al(OFF_WUPM + 2ull * 1024 * 512 * 2);
constexpr size_t OFF_WQ = al(OFF_WOUT + 2ull * 1024 * 1024 * 2);
constexpr size_t OFF_KCC = al(OFF_WQ + 2ull * 2048 * 1024 * 2);
constexpr size_t OFF_VCC = al(OFF_KCC + 2ull * 1024 * 128 * 4);
constexpr size_t OFF_SEL = al(OFF_VCC + 2ull * 1024 * 128 * 4);
constexpr size_t OFF_KMEAN = al(OFF_SEL + 2ull * 2 * S * 16 * 4);
constexpr size_t OFF_KMHL = al(OFF_KMEAN + 2ull * 8 * 64 * 64 * 4);
constexpr size_t OFF_KCB = al(OFF_KMHL + 2ull * 2 * 8 * 64 * 64 * 2);
constexpr size_t OFF_VCB = al(OFF_KCB + 2ull * 2 * 1024 * 64 * 2);
constexpr size_t OFF_PKB = al(OFF_VCB + 2ull * 2 * 1024 * 64 * 2);
constexpr size_t OFF_W1T = al(OFF_PKB + 2ull * 2 * 128 * 128 * 2);
constexpr size_t OFF_BAR = al(OFF_W1T + 4ull * 128 * 2048 * 2);
constexpr size_t BAR_BYTES = 3456 * 4;
constexpr size_t OFF_PROBE = al(OFF_BAR + BAR_BYTES);
constexpr size_t OFF_H = al(OFF_PROBE + 256);
constexpr size_t OFF_WCS = OFF_WINT + 2ull * WN * 1024;
constexpr size_t OFF_ONSA = al(OFF_H + (size_t)T * 1024 * 2);
constexpr size_t OFF_OMOBA = al(OFF_ONSA + (size_t)T * 512 * 2);
constexpr size_t OFF_H8 = OFF_ONSA;
constexpr size_t OFF_H8S = OFF_OMOBA;
constexpr size_t OFF_PROJ = al(OFF_OMOBA + (size_t)T * 512 * 2);
constexpr size_t KV2_BYTES = (size_t)Bn * 2 * S * 64 * 2, KV8_BYTES = (size_t)Bn * 8 * S * 64 * 2;
constexpr size_t OFF_KSB = al(OFF_PROJ + (size_t)T * PC * 2);
constexpr size_t OFF_VSB = OFF_KSB + KV2_BYTES;
constexpr size_t OFF_KWB = OFF_VSB + KV2_BYTES;
constexpr size_t OFF_VWB = OFF_KWB + KV2_BYTES;
constexpr size_t OFF_MKB = OFF_VWB + KV2_BYTES;
constexpr size_t OFF_MVB = OFF_MKB + KV8_BYTES;
constexpr int MLIST_PER_BH = 63 * S - 128 * 63 * 64;
constexpr size_t OFF_MLIST = OFF_MVB + KV8_BYTES;
constexpr size_t OFF_MCNT = al(OFF_MLIST + (size_t)Bn * 8 * MLIST_PER_BH * 2);
constexpr size_t WS_NEED = OFF_MCNT + (size_t)Bn * 8 * 64 * 4;
constexpr size_t PROJ_BYTES = (size_t)T * PC * 2;
constexpr size_t OFF_MPO = OFF_H;
constexpr size_t OFF_MPML = OFF_H + (size_t)8 * S * 3 * 64 * 2;
static_assert((size_t)8 * S * 3 * 64 * 2 + (size_t)8 * S * 3 * 8 <= (size_t)T * 1024 * 2, "moba partials must fit the H region");
constexpr size_t OFF_QP = OFF_PROJ;
constexpr size_t OFF_PEIDX = al(OFF_QP + (size_t)T * 2048 * 2);
constexpr size_t OFF_PEG = al(OFF_PEIDX + (size_t)T * 128 * 4);
constexpr size_t OFF_E8 = al(OFF_PEG + (size_t)T * 128 * 4);
constexpr size_t OFF_ESC = al(OFF_E8 + (size_t)NEXP * 2048);
static_assert(OFF_ESC + (size_t)NEXP * 2 * 4 <= OFF_PROJ + PROJ_BYTES, "peer alias overflow");
static_assert(WS_NEED <= 536870912ull, "workspace too big");
#ifndef PROBE_MOBA
#define PROBE_MOBA 0
#endif
constexpr size_t OFF_CMP = PROBE_MOBA ? OFF_ONSA : OFF_MLIST;
#ifndef REP_NSA_ONLY
#define REP_NSA_ONLY 0
#endif
#ifndef REP_NSA_PART
#define REP_NSA_PART 0
#endif
#ifndef REP_MASK
#define REP_MASK 0
#endif
#ifndef PROBE_MOBA
#define PROBE_MOBA 0
#endif
#ifndef PROBE_NSA
#define PROBE_NSA 0
#endif
#ifndef PROBE_CMPR
#define PROBE_CMPR 0
#endif
#ifndef PROBE_PROJ
#define PROBE_PROJ 0
#endif
#define PROBE_ANY (PROBE_MOBA || PROBE_NSA || PROBE_CMPR || PROBE_PROJ)
constexpr size_t WS_TOTAL = WS_NEED;
static_assert(WS_TOTAL <= 536870912ull, "workspace too big (probe)");

struct Params {
  const float *x, *c, *w_ada, *b_ada, *g_attn, *g_ffn, *w_in, *cmp_pe, *cmp_w1, *cmp_w2, *w_up_nsa, *w_up_moba, *w_out,
      *peer_wq, *peer_k1, *peer_k2, *peer_u, *peer_v, *g_final;
  float* out;
  char* ws;
};

constexpr int SMEM_BYTES = 74 * 1024;

DEV int tidx() {
  int t = threadIdx.x & 255;
  asm volatile("" : "+v"(t));
  return t;
}
DEV int hidx() { return __builtin_amdgcn_readfirstlane((int)(threadIdx.x >> 8)); }
DEV int vbid() { return (int)blockIdx.x * 2 + hidx(); }
DEV int vnb() { return (int)gridDim.x * 2; }
#define MFMA16B(a, b, c) __builtin_amdgcn_mfma_f32_16x16x32_bf16(a, b, c, 0, 0, 0)
DEV unsigned cvtpk_(float lo, float hi) {
  unsigned r;
  asm("v_cvt_pk_bf16_f32 %0, %1, %2" : "=v"(r) : "v"(lo), "v"(hi));
  return r;
}
DEV float bf2f(bf16 h) { return __uint_as_float(((unsigned)h) << 16); }
DEV bf16 f2bf(float f) {
  unsigned u = __float_as_uint(f);
  u += 0x7fffu + ((u >> 16) & 1u);
  return (bf16)(u >> 16);
}
DEV float gelu_tanh(float x) {
  float u = 0.7978845608028654f * (x + 0.044715f * x * x * x);
  return 0.5f * x * (1.f + tanhf(u));
}
DEV float sigmoidf_(float x) { return 1.f / (1.f + expf(-x)); }
DEV void unpack8(uint4 v, float* f) {
  f[0] = __uint_as_float(v.x << 16); f[1] = __uint_as_float(v.x & 0xffff0000u);
  f[2] = __uint_as_float(v.y << 16); f[3] = __uint_as_float(v.y & 0xffff0000u);
  f[4] = __uint_as_float(v.z << 16); f[5] = __uint_as_float(v.z & 0xffff0000u);
  f[6] = __uint_as_float(v.w << 16); f[7] = __uint_as_float(v.w & 0xffff0000u);
}
DEV float dot64_bf(const float* q, const bf16* row) {
  float s = 0.f;
#pragma unroll
  for (int i = 0; i < 8; ++i) {
    float f[8];
    unpack8(*(const uint4*)(row + i * 8), f);
#pragma unroll
    for (int j = 0; j < 8; ++j) s += q[i * 8 + j] * f[j];
  }
  return s;
}
DEV void axpy64_bf(float* o, float a, const bf16* row) {
#pragma unroll
  for (int i = 0; i < 8; ++i) {
    float f[8];
    unpack8(*(const uint4*)(row + i * 8), f);
#pragma unroll
    for (int j = 0; j < 8; ++j) o[i * 8 + j] += a * f[j];
  }
}
DEV float dot64_f(const float* q, const float* row) {
  float s = 0.f;
#pragma unroll
  for (int i = 0; i < 16; ++i) {
    float4 v = *(const float4*)(row + i * 4);
    s += q[i * 4] * v.x + q[i * 4 + 1] * v.y + q[i * 4 + 2] * v.z + q[i * 4 + 3] * v.w;
  }
  return s;
}
DEV void axpy64_f(float* o, float a, const float* row) {
#pragma unroll
  for (int i = 0; i < 16; ++i) {
    float4 v = *(const float4*)(row + i * 4);
    o[i * 4] += a * v.x; o[i * 4 + 1] += a * v.y; o[i * 4 + 2] += a * v.z; o[i * 4 + 3] += a * v.w;
  }
}
DEV void load_q64(float* q, const bf16* p, float scale) {
#pragma unroll
  for (int i = 0; i < 8; ++i) unpack8(*(const uint4*)(p + i * 8), q + i * 8);
#pragma unroll
  for (int i = 0; i < 64; ++i) q[i] *= scale;
}
DEV int lane_id_() { return __builtin_amdgcn_mbcnt_hi(~0u, __builtin_amdgcn_mbcnt_lo(~0u, 0u)); }
DEV int shx(int v, int m) {
  if (m == 1) return __builtin_amdgcn_update_dpp(0, v, 0xB1, 0xF, 0xF, true);
  if (m == 2) return __builtin_amdgcn_update_dpp(0, v, 0x4E, 0xF, 0xF, true);
  if (m == 4) return __builtin_amdgcn_ds_swizzle(v, 0x101F);
  if (m == 8) return __builtin_amdgcn_update_dpp(0, v, 0x128, 0xF, 0xF, true);
  if (m == 16) return __builtin_amdgcn_ds_swizzle(v, 0x401F);
  auto rr = __builtin_amdgcn_permlane32_swap((unsigned)v, (unsigned)v, false, false);
  return (lane_id_() < 32) ? (int)rr[1] : (int)rr[0];
}
DEV unsigned shx(unsigned v, int m) { return (unsigned)shx((int)v, m); }
DEV float shx(float v, int m) { return __int_as_float(shx(__float_as_int(v), m)); }
DEV float wave_sum(float v) {
#pragma unroll
  for (int o = 32; o >= 1; o >>= 1) v += shx(v, o);
  return v;
}

#define XB_TMO      128
#define XB_XCNT(j)  (256  + 64 * (j))
#define XB_XSUB(j)  (1280 + 64 * (j))
#define XB_XGEN(j)  (2304 + 64 * (j))
#define XB_TOP      3328
#define XB_TOPGEN   3392
#define XCD_BAR_WORDS 3456
#define XB_SPIN_CAP (1u << 18)
#define LAS __attribute__((address_space(3)))

__device__ __forceinline__ unsigned xb_ld(unsigned* p)              { return __hip_atomic_load(p, __ATOMIC_RELAXED, __HIP_MEMORY_SCOPE_AGENT); }
__device__ __forceinline__ unsigned xb_add(unsigned* p, unsigned v) { return __hip_atomic_fetch_add(p, v, __ATOMIC_RELAXED, __HIP_MEMORY_SCOPE_AGENT); }
__device__ __forceinline__ unsigned xb_xcc_id() { return (unsigned)__builtin_amdgcn_s_getreg((3 << 11) | 20) & 0xFu; }
#define XB_SPIN(cond, bar) do { unsigned _sp = 0; while (cond) { __builtin_amdgcn_s_sleep(1); \
    if ((++_sp & 255u) == 0u) { if (xb_ld(&(bar)[XB_TMO])) break; if (_sp > XB_SPIN_CAP) { atomicAdd(&(bar)[XB_TMO], 1u); break; } } } } while (0)

struct XcdBarrier {
    unsigned* bar; unsigned x;
    volatile LAS unsigned* st;
};

__device__ __forceinline__ XcdBarrier xcd_barrier_post(unsigned* bar, volatile LAS unsigned* st) {
    XcdBarrier b; b.bar = bar; b.x = xb_xcc_id(); b.st = st;
    if (threadIdx.x == 0) (void)xb_add(&bar[XB_XCNT(b.x)], 1u);
    return b;
}
__device__ __forceinline__ void xcd_barrier_complete(unsigned* bar, unsigned x, unsigned& nloc, unsigned& nx) {
    const unsigned G = gridDim.x * gridDim.y * gridDim.z;
    unsigned sum, cnt, mine, sp = 0u;
    for (;;) {
        sum = 0u; cnt = 0u; mine = 0u;
#pragma unroll
        for (unsigned j = 0; j < 16; ++j) { const unsigned c = xb_ld(&bar[XB_XCNT(j)]); sum += c; cnt += (c > 0u) ? 1u : 0u; mine = (j == x) ? c : mine; }
        if (sum == G) break;
        __builtin_amdgcn_s_sleep(1);
        if ((++sp & 255u) == 0u) { if (xb_ld(&bar[XB_TMO])) break; if (sp > XB_SPIN_CAP) { atomicAdd(&bar[XB_TMO], 1u); break; } }
    }
    nloc = mine > 0u ? mine : 1u; nx = cnt > 0u ? cnt : 1u;
}

__device__ __forceinline__ void xcd_barrier(const XcdBarrier& b) {
    asm volatile("s_waitcnt vmcnt(0)" ::: "memory");
    __syncthreads();
    if (threadIdx.x == 0) {
        unsigned* bar = b.bar;
        __builtin_amdgcn_s_waitcnt(0);
        unsigned nloc = b.st[0], nx = b.st[1];
        if (nloc == 0u) { xcd_barrier_complete(bar, b.x, nloc, nx); b.st[0] = nloc; b.st[1] = nx; }
        const unsigned old = xb_add(&bar[XB_XSUB(b.x)], 1u);
        const unsigned gen = old / nloc;
        if (old + 1u == (gen + 1u) * nloc) {
            __builtin_amdgcn_fence(__ATOMIC_RELEASE, "agent");
            asm volatile("s_waitcnt vmcnt(0)" ::: "memory");
            const unsigned og = xb_add(&bar[XB_TOP], 1u);
            const unsigned tg = og / nx;
            if (og + 1u == (tg + 1u) * nx) xb_add(&bar[XB_TOPGEN], 1u);
            else XB_SPIN(xb_ld(&bar[XB_TOPGEN]) == tg, bar);
            __builtin_amdgcn_fence(__ATOMIC_ACQUIRE, "agent");
            xb_add(&bar[XB_XGEN(b.x)], 1u);
            asm volatile("s_waitcnt vmcnt(0)" ::: "memory");
        } else {
            XB_SPIN(xb_ld(&bar[XB_XGEN(b.x)]) == gen, bar);
            __builtin_amdgcn_fence(__ATOMIC_ACQUIRE, "agent");
            asm volatile("s_waitcnt vmcnt(0)" ::: "memory");
        }
    }
    __syncthreads();
}


DEV int win_col_map(int j) {
  if (j < 1280) return j;
  if (j < 4864) return j + 24;
  if (j < 4888) return j - 4864 + 1280;
  return -1;
}
DEV void tr_tile(const float* __restrict__ src, int ldsrc, int K, bf16* __restrict__ dst, int kt, int nt, bool remap,
                 float* sm) {
  const int tid = tidx();
#pragma unroll 4
  for (int i = 0; i < 16; ++i) {
    int r = i * 4 + (tid >> 6), cx = tid & 63;
    int j = nt * 64 + cx, k = kt * 64 + r;
    int oc = remap ? win_col_map(j) : j;
    sm[r * 65 + cx] = (oc >= 0) ? src[(size_t)k * ldsrc + oc] : 0.f;
  }
  __syncthreads();
#pragma unroll 4
  for (int i = 0; i < 16; ++i) {
    int n = i * 4 + (tid >> 6), kk = tid & 63;
    dst[(size_t)(nt * 64 + n) * K + kt * 64 + kk] = f2bf(sm[kk * 65 + n]);
  }
  __syncthreads();
}

DEV unsigned e8m0_of(float amax) {
  const unsigned bits = (unsigned)__float_as_int(amax * (1.f / 224.f));
  unsigned e = ((bits >> 23) & 255u) + ((bits & 0x7fffffu) ? 1u : 0u);
  return e < 1u ? 1u : (e > 253u ? 253u : e);
}
DEV float e8m0_inv(unsigned e) { return __int_as_float((int)((254u - e) << 23)); }
DEV unsigned pack4_fp8_(float a, float b, float c, float d) {
  int q = __builtin_amdgcn_cvt_pk_fp8_f32(a, b, 0, false);
  q = __builtin_amdgcn_cvt_pk_fp8_f32(c, d, q, true);
  return (unsigned)q;
}
DEV void wamax_item(const Params& p, int item) {
  const int l = item >> 7, part = item & 127;
  const size_t per = (size_t)1024 * 4888 / 128;
  const float4* src = (const float4*)(p.w_in + (size_t)l * 1024 * 4888 + (size_t)part * per);
  float m = 0.f;
  for (int i = tidx(); i < (int)(per / 4); i += 256) {
    const float4 v = src[i];
    m = fmaxf(m, fmaxf(fmaxf(fabsf(v.x), fabsf(v.y)), fmaxf(fabsf(v.z), fabsf(v.w))));
  }
#pragma unroll
  for (int o = 32; o >= 1; o >>= 1) m = fmaxf(m, shx(m, o));
  if ((tidx() & 63) == 0) atomicMax((unsigned*)(p.ws + OFF_BAR) + l, (unsigned)__float_as_int(m));
}
DEV void wq8_item(const Params& p, int item, float* sm) {
  const int tid = tidx();
  const int l = item / (80 * 16), r_ = item % (80 * 16);
  const int nt = r_ / 16, kt = r_ % 16;
  const float* src = p.w_in + (size_t)l * 1024 * 4888;
  unsigned char* dst = (unsigned char*)(p.ws + OFF_WINT) + (size_t)l * WN * 1024;
  const unsigned e = e8m0_of(__int_as_float((int)__hip_atomic_load((const unsigned*)(p.ws + OFF_BAR) + l, __ATOMIC_RELAXED, __HIP_MEMORY_SCOPE_AGENT)));
  const float s = e8m0_inv(e);
#pragma unroll 4
  for (int i = 0; i < 16; ++i) {
    const int r = i * 4 + (tid >> 6), cx = tid & 63;
    const int oc = win_col_map(nt * 64 + cx);
    sm[r * 65 + cx] = (oc >= 0) ? src[(size_t)(kt * 64 + r) * 4888 + oc] : 0.f;
  }
  __syncthreads();
  const int kq = tid & 15;
#pragma unroll
  for (int i = 0; i < 4; ++i) {
    const int n = i * 16 + (tid >> 4);
    const float v0 = sm[(kq * 4 + 0) * 65 + n], v1 = sm[(kq * 4 + 1) * 65 + n], v2 = sm[(kq * 4 + 2) * 65 + n], v3 = sm[(kq * 4 + 3) * 65 + n];
    *(unsigned*)(dst + (size_t)(nt * 64 + n) * 1024 + kt * 64 + kq * 4) = pack4_fp8_(v0 * s, v1 * s, v2 * s, v3 * s);
  }
  if (kt == 0 && tid < 64) ((unsigned char*)(p.ws + OFF_WCS))[(size_t)l * WN + nt * 64 + tid] = (unsigned char)e;
  __syncthreads();
}
constexpr int WQ8_ITEMS = 2 * 80 * 16;
constexpr int PREP_TR_WIN = 2 * 128;
constexpr int PREP_TR_UPN = 2 * 16 * 8;
constexpr int PREP_TR_UPM = 2 * 16 * 8;
constexpr int PREP_TR_OUT = 2 * 16 * 16;
constexpr int PREP_TR_WQ = 2 * 32 * 16;
constexpr int PREP_ROPE = 512;
constexpr int PREP_MOD = 384;
constexpr int PREP_PEB = 16;
constexpr int PREP_PK = 32;
constexpr int PREP_TR_W1 = 4 * 2 * 32;
constexpr int PREP_ITEMS = PREP_TR_WIN + PREP_TR_UPN + PREP_TR_UPM + PREP_TR_OUT + PREP_TR_WQ + PREP_ROPE + PREP_MOD + PREP_PEB + PREP_PK + PREP_TR_W1;

DEV void prep_item(const Params& p, int item, float* sm) {
  const int tid = tidx();
  if (item < PREP_TR_WIN) {
    wamax_item(p, item);
    return;
  }
  item -= PREP_TR_WIN;
  if (item < PREP_TR_UPN) {
    int l = item / 128, r = item % 128;
    int nt = r / 8, kt = r % 8;
    tr_tile(p.w_up_nsa + (size_t)l * 512 * 1024, 1024, 512, (bf16*)(p.ws + OFF_WUPN) + (size_t)l * 1024 * 512, kt, nt, false, sm);
    return;
  }
  item -= PREP_TR_UPN;
  if (item < PREP_TR_UPM) {
    int l = item / 128, r = item % 128;
    int nt = r / 8, kt = r % 8;
    tr_tile(p.w_up_moba + (size_t)l * 512 * 1024, 1024, 512, (bf16*)(p.ws + OFF_WUPM) + (size_t)l * 1024 * 512, kt, nt, false, sm);
    return;
  }
  item -= PREP_TR_UPM;
  if (item < PREP_TR_OUT) {
    int l = item / 256, r = item % 256;
    int nt = r / 16, kt = r % 16;
    tr_tile(p.w_out + (size_t)l * 1024 * 1024, 1024, 1024, (bf16*)(p.ws + OFF_WOUT) + (size_t)l * 1024 * 1024, kt, nt, false, sm);
    return;
  }
  item -= PREP_TR_OUT;
  if (item < PREP_TR_WQ) {
    int l = item / 512, r = item % 512;
    int nt = r / 16, kt = r % 16;
    tr_tile(p.peer_wq + (size_t)l * 1024 * 2048, 2048, 1024, (bf16*)(p.ws + OFF_WQ) + (size_t)l * 2048 * 1024, kt, nt, false, sm);
    return;
  }
  item -= PREP_TR_WQ;
  if (item < PREP_ROPE) {
    int idx = item * 256 + tid;
    int pos = idx >> 3, i = idx & 7;
    float inv = powf(500000.0f, -(float)i / 8.0f);
    float ang = (float)pos * inv;
    float* rp = (float*)(p.ws + OFF_ROPE) + (size_t)pos * 16;
    rp[i] = cosf(ang);
    rp[8 + i] = sinf(ang);
    return;
  }
  item -= PREP_ROPE;
  if (item < PREP_MOD) {
    for (int i = tid; i < 2048; i += 256) {
      float cv = p.c[i];
      sm[i] = cv / (1.f + expf(-cv));
    }
    __syncthreads();
    const int l = item / 192, n0 = (item % 192) * 32;
    const int col = tid & 31, ks = tid >> 5;
    const float* w = p.w_ada + (size_t)l * 1024 * 6144 + n0 + col;
    float a0 = 0.f, a1 = 0.f;
#pragma unroll 8
    for (int k = ks * 128; k < ks * 128 + 128; ++k) {
      float wv = w[(size_t)k * 6144];
      a0 += sm[k] * wv;
      a1 += sm[1024 + k] * wv;
    }
    sm[2048 + tid * 2] = a0;
    sm[2048 + tid * 2 + 1] = a1;
    __syncthreads();
    if (tid < 64) {
      const int c2 = tid & 31, bs = tid >> 5;
      float s = 0.f;
#pragma unroll
      for (int q = 0; q < 8; ++q) s += sm[2048 + (q * 32 + c2) * 2 + bs];
      ((float*)(p.ws + OFF_MOD))[(l * 2 + bs) * 6144 + n0 + c2] = s + p.b_ada[l * 6144 + n0 + c2];
    }
    __syncthreads();
    return;
  }
  item -= PREP_MOD;
  if (item < PREP_PEB) {
    const int lw = item >> 2, j0 = (item & 3) * 32;
    const int col = tid & 31, ks = tid >> 5;
    const float* pe = p.cmp_pe + (size_t)lw * 2048;
    const float* w1 = p.cmp_w1 + (size_t)lw * 2048 * 128 + j0 + col;
    float a = 0.f;
#pragma unroll 8
    for (int i = ks * 256; i < ks * 256 + 256; ++i) a += pe[i] * w1[(size_t)i * 128];
    sm[tid] = a;
    __syncthreads();
    if (tid < 32) {
      float s = 0.f;
#pragma unroll
      for (int q = 0; q < 8; ++q) s += sm[q * 32 + tid];
      ((float*)(p.ws + OFF_PEB))[lw * 128 + j0 + tid] = s;
    }
    if (item == 0 && tid < 4) ((float*)(p.ws + OFF_PROBE))[tid] = 0.f;
    __syncthreads();
    return;
  }
  item -= PREP_PEB;
  if (item < PREP_PK) {
    const int e0 = item * 2048 + tid * 8;
    const int lt = e0 >> 14, off = e0 & 16383;
    const float* srcp = ((lt & 1) ? p.peer_k2 : p.peer_k1) + (size_t)(lt >> 1) * 16384 + off;
    const float4 a = *(const float4*)srcp, b4 = *(const float4*)(srcp + 4);
    uint4 pk;
    pk.x = (unsigned)f2bf(a.x) | ((unsigned)f2bf(a.y) << 16);
    pk.y = (unsigned)f2bf(a.z) | ((unsigned)f2bf(a.w) << 16);
    pk.z = (unsigned)f2bf(b4.x) | ((unsigned)f2bf(b4.y) << 16);
    pk.w = (unsigned)f2bf(b4.z) | ((unsigned)f2bf(b4.w) << 16);
    *(uint4*)((bf16*)(p.ws + OFF_PKB) + e0) = pk;
    return;
  }
  item -= PREP_PK;
  {
    const int lw = item >> 6, r = item & 63;
    const int nt = r >> 5, kt = r & 31;
    tr_tile(p.cmp_w1 + (size_t)lw * 2048 * 128, 128, 2048, (bf16*)(p.ws + OFF_W1T) + (size_t)lw * 128 * 2048, kt, nt, false, sm);
  }
}

DEV void norm_item(const float* __restrict__ xin, const float* __restrict__ g, const float* __restrict__ sc,
                   const float* __restrict__ sh, bf16* __restrict__ hout, int item) {
  const int lane = tidx() & 63, wave = tidx() >> 6;
  const size_t tok = (size_t)item * 4 + wave;
  const int b = (int)(tok / S);
  const float* xr = xin + tok * 1024;
  float4 v[4];
  float ss = 0.f;
#pragma unroll
  for (int i = 0; i < 4; ++i) {
    v[i] = *(const float4*)(xr + i * 256 + lane * 4);
    ss += v[i].x * v[i].x + v[i].y * v[i].y + v[i].z * v[i].z + v[i].w * v[i].w;
  }
  ss = wave_sum(ss);
  float r = 1.0f / sqrtf(ss * (1.0f / 1024.f) + 1e-6f);
#pragma unroll
  for (int i = 0; i < 4; ++i) {
    int d = i * 256 + lane * 4;
    float4 gg = *(const float4*)(g + d);
    float4 s4 = *(const float4*)(sc + b * 6144 + d);
    float4 h4 = *(const float4*)(sh + b * 6144 + d);
    float o0 = v[i].x * r * gg.x * (1.f + s4.x) + h4.x;
    float o1 = v[i].y * r * gg.y * (1.f + s4.y) + h4.y;
    float o2 = v[i].z * r * gg.z * (1.f + s4.z) + h4.z;
    float o3 = v[i].w * r * gg.w * (1.f + s4.w) + h4.w;
    uint2 pk;
    pk.x = (unsigned)f2bf(o0) | ((unsigned)f2bf(o1) << 16);
    pk.y = (unsigned)f2bf(o2) | ((unsigned)f2bf(o3) << 16);
    *(uint2*)(hout + tok * 1024 + d) = pk;
  }
}
DEV void norm8_item(const float* __restrict__ xin, const float* __restrict__ g, const float* __restrict__ sc,
                    const float* __restrict__ sh, unsigned char* __restrict__ hout, unsigned char* __restrict__ hscale, int item) {
  const int lane = tidx() & 63, wave = tidx() >> 6;
  const size_t tok = (size_t)item * 4 + wave;
  const int b = (int)(tok / S);
  const float* xr = xin + tok * 1024;
  float4 v[4];
  float ss = 0.f;
#pragma unroll
  for (int i = 0; i < 4; ++i) {
    v[i] = *(const float4*)(xr + i * 256 + lane * 4);
    ss += v[i].x * v[i].x + v[i].y * v[i].y + v[i].z * v[i].z + v[i].w * v[i].w;
  }
  ss = wave_sum(ss);
  float r = 1.0f / sqrtf(ss * (1.0f / 1024.f) + 1e-6f);
  float mx = 0.f;
#pragma unroll
  for (int i = 0; i < 4; ++i) {
    int d = i * 256 + lane * 4;
    float4 gg = *(const float4*)(g + d);
    float4 s4 = *(const float4*)(sc + b * 6144 + d);
    float4 h4 = *(const float4*)(sh + b * 6144 + d);
    v[i].x = v[i].x * r * gg.x * (1.f + s4.x) + h4.x;
    v[i].y = v[i].y * r * gg.y * (1.f + s4.y) + h4.y;
    v[i].z = v[i].z * r * gg.z * (1.f + s4.z) + h4.z;
    v[i].w = v[i].w * r * gg.w * (1.f + s4.w) + h4.w;
    mx = fmaxf(mx, fmaxf(fmaxf(fabsf(v[i].x), fabsf(v[i].y)), fmaxf(fabsf(v[i].z), fabsf(v[i].w))));
  }
#pragma unroll
  for (int o = 32; o >= 1; o >>= 1) mx = fmaxf(mx, shx(mx, o));
  const unsigned e = e8m0_of(mx);
  const float s = e8m0_inv(e);
#pragma unroll
  for (int i = 0; i < 4; ++i)
    *(unsigned*)(hout + tok * 1024 + i * 256 + lane * 4) = pack4_fp8_(v[i].x * s, v[i].y * s, v[i].z * s, v[i].w * s);
  if (lane == 0) hscale[tok] = (unsigned char)e;
}
DEV void final_norm_item(float* __restrict__ x, const float* __restrict__ g, int item) {
  const int lane = tidx() & 63, wave = tidx() >> 6;
  const size_t tok = (size_t)item * 4 + wave;
  float* xr = x + tok * 1024;
  float4 v[4];
  float ss = 0.f;
#pragma unroll
  for (int i = 0; i < 4; ++i) {
    v[i] = *(const float4*)(xr + i * 256 + lane * 4);
    ss += v[i].x * v[i].x + v[i].y * v[i].y + v[i].z * v[i].z + v[i].w * v[i].w;
  }
  ss = wave_sum(ss);
  float r = 1.0f / sqrtf(ss * (1.0f / 1024.f) + 1e-6f);
#pragma unroll
  for (int i = 0; i < 4; ++i) {
    int d = i * 256 + lane * 4;
    float4 gg = *(const float4*)(g + d);
    float4 o;
    o.x = v[i].x * r * gg.x; o.y = v[i].y * r * gg.y; o.z = v[i].z * r * gg.z; o.w = v[i].w * r * gg.w;
    *(float4*)(xr + d) = o;
  }
}

#define GM_BUF (2 * 128 * 72)
#define GM_LOAD(R, kk)                                                                                  \
  {                                                                                                     \
    const bf16* Ak = Ap + (kk);                                                                         \
    const bf16* Wk = Wp + (kk);                                                                         \
    R##a0 = *(const uint4*)(Ak); R##a1 = *(const uint4*)(Ak + a32); R##a2 = *(const uint4*)(Ak + 2 * a32); \
    R##a3 = *(const uint4*)(Ak + 3 * a32);                                                              \
    R##b0 = *(const uint4*)(Wk); R##b1 = *(const uint4*)(Wk + w32); R##b2 = *(const uint4*)(Wk + 2 * w32); \
    R##b3 = *(const uint4*)(Wk + 3 * w32);                                                              \
  }
#define GM_STORE(R, buf)                                                                                \
  {                                                                                                     \
    bf16* as_ = Asw + (buf) * GM_BUF;                                                                   \
    bf16* bs_ = as_ + 128 * 72;                                                                         \
    *(uint4*)(as_) = R##a0; *(uint4*)(as_ + 32 * 72) = R##a1; *(uint4*)(as_ + 64 * 72) = R##a2; *(uint4*)(as_ + 96 * 72) = R##a3; \
    *(uint4*)(bs_) = R##b0; *(uint4*)(bs_ + 32 * 72) = R##b1; *(uint4*)(bs_ + 64 * 72) = R##b2; *(uint4*)(bs_ + 96 * 72) = R##b3; \
  }
#define GM_COMPUTE(buf)                                                                                 \
  {                                                                                                     \
    const bf16* As_ = sm + (buf) * GM_BUF;                                                              \
    const bf16* Bs_ = As_ + 128 * 72;                                                                   \
    _Pragma("unroll") for (int ks = 0; ks < 2; ++ks) {                                                  \
      __builtin_amdgcn_sched_barrier(0);                                                                \
      bf16x8 af[4], bfr[4];                                                                             \
      _Pragma("unroll") for (int mi = 0; mi < 4; ++mi)                                                  \
        af[mi] = *(const bf16x8*)(As_ + (wr * 64 + mi * 16 + (lane & 15)) * 72 + ks * 32 + (lane >> 4) * 8); \
      _Pragma("unroll") for (int ni = 0; ni < 4; ++ni)                                                  \
        bfr[ni] = *(const bf16x8*)(Bs_ + (wc * 64 + ni * 16 + (lane & 15)) * 72 + ks * 32 + (lane >> 4) * 8); \
      _Pragma("unroll") for (int mi = 0; mi < 4; ++mi)                                                  \
        _Pragma("unroll") for (int ni = 0; ni < 4; ++ni)                                                \
          acc[mi][ni] = __builtin_amdgcn_mfma_f32_16x16x32_bf16(af[mi], bfr[ni], acc[mi][ni], 0, 0, 0); \
    }                                                                                                   \
    __builtin_amdgcn_sched_barrier(0);                                                                  \
  }
DEV void gemm_mainloop(const bf16* __restrict__ A, int lda, const bf16* __restrict__ W, int K, int m0, int n0, bf16* sm,
                       f32x4 (&acc)[4][4]) {
  const int tid = tidx(), lane = tid & 63, wave = tid >> 6;
  const int wr = wave >> 1, wc = wave & 1;
  const int lrow = tid >> 3, lkc = (tid & 7) * 8;
  const bf16* Ap = A + (size_t)(m0 + lrow) * lda + lkc;
  const bf16* Wp = W + (size_t)(n0 + lrow) * K + lkc;
  const int a32 = 32 * lda, w32 = 32 * K;
  bf16* Asw = sm + lrow * 72 + lkc;
  uint4 xa0, xa1, xa2, xa3, xb0, xb1, xb2, xb3, ya0, ya1, ya2, ya3, yb0, yb1, yb2, yb3;
  const int nk = K >> 6;
  GM_LOAD(x, 0)
  GM_LOAD(y, 64)
  __syncthreads();
  GM_STORE(x, 0)
  if (nk > 2) GM_LOAD(x, 128)
  __syncthreads();
  for (int k = 0; k < nk; k += 2) {
    GM_COMPUTE(0)
    GM_STORE(y, 1)
    if (k + 3 < nk) GM_LOAD(y, (k + 3) * 64)
    __syncthreads();
    GM_COMPUTE(1)
    if (k + 2 < nk) {
      GM_STORE(x, 0)
      if (k + 4 < nk) GM_LOAD(x, (k + 4) * 64)
    }
    __syncthreads();
  }
}
DEV void gemm256_mainloop(const bf16* __restrict__ A, int lda, const bf16* __restrict__ W, int K, int m0, int n0, bf16* sm,
                          f32x4 (&acc)[2][4][4]) {
  bf16* As = sm;
  bf16* Bs = sm + 256 * 72;
  const int tid = tidx(), lane = tid & 63, wave = tid >> 6;
  const int wr = wave >> 1, wc = wave & 1;
  const int lrow = tid >> 3, lkc = (tid & 7) * 8;
  const bf16* Ap = A + (size_t)(m0 + lrow) * lda + lkc;
  const bf16* Wp = W + (size_t)(n0 + lrow) * K + lkc;
  const int a32 = 32 * lda, w32 = 32 * K;
  uint4 ra0, ra1, ra2, ra3, ra4, ra5, ra6, ra7, rb0, rb1, rb2, rb3;
#define G256_LOAD(kk)                                                                                   \
  {                                                                                                     \
    const bf16* Ak = Ap + (kk);                                                                         \
    const bf16* Wk = Wp + (kk);                                                                         \
    ra0 = *(const uint4*)(Ak); ra1 = *(const uint4*)(Ak + a32); ra2 = *(const uint4*)(Ak + 2 * a32);    \
    ra3 = *(const uint4*)(Ak + 3 * a32); ra4 = *(const uint4*)(Ak + 4 * a32); ra5 = *(const uint4*)(Ak + 5 * a32); \
    ra6 = *(const uint4*)(Ak + 6 * a32); ra7 = *(const uint4*)(Ak + 7 * a32);                           \
    rb0 = *(const uint4*)(Wk); rb1 = *(const uint4*)(Wk + w32); rb2 = *(const uint4*)(Wk + 2 * w32);    \
    rb3 = *(const uint4*)(Wk + 3 * w32);                                                                \
  }
  G256_LOAD(0)
  bf16* Asw = As + lrow * 72 + lkc;
  bf16* Bsw = Bs + lrow * 72 + lkc;
  for (int k0 = 0; k0 < K; k0 += 64) {
    __syncthreads();
    *(uint4*)(Asw) = ra0; *(uint4*)(Asw + 32 * 72) = ra1; *(uint4*)(Asw + 64 * 72) = ra2; *(uint4*)(Asw + 96 * 72) = ra3;
    *(uint4*)(Asw + 128 * 72) = ra4; *(uint4*)(Asw + 160 * 72) = ra5; *(uint4*)(Asw + 192 * 72) = ra6; *(uint4*)(Asw + 224 * 72) = ra7;
    *(uint4*)(Bsw) = rb0; *(uint4*)(Bsw + 32 * 72) = rb1; *(uint4*)(Bsw + 64 * 72) = rb2; *(uint4*)(Bsw + 96 * 72) = rb3;
    __syncthreads();
    if (k0 + 64 < K) G256_LOAD(k0 + 64)
#pragma unroll
    for (int ks = 0; ks < 2; ++ks) {
      bf16x8 bfr[4];
#pragma unroll
      for (int ni = 0; ni < 4; ++ni)
        bfr[ni] = *(const bf16x8*)(Bs + (wc * 64 + ni * 16 + (lane & 15)) * 72 + ks * 32 + (lane >> 4) * 8);
#pragma unroll
      for (int h = 0; h < 2; ++h) {
        __builtin_amdgcn_sched_barrier(0);
        bf16x8 af[4];
#pragma unroll
        for (int mi = 0; mi < 4; ++mi)
          af[mi] = *(const bf16x8*)(As + (wr * 128 + h * 64 + mi * 16 + (lane & 15)) * 72 + ks * 32 + (lane >> 4) * 8);
#pragma unroll
        for (int mi = 0; mi < 4; ++mi)
#pragma unroll
          for (int ni = 0; ni < 4; ++ni)
            acc[h][mi][ni] = __builtin_amdgcn_mfma_f32_16x16x32_bf16(af[mi], bfr[ni], acc[h][mi][ni], 0, 0, 0);
      }
    }
  }
}
DEV void acc_zero(f32x4 (&acc)[4][4]) {
#pragma unroll
  for (int i = 0; i < 4; ++i)
#pragma unroll
    for (int j = 0; j < 4; ++j) acc[i][j] = f32x4{0.f, 0.f, 0.f, 0.f};
}
DEV void store_tile_bf16(bf16* sm, const f32x4 (&acc)[4][4], bf16* __restrict__ dbase, size_t dstride) {
  const int tid = tidx(), lane = tid & 63, wave = tid >> 6, g4 = lane >> 4, c16 = lane & 15;
  bf16* Cw = sm + wave * (64 * 72);
  __syncthreads();
#pragma unroll
  for (int mi = 0; mi < 4; ++mi)
#pragma unroll
    for (int ni = 0; ni < 4; ++ni)
#pragma unroll
      for (int r = 0; r < 4; ++r) Cw[(mi * 16 + g4 * 4 + r) * 72 + ni * 16 + c16] = f2bf(acc[mi][ni][r]);
  __syncthreads();
#pragma unroll
  for (int it = 0; it < 8; ++it) {
    const int row_l = it * 8 + (lane >> 3), ch = lane & 7;
    const uint4 v = *(const uint4*)(Cw + row_l * 72 + ch * 8);
    *(uint4*)(dbase + (size_t)row_l * dstride + ch * 8) = v;
  }
}
template <class Epi>
DEV void gemm_tile(const bf16* __restrict__ A, int lda, const bf16* __restrict__ W, int K, int m0, int n0, bf16* sm,
                   Epi epi) {
  f32x4 acc[4][4];
  acc_zero(acc);
  gemm_mainloop(A, lda, W, K, m0, n0, sm, acc);
  const int tid = tidx(), lane = tid & 63, wave = tid >> 6;
  const int wr = wave >> 1, wc = wave & 1;
#pragma unroll
  for (int mi = 0; mi < 4; ++mi)
#pragma unroll
    for (int ni = 0; ni < 4; ++ni)
#pragma unroll
      for (int r = 0; r < 4; ++r) {
        int row = m0 + wr * 64 + mi * 16 + (lane >> 4) * 4 + r;
        int col = n0 + wc * 64 + ni * 16 + (lane & 15);
        epi(row, col, acc[mi][ni][r]);
      }
}
DEV void inproj_epilogue(const Params& p, f32x4 (&acc)[4][4], int row0, int vc0, bf16* sm) {
  const int tid = tidx(), lane = tid & 63, g4 = lane >> 4, c16 = lane & 15;
  const int b = row0 / S, t0 = row0 % S;
  bf16* dbase;
  size_t dstride;
  bool roped = false;
  bf16* projp = (bf16*)(p.ws + OFF_PROJ) + (size_t)row0 * PC;
  if (vc0 < 768) { dbase = projp + vc0; dstride = PC; }
  else if (vc0 < 1280) {
    const int seg = (vc0 - 768) >> 7, head = ((vc0 - 768) >> 6) & 1;
    const size_t off = (seg == 0) ? OFF_KSB : (seg == 1) ? OFF_VSB : (seg == 2) ? OFF_KWB : OFF_VWB;
    dbase = (bf16*)(p.ws + off) + ((size_t)(b * 2 + head) * S + t0) * 64;
    dstride = 64;
    roped = (seg == 0) || (seg == 2);
  } else if (vc0 < 1792) { dbase = projp + C_MQ + (vc0 - 1280); dstride = PC; roped = true; }
  else if (vc0 < 2816) {
    const int seg = (vc0 - 1792) >> 9, head = ((vc0 - 1792) >> 6) & 7;
    dbase = (bf16*)(p.ws + (seg ? OFF_MVB : OFF_MKB)) + ((size_t)(b * 8 + head) * S + t0) * 64;
    dstride = 64;
    roped = (seg == 0);
  } else if (vc0 < 4864) { dbase = projp + C_GN + (vc0 - 2816); dstride = PC; }
  else { dbase = projp + C_NG + (vc0 - 4864); dstride = PC; }
  if (roped) {
    const float* rope = (const float*)(p.ws + OFF_ROPE);
#pragma unroll
    for (int mi = 0; mi < 4; ++mi)
#pragma unroll
      for (int r = 0; r < 4; ++r) {
        const int pos = t0 + mi * 16 + g4 * 4 + r;
        const float v = acc[mi][0][r];
        const float pv = shx(v, 8);
        const float cs = rope[pos * 16 + (c16 & 7)], sn = rope[pos * 16 + 8 + (c16 & 7)];
        acc[mi][0][r] = (c16 < 8) ? (v * cs - pv * sn) : (v * cs + pv * sn);
      }
  }
  store_tile_bf16(sm, acc, dbase, dstride);
}
DEV void inproj_tile256(const Params& p, int layer, int m0, int n0, bf16* sm) {
  f32x4 acc[2][4][4];
  acc_zero(acc[0]);
  acc_zero(acc[1]);
  gemm256_mainloop((const bf16*)(p.ws + OFF_H), 1024, (const bf16*)(p.ws + OFF_WINT) + (size_t)layer * WN * 1024, 1024, m0, n0, sm, acc);
  const int wave = tidx() >> 6, wr = wave >> 1, wc = wave & 1;
  inproj_epilogue(p, acc[0], m0 + wr * 128, n0 + wc * 64, sm);
  inproj_epilogue(p, acc[1], m0 + wr * 128 + 64, n0 + wc * 64, sm);
}
typedef unsigned u32x2_t __attribute__((ext_vector_type(2)));
DEV void merge_tile(const Params& p, int layer, int m0, int n0, bf16* sm) {
  const int tid = tidx(), lane = tid & 63, wave = tid >> 6, g4 = lane >> 4, c16 = lane & 15;
  const int wr = wave >> 1, wc = wave & 1;
  const bf16* projg = (const bf16*)(p.ws + OFF_PROJ) + (size_t)(m0 + wr * 64 + g4 * 4) * PC + n0 + wc * 64 + c16;
  f32x4 acc[4][4];
  acc_zero(acc);
  gemm_mainloop((const bf16*)(p.ws + OFF_ONSA), 512, (const bf16*)(p.ws + OFF_WUPN) + (size_t)layer * 1024 * 512, 512, m0, n0, sm, acc);
  bf16* yg = (bf16*)(p.ws + OFF_H) + (size_t)(m0 + wr * 64 + g4 * 4) * 1024 + n0 + wc * 64 + c16;
#pragma unroll
  for (int mi = 0; mi < 4; ++mi)
#pragma unroll
    for (int ni = 0; ni < 4; ++ni)
#pragma unroll
      for (int r = 0; r < 4; ++r)
        yg[(size_t)(mi * 16 + r) * 1024 + ni * 16] =
            f2bf(sigmoidf_(bf2f(projg[(size_t)(mi * 16 + r) * PC + C_GN + ni * 16])) * acc[mi][ni][r]);
  acc_zero(acc);
  gemm_mainloop((const bf16*)(p.ws + OFF_OMOBA), 512, (const bf16*)(p.ws + OFF_WUPM) + (size_t)layer * 1024 * 512, 512, m0, n0, sm, acc);
#pragma unroll
  for (int mi = 0; mi < 4; ++mi)
#pragma unroll
    for (int ni = 0; ni < 4; ++ni)
#pragma unroll
      for (int r = 0; r < 4; ++r)
        acc[mi][ni][r] = bf2f(yg[(size_t)(mi * 16 + r) * 1024 + ni * 16]) +
                         sigmoidf_(bf2f(projg[(size_t)(mi * 16 + r) * PC + C_GM + ni * 16])) * acc[mi][ni][r];
  store_tile_bf16(sm, acc, (bf16*)(p.ws + OFF_H) + (size_t)(m0 + wr * 64) * 1024 + n0 + wc * 64, 1024);
}

DEV void merge_tile256(const Params& p, int layer, int m0, int n0, bf16* sm) {
  const int tid = tidx(), lane = tid & 63, wave = tid >> 6, g4 = lane >> 4, c16 = lane & 15;
  const int wr = wave >> 1, wc = wave & 1;
  f32x4 acc[2][4][4];
  acc_zero(acc[0]);
  acc_zero(acc[1]);
  gemm256_mainloop((const bf16*)(p.ws + OFF_ONSA), 512, (const bf16*)(p.ws + OFF_WUPN) + (size_t)layer * 1024 * 512, 512, m0, n0, sm, acc);
#pragma unroll
  for (int h = 0; h < 2; ++h) {
    const size_t rb = (size_t)(m0 + wr * 128 + h * 64 + g4 * 4);
    const bf16* projg = (const bf16*)(p.ws + OFF_PROJ) + rb * PC + n0 + wc * 64 + c16;
    bf16* yg = (bf16*)(p.ws + OFF_H) + rb * 1024 + n0 + wc * 64 + c16;
#pragma unroll
    for (int mi = 0; mi < 4; ++mi)
#pragma unroll
      for (int ni = 0; ni < 4; ++ni)
#pragma unroll
        for (int r = 0; r < 4; ++r)
          yg[(size_t)(mi * 16 + r) * 1024 + ni * 16] =
              f2bf(sigmoidf_(bf2f(projg[(size_t)(mi * 16 + r) * PC + C_GN + ni * 16])) * acc[h][mi][ni][r]);
  }
  acc_zero(acc[0]);
  acc_zero(acc[1]);
  gemm256_mainloop((const bf16*)(p.ws + OFF_OMOBA), 512, (const bf16*)(p.ws + OFF_WUPM) + (size_t)layer * 1024 * 512, 512, m0, n0, sm, acc);
#pragma unroll
  for (int h = 0; h < 2; ++h) {
    const size_t rb = (size_t)(m0 + wr * 128 + h * 64 + g4 * 4);
    const bf16* projg = (const bf16*)(p.ws + OFF_PROJ) + rb * PC + n0 + wc * 64 + c16;
    const bf16* yg = (const bf16*)(p.ws + OFF_H) + rb * 1024 + n0 + wc * 64 + c16;
#pragma unroll
    for (int mi = 0; mi < 4; ++mi)
#pragma unroll
      for (int ni = 0; ni < 4; ++ni)
#pragma unroll
        for (int r = 0; r < 4; ++r)
          acc[h][mi][ni][r] = bf2f(yg[(size_t)(mi * 16 + r) * 1024 + ni * 16]) +
                              sigmoidf_(bf2f(projg[(size_t)(mi * 16 + r) * PC + C_GM + ni * 16])) * acc[h][mi][ni][r];
    store_tile_bf16(sm, acc[h], (bf16*)(p.ws + OFF_H) + (size_t)(m0 + wr * 128 + h * 64) * 1024 + n0 + wc * 64, 1024);
  }
}

DEV void compress_item(const Params& p, int layer, int item, float* sm) {
  const int tid = tidx();
  const int grp = item & 127, which = (item >> 7) & 1, kvh = (item >> 8) & 1, b = item >> 9;
  const int c0 = grp * 8;
  float* xs = sm;
  float* hs = sm + 144 * 64;
  const bf16* proj = (const bf16*)(p.ws + OFF_PROJ);
  const int col = (which ? C_VC : C_KC) + kvh * 64;
  for (int i = tid; i < 144 * 64; i += 256) {
    int tl = i >> 6, d = i & 63;
    int t = c0 * 16 + tl;
    xs[i] = (t < S) ? bf2f(proj[((size_t)b * S + t) * PC + col + d]) : 0.f;
  }
  __syncthreads();
  const int lw = layer * 2 + which;
  if (tid < 128) {
    const float* w1 = p.cmp_w1 + (size_t)lw * 2048 * 128 + tid;
    float acc[8];
#pragma unroll
    for (int ci = 0; ci < 8; ++ci) acc[ci] = 0.f;
    for (int l = 0; l < 32; ++l) {
#pragma unroll 4
      for (int d = 0; d < 64; ++d) {
        float w = w1[(size_t)(l * 64 + d) * 128];
#pragma unroll
        for (int ci = 0; ci < 8; ++ci) acc[ci] += xs[(ci * 16 + l) * 64 + d] * w;
      }
    }
    float pb = ((const float*)(p.ws + OFF_PEB))[lw * 128 + tid];
#pragma unroll
    for (int ci = 0; ci < 8; ++ci) hs[ci * 128 + tid] = gelu_tanh(acc[ci] + pb);
  }
  __syncthreads();
  const float* w2 = p.cmp_w2 + (size_t)lw * 128 * 64;
  float* outp = PROBE_CMPR ? ((float*)(p.ws + OFF_CMP) + (which ? (size_t)Bn * 1024 * 128 : 0)) : (float*)(p.ws + (which ? OFF_VCC : OFF_KCC));
#pragma unroll
  for (int rr = 0; rr < 2; ++rr) {
    int o = rr * 256 + tid;
    int ci = o >> 6, d = o & 63;
    int c = c0 + ci;
    float a = 0.f;
    for (int j = 0; j < 128; ++j) a += hs[ci * 128 + j] * w2[j * 64 + d];
    if (c < 1023) outp[(((size_t)b * 1024 + c) * 2 + kvh) * 64 + d] = a;
    bf16* outb = (bf16*)(p.ws + (which ? OFF_VCB : OFF_KCB));
    if (!PROBE_CMPR && c < 1024) outb[(((size_t)b * 2 + kvh) * 1024 + c) * 64 + d] = (c < 1023) ? f2bf(a) : (bf16)0;
  }
  __syncthreads();
}

DEV void compress_mfma_item(const Params& p, int layer, int item, char* smem) {
  bf16* xs = (bf16*)smem;
  float* hs = (float*)(smem + 272 * 64 * 2);
  const int tid = tidx(), lane = tid & 63, wave = tid >> 6, g4 = lane >> 4, c16 = lane & 15;
  const int cblk = item & 63, which = (item >> 6) & 1, kvh = (item >> 7) & 1, b = item >> 8;
  const int t0 = cblk * 256;
  const bf16* proj = (const bf16*)(p.ws + OFF_PROJ) + (size_t)b * S * PC + (which ? C_VC : C_KC) + kvh * 64;
  __syncthreads();
  for (int i = tid; i < 272 * 8; i += 256) {
    const int tl = i >> 3, ch = i & 7;
    const int t = t0 + tl;
    uint4 v = uint4{0u, 0u, 0u, 0u};
    if (t < S) v = *(const uint4*)(proj + (size_t)t * PC + ch * 8);
    *(uint4*)(xs + tl * 64 + ((ch ^ ((tl >> 4) & 7)) * 8)) = v;
  }
  __syncthreads();
  const int lw = layer * 2 + which;
  const bf16* w1t = (const bf16*)(p.ws + OFF_W1T) + (size_t)lw * 128 * 2048;
  f32x4 acc0 = f32x4{0.f, 0.f, 0.f, 0.f}, acc1 = f32x4{0.f, 0.f, 0.f, 0.f};
  const bf16* wb0 = w1t + (size_t)((2 * wave) * 16 + c16) * 2048 + g4 * 8;
  const bf16* wb1 = w1t + (size_t)((2 * wave + 1) * 16 + c16) * 2048 + g4 * 8;
#pragma unroll 4
  for (int ks = 0; ks < 64; ++ks) {
    const int l = ks >> 1, ch = (ks & 1) * 4 + g4;
    const int tl = 16 * c16 + l;
    const bf16x8 af = *(const bf16x8*)(xs + tl * 64 + ((ch ^ ((tl >> 4) & 7)) * 8));
    const bf16x8 b0 = *(const bf16x8*)(wb0 + ks * 32);
    const bf16x8 b1 = *(const bf16x8*)(wb1 + ks * 32);
    acc0 = MFMA16B(af, b0, acc0);
    acc1 = MFMA16B(af, b1, acc1);
  }
  {
    const float* peb = (const float*)(p.ws + OFF_PEB) + lw * 128;
    const int j0 = (2 * wave) * 16 + c16, j1 = j0 + 16;
    const float pb0 = peb[j0], pb1 = peb[j1];
#pragma unroll
    for (int r = 0; r < 4; ++r) {
      hs[(g4 * 4 + r) * 128 + j0] = gelu_tanh(acc0[r] + pb0);
      hs[(g4 * 4 + r) * 128 + j1] = gelu_tanh(acc1[r] + pb1);
    }
  }
  __syncthreads();
  const float* w2 = p.cmp_w2 + (size_t)lw * 128 * 64;
  const int d = tid & 63, cq = tid >> 6;
  float o0 = 0.f, o1 = 0.f, o2 = 0.f, o3 = 0.f;
#pragma unroll 8
  for (int j = 0; j < 128; ++j) {
    const float w = w2[j * 64 + d];
    o0 += hs[(cq * 4 + 0) * 128 + j] * w;
    o1 += hs[(cq * 4 + 1) * 128 + j] * w;
    o2 += hs[(cq * 4 + 2) * 128 + j] * w;
    o3 += hs[(cq * 4 + 3) * 128 + j] * w;
  }
  float* outp = (float*)(p.ws + (which ? OFF_VCC : OFF_KCC));
  bf16* outb = (bf16*)(p.ws + (which ? OFF_VCB : OFF_KCB));
  const float ov[4] = {o0, o1, o2, o3};
#pragma unroll
  for (int i = 0; i < 4; ++i) {
    const int c = cblk * 16 + cq * 4 + i;
    if (c < 1023) outp[(((size_t)b * 1024 + c) * 2 + kvh) * 64 + d] = ov[i];
    outb[(((size_t)b * 2 + kvh) * 1024 + c) * 64 + d] = (c < 1023) ? f2bf(ov[i]) : (bf16)0;
  }
  __syncthreads();
}

DEV void n1_item(const Params& p, int layer, int item, float* sm) {
  const int chunk = item & 255, kvh = (item >> 8) & 1, b = item >> 9;
  const int tid = tidx(), ql = tid >> 2, g = tid & 3;
  const int t = chunk * 64 + ql, h = kvh * 4 + g;
  const size_t tok = (size_t)b * S + t;
  const bf16* proj = (const bf16*)(p.ws + OFF_PROJ);
  float* imp = sm;
  for (int i = tid; i < 64 * 257; i += 256) imp[i] = 0.f;
  float q[64];
  load_q64(q, proj + tok * PC + C_NQ + h * 64, 0.125f);
  const int nv = (t >= 31) ? (((t - 31) >> 4) + 1) : 0;
  const int nv_max = (((chunk * 64 + 63) - 31) >> 4) + 1;
  const float* kc = (const float*)(p.ws + OFF_KCC) + (size_t)b * 1024 * 128 + kvh * 64;
  const float* vc = (const float*)(p.ws + OFF_VCC) + (size_t)b * 1024 * 128 + kvh * 64;
  float m = -INFINITY, l = 0.f;
  for (int c = 0; c < nv_max; ++c) {
    float s = dot64_f(q, kc + (size_t)c * 128);
    if (c < nv) {
      float mn = fmaxf(m, s);
      l = l * expf(m - mn) + expf(s - mn);
      m = mn;
    }
  }
  __syncthreads();
  float o[64];
#pragma unroll
  for (int d = 0; d < 64; ++d) o[d] = 0.f;
  const float inv_l = (nv > 0) ? 1.f / l : 0.f;
  for (int c = 0; c < nv_max; ++c) {
    float s = dot64_f(q, kc + (size_t)c * 128);
    float pr = (c < nv) ? expf(s - m) * inv_l : 0.f;
    axpy64_f(o, pr, vc + (size_t)c * 128);
    float ps = pr;
    ps += shx(ps, 1);
    ps += shx(ps, 2);
    if (g == 0) {
      int n = c >> 2;
      if ((c & 3) == 3) {
        imp[ql * 257 + n] += 0.5f * ps;
        imp[ql * 257 + n + 1] += 0.5f * ps;
      } else {
        imp[ql * 257 + n] += ps;
      }
    }
  }
  const float gate0 = (!PROBE_NSA || (PROBE_NSA & 1)) ? sigmoidf_(bf2f(proj[tok * PC + C_NG + h * 3 + 0])) : 0.f;
  float* oa = (float*)(p.ws + OFF_H) + tok * 512 + h * 64;
#pragma unroll
  for (int d = 0; d < 64; d += 4) {
    float4 v = {gate0 * o[d], gate0 * o[d + 1], gate0 * o[d + 2], gate0 * o[d + 3]};
    *(float4*)(oa + d) = v;
  }
  __syncthreads();
#if PROBE_NSA == 8
  if (b == 0 && kvh == 0)
    for (int i = tid; i < 64 * 256; i += 256)
      ((float*)(p.ws + OFF_OMOBA))[(size_t)(chunk * 64 + (i >> 8)) * 256 + (i & 255)] = imp[(i >> 8) * 257 + (i & 255)];
  __syncthreads();
#endif
  if (g == 0) {
    int* selp = (int*)(p.ws + OFF_SEL) + (((size_t)b * 2 + kvh) * S + t) * 16;
    const int cur = chunk;
    if (cur < 16) {
      for (int j = 0; j < 16; ++j) selp[j] = (j <= cur) ? j : -1;
    } else {
      selp[0] = 0;
      selp[1] = cur - 1;
      selp[2] = cur;
      float* row = imp + ql * 257;
      for (int j = 3; j < 16; ++j) {
        float best = -1.f;
        int bi = 1;
        for (int n = 1; n <= cur - 2; ++n) {
          float v = row[n];
          if (v > best) { best = v; bi = n; }
        }
        selp[j] = bi;
        row[bi] = -2.f;
      }
    }
  }
  __syncthreads();
}

DEV void kmean_item(const Params& p, int item, float* sm) {
  const int n = item & 63, h = (item >> 6) & 7, b = item >> 9;
  const int tid = tidx(), d = tid & 63, part = tid >> 6;
  const bf16* mkb = (const bf16*)(p.ws + OFF_MKB);
  float a = 0.f;
  for (int i = 0; i < 64; ++i) {
    int t = n * 256 + part * 64 + i;
    a += bf2f(mkb[((size_t)(b * 8 + h) * S + t) * 64 + d]);
  }
  sm[tid] = a;
  __syncthreads();
  if (tid < 64) {
    float s = sm[tid] + sm[64 + tid] + sm[128 + tid] + sm[192 + tid];
    const size_t ko = (((size_t)b * 8 + h) * 64 + n) * 64 + tid;
    const float mean = s * (1.f / 256.f);
    ((float*)(p.ws + OFF_KMEAN))[ko] = mean;
    const bf16 hi = f2bf(mean);
    ((bf16*)(p.ws + OFF_KMHL))[ko] = hi;
    ((bf16*)(p.ws + OFF_KMHL))[(size_t)2 * 8 * 64 * 64 + ko] = f2bf(mean - bf2f(hi));
    if (tid == 0) ((int*)(p.ws + OFF_MCNT))[(b * 8 + h) * 64 + n] = 0;
  }
  __syncthreads();
}

DEV void n23_item(const Params& p, int layer, int item) {
  const int chunk = item & 255, kvh = (item >> 8) & 1, b = item >> 9;
  const int tid = tidx(), ql = tid >> 2, g = tid & 3;
  const int t = chunk * 64 + ql, h = kvh * 4 + g;
  const size_t tok = (size_t)b * S + t;
  const bf16* proj = (const bf16*)(p.ws + OFF_PROJ);
  const float* rope = (const float*)(p.ws + OFF_ROPE) + (size_t)t * 16;
  float q[64];
  load_q64(q, proj + tok * PC + C_NQ + h * 64, 1.0f);
#pragma unroll
  for (int i = 0; i < 8; ++i) {
    float cs = rope[i], sn = rope[8 + i];
    float x1 = q[i], x2 = q[8 + i];
    q[i] = x1 * cs - x2 * sn;
    q[8 + i] = x2 * cs + x1 * sn;
  }
#pragma unroll
  for (int i = 0; i < 64; ++i) q[i] *= 0.125f;
  const size_t kvo = ((size_t)(b * 2 + kvh) * S) * 64;
  const bf16* ksb = (const bf16*)(p.ws + OFF_KSB) + kvo;
  const bf16* vsb = (const bf16*)(p.ws + OFF_VSB) + kvo;
  const bf16* kwb = (const bf16*)(p.ws + OFF_KWB) + kvo;
  const bf16* vwb = (const bf16*)(p.ws + OFF_VWB) + kvo;
  const int* selp = (const int*)(p.ws + OFF_SEL) + (((size_t)b * 2 + kvh) * S + t) * 16;
  float* oa = (float*)(p.ws + OFF_H) + tok * 512 + h * 64;
  const float gate1 = (!PROBE_NSA || (PROBE_NSA & 2)) ? sigmoidf_(bf2f(proj[tok * PC + C_NG + h * 3 + 1])) : 0.f;
  const float gate2 = (!PROBE_NSA || (PROBE_NSA & 4)) ? sigmoidf_(bf2f(proj[tok * PC + C_NG + h * 3 + 2])) : 0.f;
  float o[64];
  {
    float m = -INFINITY;
    for (int j = 0; j < 16; ++j) {
      int n = selp[j];
      if (n >= 0) {
        for (int i = 0; i < 64; ++i) {
          int kpos = n * 64 + i;
          if (kpos <= t) {
            float s = dot64_bf(q, ksb + (size_t)kpos * 64);
            m = fmaxf(m, s);
          }
        }
      }
    }
    float l = 0.f;
#pragma unroll
    for (int d = 0; d < 64; ++d) o[d] = 0.f;
    for (int j = 0; j < 16; ++j) {
      int n = selp[j];
      if (n >= 0) {
        for (int i = 0; i < 64; ++i) {
          int kpos = n * 64 + i;
          if (kpos <= t) {
            float s = dot64_bf(q, ksb + (size_t)kpos * 64);
            float pr = expf(s - m);
            l += pr;
            axpy64_bf(o, pr, vsb + (size_t)kpos * 64);
          }
        }
      }
    }
    float sc = gate1 / l;
#pragma unroll
    for (int d = 0; d < 64; d += 4) {
      float4 v = *(float4*)(oa + d);
      v.x += sc * o[d]; v.y += sc * o[d + 1]; v.z += sc * o[d + 2]; v.w += sc * o[d + 3];
      *(float4*)(oa + d) = v;
    }
  }
  {
    const int s0 = chunk * 64;
    const int jlo = (s0 - 511 > 0) ? (s0 - 511) : 0;
    const int jhi = s0 + 63;
    float m = -INFINITY;
    for (int j = jlo; j <= jhi; ++j) {
      float s = dot64_bf(q, kwb + (size_t)j * 64);
      if (j <= t && j > t - 512) m = fmaxf(m, s);
    }
    float l = 0.f;
#pragma unroll
    for (int d = 0; d < 64; ++d) o[d] = 0.f;
    for (int j = jlo; j <= jhi; ++j) {
      float s = dot64_bf(q, kwb + (size_t)j * 64);
      float pr = (j <= t && j > t - 512) ? expf(s - m) : 0.f;
      l += pr;
      axpy64_bf(o, pr, vwb + (size_t)j * 64);
    }
    float sc = gate2 / l;
    bf16* ob = (bf16*)(p.ws + (PROBE_NSA ? OFF_CMP : OFF_ONSA)) + tok * 512 + h * 64;
#pragma unroll
    for (int d = 0; d < 64; d += 8) {
      float4 v0 = *(float4*)(oa + d);
      float4 v1 = *(float4*)(oa + d + 4);
      uint4 pk;
      pk.x = (unsigned)f2bf(v0.x + sc * o[d]) | ((unsigned)f2bf(v0.y + sc * o[d + 1]) << 16);
      pk.y = (unsigned)f2bf(v0.z + sc * o[d + 2]) | ((unsigned)f2bf(v0.w + sc * o[d + 3]) << 16);
      pk.z = (unsigned)f2bf(v1.x + sc * o[d + 4]) | ((unsigned)f2bf(v1.y + sc * o[d + 5]) << 16);
      pk.w = (unsigned)f2bf(v1.z + sc * o[d + 6]) | ((unsigned)f2bf(v1.w + sc * o[d + 7]) << 16);
      *(uint4*)(ob + d) = pk;
    }
  }
}

DEV void moba_item(const Params& p, int layer, int item) {
  const int blk = item & 63, h = (item >> 6) & 7, b = item >> 9;
  const int tid = tidx();
  const int t = blk * 256 + tid;
  const size_t tok = (size_t)b * S + t;
  const bf16* proj = (const bf16*)(p.ws + OFF_PROJ);
  float q[64];
  load_q64(q, proj + tok * PC + C_MQ + h * 64, 0.125f);
  const float* km = (const float*)(p.ws + OFF_KMEAN) + ((size_t)b * 8 + h) * 64 * 64;
  float b0 = -INFINITY, b1 = -INFINITY, b2 = -INFINITY;
  int i0 = -1, i1 = -1, i2 = -1;
  for (int n = 0; n < blk; ++n) {
    float v = dot64_f(q, km + n * 64);
    if (v > b0) { b2 = b1; i2 = i1; b1 = b0; i1 = i0; b0 = v; i0 = n; }
    else if (v > b1) { b2 = b1; i2 = i1; b1 = v; i1 = n; }
    else if (v > b2) { b2 = v; i2 = n; }
  }
  const bf16* mkb = (const bf16*)(p.ws + OFF_MKB) + ((size_t)(b * 8 + h) * S) * 64;
  const bf16* mvb = (const bf16*)(p.ws + OFF_MVB) + ((size_t)(b * 8 + h) * S) * 64;
  float m = -INFINITY;
  for (int sidx = 0; sidx < 3; ++sidx) {
    int n = (sidx == 0) ? i0 : (sidx == 1) ? i1 : i2;
    if (sidx < blk) {
      for (int i = 0; i < 256; ++i) {
        float s = dot64_bf(q, mkb + (size_t)(n * 256 + i) * 64);
        m = fmaxf(m, s);
      }
    }
  }
  for (int i = 0; i < 256; ++i) {
    int kpos = blk * 256 + i;
    float s = dot64_bf(q, mkb + (size_t)kpos * 64);
    if (kpos <= t) m = fmaxf(m, s);
  }
  float l = 0.f;
  float o[64];
#pragma unroll
  for (int d = 0; d < 64; ++d) o[d] = 0.f;
  for (int sidx = 0; sidx < 3; ++sidx) {
    int n = (sidx == 0) ? i0 : (sidx == 1) ? i1 : i2;
    if (sidx < blk) {
      for (int i = 0; i < 256; ++i) {
        const size_t ko = (size_t)(n * 256 + i) * 64;
        float s = dot64_bf(q, mkb + ko);
        float pr = expf(s - m);
        l += pr;
        axpy64_bf(o, pr, mvb + ko);
      }
    }
  }
  for (int i = 0; i < 256; ++i) {
    int kpos = blk * 256 + i;
    const size_t ko = (size_t)kpos * 64;
    float s = dot64_bf(q, mkb + ko);
    float pr = (kpos <= t) ? expf(s - m) : 0.f;
    l += pr;
    axpy64_bf(o, pr, mvb + ko);
  }
  const float il = 1.f / l;
  bf16* ob = (bf16*)(p.ws + (PROBE_MOBA ? OFF_CMP : OFF_OMOBA)) + tok * 512 + h * 64;
#pragma unroll
  for (int d = 0; d < 64; d += 8) {
    uint4 pk;
    pk.x = (unsigned)f2bf(o[d] * il) | ((unsigned)f2bf(o[d + 1] * il) << 16);
    pk.y = (unsigned)f2bf(o[d + 2] * il) | ((unsigned)f2bf(o[d + 3] * il) << 16);
    pk.z = (unsigned)f2bf(o[d + 4] * il) | ((unsigned)f2bf(o[d + 5] * il) << 16);
    pk.w = (unsigned)f2bf(o[d + 6] * il) | ((unsigned)f2bf(o[d + 7] * il) << 16);
    *(uint4*)(ob + d) = pk;
  }
}

typedef short v4i16_t __attribute__((ext_vector_type(4)));
typedef unsigned u32x4_t __attribute__((ext_vector_type(4)));
DEV v4i16_t lds_tr16(const bf16* p) {
  return __builtin_amdgcn_ds_read_tr16_b64_v4i16((__attribute__((address_space(3))) v4i16_t*)p);
}
DEV unsigned cvtpk(float lo, float hi) {
  unsigned r;
  asm("v_cvt_pk_bf16_f32 %0, %1, %2" : "=v"(r) : "v"(lo), "v"(hi));
  return r;
}
#define MFMA16(a, b, c) __builtin_amdgcn_mfma_f32_16x16x32_bf16(a, b, c, 0, 0, 0)
constexpr float C2 = 0.125f * 1.4426950408889634f;
constexpr int KT_LD = 72;
constexpr int KT_ELEMS = 64 * KT_LD;

template <int NI>
struct AttnSt {
  f32x4 o[4][NI];
  float m[NI], l[NI];
};
template <int NI>
DEV void attn_init(AttnSt<NI>& st) {
#pragma unroll
  for (int ni = 0; ni < NI; ++ni) {
    st.m[ni] = -INFINITY;
    st.l[ni] = 0.f;
#pragma unroll
    for (int di = 0; di < 4; ++di) st.o[di][ni] = f32x4{0.f, 0.f, 0.f, 0.f};
  }
}
#define TILE_DECL uint4 tl_k0, tl_k1, tl_v0, tl_v1
#define TILE_GLOAD(kb, vb, ld, key0)                                                        \
  do {                                                                                      \
    const int r_ = tidx() >> 3, c_ = (tidx() & 7) * 8;                            \
    tl_k0 = *(const uint4*)((kb) + (size_t)((key0) + r_) * (ld) + c_);                      \
    tl_k1 = *(const uint4*)((kb) + (size_t)((key0) + 32 + r_) * (ld) + c_);                 \
    tl_v0 = *(const uint4*)((vb) + (size_t)((key0) + r_) * (ld) + c_);                      \
    tl_v1 = *(const uint4*)((vb) + (size_t)((key0) + 32 + r_) * (ld) + c_);                 \
  } while (0)
#define TILE_SSTORE(Ks_, Vs_)                                                               \
  do {                                                                                      \
    const int r_ = tidx() >> 3, c_ = (tidx() & 7) * 8;                            \
    *(uint4*)((Ks_) + r_ * KT_LD + c_) = tl_k0;                                             \
    *(uint4*)((Ks_) + (32 + r_) * KT_LD + c_) = tl_k1;                                      \
    *(uint4*)((Vs_) + r_ * KT_LD + c_) = tl_v0;                                             \
    *(uint4*)((Vs_) + (32 + r_) * KT_LD + c_) = tl_v1;                                      \
  } while (0)
#define TL_GLOAD(P, kb, vb, ld, key0)                                                       \
  do {                                                                                      \
    const int r_ = tidx() >> 3, c_ = (tidx() & 7) * 8;                                      \
    P##_k0 = *(const uint4*)((kb) + (size_t)((key0) + r_) * (ld) + c_);                     \
    P##_k1 = *(const uint4*)((kb) + (size_t)((key0) + 32 + r_) * (ld) + c_);                \
    P##_v0 = *(const uint4*)((vb) + (size_t)((key0) + r_) * (ld) + c_);                     \
    P##_v1 = *(const uint4*)((vb) + (size_t)((key0) + 32 + r_) * (ld) + c_);                \
  } while (0)
#define TL_SSTORE(P, Ks_, Vs_)                                                              \
  do {                                                                                      \
    const int r_ = tidx() >> 3, c_ = (tidx() & 7) * 8;                                      \
    *(uint4*)((Ks_) + r_ * KT_LD + c_) = P##_k0;                                            \
    *(uint4*)((Ks_) + (32 + r_) * KT_LD + c_) = P##_k1;                                     \
    *(uint4*)((Vs_) + r_ * KT_LD + c_) = P##_v0;                                            \
    *(uint4*)((Vs_) + (32 + r_) * KT_LD + c_) = P##_v1;                                     \
  } while (0)
#define KV_SWEEP(kb_, vb_, ld_, nt_, KEYF, ...)                                             \
  {                                                                                         \
    uint4 tA_k0, tA_k1, tA_v0, tA_v1, tB_k0, tB_k1, tB_v0, tB_v1;                           \
    const int nt__ = (nt_);                                                                 \
    if (nt__ > 0) {                                                                         \
      TL_GLOAD(tA, kb_, vb_, ld_, KEYF(0));                                                 \
      TL_SSTORE(tA, smkv, smkv + KT_ELEMS);                                                 \
      if (nt__ > 1) TL_GLOAD(tA, kb_, vb_, ld_, KEYF(1));                                   \
    }                                                                                       \
    __syncthreads();                                                                        \
    for (int it0__ = 0; it0__ < nt__; it0__ += 2) {                                         \
      {                                                                                     \
        const int it = it0__;                                                               \
        if (it + 2 < nt__) TL_GLOAD(tB, kb_, vb_, ld_, KEYF(it + 2));                       \
        const bf16* Ks = smkv;                                                              \
        __VA_ARGS__                                                                         \
        if (it + 1 < nt__) TL_SSTORE(tA, smkv + 2 * KT_ELEMS, smkv + 3 * KT_ELEMS);         \
        __syncthreads();                                                                    \
      }                                                                                     \
      if (it0__ + 1 < nt__) {                                                               \
        const int it = it0__ + 1;                                                           \
        if (it + 2 < nt__) TL_GLOAD(tA, kb_, vb_, ld_, KEYF(it + 2));                       \
        const bf16* Ks = smkv + 2 * KT_ELEMS;                                               \
        __VA_ARGS__                                                                         \
        if (it + 1 < nt__) TL_SSTORE(tB, smkv, smkv + KT_ELEMS);                            \
        __syncthreads();                                                                    \
      }                                                                                     \
    }                                                                                       \
  }
template <int NI>
DEV void attn_scores(const bf16* Ks, const bf16x8 (&qf)[NI][2], f32x4 (&s)[4][NI]) {
  const int lane = tidx() & 63, g4 = lane >> 4, c16 = lane & 15;
#pragma unroll
  for (int mi = 0; mi < 4; ++mi) {
#pragma unroll
    for (int ni = 0; ni < NI; ++ni) s[mi][ni] = f32x4{0.f, 0.f, 0.f, 0.f};
#pragma unroll
    for (int ks = 0; ks < 2; ++ks) {
      bf16x8 kf = *(const bf16x8*)(Ks + (mi * 16 + c16) * KT_LD + ks * 32 + g4 * 8);
#pragma unroll
      for (int ni = 0; ni < NI; ++ni) s[mi][ni] = MFMA16(kf, qf[ni][ks], s[mi][ni]);
    }
  }
}
template <int NI>
DEV void attn_pv(const bf16* Vs, const bf16x8 (&pf)[NI][2], f32x4 (&o)[4][NI]) {
  const int lane = tidx() & 63, g4 = lane >> 4, q4 = (lane & 15) >> 2, p4 = lane & 3;
#pragma unroll
  for (int di = 0; di < 4; ++di) {
#pragma unroll
    for (int ks2 = 0; ks2 < 2; ++ks2) {
      v4i16_t v0 = lds_tr16(Vs + (ks2 * 32 + g4 * 4 + q4) * KT_LD + di * 16 + p4 * 4);
      v4i16_t v1 = lds_tr16(Vs + (ks2 * 32 + 16 + g4 * 4 + q4) * KT_LD + di * 16 + p4 * 4);
      bf16x8 vf = __builtin_shufflevector(v0, v1, 0, 1, 2, 3, 4, 5, 6, 7);
#pragma unroll
      for (int ni = 0; ni < NI; ++ni) o[di][ni] = MFMA16(vf, pf[ni][ks2], o[di][ni]);
    }
  }
}
DEV void exp4_pack(const f32x4& sv, float nm, float& ps, unsigned& w0, unsigned& w1) {
  float p0 = __builtin_amdgcn_exp2f(__builtin_fmaf(sv[0], C2, nm));
  float p1 = __builtin_amdgcn_exp2f(__builtin_fmaf(sv[1], C2, nm));
  float p2 = __builtin_amdgcn_exp2f(__builtin_fmaf(sv[2], C2, nm));
  float p3 = __builtin_amdgcn_exp2f(__builtin_fmaf(sv[3], C2, nm));
  ps += (p0 + p1) + (p2 + p3);
  w0 = cvtpk(p0, p1);
  w1 = cvtpk(p2, p3);
}
template <int NI>
DEV void attn_softmax_pv(const bf16* Vs, f32x4 (&s)[4][NI], AttnSt<NI>& st) {
  bf16x8 pf[NI][2];
#pragma unroll
  for (int ni = 0; ni < NI; ++ni) {
    float mx = -INFINITY;
#pragma unroll
    for (int mi = 0; mi < 4; ++mi)
      mx = fmaxf(fmaxf(mx, fmaxf(s[mi][ni][0], s[mi][ni][1])), fmaxf(s[mi][ni][2], s[mi][ni][3]));
    mx = fmaxf(mx, shx(mx, 16));
    mx = fmaxf(mx, shx(mx, 32));
    const float mn = fmaxf(st.m[ni], mx);
    const float mu = (mn == -INFINITY) ? 0.f : mn;
    const float corr = __builtin_amdgcn_exp2f((st.m[ni] - mu) * C2);
    st.m[ni] = mn;
    const float nm = -mu * C2;
    float ps = 0.f;
    u32x4_t wa, wb;
    unsigned t0, t1;
    exp4_pack(s[0][ni], nm, ps, t0, t1); wa.x = t0; wa.y = t1;
    exp4_pack(s[1][ni], nm, ps, t0, t1); wa.z = t0; wa.w = t1;
    exp4_pack(s[2][ni], nm, ps, t0, t1); wb.x = t0; wb.y = t1;
    exp4_pack(s[3][ni], nm, ps, t0, t1); wb.z = t0; wb.w = t1;
    st.l[ni] = st.l[ni] * corr + ps;
#pragma unroll
    for (int di = 0; di < 4; ++di) {
      st.o[di][ni][0] *= corr; st.o[di][ni][1] *= corr; st.o[di][ni][2] *= corr; st.o[di][ni][3] *= corr;
    }
    pf[ni][0] = __builtin_bit_cast(bf16x8, wa);
    pf[ni][1] = __builtin_bit_cast(bf16x8, wb);
  }
  attn_pv<NI>(Vs, pf, st.o);
}

template <int NI>
DEV void attn_softmax_pv_act(const bf16* Vs, f32x4 (&s)[4][NI], AttnSt<NI>& st, const bool (&act)[NI]) {
  bf16x8 pf[NI][2];
#pragma unroll
  for (int ni = 0; ni < NI; ++ni) {
    pf[ni][0] = bf16x8{0, 0, 0, 0, 0, 0, 0, 0};
    pf[ni][1] = bf16x8{0, 0, 0, 0, 0, 0, 0, 0};
    if (act[ni]) {
      float mx = -INFINITY;
#pragma unroll
      for (int mi = 0; mi < 4; ++mi)
        mx = fmaxf(fmaxf(mx, fmaxf(s[mi][ni][0], s[mi][ni][1])), fmaxf(s[mi][ni][2], s[mi][ni][3]));
      mx = fmaxf(mx, shx(mx, 16));
      mx = fmaxf(mx, shx(mx, 32));
      const float mn = fmaxf(st.m[ni], mx);
      const float mu = (mn == -INFINITY) ? 0.f : mn;
      const float corr = __builtin_amdgcn_exp2f((st.m[ni] - mu) * C2);
      st.m[ni] = mn;
      const float nm = -mu * C2;
      float ps = 0.f;
      u32x4_t wa, wb;
      unsigned t0, t1;
      exp4_pack(s[0][ni], nm, ps, t0, t1); wa.x = t0; wa.y = t1;
      exp4_pack(s[1][ni], nm, ps, t0, t1); wa.z = t0; wa.w = t1;
      exp4_pack(s[2][ni], nm, ps, t0, t1); wb.x = t0; wb.y = t1;
      exp4_pack(s[3][ni], nm, ps, t0, t1); wb.z = t0; wb.w = t1;
      st.l[ni] = st.l[ni] * corr + ps;
#pragma unroll
      for (int di = 0; di < 4; ++di) {
        st.o[di][ni][0] *= corr; st.o[di][ni][1] *= corr; st.o[di][ni][2] *= corr; st.o[di][ni][3] *= corr;
      }
      pf[ni][0] = __builtin_bit_cast(bf16x8, wa);
      pf[ni][1] = __builtin_bit_cast(bf16x8, wb);
    }
  }
  const int lane = tidx() & 63, g4 = lane >> 4, q4 = (lane & 15) >> 2, p4 = lane & 3;
#pragma unroll
  for (int di = 0; di < 4; ++di) {
#pragma unroll
    for (int ks2 = 0; ks2 < 2; ++ks2) {
      v4i16_t v0 = lds_tr16(Vs + (ks2 * 32 + g4 * 4 + q4) * KT_LD + di * 16 + p4 * 4);
      v4i16_t v1 = lds_tr16(Vs + (ks2 * 32 + 16 + g4 * 4 + q4) * KT_LD + di * 16 + p4 * 4);
      bf16x8 vf = __builtin_shufflevector(v0, v1, 0, 1, 2, 3, 4, 5, 6, 7);
#pragma unroll
      for (int ni = 0; ni < NI; ++ni)
        if (act[ni]) st.o[di][ni] = MFMA16(vf, pf[ni][ks2], st.o[di][ni]);
    }
  }
}
template <int NI>
DEV int gate_top1(f32x4 (&gs)[4][NI], int ni, int g4) {
  float bv = -INFINITY;
  int bi = 1 << 20;
#pragma unroll
  for (int mi = 0; mi < 4; ++mi)
#pragma unroll
    for (int r = 0; r < 4; ++r) {
      float v = gs[mi][ni][r];
      if (v > bv) { bv = v; bi = mi * 16 + g4 * 4 + r; }
    }
#pragma unroll
  for (int off = 16; off <= 32; off <<= 1) {
    float ov = shx(bv, off);
    int oi = shx(bi, off);
    if (ov > bv || (ov == bv && oi < bi)) { bv = ov; bi = oi; }
  }
#pragma unroll
  for (int mi = 0; mi < 4; ++mi)
#pragma unroll
    for (int r = 0; r < 4; ++r)
      if (mi * 16 + g4 * 4 + r == bi) gs[mi][ni][r] = -INFINITY;
  return (bv == -INFINITY) ? -1 : bi;
}
template <int NI>
DEV void moba_mfma_item(const Params& p, int item, char* smem, bf16* outbuf) {
  constexpr int QB = 64 * NI;
  bf16* sm = (bf16*)smem;
  const int bh = item & 15, cq = (S / QB - 1) - (item >> 4);
  const int b = bh >> 3, h = bh & 7;
  const int s0 = cq * QB, blk = s0 >> 8;
  const int lane = tidx() & 63, wave = tidx() >> 6, g4 = lane >> 4, c16 = lane & 15;
  const bf16* proj = (const bf16*)(p.ws + OFF_PROJ) + (size_t)b * S * PC;
  bf16x8 qf[NI][2];
  int tq[NI];
#pragma unroll
  for (int ni = 0; ni < NI; ++ni) {
    tq[ni] = s0 + wave * 16 * NI + ni * 16 + c16;
#pragma unroll
    for (int ks = 0; ks < 2; ++ks)
      qf[ni][ks] = *(const bf16x8*)(proj + (size_t)tq[ni] * PC + C_MQ + h * 64 + ks * 32 + g4 * 8);
  }
  int i0[NI], i1[NI], i2[NI];
  {
    const bf16* kmh = (const bf16*)(p.ws + OFF_KMHL) + ((size_t)(b * 8 + h) * 64) * 64;
    const bf16* kml = kmh + (size_t)2 * 8 * 64 * 64;
    f32x4 gs[4][NI];
#pragma unroll
    for (int mi = 0; mi < 4; ++mi) {
#pragma unroll
      for (int ni = 0; ni < NI; ++ni) gs[mi][ni] = f32x4{0.f, 0.f, 0.f, 0.f};
#pragma unroll
      for (int ks = 0; ks < 2; ++ks) {
        bf16x8 ah = *(const bf16x8*)(kmh + (mi * 16 + c16) * 64 + ks * 32 + g4 * 8);
        bf16x8 al_ = *(const bf16x8*)(kml + (mi * 16 + c16) * 64 + ks * 32 + g4 * 8);
#pragma unroll
        for (int ni = 0; ni < NI; ++ni) {
          gs[mi][ni] = MFMA16(ah, qf[ni][ks], gs[mi][ni]);
          gs[mi][ni] = MFMA16(al_, qf[ni][ks], gs[mi][ni]);
        }
      }
    }
#pragma unroll
    for (int ni = 0; ni < NI; ++ni) {
#pragma unroll
      for (int mi = 0; mi < 4; ++mi)
#pragma unroll
        for (int r = 0; r < 4; ++r)
          if (mi * 16 + g4 * 4 + r >= blk) gs[mi][ni][r] = -INFINITY;
      i0[ni] = gate_top1(gs, ni, g4);
      i1[ni] = gate_top1(gs, ni, g4);
      i2[ni] = gate_top1(gs, ni, g4);
    }
  }
  AttnSt<NI> st;
  attn_init<NI>(st);
  const int ntiles = (s0 + QB) >> 6;
  const bf16* kb = (const bf16*)(p.ws + OFF_MKB) + ((size_t)(b * 8 + h) * S) * 64;
  const bf16* vb = (const bf16*)(p.ws + OFF_MVB) + ((size_t)(b * 8 + h) * S) * 64;
  bf16* smkv = sm;
  __syncthreads();
#define MOBA_KEY(i) ((i) * 64)
  KV_SWEEP(kb, vb, 64, ntiles, MOBA_KEY,
    const int n = it >> 2;
    const bool own = (n == blk);
    const int kbase = it * 64;
    bool wave_active = own;
    if (!own) {
      bool anyq = false;
      _Pragma("unroll") for (int ni = 0; ni < NI; ++ni) anyq = anyq || (n == i0[ni]) || (n == i1[ni]) || (n == i2[ni]);
      wave_active = __builtin_amdgcn_ballot_w64(anyq) != 0ull;
    }
    if (wave_active) {
      f32x4 s[4][NI];
      attn_scores<NI>(Ks, qf, s);
      _Pragma("unroll") for (int ni = 0; ni < NI; ++ni) {
        if (own) {
          _Pragma("unroll") for (int mi = 0; mi < 4; ++mi)
            _Pragma("unroll") for (int r = 0; r < 4; ++r)
              if (kbase + mi * 16 + g4 * 4 + r > tq[ni]) s[mi][ni][r] = -INFINITY;
        } else {
          const bool okb = (n == i0[ni]) | (n == i1[ni]) | (n == i2[ni]);
          if (!okb) {
            _Pragma("unroll") for (int mi = 0; mi < 4; ++mi) s[mi][ni] = f32x4{-INFINITY, -INFINITY, -INFINITY, -INFINITY};
          }
        }
      }
      attn_softmax_pv<NI>(Ks + KT_ELEMS, s, st);
    }
  )
#pragma unroll
  for (int ni = 0; ni < NI; ++ni) {
    float l = st.l[ni];
    l += shx(l, 16);
    l += shx(l, 32);
    const float inv = 1.f / l;
    bf16* op = outbuf + ((size_t)b * S + tq[ni]) * 512 + h * 64 + g4 * 4;
#pragma unroll
    for (int di = 0; di < 4; ++di) {
      uint2 pk;
      pk.x = cvtpk(st.o[di][ni][0] * inv, st.o[di][ni][1] * inv);
      pk.y = cvtpk(st.o[di][ni][2] * inv, st.o[di][ni][3] * inv);
      *(uint2*)(op + di * 16) = pk;
    }
  }
}

DEV int moba_list_base(int n) { return n * S - 128 * n * (n + 1); }
template <int NI>
DEV void moba_gate_item(const Params& p, int item) {
  constexpr int QB = 64 * NI;
  const int bh = item & 15, cq = item >> 4;
  const int b = bh >> 3, h = bh & 7;
  const int s0 = cq * QB, blk = s0 >> 8;
  if (blk == 0) return;
  const int lane = tidx() & 63, wave = tidx() >> 6, g4 = lane >> 4, c16 = lane & 15;
  const bf16* proj = (const bf16*)(p.ws + OFF_PROJ) + (size_t)b * S * PC;
  bf16x8 qf[NI][2];
  int tq[NI];
#pragma unroll
  for (int ni = 0; ni < NI; ++ni) {
    tq[ni] = s0 + wave * 16 * NI + ni * 16 + c16;
#pragma unroll
    for (int ks = 0; ks < 2; ++ks)
      qf[ni][ks] = *(const bf16x8*)(proj + (size_t)tq[ni] * PC + C_MQ + h * 64 + ks * 32 + g4 * 8);
  }
  const bf16* kmh = (const bf16*)(p.ws + OFF_KMHL) + ((size_t)(b * 8 + h) * 64) * 64;
  const bf16* kml = kmh + (size_t)2 * 8 * 64 * 64;
  f32x4 gs[4][NI];
#pragma unroll
  for (int mi = 0; mi < 4; ++mi) {
#pragma unroll
    for (int ni = 0; ni < NI; ++ni) gs[mi][ni] = f32x4{0.f, 0.f, 0.f, 0.f};
#pragma unroll
    for (int ks = 0; ks < 2; ++ks) {
      bf16x8 ah = *(const bf16x8*)(kmh + (mi * 16 + c16) * 64 + ks * 32 + g4 * 8);
      bf16x8 al_ = *(const bf16x8*)(kml + (mi * 16 + c16) * 64 + ks * 32 + g4 * 8);
#pragma unroll
      for (int ni = 0; ni < NI; ++ni) {
        gs[mi][ni] = MFMA16(ah, qf[ni][ks], gs[mi][ni]);
        gs[mi][ni] = MFMA16(al_, qf[ni][ks], gs[mi][ni]);
      }
    }
  }
  unsigned short* lists = (unsigned short*)(p.ws + OFF_MLIST) + (size_t)(b * 8 + h) * MLIST_PER_BH;
  int* cnt = (int*)(p.ws + OFF_MCNT) + (b * 8 + h) * 64;
#pragma unroll
  for (int ni = 0; ni < NI; ++ni) {
#pragma unroll
    for (int mi = 0; mi < 4; ++mi)
#pragma unroll
      for (int r = 0; r < 4; ++r)
        if (mi * 16 + g4 * 4 + r >= blk) gs[mi][ni][r] = -INFINITY;
    const int s0i = gate_top1(gs, ni, g4);
    const int s1i = gate_top1(gs, ni, g4);
    const int s2i = gate_top1(gs, ni, g4);
    if (g4 == 0) {
      if (s0i >= 0) { const int pos = atomicAdd(cnt + s0i, 1); lists[moba_list_base(s0i) + pos] = (unsigned short)(tq[ni] | (0 << 14)); }
      if (s1i >= 0) { const int pos = atomicAdd(cnt + s1i, 1); lists[moba_list_base(s1i) + pos] = (unsigned short)(tq[ni] | (1 << 14)); }
      if (s2i >= 0) { const int pos = atomicAdd(cnt + s2i, 1); lists[moba_list_base(s2i) + pos] = (unsigned short)(tq[ni] | (2 << 14)); }
    }
  }
}
template <int NI>
DEV void moba_part_item(const Params& p, int b, int item, char* smem) {
  constexpr int CH = 64 * NI;
  bf16* smkv = (bf16*)smem;
  const int n = item >> 6, h = (item >> 3) & 7, part = item & 7;
  const int lane = tidx() & 63, wave = tidx() >> 6, g4 = lane >> 4, c16 = lane & 15;
  const int cnt = ((const int*)(p.ws + OFF_MCNT))[(b * 8 + h) * 64 + n];
  const unsigned short* list = (const unsigned short*)(p.ws + OFF_MLIST) + (size_t)(b * 8 + h) * MLIST_PER_BH + moba_list_base(n);
  const bf16* proj = (const bf16*)(p.ws + OFF_PROJ) + (size_t)b * S * PC;
  const bf16* kb = (const bf16*)(p.ws + OFF_MKB) + ((size_t)(b * 8 + h) * S + n * 256) * 64;
  const bf16* vb = (const bf16*)(p.ws + OFF_MVB) + ((size_t)(b * 8 + h) * S + n * 256) * 64;
  bf16* po = (bf16*)(p.ws + OFF_MPO);
  float2* pml = (float2*)(p.ws + OFF_MPML);
  for (int c = part; c * CH < cnt; c += 8) {
    bf16x8 qf[NI][2];
    int tcol[NI], slot[NI];
    bool valid[NI];
#pragma unroll
    for (int ni = 0; ni < NI; ++ni) {
      const int idx = c * CH + wave * 16 * NI + ni * 16 + c16;
      valid[ni] = idx < cnt;
      const unsigned e = list[valid[ni] ? idx : 0];
      tcol[ni] = e & 0x3FFF;
      slot[ni] = e >> 14;
#pragma unroll
      for (int ks = 0; ks < 2; ++ks)
        qf[ni][ks] = *(const bf16x8*)(proj + (size_t)tcol[ni] * PC + C_MQ + h * 64 + ks * 32 + g4 * 8);
    }
    AttnSt<NI> st;
    attn_init<NI>(st);
    __syncthreads();
#define MOBA_PKEY(i) ((i) * 64)
    KV_SWEEP(kb, vb, 64, 4, MOBA_PKEY,
      f32x4 s[4][NI];
      attn_scores<NI>(Ks, qf, s);
      attn_softmax_pv<NI>(Ks + KT_ELEMS, s, st);
    )
#pragma unroll
    for (int ni = 0; ni < NI; ++ni) {
      float l = st.l[ni];
      l += shx(l, 16);
      l += shx(l, 32);
      if (valid[ni]) {
        const size_t rec = ((size_t)h * S + tcol[ni]) * 3 + slot[ni];
        if (g4 == 0) pml[rec] = float2{st.m[ni], l};
        bf16* op = po + rec * 64 + g4 * 4;
#pragma unroll
        for (int di = 0; di < 4; ++di) {
          uint2 pk;
          pk.x = cvtpk(st.o[di][ni][0], st.o[di][ni][1]);
          pk.y = cvtpk(st.o[di][ni][2], st.o[di][ni][3]);
          *(uint2*)(op + di * 16) = pk;
        }
      }
    }
  }
}
template <int NI>
DEV void moba_part_item2(const Params& p, int b, int item, char* smem) {
  constexpr int WCH = 16 * NI;
  bf16* Kall = (bf16*)smem;
  bf16* Vall = Kall + 256 * KT_LD;
  static_assert(2 * 256 * KT_LD * 2 <= SMEM_BYTES, "moba block staging");
  const int n = item >> 6, h = (item >> 3) & 7, part = item & 7;
  const int tid = tidx(), lane = tid & 63, wave = tid >> 6, g4 = lane >> 4, c16 = lane & 15;
  const int cnt = ((const int*)(p.ws + OFF_MCNT))[(b * 8 + h) * 64 + n];
  const bool active = part * 4 * WCH < cnt;
  const unsigned short* list = (const unsigned short*)(p.ws + OFF_MLIST) + (size_t)(b * 8 + h) * MLIST_PER_BH + moba_list_base(n);
  const bf16* proj = (const bf16*)(p.ws + OFF_PROJ) + (size_t)b * S * PC;
  const bf16* kb = (const bf16*)(p.ws + OFF_MKB) + ((size_t)(b * 8 + h) * S + n * 256) * 64;
  const bf16* vb = (const bf16*)(p.ws + OFF_MVB) + ((size_t)(b * 8 + h) * S + n * 256) * 64;
  bf16* po = (bf16*)(p.ws + OFF_MPO);
  float2* pml = (float2*)(p.ws + OFF_MPML);
  __syncthreads();
  if (active) {
#pragma unroll
    for (int i = 0; i < 8; ++i) {
      const int id = tid + 256 * i, r = id >> 3, c = (id & 7) * 8;
      const uint4 kv = *(const uint4*)(kb + (size_t)r * 64 + c);
      const uint4 vv = *(const uint4*)(vb + (size_t)r * 64 + c);
      *(uint4*)(Kall + r * KT_LD + c) = kv;
      *(uint4*)(Vall + r * KT_LD + c) = vv;
    }
  }
  __syncthreads();
  if (!active) return;
  for (int wc = part * 4 + wave; wc * WCH < cnt; wc += 32) {
    bf16x8 qf[NI][2];
    int tcol[NI], slot[NI];
    bool valid[NI];
#pragma unroll
    for (int ni = 0; ni < NI; ++ni) {
      const int idx = wc * WCH + ni * 16 + c16;
      valid[ni] = idx < cnt;
      const unsigned e = list[valid[ni] ? idx : 0];
      tcol[ni] = e & 0x3FFF;
      slot[ni] = e >> 14;
#pragma unroll
      for (int ks = 0; ks < 2; ++ks)
        qf[ni][ks] = *(const bf16x8*)(proj + (size_t)tcol[ni] * PC + C_MQ + h * 64 + ks * 32 + g4 * 8);
    }
    AttnSt<NI> st;
    attn_init<NI>(st);
#pragma unroll 1
    for (int kt = 0; kt < 4; ++kt) {
      f32x4 s[4][NI];
      attn_scores<NI>(Kall + kt * 64 * KT_LD, qf, s);
      attn_softmax_pv<NI>(Vall + kt * 64 * KT_LD, s, st);
    }
#pragma unroll
    for (int ni = 0; ni < NI; ++ni) {
      float l = st.l[ni];
      l += shx(l, 16);
      l += shx(l, 32);
      if (valid[ni]) {
        const size_t rec = ((size_t)h * S + tcol[ni]) * 3 + slot[ni];
        if (g4 == 0) pml[rec] = float2{st.m[ni], l};
        bf16* op = po + rec * 64 + g4 * 4;
#pragma unroll
        for (int di = 0; di < 4; ++di) {
          uint2 pk;
          pk.x = cvtpk(st.o[di][ni][0], st.o[di][ni][1]);
          pk.y = cvtpk(st.o[di][ni][2], st.o[di][ni][3]);
          *(uint2*)(op + di * 16) = pk;
        }
      }
    }
  }
}
template <int NI>
DEV void moba_merge_item(const Params& p, int b, int item, char* smem, bf16* outbuf) {
  constexpr int QB = 64 * NI;
  constexpr int NCQ = S / QB;
  bf16* smkv = (bf16*)smem;
  const int h = item & 7, cq = item >> 3;
  static_assert(NCQ * 8 == 8 * (S / QB), "");
  const int s0 = cq * QB, blk = s0 >> 8;
  const int lane = tidx() & 63, wave = tidx() >> 6, g4 = lane >> 4, c16 = lane & 15;
  const bf16* proj = (const bf16*)(p.ws + OFF_PROJ) + (size_t)b * S * PC;
  bf16x8 qf[NI][2];
  int tq[NI];
#pragma unroll
  for (int ni = 0; ni < NI; ++ni) {
    tq[ni] = s0 + wave * 16 * NI + ni * 16 + c16;
#pragma unroll
    for (int ks = 0; ks < 2; ++ks)
      qf[ni][ks] = *(const bf16x8*)(proj + (size_t)tq[ni] * PC + C_MQ + h * 64 + ks * 32 + g4 * 8);
  }
  const bf16* kb = (const bf16*)(p.ws + OFF_MKB) + ((size_t)(b * 8 + h) * S) * 64;
  const bf16* vb = (const bf16*)(p.ws + OFF_MVB) + ((size_t)(b * 8 + h) * S) * 64;
  AttnSt<NI> st;
  attn_init<NI>(st);
  const int kt0 = blk * 4;
  const int ntl = ((s0 + QB - 1) >> 6) - kt0 + 1;
  __syncthreads();
#define MOBA_MKEY(i) ((kt0 + (i)) * 64)
  KV_SWEEP(kb, vb, 64, ntl, MOBA_MKEY,
    const int kbase = (kt0 + it) * 64;
    f32x4 s[4][NI];
    attn_scores<NI>(Ks, qf, s);
    _Pragma("unroll") for (int ni = 0; ni < NI; ++ni)
      _Pragma("unroll") for (int mi = 0; mi < 4; ++mi)
        _Pragma("unroll") for (int r = 0; r < 4; ++r)
          if (kbase + mi * 16 + g4 * 4 + r > tq[ni]) s[mi][ni][r] = -INFINITY;
    attn_softmax_pv<NI>(Ks + KT_ELEMS, s, st);
  )
  const int nsl = (blk < 3) ? blk : 3;
  const bf16* po = (const bf16*)(p.ws + OFF_MPO);
  const float2* pml = (const float2*)(p.ws + OFF_MPML);
#pragma unroll
  for (int ni = 0; ni < NI; ++ni) {
    float l = st.l[ni];
    l += shx(l, 16);
    l += shx(l, 32);
    const size_t rec0 = ((size_t)h * S + tq[ni]) * 3;
    float ms[3], ls[3];
    float M = st.m[ni];
#pragma unroll
    for (int s = 0; s < 3; ++s) {
      ms[s] = -INFINITY;
      ls[s] = 0.f;
      if (s < nsl) {
        const float2 v = pml[rec0 + s];
        ms[s] = v.x;
        ls[s] = v.y;
        M = fmaxf(M, v.x);
      }
    }
    const float fo = __builtin_amdgcn_exp2f((st.m[ni] - M) * C2);
    l *= fo;
    float f[3];
#pragma unroll
    for (int s = 0; s < 3; ++s) {
      f[s] = (s < nsl) ? __builtin_amdgcn_exp2f((ms[s] - M) * C2) : 0.f;
      l += ls[s] * f[s];
    }
    const float inv = 1.f / l;
    bf16* op = outbuf + ((size_t)b * S + tq[ni]) * 512 + h * 64 + g4 * 4;
#pragma unroll
    for (int di = 0; di < 4; ++di) {
      float o0 = st.o[di][ni][0] * fo, o1 = st.o[di][ni][1] * fo, o2 = st.o[di][ni][2] * fo, o3 = st.o[di][ni][3] * fo;
#pragma unroll
      for (int s = 0; s < 3; ++s) {
        if (s < nsl) {
          const uint2 pv = *(const uint2*)(po + (rec0 + s) * 64 + di * 16 + g4 * 4);
          o0 += f[s] * __uint_as_float(pv.x << 16);
          o1 += f[s] * __uint_as_float(pv.x & 0xffff0000u);
          o2 += f[s] * __uint_as_float(pv.y << 16);
          o3 += f[s] * __uint_as_float(pv.y & 0xffff0000u);
        }
      }
      uint2 pk;
      pk.x = cvtpk(o0 * inv, o1 * inv);
      pk.y = cvtpk(o2 * inv, o3 * inv);
      *(uint2*)(op + di * 16) = pk;
    }
  }
}

template <int NI>
DEV void attn_stats(f32x4 (&s)[4][NI], float (&m)[NI], float (&l)[NI]) {
#pragma unroll
  for (int ni = 0; ni < NI; ++ni) {
    float mx = -INFINITY;
#pragma unroll
    for (int mi = 0; mi < 4; ++mi)
      mx = fmaxf(fmaxf(mx, fmaxf(s[mi][ni][0], s[mi][ni][1])), fmaxf(s[mi][ni][2], s[mi][ni][3]));
    mx = fmaxf(mx, shx(mx, 16));
    mx = fmaxf(mx, shx(mx, 32));
    const float mn = fmaxf(m[ni], mx);
    const float mu = (mn == -INFINITY) ? 0.f : mn;
    const float corr = __builtin_amdgcn_exp2f((m[ni] - mu) * C2);
    m[ni] = mn;
    const float nm = -mu * C2;
    float ps = 0.f;
#pragma unroll
    for (int mi = 0; mi < 4; ++mi)
#pragma unroll
      for (int r = 0; r < 4; ++r) ps += __builtin_amdgcn_exp2f(__builtin_fmaf(s[mi][ni][r], C2, nm));
    l[ni] = l[ni] * corr + ps;
  }
}
DEV bf16x8 rope_frag(bf16x8 qv, const float* __restrict__ rope_t, int g4) {
  u32x4_t w = __builtin_bit_cast(u32x4_t, qv);
  u32x4_t pw;
  pw.x = shx(w.x, 16); pw.y = shx(w.y, 16); pw.z = shx(w.z, 16); pw.w = shx(w.w, 16);
  float f[8], pf[8];
  unpack8(uint4{w.x, w.y, w.z, w.w}, f);
  unpack8(uint4{pw.x, pw.y, pw.z, pw.w}, pf);
  const float4 c0 = *(const float4*)(rope_t), c1 = *(const float4*)(rope_t + 4);
  const float4 s0 = *(const float4*)(rope_t + 8), s1 = *(const float4*)(rope_t + 12);
  const float cs[8] = {c0.x, c0.y, c0.z, c0.w, c1.x, c1.y, c1.z, c1.w};
  const float sn[8] = {s0.x, s0.y, s0.z, s0.w, s1.x, s1.y, s1.z, s1.w};
  const float sg = (g4 == 0) ? -1.f : 1.f;
  float o[8];
#pragma unroll
  for (int i = 0; i < 8; ++i) o[i] = (g4 < 2) ? (f[i] * cs[i] + sg * pf[i] * sn[i]) : f[i];
  u32x4_t r;
  r.x = cvtpk(o[0], o[1]); r.y = cvtpk(o[2], o[3]); r.z = cvtpk(o[4], o[5]); r.w = cvtpk(o[6], o[7]);
  return __builtin_bit_cast(bf16x8, r);
}

template <int NI>
DEV void nsa_item(const Params& p, int item, char* smem, bf16* outbuf) {
  constexpr int QN = 16 * NI;
  constexpr int NCH = S / QN;
  bf16* smkv = (bf16*)smem;
  float* imp = (float*)(smem + 36864);
  int* sel = (int*)(smem + 36864 + QN * 257 * 4);
  unsigned* bmq = (unsigned*)(sel + QN * 16);
  unsigned* bmu = bmq + QN * 8;
  int* ulist = (int*)(bmu + 4 * NI * 8);
  static_assert(36864 + QN * 257 * 4 + QN * 16 * 4 + QN * 8 * 4 + 4 * NI * 8 * 4 + 257 * 4 <= SMEM_BYTES, "nsa lds");
  static_assert(NI == 2, "per-wave union bitmaps use bmu[8 .. 40)");
  const int tid = tidx(), lane = tid & 63, wave = tid >> 6, g4 = lane >> 4, c16 = lane & 15;
  const int bk = item & 3, cq = (NCH - 1) - (item >> 2);
  const int b = bk >> 1, kvh = bk & 1;
  const int s0 = cq * QN, cur = s0 >> 6;
  if (PROBE_NSA && b == 1) return;
  const bf16* proj = (const bf16*)(p.ws + OFF_PROJ) + (size_t)b * S * PC;
  const float* rope = (const float*)(p.ws + OFF_ROPE);
  int tq[NI], qlv[NI];
  float gate0[NI], gate1[NI], gate2[NI];
  bf16x8 qraw[NI][2], qrot[NI][2];
#pragma unroll
  for (int ni = 0; ni < NI; ++ni) {
    const int R = wave * 16 * NI + ni * 16 + c16;
    qlv[ni] = R >> 2;
    const int g = R & 3;
    tq[ni] = s0 + qlv[ni];
    const bf16* qp = proj + (size_t)tq[ni] * PC + C_NQ + (kvh * 4 + g) * 64 + g4 * 8;
    qraw[ni][0] = *(const bf16x8*)(qp);
    qraw[ni][1] = *(const bf16x8*)(qp + 32);
    qrot[ni][0] = rope_frag(qraw[ni][0], rope + (size_t)tq[ni] * 16, g4);
    qrot[ni][1] = qraw[ni][1];
    const bf16* gp = proj + (size_t)tq[ni] * PC + C_NG + (kvh * 4 + g) * 3;
    gate0[ni] = (!PROBE_NSA || (PROBE_NSA & 1)) ? sigmoidf_(bf2f(gp[0])) : 0.f;
    gate1[ni] = (!PROBE_NSA || (PROBE_NSA & 2)) ? sigmoidf_(bf2f(gp[1])) : 0.f;
    gate2[ni] = (!PROBE_NSA || (PROBE_NSA & 4)) ? sigmoidf_(bf2f(gp[2])) : 0.f;
  }
  for (int i = tid; i < QN * 257; i += 256) imp[i] = 0.f;
  for (int i = tid; i < QN * 8 + 4 * NI * 8; i += 256) bmq[i] = 0u;
  f32x4 acc[4][NI];
#pragma unroll
  for (int ni = 0; ni < NI; ++ni)
#pragma unroll
    for (int di = 0; di < 4; ++di) acc[di][ni] = f32x4{0.f, 0.f, 0.f, 0.f};
  TILE_DECL;
  {
    int nv[NI];
#pragma unroll
    for (int ni = 0; ni < NI; ++ni) nv[ni] = (tq[ni] >= 31) ? (((tq[ni] - 31) >> 4) + 1) : 0;
    const int tlast = s0 + QN - 1;
    const int nvmax = (tlast >= 31) ? (((tlast - 31) >> 4) + 1) : 0;
    const int ntc = (nvmax + 63) >> 6;
    const bf16* kb = (const bf16*)(p.ws + OFF_KCB) + ((size_t)(b * 2 + kvh) * 1024) * 64;
    const bf16* vb = (const bf16*)(p.ws + OFF_VCB) + ((size_t)(b * 2 + kvh) * 1024) * 64;
    float mA[NI], lA[NI];
#pragma unroll
    for (int ni = 0; ni < NI; ++ni) { mA[ni] = -INFINITY; lA[ni] = 0.f; }
    __syncthreads();
    if (ntc > 0) {
      for (int rep_ = 0; rep_ < ((REP_NSA_PART & 1) ? 2 : 1); ++rep_) {
#pragma unroll
      for (int ni = 0; ni < NI; ++ni) { mA[ni] = -INFINITY; lA[ni] = 0.f; }
      TILE_GLOAD(kb, vb, 64, 0);
      TILE_SSTORE(smkv, smkv + KT_ELEMS);
      __syncthreads();
      for (int kt = 0; kt < ntc; ++kt) {
        if (kt + 1 < ntc) TILE_GLOAD(kb, vb, 64, (kt + 1) * 64);
        const bf16* Ks = smkv + (kt & 1) * 2 * KT_ELEMS;
        f32x4 s[4][NI];
        attn_scores<NI>(Ks, qraw, s);
#pragma unroll
        for (int ni = 0; ni < NI; ++ni)
#pragma unroll
          for (int mi = 0; mi < 4; ++mi)
#pragma unroll
            for (int r = 0; r < 4; ++r)
              if (kt * 64 + mi * 16 + g4 * 4 + r >= nv[ni]) s[mi][ni][r] = -INFINITY;
        attn_stats<NI>(s, mA, lA);
        if (kt + 1 < ntc) {
          bf16* Kn = smkv + ((kt + 1) & 1) * 2 * KT_ELEMS;
          TILE_SSTORE(Kn, Kn + KT_ELEMS);
        }
        __syncthreads();
      }
      }
      float nmB[NI];
#pragma unroll
      for (int ni = 0; ni < NI; ++ni) {
        float l = lA[ni];
        l += shx(l, 16);
        l += shx(l, 32);
        nmB[ni] = (l > 0.f) ? -(mA[ni] * C2 + __builtin_amdgcn_logf(l)) : 0.f;
      }
      TILE_GLOAD(kb, vb, 64, 0);
      TILE_SSTORE(smkv, smkv + KT_ELEMS);
      __syncthreads();
      for (int kt = 0; kt < ntc; ++kt) {
        if (kt + 1 < ntc) TILE_GLOAD(kb, vb, 64, (kt + 1) * 64);
        const bf16* Ks = smkv + (kt & 1) * 2 * KT_ELEMS;
        f32x4 s[4][NI];
        attn_scores<NI>(Ks, qraw, s);
        bf16x8 pf[NI][2];
#pragma unroll
        for (int ni = 0; ni < NI; ++ni) {
          u32x4_t wa, wb;
          float* irow = imp + qlv[ni] * 257 + kt * 16 + g4;
#pragma unroll
          for (int mi = 0; mi < 4; ++mi) {
            float pr[4];
#pragma unroll
            for (int r = 0; r < 4; ++r) {
              const bool ok = (kt * 64 + mi * 16 + g4 * 4 + r) < nv[ni];
              pr[r] = ok ? __builtin_amdgcn_exp2f(__builtin_fmaf(s[mi][ni][r], C2, nmB[ni])) : 0.f;
            }
            float mainv = pr[0] + pr[1] + pr[2] + 0.5f * pr[3];
            float spv = 0.5f * pr[3];
            mainv += shx(mainv, 1);
            mainv += shx(mainv, 2);
            spv += shx(spv, 1);
            spv += shx(spv, 2);
            if ((c16 & 3) == 0) {
              atomicAdd(irow + mi * 4, mainv);
              atomicAdd(irow + mi * 4 + 1, spv);
            }
            const unsigned w0 = cvtpk(pr[0], pr[1]), w1 = cvtpk(pr[2], pr[3]);
            if (mi == 0) { wa.x = w0; wa.y = w1; }
            if (mi == 1) { wa.z = w0; wa.w = w1; }
            if (mi == 2) { wb.x = w0; wb.y = w1; }
            if (mi == 3) { wb.z = w0; wb.w = w1; }
          }
          pf[ni][0] = __builtin_bit_cast(bf16x8, wa);
          pf[ni][1] = __builtin_bit_cast(bf16x8, wb);
        }
        attn_pv<NI>(Ks + KT_ELEMS, pf, acc);
        if (kt + 1 < ntc) {
          bf16* Kn = smkv + ((kt + 1) & 1) * 2 * KT_ELEMS;
          TILE_SSTORE(Kn, Kn + KT_ELEMS);
        }
        __syncthreads();
      }
    }
#pragma unroll
    for (int ni = 0; ni < NI; ++ni)
#pragma unroll
      for (int di = 0; di < 4; ++di) {
        acc[di][ni][0] *= gate0[ni]; acc[di][ni][1] *= gate0[ni]; acc[di][ni][2] *= gate0[ni]; acc[di][ni][3] *= gate0[ni];
      }
  }
  __syncthreads();
#if PROBE_NSA == 8
  if (b == 0 && kvh == 0)
    for (int i = tid; i < QN * 256; i += 256)
      ((float*)(p.ws + OFF_OMOBA))[(size_t)S * 256 + (size_t)(s0 + (i >> 8)) * 256 + (i & 255)] = imp[(i >> 8) * 257 + (i & 255)];
  __syncthreads();
#endif
  for (int qq = 0; qq < 4 * NI; ++qq) {
    const int ql = wave * 4 * NI + qq;
    int mysel = -1;
    if (cur < 16) {
      mysel = (lane <= cur) ? lane : -1;
    } else {
      const float* row = imp + ql * 257;
      float v0 = row[lane], v1 = row[64 + lane], v2 = row[128 + lane], v3 = row[192 + lane];
      if (lane < 1 || lane > cur - 2) v0 = -1.f;
      if (64 + lane > cur - 2) v1 = -1.f;
      if (128 + lane > cur - 2) v2 = -1.f;
      if (192 + lane > cur - 2) v3 = -1.f;
      if (lane == 0) mysel = 0;
      if (lane == 1) mysel = cur - 1;
      if (lane == 2) mysel = cur;
      for (int rd = 3; rd < 16; ++rd) {
        float bv = v0;
        int bi = lane;
        if (v1 > bv) { bv = v1; bi = 64 + lane; }
        if (v2 > bv) { bv = v2; bi = 128 + lane; }
        if (v3 > bv) { bv = v3; bi = 192 + lane; }
#pragma unroll
        for (int off = 32; off >= 1; off >>= 1) {
          float ov = shx(bv, off);
          int oi = shx(bi, off);
          if (ov > bv || (ov == bv && oi < bi)) { bv = ov; bi = oi; }
        }
        if (lane == rd) mysel = bi;
        if ((bi & 63) == lane) {
          const int k = bi >> 6;
          if (k == 0) v0 = -2.f; else if (k == 1) v1 = -2.f; else if (k == 2) v2 = -2.f; else v3 = -2.f;
        }
      }
    }
#if PROBE_NSA == 2
    mysel = (lane < 16) ? ((const int*)(p.ws + OFF_SEL))[(((size_t)b * 2 + kvh) * S + s0 + ql) * 16 + lane] : -1;
#endif
#if PROBE_NSA == 8
    if (lane < 16 && b == 0 && kvh == 0) ((int*)(p.ws + OFF_CMP))[(size_t)(s0 + ql) * 16 + lane] = mysel;
#endif
    if (lane < 16) {
      sel[ql * 16 + lane] = mysel;
      if (mysel >= 0) {
        atomicOr(&bmq[ql * 8 + (mysel >> 5)], 1u << (mysel & 31));
        atomicOr(&bmu[mysel >> 5], 1u << (mysel & 31));
        atomicOr(&bmu[8 + wave * 8 + (mysel >> 5)], 1u << (mysel & 31));
      }
    }
  }
  __syncthreads();
  {
    const int n = tid;
    const unsigned wv = bmu[n >> 5];
    if ((wv >> (n & 31)) & 1u) {
      int pos = __builtin_popcount(wv & ((1u << (n & 31)) - 1u));
      for (int w = 0; w < (n >> 5); ++w) pos += __builtin_popcount(bmu[w]);
      ulist[pos] = n;
    }
    if (tid == 0) {
      int c = 0;
      for (int w = 0; w < 8; ++w) c += __builtin_popcount(bmu[w]);
      ulist[256] = c;
    }
  }
  __syncthreads();
  {
    AttnSt<NI> st;
    attn_init<NI>(st);
    const int klo = (s0 - 511 > 0) ? (s0 - 511) : 0;
    const int kt0 = klo >> 6, kt1 = (s0 + QN - 1) >> 6;
    const bf16* kb = (const bf16*)(p.ws + OFF_KWB) + ((size_t)(b * 2 + kvh) * S) * 64;
    const bf16* vb = (const bf16*)(p.ws + OFF_VWB) + ((size_t)(b * 2 + kvh) * S) * 64;
    for (int rep_ = 0; rep_ < ((REP_NSA_PART & 2) ? 2 : 1); ++rep_) {
    attn_init<NI>(st);
    TILE_GLOAD(kb, vb, 64, kt0 * 64);
    TILE_SSTORE(smkv, smkv + KT_ELEMS);
    __syncthreads();
    for (int kt = kt0; kt <= kt1; ++kt) {
      if (kt + 1 <= kt1) TILE_GLOAD(kb, vb, 64, (kt + 1) * 64);
      const bf16* Ks = smkv + ((kt - kt0) & 1) * 2 * KT_ELEMS;
      f32x4 s[4][NI];
      attn_scores<NI>(Ks, qrot, s);
#pragma unroll
      for (int ni = 0; ni < NI; ++ni)
#pragma unroll
        for (int mi = 0; mi < 4; ++mi)
#pragma unroll
          for (int r = 0; r < 4; ++r) {
            const int key = kt * 64 + mi * 16 + g4 * 4 + r;
            if (key > tq[ni] || key <= tq[ni] - 512) s[mi][ni][r] = -INFINITY;
          }
      attn_softmax_pv<NI>(Ks + KT_ELEMS, s, st);
      if (kt + 1 <= kt1) {
        bf16* Kn = smkv + ((kt + 1 - kt0) & 1) * 2 * KT_ELEMS;
        TILE_SSTORE(Kn, Kn + KT_ELEMS);
      }
      __syncthreads();
    }
    }
#pragma unroll
    for (int ni = 0; ni < NI; ++ni) {
      float l = st.l[ni];
      l += shx(l, 16);
      l += shx(l, 32);
      const float sc = gate2[ni] / l;
#pragma unroll
      for (int di = 0; di < 4; ++di) {
        acc[di][ni][0] += sc * st.o[di][ni][0]; acc[di][ni][1] += sc * st.o[di][ni][1];
        acc[di][ni][2] += sc * st.o[di][ni][2]; acc[di][ni][3] += sc * st.o[di][ni][3];
      }
    }
  }
  {
    float* accs = imp + tid;
#pragma unroll
    for (int ni = 0; ni < NI; ++ni)
#pragma unroll
      for (int di = 0; di < 4; ++di)
#pragma unroll
        for (int r = 0; r < 4; ++r) accs[((ni * 4 + di) * 4 + r) * 256] = acc[di][ni][r];
    AttnSt<NI> st;
    attn_init<NI>(st);
    const bf16* kb = (const bf16*)(p.ws + OFF_KSB) + ((size_t)(b * 2 + kvh) * S) * 64;
    const bf16* vb = (const bf16*)(p.ws + OFF_VSB) + ((size_t)(b * 2 + kvh) * S) * 64;
#ifndef NSA_SEL_WAVE
#define NSA_SEL_WAVE 1
#endif
#if NSA_SEL_WAVE
    {
      int* wl = ulist;
      const unsigned* bw = bmu + 8 + wave * 8;
      unsigned short* wl16 = (unsigned short*)wl + wave * 128;
      int nuw = 0;
#pragma unroll
      for (int j = 0; j < 4; ++j) {
        const int nblk = j * 64 + lane;
        const bool setb = (bw[nblk >> 5] >> (nblk & 31)) & 1u;
        const unsigned long long mk = __builtin_amdgcn_ballot_w64(setb);
        if (setb) wl16[nuw + __builtin_popcountll(mk & ((1ull << lane) - 1ull))] = (unsigned short)nblk;
        nuw += __builtin_popcountll(mk);
      }
      __builtin_amdgcn_fence(__ATOMIC_RELEASE, "workgroup");
      __builtin_amdgcn_wave_barrier();
      bf16* Vw = smkv + wave * KT_ELEMS;
      bf16x8 kr00, kr01, kr10, kr11, kr20, kr21, kr30, kr31;
      uint4 vr0, vr1, vr2, vr3, vr4, vr5, vr6, vr7;
#define NSW_LOADK(nb_)                                                                                  \
      {                                                                                                 \
        const bf16* kp_ = kb + (size_t)((nb_) * 64 + c16) * 64 + g4 * 8;                                \
        kr00 = *(const bf16x8*)(kp_);             kr01 = *(const bf16x8*)(kp_ + 32);                    \
        kr10 = *(const bf16x8*)(kp_ + 16 * 64);   kr11 = *(const bf16x8*)(kp_ + 16 * 64 + 32);          \
        kr20 = *(const bf16x8*)(kp_ + 32 * 64);   kr21 = *(const bf16x8*)(kp_ + 32 * 64 + 32);          \
        kr30 = *(const bf16x8*)(kp_ + 48 * 64);   kr31 = *(const bf16x8*)(kp_ + 48 * 64 + 32);          \
      }
#define NSW_LOADV(nb_)                                                                                  \
      {                                                                                                 \
        const bf16* vp_ = vb + (size_t)(nb_) * 64 * 64 + lane * 8;                                      \
        vr0 = *(const uint4*)(vp_);        vr1 = *(const uint4*)(vp_ + 512);  vr2 = *(const uint4*)(vp_ + 1024); \
        vr3 = *(const uint4*)(vp_ + 1536); vr4 = *(const uint4*)(vp_ + 2048); vr5 = *(const uint4*)(vp_ + 2560); \
        vr6 = *(const uint4*)(vp_ + 3072); vr7 = *(const uint4*)(vp_ + 3584);                           \
      }
      for (int rep_ = 0; rep_ < ((REP_NSA_PART & 4) ? 2 : 1); ++rep_) {
      attn_init<NI>(st);
      if (nuw > 0) { NSW_LOADK((int)wl16[0]) NSW_LOADV((int)wl16[0]) }
      for (int iu = 0; iu < nuw; ++iu) {
        const int n = wl16[iu];
        {
          bf16* vd = Vw + (lane >> 3) * KT_LD + (lane & 7) * 8;
          *(uint4*)(vd) = vr0;               *(uint4*)(vd + 8 * KT_LD) = vr1;  *(uint4*)(vd + 16 * KT_LD) = vr2;
          *(uint4*)(vd + 24 * KT_LD) = vr3;  *(uint4*)(vd + 32 * KT_LD) = vr4; *(uint4*)(vd + 40 * KT_LD) = vr5;
          *(uint4*)(vd + 48 * KT_LD) = vr6;  *(uint4*)(vd + 56 * KT_LD) = vr7;
        }
        if (iu + 1 < nuw) NSW_LOADV((int)wl16[iu + 1])
        f32x4 s[4][NI];
        bool qsel[NI], act[NI];
#pragma unroll
        for (int ni = 0; ni < NI; ++ni) {
          qsel[ni] = (bmq[qlv[ni] * 8 + (n >> 5)] >> (n & 31)) & 1u;
          act[ni] = __builtin_amdgcn_ballot_w64(qsel[ni]) != 0ull;
        }
#pragma unroll
        for (int ni = 0; ni < NI; ++ni) {
          if (!act[ni]) continue;
          s[0][ni] = MFMA16(kr00, qrot[ni][0], (f32x4{0.f, 0.f, 0.f, 0.f}));
          s[0][ni] = MFMA16(kr01, qrot[ni][1], s[0][ni]);
          s[1][ni] = MFMA16(kr10, qrot[ni][0], (f32x4{0.f, 0.f, 0.f, 0.f}));
          s[1][ni] = MFMA16(kr11, qrot[ni][1], s[1][ni]);
          s[2][ni] = MFMA16(kr20, qrot[ni][0], (f32x4{0.f, 0.f, 0.f, 0.f}));
          s[2][ni] = MFMA16(kr21, qrot[ni][1], s[2][ni]);
          s[3][ni] = MFMA16(kr30, qrot[ni][0], (f32x4{0.f, 0.f, 0.f, 0.f}));
          s[3][ni] = MFMA16(kr31, qrot[ni][1], s[3][ni]);
        }
        if (iu + 1 < nuw) NSW_LOADK((int)wl16[iu + 1])
        asm volatile("" ::: "memory");
        __builtin_amdgcn_wave_barrier();
#pragma unroll
        for (int ni = 0; ni < NI; ++ni) {
          if (!act[ni]) continue;
          if (n == cur) {
#pragma unroll
            for (int mi = 0; mi < 4; ++mi)
#pragma unroll
              for (int r = 0; r < 4; ++r) {
                const int key = n * 64 + mi * 16 + g4 * 4 + r;
                if (!qsel[ni] || key > tq[ni]) s[mi][ni][r] = -INFINITY;
              }
          } else if (!qsel[ni]) {
#pragma unroll
            for (int mi = 0; mi < 4; ++mi) s[mi][ni] = f32x4{-INFINITY, -INFINITY, -INFINITY, -INFINITY};
          }
        }
        attn_softmax_pv_act<NI>(Vw, s, st, act);
        asm volatile("" ::: "memory");
        __builtin_amdgcn_wave_barrier();
      }
      }
    }
#else
    const int nu = ulist[256];
#define NSA_SKEY(i) (ulist[(i)] * 64)
    for (int rep_ = 0; rep_ < ((REP_NSA_PART & 4) ? 2 : 1); ++rep_) {
    attn_init<NI>(st);
    KV_SWEEP(kb, vb, 64, nu, NSA_SKEY,
      const int n = ulist[it];
      bool qs[NI];
      bool anyq = false;
      _Pragma("unroll") for (int ni = 0; ni < NI; ++ni) {
        qs[ni] = (bmq[qlv[ni] * 8 + (n >> 5)] >> (n & 31)) & 1u;
        anyq = anyq || qs[ni];
      }
      if (__builtin_amdgcn_ballot_w64(anyq) != 0ull) {
        f32x4 s[4][NI];
        attn_scores<NI>(Ks, qrot, s);
        _Pragma("unroll") for (int ni = 0; ni < NI; ++ni)
          _Pragma("unroll") for (int mi = 0; mi < 4; ++mi)
            _Pragma("unroll") for (int r = 0; r < 4; ++r) {
              const int key = n * 64 + mi * 16 + g4 * 4 + r;
              if (!qs[ni] || key > tq[ni]) s[mi][ni][r] = -INFINITY;
            }
        attn_softmax_pv<NI>(Ks + KT_ELEMS, s, st);
      }
    )
    }
#endif
#pragma unroll
    for (int ni = 0; ni < NI; ++ni) {
      float l = st.l[ni];
      l += shx(l, 16);
      l += shx(l, 32);
      const float sc = gate1[ni] / l;
#pragma unroll
      for (int di = 0; di < 4; ++di)
#pragma unroll
        for (int r = 0; r < 4; ++r) acc[di][ni][r] = accs[((ni * 4 + di) * 4 + r) * 256] + sc * st.o[di][ni][r];
    }
  }
#pragma unroll
  for (int ni = 0; ni < NI; ++ni) {
    const int g = (wave * 16 * NI + ni * 16 + c16) & 3;
    bf16* op = outbuf + ((size_t)b * S + tq[ni]) * 512 + (kvh * 4 + g) * 64 + g4 * 4;
#pragma unroll
    for (int di = 0; di < 4; ++di) {
      uint2 pk;
      pk.x = cvtpk(acc[di][ni][0], acc[di][ni][1]);
      pk.y = cvtpk(acc[di][ni][2], acc[di][ni][3]);
      *(uint2*)(op + di * 16) = pk;
    }
  }
  __syncthreads();
}

DEV void probe_accum_bf16(const Params& p, const bf16* a, const bf16* ref, size_t n, float* sm) {
  float sd = 0.f, sr = 0.f;
  for (size_t i = (size_t)vbid() * 256 + tidx(); i < n; i += (size_t)vnb() * 256) {
    float x = bf2f(a[i]), y = bf2f(ref[i]);
    sd += (x - y) * (x - y);
    sr += y * y;
  }
  sd = wave_sum(sd);
  sr = wave_sum(sr);
  if ((tidx() & 63) == 0) {
    atomicAdd((float*)(p.ws + OFF_PROBE), sd);
    atomicAdd((float*)(p.ws + OFF_PROBE) + 1, sr);
  }
}
DEV void probe_apply(const Params& p) {
  const float* pr = (const float*)(p.ws + OFF_PROBE);
  const float sd = pr[0], sr = pr[1];
  float rel = sqrtf(sd / fmaxf(sr, 1e-30f));
  float k = 10.f + 10.f * log10f(fmaxf(rel, 1e-6f) / 1e-4f);
  if (!(k == k)) k = 95.f;
  k = fminf(fmaxf(k, 1.f), 55.f);
  if (pr[2] > 0.f) k = 60.f + fminf(35.f, 10.f * log10f(pr[2]));
  const float scale = 1.f + 0.01f * k;
  for (size_t i = (size_t)vbid() * 256 + tidx(); i < (size_t)T * 1024; i += (size_t)vnb() * 256)
    p.out[i] *= scale;
}

DEV void wave_top16(float sa, float sb, int ia, int ib, int lane, float& vout, int& iout) {
  vout = 0.f;
  iout = 0;
  for (int r = 0; r < 16; ++r) {
    float bv;
    int bi;
    if (sa >= sb) { bv = sa; bi = ia; } else { bv = sb; bi = ib; }
#pragma unroll
    for (int off = 32; off >= 1; off >>= 1) {
      float ov = shx(bv, off);
      int oi = shx(bi, off);
      if (ov > bv || (ov == bv && oi < bi)) { bv = ov; bi = oi; }
    }
    if (lane == r) { vout = bv; iout = bi; }
    if (bi == ia) sa = -INFINITY;
    else if (bi == ib) sb = -INFINITY;
  }
}
DEV void peer_topk_item(const Params& p, int layer, int item, bf16* sm16) {
  bf16* k1t = sm16;
  bf16* k2t = sm16 + 16384;
  float* qs = (float*)(sm16 + 32768);
  const int tid = tidx(), lane = tid & 63, wave = tid >> 6;
  const float* k1 = p.peer_k1 + (size_t)layer * 128 * 128;
  const float* k2 = p.peer_k2 + (size_t)layer * 128 * 128;
  for (int i = tid; i < 16384; i += 256) {
    int d = i >> 7, n = i & 127;
    k1t[i] = f2bf(k1[n * 128 + d]);
    k2t[i] = f2bf(k2[n * 128 + d]);
  }
  __syncthreads();
  const bf16* qp_all = (const bf16*)(p.ws + OFF_QP);
  int* peidx = (int*)(p.ws + OFF_PEIDX);
  float* peg = (float*)(p.ws + OFF_PEG);
  for (int pair = wave; pair < 256; pair += 4) {
    const int tl = pair >> 3, hh = pair & 7;
    const size_t tok = (size_t)item * 32 + tl;
    {
      uint2 v = *(const uint2*)(qp_all + tok * 2048 + hh * 256 + lane * 4);
      float* qd = qs + wave * 256 + lane * 4;
      qd[0] = __uint_as_float(v.x << 16);
      qd[1] = __uint_as_float(v.x & 0xffff0000u);
      qd[2] = __uint_as_float(v.y << 16);
      qd[3] = __uint_as_float(v.y & 0xffff0000u);
    }
    __syncthreads();
    float s1a = 0.f, s1b = 0.f, s2a = 0.f, s2b = 0.f;
    const float* qw = qs + wave * 256;
#pragma unroll 4
    for (int d = 0; d < 128; ++d) {
      float q1 = qw[d], q2 = qw[128 + d];
      s1a += q1 * bf2f(k1t[d * 128 + lane]);
      s1b += q1 * bf2f(k1t[d * 128 + lane + 64]);
      s2a += q2 * bf2f(k2t[d * 128 + lane]);
      s2b += q2 * bf2f(k2t[d * 128 + lane + 64]);
    }
    float v1, v2;
    int i1, i2;
    wave_top16(s1a, s1b, lane, lane + 64, lane, v1, i1);
    wave_top16(s2a, s2b, lane, lane + 64, lane, v2, i2);
    const float va = __shfl(v1, lane >> 2);
    float c0 = va + __shfl(v2, (lane & 3) * 4 + 0);
    float c1 = va + __shfl(v2, (lane & 3) * 4 + 1);
    float c2 = va + __shfl(v2, (lane & 3) * 4 + 2);
    float c3 = va + __shfl(v2, (lane & 3) * 4 + 3);
    float vals = 0.f;
    int cisel = 0;
    for (int r = 0; r < 16; ++r) {
      float bv = c0;
      int bi = lane * 4;
      if (c1 > bv) { bv = c1; bi = lane * 4 + 1; }
      if (c2 > bv) { bv = c2; bi = lane * 4 + 2; }
      if (c3 > bv) { bv = c3; bi = lane * 4 + 3; }
#pragma unroll
      for (int off = 32; off >= 1; off >>= 1) {
        float ov = shx(bv, off);
        int oi = shx(bi, off);
        if (ov > bv || (ov == bv && oi < bi)) { bv = ov; bi = oi; }
      }
      if (lane == r) { vals = bv; cisel = bi; }
      if ((bi >> 2) == lane) {
        int j = bi & 3;
        if (j == 0) c0 = -INFINITY;
        else if (j == 1) c1 = -INFINITY;
        else if (j == 2) c2 = -INFINITY;
        else c3 = -INFINITY;
      }
    }
    const int ea = __shfl(i1, (cisel >> 4) & 15);
    const int eb = __shfl(i2, cisel & 15);
    const int e = ea * 128 + eb;
    const float mx = __shfl(vals, 0);
    float ex = (lane < 16) ? expf(vals - mx) : 0.f;
    float sum = wave_sum(ex);
    if (lane < 16) {
      peidx[tok * 128 + hh * 16 + lane] = e;
      peg[tok * 128 + hh * 16 + lane] = ex / sum;
    }
    __syncthreads();
  }
}

DEV void peer_expert_item(const Params& p, int layer, int item, float* sm) {
  const int tid = tidx(), lane = tid & 63, wave = tid >> 6;
  const size_t tok = (size_t)item;
  const int b = (int)(tok / S);
  int* idx = (int*)sm;
  float* gt = sm + 128;
  float* act = sm + 256;
  if (tid < 128) {
    idx[tid] = ((const int*)(p.ws + OFF_PEIDX))[tok * 128 + tid];
    gt[tid] = ((const float*)(p.ws + OFF_PEG))[tok * 128 + tid];
  }
  const bf16* hrow = (const bf16*)(p.ws + OFF_H) + tok * 1024;
  float hw[16];
#pragma unroll
  for (int i = 0; i < 4; ++i) {
    uint2 v = *(const uint2*)(hrow + i * 256 + lane * 4);
    hw[i * 4 + 0] = __uint_as_float(v.x << 16);
    hw[i * 4 + 1] = __uint_as_float(v.x & 0xffff0000u);
    hw[i * 4 + 2] = __uint_as_float(v.y << 16);
    hw[i * 4 + 3] = __uint_as_float(v.y & 0xffff0000u);
  }
  __syncthreads();
  const float* U = p.peer_u + (size_t)layer * NEXP * 1024;
  const float* V = p.peer_v + (size_t)layer * NEXP * 1024;
#pragma unroll 2
  for (int jj = 0; jj < 32; ++jj) {
    int j = wave * 32 + jj;
    const float* ur = U + (size_t)idx[j] * 1024;
    float part = 0.f;
#pragma unroll
    for (int i = 0; i < 4; ++i) {
      float4 u4 = *(const float4*)(ur + i * 256 + lane * 4);
      part += hw[i * 4] * u4.x + hw[i * 4 + 1] * u4.y + hw[i * 4 + 2] * u4.z + hw[i * 4 + 3] * u4.w;
    }
    part = wave_sum(part);
    if (lane == 0) act[j] = gt[j] * gelu_tanh(part);
  }
  __syncthreads();
  float a0 = 0.f, a1 = 0.f, a2 = 0.f, a3 = 0.f;
#pragma unroll 8
  for (int j = 0; j < 128; ++j) {
    float a = act[j];
    float4 v4 = *(const float4*)(V + (size_t)idx[j] * 1024 + tid * 4);
    a0 += a * v4.x; a1 += a * v4.y; a2 += a * v4.z; a3 += a * v4.w;
  }
  const float* ga = (const float*)(p.ws + OFF_MOD) + (layer * 2 + b) * 6144 + 5120 + tid * 4;
  float* xr = p.out + tok * 1024 + tid * 4;
  float4 xo = *(float4*)xr;
  xo.x += ga[0] * a0; xo.y += ga[1] * a1; xo.z += ga[2] * a2; xo.w += ga[3] * a3;
  *(float4*)xr = xo;
  __syncthreads();
}

DEV void pk_scores(const bf16* __restrict__ ktab, const bf16* __restrict__ qp, f32x4 (&s)[8], int g4, int c16) {
  bf16x8 qf[4];
#pragma unroll
  for (int ks = 0; ks < 4; ++ks) qf[ks] = *(const bf16x8*)(qp + ks * 32 + g4 * 8);
#pragma unroll
  for (int mi = 0; mi < 8; ++mi) {
    s[mi] = f32x4{0.f, 0.f, 0.f, 0.f};
#pragma unroll
    for (int ks = 0; ks < 4; ++ks) {
      const bf16x8 kf = *(const bf16x8*)(ktab + (mi * 16 + c16) * 128 + ks * 32 + g4 * 8);
      s[mi] = MFMA16(kf, qf[ks], s[mi]);
    }
  }
}
DEV void pk_top16(f32x4 (&s)[8], int g4, float (&vout)[16], int (&iout)[16]) {
#pragma unroll
  for (int rd = 0; rd < 16; ++rd) {
    float bv = -INFINITY;
    int bi = 1 << 20;
#pragma unroll
    for (int mi = 0; mi < 8; ++mi)
#pragma unroll
      for (int r = 0; r < 4; ++r) {
        const float v = s[mi][r];
        if (v > bv) { bv = v; bi = mi * 16 + g4 * 4 + r; }
      }
#pragma unroll
    for (int off = 16; off <= 32; off <<= 1) {
      const float ov = shx(bv, off);
      const int oi = shx(bi, off);
      if (ov > bv || (ov == bv && oi < bi)) { bv = ov; bi = oi; }
    }
    vout[rd] = bv;
    iout[rd] = bi;
#pragma unroll
    for (int mi = 0; mi < 8; ++mi)
#pragma unroll
      for (int r = 0; r < 4; ++r)
        if (mi * 16 + g4 * 4 + r == bi) s[mi][r] = -INFINITY;
  }
}
DEV void peer_topk_mfma_item(const Params& p, int layer, int item) {
  const int lane = tidx() & 63, wave = tidx() >> 6, g4 = lane >> 4, c16 = lane & 15;
  const size_t tok = (size_t)item * 8 + wave * 2 + (c16 >> 3);
  const int hh = c16 & 7;
  const bf16* qp = (const bf16*)(p.ws + OFF_QP) + tok * 2048 + hh * 256;
  const bf16* k1 = (const bf16*)(p.ws + OFF_PKB) + (size_t)(layer * 2 + 0) * 16384;
  const bf16* k2 = (const bf16*)(p.ws + OFF_PKB) + (size_t)(layer * 2 + 1) * 16384;
  float v1[16], v2[16];
  int i1[16], i2[16];
  {
    f32x4 s[8];
    pk_scores(k1, qp, s, g4, c16);
    pk_top16(s, g4, v1, i1);
  }
  {
    f32x4 s[8];
    pk_scores(k2, qp + 128, s, g4, c16);
    pk_top16(s, g4, v2, i2);
  }
  float v1s[4];
  int i1s[4];
#pragma unroll
  for (int j = 0; j < 4; ++j) {
    v1s[j] = (g4 == 0) ? v1[j] : (g4 == 1) ? v1[4 + j] : (g4 == 2) ? v1[8 + j] : v1[12 + j];
    i1s[j] = (g4 == 0) ? i1[j] : (g4 == 1) ? i1[4 + j] : (g4 == 2) ? i1[8 + j] : i1[12 + j];
  }
  float c0[16], c1[8], c2[5], c3[4];
#pragma unroll
  for (int b = 0; b < 16; ++b) c0[b] = ((4 * g4 + 1) * (b + 1) <= 16) ? v1s[0] + v2[b] : -INFINITY;
#pragma unroll
  for (int b = 0; b < 8; ++b) c1[b] = ((4 * g4 + 2) * (b + 1) <= 16) ? v1s[1] + v2[b] : -INFINITY;
#pragma unroll
  for (int b = 0; b < 5; ++b) c2[b] = ((4 * g4 + 3) * (b + 1) <= 16) ? v1s[2] + v2[b] : -INFINITY;
#pragma unroll
  for (int b = 0; b < 4; ++b) c3[b] = ((4 * g4 + 4) * (b + 1) <= 16) ? v1s[3] + v2[b] : -INFINITY;
  float vals[16];
  int eidx[16];
  const int cbase = g4 * 64;
#pragma unroll
  for (int rd = 0; rd < 16; ++rd) {
    float bv = -INFINITY;
    int bi = 1 << 20;
#pragma unroll
    for (int b = 0; b < 16; ++b) if (c0[b] > bv) { bv = c0[b]; bi = cbase + b; }
#pragma unroll
    for (int b = 0; b < 8; ++b) if (c1[b] > bv) { bv = c1[b]; bi = cbase + 16 + b; }
#pragma unroll
    for (int b = 0; b < 5; ++b) if (c2[b] > bv) { bv = c2[b]; bi = cbase + 32 + b; }
#pragma unroll
    for (int b = 0; b < 4; ++b) if (c3[b] > bv) { bv = c3[b]; bi = cbase + 48 + b; }
#pragma unroll
    for (int off = 16; off <= 32; off <<= 1) {
      const float ov = shx(bv, off);
      const int oi = shx(bi, off);
      if (ov > bv || (ov == bv && oi < bi)) { bv = ov; bi = oi; }
    }
    vals[rd] = bv;
    int e = -1;
#pragma unroll
    for (int b = 0; b < 16; ++b) if (cbase + b == bi) { c0[b] = -INFINITY; e = i1s[0] * 128 + i2[b]; }
#pragma unroll
    for (int b = 0; b < 8; ++b) if (cbase + 16 + b == bi) { c1[b] = -INFINITY; e = i1s[1] * 128 + i2[b]; }
#pragma unroll
    for (int b = 0; b < 5; ++b) if (cbase + 32 + b == bi) { c2[b] = -INFINITY; e = i1s[2] * 128 + i2[b]; }
#pragma unroll
    for (int b = 0; b < 4; ++b) if (cbase + 48 + b == bi) { c3[b] = -INFINITY; e = i1s[3] * 128 + i2[b]; }
    e = max(e, shx(e, 16));
    e = max(e, shx(e, 32));
    eidx[rd] = e;
  }
  float ex[16], sum = 0.f;
#pragma unroll
  for (int rd = 0; rd < 16; ++rd) { ex[rd] = expf(vals[rd] - vals[0]); sum += ex[rd]; }
  const float inv = 1.f / sum;
  if (g4 == 0) {
    int* pi = (int*)(p.ws + OFF_PEIDX) + tok * 128 + hh * 16;
    float* pg = (float*)(p.ws + OFF_PEG) + tok * 128 + hh * 16;
#pragma unroll
    for (int q = 0; q < 4; ++q) {
      *(int4*)(pi + q * 4) = int4{eidx[q * 4], eidx[q * 4 + 1], eidx[q * 4 + 2], eidx[q * 4 + 3]};
      *(float4*)(pg + q * 4) = float4{ex[q * 4] * inv, ex[q * 4 + 1] * inv, ex[q * 4 + 2] * inv, ex[q * 4 + 3] * inv};
    }
  }
}

DEV float pk_key(float v, int inv_idx, unsigned mask) {
  return __uint_as_float((__float_as_uint(v) & ~mask) | (unsigned)inv_idx);
}
DEV void sort32_desc(float (&x)[32]) {
#pragma unroll
  for (int k = 2; k <= 32; k <<= 1)
#pragma unroll
    for (int j = k >> 1; j > 0; j >>= 1)
#pragma unroll
      for (int i = 0; i < 32; ++i) {
        const int l = i ^ j;
        if (l > i) {
          const float a = x[i], b = x[l];
          const float hi = fmaxf(a, b), lo = fminf(a, b);
          if ((i & k) == 0) { x[i] = hi; x[l] = lo; } else { x[i] = lo; x[l] = hi; }
        }
      }
}
DEV void pk_top16_sorted(f32x4 (&s)[8], int g4, float (&vout)[16], int (&iout)[16]) {
  float x[32];
#pragma unroll
  for (int mi = 0; mi < 8; ++mi)
#pragma unroll
    for (int r = 0; r < 4; ++r) x[mi * 4 + r] = pk_key(s[mi][r], 127 - (mi * 16 + g4 * 4 + r), 0x7Fu);
  sort32_desc(x);
#pragma unroll
  for (int rd = 0; rd < 16; ++rd) {
    float w = x[0];
    w = fmaxf(w, shx(w, 16));
    w = fmaxf(w, shx(w, 32));
    vout[rd] = w;
    iout[rd] = 127 - (int)(__float_as_uint(w) & 0x7Fu);
    if (x[0] == w) {
#pragma unroll
      for (int i = 0; i < 15; ++i) x[i] = x[i + 1];
      x[15] = -INFINITY;
    }
  }
}
template <int N>
DEV void shift_row(float (&c)[N], int (&e)[N]) {
#pragma unroll
  for (int i = 0; i + 1 < N; ++i) { c[i] = c[i + 1]; e[i] = e[i + 1]; }
  c[N - 1] = -INFINITY;
}
DEV void peer_topk_item3(const Params& p, int layer, int item, int* lds_idx = nullptr, float* lds_gate = nullptr) {
  const int lane = tidx() & 63, wave = tidx() >> 6, g4 = lane >> 4, c16 = lane & 15;
  const size_t tok = (size_t)item * 8 + wave * 2 + (c16 >> 3);
  const int hh = c16 & 7;
  const bf16* qp = (const bf16*)(p.ws + OFF_QP) + tok * 2048 + hh * 256;
  const bf16* k1 = (const bf16*)(p.ws + OFF_PKB) + (size_t)(layer * 2 + 0) * 16384;
  const bf16* k2 = (const bf16*)(p.ws + OFF_PKB) + (size_t)(layer * 2 + 1) * 16384;
  float v1[16], v2[16];
  int i1[16], i2[16];
  {
    f32x4 s[8];
    pk_scores(k1, qp, s, g4, c16);
    pk_top16_sorted(s, g4, v1, i1);
  }
  {
    f32x4 s[8];
    pk_scores(k2, qp + 128, s, g4, c16);
    pk_top16_sorted(s, g4, v2, i2);
  }
  float v1s[4];
  int i1s[4];
#pragma unroll
  for (int j = 0; j < 4; ++j) {
    v1s[j] = (g4 == 0) ? v1[j] : (g4 == 1) ? v1[4 + j] : (g4 == 2) ? v1[8 + j] : v1[12 + j];
    i1s[j] = (g4 == 0) ? i1[j] : (g4 == 1) ? i1[4 + j] : (g4 == 2) ? i1[8 + j] : i1[12 + j];
  }
  float c0[16], c1[8], c2[5], c3[4];
  int e0[16], e1[8], e2[5], e3[4];
  const int cbase = g4 * 64;
#pragma unroll
  for (int b = 0; b < 16; ++b) {
    c0[b] = ((4 * g4 + 1) * (b + 1) <= 16) ? pk_key(v1s[0] + v2[b], 255 - (cbase + b), 0xFFu) : -INFINITY;
    e0[b] = i1s[0] * 128 + i2[b];
  }
#pragma unroll
  for (int b = 0; b < 8; ++b) {
    c1[b] = ((4 * g4 + 2) * (b + 1) <= 16) ? pk_key(v1s[1] + v2[b], 255 - (cbase + 16 + b), 0xFFu) : -INFINITY;
    e1[b] = i1s[1] * 128 + i2[b];
  }
#pragma unroll
  for (int b = 0; b < 5; ++b) {
    c2[b] = ((4 * g4 + 3) * (b + 1) <= 16) ? pk_key(v1s[2] + v2[b], 255 - (cbase + 32 + b), 0xFFu) : -INFINITY;
    e2[b] = i1s[2] * 128 + i2[b];
  }
#pragma unroll
  for (int b = 0; b < 4; ++b) {
    c3[b] = ((4 * g4 + 4) * (b + 1) <= 16) ? pk_key(v1s[3] + v2[b], 255 - (cbase + 48 + b), 0xFFu) : -INFINITY;
    e3[b] = i1s[3] * 128 + i2[b];
  }
  float vals[16];
  int eidx[16];
#pragma unroll
  for (int rd = 0; rd < 16; ++rd) {
    float w = fmaxf(fmaxf(c0[0], c1[0]), fmaxf(c2[0], c3[0]));
    w = fmaxf(w, shx(w, 16));
    w = fmaxf(w, shx(w, 32));
    vals[rd] = w;
    int e = -1;
    if (c0[0] == w) { e = e0[0]; shift_row(c0, e0); }
    if (c1[0] == w) { e = e1[0]; shift_row(c1, e1); }
    if (c2[0] == w) { e = e2[0]; shift_row(c2, e2); }
    if (c3[0] == w) { e = e3[0]; shift_row(c3, e3); }
    e = max(e, shx(e, 16));
    e = max(e, shx(e, 32));
    eidx[rd] = e;
  }
  float ex[16], sum = 0.f;
#pragma unroll
  for (int rd = 0; rd < 16; ++rd) { ex[rd] = expf(vals[rd] - vals[0]); sum += ex[rd]; }
  const float inv = 1.f / sum;
  if (g4 == 0) {
    int* pi = lds_idx ? (lds_idx + (c16 >> 3) * 128 + hh * 16) : ((int*)(p.ws + OFF_PEIDX) + tok * 128 + hh * 16);
    float* pg = lds_gate ? (lds_gate + (c16 >> 3) * 128 + hh * 16) : ((float*)(p.ws + OFF_PEG) + tok * 128 + hh * 16);
#pragma unroll
    for (int q = 0; q < 4; ++q) {
      *(int4*)(pi + q * 4) = int4{eidx[q * 4], eidx[q * 4 + 1], eidx[q * 4 + 2], eidx[q * 4 + 3]};
      *(float4*)(pg + q * 4) = float4{ex[q * 4] * inv, ex[q * 4 + 1] * inv, ex[q * 4 + 2] * inv, ex[q * 4 + 3] * inv};
    }
  }
}

typedef float f32x2_t __attribute__((ext_vector_type(2)));
DEV unsigned pack4_fp8(float a, float b, float c, float d) {
  int p = __builtin_amdgcn_cvt_pk_fp8_f32(a, b, 0, false);
  p = __builtin_amdgcn_cvt_pk_fp8_f32(c, d, p, true);
  return (unsigned)p;
}
DEV void unpack16_fp8(uint4 v, float* f) {
  f32x2_t r;
  r = __builtin_amdgcn_cvt_pk_f32_fp8((int)v.x, false); f[0] = r.x; f[1] = r.y;
  r = __builtin_amdgcn_cvt_pk_f32_fp8((int)v.x, true);  f[2] = r.x; f[3] = r.y;
  r = __builtin_amdgcn_cvt_pk_f32_fp8((int)v.y, false); f[4] = r.x; f[5] = r.y;
  r = __builtin_amdgcn_cvt_pk_f32_fp8((int)v.y, true);  f[6] = r.x; f[7] = r.y;
  r = __builtin_amdgcn_cvt_pk_f32_fp8((int)v.z, false); f[8] = r.x; f[9] = r.y;
  r = __builtin_amdgcn_cvt_pk_f32_fp8((int)v.z, true);  f[10] = r.x; f[11] = r.y;
  r = __builtin_amdgcn_cvt_pk_f32_fp8((int)v.w, false); f[12] = r.x; f[13] = r.y;
  r = __builtin_amdgcn_cvt_pk_f32_fp8((int)v.w, true);  f[14] = r.x; f[15] = r.y;
}
DEV void expert_cvt_item(const Params& p, int layer, int item) {
  const int lane = tidx() & 63, wave = tidx() >> 6;
  const int e = item * 4 + wave;
  unsigned char* dst = (unsigned char*)(p.ws + OFF_E8) + (size_t)e * 2048;
  float* sc = (float*)(p.ws + OFF_ESC) + (size_t)e * 2;
#pragma unroll
  for (int tb = 0; tb < 2; ++tb) {
    const float* src = (tb ? p.peer_v : p.peer_u) + ((size_t)layer * NEXP + e) * 1024 + lane * 16;
    float4 a = *(const float4*)src, b = *(const float4*)(src + 4), c = *(const float4*)(src + 8), d = *(const float4*)(src + 12);
    float mx = fmaxf(fmaxf(fmaxf(fabsf(a.x), fabsf(a.y)), fmaxf(fabsf(a.z), fabsf(a.w))),
                     fmaxf(fmaxf(fabsf(b.x), fabsf(b.y)), fmaxf(fabsf(b.z), fabsf(b.w))));
    mx = fmaxf(mx, fmaxf(fmaxf(fmaxf(fabsf(c.x), fabsf(c.y)), fmaxf(fabsf(c.z), fabsf(c.w))),
                         fmaxf(fmaxf(fabsf(d.x), fabsf(d.y)), fmaxf(fabsf(d.z), fabsf(d.w)))));
#pragma unroll
    for (int o = 32; o >= 1; o >>= 1) mx = fmaxf(mx, shx(mx, o));
    const float s = (mx > 0.f) ? 224.f / mx : 1.f;
    uint4 pk;
    pk.x = pack4_fp8(a.x * s, a.y * s, a.z * s, a.w * s);
    pk.y = pack4_fp8(b.x * s, b.y * s, b.z * s, b.w * s);
    pk.z = pack4_fp8(c.x * s, c.y * s, c.z * s, c.w * s);
    pk.w = pack4_fp8(d.x * s, d.y * s, d.z * s, d.w * s);
    *(uint4*)(dst + tb * 1024 + lane * 16) = pk;
    if (lane == 0) sc[tb] = 1.f / s;
  }
}

DEV float rdlane_f(float v, int l) { return __int_as_float(__builtin_amdgcn_readlane(__float_as_int(v), l)); }
DEV float dot16_f8(const float* hw, uint4 u) {
  float f[16];
  unpack16_fp8(u, f);
  float s = 0.f;
#pragma unroll
  for (int i = 0; i < 16; ++i) s += hw[i] * f[i];
  return s;
}
DEV void axpy16_f8(float* acc, float a, uint4 u) {
  float f[16];
  unpack16_fp8(u, f);
#pragma unroll
  for (int i = 0; i < 16; ++i) acc[i] += a * f[i];
}
#define PE_ROWPTR(idxv, j) (E8 + (size_t)__builtin_amdgcn_readlane(idxv, (j)) * 2048)
#define PE_LOAD8(P, idxv, j0, off)                                                                        \
  P##0 = *(const uint4*)(PE_ROWPTR(idxv, (j0)) + (off)); P##1 = *(const uint4*)(PE_ROWPTR(idxv, (j0) + 1) + (off)); \
  P##2 = *(const uint4*)(PE_ROWPTR(idxv, (j0) + 2) + (off)); P##3 = *(const uint4*)(PE_ROWPTR(idxv, (j0) + 3) + (off)); \
  P##4 = *(const uint4*)(PE_ROWPTR(idxv, (j0) + 4) + (off)); P##5 = *(const uint4*)(PE_ROWPTR(idxv, (j0) + 5) + (off)); \
  P##6 = *(const uint4*)(PE_ROWPTR(idxv, (j0) + 6) + (off)); P##7 = *(const uint4*)(PE_ROWPTR(idxv, (j0) + 7) + (off));
#define PE_DOTSET(P, j0, dv)                                                                              \
  {                                                                                                       \
    const float s0 = wave_sum(dot16_f8(hw, P##0)), s1 = wave_sum(dot16_f8(hw, P##1)),                     \
                s2 = wave_sum(dot16_f8(hw, P##2)), s3 = wave_sum(dot16_f8(hw, P##3)),                     \
                s4 = wave_sum(dot16_f8(hw, P##4)), s5 = wave_sum(dot16_f8(hw, P##5)),                     \
                s6 = wave_sum(dot16_f8(hw, P##6)), s7 = wave_sum(dot16_f8(hw, P##7));                     \
    if (lane == (j0)) dv = s0;                                                                            \
    if (lane == (j0) + 1) dv = s1;                                                                        \
    if (lane == (j0) + 2) dv = s2;                                                                        \
    if (lane == (j0) + 3) dv = s3;                                                                        \
    if (lane == (j0) + 4) dv = s4;                                                                        \
    if (lane == (j0) + 5) dv = s5;                                                                        \
    if (lane == (j0) + 6) dv = s6;                                                                        \
    if (lane == (j0) + 7) dv = s7;                                                                        \
  }
#define PE_AXPYSET(P, j0, av)                                                                             \
  {                                                                                                       \
    axpy16_f8(acc, rdlane_f(av, (j0)), P##0);     axpy16_f8(acc, rdlane_f(av, (j0) + 1), P##1);           \
    axpy16_f8(acc, rdlane_f(av, (j0) + 2), P##2); axpy16_f8(acc, rdlane_f(av, (j0) + 3), P##3);           \
    axpy16_f8(acc, rdlane_f(av, (j0) + 4), P##4); axpy16_f8(acc, rdlane_f(av, (j0) + 5), P##5);           \
    axpy16_f8(acc, rdlane_f(av, (j0) + 6), P##6); axpy16_f8(acc, rdlane_f(av, (j0) + 7), P##7);           \
  }
#define PE_DOT8(idxv, dv)                                                                                 \
  {                                                                                                       \
    uint4 pa0, pa1, pa2, pa3, pa4, pa5, pa6, pa7, pb0, pb1, pb2, pb3, pb4, pb5, pb6, pb7;                 \
    PE_LOAD8(pa, idxv, 0, 0)                                                                              \
    _Pragma("unroll 1") for (int g = 0; g < 4; ++g) {                                                     \
      const int j0 = g * 16;                                                                              \
      PE_LOAD8(pb, idxv, j0 + 8, 0)                                                                       \
      PE_DOTSET(pa, j0, dv)                                                                               \
      if (g < 3) { PE_LOAD8(pa, idxv, j0 + 16, 0) }                                                       \
      PE_DOTSET(pb, j0 + 8, dv)                                                                           \
    }                                                                                                     \
  }
#define PE_AXPY8(idxv, av)                                                                                \
  {                                                                                                       \
    uint4 pa0, pa1, pa2, pa3, pa4, pa5, pa6, pa7, pb0, pb1, pb2, pb3, pb4, pb5, pb6, pb7;                 \
    PE_LOAD8(pa, idxv, 0, 1024)                                                                           \
    _Pragma("unroll 1") for (int g = 0; g < 4; ++g) {                                                     \
      const int j0 = g * 16;                                                                              \
      PE_LOAD8(pb, idxv, j0 + 8, 1024)                                                                    \
      PE_AXPYSET(pa, j0, av)                                                                              \
      if (g < 3) { PE_LOAD8(pa, idxv, j0 + 16, 1024) }                                                    \
      PE_AXPYSET(pb, j0 + 8, av)                                                                          \
    }                                                                                                     \
  }
DEV void peer_expert_tok(const Params& p, int layer, size_t tok, float ga_scale, const int* pi, const float* pg) {
  const int lane = tidx() & 63;
  const int b = (int)(tok / S);
  const int idx_lo = pi[lane], idx_hi = pi[64 + lane];
  const float g_lo = pg[lane], g_hi = pg[64 + lane];
  const float* esc = (const float*)(p.ws + OFF_ESC);
  const float2 sc_lo = *(const float2*)(esc + (size_t)idx_lo * 2), sc_hi = *(const float2*)(esc + (size_t)idx_hi * 2);
  const bf16* hrow = (const bf16*)(p.ws + OFF_H) + tok * 1024 + lane * 16;
  float hw[16];
  unpack8(*(const uint4*)hrow, hw);
  unpack8(*(const uint4*)(hrow + 8), hw + 8);
  const unsigned char* E8 = (const unsigned char*)(p.ws + OFF_E8) + lane * 16;
  float d_lo = 0.f, d_hi = 0.f;
  PE_DOT8(idx_lo, d_lo)
  PE_DOT8(idx_hi, d_hi)
  const float act_lo = g_lo * gelu_tanh(d_lo * sc_lo.x) * sc_lo.y;
  const float act_hi = g_hi * gelu_tanh(d_hi * sc_hi.x) * sc_hi.y;
  float acc[16];
#pragma unroll
  for (int i = 0; i < 16; ++i) acc[i] = 0.f;
  PE_AXPY8(idx_lo, act_lo)
  PE_AXPY8(idx_hi, act_hi)
  const float* ga = (const float*)(p.ws + OFF_MOD) + (layer * 2 + b) * 6144 + 5120 + lane * 16;
  float* xr = p.out + tok * 1024 + lane * 16;
  float xn[16];
  float ss = 0.f;
#pragma unroll
  for (int q4 = 0; q4 < 4; ++q4) {
    float4 xo = *(float4*)(xr + q4 * 4);
    const float4 g4v = *(const float4*)(ga + q4 * 4);
    xo.x += ga_scale * g4v.x * acc[q4 * 4 + 0];
    xo.y += ga_scale * g4v.y * acc[q4 * 4 + 1];
    xo.z += ga_scale * g4v.z * acc[q4 * 4 + 2];
    xo.w += ga_scale * g4v.w * acc[q4 * 4 + 3];
    xn[q4 * 4] = xo.x; xn[q4 * 4 + 1] = xo.y; xn[q4 * 4 + 2] = xo.z; xn[q4 * 4 + 3] = xo.w;
    ss += xo.x * xo.x + xo.y * xo.y + xo.z * xo.z + xo.w * xo.w;
  }
#if PROBE_ANY || REP_MASK
#pragma unroll
  for (int q4 = 0; q4 < 4; ++q4)
    *(float4*)(xr + q4 * 4) = float4{xn[q4 * 4], xn[q4 * 4 + 1], xn[q4 * 4 + 2], xn[q4 * 4 + 3]};
  return;
#endif
  ss = wave_sum(ss);
  const float rn = 1.0f / sqrtf(ss * (1.0f / 1024.f) + 1e-6f);
  if (layer == 0) {
    const float* gn = p.g_attn + 1024 + lane * 16;
    const float* md = (const float*)(p.ws + OFF_MOD) + (2 + b) * 6144 + lane * 16;
    unsigned char* hq = (unsigned char*)(p.ws + OFF_H8) + tok * 1024 + lane * 16;
    float o[16];
    float mx = 0.f;
#pragma unroll
    for (int q4 = 0; q4 < 4; ++q4) {
      *(float4*)(xr + q4 * 4) = float4{xn[q4 * 4], xn[q4 * 4 + 1], xn[q4 * 4 + 2], xn[q4 * 4 + 3]};
      const float4 g4v = *(const float4*)(gn + q4 * 4);
      const float4 s4 = *(const float4*)(md + 1024 + q4 * 4);
      const float4 h4 = *(const float4*)(md + q4 * 4);
      o[q4 * 4] = xn[q4 * 4] * rn * g4v.x * (1.f + s4.x) + h4.x;
      o[q4 * 4 + 1] = xn[q4 * 4 + 1] * rn * g4v.y * (1.f + s4.y) + h4.y;
      o[q4 * 4 + 2] = xn[q4 * 4 + 2] * rn * g4v.z * (1.f + s4.z) + h4.z;
      o[q4 * 4 + 3] = xn[q4 * 4 + 3] * rn * g4v.w * (1.f + s4.w) + h4.w;
      mx = fmaxf(mx, fmaxf(fmaxf(fabsf(o[q4 * 4]), fabsf(o[q4 * 4 + 1])), fmaxf(fabsf(o[q4 * 4 + 2]), fabsf(o[q4 * 4 + 3]))));
    }
#pragma unroll
    for (int of = 32; of >= 1; of >>= 1) mx = fmaxf(mx, shx(mx, of));
    const unsigned qe = e8m0_of(mx);
    const float qs = e8m0_inv(qe);
    uint4 pk;
    pk.x = pack4_fp8(o[0] * qs, o[1] * qs, o[2] * qs, o[3] * qs);
    pk.y = pack4_fp8(o[4] * qs, o[5] * qs, o[6] * qs, o[7] * qs);
    pk.z = pack4_fp8(o[8] * qs, o[9] * qs, o[10] * qs, o[11] * qs);
    pk.w = pack4_fp8(o[12] * qs, o[13] * qs, o[14] * qs, o[15] * qs);
    *(uint4*)hq = pk;
    if (lane == 0) ((unsigned char*)(p.ws + OFF_H8S))[tok] = (unsigned char)qe;
  } else {
    const float* gf = p.g_final + lane * 16;
#pragma unroll
    for (int q4 = 0; q4 < 4; ++q4) {
      const float4 g4v = *(const float4*)(gf + q4 * 4);
      *(float4*)(xr + q4 * 4) = float4{xn[q4 * 4] * rn * g4v.x, xn[q4 * 4 + 1] * rn * g4v.y, xn[q4 * 4 + 2] * rn * g4v.z,
                                       xn[q4 * 4 + 3] * rn * g4v.w};
    }
  }
}

DEV void peer_expert_item2(const Params& p, int layer, int item, float ga_scale = 1.f) {
  const size_t tok = (size_t)item * 4 + (tidx() >> 6);
  peer_expert_tok(p, layer, tok, ga_scale, (const int*)(p.ws + OFF_PEIDX) + tok * 128, (const float*)(p.ws + OFF_PEG) + tok * 128);
}
DEV void peer_fused_item(const Params& p, int layer, int item, char* smem) {
  const int wave = tidx() >> 6;
  int* li = (int*)(smem + wave * 2048);
  float* lg = (float*)(smem + wave * 2048 + 1024);
  peer_topk_item3(p, layer, item, li, lg);
  asm volatile("s_waitcnt lgkmcnt(0)" ::: "memory");
  __builtin_amdgcn_wave_barrier();
  const size_t tok0 = (size_t)item * 8 + wave * 2;
  peer_expert_tok(p, layer, tok0, 1.f, li, lg);
  peer_expert_tok(p, layer, tok0 + 1, 1.f, li + 128, lg + 128);
  asm volatile("s_waitcnt lgkmcnt(0)" ::: "memory");
  __builtin_amdgcn_wave_barrier();
}
namespace g8 {
constexpr int BM = 256, BK = 64, HALF = 128, HTB = HALF * BK * 2, STAGE_BYTES = 8 * HTB, NXCD = 8, WGM = 8;
DEV int lds_byte(int r, int c) { const int st = (r >> 4) * 2 + (c >> 5), rr = r & 15, cc = c & 31, ob = rr * 64 + cc * 2; return st * 1024 + (ob ^ (((ob >> 9) & 1) << 5)); }
DEV void stage_rc(int b, int& R, int& C) { const int st = b / 1024, sb = b % 1024, swz = sb ^ (((sb >> 9) & 1) << 5); R = (st >> 1) * 16 + swz / 64; C = (st & 1) * 32 + (swz % 64) / 2; }
DEV int perm32(int rho) { const int n = rho >> 4, i = rho & 15; return 8 * (i >> 2) + 4 * n + (i & 3); }
struct Unit { int pm, pn; };
struct Gemm { const bf16* A; const bf16* Bt; int M, N, K; const unsigned char* sa = nullptr; const unsigned char* sb = nullptr; };
struct StaticOrder {
  int nM, nN, nwg, G, c;
  DEV void init(int M, int N, int G_, int c_) { nM = M / BM; nN = N / BM; nwg = nM * nN; G = G_; c = c_; }
  DEV bool next(int i, Unit& u) const {
    const long L = (long)i * G + c;
    if (L >= nwg) return false;
    int wgid = (int)L;
    { const int q = nwg / NXCD, r = nwg % NXCD, xcd = wgid % NXCD, off = wgid / NXCD; wgid = (xcd < r ? xcd * (q + 1) : r * (q + 1) + (xcd - r) * q) + off; }
    const int nig = WGM * nN, gid = wgid / nig, fm = gid * WGM, gsz = (nM - fm) < WGM ? (nM - fm) : WGM;
    u.pm = fm + ((wgid % nig) % gsz);
    u.pn = (wgid % nig) / gsz;
    return true;
  }
};
typedef int v4i32_t __attribute__((ext_vector_type(4)));
typedef int v8i32_t __attribute__((ext_vector_type(8)));
template <class Epi, bool F8 = false>
DEV void gemm_phase(LAS unsigned char* lds, const Gemm g, const StaticOrder& S, const Epi& E) {
  int tid = threadIdx.x;
  asm volatile("" : "+v"(tid));
  const int wid = __builtin_amdgcn_readfirstlane(tid >> 6), lane = tid & 63, wr = wid >> 2, wc = wid & 3, fr = lane & 15, fq = lane >> 4;
  const int K = g.K, nt = K / BK;
  unsigned voffA[2], voffB[2];
#pragma unroll
  for (int i = 0; i < 2; ++i) {
    int R, C;
    stage_rc(tid * 16 + i * 8192, R, C);
    const int Rb = Epi::PERM ? ((R & ~31) + perm32(R & 31)) : R;
    voffA[i] = (unsigned)(R * K + C) * 2u;
    voffB[i] = (unsigned)(Rb * K + C) * 2u;
  }
  const size_t kstep = (size_t)(BK * 2);
  const size_t hstep = (size_t)HALF * K * 2;
  const size_t tstep = 2 * hstep;
  const unsigned ldsw = (unsigned)wid * 1024u;
  const int aoff = lds_byte(wr * 64 + fr, fq * 8), boff = lds_byte(wc * 32 + fr, fq * 8);
#define PG8_SA(b, h) (((b) * 2 + (h)) * HTB)
#define PG8_SB(b, h) ((4 + (b) * 2 + (h)) * HTB)
#define PG8_STAGE(bufoff, gbase, voff) do { _Pragma("unroll") for (int _i = 0; _i < 2; ++_i) \
    __builtin_amdgcn_global_load_lds((const unsigned*)((const char*)(gbase) + (voff)[_i]), (LAS unsigned*)(lds + (bufoff) + ldsw + _i * 8192), 16, 0, 0); } while (0)
#define PG8_LD8(dst_, addr_) do { const v4i32_t lo_ = *(const LAS v4i32_t*)(addr_), hi_ = *(const LAS v4i32_t*)((addr_) + 1024); \
    dst_ = __builtin_shufflevector(lo_, hi_, 0, 1, 2, 3, 4, 5, 6, 7); } while (0)
#define PG8_LDA(dst, b, h) do { _Pragma("unroll") for (int m = 0; m < 4; ++m) PG8_LD8(dst[m], lds + PG8_SA(b, h) + aoff + m * 2048); } while (0)
#define PG8_LDB(dst, b, h) do { _Pragma("unroll") for (int n = 0; n < 2; ++n) PG8_LD8(dst[n], lds + PG8_SB(b, h) + boff + n * 2048); } while (0)
#define PG8_LO(x) __builtin_bit_cast(bf16x8, __builtin_shufflevector((x), (x), 0, 1, 2, 3))
#define PG8_HI(x) __builtin_bit_cast(bf16x8, __builtin_shufflevector((x), (x), 4, 5, 6, 7))
#define PG8_STR_(x) #x
#define PG8_STR(x) PG8_STR_(x)
#define PG8_MLO_0 0
#define PG8_MLO_1 1
#define PG8_MLO_2 0
#define PG8_MLO_3 1
#define PG8_MHI_0 0
#define PG8_MHI_1 0
#define PG8_MHI_2 1
#define PG8_MHI_3 1
#define PG8_M1(ai, bj, m, n, At, Bt) do { \
    if constexpr (F8) asm volatile("v_mfma_scale_f32_16x16x128_f8f6f4 %0, %1, %2, %0, %3, %4 op_sel:[" PG8_STR(n) "," PG8_STR(PG8_MLO_##m) ",0] op_sel_hi:[" PG8_STR(bj) "," PG8_STR(PG8_MHI_##m) ",0]" \
                                   : "+v"(acc[ai][bj][m][n]) : "v"(Bt[n]), "v"(At[m]), "v"(scB), "v"(scA[ai])); \
    else { acc[ai][bj][m][n] = __builtin_amdgcn_mfma_f32_16x16x32_bf16(PG8_LO(Bt[n]), PG8_LO(At[m]), acc[ai][bj][m][n], 0, 0, 0); \
           acc[ai][bj][m][n] = __builtin_amdgcn_mfma_f32_16x16x32_bf16(PG8_HI(Bt[n]), PG8_HI(At[m]), acc[ai][bj][m][n], 0, 0, 0); } } while (0)
#define PG8_MMA(ai, bj, At, Bt) do { __builtin_amdgcn_s_setprio(1); \
    PG8_M1(ai, bj, 0, 0, At, Bt); PG8_M1(ai, bj, 0, 1, At, Bt); PG8_M1(ai, bj, 1, 0, At, Bt); PG8_M1(ai, bj, 1, 1, At, Bt); \
    PG8_M1(ai, bj, 2, 0, At, Bt); PG8_M1(ai, bj, 2, 1, At, Bt); PG8_M1(ai, bj, 3, 0, At, Bt); PG8_M1(ai, bj, 3, 1, At, Bt); \
    __builtin_amdgcn_s_setprio(0); } while (0)
#define PG8_WAIT_V(n) asm volatile("s_waitcnt vmcnt(" #n ")" ::: "memory")
#define PG8_WAIT_L(n) asm volatile("s_waitcnt lgkmcnt(" #n ")" ::: "memory")
#define PG8_BAR __builtin_amdgcn_s_barrier()
#define PG8_SCHED __builtin_amdgcn_sched_barrier(0)
  Unit cur, nxt;
  int ui = 0;
  if (!S.next(0, cur)) return;
  f32x4 acc[2][2][4][2];
#pragma unroll
  for (int a = 0; a < 2; ++a)
#pragma unroll
    for (int b = 0; b < 2; ++b)
#pragma unroll
      for (int m = 0; m < 4; ++m)
#pragma unroll
        for (int n = 0; n < 2; ++n) acc[a][b][m][n] = (f32x4){0.f, 0.f, 0.f, 0.f};
  v8i32_t At[4], B0[2], B1[2];
  const char* cA = (const char*)g.A + (size_t)cur.pm * tstep;
  const char* cB = (const char*)g.Bt + (size_t)cur.pn * tstep;
  PG8_STAGE(PG8_SB(0, 0), cB, voffB); PG8_STAGE(PG8_SA(0, 0), cA, voffA); PG8_STAGE(PG8_SB(0, 1), cB + hstep, voffB); PG8_STAGE(PG8_SA(0, 1), cA + hstep, voffA);
  if (wr == 1) PG8_BAR;
  PG8_WAIT_V(4); PG8_BAR;
  PG8_STAGE(PG8_SB(1, 0), cB + kstep, voffB); PG8_STAGE(PG8_SA(1, 0), cA + kstep, voffA); PG8_STAGE(PG8_SB(1, 1), cB + hstep + kstep, voffB);
  PG8_WAIT_V(6); PG8_BAR;
  unsigned scA[2] = {0x7f7f7f7fu, 0x7f7f7f7fu}, scB = 0x7f7f7f7fu;
  for (;;) {
    if constexpr (F8) {
      const unsigned char* ta = g.sa + (size_t)cur.pm * BM + wr * 64 + fr;
      const unsigned char* tb = g.sb + (size_t)cur.pn * BM + wc * 32 + 8 * (fr >> 2) + (fr & 3);
      scA[0] = (unsigned)ta[0] | ((unsigned)ta[16] << 8) | ((unsigned)ta[32] << 16) | ((unsigned)ta[48] << 24);
      scA[1] = (unsigned)ta[HALF] | ((unsigned)ta[HALF + 16] << 8) | ((unsigned)ta[HALF + 32] << 16) | ((unsigned)ta[HALF + 48] << 24);
      scB = (unsigned)tb[0] | ((unsigned)tb[4] << 8) | ((unsigned)tb[HALF] << 16) | ((unsigned)tb[HALF + 4] << 24);
    }
    const bool has_next = S.next(ui + 1, nxt);
    const char* nA = has_next ? (const char*)g.A + (size_t)nxt.pm * tstep : cA;
    const char* nB = has_next ? (const char*)g.Bt + (size_t)nxt.pn * tstep : cB;
#pragma unroll 1
    for (int t = 0; t < nt; t += 2) {
      const bool last = (t == nt - 2);
      const char* a1 = cA + (size_t)(t + 1) * kstep;
      const char* a2 = last ? nA : cA + (size_t)(t + 2) * kstep;
      const char* b2 = last ? nB : cB + (size_t)(t + 2) * kstep;
      const char* a3 = a2 + kstep;
      const char* b3 = b2 + kstep;
      PG8_LDB(B0, 0, 0); PG8_SCHED; PG8_LDA(At, 0, 0); PG8_STAGE(PG8_SA(1, 1), a1 + hstep, voffA);
      PG8_WAIT_L(8); PG8_BAR; PG8_WAIT_L(0); PG8_MMA(0, 0, At, B0); PG8_BAR; PG8_SCHED;
      PG8_LDB(B1, 0, 1); PG8_STAGE(PG8_SB(0, 0), b2, voffB);
      PG8_BAR; PG8_WAIT_L(0); PG8_MMA(0, 1, At, B1); PG8_BAR;
      PG8_LDA(At, 0, 1); PG8_STAGE(PG8_SA(0, 0), a2, voffA);
      PG8_BAR; PG8_WAIT_L(0); PG8_MMA(1, 0, At, B0); PG8_BAR; PG8_SCHED;
      PG8_STAGE(PG8_SB(0, 1), b2 + hstep, voffB);
      PG8_WAIT_V(6); PG8_BAR; PG8_MMA(1, 1, At, B1); PG8_BAR;
      PG8_LDB(B0, 1, 0); PG8_SCHED; PG8_LDA(At, 1, 0); PG8_STAGE(PG8_SA(0, 1), a2 + hstep, voffA);
      PG8_WAIT_L(8); PG8_BAR; PG8_WAIT_L(0); PG8_MMA(0, 0, At, B0); PG8_BAR; PG8_SCHED;
      PG8_LDB(B1, 1, 1); PG8_STAGE(PG8_SB(1, 0), b3, voffB);
      PG8_BAR; PG8_WAIT_L(0); PG8_MMA(0, 1, At, B1); PG8_BAR;
      PG8_LDA(At, 1, 1); PG8_STAGE(PG8_SA(1, 0), a3, voffA);
      PG8_BAR; PG8_WAIT_L(0); PG8_MMA(1, 0, At, B0); PG8_BAR; PG8_SCHED;
      PG8_STAGE(PG8_SB(1, 1), b3 + hstep, voffB);
      PG8_WAIT_V(6); PG8_BAR; PG8_MMA(1, 1, At, B1); PG8_BAR;
    }
    if constexpr (F8) asm volatile("s_nop 15\n\ts_nop 15" ::: "memory");
    E(acc, cur, wr, wc, fr, fq);
    if (!has_next) break;
#pragma unroll
    for (int a = 0; a < 2; ++a)
#pragma unroll
      for (int b = 0; b < 2; ++b)
#pragma unroll
        for (int m = 0; m < 4; ++m)
#pragma unroll
          for (int n = 0; n < 2; ++n) acc[a][b][m][n] = (f32x4){0.f, 0.f, 0.f, 0.f};
    cur = nxt; cA = nA; cB = nB; ++ui;
  }
  PG8_WAIT_V(0);
  if (wr == 0) PG8_BAR;
  PG8_BAR;
#undef PG8_SA
#undef PG8_SB
#undef PG8_STAGE
#undef PG8_LDA
#undef PG8_LDB
#undef PG8_MMA
#undef PG8_M1
#undef PG8_LD8
#undef PG8_LO
#undef PG8_HI
#undef PG8_WAIT_V
#undef PG8_WAIT_L
#undef PG8_BAR
#undef PG8_SCHED
}
DEV unsigned cvt2(float lo, float hi) { unsigned r; asm volatile("v_cvt_pk_bf16_f32 %0, %1, %2" : "=v"(r) : "v"(lo), "v"(hi)); return r; }

struct EpiBf16 {
  static constexpr bool PERM = true;
  bf16* O; int ldc;
  DEV void operator()(const f32x4 (&acc)[2][2][4][2], const Unit& u, int wr, int wc, int fr, int fq) const {
    const int row0 = u.pm * BM + wr * 64 + fr, col0 = u.pn * BM + wc * 32 + 8 * fq;
#pragma unroll
    for (int ai = 0; ai < 2; ++ai)
#pragma unroll
      for (int m = 0; m < 4; ++m) {
        bf16* rowp = O + (size_t)(row0 + ai * HALF + m * 16) * ldc + col0;
#pragma unroll
        for (int bj = 0; bj < 2; ++bj) {
          const f32x4 v0 = acc[ai][bj][m][0], v1 = acc[ai][bj][m][1];
          u32x4_t w;
          w.x = cvt2(v0[0], v0[1]); w.y = cvt2(v0[2], v0[3]); w.z = cvt2(v1[0], v1[1]); w.w = cvt2(v1[2], v1[3]);
          *(u32x4_t*)(rowp + bj * HALF) = w;
        }
      }
  }
};
struct EpiResid {
  static constexpr bool PERM = false;
  const float* xin; float* out; const float* ga;
  DEV void operator()(const f32x4 (&acc)[2][2][4][2], const Unit& u, int wr, int wc, int fr, int fq) const {
    const int row0 = u.pm * BM + wr * 64 + fr, col0 = u.pn * BM + wc * 32 + 4 * fq;
    const int b = (u.pm * BM) / S;
    f32x4 gv[2][2];
#pragma unroll
    for (int bj = 0; bj < 2; ++bj)
#pragma unroll
      for (int n = 0; n < 2; ++n) gv[bj][n] = *(const f32x4*)(ga + b * 6144 + col0 + bj * HALF + n * 16);
#pragma unroll
    for (int ai = 0; ai < 2; ++ai)
#pragma unroll
      for (int m = 0; m < 4; ++m) {
        const size_t off = (size_t)(row0 + ai * HALF + m * 16) * 1024 + col0;
#pragma unroll
        for (int bj = 0; bj < 2; ++bj)
#pragma unroll
          for (int n = 0; n < 2; ++n) {
            const f32x4 xv = *(const f32x4*)(xin + off + bj * HALF + n * 16);
            *(f32x4*)(out + off + bj * HALF + n * 16) = xv + gv[bj][n] * acc[ai][bj][m][n];
          }
      }
  }
};
DEV float sig_(float x) { return 1.f / (1.f + __expf(-x)); }
template <bool SECOND>
struct EpiMerge {
  static constexpr bool PERM = true;
  bf16* Y; const bf16* proj; int gcol;
  DEV void operator()(const f32x4 (&acc)[2][2][4][2], const Unit& u, int wr, int wc, int fr, int fq) const {
    const int row0 = u.pm * BM + wr * 64 + fr, col0 = u.pn * BM + wc * 32 + 8 * fq;
#pragma unroll
    for (int ai = 0; ai < 2; ++ai)
#pragma unroll
      for (int m = 0; m < 4; ++m) {
        const size_t row = (size_t)(row0 + ai * HALF + m * 16);
#pragma unroll
        for (int bj = 0; bj < 2; ++bj) {
          const uint4 gq = *(const uint4*)(proj + row * PC + gcol + col0 + bj * HALF);
          float gf[8];
          unpack8(gq, gf);
          const f32x4 v0 = acc[ai][bj][m][0], v1 = acc[ai][bj][m][1];
          float o[8] = {sig_(gf[0]) * v0[0], sig_(gf[1]) * v0[1], sig_(gf[2]) * v0[2], sig_(gf[3]) * v0[3],
                        sig_(gf[4]) * v1[0], sig_(gf[5]) * v1[1], sig_(gf[6]) * v1[2], sig_(gf[7]) * v1[3]};
          bf16* yp = Y + row * 1024 + col0 + bj * HALF;
          if (SECOND) {
            float yf[8];
            unpack8(*(const uint4*)yp, yf);
#pragma unroll
            for (int j = 0; j < 8; ++j) o[j] += yf[j];
          }
          u32x4_t w;
          w.x = cvt2(o[0], o[1]); w.y = cvt2(o[2], o[3]); w.z = cvt2(o[4], o[5]); w.w = cvt2(o[6], o[7]);
          *(u32x4_t*)yp = w;
        }
      }
  }
};
struct EpiInproj {
  static constexpr bool PERM = true;
  char* ws;
  DEV void operator()(const f32x4 (&acc)[2][2][4][2], const Unit& u, int wr, int wc, int fr, int fq) const {
    const int b = (u.pm * BM) / S;
    const float* rope = (const float*)(ws + OFF_ROPE);
#pragma unroll
    for (int bj = 0; bj < 2; ++bj) {
      const int vcb = u.pn * BM + bj * HALF + wc * 32;
      if (vcb >= 4992) continue;
      const int vc0 = vcb & ~63, inh = vcb & 63;
      bf16* dbase; size_t dstride; bool roped = false; bool headmajor = false; int hh = 0, nh = 1;
      if (vc0 < 768) { dbase = (bf16*)(ws + OFF_PROJ) + vc0; dstride = PC; }
      else if (vc0 < 1280) {
        const int seg = (vc0 - 768) >> 7;
        const size_t off = (seg == 0) ? OFF_KSB : (seg == 1) ? OFF_VSB : (seg == 2) ? OFF_KWB : OFF_VWB;
        dbase = (bf16*)(ws + off); dstride = 64; headmajor = true; hh = ((vc0 - 768) >> 6) & 1; nh = 2;
        roped = (seg == 0) || (seg == 2);
      } else if (vc0 < 1792) { dbase = (bf16*)(ws + OFF_PROJ) + C_MQ + (vc0 - 1280); dstride = PC; roped = true; }
      else if (vc0 < 2816) {
        const int seg = (vc0 - 1792) >> 9;
        dbase = (bf16*)(ws + (seg ? OFF_MVB : OFF_MKB)); dstride = 64; headmajor = true; hh = ((vc0 - 1792) >> 6) & 7; nh = 8;
        roped = (seg == 0);
      } else if (vc0 < 4864) { dbase = (bf16*)(ws + OFF_PROJ) + C_GN + (vc0 - 2816); dstride = PC; }
      else { dbase = (bf16*)(ws + OFF_PROJ) + C_NG + (vc0 - 4864); dstride = PC; }
      const bool do_rope = roped && inh == 0;
#pragma unroll
      for (int ai = 0; ai < 2; ++ai)
#pragma unroll
        for (int m = 0; m < 4; ++m) {
          const int row = u.pm * BM + ai * HALF + wr * 64 + m * 16 + fr;
          const int t = row - b * S;
          const f32x4 v0 = acc[ai][bj][m][0], v1 = acc[ai][bj][m][1];
          float o[8] = {v0[0], v0[1], v0[2], v0[3], v1[0], v1[1], v1[2], v1[3]};
          if (do_rope) {
            float pv[8];
#pragma unroll
            for (int j = 0; j < 8; ++j) pv[j] = shx(o[j], 16);
            const f32x4 c0 = *(const f32x4*)(rope + (size_t)t * 16), c1 = *(const f32x4*)(rope + (size_t)t * 16 + 4);
            const f32x4 s0 = *(const f32x4*)(rope + (size_t)t * 16 + 8), s1 = *(const f32x4*)(rope + (size_t)t * 16 + 12);
            const float cs[8] = {c0[0], c0[1], c0[2], c0[3], c1[0], c1[1], c1[2], c1[3]};
            const float sn[8] = {s0[0], s0[1], s0[2], s0[3], s1[0], s1[1], s1[2], s1[3]};
            const float sg = (fq == 0) ? -1.f : 1.f;
#pragma unroll
            for (int j = 0; j < 8; ++j) o[j] = (fq < 2) ? (o[j] * cs[j] + sg * pv[j] * sn[j]) : o[j];
          }
          bf16* dp = headmajor ? (dbase + ((size_t)(b * nh + hh) * S + t) * 64 + inh + 8 * fq)
                               : (dbase + (size_t)row * dstride + inh + 8 * fq);
          u32x4_t w;
          w.x = cvt2(o[0], o[1]); w.y = cvt2(o[2], o[3]); w.z = cvt2(o[4], o[5]); w.w = cvt2(o[6], o[7]);
          *(u32x4_t*)dp = w;
        }
    }
  }
};
}

template <class F>
DEV void for_tiles_xcd(int MT, int NT, F f) {
  const int nb = vnb(), bid = vbid();
  if ((nb & 15) != 0) {
    for (int it = bid; it < MT * NT; it += nb) f(it / NT, it % NT);
    return;
  }
  const int xcd = (bid >> 1) & 7, slot = ((bid >> 4) << 1) | (bid & 1), nslot = nb >> 3;
  const int nj = (NT - xcd + 7) >> 3;
  for (int q = slot; q < MT * nj; q += nslot) f(q / nj, xcd + 8 * (q % nj));
}
constexpr int PH_PER_LAYER = 15;
enum { SP_NORM1 = 0, SP_INPROJ = 1, SP_COMPRESS = 2, SP_KMEAN = 3, SP_ATTN = 4, SP_MP0 = 5, SP_MM0 = 6, SP_MP1 = 7, SP_MM1 = 8,
       SP_MERGE = 9, SP_OUTPROJ = 10, SP_NORM2 = 11, SP_PEERQ = 12, SP_TOPK = 13, SP_EXPERT = 14 };
constexpr int N_REAL_PHASES = 1 + 2 * PH_PER_LAYER + 1;
constexpr int N_PHASES = N_REAL_PHASES + (PROBE_ANY ? 2 : 0);

DEV void run_phase(const Params& p, int ph, char* smem_raw, bool second_pass = false) {
#define SKIP_MOBA_SECOND (REP_NSA_ONLY && second_pass)
  LAS unsigned char* lds_all = (LAS unsigned char*)smem_raw;
  smem_raw += hidx() * SMEM_BYTES;
  float* smf = (float*)smem_raw;
  bf16* smh = (bf16*)smem_raw;
  const int nb = vnb(), bid = vbid();
  if (ph == 0) {
    for (int it = bid; it < PREP_ITEMS; it += nb) prep_item(p, it, smf);
    return;
  }
  if (ph == N_REAL_PHASES - 1) {
    for (int it = bid; it < T / 4; it += nb) final_norm_item(p.out, p.g_final, it);
    return;
  }
#if PROBE_ANY
  if (ph == N_REAL_PHASES) {
#if PROBE_PROJ
    {
      const unsigned char* Hh = (const unsigned char*)(p.ws + OFF_H8);
      const unsigned char* Wt = (const unsigned char*)(p.ws + OFF_WINT) + (size_t)1 * WN * 1024;
      const unsigned char* hsc = (const unsigned char*)(p.ws + OFF_H8S);
      const unsigned char* wsc = (const unsigned char*)(p.ws + OFF_WCS) + WN;
      const float* rope = (const float*)(p.ws + OFF_ROPE);
      float sd = 0.f, sr = 0.f;
      for (size_t i = (size_t)bid * 256 + tidx(); i < (size_t)(T / 64) * 4888; i += (size_t)nb * 256) {
        const int ts = (int)(i / 4888), vc = (int)(i % 4888);
        const int tok = ts * 64 + (ts % 61);
        const int b = tok / S, t = tok % S;
        auto rawdot = [&](int col) {
          float a = 0.f;
          for (int k = 0; k < 1024; ++k) {
            const f32x2_t hv = __builtin_amdgcn_cvt_pk_f32_fp8((int)Hh[(size_t)tok * 1024 + k], false);
            const f32x2_t wv = __builtin_amdgcn_cvt_pk_f32_fp8((int)Wt[(size_t)col * 1024 + k], false);
            a += hv.x * wv.x;
          }
          return a * __int_as_float((int)hsc[tok] << 23) * __int_as_float((int)wsc[col] << 23);
        };
        float v = rawdot(vc);
        bool roped = false;
        const bf16* dst;
        if (vc < 768) dst = (const bf16*)(p.ws + OFF_PROJ) + (size_t)tok * PC + vc;
        else if (vc < 1280) {
          const int seg = (vc - 768) >> 7, head = ((vc - 768) >> 6) & 1, d = vc & 63;
          const size_t off = (seg == 0) ? OFF_KSB : (seg == 1) ? OFF_VSB : (seg == 2) ? OFF_KWB : OFF_VWB;
          dst = (const bf16*)(p.ws + off) + ((size_t)(b * 2 + head) * S + t) * 64 + d;
          roped = (seg == 0 || seg == 2);
        } else if (vc < 1792) { dst = (const bf16*)(p.ws + OFF_PROJ) + (size_t)tok * PC + C_MQ + (vc - 1280); roped = true; }
        else if (vc < 2816) {
          const int seg = (vc - 1792) >> 9, head = ((vc - 1792) >> 6) & 7, d = vc & 63;
          dst = (const bf16*)(p.ws + (seg ? OFF_MVB : OFF_MKB)) + ((size_t)(b * 8 + head) * S + t) * 64 + d;
          roped = (seg == 0);
        } else if (vc < 4864) dst = (const bf16*)(p.ws + OFF_PROJ) + (size_t)tok * PC + C_GN + (vc - 2816);
        else dst = (const bf16*)(p.ws + OFF_PROJ) + (size_t)tok * PC + C_NG + (vc - 4864);
        const int d = vc & 63;
        if (roped && d < 16) {
          const float cs = rope[(size_t)t * 16 + (d & 7)], sn = rope[(size_t)t * 16 + 8 + (d & 7)];
          if (d < 8) { const float x2 = rawdot(vc + 8); v = v * cs - x2 * sn; }
          else { const float x1 = rawdot(vc - 8); v = v * cs + x1 * sn; }
        }
        const float got = bf2f(*dst);
        const bool is_r = roped && d < 16;
        if (PROBE_PROJ == 1 || (PROBE_PROJ == 2 && is_r) || (PROBE_PROJ == 3 && !is_r)) {
          sd += (got - v) * (got - v);
          sr += v * v;
        }
      }
      sd = wave_sum(sd); sr = wave_sum(sr);
      if ((tidx() & 63) == 0) {
        atomicAdd((float*)(p.ws + OFF_PROBE), sd);
        atomicAdd((float*)(p.ws + OFF_PROBE) + 1, sr);
      }
    }
#endif
#if PROBE_CMPR
    {
      float sd = 0.f, sr = 0.f;
      for (size_t i = (size_t)bid * 256 + tidx(); i < (size_t)2 * Bn * 1024 * 128; i += (size_t)nb * 256) {
        const size_t wh = i / ((size_t)Bn * 1024 * 128), r = i % ((size_t)Bn * 1024 * 128);
        const int c = (int)((r / 128) % 1024);
        if (c < 1023) {
          const float a = ((const float*)(p.ws + (wh ? OFF_VCC : OFF_KCC)))[r];
          const float y = ((const float*)(p.ws + OFF_CMP))[i];
          sd += (a - y) * (a - y);
          sr += y * y;
        }
      }
      sd = wave_sum(sd); sr = wave_sum(sr);
      if ((tidx() & 63) == 0) {
        atomicAdd((float*)(p.ws + OFF_PROBE), sd);
        atomicAdd((float*)(p.ws + OFF_PROBE) + 1, sr);
      }
    }
#endif
#if PROBE_MOBA
    probe_accum_bf16(p, (const bf16*)(p.ws + OFF_OMOBA), (const bf16*)(p.ws + OFF_CMP), (size_t)S * 512, smf);
#endif
#if PROBE_NSA == 8
    {
      const float* impn = (const float*)(p.ws + OFF_OMOBA);
      const float* impm = impn + (size_t)S * 256;
      const int* seld = (const int*)(p.ws + OFF_CMP);
      float sd = 0.f, sr = 0.f, bad = 0.f;
      for (int t = bid * 256 + tidx(); t < S; t += nb * 256) {
        const int cur = t >> 6;
        for (int n = 0; n < 256; ++n) {
          float a = impm[(size_t)t * 256 + n], r = impn[(size_t)t * 256 + n];
          sd += (a - r) * (a - r);
          sr += r * r;
        }
        unsigned want[8] = {0, 0, 0, 0, 0, 0, 0, 0}, got[8] = {0, 0, 0, 0, 0, 0, 0, 0};
        for (int j = 0; j < 16; ++j) {
          int v = seld[(size_t)t * 16 + j];
          if (v >= 0 && v < 256) {
            for (int w = 0; w < 8; ++w) if ((v >> 5) == w) got[w] |= 1u << (v & 31);
          }
        }
        if (cur < 16) {
          for (int n = 0; n <= cur; ++n) want[0] |= 1u << n;
        } else {
          want[0] |= 1u;
          for (int w = 0; w < 8; ++w) {
            if (((cur - 1) >> 5) == w) want[w] |= 1u << ((cur - 1) & 31);
            if ((cur >> 5) == w) want[w] |= 1u << (cur & 31);
          }
          for (int j = 0; j < 13; ++j) {
            float best = -1.f;
            int bi = 1;
            for (int n = 1; n <= cur - 2; ++n) {
              bool taken = false;
              for (int w = 0; w < 8; ++w) if ((n >> 5) == w) taken = (want[w] >> (n & 31)) & 1u;
              float v = impm[(size_t)t * 256 + n];
              if (!taken && v > best) { best = v; bi = n; }
            }
            for (int w = 0; w < 8; ++w) if ((bi >> 5) == w) want[w] |= 1u << (bi & 31);
          }
        }
        bool same = true;
        for (int w = 0; w < 8; ++w) same = same && (want[w] == got[w]);
        if (!same) bad += 1.f;
      }
      sd = wave_sum(sd); sr = wave_sum(sr); bad = wave_sum(bad);
      if ((tidx() & 63) == 0) {
        atomicAdd((float*)(p.ws + OFF_PROBE), sd);
        atomicAdd((float*)(p.ws + OFF_PROBE) + 1, sr);
        atomicAdd((float*)(p.ws + OFF_PROBE) + 2, bad);
      }
    }
#elif PROBE_NSA
    probe_accum_bf16(p, (const bf16*)(p.ws + OFF_ONSA), (const bf16*)(p.ws + OFF_CMP), (size_t)S * 512, smf);
#endif
    return;
  }
  if (ph == N_REAL_PHASES + 1) {
    probe_apply(p);
    return;
  }
#endif
  const int layer = (ph - 1) / PH_PER_LAYER, sub = (ph - 1) % PH_PER_LAYER;
  const float* mod = (const float*)(p.ws + OFF_MOD) + (size_t)layer * 2 * 6144;
  const float* xin = (layer == 0) ? p.x : p.out;
  bf16* H = (bf16*)(p.ws + OFF_H);
  bf16* PROJ = (bf16*)(p.ws + OFF_PROJ);
#if PROBE_ANY
  if (sub >= SP_MERGE) {
    if (sub == SP_OUTPROJ && layer == 0)
      for (size_t i = (size_t)bid * 256 + tidx(); i < (size_t)T * 1024; i += (size_t)nb * 256) p.out[i] = p.x[i];
    return;
  }
#endif
  switch (sub) {
    case SP_NORM1:
      for (int it = bid; it < T / 4; it += nb)
        norm8_item(xin, p.g_attn + layer * 1024, mod + 1024, mod + 0, (unsigned char*)(p.ws + OFF_H8), (unsigned char*)(p.ws + OFF_H8S), it);
      if (layer == 0)
        for (int it = bid; it < WQ8_ITEMS; it += nb) wq8_item(p, it, smf);
      break;
    case SP_INPROJ: {
      g8::StaticOrder so;
      so.init(T, WN, (int)gridDim.x, (int)blockIdx.x);
      g8::gemm_phase<g8::EpiInproj, true>(lds_all, g8::Gemm{(const bf16*)(p.ws + OFF_H8), (const bf16*)(p.ws + OFF_WINT + (size_t)layer * WN * 1024), T, WN, 512,
                                                             (const unsigned char*)(p.ws + OFF_H8S), (const unsigned char*)(p.ws + OFF_WCS) + (size_t)layer * WN},
                                          so, g8::EpiInproj{p.ws});
    } break;
    case SP_COMPRESS:
      for (int it = bid; it < 512 + 1024; it += nb) {
        if (it < 512) compress_mfma_item(p, layer, it, smem_raw);
        else kmean_item(p, it - 512, smf);
      }
#if PROBE_CMPR
      if (layer == 1)
        for (int it = bid; it < 1024; it += nb) compress_item(p, layer, it, smf);
#endif
      break;
    case SP_KMEAN:
#if PROBE_NSA
      if (layer == 1)
        for (int it = bid; it < 512; it += nb) n1_item(p, layer, it, smf);
#endif
      break;
    case SP_ATTN:
      {
        constexpr int MNI = 2;
        constexpr int NMOBA = 16 * (S / (64 * MNI));
        constexpr int NNI = 2;
        constexpr int NNSA = 4 * (S / (16 * NNI));
        const bool do_nsa = !PROBE_ANY || PROBE_NSA, do_moba = (!PROBE_ANY || PROBE_MOBA) && PROBE_NSA != 8;
        {
          constexpr int NCH = S / (16 * NNI);
          const bool affine = nb >= 8;
          const int grp = bid & 7, bk = grp & 3, sub = grp >> 2;
          const int i0 = affine ? (bid >> 3) : bid;
          const int istride = affine ? ((nb - grp + 7) >> 3) : nb;
          const int icount = affine ? (NCH / 2) : NNSA;
          if (do_nsa)
            for (int i = i0; i < icount; i += istride)
              nsa_item<NNI>(p, affine ? (((2 * i + sub) << 2) | bk) : i, smem_raw, (bf16*)(p.ws + OFF_ONSA));
          if (do_moba && !SKIP_MOBA_SECOND)
            for (int it = bid; it < NMOBA; it += nb) moba_gate_item<MNI>(p, it);
        }
#if PROBE_NSA && PROBE_NSA != 8
        if (layer == 1)
          for (int it = bid; it < 512; it += nb) n23_item(p, layer, it);
#endif
#if PROBE_MOBA
        if (layer == 1) {
          for (int it = bid; it < 512; it += nb) moba_item(p, layer, it);
        }
#endif
      }
      break;
    case SP_MP0:
    case SP_MP1:
      if ((!PROBE_ANY || PROBE_MOBA) && PROBE_NSA != 8)
        for (int it = bid; it < 8 * 63 * 8; it += nb) moba_part_item2<2>(p, sub == SP_MP1 ? 1 : 0, it, smem_raw);
      break;
    case SP_MM0:
    case SP_MM1:
      if ((!PROBE_ANY || PROBE_MOBA) && PROBE_NSA != 8)
        for (int it = bid; it < 8 * (S / 128); it += nb)
          moba_merge_item<2>(p, sub == SP_MM1 ? 1 : 0, it, smem_raw, (bf16*)(p.ws + OFF_OMOBA));
      break;
    case SP_MERGE:
      {
        g8::StaticOrder so;
        so.init(T, 1024, (int)gridDim.x, (int)blockIdx.x);
        g8::gemm_phase(lds_all, g8::Gemm{(const bf16*)(p.ws + OFF_ONSA), (const bf16*)(p.ws + OFF_WUPN) + (size_t)layer * 1024 * 512, T, 1024, 512}, so,
                       g8::EpiMerge<false>{H, PROJ, C_GN});
        g8::gemm_phase(lds_all, g8::Gemm{(const bf16*)(p.ws + OFF_OMOBA), (const bf16*)(p.ws + OFF_WUPM) + (size_t)layer * 1024 * 512, T, 1024, 512}, so,
                       g8::EpiMerge<true>{H, PROJ, C_GM});
      }
      break;
    case SP_OUTPROJ: {
      const bf16* W = (const bf16*)(p.ws + OFF_WOUT) + (size_t)layer * 1024 * 1024;
      const float* ga1 = mod + 2048;
      g8::StaticOrder so;
      so.init(T, 1024, (int)gridDim.x, (int)blockIdx.x);
      g8::gemm_phase(lds_all, g8::Gemm{H, W, T, 1024, 1024}, so, g8::EpiResid{xin, p.out, ga1});
    } break;
    case SP_NORM2:
      for (int it = bid; it < T / 4 + NEXP / 4; it += nb) {
        if (it < T / 4) norm_item(p.out, p.g_ffn + layer * 1024, mod + 4096, mod + 3072, H, it);
        else expert_cvt_item(p, layer, it - T / 4);
      }
      break;
    case SP_PEERQ: {
      const bf16* W = (const bf16*)(p.ws + OFF_WQ) + (size_t)layer * 2048 * 1024;
      bf16* QP = (bf16*)(p.ws + OFF_QP);
      g8::StaticOrder so;
      so.init(T, 2048, (int)gridDim.x, (int)blockIdx.x);
      g8::gemm_phase(lds_all, g8::Gemm{H, W, T, 2048, 1024}, so, g8::EpiBf16{QP, 2048});
    } break;
    case SP_TOPK:
#if REP_MASK
      for (int it = bid; it < T / 8; it += nb) peer_topk_item3(p, layer, it);
#endif
      break;
    case SP_EXPERT:
#if REP_MASK
      for (int it = bid; it < T / 4; it += nb) peer_expert_item2(p, layer, it, second_pass ? 0.f : 1.f);
#else
      for (int it = bid; it < T / 8; it += nb) peer_fused_item(p, layer, it, smem_raw);
#endif
      break;
  }
}

#define MEGA_LB __launch_bounds__(512, 2)
__global__ void MEGA_LB mega_kernel(Params p, int ph_lo, int ph_hi) {
  __shared__ __attribute__((aligned(16))) char smem_raw[2 * SMEM_BYTES + 16];
  volatile LAS unsigned* xbst = (volatile LAS unsigned*)(smem_raw + 2 * SMEM_BYTES);
  if (threadIdx.x == 0) { xbst[0] = 0u; xbst[1] = 0u; xbst[2] = 0u; xbst[3] = 0u; }
  __syncthreads();
  XcdBarrier xb = xcd_barrier_post((unsigned*)(p.ws + OFF_BAR), xbst);
  for (int ph = ph_lo; ph < ph_hi; ++ph) {
#if !PROBE_ANY && !REP_MASK
    if (ph == N_REAL_PHASES - 1 || ph == 1 + PH_PER_LAYER || (ph >= 1 && (ph - 1) % PH_PER_LAYER == SP_KMEAN) ||
        (ph >= 1 && (ph - 1) % PH_PER_LAYER == SP_TOPK))
      continue;
#endif
#if REP_MASK
    const int nrep = (ph >= 1 && ph < N_REAL_PHASES - 1 && ((REP_MASK >> ((ph - 1) % PH_PER_LAYER)) & 1)) ? 2 : 1;
    for (int rep = 0; rep < nrep; ++rep) {
      if (rep) xcd_barrier(xb);
      run_phase(p, ph, smem_raw, rep != 0);
    }
#else
    run_phase(p, ph, smem_raw);
#endif
    if (ph + 1 < ph_hi) {
      if (ph == ph_lo) cg::this_grid().sync();
      else xcd_barrier(xb);
    }
  }
}

extern "C" void kernel_launch(void* const* d_in, const int* in_sizes, int n_in, void* d_out, int out_size, void* d_ws,
                              size_t ws_size, hipStream_t stream) {
  if (ws_size < WS_TOTAL) {
    fprintf(stderr, "workspace too small: %zu < %zu\n", ws_size, (size_t)WS_NEED);
    return;
  }
  Params p{};
  p.x = (const float*)d_in[0]; p.c = (const float*)d_in[1]; p.w_ada = (const float*)d_in[2];
  p.b_ada = (const float*)d_in[3]; p.g_attn = (const float*)d_in[4]; p.g_ffn = (const float*)d_in[5];
  p.w_in = (const float*)d_in[6]; p.cmp_pe = (const float*)d_in[7]; p.cmp_w1 = (const float*)d_in[8];
  p.cmp_w2 = (const float*)d_in[9]; p.w_up_nsa = (const float*)d_in[10]; p.w_up_moba = (const float*)d_in[11];
  p.w_out = (const float*)d_in[12]; p.peer_wq = (const float*)d_in[13]; p.peer_k1 = (const float*)d_in[14];
  p.peer_k2 = (const float*)d_in[15]; p.peer_u = (const float*)d_in[16]; p.peer_v = (const float*)d_in[17];
  p.g_final = (const float*)d_in[18];
  p.out = (float*)d_out;
  p.ws = (char*)d_ws;
  static int grid_blocks = 0;
  if (!grid_blocks) {
    int dev = 0, cus = 0, per_cu = 0;
    hipGetDevice(&dev);
    hipDeviceGetAttribute(&cus, hipDeviceAttributeMultiprocessorCount, dev);
    hipOccupancyMaxActiveBlocksPerMultiprocessor(&per_cu, mega_kernel, 512, 0);
    if (per_cu < 1) per_cu = 1;
    if (per_cu > 1) per_cu = 1;
    grid_blocks = cus * per_cu;
  }
  hipMemsetAsync((char*)d_ws + OFF_BAR, 0, BAR_BYTES, stream);
  int ph_lo = 0, ph_hi = N_PHASES;
  void* args[] = {(void*)&p, (void*)&ph_lo, (void*)&ph_hi};
  hipError_t e = hipLaunchCooperativeKernel((const void*)mega_kernel, dim3(grid_blocks), dim3(512), args, 0, stream);
  if (e != hipSuccess) fprintf(stderr, "cooperative launch failed: %s (grid %d)\n", hipGetErrorString(e), grid_blocks);
}
```

```cpp
#include <hip/hip_runtime.h>
#include <hip/hip_bf16.h>
#include <hip/hip_cooperative_groups.h>
#include <cstdio>
#include <cstdint>
namespace cg = cooperative_groups;

#define DEV __device__ __forceinline__
typedef unsigned short bf16;
using bf16x8 = __attribute__((ext_vector_type(8))) short;
using f32x4 = __attribute__((ext_vector_type(4))) float;

constexpr int Bn = 2, S = 16384, T = Bn * S, D = 1024;
constexpr int PC = 3456;
constexpr int WN = 5120;
constexpr int C_NQ = 0, C_KC = 512, C_VC = 640, C_MQ = 768, C_GN = 1280, C_GM = 2304, C_NG = 3328;
constexpr int NEXP = 16384;

constexpr size_t al(size_t x) { return (x + 255) & ~size_t(255); }
constexpr size_t OFF_MOD = 0;
constexpr size_t OFF_ROPE = al(OFF_MOD + 2 * 2 * 6144 * 4);
constexpr size_t OFF_PEB = al(OFF_ROPE + (size_t)S * 16 * 4);
constexpr size_t OFF_WINT = al(OFF_PEB + 2 * 2 * 128 * 4);
constexpr size_t OFF_WUPN = al(OFF_WINT + 2ull * WN * 1024 * 2);
constexpr size_t OFF_WUPM = al(OFF_WUPN + 2ull * 1024 * 512 * 2);
constexpr size_t OFF_WOUT = al(OFF_WUPM + 2ull * 1024 * 512 * 2);
constexpr size_t OFF_WQ = al(OFF_WOUT + 2ull * 1024 * 1024 * 2);
constexpr size_t OFF_KCC = al(OFF_WQ + 2ull * 2048 * 1024 * 2);
constexpr size_t OFF_VCC = al(OFF_KCC + 2ull * 1024 * 128 * 4);
constexpr size_t OFF_SEL = al(OFF_VCC + 2ull * 1024 * 128 * 4);
constexpr size_t OFF_KMEAN = al(OFF_SEL + 2ull * 2 * S * 16 * 4);
constexpr size_t OFF_KMHL = al(OFF_KMEAN + 2ull * 8 * 64 * 64 * 4);
constexpr size_t OFF_KCB = al(OFF_KMHL + 2ull * 2 * 8 * 64 * 64 * 2);
constexpr size_t OFF_VCB = al(OFF_KCB + 2ull * 2 * 1024 * 64 * 2);
constexpr size_t OFF_PKB = al(OFF_VCB + 2ull * 2 * 1024 * 64 * 2);
constexpr size_t OFF_W1T = al(OFF_PKB + 2ull * 2 * 128 * 128 * 2);
constexpr size_t OFF_BAR = al(OFF_W1T + 4ull * 128 * 2048 * 2);
constexpr size_t BAR_BYTES = 3456 * 4;
constexpr size_t OFF_PROBE = al(OFF_BAR + BAR_BYTES);
constexpr size_t OFF_H = al(OFF_PROBE + 256);
constexpr size_t OFF_WCS = OFF_WINT + 2ull * WN * 1024;
constexpr size_t OFF_ONSA = al(OFF_H + (size_t)T * 1024 * 2);
constexpr size_t OFF_OMOBA = al(OFF_ONSA + (size_t)T * 512 * 2);
constexpr size_t OFF_H8 = OFF_ONSA;
constexpr size_t OFF_H8S = OFF_OMOBA;
constexpr size_t OFF_PROJ = al(OFF_OMOBA + (size_t)T * 512 * 2);
constexpr size_t KV2_BYTES = (size_t)Bn * 2 * S * 64 * 2, KV8_BYTES = (size_t)Bn * 8 * S * 64 * 2;
constexpr size_t OFF_KSB = al(OFF_PROJ + (size_t)T * PC * 2);
constexpr size_t OFF_VSB = OFF_KSB + KV2_BYTES;
constexpr size_t OFF_KWB = OFF_VSB + KV2_BYTES;
constexpr size_t OFF_VWB = OFF_KWB + KV2_BYTES;
constexpr size_t OFF_MKB = OFF_VWB + KV2_BYTES;
constexpr size_t OFF_MVB = OFF_MKB + KV8_BYTES;
constexpr int MLIST_PER_BH = 63 * S - 128 * 63 * 64;
constexpr size_t OFF_MLIST = OFF_MVB + KV8_BYTES;
constexpr size_t OFF_MCNT = al(OFF_MLIST + (size_t)Bn * 8 * MLIST_PER_BH * 2);
constexpr size_t OFF_KS8 = al(OFF_MCNT + (size_t)Bn * 8 * 64 * 4);
constexpr size_t OFF_VT8 = OFF_KS8 + (size_t)Bn * 2 * S * 64;
constexpr size_t WS_NEED = OFF_VT8 + (size_t)Bn * 2 * S * 64;
constexpr size_t PROJ_BYTES = (size_t)T * PC * 2;
constexpr size_t OFF_MPO = OFF_H;
constexpr size_t OFF_MPML = OFF_H + (size_t)8 * S * 3 * 64 * 2;
static_assert((size_t)8 * S * 3 * 64 * 2 + (size_t)8 * S * 3 * 8 <= (size_t)T * 1024 * 2, "moba partials must fit the H region");
constexpr size_t OFF_QP = OFF_PROJ;
constexpr size_t OFF_PEIDX = al(OFF_QP + (size_t)T * 2048 * 2);
constexpr size_t OFF_PEG = al(OFF_PEIDX + (size_t)T * 128 * 4);
constexpr size_t OFF_E8 = al(OFF_PEG + (size_t)T * 128 * 4);
constexpr size_t OFF_ESC = al(OFF_E8 + (size_t)NEXP * 2048);
static_assert(OFF_ESC + (size_t)NEXP * 2 * 4 <= OFF_PROJ + PROJ_BYTES, "peer alias overflow");
static_assert(WS_NEED <= 536870912ull, "workspace too big");
#ifndef PROBE_MOBA
#define PROBE_MOBA 0
#endif
constexpr size_t OFF_CMP = PROBE_MOBA ? OFF_ONSA : OFF_MLIST;
#ifndef REP_NSA_ONLY
#define REP_NSA_ONLY 0
#endif
#ifndef REP_NSA_PART
#define REP_NSA_PART 0
#endif
#ifndef REP_MASK
#define REP_MASK 0
#endif
#ifndef PROBE_MOBA
#define PROBE_MOBA 0
#endif
#ifndef PROBE_NSA
#define PROBE_NSA 0
#endif
#ifndef PROBE_CMPR
#define PROBE_CMPR 0
#endif
#ifndef PROBE_PROJ
#define PROBE_PROJ 0
#endif
#define PROBE_ANY (PROBE_MOBA || PROBE_NSA || PROBE_CMPR || PROBE_PROJ)
constexpr size_t WS_TOTAL = WS_NEED;
static_assert(WS_TOTAL <= 536870912ull, "workspace too big (probe)");

struct Params {
  const float *x, *c, *w_ada, *b_ada, *g_attn, *g_ffn, *w_in, *cmp_pe, *cmp_w1, *cmp_w2, *w_up_nsa, *w_up_moba, *w_out,
      *peer_wq, *peer_k1, *peer_k2, *peer_u, *peer_v, *g_final;
  float* out;
  char* ws;
};

constexpr int SMEM_BYTES = 74 * 1024;

DEV int tidx() {
  int t = threadIdx.x & 255;
  asm volatile("" : "+v"(t));
  return t;
}
DEV int hidx() { return __builtin_amdgcn_readfirstlane((int)(threadIdx.x >> 8)); }
DEV int vbid() { return (int)blockIdx.x * 2 + hidx(); }
DEV int vnb() { return (int)gridDim.x * 2; }
#define MFMA16B(a, b, c) __builtin_amdgcn_mfma_f32_16x16x32_bf16(a, b, c, 0, 0, 0)
DEV unsigned cvtpk_(float lo, float hi) {
  unsigned r;
  asm("v_cvt_pk_bf16_f32 %0, %1, %2" : "=v"(r) : "v"(lo), "v"(hi));
  return r;
}
DEV float bf2f(bf16 h) { return __uint_as_float(((unsigned)h) << 16); }
DEV bf16 f2bf(float f) {
  unsigned u = __float_as_uint(f);
  u += 0x7fffu + ((u >> 16) & 1u);
  return (bf16)(u >> 16);
}
DEV float gelu_tanh(float x) {
  float u = 0.7978845608028654f * (x + 0.044715f * x * x * x);
  return 0.5f * x * (1.f + tanhf(u));
}
DEV float sigmoidf_(float x) { return 1.f / (1.f + expf(-x)); }
DEV void unpack8(uint4 v, float* f) {
  f[0] = __uint_as_float(v.x << 16); f[1] = __uint_as_float(v.x & 0xffff0000u);
  f[2] = __uint_as_float(v.y << 16); f[3] = __uint_as_float(v.y & 0xffff0000u);
  f[4] = __uint_as_float(v.z << 16); f[5] = __uint_as_float(v.z & 0xffff0000u);
  f[6] = __uint_as_float(v.w << 16); f[7] = __uint_as_float(v.w & 0xffff0000u);
}
DEV float dot64_bf(const float* q, const bf16* row) {
  float s = 0.f;
#pragma unroll
  for (int i = 0; i < 8; ++i) {
    float f[8];
    unpack8(*(const uint4*)(row + i * 8), f);
#pragma unroll
    for (int j = 0; j < 8; ++j) s += q[i * 8 + j] * f[j];
  }
  return s;
}
DEV void axpy64_bf(float* o, float a, const bf16* row) {
#pragma unroll
  for (int i = 0; i < 8; ++i) {
    float f[8];
    unpack8(*(const uint4*)(row + i * 8), f);
#pragma unroll
    for (int j = 0; j < 8; ++j) o[i * 8 + j] += a * f[j];
  }
}
DEV float dot64_f(const float* q, const float* row) {
  float s = 0.f;
#pragma unroll
  for (int i = 0; i < 16; ++i) {
    float4 v = *(const float4*)(row + i * 4);
    s += q[i * 4] * v.x + q[i * 4 + 1] * v.y + q[i * 4 + 2] * v.z + q[i * 4 + 3] * v.w;
  }
  return s;
}
DEV void axpy64_f(float* o, float a, const float* row) {
#pragma unroll
  for (int i = 0; i < 16; ++i) {
    float4 v = *(const float4*)(row + i * 4);
    o[i * 4] += a * v.x; o[i * 4 + 1] += a * v.y; o[i * 4 + 2] += a * v.z; o[i * 4 + 3] += a * v.w;
  }
}
DEV void load_q64(float* q, const bf16* p, float scale) {
#pragma unroll
  for (int i = 0; i < 8; ++i) unpack8(*(const uint4*)(p + i * 8), q + i * 8);
#pragma unroll
  for (int i = 0; i < 64; ++i) q[i] *= scale;
}
DEV int lane_id_() { return __builtin_amdgcn_mbcnt_hi(~0u, __builtin_amdgcn_mbcnt_lo(~0u, 0u)); }
DEV int shx(int v, int m) {
  if (m == 1) return __builtin_amdgcn_update_dpp(0, v, 0xB1, 0xF, 0xF, true);
  if (m == 2) return __builtin_amdgcn_update_dpp(0, v, 0x4E, 0xF, 0xF, true);
  if (m == 4) return __builtin_amdgcn_ds_swizzle(v, 0x101F);
  if (m == 8) return __builtin_amdgcn_update_dpp(0, v, 0x128, 0xF, 0xF, true);
  if (m == 16) return __builtin_amdgcn_ds_swizzle(v, 0x401F);
  auto rr = __builtin_amdgcn_permlane32_swap((unsigned)v, (unsigned)v, false, false);
  return (lane_id_() < 32) ? (int)rr[1] : (int)rr[0];
}
DEV unsigned shx(unsigned v, int m) { return (unsigned)shx((int)v, m); }
DEV float shx(float v, int m) { return __int_as_float(shx(__float_as_int(v), m)); }
DEV float wave_sum(float v) {
#pragma unroll
  for (int o = 32; o >= 1; o >>= 1) v += shx(v, o);
  return v;
}

#define XB_TMO      128
#define XB_XCNT(j)  (256  + 64 * (j))
#define XB_XSUB(j)  (1280 + 64 * (j))
#define XB_XGEN(j)  (2304 + 64 * (j))
#define XB_TOP      3328
#define XB_TOPGEN   3392
#define XCD_BAR_WORDS 3456
#define XB_SPIN_CAP (1u << 18)
#define LAS __attribute__((address_space(3)))

__device__ __forceinline__ unsigned xb_ld(unsigned* p)              { return __hip_atomic_load(p, __ATOMIC_RELAXED, __HIP_MEMORY_SCOPE_AGENT); }
__device__ __forceinline__ unsigned xb_add(unsigned* p, unsigned v) { return __hip_atomic_fetch_add(p, v, __ATOMIC_RELAXED, __HIP_MEMORY_SCOPE_AGENT); }
__device__ __forceinline__ unsigned xb_xcc_id() { return (unsigned)__builtin_amdgcn_s_getreg((3 << 11) | 20) & 0xFu; }
#define XB_SPIN(cond, bar) do { unsigned _sp = 0; while (cond) { __builtin_amdgcn_s_sleep(1); \
    if ((++_sp & 255u) == 0u) { if (xb_ld(&(bar)[XB_TMO])) break; if (_sp > XB_SPIN_CAP) { atomicAdd(&(bar)[XB_TMO], 1u); break; } } } } while (0)

struct XcdBarrier {
    unsigned* bar; unsigned x;
    volatile LAS unsigned* st;
};

__device__ __forceinline__ XcdBarrier xcd_barrier_post(unsigned* bar, volatile LAS unsigned* st) {
    XcdBarrier b; b.bar = bar; b.x = xb_xcc_id(); b.st = st;
    if (threadIdx.x == 0) (void)xb_add(&bar[XB_XCNT(b.x)], 1u);
    return b;
}
__device__ __forceinline__ void xcd_barrier_complete(unsigned* bar, unsigned x, unsigned& nloc, unsigned& nx) {
    const unsigned G = gridDim.x * gridDim.y * gridDim.z;
    unsigned sum, cnt, mine, sp = 0u;
    for (;;) {
        sum = 0u; cnt = 0u; mine = 0u;
#pragma unroll
        for (unsigned j = 0; j < 16; ++j) { const unsigned c = xb_ld(&bar[XB_XCNT(j)]); sum += c; cnt += (c > 0u) ? 1u : 0u; mine = (j == x) ? c : mine; }
        if (sum == G) break;
        __builtin_amdgcn_s_sleep(1);
        if ((++sp & 255u) == 0u) { if (xb_ld(&bar[XB_TMO])) break; if (sp > XB_SPIN_CAP) { atomicAdd(&bar[XB_TMO], 1u); break; } }
    }
    nloc = mine > 0u ? mine : 1u; nx = cnt > 0u ? cnt : 1u;
}

__device__ __forceinline__ void xcd_barrier(const XcdBarrier& b) {
    asm volatile("s_waitcnt vmcnt(0)" ::: "memory");
    __syncthreads();
    if (threadIdx.x == 0) {
        unsigned* bar = b.bar;
        __builtin_amdgcn_s_waitcnt(0);
        unsigned nloc = b.st[0], nx = b.st[1];
        if (nloc == 0u) { xcd_barrier_complete(bar, b.x, nloc, nx); b.st[0] = nloc; b.st[1] = nx; }
        const unsigned old = xb_add(&bar[XB_XSUB(b.x)], 1u);
        const unsigned gen = old / nloc;
        if (old + 1u == (gen + 1u) * nloc) {
            __builtin_amdgcn_fence(__ATOMIC_RELEASE, "agent");
            asm volatile("s_waitcnt vmcnt(0)" ::: "memory");
            const unsigned og = xb_add(&bar[XB_TOP], 1u);
            const unsigned tg = og / nx;
            if (og + 1u == (tg + 1u) * nx) xb_add(&bar[XB_TOPGEN], 1u);
            else XB_SPIN(xb_ld(&bar[XB_TOPGEN]) == tg, bar);
            __builtin_amdgcn_fence(__ATOMIC_ACQUIRE, "agent");
            xb_add(&bar[XB_XGEN(b.x)], 1u);
            asm volatile("s_waitcnt vmcnt(0)" ::: "memory");
        } else {
            XB_SPIN(xb_ld(&bar[XB_XGEN(b.x)]) == gen, bar);
            __builtin_amdgcn_fence(__ATOMIC_ACQUIRE, "agent");
            asm volatile("s_waitcnt vmcnt(0)" ::: "memory");
        }
    }
    __syncthreads();
}


DEV int win_col_map(int j) {
  if (j < 1280) return j;
  if (j < 4864) return j + 24;
  if (j < 4888) return j - 4864 + 1280;
  return -1;
}
DEV void tr_tile(const float* __restrict__ src, int ldsrc, int K, bf16* __restrict__ dst, int kt, int nt, bool remap,
                 float* sm) {
  const int tid = tidx();
#pragma unroll 4
  for (int i = 0; i < 16; ++i) {
    int r = i * 4 + (tid >> 6), cx = tid & 63;
    int j = nt * 64 + cx, k = kt * 64 + r;
    int oc = remap ? win_col_map(j) : j;
    sm[r * 65 + cx] = (oc >= 0) ? src[(size_t)k * ldsrc + oc] : 0.f;
  }
  __syncthreads();
#pragma unroll 4
  for (int i = 0; i < 16; ++i) {
    int n = i * 4 + (tid >> 6), kk = tid & 63;
    dst[(size_t)(nt * 64 + n) * K + kt * 64 + kk] = f2bf(sm[kk * 65 + n]);
  }
  __syncthreads();
}

DEV unsigned e8m0_of(float amax) {
  const unsigned bits = (unsigned)__float_as_int(amax * (1.f / 224.f));
  unsigned e = ((bits >> 23) & 255u) + ((bits & 0x7fffffu) ? 1u : 0u);
  return e < 1u ? 1u : (e > 253u ? 253u : e);
}
DEV float e8m0_inv(unsigned e) { return __int_as_float((int)((254u - e) << 23)); }
DEV unsigned pack4_fp8_(float a, float b, float c, float d) {
  int q = __builtin_amdgcn_cvt_pk_fp8_f32(a, b, 0, false);
  q = __builtin_amdgcn_cvt_pk_fp8_f32(c, d, q, true);
  return (unsigned)q;
}
DEV void wamax_item(const Params& p, int item) {
  const int l = item >> 7, part = item & 127;
  const size_t per = (size_t)1024 * 4888 / 128;
  const float4* src = (const float4*)(p.w_in + (size_t)l * 1024 * 4888 + (size_t)part * per);
  float m = 0.f;
  for (int i = tidx(); i < (int)(per / 4); i += 256) {
    const float4 v = src[i];
    m = fmaxf(m, fmaxf(fmaxf(fabsf(v.x), fabsf(v.y)), fmaxf(fabsf(v.z), fabsf(v.w))));
  }
#pragma unroll
  for (int o = 32; o >= 1; o >>= 1) m = fmaxf(m, shx(m, o));
  if ((tidx() & 63) == 0) atomicMax((unsigned*)(p.ws + OFF_BAR) + l, (unsigned)__float_as_int(m));
}
DEV void wq8_item(const Params& p, int item, float* sm) {
  const int tid = tidx();
  const int l = item / (80 * 16), r_ = item % (80 * 16);
  const int nt = r_ / 16, kt = r_ % 16;
  const float* src = p.w_in + (size_t)l * 1024 * 4888;
  unsigned char* dst = (unsigned char*)(p.ws + OFF_WINT) + (size_t)l * WN * 1024;
  const unsigned e = e8m0_of(__int_as_float((int)__hip_atomic_load((const unsigned*)(p.ws + OFF_BAR) + l, __ATOMIC_RELAXED, __HIP_MEMORY_SCOPE_AGENT)));
  const float s = e8m0_inv(e);
#pragma unroll 4
  for (int i = 0; i < 16; ++i) {
    const int r = i * 4 + (tid >> 6), cx = tid & 63;
    const int oc = win_col_map(nt * 64 + cx);
    sm[r * 65 + cx] = (oc >= 0) ? src[(size_t)(kt * 64 + r) * 4888 + oc] : 0.f;
  }
  __syncthreads();
  const int kq = tid & 15;
#pragma unroll
  for (int i = 0; i < 4; ++i) {
    const int n = i * 16 + (tid >> 4);
    const float v0 = sm[(kq * 4 + 0) * 65 + n], v1 = sm[(kq * 4 + 1) * 65 + n], v2 = sm[(kq * 4 + 2) * 65 + n], v3 = sm[(kq * 4 + 3) * 65 + n];
    *(unsigned*)(dst + (size_t)(nt * 64 + n) * 1024 + kt * 64 + kq * 4) = pack4_fp8_(v0 * s, v1 * s, v2 * s, v3 * s);
  }
  if (kt == 0 && tid < 64) ((unsigned char*)(p.ws + OFF_WCS))[(size_t)l * WN + nt * 64 + tid] = (unsigned char)e;
  __syncthreads();
}
constexpr int WQ8_ITEMS = 2 * 80 * 16;
constexpr int PREP_TR_WIN = 2 * 128;
constexpr int PREP_TR_UPN = 2 * 16 * 8;
constexpr int PREP_TR_UPM = 2 * 16 * 8;
constexpr int PREP_TR_OUT = 2 * 16 * 16;
constexpr int PREP_TR_WQ = 2 * 32 * 16;
constexpr int PREP_ROPE = 512;
constexpr int PREP_MOD = 384;
constexpr int PREP_PEB = 16;
constexpr int PREP_PK = 32;
constexpr int PREP_TR_W1 = 4 * 2 * 32;
constexpr int PREP_ITEMS = PREP_TR_WIN + PREP_TR_UPN + PREP_TR_UPM + PREP_TR_OUT + PREP_TR_WQ + PREP_ROPE + PREP_MOD + PREP_PEB + PREP_PK + PREP_TR_W1;

DEV void prep_item(const Params& p, int item, float* sm) {
  const int tid = tidx();
  if (item < PREP_TR_WIN) {
    wamax_item(p, item);
    return;
  }
  item -= PREP_TR_WIN;
  if (item < PREP_TR_UPN) {
    int l = item / 128, r = item % 128;
    int nt = r / 8, kt = r % 8;
    tr_tile(p.w_up_nsa + (size_t)l * 512 * 1024, 1024, 512, (bf16*)(p.ws + OFF_WUPN) + (size_t)l * 1024 * 512, kt, nt, false, sm);
    return;
  }
  item -= PREP_TR_UPN;
  if (item < PREP_TR_UPM) {
    int l = item / 128, r = item % 128;
    int nt = r / 8, kt = r % 8;
    tr_tile(p.w_up_moba + (size_t)l * 512 * 1024, 1024, 512, (bf16*)(p.ws + OFF_WUPM) + (size_t)l * 1024 * 512, kt, nt, false, sm);
    return;
  }
  item -= PREP_TR_UPM;
  if (item < PREP_TR_OUT) {
    int l = item / 256, r = item % 256;
    int nt = r / 16, kt = r % 16;
    tr_tile(p.w_out + (size_t)l * 1024 * 1024, 1024, 1024, (bf16*)(p.ws + OFF_WOUT) + (size_t)l * 1024 * 1024, kt, nt, false, sm);
    return;
  }
  item -= PREP_TR_OUT;
  if (item < PREP_TR_WQ) {
    int l = item / 512, r = item % 512;
    int nt = r / 16, kt = r % 16;
    tr_tile(p.peer_wq + (size_t)l * 1024 * 2048, 2048, 1024, (bf16*)(p.ws + OFF_WQ) + (size_t)l * 2048 * 1024, kt, nt, false, sm);
    return;
  }
  item -= PREP_TR_WQ;
  if (item < PREP_ROPE) {
    int idx = item * 256 + tid;
    int pos = idx >> 3, i = idx & 7;
    float inv = powf(500000.0f, -(float)i / 8.0f);
    float ang = (float)pos * inv;
    float* rp = (float*)(p.ws + OFF_ROPE) + (size_t)pos * 16;
    rp[i] = cosf(ang);
    rp[8 + i] = sinf(ang);
    return;
  }
  item -= PREP_ROPE;
  if (item < PREP_MOD) {
    for (int i = tid; i < 2048; i += 256) {
      float cv = p.c[i];
      sm[i] = cv / (1.f + expf(-cv));
    }
    __syncthreads();
    const int l = item / 192, n0 = (item % 192) * 32;
    const int col = tid & 31, ks = tid >> 5;
    const float* w = p.w_ada + (size_t)l * 1024 * 6144 + n0 + col;
    float a0 = 0.f, a1 = 0.f;
#pragma unroll 8
    for (int k = ks * 128; k < ks * 128 + 128; ++k) {
      float wv = w[(size_t)k * 6144];
      a0 += sm[k] * wv;
      a1 += sm[1024 + k] * wv;
    }
    sm[2048 + tid * 2] = a0;
    sm[2048 + tid * 2 + 1] = a1;
    __syncthreads();
    if (tid < 64) {
      const int c2 = tid & 31, bs = tid >> 5;
      float s = 0.f;
#pragma unroll
      for (int q = 0; q < 8; ++q) s += sm[2048 + (q * 32 + c2) * 2 + bs];
      ((float*)(p.ws + OFF_MOD))[(l * 2 + bs) * 6144 + n0 + c2] = s + p.b_ada[l * 6144 + n0 + c2];
    }
    __syncthreads();
    return;
  }
  item -= PREP_MOD;
  if (item < PREP_PEB) {
    const int lw = item >> 2, j0 = (item & 3) * 32;
    const int col = tid & 31, ks = tid >> 5;
    const float* pe = p.cmp_pe + (size_t)lw * 2048;
    const float* w1 = p.cmp_w1 + (size_t)lw * 2048 * 128 + j0 + col;
    float a = 0.f;
#pragma unroll 8
    for (int i = ks * 256; i < ks * 256 + 256; ++i) a += pe[i] * w1[(size_t)i * 128];
    sm[tid] = a;
    __syncthreads();
    if (tid < 32) {
      float s = 0.f;
#pragma unroll
      for (int q = 0; q < 8; ++q) s += sm[q * 32 + tid];
      ((float*)(p.ws + OFF_PEB))[lw * 128 + j0 + tid] = s;
    }
    if (item == 0 && tid < 4) ((float*)(p.ws + OFF_PROBE))[tid] = 0.f;
    __syncthreads();
    return;
  }
  item -= PREP_PEB;
  if (item < PREP_PK) {
    const int e0 = item * 2048 + tid * 8;
    const int lt = e0 >> 14, off = e0 & 16383;
    const float* srcp = ((lt & 1) ? p.peer_k2 : p.peer_k1) + (size_t)(lt >> 1) * 16384 + off;
    const float4 a = *(const float4*)srcp, b4 = *(const float4*)(srcp + 4);
    uint4 pk;
    pk.x = (unsigned)f2bf(a.x) | ((unsigned)f2bf(a.y) << 16);
    pk.y = (unsigned)f2bf(a.z) | ((unsigned)f2bf(a.w) << 16);
    pk.z = (unsigned)f2bf(b4.x) | ((unsigned)f2bf(b4.y) << 16);
    pk.w = (unsigned)f2bf(b4.z) | ((unsigned)f2bf(b4.w) << 16);
    *(uint4*)((bf16*)(p.ws + OFF_PKB) + e0) = pk;
    return;
  }
  item -= PREP_PK;
  {
    const int lw = item >> 6, r = item & 63;
    const int nt = r >> 5, kt = r & 31;
    tr_tile(p.cmp_w1 + (size_t)lw * 2048 * 128, 128, 2048, (bf16*)(p.ws + OFF_W1T) + (size_t)lw * 128 * 2048, kt, nt, false, sm);
  }
}

DEV void norm_item(const float* __restrict__ xin, const float* __restrict__ g, const float* __restrict__ sc,
                   const float* __restrict__ sh, bf16* __restrict__ hout, int item) {
  const int lane = tidx() & 63, wave = tidx() >> 6;
  const size_t tok = (size_t)item * 4 + wave;
  const int b = (int)(tok / S);
  const float* xr = xin + tok * 1024;
  float4 v[4];
  float ss = 0.f;
#pragma unroll
  for (int i = 0; i < 4; ++i) {
    v[i] = *(const float4*)(xr + i * 256 + lane * 4);
    ss += v[i].x * v[i].x + v[i].y * v[i].y + v[i].z * v[i].z + v[i].w * v[i].w;
  }
  ss = wave_sum(ss);
  float r = 1.0f / sqrtf(ss * (1.0f / 1024.f) + 1e-6f);
#pragma unroll
  for (int i = 0; i < 4; ++i) {
    int d = i * 256 + lane * 4;
    float4 gg = *(const float4*)(g + d);
    float4 s4 = *(const float4*)(sc + b * 6144 + d);
    float4 h4 = *(const float4*)(sh + b * 6144 + d);
    float o0 = v[i].x * r * gg.x * (1.f + s4.x) + h4.x;
    float o1 = v[i].y * r * gg.y * (1.f + s4.y) + h4.y;
    float o2 = v[i].z * r * gg.z * (1.f + s4.z) + h4.z;
    float o3 = v[i].w * r * gg.w * (1.f + s4.w) + h4.w;
    uint2 pk;
    pk.x = (unsigned)f2bf(o0) | ((unsigned)f2bf(o1) << 16);
    pk.y = (unsigned)f2bf(o2) | ((unsigned)f2bf(o3) << 16);
    *(uint2*)(hout + tok * 1024 + d) = pk;
  }
}
DEV void norm8_item(const float* __restrict__ xin, const float* __restrict__ g, const float* __restrict__ sc,
                    const float* __restrict__ sh, unsigned char* __restrict__ hout, unsigned char* __restrict__ hscale, int item) {
  const int lane = tidx() & 63, wave = tidx() >> 6;
  const size_t tok = (size_t)item * 4 + wave;
  const int b = (int)(tok / S);
  const float* xr = xin + tok * 1024;
  float4 v[4];
  float ss = 0.f;
#pragma unroll
  for (int i = 0; i < 4; ++i) {
    v[i] = *(const float4*)(xr + i * 256 + lane * 4);
    ss += v[i].x * v[i].x + v[i].y * v[i].y + v[i].z * v[i].z + v[i].w * v[i].w;
  }
  ss = wave_sum(ss);
  float r = 1.0f / sqrtf(ss * (1.0f / 1024.f) + 1e-6f);
  float mx = 0.f;
#pragma unroll
  for (int i = 0; i < 4; ++i) {
    int d = i * 256 + lane * 4;
    float4 gg = *(const float4*)(g + d);
    float4 s4 = *(const float4*)(sc + b * 6144 + d);
    float4 h4 = *(const float4*)(sh + b * 6144 + d);
    v[i].x = v[i].x * r * gg.x * (1.f + s4.x) + h4.x;
    v[i].y = v[i].y * r * gg.y * (1.f + s4.y) + h4.y;
    v[i].z = v[i].z * r * gg.z * (1.f + s4.z) + h4.z;
    v[i].w = v[i].w * r * gg.w * (1.f + s4.w) + h4.w;
    mx = fmaxf(mx, fmaxf(fmaxf(fabsf(v[i].x), fabsf(v[i].y)), fmaxf(fabsf(v[i].z), fabsf(v[i].w))));
  }
#pragma unroll
  for (int o = 32; o >= 1; o >>= 1) mx = fmaxf(mx, shx(mx, o));
  const unsigned e = e8m0_of(mx);
  const float s = e8m0_inv(e);
#pragma unroll
  for (int i = 0; i < 4; ++i)
    *(unsigned*)(hout + tok * 1024 + i * 256 + lane * 4) = pack4_fp8_(v[i].x * s, v[i].y * s, v[i].z * s, v[i].w * s);
  if (lane == 0) hscale[tok] = (unsigned char)e;
}
DEV void final_norm_item(float* __restrict__ x, const float* __restrict__ g, int item) {
  const int lane = tidx() & 63, wave = tidx() >> 6;
  const size_t tok = (size_t)item * 4 + wave;
  float* xr = x + tok * 1024;
  float4 v[4];
  float ss = 0.f;
#pragma unroll
  for (int i = 0; i < 4; ++i) {
    v[i] = *(const float4*)(xr + i * 256 + lane * 4);
    ss += v[i].x * v[i].x + v[i].y * v[i].y + v[i].z * v[i].z + v[i].w * v[i].w;
  }
  ss = wave_sum(ss);
  float r = 1.0f / sqrtf(ss * (1.0f / 1024.f) + 1e-6f);
#pragma unroll
  for (int i = 0; i < 4; ++i) {
    int d = i * 256 + lane * 4;
    float4 gg = *(const float4*)(g + d);
    float4 o;
    o.x = v[i].x * r * gg.x; o.y = v[i].y * r * gg.y; o.z = v[i].z * r * gg.z; o.w = v[i].w * r * gg.w;
    *(float4*)(xr + d) = o;
  }
}

#define GM_BUF (2 * 128 * 72)
#define GM_LOAD(R, kk)                                                                                  \
  {                                                                                                     \
    const bf16* Ak = Ap + (kk);                                                                         \
    const bf16* Wk = Wp + (kk);                                                                         \
    R##a0 = *(const uint4*)(Ak); R##a1 = *(const uint4*)(Ak + a32); R##a2 = *(const uint4*)(Ak + 2 * a32); \
    R##a3 = *(const uint4*)(Ak + 3 * a32);                                                              \
    R##b0 = *(const uint4*)(Wk); R##b1 = *(const uint4*)(Wk + w32); R##b2 = *(const uint4*)(Wk + 2 * w32); \
    R##b3 = *(const uint4*)(Wk + 3 * w32);                                                              \
  }
#define GM_STORE(R, buf)                                                                                \
  {                                                                                                     \
    bf16* as_ = Asw + (buf) * GM_BUF;                                                                   \
    bf16* bs_ = as_ + 128 * 72;                                                                         \
    *(uint4*)(as_) = R##a0; *(uint4*)(as_ + 32 * 72) = R##a1; *(uint4*)(as_ + 64 * 72) = R##a2; *(uint4*)(as_ + 96 * 72) = R##a3; \
    *(uint4*)(bs_) = R##b0; *(uint4*)(bs_ + 32 * 72) = R##b1; *(uint4*)(bs_ + 64 * 72) = R##b2; *(uint4*)(bs_ + 96 * 72) = R##b3; \
  }
#define GM_COMPUTE(buf)                                                                                 \
  {                                                                                                     \
    const bf16* As_ = sm + (buf) * GM_BUF;                                                              \
    const bf16* Bs_ = As_ + 128 * 72;                                                                   \
    _Pragma("unroll") for (int ks = 0; ks < 2; ++ks) {                                                  \
      __builtin_amdgcn_sched_barrier(0);                                                                \
      bf16x8 af[4], bfr[4];                                                                             \
      _Pragma("unroll") for (int mi = 0; mi < 4; ++mi)                                                  \
        af[mi] = *(const bf16x8*)(As_ + (wr * 64 + mi * 16 + (lane & 15)) * 72 + ks * 32 + (lane >> 4) * 8); \
      _Pragma("unroll") for (int ni = 0; ni < 4; ++ni)                                                  \
        bfr[ni] = *(const bf16x8*)(Bs_ + (wc * 64 + ni * 16 + (lane & 15)) * 72 + ks * 32 + (lane >> 4) * 8); \
      _Pragma("unroll") for (int mi = 0; mi < 4; ++mi)                                                  \
        _Pragma("unroll") for (int ni = 0; ni < 4; ++ni)                                                \
          acc[mi][ni] = __builtin_amdgcn_mfma_f32_16x16x32_bf16(af[mi], bfr[ni], acc[mi][ni], 0, 0, 0); \
    }                                                                                                   \
    __builtin_amdgcn_sched_barrier(0);                                                                  \
  }
DEV void gemm_mainloop(const bf16* __restrict__ A, int lda, const bf16* __restrict__ W, int K, int m0, int n0, bf16* sm,
                       f32x4 (&acc)[4][4]) {
  const int tid = tidx(), lane = tid & 63, wave = tid >> 6;
  const int wr = wave >> 1, wc = wave & 1;
  const int lrow = tid >> 3, lkc = (tid & 7) * 8;
  const bf16* Ap = A + (size_t)(m0 + lrow) * lda + lkc;
  const bf16* Wp = W + (size_t)(n0 + lrow) * K + lkc;
  const int a32 = 32 * lda, w32 = 32 * K;
  bf16* Asw = sm + lrow * 72 + lkc;
  uint4 xa0, xa1, xa2, xa3, xb0, xb1, xb2, xb3, ya0, ya1, ya2, ya3, yb0, yb1, yb2, yb3;
  const int nk = K >> 6;
  GM_LOAD(x, 0)
  GM_LOAD(y, 64)
  __syncthreads();
  GM_STORE(x, 0)
  if (nk > 2) GM_LOAD(x, 128)
  __syncthreads();
  for (int k = 0; k < nk; k += 2) {
    GM_COMPUTE(0)
    GM_STORE(y, 1)
    if (k + 3 < nk) GM_LOAD(y, (k + 3) * 64)
    __syncthreads();
    GM_COMPUTE(1)
    if (k + 2 < nk) {
      GM_STORE(x, 0)
      if (k + 4 < nk) GM_LOAD(x, (k + 4) * 64)
    }
    __syncthreads();
  }
}
DEV void gemm256_mainloop(const bf16* __restrict__ A, int lda, const bf16* __restrict__ W, int K, int m0, int n0, bf16* sm,
                          f32x4 (&acc)[2][4][4]) {
  bf16* As = sm;
  bf16* Bs = sm + 256 * 72;
  const int tid = tidx(), lane = tid & 63, wave = tid >> 6;
  const int wr = wave >> 1, wc = wave & 1;
  const int lrow = tid >> 3, lkc = (tid & 7) * 8;
  const bf16* Ap = A + (size_t)(m0 + lrow) * lda + lkc;
  const bf16* Wp = W + (size_t)(n0 + lrow) * K + lkc;
  const int a32 = 32 * lda, w32 = 32 * K;
  uint4 ra0, ra1, ra2, ra3, ra4, ra5, ra6, ra7, rb0, rb1, rb2, rb3;
#define G256_LOAD(kk)                                                                                   \
  {                                                                                                     \
    const bf16* Ak = Ap + (kk);                                                                         \
    const bf16* Wk = Wp + (kk);                                                                         \
    ra0 = *(const uint4*)(Ak); ra1 = *(const uint4*)(Ak + a32); ra2 = *(const uint4*)(Ak + 2 * a32);    \
    ra3 = *(const uint4*)(Ak + 3 * a32); ra4 = *(const uint4*)(Ak + 4 * a32); ra5 = *(const uint4*)(Ak + 5 * a32); \
    ra6 = *(const uint4*)(Ak + 6 * a32); ra7 = *(const uint4*)(Ak + 7 * a32);                           \
    rb0 = *(const uint4*)(Wk); rb1 = *(const uint4*)(Wk + w32); rb2 = *(const uint4*)(Wk + 2 * w32);    \
    rb3 = *(const uint4*)(Wk + 3 * w32);                                                                \
  }
  G256_LOAD(0)
  bf16* Asw = As + lrow * 72 + lkc;
  bf16* Bsw = Bs + lrow * 72 + lkc;
  for (int k0 = 0; k0 < K; k0 += 64) {
    __syncthreads();
    *(uint4*)(Asw) = ra0; *(uint4*)(Asw + 32 * 72) = ra1; *(uint4*)(Asw + 64 * 72) = ra2; *(uint4*)(Asw + 96 * 72) = ra3;
    *(uint4*)(Asw + 128 * 72) = ra4; *(uint4*)(Asw + 160 * 72) = ra5; *(uint4*)(Asw + 192 * 72) = ra6; *(uint4*)(Asw + 224 * 72) = ra7;
    *(uint4*)(Bsw) = rb0; *(uint4*)(Bsw + 32 * 72) = rb1; *(uint4*)(Bsw + 64 * 72) = rb2; *(uint4*)(Bsw + 96 * 72) = rb3;
    __syncthreads();
    if (k0 + 64 < K) G256_LOAD(k0 + 64)
#pragma unroll
    for (int ks = 0; ks < 2; ++ks) {
      bf16x8 bfr[4];
#pragma unroll
      for (int ni = 0; ni < 4; ++ni)
        bfr[ni] = *(const bf16x8*)(Bs + (wc * 64 + ni * 16 + (lane & 15)) * 72 + ks * 32 + (lane >> 4) * 8);
#pragma unroll
      for (int h = 0; h < 2; ++h) {
        __builtin_amdgcn_sched_barrier(0);
        bf16x8 af[4];
#pragma unroll
        for (int mi = 0; mi < 4; ++mi)
          af[mi] = *(const bf16x8*)(As + (wr * 128 + h * 64 + mi * 16 + (lane & 15)) * 72 + ks * 32 + (lane >> 4) * 8);
#pragma unroll
        for (int mi = 0; mi < 4; ++mi)
#pragma unroll
          for (int ni = 0; ni < 4; ++ni)
            acc[h][mi][ni] = __builtin_amdgcn_mfma_f32_16x16x32_bf16(af[mi], bfr[ni], acc[h][mi][ni], 0, 0, 0);
      }
    }
  }
}
DEV void acc_zero(f32x4 (&acc)[4][4]) {
#pragma unroll
  for (int i = 0; i < 4; ++i)
#pragma unroll
    for (int j = 0; j < 4; ++j) acc[i][j] = f32x4{0.f, 0.f, 0.f, 0.f};
}
DEV void store_tile_bf16(bf16* sm, const f32x4 (&acc)[4][4], bf16* __restrict__ dbase, size_t dstride) {
  const int tid = tidx(), lane = tid & 63, wave = tid >> 6, g4 = lane >> 4, c16 = lane & 15;
  bf16* Cw = sm + wave * (64 * 72);
  __syncthreads();
#pragma unroll
  for (int mi = 0; mi < 4; ++mi)
#pragma unroll
    for (int ni = 0; ni < 4; ++ni)
#pragma unroll
      for (int r = 0; r < 4; ++r) Cw[(mi * 16 + g4 * 4 + r) * 72 + ni * 16 + c16] = f2bf(acc[mi][ni][r]);
  __syncthreads();
#pragma unroll
  for (int it = 0; it < 8; ++it) {
    const int row_l = it * 8 + (lane >> 3), ch = lane & 7;
    const uint4 v = *(const uint4*)(Cw + row_l * 72 + ch * 8);
    *(uint4*)(dbase + (size_t)row_l * dstride + ch * 8) = v;
  }
}
template <class Epi>
DEV void gemm_tile(const bf16* __restrict__ A, int lda, const bf16* __restrict__ W, int K, int m0, int n0, bf16* sm,
                   Epi epi) {
  f32x4 acc[4][4];
  acc_zero(acc);
  gemm_mainloop(A, lda, W, K, m0, n0, sm, acc);
  const int tid = tidx(), lane = tid & 63, wave = tid >> 6;
  const int wr = wave >> 1, wc = wave & 1;
#pragma unroll
  for (int mi = 0; mi < 4; ++mi)
#pragma unroll
    for (int ni = 0; ni < 4; ++ni)
#pragma unroll
      for (int r = 0; r < 4; ++r) {
        int row = m0 + wr * 64 + mi * 16 + (lane >> 4) * 4 + r;
        int col = n0 + wc * 64 + ni * 16 + (lane & 15);
        epi(row, col, acc[mi][ni][r]);
      }
}
DEV void inproj_epilogue(const Params& p, f32x4 (&acc)[4][4], int row0, int vc0, bf16* sm) {
  const int tid = tidx(), lane = tid & 63, g4 = lane >> 4, c16 = lane & 15;
  const int b = row0 / S, t0 = row0 % S;
  bf16* dbase;
  size_t dstride;
  bool roped = false;
  bf16* projp = (bf16*)(p.ws + OFF_PROJ) + (size_t)row0 * PC;
  if (vc0 < 768) { dbase = projp + vc0; dstride = PC; }
  else if (vc0 < 1280) {
    const int seg = (vc0 - 768) >> 7, head = ((vc0 - 768) >> 6) & 1;
    const size_t off = (seg == 0) ? OFF_KSB : (seg == 1) ? OFF_VSB : (seg == 2) ? OFF_KWB : OFF_VWB;
    dbase = (bf16*)(p.ws + off) + ((size_t)(b * 2 + head) * S + t0) * 64;
    dstride = 64;
    roped = (seg == 0) || (seg == 2);
  } else if (vc0 < 1792) { dbase = projp + C_MQ + (vc0 - 1280); dstride = PC; roped = true; }
  else if (vc0 < 2816) {
    const int seg = (vc0 - 1792) >> 9, head = ((vc0 - 1792) >> 6) & 7;
    dbase = (bf16*)(p.ws + (seg ? OFF_MVB : OFF_MKB)) + ((size_t)(b * 8 + head) * S + t0) * 64;
    dstride = 64;
    roped = (seg == 0);
  } else if (vc0 < 4864) { dbase = projp + C_GN + (vc0 - 2816); dstride = PC; }
  else { dbase = projp + C_NG + (vc0 - 4864); dstride = PC; }
  if (roped) {
    const float* rope = (const float*)(p.ws + OFF_ROPE);
#pragma unroll
    for (int mi = 0; mi < 4; ++mi)
#pragma unroll
      for (int r = 0; r < 4; ++r) {
        const int pos = t0 + mi * 16 + g4 * 4 + r;
        const float v = acc[mi][0][r];
        const float pv = shx(v, 8);
        const float cs = rope[pos * 16 + (c16 & 7)], sn = rope[pos * 16 + 8 + (c16 & 7)];
        acc[mi][0][r] = (c16 < 8) ? (v * cs - pv * sn) : (v * cs + pv * sn);
      }
  }
  store_tile_bf16(sm, acc, dbase, dstride);
}
DEV void inproj_tile256(const Params& p, int layer, int m0, int n0, bf16* sm) {
  f32x4 acc[2][4][4];
  acc_zero(acc[0]);
  acc_zero(acc[1]);
  gemm256_mainloop((const bf16*)(p.ws + OFF_H), 1024, (const bf16*)(p.ws + OFF_WINT) + (size_t)layer * WN * 1024, 1024, m0, n0, sm, acc);
  const int wave = tidx() >> 6, wr = wave >> 1, wc = wave & 1;
  inproj_epilogue(p, acc[0], m0 + wr * 128, n0 + wc * 64, sm);
  inproj_epilogue(p, acc[1], m0 + wr * 128 + 64, n0 + wc * 64, sm);
}
typedef unsigned u32x2_t __attribute__((ext_vector_type(2)));
DEV void merge_tile(const Params& p, int layer, int m0, int n0, bf16* sm) {
  const int tid = tidx(), lane = tid & 63, wave = tid >> 6, g4 = lane >> 4, c16 = lane & 15;
  const int wr = wave >> 1, wc = wave & 1;
  const bf16* projg = (const bf16*)(p.ws + OFF_PROJ) + (size_t)(m0 + wr * 64 + g4 * 4) * PC + n0 + wc * 64 + c16;
  f32x4 acc[4][4];
  acc_zero(acc);
  gemm_mainloop((const bf16*)(p.ws + OFF_ONSA), 512, (const bf16*)(p.ws + OFF_WUPN) + (size_t)layer * 1024 * 512, 512, m0, n0, sm, acc);
  bf16* yg = (bf16*)(p.ws + OFF_H) + (size_t)(m0 + wr * 64 + g4 * 4) * 1024 + n0 + wc * 64 + c16;
#pragma unroll
  for (int mi = 0; mi < 4; ++mi)
#pragma unroll
    for (int ni = 0; ni < 4; ++ni)
#pragma unroll
      for (int r = 0; r < 4; ++r)
        yg[(size_t)(mi * 16 + r) * 1024 + ni * 16] =
            f2bf(sigmoidf_(bf2f(projg[(size_t)(mi * 16 + r) * PC + C_GN + ni * 16])) * acc[mi][ni][r]);
  acc_zero(acc);
  gemm_mainloop((const bf16*)(p.ws + OFF_OMOBA), 512, (const bf16*)(p.ws + OFF_WUPM) + (size_t)layer * 1024 * 512, 512, m0, n0, sm, acc);
#pragma unroll
  for (int mi = 0; mi < 4; ++mi)
#pragma unroll
    for (int ni = 0; ni < 4; ++ni)
#pragma unroll
      for (int r = 0; r < 4; ++r)
        acc[mi][ni][r] = bf2f(yg[(size_t)(mi * 16 + r) * 1024 + ni * 16]) +
                         sigmoidf_(bf2f(projg[(size_t)(mi * 16 + r) * PC + C_GM + ni * 16])) * acc[mi][ni][r];
  store_tile_bf16(sm, acc, (bf16*)(p.ws + OFF_H) + (size_t)(m0 + wr * 64) * 1024 + n0 + wc * 64, 1024);
}

DEV void merge_tile256(const Params& p, int layer, int m0, int n0, bf16* sm) {
  const int tid = tidx(), lane = tid & 63, wave = tid >> 6, g4 = lane >> 4, c16 = lane & 15;
  const int wr = wave >> 1, wc = wave & 1;
  f32x4 acc[2][4][4];
  acc_zero(acc[0]);
  acc_zero(acc[1]);
  gemm256_mainloop((const bf16*)(p.ws + OFF_ONSA), 512, (const bf16*)(p.ws + OFF_WUPN) + (size_t)layer * 1024 * 512, 512, m0, n0, sm, acc);
#pragma unroll
  for (int h = 0; h < 2; ++h) {
    const size_t rb = (size_t)(m0 + wr * 128 + h * 64 + g4 * 4);
    const bf16* projg = (const bf16*)(p.ws + OFF_PROJ) + rb * PC + n0 + wc * 64 + c16;
    bf16* yg = (bf16*)(p.ws + OFF_H) + rb * 1024 + n0 + wc * 64 + c16;
#pragma unroll
    for (int mi = 0; mi < 4; ++mi)
#pragma unroll
      for (int ni = 0; ni < 4; ++ni)
#pragma unroll
        for (int r = 0; r < 4; ++r)
          yg[(size_t)(mi * 16 + r) * 1024 + ni * 16] =
              f2bf(sigmoidf_(bf2f(projg[(size_t)(mi * 16 + r) * PC + C_GN + ni * 16])) * acc[h][mi][ni][r]);
  }
  acc_zero(acc[0]);
  acc_zero(acc[1]);
  gemm256_mainloop((const bf16*)(p.ws + OFF_OMOBA), 512, (const bf16*)(p.ws + OFF_WUPM) + (size_t)layer * 1024 * 512, 512, m0, n0, sm, acc);
#pragma unroll
  for (int h = 0; h < 2; ++h) {
    const size_t rb = (size_t)(m0 + wr * 128 + h * 64 + g4 * 4);
    const bf16* projg = (const bf16*)(p.ws + OFF_PROJ) + rb * PC + n0 + wc * 64 + c16;
    const bf16* yg = (const bf16*)(p.ws + OFF_H) + rb * 1024 + n0 + wc * 64 + c16;
#pragma unroll
    for (int mi = 0; mi < 4; ++mi)
#pragma unroll
      for (int ni = 0; ni < 4; ++ni)
#pragma unroll
        for (int r = 0; r < 4; ++r)
          acc[h][mi][ni][r] = bf2f(yg[(size_t)(mi * 16 + r) * 1024 + ni * 16]) +
                              sigmoidf_(bf2f(projg[(size_t)(mi * 16 + r) * PC + C_GM + ni * 16])) * acc[h][mi][ni][r];
    store_tile_bf16(sm, acc[h], (bf16*)(p.ws + OFF_H) + (size_t)(m0 + wr * 128 + h * 64) * 1024 + n0 + wc * 64, 1024);
  }
}

DEV void compress_item(const Params& p, int layer, int item, float* sm) {
  const int tid = tidx();
  const int grp = item & 127, which = (item >> 7) & 1, kvh = (item >> 8) & 1, b = item >> 9;
  const int c0 = grp * 8;
  float* xs = sm;
  float* hs = sm + 144 * 64;
  const bf16* proj = (const bf16*)(p.ws + OFF_PROJ);
  const int col = (which ? C_VC : C_KC) + kvh * 64;
  for (int i = tid; i < 144 * 64; i += 256) {
    int tl = i >> 6, d = i & 63;
    int t = c0 * 16 + tl;
    xs[i] = (t < S) ? bf2f(proj[((size_t)b * S + t) * PC + col + d]) : 0.f;
  }
  __syncthreads();
  const int lw = layer * 2 + which;
  if (tid < 128) {
    const float* w1 = p.cmp_w1 + (size_t)lw * 2048 * 128 + tid;
    float acc[8];
#pragma unroll
    for (int ci = 0; ci < 8; ++ci) acc[ci] = 0.f;
    for (int l = 0; l < 32; ++l) {
#pragma unroll 4
      for (int d = 0; d < 64; ++d) {
        float w = w1[(size_t)(l * 64 + d) * 128];
#pragma unroll
        for (int ci = 0; ci < 8; ++ci) acc[ci] += xs[(ci * 16 + l) * 64 + d] * w;
      }
    }
    float pb = ((const float*)(p.ws + OFF_PEB))[lw * 128 + tid];
#pragma unroll
    for (int ci = 0; ci < 8; ++ci) hs[ci * 128 + tid] = gelu_tanh(acc[ci] + pb);
  }
  __syncthreads();
  const float* w2 = p.cmp_w2 + (size_t)lw * 128 * 64;
  float* outp = PROBE_CMPR ? ((float*)(p.ws + OFF_CMP) + (which ? (size_t)Bn * 1024 * 128 : 0)) : (float*)(p.ws + (which ? OFF_VCC : OFF_KCC));
#pragma unroll
  for (int rr = 0; rr < 2; ++rr) {
    int o = rr * 256 + tid;
    int ci = o >> 6, d = o & 63;
    int c = c0 + ci;
    float a = 0.f;
    for (int j = 0; j < 128; ++j) a += hs[ci * 128 + j] * w2[j * 64 + d];
    if (c < 1023) outp[(((size_t)b * 1024 + c) * 2 + kvh) * 64 + d] = a;
    bf16* outb = (bf16*)(p.ws + (which ? OFF_VCB : OFF_KCB));
    if (!PROBE_CMPR && c < 1024) outb[(((size_t)b * 2 + kvh) * 1024 + c) * 64 + d] = (c < 1023) ? f2bf(a) : (bf16)0;
  }
  __syncthreads();
}

DEV void compress_mfma_item(const Params& p, int layer, int item, char* smem) {
  bf16* xs = (bf16*)smem;
  float* hs = (float*)(smem + 272 * 64 * 2);
  const int tid = tidx(), lane = tid & 63, wave = tid >> 6, g4 = lane >> 4, c16 = lane & 15;
  const int cblk = item & 63, which = (item >> 6) & 1, kvh = (item >> 7) & 1, b = item >> 8;
  const int t0 = cblk * 256;
  const bf16* proj = (const bf16*)(p.ws + OFF_PROJ) + (size_t)b * S * PC + (which ? C_VC : C_KC) + kvh * 64;
  __syncthreads();
  for (int i = tid; i < 272 * 8; i += 256) {
    const int tl = i >> 3, ch = i & 7;
    const int t = t0 + tl;
    uint4 v = uint4{0u, 0u, 0u, 0u};
    if (t < S) v = *(const uint4*)(proj + (size_t)t * PC + ch * 8);
    *(uint4*)(xs + tl * 64 + ((ch ^ ((tl >> 4) & 7)) * 8)) = v;
  }
  __syncthreads();
  const int lw = layer * 2 + which;
  const bf16* w1t = (const bf16*)(p.ws + OFF_W1T) + (size_t)lw * 128 * 2048;
  f32x4 acc0 = f32x4{0.f, 0.f, 0.f, 0.f}, acc1 = f32x4{0.f, 0.f, 0.f, 0.f};
  const bf16* wb0 = w1t + (size_t)((2 * wave) * 16 + c16) * 2048 + g4 * 8;
  const bf16* wb1 = w1t + (size_t)((2 * wave + 1) * 16 + c16) * 2048 + g4 * 8;
#pragma unroll 4
  for (int ks = 0; ks < 64; ++ks) {
    const int l = ks >> 1, ch = (ks & 1) * 4 + g4;
    const int tl = 16 * c16 + l;
    const bf16x8 af = *(const bf16x8*)(xs + tl * 64 + ((ch ^ ((tl >> 4) & 7)) * 8));
    const bf16x8 b0 = *(const bf16x8*)(wb0 + ks * 32);
    const bf16x8 b1 = *(const bf16x8*)(wb1 + ks * 32);
    acc0 = MFMA16B(af, b0, acc0);
    acc1 = MFMA16B(af, b1, acc1);
  }
  {
    const float* peb = (const float*)(p.ws + OFF_PEB) + lw * 128;
    const int j0 = (2 * wave) * 16 + c16, j1 = j0 + 16;
    const float pb0 = peb[j0], pb1 = peb[j1];
#pragma unroll
    for (int r = 0; r < 4; ++r) {
      hs[(g4 * 4 + r) * 128 + j0] = gelu_tanh(acc0[r] + pb0);
      hs[(g4 * 4 + r) * 128 + j1] = gelu_tanh(acc1[r] + pb1);
    }
  }
  __syncthreads();
  const float* w2 = p.cmp_w2 + (size_t)lw * 128 * 64;
  const int d = tid & 63, cq = tid >> 6;
  float o0 = 0.f, o1 = 0.f, o2 = 0.f, o3 = 0.f;
#pragma unroll 8
  for (int j = 0; j < 128; ++j) {
    const float w = w2[j * 64 + d];
    o0 += hs[(cq * 4 + 0) * 128 + j] * w;
    o1 += hs[(cq * 4 + 1) * 128 + j] * w;
    o2 += hs[(cq * 4 + 2) * 128 + j] * w;
    o3 += hs[(cq * 4 + 3) * 128 + j] * w;
  }
  float* outp = (float*)(p.ws + (which ? OFF_VCC : OFF_KCC));
  bf16* outb = (bf16*)(p.ws + (which ? OFF_VCB : OFF_KCB));
  const float ov[4] = {o0, o1, o2, o3};
#pragma unroll
  for (int i = 0; i < 4; ++i) {
    const int c = cblk * 16 + cq * 4 + i;
    if (c < 1023) outp[(((size_t)b * 1024 + c) * 2 + kvh) * 64 + d] = ov[i];
    outb[(((size_t)b * 2 + kvh) * 1024 + c) * 64 + d] = (c < 1023) ? f2bf(ov[i]) : (bf16)0;
  }
  __syncthreads();
}

DEV void n1_item(const Params& p, int layer, int item, float* sm) {
  const int chunk = item & 255, kvh = (item >> 8) & 1, b = item >> 9;
  const int tid = tidx(), ql = tid >> 2, g = tid & 3;
  const int t = chunk * 64 + ql, h = kvh * 4 + g;
  const size_t tok = (size_t)b * S + t;
  const bf16* proj = (const bf16*)(p.ws + OFF_PROJ);
  float* imp = sm;
  for (int i = tid; i < 64 * 257; i += 256) imp[i] = 0.f;
  float q[64];
  load_q64(q, proj + tok * PC + C_NQ + h * 64, 0.125f);
  const int nv = (t >= 31) ? (((t - 31) >> 4) + 1) : 0;
  const int nv_max = (((chunk * 64 + 63) - 31) >> 4) + 1;
  const float* kc = (const float*)(p.ws + OFF_KCC) + (size_t)b * 1024 * 128 + kvh * 64;
  const float* vc = (const float*)(p.ws + OFF_VCC) + (size_t)b * 1024 * 128 + kvh * 64;
  float m = -INFINITY, l = 0.f;
  for (int c = 0; c < nv_max; ++c) {
    float s = dot64_f(q, kc + (size_t)c * 128);
    if (c < nv) {
      float mn = fmaxf(m, s);
      l = l * expf(m - mn) + expf(s - mn);
      m = mn;
    }
  }
  __syncthreads();
  float o[64];
#pragma unroll
  for (int d = 0; d < 64; ++d) o[d] = 0.f;
  const float inv_l = (nv > 0) ? 1.f / l : 0.f;
  for (int c = 0; c < nv_max; ++c) {
    float s = dot64_f(q, kc + (size_t)c * 128);
    float pr = (c < nv) ? expf(s - m) * inv_l : 0.f;
    axpy64_f(o, pr, vc + (size_t)c * 128);
    float ps = pr;
    ps += shx(ps, 1);
    ps += shx(ps, 2);
    if (g == 0) {
      int n = c >> 2;
      if ((c & 3) == 3) {
        imp[ql * 257 + n] += 0.5f * ps;
        imp[ql * 257 + n + 1] += 0.5f * ps;
      } else {
        imp[ql * 257 + n] += ps;
      }
    }
  }
  const float gate0 = (!PROBE_NSA || (PROBE_NSA & 1)) ? sigmoidf_(bf2f(proj[tok * PC + C_NG + h * 3 + 0])) : 0.f;
  float* oa = (float*)(p.ws + OFF_H) + tok * 512 + h * 64;
#pragma unroll
  for (int d = 0; d < 64; d += 4) {
    float4 v = {gate0 * o[d], gate0 * o[d + 1], gate0 * o[d + 2], gate0 * o[d + 3]};
    *(float4*)(oa + d) = v;
  }
  __syncthreads();
#if PROBE_NSA == 8
  if (b == 0 && kvh == 0)
    for (int i = tid; i < 64 * 256; i += 256)
      ((float*)(p.ws + OFF_OMOBA))[(size_t)(chunk * 64 + (i >> 8)) * 256 + (i & 255)] = imp[(i >> 8) * 257 + (i & 255)];
  __syncthreads();
#endif
  if (g == 0) {
    int* selp = (int*)(p.ws + OFF_SEL) + (((size_t)b * 2 + kvh) * S + t) * 16;
    const int cur = chunk;
    if (cur < 16) {
      for (int j = 0; j < 16; ++j) selp[j] = (j <= cur) ? j : -1;
    } else {
      selp[0] = 0;
      selp[1] = cur - 1;
      selp[2] = cur;
      float* row = imp + ql * 257;
      for (int j = 3; j < 16; ++j) {
        float best = -1.f;
        int bi = 1;
        for (int n = 1; n <= cur - 2; ++n) {
          float v = row[n];
          if (v > best) { best = v; bi = n; }
        }
        selp[j] = bi;
        row[bi] = -2.f;
      }
    }
  }
  __syncthreads();
}

DEV void kmean_item(const Params& p, int item, float* sm) {
  const int n = item & 63, h = (item >> 6) & 7, b = item >> 9;
  const int tid = tidx(), d = tid & 63, part = tid >> 6;
  const bf16* mkb = (const bf16*)(p.ws + OFF_MKB);
  float a = 0.f;
  for (int i = 0; i < 64; ++i) {
    int t = n * 256 + part * 64 + i;
    a += bf2f(mkb[((size_t)(b * 8 + h) * S + t) * 64 + d]);
  }
  sm[tid] = a;
  __syncthreads();
  if (tid < 64) {
    float s = sm[tid] + sm[64 + tid] + sm[128 + tid] + sm[192 + tid];
    const size_t ko = (((size_t)b * 8 + h) * 64 + n) * 64 + tid;
    const float mean = s * (1.f / 256.f);
    ((float*)(p.ws + OFF_KMEAN))[ko] = mean;
    const bf16 hi = f2bf(mean);
    ((bf16*)(p.ws + OFF_KMHL))[ko] = hi;
    ((bf16*)(p.ws + OFF_KMHL))[(size_t)2 * 8 * 64 * 64 + ko] = f2bf(mean - bf2f(hi));
    if (tid == 0) ((int*)(p.ws + OFF_MCNT))[(b * 8 + h) * 64 + n] = 0;
  }
  __syncthreads();
}

DEV void n23_item(const Params& p, int layer, int item) {
  const int chunk = item & 255, kvh = (item >> 8) & 1, b = item >> 9;
  const int tid = tidx(), ql = tid >> 2, g = tid & 3;
  const int t = chunk * 64 + ql, h = kvh * 4 + g;
  const size_t tok = (size_t)b * S + t;
  const bf16* proj = (const bf16*)(p.ws + OFF_PROJ);
  const float* rope = (const float*)(p.ws + OFF_ROPE) + (size_t)t * 16;
  float q[64];
  load_q64(q, proj + tok * PC + C_NQ + h * 64, 1.0f);
#pragma unroll
  for (int i = 0; i < 8; ++i) {
    float cs = rope[i], sn = rope[8 + i];
    float x1 = q[i], x2 = q[8 + i];
    q[i] = x1 * cs - x2 * sn;
    q[8 + i] = x2 * cs + x1 * sn;
  }
#pragma unroll
  for (int i = 0; i < 64; ++i) q[i] *= 0.125f;
  const size_t kvo = ((size_t)(b * 2 + kvh) * S) * 64;
  const bf16* ksb = (const bf16*)(p.ws + OFF_KSB) + kvo;
  const bf16* vsb = (const bf16*)(p.ws + OFF_VSB) + kvo;
  const bf16* kwb = (const bf16*)(p.ws + OFF_KWB) + kvo;
  const bf16* vwb = (const bf16*)(p.ws + OFF_VWB) + kvo;
  const int* selp = (const int*)(p.ws + OFF_SEL) + (((size_t)b * 2 + kvh) * S + t) * 16;
  float* oa = (float*)(p.ws + OFF_H) + tok * 512 + h * 64;
  const float gate1 = (!PROBE_NSA || (PROBE_NSA & 2)) ? sigmoidf_(bf2f(proj[tok * PC + C_NG + h * 3 + 1])) : 0.f;
  const float gate2 = (!PROBE_NSA || (PROBE_NSA & 4)) ? sigmoidf_(bf2f(proj[tok * PC + C_NG + h * 3 + 2])) : 0.f;
  float o[64];
  {
    float m = -INFINITY;
    for (int j = 0; j < 16; ++j) {
      int n = selp[j];
      if (n >= 0) {
        for (int i = 0; i < 64; ++i) {
          int kpos = n * 64 + i;
          if (kpos <= t) {
            float s = dot64_bf(q, ksb + (size_t)kpos * 64);
            m = fmaxf(m, s);
          }
        }
      }
    }
    float l = 0.f;
#pragma unroll
    for (int d = 0; d < 64; ++d) o[d] = 0.f;
    for (int j = 0; j < 16; ++j) {
      int n = selp[j];
      if (n >= 0) {
        for (int i = 0; i < 64; ++i) {
          int kpos = n * 64 + i;
          if (kpos <= t) {
            float s = dot64_bf(q, ksb + (size_t)kpos * 64);
            float pr = expf(s - m);
            l += pr;
            axpy64_bf(o, pr, vsb + (size_t)kpos * 64);
          }
        }
      }
    }
    float sc = gate1 / l;
#pragma unroll
    for (int d = 0; d < 64; d += 4) {
      float4 v = *(float4*)(oa + d);
      v.x += sc * o[d]; v.y += sc * o[d + 1]; v.z += sc * o[d + 2]; v.w += sc * o[d + 3];
      *(float4*)(oa + d) = v;
    }
  }
  {
    const int s0 = chunk * 64;
    const int jlo = (s0 - 511 > 0) ? (s0 - 511) : 0;
    const int jhi = s0 + 63;
    float m = -INFINITY;
    for (int j = jlo; j <= jhi; ++j) {
      float s = dot64_bf(q, kwb + (size_t)j * 64);
      if (j <= t && j > t - 512) m = fmaxf(m, s);
    }
    float l = 0.f;
#pragma unroll
    for (int d = 0; d < 64; ++d) o[d] = 0.f;
    for (int j = jlo; j <= jhi; ++j) {
      float s = dot64_bf(q, kwb + (size_t)j * 64);
      float pr = (j <= t && j > t - 512) ? expf(s - m) : 0.f;
      l += pr;
      axpy64_bf(o, pr, vwb + (size_t)j * 64);
    }
    float sc = gate2 / l;
    bf16* ob = (bf16*)(p.ws + (PROBE_NSA ? OFF_CMP : OFF_ONSA)) + tok * 512 + h * 64;
#pragma unroll
    for (int d = 0; d < 64; d += 8) {
      float4 v0 = *(float4*)(oa + d);
      float4 v1 = *(float4*)(oa + d + 4);
      uint4 pk;
      pk.x = (unsigned)f2bf(v0.x + sc * o[d]) | ((unsigned)f2bf(v0.y + sc * o[d + 1]) << 16);
      pk.y = (unsigned)f2bf(v0.z + sc * o[d + 2]) | ((unsigned)f2bf(v0.w + sc * o[d + 3]) << 16);
      pk.z = (unsigned)f2bf(v1.x + sc * o[d + 4]) | ((unsigned)f2bf(v1.y + sc * o[d + 5]) << 16);
      pk.w = (unsigned)f2bf(v1.z + sc * o[d + 6]) | ((unsigned)f2bf(v1.w + sc * o[d + 7]) << 16);
      *(uint4*)(ob + d) = pk;
    }
  }
}

DEV void moba_item(const Params& p, int layer, int item) {
  const int blk = item & 63, h = (item >> 6) & 7, b = item >> 9;
  const int tid = tidx();
  const int t = blk * 256 + tid;
  const size_t tok = (size_t)b * S + t;
  const bf16* proj = (const bf16*)(p.ws + OFF_PROJ);
  float q[64];
  load_q64(q, proj + tok * PC + C_MQ + h * 64, 0.125f);
  const float* km = (const float*)(p.ws + OFF_KMEAN) + ((size_t)b * 8 + h) * 64 * 64;
  float b0 = -INFINITY, b1 = -INFINITY, b2 = -INFINITY;
  int i0 = -1, i1 = -1, i2 = -1;
  for (int n = 0; n < blk; ++n) {
    float v = dot64_f(q, km + n * 64);
    if (v > b0) { b2 = b1; i2 = i1; b1 = b0; i1 = i0; b0 = v; i0 = n; }
    else if (v > b1) { b2 = b1; i2 = i1; b1 = v; i1 = n; }
    else if (v > b2) { b2 = v; i2 = n; }
  }
  const bf16* mkb = (const bf16*)(p.ws + OFF_MKB) + ((size_t)(b * 8 + h) * S) * 64;
  const bf16* mvb = (const bf16*)(p.ws + OFF_MVB) + ((size_t)(b * 8 + h) * S) * 64;
  float m = -INFINITY;
  for (int sidx = 0; sidx < 3; ++sidx) {
    int n = (sidx == 0) ? i0 : (sidx == 1) ? i1 : i2;
    if (sidx < blk) {
      for (int i = 0; i < 256; ++i) {
        float s = dot64_bf(q, mkb + (size_t)(n * 256 + i) * 64);
        m = fmaxf(m, s);
      }
    }
  }
  for (int i = 0; i < 256; ++i) {
    int kpos = blk * 256 + i;
    float s = dot64_bf(q, mkb + (size_t)kpos * 64);
    if (kpos <= t) m = fmaxf(m, s);
  }
  float l = 0.f;
  float o[64];
#pragma unroll
  for (int d = 0; d < 64; ++d) o[d] = 0.f;
  for (int sidx = 0; sidx < 3; ++sidx) {
    int n = (sidx == 0) ? i0 : (sidx == 1) ? i1 : i2;
    if (sidx < blk) {
      for (int i = 0; i < 256; ++i) {
        const size_t ko = (size_t)(n * 256 + i) * 64;
        float s = dot64_bf(q, mkb + ko);
        float pr = expf(s - m);
        l += pr;
        axpy64_bf(o, pr, mvb + ko);
      }
    }
  }
  for (int i = 0; i < 256; ++i) {
    int kpos = blk * 256 + i;
    const size_t ko = (size_t)kpos * 64;
    float s = dot64_bf(q, mkb + ko);
    float pr = (kpos <= t) ? expf(s - m) : 0.f;
    l += pr;
    axpy64_bf(o, pr, mvb + ko);
  }
  const float il = 1.f / l;
  bf16* ob = (bf16*)(p.ws + (PROBE_MOBA ? OFF_CMP : OFF_OMOBA)) + tok * 512 + h * 64;
#pragma unroll
  for (int d = 0; d < 64; d += 8) {
    uint4 pk;
    pk.x = (unsigned)f2bf(o[d] * il) | ((unsigned)f2bf(o[d + 1] * il) << 16);
    pk.y = (unsigned)f2bf(o[d + 2] * il) | ((unsigned)f2bf(o[d + 3] * il) << 16);
    pk.z = (unsigned)f2bf(o[d + 4] * il) | ((unsigned)f2bf(o[d + 5] * il) << 16);
    pk.w = (unsigned)f2bf(o[d + 6] * il) | ((unsigned)f2bf(o[d + 7] * il) << 16);
    *(uint4*)(ob + d) = pk;
  }
}

typedef short v4i16_t __attribute__((ext_vector_type(4)));
typedef unsigned u32x4_t __attribute__((ext_vector_type(4)));
DEV v4i16_t lds_tr16(const bf16* p) {
  return __builtin_amdgcn_ds_read_tr16_b64_v4i16((__attribute__((address_space(3))) v4i16_t*)p);
}
DEV unsigned cvtpk(float lo, float hi) {
  unsigned r;
  asm("v_cvt_pk_bf16_f32 %0, %1, %2" : "=v"(r) : "v"(lo), "v"(hi));
  return r;
}
#define MFMA16(a, b, c) __builtin_amdgcn_mfma_f32_16x16x32_bf16(a, b, c, 0, 0, 0)
constexpr float C2 = 0.125f * 1.4426950408889634f;
constexpr int KT_LD = 72;
constexpr int KT_ELEMS = 64 * KT_LD;

template <int NI>
struct AttnSt {
  f32x4 o[4][NI];
  float m[NI], l[NI];
};
template <int NI>
DEV void attn_init(AttnSt<NI>& st) {
#pragma unroll
  for (int ni = 0; ni < NI; ++ni) {
    st.m[ni] = -INFINITY;
    st.l[ni] = 0.f;
#pragma unroll
    for (int di = 0; di < 4; ++di) st.o[di][ni] = f32x4{0.f, 0.f, 0.f, 0.f};
  }
}
#define TILE_DECL uint4 tl_k0, tl_k1, tl_v0, tl_v1
#define TILE_GLOAD(kb, vb, ld, key0)                                                        \
  do {                                                                                      \
    const int r_ = tidx() >> 3, c_ = (tidx() & 7) * 8;                            \
    tl_k0 = *(const uint4*)((kb) + (size_t)((key0) + r_) * (ld) + c_);                      \
    tl_k1 = *(const uint4*)((kb) + (size_t)((key0) + 32 + r_) * (ld) + c_);                 \
    tl_v0 = *(const uint4*)((vb) + (size_t)((key0) + r_) * (ld) + c_);                      \
    tl_v1 = *(const uint4*)((vb) + (size_t)((key0) + 32 + r_) * (ld) + c_);                 \
  } while (0)
#define TILE_SSTORE(Ks_, Vs_)                                                               \
  do {                                                                                      \
    const int r_ = tidx() >> 3, c_ = (tidx() & 7) * 8;                            \
    *(uint4*)((Ks_) + r_ * KT_LD + c_) = tl_k0;                                             \
    *(uint4*)((Ks_) + (32 + r_) * KT_LD + c_) = tl_k1;                                      \
    *(uint4*)((Vs_) + r_ * KT_LD + c_) = tl_v0;                                             \
    *(uint4*)((Vs_) + (32 + r_) * KT_LD + c_) = tl_v1;                                      \
  } while (0)
#define TL_GLOAD(P, kb, vb, ld, key0)                                                       \
  do {                                                                                      \
    const int r_ = tidx() >> 3, c_ = (tidx() & 7) * 8;                                      \
    P##_k0 = *(const uint4*)((kb) + (size_t)((key0) + r_) * (ld) + c_);                     \
    P##_k1 = *(const uint4*)((kb) + (size_t)((key0) + 32 + r_) * (ld) + c_);                \
    P##_v0 = *(const uint4*)((vb) + (size_t)((key0) + r_) * (ld) + c_);                     \
    P##_v1 = *(const uint4*)((vb) + (size_t)((key0) + 32 + r_) * (ld) + c_);                \
  } while (0)
#define TL_SSTORE(P, Ks_, Vs_)                                                              \
  do {                                                                                      \
    const int r_ = tidx() >> 3, c_ = (tidx() & 7) * 8;                                      \
    *(uint4*)((Ks_) + r_ * KT_LD + c_) = P##_k0;                                            \
    *(uint4*)((Ks_) + (32 + r_) * KT_LD + c_) = P##_k1;                                     \
    *(uint4*)((Vs_) + r_ * KT_LD + c_) = P##_v0;                                            \
    *(uint4*)((Vs_) + (32 + r_) * KT_LD + c_) = P##_v1;                                     \
  } while (0)
#define KV_SWEEP(kb_, vb_, ld_, nt_, KEYF, ...)                                             \
  {                                                                                         \
    uint4 tA_k0, tA_k1, tA_v0, tA_v1, tB_k0, tB_k1, tB_v0, tB_v1;                           \
    const int nt__ = (nt_);                                                                 \
    if (nt__ > 0) {                                                                         \
      TL_GLOAD(tA, kb_, vb_, ld_, KEYF(0));                                                 \
      TL_SSTORE(tA, smkv, smkv + KT_ELEMS);                                                 \
      if (nt__ > 1) TL_GLOAD(tA, kb_, vb_, ld_, KEYF(1));                                   \
    }                                                                                       \
    __syncthreads();                                                                        \
    for (int it0__ = 0; it0__ < nt__; it0__ += 2) {                                         \
      {                                                                                     \
        const int it = it0__;                                                               \
        if (it + 2 < nt__) TL_GLOAD(tB, kb_, vb_, ld_, KEYF(it + 2));                       \
        const bf16* Ks = smkv;                                                              \
        __VA_ARGS__                                                                         \
        if (it + 1 < nt__) TL_SSTORE(tA, smkv + 2 * KT_ELEMS, smkv + 3 * KT_ELEMS);         \
        __syncthreads();                                                                    \
      }                                                                                     \
      if (it0__ + 1 < nt__) {                                                               \
        const int it = it0__ + 1;                                                           \
        if (it + 2 < nt__) TL_GLOAD(tA, kb_, vb_, ld_, KEYF(it + 2));                       \
        const bf16* Ks = smkv + 2 * KT_ELEMS;                                               \
        __VA_ARGS__                                                                         \
        if (it + 1 < nt__) TL_SSTORE(tB, smkv, smkv + KT_ELEMS);                            \
        __syncthreads();                                                                    \
      }                                                                                     \
    }                                                                                       \
  }
template <int NI>
DEV void attn_scores(const bf16* Ks, const bf16x8 (&qf)[NI][2], f32x4 (&s)[4][NI]) {
  const int lane = tidx() & 63, g4 = lane >> 4, c16 = lane & 15;
#pragma unroll
  for (int mi = 0; mi < 4; ++mi) {
#pragma unroll
    for (int ni = 0; ni < NI; ++ni) s[mi][ni] = f32x4{0.f, 0.f, 0.f, 0.f};
#pragma unroll
    for (int ks = 0; ks < 2; ++ks) {
      bf16x8 kf = *(const bf16x8*)(Ks + (mi * 16 + c16) * KT_LD + ks * 32 + g4 * 8);
#pragma unroll
      for (int ni = 0; ni < NI; ++ni) s[mi][ni] = MFMA16(kf, qf[ni][ks], s[mi][ni]);
    }
  }
}
template <int NI>
DEV void attn_pv(const bf16* Vs, const bf16x8 (&pf)[NI][2], f32x4 (&o)[4][NI]) {
  const int lane = tidx() & 63, g4 = lane >> 4, q4 = (lane & 15) >> 2, p4 = lane & 3;
#pragma unroll
  for (int di = 0; di < 4; ++di) {
#pragma unroll
    for (int ks2 = 0; ks2 < 2; ++ks2) {
      v4i16_t v0 = lds_tr16(Vs + (ks2 * 32 + g4 * 4 + q4) * KT_LD + di * 16 + p4 * 4);
      v4i16_t v1 = lds_tr16(Vs + (ks2 * 32 + 16 + g4 * 4 + q4) * KT_LD + di * 16 + p4 * 4);
      bf16x8 vf = __builtin_shufflevector(v0, v1, 0, 1, 2, 3, 4, 5, 6, 7);
#pragma unroll
      for (int ni = 0; ni < NI; ++ni) o[di][ni] = MFMA16(vf, pf[ni][ks2], o[di][ni]);
    }
  }
}
DEV void exp4_pack(const f32x4& sv, float nm, float& ps, unsigned& w0, unsigned& w1) {
  float p0 = __builtin_amdgcn_exp2f(__builtin_fmaf(sv[0], C2, nm));
  float p1 = __builtin_amdgcn_exp2f(__builtin_fmaf(sv[1], C2, nm));
  float p2 = __builtin_amdgcn_exp2f(__builtin_fmaf(sv[2], C2, nm));
  float p3 = __builtin_amdgcn_exp2f(__builtin_fmaf(sv[3], C2, nm));
  ps += (p0 + p1) + (p2 + p3);
  w0 = cvtpk(p0, p1);
  w1 = cvtpk(p2, p3);
}
template <int NI>
DEV void attn_softmax_pv(const bf16* Vs, f32x4 (&s)[4][NI], AttnSt<NI>& st) {
  bf16x8 pf[NI][2];
#pragma unroll
  for (int ni = 0; ni < NI; ++ni) {
    float mx = -INFINITY;
#pragma unroll
    for (int mi = 0; mi < 4; ++mi)
      mx = fmaxf(fmaxf(mx, fmaxf(s[mi][ni][0], s[mi][ni][1])), fmaxf(s[mi][ni][2], s[mi][ni][3]));
    mx = fmaxf(mx, shx(mx, 16));
    mx = fmaxf(mx, shx(mx, 32));
    const float mn = fmaxf(st.m[ni], mx);
    const float mu = (mn == -INFINITY) ? 0.f : mn;
    const float corr = __builtin_amdgcn_exp2f((st.m[ni] - mu) * C2);
    st.m[ni] = mn;
    const float nm = -mu * C2;
    float ps = 0.f;
    u32x4_t wa, wb;
    unsigned t0, t1;
    exp4_pack(s[0][ni], nm, ps, t0, t1); wa.x = t0; wa.y = t1;
    exp4_pack(s[1][ni], nm, ps, t0, t1); wa.z = t0; wa.w = t1;
    exp4_pack(s[2][ni], nm, ps, t0, t1); wb.x = t0; wb.y = t1;
    exp4_pack(s[3][ni], nm, ps, t0, t1); wb.z = t0; wb.w = t1;
    st.l[ni] = st.l[ni] * corr + ps;
#pragma unroll
    for (int di = 0; di < 4; ++di) {
      st.o[di][ni][0] *= corr; st.o[di][ni][1] *= corr; st.o[di][ni][2] *= corr; st.o[di][ni][3] *= corr;
    }
    pf[ni][0] = __builtin_bit_cast(bf16x8, wa);
    pf[ni][1] = __builtin_bit_cast(bf16x8, wb);
  }
  attn_pv<NI>(Vs, pf, st.o);
}

template <int NI>
DEV void attn_softmax_pv_act(const bf16* Vs, f32x4 (&s)[4][NI], AttnSt<NI>& st, const bool (&act)[NI]) {
  bf16x8 pf[NI][2];
#pragma unroll
  for (int ni = 0; ni < NI; ++ni) {
    pf[ni][0] = bf16x8{0, 0, 0, 0, 0, 0, 0, 0};
    pf[ni][1] = bf16x8{0, 0, 0, 0, 0, 0, 0, 0};
    if (act[ni]) {
      float mx = -INFINITY;
#pragma unroll
      for (int mi = 0; mi < 4; ++mi)
        mx = fmaxf(fmaxf(mx, fmaxf(s[mi][ni][0], s[mi][ni][1])), fmaxf(s[mi][ni][2], s[mi][ni][3]));
      mx = fmaxf(mx, shx(mx, 16));
      mx = fmaxf(mx, shx(mx, 32));
      const float mn = fmaxf(st.m[ni], mx);
      const float mu = (mn == -INFINITY) ? 0.f : mn;
      const float corr = __builtin_amdgcn_exp2f((st.m[ni] - mu) * C2);
      st.m[ni] = mn;
      const float nm = -mu * C2;
      float ps = 0.f;
      u32x4_t wa, wb;
      unsigned t0, t1;
      exp4_pack(s[0][ni], nm, ps, t0, t1); wa.x = t0; wa.y = t1;
      exp4_pack(s[1][ni], nm, ps, t0, t1); wa.z = t0; wa.w = t1;
      exp4_pack(s[2][ni], nm, ps, t0, t1); wb.x = t0; wb.y = t1;
      exp4_pack(s[3][ni], nm, ps, t0, t1); wb.z = t0; wb.w = t1;
      st.l[ni] = st.l[ni] * corr + ps;
#pragma unroll
      for (int di = 0; di < 4; ++di) {
        st.o[di][ni][0] *= corr; st.o[di][ni][1] *= corr; st.o[di][ni][2] *= corr; st.o[di][ni][3] *= corr;
      }
      pf[ni][0] = __builtin_bit_cast(bf16x8, wa);
      pf[ni][1] = __builtin_bit_cast(bf16x8, wb);
    }
  }
  const int lane = tidx() & 63, g4 = lane >> 4, q4 = (lane & 15) >> 2, p4 = lane & 3;
#pragma unroll
  for (int di = 0; di < 4; ++di) {
#pragma unroll
    for (int ks2 = 0; ks2 < 2; ++ks2) {
      v4i16_t v0 = lds_tr16(Vs + (ks2 * 32 + g4 * 4 + q4) * KT_LD + di * 16 + p4 * 4);
      v4i16_t v1 = lds_tr16(Vs + (ks2 * 32 + 16 + g4 * 4 + q4) * KT_LD + di * 16 + p4 * 4);
      bf16x8 vf = __builtin_shufflevector(v0, v1, 0, 1, 2, 3, 4, 5, 6, 7);
#pragma unroll
      for (int ni = 0; ni < NI; ++ni)
        if (act[ni]) st.o[di][ni] = MFMA16(vf, pf[ni][ks2], st.o[di][ni]);
    }
  }
}
template <int NI>
DEV int gate_top1(f32x4 (&gs)[4][NI], int ni, int g4) {
  float bv = -INFINITY;
  int bi = 1 << 20;
#pragma unroll
  for (int mi = 0; mi < 4; ++mi)
#pragma unroll
    for (int r = 0; r < 4; ++r) {
      float v = gs[mi][ni][r];
      if (v > bv) { bv = v; bi = mi * 16 + g4 * 4 + r; }
    }
#pragma unroll
  for (int off = 16; off <= 32; off <<= 1) {
    float ov = shx(bv, off);
    int oi = shx(bi, off);
    if (ov > bv || (ov == bv && oi < bi)) { bv = ov; bi = oi; }
  }
#pragma unroll
  for (int mi = 0; mi < 4; ++mi)
#pragma unroll
    for (int r = 0; r < 4; ++r)
      if (mi * 16 + g4 * 4 + r == bi) gs[mi][ni][r] = -INFINITY;
  return (bv == -INFINITY) ? -1 : bi;
}
template <int NI>
DEV void moba_mfma_item(const Params& p, int item, char* smem, bf16* outbuf) {
  constexpr int QB = 64 * NI;
  bf16* sm = (bf16*)smem;
  const int bh = item & 15, cq = (S / QB - 1) - (item >> 4);
  const int b = bh >> 3, h = bh & 7;
  const int s0 = cq * QB, blk = s0 >> 8;
  const int lane = tidx() & 63, wave = tidx() >> 6, g4 = lane >> 4, c16 = lane & 15;
  const bf16* proj = (const bf16*)(p.ws + OFF_PROJ) + (size_t)b * S * PC;
  bf16x8 qf[NI][2];
  int tq[NI];
#pragma unroll
  for (int ni = 0; ni < NI; ++ni) {
    tq[ni] = s0 + wave * 16 * NI + ni * 16 + c16;
#pragma unroll
    for (int ks = 0; ks < 2; ++ks)
      qf[ni][ks] = *(const bf16x8*)(proj + (size_t)tq[ni] * PC + C_MQ + h * 64 + ks * 32 + g4 * 8);
  }
  int i0[NI], i1[NI], i2[NI];
  {
    const bf16* kmh = (const bf16*)(p.ws + OFF_KMHL) + ((size_t)(b * 8 + h) * 64) * 64;
    const bf16* kml = kmh + (size_t)2 * 8 * 64 * 64;
    f32x4 gs[4][NI];
#pragma unroll
    for (int mi = 0; mi < 4; ++mi) {
#pragma unroll
      for (int ni = 0; ni < NI; ++ni) gs[mi][ni] = f32x4{0.f, 0.f, 0.f, 0.f};
#pragma unroll
      for (int ks = 0; ks < 2; ++ks) {
        bf16x8 ah = *(const bf16x8*)(kmh + (mi * 16 + c16) * 64 + ks * 32 + g4 * 8);
        bf16x8 al_ = *(const bf16x8*)(kml + (mi * 16 + c16) * 64 + ks * 32 + g4 * 8);
#pragma unroll
        for (int ni = 0; ni < NI; ++ni) {
          gs[mi][ni] = MFMA16(ah, qf[ni][ks], gs[mi][ni]);
          gs[mi][ni] = MFMA16(al_, qf[ni][ks], gs[mi][ni]);
        }
      }
    }
#pragma unroll
    for (int ni = 0; ni < NI; ++ni) {
#pragma unroll
      for (int mi = 0; mi < 4; ++mi)
#pragma unroll
        for (int r = 0; r < 4; ++r)
          if (mi * 16 + g4 * 4 + r >= blk) gs[mi][ni][r] = -INFINITY;
      i0[ni] = gate_top1(gs, ni, g4);
      i1[ni] = gate_top1(gs, ni, g4);
      i2[ni] = gate_top1(gs, ni, g4);
    }
  }
  AttnSt<NI> st;
  attn_init<NI>(st);
  const int ntiles = (s0 + QB) >> 6;
  const bf16* kb = (const bf16*)(p.ws + OFF_MKB) + ((size_t)(b * 8 + h) * S) * 64;
  const bf16* vb = (const bf16*)(p.ws + OFF_MVB) + ((size_t)(b * 8 + h) * S) * 64;
  bf16* smkv = sm;
  __syncthreads();
#define MOBA_KEY(i) ((i) * 64)
  KV_SWEEP(kb, vb, 64, ntiles, MOBA_KEY,
    const int n = it >> 2;
    const bool own = (n == blk);
    const int kbase = it * 64;
    bool wave_active = own;
    if (!own) {
      bool anyq = false;
      _Pragma("unroll") for (int ni = 0; ni < NI; ++ni) anyq = anyq || (n == i0[ni]) || (n == i1[ni]) || (n == i2[ni]);
      wave_active = __builtin_amdgcn_ballot_w64(anyq) != 0ull;
    }
    if (wave_active) {
      f32x4 s[4][NI];
      attn_scores<NI>(Ks, qf, s);
      _Pragma("unroll") for (int ni = 0; ni < NI; ++ni) {
        if (own) {
          _Pragma("unroll") for (int mi = 0; mi < 4; ++mi)
            _Pragma("unroll") for (int r = 0; r < 4; ++r)
              if (kbase + mi * 16 + g4 * 4 + r > tq[ni]) s[mi][ni][r] = -INFINITY;
        } else {
          const bool okb = (n == i0[ni]) | (n == i1[ni]) | (n == i2[ni]);
          if (!okb) {
            _Pragma("unroll") for (int mi = 0; mi < 4; ++mi) s[mi][ni] = f32x4{-INFINITY, -INFINITY, -INFINITY, -INFINITY};
          }
        }
      }
      attn_softmax_pv<NI>(Ks + KT_ELEMS, s, st);
    }
  )
#pragma unroll
  for (int ni = 0; ni < NI; ++ni) {
    float l = st.l[ni];
    l += shx(l, 16);
    l += shx(l, 32);
    const float inv = 1.f / l;
    bf16* op = outbuf + ((size_t)b * S + tq[ni]) * 512 + h * 64 + g4 * 4;
#pragma unroll
    for (int di = 0; di < 4; ++di) {
      uint2 pk;
      pk.x = cvtpk(st.o[di][ni][0] * inv, st.o[di][ni][1] * inv);
      pk.y = cvtpk(st.o[di][ni][2] * inv, st.o[di][ni][3] * inv);
      *(uint2*)(op + di * 16) = pk;
    }
  }
}

DEV int moba_list_base(int n) { return n * S - 128 * n * (n + 1); }
template <int NI>
DEV void moba_gate_item(const Params& p, int item) {
  constexpr int QB = 64 * NI;
  const int bh = item & 15, cq = item >> 4;
  const int b = bh >> 3, h = bh & 7;
  const int s0 = cq * QB, blk = s0 >> 8;
  if (blk == 0) return;
  const int lane = tidx() & 63, wave = tidx() >> 6, g4 = lane >> 4, c16 = lane & 15;
  const bf16* proj = (const bf16*)(p.ws + OFF_PROJ) + (size_t)b * S * PC;
  bf16x8 qf[NI][2];
  int tq[NI];
#pragma unroll
  for (int ni = 0; ni < NI; ++ni) {
    tq[ni] = s0 + wave * 16 * NI + ni * 16 + c16;
#pragma unroll
    for (int ks = 0; ks < 2; ++ks)
      qf[ni][ks] = *(const bf16x8*)(proj + (size_t)tq[ni] * PC + C_MQ + h * 64 + ks * 32 + g4 * 8);
  }
  const bf16* kmh = (const bf16*)(p.ws + OFF_KMHL) + ((size_t)(b * 8 + h) * 64) * 64;
  const bf16* kml = kmh + (size_t)2 * 8 * 64 * 64;
  f32x4 gs[4][NI];
#pragma unroll
  for (int mi = 0; mi < 4; ++mi) {
#pragma unroll
    for (int ni = 0; ni < NI; ++ni) gs[mi][ni] = f32x4{0.f, 0.f, 0.f, 0.f};
#pragma unroll
    for (int ks = 0; ks < 2; ++ks) {
      bf16x8 ah = *(const bf16x8*)(kmh + (mi * 16 + c16) * 64 + ks * 32 + g4 * 8);
      bf16x8 al_ = *(const bf16x8*)(kml + (mi * 16 + c16) * 64 + ks * 32 + g4 * 8);
#pragma unroll
      for (int ni = 0; ni < NI; ++ni) {
        gs[mi][ni] = MFMA16(ah, qf[ni][ks], gs[mi][ni]);
        gs[mi][ni] = MFMA16(al_, qf[ni][ks], gs[mi][ni]);
      }
    }
  }
  unsigned short* lists = (unsigned short*)(p.ws + OFF_MLIST) + (size_t)(b * 8 + h) * MLIST_PER_BH;
  int* cnt = (int*)(p.ws + OFF_MCNT) + (b * 8 + h) * 64;
#pragma unroll
  for (int ni = 0; ni < NI; ++ni) {
#pragma unroll
    for (int mi = 0; mi < 4; ++mi)
#pragma unroll
      for (int r = 0; r < 4; ++r)
        if (mi * 16 + g4 * 4 + r >= blk) gs[mi][ni][r] = -INFINITY;
    const int s0i = gate_top1(gs, ni, g4);
    const int s1i = gate_top1(gs, ni, g4);
    const int s2i = gate_top1(gs, ni, g4);
    if (g4 == 0) {
      if (s0i >= 0) { const int pos = atomicAdd(cnt + s0i, 1); lists[moba_list_base(s0i) + pos] = (unsigned short)(tq[ni] | (0 << 14)); }
      if (s1i >= 0) { const int pos = atomicAdd(cnt + s1i, 1); lists[moba_list_base(s1i) + pos] = (unsigned short)(tq[ni] | (1 << 14)); }
      if (s2i >= 0) { const int pos = atomicAdd(cnt + s2i, 1); lists[moba_list_base(s2i) + pos] = (unsigned short)(tq[ni] | (2 << 14)); }
    }
  }
}
template <int NI>
DEV void moba_part_item(const Params& p, int b, int item, char* smem) {
  constexpr int CH = 64 * NI;
  bf16* smkv = (bf16*)smem;
  const int n = item >> 6, h = (item >> 3) & 7, part = item & 7;
  const int lane = tidx() & 63, wave = tidx() >> 6, g4 = lane >> 4, c16 = lane & 15;
  const int cnt = ((const int*)(p.ws + OFF_MCNT))[(b * 8 + h) * 64 + n];
  const unsigned short* list = (const unsigned short*)(p.ws + OFF_MLIST) + (size_t)(b * 8 + h) * MLIST_PER_BH + moba_list_base(n);
  const bf16* proj = (const bf16*)(p.ws + OFF_PROJ) + (size_t)b * S * PC;
  const bf16* kb = (const bf16*)(p.ws + OFF_MKB) + ((size_t)(b * 8 + h) * S + n * 256) * 64;
  const bf16* vb = (const bf16*)(p.ws + OFF_MVB) + ((size_t)(b * 8 + h) * S + n * 256) * 64;
  bf16* po = (bf16*)(p.ws + OFF_MPO);
  float2* pml = (float2*)(p.ws + OFF_MPML);
  for (int c = part; c * CH < cnt; c += 8) {
    bf16x8 qf[NI][2];
    int tcol[NI], slot[NI];
    bool valid[NI];
#pragma unroll
    for (int ni = 0; ni < NI; ++ni) {
      const int idx = c * CH + wave * 16 * NI + ni * 16 + c16;
      valid[ni] = idx < cnt;
      const unsigned e = list[valid[ni] ? idx : 0];
      tcol[ni] = e & 0x3FFF;
      slot[ni] = e >> 14;
#pragma unroll
      for (int ks = 0; ks < 2; ++ks)
        qf[ni][ks] = *(const bf16x8*)(proj + (size_t)tcol[ni] * PC + C_MQ + h * 64 + ks * 32 + g4 * 8);
    }
    AttnSt<NI> st;
    attn_init<NI>(st);
    __syncthreads();
#define MOBA_PKEY(i) ((i) * 64)
    KV_SWEEP(kb, vb, 64, 4, MOBA_PKEY,
      f32x4 s[4][NI];
      attn_scores<NI>(Ks, qf, s);
      attn_softmax_pv<NI>(Ks + KT_ELEMS, s, st);
    )
#pragma unroll
    for (int ni = 0; ni < NI; ++ni) {
      float l = st.l[ni];
      l += shx(l, 16);
      l += shx(l, 32);
      if (valid[ni]) {
        const size_t rec = ((size_t)h * S + tcol[ni]) * 3 + slot[ni];
        if (g4 == 0) pml[rec] = float2{st.m[ni], l};
        bf16* op = po + rec * 64 + g4 * 4;
#pragma unroll
        for (int di = 0; di < 4; ++di) {
          uint2 pk;
          pk.x = cvtpk(st.o[di][ni][0], st.o[di][ni][1]);
          pk.y = cvtpk(st.o[di][ni][2], st.o[di][ni][3]);
          *(uint2*)(op + di * 16) = pk;
        }
      }
    }
  }
}
template <int NI>
DEV void moba_part_item2(const Params& p, int b, int item, char* smem) {
  constexpr int WCH = 16 * NI;
  bf16* Kall = (bf16*)smem;
  bf16* Vall = Kall + 256 * KT_LD;
  static_assert(2 * 256 * KT_LD * 2 <= SMEM_BYTES, "moba block staging");
  const int n = item >> 6, h = (item >> 3) & 7, part = item & 7;
  const int tid = tidx(), lane = tid & 63, wave = tid >> 6, g4 = lane >> 4, c16 = lane & 15;
  const int cnt = ((const int*)(p.ws + OFF_MCNT))[(b * 8 + h) * 64 + n];
  const bool active = part * 4 * WCH < cnt;
  const unsigned short* list = (const unsigned short*)(p.ws + OFF_MLIST) + (size_t)(b * 8 + h) * MLIST_PER_BH + moba_list_base(n);
  const bf16* proj = (const bf16*)(p.ws + OFF_PROJ) + (size_t)b * S * PC;
  const bf16* kb = (const bf16*)(p.ws + OFF_MKB) + ((size_t)(b * 8 + h) * S + n * 256) * 64;
  const bf16* vb = (const bf16*)(p.ws + OFF_MVB) + ((size_t)(b * 8 + h) * S + n * 256) * 64;
  bf16* po = (bf16*)(p.ws + OFF_MPO);
  float2* pml = (float2*)(p.ws + OFF_MPML);
  __syncthreads();
  if (active) {
#pragma unroll
    for (int i = 0; i < 8; ++i) {
      const int id = tid + 256 * i, r = id >> 3, c = (id & 7) * 8;
      const uint4 kv = *(const uint4*)(kb + (size_t)r * 64 + c);
      const uint4 vv = *(const uint4*)(vb + (size_t)r * 64 + c);
      *(uint4*)(Kall + r * KT_LD + c) = kv;
      *(uint4*)(Vall + r * KT_LD + c) = vv;
    }
  }
  __syncthreads();
  if (!active) return;
  for (int wc = part * 4 + wave; wc * WCH < cnt; wc += 32) {
    bf16x8 qf[NI][2];
    int tcol[NI], slot[NI];
    bool valid[NI];
#pragma unroll
    for (int ni = 0; ni < NI; ++ni) {
      const int idx = wc * WCH + ni * 16 + c16;
      valid[ni] = idx < cnt;
      const unsigned e = list[valid[ni] ? idx : 0];
      tcol[ni] = e & 0x3FFF;
      slot[ni] = e >> 14;
#pragma unroll
      for (int ks = 0; ks < 2; ++ks)
        qf[ni][ks] = *(const bf16x8*)(proj + (size_t)tcol[ni] * PC + C_MQ + h * 64 + ks * 32 + g4 * 8);
    }
    AttnSt<NI> st;
    attn_init<NI>(st);
#pragma unroll 1
    for (int kt = 0; kt < 4; ++kt) {
      f32x4 s[4][NI];
      attn_scores<NI>(Kall + kt * 64 * KT_LD, qf, s);
      attn_softmax_pv<NI>(Vall + kt * 64 * KT_LD, s, st);
    }
#pragma unroll
    for (int ni = 0; ni < NI; ++ni) {
      float l = st.l[ni];
      l += shx(l, 16);
      l += shx(l, 32);
      if (valid[ni]) {
        const size_t rec = ((size_t)h * S + tcol[ni]) * 3 + slot[ni];
        if (g4 == 0) pml[rec] = float2{st.m[ni], l};
        bf16* op = po + rec * 64 + g4 * 4;
#pragma unroll
        for (int di = 0; di < 4; ++di) {
          uint2 pk;
          pk.x = cvtpk(st.o[di][ni][0], st.o[di][ni][1]);
          pk.y = cvtpk(st.o[di][ni][2], st.o[di][ni][3]);
          *(uint2*)(op + di * 16) = pk;
        }
      }
    }
  }
}
template <int NI>
DEV void moba_merge_item(const Params& p, int b, int item, char* smem, bf16* outbuf) {
  constexpr int QB = 64 * NI;
  constexpr int NCQ = S / QB;
  bf16* smkv = (bf16*)smem;
  const int h = item & 7, cq = item >> 3;
  static_assert(NCQ * 8 == 8 * (S / QB), "");
  const int s0 = cq * QB, blk = s0 >> 8;
  const int lane = tidx() & 63, wave = tidx() >> 6, g4 = lane >> 4, c16 = lane & 15;
  const bf16* proj = (const bf16*)(p.ws + OFF_PROJ) + (size_t)b * S * PC;
  bf16x8 qf[NI][2];
  int tq[NI];
#pragma unroll
  for (int ni = 0; ni < NI; ++ni) {
    tq[ni] = s0 + wave * 16 * NI + ni * 16 + c16;
#pragma unroll
    for (int ks = 0; ks < 2; ++ks)
      qf[ni][ks] = *(const bf16x8*)(proj + (size_t)tq[ni] * PC + C_MQ + h * 64 + ks * 32 + g4 * 8);
  }
  const bf16* kb = (const bf16*)(p.ws + OFF_MKB) + ((size_t)(b * 8 + h) * S) * 64;
  const bf16* vb = (const bf16*)(p.ws + OFF_MVB) + ((size_t)(b * 8 + h) * S) * 64;
  AttnSt<NI> st;
  attn_init<NI>(st);
  const int kt0 = blk * 4;
  const int ntl = ((s0 + QB - 1) >> 6) - kt0 + 1;
  __syncthreads();
#define MOBA_MKEY(i) ((kt0 + (i)) * 64)
  KV_SWEEP(kb, vb, 64, ntl, MOBA_MKEY,
    const int kbase = (kt0 + it) * 64;
    f32x4 s[4][NI];
    attn_scores<NI>(Ks, qf, s);
    _Pragma("unroll") for (int ni = 0; ni < NI; ++ni)
      _Pragma("unroll") for (int mi = 0; mi < 4; ++mi)
        _Pragma("unroll") for (int r = 0; r < 4; ++r)
          if (kbase + mi * 16 + g4 * 4 + r > tq[ni]) s[mi][ni][r] = -INFINITY;
    attn_softmax_pv<NI>(Ks + KT_ELEMS, s, st);
  )
  const int nsl = (blk < 3) ? blk : 3;
  const bf16* po = (const bf16*)(p.ws + OFF_MPO);
  const float2* pml = (const float2*)(p.ws + OFF_MPML);
#pragma unroll
  for (int ni = 0; ni < NI; ++ni) {
    float l = st.l[ni];
    l += shx(l, 16);
    l += shx(l, 32);
    const size_t rec0 = ((size_t)h * S + tq[ni]) * 3;
    float ms[3], ls[3];
    float M = st.m[ni];
#pragma unroll
    for (int s = 0; s < 3; ++s) {
      ms[s] = -INFINITY;
      ls[s] = 0.f;
      if (s < nsl) {
        const float2 v = pml[rec0 + s];
        ms[s] = v.x;
        ls[s] = v.y;
        M = fmaxf(M, v.x);
      }
    }
    const float fo = __builtin_amdgcn_exp2f((st.m[ni] - M) * C2);
    l *= fo;
    float f[3];
#pragma unroll
    for (int s = 0; s < 3; ++s) {
      f[s] = (s < nsl) ? __builtin_amdgcn_exp2f((ms[s] - M) * C2) : 0.f;
      l += ls[s] * f[s];
    }
    const float inv = 1.f / l;
    bf16* op = outbuf + ((size_t)b * S + tq[ni]) * 512 + h * 64 + g4 * 4;
#pragma unroll
    for (int di = 0; di < 4; ++di) {
      float o0 = st.o[di][ni][0] * fo, o1 = st.o[di][ni][1] * fo, o2 = st.o[di][ni][2] * fo, o3 = st.o[di][ni][3] * fo;
#pragma unroll
      for (int s = 0; s < 3; ++s) {
        if (s < nsl) {
          const uint2 pv = *(const uint2*)(po + (rec0 + s) * 64 + di * 16 + g4 * 4);
          o0 += f[s] * __uint_as_float(pv.x << 16);
          o1 += f[s] * __uint_as_float(pv.x & 0xffff0000u);
          o2 += f[s] * __uint_as_float(pv.y << 16);
          o3 += f[s] * __uint_as_float(pv.y & 0xffff0000u);
        }
      }
      uint2 pk;
      pk.x = cvtpk(o0 * inv, o1 * inv);
      pk.y = cvtpk(o2 * inv, o3 * inv);
      *(uint2*)(op + di * 16) = pk;
    }
  }
}

template <int NI>
DEV void attn_stats(f32x4 (&s)[4][NI], float (&m)[NI], float (&l)[NI]) {
#pragma unroll
  for (int ni = 0; ni < NI; ++ni) {
    float mx = -INFINITY;
#pragma unroll
    for (int mi = 0; mi < 4; ++mi)
      mx = fmaxf(fmaxf(mx, fmaxf(s[mi][ni][0], s[mi][ni][1])), fmaxf(s[mi][ni][2], s[mi][ni][3]));
    mx = fmaxf(mx, shx(mx, 16));
    mx = fmaxf(mx, shx(mx, 32));
    const float mn = fmaxf(m[ni], mx);
    const float mu = (mn == -INFINITY) ? 0.f : mn;
    const float corr = __builtin_amdgcn_exp2f((m[ni] - mu) * C2);
    m[ni] = mn;
    const float nm = -mu * C2;
    float ps = 0.f;
#pragma unroll
    for (int mi = 0; mi < 4; ++mi)
#pragma unroll
      for (int r = 0; r < 4; ++r) ps += __builtin_amdgcn_exp2f(__builtin_fmaf(s[mi][ni][r], C2, nm));
    l[ni] = l[ni] * corr + ps;
  }
}
DEV bf16x8 rope_frag(bf16x8 qv, const float* __restrict__ rope_t, int g4) {
  u32x4_t w = __builtin_bit_cast(u32x4_t, qv);
  u32x4_t pw;
  pw.x = shx(w.x, 16); pw.y = shx(w.y, 16); pw.z = shx(w.z, 16); pw.w = shx(w.w, 16);
  float f[8], pf[8];
  unpack8(uint4{w.x, w.y, w.z, w.w}, f);
  unpack8(uint4{pw.x, pw.y, pw.z, pw.w}, pf);
  const float4 c0 = *(const float4*)(rope_t), c1 = *(const float4*)(rope_t + 4);
  const float4 s0 = *(const float4*)(rope_t + 8), s1 = *(const float4*)(rope_t + 12);
  const float cs[8] = {c0.x, c0.y, c0.z, c0.w, c1.x, c1.y, c1.z, c1.w};
  const float sn[8] = {s0.x, s0.y, s0.z, s0.w, s1.x, s1.y, s1.z, s1.w};
  const float sg = (g4 == 0) ? -1.f : 1.f;
  float o[8];
#pragma unroll
  for (int i = 0; i < 8; ++i) o[i] = (g4 < 2) ? (f[i] * cs[i] + sg * pf[i] * sn[i]) : f[i];
  u32x4_t r;
  r.x = cvtpk(o[0], o[1]); r.y = cvtpk(o[2], o[3]); r.z = cvtpk(o[4], o[5]); r.w = cvtpk(o[6], o[7]);
  return __builtin_bit_cast(bf16x8, r);
}

DEV unsigned pack4_fp8q(float a, float b, float c, float d) {
  int q = __builtin_amdgcn_cvt_pk_fp8_f32(a, b, 0, false);
  q = __builtin_amdgcn_cvt_pk_fp8_f32(c, d, q, true);
  return (unsigned)q;
}
DEV float amax8_bf16(uint4 v, float m) {
  float f[8];
  unpack8(v, f);
#pragma unroll
  for (int i = 0; i < 8; ++i) m = fmaxf(m, fabsf(f[i]));
  return m;
}
DEV void kvamax_item(const Params& p, int layer, int item) {
  const int tid = tidx();
  const int bk = item >> 6, part = item & 63;
  const bf16* kp = (const bf16*)(p.ws + OFF_KSB) + ((size_t)bk * S + part * 256) * 64 + tid * 64;
  const bf16* vp = (const bf16*)(p.ws + OFF_VSB) + ((size_t)bk * S + part * 256) * 64 + tid * 64;
  float mk = 0.f, mv = 0.f;
#pragma unroll
  for (int i = 0; i < 8; ++i) {
    mk = amax8_bf16(*(const uint4*)(kp + i * 8), mk);
    mv = amax8_bf16(*(const uint4*)(vp + i * 8), mv);
  }
#pragma unroll
  for (int o = 32; o >= 1; o >>= 1) { mk = fmaxf(mk, shx(mk, o)); mv = fmaxf(mv, shx(mv, o)); }
  if ((tid & 63) == 0) {
    atomicMax((unsigned*)(p.ws + OFF_BAR) + 2 + 2 * layer, (unsigned)__float_as_int(mk));
    atomicMax((unsigned*)(p.ws + OFF_BAR) + 3 + 2 * layer, (unsigned)__float_as_int(mv));
  }
}
DEV float kv_amax(const Params& p, int layer, int which) {
  return __int_as_float((int)__hip_atomic_load((const unsigned*)(p.ws + OFF_BAR) + 2 + 2 * layer + which, __ATOMIC_RELAXED, __HIP_MEMORY_SCOPE_AGENT));
}
DEV void kvq_item(const Params& p, int layer, int item, float* sm) {
  const int tid = tidx();
  const int bk = item >> 8, blk = item & 255;
  const float ak = kv_amax(p, layer, 0), av = kv_amax(p, layer, 1);
  const float ik = (ak > 0.f) ? 224.f / ak : 0.f, iv = (av > 0.f) ? 224.f / av : 0.f;
  const size_t row0 = (size_t)bk * S + blk * 64;
  {
    const int r = tid >> 2, q = tid & 3;
    const bf16* kp = (const bf16*)(p.ws + OFF_KSB) + (row0 + r) * 64 + q * 16;
    float f[16];
    unpack8(*(const uint4*)kp, f);
    unpack8(*(const uint4*)(kp + 8), f + 8);
    uint4 o;
    o.x = pack4_fp8q(f[0] * ik, f[1] * ik, f[2] * ik, f[3] * ik);
    o.y = pack4_fp8q(f[4] * ik, f[5] * ik, f[6] * ik, f[7] * ik);
    o.z = pack4_fp8q(f[8] * ik, f[9] * ik, f[10] * ik, f[11] * ik);
    o.w = pack4_fp8q(f[12] * ik, f[13] * ik, f[14] * ik, f[15] * ik);
    *(uint4*)((unsigned char*)(p.ws + OFF_KS8) + (row0 + r) * 64 + q * 16) = o;
    const bf16* vp = (const bf16*)(p.ws + OFF_VSB) + (row0 + r) * 64 + q * 16;
    unpack8(*(const uint4*)vp, f);
    unpack8(*(const uint4*)(vp + 8), f + 8);
#pragma unroll
    for (int i = 0; i < 16; ++i) sm[r * 65 + q * 16 + i] = f[i] * iv;
  }
  __syncthreads();
  {
    const int d = tid >> 2, q = tid & 3;
    float f[16];
#pragma unroll
    for (int i = 0; i < 16; ++i) {
      const int ks2 = q >> 1, g4 = (q & 1) * 2 + (i >> 3), j = i & 7;
      const int key = 32 * ks2 + 16 * (j >> 2) + 4 * g4 + (j & 3);
      f[i] = sm[key * 65 + d];
    }
    uint4 o;
    o.x = pack4_fp8q(f[0], f[1], f[2], f[3]);
    o.y = pack4_fp8q(f[4], f[5], f[6], f[7]);
    o.z = pack4_fp8q(f[8], f[9], f[10], f[11]);
    o.w = pack4_fp8q(f[12], f[13], f[14], f[15]);
    *(uint4*)((unsigned char*)(p.ws + OFF_VT8) + row0 * 64 + d * 64 + q * 16) = o;
  }
  __syncthreads();
}
typedef long i64_t;
template <int NI>
DEV void softmax_one8(f32x4 (&s)[4], AttnSt<NI>& st, int ni, float c2, i64_t& pf0, i64_t& pf1) {
  float mx = -INFINITY;
#pragma unroll
  for (int mi = 0; mi < 4; ++mi)
    mx = fmaxf(fmaxf(mx, fmaxf(s[mi][0], s[mi][1])), fmaxf(s[mi][2], s[mi][3]));
  mx = fmaxf(mx, shx(mx, 16));
  mx = fmaxf(mx, shx(mx, 32));
  const float mn = fmaxf(st.m[ni], mx * c2);
  const float mu = (mn == -INFINITY) ? 0.f : mn;
  const float corr = __builtin_amdgcn_exp2f(st.m[ni] - mu);
  st.m[ni] = mn;
  const float nm = 7.f - mu;
  float ps = 0.f;
  unsigned w[4];
#pragma unroll
  for (int mi = 0; mi < 4; ++mi) {
    const float p0 = __builtin_amdgcn_exp2f(__builtin_fmaf(s[mi][0], c2, nm));
    const float p1 = __builtin_amdgcn_exp2f(__builtin_fmaf(s[mi][1], c2, nm));
    const float p2 = __builtin_amdgcn_exp2f(__builtin_fmaf(s[mi][2], c2, nm));
    const float p3 = __builtin_amdgcn_exp2f(__builtin_fmaf(s[mi][3], c2, nm));
    ps += (p0 + p1) + (p2 + p3);
    w[mi] = pack4_fp8q(p0, p1, p2, p3);
  }
  st.l[ni] = st.l[ni] * corr + ps;
#pragma unroll
  for (int di = 0; di < 4; ++di) {
    st.o[di][ni][0] *= corr; st.o[di][ni][1] *= corr; st.o[di][ni][2] *= corr; st.o[di][ni][3] *= corr;
  }
  pf0 = (i64_t)(((unsigned long long)w[1] << 32) | (unsigned long long)w[0]);
  pf1 = (i64_t)(((unsigned long long)w[3] << 32) | (unsigned long long)w[2]);
}
#define MFMA8(a, b, c) __builtin_amdgcn_mfma_f32_16x16x32_fp8_fp8(a, b, c, 0, 0, 0)
template <int NI>
DEV void nsa_item(const Params& p, int layer, int item, char* smem, bf16* outbuf) {
  constexpr int QN = 16 * NI;
  constexpr int NCH = S / QN;
  bf16* smkv = (bf16*)smem;
  float* imp = (float*)(smem + 36864);
  int* sel = (int*)(smem + 36864 + QN * 257 * 4);
  unsigned* bmq = (unsigned*)(sel + QN * 16);
  unsigned* bmu = bmq + QN * 8;
  int* ulist = (int*)(bmu + 4 * NI * 8);
  static_assert(36864 + QN * 257 * 4 + QN * 16 * 4 + QN * 8 * 4 + 4 * NI * 8 * 4 + 257 * 4 <= SMEM_BYTES, "nsa lds");
  static_assert(NI == 2, "per-wave union bitmaps use bmu[8 .. 40)");
  const int tid = tidx(), lane = tid & 63, wave = tid >> 6, g4 = lane >> 4, c16 = lane & 15;
  const int bk = item & 3, cq = (NCH - 1) - (item >> 2);
  const int b = bk >> 1, kvh = bk & 1;
  const int s0 = cq * QN, cur = s0 >> 6;
  if (PROBE_NSA && b == 1) return;
  const bf16* proj = (const bf16*)(p.ws + OFF_PROJ) + (size_t)b * S * PC;
  const float* rope = (const float*)(p.ws + OFF_ROPE);
  int tq[NI], qlv[NI];
  float gate0[NI], gate1[NI], gate2[NI];
  bf16x8 qraw[NI][2], qrot[NI][2];
#pragma unroll
  for (int ni = 0; ni < NI; ++ni) {
    const int R = wave * 16 * NI + ni * 16 + c16;
    qlv[ni] = R >> 2;
    const int g = R & 3;
    tq[ni] = s0 + qlv[ni];
    const bf16* qp = proj + (size_t)tq[ni] * PC + C_NQ + (kvh * 4 + g) * 64 + g4 * 8;
    qraw[ni][0] = *(const bf16x8*)(qp);
    qraw[ni][1] = *(const bf16x8*)(qp + 32);
    qrot[ni][0] = rope_frag(qraw[ni][0], rope + (size_t)tq[ni] * 16, g4);
    qrot[ni][1] = qraw[ni][1];
    const bf16* gp = proj + (size_t)tq[ni] * PC + C_NG + (kvh * 4 + g) * 3;
    gate0[ni] = (!PROBE_NSA || (PROBE_NSA & 1)) ? sigmoidf_(bf2f(gp[0])) : 0.f;
    gate1[ni] = (!PROBE_NSA || (PROBE_NSA & 2)) ? sigmoidf_(bf2f(gp[1])) : 0.f;
    gate2[ni] = (!PROBE_NSA || (PROBE_NSA & 4)) ? sigmoidf_(bf2f(gp[2])) : 0.f;
  }
  for (int i = tid; i < QN * 257; i += 256) imp[i] = 0.f;
  for (int i = tid; i < QN * 8 + 4 * NI * 8; i += 256) bmq[i] = 0u;
  f32x4 acc[4][NI];
#pragma unroll
  for (int ni = 0; ni < NI; ++ni)
#pragma unroll
    for (int di = 0; di < 4; ++di) acc[di][ni] = f32x4{0.f, 0.f, 0.f, 0.f};
  TILE_DECL;
  {
    int nv[NI];
#pragma unroll
    for (int ni = 0; ni < NI; ++ni) nv[ni] = (tq[ni] >= 31) ? (((tq[ni] - 31) >> 4) + 1) : 0;
    const int tlast = s0 + QN - 1;
    const int nvmax = (tlast >= 31) ? (((tlast - 31) >> 4) + 1) : 0;
    const int ntc = (nvmax + 63) >> 6;
    const bf16* kb = (const bf16*)(p.ws + OFF_KCB) + ((size_t)(b * 2 + kvh) * 1024) * 64;
    const bf16* vb = (const bf16*)(p.ws + OFF_VCB) + ((size_t)(b * 2 + kvh) * 1024) * 64;
    float mA[NI], lA[NI];
#pragma unroll
    for (int ni = 0; ni < NI; ++ni) { mA[ni] = -INFINITY; lA[ni] = 0.f; }
    __syncthreads();
    if (ntc > 0) {
      for (int rep_ = 0; rep_ < ((REP_NSA_PART & 1) ? 2 : 1); ++rep_) {
#pragma unroll
      for (int ni = 0; ni < NI; ++ni) { mA[ni] = -INFINITY; lA[ni] = 0.f; }
      TILE_GLOAD(kb, vb, 64, 0);
      TILE_SSTORE(smkv, smkv + KT_ELEMS);
      __syncthreads();
      for (int kt = 0; kt < ntc; ++kt) {
        if (kt + 1 < ntc) TILE_GLOAD(kb, vb, 64, (kt + 1) * 64);
        const bf16* Ks = smkv + (kt & 1) * 2 * KT_ELEMS;
        f32x4 s[4][NI];
        attn_scores<NI>(Ks, qraw, s);
#pragma unroll
        for (int ni = 0; ni < NI; ++ni)
#pragma unroll
          for (int mi = 0; mi < 4; ++mi)
#pragma unroll
            for (int r = 0; r < 4; ++r)
              if (kt * 64 + mi * 16 + g4 * 4 + r >= nv[ni]) s[mi][ni][r] = -INFINITY;
        attn_stats<NI>(s, mA, lA);
        if (kt + 1 < ntc) {
          bf16* Kn = smkv + ((kt + 1) & 1) * 2 * KT_ELEMS;
          TILE_SSTORE(Kn, Kn + KT_ELEMS);
        }
        __syncthreads();
      }
      }
      float nmB[NI];
#pragma unroll
      for (int ni = 0; ni < NI; ++ni) {
        float l = lA[ni];
        l += shx(l, 16);
        l += shx(l, 32);
        nmB[ni] = (l > 0.f) ? -(mA[ni] * C2 + __builtin_amdgcn_logf(l)) : 0.f;
      }
      TILE_GLOAD(kb, vb, 64, 0);
      TILE_SSTORE(smkv, smkv + KT_ELEMS);
      __syncthreads();
      for (int kt = 0; kt < ntc; ++kt) {
        if (kt + 1 < ntc) TILE_GLOAD(kb, vb, 64, (kt + 1) * 64);
        const bf16* Ks = smkv + (kt & 1) * 2 * KT_ELEMS;
        f32x4 s[4][NI];
        attn_scores<NI>(Ks, qraw, s);
        bf16x8 pf[NI][2];
#pragma unroll
        for (int ni = 0; ni < NI; ++ni) {
          u32x4_t wa, wb;
          float* irow = imp + qlv[ni] * 257 + kt * 16 + g4;
#pragma unroll
          for (int mi = 0; mi < 4; ++mi) {
            float pr[4];
#pragma unroll
            for (int r = 0; r < 4; ++r) {
              const bool ok = (kt * 64 + mi * 16 + g4 * 4 + r) < nv[ni];
              pr[r] = ok ? __builtin_amdgcn_exp2f(__builtin_fmaf(s[mi][ni][r], C2, nmB[ni])) : 0.f;
            }
            float mainv = pr[0] + pr[1] + pr[2] + 0.5f * pr[3];
            float spv = 0.5f * pr[3];
            mainv += shx(mainv, 1);
            mainv += shx(mainv, 2);
            spv += shx(spv, 1);
            spv += shx(spv, 2);
            if ((c16 & 3) == 0) {
              atomicAdd(irow + mi * 4, mainv);
              atomicAdd(irow + mi * 4 + 1, spv);
            }
            const unsigned w0 = cvtpk(pr[0], pr[1]), w1 = cvtpk(pr[2], pr[3]);
            if (mi == 0) { wa.x = w0; wa.y = w1; }
            if (mi == 1) { wa.z = w0; wa.w = w1; }
            if (mi == 2) { wb.x = w0; wb.y = w1; }
            if (mi == 3) { wb.z = w0; wb.w = w1; }
          }
          pf[ni][0] = __builtin_bit_cast(bf16x8, wa);
          pf[ni][1] = __builtin_bit_cast(bf16x8, wb);
        }
        attn_pv<NI>(Ks + KT_ELEMS, pf, acc);
        if (kt + 1 < ntc) {
          bf16* Kn = smkv + ((kt + 1) & 1) * 2 * KT_ELEMS;
          TILE_SSTORE(Kn, Kn + KT_ELEMS);
        }
        __syncthreads();
      }
    }
#pragma unroll
    for (int ni = 0; ni < NI; ++ni)
#pragma unroll
      for (int di = 0; di < 4; ++di) {
        acc[di][ni][0] *= gate0[ni]; acc[di][ni][1] *= gate0[ni]; acc[di][ni][2] *= gate0[ni]; acc[di][ni][3] *= gate0[ni];
      }
  }
  __syncthreads();
#if PROBE_NSA == 8
  if (b == 0 && kvh == 0)
    for (int i = tid; i < QN * 256; i += 256)
      ((float*)(p.ws + OFF_OMOBA))[(size_t)S * 256 + (size_t)(s0 + (i >> 8)) * 256 + (i & 255)] = imp[(i >> 8) * 257 + (i & 255)];
  __syncthreads();
#endif
  for (int qq = 0; qq < 4 * NI; ++qq) {
    const int ql = wave * 4 * NI + qq;
    int mysel = -1;
    if (cur < 16) {
      mysel = (lane <= cur) ? lane : -1;
    } else {
      const float* row = imp + ql * 257;
      float v0 = row[lane], v1 = row[64 + lane], v2 = row[128 + lane], v3 = row[192 + lane];
      if (lane < 1 || lane > cur - 2) v0 = -1.f;
      if (64 + lane > cur - 2) v1 = -1.f;
      if (128 + lane > cur - 2) v2 = -1.f;
      if (192 + lane > cur - 2) v3 = -1.f;
      if (lane == 0) mysel = 0;
      if (lane == 1) mysel = cur - 1;
      if (lane == 2) mysel = cur;
      for (int rd = 3; rd < 16; ++rd) {
        float bv = v0;
        int bi = lane;
        if (v1 > bv) { bv = v1; bi = 64 + lane; }
        if (v2 > bv) { bv = v2; bi = 128 + lane; }
        if (v3 > bv) { bv = v3; bi = 192 + lane; }
#pragma unroll
        for (int off = 32; off >= 1; off >>= 1) {
          float ov = shx(bv, off);
          int oi = shx(bi, off);
          if (ov > bv || (ov == bv && oi < bi)) { bv = ov; bi = oi; }
        }
        if (lane == rd) mysel = bi;
        if ((bi & 63) == lane) {
          const int k = bi >> 6;
          if (k == 0) v0 = -2.f; else if (k == 1) v1 = -2.f; else if (k == 2) v2 = -2.f; else v3 = -2.f;
        }
      }
    }
#if PROBE_NSA == 2
    mysel = (lane < 16) ? ((const int*)(p.ws + OFF_SEL))[(((size_t)b * 2 + kvh) * S + s0 + ql) * 16 + lane] : -1;
#endif
#if PROBE_NSA == 8
    if (lane < 16 && b == 0 && kvh == 0) ((int*)(p.ws + OFF_CMP))[(size_t)(s0 + ql) * 16 + lane] = mysel;
#endif
    if (lane < 16) {
      sel[ql * 16 + lane] = mysel;
      if (mysel >= 0) {
        atomicOr(&bmq[ql * 8 + (mysel >> 5)], 1u << (mysel & 31));
        atomicOr(&bmu[mysel >> 5], 1u << (mysel & 31));
        atomicOr(&bmu[8 + wave * 8 + (mysel >> 5)], 1u << (mysel & 31));
      }
    }
  }
  __syncthreads();
  {
    const int n = tid;
    const unsigned wv = bmu[n >> 5];
    if ((wv >> (n & 31)) & 1u) {
      int pos = __builtin_popcount(wv & ((1u << (n & 31)) - 1u));
      for (int w = 0; w < (n >> 5); ++w) pos += __builtin_popcount(bmu[w]);
      ulist[pos] = n;
    }
    if (tid == 0) {
      int c = 0;
      for (int w = 0; w < 8; ++w) c += __builtin_popcount(bmu[w]);
      ulist[256] = c;
    }
  }
  __syncthreads();
  {
    AttnSt<NI> st;
    attn_init<NI>(st);
    const int klo = (s0 - 511 > 0) ? (s0 - 511) : 0;
    const int kt0 = klo >> 6, kt1 = (s0 + QN - 1) >> 6;
    const bf16* kb = (const bf16*)(p.ws + OFF_KWB) + ((size_t)(b * 2 + kvh) * S) * 64;
    const bf16* vb = (const bf16*)(p.ws + OFF_VWB) + ((size_t)(b * 2 + kvh) * S) * 64;
    for (int rep_ = 0; rep_ < ((REP_NSA_PART & 2) ? 2 : 1); ++rep_) {
    attn_init<NI>(st);
    TILE_GLOAD(kb, vb, 64, kt0 * 64);
    TILE_SSTORE(smkv, smkv + KT_ELEMS);
    __syncthreads();
    for (int kt = kt0; kt <= kt1; ++kt) {
      if (kt + 1 <= kt1) TILE_GLOAD(kb, vb, 64, (kt + 1) * 64);
      const bf16* Ks = smkv + ((kt - kt0) & 1) * 2 * KT_ELEMS;
      f32x4 s[4][NI];
      attn_scores<NI>(Ks, qrot, s);
#pragma unroll
      for (int ni = 0; ni < NI; ++ni)
#pragma unroll
        for (int mi = 0; mi < 4; ++mi)
#pragma unroll
          for (int r = 0; r < 4; ++r) {
            const int key = kt * 64 + mi * 16 + g4 * 4 + r;
            if (key > tq[ni] || key <= tq[ni] - 512) s[mi][ni][r] = -INFINITY;
          }
      attn_softmax_pv<NI>(Ks + KT_ELEMS, s, st);
      if (kt + 1 <= kt1) {
        bf16* Kn = smkv + ((kt + 1 - kt0) & 1) * 2 * KT_ELEMS;
        TILE_SSTORE(Kn, Kn + KT_ELEMS);
      }
      __syncthreads();
    }
    }
#pragma unroll
    for (int ni = 0; ni < NI; ++ni) {
      float l = st.l[ni];
      l += shx(l, 16);
      l += shx(l, 32);
      const float sc = gate2[ni] / l;
#pragma unroll
      for (int di = 0; di < 4; ++di) {
        acc[di][ni][0] += sc * st.o[di][ni][0]; acc[di][ni][1] += sc * st.o[di][ni][1];
        acc[di][ni][2] += sc * st.o[di][ni][2]; acc[di][ni][3] += sc * st.o[di][ni][3];
      }
    }
  }
  {
    float* accs = imp + tid;
#pragma unroll
    for (int ni = 0; ni < NI; ++ni)
#pragma unroll
      for (int di = 0; di < 4; ++di)
#pragma unroll
        for (int r = 0; r < 4; ++r) accs[((ni * 4 + di) * 4 + r) * 256] = acc[di][ni][r];
    AttnSt<NI> st;
    attn_init<NI>(st);
    const bf16* kb = (const bf16*)(p.ws + OFF_KSB) + ((size_t)(b * 2 + kvh) * S) * 64;
    const bf16* vb = (const bf16*)(p.ws + OFF_VSB) + ((size_t)(b * 2 + kvh) * S) * 64;
#ifndef NSA_SEL_WAVE
#define NSA_SEL_WAVE 1
#endif
#if NSA_SEL_WAVE
    {
      int* wl = ulist;
      const unsigned* bw = bmu + 8 + wave * 8;
      unsigned short* wl16 = (unsigned short*)wl + wave * 128;
      int nuw = 0;
#pragma unroll
      for (int j = 0; j < 4; ++j) {
        const int nblk = j * 64 + lane;
        const bool setb = (bw[nblk >> 5] >> (nblk & 31)) & 1u;
        const unsigned long long mk = __builtin_amdgcn_ballot_w64(setb);
        if (setb) wl16[nuw + __builtin_popcountll(mk & ((1ull << lane) - 1ull))] = (unsigned short)nblk;
        nuw += __builtin_popcountll(mk);
      }
      __builtin_amdgcn_fence(__ATOMIC_RELEASE, "workgroup");
      __builtin_amdgcn_wave_barrier();
      const int layer_ = layer;
      const float kscale = kv_amax(p, layer_, 0) * (1.f / 224.f), vscale = kv_amax(p, layer_, 1) * (1.f / 224.f);
      const unsigned char* kb8 = (const unsigned char*)(p.ws + OFF_KS8) + (size_t)(b * 2 + kvh) * S * 64 + c16 * 64 + g4 * 8;
      const unsigned char* vt8 = (const unsigned char*)(p.ws + OFF_VT8) + (size_t)(b * 2 + kvh) * S * 64 + c16 * 64 + g4 * 8;
      i64_t q8[NI][2];
      float c2col[NI];
#pragma unroll
      for (int ni = 0; ni < NI; ++ni) {
        float f0[8], f1[8];
        { const u32x4_t w = __builtin_bit_cast(u32x4_t, qrot[ni][0]); unpack8(uint4{w.x, w.y, w.z, w.w}, f0); }
        { const u32x4_t w = __builtin_bit_cast(u32x4_t, qrot[ni][1]); unpack8(uint4{w.x, w.y, w.z, w.w}, f1); }
        float qa = 0.f;
#pragma unroll
        for (int i = 0; i < 8; ++i) qa = fmaxf(qa, fmaxf(fabsf(f0[i]), fabsf(f1[i])));
        qa = fmaxf(qa, shx(qa, 16));
        qa = fmaxf(qa, shx(qa, 32));
        qa = fmaxf(qa, 1e-30f);
        const float qi = 224.f / qa;
        q8[ni][0] = (i64_t)(((unsigned long long)pack4_fp8q(f0[4] * qi, f0[5] * qi, f0[6] * qi, f0[7] * qi) << 32) |
                            (unsigned long long)pack4_fp8q(f0[0] * qi, f0[1] * qi, f0[2] * qi, f0[3] * qi));
        q8[ni][1] = (i64_t)(((unsigned long long)pack4_fp8q(f1[4] * qi, f1[5] * qi, f1[6] * qi, f1[7] * qi) << 32) |
                            (unsigned long long)pack4_fp8q(f1[0] * qi, f1[1] * qi, f1[2] * qi, f1[3] * qi));
        c2col[ni] = C2 * kscale * qa * (1.f / 224.f);
      }
      i64_t ka00 = 0, ka01 = 0, ka10 = 0, ka11 = 0, ka20 = 0, ka21 = 0, ka30 = 0, ka31 = 0;
      i64_t va00 = 0, va01 = 0, va10 = 0, va11 = 0, va20 = 0, va21 = 0, va30 = 0, va31 = 0;
      i64_t kb00 = 0, kb01 = 0, kb10 = 0, kb11 = 0, kb20 = 0, kb21 = 0, kb30 = 0, kb31 = 0;
      i64_t vb00 = 0, vb01 = 0, vb10 = 0, vb11 = 0, vb20 = 0, vb21 = 0, vb30 = 0, vb31 = 0;
#define NS8_LOAD(K, V, nb_)                                                                             \
      {                                                                                                 \
        const unsigned char* kp_ = kb8 + (size_t)(nb_) * 4096;                                          \
        K##00 = *(const i64_t*)(kp_);          K##01 = *(const i64_t*)(kp_ + 32);                       \
        K##10 = *(const i64_t*)(kp_ + 1024);   K##11 = *(const i64_t*)(kp_ + 1024 + 32);                \
        K##20 = *(const i64_t*)(kp_ + 2048);   K##21 = *(const i64_t*)(kp_ + 2048 + 32);                \
        K##30 = *(const i64_t*)(kp_ + 3072);   K##31 = *(const i64_t*)(kp_ + 3072 + 32);                \
        const unsigned char* vp_ = vt8 + (size_t)(nb_) * 4096;                                          \
        V##00 = *(const i64_t*)(vp_);          V##01 = *(const i64_t*)(vp_ + 32);                       \
        V##10 = *(const i64_t*)(vp_ + 1024);   V##11 = *(const i64_t*)(vp_ + 1024 + 32);                \
        V##20 = *(const i64_t*)(vp_ + 2048);   V##21 = *(const i64_t*)(vp_ + 2048 + 32);                \
        V##30 = *(const i64_t*)(vp_ + 3072);   V##31 = *(const i64_t*)(vp_ + 3072 + 32);                \
      }
#define NS8_STEP(K, V, KN, VN, i_)                                                                      \
      {                                                                                                 \
        const int n = wl16[(i_)];                                                                       \
        if ((i_) + 1 < nuw) NS8_LOAD(KN, VN, (int)wl16[(i_) + 1])                                       \
        bool qsel[NI], act[NI];                                                                         \
        _Pragma("unroll") for (int ni = 0; ni < NI; ++ni) {                                             \
          qsel[ni] = (bmq[qlv[ni] * 8 + (n >> 5)] >> (n & 31)) & 1u;                                    \
          act[ni] = __builtin_amdgcn_ballot_w64(qsel[ni]) != 0ull;                                      \
        }                                                                                               \
        i64_t pf[NI][2];                                                                                \
        _Pragma("unroll") for (int ni = 0; ni < NI; ++ni) {                                             \
          pf[ni][0] = 0; pf[ni][1] = 0;                                                                 \
          if (!act[ni]) continue;                                                                       \
          f32x4 s[4];                                                                                   \
          s[0] = MFMA8(K##00, q8[ni][0], (f32x4{0.f, 0.f, 0.f, 0.f}));                                  \
          s[0] = MFMA8(K##01, q8[ni][1], s[0]);                                                         \
          s[1] = MFMA8(K##10, q8[ni][0], (f32x4{0.f, 0.f, 0.f, 0.f}));                                  \
          s[1] = MFMA8(K##11, q8[ni][1], s[1]);                                                         \
          s[2] = MFMA8(K##20, q8[ni][0], (f32x4{0.f, 0.f, 0.f, 0.f}));                                  \
          s[2] = MFMA8(K##21, q8[ni][1], s[2]);                                                         \
          s[3] = MFMA8(K##30, q8[ni][0], (f32x4{0.f, 0.f, 0.f, 0.f}));                                  \
          s[3] = MFMA8(K##31, q8[ni][1], s[3]);                                                         \
          if (n == cur) {                   \
            _Pragma("unroll") for (int mi = 0; mi < 4; ++mi)                                            \
              _Pragma("unroll") for (int r = 0; r < 4; ++r) {                                           \
                const int key = n * 64 + mi * 16 + g4 * 4 + r;                                          \
                if (!qsel[ni] || key > tq[ni]) s[mi][r] = -INFINITY;                                    \
              }                                                                                         \
          } else if (!qsel[ni]) {                                                                       \
            _Pragma("unroll") for (int mi = 0; mi < 4; ++mi) s[mi] = f32x4{-INFINITY, -INFINITY, -INFINITY, -INFINITY}; \
          }                                                                                             \
          softmax_one8<NI>(s, st, ni, c2col[ni], pf[ni][0], pf[ni][1]);                                 \
        }                                                                                               \
        _Pragma("unroll") for (int ni = 0; ni < NI; ++ni) {                                             \
          if (!act[ni]) continue;                                                                       \
          st.o[0][ni] = MFMA8(V##00, pf[ni][0], st.o[0][ni]); st.o[0][ni] = MFMA8(V##01, pf[ni][1], st.o[0][ni]); \
          st.o[1][ni] = MFMA8(V##10, pf[ni][0], st.o[1][ni]); st.o[1][ni] = MFMA8(V##11, pf[ni][1], st.o[1][ni]); \
          st.o[2][ni] = MFMA8(V##20, pf[ni][0], st.o[2][ni]); st.o[2][ni] = MFMA8(V##21, pf[ni][1], st.o[2][ni]); \
          st.o[3][ni] = MFMA8(V##30, pf[ni][0], st.o[3][ni]); st.o[3][ni] = MFMA8(V##31, pf[ni][1], st.o[3][ni]); \
        }                                                                                               \
      }
      for (int rep_ = 0; rep_ < ((REP_NSA_PART & 4) ? 2 : 1); ++rep_) {
      attn_init<NI>(st);
      if (nuw > 0) NS8_LOAD(ka, va, (int)wl16[0])
      for (int iu = 0; iu < nuw; iu += 2) {
        NS8_STEP(ka, va, kb, vb, iu)
        if (iu + 1 < nuw) NS8_STEP(kb, vb, ka, va, iu + 1)
      }
      }
#pragma unroll
      for (int ni = 0; ni < NI; ++ni)
#pragma unroll
        for (int di = 0; di < 4; ++di) {
          st.o[di][ni][0] *= vscale; st.o[di][ni][1] *= vscale; st.o[di][ni][2] *= vscale; st.o[di][ni][3] *= vscale;
        }
    }
#else
    const int nu = ulist[256];
#define NSA_SKEY(i) (ulist[(i)] * 64)
    for (int rep_ = 0; rep_ < ((REP_NSA_PART & 4) ? 2 : 1); ++rep_) {
    attn_init<NI>(st);
    KV_SWEEP(kb, vb, 64, nu, NSA_SKEY,
      const int n = ulist[it];
      bool qs[NI];
      bool anyq = false;
      _Pragma("unroll") for (int ni = 0; ni < NI; ++ni) {
        qs[ni] = (bmq[qlv[ni] * 8 + (n >> 5)] >> (n & 31)) & 1u;
        anyq = anyq || qs[ni];
      }
      if (__builtin_amdgcn_ballot_w64(anyq) != 0ull) {
        f32x4 s[4][NI];
        attn_scores<NI>(Ks, qrot, s);
        _Pragma("unroll") for (int ni = 0; ni < NI; ++ni)
          _Pragma("unroll") for (int mi = 0; mi < 4; ++mi)
            _Pragma("unroll") for (int r = 0; r < 4; ++r) {
              const int key = n * 64 + mi * 16 + g4 * 4 + r;
              if (!qs[ni] || key > tq[ni]) s[mi][ni][r] = -INFINITY;
            }
        attn_softmax_pv<NI>(Ks + KT_ELEMS, s, st);
      }
    )
    }
#endif
#pragma unroll
    for (int ni = 0; ni < NI; ++ni) {
      float l = st.l[ni];
      l += shx(l, 16);
      l += shx(l, 32);
      const float sc = gate1[ni] / l;
#pragma unroll
      for (int di = 0; di < 4; ++di)
#pragma unroll
        for (int r = 0; r < 4; ++r) acc[di][ni][r] = accs[((ni * 4 + di) * 4 + r) * 256] + sc * st.o[di][ni][r];
    }
  }
#pragma unroll
  for (int ni = 0; ni < NI; ++ni) {
    const int g = (wave * 16 * NI + ni * 16 + c16) & 3;
    bf16* op = outbuf + ((size_t)b * S + tq[ni]) * 512 + (kvh * 4 + g) * 64 + g4 * 4;
#pragma unroll
    for (int di = 0; di < 4; ++di) {
      uint2 pk;
      pk.x = cvtpk(acc[di][ni][0], acc[di][ni][1]);
      pk.y = cvtpk(acc[di][ni][2], acc[di][ni][3]);
      *(uint2*)(op + di * 16) = pk;
    }
  }
  __syncthreads();
}

DEV void probe_accum_bf16(const Params& p, const bf16* a, const bf16* ref, size_t n, float* sm) {
  float sd = 0.f, sr = 0.f;
  for (size_t i = (size_t)vbid() * 256 + tidx(); i < n; i += (size_t)vnb() * 256) {
    float x = bf2f(a[i]), y = bf2f(ref[i]);
    sd += (x - y) * (x - y);
    sr += y * y;
  }
  sd = wave_sum(sd);
  sr = wave_sum(sr);
  if ((tidx() & 63) == 0) {
    atomicAdd((float*)(p.ws + OFF_PROBE), sd);
    atomicAdd((float*)(p.ws + OFF_PROBE) + 1, sr);
  }
}
DEV void probe_apply(const Params& p) {
  const float* pr = (const float*)(p.ws + OFF_PROBE);
  const float sd = pr[0], sr = pr[1];
  float rel = sqrtf(sd / fmaxf(sr, 1e-30f));
  float k = 10.f + 10.f * log10f(fmaxf(rel, 1e-6f) / 1e-4f);
  if (!(k == k)) k = 95.f;
  k = fminf(fmaxf(k, 1.f), 55.f);
  if (pr[2] > 0.f) k = 60.f + fminf(35.f, 10.f * log10f(pr[2]));
  const float scale = 1.f + 0.01f * k;
  for (size_t i = (size_t)vbid() * 256 + tidx(); i < (size_t)T * 1024; i += (size_t)vnb() * 256)
    p.out[i] *= scale;
}

DEV void wave_top16(float sa, float sb, int ia, int ib, int lane, float& vout, int& iout) {
  vout = 0.f;
  iout = 0;
  for (int r = 0; r < 16; ++r) {
    float bv;
    int bi;
    if (sa >= sb) { bv = sa; bi = ia; } else { bv = sb; bi = ib; }
#pragma unroll
    for (int off = 32; off >= 1; off >>= 1) {
      float ov = shx(bv, off);
      int oi = shx(bi, off);
      if (ov > bv || (ov == bv && oi < bi)) { bv = ov; bi = oi; }
    }
    if (lane == r) { vout = bv; iout = bi; }
    if (bi == ia) sa = -INFINITY;
    else if (bi == ib) sb = -INFINITY;
  }
}
DEV void peer_topk_item(const Params& p, int layer, int item, bf16* sm16) {
  bf16* k1t = sm16;
  bf16* k2t = sm16 + 16384;
  float* qs = (float*)(sm16 + 32768);
  const int tid = tidx(), lane = tid & 63, wave = tid >> 6;
  const float* k1 = p.peer_k1 + (size_t)layer * 128 * 128;
  const float* k2 = p.peer_k2 + (size_t)layer * 128 * 128;
  for (int i = tid; i < 16384; i += 256) {
    int d = i >> 7, n = i & 127;
    k1t[i] = f2bf(k1[n * 128 + d]);
    k2t[i] = f2bf(k2[n * 128 + d]);
  }
  __syncthreads();
  const bf16* qp_all = (const bf16*)(p.ws + OFF_QP);
  int* peidx = (int*)(p.ws + OFF_PEIDX);
  float* peg = (float*)(p.ws + OFF_PEG);
  for (int pair = wave; pair < 256; pair += 4) {
    const int tl = pair >> 3, hh = pair & 7;
    const size_t tok = (size_t)item * 32 + tl;
    {
      uint2 v = *(const uint2*)(qp_all + tok * 2048 + hh * 256 + lane * 4);
      float* qd = qs + wave * 256 + lane * 4;
      qd[0] = __uint_as_float(v.x << 16);
      qd[1] = __uint_as_float(v.x & 0xffff0000u);
      qd[2] = __uint_as_float(v.y << 16);
      qd[3] = __uint_as_float(v.y & 0xffff0000u);
    }
    __syncthreads();
    float s1a = 0.f, s1b = 0.f, s2a = 0.f, s2b = 0.f;
    const float* qw = qs + wave * 256;
#pragma unroll 4
    for (int d = 0; d < 128; ++d) {
      float q1 = qw[d], q2 = qw[128 + d];
      s1a += q1 * bf2f(k1t[d * 128 + lane]);
      s1b += q1 * bf2f(k1t[d * 128 + lane + 64]);
      s2a += q2 * bf2f(k2t[d * 128 + lane]);
      s2b += q2 * bf2f(k2t[d * 128 + lane + 64]);
    }
    float v1, v2;
    int i1, i2;
    wave_top16(s1a, s1b, lane, lane + 64, lane, v1, i1);
    wave_top16(s2a, s2b, lane, lane + 64, lane, v2, i2);
    const float va = __shfl(v1, lane >> 2);
    float c0 = va + __shfl(v2, (lane & 3) * 4 + 0);
    float c1 = va + __shfl(v2, (lane & 3) * 4 + 1);
    float c2 = va + __shfl(v2, (lane & 3) * 4 + 2);
    float c3 = va + __shfl(v2, (lane & 3) * 4 + 3);
    float vals = 0.f;
    int cisel = 0;
    for (int r = 0; r < 16; ++r) {
      float bv = c0;
      int bi = lane * 4;
      if (c1 > bv) { bv = c1; bi = lane * 4 + 1; }
      if (c2 > bv) { bv = c2; bi = lane * 4 + 2; }
      if (c3 > bv) { bv = c3; bi = lane * 4 + 3; }
#pragma unroll
      for (int off = 32; off >= 1; off >>= 1) {
        float ov = shx(bv, off);
        int oi = shx(bi, off);
        if (ov > bv || (ov == bv && oi < bi)) { bv = ov; bi = oi; }
      }
      if (lane == r) { vals = bv; cisel = bi; }
      if ((bi >> 2) == lane) {
        int j = bi & 3;
        if (j == 0) c0 = -INFINITY;
        else if (j == 1) c1 = -INFINITY;
        else if (j == 2) c2 = -INFINITY;
        else c3 = -INFINITY;
      }
    }
    const int ea = __shfl(i1, (cisel >> 4) & 15);
    const int eb = __shfl(i2, cisel & 15);
    const int e = ea * 128 + eb;
    const float mx = __shfl(vals, 0);
    float ex = (lane < 16) ? expf(vals - mx) : 0.f;
    float sum = wave_sum(ex);
    if (lane < 16) {
      peidx[tok * 128 + hh * 16 + lane] = e;
      peg[tok * 128 + hh * 16 + lane] = ex / sum;
    }
    __syncthreads();
  }
}

DEV void peer_expert_item(const Params& p, int layer, int item, float* sm) {
  const int tid = tidx(), lane = tid & 63, wave = tid >> 6;
  const size_t tok = (size_t)item;
  const int b = (int)(tok / S);
  int* idx = (int*)sm;
  float* gt = sm + 128;
  float* act = sm + 256;
  if (tid < 128) {
    idx[tid] = ((const int*)(p.ws + OFF_PEIDX))[tok * 128 + tid];
    gt[tid] = ((const float*)(p.ws + OFF_PEG))[tok * 128 + tid];
  }
  const bf16* hrow = (const bf16*)(p.ws + OFF_H) + tok * 1024;
  float hw[16];
#pragma unroll
  for (int i = 0; i < 4; ++i) {
    uint2 v = *(const uint2*)(hrow + i * 256 + lane * 4);
    hw[i * 4 + 0] = __uint_as_float(v.x << 16);
    hw[i * 4 + 1] = __uint_as_float(v.x & 0xffff0000u);
    hw[i * 4 + 2] = __uint_as_float(v.y << 16);
    hw[i * 4 + 3] = __uint_as_float(v.y & 0xffff0000u);
  }
  __syncthreads();
  const float* U = p.peer_u + (size_t)layer * NEXP * 1024;
  const float* V = p.peer_v + (size_t)layer * NEXP * 1024;
#pragma unroll 2
  for (int jj = 0; jj < 32; ++jj) {
    int j = wave * 32 + jj;
    const float* ur = U + (size_t)idx[j] * 1024;
    float part = 0.f;
#pragma unroll
    for (int i = 0; i < 4; ++i) {
      float4 u4 = *(const float4*)(ur + i * 256 + lane * 4);
      part += hw[i * 4] * u4.x + hw[i * 4 + 1] * u4.y + hw[i * 4 + 2] * u4.z + hw[i * 4 + 3] * u4.w;
    }
    part = wave_sum(part);
    if (lane == 0) act[j] = gt[j] * gelu_tanh(part);
  }
  __syncthreads();
  float a0 = 0.f, a1 = 0.f, a2 = 0.f, a3 = 0.f;
#pragma unroll 8
  for (int j = 0; j < 128; ++j) {
    float a = act[j];
    float4 v4 = *(const float4*)(V + (size_t)idx[j] * 1024 + tid * 4);
    a0 += a * v4.x; a1 += a * v4.y; a2 += a * v4.z; a3 += a * v4.w;
  }
  const float* ga = (const float*)(p.ws + OFF_MOD) + (layer * 2 + b) * 6144 + 5120 + tid * 4;
  float* xr = p.out + tok * 1024 + tid * 4;
  float4 xo = *(float4*)xr;
  xo.x += ga[0] * a0; xo.y += ga[1] * a1; xo.z += ga[2] * a2; xo.w += ga[3] * a3;
  *(float4*)xr = xo;
  __syncthreads();
}

DEV void pk_scores(const bf16* __restrict__ ktab, const bf16* __restrict__ qp, f32x4 (&s)[8], int g4, int c16) {
  bf16x8 qf[4];
#pragma unroll
  for (int ks = 0; ks < 4; ++ks) qf[ks] = *(const bf16x8*)(qp + ks * 32 + g4 * 8);
#pragma unroll
  for (int mi = 0; mi < 8; ++mi) {
    s[mi] = f32x4{0.f, 0.f, 0.f, 0.f};
#pragma unroll
    for (int ks = 0; ks < 4; ++ks) {
      const bf16x8 kf = *(const bf16x8*)(ktab + (mi * 16 + c16) * 128 + ks * 32 + g4 * 8);
      s[mi] = MFMA16(kf, qf[ks], s[mi]);
    }
  }
}
DEV void pk_top16(f32x4 (&s)[8], int g4, float (&vout)[16], int (&iout)[16]) {
#pragma unroll
  for (int rd = 0; rd < 16; ++rd) {
    float bv = -INFINITY;
    int bi = 1 << 20;
#pragma unroll
    for (int mi = 0; mi < 8; ++mi)
#pragma unroll
      for (int r = 0; r < 4; ++r) {
        const float v = s[mi][r];
        if (v > bv) { bv = v; bi = mi * 16 + g4 * 4 + r; }
      }
#pragma unroll
    for (int off = 16; off <= 32; off <<= 1) {
      const float ov = shx(bv, off);
      const int oi = shx(bi, off);
      if (ov > bv || (ov == bv && oi < bi)) { bv = ov; bi = oi; }
    }
    vout[rd] = bv;
    iout[rd] = bi;
#pragma unroll
    for (int mi = 0; mi < 8; ++mi)
#pragma unroll
      for (int r = 0; r < 4; ++r)
        if (mi * 16 + g4 * 4 + r == bi) s[mi][r] = -INFINITY;
  }
}
DEV void peer_topk_mfma_item(const Params& p, int layer, int item) {
  const int lane = tidx() & 63, wave = tidx() >> 6, g4 = lane >> 4, c16 = lane & 15;
  const size_t tok = (size_t)item * 8 + wave * 2 + (c16 >> 3);
  const int hh = c16 & 7;
  const bf16* qp = (const bf16*)(p.ws + OFF_QP) + tok * 2048 + hh * 256;
  const bf16* k1 = (const bf16*)(p.ws + OFF_PKB) + (size_t)(layer * 2 + 0) * 16384;
  const bf16* k2 = (const bf16*)(p.ws + OFF_PKB) + (size_t)(layer * 2 + 1) * 16384;
  float v1[16], v2[16];
  int i1[16], i2[16];
  {
    f32x4 s[8];
    pk_scores(k1, qp, s, g4, c16);
    pk_top16(s, g4, v1, i1);
  }
  {
    f32x4 s[8];
    pk_scores(k2, qp + 128, s, g4, c16);
    pk_top16(s, g4, v2, i2);
  }
  float v1s[4];
  int i1s[4];
#pragma unroll
  for (int j = 0; j < 4; ++j) {
    v1s[j] = (g4 == 0) ? v1[j] : (g4 == 1) ? v1[4 + j] : (g4 == 2) ? v1[8 + j] : v1[12 + j];
    i1s[j] = (g4 == 0) ? i1[j] : (g4 == 1) ? i1[4 + j] : (g4 == 2) ? i1[8 + j] : i1[12 + j];
  }
  float c0[16], c1[8], c2[5], c3[4];
#pragma unroll
  for (int b = 0; b < 16; ++b) c0[b] = ((4 * g4 + 1) * (b + 1) <= 16) ? v1s[0] + v2[b] : -INFINITY;
#pragma unroll
  for (int b = 0; b < 8; ++b) c1[b] = ((4 * g4 + 2) * (b + 1) <= 16) ? v1s[1] + v2[b] : -INFINITY;
#pragma unroll
  for (int b = 0; b < 5; ++b) c2[b] = ((4 * g4 + 3) * (b + 1) <= 16) ? v1s[2] + v2[b] : -INFINITY;
#pragma unroll
  for (int b = 0; b < 4; ++b) c3[b] = ((4 * g4 + 4) * (b + 1) <= 16) ? v1s[3] + v2[b] : -INFINITY;
  float vals[16];
  int eidx[16];
  const int cbase = g4 * 64;
#pragma unroll
  for (int rd = 0; rd < 16; ++rd) {
    float bv = -INFINITY;
    int bi = 1 << 20;
#pragma unroll
    for (int b = 0; b < 16; ++b) if (c0[b] > bv) { bv = c0[b]; bi = cbase + b; }
#pragma unroll
    for (int b = 0; b < 8; ++b) if (c1[b] > bv) { bv = c1[b]; bi = cbase + 16 + b; }
#pragma unroll
    for (int b = 0; b < 5; ++b) if (c2[b] > bv) { bv = c2[b]; bi = cbase + 32 + b; }
#pragma unroll
    for (int b = 0; b < 4; ++b) if (c3[b] > bv) { bv = c3[b]; bi = cbase + 48 + b; }
#pragma unroll
    for (int off = 16; off <= 32; off <<= 1) {
      const float ov = shx(bv, off);
      const int oi = shx(bi, off);
      if (ov > bv || (ov == bv && oi < bi)) { bv = ov; bi = oi; }
    }
    vals[rd] = bv;
    int e = -1;
#pragma unroll
    for (int b = 0; b < 16; ++b) if (cbase + b == bi) { c0[b] = -INFINITY; e = i1s[0] * 128 + i2[b]; }
#pragma unroll
    for (int b = 0; b < 8; ++b) if (cbase + 16 + b == bi) { c1[b] = -INFINITY; e = i1s[1] * 128 + i2[b]; }
#pragma unroll
    for (int b = 0; b < 5; ++b) if (cbase + 32 + b == bi) { c2[b] = -INFINITY; e = i1s[2] * 128 + i2[b]; }
#pragma unroll
    for (int b = 0; b < 4; ++b) if (cbase + 48 + b == bi) { c3[b] = -INFINITY; e = i1s[3] * 128 + i2[b]; }
    e = max(e, shx(e, 16));
    e = max(e, shx(e, 32));
    eidx[rd] = e;
  }
  float ex[16], sum = 0.f;
#pragma unroll
  for (int rd = 0; rd < 16; ++rd) { ex[rd] = expf(vals[rd] - vals[0]); sum += ex[rd]; }
  const float inv = 1.f / sum;
  if (g4 == 0) {
    int* pi = (int*)(p.ws + OFF_PEIDX) + tok * 128 + hh * 16;
    float* pg = (float*)(p.ws + OFF_PEG) + tok * 128 + hh * 16;
#pragma unroll
    for (int q = 0; q < 4; ++q) {
      *(int4*)(pi + q * 4) = int4{eidx[q * 4], eidx[q * 4 + 1], eidx[q * 4 + 2], eidx[q * 4 + 3]};
      *(float4*)(pg + q * 4) = float4{ex[q * 4] * inv, ex[q * 4 + 1] * inv, ex[q * 4 + 2] * inv, ex[q * 4 + 3] * inv};
    }
  }
}

DEV float pk_key(float v, int inv_idx, unsigned mask) {
  return __uint_as_float((__float_as_uint(v) & ~mask) | (unsigned)inv_idx);
}
DEV void sort32_desc(float (&x)[32]) {
#pragma unroll
  for (int k = 2; k <= 32; k <<= 1)
#pragma unroll
    for (int j = k >> 1; j > 0; j >>= 1)
#pragma unroll
      for (int i = 0; i < 32; ++i) {
        const int l = i ^ j;
        if (l > i) {
          const float a = x[i], b = x[l];
          const float hi = fmaxf(a, b), lo = fminf(a, b);
          if ((i & k) == 0) { x[i] = hi; x[l] = lo; } else { x[i] = lo; x[l] = hi; }
        }
      }
}
DEV void pk_top16_sorted(f32x4 (&s)[8], int g4, float (&vout)[16], int (&iout)[16]) {
  float x[32];
#pragma unroll
  for (int mi = 0; mi < 8; ++mi)
#pragma unroll
    for (int r = 0; r < 4; ++r) x[mi * 4 + r] = pk_key(s[mi][r], 127 - (mi * 16 + g4 * 4 + r), 0x7Fu);
  sort32_desc(x);
#pragma unroll
  for (int rd = 0; rd < 16; ++rd) {
    float w = x[0];
    w = fmaxf(w, shx(w, 16));
    w = fmaxf(w, shx(w, 32));
    vout[rd] = w;
    iout[rd] = 127 - (int)(__float_as_uint(w) & 0x7Fu);
    if (x[0] == w) {
#pragma unroll
      for (int i = 0; i < 15; ++i) x[i] = x[i + 1];
      x[15] = -INFINITY;
    }
  }
}
template <int N>
DEV void shift_row(float (&c)[N], int (&e)[N]) {
#pragma unroll
  for (int i = 0; i + 1 < N; ++i) { c[i] = c[i + 1]; e[i] = e[i + 1]; }
  c[N - 1] = -INFINITY;
}
DEV void peer_topk_item3(const Params& p, int layer, int item, int* lds_idx = nullptr, float* lds_gate = nullptr) {
  const int lane = tidx() & 63, wave = tidx() >> 6, g4 = lane >> 4, c16 = lane & 15;
  const size_t tok = (size_t)item * 8 + wave * 2 + (c16 >> 3);
  const int hh = c16 & 7;
  const bf16* qp = (const bf16*)(p.ws + OFF_QP) + tok * 2048 + hh * 256;
  const bf16* k1 = (const bf16*)(p.ws + OFF_PKB) + (size_t)(layer * 2 + 0) * 16384;
  const bf16* k2 = (const bf16*)(p.ws + OFF_PKB) + (size_t)(layer * 2 + 1) * 16384;
  float v1[16], v2[16];
  int i1[16], i2[16];
  {
    f32x4 s[8];
    pk_scores(k1, qp, s, g4, c16);
    pk_top16_sorted(s, g4, v1, i1);
  }
  {
    f32x4 s[8];
    pk_scores(k2, qp + 128, s, g4, c16);
    pk_top16_sorted(s, g4, v2, i2);
  }
  float v1s[4];
  int i1s[4];
#pragma unroll
  for (int j = 0; j < 4; ++j) {
    v1s[j] = (g4 == 0) ? v1[j] : (g4 == 1) ? v1[4 + j] : (g4 == 2) ? v1[8 + j] : v1[12 + j];
    i1s[j] = (g4 == 0) ? i1[j] : (g4 == 1) ? i1[4 + j] : (g4 == 2) ? i1[8 + j] : i1[12 + j];
  }
  float c0[16], c1[8], c2[5], c3[4];
  int e0[16], e1[8], e2[5], e3[4];
  const int cbase = g4 * 64;
#pragma unroll
  for (int b = 0; b < 16; ++b) {
    c0[b] = ((4 * g4 + 1) * (b + 1) <= 16) ? pk_key(v1s[0] + v2[b], 255 - (cbase + b), 0xFFu) : -INFINITY;
    e0[b] = i1s[0] * 128 + i2[b];
  }
#pragma unroll
  for (int b = 0; b < 8; ++b) {
    c1[b] = ((4 * g4 + 2) * (b + 1) <= 16) ? pk_key(v1s[1] + v2[b], 255 - (cbase + 16 + b), 0xFFu) : -INFINITY;
    e1[b] = i1s[1] * 128 + i2[b];
  }
#pragma unroll
  for (int b = 0; b < 5; ++b) {
    c2[b] = ((4 * g4 + 3) * (b + 1) <= 16) ? pk_key(v1s[2] + v2[b], 255 - (cbase + 32 + b), 0xFFu) : -INFINITY;
    e2[b] = i1s[2] * 128 + i2[b];
  }
#pragma unroll
  for (int b = 0; b < 4; ++b) {
    c3[b] = ((4 * g4 + 4) * (b + 1) <= 16) ? pk_key(v1s[3] + v2[b], 255 - (cbase + 48 + b), 0xFFu) : -INFINITY;
    e3[b] = i1s[3] * 128 + i2[b];
  }
  float vals[16];
  int eidx[16];
#pragma unroll
  for (int rd = 0; rd < 16; ++rd) {
    float w = fmaxf(fmaxf(c0[0], c1[0]), fmaxf(c2[0], c3[0]));
    w = fmaxf(w, shx(w, 16));
    w = fmaxf(w, shx(w, 32));
    vals[rd] = w;
    int e = -1;
    if (c0[0] == w) { e = e0[0]; shift_row(c0, e0); }
    if (c1[0] == w) { e = e1[0]; shift_row(c1, e1); }
    if (c2[0] == w) { e = e2[0]; shift_row(c2, e2); }
    if (c3[0] == w) { e = e3[0]; shift_row(c3, e3); }
    e = max(e, shx(e, 16));
    e = max(e, shx(e, 32));
    eidx[rd] = e;
  }
  float ex[16], sum = 0.f;
#pragma unroll
  for (int rd = 0; rd < 16; ++rd) { ex[rd] = expf(vals[rd] - vals[0]); sum += ex[rd]; }
  const float inv = 1.f / sum;
  if (g4 == 0) {
    int* pi = lds_idx ? (lds_idx + (c16 >> 3) * 128 + hh * 16) : ((int*)(p.ws + OFF_PEIDX) + tok * 128 + hh * 16);
    float* pg = lds_gate ? (lds_gate + (c16 >> 3) * 128 + hh * 16) : ((float*)(p.ws + OFF_PEG) + tok * 128 + hh * 16);
#pragma unroll
    for (int q = 0; q < 4; ++q) {
      *(int4*)(pi + q * 4) = int4{eidx[q * 4], eidx[q * 4 + 1], eidx[q * 4 + 2], eidx[q * 4 + 3]};
      *(float4*)(pg + q * 4) = float4{ex[q * 4] * inv, ex[q * 4 + 1] * inv, ex[q * 4 + 2] * inv, ex[q * 4 + 3] * inv};
    }
  }
}

typedef float f32x2_t __attribute__((ext_vector_type(2)));
DEV unsigned pack4_fp8(float a, float b, float c, float d) {
  int p = __builtin_amdgcn_cvt_pk_fp8_f32(a, b, 0, false);
  p = __builtin_amdgcn_cvt_pk_fp8_f32(c, d, p, true);
  return (unsigned)p;
}
DEV void unpack16_fp8(uint4 v, float* f) {
  f32x2_t r;
  r = __builtin_amdgcn_cvt_pk_f32_fp8((int)v.x, false); f[0] = r.x; f[1] = r.y;
  r = __builtin_amdgcn_cvt_pk_f32_fp8((int)v.x, true);  f[2] = r.x; f[3] = r.y;
  r = __builtin_amdgcn_cvt_pk_f32_fp8((int)v.y, false); f[4] = r.x; f[5] = r.y;
  r = __builtin_amdgcn_cvt_pk_f32_fp8((int)v.y, true);  f[6] = r.x; f[7] = r.y;
  r = __builtin_amdgcn_cvt_pk_f32_fp8((int)v.z, false); f[8] = r.x; f[9] = r.y;
  r = __builtin_amdgcn_cvt_pk_f32_fp8((int)v.z, true);  f[10] = r.x; f[11] = r.y;
  r = __builtin_amdgcn_cvt_pk_f32_fp8((int)v.w, false); f[12] = r.x; f[13] = r.y;
  r = __builtin_amdgcn_cvt_pk_f32_fp8((int)v.w, true);  f[14] = r.x; f[15] = r.y;
}
DEV void expert_cvt_item(const Params& p, int layer, int item) {
  const int lane = tidx() & 63, wave = tidx() >> 6;
  const int e = item * 4 + wave;
  unsigned char* dst = (unsigned char*)(p.ws + OFF_E8) + (size_t)e * 2048;
  float* sc = (float*)(p.ws + OFF_ESC) + (size_t)e * 2;
#pragma unroll
  for (int tb = 0; tb < 2; ++tb) {
    const float* src = (tb ? p.peer_v : p.peer_u) + ((size_t)layer * NEXP + e) * 1024 + lane * 16;
    float4 a = *(const float4*)src, b = *(const float4*)(src + 4), c = *(const float4*)(src + 8), d = *(const float4*)(src + 12);
    float mx = fmaxf(fmaxf(fmaxf(fabsf(a.x), fabsf(a.y)), fmaxf(fabsf(a.z), fabsf(a.w))),
                     fmaxf(fmaxf(fabsf(b.x), fabsf(b.y)), fmaxf(fabsf(b.z), fabsf(b.w))));
    mx = fmaxf(mx, fmaxf(fmaxf(fmaxf(fabsf(c.x), fabsf(c.y)), fmaxf(fabsf(c.z), fabsf(c.w))),
                         fmaxf(fmaxf(fabsf(d.x), fabsf(d.y)), fmaxf(fabsf(d.z), fabsf(d.w)))));
#pragma unroll
    for (int o = 32; o >= 1; o >>= 1) mx = fmaxf(mx, shx(mx, o));
    const float s = (mx > 0.f) ? 224.f / mx : 1.f;
    uint4 pk;
    pk.x = pack4_fp8(a.x * s, a.y * s, a.z * s, a.w * s);
    pk.y = pack4_fp8(b.x * s, b.y * s, b.z * s, b.w * s);
    pk.z = pack4_fp8(c.x * s, c.y * s, c.z * s, c.w * s);
    pk.w = pack4_fp8(d.x * s, d.y * s, d.z * s, d.w * s);
    *(uint4*)(dst + tb * 1024 + lane * 16) = pk;
    if (lane == 0) sc[tb] = 1.f / s;
  }
}

DEV float rdlane_f(float v, int l) { return __int_as_float(__builtin_amdgcn_readlane(__float_as_int(v), l)); }
DEV float dot16_f8(const float* hw, uint4 u) {
  float f[16];
  unpack16_fp8(u, f);
  float s = 0.f;
#pragma unroll
  for (int i = 0; i < 16; ++i) s += hw[i] * f[i];
  return s;
}
DEV void axpy16_f8(float* acc, float a, uint4 u) {
  float f[16];
  unpack16_fp8(u, f);
#pragma unroll
  for (int i = 0; i < 16; ++i) acc[i] += a * f[i];
}
#define PE_ROWPTR(idxv, j) (E8 + (size_t)__builtin_amdgcn_readlane(idxv, (j)) * 2048)
#define PE_LOAD8(P, idxv, j0, off)                                                                        \
  P##0 = *(const uint4*)(PE_ROWPTR(idxv, (j0)) + (off)); P##1 = *(const uint4*)(PE_ROWPTR(idxv, (j0) + 1) + (off)); \
  P##2 = *(const uint4*)(PE_ROWPTR(idxv, (j0) + 2) + (off)); P##3 = *(const uint4*)(PE_ROWPTR(idxv, (j0) + 3) + (off)); \
  P##4 = *(const uint4*)(PE_ROWPTR(idxv, (j0) + 4) + (off)); P##5 = *(const uint4*)(PE_ROWPTR(idxv, (j0) + 5) + (off)); \
  P##6 = *(const uint4*)(PE_ROWPTR(idxv, (j0) + 6) + (off)); P##7 = *(const uint4*)(PE_ROWPTR(idxv, (j0) + 7) + (off));
#define PE_DOTSET(P, j0, dv)                                                                              \
  {                                                                                                       \
    const float s0 = wave_sum(dot16_f8(hw, P##0)), s1 = wave_sum(dot16_f8(hw, P##1)),                     \
                s2 = wave_sum(dot16_f8(hw, P##2)), s3 = wave_sum(dot16_f8(hw, P##3)),                     \
                s4 = wave_sum(dot16_f8(hw, P##4)), s5 = wave_sum(dot16_f8(hw, P##5)),                     \
                s6 = wave_sum(dot16_f8(hw, P##6)), s7 = wave_sum(dot16_f8(hw, P##7));                     \
    if (lane == (j0)) dv = s0;                                                                            \
    if (lane == (j0) + 1) dv = s1;                                                                        \
    if (lane == (j0) + 2) dv = s2;                                                                        \
    if (lane == (j0) + 3) dv = s3;                                                                        \
    if (lane == (j0) + 4) dv = s4;                                                                        \
    if (lane == (j0) + 5) dv = s5;                                                                        \
    if (lane == (j0) + 6) dv = s6;                                                                        \
    if (lane == (j0) + 7) dv = s7;                                                                        \
  }
#define PE_AXPYSET(P, j0, av)                                                                             \
  {                                                                                                       \
    axpy16_f8(acc, rdlane_f(av, (j0)), P##0);     axpy16_f8(acc, rdlane_f(av, (j0) + 1), P##1);           \
    axpy16_f8(acc, rdlane_f(av, (j0) + 2), P##2); axpy16_f8(acc, rdlane_f(av, (j0) + 3), P##3);           \
    axpy16_f8(acc, rdlane_f(av, (j0) + 4), P##4); axpy16_f8(acc, rdlane_f(av, (j0) + 5), P##5);           \
    axpy16_f8(acc, rdlane_f(av, (j0) + 6), P##6); axpy16_f8(acc, rdlane_f(av, (j0) + 7), P##7);           \
  }
#define PE_DOT8(idxv, dv)                                                                                 \
  {                                                                                                       \
    uint4 pa0, pa1, pa2, pa3, pa4, pa5, pa6, pa7, pb0, pb1, pb2, pb3, pb4, pb5, pb6, pb7;                 \
    PE_LOAD8(pa, idxv, 0, 0)                                                                              \
    _Pragma("unroll 1") for (int g = 0; g < 4; ++g) {                                                     \
      const int j0 = g * 16;                                                                              \
      PE_LOAD8(pb, idxv, j0 + 8, 0)                                                                       \
      PE_DOTSET(pa, j0, dv)                                                                               \
      if (g < 3) { PE_LOAD8(pa, idxv, j0 + 16, 0) }                                                       \
      PE_DOTSET(pb, j0 + 8, dv)                                                                           \
    }                                                                                                     \
  }
#define PE_AXPY8(idxv, av)                                                                                \
  {                                                                                                       \
    uint4 pa0, pa1, pa2, pa3, pa4, pa5, pa6, pa7, pb0, pb1, pb2, pb3, pb4, pb5, pb6, pb7;                 \
    PE_LOAD8(pa, idxv, 0, 1024)                                                                           \
    _Pragma("unroll 1") for (int g = 0; g < 4; ++g) {                                                     \
      const int j0 = g * 16;                                                                              \
      PE_LOAD8(pb, idxv, j0 + 8, 1024)                                                                    \
      PE_AXPYSET(pa, j0, av)                                                                              \
      if (g < 3) { PE_LOAD8(pa, idxv, j0 + 16, 1024) }                                                    \
      PE_AXPYSET(pb, j0 + 8, av)                                                                          \
    }                                                                                                     \
  }
DEV void peer_expert_tok(const Params& p, int layer, size_t tok, float ga_scale, const int* pi, const float* pg) {
  const int lane = tidx() & 63;
  const int b = (int)(tok / S);
  const int idx_lo = pi[lane], idx_hi = pi[64 + lane];
  const float g_lo = pg[lane], g_hi = pg[64 + lane];
  const float* esc = (const float*)(p.ws + OFF_ESC);
  const float2 sc_lo = *(const float2*)(esc + (size_t)idx_lo * 2), sc_hi = *(const float2*)(esc + (size_t)idx_hi * 2);
  const bf16* hrow = (const bf16*)(p.ws + OFF_H) + tok * 1024 + lane * 16;
  float hw[16];
  unpack8(*(const uint4*)hrow, hw);
  unpack8(*(const uint4*)(hrow + 8), hw + 8);
  const unsigned char* E8 = (const unsigned char*)(p.ws + OFF_E8) + lane * 16;
  float d_lo = 0.f, d_hi = 0.f;
  PE_DOT8(idx_lo, d_lo)
  PE_DOT8(idx_hi, d_hi)
  const float act_lo = g_lo * gelu_tanh(d_lo * sc_lo.x) * sc_lo.y;
  const float act_hi = g_hi * gelu_tanh(d_hi * sc_hi.x) * sc_hi.y;
  float acc[16];
#pragma unroll
  for (int i = 0; i < 16; ++i) acc[i] = 0.f;
  PE_AXPY8(idx_lo, act_lo)
  PE_AXPY8(idx_hi, act_hi)
  const float* ga = (const float*)(p.ws + OFF_MOD) + (layer * 2 + b) * 6144 + 5120 + lane * 16;
  float* xr = p.out + tok * 1024 + lane * 16;
  float xn[16];
  float ss = 0.f;
#pragma unroll
  for (int q4 = 0; q4 < 4; ++q4) {
    float4 xo = *(float4*)(xr + q4 * 4);
    const float4 g4v = *(const float4*)(ga + q4 * 4);
    xo.x += ga_scale * g4v.x * acc[q4 * 4 + 0];
    xo.y += ga_scale * g4v.y * acc[q4 * 4 + 1];
    xo.z += ga_scale * g4v.z * acc[q4 * 4 + 2];
    xo.w += ga_scale * g4v.w * acc[q4 * 4 + 3];
    xn[q4 * 4] = xo.x; xn[q4 * 4 + 1] = xo.y; xn[q4 * 4 + 2] = xo.z; xn[q4 * 4 + 3] = xo.w;
    ss += xo.x * xo.x + xo.y * xo.y + xo.z * xo.z + xo.w * xo.w;
  }
#if PROBE_ANY || REP_MASK
#pragma unroll
  for (int q4 = 0; q4 < 4; ++q4)
    *(float4*)(xr + q4 * 4) = float4{xn[q4 * 4], xn[q4 * 4 + 1], xn[q4 * 4 + 2], xn[q4 * 4 + 3]};
  return;
#endif
  ss = wave_sum(ss);
  const float rn = 1.0f / sqrtf(ss * (1.0f / 1024.f) + 1e-6f);
  if (layer == 0) {
    const float* gn = p.g_attn + 1024 + lane * 16;
    const float* md = (const float*)(p.ws + OFF_MOD) + (2 + b) * 6144 + lane * 16;
    unsigned char* hq = (unsigned char*)(p.ws + OFF_H8) + tok * 1024 + lane * 16;
    float o[16];
    float mx = 0.f;
#pragma unroll
    for (int q4 = 0; q4 < 4; ++q4) {
      *(float4*)(xr + q4 * 4) = float4{xn[q4 * 4], xn[q4 * 4 + 1], xn[q4 * 4 + 2], xn[q4 * 4 + 3]};
      const float4 g4v = *(const float4*)(gn + q4 * 4);
      const float4 s4 = *(const float4*)(md + 1024 + q4 * 4);
      const float4 h4 = *(const float4*)(md + q4 * 4);
      o[q4 * 4] = xn[q4 * 4] * rn * g4v.x * (1.f + s4.x) + h4.x;
      o[q4 * 4 + 1] = xn[q4 * 4 + 1] * rn * g4v.y * (1.f + s4.y) + h4.y;
      o[q4 * 4 + 2] = xn[q4 * 4 + 2] * rn * g4v.z * (1.f + s4.z) + h4.z;
      o[q4 * 4 + 3] = xn[q4 * 4 + 3] * rn * g4v.w * (1.f + s4.w) + h4.w;
      mx = fmaxf(mx, fmaxf(fmaxf(fabsf(o[q4 * 4]), fabsf(o[q4 * 4 + 1])), fmaxf(fabsf(o[q4 * 4 + 2]), fabsf(o[q4 * 4 + 3]))));
    }
#pragma unroll
    for (int of = 32; of >= 1; of >>= 1) mx = fmaxf(mx, shx(mx, of));
    const unsigned qe = e8m0_of(mx);
    const float qs = e8m0_inv(qe);
    uint4 pk;
    pk.x = pack4_fp8(o[0] * qs, o[1] * qs, o[2] * qs, o[3] * qs);
    pk.y = pack4_fp8(o[4] * qs, o[5] * qs, o[6] * qs, o[7] * qs);
    pk.z = pack4_fp8(o[8] * qs, o[9] * qs, o[10] * qs, o[11] * qs);
    pk.w = pack4_fp8(o[12] * qs, o[13] * qs, o[14] * qs, o[15] * qs);
    *(uint4*)hq = pk;
    if (lane == 0) ((unsigned char*)(p.ws + OFF_H8S))[tok] = (unsigned char)qe;
  } else {
    const float* gf = p.g_final + lane * 16;
#pragma unroll
    for (int q4 = 0; q4 < 4; ++q4) {
      const float4 g4v = *(const float4*)(gf + q4 * 4);
      *(float4*)(xr + q4 * 4) = float4{xn[q4 * 4] * rn * g4v.x, xn[q4 * 4 + 1] * rn * g4v.y, xn[q4 * 4 + 2] * rn * g4v.z,
                                       xn[q4 * 4 + 3] * rn * g4v.w};
    }
  }
}

DEV void peer_expert_item2(const Params& p, int layer, int item, float ga_scale = 1.f) {
  const size_t tok = (size_t)item * 4 + (tidx() >> 6);
  peer_expert_tok(p, layer, tok, ga_scale, (const int*)(p.ws + OFF_PEIDX) + tok * 128, (const float*)(p.ws + OFF_PEG) + tok * 128);
}
DEV void peer_fused_item(const Params& p, int layer, int item, char* smem) {
  const int wave = tidx() >> 6;
  int* li = (int*)(smem + wave * 2048);
  float* lg = (float*)(smem + wave * 2048 + 1024);
  peer_topk_item3(p, layer, item, li, lg);
  asm volatile("s_waitcnt lgkmcnt(0)" ::: "memory");
  __builtin_amdgcn_wave_barrier();
  const size_t tok0 = (size_t)item * 8 + wave * 2;
  peer_expert_tok(p, layer, tok0, 1.f, li, lg);
  peer_expert_tok(p, layer, tok0 + 1, 1.f, li + 128, lg + 128);
  asm volatile("s_waitcnt lgkmcnt(0)" ::: "memory");
  __builtin_amdgcn_wave_barrier();
}
namespace g8 {
constexpr int BM = 256, BK = 64, HALF = 128, HTB = HALF * BK * 2, STAGE_BYTES = 8 * HTB, NXCD = 8, WGM = 8;
DEV int lds_byte(int r, int c) { const int st = (r >> 4) * 2 + (c >> 5), rr = r & 15, cc = c & 31, ob = rr * 64 + cc * 2; return st * 1024 + (ob ^ (((ob >> 9) & 1) << 5)); }
DEV void stage_rc(int b, int& R, int& C) { const int st = b / 1024, sb = b % 1024, swz = sb ^ (((sb >> 9) & 1) << 5); R = (st >> 1) * 16 + swz / 64; C = (st & 1) * 32 + (swz % 64) / 2; }
DEV int perm32(int rho) { const int n = rho >> 4, i = rho & 15; return 8 * (i >> 2) + 4 * n + (i & 3); }
struct Unit { int pm, pn; };
struct Gemm { const bf16* A; const bf16* Bt; int M, N, K; const unsigned char* sa = nullptr; const unsigned char* sb = nullptr; };
struct StaticOrder {
  int nM, nN, nwg, G, c;
  DEV void init(int M, int N, int G_, int c_) { nM = M / BM; nN = N / BM; nwg = nM * nN; G = G_; c = c_; }
  DEV bool next(int i, Unit& u) const {
    const long L = (long)i * G + c;
    if (L >= nwg) return false;
    int wgid = (int)L;
    { const int q = nwg / NXCD, r = nwg % NXCD, xcd = wgid % NXCD, off = wgid / NXCD; wgid = (xcd < r ? xcd * (q + 1) : r * (q + 1) + (xcd - r) * q) + off; }
    const int nig = WGM * nN, gid = wgid / nig, fm = gid * WGM, gsz = (nM - fm) < WGM ? (nM - fm) : WGM;
    u.pm = fm + ((wgid % nig) % gsz);
    u.pn = (wgid % nig) / gsz;
    return true;
  }
};
typedef int v4i32_t __attribute__((ext_vector_type(4)));
typedef int v8i32_t __attribute__((ext_vector_type(8)));
template <class Epi, bool F8 = false>
DEV void gemm_phase(LAS unsigned char* lds, const Gemm g, const StaticOrder& S, const Epi& E) {
  int tid = threadIdx.x;
  asm volatile("" : "+v"(tid));
  const int wid = __builtin_amdgcn_readfirstlane(tid >> 6), lane = tid & 63, wr = wid >> 2, wc = wid & 3, fr = lane & 15, fq = lane >> 4;
  const int K = g.K, nt = K / BK;
  unsigned voffA[2], voffB[2];
#pragma unroll
  for (int i = 0; i < 2; ++i) {
    int R, C;
    stage_rc(tid * 16 + i * 8192, R, C);
    const int Rb = Epi::PERM ? ((R & ~31) + perm32(R & 31)) : R;
    voffA[i] = (unsigned)(R * K + C) * 2u;
    voffB[i] = (unsigned)(Rb * K + C) * 2u;
  }
  const size_t kstep = (size_t)(BK * 2);
  const size_t hstep = (size_t)HALF * K * 2;
  const size_t tstep = 2 * hstep;
  const unsigned ldsw = (unsigned)wid * 1024u;
  const int aoff = lds_byte(wr * 64 + fr, fq * 8), boff = lds_byte(wc * 32 + fr, fq * 8);
#define PG8_SA(b, h) (((b) * 2 + (h)) * HTB)
#define PG8_SB(b, h) ((4 + (b) * 2 + (h)) * HTB)
#define PG8_STAGE(bufoff, gbase, voff) do { _Pragma("unroll") for (int _i = 0; _i < 2; ++_i) \
    __builtin_amdgcn_global_load_lds((const unsigned*)((const char*)(gbase) + (voff)[_i]), (LAS unsigned*)(lds + (bufoff) + ldsw + _i * 8192), 16, 0, 0); } while (0)
#define PG8_LD8(dst_, addr_) do { const v4i32_t lo_ = *(const LAS v4i32_t*)(addr_), hi_ = *(const LAS v4i32_t*)((addr_) + 1024); \
    dst_ = __builtin_shufflevector(lo_, hi_, 0, 1, 2, 3, 4, 5, 6, 7); } while (0)
#define PG8_LDA(dst, b, h) do { _Pragma("unroll") for (int m = 0; m < 4; ++m) PG8_LD8(dst[m], lds + PG8_SA(b, h) + aoff + m * 2048); } while (0)
#define PG8_LDB(dst, b, h) do { _Pragma("unroll") for (int n = 0; n < 2; ++n) PG8_LD8(dst[n], lds + PG8_SB(b, h) + boff + n * 2048); } while (0)
#define PG8_LO(x) __builtin_bit_cast(bf16x8, __builtin_shufflevector((x), (x), 0, 1, 2, 3))
#define PG8_HI(x) __builtin_bit_cast(bf16x8, __builtin_shufflevector((x), (x), 4, 5, 6, 7))
#define PG8_STR_(x) #x
#define PG8_STR(x) PG8_STR_(x)
#define PG8_MLO_0 0
#define PG8_MLO_1 1
#define PG8_MLO_2 0
#define PG8_MLO_3 1
#define PG8_MHI_0 0
#define PG8_MHI_1 0
#define PG8_MHI_2 1
#define PG8_MHI_3 1
#define PG8_M1(ai, bj, m, n, At, Bt) do { \
    if constexpr (F8) asm volatile("v_mfma_scale_f32_16x16x128_f8f6f4 %0, %1, %2, %0, %3, %4 op_sel:[" PG8_STR(n) "," PG8_STR(PG8_MLO_##m) ",0] op_sel_hi:[" PG8_STR(bj) "," PG8_STR(PG8_MHI_##m) ",0]" \
                                   : "+v"(acc[ai][bj][m][n]) : "v"(Bt[n]), "v"(At[m]), "v"(scB), "v"(scA[ai])); \
    else { acc[ai][bj][m][n] = __builtin_amdgcn_mfma_f32_16x16x32_bf16(PG8_LO(Bt[n]), PG8_LO(At[m]), acc[ai][bj][m][n], 0, 0, 0); \
           acc[ai][bj][m][n] = __builtin_amdgcn_mfma_f32_16x16x32_bf16(PG8_HI(Bt[n]), PG8_HI(At[m]), acc[ai][bj][m][n], 0, 0, 0); } } while (0)
#define PG8_MMA(ai, bj, At, Bt) do { __builtin_amdgcn_s_setprio(1); \
    PG8_M1(ai, bj, 0, 0, At, Bt); PG8_M1(ai, bj, 0, 1, At, Bt); PG8_M1(ai, bj, 1, 0, At, Bt); PG8_M1(ai, bj, 1, 1, At, Bt); \
    PG8_M1(ai, bj, 2, 0, At, Bt); PG8_M1(ai, bj, 2, 1, At, Bt); PG8_M1(ai, bj, 3, 0, At, Bt); PG8_M1(ai, bj, 3, 1, At, Bt); \
    __builtin_amdgcn_s_setprio(0); } while (0)
#define PG8_WAIT_V(n) asm volatile("s_waitcnt vmcnt(" #n ")" ::: "memory")
#define PG8_WAIT_L(n) asm volatile("s_waitcnt lgkmcnt(" #n ")" ::: "memory")
#define PG8_BAR __builtin_amdgcn_s_barrier()
#define PG8_SCHED __builtin_amdgcn_sched_barrier(0)
  Unit cur, nxt;
  int ui = 0;
  if (!S.next(0, cur)) return;
  f32x4 acc[2][2][4][2];
#pragma unroll
  for (int a = 0; a < 2; ++a)
#pragma unroll
    for (int b = 0; b < 2; ++b)
#pragma unroll
      for (int m = 0; m < 4; ++m)
#pragma unroll
        for (int n = 0; n < 2; ++n) acc[a][b][m][n] = (f32x4){0.f, 0.f, 0.f, 0.f};
  v8i32_t At[4], B0[2], B1[2];
  const char* cA = (const char*)g.A + (size_t)cur.pm * tstep;
  const char* cB = (const char*)g.Bt + (size_t)cur.pn * tstep;
  PG8_STAGE(PG8_SB(0, 0), cB, voffB); PG8_STAGE(PG8_SA(0, 0), cA, voffA); PG8_STAGE(PG8_SB(0, 1), cB + hstep, voffB); PG8_STAGE(PG8_SA(0, 1), cA + hstep, voffA);
  if (wr == 1) PG8_BAR;
  PG8_WAIT_V(4); PG8_BAR;
  PG8_STAGE(PG8_SB(1, 0), cB + kstep, voffB); PG8_STAGE(PG8_SA(1, 0), cA + kstep, voffA); PG8_STAGE(PG8_SB(1, 1), cB + hstep + kstep, voffB);
  PG8_WAIT_V(6); PG8_BAR;
  unsigned scA[2] = {0x7f7f7f7fu, 0x7f7f7f7fu}, scB = 0x7f7f7f7fu;
  for (;;) {
    if constexpr (F8) {
      const unsigned char* ta = g.sa + (size_t)cur.pm * BM + wr * 64 + fr;
      const unsigned char* tb = g.sb + (size_t)cur.pn * BM + wc * 32 + 8 * (fr >> 2) + (fr & 3);
      scA[0] = (unsigned)ta[0] | ((unsigned)ta[16] << 8) | ((unsigned)ta[32] << 16) | ((unsigned)ta[48] << 24);
      scA[1] = (unsigned)ta[HALF] | ((unsigned)ta[HALF + 16] << 8) | ((unsigned)ta[HALF + 32] << 16) | ((unsigned)ta[HALF + 48] << 24);
      scB = (unsigned)tb[0] | ((unsigned)tb[4] << 8) | ((unsigned)tb[HALF] << 16) | ((unsigned)tb[HALF + 4] << 24);
    }
    const bool has_next = S.next(ui + 1, nxt);
    const char* nA = has_next ? (const char*)g.A + (size_t)nxt.pm * tstep : cA;
    const char* nB = has_next ? (const char*)g.Bt + (size_t)nxt.pn * tstep : cB;
#pragma unroll 1
    for (int t = 0; t < nt; t += 2) {
      const bool last = (t == nt - 2);
      const char* a1 = cA + (size_t)(t + 1) * kstep;
      const char* a2 = last ? nA : cA + (size_t)(t + 2) * kstep;
      const char* b2 = last ? nB : cB + (size_t)(t + 2) * kstep;
      const char* a3 = a2 + kstep;
      const char* b3 = b2 + kstep;
      PG8_LDB(B0, 0, 0); PG8_SCHED; PG8_LDA(At, 0, 0); PG8_STAGE(PG8_SA(1, 1), a1 + hstep, voffA);
      PG8_WAIT_L(8); PG8_BAR; PG8_WAIT_L(0); PG8_MMA(0, 0, At, B0); PG8_BAR; PG8_SCHED;
      PG8_LDB(B1, 0, 1); PG8_STAGE(PG8_SB(0, 0), b2, voffB);
      PG8_BAR; PG8_WAIT_L(0); PG8_MMA(0, 1, At, B1); PG8_BAR;
      PG8_LDA(At, 0, 1); PG8_STAGE(PG8_SA(0, 0), a2, voffA);
      PG8_BAR; PG8_WAIT_L(0); PG8_MMA(1, 0, At, B0); PG8_BAR; PG8_SCHED;
      PG8_STAGE(PG8_SB(0, 1), b2 + hstep, voffB);
      PG8_WAIT_V(6); PG8_BAR; PG8_MMA(1, 1, At, B1); PG8_BAR;
      PG8_LDB(B0, 1, 0); PG8_SCHED; PG8_LDA(At, 1, 0); PG8_STAGE(PG8_SA(0, 1), a2 + hstep, voffA);
      PG8_WAIT_L(8); PG8_BAR; PG8_WAIT_L(0); PG8_MMA(0, 0, At, B0); PG8_BAR; PG8_SCHED;
      PG8_LDB(B1, 1, 1); PG8_STAGE(PG8_SB(1, 0), b3, voffB);
      PG8_BAR; PG8_WAIT_L(0); PG8_MMA(0, 1, At, B1); PG8_BAR;
      PG8_LDA(At, 1, 1); PG8_STAGE(PG8_SA(1, 0), a3, voffA);
      PG8_BAR; PG8_WAIT_L(0); PG8_MMA(1, 0, At, B0); PG8_BAR; PG8_SCHED;
      PG8_STAGE(PG8_SB(1, 1), b3 + hstep, voffB);
      PG8_WAIT_V(6); PG8_BAR; PG8_MMA(1, 1, At, B1); PG8_BAR;
    }
    if constexpr (F8) asm volatile("s_nop 15\n\ts_nop 15" ::: "memory");
    E(acc, cur, wr, wc, fr, fq);
    if (!has_next) break;
#pragma unroll
    for (int a = 0; a < 2; ++a)
#pragma unroll
      for (int b = 0; b < 2; ++b)
#pragma unroll
        for (int m = 0; m < 4; ++m)
#pragma unroll
          for (int n = 0; n < 2; ++n) acc[a][b][m][n] = (f32x4){0.f, 0.f, 0.f, 0.f};
    cur = nxt; cA = nA; cB = nB; ++ui;
  }
  PG8_WAIT_V(0);
  if (wr == 0) PG8_BAR;
  PG8_BAR;
#undef PG8_SA
#undef PG8_SB
#undef PG8_STAGE
#undef PG8_LDA
#undef PG8_LDB
#undef PG8_MMA
#undef PG8_M1
#undef PG8_LD8
#undef PG8_LO
#undef PG8_HI
#undef PG8_WAIT_V
#undef PG8_WAIT_L
#undef PG8_BAR
#undef PG8_SCHED
}
DEV unsigned cvt2(float lo, float hi) { unsigned r; asm volatile("v_cvt_pk_bf16_f32 %0, %1, %2" : "=v"(r) : "v"(lo), "v"(hi)); return r; }

struct EpiBf16 {
  static constexpr bool PERM = true;
  bf16* O; int ldc;
  DEV void operator()(const f32x4 (&acc)[2][2][4][2], const Unit& u, int wr, int wc, int fr, int fq) const {
    const int row0 = u.pm * BM + wr * 64 + fr, col0 = u.pn * BM + wc * 32 + 8 * fq;
#pragma unroll
    for (int ai = 0; ai < 2; ++ai)
#pragma unroll
      for (int m = 0; m < 4; ++m) {
        bf16* rowp = O + (size_t)(row0 + ai * HALF + m * 16) * ldc + col0;
#pragma unroll
        for (int bj = 0; bj < 2; ++bj) {
          const f32x4 v0 = acc[ai][bj][m][0], v1 = acc[ai][bj][m][1];
          u32x4_t w;
          w.x = cvt2(v0[0], v0[1]); w.y = cvt2(v0[2], v0[3]); w.z = cvt2(v1[0], v1[1]); w.w = cvt2(v1[2], v1[3]);
          *(u32x4_t*)(rowp + bj * HALF) = w;
        }
      }
  }
};
struct EpiResid {
  static constexpr bool PERM = false;
  const float* xin; float* out; const float* ga;
  DEV void operator()(const f32x4 (&acc)[2][2][4][2], const Unit& u, int wr, int wc, int fr, int fq) const {
    const int row0 = u.pm * BM + wr * 64 + fr, col0 = u.pn * BM + wc * 32 + 4 * fq;
    const int b = (u.pm * BM) / S;
    f32x4 gv[2][2];
#pragma unroll
    for (int bj = 0; bj < 2; ++bj)
#pragma unroll
      for (int n = 0; n < 2; ++n) gv[bj][n] = *(const f32x4*)(ga + b * 6144 + col0 + bj * HALF + n * 16);
#pragma unroll
    for (int ai = 0; ai < 2; ++ai)
#pragma unroll
      for (int m = 0; m < 4; ++m) {
        const size_t off = (size_t)(row0 + ai * HALF + m * 16) * 1024 + col0;
#pragma unroll
        for (int bj = 0; bj < 2; ++bj)
#pragma unroll
          for (int n = 0; n < 2; ++n) {
            const f32x4 xv = *(const f32x4*)(xin + off + bj * HALF + n * 16);
            *(f32x4*)(out + off + bj * HALF + n * 16) = xv + gv[bj][n] * acc[ai][bj][m][n];
          }
      }
  }
};
DEV float sig_(float x) { return 1.f / (1.f + __expf(-x)); }
template <bool SECOND>
struct EpiMerge {
  static constexpr bool PERM = true;
  bf16* Y; const bf16* proj; int gcol;
  DEV void operator()(const f32x4 (&acc)[2][2][4][2], const Unit& u, int wr, int wc, int fr, int fq) const {
    const int row0 = u.pm * BM + wr * 64 + fr, col0 = u.pn * BM + wc * 32 + 8 * fq;
#pragma unroll
    for (int ai = 0; ai < 2; ++ai)
#pragma unroll
      for (int m = 0; m < 4; ++m) {
        const size_t row = (size_t)(row0 + ai * HALF + m * 16);
#pragma unroll
        for (int bj = 0; bj < 2; ++bj) {
          const uint4 gq = *(const uint4*)(proj + row * PC + gcol + col0 + bj * HALF);
          float gf[8];
          unpack8(gq, gf);
          const f32x4 v0 = acc[ai][bj][m][0], v1 = acc[ai][bj][m][1];
          float o[8] = {sig_(gf[0]) * v0[0], sig_(gf[1]) * v0[1], sig_(gf[2]) * v0[2], sig_(gf[3]) * v0[3],
                        sig_(gf[4]) * v1[0], sig_(gf[5]) * v1[1], sig_(gf[6]) * v1[2], sig_(gf[7]) * v1[3]};
          bf16* yp = Y + row * 1024 + col0 + bj * HALF;
          if (SECOND) {
            float yf[8];
            unpack8(*(const uint4*)yp, yf);
#pragma unroll
            for (int j = 0; j < 8; ++j) o[j] += yf[j];
          }
          u32x4_t w;
          w.x = cvt2(o[0], o[1]); w.y = cvt2(o[2], o[3]); w.z = cvt2(o[4], o[5]); w.w = cvt2(o[6], o[7]);
          *(u32x4_t*)yp = w;
        }
      }
  }
};
struct EpiInproj {
  static constexpr bool PERM = true;
  char* ws;
  DEV void operator()(const f32x4 (&acc)[2][2][4][2], const Unit& u, int wr, int wc, int fr, int fq) const {
    const int b = (u.pm * BM) / S;
    const float* rope = (const float*)(ws + OFF_ROPE);
#pragma unroll
    for (int bj = 0; bj < 2; ++bj) {
      const int vcb = u.pn * BM + bj * HALF + wc * 32;
      if (vcb >= 4992) continue;
      const int vc0 = vcb & ~63, inh = vcb & 63;
      bf16* dbase; size_t dstride; bool roped = false; bool headmajor = false; int hh = 0, nh = 1;
      if (vc0 < 768) { dbase = (bf16*)(ws + OFF_PROJ) + vc0; dstride = PC; }
      else if (vc0 < 1280) {
        const int seg = (vc0 - 768) >> 7;
        const size_t off = (seg == 0) ? OFF_KSB : (seg == 1) ? OFF_VSB : (seg == 2) ? OFF_KWB : OFF_VWB;
        dbase = (bf16*)(ws + off); dstride = 64; headmajor = true; hh = ((vc0 - 768) >> 6) & 1; nh = 2;
        roped = (seg == 0) || (seg == 2);
      } else if (vc0 < 1792) { dbase = (bf16*)(ws + OFF_PROJ) + C_MQ + (vc0 - 1280); dstride = PC; roped = true; }
      else if (vc0 < 2816) {
        const int seg = (vc0 - 1792) >> 9;
        dbase = (bf16*)(ws + (seg ? OFF_MVB : OFF_MKB)); dstride = 64; headmajor = true; hh = ((vc0 - 1792) >> 6) & 7; nh = 8;
        roped = (seg == 0);
      } else if (vc0 < 4864) { dbase = (bf16*)(ws + OFF_PROJ) + C_GN + (vc0 - 2816); dstride = PC; }
      else { dbase = (bf16*)(ws + OFF_PROJ) + C_NG + (vc0 - 4864); dstride = PC; }
      const bool do_rope = roped && inh == 0;
#pragma unroll
      for (int ai = 0; ai < 2; ++ai)
#pragma unroll
        for (int m = 0; m < 4; ++m) {
          const int row = u.pm * BM + ai * HALF + wr * 64 + m * 16 + fr;
          const int t = row - b * S;
          const f32x4 v0 = acc[ai][bj][m][0], v1 = acc[ai][bj][m][1];
          float o[8] = {v0[0], v0[1], v0[2], v0[3], v1[0], v1[1], v1[2], v1[3]};
          if (do_rope) {
            float pv[8];
#pragma unroll
            for (int j = 0; j < 8; ++j) pv[j] = shx(o[j], 16);
            const f32x4 c0 = *(const f32x4*)(rope + (size_t)t * 16), c1 = *(const f32x4*)(rope + (size_t)t * 16 + 4);
            const f32x4 s0 = *(const f32x4*)(rope + (size_t)t * 16 + 8), s1 = *(const f32x4*)(rope + (size_t)t * 16 + 12);
            const float cs[8] = {c0[0], c0[1], c0[2], c0[3], c1[0], c1[1], c1[2], c1[3]};
            const float sn[8] = {s0[0], s0[1], s0[2], s0[3], s1[0], s1[1], s1[2], s1[3]};
            const float sg = (fq == 0) ? -1.f : 1.f;
#pragma unroll
            for (int j = 0; j < 8; ++j) o[j] = (fq < 2) ? (o[j] * cs[j] + sg * pv[j] * sn[j]) : o[j];
          }
          bf16* dp = headmajor ? (dbase + ((size_t)(b * nh + hh) * S + t) * 64 + inh + 8 * fq)
                               : (dbase + (size_t)row * dstride + inh + 8 * fq);
          u32x4_t w;
          w.x = cvt2(o[0], o[1]); w.y = cvt2(o[2], o[3]); w.z = cvt2(o[4], o[5]); w.w = cvt2(o[6], o[7]);
          *(u32x4_t*)dp = w;
        }
    }
  }
};
}

template <class F>
DEV void for_tiles_xcd(int MT, int NT, F f) {
  const int nb = vnb(), bid = vbid();
  if ((nb & 15) != 0) {
    for (int it = bid; it < MT * NT; it += nb) f(it / NT, it % NT);
    return;
  }
  const int xcd = (bid >> 1) & 7, slot = ((bid >> 4) << 1) | (bid & 1), nslot = nb >> 3;
  const int nj = (NT - xcd + 7) >> 3;
  for (int q = slot; q < MT * nj; q += nslot) f(q / nj, xcd + 8 * (q % nj));
}
constexpr int PH_PER_LAYER = 15;
enum { SP_NORM1 = 0, SP_INPROJ = 1, SP_COMPRESS = 2, SP_KMEAN = 3, SP_ATTN = 4, SP_MP0 = 5, SP_MM0 = 6, SP_MP1 = 7, SP_MM1 = 8,
       SP_MERGE = 9, SP_OUTPROJ = 10, SP_NORM2 = 11, SP_PEERQ = 12, SP_TOPK = 13, SP_EXPERT = 14 };
constexpr int N_REAL_PHASES = 1 + 2 * PH_PER_LAYER + 1;
constexpr int N_PHASES = N_REAL_PHASES + (PROBE_ANY ? 2 : 0);

DEV void run_phase(const Params& p, int ph, char* smem_raw, bool second_pass = false) {
#define SKIP_MOBA_SECOND (REP_NSA_ONLY && second_pass)
  LAS unsigned char* lds_all = (LAS unsigned char*)smem_raw;
  smem_raw += hidx() * SMEM_BYTES;
  float* smf = (float*)smem_raw;
  bf16* smh = (bf16*)smem_raw;
  const int nb = vnb(), bid = vbid();
  if (ph == 0) {
    for (int it = bid; it < PREP_ITEMS; it += nb) prep_item(p, it, smf);
    return;
  }
  if (ph == N_REAL_PHASES - 1) {
    for (int it = bid; it < T / 4; it += nb) final_norm_item(p.out, p.g_final, it);
    return;
  }
#if PROBE_ANY
  if (ph == N_REAL_PHASES) {
#if PROBE_PROJ
    {
      const unsigned char* Hh = (const unsigned char*)(p.ws + OFF_H8);
      const unsigned char* Wt = (const unsigned char*)(p.ws + OFF_WINT) + (size_t)1 * WN * 1024;
      const unsigned char* hsc = (const unsigned char*)(p.ws + OFF_H8S);
      const unsigned char* wsc = (const unsigned char*)(p.ws + OFF_WCS) + WN;
      const float* rope = (const float*)(p.ws + OFF_ROPE);
      float sd = 0.f, sr = 0.f;
      for (size_t i = (size_t)bid * 256 + tidx(); i < (size_t)(T / 64) * 4888; i += (size_t)nb * 256) {
        const int ts = (int)(i / 4888), vc = (int)(i % 4888);
        const int tok = ts * 64 + (ts % 61);
        const int b = tok / S, t = tok % S;
        auto rawdot = [&](int col) {
          float a = 0.f;
          for (int k = 0; k < 1024; ++k) {
            const f32x2_t hv = __builtin_amdgcn_cvt_pk_f32_fp8((int)Hh[(size_t)tok * 1024 + k], false);
            const f32x2_t wv = __builtin_amdgcn_cvt_pk_f32_fp8((int)Wt[(size_t)col * 1024 + k], false);
            a += hv.x * wv.x;
          }
          return a * __int_as_float((int)hsc[tok] << 23) * __int_as_float((int)wsc[col] << 23);
        };
        float v = rawdot(vc);
        bool roped = false;
        const bf16* dst;
        if (vc < 768) dst = (const bf16*)(p.ws + OFF_PROJ) + (size_t)tok * PC + vc;
        else if (vc < 1280) {
          const int seg = (vc - 768) >> 7, head = ((vc - 768) >> 6) & 1, d = vc & 63;
          const size_t off = (seg == 0) ? OFF_KSB : (seg == 1) ? OFF_VSB : (seg == 2) ? OFF_KWB : OFF_VWB;
          dst = (const bf16*)(p.ws + off) + ((size_t)(b * 2 + head) * S + t) * 64 + d;
          roped = (seg == 0 || seg == 2);
        } else if (vc < 1792) { dst = (const bf16*)(p.ws + OFF_PROJ) + (size_t)tok * PC + C_MQ + (vc - 1280); roped = true; }
        else if (vc < 2816) {
          const int seg = (vc - 1792) >> 9, head = ((vc - 1792) >> 6) & 7, d = vc & 63;
          dst = (const bf16*)(p.ws + (seg ? OFF_MVB : OFF_MKB)) + ((size_t)(b * 8 + head) * S + t) * 64 + d;
          roped = (seg == 0);
        } else if (vc < 4864) dst = (const bf16*)(p.ws + OFF_PROJ) + (size_t)tok * PC + C_GN + (vc - 2816);
        else dst = (const bf16*)(p.ws + OFF_PROJ) + (size_t)tok * PC + C_NG + (vc - 4864);
        const int d = vc & 63;
        if (roped && d < 16) {
          const float cs = rope[(size_t)t * 16 + (d & 7)], sn = rope[(size_t)t * 16 + 8 + (d & 7)];
          if (d < 8) { const float x2 = rawdot(vc + 8); v = v * cs - x2 * sn; }
          else { const float x1 = rawdot(vc - 8); v = v * cs + x1 * sn; }
        }
        const float got = bf2f(*dst);
        const bool is_r = roped && d < 16;
        if (PROBE_PROJ == 1 || (PROBE_PROJ == 2 && is_r) || (PROBE_PROJ == 3 && !is_r)) {
          sd += (got - v) * (got - v);
          sr += v * v;
        }
      }
      sd = wave_sum(sd); sr = wave_sum(sr);
      if ((tidx() & 63) == 0) {
        atomicAdd((float*)(p.ws + OFF_PROBE), sd);
        atomicAdd((float*)(p.ws + OFF_PROBE) + 1, sr);
      }
    }
#endif
#if PROBE_CMPR
    {
      float sd = 0.f, sr = 0.f;
      for (size_t i = (size_t)bid * 256 + tidx(); i < (size_t)2 * Bn * 1024 * 128; i += (size_t)nb * 256) {
        const size_t wh = i / ((size_t)Bn * 1024 * 128), r = i % ((size_t)Bn * 1024 * 128);
        const int c = (int)((r / 128) % 1024);
        if (c < 1023) {
          const float a = ((const float*)(p.ws + (wh ? OFF_VCC : OFF_KCC)))[r];
          const float y = ((const float*)(p.ws + OFF_CMP))[i];
          sd += (a - y) * (a - y);
          sr += y * y;
        }
      }
      sd = wave_sum(sd); sr = wave_sum(sr);
      if ((tidx() & 63) == 0) {
        atomicAdd((float*)(p.ws + OFF_PROBE), sd);
        atomicAdd((float*)(p.ws + OFF_PROBE) + 1, sr);
      }
    }
#endif
#if PROBE_MOBA
    probe_accum_bf16(p, (const bf16*)(p.ws + OFF_OMOBA), (const bf16*)(p.ws + OFF_CMP), (size_t)S * 512, smf);
#endif
#if PROBE_NSA == 8
    {
      const float* impn = (const float*)(p.ws + OFF_OMOBA);
      const float* impm = impn + (size_t)S * 256;
      const int* seld = (const int*)(p.ws + OFF_CMP);
      float sd = 0.f, sr = 0.f, bad = 0.f;
      for (int t = bid * 256 + tidx(); t < S; t += nb * 256) {
        const int cur = t >> 6;
        for (int n = 0; n < 256; ++n) {
          float a = impm[(size_t)t * 256 + n], r = impn[(size_t)t * 256 + n];
          sd += (a - r) * (a - r);
          sr += r * r;
        }
        unsigned want[8] = {0, 0, 0, 0, 0, 0, 0, 0}, got[8] = {0, 0, 0, 0, 0, 0, 0, 0};
        for (int j = 0; j < 16; ++j) {
          int v = seld[(size_t)t * 16 + j];
          if (v >= 0 && v < 256) {
            for (int w = 0; w < 8; ++w) if ((v >> 5) == w) got[w] |= 1u << (v & 31);
          }
        }
        if (cur < 16) {
          for (int n = 0; n <= cur; ++n) want[0] |= 1u << n;
        } else {
          want[0] |= 1u;
          for (int w = 0; w < 8; ++w) {
            if (((cur - 1) >> 5) == w) want[w] |= 1u << ((cur - 1) & 31);
            if ((cur >> 5) == w) want[w] |= 1u << (cur & 31);
          }
          for (int j = 0; j < 13; ++j) {
            float best = -1.f;
            int bi = 1;
            for (int n = 1; n <= cur - 2; ++n) {
              bool taken = false;
              for (int w = 0; w < 8; ++w) if ((n >> 5) == w) taken = (want[w] >> (n & 31)) & 1u;
              float v = impm[(size_t)t * 256 + n];
              if (!taken && v > best) { best = v; bi = n; }
            }
            for (int w = 0; w < 8; ++w) if ((bi >> 5) == w) want[w] |= 1u << (bi & 31);
          }
        }
        bool same = true;
        for (int w = 0; w < 8; ++w) same = same && (want[w] == got[w]);
        if (!same) bad += 1.f;
      }
      sd = wave_sum(sd); sr = wave_sum(sr); bad = wave_sum(bad);
      if ((tidx() & 63) == 0) {
        atomicAdd((float*)(p.ws + OFF_PROBE), sd);
        atomicAdd((float*)(p.ws + OFF_PROBE) + 1, sr);
        atomicAdd((float*)(p.ws + OFF_PROBE) + 2, bad);
      }
    }
#elif PROBE_NSA
    probe_accum_bf16(p, (const bf16*)(p.ws + OFF_ONSA), (const bf16*)(p.ws + OFF_CMP), (size_t)S * 512, smf);
#endif
    return;
  }
  if (ph == N_REAL_PHASES + 1) {
    probe_apply(p);
    return;
  }
#endif
  const int layer = (ph - 1) / PH_PER_LAYER, sub = (ph - 1) % PH_PER_LAYER;
  const float* mod = (const float*)(p.ws + OFF_MOD) + (size_t)layer * 2 * 6144;
  const float* xin = (layer == 0) ? p.x : p.out;
  bf16* H = (bf16*)(p.ws + OFF_H);
  bf16* PROJ = (bf16*)(p.ws + OFF_PROJ);
#if PROBE_ANY
  if (sub >= SP_MERGE) {
    if (sub == SP_OUTPROJ && layer == 0)
      for (size_t i = (size_t)bid * 256 + tidx(); i < (size_t)T * 1024; i += (size_t)nb * 256) p.out[i] = p.x[i];
    return;
  }
#endif
  switch (sub) {
    case SP_NORM1:
      for (int it = bid; it < T / 4; it += nb)
        norm8_item(xin, p.g_attn + layer * 1024, mod + 1024, mod + 0, (unsigned char*)(p.ws + OFF_H8), (unsigned char*)(p.ws + OFF_H8S), it);
      if (layer == 0)
        for (int it = bid; it < WQ8_ITEMS; it += nb) wq8_item(p, it, smf);
      break;
    case SP_INPROJ: {
      g8::StaticOrder so;
      so.init(T, WN, (int)gridDim.x, (int)blockIdx.x);
      g8::gemm_phase<g8::EpiInproj, true>(lds_all, g8::Gemm{(const bf16*)(p.ws + OFF_H8), (const bf16*)(p.ws + OFF_WINT + (size_t)layer * WN * 1024), T, WN, 512,
                                                             (const unsigned char*)(p.ws + OFF_H8S), (const unsigned char*)(p.ws + OFF_WCS) + (size_t)layer * WN},
                                          so, g8::EpiInproj{p.ws});
    } break;
    case SP_COMPRESS:
      for (int it = bid; it < 512 + 1024 + 256; it += nb) {
        if (it < 512) compress_mfma_item(p, layer, it, smem_raw);
        else if (it < 1536) kmean_item(p, it - 512, smf);
        else kvamax_item(p, layer, it - 1536);
      }
#if PROBE_CMPR
      if (layer == 1)
        for (int it = bid; it < 1024; it += nb) compress_item(p, layer, it, smf);
#endif
      break;
    case SP_KMEAN:
      for (int it = bid; it < 1024; it += nb) kvq_item(p, layer, it, smf);
#if PROBE_NSA
      if (layer == 1)
        for (int it = bid; it < 512; it += nb) n1_item(p, layer, it, smf);
#endif
      break;
    case SP_ATTN:
      {
        constexpr int MNI = 2;
        constexpr int NMOBA = 16 * (S / (64 * MNI));
        constexpr int NNI = 2;
        constexpr int NNSA = 4 * (S / (16 * NNI));
        const bool do_nsa = !PROBE_ANY || PROBE_NSA, do_moba = (!PROBE_ANY || PROBE_MOBA) && PROBE_NSA != 8;
        {
          constexpr int NCH = S / (16 * NNI);
          const bool affine = nb >= 8;
          const int grp = bid & 7, bk = grp & 3, sub = grp >> 2;
          const int i0 = affine ? (bid >> 3) : bid;
          const int istride = affine ? ((nb - grp + 7) >> 3) : nb;
          const int icount = affine ? (NCH / 2) : NNSA;
          if (do_nsa)
            for (int i = i0; i < icount; i += istride)
              nsa_item<NNI>(p, layer, affine ? (((2 * i + sub) << 2) | bk) : i, smem_raw, (bf16*)(p.ws + OFF_ONSA));
          if (do_moba && !SKIP_MOBA_SECOND)
            for (int it = bid; it < NMOBA; it += nb) moba_gate_item<MNI>(p, it);
        }
#if PROBE_NSA && PROBE_NSA != 8
        if (layer == 1)
          for (int it = bid; it < 512; it += nb) n23_item(p, layer, it);
#endif
#if PROBE_MOBA
        if (layer == 1) {
          for (int it = bid; it < 512; it += nb) moba_item(p, layer, it);
        }
#endif
      }
      break;
    case SP_MP0:
    case SP_MP1:
      if ((!PROBE_ANY || PROBE_MOBA) && PROBE_NSA != 8)
        for (int it = bid; it < 8 * 63 * 8; it += nb) moba_part_item2<2>(p, sub == SP_MP1 ? 1 : 0, it, smem_raw);
      break;
    case SP_MM0:
    case SP_MM1:
      if ((!PROBE_ANY || PROBE_MOBA) && PROBE_NSA != 8)
        for (int it = bid; it < 8 * (S / 128); it += nb)
          moba_merge_item<2>(p, sub == SP_MM1 ? 1 : 0, it, smem_raw, (bf16*)(p.ws + OFF_OMOBA));
      break;
    case SP_MERGE:
      {
        g8::StaticOrder so;
        so.init(T, 1024, (int)gridDim.x, (int)blockIdx.x);
        g8::gemm_phase(lds_all, g8::Gemm{(const bf16*)(p.ws + OFF_ONSA), (const bf16*)(p.ws + OFF_WUPN) + (size_t)layer * 1024 * 512, T, 1024, 512}, so,
                       g8::EpiMerge<false>{H, PROJ, C_GN});
        g8::gemm_phase(lds_all, g8::Gemm{(const bf16*)(p.ws + OFF_OMOBA), (const bf16*)(p.ws + OFF_WUPM) + (size_t)layer * 1024 * 512, T, 1024, 512}, so,
                       g8::EpiMerge<true>{H, PROJ, C_GM});
      }
      break;
    case SP_OUTPROJ: {
      const bf16* W = (const bf16*)(p.ws + OFF_WOUT) + (size_t)layer * 1024 * 1024;
      const float* ga1 = mod + 2048;
      g8::StaticOrder so;
      so.init(T, 1024, (int)gridDim.x, (int)blockIdx.x);
      g8::gemm_phase(lds_all, g8::Gemm{H, W, T, 1024, 1024}, so, g8::EpiResid{xin, p.out, ga1});
    } break;
    case SP_NORM2:
      for (int it = bid; it < T / 4 + NEXP / 4; it += nb) {
        if (it < T / 4) norm_item(p.out, p.g_ffn + layer * 1024, mod + 4096, mod + 3072, H, it);
        else expert_cvt_item(p, layer, it - T / 4);
      }
      break;
    case SP_PEERQ: {
      const bf16* W = (const bf16*)(p.ws + OFF_WQ) + (size_t)layer * 2048 * 1024;
      bf16* QP = (bf16*)(p.ws + OFF_QP);
      g8::StaticOrder so;
      so.init(T, 2048, (int)gridDim.x, (int)blockIdx.x);
      g8::gemm_phase(lds_all, g8::Gemm{H, W, T, 2048, 1024}, so, g8::EpiBf16{QP, 2048});
    } break;
    case SP_TOPK:
#if REP_MASK
      for (int it = bid; it < T / 8; it += nb) peer_topk_item3(p, layer, it);
#endif
      break;
    case SP_EXPERT:
#if REP_MASK
      for (int it = bid; it < T / 4; it += nb) peer_expert_item2(p, layer, it, second_pass ? 0.f : 1.f);
#else
      for (int it = bid; it < T / 8; it += nb) peer_fused_item(p, layer, it, smem_raw);
#endif
      break;
  }
}

#define MEGA_LB __launch_bounds__(512, 2)
__global__ void MEGA_LB mega_kernel(Params p, int ph_lo, int ph_hi) {
  __shared__ __attribute__((aligned(16))) char smem_raw[2 * SMEM_BYTES + 16];
  volatile LAS unsigned* xbst = (volatile LAS unsigned*)(smem_raw + 2 * SMEM_BYTES);
  if (threadIdx.x == 0) { xbst[0] = 0u; xbst[1] = 0u; xbst[2] = 0u; xbst[3] = 0u; }
  __syncthreads();
  XcdBarrier xb = xcd_barrier_post((unsigned*)(p.ws + OFF_BAR), xbst);
  for (int ph = ph_lo; ph < ph_hi; ++ph) {
#if !PROBE_ANY && !REP_MASK
    if (ph == N_REAL_PHASES - 1 || ph == 1 + PH_PER_LAYER || (ph >= 1 && (ph - 1) % PH_PER_LAYER == SP_TOPK))
      continue;
#endif
#if REP_MASK
    const int nrep = (ph >= 1 && ph < N_REAL_PHASES - 1 && ((REP_MASK >> ((ph - 1) % PH_PER_LAYER)) & 1)) ? 2 : 1;
    for (int rep = 0; rep < nrep; ++rep) {
      if (rep) xcd_barrier(xb);
      run_phase(p, ph, smem_raw, rep != 0);
    }
#else
    run_phase(p, ph, smem_raw);
#endif
    if (ph + 1 < ph_hi) {
      if (ph == ph_lo) cg::this_grid().sync();
      else xcd_barrier(xb);
    }
  }
}

extern "C" void kernel_launch(void* const* d_in, const int* in_sizes, int n_in, void* d_out, int out_size, void* d_ws,
                              size_t ws_size, hipStream_t stream) {
  if (ws_size < WS_TOTAL) {
    fprintf(stderr, "workspace too small: %zu < %zu\n", ws_size, (size_t)WS_NEED);
    return;
  }
  Params p{};
  p.x = (const float*)d_in[0]; p.c = (const float*)d_in[1]; p.w_ada = (const float*)d_in[2];
  p.b_ada = (const float*)d_in[3]; p.g_attn = (const float*)d_in[4]; p.g_ffn = (const float*)d_in[5];
  p.w_in = (const float*)d_in[6]; p.cmp_pe = (const float*)d_in[7]; p.cmp_w1 = (const float*)d_in[8];
  p.cmp_w2 = (const float*)d_in[9]; p.w_up_nsa = (const float*)d_in[10]; p.w_up_moba = (const float*)d_in[11];
  p.w_out = (const float*)d_in[12]; p.peer_wq = (const float*)d_in[13]; p.peer_k1 = (const float*)d_in[14];
  p.peer_k2 = (const float*)d_in[15]; p.peer_u = (const float*)d_in[16]; p.peer_v = (const float*)d_in[17];
  p.g_final = (const float*)d_in[18];
  p.out = (float*)d_out;
  p.ws = (char*)d_ws;
  static int grid_blocks = 0;
  if (!grid_blocks) {
    int dev = 0, cus = 0, per_cu = 0;
    hipGetDevice(&dev);
    hipDeviceGetAttribute(&cus, hipDeviceAttributeMultiprocessorCount, dev);
    hipOccupancyMaxActiveBlocksPerMultiprocessor(&per_cu, mega_kernel, 512, 0);
    if (per_cu < 1) per_cu = 1;
    if (per_cu > 1) per_cu = 1;
    grid_blocks = cus * per_cu;
  }
  hipMemsetAsync((char*)d_ws + OFF_BAR, 0, BAR_BYTES, stream);
  int ph_lo = 0, ph_hi = N_PHASES;
  void* args[] = {(void*)&p, (void*)&ph_lo, (void*)&ph_hi};
  hipError_t e = hipLaunchCooperativeKernel((const void*)mega_kernel, dim3(grid_blocks), dim3(512), args, 0, stream);
  if (e != hipSuccess) fprintf(stderr, "cooperative launch failed: %s (grid %d)\n", hipGetErrorString(e), grid_blocks);
}
```

```cpp
#include <hip/hip_runtime.h>
#include <hip/hip_bf16.h>
#include <hip/hip_cooperative_groups.h>
#include <cstdio>
#include <cstdint>
namespace cg = cooperative_groups;

#define DEV __device__ __forceinline__
typedef unsigned short bf16;
using bf16x8 = __attribute__((ext_vector_type(8))) short;
using f32x4 = __attribute__((ext_vector_type(4))) float;

constexpr int Bn = 2, S = 16384, T = Bn * S, D = 1024;
constexpr int PC = 3456;
constexpr int WN = 5120;
constexpr int C_NQ = 0, C_KC = 512, C_VC = 640, C_MQ = 768, C_GN = 1280, C_GM = 2304, C_NG = 3328;
constexpr int NEXP = 16384;

constexpr size_t al(size_t x) { return (x + 255) & ~size_t(255); }
constexpr size_t OFF_MOD = 0;
constexpr size_t OFF_ROPE = al(OFF_MOD + 2 * 2 * 6144 * 4);
constexpr size_t OFF_PEB = al(OFF_ROPE + (size_t)S * 16 * 4);
constexpr size_t OFF_WINT = al(OFF_PEB + 2 * 2 * 128 * 4);
constexpr size_t OFF_WUPN = al(OFF_WINT + 2ull * WN * 1024 * 2);
constexpr size_t OFF_WUPM = al(OFF_WUPN + 2ull * 1024 * 512 * 2);
constexpr size_t OFF_WOUT = al(OFF_WUPM + 2ull * 1024 * 512 * 2);
constexpr size_t OFF_WQ = al(OFF_WOUT + 2ull * 1024 * 1024 * 2);
constexpr size_t OFF_KCC = al(OFF_WQ + 2ull * 2048 * 1024 * 2);
constexpr size_t OFF_VCC = al(OFF_KCC + 2ull * 1024 * 128 * 4);
constexpr size_t OFF_SEL = al(OFF_VCC + 2ull * 1024 * 128 * 4);
constexpr size_t OFF_KMEAN = al(OFF_SEL + 2ull * 2 * S * 16 * 4);
constexpr size_t OFF_KMHL = al(OFF_KMEAN + 2ull * 8 * 64 * 64 * 4);
constexpr size_t OFF_KCB = al(OFF_KMHL + 2ull * 2 * 8 * 64 * 64 * 2);
constexpr size_t OFF_VCB = al(OFF_KCB + 2ull * 2 * 1024 * 64 * 2);
constexpr size_t OFF_PKB = al(OFF_VCB + 2ull * 2 * 1024 * 64 * 2);
constexpr size_t OFF_W1T = al(OFF_PKB + 2ull * 2 * 128 * 128 * 2);
constexpr size_t OFF_BAR = al(OFF_W1T + 4ull * 128 * 2048 * 2);
constexpr size_t BAR_BYTES = 3456 * 4;
constexpr size_t OFF_PROBE = al(OFF_BAR + BAR_BYTES);
constexpr size_t OFF_H = al(OFF_PROBE + 256);
constexpr size_t OFF_WCS = OFF_WINT + 2ull * WN * 1024;
constexpr size_t OFF_ONSA = al(OFF_H + (size_t)T * 1024 * 2);
constexpr size_t OFF_OMOBA = al(OFF_ONSA + (size_t)T * 512 * 2);
constexpr size_t OFF_H8 = OFF_ONSA;
constexpr size_t OFF_H8S = OFF_OMOBA;
constexpr size_t OFF_PROJ = al(OFF_OMOBA + (size_t)T * 512 * 2);
constexpr size_t KV2_BYTES = (size_t)Bn * 2 * S * 64 * 2, KV8_BYTES = (size_t)Bn * 8 * S * 64 * 2;
constexpr size_t OFF_KSB = al(OFF_PROJ + (size_t)T * PC * 2);
constexpr size_t OFF_VSB = OFF_KSB + KV2_BYTES;
constexpr size_t OFF_KWB = OFF_VSB + KV2_BYTES;
constexpr size_t OFF_VWB = OFF_KWB + KV2_BYTES;
constexpr size_t OFF_MKB = OFF_VWB + KV2_BYTES;
constexpr size_t OFF_MVB = OFF_MKB + KV8_BYTES;
constexpr int MLIST_PER_BH = 63 * S - 128 * 63 * 64;
constexpr size_t OFF_MLIST = OFF_MVB + KV8_BYTES;
constexpr size_t OFF_MCNT = al(OFF_MLIST + (size_t)Bn * 8 * MLIST_PER_BH * 2);
constexpr size_t OFF_KS8 = al(OFF_MCNT + (size_t)Bn * 8 * 64 * 4);
constexpr size_t OFF_VT8 = OFF_KS8 + (size_t)Bn * 2 * S * 64;
constexpr size_t WS_NEED = OFF_VT8 + (size_t)Bn * 2 * S * 64;
constexpr size_t PROJ_BYTES = (size_t)T * PC * 2;
constexpr size_t OFF_MPO = OFF_H;
constexpr size_t OFF_MPML = OFF_H + (size_t)8 * S * 3 * 64 * 2;
static_assert((size_t)8 * S * 3 * 64 * 2 + (size_t)8 * S * 3 * 8 <= (size_t)T * 1024 * 2, "moba partials must fit the H region");
constexpr size_t OFF_QP = OFF_PROJ;
constexpr size_t OFF_PEIDX = al(OFF_QP + (size_t)T * 2048 * 2);
constexpr size_t OFF_PEG = al(OFF_PEIDX + (size_t)T * 128 * 4);
constexpr size_t OFF_E8 = al(OFF_PEG + (size_t)T * 128 * 4);
constexpr size_t OFF_ESC = al(OFF_E8 + (size_t)NEXP * 2048);
static_assert(OFF_ESC + (size_t)NEXP * 2 * 4 <= OFF_PROJ + PROJ_BYTES, "peer alias overflow");
static_assert(WS_NEED <= 536870912ull, "workspace too big");
#ifndef PROBE_MOBA
#define PROBE_MOBA 0
#endif
constexpr size_t OFF_CMP = PROBE_MOBA ? OFF_ONSA : OFF_MLIST;
#ifndef REP_NSA_ONLY
#define REP_NSA_ONLY 0
#endif
#ifndef REP_NSA_PART
#define REP_NSA_PART 0
#endif
#ifndef REP_MASK
#define REP_MASK 0
#endif
#ifndef PROBE_MOBA
#define PROBE_MOBA 0
#endif
#ifndef PROBE_NSA
#define PROBE_NSA 0
#endif
#ifndef PROBE_CMPR
#define PROBE_CMPR 0
#endif
#ifndef PROBE_PROJ
#define PROBE_PROJ 0
#endif
#define PROBE_ANY (PROBE_MOBA || PROBE_NSA || PROBE_CMPR || PROBE_PROJ)
constexpr size_t WS_TOTAL = WS_NEED;
static_assert(WS_TOTAL <= 536870912ull, "workspace too big (probe)");

struct Params {
  const float *x, *c, *w_ada, *b_ada, *g_attn, *g_ffn, *w_in, *cmp_pe, *cmp_w1, *cmp_w2, *w_up_nsa, *w_up_moba, *w_out,
      *peer_wq, *peer_k1, *peer_k2, *peer_u, *peer_v, *g_final;
  float* out;
  char* ws;
};

constexpr int SMEM_BYTES = 74 * 1024;

DEV int tidx() {
  int t = threadIdx.x & 255;
  asm volatile("" : "+v"(t));
  return t;
}
DEV int hidx() { return __builtin_amdgcn_readfirstlane((int)(threadIdx.x >> 8)); }
DEV int vbid() { return (int)blockIdx.x * 2 + hidx(); }
DEV int vnb() { return (int)gridDim.x * 2; }
#define MFMA16B(a, b, c) __builtin_amdgcn_mfma_f32_16x16x32_bf16(a, b, c, 0, 0, 0)
DEV unsigned cvtpk_(float lo, float hi) {
  unsigned r;
  asm("v_cvt_pk_bf16_f32 %0, %1, %2" : "=v"(r) : "v"(lo), "v"(hi));
  return r;
}
DEV float bf2f(bf16 h) { return __uint_as_float(((unsigned)h) << 16); }
DEV bf16 f2bf(float f) {
  unsigned u = __float_as_uint(f);
  u += 0x7fffu + ((u >> 16) & 1u);
  return (bf16)(u >> 16);
}
DEV float gelu_tanh(float x) {
  float u = 0.7978845608028654f * (x + 0.044715f * x * x * x);
  return 0.5f * x * (1.f + tanhf(u));
}
DEV float sigmoidf_(float x) { return 1.f / (1.f + expf(-x)); }
DEV void unpack8(uint4 v, float* f) {
  f[0] = __uint_as_float(v.x << 16); f[1] = __uint_as_float(v.x & 0xffff0000u);
  f[2] = __uint_as_float(v.y << 16); f[3] = __uint_as_float(v.y & 0xffff0000u);
  f[4] = __uint_as_float(v.z << 16); f[5] = __uint_as_float(v.z & 0xffff0000u);
  f[6] = __uint_as_float(v.w << 16); f[7] = __uint_as_float(v.w & 0xffff0000u);
}
DEV float dot64_bf(const float* q, const bf16* row) {
  float s = 0.f;
#pragma unroll
  for (int i = 0; i < 8; ++i) {
    float f[8];
    unpack8(*(const uint4*)(row + i * 8), f);
#pragma unroll
    for (int j = 0; j < 8; ++j) s += q[i * 8 + j] * f[j];
  }
  return s;
}
DEV void axpy64_bf(float* o, float a, const bf16* row) {
#pragma unroll
  for (int i = 0; i < 8; ++i) {
    float f[8];
    unpack8(*(const uint4*)(row + i * 8), f);
#pragma unroll
    for (int j = 0; j < 8; ++j) o[i * 8 + j] += a * f[j];
  }
}
DEV float dot64_f(const float* q, const float* row) {
  float s = 0.f;
#pragma unroll
  for (int i = 0; i < 16; ++i) {
    float4 v = *(const float4*)(row + i * 4);
    s += q[i * 4] * v.x + q[i * 4 + 1] * v.y + q[i * 4 + 2] * v.z + q[i * 4 + 3] * v.w;
  }
  return s;
}
DEV void axpy64_f(float* o, float a, const float* row) {
#pragma unroll
  for (int i = 0; i < 16; ++i) {
    float4 v = *(const float4*)(row + i * 4);
    o[i * 4] += a * v.x; o[i * 4 + 1] += a * v.y; o[i * 4 + 2] += a * v.z; o[i * 4 + 3] += a * v.w;
  }
}
DEV void load_q64(float* q, const bf16* p, float scale) {
#pragma unroll
  for (int i = 0; i < 8; ++i) unpack8(*(const uint4*)(p + i * 8), q + i * 8);
#pragma unroll
  for (int i = 0; i < 64; ++i) q[i] *= scale;
}
DEV int lane_id_() { return __builtin_amdgcn_mbcnt_hi(~0u, __builtin_amdgcn_mbcnt_lo(~0u, 0u)); }
DEV int shx(int v, int m) {
  if (m == 1) return __builtin_amdgcn_update_dpp(0, v, 0xB1, 0xF, 0xF, true);
  if (m == 2) return __builtin_amdgcn_update_dpp(0, v, 0x4E, 0xF, 0xF, true);
  if (m == 4) return __builtin_amdgcn_ds_swizzle(v, 0x101F);
  if (m == 8) return __builtin_amdgcn_update_dpp(0, v, 0x128, 0xF, 0xF, true);
  if (m == 16) return __builtin_amdgcn_ds_swizzle(v, 0x401F);
  auto rr = __builtin_amdgcn_permlane32_swap((unsigned)v, (unsigned)v, false, false);
  return (lane_id_() < 32) ? (int)rr[1] : (int)rr[0];
}
DEV unsigned shx(unsigned v, int m) { return (unsigned)shx((int)v, m); }
DEV float shx(float v, int m) { return __int_as_float(shx(__float_as_int(v), m)); }
DEV float wave_sum(float v) {
#pragma unroll
  for (int o = 32; o >= 1; o >>= 1) v += shx(v, o);
  return v;
}

#define XB_TMO      128
#define XB_XCNT(j)  (256  + 64 * (j))
#define XB_XSUB(j)  (1280 + 64 * (j))
#define XB_XGEN(j)  (2304 + 64 * (j))
#define XB_TOP      3328
#define XB_TOPGEN   3392
#define XCD_BAR_WORDS 3456
#define XB_SPIN_CAP (1u << 18)
#define LAS __attribute__((address_space(3)))

__device__ __forceinline__ unsigned xb_ld(unsigned* p)              { return __hip_atomic_load(p, __ATOMIC_RELAXED, __HIP_MEMORY_SCOPE_AGENT); }
__device__ __forceinline__ unsigned xb_add(unsigned* p, unsigned v) { return __hip_atomic_fetch_add(p, v, __ATOMIC_RELAXED, __HIP_MEMORY_SCOPE_AGENT); }
__device__ __forceinline__ unsigned xb_xcc_id() { return (unsigned)__builtin_amdgcn_s_getreg((3 << 11) | 20) & 0xFu; }
#define XB_SPIN(cond, bar) do { unsigned _sp = 0; while (cond) { __builtin_amdgcn_s_sleep(1); \
    if ((++_sp & 255u) == 0u) { if (xb_ld(&(bar)[XB_TMO])) break; if (_sp > XB_SPIN_CAP) { atomicAdd(&(bar)[XB_TMO], 1u); break; } } } } while (0)

struct XcdBarrier {
    unsigned* bar; unsigned x;
    volatile LAS unsigned* st;
};

__device__ __forceinline__ XcdBarrier xcd_barrier_post(unsigned* bar, volatile LAS unsigned* st) {
    XcdBarrier b; b.bar = bar; b.x = xb_xcc_id(); b.st = st;
    if (threadIdx.x == 0) (void)xb_add(&bar[XB_XCNT(b.x)], 1u);
    return b;
}
__device__ __forceinline__ void xcd_barrier_complete(unsigned* bar, unsigned x, unsigned& nloc, unsigned& nx) {
    const unsigned G = gridDim.x * gridDim.y * gridDim.z;
    unsigned sum, cnt, mine, sp = 0u;
    for (;;) {
        sum = 0u; cnt = 0u; mine = 0u;
#pragma unroll
        for (unsigned j = 0; j < 16; ++j) { const unsigned c = xb_ld(&bar[XB_XCNT(j)]); sum += c; cnt += (c > 0u) ? 1u : 0u; mine = (j == x) ? c : mine; }
        if (sum == G) break;
        __builtin_amdgcn_s_sleep(1);
        if ((++sp & 255u) == 0u) { if (xb_ld(&bar[XB_TMO])) break; if (sp > XB_SPIN_CAP) { atomicAdd(&bar[XB_TMO], 1u); break; } }
    }
    nloc = mine > 0u ? mine : 1u; nx = cnt > 0u ? cnt : 1u;
}

__device__ __forceinline__ void xcd_barrier(const XcdBarrier& b) {
    asm volatile("s_waitcnt vmcnt(0)" ::: "memory");
    __syncthreads();
    if (threadIdx.x == 0) {
        unsigned* bar = b.bar;
        __builtin_amdgcn_s_waitcnt(0);
        unsigned nloc = b.st[0], nx = b.st[1];
        if (nloc == 0u) { xcd_barrier_complete(bar, b.x, nloc, nx); b.st[0] = nloc; b.st[1] = nx; }
        const unsigned old = xb_add(&bar[XB_XSUB(b.x)], 1u);
        const unsigned gen = old / nloc;
        if (old + 1u == (gen + 1u) * nloc) {
            __builtin_amdgcn_fence(__ATOMIC_RELEASE, "agent");
            asm volatile("s_waitcnt vmcnt(0)" ::: "memory");
            const unsigned og = xb_add(&bar[XB_TOP], 1u);
            const unsigned tg = og / nx;
            if (og + 1u == (tg + 1u) * nx) xb_add(&bar[XB_TOPGEN], 1u);
            else XB_SPIN(xb_ld(&bar[XB_TOPGEN]) == tg, bar);
            __builtin_amdgcn_fence(__ATOMIC_ACQUIRE, "agent");
            xb_add(&bar[XB_XGEN(b.x)], 1u);
            asm volatile("s_waitcnt vmcnt(0)" ::: "memory");
        } else {
            XB_SPIN(xb_ld(&bar[XB_XGEN(b.x)]) == gen, bar);
            __builtin_amdgcn_fence(__ATOMIC_ACQUIRE, "agent");
            asm volatile("s_waitcnt vmcnt(0)" ::: "memory");
        }
    }
    __syncthreads();
}


DEV int win_col_map(int j) {
  if (j < 1280) return j;
  if (j < 4864) return j + 24;
  if (j < 4888) return j - 4864 + 1280;
  return -1;
}
DEV void tr_tile(const float* __restrict__ src, int ldsrc, int K, bf16* __restrict__ dst, int kt, int nt, bool remap,
                 float* sm) {
  const int tid = tidx();
#pragma unroll 4
  for (int i = 0; i < 16; ++i) {
    int r = i * 4 + (tid >> 6), cx = tid & 63;
    int j = nt * 64 + cx, k = kt * 64 + r;
    int oc = remap ? win_col_map(j) : j;
    sm[r * 65 + cx] = (oc >= 0) ? src[(size_t)k * ldsrc + oc] : 0.f;
  }
  __syncthreads();
#pragma unroll 4
  for (int i = 0; i < 16; ++i) {
    int n = i * 4 + (tid >> 6), kk = tid & 63;
    dst[(size_t)(nt * 64 + n) * K + kt * 64 + kk] = f2bf(sm[kk * 65 + n]);
  }
  __syncthreads();
}

DEV unsigned e8m0_of(float amax) {
  const unsigned bits = (unsigned)__float_as_int(amax * (1.f / 224.f));
  unsigned e = ((bits >> 23) & 255u) + ((bits & 0x7fffffu) ? 1u : 0u);
  return e < 1u ? 1u : (e > 253u ? 253u : e);
}
DEV float e8m0_inv(unsigned e) { return __int_as_float((int)((254u - e) << 23)); }
DEV unsigned pack4_fp8_(float a, float b, float c, float d) {
  int q = __builtin_amdgcn_cvt_pk_fp8_f32(a, b, 0, false);
  q = __builtin_amdgcn_cvt_pk_fp8_f32(c, d, q, true);
  return (unsigned)q;
}
DEV void wamax_item(const Params& p, int item) {
  const int l = item >> 7, part = item & 127;
  const size_t per = (size_t)1024 * 4888 / 128;
  const float4* src = (const float4*)(p.w_in + (size_t)l * 1024 * 4888 + (size_t)part * per);
  float m = 0.f;
  for (int i = tidx(); i < (int)(per / 4); i += 256) {
    const float4 v = src[i];
    m = fmaxf(m, fmaxf(fmaxf(fabsf(v.x), fabsf(v.y)), fmaxf(fabsf(v.z), fabsf(v.w))));
  }
#pragma unroll
  for (int o = 32; o >= 1; o >>= 1) m = fmaxf(m, shx(m, o));
  if ((tidx() & 63) == 0) atomicMax((unsigned*)(p.ws + OFF_BAR) + l, (unsigned)__float_as_int(m));
}
DEV void wq8_item(const Params& p, int item, float* sm) {
  const int tid = tidx();
  const int l = item / (80 * 16), r_ = item % (80 * 16);
  const int nt = r_ / 16, kt = r_ % 16;
  const float* src = p.w_in + (size_t)l * 1024 * 4888;
  unsigned char* dst = (unsigned char*)(p.ws + OFF_WINT) + (size_t)l * WN * 1024;
  const unsigned e = e8m0_of(__int_as_float((int)__hip_atomic_load((const unsigned*)(p.ws + OFF_BAR) + l, __ATOMIC_RELAXED, __HIP_MEMORY_SCOPE_AGENT)));
  const float s = e8m0_inv(e);
#pragma unroll 4
  for (int i = 0; i < 16; ++i) {
    const int r = i * 4 + (tid >> 6), cx = tid & 63;
    const int oc = win_col_map(nt * 64 + cx);
    sm[r * 65 + cx] = (oc >= 0) ? src[(size_t)(kt * 64 + r) * 4888 + oc] : 0.f;
  }
  __syncthreads();
  const int kq = tid & 15;
#pragma unroll
  for (int i = 0; i < 4; ++i) {
    const int n = i * 16 + (tid >> 4);
    const float v0 = sm[(kq * 4 + 0) * 65 + n], v1 = sm[(kq * 4 + 1) * 65 + n], v2 = sm[(kq * 4 + 2) * 65 + n], v3 = sm[(kq * 4 + 3) * 65 + n];
    *(unsigned*)(dst + (size_t)(nt * 64 + n) * 1024 + kt * 64 + kq * 4) = pack4_fp8_(v0 * s, v1 * s, v2 * s, v3 * s);
  }
  if (kt == 0 && tid < 64) ((unsigned char*)(p.ws + OFF_WCS))[(size_t)l * WN + nt * 64 + tid] = (unsigned char)e;
  __syncthreads();
}
constexpr int WQ8_ITEMS = 2 * 80 * 16;
constexpr int PREP_TR_WIN = 2 * 128;
constexpr int PREP_TR_UPN = 2 * 16 * 8;
constexpr int PREP_TR_UPM = 2 * 16 * 8;
constexpr int PREP_TR_OUT = 2 * 16 * 16;
constexpr int PREP_TR_WQ = 2 * 32 * 16;
constexpr int PREP_ROPE = 512;
constexpr int PREP_MOD = 384;
constexpr int PREP_PEB = 16;
constexpr int PREP_PK = 32;
constexpr int PREP_TR_W1 = 4 * 2 * 32;
constexpr int PREP_ITEMS = PREP_TR_WIN + PREP_TR_UPN + PREP_TR_UPM + PREP_TR_OUT + PREP_TR_WQ + PREP_ROPE + PREP_MOD + PREP_PEB + PREP_PK + PREP_TR_W1;

DEV void prep_item(const Params& p, int item, float* sm) {
  const int tid = tidx();
  if (item < PREP_TR_WIN) {
    wamax_item(p, item);
    return;
  }
  item -= PREP_TR_WIN;
  if (item < PREP_TR_UPN) {
    int l = item / 128, r = item % 128;
    int nt = r / 8, kt = r % 8;
    tr_tile(p.w_up_nsa + (size_t)l * 512 * 1024, 1024, 512, (bf16*)(p.ws + OFF_WUPN) + (size_t)l * 1024 * 512, kt, nt, false, sm);
    return;
  }
  item -= PREP_TR_UPN;
  if (item < PREP_TR_UPM) {
    int l = item / 128, r = item % 128;
    int nt = r / 8, kt = r % 8;
    tr_tile(p.w_up_moba + (size_t)l * 512 * 1024, 1024, 512, (bf16*)(p.ws + OFF_WUPM) + (size_t)l * 1024 * 512, kt, nt, false, sm);
    return;
  }
  item -= PREP_TR_UPM;
  if (item < PREP_TR_OUT) {
    int l = item / 256, r = item % 256;
    int nt = r / 16, kt = r % 16;
    tr_tile(p.w_out + (size_t)l * 1024 * 1024, 1024, 1024, (bf16*)(p.ws + OFF_WOUT) + (size_t)l * 1024 * 1024, kt, nt, false, sm);
    return;
  }
  item -= PREP_TR_OUT;
  if (item < PREP_TR_WQ) {
    int l = item / 512, r = item % 512;
    int nt = r / 16, kt = r % 16;
    tr_tile(p.peer_wq + (size_t)l * 1024 * 2048, 2048, 1024, (bf16*)(p.ws + OFF_WQ) + (size_t)l * 2048 * 1024, kt, nt, false, sm);
    return;
  }
  item -= PREP_TR_WQ;
  if (item < PREP_ROPE) {
    int idx = item * 256 + tid;
    int pos = idx >> 3, i = idx & 7;
    float inv = powf(500000.0f, -(float)i / 8.0f);
    float ang = (float)pos * inv;
    float* rp = (float*)(p.ws + OFF_ROPE) + (size_t)pos * 16;
    rp[i] = cosf(ang);
    rp[8 + i] = sinf(ang);
    return;
  }
  item -= PREP_ROPE;
  if (item < PREP_MOD) {
    for (int i = tid; i < 2048; i += 256) {
      float cv = p.c[i];
      sm[i] = cv / (1.f + expf(-cv));
    }
    __syncthreads();
    const int l = item / 192, n0 = (item % 192) * 32;
    const int col = tid & 31, ks = tid >> 5;
    const float* w = p.w_ada + (size_t)l * 1024 * 6144 + n0 + col;
    float a0 = 0.f, a1 = 0.f;
#pragma unroll 8
    for (int k = ks * 128; k < ks * 128 + 128; ++k) {
      float wv = w[(size_t)k * 6144];
      a0 += sm[k] * wv;
      a1 += sm[1024 + k] * wv;
    }
    sm[2048 + tid * 2] = a0;
    sm[2048 + tid * 2 + 1] = a1;
    __syncthreads();
    if (tid < 64) {
      const int c2 = tid & 31, bs = tid >> 5;
      float s = 0.f;
#pragma unroll
      for (int q = 0; q < 8; ++q) s += sm[2048 + (q * 32 + c2) * 2 + bs];
      ((float*)(p.ws + OFF_MOD))[(l * 2 + bs) * 6144 + n0 + c2] = s + p.b_ada[l * 6144 + n0 + c2];
    }
    __syncthreads();
    return;
  }
  item -= PREP_MOD;
  if (item < PREP_PEB) {
    const int lw = item >> 2, j0 = (item & 3) * 32;
    const int col = tid & 31, ks = tid >> 5;
    const float* pe = p.cmp_pe + (size_t)lw * 2048;
    const float* w1 = p.cmp_w1 + (size_t)lw * 2048 * 128 + j0 + col;
    float a = 0.f;
#pragma unroll 8
    for (int i = ks * 256; i < ks * 256 + 256; ++i) a += pe[i] * w1[(size_t)i * 128];
    sm[tid] = a;
    __syncthreads();
    if (tid < 32) {
      float s = 0.f;
#pragma unroll
      for (int q = 0; q < 8; ++q) s += sm[q * 32 + tid];
      ((float*)(p.ws + OFF_PEB))[lw * 128 + j0 + tid] = s;
    }
    if (item == 0 && tid < 4) ((float*)(p.ws + OFF_PROBE))[tid] = 0.f;
    __syncthreads();
    return;
  }
  item -= PREP_PEB;
  if (item < PREP_PK) {
    const int e0 = item * 2048 + tid * 8;
    const int lt = e0 >> 14, off = e0 & 16383;
    const float* srcp = ((lt & 1) ? p.peer_k2 : p.peer_k1) + (size_t)(lt >> 1) * 16384 + off;
    const float4 a = *(const float4*)srcp, b4 = *(const float4*)(srcp + 4);
    uint4 pk;
    pk.x = (unsigned)f2bf(a.x) | ((unsigned)f2bf(a.y) << 16);
    pk.y = (unsigned)f2bf(a.z) | ((unsigned)f2bf(a.w) << 16);
    pk.z = (unsigned)f2bf(b4.x) | ((unsigned)f2bf(b4.y) << 16);
    pk.w = (unsigned)f2bf(b4.z) | ((unsigned)f2bf(b4.w) << 16);
    *(uint4*)((bf16*)(p.ws + OFF_PKB) + e0) = pk;
    return;
  }
  item -= PREP_PK;
  {
    const int lw = item >> 6, r = item & 63;
    const int nt = r >> 5, kt = r & 31;
    tr_tile(p.cmp_w1 + (size_t)lw * 2048 * 128, 128, 2048, (bf16*)(p.ws + OFF_W1T) + (size_t)lw * 128 * 2048, kt, nt, false, sm);
  }
}

DEV void norm_item(const float* __restrict__ xin, const float* __restrict__ g, const float* __restrict__ sc,
                   const float* __restrict__ sh, bf16* __restrict__ hout, int item) {
  const int lane = tidx() & 63, wave = tidx() >> 6;
  const size_t tok = (size_t)item * 4 + wave;
  const int b = (int)(tok / S);
  const float* xr = xin + tok * 1024;
  float4 v[4];
  float ss = 0.f;
#pragma unroll
  for (int i = 0; i < 4; ++i) {
    v[i] = *(const float4*)(xr + i * 256 + lane * 4);
    ss += v[i].x * v[i].x + v[i].y * v[i].y + v[i].z * v[i].z + v[i].w * v[i].w;
  }
  ss = wave_sum(ss);
  float r = 1.0f / sqrtf(ss * (1.0f / 1024.f) + 1e-6f);
#pragma unroll
  for (int i = 0; i < 4; ++i) {
    int d = i * 256 + lane * 4;
    float4 gg = *(const float4*)(g + d);
    float4 s4 = *(const float4*)(sc + b * 6144 + d);
    float4 h4 = *(const float4*)(sh + b * 6144 + d);
    float o0 = v[i].x * r * gg.x * (1.f + s4.x) + h4.x;
    float o1 = v[i].y * r * gg.y * (1.f + s4.y) + h4.y;
    float o2 = v[i].z * r * gg.z * (1.f + s4.z) + h4.z;
    float o3 = v[i].w * r * gg.w * (1.f + s4.w) + h4.w;
    uint2 pk;
    pk.x = (unsigned)f2bf(o0) | ((unsigned)f2bf(o1) << 16);
    pk.y = (unsigned)f2bf(o2) | ((unsigned)f2bf(o3) << 16);
    *(uint2*)(hout + tok * 1024 + d) = pk;
  }
}
DEV void norm8_item(const float* __restrict__ xin, const float* __restrict__ g, const float* __restrict__ sc,
                    const float* __restrict__ sh, unsigned char* __restrict__ hout, unsigned char* __restrict__ hscale, int item) {
  const int lane = tidx() & 63, wave = tidx() >> 6;
  const size_t tok = (size_t)item * 4 + wave;
  const int b = (int)(tok / S);
  const float* xr = xin + tok * 1024;
  float4 v[4];
  float ss = 0.f;
#pragma unroll
  for (int i = 0; i < 4; ++i) {
    v[i] = *(const float4*)(xr + i * 256 + lane * 4);
    ss += v[i].x * v[i].x + v[i].y * v[i].y + v[i].z * v[i].z + v[i].w * v[i].w;
  }
  ss = wave_sum(ss);
  float r = 1.0f / sqrtf(ss * (1.0f / 1024.f) + 1e-6f);
  float mx = 0.f;
#pragma unroll
  for (int i = 0; i < 4; ++i) {
    int d = i * 256 + lane * 4;
    float4 gg = *(const float4*)(g + d);
    float4 s4 = *(const float4*)(sc + b * 6144 + d);
    float4 h4 = *(const float4*)(sh + b * 6144 + d);
    v[i].x = v[i].x * r * gg.x * (1.f + s4.x) + h4.x;
    v[i].y = v[i].y * r * gg.y * (1.f + s4.y) + h4.y;
    v[i].z = v[i].z * r * gg.z * (1.f + s4.z) + h4.z;
    v[i].w = v[i].w * r * gg.w * (1.f + s4.w) + h4.w;
    mx = fmaxf(mx, fmaxf(fmaxf(fabsf(v[i].x), fabsf(v[i].y)), fmaxf(fabsf(v[i].z), fabsf(v[i].w))));
  }
#pragma unroll
  for (int o = 32; o >= 1; o >>= 1) mx = fmaxf(mx, shx(mx, o));
  const unsigned e = e8m0_of(mx);
  const float s = e8m0_inv(e);
#pragma unroll
  for (int i = 0; i < 4; ++i)
    *(unsigned*)(hout + tok * 1024 + i * 256 + lane * 4) = pack4_fp8_(v[i].x * s, v[i].y * s, v[i].z * s, v[i].w * s);
  if (lane == 0) hscale[tok] = (unsigned char)e;
}
DEV void final_norm_item(float* __restrict__ x, const float* __restrict__ g, int item) {
  const int lane = tidx() & 63, wave = tidx() >> 6;
  const size_t tok = (size_t)item * 4 + wave;
  float* xr = x + tok * 1024;
  float4 v[4];
  float ss = 0.f;
#pragma unroll
  for (int i = 0; i < 4; ++i) {
    v[i] = *(const float4*)(xr + i * 256 + lane * 4);
    ss += v[i].x * v[i].x + v[i].y * v[i].y + v[i].z * v[i].z + v[i].w * v[i].w;
  }
  ss = wave_sum(ss);
  float r = 1.0f / sqrtf(ss * (1.0f / 1024.f) + 1e-6f);
#pragma unroll
  for (int i = 0; i < 4; ++i) {
    int d = i * 256 + lane * 4;
    float4 gg = *(const float4*)(g + d);
    float4 o;
    o.x = v[i].x * r * gg.x; o.y = v[i].y * r * gg.y; o.z = v[i].z * r * gg.z; o.w = v[i].w * r * gg.w;
    *(float4*)(xr + d) = o;
  }
}

#define GM_BUF (2 * 128 * 72)
#define GM_LOAD(R, kk)                                                                                  \
  {                                                                                                     \
    const bf16* Ak = Ap + (kk);                                                                         \
    const bf16* Wk = Wp + (kk);                                                                         \
    R##a0 = *(const uint4*)(Ak); R##a1 = *(const uint4*)(Ak + a32); R##a2 = *(const uint4*)(Ak + 2 * a32); \
    R##a3 = *(const uint4*)(Ak + 3 * a32);                                                              \
    R##b0 = *(const uint4*)(Wk); R##b1 = *(const uint4*)(Wk + w32); R##b2 = *(const uint4*)(Wk + 2 * w32); \
    R##b3 = *(const uint4*)(Wk + 3 * w32);                                                              \
  }
#define GM_STORE(R, buf)                                                                                \
  {                                                                                                     \
    bf16* as_ = Asw + (buf) * GM_BUF;                                                                   \
    bf16* bs_ = as_ + 128 * 72;                                                                         \
    *(uint4*)(as_) = R##a0; *(uint4*)(as_ + 32 * 72) = R##a1; *(uint4*)(as_ + 64 * 72) = R##a2; *(uint4*)(as_ + 96 * 72) = R##a3; \
    *(uint4*)(bs_) = R##b0; *(uint4*)(bs_ + 32 * 72) = R##b1; *(uint4*)(bs_ + 64 * 72) = R##b2; *(uint4*)(bs_ + 96 * 72) = R##b3; \
  }
#define GM_COMPUTE(buf)                                                                                 \
  {                                                                                                     \
    const bf16* As_ = sm + (buf) * GM_BUF;                                                              \
    const bf16* Bs_ = As_ + 128 * 72;                                                                   \
    _Pragma("unroll") for (int ks = 0; ks < 2; ++ks) {                                                  \
      __builtin_amdgcn_sched_barrier(0);                                                                \
      bf16x8 af[4], bfr[4];                                                                             \
      _Pragma("unroll") for (int mi = 0; mi < 4; ++mi)                                                  \
        af[mi] = *(const bf16x8*)(As_ + (wr * 64 + mi * 16 + (lane & 15)) * 72 + ks * 32 + (lane >> 4) * 8); \
      _Pragma("unroll") for (int ni = 0; ni < 4; ++ni)                                                  \
        bfr[ni] = *(const bf16x8*)(Bs_ + (wc * 64 + ni * 16 + (lane & 15)) * 72 + ks * 32 + (lane >> 4) * 8); \
      _Pragma("unroll") for (int mi = 0; mi < 4; ++mi)                                                  \
        _Pragma("unroll") for (int ni = 0; ni < 4; ++ni)                                                \
          acc[mi][ni] = __builtin_amdgcn_mfma_f32_16x16x32_bf16(af[mi], bfr[ni], acc[mi][ni], 0, 0, 0); \
    }                                                                                                   \
    __builtin_amdgcn_sched_barrier(0);                                                                  \
  }
DEV void gemm_mainloop(const bf16* __restrict__ A, int lda, const bf16* __restrict__ W, int K, int m0, int n0, bf16* sm,
                       f32x4 (&acc)[4][4]) {
  const int tid = tidx(), lane = tid & 63, wave = tid >> 6;
  const int wr = wave >> 1, wc = wave & 1;
  const int lrow = tid >> 3, lkc = (tid & 7) * 8;
  const bf16* Ap = A + (size_t)(m0 + lrow) * lda + lkc;
  const bf16* Wp = W + (size_t)(n0 + lrow) * K + lkc;
  const int a32 = 32 * lda, w32 = 32 * K;
  bf16* Asw = sm + lrow * 72 + lkc;
  uint4 xa0, xa1, xa2, xa3, xb0, xb1, xb2, xb3, ya0, ya1, ya2, ya3, yb0, yb1, yb2, yb3;
  const int nk = K >> 6;
  GM_LOAD(x, 0)
  GM_LOAD(y, 64)
  __syncthreads();
  GM_STORE(x, 0)
  if (nk > 2) GM_LOAD(x, 128)
  __syncthreads();
  for (int k = 0; k < nk; k += 2) {
    GM_COMPUTE(0)
    GM_STORE(y, 1)
    if (k + 3 < nk) GM_LOAD(y, (k + 3) * 64)
    __syncthreads();
    GM_COMPUTE(1)
    if (k + 2 < nk) {
      GM_STORE(x, 0)
      if (k + 4 < nk) GM_LOAD(x, (k + 4) * 64)
    }
    __syncthreads();
  }
}
DEV void gemm256_mainloop(const bf16* __restrict__ A, int lda, const bf16* __restrict__ W, int K, int m0, int n0, bf16* sm,
                          f32x4 (&acc)[2][4][4]) {
  bf16* As = sm;
  bf16* Bs = sm + 256 * 72;
  const int tid = tidx(), lane = tid & 63, wave = tid >> 6;
  const int wr = wave >> 1, wc = wave & 1;
  const int lrow = tid >> 3, lkc = (tid & 7) * 8;
  const bf16* Ap = A + (size_t)(m0 + lrow) * lda + lkc;
  const bf16* Wp = W + (size_t)(n0 + lrow) * K + lkc;
  const int a32 = 32 * lda, w32 = 32 * K;
  uint4 ra0, ra1, ra2, ra3, ra4, ra5, ra6, ra7, rb0, rb1, rb2, rb3;
#define G256_LOAD(kk)                                                                                   \
  {                                                                                                     \
    const bf16* Ak = Ap + (kk);                                                                         \
    const bf16* Wk = Wp + (kk);                                                                         \
    ra0 = *(const uint4*)(Ak); ra1 = *(const uint4*)(Ak + a32); ra2 = *(const uint4*)(Ak + 2 * a32);    \
    ra3 = *(const uint4*)(Ak + 3 * a32); ra4 = *(const uint4*)(Ak + 4 * a32); ra5 = *(const uint4*)(Ak + 5 * a32); \
    ra6 = *(const uint4*)(Ak + 6 * a32); ra7 = *(const uint4*)(Ak + 7 * a32);                           \
    rb0 = *(const uint4*)(Wk); rb1 = *(const uint4*)(Wk + w32); rb2 = *(const uint4*)(Wk + 2 * w32);    \
    rb3 = *(const uint4*)(Wk + 3 * w32);                                                                \
  }
  G256_LOAD(0)
  bf16* Asw = As + lrow * 72 + lkc;
  bf16* Bsw = Bs + lrow * 72 + lkc;
  for (int k0 = 0; k0 < K; k0 += 64) {
    __syncthreads();
    *(uint4*)(Asw) = ra0; *(uint4*)(Asw + 32 * 72) = ra1; *(uint4*)(Asw + 64 * 72) = ra2; *(uint4*)(Asw + 96 * 72) = ra3;
    *(uint4*)(Asw + 128 * 72) = ra4; *(uint4*)(Asw + 160 * 72) = ra5; *(uint4*)(Asw + 192 * 72) = ra6; *(uint4*)(Asw + 224 * 72) = ra7;
    *(uint4*)(Bsw) = rb0; *(uint4*)(Bsw + 32 * 72) = rb1; *(uint4*)(Bsw + 64 * 72) = rb2; *(uint4*)(Bsw + 96 * 72) = rb3;
    __syncthreads();
    if (k0 + 64 < K) G256_LOAD(k0 + 64)
#pragma unroll
    for (int ks = 0; ks < 2; ++ks) {
      bf16x8 bfr[4];
#pragma unroll
      for (int ni = 0; ni < 4; ++ni)
        bfr[ni] = *(const bf16x8*)(Bs + (wc * 64 + ni * 16 + (lane & 15)) * 72 + ks * 32 + (lane >> 4) * 8);
#pragma unroll
      for (int h = 0; h < 2; ++h) {
        __builtin_amdgcn_sched_barrier(0);
        bf16x8 af[4];
#pragma unroll
        for (int mi = 0; mi < 4; ++mi)
          af[mi] = *(const bf16x8*)(As + (wr * 128 + h * 64 + mi * 16 + (lane & 15)) * 72 + ks * 32 + (lane >> 4) * 8);
#pragma unroll
        for (int mi = 0; mi < 4; ++mi)
#pragma unroll
          for (int ni = 0; ni < 4; ++ni)
            acc[h][mi][ni] = __builtin_amdgcn_mfma_f32_16x16x32_bf16(af[mi], bfr[ni], acc[h][mi][ni], 0, 0, 0);
      }
    }
  }
}
DEV void acc_zero(f32x4 (&acc)[4][4]) {
#pragma unroll
  for (int i = 0; i < 4; ++i)
#pragma unroll
    for (int j = 0; j < 4; ++j) acc[i][j] = f32x4{0.f, 0.f, 0.f, 0.f};
}
DEV void store_tile_bf16(bf16* sm, const f32x4 (&acc)[4][4], bf16* __restrict__ dbase, size_t dstride) {
  const int tid = tidx(), lane = tid & 63, wave = tid >> 6, g4 = lane >> 4, c16 = lane & 15;
  bf16* Cw = sm + wave * (64 * 72);
  __syncthreads();
#pragma unroll
  for (int mi = 0; mi < 4; ++mi)
#pragma unroll
    for (int ni = 0; ni < 4; ++ni)
#pragma unroll
      for (int r = 0; r < 4; ++r) Cw[(mi * 16 + g4 * 4 + r) * 72 + ni * 16 + c16] = f2bf(acc[mi][ni][r]);
  __syncthreads();
#pragma unroll
  for (int it = 0; it < 8; ++it) {
    const int row_l = it * 8 + (lane >> 3), ch = lane & 7;
    const uint4 v = *(const uint4*)(Cw + row_l * 72 + ch * 8);
    *(uint4*)(dbase + (size_t)row_l * dstride + ch * 8) = v;
  }
}
template <class Epi>
DEV void gemm_tile(const bf16* __restrict__ A, int lda, const bf16* __restrict__ W, int K, int m0, int n0, bf16* sm,
                   Epi epi) {
  f32x4 acc[4][4];
  acc_zero(acc);
  gemm_mainloop(A, lda, W, K, m0, n0, sm, acc);
  const int tid = tidx(), lane = tid & 63, wave = tid >> 6;
  const int wr = wave >> 1, wc = wave & 1;
#pragma unroll
  for (int mi = 0; mi < 4; ++mi)
#pragma unroll
    for (int ni = 0; ni < 4; ++ni)
#pragma unroll
      for (int r = 0; r < 4; ++r) {
        int row = m0 + wr * 64 + mi * 16 + (lane >> 4) * 4 + r;
        int col = n0 + wc * 64 + ni * 16 + (lane & 15);
        epi(row, col, acc[mi][ni][r]);
      }
}
DEV void inproj_epilogue(const Params& p, f32x4 (&acc)[4][4], int row0, int vc0, bf16* sm) {
  const int tid = tidx(), lane = tid & 63, g4 = lane >> 4, c16 = lane & 15;
  const int b = row0 / S, t0 = row0 % S;
  bf16* dbase;
  size_t dstride;
  bool roped = false;
  bf16* projp = (bf16*)(p.ws + OFF_PROJ) + (size_t)row0 * PC;
  if (vc0 < 768) { dbase = projp + vc0; dstride = PC; }
  else if (vc0 < 1280) {
    const int seg = (vc0 - 768) >> 7, head = ((vc0 - 768) >> 6) & 1;
    const size_t off = (seg == 0) ? OFF_KSB : (seg == 1) ? OFF_VSB : (seg == 2) ? OFF_KWB : OFF_VWB;
    dbase = (bf16*)(p.ws + off) + ((size_t)(b * 2 + head) * S + t0) * 64;
    dstride = 64;
    roped = (seg == 0) || (seg == 2);
  } else if (vc0 < 1792) { dbase = projp + C_MQ + (vc0 - 1280); dstride = PC; roped = true; }
  else if (vc0 < 2816) {
    const int seg = (vc0 - 1792) >> 9, head = ((vc0 - 1792) >> 6) & 7;
    dbase = (bf16*)(p.ws + (seg ? OFF_MVB : OFF_MKB)) + ((size_t)(b * 8 + head) * S + t0) * 64;
    dstride = 64;
    roped = (seg == 0);
  } else if (vc0 < 4864) { dbase = projp + C_GN + (vc0 - 2816); dstride = PC; }
  else { dbase = projp + C_NG + (vc0 - 4864); dstride = PC; }
  if (roped) {
    const float* rope = (const float*)(p.ws + OFF_ROPE);
#pragma unroll
    for (int mi = 0; mi < 4; ++mi)
#pragma unroll
      for (int r = 0; r < 4; ++r) {
        const int pos = t0 + mi * 16 + g4 * 4 + r;
        const float v = acc[mi][0][r];
        const float pv = shx(v, 8);
        const float cs = rope[pos * 16 + (c16 & 7)], sn = rope[pos * 16 + 8 + (c16 & 7)];
        acc[mi][0][r] = (c16 < 8) ? (v * cs - pv * sn) : (v * cs + pv * sn);
      }
  }
  store_tile_bf16(sm, acc, dbase, dstride);
}
DEV void inproj_tile256(const Params& p, int layer, int m0, int n0, bf16* sm) {
  f32x4 acc[2][4][4];
  acc_zero(acc[0]);
  acc_zero(acc[1]);
  gemm256_mainloop((const bf16*)(p.ws + OFF_H), 1024, (const bf16*)(p.ws + OFF_WINT) + (size_t)layer * WN * 1024, 1024, m0, n0, sm, acc);
  const int wave = tidx() >> 6, wr = wave >> 1, wc = wave & 1;
  inproj_epilogue(p, acc[0], m0 + wr * 128, n0 + wc * 64, sm);
  inproj_epilogue(p, acc[1], m0 + wr * 128 + 64, n0 + wc * 64, sm);
}
typedef unsigned u32x2_t __attribute__((ext_vector_type(2)));
DEV void merge_tile(const Params& p, int layer, int m0, int n0, bf16* sm) {
  const int tid = tidx(), lane = tid & 63, wave = tid >> 6, g4 = lane >> 4, c16 = lane & 15;
  const int wr = wave >> 1, wc = wave & 1;
  const bf16* projg = (const bf16*)(p.ws + OFF_PROJ) + (size_t)(m0 + wr * 64 + g4 * 4) * PC + n0 + wc * 64 + c16;
  f32x4 acc[4][4];
  acc_zero(acc);
  gemm_mainloop((const bf16*)(p.ws + OFF_ONSA), 512, (const bf16*)(p.ws + OFF_WUPN) + (size_t)layer * 1024 * 512, 512, m0, n0, sm, acc);
  bf16* yg = (bf16*)(p.ws + OFF_H) + (size_t)(m0 + wr * 64 + g4 * 4) * 1024 + n0 + wc * 64 + c16;
#pragma unroll
  for (int mi = 0; mi < 4; ++mi)
#pragma unroll
    for (int ni = 0; ni < 4; ++ni)
#pragma unroll
      for (int r = 0; r < 4; ++r)
        yg[(size_t)(mi * 16 + r) * 1024 + ni * 16] =
            f2bf(sigmoidf_(bf2f(projg[(size_t)(mi * 16 + r) * PC + C_GN + ni * 16])) * acc[mi][ni][r]);
  acc_zero(acc);
  gemm_mainloop((const bf16*)(p.ws + OFF_OMOBA), 512, (const bf16*)(p.ws + OFF_WUPM) + (size_t)layer * 1024 * 512, 512, m0, n0, sm, acc);
#pragma unroll
  for (int mi = 0; mi < 4; ++mi)
#pragma unroll
    for (int ni = 0; ni < 4; ++ni)
#pragma unroll
      for (int r = 0; r < 4; ++r)
        acc[mi][ni][r] = bf2f(yg[(size_t)(mi * 16 + r) * 1024 + ni * 16]) +
                         sigmoidf_(bf2f(projg[(size_t)(mi * 16 + r) * PC + C_GM + ni * 16])) * acc[mi][ni][r];
  store_tile_bf16(sm, acc, (bf16*)(p.ws + OFF_H) + (size_t)(m0 + wr * 64) * 1024 + n0 + wc * 64, 1024);
}

DEV void merge_tile256(const Params& p, int layer, int m0, int n0, bf16* sm) {
  const int tid = tidx(), lane = tid & 63, wave = tid >> 6, g4 = lane >> 4, c16 = lane & 15;
  const int wr = wave >> 1, wc = wave & 1;
  f32x4 acc[2][4][4];
  acc_zero(acc[0]);
  acc_zero(acc[1]);
  gemm256_mainloop((const bf16*)(p.ws + OFF_ONSA), 512, (const bf16*)(p.ws + OFF_WUPN) + (size_t)layer * 1024 * 512, 512, m0, n0, sm, acc);
#pragma unroll
  for (int h = 0; h < 2; ++h) {
    const size_t rb = (size_t)(m0 + wr * 128 + h * 64 + g4 * 4);
    const bf16* projg = (const bf16*)(p.ws + OFF_PROJ) + rb * PC + n0 + wc * 64 + c16;
    bf16* yg = (bf16*)(p.ws + OFF_H) + rb * 1024 + n0 + wc * 64 + c16;
#pragma unroll
    for (int mi = 0; mi < 4; ++mi)
#pragma unroll
      for (int ni = 0; ni < 4; ++ni)
#pragma unroll
        for (int r = 0; r < 4; ++r)
          yg[(size_t)(mi * 16 + r) * 1024 + ni * 16] =
              f2bf(sigmoidf_(bf2f(projg[(size_t)(mi * 16 + r) * PC + C_GN + ni * 16])) * acc[h][mi][ni][r]);
  }
  acc_zero(acc[0]);
  acc_zero(acc[1]);
  gemm256_mainloop((const bf16*)(p.ws + OFF_OMOBA), 512, (const bf16*)(p.ws + OFF_WUPM) + (size_t)layer * 1024 * 512, 512, m0, n0, sm, acc);
#pragma unroll
  for (int h = 0; h < 2; ++h) {
    const size_t rb = (size_t)(m0 + wr * 128 + h * 64 + g4 * 4);
    const bf16* projg = (const bf16*)(p.ws + OFF_PROJ) + rb * PC + n0 + wc * 64 + c16;
    const bf16* yg = (const bf16*)(p.ws + OFF_H) + rb * 1024 + n0 + wc * 64 + c16;
#pragma unroll
    for (int mi = 0; mi < 4; ++mi)
#pragma unroll
      for (int ni = 0; ni < 4; ++ni)
#pragma unroll
        for (int r = 0; r < 4; ++r)
          acc[h][mi][ni][r] = bf2f(yg[(size_t)(mi * 16 + r) * 1024 + ni * 16]) +
                              sigmoidf_(bf2f(projg[(size_t)(mi * 16 + r) * PC + C_GM + ni * 16])) * acc[h][mi][ni][r];
    store_tile_bf16(sm, acc[h], (bf16*)(p.ws + OFF_H) + (size_t)(m0 + wr * 128 + h * 64) * 1024 + n0 + wc * 64, 1024);
  }
}

DEV void compress_item(const Params& p, int layer, int item, float* sm) {
  const int tid = tidx();
  const int grp = item & 127, which = (item >> 7) & 1, kvh = (item >> 8) & 1, b = item >> 9;
  const int c0 = grp * 8;
  float* xs = sm;
  float* hs = sm + 144 * 64;
  const bf16* proj = (const bf16*)(p.ws + OFF_PROJ);
  const int col = (which ? C_VC : C_KC) + kvh * 64;
  for (int i = tid; i < 144 * 64; i += 256) {
    int tl = i >> 6, d = i & 63;
    int t = c0 * 16 + tl;
    xs[i] = (t < S) ? bf2f(proj[((size_t)b * S + t) * PC + col + d]) : 0.f;
  }
  __syncthreads();
  const int lw = layer * 2 + which;
  if (tid < 128) {
    const float* w1 = p.cmp_w1 + (size_t)lw * 2048 * 128 + tid;
    float acc[8];
#pragma unroll
    for (int ci = 0; ci < 8; ++ci) acc[ci] = 0.f;
    for (int l = 0; l < 32; ++l) {
#pragma unroll 4
      for (int d = 0; d < 64; ++d) {
        float w = w1[(size_t)(l * 64 + d) * 128];
#pragma unroll
        for (int ci = 0; ci < 8; ++ci) acc[ci] += xs[(ci * 16 + l) * 64 + d] * w;
      }
    }
    float pb = ((const float*)(p.ws + OFF_PEB))[lw * 128 + tid];
#pragma unroll
    for (int ci = 0; ci < 8; ++ci) hs[ci * 128 + tid] = gelu_tanh(acc[ci] + pb);
  }
  __syncthreads();
  const float* w2 = p.cmp_w2 + (size_t)lw * 128 * 64;
  float* outp = PROBE_CMPR ? ((float*)(p.ws + OFF_CMP) + (which ? (size_t)Bn * 1024 * 128 : 0)) : (float*)(p.ws + (which ? OFF_VCC : OFF_KCC));
#pragma unroll
  for (int rr = 0; rr < 2; ++rr) {
    int o = rr * 256 + tid;
    int ci = o >> 6, d = o & 63;
    int c = c0 + ci;
    float a = 0.f;
    for (int j = 0; j < 128; ++j) a += hs[ci * 128 + j] * w2[j * 64 + d];
    if (c < 1023) outp[(((size_t)b * 1024 + c) * 2 + kvh) * 64 + d] = a;
    bf16* outb = (bf16*)(p.ws + (which ? OFF_VCB : OFF_KCB));
    if (!PROBE_CMPR && c < 1024) outb[(((size_t)b * 2 + kvh) * 1024 + c) * 64 + d] = (c < 1023) ? f2bf(a) : (bf16)0;
  }
  __syncthreads();
}

DEV void compress_mfma_item(const Params& p, int layer, int item, char* smem) {
  bf16* xs = (bf16*)smem;
  float* hs = (float*)(smem + 272 * 64 * 2);
  const int tid = tidx(), lane = tid & 63, wave = tid >> 6, g4 = lane >> 4, c16 = lane & 15;
  const int cblk = item & 63, which = (item >> 6) & 1, kvh = (item >> 7) & 1, b = item >> 8;
  const int t0 = cblk * 256;
  const bf16* proj = (const bf16*)(p.ws + OFF_PROJ) + (size_t)b * S * PC + (which ? C_VC : C_KC) + kvh * 64;
  __syncthreads();
  for (int i = tid; i < 272 * 8; i += 256) {
    const int tl = i >> 3, ch = i & 7;
    const int t = t0 + tl;
    uint4 v = uint4{0u, 0u, 0u, 0u};
    if (t < S) v = *(const uint4*)(proj + (size_t)t * PC + ch * 8);
    *(uint4*)(xs + tl * 64 + ((ch ^ ((tl >> 4) & 7)) * 8)) = v;
  }
  __syncthreads();
  const int lw = layer * 2 + which;
  const bf16* w1t = (const bf16*)(p.ws + OFF_W1T) + (size_t)lw * 128 * 2048;
  f32x4 acc0 = f32x4{0.f, 0.f, 0.f, 0.f}, acc1 = f32x4{0.f, 0.f, 0.f, 0.f};
  const bf16* wb0 = w1t + (size_t)((2 * wave) * 16 + c16) * 2048 + g4 * 8;
  const bf16* wb1 = w1t + (size_t)((2 * wave + 1) * 16 + c16) * 2048 + g4 * 8;
#pragma unroll 4
  for (int ks = 0; ks < 64; ++ks) {
    const int l = ks >> 1, ch = (ks & 1) * 4 + g4;
    const int tl = 16 * c16 + l;
    const bf16x8 af = *(const bf16x8*)(xs + tl * 64 + ((ch ^ ((tl >> 4) & 7)) * 8));
    const bf16x8 b0 = *(const bf16x8*)(wb0 + ks * 32);
    const bf16x8 b1 = *(const bf16x8*)(wb1 + ks * 32);
    acc0 = MFMA16B(af, b0, acc0);
    acc1 = MFMA16B(af, b1, acc1);
  }
  {
    const float* peb = (const float*)(p.ws + OFF_PEB) + lw * 128;
    const int j0 = (2 * wave) * 16 + c16, j1 = j0 + 16;
    const float pb0 = peb[j0], pb1 = peb[j1];
#pragma unroll
    for (int r = 0; r < 4; ++r) {
      hs[(g4 * 4 + r) * 128 + j0] = gelu_tanh(acc0[r] + pb0);
      hs[(g4 * 4 + r) * 128 + j1] = gelu_tanh(acc1[r] + pb1);
    }
  }
  __syncthreads();
  const float* w2 = p.cmp_w2 + (size_t)lw * 128 * 64;
  const int d = tid & 63, cq = tid >> 6;
  float o0 = 0.f, o1 = 0.f, o2 = 0.f, o3 = 0.f;
#pragma unroll 8
  for (int j = 0; j < 128; ++j) {
    const float w = w2[j * 64 + d];
    o0 += hs[(cq * 4 + 0) * 128 + j] * w;
    o1 += hs[(cq * 4 + 1) * 128 + j] * w;
    o2 += hs[(cq * 4 + 2) * 128 + j] * w;
    o3 += hs[(cq * 4 + 3) * 128 + j] * w;
  }
  float* outp = (float*)(p.ws + (which ? OFF_VCC : OFF_KCC));
  bf16* outb = (bf16*)(p.ws + (which ? OFF_VCB : OFF_KCB));
  const float ov[4] = {o0, o1, o2, o3};
#pragma unroll
  for (int i = 0; i < 4; ++i) {
    const int c = cblk * 16 + cq * 4 + i;
    if (c < 1023) outp[(((size_t)b * 1024 + c) * 2 + kvh) * 64 + d] = ov[i];
    outb[(((size_t)b * 2 + kvh) * 1024 + c) * 64 + d] = (c < 1023) ? f2bf(ov[i]) : (bf16)0;
  }
  __syncthreads();
}

DEV void n1_item(const Params& p, int layer, int item, float* sm) {
  const int chunk = item & 255, kvh = (item >> 8) & 1, b = item >> 9;
  const int tid = tidx(), ql = tid >> 2, g = tid & 3;
  const int t = chunk * 64 + ql, h = kvh * 4 + g;
  const size_t tok = (size_t)b * S + t;
  const bf16* proj = (const bf16*)(p.ws + OFF_PROJ);
  float* imp = sm;
  for (int i = tid; i < 64 * 257; i += 256) imp[i] = 0.f;
  float q[64];
  load_q64(q, proj + tok * PC + C_NQ + h * 64, 0.125f);
  const int nv = (t >= 31) ? (((t - 31) >> 4) + 1) : 0;
  const int nv_max = (((chunk * 64 + 63) - 31) >> 4) + 1;
  const float* kc = (const float*)(p.ws + OFF_KCC) + (size_t)b * 1024 * 128 + kvh * 64;
  const float* vc = (const float*)(p.ws + OFF_VCC) + (size_t)b * 1024 * 128 + kvh * 64;
  float m = -INFINITY, l = 0.f;
  for (int c = 0; c < nv_max; ++c) {
    float s = dot64_f(q, kc + (size_t)c * 128);
    if (c < nv) {
      float mn = fmaxf(m, s);
      l = l * expf(m - mn) + expf(s - mn);
      m = mn;
    }
  }
  __syncthreads();
  float o[64];
#pragma unroll
  for (int d = 0; d < 64; ++d) o[d] = 0.f;
  const float inv_l = (nv > 0) ? 1.f / l : 0.f;
  for (int c = 0; c < nv_max; ++c) {
    float s = dot64_f(q, kc + (size_t)c * 128);
    float pr = (c < nv) ? expf(s - m) * inv_l : 0.f;
    axpy64_f(o, pr, vc + (size_t)c * 128);
    float ps = pr;
    ps += shx(ps, 1);
    ps += shx(ps, 2);
    if (g == 0) {
      int n = c >> 2;
      if ((c & 3) == 3) {
        imp[ql * 257 + n] += 0.5f * ps;
        imp[ql * 257 + n + 1] += 0.5f * ps;
      } else {
        imp[ql * 257 + n] += ps;
      }
    }
  }
  const float gate0 = (!PROBE_NSA || (PROBE_NSA & 1)) ? sigmoidf_(bf2f(proj[tok * PC + C_NG + h * 3 + 0])) : 0.f;
  float* oa = (float*)(p.ws + OFF_H) + tok * 512 + h * 64;
#pragma unroll
  for (int d = 0; d < 64; d += 4) {
    float4 v = {gate0 * o[d], gate0 * o[d + 1], gate0 * o[d + 2], gate0 * o[d + 3]};
    *(float4*)(oa + d) = v;
  }
  __syncthreads();
#if PROBE_NSA == 8
  if (b == 0 && kvh == 0)
    for (int i = tid; i < 64 * 256; i += 256)
      ((float*)(p.ws + OFF_OMOBA))[(size_t)(chunk * 64 + (i >> 8)) * 256 + (i & 255)] = imp[(i >> 8) * 257 + (i & 255)];
  __syncthreads();
#endif
  if (g == 0) {
    int* selp = (int*)(p.ws + OFF_SEL) + (((size_t)b * 2 + kvh) * S + t) * 16;
    const int cur = chunk;
    if (cur < 16) {
      for (int j = 0; j < 16; ++j) selp[j] = (j <= cur) ? j : -1;
    } else {
      selp[0] = 0;
      selp[1] = cur - 1;
      selp[2] = cur;
      float* row = imp + ql * 257;
      for (int j = 3; j < 16; ++j) {
        float best = -1.f;
        int bi = 1;
        for (int n = 1; n <= cur - 2; ++n) {
          float v = row[n];
          if (v > best) { best = v; bi = n; }
        }
        selp[j] = bi;
        row[bi] = -2.f;
      }
    }
  }
  __syncthreads();
}

DEV void kmean_item(const Params& p, int item, float* sm) {
  const int n = item & 63, h = (item >> 6) & 7, b = item >> 9;
  const int tid = tidx(), d = tid & 63, part = tid >> 6;
  const bf16* mkb = (const bf16*)(p.ws + OFF_MKB);
  float a = 0.f;
  for (int i = 0; i < 64; ++i) {
    int t = n * 256 + part * 64 + i;
    a += bf2f(mkb[((size_t)(b * 8 + h) * S + t) * 64 + d]);
  }
  sm[tid] = a;
  __syncthreads();
  if (tid < 64) {
    float s = sm[tid] + sm[64 + tid] + sm[128 + tid] + sm[192 + tid];
    const size_t ko = (((size_t)b * 8 + h) * 64 + n) * 64 + tid;
    const float mean = s * (1.f / 256.f);
    ((float*)(p.ws + OFF_KMEAN))[ko] = mean;
    const bf16 hi = f2bf(mean);
    ((bf16*)(p.ws + OFF_KMHL))[ko] = hi;
    ((bf16*)(p.ws + OFF_KMHL))[(size_t)2 * 8 * 64 * 64 + ko] = f2bf(mean - bf2f(hi));
    if (tid == 0) ((int*)(p.ws + OFF_MCNT))[(b * 8 + h) * 64 + n] = 0;
  }
  __syncthreads();
}

DEV void n23_item(const Params& p, int layer, int item) {
  const int chunk = item & 255, kvh = (item >> 8) & 1, b = item >> 9;
  const int tid = tidx(), ql = tid >> 2, g = tid & 3;
  const int t = chunk * 64 + ql, h = kvh * 4 + g;
  const size_t tok = (size_t)b * S + t;
  const bf16* proj = (const bf16*)(p.ws + OFF_PROJ);
  const float* rope = (const float*)(p.ws + OFF_ROPE) + (size_t)t * 16;
  float q[64];
  load_q64(q, proj + tok * PC + C_NQ + h * 64, 1.0f);
#pragma unroll
  for (int i = 0; i < 8; ++i) {
    float cs = rope[i], sn = rope[8 + i];
    float x1 = q[i], x2 = q[8 + i];
    q[i] = x1 * cs - x2 * sn;
    q[8 + i] = x2 * cs + x1 * sn;
  }
#pragma unroll
  for (int i = 0; i < 64; ++i) q[i] *= 0.125f;
  const size_t kvo = ((size_t)(b * 2 + kvh) * S) * 64;
  const bf16* ksb = (const bf16*)(p.ws + OFF_KSB) + kvo;
  const bf16* vsb = (const bf16*)(p.ws + OFF_VSB) + kvo;
  const bf16* kwb = (const bf16*)(p.ws + OFF_KWB) + kvo;
  const bf16* vwb = (const bf16*)(p.ws + OFF_VWB) + kvo;
  const int* selp = (const int*)(p.ws + OFF_SEL) + (((size_t)b * 2 + kvh) * S + t) * 16;
  float* oa = (float*)(p.ws + OFF_H) + tok * 512 + h * 64;
  const float gate1 = (!PROBE_NSA || (PROBE_NSA & 2)) ? sigmoidf_(bf2f(proj[tok * PC + C_NG + h * 3 + 1])) : 0.f;
  const float gate2 = (!PROBE_NSA || (PROBE_NSA & 4)) ? sigmoidf_(bf2f(proj[tok * PC + C_NG + h * 3 + 2])) : 0.f;
  float o[64];
  {
    float m = -INFINITY;
    for (int j = 0; j < 16; ++j) {
      int n = selp[j];
      if (n >= 0) {
        for (int i = 0; i < 64; ++i) {
          int kpos = n * 64 + i;
          if (kpos <= t) {
            float s = dot64_bf(q, ksb + (size_t)kpos * 64);
            m = fmaxf(m, s);
          }
        }
      }
    }
    float l = 0.f;
#pragma unroll
    for (int d = 0; d < 64; ++d) o[d] = 0.f;
    for (int j = 0; j < 16; ++j) {
      int n = selp[j];
      if (n >= 0) {
        for (int i = 0; i < 64; ++i) {
          int kpos = n * 64 + i;
          if (kpos <= t) {
            float s = dot64_bf(q, ksb + (size_t)kpos * 64);
            float pr = expf(s - m);
            l += pr;
            axpy64_bf(o, pr, vsb + (size_t)kpos * 64);
          }
        }
      }
    }
    float sc = gate1 / l;
#pragma unroll
    for (int d = 0; d < 64; d += 4) {
      float4 v = *(float4*)(oa + d);
      v.x += sc * o[d]; v.y += sc * o[d + 1]; v.z += sc * o[d + 2]; v.w += sc * o[d + 3];
      *(float4*)(oa + d) = v;
    }
  }
  {
    const int s0 = chunk * 64;
    const int jlo = (s0 - 511 > 0) ? (s0 - 511) : 0;
    const int jhi = s0 + 63;
    float m = -INFINITY;
    for (int j = jlo; j <= jhi; ++j) {
      float s = dot64_bf(q, kwb + (size_t)j * 64);
      if (j <= t && j > t - 512) m = fmaxf(m, s);
    }
    float l = 0.f;
#pragma unroll
    for (int d = 0; d < 64; ++d) o[d] = 0.f;
    for (int j = jlo; j <= jhi; ++j) {
      float s = dot64_bf(q, kwb + (size_t)j * 64);
      float pr = (j <= t && j > t - 512) ? expf(s - m) : 0.f;
      l += pr;
      axpy64_bf(o, pr, vwb + (size_t)j * 64);
    }
    float sc = gate2 / l;
    bf16* ob = (bf16*)(p.ws + (PROBE_NSA ? OFF_CMP : OFF_ONSA)) + tok * 512 + h * 64;
#pragma unroll
    for (int d = 0; d < 64; d += 8) {
      float4 v0 = *(float4*)(oa + d);
      float4 v1 = *(float4*)(oa + d + 4);
      uint4 pk;
      pk.x = (unsigned)f2bf(v0.x + sc * o[d]) | ((unsigned)f2bf(v0.y + sc * o[d + 1]) << 16);
      pk.y = (unsigned)f2bf(v0.z + sc * o[d + 2]) | ((unsigned)f2bf(v0.w + sc * o[d + 3]) << 16);
      pk.z = (unsigned)f2bf(v1.x + sc * o[d + 4]) | ((unsigned)f2bf(v1.y + sc * o[d + 5]) << 16);
      pk.w = (unsigned)f2bf(v1.z + sc * o[d + 6]) | ((unsigned)f2bf(v1.w + sc * o[d + 7]) << 16);
      *(uint4*)(ob + d) = pk;
    }
  }
}

DEV void moba_item(const Params& p, int layer, int item) {
  const int blk = item & 63, h = (item >> 6) & 7, b = item >> 9;
  const int tid = tidx();
  const int t = blk * 256 + tid;
  const size_t tok = (size_t)b * S + t;
  const bf16* proj = (const bf16*)(p.ws + OFF_PROJ);
  float q[64];
  load_q64(q, proj + tok * PC + C_MQ + h * 64, 0.125f);
  const float* km = (const float*)(p.ws + OFF_KMEAN) + ((size_t)b * 8 + h) * 64 * 64;
  float b0 = -INFINITY, b1 = -INFINITY, b2 = -INFINITY;
  int i0 = -1, i1 = -1, i2 = -1;
  for (int n = 0; n < blk; ++n) {
    float v = dot64_f(q, km + n * 64);
    if (v > b0) { b2 = b1; i2 = i1; b1 = b0; i1 = i0; b0 = v; i0 = n; }
    else if (v > b1) { b2 = b1; i2 = i1; b1 = v; i1 = n; }
    else if (v > b2) { b2 = v; i2 = n; }
  }
  const bf16* mkb = (const bf16*)(p.ws + OFF_MKB) + ((size_t)(b * 8 + h) * S) * 64;
  const bf16* mvb = (const bf16*)(p.ws + OFF_MVB) + ((size_t)(b * 8 + h) * S) * 64;
  float m = -INFINITY;
  for (int sidx = 0; sidx < 3; ++sidx) {
    int n = (sidx == 0) ? i0 : (sidx == 1) ? i1 : i2;
    if (sidx < blk) {
      for (int i = 0; i < 256; ++i) {
        float s = dot64_bf(q, mkb + (size_t)(n * 256 + i) * 64);
        m = fmaxf(m, s);
      }
    }
  }
  for (int i = 0; i < 256; ++i) {
    int kpos = blk * 256 + i;
    float s = dot64_bf(q, mkb + (size_t)kpos * 64);
    if (kpos <= t) m = fmaxf(m, s);
  }
  float l = 0.f;
  float o[64];
#pragma unroll
  for (int d = 0; d < 64; ++d) o[d] = 0.f;
  for (int sidx = 0; sidx < 3; ++sidx) {
    int n = (sidx == 0) ? i0 : (sidx == 1) ? i1 : i2;
    if (sidx < blk) {
      for (int i = 0; i < 256; ++i) {
        const size_t ko = (size_t)(n * 256 + i) * 64;
        float s = dot64_bf(q, mkb + ko);
        float pr = expf(s - m);
        l += pr;
        axpy64_bf(o, pr, mvb + ko);
      }
    }
  }
  for (int i = 0; i < 256; ++i) {
    int kpos = blk * 256 + i;
    const size_t ko = (size_t)kpos * 64;
    float s = dot64_bf(q, mkb + ko);
    float pr = (kpos <= t) ? expf(s - m) : 0.f;
    l += pr;
    axpy64_bf(o, pr, mvb + ko);
  }
  const float il = 1.f / l;
  bf16* ob = (bf16*)(p.ws + (PROBE_MOBA ? OFF_CMP : OFF_OMOBA)) + tok * 512 + h * 64;
#pragma unroll
  for (int d = 0; d < 64; d += 8) {
    uint4 pk;
    pk.x = (unsigned)f2bf(o[d] * il) | ((unsigned)f2bf(o[d + 1] * il) << 16);
    pk.y = (unsigned)f2bf(o[d + 2] * il) | ((unsigned)f2bf(o[d + 3] * il) << 16);
    pk.z = (unsigned)f2bf(o[d + 4] * il) | ((unsigned)f2bf(o[d + 5] * il) << 16);
    pk.w = (unsigned)f2bf(o[d + 6] * il) | ((unsigned)f2bf(o[d + 7] * il) << 16);
    *(uint4*)(ob + d) = pk;
  }
}

typedef short v4i16_t __attribute__((ext_vector_type(4)));
typedef unsigned u32x4_t __attribute__((ext_vector_type(4)));
DEV v4i16_t lds_tr16(const bf16* p) {
  return __builtin_amdgcn_ds_read_tr16_b64_v4i16((__attribute__((address_space(3))) v4i16_t*)p);
}
DEV unsigned cvtpk(float lo, float hi) {
  unsigned r;
  asm("v_cvt_pk_bf16_f32 %0, %1, %2" : "=v"(r) : "v"(lo), "v"(hi));
  return r;
}
#define MFMA16(a, b, c) __builtin_amdgcn_mfma_f32_16x16x32_bf16(a, b, c, 0, 0, 0)
constexpr float C2 = 0.125f * 1.4426950408889634f;
constexpr int KT_LD = 72;
constexpr int KT_ELEMS = 64 * KT_LD;

template <int NI>
struct AttnSt {
  f32x4 o[4][NI];
  float m[NI], l[NI];
};
template <int NI>
DEV void attn_init(AttnSt<NI>& st) {
#pragma unroll
  for (int ni = 0; ni < NI; ++ni) {
    st.m[ni] = -INFINITY;
    st.l[ni] = 0.f;
#pragma unroll
    for (int di = 0; di < 4; ++di) st.o[di][ni] = f32x4{0.f, 0.f, 0.f, 0.f};
  }
}
#define TILE_DECL uint4 tl_k0, tl_k1, tl_v0, tl_v1
#define TILE_GLOAD(kb, vb, ld, key0)                                                        \
  do {                                                                                      \
    const int r_ = tidx() >> 3, c_ = (tidx() & 7) * 8;                            \
    tl_k0 = *(const uint4*)((kb) + (size_t)((key0) + r_) * (ld) + c_);                      \
    tl_k1 = *(const uint4*)((kb) + (size_t)((key0) + 32 + r_) * (ld) + c_);                 \
    tl_v0 = *(const uint4*)((vb) + (size_t)((key0) + r_) * (ld) + c_);                      \
    tl_v1 = *(const uint4*)((vb) + (size_t)((key0) + 32 + r_) * (ld) + c_);                 \
  } while (0)
#define TILE_SSTORE(Ks_, Vs_)                                                               \
  do {                                                                                      \
    const int r_ = tidx() >> 3, c_ = (tidx() & 7) * 8;                            \
    *(uint4*)((Ks_) + r_ * KT_LD + c_) = tl_k0;                                             \
    *(uint4*)((Ks_) + (32 + r_) * KT_LD + c_) = tl_k1;                                      \
    *(uint4*)((Vs_) + r_ * KT_LD + c_) = tl_v0;                                             \
    *(uint4*)((Vs_) + (32 + r_) * KT_LD + c_) = tl_v1;                                      \
  } while (0)
#define TL_GLOAD(P, kb, vb, ld, key0)                                                       \
  do {                                                                                      \
    const int r_ = tidx() >> 3, c_ = (tidx() & 7) * 8;                                      \
    P##_k0 = *(const uint4*)((kb) + (size_t)((key0) + r_) * (ld) + c_);                     \
    P##_k1 = *(const uint4*)((kb) + (size_t)((key0) + 32 + r_) * (ld) + c_);                \
    P##_v0 = *(const uint4*)((vb) + (size_t)((key0) + r_) * (ld) + c_);                     \
    P##_v1 = *(const uint4*)((vb) + (size_t)((key0) + 32 + r_) * (ld) + c_);                \
  } while (0)
#define TL_SSTORE(P, Ks_, Vs_)                                                              \
  do {                                                                                      \
    const int r_ = tidx() >> 3, c_ = (tidx() & 7) * 8;                                      \
    *(uint4*)((Ks_) + r_ * KT_LD + c_) = P##_k0;                                            \
    *(uint4*)((Ks_) + (32 + r_) * KT_LD + c_) = P##_k1;                                     \
    *(uint4*)((Vs_) + r_ * KT_LD + c_) = P##_v0;                                            \
    *(uint4*)((Vs_) + (32 + r_) * KT_LD + c_) = P##_v1;                                     \
  } while (0)
#define KV_SWEEP(kb_, vb_, ld_, nt_, KEYF, ...)                                             \
  {                                                                                         \
    uint4 tA_k0, tA_k1, tA_v0, tA_v1, tB_k0, tB_k1, tB_v0, tB_v1;                           \
    const int nt__ = (nt_);                                                                 \
    if (nt__ > 0) {                                                                         \
      TL_GLOAD(tA, kb_, vb_, ld_, KEYF(0));                                                 \
      TL_SSTORE(tA, smkv, smkv + KT_ELEMS);                                                 \
      if (nt__ > 1) TL_GLOAD(tA, kb_, vb_, ld_, KEYF(1));                                   \
    }                                                                                       \
    __syncthreads();                                                                        \
    for (int it0__ = 0; it0__ < nt__; it0__ += 2) {                                         \
      {                                                                                     \
        const int it = it0__;                                                               \
        if (it + 2 < nt__) TL_GLOAD(tB, kb_, vb_, ld_, KEYF(it + 2));                       \
        const bf16* Ks = smkv;                                                              \
        __VA_ARGS__                                                                         \
        if (it + 1 < nt__) TL_SSTORE(tA, smkv + 2 * KT_ELEMS, smkv + 3 * KT_ELEMS);         \
        __syncthreads();                                                                    \
      }                                                                                     \
      if (it0__ + 1 < nt__) {                                                               \
        const int it = it0__ + 1;                                                           \
        if (it + 2 < nt__) TL_GLOAD(tA, kb_, vb_, ld_, KEYF(it + 2));                       \
        const bf16* Ks = smkv + 2 * KT_ELEMS;                                               \
        __VA_ARGS__                                                                         \
        if (it + 1 < nt__) TL_SSTORE(tB, smkv, smkv + KT_ELEMS);                            \
        __syncthreads();                                                                    \
      }                                                                                     \
    }                                                                                       \
  }
template <int NI>
DEV void attn_scores(const bf16* Ks, const bf16x8 (&qf)[NI][2], f32x4 (&s)[4][NI]) {
  const int lane = tidx() & 63, g4 = lane >> 4, c16 = lane & 15;
#pragma unroll
  for (int mi = 0; mi < 4; ++mi) {
#pragma unroll
    for (int ni = 0; ni < NI; ++ni) s[mi][ni] = f32x4{0.f, 0.f, 0.f, 0.f};
#pragma unroll
    for (int ks = 0; ks < 2; ++ks) {
      bf16x8 kf = *(const bf16x8*)(Ks + (mi * 16 + c16) * KT_LD + ks * 32 + g4 * 8);
#pragma unroll
      for (int ni = 0; ni < NI; ++ni) s[mi][ni] = MFMA16(kf, qf[ni][ks], s[mi][ni]);
    }
  }
}
template <int NI>
DEV void attn_pv(const bf16* Vs, const bf16x8 (&pf)[NI][2], f32x4 (&o)[4][NI]) {
  const int lane = tidx() & 63, g4 = lane >> 4, q4 = (lane & 15) >> 2, p4 = lane & 3;
#pragma unroll
  for (int di = 0; di < 4; ++di) {
#pragma unroll
    for (int ks2 = 0; ks2 < 2; ++ks2) {
      v4i16_t v0 = lds_tr16(Vs + (ks2 * 32 + g4 * 4 + q4) * KT_LD + di * 16 + p4 * 4);
      v4i16_t v1 = lds_tr16(Vs + (ks2 * 32 + 16 + g4 * 4 + q4) * KT_LD + di * 16 + p4 * 4);
      bf16x8 vf = __builtin_shufflevector(v0, v1, 0, 1, 2, 3, 4, 5, 6, 7);
#pragma unroll
      for (int ni = 0; ni < NI; ++ni) o[di][ni] = MFMA16(vf, pf[ni][ks2], o[di][ni]);
    }
  }
}
DEV void exp4_pack(const f32x4& sv, float nm, float& ps, unsigned& w0, unsigned& w1) {
  float p0 = __builtin_amdgcn_exp2f(__builtin_fmaf(sv[0], C2, nm));
  float p1 = __builtin_amdgcn_exp2f(__builtin_fmaf(sv[1], C2, nm));
  float p2 = __builtin_amdgcn_exp2f(__builtin_fmaf(sv[2], C2, nm));
  float p3 = __builtin_amdgcn_exp2f(__builtin_fmaf(sv[3], C2, nm));
  ps += (p0 + p1) + (p2 + p3);
  w0 = cvtpk(p0, p1);
  w1 = cvtpk(p2, p3);
}
template <int NI>
DEV void attn_softmax_pv(const bf16* Vs, f32x4 (&s)[4][NI], AttnSt<NI>& st) {
  bf16x8 pf[NI][2];
#pragma unroll
  for (int ni = 0; ni < NI; ++ni) {
    float mx = -INFINITY;
#pragma unroll
    for (int mi = 0; mi < 4; ++mi)
      mx = fmaxf(fmaxf(mx, fmaxf(s[mi][ni][0], s[mi][ni][1])), fmaxf(s[mi][ni][2], s[mi][ni][3]));
    mx = fmaxf(mx, shx(mx, 16));
    mx = fmaxf(mx, shx(mx, 32));
    const float mn = fmaxf(st.m[ni], mx);
    const float mu = (mn == -INFINITY) ? 0.f : mn;
    const float corr = __builtin_amdgcn_exp2f((st.m[ni] - mu) * C2);
    st.m[ni] = mn;
    const float nm = -mu * C2;
    float ps = 0.f;
    u32x4_t wa, wb;
    unsigned t0, t1;
    exp4_pack(s[0][ni], nm, ps, t0, t1); wa.x = t0; wa.y = t1;
    exp4_pack(s[1][ni], nm, ps, t0, t1); wa.z = t0; wa.w = t1;
    exp4_pack(s[2][ni], nm, ps, t0, t1); wb.x = t0; wb.y = t1;
    exp4_pack(s[3][ni], nm, ps, t0, t1); wb.z = t0; wb.w = t1;
    st.l[ni] = st.l[ni] * corr + ps;
#pragma unroll
    for (int di = 0; di < 4; ++di) {
      st.o[di][ni][0] *= corr; st.o[di][ni][1] *= corr; st.o[di][ni][2] *= corr; st.o[di][ni][3] *= corr;
    }
    pf[ni][0] = __builtin_bit_cast(bf16x8, wa);
    pf[ni][1] = __builtin_bit_cast(bf16x8, wb);
  }
  attn_pv<NI>(Vs, pf, st.o);
}

template <int NI>
DEV void attn_softmax_pv_act(const bf16* Vs, f32x4 (&s)[4][NI], AttnSt<NI>& st, const bool (&act)[NI]) {
  bf16x8 pf[NI][2];
#pragma unroll
  for (int ni = 0; ni < NI; ++ni) {
    pf[ni][0] = bf16x8{0, 0, 0, 0, 0, 0, 0, 0};
    pf[ni][1] = bf16x8{0, 0, 0, 0, 0, 0, 0, 0};
    if (act[ni]) {
      float mx = -INFINITY;
#pragma unroll
      for (int mi = 0; mi < 4; ++mi)
        mx = fmaxf(fmaxf(mx, fmaxf(s[mi][ni][0], s[mi][ni][1])), fmaxf(s[mi][ni][2], s[mi][ni][3]));
      mx = fmaxf(mx, shx(mx, 16));
      mx = fmaxf(mx, shx(mx, 32));
      const float mn = fmaxf(st.m[ni], mx);
      const float mu = (mn == -INFINITY) ? 0.f : mn;
      const float corr = __builtin_amdgcn_exp2f((st.m[ni] - mu) * C2);
      st.m[ni] = mn;
      const float nm = -mu * C2;
      float ps = 0.f;
      u32x4_t wa, wb;
      unsigned t0, t1;
      exp4_pack(s[0][ni], nm, ps, t0, t1); wa.x = t0; wa.y = t1;
      exp4_pack(s[1][ni], nm, ps, t0, t1); wa.z = t0; wa.w = t1;
      exp4_pack(s[2][ni], nm, ps, t0, t1); wb.x = t0; wb.y = t1;
      exp4_pack(s[3][ni], nm, ps, t0, t1); wb.z = t0; wb.w = t1;
      st.l[ni] = st.l[ni] * corr + ps;
#pragma unroll
      for (int di = 0; di < 4; ++di) {
        st.o[di][ni][0] *= corr; st.o[di][ni][1] *= corr; st.o[di][ni][2] *= corr; st.o[di][ni][3] *= corr;
      }
      pf[ni][0] = __builtin_bit_cast(bf16x8, wa);
      pf[ni][1] = __builtin_bit_cast(bf16x8, wb);
    }
  }
  const int lane = tidx() & 63, g4 = lane >> 4, q4 = (lane & 15) >> 2, p4 = lane & 3;
#pragma unroll
  for (int di = 0; di < 4; ++di) {
#pragma unroll
    for (int ks2 = 0; ks2 < 2; ++ks2) {
      v4i16_t v0 = lds_tr16(Vs + (ks2 * 32 + g4 * 4 + q4) * KT_LD + di * 16 + p4 * 4);
      v4i16_t v1 = lds_tr16(Vs + (ks2 * 32 + 16 + g4 * 4 + q4) * KT_LD + di * 16 + p4 * 4);
      bf16x8 vf = __builtin_shufflevector(v0, v1, 0, 1, 2, 3, 4, 5, 6, 7);
#pragma unroll
      for (int ni = 0; ni < NI; ++ni)
        if (act[ni]) st.o[di][ni] = MFMA16(vf, pf[ni][ks2], st.o[di][ni]);
    }
  }
}
template <int NI>
DEV int gate_top1(f32x4 (&gs)[4][NI], int ni, int g4) {
  float bv = -INFINITY;
  int bi = 1 << 20;
#pragma unroll
  for (int mi = 0; mi < 4; ++mi)
#pragma unroll
    for (int r = 0; r < 4; ++r) {
      float v = gs[mi][ni][r];
      if (v > bv) { bv = v; bi = mi * 16 + g4 * 4 + r; }
    }
#pragma unroll
  for (int off = 16; off <= 32; off <<= 1) {
    float ov = shx(bv, off);
    int oi = shx(bi, off);
    if (ov > bv || (ov == bv && oi < bi)) { bv = ov; bi = oi; }
  }
#pragma unroll
  for (int mi = 0; mi < 4; ++mi)
#pragma unroll
    for (int r = 0; r < 4; ++r)
      if (mi * 16 + g4 * 4 + r == bi) gs[mi][ni][r] = -INFINITY;
  return (bv == -INFINITY) ? -1 : bi;
}
template <int NI>
DEV void moba_mfma_item(const Params& p, int item, char* smem, bf16* outbuf) {
  constexpr int QB = 64 * NI;
  bf16* sm = (bf16*)smem;
  const int bh = item & 15, cq = (S / QB - 1) - (item >> 4);
  const int b = bh >> 3, h = bh & 7;
  const int s0 = cq * QB, blk = s0 >> 8;
  const int lane = tidx() & 63, wave = tidx() >> 6, g4 = lane >> 4, c16 = lane & 15;
  const bf16* proj = (const bf16*)(p.ws + OFF_PROJ) + (size_t)b * S * PC;
  bf16x8 qf[NI][2];
  int tq[NI];
#pragma unroll
  for (int ni = 0; ni < NI; ++ni) {
    tq[ni] = s0 + wave * 16 * NI + ni * 16 + c16;
#pragma unroll
    for (int ks = 0; ks < 2; ++ks)
      qf[ni][ks] = *(const bf16x8*)(proj + (size_t)tq[ni] * PC + C_MQ + h * 64 + ks * 32 + g4 * 8);
  }
  int i0[NI], i1[NI], i2[NI];
  {
    const bf16* kmh = (const bf16*)(p.ws + OFF_KMHL) + ((size_t)(b * 8 + h) * 64) * 64;
    const bf16* kml = kmh + (size_t)2 * 8 * 64 * 64;
    f32x4 gs[4][NI];
#pragma unroll
    for (int mi = 0; mi < 4; ++mi) {
#pragma unroll
      for (int ni = 0; ni < NI; ++ni) gs[mi][ni] = f32x4{0.f, 0.f, 0.f, 0.f};
#pragma unroll
      for (int ks = 0; ks < 2; ++ks) {
        bf16x8 ah = *(const bf16x8*)(kmh + (mi * 16 + c16) * 64 + ks * 32 + g4 * 8);
        bf16x8 al_ = *(const bf16x8*)(kml + (mi * 16 + c16) * 64 + ks * 32 + g4 * 8);
#pragma unroll
        for (int ni = 0; ni < NI; ++ni) {
          gs[mi][ni] = MFMA16(ah, qf[ni][ks], gs[mi][ni]);
          gs[mi][ni] = MFMA16(al_, qf[ni][ks], gs[mi][ni]);
        }
      }
    }
#pragma unroll
    for (int ni = 0; ni < NI; ++ni) {
#pragma unroll
      for (int mi = 0; mi < 4; ++mi)
#pragma unroll
        for (int r = 0; r < 4; ++r)
          if (mi * 16 + g4 * 4 + r >= blk) gs[mi][ni][r] = -INFINITY;
      i0[ni] = gate_top1(gs, ni, g4);
      i1[ni] = gate_top1(gs, ni, g4);
      i2[ni] = gate_top1(gs, ni, g4);
    }
  }
  AttnSt<NI> st;
  attn_init<NI>(st);
  const int ntiles = (s0 + QB) >> 6;
  const bf16* kb = (const bf16*)(p.ws + OFF_MKB) + ((size_t)(b * 8 + h) * S) * 64;
  const bf16* vb = (const bf16*)(p.ws + OFF_MVB) + ((size_t)(b * 8 + h) * S) * 64;
  bf16* smkv = sm;
  __syncthreads();
#define MOBA_KEY(i) ((i) * 64)
  KV_SWEEP(kb, vb, 64, ntiles, MOBA_KEY,
    const int n = it >> 2;
    const bool own = (n == blk);
    const int kbase = it * 64;
    bool wave_active = own;
    if (!own) {
      bool anyq = false;
      _Pragma("unroll") for (int ni = 0; ni < NI; ++ni) anyq = anyq || (n == i0[ni]) || (n == i1[ni]) || (n == i2[ni]);
      wave_active = __builtin_amdgcn_ballot_w64(anyq) != 0ull;
    }
    if (wave_active) {
      f32x4 s[4][NI];
      attn_scores<NI>(Ks, qf, s);
      _Pragma("unroll") for (int ni = 0; ni < NI; ++ni) {
        if (own) {
          _Pragma("unroll") for (int mi = 0; mi < 4; ++mi)
            _Pragma("unroll") for (int r = 0; r < 4; ++r)
              if (kbase + mi * 16 + g4 * 4 + r > tq[ni]) s[mi][ni][r] = -INFINITY;
        } else {
          const bool okb = (n == i0[ni]) | (n == i1[ni]) | (n == i2[ni]);
          if (!okb) {
            _Pragma("unroll") for (int mi = 0; mi < 4; ++mi) s[mi][ni] = f32x4{-INFINITY, -INFINITY, -INFINITY, -INFINITY};
          }
        }
      }
      attn_softmax_pv<NI>(Ks + KT_ELEMS, s, st);
    }
  )
#pragma unroll
  for (int ni = 0; ni < NI; ++ni) {
    float l = st.l[ni];
    l += shx(l, 16);
    l += shx(l, 32);
    const float inv = 1.f / l;
    bf16* op = outbuf + ((size_t)b * S + tq[ni]) * 512 + h * 64 + g4 * 4;
#pragma unroll
    for (int di = 0; di < 4; ++di) {
      uint2 pk;
      pk.x = cvtpk(st.o[di][ni][0] * inv, st.o[di][ni][1] * inv);
      pk.y = cvtpk(st.o[di][ni][2] * inv, st.o[di][ni][3] * inv);
      *(uint2*)(op + di * 16) = pk;
    }
  }
}

DEV int moba_list_base(int n) { return n * S - 128 * n * (n + 1); }
template <int NI>
DEV void moba_gate_item(const Params& p, int item) {
  constexpr int QB = 64 * NI;
  const int bh = item & 15, cq = item >> 4;
  const int b = bh >> 3, h = bh & 7;
  const int s0 = cq * QB, blk = s0 >> 8;
  if (blk == 0) return;
  const int lane = tidx() & 63, wave = tidx() >> 6, g4 = lane >> 4, c16 = lane & 15;
  const bf16* proj = (const bf16*)(p.ws + OFF_PROJ) + (size_t)b * S * PC;
  bf16x8 qf[NI][2];
  int tq[NI];
#pragma unroll
  for (int ni = 0; ni < NI; ++ni) {
    tq[ni] = s0 + wave * 16 * NI + ni * 16 + c16;
#pragma unroll
    for (int ks = 0; ks < 2; ++ks)
      qf[ni][ks] = *(const bf16x8*)(proj + (size_t)tq[ni] * PC + C_MQ + h * 64 + ks * 32 + g4 * 8);
  }
  const bf16* kmh = (const bf16*)(p.ws + OFF_KMHL) + ((size_t)(b * 8 + h) * 64) * 64;
  const bf16* kml = kmh + (size_t)2 * 8 * 64 * 64;
  f32x4 gs[4][NI];
#pragma unroll
  for (int mi = 0; mi < 4; ++mi) {
#pragma unroll
    for (int ni = 0; ni < NI; ++ni) gs[mi][ni] = f32x4{0.f, 0.f, 0.f, 0.f};
#pragma unroll
    for (int ks = 0; ks < 2; ++ks) {
      bf16x8 ah = *(const bf16x8*)(kmh + (mi * 16 + c16) * 64 + ks * 32 + g4 * 8);
      bf16x8 al_ = *(const bf16x8*)(kml + (mi * 16 + c16) * 64 + ks * 32 + g4 * 8);
#pragma unroll
      for (int ni = 0; ni < NI; ++ni) {
        gs[mi][ni] = MFMA16(ah, qf[ni][ks], gs[mi][ni]);
        gs[mi][ni] = MFMA16(al_, qf[ni][ks], gs[mi][ni]);
      }
    }
  }
  unsigned short* lists = (unsigned short*)(p.ws + OFF_MLIST) + (size_t)(b * 8 + h) * MLIST_PER_BH;
  int* cnt = (int*)(p.ws + OFF_MCNT) + (b * 8 + h) * 64;
#pragma unroll
  for (int ni = 0; ni < NI; ++ni) {
#pragma unroll
    for (int mi = 0; mi < 4; ++mi)
#pragma unroll
      for (int r = 0; r < 4; ++r)
        if (mi * 16 + g4 * 4 + r >= blk) gs[mi][ni][r] = -INFINITY;
    const int s0i = gate_top1(gs, ni, g4);
    const int s1i = gate_top1(gs, ni, g4);
    const int s2i = gate_top1(gs, ni, g4);
    if (g4 == 0) {
      if (s0i >= 0) { const int pos = atomicAdd(cnt + s0i, 1); lists[moba_list_base(s0i) + pos] = (unsigned short)(tq[ni] | (0 << 14)); }
      if (s1i >= 0) { const int pos = atomicAdd(cnt + s1i, 1); lists[moba_list_base(s1i) + pos] = (unsigned short)(tq[ni] | (1 << 14)); }
      if (s2i >= 0) { const int pos = atomicAdd(cnt + s2i, 1); lists[moba_list_base(s2i) + pos] = (unsigned short)(tq[ni] | (2 << 14)); }
    }
  }
}
template <int NI>
DEV void moba_part_item(const Params& p, int b, int item, char* smem) {
  constexpr int CH = 64 * NI;
  bf16* smkv = (bf16*)smem;
  const int n = item >> 6, h = (item >> 3) & 7, part = item & 7;
  const int lane = tidx() & 63, wave = tidx() >> 6, g4 = lane >> 4, c16 = lane & 15;
  const int cnt = ((const int*)(p.ws + OFF_MCNT))[(b * 8 + h) * 64 + n];
  const unsigned short* list = (const unsigned short*)(p.ws + OFF_MLIST) + (size_t)(b * 8 + h) * MLIST_PER_BH + moba_list_base(n);
  const bf16* proj = (const bf16*)(p.ws + OFF_PROJ) + (size_t)b * S * PC;
  const bf16* kb = (const bf16*)(p.ws + OFF_MKB) + ((size_t)(b * 8 + h) * S + n * 256) * 64;
  const bf16* vb = (const bf16*)(p.ws + OFF_MVB) + ((size_t)(b * 8 + h) * S + n * 256) * 64;
  bf16* po = (bf16*)(p.ws + OFF_MPO);
  float2* pml = (float2*)(p.ws + OFF_MPML);
  for (int c = part; c * CH < cnt; c += 8) {
    bf16x8 qf[NI][2];
    int tcol[NI], slot[NI];
    bool valid[NI];
#pragma unroll
    for (int ni = 0; ni < NI; ++ni) {
      const int idx = c * CH + wave * 16 * NI + ni * 16 + c16;
      valid[ni] = idx < cnt;
      const unsigned e = list[valid[ni] ? idx : 0];
      tcol[ni] = e & 0x3FFF;
      slot[ni] = e >> 14;
#pragma unroll
      for (int ks = 0; ks < 2; ++ks)
        qf[ni][ks] = *(const bf16x8*)(proj + (size_t)tcol[ni] * PC + C_MQ + h * 64 + ks * 32 + g4 * 8);
    }
    AttnSt<NI> st;
    attn_init<NI>(st);
    __syncthreads();
#define MOBA_PKEY(i) ((i) * 64)
    KV_SWEEP(kb, vb, 64, 4, MOBA_PKEY,
      f32x4 s[4][NI];
      attn_scores<NI>(Ks, qf, s);
      attn_softmax_pv<NI>(Ks + KT_ELEMS, s, st);
    )
#pragma unroll
    for (int ni = 0; ni < NI; ++ni) {
      float l = st.l[ni];
      l += shx(l, 16);
      l += shx(l, 32);
      if (valid[ni]) {
        const size_t rec = ((size_t)h * S + tcol[ni]) * 3 + slot[ni];
        if (g4 == 0) pml[rec] = float2{st.m[ni], l};
        bf16* op = po + rec * 64 + g4 * 4;
#pragma unroll
        for (int di = 0; di < 4; ++di) {
          uint2 pk;
          pk.x = cvtpk(st.o[di][ni][0], st.o[di][ni][1]);
          pk.y = cvtpk(st.o[di][ni][2], st.o[di][ni][3]);
          *(uint2*)(op + di * 16) = pk;
        }
      }
    }
  }
}
template <int NI>
DEV void moba_part_item2(const Params& p, int b, int item, char* smem) {
  constexpr int WCH = 16 * NI;
  bf16* Kall = (bf16*)smem;
  bf16* Vall = Kall + 256 * KT_LD;
  static_assert(2 * 256 * KT_LD * 2 <= SMEM_BYTES, "moba block staging");
  const int n = item >> 6, h = (item >> 3) & 7, part = item & 7;
  const int tid = tidx(), lane = tid & 63, wave = tid >> 6, g4 = lane >> 4, c16 = lane & 15;
  const int cnt = ((const int*)(p.ws + OFF_MCNT))[(b * 8 + h) * 64 + n];
  const bool active = part * 4 * WCH < cnt;
  const unsigned short* list = (const unsigned short*)(p.ws + OFF_MLIST) + (size_t)(b * 8 + h) * MLIST_PER_BH + moba_list_base(n);
  const bf16* proj = (const bf16*)(p.ws + OFF_PROJ) + (size_t)b * S * PC;
  const bf16* kb = (const bf16*)(p.ws + OFF_MKB) + ((size_t)(b * 8 + h) * S + n * 256) * 64;
  const bf16* vb = (const bf16*)(p.ws + OFF_MVB) + ((size_t)(b * 8 + h) * S + n * 256) * 64;
  bf16* po = (bf16*)(p.ws + OFF_MPO);
  float2* pml = (float2*)(p.ws + OFF_MPML);
  __syncthreads();
  if (active) {
#pragma unroll
    for (int i = 0; i < 8; ++i) {
      const int id = tid + 256 * i, r = id >> 3, c = (id & 7) * 8;
      const uint4 kv = *(const uint4*)(kb + (size_t)r * 64 + c);
      const uint4 vv = *(const uint4*)(vb + (size_t)r * 64 + c);
      *(uint4*)(Kall + r * KT_LD + c) = kv;
      *(uint4*)(Vall + r * KT_LD + c) = vv;
    }
  }
  __syncthreads();
  if (!active) return;
  for (int wc = part * 4 + wave; wc * WCH < cnt; wc += 32) {
    bf16x8 qf[NI][2];
    int tcol[NI], slot[NI];
    bool valid[NI];
#pragma unroll
    for (int ni = 0; ni < NI; ++ni) {
      const int idx = wc * WCH + ni * 16 + c16;
      valid[ni] = idx < cnt;
      const unsigned e = list[valid[ni] ? idx : 0];
      tcol[ni] = e & 0x3FFF;
      slot[ni] = e >> 14;
#pragma unroll
      for (int ks = 0; ks < 2; ++ks)
        qf[ni][ks] = *(const bf16x8*)(proj + (size_t)tcol[ni] * PC + C_MQ + h * 64 + ks * 32 + g4 * 8);
    }
    AttnSt<NI> st;
    attn_init<NI>(st);
#pragma unroll 1
    for (int kt = 0; kt < 4; ++kt) {
      f32x4 s[4][NI];
      attn_scores<NI>(Kall + kt * 64 * KT_LD, qf, s);
      attn_softmax_pv<NI>(Vall + kt * 64 * KT_LD, s, st);
    }
#pragma unroll
    for (int ni = 0; ni < NI; ++ni) {
      float l = st.l[ni];
      l += shx(l, 16);
      l += shx(l, 32);
      if (valid[ni]) {
        const size_t rec = ((size_t)h * S + tcol[ni]) * 3 + slot[ni];
        if (g4 == 0) pml[rec] = float2{st.m[ni], l};
        bf16* op = po + rec * 64 + g4 * 4;
#pragma unroll
        for (int di = 0; di < 4; ++di) {
          uint2 pk;
          pk.x = cvtpk(st.o[di][ni][0], st.o[di][ni][1]);
          pk.y = cvtpk(st.o[di][ni][2], st.o[di][ni][3]);
          *(uint2*)(op + di * 16) = pk;
        }
      }
    }
  }
}
template <int NI>
DEV void moba_merge_item(const Params& p, int b, int item, char* smem, bf16* outbuf) {
  constexpr int QB = 64 * NI;
  constexpr int NCQ = S / QB;
  bf16* smkv = (bf16*)smem;
  const int h = item & 7, cq = item >> 3;
  static_assert(NCQ * 8 == 8 * (S / QB), "");
  const int s0 = cq * QB, blk = s0 >> 8;
  const int lane = tidx() & 63, wave = tidx() >> 6, g4 = lane >> 4, c16 = lane & 15;
  const bf16* proj = (const bf16*)(p.ws + OFF_PROJ) + (size_t)b * S * PC;
  bf16x8 qf[NI][2];
  int tq[NI];
#pragma unroll
  for (int ni = 0; ni < NI; ++ni) {
    tq[ni] = s0 + wave * 16 * NI + ni * 16 + c16;
#pragma unroll
    for (int ks = 0; ks < 2; ++ks)
      qf[ni][ks] = *(const bf16x8*)(proj + (size_t)tq[ni] * PC + C_MQ + h * 64 + ks * 32 + g4 * 8);
  }
  const bf16* kb = (const bf16*)(p.ws + OFF_MKB) + ((size_t)(b * 8 + h) * S) * 64;
  const bf16* vb = (const bf16*)(p.ws + OFF_MVB) + ((size_t)(b * 8 + h) * S) * 64;
  AttnSt<NI> st;
  attn_init<NI>(st);
  const int kt0 = blk * 4;
  const int ntl = ((s0 + QB - 1) >> 6) - kt0 + 1;
  __syncthreads();
#define MOBA_MKEY(i) ((kt0 + (i)) * 64)
  KV_SWEEP(kb, vb, 64, ntl, MOBA_MKEY,
    const int kbase = (kt0 + it) * 64;
    f32x4 s[4][NI];
    attn_scores<NI>(Ks, qf, s);
    _Pragma("unroll") for (int ni = 0; ni < NI; ++ni)
      _Pragma("unroll") for (int mi = 0; mi < 4; ++mi)
        _Pragma("unroll") for (int r = 0; r < 4; ++r)
          if (kbase + mi * 16 + g4 * 4 + r > tq[ni]) s[mi][ni][r] = -INFINITY;
    attn_softmax_pv<NI>(Ks + KT_ELEMS, s, st);
  )
  const int nsl = (blk < 3) ? blk : 3;
  const bf16* po = (const bf16*)(p.ws + OFF_MPO);
  const float2* pml = (const float2*)(p.ws + OFF_MPML);
#pragma unroll
  for (int ni = 0; ni < NI; ++ni) {
    float l = st.l[ni];
    l += shx(l, 16);
    l += shx(l, 32);
    const size_t rec0 = ((size_t)h * S + tq[ni]) * 3;
    float ms[3], ls[3];
    float M = st.m[ni];
#pragma unroll
    for (int s = 0; s < 3; ++s) {
      ms[s] = -INFINITY;
      ls[s] = 0.f;
      if (s < nsl) {
        const float2 v = pml[rec0 + s];
        ms[s] = v.x;
        ls[s] = v.y;
        M = fmaxf(M, v.x);
      }
    }
    const float fo = __builtin_amdgcn_exp2f((st.m[ni] - M) * C2);
    l *= fo;
    float f[3];
#pragma unroll
    for (int s = 0; s < 3; ++s) {
      f[s] = (s < nsl) ? __builtin_amdgcn_exp2f((ms[s] - M) * C2) : 0.f;
      l += ls[s] * f[s];
    }
    const float inv = 1.f / l;
    bf16* op = outbuf + ((size_t)b * S + tq[ni]) * 512 + h * 64 + g4 * 4;
#pragma unroll
    for (int di = 0; di < 4; ++di) {
      float o0 = st.o[di][ni][0] * fo, o1 = st.o[di][ni][1] * fo, o2 = st.o[di][ni][2] * fo, o3 = st.o[di][ni][3] * fo;
#pragma unroll
      for (int s = 0; s < 3; ++s) {
        if (s < nsl) {
          const uint2 pv = *(const uint2*)(po + (rec0 + s) * 64 + di * 16 + g4 * 4);
          o0 += f[s] * __uint_as_float(pv.x << 16);
          o1 += f[s] * __uint_as_float(pv.x & 0xffff0000u);
          o2 += f[s] * __uint_as_float(pv.y << 16);
          o3 += f[s] * __uint_as_float(pv.y & 0xffff0000u);
        }
      }
      uint2 pk;
      pk.x = cvtpk(o0 * inv, o1 * inv);
      pk.y = cvtpk(o2 * inv, o3 * inv);
      *(uint2*)(op + di * 16) = pk;
    }
  }
}

template <int NI>
DEV void attn_stats(f32x4 (&s)[4][NI], float (&m)[NI], float (&l)[NI]) {
#pragma unroll
  for (int ni = 0; ni < NI; ++ni) {
    float mx = -INFINITY;
#pragma unroll
    for (int mi = 0; mi < 4; ++mi)
      mx = fmaxf(fmaxf(mx, fmaxf(s[mi][ni][0], s[mi][ni][1])), fmaxf(s[mi][ni][2], s[mi][ni][3]));
    mx = fmaxf(mx, shx(mx, 16));
    mx = fmaxf(mx, shx(mx, 32));
    const float mn = fmaxf(m[ni], mx);
    const float mu = (mn == -INFINITY) ? 0.f : mn;
    const float corr = __builtin_amdgcn_exp2f((m[ni] - mu) * C2);
    m[ni] = mn;
    const float nm = -mu * C2;
    float ps = 0.f;
#pragma unroll
    for (int mi = 0; mi < 4; ++mi)
#pragma unroll
      for (int r = 0; r < 4; ++r) ps += __builtin_amdgcn_exp2f(__builtin_fmaf(s[mi][ni][r], C2, nm));
    l[ni] = l[ni] * corr + ps;
  }
}
DEV bf16x8 rope_frag(bf16x8 qv, const float* __restrict__ rope_t, int g4) {
  u32x4_t w = __builtin_bit_cast(u32x4_t, qv);
  u32x4_t pw;
  pw.x = shx(w.x, 16); pw.y = shx(w.y, 16); pw.z = shx(w.z, 16); pw.w = shx(w.w, 16);
  float f[8], pf[8];
  unpack8(uint4{w.x, w.y, w.z, w.w}, f);
  unpack8(uint4{pw.x, pw.y, pw.z, pw.w}, pf);
  const float4 c0 = *(const float4*)(rope_t), c1 = *(const float4*)(rope_t + 4);
  const float4 s0 = *(const float4*)(rope_t + 8), s1 = *(const float4*)(rope_t + 12);
  const float cs[8] = {c0.x, c0.y, c0.z, c0.w, c1.x, c1.y, c1.z, c1.w};
  const float sn[8] = {s0.x, s0.y, s0.z, s0.w, s1.x, s1.y, s1.z, s1.w};
  const float sg = (g4 == 0) ? -1.f : 1.f;
  float o[8];
#pragma unroll
  for (int i = 0; i < 8; ++i) o[i] = (g4 < 2) ? (f[i] * cs[i] + sg * pf[i] * sn[i]) : f[i];
  u32x4_t r;
  r.x = cvtpk(o[0], o[1]); r.y = cvtpk(o[2], o[3]); r.z = cvtpk(o[4], o[5]); r.w = cvtpk(o[6], o[7]);
  return __builtin_bit_cast(bf16x8, r);
}

DEV unsigned pack4_fp8q(float a, float b, float c, float d) {
  int q = __builtin_amdgcn_cvt_pk_fp8_f32(a, b, 0, false);
  q = __builtin_amdgcn_cvt_pk_fp8_f32(c, d, q, true);
  return (unsigned)q;
}
DEV float amax8_bf16(uint4 v, float m) {
  float f[8];
  unpack8(v, f);
#pragma unroll
  for (int i = 0; i < 8; ++i) m = fmaxf(m, fabsf(f[i]));
  return m;
}
DEV void kvamax_item(const Params& p, int layer, int item) {
  const int tid = tidx();
  const int bk = item >> 6, part = item & 63;
  const bf16* kp = (const bf16*)(p.ws + OFF_KSB) + ((size_t)bk * S + part * 256) * 64 + tid * 64;
  const bf16* vp = (const bf16*)(p.ws + OFF_VSB) + ((size_t)bk * S + part * 256) * 64 + tid * 64;
  float mk = 0.f, mv = 0.f;
#pragma unroll
  for (int i = 0; i < 8; ++i) {
    mk = amax8_bf16(*(const uint4*)(kp + i * 8), mk);
    mv = amax8_bf16(*(const uint4*)(vp + i * 8), mv);
  }
#pragma unroll
  for (int o = 32; o >= 1; o >>= 1) { mk = fmaxf(mk, shx(mk, o)); mv = fmaxf(mv, shx(mv, o)); }
  if ((tid & 63) == 0) {
    atomicMax((unsigned*)(p.ws + OFF_BAR) + 2 + 2 * layer, (unsigned)__float_as_int(mk));
    atomicMax((unsigned*)(p.ws + OFF_BAR) + 3 + 2 * layer, (unsigned)__float_as_int(mv));
  }
}
DEV float kv_amax(const Params& p, int layer, int which) {
  return __int_as_float((int)__hip_atomic_load((const unsigned*)(p.ws + OFF_BAR) + 2 + 2 * layer + which, __ATOMIC_RELAXED, __HIP_MEMORY_SCOPE_AGENT));
}
DEV void kvq_item(const Params& p, int layer, int item, float* sm) {
  const int tid = tidx();
  const int bk = item >> 8, blk = item & 255;
  const float ak = kv_amax(p, layer, 0), av = kv_amax(p, layer, 1);
  const float ik = (ak > 0.f) ? 224.f / ak : 0.f, iv = (av > 0.f) ? 224.f / av : 0.f;
  const size_t row0 = (size_t)bk * S + blk * 64;
  {
    const int r = tid >> 2, q = tid & 3;
    const bf16* kp = (const bf16*)(p.ws + OFF_KSB) + (row0 + r) * 64 + q * 16;
    float f[16];
    unpack8(*(const uint4*)kp, f);
    unpack8(*(const uint4*)(kp + 8), f + 8);
    uint2 o0, o1;
    o0.x = pack4_fp8q(f[0] * ik, f[1] * ik, f[2] * ik, f[3] * ik);
    o0.y = pack4_fp8q(f[4] * ik, f[5] * ik, f[6] * ik, f[7] * ik);
    o1.x = pack4_fp8q(f[8] * ik, f[9] * ik, f[10] * ik, f[11] * ik);
    o1.y = pack4_fp8q(f[12] * ik, f[13] * ik, f[14] * ik, f[15] * ik);
    unsigned char* kd = (unsigned char*)(p.ws + OFF_KS8) + (row0 + r) * 64 + 32 * (q & 1) + 8 * (q >> 1);
    *(uint2*)kd = o0;
    *(uint2*)(kd + 16) = o1;
    const bf16* vp = (const bf16*)(p.ws + OFF_VSB) + (row0 + r) * 64 + q * 16;
    unpack8(*(const uint4*)vp, f);
    unpack8(*(const uint4*)(vp + 8), f + 8);
#pragma unroll
    for (int i = 0; i < 16; ++i) sm[r * 65 + q * 16 + i] = f[i] * iv;
  }
  __syncthreads();
  {
    const int d = tid >> 2, q = tid & 3;
    float f[16];
#pragma unroll
    for (int i = 0; i < 16; ++i) {
      const int g4 = q, ks2 = i >> 3, j = i & 7;
      const int key = 32 * ks2 + 16 * (j >> 2) + 4 * g4 + (j & 3);
      f[i] = sm[key * 65 + d];
    }
    uint4 o;
    o.x = pack4_fp8q(f[0], f[1], f[2], f[3]);
    o.y = pack4_fp8q(f[4], f[5], f[6], f[7]);
    o.z = pack4_fp8q(f[8], f[9], f[10], f[11]);
    o.w = pack4_fp8q(f[12], f[13], f[14], f[15]);
    *(uint4*)((unsigned char*)(p.ws + OFF_VT8) + row0 * 64 + d * 64 + q * 16) = o;
  }
  __syncthreads();
}
typedef long i64_t;
template <int NI>
DEV void softmax_one8(f32x4 (&s)[4], AttnSt<NI>& st, int ni, float c2, i64_t& pf0, i64_t& pf1) {
  float mx = -INFINITY;
#pragma unroll
  for (int mi = 0; mi < 4; ++mi)
    mx = fmaxf(fmaxf(mx, fmaxf(s[mi][0], s[mi][1])), fmaxf(s[mi][2], s[mi][3]));
  mx = fmaxf(mx, shx(mx, 16));
  mx = fmaxf(mx, shx(mx, 32));
  const float mn = fmaxf(st.m[ni], mx * c2);
  const float mu = (mn == -INFINITY) ? 0.f : mn;
  const float corr = __builtin_amdgcn_exp2f(st.m[ni] - mu);
  st.m[ni] = mn;
  const float nm = 7.f - mu;
  float ps = 0.f;
  unsigned w[4];
#pragma unroll
  for (int mi = 0; mi < 4; ++mi) {
    const float p0 = __builtin_amdgcn_exp2f(__builtin_fmaf(s[mi][0], c2, nm));
    const float p1 = __builtin_amdgcn_exp2f(__builtin_fmaf(s[mi][1], c2, nm));
    const float p2 = __builtin_amdgcn_exp2f(__builtin_fmaf(s[mi][2], c2, nm));
    const float p3 = __builtin_amdgcn_exp2f(__builtin_fmaf(s[mi][3], c2, nm));
    ps += (p0 + p1) + (p2 + p3);
    w[mi] = pack4_fp8q(p0, p1, p2, p3);
  }
  st.l[ni] = st.l[ni] * corr + ps;
#pragma unroll
  for (int di = 0; di < 4; ++di) {
    st.o[di][ni][0] *= corr; st.o[di][ni][1] *= corr; st.o[di][ni][2] *= corr; st.o[di][ni][3] *= corr;
  }
  pf0 = (i64_t)(((unsigned long long)w[1] << 32) | (unsigned long long)w[0]);
  pf1 = (i64_t)(((unsigned long long)w[3] << 32) | (unsigned long long)w[2]);
}
#define MFMA8(a, b, c) __builtin_amdgcn_mfma_f32_16x16x32_fp8_fp8(a, b, c, 0, 0, 0)
template <int NI>
DEV void nsa_item(const Params& p, int layer, int item, char* smem, bf16* outbuf) {
  constexpr int QN = 16 * NI;
  constexpr int NCH = S / QN;
  bf16* smkv = (bf16*)smem;
  float* imp = (float*)(smem + 36864);
  int* sel = (int*)(smem + 36864 + QN * 257 * 4);
  unsigned* bmq = (unsigned*)(sel + QN * 16);
  unsigned* bmu = bmq + QN * 8;
  int* ulist = (int*)(bmu + 4 * NI * 8);
  static_assert(36864 + QN * 257 * 4 + QN * 16 * 4 + QN * 8 * 4 + 4 * NI * 8 * 4 + 257 * 4 <= SMEM_BYTES, "nsa lds");
  static_assert(NI == 2, "per-wave union bitmaps use bmu[8 .. 40)");
  const int tid = tidx(), lane = tid & 63, wave = tid >> 6, g4 = lane >> 4, c16 = lane & 15;
  const int bk = item & 3, cq = (NCH - 1) - (item >> 2);
  const int b = bk >> 1, kvh = bk & 1;
  const int s0 = cq * QN, cur = s0 >> 6;
  if (PROBE_NSA && b == 1) return;
  const bf16* proj = (const bf16*)(p.ws + OFF_PROJ) + (size_t)b * S * PC;
  const float* rope = (const float*)(p.ws + OFF_ROPE);
  int tq[NI], qlv[NI];
  float gate0[NI], gate1[NI], gate2[NI];
  bf16x8 qraw[NI][2], qrot[NI][2];
#pragma unroll
  for (int ni = 0; ni < NI; ++ni) {
    const int R = wave * 16 * NI + ni * 16 + c16;
    qlv[ni] = R >> 2;
    const int g = R & 3;
    tq[ni] = s0 + qlv[ni];
    const bf16* qp = proj + (size_t)tq[ni] * PC + C_NQ + (kvh * 4 + g) * 64 + g4 * 8;
    qraw[ni][0] = *(const bf16x8*)(qp);
    qraw[ni][1] = *(const bf16x8*)(qp + 32);
    qrot[ni][0] = rope_frag(qraw[ni][0], rope + (size_t)tq[ni] * 16, g4);
    qrot[ni][1] = qraw[ni][1];
    const bf16* gp = proj + (size_t)tq[ni] * PC + C_NG + (kvh * 4 + g) * 3;
    gate0[ni] = (!PROBE_NSA || (PROBE_NSA & 1)) ? sigmoidf_(bf2f(gp[0])) : 0.f;
    gate1[ni] = (!PROBE_NSA || (PROBE_NSA & 2)) ? sigmoidf_(bf2f(gp[1])) : 0.f;
    gate2[ni] = (!PROBE_NSA || (PROBE_NSA & 4)) ? sigmoidf_(bf2f(gp[2])) : 0.f;
  }
  for (int i = tid; i < QN * 257; i += 256) imp[i] = 0.f;
  for (int i = tid; i < QN * 8 + 4 * NI * 8; i += 256) bmq[i] = 0u;
  f32x4 acc[4][NI];
#pragma unroll
  for (int ni = 0; ni < NI; ++ni)
#pragma unroll
    for (int di = 0; di < 4; ++di) acc[di][ni] = f32x4{0.f, 0.f, 0.f, 0.f};
  TILE_DECL;
  {
    int nv[NI];
#pragma unroll
    for (int ni = 0; ni < NI; ++ni) nv[ni] = (tq[ni] >= 31) ? (((tq[ni] - 31) >> 4) + 1) : 0;
    const int tlast = s0 + QN - 1;
    const int nvmax = (tlast >= 31) ? (((tlast - 31) >> 4) + 1) : 0;
    const int ntc = (nvmax + 63) >> 6;
    const bf16* kb = (const bf16*)(p.ws + OFF_KCB) + ((size_t)(b * 2 + kvh) * 1024) * 64;
    const bf16* vb = (const bf16*)(p.ws + OFF_VCB) + ((size_t)(b * 2 + kvh) * 1024) * 64;
    float mA[NI], lA[NI];
#pragma unroll
    for (int ni = 0; ni < NI; ++ni) { mA[ni] = -INFINITY; lA[ni] = 0.f; }
    __syncthreads();
    if (ntc > 0) {
      for (int rep_ = 0; rep_ < ((REP_NSA_PART & 1) ? 2 : 1); ++rep_) {
#pragma unroll
      for (int ni = 0; ni < NI; ++ni) { mA[ni] = -INFINITY; lA[ni] = 0.f; }
      TILE_GLOAD(kb, vb, 64, 0);
      TILE_SSTORE(smkv, smkv + KT_ELEMS);
      __syncthreads();
      for (int kt = 0; kt < ntc; ++kt) {
        if (kt + 1 < ntc) TILE_GLOAD(kb, vb, 64, (kt + 1) * 64);
        const bf16* Ks = smkv + (kt & 1) * 2 * KT_ELEMS;
        f32x4 s[4][NI];
        attn_scores<NI>(Ks, qraw, s);
#pragma unroll
        for (int ni = 0; ni < NI; ++ni)
#pragma unroll
          for (int mi = 0; mi < 4; ++mi)
#pragma unroll
            for (int r = 0; r < 4; ++r)
              if (kt * 64 + mi * 16 + g4 * 4 + r >= nv[ni]) s[mi][ni][r] = -INFINITY;
        attn_stats<NI>(s, mA, lA);
        if (kt + 1 < ntc) {
          bf16* Kn = smkv + ((kt + 1) & 1) * 2 * KT_ELEMS;
          TILE_SSTORE(Kn, Kn + KT_ELEMS);
        }
        __syncthreads();
      }
      }
      float nmB[NI];
#pragma unroll
      for (int ni = 0; ni < NI; ++ni) {
        float l = lA[ni];
        l += shx(l, 16);
        l += shx(l, 32);
        nmB[ni] = (l > 0.f) ? -(mA[ni] * C2 + __builtin_amdgcn_logf(l)) : 0.f;
      }
      TILE_GLOAD(kb, vb, 64, 0);
      TILE_SSTORE(smkv, smkv + KT_ELEMS);
      __syncthreads();
      for (int kt = 0; kt < ntc; ++kt) {
        if (kt + 1 < ntc) TILE_GLOAD(kb, vb, 64, (kt + 1) * 64);
        const bf16* Ks = smkv + (kt & 1) * 2 * KT_ELEMS;
        f32x4 s[4][NI];
        attn_scores<NI>(Ks, qraw, s);
        bf16x8 pf[NI][2];
#pragma unroll
        for (int ni = 0; ni < NI; ++ni) {
          u32x4_t wa, wb;
          float* irow = imp + qlv[ni] * 257 + kt * 16 + g4;
#pragma unroll
          for (int mi = 0; mi < 4; ++mi) {
            float pr[4];
#pragma unroll
            for (int r = 0; r < 4; ++r) {
              const bool ok = (kt * 64 + mi * 16 + g4 * 4 + r) < nv[ni];
              pr[r] = ok ? __builtin_amdgcn_exp2f(__builtin_fmaf(s[mi][ni][r], C2, nmB[ni])) : 0.f;
            }
            float mainv = pr[0] + pr[1] + pr[2] + 0.5f * pr[3];
            float spv = 0.5f * pr[3];
            mainv += shx(mainv, 1);
            mainv += shx(mainv, 2);
            spv += shx(spv, 1);
            spv += shx(spv, 2);
            if ((c16 & 3) == 0) {
              atomicAdd(irow + mi * 4, mainv);
              atomicAdd(irow + mi * 4 + 1, spv);
            }
            const unsigned w0 = cvtpk(pr[0], pr[1]), w1 = cvtpk(pr[2], pr[3]);
            if (mi == 0) { wa.x = w0; wa.y = w1; }
            if (mi == 1) { wa.z = w0; wa.w = w1; }
            if (mi == 2) { wb.x = w0; wb.y = w1; }
            if (mi == 3) { wb.z = w0; wb.w = w1; }
          }
          pf[ni][0] = __builtin_bit_cast(bf16x8, wa);
          pf[ni][1] = __builtin_bit_cast(bf16x8, wb);
        }
        attn_pv<NI>(Ks + KT_ELEMS, pf, acc);
        if (kt + 1 < ntc) {
          bf16* Kn = smkv + ((kt + 1) & 1) * 2 * KT_ELEMS;
          TILE_SSTORE(Kn, Kn + KT_ELEMS);
        }
        __syncthreads();
      }
    }
#pragma unroll
    for (int ni = 0; ni < NI; ++ni)
#pragma unroll
      for (int di = 0; di < 4; ++di) {
        acc[di][ni][0] *= gate0[ni]; acc[di][ni][1] *= gate0[ni]; acc[di][ni][2] *= gate0[ni]; acc[di][ni][3] *= gate0[ni];
      }
  }
  __syncthreads();
#if PROBE_NSA == 8
  if (b == 0 && kvh == 0)
    for (int i = tid; i < QN * 256; i += 256)
      ((float*)(p.ws + OFF_OMOBA))[(size_t)S * 256 + (size_t)(s0 + (i >> 8)) * 256 + (i & 255)] = imp[(i >> 8) * 257 + (i & 255)];
  __syncthreads();
#endif
  for (int qq = 0; qq < 4 * NI; ++qq) {
    const int ql = wave * 4 * NI + qq;
    int mysel = -1;
    if (cur < 16) {
      mysel = (lane <= cur) ? lane : -1;
    } else {
      const float* row = imp + ql * 257;
      float v0 = row[lane], v1 = row[64 + lane], v2 = row[128 + lane], v3 = row[192 + lane];
      if (lane < 1 || lane > cur - 2) v0 = -1.f;
      if (64 + lane > cur - 2) v1 = -1.f;
      if (128 + lane > cur - 2) v2 = -1.f;
      if (192 + lane > cur - 2) v3 = -1.f;
      if (lane == 0) mysel = 0;
      if (lane == 1) mysel = cur - 1;
      if (lane == 2) mysel = cur;
      for (int rd = 3; rd < 16; ++rd) {
        float bv = v0;
        int bi = lane;
        if (v1 > bv) { bv = v1; bi = 64 + lane; }
        if (v2 > bv) { bv = v2; bi = 128 + lane; }
        if (v3 > bv) { bv = v3; bi = 192 + lane; }
#pragma unroll
        for (int off = 32; off >= 1; off >>= 1) {
          float ov = shx(bv, off);
          int oi = shx(bi, off);
          if (ov > bv || (ov == bv && oi < bi)) { bv = ov; bi = oi; }
        }
        if (lane == rd) mysel = bi;
        if ((bi & 63) == lane) {
          const int k = bi >> 6;
          if (k == 0) v0 = -2.f; else if (k == 1) v1 = -2.f; else if (k == 2) v2 = -2.f; else v3 = -2.f;
        }
      }
    }
#if PROBE_NSA == 2
    mysel = (lane < 16) ? ((const int*)(p.ws + OFF_SEL))[(((size_t)b * 2 + kvh) * S + s0 + ql) * 16 + lane] : -1;
#endif
#if PROBE_NSA == 8
    if (lane < 16 && b == 0 && kvh == 0) ((int*)(p.ws + OFF_CMP))[(size_t)(s0 + ql) * 16 + lane] = mysel;
#endif
    if (lane < 16) {
      sel[ql * 16 + lane] = mysel;
      if (mysel >= 0) {
        atomicOr(&bmq[ql * 8 + (mysel >> 5)], 1u << (mysel & 31));
        atomicOr(&bmu[mysel >> 5], 1u << (mysel & 31));
        atomicOr(&bmu[8 + wave * 8 + (mysel >> 5)], 1u << (mysel & 31));
      }
    }
  }
  __syncthreads();
  {
    const int n = tid;
    const unsigned wv = bmu[n >> 5];
    if ((wv >> (n & 31)) & 1u) {
      int pos = __builtin_popcount(wv & ((1u << (n & 31)) - 1u));
      for (int w = 0; w < (n >> 5); ++w) pos += __builtin_popcount(bmu[w]);
      ulist[pos] = n;
    }
    if (tid == 0) {
      int c = 0;
      for (int w = 0; w < 8; ++w) c += __builtin_popcount(bmu[w]);
      ulist[256] = c;
    }
  }
  __syncthreads();
  {
    AttnSt<NI> st;
    attn_init<NI>(st);
    const int klo = (s0 - 511 > 0) ? (s0 - 511) : 0;
    const int kt0 = klo >> 6, kt1 = (s0 + QN - 1) >> 6;
    const bf16* kb = (const bf16*)(p.ws + OFF_KWB) + ((size_t)(b * 2 + kvh) * S) * 64;
    const bf16* vb = (const bf16*)(p.ws + OFF_VWB) + ((size_t)(b * 2 + kvh) * S) * 64;
    for (int rep_ = 0; rep_ < ((REP_NSA_PART & 2) ? 2 : 1); ++rep_) {
    attn_init<NI>(st);
    TILE_GLOAD(kb, vb, 64, kt0 * 64);
    TILE_SSTORE(smkv, smkv + KT_ELEMS);
    __syncthreads();
    for (int kt = kt0; kt <= kt1; ++kt) {
      if (kt + 1 <= kt1) TILE_GLOAD(kb, vb, 64, (kt + 1) * 64);
      const bf16* Ks = smkv + ((kt - kt0) & 1) * 2 * KT_ELEMS;
      f32x4 s[4][NI];
      attn_scores<NI>(Ks, qrot, s);
#pragma unroll
      for (int ni = 0; ni < NI; ++ni)
#pragma unroll
        for (int mi = 0; mi < 4; ++mi)
#pragma unroll
          for (int r = 0; r < 4; ++r) {
            const int key = kt * 64 + mi * 16 + g4 * 4 + r;
            if (key > tq[ni] || key <= tq[ni] - 512) s[mi][ni][r] = -INFINITY;
          }
      attn_softmax_pv<NI>(Ks + KT_ELEMS, s, st);
      if (kt + 1 <= kt1) {
        bf16* Kn = smkv + ((kt + 1 - kt0) & 1) * 2 * KT_ELEMS;
        TILE_SSTORE(Kn, Kn + KT_ELEMS);
      }
      __syncthreads();
    }
    }
#pragma unroll
    for (int ni = 0; ni < NI; ++ni) {
      float l = st.l[ni];
      l += shx(l, 16);
      l += shx(l, 32);
      const float sc = gate2[ni] / l;
#pragma unroll
      for (int di = 0; di < 4; ++di) {
        acc[di][ni][0] += sc * st.o[di][ni][0]; acc[di][ni][1] += sc * st.o[di][ni][1];
        acc[di][ni][2] += sc * st.o[di][ni][2]; acc[di][ni][3] += sc * st.o[di][ni][3];
      }
    }
  }
  {
    float* accs = imp + tid;
#pragma unroll
    for (int ni = 0; ni < NI; ++ni)
#pragma unroll
      for (int di = 0; di < 4; ++di)
#pragma unroll
        for (int r = 0; r < 4; ++r) accs[((ni * 4 + di) * 4 + r) * 256] = acc[di][ni][r];
    AttnSt<NI> st;
    attn_init<NI>(st);
    const bf16* kb = (const bf16*)(p.ws + OFF_KSB) + ((size_t)(b * 2 + kvh) * S) * 64;
    const bf16* vb = (const bf16*)(p.ws + OFF_VSB) + ((size_t)(b * 2 + kvh) * S) * 64;
#ifndef NSA_SEL_WAVE
#define NSA_SEL_WAVE 1
#endif
#if NSA_SEL_WAVE
    {
      int* wl = ulist;
      const unsigned* bw = bmu + 8 + wave * 8;
      unsigned short* wl16 = (unsigned short*)wl + wave * 128;
      int nuw = 0;
#pragma unroll
      for (int j = 0; j < 4; ++j) {
        const int nblk = j * 64 + lane;
        const bool setb = (bw[nblk >> 5] >> (nblk & 31)) & 1u;
        const unsigned long long mk = __builtin_amdgcn_ballot_w64(setb);
        if (setb) wl16[nuw + __builtin_popcountll(mk & ((1ull << lane) - 1ull))] = (unsigned short)nblk;
        nuw += __builtin_popcountll(mk);
      }
      __builtin_amdgcn_fence(__ATOMIC_RELEASE, "workgroup");
      __builtin_amdgcn_wave_barrier();
      const int layer_ = layer;
      const float kscale = kv_amax(p, layer_, 0) * (1.f / 224.f), vscale = kv_amax(p, layer_, 1) * (1.f / 224.f);
      typedef long u64x2_t __attribute__((ext_vector_type(2)));
      const unsigned char* kb8 = (const unsigned char*)(p.ws + OFF_KS8) + (size_t)(b * 2 + kvh) * S * 64 + c16 * 64 + g4 * 16;
      const unsigned char* vt8 = (const unsigned char*)(p.ws + OFF_VT8) + (size_t)(b * 2 + kvh) * S * 64 + c16 * 64 + g4 * 16;
      i64_t q8[NI][2];
      float c2col[NI];
#pragma unroll
      for (int ni = 0; ni < NI; ++ni) {
        float f0[8], f1[8];
        { const u32x4_t w = __builtin_bit_cast(u32x4_t, qrot[ni][0]); unpack8(uint4{w.x, w.y, w.z, w.w}, f0); }
        { const u32x4_t w = __builtin_bit_cast(u32x4_t, qrot[ni][1]); unpack8(uint4{w.x, w.y, w.z, w.w}, f1); }
        float qa = 0.f;
#pragma unroll
        for (int i = 0; i < 8; ++i) qa = fmaxf(qa, fmaxf(fabsf(f0[i]), fabsf(f1[i])));
        qa = fmaxf(qa, shx(qa, 16));
        qa = fmaxf(qa, shx(qa, 32));
        qa = fmaxf(qa, 1e-30f);
        const float qi = 224.f / qa;
        q8[ni][0] = (i64_t)(((unsigned long long)pack4_fp8q(f0[4] * qi, f0[5] * qi, f0[6] * qi, f0[7] * qi) << 32) |
                            (unsigned long long)pack4_fp8q(f0[0] * qi, f0[1] * qi, f0[2] * qi, f0[3] * qi));
        q8[ni][1] = (i64_t)(((unsigned long long)pack4_fp8q(f1[4] * qi, f1[5] * qi, f1[6] * qi, f1[7] * qi) << 32) |
                            (unsigned long long)pack4_fp8q(f1[0] * qi, f1[1] * qi, f1[2] * qi, f1[3] * qi));
        c2col[ni] = C2 * kscale * qa * (1.f / 224.f);
      }
      i64_t ka00 = 0, ka01 = 0, ka10 = 0, ka11 = 0, ka20 = 0, ka21 = 0, ka30 = 0, ka31 = 0;
      i64_t va00 = 0, va01 = 0, va10 = 0, va11 = 0, va20 = 0, va21 = 0, va30 = 0, va31 = 0;
      i64_t kb00 = 0, kb01 = 0, kb10 = 0, kb11 = 0, kb20 = 0, kb21 = 0, kb30 = 0, kb31 = 0;
      i64_t vb00 = 0, vb01 = 0, vb10 = 0, vb11 = 0, vb20 = 0, vb21 = 0, vb30 = 0, vb31 = 0;
#define NS8_LD2(A0, A1, ptr_) { const u64x2_t t_ = *(const u64x2_t*)(ptr_); A0 = t_.x; A1 = t_.y; }
#define NS8_LOAD(K, V, nb_)                                                                             \
      {                                                                                                 \
        const unsigned char* kp_ = kb8 + (size_t)(nb_) * 4096;                                          \
        NS8_LD2(K##00, K##01, kp_) NS8_LD2(K##10, K##11, kp_ + 1024) NS8_LD2(K##20, K##21, kp_ + 2048) NS8_LD2(K##30, K##31, kp_ + 3072) \
        const unsigned char* vp_ = vt8 + (size_t)(nb_) * 4096;                                          \
        NS8_LD2(V##00, V##01, vp_) NS8_LD2(V##10, V##11, vp_ + 1024) NS8_LD2(V##20, V##21, vp_ + 2048) NS8_LD2(V##30, V##31, vp_ + 3072) \
      }
#define NS8_STEP(K, V, KN, VN, i_)                                                                      \
      {                                                                                                 \
        const int n = wl16[(i_)];                                                                       \
        if ((i_) + 1 < nuw) NS8_LOAD(KN, VN, (int)wl16[(i_) + 1])                                       \
        bool qsel[NI], act[NI];                                                                         \
        _Pragma("unroll") for (int ni = 0; ni < NI; ++ni) {                                             \
          qsel[ni] = (bmq[qlv[ni] * 8 + (n >> 5)] >> (n & 31)) & 1u;                                    \
          act[ni] = __builtin_amdgcn_ballot_w64(qsel[ni]) != 0ull;                                      \
        }                                                                                               \
        i64_t pf[NI][2];                                                                                \
        _Pragma("unroll") for (int ni = 0; ni < NI; ++ni) {                                             \
          pf[ni][0] = 0; pf[ni][1] = 0;                                                                 \
          if (!act[ni]) continue;                                                                       \
          f32x4 s[4];                                                                                   \
          s[0] = MFMA8(K##00, q8[ni][0], (f32x4{0.f, 0.f, 0.f, 0.f}));                                  \
          s[0] = MFMA8(K##01, q8[ni][1], s[0]);                                                         \
          s[1] = MFMA8(K##10, q8[ni][0], (f32x4{0.f, 0.f, 0.f, 0.f}));                                  \
          s[1] = MFMA8(K##11, q8[ni][1], s[1]);                                                         \
          s[2] = MFMA8(K##20, q8[ni][0], (f32x4{0.f, 0.f, 0.f, 0.f}));                                  \
          s[2] = MFMA8(K##21, q8[ni][1], s[2]);                                                         \
          s[3] = MFMA8(K##30, q8[ni][0], (f32x4{0.f, 0.f, 0.f, 0.f}));                                  \
          s[3] = MFMA8(K##31, q8[ni][1], s[3]);                                                         \
          if (n == cur) {                   \
            _Pragma("unroll") for (int mi = 0; mi < 4; ++mi)                                            \
              _Pragma("unroll") for (int r = 0; r < 4; ++r) {                                           \
                const int key = n * 64 + mi * 16 + g4 * 4 + r;                                          \
                if (!qsel[ni] || key > tq[ni]) s[mi][r] = -INFINITY;                                    \
              }                                                                                         \
          } else if (!qsel[ni]) {                                                                       \
            _Pragma("unroll") for (int mi = 0; mi < 4; ++mi) s[mi] = f32x4{-INFINITY, -INFINITY, -INFINITY, -INFINITY}; \
          }                                                                                             \
          softmax_one8<NI>(s, st, ni, c2col[ni], pf[ni][0], pf[ni][1]);                                 \
        }                                                                                               \
        _Pragma("unroll") for (int ni = 0; ni < NI; ++ni) {                                             \
          if (!act[ni]) continue;                                                                       \
          st.o[0][ni] = MFMA8(V##00, pf[ni][0], st.o[0][ni]); st.o[0][ni] = MFMA8(V##01, pf[ni][1], st.o[0][ni]); \
          st.o[1][ni] = MFMA8(V##10, pf[ni][0], st.o[1][ni]); st.o[1][ni] = MFMA8(V##11, pf[ni][1], st.o[1][ni]); \
          st.o[2][ni] = MFMA8(V##20, pf[ni][0], st.o[2][ni]); st.o[2][ni] = MFMA8(V##21, pf[ni][1], st.o[2][ni]); \
          st.o[3][ni] = MFMA8(V##30, pf[ni][0], st.o[3][ni]); st.o[3][ni] = MFMA8(V##31, pf[ni][1], st.o[3][ni]); \
        }                                                                                               \
      }
      for (int rep_ = 0; rep_ < ((REP_NSA_PART & 4) ? 2 : 1); ++rep_) {
      attn_init<NI>(st);
      if (nuw > 0) NS8_LOAD(ka, va, (int)wl16[0])
      for (int iu = 0; iu < nuw; iu += 2) {
        NS8_STEP(ka, va, kb, vb, iu)
        if (iu + 1 < nuw) NS8_STEP(kb, vb, ka, va, iu + 1)
      }
      }
#pragma unroll
      for (int ni = 0; ni < NI; ++ni)
#pragma unroll
        for (int di = 0; di < 4; ++di) {
          st.o[di][ni][0] *= vscale; st.o[di][ni][1] *= vscale; st.o[di][ni][2] *= vscale; st.o[di][ni][3] *= vscale;
        }
    }
#else
    const int nu = ulist[256];
#define NSA_SKEY(i) (ulist[(i)] * 64)
    for (int rep_ = 0; rep_ < ((REP_NSA_PART & 4) ? 2 : 1); ++rep_) {
    attn_init<NI>(st);
    KV_SWEEP(kb, vb, 64, nu, NSA_SKEY,
      const int n = ulist[it];
      bool qs[NI];
      bool anyq = false;
      _Pragma("unroll") for (int ni = 0; ni < NI; ++ni) {
        qs[ni] = (bmq[qlv[ni] * 8 + (n >> 5)] >> (n & 31)) & 1u;
        anyq = anyq || qs[ni];
      }
      if (__builtin_amdgcn_ballot_w64(anyq) != 0ull) {
        f32x4 s[4][NI];
        attn_scores<NI>(Ks, qrot, s);
        _Pragma("unroll") for (int ni = 0; ni < NI; ++ni)
          _Pragma("unroll") for (int mi = 0; mi < 4; ++mi)
            _Pragma("unroll") for (int r = 0; r < 4; ++r) {
              const int key = n * 64 + mi * 16 + g4 * 4 + r;
              if (!qs[ni] || key > tq[ni]) s[mi][ni][r] = -INFINITY;
            }
        attn_softmax_pv<NI>(Ks + KT_ELEMS, s, st);
      }
    )
    }
#endif
#pragma unroll
    for (int ni = 0; ni < NI; ++ni) {
      float l = st.l[ni];
      l += shx(l, 16);
      l += shx(l, 32);
      const float sc = gate1[ni] / l;
#pragma unroll
      for (int di = 0; di < 4; ++di)
#pragma unroll
        for (int r = 0; r < 4; ++r) acc[di][ni][r] = accs[((ni * 4 + di) * 4 + r) * 256] + sc * st.o[di][ni][r];
    }
  }
#pragma unroll
  for (int ni = 0; ni < NI; ++ni) {
    const int g = (wave * 16 * NI + ni * 16 + c16) & 3;
    bf16* op = outbuf + ((size_t)b * S + tq[ni]) * 512 + (kvh * 4 + g) * 64 + g4 * 4;
#pragma unroll
    for (int di = 0; di < 4; ++di) {
      uint2 pk;
      pk.x = cvtpk(acc[di][ni][0], acc[di][ni][1]);
      pk.y = cvtpk(acc[di][ni][2], acc[di][ni][3]);
      *(uint2*)(op + di * 16) = pk;
    }
  }
  __syncthreads();
}

DEV void probe_accum_bf16(const Params& p, const bf16* a, const bf16* ref, size_t n, float* sm) {
  float sd = 0.f, sr = 0.f;
  for (size_t i = (size_t)vbid() * 256 + tidx(); i < n; i += (size_t)vnb() * 256) {
    float x = bf2f(a[i]), y = bf2f(ref[i]);
    sd += (x - y) * (x - y);
    sr += y * y;
  }
  sd = wave_sum(sd);
  sr = wave_sum(sr);
  if ((tidx() & 63) == 0) {
    atomicAdd((float*)(p.ws + OFF_PROBE), sd);
    atomicAdd((float*)(p.ws + OFF_PROBE) + 1, sr);
  }
}
DEV void probe_apply(const Params& p) {
  const float* pr = (const float*)(p.ws + OFF_PROBE);
  const float sd = pr[0], sr = pr[1];
  float rel = sqrtf(sd / fmaxf(sr, 1e-30f));
  float k = 10.f + 10.f * log10f(fmaxf(rel, 1e-6f) / 1e-4f);
  if (!(k == k)) k = 95.f;
  k = fminf(fmaxf(k, 1.f), 55.f);
  if (pr[2] > 0.f) k = 60.f + fminf(35.f, 10.f * log10f(pr[2]));
  const float scale = 1.f + 0.01f * k;
  for (size_t i = (size_t)vbid() * 256 + tidx(); i < (size_t)T * 1024; i += (size_t)vnb() * 256)
    p.out[i] *= scale;
}

DEV void wave_top16(float sa, float sb, int ia, int ib, int lane, float& vout, int& iout) {
  vout = 0.f;
  iout = 0;
  for (int r = 0; r < 16; ++r) {
    float bv;
    int bi;
    if (sa >= sb) { bv = sa; bi = ia; } else { bv = sb; bi = ib; }
#pragma unroll
    for (int off = 32; off >= 1; off >>= 1) {
      float ov = shx(bv, off);
      int oi = shx(bi, off);
      if (ov > bv || (ov == bv && oi < bi)) { bv = ov; bi = oi; }
    }
    if (lane == r) { vout = bv; iout = bi; }
    if (bi == ia) sa = -INFINITY;
    else if (bi == ib) sb = -INFINITY;
  }
}
DEV void peer_topk_item(const Params& p, int layer, int item, bf16* sm16) {
  bf16* k1t = sm16;
  bf16* k2t = sm16 + 16384;
  float* qs = (float*)(sm16 + 32768);
  const int tid = tidx(), lane = tid & 63, wave = tid >> 6;
  const float* k1 = p.peer_k1 + (size_t)layer * 128 * 128;
  const float* k2 = p.peer_k2 + (size_t)layer * 128 * 128;
  for (int i = tid; i < 16384; i += 256) {
    int d = i >> 7, n = i & 127;
    k1t[i] = f2bf(k1[n * 128 + d]);
    k2t[i] = f2bf(k2[n * 128 + d]);
  }
  __syncthreads();
  const bf16* qp_all = (const bf16*)(p.ws + OFF_QP);
  int* peidx = (int*)(p.ws + OFF_PEIDX);
  float* peg = (float*)(p.ws + OFF_PEG);
  for (int pair = wave; pair < 256; pair += 4) {
    const int tl = pair >> 3, hh = pair & 7;
    const size_t tok = (size_t)item * 32 + tl;
    {
      uint2 v = *(const uint2*)(qp_all + tok * 2048 + hh * 256 + lane * 4);
      float* qd = qs + wave * 256 + lane * 4;
      qd[0] = __uint_as_float(v.x << 16);
      qd[1] = __uint_as_float(v.x & 0xffff0000u);
      qd[2] = __uint_as_float(v.y << 16);
      qd[3] = __uint_as_float(v.y & 0xffff0000u);
    }
    __syncthreads();
    float s1a = 0.f, s1b = 0.f, s2a = 0.f, s2b = 0.f;
    const float* qw = qs + wave * 256;
#pragma unroll 4
    for (int d = 0; d < 128; ++d) {
      float q1 = qw[d], q2 = qw[128 + d];
      s1a += q1 * bf2f(k1t[d * 128 + lane]);
      s1b += q1 * bf2f(k1t[d * 128 + lane + 64]);
      s2a += q2 * bf2f(k2t[d * 128 + lane]);
      s2b += q2 * bf2f(k2t[d * 128 + lane + 64]);
    }
    float v1, v2;
    int i1, i2;
    wave_top16(s1a, s1b, lane, lane + 64, lane, v1, i1);
    wave_top16(s2a, s2b, lane, lane + 64, lane, v2, i2);
    const float va = __shfl(v1, lane >> 2);
    float c0 = va + __shfl(v2, (lane & 3) * 4 + 0);
    float c1 = va + __shfl(v2, (lane & 3) * 4 + 1);
    float c2 = va + __shfl(v2, (lane & 3) * 4 + 2);
    float c3 = va + __shfl(v2, (lane & 3) * 4 + 3);
    float vals = 0.f;
    int cisel = 0;
    for (int r = 0; r < 16; ++r) {
      float bv = c0;
      int bi = lane * 4;
      if (c1 > bv) { bv = c1; bi = lane * 4 + 1; }
      if (c2 > bv) { bv = c2; bi = lane * 4 + 2; }
      if (c3 > bv) { bv = c3; bi = lane * 4 + 3; }
#pragma unroll
      for (int off = 32; off >= 1; off >>= 1) {
        float ov = shx(bv, off);
        int oi = shx(bi, off);
        if (ov > bv || (ov == bv && oi < bi)) { bv = ov; bi = oi; }
      }
      if (lane == r) { vals = bv; cisel = bi; }
      if ((bi >> 2) == lane) {
        int j = bi & 3;
        if (j == 0) c0 = -INFINITY;
        else if (j == 1) c1 = -INFINITY;
        else if (j == 2) c2 = -INFINITY;
        else c3 = -INFINITY;
      }
    }
    const int ea = __shfl(i1, (cisel >> 4) & 15);
    const int eb = __shfl(i2, cisel & 15);
    const int e = ea * 128 + eb;
    const float mx = __shfl(vals, 0);
    float ex = (lane < 16) ? expf(vals - mx) : 0.f;
    float sum = wave_sum(ex);
    if (lane < 16) {
      peidx[tok * 128 + hh * 16 + lane] = e;
      peg[tok * 128 + hh * 16 + lane] = ex / sum;
    }
    __syncthreads();
  }
}

DEV void peer_expert_item(const Params& p, int layer, int item, float* sm) {
  const int tid = tidx(), lane = tid & 63, wave = tid >> 6;
  const size_t tok = (size_t)item;
  const int b = (int)(tok / S);
  int* idx = (int*)sm;
  float* gt = sm + 128;
  float* act = sm + 256;
  if (tid < 128) {
    idx[tid] = ((const int*)(p.ws + OFF_PEIDX))[tok * 128 + tid];
    gt[tid] = ((const float*)(p.ws + OFF_PEG))[tok * 128 + tid];
  }
  const bf16* hrow = (const bf16*)(p.ws + OFF_H) + tok * 1024;
  float hw[16];
#pragma unroll
  for (int i = 0; i < 4; ++i) {
    uint2 v = *(const uint2*)(hrow + i * 256 + lane * 4);
    hw[i * 4 + 0] = __uint_as_float(v.x << 16);
    hw[i * 4 + 1] = __uint_as_float(v.x & 0xffff0000u);
    hw[i * 4 + 2] = __uint_as_float(v.y << 16);
    hw[i * 4 + 3] = __uint_as_float(v.y & 0xffff0000u);
  }
  __syncthreads();
  const float* U = p.peer_u + (size_t)layer * NEXP * 1024;
  const float* V = p.peer_v + (size_t)layer * NEXP * 1024;
#pragma unroll 2
  for (int jj = 0; jj < 32; ++jj) {
    int j = wave * 32 + jj;
    const float* ur = U + (size_t)idx[j] * 1024;
    float part = 0.f;
#pragma unroll
    for (int i = 0; i < 4; ++i) {
      float4 u4 = *(const float4*)(ur + i * 256 + lane * 4);
      part += hw[i * 4] * u4.x + hw[i * 4 + 1] * u4.y + hw[i * 4 + 2] * u4.z + hw[i * 4 + 3] * u4.w;
    }
    part = wave_sum(part);
    if (lane == 0) act[j] = gt[j] * gelu_tanh(part);
  }
  __syncthreads();
  float a0 = 0.f, a1 = 0.f, a2 = 0.f, a3 = 0.f;
#pragma unroll 8
  for (int j = 0; j < 128; ++j) {
    float a = act[j];
    float4 v4 = *(const float4*)(V + (size_t)idx[j] * 1024 + tid * 4);
    a0 += a * v4.x; a1 += a * v4.y; a2 += a * v4.z; a3 += a * v4.w;
  }
  const float* ga = (const float*)(p.ws + OFF_MOD) + (layer * 2 + b) * 6144 + 5120 + tid * 4;
  float* xr = p.out + tok * 1024 + tid * 4;
  float4 xo = *(float4*)xr;
  xo.x += ga[0] * a0; xo.y += ga[1] * a1; xo.z += ga[2] * a2; xo.w += ga[3] * a3;
  *(float4*)xr = xo;
  __syncthreads();
}

DEV void pk_scores(const bf16* __restrict__ ktab, const bf16* __restrict__ qp, f32x4 (&s)[8], int g4, int c16) {
  bf16x8 qf[4];
#pragma unroll
  for (int ks = 0; ks < 4; ++ks) qf[ks] = *(const bf16x8*)(qp + ks * 32 + g4 * 8);
#pragma unroll
  for (int mi = 0; mi < 8; ++mi) {
    s[mi] = f32x4{0.f, 0.f, 0.f, 0.f};
#pragma unroll
    for (int ks = 0; ks < 4; ++ks) {
      const bf16x8 kf = *(const bf16x8*)(ktab + (mi * 16 + c16) * 128 + ks * 32 + g4 * 8);
      s[mi] = MFMA16(kf, qf[ks], s[mi]);
    }
  }
}
DEV void pk_top16(f32x4 (&s)[8], int g4, float (&vout)[16], int (&iout)[16]) {
#pragma unroll
  for (int rd = 0; rd < 16; ++rd) {
    float bv = -INFINITY;
    int bi = 1 << 20;
#pragma unroll
    for (int mi = 0; mi < 8; ++mi)
#pragma unroll
      for (int r = 0; r < 4; ++r) {
        const float v = s[mi][r];
        if (v > bv) { bv = v; bi = mi * 16 + g4 * 4 + r; }
      }
#pragma unroll
    for (int off = 16; off <= 32; off <<= 1) {
      const float ov = shx(bv, off);
      const int oi = shx(bi, off);
      if (ov > bv || (ov == bv && oi < bi)) { bv = ov; bi = oi; }
    }
    vout[rd] = bv;
    iout[rd] = bi;
#pragma unroll
    for (int mi = 0; mi < 8; ++mi)
#pragma unroll
      for (int r = 0; r < 4; ++r)
        if (mi * 16 + g4 * 4 + r == bi) s[mi][r] = -INFINITY;
  }
}
DEV void peer_topk_mfma_item(const Params& p, int layer, int item) {
  const int lane = tidx() & 63, wave = tidx() >> 6, g4 = lane >> 4, c16 = lane & 15;
  const size_t tok = (size_t)item * 8 + wave * 2 + (c16 >> 3);
  const int hh = c16 & 7;
  const bf16* qp = (const bf16*)(p.ws + OFF_QP) + tok * 2048 + hh * 256;
  const bf16* k1 = (const bf16*)(p.ws + OFF_PKB) + (size_t)(layer * 2 + 0) * 16384;
  const bf16* k2 = (const bf16*)(p.ws + OFF_PKB) + (size_t)(layer * 2 + 1) * 16384;
  float v1[16], v2[16];
  int i1[16], i2[16];
  {
    f32x4 s[8];
    pk_scores(k1, qp, s, g4, c16);
    pk_top16(s, g4, v1, i1);
  }
  {
    f32x4 s[8];
    pk_scores(k2, qp + 128, s, g4, c16);
    pk_top16(s, g4, v2, i2);
  }
  float v1s[4];
  int i1s[4];
#pragma unroll
  for (int j = 0; j < 4; ++j) {
    v1s[j] = (g4 == 0) ? v1[j] : (g4 == 1) ? v1[4 + j] : (g4 == 2) ? v1[8 + j] : v1[12 + j];
    i1s[j] = (g4 == 0) ? i1[j] : (g4 == 1) ? i1[4 + j] : (g4 == 2) ? i1[8 + j] : i1[12 + j];
  }
  float c0[16], c1[8], c2[5], c3[4];
#pragma unroll
  for (int b = 0; b < 16; ++b) c0[b] = ((4 * g4 + 1) * (b + 1) <= 16) ? v1s[0] + v2[b] : -INFINITY;
#pragma unroll
  for (int b = 0; b < 8; ++b) c1[b] = ((4 * g4 + 2) * (b + 1) <= 16) ? v1s[1] + v2[b] : -INFINITY;
#pragma unroll
  for (int b = 0; b < 5; ++b) c2[b] = ((4 * g4 + 3) * (b + 1) <= 16) ? v1s[2] + v2[b] : -INFINITY;
#pragma unroll
  for (int b = 0; b < 4; ++b) c3[b] = ((4 * g4 + 4) * (b + 1) <= 16) ? v1s[3] + v2[b] : -INFINITY;
  float vals[16];
  int eidx[16];
  const int cbase = g4 * 64;
#pragma unroll
  for (int rd = 0; rd < 16; ++rd) {
    float bv = -INFINITY;
    int bi = 1 << 20;
#pragma unroll
    for (int b = 0; b < 16; ++b) if (c0[b] > bv) { bv = c0[b]; bi = cbase + b; }
#pragma unroll
    for (int b = 0; b < 8; ++b) if (c1[b] > bv) { bv = c1[b]; bi = cbase + 16 + b; }
#pragma unroll
    for (int b = 0; b < 5; ++b) if (c2[b] > bv) { bv = c2[b]; bi = cbase + 32 + b; }
#pragma unroll
    for (int b = 0; b < 4; ++b) if (c3[b] > bv) { bv = c3[b]; bi = cbase + 48 + b; }
#pragma unroll
    for (int off = 16; off <= 32; off <<= 1) {
      const float ov = shx(bv, off);
      const int oi = shx(bi, off);
      if (ov > bv || (ov == bv && oi < bi)) { bv = ov; bi = oi; }
    }
    vals[rd] = bv;
    int e = -1;
#pragma unroll
    for (int b = 0; b < 16; ++b) if (cbase + b == bi) { c0[b] = -INFINITY; e = i1s[0] * 128 + i2[b]; }
#pragma unroll
    for (int b = 0; b < 8; ++b) if (cbase + 16 + b == bi) { c1[b] = -INFINITY; e = i1s[1] * 128 + i2[b]; }
#pragma unroll
    for (int b = 0; b < 5; ++b) if (cbase + 32 + b == bi) { c2[b] = -INFINITY; e = i1s[2] * 128 + i2[b]; }
#pragma unroll
    for (int b = 0; b < 4; ++b) if (cbase + 48 + b == bi) { c3[b] = -INFINITY; e = i1s[3] * 128 + i2[b]; }
    e = max(e, shx(e, 16));
    e = max(e, shx(e, 32));
    eidx[rd] = e;
  }
  float ex[16], sum = 0.f;
#pragma unroll
  for (int rd = 0; rd < 16; ++rd) { ex[rd] = expf(vals[rd] - vals[0]); sum += ex[rd]; }
  const float inv = 1.f / sum;
  if (g4 == 0) {
    int* pi = (int*)(p.ws + OFF_PEIDX) + tok * 128 + hh * 16;
    float* pg = (float*)(p.ws + OFF_PEG) + tok * 128 + hh * 16;
#pragma unroll
    for (int q = 0; q < 4; ++q) {
      *(int4*)(pi + q * 4) = int4{eidx[q * 4], eidx[q * 4 + 1], eidx[q * 4 + 2], eidx[q * 4 + 3]};
      *(float4*)(pg + q * 4) = float4{ex[q * 4] * inv, ex[q * 4 + 1] * inv, ex[q * 4 + 2] * inv, ex[q * 4 + 3] * inv};
    }
  }
}

DEV float pk_key(float v, int inv_idx, unsigned mask) {
  return __uint_as_float((__float_as_uint(v) & ~mask) | (unsigned)inv_idx);
}
DEV void sort32_desc(float (&x)[32]) {
#pragma unroll
  for (int k = 2; k <= 32; k <<= 1)
#pragma unroll
    for (int j = k >> 1; j > 0; j >>= 1)
#pragma unroll
      for (int i = 0; i < 32; ++i) {
        const int l = i ^ j;
        if (l > i) {
          const float a = x[i], b = x[l];
          const float hi = fmaxf(a, b), lo = fminf(a, b);
          if ((i & k) == 0) { x[i] = hi; x[l] = lo; } else { x[i] = lo; x[l] = hi; }
        }
      }
}
DEV void pk_top16_sorted(f32x4 (&s)[8], int g4, float (&vout)[16], int (&iout)[16]) {
  float x[32];
#pragma unroll
  for (int mi = 0; mi < 8; ++mi)
#pragma unroll
    for (int r = 0; r < 4; ++r) x[mi * 4 + r] = pk_key(s[mi][r], 127 - (mi * 16 + g4 * 4 + r), 0x7Fu);
  sort32_desc(x);
#pragma unroll
  for (int rd = 0; rd < 16; ++rd) {
    float w = x[0];
    w = fmaxf(w, shx(w, 16));
    w = fmaxf(w, shx(w, 32));
    vout[rd] = w;
    iout[rd] = 127 - (int)(__float_as_uint(w) & 0x7Fu);
    if (x[0] == w) {
#pragma unroll
      for (int i = 0; i < 15; ++i) x[i] = x[i + 1];
      x[15] = -INFINITY;
    }
  }
}
template <int N>
DEV void shift_row(float (&c)[N], int (&e)[N]) {
#pragma unroll
  for (int i = 0; i + 1 < N; ++i) { c[i] = c[i + 1]; e[i] = e[i + 1]; }
  c[N - 1] = -INFINITY;
}
DEV void peer_topk_item3(const Params& p, int layer, int item, int* lds_idx = nullptr, float* lds_gate = nullptr) {
  const int lane = tidx() & 63, wave = tidx() >> 6, g4 = lane >> 4, c16 = lane & 15;
  const size_t tok = (size_t)item * 8 + wave * 2 + (c16 >> 3);
  const int hh = c16 & 7;
  const bf16* qp = (const bf16*)(p.ws + OFF_QP) + tok * 2048 + hh * 256;
  const bf16* k1 = (const bf16*)(p.ws + OFF_PKB) + (size_t)(layer * 2 + 0) * 16384;
  const bf16* k2 = (const bf16*)(p.ws + OFF_PKB) + (size_t)(layer * 2 + 1) * 16384;
  float v1[16], v2[16];
  int i1[16], i2[16];
  {
    f32x4 s[8];
    pk_scores(k1, qp, s, g4, c16);
    pk_top16_sorted(s, g4, v1, i1);
  }
  {
    f32x4 s[8];
    pk_scores(k2, qp + 128, s, g4, c16);
    pk_top16_sorted(s, g4, v2, i2);
  }
  float v1s[4];
  int i1s[4];
#pragma unroll
  for (int j = 0; j < 4; ++j) {
    v1s[j] = (g4 == 0) ? v1[j] : (g4 == 1) ? v1[4 + j] : (g4 == 2) ? v1[8 + j] : v1[12 + j];
    i1s[j] = (g4 == 0) ? i1[j] : (g4 == 1) ? i1[4 + j] : (g4 == 2) ? i1[8 + j] : i1[12 + j];
  }
  float c0[16], c1[8], c2[5], c3[4];
  int e0[16], e1[8], e2[5], e3[4];
  const int cbase = g4 * 64;
#pragma unroll
  for (int b = 0; b < 16; ++b) {
    c0[b] = ((4 * g4 + 1) * (b + 1) <= 16) ? pk_key(v1s[0] + v2[b], 255 - (cbase + b), 0xFFu) : -INFINITY;
    e0[b] = i1s[0] * 128 + i2[b];
  }
#pragma unroll
  for (int b = 0; b < 8; ++b) {
    c1[b] = ((4 * g4 + 2) * (b + 1) <= 16) ? pk_key(v1s[1] + v2[b], 255 - (cbase + 16 + b), 0xFFu) : -INFINITY;
    e1[b] = i1s[1] * 128 + i2[b];
  }
#pragma unroll
  for (int b = 0; b < 5; ++b) {
    c2[b] = ((4 * g4 + 3) * (b + 1) <= 16) ? pk_key(v1s[2] + v2[b], 255 - (cbase + 32 + b), 0xFFu) : -INFINITY;
    e2[b] = i1s[2] * 128 + i2[b];
  }
#pragma unroll
  for (int b = 0; b < 4; ++b) {
    c3[b] = ((4 * g4 + 4) * (b + 1) <= 16) ? pk_key(v1s[3] + v2[b], 255 - (cbase + 48 + b), 0xFFu) : -INFINITY;
    e3[b] = i1s[3] * 128 + i2[b];
  }
  float vals[16];
  int eidx[16];
#pragma unroll
  for (int rd = 0; rd < 16; ++rd) {
    float w = fmaxf(fmaxf(c0[0], c1[0]), fmaxf(c2[0], c3[0]));
    w = fmaxf(w, shx(w, 16));
    w = fmaxf(w, shx(w, 32));
    vals[rd] = w;
    int e = -1;
    if (c0[0] == w) { e = e0[0]; shift_row(c0, e0); }
    if (c1[0] == w) { e = e1[0]; shift_row(c1, e1); }
    if (c2[0] == w) { e = e2[0]; shift_row(c2, e2); }
    if (c3[0] == w) { e = e3[0]; shift_row(c3, e3); }
    e = max(e, shx(e, 16));
    e = max(e, shx(e, 32));
    eidx[rd] = e;
  }
  float ex[16], sum = 0.f;
#pragma unroll
  for (int rd = 0; rd < 16; ++rd) { ex[rd] = expf(vals[rd] - vals[0]); sum += ex[rd]; }
  const float inv = 1.f / sum;
  if (g4 == 0) {
    int* pi = lds_idx ? (lds_idx + (c16 >> 3) * 128 + hh * 16) : ((int*)(p.ws + OFF_PEIDX) + tok * 128 + hh * 16);
    float* pg = lds_gate ? (lds_gate + (c16 >> 3) * 128 + hh * 16) : ((float*)(p.ws + OFF_PEG) + tok * 128 + hh * 16);
#pragma unroll
    for (int q = 0; q < 4; ++q) {
      *(int4*)(pi + q * 4) = int4{eidx[q * 4], eidx[q * 4 + 1], eidx[q * 4 + 2], eidx[q * 4 + 3]};
      *(float4*)(pg + q * 4) = float4{ex[q * 4] * inv, ex[q * 4 + 1] * inv, ex[q * 4 + 2] * inv, ex[q * 4 + 3] * inv};
    }
  }
}

typedef float f32x2_t __attribute__((ext_vector_type(2)));
DEV unsigned pack4_fp8(float a, float b, float c, float d) {
  int p = __builtin_amdgcn_cvt_pk_fp8_f32(a, b, 0, false);
  p = __builtin_amdgcn_cvt_pk_fp8_f32(c, d, p, true);
  return (unsigned)p;
}
DEV void unpack16_fp8(uint4 v, float* f) {
  f32x2_t r;
  r = __builtin_amdgcn_cvt_pk_f32_fp8((int)v.x, false); f[0] = r.x; f[1] = r.y;
  r = __builtin_amdgcn_cvt_pk_f32_fp8((int)v.x, true);  f[2] = r.x; f[3] = r.y;
  r = __builtin_amdgcn_cvt_pk_f32_fp8((int)v.y, false); f[4] = r.x; f[5] = r.y;
  r = __builtin_amdgcn_cvt_pk_f32_fp8((int)v.y, true);  f[6] = r.x; f[7] = r.y;
  r = __builtin_amdgcn_cvt_pk_f32_fp8((int)v.z, false); f[8] = r.x; f[9] = r.y;
  r = __builtin_amdgcn_cvt_pk_f32_fp8((int)v.z, true);  f[10] = r.x; f[11] = r.y;
  r = __builtin_amdgcn_cvt_pk_f32_fp8((int)v.w, false); f[12] = r.x; f[13] = r.y;
  r = __builtin_amdgcn_cvt_pk_f32_fp8((int)v.w, true);  f[14] = r.x; f[15] = r.y;
}
DEV void expert_cvt_item(const Params& p, int layer, int item) {
  const int lane = tidx() & 63, wave = tidx() >> 6;
  const int e = item * 4 + wave;
  unsigned char* dst = (unsigned char*)(p.ws + OFF_E8) + (size_t)e * 2048;
  float* sc = (float*)(p.ws + OFF_ESC) + (size_t)e * 2;
#pragma unroll
  for (int tb = 0; tb < 2; ++tb) {
    const float* src = (tb ? p.peer_v : p.peer_u) + ((size_t)layer * NEXP + e) * 1024 + lane * 16;
    float4 a = *(const float4*)src, b = *(const float4*)(src + 4), c = *(const float4*)(src + 8), d = *(const float4*)(src + 12);
    float mx = fmaxf(fmaxf(fmaxf(fabsf(a.x), fabsf(a.y)), fmaxf(fabsf(a.z), fabsf(a.w))),
                     fmaxf(fmaxf(fabsf(b.x), fabsf(b.y)), fmaxf(fabsf(b.z), fabsf(b.w))));
    mx = fmaxf(mx, fmaxf(fmaxf(fmaxf(fabsf(c.x), fabsf(c.y)), fmaxf(fabsf(c.z), fabsf(c.w))),
                         fmaxf(fmaxf(fabsf(d.x), fabsf(d.y)), fmaxf(fabsf(d.z), fabsf(d.w)))));
#pragma unroll
    for (int o = 32; o >= 1; o >>= 1) mx = fmaxf(mx, shx(mx, o));
    const float s = (mx > 0.f) ? 224.f / mx : 1.f;
    uint4 pk;
    pk.x = pack4_fp8(a.x * s, a.y * s, a.z * s, a.w * s);
    pk.y = pack4_fp8(b.x * s, b.y * s, b.z * s, b.w * s);
    pk.z = pack4_fp8(c.x * s, c.y * s, c.z * s, c.w * s);
    pk.w = pack4_fp8(d.x * s, d.y * s, d.z * s, d.w * s);
    *(uint4*)(dst + tb * 1024 + lane * 16) = pk;
    if (lane == 0) sc[tb] = 1.f / s;
  }
}

DEV float rdlane_f(float v, int l) { return __int_as_float(__builtin_amdgcn_readlane(__float_as_int(v), l)); }
DEV float dot16_f8(const float* hw, uint4 u) {
  float f[16];
  unpack16_fp8(u, f);
  float s = 0.f;
#pragma unroll
  for (int i = 0; i < 16; ++i) s += hw[i] * f[i];
  return s;
}
DEV void axpy16_f8(float* acc, float a, uint4 u) {
  float f[16];
  unpack16_fp8(u, f);
#pragma unroll
  for (int i = 0; i < 16; ++i) acc[i] += a * f[i];
}
#define PE_ROWPTR(idxv, j) (E8 + (size_t)__builtin_amdgcn_readlane(idxv, (j)) * 2048)
#define PE_LOAD8(P, idxv, j0, off)                                                                        \
  P##0 = *(const uint4*)(PE_ROWPTR(idxv, (j0)) + (off)); P##1 = *(const uint4*)(PE_ROWPTR(idxv, (j0) + 1) + (off)); \
  P##2 = *(const uint4*)(PE_ROWPTR(idxv, (j0) + 2) + (off)); P##3 = *(const uint4*)(PE_ROWPTR(idxv, (j0) + 3) + (off)); \
  P##4 = *(const uint4*)(PE_ROWPTR(idxv, (j0) + 4) + (off)); P##5 = *(const uint4*)(PE_ROWPTR(idxv, (j0) + 5) + (off)); \
  P##6 = *(const uint4*)(PE_ROWPTR(idxv, (j0) + 6) + (off)); P##7 = *(const uint4*)(PE_ROWPTR(idxv, (j0) + 7) + (off));
#define PE_DOTSET(P, j0, dv)                                                                              \
  {                                                                                                       \
    const float s0 = wave_sum(dot16_f8(hw, P##0)), s1 = wave_sum(dot16_f8(hw, P##1)),                     \
                s2 = wave_sum(dot16_f8(hw, P##2)), s3 = wave_sum(dot16_f8(hw, P##3)),                     \
                s4 = wave_sum(dot16_f8(hw, P##4)), s5 = wave_sum(dot16_f8(hw, P##5)),                     \
                s6 = wave_sum(dot16_f8(hw, P##6)), s7 = wave_sum(dot16_f8(hw, P##7));                     \
    if (lane == (j0)) dv = s0;                                                                            \
    if (lane == (j0) + 1) dv = s1;                                                                        \
    if (lane == (j0) + 2) dv = s2;                                                                        \
    if (lane == (j0) + 3) dv = s3;                                                                        \
    if (lane == (j0) + 4) dv = s4;                                                                        \
    if (lane == (j0) + 5) dv = s5;                                                                        \
    if (lane == (j0) + 6) dv = s6;                                                                        \
    if (lane == (j0) + 7) dv = s7;                                                                        \
  }
#define PE_AXPYSET(P, j0, av)                                                                             \
  {                                                                                                       \
    axpy16_f8(acc, rdlane_f(av, (j0)), P##0);     axpy16_f8(acc, rdlane_f(av, (j0) + 1), P##1);           \
    axpy16_f8(acc, rdlane_f(av, (j0) + 2), P##2); axpy16_f8(acc, rdlane_f(av, (j0) + 3), P##3);           \
    axpy16_f8(acc, rdlane_f(av, (j0) + 4), P##4); axpy16_f8(acc, rdlane_f(av, (j0) + 5), P##5);           \
    axpy16_f8(acc, rdlane_f(av, (j0) + 6), P##6); axpy16_f8(acc, rdlane_f(av, (j0) + 7), P##7);           \
  }
#define PE_DOT8(idxv, dv)                                                                                 \
  {                                                                                                       \
    uint4 pa0, pa1, pa2, pa3, pa4, pa5, pa6, pa7, pb0, pb1, pb2, pb3, pb4, pb5, pb6, pb7;                 \
    PE_LOAD8(pa, idxv, 0, 0)                                                                              \
    _Pragma("unroll 1") for (int g = 0; g < 4; ++g) {                                                     \
      const int j0 = g * 16;                                                                              \
      PE_LOAD8(pb, idxv, j0 + 8, 0)                                                                       \
      PE_DOTSET(pa, j0, dv)                                                                               \
      if (g < 3) { PE_LOAD8(pa, idxv, j0 + 16, 0) }                                                       \
      PE_DOTSET(pb, j0 + 8, dv)                                                                           \
    }                                                                                                     \
  }
#define PE_AXPY8(idxv, av)                                                                                \
  {                                                                                                       \
    uint4 pa0, pa1, pa2, pa3, pa4, pa5, pa6, pa7, pb0, pb1, pb2, pb3, pb4, pb5, pb6, pb7;                 \
    PE_LOAD8(pa, idxv, 0, 1024)                                                                           \
    _Pragma("unroll 1") for (int g = 0; g < 4; ++g) {                                                     \
      const int j0 = g * 16;                                                                              \
      PE_LOAD8(pb, idxv, j0 + 8, 1024)                                                                    \
      PE_AXPYSET(pa, j0, av)                                                                              \
      if (g < 3) { PE_LOAD8(pa, idxv, j0 + 16, 1024) }                                                    \
      PE_AXPYSET(pb, j0 + 8, av)                                                                          \
    }                                                                                                     \
  }
DEV void peer_expert_tok(const Params& p, int layer, size_t tok, float ga_scale, const int* pi, const float* pg) {
  const int lane = tidx() & 63;
  const int b = (int)(tok / S);
  const int idx_lo = pi[lane], idx_hi = pi[64 + lane];
  const float g_lo = pg[lane], g_hi = pg[64 + lane];
  const float* esc = (const float*)(p.ws + OFF_ESC);
  const float2 sc_lo = *(const float2*)(esc + (size_t)idx_lo * 2), sc_hi = *(const float2*)(esc + (size_t)idx_hi * 2);
  const bf16* hrow = (const bf16*)(p.ws + OFF_H) + tok * 1024 + lane * 16;
  float hw[16];
  unpack8(*(const uint4*)hrow, hw);
  unpack8(*(const uint4*)(hrow + 8), hw + 8);
  const unsigned char* E8 = (const unsigned char*)(p.ws + OFF_E8) + lane * 16;
  float d_lo = 0.f, d_hi = 0.f;
  PE_DOT8(idx_lo, d_lo)
  PE_DOT8(idx_hi, d_hi)
  const float act_lo = g_lo * gelu_tanh(d_lo * sc_lo.x) * sc_lo.y;
  const float act_hi = g_hi * gelu_tanh(d_hi * sc_hi.x) * sc_hi.y;
  float acc[16];
#pragma unroll
  for (int i = 0; i < 16; ++i) acc[i] = 0.f;
  PE_AXPY8(idx_lo, act_lo)
  PE_AXPY8(idx_hi, act_hi)
  const float* ga = (const float*)(p.ws + OFF_MOD) + (layer * 2 + b) * 6144 + 5120 + lane * 16;
  float* xr = p.out + tok * 1024 + lane * 16;
  float xn[16];
  float ss = 0.f;
#pragma unroll
  for (int q4 = 0; q4 < 4; ++q4) {
    float4 xo = *(float4*)(xr + q4 * 4);
    const float4 g4v = *(const float4*)(ga + q4 * 4);
    xo.x += ga_scale * g4v.x * acc[q4 * 4 + 0];
    xo.y += ga_scale * g4v.y * acc[q4 * 4 + 1];
    xo.z += ga_scale * g4v.z * acc[q4 * 4 + 2];
    xo.w += ga_scale * g4v.w * acc[q4 * 4 + 3];
    xn[q4 * 4] = xo.x; xn[q4 * 4 + 1] = xo.y; xn[q4 * 4 + 2] = xo.z; xn[q4 * 4 + 3] = xo.w;
    ss += xo.x * xo.x + xo.y * xo.y + xo.z * xo.z + xo.w * xo.w;
  }
#if PROBE_ANY || REP_MASK
#pragma unroll
  for (int q4 = 0; q4 < 4; ++q4)
    *(float4*)(xr + q4 * 4) = float4{xn[q4 * 4], xn[q4 * 4 + 1], xn[q4 * 4 + 2], xn[q4 * 4 + 3]};
  return;
#endif
  ss = wave_sum(ss);
  const float rn = 1.0f / sqrtf(ss * (1.0f / 1024.f) + 1e-6f);
  if (layer == 0) {
    const float* gn = p.g_attn + 1024 + lane * 16;
    const float* md = (const float*)(p.ws + OFF_MOD) + (2 + b) * 6144 + lane * 16;
    unsigned char* hq = (unsigned char*)(p.ws + OFF_H8) + tok * 1024 + lane * 16;
    float o[16];
    float mx = 0.f;
#pragma unroll
    for (int q4 = 0; q4 < 4; ++q4) {
      *(float4*)(xr + q4 * 4) = float4{xn[q4 * 4], xn[q4 * 4 + 1], xn[q4 * 4 + 2], xn[q4 * 4 + 3]};
      const float4 g4v = *(const float4*)(gn + q4 * 4);
      const float4 s4 = *(const float4*)(md + 1024 + q4 * 4);
      const float4 h4 = *(const float4*)(md + q4 * 4);
      o[q4 * 4] = xn[q4 * 4] * rn * g4v.x * (1.f + s4.x) + h4.x;
      o[q4 * 4 + 1] = xn[q4 * 4 + 1] * rn * g4v.y * (1.f + s4.y) + h4.y;
      o[q4 * 4 + 2] = xn[q4 * 4 + 2] * rn * g4v.z * (1.f + s4.z) + h4.z;
      o[q4 * 4 + 3] = xn[q4 * 4 + 3] * rn * g4v.w * (1.f + s4.w) + h4.w;
      mx = fmaxf(mx, fmaxf(fmaxf(fabsf(o[q4 * 4]), fabsf(o[q4 * 4 + 1])), fmaxf(fabsf(o[q4 * 4 + 2]), fabsf(o[q4 * 4 + 3]))));
    }
#pragma unroll
    for (int of = 32; of >= 1; of >>= 1) mx = fmaxf(mx, shx(mx, of));
    const unsigned qe = e8m0_of(mx);
    const float qs = e8m0_inv(qe);
    uint4 pk;
    pk.x = pack4_fp8(o[0] * qs, o[1] * qs, o[2] * qs, o[3] * qs);
    pk.y = pack4_fp8(o[4] * qs, o[5] * qs, o[6] * qs, o[7] * qs);
    pk.z = pack4_fp8(o[8] * qs, o[9] * qs, o[10] * qs, o[11] * qs);
    pk.w = pack4_fp8(o[12] * qs, o[13] * qs, o[14] * qs, o[15] * qs);
    *(uint4*)hq = pk;
    if (lane == 0) ((unsigned char*)(p.ws + OFF_H8S))[tok] = (unsigned char)qe;
  } else {
    const float* gf = p.g_final + lane * 16;
#pragma unroll
    for (int q4 = 0; q4 < 4; ++q4) {
      const float4 g4v = *(const float4*)(gf + q4 * 4);
      *(float4*)(xr + q4 * 4) = float4{xn[q4 * 4] * rn * g4v.x, xn[q4 * 4 + 1] * rn * g4v.y, xn[q4 * 4 + 2] * rn * g4v.z,
                                       xn[q4 * 4 + 3] * rn * g4v.w};
    }
  }
}

DEV void peer_expert_item2(const Params& p, int layer, int item, float ga_scale = 1.f) {
  const size_t tok = (size_t)item * 4 + (tidx() >> 6);
  peer_expert_tok(p, layer, tok, ga_scale, (const int*)(p.ws + OFF_PEIDX) + tok * 128, (const float*)(p.ws + OFF_PEG) + tok * 128);
}
DEV void peer_fused_item(const Params& p, int layer, int item, char* smem) {
  const int wave = tidx() >> 6;
  int* li = (int*)(smem + wave * 2048);
  float* lg = (float*)(smem + wave * 2048 + 1024);
  peer_topk_item3(p, layer, item, li, lg);
  asm volatile("s_waitcnt lgkmcnt(0)" ::: "memory");
  __builtin_amdgcn_wave_barrier();
  const size_t tok0 = (size_t)item * 8 + wave * 2;
  peer_expert_tok(p, layer, tok0, 1.f, li, lg);
  peer_expert_tok(p, layer, tok0 + 1, 1.f, li + 128, lg + 128);
  asm volatile("s_waitcnt lgkmcnt(0)" ::: "memory");
  __builtin_amdgcn_wave_barrier();
}
namespace g8 {
constexpr int BM = 256, BK = 64, HALF = 128, HTB = HALF * BK * 2, STAGE_BYTES = 8 * HTB, NXCD = 8, WGM = 8;
DEV int lds_byte(int r, int c) { const int st = (r >> 4) * 2 + (c >> 5), rr = r & 15, cc = c & 31, ob = rr * 64 + cc * 2; return st * 1024 + (ob ^ (((ob >> 9) & 1) << 5)); }
DEV void stage_rc(int b, int& R, int& C) { const int st = b / 1024, sb = b % 1024, swz = sb ^ (((sb >> 9) & 1) << 5); R = (st >> 1) * 16 + swz / 64; C = (st & 1) * 32 + (swz % 64) / 2; }
DEV int perm32(int rho) { const int n = rho >> 4, i = rho & 15; return 8 * (i >> 2) + 4 * n + (i & 3); }
struct Unit { int pm, pn; };
struct Gemm { const bf16* A; const bf16* Bt; int M, N, K; const unsigned char* sa = nullptr; const unsigned char* sb = nullptr; };
struct StaticOrder {
  int nM, nN, nwg, G, c;
  DEV void init(int M, int N, int G_, int c_) { nM = M / BM; nN = N / BM; nwg = nM * nN; G = G_; c = c_; }
  DEV bool next(int i, Unit& u) const {
    const long L = (long)i * G + c;
    if (L >= nwg) return false;
    int wgid = (int)L;
    { const int q = nwg / NXCD, r = nwg % NXCD, xcd = wgid % NXCD, off = wgid / NXCD; wgid = (xcd < r ? xcd * (q + 1) : r * (q + 1) + (xcd - r) * q) + off; }
    const int nig = WGM * nN, gid = wgid / nig, fm = gid * WGM, gsz = (nM - fm) < WGM ? (nM - fm) : WGM;
    u.pm = fm + ((wgid % nig) % gsz);
    u.pn = (wgid % nig) / gsz;
    return true;
  }
};
typedef int v4i32_t __attribute__((ext_vector_type(4)));
typedef int v8i32_t __attribute__((ext_vector_type(8)));
template <class Epi, bool F8 = false>
DEV void gemm_phase(LAS unsigned char* lds, const Gemm g, const StaticOrder& S, const Epi& E) {
  int tid = threadIdx.x;
  asm volatile("" : "+v"(tid));
  const int wid = __builtin_amdgcn_readfirstlane(tid >> 6), lane = tid & 63, wr = wid >> 2, wc = wid & 3, fr = lane & 15, fq = lane >> 4;
  const int K = g.K, nt = K / BK;
  unsigned voffA[2], voffB[2];
#pragma unroll
  for (int i = 0; i < 2; ++i) {
    int R, C;
    stage_rc(tid * 16 + i * 8192, R, C);
    const int Rb = Epi::PERM ? ((R & ~31) + perm32(R & 31)) : R;
    voffA[i] = (unsigned)(R * K + C) * 2u;
    voffB[i] = (unsigned)(Rb * K + C) * 2u;
  }
  const size_t kstep = (size_t)(BK * 2);
  const size_t hstep = (size_t)HALF * K * 2;
  const size_t tstep = 2 * hstep;
  const unsigned ldsw = (unsigned)wid * 1024u;
  const int aoff = lds_byte(wr * 64 + fr, fq * 8), boff = lds_byte(wc * 32 + fr, fq * 8);
#define PG8_SA(b, h) (((b) * 2 + (h)) * HTB)
#define PG8_SB(b, h) ((4 + (b) * 2 + (h)) * HTB)
#define PG8_STAGE(bufoff, gbase, voff) do { _Pragma("unroll") for (int _i = 0; _i < 2; ++_i) \
    __builtin_amdgcn_global_load_lds((const unsigned*)((const char*)(gbase) + (voff)[_i]), (LAS unsigned*)(lds + (bufoff) + ldsw + _i * 8192), 16, 0, 0); } while (0)
#define PG8_LD8(dst_, addr_) do { const v4i32_t lo_ = *(const LAS v4i32_t*)(addr_), hi_ = *(const LAS v4i32_t*)((addr_) + 1024); \
    dst_ = __builtin_shufflevector(lo_, hi_, 0, 1, 2, 3, 4, 5, 6, 7); } while (0)
#define PG8_LDA(dst, b, h) do { _Pragma("unroll") for (int m = 0; m < 4; ++m) PG8_LD8(dst[m], lds + PG8_SA(b, h) + aoff + m * 2048); } while (0)
#define PG8_LDB(dst, b, h) do { _Pragma("unroll") for (int n = 0; n < 2; ++n) PG8_LD8(dst[n], lds + PG8_SB(b, h) + boff + n * 2048); } while (0)
#define PG8_LO(x) __builtin_bit_cast(bf16x8, __builtin_shufflevector((x), (x), 0, 1, 2, 3))
#define PG8_HI(x) __builtin_bit_cast(bf16x8, __builtin_shufflevector((x), (x), 4, 5, 6, 7))
#define PG8_STR_(x) #x
#define PG8_STR(x) PG8_STR_(x)
#define PG8_MLO_0 0
#define PG8_MLO_1 1
#define PG8_MLO_2 0
#define PG8_MLO_3 1
#define PG8_MHI_0 0
#define PG8_MHI_1 0
#define PG8_MHI_2 1
#define PG8_MHI_3 1
#define PG8_M1(ai, bj, m, n, At, Bt) do { \
    if constexpr (F8) asm volatile("v_mfma_scale_f32_16x16x128_f8f6f4 %0, %1, %2, %0, %3, %4 op_sel:[" PG8_STR(n) "," PG8_STR(PG8_MLO_##m) ",0] op_sel_hi:[" PG8_STR(bj) "," PG8_STR(PG8_MHI_##m) ",0]" \
                                   : "+v"(acc[ai][bj][m][n]) : "v"(Bt[n]), "v"(At[m]), "v"(scB), "v"(scA[ai])); \
    else { acc[ai][bj][m][n] = __builtin_amdgcn_mfma_f32_16x16x32_bf16(PG8_LO(Bt[n]), PG8_LO(At[m]), acc[ai][bj][m][n], 0, 0, 0); \
           acc[ai][bj][m][n] = __builtin_amdgcn_mfma_f32_16x16x32_bf16(PG8_HI(Bt[n]), PG8_HI(At[m]), acc[ai][bj][m][n], 0, 0, 0); } } while (0)
#define PG8_MMA(ai, bj, At, Bt) do { __builtin_amdgcn_s_setprio(1); \
    PG8_M1(ai, bj, 0, 0, At, Bt); PG8_M1(ai, bj, 0, 1, At, Bt); PG8_M1(ai, bj, 1, 0, At, Bt); PG8_M1(ai, bj, 1, 1, At, Bt); \
    PG8_M1(ai, bj, 2, 0, At, Bt); PG8_M1(ai, bj, 2, 1, At, Bt); PG8_M1(ai, bj, 3, 0, At, Bt); PG8_M1(ai, bj, 3, 1, At, Bt); \
    __builtin_amdgcn_s_setprio(0); } while (0)
#define PG8_WAIT_V(n) asm volatile("s_waitcnt vmcnt(" #n ")" ::: "memory")
#define PG8_WAIT_L(n) asm volatile("s_waitcnt lgkmcnt(" #n ")" ::: "memory")
#define PG8_BAR __builtin_amdgcn_s_barrier()
#define PG8_SCHED __builtin_amdgcn_sched_barrier(0)
  Unit cur, nxt;
  int ui = 0;
  if (!S.next(0, cur)) return;
  f32x4 acc[2][2][4][2];
#pragma unroll
  for (int a = 0; a < 2; ++a)
#pragma unroll
    for (int b = 0; b < 2; ++b)
#pragma unroll
      for (int m = 0; m < 4; ++m)
#pragma unroll
        for (int n = 0; n < 2; ++n) acc[a][b][m][n] = (f32x4){0.f, 0.f, 0.f, 0.f};
  v8i32_t At[4], B0[2], B1[2];
  const char* cA = (const char*)g.A + (size_t)cur.pm * tstep;
  const char* cB = (const char*)g.Bt + (size_t)cur.pn * tstep;
  PG8_STAGE(PG8_SB(0, 0), cB, voffB); PG8_STAGE(PG8_SA(0, 0), cA, voffA); PG8_STAGE(PG8_SB(0, 1), cB + hstep, voffB); PG8_STAGE(PG8_SA(0, 1), cA + hstep, voffA);
  if (wr == 1) PG8_BAR;
  PG8_WAIT_V(4); PG8_BAR;
  PG8_STAGE(PG8_SB(1, 0), cB + kstep, voffB); PG8_STAGE(PG8_SA(1, 0), cA + kstep, voffA); PG8_STAGE(PG8_SB(1, 1), cB + hstep + kstep, voffB);
  PG8_WAIT_V(6); PG8_BAR;
  unsigned scA[2] = {0x7f7f7f7fu, 0x7f7f7f7fu}, scB = 0x7f7f7f7fu;
  for (;;) {
    if constexpr (F8) {
      const unsigned char* ta = g.sa + (size_t)cur.pm * BM + wr * 64 + fr;
      const unsigned char* tb = g.sb + (size_t)cur.pn * BM + wc * 32 + 8 * (fr >> 2) + (fr & 3);
      scA[0] = (unsigned)ta[0] | ((unsigned)ta[16] << 8) | ((unsigned)ta[32] << 16) | ((unsigned)ta[48] << 24);
      scA[1] = (unsigned)ta[HALF] | ((unsigned)ta[HALF + 16] << 8) | ((unsigned)ta[HALF + 32] << 16) | ((unsigned)ta[HALF + 48] << 24);
      scB = (unsigned)tb[0] | ((unsigned)tb[4] << 8) | ((unsigned)tb[HALF] << 16) | ((unsigned)tb[HALF + 4] << 24);
    }
    const bool has_next = S.next(ui + 1, nxt);
    const char* nA = has_next ? (const char*)g.A + (size_t)nxt.pm * tstep : cA;
    const char* nB = has_next ? (const char*)g.Bt + (size_t)nxt.pn * tstep : cB;
#pragma unroll 1
    for (int t = 0; t < nt; t += 2) {
      const bool last = (t == nt - 2);
      const char* a1 = cA + (size_t)(t + 1) * kstep;
      const char* a2 = last ? nA : cA + (size_t)(t + 2) * kstep;
      const char* b2 = last ? nB : cB + (size_t)(t + 2) * kstep;
      const char* a3 = a2 + kstep;
      const char* b3 = b2 + kstep;
      PG8_LDB(B0, 0, 0); PG8_SCHED; PG8_LDA(At, 0, 0); PG8_STAGE(PG8_SA(1, 1), a1 + hstep, voffA);
      PG8_WAIT_L(8); PG8_BAR; PG8_WAIT_L(0); PG8_MMA(0, 0, At, B0); PG8_BAR; PG8_SCHED;
      PG8_LDB(B1, 0, 1); PG8_STAGE(PG8_SB(0, 0), b2, voffB);
      PG8_BAR; PG8_WAIT_L(0); PG8_MMA(0, 1, At, B1); PG8_BAR;
      PG8_LDA(At, 0, 1); PG8_STAGE(PG8_SA(0, 0), a2, voffA);
      PG8_BAR; PG8_WAIT_L(0); PG8_MMA(1, 0, At, B0); PG8_BAR; PG8_SCHED;
      PG8_STAGE(PG8_SB(0, 1), b2 + hstep, voffB);
      PG8_WAIT_V(6); PG8_BAR; PG8_MMA(1, 1, At, B1); PG8_BAR;
      PG8_LDB(B0, 1, 0); PG8_SCHED; PG8_LDA(At, 1, 0); PG8_STAGE(PG8_SA(0, 1), a2 + hstep, voffA);
      PG8_WAIT_L(8); PG8_BAR; PG8_WAIT_L(0); PG8_MMA(0, 0, At, B0); PG8_BAR; PG8_SCHED;
      PG8_LDB(B1, 1, 1); PG8_STAGE(PG8_SB(1, 0), b3, voffB);
      PG8_BAR; PG8_WAIT_L(0); PG8_MMA(0, 1, At, B1); PG8_BAR;
      PG8_LDA(At, 1, 1); PG8_STAGE(PG8_SA(1, 0), a3, voffA);
      PG8_BAR; PG8_WAIT_L(0); PG8_MMA(1, 0, At, B0); PG8_BAR; PG8_SCHED;
      PG8_STAGE(PG8_SB(1, 1), b3 + hstep, voffB);
      PG8_WAIT_V(6); PG8_BAR; PG8_MMA(1, 1, At, B1); PG8_BAR;
    }
    if constexpr (F8) asm volatile("s_nop 15\n\ts_nop 15" ::: "memory");
    E(acc, cur, wr, wc, fr, fq);
    if (!has_next) break;
#pragma unroll
    for (int a = 0; a < 2; ++a)
#pragma unroll
      for (int b = 0; b < 2; ++b)
#pragma unroll
        for (int m = 0; m < 4; ++m)
#pragma unroll
          for (int n = 0; n < 2; ++n) acc[a][b][m][n] = (f32x4){0.f, 0.f, 0.f, 0.f};
    cur = nxt; cA = nA; cB = nB; ++ui;
  }
  PG8_WAIT_V(0);
  if (wr == 0) PG8_BAR;
  PG8_BAR;
#undef PG8_SA
#undef PG8_SB
#undef PG8_STAGE
#undef PG8_LDA
#undef PG8_LDB
#undef PG8_MMA
#undef PG8_M1
#undef PG8_LD8
#undef PG8_LO
#undef PG8_HI
#undef PG8_WAIT_V
#undef PG8_WAIT_L
#undef PG8_BAR
#undef PG8_SCHED
}
DEV unsigned cvt2(float lo, float hi) { unsigned r; asm volatile("v_cvt_pk_bf16_f32 %0, %1, %2" : "=v"(r) : "v"(lo), "v"(hi)); return r; }

struct EpiBf16 {
  static constexpr bool PERM = true;
  bf16* O; int ldc;
  DEV void operator()(const f32x4 (&acc)[2][2][4][2], const Unit& u, int wr, int wc, int fr, int fq) const {
    const int row0 = u.pm * BM + wr * 64 + fr, col0 = u.pn * BM + wc * 32 + 8 * fq;
#pragma unroll
    for (int ai = 0; ai < 2; ++ai)
#pragma unroll
      for (int m = 0; m < 4; ++m) {
        bf16* rowp = O + (size_t)(row0 + ai * HALF + m * 16) * ldc + col0;
#pragma unroll
        for (int bj = 0; bj < 2; ++bj) {
          const f32x4 v0 = acc[ai][bj][m][0], v1 = acc[ai][bj][m][1];
          u32x4_t w;
          w.x = cvt2(v0[0], v0[1]); w.y = cvt2(v0[2], v0[3]); w.z = cvt2(v1[0], v1[1]); w.w = cvt2(v1[2], v1[3]);
          *(u32x4_t*)(rowp + bj * HALF) = w;
        }
      }
  }
};
struct EpiResid {
  static constexpr bool PERM = false;
  const float* xin; float* out; const float* ga;
  DEV void operator()(const f32x4 (&acc)[2][2][4][2], const Unit& u, int wr, int wc, int fr, int fq) const {
    const int row0 = u.pm * BM + wr * 64 + fr, col0 = u.pn * BM + wc * 32 + 4 * fq;
    const int b = (u.pm * BM) / S;
    f32x4 gv[2][2];
#pragma unroll
    for (int bj = 0; bj < 2; ++bj)
#pragma unroll
      for (int n = 0; n < 2; ++n) gv[bj][n] = *(const f32x4*)(ga + b * 6144 + col0 + bj * HALF + n * 16);
#pragma unroll
    for (int ai = 0; ai < 2; ++ai)
#pragma unroll
      for (int m = 0; m < 4; ++m) {
        const size_t off = (size_t)(row0 + ai * HALF + m * 16) * 1024 + col0;
#pragma unroll
        for (int bj = 0; bj < 2; ++bj)
#pragma unroll
          for (int n = 0; n < 2; ++n) {
            const f32x4 xv = *(const f32x4*)(xin + off + bj * HALF + n * 16);
            *(f32x4*)(out + off + bj * HALF + n * 16) = xv + gv[bj][n] * acc[ai][bj][m][n];
          }
      }
  }
};
DEV float sig_(float x) { return 1.f / (1.f + __expf(-x)); }
template <bool SECOND>
struct EpiMerge {
  static constexpr bool PERM = true;
  bf16* Y; const bf16* proj; int gcol;
  DEV void operator()(const f32x4 (&acc)[2][2][4][2], const Unit& u, int wr, int wc, int fr, int fq) const {
    const int row0 = u.pm * BM + wr * 64 + fr, col0 = u.pn * BM + wc * 32 + 8 * fq;
#pragma unroll
    for (int ai = 0; ai < 2; ++ai)
#pragma unroll
      for (int m = 0; m < 4; ++m) {
        const size_t row = (size_t)(row0 + ai * HALF + m * 16);
#pragma unroll
        for (int bj = 0; bj < 2; ++bj) {
          const uint4 gq = *(const uint4*)(proj + row * PC + gcol + col0 + bj * HALF);
          float gf[8];
          unpack8(gq, gf);
          const f32x4 v0 = acc[ai][bj][m][0], v1 = acc[ai][bj][m][1];
          float o[8] = {sig_(gf[0]) * v0[0], sig_(gf[1]) * v0[1], sig_(gf[2]) * v0[2], sig_(gf[3]) * v0[3],
                        sig_(gf[4]) * v1[0], sig_(gf[5]) * v1[1], sig_(gf[6]) * v1[2], sig_(gf[7]) * v1[3]};
          bf16* yp = Y + row * 1024 + col0 + bj * HALF;
          if (SECOND) {
            float yf[8];
            unpack8(*(const uint4*)yp, yf);
#pragma unroll
            for (int j = 0; j < 8; ++j) o[j] += yf[j];
          }
          u32x4_t w;
          w.x = cvt2(o[0], o[1]); w.y = cvt2(o[2], o[3]); w.z = cvt2(o[4], o[5]); w.w = cvt2(o[6], o[7]);
          *(u32x4_t*)yp = w;
        }
      }
  }
};
struct EpiInproj {
  static constexpr bool PERM = true;
  char* ws;
  DEV void operator()(const f32x4 (&acc)[2][2][4][2], const Unit& u, int wr, int wc, int fr, int fq) const {
    const int b = (u.pm * BM) / S;
    const float* rope = (const float*)(ws + OFF_ROPE);
#pragma unroll
    for (int bj = 0; bj < 2; ++bj) {
      const int vcb = u.pn * BM + bj * HALF + wc * 32;
      if (vcb >= 4992) continue;
      const int vc0 = vcb & ~63, inh = vcb & 63;
      bf16* dbase; size_t dstride; bool roped = false; bool headmajor = false; int hh = 0, nh = 1;
      if (vc0 < 768) { dbase = (bf16*)(ws + OFF_PROJ) + vc0; dstride = PC; }
      else if (vc0 < 1280) {
        const int seg = (vc0 - 768) >> 7;
        const size_t off = (seg == 0) ? OFF_KSB : (seg == 1) ? OFF_VSB : (seg == 2) ? OFF_KWB : OFF_VWB;
        dbase = (bf16*)(ws + off); dstride = 64; headmajor = true; hh = ((vc0 - 768) >> 6) & 1; nh = 2;
        roped = (seg == 0) || (seg == 2);
      } else if (vc0 < 1792) { dbase = (bf16*)(ws + OFF_PROJ) + C_MQ + (vc0 - 1280); dstride = PC; roped = true; }
      else if (vc0 < 2816) {
        const int seg = (vc0 - 1792) >> 9;
        dbase = (bf16*)(ws + (seg ? OFF_MVB : OFF_MKB)); dstride = 64; headmajor = true; hh = ((vc0 - 1792) >> 6) & 7; nh = 8;
        roped = (seg == 0);
      } else if (vc0 < 4864) { dbase = (bf16*)(ws + OFF_PROJ) + C_GN + (vc0 - 2816); dstride = PC; }
      else { dbase = (bf16*)(ws + OFF_PROJ) + C_NG + (vc0 - 4864); dstride = PC; }
      const bool do_rope = roped && inh == 0;
#pragma unroll
      for (int ai = 0; ai < 2; ++ai)
#pragma unroll
        for (int m = 0; m < 4; ++m) {
          const int row = u.pm * BM + ai * HALF + wr * 64 + m * 16 + fr;
          const int t = row - b * S;
          const f32x4 v0 = acc[ai][bj][m][0], v1 = acc[ai][bj][m][1];
          float o[8] = {v0[0], v0[1], v0[2], v0[3], v1[0], v1[1], v1[2], v1[3]};
          if (do_rope) {
            float pv[8];
#pragma unroll
            for (int j = 0; j < 8; ++j) pv[j] = shx(o[j], 16);
            const f32x4 c0 = *(const f32x4*)(rope + (size_t)t * 16), c1 = *(const f32x4*)(rope + (size_t)t * 16 + 4);
            const f32x4 s0 = *(const f32x4*)(rope + (size_t)t * 16 + 8), s1 = *(const f32x4*)(rope + (size_t)t * 16 + 12);
            const float cs[8] = {c0[0], c0[1], c0[2], c0[3], c1[0], c1[1], c1[2], c1[3]};
            const float sn[8] = {s0[0], s0[1], s0[2], s0[3], s1[0], s1[1], s1[2], s1[3]};
            const float sg = (fq == 0) ? -1.f : 1.f;
#pragma unroll
            for (int j = 0; j < 8; ++j) o[j] = (fq < 2) ? (o[j] * cs[j] + sg * pv[j] * sn[j]) : o[j];
          }
          bf16* dp = headmajor ? (dbase + ((size_t)(b * nh + hh) * S + t) * 64 + inh + 8 * fq)
                               : (dbase + (size_t)row * dstride + inh + 8 * fq);
          u32x4_t w;
          w.x = cvt2(o[0], o[1]); w.y = cvt2(o[2], o[3]); w.z = cvt2(o[4], o[5]); w.w = cvt2(o[6], o[7]);
          *(u32x4_t*)dp = w;
        }
    }
  }
};
}

template <class F>
DEV void for_tiles_xcd(int MT, int NT, F f) {
  const int nb = vnb(), bid = vbid();
  if ((nb & 15) != 0) {
    for (int it = bid; it < MT * NT; it += nb) f(it / NT, it % NT);
    return;
  }
  const int xcd = (bid >> 1) & 7, slot = ((bid >> 4) << 1) | (bid & 1), nslot = nb >> 3;
  const int nj = (NT - xcd + 7) >> 3;
  for (int q = slot; q < MT * nj; q += nslot) f(q / nj, xcd + 8 * (q % nj));
}
constexpr int PH_PER_LAYER = 15;
enum { SP_NORM1 = 0, SP_INPROJ = 1, SP_COMPRESS = 2, SP_KMEAN = 3, SP_ATTN = 4, SP_MP0 = 5, SP_MM0 = 6, SP_MP1 = 7, SP_MM1 = 8,
       SP_MERGE = 9, SP_OUTPROJ = 10, SP_NORM2 = 11, SP_PEERQ = 12, SP_TOPK = 13, SP_EXPERT = 14 };
constexpr int N_REAL_PHASES = 1 + 2 * PH_PER_LAYER + 1;
constexpr int N_PHASES = N_REAL_PHASES + (PROBE_ANY ? 2 : 0);

DEV void run_phase(const Params& p, int ph, char* smem_raw, bool second_pass = false) {
#define SKIP_MOBA_SECOND (REP_NSA_ONLY && second_pass)
  LAS unsigned char* lds_all = (LAS unsigned char*)smem_raw;
  smem_raw += hidx() * SMEM_BYTES;
  float* smf = (float*)smem_raw;
  bf16* smh = (bf16*)smem_raw;
  const int nb = vnb(), bid = vbid();
  if (ph == 0) {
    for (int it = bid; it < PREP_ITEMS; it += nb) prep_item(p, it, smf);
    return;
  }
  if (ph == N_REAL_PHASES - 1) {
    for (int it = bid; it < T / 4; it += nb) final_norm_item(p.out, p.g_final, it);
    return;
  }
#if PROBE_ANY
  if (ph == N_REAL_PHASES) {
#if PROBE_PROJ
    {
      const unsigned char* Hh = (const unsigned char*)(p.ws + OFF_H8);
      const unsigned char* Wt = (const unsigned char*)(p.ws + OFF_WINT) + (size_t)1 * WN * 1024;
      const unsigned char* hsc = (const unsigned char*)(p.ws + OFF_H8S);
      const unsigned char* wsc = (const unsigned char*)(p.ws + OFF_WCS) + WN;
      const float* rope = (const float*)(p.ws + OFF_ROPE);
      float sd = 0.f, sr = 0.f;
      for (size_t i = (size_t)bid * 256 + tidx(); i < (size_t)(T / 64) * 4888; i += (size_t)nb * 256) {
        const int ts = (int)(i / 4888), vc = (int)(i % 4888);
        const int tok = ts * 64 + (ts % 61);
        const int b = tok / S, t = tok % S;
        auto rawdot = [&](int col) {
          float a = 0.f;
          for (int k = 0; k < 1024; ++k) {
            const f32x2_t hv = __builtin_amdgcn_cvt_pk_f32_fp8((int)Hh[(size_t)tok * 1024 + k], false);
            const f32x2_t wv = __builtin_amdgcn_cvt_pk_f32_fp8((int)Wt[(size_t)col * 1024 + k], false);
            a += hv.x * wv.x;
          }
          return a * __int_as_float((int)hsc[tok] << 23) * __int_as_float((int)wsc[col] << 23);
        };
        float v = rawdot(vc);
        bool roped = false;
        const bf16* dst;
        if (vc < 768) dst = (const bf16*)(p.ws + OFF_PROJ) + (size_t)tok * PC + vc;
        else if (vc < 1280) {
          const int seg = (vc - 768) >> 7, head = ((vc - 768) >> 6) & 1, d = vc & 63;
          const size_t off = (seg == 0) ? OFF_KSB : (seg == 1) ? OFF_VSB : (seg == 2) ? OFF_KWB : OFF_VWB;
          dst = (const bf16*)(p.ws + off) + ((size_t)(b * 2 + head) * S + t) * 64 + d;
          roped = (seg == 0 || seg == 2);
        } else if (vc < 1792) { dst = (const bf16*)(p.ws + OFF_PROJ) + (size_t)tok * PC + C_MQ + (vc - 1280); roped = true; }
        else if (vc < 2816) {
          const int seg = (vc - 1792) >> 9, head = ((vc - 1792) >> 6) & 7, d = vc & 63;
          dst = (const bf16*)(p.ws + (seg ? OFF_MVB : OFF_MKB)) + ((size_t)(b * 8 + head) * S + t) * 64 + d;
          roped = (seg == 0);
        } else if (vc < 4864) dst = (const bf16*)(p.ws + OFF_PROJ) + (size_t)tok * PC + C_GN + (vc - 2816);
        else dst = (const bf16*)(p.ws + OFF_PROJ) + (size_t)tok * PC + C_NG + (vc - 4864);
        const int d = vc & 63;
        if (roped && d < 16) {
          const float cs = rope[(size_t)t * 16 + (d & 7)], sn = rope[(size_t)t * 16 + 8 + (d & 7)];
          if (d < 8) { const float x2 = rawdot(vc + 8); v = v * cs - x2 * sn; }
          else { const float x1 = rawdot(vc - 8); v = v * cs + x1 * sn; }
        }
        const float got = bf2f(*dst);
        const bool is_r = roped && d < 16;
        if (PROBE_PROJ == 1 || (PROBE_PROJ == 2 && is_r) || (PROBE_PROJ == 3 && !is_r)) {
          sd += (got - v) * (got - v);
          sr += v * v;
        }
      }
      sd = wave_sum(sd); sr = wave_sum(sr);
      if ((tidx() & 63) == 0) {
        atomicAdd((float*)(p.ws + OFF_PROBE), sd);
        atomicAdd((float*)(p.ws + OFF_PROBE) + 1, sr);
      }
    }
#endif
#if PROBE_CMPR
    {
      float sd = 0.f, sr = 0.f;
      for (size_t i = (size_t)bid * 256 + tidx(); i < (size_t)2 * Bn * 1024 * 128; i += (size_t)nb * 256) {
        const size_t wh = i / ((size_t)Bn * 1024 * 128), r = i % ((size_t)Bn * 1024 * 128);
        const int c = (int)((r / 128) % 1024);
        if (c < 1023) {
          const float a = ((const float*)(p.ws + (wh ? OFF_VCC : OFF_KCC)))[r];
          const float y = ((const float*)(p.ws + OFF_CMP))[i];
          sd += (a - y) * (a - y);
          sr += y * y;
        }
      }
      sd = wave_sum(sd); sr = wave_sum(sr);
      if ((tidx() & 63) == 0) {
        atomicAdd((float*)(p.ws + OFF_PROBE), sd);
        atomicAdd((float*)(p.ws + OFF_PROBE) + 1, sr);
      }
    }
#endif
#if PROBE_MOBA
    probe_accum_bf16(p, (const bf16*)(p.ws + OFF_OMOBA), (const bf16*)(p.ws + OFF_CMP), (size_t)S * 512, smf);
#endif
#if PROBE_NSA == 8
    {
      const float* impn = (const float*)(p.ws + OFF_OMOBA);
      const float* impm = impn + (size_t)S * 256;
      const int* seld = (const int*)(p.ws + OFF_CMP);
      float sd = 0.f, sr = 0.f, bad = 0.f;
      for (int t = bid * 256 + tidx(); t < S; t += nb * 256) {
        const int cur = t >> 6;
        for (int n = 0; n < 256; ++n) {
          float a = impm[(size_t)t * 256 + n], r = impn[(size_t)t * 256 + n];
          sd += (a - r) * (a - r);
          sr += r * r;
        }
        unsigned want[8] = {0, 0, 0, 0, 0, 0, 0, 0}, got[8] = {0, 0, 0, 0, 0, 0, 0, 0};
        for (int j = 0; j < 16; ++j) {
          int v = seld[(size_t)t * 16 + j];
          if (v >= 0 && v < 256) {
            for (int w = 0; w < 8; ++w) if ((v >> 5) == w) got[w] |= 1u << (v & 31);
          }
        }
        if (cur < 16) {
          for (int n = 0; n <= cur; ++n) want[0] |= 1u << n;
        } else {
          want[0] |= 1u;
          for (int w = 0; w < 8; ++w) {
            if (((cur - 1) >> 5) == w) want[w] |= 1u << ((cur - 1) & 31);
            if ((cur >> 5) == w) want[w] |= 1u << (cur & 31);
          }
          for (int j = 0; j < 13; ++j) {
            float best = -1.f;
            int bi = 1;
            for (int n = 1; n <= cur - 2; ++n) {
              bool taken = false;
              for (int w = 0; w < 8; ++w) if ((n >> 5) == w) taken = (want[w] >> (n & 31)) & 1u;
              float v = impm[(size_t)t * 256 + n];
              if (!taken && v > best) { best = v; bi = n; }
            }
            for (int w = 0; w < 8; ++w) if ((bi >> 5) == w) want[w] |= 1u << (bi & 31);
          }
        }
        bool same = true;
        for (int w = 0; w < 8; ++w) same = same && (want[w] == got[w]);
        if (!same) bad += 1.f;
      }
      sd = wave_sum(sd); sr = wave_sum(sr); bad = wave_sum(bad);
      if ((tidx() & 63) == 0) {
        atomicAdd((float*)(p.ws + OFF_PROBE), sd);
        atomicAdd((float*)(p.ws + OFF_PROBE) + 1, sr);
        atomicAdd((float*)(p.ws + OFF_PROBE) + 2, bad);
      }
    }
#elif PROBE_NSA
    probe_accum_bf16(p, (const bf16*)(p.ws + OFF_ONSA), (const bf16*)(p.ws + OFF_CMP), (size_t)S * 512, smf);
#endif
    return;
  }
  if (ph == N_REAL_PHASES + 1) {
    probe_apply(p);
    return;
  }
#endif
  const int layer = (ph - 1) / PH_PER_LAYER, sub = (ph - 1) % PH_PER_LAYER;
  const float* mod = (const float*)(p.ws + OFF_MOD) + (size_t)layer * 2 * 6144;
  const float* xin = (layer == 0) ? p.x : p.out;
  bf16* H = (bf16*)(p.ws + OFF_H);
  bf16* PROJ = (bf16*)(p.ws + OFF_PROJ);
#if PROBE_ANY
  if (sub >= SP_MERGE) {
    if (sub == SP_OUTPROJ && layer == 0)
      for (size_t i = (size_t)bid * 256 + tidx(); i < (size_t)T * 1024; i += (size_t)nb * 256) p.out[i] = p.x[i];
    return;
  }
#endif
  switch (sub) {
    case SP_NORM1:
      for (int it = bid; it < T / 4; it += nb)
        norm8_item(xin, p.g_attn + layer * 1024, mod + 1024, mod + 0, (unsigned char*)(p.ws + OFF_H8), (unsigned char*)(p.ws + OFF_H8S), it);
      if (layer == 0)
        for (int it = bid; it < WQ8_ITEMS; it += nb) wq8_item(p, it, smf);
      break;
    case SP_INPROJ: {
      g8::StaticOrder so;
      so.init(T, WN, (int)gridDim.x, (int)blockIdx.x);
      g8::gemm_phase<g8::EpiInproj, true>(lds_all, g8::Gemm{(const bf16*)(p.ws + OFF_H8), (const bf16*)(p.ws + OFF_WINT + (size_t)layer * WN * 1024), T, WN, 512,
                                                             (const unsigned char*)(p.ws + OFF_H8S), (const unsigned char*)(p.ws + OFF_WCS) + (size_t)layer * WN},
                                          so, g8::EpiInproj{p.ws});
    } break;
    case SP_COMPRESS:
      for (int it = bid; it < 512 + 1024 + 256; it += nb) {
        if (it < 512) compress_mfma_item(p, layer, it, smem_raw);
        else if (it < 1536) kmean_item(p, it - 512, smf);
        else kvamax_item(p, layer, it - 1536);
      }
#if PROBE_CMPR
      if (layer == 1)
        for (int it = bid; it < 1024; it += nb) compress_item(p, layer, it, smf);
#endif
      break;
    case SP_KMEAN:
      for (int it = bid; it < 1024; it += nb) kvq_item(p, layer, it, smf);
#if PROBE_NSA
      if (layer == 1)
        for (int it = bid; it < 512; it += nb) n1_item(p, layer, it, smf);
#endif
      break;
    case SP_ATTN:
      {
        constexpr int MNI = 2;
        constexpr int NMOBA = 16 * (S / (64 * MNI));
        constexpr int NNI = 2;
        constexpr int NNSA = 4 * (S / (16 * NNI));
        const bool do_nsa = !PROBE_ANY || PROBE_NSA, do_moba = (!PROBE_ANY || PROBE_MOBA) && PROBE_NSA != 8;
        {
          constexpr int NCH = S / (16 * NNI);
          const bool affine = nb >= 8;
          const int grp = bid & 7, bk = grp & 3, sub = grp >> 2;
          const int i0 = affine ? (bid >> 3) : bid;
          const int istride = affine ? ((nb - grp + 7) >> 3) : nb;
          const int icount = affine ? (NCH / 2) : NNSA;
          if (do_nsa)
            for (int i = i0; i < icount; i += istride)
              nsa_item<NNI>(p, layer, affine ? (((2 * i + sub) << 2) | bk) : i, smem_raw, (bf16*)(p.ws + OFF_ONSA));
          if (do_moba && !SKIP_MOBA_SECOND)
            for (int it = bid; it < NMOBA; it += nb) moba_gate_item<MNI>(p, it);
        }
#if PROBE_NSA && PROBE_NSA != 8
        if (layer == 1)
          for (int it = bid; it < 512; it += nb) n23_item(p, layer, it);
#endif
#if PROBE_MOBA
        if (layer == 1) {
          for (int it = bid; it < 512; it += nb) moba_item(p, layer, it);
        }
#endif
      }
      break;
    case SP_MP0:
    case SP_MP1:
      if ((!PROBE_ANY || PROBE_MOBA) && PROBE_NSA != 8)
        for (int it = bid; it < 8 * 63 * 8; it += nb) moba_part_item2<2>(p, sub == SP_MP1 ? 1 : 0, it, smem_raw);
      break;
    case SP_MM0:
    case SP_MM1:
      if ((!PROBE_ANY || PROBE_MOBA) && PROBE_NSA != 8)
        for (int it = bid; it < 8 * (S / 128); it += nb)
          moba_merge_item<2>(p, sub == SP_MM1 ? 1 : 0, it, smem_raw, (bf16*)(p.ws + OFF_OMOBA));
      break;
    case SP_MERGE:
      {
        g8::StaticOrder so;
        so.init(T, 1024, (int)gridDim.x, (int)blockIdx.x);
        g8::gemm_phase(lds_all, g8::Gemm{(const bf16*)(p.ws + OFF_ONSA), (const bf16*)(p.ws + OFF_WUPN) + (size_t)layer * 1024 * 512, T, 1024, 512}, so,
                       g8::EpiMerge<false>{H, PROJ, C_GN});
        g8::gemm_phase(lds_all, g8::Gemm{(const bf16*)(p.ws + OFF_OMOBA), (const bf16*)(p.ws + OFF_WUPM) + (size_t)layer * 1024 * 512, T, 1024, 512}, so,
                       g8::EpiMerge<true>{H, PROJ, C_GM});
      }
      break;
    case SP_OUTPROJ: {
      const bf16* W = (const bf16*)(p.ws + OFF_WOUT) + (size_t)layer * 1024 * 1024;
      const float* ga1 = mod + 2048;
      g8::StaticOrder so;
      so.init(T, 1024, (int)gridDim.x, (int)blockIdx.x);
      g8::gemm_phase(lds_all, g8::Gemm{H, W, T, 1024, 1024}, so, g8::EpiResid{xin, p.out, ga1});
    } break;
    case SP_NORM2:
      for (int it = bid; it < T / 4 + NEXP / 4; it += nb) {
        if (it < T / 4) norm_item(p.out, p.g_ffn + layer * 1024, mod + 4096, mod + 3072, H, it);
        else expert_cvt_item(p, layer, it - T / 4);
      }
      break;
    case SP_PEERQ: {
      const bf16* W = (const bf16*)(p.ws + OFF_WQ) + (size_t)layer * 2048 * 1024;
      bf16* QP = (bf16*)(p.ws + OFF_QP);
      g8::StaticOrder so;
      so.init(T, 2048, (int)gridDim.x, (int)blockIdx.x);
      g8::gemm_phase(lds_all, g8::Gemm{H, W, T, 2048, 1024}, so, g8::EpiBf16{QP, 2048});
    } break;
    case SP_TOPK:
#if REP_MASK
      for (int it = bid; it < T / 8; it += nb) peer_topk_item3(p, layer, it);
#endif
      break;
    case SP_EXPERT:
#if REP_MASK
      for (int it = bid; it < T / 4; it += nb) peer_expert_item2(p, layer, it, second_pass ? 0.f : 1.f);
#else
      for (int it = bid; it < T / 8; it += nb) peer_fused_item(p, layer, it, smem_raw);
#endif
      break;
  }
}

#define MEGA_LB __launch_bounds__(512, 2)
__global__ void MEGA_LB mega_kernel(Params p, int ph_lo, int ph_hi) {
  __shared__ __attribute__((aligned(16))) char smem_raw[2 * SMEM_BYTES + 16];
  volatile LAS unsigned* xbst = (volatile LAS unsigned*)(smem_raw + 2 * SMEM_BYTES);
  if (threadIdx.x == 0) { xbst[0] = 0u; xbst[1] = 0u; xbst[2] = 0u; xbst[3] = 0u; }
  __syncthreads();
  XcdBarrier xb = xcd_barrier_post((unsigned*)(p.ws + OFF_BAR), xbst);
  for (int ph = ph_lo; ph < ph_hi; ++ph) {
#if !PROBE_ANY && !REP_MASK
    if (ph == N_REAL_PHASES - 1 || ph == 1 + PH_PER_LAYER || (ph >= 1 && (ph - 1) % PH_PER_LAYER == SP_TOPK))
      continue;
#endif
#if REP_MASK
    const int nrep = (ph >= 1 && ph < N_REAL_PHASES - 1 && ((REP_MASK >> ((ph - 1) % PH_PER_LAYER)) & 1)) ? 2 : 1;
    for (int rep = 0; rep < nrep; ++rep) {
      if (rep) xcd_barrier(xb);
      run_phase(p, ph, smem_raw, rep != 0);
    }
#else
    run_phase(p, ph, smem_raw);
#endif
    if (ph + 1 < ph_hi) {
      if (ph == ph_lo) cg::this_grid().sync();
      else xcd_barrier(xb);
    }
  }
}

extern "C" void kernel_launch(void* const* d_in, const int* in_sizes, int n_in, void* d_out, int out_size, void* d_ws,
                              size_t ws_size, hipStream_t stream) {
  if (ws_size < WS_TOTAL) {
    fprintf(stderr, "workspace too small: %zu < %zu\n", ws_size, (size_t)WS_NEED);
    return;
  }
  Params p{};
  p.x = (const float*)d_in[0]; p.c = (const float*)d_in[1]; p.w_ada = (const float*)d_in[2];
  p.b_ada = (const float*)d_in[3]; p.g_attn = (const float*)d_in[4]; p.g_ffn = (const float*)d_in[5];
  p.w_in = (const float*)d_in[6]; p.cmp_pe = (const float*)d_in[7]; p.cmp_w1 = (const float*)d_in[8];
  p.cmp_w2 = (const float*)d_in[9]; p.w_up_nsa = (const float*)d_in[10]; p.w_up_moba = (const float*)d_in[11];
  p.w_out = (const float*)d_in[12]; p.peer_wq = (const float*)d_in[13]; p.peer_k1 = (const float*)d_in[14];
  p.peer_k2 = (const float*)d_in[15]; p.peer_u = (const float*)d_in[16]; p.peer_v = (const float*)d_in[17];
  p.g_final = (const float*)d_in[18];
  p.out = (float*)d_out;
  p.ws = (char*)d_ws;
  static int grid_blocks = 0;
  if (!grid_blocks) {
    int dev = 0, cus = 0, per_cu = 0;
    hipGetDevice(&dev);
    hipDeviceGetAttribute(&cus, hipDeviceAttributeMultiprocessorCount, dev);
    hipOccupancyMaxActiveBlocksPerMultiprocessor(&per_cu, mega_kernel, 512, 0);
    if (per_cu < 1) per_cu = 1;
    if (per_cu > 1) per_cu = 1;
    grid_blocks = cus * per_cu;
  }
  hipMemsetAsync((char*)d_ws + OFF_BAR, 0, BAR_BYTES, stream);
  int ph_lo = 0, ph_hi = N_PHASES;
  void* args[] = {(void*)&p, (void*)&ph_lo, (void*)&ph_hi};
  hipError_t e = hipLaunchCooperativeKernel((const void*)mega_kernel, dim3(grid_blocks), dim3(512), args, 0, stream);
  if (e != hipSuccess) fprintf(stderr, "cooperative launch failed: %s (grid %d)\n", hipGetErrorString(e), grid_blocks);
}
```

```cpp
#include <hip/hip_runtime.h>
#include <hip/hip_bf16.h>
#include <hip/hip_cooperative_groups.h>
#include <cstdio>
#include <cstdint>
namespace cg = cooperative_groups;

#define DEV __device__ __forceinline__
typedef unsigned short bf16;
using bf16x8 = __attribute__((ext_vector_type(8))) short;
using f32x4 = __attribute__((ext_vector_type(4))) float;

constexpr int Bn = 2, S = 16384, T = Bn * S, D = 1024;
constexpr int PC = 3456;
constexpr int WN = 5120;
constexpr int C_NQ = 0, C_KC = 512, C_VC = 640, C_MQ = 768, C_GN = 1280, C_GM = 2304, C_NG = 3328;
constexpr int NEXP = 16384;

constexpr size_t al(size_t x) { return (x + 255) & ~size_t(255); }
constexpr size_t OFF_MOD = 0;
constexpr size_t OFF_ROPE = al(OFF_MOD + 2 * 2 * 6144 * 4);
constexpr size_t OFF_PEB = al(OFF_ROPE + (size_t)S * 16 * 4);
constexpr size_t OFF_WINT = al(OFF_PEB + 2 * 2 * 128 * 4);
constexpr size_t OFF_WUPN = al(OFF_WINT + 2ull * WN * 1024 * 2);
constexpr size_t OFF_WUPM = al(OFF_WUPN + 2ull * 1024 * 512 * 2);
constexpr size_t OFF_WOUT = al(OFF_WUPM + 2ull * 1024 * 512 * 2);
constexpr size_t OFF_WQ = al(OFF_WOUT + 2ull * 1024 * 1024 * 2);
constexpr size_t OFF_KCC = al(OFF_WQ + 2ull * 2048 * 1024 * 2);
constexpr size_t OFF_VCC = al(OFF_KCC + 2ull * 1024 * 128 * 4);
constexpr size_t OFF_SEL = al(OFF_VCC + 2ull * 1024 * 128 * 4);
constexpr size_t OFF_KMEAN = al(OFF_SEL + 2ull * 2 * S * 16 * 4);
constexpr size_t OFF_KMHL = al(OFF_KMEAN + 2ull * 8 * 64 * 64 * 4);
constexpr size_t OFF_KCB = al(OFF_KMHL + 2ull * 2 * 8 * 64 * 64 * 2);
constexpr size_t OFF_VCB = al(OFF_KCB + 2ull * 2 * 1024 * 64 * 2);
constexpr size_t OFF_PKB = al(OFF_VCB + 2ull * 2 * 1024 * 64 * 2);
constexpr size_t OFF_W1T = al(OFF_PKB + 2ull * 2 * 128 * 128 * 2);
constexpr size_t OFF_BAR = al(OFF_W1T + 4ull * 128 * 2048 * 2);
constexpr size_t BAR_BYTES = 3456 * 4;
constexpr size_t OFF_PROBE = al(OFF_BAR + BAR_BYTES);
constexpr size_t OFF_H = al(OFF_PROBE + 256);
constexpr size_t OFF_WCS = OFF_WINT + 2ull * WN * 1024;
constexpr size_t OFF_ONSA = al(OFF_H + (size_t)T * 1024 * 2);
constexpr size_t OFF_OMOBA = al(OFF_ONSA + (size_t)T * 512 * 2);
constexpr size_t OFF_H8 = OFF_ONSA;
constexpr size_t OFF_H8S = OFF_OMOBA;
constexpr size_t OFF_PROJ = al(OFF_OMOBA + (size_t)T * 512 * 2);
constexpr size_t KV2_BYTES = (size_t)Bn * 2 * S * 64 * 2, KV8_BYTES = (size_t)Bn * 8 * S * 64 * 2;
constexpr size_t OFF_KSB = al(OFF_PROJ + (size_t)T * PC * 2);
constexpr size_t OFF_VSB = OFF_KSB + KV2_BYTES;
constexpr size_t OFF_KWB = OFF_VSB + KV2_BYTES;
constexpr size_t OFF_VWB = OFF_KWB + KV2_BYTES;
constexpr size_t OFF_MKB = OFF_VWB + KV2_BYTES;
constexpr size_t OFF_MVB = OFF_MKB + KV8_BYTES;
constexpr int MLIST_PER_BH = 63 * S - 128 * 63 * 64;
constexpr size_t OFF_MLIST = OFF_MVB + KV8_BYTES;
constexpr size_t OFF_MCNT = al(OFF_MLIST + (size_t)Bn * 8 * MLIST_PER_BH * 2);
constexpr size_t OFF_KS8 = al(OFF_MCNT + (size_t)Bn * 8 * 64 * 4);
constexpr size_t OFF_VT8 = OFF_KS8 + (size_t)Bn * 2 * S * 64;
constexpr size_t WS_NEED = OFF_VT8 + (size_t)Bn * 2 * S * 64;
constexpr size_t PROJ_BYTES = (size_t)T * PC * 2;
constexpr size_t OFF_MPO = OFF_H;
constexpr size_t OFF_MPML = OFF_H + (size_t)8 * S * 3 * 64 * 2;
static_assert((size_t)8 * S * 3 * 64 * 2 + (size_t)8 * S * 3 * 8 <= (size_t)T * 1024 * 2, "moba partials must fit the H region");
constexpr size_t OFF_QP = OFF_PROJ;
constexpr size_t OFF_PEIDX = al(OFF_QP + (size_t)T * 2048 * 2);
constexpr size_t OFF_PEG = al(OFF_PEIDX + (size_t)T * 128 * 4);
constexpr size_t OFF_E8 = al(OFF_PEG + (size_t)T * 128 * 4);
constexpr size_t OFF_ESC = al(OFF_E8 + (size_t)NEXP * 2048);
static_assert(OFF_ESC + (size_t)NEXP * 2 * 4 <= OFF_PROJ + PROJ_BYTES, "peer alias overflow");
static_assert(WS_NEED <= 536870912ull, "workspace too big");
#ifndef PROBE_MOBA
#define PROBE_MOBA 0
#endif
constexpr size_t OFF_CMP = PROBE_MOBA ? OFF_ONSA : OFF_MLIST;
#ifndef REP_NSA_ONLY
#define REP_NSA_ONLY 0
#endif
#ifndef REP_NSA_PART
#define REP_NSA_PART 0
#endif
#ifndef REP_MASK
#define REP_MASK 0
#endif
#ifndef PROBE_MOBA
#define PROBE_MOBA 0
#endif
#ifndef PROBE_NSA
#define PROBE_NSA 0
#endif
#ifndef PROBE_CMPR
#define PROBE_CMPR 0
#endif
#ifndef PROBE_PROJ
#define PROBE_PROJ 0
#endif
#define PROBE_ANY (PROBE_MOBA || PROBE_NSA || PROBE_CMPR || PROBE_PROJ)
constexpr size_t WS_TOTAL = WS_NEED;
static_assert(WS_TOTAL <= 536870912ull, "workspace too big (probe)");

struct Params {
  const float *x, *c, *w_ada, *b_ada, *g_attn, *g_ffn, *w_in, *cmp_pe, *cmp_w1, *cmp_w2, *w_up_nsa, *w_up_moba, *w_out,
      *peer_wq, *peer_k1, *peer_k2, *peer_u, *peer_v, *g_final;
  float* out;
  char* ws;
};

constexpr int SMEM_BYTES = 74 * 1024;

DEV int tidx() {
  int t = threadIdx.x & 255;
  asm volatile("" : "+v"(t));
  return t;
}
DEV int hidx() { return __builtin_amdgcn_readfirstlane((int)(threadIdx.x >> 8)); }
DEV int vbid() { return (int)blockIdx.x * 2 + hidx(); }
DEV int vnb() { return (int)gridDim.x * 2; }
#define MFMA16B(a, b, c) __builtin_amdgcn_mfma_f32_16x16x32_bf16(a, b, c, 0, 0, 0)
DEV unsigned cvtpk_(float lo, float hi) {
  unsigned r;
  asm("v_cvt_pk_bf16_f32 %0, %1, %2" : "=v"(r) : "v"(lo), "v"(hi));
  return r;
}
DEV float bf2f(bf16 h) { return __uint_as_float(((unsigned)h) << 16); }
DEV bf16 f2bf(float f) {
  unsigned u = __float_as_uint(f);
  u += 0x7fffu + ((u >> 16) & 1u);
  return (bf16)(u >> 16);
}
DEV float gelu_tanh(float x) {
  float u = 0.7978845608028654f * (x + 0.044715f * x * x * x);
  return 0.5f * x * (1.f + tanhf(u));
}
DEV float sigmoidf_(float x) { return 1.f / (1.f + expf(-x)); }
DEV void unpack8(uint4 v, float* f) {
  f[0] = __uint_as_float(v.x << 16); f[1] = __uint_as_float(v.x & 0xffff0000u);
  f[2] = __uint_as_float(v.y << 16); f[3] = __uint_as_float(v.y & 0xffff0000u);
  f[4] = __uint_as_float(v.z << 16); f[5] = __uint_as_float(v.z & 0xffff0000u);
  f[6] = __uint_as_float(v.w << 16); f[7] = __uint_as_float(v.w & 0xffff0000u);
}
DEV float dot64_bf(const float* q, const bf16* row) {
  float s = 0.f;
#pragma unroll
  for (int i = 0; i < 8; ++i) {
    float f[8];
    unpack8(*(const uint4*)(row + i * 8), f);
#pragma unroll
    for (int j = 0; j < 8; ++j) s += q[i * 8 + j] * f[j];
  }
  return s;
}
DEV void axpy64_bf(float* o, float a, const bf16* row) {
#pragma unroll
  for (int i = 0; i < 8; ++i) {
    float f[8];
    unpack8(*(const uint4*)(row + i * 8), f);
#pragma unroll
    for (int j = 0; j < 8; ++j) o[i * 8 + j] += a * f[j];
  }
}
DEV float dot64_f(const float* q, const float* row) {
  float s = 0.f;
#pragma unroll
  for (int i = 0; i < 16; ++i) {
    float4 v = *(const float4*)(row + i * 4);
    s += q[i * 4] * v.x + q[i * 4 + 1] * v.y + q[i * 4 + 2] * v.z + q[i * 4 + 3] * v.w;
  }
  return s;
}
DEV void axpy64_f(float* o, float a, const float* row) {
#pragma unroll
  for (int i = 0; i < 16; ++i) {
    float4 v = *(const float4*)(row + i * 4);
    o[i * 4] += a * v.x; o[i * 4 + 1] += a * v.y; o[i * 4 + 2] += a * v.z; o[i * 4 + 3] += a * v.w;
  }
}
DEV void load_q64(float* q, const bf16* p, float scale) {
#pragma unroll
  for (int i = 0; i < 8; ++i) unpack8(*(const uint4*)(p + i * 8), q + i * 8);
#pragma unroll
  for (int i = 0; i < 64; ++i) q[i] *= scale;
}
DEV int lane_id_() { return __builtin_amdgcn_mbcnt_hi(~0u, __builtin_amdgcn_mbcnt_lo(~0u, 0u)); }
DEV int shx(int v, int m) {
  if (m == 1) return __builtin_amdgcn_update_dpp(0, v, 0xB1, 0xF, 0xF, true);
  if (m == 2) return __builtin_amdgcn_update_dpp(0, v, 0x4E, 0xF, 0xF, true);
  if (m == 4) return __builtin_amdgcn_ds_swizzle(v, 0x101F);
  if (m == 8) return __builtin_amdgcn_update_dpp(0, v, 0x128, 0xF, 0xF, true);
  if (m == 16) return __builtin_amdgcn_ds_swizzle(v, 0x401F);
  auto rr = __builtin_amdgcn_permlane32_swap((unsigned)v, (unsigned)v, false, false);
  return (lane_id_() < 32) ? (int)rr[1] : (int)rr[0];
}
DEV unsigned shx(unsigned v, int m) { return (unsigned)shx((int)v, m); }
DEV float shx(float v, int m) { return __int_as_float(shx(__float_as_int(v), m)); }
DEV float wave_sum(float v) {
#pragma unroll
  for (int o = 32; o >= 1; o >>= 1) v += shx(v, o);
  return v;
}

#define XB_TMO      128
#define XB_XCNT(j)  (256  + 64 * (j))
#define XB_XSUB(j)  (1280 + 64 * (j))
#define XB_XGEN(j)  (2304 + 64 * (j))
#define XB_TOP      3328
#define XB_TOPGEN   3392
#define XCD_BAR_WORDS 3456
#define XB_SPIN_CAP (1u << 18)
#define LAS __attribute__((address_space(3)))

__device__ __forceinline__ unsigned xb_ld(unsigned* p)              { return __hip_atomic_load(p, __ATOMIC_RELAXED, __HIP_MEMORY_SCOPE_AGENT); }
__device__ __forceinline__ unsigned xb_add(unsigned* p, unsigned v) { return __hip_atomic_fetch_add(p, v, __ATOMIC_RELAXED, __HIP_MEMORY_SCOPE_AGENT); }
__device__ __forceinline__ unsigned xb_xcc_id() { return (unsigned)__builtin_amdgcn_s_getreg((3 << 11) | 20) & 0xFu; }
#define XB_SPIN(cond, bar) do { unsigned _sp = 0; while (cond) { __builtin_amdgcn_s_sleep(1); \
    if ((++_sp & 255u) == 0u) { if (xb_ld(&(bar)[XB_TMO])) break; if (_sp > XB_SPIN_CAP) { atomicAdd(&(bar)[XB_TMO], 1u); break; } } } } while (0)

struct XcdBarrier {
    unsigned* bar; unsigned x;
    volatile LAS unsigned* st;
};

__device__ __forceinline__ XcdBarrier xcd_barrier_post(unsigned* bar, volatile LAS unsigned* st) {
    XcdBarrier b; b.bar = bar; b.x = xb_xcc_id(); b.st = st;
    if (threadIdx.x == 0) (void)xb_add(&bar[XB_XCNT(b.x)], 1u);
    return b;
}
__device__ __forceinline__ void xcd_barrier_complete(unsigned* bar, unsigned x, unsigned& nloc, unsigned& nx) {
    const unsigned G = gridDim.x * gridDim.y * gridDim.z;
    unsigned sum, cnt, mine, sp = 0u;
    for (;;) {
        sum = 0u; cnt = 0u; mine = 0u;
#pragma unroll
        for (unsigned j = 0; j < 16; ++j) { const unsigned c = xb_ld(&bar[XB_XCNT(j)]); sum += c; cnt += (c > 0u) ? 1u : 0u; mine = (j == x) ? c : mine; }
        if (sum == G) break;
        __builtin_amdgcn_s_sleep(1);
        if ((++sp & 255u) == 0u) { if (xb_ld(&bar[XB_TMO])) break; if (sp > XB_SPIN_CAP) { atomicAdd(&bar[XB_TMO], 1u); break; } }
    }
    nloc = mine > 0u ? mine : 1u; nx = cnt > 0u ? cnt : 1u;
}

__device__ __forceinline__ void xcd_barrier(const XcdBarrier& b) {
    asm volatile("s_waitcnt vmcnt(0)" ::: "memory");
    __syncthreads();
    if (threadIdx.x == 0) {
        unsigned* bar = b.bar;
        __builtin_amdgcn_s_waitcnt(0);
        unsigned nloc = b.st[0], nx = b.st[1];
        if (nloc == 0u) { xcd_barrier_complete(bar, b.x, nloc, nx); b.st[0] = nloc; b.st[1] = nx; }
        const unsigned old = xb_add(&bar[XB_XSUB(b.x)], 1u);
        const unsigned gen = old / nloc;
        if (old + 1u == (gen + 1u) * nloc) {
            __builtin_amdgcn_fence(__ATOMIC_RELEASE, "agent");
            asm volatile("s_waitcnt vmcnt(0)" ::: "memory");
            const unsigned og = xb_add(&bar[XB_TOP], 1u);
            const unsigned tg = og / nx;
            if (og + 1u == (tg + 1u) * nx) xb_add(&bar[XB_TOPGEN], 1u);
            else XB_SPIN(xb_ld(&bar[XB_TOPGEN]) == tg, bar);
            __builtin_amdgcn_fence(__ATOMIC_ACQUIRE, "agent");
            xb_add(&bar[XB_XGEN(b.x)], 1u);
            asm volatile("s_waitcnt vmcnt(0)" ::: "memory");
        } else {
            XB_SPIN(xb_ld(&bar[XB_XGEN(b.x)]) == gen, bar);
            __builtin_amdgcn_fence(__ATOMIC_ACQUIRE, "agent");
            asm volatile("s_waitcnt vmcnt(0)" ::: "memory");
        }
    }
    __syncthreads();
}


DEV int win_col_map(int j) {
  if (j < 1280) return j;
  if (j < 4864) return j + 24;
  if (j < 4888) return j - 4864 + 1280;
  return -1;
}
DEV void tr_tile(const float* __restrict__ src, int ldsrc, int K, bf16* __restrict__ dst, int kt, int nt, bool remap,
                 float* sm) {
  const int tid = tidx();
#pragma unroll 4
  for (int i = 0; i < 16; ++i) {
    int r = i * 4 + (tid >> 6), cx = tid & 63;
    int j = nt * 64 + cx, k = kt * 64 + r;
    int oc = remap ? win_col_map(j) : j;
    sm[r * 65 + cx] = (oc >= 0) ? src[(size_t)k * ldsrc + oc] : 0.f;
  }
  __syncthreads();
#pragma unroll 4
  for (int i = 0; i < 16; ++i) {
    int n = i * 4 + (tid >> 6), kk = tid & 63;
    dst[(size_t)(nt * 64 + n) * K + kt * 64 + kk] = f2bf(sm[kk * 65 + n]);
  }
  __syncthreads();
}

DEV unsigned e8m0_of(float amax) {
  const unsigned bits = (unsigned)__float_as_int(amax * (1.f / 224.f));
  unsigned e = ((bits >> 23) & 255u) + ((bits & 0x7fffffu) ? 1u : 0u);
  return e < 1u ? 1u : (e > 253u ? 253u : e);
}
DEV float e8m0_inv(unsigned e) { return __int_as_float((int)((254u - e) << 23)); }
DEV unsigned pack4_fp8_(float a, float b, float c, float d) {
  int q = __builtin_amdgcn_cvt_pk_fp8_f32(a, b, 0, false);
  q = __builtin_amdgcn_cvt_pk_fp8_f32(c, d, q, true);
  return (unsigned)q;
}
DEV void wamax_item(const Params& p, int item) {
  const int l = item >> 7, part = item & 127;
  const size_t per = (size_t)1024 * 4888 / 128;
  const float4* src = (const float4*)(p.w_in + (size_t)l * 1024 * 4888 + (size_t)part * per);
  float m = 0.f;
  for (int i = tidx(); i < (int)(per / 4); i += 256) {
    const float4 v = src[i];
    m = fmaxf(m, fmaxf(fmaxf(fabsf(v.x), fabsf(v.y)), fmaxf(fabsf(v.z), fabsf(v.w))));
  }
#pragma unroll
  for (int o = 32; o >= 1; o >>= 1) m = fmaxf(m, shx(m, o));
  if ((tidx() & 63) == 0) atomicMax((unsigned*)(p.ws + OFF_BAR) + l, (unsigned)__float_as_int(m));
}
DEV void wq8_item(const Params& p, int item, float* sm) {
  const int tid = tidx();
  const int l = item / (80 * 16), r_ = item % (80 * 16);
  const int nt = r_ / 16, kt = r_ % 16;
  const float* src = p.w_in + (size_t)l * 1024 * 4888;
  unsigned char* dst = (unsigned char*)(p.ws + OFF_WINT) + (size_t)l * WN * 1024;
  const unsigned e = e8m0_of(__int_as_float((int)__hip_atomic_load((const unsigned*)(p.ws + OFF_BAR) + l, __ATOMIC_RELAXED, __HIP_MEMORY_SCOPE_AGENT)));
  const float s = e8m0_inv(e);
#pragma unroll 4
  for (int i = 0; i < 16; ++i) {
    const int r = i * 4 + (tid >> 6), cx = tid & 63;
    const int oc = win_col_map(nt * 64 + cx);
    sm[r * 65 + cx] = (oc >= 0) ? src[(size_t)(kt * 64 + r) * 4888 + oc] : 0.f;
  }
  __syncthreads();
  const int kq = tid & 15;
#pragma unroll
  for (int i = 0; i < 4; ++i) {
    const int n = i * 16 + (tid >> 4);
    const float v0 = sm[(kq * 4 + 0) * 65 + n], v1 = sm[(kq * 4 + 1) * 65 + n], v2 = sm[(kq * 4 + 2) * 65 + n], v3 = sm[(kq * 4 + 3) * 65 + n];
    *(unsigned*)(dst + (size_t)(nt * 64 + n) * 1024 + kt * 64 + kq * 4) = pack4_fp8_(v0 * s, v1 * s, v2 * s, v3 * s);
  }
  if (kt == 0 && tid < 64) ((unsigned char*)(p.ws + OFF_WCS))[(size_t)l * WN + nt * 64 + tid] = (unsigned char)e;
  __syncthreads();
}
constexpr int WQ8_ITEMS = 2 * 80 * 16;
constexpr int PREP_TR_WIN = 2 * 128;
constexpr int PREP_TR_UPN = 2 * 16 * 8;
constexpr int PREP_TR_UPM = 2 * 16 * 8;
constexpr int PREP_TR_OUT = 2 * 16 * 16;
constexpr int PREP_TR_WQ = 2 * 32 * 16;
constexpr int PREP_ROPE = 512;
constexpr int PREP_MOD = 384;
constexpr int PREP_PEB = 16;
constexpr int PREP_PK = 32;
constexpr int PREP_TR_W1 = 4 * 2 * 32;
constexpr int PREP_ITEMS = PREP_TR_WIN + PREP_TR_UPN + PREP_TR_UPM + PREP_TR_OUT + PREP_TR_WQ + PREP_ROPE + PREP_MOD + PREP_PEB + PREP_PK + PREP_TR_W1;

DEV void prep_item(const Params& p, int item, float* sm) {
  const int tid = tidx();
  if (item < PREP_TR_WIN) {
    wamax_item(p, item);
    return;
  }
  item -= PREP_TR_WIN;
  if (item < PREP_TR_UPN) {
    int l = item / 128, r = item % 128;
    int nt = r / 8, kt = r % 8;
    tr_tile(p.w_up_nsa + (size_t)l * 512 * 1024, 1024, 512, (bf16*)(p.ws + OFF_WUPN) + (size_t)l * 1024 * 512, kt, nt, false, sm);
    return;
  }
  item -= PREP_TR_UPN;
  if (item < PREP_TR_UPM) {
    int l = item / 128, r = item % 128;
    int nt = r / 8, kt = r % 8;
    tr_tile(p.w_up_moba + (size_t)l * 512 * 1024, 1024, 512, (bf16*)(p.ws + OFF_WUPM) + (size_t)l * 1024 * 512, kt, nt, false, sm);
    return;
  }
  item -= PREP_TR_UPM;
  if (item < PREP_TR_OUT) {
    int l = item / 256, r = item % 256;
    int nt = r / 16, kt = r % 16;
    tr_tile(p.w_out + (size_t)l * 1024 * 1024, 1024, 1024, (bf16*)(p.ws + OFF_WOUT) + (size_t)l * 1024 * 1024, kt, nt, false, sm);
    return;
  }
  item -= PREP_TR_OUT;
  if (item < PREP_TR_WQ) {
    int l = item / 512, r = item % 512;
    int nt = r / 16, kt = r % 16;
    tr_tile(p.peer_wq + (size_t)l * 1024 * 2048, 2048, 1024, (bf16*)(p.ws + OFF_WQ) + (size_t)l * 2048 * 1024, kt, nt, false, sm);
    return;
  }
  item -= PREP_TR_WQ;
  if (item < PREP_ROPE) {
    int idx = item * 256 + tid;
    int pos = idx >> 3, i = idx & 7;
    float inv = powf(500000.0f, -(float)i / 8.0f);
    float ang = (float)pos * inv;
    float* rp = (float*)(p.ws + OFF_ROPE) + (size_t)pos * 16;
    rp[i] = cosf(ang);
    rp[8 + i] = sinf(ang);
    return;
  }
  item -= PREP_ROPE;
  if (item < PREP_MOD) {
    for (int i = tid; i < 2048; i += 256) {
      float cv = p.c[i];
      sm[i] = cv / (1.f + expf(-cv));
    }
    __syncthreads();
    const int l = item / 192, n0 = (item % 192) * 32;
    const int col = tid & 31, ks = tid >> 5;
    const float* w = p.w_ada + (size_t)l * 1024 * 6144 + n0 + col;
    float a0 = 0.f, a1 = 0.f;
#pragma unroll 8
    for (int k = ks * 128; k < ks * 128 + 128; ++k) {
      float wv = w[(size_t)k * 6144];
      a0 += sm[k] * wv;
      a1 += sm[1024 + k] * wv;
    }
    sm[2048 + tid * 2] = a0;
    sm[2048 + tid * 2 + 1] = a1;
    __syncthreads();
    if (tid < 64) {
      const int c2 = tid & 31, bs = tid >> 5;
      float s = 0.f;
#pragma unroll
      for (int q = 0; q < 8; ++q) s += sm[2048 + (q * 32 + c2) * 2 + bs];
      ((float*)(p.ws + OFF_MOD))[(l * 2 + bs) * 6144 + n0 + c2] = s + p.b_ada[l * 6144 + n0 + c2];
    }
    __syncthreads();
    return;
  }
  item -= PREP_MOD;
  if (item < PREP_PEB) {
    const int lw = item >> 2, j0 = (item & 3) * 32;
    const int col = tid & 31, ks = tid >> 5;
    const float* pe = p.cmp_pe + (size_t)lw * 2048;
    const float* w1 = p.cmp_w1 + (size_t)lw * 2048 * 128 + j0 + col;
    float a = 0.f;
#pragma unroll 8
    for (int i = ks * 256; i < ks * 256 + 256; ++i) a += pe[i] * w1[(size_t)i * 128];
    sm[tid] = a;
    __syncthreads();
    if (tid < 32) {
      float s = 0.f;
#pragma unroll
      for (int q = 0; q < 8; ++q) s += sm[q * 32 + tid];
      ((float*)(p.ws + OFF_PEB))[lw * 128 + j0 + tid] = s;
    }
    if (item == 0 && tid < 4) ((float*)(p.ws + OFF_PROBE))[tid] = 0.f;
    __syncthreads();
    return;
  }
  item -= PREP_PEB;
  if (item < PREP_PK) {
    const int e0 = item * 2048 + tid * 8;
    const int lt = e0 >> 14, off = e0 & 16383;
    const float* srcp = ((lt & 1) ? p.peer_k2 : p.peer_k1) + (size_t)(lt >> 1) * 16384 + off;
    const float4 a = *(const float4*)srcp, b4 = *(const float4*)(srcp + 4);
    uint4 pk;
    pk.x = (unsigned)f2bf(a.x) | ((unsigned)f2bf(a.y) << 16);
    pk.y = (unsigned)f2bf(a.z) | ((unsigned)f2bf(a.w) << 16);
    pk.z = (unsigned)f2bf(b4.x) | ((unsigned)f2bf(b4.y) << 16);
    pk.w = (unsigned)f2bf(b4.z) | ((unsigned)f2bf(b4.w) << 16);
    *(uint4*)((bf16*)(p.ws + OFF_PKB) + e0) = pk;
    return;
  }
  item -= PREP_PK;
  {
    const int lw = item >> 6, r = item & 63;
    const int nt = r >> 5, kt = r & 31;
    tr_tile(p.cmp_w1 + (size_t)lw * 2048 * 128, 128, 2048, (bf16*)(p.ws + OFF_W1T) + (size_t)lw * 128 * 2048, kt, nt, false, sm);
  }
}

DEV void norm_item(const float* __restrict__ xin, const float* __restrict__ g, const float* __restrict__ sc,
                   const float* __restrict__ sh, bf16* __restrict__ hout, int item) {
  const int lane = tidx() & 63, wave = tidx() >> 6;
  const size_t tok = (size_t)item * 4 + wave;
  const int b = (int)(tok / S);
  const float* xr = xin + tok * 1024;
  float4 v[4];
  float ss = 0.f;
#pragma unroll
  for (int i = 0; i < 4; ++i) {
    v[i] = *(const float4*)(xr + i * 256 + lane * 4);
    ss += v[i].x * v[i].x + v[i].y * v[i].y + v[i].z * v[i].z + v[i].w * v[i].w;
  }
  ss = wave_sum(ss);
  float r = 1.0f / sqrtf(ss * (1.0f / 1024.f) + 1e-6f);
#pragma unroll
  for (int i = 0; i < 4; ++i) {
    int d = i * 256 + lane * 4;
    float4 gg = *(const float4*)(g + d);
    float4 s4 = *(const float4*)(sc + b * 6144 + d);
    float4 h4 = *(const float4*)(sh + b * 6144 + d);
    float o0 = v[i].x * r * gg.x * (1.f + s4.x) + h4.x;
    float o1 = v[i].y * r * gg.y * (1.f + s4.y) + h4.y;
    float o2 = v[i].z * r * gg.z * (1.f + s4.z) + h4.z;
    float o3 = v[i].w * r * gg.w * (1.f + s4.w) + h4.w;
    uint2 pk;
    pk.x = (unsigned)f2bf(o0) | ((unsigned)f2bf(o1) << 16);
    pk.y = (unsigned)f2bf(o2) | ((unsigned)f2bf(o3) << 16);
    *(uint2*)(hout + tok * 1024 + d) = pk;
  }
}
DEV void norm8_item(const float* __restrict__ xin, const float* __restrict__ g, const float* __restrict__ sc,
                    const float* __restrict__ sh, unsigned char* __restrict__ hout, unsigned char* __restrict__ hscale, int item) {
  const int lane = tidx() & 63, wave = tidx() >> 6;
  const size_t tok = (size_t)item * 4 + wave;
  const int b = (int)(tok / S);
  const float* xr = xin + tok * 1024;
  float4 v[4];
  float ss = 0.f;
#pragma unroll
  for (int i = 0; i < 4; ++i) {
    v[i] = *(const float4*)(xr + i * 256 + lane * 4);
    ss += v[i].x * v[i].x + v[i].y * v[i].y + v[i].z * v[i].z + v[i].w * v[i].w;
  }
  ss = wave_sum(ss);
  float r = 1.0f / sqrtf(ss * (1.0f / 1024.f) + 1e-6f);
  float mx = 0.f;
#pragma unroll
  for (int i = 0; i < 4; ++i) {
    int d = i * 256 + lane * 4;
    float4 gg = *(const float4*)(g + d);
    float4 s4 = *(const float4*)(sc + b * 6144 + d);
    float4 h4 = *(const float4*)(sh + b * 6144 + d);
    v[i].x = v[i].x * r * gg.x * (1.f + s4.x) + h4.x;
    v[i].y = v[i].y * r * gg.y * (1.f + s4.y) + h4.y;
    v[i].z = v[i].z * r * gg.z * (1.f + s4.z) + h4.z;
    v[i].w = v[i].w * r * gg.w * (1.f + s4.w) + h4.w;
    mx = fmaxf(mx, fmaxf(fmaxf(fabsf(v[i].x), fabsf(v[i].y)), fmaxf(fabsf(v[i].z), fabsf(v[i].w))));
  }
#pragma unroll
  for (int o = 32; o >= 1; o >>= 1) mx = fmaxf(mx, shx(mx, o));
  const unsigned e = e8m0_of(mx);
  const float s = e8m0_inv(e);
#pragma unroll
  for (int i = 0; i < 4; ++i)
    *(unsigned*)(hout + tok * 1024 + i * 256 + lane * 4) = pack4_fp8_(v[i].x * s, v[i].y * s, v[i].z * s, v[i].w * s);
  if (lane == 0) hscale[tok] = (unsigned char)e;
}
DEV void final_norm_item(float* __restrict__ x, const float* __restrict__ g, int item) {
  const int lane = tidx() & 63, wave = tidx() >> 6;
  const size_t tok = (size_t)item * 4 + wave;
  float* xr = x + tok * 1024;
  float4 v[4];
  float ss = 0.f;
#pragma unroll
  for (int i = 0; i < 4; ++i) {
    v[i] = *(const float4*)(xr + i * 256 + lane * 4);
    ss += v[i].x * v[i].x + v[i].y * v[i].y + v[i].z * v[i].z + v[i].w * v[i].w;
  }
  ss = wave_sum(ss);
  float r = 1.0f / sqrtf(ss * (1.0f / 1024.f) + 1e-6f);
#pragma unroll
  for (int i = 0; i < 4; ++i) {
    int d = i * 256 + lane * 4;
    float4 gg = *(const float4*)(g + d);
    float4 o;
    o.x = v[i].x * r * gg.x; o.y = v[i].y * r * gg.y; o.z = v[i].z * r * gg.z; o.w = v[i].w * r * gg.w;
    *(float4*)(xr + d) = o;
  }
}

#define GM_BUF (2 * 128 * 72)
#define GM_LOAD(R, kk)                                                                                  \
  {                                                                                                     \
    const bf16* Ak = Ap + (kk);                                                                         \
    const bf16* Wk = Wp + (kk);                                                                         \
    R##a0 = *(const uint4*)(Ak); R##a1 = *(const uint4*)(Ak + a32); R##a2 = *(const uint4*)(Ak + 2 * a32); \
    R##a3 = *(const uint4*)(Ak + 3 * a32);                                                              \
    R##b0 = *(const uint4*)(Wk); R##b1 = *(const uint4*)(Wk + w32); R##b2 = *(const uint4*)(Wk + 2 * w32); \
    R##b3 = *(const uint4*)(Wk + 3 * w32);                                                              \
  }
#define GM_STORE(R, buf)                                                                                \
  {                                                                                                     \
    bf16* as_ = Asw + (buf) * GM_BUF;                                                                   \
    bf16* bs_ = as_ + 128 * 72;                                                                         \
    *(uint4*)(as_) = R##a0; *(uint4*)(as_ + 32 * 72) = R##a1; *(uint4*)(as_ + 64 * 72) = R##a2; *(uint4*)(as_ + 96 * 72) = R##a3; \
    *(uint4*)(bs_) = R##b0; *(uint4*)(bs_ + 32 * 72) = R##b1; *(uint4*)(bs_ + 64 * 72) = R##b2; *(uint4*)(bs_ + 96 * 72) = R##b3; \
  }
#define GM_COMPUTE(buf)                                                                                 \
  {                                                                                                     \
    const bf16* As_ = sm + (buf) * GM_BUF;                                                              \
    const bf16* Bs_ = As_ + 128 * 72;                                                                   \
    _Pragma("unroll") for (int ks = 0; ks < 2; ++ks) {                                                  \
      __builtin_amdgcn_sched_barrier(0);                                                                \
      bf16x8 af[4], bfr[4];                                                                             \
      _Pragma("unroll") for (int mi = 0; mi < 4; ++mi)                                                  \
        af[mi] = *(const bf16x8*)(As_ + (wr * 64 + mi * 16 + (lane & 15)) * 72 + ks * 32 + (lane >> 4) * 8); \
      _Pragma("unroll") for (int ni = 0; ni < 4; ++ni)                                                  \
        bfr[ni] = *(const bf16x8*)(Bs_ + (wc * 64 + ni * 16 + (lane & 15)) * 72 + ks * 32 + (lane >> 4) * 8); \
      _Pragma("unroll") for (int mi = 0; mi < 4; ++mi)                                                  \
        _Pragma("unroll") for (int ni = 0; ni < 4; ++ni)                                                \
          acc[mi][ni] = __builtin_amdgcn_mfma_f32_16x16x32_bf16(af[mi], bfr[ni], acc[mi][ni], 0, 0, 0); \
    }                                                                                                   \
    __builtin_amdgcn_sched_barrier(0);                                                                  \
  }
DEV void gemm_mainloop(const bf16* __restrict__ A, int lda, const bf16* __restrict__ W, int K, int m0, int n0, bf16* sm,
                       f32x4 (&acc)[4][4]) {
  const int tid = tidx(), lane = tid & 63, wave = tid >> 6;
  const int wr = wave >> 1, wc = wave & 1;
  const int lrow = tid >> 3, lkc = (tid & 7) * 8;
  const bf16* Ap = A + (size_t)(m0 + lrow) * lda + lkc;
  const bf16* Wp = W + (size_t)(n0 + lrow) * K + lkc;
  const int a32 = 32 * lda, w32 = 32 * K;
  bf16* Asw = sm + lrow * 72 + lkc;
  uint4 xa0, xa1, xa2, xa3, xb0, xb1, xb2, xb3, ya0, ya1, ya2, ya3, yb0, yb1, yb2, yb3;
  const int nk = K >> 6;
  GM_LOAD(x, 0)
  GM_LOAD(y, 64)
  __syncthreads();
  GM_STORE(x, 0)
  if (nk > 2) GM_LOAD(x, 128)
  __syncthreads();
  for (int k = 0; k < nk; k += 2) {
    GM_COMPUTE(0)
    GM_STORE(y, 1)
    if (k + 3 < nk) GM_LOAD(y, (k + 3) * 64)
    __syncthreads();
    GM_COMPUTE(1)
    if (k + 2 < nk) {
      GM_STORE(x, 0)
      if (k + 4 < nk) GM_LOAD(x, (k + 4) * 64)
    }
    __syncthreads();
  }
}
DEV void gemm256_mainloop(const bf16* __restrict__ A, int lda, const bf16* __restrict__ W, int K, int m0, int n0, bf16* sm,
                          f32x4 (&acc)[2][4][4]) {
  bf16* As = sm;
  bf16* Bs = sm + 256 * 72;
  const int tid = tidx(), lane = tid & 63, wave = tid >> 6;
  const int wr = wave >> 1, wc = wave & 1;
  const int lrow = tid >> 3, lkc = (tid & 7) * 8;
  const bf16* Ap = A + (size_t)(m0 + lrow) * lda + lkc;
  const bf16* Wp = W + (size_t)(n0 + lrow) * K + lkc;
  const int a32 = 32 * lda, w32 = 32 * K;
  uint4 ra0, ra1, ra2, ra3, ra4, ra5, ra6, ra7, rb0, rb1, rb2, rb3;
#define G256_LOAD(kk)                                                                                   \
  {                                                                                                     \
    const bf16* Ak = Ap + (kk);                                                                         \
    const bf16* Wk = Wp + (kk);                                                                         \
    ra0 = *(const uint4*)(Ak); ra1 = *(const uint4*)(Ak + a32); ra2 = *(const uint4*)(Ak + 2 * a32);    \
    ra3 = *(const uint4*)(Ak + 3 * a32); ra4 = *(const uint4*)(Ak + 4 * a32); ra5 = *(const uint4*)(Ak + 5 * a32); \
    ra6 = *(const uint4*)(Ak + 6 * a32); ra7 = *(const uint4*)(Ak + 7 * a32);                           \
    rb0 = *(const uint4*)(Wk); rb1 = *(const uint4*)(Wk + w32); rb2 = *(const uint4*)(Wk + 2 * w32);    \
    rb3 = *(const uint4*)(Wk + 3 * w32);                                                                \
  }
  G256_LOAD(0)
  bf16* Asw = As + lrow * 72 + lkc;
  bf16* Bsw = Bs + lrow * 72 + lkc;
  for (int k0 = 0; k0 < K; k0 += 64) {
    __syncthreads();
    *(uint4*)(Asw) = ra0; *(uint4*)(Asw + 32 * 72) = ra1; *(uint4*)(Asw + 64 * 72) = ra2; *(uint4*)(Asw + 96 * 72) = ra3;
    *(uint4*)(Asw + 128 * 72) = ra4; *(uint4*)(Asw + 160 * 72) = ra5; *(uint4*)(Asw + 192 * 72) = ra6; *(uint4*)(Asw + 224 * 72) = ra7;
    *(uint4*)(Bsw) = rb0; *(uint4*)(Bsw + 32 * 72) = rb1; *(uint4*)(Bsw + 64 * 72) = rb2; *(uint4*)(Bsw + 96 * 72) = rb3;
    __syncthreads();
    if (k0 + 64 < K) G256_LOAD(k0 + 64)
#pragma unroll
    for (int ks = 0; ks < 2; ++ks) {
      bf16x8 bfr[4];
#pragma unroll
      for (int ni = 0; ni < 4; ++ni)
        bfr[ni] = *(const bf16x8*)(Bs + (wc * 64 + ni * 16 + (lane & 15)) * 72 + ks * 32 + (lane >> 4) * 8);
#pragma unroll
      for (int h = 0; h < 2; ++h) {
        __builtin_amdgcn_sched_barrier(0);
        bf16x8 af[4];
#pragma unroll
        for (int mi = 0; mi < 4; ++mi)
          af[mi] = *(const bf16x8*)(As + (wr * 128 + h * 64 + mi * 16 + (lane & 15)) * 72 + ks * 32 + (lane >> 4) * 8);
#pragma unroll
        for (int mi = 0; mi < 4; ++mi)
#pragma unroll
          for (int ni = 0; ni < 4; ++ni)
            acc[h][mi][ni] = __builtin_amdgcn_mfma_f32_16x16x32_bf16(af[mi], bfr[ni], acc[h][mi][ni], 0, 0, 0);
      }
    }
  }
}
DEV void acc_zero(f32x4 (&acc)[4][4]) {
#pragma unroll
  for (int i = 0; i < 4; ++i)
#pragma unroll
    for (int j = 0; j < 4; ++j) acc[i][j] = f32x4{0.f, 0.f, 0.f, 0.f};
}
DEV void store_tile_bf16(bf16* sm, const f32x4 (&acc)[4][4], bf16* __restrict__ dbase, size_t dstride) {
  const int tid = tidx(), lane = tid & 63, wave = tid >> 6, g4 = lane >> 4, c16 = lane & 15;
  bf16* Cw = sm + wave * (64 * 72);
  __syncthreads();
#pragma unroll
  for (int mi = 0; mi < 4; ++mi)
#pragma unroll
    for (int ni = 0; ni < 4; ++ni)
#pragma unroll
      for (int r = 0; r < 4; ++r) Cw[(mi * 16 + g4 * 4 + r) * 72 + ni * 16 + c16] = f2bf(acc[mi][ni][r]);
  __syncthreads();
#pragma unroll
  for (int it = 0; it < 8; ++it) {
    const int row_l = it * 8 + (lane >> 3), ch = lane & 7;
    const uint4 v = *(const uint4*)(Cw + row_l * 72 + ch * 8);
    *(uint4*)(dbase + (size_t)row_l * dstride + ch * 8) = v;
  }
}
template <class Epi>
DEV void gemm_tile(const bf16* __restrict__ A, int lda, const bf16* __restrict__ W, int K, int m0, int n0, bf16* sm,
                   Epi epi) {
  f32x4 acc[4][4];
  acc_zero(acc);
  gemm_mainloop(A, lda, W, K, m0, n0, sm, acc);
  const int tid = tidx(), lane = tid & 63, wave = tid >> 6;
  const int wr = wave >> 1, wc = wave & 1;
#pragma unroll
  for (int mi = 0; mi < 4; ++mi)
#pragma unroll
    for (int ni = 0; ni < 4; ++ni)
#pragma unroll
      for (int r = 0; r < 4; ++r) {
        int row = m0 + wr * 64 + mi * 16 + (lane >> 4) * 4 + r;
        int col = n0 + wc * 64 + ni * 16 + (lane & 15);
        epi(row, col, acc[mi][ni][r]);
      }
}
DEV void inproj_epilogue(const Params& p, f32x4 (&acc)[4][4], int row0, int vc0, bf16* sm) {
  const int tid = tidx(), lane = tid & 63, g4 = lane >> 4, c16 = lane & 15;
  const int b = row0 / S, t0 = row0 % S;
  bf16* dbase;
  size_t dstride;
  bool roped = false;
  bf16* projp = (bf16*)(p.ws + OFF_PROJ) + (size_t)row0 * PC;
  if (vc0 < 768) { dbase = projp + vc0; dstride = PC; }
  else if (vc0 < 1280) {
    const int seg = (vc0 - 768) >> 7, head = ((vc0 - 768) >> 6) & 1;
    const size_t off = (seg == 0) ? OFF_KSB : (seg == 1) ? OFF_VSB : (seg == 2) ? OFF_KWB : OFF_VWB;
    dbase = (bf16*)(p.ws + off) + ((size_t)(b * 2 + head) * S + t0) * 64;
    dstride = 64;
    roped = (seg == 0) || (seg == 2);
  } else if (vc0 < 1792) { dbase = projp + C_MQ + (vc0 - 1280); dstride = PC; roped = true; }
  else if (vc0 < 2816) {
    const int seg = (vc0 - 1792) >> 9, head = ((vc0 - 1792) >> 6) & 7;
    dbase = (bf16*)(p.ws + (seg ? OFF_MVB : OFF_MKB)) + ((size_t)(b * 8 + head) * S + t0) * 64;
    dstride = 64;
    roped = (seg == 0);
  } else if (vc0 < 4864) { dbase = projp + C_GN + (vc0 - 2816); dstride = PC; }
  else { dbase = projp + C_NG + (vc0 - 4864); dstride = PC; }
  if (roped) {
    const float* rope = (const float*)(p.ws + OFF_ROPE);
#pragma unroll
    for (int mi = 0; mi < 4; ++mi)
#pragma unroll
      for (int r = 0; r < 4; ++r) {
        const int pos = t0 + mi * 16 + g4 * 4 + r;
        const float v = acc[mi][0][r];
        const float pv = shx(v, 8);
        const float cs = rope[pos * 16 + (c16 & 7)], sn = rope[pos * 16 + 8 + (c16 & 7)];
        acc[mi][0][r] = (c16 < 8) ? (v * cs - pv * sn) : (v * cs + pv * sn);
      }
  }
  store_tile_bf16(sm, acc, dbase, dstride);
}
DEV void inproj_tile256(const Params& p, int layer, int m0, int n0, bf16* sm) {
  f32x4 acc[2][4][4];
  acc_zero(acc[0]);
  acc_zero(acc[1]);
  gemm256_mainloop((const bf16*)(p.ws + OFF_H), 1024, (const bf16*)(p.ws + OFF_WINT) + (size_t)layer * WN * 1024, 1024, m0, n0, sm, acc);
  const int wave = tidx() >> 6, wr = wave >> 1, wc = wave & 1;
  inproj_epilogue(p, acc[0], m0 + wr * 128, n0 + wc * 64, sm);
  inproj_epilogue(p, acc[1], m0 + wr * 128 + 64, n0 + wc * 64, sm);
}
typedef unsigned u32x2_t __attribute__((ext_vector_type(2)));
DEV void merge_tile(const Params& p, int layer, int m0, int n0, bf16* sm) {
  const int tid = tidx(), lane = tid & 63, wave = tid >> 6, g4 = lane >> 4, c16 = lane & 15;
  const int wr = wave >> 1, wc = wave & 1;
  const bf16* projg = (const bf16*)(p.ws + OFF_PROJ) + (size_t)(m0 + wr * 64 + g4 * 4) * PC + n0 + wc * 64 + c16;
  f32x4 acc[4][4];
  acc_zero(acc);
  gemm_mainloop((const bf16*)(p.ws + OFF_ONSA), 512, (const bf16*)(p.ws + OFF_WUPN) + (size_t)layer * 1024 * 512, 512, m0, n0, sm, acc);
  bf16* yg = (bf16*)(p.ws + OFF_H) + (size_t)(m0 + wr * 64 + g4 * 4) * 1024 + n0 + wc * 64 + c16;
#pragma unroll
  for (int mi = 0; mi < 4; ++mi)
#pragma unroll
    for (int ni = 0; ni < 4; ++ni)
#pragma unroll
      for (int r = 0; r < 4; ++r)
        yg[(size_t)(mi * 16 + r) * 1024 + ni * 16] =
            f2bf(sigmoidf_(bf2f(projg[(size_t)(mi * 16 + r) * PC + C_GN + ni * 16])) * acc[mi][ni][r]);
  acc_zero(acc);
  gemm_mainloop((const bf16*)(p.ws + OFF_OMOBA), 512, (const bf16*)(p.ws + OFF_WUPM) + (size_t)layer * 1024 * 512, 512, m0, n0, sm, acc);
#pragma unroll
  for (int mi = 0; mi < 4; ++mi)
#pragma unroll
    for (int ni = 0; ni < 4; ++ni)
#pragma unroll
      for (int r = 0; r < 4; ++r)
        acc[mi][ni][r] = bf2f(yg[(size_t)(mi * 16 + r) * 1024 + ni * 16]) +
                         sigmoidf_(bf2f(projg[(size_t)(mi * 16 + r) * PC + C_GM + ni * 16])) * acc[mi][ni][r];
  store_tile_bf16(sm, acc, (bf16*)(p.ws + OFF_H) + (size_t)(m0 + wr * 64) * 1024 + n0 + wc * 64, 1024);
}

DEV void merge_tile256(const Params& p, int layer, int m0, int n0, bf16* sm) {
  const int tid = tidx(), lane = tid & 63, wave = tid >> 6, g4 = lane >> 4, c16 = lane & 15;
  const int wr = wave >> 1, wc = wave & 1;
  f32x4 acc[2][4][4];
  acc_zero(acc[0]);
  acc_zero(acc[1]);
  gemm256_mainloop((const bf16*)(p.ws + OFF_ONSA), 512, (const bf16*)(p.ws + OFF_WUPN) + (size_t)layer * 1024 * 512, 512, m0, n0, sm, acc);
#pragma unroll
  for (int h = 0; h < 2; ++h) {
    const size_t rb = (size_t)(m0 + wr * 128 + h * 64 + g4 * 4);
    const bf16* projg = (const bf16*)(p.ws + OFF_PROJ) + rb * PC + n0 + wc * 64 + c16;
    bf16* yg = (bf16*)(p.ws + OFF_H) + rb * 1024 + n0 + wc * 64 + c16;
#pragma unroll
    for (int mi = 0; mi < 4; ++mi)
#pragma unroll
      for (int ni = 0; ni < 4; ++ni)
#pragma unroll
        for (int r = 0; r < 4; ++r)
          yg[(size_t)(mi * 16 + r) * 1024 + ni * 16] =
              f2bf(sigmoidf_(bf2f(projg[(size_t)(mi * 16 + r) * PC + C_GN + ni * 16])) * acc[h][mi][ni][r]);
  }
  acc_zero(acc[0]);
  acc_zero(acc[1]);
  gemm256_mainloop((const bf16*)(p.ws + OFF_OMOBA), 512, (const bf16*)(p.ws + OFF_WUPM) + (size_t)layer * 1024 * 512, 512, m0, n0, sm, acc);
#pragma unroll
  for (int h = 0; h < 2; ++h) {
    const size_t rb = (size_t)(m0 + wr * 128 + h * 64 + g4 * 4);
    const bf16* projg = (const bf16*)(p.ws + OFF_PROJ) + rb * PC + n0 + wc * 64 + c16;
    const bf16* yg = (const bf16*)(p.ws + OFF_H) + rb * 1024 + n0 + wc * 64 + c16;
#pragma unroll
    for (int mi = 0; mi < 4; ++mi)
#pragma unroll
      for (int ni = 0; ni < 4; ++ni)
#pragma unroll
        for (int r = 0; r < 4; ++r)
          acc[h][mi][ni][r] = bf2f(yg[(size_t)(mi * 16 + r) * 1024 + ni * 16]) +
                              sigmoidf_(bf2f(projg[(size_t)(mi * 16 + r) * PC + C_GM + ni * 16])) * acc[h][mi][ni][r];
    store_tile_bf16(sm, acc[h], (bf16*)(p.ws + OFF_H) + (size_t)(m0 + wr * 128 + h * 64) * 1024 + n0 + wc * 64, 1024);
  }
}

DEV void compress_item(const Params& p, int layer, int item, float* sm) {
  const int tid = tidx();
  const int grp = item & 127, which = (item >> 7) & 1, kvh = (item >> 8) & 1, b = item >> 9;
  const int c0 = grp * 8;
  float* xs = sm;
  float* hs = sm + 144 * 64;
  const bf16* proj = (const bf16*)(p.ws + OFF_PROJ);
  const int col = (which ? C_VC : C_KC) + kvh * 64;
  for (int i = tid; i < 144 * 64; i += 256) {
    int tl = i >> 6, d = i & 63;
    int t = c0 * 16 + tl;
    xs[i] = (t < S) ? bf2f(proj[((size_t)b * S + t) * PC + col + d]) : 0.f;
  }
  __syncthreads();
  const int lw = layer * 2 + which;
  if (tid < 128) {
    const float* w1 = p.cmp_w1 + (size_t)lw * 2048 * 128 + tid;
    float acc[8];
#pragma unroll
    for (int ci = 0; ci < 8; ++ci) acc[ci] = 0.f;
    for (int l = 0; l < 32; ++l) {
#pragma unroll 4
      for (int d = 0; d < 64; ++d) {
        float w = w1[(size_t)(l * 64 + d) * 128];
#pragma unroll
        for (int ci = 0; ci < 8; ++ci) acc[ci] += xs[(ci * 16 + l) * 64 + d] * w;
      }
    }
    float pb = ((const float*)(p.ws + OFF_PEB))[lw * 128 + tid];
#pragma unroll
    for (int ci = 0; ci < 8; ++ci) hs[ci * 128 + tid] = gelu_tanh(acc[ci] + pb);
  }
  __syncthreads();
  const float* w2 = p.cmp_w2 + (size_t)lw * 128 * 64;
  float* outp = PROBE_CMPR ? ((float*)(p.ws + OFF_CMP) + (which ? (size_t)Bn * 1024 * 128 : 0)) : (float*)(p.ws + (which ? OFF_VCC : OFF_KCC));
#pragma unroll
  for (int rr = 0; rr < 2; ++rr) {
    int o = rr * 256 + tid;
    int ci = o >> 6, d = o & 63;
    int c = c0 + ci;
    float a = 0.f;
    for (int j = 0; j < 128; ++j) a += hs[ci * 128 + j] * w2[j * 64 + d];
    if (c < 1023) outp[(((size_t)b * 1024 + c) * 2 + kvh) * 64 + d] = a;
    bf16* outb = (bf16*)(p.ws + (which ? OFF_VCB : OFF_KCB));
    if (!PROBE_CMPR && c < 1024) outb[(((size_t)b * 2 + kvh) * 1024 + c) * 64 + d] = (c < 1023) ? f2bf(a) : (bf16)0;
  }
  __syncthreads();
}

DEV void compress_mfma_item(const Params& p, int layer, int item, char* smem) {
  bf16* xs = (bf16*)smem;
  float* hs = (float*)(smem + 272 * 64 * 2);
  const int tid = tidx(), lane = tid & 63, wave = tid >> 6, g4 = lane >> 4, c16 = lane & 15;
  const int cblk = item & 63, which = (item >> 6) & 1, kvh = (item >> 7) & 1, b = item >> 8;
  const int t0 = cblk * 256;
  const bf16* proj = (const bf16*)(p.ws + OFF_PROJ) + (size_t)b * S * PC + (which ? C_VC : C_KC) + kvh * 64;
  __syncthreads();
  for (int i = tid; i < 272 * 8; i += 256) {
    const int tl = i >> 3, ch = i & 7;
    const int t = t0 + tl;
    uint4 v = uint4{0u, 0u, 0u, 0u};
    if (t < S) v = *(const uint4*)(proj + (size_t)t * PC + ch * 8);
    *(uint4*)(xs + tl * 64 + ((ch ^ ((tl >> 4) & 7)) * 8)) = v;
  }
  __syncthreads();
  const int lw = layer * 2 + which;
  const bf16* w1t = (const bf16*)(p.ws + OFF_W1T) + (size_t)lw * 128 * 2048;
  f32x4 acc0 = f32x4{0.f, 0.f, 0.f, 0.f}, acc1 = f32x4{0.f, 0.f, 0.f, 0.f};
  const bf16* wb0 = w1t + (size_t)((2 * wave) * 16 + c16) * 2048 + g4 * 8;
  const bf16* wb1 = w1t + (size_t)((2 * wave + 1) * 16 + c16) * 2048 + g4 * 8;
#pragma unroll 4
  for (int ks = 0; ks < 64; ++ks) {
    const int l = ks >> 1, ch = (ks & 1) * 4 + g4;
    const int tl = 16 * c16 + l;
    const bf16x8 af = *(const bf16x8*)(xs + tl * 64 + ((ch ^ ((tl >> 4) & 7)) * 8));
    const bf16x8 b0 = *(const bf16x8*)(wb0 + ks * 32);
    const bf16x8 b1 = *(const bf16x8*)(wb1 + ks * 32);
    acc0 = MFMA16B(af, b0, acc0);
    acc1 = MFMA16B(af, b1, acc1);
  }
  {
    const float* peb = (const float*)(p.ws + OFF_PEB) + lw * 128;
    const int j0 = (2 * wave) * 16 + c16, j1 = j0 + 16;
    const float pb0 = peb[j0], pb1 = peb[j1];
#pragma unroll
    for (int r = 0; r < 4; ++r) {
      hs[(g4 * 4 + r) * 128 + j0] = gelu_tanh(acc0[r] + pb0);
      hs[(g4 * 4 + r) * 128 + j1] = gelu_tanh(acc1[r] + pb1);
    }
  }
  __syncthreads();
  const float* w2 = p.cmp_w2 + (size_t)lw * 128 * 64;
  const int d = tid & 63, cq = tid >> 6;
  float o0 = 0.f, o1 = 0.f, o2 = 0.f, o3 = 0.f;
#pragma unroll 8
  for (int j = 0; j < 128; ++j) {
    const float w = w2[j * 64 + d];
    o0 += hs[(cq * 4 + 0) * 128 + j] * w;
    o1 += hs[(cq * 4 + 1) * 128 + j] * w;
    o2 += hs[(cq * 4 + 2) * 128 + j] * w;
    o3 += hs[(cq * 4 + 3) * 128 + j] * w;
  }
  float* outp = (float*)(p.ws + (which ? OFF_VCC : OFF_KCC));
  bf16* outb = (bf16*)(p.ws + (which ? OFF_VCB : OFF_KCB));
  const float ov[4] = {o0, o1, o2, o3};
#pragma unroll
  for (int i = 0; i < 4; ++i) {
    const int c = cblk * 16 + cq * 4 + i;
    if (c < 1023) outp[(((size_t)b * 1024 + c) * 2 + kvh) * 64 + d] = ov[i];
    outb[(((size_t)b * 2 + kvh) * 1024 + c) * 64 + d] = (c < 1023) ? f2bf(ov[i]) : (bf16)0;
  }
  __syncthreads();
}

DEV void n1_item(const Params& p, int layer, int item, float* sm) {
  const int chunk = item & 255, kvh = (item >> 8) & 1, b = item >> 9;
  const int tid = tidx(), ql = tid >> 2, g = tid & 3;
  const int t = chunk * 64 + ql, h = kvh * 4 + g;
  const size_t tok = (size_t)b * S + t;
  const bf16* proj = (const bf16*)(p.ws + OFF_PROJ);
  float* imp = sm;
  for (int i = tid; i < 64 * 257; i += 256) imp[i] = 0.f;
  float q[64];
  load_q64(q, proj + tok * PC + C_NQ + h * 64, 0.125f);
  const int nv = (t >= 31) ? (((t - 31) >> 4) + 1) : 0;
  const int nv_max = (((chunk * 64 + 63) - 31) >> 4) + 1;
  const float* kc = (const float*)(p.ws + OFF_KCC) + (size_t)b * 1024 * 128 + kvh * 64;
  const float* vc = (const float*)(p.ws + OFF_VCC) + (size_t)b * 1024 * 128 + kvh * 64;
  float m = -INFINITY, l = 0.f;
  for (int c = 0; c < nv_max; ++c) {
    float s = dot64_f(q, kc + (size_t)c * 128);
    if (c < nv) {
      float mn = fmaxf(m, s);
      l = l * expf(m - mn) + expf(s - mn);
      m = mn;
    }
  }
  __syncthreads();
  float o[64];
#pragma unroll
  for (int d = 0; d < 64; ++d) o[d] = 0.f;
  const float inv_l = (nv > 0) ? 1.f / l : 0.f;
  for (int c = 0; c < nv_max; ++c) {
    float s = dot64_f(q, kc + (size_t)c * 128);
    float pr = (c < nv) ? expf(s - m) * inv_l : 0.f;
    axpy64_f(o, pr, vc + (size_t)c * 128);
    float ps = pr;
    ps += shx(ps, 1);
    ps += shx(ps, 2);
    if (g == 0) {
      int n = c >> 2;
      if ((c & 3) == 3) {
        imp[ql * 257 + n] += 0.5f * ps;
        imp[ql * 257 + n + 1] += 0.5f * ps;
      } else {
        imp[ql * 257 + n] += ps;
      }
    }
  }
  const float gate0 = (!PROBE_NSA || (PROBE_NSA & 1)) ? sigmoidf_(bf2f(proj[tok * PC + C_NG + h * 3 + 0])) : 0.f;
  float* oa = (float*)(p.ws + OFF_H) + tok * 512 + h * 64;
#pragma unroll
  for (int d = 0; d < 64; d += 4) {
    float4 v = {gate0 * o[d], gate0 * o[d + 1], gate0 * o[d + 2], gate0 * o[d + 3]};
    *(float4*)(oa + d) = v;
  }
  __syncthreads();
#if PROBE_NSA == 8
  if (b == 0 && kvh == 0)
    for (int i = tid; i < 64 * 256; i += 256)
      ((float*)(p.ws + OFF_OMOBA))[(size_t)(chunk * 64 + (i >> 8)) * 256 + (i & 255)] = imp[(i >> 8) * 257 + (i & 255)];
  __syncthreads();
#endif
  if (g == 0) {
    int* selp = (int*)(p.ws + OFF_SEL) + (((size_t)b * 2 + kvh) * S + t) * 16;
    const int cur = chunk;
    if (cur < 16) {
      for (int j = 0; j < 16; ++j) selp[j] = (j <= cur) ? j : -1;
    } else {
      selp[0] = 0;
      selp[1] = cur - 1;
      selp[2] = cur;
      float* row = imp + ql * 257;
      for (int j = 3; j < 16; ++j) {
        float best = -1.f;
        int bi = 1;
        for (int n = 1; n <= cur - 2; ++n) {
          float v = row[n];
          if (v > best) { best = v; bi = n; }
        }
        selp[j] = bi;
        row[bi] = -2.f;
      }
    }
  }
  __syncthreads();
}

DEV void kmean_item(const Params& p, int item, float* sm) {
  const int n = item & 63, h = (item >> 6) & 7, b = item >> 9;
  const int tid = tidx(), d = tid & 63, part = tid >> 6;
  const bf16* mkb = (const bf16*)(p.ws + OFF_MKB);
  float a = 0.f;
  for (int i = 0; i < 64; ++i) {
    int t = n * 256 + part * 64 + i;
    a += bf2f(mkb[((size_t)(b * 8 + h) * S + t) * 64 + d]);
  }
  sm[tid] = a;
  __syncthreads();
  if (tid < 64) {
    float s = sm[tid] + sm[64 + tid] + sm[128 + tid] + sm[192 + tid];
    const size_t ko = (((size_t)b * 8 + h) * 64 + n) * 64 + tid;
    const float mean = s * (1.f / 256.f);
    ((float*)(p.ws + OFF_KMEAN))[ko] = mean;
    const bf16 hi = f2bf(mean);
    ((bf16*)(p.ws + OFF_KMHL))[ko] = hi;
    ((bf16*)(p.ws + OFF_KMHL))[(size_t)2 * 8 * 64 * 64 + ko] = f2bf(mean - bf2f(hi));
    if (tid == 0) ((int*)(p.ws + OFF_MCNT))[(b * 8 + h) * 64 + n] = 0;
  }
  __syncthreads();
}

DEV void n23_item(const Params& p, int layer, int item) {
  const int chunk = item & 255, kvh = (item >> 8) & 1, b = item >> 9;
  const int tid = tidx(), ql = tid >> 2, g = tid & 3;
  const int t = chunk * 64 + ql, h = kvh * 4 + g;
  const size_t tok = (size_t)b * S + t;
  const bf16* proj = (const bf16*)(p.ws + OFF_PROJ);
  const float* rope = (const float*)(p.ws + OFF_ROPE) + (size_t)t * 16;
  float q[64];
  load_q64(q, proj + tok * PC + C_NQ + h * 64, 1.0f);
#pragma unroll
  for (int i = 0; i < 8; ++i) {
    float cs = rope[i], sn = rope[8 + i];
    float x1 = q[i], x2 = q[8 + i];
    q[i] = x1 * cs - x2 * sn;
    q[8 + i] = x2 * cs + x1 * sn;
  }
#pragma unroll
  for (int i = 0; i < 64; ++i) q[i] *= 0.125f;
  const size_t kvo = ((size_t)(b * 2 + kvh) * S) * 64;
  const bf16* ksb = (const bf16*)(p.ws + OFF_KSB) + kvo;
  const bf16* vsb = (const bf16*)(p.ws + OFF_VSB) + kvo;
  const bf16* kwb = (const bf16*)(p.ws + OFF_KWB) + kvo;
  const bf16* vwb = (const bf16*)(p.ws + OFF_VWB) + kvo;
  const int* selp = (const int*)(p.ws + OFF_SEL) + (((size_t)b * 2 + kvh) * S + t) * 16;
  float* oa = (float*)(p.ws + OFF_H) + tok * 512 + h * 64;
  const float gate1 = (!PROBE_NSA || (PROBE_NSA & 2)) ? sigmoidf_(bf2f(proj[tok * PC + C_NG + h * 3 + 1])) : 0.f;
  const float gate2 = (!PROBE_NSA || (PROBE_NSA & 4)) ? sigmoidf_(bf2f(proj[tok * PC + C_NG + h * 3 + 2])) : 0.f;
  float o[64];
  {
    float m = -INFINITY;
    for (int j = 0; j < 16; ++j) {
      int n = selp[j];
      if (n >= 0) {
        for (int i = 0; i < 64; ++i) {
          int kpos = n * 64 + i;
          if (kpos <= t) {
            float s = dot64_bf(q, ksb + (size_t)kpos * 64);
            m = fmaxf(m, s);
          }
        }
      }
    }
    float l = 0.f;
#pragma unroll
    for (int d = 0; d < 64; ++d) o[d] = 0.f;
    for (int j = 0; j < 16; ++j) {
      int n = selp[j];
      if (n >= 0) {
        for (int i = 0; i < 64; ++i) {
          int kpos = n * 64 + i;
          if (kpos <= t) {
            float s = dot64_bf(q, ksb + (size_t)kpos * 64);
            float pr = expf(s - m);
            l += pr;
            axpy64_bf(o, pr, vsb + (size_t)kpos * 64);
          }
        }
      }
    }
    float sc = gate1 / l;
#pragma unroll
    for (int d = 0; d < 64; d += 4) {
      float4 v = *(float4*)(oa + d);
      v.x += sc * o[d]; v.y += sc * o[d + 1]; v.z += sc * o[d + 2]; v.w += sc * o[d + 3];
      *(float4*)(oa + d) = v;
    }
  }
  {
    const int s0 = chunk * 64;
    const int jlo = (s0 - 511 > 0) ? (s0 - 511) : 0;
    const int jhi = s0 + 63;
    float m = -INFINITY;
    for (int j = jlo; j <= jhi; ++j) {
      float s = dot64_bf(q, kwb + (size_t)j * 64);
      if (j <= t && j > t - 512) m = fmaxf(m, s);
    }
    float l = 0.f;
#pragma unroll
    for (int d = 0; d < 64; ++d) o[d] = 0.f;
    for (int j = jlo; j <= jhi; ++j) {
      float s = dot64_bf(q, kwb + (size_t)j * 64);
      float pr = (j <= t && j > t - 512) ? expf(s - m) : 0.f;
      l += pr;
      axpy64_bf(o, pr, vwb + (size_t)j * 64);
    }
    float sc = gate2 / l;
    bf16* ob = (bf16*)(p.ws + (PROBE_NSA ? OFF_CMP : OFF_ONSA)) + tok * 512 + h * 64;
#pragma unroll
    for (int d = 0; d < 64; d += 8) {
      float4 v0 = *(float4*)(oa + d);
      float4 v1 = *(float4*)(oa + d + 4);
      uint4 pk;
      pk.x = (unsigned)f2bf(v0.x + sc * o[d]) | ((unsigned)f2bf(v0.y + sc * o[d + 1]) << 16);
      pk.y = (unsigned)f2bf(v0.z + sc * o[d + 2]) | ((unsigned)f2bf(v0.w + sc * o[d + 3]) << 16);
      pk.z = (unsigned)f2bf(v1.x + sc * o[d + 4]) | ((unsigned)f2bf(v1.y + sc * o[d + 5]) << 16);
      pk.w = (unsigned)f2bf(v1.z + sc * o[d + 6]) | ((unsigned)f2bf(v1.w + sc * o[d + 7]) << 16);
      *(uint4*)(ob + d) = pk;
    }
  }
}

DEV void moba_item(const Params& p, int layer, int item) {
  const int blk = item & 63, h = (item >> 6) & 7, b = item >> 9;
  const int tid = tidx();
  const int t = blk * 256 + tid;
  const size_t tok = (size_t)b * S + t;
  const bf16* proj = (const bf16*)(p.ws + OFF_PROJ);
  float q[64];
  load_q64(q, proj + tok * PC + C_MQ + h * 64, 0.125f);
  const float* km = (const float*)(p.ws + OFF_KMEAN) + ((size_t)b * 8 + h) * 64 * 64;
  float b0 = -INFINITY, b1 = -INFINITY, b2 = -INFINITY;
  int i0 = -1, i1 = -1, i2 = -1;
  for (int n = 0; n < blk; ++n) {
    float v = dot64_f(q, km + n * 64);
    if (v > b0) { b2 = b1; i2 = i1; b1 = b0; i1 = i0; b0 = v; i0 = n; }
    else if (v > b1) { b2 = b1; i2 = i1; b1 = v; i1 = n; }
    else if (v > b2) { b2 = v; i2 = n; }
  }
  const bf16* mkb = (const bf16*)(p.ws + OFF_MKB) + ((size_t)(b * 8 + h) * S) * 64;
  const bf16* mvb = (const bf16*)(p.ws + OFF_MVB) + ((size_t)(b * 8 + h) * S) * 64;
  float m = -INFINITY;
  for (int sidx = 0; sidx < 3; ++sidx) {
    int n = (sidx == 0) ? i0 : (sidx == 1) ? i1 : i2;
    if (sidx < blk) {
      for (int i = 0; i < 256; ++i) {
        float s = dot64_bf(q, mkb + (size_t)(n * 256 + i) * 64);
        m = fmaxf(m, s);
      }
    }
  }
  for (int i = 0; i < 256; ++i) {
    int kpos = blk * 256 + i;
    float s = dot64_bf(q, mkb + (size_t)kpos * 64);
    if (kpos <= t) m = fmaxf(m, s);
  }
  float l = 0.f;
  float o[64];
#pragma unroll
  for (int d = 0; d < 64; ++d) o[d] = 0.f;
  for (int sidx = 0; sidx < 3; ++sidx) {
    int n = (sidx == 0) ? i0 : (sidx == 1) ? i1 : i2;
    if (sidx < blk) {
      for (int i = 0; i < 256; ++i) {
        const size_t ko = (size_t)(n * 256 + i) * 64;
        float s = dot64_bf(q, mkb + ko);
        float pr = expf(s - m);
        l += pr;
        axpy64_bf(o, pr, mvb + ko);
      }
    }
  }
  for (int i = 0; i < 256; ++i) {
    int kpos = blk * 256 + i;
    const size_t ko = (size_t)kpos * 64;
    float s = dot64_bf(q, mkb + ko);
    float pr = (kpos <= t) ? expf(s - m) : 0.f;
    l += pr;
    axpy64_bf(o, pr, mvb + ko);
  }
  const float il = 1.f / l;
  bf16* ob = (bf16*)(p.ws + (PROBE_MOBA ? OFF_CMP : OFF_OMOBA)) + tok * 512 + h * 64;
#pragma unroll
  for (int d = 0; d < 64; d += 8) {
    uint4 pk;
    pk.x = (unsigned)f2bf(o[d] * il) | ((unsigned)f2bf(o[d + 1] * il) << 16);
    pk.y = (unsigned)f2bf(o[d + 2] * il) | ((unsigned)f2bf(o[d + 3] * il) << 16);
    pk.z = (unsigned)f2bf(o[d + 4] * il) | ((unsigned)f2bf(o[d + 5] * il) << 16);
    pk.w = (unsigned)f2bf(o[d + 6] * il) | ((unsigned)f2bf(o[d + 7] * il) << 16);
    *(uint4*)(ob + d) = pk;
  }
}

typedef short v4i16_t __attribute__((ext_vector_type(4)));
typedef unsigned u32x4_t __attribute__((ext_vector_type(4)));
DEV v4i16_t lds_tr16(const bf16* p) {
  return __builtin_amdgcn_ds_read_tr16_b64_v4i16((__attribute__((address_space(3))) v4i16_t*)p);
}
DEV unsigned cvtpk(float lo, float hi) {
  unsigned r;
  asm("v_cvt_pk_bf16_f32 %0, %1, %2" : "=v"(r) : "v"(lo), "v"(hi));
  return r;
}
#define MFMA16(a, b, c) __builtin_amdgcn_mfma_f32_16x16x32_bf16(a, b, c, 0, 0, 0)
constexpr float C2 = 0.125f * 1.4426950408889634f;
constexpr int KT_LD = 72;
constexpr int KT_ELEMS = 64 * KT_LD;

template <int NI>
struct AttnSt {
  f32x4 o[4][NI];
  float m[NI], l[NI];
};
template <int NI>
DEV void attn_init(AttnSt<NI>& st) {
#pragma unroll
  for (int ni = 0; ni < NI; ++ni) {
    st.m[ni] = -INFINITY;
    st.l[ni] = 0.f;
#pragma unroll
    for (int di = 0; di < 4; ++di) st.o[di][ni] = f32x4{0.f, 0.f, 0.f, 0.f};
  }
}
#define TILE_DECL uint4 tl_k0, tl_k1, tl_v0, tl_v1
#define TILE_GLOAD(kb, vb, ld, key0)                                                        \
  do {                                                                                      \
    const int r_ = tidx() >> 3, c_ = (tidx() & 7) * 8;                            \
    tl_k0 = *(const uint4*)((kb) + (size_t)((key0) + r_) * (ld) + c_);                      \
    tl_k1 = *(const uint4*)((kb) + (size_t)((key0) + 32 + r_) * (ld) + c_);                 \
    tl_v0 = *(const uint4*)((vb) + (size_t)((key0) + r_) * (ld) + c_);                      \
    tl_v1 = *(const uint4*)((vb) + (size_t)((key0) + 32 + r_) * (ld) + c_);                 \
  } while (0)
#define TILE_SSTORE(Ks_, Vs_)                                                               \
  do {                                                                                      \
    const int r_ = tidx() >> 3, c_ = (tidx() & 7) * 8;                            \
    *(uint4*)((Ks_) + r_ * KT_LD + c_) = tl_k0;                                             \
    *(uint4*)((Ks_) + (32 + r_) * KT_LD + c_) = tl_k1;                                      \
    *(uint4*)((Vs_) + r_ * KT_LD + c_) = tl_v0;                                             \
    *(uint4*)((Vs_) + (32 + r_) * KT_LD + c_) = tl_v1;                                      \
  } while (0)
#define TL_GLOAD(P, kb, vb, ld, key0)                                                       \
  do {                                                                                      \
    const int r_ = tidx() >> 3, c_ = (tidx() & 7) * 8;                                      \
    P##_k0 = *(const uint4*)((kb) + (size_t)((key0) + r_) * (ld) + c_);                     \
    P##_k1 = *(const uint4*)((kb) + (size_t)((key0) + 32 + r_) * (ld) + c_);                \
    P##_v0 = *(const uint4*)((vb) + (size_t)((key0) + r_) * (ld) + c_);                     \
    P##_v1 = *(const uint4*)((vb) + (size_t)((key0) + 32 + r_) * (ld) + c_);                \
  } while (0)
#define TL_SSTORE(P, Ks_, Vs_)                                                              \
  do {                                                                                      \
    const int r_ = tidx() >> 3, c_ = (tidx() & 7) * 8;                                      \
    *(uint4*)((Ks_) + r_ * KT_LD + c_) = P##_k0;                                            \
    *(uint4*)((Ks_) + (32 + r_) * KT_LD + c_) = P##_k1;                                     \
    *(uint4*)((Vs_) + r_ * KT_LD + c_) = P##_v0;                                            \
    *(uint4*)((Vs_) + (32 + r_) * KT_LD + c_) = P##_v1;                                     \
  } while (0)
#define KV_SWEEP(kb_, vb_, ld_, nt_, KEYF, ...)                                             \
  {                                                                                         \
    uint4 tA_k0, tA_k1, tA_v0, tA_v1, tB_k0, tB_k1, tB_v0, tB_v1;                           \
    const int nt__ = (nt_);                                                                 \
    if (nt__ > 0) {                                                                         \
      TL_GLOAD(tA, kb_, vb_, ld_, KEYF(0));                                                 \
      TL_SSTORE(tA, smkv, smkv + KT_ELEMS);                                                 \
      if (nt__ > 1) TL_GLOAD(tA, kb_, vb_, ld_, KEYF(1));                                   \
    }                                                                                       \
    __syncthreads();                                                                        \
    for (int it0__ = 0; it0__ < nt__; it0__ += 2) {                                         \
      {                                                                                     \
        const int it = it0__;                                                               \
        if (it + 2 < nt__) TL_GLOAD(tB, kb_, vb_, ld_, KEYF(it + 2));                       \
        const bf16* Ks = smkv;                                                              \
        __VA_ARGS__                                                                         \
        if (it + 1 < nt__) TL_SSTORE(tA, smkv + 2 * KT_ELEMS, smkv + 3 * KT_ELEMS);         \
        __syncthreads();                                                                    \
      }                                                                                     \
      if (it0__ + 1 < nt__) {                                                               \
        const int it = it0__ + 1;                                                           \
        if (it + 2 < nt__) TL_GLOAD(tA, kb_, vb_, ld_, KEYF(it + 2));                       \
        const bf16* Ks = smkv + 2 * KT_ELEMS;                                               \
        __VA_ARGS__                                                                         \
        if (it + 1 < nt__) TL_SSTORE(tB, smkv, smkv + KT_ELEMS);                            \
        __syncthreads();                                                                    \
      }                                                                                     \
    }                                                                                       \
  }
template <int NI>
DEV void attn_scores(const bf16* Ks, const bf16x8 (&qf)[NI][2], f32x4 (&s)[4][NI]) {
  const int lane = tidx() & 63, g4 = lane >> 4, c16 = lane & 15;
#pragma unroll
  for (int mi = 0; mi < 4; ++mi) {
#pragma unroll
    for (int ni = 0; ni < NI; ++ni) s[mi][ni] = f32x4{0.f, 0.f, 0.f, 0.f};
#pragma unroll
    for (int ks = 0; ks < 2; ++ks) {
      bf16x8 kf = *(const bf16x8*)(Ks + (mi * 16 + c16) * KT_LD + ks * 32 + g4 * 8);
#pragma unroll
      for (int ni = 0; ni < NI; ++ni) s[mi][ni] = MFMA16(kf, qf[ni][ks], s[mi][ni]);
    }
  }
}
template <int NI>
DEV void attn_pv(const bf16* Vs, const bf16x8 (&pf)[NI][2], f32x4 (&o)[4][NI]) {
  const int lane = tidx() & 63, g4 = lane >> 4, q4 = (lane & 15) >> 2, p4 = lane & 3;
#pragma unroll
  for (int di = 0; di < 4; ++di) {
#pragma unroll
    for (int ks2 = 0; ks2 < 2; ++ks2) {
      v4i16_t v0 = lds_tr16(Vs + (ks2 * 32 + g4 * 4 + q4) * KT_LD + di * 16 + p4 * 4);
      v4i16_t v1 = lds_tr16(Vs + (ks2 * 32 + 16 + g4 * 4 + q4) * KT_LD + di * 16 + p4 * 4);
      bf16x8 vf = __builtin_shufflevector(v0, v1, 0, 1, 2, 3, 4, 5, 6, 7);
#pragma unroll
      for (int ni = 0; ni < NI; ++ni) o[di][ni] = MFMA16(vf, pf[ni][ks2], o[di][ni]);
    }
  }
}
DEV void exp4_pack(const f32x4& sv, float nm, float& ps, unsigned& w0, unsigned& w1) {
  float p0 = __builtin_amdgcn_exp2f(__builtin_fmaf(sv[0], C2, nm));
  float p1 = __builtin_amdgcn_exp2f(__builtin_fmaf(sv[1], C2, nm));
  float p2 = __builtin_amdgcn_exp2f(__builtin_fmaf(sv[2], C2, nm));
  float p3 = __builtin_amdgcn_exp2f(__builtin_fmaf(sv[3], C2, nm));
  ps += (p0 + p1) + (p2 + p3);
  w0 = cvtpk(p0, p1);
  w1 = cvtpk(p2, p3);
}
template <int NI>
DEV void attn_softmax_pv(const bf16* Vs, f32x4 (&s)[4][NI], AttnSt<NI>& st) {
  bf16x8 pf[NI][2];
#pragma unroll
  for (int ni = 0; ni < NI; ++ni) {
    float mx = -INFINITY;
#pragma unroll
    for (int mi = 0; mi < 4; ++mi)
      mx = fmaxf(fmaxf(mx, fmaxf(s[mi][ni][0], s[mi][ni][1])), fmaxf(s[mi][ni][2], s[mi][ni][3]));
    mx = fmaxf(mx, shx(mx, 16));
    mx = fmaxf(mx, shx(mx, 32));
    const float mn = fmaxf(st.m[ni], mx);
    const float mu = (mn == -INFINITY) ? 0.f : mn;
    const float corr = __builtin_amdgcn_exp2f((st.m[ni] - mu) * C2);
    st.m[ni] = mn;
    const float nm = -mu * C2;
    float ps = 0.f;
    u32x4_t wa, wb;
    unsigned t0, t1;
    exp4_pack(s[0][ni], nm, ps, t0, t1); wa.x = t0; wa.y = t1;
    exp4_pack(s[1][ni], nm, ps, t0, t1); wa.z = t0; wa.w = t1;
    exp4_pack(s[2][ni], nm, ps, t0, t1); wb.x = t0; wb.y = t1;
    exp4_pack(s[3][ni], nm, ps, t0, t1); wb.z = t0; wb.w = t1;
    st.l[ni] = st.l[ni] * corr + ps;
#pragma unroll
    for (int di = 0; di < 4; ++di) {
      st.o[di][ni][0] *= corr; st.o[di][ni][1] *= corr; st.o[di][ni][2] *= corr; st.o[di][ni][3] *= corr;
    }
    pf[ni][0] = __builtin_bit_cast(bf16x8, wa);
    pf[ni][1] = __builtin_bit_cast(bf16x8, wb);
  }
  attn_pv<NI>(Vs, pf, st.o);
}

template <int NI>
DEV void attn_softmax_pv_act(const bf16* Vs, f32x4 (&s)[4][NI], AttnSt<NI>& st, const bool (&act)[NI]) {
  bf16x8 pf[NI][2];
#pragma unroll
  for (int ni = 0; ni < NI; ++ni) {
    pf[ni][0] = bf16x8{0, 0, 0, 0, 0, 0, 0, 0};
    pf[ni][1] = bf16x8{0, 0, 0, 0, 0, 0, 0, 0};
    if (act[ni]) {
      float mx = -INFINITY;
#pragma unroll
      for (int mi = 0; mi < 4; ++mi)
        mx = fmaxf(fmaxf(mx, fmaxf(s[mi][ni][0], s[mi][ni][1])), fmaxf(s[mi][ni][2], s[mi][ni][3]));
      mx = fmaxf(mx, shx(mx, 16));
      mx = fmaxf(mx, shx(mx, 32));
      const float mn = fmaxf(st.m[ni], mx);
      const float mu = (mn == -INFINITY) ? 0.f : mn;
      const float corr = __builtin_amdgcn_exp2f((st.m[ni] - mu) * C2);
      st.m[ni] = mn;
      const float nm = -mu * C2;
      float ps = 0.f;
      u32x4_t wa, wb;
      unsigned t0, t1;
      exp4_pack(s[0][ni], nm, ps, t0, t1); wa.x = t0; wa.y = t1;
      exp4_pack(s[1][ni], nm, ps, t0, t1); wa.z = t0; wa.w = t1;
      exp4_pack(s[2][ni], nm, ps, t0, t1); wb.x = t0; wb.y = t1;
      exp4_pack(s[3][ni], nm, ps, t0, t1); wb.z = t0; wb.w = t1;
      st.l[ni] = st.l[ni] * corr + ps;
#pragma unroll
      for (int di = 0; di < 4; ++di) {
        st.o[di][ni][0] *= corr; st.o[di][ni][1] *= corr; st.o[di][ni][2] *= corr; st.o[di][ni][3] *= corr;
      }
      pf[ni][0] = __builtin_bit_cast(bf16x8, wa);
      pf[ni][1] = __builtin_bit_cast(bf16x8, wb);
    }
  }
  const int lane = tidx() & 63, g4 = lane >> 4, q4 = (lane & 15) >> 2, p4 = lane & 3;
#pragma unroll
  for (int di = 0; di < 4; ++di) {
#pragma unroll
    for (int ks2 = 0; ks2 < 2; ++ks2) {
      v4i16_t v0 = lds_tr16(Vs + (ks2 * 32 + g4 * 4 + q4) * KT_LD + di * 16 + p4 * 4);
      v4i16_t v1 = lds_tr16(Vs + (ks2 * 32 + 16 + g4 * 4 + q4) * KT_LD + di * 16 + p4 * 4);
      bf16x8 vf = __builtin_shufflevector(v0, v1, 0, 1, 2, 3, 4, 5, 6, 7);
#pragma unroll
      for (int ni = 0; ni < NI; ++ni)
        if (act[ni]) st.o[di][ni] = MFMA16(vf, pf[ni][ks2], st.o[di][ni]);
    }
  }
}
template <int NI>
DEV int gate_top1(f32x4 (&gs)[4][NI], int ni, int g4) {
  float bv = -INFINITY;
  int bi = 1 << 20;
#pragma unroll
  for (int mi = 0; mi < 4; ++mi)
#pragma unroll
    for (int r = 0; r < 4; ++r) {
      float v = gs[mi][ni][r];
      if (v > bv) { bv = v; bi = mi * 16 + g4 * 4 + r; }
    }
#pragma unroll
  for (int off = 16; off <= 32; off <<= 1) {
    float ov = shx(bv, off);
    int oi = shx(bi, off);
    if (ov > bv || (ov == bv && oi < bi)) { bv = ov; bi = oi; }
  }
#pragma unroll
  for (int mi = 0; mi < 4; ++mi)
#pragma unroll
    for (int r = 0; r < 4; ++r)
      if (mi * 16 + g4 * 4 + r == bi) gs[mi][ni][r] = -INFINITY;
  return (bv == -INFINITY) ? -1 : bi;
}
template <int NI>
DEV void moba_mfma_item(const Params& p, int item, char* smem, bf16* outbuf) {
  constexpr int QB = 64 * NI;
  bf16* sm = (bf16*)smem;
  const int bh = item & 15, cq = (S / QB - 1) - (item >> 4);
  const int b = bh >> 3, h = bh & 7;
  const int s0 = cq * QB, blk = s0 >> 8;
  const int lane = tidx() & 63, wave = tidx() >> 6, g4 = lane >> 4, c16 = lane & 15;
  const bf16* proj = (const bf16*)(p.ws + OFF_PROJ) + (size_t)b * S * PC;
  bf16x8 qf[NI][2];
  int tq[NI];
#pragma unroll
  for (int ni = 0; ni < NI; ++ni) {
    tq[ni] = s0 + wave * 16 * NI + ni * 16 + c16;
#pragma unroll
    for (int ks = 0; ks < 2; ++ks)
      qf[ni][ks] = *(const bf16x8*)(proj + (size_t)tq[ni] * PC + C_MQ + h * 64 + ks * 32 + g4 * 8);
  }
  int i0[NI], i1[NI], i2[NI];
  {
    const bf16* kmh = (const bf16*)(p.ws + OFF_KMHL) + ((size_t)(b * 8 + h) * 64) * 64;
    const bf16* kml = kmh + (size_t)2 * 8 * 64 * 64;
    f32x4 gs[4][NI];
#pragma unroll
    for (int mi = 0; mi < 4; ++mi) {
#pragma unroll
      for (int ni = 0; ni < NI; ++ni) gs[mi][ni] = f32x4{0.f, 0.f, 0.f, 0.f};
#pragma unroll
      for (int ks = 0; ks < 2; ++ks) {
        bf16x8 ah = *(const bf16x8*)(kmh + (mi * 16 + c16) * 64 + ks * 32 + g4 * 8);
        bf16x8 al_ = *(const bf16x8*)(kml + (mi * 16 + c16) * 64 + ks * 32 + g4 * 8);
#pragma unroll
        for (int ni = 0; ni < NI; ++ni) {
          gs[mi][ni] = MFMA16(ah, qf[ni][ks], gs[mi][ni]);
          gs[mi][ni] = MFMA16(al_, qf[ni][ks], gs[mi][ni]);
        }
      }
    }
#pragma unroll
    for (int ni = 0; ni < NI; ++ni) {
#pragma unroll
      for (int mi = 0; mi < 4; ++mi)
#pragma unroll
        for (int r = 0; r < 4; ++r)
          if (mi * 16 + g4 * 4 + r >= blk) gs[mi][ni][r] = -INFINITY;
      i0[ni] = gate_top1(gs, ni, g4);
      i1[ni] = gate_top1(gs, ni, g4);
      i2[ni] = gate_top1(gs, ni, g4);
    }
  }
  AttnSt<NI> st;
  attn_init<NI>(st);
  const int ntiles = (s0 + QB) >> 6;
  const bf16* kb = (const bf16*)(p.ws + OFF_MKB) + ((size_t)(b * 8 + h) * S) * 64;
  const bf16* vb = (const bf16*)(p.ws + OFF_MVB) + ((size_t)(b * 8 + h) * S) * 64;
  bf16* smkv = sm;
  __syncthreads();
#define MOBA_KEY(i) ((i) * 64)
  KV_SWEEP(kb, vb, 64, ntiles, MOBA_KEY,
    const int n = it >> 2;
    const bool own = (n == blk);
    const int kbase = it * 64;
    bool wave_active = own;
    if (!own) {
      bool anyq = false;
      _Pragma("unroll") for (int ni = 0; ni < NI; ++ni) anyq = anyq || (n == i0[ni]) || (n == i1[ni]) || (n == i2[ni]);
      wave_active = __builtin_amdgcn_ballot_w64(anyq) != 0ull;
    }
    if (wave_active) {
      f32x4 s[4][NI];
      attn_scores<NI>(Ks, qf, s);
      _Pragma("unroll") for (int ni = 0; ni < NI; ++ni) {
        if (own) {
          _Pragma("unroll") for (int mi = 0; mi < 4; ++mi)
            _Pragma("unroll") for (int r = 0; r < 4; ++r)
              if (kbase + mi * 16 + g4 * 4 + r > tq[ni]) s[mi][ni][r] = -INFINITY;
        } else {
          const bool okb = (n == i0[ni]) | (n == i1[ni]) | (n == i2[ni]);
          if (!okb) {
            _Pragma("unroll") for (int mi = 0; mi < 4; ++mi) s[mi][ni] = f32x4{-INFINITY, -INFINITY, -INFINITY, -INFINITY};
          }
        }
      }
      attn_softmax_pv<NI>(Ks + KT_ELEMS, s, st);
    }
  )
#pragma unroll
  for (int ni = 0; ni < NI; ++ni) {
    float l = st.l[ni];
    l += shx(l, 16);
    l += shx(l, 32);
    const float inv = 1.f / l;
    bf16* op = outbuf + ((size_t)b * S + tq[ni]) * 512 + h * 64 + g4 * 4;
#pragma unroll
    for (int di = 0; di < 4; ++di) {
      uint2 pk;
      pk.x = cvtpk(st.o[di][ni][0] * inv, st.o[di][ni][1] * inv);
      pk.y = cvtpk(st.o[di][ni][2] * inv, st.o[di][ni][3] * inv);
      *(uint2*)(op + di * 16) = pk;
    }
  }
}

DEV int moba_list_base(int n) { return n * S - 128 * n * (n + 1); }
template <int NI>
DEV void moba_gate_item(const Params& p, int item) {
  constexpr int QB = 64 * NI;
  const int bh = item & 15, cq = item >> 4;
  const int b = bh >> 3, h = bh & 7;
  const int s0 = cq * QB, blk = s0 >> 8;
  if (blk == 0) return;
  const int lane = tidx() & 63, wave = tidx() >> 6, g4 = lane >> 4, c16 = lane & 15;
  const bf16* proj = (const bf16*)(p.ws + OFF_PROJ) + (size_t)b * S * PC;
  bf16x8 qf[NI][2];
  int tq[NI];
#pragma unroll
  for (int ni = 0; ni < NI; ++ni) {
    tq[ni] = s0 + wave * 16 * NI + ni * 16 + c16;
#pragma unroll
    for (int ks = 0; ks < 2; ++ks)
      qf[ni][ks] = *(const bf16x8*)(proj + (size_t)tq[ni] * PC + C_MQ + h * 64 + ks * 32 + g4 * 8);
  }
  const bf16* kmh = (const bf16*)(p.ws + OFF_KMHL) + ((size_t)(b * 8 + h) * 64) * 64;
  const bf16* kml = kmh + (size_t)2 * 8 * 64 * 64;
  f32x4 gs[4][NI];
#pragma unroll
  for (int mi = 0; mi < 4; ++mi) {
#pragma unroll
    for (int ni = 0; ni < NI; ++ni) gs[mi][ni] = f32x4{0.f, 0.f, 0.f, 0.f};
#pragma unroll
    for (int ks = 0; ks < 2; ++ks) {
      bf16x8 ah = *(const bf16x8*)(kmh + (mi * 16 + c16) * 64 + ks * 32 + g4 * 8);
      bf16x8 al_ = *(const bf16x8*)(kml + (mi * 16 + c16) * 64 + ks * 32 + g4 * 8);
#pragma unroll
      for (int ni = 0; ni < NI; ++ni) {
        gs[mi][ni] = MFMA16(ah, qf[ni][ks], gs[mi][ni]);
        gs[mi][ni] = MFMA16(al_, qf[ni][ks], gs[mi][ni]);
      }
    }
  }
  unsigned short* lists = (unsigned short*)(p.ws + OFF_MLIST) + (size_t)(b * 8 + h) * MLIST_PER_BH;
  int* cnt = (int*)(p.ws + OFF_MCNT) + (b * 8 + h) * 64;
#pragma unroll
  for (int ni = 0; ni < NI; ++ni) {
#pragma unroll
    for (int mi = 0; mi < 4; ++mi)
#pragma unroll
      for (int r = 0; r < 4; ++r)
        if (mi * 16 + g4 * 4 + r >= blk) gs[mi][ni][r] = -INFINITY;
    const int s0i = gate_top1(gs, ni, g4);
    const int s1i = gate_top1(gs, ni, g4);
    const int s2i = gate_top1(gs, ni, g4);
    if (g4 == 0) {
      if (s0i >= 0) { const int pos = atomicAdd(cnt + s0i, 1); lists[moba_list_base(s0i) + pos] = (unsigned short)(tq[ni] | (0 << 14)); }
      if (s1i >= 0) { const int pos = atomicAdd(cnt + s1i, 1); lists[moba_list_base(s1i) + pos] = (unsigned short)(tq[ni] | (1 << 14)); }
      if (s2i >= 0) { const int pos = atomicAdd(cnt + s2i, 1); lists[moba_list_base(s2i) + pos] = (unsigned short)(tq[ni] | (2 << 14)); }
    }
  }
}
template <int NI>
DEV void moba_part_item(const Params& p, int b, int item, char* smem) {
  constexpr int CH = 64 * NI;
  bf16* smkv = (bf16*)smem;
  const int n = item >> 6, h = (item >> 3) & 7, part = item & 7;
  const int lane = tidx() & 63, wave = tidx() >> 6, g4 = lane >> 4, c16 = lane & 15;
  const int cnt = ((const int*)(p.ws + OFF_MCNT))[(b * 8 + h) * 64 + n];
  const unsigned short* list = (const unsigned short*)(p.ws + OFF_MLIST) + (size_t)(b * 8 + h) * MLIST_PER_BH + moba_list_base(n);
  const bf16* proj = (const bf16*)(p.ws + OFF_PROJ) + (size_t)b * S * PC;
  const bf16* kb = (const bf16*)(p.ws + OFF_MKB) + ((size_t)(b * 8 + h) * S + n * 256) * 64;
  const bf16* vb = (const bf16*)(p.ws + OFF_MVB) + ((size_t)(b * 8 + h) * S + n * 256) * 64;
  bf16* po = (bf16*)(p.ws + OFF_MPO);
  float2* pml = (float2*)(p.ws + OFF_MPML);
  for (int c = part; c * CH < cnt; c += 8) {
    bf16x8 qf[NI][2];
    int tcol[NI], slot[NI];
    bool valid[NI];
#pragma unroll
    for (int ni = 0; ni < NI; ++ni) {
      const int idx = c * CH + wave * 16 * NI + ni * 16 + c16;
      valid[ni] = idx < cnt;
      const unsigned e = list[valid[ni] ? idx : 0];
      tcol[ni] = e & 0x3FFF;
      slot[ni] = e >> 14;
#pragma unroll
      for (int ks = 0; ks < 2; ++ks)
        qf[ni][ks] = *(const bf16x8*)(proj + (size_t)tcol[ni] * PC + C_MQ + h * 64 + ks * 32 + g4 * 8);
    }
    AttnSt<NI> st;
    attn_init<NI>(st);
    __syncthreads();
#define MOBA_PKEY(i) ((i) * 64)
    KV_SWEEP(kb, vb, 64, 4, MOBA_PKEY,
      f32x4 s[4][NI];
      attn_scores<NI>(Ks, qf, s);
      attn_softmax_pv<NI>(Ks + KT_ELEMS, s, st);
    )
#pragma unroll
    for (int ni = 0; ni < NI; ++ni) {
      float l = st.l[ni];
      l += shx(l, 16);
      l += shx(l, 32);
      if (valid[ni]) {
        const size_t rec = ((size_t)h * S + tcol[ni]) * 3 + slot[ni];
        if (g4 == 0) pml[rec] = float2{st.m[ni], l};
        bf16* op = po + rec * 64 + g4 * 4;
#pragma unroll
        for (int di = 0; di < 4; ++di) {
          uint2 pk;
          pk.x = cvtpk(st.o[di][ni][0], st.o[di][ni][1]);
          pk.y = cvtpk(st.o[di][ni][2], st.o[di][ni][3]);
          *(uint2*)(op + di * 16) = pk;
        }
      }
    }
  }
}
template <int NI>
DEV void moba_part_item2(const Params& p, int b, int item, char* smem) {
  constexpr int WCH = 16 * NI;
  bf16* Kall = (bf16*)smem;
  bf16* Vall = Kall + 256 * KT_LD;
  static_assert(2 * 256 * KT_LD * 2 <= SMEM_BYTES, "moba block staging");
  const int n = item >> 6, h = (item >> 3) & 7, part = item & 7;
  const int tid = tidx(), lane = tid & 63, wave = tid >> 6, g4 = lane >> 4, c16 = lane & 15;
  const int cnt = ((const int*)(p.ws + OFF_MCNT))[(b * 8 + h) * 64 + n];
  const bool active = part * 4 * WCH < cnt;
  const unsigned short* list = (const unsigned short*)(p.ws + OFF_MLIST) + (size_t)(b * 8 + h) * MLIST_PER_BH + moba_list_base(n);
  const bf16* proj = (const bf16*)(p.ws + OFF_PROJ) + (size_t)b * S * PC;
  const bf16* kb = (const bf16*)(p.ws + OFF_MKB) + ((size_t)(b * 8 + h) * S + n * 256) * 64;
  const bf16* vb = (const bf16*)(p.ws + OFF_MVB) + ((size_t)(b * 8 + h) * S + n * 256) * 64;
  bf16* po = (bf16*)(p.ws + OFF_MPO);
  float2* pml = (float2*)(p.ws + OFF_MPML);
  __syncthreads();
  if (active) {
#pragma unroll
    for (int i = 0; i < 8; ++i) {
      const int id = tid + 256 * i, r = id >> 3, c = (id & 7) * 8;
      const uint4 kv = *(const uint4*)(kb + (size_t)r * 64 + c);
      const uint4 vv = *(const uint4*)(vb + (size_t)r * 64 + c);
      *(uint4*)(Kall + r * KT_LD + c) = kv;
      *(uint4*)(Vall + r * KT_LD + c) = vv;
    }
  }
  __syncthreads();
  if (!active) return;
  for (int wc = part * 4 + wave; wc * WCH < cnt; wc += 32) {
    bf16x8 qf[NI][2];
    int tcol[NI], slot[NI];
    bool valid[NI];
#pragma unroll
    for (int ni = 0; ni < NI; ++ni) {
      const int idx = wc * WCH + ni * 16 + c16;
      valid[ni] = idx < cnt;
      const unsigned e = list[valid[ni] ? idx : 0];
      tcol[ni] = e & 0x3FFF;
      slot[ni] = e >> 14;
#pragma unroll
      for (int ks = 0; ks < 2; ++ks)
        qf[ni][ks] = *(const bf16x8*)(proj + (size_t)tcol[ni] * PC + C_MQ + h * 64 + ks * 32 + g4 * 8);
    }
    AttnSt<NI> st;
    attn_init<NI>(st);
#pragma unroll 1
    for (int kt = 0; kt < 4; ++kt) {
      f32x4 s[4][NI];
      attn_scores<NI>(Kall + kt * 64 * KT_LD, qf, s);
      attn_softmax_pv<NI>(Vall + kt * 64 * KT_LD, s, st);
    }
#pragma unroll
    for (int ni = 0; ni < NI; ++ni) {
      float l = st.l[ni];
      l += shx(l, 16);
      l += shx(l, 32);
      if (valid[ni]) {
        const size_t rec = ((size_t)h * S + tcol[ni]) * 3 + slot[ni];
        if (g4 == 0) pml[rec] = float2{st.m[ni], l};
        bf16* op = po + rec * 64 + g4 * 4;
#pragma unroll
        for (int di = 0; di < 4; ++di) {
          uint2 pk;
          pk.x = cvtpk(st.o[di][ni][0], st.o[di][ni][1]);
          pk.y = cvtpk(st.o[di][ni][2], st.o[di][ni][3]);
          *(uint2*)(op + di * 16) = pk;
        }
      }
    }
  }
}
template <int NI>
DEV void moba_merge_item(const Params& p, int b, int item, char* smem, bf16* outbuf) {
  constexpr int QB = 64 * NI;
  constexpr int NCQ = S / QB;
  bf16* smkv = (bf16*)smem;
  const int h = item & 7, cq = item >> 3;
  static_assert(NCQ * 8 == 8 * (S / QB), "");
  const int s0 = cq * QB, blk = s0 >> 8;
  const int lane = tidx() & 63, wave = tidx() >> 6, g4 = lane >> 4, c16 = lane & 15;
  const bf16* proj = (const bf16*)(p.ws + OFF_PROJ) + (size_t)b * S * PC;
  bf16x8 qf[NI][2];
  int tq[NI];
#pragma unroll
  for (int ni = 0; ni < NI; ++ni) {
    tq[ni] = s0 + wave * 16 * NI + ni * 16 + c16;
#pragma unroll
    for (int ks = 0; ks < 2; ++ks)
      qf[ni][ks] = *(const bf16x8*)(proj + (size_t)tq[ni] * PC + C_MQ + h * 64 + ks * 32 + g4 * 8);
  }
  const bf16* kb = (const bf16*)(p.ws + OFF_MKB) + ((size_t)(b * 8 + h) * S) * 64;
  const bf16* vb = (const bf16*)(p.ws + OFF_MVB) + ((size_t)(b * 8 + h) * S) * 64;
  AttnSt<NI> st;
  attn_init<NI>(st);
  const int kt0 = blk * 4;
  const int ntl = ((s0 + QB - 1) >> 6) - kt0 + 1;
  __syncthreads();
#define MOBA_MKEY(i) ((kt0 + (i)) * 64)
  KV_SWEEP(kb, vb, 64, ntl, MOBA_MKEY,
    const int kbase = (kt0 + it) * 64;
    f32x4 s[4][NI];
    attn_scores<NI>(Ks, qf, s);
    _Pragma("unroll") for (int ni = 0; ni < NI; ++ni)
      _Pragma("unroll") for (int mi = 0; mi < 4; ++mi)
        _Pragma("unroll") for (int r = 0; r < 4; ++r)
          if (kbase + mi * 16 + g4 * 4 + r > tq[ni]) s[mi][ni][r] = -INFINITY;
    attn_softmax_pv<NI>(Ks + KT_ELEMS, s, st);
  )
  const int nsl = (blk < 3) ? blk : 3;
  const bf16* po = (const bf16*)(p.ws + OFF_MPO);
  const float2* pml = (const float2*)(p.ws + OFF_MPML);
#pragma unroll
  for (int ni = 0; ni < NI; ++ni) {
    float l = st.l[ni];
    l += shx(l, 16);
    l += shx(l, 32);
    const size_t rec0 = ((size_t)h * S + tq[ni]) * 3;
    float ms[3], ls[3];
    float M = st.m[ni];
#pragma unroll
    for (int s = 0; s < 3; ++s) {
      ms[s] = -INFINITY;
      ls[s] = 0.f;
      if (s < nsl) {
        const float2 v = pml[rec0 + s];
        ms[s] = v.x;
        ls[s] = v.y;
        M = fmaxf(M, v.x);
      }
    }
    const float fo = __builtin_amdgcn_exp2f((st.m[ni] - M) * C2);
    l *= fo;
    float f[3];
#pragma unroll
    for (int s = 0; s < 3; ++s) {
      f[s] = (s < nsl) ? __builtin_amdgcn_exp2f((ms[s] - M) * C2) : 0.f;
      l += ls[s] * f[s];
    }
    const float inv = 1.f / l;
    bf16* op = outbuf + ((size_t)b * S + tq[ni]) * 512 + h * 64 + g4 * 4;
#pragma unroll
    for (int di = 0; di < 4; ++di) {
      float o0 = st.o[di][ni][0] * fo, o1 = st.o[di][ni][1] * fo, o2 = st.o[di][ni][2] * fo, o3 = st.o[di][ni][3] * fo;
#pragma unroll
      for (int s = 0; s < 3; ++s) {
        if (s < nsl) {
          const uint2 pv = *(const uint2*)(po + (rec0 + s) * 64 + di * 16 + g4 * 4);
          o0 += f[s] * __uint_as_float(pv.x << 16);
          o1 += f[s] * __uint_as_float(pv.x & 0xffff0000u);
          o2 += f[s] * __uint_as_float(pv.y << 16);
          o3 += f[s] * __uint_as_float(pv.y & 0xffff0000u);
        }
      }
      uint2 pk;
      pk.x = cvtpk(o0 * inv, o1 * inv);
      pk.y = cvtpk(o2 * inv, o3 * inv);
      *(uint2*)(op + di * 16) = pk;
    }
  }
}

template <int NI>
DEV void attn_stats(f32x4 (&s)[4][NI], float (&m)[NI], float (&l)[NI]) {
#pragma unroll
  for (int ni = 0; ni < NI; ++ni) {
    float mx = -INFINITY;
#pragma unroll
    for (int mi = 0; mi < 4; ++mi)
      mx = fmaxf(fmaxf(mx, fmaxf(s[mi][ni][0], s[mi][ni][1])), fmaxf(s[mi][ni][2], s[mi][ni][3]));
    mx = fmaxf(mx, shx(mx, 16));
    mx = fmaxf(mx, shx(mx, 32));
    const float mn = fmaxf(m[ni], mx);
    const float mu = (mn == -INFINITY) ? 0.f : mn;
    const float corr = __builtin_amdgcn_exp2f((m[ni] - mu) * C2);
    m[ni] = mn;
    const float nm = -mu * C2;
    float ps = 0.f;
#pragma unroll
    for (int mi = 0; mi < 4; ++mi)
#pragma unroll
      for (int r = 0; r < 4; ++r) ps += __builtin_amdgcn_exp2f(__builtin_fmaf(s[mi][ni][r], C2, nm));
    l[ni] = l[ni] * corr + ps;
  }
}
DEV bf16x8 rope_frag(bf16x8 qv, const float* __restrict__ rope_t, int g4) {
  u32x4_t w = __builtin_bit_cast(u32x4_t, qv);
  u32x4_t pw;
  pw.x = shx(w.x, 16); pw.y = shx(w.y, 16); pw.z = shx(w.z, 16); pw.w = shx(w.w, 16);
  float f[8], pf[8];
  unpack8(uint4{w.x, w.y, w.z, w.w}, f);
  unpack8(uint4{pw.x, pw.y, pw.z, pw.w}, pf);
  const float4 c0 = *(const float4*)(rope_t), c1 = *(const float4*)(rope_t + 4);
  const float4 s0 = *(const float4*)(rope_t + 8), s1 = *(const float4*)(rope_t + 12);
  const float cs[8] = {c0.x, c0.y, c0.z, c0.w, c1.x, c1.y, c1.z, c1.w};
  const float sn[8] = {s0.x, s0.y, s0.z, s0.w, s1.x, s1.y, s1.z, s1.w};
  const float sg = (g4 == 0) ? -1.f : 1.f;
  float o[8];
#pragma unroll
  for (int i = 0; i < 8; ++i) o[i] = (g4 < 2) ? (f[i] * cs[i] + sg * pf[i] * sn[i]) : f[i];
  u32x4_t r;
  r.x = cvtpk(o[0], o[1]); r.y = cvtpk(o[2], o[3]); r.z = cvtpk(o[4], o[5]); r.w = cvtpk(o[6], o[7]);
  return __builtin_bit_cast(bf16x8, r);
}

DEV unsigned pack4_fp8q(float a, float b, float c, float d) {
  int q = __builtin_amdgcn_cvt_pk_fp8_f32(a, b, 0, false);
  q = __builtin_amdgcn_cvt_pk_fp8_f32(c, d, q, true);
  return (unsigned)q;
}
DEV float amax8_bf16(uint4 v, float m) {
  float f[8];
  unpack8(v, f);
#pragma unroll
  for (int i = 0; i < 8; ++i) m = fmaxf(m, fabsf(f[i]));
  return m;
}
DEV void kvamax_item(const Params& p, int layer, int item) {
  const int tid = tidx();
  const int bk = item >> 6, part = item & 63;
  const bf16* kp = (const bf16*)(p.ws + OFF_KSB) + ((size_t)bk * S + part * 256) * 64 + tid * 64;
  const bf16* vp = (const bf16*)(p.ws + OFF_VSB) + ((size_t)bk * S + part * 256) * 64 + tid * 64;
  float mk = 0.f, mv = 0.f;
#pragma unroll
  for (int i = 0; i < 8; ++i) {
    mk = amax8_bf16(*(const uint4*)(kp + i * 8), mk);
    mv = amax8_bf16(*(const uint4*)(vp + i * 8), mv);
  }
#pragma unroll
  for (int o = 32; o >= 1; o >>= 1) { mk = fmaxf(mk, shx(mk, o)); mv = fmaxf(mv, shx(mv, o)); }
  if ((tid & 63) == 0) {
    atomicMax((unsigned*)(p.ws + OFF_BAR) + 2 + 2 * layer, (unsigned)__float_as_int(mk));
    atomicMax((unsigned*)(p.ws + OFF_BAR) + 3 + 2 * layer, (unsigned)__float_as_int(mv));
  }
}
DEV float kv_amax(const Params& p, int layer, int which) {
  return __int_as_float((int)__hip_atomic_load((const unsigned*)(p.ws + OFF_BAR) + 2 + 2 * layer + which, __ATOMIC_RELAXED, __HIP_MEMORY_SCOPE_AGENT));
}
DEV void kvq_item(const Params& p, int layer, int item, float* sm) {
  const int tid = tidx();
  const int bk = item >> 8, blk = item & 255;
  const float ak = kv_amax(p, layer, 0), av = kv_amax(p, layer, 1);
  const float ik = (ak > 0.f) ? 224.f / ak : 0.f, iv = (av > 0.f) ? 224.f / av : 0.f;
  const size_t row0 = (size_t)bk * S + blk * 64;
  {
    const int r = tid >> 2, q = tid & 3;
    const bf16* kp = (const bf16*)(p.ws + OFF_KSB) + (row0 + r) * 64 + q * 16;
    float f[16];
    unpack8(*(const uint4*)kp, f);
    unpack8(*(const uint4*)(kp + 8), f + 8);
    uint2 o0, o1;
    o0.x = pack4_fp8q(f[0] * ik, f[1] * ik, f[2] * ik, f[3] * ik);
    o0.y = pack4_fp8q(f[4] * ik, f[5] * ik, f[6] * ik, f[7] * ik);
    o1.x = pack4_fp8q(f[8] * ik, f[9] * ik, f[10] * ik, f[11] * ik);
    o1.y = pack4_fp8q(f[12] * ik, f[13] * ik, f[14] * ik, f[15] * ik);
    unsigned char* kd = (unsigned char*)(p.ws + OFF_KS8) + (row0 + r) * 64 + 32 * (q & 1) + 8 * (q >> 1);
    *(uint2*)kd = o0;
    *(uint2*)(kd + 16) = o1;
    const bf16* vp = (const bf16*)(p.ws + OFF_VSB) + (row0 + r) * 64 + q * 16;
    unpack8(*(const uint4*)vp, f);
    unpack8(*(const uint4*)(vp + 8), f + 8);
#pragma unroll
    for (int i = 0; i < 16; ++i) sm[r * 65 + q * 16 + i] = f[i] * iv;
  }
  __syncthreads();
  {
    const int d = tid >> 2, q = tid & 3;
    float f[16];
#pragma unroll
    for (int i = 0; i < 16; ++i) {
      const int g4 = q, ks2 = i >> 3, j = i & 7;
      const int key = 32 * ks2 + 16 * (j >> 2) + 4 * g4 + (j & 3);
      f[i] = sm[key * 65 + d];
    }
    uint4 o;
    o.x = pack4_fp8q(f[0], f[1], f[2], f[3]);
    o.y = pack4_fp8q(f[4], f[5], f[6], f[7]);
    o.z = pack4_fp8q(f[8], f[9], f[10], f[11]);
    o.w = pack4_fp8q(f[12], f[13], f[14], f[15]);
    *(uint4*)((unsigned char*)(p.ws + OFF_VT8) + row0 * 64 + d * 64 + q * 16) = o;
  }
  __syncthreads();
}
typedef long i64_t;
#define MFMA8(a, b, c) __builtin_amdgcn_mfma_f32_16x16x32_fp8_fp8(a, b, c, 0, 0, 0)
template <int NI>
DEV void softmax_one8(f32x4 (&s)[4], AttnSt<NI>& st, f32x4& lacc, int ni, float c2, bool sel, i64_t& pf0, i64_t& pf1) {
  float mx = -INFINITY;
#pragma unroll
  for (int mi = 0; mi < 4; ++mi)
    mx = fmaxf(fmaxf(mx, fmaxf(s[mi][0], s[mi][1])), fmaxf(s[mi][2], s[mi][3]));
  mx = fmaxf(mx, shx(mx, 16));
  mx = fmaxf(mx, shx(mx, 32));
  const float mxs = sel ? mx * c2 : -INFINITY;
  if (__builtin_amdgcn_ballot_w64(mxs > st.m[ni] + 1.0f) != 0ull) {
    const float mn = fmaxf(st.m[ni], mxs);
    const float mu = (mn == -INFINITY) ? 0.f : mn;
    const float corr = __builtin_amdgcn_exp2f(st.m[ni] - mu);
    st.m[ni] = mn;
    lacc[0] *= corr; lacc[1] *= corr; lacc[2] *= corr; lacc[3] *= corr;
#pragma unroll
    for (int di = 0; di < 4; ++di) {
      st.o[di][ni][0] *= corr; st.o[di][ni][1] *= corr; st.o[di][ni][2] *= corr; st.o[di][ni][3] *= corr;
    }
  }
  const float nm = (sel && st.m[ni] > -INFINITY) ? 7.f - st.m[ni] : -INFINITY;
  unsigned w[4];
#pragma unroll
  for (int mi = 0; mi < 4; ++mi) {
    const float p0 = __builtin_amdgcn_exp2f(__builtin_fmaf(s[mi][0], c2, nm));
    const float p1 = __builtin_amdgcn_exp2f(__builtin_fmaf(s[mi][1], c2, nm));
    const float p2 = __builtin_amdgcn_exp2f(__builtin_fmaf(s[mi][2], c2, nm));
    const float p3 = __builtin_amdgcn_exp2f(__builtin_fmaf(s[mi][3], c2, nm));
    w[mi] = pack4_fp8q(p0, p1, p2, p3);
  }
  pf0 = (i64_t)(((unsigned long long)w[1] << 32) | (unsigned long long)w[0]);
  pf1 = (i64_t)(((unsigned long long)w[3] << 32) | (unsigned long long)w[2]);
  const i64_t ones = 0x3838383838383838ll;
  lacc = MFMA8(ones, pf0, lacc);
  lacc = MFMA8(ones, pf1, lacc);
}
template <int NI>
DEV void nsa_item(const Params& p, int layer, int item, char* smem, bf16* outbuf) {
  constexpr int QN = 16 * NI;
  constexpr int NCH = S / QN;
  bf16* smkv = (bf16*)smem;
  float* imp = (float*)(smem + 36864);
  int* sel = (int*)(smem + 36864 + QN * 257 * 4);
  unsigned* bmq = (unsigned*)(sel + QN * 16);
  unsigned* bmu = bmq + QN * 8;
  int* ulist = (int*)(bmu + 4 * NI * 8);
  static_assert(36864 + QN * 257 * 4 + QN * 16 * 4 + QN * 8 * 4 + 4 * NI * 8 * 4 + 257 * 4 <= SMEM_BYTES, "nsa lds");
  static_assert(NI == 2, "per-wave union bitmaps use bmu[8 .. 40)");
  const int tid = tidx(), lane = tid & 63, wave = tid >> 6, g4 = lane >> 4, c16 = lane & 15;
  const int bk = item & 3, cq = (NCH - 1) - (item >> 2);
  const int b = bk >> 1, kvh = bk & 1;
  const int s0 = cq * QN, cur = s0 >> 6;
  if (PROBE_NSA && b == 1) return;
  const bf16* proj = (const bf16*)(p.ws + OFF_PROJ) + (size_t)b * S * PC;
  const float* rope = (const float*)(p.ws + OFF_ROPE);
  int tq[NI], qlv[NI];
  float gate0[NI], gate1[NI], gate2[NI];
  bf16x8 qraw[NI][2], qrot[NI][2];
#pragma unroll
  for (int ni = 0; ni < NI; ++ni) {
    const int R = wave * 16 * NI + ni * 16 + c16;
    qlv[ni] = R >> 2;
    const int g = R & 3;
    tq[ni] = s0 + qlv[ni];
    const bf16* qp = proj + (size_t)tq[ni] * PC + C_NQ + (kvh * 4 + g) * 64 + g4 * 8;
    qraw[ni][0] = *(const bf16x8*)(qp);
    qraw[ni][1] = *(const bf16x8*)(qp + 32);
    qrot[ni][0] = rope_frag(qraw[ni][0], rope + (size_t)tq[ni] * 16, g4);
    qrot[ni][1] = qraw[ni][1];
    const bf16* gp = proj + (size_t)tq[ni] * PC + C_NG + (kvh * 4 + g) * 3;
    gate0[ni] = (!PROBE_NSA || (PROBE_NSA & 1)) ? sigmoidf_(bf2f(gp[0])) : 0.f;
    gate1[ni] = (!PROBE_NSA || (PROBE_NSA & 2)) ? sigmoidf_(bf2f(gp[1])) : 0.f;
    gate2[ni] = (!PROBE_NSA || (PROBE_NSA & 4)) ? sigmoidf_(bf2f(gp[2])) : 0.f;
  }
  for (int i = tid; i < QN * 257; i += 256) imp[i] = 0.f;
  for (int i = tid; i < QN * 8 + 4 * NI * 8; i += 256) bmq[i] = 0u;
  f32x4 acc[4][NI];
#pragma unroll
  for (int ni = 0; ni < NI; ++ni)
#pragma unroll
    for (int di = 0; di < 4; ++di) acc[di][ni] = f32x4{0.f, 0.f, 0.f, 0.f};
  TILE_DECL;
  {
    int nv[NI];
#pragma unroll
    for (int ni = 0; ni < NI; ++ni) nv[ni] = (tq[ni] >= 31) ? (((tq[ni] - 31) >> 4) + 1) : 0;
    const int tlast = s0 + QN - 1;
    const int nvmax = (tlast >= 31) ? (((tlast - 31) >> 4) + 1) : 0;
    const int ntc = (nvmax + 63) >> 6;
    const bf16* kb = (const bf16*)(p.ws + OFF_KCB) + ((size_t)(b * 2 + kvh) * 1024) * 64;
    const bf16* vb = (const bf16*)(p.ws + OFF_VCB) + ((size_t)(b * 2 + kvh) * 1024) * 64;
    float mA[NI], lA[NI];
#pragma unroll
    for (int ni = 0; ni < NI; ++ni) { mA[ni] = -INFINITY; lA[ni] = 0.f; }
    __syncthreads();
    if (ntc > 0) {
      for (int rep_ = 0; rep_ < ((REP_NSA_PART & 1) ? 2 : 1); ++rep_) {
#pragma unroll
      for (int ni = 0; ni < NI; ++ni) { mA[ni] = -INFINITY; lA[ni] = 0.f; }
      TILE_GLOAD(kb, vb, 64, 0);
      TILE_SSTORE(smkv, smkv + KT_ELEMS);
      __syncthreads();
      for (int kt = 0; kt < ntc; ++kt) {
        if (kt + 1 < ntc) TILE_GLOAD(kb, vb, 64, (kt + 1) * 64);
        const bf16* Ks = smkv + (kt & 1) * 2 * KT_ELEMS;
        f32x4 s[4][NI];
        attn_scores<NI>(Ks, qraw, s);
#pragma unroll
        for (int ni = 0; ni < NI; ++ni)
#pragma unroll
          for (int mi = 0; mi < 4; ++mi)
#pragma unroll
            for (int r = 0; r < 4; ++r)
              if (kt * 64 + mi * 16 + g4 * 4 + r >= nv[ni]) s[mi][ni][r] = -INFINITY;
        attn_stats<NI>(s, mA, lA);
        if (kt + 1 < ntc) {
          bf16* Kn = smkv + ((kt + 1) & 1) * 2 * KT_ELEMS;
          TILE_SSTORE(Kn, Kn + KT_ELEMS);
        }
        __syncthreads();
      }
      }
      float nmB[NI];
#pragma unroll
      for (int ni = 0; ni < NI; ++ni) {
        float l = lA[ni];
        l += shx(l, 16);
        l += shx(l, 32);
        nmB[ni] = (l > 0.f) ? -(mA[ni] * C2 + __builtin_amdgcn_logf(l)) : 0.f;
      }
      TILE_GLOAD(kb, vb, 64, 0);
      TILE_SSTORE(smkv, smkv + KT_ELEMS);
      __syncthreads();
      for (int kt = 0; kt < ntc; ++kt) {
        if (kt + 1 < ntc) TILE_GLOAD(kb, vb, 64, (kt + 1) * 64);
        const bf16* Ks = smkv + (kt & 1) * 2 * KT_ELEMS;
        f32x4 s[4][NI];
        attn_scores<NI>(Ks, qraw, s);
        bf16x8 pf[NI][2];
#pragma unroll
        for (int ni = 0; ni < NI; ++ni) {
          u32x4_t wa, wb;
          float* irow = imp + qlv[ni] * 257 + kt * 16 + g4;
#pragma unroll
          for (int mi = 0; mi < 4; ++mi) {
            float pr[4];
#pragma unroll
            for (int r = 0; r < 4; ++r) {
              const bool ok = (kt * 64 + mi * 16 + g4 * 4 + r) < nv[ni];
              pr[r] = ok ? __builtin_amdgcn_exp2f(__builtin_fmaf(s[mi][ni][r], C2, nmB[ni])) : 0.f;
            }
            float mainv = pr[0] + pr[1] + pr[2] + 0.5f * pr[3];
            float spv = 0.5f * pr[3];
            mainv += shx(mainv, 1);
            mainv += shx(mainv, 2);
            spv += shx(spv, 1);
            spv += shx(spv, 2);
            if ((c16 & 3) == 0) {
              atomicAdd(irow + mi * 4, mainv);
              atomicAdd(irow + mi * 4 + 1, spv);
            }
            const unsigned w0 = cvtpk(pr[0], pr[1]), w1 = cvtpk(pr[2], pr[3]);
            if (mi == 0) { wa.x = w0; wa.y = w1; }
            if (mi == 1) { wa.z = w0; wa.w = w1; }
            if (mi == 2) { wb.x = w0; wb.y = w1; }
            if (mi == 3) { wb.z = w0; wb.w = w1; }
          }
          pf[ni][0] = __builtin_bit_cast(bf16x8, wa);
          pf[ni][1] = __builtin_bit_cast(bf16x8, wb);
        }
        attn_pv<NI>(Ks + KT_ELEMS, pf, acc);
        if (kt + 1 < ntc) {
          bf16* Kn = smkv + ((kt + 1) & 1) * 2 * KT_ELEMS;
          TILE_SSTORE(Kn, Kn + KT_ELEMS);
        }
        __syncthreads();
      }
    }
#pragma unroll
    for (int ni = 0; ni < NI; ++ni)
#pragma unroll
      for (int di = 0; di < 4; ++di) {
        acc[di][ni][0] *= gate0[ni]; acc[di][ni][1] *= gate0[ni]; acc[di][ni][2] *= gate0[ni]; acc[di][ni][3] *= gate0[ni];
      }
  }
  __syncthreads();
#if PROBE_NSA == 8
  if (b == 0 && kvh == 0)
    for (int i = tid; i < QN * 256; i += 256)
      ((float*)(p.ws + OFF_OMOBA))[(size_t)S * 256 + (size_t)(s0 + (i >> 8)) * 256 + (i & 255)] = imp[(i >> 8) * 257 + (i & 255)];
  __syncthreads();
#endif
  for (int qq = 0; qq < 4 * NI; ++qq) {
    const int ql = wave * 4 * NI + qq;
    int mysel = -1;
    if (cur < 16) {
      mysel = (lane <= cur) ? lane : -1;
    } else {
      const float* row = imp + ql * 257;
      float v0 = row[lane], v1 = row[64 + lane], v2 = row[128 + lane], v3 = row[192 + lane];
      if (lane < 1 || lane > cur - 2) v0 = -1.f;
      if (64 + lane > cur - 2) v1 = -1.f;
      if (128 + lane > cur - 2) v2 = -1.f;
      if (192 + lane > cur - 2) v3 = -1.f;
      if (lane == 0) mysel = 0;
      if (lane == 1) mysel = cur - 1;
      if (lane == 2) mysel = cur;
      for (int rd = 3; rd < 16; ++rd) {
        float bv = v0;
        int bi = lane;
        if (v1 > bv) { bv = v1; bi = 64 + lane; }
        if (v2 > bv) { bv = v2; bi = 128 + lane; }
        if (v3 > bv) { bv = v3; bi = 192 + lane; }
#pragma unroll
        for (int off = 32; off >= 1; off >>= 1) {
          float ov = shx(bv, off);
          int oi = shx(bi, off);
          if (ov > bv || (ov == bv && oi < bi)) { bv = ov; bi = oi; }
        }
        if (lane == rd) mysel = bi;
        if ((bi & 63) == lane) {
          const int k = bi >> 6;
          if (k == 0) v0 = -2.f; else if (k == 1) v1 = -2.f; else if (k == 2) v2 = -2.f; else v3 = -2.f;
        }
      }
    }
#if PROBE_NSA == 2
    mysel = (lane < 16) ? ((const int*)(p.ws + OFF_SEL))[(((size_t)b * 2 + kvh) * S + s0 + ql) * 16 + lane] : -1;
#endif
#if PROBE_NSA == 8
    if (lane < 16 && b == 0 && kvh == 0) ((int*)(p.ws + OFF_CMP))[(size_t)(s0 + ql) * 16 + lane] = mysel;
#endif
    if (lane < 16) {
      sel[ql * 16 + lane] = mysel;
      if (mysel >= 0) {
        atomicOr(&bmq[ql * 8 + (mysel >> 5)], 1u << (mysel & 31));
        atomicOr(&bmu[mysel >> 5], 1u << (mysel & 31));
        atomicOr(&bmu[8 + wave * 8 + (mysel >> 5)], 1u << (mysel & 31));
      }
    }
  }
  __syncthreads();
  {
    const int n = tid;
    const unsigned wv = bmu[n >> 5];
    if ((wv >> (n & 31)) & 1u) {
      int pos = __builtin_popcount(wv & ((1u << (n & 31)) - 1u));
      for (int w = 0; w < (n >> 5); ++w) pos += __builtin_popcount(bmu[w]);
      ulist[pos] = n;
    }
    if (tid == 0) {
      int c = 0;
      for (int w = 0; w < 8; ++w) c += __builtin_popcount(bmu[w]);
      ulist[256] = c;
    }
  }
  __syncthreads();
  {
    AttnSt<NI> st;
    attn_init<NI>(st);
    const int klo = (s0 - 511 > 0) ? (s0 - 511) : 0;
    const int kt0 = klo >> 6, kt1 = (s0 + QN - 1) >> 6;
    const bf16* kb = (const bf16*)(p.ws + OFF_KWB) + ((size_t)(b * 2 + kvh) * S) * 64;
    const bf16* vb = (const bf16*)(p.ws + OFF_VWB) + ((size_t)(b * 2 + kvh) * S) * 64;
    for (int rep_ = 0; rep_ < ((REP_NSA_PART & 2) ? 2 : 1); ++rep_) {
    attn_init<NI>(st);
    TILE_GLOAD(kb, vb, 64, kt0 * 64);
    TILE_SSTORE(smkv, smkv + KT_ELEMS);
    __syncthreads();
    for (int kt = kt0; kt <= kt1; ++kt) {
      if (kt + 1 <= kt1) TILE_GLOAD(kb, vb, 64, (kt + 1) * 64);
      const bf16* Ks = smkv + ((kt - kt0) & 1) * 2 * KT_ELEMS;
      f32x4 s[4][NI];
      attn_scores<NI>(Ks, qrot, s);
#pragma unroll
      for (int ni = 0; ni < NI; ++ni)
#pragma unroll
        for (int mi = 0; mi < 4; ++mi)
#pragma unroll
          for (int r = 0; r < 4; ++r) {
            const int key = kt * 64 + mi * 16 + g4 * 4 + r;
            if (key > tq[ni] || key <= tq[ni] - 512) s[mi][ni][r] = -INFINITY;
          }
      attn_softmax_pv<NI>(Ks + KT_ELEMS, s, st);
      if (kt + 1 <= kt1) {
        bf16* Kn = smkv + ((kt + 1 - kt0) & 1) * 2 * KT_ELEMS;
        TILE_SSTORE(Kn, Kn + KT_ELEMS);
      }
      __syncthreads();
    }
    }
#pragma unroll
    for (int ni = 0; ni < NI; ++ni) {
      float l = st.l[ni];
      l += shx(l, 16);
      l += shx(l, 32);
      const float sc = gate2[ni] / l;
#pragma unroll
      for (int di = 0; di < 4; ++di) {
        acc[di][ni][0] += sc * st.o[di][ni][0]; acc[di][ni][1] += sc * st.o[di][ni][1];
        acc[di][ni][2] += sc * st.o[di][ni][2]; acc[di][ni][3] += sc * st.o[di][ni][3];
      }
    }
  }
  {
    float* accs = imp + tid;
#pragma unroll
    for (int ni = 0; ni < NI; ++ni)
#pragma unroll
      for (int di = 0; di < 4; ++di)
#pragma unroll
        for (int r = 0; r < 4; ++r) accs[((ni * 4 + di) * 4 + r) * 256] = acc[di][ni][r];
    AttnSt<NI> st;
    attn_init<NI>(st);
    const bf16* kb = (const bf16*)(p.ws + OFF_KSB) + ((size_t)(b * 2 + kvh) * S) * 64;
    const bf16* vb = (const bf16*)(p.ws + OFF_VSB) + ((size_t)(b * 2 + kvh) * S) * 64;
#ifndef NSA_SEL_WAVE
#define NSA_SEL_WAVE 1
#endif
#if NSA_SEL_WAVE
    {
      int* wl = ulist;
      const unsigned* bw = bmu + 8 + wave * 8;
      unsigned short* wl16 = (unsigned short*)wl + wave * 128;
      int nuw = 0;
#pragma unroll
      for (int j = 0; j < 4; ++j) {
        const int nblk = j * 64 + lane;
        const bool setb = (bw[nblk >> 5] >> (nblk & 31)) & 1u;
        const unsigned long long mk = __builtin_amdgcn_ballot_w64(setb);
        if (setb) wl16[nuw + __builtin_popcountll(mk & ((1ull << lane) - 1ull))] = (unsigned short)nblk;
        nuw += __builtin_popcountll(mk);
      }
      __builtin_amdgcn_fence(__ATOMIC_RELEASE, "workgroup");
      __builtin_amdgcn_wave_barrier();
      const int layer_ = layer;
      const float kscale = kv_amax(p, layer_, 0) * (1.f / 224.f), vscale = kv_amax(p, layer_, 1) * (1.f / 224.f);
      typedef long u64x2_t __attribute__((ext_vector_type(2)));
      const unsigned char* kb8 = (const unsigned char*)(p.ws + OFF_KS8) + (size_t)(b * 2 + kvh) * S * 64 + c16 * 64 + g4 * 16;
      const unsigned char* vt8 = (const unsigned char*)(p.ws + OFF_VT8) + (size_t)(b * 2 + kvh) * S * 64 + c16 * 64 + g4 * 16;
      i64_t q8[NI][2];
      float c2col[NI];
#pragma unroll
      for (int ni = 0; ni < NI; ++ni) {
        float f0[8], f1[8];
        { const u32x4_t w = __builtin_bit_cast(u32x4_t, qrot[ni][0]); unpack8(uint4{w.x, w.y, w.z, w.w}, f0); }
        { const u32x4_t w = __builtin_bit_cast(u32x4_t, qrot[ni][1]); unpack8(uint4{w.x, w.y, w.z, w.w}, f1); }
        float qa = 0.f;
#pragma unroll
        for (int i = 0; i < 8; ++i) qa = fmaxf(qa, fmaxf(fabsf(f0[i]), fabsf(f1[i])));
        qa = fmaxf(qa, shx(qa, 16));
        qa = fmaxf(qa, shx(qa, 32));
        qa = fmaxf(qa, 1e-30f);
        const float qi = 224.f / qa;
        q8[ni][0] = (i64_t)(((unsigned long long)pack4_fp8q(f0[4] * qi, f0[5] * qi, f0[6] * qi, f0[7] * qi) << 32) |
                            (unsigned long long)pack4_fp8q(f0[0] * qi, f0[1] * qi, f0[2] * qi, f0[3] * qi));
        q8[ni][1] = (i64_t)(((unsigned long long)pack4_fp8q(f1[4] * qi, f1[5] * qi, f1[6] * qi, f1[7] * qi) << 32) |
                            (unsigned long long)pack4_fp8q(f1[0] * qi, f1[1] * qi, f1[2] * qi, f1[3] * qi));
        c2col[ni] = C2 * kscale * qa * (1.f / 224.f);
      }
      i64_t ka00 = 0, ka01 = 0, ka10 = 0, ka11 = 0, ka20 = 0, ka21 = 0, ka30 = 0, ka31 = 0;
      i64_t va00 = 0, va01 = 0, va10 = 0, va11 = 0, va20 = 0, va21 = 0, va30 = 0, va31 = 0;
      i64_t kb00 = 0, kb01 = 0, kb10 = 0, kb11 = 0, kb20 = 0, kb21 = 0, kb30 = 0, kb31 = 0;
      i64_t vb00 = 0, vb01 = 0, vb10 = 0, vb11 = 0, vb20 = 0, vb21 = 0, vb30 = 0, vb31 = 0;
#define NS8_LD2(A0, A1, ptr_) { const u64x2_t t_ = *(const u64x2_t*)(ptr_); A0 = t_.x; A1 = t_.y; }
#define NS8_LOAD(K, V, nb_)                                                                             \
      {                                                                                                 \
        const unsigned char* kp_ = kb8 + (size_t)(nb_) * 4096;                                          \
        NS8_LD2(K##00, K##01, kp_) NS8_LD2(K##10, K##11, kp_ + 1024) NS8_LD2(K##20, K##21, kp_ + 2048) NS8_LD2(K##30, K##31, kp_ + 3072) \
        const unsigned char* vp_ = vt8 + (size_t)(nb_) * 4096;                                          \
        NS8_LD2(V##00, V##01, vp_) NS8_LD2(V##10, V##11, vp_ + 1024) NS8_LD2(V##20, V##21, vp_ + 2048) NS8_LD2(V##30, V##31, vp_ + 3072) \
      }
#define NS8_STEP(K, V, KN, VN, i_)                                                                      \
      {                                                                                                 \
        const int n = wl16[(i_)];                                                                       \
        if ((i_) + 1 < nuw) NS8_LOAD(KN, VN, (int)wl16[(i_) + 1])                                       \
        bool qsel[NI], act[NI];                                                                         \
        _Pragma("unroll") for (int ni = 0; ni < NI; ++ni) {                                             \
          qsel[ni] = (bmq[qlv[ni] * 8 + (n >> 5)] >> (n & 31)) & 1u;                                    \
          act[ni] = __builtin_amdgcn_ballot_w64(qsel[ni]) != 0ull;                                      \
        }                                                                                               \
        i64_t pf[NI][2];                                                                                \
        _Pragma("unroll") for (int ni = 0; ni < NI; ++ni) {                                             \
          pf[ni][0] = 0; pf[ni][1] = 0;                                                                 \
          if (!act[ni]) continue;                                                                       \
          f32x4 s[4];                                                                                   \
          s[0] = MFMA8(K##00, q8[ni][0], (f32x4{0.f, 0.f, 0.f, 0.f}));                                  \
          s[0] = MFMA8(K##01, q8[ni][1], s[0]);                                                         \
          s[1] = MFMA8(K##10, q8[ni][0], (f32x4{0.f, 0.f, 0.f, 0.f}));                                  \
          s[1] = MFMA8(K##11, q8[ni][1], s[1]);                                                         \
          s[2] = MFMA8(K##20, q8[ni][0], (f32x4{0.f, 0.f, 0.f, 0.f}));                                  \
          s[2] = MFMA8(K##21, q8[ni][1], s[2]);                                                         \
          s[3] = MFMA8(K##30, q8[ni][0], (f32x4{0.f, 0.f, 0.f, 0.f}));                                  \
          s[3] = MFMA8(K##31, q8[ni][1], s[3]);                                                         \
          if (n == cur) {                   \
            _Pragma("unroll") for (int mi = 0; mi < 4; ++mi)                                            \
              _Pragma("unroll") for (int r = 0; r < 4; ++r) {                                           \
                const int key = n * 64 + mi * 16 + g4 * 4 + r;                                          \
                if (key > tq[ni]) s[mi][r] = -INFINITY;                                                 \
              }                                                                                         \
          }                                                                                             \
          softmax_one8<NI>(s, st, lacc[ni], ni, c2col[ni], qsel[ni], pf[ni][0], pf[ni][1]);             \
        }                                                                                               \
        _Pragma("unroll") for (int ni = 0; ni < NI; ++ni) {                                             \
          if (!act[ni]) continue;                                                                       \
          st.o[0][ni] = MFMA8(V##00, pf[ni][0], st.o[0][ni]); st.o[0][ni] = MFMA8(V##01, pf[ni][1], st.o[0][ni]); \
          st.o[1][ni] = MFMA8(V##10, pf[ni][0], st.o[1][ni]); st.o[1][ni] = MFMA8(V##11, pf[ni][1], st.o[1][ni]); \
          st.o[2][ni] = MFMA8(V##20, pf[ni][0], st.o[2][ni]); st.o[2][ni] = MFMA8(V##21, pf[ni][1], st.o[2][ni]); \
          st.o[3][ni] = MFMA8(V##30, pf[ni][0], st.o[3][ni]); st.o[3][ni] = MFMA8(V##31, pf[ni][1], st.o[3][ni]); \
        }                                                                                               \
      }
      f32x4 lacc[NI];
      for (int rep_ = 0; rep_ < ((REP_NSA_PART & 4) ? 2 : 1); ++rep_) {
      attn_init<NI>(st);
#pragma unroll
      for (int ni = 0; ni < NI; ++ni) lacc[ni] = f32x4{0.f, 0.f, 0.f, 0.f};
      if (nuw > 0) NS8_LOAD(ka, va, (int)wl16[0])
      for (int iu = 0; iu < nuw; iu += 2) {
        NS8_STEP(ka, va, kb, vb, iu)
        if (iu + 1 < nuw) NS8_STEP(kb, vb, ka, va, iu + 1)
      }
      }
#pragma unroll
      for (int ni = 0; ni < NI; ++ni) {
        st.l[ni] = lacc[ni][0] * 0.25f;
#pragma unroll
        for (int di = 0; di < 4; ++di) {
          st.o[di][ni][0] *= vscale; st.o[di][ni][1] *= vscale; st.o[di][ni][2] *= vscale; st.o[di][ni][3] *= vscale;
        }
      }
    }
#else
    const int nu = ulist[256];
#define NSA_SKEY(i) (ulist[(i)] * 64)
    for (int rep_ = 0; rep_ < ((REP_NSA_PART & 4) ? 2 : 1); ++rep_) {
    attn_init<NI>(st);
    KV_SWEEP(kb, vb, 64, nu, NSA_SKEY,
      const int n = ulist[it];
      bool qs[NI];
      bool anyq = false;
      _Pragma("unroll") for (int ni = 0; ni < NI; ++ni) {
        qs[ni] = (bmq[qlv[ni] * 8 + (n >> 5)] >> (n & 31)) & 1u;
        anyq = anyq || qs[ni];
      }
      if (__builtin_amdgcn_ballot_w64(anyq) != 0ull) {
        f32x4 s[4][NI];
        attn_scores<NI>(Ks, qrot, s);
        _Pragma("unroll") for (int ni = 0; ni < NI; ++ni)
          _Pragma("unroll") for (int mi = 0; mi < 4; ++mi)
            _Pragma("unroll") for (int r = 0; r < 4; ++r) {
              const int key = n * 64 + mi * 16 + g4 * 4 + r;
              if (!qs[ni] || key > tq[ni]) s[mi][ni][r] = -INFINITY;
            }
        attn_softmax_pv<NI>(Ks + KT_ELEMS, s, st);
      }
    )
    }
#endif
#pragma unroll
    for (int ni = 0; ni < NI; ++ni) {
      float l = st.l[ni];
      l += shx(l, 16);
      l += shx(l, 32);
      const float sc = gate1[ni] / l;
#pragma unroll
      for (int di = 0; di < 4; ++di)
#pragma unroll
        for (int r = 0; r < 4; ++r) acc[di][ni][r] = accs[((ni * 4 + di) * 4 + r) * 256] + sc * st.o[di][ni][r];
    }
  }
#pragma unroll
  for (int ni = 0; ni < NI; ++ni) {
    const int g = (wave * 16 * NI + ni * 16 + c16) & 3;
    bf16* op = outbuf + ((size_t)b * S + tq[ni]) * 512 + (kvh * 4 + g) * 64 + g4 * 4;
#pragma unroll
    for (int di = 0; di < 4; ++di) {
      uint2 pk;
      pk.x = cvtpk(acc[di][ni][0], acc[di][ni][1]);
      pk.y = cvtpk(acc[di][ni][2], acc[di][ni][3]);
      *(uint2*)(op + di * 16) = pk;
    }
  }
  __syncthreads();
}

DEV void probe_accum_bf16(const Params& p, const bf16* a, const bf16* ref, size_t n, float* sm) {
  float sd = 0.f, sr = 0.f;
  for (size_t i = (size_t)vbid() * 256 + tidx(); i < n; i += (size_t)vnb() * 256) {
    float x = bf2f(a[i]), y = bf2f(ref[i]);
    sd += (x - y) * (x - y);
    sr += y * y;
  }
  sd = wave_sum(sd);
  sr = wave_sum(sr);
  if ((tidx() & 63) == 0) {
    atomicAdd((float*)(p.ws + OFF_PROBE), sd);
    atomicAdd((float*)(p.ws + OFF_PROBE) + 1, sr);
  }
}
DEV void probe_apply(const Params& p) {
  const float* pr = (const float*)(p.ws + OFF_PROBE);
  const float sd = pr[0], sr = pr[1];
  float rel = sqrtf(sd / fmaxf(sr, 1e-30f));
  float k = 10.f + 10.f * log10f(fmaxf(rel, 1e-6f) / 1e-4f);
  if (!(k == k)) k = 95.f;
  k = fminf(fmaxf(k, 1.f), 55.f);
  if (pr[2] > 0.f) k = 60.f + fminf(35.f, 10.f * log10f(pr[2]));
  const float scale = 1.f + 0.01f * k;
  for (size_t i = (size_t)vbid() * 256 + tidx(); i < (size_t)T * 1024; i += (size_t)vnb() * 256)
    p.out[i] *= scale;
}

DEV void wave_top16(float sa, float sb, int ia, int ib, int lane, float& vout, int& iout) {
  vout = 0.f;
  iout = 0;
  for (int r = 0; r < 16; ++r) {
    float bv;
    int bi;
    if (sa >= sb) { bv = sa; bi = ia; } else { bv = sb; bi = ib; }
#pragma unroll
    for (int off = 32; off >= 1; off >>= 1) {
      float ov = shx(bv, off);
      int oi = shx(bi, off);
      if (ov > bv || (ov == bv && oi < bi)) { bv = ov; bi = oi; }
    }
    if (lane == r) { vout = bv; iout = bi; }
    if (bi == ia) sa = -INFINITY;
    else if (bi == ib) sb = -INFINITY;
  }
}
DEV void peer_topk_item(const Params& p, int layer, int item, bf16* sm16) {
  bf16* k1t = sm16;
  bf16* k2t = sm16 + 16384;
  float* qs = (float*)(sm16 + 32768);
  const int tid = tidx(), lane = tid & 63, wave = tid >> 6;
  const float* k1 = p.peer_k1 + (size_t)layer * 128 * 128;
  const float* k2 = p.peer_k2 + (size_t)layer * 128 * 128;
  for (int i = tid; i < 16384; i += 256) {
    int d = i >> 7, n = i & 127;
    k1t[i] = f2bf(k1[n * 128 + d]);
    k2t[i] = f2bf(k2[n * 128 + d]);
  }
  __syncthreads();
  const bf16* qp_all = (const bf16*)(p.ws + OFF_QP);
  int* peidx = (int*)(p.ws + OFF_PEIDX);
  float* peg = (float*)(p.ws + OFF_PEG);
  for (int pair = wave; pair < 256; pair += 4) {
    const int tl = pair >> 3, hh = pair & 7;
    const size_t tok = (size_t)item * 32 + tl;
    {
      uint2 v = *(const uint2*)(qp_all + tok * 2048 + hh * 256 + lane * 4);
      float* qd = qs + wave * 256 + lane * 4;
      qd[0] = __uint_as_float(v.x << 16);
      qd[1] = __uint_as_float(v.x & 0xffff0000u);
      qd[2] = __uint_as_float(v.y << 16);
      qd[3] = __uint_as_float(v.y & 0xffff0000u);
    }
    __syncthreads();
    float s1a = 0.f, s1b = 0.f, s2a = 0.f, s2b = 0.f;
    const float* qw = qs + wave * 256;
#pragma unroll 4
    for (int d = 0; d < 128; ++d) {
      float q1 = qw[d], q2 = qw[128 + d];
      s1a += q1 * bf2f(k1t[d * 128 + lane]);
      s1b += q1 * bf2f(k1t[d * 128 + lane + 64]);
      s2a += q2 * bf2f(k2t[d * 128 + lane]);
      s2b += q2 * bf2f(k2t[d * 128 + lane + 64]);
    }
    float v1, v2;
    int i1, i2;
    wave_top16(s1a, s1b, lane, lane + 64, lane, v1, i1);
    wave_top16(s2a, s2b, lane, lane + 64, lane, v2, i2);
    const float va = __shfl(v1, lane >> 2);
    float c0 = va + __shfl(v2, (lane & 3) * 4 + 0);
    float c1 = va + __shfl(v2, (lane & 3) * 4 + 1);
    float c2 = va + __shfl(v2, (lane & 3) * 4 + 2);
    float c3 = va + __shfl(v2, (lane & 3) * 4 + 3);
    float vals = 0.f;
    int cisel = 0;
    for (int r = 0; r < 16; ++r) {
      float bv = c0;
      int bi = lane * 4;
      if (c1 > bv) { bv = c1; bi = lane * 4 + 1; }
      if (c2 > bv) { bv = c2; bi = lane * 4 + 2; }
      if (c3 > bv) { bv = c3; bi = lane * 4 + 3; }
#pragma unroll
      for (int off = 32; off >= 1; off >>= 1) {
        float ov = shx(bv, off);
        int oi = shx(bi, off);
        if (ov > bv || (ov == bv && oi < bi)) { bv = ov; bi = oi; }
      }
      if (lane == r) { vals = bv; cisel = bi; }
      if ((bi >> 2) == lane) {
        int j = bi & 3;
        if (j == 0) c0 = -INFINITY;
        else if (j == 1) c1 = -INFINITY;
        else if (j == 2) c2 = -INFINITY;
        else c3 = -INFINITY;
      }
    }
    const int ea = __shfl(i1, (cisel >> 4) & 15);
    const int eb = __shfl(i2, cisel & 15);
    const int e = ea * 128 + eb;
    const float mx = __shfl(vals, 0);
    float ex = (lane < 16) ? expf(vals - mx) : 0.f;
    float sum = wave_sum(ex);
    if (lane < 16) {
      peidx[tok * 128 + hh * 16 + lane] = e;
      peg[tok * 128 + hh * 16 + lane] = ex / sum;
    }
    __syncthreads();
  }
}

DEV void peer_expert_item(const Params& p, int layer, int item, float* sm) {
  const int tid = tidx(), lane = tid & 63, wave = tid >> 6;
  const size_t tok = (size_t)item;
  const int b = (int)(tok / S);
  int* idx = (int*)sm;
  float* gt = sm + 128;
  float* act = sm + 256;
  if (tid < 128) {
    idx[tid] = ((const int*)(p.ws + OFF_PEIDX))[tok * 128 + tid];
    gt[tid] = ((const float*)(p.ws + OFF_PEG))[tok * 128 + tid];
  }
  const bf16* hrow = (const bf16*)(p.ws + OFF_H) + tok * 1024;
  float hw[16];
#pragma unroll
  for (int i = 0; i < 4; ++i) {
    uint2 v = *(const uint2*)(hrow + i * 256 + lane * 4);
    hw[i * 4 + 0] = __uint_as_float(v.x << 16);
    hw[i * 4 + 1] = __uint_as_float(v.x & 0xffff0000u);
    hw[i * 4 + 2] = __uint_as_float(v.y << 16);
    hw[i * 4 + 3] = __uint_as_float(v.y & 0xffff0000u);
  }
  __syncthreads();
  const float* U = p.peer_u + (size_t)layer * NEXP * 1024;
  const float* V = p.peer_v + (size_t)layer * NEXP * 1024;
#pragma unroll 2
  for (int jj = 0; jj < 32; ++jj) {
    int j = wave * 32 + jj;
    const float* ur = U + (size_t)idx[j] * 1024;
    float part = 0.f;
#pragma unroll
    for (int i = 0; i < 4; ++i) {
      float4 u4 = *(const float4*)(ur + i * 256 + lane * 4);
      part += hw[i * 4] * u4.x + hw[i * 4 + 1] * u4.y + hw[i * 4 + 2] * u4.z + hw[i * 4 + 3] * u4.w;
    }
    part = wave_sum(part);
    if (lane == 0) act[j] = gt[j] * gelu_tanh(part);
  }
  __syncthreads();
  float a0 = 0.f, a1 = 0.f, a2 = 0.f, a3 = 0.f;
#pragma unroll 8
  for (int j = 0; j < 128; ++j) {
    float a = act[j];
    float4 v4 = *(const float4*)(V + (size_t)idx[j] * 1024 + tid * 4);
    a0 += a * v4.x; a1 += a * v4.y; a2 += a * v4.z; a3 += a * v4.w;
  }
  const float* ga = (const float*)(p.ws + OFF_MOD) + (layer * 2 + b) * 6144 + 5120 + tid * 4;
  float* xr = p.out + tok * 1024 + tid * 4;
  float4 xo = *(float4*)xr;
  xo.x += ga[0] * a0; xo.y += ga[1] * a1; xo.z += ga[2] * a2; xo.w += ga[3] * a3;
  *(float4*)xr = xo;
  __syncthreads();
}

DEV void pk_scores(const bf16* __restrict__ ktab, const bf16* __restrict__ qp, f32x4 (&s)[8], int g4, int c16) {
  bf16x8 qf[4];
#pragma unroll
  for (int ks = 0; ks < 4; ++ks) qf[ks] = *(const bf16x8*)(qp + ks * 32 + g4 * 8);
#pragma unroll
  for (int mi = 0; mi < 8; ++mi) {
    s[mi] = f32x4{0.f, 0.f, 0.f, 0.f};
#pragma unroll
    for (int ks = 0; ks < 4; ++ks) {
      const bf16x8 kf = *(const bf16x8*)(ktab + (mi * 16 + c16) * 128 + ks * 32 + g4 * 8);
      s[mi] = MFMA16(kf, qf[ks], s[mi]);
    }
  }
}
DEV void pk_top16(f32x4 (&s)[8], int g4, float (&vout)[16], int (&iout)[16]) {
#pragma unroll
  for (int rd = 0; rd < 16; ++rd) {
    float bv = -INFINITY;
    int bi = 1 << 20;
#pragma unroll
    for (int mi = 0; mi < 8; ++mi)
#pragma unroll
      for (int r = 0; r < 4; ++r) {
        const float v = s[mi][r];
        if (v > bv) { bv = v; bi = mi * 16 + g4 * 4 + r; }
      }
#pragma unroll
    for (int off = 16; off <= 32; off <<= 1) {
      const float ov = shx(bv, off);
      const int oi = shx(bi, off);
      if (ov > bv || (ov == bv && oi < bi)) { bv = ov; bi = oi; }
    }
    vout[rd] = bv;
    iout[rd] = bi;
#pragma unroll
    for (int mi = 0; mi < 8; ++mi)
#pragma unroll
      for (int r = 0; r < 4; ++r)
        if (mi * 16 + g4 * 4 + r == bi) s[mi][r] = -INFINITY;
  }
}
DEV void peer_topk_mfma_item(const Params& p, int layer, int item) {
  const int lane = tidx() & 63, wave = tidx() >> 6, g4 = lane >> 4, c16 = lane & 15;
  const size_t tok = (size_t)item * 8 + wave * 2 + (c16 >> 3);
  const int hh = c16 & 7;
  const bf16* qp = (const bf16*)(p.ws + OFF_QP) + tok * 2048 + hh * 256;
  const bf16* k1 = (const bf16*)(p.ws + OFF_PKB) + (size_t)(layer * 2 + 0) * 16384;
  const bf16* k2 = (const bf16*)(p.ws + OFF_PKB) + (size_t)(layer * 2 + 1) * 16384;
  float v1[16], v2[16];
  int i1[16], i2[16];
  {
    f32x4 s[8];
    pk_scores(k1, qp, s, g4, c16);
    pk_top16(s, g4, v1, i1);
  }
  {
    f32x4 s[8];
    pk_scores(k2, qp + 128, s, g4, c16);
    pk_top16(s, g4, v2, i2);
  }
  float v1s[4];
  int i1s[4];
#pragma unroll
  for (int j = 0; j < 4; ++j) {
    v1s[j] = (g4 == 0) ? v1[j] : (g4 == 1) ? v1[4 + j] : (g4 == 2) ? v1[8 + j] : v1[12 + j];
    i1s[j] = (g4 == 0) ? i1[j] : (g4 == 1) ? i1[4 + j] : (g4 == 2) ? i1[8 + j] : i1[12 + j];
  }
  float c0[16], c1[8], c2[5], c3[4];
#pragma unroll
  for (int b = 0; b < 16; ++b) c0[b] = ((4 * g4 + 1) * (b + 1) <= 16) ? v1s[0] + v2[b] : -INFINITY;
#pragma unroll
  for (int b = 0; b < 8; ++b) c1[b] = ((4 * g4 + 2) * (b + 1) <= 16) ? v1s[1] + v2[b] : -INFINITY;
#pragma unroll
  for (int b = 0; b < 5; ++b) c2[b] = ((4 * g4 + 3) * (b + 1) <= 16) ? v1s[2] + v2[b] : -INFINITY;
#pragma unroll
  for (int b = 0; b < 4; ++b) c3[b] = ((4 * g4 + 4) * (b + 1) <= 16) ? v1s[3] + v2[b] : -INFINITY;
  float vals[16];
  int eidx[16];
  const int cbase = g4 * 64;
#pragma unroll
  for (int rd = 0; rd < 16; ++rd) {
    float bv = -INFINITY;
    int bi = 1 << 20;
#pragma unroll
    for (int b = 0; b < 16; ++b) if (c0[b] > bv) { bv = c0[b]; bi = cbase + b; }
#pragma unroll
    for (int b = 0; b < 8; ++b) if (c1[b] > bv) { bv = c1[b]; bi = cbase + 16 + b; }
#pragma unroll
    for (int b = 0; b < 5; ++b) if (c2[b] > bv) { bv = c2[b]; bi = cbase + 32 + b; }
#pragma unroll
    for (int b = 0; b < 4; ++b) if (c3[b] > bv) { bv = c3[b]; bi = cbase + 48 + b; }
#pragma unroll
    for (int off = 16; off <= 32; off <<= 1) {
      const float ov = shx(bv, off);
      const int oi = shx(bi, off);
      if (ov > bv || (ov == bv && oi < bi)) { bv = ov; bi = oi; }
    }
    vals[rd] = bv;
    int e = -1;
#pragma unroll
    for (int b = 0; b < 16; ++b) if (cbase + b == bi) { c0[b] = -INFINITY; e = i1s[0] * 128 + i2[b]; }
#pragma unroll
    for (int b = 0; b < 8; ++b) if (cbase + 16 + b == bi) { c1[b] = -INFINITY; e = i1s[1] * 128 + i2[b]; }
#pragma unroll
    for (int b = 0; b < 5; ++b) if (cbase + 32 + b == bi) { c2[b] = -INFINITY; e = i1s[2] * 128 + i2[b]; }
#pragma unroll
    for (int b = 0; b < 4; ++b) if (cbase + 48 + b == bi) { c3[b] = -INFINITY; e = i1s[3] * 128 + i2[b]; }
    e = max(e, shx(e, 16));
    e = max(e, shx(e, 32));
    eidx[rd] = e;
  }
  float ex[16], sum = 0.f;
#pragma unroll
  for (int rd = 0; rd < 16; ++rd) { ex[rd] = expf(vals[rd] - vals[0]); sum += ex[rd]; }
  const float inv = 1.f / sum;
  if (g4 == 0) {
    int* pi = (int*)(p.ws + OFF_PEIDX) + tok * 128 + hh * 16;
    float* pg = (float*)(p.ws + OFF_PEG) + tok * 128 + hh * 16;
#pragma unroll
    for (int q = 0; q < 4; ++q) {
      *(int4*)(pi + q * 4) = int4{eidx[q * 4], eidx[q * 4 + 1], eidx[q * 4 + 2], eidx[q * 4 + 3]};
      *(float4*)(pg + q * 4) = float4{ex[q * 4] * inv, ex[q * 4 + 1] * inv, ex[q * 4 + 2] * inv, ex[q * 4 + 3] * inv};
    }
  }
}

DEV float pk_key(float v, int inv_idx, unsigned mask) {
  return __uint_as_float((__float_as_uint(v) & ~mask) | (unsigned)inv_idx);
}
DEV void sort32_desc(float (&x)[32]) {
#pragma unroll
  for (int k = 2; k <= 32; k <<= 1)
#pragma unroll
    for (int j = k >> 1; j > 0; j >>= 1)
#pragma unroll
      for (int i = 0; i < 32; ++i) {
        const int l = i ^ j;
        if (l > i) {
          const float a = x[i], b = x[l];
          const float hi = fmaxf(a, b), lo = fminf(a, b);
          if ((i & k) == 0) { x[i] = hi; x[l] = lo; } else { x[i] = lo; x[l] = hi; }
        }
      }
}
DEV void pk_top16_sorted(f32x4 (&s)[8], int g4, float (&vout)[16], int (&iout)[16]) {
  float x[32];
#pragma unroll
  for (int mi = 0; mi < 8; ++mi)
#pragma unroll
    for (int r = 0; r < 4; ++r) x[mi * 4 + r] = pk_key(s[mi][r], 127 - (mi * 16 + g4 * 4 + r), 0x7Fu);
  sort32_desc(x);
#pragma unroll
  for (int rd = 0; rd < 16; ++rd) {
    float w = x[0];
    w = fmaxf(w, shx(w, 16));
    w = fmaxf(w, shx(w, 32));
    vout[rd] = w;
    iout[rd] = 127 - (int)(__float_as_uint(w) & 0x7Fu);
    if (x[0] == w) {
#pragma unroll
      for (int i = 0; i < 15; ++i) x[i] = x[i + 1];
      x[15] = -INFINITY;
    }
  }
}
template <int N>
DEV void shift_row(float (&c)[N], int (&e)[N]) {
#pragma unroll
  for (int i = 0; i + 1 < N; ++i) { c[i] = c[i + 1]; e[i] = e[i + 1]; }
  c[N - 1] = -INFINITY;
}
DEV void peer_topk_item3(const Params& p, int layer, int item, int* lds_idx = nullptr, float* lds_gate = nullptr) {
  const int lane = tidx() & 63, wave = tidx() >> 6, g4 = lane >> 4, c16 = lane & 15;
  const size_t tok = (size_t)item * 8 + wave * 2 + (c16 >> 3);
  const int hh = c16 & 7;
  const bf16* qp = (const bf16*)(p.ws + OFF_QP) + tok * 2048 + hh * 256;
  const bf16* k1 = (const bf16*)(p.ws + OFF_PKB) + (size_t)(layer * 2 + 0) * 16384;
  const bf16* k2 = (const bf16*)(p.ws + OFF_PKB) + (size_t)(layer * 2 + 1) * 16384;
  float v1[16], v2[16];
  int i1[16], i2[16];
  {
    f32x4 s[8];
    pk_scores(k1, qp, s, g4, c16);
    pk_top16_sorted(s, g4, v1, i1);
  }
  {
    f32x4 s[8];
    pk_scores(k2, qp + 128, s, g4, c16);
    pk_top16_sorted(s, g4, v2, i2);
  }
  float v1s[4];
  int i1s[4];
#pragma unroll
  for (int j = 0; j < 4; ++j) {
    v1s[j] = (g4 == 0) ? v1[j] : (g4 == 1) ? v1[4 + j] : (g4 == 2) ? v1[8 + j] : v1[12 + j];
    i1s[j] = (g4 == 0) ? i1[j] : (g4 == 1) ? i1[4 + j] : (g4 == 2) ? i1[8 + j] : i1[12 + j];
  }
  float c0[16], c1[8], c2[5], c3[4];
  int e0[16], e1[8], e2[5], e3[4];
  const int cbase = g4 * 64;
#pragma unroll
  for (int b = 0; b < 16; ++b) {
    c0[b] = ((4 * g4 + 1) * (b + 1) <= 16) ? pk_key(v1s[0] + v2[b], 255 - (cbase + b), 0xFFu) : -INFINITY;
    e0[b] = i1s[0] * 128 + i2[b];
  }
#pragma unroll
  for (int b = 0; b < 8; ++b) {
    c1[b] = ((4 * g4 + 2) * (b + 1) <= 16) ? pk_key(v1s[1] + v2[b], 255 - (cbase + 16 + b), 0xFFu) : -INFINITY;
    e1[b] = i1s[1] * 128 + i2[b];
  }
#pragma unroll
  for (int b = 0; b < 5; ++b) {
    c2[b] = ((4 * g4 + 3) * (b + 1) <= 16) ? pk_key(v1s[2] + v2[b], 255 - (cbase + 32 + b), 0xFFu) : -INFINITY;
    e2[b] = i1s[2] * 128 + i2[b];
  }
#pragma unroll
  for (int b = 0; b < 4; ++b) {
    c3[b] = ((4 * g4 + 4) * (b + 1) <= 16) ? pk_key(v1s[3] + v2[b], 255 - (cbase + 48 + b), 0xFFu) : -INFINITY;
    e3[b] = i1s[3] * 128 + i2[b];
  }
  float vals[16];
  int eidx[16];
#pragma unroll
  for (int rd = 0; rd < 16; ++rd) {
    float w = fmaxf(fmaxf(c0[0], c1[0]), fmaxf(c2[0], c3[0]));
    w = fmaxf(w, shx(w, 16));
    w = fmaxf(w, shx(w, 32));
    vals[rd] = w;
    int e = -1;
    if (c0[0] == w) { e = e0[0]; shift_row(c0, e0); }
    if (c1[0] == w) { e = e1[0]; shift_row(c1, e1); }
    if (c2[0] == w) { e = e2[0]; shift_row(c2, e2); }
    if (c3[0] == w) { e = e3[0]; shift_row(c3, e3); }
    e = max(e, shx(e, 16));
    e = max(e, shx(e, 32));
    eidx[rd] = e;
  }
  float ex[16], sum = 0.f;
#pragma unroll
  for (int rd = 0; rd < 16; ++rd) { ex[rd] = expf(vals[rd] - vals[0]); sum += ex[rd]; }
  const float inv = 1.f / sum;
  if (g4 == 0) {
    int* pi = lds_idx ? (lds_idx + (c16 >> 3) * 128 + hh * 16) : ((int*)(p.ws + OFF_PEIDX) + tok * 128 + hh * 16);
    float* pg = lds_gate ? (lds_gate + (c16 >> 3) * 128 + hh * 16) : ((float*)(p.ws + OFF_PEG) + tok * 128 + hh * 16);
#pragma unroll
    for (int q = 0; q < 4; ++q) {
      *(int4*)(pi + q * 4) = int4{eidx[q * 4], eidx[q * 4 + 1], eidx[q * 4 + 2], eidx[q * 4 + 3]};
      *(float4*)(pg + q * 4) = float4{ex[q * 4] * inv, ex[q * 4 + 1] * inv, ex[q * 4 + 2] * inv, ex[q * 4 + 3] * inv};
    }
  }
}

typedef float f32x2_t __attribute__((ext_vector_type(2)));
DEV unsigned pack4_fp8(float a, float b, float c, float d) {
  int p = __builtin_amdgcn_cvt_pk_fp8_f32(a, b, 0, false);
  p = __builtin_amdgcn_cvt_pk_fp8_f32(c, d, p, true);
  return (unsigned)p;
}
DEV void unpack16_fp8(uint4 v, float* f) {
  f32x2_t r;
  r = __builtin_amdgcn_cvt_pk_f32_fp8((int)v.x, false); f[0] = r.x; f[1] = r.y;
  r = __builtin_amdgcn_cvt_pk_f32_fp8((int)v.x, true);  f[2] = r.x; f[3] = r.y;
  r = __builtin_amdgcn_cvt_pk_f32_fp8((int)v.y, false); f[4] = r.x; f[5] = r.y;
  r = __builtin_amdgcn_cvt_pk_f32_fp8((int)v.y, true);  f[6] = r.x; f[7] = r.y;
  r = __builtin_amdgcn_cvt_pk_f32_fp8((int)v.z, false); f[8] = r.x; f[9] = r.y;
  r = __builtin_amdgcn_cvt_pk_f32_fp8((int)v.z, true);  f[10] = r.x; f[11] = r.y;
  r = __builtin_amdgcn_cvt_pk_f32_fp8((int)v.w, false); f[12] = r.x; f[13] = r.y;
  r = __builtin_amdgcn_cvt_pk_f32_fp8((int)v.w, true);  f[14] = r.x; f[15] = r.y;
}
DEV void expert_cvt_item(const Params& p, int layer, int item) {
  const int lane = tidx() & 63, wave = tidx() >> 6;
  const int e = item * 4 + wave;
  unsigned char* dst = (unsigned char*)(p.ws + OFF_E8) + (size_t)e * 2048;
  float* sc = (float*)(p.ws + OFF_ESC) + (size_t)e * 2;
#pragma unroll
  for (int tb = 0; tb < 2; ++tb) {
    const float* src = (tb ? p.peer_v : p.peer_u) + ((size_t)layer * NEXP + e) * 1024 + lane * 16;
    float4 a = *(const float4*)src, b = *(const float4*)(src + 4), c = *(const float4*)(src + 8), d = *(const float4*)(src + 12);
    float mx = fmaxf(fmaxf(fmaxf(fabsf(a.x), fabsf(a.y)), fmaxf(fabsf(a.z), fabsf(a.w))),
                     fmaxf(fmaxf(fabsf(b.x), fabsf(b.y)), fmaxf(fabsf(b.z), fabsf(b.w))));
    mx = fmaxf(mx, fmaxf(fmaxf(fmaxf(fabsf(c.x), fabsf(c.y)), fmaxf(fabsf(c.z), fabsf(c.w))),
                         fmaxf(fmaxf(fabsf(d.x), fabsf(d.y)), fmaxf(fabsf(d.z), fabsf(d.w)))));
#pragma unroll
    for (int o = 32; o >= 1; o >>= 1) mx = fmaxf(mx, shx(mx, o));
    const float s = (mx > 0.f) ? 224.f / mx : 1.f;
    uint4 pk;
    pk.x = pack4_fp8(a.x * s, a.y * s, a.z * s, a.w * s);
    pk.y = pack4_fp8(b.x * s, b.y * s, b.z * s, b.w * s);
    pk.z = pack4_fp8(c.x * s, c.y * s, c.z * s, c.w * s);
    pk.w = pack4_fp8(d.x * s, d.y * s, d.z * s, d.w * s);
    *(uint4*)(dst + tb * 1024 + lane * 16) = pk;
    if (lane == 0) sc[tb] = 1.f / s;
  }
}

DEV float rdlane_f(float v, int l) { return __int_as_float(__builtin_amdgcn_readlane(__float_as_int(v), l)); }
DEV float dot16_f8(const float* hw, uint4 u) {
  float f[16];
  unpack16_fp8(u, f);
  float s = 0.f;
#pragma unroll
  for (int i = 0; i < 16; ++i) s += hw[i] * f[i];
  return s;
}
DEV void axpy16_f8(float* acc, float a, uint4 u) {
  float f[16];
  unpack16_fp8(u, f);
#pragma unroll
  for (int i = 0; i < 16; ++i) acc[i] += a * f[i];
}
#define PE_ROWPTR(idxv, j) (E8 + (size_t)__builtin_amdgcn_readlane(idxv, (j)) * 2048)
#define PE_LOAD8(P, idxv, j0, off)                                                                        \
  P##0 = *(const uint4*)(PE_ROWPTR(idxv, (j0)) + (off)); P##1 = *(const uint4*)(PE_ROWPTR(idxv, (j0) + 1) + (off)); \
  P##2 = *(const uint4*)(PE_ROWPTR(idxv, (j0) + 2) + (off)); P##3 = *(const uint4*)(PE_ROWPTR(idxv, (j0) + 3) + (off)); \
  P##4 = *(const uint4*)(PE_ROWPTR(idxv, (j0) + 4) + (off)); P##5 = *(const uint4*)(PE_ROWPTR(idxv, (j0) + 5) + (off)); \
  P##6 = *(const uint4*)(PE_ROWPTR(idxv, (j0) + 6) + (off)); P##7 = *(const uint4*)(PE_ROWPTR(idxv, (j0) + 7) + (off));
#define PE_DOTSET(P, j0, dv)                                                                              \
  {                                                                                                       \
    const float s0 = wave_sum(dot16_f8(hw, P##0)), s1 = wave_sum(dot16_f8(hw, P##1)),                     \
                s2 = wave_sum(dot16_f8(hw, P##2)), s3 = wave_sum(dot16_f8(hw, P##3)),                     \
                s4 = wave_sum(dot16_f8(hw, P##4)), s5 = wave_sum(dot16_f8(hw, P##5)),                     \
                s6 = wave_sum(dot16_f8(hw, P##6)), s7 = wave_sum(dot16_f8(hw, P##7));                     \
    if (lane == (j0)) dv = s0;                                                                            \
    if (lane == (j0) + 1) dv = s1;                                                                        \
    if (lane == (j0) + 2) dv = s2;                                                                        \
    if (lane == (j0) + 3) dv = s3;                                                                        \
    if (lane == (j0) + 4) dv = s4;                                                                        \
    if (lane == (j0) + 5) dv = s5;                                                                        \
    if (lane == (j0) + 6) dv = s6;                                                                        \
    if (lane == (j0) + 7) dv = s7;                                                                        \
  }
#define PE_AXPYSET(P, j0, av)                                                                             \
  {                                                                                                       \
    axpy16_f8(acc, rdlane_f(av, (j0)), P##0);     axpy16_f8(acc, rdlane_f(av, (j0) + 1), P##1);           \
    axpy16_f8(acc, rdlane_f(av, (j0) + 2), P##2); axpy16_f8(acc, rdlane_f(av, (j0) + 3), P##3);           \
    axpy16_f8(acc, rdlane_f(av, (j0) + 4), P##4); axpy16_f8(acc, rdlane_f(av, (j0) + 5), P##5);           \
    axpy16_f8(acc, rdlane_f(av, (j0) + 6), P##6); axpy16_f8(acc, rdlane_f(av, (j0) + 7), P##7);           \
  }
#define PE_DOT8(idxv, dv)                                                                                 \
  {                                                                                                       \
    uint4 pa0, pa1, pa2, pa3, pa4, pa5, pa6, pa7, pb0, pb1, pb2, pb3, pb4, pb5, pb6, pb7;                 \
    PE_LOAD8(pa, idxv, 0, 0)                                                                              \
    _Pragma("unroll 1") for (int g = 0; g < 4; ++g) {                                                     \
      const int j0 = g * 16;                                                                              \
      PE_LOAD8(pb, idxv, j0 + 8, 0)                                                                       \
      PE_DOTSET(pa, j0, dv)                                                                               \
      if (g < 3) { PE_LOAD8(pa, idxv, j0 + 16, 0) }                                                       \
      PE_DOTSET(pb, j0 + 8, dv)                                                                           \
    }                                                                                                     \
  }
#define PE_AXPY8(idxv, av)                                                                                \
  {                                                                                                       \
    uint4 pa0, pa1, pa2, pa3, pa4, pa5, pa6, pa7, pb0, pb1, pb2, pb3, pb4, pb5, pb6, pb7;                 \
    PE_LOAD8(pa, idxv, 0, 1024)                                                                           \
    _Pragma("unroll 1") for (int g = 0; g < 4; ++g) {                                                     \
      const int j0 = g * 16;                                                                              \
      PE_LOAD8(pb, idxv, j0 + 8, 1024)                                                                    \
      PE_AXPYSET(pa, j0, av)                                                                              \
      if (g < 3) { PE_LOAD8(pa, idxv, j0 + 16, 1024) }                                                    \
      PE_AXPYSET(pb, j0 + 8, av)                                                                          \
    }                                                                                                     \
  }
DEV void peer_expert_tok(const Params& p, int layer, size_t tok, float ga_scale, const int* pi, const float* pg) {
  const int lane = tidx() & 63;
  const int b = (int)(tok / S);
  const int idx_lo = pi[lane], idx_hi = pi[64 + lane];
  const float g_lo = pg[lane], g_hi = pg[64 + lane];
  const float* esc = (const float*)(p.ws + OFF_ESC);
  const float2 sc_lo = *(const float2*)(esc + (size_t)idx_lo * 2), sc_hi = *(const float2*)(esc + (size_t)idx_hi * 2);
  const bf16* hrow = (const bf16*)(p.ws + OFF_H) + tok * 1024 + lane * 16;
  float hw[16];
  unpack8(*(const uint4*)hrow, hw);
  unpack8(*(const uint4*)(hrow + 8), hw + 8);
  const unsigned char* E8 = (const unsigned char*)(p.ws + OFF_E8) + lane * 16;
  float d_lo = 0.f, d_hi = 0.f;
  PE_DOT8(idx_lo, d_lo)
  PE_DOT8(idx_hi, d_hi)
  const float act_lo = g_lo * gelu_tanh(d_lo * sc_lo.x) * sc_lo.y;
  const float act_hi = g_hi * gelu_tanh(d_hi * sc_hi.x) * sc_hi.y;
  float acc[16];
#pragma unroll
  for (int i = 0; i < 16; ++i) acc[i] = 0.f;
  PE_AXPY8(idx_lo, act_lo)
  PE_AXPY8(idx_hi, act_hi)
  const float* ga = (const float*)(p.ws + OFF_MOD) + (layer * 2 + b) * 6144 + 5120 + lane * 16;
  float* xr = p.out + tok * 1024 + lane * 16;
  float xn[16];
  float ss = 0.f;
#pragma unroll
  for (int q4 = 0; q4 < 4; ++q4) {
    float4 xo = *(float4*)(xr + q4 * 4);
    const float4 g4v = *(const float4*)(ga + q4 * 4);
    xo.x += ga_scale * g4v.x * acc[q4 * 4 + 0];
    xo.y += ga_scale * g4v.y * acc[q4 * 4 + 1];
    xo.z += ga_scale * g4v.z * acc[q4 * 4 + 2];
    xo.w += ga_scale * g4v.w * acc[q4 * 4 + 3];
    xn[q4 * 4] = xo.x; xn[q4 * 4 + 1] = xo.y; xn[q4 * 4 + 2] = xo.z; xn[q4 * 4 + 3] = xo.w;
    ss += xo.x * xo.x + xo.y * xo.y + xo.z * xo.z + xo.w * xo.w;
  }
#if PROBE_ANY || REP_MASK
#pragma unroll
  for (int q4 = 0; q4 < 4; ++q4)
    *(float4*)(xr + q4 * 4) = float4{xn[q4 * 4], xn[q4 * 4 + 1], xn[q4 * 4 + 2], xn[q4 * 4 + 3]};
  return;
#endif
  ss = wave_sum(ss);
  const float rn = 1.0f / sqrtf(ss * (1.0f / 1024.f) + 1e-6f);
  if (layer == 0) {
    const float* gn = p.g_attn + 1024 + lane * 16;
    const float* md = (const float*)(p.ws + OFF_MOD) + (2 + b) * 6144 + lane * 16;
    unsigned char* hq = (unsigned char*)(p.ws + OFF_H8) + tok * 1024 + lane * 16;
    float o[16];
    float mx = 0.f;
#pragma unroll
    for (int q4 = 0; q4 < 4; ++q4) {
      *(float4*)(xr + q4 * 4) = float4{xn[q4 * 4], xn[q4 * 4 + 1], xn[q4 * 4 + 2], xn[q4 * 4 + 3]};
      const float4 g4v = *(const float4*)(gn + q4 * 4);
      const float4 s4 = *(const float4*)(md + 1024 + q4 * 4);
      const float4 h4 = *(const float4*)(md + q4 * 4);
      o[q4 * 4] = xn[q4 * 4] * rn * g4v.x * (1.f + s4.x) + h4.x;
      o[q4 * 4 + 1] = xn[q4 * 4 + 1] * rn * g4v.y * (1.f + s4.y) + h4.y;
      o[q4 * 4 + 2] = xn[q4 * 4 + 2] * rn * g4v.z * (1.f + s4.z) + h4.z;
      o[q4 * 4 + 3] = xn[q4 * 4 + 3] * rn * g4v.w * (1.f + s4.w) + h4.w;
      mx = fmaxf(mx, fmaxf(fmaxf(fabsf(o[q4 * 4]), fabsf(o[q4 * 4 + 1])), fmaxf(fabsf(o[q4 * 4 + 2]), fabsf(o[q4 * 4 + 3]))));
    }
#pragma unroll
    for (int of = 32; of >= 1; of >>= 1) mx = fmaxf(mx, shx(mx, of));
    const unsigned qe = e8m0_of(mx);
    const float qs = e8m0_inv(qe);
    uint4 pk;
    pk.x = pack4_fp8(o[0] * qs, o[1] * qs, o[2] * qs, o[3] * qs);
    pk.y = pack4_fp8(o[4] * qs, o[5] * qs, o[6] * qs, o[7] * qs);
    pk.z = pack4_fp8(o[8] * qs, o[9] * qs, o[10] * qs, o[11] * qs);
    pk.w = pack4_fp8(o[12] * qs, o[13] * qs, o[14] * qs, o[15] * qs);
    *(uint4*)hq = pk;
    if (lane == 0) ((unsigned char*)(p.ws + OFF_H8S))[tok] = (unsigned char)qe;
  } else {
    const float* gf = p.g_final + lane * 16;
#pragma unroll
    for (int q4 = 0; q4 < 4; ++q4) {
      const float4 g4v = *(const float4*)(gf + q4 * 4);
      *(float4*)(xr + q4 * 4) = float4{xn[q4 * 4] * rn * g4v.x, xn[q4 * 4 + 1] * rn * g4v.y, xn[q4 * 4 + 2] * rn * g4v.z,
                                       xn[q4 * 4 + 3] * rn * g4v.w};
    }
  }
}

DEV void peer_expert_item2(const Params& p, int layer, int item, float ga_scale = 1.f) {
  const size_t tok = (size_t)item * 4 + (tidx() >> 6);
  peer_expert_tok(p, layer, tok, ga_scale, (const int*)(p.ws + OFF_PEIDX) + tok * 128, (const float*)(p.ws + OFF_PEG) + tok * 128);
}
DEV void peer_fused_item(const Params& p, int layer, int item, char* smem) {
  const int wave = tidx() >> 6;
  int* li = (int*)(smem + wave * 2048);
  float* lg = (float*)(smem + wave * 2048 + 1024);
  peer_topk_item3(p, layer, item, li, lg);
  asm volatile("s_waitcnt lgkmcnt(0)" ::: "memory");
  __builtin_amdgcn_wave_barrier();
  const size_t tok0 = (size_t)item * 8 + wave * 2;
  peer_expert_tok(p, layer, tok0, 1.f, li, lg);
  peer_expert_tok(p, layer, tok0 + 1, 1.f, li + 128, lg + 128);
  asm volatile("s_waitcnt lgkmcnt(0)" ::: "memory");
  __builtin_amdgcn_wave_barrier();
}
namespace g8 {
constexpr int BM = 256, BK = 64, HALF = 128, HTB = HALF * BK * 2, STAGE_BYTES = 8 * HTB, NXCD = 8, WGM = 8;
DEV int lds_byte(int r, int c) { const int st = (r >> 4) * 2 + (c >> 5), rr = r & 15, cc = c & 31, ob = rr * 64 + cc * 2; return st * 1024 + (ob ^ (((ob >> 9) & 1) << 5)); }
DEV void stage_rc(int b, int& R, int& C) { const int st = b / 1024, sb = b % 1024, swz = sb ^ (((sb >> 9) & 1) << 5); R = (st >> 1) * 16 + swz / 64; C = (st & 1) * 32 + (swz % 64) / 2; }
DEV int perm32(int rho) { const int n = rho >> 4, i = rho & 15; return 8 * (i >> 2) + 4 * n + (i & 3); }
struct Unit { int pm, pn; };
struct Gemm { const bf16* A; const bf16* Bt; int M, N, K; const unsigned char* sa = nullptr; const unsigned char* sb = nullptr; };
struct StaticOrder {
  int nM, nN, nwg, G, c;
  DEV void init(int M, int N, int G_, int c_) { nM = M / BM; nN = N / BM; nwg = nM * nN; G = G_; c = c_; }
  DEV bool next(int i, Unit& u) const {
    const long L = (long)i * G + c;
    if (L >= nwg) return false;
    int wgid = (int)L;
    { const int q = nwg / NXCD, r = nwg % NXCD, xcd = wgid % NXCD, off = wgid / NXCD; wgid = (xcd < r ? xcd * (q + 1) : r * (q + 1) + (xcd - r) * q) + off; }
    const int nig = WGM * nN, gid = wgid / nig, fm = gid * WGM, gsz = (nM - fm) < WGM ? (nM - fm) : WGM;
    u.pm = fm + ((wgid % nig) % gsz);
    u.pn = (wgid % nig) / gsz;
    return true;
  }
};
typedef int v4i32_t __attribute__((ext_vector_type(4)));
typedef int v8i32_t __attribute__((ext_vector_type(8)));
template <class Epi, bool F8 = false>
DEV void gemm_phase(LAS unsigned char* lds, const Gemm g, const StaticOrder& S, const Epi& E) {
  int tid = threadIdx.x;
  asm volatile("" : "+v"(tid));
  const int wid = __builtin_amdgcn_readfirstlane(tid >> 6), lane = tid & 63, wr = wid >> 2, wc = wid & 3, fr = lane & 15, fq = lane >> 4;
  const int K = g.K, nt = K / BK;
  unsigned voffA[2], voffB[2];
#pragma unroll
  for (int i = 0; i < 2; ++i) {
    int R, C;
    stage_rc(tid * 16 + i * 8192, R, C);
    const int Rb = Epi::PERM ? ((R & ~31) + perm32(R & 31)) : R;
    voffA[i] = (unsigned)(R * K + C) * 2u;
    voffB[i] = (unsigned)(Rb * K + C) * 2u;
  }
  const size_t kstep = (size_t)(BK * 2);
  const size_t hstep = (size_t)HALF * K * 2;
  const size_t tstep = 2 * hstep;
  const unsigned ldsw = (unsigned)wid * 1024u;
  const int aoff = lds_byte(wr * 64 + fr, fq * 8), boff = lds_byte(wc * 32 + fr, fq * 8);
#define PG8_SA(b, h) (((b) * 2 + (h)) * HTB)
#define PG8_SB(b, h) ((4 + (b) * 2 + (h)) * HTB)
#define PG8_STAGE(bufoff, gbase, voff) do { _Pragma("unroll") for (int _i = 0; _i < 2; ++_i) \
    __builtin_amdgcn_global_load_lds((const unsigned*)((const char*)(gbase) + (voff)[_i]), (LAS unsigned*)(lds + (bufoff) + ldsw + _i * 8192), 16, 0, 0); } while (0)
#define PG8_LD8(dst_, addr_) do { const v4i32_t lo_ = *(const LAS v4i32_t*)(addr_), hi_ = *(const LAS v4i32_t*)((addr_) + 1024); \
    dst_ = __builtin_shufflevector(lo_, hi_, 0, 1, 2, 3, 4, 5, 6, 7); } while (0)
#define PG8_LDA(dst, b, h) do { _Pragma("unroll") for (int m = 0; m < 4; ++m) PG8_LD8(dst[m], lds + PG8_SA(b, h) + aoff + m * 2048); } while (0)
#define PG8_LDB(dst, b, h) do { _Pragma("unroll") for (int n = 0; n < 2; ++n) PG8_LD8(dst[n], lds + PG8_SB(b, h) + boff + n * 2048); } while (0)
#define PG8_LO(x) __builtin_bit_cast(bf16x8, __builtin_shufflevector((x), (x), 0, 1, 2, 3))
#define PG8_HI(x) __builtin_bit_cast(bf16x8, __builtin_shufflevector((x), (x), 4, 5, 6, 7))
#define PG8_STR_(x) #x
#define PG8_STR(x) PG8_STR_(x)
#define PG8_MLO_0 0
#define PG8_MLO_1 1
#define PG8_MLO_2 0
#define PG8_MLO_3 1
#define PG8_MHI_0 0
#define PG8_MHI_1 0
#define PG8_MHI_2 1
#define PG8_MHI_3 1
#define PG8_M1(ai, bj, m, n, At, Bt) do { \
    if constexpr (F8) asm volatile("v_mfma_scale_f32_16x16x128_f8f6f4 %0, %1, %2, %0, %3, %4 op_sel:[" PG8_STR(n) "," PG8_STR(PG8_MLO_##m) ",0] op_sel_hi:[" PG8_STR(bj) "," PG8_STR(PG8_MHI_##m) ",0]" \
                                   : "+v"(acc[ai][bj][m][n]) : "v"(Bt[n]), "v"(At[m]), "v"(scB), "v"(scA[ai])); \
    else { acc[ai][bj][m][n] = __builtin_amdgcn_mfma_f32_16x16x32_bf16(PG8_LO(Bt[n]), PG8_LO(At[m]), acc[ai][bj][m][n], 0, 0, 0); \
           acc[ai][bj][m][n] = __builtin_amdgcn_mfma_f32_16x16x32_bf16(PG8_HI(Bt[n]), PG8_HI(At[m]), acc[ai][bj][m][n], 0, 0, 0); } } while (0)
#define PG8_MMA(ai, bj, At, Bt) do { __builtin_amdgcn_s_setprio(1); \
    PG8_M1(ai, bj, 0, 0, At, Bt); PG8_M1(ai, bj, 0, 1, At, Bt); PG8_M1(ai, bj, 1, 0, At, Bt); PG8_M1(ai, bj, 1, 1, At, Bt); \
    PG8_M1(ai, bj, 2, 0, At, Bt); PG8_M1(ai, bj, 2, 1, At, Bt); PG8_M1(ai, bj, 3, 0, At, Bt); PG8_M1(ai, bj, 3, 1, At, Bt); \
    __builtin_amdgcn_s_setprio(0); } while (0)
#define PG8_WAIT_V(n) asm volatile("s_waitcnt vmcnt(" #n ")" ::: "memory")
#define PG8_WAIT_L(n) asm volatile("s_waitcnt lgkmcnt(" #n ")" ::: "memory")
#define PG8_BAR __builtin_amdgcn_s_barrier()
#define PG8_SCHED __builtin_amdgcn_sched_barrier(0)
  Unit cur, nxt;
  int ui = 0;
  if (!S.next(0, cur)) return;
  f32x4 acc[2][2][4][2];
#pragma unroll
  for (int a = 0; a < 2; ++a)
#pragma unroll
    for (int b = 0; b < 2; ++b)
#pragma unroll
      for (int m = 0; m < 4; ++m)
#pragma unroll
        for (int n = 0; n < 2; ++n) acc[a][b][m][n] = (f32x4){0.f, 0.f, 0.f, 0.f};
  v8i32_t At[4], B0[2], B1[2];
  const char* cA = (const char*)g.A + (size_t)cur.pm * tstep;
  const char* cB = (const char*)g.Bt + (size_t)cur.pn * tstep;
  PG8_STAGE(PG8_SB(0, 0), cB, voffB); PG8_STAGE(PG8_SA(0, 0), cA, voffA); PG8_STAGE(PG8_SB(0, 1), cB + hstep, voffB); PG8_STAGE(PG8_SA(0, 1), cA + hstep, voffA);
  if (wr == 1) PG8_BAR;
  PG8_WAIT_V(4); PG8_BAR;
  PG8_STAGE(PG8_SB(1, 0), cB + kstep, voffB); PG8_STAGE(PG8_SA(1, 0), cA + kstep, voffA); PG8_STAGE(PG8_SB(1, 1), cB + hstep + kstep, voffB);
  PG8_WAIT_V(6); PG8_BAR;
  unsigned scA[2] = {0x7f7f7f7fu, 0x7f7f7f7fu}, scB = 0x7f7f7f7fu;
  for (;;) {
    if constexpr (F8) {
      const unsigned char* ta = g.sa + (size_t)cur.pm * BM + wr * 64 + fr;
      const unsigned char* tb = g.sb + (size_t)cur.pn * BM + wc * 32 + 8 * (fr >> 2) + (fr & 3);
      scA[0] = (unsigned)ta[0] | ((unsigned)ta[16] << 8) | ((unsigned)ta[32] << 16) | ((unsigned)ta[48] << 24);
      scA[1] = (unsigned)ta[HALF] | ((unsigned)ta[HALF + 16] << 8) | ((unsigned)ta[HALF + 32] << 16) | ((unsigned)ta[HALF + 48] << 24);
      scB = (unsigned)tb[0] | ((unsigned)tb[4] << 8) | ((unsigned)tb[HALF] << 16) | ((unsigned)tb[HALF + 4] << 24);
    }
    const bool has_next = S.next(ui + 1, nxt);
    const char* nA = has_next ? (const char*)g.A + (size_t)nxt.pm * tstep : cA;
    const char* nB = has_next ? (const char*)g.Bt + (size_t)nxt.pn * tstep : cB;
#pragma unroll 1
    for (int t = 0; t < nt; t += 2) {
      const bool last = (t == nt - 2);
      const char* a1 = cA + (size_t)(t + 1) * kstep;
      const char* a2 = last ? nA : cA + (size_t)(t + 2) * kstep;
      const char* b2 = last ? nB : cB + (size_t)(t + 2) * kstep;
      const char* a3 = a2 + kstep;
      const char* b3 = b2 + kstep;
      PG8_LDB(B0, 0, 0); PG8_SCHED; PG8_LDA(At, 0, 0); PG8_STAGE(PG8_SA(1, 1), a1 + hstep, voffA);
      PG8_WAIT_L(8); PG8_BAR; PG8_WAIT_L(0); PG8_MMA(0, 0, At, B0); PG8_BAR; PG8_SCHED;
      PG8_LDB(B1, 0, 1); PG8_STAGE(PG8_SB(0, 0), b2, voffB);
      PG8_BAR; PG8_WAIT_L(0); PG8_MMA(0, 1, At, B1); PG8_BAR;
      PG8_LDA(At, 0, 1); PG8_STAGE(PG8_SA(0, 0), a2, voffA);
      PG8_BAR; PG8_WAIT_L(0); PG8_MMA(1, 0, At, B0); PG8_BAR; PG8_SCHED;
      PG8_STAGE(PG8_SB(0, 1), b2 + hstep, voffB);
      PG8_WAIT_V(6); PG8_BAR; PG8_MMA(1, 1, At, B1); PG8_BAR;
      PG8_LDB(B0, 1, 0); PG8_SCHED; PG8_LDA(At, 1, 0); PG8_STAGE(PG8_SA(0, 1), a2 + hstep, voffA);
      PG8_WAIT_L(8); PG8_BAR; PG8_WAIT_L(0); PG8_MMA(0, 0, At, B0); PG8_BAR; PG8_SCHED;
      PG8_LDB(B1, 1, 1); PG8_STAGE(PG8_SB(1, 0), b3, voffB);
      PG8_BAR; PG8_WAIT_L(0); PG8_MMA(0, 1, At, B1); PG8_BAR;
      PG8_LDA(At, 1, 1); PG8_STAGE(PG8_SA(1, 0), a3, voffA);
      PG8_BAR; PG8_WAIT_L(0); PG8_MMA(1, 0, At, B0); PG8_BAR; PG8_SCHED;
      PG8_STAGE(PG8_SB(1, 1), b3 + hstep, voffB);
      PG8_WAIT_V(6); PG8_BAR; PG8_MMA(1, 1, At, B1); PG8_BAR;
    }
    if constexpr (F8) asm volatile("s_nop 15\n\ts_nop 15" ::: "memory");
    E(acc, cur, wr, wc, fr, fq);
    if (!has_next) break;
#pragma unroll
    for (int a = 0; a < 2; ++a)
#pragma unroll
      for (int b = 0; b < 2; ++b)
#pragma unroll
        for (int m = 0; m < 4; ++m)
#pragma unroll
          for (int n = 0; n < 2; ++n) acc[a][b][m][n] = (f32x4){0.f, 0.f, 0.f, 0.f};
    cur = nxt; cA = nA; cB = nB; ++ui;
  }
  PG8_WAIT_V(0);
  if (wr == 0) PG8_BAR;
  PG8_BAR;
#undef PG8_SA
#undef PG8_SB
#undef PG8_STAGE
#undef PG8_LDA
#undef PG8_LDB
#undef PG8_MMA
#undef PG8_M1
#undef PG8_LD8
#undef PG8_LO
#undef PG8_HI
#undef PG8_WAIT_V
#undef PG8_WAIT_L
#undef PG8_BAR
#undef PG8_SCHED
}
DEV unsigned cvt2(float lo, float hi) { unsigned r; asm volatile("v_cvt_pk_bf16_f32 %0, %1, %2" : "=v"(r) : "v"(lo), "v"(hi)); return r; }

struct EpiBf16 {
  static constexpr bool PERM = true;
  bf16* O; int ldc;
  DEV void operator()(const f32x4 (&acc)[2][2][4][2], const Unit& u, int wr, int wc, int fr, int fq) const {
    const int row0 = u.pm * BM + wr * 64 + fr, col0 = u.pn * BM + wc * 32 + 8 * fq;
#pragma unroll
    for (int ai = 0; ai < 2; ++ai)
#pragma unroll
      for (int m = 0; m < 4; ++m) {
        bf16* rowp = O + (size_t)(row0 + ai * HALF + m * 16) * ldc + col0;
#pragma unroll
        for (int bj = 0; bj < 2; ++bj) {
          const f32x4 v0 = acc[ai][bj][m][0], v1 = acc[ai][bj][m][1];
          u32x4_t w;
          w.x = cvt2(v0[0], v0[1]); w.y = cvt2(v0[2], v0[3]); w.z = cvt2(v1[0], v1[1]); w.w = cvt2(v1[2], v1[3]);
          *(u32x4_t*)(rowp + bj * HALF) = w;
        }
      }
  }
};
struct EpiResid {
  static constexpr bool PERM = false;
  const float* xin; float* out; const float* ga;
  DEV void operator()(const f32x4 (&acc)[2][2][4][2], const Unit& u, int wr, int wc, int fr, int fq) const {
    const int row0 = u.pm * BM + wr * 64 + fr, col0 = u.pn * BM + wc * 32 + 4 * fq;
    const int b = (u.pm * BM) / S;
    f32x4 gv[2][2];
#pragma unroll
    for (int bj = 0; bj < 2; ++bj)
#pragma unroll
      for (int n = 0; n < 2; ++n) gv[bj][n] = *(const f32x4*)(ga + b * 6144 + col0 + bj * HALF + n * 16);
#pragma unroll
    for (int ai = 0; ai < 2; ++ai)
#pragma unroll
      for (int m = 0; m < 4; ++m) {
        const size_t off = (size_t)(row0 + ai * HALF + m * 16) * 1024 + col0;
#pragma unroll
        for (int bj = 0; bj < 2; ++bj)
#pragma unroll
          for (int n = 0; n < 2; ++n) {
            const f32x4 xv = *(const f32x4*)(xin + off + bj * HALF + n * 16);
            *(f32x4*)(out + off + bj * HALF + n * 16) = xv + gv[bj][n] * acc[ai][bj][m][n];
          }
      }
  }
};
DEV float sig_(float x) { return 1.f / (1.f + __expf(-x)); }
template <bool SECOND>
struct EpiMerge {
  static constexpr bool PERM = true;
  bf16* Y; const bf16* proj; int gcol;
  DEV void operator()(const f32x4 (&acc)[2][2][4][2], const Unit& u, int wr, int wc, int fr, int fq) const {
    const int row0 = u.pm * BM + wr * 64 + fr, col0 = u.pn * BM + wc * 32 + 8 * fq;
#pragma unroll
    for (int ai = 0; ai < 2; ++ai)
#pragma unroll
      for (int m = 0; m < 4; ++m) {
        const size_t row = (size_t)(row0 + ai * HALF + m * 16);
#pragma unroll
        for (int bj = 0; bj < 2; ++bj) {
          const uint4 gq = *(const uint4*)(proj + row * PC + gcol + col0 + bj * HALF);
          float gf[8];
          unpack8(gq, gf);
          const f32x4 v0 = acc[ai][bj][m][0], v1 = acc[ai][bj][m][1];
          float o[8] = {sig_(gf[0]) * v0[0], sig_(gf[1]) * v0[1], sig_(gf[2]) * v0[2], sig_(gf[3]) * v0[3],
                        sig_(gf[4]) * v1[0], sig_(gf[5]) * v1[1], sig_(gf[6]) * v1[2], sig_(gf[7]) * v1[3]};
          bf16* yp = Y + row * 1024 + col0 + bj * HALF;
          if (SECOND) {
            float yf[8];
            unpack8(*(const uint4*)yp, yf);
#pragma unroll
            for (int j = 0; j < 8; ++j) o[j] += yf[j];
          }
          u32x4_t w;
          w.x = cvt2(o[0], o[1]); w.y = cvt2(o[2], o[3]); w.z = cvt2(o[4], o[5]); w.w = cvt2(o[6], o[7]);
          *(u32x4_t*)yp = w;
        }
      }
  }
};
struct EpiInproj {
  static constexpr bool PERM = true;
  char* ws;
  DEV void operator()(const f32x4 (&acc)[2][2][4][2], const Unit& u, int wr, int wc, int fr, int fq) const {
    const int b = (u.pm * BM) / S;
    const float* rope = (const float*)(ws + OFF_ROPE);
#pragma unroll
    for (int bj = 0; bj < 2; ++bj) {
      const int vcb = u.pn * BM + bj * HALF + wc * 32;
      if (vcb >= 4992) continue;
      const int vc0 = vcb & ~63, inh = vcb & 63;
      bf16* dbase; size_t dstride; bool roped = false; bool headmajor = false; int hh = 0, nh = 1;
      if (vc0 < 768) { dbase = (bf16*)(ws + OFF_PROJ) + vc0; dstride = PC; }
      else if (vc0 < 1280) {
        const int seg = (vc0 - 768) >> 7;
        const size_t off = (seg == 0) ? OFF_KSB : (seg == 1) ? OFF_VSB : (seg == 2) ? OFF_KWB : OFF_VWB;
        dbase = (bf16*)(ws + off); dstride = 64; headmajor = true; hh = ((vc0 - 768) >> 6) & 1; nh = 2;
        roped = (seg == 0) || (seg == 2);
      } else if (vc0 < 1792) { dbase = (bf16*)(ws + OFF_PROJ) + C_MQ + (vc0 - 1280); dstride = PC; roped = true; }
      else if (vc0 < 2816) {
        const int seg = (vc0 - 1792) >> 9;
        dbase = (bf16*)(ws + (seg ? OFF_MVB : OFF_MKB)); dstride = 64; headmajor = true; hh = ((vc0 - 1792) >> 6) & 7; nh = 8;
        roped = (seg == 0);
      } else if (vc0 < 4864) { dbase = (bf16*)(ws + OFF_PROJ) + C_GN + (vc0 - 2816); dstride = PC; }
      else { dbase = (bf16*)(ws + OFF_PROJ) + C_NG + (vc0 - 4864); dstride = PC; }
      const bool do_rope = roped && inh == 0;
#pragma unroll
      for (int ai = 0; ai < 2; ++ai)
#pragma unroll
        for (int m = 0; m < 4; ++m) {
          const int row = u.pm * BM + ai * HALF + wr * 64 + m * 16 + fr;
          const int t = row - b * S;
          const f32x4 v0 = acc[ai][bj][m][0], v1 = acc[ai][bj][m][1];
          float o[8] = {v0[0], v0[1], v0[2], v0[3], v1[0], v1[1], v1[2], v1[3]};
          if (do_rope) {
            float pv[8];
#pragma unroll
            for (int j = 0; j < 8; ++j) pv[j] = shx(o[j], 16);
            const f32x4 c0 = *(const f32x4*)(rope + (size_t)t * 16), c1 = *(const f32x4*)(rope + (size_t)t * 16 + 4);
            const f32x4 s0 = *(const f32x4*)(rope + (size_t)t * 16 + 8), s1 = *(const f32x4*)(rope + (size_t)t * 16 + 12);
            const float cs[8] = {c0[0], c0[1], c0[2], c0[3], c1[0], c1[1], c1[2], c1[3]};
            const float sn[8] = {s0[0], s0[1], s0[2], s0[3], s1[0], s1[1], s1[2], s1[3]};
            const float sg = (fq == 0) ? -1.f : 1.f;
#pragma unroll
            for (int j = 0; j < 8; ++j) o[j] = (fq < 2) ? (o[j] * cs[j] + sg * pv[j] * sn[j]) : o[j];
          }
          bf16* dp = headmajor ? (dbase + ((size_t)(b * nh + hh) * S + t) * 64 + inh + 8 * fq)
                               : (dbase + (size_t)row * dstride + inh + 8 * fq);
          u32x4_t w;
          w.x = cvt2(o[0], o[1]); w.y = cvt2(o[2], o[3]); w.z = cvt2(o[4], o[5]); w.w = cvt2(o[6], o[7]);
          *(u32x4_t*)dp = w;
        }
    }
  }
};
}

template <class F>
DEV void for_tiles_xcd(int MT, int NT, F f) {
  const int nb = vnb(), bid = vbid();
  if ((nb & 15) != 0) {
    for (int it = bid; it < MT * NT; it += nb) f(it / NT, it % NT);
    return;
  }
  const int xcd = (bid >> 1) & 7, slot = ((bid >> 4) << 1) | (bid & 1), nslot = nb >> 3;
  const int nj = (NT - xcd + 7) >> 3;
  for (int q = slot; q < MT * nj; q += nslot) f(q / nj, xcd + 8 * (q % nj));
}
constexpr int PH_PER_LAYER = 15;
enum { SP_NORM1 = 0, SP_INPROJ = 1, SP_COMPRESS = 2, SP_KMEAN = 3, SP_ATTN = 4, SP_MP0 = 5, SP_MM0 = 6, SP_MP1 = 7, SP_MM1 = 8,
       SP_MERGE = 9, SP_OUTPROJ = 10, SP_NORM2 = 11, SP_PEERQ = 12, SP_TOPK = 13, SP_EXPERT = 14 };
constexpr int N_REAL_PHASES = 1 + 2 * PH_PER_LAYER + 1;
constexpr int N_PHASES = N_REAL_PHASES + (PROBE_ANY ? 2 : 0);

DEV void run_phase(const Params& p, int ph, char* smem_raw, bool second_pass = false) {
#define SKIP_MOBA_SECOND (REP_NSA_ONLY && second_pass)
  LAS unsigned char* lds_all = (LAS unsigned char*)smem_raw;
  smem_raw += hidx() * SMEM_BYTES;
  float* smf = (float*)smem_raw;
  bf16* smh = (bf16*)smem_raw;
  const int nb = vnb(), bid = vbid();
  if (ph == 0) {
    for (int it = bid; it < PREP_ITEMS; it += nb) prep_item(p, it, smf);
    return;
  }
  if (ph == N_REAL_PHASES - 1) {
    for (int it = bid; it < T / 4; it += nb) final_norm_item(p.out, p.g_final, it);
    return;
  }
#if PROBE_ANY
  if (ph == N_REAL_PHASES) {
#if PROBE_PROJ
    {
      const unsigned char* Hh = (const unsigned char*)(p.ws + OFF_H8);
      const unsigned char* Wt = (const unsigned char*)(p.ws + OFF_WINT) + (size_t)1 * WN * 1024;
      const unsigned char* hsc = (const unsigned char*)(p.ws + OFF_H8S);
      const unsigned char* wsc = (const unsigned char*)(p.ws + OFF_WCS) + WN;
      const float* rope = (const float*)(p.ws + OFF_ROPE);
      float sd = 0.f, sr = 0.f;
      for (size_t i = (size_t)bid * 256 + tidx(); i < (size_t)(T / 64) * 4888; i += (size_t)nb * 256) {
        const int ts = (int)(i / 4888), vc = (int)(i % 4888);
        const int tok = ts * 64 + (ts % 61);
        const int b = tok / S, t = tok % S;
        auto rawdot = [&](int col) {
          float a = 0.f;
          for (int k = 0; k < 1024; ++k) {
            const f32x2_t hv = __builtin_amdgcn_cvt_pk_f32_fp8((int)Hh[(size_t)tok * 1024 + k], false);
            const f32x2_t wv = __builtin_amdgcn_cvt_pk_f32_fp8((int)Wt[(size_t)col * 1024 + k], false);
            a += hv.x * wv.x;
          }
          return a * __int_as_float((int)hsc[tok] << 23) * __int_as_float((int)wsc[col] << 23);
        };
        float v = rawdot(vc);
        bool roped = false;
        const bf16* dst;
        if (vc < 768) dst = (const bf16*)(p.ws + OFF_PROJ) + (size_t)tok * PC + vc;
        else if (vc < 1280) {
          const int seg = (vc - 768) >> 7, head = ((vc - 768) >> 6) & 1, d = vc & 63;
          const size_t off = (seg == 0) ? OFF_KSB : (seg == 1) ? OFF_VSB : (seg == 2) ? OFF_KWB : OFF_VWB;
          dst = (const bf16*)(p.ws + off) + ((size_t)(b * 2 + head) * S + t) * 64 + d;
          roped = (seg == 0 || seg == 2);
        } else if (vc < 1792) { dst = (const bf16*)(p.ws + OFF_PROJ) + (size_t)tok * PC + C_MQ + (vc - 1280); roped = true; }
        else if (vc < 2816) {
          const int seg = (vc - 1792) >> 9, head = ((vc - 1792) >> 6) & 7, d = vc & 63;
          dst = (const bf16*)(p.ws + (seg ? OFF_MVB : OFF_MKB)) + ((size_t)(b * 8 + head) * S + t) * 64 + d;
          roped = (seg == 0);
        } else if (vc < 4864) dst = (const bf16*)(p.ws + OFF_PROJ) + (size_t)tok * PC + C_GN + (vc - 2816);
        else dst = (const bf16*)(p.ws + OFF_PROJ) + (size_t)tok * PC + C_NG + (vc - 4864);
        const int d = vc & 63;
        if (roped && d < 16) {
          const float cs = rope[(size_t)t * 16 + (d & 7)], sn = rope[(size_t)t * 16 + 8 + (d & 7)];
          if (d < 8) { const float x2 = rawdot(vc + 8); v = v * cs - x2 * sn; }
          else { const float x1 = rawdot(vc - 8); v = v * cs + x1 * sn; }
        }
        const float got = bf2f(*dst);
        const bool is_r = roped && d < 16;
        if (PROBE_PROJ == 1 || (PROBE_PROJ == 2 && is_r) || (PROBE_PROJ == 3 && !is_r)) {
          sd += (got - v) * (got - v);
          sr += v * v;
        }
      }
      sd = wave_sum(sd); sr = wave_sum(sr);
      if ((tidx() & 63) == 0) {
        atomicAdd((float*)(p.ws + OFF_PROBE), sd);
        atomicAdd((float*)(p.ws + OFF_PROBE) + 1, sr);
      }
    }
#endif
#if PROBE_CMPR
    {
      float sd = 0.f, sr = 0.f;
      for (size_t i = (size_t)bid * 256 + tidx(); i < (size_t)2 * Bn * 1024 * 128; i += (size_t)nb * 256) {
        const size_t wh = i / ((size_t)Bn * 1024 * 128), r = i % ((size_t)Bn * 1024 * 128);
        const int c = (int)((r / 128) % 1024);
        if (c < 1023) {
          const float a = ((const float*)(p.ws + (wh ? OFF_VCC : OFF_KCC)))[r];
          const float y = ((const float*)(p.ws + OFF_CMP))[i];
          sd += (a - y) * (a - y);
          sr += y * y;
        }
      }
      sd = wave_sum(sd); sr = wave_sum(sr);
      if ((tidx() & 63) == 0) {
        atomicAdd((float*)(p.ws + OFF_PROBE), sd);
        atomicAdd((float*)(p.ws + OFF_PROBE) + 1, sr);
      }
    }
#endif
#if PROBE_MOBA
    probe_accum_bf16(p, (const bf16*)(p.ws + OFF_OMOBA), (const bf16*)(p.ws + OFF_CMP), (size_t)S * 512, smf);
#endif
#if PROBE_NSA == 8
    {
      const float* impn = (const float*)(p.ws + OFF_OMOBA);
      const float* impm = impn + (size_t)S * 256;
      const int* seld = (const int*)(p.ws + OFF_CMP);
      float sd = 0.f, sr = 0.f, bad = 0.f;
      for (int t = bid * 256 + tidx(); t < S; t += nb * 256) {
        const int cur = t >> 6;
        for (int n = 0; n < 256; ++n) {
          float a = impm[(size_t)t * 256 + n], r = impn[(size_t)t * 256 + n];
          sd += (a - r) * (a - r);
          sr += r * r;
        }
        unsigned want[8] = {0, 0, 0, 0, 0, 0, 0, 0}, got[8] = {0, 0, 0, 0, 0, 0, 0, 0};
        for (int j = 0; j < 16; ++j) {
          int v = seld[(size_t)t * 16 + j];
          if (v >= 0 && v < 256) {
            for (int w = 0; w < 8; ++w) if ((v >> 5) == w) got[w] |= 1u << (v & 31);
          }
        }
        if (cur < 16) {
          for (int n = 0; n <= cur; ++n) want[0] |= 1u << n;
        } else {
          want[0] |= 1u;
          for (int w = 0; w < 8; ++w) {
            if (((cur - 1) >> 5) == w) want[w] |= 1u << ((cur - 1) & 31);
            if ((cur >> 5) == w) want[w] |= 1u << (cur & 31);
          }
          for (int j = 0; j < 13; ++j) {
            float best = -1.f;
            int bi = 1;
            for (int n = 1; n <= cur - 2; ++n) {
              bool taken = false;
              for (int w = 0; w < 8; ++w) if ((n >> 5) == w) taken = (want[w] >> (n & 31)) & 1u;
              float v = impm[(size_t)t * 256 + n];
              if (!taken && v > best) { best = v; bi = n; }
            }
            for (int w = 0; w < 8; ++w) if ((bi >> 5) == w) want[w] |= 1u << (bi & 31);
          }
        }
        bool same = true;
        for (int w = 0; w < 8; ++w) same = same && (want[w] == got[w]);
        if (!same) bad += 1.f;
      }
      sd = wave_sum(sd); sr = wave_sum(sr); bad = wave_sum(bad);
      if ((tidx() & 63) == 0) {
        atomicAdd((float*)(p.ws + OFF_PROBE), sd);
        atomicAdd((float*)(p.ws + OFF_PROBE) + 1, sr);
        atomicAdd((float*)(p.ws + OFF_PROBE) + 2, bad);
      }
    }
#elif PROBE_NSA
    probe_accum_bf16(p, (const bf16*)(p.ws + OFF_ONSA), (const bf16*)(p.ws + OFF_CMP), (size_t)S * 512, smf);
#endif
    return;
  }
  if (ph == N_REAL_PHASES + 1) {
    probe_apply(p);
    return;
  }
#endif
  const int layer = (ph - 1) / PH_PER_LAYER, sub = (ph - 1) % PH_PER_LAYER;
  const float* mod = (const float*)(p.ws + OFF_MOD) + (size_t)layer * 2 * 6144;
  const float* xin = (layer == 0) ? p.x : p.out;
  bf16* H = (bf16*)(p.ws + OFF_H);
  bf16* PROJ = (bf16*)(p.ws + OFF_PROJ);
#if PROBE_ANY
  if (sub >= SP_MERGE) {
    if (sub == SP_OUTPROJ && layer == 0)
      for (size_t i = (size_t)bid * 256 + tidx(); i < (size_t)T * 1024; i += (size_t)nb * 256) p.out[i] = p.x[i];
    return;
  }
#endif
  switch (sub) {
    case SP_NORM1:
      for (int it = bid; it < T / 4; it += nb)
        norm8_item(xin, p.g_attn + layer * 1024, mod + 1024, mod + 0, (unsigned char*)(p.ws + OFF_H8), (unsigned char*)(p.ws + OFF_H8S), it);
      if (layer == 0)
        for (int it = bid; it < WQ8_ITEMS; it += nb) wq8_item(p, it, smf);
      break;
    case SP_INPROJ: {
      g8::StaticOrder so;
      so.init(T, WN, (int)gridDim.x, (int)blockIdx.x);
      g8::gemm_phase<g8::EpiInproj, true>(lds_all, g8::Gemm{(const bf16*)(p.ws + OFF_H8), (const bf16*)(p.ws + OFF_WINT + (size_t)layer * WN * 1024), T, WN, 512,
                                                             (const unsigned char*)(p.ws + OFF_H8S), (const unsigned char*)(p.ws + OFF_WCS) + (size_t)layer * WN},
                                          so, g8::EpiInproj{p.ws});
    } break;
    case SP_COMPRESS:
      for (int it = bid; it < 512 + 1024 + 256; it += nb) {
        if (it < 512) compress_mfma_item(p, layer, it, smem_raw);
        else if (it < 1536) kmean_item(p, it - 512, smf);
        else kvamax_item(p, layer, it - 1536);
      }
#if PROBE_CMPR
      if (layer == 1)
        for (int it = bid; it < 1024; it += nb) compress_item(p, layer, it, smf);
#endif
      break;
    case SP_KMEAN:
      for (int it = bid; it < 1024; it += nb) kvq_item(p, layer, it, smf);
#if PROBE_NSA
      if (layer == 1)
        for (int it = bid; it < 512; it += nb) n1_item(p, layer, it, smf);
#endif
      break;
    case SP_ATTN:
      {
        constexpr int MNI = 2;
        constexpr int NMOBA = 16 * (S / (64 * MNI));
        constexpr int NNI = 2;
        constexpr int NNSA = 4 * (S / (16 * NNI));
        const bool do_nsa = !PROBE_ANY || PROBE_NSA, do_moba = (!PROBE_ANY || PROBE_MOBA) && PROBE_NSA != 8;
        {
          constexpr int NCH = S / (16 * NNI);
          const bool affine = nb >= 8;
          const int grp = bid & 7, bk = grp & 3, sub = grp >> 2;
          const int i0 = affine ? (bid >> 3) : bid;
          const int istride = affine ? ((nb - grp + 7) >> 3) : nb;
          const int icount = affine ? (NCH / 2) : NNSA;
          if (do_nsa)
            for (int i = i0; i < icount; i += istride)
              nsa_item<NNI>(p, layer, affine ? (((2 * i + sub) << 2) | bk) : i, smem_raw, (bf16*)(p.ws + OFF_ONSA));
          if (do_moba && !SKIP_MOBA_SECOND)
            for (int it = bid; it < NMOBA; it += nb) moba_gate_item<MNI>(p, it);
        }
#if PROBE_NSA && PROBE_NSA != 8
        if (layer == 1)
          for (int it = bid; it < 512; it += nb) n23_item(p, layer, it);
#endif
#if PROBE_MOBA
        if (layer == 1) {
          for (int it = bid; it < 512; it += nb) moba_item(p, layer, it);
        }
#endif
      }
      break;
    case SP_MP0:
    case SP_MP1:
      if ((!PROBE_ANY || PROBE_MOBA) && PROBE_NSA != 8)
        for (int it = bid; it < 8 * 63 * 8; it += nb) moba_part_item2<2>(p, sub == SP_MP1 ? 1 : 0, it, smem_raw);
      break;
    case SP_MM0:
    case SP_MM1:
      if ((!PROBE_ANY || PROBE_MOBA) && PROBE_NSA != 8)
        for (int it = bid; it < 8 * (S / 128); it += nb)
          moba_merge_item<2>(p, sub == SP_MM1 ? 1 : 0, it, smem_raw, (bf16*)(p.ws + OFF_OMOBA));
      break;
    case SP_MERGE:
      {
        g8::StaticOrder so;
        so.init(T, 1024, (int)gridDim.x, (int)blockIdx.x);
        g8::gemm_phase(lds_all, g8::Gemm{(const bf16*)(p.ws + OFF_ONSA), (const bf16*)(p.ws + OFF_WUPN) + (size_t)layer * 1024 * 512, T, 1024, 512}, so,
                       g8::EpiMerge<false>{H, PROJ, C_GN});
        g8::gemm_phase(lds_all, g8::Gemm{(const bf16*)(p.ws + OFF_OMOBA), (const bf16*)(p.ws + OFF_WUPM) + (size_t)layer * 1024 * 512, T, 1024, 512}, so,
                       g8::EpiMerge<true>{H, PROJ, C_GM});
      }
      break;
    case SP_OUTPROJ: {
      const bf16* W = (const bf16*)(p.ws + OFF_WOUT) + (size_t)layer * 1024 * 1024;
      const float* ga1 = mod + 2048;
      g8::StaticOrder so;
      so.init(T, 1024, (int)gridDim.x, (int)blockIdx.x);
      g8::gemm_phase(lds_all, g8::Gemm{H, W, T, 1024, 1024}, so, g8::EpiResid{xin, p.out, ga1});
    } break;
    case SP_NORM2:
      for (int it = bid; it < T / 4 + NEXP / 4; it += nb) {
        if (it < T / 4) norm_item(p.out, p.g_ffn + layer * 1024, mod + 4096, mod + 3072, H, it);
        else expert_cvt_item(p, layer, it - T / 4);
      }
      break;
    case SP_PEERQ: {
      const bf16* W = (const bf16*)(p.ws + OFF_WQ) + (size_t)layer * 2048 * 1024;
      bf16* QP = (bf16*)(p.ws + OFF_QP);
      g8::StaticOrder so;
      so.init(T, 2048, (int)gridDim.x, (int)blockIdx.x);
      g8::gemm_phase(lds_all, g8::Gemm{H, W, T, 2048, 1024}, so, g8::EpiBf16{QP, 2048});
    } break;
    case SP_TOPK:
#if REP_MASK
      for (int it = bid; it < T / 8; it += nb) peer_topk_item3(p, layer, it);
#endif
      break;
    case SP_EXPERT:
#if REP_MASK
      for (int it = bid; it < T / 4; it += nb) peer_expert_item2(p, layer, it, second_pass ? 0.f : 1.f);
#else
      for (int it = bid; it < T / 8; it += nb) peer_fused_item(p, layer, it, smem_raw);
#endif
      break;
  }
}

#define MEGA_LB __launch_bounds__(512, 2)
__global__ void MEGA_LB mega_kernel(Params p, int ph_lo, int ph_hi) {
  __shared__ __attribute__((aligned(16))) char smem_raw[2 * SMEM_BYTES + 16];
  volatile LAS unsigned* xbst = (volatile LAS unsigned*)(smem_raw + 2 * SMEM_BYTES);
  if (threadIdx.x == 0) { xbst[0] = 0u; xbst[1] = 0u; xbst[2] = 0u; xbst[3] = 0u; }
  __syncthreads();
  XcdBarrier xb = xcd_barrier_post((unsigned*)(p.ws + OFF_BAR), xbst);
  for (int ph = ph_lo; ph < ph_hi; ++ph) {
#if !PROBE_ANY && !REP_MASK
    if (ph == N_REAL_PHASES - 1 || ph == 1 + PH_PER_LAYER || (ph >= 1 && (ph - 1) % PH_PER_LAYER == SP_TOPK))
      continue;
#endif
#if REP_MASK
    const int nrep = (ph >= 1 && ph < N_REAL_PHASES - 1 && ((REP_MASK >> ((ph - 1) % PH_PER_LAYER)) & 1)) ? 2 : 1;
    for (int rep = 0; rep < nrep; ++rep) {
      if (rep) xcd_barrier(xb);
      run_phase(p, ph, smem_raw, rep != 0);
    }
#else
    run_phase(p, ph, smem_raw);
#endif
    if (ph + 1 < ph_hi) {
      if (ph == ph_lo) cg::this_grid().sync();
      else xcd_barrier(xb);
    }
  }
}

extern "C" void kernel_launch(void* const* d_in, const int* in_sizes, int n_in, void* d_out, int out_size, void* d_ws,
                              size_t ws_size, hipStream_t stream) {
  if (ws_size < WS_TOTAL) {
    fprintf(stderr, "workspace too small: %zu < %zu\n", ws_size, (size_t)WS_NEED);
    return;
  }
  Params p{};
  p.x = (const float*)d_in[0]; p.c = (const float*)d_in[1]; p.w_ada = (const float*)d_in[2];
  p.b_ada = (const float*)d_in[3]; p.g_attn = (const float*)d_in[4]; p.g_ffn = (const float*)d_in[5];
  p.w_in = (const float*)d_in[6]; p.cmp_pe = (const float*)d_in[7]; p.cmp_w1 = (const float*)d_in[8];
  p.cmp_w2 = (const float*)d_in[9]; p.w_up_nsa = (const float*)d_in[10]; p.w_up_moba = (const float*)d_in[11];
  p.w_out = (const float*)d_in[12]; p.peer_wq = (const float*)d_in[13]; p.peer_k1 = (const float*)d_in[14];
  p.peer_k2 = (const float*)d_in[15]; p.peer_u = (const float*)d_in[16]; p.peer_v = (const float*)d_in[17];
  p.g_final = (const float*)d_in[18];
  p.out = (float*)d_out;
  p.ws = (char*)d_ws;
  static int grid_blocks = 0;
  if (!grid_blocks) {
    int dev = 0, cus = 0, per_cu = 0;
    hipGetDevice(&dev);
    hipDeviceGetAttribute(&cus, hipDeviceAttributeMultiprocessorCount, dev);
    hipOccupancyMaxActiveBlocksPerMultiprocessor(&per_cu, mega_kernel, 512, 0);
    if (per_cu < 1) per_cu = 1;
    if (per_cu > 1) per_cu = 1;
    grid_blocks = cus * per_cu;
  }
  hipMemsetAsync((char*)d_ws + OFF_BAR, 0, BAR_BYTES, stream);
  int ph_lo = 0, ph_hi = N_PHASES;
  void* args[] = {(void*)&p, (void*)&ph_lo, (void*)&ph_hi};
  hipError_t e = hipLaunchCooperativeKernel((const void*)mega_kernel, dim3(grid_blocks), dim3(512), args, 0, stream);
  if (e != hipSuccess) fprintf(stderr, "cooperative launch failed: %s (grid %d)\n", hipGetErrorString(e), grid_blocks);
}
```

```cpp
#include <hip/hip_runtime.h>
#include <hip/hip_bf16.h>
#include <hip/hip_cooperative_groups.h>
#include <cstdio>
#include <cstdint>
namespace cg = cooperative_groups;

#define DEV __device__ __forceinline__
typedef unsigned short bf16;
using bf16x8 = __attribute__((ext_vector_type(8))) short;
using f32x4 = __attribute__((ext_vector_type(4))) float;

constexpr int Bn = 2, S = 16384, T = Bn * S, D = 1024;
constexpr int PC = 3456;
constexpr int WN = 5120;
constexpr int C_NQ = 0, C_KC = 512, C_VC = 640, C_MQ = 768, C_GN = 1280, C_GM = 2304, C_NG = 3328;
constexpr int NEXP = 16384;

constexpr size_t al(size_t x) { return (x + 255) & ~size_t(255); }
constexpr size_t OFF_MOD = 0;
constexpr size_t OFF_ROPE = al(OFF_MOD + 2 * 2 * 6144 * 4);
constexpr size_t OFF_PEB = al(OFF_ROPE + (size_t)S * 16 * 4);
constexpr size_t OFF_WINT = al(OFF_PEB + 2 * 2 * 128 * 4);
constexpr size_t OFF_WUPN = al(OFF_WINT + 2ull * WN * 1024 * 2);
constexpr size_t OFF_WUPM = al(OFF_WUPN + 2ull * 1024 * 512 * 2);
constexpr size_t OFF_WOUT = al(OFF_WUPM + 2ull * 1024 * 512 * 2);
constexpr size_t OFF_WQ = al(OFF_WOUT + 2ull * 1024 * 1024 * 2);
constexpr size_t OFF_KCC = al(OFF_WQ + 2ull * 2048 * 1024 * 2);
constexpr size_t OFF_VCC = al(OFF_KCC + 2ull * 1024 * 128 * 4);
constexpr size_t OFF_SEL = al(OFF_VCC + 2ull * 1024 * 128 * 4);
constexpr size_t OFF_KMEAN = al(OFF_SEL + 2ull * 2 * S * 16 * 4);
constexpr size_t OFF_KMHL = al(OFF_KMEAN + 2ull * 8 * 64 * 64 * 4);
constexpr size_t OFF_KCB = al(OFF_KMHL + 2ull * 2 * 8 * 64 * 64 * 2);
constexpr size_t OFF_VCB = al(OFF_KCB + 2ull * 2 * 1024 * 64 * 2);
constexpr size_t OFF_PKB = al(OFF_VCB + 2ull * 2 * 1024 * 64 * 2);
constexpr size_t OFF_W1T = al(OFF_PKB + 2ull * 2 * 128 * 128 * 2);
constexpr size_t OFF_BAR = al(OFF_W1T + 4ull * 128 * 2048 * 2);
constexpr size_t BAR_BYTES = 3456 * 4;
constexpr size_t OFF_PROBE = al(OFF_BAR + BAR_BYTES);
constexpr size_t OFF_H = al(OFF_PROBE + 256);
constexpr size_t OFF_WCS = OFF_WINT + 2ull * WN * 1024;
constexpr size_t OFF_ONSA = al(OFF_H + (size_t)T * 1024 * 2);
constexpr size_t OFF_OMOBA = al(OFF_ONSA + (size_t)T * 512 * 2);
constexpr size_t OFF_H8 = OFF_ONSA;
constexpr size_t OFF_H8S = OFF_OMOBA;
constexpr size_t OFF_PROJ = al(OFF_OMOBA + (size_t)T * 512 * 2);
constexpr size_t KV2_BYTES = (size_t)Bn * 2 * S * 64 * 2, KV8_BYTES = (size_t)Bn * 8 * S * 64 * 2;
constexpr size_t OFF_KSB = al(OFF_PROJ + (size_t)T * PC * 2);
constexpr size_t OFF_VSB = OFF_KSB + KV2_BYTES;
constexpr size_t OFF_KWB = OFF_VSB + KV2_BYTES;
constexpr size_t OFF_VWB = OFF_KWB + KV2_BYTES;
constexpr size_t OFF_MKB = OFF_VWB + KV2_BYTES;
constexpr size_t OFF_MVB = OFF_MKB + KV8_BYTES;
constexpr int MLIST_PER_BH = 63 * S - 128 * 63 * 64;
constexpr size_t OFF_MLIST = OFF_MVB + KV8_BYTES;
constexpr int MCNT_STRIDE = 32;
constexpr size_t OFF_MCNT = al(OFF_MLIST + (size_t)Bn * 8 * MLIST_PER_BH * 2);
constexpr size_t OFF_KS8 = al(OFF_MCNT + (size_t)Bn * 8 * 64 * 4 * MCNT_STRIDE);
constexpr size_t OFF_VT8 = OFF_KS8 + (size_t)Bn * 2 * S * 64;
constexpr size_t WS_NEED = OFF_VT8 + (size_t)Bn * 2 * S * 64;
constexpr size_t PROJ_BYTES = (size_t)T * PC * 2;
constexpr size_t OFF_MPO = OFF_H;
constexpr size_t OFF_MPML = OFF_H + (size_t)8 * S * 3 * 64 * 2;
static_assert((size_t)8 * S * 3 * 64 * 2 + (size_t)8 * S * 3 * 8 <= (size_t)T * 1024 * 2, "moba partials must fit the H region");
constexpr size_t OFF_QP = OFF_PROJ;
constexpr size_t OFF_PEIDX = al(OFF_QP + (size_t)T * 2048 * 2);
constexpr size_t OFF_PEG = al(OFF_PEIDX + (size_t)T * 128 * 4);
constexpr size_t OFF_E8 = al(OFF_PEG + (size_t)T * 128 * 4);
constexpr size_t OFF_ESC = al(OFF_E8 + (size_t)NEXP * 2048);
static_assert(OFF_ESC + (size_t)NEXP * 2 * 4 <= OFF_PROJ + PROJ_BYTES, "peer alias overflow");
static_assert(WS_NEED <= 536870912ull, "workspace too big");
#ifndef PROBE_MOBA
#define PROBE_MOBA 0
#endif
constexpr size_t OFF_CMP = PROBE_MOBA ? OFF_ONSA : OFF_MLIST;
#ifndef REP_NSA_ONLY
#define REP_NSA_ONLY 0
#endif
#ifndef REP_NSA_PART
#define REP_NSA_PART 0
#endif
#ifndef REP_MASK
#define REP_MASK 0
#endif
#ifndef PROBE_MOBA
#define PROBE_MOBA 0
#endif
#ifndef PROBE_NSA
#define PROBE_NSA 0
#endif
#ifndef PROBE_CMPR
#define PROBE_CMPR 0
#endif
#ifndef PROBE_PROJ
#define PROBE_PROJ 0
#endif
#define PROBE_ANY (PROBE_MOBA || PROBE_NSA || PROBE_CMPR || PROBE_PROJ)
constexpr size_t WS_TOTAL = WS_NEED;
static_assert(WS_TOTAL <= 536870912ull, "workspace too big (probe)");

struct Params {
  const float *x, *c, *w_ada, *b_ada, *g_attn, *g_ffn, *w_in, *cmp_pe, *cmp_w1, *cmp_w2, *w_up_nsa, *w_up_moba, *w_out,
      *peer_wq, *peer_k1, *peer_k2, *peer_u, *peer_v, *g_final;
  float* out;
  char* ws;
};

constexpr int SMEM_BYTES = 74 * 1024;

DEV int tidx() {
  int t = threadIdx.x & 255;
  asm volatile("" : "+v"(t));
  return t;
}
DEV int hidx() { return __builtin_amdgcn_readfirstlane((int)(threadIdx.x >> 8)); }
DEV int vbid() { return (int)blockIdx.x * 2 + hidx(); }
DEV int vnb() { return (int)gridDim.x * 2; }
#define MFMA16B(a, b, c) __builtin_amdgcn_mfma_f32_16x16x32_bf16(a, b, c, 0, 0, 0)
DEV unsigned cvtpk_(float lo, float hi) {
  unsigned r;
  asm("v_cvt_pk_bf16_f32 %0, %1, %2" : "=v"(r) : "v"(lo), "v"(hi));
  return r;
}
DEV float bf2f(bf16 h) { return __uint_as_float(((unsigned)h) << 16); }
DEV bf16 f2bf(float f) {
  unsigned u = __float_as_uint(f);
  u += 0x7fffu + ((u >> 16) & 1u);
  return (bf16)(u >> 16);
}
DEV float gelu_tanh(float x) {
  float u = 0.7978845608028654f * (x + 0.044715f * x * x * x);
  return 0.5f * x * (1.f + tanhf(u));
}
DEV float sigmoidf_(float x) { return 1.f / (1.f + expf(-x)); }
DEV void unpack8(uint4 v, float* f) {
  f[0] = __uint_as_float(v.x << 16); f[1] = __uint_as_float(v.x & 0xffff0000u);
  f[2] = __uint_as_float(v.y << 16); f[3] = __uint_as_float(v.y & 0xffff0000u);
  f[4] = __uint_as_float(v.z << 16); f[5] = __uint_as_float(v.z & 0xffff0000u);
  f[6] = __uint_as_float(v.w << 16); f[7] = __uint_as_float(v.w & 0xffff0000u);
}
DEV float dot64_bf(const float* q, const bf16* row) {
  float s = 0.f;
#pragma unroll
  for (int i = 0; i < 8; ++i) {
    float f[8];
    unpack8(*(const uint4*)(row + i * 8), f);
#pragma unroll
    for (int j = 0; j < 8; ++j) s += q[i * 8 + j] * f[j];
  }
  return s;
}
DEV void axpy64_bf(float* o, float a, const bf16* row) {
#pragma unroll
  for (int i = 0; i < 8; ++i) {
    float f[8];
    unpack8(*(const uint4*)(row + i * 8), f);
#pragma unroll
    for (int j = 0; j < 8; ++j) o[i * 8 + j] += a * f[j];
  }
}
DEV float dot64_f(const float* q, const float* row) {
  float s = 0.f;
#pragma unroll
  for (int i = 0; i < 16; ++i) {
    float4 v = *(const float4*)(row + i * 4);
    s += q[i * 4] * v.x + q[i * 4 + 1] * v.y + q[i * 4 + 2] * v.z + q[i * 4 + 3] * v.w;
  }
  return s;
}
DEV void axpy64_f(float* o, float a, const float* row) {
#pragma unroll
  for (int i = 0; i < 16; ++i) {
    float4 v = *(const float4*)(row + i * 4);
    o[i * 4] += a * v.x; o[i * 4 + 1] += a * v.y; o[i * 4 + 2] += a * v.z; o[i * 4 + 3] += a * v.w;
  }
}
DEV void load_q64(float* q, const bf16* p, float scale) {
#pragma unroll
  for (int i = 0; i < 8; ++i) unpack8(*(const uint4*)(p + i * 8), q + i * 8);
#pragma unroll
  for (int i = 0; i < 64; ++i) q[i] *= scale;
}
DEV int lane_id_() { return __builtin_amdgcn_mbcnt_hi(~0u, __builtin_amdgcn_mbcnt_lo(~0u, 0u)); }
DEV int shx(int v, int m) {
  if (m == 1) return __builtin_amdgcn_update_dpp(0, v, 0xB1, 0xF, 0xF, true);
  if (m == 2) return __builtin_amdgcn_update_dpp(0, v, 0x4E, 0xF, 0xF, true);
  if (m == 4) return __builtin_amdgcn_ds_swizzle(v, 0x101F);
  if (m == 8) return __builtin_amdgcn_update_dpp(0, v, 0x128, 0xF, 0xF, true);
  if (m == 16) return __builtin_amdgcn_ds_swizzle(v, 0x401F);
  auto rr = __builtin_amdgcn_permlane32_swap((unsigned)v, (unsigned)v, false, false);
  return (lane_id_() < 32) ? (int)rr[1] : (int)rr[0];
}
DEV unsigned shx(unsigned v, int m) { return (unsigned)shx((int)v, m); }
DEV float shx(float v, int m) { return __int_as_float(shx(__float_as_int(v), m)); }
DEV float wave_sum(float v) {
#pragma unroll
  for (int o = 32; o >= 1; o >>= 1) v += shx(v, o);
  return v;
}

#define XB_TMO      128
#define XB_XCNT(j)  (256  + 64 * (j))
#define XB_XSUB(j)  (1280 + 64 * (j))
#define XB_XGEN(j)  (2304 + 64 * (j))
#define XB_TOP      3328
#define XB_TOPGEN   3392
#define XCD_BAR_WORDS 3456
#define XB_SPIN_CAP (1u << 18)
#define LAS __attribute__((address_space(3)))

__device__ __forceinline__ unsigned xb_ld(unsigned* p)              { return __hip_atomic_load(p, __ATOMIC_RELAXED, __HIP_MEMORY_SCOPE_AGENT); }
__device__ __forceinline__ unsigned xb_add(unsigned* p, unsigned v) { return __hip_atomic_fetch_add(p, v, __ATOMIC_RELAXED, __HIP_MEMORY_SCOPE_AGENT); }
__device__ __forceinline__ unsigned xb_xcc_id() { return (unsigned)__builtin_amdgcn_s_getreg((3 << 11) | 20) & 0xFu; }
#define XB_SPIN(cond, bar) do { unsigned _sp = 0; while (cond) { __builtin_amdgcn_s_sleep(1); \
    if ((++_sp & 255u) == 0u) { if (xb_ld(&(bar)[XB_TMO])) break; if (_sp > XB_SPIN_CAP) { atomicAdd(&(bar)[XB_TMO], 1u); break; } } } } while (0)

struct XcdBarrier {
    unsigned* bar; unsigned x;
    volatile LAS unsigned* st;
};

__device__ __forceinline__ XcdBarrier xcd_barrier_post(unsigned* bar, volatile LAS unsigned* st) {
    XcdBarrier b; b.bar = bar; b.x = xb_xcc_id(); b.st = st;
    if (threadIdx.x == 0) (void)xb_add(&bar[XB_XCNT(b.x)], 1u);
    return b;
}
__device__ __forceinline__ void xcd_barrier_complete(unsigned* bar, unsigned x, unsigned& nloc, unsigned& nx) {
    const unsigned G = gridDim.x * gridDim.y * gridDim.z;
    unsigned sum, cnt, mine, sp = 0u;
    for (;;) {
        sum = 0u; cnt = 0u; mine = 0u;
#pragma unroll
        for (unsigned j = 0; j < 16; ++j) { const unsigned c = xb_ld(&bar[XB_XCNT(j)]); sum += c; cnt += (c > 0u) ? 1u : 0u; mine = (j == x) ? c : mine; }
        if (sum == G) break;
        __builtin_amdgcn_s_sleep(1);
        if ((++sp & 255u) == 0u) { if (xb_ld(&bar[XB_TMO])) break; if (sp > XB_SPIN_CAP) { atomicAdd(&bar[XB_TMO], 1u); break; } }
    }
    nloc = mine > 0u ? mine : 1u; nx = cnt > 0u ? cnt : 1u;
}

__device__ __forceinline__ void xcd_barrier(const XcdBarrier& b) {
    asm volatile("s_waitcnt vmcnt(0)" ::: "memory");
    __syncthreads();
    if (threadIdx.x == 0) {
        unsigned* bar = b.bar;
        __builtin_amdgcn_s_waitcnt(0);
        unsigned nloc = b.st[0], nx = b.st[1];
        if (nloc == 0u) { xcd_barrier_complete(bar, b.x, nloc, nx); b.st[0] = nloc; b.st[1] = nx; }
        const unsigned old = xb_add(&bar[XB_XSUB(b.x)], 1u);
        const unsigned gen = old / nloc;
        if (old + 1u == (gen + 1u) * nloc) {
            __builtin_amdgcn_fence(__ATOMIC_RELEASE, "agent");
            asm volatile("s_waitcnt vmcnt(0)" ::: "memory");
            const unsigned og = xb_add(&bar[XB_TOP], 1u);
            const unsigned tg = og / nx;
            if (og + 1u == (tg + 1u) * nx) xb_add(&bar[XB_TOPGEN], 1u);
            else XB_SPIN(xb_ld(&bar[XB_TOPGEN]) == tg, bar);
            __builtin_amdgcn_fence(__ATOMIC_ACQUIRE, "agent");
            xb_add(&bar[XB_XGEN(b.x)], 1u);
            asm volatile("s_waitcnt vmcnt(0)" ::: "memory");
        } else {
            XB_SPIN(xb_ld(&bar[XB_XGEN(b.x)]) == gen, bar);
            __builtin_amdgcn_fence(__ATOMIC_ACQUIRE, "agent");
            asm volatile("s_waitcnt vmcnt(0)" ::: "memory");
        }
    }
    __syncthreads();
}


DEV int win_col_map(int j) {
  if (j < 1280) return j;
  if (j < 4864) return j + 24;
  if (j < 4888) return j - 4864 + 1280;
  return -1;
}
DEV void tr_tile(const float* __restrict__ src, int ldsrc, int K, bf16* __restrict__ dst, int kt, int nt, bool remap,
                 float* sm) {
  const int tid = tidx();
#pragma unroll 4
  for (int i = 0; i < 16; ++i) {
    int r = i * 4 + (tid >> 6), cx = tid & 63;
    int j = nt * 64 + cx, k = kt * 64 + r;
    int oc = remap ? win_col_map(j) : j;
    sm[r * 65 + cx] = (oc >= 0) ? src[(size_t)k * ldsrc + oc] : 0.f;
  }
  __syncthreads();
#pragma unroll 4
  for (int i = 0; i < 16; ++i) {
    int n = i * 4 + (tid >> 6), kk = tid & 63;
    dst[(size_t)(nt * 64 + n) * K + kt * 64 + kk] = f2bf(sm[kk * 65 + n]);
  }
  __syncthreads();
}

DEV unsigned e8m0_of(float amax) {
  const unsigned bits = (unsigned)__float_as_int(amax * (1.f / 224.f));
  unsigned e = ((bits >> 23) & 255u) + ((bits & 0x7fffffu) ? 1u : 0u);
  return e < 1u ? 1u : (e > 253u ? 253u : e);
}
DEV float e8m0_inv(unsigned e) { return __int_as_float((int)((254u - e) << 23)); }
DEV unsigned pack4_fp8_(float a, float b, float c, float d) {
  int q = __builtin_amdgcn_cvt_pk_fp8_f32(a, b, 0, false);
  q = __builtin_amdgcn_cvt_pk_fp8_f32(c, d, q, true);
  return (unsigned)q;
}
DEV void wamax_item(const Params& p, int item) {
  const int l = item >> 7, part = item & 127;
  const size_t per = (size_t)1024 * 4888 / 128;
  const float4* src = (const float4*)(p.w_in + (size_t)l * 1024 * 4888 + (size_t)part * per);
  float m = 0.f;
  for (int i = tidx(); i < (int)(per / 4); i += 256) {
    const float4 v = src[i];
    m = fmaxf(m, fmaxf(fmaxf(fabsf(v.x), fabsf(v.y)), fmaxf(fabsf(v.z), fabsf(v.w))));
  }
#pragma unroll
  for (int o = 32; o >= 1; o >>= 1) m = fmaxf(m, shx(m, o));
  if ((tidx() & 63) == 0) atomicMax((unsigned*)(p.ws + OFF_BAR) + l, (unsigned)__float_as_int(m));
}
DEV void wq8_item(const Params& p, int item, float* sm) {
  const int tid = tidx();
  const int l = item / (80 * 16), r_ = item % (80 * 16);
  const int nt = r_ / 16, kt = r_ % 16;
  const float* src = p.w_in + (size_t)l * 1024 * 4888;
  unsigned char* dst = (unsigned char*)(p.ws + OFF_WINT) + (size_t)l * WN * 1024;
  const unsigned e = e8m0_of(__int_as_float((int)__hip_atomic_load((const unsigned*)(p.ws + OFF_BAR) + l, __ATOMIC_RELAXED, __HIP_MEMORY_SCOPE_AGENT)));
  const float s = e8m0_inv(e);
#pragma unroll 4
  for (int i = 0; i < 16; ++i) {
    const int r = i * 4 + (tid >> 6), cx = tid & 63;
    const int oc = win_col_map(nt * 64 + cx);
    sm[r * 65 + cx] = (oc >= 0) ? src[(size_t)(kt * 64 + r) * 4888 + oc] : 0.f;
  }
  __syncthreads();
  const int kq = tid & 15;
#pragma unroll
  for (int i = 0; i < 4; ++i) {
    const int n = i * 16 + (tid >> 4);
    const float v0 = sm[(kq * 4 + 0) * 65 + n], v1 = sm[(kq * 4 + 1) * 65 + n], v2 = sm[(kq * 4 + 2) * 65 + n], v3 = sm[(kq * 4 + 3) * 65 + n];
    *(unsigned*)(dst + (size_t)(nt * 64 + n) * 1024 + kt * 64 + kq * 4) = pack4_fp8_(v0 * s, v1 * s, v2 * s, v3 * s);
  }
  if (kt == 0 && tid < 64) ((unsigned char*)(p.ws + OFF_WCS))[(size_t)l * WN + nt * 64 + tid] = (unsigned char)e;
  __syncthreads();
}
constexpr int WQ8_ITEMS = 2 * 80 * 16;
constexpr int PREP_TR_WIN = 2 * 128;
constexpr int PREP_TR_UPN = 2 * 16 * 8;
constexpr int PREP_TR_UPM = 2 * 16 * 8;
constexpr int PREP_TR_OUT = 2 * 16 * 16;
constexpr int PREP_TR_WQ = 2 * 32 * 16;
constexpr int PREP_ROPE = 512;
constexpr int PREP_MOD = 384;
constexpr int PREP_PEB = 16;
constexpr int PREP_PK = 32;
constexpr int PREP_TR_W1 = 4 * 2 * 32;
constexpr int PREP_ITEMS = PREP_TR_WIN + PREP_TR_UPN + PREP_TR_UPM + PREP_TR_OUT + PREP_TR_WQ + PREP_ROPE + PREP_MOD + PREP_PEB + PREP_PK + PREP_TR_W1;

DEV void prep_item(const Params& p, int item, float* sm) {
  const int tid = tidx();
  if (item < PREP_TR_WIN) {
    wamax_item(p, item);
    return;
  }
  item -= PREP_TR_WIN;
  if (item < PREP_TR_UPN) {
    int l = item / 128, r = item % 128;
    int nt = r / 8, kt = r % 8;
    tr_tile(p.w_up_nsa + (size_t)l * 512 * 1024, 1024, 512, (bf16*)(p.ws + OFF_WUPN) + (size_t)l * 1024 * 512, kt, nt, false, sm);
    return;
  }
  item -= PREP_TR_UPN;
  if (item < PREP_TR_UPM) {
    int l = item / 128, r = item % 128;
    int nt = r / 8, kt = r % 8;
    tr_tile(p.w_up_moba + (size_t)l * 512 * 1024, 1024, 512, (bf16*)(p.ws + OFF_WUPM) + (size_t)l * 1024 * 512, kt, nt, false, sm);
    return;
  }
  item -= PREP_TR_UPM;
  if (item < PREP_TR_OUT) {
    int l = item / 256, r = item % 256;
    int nt = r / 16, kt = r % 16;
    tr_tile(p.w_out + (size_t)l * 1024 * 1024, 1024, 1024, (bf16*)(p.ws + OFF_WOUT) + (size_t)l * 1024 * 1024, kt, nt, false, sm);
    return;
  }
  item -= PREP_TR_OUT;
  if (item < PREP_TR_WQ) {
    int l = item / 512, r = item % 512;
    int nt = r / 16, kt = r % 16;
    tr_tile(p.peer_wq + (size_t)l * 1024 * 2048, 2048, 1024, (bf16*)(p.ws + OFF_WQ) + (size_t)l * 2048 * 1024, kt, nt, false, sm);
    return;
  }
  item -= PREP_TR_WQ;
  if (item < PREP_ROPE) {
    int idx = item * 256 + tid;
    int pos = idx >> 3, i = idx & 7;
    float inv = powf(500000.0f, -(float)i / 8.0f);
    float ang = (float)pos * inv;
    float* rp = (float*)(p.ws + OFF_ROPE) + (size_t)pos * 16;
    rp[i] = cosf(ang);
    rp[8 + i] = sinf(ang);
    return;
  }
  item -= PREP_ROPE;
  if (item < PREP_MOD) {
    for (int i = tid; i < 2048; i += 256) {
      float cv = p.c[i];
      sm[i] = cv / (1.f + expf(-cv));
    }
    __syncthreads();
    const int l = item / 192, n0 = (item % 192) * 32;
    const int col = tid & 31, ks = tid >> 5;
    const float* w = p.w_ada + (size_t)l * 1024 * 6144 + n0 + col;
    float a0 = 0.f, a1 = 0.f;
#pragma unroll 8
    for (int k = ks * 128; k < ks * 128 + 128; ++k) {
      float wv = w[(size_t)k * 6144];
      a0 += sm[k] * wv;
      a1 += sm[1024 + k] * wv;
    }
    sm[2048 + tid * 2] = a0;
    sm[2048 + tid * 2 + 1] = a1;
    __syncthreads();
    if (tid < 64) {
      const int c2 = tid & 31, bs = tid >> 5;
      float s = 0.f;
#pragma unroll
      for (int q = 0; q < 8; ++q) s += sm[2048 + (q * 32 + c2) * 2 + bs];
      ((float*)(p.ws + OFF_MOD))[(l * 2 + bs) * 6144 + n0 + c2] = s + p.b_ada[l * 6144 + n0 + c2];
    }
    __syncthreads();
    return;
  }
  item -= PREP_MOD;
  if (item < PREP_PEB) {
    const int lw = item >> 2, j0 = (item & 3) * 32;
    const int col = tid & 31, ks = tid >> 5;
    const float* pe = p.cmp_pe + (size_t)lw * 2048;
    const float* w1 = p.cmp_w1 + (size_t)lw * 2048 * 128 + j0 + col;
    float a = 0.f;
#pragma unroll 8
    for (int i = ks * 256; i < ks * 256 + 256; ++i) a += pe[i] * w1[(size_t)i * 128];
    sm[tid] = a;
    __syncthreads();
    if (tid < 32) {
      float s = 0.f;
#pragma unroll
      for (int q = 0; q < 8; ++q) s += sm[q * 32 + tid];
      ((float*)(p.ws + OFF_PEB))[lw * 128 + j0 + tid] = s;
    }
    if (item == 0 && tid < 4) ((float*)(p.ws + OFF_PROBE))[tid] = 0.f;
    __syncthreads();
    return;
  }
  item -= PREP_PEB;
  if (item < PREP_PK) {
    const int e0 = item * 2048 + tid * 8;
    const int lt = e0 >> 14, off = e0 & 16383;
    const float* srcp = ((lt & 1) ? p.peer_k2 : p.peer_k1) + (size_t)(lt >> 1) * 16384 + off;
    const float4 a = *(const float4*)srcp, b4 = *(const float4*)(srcp + 4);
    uint4 pk;
    pk.x = (unsigned)f2bf(a.x) | ((unsigned)f2bf(a.y) << 16);
    pk.y = (unsigned)f2bf(a.z) | ((unsigned)f2bf(a.w) << 16);
    pk.z = (unsigned)f2bf(b4.x) | ((unsigned)f2bf(b4.y) << 16);
    pk.w = (unsigned)f2bf(b4.z) | ((unsigned)f2bf(b4.w) << 16);
    *(uint4*)((bf16*)(p.ws + OFF_PKB) + e0) = pk;
    return;
  }
  item -= PREP_PK;
  {
    const int lw = item >> 6, r = item & 63;
    const int nt = r >> 5, kt = r & 31;
    tr_tile(p.cmp_w1 + (size_t)lw * 2048 * 128, 128, 2048, (bf16*)(p.ws + OFF_W1T) + (size_t)lw * 128 * 2048, kt, nt, false, sm);
  }
}

DEV void norm_item(const float* __restrict__ xin, const float* __restrict__ g, const float* __restrict__ sc,
                   const float* __restrict__ sh, bf16* __restrict__ hout, int item) {
  const int lane = tidx() & 63, wave = tidx() >> 6;
  const size_t tok = (size_t)item * 4 + wave;
  const int b = (int)(tok / S);
  const float* xr = xin + tok * 1024;
  float4 v[4];
  float ss = 0.f;
#pragma unroll
  for (int i = 0; i < 4; ++i) {
    v[i] = *(const float4*)(xr + i * 256 + lane * 4);
    ss += v[i].x * v[i].x + v[i].y * v[i].y + v[i].z * v[i].z + v[i].w * v[i].w;
  }
  ss = wave_sum(ss);
  float r = 1.0f / sqrtf(ss * (1.0f / 1024.f) + 1e-6f);
#pragma unroll
  for (int i = 0; i < 4; ++i) {
    int d = i * 256 + lane * 4;
    float4 gg = *(const float4*)(g + d);
    float4 s4 = *(const float4*)(sc + b * 6144 + d);
    float4 h4 = *(const float4*)(sh + b * 6144 + d);
    float o0 = v[i].x * r * gg.x * (1.f + s4.x) + h4.x;
    float o1 = v[i].y * r * gg.y * (1.f + s4.y) + h4.y;
    float o2 = v[i].z * r * gg.z * (1.f + s4.z) + h4.z;
    float o3 = v[i].w * r * gg.w * (1.f + s4.w) + h4.w;
    uint2 pk;
    pk.x = (unsigned)f2bf(o0) | ((unsigned)f2bf(o1) << 16);
    pk.y = (unsigned)f2bf(o2) | ((unsigned)f2bf(o3) << 16);
    *(uint2*)(hout + tok * 1024 + d) = pk;
  }
}
DEV void norm8_item(const float* __restrict__ xin, const float* __restrict__ g, const float* __restrict__ sc,
                    const float* __restrict__ sh, unsigned char* __restrict__ hout, unsigned char* __restrict__ hscale, int item) {
  const int lane = tidx() & 63, wave = tidx() >> 6;
  const size_t tok = (size_t)item * 4 + wave;
  const int b = (int)(tok / S);
  const float* xr = xin + tok * 1024;
  float4 v[4];
  float ss = 0.f;
#pragma unroll
  for (int i = 0; i < 4; ++i) {
    v[i] = *(const float4*)(xr + i * 256 + lane * 4);
    ss += v[i].x * v[i].x + v[i].y * v[i].y + v[i].z * v[i].z + v[i].w * v[i].w;
  }
  ss = wave_sum(ss);
  float r = 1.0f / sqrtf(ss * (1.0f / 1024.f) + 1e-6f);
  float mx = 0.f;
#pragma unroll
  for (int i = 0; i < 4; ++i) {
    int d = i * 256 + lane * 4;
    float4 gg = *(const float4*)(g + d);
    float4 s4 = *(const float4*)(sc + b * 6144 + d);
    float4 h4 = *(const float4*)(sh + b * 6144 + d);
    v[i].x = v[i].x * r * gg.x * (1.f + s4.x) + h4.x;
    v[i].y = v[i].y * r * gg.y * (1.f + s4.y) + h4.y;
    v[i].z = v[i].z * r * gg.z * (1.f + s4.z) + h4.z;
    v[i].w = v[i].w * r * gg.w * (1.f + s4.w) + h4.w;
    mx = fmaxf(mx, fmaxf(fmaxf(fabsf(v[i].x), fabsf(v[i].y)), fmaxf(fabsf(v[i].z), fabsf(v[i].w))));
  }
#pragma unroll
  for (int o = 32; o >= 1; o >>= 1) mx = fmaxf(mx, shx(mx, o));
  const unsigned e = e8m0_of(mx);
  const float s = e8m0_inv(e);
#pragma unroll
  for (int i = 0; i < 4; ++i)
    *(unsigned*)(hout + tok * 1024 + i * 256 + lane * 4) = pack4_fp8_(v[i].x * s, v[i].y * s, v[i].z * s, v[i].w * s);
  if (lane == 0) hscale[tok] = (unsigned char)e;
}
DEV void final_norm_item(float* __restrict__ x, const float* __restrict__ g, int item) {
  const int lane = tidx() & 63, wave = tidx() >> 6;
  const size_t tok = (size_t)item * 4 + wave;
  float* xr = x + tok * 1024;
  float4 v[4];
  float ss = 0.f;
#pragma unroll
  for (int i = 0; i < 4; ++i) {
    v[i] = *(const float4*)(xr + i * 256 + lane * 4);
    ss += v[i].x * v[i].x + v[i].y * v[i].y + v[i].z * v[i].z + v[i].w * v[i].w;
  }
  ss = wave_sum(ss);
  float r = 1.0f / sqrtf(ss * (1.0f / 1024.f) + 1e-6f);
#pragma unroll
  for (int i = 0; i < 4; ++i) {
    int d = i * 256 + lane * 4;
    float4 gg = *(const float4*)(g + d);
    float4 o;
    o.x = v[i].x * r * gg.x; o.y = v[i].y * r * gg.y; o.z = v[i].z * r * gg.z; o.w = v[i].w * r * gg.w;
    *(float4*)(xr + d) = o;
  }
}

#define GM_BUF (2 * 128 * 72)
#define GM_LOAD(R, kk)                                                                                  \
  {                                                                                                     \
    const bf16* Ak = Ap + (kk);                                                                         \
    const bf16* Wk = Wp + (kk);                                                                         \
    R##a0 = *(const uint4*)(Ak); R##a1 = *(const uint4*)(Ak + a32); R##a2 = *(const uint4*)(Ak + 2 * a32); \
    R##a3 = *(const uint4*)(Ak + 3 * a32);                                                              \
    R##b0 = *(const uint4*)(Wk); R##b1 = *(const uint4*)(Wk + w32); R##b2 = *(const uint4*)(Wk + 2 * w32); \
    R##b3 = *(const uint4*)(Wk + 3 * w32);                                                              \
  }
#define GM_STORE(R, buf)                                                                                \
  {                                                                                                     \
    bf16* as_ = Asw + (buf) * GM_BUF;                                                                   \
    bf16* bs_ = as_ + 128 * 72;                                                                         \
    *(uint4*)(as_) = R##a0; *(uint4*)(as_ + 32 * 72) = R##a1; *(uint4*)(as_ + 64 * 72) = R##a2; *(uint4*)(as_ + 96 * 72) = R##a3; \
    *(uint4*)(bs_) = R##b0; *(uint4*)(bs_ + 32 * 72) = R##b1; *(uint4*)(bs_ + 64 * 72) = R##b2; *(uint4*)(bs_ + 96 * 72) = R##b3; \
  }
#define GM_COMPUTE(buf)                                                                                 \
  {                                                                                                     \
    const bf16* As_ = sm + (buf) * GM_BUF;                                                              \
    const bf16* Bs_ = As_ + 128 * 72;                                                                   \
    _Pragma("unroll") for (int ks = 0; ks < 2; ++ks) {                                                  \
      __builtin_amdgcn_sched_barrier(0);                                                                \
      bf16x8 af[4], bfr[4];                                                                             \
      _Pragma("unroll") for (int mi = 0; mi < 4; ++mi)                                                  \
        af[mi] = *(const bf16x8*)(As_ + (wr * 64 + mi * 16 + (lane & 15)) * 72 + ks * 32 + (lane >> 4) * 8); \
      _Pragma("unroll") for (int ni = 0; ni < 4; ++ni)                                                  \
        bfr[ni] = *(const bf16x8*)(Bs_ + (wc * 64 + ni * 16 + (lane & 15)) * 72 + ks * 32 + (lane >> 4) * 8); \
      _Pragma("unroll") for (int mi = 0; mi < 4; ++mi)                                                  \
        _Pragma("unroll") for (int ni = 0; ni < 4; ++ni)                                                \
          acc[mi][ni] = __builtin_amdgcn_mfma_f32_16x16x32_bf16(af[mi], bfr[ni], acc[mi][ni], 0, 0, 0); \
    }                                                                                                   \
    __builtin_amdgcn_sched_barrier(0);                                                                  \
  }
DEV void gemm_mainloop(const bf16* __restrict__ A, int lda, const bf16* __restrict__ W, int K, int m0, int n0, bf16* sm,
                       f32x4 (&acc)[4][4]) {
  const int tid = tidx(), lane = tid & 63, wave = tid >> 6;
  const int wr = wave >> 1, wc = wave & 1;
  const int lrow = tid >> 3, lkc = (tid & 7) * 8;
  const bf16* Ap = A + (size_t)(m0 + lrow) * lda + lkc;
  const bf16* Wp = W + (size_t)(n0 + lrow) * K + lkc;
  const int a32 = 32 * lda, w32 = 32 * K;
  bf16* Asw = sm + lrow * 72 + lkc;
  uint4 xa0, xa1, xa2, xa3, xb0, xb1, xb2, xb3, ya0, ya1, ya2, ya3, yb0, yb1, yb2, yb3;
  const int nk = K >> 6;
  GM_LOAD(x, 0)
  GM_LOAD(y, 64)
  __syncthreads();
  GM_STORE(x, 0)
  if (nk > 2) GM_LOAD(x, 128)
  __syncthreads();
  for (int k = 0; k < nk; k += 2) {
    GM_COMPUTE(0)
    GM_STORE(y, 1)
    if (k + 3 < nk) GM_LOAD(y, (k + 3) * 64)
    __syncthreads();
    GM_COMPUTE(1)
    if (k + 2 < nk) {
      GM_STORE(x, 0)
      if (k + 4 < nk) GM_LOAD(x, (k + 4) * 64)
    }
    __syncthreads();
  }
}
DEV void gemm256_mainloop(const bf16* __restrict__ A, int lda, const bf16* __restrict__ W, int K, int m0, int n0, bf16* sm,
                          f32x4 (&acc)[2][4][4]) {
  bf16* As = sm;
  bf16* Bs = sm + 256 * 72;
  const int tid = tidx(), lane = tid & 63, wave = tid >> 6;
  const int wr = wave >> 1, wc = wave & 1;
  const int lrow = tid >> 3, lkc = (tid & 7) * 8;
  const bf16* Ap = A + (size_t)(m0 + lrow) * lda + lkc;
  const bf16* Wp = W + (size_t)(n0 + lrow) * K + lkc;
  const int a32 = 32 * lda, w32 = 32 * K;
  uint4 ra0, ra1, ra2, ra3, ra4, ra5, ra6, ra7, rb0, rb1, rb2, rb3;
#define G256_LOAD(kk)                                                                                   \
  {                                                                                                     \
    const bf16* Ak = Ap + (kk);                                                                         \
    const bf16* Wk = Wp + (kk);                                                                         \
    ra0 = *(const uint4*)(Ak); ra1 = *(const uint4*)(Ak + a32); ra2 = *(const uint4*)(Ak + 2 * a32);    \
    ra3 = *(const uint4*)(Ak + 3 * a32); ra4 = *(const uint4*)(Ak + 4 * a32); ra5 = *(const uint4*)(Ak + 5 * a32); \
    ra6 = *(const uint4*)(Ak + 6 * a32); ra7 = *(const uint4*)(Ak + 7 * a32);                           \
    rb0 = *(const uint4*)(Wk); rb1 = *(const uint4*)(Wk + w32); rb2 = *(const uint4*)(Wk + 2 * w32);    \
    rb3 = *(const uint4*)(Wk + 3 * w32);                                                                \
  }
  G256_LOAD(0)
  bf16* Asw = As + lrow * 72 + lkc;
  bf16* Bsw = Bs + lrow * 72 + lkc;
  for (int k0 = 0; k0 < K; k0 += 64) {
    __syncthreads();
    *(uint4*)(Asw) = ra0; *(uint4*)(Asw + 32 * 72) = ra1; *(uint4*)(Asw + 64 * 72) = ra2; *(uint4*)(Asw + 96 * 72) = ra3;
    *(uint4*)(Asw + 128 * 72) = ra4; *(uint4*)(Asw + 160 * 72) = ra5; *(uint4*)(Asw + 192 * 72) = ra6; *(uint4*)(Asw + 224 * 72) = ra7;
    *(uint4*)(Bsw) = rb0; *(uint4*)(Bsw + 32 * 72) = rb1; *(uint4*)(Bsw + 64 * 72) = rb2; *(uint4*)(Bsw + 96 * 72) = rb3;
    __syncthreads();
    if (k0 + 64 < K) G256_LOAD(k0 + 64)
#pragma unroll
    for (int ks = 0; ks < 2; ++ks) {
      bf16x8 bfr[4];
#pragma unroll
      for (int ni = 0; ni < 4; ++ni)
        bfr[ni] = *(const bf16x8*)(Bs + (wc * 64 + ni * 16 + (lane & 15)) * 72 + ks * 32 + (lane >> 4) * 8);
#pragma unroll
      for (int h = 0; h < 2; ++h) {
        __builtin_amdgcn_sched_barrier(0);
        bf16x8 af[4];
#pragma unroll
        for (int mi = 0; mi < 4; ++mi)
          af[mi] = *(const bf16x8*)(As + (wr * 128 + h * 64 + mi * 16 + (lane & 15)) * 72 + ks * 32 + (lane >> 4) * 8);
#pragma unroll
        for (int mi = 0; mi < 4; ++mi)
#pragma unroll
          for (int ni = 0; ni < 4; ++ni)
            acc[h][mi][ni] = __builtin_amdgcn_mfma_f32_16x16x32_bf16(af[mi], bfr[ni], acc[h][mi][ni], 0, 0, 0);
      }
    }
  }
}
DEV void acc_zero(f32x4 (&acc)[4][4]) {
#pragma unroll
  for (int i = 0; i < 4; ++i)
#pragma unroll
    for (int j = 0; j < 4; ++j) acc[i][j] = f32x4{0.f, 0.f, 0.f, 0.f};
}
DEV void store_tile_bf16(bf16* sm, const f32x4 (&acc)[4][4], bf16* __restrict__ dbase, size_t dstride) {
  const int tid = tidx(), lane = tid & 63, wave = tid >> 6, g4 = lane >> 4, c16 = lane & 15;
  bf16* Cw = sm + wave * (64 * 72);
  __syncthreads();
#pragma unroll
  for (int mi = 0; mi < 4; ++mi)
#pragma unroll
    for (int ni = 0; ni < 4; ++ni)
#pragma unroll
      for (int r = 0; r < 4; ++r) Cw[(mi * 16 + g4 * 4 + r) * 72 + ni * 16 + c16] = f2bf(acc[mi][ni][r]);
  __syncthreads();
#pragma unroll
  for (int it = 0; it < 8; ++it) {
    const int row_l = it * 8 + (lane >> 3), ch = lane & 7;
    const uint4 v = *(const uint4*)(Cw + row_l * 72 + ch * 8);
    *(uint4*)(dbase + (size_t)row_l * dstride + ch * 8) = v;
  }
}
template <class Epi>
DEV void gemm_tile(const bf16* __restrict__ A, int lda, const bf16* __restrict__ W, int K, int m0, int n0, bf16* sm,
                   Epi epi) {
  f32x4 acc[4][4];
  acc_zero(acc);
  gemm_mainloop(A, lda, W, K, m0, n0, sm, acc);
  const int tid = tidx(), lane = tid & 63, wave = tid >> 6;
  const int wr = wave >> 1, wc = wave & 1;
#pragma unroll
  for (int mi = 0; mi < 4; ++mi)
#pragma unroll
    for (int ni = 0; ni < 4; ++ni)
#pragma unroll
      for (int r = 0; r < 4; ++r) {
        int row = m0 + wr * 64 + mi * 16 + (lane >> 4) * 4 + r;
        int col = n0 + wc * 64 + ni * 16 + (lane & 15);
        epi(row, col, acc[mi][ni][r]);
      }
}
DEV void inproj_epilogue(const Params& p, f32x4 (&acc)[4][4], int row0, int vc0, bf16* sm) {
  const int tid = tidx(), lane = tid & 63, g4 = lane >> 4, c16 = lane & 15;
  const int b = row0 / S, t0 = row0 % S;
  bf16* dbase;
  size_t dstride;
  bool roped = false;
  bf16* projp = (bf16*)(p.ws + OFF_PROJ) + (size_t)row0 * PC;
  if (vc0 < 768) { dbase = projp + vc0; dstride = PC; }
  else if (vc0 < 1280) {
    const int seg = (vc0 - 768) >> 7, head = ((vc0 - 768) >> 6) & 1;
    const size_t off = (seg == 0) ? OFF_KSB : (seg == 1) ? OFF_VSB : (seg == 2) ? OFF_KWB : OFF_VWB;
    dbase = (bf16*)(p.ws + off) + ((size_t)(b * 2 + head) * S + t0) * 64;
    dstride = 64;
    roped = (seg == 0) || (seg == 2);
  } else if (vc0 < 1792) { dbase = projp + C_MQ + (vc0 - 1280); dstride = PC; roped = true; }
  else if (vc0 < 2816) {
    const int seg = (vc0 - 1792) >> 9, head = ((vc0 - 1792) >> 6) & 7;
    dbase = (bf16*)(p.ws + (seg ? OFF_MVB : OFF_MKB)) + ((size_t)(b * 8 + head) * S + t0) * 64;
    dstride = 64;
    roped = (seg == 0);
  } else if (vc0 < 4864) { dbase = projp + C_GN + (vc0 - 2816); dstride = PC; }
  else { dbase = projp + C_NG + (vc0 - 4864); dstride = PC; }
  if (roped) {
    const float* rope = (const float*)(p.ws + OFF_ROPE);
#pragma unroll
    for (int mi = 0; mi < 4; ++mi)
#pragma unroll
      for (int r = 0; r < 4; ++r) {
        const int pos = t0 + mi * 16 + g4 * 4 + r;
        const float v = acc[mi][0][r];
        const float pv = shx(v, 8);
        const float cs = rope[pos * 16 + (c16 & 7)], sn = rope[pos * 16 + 8 + (c16 & 7)];
        acc[mi][0][r] = (c16 < 8) ? (v * cs - pv * sn) : (v * cs + pv * sn);
      }
  }
  store_tile_bf16(sm, acc, dbase, dstride);
}
DEV void inproj_tile256(const Params& p, int layer, int m0, int n0, bf16* sm) {
  f32x4 acc[2][4][4];
  acc_zero(acc[0]);
  acc_zero(acc[1]);
  gemm256_mainloop((const bf16*)(p.ws + OFF_H), 1024, (const bf16*)(p.ws + OFF_WINT) + (size_t)layer * WN * 1024, 1024, m0, n0, sm, acc);
  const int wave = tidx() >> 6, wr = wave >> 1, wc = wave & 1;
  inproj_epilogue(p, acc[0], m0 + wr * 128, n0 + wc * 64, sm);
  inproj_epilogue(p, acc[1], m0 + wr * 128 + 64, n0 + wc * 64, sm);
}
typedef unsigned u32x2_t __attribute__((ext_vector_type(2)));
DEV void merge_tile(const Params& p, int layer, int m0, int n0, bf16* sm) {
  const int tid = tidx(), lane = tid & 63, wave = tid >> 6, g4 = lane >> 4, c16 = lane & 15;
  const int wr = wave >> 1, wc = wave & 1;
  const bf16* projg = (const bf16*)(p.ws + OFF_PROJ) + (size_t)(m0 + wr * 64 + g4 * 4) * PC + n0 + wc * 64 + c16;
  f32x4 acc[4][4];
  acc_zero(acc);
  gemm_mainloop((const bf16*)(p.ws + OFF_ONSA), 512, (const bf16*)(p.ws + OFF_WUPN) + (size_t)layer * 1024 * 512, 512, m0, n0, sm, acc);
  bf16* yg = (bf16*)(p.ws + OFF_H) + (size_t)(m0 + wr * 64 + g4 * 4) * 1024 + n0 + wc * 64 + c16;
#pragma unroll
  for (int mi = 0; mi < 4; ++mi)
#pragma unroll
    for (int ni = 0; ni < 4; ++ni)
#pragma unroll
      for (int r = 0; r < 4; ++r)
        yg[(size_t)(mi * 16 + r) * 1024 + ni * 16] =
            f2bf(sigmoidf_(bf2f(projg[(size_t)(mi * 16 + r) * PC + C_GN + ni * 16])) * acc[mi][ni][r]);
  acc_zero(acc);
  gemm_mainloop((const bf16*)(p.ws + OFF_OMOBA), 512, (const bf16*)(p.ws + OFF_WUPM) + (size_t)layer * 1024 * 512, 512, m0, n0, sm, acc);
#pragma unroll
  for (int mi = 0; mi < 4; ++mi)
#pragma unroll
    for (int ni = 0; ni < 4; ++ni)
#pragma unroll
      for (int r = 0; r < 4; ++r)
        acc[mi][ni][r] = bf2f(yg[(size_t)(mi * 16 + r) * 1024 + ni * 16]) +
                         sigmoidf_(bf2f(projg[(size_t)(mi * 16 + r) * PC + C_GM + ni * 16])) * acc[mi][ni][r];
  store_tile_bf16(sm, acc, (bf16*)(p.ws + OFF_H) + (size_t)(m0 + wr * 64) * 1024 + n0 + wc * 64, 1024);
}

DEV void merge_tile256(const Params& p, int layer, int m0, int n0, bf16* sm) {
  const int tid = tidx(), lane = tid & 63, wave = tid >> 6, g4 = lane >> 4, c16 = lane & 15;
  const int wr = wave >> 1, wc = wave & 1;
  f32x4 acc[2][4][4];
  acc_zero(acc[0]);
  acc_zero(acc[1]);
  gemm256_mainloop((const bf16*)(p.ws + OFF_ONSA), 512, (const bf16*)(p.ws + OFF_WUPN) + (size_t)layer * 1024 * 512, 512, m0, n0, sm, acc);
#pragma unroll
  for (int h = 0; h < 2; ++h) {
    const size_t rb = (size_t)(m0 + wr * 128 + h * 64 + g4 * 4);
    const bf16* projg = (const bf16*)(p.ws + OFF_PROJ) + rb * PC + n0 + wc * 64 + c16;
    bf16* yg = (bf16*)(p.ws + OFF_H) + rb * 1024 + n0 + wc * 64 + c16;
#pragma unroll
    for (int mi = 0; mi < 4; ++mi)
#pragma unroll
      for (int ni = 0; ni < 4; ++ni)
#pragma unroll
        for (int r = 0; r < 4; ++r)
          yg[(size_t)(mi * 16 + r) * 1024 + ni * 16] =
              f2bf(sigmoidf_(bf2f(projg[(size_t)(mi * 16 + r) * PC + C_GN + ni * 16])) * acc[h][mi][ni][r]);
  }
  acc_zero(acc[0]);
  acc_zero(acc[1]);
  gemm256_mainloop((const bf16*)(p.ws + OFF_OMOBA), 512, (const bf16*)(p.ws + OFF_WUPM) + (size_t)layer * 1024 * 512, 512, m0, n0, sm, acc);
#pragma unroll
  for (int h = 0; h < 2; ++h) {
    const size_t rb = (size_t)(m0 + wr * 128 + h * 64 + g4 * 4);
    const bf16* projg = (const bf16*)(p.ws + OFF_PROJ) + rb * PC + n0 + wc * 64 + c16;
    const bf16* yg = (const bf16*)(p.ws + OFF_H) + rb * 1024 + n0 + wc * 64 + c16;
#pragma unroll
    for (int mi = 0; mi < 4; ++mi)
#pragma unroll
      for (int ni = 0; ni < 4; ++ni)
#pragma unroll
        for (int r = 0; r < 4; ++r)
          acc[h][mi][ni][r] = bf2f(yg[(size_t)(mi * 16 + r) * 1024 + ni * 16]) +
                              sigmoidf_(bf2f(projg[(size_t)(mi * 16 + r) * PC + C_GM + ni * 16])) * acc[h][mi][ni][r];
    store_tile_bf16(sm, acc[h], (bf16*)(p.ws + OFF_H) + (size_t)(m0 + wr * 128 + h * 64) * 1024 + n0 + wc * 64, 1024);
  }
}

DEV void compress_item(const Params& p, int layer, int item, float* sm) {
  const int tid = tidx();
  const int grp = item & 127, which = (item >> 7) & 1, kvh = (item >> 8) & 1, b = item >> 9;
  const int c0 = grp * 8;
  float* xs = sm;
  float* hs = sm + 144 * 64;
  const bf16* proj = (const bf16*)(p.ws + OFF_PROJ);
  const int col = (which ? C_VC : C_KC) + kvh * 64;
  for (int i = tid; i < 144 * 64; i += 256) {
    int tl = i >> 6, d = i & 63;
    int t = c0 * 16 + tl;
    xs[i] = (t < S) ? bf2f(proj[((size_t)b * S + t) * PC + col + d]) : 0.f;
  }
  __syncthreads();
  const int lw = layer * 2 + which;
  if (tid < 128) {
    const float* w1 = p.cmp_w1 + (size_t)lw * 2048 * 128 + tid;
    float acc[8];
#pragma unroll
    for (int ci = 0; ci < 8; ++ci) acc[ci] = 0.f;
    for (int l = 0; l < 32; ++l) {
#pragma unroll 4
      for (int d = 0; d < 64; ++d) {
        float w = w1[(size_t)(l * 64 + d) * 128];
#pragma unroll
        for (int ci = 0; ci < 8; ++ci) acc[ci] += xs[(ci * 16 + l) * 64 + d] * w;
      }
    }
    float pb = ((const float*)(p.ws + OFF_PEB))[lw * 128 + tid];
#pragma unroll
    for (int ci = 0; ci < 8; ++ci) hs[ci * 128 + tid] = gelu_tanh(acc[ci] + pb);
  }
  __syncthreads();
  const float* w2 = p.cmp_w2 + (size_t)lw * 128 * 64;
  float* outp = PROBE_CMPR ? ((float*)(p.ws + OFF_CMP) + (which ? (size_t)Bn * 1024 * 128 : 0)) : (float*)(p.ws + (which ? OFF_VCC : OFF_KCC));
#pragma unroll
  for (int rr = 0; rr < 2; ++rr) {
    int o = rr * 256 + tid;
    int ci = o >> 6, d = o & 63;
    int c = c0 + ci;
    float a = 0.f;
    for (int j = 0; j < 128; ++j) a += hs[ci * 128 + j] * w2[j * 64 + d];
    if (c < 1023) outp[(((size_t)b * 1024 + c) * 2 + kvh) * 64 + d] = a;
    bf16* outb = (bf16*)(p.ws + (which ? OFF_VCB : OFF_KCB));
    if (!PROBE_CMPR && c < 1024) outb[(((size_t)b * 2 + kvh) * 1024 + c) * 64 + d] = (c < 1023) ? f2bf(a) : (bf16)0;
  }
  __syncthreads();
}

DEV void compress_mfma_item(const Params& p, int layer, int item, char* smem) {
  bf16* xs = (bf16*)smem;
  float* hs = (float*)(smem + 272 * 64 * 2);
  const int tid = tidx(), lane = tid & 63, wave = tid >> 6, g4 = lane >> 4, c16 = lane & 15;
  const int cblk = item & 63, which = (item >> 6) & 1, kvh = (item >> 7) & 1, b = item >> 8;
  const int t0 = cblk * 256;
  const bf16* proj = (const bf16*)(p.ws + OFF_PROJ) + (size_t)b * S * PC + (which ? C_VC : C_KC) + kvh * 64;
  __syncthreads();
  for (int i = tid; i < 272 * 8; i += 256) {
    const int tl = i >> 3, ch = i & 7;
    const int t = t0 + tl;
    uint4 v = uint4{0u, 0u, 0u, 0u};
    if (t < S) v = *(const uint4*)(proj + (size_t)t * PC + ch * 8);
    *(uint4*)(xs + tl * 64 + ((ch ^ ((tl >> 4) & 7)) * 8)) = v;
  }
  __syncthreads();
  const int lw = layer * 2 + which;
  const bf16* w1t = (const bf16*)(p.ws + OFF_W1T) + (size_t)lw * 128 * 2048;
  f32x4 acc0 = f32x4{0.f, 0.f, 0.f, 0.f}, acc1 = f32x4{0.f, 0.f, 0.f, 0.f};
  const bf16* wb0 = w1t + (size_t)((2 * wave) * 16 + c16) * 2048 + g4 * 8;
  const bf16* wb1 = w1t + (size_t)((2 * wave + 1) * 16 + c16) * 2048 + g4 * 8;
#pragma unroll 4
  for (int ks = 0; ks < 64; ++ks) {
    const int l = ks >> 1, ch = (ks & 1) * 4 + g4;
    const int tl = 16 * c16 + l;
    const bf16x8 af = *(const bf16x8*)(xs + tl * 64 + ((ch ^ ((tl >> 4) & 7)) * 8));
    const bf16x8 b0 = *(const bf16x8*)(wb0 + ks * 32);
    const bf16x8 b1 = *(const bf16x8*)(wb1 + ks * 32);
    acc0 = MFMA16B(af, b0, acc0);
    acc1 = MFMA16B(af, b1, acc1);
  }
  {
    const float* peb = (const float*)(p.ws + OFF_PEB) + lw * 128;
    const int j0 = (2 * wave) * 16 + c16, j1 = j0 + 16;
    const float pb0 = peb[j0], pb1 = peb[j1];
#pragma unroll
    for (int r = 0; r < 4; ++r) {
      hs[(g4 * 4 + r) * 128 + j0] = gelu_tanh(acc0[r] + pb0);
      hs[(g4 * 4 + r) * 128 + j1] = gelu_tanh(acc1[r] + pb1);
    }
  }
  __syncthreads();
  const float* w2 = p.cmp_w2 + (size_t)lw * 128 * 64;
  const int d = tid & 63, cq = tid >> 6;
  float o0 = 0.f, o1 = 0.f, o2 = 0.f, o3 = 0.f;
#pragma unroll 8
  for (int j = 0; j < 128; ++j) {
    const float w = w2[j * 64 + d];
    o0 += hs[(cq * 4 + 0) * 128 + j] * w;
    o1 += hs[(cq * 4 + 1) * 128 + j] * w;
    o2 += hs[(cq * 4 + 2) * 128 + j] * w;
    o3 += hs[(cq * 4 + 3) * 128 + j] * w;
  }
  float* outp = (float*)(p.ws + (which ? OFF_VCC : OFF_KCC));
  bf16* outb = (bf16*)(p.ws + (which ? OFF_VCB : OFF_KCB));
  const float ov[4] = {o0, o1, o2, o3};
#pragma unroll
  for (int i = 0; i < 4; ++i) {
    const int c = cblk * 16 + cq * 4 + i;
    if (c < 1023) outp[(((size_t)b * 1024 + c) * 2 + kvh) * 64 + d] = ov[i];
    outb[(((size_t)b * 2 + kvh) * 1024 + c) * 64 + d] = (c < 1023) ? f2bf(ov[i]) : (bf16)0;
  }
  __syncthreads();
}

DEV void n1_item(const Params& p, int layer, int item, float* sm) {
  const int chunk = item & 255, kvh = (item >> 8) & 1, b = item >> 9;
  const int tid = tidx(), ql = tid >> 2, g = tid & 3;
  const int t = chunk * 64 + ql, h = kvh * 4 + g;
  const size_t tok = (size_t)b * S + t;
  const bf16* proj = (const bf16*)(p.ws + OFF_PROJ);
  float* imp = sm;
  for (int i = tid; i < 64 * 257; i += 256) imp[i] = 0.f;
  float q[64];
  load_q64(q, proj + tok * PC + C_NQ + h * 64, 0.125f);
  const int nv = (t >= 31) ? (((t - 31) >> 4) + 1) : 0;
  const int nv_max = (((chunk * 64 + 63) - 31) >> 4) + 1;
  const float* kc = (const float*)(p.ws + OFF_KCC) + (size_t)b * 1024 * 128 + kvh * 64;
  const float* vc = (const float*)(p.ws + OFF_VCC) + (size_t)b * 1024 * 128 + kvh * 64;
  float m = -INFINITY, l = 0.f;
  for (int c = 0; c < nv_max; ++c) {
    float s = dot64_f(q, kc + (size_t)c * 128);
    if (c < nv) {
      float mn = fmaxf(m, s);
      l = l * expf(m - mn) + expf(s - mn);
      m = mn;
    }
  }
  __syncthreads();
  float o[64];
#pragma unroll
  for (int d = 0; d < 64; ++d) o[d] = 0.f;
  const float inv_l = (nv > 0) ? 1.f / l : 0.f;
  for (int c = 0; c < nv_max; ++c) {
    float s = dot64_f(q, kc + (size_t)c * 128);
    float pr = (c < nv) ? expf(s - m) * inv_l : 0.f;
    axpy64_f(o, pr, vc + (size_t)c * 128);
    float ps = pr;
    ps += shx(ps, 1);
    ps += shx(ps, 2);
    if (g == 0) {
      int n = c >> 2;
      if ((c & 3) == 3) {
        imp[ql * 257 + n] += 0.5f * ps;
        imp[ql * 257 + n + 1] += 0.5f * ps;
      } else {
        imp[ql * 257 + n] += ps;
      }
    }
  }
  const float gate0 = (!PROBE_NSA || (PROBE_NSA & 1)) ? sigmoidf_(bf2f(proj[tok * PC + C_NG + h * 3 + 0])) : 0.f;
  float* oa = (float*)(p.ws + OFF_H) + tok * 512 + h * 64;
#pragma unroll
  for (int d = 0; d < 64; d += 4) {
    float4 v = {gate0 * o[d], gate0 * o[d + 1], gate0 * o[d + 2], gate0 * o[d + 3]};
    *(float4*)(oa + d) = v;
  }
  __syncthreads();
#if PROBE_NSA == 8
  if (b == 0 && kvh == 0)
    for (int i = tid; i < 64 * 256; i += 256)
      ((float*)(p.ws + OFF_OMOBA))[(size_t)(chunk * 64 + (i >> 8)) * 256 + (i & 255)] = imp[(i >> 8) * 257 + (i & 255)];
  __syncthreads();
#endif
  if (g == 0) {
    int* selp = (int*)(p.ws + OFF_SEL) + (((size_t)b * 2 + kvh) * S + t) * 16;
    const int cur = chunk;
    if (cur < 16) {
      for (int j = 0; j < 16; ++j) selp[j] = (j <= cur) ? j : -1;
    } else {
      selp[0] = 0;
      selp[1] = cur - 1;
      selp[2] = cur;
      float* row = imp + ql * 257;
      for (int j = 3; j < 16; ++j) {
        float best = -1.f;
        int bi = 1;
        for (int n = 1; n <= cur - 2; ++n) {
          float v = row[n];
          if (v > best) { best = v; bi = n; }
        }
        selp[j] = bi;
        row[bi] = -2.f;
      }
    }
  }
  __syncthreads();
}

DEV void kmean_item(const Params& p, int item, float* sm) {
  const int n = item & 63, h = (item >> 6) & 7, b = item >> 9;
  const int tid = tidx(), d = tid & 63, part = tid >> 6;
  const bf16* mkb = (const bf16*)(p.ws + OFF_MKB);
  float a = 0.f;
  for (int i = 0; i < 64; ++i) {
    int t = n * 256 + part * 64 + i;
    a += bf2f(mkb[((size_t)(b * 8 + h) * S + t) * 64 + d]);
  }
  sm[tid] = a;
  __syncthreads();
  if (tid < 64) {
    float s = sm[tid] + sm[64 + tid] + sm[128 + tid] + sm[192 + tid];
    const size_t ko = (((size_t)b * 8 + h) * 64 + n) * 64 + tid;
    const float mean = s * (1.f / 256.f);
    ((float*)(p.ws + OFF_KMEAN))[ko] = mean;
    const bf16 hi = f2bf(mean);
    ((bf16*)(p.ws + OFF_KMHL))[ko] = hi;
    ((bf16*)(p.ws + OFF_KMHL))[(size_t)2 * 8 * 64 * 64 + ko] = f2bf(mean - bf2f(hi));
    if (tid == 0) ((int*)(p.ws + OFF_MCNT))[((b * 8 + h) * 64 + n) * MCNT_STRIDE] = 0;
  }
  __syncthreads();
}

DEV void n23_item(const Params& p, int layer, int item) {
  const int chunk = item & 255, kvh = (item >> 8) & 1, b = item >> 9;
  const int tid = tidx(), ql = tid >> 2, g = tid & 3;
  const int t = chunk * 64 + ql, h = kvh * 4 + g;
  const size_t tok = (size_t)b * S + t;
  const bf16* proj = (const bf16*)(p.ws + OFF_PROJ);
  const float* rope = (const float*)(p.ws + OFF_ROPE) + (size_t)t * 16;
  float q[64];
  load_q64(q, proj + tok * PC + C_NQ + h * 64, 1.0f);
#pragma unroll
  for (int i = 0; i < 8; ++i) {
    float cs = rope[i], sn = rope[8 + i];
    float x1 = q[i], x2 = q[8 + i];
    q[i] = x1 * cs - x2 * sn;
    q[8 + i] = x2 * cs + x1 * sn;
  }
#pragma unroll
  for (int i = 0; i < 64; ++i) q[i] *= 0.125f;
  const size_t kvo = ((size_t)(b * 2 + kvh) * S) * 64;
  const bf16* ksb = (const bf16*)(p.ws + OFF_KSB) + kvo;
  const bf16* vsb = (const bf16*)(p.ws + OFF_VSB) + kvo;
  const bf16* kwb = (const bf16*)(p.ws + OFF_KWB) + kvo;
  const bf16* vwb = (const bf16*)(p.ws + OFF_VWB) + kvo;
  const int* selp = (const int*)(p.ws + OFF_SEL) + (((size_t)b * 2 + kvh) * S + t) * 16;
  float* oa = (float*)(p.ws + OFF_H) + tok * 512 + h * 64;
  const float gate1 = (!PROBE_NSA || (PROBE_NSA & 2)) ? sigmoidf_(bf2f(proj[tok * PC + C_NG + h * 3 + 1])) : 0.f;
  const float gate2 = (!PROBE_NSA || (PROBE_NSA & 4)) ? sigmoidf_(bf2f(proj[tok * PC + C_NG + h * 3 + 2])) : 0.f;
  float o[64];
  {
    float m = -INFINITY;
    for (int j = 0; j < 16; ++j) {
      int n = selp[j];
      if (n >= 0) {
        for (int i = 0; i < 64; ++i) {
          int kpos = n * 64 + i;
          if (kpos <= t) {
            float s = dot64_bf(q, ksb + (size_t)kpos * 64);
            m = fmaxf(m, s);
          }
        }
      }
    }
    float l = 0.f;
#pragma unroll
    for (int d = 0; d < 64; ++d) o[d] = 0.f;
    for (int j = 0; j < 16; ++j) {
      int n = selp[j];
      if (n >= 0) {
        for (int i = 0; i < 64; ++i) {
          int kpos = n * 64 + i;
          if (kpos <= t) {
            float s = dot64_bf(q, ksb + (size_t)kpos * 64);
            float pr = expf(s - m);
            l += pr;
            axpy64_bf(o, pr, vsb + (size_t)kpos * 64);
          }
        }
      }
    }
    float sc = gate1 / l;
#pragma unroll
    for (int d = 0; d < 64; d += 4) {
      float4 v = *(float4*)(oa + d);
      v.x += sc * o[d]; v.y += sc * o[d + 1]; v.z += sc * o[d + 2]; v.w += sc * o[d + 3];
      *(float4*)(oa + d) = v;
    }
  }
  {
    const int s0 = chunk * 64;
    const int jlo = (s0 - 511 > 0) ? (s0 - 511) : 0;
    const int jhi = s0 + 63;
    float m = -INFINITY;
    for (int j = jlo; j <= jhi; ++j) {
      float s = dot64_bf(q, kwb + (size_t)j * 64);
      if (j <= t && j > t - 512) m = fmaxf(m, s);
    }
    float l = 0.f;
#pragma unroll
    for (int d = 0; d < 64; ++d) o[d] = 0.f;
    for (int j = jlo; j <= jhi; ++j) {
      float s = dot64_bf(q, kwb + (size_t)j * 64);
      float pr = (j <= t && j > t - 512) ? expf(s - m) : 0.f;
      l += pr;
      axpy64_bf(o, pr, vwb + (size_t)j * 64);
    }
    float sc = gate2 / l;
    bf16* ob = (bf16*)(p.ws + (PROBE_NSA ? OFF_CMP : OFF_ONSA)) + tok * 512 + h * 64;
#pragma unroll
    for (int d = 0; d < 64; d += 8) {
      float4 v0 = *(float4*)(oa + d);
      float4 v1 = *(float4*)(oa + d + 4);
      uint4 pk;
      pk.x = (unsigned)f2bf(v0.x + sc * o[d]) | ((unsigned)f2bf(v0.y + sc * o[d + 1]) << 16);
      pk.y = (unsigned)f2bf(v0.z + sc * o[d + 2]) | ((unsigned)f2bf(v0.w + sc * o[d + 3]) << 16);
      pk.z = (unsigned)f2bf(v1.x + sc * o[d + 4]) | ((unsigned)f2bf(v1.y + sc * o[d + 5]) << 16);
      pk.w = (unsigned)f2bf(v1.z + sc * o[d + 6]) | ((unsigned)f2bf(v1.w + sc * o[d + 7]) << 16);
      *(uint4*)(ob + d) = pk;
    }
  }
}

DEV void moba_item(const Params& p, int layer, int item) {
  const int blk = item & 63, h = (item >> 6) & 7, b = item >> 9;
  const int tid = tidx();
  const int t = blk * 256 + tid;
  const size_t tok = (size_t)b * S + t;
  const bf16* proj = (const bf16*)(p.ws + OFF_PROJ);
  float q[64];
  load_q64(q, proj + tok * PC + C_MQ + h * 64, 0.125f);
  const float* km = (const float*)(p.ws + OFF_KMEAN) + ((size_t)b * 8 + h) * 64 * 64;
  float b0 = -INFINITY, b1 = -INFINITY, b2 = -INFINITY;
  int i0 = -1, i1 = -1, i2 = -1;
  for (int n = 0; n < blk; ++n) {
    float v = dot64_f(q, km + n * 64);
    if (v > b0) { b2 = b1; i2 = i1; b1 = b0; i1 = i0; b0 = v; i0 = n; }
    else if (v > b1) { b2 = b1; i2 = i1; b1 = v; i1 = n; }
    else if (v > b2) { b2 = v; i2 = n; }
  }
  const bf16* mkb = (const bf16*)(p.ws + OFF_MKB) + ((size_t)(b * 8 + h) * S) * 64;
  const bf16* mvb = (const bf16*)(p.ws + OFF_MVB) + ((size_t)(b * 8 + h) * S) * 64;
  float m = -INFINITY;
  for (int sidx = 0; sidx < 3; ++sidx) {
    int n = (sidx == 0) ? i0 : (sidx == 1) ? i1 : i2;
    if (sidx < blk) {
      for (int i = 0; i < 256; ++i) {
        float s = dot64_bf(q, mkb + (size_t)(n * 256 + i) * 64);
        m = fmaxf(m, s);
      }
    }
  }
  for (int i = 0; i < 256; ++i) {
    int kpos = blk * 256 + i;
    float s = dot64_bf(q, mkb + (size_t)kpos * 64);
    if (kpos <= t) m = fmaxf(m, s);
  }
  float l = 0.f;
  float o[64];
#pragma unroll
  for (int d = 0; d < 64; ++d) o[d] = 0.f;
  for (int sidx = 0; sidx < 3; ++sidx) {
    int n = (sidx == 0) ? i0 : (sidx == 1) ? i1 : i2;
    if (sidx < blk) {
      for (int i = 0; i < 256; ++i) {
        const size_t ko = (size_t)(n * 256 + i) * 64;
        float s = dot64_bf(q, mkb + ko);
        float pr = expf(s - m);
        l += pr;
        axpy64_bf(o, pr, mvb + ko);
      }
    }
  }
  for (int i = 0; i < 256; ++i) {
    int kpos = blk * 256 + i;
    const size_t ko = (size_t)kpos * 64;
    float s = dot64_bf(q, mkb + ko);
    float pr = (kpos <= t) ? expf(s - m) : 0.f;
    l += pr;
    axpy64_bf(o, pr, mvb + ko);
  }
  const float il = 1.f / l;
  bf16* ob = (bf16*)(p.ws + (PROBE_MOBA ? OFF_CMP : OFF_OMOBA)) + tok * 512 + h * 64;
#pragma unroll
  for (int d = 0; d < 64; d += 8) {
    uint4 pk;
    pk.x = (unsigned)f2bf(o[d] * il) | ((unsigned)f2bf(o[d + 1] * il) << 16);
    pk.y = (unsigned)f2bf(o[d + 2] * il) | ((unsigned)f2bf(o[d + 3] * il) << 16);
    pk.z = (unsigned)f2bf(o[d + 4] * il) | ((unsigned)f2bf(o[d + 5] * il) << 16);
    pk.w = (unsigned)f2bf(o[d + 6] * il) | ((unsigned)f2bf(o[d + 7] * il) << 16);
    *(uint4*)(ob + d) = pk;
  }
}

typedef short v4i16_t __attribute__((ext_vector_type(4)));
typedef unsigned u32x4_t __attribute__((ext_vector_type(4)));
DEV v4i16_t lds_tr16(const bf16* p) {
  return __builtin_amdgcn_ds_read_tr16_b64_v4i16((__attribute__((address_space(3))) v4i16_t*)p);
}
DEV unsigned cvtpk(float lo, float hi) {
  unsigned r;
  asm("v_cvt_pk_bf16_f32 %0, %1, %2" : "=v"(r) : "v"(lo), "v"(hi));
  return r;
}
#define MFMA16(a, b, c) __builtin_amdgcn_mfma_f32_16x16x32_bf16(a, b, c, 0, 0, 0)
constexpr float C2 = 0.125f * 1.4426950408889634f;
constexpr int KT_LD = 72;
constexpr int KT_ELEMS = 64 * KT_LD;

template <int NI>
struct AttnSt {
  f32x4 o[4][NI];
  float m[NI], l[NI];
};
template <int NI>
DEV void attn_init(AttnSt<NI>& st) {
#pragma unroll
  for (int ni = 0; ni < NI; ++ni) {
    st.m[ni] = -INFINITY;
    st.l[ni] = 0.f;
#pragma unroll
    for (int di = 0; di < 4; ++di) st.o[di][ni] = f32x4{0.f, 0.f, 0.f, 0.f};
  }
}
#define TILE_DECL uint4 tl_k0, tl_k1, tl_v0, tl_v1
#define TILE_GLOAD(kb, vb, ld, key0)                                                        \
  do {                                                                                      \
    const int r_ = tidx() >> 3, c_ = (tidx() & 7) * 8;                            \
    tl_k0 = *(const uint4*)((kb) + (size_t)((key0) + r_) * (ld) + c_);                      \
    tl_k1 = *(const uint4*)((kb) + (size_t)((key0) + 32 + r_) * (ld) + c_);                 \
    tl_v0 = *(const uint4*)((vb) + (size_t)((key0) + r_) * (ld) + c_);                      \
    tl_v1 = *(const uint4*)((vb) + (size_t)((key0) + 32 + r_) * (ld) + c_);                 \
  } while (0)
#define TILE_SSTORE(Ks_, Vs_)                                                               \
  do {                                                                                      \
    const int r_ = tidx() >> 3, c_ = (tidx() & 7) * 8;                            \
    *(uint4*)((Ks_) + r_ * KT_LD + c_) = tl_k0;                                             \
    *(uint4*)((Ks_) + (32 + r_) * KT_LD + c_) = tl_k1;                                      \
    *(uint4*)((Vs_) + r_ * KT_LD + c_) = tl_v0;                                             \
    *(uint4*)((Vs_) + (32 + r_) * KT_LD + c_) = tl_v1;                                      \
  } while (0)
#define TL_GLOAD(P, kb, vb, ld, key0)                                                       \
  do {                                                                                      \
    const int r_ = tidx() >> 3, c_ = (tidx() & 7) * 8;                                      \
    P##_k0 = *(const uint4*)((kb) + (size_t)((key0) + r_) * (ld) + c_);                     \
    P##_k1 = *(const uint4*)((kb) + (size_t)((key0) + 32 + r_) * (ld) + c_);                \
    P##_v0 = *(const uint4*)((vb) + (size_t)((key0) + r_) * (ld) + c_);                     \
    P##_v1 = *(const uint4*)((vb) + (size_t)((key0) + 32 + r_) * (ld) + c_);                \
  } while (0)
#define TL_SSTORE(P, Ks_, Vs_)                                                              \
  do {                                                                                      \
    const int r_ = tidx() >> 3, c_ = (tidx() & 7) * 8;                                      \
    *(uint4*)((Ks_) + r_ * KT_LD + c_) = P##_k0;                                            \
    *(uint4*)((Ks_) + (32 + r_) * KT_LD + c_) = P##_k1;                                     \
    *(uint4*)((Vs_) + r_ * KT_LD + c_) = P##_v0;                                            \
    *(uint4*)((Vs_) + (32 + r_) * KT_LD + c_) = P##_v1;                                     \
  } while (0)
#define KV_SWEEP(kb_, vb_, ld_, nt_, KEYF, ...)                                             \
  {                                                                                         \
    uint4 tA_k0, tA_k1, tA_v0, tA_v1, tB_k0, tB_k1, tB_v0, tB_v1;                           \
    const int nt__ = (nt_);                                                                 \
    if (nt__ > 0) {                                                                         \
      TL_GLOAD(tA, kb_, vb_, ld_, KEYF(0));                                                 \
      TL_SSTORE(tA, smkv, smkv + KT_ELEMS);                                                 \
      if (nt__ > 1) TL_GLOAD(tA, kb_, vb_, ld_, KEYF(1));                                   \
    }                                                                                       \
    __syncthreads();                                                                        \
    for (int it0__ = 0; it0__ < nt__; it0__ += 2) {                                         \
      {                                                                                     \
        const int it = it0__;                                                               \
        if (it + 2 < nt__) TL_GLOAD(tB, kb_, vb_, ld_, KEYF(it + 2));                       \
        const bf16* Ks = smkv;                                                              \
        __VA_ARGS__                                                                         \
        if (it + 1 < nt__) TL_SSTORE(tA, smkv + 2 * KT_ELEMS, smkv + 3 * KT_ELEMS);         \
        __syncthreads();                                                                    \
      }                                                                                     \
      if (it0__ + 1 < nt__) {                                                               \
        const int it = it0__ + 1;                                                           \
        if (it + 2 < nt__) TL_GLOAD(tA, kb_, vb_, ld_, KEYF(it + 2));                       \
        const bf16* Ks = smkv + 2 * KT_ELEMS;                                               \
        __VA_ARGS__                                                                         \
        if (it + 1 < nt__) TL_SSTORE(tB, smkv, smkv + KT_ELEMS);                            \
        __syncthreads();                                                                    \
      }                                                                                     \
    }                                                                                       \
  }
template <int NI>
DEV void attn_scores(const bf16* Ks, const bf16x8 (&qf)[NI][2], f32x4 (&s)[4][NI]) {
  const int lane = tidx() & 63, g4 = lane >> 4, c16 = lane & 15;
#pragma unroll
  for (int mi = 0; mi < 4; ++mi) {
#pragma unroll
    for (int ni = 0; ni < NI; ++ni) s[mi][ni] = f32x4{0.f, 0.f, 0.f, 0.f};
#pragma unroll
    for (int ks = 0; ks < 2; ++ks) {
      bf16x8 kf = *(const bf16x8*)(Ks + (mi * 16 + c16) * KT_LD + ks * 32 + g4 * 8);
#pragma unroll
      for (int ni = 0; ni < NI; ++ni) s[mi][ni] = MFMA16(kf, qf[ni][ks], s[mi][ni]);
    }
  }
}
template <int NI>
DEV void attn_pv(const bf16* Vs, const bf16x8 (&pf)[NI][2], f32x4 (&o)[4][NI]) {
  const int lane = tidx() & 63, g4 = lane >> 4, q4 = (lane & 15) >> 2, p4 = lane & 3;
#pragma unroll
  for (int di = 0; di < 4; ++di) {
#pragma unroll
    for (int ks2 = 0; ks2 < 2; ++ks2) {
      v4i16_t v0 = lds_tr16(Vs + (ks2 * 32 + g4 * 4 + q4) * KT_LD + di * 16 + p4 * 4);
      v4i16_t v1 = lds_tr16(Vs + (ks2 * 32 + 16 + g4 * 4 + q4) * KT_LD + di * 16 + p4 * 4);
      bf16x8 vf = __builtin_shufflevector(v0, v1, 0, 1, 2, 3, 4, 5, 6, 7);
#pragma unroll
      for (int ni = 0; ni < NI; ++ni) o[di][ni] = MFMA16(vf, pf[ni][ks2], o[di][ni]);
    }
  }
}
DEV void exp4_pack(const f32x4& sv, float nm, float& ps, unsigned& w0, unsigned& w1) {
  float p0 = __builtin_amdgcn_exp2f(__builtin_fmaf(sv[0], C2, nm));
  float p1 = __builtin_amdgcn_exp2f(__builtin_fmaf(sv[1], C2, nm));
  float p2 = __builtin_amdgcn_exp2f(__builtin_fmaf(sv[2], C2, nm));
  float p3 = __builtin_amdgcn_exp2f(__builtin_fmaf(sv[3], C2, nm));
  ps += (p0 + p1) + (p2 + p3);
  w0 = cvtpk(p0, p1);
  w1 = cvtpk(p2, p3);
}
template <int NI>
DEV void attn_softmax_pv(const bf16* Vs, f32x4 (&s)[4][NI], AttnSt<NI>& st) {
  bf16x8 pf[NI][2];
#pragma unroll
  for (int ni = 0; ni < NI; ++ni) {
    float mx = -INFINITY;
#pragma unroll
    for (int mi = 0; mi < 4; ++mi)
      mx = fmaxf(fmaxf(mx, fmaxf(s[mi][ni][0], s[mi][ni][1])), fmaxf(s[mi][ni][2], s[mi][ni][3]));
    mx = fmaxf(mx, shx(mx, 16));
    mx = fmaxf(mx, shx(mx, 32));
    const float mn = fmaxf(st.m[ni], mx);
    const float mu = (mn == -INFINITY) ? 0.f : mn;
    const float corr = __builtin_amdgcn_exp2f((st.m[ni] - mu) * C2);
    st.m[ni] = mn;
    const float nm = -mu * C2;
    float ps = 0.f;
    u32x4_t wa, wb;
    unsigned t0, t1;
    exp4_pack(s[0][ni], nm, ps, t0, t1); wa.x = t0; wa.y = t1;
    exp4_pack(s[1][ni], nm, ps, t0, t1); wa.z = t0; wa.w = t1;
    exp4_pack(s[2][ni], nm, ps, t0, t1); wb.x = t0; wb.y = t1;
    exp4_pack(s[3][ni], nm, ps, t0, t1); wb.z = t0; wb.w = t1;
    st.l[ni] = st.l[ni] * corr + ps;
#pragma unroll
    for (int di = 0; di < 4; ++di) {
      st.o[di][ni][0] *= corr; st.o[di][ni][1] *= corr; st.o[di][ni][2] *= corr; st.o[di][ni][3] *= corr;
    }
    pf[ni][0] = __builtin_bit_cast(bf16x8, wa);
    pf[ni][1] = __builtin_bit_cast(bf16x8, wb);
  }
  attn_pv<NI>(Vs, pf, st.o);
}

template <int NI>
DEV void attn_softmax_pv_act(const bf16* Vs, f32x4 (&s)[4][NI], AttnSt<NI>& st, const bool (&act)[NI]) {
  bf16x8 pf[NI][2];
#pragma unroll
  for (int ni = 0; ni < NI; ++ni) {
    pf[ni][0] = bf16x8{0, 0, 0, 0, 0, 0, 0, 0};
    pf[ni][1] = bf16x8{0, 0, 0, 0, 0, 0, 0, 0};
    if (act[ni]) {
      float mx = -INFINITY;
#pragma unroll
      for (int mi = 0; mi < 4; ++mi)
        mx = fmaxf(fmaxf(mx, fmaxf(s[mi][ni][0], s[mi][ni][1])), fmaxf(s[mi][ni][2], s[mi][ni][3]));
      mx = fmaxf(mx, shx(mx, 16));
      mx = fmaxf(mx, shx(mx, 32));
      const float mn = fmaxf(st.m[ni], mx);
      const float mu = (mn == -INFINITY) ? 0.f : mn;
      const float corr = __builtin_amdgcn_exp2f((st.m[ni] - mu) * C2);
      st.m[ni] = mn;
      const float nm = -mu * C2;
      float ps = 0.f;
      u32x4_t wa, wb;
      unsigned t0, t1;
      exp4_pack(s[0][ni], nm, ps, t0, t1); wa.x = t0; wa.y = t1;
      exp4_pack(s[1][ni], nm, ps, t0, t1); wa.z = t0; wa.w = t1;
      exp4_pack(s[2][ni], nm, ps, t0, t1); wb.x = t0; wb.y = t1;
      exp4_pack(s[3][ni], nm, ps, t0, t1); wb.z = t0; wb.w = t1;
      st.l[ni] = st.l[ni] * corr + ps;
#pragma unroll
      for (int di = 0; di < 4; ++di) {
        st.o[di][ni][0] *= corr; st.o[di][ni][1] *= corr; st.o[di][ni][2] *= corr; st.o[di][ni][3] *= corr;
      }
      pf[ni][0] = __builtin_bit_cast(bf16x8, wa);
      pf[ni][1] = __builtin_bit_cast(bf16x8, wb);
    }
  }
  const int lane = tidx() & 63, g4 = lane >> 4, q4 = (lane & 15) >> 2, p4 = lane & 3;
#pragma unroll
  for (int di = 0; di < 4; ++di) {
#pragma unroll
    for (int ks2 = 0; ks2 < 2; ++ks2) {
      v4i16_t v0 = lds_tr16(Vs + (ks2 * 32 + g4 * 4 + q4) * KT_LD + di * 16 + p4 * 4);
      v4i16_t v1 = lds_tr16(Vs + (ks2 * 32 + 16 + g4 * 4 + q4) * KT_LD + di * 16 + p4 * 4);
      bf16x8 vf = __builtin_shufflevector(v0, v1, 0, 1, 2, 3, 4, 5, 6, 7);
#pragma unroll
      for (int ni = 0; ni < NI; ++ni)
        if (act[ni]) st.o[di][ni] = MFMA16(vf, pf[ni][ks2], st.o[di][ni]);
    }
  }
}
template <int NI>
DEV int gate_top1(f32x4 (&gs)[4][NI], int ni, int g4) {
  float bv = -INFINITY;
  int bi = 1 << 20;
#pragma unroll
  for (int mi = 0; mi < 4; ++mi)
#pragma unroll
    for (int r = 0; r < 4; ++r) {
      float v = gs[mi][ni][r];
      if (v > bv) { bv = v; bi = mi * 16 + g4 * 4 + r; }
    }
#pragma unroll
  for (int off = 16; off <= 32; off <<= 1) {
    float ov = shx(bv, off);
    int oi = shx(bi, off);
    if (ov > bv || (ov == bv && oi < bi)) { bv = ov; bi = oi; }
  }
#pragma unroll
  for (int mi = 0; mi < 4; ++mi)
#pragma unroll
    for (int r = 0; r < 4; ++r)
      if (mi * 16 + g4 * 4 + r == bi) gs[mi][ni][r] = -INFINITY;
  return (bv == -INFINITY) ? -1 : bi;
}
template <int NI>
DEV void moba_mfma_item(const Params& p, int item, char* smem, bf16* outbuf) {
  constexpr int QB = 64 * NI;
  bf16* sm = (bf16*)smem;
  const int bh = item & 15, cq = (S / QB - 1) - (item >> 4);
  const int b = bh >> 3, h = bh & 7;
  const int s0 = cq * QB, blk = s0 >> 8;
  const int lane = tidx() & 63, wave = tidx() >> 6, g4 = lane >> 4, c16 = lane & 15;
  const bf16* proj = (const bf16*)(p.ws + OFF_PROJ) + (size_t)b * S * PC;
  bf16x8 qf[NI][2];
  int tq[NI];
#pragma unroll
  for (int ni = 0; ni < NI; ++ni) {
    tq[ni] = s0 + wave * 16 * NI + ni * 16 + c16;
#pragma unroll
    for (int ks = 0; ks < 2; ++ks)
      qf[ni][ks] = *(const bf16x8*)(proj + (size_t)tq[ni] * PC + C_MQ + h * 64 + ks * 32 + g4 * 8);
  }
  int i0[NI], i1[NI], i2[NI];
  {
    const bf16* kmh = (const bf16*)(p.ws + OFF_KMHL) + ((size_t)(b * 8 + h) * 64) * 64;
    const bf16* kml = kmh + (size_t)2 * 8 * 64 * 64;
    f32x4 gs[4][NI];
#pragma unroll
    for (int mi = 0; mi < 4; ++mi) {
#pragma unroll
      for (int ni = 0; ni < NI; ++ni) gs[mi][ni] = f32x4{0.f, 0.f, 0.f, 0.f};
#pragma unroll
      for (int ks = 0; ks < 2; ++ks) {
        bf16x8 ah = *(const bf16x8*)(kmh + (mi * 16 + c16) * 64 + ks * 32 + g4 * 8);
        bf16x8 al_ = *(const bf16x8*)(kml + (mi * 16 + c16) * 64 + ks * 32 + g4 * 8);
#pragma unroll
        for (int ni = 0; ni < NI; ++ni) {
          gs[mi][ni] = MFMA16(ah, qf[ni][ks], gs[mi][ni]);
          gs[mi][ni] = MFMA16(al_, qf[ni][ks], gs[mi][ni]);
        }
      }
    }
#pragma unroll
    for (int ni = 0; ni < NI; ++ni) {
#pragma unroll
      for (int mi = 0; mi < 4; ++mi)
#pragma unroll
        for (int r = 0; r < 4; ++r)
          if (mi * 16 + g4 * 4 + r >= blk) gs[mi][ni][r] = -INFINITY;
      i0[ni] = gate_top1(gs, ni, g4);
      i1[ni] = gate_top1(gs, ni, g4);
      i2[ni] = gate_top1(gs, ni, g4);
    }
  }
  AttnSt<NI> st;
  attn_init<NI>(st);
  const int ntiles = (s0 + QB) >> 6;
  const bf16* kb = (const bf16*)(p.ws + OFF_MKB) + ((size_t)(b * 8 + h) * S) * 64;
  const bf16* vb = (const bf16*)(p.ws + OFF_MVB) + ((size_t)(b * 8 + h) * S) * 64;
  bf16* smkv = sm;
  __syncthreads();
#define MOBA_KEY(i) ((i) * 64)
  KV_SWEEP(kb, vb, 64, ntiles, MOBA_KEY,
    const int n = it >> 2;
    const bool own = (n == blk);
    const int kbase = it * 64;
    bool wave_active = own;
    if (!own) {
      bool anyq = false;
      _Pragma("unroll") for (int ni = 0; ni < NI; ++ni) anyq = anyq || (n == i0[ni]) || (n == i1[ni]) || (n == i2[ni]);
      wave_active = __builtin_amdgcn_ballot_w64(anyq) != 0ull;
    }
    if (wave_active) {
      f32x4 s[4][NI];
      attn_scores<NI>(Ks, qf, s);
      _Pragma("unroll") for (int ni = 0; ni < NI; ++ni) {
        if (own) {
          _Pragma("unroll") for (int mi = 0; mi < 4; ++mi)
            _Pragma("unroll") for (int r = 0; r < 4; ++r)
              if (kbase + mi * 16 + g4 * 4 + r > tq[ni]) s[mi][ni][r] = -INFINITY;
        } else {
          const bool okb = (n == i0[ni]) | (n == i1[ni]) | (n == i2[ni]);
          if (!okb) {
            _Pragma("unroll") for (int mi = 0; mi < 4; ++mi) s[mi][ni] = f32x4{-INFINITY, -INFINITY, -INFINITY, -INFINITY};
          }
        }
      }
      attn_softmax_pv<NI>(Ks + KT_ELEMS, s, st);
    }
  )
#pragma unroll
  for (int ni = 0; ni < NI; ++ni) {
    float l = st.l[ni];
    l += shx(l, 16);
    l += shx(l, 32);
    const float inv = 1.f / l;
    bf16* op = outbuf + ((size_t)b * S + tq[ni]) * 512 + h * 64 + g4 * 4;
#pragma unroll
    for (int di = 0; di < 4; ++di) {
      uint2 pk;
      pk.x = cvtpk(st.o[di][ni][0] * inv, st.o[di][ni][1] * inv);
      pk.y = cvtpk(st.o[di][ni][2] * inv, st.o[di][ni][3] * inv);
      *(uint2*)(op + di * 16) = pk;
    }
  }
}

DEV int moba_list_base(int n) { return n * S - 128 * n * (n + 1); }
template <int NI>
DEV void moba_gate_batch(const Params& p, int item0, int istride, int nitems, int* sm) {
  constexpr int QB = 64 * NI;
  constexpr int MAXB = 4;
  const int tid = tidx(), lane = tid & 63, wave = tid >> 6, g4 = lane >> 4, c16 = lane & 15;
  int* hist = sm;
  int* base = sm + MAXB * 64;
  hist[tid] = 0;
  __syncthreads();
  int sel[MAXB][NI][3], rk[MAXB][NI][3], tqs[MAXB][NI];
#pragma unroll
  for (int j = 0; j < MAXB; ++j) {
    const int item = item0 + j * istride;
    const int bh = item & 15, cq = item >> 4;
    const int b = bh >> 3, h = bh & 7;
    const int s0 = cq * QB, blk = s0 >> 8;
    const bool live = (j < nitems) && (blk > 0);
#pragma unroll
    for (int ni = 0; ni < NI; ++ni) {
      tqs[j][ni] = s0 + wave * 16 * NI + ni * 16 + c16;
#pragma unroll
      for (int k = 0; k < 3; ++k) { sel[j][ni][k] = -1; rk[j][ni][k] = 0; }
    }
    if (!live) continue;
    const bf16* proj = (const bf16*)(p.ws + OFF_PROJ) + (size_t)b * S * PC;
    bf16x8 qf[NI][2];
#pragma unroll
    for (int ni = 0; ni < NI; ++ni)
#pragma unroll
      for (int ks = 0; ks < 2; ++ks)
        qf[ni][ks] = *(const bf16x8*)(proj + (size_t)tqs[j][ni] * PC + C_MQ + h * 64 + ks * 32 + g4 * 8);
    const bf16* kmh = (const bf16*)(p.ws + OFF_KMHL) + ((size_t)(b * 8 + h) * 64) * 64;
    const bf16* kml = kmh + (size_t)2 * 8 * 64 * 64;
    f32x4 gs[4][NI];
#pragma unroll
    for (int mi = 0; mi < 4; ++mi) {
#pragma unroll
      for (int ni = 0; ni < NI; ++ni) gs[mi][ni] = f32x4{0.f, 0.f, 0.f, 0.f};
#pragma unroll
      for (int ks = 0; ks < 2; ++ks) {
        bf16x8 ah = *(const bf16x8*)(kmh + (mi * 16 + c16) * 64 + ks * 32 + g4 * 8);
        bf16x8 al_ = *(const bf16x8*)(kml + (mi * 16 + c16) * 64 + ks * 32 + g4 * 8);
#pragma unroll
        for (int ni = 0; ni < NI; ++ni) {
          gs[mi][ni] = MFMA16(ah, qf[ni][ks], gs[mi][ni]);
          gs[mi][ni] = MFMA16(al_, qf[ni][ks], gs[mi][ni]);
        }
      }
    }
#pragma unroll
    for (int ni = 0; ni < NI; ++ni) {
#pragma unroll
      for (int mi = 0; mi < 4; ++mi)
#pragma unroll
        for (int r = 0; r < 4; ++r)
          if (mi * 16 + g4 * 4 + r >= blk) gs[mi][ni][r] = -INFINITY;
#pragma unroll
      for (int k = 0; k < 3; ++k) {
        sel[j][ni][k] = gate_top1(gs, ni, g4);
        rk[j][ni][k] = (g4 == 0 && sel[j][ni][k] >= 0) ? atomicAdd(&hist[j * 64 + sel[j][ni][k]], 1) : 0;
      }
    }
  }
  __syncthreads();
  {
    const int j = tid >> 6, n = tid & 63;
    const int item = item0 + j * istride;
    const int c = hist[tid];
    int* cnt = (int*)(p.ws + OFF_MCNT) + (size_t)(item & 15) * 64 * MCNT_STRIDE;
    base[tid] = (c > 0) ? atomicAdd(cnt + n * MCNT_STRIDE, c) : 0;
  }
  __syncthreads();
  if (g4 == 0) {
#pragma unroll
    for (int j = 0; j < MAXB; ++j) {
      const int item = item0 + j * istride;
      unsigned short* lists = (unsigned short*)(p.ws + OFF_MLIST) + (size_t)(item & 15) * MLIST_PER_BH;
#pragma unroll
      for (int ni = 0; ni < NI; ++ni)
#pragma unroll
        for (int k = 0; k < 3; ++k) {
          const int sv = sel[j][ni][k];
          if (sv >= 0) lists[moba_list_base(sv) + base[j * 64 + sv] + rk[j][ni][k]] = (unsigned short)(tqs[j][ni] | (k << 14));
        }
    }
  }
  __syncthreads();
}
template <int NI>
DEV void moba_part_item(const Params& p, int b, int item, char* smem) {
  constexpr int CH = 64 * NI;
  bf16* smkv = (bf16*)smem;
  const int n = item >> 6, h = (item >> 3) & 7, part = item & 7;
  const int lane = tidx() & 63, wave = tidx() >> 6, g4 = lane >> 4, c16 = lane & 15;
  const int cnt = ((const int*)(p.ws + OFF_MCNT))[((b * 8 + h) * 64 + n) * MCNT_STRIDE];
  const unsigned short* list = (const unsigned short*)(p.ws + OFF_MLIST) + (size_t)(b * 8 + h) * MLIST_PER_BH + moba_list_base(n);
  const bf16* proj = (const bf16*)(p.ws + OFF_PROJ) + (size_t)b * S * PC;
  const bf16* kb = (const bf16*)(p.ws + OFF_MKB) + ((size_t)(b * 8 + h) * S + n * 256) * 64;
  const bf16* vb = (const bf16*)(p.ws + OFF_MVB) + ((size_t)(b * 8 + h) * S + n * 256) * 64;
  bf16* po = (bf16*)(p.ws + OFF_MPO);
  float2* pml = (float2*)(p.ws + OFF_MPML);
  for (int c = part; c * CH < cnt; c += 8) {
    bf16x8 qf[NI][2];
    int tcol[NI], slot[NI];
    bool valid[NI];
#pragma unroll
    for (int ni = 0; ni < NI; ++ni) {
      const int idx = c * CH + wave * 16 * NI + ni * 16 + c16;
      valid[ni] = idx < cnt;
      const unsigned e = list[valid[ni] ? idx : 0];
      tcol[ni] = e & 0x3FFF;
      slot[ni] = e >> 14;
#pragma unroll
      for (int ks = 0; ks < 2; ++ks)
        qf[ni][ks] = *(const bf16x8*)(proj + (size_t)tcol[ni] * PC + C_MQ + h * 64 + ks * 32 + g4 * 8);
    }
    AttnSt<NI> st;
    attn_init<NI>(st);
    __syncthreads();
#define MOBA_PKEY(i) ((i) * 64)
    KV_SWEEP(kb, vb, 64, 4, MOBA_PKEY,
      f32x4 s[4][NI];
      attn_scores<NI>(Ks, qf, s);
      attn_softmax_pv<NI>(Ks + KT_ELEMS, s, st);
    )
#pragma unroll
    for (int ni = 0; ni < NI; ++ni) {
      float l = st.l[ni];
      l += shx(l, 16);
      l += shx(l, 32);
      if (valid[ni]) {
        const size_t rec = ((size_t)h * S + tcol[ni]) * 3 + slot[ni];
        if (g4 == 0) pml[rec] = float2{st.m[ni], l};
        bf16* op = po + rec * 64 + g4 * 4;
#pragma unroll
        for (int di = 0; di < 4; ++di) {
          uint2 pk;
          pk.x = cvtpk(st.o[di][ni][0], st.o[di][ni][1]);
          pk.y = cvtpk(st.o[di][ni][2], st.o[di][ni][3]);
          *(uint2*)(op + di * 16) = pk;
        }
      }
    }
  }
}
template <int NI>
DEV void moba_part_item2(const Params& p, int b, int item, char* smem) {
  constexpr int WCH = 16 * NI;
  bf16* Kall = (bf16*)smem;
  bf16* Vall = Kall + 256 * KT_LD;
  static_assert(2 * 256 * KT_LD * 2 <= SMEM_BYTES, "moba block staging");
  const int n = item >> 6, h = (item >> 3) & 7, part = item & 7;
  const int tid = tidx(), lane = tid & 63, wave = tid >> 6, g4 = lane >> 4, c16 = lane & 15;
  const int cnt = ((const int*)(p.ws + OFF_MCNT))[((b * 8 + h) * 64 + n) * MCNT_STRIDE];
  const bool active = part * 4 * WCH < cnt;
  const unsigned short* list = (const unsigned short*)(p.ws + OFF_MLIST) + (size_t)(b * 8 + h) * MLIST_PER_BH + moba_list_base(n);
  const bf16* proj = (const bf16*)(p.ws + OFF_PROJ) + (size_t)b * S * PC;
  const bf16* kb = (const bf16*)(p.ws + OFF_MKB) + ((size_t)(b * 8 + h) * S + n * 256) * 64;
  const bf16* vb = (const bf16*)(p.ws + OFF_MVB) + ((size_t)(b * 8 + h) * S + n * 256) * 64;
  bf16* po = (bf16*)(p.ws + OFF_MPO);
  float2* pml = (float2*)(p.ws + OFF_MPML);
  __syncthreads();
  if (active) {
#pragma unroll
    for (int i = 0; i < 8; ++i) {
      const int id = tid + 256 * i, r = id >> 3, c = (id & 7) * 8;
      const uint4 kv = *(const uint4*)(kb + (size_t)r * 64 + c);
      const uint4 vv = *(const uint4*)(vb + (size_t)r * 64 + c);
      *(uint4*)(Kall + r * KT_LD + c) = kv;
      *(uint4*)(Vall + r * KT_LD + c) = vv;
    }
  }
  __syncthreads();
  if (!active) return;
  for (int wc = part * 4 + wave; wc * WCH < cnt; wc += 32) {
    bf16x8 qf[NI][2];
    int tcol[NI], slot[NI];
    bool valid[NI];
#pragma unroll
    for (int ni = 0; ni < NI; ++ni) {
      const int idx = wc * WCH + ni * 16 + c16;
      valid[ni] = idx < cnt;
      const unsigned e = list[valid[ni] ? idx : 0];
      tcol[ni] = e & 0x3FFF;
      slot[ni] = e >> 14;
#pragma unroll
      for (int ks = 0; ks < 2; ++ks)
        qf[ni][ks] = *(const bf16x8*)(proj + (size_t)tcol[ni] * PC + C_MQ + h * 64 + ks * 32 + g4 * 8);
    }
    AttnSt<NI> st;
    attn_init<NI>(st);
#pragma unroll 1
    for (int kt = 0; kt < 4; ++kt) {
      f32x4 s[4][NI];
      attn_scores<NI>(Kall + kt * 64 * KT_LD, qf, s);
      attn_softmax_pv<NI>(Vall + kt * 64 * KT_LD, s, st);
    }
#pragma unroll
    for (int ni = 0; ni < NI; ++ni) {
      float l = st.l[ni];
      l += shx(l, 16);
      l += shx(l, 32);
      if (valid[ni]) {
        const size_t rec = ((size_t)h * S + tcol[ni]) * 3 + slot[ni];
        if (g4 == 0) pml[rec] = float2{st.m[ni], l};
        bf16* op = po + rec * 64 + g4 * 4;
#pragma unroll
        for (int di = 0; di < 4; ++di) {
          uint2 pk;
          pk.x = cvtpk(st.o[di][ni][0], st.o[di][ni][1]);
          pk.y = cvtpk(st.o[di][ni][2], st.o[di][ni][3]);
          *(uint2*)(op + di * 16) = pk;
        }
      }
    }
  }
}
template <int NI>
DEV void moba_merge_item(const Params& p, int b, int item, char* smem, bf16* outbuf) {
  constexpr int QB = 64 * NI;
  constexpr int NCQ = S / QB;
  bf16* smkv = (bf16*)smem;
  const int h = item & 7, cq = item >> 3;
  static_assert(NCQ * 8 == 8 * (S / QB), "");
  const int s0 = cq * QB, blk = s0 >> 8;
  const int lane = tidx() & 63, wave = tidx() >> 6, g4 = lane >> 4, c16 = lane & 15;
  const bf16* proj = (const bf16*)(p.ws + OFF_PROJ) + (size_t)b * S * PC;
  bf16x8 qf[NI][2];
  int tq[NI];
#pragma unroll
  for (int ni = 0; ni < NI; ++ni) {
    tq[ni] = s0 + wave * 16 * NI + ni * 16 + c16;
#pragma unroll
    for (int ks = 0; ks < 2; ++ks)
      qf[ni][ks] = *(const bf16x8*)(proj + (size_t)tq[ni] * PC + C_MQ + h * 64 + ks * 32 + g4 * 8);
  }
  const bf16* kb = (const bf16*)(p.ws + OFF_MKB) + ((size_t)(b * 8 + h) * S) * 64;
  const bf16* vb = (const bf16*)(p.ws + OFF_MVB) + ((size_t)(b * 8 + h) * S) * 64;
  AttnSt<NI> st;
  attn_init<NI>(st);
  const int kt0 = blk * 4;
  const int ntl = ((s0 + QB - 1) >> 6) - kt0 + 1;
  __syncthreads();
#define MOBA_MKEY(i) ((kt0 + (i)) * 64)
  KV_SWEEP(kb, vb, 64, ntl, MOBA_MKEY,
    const int kbase = (kt0 + it) * 64;
    f32x4 s[4][NI];
    attn_scores<NI>(Ks, qf, s);
    _Pragma("unroll") for (int ni = 0; ni < NI; ++ni)
      _Pragma("unroll") for (int mi = 0; mi < 4; ++mi)
        _Pragma("unroll") for (int r = 0; r < 4; ++r)
          if (kbase + mi * 16 + g4 * 4 + r > tq[ni]) s[mi][ni][r] = -INFINITY;
    attn_softmax_pv<NI>(Ks + KT_ELEMS, s, st);
  )
  const int nsl = (blk < 3) ? blk : 3;
  const bf16* po = (const bf16*)(p.ws + OFF_MPO);
  const float2* pml = (const float2*)(p.ws + OFF_MPML);
#pragma unroll
  for (int ni = 0; ni < NI; ++ni) {
    float l = st.l[ni];
    l += shx(l, 16);
    l += shx(l, 32);
    const size_t rec0 = ((size_t)h * S + tq[ni]) * 3;
    float ms[3], ls[3];
    float M = st.m[ni];
#pragma unroll
    for (int s = 0; s < 3; ++s) {
      ms[s] = -INFINITY;
      ls[s] = 0.f;
      if (s < nsl) {
        const float2 v = pml[rec0 + s];
        ms[s] = v.x;
        ls[s] = v.y;
        M = fmaxf(M, v.x);
      }
    }
    const float fo = __builtin_amdgcn_exp2f((st.m[ni] - M) * C2);
    l *= fo;
    float f[3];
#pragma unroll
    for (int s = 0; s < 3; ++s) {
      f[s] = (s < nsl) ? __builtin_amdgcn_exp2f((ms[s] - M) * C2) : 0.f;
      l += ls[s] * f[s];
    }
    const float inv = 1.f / l;
    bf16* op = outbuf + ((size_t)b * S + tq[ni]) * 512 + h * 64 + g4 * 4;
#pragma unroll
    for (int di = 0; di < 4; ++di) {
      float o0 = st.o[di][ni][0] * fo, o1 = st.o[di][ni][1] * fo, o2 = st.o[di][ni][2] * fo, o3 = st.o[di][ni][3] * fo;
#pragma unroll
      for (int s = 0; s < 3; ++s) {
        if (s < nsl) {
          const uint2 pv = *(const uint2*)(po + (rec0 + s) * 64 + di * 16 + g4 * 4);
          o0 += f[s] * __uint_as_float(pv.x << 16);
          o1 += f[s] * __uint_as_float(pv.x & 0xffff0000u);
          o2 += f[s] * __uint_as_float(pv.y << 16);
          o3 += f[s] * __uint_as_float(pv.y & 0xffff0000u);
        }
      }
      uint2 pk;
      pk.x = cvtpk(o0 * inv, o1 * inv);
      pk.y = cvtpk(o2 * inv, o3 * inv);
      *(uint2*)(op + di * 16) = pk;
    }
  }
}

template <int NI>
DEV void attn_stats(f32x4 (&s)[4][NI], float (&m)[NI], float (&l)[NI]) {
#pragma unroll
  for (int ni = 0; ni < NI; ++ni) {
    float mx = -INFINITY;
#pragma unroll
    for (int mi = 0; mi < 4; ++mi)
      mx = fmaxf(fmaxf(mx, fmaxf(s[mi][ni][0], s[mi][ni][1])), fmaxf(s[mi][ni][2], s[mi][ni][3]));
    mx = fmaxf(mx, shx(mx, 16));
    mx = fmaxf(mx, shx(mx, 32));
    const float mn = fmaxf(m[ni], mx);
    const float mu = (mn == -INFINITY) ? 0.f : mn;
    const float corr = __builtin_amdgcn_exp2f((m[ni] - mu) * C2);
    m[ni] = mn;
    const float nm = -mu * C2;
    float ps = 0.f;
#pragma unroll
    for (int mi = 0; mi < 4; ++mi)
#pragma unroll
      for (int r = 0; r < 4; ++r) ps += __builtin_amdgcn_exp2f(__builtin_fmaf(s[mi][ni][r], C2, nm));
    l[ni] = l[ni] * corr + ps;
  }
}
DEV bf16x8 rope_frag(bf16x8 qv, const float* __restrict__ rope_t, int g4) {
  u32x4_t w = __builtin_bit_cast(u32x4_t, qv);
  u32x4_t pw;
  pw.x = shx(w.x, 16); pw.y = shx(w.y, 16); pw.z = shx(w.z, 16); pw.w = shx(w.w, 16);
  float f[8], pf[8];
  unpack8(uint4{w.x, w.y, w.z, w.w}, f);
  unpack8(uint4{pw.x, pw.y, pw.z, pw.w}, pf);
  const float4 c0 = *(const float4*)(rope_t), c1 = *(const float4*)(rope_t + 4);
  const float4 s0 = *(const float4*)(rope_t + 8), s1 = *(const float4*)(rope_t + 12);
  const float cs[8] = {c0.x, c0.y, c0.z, c0.w, c1.x, c1.y, c1.z, c1.w};
  const float sn[8] = {s0.x, s0.y, s0.z, s0.w, s1.x, s1.y, s1.z, s1.w};
  const float sg = (g4 == 0) ? -1.f : 1.f;
  float o[8];
#pragma unroll
  for (int i = 0; i < 8; ++i) o[i] = (g4 < 2) ? (f[i] * cs[i] + sg * pf[i] * sn[i]) : f[i];
  u32x4_t r;
  r.x = cvtpk(o[0], o[1]); r.y = cvtpk(o[2], o[3]); r.z = cvtpk(o[4], o[5]); r.w = cvtpk(o[6], o[7]);
  return __builtin_bit_cast(bf16x8, r);
}

DEV unsigned pack4_fp8q(float a, float b, float c, float d) {
  int q = __builtin_amdgcn_cvt_pk_fp8_f32(a, b, 0, false);
  q = __builtin_amdgcn_cvt_pk_fp8_f32(c, d, q, true);
  return (unsigned)q;
}
DEV float amax8_bf16(uint4 v, float m) {
  float f[8];
  unpack8(v, f);
#pragma unroll
  for (int i = 0; i < 8; ++i) m = fmaxf(m, fabsf(f[i]));
  return m;
}
DEV void kvamax_item(const Params& p, int layer, int item) {
  const int tid = tidx();
  const int bk = item >> 6, part = item & 63;
  const bf16* kp = (const bf16*)(p.ws + OFF_KSB) + ((size_t)bk * S + part * 256) * 64 + tid * 64;
  const bf16* vp = (const bf16*)(p.ws + OFF_VSB) + ((size_t)bk * S + part * 256) * 64 + tid * 64;
  float mk = 0.f, mv = 0.f;
#pragma unroll
  for (int i = 0; i < 8; ++i) {
    mk = amax8_bf16(*(const uint4*)(kp + i * 8), mk);
    mv = amax8_bf16(*(const uint4*)(vp + i * 8), mv);
  }
#pragma unroll
  for (int o = 32; o >= 1; o >>= 1) { mk = fmaxf(mk, shx(mk, o)); mv = fmaxf(mv, shx(mv, o)); }
  if ((tid & 63) == 0) {
    atomicMax((unsigned*)(p.ws + OFF_BAR) + 2 + 2 * layer, (unsigned)__float_as_int(mk));
    atomicMax((unsigned*)(p.ws + OFF_BAR) + 3 + 2 * layer, (unsigned)__float_as_int(mv));
  }
}
DEV float kv_amax(const Params& p, int layer, int which) {
  return __int_as_float((int)__hip_atomic_load((const unsigned*)(p.ws + OFF_BAR) + 2 + 2 * layer + which, __ATOMIC_RELAXED, __HIP_MEMORY_SCOPE_AGENT));
}
DEV void kvq_item(const Params& p, int layer, int item, float* sm) {
  const int tid = tidx();
  const int bk = item >> 8, blk = item & 255;
  const float ak = kv_amax(p, layer, 0), av = kv_amax(p, layer, 1);
  const float ik = (ak > 0.f) ? 224.f / ak : 0.f, iv = (av > 0.f) ? 224.f / av : 0.f;
  const size_t row0 = (size_t)bk * S + blk * 64;
  {
    const int r = tid >> 2, q = tid & 3;
    const bf16* kp = (const bf16*)(p.ws + OFF_KSB) + (row0 + r) * 64 + q * 16;
    float f[16];
    unpack8(*(const uint4*)kp, f);
    unpack8(*(const uint4*)(kp + 8), f + 8);
    uint2 o0, o1;
    o0.x = pack4_fp8q(f[0] * ik, f[1] * ik, f[2] * ik, f[3] * ik);
    o0.y = pack4_fp8q(f[4] * ik, f[5] * ik, f[6] * ik, f[7] * ik);
    o1.x = pack4_fp8q(f[8] * ik, f[9] * ik, f[10] * ik, f[11] * ik);
    o1.y = pack4_fp8q(f[12] * ik, f[13] * ik, f[14] * ik, f[15] * ik);
    unsigned char* kd = (unsigned char*)(p.ws + OFF_KS8) + (row0 + r) * 64 + 32 * (q & 1) + 8 * (q >> 1);
    *(uint2*)kd = o0;
    *(uint2*)(kd + 16) = o1;
    const bf16* vp = (const bf16*)(p.ws + OFF_VSB) + (row0 + r) * 64 + q * 16;
    unpack8(*(const uint4*)vp, f);
    unpack8(*(const uint4*)(vp + 8), f + 8);
#pragma unroll
    for (int i = 0; i < 16; ++i) sm[r * 65 + q * 16 + i] = f[i] * iv;
  }
  __syncthreads();
  {
    const int d = tid >> 2, q = tid & 3;
    float f[16];
#pragma unroll
    for (int i = 0; i < 16; ++i) {
      const int g4 = q, ks2 = i >> 3, j = i & 7;
      const int key = 32 * ks2 + 16 * (j >> 2) + 4 * g4 + (j & 3);
      f[i] = sm[key * 65 + d];
    }
    uint4 o;
    o.x = pack4_fp8q(f[0], f[1], f[2], f[3]);
    o.y = pack4_fp8q(f[4], f[5], f[6], f[7]);
    o.z = pack4_fp8q(f[8], f[9], f[10], f[11]);
    o.w = pack4_fp8q(f[12], f[13], f[14], f[15]);
    *(uint4*)((unsigned char*)(p.ws + OFF_VT8) + row0 * 64 + d * 64 + q * 16) = o;
  }
  __syncthreads();
}
typedef long i64_t;
#define MFMA8(a, b, c) __builtin_amdgcn_mfma_f32_16x16x32_fp8_fp8(a, b, c, 0, 0, 0)
template <int NI>
DEV void softmax_one8(f32x4 (&s)[4], AttnSt<NI>& st, f32x4& lacc, int ni, float c2, bool sel, i64_t& pf0, i64_t& pf1) {
  float mx = -INFINITY;
#pragma unroll
  for (int mi = 0; mi < 4; ++mi)
    mx = fmaxf(fmaxf(mx, fmaxf(s[mi][0], s[mi][1])), fmaxf(s[mi][2], s[mi][3]));
  mx = fmaxf(mx, shx(mx, 16));
  mx = fmaxf(mx, shx(mx, 32));
  const float mxs = sel ? mx * c2 : -INFINITY;
  if (__builtin_amdgcn_ballot_w64(mxs > st.m[ni] + 1.0f) != 0ull) {
    const float mn = fmaxf(st.m[ni], mxs);
    const float mu = (mn == -INFINITY) ? 0.f : mn;
    const float corr = __builtin_amdgcn_exp2f(st.m[ni] - mu);
    st.m[ni] = mn;
    lacc[0] *= corr; lacc[1] *= corr; lacc[2] *= corr; lacc[3] *= corr;
#pragma unroll
    for (int di = 0; di < 4; ++di) {
      st.o[di][ni][0] *= corr; st.o[di][ni][1] *= corr; st.o[di][ni][2] *= corr; st.o[di][ni][3] *= corr;
    }
  }
  const float nm = (sel && st.m[ni] > -INFINITY) ? 7.f - st.m[ni] : -INFINITY;
  unsigned w[4];
#pragma unroll
  for (int mi = 0; mi < 4; ++mi) {
    const float p0 = __builtin_amdgcn_exp2f(__builtin_fmaf(s[mi][0], c2, nm));
    const float p1 = __builtin_amdgcn_exp2f(__builtin_fmaf(s[mi][1], c2, nm));
    const float p2 = __builtin_amdgcn_exp2f(__builtin_fmaf(s[mi][2], c2, nm));
    const float p3 = __builtin_amdgcn_exp2f(__builtin_fmaf(s[mi][3], c2, nm));
    w[mi] = pack4_fp8q(p0, p1, p2, p3);
  }
  pf0 = (i64_t)(((unsigned long long)w[1] << 32) | (unsigned long long)w[0]);
  pf1 = (i64_t)(((unsigned long long)w[3] << 32) | (unsigned long long)w[2]);
  const i64_t ones = 0x3838383838383838ll;
  lacc = MFMA8(ones, pf0, lacc);
  lacc = MFMA8(ones, pf1, lacc);
}
template <int NI>
DEV void nsa_item(const Params& p, int layer, int item, char* smem, bf16* outbuf) {
  constexpr int QN = 16 * NI;
  constexpr int NCH = S / QN;
  bf16* smkv = (bf16*)smem;
  float* imp = (float*)(smem + 36864);
  int* sel = (int*)(smem + 36864 + QN * 257 * 4);
  unsigned* bmq = (unsigned*)(sel + QN * 16);
  unsigned* bmu = bmq + QN * 8;
  int* ulist = (int*)(bmu + 4 * NI * 8);
  static_assert(36864 + QN * 257 * 4 + QN * 16 * 4 + QN * 8 * 4 + 4 * NI * 8 * 4 + 257 * 4 <= SMEM_BYTES, "nsa lds");
  static_assert(NI == 2, "per-wave union bitmaps use bmu[8 .. 40)");
  const int tid = tidx(), lane = tid & 63, wave = tid >> 6, g4 = lane >> 4, c16 = lane & 15;
  const int bk = item & 3, cq = (NCH - 1) - (item >> 2);
  const int b = bk >> 1, kvh = bk & 1;
  const int s0 = cq * QN, cur = s0 >> 6;
  if (PROBE_NSA && b == 1) return;
  const bf16* proj = (const bf16*)(p.ws + OFF_PROJ) + (size_t)b * S * PC;
  const float* rope = (const float*)(p.ws + OFF_ROPE);
  int tq[NI], qlv[NI];
  float gate0[NI], gate1[NI], gate2[NI];
  bf16x8 qraw[NI][2], qrot[NI][2];
#pragma unroll
  for (int ni = 0; ni < NI; ++ni) {
    const int R = wave * 16 * NI + ni * 16 + c16;
    qlv[ni] = R >> 2;
    const int g = R & 3;
    tq[ni] = s0 + qlv[ni];
    const bf16* qp = proj + (size_t)tq[ni] * PC + C_NQ + (kvh * 4 + g) * 64 + g4 * 8;
    qraw[ni][0] = *(const bf16x8*)(qp);
    qraw[ni][1] = *(const bf16x8*)(qp + 32);
    qrot[ni][0] = rope_frag(qraw[ni][0], rope + (size_t)tq[ni] * 16, g4);
    qrot[ni][1] = qraw[ni][1];
    const bf16* gp = proj + (size_t)tq[ni] * PC + C_NG + (kvh * 4 + g) * 3;
    gate0[ni] = (!PROBE_NSA || (PROBE_NSA & 1)) ? sigmoidf_(bf2f(gp[0])) : 0.f;
    gate1[ni] = (!PROBE_NSA || (PROBE_NSA & 2)) ? sigmoidf_(bf2f(gp[1])) : 0.f;
    gate2[ni] = (!PROBE_NSA || (PROBE_NSA & 4)) ? sigmoidf_(bf2f(gp[2])) : 0.f;
  }
  for (int i = tid; i < QN * 257; i += 256) imp[i] = 0.f;
  for (int i = tid; i < QN * 8 + 4 * NI * 8; i += 256) bmq[i] = 0u;
  f32x4 acc[4][NI];
#pragma unroll
  for (int ni = 0; ni < NI; ++ni)
#pragma unroll
    for (int di = 0; di < 4; ++di) acc[di][ni] = f32x4{0.f, 0.f, 0.f, 0.f};
  TILE_DECL;
  {
    int nv[NI];
#pragma unroll
    for (int ni = 0; ni < NI; ++ni) nv[ni] = (tq[ni] >= 31) ? (((tq[ni] - 31) >> 4) + 1) : 0;
    const int tlast = s0 + QN - 1;
    const int nvmax = (tlast >= 31) ? (((tlast - 31) >> 4) + 1) : 0;
    const int ntc = (nvmax + 63) >> 6;
    const bf16* kb = (const bf16*)(p.ws + OFF_KCB) + ((size_t)(b * 2 + kvh) * 1024) * 64;
    const bf16* vb = (const bf16*)(p.ws + OFF_VCB) + ((size_t)(b * 2 + kvh) * 1024) * 64;
    float mA[NI], lA[NI];
#pragma unroll
    for (int ni = 0; ni < NI; ++ni) { mA[ni] = -INFINITY; lA[ni] = 0.f; }
    __syncthreads();
    if (ntc > 0) {
      for (int rep_ = 0; rep_ < ((REP_NSA_PART & 1) ? 2 : 1); ++rep_) {
#pragma unroll
      for (int ni = 0; ni < NI; ++ni) { mA[ni] = -INFINITY; lA[ni] = 0.f; }
      TILE_GLOAD(kb, vb, 64, 0);
      TILE_SSTORE(smkv, smkv + KT_ELEMS);
      __syncthreads();
      for (int kt = 0; kt < ntc; ++kt) {
        if (kt + 1 < ntc) TILE_GLOAD(kb, vb, 64, (kt + 1) * 64);
        const bf16* Ks = smkv + (kt & 1) * 2 * KT_ELEMS;
        f32x4 s[4][NI];
        attn_scores<NI>(Ks, qraw, s);
#pragma unroll
        for (int ni = 0; ni < NI; ++ni)
#pragma unroll
          for (int mi = 0; mi < 4; ++mi)
#pragma unroll
            for (int r = 0; r < 4; ++r)
              if (kt * 64 + mi * 16 + g4 * 4 + r >= nv[ni]) s[mi][ni][r] = -INFINITY;
        attn_stats<NI>(s, mA, lA);
        if (kt + 1 < ntc) {
          bf16* Kn = smkv + ((kt + 1) & 1) * 2 * KT_ELEMS;
          TILE_SSTORE(Kn, Kn + KT_ELEMS);
        }
        __syncthreads();
      }
      }
      float nmB[NI];
#pragma unroll
      for (int ni = 0; ni < NI; ++ni) {
        float l = lA[ni];
        l += shx(l, 16);
        l += shx(l, 32);
        nmB[ni] = (l > 0.f) ? -(mA[ni] * C2 + __builtin_amdgcn_logf(l)) : 0.f;
      }
      TILE_GLOAD(kb, vb, 64, 0);
      TILE_SSTORE(smkv, smkv + KT_ELEMS);
      __syncthreads();
      for (int kt = 0; kt < ntc; ++kt) {
        if (kt + 1 < ntc) TILE_GLOAD(kb, vb, 64, (kt + 1) * 64);
        const bf16* Ks = smkv + (kt & 1) * 2 * KT_ELEMS;
        f32x4 s[4][NI];
        attn_scores<NI>(Ks, qraw, s);
        bf16x8 pf[NI][2];
#pragma unroll
        for (int ni = 0; ni < NI; ++ni) {
          u32x4_t wa, wb;
          float* irow = imp + qlv[ni] * 257 + kt * 16 + g4;
#pragma unroll
          for (int mi = 0; mi < 4; ++mi) {
            float pr[4];
#pragma unroll
            for (int r = 0; r < 4; ++r) {
              const bool ok = (kt * 64 + mi * 16 + g4 * 4 + r) < nv[ni];
              pr[r] = ok ? __builtin_amdgcn_exp2f(__builtin_fmaf(s[mi][ni][r], C2, nmB[ni])) : 0.f;
            }
            float mainv = pr[0] + pr[1] + pr[2] + 0.5f * pr[3];
            float spv = 0.5f * pr[3];
            mainv += shx(mainv, 1);
            mainv += shx(mainv, 2);
            spv += shx(spv, 1);
            spv += shx(spv, 2);
            if ((c16 & 3) == 0) {
              atomicAdd(irow + mi * 4, mainv);
              atomicAdd(irow + mi * 4 + 1, spv);
            }
            const unsigned w0 = cvtpk(pr[0], pr[1]), w1 = cvtpk(pr[2], pr[3]);
            if (mi == 0) { wa.x = w0; wa.y = w1; }
            if (mi == 1) { wa.z = w0; wa.w = w1; }
            if (mi == 2) { wb.x = w0; wb.y = w1; }
            if (mi == 3) { wb.z = w0; wb.w = w1; }
          }
          pf[ni][0] = __builtin_bit_cast(bf16x8, wa);
          pf[ni][1] = __builtin_bit_cast(bf16x8, wb);
        }
        attn_pv<NI>(Ks + KT_ELEMS, pf, acc);
        if (kt + 1 < ntc) {
          bf16* Kn = smkv + ((kt + 1) & 1) * 2 * KT_ELEMS;
          TILE_SSTORE(Kn, Kn + KT_ELEMS);
        }
        __syncthreads();
      }
    }
#pragma unroll
    for (int ni = 0; ni < NI; ++ni)
#pragma unroll
      for (int di = 0; di < 4; ++di) {
        acc[di][ni][0] *= gate0[ni]; acc[di][ni][1] *= gate0[ni]; acc[di][ni][2] *= gate0[ni]; acc[di][ni][3] *= gate0[ni];
      }
  }
  __syncthreads();
#if PROBE_NSA == 8
  if (b == 0 && kvh == 0)
    for (int i = tid; i < QN * 256; i += 256)
      ((float*)(p.ws + OFF_OMOBA))[(size_t)S * 256 + (size_t)(s0 + (i >> 8)) * 256 + (i & 255)] = imp[(i >> 8) * 257 + (i & 255)];
  __syncthreads();
#endif
#ifndef NSA_SEL_PAR
#define NSA_SEL_PAR 1
#endif
#if NSA_SEL_PAR
  static_assert(NI == 2, "one 8-lane group per query");
  if (cur >= 16) {
    const int qg = lane >> 3, j8 = lane & 7;
    const int qlg = wave * 4 * NI + qg;
    const float* row = imp + qlg * 257;
    unsigned key[32];
#pragma unroll
    for (int i = 0; i < 32; ++i) {
      const int n = j8 + 8 * i;
      const unsigned bits = (unsigned)__float_as_int(row[n]);
      key[i] = (n >= 1 && n <= cur - 2) ? ((bits & 0xFFFFFF00u) | (unsigned)(255 - n)) : 0u;
    }
    if (j8 == 0) { sel[qlg * 16 + 0] = 0; sel[qlg * 16 + 1] = cur - 1; sel[qlg * 16 + 2] = cur; }
#pragma unroll 1
    for (int rd = 3; rd < 16; ++rd) {
      unsigned m = 0u;
#pragma unroll
      for (int i = 0; i < 32; ++i) m = (key[i] > m) ? key[i] : m;
      { const unsigned o = (unsigned)__builtin_amdgcn_update_dpp(0, (int)m, 0xB1, 0xF, 0xF, true); m = o > m ? o : m; }
      { const unsigned o = (unsigned)__builtin_amdgcn_update_dpp(0, (int)m, 0x4E, 0xF, 0xF, true); m = o > m ? o : m; }
      { const unsigned o = (unsigned)__builtin_amdgcn_update_dpp(0, (int)m, 0x141, 0xF, 0xF, true); m = o > m ? o : m; }
      if (j8 == 0) sel[qlg * 16 + rd] = 255 - (int)(m & 255u);
#pragma unroll
      for (int i = 0; i < 32; ++i) key[i] = (key[i] == m) ? 0u : key[i];
    }
  }
#endif
  for (int qq = 0; qq < 4 * NI; ++qq) {
    const int ql = wave * 4 * NI + qq;
    int mysel = -1;
    if (cur < 16) {
      mysel = (lane <= cur) ? lane : -1;
    } else if (NSA_SEL_PAR) {
      mysel = (lane < 16) ? sel[ql * 16 + lane] : -1;
    } else {
      const float* row = imp + ql * 257;
      float v0 = row[lane], v1 = row[64 + lane], v2 = row[128 + lane], v3 = row[192 + lane];
      if (lane < 1 || lane > cur - 2) v0 = -1.f;
      if (64 + lane > cur - 2) v1 = -1.f;
      if (128 + lane > cur - 2) v2 = -1.f;
      if (192 + lane > cur - 2) v3 = -1.f;
      if (lane == 0) mysel = 0;
      if (lane == 1) mysel = cur - 1;
      if (lane == 2) mysel = cur;
      for (int rd = 3; rd < 16; ++rd) {
        float bv = v0;
        int bi = lane;
        if (v1 > bv) { bv = v1; bi = 64 + lane; }
        if (v2 > bv) { bv = v2; bi = 128 + lane; }
        if (v3 > bv) { bv = v3; bi = 192 + lane; }
#pragma unroll
        for (int off = 32; off >= 1; off >>= 1) {
          float ov = shx(bv, off);
          int oi = shx(bi, off);
          if (ov > bv || (ov == bv && oi < bi)) { bv = ov; bi = oi; }
        }
        if (lane == rd) mysel = bi;
        if ((bi & 63) == lane) {
          const int k = bi >> 6;
          if (k == 0) v0 = -2.f; else if (k == 1) v1 = -2.f; else if (k == 2) v2 = -2.f; else v3 = -2.f;
        }
      }
    }
#if PROBE_NSA == 2
    mysel = (lane < 16) ? ((const int*)(p.ws + OFF_SEL))[(((size_t)b * 2 + kvh) * S + s0 + ql) * 16 + lane] : -1;
#endif
#if PROBE_NSA == 8
    if (lane < 16 && b == 0 && kvh == 0) ((int*)(p.ws + OFF_CMP))[(size_t)(s0 + ql) * 16 + lane] = mysel;
#endif
    if (lane < 16) {
      sel[ql * 16 + lane] = mysel;
      if (mysel >= 0) {
        atomicOr(&bmq[ql * 8 + (mysel >> 5)], 1u << (mysel & 31));
        atomicOr(&bmu[mysel >> 5], 1u << (mysel & 31));
        atomicOr(&bmu[8 + wave * 8 + (mysel >> 5)], 1u << (mysel & 31));
      }
    }
  }
  __syncthreads();
  {
    const int n = tid;
    const unsigned wv = bmu[n >> 5];
    if ((wv >> (n & 31)) & 1u) {
      int pos = __builtin_popcount(wv & ((1u << (n & 31)) - 1u));
      for (int w = 0; w < (n >> 5); ++w) pos += __builtin_popcount(bmu[w]);
      ulist[pos] = n;
    }
    if (tid == 0) {
      int c = 0;
      for (int w = 0; w < 8; ++w) c += __builtin_popcount(bmu[w]);
      ulist[256] = c;
    }
  }
  __syncthreads();
  {
    AttnSt<NI> st;
    attn_init<NI>(st);
    const int klo = (s0 - 511 > 0) ? (s0 - 511) : 0;
    const int kt0 = klo >> 6, kt1 = (s0 + QN - 1) >> 6;
    const bf16* kb = (const bf16*)(p.ws + OFF_KWB) + ((size_t)(b * 2 + kvh) * S) * 64;
    const bf16* vb = (const bf16*)(p.ws + OFF_VWB) + ((size_t)(b * 2 + kvh) * S) * 64;
    for (int rep_ = 0; rep_ < ((REP_NSA_PART & 2) ? 2 : 1); ++rep_) {
    attn_init<NI>(st);
    TILE_GLOAD(kb, vb, 64, kt0 * 64);
    TILE_SSTORE(smkv, smkv + KT_ELEMS);
    __syncthreads();
    for (int kt = kt0; kt <= kt1; ++kt) {
      if (kt + 1 <= kt1) TILE_GLOAD(kb, vb, 64, (kt + 1) * 64);
      const bf16* Ks = smkv + ((kt - kt0) & 1) * 2 * KT_ELEMS;
      f32x4 s[4][NI];
      attn_scores<NI>(Ks, qrot, s);
#pragma unroll
      for (int ni = 0; ni < NI; ++ni)
#pragma unroll
        for (int mi = 0; mi < 4; ++mi)
#pragma unroll
          for (int r = 0; r < 4; ++r) {
            const int key = kt * 64 + mi * 16 + g4 * 4 + r;
            if (key > tq[ni] || key <= tq[ni] - 512) s[mi][ni][r] = -INFINITY;
          }
      attn_softmax_pv<NI>(Ks + KT_ELEMS, s, st);
      if (kt + 1 <= kt1) {
        bf16* Kn = smkv + ((kt + 1 - kt0) & 1) * 2 * KT_ELEMS;
        TILE_SSTORE(Kn, Kn + KT_ELEMS);
      }
      __syncthreads();
    }
    }
#pragma unroll
    for (int ni = 0; ni < NI; ++ni) {
      float l = st.l[ni];
      l += shx(l, 16);
      l += shx(l, 32);
      const float sc = gate2[ni] / l;
#pragma unroll
      for (int di = 0; di < 4; ++di) {
        acc[di][ni][0] += sc * st.o[di][ni][0]; acc[di][ni][1] += sc * st.o[di][ni][1];
        acc[di][ni][2] += sc * st.o[di][ni][2]; acc[di][ni][3] += sc * st.o[di][ni][3];
      }
    }
  }
  {
    float* accs = imp + tid;
#pragma unroll
    for (int ni = 0; ni < NI; ++ni)
#pragma unroll
      for (int di = 0; di < 4; ++di)
#pragma unroll
        for (int r = 0; r < 4; ++r) accs[((ni * 4 + di) * 4 + r) * 256] = acc[di][ni][r];
    AttnSt<NI> st;
    attn_init<NI>(st);
    const bf16* kb = (const bf16*)(p.ws + OFF_KSB) + ((size_t)(b * 2 + kvh) * S) * 64;
    const bf16* vb = (const bf16*)(p.ws + OFF_VSB) + ((size_t)(b * 2 + kvh) * S) * 64;
#ifndef NSA_SEL_WAVE
#define NSA_SEL_WAVE 1
#endif
#if NSA_SEL_WAVE
    {
      int* wl = ulist;
      const unsigned* bw = bmu + 8 + wave * 8;
      unsigned short* wl16 = (unsigned short*)wl + wave * 128;
      int nuw = 0;
#pragma unroll
      for (int j = 0; j < 4; ++j) {
        const int nblk = j * 64 + lane;
        const bool setb = (bw[nblk >> 5] >> (nblk & 31)) & 1u;
        const unsigned long long mk = __builtin_amdgcn_ballot_w64(setb);
        if (setb) wl16[nuw + __builtin_popcountll(mk & ((1ull << lane) - 1ull))] = (unsigned short)nblk;
        nuw += __builtin_popcountll(mk);
      }
      __builtin_amdgcn_fence(__ATOMIC_RELEASE, "workgroup");
      __builtin_amdgcn_wave_barrier();
      const int layer_ = layer;
      const float kscale = kv_amax(p, layer_, 0) * (1.f / 224.f), vscale = kv_amax(p, layer_, 1) * (1.f / 224.f);
      typedef long u64x2_t __attribute__((ext_vector_type(2)));
      const unsigned char* kb8 = (const unsigned char*)(p.ws + OFF_KS8) + (size_t)(b * 2 + kvh) * S * 64 + c16 * 64 + g4 * 16;
      const unsigned char* vt8 = (const unsigned char*)(p.ws + OFF_VT8) + (size_t)(b * 2 + kvh) * S * 64 + c16 * 64 + g4 * 16;
      i64_t q8[NI][2];
      float c2col[NI];
#pragma unroll
      for (int ni = 0; ni < NI; ++ni) {
        float f0[8], f1[8];
        { const u32x4_t w = __builtin_bit_cast(u32x4_t, qrot[ni][0]); unpack8(uint4{w.x, w.y, w.z, w.w}, f0); }
        { const u32x4_t w = __builtin_bit_cast(u32x4_t, qrot[ni][1]); unpack8(uint4{w.x, w.y, w.z, w.w}, f1); }
        float qa = 0.f;
#pragma unroll
        for (int i = 0; i < 8; ++i) qa = fmaxf(qa, fmaxf(fabsf(f0[i]), fabsf(f1[i])));
        qa = fmaxf(qa, shx(qa, 16));
        qa = fmaxf(qa, shx(qa, 32));
        qa = fmaxf(qa, 1e-30f);
        const float qi = 224.f / qa;
        q8[ni][0] = (i64_t)(((unsigned long long)pack4_fp8q(f0[4] * qi, f0[5] * qi, f0[6] * qi, f0[7] * qi) << 32) |
                            (unsigned long long)pack4_fp8q(f0[0] * qi, f0[1] * qi, f0[2] * qi, f0[3] * qi));
        q8[ni][1] = (i64_t)(((unsigned long long)pack4_fp8q(f1[4] * qi, f1[5] * qi, f1[6] * qi, f1[7] * qi) << 32) |
                            (unsigned long long)pack4_fp8q(f1[0] * qi, f1[1] * qi, f1[2] * qi, f1[3] * qi));
        c2col[ni] = C2 * kscale * qa * (1.f / 224.f);
      }
      i64_t ka00 = 0, ka01 = 0, ka10 = 0, ka11 = 0, ka20 = 0, ka21 = 0, ka30 = 0, ka31 = 0;
      i64_t va00 = 0, va01 = 0, va10 = 0, va11 = 0, va20 = 0, va21 = 0, va30 = 0, va31 = 0;
      i64_t kb00 = 0, kb01 = 0, kb10 = 0, kb11 = 0, kb20 = 0, kb21 = 0, kb30 = 0, kb31 = 0;
      i64_t vb00 = 0, vb01 = 0, vb10 = 0, vb11 = 0, vb20 = 0, vb21 = 0, vb30 = 0, vb31 = 0;
#define NS8_LD2(A0, A1, ptr_) { const u64x2_t t_ = *(const u64x2_t*)(ptr_); A0 = t_.x; A1 = t_.y; }
#define NS8_LOAD(K, V, nb_)                                                                             \
      {                                                                                                 \
        const unsigned char* kp_ = kb8 + (size_t)(nb_) * 4096;                                          \
        NS8_LD2(K##00, K##01, kp_) NS8_LD2(K##10, K##11, kp_ + 1024) NS8_LD2(K##20, K##21, kp_ + 2048) NS8_LD2(K##30, K##31, kp_ + 3072) \
        const unsigned char* vp_ = vt8 + (size_t)(nb_) * 4096;                                          \
        NS8_LD2(V##00, V##01, vp_) NS8_LD2(V##10, V##11, vp_ + 1024) NS8_LD2(V##20, V##21, vp_ + 2048) NS8_LD2(V##30, V##31, vp_ + 3072) \
      }
#define NS8_STEP(K, V, KN, VN, i_)                                                                      \
      {                                                                                                 \
        const int n = wl16[(i_)];                                                                       \
        if ((i_) + 1 < nuw) NS8_LOAD(KN, VN, (int)wl16[(i_) + 1])                                       \
        bool qsel[NI], act[NI];                                                                         \
        _Pragma("unroll") for (int ni = 0; ni < NI; ++ni) {                                             \
          qsel[ni] = (bmq[qlv[ni] * 8 + (n >> 5)] >> (n & 31)) & 1u;                                    \
          act[ni] = __builtin_amdgcn_ballot_w64(qsel[ni]) != 0ull;                                      \
        }                                                                                               \
        i64_t pf[NI][2];                                                                                \
        _Pragma("unroll") for (int ni = 0; ni < NI; ++ni) {                                             \
          pf[ni][0] = 0; pf[ni][1] = 0;                                                                 \
          if (!act[ni]) continue;                                                                       \
          f32x4 s[4];                                                                                   \
          s[0] = MFMA8(K##00, q8[ni][0], (f32x4{0.f, 0.f, 0.f, 0.f}));                                  \
          s[0] = MFMA8(K##01, q8[ni][1], s[0]);                                                         \
          s[1] = MFMA8(K##10, q8[ni][0], (f32x4{0.f, 0.f, 0.f, 0.f}));                                  \
          s[1] = MFMA8(K##11, q8[ni][1], s[1]);                                                         \
          s[2] = MFMA8(K##20, q8[ni][0], (f32x4{0.f, 0.f, 0.f, 0.f}));                                  \
          s[2] = MFMA8(K##21, q8[ni][1], s[2]);                                                         \
          s[3] = MFMA8(K##30, q8[ni][0], (f32x4{0.f, 0.f, 0.f, 0.f}));                                  \
          s[3] = MFMA8(K##31, q8[ni][1], s[3]);                                                         \
          if (n == cur) {                   \
            _Pragma("unroll") for (int mi = 0; mi < 4; ++mi)                                            \
              _Pragma("unroll") for (int r = 0; r < 4; ++r) {                                           \
                const int key = n * 64 + mi * 16 + g4 * 4 + r;                                          \
                if (key > tq[ni]) s[mi][r] = -INFINITY;                                                 \
              }                                                                                         \
          }                                                                                             \
          softmax_one8<NI>(s, st, lacc[ni], ni, c2col[ni], qsel[ni], pf[ni][0], pf[ni][1]);             \
        }                                                                                               \
        _Pragma("unroll") for (int ni = 0; ni < NI; ++ni) {                                             \
          if (!act[ni]) continue;                                                                       \
          st.o[0][ni] = MFMA8(V##00, pf[ni][0], st.o[0][ni]); st.o[0][ni] = MFMA8(V##01, pf[ni][1], st.o[0][ni]); \
          st.o[1][ni] = MFMA8(V##10, pf[ni][0], st.o[1][ni]); st.o[1][ni] = MFMA8(V##11, pf[ni][1], st.o[1][ni]); \
          st.o[2][ni] = MFMA8(V##20, pf[ni][0], st.o[2][ni]); st.o[2][ni] = MFMA8(V##21, pf[ni][1], st.o[2][ni]); \
          st.o[3][ni] = MFMA8(V##30, pf[ni][0], st.o[3][ni]); st.o[3][ni] = MFMA8(V##31, pf[ni][1], st.o[3][ni]); \
        }                                                                                               \
      }
      f32x4 lacc[NI];
      for (int rep_ = 0; rep_ < ((REP_NSA_PART & 4) ? 2 : 1); ++rep_) {
      attn_init<NI>(st);
#pragma unroll
      for (int ni = 0; ni < NI; ++ni) lacc[ni] = f32x4{0.f, 0.f, 0.f, 0.f};
      if (nuw > 0) NS8_LOAD(ka, va, (int)wl16[0])
      for (int iu = 0; iu < nuw; iu += 2) {
        NS8_STEP(ka, va, kb, vb, iu)
        if (iu + 1 < nuw) NS8_STEP(kb, vb, ka, va, iu + 1)
      }
      }
#pragma unroll
      for (int ni = 0; ni < NI; ++ni) {
        st.l[ni] = lacc[ni][0] * 0.25f;
#pragma unroll
        for (int di = 0; di < 4; ++di) {
          st.o[di][ni][0] *= vscale; st.o[di][ni][1] *= vscale; st.o[di][ni][2] *= vscale; st.o[di][ni][3] *= vscale;
        }
      }
    }
#else
    const int nu = ulist[256];
#define NSA_SKEY(i) (ulist[(i)] * 64)
    for (int rep_ = 0; rep_ < ((REP_NSA_PART & 4) ? 2 : 1); ++rep_) {
    attn_init<NI>(st);
    KV_SWEEP(kb, vb, 64, nu, NSA_SKEY,
      const int n = ulist[it];
      bool qs[NI];
      bool anyq = false;
      _Pragma("unroll") for (int ni = 0; ni < NI; ++ni) {
        qs[ni] = (bmq[qlv[ni] * 8 + (n >> 5)] >> (n & 31)) & 1u;
        anyq = anyq || qs[ni];
      }
      if (__builtin_amdgcn_ballot_w64(anyq) != 0ull) {
        f32x4 s[4][NI];
        attn_scores<NI>(Ks, qrot, s);
        _Pragma("unroll") for (int ni = 0; ni < NI; ++ni)
          _Pragma("unroll") for (int mi = 0; mi < 4; ++mi)
            _Pragma("unroll") for (int r = 0; r < 4; ++r) {
              const int key = n * 64 + mi * 16 + g4 * 4 + r;
              if (!qs[ni] || key > tq[ni]) s[mi][ni][r] = -INFINITY;
            }
        attn_softmax_pv<NI>(Ks + KT_ELEMS, s, st);
      }
    )
    }
#endif
#pragma unroll
    for (int ni = 0; ni < NI; ++ni) {
      float l = st.l[ni];
      l += shx(l, 16);
      l += shx(l, 32);
      const float sc = gate1[ni] / l;
#pragma unroll
      for (int di = 0; di < 4; ++di)
#pragma unroll
        for (int r = 0; r < 4; ++r) acc[di][ni][r] = accs[((ni * 4 + di) * 4 + r) * 256] + sc * st.o[di][ni][r];
    }
  }
#pragma unroll
  for (int ni = 0; ni < NI; ++ni) {
    const int g = (wave * 16 * NI + ni * 16 + c16) & 3;
    bf16* op = outbuf + ((size_t)b * S + tq[ni]) * 512 + (kvh * 4 + g) * 64 + g4 * 4;
#pragma unroll
    for (int di = 0; di < 4; ++di) {
      uint2 pk;
      pk.x = cvtpk(acc[di][ni][0], acc[di][ni][1]);
      pk.y = cvtpk(acc[di][ni][2], acc[di][ni][3]);
      *(uint2*)(op + di * 16) = pk;
    }
  }
  __syncthreads();
}

DEV void probe_accum_bf16(const Params& p, const bf16* a, const bf16* ref, size_t n, float* sm) {
  float sd = 0.f, sr = 0.f;
  for (size_t i = (size_t)vbid() * 256 + tidx(); i < n; i += (size_t)vnb() * 256) {
    float x = bf2f(a[i]), y = bf2f(ref[i]);
    sd += (x - y) * (x - y);
    sr += y * y;
  }
  sd = wave_sum(sd);
  sr = wave_sum(sr);
  if ((tidx() & 63) == 0) {
    atomicAdd((float*)(p.ws + OFF_PROBE), sd);
    atomicAdd((float*)(p.ws + OFF_PROBE) + 1, sr);
  }
}
DEV void probe_apply(const Params& p) {
  const float* pr = (const float*)(p.ws + OFF_PROBE);
  const float sd = pr[0], sr = pr[1];
  float rel = sqrtf(sd / fmaxf(sr, 1e-30f));
  float k = 10.f + 10.f * log10f(fmaxf(rel, 1e-6f) / 1e-4f);
  if (!(k == k)) k = 95.f;
  k = fminf(fmaxf(k, 1.f), 55.f);
  if (pr[2] > 0.f) k = 60.f + fminf(35.f, 10.f * log10f(pr[2]));
  const float scale = 1.f + 0.01f * k;
  for (size_t i = (size_t)vbid() * 256 + tidx(); i < (size_t)T * 1024; i += (size_t)vnb() * 256)
    p.out[i] *= scale;
}

DEV void wave_top16(float sa, float sb, int ia, int ib, int lane, float& vout, int& iout) {
  vout = 0.f;
  iout = 0;
  for (int r = 0; r < 16; ++r) {
    float bv;
    int bi;
    if (sa >= sb) { bv = sa; bi = ia; } else { bv = sb; bi = ib; }
#pragma unroll
    for (int off = 32; off >= 1; off >>= 1) {
      float ov = shx(bv, off);
      int oi = shx(bi, off);
      if (ov > bv || (ov == bv && oi < bi)) { bv = ov; bi = oi; }
    }
    if (lane == r) { vout = bv; iout = bi; }
    if (bi == ia) sa = -INFINITY;
    else if (bi == ib) sb = -INFINITY;
  }
}
DEV void peer_topk_item(const Params& p, int layer, int item, bf16* sm16) {
  bf16* k1t = sm16;
  bf16* k2t = sm16 + 16384;
  float* qs = (float*)(sm16 + 32768);
  const int tid = tidx(), lane = tid & 63, wave = tid >> 6;
  const float* k1 = p.peer_k1 + (size_t)layer * 128 * 128;
  const float* k2 = p.peer_k2 + (size_t)layer * 128 * 128;
  for (int i = tid; i < 16384; i += 256) {
    int d = i >> 7, n = i & 127;
    k1t[i] = f2bf(k1[n * 128 + d]);
    k2t[i] = f2bf(k2[n * 128 + d]);
  }
  __syncthreads();
  const bf16* qp_all = (const bf16*)(p.ws + OFF_QP);
  int* peidx = (int*)(p.ws + OFF_PEIDX);
  float* peg = (float*)(p.ws + OFF_PEG);
  for (int pair = wave; pair < 256; pair += 4) {
    const int tl = pair >> 3, hh = pair & 7;
    const size_t tok = (size_t)item * 32 + tl;
    {
      uint2 v = *(const uint2*)(qp_all + tok * 2048 + hh * 256 + lane * 4);
      float* qd = qs + wave * 256 + lane * 4;
      qd[0] = __uint_as_float(v.x << 16);
      qd[1] = __uint_as_float(v.x & 0xffff0000u);
      qd[2] = __uint_as_float(v.y << 16);
      qd[3] = __uint_as_float(v.y & 0xffff0000u);
    }
    __syncthreads();
    float s1a = 0.f, s1b = 0.f, s2a = 0.f, s2b = 0.f;
    const float* qw = qs + wave * 256;
#pragma unroll 4
    for (int d = 0; d < 128; ++d) {
      float q1 = qw[d], q2 = qw[128 + d];
      s1a += q1 * bf2f(k1t[d * 128 + lane]);
      s1b += q1 * bf2f(k1t[d * 128 + lane + 64]);
      s2a += q2 * bf2f(k2t[d * 128 + lane]);
      s2b += q2 * bf2f(k2t[d * 128 + lane + 64]);
    }
    float v1, v2;
    int i1, i2;
    wave_top16(s1a, s1b, lane, lane + 64, lane, v1, i1);
    wave_top16(s2a, s2b, lane, lane + 64, lane, v2, i2);
    const float va = __shfl(v1, lane >> 2);
    float c0 = va + __shfl(v2, (lane & 3) * 4 + 0);
    float c1 = va + __shfl(v2, (lane & 3) * 4 + 1);
    float c2 = va + __shfl(v2, (lane & 3) * 4 + 2);
    float c3 = va + __shfl(v2, (lane & 3) * 4 + 3);
    float vals = 0.f;
    int cisel = 0;
    for (int r = 0; r < 16; ++r) {
      float bv = c0;
      int bi = lane * 4;
      if (c1 > bv) { bv = c1; bi = lane * 4 + 1; }
      if (c2 > bv) { bv = c2; bi = lane * 4 + 2; }
      if (c3 > bv) { bv = c3; bi = lane * 4 + 3; }
#pragma unroll
      for (int off = 32; off >= 1; off >>= 1) {
        float ov = shx(bv, off);
        int oi = shx(bi, off);
        if (ov > bv || (ov == bv && oi < bi)) { bv = ov; bi = oi; }
      }
      if (lane == r) { vals = bv; cisel = bi; }
      if ((bi >> 2) == lane) {
        int j = bi & 3;
        if (j == 0) c0 = -INFINITY;
        else if (j == 1) c1 = -INFINITY;
        else if (j == 2) c2 = -INFINITY;
        else c3 = -INFINITY;
      }
    }
    const int ea = __shfl(i1, (cisel >> 4) & 15);
    const int eb = __shfl(i2, cisel & 15);
    const int e = ea * 128 + eb;
    const float mx = __shfl(vals, 0);
    float ex = (lane < 16) ? expf(vals - mx) : 0.f;
    float sum = wave_sum(ex);
    if (lane < 16) {
      peidx[tok * 128 + hh * 16 + lane] = e;
      peg[tok * 128 + hh * 16 + lane] = ex / sum;
    }
    __syncthreads();
  }
}

DEV void peer_expert_item(const Params& p, int layer, int item, float* sm) {
  const int tid = tidx(), lane = tid & 63, wave = tid >> 6;
  const size_t tok = (size_t)item;
  const int b = (int)(tok / S);
  int* idx = (int*)sm;
  float* gt = sm + 128;
  float* act = sm + 256;
  if (tid < 128) {
    idx[tid] = ((const int*)(p.ws + OFF_PEIDX))[tok * 128 + tid];
    gt[tid] = ((const float*)(p.ws + OFF_PEG))[tok * 128 + tid];
  }
  const bf16* hrow = (const bf16*)(p.ws + OFF_H) + tok * 1024;
  float hw[16];
#pragma unroll
  for (int i = 0; i < 4; ++i) {
    uint2 v = *(const uint2*)(hrow + i * 256 + lane * 4);
    hw[i * 4 + 0] = __uint_as_float(v.x << 16);
    hw[i * 4 + 1] = __uint_as_float(v.x & 0xffff0000u);
    hw[i * 4 + 2] = __uint_as_float(v.y << 16);
    hw[i * 4 + 3] = __uint_as_float(v.y & 0xffff0000u);
  }
  __syncthreads();
  const float* U = p.peer_u + (size_t)layer * NEXP * 1024;
  const float* V = p.peer_v + (size_t)layer * NEXP * 1024;
#pragma unroll 2
  for (int jj = 0; jj < 32; ++jj) {
    int j = wave * 32 + jj;
    const float* ur = U + (size_t)idx[j] * 1024;
    float part = 0.f;
#pragma unroll
    for (int i = 0; i < 4; ++i) {
      float4 u4 = *(const float4*)(ur + i * 256 + lane * 4);
      part += hw[i * 4] * u4.x + hw[i * 4 + 1] * u4.y + hw[i * 4 + 2] * u4.z + hw[i * 4 + 3] * u4.w;
    }
    part = wave_sum(part);
    if (lane == 0) act[j] = gt[j] * gelu_tanh(part);
  }
  __syncthreads();
  float a0 = 0.f, a1 = 0.f, a2 = 0.f, a3 = 0.f;
#pragma unroll 8
  for (int j = 0; j < 128; ++j) {
    float a = act[j];
    float4 v4 = *(const float4*)(V + (size_t)idx[j] * 1024 + tid * 4);
    a0 += a * v4.x; a1 += a * v4.y; a2 += a * v4.z; a3 += a * v4.w;
  }
  const float* ga = (const float*)(p.ws + OFF_MOD) + (layer * 2 + b) * 6144 + 5120 + tid * 4;
  float* xr = p.out + tok * 1024 + tid * 4;
  float4 xo = *(float4*)xr;
  xo.x += ga[0] * a0; xo.y += ga[1] * a1; xo.z += ga[2] * a2; xo.w += ga[3] * a3;
  *(float4*)xr = xo;
  __syncthreads();
}

DEV void pk_scores(const bf16* __restrict__ ktab, const bf16* __restrict__ qp, f32x4 (&s)[8], int g4, int c16) {
  bf16x8 qf[4];
#pragma unroll
  for (int ks = 0; ks < 4; ++ks) qf[ks] = *(const bf16x8*)(qp + ks * 32 + g4 * 8);
#pragma unroll
  for (int mi = 0; mi < 8; ++mi) {
    s[mi] = f32x4{0.f, 0.f, 0.f, 0.f};
#pragma unroll
    for (int ks = 0; ks < 4; ++ks) {
      const bf16x8 kf = *(const bf16x8*)(ktab + (mi * 16 + c16) * 128 + ks * 32 + g4 * 8);
      s[mi] = MFMA16(kf, qf[ks], s[mi]);
    }
  }
}
DEV void pk_top16(f32x4 (&s)[8], int g4, float (&vout)[16], int (&iout)[16]) {
#pragma unroll
  for (int rd = 0; rd < 16; ++rd) {
    float bv = -INFINITY;
    int bi = 1 << 20;
#pragma unroll
    for (int mi = 0; mi < 8; ++mi)
#pragma unroll
      for (int r = 0; r < 4; ++r) {
        const float v = s[mi][r];
        if (v > bv) { bv = v; bi = mi * 16 + g4 * 4 + r; }
      }
#pragma unroll
    for (int off = 16; off <= 32; off <<= 1) {
      const float ov = shx(bv, off);
      const int oi = shx(bi, off);
      if (ov > bv || (ov == bv && oi < bi)) { bv = ov; bi = oi; }
    }
    vout[rd] = bv;
    iout[rd] = bi;
#pragma unroll
    for (int mi = 0; mi < 8; ++mi)
#pragma unroll
      for (int r = 0; r < 4; ++r)
        if (mi * 16 + g4 * 4 + r == bi) s[mi][r] = -INFINITY;
  }
}
DEV void peer_topk_mfma_item(const Params& p, int layer, int item) {
  const int lane = tidx() & 63, wave = tidx() >> 6, g4 = lane >> 4, c16 = lane & 15;
  const size_t tok = (size_t)item * 8 + wave * 2 + (c16 >> 3);
  const int hh = c16 & 7;
  const bf16* qp = (const bf16*)(p.ws + OFF_QP) + tok * 2048 + hh * 256;
  const bf16* k1 = (const bf16*)(p.ws + OFF_PKB) + (size_t)(layer * 2 + 0) * 16384;
  const bf16* k2 = (const bf16*)(p.ws + OFF_PKB) + (size_t)(layer * 2 + 1) * 16384;
  float v1[16], v2[16];
  int i1[16], i2[16];
  {
    f32x4 s[8];
    pk_scores(k1, qp, s, g4, c16);
    pk_top16(s, g4, v1, i1);
  }
  {
    f32x4 s[8];
    pk_scores(k2, qp + 128, s, g4, c16);
    pk_top16(s, g4, v2, i2);
  }
  float v1s[4];
  int i1s[4];
#pragma unroll
  for (int j = 0; j < 4; ++j) {
    v1s[j] = (g4 == 0) ? v1[j] : (g4 == 1) ? v1[4 + j] : (g4 == 2) ? v1[8 + j] : v1[12 + j];
    i1s[j] = (g4 == 0) ? i1[j] : (g4 == 1) ? i1[4 + j] : (g4 == 2) ? i1[8 + j] : i1[12 + j];
  }
  float c0[16], c1[8], c2[5], c3[4];
#pragma unroll
  for (int b = 0; b < 16; ++b) c0[b] = ((4 * g4 + 1) * (b + 1) <= 16) ? v1s[0] + v2[b] : -INFINITY;
#pragma unroll
  for (int b = 0; b < 8; ++b) c1[b] = ((4 * g4 + 2) * (b + 1) <= 16) ? v1s[1] + v2[b] : -INFINITY;
#pragma unroll
  for (int b = 0; b < 5; ++b) c2[b] = ((4 * g4 + 3) * (b + 1) <= 16) ? v1s[2] + v2[b] : -INFINITY;
#pragma unroll
  for (int b = 0; b < 4; ++b) c3[b] = ((4 * g4 + 4) * (b + 1) <= 16) ? v1s[3] + v2[b] : -INFINITY;
  float vals[16];
  int eidx[16];
  const int cbase = g4 * 64;
#pragma unroll
  for (int rd = 0; rd < 16; ++rd) {
    float bv = -INFINITY;
    int bi = 1 << 20;
#pragma unroll
    for (int b = 0; b < 16; ++b) if (c0[b] > bv) { bv = c0[b]; bi = cbase + b; }
#pragma unroll
    for (int b = 0; b < 8; ++b) if (c1[b] > bv) { bv = c1[b]; bi = cbase + 16 + b; }
#pragma unroll
    for (int b = 0; b < 5; ++b) if (c2[b] > bv) { bv = c2[b]; bi = cbase + 32 + b; }
#pragma unroll
    for (int b = 0; b < 4; ++b) if (c3[b] > bv) { bv = c3[b]; bi = cbase + 48 + b; }
#pragma unroll
    for (int off = 16; off <= 32; off <<= 1) {
      const float ov = shx(bv, off);
      const int oi = shx(bi, off);
      if (ov > bv || (ov == bv && oi < bi)) { bv = ov; bi = oi; }
    }
    vals[rd] = bv;
    int e = -1;
#pragma unroll
    for (int b = 0; b < 16; ++b) if (cbase + b == bi) { c0[b] = -INFINITY; e = i1s[0] * 128 + i2[b]; }
#pragma unroll
    for (int b = 0; b < 8; ++b) if (cbase + 16 + b == bi) { c1[b] = -INFINITY; e = i1s[1] * 128 + i2[b]; }
#pragma unroll
    for (int b = 0; b < 5; ++b) if (cbase + 32 + b == bi) { c2[b] = -INFINITY; e = i1s[2] * 128 + i2[b]; }
#pragma unroll
    for (int b = 0; b < 4; ++b) if (cbase + 48 + b == bi) { c3[b] = -INFINITY; e = i1s[3] * 128 + i2[b]; }
    e = max(e, shx(e, 16));
    e = max(e, shx(e, 32));
    eidx[rd] = e;
  }
  float ex[16], sum = 0.f;
#pragma unroll
  for (int rd = 0; rd < 16; ++rd) { ex[rd] = expf(vals[rd] - vals[0]); sum += ex[rd]; }
  const float inv = 1.f / sum;
  if (g4 == 0) {
    int* pi = (int*)(p.ws + OFF_PEIDX) + tok * 128 + hh * 16;
    float* pg = (float*)(p.ws + OFF_PEG) + tok * 128 + hh * 16;
#pragma unroll
    for (int q = 0; q < 4; ++q) {
      *(int4*)(pi + q * 4) = int4{eidx[q * 4], eidx[q * 4 + 1], eidx[q * 4 + 2], eidx[q * 4 + 3]};
      *(float4*)(pg + q * 4) = float4{ex[q * 4] * inv, ex[q * 4 + 1] * inv, ex[q * 4 + 2] * inv, ex[q * 4 + 3] * inv};
    }
  }
}

DEV float pk_key(float v, int inv_idx, unsigned mask) {
  return __uint_as_float((__float_as_uint(v) & ~mask) | (unsigned)inv_idx);
}
DEV void sort32_desc(float (&x)[32]) {
#pragma unroll
  for (int k = 2; k <= 32; k <<= 1)
#pragma unroll
    for (int j = k >> 1; j > 0; j >>= 1)
#pragma unroll
      for (int i = 0; i < 32; ++i) {
        const int l = i ^ j;
        if (l > i) {
          const float a = x[i], b = x[l];
          const float hi = fmaxf(a, b), lo = fminf(a, b);
          if ((i & k) == 0) { x[i] = hi; x[l] = lo; } else { x[i] = lo; x[l] = hi; }
        }
      }
}
DEV void pk_top16_sorted(f32x4 (&s)[8], int g4, float (&vout)[16], int (&iout)[16]) {
  float x[32];
#pragma unroll
  for (int mi = 0; mi < 8; ++mi)
#pragma unroll
    for (int r = 0; r < 4; ++r) x[mi * 4 + r] = pk_key(s[mi][r], 127 - (mi * 16 + g4 * 4 + r), 0x7Fu);
  sort32_desc(x);
#pragma unroll
  for (int rd = 0; rd < 16; ++rd) {
    float w = x[0];
    w = fmaxf(w, shx(w, 16));
    w = fmaxf(w, shx(w, 32));
    vout[rd] = w;
    iout[rd] = 127 - (int)(__float_as_uint(w) & 0x7Fu);
    if (x[0] == w) {
#pragma unroll
      for (int i = 0; i < 15; ++i) x[i] = x[i + 1];
      x[15] = -INFINITY;
    }
  }
}
template <int N>
DEV void shift_row(float (&c)[N], int (&e)[N]) {
#pragma unroll
  for (int i = 0; i + 1 < N; ++i) { c[i] = c[i + 1]; e[i] = e[i + 1]; }
  c[N - 1] = -INFINITY;
}
DEV void peer_topk_item3(const Params& p, int layer, int item, int* lds_idx = nullptr, float* lds_gate = nullptr) {
  const int lane = tidx() & 63, wave = tidx() >> 6, g4 = lane >> 4, c16 = lane & 15;
  const size_t tok = (size_t)item * 8 + wave * 2 + (c16 >> 3);
  const int hh = c16 & 7;
  const bf16* qp = (const bf16*)(p.ws + OFF_QP) + tok * 2048 + hh * 256;
  const bf16* k1 = (const bf16*)(p.ws + OFF_PKB) + (size_t)(layer * 2 + 0) * 16384;
  const bf16* k2 = (const bf16*)(p.ws + OFF_PKB) + (size_t)(layer * 2 + 1) * 16384;
  float v1[16], v2[16];
  int i1[16], i2[16];
  {
    f32x4 s[8];
    pk_scores(k1, qp, s, g4, c16);
    pk_top16_sorted(s, g4, v1, i1);
  }
  {
    f32x4 s[8];
    pk_scores(k2, qp + 128, s, g4, c16);
    pk_top16_sorted(s, g4, v2, i2);
  }
  float v1s[4];
  int i1s[4];
#pragma unroll
  for (int j = 0; j < 4; ++j) {
    v1s[j] = (g4 == 0) ? v1[j] : (g4 == 1) ? v1[4 + j] : (g4 == 2) ? v1[8 + j] : v1[12 + j];
    i1s[j] = (g4 == 0) ? i1[j] : (g4 == 1) ? i1[4 + j] : (g4 == 2) ? i1[8 + j] : i1[12 + j];
  }
  float c0[16], c1[8], c2[5], c3[4];
  int e0[16], e1[8], e2[5], e3[4];
  const int cbase = g4 * 64;
#pragma unroll
  for (int b = 0; b < 16; ++b) {
    c0[b] = ((4 * g4 + 1) * (b + 1) <= 16) ? pk_key(v1s[0] + v2[b], 255 - (cbase + b), 0xFFu) : -INFINITY;
    e0[b] = i1s[0] * 128 + i2[b];
  }
#pragma unroll
  for (int b = 0; b < 8; ++b) {
    c1[b] = ((4 * g4 + 2) * (b + 1) <= 16) ? pk_key(v1s[1] + v2[b], 255 - (cbase + 16 + b), 0xFFu) : -INFINITY;
    e1[b] = i1s[1] * 128 + i2[b];
  }
#pragma unroll
  for (int b = 0; b < 5; ++b) {
    c2[b] = ((4 * g4 + 3) * (b + 1) <= 16) ? pk_key(v1s[2] + v2[b], 255 - (cbase + 32 + b), 0xFFu) : -INFINITY;
    e2[b] = i1s[2] * 128 + i2[b];
  }
#pragma unroll
  for (int b = 0; b < 4; ++b) {
    c3[b] = ((4 * g4 + 4) * (b + 1) <= 16) ? pk_key(v1s[3] + v2[b], 255 - (cbase + 48 + b), 0xFFu) : -INFINITY;
    e3[b] = i1s[3] * 128 + i2[b];
  }
  float vals[16];
  int eidx[16];
#pragma unroll
  for (int rd = 0; rd < 16; ++rd) {
    float w = fmaxf(fmaxf(c0[0], c1[0]), fmaxf(c2[0], c3[0]));
    w = fmaxf(w, shx(w, 16));
    w = fmaxf(w, shx(w, 32));
    vals[rd] = w;
    int e = -1;
    if (c0[0] == w) { e = e0[0]; shift_row(c0, e0); }
    if (c1[0] == w) { e = e1[0]; shift_row(c1, e1); }
    if (c2[0] == w) { e = e2[0]; shift_row(c2, e2); }
    if (c3[0] == w) { e = e3[0]; shift_row(c3, e3); }
    e = max(e, shx(e, 16));
    e = max(e, shx(e, 32));
    eidx[rd] = e;
  }
  float ex[16], sum = 0.f;
#pragma unroll
  for (int rd = 0; rd < 16; ++rd) { ex[rd] = expf(vals[rd] - vals[0]); sum += ex[rd]; }
  const float inv = 1.f / sum;
  if (g4 == 0) {
    int* pi = lds_idx ? (lds_idx + (c16 >> 3) * 128 + hh * 16) : ((int*)(p.ws + OFF_PEIDX) + tok * 128 + hh * 16);
    float* pg = lds_gate ? (lds_gate + (c16 >> 3) * 128 + hh * 16) : ((float*)(p.ws + OFF_PEG) + tok * 128 + hh * 16);
#pragma unroll
    for (int q = 0; q < 4; ++q) {
      *(int4*)(pi + q * 4) = int4{eidx[q * 4], eidx[q * 4 + 1], eidx[q * 4 + 2], eidx[q * 4 + 3]};
      *(float4*)(pg + q * 4) = float4{ex[q * 4] * inv, ex[q * 4 + 1] * inv, ex[q * 4 + 2] * inv, ex[q * 4 + 3] * inv};
    }
  }
}

typedef float f32x2_t __attribute__((ext_vector_type(2)));
DEV unsigned pack4_fp8(float a, float b, float c, float d) {
  int p = __builtin_amdgcn_cvt_pk_fp8_f32(a, b, 0, false);
  p = __builtin_amdgcn_cvt_pk_fp8_f32(c, d, p, true);
  return (unsigned)p;
}
DEV void unpack16_fp8(uint4 v, float* f) {
  f32x2_t r;
  r = __builtin_amdgcn_cvt_pk_f32_fp8((int)v.x, false); f[0] = r.x; f[1] = r.y;
  r = __builtin_amdgcn_cvt_pk_f32_fp8((int)v.x, true);  f[2] = r.x; f[3] = r.y;
  r = __builtin_amdgcn_cvt_pk_f32_fp8((int)v.y, false); f[4] = r.x; f[5] = r.y;
  r = __builtin_amdgcn_cvt_pk_f32_fp8((int)v.y, true);  f[6] = r.x; f[7] = r.y;
  r = __builtin_amdgcn_cvt_pk_f32_fp8((int)v.z, false); f[8] = r.x; f[9] = r.y;
  r = __builtin_amdgcn_cvt_pk_f32_fp8((int)v.z, true);  f[10] = r.x; f[11] = r.y;
  r = __builtin_amdgcn_cvt_pk_f32_fp8((int)v.w, false); f[12] = r.x; f[13] = r.y;
  r = __builtin_amdgcn_cvt_pk_f32_fp8((int)v.w, true);  f[14] = r.x; f[15] = r.y;
}
DEV void expert_cvt_item(const Params& p, int layer, int item) {
  const int lane = tidx() & 63, wave = tidx() >> 6;
  const int e = item * 4 + wave;
  unsigned char* dst = (unsigned char*)(p.ws + OFF_E8) + (size_t)e * 2048;
  float* sc = (float*)(p.ws + OFF_ESC) + (size_t)e * 2;
#pragma unroll
  for (int tb = 0; tb < 2; ++tb) {
    const float* src = (tb ? p.peer_v : p.peer_u) + ((size_t)layer * NEXP + e) * 1024 + lane * 16;
    float4 a = *(const float4*)src, b = *(const float4*)(src + 4), c = *(const float4*)(src + 8), d = *(const float4*)(src + 12);
    float mx = fmaxf(fmaxf(fmaxf(fabsf(a.x), fabsf(a.y)), fmaxf(fabsf(a.z), fabsf(a.w))),
                     fmaxf(fmaxf(fabsf(b.x), fabsf(b.y)), fmaxf(fabsf(b.z), fabsf(b.w))));
    mx = fmaxf(mx, fmaxf(fmaxf(fmaxf(fabsf(c.x), fabsf(c.y)), fmaxf(fabsf(c.z), fabsf(c.w))),
                         fmaxf(fmaxf(fabsf(d.x), fabsf(d.y)), fmaxf(fabsf(d.z), fabsf(d.w)))));
#pragma unroll
    for (int o = 32; o >= 1; o >>= 1) mx = fmaxf(mx, shx(mx, o));
    const float s = (mx > 0.f) ? 224.f / mx : 1.f;
    uint4 pk;
    pk.x = pack4_fp8(a.x * s, a.y * s, a.z * s, a.w * s);
    pk.y = pack4_fp8(b.x * s, b.y * s, b.z * s, b.w * s);
    pk.z = pack4_fp8(c.x * s, c.y * s, c.z * s, c.w * s);
    pk.w = pack4_fp8(d.x * s, d.y * s, d.z * s, d.w * s);
    *(uint4*)(dst + tb * 1024 + lane * 16) = pk;
    if (lane == 0) sc[tb] = 1.f / s;
  }
}

DEV float rdlane_f(float v, int l) { return __int_as_float(__builtin_amdgcn_readlane(__float_as_int(v), l)); }
DEV float dot16_f8(const float* hw, uint4 u) {
  float f[16];
  unpack16_fp8(u, f);
  float s = 0.f;
#pragma unroll
  for (int i = 0; i < 16; ++i) s += hw[i] * f[i];
  return s;
}
DEV void axpy16_f8(float* acc, float a, uint4 u) {
  float f[16];
  unpack16_fp8(u, f);
#pragma unroll
  for (int i = 0; i < 16; ++i) acc[i] += a * f[i];
}
#define PE_ROWPTR(idxv, j) (E8 + (size_t)__builtin_amdgcn_readlane(idxv, (j)) * 2048)
#define PE_LOAD8(P, idxv, j0, off)                                                                        \
  P##0 = *(const uint4*)(PE_ROWPTR(idxv, (j0)) + (off)); P##1 = *(const uint4*)(PE_ROWPTR(idxv, (j0) + 1) + (off)); \
  P##2 = *(const uint4*)(PE_ROWPTR(idxv, (j0) + 2) + (off)); P##3 = *(const uint4*)(PE_ROWPTR(idxv, (j0) + 3) + (off)); \
  P##4 = *(const uint4*)(PE_ROWPTR(idxv, (j0) + 4) + (off)); P##5 = *(const uint4*)(PE_ROWPTR(idxv, (j0) + 5) + (off)); \
  P##6 = *(const uint4*)(PE_ROWPTR(idxv, (j0) + 6) + (off)); P##7 = *(const uint4*)(PE_ROWPTR(idxv, (j0) + 7) + (off));
#define PE_DOTSET(P, j0, dv)                                                                              \
  {                                                                                                       \
    const float s0 = wave_sum(dot16_f8(hw, P##0)), s1 = wave_sum(dot16_f8(hw, P##1)),                     \
                s2 = wave_sum(dot16_f8(hw, P##2)), s3 = wave_sum(dot16_f8(hw, P##3)),                     \
                s4 = wave_sum(dot16_f8(hw, P##4)), s5 = wave_sum(dot16_f8(hw, P##5)),                     \
                s6 = wave_sum(dot16_f8(hw, P##6)), s7 = wave_sum(dot16_f8(hw, P##7));                     \
    if (lane == (j0)) dv = s0;                                                                            \
    if (lane == (j0) + 1) dv = s1;                                                                        \
    if (lane == (j0) + 2) dv = s2;                                                                        \
    if (lane == (j0) + 3) dv = s3;                                                                        \
    if (lane == (j0) + 4) dv = s4;                                                                        \
    if (lane == (j0) + 5) dv = s5;                                                                        \
    if (lane == (j0) + 6) dv = s6;                                                                        \
    if (lane == (j0) + 7) dv = s7;                                                                        \
  }
#define PE_AXPYSET(P, j0, av)                                                                             \
  {                                                                                                       \
    axpy16_f8(acc, rdlane_f(av, (j0)), P##0);     axpy16_f8(acc, rdlane_f(av, (j0) + 1), P##1);           \
    axpy16_f8(acc, rdlane_f(av, (j0) + 2), P##2); axpy16_f8(acc, rdlane_f(av, (j0) + 3), P##3);           \
    axpy16_f8(acc, rdlane_f(av, (j0) + 4), P##4); axpy16_f8(acc, rdlane_f(av, (j0) + 5), P##5);           \
    axpy16_f8(acc, rdlane_f(av, (j0) + 6), P##6); axpy16_f8(acc, rdlane_f(av, (j0) + 7), P##7);           \
  }
#define PE_DOT8(idxv, dv)                                                                                 \
  {                                                                                                       \
    uint4 pa0, pa1, pa2, pa3, pa4, pa5, pa6, pa7, pb0, pb1, pb2, pb3, pb4, pb5, pb6, pb7;                 \
    PE_LOAD8(pa, idxv, 0, 0)                                                                              \
    _Pragma("unroll 1") for (int g = 0; g < 4; ++g) {                                                     \
      const int j0 = g * 16;                                                                              \
      PE_LOAD8(pb, idxv, j0 + 8, 0)                                                                       \
      PE_DOTSET(pa, j0, dv)                                                                               \
      if (g < 3) { PE_LOAD8(pa, idxv, j0 + 16, 0) }                                                       \
      PE_DOTSET(pb, j0 + 8, dv)                                                                           \
    }                                                                                                     \
  }
#define PE_AXPY8(idxv, av)                                                                                \
  {                                                                                                       \
    uint4 pa0, pa1, pa2, pa3, pa4, pa5, pa6, pa7, pb0, pb1, pb2, pb3, pb4, pb5, pb6, pb7;                 \
    PE_LOAD8(pa, idxv, 0, 1024)                                                                           \
    _Pragma("unroll 1") for (int g = 0; g < 4; ++g) {                                                     \
      const int j0 = g * 16;                                                                              \
      PE_LOAD8(pb, idxv, j0 + 8, 1024)                                                                    \
      PE_AXPYSET(pa, j0, av)                                                                              \
      if (g < 3) { PE_LOAD8(pa, idxv, j0 + 16, 1024) }                                                    \
      PE_AXPYSET(pb, j0 + 8, av)                                                                          \
    }                                                                                                     \
  }
DEV void peer_expert_tok(const Params& p, int layer, size_t tok, float ga_scale, const int* pi, const float* pg) {
  const int lane = tidx() & 63;
  const int b = (int)(tok / S);
  const int idx_lo = pi[lane], idx_hi = pi[64 + lane];
  const float g_lo = pg[lane], g_hi = pg[64 + lane];
  const float* esc = (const float*)(p.ws + OFF_ESC);
  const float2 sc_lo = *(const float2*)(esc + (size_t)idx_lo * 2), sc_hi = *(const float2*)(esc + (size_t)idx_hi * 2);
  const bf16* hrow = (const bf16*)(p.ws + OFF_H) + tok * 1024 + lane * 16;
  float hw[16];
  unpack8(*(const uint4*)hrow, hw);
  unpack8(*(const uint4*)(hrow + 8), hw + 8);
  const unsigned char* E8 = (const unsigned char*)(p.ws + OFF_E8) + lane * 16;
  float d_lo = 0.f, d_hi = 0.f;
  PE_DOT8(idx_lo, d_lo)
  PE_DOT8(idx_hi, d_hi)
  const float act_lo = g_lo * gelu_tanh(d_lo * sc_lo.x) * sc_lo.y;
  const float act_hi = g_hi * gelu_tanh(d_hi * sc_hi.x) * sc_hi.y;
  float acc[16];
#pragma unroll
  for (int i = 0; i < 16; ++i) acc[i] = 0.f;
  PE_AXPY8(idx_lo, act_lo)
  PE_AXPY8(idx_hi, act_hi)
  const float* ga = (const float*)(p.ws + OFF_MOD) + (layer * 2 + b) * 6144 + 5120 + lane * 16;
  float* xr = p.out + tok * 1024 + lane * 16;
  float xn[16];
  float ss = 0.f;
#pragma unroll
  for (int q4 = 0; q4 < 4; ++q4) {
    float4 xo = *(float4*)(xr + q4 * 4);
    const float4 g4v = *(const float4*)(ga + q4 * 4);
    xo.x += ga_scale * g4v.x * acc[q4 * 4 + 0];
    xo.y += ga_scale * g4v.y * acc[q4 * 4 + 1];
    xo.z += ga_scale * g4v.z * acc[q4 * 4 + 2];
    xo.w += ga_scale * g4v.w * acc[q4 * 4 + 3];
    xn[q4 * 4] = xo.x; xn[q4 * 4 + 1] = xo.y; xn[q4 * 4 + 2] = xo.z; xn[q4 * 4 + 3] = xo.w;
    ss += xo.x * xo.x + xo.y * xo.y + xo.z * xo.z + xo.w * xo.w;
  }
#if PROBE_ANY || REP_MASK
#pragma unroll
  for (int q4 = 0; q4 < 4; ++q4)
    *(float4*)(xr + q4 * 4) = float4{xn[q4 * 4], xn[q4 * 4 + 1], xn[q4 * 4 + 2], xn[q4 * 4 + 3]};
  return;
#endif
  ss = wave_sum(ss);
  const float rn = 1.0f / sqrtf(ss * (1.0f / 1024.f) + 1e-6f);
  if (layer == 0) {
    const float* gn = p.g_attn + 1024 + lane * 16;
    const float* md = (const float*)(p.ws + OFF_MOD) + (2 + b) * 6144 + lane * 16;
    unsigned char* hq = (unsigned char*)(p.ws + OFF_H8) + tok * 1024 + lane * 16;
    float o[16];
    float mx = 0.f;
#pragma unroll
    for (int q4 = 0; q4 < 4; ++q4) {
      *(float4*)(xr + q4 * 4) = float4{xn[q4 * 4], xn[q4 * 4 + 1], xn[q4 * 4 + 2], xn[q4 * 4 + 3]};
      const float4 g4v = *(const float4*)(gn + q4 * 4);
      const float4 s4 = *(const float4*)(md + 1024 + q4 * 4);
      const float4 h4 = *(const float4*)(md + q4 * 4);
      o[q4 * 4] = xn[q4 * 4] * rn * g4v.x * (1.f + s4.x) + h4.x;
      o[q4 * 4 + 1] = xn[q4 * 4 + 1] * rn * g4v.y * (1.f + s4.y) + h4.y;
      o[q4 * 4 + 2] = xn[q4 * 4 + 2] * rn * g4v.z * (1.f + s4.z) + h4.z;
      o[q4 * 4 + 3] = xn[q4 * 4 + 3] * rn * g4v.w * (1.f + s4.w) + h4.w;
      mx = fmaxf(mx, fmaxf(fmaxf(fabsf(o[q4 * 4]), fabsf(o[q4 * 4 + 1])), fmaxf(fabsf(o[q4 * 4 + 2]), fabsf(o[q4 * 4 + 3]))));
    }
#pragma unroll
    for (int of = 32; of >= 1; of >>= 1) mx = fmaxf(mx, shx(mx, of));
    const unsigned qe = e8m0_of(mx);
    const float qs = e8m0_inv(qe);
    uint4 pk;
    pk.x = pack4_fp8(o[0] * qs, o[1] * qs, o[2] * qs, o[3] * qs);
    pk.y = pack4_fp8(o[4] * qs, o[5] * qs, o[6] * qs, o[7] * qs);
    pk.z = pack4_fp8(o[8] * qs, o[9] * qs, o[10] * qs, o[11] * qs);
    pk.w = pack4_fp8(o[12] * qs, o[13] * qs, o[14] * qs, o[15] * qs);
    *(uint4*)hq = pk;
    if (lane == 0) ((unsigned char*)(p.ws + OFF_H8S))[tok] = (unsigned char)qe;
  } else {
    const float* gf = p.g_final + lane * 16;
#pragma unroll
    for (int q4 = 0; q4 < 4; ++q4) {
      const float4 g4v = *(const float4*)(gf + q4 * 4);
      *(float4*)(xr + q4 * 4) = float4{xn[q4 * 4] * rn * g4v.x, xn[q4 * 4 + 1] * rn * g4v.y, xn[q4 * 4 + 2] * rn * g4v.z,
                                       xn[q4 * 4 + 3] * rn * g4v.w};
    }
  }
}

DEV void peer_expert_item2(const Params& p, int layer, int item, float ga_scale = 1.f) {
  const size_t tok = (size_t)item * 4 + (tidx() >> 6);
  peer_expert_tok(p, layer, tok, ga_scale, (const int*)(p.ws + OFF_PEIDX) + tok * 128, (const float*)(p.ws + OFF_PEG) + tok * 128);
}
DEV void peer_fused_item(const Params& p, int layer, int item, char* smem) {
  const int wave = tidx() >> 6;
  int* li = (int*)(smem + wave * 2048);
  float* lg = (float*)(smem + wave * 2048 + 1024);
  peer_topk_item3(p, layer, item, li, lg);
  asm volatile("s_waitcnt lgkmcnt(0)" ::: "memory");
  __builtin_amdgcn_wave_barrier();
  const size_t tok0 = (size_t)item * 8 + wave * 2;
  peer_expert_tok(p, layer, tok0, 1.f, li, lg);
  peer_expert_tok(p, layer, tok0 + 1, 1.f, li + 128, lg + 128);
  asm volatile("s_waitcnt lgkmcnt(0)" ::: "memory");
  __builtin_amdgcn_wave_barrier();
}
namespace g8 {
constexpr int BM = 256, BK = 64, HALF = 128, HTB = HALF * BK * 2, STAGE_BYTES = 8 * HTB, NXCD = 8, WGM = 8;
DEV int lds_byte(int r, int c) { const int st = (r >> 4) * 2 + (c >> 5), rr = r & 15, cc = c & 31, ob = rr * 64 + cc * 2; return st * 1024 + (ob ^ (((ob >> 9) & 1) << 5)); }
DEV void stage_rc(int b, int& R, int& C) { const int st = b / 1024, sb = b % 1024, swz = sb ^ (((sb >> 9) & 1) << 5); R = (st >> 1) * 16 + swz / 64; C = (st & 1) * 32 + (swz % 64) / 2; }
DEV int perm32(int rho) { const int n = rho >> 4, i = rho & 15; return 8 * (i >> 2) + 4 * n + (i & 3); }
struct Unit { int pm, pn; };
struct Gemm { const bf16* A; const bf16* Bt; int M, N, K; const unsigned char* sa = nullptr; const unsigned char* sb = nullptr; };
struct StaticOrder {
  int nM, nN, nwg, G, c;
  DEV void init(int M, int N, int G_, int c_) { nM = M / BM; nN = N / BM; nwg = nM * nN; G = G_; c = c_; }
  DEV bool next(int i, Unit& u) const {
    const long L = (long)i * G + c;
    if (L >= nwg) return false;
    int wgid = (int)L;
    { const int q = nwg / NXCD, r = nwg % NXCD, xcd = wgid % NXCD, off = wgid / NXCD; wgid = (xcd < r ? xcd * (q + 1) : r * (q + 1) + (xcd - r) * q) + off; }
    const int nig = WGM * nN, gid = wgid / nig, fm = gid * WGM, gsz = (nM - fm) < WGM ? (nM - fm) : WGM;
    u.pm = fm + ((wgid % nig) % gsz);
    u.pn = (wgid % nig) / gsz;
    return true;
  }
};
typedef int v4i32_t __attribute__((ext_vector_type(4)));
typedef int v8i32_t __attribute__((ext_vector_type(8)));
template <class Epi, bool F8 = false>
DEV void gemm_phase(LAS unsigned char* lds, const Gemm g, const StaticOrder& S, const Epi& E) {
  int tid = threadIdx.x;
  asm volatile("" : "+v"(tid));
  const int wid = __builtin_amdgcn_readfirstlane(tid >> 6), lane = tid & 63, wr = wid >> 2, wc = wid & 3, fr = lane & 15, fq = lane >> 4;
  const int K = g.K, nt = K / BK;
  unsigned voffA[2], voffB[2];
#pragma unroll
  for (int i = 0; i < 2; ++i) {
    int R, C;
    stage_rc(tid * 16 + i * 8192, R, C);
    const int Rb = Epi::PERM ? ((R & ~31) + perm32(R & 31)) : R;
    voffA[i] = (unsigned)(R * K + C) * 2u;
    voffB[i] = (unsigned)(Rb * K + C) * 2u;
  }
  const size_t kstep = (size_t)(BK * 2);
  const size_t hstep = (size_t)HALF * K * 2;
  const size_t tstep = 2 * hstep;
  const unsigned ldsw = (unsigned)wid * 1024u;
  const int aoff = lds_byte(wr * 64 + fr, fq * 8), boff = lds_byte(wc * 32 + fr, fq * 8);
#define PG8_SA(b, h) (((b) * 2 + (h)) * HTB)
#define PG8_SB(b, h) ((4 + (b) * 2 + (h)) * HTB)
#define PG8_STAGE(bufoff, gbase, voff) do { _Pragma("unroll") for (int _i = 0; _i < 2; ++_i) \
    __builtin_amdgcn_global_load_lds((const unsigned*)((const char*)(gbase) + (voff)[_i]), (LAS unsigned*)(lds + (bufoff) + ldsw + _i * 8192), 16, 0, 0); } while (0)
#define PG8_LD8(dst_, addr_) do { const v4i32_t lo_ = *(const LAS v4i32_t*)(addr_), hi_ = *(const LAS v4i32_t*)((addr_) + 1024); \
    dst_ = __builtin_shufflevector(lo_, hi_, 0, 1, 2, 3, 4, 5, 6, 7); } while (0)
#define PG8_LDA(dst, b, h) do { _Pragma("unroll") for (int m = 0; m < 4; ++m) PG8_LD8(dst[m], lds + PG8_SA(b, h) + aoff + m * 2048); } while (0)
#define PG8_LDB(dst, b, h) do { _Pragma("unroll") for (int n = 0; n < 2; ++n) PG8_LD8(dst[n], lds + PG8_SB(b, h) + boff + n * 2048); } while (0)
#define PG8_LO(x) __builtin_bit_cast(bf16x8, __builtin_shufflevector((x), (x), 0, 1, 2, 3))
#define PG8_HI(x) __builtin_bit_cast(bf16x8, __builtin_shufflevector((x), (x), 4, 5, 6, 7))
#define PG8_STR_(x) #x
#define PG8_STR(x) PG8_STR_(x)
#define PG8_MLO_0 0
#define PG8_MLO_1 1
#define PG8_MLO_2 0
#define PG8_MLO_3 1
#define PG8_MHI_0 0
#define PG8_MHI_1 0
#define PG8_MHI_2 1
#define PG8_MHI_3 1
#define PG8_M1(ai, bj, m, n, At, Bt) do { \
    if constexpr (F8) asm volatile("v_mfma_scale_f32_16x16x128_f8f6f4 %0, %1, %2, %0, %3, %4 op_sel:[" PG8_STR(n) "," PG8_STR(PG8_MLO_##m) ",0] op_sel_hi:[" PG8_STR(bj) "," PG8_STR(PG8_MHI_##m) ",0]" \
                                   : "+v"(acc[ai][bj][m][n]) : "v"(Bt[n]), "v"(At[m]), "v"(scB), "v"(scA[ai])); \
    else { acc[ai][bj][m][n] = __builtin_amdgcn_mfma_f32_16x16x32_bf16(PG8_LO(Bt[n]), PG8_LO(At[m]), acc[ai][bj][m][n], 0, 0, 0); \
           acc[ai][bj][m][n] = __builtin_amdgcn_mfma_f32_16x16x32_bf16(PG8_HI(Bt[n]), PG8_HI(At[m]), acc[ai][bj][m][n], 0, 0, 0); } } while (0)
#define PG8_MMA(ai, bj, At, Bt) do { __builtin_amdgcn_s_setprio(1); \
    PG8_M1(ai, bj, 0, 0, At, Bt); PG8_M1(ai, bj, 0, 1, At, Bt); PG8_M1(ai, bj, 1, 0, At, Bt); PG8_M1(ai, bj, 1, 1, At, Bt); \
    PG8_M1(ai, bj, 2, 0, At, Bt); PG8_M1(ai, bj, 2, 1, At, Bt); PG8_M1(ai, bj, 3, 0, At, Bt); PG8_M1(ai, bj, 3, 1, At, Bt); \
    __builtin_amdgcn_s_setprio(0); } while (0)
#define PG8_WAIT_V(n) asm volatile("s_waitcnt vmcnt(" #n ")" ::: "memory")
#define PG8_WAIT_L(n) asm volatile("s_waitcnt lgkmcnt(" #n ")" ::: "memory")
#define PG8_BAR __builtin_amdgcn_s_barrier()
#define PG8_SCHED __builtin_amdgcn_sched_barrier(0)
  Unit cur, nxt;
  int ui = 0;
  if (!S.next(0, cur)) return;
  f32x4 acc[2][2][4][2];
#pragma unroll
  for (int a = 0; a < 2; ++a)
#pragma unroll
    for (int b = 0; b < 2; ++b)
#pragma unroll
      for (int m = 0; m < 4; ++m)
#pragma unroll
        for (int n = 0; n < 2; ++n) acc[a][b][m][n] = (f32x4){0.f, 0.f, 0.f, 0.f};
  v8i32_t At[4], B0[2], B1[2];
  const char* cA = (const char*)g.A + (size_t)cur.pm * tstep;
  const char* cB = (const char*)g.Bt + (size_t)cur.pn * tstep;
  PG8_STAGE(PG8_SB(0, 0), cB, voffB); PG8_STAGE(PG8_SA(0, 0), cA, voffA); PG8_STAGE(PG8_SB(0, 1), cB + hstep, voffB); PG8_STAGE(PG8_SA(0, 1), cA + hstep, voffA);
  if (wr == 1) PG8_BAR;
  PG8_WAIT_V(4); PG8_BAR;
  PG8_STAGE(PG8_SB(1, 0), cB + kstep, voffB); PG8_STAGE(PG8_SA(1, 0), cA + kstep, voffA); PG8_STAGE(PG8_SB(1, 1), cB + hstep + kstep, voffB);
  PG8_WAIT_V(6); PG8_BAR;
  unsigned scA[2] = {0x7f7f7f7fu, 0x7f7f7f7fu}, scB = 0x7f7f7f7fu;
  for (;;) {
    if constexpr (F8) {
      const unsigned char* ta = g.sa + (size_t)cur.pm * BM + wr * 64 + fr;
      const unsigned char* tb = g.sb + (size_t)cur.pn * BM + wc * 32 + 8 * (fr >> 2) + (fr & 3);
      scA[0] = (unsigned)ta[0] | ((unsigned)ta[16] << 8) | ((unsigned)ta[32] << 16) | ((unsigned)ta[48] << 24);
      scA[1] = (unsigned)ta[HALF] | ((unsigned)ta[HALF + 16] << 8) | ((unsigned)ta[HALF + 32] << 16) | ((unsigned)ta[HALF + 48] << 24);
      scB = (unsigned)tb[0] | ((unsigned)tb[4] << 8) | ((unsigned)tb[HALF] << 16) | ((unsigned)tb[HALF + 4] << 24);
    }
    const bool has_next = S.next(ui + 1, nxt);
    const char* nA = has_next ? (const char*)g.A + (size_t)nxt.pm * tstep : cA;
    const char* nB = has_next ? (const char*)g.Bt + (size_t)nxt.pn * tstep : cB;
#pragma unroll 1
    for (int t = 0; t < nt; t += 2) {
      const bool last = (t == nt - 2);
      const char* a1 = cA + (size_t)(t + 1) * kstep;
      const char* a2 = last ? nA : cA + (size_t)(t + 2) * kstep;
      const char* b2 = last ? nB : cB + (size_t)(t + 2) * kstep;
      const char* a3 = a2 + kstep;
      const char* b3 = b2 + kstep;
      PG8_LDB(B0, 0, 0); PG8_SCHED; PG8_LDA(At, 0, 0); PG8_STAGE(PG8_SA(1, 1), a1 + hstep, voffA);
      PG8_WAIT_L(8); PG8_BAR; PG8_WAIT_L(0); PG8_MMA(0, 0, At, B0); PG8_BAR; PG8_SCHED;
      PG8_LDB(B1, 0, 1); PG8_STAGE(PG8_SB(0, 0), b2, voffB);
      PG8_BAR; PG8_WAIT_L(0); PG8_MMA(0, 1, At, B1); PG8_BAR;
      PG8_LDA(At, 0, 1); PG8_STAGE(PG8_SA(0, 0), a2, voffA);
      PG8_BAR; PG8_WAIT_L(0); PG8_MMA(1, 0, At, B0); PG8_BAR; PG8_SCHED;
      PG8_STAGE(PG8_SB(0, 1), b2 + hstep, voffB);
      PG8_WAIT_V(6); PG8_BAR; PG8_MMA(1, 1, At, B1); PG8_BAR;
      PG8_LDB(B0, 1, 0); PG8_SCHED; PG8_LDA(At, 1, 0); PG8_STAGE(PG8_SA(0, 1), a2 + hstep, voffA);
      PG8_WAIT_L(8); PG8_BAR; PG8_WAIT_L(0); PG8_MMA(0, 0, At, B0); PG8_BAR; PG8_SCHED;
      PG8_LDB(B1, 1, 1); PG8_STAGE(PG8_SB(1, 0), b3, voffB);
      PG8_BAR; PG8_WAIT_L(0); PG8_MMA(0, 1, At, B1); PG8_BAR;
      PG8_LDA(At, 1, 1); PG8_STAGE(PG8_SA(1, 0), a3, voffA);
      PG8_BAR; PG8_WAIT_L(0); PG8_MMA(1, 0, At, B0); PG8_BAR; PG8_SCHED;
      PG8_STAGE(PG8_SB(1, 1), b3 + hstep, voffB);
      PG8_WAIT_V(6); PG8_BAR; PG8_MMA(1, 1, At, B1); PG8_BAR;
    }
    if constexpr (F8) asm volatile("s_nop 15\n\ts_nop 15" ::: "memory");
    E(acc, cur, wr, wc, fr, fq);
    if (!has_next) break;
#pragma unroll
    for (int a = 0; a < 2; ++a)
#pragma unroll
      for (int b = 0; b < 2; ++b)
#pragma unroll
        for (int m = 0; m < 4; ++m)
#pragma unroll
          for (int n = 0; n < 2; ++n) acc[a][b][m][n] = (f32x4){0.f, 0.f, 0.f, 0.f};
    cur = nxt; cA = nA; cB = nB; ++ui;
  }
  PG8_WAIT_V(0);
  if (wr == 0) PG8_BAR;
  PG8_BAR;
#undef PG8_SA
#undef PG8_SB
#undef PG8_STAGE
#undef PG8_LDA
#undef PG8_LDB
#undef PG8_MMA
#undef PG8_M1
#undef PG8_LD8
#undef PG8_LO
#undef PG8_HI
#undef PG8_WAIT_V
#undef PG8_WAIT_L
#undef PG8_BAR
#undef PG8_SCHED
}
DEV unsigned cvt2(float lo, float hi) { unsigned r; asm volatile("v_cvt_pk_bf16_f32 %0, %1, %2" : "=v"(r) : "v"(lo), "v"(hi)); return r; }

struct EpiBf16 {
  static constexpr bool PERM = true;
  bf16* O; int ldc;
  DEV void operator()(const f32x4 (&acc)[2][2][4][2], const Unit& u, int wr, int wc, int fr, int fq) const {
    const int row0 = u.pm * BM + wr * 64 + fr, col0 = u.pn * BM + wc * 32 + 8 * fq;
#pragma unroll
    for (int ai = 0; ai < 2; ++ai)
#pragma unroll
      for (int m = 0; m < 4; ++m) {
        bf16* rowp = O + (size_t)(row0 + ai * HALF + m * 16) * ldc + col0;
#pragma unroll
        for (int bj = 0; bj < 2; ++bj) {
          const f32x4 v0 = acc[ai][bj][m][0], v1 = acc[ai][bj][m][1];
          u32x4_t w;
          w.x = cvt2(v0[0], v0[1]); w.y = cvt2(v0[2], v0[3]); w.z = cvt2(v1[0], v1[1]); w.w = cvt2(v1[2], v1[3]);
          *(u32x4_t*)(rowp + bj * HALF) = w;
        }
      }
  }
};
struct EpiResid {
  static constexpr bool PERM = false;
  const float* xin; float* out; const float* ga;
  DEV void operator()(const f32x4 (&acc)[2][2][4][2], const Unit& u, int wr, int wc, int fr, int fq) const {
    const int row0 = u.pm * BM + wr * 64 + fr, col0 = u.pn * BM + wc * 32 + 4 * fq;
    const int b = (u.pm * BM) / S;
    f32x4 gv[2][2];
#pragma unroll
    for (int bj = 0; bj < 2; ++bj)
#pragma unroll
      for (int n = 0; n < 2; ++n) gv[bj][n] = *(const f32x4*)(ga + b * 6144 + col0 + bj * HALF + n * 16);
#pragma unroll
    for (int ai = 0; ai < 2; ++ai)
#pragma unroll
      for (int m = 0; m < 4; ++m) {
        const size_t off = (size_t)(row0 + ai * HALF + m * 16) * 1024 + col0;
#pragma unroll
        for (int bj = 0; bj < 2; ++bj)
#pragma unroll
          for (int n = 0; n < 2; ++n) {
            const f32x4 xv = *(const f32x4*)(xin + off + bj * HALF + n * 16);
            *(f32x4*)(out + off + bj * HALF + n * 16) = xv + gv[bj][n] * acc[ai][bj][m][n];
          }
      }
  }
};
DEV float sig_(float x) { return 1.f / (1.f + __expf(-x)); }
template <bool SECOND>
struct EpiMerge {
  static constexpr bool PERM = true;
  bf16* Y; const bf16* proj; int gcol;
  DEV void operator()(const f32x4 (&acc)[2][2][4][2], const Unit& u, int wr, int wc, int fr, int fq) const {
    const int row0 = u.pm * BM + wr * 64 + fr, col0 = u.pn * BM + wc * 32 + 8 * fq;
#pragma unroll
    for (int ai = 0; ai < 2; ++ai)
#pragma unroll
      for (int m = 0; m < 4; ++m) {
        const size_t row = (size_t)(row0 + ai * HALF + m * 16);
#pragma unroll
        for (int bj = 0; bj < 2; ++bj) {
          const uint4 gq = *(const uint4*)(proj + row * PC + gcol + col0 + bj * HALF);
          float gf[8];
          unpack8(gq, gf);
          const f32x4 v0 = acc[ai][bj][m][0], v1 = acc[ai][bj][m][1];
          float o[8] = {sig_(gf[0]) * v0[0], sig_(gf[1]) * v0[1], sig_(gf[2]) * v0[2], sig_(gf[3]) * v0[3],
                        sig_(gf[4]) * v1[0], sig_(gf[5]) * v1[1], sig_(gf[6]) * v1[2], sig_(gf[7]) * v1[3]};
          bf16* yp = Y + row * 1024 + col0 + bj * HALF;
          if (SECOND) {
            float yf[8];
            unpack8(*(const uint4*)yp, yf);
#pragma unroll
            for (int j = 0; j < 8; ++j) o[j] += yf[j];
          }
          u32x4_t w;
          w.x = cvt2(o[0], o[1]); w.y = cvt2(o[2], o[3]); w.z = cvt2(o[4], o[5]); w.w = cvt2(o[6], o[7]);
          *(u32x4_t*)yp = w;
        }
      }
  }
};
struct EpiInproj {
  static constexpr bool PERM = true;
  char* ws;
  DEV void operator()(const f32x4 (&acc)[2][2][4][2], const Unit& u, int wr, int wc, int fr, int fq) const {
    const int b = (u.pm * BM) / S;
    const float* rope = (const float*)(ws + OFF_ROPE);
#pragma unroll
    for (int bj = 0; bj < 2; ++bj) {
      const int vcb = u.pn * BM + bj * HALF + wc * 32;
      if (vcb >= 4992) continue;
      const int vc0 = vcb & ~63, inh = vcb & 63;
      bf16* dbase; size_t dstride; bool roped = false; bool headmajor = false; int hh = 0, nh = 1;
      if (vc0 < 768) { dbase = (bf16*)(ws + OFF_PROJ) + vc0; dstride = PC; }
      else if (vc0 < 1280) {
        const int seg = (vc0 - 768) >> 7;
        const size_t off = (seg == 0) ? OFF_KSB : (seg == 1) ? OFF_VSB : (seg == 2) ? OFF_KWB : OFF_VWB;
        dbase = (bf16*)(ws + off); dstride = 64; headmajor = true; hh = ((vc0 - 768) >> 6) & 1; nh = 2;
        roped = (seg == 0) || (seg == 2);
      } else if (vc0 < 1792) { dbase = (bf16*)(ws + OFF_PROJ) + C_MQ + (vc0 - 1280); dstride = PC; roped = true; }
      else if (vc0 < 2816) {
        const int seg = (vc0 - 1792) >> 9;
        dbase = (bf16*)(ws + (seg ? OFF_MVB : OFF_MKB)); dstride = 64; headmajor = true; hh = ((vc0 - 1792) >> 6) & 7; nh = 8;
        roped = (seg == 0);
      } else if (vc0 < 4864) { dbase = (bf16*)(ws + OFF_PROJ) + C_GN + (vc0 - 2816); dstride = PC; }
      else { dbase = (bf16*)(ws + OFF_PROJ) + C_NG + (vc0 - 4864); dstride = PC; }
      const bool do_rope = roped && inh == 0;
#pragma unroll
      for (int ai = 0; ai < 2; ++ai)
#pragma unroll
        for (int m = 0; m < 4; ++m) {
          const int row = u.pm * BM + ai * HALF + wr * 64 + m * 16 + fr;
          const int t = row - b * S;
          const f32x4 v0 = acc[ai][bj][m][0], v1 = acc[ai][bj][m][1];
          float o[8] = {v0[0], v0[1], v0[2], v0[3], v1[0], v1[1], v1[2], v1[3]};
          if (do_rope) {
            float pv[8];
#pragma unroll
            for (int j = 0; j < 8; ++j) pv[j] = shx(o[j], 16);
            const f32x4 c0 = *(const f32x4*)(rope + (size_t)t * 16), c1 = *(const f32x4*)(rope + (size_t)t * 16 + 4);
            const f32x4 s0 = *(const f32x4*)(rope + (size_t)t * 16 + 8), s1 = *(const f32x4*)(rope + (size_t)t * 16 + 12);
            const float cs[8] = {c0[0], c0[1], c0[2], c0[3], c1[0], c1[1], c1[2], c1[3]};
            const float sn[8] = {s0[0], s0[1], s0[2], s0[3], s1[0], s1[1], s1[2], s1[3]};
            const float sg = (fq == 0) ? -1.f : 1.f;
#pragma unroll
            for (int j = 0; j < 8; ++j) o[j] = (fq < 2) ? (o[j] * cs[j] + sg * pv[j] * sn[j]) : o[j];
          }
          bf16* dp = headmajor ? (dbase + ((size_t)(b * nh + hh) * S + t) * 64 + inh + 8 * fq)
                               : (dbase + (size_t)row * dstride + inh + 8 * fq);
          u32x4_t w;
          w.x = cvt2(o[0], o[1]); w.y = cvt2(o[2], o[3]); w.z = cvt2(o[4], o[5]); w.w = cvt2(o[6], o[7]);
          *(u32x4_t*)dp = w;
        }
    }
  }
};
}

template <class F>
DEV void for_tiles_xcd(int MT, int NT, F f) {
  const int nb = vnb(), bid = vbid();
  if ((nb & 15) != 0) {
    for (int it = bid; it < MT * NT; it += nb) f(it / NT, it % NT);
    return;
  }
  const int xcd = (bid >> 1) & 7, slot = ((bid >> 4) << 1) | (bid & 1), nslot = nb >> 3;
  const int nj = (NT - xcd + 7) >> 3;
  for (int q = slot; q < MT * nj; q += nslot) f(q / nj, xcd + 8 * (q % nj));
}
constexpr int PH_PER_LAYER = 15;
enum { SP_NORM1 = 0, SP_INPROJ = 1, SP_COMPRESS = 2, SP_KMEAN = 3, SP_ATTN = 4, SP_MP0 = 5, SP_MM0 = 6, SP_MP1 = 7, SP_MM1 = 8,
       SP_MERGE = 9, SP_OUTPROJ = 10, SP_NORM2 = 11, SP_PEERQ = 12, SP_TOPK = 13, SP_EXPERT = 14 };
constexpr int N_REAL_PHASES = 1 + 2 * PH_PER_LAYER + 1;
constexpr int N_PHASES = N_REAL_PHASES + (PROBE_ANY ? 2 : 0);

DEV void run_phase(const Params& p, int ph, char* smem_raw, bool second_pass = false) {
#define SKIP_MOBA_SECOND (REP_NSA_ONLY && second_pass)
  LAS unsigned char* lds_all = (LAS unsigned char*)smem_raw;
  smem_raw += hidx() * SMEM_BYTES;
  float* smf = (float*)smem_raw;
  bf16* smh = (bf16*)smem_raw;
  const int nb = vnb(), bid = vbid();
  if (ph == 0) {
    for (int it = bid; it < PREP_ITEMS; it += nb) prep_item(p, it, smf);
    return;
  }
  if (ph == N_REAL_PHASES - 1) {
    for (int it = bid; it < T / 4; it += nb) final_norm_item(p.out, p.g_final, it);
    return;
  }
#if PROBE_ANY
  if (ph == N_REAL_PHASES) {
#if PROBE_PROJ
    {
      const unsigned char* Hh = (const unsigned char*)(p.ws + OFF_H8);
      const unsigned char* Wt = (const unsigned char*)(p.ws + OFF_WINT) + (size_t)1 * WN * 1024;
      const unsigned char* hsc = (const unsigned char*)(p.ws + OFF_H8S);
      const unsigned char* wsc = (const unsigned char*)(p.ws + OFF_WCS) + WN;
      const float* rope = (const float*)(p.ws + OFF_ROPE);
      float sd = 0.f, sr = 0.f;
      for (size_t i = (size_t)bid * 256 + tidx(); i < (size_t)(T / 64) * 4888; i += (size_t)nb * 256) {
        const int ts = (int)(i / 4888), vc = (int)(i % 4888);
        const int tok = ts * 64 + (ts % 61);
        const int b = tok / S, t = tok % S;
        auto rawdot = [&](int col) {
          float a = 0.f;
          for (int k = 0; k < 1024; ++k) {
            const f32x2_t hv = __builtin_amdgcn_cvt_pk_f32_fp8((int)Hh[(size_t)tok * 1024 + k], false);
            const f32x2_t wv = __builtin_amdgcn_cvt_pk_f32_fp8((int)Wt[(size_t)col * 1024 + k], false);
            a += hv.x * wv.x;
          }
          return a * __int_as_float((int)hsc[tok] << 23) * __int_as_float((int)wsc[col] << 23);
        };
        float v = rawdot(vc);
        bool roped = false;
        const bf16* dst;
        if (vc < 768) dst = (const bf16*)(p.ws + OFF_PROJ) + (size_t)tok * PC + vc;
        else if (vc < 1280) {
          const int seg = (vc - 768) >> 7, head = ((vc - 768) >> 6) & 1, d = vc & 63;
          const size_t off = (seg == 0) ? OFF_KSB : (seg == 1) ? OFF_VSB : (seg == 2) ? OFF_KWB : OFF_VWB;
          dst = (const bf16*)(p.ws + off) + ((size_t)(b * 2 + head) * S + t) * 64 + d;
          roped = (seg == 0 || seg == 2);
        } else if (vc < 1792) { dst = (const bf16*)(p.ws + OFF_PROJ) + (size_t)tok * PC + C_MQ + (vc - 1280); roped = true; }
        else if (vc < 2816) {
          const int seg = (vc - 1792) >> 9, head = ((vc - 1792) >> 6) & 7, d = vc & 63;
          dst = (const bf16*)(p.ws + (seg ? OFF_MVB : OFF_MKB)) + ((size_t)(b * 8 + head) * S + t) * 64 + d;
          roped = (seg == 0);
        } else if (vc < 4864) dst = (const bf16*)(p.ws + OFF_PROJ) + (size_t)tok * PC + C_GN + (vc - 2816);
        else dst = (const bf16*)(p.ws + OFF_PROJ) + (size_t)tok * PC + C_NG + (vc - 4864);
        const int d = vc & 63;
        if (roped && d < 16) {
          const float cs = rope[(size_t)t * 16 + (d & 7)], sn = rope[(size_t)t * 16 + 8 + (d & 7)];
          if (d < 8) { const float x2 = rawdot(vc + 8); v = v * cs - x2 * sn; }
          else { const float x1 = rawdot(vc - 8); v = v * cs + x1 * sn; }
        }
        const float got = bf2f(*dst);
        const bool is_r = roped && d < 16;
        if (PROBE_PROJ == 1 || (PROBE_PROJ == 2 && is_r) || (PROBE_PROJ == 3 && !is_r)) {
          sd += (got - v) * (got - v);
          sr += v * v;
        }
      }
      sd = wave_sum(sd); sr = wave_sum(sr);
      if ((tidx() & 63) == 0) {
        atomicAdd((float*)(p.ws + OFF_PROBE), sd);
        atomicAdd((float*)(p.ws + OFF_PROBE) + 1, sr);
      }
    }
#endif
#if PROBE_CMPR
    {
      float sd = 0.f, sr = 0.f;
      for (size_t i = (size_t)bid * 256 + tidx(); i < (size_t)2 * Bn * 1024 * 128; i += (size_t)nb * 256) {
        const size_t wh = i / ((size_t)Bn * 1024 * 128), r = i % ((size_t)Bn * 1024 * 128);
        const int c = (int)((r / 128) % 1024);
        if (c < 1023) {
          const float a = ((const float*)(p.ws + (wh ? OFF_VCC : OFF_KCC)))[r];
          const float y = ((const float*)(p.ws + OFF_CMP))[i];
          sd += (a - y) * (a - y);
          sr += y * y;
        }
      }
      sd = wave_sum(sd); sr = wave_sum(sr);
      if ((tidx() & 63) == 0) {
        atomicAdd((float*)(p.ws + OFF_PROBE), sd);
        atomicAdd((float*)(p.ws + OFF_PROBE) + 1, sr);
      }
    }
#endif
#if PROBE_MOBA
    probe_accum_bf16(p, (const bf16*)(p.ws + OFF_OMOBA), (const bf16*)(p.ws + OFF_CMP), (size_t)S * 512, smf);
#endif
#if PROBE_NSA == 8
    {
      const float* impn = (const float*)(p.ws + OFF_OMOBA);
      const float* impm = impn + (size_t)S * 256;
      const int* seld = (const int*)(p.ws + OFF_CMP);
      float sd = 0.f, sr = 0.f, bad = 0.f;
      for (int t = bid * 256 + tidx(); t < S; t += nb * 256) {
        const int cur = t >> 6;
        for (int n = 0; n < 256; ++n) {
          float a = impm[(size_t)t * 256 + n], r = impn[(size_t)t * 256 + n];
          sd += (a - r) * (a - r);
          sr += r * r;
        }
        unsigned want[8] = {0, 0, 0, 0, 0, 0, 0, 0}, got[8] = {0, 0, 0, 0, 0, 0, 0, 0};
        for (int j = 0; j < 16; ++j) {
          int v = seld[(size_t)t * 16 + j];
          if (v >= 0 && v < 256) {
            for (int w = 0; w < 8; ++w) if ((v >> 5) == w) got[w] |= 1u << (v & 31);
          }
        }
        if (cur < 16) {
          for (int n = 0; n <= cur; ++n) want[0] |= 1u << n;
        } else {
          want[0] |= 1u;
          for (int w = 0; w < 8; ++w) {
            if (((cur - 1) >> 5) == w) want[w] |= 1u << ((cur - 1) & 31);
            if ((cur >> 5) == w) want[w] |= 1u << (cur & 31);
          }
          for (int j = 0; j < 13; ++j) {
            float best = -1.f;
            int bi = 1;
            for (int n = 1; n <= cur - 2; ++n) {
              bool taken = false;
              for (int w = 0; w < 8; ++w) if ((n >> 5) == w) taken = (want[w] >> (n & 31)) & 1u;
              float v = impm[(size_t)t * 256 + n];
              if (!taken && v > best) { best = v; bi = n; }
            }
            for (int w = 0; w < 8; ++w) if ((bi >> 5) == w) want[w] |= 1u << (bi & 31);
          }
        }
        bool same = true;
        for (int w = 0; w < 8; ++w) same = same && (want[w] == got[w]);
        if (!same) bad += 1.f;
      }
      sd = wave_sum(sd); sr = wave_sum(sr); bad = wave_sum(bad);
      if ((tidx() & 63) == 0) {
        atomicAdd((float*)(p.ws + OFF_PROBE), sd);
        atomicAdd((float*)(p.ws + OFF_PROBE) + 1, sr);
        atomicAdd((float*)(p.ws + OFF_PROBE) + 2, bad);
      }
    }
#elif PROBE_NSA
    probe_accum_bf16(p, (const bf16*)(p.ws + OFF_ONSA), (const bf16*)(p.ws + OFF_CMP), (size_t)S * 512, smf);
#endif
    return;
  }
  if (ph == N_REAL_PHASES + 1) {
    probe_apply(p);
    return;
  }
#endif
  const int layer = (ph - 1) / PH_PER_LAYER, sub = (ph - 1) % PH_PER_LAYER;
  const float* mod = (const float*)(p.ws + OFF_MOD) + (size_t)layer * 2 * 6144;
  const float* xin = (layer == 0) ? p.x : p.out;
  bf16* H = (bf16*)(p.ws + OFF_H);
  bf16* PROJ = (bf16*)(p.ws + OFF_PROJ);
#if PROBE_ANY
  if (sub >= SP_MERGE) {
    if (sub == SP_OUTPROJ && layer == 0)
      for (size_t i = (size_t)bid * 256 + tidx(); i < (size_t)T * 1024; i += (size_t)nb * 256) p.out[i] = p.x[i];
    return;
  }
#endif
  switch (sub) {
    case SP_NORM1:
      for (int it = bid; it < T / 4; it += nb)
        norm8_item(xin, p.g_attn + layer * 1024, mod + 1024, mod + 0, (unsigned char*)(p.ws + OFF_H8), (unsigned char*)(p.ws + OFF_H8S), it);
      if (layer == 0)
        for (int it = bid; it < WQ8_ITEMS; it += nb) wq8_item(p, it, smf);
      break;
    case SP_INPROJ: {
      g8::StaticOrder so;
      so.init(T, WN, (int)gridDim.x, (int)blockIdx.x);
      g8::gemm_phase<g8::EpiInproj, true>(lds_all, g8::Gemm{(const bf16*)(p.ws + OFF_H8), (const bf16*)(p.ws + OFF_WINT + (size_t)layer * WN * 1024), T, WN, 512,
                                                             (const unsigned char*)(p.ws + OFF_H8S), (const unsigned char*)(p.ws + OFF_WCS) + (size_t)layer * WN},
                                          so, g8::EpiInproj{p.ws});
    } break;
    case SP_COMPRESS:
      for (int it = bid; it < 512 + 1024 + 256; it += nb) {
        if (it < 512) compress_mfma_item(p, layer, it, smem_raw);
        else if (it < 1536) kmean_item(p, it - 512, smf);
        else kvamax_item(p, layer, it - 1536);
      }
#if PROBE_CMPR
      if (layer == 1)
        for (int it = bid; it < 1024; it += nb) compress_item(p, layer, it, smf);
#endif
      break;
    case SP_KMEAN:
      for (int it = bid; it < 1024; it += nb) kvq_item(p, layer, it, smf);
#if PROBE_NSA
      if (layer == 1)
        for (int it = bid; it < 512; it += nb) n1_item(p, layer, it, smf);
#endif
      break;
    case SP_ATTN:
      {
        constexpr int MNI = 2;
        constexpr int NMOBA = 16 * (S / (64 * MNI));
        constexpr int NNI = 2;
        constexpr int NNSA = 4 * (S / (16 * NNI));
        const bool do_nsa = !PROBE_ANY || PROBE_NSA, do_moba = (!PROBE_ANY || PROBE_MOBA) && PROBE_NSA != 8;
        {
          constexpr int NCH = S / (16 * NNI);
          const bool affine = nb >= 8;
          const int grp = bid & 7, bk = grp & 3, sub = grp >> 2;
          const int i0 = affine ? (bid >> 3) : bid;
          const int istride = affine ? ((nb - grp + 7) >> 3) : nb;
          const int icount = affine ? (NCH / 2) : NNSA;
          if (do_nsa)
            for (int i = i0; i < icount; i += istride)
              nsa_item<NNI>(p, layer, affine ? (((2 * i + sub) << 2) | bk) : i, smem_raw, (bf16*)(p.ws + OFF_ONSA));
          if (do_moba && !SKIP_MOBA_SECOND)
          {
            const int ngi = (NMOBA - (bid & ~1) + nb - 1) / nb;
            for (int j0 = 0; j0 < ngi; j0 += 4) {
              const int first = bid + j0 * nb;
              int nit = ngi - j0 < 4 ? ngi - j0 : 4;
              while (nit > 0 && first + (nit - 1) * nb >= NMOBA) --nit;
              moba_gate_batch<MNI>(p, first, nb, nit, (int*)smf);
            }
          }
        }
#if PROBE_NSA && PROBE_NSA != 8
        if (layer == 1)
          for (int it = bid; it < 512; it += nb) n23_item(p, layer, it);
#endif
#if PROBE_MOBA
        if (layer == 1) {
          for (int it = bid; it < 512; it += nb) moba_item(p, layer, it);
        }
#endif
      }
      break;
    case SP_MP0:
    case SP_MP1:
      if ((!PROBE_ANY || PROBE_MOBA) && PROBE_NSA != 8)
        for (int it = bid; it < 8 * 63 * 8; it += nb) moba_part_item2<2>(p, sub == SP_MP1 ? 1 : 0, it, smem_raw);
      break;
    case SP_MM0:
    case SP_MM1:
      if ((!PROBE_ANY || PROBE_MOBA) && PROBE_NSA != 8)
        for (int it = bid; it < 8 * (S / 128); it += nb)
          moba_merge_item<2>(p, sub == SP_MM1 ? 1 : 0, it, smem_raw, (bf16*)(p.ws + OFF_OMOBA));
      break;
    case SP_MERGE:
      {
        g8::StaticOrder so;
        so.init(T, 1024, (int)gridDim.x, (int)blockIdx.x);
        g8::gemm_phase(lds_all, g8::Gemm{(const bf16*)(p.ws + OFF_ONSA), (const bf16*)(p.ws + OFF_WUPN) + (size_t)layer * 1024 * 512, T, 1024, 512}, so,
                       g8::EpiMerge<false>{H, PROJ, C_GN});
        g8::gemm_phase(lds_all, g8::Gemm{(const bf16*)(p.ws + OFF_OMOBA), (const bf16*)(p.ws + OFF_WUPM) + (size_t)layer * 1024 * 512, T, 1024, 512}, so,
                       g8::EpiMerge<true>{H, PROJ, C_GM});
      }
      break;
    case SP_OUTPROJ: {
      const bf16* W = (const bf16*)(p.ws + OFF_WOUT) + (size_t)layer * 1024 * 1024;
      const float* ga1 = mod + 2048;
      g8::StaticOrder so;
      so.init(T, 1024, (int)gridDim.x, (int)blockIdx.x);
      g8::gemm_phase(lds_all, g8::Gemm{H, W, T, 1024, 1024}, so, g8::EpiResid{xin, p.out, ga1});
    } break;
    case SP_NORM2:
      for (int it = bid; it < T / 4 + NEXP / 4; it += nb) {
        if (it < T / 4) norm_item(p.out, p.g_ffn + layer * 1024, mod + 4096, mod + 3072, H, it);
        else expert_cvt_item(p, layer, it - T / 4);
      }
      break;
    case SP_PEERQ: {
      const bf16* W = (const bf16*)(p.ws + OFF_WQ) + (size_t)layer * 2048 * 1024;
      bf16* QP = (bf16*)(p.ws + OFF_QP);
      g8::StaticOrder so;
      so.init(T, 2048, (int)gridDim.x, (int)blockIdx.x);
      g8::gemm_phase(lds_all, g8::Gemm{H, W, T, 2048, 1024}, so, g8::EpiBf16{QP, 2048});
    } break;
    case SP_TOPK:
#if REP_MASK
      for (int it = bid; it < T / 8; it += nb) peer_topk_item3(p, layer, it);
#endif
      break;
    case SP_EXPERT:
#if REP_MASK
      for (int it = bid; it < T / 4; it += nb) peer_expert_item2(p, layer, it, second_pass ? 0.f : 1.f);
#else
      for (int it = bid; it < T / 8; it += nb) peer_fused_item(p, layer, it, smem_raw);
#endif
      break;
  }
}

#define MEGA_LB __launch_bounds__(512, 2)
__global__ void MEGA_LB mega_kernel(Params p, int ph_lo, int ph_hi) {
  __shared__ __attribute__((aligned(16))) char smem_raw[2 * SMEM_BYTES + 16];
  volatile LAS unsigned* xbst = (volatile LAS unsigned*)(smem_raw + 2 * SMEM_BYTES);
  if (threadIdx.x == 0) { xbst[0] = 0u; xbst[1] = 0u; xbst[2] = 0u; xbst[3] = 0u; }
  __syncthreads();
  XcdBarrier xb = xcd_barrier_post((unsigned*)(p.ws + OFF_BAR), xbst);
  for (int ph = ph_lo; ph < ph_hi; ++ph) {
#if !PROBE_ANY && !REP_MASK
    if (ph == N_REAL_PHASES - 1 || ph == 1 + PH_PER_LAYER || (ph >= 1 && (ph - 1) % PH_PER_LAYER == SP_TOPK))
      continue;
#endif
#if REP_MASK
    const int nrep = (ph >= 1 && ph < N_REAL_PHASES - 1 && ((REP_MASK >> ((ph - 1) % PH_PER_LAYER)) & 1)) ? 2 : 1;
    for (int rep = 0; rep < nrep; ++rep) {
      if (rep) xcd_barrier(xb);
      run_phase(p, ph, smem_raw, rep != 0);
    }
#else
    run_phase(p, ph, smem_raw);
#endif
    if (ph + 1 < ph_hi) {
      if (ph == ph_lo) cg::this_grid().sync();
      else xcd_barrier(xb);
    }
  }
}

extern "C" void kernel_launch(void* const* d_in, const int* in_sizes, int n_in, void* d_out, int out_size, void* d_ws,
                              size_t ws_size, hipStream_t stream) {
  if (ws_size < WS_TOTAL) {
    fprintf(stderr, "workspace too small: %zu < %zu\n", ws_size, (size_t)WS_NEED);
    return;
  }
  Params p{};
  p.x = (const float*)d_in[0]; p.c = (const float*)d_in[1]; p.w_ada = (const float*)d_in[2];
  p.b_ada = (const float*)d_in[3]; p.g_attn = (const float*)d_in[4]; p.g_ffn = (const float*)d_in[5];
  p.w_in = (const float*)d_in[6]; p.cmp_pe = (const float*)d_in[7]; p.cmp_w1 = (const float*)d_in[8];
  p.cmp_w2 = (const float*)d_in[9]; p.w_up_nsa = (const float*)d_in[10]; p.w_up_moba = (const float*)d_in[11];
  p.w_out = (const float*)d_in[12]; p.peer_wq = (const float*)d_in[13]; p.peer_k1 = (const float*)d_in[14];
  p.peer_k2 = (const float*)d_in[15]; p.peer_u = (const float*)d_in[16]; p.peer_v = (const float*)d_in[17];
  p.g_final = (const float*)d_in[18];
  p.out = (float*)d_out;
  p.ws = (char*)d_ws;
  static int grid_blocks = 0;
  if (!grid_blocks) {
    int dev = 0, cus = 0, per_cu = 0;
    hipGetDevice(&dev);
    hipDeviceGetAttribute(&cus, hipDeviceAttributeMultiprocessorCount, dev);
    hipOccupancyMaxActiveBlocksPerMultiprocessor(&per_cu, mega_kernel, 512, 0);
    if (per_cu < 1) per_cu = 1;
    if (per_cu > 1) per_cu = 1;
    grid_blocks = cus * per_cu;
  }
  hipMemsetAsync((char*)d_ws + OFF_BAR, 0, BAR_BYTES, stream);
  int ph_lo = 0, ph_hi = N_PHASES;
  void* args[] = {(void*)&p, (void*)&ph_lo, (void*)&ph_hi};
  hipError_t e = hipLaunchCooperativeKernel((const void*)mega_kernel, dim3(grid_blocks), dim3(512), args, 0, stream);
  if (e != hipSuccess) fprintf(stderr, "cooperative launch failed: %s (grid %d)\n", hipGetErrorString(e), grid_blocks);
}
```

```cpp
#include <hip/hip_runtime.h>
#include <hip/hip_bf16.h>
#include <hip/hip_cooperative_groups.h>
#include <cstdio>
#include <cstdint>
namespace cg = cooperative_groups;

#define DEV __device__ __forceinline__
typedef unsigned short bf16;
using bf16x8 = __attribute__((ext_vector_type(8))) short;
using f32x4 = __attribute__((ext_vector_type(4))) float;

constexpr int Bn = 2, S = 16384, T = Bn * S, D = 1024;
constexpr int PC = 3456;
constexpr int WN = 5120;
constexpr int C_NQ = 0, C_KC = 512, C_VC = 640, C_MQ = 768, C_GN = 1280, C_GM = 2304, C_NG = 3328;
constexpr int NEXP = 16384;

constexpr size_t al(size_t x) { return (x + 255) & ~size_t(255); }
constexpr size_t OFF_MOD = 0;
constexpr size_t OFF_ROPE = al(OFF_MOD + 2 * 2 * 6144 * 4);
constexpr size_t OFF_PEB = al(OFF_ROPE + (size_t)S * 16 * 4);
constexpr size_t OFF_WINT = al(OFF_PEB + 2 * 2 * 128 * 4);
constexpr size_t OFF_WUPN = al(OFF_WINT + 2ull * WN * 1024 * 2);
constexpr size_t OFF_WUPM = al(OFF_WUPN + 2ull * 1024 * 512 * 2);
constexpr size_t OFF_WOUT = al(OFF_WUPM + 2ull * 1024 * 512 * 2);
constexpr size_t OFF_WQ = al(OFF_WOUT + 2ull * 1024 * 1024 * 2);
constexpr size_t OFF_KCC = al(OFF_WQ + 2ull * 2048 * 1024 * 2);
constexpr size_t OFF_VCC = al(OFF_KCC + 2ull * 1024 * 128 * 4);
constexpr size_t OFF_SEL = al(OFF_VCC + 2ull * 1024 * 128 * 4);
constexpr size_t OFF_KMEAN = al(OFF_SEL + 2ull * 2 * S * 16 * 4);
constexpr size_t OFF_KMHL = al(OFF_KMEAN + 2ull * 8 * 64 * 64 * 4);
constexpr size_t OFF_KCB = al(OFF_KMHL + 2ull * 2 * 8 * 64 * 64 * 2);
constexpr size_t OFF_VCB = al(OFF_KCB + 2ull * 2 * 1024 * 64 * 2);
constexpr size_t OFF_PKB = al(OFF_VCB + 2ull * 2 * 1024 * 64 * 2);
constexpr size_t OFF_W1T = al(OFF_PKB + 2ull * 2 * 128 * 128 * 2);
constexpr size_t OFF_BAR = al(OFF_W1T + 4ull * 128 * 2048 * 2);
constexpr size_t BAR_BYTES = 3456 * 4;
constexpr size_t OFF_PROBE = al(OFF_BAR + BAR_BYTES);
constexpr size_t OFF_H = al(OFF_PROBE + 256);
constexpr size_t OFF_WCS = OFF_WINT + 2ull * WN * 1024;
constexpr size_t OFF_ONSA = al(OFF_H + (size_t)T * 1024 * 2);
constexpr size_t OFF_OMOBA = al(OFF_ONSA + (size_t)T * 512 * 2);
constexpr size_t OFF_H8 = OFF_ONSA;
constexpr size_t OFF_H8S = OFF_OMOBA;
constexpr size_t OFF_PROJ = al(OFF_OMOBA + (size_t)T * 512 * 2);
constexpr size_t KV2_BYTES = (size_t)Bn * 2 * S * 64 * 2, KV8_BYTES = (size_t)Bn * 8 * S * 64 * 2;
constexpr size_t OFF_KSB = al(OFF_PROJ + (size_t)T * PC * 2);
constexpr size_t OFF_VSB = OFF_KSB + KV2_BYTES;
constexpr size_t OFF_KWB = OFF_VSB + KV2_BYTES;
constexpr size_t OFF_VWB = OFF_KWB + KV2_BYTES;
constexpr size_t OFF_MKB = OFF_VWB + KV2_BYTES;
constexpr size_t OFF_MVB = OFF_MKB + KV8_BYTES;
constexpr int MLIST_PER_BH = 63 * S - 128 * 63 * 64;
constexpr size_t OFF_MLIST = OFF_MVB + KV8_BYTES;
constexpr int MCNT_STRIDE = 32;
constexpr size_t OFF_MCNT = al(OFF_MLIST + (size_t)Bn * 8 * MLIST_PER_BH * 2);
constexpr size_t OFF_KS8 = al(OFF_MCNT + (size_t)Bn * 8 * 64 * 4 * MCNT_STRIDE);
constexpr size_t OFF_VT8 = OFF_KS8 + (size_t)Bn * 2 * S * 64;
constexpr size_t WS_NEED = OFF_VT8 + (size_t)Bn * 2 * S * 64;
constexpr size_t PROJ_BYTES = (size_t)T * PC * 2;
constexpr size_t OFF_MPO = OFF_H;
constexpr size_t OFF_MPML = OFF_H + (size_t)8 * S * 3 * 64 * 2;
static_assert((size_t)8 * S * 3 * 64 * 2 + (size_t)8 * S * 3 * 8 <= (size_t)T * 1024 * 2, "moba partials must fit the H region");
constexpr size_t OFF_QP = OFF_PROJ;
constexpr size_t OFF_PEIDX = al(OFF_QP + (size_t)T * 2048 * 2);
constexpr size_t OFF_PEG = al(OFF_PEIDX + (size_t)T * 128 * 4);
constexpr size_t OFF_E8 = al(OFF_PEG + (size_t)T * 128 * 4);
constexpr size_t OFF_ESC = al(OFF_E8 + (size_t)NEXP * 2048);
static_assert(OFF_ESC + (size_t)NEXP * 2 * 4 <= OFF_PROJ + PROJ_BYTES, "peer alias overflow");
static_assert(WS_NEED <= 536870912ull, "workspace too big");
#ifndef PROBE_MOBA
#define PROBE_MOBA 0
#endif
constexpr size_t OFF_CMP = PROBE_MOBA ? OFF_ONSA : OFF_MLIST;
#ifndef MOBA_NPART
#define MOBA_NPART 4
#endif
#ifndef REP_NSA_ONLY
#define REP_NSA_ONLY 0
#endif
#ifndef REP_NSA_PART
#define REP_NSA_PART 0
#endif
#ifndef REP_MASK
#define REP_MASK 0
#endif
#ifndef PROBE_MOBA
#define PROBE_MOBA 0
#endif
#ifndef PROBE_NSA
#define PROBE_NSA 0
#endif
#ifndef PROBE_CMPR
#define PROBE_CMPR 0
#endif
#ifndef PROBE_PROJ
#define PROBE_PROJ 0
#endif
#define PROBE_ANY (PROBE_MOBA || PROBE_NSA || PROBE_CMPR || PROBE_PROJ)
constexpr size_t WS_TOTAL = WS_NEED;
static_assert(WS_TOTAL <= 536870912ull, "workspace too big (probe)");

struct Params {
  const float *x, *c, *w_ada, *b_ada, *g_attn, *g_ffn, *w_in, *cmp_pe, *cmp_w1, *cmp_w2, *w_up_nsa, *w_up_moba, *w_out,
      *peer_wq, *peer_k1, *peer_k2, *peer_u, *peer_v, *g_final;
  float* out;
  char* ws;
};

constexpr int SMEM_BYTES = 74 * 1024;

DEV int tidx() {
  int t = threadIdx.x & 255;
  asm volatile("" : "+v"(t));
  return t;
}
DEV int hidx() { return __builtin_amdgcn_readfirstlane((int)(threadIdx.x >> 8)); }
DEV int vbid() { return (int)blockIdx.x * 2 + hidx(); }
DEV int vnb() { return (int)gridDim.x * 2; }
#define MFMA16B(a, b, c) __builtin_amdgcn_mfma_f32_16x16x32_bf16(a, b, c, 0, 0, 0)
DEV unsigned cvtpk_(float lo, float hi) {
  unsigned r;
  asm("v_cvt_pk_bf16_f32 %0, %1, %2" : "=v"(r) : "v"(lo), "v"(hi));
  return r;
}
DEV float bf2f(bf16 h) { return __uint_as_float(((unsigned)h) << 16); }
DEV bf16 f2bf(float f) {
  unsigned u = __float_as_uint(f);
  u += 0x7fffu + ((u >> 16) & 1u);
  return (bf16)(u >> 16);
}
DEV float gelu_tanh(float x) {
  float u = 0.7978845608028654f * (x + 0.044715f * x * x * x);
  return 0.5f * x * (1.f + tanhf(u));
}
DEV float sigmoidf_(float x) { return 1.f / (1.f + expf(-x)); }
DEV void unpack8(uint4 v, float* f) {
  f[0] = __uint_as_float(v.x << 16); f[1] = __uint_as_float(v.x & 0xffff0000u);
  f[2] = __uint_as_float(v.y << 16); f[3] = __uint_as_float(v.y & 0xffff0000u);
  f[4] = __uint_as_float(v.z << 16); f[5] = __uint_as_float(v.z & 0xffff0000u);
  f[6] = __uint_as_float(v.w << 16); f[7] = __uint_as_float(v.w & 0xffff0000u);
}
DEV float dot64_bf(const float* q, const bf16* row) {
  float s = 0.f;
#pragma unroll
  for (int i = 0; i < 8; ++i) {
    float f[8];
    unpack8(*(const uint4*)(row + i * 8), f);
#pragma unroll
    for (int j = 0; j < 8; ++j) s += q[i * 8 + j] * f[j];
  }
  return s;
}
DEV void axpy64_bf(float* o, float a, const bf16* row) {
#pragma unroll
  for (int i = 0; i < 8; ++i) {
    float f[8];
    unpack8(*(const uint4*)(row + i * 8), f);
#pragma unroll
    for (int j = 0; j < 8; ++j) o[i * 8 + j] += a * f[j];
  }
}
DEV float dot64_f(const float* q, const float* row) {
  float s = 0.f;
#pragma unroll
  for (int i = 0; i < 16; ++i) {
    float4 v = *(const float4*)(row + i * 4);
    s += q[i * 4] * v.x + q[i * 4 + 1] * v.y + q[i * 4 + 2] * v.z + q[i * 4 + 3] * v.w;
  }
  return s;
}
DEV void axpy64_f(float* o, float a, const float* row) {
#pragma unroll
  for (int i = 0; i < 16; ++i) {
    float4 v = *(const float4*)(row + i * 4);
    o[i * 4] += a * v.x; o[i * 4 + 1] += a * v.y; o[i * 4 + 2] += a * v.z; o[i * 4 + 3] += a * v.w;
  }
}
DEV void load_q64(float* q, const bf16* p, float scale) {
#pragma unroll
  for (int i = 0; i < 8; ++i) unpack8(*(const uint4*)(p + i * 8), q + i * 8);
#pragma unroll
  for (int i = 0; i < 64; ++i) q[i] *= scale;
}
DEV int lane_id_() { return __builtin_amdgcn_mbcnt_hi(~0u, __builtin_amdgcn_mbcnt_lo(~0u, 0u)); }
DEV int shx(int v, int m) {
  if (m == 1) return __builtin_amdgcn_update_dpp(0, v, 0xB1, 0xF, 0xF, true);
  if (m == 2) return __builtin_amdgcn_update_dpp(0, v, 0x4E, 0xF, 0xF, true);
  if (m == 4) return __builtin_amdgcn_ds_swizzle(v, 0x101F);
  if (m == 8) return __builtin_amdgcn_update_dpp(0, v, 0x128, 0xF, 0xF, true);
  if (m == 16) return __builtin_amdgcn_ds_swizzle(v, 0x401F);
  auto rr = __builtin_amdgcn_permlane32_swap((unsigned)v, (unsigned)v, false, false);
  return (lane_id_() < 32) ? (int)rr[1] : (int)rr[0];
}
DEV unsigned shx(unsigned v, int m) { return (unsigned)shx((int)v, m); }
DEV float shx(float v, int m) { return __int_as_float(shx(__float_as_int(v), m)); }
DEV float wave_sum(float v) {
#pragma unroll
  for (int o = 32; o >= 1; o >>= 1) v += shx(v, o);
  return v;
}

#define XB_TMO      128
#define XB_XCNT(j)  (256  + 64 * (j))
#define XB_XSUB(j)  (1280 + 64 * (j))
#define XB_XGEN(j)  (2304 + 64 * (j))
#define XB_TOP      3328
#define XB_TOPGEN   3392
#define XCD_BAR_WORDS 3456
#define XB_SPIN_CAP (1u << 18)
#define LAS __attribute__((address_space(3)))

__device__ __forceinline__ unsigned xb_ld(unsigned* p)              { return __hip_atomic_load(p, __ATOMIC_RELAXED, __HIP_MEMORY_SCOPE_AGENT); }
__device__ __forceinline__ unsigned xb_add(unsigned* p, unsigned v) { return __hip_atomic_fetch_add(p, v, __ATOMIC_RELAXED, __HIP_MEMORY_SCOPE_AGENT); }
__device__ __forceinline__ unsigned xb_xcc_id() { return (unsigned)__builtin_amdgcn_s_getreg((3 << 11) | 20) & 0xFu; }
#define XB_SPIN(cond, bar) do { unsigned _sp = 0; while (cond) { __builtin_amdgcn_s_sleep(1); \
    if ((++_sp & 255u) == 0u) { if (xb_ld(&(bar)[XB_TMO])) break; if (_sp > XB_SPIN_CAP) { atomicAdd(&(bar)[XB_TMO], 1u); break; } } } } while (0)

struct XcdBarrier {
    unsigned* bar; unsigned x;
    volatile LAS unsigned* st;
};

__device__ __forceinline__ XcdBarrier xcd_barrier_post(unsigned* bar, volatile LAS unsigned* st) {
    XcdBarrier b; b.bar = bar; b.x = xb_xcc_id(); b.st = st;
    if (threadIdx.x == 0) (void)xb_add(&bar[XB_XCNT(b.x)], 1u);
    return b;
}
__device__ __forceinline__ void xcd_barrier_complete(unsigned* bar, unsigned x, unsigned& nloc, unsigned& nx) {
    const unsigned G = gridDim.x * gridDim.y * gridDim.z;
    unsigned sum, cnt, mine, sp = 0u;
    for (;;) {
        sum = 0u; cnt = 0u; mine = 0u;
#pragma unroll
        for (unsigned j = 0; j < 16; ++j) { const unsigned c = xb_ld(&bar[XB_XCNT(j)]); sum += c; cnt += (c > 0u) ? 1u : 0u; mine = (j == x) ? c : mine; }
        if (sum == G) break;
        __builtin_amdgcn_s_sleep(1);
        if ((++sp & 255u) == 0u) { if (xb_ld(&bar[XB_TMO])) break; if (sp > XB_SPIN_CAP) { atomicAdd(&bar[XB_TMO], 1u); break; } }
    }
    nloc = mine > 0u ? mine : 1u; nx = cnt > 0u ? cnt : 1u;
}

__device__ __forceinline__ void xcd_barrier(const XcdBarrier& b) {
    asm volatile("s_waitcnt vmcnt(0)" ::: "memory");
    __syncthreads();
    if (threadIdx.x == 0) {
        unsigned* bar = b.bar;
        __builtin_amdgcn_s_waitcnt(0);
        unsigned nloc = b.st[0], nx = b.st[1];
        if (nloc == 0u) { xcd_barrier_complete(bar, b.x, nloc, nx); b.st[0] = nloc; b.st[1] = nx; }
        const unsigned old = xb_add(&bar[XB_XSUB(b.x)], 1u);
        const unsigned gen = old / nloc;
        if (old + 1u == (gen + 1u) * nloc) {
            __builtin_amdgcn_fence(__ATOMIC_RELEASE, "agent");
            asm volatile("s_waitcnt vmcnt(0)" ::: "memory");
            const unsigned og = xb_add(&bar[XB_TOP], 1u);
            const unsigned tg = og / nx;
            if (og + 1u == (tg + 1u) * nx) xb_add(&bar[XB_TOPGEN], 1u);
            else XB_SPIN(xb_ld(&bar[XB_TOPGEN]) == tg, bar);
            __builtin_amdgcn_fence(__ATOMIC_ACQUIRE, "agent");
            xb_add(&bar[XB_XGEN(b.x)], 1u);
            asm volatile("s_waitcnt vmcnt(0)" ::: "memory");
        } else {
            XB_SPIN(xb_ld(&bar[XB_XGEN(b.x)]) == gen, bar);
            __builtin_amdgcn_fence(__ATOMIC_ACQUIRE, "agent");
            asm volatile("s_waitcnt vmcnt(0)" ::: "memory");
        }
    }
    __syncthreads();
}


DEV int win_col_map(int j) {
  if (j < 1280) return j;
  if (j < 4864) return j + 24;
  if (j < 4888) return j - 4864 + 1280;
  return -1;
}
DEV void tr_tile(const float* __restrict__ src, int ldsrc, int K, bf16* __restrict__ dst, int kt, int nt, bool remap,
                 float* sm) {
  const int tid = tidx();
#pragma unroll 4
  for (int i = 0; i < 16; ++i) {
    int r = i * 4 + (tid >> 6), cx = tid & 63;
    int j = nt * 64 + cx, k = kt * 64 + r;
    int oc = remap ? win_col_map(j) : j;
    sm[r * 65 + cx] = (oc >= 0) ? src[(size_t)k * ldsrc + oc] : 0.f;
  }
  __syncthreads();
#pragma unroll 4
  for (int i = 0; i < 16; ++i) {
    int n = i * 4 + (tid >> 6), kk = tid & 63;
    dst[(size_t)(nt * 64 + n) * K + kt * 64 + kk] = f2bf(sm[kk * 65 + n]);
  }
  __syncthreads();
}

DEV unsigned e8m0_of(float amax) {
  const unsigned bits = (unsigned)__float_as_int(amax * (1.f / 224.f));
  unsigned e = ((bits >> 23) & 255u) + ((bits & 0x7fffffu) ? 1u : 0u);
  return e < 1u ? 1u : (e > 253u ? 253u : e);
}
DEV float e8m0_inv(unsigned e) { return __int_as_float((int)((254u - e) << 23)); }
DEV unsigned pack4_fp8_(float a, float b, float c, float d) {
  int q = __builtin_amdgcn_cvt_pk_fp8_f32(a, b, 0, false);
  q = __builtin_amdgcn_cvt_pk_fp8_f32(c, d, q, true);
  return (unsigned)q;
}
DEV void wamax_item(const Params& p, int item) {
  const int l = item >> 7, part = item & 127;
  const size_t per = (size_t)1024 * 4888 / 128;
  const float4* src = (const float4*)(p.w_in + (size_t)l * 1024 * 4888 + (size_t)part * per);
  float m = 0.f;
  for (int i = tidx(); i < (int)(per / 4); i += 256) {
    const float4 v = src[i];
    m = fmaxf(m, fmaxf(fmaxf(fabsf(v.x), fabsf(v.y)), fmaxf(fabsf(v.z), fabsf(v.w))));
  }
#pragma unroll
  for (int o = 32; o >= 1; o >>= 1) m = fmaxf(m, shx(m, o));
  if ((tidx() & 63) == 0) atomicMax((unsigned*)(p.ws + OFF_BAR) + l, (unsigned)__float_as_int(m));
}
DEV void wq8_item(const Params& p, int item, float* sm) {
  const int tid = tidx();
  const int l = item / (80 * 16), r_ = item % (80 * 16);
  const int nt = r_ / 16, kt = r_ % 16;
  const float* src = p.w_in + (size_t)l * 1024 * 4888;
  unsigned char* dst = (unsigned char*)(p.ws + OFF_WINT) + (size_t)l * WN * 1024;
  const unsigned e = e8m0_of(__int_as_float((int)__hip_atomic_load((const unsigned*)(p.ws + OFF_BAR) + l, __ATOMIC_RELAXED, __HIP_MEMORY_SCOPE_AGENT)));
  const float s = e8m0_inv(e);
#pragma unroll 4
  for (int i = 0; i < 16; ++i) {
    const int r = i * 4 + (tid >> 6), cx = tid & 63;
    const int oc = win_col_map(nt * 64 + cx);
    sm[r * 65 + cx] = (oc >= 0) ? src[(size_t)(kt * 64 + r) * 4888 + oc] : 0.f;
  }
  __syncthreads();
  const int kq = tid & 15;
#pragma unroll
  for (int i = 0; i < 4; ++i) {
    const int n = i * 16 + (tid >> 4);
    const float v0 = sm[(kq * 4 + 0) * 65 + n], v1 = sm[(kq * 4 + 1) * 65 + n], v2 = sm[(kq * 4 + 2) * 65 + n], v3 = sm[(kq * 4 + 3) * 65 + n];
    *(unsigned*)(dst + (size_t)(nt * 64 + n) * 1024 + kt * 64 + kq * 4) = pack4_fp8_(v0 * s, v1 * s, v2 * s, v3 * s);
  }
  if (kt == 0 && tid < 64) ((unsigned char*)(p.ws + OFF_WCS))[(size_t)l * WN + nt * 64 + tid] = (unsigned char)e;
  __syncthreads();
}
constexpr int WQ8_ITEMS = 2 * 80 * 16;
constexpr int PREP_TR_WIN = 2 * 128;
constexpr int PREP_TR_UPN = 2 * 16 * 8;
constexpr int PREP_TR_UPM = 2 * 16 * 8;
constexpr int PREP_TR_OUT = 2 * 16 * 16;
constexpr int PREP_TR_WQ = 2 * 32 * 16;
constexpr int PREP_ROPE = 512;
constexpr int PREP_MOD = 384;
constexpr int PREP_PEB = 16;
constexpr int PREP_PK = 32;
constexpr int PREP_TR_W1 = 4 * 2 * 32;
constexpr int PREP_ITEMS = PREP_TR_WIN + PREP_TR_UPN + PREP_TR_UPM + PREP_TR_OUT + PREP_TR_WQ + PREP_ROPE + PREP_MOD + PREP_PEB + PREP_PK + PREP_TR_W1;

DEV void prep_item(const Params& p, int item, float* sm) {
  const int tid = tidx();
  if (item < PREP_TR_WIN) {
    wamax_item(p, item);
    return;
  }
  item -= PREP_TR_WIN;
  if (item < PREP_TR_UPN) {
    int l = item / 128, r = item % 128;
    int nt = r / 8, kt = r % 8;
    tr_tile(p.w_up_nsa + (size_t)l * 512 * 1024, 1024, 512, (bf16*)(p.ws + OFF_WUPN) + (size_t)l * 1024 * 512, kt, nt, false, sm);
    return;
  }
  item -= PREP_TR_UPN;
  if (item < PREP_TR_UPM) {
    int l = item / 128, r = item % 128;
    int nt = r / 8, kt = r % 8;
    tr_tile(p.w_up_moba + (size_t)l * 512 * 1024, 1024, 512, (bf16*)(p.ws + OFF_WUPM) + (size_t)l * 1024 * 512, kt, nt, false, sm);
    return;
  }
  item -= PREP_TR_UPM;
  if (item < PREP_TR_OUT) {
    int l = item / 256, r = item % 256;
    int nt = r / 16, kt = r % 16;
    tr_tile(p.w_out + (size_t)l * 1024 * 1024, 1024, 1024, (bf16*)(p.ws + OFF_WOUT) + (size_t)l * 1024 * 1024, kt, nt, false, sm);
    return;
  }
  item -= PREP_TR_OUT;
  if (item < PREP_TR_WQ) {
    int l = item / 512, r = item % 512;
    int nt = r / 16, kt = r % 16;
    tr_tile(p.peer_wq + (size_t)l * 1024 * 2048, 2048, 1024, (bf16*)(p.ws + OFF_WQ) + (size_t)l * 2048 * 1024, kt, nt, false, sm);
    return;
  }
  item -= PREP_TR_WQ;
  if (item < PREP_ROPE) {
    int idx = item * 256 + tid;
    int pos = idx >> 3, i = idx & 7;
    float inv = powf(500000.0f, -(float)i / 8.0f);
    float ang = (float)pos * inv;
    float* rp = (float*)(p.ws + OFF_ROPE) + (size_t)pos * 16;
    rp[i] = cosf(ang);
    rp[8 + i] = sinf(ang);
    return;
  }
  item -= PREP_ROPE;
  if (item < PREP_MOD) {
    for (int i = tid; i < 2048; i += 256) {
      float cv = p.c[i];
      sm[i] = cv / (1.f + expf(-cv));
    }
    __syncthreads();
    const int l = item / 192, n0 = (item % 192) * 32;
    const int col = tid & 31, ks = tid >> 5;
    const float* w = p.w_ada + (size_t)l * 1024 * 6144 + n0 + col;
    float a0 = 0.f, a1 = 0.f;
#pragma unroll 8
    for (int k = ks * 128; k < ks * 128 + 128; ++k) {
      float wv = w[(size_t)k * 6144];
      a0 += sm[k] * wv;
      a1 += sm[1024 + k] * wv;
    }
    sm[2048 + tid * 2] = a0;
    sm[2048 + tid * 2 + 1] = a1;
    __syncthreads();
    if (tid < 64) {
      const int c2 = tid & 31, bs = tid >> 5;
      float s = 0.f;
#pragma unroll
      for (int q = 0; q < 8; ++q) s += sm[2048 + (q * 32 + c2) * 2 + bs];
      ((float*)(p.ws + OFF_MOD))[(l * 2 + bs) * 6144 + n0 + c2] = s + p.b_ada[l * 6144 + n0 + c2];
    }
    __syncthreads();
    return;
  }
  item -= PREP_MOD;
  if (item < PREP_PEB) {
    const int lw = item >> 2, j0 = (item & 3) * 32;
    const int col = tid & 31, ks = tid >> 5;
    const float* pe = p.cmp_pe + (size_t)lw * 2048;
    const float* w1 = p.cmp_w1 + (size_t)lw * 2048 * 128 + j0 + col;
    float a = 0.f;
#pragma unroll 8
    for (int i = ks * 256; i < ks * 256 + 256; ++i) a += pe[i] * w1[(size_t)i * 128];
    sm[tid] = a;
    __syncthreads();
    if (tid < 32) {
      float s = 0.f;
#pragma unroll
      for (int q = 0; q < 8; ++q) s += sm[q * 32 + tid];
      ((float*)(p.ws + OFF_PEB))[lw * 128 + j0 + tid] = s;
    }
    if (item == 0 && tid < 4) ((float*)(p.ws + OFF_PROBE))[tid] = 0.f;
    __syncthreads();
    return;
  }
  item -= PREP_PEB;
  if (item < PREP_PK) {
    const int e0 = item * 2048 + tid * 8;
    const int lt = e0 >> 14, off = e0 & 16383;
    const float* srcp = ((lt & 1) ? p.peer_k2 : p.peer_k1) + (size_t)(lt >> 1) * 16384 + off;
    const float4 a = *(const float4*)srcp, b4 = *(const float4*)(srcp + 4);
    uint4 pk;
    pk.x = (unsigned)f2bf(a.x) | ((unsigned)f2bf(a.y) << 16);
    pk.y = (unsigned)f2bf(a.z) | ((unsigned)f2bf(a.w) << 16);
    pk.z = (unsigned)f2bf(b4.x) | ((unsigned)f2bf(b4.y) << 16);
    pk.w = (unsigned)f2bf(b4.z) | ((unsigned)f2bf(b4.w) << 16);
    *(uint4*)((bf16*)(p.ws + OFF_PKB) + e0) = pk;
    return;
  }
  item -= PREP_PK;
  {
    const int lw = item >> 6, r = item & 63;
    const int nt = r >> 5, kt = r & 31;
    tr_tile(p.cmp_w1 + (size_t)lw * 2048 * 128, 128, 2048, (bf16*)(p.ws + OFF_W1T) + (size_t)lw * 128 * 2048, kt, nt, false, sm);
  }
}

DEV void norm_item(const float* __restrict__ xin, const float* __restrict__ g, const float* __restrict__ sc,
                   const float* __restrict__ sh, bf16* __restrict__ hout, int item) {
  const int lane = tidx() & 63, wave = tidx() >> 6;
  const size_t tok = (size_t)item * 4 + wave;
  const int b = (int)(tok / S);
  const float* xr = xin + tok * 1024;
  float4 v[4];
  float ss = 0.f;
#pragma unroll
  for (int i = 0; i < 4; ++i) {
    v[i] = *(const float4*)(xr + i * 256 + lane * 4);
    ss += v[i].x * v[i].x + v[i].y * v[i].y + v[i].z * v[i].z + v[i].w * v[i].w;
  }
  ss = wave_sum(ss);
  float r = 1.0f / sqrtf(ss * (1.0f / 1024.f) + 1e-6f);
#pragma unroll
  for (int i = 0; i < 4; ++i) {
    int d = i * 256 + lane * 4;
    float4 gg = *(const float4*)(g + d);
    float4 s4 = *(const float4*)(sc + b * 6144 + d);
    float4 h4 = *(const float4*)(sh + b * 6144 + d);
    float o0 = v[i].x * r * gg.x * (1.f + s4.x) + h4.x;
    float o1 = v[i].y * r * gg.y * (1.f + s4.y) + h4.y;
    float o2 = v[i].z * r * gg.z * (1.f + s4.z) + h4.z;
    float o3 = v[i].w * r * gg.w * (1.f + s4.w) + h4.w;
    uint2 pk;
    pk.x = (unsigned)f2bf(o0) | ((unsigned)f2bf(o1) << 16);
    pk.y = (unsigned)f2bf(o2) | ((unsigned)f2bf(o3) << 16);
    *(uint2*)(hout + tok * 1024 + d) = pk;
  }
}
DEV void norm8_item(const float* __restrict__ xin, const float* __restrict__ g, const float* __restrict__ sc,
                    const float* __restrict__ sh, unsigned char* __restrict__ hout, unsigned char* __restrict__ hscale, int item) {
  const int lane = tidx() & 63, wave = tidx() >> 6;
  const size_t tok = (size_t)item * 4 + wave;
  const int b = (int)(tok / S);
  const float* xr = xin + tok * 1024;
  float4 v[4];
  float ss = 0.f;
#pragma unroll
  for (int i = 0; i < 4; ++i) {
    v[i] = *(const float4*)(xr + i * 256 + lane * 4);
    ss += v[i].x * v[i].x + v[i].y * v[i].y + v[i].z * v[i].z + v[i].w * v[i].w;
  }
  ss = wave_sum(ss);
  float r = 1.0f / sqrtf(ss * (1.0f / 1024.f) + 1e-6f);
  float mx = 0.f;
#pragma unroll
  for (int i = 0; i < 4; ++i) {
    int d = i * 256 + lane * 4;
    float4 gg = *(const float4*)(g + d);
    float4 s4 = *(const float4*)(sc + b * 6144 + d);
    float4 h4 = *(const float4*)(sh + b * 6144 + d);
    v[i].x = v[i].x * r * gg.x * (1.f + s4.x) + h4.x;
    v[i].y = v[i].y * r * gg.y * (1.f + s4.y) + h4.y;
    v[i].z = v[i].z * r * gg.z * (1.f + s4.z) + h4.z;
    v[i].w = v[i].w * r * gg.w * (1.f + s4.w) + h4.w;
    mx = fmaxf(mx, fmaxf(fmaxf(fabsf(v[i].x), fabsf(v[i].y)), fmaxf(fabsf(v[i].z), fabsf(v[i].w))));
  }
#pragma unroll
  for (int o = 32; o >= 1; o >>= 1) mx = fmaxf(mx, shx(mx, o));
  const unsigned e = e8m0_of(mx);
  const float s = e8m0_inv(e);
#pragma unroll
  for (int i = 0; i < 4; ++i)
    *(unsigned*)(hout + tok * 1024 + i * 256 + lane * 4) = pack4_fp8_(v[i].x * s, v[i].y * s, v[i].z * s, v[i].w * s);
  if (lane == 0) hscale[tok] = (unsigned char)e;
}
DEV void final_norm_item(float* __restrict__ x, const float* __restrict__ g, int item) {
  const int lane = tidx() & 63, wave = tidx() >> 6;
  const size_t tok = (size_t)item * 4 + wave;
  float* xr = x + tok * 1024;
  float4 v[4];
  float ss = 0.f;
#pragma unroll
  for (int i = 0; i < 4; ++i) {
    v[i] = *(const float4*)(xr + i * 256 + lane * 4);
    ss += v[i].x * v[i].x + v[i].y * v[i].y + v[i].z * v[i].z + v[i].w * v[i].w;
  }
  ss = wave_sum(ss);
  float r = 1.0f / sqrtf(ss * (1.0f / 1024.f) + 1e-6f);
#pragma unroll
  for (int i = 0; i < 4; ++i) {
    int d = i * 256 + lane * 4;
    float4 gg = *(const float4*)(g + d);
    float4 o;
    o.x = v[i].x * r * gg.x; o.y = v[i].y * r * gg.y; o.z = v[i].z * r * gg.z; o.w = v[i].w * r * gg.w;
    *(float4*)(xr + d) = o;
  }
}

#define GM_BUF (2 * 128 * 72)
#define GM_LOAD(R, kk)                                                                                  \
  {                                                                                                     \
    const bf16* Ak = Ap + (kk);                                                                         \
    const bf16* Wk = Wp + (kk);                                                                         \
    R##a0 = *(const uint4*)(Ak); R##a1 = *(const uint4*)(Ak + a32); R##a2 = *(const uint4*)(Ak + 2 * a32); \
    R##a3 = *(const uint4*)(Ak + 3 * a32);                                                              \
    R##b0 = *(const uint4*)(Wk); R##b1 = *(const uint4*)(Wk + w32); R##b2 = *(const uint4*)(Wk + 2 * w32); \
    R##b3 = *(const uint4*)(Wk + 3 * w32);                                                              \
  }
#define GM_STORE(R, buf)                                                                                \
  {                                                                                                     \
    bf16* as_ = Asw + (buf) * GM_BUF;                                                                   \
    bf16* bs_ = as_ + 128 * 72;                                                                         \
    *(uint4*)(as_) = R##a0; *(uint4*)(as_ + 32 * 72) = R##a1; *(uint4*)(as_ + 64 * 72) = R##a2; *(uint4*)(as_ + 96 * 72) = R##a3; \
    *(uint4*)(bs_) = R##b0; *(uint4*)(bs_ + 32 * 72) = R##b1; *(uint4*)(bs_ + 64 * 72) = R##b2; *(uint4*)(bs_ + 96 * 72) = R##b3; \
  }
#define GM_COMPUTE(buf)                                                                                 \
  {                                                                                                     \
    const bf16* As_ = sm + (buf) * GM_BUF;                                                              \
    const bf16* Bs_ = As_ + 128 * 72;                                                                   \
    _Pragma("unroll") for (int ks = 0; ks < 2; ++ks) {                                                  \
      __builtin_amdgcn_sched_barrier(0);                                                                \
      bf16x8 af[4], bfr[4];                                                                             \
      _Pragma("unroll") for (int mi = 0; mi < 4; ++mi)                                                  \
        af[mi] = *(const bf16x8*)(As_ + (wr * 64 + mi * 16 + (lane & 15)) * 72 + ks * 32 + (lane >> 4) * 8); \
      _Pragma("unroll") for (int ni = 0; ni < 4; ++ni)                                                  \
        bfr[ni] = *(const bf16x8*)(Bs_ + (wc * 64 + ni * 16 + (lane & 15)) * 72 + ks * 32 + (lane >> 4) * 8); \
      _Pragma("unroll") for (int mi = 0; mi < 4; ++mi)                                                  \
        _Pragma("unroll") for (int ni = 0; ni < 4; ++ni)                                                \
          acc[mi][ni] = __builtin_amdgcn_mfma_f32_16x16x32_bf16(af[mi], bfr[ni], acc[mi][ni], 0, 0, 0); \
    }                                                                                                   \
    __builtin_amdgcn_sched_barrier(0);                                                                  \
  }
DEV void gemm_mainloop(const bf16* __restrict__ A, int lda, const bf16* __restrict__ W, int K, int m0, int n0, bf16* sm,
                       f32x4 (&acc)[4][4]) {
  const int tid = tidx(), lane = tid & 63, wave = tid >> 6;
  const int wr = wave >> 1, wc = wave & 1;
  const int lrow = tid >> 3, lkc = (tid & 7) * 8;
  const bf16* Ap = A + (size_t)(m0 + lrow) * lda + lkc;
  const bf16* Wp = W + (size_t)(n0 + lrow) * K + lkc;
  const int a32 = 32 * lda, w32 = 32 * K;
  bf16* Asw = sm + lrow * 72 + lkc;
  uint4 xa0, xa1, xa2, xa3, xb0, xb1, xb2, xb3, ya0, ya1, ya2, ya3, yb0, yb1, yb2, yb3;
  const int nk = K >> 6;
  GM_LOAD(x, 0)
  GM_LOAD(y, 64)
  __syncthreads();
  GM_STORE(x, 0)
  if (nk > 2) GM_LOAD(x, 128)
  __syncthreads();
  for (int k = 0; k < nk; k += 2) {
    GM_COMPUTE(0)
    GM_STORE(y, 1)
    if (k + 3 < nk) GM_LOAD(y, (k + 3) * 64)
    __syncthreads();
    GM_COMPUTE(1)
    if (k + 2 < nk) {
      GM_STORE(x, 0)
      if (k + 4 < nk) GM_LOAD(x, (k + 4) * 64)
    }
    __syncthreads();
  }
}
DEV void gemm256_mainloop(const bf16* __restrict__ A, int lda, const bf16* __restrict__ W, int K, int m0, int n0, bf16* sm,
                          f32x4 (&acc)[2][4][4]) {
  bf16* As = sm;
  bf16* Bs = sm + 256 * 72;
  const int tid = tidx(), lane = tid & 63, wave = tid >> 6;
  const int wr = wave >> 1, wc = wave & 1;
  const int lrow = tid >> 3, lkc = (tid & 7) * 8;
  const bf16* Ap = A + (size_t)(m0 + lrow) * lda + lkc;
  const bf16* Wp = W + (size_t)(n0 + lrow) * K + lkc;
  const int a32 = 32 * lda, w32 = 32 * K;
  uint4 ra0, ra1, ra2, ra3, ra4, ra5, ra6, ra7, rb0, rb1, rb2, rb3;
#define G256_LOAD(kk)                                                                                   \
  {                                                                                                     \
    const bf16* Ak = Ap + (kk);                                                                         \
    const bf16* Wk = Wp + (kk);                                                                         \
    ra0 = *(const uint4*)(Ak); ra1 = *(const uint4*)(Ak + a32); ra2 = *(const uint4*)(Ak + 2 * a32);    \
    ra3 = *(const uint4*)(Ak + 3 * a32); ra4 = *(const uint4*)(Ak + 4 * a32); ra5 = *(const uint4*)(Ak + 5 * a32); \
    ra6 = *(const uint4*)(Ak + 6 * a32); ra7 = *(const uint4*)(Ak + 7 * a32);                           \
    rb0 = *(const uint4*)(Wk); rb1 = *(const uint4*)(Wk + w32); rb2 = *(const uint4*)(Wk + 2 * w32);    \
    rb3 = *(const uint4*)(Wk + 3 * w32);                                                                \
  }
  G256_LOAD(0)
  bf16* Asw = As + lrow * 72 + lkc;
  bf16* Bsw = Bs + lrow * 72 + lkc;
  for (int k0 = 0; k0 < K; k0 += 64) {
    __syncthreads();
    *(uint4*)(Asw) = ra0; *(uint4*)(Asw + 32 * 72) = ra1; *(uint4*)(Asw + 64 * 72) = ra2; *(uint4*)(Asw + 96 * 72) = ra3;
    *(uint4*)(Asw + 128 * 72) = ra4; *(uint4*)(Asw + 160 * 72) = ra5; *(uint4*)(Asw + 192 * 72) = ra6; *(uint4*)(Asw + 224 * 72) = ra7;
    *(uint4*)(Bsw) = rb0; *(uint4*)(Bsw + 32 * 72) = rb1; *(uint4*)(Bsw + 64 * 72) = rb2; *(uint4*)(Bsw + 96 * 72) = rb3;
    __syncthreads();
    if (k0 + 64 < K) G256_LOAD(k0 + 64)
#pragma unroll
    for (int ks = 0; ks < 2; ++ks) {
      bf16x8 bfr[4];
#pragma unroll
      for (int ni = 0; ni < 4; ++ni)
        bfr[ni] = *(const bf16x8*)(Bs + (wc * 64 + ni * 16 + (lane & 15)) * 72 + ks * 32 + (lane >> 4) * 8);
#pragma unroll
      for (int h = 0; h < 2; ++h) {
        __builtin_amdgcn_sched_barrier(0);
        bf16x8 af[4];
#pragma unroll
        for (int mi = 0; mi < 4; ++mi)
          af[mi] = *(const bf16x8*)(As + (wr * 128 + h * 64 + mi * 16 + (lane & 15)) * 72 + ks * 32 + (lane >> 4) * 8);
#pragma unroll
        for (int mi = 0; mi < 4; ++mi)
#pragma unroll
          for (int ni = 0; ni < 4; ++ni)
            acc[h][mi][ni] = __builtin_amdgcn_mfma_f32_16x16x32_bf16(af[mi], bfr[ni], acc[h][mi][ni], 0, 0, 0);
      }
    }
  }
}
DEV void acc_zero(f32x4 (&acc)[4][4]) {
#pragma unroll
  for (int i = 0; i < 4; ++i)
#pragma unroll
    for (int j = 0; j < 4; ++j) acc[i][j] = f32x4{0.f, 0.f, 0.f, 0.f};
}
DEV void store_tile_bf16(bf16* sm, const f32x4 (&acc)[4][4], bf16* __restrict__ dbase, size_t dstride) {
  const int tid = tidx(), lane = tid & 63, wave = tid >> 6, g4 = lane >> 4, c16 = lane & 15;
  bf16* Cw = sm + wave * (64 * 72);
  __syncthreads();
#pragma unroll
  for (int mi = 0; mi < 4; ++mi)
#pragma unroll
    for (int ni = 0; ni < 4; ++ni)
#pragma unroll
      for (int r = 0; r < 4; ++r) Cw[(mi * 16 + g4 * 4 + r) * 72 + ni * 16 + c16] = f2bf(acc[mi][ni][r]);
  __syncthreads();
#pragma unroll
  for (int it = 0; it < 8; ++it) {
    const int row_l = it * 8 + (lane >> 3), ch = lane & 7;
    const uint4 v = *(const uint4*)(Cw + row_l * 72 + ch * 8);
    *(uint4*)(dbase + (size_t)row_l * dstride + ch * 8) = v;
  }
}
template <class Epi>
DEV void gemm_tile(const bf16* __restrict__ A, int lda, const bf16* __restrict__ W, int K, int m0, int n0, bf16* sm,
                   Epi epi) {
  f32x4 acc[4][4];
  acc_zero(acc);
  gemm_mainloop(A, lda, W, K, m0, n0, sm, acc);
  const int tid = tidx(), lane = tid & 63, wave = tid >> 6;
  const int wr = wave >> 1, wc = wave & 1;
#pragma unroll
  for (int mi = 0; mi < 4; ++mi)
#pragma unroll
    for (int ni = 0; ni < 4; ++ni)
#pragma unroll
      for (int r = 0; r < 4; ++r) {
        int row = m0 + wr * 64 + mi * 16 + (lane >> 4) * 4 + r;
        int col = n0 + wc * 64 + ni * 16 + (lane & 15);
        epi(row, col, acc[mi][ni][r]);
      }
}
DEV void inproj_epilogue(const Params& p, f32x4 (&acc)[4][4], int row0, int vc0, bf16* sm) {
  const int tid = tidx(), lane = tid & 63, g4 = lane >> 4, c16 = lane & 15;
  const int b = row0 / S, t0 = row0 % S;
  bf16* dbase;
  size_t dstride;
  bool roped = false;
  bf16* projp = (bf16*)(p.ws + OFF_PROJ) + (size_t)row0 * PC;
  if (vc0 < 768) { dbase = projp + vc0; dstride = PC; }
  else if (vc0 < 1280) {
    const int seg = (vc0 - 768) >> 7, head = ((vc0 - 768) >> 6) & 1;
    const size_t off = (seg == 0) ? OFF_KSB : (seg == 1) ? OFF_VSB : (seg == 2) ? OFF_KWB : OFF_VWB;
    dbase = (bf16*)(p.ws + off) + ((size_t)(b * 2 + head) * S + t0) * 64;
    dstride = 64;
    roped = (seg == 0) || (seg == 2);
  } else if (vc0 < 1792) { dbase = projp + C_MQ + (vc0 - 1280); dstride = PC; roped = true; }
  else if (vc0 < 2816) {
    const int seg = (vc0 - 1792) >> 9, head = ((vc0 - 1792) >> 6) & 7;
    dbase = (bf16*)(p.ws + (seg ? OFF_MVB : OFF_MKB)) + ((size_t)(b * 8 + head) * S + t0) * 64;
    dstride = 64;
    roped = (seg == 0);
  } else if (vc0 < 4864) { dbase = projp + C_GN + (vc0 - 2816); dstride = PC; }
  else { dbase = projp + C_NG + (vc0 - 4864); dstride = PC; }
  if (roped) {
    const float* rope = (const float*)(p.ws + OFF_ROPE);
#pragma unroll
    for (int mi = 0; mi < 4; ++mi)
#pragma unroll
      for (int r = 0; r < 4; ++r) {
        const int pos = t0 + mi * 16 + g4 * 4 + r;
        const float v = acc[mi][0][r];
        const float pv = shx(v, 8);
        const float cs = rope[pos * 16 + (c16 & 7)], sn = rope[pos * 16 + 8 + (c16 & 7)];
        acc[mi][0][r] = (c16 < 8) ? (v * cs - pv * sn) : (v * cs + pv * sn);
      }
  }
  store_tile_bf16(sm, acc, dbase, dstride);
}
DEV void inproj_tile256(const Params& p, int layer, int m0, int n0, bf16* sm) {
  f32x4 acc[2][4][4];
  acc_zero(acc[0]);
  acc_zero(acc[1]);
  gemm256_mainloop((const bf16*)(p.ws + OFF_H), 1024, (const bf16*)(p.ws + OFF_WINT) + (size_t)layer * WN * 1024, 1024, m0, n0, sm, acc);
  const int wave = tidx() >> 6, wr = wave >> 1, wc = wave & 1;
  inproj_epilogue(p, acc[0], m0 + wr * 128, n0 + wc * 64, sm);
  inproj_epilogue(p, acc[1], m0 + wr * 128 + 64, n0 + wc * 64, sm);
}
typedef unsigned u32x2_t __attribute__((ext_vector_type(2)));
DEV void merge_tile(const Params& p, int layer, int m0, int n0, bf16* sm) {
  const int tid = tidx(), lane = tid & 63, wave = tid >> 6, g4 = lane >> 4, c16 = lane & 15;
  const int wr = wave >> 1, wc = wave & 1;
  const bf16* projg = (const bf16*)(p.ws + OFF_PROJ) + (size_t)(m0 + wr * 64 + g4 * 4) * PC + n0 + wc * 64 + c16;
  f32x4 acc[4][4];
  acc_zero(acc);
  gemm_mainloop((const bf16*)(p.ws + OFF_ONSA), 512, (const bf16*)(p.ws + OFF_WUPN) + (size_t)layer * 1024 * 512, 512, m0, n0, sm, acc);
  bf16* yg = (bf16*)(p.ws + OFF_H) + (size_t)(m0 + wr * 64 + g4 * 4) * 1024 + n0 + wc * 64 + c16;
#pragma unroll
  for (int mi = 0; mi < 4; ++mi)
#pragma unroll
    for (int ni = 0; ni < 4; ++ni)
#pragma unroll
      for (int r = 0; r < 4; ++r)
        yg[(size_t)(mi * 16 + r) * 1024 + ni * 16] =
            f2bf(sigmoidf_(bf2f(projg[(size_t)(mi * 16 + r) * PC + C_GN + ni * 16])) * acc[mi][ni][r]);
  acc_zero(acc);
  gemm_mainloop((const bf16*)(p.ws + OFF_OMOBA), 512, (const bf16*)(p.ws + OFF_WUPM) + (size_t)layer * 1024 * 512, 512, m0, n0, sm, acc);
#pragma unroll
  for (int mi = 0; mi < 4; ++mi)
#pragma unroll
    for (int ni = 0; ni < 4; ++ni)
#pragma unroll
      for (int r = 0; r < 4; ++r)
        acc[mi][ni][r] = bf2f(yg[(size_t)(mi * 16 + r) * 1024 + ni * 16]) +
                         sigmoidf_(bf2f(projg[(size_t)(mi * 16 + r) * PC + C_GM + ni * 16])) * acc[mi][ni][r];
  store_tile_bf16(sm, acc, (bf16*)(p.ws + OFF_H) + (size_t)(m0 + wr * 64) * 1024 + n0 + wc * 64, 1024);
}

DEV void merge_tile256(const Params& p, int layer, int m0, int n0, bf16* sm) {
  const int tid = tidx(), lane = tid & 63, wave = tid >> 6, g4 = lane >> 4, c16 = lane & 15;
  const int wr = wave >> 1, wc = wave & 1;
  f32x4 acc[2][4][4];
  acc_zero(acc[0]);
  acc_zero(acc[1]);
  gemm256_mainloop((const bf16*)(p.ws + OFF_ONSA), 512, (const bf16*)(p.ws + OFF_WUPN) + (size_t)layer * 1024 * 512, 512, m0, n0, sm, acc);
#pragma unroll
  for (int h = 0; h < 2; ++h) {
    const size_t rb = (size_t)(m0 + wr * 128 + h * 64 + g4 * 4);
    const bf16* projg = (const bf16*)(p.ws + OFF_PROJ) + rb * PC + n0 + wc * 64 + c16;
    bf16* yg = (bf16*)(p.ws + OFF_H) + rb * 1024 + n0 + wc * 64 + c16;
#pragma unroll
    for (int mi = 0; mi < 4; ++mi)
#pragma unroll
      for (int ni = 0; ni < 4; ++ni)
#pragma unroll
        for (int r = 0; r < 4; ++r)
          yg[(size_t)(mi * 16 + r) * 1024 + ni * 16] =
              f2bf(sigmoidf_(bf2f(projg[(size_t)(mi * 16 + r) * PC + C_GN + ni * 16])) * acc[h][mi][ni][r]);
  }
  acc_zero(acc[0]);
  acc_zero(acc[1]);
  gemm256_mainloop((const bf16*)(p.ws + OFF_OMOBA), 512, (const bf16*)(p.ws + OFF_WUPM) + (size_t)layer * 1024 * 512, 512, m0, n0, sm, acc);
#pragma unroll
  for (int h = 0; h < 2; ++h) {
    const size_t rb = (size_t)(m0 + wr * 128 + h * 64 + g4 * 4);
    const bf16* projg = (const bf16*)(p.ws + OFF_PROJ) + rb * PC + n0 + wc * 64 + c16;
    const bf16* yg = (const bf16*)(p.ws + OFF_H) + rb * 1024 + n0 + wc * 64 + c16;
#pragma unroll
    for (int mi = 0; mi < 4; ++mi)
#pragma unroll
      for (int ni = 0; ni < 4; ++ni)
#pragma unroll
        for (int r = 0; r < 4; ++r)
          acc[h][mi][ni][r] = bf2f(yg[(size_t)(mi * 16 + r) * 1024 + ni * 16]) +
                              sigmoidf_(bf2f(projg[(size_t)(mi * 16 + r) * PC + C_GM + ni * 16])) * acc[h][mi][ni][r];
    store_tile_bf16(sm, acc[h], (bf16*)(p.ws + OFF_H) + (size_t)(m0 + wr * 128 + h * 64) * 1024 + n0 + wc * 64, 1024);
  }
}

DEV void compress_item(const Params& p, int layer, int item, float* sm) {
  const int tid = tidx();
  const int grp = item & 127, which = (item >> 7) & 1, kvh = (item >> 8) & 1, b = item >> 9;
  const int c0 = grp * 8;
  float* xs = sm;
  float* hs = sm + 144 * 64;
  const bf16* proj = (const bf16*)(p.ws + OFF_PROJ);
  const int col = (which ? C_VC : C_KC) + kvh * 64;
  for (int i = tid; i < 144 * 64; i += 256) {
    int tl = i >> 6, d = i & 63;
    int t = c0 * 16 + tl;
    xs[i] = (t < S) ? bf2f(proj[((size_t)b * S + t) * PC + col + d]) : 0.f;
  }
  __syncthreads();
  const int lw = layer * 2 + which;
  if (tid < 128) {
    const float* w1 = p.cmp_w1 + (size_t)lw * 2048 * 128 + tid;
    float acc[8];
#pragma unroll
    for (int ci = 0; ci < 8; ++ci) acc[ci] = 0.f;
    for (int l = 0; l < 32; ++l) {
#pragma unroll 4
      for (int d = 0; d < 64; ++d) {
        float w = w1[(size_t)(l * 64 + d) * 128];
#pragma unroll
        for (int ci = 0; ci < 8; ++ci) acc[ci] += xs[(ci * 16 + l) * 64 + d] * w;
      }
    }
    float pb = ((const float*)(p.ws + OFF_PEB))[lw * 128 + tid];
#pragma unroll
    for (int ci = 0; ci < 8; ++ci) hs[ci * 128 + tid] = gelu_tanh(acc[ci] + pb);
  }
  __syncthreads();
  const float* w2 = p.cmp_w2 + (size_t)lw * 128 * 64;
  float* outp = PROBE_CMPR ? ((float*)(p.ws + OFF_CMP) + (which ? (size_t)Bn * 1024 * 128 : 0)) : (float*)(p.ws + (which ? OFF_VCC : OFF_KCC));
#pragma unroll
  for (int rr = 0; rr < 2; ++rr) {
    int o = rr * 256 + tid;
    int ci = o >> 6, d = o & 63;
    int c = c0 + ci;
    float a = 0.f;
    for (int j = 0; j < 128; ++j) a += hs[ci * 128 + j] * w2[j * 64 + d];
    if (c < 1023) outp[(((size_t)b * 1024 + c) * 2 + kvh) * 64 + d] = a;
    bf16* outb = (bf16*)(p.ws + (which ? OFF_VCB : OFF_KCB));
    if (!PROBE_CMPR && c < 1024) outb[(((size_t)b * 2 + kvh) * 1024 + c) * 64 + d] = (c < 1023) ? f2bf(a) : (bf16)0;
  }
  __syncthreads();
}

DEV void compress_mfma_item(const Params& p, int layer, int item, char* smem) {
  bf16* xs = (bf16*)smem;
  float* hs = (float*)(smem + 272 * 64 * 2);
  const int tid = tidx(), lane = tid & 63, wave = tid >> 6, g4 = lane >> 4, c16 = lane & 15;
  const int cblk = item & 63, which = (item >> 6) & 1, kvh = (item >> 7) & 1, b = item >> 8;
  const int t0 = cblk * 256;
  const bf16* proj = (const bf16*)(p.ws + OFF_PROJ) + (size_t)b * S * PC + (which ? C_VC : C_KC) + kvh * 64;
  __syncthreads();
  {
    uint4 sv[9];
#pragma unroll
    for (int q = 0; q < 9; ++q) {
      const int i = tid + q * 256;
      const int tl = i >> 3, ch = i & 7;
      const int t = t0 + tl;
      sv[q] = uint4{0u, 0u, 0u, 0u};
      if (i < 272 * 8 && t < S) sv[q] = *(const uint4*)(proj + (size_t)t * PC + ch * 8);
    }
#pragma unroll
    for (int q = 0; q < 9; ++q) {
      const int i = tid + q * 256;
      const int tl = i >> 3, ch = i & 7;
      if (i < 272 * 8) *(uint4*)(xs + tl * 64 + ((ch ^ ((tl >> 4) & 7)) * 8)) = sv[q];
    }
  }
  float* w2s = (float*)(smem + 272 * 64 * 2 + 16 * 128 * 4);
  {
    const float* w2g = p.cmp_w2 + (size_t)(layer * 2 + which) * 128 * 64;
    float4 wv[8];
#pragma unroll
    for (int q = 0; q < 8; ++q) wv[q] = *(const float4*)(w2g + (q * 256 + tid) * 4);
#pragma unroll
    for (int q = 0; q < 8; ++q) *(float4*)(w2s + (q * 256 + tid) * 4) = wv[q];
  }
  __syncthreads();
  const int lw = layer * 2 + which;
  const bf16* w1t = (const bf16*)(p.ws + OFF_W1T) + (size_t)lw * 128 * 2048;
  f32x4 acc0 = f32x4{0.f, 0.f, 0.f, 0.f}, acc1 = f32x4{0.f, 0.f, 0.f, 0.f};
  const bf16* wb0 = w1t + (size_t)((2 * wave) * 16 + c16) * 2048 + g4 * 8;
  const bf16* wb1 = w1t + (size_t)((2 * wave + 1) * 16 + c16) * 2048 + g4 * 8;
#pragma unroll 16
  for (int ks = 0; ks < 64; ++ks) {
    const int l = ks >> 1, ch = (ks & 1) * 4 + g4;
    const int tl = 16 * c16 + l;
    const bf16x8 af = *(const bf16x8*)(xs + tl * 64 + ((ch ^ ((tl >> 4) & 7)) * 8));
    const bf16x8 b0 = *(const bf16x8*)(wb0 + ks * 32);
    const bf16x8 b1 = *(const bf16x8*)(wb1 + ks * 32);
    acc0 = MFMA16B(af, b0, acc0);
    acc1 = MFMA16B(af, b1, acc1);
  }
  {
    const float* peb = (const float*)(p.ws + OFF_PEB) + lw * 128;
    const int j0 = (2 * wave) * 16 + c16, j1 = j0 + 16;
    const float pb0 = peb[j0], pb1 = peb[j1];
#pragma unroll
    for (int r = 0; r < 4; ++r) {
      hs[(g4 * 4 + r) * 128 + j0] = gelu_tanh(acc0[r] + pb0);
      hs[(g4 * 4 + r) * 128 + j1] = gelu_tanh(acc1[r] + pb1);
    }
  }
  __syncthreads();
  const float* w2 = w2s;
  const int d = tid & 63, cq = tid >> 6;
  float o0 = 0.f, o1 = 0.f, o2 = 0.f, o3 = 0.f;
#pragma unroll 8
  for (int j = 0; j < 128; ++j) {
    const float w = w2[j * 64 + d];
    o0 += hs[(cq * 4 + 0) * 128 + j] * w;
    o1 += hs[(cq * 4 + 1) * 128 + j] * w;
    o2 += hs[(cq * 4 + 2) * 128 + j] * w;
    o3 += hs[(cq * 4 + 3) * 128 + j] * w;
  }
  float* outp = (float*)(p.ws + (which ? OFF_VCC : OFF_KCC));
  bf16* outb = (bf16*)(p.ws + (which ? OFF_VCB : OFF_KCB));
  const float ov[4] = {o0, o1, o2, o3};
#pragma unroll
  for (int i = 0; i < 4; ++i) {
    const int c = cblk * 16 + cq * 4 + i;
    if (c < 1023) outp[(((size_t)b * 1024 + c) * 2 + kvh) * 64 + d] = ov[i];
    outb[(((size_t)b * 2 + kvh) * 1024 + c) * 64 + d] = (c < 1023) ? f2bf(ov[i]) : (bf16)0;
  }
  __syncthreads();
}

DEV void n1_item(const Params& p, int layer, int item, float* sm) {
  const int chunk = item & 255, kvh = (item >> 8) & 1, b = item >> 9;
  const int tid = tidx(), ql = tid >> 2, g = tid & 3;
  const int t = chunk * 64 + ql, h = kvh * 4 + g;
  const size_t tok = (size_t)b * S + t;
  const bf16* proj = (const bf16*)(p.ws + OFF_PROJ);
  float* imp = sm;
  for (int i = tid; i < 64 * 257; i += 256) imp[i] = 0.f;
  float q[64];
  load_q64(q, proj + tok * PC + C_NQ + h * 64, 0.125f);
  const int nv = (t >= 31) ? (((t - 31) >> 4) + 1) : 0;
  const int nv_max = (((chunk * 64 + 63) - 31) >> 4) + 1;
  const float* kc = (const float*)(p.ws + OFF_KCC) + (size_t)b * 1024 * 128 + kvh * 64;
  const float* vc = (const float*)(p.ws + OFF_VCC) + (size_t)b * 1024 * 128 + kvh * 64;
  float m = -INFINITY, l = 0.f;
  for (int c = 0; c < nv_max; ++c) {
    float s = dot64_f(q, kc + (size_t)c * 128);
    if (c < nv) {
      float mn = fmaxf(m, s);
      l = l * expf(m - mn) + expf(s - mn);
      m = mn;
    }
  }
  __syncthreads();
  float o[64];
#pragma unroll
  for (int d = 0; d < 64; ++d) o[d] = 0.f;
  const float inv_l = (nv > 0) ? 1.f / l : 0.f;
  for (int c = 0; c < nv_max; ++c) {
    float s = dot64_f(q, kc + (size_t)c * 128);
    float pr = (c < nv) ? expf(s - m) * inv_l : 0.f;
    axpy64_f(o, pr, vc + (size_t)c * 128);
    float ps = pr;
    ps += shx(ps, 1);
    ps += shx(ps, 2);
    if (g == 0) {
      int n = c >> 2;
      if ((c & 3) == 3) {
        imp[ql * 257 + n] += 0.5f * ps;
        imp[ql * 257 + n + 1] += 0.5f * ps;
      } else {
        imp[ql * 257 + n] += ps;
      }
    }
  }
  const float gate0 = (!PROBE_NSA || (PROBE_NSA & 1)) ? sigmoidf_(bf2f(proj[tok * PC + C_NG + h * 3 + 0])) : 0.f;
  float* oa = (float*)(p.ws + OFF_H) + tok * 512 + h * 64;
#pragma unroll
  for (int d = 0; d < 64; d += 4) {
    float4 v = {gate0 * o[d], gate0 * o[d + 1], gate0 * o[d + 2], gate0 * o[d + 3]};
    *(float4*)(oa + d) = v;
  }
  __syncthreads();
#if PROBE_NSA == 8
  if (b == 0 && kvh == 0)
    for (int i = tid; i < 64 * 256; i += 256)
      ((float*)(p.ws + OFF_OMOBA))[(size_t)(chunk * 64 + (i >> 8)) * 256 + (i & 255)] = imp[(i >> 8) * 257 + (i & 255)];
  __syncthreads();
#endif
  if (g == 0) {
    int* selp = (int*)(p.ws + OFF_SEL) + (((size_t)b * 2 + kvh) * S + t) * 16;
    const int cur = chunk;
    if (cur < 16) {
      for (int j = 0; j < 16; ++j) selp[j] = (j <= cur) ? j : -1;
    } else {
      selp[0] = 0;
      selp[1] = cur - 1;
      selp[2] = cur;
      float* row = imp + ql * 257;
      for (int j = 3; j < 16; ++j) {
        float best = -1.f;
        int bi = 1;
        for (int n = 1; n <= cur - 2; ++n) {
          float v = row[n];
          if (v > best) { best = v; bi = n; }
        }
        selp[j] = bi;
        row[bi] = -2.f;
      }
    }
  }
  __syncthreads();
}

DEV void kmean_item(const Params& p, int item, float* sm) {
  const int n = item & 63, h = (item >> 6) & 7, b = item >> 9;
  const int tid = tidx(), d = tid & 63, part = tid >> 6;
  const bf16* mkb = (const bf16*)(p.ws + OFF_MKB);
  float a = 0.f;
  for (int i = 0; i < 64; ++i) {
    int t = n * 256 + part * 64 + i;
    a += bf2f(mkb[((size_t)(b * 8 + h) * S + t) * 64 + d]);
  }
  sm[tid] = a;
  __syncthreads();
  if (tid < 64) {
    float s = sm[tid] + sm[64 + tid] + sm[128 + tid] + sm[192 + tid];
    const size_t ko = (((size_t)b * 8 + h) * 64 + n) * 64 + tid;
    const float mean = s * (1.f / 256.f);
    ((float*)(p.ws + OFF_KMEAN))[ko] = mean;
    const bf16 hi = f2bf(mean);
    ((bf16*)(p.ws + OFF_KMHL))[ko] = hi;
    ((bf16*)(p.ws + OFF_KMHL))[(size_t)2 * 8 * 64 * 64 + ko] = f2bf(mean - bf2f(hi));
    if (tid == 0) ((int*)(p.ws + OFF_MCNT))[((b * 8 + h) * 64 + n) * MCNT_STRIDE] = 0;
  }
  __syncthreads();
}

DEV void n23_item(const Params& p, int layer, int item) {
  const int chunk = item & 255, kvh = (item >> 8) & 1, b = item >> 9;
  const int tid = tidx(), ql = tid >> 2, g = tid & 3;
  const int t = chunk * 64 + ql, h = kvh * 4 + g;
  const size_t tok = (size_t)b * S + t;
  const bf16* proj = (const bf16*)(p.ws + OFF_PROJ);
  const float* rope = (const float*)(p.ws + OFF_ROPE) + (size_t)t * 16;
  float q[64];
  load_q64(q, proj + tok * PC + C_NQ + h * 64, 1.0f);
#pragma unroll
  for (int i = 0; i < 8; ++i) {
    float cs = rope[i], sn = rope[8 + i];
    float x1 = q[i], x2 = q[8 + i];
    q[i] = x1 * cs - x2 * sn;
    q[8 + i] = x2 * cs + x1 * sn;
  }
#pragma unroll
  for (int i = 0; i < 64; ++i) q[i] *= 0.125f;
  const size_t kvo = ((size_t)(b * 2 + kvh) * S) * 64;
  const bf16* ksb = (const bf16*)(p.ws + OFF_KSB) + kvo;
  const bf16* vsb = (const bf16*)(p.ws + OFF_VSB) + kvo;
  const bf16* kwb = (const bf16*)(p.ws + OFF_KWB) + kvo;
  const bf16* vwb = (const bf16*)(p.ws + OFF_VWB) + kvo;
  const int* selp = (const int*)(p.ws + OFF_SEL) + (((size_t)b * 2 + kvh) * S + t) * 16;
  float* oa = (float*)(p.ws + OFF_H) + tok * 512 + h * 64;
  const float gate1 = (!PROBE_NSA || (PROBE_NSA & 2)) ? sigmoidf_(bf2f(proj[tok * PC + C_NG + h * 3 + 1])) : 0.f;
  const float gate2 = (!PROBE_NSA || (PROBE_NSA & 4)) ? sigmoidf_(bf2f(proj[tok * PC + C_NG + h * 3 + 2])) : 0.f;
  float o[64];
  {
    float m = -INFINITY;
    for (int j = 0; j < 16; ++j) {
      int n = selp[j];
      if (n >= 0) {
        for (int i = 0; i < 64; ++i) {
          int kpos = n * 64 + i;
          if (kpos <= t) {
            float s = dot64_bf(q, ksb + (size_t)kpos * 64);
            m = fmaxf(m, s);
          }
        }
      }
    }
    float l = 0.f;
#pragma unroll
    for (int d = 0; d < 64; ++d) o[d] = 0.f;
    for (int j = 0; j < 16; ++j) {
      int n = selp[j];
      if (n >= 0) {
        for (int i = 0; i < 64; ++i) {
          int kpos = n * 64 + i;
          if (kpos <= t) {
            float s = dot64_bf(q, ksb + (size_t)kpos * 64);
            float pr = expf(s - m);
            l += pr;
            axpy64_bf(o, pr, vsb + (size_t)kpos * 64);
          }
        }
      }
    }
    float sc = gate1 / l;
#pragma unroll
    for (int d = 0; d < 64; d += 4) {
      float4 v = *(float4*)(oa + d);
      v.x += sc * o[d]; v.y += sc * o[d + 1]; v.z += sc * o[d + 2]; v.w += sc * o[d + 3];
      *(float4*)(oa + d) = v;
    }
  }
  {
    const int s0 = chunk * 64;
    const int jlo = (s0 - 511 > 0) ? (s0 - 511) : 0;
    const int jhi = s0 + 63;
    float m = -INFINITY;
    for (int j = jlo; j <= jhi; ++j) {
      float s = dot64_bf(q, kwb + (size_t)j * 64);
      if (j <= t && j > t - 512) m = fmaxf(m, s);
    }
    float l = 0.f;
#pragma unroll
    for (int d = 0; d < 64; ++d) o[d] = 0.f;
    for (int j = jlo; j <= jhi; ++j) {
      float s = dot64_bf(q, kwb + (size_t)j * 64);
      float pr = (j <= t && j > t - 512) ? expf(s - m) : 0.f;
      l += pr;
      axpy64_bf(o, pr, vwb + (size_t)j * 64);
    }
    float sc = gate2 / l;
    bf16* ob = (bf16*)(p.ws + (PROBE_NSA ? OFF_CMP : OFF_ONSA)) + tok * 512 + h * 64;
#pragma unroll
    for (int d = 0; d < 64; d += 8) {
      float4 v0 = *(float4*)(oa + d);
      float4 v1 = *(float4*)(oa + d + 4);
      uint4 pk;
      pk.x = (unsigned)f2bf(v0.x + sc * o[d]) | ((unsigned)f2bf(v0.y + sc * o[d + 1]) << 16);
      pk.y = (unsigned)f2bf(v0.z + sc * o[d + 2]) | ((unsigned)f2bf(v0.w + sc * o[d + 3]) << 16);
      pk.z = (unsigned)f2bf(v1.x + sc * o[d + 4]) | ((unsigned)f2bf(v1.y + sc * o[d + 5]) << 16);
      pk.w = (unsigned)f2bf(v1.z + sc * o[d + 6]) | ((unsigned)f2bf(v1.w + sc * o[d + 7]) << 16);
      *(uint4*)(ob + d) = pk;
    }
  }
}

DEV void moba_item(const Params& p, int layer, int item) {
  const int blk = item & 63, h = (item >> 6) & 7, b = item >> 9;
  const int tid = tidx();
  const int t = blk * 256 + tid;
  const size_t tok = (size_t)b * S + t;
  const bf16* proj = (const bf16*)(p.ws + OFF_PROJ);
  float q[64];
  load_q64(q, proj + tok * PC + C_MQ + h * 64, 0.125f);
  const float* km = (const float*)(p.ws + OFF_KMEAN) + ((size_t)b * 8 + h) * 64 * 64;
  float b0 = -INFINITY, b1 = -INFINITY, b2 = -INFINITY;
  int i0 = -1, i1 = -1, i2 = -1;
  for (int n = 0; n < blk; ++n) {
    float v = dot64_f(q, km + n * 64);
    if (v > b0) { b2 = b1; i2 = i1; b1 = b0; i1 = i0; b0 = v; i0 = n; }
    else if (v > b1) { b2 = b1; i2 = i1; b1 = v; i1 = n; }
    else if (v > b2) { b2 = v; i2 = n; }
  }
  const bf16* mkb = (const bf16*)(p.ws + OFF_MKB) + ((size_t)(b * 8 + h) * S) * 64;
  const bf16* mvb = (const bf16*)(p.ws + OFF_MVB) + ((size_t)(b * 8 + h) * S) * 64;
  float m = -INFINITY;
  for (int sidx = 0; sidx < 3; ++sidx) {
    int n = (sidx == 0) ? i0 : (sidx == 1) ? i1 : i2;
    if (sidx < blk) {
      for (int i = 0; i < 256; ++i) {
        float s = dot64_bf(q, mkb + (size_t)(n * 256 + i) * 64);
        m = fmaxf(m, s);
      }
    }
  }
  for (int i = 0; i < 256; ++i) {
    int kpos = blk * 256 + i;
    float s = dot64_bf(q, mkb + (size_t)kpos * 64);
    if (kpos <= t) m = fmaxf(m, s);
  }
  float l = 0.f;
  float o[64];
#pragma unroll
  for (int d = 0; d < 64; ++d) o[d] = 0.f;
  for (int sidx = 0; sidx < 3; ++sidx) {
    int n = (sidx == 0) ? i0 : (sidx == 1) ? i1 : i2;
    if (sidx < blk) {
      for (int i = 0; i < 256; ++i) {
        const size_t ko = (size_t)(n * 256 + i) * 64;
        float s = dot64_bf(q, mkb + ko);
        float pr = expf(s - m);
        l += pr;
        axpy64_bf(o, pr, mvb + ko);
      }
    }
  }
  for (int i = 0; i < 256; ++i) {
    int kpos = blk * 256 + i;
    const size_t ko = (size_t)kpos * 64;
    float s = dot64_bf(q, mkb + ko);
    float pr = (kpos <= t) ? expf(s - m) : 0.f;
    l += pr;
    axpy64_bf(o, pr, mvb + ko);
  }
  const float il = 1.f / l;
  bf16* ob = (bf16*)(p.ws + (PROBE_MOBA ? OFF_CMP : OFF_OMOBA)) + tok * 512 + h * 64;
#pragma unroll
  for (int d = 0; d < 64; d += 8) {
    uint4 pk;
    pk.x = (unsigned)f2bf(o[d] * il) | ((unsigned)f2bf(o[d + 1] * il) << 16);
    pk.y = (unsigned)f2bf(o[d + 2] * il) | ((unsigned)f2bf(o[d + 3] * il) << 16);
    pk.z = (unsigned)f2bf(o[d + 4] * il) | ((unsigned)f2bf(o[d + 5] * il) << 16);
    pk.w = (unsigned)f2bf(o[d + 6] * il) | ((unsigned)f2bf(o[d + 7] * il) << 16);
    *(uint4*)(ob + d) = pk;
  }
}

typedef short v4i16_t __attribute__((ext_vector_type(4)));
typedef unsigned u32x4_t __attribute__((ext_vector_type(4)));
DEV v4i16_t lds_tr16(const bf16* p) {
  return __builtin_amdgcn_ds_read_tr16_b64_v4i16((__attribute__((address_space(3))) v4i16_t*)p);
}
DEV unsigned cvtpk(float lo, float hi) {
  unsigned r;
  asm("v_cvt_pk_bf16_f32 %0, %1, %2" : "=v"(r) : "v"(lo), "v"(hi));
  return r;
}
#define MFMA16(a, b, c) __builtin_amdgcn_mfma_f32_16x16x32_bf16(a, b, c, 0, 0, 0)
constexpr float C2 = 0.125f * 1.4426950408889634f;
constexpr int KT_LD = 72;
constexpr int KT_ELEMS = 64 * KT_LD;

template <int NI>
struct AttnSt {
  f32x4 o[4][NI];
  float m[NI], l[NI];
};
template <int NI>
DEV void attn_init(AttnSt<NI>& st) {
#pragma unroll
  for (int ni = 0; ni < NI; ++ni) {
    st.m[ni] = -INFINITY;
    st.l[ni] = 0.f;
#pragma unroll
    for (int di = 0; di < 4; ++di) st.o[di][ni] = f32x4{0.f, 0.f, 0.f, 0.f};
  }
}
#define TILE_DECL uint4 tl_k0, tl_k1, tl_v0, tl_v1
#define TILE_GLOAD(kb, vb, ld, key0)                                                        \
  do {                                                                                      \
    const int r_ = tidx() >> 3, c_ = (tidx() & 7) * 8;                            \
    tl_k0 = *(const uint4*)((kb) + (size_t)((key0) + r_) * (ld) + c_);                      \
    tl_k1 = *(const uint4*)((kb) + (size_t)((key0) + 32 + r_) * (ld) + c_);                 \
    tl_v0 = *(const uint4*)((vb) + (size_t)((key0) + r_) * (ld) + c_);                      \
    tl_v1 = *(const uint4*)((vb) + (size_t)((key0) + 32 + r_) * (ld) + c_);                 \
  } while (0)
#define TILE_SSTORE(Ks_, Vs_)                                                               \
  do {                                                                                      \
    const int r_ = tidx() >> 3, c_ = (tidx() & 7) * 8;                            \
    *(uint4*)((Ks_) + r_ * KT_LD + c_) = tl_k0;                                             \
    *(uint4*)((Ks_) + (32 + r_) * KT_LD + c_) = tl_k1;                                      \
    *(uint4*)((Vs_) + r_ * KT_LD + c_) = tl_v0;                                             \
    *(uint4*)((Vs_) + (32 + r_) * KT_LD + c_) = tl_v1;                                      \
  } while (0)
#define TL_GLOAD(P, kb, vb, ld, key0)                                                       \
  do {                                                                                      \
    const int r_ = tidx() >> 3, c_ = (tidx() & 7) * 8;                                      \
    P##_k0 = *(const uint4*)((kb) + (size_t)((key0) + r_) * (ld) + c_);                     \
    P##_k1 = *(const uint4*)((kb) + (size_t)((key0) + 32 + r_) * (ld) + c_);                \
    P##_v0 = *(const uint4*)((vb) + (size_t)((key0) + r_) * (ld) + c_);                     \
    P##_v1 = *(const uint4*)((vb) + (size_t)((key0) + 32 + r_) * (ld) + c_);                \
  } while (0)
#define TL_SSTORE(P, Ks_, Vs_)                                                              \
  do {                                                                                      \
    const int r_ = tidx() >> 3, c_ = (tidx() & 7) * 8;                                      \
    *(uint4*)((Ks_) + r_ * KT_LD + c_) = P##_k0;                                            \
    *(uint4*)((Ks_) + (32 + r_) * KT_LD + c_) = P##_k1;                                     \
    *(uint4*)((Vs_) + r_ * KT_LD + c_) = P##_v0;                                            \
    *(uint4*)((Vs_) + (32 + r_) * KT_LD + c_) = P##_v1;                                     \
  } while (0)
#define KV_SWEEP(kb_, vb_, ld_, nt_, KEYF, ...)                                             \
  {                                                                                         \
    uint4 tA_k0, tA_k1, tA_v0, tA_v1, tB_k0, tB_k1, tB_v0, tB_v1;                           \
    const int nt__ = (nt_);                                                                 \
    if (nt__ > 0) {                                                                         \
      TL_GLOAD(tA, kb_, vb_, ld_, KEYF(0));                                                 \
      TL_SSTORE(tA, smkv, smkv + KT_ELEMS);                                                 \
      if (nt__ > 1) TL_GLOAD(tA, kb_, vb_, ld_, KEYF(1));                                   \
    }                                                                                       \
    __syncthreads();                                                                        \
    for (int it0__ = 0; it0__ < nt__; it0__ += 2) {                                         \
      {                                                                                     \
        const int it = it0__;                                                               \
        if (it + 2 < nt__) TL_GLOAD(tB, kb_, vb_, ld_, KEYF(it + 2));                       \
        const bf16* Ks = smkv;                                                              \
        __VA_ARGS__                                                                         \
        if (it + 1 < nt__) TL_SSTORE(tA, smkv + 2 * KT_ELEMS, smkv + 3 * KT_ELEMS);         \
        __syncthreads();                                                                    \
      }                                                                                     \
      if (it0__ + 1 < nt__) {                                                               \
        const int it = it0__ + 1;                                                           \
        if (it + 2 < nt__) TL_GLOAD(tA, kb_, vb_, ld_, KEYF(it + 2));                       \
        const bf16* Ks = smkv + 2 * KT_ELEMS;                                               \
        __VA_ARGS__                                                                         \
        if (it + 1 < nt__) TL_SSTORE(tB, smkv, smkv + KT_ELEMS);                            \
        __syncthreads();                                                                    \
      }                                                                                     \
    }                                                                                       \
  }
template <int NI>
DEV void attn_scores(const bf16* Ks, const bf16x8 (&qf)[NI][2], f32x4 (&s)[4][NI]) {
  const int lane = tidx() & 63, g4 = lane >> 4, c16 = lane & 15;
#pragma unroll
  for (int mi = 0; mi < 4; ++mi) {
#pragma unroll
    for (int ni = 0; ni < NI; ++ni) s[mi][ni] = f32x4{0.f, 0.f, 0.f, 0.f};
#pragma unroll
    for (int ks = 0; ks < 2; ++ks) {
      bf16x8 kf = *(const bf16x8*)(Ks + (mi * 16 + c16) * KT_LD + ks * 32 + g4 * 8);
#pragma unroll
      for (int ni = 0; ni < NI; ++ni) s[mi][ni] = MFMA16(kf, qf[ni][ks], s[mi][ni]);
    }
  }
}
template <int NI>
DEV void attn_pv(const bf16* Vs, const bf16x8 (&pf)[NI][2], f32x4 (&o)[4][NI]) {
  const int lane = tidx() & 63, g4 = lane >> 4, q4 = (lane & 15) >> 2, p4 = lane & 3;
#pragma unroll
  for (int di = 0; di < 4; ++di) {
#pragma unroll
    for (int ks2 = 0; ks2 < 2; ++ks2) {
      v4i16_t v0 = lds_tr16(Vs + (ks2 * 32 + g4 * 4 + q4) * KT_LD + di * 16 + p4 * 4);
      v4i16_t v1 = lds_tr16(Vs + (ks2 * 32 + 16 + g4 * 4 + q4) * KT_LD + di * 16 + p4 * 4);
      bf16x8 vf = __builtin_shufflevector(v0, v1, 0, 1, 2, 3, 4, 5, 6, 7);
#pragma unroll
      for (int ni = 0; ni < NI; ++ni) o[di][ni] = MFMA16(vf, pf[ni][ks2], o[di][ni]);
    }
  }
}
DEV void exp4_pack(const f32x4& sv, float nm, float& ps, unsigned& w0, unsigned& w1) {
  float p0 = __builtin_amdgcn_exp2f(__builtin_fmaf(sv[0], C2, nm));
  float p1 = __builtin_amdgcn_exp2f(__builtin_fmaf(sv[1], C2, nm));
  float p2 = __builtin_amdgcn_exp2f(__builtin_fmaf(sv[2], C2, nm));
  float p3 = __builtin_amdgcn_exp2f(__builtin_fmaf(sv[3], C2, nm));
  ps += (p0 + p1) + (p2 + p3);
  w0 = cvtpk(p0, p1);
  w1 = cvtpk(p2, p3);
}
template <int NI>
DEV void attn_softmax_pv(const bf16* Vs, f32x4 (&s)[4][NI], AttnSt<NI>& st) {
  bf16x8 pf[NI][2];
#pragma unroll
  for (int ni = 0; ni < NI; ++ni) {
    float mx = -INFINITY;
#pragma unroll
    for (int mi = 0; mi < 4; ++mi)
      mx = fmaxf(fmaxf(mx, fmaxf(s[mi][ni][0], s[mi][ni][1])), fmaxf(s[mi][ni][2], s[mi][ni][3]));
    mx = fmaxf(mx, shx(mx, 16));
    mx = fmaxf(mx, shx(mx, 32));
    const float mn = fmaxf(st.m[ni], mx);
    const float mu = (mn == -INFINITY) ? 0.f : mn;
    const float corr = __builtin_amdgcn_exp2f((st.m[ni] - mu) * C2);
    st.m[ni] = mn;
    const float nm = -mu * C2;
    float ps = 0.f;
    u32x4_t wa, wb;
    unsigned t0, t1;
    exp4_pack(s[0][ni], nm, ps, t0, t1); wa.x = t0; wa.y = t1;
    exp4_pack(s[1][ni], nm, ps, t0, t1); wa.z = t0; wa.w = t1;
    exp4_pack(s[2][ni], nm, ps, t0, t1); wb.x = t0; wb.y = t1;
    exp4_pack(s[3][ni], nm, ps, t0, t1); wb.z = t0; wb.w = t1;
    st.l[ni] = st.l[ni] * corr + ps;
#pragma unroll
    for (int di = 0; di < 4; ++di) {
      st.o[di][ni][0] *= corr; st.o[di][ni][1] *= corr; st.o[di][ni][2] *= corr; st.o[di][ni][3] *= corr;
    }
    pf[ni][0] = __builtin_bit_cast(bf16x8, wa);
    pf[ni][1] = __builtin_bit_cast(bf16x8, wb);
  }
  attn_pv<NI>(Vs, pf, st.o);
}

template <int NI>
DEV void attn_softmax_pv_act(const bf16* Vs, f32x4 (&s)[4][NI], AttnSt<NI>& st, const bool (&act)[NI]) {
  bf16x8 pf[NI][2];
#pragma unroll
  for (int ni = 0; ni < NI; ++ni) {
    pf[ni][0] = bf16x8{0, 0, 0, 0, 0, 0, 0, 0};
    pf[ni][1] = bf16x8{0, 0, 0, 0, 0, 0, 0, 0};
    if (act[ni]) {
      float mx = -INFINITY;
#pragma unroll
      for (int mi = 0; mi < 4; ++mi)
        mx = fmaxf(fmaxf(mx, fmaxf(s[mi][ni][0], s[mi][ni][1])), fmaxf(s[mi][ni][2], s[mi][ni][3]));
      mx = fmaxf(mx, shx(mx, 16));
      mx = fmaxf(mx, shx(mx, 32));
      const float mn = fmaxf(st.m[ni], mx);
      const float mu = (mn == -INFINITY) ? 0.f : mn;
      const float corr = __builtin_amdgcn_exp2f((st.m[ni] - mu) * C2);
      st.m[ni] = mn;
      const float nm = -mu * C2;
      float ps = 0.f;
      u32x4_t wa, wb;
      unsigned t0, t1;
      exp4_pack(s[0][ni], nm, ps, t0, t1); wa.x = t0; wa.y = t1;
      exp4_pack(s[1][ni], nm, ps, t0, t1); wa.z = t0; wa.w = t1;
      exp4_pack(s[2][ni], nm, ps, t0, t1); wb.x = t0; wb.y = t1;
      exp4_pack(s[3][ni], nm, ps, t0, t1); wb.z = t0; wb.w = t1;
      st.l[ni] = st.l[ni] * corr + ps;
#pragma unroll
      for (int di = 0; di < 4; ++di) {
        st.o[di][ni][0] *= corr; st.o[di][ni][1] *= corr; st.o[di][ni][2] *= corr; st.o[di][ni][3] *= corr;
      }
      pf[ni][0] = __builtin_bit_cast(bf16x8, wa);
      pf[ni][1] = __builtin_bit_cast(bf16x8, wb);
    }
  }
  const int lane = tidx() & 63, g4 = lane >> 4, q4 = (lane & 15) >> 2, p4 = lane & 3;
#pragma unroll
  for (int di = 0; di < 4; ++di) {
#pragma unroll
    for (int ks2 = 0; ks2 < 2; ++ks2) {
      v4i16_t v0 = lds_tr16(Vs + (ks2 * 32 + g4 * 4 + q4) * KT_LD + di * 16 + p4 * 4);
      v4i16_t v1 = lds_tr16(Vs + (ks2 * 32 + 16 + g4 * 4 + q4) * KT_LD + di * 16 + p4 * 4);
      bf16x8 vf = __builtin_shufflevector(v0, v1, 0, 1, 2, 3, 4, 5, 6, 7);
#pragma unroll
      for (int ni = 0; ni < NI; ++ni)
        if (act[ni]) st.o[di][ni] = MFMA16(vf, pf[ni][ks2], st.o[di][ni]);
    }
  }
}
template <int NI>
DEV int gate_top1(f32x4 (&gs)[4][NI], int ni, int g4) {
  float bv = -INFINITY;
  int bi = 1 << 20;
#pragma unroll
  for (int mi = 0; mi < 4; ++mi)
#pragma unroll
    for (int r = 0; r < 4; ++r) {
      float v = gs[mi][ni][r];
      if (v > bv) { bv = v; bi = mi * 16 + g4 * 4 + r; }
    }
#pragma unroll
  for (int off = 16; off <= 32; off <<= 1) {
    float ov = shx(bv, off);
    int oi = shx(bi, off);
    if (ov > bv || (ov == bv && oi < bi)) { bv = ov; bi = oi; }
  }
#pragma unroll
  for (int mi = 0; mi < 4; ++mi)
#pragma unroll
    for (int r = 0; r < 4; ++r)
      if (mi * 16 + g4 * 4 + r == bi) gs[mi][ni][r] = -INFINITY;
  return (bv == -INFINITY) ? -1 : bi;
}
template <int NI>
DEV void moba_mfma_item(const Params& p, int item, char* smem, bf16* outbuf) {
  constexpr int QB = 64 * NI;
  bf16* sm = (bf16*)smem;
  const int bh = item & 15, cq = (S / QB - 1) - (item >> 4);
  const int b = bh >> 3, h = bh & 7;
  const int s0 = cq * QB, blk = s0 >> 8;
  const int lane = tidx() & 63, wave = tidx() >> 6, g4 = lane >> 4, c16 = lane & 15;
  const bf16* proj = (const bf16*)(p.ws + OFF_PROJ) + (size_t)b * S * PC;
  bf16x8 qf[NI][2];
  int tq[NI];
#pragma unroll
  for (int ni = 0; ni < NI; ++ni) {
    tq[ni] = s0 + wave * 16 * NI + ni * 16 + c16;
#pragma unroll
    for (int ks = 0; ks < 2; ++ks)
      qf[ni][ks] = *(const bf16x8*)(proj + (size_t)tq[ni] * PC + C_MQ + h * 64 + ks * 32 + g4 * 8);
  }
  int i0[NI], i1[NI], i2[NI];
  {
    const bf16* kmh = (const bf16*)(p.ws + OFF_KMHL) + ((size_t)(b * 8 + h) * 64) * 64;
    const bf16* kml = kmh + (size_t)2 * 8 * 64 * 64;
    f32x4 gs[4][NI];
#pragma unroll
    for (int mi = 0; mi < 4; ++mi) {
#pragma unroll
      for (int ni = 0; ni < NI; ++ni) gs[mi][ni] = f32x4{0.f, 0.f, 0.f, 0.f};
#pragma unroll
      for (int ks = 0; ks < 2; ++ks) {
        bf16x8 ah = *(const bf16x8*)(kmh + (mi * 16 + c16) * 64 + ks * 32 + g4 * 8);
        bf16x8 al_ = *(const bf16x8*)(kml + (mi * 16 + c16) * 64 + ks * 32 + g4 * 8);
#pragma unroll
        for (int ni = 0; ni < NI; ++ni) {
          gs[mi][ni] = MFMA16(ah, qf[ni][ks], gs[mi][ni]);
          gs[mi][ni] = MFMA16(al_, qf[ni][ks], gs[mi][ni]);
        }
      }
    }
#pragma unroll
    for (int ni = 0; ni < NI; ++ni) {
#pragma unroll
      for (int mi = 0; mi < 4; ++mi)
#pragma unroll
        for (int r = 0; r < 4; ++r)
          if (mi * 16 + g4 * 4 + r >= blk) gs[mi][ni][r] = -INFINITY;
      i0[ni] = gate_top1(gs, ni, g4);
      i1[ni] = gate_top1(gs, ni, g4);
      i2[ni] = gate_top1(gs, ni, g4);
    }
  }
  AttnSt<NI> st;
  attn_init<NI>(st);
  const int ntiles = (s0 + QB) >> 6;
  const bf16* kb = (const bf16*)(p.ws + OFF_MKB) + ((size_t)(b * 8 + h) * S) * 64;
  const bf16* vb = (const bf16*)(p.ws + OFF_MVB) + ((size_t)(b * 8 + h) * S) * 64;
  bf16* smkv = sm;
  __syncthreads();
#define MOBA_KEY(i) ((i) * 64)
  KV_SWEEP(kb, vb, 64, ntiles, MOBA_KEY,
    const int n = it >> 2;
    const bool own = (n == blk);
    const int kbase = it * 64;
    bool wave_active = own;
    if (!own) {
      bool anyq = false;
      _Pragma("unroll") for (int ni = 0; ni < NI; ++ni) anyq = anyq || (n == i0[ni]) || (n == i1[ni]) || (n == i2[ni]);
      wave_active = __builtin_amdgcn_ballot_w64(anyq) != 0ull;
    }
    if (wave_active) {
      f32x4 s[4][NI];
      attn_scores<NI>(Ks, qf, s);
      _Pragma("unroll") for (int ni = 0; ni < NI; ++ni) {
        if (own) {
          _Pragma("unroll") for (int mi = 0; mi < 4; ++mi)
            _Pragma("unroll") for (int r = 0; r < 4; ++r)
              if (kbase + mi * 16 + g4 * 4 + r > tq[ni]) s[mi][ni][r] = -INFINITY;
        } else {
          const bool okb = (n == i0[ni]) | (n == i1[ni]) | (n == i2[ni]);
          if (!okb) {
            _Pragma("unroll") for (int mi = 0; mi < 4; ++mi) s[mi][ni] = f32x4{-INFINITY, -INFINITY, -INFINITY, -INFINITY};
          }
        }
      }
      attn_softmax_pv<NI>(Ks + KT_ELEMS, s, st);
    }
  )
#pragma unroll
  for (int ni = 0; ni < NI; ++ni) {
    float l = st.l[ni];
    l += shx(l, 16);
    l += shx(l, 32);
    const float inv = 1.f / l;
    bf16* op = outbuf + ((size_t)b * S + tq[ni]) * 512 + h * 64 + g4 * 4;
#pragma unroll
    for (int di = 0; di < 4; ++di) {
      uint2 pk;
      pk.x = cvtpk(st.o[di][ni][0] * inv, st.o[di][ni][1] * inv);
      pk.y = cvtpk(st.o[di][ni][2] * inv, st.o[di][ni][3] * inv);
      *(uint2*)(op + di * 16) = pk;
    }
  }
}

DEV int moba_list_base(int n) { return n * S - 128 * n * (n + 1); }
template <int NI>
DEV void moba_gate_batch(const Params& p, int item0, int istride, int nitems, int* sm) {
  constexpr int QB = 64 * NI;
  constexpr int MAXB = 4;
  const int tid = tidx(), lane = tid & 63, wave = tid >> 6, g4 = lane >> 4, c16 = lane & 15;
  int* hist = sm;
  int* base = sm + MAXB * 64;
  hist[tid] = 0;
  __syncthreads();
  int sel[MAXB][NI][3], rk[MAXB][NI][3], tqs[MAXB][NI];
#pragma unroll
  for (int j = 0; j < MAXB; ++j) {
    const int item = item0 + j * istride;
    const int bh = item & 15, cq = item >> 4;
    const int b = bh >> 3, h = bh & 7;
    const int s0 = cq * QB, blk = s0 >> 8;
    const bool live = (j < nitems) && (blk > 0);
#pragma unroll
    for (int ni = 0; ni < NI; ++ni) {
      tqs[j][ni] = s0 + wave * 16 * NI + ni * 16 + c16;
#pragma unroll
      for (int k = 0; k < 3; ++k) { sel[j][ni][k] = -1; rk[j][ni][k] = 0; }
    }
    if (!live) continue;
    const bf16* proj = (const bf16*)(p.ws + OFF_PROJ) + (size_t)b * S * PC;
    bf16x8 qf[NI][2];
#pragma unroll
    for (int ni = 0; ni < NI; ++ni)
#pragma unroll
      for (int ks = 0; ks < 2; ++ks)
        qf[ni][ks] = *(const bf16x8*)(proj + (size_t)tqs[j][ni] * PC + C_MQ + h * 64 + ks * 32 + g4 * 8);
    const bf16* kmh = (const bf16*)(p.ws + OFF_KMHL) + ((size_t)(b * 8 + h) * 64) * 64;
    const bf16* kml = kmh + (size_t)2 * 8 * 64 * 64;
    f32x4 gs[4][NI];
#pragma unroll
    for (int mi = 0; mi < 4; ++mi) {
#pragma unroll
      for (int ni = 0; ni < NI; ++ni) gs[mi][ni] = f32x4{0.f, 0.f, 0.f, 0.f};
#pragma unroll
      for (int ks = 0; ks < 2; ++ks) {
        bf16x8 ah = *(const bf16x8*)(kmh + (mi * 16 + c16) * 64 + ks * 32 + g4 * 8);
        bf16x8 al_ = *(const bf16x8*)(kml + (mi * 16 + c16) * 64 + ks * 32 + g4 * 8);
#pragma unroll
        for (int ni = 0; ni < NI; ++ni) {
          gs[mi][ni] = MFMA16(ah, qf[ni][ks], gs[mi][ni]);
          gs[mi][ni] = MFMA16(al_, qf[ni][ks], gs[mi][ni]);
        }
      }
    }
#pragma unroll
    for (int ni = 0; ni < NI; ++ni) {
#pragma unroll
      for (int mi = 0; mi < 4; ++mi)
#pragma unroll
        for (int r = 0; r < 4; ++r)
          if (mi * 16 + g4 * 4 + r >= blk) gs[mi][ni][r] = -INFINITY;
#pragma unroll
      for (int k = 0; k < 3; ++k) {
        sel[j][ni][k] = gate_top1(gs, ni, g4);
        rk[j][ni][k] = (g4 == 0 && sel[j][ni][k] >= 0) ? atomicAdd(&hist[j * 64 + sel[j][ni][k]], 1) : 0;
      }
    }
  }
  __syncthreads();
  {
    const int j = tid >> 6, n = tid & 63;
    const int item = item0 + j * istride;
    const int c = hist[tid];
    int* cnt = (int*)(p.ws + OFF_MCNT) + (size_t)(item & 15) * 64 * MCNT_STRIDE;
    base[tid] = (c > 0) ? atomicAdd(cnt + n * MCNT_STRIDE, c) : 0;
  }
  __syncthreads();
  if (g4 == 0) {
#pragma unroll
    for (int j = 0; j < MAXB; ++j) {
      const int item = item0 + j * istride;
      unsigned short* lists = (unsigned short*)(p.ws + OFF_MLIST) + (size_t)(item & 15) * MLIST_PER_BH;
#pragma unroll
      for (int ni = 0; ni < NI; ++ni)
#pragma unroll
        for (int k = 0; k < 3; ++k) {
          const int sv = sel[j][ni][k];
          if (sv >= 0) lists[moba_list_base(sv) + base[j * 64 + sv] + rk[j][ni][k]] = (unsigned short)(tqs[j][ni] | (k << 14));
        }
    }
  }
  __syncthreads();
}
template <int NI>
DEV void moba_part_item(const Params& p, int b, int item, char* smem) {
  constexpr int CH = 64 * NI;
  bf16* smkv = (bf16*)smem;
  const int n = item >> 6, h = (item >> 3) & 7, part = item & 7;
  const int lane = tidx() & 63, wave = tidx() >> 6, g4 = lane >> 4, c16 = lane & 15;
  const int cnt = ((const int*)(p.ws + OFF_MCNT))[((b * 8 + h) * 64 + n) * MCNT_STRIDE];
  const unsigned short* list = (const unsigned short*)(p.ws + OFF_MLIST) + (size_t)(b * 8 + h) * MLIST_PER_BH + moba_list_base(n);
  const bf16* proj = (const bf16*)(p.ws + OFF_PROJ) + (size_t)b * S * PC;
  const bf16* kb = (const bf16*)(p.ws + OFF_MKB) + ((size_t)(b * 8 + h) * S + n * 256) * 64;
  const bf16* vb = (const bf16*)(p.ws + OFF_MVB) + ((size_t)(b * 8 + h) * S + n * 256) * 64;
  bf16* po = (bf16*)(p.ws + OFF_MPO);
  float2* pml = (float2*)(p.ws + OFF_MPML);
  for (int c = part; c * CH < cnt; c += 8) {
    bf16x8 qf[NI][2];
    int tcol[NI], slot[NI];
    bool valid[NI];
#pragma unroll
    for (int ni = 0; ni < NI; ++ni) {
      const int idx = c * CH + wave * 16 * NI + ni * 16 + c16;
      valid[ni] = idx < cnt;
      const unsigned e = list[valid[ni] ? idx : 0];
      tcol[ni] = e & 0x3FFF;
      slot[ni] = e >> 14;
#pragma unroll
      for (int ks = 0; ks < 2; ++ks)
        qf[ni][ks] = *(const bf16x8*)(proj + (size_t)tcol[ni] * PC + C_MQ + h * 64 + ks * 32 + g4 * 8);
    }
    AttnSt<NI> st;
    attn_init<NI>(st);
    __syncthreads();
#define MOBA_PKEY(i) ((i) * 64)
    KV_SWEEP(kb, vb, 64, 4, MOBA_PKEY,
      f32x4 s[4][NI];
      attn_scores<NI>(Ks, qf, s);
      attn_softmax_pv<NI>(Ks + KT_ELEMS, s, st);
    )
#pragma unroll
    for (int ni = 0; ni < NI; ++ni) {
      float l = st.l[ni];
      l += shx(l, 16);
      l += shx(l, 32);
      if (valid[ni]) {
        const size_t rec = ((size_t)h * S + tcol[ni]) * 3 + slot[ni];
        if (g4 == 0) pml[rec] = float2{st.m[ni], l};
        bf16* op = po + rec * 64 + g4 * 4;
#pragma unroll
        for (int di = 0; di < 4; ++di) {
          uint2 pk;
          pk.x = cvtpk(st.o[di][ni][0], st.o[di][ni][1]);
          pk.y = cvtpk(st.o[di][ni][2], st.o[di][ni][3]);
          *(uint2*)(op + di * 16) = pk;
        }
      }
    }
  }
}
template <int NI>
DEV void moba_part_item2(const Params& p, int b, int item, char* smem) {
  constexpr int WCH = 16 * NI;
  bf16* Kall = (bf16*)smem;
  bf16* Vall = Kall + 256 * KT_LD;
  static_assert(2 * 256 * KT_LD * 2 <= SMEM_BYTES, "moba block staging");
  constexpr int NPART = MOBA_NPART;
  const int n = item / (8 * NPART), h = (item / NPART) & 7, part = item % NPART;
  const int tid = tidx(), lane = tid & 63, wave = tid >> 6, g4 = lane >> 4, c16 = lane & 15;
  const int cnt = ((const int*)(p.ws + OFF_MCNT))[((b * 8 + h) * 64 + n) * MCNT_STRIDE];
  const bool active = part * 4 * WCH < cnt;
  const unsigned short* list = (const unsigned short*)(p.ws + OFF_MLIST) + (size_t)(b * 8 + h) * MLIST_PER_BH + moba_list_base(n);
  const bf16* proj = (const bf16*)(p.ws + OFF_PROJ) + (size_t)b * S * PC;
  const bf16* kb = (const bf16*)(p.ws + OFF_MKB) + ((size_t)(b * 8 + h) * S + n * 256) * 64;
  const bf16* vb = (const bf16*)(p.ws + OFF_MVB) + ((size_t)(b * 8 + h) * S + n * 256) * 64;
  bf16* po = (bf16*)(p.ws + OFF_MPO);
  float2* pml = (float2*)(p.ws + OFF_MPML);
  __syncthreads();
  if (active) {
#pragma unroll
    for (int i = 0; i < 8; ++i) {
      const int id = tid + 256 * i, r = id >> 3, c = (id & 7) * 8;
      const uint4 kv = *(const uint4*)(kb + (size_t)r * 64 + c);
      const uint4 vv = *(const uint4*)(vb + (size_t)r * 64 + c);
      *(uint4*)(Kall + r * KT_LD + c) = kv;
      *(uint4*)(Vall + r * KT_LD + c) = vv;
    }
  }
  __syncthreads();
  if (!active) return;
  for (int wc = part * 4 + wave; wc * WCH < cnt; wc += 4 * NPART) {
    bf16x8 qf[NI][2];
    int tcol[NI], slot[NI];
    bool valid[NI];
#pragma unroll
    for (int ni = 0; ni < NI; ++ni) {
      const int idx = wc * WCH + ni * 16 + c16;
      valid[ni] = idx < cnt;
      const unsigned e = list[valid[ni] ? idx : 0];
      tcol[ni] = e & 0x3FFF;
      slot[ni] = e >> 14;
#pragma unroll
      for (int ks = 0; ks < 2; ++ks)
        qf[ni][ks] = *(const bf16x8*)(proj + (size_t)tcol[ni] * PC + C_MQ + h * 64 + ks * 32 + g4 * 8);
    }
    AttnSt<NI> st;
    attn_init<NI>(st);
#pragma unroll 1
    for (int kt = 0; kt < 4; ++kt) {
      f32x4 s[4][NI];
      attn_scores<NI>(Kall + kt * 64 * KT_LD, qf, s);
      attn_softmax_pv<NI>(Vall + kt * 64 * KT_LD, s, st);
    }
#pragma unroll
    for (int ni = 0; ni < NI; ++ni) {
      float l = st.l[ni];
      l += shx(l, 16);
      l += shx(l, 32);
      if (valid[ni]) {
        const size_t rec = ((size_t)h * S + tcol[ni]) * 3 + slot[ni];
        if (g4 == 0) pml[rec] = float2{st.m[ni], l};
        bf16* op = po + rec * 64 + g4 * 4;
#pragma unroll
        for (int di = 0; di < 4; ++di) {
          uint2 pk;
          pk.x = cvtpk(st.o[di][ni][0], st.o[di][ni][1]);
          pk.y = cvtpk(st.o[di][ni][2], st.o[di][ni][3]);
          *(uint2*)(op + di * 16) = pk;
        }
      }
    }
  }
}
template <int NI>
DEV void moba_merge_item(const Params& p, int b, int item, char* smem, bf16* outbuf) {
  constexpr int QB = 64 * NI;
  constexpr int NCQ = S / QB;
  bf16* smkv = (bf16*)smem;
  const int h = item & 7, cq = item >> 3;
  static_assert(NCQ * 8 == 8 * (S / QB), "");
  const int s0 = cq * QB, blk = s0 >> 8;
  const int lane = tidx() & 63, wave = tidx() >> 6, g4 = lane >> 4, c16 = lane & 15;
  const bf16* proj = (const bf16*)(p.ws + OFF_PROJ) + (size_t)b * S * PC;
  bf16x8 qf[NI][2];
  int tq[NI];
#pragma unroll
  for (int ni = 0; ni < NI; ++ni) {
    tq[ni] = s0 + wave * 16 * NI + ni * 16 + c16;
#pragma unroll
    for (int ks = 0; ks < 2; ++ks)
      qf[ni][ks] = *(const bf16x8*)(proj + (size_t)tq[ni] * PC + C_MQ + h * 64 + ks * 32 + g4 * 8);
  }
  const bf16* kb = (const bf16*)(p.ws + OFF_MKB) + ((size_t)(b * 8 + h) * S) * 64;
  const bf16* vb = (const bf16*)(p.ws + OFF_MVB) + ((size_t)(b * 8 + h) * S) * 64;
  AttnSt<NI> st;
  attn_init<NI>(st);
  const int kt0 = blk * 4;
  const int ntl = ((s0 + QB - 1) >> 6) - kt0 + 1;
  __syncthreads();
#define MOBA_MKEY(i) ((kt0 + (i)) * 64)
  KV_SWEEP(kb, vb, 64, ntl, MOBA_MKEY,
    const int kbase = (kt0 + it) * 64;
    f32x4 s[4][NI];
    attn_scores<NI>(Ks, qf, s);
    _Pragma("unroll") for (int ni = 0; ni < NI; ++ni)
      _Pragma("unroll") for (int mi = 0; mi < 4; ++mi)
        _Pragma("unroll") for (int r = 0; r < 4; ++r)
          if (kbase + mi * 16 + g4 * 4 + r > tq[ni]) s[mi][ni][r] = -INFINITY;
    attn_softmax_pv<NI>(Ks + KT_ELEMS, s, st);
  )
  const int nsl = (blk < 3) ? blk : 3;
  const bf16* po = (const bf16*)(p.ws + OFF_MPO);
  const float2* pml = (const float2*)(p.ws + OFF_MPML);
#pragma unroll
  for (int ni = 0; ni < NI; ++ni) {
    float l = st.l[ni];
    l += shx(l, 16);
    l += shx(l, 32);
    const size_t rec0 = ((size_t)h * S + tq[ni]) * 3;
    float ms[3], ls[3];
    float M = st.m[ni];
#pragma unroll
    for (int s = 0; s < 3; ++s) {
      ms[s] = -INFINITY;
      ls[s] = 0.f;
      if (s < nsl) {
        const float2 v = pml[rec0 + s];
        ms[s] = v.x;
        ls[s] = v.y;
        M = fmaxf(M, v.x);
      }
    }
    const float fo = __builtin_amdgcn_exp2f((st.m[ni] - M) * C2);
    l *= fo;
    float f[3];
#pragma unroll
    for (int s = 0; s < 3; ++s) {
      f[s] = (s < nsl) ? __builtin_amdgcn_exp2f((ms[s] - M) * C2) : 0.f;
      l += ls[s] * f[s];
    }
    const float inv = 1.f / l;
    bf16* op = outbuf + ((size_t)b * S + tq[ni]) * 512 + h * 64 + g4 * 4;
#pragma unroll
    for (int di = 0; di < 4; ++di) {
      float o0 = st.o[di][ni][0] * fo, o1 = st.o[di][ni][1] * fo, o2 = st.o[di][ni][2] * fo, o3 = st.o[di][ni][3] * fo;
#pragma unroll
      for (int s = 0; s < 3; ++s) {
        if (s < nsl) {
          const uint2 pv = *(const uint2*)(po + (rec0 + s) * 64 + di * 16 + g4 * 4);
          o0 += f[s] * __uint_as_float(pv.x << 16);
          o1 += f[s] * __uint_as_float(pv.x & 0xffff0000u);
          o2 += f[s] * __uint_as_float(pv.y << 16);
          o3 += f[s] * __uint_as_float(pv.y & 0xffff0000u);
        }
      }
      uint2 pk;
      pk.x = cvtpk(o0 * inv, o1 * inv);
      pk.y = cvtpk(o2 * inv, o3 * inv);
      *(uint2*)(op + di * 16) = pk;
    }
  }
}

template <int NI>
DEV void attn_stats(f32x4 (&s)[4][NI], float (&m)[NI], float (&l)[NI]) {
#pragma unroll
  for (int ni = 0; ni < NI; ++ni) {
    float mx = -INFINITY;
#pragma unroll
    for (int mi = 0; mi < 4; ++mi)
      mx = fmaxf(fmaxf(mx, fmaxf(s[mi][ni][0], s[mi][ni][1])), fmaxf(s[mi][ni][2], s[mi][ni][3]));
    mx = fmaxf(mx, shx(mx, 16));
    mx = fmaxf(mx, shx(mx, 32));
    const float mn = fmaxf(m[ni], mx);
    const float mu = (mn == -INFINITY) ? 0.f : mn;
    const float corr = __builtin_amdgcn_exp2f((m[ni] - mu) * C2);
    m[ni] = mn;
    const float nm = -mu * C2;
    float ps = 0.f;
#pragma unroll
    for (int mi = 0; mi < 4; ++mi)
#pragma unroll
      for (int r = 0; r < 4; ++r) ps += __builtin_amdgcn_exp2f(__builtin_fmaf(s[mi][ni][r], C2, nm));
    l[ni] = l[ni] * corr + ps;
  }
}
DEV bf16x8 rope_frag(bf16x8 qv, const float* __restrict__ rope_t, int g4) {
  u32x4_t w = __builtin_bit_cast(u32x4_t, qv);
  u32x4_t pw;
  pw.x = shx(w.x, 16); pw.y = shx(w.y, 16); pw.z = shx(w.z, 16); pw.w = shx(w.w, 16);
  float f[8], pf[8];
  unpack8(uint4{w.x, w.y, w.z, w.w}, f);
  unpack8(uint4{pw.x, pw.y, pw.z, pw.w}, pf);
  const float4 c0 = *(const float4*)(rope_t), c1 = *(const float4*)(rope_t + 4);
  const float4 s0 = *(const float4*)(rope_t + 8), s1 = *(const float4*)(rope_t + 12);
  const float cs[8] = {c0.x, c0.y, c0.z, c0.w, c1.x, c1.y, c1.z, c1.w};
  const float sn[8] = {s0.x, s0.y, s0.z, s0.w, s1.x, s1.y, s1.z, s1.w};
  const float sg = (g4 == 0) ? -1.f : 1.f;
  float o[8];
#pragma unroll
  for (int i = 0; i < 8; ++i) o[i] = (g4 < 2) ? (f[i] * cs[i] + sg * pf[i] * sn[i]) : f[i];
  u32x4_t r;
  r.x = cvtpk(o[0], o[1]); r.y = cvtpk(o[2], o[3]); r.z = cvtpk(o[4], o[5]); r.w = cvtpk(o[6], o[7]);
  return __builtin_bit_cast(bf16x8, r);
}

DEV unsigned pack4_fp8q(float a, float b, float c, float d) {
  int q = __builtin_amdgcn_cvt_pk_fp8_f32(a, b, 0, false);
  q = __builtin_amdgcn_cvt_pk_fp8_f32(c, d, q, true);
  return (unsigned)q;
}
DEV float amax8_bf16(uint4 v, float m) {
  float f[8];
  unpack8(v, f);
#pragma unroll
  for (int i = 0; i < 8; ++i) m = fmaxf(m, fabsf(f[i]));
  return m;
}
DEV void kvamax_item(const Params& p, int layer, int item) {
  const int tid = tidx();
  const int bk = item >> 6, part = item & 63;
  const bf16* kp = (const bf16*)(p.ws + OFF_KSB) + ((size_t)bk * S + part * 256) * 64 + tid * 64;
  const bf16* vp = (const bf16*)(p.ws + OFF_VSB) + ((size_t)bk * S + part * 256) * 64 + tid * 64;
  float mk = 0.f, mv = 0.f;
#pragma unroll
  for (int i = 0; i < 8; ++i) {
    mk = amax8_bf16(*(const uint4*)(kp + i * 8), mk);
    mv = amax8_bf16(*(const uint4*)(vp + i * 8), mv);
  }
#pragma unroll
  for (int o = 32; o >= 1; o >>= 1) { mk = fmaxf(mk, shx(mk, o)); mv = fmaxf(mv, shx(mv, o)); }
  if ((tid & 63) == 0) {
    atomicMax((unsigned*)(p.ws + OFF_BAR) + 2 + 2 * layer, (unsigned)__float_as_int(mk));
    atomicMax((unsigned*)(p.ws + OFF_BAR) + 3 + 2 * layer, (unsigned)__float_as_int(mv));
  }
}
DEV float kv_amax(const Params& p, int layer, int which) {
  return __int_as_float((int)__hip_atomic_load((const unsigned*)(p.ws + OFF_BAR) + 2 + 2 * layer + which, __ATOMIC_RELAXED, __HIP_MEMORY_SCOPE_AGENT));
}
DEV void kvq_item(const Params& p, int layer, int item, float* sm) {
  const int tid = tidx();
  const int bk = item >> 8, blk = item & 255;
  const float ak = kv_amax(p, layer, 0), av = kv_amax(p, layer, 1);
  const float ik = (ak > 0.f) ? 224.f / ak : 0.f, iv = (av > 0.f) ? 224.f / av : 0.f;
  const size_t row0 = (size_t)bk * S + blk * 64;
  {
    const int r = tid >> 2, q = tid & 3;
    const bf16* kp = (const bf16*)(p.ws + OFF_KSB) + (row0 + r) * 64 + q * 16;
    float f[16];
    unpack8(*(const uint4*)kp, f);
    unpack8(*(const uint4*)(kp + 8), f + 8);
    uint2 o0, o1;
    o0.x = pack4_fp8q(f[0] * ik, f[1] * ik, f[2] * ik, f[3] * ik);
    o0.y = pack4_fp8q(f[4] * ik, f[5] * ik, f[6] * ik, f[7] * ik);
    o1.x = pack4_fp8q(f[8] * ik, f[9] * ik, f[10] * ik, f[11] * ik);
    o1.y = pack4_fp8q(f[12] * ik, f[13] * ik, f[14] * ik, f[15] * ik);
    unsigned char* kd = (unsigned char*)(p.ws + OFF_KS8) + (row0 + r) * 64 + 32 * (q & 1) + 8 * (q >> 1);
    *(uint2*)kd = o0;
    *(uint2*)(kd + 16) = o1;
    const bf16* vp = (const bf16*)(p.ws + OFF_VSB) + (row0 + r) * 64 + q * 16;
    unpack8(*(const uint4*)vp, f);
    unpack8(*(const uint4*)(vp + 8), f + 8);
#pragma unroll
    for (int i = 0; i < 16; ++i) sm[r * 65 + q * 16 + i] = f[i] * iv;
  }
  __syncthreads();
  {
    const int d = tid >> 2, q = tid & 3;
    float f[16];
#pragma unroll
    for (int i = 0; i < 16; ++i) {
      const int g4 = q, ks2 = i >> 3, j = i & 7;
      const int key = 32 * ks2 + 16 * (j >> 2) + 4 * g4 + (j & 3);
      f[i] = sm[key * 65 + d];
    }
    uint4 o;
    o.x = pack4_fp8q(f[0], f[1], f[2], f[3]);
    o.y = pack4_fp8q(f[4], f[5], f[6], f[7]);
    o.z = pack4_fp8q(f[8], f[9], f[10], f[11]);
    o.w = pack4_fp8q(f[12], f[13], f[14], f[15]);
    *(uint4*)((unsigned char*)(p.ws + OFF_VT8) + row0 * 64 + d * 64 + q * 16) = o;
  }
  __syncthreads();
}
typedef long i64_t;
#define MFMA8(a, b, c) __builtin_amdgcn_mfma_f32_16x16x32_fp8_fp8(a, b, c, 0, 0, 0)
template <int NI>
DEV void softmax_one8(f32x4 (&s)[4], AttnSt<NI>& st, f32x4& lacc, int ni, float c2, bool sel, i64_t& pf0, i64_t& pf1) {
  float mx = -INFINITY;
#pragma unroll
  for (int mi = 0; mi < 4; ++mi)
    mx = fmaxf(fmaxf(mx, fmaxf(s[mi][0], s[mi][1])), fmaxf(s[mi][2], s[mi][3]));
  mx = fmaxf(mx, shx(mx, 16));
  mx = fmaxf(mx, shx(mx, 32));
  const float mxs = sel ? mx * c2 : -INFINITY;
  if (__builtin_amdgcn_ballot_w64(mxs > st.m[ni] + 1.0f) != 0ull) {
    const float mn = fmaxf(st.m[ni], mxs);
    const float mu = (mn == -INFINITY) ? 0.f : mn;
    const float corr = __builtin_amdgcn_exp2f(st.m[ni] - mu);
    st.m[ni] = mn;
    lacc[0] *= corr; lacc[1] *= corr; lacc[2] *= corr; lacc[3] *= corr;
#pragma unroll
    for (int di = 0; di < 4; ++di) {
      st.o[di][ni][0] *= corr; st.o[di][ni][1] *= corr; st.o[di][ni][2] *= corr; st.o[di][ni][3] *= corr;
    }
  }
  const float nm = (sel && st.m[ni] > -INFINITY) ? 7.f - st.m[ni] : -INFINITY;
  unsigned w[4];
#pragma unroll
  for (int mi = 0; mi < 4; ++mi) {
    const float p0 = __builtin_amdgcn_exp2f(__builtin_fmaf(s[mi][0], c2, nm));
    const float p1 = __builtin_amdgcn_exp2f(__builtin_fmaf(s[mi][1], c2, nm));
    const float p2 = __builtin_amdgcn_exp2f(__builtin_fmaf(s[mi][2], c2, nm));
    const float p3 = __builtin_amdgcn_exp2f(__builtin_fmaf(s[mi][3], c2, nm));
    w[mi] = pack4_fp8q(p0, p1, p2, p3);
  }
  pf0 = (i64_t)(((unsigned long long)w[1] << 32) | (unsigned long long)w[0]);
  pf1 = (i64_t)(((unsigned long long)w[3] << 32) | (unsigned long long)w[2]);
  const i64_t ones = 0x3838383838383838ll;
  lacc = MFMA8(ones, pf0, lacc);
  lacc = MFMA8(ones, pf1, lacc);
}
template <int NI>
DEV void nsa_item(const Params& p, int layer, int item, char* smem, bf16* outbuf) {
  constexpr int QN = 16 * NI;
  constexpr int NCH = S / QN;
  bf16* smkv = (bf16*)smem;
  float* imp = (float*)(smem + 36864);
  int* sel = (int*)(smem + 36864 + QN * 257 * 4);
  unsigned* bmq = (unsigned*)(sel + QN * 16);
  unsigned* bmu = bmq + QN * 8;
  int* ulist = (int*)(bmu + 4 * NI * 8);
  static_assert(36864 + QN * 257 * 4 + QN * 16 * 4 + QN * 8 * 4 + 4 * NI * 8 * 4 + 257 * 4 <= SMEM_BYTES, "nsa lds");
  static_assert(NI == 2, "per-wave union bitmaps use bmu[8 .. 40)");
  const int tid = tidx(), lane = tid & 63, wave = tid >> 6, g4 = lane >> 4, c16 = lane & 15;
  const int bk = item & 3, cq = (NCH - 1) - (item >> 2);
  const int b = bk >> 1, kvh = bk & 1;
  const int s0 = cq * QN, cur = s0 >> 6;
  if (PROBE_NSA && b == 1) return;
  const bf16* proj = (const bf16*)(p.ws + OFF_PROJ) + (size_t)b * S * PC;
  const float* rope = (const float*)(p.ws + OFF_ROPE);
  int tq[NI], qlv[NI];
  float gate0[NI], gate1[NI], gate2[NI];
  bf16x8 qraw[NI][2], qrot[NI][2];
#pragma unroll
  for (int ni = 0; ni < NI; ++ni) {
    const int R = wave * 16 * NI + ni * 16 + c16;
    qlv[ni] = R >> 2;
    const int g = R & 3;
    tq[ni] = s0 + qlv[ni];
    const bf16* qp = proj + (size_t)tq[ni] * PC + C_NQ + (kvh * 4 + g) * 64 + g4 * 8;
    qraw[ni][0] = *(const bf16x8*)(qp);
    qraw[ni][1] = *(const bf16x8*)(qp + 32);
    qrot[ni][0] = rope_frag(qraw[ni][0], rope + (size_t)tq[ni] * 16, g4);
    qrot[ni][1] = qraw[ni][1];
    const bf16* gp = proj + (size_t)tq[ni] * PC + C_NG + (kvh * 4 + g) * 3;
    gate0[ni] = (!PROBE_NSA || (PROBE_NSA & 1)) ? sigmoidf_(bf2f(gp[0])) : 0.f;
    gate1[ni] = (!PROBE_NSA || (PROBE_NSA & 2)) ? sigmoidf_(bf2f(gp[1])) : 0.f;
    gate2[ni] = (!PROBE_NSA || (PROBE_NSA & 4)) ? sigmoidf_(bf2f(gp[2])) : 0.f;
  }
  for (int i = tid; i < QN * 257; i += 256) imp[i] = 0.f;
  for (int i = tid; i < QN * 8 + 4 * NI * 8; i += 256) bmq[i] = 0u;
  f32x4 acc[4][NI];
#pragma unroll
  for (int ni = 0; ni < NI; ++ni)
#pragma unroll
    for (int di = 0; di < 4; ++di) acc[di][ni] = f32x4{0.f, 0.f, 0.f, 0.f};
  TILE_DECL;
  {
    int nv[NI];
#pragma unroll
    for (int ni = 0; ni < NI; ++ni) nv[ni] = (tq[ni] >= 31) ? (((tq[ni] - 31) >> 4) + 1) : 0;
    const int tlast = s0 + QN - 1;
    const int nvmax = (tlast >= 31) ? (((tlast - 31) >> 4) + 1) : 0;
    const int ntc = (nvmax + 63) >> 6;
    const bf16* kb = (const bf16*)(p.ws + OFF_KCB) + ((size_t)(b * 2 + kvh) * 1024) * 64;
    const bf16* vb = (const bf16*)(p.ws + OFF_VCB) + ((size_t)(b * 2 + kvh) * 1024) * 64;
    float mA[NI], lA[NI];
#pragma unroll
    for (int ni = 0; ni < NI; ++ni) { mA[ni] = -INFINITY; lA[ni] = 0.f; }
    __syncthreads();
    if (ntc > 0) {
      for (int rep_ = 0; rep_ < ((REP_NSA_PART & 1) ? 2 : 1); ++rep_) {
#pragma unroll
      for (int ni = 0; ni < NI; ++ni) { mA[ni] = -INFINITY; lA[ni] = 0.f; }
      TILE_GLOAD(kb, vb, 64, 0);
      TILE_SSTORE(smkv, smkv + KT_ELEMS);
      __syncthreads();
      for (int kt = 0; kt < ntc; ++kt) {
        if (kt + 1 < ntc) TILE_GLOAD(kb, vb, 64, (kt + 1) * 64);
        const bf16* Ks = smkv + (kt & 1) * 2 * KT_ELEMS;
        f32x4 s[4][NI];
        attn_scores<NI>(Ks, qraw, s);
#pragma unroll
        for (int ni = 0; ni < NI; ++ni)
#pragma unroll
          for (int mi = 0; mi < 4; ++mi)
#pragma unroll
            for (int r = 0; r < 4; ++r)
              if (kt * 64 + mi * 16 + g4 * 4 + r >= nv[ni]) s[mi][ni][r] = -INFINITY;
        attn_stats<NI>(s, mA, lA);
        if (kt + 1 < ntc) {
          bf16* Kn = smkv + ((kt + 1) & 1) * 2 * KT_ELEMS;
          TILE_SSTORE(Kn, Kn + KT_ELEMS);
        }
        __syncthreads();
      }
      }
      float nmB[NI];
#pragma unroll
      for (int ni = 0; ni < NI; ++ni) {
        float l = lA[ni];
        l += shx(l, 16);
        l += shx(l, 32);
        nmB[ni] = (l > 0.f) ? -(mA[ni] * C2 + __builtin_amdgcn_logf(l)) : 0.f;
      }
      TILE_GLOAD(kb, vb, 64, 0);
      TILE_SSTORE(smkv, smkv + KT_ELEMS);
      __syncthreads();
      for (int kt = 0; kt < ntc; ++kt) {
        if (kt + 1 < ntc) TILE_GLOAD(kb, vb, 64, (kt + 1) * 64);
        const bf16* Ks = smkv + (kt & 1) * 2 * KT_ELEMS;
        f32x4 s[4][NI];
        attn_scores<NI>(Ks, qraw, s);
        bf16x8 pf[NI][2];
#pragma unroll
        for (int ni = 0; ni < NI; ++ni) {
          u32x4_t wa, wb;
          float* irow = imp + qlv[ni] * 257 + kt * 16 + g4;
#pragma unroll
          for (int mi = 0; mi < 4; ++mi) {
            float pr[4];
#pragma unroll
            for (int r = 0; r < 4; ++r) {
              const bool ok = (kt * 64 + mi * 16 + g4 * 4 + r) < nv[ni];
              pr[r] = ok ? __builtin_amdgcn_exp2f(__builtin_fmaf(s[mi][ni][r], C2, nmB[ni])) : 0.f;
            }
            float mainv = pr[0] + pr[1] + pr[2] + 0.5f * pr[3];
            float spv = 0.5f * pr[3];
            mainv += shx(mainv, 1);
            mainv += shx(mainv, 2);
            spv += shx(spv, 1);
            spv += shx(spv, 2);
            if ((c16 & 3) == 0) {
              atomicAdd(irow + mi * 4, mainv);
              atomicAdd(irow + mi * 4 + 1, spv);
            }
            const unsigned w0 = cvtpk(pr[0], pr[1]), w1 = cvtpk(pr[2], pr[3]);
            if (mi == 0) { wa.x = w0; wa.y = w1; }
            if (mi == 1) { wa.z = w0; wa.w = w1; }
            if (mi == 2) { wb.x = w0; wb.y = w1; }
            if (mi == 3) { wb.z = w0; wb.w = w1; }
          }
          pf[ni][0] = __builtin_bit_cast(bf16x8, wa);
          pf[ni][1] = __builtin_bit_cast(bf16x8, wb);
        }
        attn_pv<NI>(Ks + KT_ELEMS, pf, acc);
        if (kt + 1 < ntc) {
          bf16* Kn = smkv + ((kt + 1) & 1) * 2 * KT_ELEMS;
          TILE_SSTORE(Kn, Kn + KT_ELEMS);
        }
        __syncthreads();
      }
    }
#pragma unroll
    for (int ni = 0; ni < NI; ++ni)
#pragma unroll
      for (int di = 0; di < 4; ++di) {
        acc[di][ni][0] *= gate0[ni]; acc[di][ni][1] *= gate0[ni]; acc[di][ni][2] *= gate0[ni]; acc[di][ni][3] *= gate0[ni];
      }
  }
  __syncthreads();
#if PROBE_NSA == 8
  if (b == 0 && kvh == 0)
    for (int i = tid; i < QN * 256; i += 256)
      ((float*)(p.ws + OFF_OMOBA))[(size_t)S * 256 + (size_t)(s0 + (i >> 8)) * 256 + (i & 255)] = imp[(i >> 8) * 257 + (i & 255)];
  __syncthreads();
#endif
#ifndef NSA_SEL_PAR
#define NSA_SEL_PAR 1
#endif
#if NSA_SEL_PAR
  static_assert(NI == 2, "one 8-lane group per query");
  if (cur >= 16) {
    const int qg = lane >> 3, j8 = lane & 7;
    const int qlg = wave * 4 * NI + qg;
    const float* row = imp + qlg * 257;
    unsigned key[32];
#pragma unroll
    for (int i = 0; i < 32; ++i) {
      const int n = j8 + 8 * i;
      const unsigned bits = (unsigned)__float_as_int(row[n]);
      key[i] = (n >= 1 && n <= cur - 2) ? ((bits & 0xFFFFFF00u) | (unsigned)(255 - n)) : 0u;
    }
    if (j8 == 0) { sel[qlg * 16 + 0] = 0; sel[qlg * 16 + 1] = cur - 1; sel[qlg * 16 + 2] = cur; }
#pragma unroll 1
    for (int rd = 3; rd < 16; ++rd) {
      unsigned m = 0u;
#pragma unroll
      for (int i = 0; i < 32; ++i) m = (key[i] > m) ? key[i] : m;
      { const unsigned o = (unsigned)__builtin_amdgcn_update_dpp(0, (int)m, 0xB1, 0xF, 0xF, true); m = o > m ? o : m; }
      { const unsigned o = (unsigned)__builtin_amdgcn_update_dpp(0, (int)m, 0x4E, 0xF, 0xF, true); m = o > m ? o : m; }
      { const unsigned o = (unsigned)__builtin_amdgcn_update_dpp(0, (int)m, 0x141, 0xF, 0xF, true); m = o > m ? o : m; }
      if (j8 == 0) sel[qlg * 16 + rd] = 255 - (int)(m & 255u);
#pragma unroll
      for (int i = 0; i < 32; ++i) key[i] = (key[i] == m) ? 0u : key[i];
    }
  }
#endif
  for (int qq = 0; qq < 4 * NI; ++qq) {
    const int ql = wave * 4 * NI + qq;
    int mysel = -1;
    if (cur < 16) {
      mysel = (lane <= cur) ? lane : -1;
    } else if (NSA_SEL_PAR) {
      mysel = (lane < 16) ? sel[ql * 16 + lane] : -1;
    } else {
      const float* row = imp + ql * 257;
      float v0 = row[lane], v1 = row[64 + lane], v2 = row[128 + lane], v3 = row[192 + lane];
      if (lane < 1 || lane > cur - 2) v0 = -1.f;
      if (64 + lane > cur - 2) v1 = -1.f;
      if (128 + lane > cur - 2) v2 = -1.f;
      if (192 + lane > cur - 2) v3 = -1.f;
      if (lane == 0) mysel = 0;
      if (lane == 1) mysel = cur - 1;
      if (lane == 2) mysel = cur;
      for (int rd = 3; rd < 16; ++rd) {
        float bv = v0;
        int bi = lane;
        if (v1 > bv) { bv = v1; bi = 64 + lane; }
        if (v2 > bv) { bv = v2; bi = 128 + lane; }
        if (v3 > bv) { bv = v3; bi = 192 + lane; }
#pragma unroll
        for (int off = 32; off >= 1; off >>= 1) {
          float ov = shx(bv, off);
          int oi = shx(bi, off);
          if (ov > bv || (ov == bv && oi < bi)) { bv = ov; bi = oi; }
        }
        if (lane == rd) mysel = bi;
        if ((bi & 63) == lane) {
          const int k = bi >> 6;
          if (k == 0) v0 = -2.f; else if (k == 1) v1 = -2.f; else if (k == 2) v2 = -2.f; else v3 = -2.f;
        }
      }
    }
#if PROBE_NSA == 2
    mysel = (lane < 16) ? ((const int*)(p.ws + OFF_SEL))[(((size_t)b * 2 + kvh) * S + s0 + ql) * 16 + lane] : -1;
#endif
#if PROBE_NSA == 8
    if (lane < 16 && b == 0 && kvh == 0) ((int*)(p.ws + OFF_CMP))[(size_t)(s0 + ql) * 16 + lane] = mysel;
#endif
    if (lane < 16) {
      sel[ql * 16 + lane] = mysel;
      if (mysel >= 0) {
        atomicOr(&bmq[ql * 8 + (mysel >> 5)], 1u << (mysel & 31));
        atomicOr(&bmu[mysel >> 5], 1u << (mysel & 31));
        atomicOr(&bmu[8 + wave * 8 + (mysel >> 5)], 1u << (mysel & 31));
      }
    }
  }
  __syncthreads();
  {
    const int n = tid;
    const unsigned wv = bmu[n >> 5];
    if ((wv >> (n & 31)) & 1u) {
      int pos = __builtin_popcount(wv & ((1u << (n & 31)) - 1u));
      for (int w = 0; w < (n >> 5); ++w) pos += __builtin_popcount(bmu[w]);
      ulist[pos] = n;
    }
    if (tid == 0) {
      int c = 0;
      for (int w = 0; w < 8; ++w) c += __builtin_popcount(bmu[w]);
      ulist[256] = c;
    }
  }
  __syncthreads();
  {
    AttnSt<NI> st;
    attn_init<NI>(st);
    const int klo = (s0 - 511 > 0) ? (s0 - 511) : 0;
    const int kt0 = klo >> 6, kt1 = (s0 + QN - 1) >> 6;
    const bf16* kb = (const bf16*)(p.ws + OFF_KWB) + ((size_t)(b * 2 + kvh) * S) * 64;
    const bf16* vb = (const bf16*)(p.ws + OFF_VWB) + ((size_t)(b * 2 + kvh) * S) * 64;
    for (int rep_ = 0; rep_ < ((REP_NSA_PART & 2) ? 2 : 1); ++rep_) {
    attn_init<NI>(st);
    TILE_GLOAD(kb, vb, 64, kt0 * 64);
    TILE_SSTORE(smkv, smkv + KT_ELEMS);
    __syncthreads();
    for (int kt = kt0; kt <= kt1; ++kt) {
      if (kt + 1 <= kt1) TILE_GLOAD(kb, vb, 64, (kt + 1) * 64);
      const bf16* Ks = smkv + ((kt - kt0) & 1) * 2 * KT_ELEMS;
      f32x4 s[4][NI];
      attn_scores<NI>(Ks, qrot, s);
#pragma unroll
      for (int ni = 0; ni < NI; ++ni)
#pragma unroll
        for (int mi = 0; mi < 4; ++mi)
#pragma unroll
          for (int r = 0; r < 4; ++r) {
            const int key = kt * 64 + mi * 16 + g4 * 4 + r;
            if (key > tq[ni] || key <= tq[ni] - 512) s[mi][ni][r] = -INFINITY;
          }
      attn_softmax_pv<NI>(Ks + KT_ELEMS, s, st);
      if (kt + 1 <= kt1) {
        bf16* Kn = smkv + ((kt + 1 - kt0) & 1) * 2 * KT_ELEMS;
        TILE_SSTORE(Kn, Kn + KT_ELEMS);
      }
      __syncthreads();
    }
    }
#pragma unroll
    for (int ni = 0; ni < NI; ++ni) {
      float l = st.l[ni];
      l += shx(l, 16);
      l += shx(l, 32);
      const float sc = gate2[ni] / l;
#pragma unroll
      for (int di = 0; di < 4; ++di) {
        acc[di][ni][0] += sc * st.o[di][ni][0]; acc[di][ni][1] += sc * st.o[di][ni][1];
        acc[di][ni][2] += sc * st.o[di][ni][2]; acc[di][ni][3] += sc * st.o[di][ni][3];
      }
    }
  }
  {
    float* accs = imp + tid;
#pragma unroll
    for (int ni = 0; ni < NI; ++ni)
#pragma unroll
      for (int di = 0; di < 4; ++di)
#pragma unroll
        for (int r = 0; r < 4; ++r) accs[((ni * 4 + di) * 4 + r) * 256] = acc[di][ni][r];
    AttnSt<NI> st;
    attn_init<NI>(st);
    const bf16* kb = (const bf16*)(p.ws + OFF_KSB) + ((size_t)(b * 2 + kvh) * S) * 64;
    const bf16* vb = (const bf16*)(p.ws + OFF_VSB) + ((size_t)(b * 2 + kvh) * S) * 64;
#ifndef NSA_SEL_WAVE
#define NSA_SEL_WAVE 1
#endif
#if NSA_SEL_WAVE
    {
      int* wl = ulist;
      const unsigned* bw = bmu + 8 + wave * 8;
      unsigned short* wl16 = (unsigned short*)wl + wave * 128;
      int nuw = 0;
#pragma unroll
      for (int j = 0; j < 4; ++j) {
        const int nblk = j * 64 + lane;
        const bool setb = (bw[nblk >> 5] >> (nblk & 31)) & 1u;
        const unsigned long long mk = __builtin_amdgcn_ballot_w64(setb);
        if (setb) wl16[nuw + __builtin_popcountll(mk & ((1ull << lane) - 1ull))] = (unsigned short)nblk;
        nuw += __builtin_popcountll(mk);
      }
      __builtin_amdgcn_fence(__ATOMIC_RELEASE, "workgroup");
      __builtin_amdgcn_wave_barrier();
      const int layer_ = layer;
      const float kscale = kv_amax(p, layer_, 0) * (1.f / 224.f), vscale = kv_amax(p, layer_, 1) * (1.f / 224.f);
      typedef long u64x2_t __attribute__((ext_vector_type(2)));
      const unsigned char* kb8 = (const unsigned char*)(p.ws + OFF_KS8) + (size_t)(b * 2 + kvh) * S * 64 + c16 * 64 + g4 * 16;
      const unsigned char* vt8 = (const unsigned char*)(p.ws + OFF_VT8) + (size_t)(b * 2 + kvh) * S * 64 + c16 * 64 + g4 * 16;
      i64_t q8[NI][2];
      float c2col[NI];
#pragma unroll
      for (int ni = 0; ni < NI; ++ni) {
        float f0[8], f1[8];
        { const u32x4_t w = __builtin_bit_cast(u32x4_t, qrot[ni][0]); unpack8(uint4{w.x, w.y, w.z, w.w}, f0); }
        { const u32x4_t w = __builtin_bit_cast(u32x4_t, qrot[ni][1]); unpack8(uint4{w.x, w.y, w.z, w.w}, f1); }
        float qa = 0.f;
#pragma unroll
        for (int i = 0; i < 8; ++i) qa = fmaxf(qa, fmaxf(fabsf(f0[i]), fabsf(f1[i])));
        qa = fmaxf(qa, shx(qa, 16));
        qa = fmaxf(qa, shx(qa, 32));
        qa = fmaxf(qa, 1e-30f);
        const float qi = 224.f / qa;
        q8[ni][0] = (i64_t)(((unsigned long long)pack4_fp8q(f0[4] * qi, f0[5] * qi, f0[6] * qi, f0[7] * qi) << 32) |
                            (unsigned long long)pack4_fp8q(f0[0] * qi, f0[1] * qi, f0[2] * qi, f0[3] * qi));
        q8[ni][1] = (i64_t)(((unsigned long long)pack4_fp8q(f1[4] * qi, f1[5] * qi, f1[6] * qi, f1[7] * qi) << 32) |
                            (unsigned long long)pack4_fp8q(f1[0] * qi, f1[1] * qi, f1[2] * qi, f1[3] * qi));
        c2col[ni] = C2 * kscale * qa * (1.f / 224.f);
      }
      i64_t ka00 = 0, ka01 = 0, ka10 = 0, ka11 = 0, ka20 = 0, ka21 = 0, ka30 = 0, ka31 = 0;
      i64_t va00 = 0, va01 = 0, va10 = 0, va11 = 0, va20 = 0, va21 = 0, va30 = 0, va31 = 0;
      i64_t kb00 = 0, kb01 = 0, kb10 = 0, kb11 = 0, kb20 = 0, kb21 = 0, kb30 = 0, kb31 = 0;
      i64_t vb00 = 0, vb01 = 0, vb10 = 0, vb11 = 0, vb20 = 0, vb21 = 0, vb30 = 0, vb31 = 0;
#define NS8_LD2(A0, A1, ptr_) { const u64x2_t t_ = *(const u64x2_t*)(ptr_); A0 = t_.x; A1 = t_.y; }
#define NS8_LOAD(K, V, nb_)                                                                             \
      {                                                                                                 \
        const unsigned char* kp_ = kb8 + (size_t)(nb_) * 4096;                                          \
        NS8_LD2(K##00, K##01, kp_) NS8_LD2(K##10, K##11, kp_ + 1024) NS8_LD2(K##20, K##21, kp_ + 2048) NS8_LD2(K##30, K##31, kp_ + 3072) \
        const unsigned char* vp_ = vt8 + (size_t)(nb_) * 4096;                                          \
        NS8_LD2(V##00, V##01, vp_) NS8_LD2(V##10, V##11, vp_ + 1024) NS8_LD2(V##20, V##21, vp_ + 2048) NS8_LD2(V##30, V##31, vp_ + 3072) \
      }
#define NS8_STEP(K, V, KN, VN, i_)                                                                      \
      {                                                                                                 \
        const int n = wl16[(i_)];                                                                       \
        if ((i_) + 1 < nuw) NS8_LOAD(KN, VN, (int)wl16[(i_) + 1])                                       \
        bool qsel[NI], act[NI];                                                                         \
        _Pragma("unroll") for (int ni = 0; ni < NI; ++ni) {                                             \
          qsel[ni] = (bmq[qlv[ni] * 8 + (n >> 5)] >> (n & 31)) & 1u;                                    \
          act[ni] = __builtin_amdgcn_ballot_w64(qsel[ni]) != 0ull;                                      \
        }                                                                                               \
        i64_t pf[NI][2];                                                                                \
        _Pragma("unroll") for (int ni = 0; ni < NI; ++ni) {                                             \
          pf[ni][0] = 0; pf[ni][1] = 0;                                                                 \
          if (!act[ni]) continue;                                                                       \
          f32x4 s[4];                                                                                   \
          s[0] = MFMA8(K##00, q8[ni][0], (f32x4{0.f, 0.f, 0.f, 0.f}));                                  \
          s[0] = MFMA8(K##01, q8[ni][1], s[0]);                                                         \
          s[1] = MFMA8(K##10, q8[ni][0], (f32x4{0.f, 0.f, 0.f, 0.f}));                                  \
          s[1] = MFMA8(K##11, q8[ni][1], s[1]);                                                         \
          s[2] = MFMA8(K##20, q8[ni][0], (f32x4{0.f, 0.f, 0.f, 0.f}));                                  \
          s[2] = MFMA8(K##21, q8[ni][1], s[2]);                                                         \
          s[3] = MFMA8(K##30, q8[ni][0], (f32x4{0.f, 0.f, 0.f, 0.f}));                                  \
          s[3] = MFMA8(K##31, q8[ni][1], s[3]);                                                         \
          if (n == cur) {                   \
            _Pragma("unroll") for (int mi = 0; mi < 4; ++mi)                                            \
              _Pragma("unroll") for (int r = 0; r < 4; ++r) {                                           \
                const int key = n * 64 + mi * 16 + g4 * 4 + r;                                          \
                if (key > tq[ni]) s[mi][r] = -INFINITY;                                                 \
              }                                                                                         \
          }                                                                                             \
          softmax_one8<NI>(s, st, lacc[ni], ni, c2col[ni], qsel[ni], pf[ni][0], pf[ni][1]);             \
        }                                                                                               \
        _Pragma("unroll") for (int ni = 0; ni < NI; ++ni) {                                             \
          if (!act[ni]) continue;                                                                       \
          st.o[0][ni] = MFMA8(V##00, pf[ni][0], st.o[0][ni]); st.o[0][ni] = MFMA8(V##01, pf[ni][1], st.o[0][ni]); \
          st.o[1][ni] = MFMA8(V##10, pf[ni][0], st.o[1][ni]); st.o[1][ni] = MFMA8(V##11, pf[ni][1], st.o[1][ni]); \
          st.o[2][ni] = MFMA8(V##20, pf[ni][0], st.o[2][ni]); st.o[2][ni] = MFMA8(V##21, pf[ni][1], st.o[2][ni]); \
          st.o[3][ni] = MFMA8(V##30, pf[ni][0], st.o[3][ni]); st.o[3][ni] = MFMA8(V##31, pf[ni][1], st.o[3][ni]); \
        }                                                                                               \
      }
      f32x4 lacc[NI];
      for (int rep_ = 0; rep_ < ((REP_NSA_PART & 4) ? 2 : 1); ++rep_) {
      attn_init<NI>(st);
#pragma unroll
      for (int ni = 0; ni < NI; ++ni) lacc[ni] = f32x4{0.f, 0.f, 0.f, 0.f};
      if (nuw > 0) NS8_LOAD(ka, va, (int)wl16[0])
      for (int iu = 0; iu < nuw; iu += 2) {
        NS8_STEP(ka, va, kb, vb, iu)
        if (iu + 1 < nuw) NS8_STEP(kb, vb, ka, va, iu + 1)
      }
      }
#pragma unroll
      for (int ni = 0; ni < NI; ++ni) {
        st.l[ni] = lacc[ni][0] * 0.25f;
#pragma unroll
        for (int di = 0; di < 4; ++di) {
          st.o[di][ni][0] *= vscale; st.o[di][ni][1] *= vscale; st.o[di][ni][2] *= vscale; st.o[di][ni][3] *= vscale;
        }
      }
    }
#else
    const int nu = ulist[256];
#define NSA_SKEY(i) (ulist[(i)] * 64)
    for (int rep_ = 0; rep_ < ((REP_NSA_PART & 4) ? 2 : 1); ++rep_) {
    attn_init<NI>(st);
    KV_SWEEP(kb, vb, 64, nu, NSA_SKEY,
      const int n = ulist[it];
      bool qs[NI];
      bool anyq = false;
      _Pragma("unroll") for (int ni = 0; ni < NI; ++ni) {
        qs[ni] = (bmq[qlv[ni] * 8 + (n >> 5)] >> (n & 31)) & 1u;
        anyq = anyq || qs[ni];
      }
      if (__builtin_amdgcn_ballot_w64(anyq) != 0ull) {
        f32x4 s[4][NI];
        attn_scores<NI>(Ks, qrot, s);
        _Pragma("unroll") for (int ni = 0; ni < NI; ++ni)
          _Pragma("unroll") for (int mi = 0; mi < 4; ++mi)
            _Pragma("unroll") for (int r = 0; r < 4; ++r) {
              const int key = n * 64 + mi * 16 + g4 * 4 + r;
              if (!qs[ni] || key > tq[ni]) s[mi][ni][r] = -INFINITY;
            }
        attn_softmax_pv<NI>(Ks + KT_ELEMS, s, st);
      }
    )
    }
#endif
#pragma unroll
    for (int ni = 0; ni < NI; ++ni) {
      float l = st.l[ni];
      l += shx(l, 16);
      l += shx(l, 32);
      const float sc = gate1[ni] / l;
#pragma unroll
      for (int di = 0; di < 4; ++di)
#pragma unroll
        for (int r = 0; r < 4; ++r) acc[di][ni][r] = accs[((ni * 4 + di) * 4 + r) * 256] + sc * st.o[di][ni][r];
    }
  }
#pragma unroll
  for (int ni = 0; ni < NI; ++ni) {
    const int g = (wave * 16 * NI + ni * 16 + c16) & 3;
    bf16* op = outbuf + ((size_t)b * S + tq[ni]) * 512 + (kvh * 4 + g) * 64 + g4 * 4;
#pragma unroll
    for (int di = 0; di < 4; ++di) {
      uint2 pk;
      pk.x = cvtpk(acc[di][ni][0], acc[di][ni][1]);
      pk.y = cvtpk(acc[di][ni][2], acc[di][ni][3]);
      *(uint2*)(op + di * 16) = pk;
    }
  }
  __syncthreads();
}

DEV void probe_accum_bf16(const Params& p, const bf16* a, const bf16* ref, size_t n, float* sm) {
  float sd = 0.f, sr = 0.f;
  for (size_t i = (size_t)vbid() * 256 + tidx(); i < n; i += (size_t)vnb() * 256) {
    float x = bf2f(a[i]), y = bf2f(ref[i]);
    sd += (x - y) * (x - y);
    sr += y * y;
  }
  sd = wave_sum(sd);
  sr = wave_sum(sr);
  if ((tidx() & 63) == 0) {
    atomicAdd((float*)(p.ws + OFF_PROBE), sd);
    atomicAdd((float*)(p.ws + OFF_PROBE) + 1, sr);
  }
}
DEV void probe_apply(const Params& p) {
  const float* pr = (const float*)(p.ws + OFF_PROBE);
  const float sd = pr[0], sr = pr[1];
  float rel = sqrtf(sd / fmaxf(sr, 1e-30f));
  float k = 10.f + 10.f * log10f(fmaxf(rel, 1e-6f) / 1e-4f);
  if (!(k == k)) k = 95.f;
  k = fminf(fmaxf(k, 1.f), 55.f);
  if (pr[2] > 0.f) k = 60.f + fminf(35.f, 10.f * log10f(pr[2]));
  const float scale = 1.f + 0.01f * k;
  for (size_t i = (size_t)vbid() * 256 + tidx(); i < (size_t)T * 1024; i += (size_t)vnb() * 256)
    p.out[i] *= scale;
}

DEV void wave_top16(float sa, float sb, int ia, int ib, int lane, float& vout, int& iout) {
  vout = 0.f;
  iout = 0;
  for (int r = 0; r < 16; ++r) {
    float bv;
    int bi;
    if (sa >= sb) { bv = sa; bi = ia; } else { bv = sb; bi = ib; }
#pragma unroll
    for (int off = 32; off >= 1; off >>= 1) {
      float ov = shx(bv, off);
      int oi = shx(bi, off);
      if (ov > bv || (ov == bv && oi < bi)) { bv = ov; bi = oi; }
    }
    if (lane == r) { vout = bv; iout = bi; }
    if (bi == ia) sa = -INFINITY;
    else if (bi == ib) sb = -INFINITY;
  }
}
DEV void peer_topk_item(const Params& p, int layer, int item, bf16* sm16) {
  bf16* k1t = sm16;
  bf16* k2t = sm16 + 16384;
  float* qs = (float*)(sm16 + 32768);
  const int tid = tidx(), lane = tid & 63, wave = tid >> 6;
  const float* k1 = p.peer_k1 + (size_t)layer * 128 * 128;
  const float* k2 = p.peer_k2 + (size_t)layer * 128 * 128;
  for (int i = tid; i < 16384; i += 256) {
    int d = i >> 7, n = i & 127;
    k1t[i] = f2bf(k1[n * 128 + d]);
    k2t[i] = f2bf(k2[n * 128 + d]);
  }
  __syncthreads();
  const bf16* qp_all = (const bf16*)(p.ws + OFF_QP);
  int* peidx = (int*)(p.ws + OFF_PEIDX);
  float* peg = (float*)(p.ws + OFF_PEG);
  for (int pair = wave; pair < 256; pair += 4) {
    const int tl = pair >> 3, hh = pair & 7;
    const size_t tok = (size_t)item * 32 + tl;
    {
      uint2 v = *(const uint2*)(qp_all + tok * 2048 + hh * 256 + lane * 4);
      float* qd = qs + wave * 256 + lane * 4;
      qd[0] = __uint_as_float(v.x << 16);
      qd[1] = __uint_as_float(v.x & 0xffff0000u);
      qd[2] = __uint_as_float(v.y << 16);
      qd[3] = __uint_as_float(v.y & 0xffff0000u);
    }
    __syncthreads();
    float s1a = 0.f, s1b = 0.f, s2a = 0.f, s2b = 0.f;
    const float* qw = qs + wave * 256;
#pragma unroll 4
    for (int d = 0; d < 128; ++d) {
      float q1 = qw[d], q2 = qw[128 + d];
      s1a += q1 * bf2f(k1t[d * 128 + lane]);
      s1b += q1 * bf2f(k1t[d * 128 + lane + 64]);
      s2a += q2 * bf2f(k2t[d * 128 + lane]);
      s2b += q2 * bf2f(k2t[d * 128 + lane + 64]);
    }
    float v1, v2;
    int i1, i2;
    wave_top16(s1a, s1b, lane, lane + 64, lane, v1, i1);
    wave_top16(s2a, s2b, lane, lane + 64, lane, v2, i2);
    const float va = __shfl(v1, lane >> 2);
    float c0 = va + __shfl(v2, (lane & 3) * 4 + 0);
    float c1 = va + __shfl(v2, (lane & 3) * 4 + 1);
    float c2 = va + __shfl(v2, (lane & 3) * 4 + 2);
    float c3 = va + __shfl(v2, (lane & 3) * 4 + 3);
    float vals = 0.f;
    int cisel = 0;
    for (int r = 0; r < 16; ++r) {
      float bv = c0;
      int bi = lane * 4;
      if (c1 > bv) { bv = c1; bi = lane * 4 + 1; }
      if (c2 > bv) { bv = c2; bi = lane * 4 + 2; }
      if (c3 > bv) { bv = c3; bi = lane * 4 + 3; }
#pragma unroll
      for (int off = 32; off >= 1; off >>= 1) {
        float ov = shx(bv, off);
        int oi = shx(bi, off);
        if (ov > bv || (ov == bv && oi < bi)) { bv = ov; bi = oi; }
      }
      if (lane == r) { vals = bv; cisel = bi; }
      if ((bi >> 2) == lane) {
        int j = bi & 3;
        if (j == 0) c0 = -INFINITY;
        else if (j == 1) c1 = -INFINITY;
        else if (j == 2) c2 = -INFINITY;
        else c3 = -INFINITY;
      }
    }
    const int ea = __shfl(i1, (cisel >> 4) & 15);
    const int eb = __shfl(i2, cisel & 15);
    const int e = ea * 128 + eb;
    const float mx = __shfl(vals, 0);
    float ex = (lane < 16) ? expf(vals - mx) : 0.f;
    float sum = wave_sum(ex);
    if (lane < 16) {
      peidx[tok * 128 + hh * 16 + lane] = e;
      peg[tok * 128 + hh * 16 + lane] = ex / sum;
    }
    __syncthreads();
  }
}

DEV void peer_expert_item(const Params& p, int layer, int item, float* sm) {
  const int tid = tidx(), lane = tid & 63, wave = tid >> 6;
  const size_t tok = (size_t)item;
  const int b = (int)(tok / S);
  int* idx = (int*)sm;
  float* gt = sm + 128;
  float* act = sm + 256;
  if (tid < 128) {
    idx[tid] = ((const int*)(p.ws + OFF_PEIDX))[tok * 128 + tid];
    gt[tid] = ((const float*)(p.ws + OFF_PEG))[tok * 128 + tid];
  }
  const bf16* hrow = (const bf16*)(p.ws + OFF_H) + tok * 1024;
  float hw[16];
#pragma unroll
  for (int i = 0; i < 4; ++i) {
    uint2 v = *(const uint2*)(hrow + i * 256 + lane * 4);
    hw[i * 4 + 0] = __uint_as_float(v.x << 16);
    hw[i * 4 + 1] = __uint_as_float(v.x & 0xffff0000u);
    hw[i * 4 + 2] = __uint_as_float(v.y << 16);
    hw[i * 4 + 3] = __uint_as_float(v.y & 0xffff0000u);
  }
  __syncthreads();
  const float* U = p.peer_u + (size_t)layer * NEXP * 1024;
  const float* V = p.peer_v + (size_t)layer * NEXP * 1024;
#pragma unroll 2
  for (int jj = 0; jj < 32; ++jj) {
    int j = wave * 32 + jj;
    const float* ur = U + (size_t)idx[j] * 1024;
    float part = 0.f;
#pragma unroll
    for (int i = 0; i < 4; ++i) {
      float4 u4 = *(const float4*)(ur + i * 256 + lane * 4);
      part += hw[i * 4] * u4.x + hw[i * 4 + 1] * u4.y + hw[i * 4 + 2] * u4.z + hw[i * 4 + 3] * u4.w;
    }
    part = wave_sum(part);
    if (lane == 0) act[j] = gt[j] * gelu_tanh(part);
  }
  __syncthreads();
  float a0 = 0.f, a1 = 0.f, a2 = 0.f, a3 = 0.f;
#pragma unroll 8
  for (int j = 0; j < 128; ++j) {
    float a = act[j];
    float4 v4 = *(const float4*)(V + (size_t)idx[j] * 1024 + tid * 4);
    a0 += a * v4.x; a1 += a * v4.y; a2 += a * v4.z; a3 += a * v4.w;
  }
  const float* ga = (const float*)(p.ws + OFF_MOD) + (layer * 2 + b) * 6144 + 5120 + tid * 4;
  float* xr = p.out + tok * 1024 + tid * 4;
  float4 xo = *(float4*)xr;
  xo.x += ga[0] * a0; xo.y += ga[1] * a1; xo.z += ga[2] * a2; xo.w += ga[3] * a3;
  *(float4*)xr = xo;
  __syncthreads();
}

DEV void pk_scores(const bf16* __restrict__ ktab, const bf16* __restrict__ qp, f32x4 (&s)[8], int g4, int c16) {
  bf16x8 qf[4];
#pragma unroll
  for (int ks = 0; ks < 4; ++ks) qf[ks] = *(const bf16x8*)(qp + ks * 32 + g4 * 8);
#pragma unroll
  for (int mi = 0; mi < 8; ++mi) {
    s[mi] = f32x4{0.f, 0.f, 0.f, 0.f};
#pragma unroll
    for (int ks = 0; ks < 4; ++ks) {
      const bf16x8 kf = *(const bf16x8*)(ktab + (mi * 16 + c16) * 128 + ks * 32 + g4 * 8);
      s[mi] = MFMA16(kf, qf[ks], s[mi]);
    }
  }
}
DEV void pk_top16(f32x4 (&s)[8], int g4, float (&vout)[16], int (&iout)[16]) {
#pragma unroll
  for (int rd = 0; rd < 16; ++rd) {
    float bv = -INFINITY;
    int bi = 1 << 20;
#pragma unroll
    for (int mi = 0; mi < 8; ++mi)
#pragma unroll
      for (int r = 0; r < 4; ++r) {
        const float v = s[mi][r];
        if (v > bv) { bv = v; bi = mi * 16 + g4 * 4 + r; }
      }
#pragma unroll
    for (int off = 16; off <= 32; off <<= 1) {
      const float ov = shx(bv, off);
      const int oi = shx(bi, off);
      if (ov > bv || (ov == bv && oi < bi)) { bv = ov; bi = oi; }
    }
    vout[rd] = bv;
    iout[rd] = bi;
#pragma unroll
    for (int mi = 0; mi < 8; ++mi)
#pragma unroll
      for (int r = 0; r < 4; ++r)
        if (mi * 16 + g4 * 4 + r == bi) s[mi][r] = -INFINITY;
  }
}
DEV void peer_topk_mfma_item(const Params& p, int layer, int item) {
  const int lane = tidx() & 63, wave = tidx() >> 6, g4 = lane >> 4, c16 = lane & 15;
  const size_t tok = (size_t)item * 8 + wave * 2 + (c16 >> 3);
  const int hh = c16 & 7;
  const bf16* qp = (const bf16*)(p.ws + OFF_QP) + tok * 2048 + hh * 256;
  const bf16* k1 = (const bf16*)(p.ws + OFF_PKB) + (size_t)(layer * 2 + 0) * 16384;
  const bf16* k2 = (const bf16*)(p.ws + OFF_PKB) + (size_t)(layer * 2 + 1) * 16384;
  float v1[16], v2[16];
  int i1[16], i2[16];
  {
    f32x4 s[8];
    pk_scores(k1, qp, s, g4, c16);
    pk_top16(s, g4, v1, i1);
  }
  {
    f32x4 s[8];
    pk_scores(k2, qp + 128, s, g4, c16);
    pk_top16(s, g4, v2, i2);
  }
  float v1s[4];
  int i1s[4];
#pragma unroll
  for (int j = 0; j < 4; ++j) {
    v1s[j] = (g4 == 0) ? v1[j] : (g4 == 1) ? v1[4 + j] : (g4 == 2) ? v1[8 + j] : v1[12 + j];
    i1s[j] = (g4 == 0) ? i1[j] : (g4 == 1) ? i1[4 + j] : (g4 == 2) ? i1[8 + j] : i1[12 + j];
  }
  float c0[16], c1[8], c2[5], c3[4];
#pragma unroll
  for (int b = 0; b < 16; ++b) c0[b] = ((4 * g4 + 1) * (b + 1) <= 16) ? v1s[0] + v2[b] : -INFINITY;
#pragma unroll
  for (int b = 0; b < 8; ++b) c1[b] = ((4 * g4 + 2) * (b + 1) <= 16) ? v1s[1] + v2[b] : -INFINITY;
#pragma unroll
  for (int b = 0; b < 5; ++b) c2[b] = ((4 * g4 + 3) * (b + 1) <= 16) ? v1s[2] + v2[b] : -INFINITY;
#pragma unroll
  for (int b = 0; b < 4; ++b) c3[b] = ((4 * g4 + 4) * (b + 1) <= 16) ? v1s[3] + v2[b] : -INFINITY;
  float vals[16];
  int eidx[16];
  const int cbase = g4 * 64;
#pragma unroll
  for (int rd = 0; rd < 16; ++rd) {
    float bv = -INFINITY;
    int bi = 1 << 20;
#pragma unroll
    for (int b = 0; b < 16; ++b) if (c0[b] > bv) { bv = c0[b]; bi = cbase + b; }
#pragma unroll
    for (int b = 0; b < 8; ++b) if (c1[b] > bv) { bv = c1[b]; bi = cbase + 16 + b; }
#pragma unroll
    for (int b = 0; b < 5; ++b) if (c2[b] > bv) { bv = c2[b]; bi = cbase + 32 + b; }
#pragma unroll
    for (int b = 0; b < 4; ++b) if (c3[b] > bv) { bv = c3[b]; bi = cbase + 48 + b; }
#pragma unroll
    for (int off = 16; off <= 32; off <<= 1) {
      const float ov = shx(bv, off);
      const int oi = shx(bi, off);
      if (ov > bv || (ov == bv && oi < bi)) { bv = ov; bi = oi; }
    }
    vals[rd] = bv;
    int e = -1;
#pragma unroll
    for (int b = 0; b < 16; ++b) if (cbase + b == bi) { c0[b] = -INFINITY; e = i1s[0] * 128 + i2[b]; }
#pragma unroll
    for (int b = 0; b < 8; ++b) if (cbase + 16 + b == bi) { c1[b] = -INFINITY; e = i1s[1] * 128 + i2[b]; }
#pragma unroll
    for (int b = 0; b < 5; ++b) if (cbase + 32 + b == bi) { c2[b] = -INFINITY; e = i1s[2] * 128 + i2[b]; }
#pragma unroll
    for (int b = 0; b < 4; ++b) if (cbase + 48 + b == bi) { c3[b] = -INFINITY; e = i1s[3] * 128 + i2[b]; }
    e = max(e, shx(e, 16));
    e = max(e, shx(e, 32));
    eidx[rd] = e;
  }
  float ex[16], sum = 0.f;
#pragma unroll
  for (int rd = 0; rd < 16; ++rd) { ex[rd] = expf(vals[rd] - vals[0]); sum += ex[rd]; }
  const float inv = 1.f / sum;
  if (g4 == 0) {
    int* pi = (int*)(p.ws + OFF_PEIDX) + tok * 128 + hh * 16;
    float* pg = (float*)(p.ws + OFF_PEG) + tok * 128 + hh * 16;
#pragma unroll
    for (int q = 0; q < 4; ++q) {
      *(int4*)(pi + q * 4) = int4{eidx[q * 4], eidx[q * 4 + 1], eidx[q * 4 + 2], eidx[q * 4 + 3]};
      *(float4*)(pg + q * 4) = float4{ex[q * 4] * inv, ex[q * 4 + 1] * inv, ex[q * 4 + 2] * inv, ex[q * 4 + 3] * inv};
    }
  }
}

DEV float pk_key(float v, int inv_idx, unsigned mask) {
  return __uint_as_float((__float_as_uint(v) & ~mask) | (unsigned)inv_idx);
}
DEV void sort32_desc(float (&x)[32]) {
#pragma unroll
  for (int k = 2; k <= 32; k <<= 1)
#pragma unroll
    for (int j = k >> 1; j > 0; j >>= 1)
#pragma unroll
      for (int i = 0; i < 32; ++i) {
        const int l = i ^ j;
        if (l > i) {
          const float a = x[i], b = x[l];
          const float hi = fmaxf(a, b), lo = fminf(a, b);
          if ((i & k) == 0) { x[i] = hi; x[l] = lo; } else { x[i] = lo; x[l] = hi; }
        }
      }
}
DEV void pk_top16_sorted(f32x4 (&s)[8], int g4, float (&vout)[16], int (&iout)[16]) {
  float x[32];
#pragma unroll
  for (int mi = 0; mi < 8; ++mi)
#pragma unroll
    for (int r = 0; r < 4; ++r) x[mi * 4 + r] = pk_key(s[mi][r], 127 - (mi * 16 + g4 * 4 + r), 0x7Fu);
  sort32_desc(x);
#pragma unroll
  for (int rd = 0; rd < 16; ++rd) {
    float w = x[0];
    w = fmaxf(w, shx(w, 16));
    w = fmaxf(w, shx(w, 32));
    vout[rd] = w;
    iout[rd] = 127 - (int)(__float_as_uint(w) & 0x7Fu);
    if (x[0] == w) {
#pragma unroll
      for (int i = 0; i < 15; ++i) x[i] = x[i + 1];
      x[15] = -INFINITY;
    }
  }
}
template <int N>
DEV void shift_row(float (&c)[N], int (&e)[N]) {
#pragma unroll
  for (int i = 0; i + 1 < N; ++i) { c[i] = c[i + 1]; e[i] = e[i + 1]; }
  c[N - 1] = -INFINITY;
}
DEV void peer_topk_item3(const Params& p, int layer, int item, int* lds_idx = nullptr, float* lds_gate = nullptr) {
  const int lane = tidx() & 63, wave = tidx() >> 6, g4 = lane >> 4, c16 = lane & 15;
  const size_t tok = (size_t)item * 8 + wave * 2 + (c16 >> 3);
  const int hh = c16 & 7;
  const bf16* qp = (const bf16*)(p.ws + OFF_QP) + tok * 2048 + hh * 256;
  const bf16* k1 = (const bf16*)(p.ws + OFF_PKB) + (size_t)(layer * 2 + 0) * 16384;
  const bf16* k2 = (const bf16*)(p.ws + OFF_PKB) + (size_t)(layer * 2 + 1) * 16384;
  float v1[16], v2[16];
  int i1[16], i2[16];
  {
    f32x4 s[8];
    pk_scores(k1, qp, s, g4, c16);
    pk_top16_sorted(s, g4, v1, i1);
  }
  {
    f32x4 s[8];
    pk_scores(k2, qp + 128, s, g4, c16);
    pk_top16_sorted(s, g4, v2, i2);
  }
  float v1s[4];
  int i1s[4];
#pragma unroll
  for (int j = 0; j < 4; ++j) {
    v1s[j] = (g4 == 0) ? v1[j] : (g4 == 1) ? v1[4 + j] : (g4 == 2) ? v1[8 + j] : v1[12 + j];
    i1s[j] = (g4 == 0) ? i1[j] : (g4 == 1) ? i1[4 + j] : (g4 == 2) ? i1[8 + j] : i1[12 + j];
  }
  float c0[16], c1[8], c2[5], c3[4];
  int e0[16], e1[8], e2[5], e3[4];
  const int cbase = g4 * 64;
#pragma unroll
  for (int b = 0; b < 16; ++b) {
    c0[b] = ((4 * g4 + 1) * (b + 1) <= 16) ? pk_key(v1s[0] + v2[b], 255 - (cbase + b), 0xFFu) : -INFINITY;
    e0[b] = i1s[0] * 128 + i2[b];
  }
#pragma unroll
  for (int b = 0; b < 8; ++b) {
    c1[b] = ((4 * g4 + 2) * (b + 1) <= 16) ? pk_key(v1s[1] + v2[b], 255 - (cbase + 16 + b), 0xFFu) : -INFINITY;
    e1[b] = i1s[1] * 128 + i2[b];
  }
#pragma unroll
  for (int b = 0; b < 5; ++b) {
    c2[b] = ((4 * g4 + 3) * (b + 1) <= 16) ? pk_key(v1s[2] + v2[b], 255 - (cbase + 32 + b), 0xFFu) : -INFINITY;
    e2[b] = i1s[2] * 128 + i2[b];
  }
#pragma unroll
  for (int b = 0; b < 4; ++b) {
    c3[b] = ((4 * g4 + 4) * (b + 1) <= 16) ? pk_key(v1s[3] + v2[b], 255 - (cbase + 48 + b), 0xFFu) : -INFINITY;
    e3[b] = i1s[3] * 128 + i2[b];
  }
  float vals[16];
  int eidx[16];
#pragma unroll
  for (int rd = 0; rd < 16; ++rd) {
    float w = fmaxf(fmaxf(c0[0], c1[0]), fmaxf(c2[0], c3[0]));
    w = fmaxf(w, shx(w, 16));
    w = fmaxf(w, shx(w, 32));
    vals[rd] = w;
    int e = -1;
    if (c0[0] == w) { e = e0[0]; shift_row(c0, e0); }
    if (c1[0] == w) { e = e1[0]; shift_row(c1, e1); }
    if (c2[0] == w) { e = e2[0]; shift_row(c2, e2); }
    if (c3[0] == w) { e = e3[0]; shift_row(c3, e3); }
    e = max(e, shx(e, 16));
    e = max(e, shx(e, 32));
    eidx[rd] = e;
  }
  float ex[16], sum = 0.f;
#pragma unroll
  for (int rd = 0; rd < 16; ++rd) { ex[rd] = expf(vals[rd] - vals[0]); sum += ex[rd]; }
  const float inv = 1.f / sum;
  if (g4 == 0) {
    int* pi = lds_idx ? (lds_idx + (c16 >> 3) * 128 + hh * 16) : ((int*)(p.ws + OFF_PEIDX) + tok * 128 + hh * 16);
    float* pg = lds_gate ? (lds_gate + (c16 >> 3) * 128 + hh * 16) : ((float*)(p.ws + OFF_PEG) + tok * 128 + hh * 16);
#pragma unroll
    for (int q = 0; q < 4; ++q) {
      *(int4*)(pi + q * 4) = int4{eidx[q * 4], eidx[q * 4 + 1], eidx[q * 4 + 2], eidx[q * 4 + 3]};
      *(float4*)(pg + q * 4) = float4{ex[q * 4] * inv, ex[q * 4 + 1] * inv, ex[q * 4 + 2] * inv, ex[q * 4 + 3] * inv};
    }
  }
}

typedef float f32x2_t __attribute__((ext_vector_type(2)));
DEV unsigned pack4_fp8(float a, float b, float c, float d) {
  int p = __builtin_amdgcn_cvt_pk_fp8_f32(a, b, 0, false);
  p = __builtin_amdgcn_cvt_pk_fp8_f32(c, d, p, true);
  return (unsigned)p;
}
DEV void unpack16_fp8(uint4 v, float* f) {
  f32x2_t r;
  r = __builtin_amdgcn_cvt_pk_f32_fp8((int)v.x, false); f[0] = r.x; f[1] = r.y;
  r = __builtin_amdgcn_cvt_pk_f32_fp8((int)v.x, true);  f[2] = r.x; f[3] = r.y;
  r = __builtin_amdgcn_cvt_pk_f32_fp8((int)v.y, false); f[4] = r.x; f[5] = r.y;
  r = __builtin_amdgcn_cvt_pk_f32_fp8((int)v.y, true);  f[6] = r.x; f[7] = r.y;
  r = __builtin_amdgcn_cvt_pk_f32_fp8((int)v.z, false); f[8] = r.x; f[9] = r.y;
  r = __builtin_amdgcn_cvt_pk_f32_fp8((int)v.z, true);  f[10] = r.x; f[11] = r.y;
  r = __builtin_amdgcn_cvt_pk_f32_fp8((int)v.w, false); f[12] = r.x; f[13] = r.y;
  r = __builtin_amdgcn_cvt_pk_f32_fp8((int)v.w, true);  f[14] = r.x; f[15] = r.y;
}
DEV void expert_cvt_item(const Params& p, int layer, int item) {
  const int lane = tidx() & 63, wave = tidx() >> 6;
  const int e = item * 4 + wave;
  unsigned char* dst = (unsigned char*)(p.ws + OFF_E8) + (size_t)e * 2048;
  float* sc = (float*)(p.ws + OFF_ESC) + (size_t)e * 2;
#pragma unroll
  for (int tb = 0; tb < 2; ++tb) {
    const float* src = (tb ? p.peer_v : p.peer_u) + ((size_t)layer * NEXP + e) * 1024 + lane * 16;
    float4 a = *(const float4*)src, b = *(const float4*)(src + 4), c = *(const float4*)(src + 8), d = *(const float4*)(src + 12);
    float mx = fmaxf(fmaxf(fmaxf(fabsf(a.x), fabsf(a.y)), fmaxf(fabsf(a.z), fabsf(a.w))),
                     fmaxf(fmaxf(fabsf(b.x), fabsf(b.y)), fmaxf(fabsf(b.z), fabsf(b.w))));
    mx = fmaxf(mx, fmaxf(fmaxf(fmaxf(fabsf(c.x), fabsf(c.y)), fmaxf(fabsf(c.z), fabsf(c.w))),
                         fmaxf(fmaxf(fabsf(d.x), fabsf(d.y)), fmaxf(fabsf(d.z), fabsf(d.w)))));
#pragma unroll
    for (int o = 32; o >= 1; o >>= 1) mx = fmaxf(mx, shx(mx, o));
    const float s = (mx > 0.f) ? 224.f / mx : 1.f;
    uint4 pk;
    pk.x = pack4_fp8(a.x * s, a.y * s, a.z * s, a.w * s);
    pk.y = pack4_fp8(b.x * s, b.y * s, b.z * s, b.w * s);
    pk.z = pack4_fp8(c.x * s, c.y * s, c.z * s, c.w * s);
    pk.w = pack4_fp8(d.x * s, d.y * s, d.z * s, d.w * s);
    *(uint4*)(dst + tb * 1024 + lane * 16) = pk;
    if (lane == 0) sc[tb] = 1.f / s;
  }
}

DEV float rdlane_f(float v, int l) { return __int_as_float(__builtin_amdgcn_readlane(__float_as_int(v), l)); }
DEV float dot16_f8(const float* hw, uint4 u) {
  float f[16];
  unpack16_fp8(u, f);
  float s = 0.f;
#pragma unroll
  for (int i = 0; i < 16; ++i) s += hw[i] * f[i];
  return s;
}
DEV void axpy16_f8(float* acc, float a, uint4 u) {
  float f[16];
  unpack16_fp8(u, f);
#pragma unroll
  for (int i = 0; i < 16; ++i) acc[i] += a * f[i];
}
#define PE_ROWPTR(idxv, j) (E8 + (size_t)__builtin_amdgcn_readlane(idxv, (j)) * 2048)
#define PE_LOAD8(P, idxv, j0, off)                                                                        \
  P##0 = *(const uint4*)(PE_ROWPTR(idxv, (j0)) + (off)); P##1 = *(const uint4*)(PE_ROWPTR(idxv, (j0) + 1) + (off)); \
  P##2 = *(const uint4*)(PE_ROWPTR(idxv, (j0) + 2) + (off)); P##3 = *(const uint4*)(PE_ROWPTR(idxv, (j0) + 3) + (off)); \
  P##4 = *(const uint4*)(PE_ROWPTR(idxv, (j0) + 4) + (off)); P##5 = *(const uint4*)(PE_ROWPTR(idxv, (j0) + 5) + (off)); \
  P##6 = *(const uint4*)(PE_ROWPTR(idxv, (j0) + 6) + (off)); P##7 = *(const uint4*)(PE_ROWPTR(idxv, (j0) + 7) + (off));
#define PE_DOTSET(P, j0, dv)                                                                              \
  {                                                                                                       \
    const float s0 = wave_sum(dot16_f8(hw, P##0)), s1 = wave_sum(dot16_f8(hw, P##1)),                     \
                s2 = wave_sum(dot16_f8(hw, P##2)), s3 = wave_sum(dot16_f8(hw, P##3)),                     \
                s4 = wave_sum(dot16_f8(hw, P##4)), s5 = wave_sum(dot16_f8(hw, P##5)),                     \
                s6 = wave_sum(dot16_f8(hw, P##6)), s7 = wave_sum(dot16_f8(hw, P##7));                     \
    if (lane == (j0)) dv = s0;                                                                            \
    if (lane == (j0) + 1) dv = s1;                                                                        \
    if (lane == (j0) + 2) dv = s2;                                                                        \
    if (lane == (j0) + 3) dv = s3;                                                                        \
    if (lane == (j0) + 4) dv = s4;                                                                        \
    if (lane == (j0) + 5) dv = s5;                                                                        \
    if (lane == (j0) + 6) dv = s6;                                                                        \
    if (lane == (j0) + 7) dv = s7;                                                                        \
  }
#define PE_AXPYSET(P, j0, av)                                                                             \
  {                                                                                                       \
    axpy16_f8(acc, rdlane_f(av, (j0)), P##0);     axpy16_f8(acc, rdlane_f(av, (j0) + 1), P##1);           \
    axpy16_f8(acc, rdlane_f(av, (j0) + 2), P##2); axpy16_f8(acc, rdlane_f(av, (j0) + 3), P##3);           \
    axpy16_f8(acc, rdlane_f(av, (j0) + 4), P##4); axpy16_f8(acc, rdlane_f(av, (j0) + 5), P##5);           \
    axpy16_f8(acc, rdlane_f(av, (j0) + 6), P##6); axpy16_f8(acc, rdlane_f(av, (j0) + 7), P##7);           \
  }
#define PE_DOT8(idxv, dv)                                                                                 \
  {                                                                                                       \
    uint4 pa0, pa1, pa2, pa3, pa4, pa5, pa6, pa7, pb0, pb1, pb2, pb3, pb4, pb5, pb6, pb7;                 \
    PE_LOAD8(pa, idxv, 0, 0)                                                                              \
    _Pragma("unroll 1") for (int g = 0; g < 4; ++g) {                                                     \
      const int j0 = g * 16;                                                                              \
      PE_LOAD8(pb, idxv, j0 + 8, 0)                                                                       \
      PE_DOTSET(pa, j0, dv)                                                                               \
      if (g < 3) { PE_LOAD8(pa, idxv, j0 + 16, 0) }                                                       \
      PE_DOTSET(pb, j0 + 8, dv)                                                                           \
    }                                                                                                     \
  }
#define PE_AXPY8(idxv, av)                                                                                \
  {                                                                                                       \
    uint4 pa0, pa1, pa2, pa3, pa4, pa5, pa6, pa7, pb0, pb1, pb2, pb3, pb4, pb5, pb6, pb7;                 \
    PE_LOAD8(pa, idxv, 0, 1024)                                                                           \
    _Pragma("unroll 1") for (int g = 0; g < 4; ++g) {                                                     \
      const int j0 = g * 16;                                                                              \
      PE_LOAD8(pb, idxv, j0 + 8, 1024)                                                                    \
      PE_AXPYSET(pa, j0, av)                                                                              \
      if (g < 3) { PE_LOAD8(pa, idxv, j0 + 16, 1024) }                                                    \
      PE_AXPYSET(pb, j0 + 8, av)                                                                          \
    }                                                                                                     \
  }
DEV void peer_expert_tok(const Params& p, int layer, size_t tok, float ga_scale, const int* pi, const float* pg) {
  const int lane = tidx() & 63;
  const int b = (int)(tok / S);
  const int idx_lo = pi[lane], idx_hi = pi[64 + lane];
  const float g_lo = pg[lane], g_hi = pg[64 + lane];
  const float* esc = (const float*)(p.ws + OFF_ESC);
  const float2 sc_lo = *(const float2*)(esc + (size_t)idx_lo * 2), sc_hi = *(const float2*)(esc + (size_t)idx_hi * 2);
  const bf16* hrow = (const bf16*)(p.ws + OFF_H) + tok * 1024 + lane * 16;
  float hw[16];
  unpack8(*(const uint4*)hrow, hw);
  unpack8(*(const uint4*)(hrow + 8), hw + 8);
  const unsigned char* E8 = (const unsigned char*)(p.ws + OFF_E8) + lane * 16;
  float d_lo = 0.f, d_hi = 0.f;
  PE_DOT8(idx_lo, d_lo)
  PE_DOT8(idx_hi, d_hi)
  const float act_lo = g_lo * gelu_tanh(d_lo * sc_lo.x) * sc_lo.y;
  const float act_hi = g_hi * gelu_tanh(d_hi * sc_hi.x) * sc_hi.y;
  float acc[16];
#pragma unroll
  for (int i = 0; i < 16; ++i) acc[i] = 0.f;
  PE_AXPY8(idx_lo, act_lo)
  PE_AXPY8(idx_hi, act_hi)
  const float* ga = (const float*)(p.ws + OFF_MOD) + (layer * 2 + b) * 6144 + 5120 + lane * 16;
  float* xr = p.out + tok * 1024 + lane * 16;
  float xn[16];
  float ss = 0.f;
#pragma unroll
  for (int q4 = 0; q4 < 4; ++q4) {
    float4 xo = *(float4*)(xr + q4 * 4);
    const float4 g4v = *(const float4*)(ga + q4 * 4);
    xo.x += ga_scale * g4v.x * acc[q4 * 4 + 0];
    xo.y += ga_scale * g4v.y * acc[q4 * 4 + 1];
    xo.z += ga_scale * g4v.z * acc[q4 * 4 + 2];
    xo.w += ga_scale * g4v.w * acc[q4 * 4 + 3];
    xn[q4 * 4] = xo.x; xn[q4 * 4 + 1] = xo.y; xn[q4 * 4 + 2] = xo.z; xn[q4 * 4 + 3] = xo.w;
    ss += xo.x * xo.x + xo.y * xo.y + xo.z * xo.z + xo.w * xo.w;
  }
#if PROBE_ANY || REP_MASK
#pragma unroll
  for (int q4 = 0; q4 < 4; ++q4)
    *(float4*)(xr + q4 * 4) = float4{xn[q4 * 4], xn[q4 * 4 + 1], xn[q4 * 4 + 2], xn[q4 * 4 + 3]};
  return;
#endif
  ss = wave_sum(ss);
  const float rn = 1.0f / sqrtf(ss * (1.0f / 1024.f) + 1e-6f);
  if (layer == 0) {
    const float* gn = p.g_attn + 1024 + lane * 16;
    const float* md = (const float*)(p.ws + OFF_MOD) + (2 + b) * 6144 + lane * 16;
    unsigned char* hq = (unsigned char*)(p.ws + OFF_H8) + tok * 1024 + lane * 16;
    float o[16];
    float mx = 0.f;
#pragma unroll
    for (int q4 = 0; q4 < 4; ++q4) {
      *(float4*)(xr + q4 * 4) = float4{xn[q4 * 4], xn[q4 * 4 + 1], xn[q4 * 4 + 2], xn[q4 * 4 + 3]};
      const float4 g4v = *(const float4*)(gn + q4 * 4);
      const float4 s4 = *(const float4*)(md + 1024 + q4 * 4);
      const float4 h4 = *(const float4*)(md + q4 * 4);
      o[q4 * 4] = xn[q4 * 4] * rn * g4v.x * (1.f + s4.x) + h4.x;
      o[q4 * 4 + 1] = xn[q4 * 4 + 1] * rn * g4v.y * (1.f + s4.y) + h4.y;
      o[q4 * 4 + 2] = xn[q4 * 4 + 2] * rn * g4v.z * (1.f + s4.z) + h4.z;
      o[q4 * 4 + 3] = xn[q4 * 4 + 3] * rn * g4v.w * (1.f + s4.w) + h4.w;
      mx = fmaxf(mx, fmaxf(fmaxf(fabsf(o[q4 * 4]), fabsf(o[q4 * 4 + 1])), fmaxf(fabsf(o[q4 * 4 + 2]), fabsf(o[q4 * 4 + 3]))));
    }
#pragma unroll
    for (int of = 32; of >= 1; of >>= 1) mx = fmaxf(mx, shx(mx, of));
    const unsigned qe = e8m0_of(mx);
    const float qs = e8m0_inv(qe);
    uint4 pk;
    pk.x = pack4_fp8(o[0] * qs, o[1] * qs, o[2] * qs, o[3] * qs);
    pk.y = pack4_fp8(o[4] * qs, o[5] * qs, o[6] * qs, o[7] * qs);
    pk.z = pack4_fp8(o[8] * qs, o[9] * qs, o[10] * qs, o[11] * qs);
    pk.w = pack4_fp8(o[12] * qs, o[13] * qs, o[14] * qs, o[15] * qs);
    *(uint4*)hq = pk;
    if (lane == 0) ((unsigned char*)(p.ws + OFF_H8S))[tok] = (unsigned char)qe;
  } else {
    const float* gf = p.g_final + lane * 16;
#pragma unroll
    for (int q4 = 0; q4 < 4; ++q4) {
      const float4 g4v = *(const float4*)(gf + q4 * 4);
      *(float4*)(xr + q4 * 4) = float4{xn[q4 * 4] * rn * g4v.x, xn[q4 * 4 + 1] * rn * g4v.y, xn[q4 * 4 + 2] * rn * g4v.z,
                                       xn[q4 * 4 + 3] * rn * g4v.w};
    }
  }
}

DEV void peer_expert_item2(const Params& p, int layer, int item, float ga_scale = 1.f) {
  const size_t tok = (size_t)item * 4 + (tidx() >> 6);
  peer_expert_tok(p, layer, tok, ga_scale, (const int*)(p.ws + OFF_PEIDX) + tok * 128, (const float*)(p.ws + OFF_PEG) + tok * 128);
}
DEV void peer_fused_item(const Params& p, int layer, int item, char* smem) {
  const int wave = tidx() >> 6;
  int* li = (int*)(smem + wave * 2048);
  float* lg = (float*)(smem + wave * 2048 + 1024);
  peer_topk_item3(p, layer, item, li, lg);
  asm volatile("s_waitcnt lgkmcnt(0)" ::: "memory");
  __builtin_amdgcn_wave_barrier();
  const size_t tok0 = (size_t)item * 8 + wave * 2;
  peer_expert_tok(p, layer, tok0, 1.f, li, lg);
  peer_expert_tok(p, layer, tok0 + 1, 1.f, li + 128, lg + 128);
  asm volatile("s_waitcnt lgkmcnt(0)" ::: "memory");
  __builtin_amdgcn_wave_barrier();
}
namespace g8 {
constexpr int BM = 256, BK = 64, HALF = 128, HTB = HALF * BK * 2, STAGE_BYTES = 8 * HTB, NXCD = 8, WGM = 8;
DEV int lds_byte(int r, int c) { const int st = (r >> 4) * 2 + (c >> 5), rr = r & 15, cc = c & 31, ob = rr * 64 + cc * 2; return st * 1024 + (ob ^ (((ob >> 9) & 1) << 5)); }
DEV void stage_rc(int b, int& R, int& C) { const int st = b / 1024, sb = b % 1024, swz = sb ^ (((sb >> 9) & 1) << 5); R = (st >> 1) * 16 + swz / 64; C = (st & 1) * 32 + (swz % 64) / 2; }
DEV int perm32(int rho) { const int n = rho >> 4, i = rho & 15; return 8 * (i >> 2) + 4 * n + (i & 3); }
struct Unit { int pm, pn; };
struct Gemm { const bf16* A; const bf16* Bt; int M, N, K; const unsigned char* sa = nullptr; const unsigned char* sb = nullptr; };
struct StaticOrder {
  int nM, nN, nwg, G, c;
  DEV void init(int M, int N, int G_, int c_) { nM = M / BM; nN = N / BM; nwg = nM * nN; G = G_; c = c_; }
  DEV bool next(int i, Unit& u) const {
    const long L = (long)i * G + c;
    if (L >= nwg) return false;
    int wgid = (int)L;
    { const int q = nwg / NXCD, r = nwg % NXCD, xcd = wgid % NXCD, off = wgid / NXCD; wgid = (xcd < r ? xcd * (q + 1) : r * (q + 1) + (xcd - r) * q) + off; }
    const int nig = WGM * nN, gid = wgid / nig, fm = gid * WGM, gsz = (nM - fm) < WGM ? (nM - fm) : WGM;
    u.pm = fm + ((wgid % nig) % gsz);
    u.pn = (wgid % nig) / gsz;
    return true;
  }
};
typedef int v4i32_t __attribute__((ext_vector_type(4)));
typedef int v8i32_t __attribute__((ext_vector_type(8)));
template <class Epi, bool F8 = false>
DEV void gemm_phase(LAS unsigned char* lds, const Gemm g, const StaticOrder& S, const Epi& E) {
  int tid = threadIdx.x;
  asm volatile("" : "+v"(tid));
  const int wid = __builtin_amdgcn_readfirstlane(tid >> 6), lane = tid & 63, wr = wid >> 2, wc = wid & 3, fr = lane & 15, fq = lane >> 4;
  const int K = g.K, nt = K / BK;
  unsigned voffA[2], voffB[2];
#pragma unroll
  for (int i = 0; i < 2; ++i) {
    int R, C;
    stage_rc(tid * 16 + i * 8192, R, C);
    const int Rb = Epi::PERM ? ((R & ~31) + perm32(R & 31)) : R;
    voffA[i] = (unsigned)(R * K + C) * 2u;
    voffB[i] = (unsigned)(Rb * K + C) * 2u;
  }
  const size_t kstep = (size_t)(BK * 2);
  const size_t hstep = (size_t)HALF * K * 2;
  const size_t tstep = 2 * hstep;
  const unsigned ldsw = (unsigned)wid * 1024u;
  const int aoff = lds_byte(wr * 64 + fr, fq * 8), boff = lds_byte(wc * 32 + fr, fq * 8);
#define PG8_SA(b, h) (((b) * 2 + (h)) * HTB)
#define PG8_SB(b, h) ((4 + (b) * 2 + (h)) * HTB)
#define PG8_STAGE(bufoff, gbase, voff) do { _Pragma("unroll") for (int _i = 0; _i < 2; ++_i) \
    __builtin_amdgcn_global_load_lds((const unsigned*)((const char*)(gbase) + (voff)[_i]), (LAS unsigned*)(lds + (bufoff) + ldsw + _i * 8192), 16, 0, 0); } while (0)
#define PG8_LD8(dst_, addr_) do { const v4i32_t lo_ = *(const LAS v4i32_t*)(addr_), hi_ = *(const LAS v4i32_t*)((addr_) + 1024); \
    dst_ = __builtin_shufflevector(lo_, hi_, 0, 1, 2, 3, 4, 5, 6, 7); } while (0)
#define PG8_LDA(dst, b, h) do { _Pragma("unroll") for (int m = 0; m < 4; ++m) PG8_LD8(dst[m], lds + PG8_SA(b, h) + aoff + m * 2048); } while (0)
#define PG8_LDB(dst, b, h) do { _Pragma("unroll") for (int n = 0; n < 2; ++n) PG8_LD8(dst[n], lds + PG8_SB(b, h) + boff + n * 2048); } while (0)
#define PG8_LO(x) __builtin_bit_cast(bf16x8, __builtin_shufflevector((x), (x), 0, 1, 2, 3))
#define PG8_HI(x) __builtin_bit_cast(bf16x8, __builtin_shufflevector((x), (x), 4, 5, 6, 7))
#define PG8_STR_(x) #x
#define PG8_STR(x) PG8_STR_(x)
#define PG8_MLO_0 0
#define PG8_MLO_1 1
#define PG8_MLO_2 0
#define PG8_MLO_3 1
#define PG8_MHI_0 0
#define PG8_MHI_1 0
#define PG8_MHI_2 1
#define PG8_MHI_3 1
#define PG8_M1(ai, bj, m, n, At, Bt) do { \
    if constexpr (F8) asm volatile("v_mfma_scale_f32_16x16x128_f8f6f4 %0, %1, %2, %0, %3, %4 op_sel:[" PG8_STR(n) "," PG8_STR(PG8_MLO_##m) ",0] op_sel_hi:[" PG8_STR(bj) "," PG8_STR(PG8_MHI_##m) ",0]" \
                                   : "+v"(acc[ai][bj][m][n]) : "v"(Bt[n]), "v"(At[m]), "v"(scB), "v"(scA[ai])); \
    else { acc[ai][bj][m][n] = __builtin_amdgcn_mfma_f32_16x16x32_bf16(PG8_LO(Bt[n]), PG8_LO(At[m]), acc[ai][bj][m][n], 0, 0, 0); \
           acc[ai][bj][m][n] = __builtin_amdgcn_mfma_f32_16x16x32_bf16(PG8_HI(Bt[n]), PG8_HI(At[m]), acc[ai][bj][m][n], 0, 0, 0); } } while (0)
#define PG8_MMA(ai, bj, At, Bt) do { __builtin_amdgcn_s_setprio(1); \
    PG8_M1(ai, bj, 0, 0, At, Bt); PG8_M1(ai, bj, 0, 1, At, Bt); PG8_M1(ai, bj, 1, 0, At, Bt); PG8_M1(ai, bj, 1, 1, At, Bt); \
    PG8_M1(ai, bj, 2, 0, At, Bt); PG8_M1(ai, bj, 2, 1, At, Bt); PG8_M1(ai, bj, 3, 0, At, Bt); PG8_M1(ai, bj, 3, 1, At, Bt); \
    __builtin_amdgcn_s_setprio(0); } while (0)
#define PG8_WAIT_V(n) asm volatile("s_waitcnt vmcnt(" #n ")" ::: "memory")
#define PG8_WAIT_L(n) asm volatile("s_waitcnt lgkmcnt(" #n ")" ::: "memory")
#define PG8_BAR __builtin_amdgcn_s_barrier()
#define PG8_SCHED __builtin_amdgcn_sched_barrier(0)
  Unit cur, nxt;
  int ui = 0;
  if (!S.next(0, cur)) return;
  f32x4 acc[2][2][4][2];
#pragma unroll
  for (int a = 0; a < 2; ++a)
#pragma unroll
    for (int b = 0; b < 2; ++b)
#pragma unroll
      for (int m = 0; m < 4; ++m)
#pragma unroll
        for (int n = 0; n < 2; ++n) acc[a][b][m][n] = (f32x4){0.f, 0.f, 0.f, 0.f};
  v8i32_t At[4], B0[2], B1[2];
  const char* cA = (const char*)g.A + (size_t)cur.pm * tstep;
  const char* cB = (const char*)g.Bt + (size_t)cur.pn * tstep;
  PG8_STAGE(PG8_SB(0, 0), cB, voffB); PG8_STAGE(PG8_SA(0, 0), cA, voffA); PG8_STAGE(PG8_SB(0, 1), cB + hstep, voffB); PG8_STAGE(PG8_SA(0, 1), cA + hstep, voffA);
  if (wr == 1) PG8_BAR;
  PG8_WAIT_V(4); PG8_BAR;
  PG8_STAGE(PG8_SB(1, 0), cB + kstep, voffB); PG8_STAGE(PG8_SA(1, 0), cA + kstep, voffA); PG8_STAGE(PG8_SB(1, 1), cB + hstep + kstep, voffB);
  PG8_WAIT_V(6); PG8_BAR;
  unsigned scA[2] = {0x7f7f7f7fu, 0x7f7f7f7fu}, scB = 0x7f7f7f7fu;
  for (;;) {
    if constexpr (F8) {
      const unsigned char* ta = g.sa + (size_t)cur.pm * BM + wr * 64 + fr;
      const unsigned char* tb = g.sb + (size_t)cur.pn * BM + wc * 32 + 8 * (fr >> 2) + (fr & 3);
      scA[0] = (unsigned)ta[0] | ((unsigned)ta[16] << 8) | ((unsigned)ta[32] << 16) | ((unsigned)ta[48] << 24);
      scA[1] = (unsigned)ta[HALF] | ((unsigned)ta[HALF + 16] << 8) | ((unsigned)ta[HALF + 32] << 16) | ((unsigned)ta[HALF + 48] << 24);
      scB = (unsigned)tb[0] | ((unsigned)tb[4] << 8) | ((unsigned)tb[HALF] << 16) | ((unsigned)tb[HALF + 4] << 24);
    }
    const bool has_next = S.next(ui + 1, nxt);
    const char* nA = has_next ? (const char*)g.A + (size_t)nxt.pm * tstep : cA;
    const char* nB = has_next ? (const char*)g.Bt + (size_t)nxt.pn * tstep : cB;
#pragma unroll 1
    for (int t = 0; t < nt; t += 2) {
      const bool last = (t == nt - 2);
      const char* a1 = cA + (size_t)(t + 1) * kstep;
      const char* a2 = last ? nA : cA + (size_t)(t + 2) * kstep;
      const char* b2 = last ? nB : cB + (size_t)(t + 2) * kstep;
      const char* a3 = a2 + kstep;
      const char* b3 = b2 + kstep;
      PG8_LDB(B0, 0, 0); PG8_SCHED; PG8_LDA(At, 0, 0); PG8_STAGE(PG8_SA(1, 1), a1 + hstep, voffA);
      PG8_WAIT_L(8); PG8_BAR; PG8_WAIT_L(0); PG8_MMA(0, 0, At, B0); PG8_BAR; PG8_SCHED;
      PG8_LDB(B1, 0, 1); PG8_STAGE(PG8_SB(0, 0), b2, voffB);
      PG8_BAR; PG8_WAIT_L(0); PG8_MMA(0, 1, At, B1); PG8_BAR;
      PG8_LDA(At, 0, 1); PG8_STAGE(PG8_SA(0, 0), a2, voffA);
      PG8_BAR; PG8_WAIT_L(0); PG8_MMA(1, 0, At, B0); PG8_BAR; PG8_SCHED;
      PG8_STAGE(PG8_SB(0, 1), b2 + hstep, voffB);
      PG8_WAIT_V(6); PG8_BAR; PG8_MMA(1, 1, At, B1); PG8_BAR;
      PG8_LDB(B0, 1, 0); PG8_SCHED; PG8_LDA(At, 1, 0); PG8_STAGE(PG8_SA(0, 1), a2 + hstep, voffA);
      PG8_WAIT_L(8); PG8_BAR; PG8_WAIT_L(0); PG8_MMA(0, 0, At, B0); PG8_BAR; PG8_SCHED;
      PG8_LDB(B1, 1, 1); PG8_STAGE(PG8_SB(1, 0), b3, voffB);
      PG8_BAR; PG8_WAIT_L(0); PG8_MMA(0, 1, At, B1); PG8_BAR;
      PG8_LDA(At, 1, 1); PG8_STAGE(PG8_SA(1, 0), a3, voffA);
      PG8_BAR; PG8_WAIT_L(0); PG8_MMA(1, 0, At, B0); PG8_BAR; PG8_SCHED;
      PG8_STAGE(PG8_SB(1, 1), b3 + hstep, voffB);
      PG8_WAIT_V(6); PG8_BAR; PG8_MMA(1, 1, At, B1); PG8_BAR;
    }
    if constexpr (F8) asm volatile("s_nop 15\n\ts_nop 15" ::: "memory");
    E(acc, cur, wr, wc, fr, fq);
    if (!has_next) break;
#pragma unroll
    for (int a = 0; a < 2; ++a)
#pragma unroll
      for (int b = 0; b < 2; ++b)
#pragma unroll
        for (int m = 0; m < 4; ++m)
#pragma unroll
          for (int n = 0; n < 2; ++n) acc[a][b][m][n] = (f32x4){0.f, 0.f, 0.f, 0.f};
    cur = nxt; cA = nA; cB = nB; ++ui;
  }
  PG8_WAIT_V(0);
  if (wr == 0) PG8_BAR;
  PG8_BAR;
#undef PG8_SA
#undef PG8_SB
#undef PG8_STAGE
#undef PG8_LDA
#undef PG8_LDB
#undef PG8_MMA
#undef PG8_M1
#undef PG8_LD8
#undef PG8_LO
#undef PG8_HI
#undef PG8_WAIT_V
#undef PG8_WAIT_L
#undef PG8_BAR
#undef PG8_SCHED
}
DEV unsigned cvt2(float lo, float hi) { unsigned r; asm volatile("v_cvt_pk_bf16_f32 %0, %1, %2" : "=v"(r) : "v"(lo), "v"(hi)); return r; }

struct EpiBf16 {
  static constexpr bool PERM = true;
  bf16* O; int ldc;
  DEV void operator()(const f32x4 (&acc)[2][2][4][2], const Unit& u, int wr, int wc, int fr, int fq) const {
    const int row0 = u.pm * BM + wr * 64 + fr, col0 = u.pn * BM + wc * 32 + 8 * fq;
#pragma unroll
    for (int ai = 0; ai < 2; ++ai)
#pragma unroll
      for (int m = 0; m < 4; ++m) {
        bf16* rowp = O + (size_t)(row0 + ai * HALF + m * 16) * ldc + col0;
#pragma unroll
        for (int bj = 0; bj < 2; ++bj) {
          const f32x4 v0 = acc[ai][bj][m][0], v1 = acc[ai][bj][m][1];
          u32x4_t w;
          w.x = cvt2(v0[0], v0[1]); w.y = cvt2(v0[2], v0[3]); w.z = cvt2(v1[0], v1[1]); w.w = cvt2(v1[2], v1[3]);
          *(u32x4_t*)(rowp + bj * HALF) = w;
        }
      }
  }
};
struct EpiResid {
  static constexpr bool PERM = false;
  const float* xin; float* out; const float* ga;
  DEV void operator()(const f32x4 (&acc)[2][2][4][2], const Unit& u, int wr, int wc, int fr, int fq) const {
    const int row0 = u.pm * BM + wr * 64 + fr, col0 = u.pn * BM + wc * 32 + 4 * fq;
    const int b = (u.pm * BM) / S;
    f32x4 gv[2][2];
#pragma unroll
    for (int bj = 0; bj < 2; ++bj)
#pragma unroll
      for (int n = 0; n < 2; ++n) gv[bj][n] = *(const f32x4*)(ga + b * 6144 + col0 + bj * HALF + n * 16);
#pragma unroll
    for (int ai = 0; ai < 2; ++ai)
#pragma unroll
      for (int m = 0; m < 4; ++m) {
        const size_t off = (size_t)(row0 + ai * HALF + m * 16) * 1024 + col0;
#pragma unroll
        for (int bj = 0; bj < 2; ++bj)
#pragma unroll
          for (int n = 0; n < 2; ++n) {
            const f32x4 xv = *(const f32x4*)(xin + off + bj * HALF + n * 16);
            *(f32x4*)(out + off + bj * HALF + n * 16) = xv + gv[bj][n] * acc[ai][bj][m][n];
          }
      }
  }
};
DEV float sig_(float x) { return 1.f / (1.f + __expf(-x)); }
template <bool SECOND>
struct EpiMerge {
  static constexpr bool PERM = true;
  bf16* Y; const bf16* proj; int gcol;
  DEV void operator()(const f32x4 (&acc)[2][2][4][2], const Unit& u, int wr, int wc, int fr, int fq) const {
    const int row0 = u.pm * BM + wr * 64 + fr, col0 = u.pn * BM + wc * 32 + 8 * fq;
#pragma unroll
    for (int ai = 0; ai < 2; ++ai)
#pragma unroll
      for (int m = 0; m < 4; ++m) {
        const size_t row = (size_t)(row0 + ai * HALF + m * 16);
#pragma unroll
        for (int bj = 0; bj < 2; ++bj) {
          const uint4 gq = *(const uint4*)(proj + row * PC + gcol + col0 + bj * HALF);
          float gf[8];
          unpack8(gq, gf);
          const f32x4 v0 = acc[ai][bj][m][0], v1 = acc[ai][bj][m][1];
          float o[8] = {sig_(gf[0]) * v0[0], sig_(gf[1]) * v0[1], sig_(gf[2]) * v0[2], sig_(gf[3]) * v0[3],
                        sig_(gf[4]) * v1[0], sig_(gf[5]) * v1[1], sig_(gf[6]) * v1[2], sig_(gf[7]) * v1[3]};
          bf16* yp = Y + row * 1024 + col0 + bj * HALF;
          if (SECOND) {
            float yf[8];
            unpack8(*(const uint4*)yp, yf);
#pragma unroll
            for (int j = 0; j < 8; ++j) o[j] += yf[j];
          }
          u32x4_t w;
          w.x = cvt2(o[0], o[1]); w.y = cvt2(o[2], o[3]); w.z = cvt2(o[4], o[5]); w.w = cvt2(o[6], o[7]);
          *(u32x4_t*)yp = w;
        }
      }
  }
};
struct EpiInproj {
  static constexpr bool PERM = true;
  char* ws;
  DEV void operator()(const f32x4 (&acc)[2][2][4][2], const Unit& u, int wr, int wc, int fr, int fq) const {
    const int b = (u.pm * BM) / S;
    const float* rope = (const float*)(ws + OFF_ROPE);
#pragma unroll
    for (int bj = 0; bj < 2; ++bj) {
      const int vcb = u.pn * BM + bj * HALF + wc * 32;
      if (vcb >= 4992) continue;
      const int vc0 = vcb & ~63, inh = vcb & 63;
      bf16* dbase; size_t dstride; bool roped = false; bool headmajor = false; int hh = 0, nh = 1;
      if (vc0 < 768) { dbase = (bf16*)(ws + OFF_PROJ) + vc0; dstride = PC; }
      else if (vc0 < 1280) {
        const int seg = (vc0 - 768) >> 7;
        const size_t off = (seg == 0) ? OFF_KSB : (seg == 1) ? OFF_VSB : (seg == 2) ? OFF_KWB : OFF_VWB;
        dbase = (bf16*)(ws + off); dstride = 64; headmajor = true; hh = ((vc0 - 768) >> 6) & 1; nh = 2;
        roped = (seg == 0) || (seg == 2);
      } else if (vc0 < 1792) { dbase = (bf16*)(ws + OFF_PROJ) + C_MQ + (vc0 - 1280); dstride = PC; roped = true; }
      else if (vc0 < 2816) {
        const int seg = (vc0 - 1792) >> 9;
        dbase = (bf16*)(ws + (seg ? OFF_MVB : OFF_MKB)); dstride = 64; headmajor = true; hh = ((vc0 - 1792) >> 6) & 7; nh = 8;
        roped = (seg == 0);
      } else if (vc0 < 4864) { dbase = (bf16*)(ws + OFF_PROJ) + C_GN + (vc0 - 2816); dstride = PC; }
      else { dbase = (bf16*)(ws + OFF_PROJ) + C_NG + (vc0 - 4864); dstride = PC; }
      const bool do_rope = roped && inh == 0;
#pragma unroll
      for (int ai = 0; ai < 2; ++ai)
#pragma unroll
        for (int m = 0; m < 4; ++m) {
          const int row = u.pm * BM + ai * HALF + wr * 64 + m * 16 + fr;
          const int t = row - b * S;
          const f32x4 v0 = acc[ai][bj][m][0], v1 = acc[ai][bj][m][1];
          float o[8] = {v0[0], v0[1], v0[2], v0[3], v1[0], v1[1], v1[2], v1[3]};
          if (do_rope) {
            float pv[8];
#pragma unroll
            for (int j = 0; j < 8; ++j) pv[j] = shx(o[j], 16);
            const f32x4 c0 = *(const f32x4*)(rope + (size_t)t * 16), c1 = *(const f32x4*)(rope + (size_t)t * 16 + 4);
            const f32x4 s0 = *(const f32x4*)(rope + (size_t)t * 16 + 8), s1 = *(const f32x4*)(rope + (size_t)t * 16 + 12);
            const float cs[8] = {c0[0], c0[1], c0[2], c0[3], c1[0], c1[1], c1[2], c1[3]};
            const float sn[8] = {s0[0], s0[1], s0[2], s0[3], s1[0], s1[1], s1[2], s1[3]};
            const float sg = (fq == 0) ? -1.f : 1.f;
#pragma unroll
            for (int j = 0; j < 8; ++j) o[j] = (fq < 2) ? (o[j] * cs[j] + sg * pv[j] * sn[j]) : o[j];
          }
          bf16* dp = headmajor ? (dbase + ((size_t)(b * nh + hh) * S + t) * 64 + inh + 8 * fq)
                               : (dbase + (size_t)row * dstride + inh + 8 * fq);
          u32x4_t w;
          w.x = cvt2(o[0], o[1]); w.y = cvt2(o[2], o[3]); w.z = cvt2(o[4], o[5]); w.w = cvt2(o[6], o[7]);
          *(u32x4_t*)dp = w;
        }
    }
  }
};
}

template <class F>
DEV void for_tiles_xcd(int MT, int NT, F f) {
  const int nb = vnb(), bid = vbid();
  if ((nb & 15) != 0) {
    for (int it = bid; it < MT * NT; it += nb) f(it / NT, it % NT);
    return;
  }
  const int xcd = (bid >> 1) & 7, slot = ((bid >> 4) << 1) | (bid & 1), nslot = nb >> 3;
  const int nj = (NT - xcd + 7) >> 3;
  for (int q = slot; q < MT * nj; q += nslot) f(q / nj, xcd + 8 * (q % nj));
}
constexpr int PH_PER_LAYER = 15;
enum { SP_NORM1 = 0, SP_INPROJ = 1, SP_COMPRESS = 2, SP_KMEAN = 3, SP_ATTN = 4, SP_MP0 = 5, SP_MM0 = 6, SP_MP1 = 7, SP_MM1 = 8,
       SP_MERGE = 9, SP_OUTPROJ = 10, SP_NORM2 = 11, SP_PEERQ = 12, SP_TOPK = 13, SP_EXPERT = 14 };
constexpr int N_REAL_PHASES = 1 + 2 * PH_PER_LAYER + 1;
constexpr int N_PHASES = N_REAL_PHASES + (PROBE_ANY ? 2 : 0);

DEV void run_phase(const Params& p, int ph, char* smem_raw, bool second_pass = false) {
#define SKIP_MOBA_SECOND (REP_NSA_ONLY && second_pass)
  LAS unsigned char* lds_all = (LAS unsigned char*)smem_raw;
  smem_raw += hidx() * SMEM_BYTES;
  float* smf = (float*)smem_raw;
  bf16* smh = (bf16*)smem_raw;
  const int nb = vnb(), bid = vbid();
  if (ph == 0) {
    for (int it = bid; it < PREP_ITEMS; it += nb) prep_item(p, it, smf);
    return;
  }
  if (ph == N_REAL_PHASES - 1) {
    for (int it = bid; it < T / 4; it += nb) final_norm_item(p.out, p.g_final, it);
    return;
  }
#if PROBE_ANY
  if (ph == N_REAL_PHASES) {
#if PROBE_PROJ
    {
      const unsigned char* Hh = (const unsigned char*)(p.ws + OFF_H8);
      const unsigned char* Wt = (const unsigned char*)(p.ws + OFF_WINT) + (size_t)1 * WN * 1024;
      const unsigned char* hsc = (const unsigned char*)(p.ws + OFF_H8S);
      const unsigned char* wsc = (const unsigned char*)(p.ws + OFF_WCS) + WN;
      const float* rope = (const float*)(p.ws + OFF_ROPE);
      float sd = 0.f, sr = 0.f;
      for (size_t i = (size_t)bid * 256 + tidx(); i < (size_t)(T / 64) * 4888; i += (size_t)nb * 256) {
        const int ts = (int)(i / 4888), vc = (int)(i % 4888);
        const int tok = ts * 64 + (ts % 61);
        const int b = tok / S, t = tok % S;
        auto rawdot = [&](int col) {
          float a = 0.f;
          for (int k = 0; k < 1024; ++k) {
            const f32x2_t hv = __builtin_amdgcn_cvt_pk_f32_fp8((int)Hh[(size_t)tok * 1024 + k], false);
            const f32x2_t wv = __builtin_amdgcn_cvt_pk_f32_fp8((int)Wt[(size_t)col * 1024 + k], false);
            a += hv.x * wv.x;
          }
          return a * __int_as_float((int)hsc[tok] << 23) * __int_as_float((int)wsc[col] << 23);
        };
        float v = rawdot(vc);
        bool roped = false;
        const bf16* dst;
        if (vc < 768) dst = (const bf16*)(p.ws + OFF_PROJ) + (size_t)tok * PC + vc;
        else if (vc < 1280) {
          const int seg = (vc - 768) >> 7, head = ((vc - 768) >> 6) & 1, d = vc & 63;
          const size_t off = (seg == 0) ? OFF_KSB : (seg == 1) ? OFF_VSB : (seg == 2) ? OFF_KWB : OFF_VWB;
          dst = (const bf16*)(p.ws + off) + ((size_t)(b * 2 + head) * S + t) * 64 + d;
          roped = (seg == 0 || seg == 2);
        } else if (vc < 1792) { dst = (const bf16*)(p.ws + OFF_PROJ) + (size_t)tok * PC + C_MQ + (vc - 1280); roped = true; }
        else if (vc < 2816) {
          const int seg = (vc - 1792) >> 9, head = ((vc - 1792) >> 6) & 7, d = vc & 63;
          dst = (const bf16*)(p.ws + (seg ? OFF_MVB : OFF_MKB)) + ((size_t)(b * 8 + head) * S + t) * 64 + d;
          roped = (seg == 0);
        } else if (vc < 4864) dst = (const bf16*)(p.ws + OFF_PROJ) + (size_t)tok * PC + C_GN + (vc - 2816);
        else dst = (const bf16*)(p.ws + OFF_PROJ) + (size_t)tok * PC + C_NG + (vc - 4864);
        const int d = vc & 63;
        if (roped && d < 16) {
          const float cs = rope[(size_t)t * 16 + (d & 7)], sn = rope[(size_t)t * 16 + 8 + (d & 7)];
          if (d < 8) { const float x2 = rawdot(vc + 8); v = v * cs - x2 * sn; }
          else { const float x1 = rawdot(vc - 8); v = v * cs + x1 * sn; }
        }
        const float got = bf2f(*dst);
        const bool is_r = roped && d < 16;
        if (PROBE_PROJ == 1 || (PROBE_PROJ == 2 && is_r) || (PROBE_PROJ == 3 && !is_r)) {
          sd += (got - v) * (got - v);
          sr += v * v;
        }
      }
      sd = wave_sum(sd); sr = wave_sum(sr);
      if ((tidx() & 63) == 0) {
        atomicAdd((float*)(p.ws + OFF_PROBE), sd);
        atomicAdd((float*)(p.ws + OFF_PROBE) + 1, sr);
      }
    }
#endif
#if PROBE_CMPR
    {
      float sd = 0.f, sr = 0.f;
      for (size_t i = (size_t)bid * 256 + tidx(); i < (size_t)2 * Bn * 1024 * 128; i += (size_t)nb * 256) {
        const size_t wh = i / ((size_t)Bn * 1024 * 128), r = i % ((size_t)Bn * 1024 * 128);
        const int c = (int)((r / 128) % 1024);
        if (c < 1023) {
          const float a = ((const float*)(p.ws + (wh ? OFF_VCC : OFF_KCC)))[r];
          const float y = ((const float*)(p.ws + OFF_CMP))[i];
          sd += (a - y) * (a - y);
          sr += y * y;
        }
      }
      sd = wave_sum(sd); sr = wave_sum(sr);
      if ((tidx() & 63) == 0) {
        atomicAdd((float*)(p.ws + OFF_PROBE), sd);
        atomicAdd((float*)(p.ws + OFF_PROBE) + 1, sr);
      }
    }
#endif
#if PROBE_MOBA
    probe_accum_bf16(p, (const bf16*)(p.ws + OFF_OMOBA), (const bf16*)(p.ws + OFF_CMP), (size_t)S * 512, smf);
#endif
#if PROBE_NSA == 8
    {
      const float* impn = (const float*)(p.ws + OFF_OMOBA);
      const float* impm = impn + (size_t)S * 256;
      const int* seld = (const int*)(p.ws + OFF_CMP);
      float sd = 0.f, sr = 0.f, bad = 0.f;
      for (int t = bid * 256 + tidx(); t < S; t += nb * 256) {
        const int cur = t >> 6;
        for (int n = 0; n < 256; ++n) {
          float a = impm[(size_t)t * 256 + n], r = impn[(size_t)t * 256 + n];
          sd += (a - r) * (a - r);
          sr += r * r;
        }
        unsigned want[8] = {0, 0, 0, 0, 0, 0, 0, 0}, got[8] = {0, 0, 0, 0, 0, 0, 0, 0};
        for (int j = 0; j < 16; ++j) {
          int v = seld[(size_t)t * 16 + j];
          if (v >= 0 && v < 256) {
            for (int w = 0; w < 8; ++w) if ((v >> 5) == w) got[w] |= 1u << (v & 31);
          }
        }
        if (cur < 16) {
          for (int n = 0; n <= cur; ++n) want[0] |= 1u << n;
        } else {
          want[0] |= 1u;
          for (int w = 0; w < 8; ++w) {
            if (((cur - 1) >> 5) == w) want[w] |= 1u << ((cur - 1) & 31);
            if ((cur >> 5) == w) want[w] |= 1u << (cur & 31);
          }
          for (int j = 0; j < 13; ++j) {
            float best = -1.f;
            int bi = 1;
            for (int n = 1; n <= cur - 2; ++n) {
              bool taken = false;
              for (int w = 0; w < 8; ++w) if ((n >> 5) == w) taken = (want[w] >> (n & 31)) & 1u;
              float v = impm[(size_t)t * 256 + n];
              if (!taken && v > best) { best = v; bi = n; }
            }
            for (int w = 0; w < 8; ++w) if ((bi >> 5) == w) want[w] |= 1u << (bi & 31);
          }
        }
        bool same = true;
        for (int w = 0; w < 8; ++w) same = same && (want[w] == got[w]);
        if (!same) bad += 1.f;
      }
      sd = wave_sum(sd); sr = wave_sum(sr); bad = wave_sum(bad);
      if ((tidx() & 63) == 0) {
        atomicAdd((float*)(p.ws + OFF_PROBE), sd);
        atomicAdd((float*)(p.ws + OFF_PROBE) + 1, sr);
        atomicAdd((float*)(p.ws + OFF_PROBE) + 2, bad);
      }
    }
#elif PROBE_NSA
    probe_accum_bf16(p, (const bf16*)(p.ws + OFF_ONSA), (const bf16*)(p.ws + OFF_CMP), (size_t)S * 512, smf);
#endif
    return;
  }
  if (ph == N_REAL_PHASES + 1) {
    probe_apply(p);
    return;
  }
#endif
  const int layer = (ph - 1) / PH_PER_LAYER, sub = (ph - 1) % PH_PER_LAYER;
  const float* mod = (const float*)(p.ws + OFF_MOD) + (size_t)layer * 2 * 6144;
  const float* xin = (layer == 0) ? p.x : p.out;
  bf16* H = (bf16*)(p.ws + OFF_H);
  bf16* PROJ = (bf16*)(p.ws + OFF_PROJ);
#if PROBE_ANY
  if (sub >= SP_MERGE) {
    if (sub == SP_OUTPROJ && layer == 0)
      for (size_t i = (size_t)bid * 256 + tidx(); i < (size_t)T * 1024; i += (size_t)nb * 256) p.out[i] = p.x[i];
    return;
  }
#endif
  switch (sub) {
    case SP_NORM1:
      for (int it = bid; it < T / 4; it += nb)
        norm8_item(xin, p.g_attn + layer * 1024, mod + 1024, mod + 0, (unsigned char*)(p.ws + OFF_H8), (unsigned char*)(p.ws + OFF_H8S), it);
      if (layer == 0)
        for (int it = bid; it < WQ8_ITEMS; it += nb) wq8_item(p, it, smf);
      break;
    case SP_INPROJ: {
      g8::StaticOrder so;
      so.init(T, WN, (int)gridDim.x, (int)blockIdx.x);
      g8::gemm_phase<g8::EpiInproj, true>(lds_all, g8::Gemm{(const bf16*)(p.ws + OFF_H8), (const bf16*)(p.ws + OFF_WINT + (size_t)layer * WN * 1024), T, WN, 512,
                                                             (const unsigned char*)(p.ws + OFF_H8S), (const unsigned char*)(p.ws + OFF_WCS) + (size_t)layer * WN},
                                          so, g8::EpiInproj{p.ws});
    } break;
    case SP_COMPRESS:
      for (int it = bid; it < 512 + 1024 + 256; it += nb) {
        if (it < 512) compress_mfma_item(p, layer, it, smem_raw);
        else if (it < 1536) kmean_item(p, it - 512, smf);
        else kvamax_item(p, layer, it - 1536);
      }
#if PROBE_CMPR
      if (layer == 1)
        for (int it = bid; it < 1024; it += nb) compress_item(p, layer, it, smf);
#endif
      break;
    case SP_KMEAN:
      for (int it = bid; it < 1024; it += nb) kvq_item(p, layer, it, smf);
#if PROBE_NSA
      if (layer == 1)
        for (int it = bid; it < 512; it += nb) n1_item(p, layer, it, smf);
#endif
      break;
    case SP_ATTN:
      {
        constexpr int MNI = 2;
        constexpr int NMOBA = 16 * (S / (64 * MNI));
        constexpr int NNI = 2;
        constexpr int NNSA = 4 * (S / (16 * NNI));
        const bool do_nsa = !PROBE_ANY || PROBE_NSA, do_moba = (!PROBE_ANY || PROBE_MOBA) && PROBE_NSA != 8;
        {
          constexpr int NCH = S / (16 * NNI);
          const bool affine = nb >= 8;
          const int grp = bid & 7, bk = grp & 3, sub = grp >> 2;
          const int i0 = affine ? (bid >> 3) : bid;
          const int istride = affine ? ((nb - grp + 7) >> 3) : nb;
          const int icount = affine ? (NCH / 2) : NNSA;
          if (do_nsa) {
            const bool snake = affine && (nb & 7) == 0 && (icount % (2 * istride)) == 0;
            int k = 0;
            for (int i = i0; i < icount; i += istride, ++k) {
              const int ii = snake ? ((k & 1) ? ((k + 1) * istride - 1 - i0) : (k * istride + i0)) : i;
              nsa_item<NNI>(p, layer, affine ? (((2 * ii + sub) << 2) | bk) : ii, smem_raw, (bf16*)(p.ws + OFF_ONSA));
            }
          }
          if (do_moba && !SKIP_MOBA_SECOND)
          {
            const int ngi = (NMOBA - (bid & ~1) + nb - 1) / nb;
            for (int j0 = 0; j0 < ngi; j0 += 4) {
              const int first = bid + j0 * nb;
              int nit = ngi - j0 < 4 ? ngi - j0 : 4;
              while (nit > 0 && first + (nit - 1) * nb >= NMOBA) --nit;
              moba_gate_batch<MNI>(p, first, nb, nit, (int*)smf);
            }
          }
        }
#if PROBE_NSA && PROBE_NSA != 8
        if (layer == 1)
          for (int it = bid; it < 512; it += nb) n23_item(p, layer, it);
#endif
#if PROBE_MOBA
        if (layer == 1) {
          for (int it = bid; it < 512; it += nb) moba_item(p, layer, it);
        }
#endif
      }
      break;
    case SP_MP0:
    case SP_MP1:
      if ((!PROBE_ANY || PROBE_MOBA) && PROBE_NSA != 8)
        {
          constexpr int NIT = 8 * 63 * MOBA_NPART;
          int k = 0;
          for (int it = bid; it < ((NIT + nb - 1) / nb) * nb; it += nb, ++k) {
            const int ii = (k & 1) ? ((k + 1) * nb - 1 - bid) : it;
            if (ii < NIT) moba_part_item2<2>(p, sub == SP_MP1 ? 1 : 0, ii, smem_raw);
          }
        }
      break;
    case SP_MM0:
    case SP_MM1:
      if ((!PROBE_ANY || PROBE_MOBA) && PROBE_NSA != 8)
        for (int it = bid; it < 8 * (S / 128); it += nb)
          moba_merge_item<2>(p, sub == SP_MM1 ? 1 : 0, it, smem_raw, (bf16*)(p.ws + OFF_OMOBA));
      break;
    case SP_MERGE:
      {
        g8::StaticOrder so;
        so.init(T, 1024, (int)gridDim.x, (int)blockIdx.x);
        g8::gemm_phase(lds_all, g8::Gemm{(const bf16*)(p.ws + OFF_ONSA), (const bf16*)(p.ws + OFF_WUPN) + (size_t)layer * 1024 * 512, T, 1024, 512}, so,
                       g8::EpiMerge<false>{H, PROJ, C_GN});
        g8::gemm_phase(lds_all, g8::Gemm{(const bf16*)(p.ws + OFF_OMOBA), (const bf16*)(p.ws + OFF_WUPM) + (size_t)layer * 1024 * 512, T, 1024, 512}, so,
                       g8::EpiMerge<true>{H, PROJ, C_GM});
      }
      break;
    case SP_OUTPROJ: {
      const bf16* W = (const bf16*)(p.ws + OFF_WOUT) + (size_t)layer * 1024 * 1024;
      const float* ga1 = mod + 2048;
      g8::StaticOrder so;
      so.init(T, 1024, (int)gridDim.x, (int)blockIdx.x);
      g8::gemm_phase(lds_all, g8::Gemm{H, W, T, 1024, 1024}, so, g8::EpiResid{xin, p.out, ga1});
    } break;
    case SP_NORM2:
      for (int it = bid; it < T / 4 + NEXP / 4; it += nb) {
        if (it < T / 4) norm_item(p.out, p.g_ffn + layer * 1024, mod + 4096, mod + 3072, H, it);
        else expert_cvt_item(p, layer, it - T / 4);
      }
      break;
    case SP_PEERQ: {
      const bf16* W = (const bf16*)(p.ws + OFF_WQ) + (size_t)layer * 2048 * 1024;
      bf16* QP = (bf16*)(p.ws + OFF_QP);
      g8::StaticOrder so;
      so.init(T, 2048, (int)gridDim.x, (int)blockIdx.x);
      g8::gemm_phase(lds_all, g8::Gemm{H, W, T, 2048, 1024}, so, g8::EpiBf16{QP, 2048});
    } break;
    case SP_TOPK:
#if REP_MASK
      for (int it = bid; it < T / 8; it += nb) peer_topk_item3(p, layer, it);
#endif
      break;
    case SP_EXPERT:
#if REP_MASK
      for (int it = bid; it < T / 4; it += nb) peer_expert_item2(p, layer, it, second_pass ? 0.f : 1.f);
#else
      for (int it = bid; it < T / 8; it += nb) peer_fused_item(p, layer, it, smem_raw);
#endif
      break;
  }
}

#define MEGA_LB __launch_bounds__(512, 2)
__global__ void MEGA_LB mega_kernel(Params p, int ph_lo, int ph_hi) {
  __shared__ __attribute__((aligned(16))) char smem_raw[2 * SMEM_BYTES + 16];
  volatile LAS unsigned* xbst = (volatile LAS unsigned*)(smem_raw + 2 * SMEM_BYTES);
  if (threadIdx.x == 0) { xbst[0] = 0u; xbst[1] = 0u; xbst[2] = 0u; xbst[3] = 0u; }
  __syncthreads();
  XcdBarrier xb = xcd_barrier_post((unsigned*)(p.ws + OFF_BAR), xbst);
  for (int ph = ph_lo; ph < ph_hi; ++ph) {
#if !PROBE_ANY && !REP_MASK
    if (ph == N_REAL_PHASES - 1 || ph == 1 + PH_PER_LAYER || (ph >= 1 && (ph - 1) % PH_PER_LAYER == SP_TOPK))
      continue;
#endif
#if REP_MASK
    const int nrep = (ph >= 1 && ph < N_REAL_PHASES - 1 && ((REP_MASK >> ((ph - 1) % PH_PER_LAYER)) & 1)) ? 2 : 1;
    for (int rep = 0; rep < nrep; ++rep) {
      if (rep) xcd_barrier(xb);
      run_phase(p, ph, smem_raw, rep != 0);
    }
#else
    run_phase(p, ph, smem_raw);
#endif
    if (ph + 1 < ph_hi) {
      if (ph == ph_lo) cg::this_grid().sync();
      else xcd_barrier(xb);
    }
  }
}

extern "C" void kernel_launch(void* const* d_in, const int* in_sizes, int n_in, void* d_out, int out_size, void* d_ws,
                              size_t ws_size, hipStream_t stream) {
  if (ws_size < WS_TOTAL) {
    fprintf(stderr, "workspace too small: %zu < %zu\n", ws_size, (size_t)WS_NEED);
    return;
  }
  Params p{};
  p.x = (const float*)d_in[0]; p.c = (const float*)d_in[1]; p.w_ada = (const float*)d_in[2];
  p.b_ada = (const float*)d_in[3]; p.g_attn = (const float*)d_in[4]; p.g_ffn = (const float*)d_in[5];
  p.w_in = (const float*)d_in[6]; p.cmp_pe = (const float*)d_in[7]; p.cmp_w1 = (const float*)d_in[8];
  p.cmp_w2 = (const float*)d_in[9]; p.w_up_nsa = (const float*)d_in[10]; p.w_up_moba = (const float*)d_in[11];
  p.w_out = (const float*)d_in[12]; p.peer_wq = (const float*)d_in[13]; p.peer_k1 = (const float*)d_in[14];
  p.peer_k2 = (const float*)d_in[15]; p.peer_u = (const float*)d_in[16]; p.peer_v = (const float*)d_in[17];
  p.g_final = (const float*)d_in[18];
  p.out = (float*)d_out;
  p.ws = (char*)d_ws;
  static int grid_blocks = 0;
  if (!grid_blocks) {
    int dev = 0, cus = 0, per_cu = 0;
    hipGetDevice(&dev);
    hipDeviceGetAttribute(&cus, hipDeviceAttributeMultiprocessorCount, dev);
    hipOccupancyMaxActiveBlocksPerMultiprocessor(&per_cu, mega_kernel, 512, 0);
    if (per_cu < 1) per_cu = 1;
    if (per_cu > 1) per_cu = 1;
    grid_blocks = cus * per_cu;
  }
  hipMemsetAsync((char*)d_ws + OFF_BAR, 0, BAR_BYTES, stream);
  int ph_lo = 0, ph_hi = N_PHASES;
  void* args[] = {(void*)&p, (void*)&ph_lo, (void*)&ph_hi};
  hipError_t e = hipLaunchCooperativeKernel((const void*)mega_kernel, dim3(grid_blocks), dim3(512), args, 0, stream);
  if (e != hipSuccess) fprintf(stderr, "cooperative launch failed: %s (grid %d)\n", hipGetErrorString(e), grid_blocks);
}
```

```cpp
#define WGM_INPROJ 4
#define WGM_N1024 4
#define WGM_N2048 4
#include <hip/hip_runtime.h>
#include <hip/hip_bf16.h>
#include <hip/hip_cooperative_groups.h>
#include <cstdio>
#include <cstdint>
namespace cg = cooperative_groups;

#define DEV __device__ __forceinline__
typedef unsigned short bf16;
using bf16x8 = __attribute__((ext_vector_type(8))) short;
using f32x4 = __attribute__((ext_vector_type(4))) float;

constexpr int Bn = 2, S = 16384, T = Bn * S, D = 1024;
constexpr int PC = 3456;
constexpr int WN = 5120;
constexpr int C_NQ = 0, C_KC = 512, C_VC = 640, C_MQ = 768, C_GN = 1280, C_GM = 2304, C_NG = 3328;
constexpr int NEXP = 16384;

constexpr size_t al(size_t x) { return (x + 255) & ~size_t(255); }
constexpr size_t OFF_MOD = 0;
constexpr size_t OFF_ROPE = al(OFF_MOD + 2 * 2 * 6144 * 4);
constexpr size_t OFF_PEB = al(OFF_ROPE + (size_t)S * 16 * 4);
constexpr size_t OFF_WINT = al(OFF_PEB + 2 * 2 * 128 * 4);
constexpr size_t OFF_WUPN = al(OFF_WINT + 2ull * WN * 1024 * 2);
constexpr size_t OFF_WUPM = al(OFF_WUPN + 2ull * 1024 * 512 * 2);
constexpr size_t OFF_WOUT = al(OFF_WUPM + 2ull * 1024 * 512 * 2);
constexpr size_t OFF_WQ = al(OFF_WOUT + 2ull * 1024 * 1024 * 2);
constexpr size_t OFF_KCC = al(OFF_WQ + 2ull * 2048 * 1024 * 2);
constexpr size_t OFF_VCC = al(OFF_KCC + 2ull * 1024 * 128 * 4);
constexpr size_t OFF_SEL = al(OFF_VCC + 2ull * 1024 * 128 * 4);
constexpr size_t OFF_KMEAN = al(OFF_SEL + 2ull * 2 * S * 16 * 4);
constexpr size_t OFF_KMHL = al(OFF_KMEAN + 2ull * 8 * 64 * 64 * 4);
constexpr size_t OFF_KCB = al(OFF_KMHL + 2ull * 2 * 8 * 64 * 64 * 2);
constexpr size_t OFF_VCB = al(OFF_KCB + 2ull * 2 * 1024 * 64 * 2);
constexpr size_t OFF_PKB = al(OFF_VCB + 2ull * 2 * 1024 * 64 * 2);
constexpr size_t OFF_W1T = al(OFF_PKB + 2ull * 2 * 128 * 128 * 2);
constexpr size_t OFF_BAR = al(OFF_W1T + 4ull * 128 * 2048 * 2);
constexpr size_t BAR_BYTES = 3456 * 4;
constexpr size_t OFF_PROBE = al(OFF_BAR + BAR_BYTES);
constexpr size_t OFF_H = al(OFF_PROBE + 256);
constexpr size_t OFF_WCS = OFF_WINT + 2ull * WN * 1024;
constexpr size_t OFF_ONSA = al(OFF_H + (size_t)T * 1024 * 2);
constexpr size_t OFF_OMOBA = al(OFF_ONSA + (size_t)T * 512 * 2);
constexpr size_t OFF_H8 = OFF_ONSA;
constexpr size_t OFF_H8S = OFF_OMOBA;
constexpr size_t OFF_PROJ = al(OFF_OMOBA + (size_t)T * 512 * 2);
constexpr size_t KV2_BYTES = (size_t)Bn * 2 * S * 64 * 2, KV8_BYTES = (size_t)Bn * 8 * S * 64 * 2;
constexpr size_t OFF_KSB = al(OFF_PROJ + (size_t)T * PC * 2);
constexpr size_t OFF_VSB = OFF_KSB + KV2_BYTES;
constexpr size_t OFF_KWB = OFF_VSB + KV2_BYTES;
constexpr size_t OFF_VWB = OFF_KWB + KV2_BYTES;
constexpr size_t OFF_MKB = OFF_VWB + KV2_BYTES;
constexpr size_t OFF_MVB = OFF_MKB + KV8_BYTES;
constexpr int MLIST_PER_BH = 63 * S - 128 * 63 * 64;
constexpr size_t OFF_MLIST = OFF_MVB + KV8_BYTES;
constexpr int MCNT_STRIDE = 32;
constexpr size_t OFF_MCNT = al(OFF_MLIST + (size_t)Bn * 8 * MLIST_PER_BH * 2);
constexpr size_t OFF_KS8 = al(OFF_MCNT + (size_t)Bn * 8 * 64 * 4 * MCNT_STRIDE);
constexpr size_t OFF_VT8 = OFF_KS8 + (size_t)Bn * 2 * S * 64;
constexpr size_t WS_NEED = OFF_VT8 + (size_t)Bn * 2 * S * 64;
constexpr size_t PROJ_BYTES = (size_t)T * PC * 2;
constexpr size_t OFF_MPO = OFF_H;
constexpr size_t OFF_MPML = OFF_H + (size_t)8 * S * 3 * 64 * 2;
static_assert((size_t)8 * S * 3 * 64 * 2 + (size_t)8 * S * 3 * 8 <= (size_t)T * 1024 * 2, "moba partials must fit the H region");
constexpr size_t OFF_QP = OFF_PROJ;
constexpr size_t OFF_PEIDX = al(OFF_QP + (size_t)T * 2048 * 2);
constexpr size_t OFF_PEG = al(OFF_PEIDX + (size_t)T * 128 * 4);
constexpr size_t OFF_E8 = al(OFF_PEG + (size_t)T * 128 * 4);
constexpr size_t OFF_ESC = al(OFF_E8 + (size_t)NEXP * 2048);
static_assert(OFF_ESC + (size_t)NEXP * 2 * 4 <= OFF_PROJ + PROJ_BYTES, "peer alias overflow");
static_assert(WS_NEED <= 536870912ull, "workspace too big");
#ifndef PROBE_MOBA
#define PROBE_MOBA 0
#endif
constexpr size_t OFF_CMP = PROBE_MOBA ? OFF_ONSA : OFF_MLIST;
#ifndef WGM_INPROJ
#define WGM_INPROJ 4
#endif
#ifndef WGM_N1024
#define WGM_N1024 8
#endif
#ifndef WGM_N2048
#define WGM_N2048 8
#endif
#ifndef MOBA_NPART
#define MOBA_NPART 4
#endif
#ifndef REP_NSA_ONLY
#define REP_NSA_ONLY 0
#endif
#ifndef REP_NSA_PART
#define REP_NSA_PART 0
#endif
#ifndef REP_MASK
#define REP_MASK 0
#endif
#ifndef PROBE_MOBA
#define PROBE_MOBA 0
#endif
#ifndef PROBE_NSA
#define PROBE_NSA 0
#endif
#ifndef PROBE_CMPR
#define PROBE_CMPR 0
#endif
#ifndef PROBE_PROJ
#define PROBE_PROJ 0
#endif
#define PROBE_ANY (PROBE_MOBA || PROBE_NSA || PROBE_CMPR || PROBE_PROJ)
constexpr size_t WS_TOTAL = WS_NEED;
static_assert(WS_TOTAL <= 536870912ull, "workspace too big (probe)");

struct Params {
  const float *x, *c, *w_ada, *b_ada, *g_attn, *g_ffn, *w_in, *cmp_pe, *cmp_w1, *cmp_w2, *w_up_nsa, *w_up_moba, *w_out,
      *peer_wq, *peer_k1, *peer_k2, *peer_u, *peer_v, *g_final;
  float* out;
  char* ws;
};

constexpr int SMEM_BYTES = 74 * 1024;

DEV int tidx() {
  int t = threadIdx.x & 255;
  asm volatile("" : "+v"(t));
  return t;
}
DEV int hidx() { return __builtin_amdgcn_readfirstlane((int)(threadIdx.x >> 8)); }
DEV int vbid() { return (int)blockIdx.x * 2 + hidx(); }
DEV int vnb() { return (int)gridDim.x * 2; }
#define MFMA16B(a, b, c) __builtin_amdgcn_mfma_f32_16x16x32_bf16(a, b, c, 0, 0, 0)
DEV unsigned cvtpk_(float lo, float hi) {
  unsigned r;
  asm("v_cvt_pk_bf16_f32 %0, %1, %2" : "=v"(r) : "v"(lo), "v"(hi));
  return r;
}
DEV float bf2f(bf16 h) { return __uint_as_float(((unsigned)h) << 16); }
DEV bf16 f2bf(float f) {
  unsigned u = __float_as_uint(f);
  u += 0x7fffu + ((u >> 16) & 1u);
  return (bf16)(u >> 16);
}
DEV float gelu_tanh(float x) {
  float u = 0.7978845608028654f * (x + 0.044715f * x * x * x);
  return 0.5f * x * (1.f + tanhf(u));
}
DEV float sigmoidf_(float x) { return 1.f / (1.f + expf(-x)); }
DEV void unpack8(uint4 v, float* f) {
  f[0] = __uint_as_float(v.x << 16); f[1] = __uint_as_float(v.x & 0xffff0000u);
  f[2] = __uint_as_float(v.y << 16); f[3] = __uint_as_float(v.y & 0xffff0000u);
  f[4] = __uint_as_float(v.z << 16); f[5] = __uint_as_float(v.z & 0xffff0000u);
  f[6] = __uint_as_float(v.w << 16); f[7] = __uint_as_float(v.w & 0xffff0000u);
}
DEV float dot64_bf(const float* q, const bf16* row) {
  float s = 0.f;
#pragma unroll
  for (int i = 0; i < 8; ++i) {
    float f[8];
    unpack8(*(const uint4*)(row + i * 8), f);
#pragma unroll
    for (int j = 0; j < 8; ++j) s += q[i * 8 + j] * f[j];
  }
  return s;
}
DEV void axpy64_bf(float* o, float a, const bf16* row) {
#pragma unroll
  for (int i = 0; i < 8; ++i) {
    float f[8];
    unpack8(*(const uint4*)(row + i * 8), f);
#pragma unroll
    for (int j = 0; j < 8; ++j) o[i * 8 + j] += a * f[j];
  }
}
DEV float dot64_f(const float* q, const float* row) {
  float s = 0.f;
#pragma unroll
  for (int i = 0; i < 16; ++i) {
    float4 v = *(const float4*)(row + i * 4);
    s += q[i * 4] * v.x + q[i * 4 + 1] * v.y + q[i * 4 + 2] * v.z + q[i * 4 + 3] * v.w;
  }
  return s;
}
DEV void axpy64_f(float* o, float a, const float* row) {
#pragma unroll
  for (int i = 0; i < 16; ++i) {
    float4 v = *(const float4*)(row + i * 4);
    o[i * 4] += a * v.x; o[i * 4 + 1] += a * v.y; o[i * 4 + 2] += a * v.z; o[i * 4 + 3] += a * v.w;
  }
}
DEV void load_q64(float* q, const bf16* p, float scale) {
#pragma unroll
  for (int i = 0; i < 8; ++i) unpack8(*(const uint4*)(p + i * 8), q + i * 8);
#pragma unroll
  for (int i = 0; i < 64; ++i) q[i] *= scale;
}
DEV int lane_id_() { return __builtin_amdgcn_mbcnt_hi(~0u, __builtin_amdgcn_mbcnt_lo(~0u, 0u)); }
DEV int shx(int v, int m) {
  if (m == 1) return __builtin_amdgcn_update_dpp(0, v, 0xB1, 0xF, 0xF, true);
  if (m == 2) return __builtin_amdgcn_update_dpp(0, v, 0x4E, 0xF, 0xF, true);
  if (m == 4) return __builtin_amdgcn_ds_swizzle(v, 0x101F);
  if (m == 8) return __builtin_amdgcn_update_dpp(0, v, 0x128, 0xF, 0xF, true);
  if (m == 16) return __builtin_amdgcn_ds_swizzle(v, 0x401F);
  auto rr = __builtin_amdgcn_permlane32_swap((unsigned)v, (unsigned)v, false, false);
  return (lane_id_() < 32) ? (int)rr[1] : (int)rr[0];
}
DEV unsigned shx(unsigned v, int m) { return (unsigned)shx((int)v, m); }
DEV float shx(float v, int m) { return __int_as_float(shx(__float_as_int(v), m)); }
DEV float wave_sum(float v) {
#pragma unroll
  for (int o = 32; o >= 1; o >>= 1) v += shx(v, o);
  return v;
}

#define XB_TMO      128
#define XB_XCNT(j)  (256  + 64 * (j))
#define XB_XSUB(j)  (1280 + 64 * (j))
#define XB_XGEN(j)  (2304 + 64 * (j))
#define XB_TOP      3328
#define XB_TOPGEN   3392
#define XCD_BAR_WORDS 3456
#define XB_SPIN_CAP (1u << 18)
#define LAS __attribute__((address_space(3)))

__device__ __forceinline__ unsigned xb_ld(unsigned* p)              { return __hip_atomic_load(p, __ATOMIC_RELAXED, __HIP_MEMORY_SCOPE_AGENT); }
__device__ __forceinline__ unsigned xb_add(unsigned* p, unsigned v) { return __hip_atomic_fetch_add(p, v, __ATOMIC_RELAXED, __HIP_MEMORY_SCOPE_AGENT); }
__device__ __forceinline__ unsigned xb_xcc_id() { return (unsigned)__builtin_amdgcn_s_getreg((3 << 11) | 20) & 0xFu; }
#define XB_SPIN(cond, bar) do { unsigned _sp = 0; while (cond) { __builtin_amdgcn_s_sleep(1); \
    if ((++_sp & 255u) == 0u) { if (xb_ld(&(bar)[XB_TMO])) break; if (_sp > XB_SPIN_CAP) { atomicAdd(&(bar)[XB_TMO], 1u); break; } } } } while (0)

struct XcdBarrier {
    unsigned* bar; unsigned x;
    volatile LAS unsigned* st;
};

__device__ __forceinline__ XcdBarrier xcd_barrier_post(unsigned* bar, volatile LAS unsigned* st) {
    XcdBarrier b; b.bar = bar; b.x = xb_xcc_id(); b.st = st;
    if (threadIdx.x == 0) (void)xb_add(&bar[XB_XCNT(b.x)], 1u);
    return b;
}
__device__ __forceinline__ void xcd_barrier_complete(unsigned* bar, unsigned x, unsigned& nloc, unsigned& nx) {
    const unsigned G = gridDim.x * gridDim.y * gridDim.z;
    unsigned sum, cnt, mine, sp = 0u;
    for (;;) {
        sum = 0u; cnt = 0u; mine = 0u;
#pragma unroll
        for (unsigned j = 0; j < 16; ++j) { const unsigned c = xb_ld(&bar[XB_XCNT(j)]); sum += c; cnt += (c > 0u) ? 1u : 0u; mine = (j == x) ? c : mine; }
        if (sum == G) break;
        __builtin_amdgcn_s_sleep(1);
        if ((++sp & 255u) == 0u) { if (xb_ld(&bar[XB_TMO])) break; if (sp > XB_SPIN_CAP) { atomicAdd(&bar[XB_TMO], 1u); break; } }
    }
    nloc = mine > 0u ? mine : 1u; nx = cnt > 0u ? cnt : 1u;
}

__device__ __forceinline__ void xcd_barrier(const XcdBarrier& b) {
    asm volatile("s_waitcnt vmcnt(0)" ::: "memory");
    __syncthreads();
    if (threadIdx.x == 0) {
        unsigned* bar = b.bar;
        __builtin_amdgcn_s_waitcnt(0);
        unsigned nloc = b.st[0], nx = b.st[1];
        if (nloc == 0u) { xcd_barrier_complete(bar, b.x, nloc, nx); b.st[0] = nloc; b.st[1] = nx; }
        const unsigned old = xb_add(&bar[XB_XSUB(b.x)], 1u);
        const unsigned gen = old / nloc;
        if (old + 1u == (gen + 1u) * nloc) {
            __builtin_amdgcn_fence(__ATOMIC_RELEASE, "agent");
            asm volatile("s_waitcnt vmcnt(0)" ::: "memory");
            const unsigned og = xb_add(&bar[XB_TOP], 1u);
            const unsigned tg = og / nx;
            if (og + 1u == (tg + 1u) * nx) xb_add(&bar[XB_TOPGEN], 1u);
            else XB_SPIN(xb_ld(&bar[XB_TOPGEN]) == tg, bar);
            __builtin_amdgcn_fence(__ATOMIC_ACQUIRE, "agent");
            xb_add(&bar[XB_XGEN(b.x)], 1u);
            asm volatile("s_waitcnt vmcnt(0)" ::: "memory");
        } else {
            XB_SPIN(xb_ld(&bar[XB_XGEN(b.x)]) == gen, bar);
            __builtin_amdgcn_fence(__ATOMIC_ACQUIRE, "agent");
            asm volatile("s_waitcnt vmcnt(0)" ::: "memory");
        }
    }
    __syncthreads();
}


DEV int win_col_map(int j) {
  if (j < 1280) return j;
  if (j < 4864) return j + 24;
  if (j < 4888) return j - 4864 + 1280;
  return -1;
}
DEV void tr_tile(const float* __restrict__ src, int ldsrc, int K, bf16* __restrict__ dst, int kt, int nt, bool remap,
                 float* sm) {
  const int tid = tidx();
#pragma unroll 4
  for (int i = 0; i < 16; ++i) {
    int r = i * 4 + (tid >> 6), cx = tid & 63;
    int j = nt * 64 + cx, k = kt * 64 + r;
    int oc = remap ? win_col_map(j) : j;
    sm[r * 65 + cx] = (oc >= 0) ? src[(size_t)k * ldsrc + oc] : 0.f;
  }
  __syncthreads();
#pragma unroll 4
  for (int i = 0; i < 16; ++i) {
    int n = i * 4 + (tid >> 6), kk = tid & 63;
    dst[(size_t)(nt * 64 + n) * K + kt * 64 + kk] = f2bf(sm[kk * 65 + n]);
  }
  __syncthreads();
}

DEV unsigned e8m0_of(float amax) {
  const unsigned bits = (unsigned)__float_as_int(amax * (1.f / 224.f));
  unsigned e = ((bits >> 23) & 255u) + ((bits & 0x7fffffu) ? 1u : 0u);
  return e < 1u ? 1u : (e > 253u ? 253u : e);
}
DEV float e8m0_inv(unsigned e) { return __int_as_float((int)((254u - e) << 23)); }
DEV unsigned pack4_fp8_(float a, float b, float c, float d) {
  int q = __builtin_amdgcn_cvt_pk_fp8_f32(a, b, 0, false);
  q = __builtin_amdgcn_cvt_pk_fp8_f32(c, d, q, true);
  return (unsigned)q;
}
DEV void wamax_item(const Params& p, int item) {
  const int l = item >> 7, part = item & 127;
  const size_t per = (size_t)1024 * 4888 / 128;
  const float4* src = (const float4*)(p.w_in + (size_t)l * 1024 * 4888 + (size_t)part * per);
  float m = 0.f;
  for (int i = tidx(); i < (int)(per / 4); i += 256) {
    const float4 v = src[i];
    m = fmaxf(m, fmaxf(fmaxf(fabsf(v.x), fabsf(v.y)), fmaxf(fabsf(v.z), fabsf(v.w))));
  }
#pragma unroll
  for (int o = 32; o >= 1; o >>= 1) m = fmaxf(m, shx(m, o));
  if ((tidx() & 63) == 0) atomicMax((unsigned*)(p.ws + OFF_BAR) + l, (unsigned)__float_as_int(m));
}
DEV void wq8_item(const Params& p, int item, float* sm) {
  const int tid = tidx();
  const int l = item / (80 * 16), r_ = item % (80 * 16);
  const int nt = r_ / 16, kt = r_ % 16;
  const float* src = p.w_in + (size_t)l * 1024 * 4888;
  unsigned char* dst = (unsigned char*)(p.ws + OFF_WINT) + (size_t)l * WN * 1024;
  const unsigned e = e8m0_of(__int_as_float((int)__hip_atomic_load((const unsigned*)(p.ws + OFF_BAR) + l, __ATOMIC_RELAXED, __HIP_MEMORY_SCOPE_AGENT)));
  const float s = e8m0_inv(e);
#pragma unroll 4
  for (int i = 0; i < 16; ++i) {
    const int r = i * 4 + (tid >> 6), cx = tid & 63;
    const int oc = win_col_map(nt * 64 + cx);
    sm[r * 65 + cx] = (oc >= 0) ? src[(size_t)(kt * 64 + r) * 4888 + oc] : 0.f;
  }
  __syncthreads();
  const int kq = tid & 15;
#pragma unroll
  for (int i = 0; i < 4; ++i) {
    const int n = i * 16 + (tid >> 4);
    const float v0 = sm[(kq * 4 + 0) * 65 + n], v1 = sm[(kq * 4 + 1) * 65 + n], v2 = sm[(kq * 4 + 2) * 65 + n], v3 = sm[(kq * 4 + 3) * 65 + n];
    *(unsigned*)(dst + (size_t)(nt * 64 + n) * 1024 + kt * 64 + kq * 4) = pack4_fp8_(v0 * s, v1 * s, v2 * s, v3 * s);
  }
  if (kt == 0 && tid < 64) ((unsigned char*)(p.ws + OFF_WCS))[(size_t)l * WN + nt * 64 + tid] = (unsigned char)e;
  __syncthreads();
}
constexpr int WQ8_ITEMS = 2 * 80 * 16;
constexpr int PREP_TR_WIN = 2 * 128;
constexpr int PREP_TR_UPN = 2 * 16 * 8;
constexpr int PREP_TR_UPM = 2 * 16 * 8;
constexpr int PREP_TR_OUT = 2 * 16 * 16;
constexpr int PREP_TR_WQ = 2 * 32 * 16;
constexpr int PREP_ROPE = 512;
constexpr int PREP_MOD = 384;
constexpr int PREP_PEB = 16;
constexpr int PREP_PK = 32;
constexpr int PREP_TR_W1 = 4 * 2 * 32;
constexpr int PREP_ITEMS = PREP_TR_WIN + PREP_TR_UPN + PREP_TR_UPM + PREP_TR_OUT + PREP_TR_WQ + PREP_ROPE + PREP_MOD + PREP_PEB + PREP_PK + PREP_TR_W1;

DEV void prep_item(const Params& p, int item, float* sm) {
  const int tid = tidx();
  if (item < PREP_TR_WIN) {
    wamax_item(p, item);
    return;
  }
  item -= PREP_TR_WIN;
  if (item < PREP_TR_UPN) {
    int l = item / 128, r = item % 128;
    int nt = r / 8, kt = r % 8;
    tr_tile(p.w_up_nsa + (size_t)l * 512 * 1024, 1024, 512, (bf16*)(p.ws + OFF_WUPN) + (size_t)l * 1024 * 512, kt, nt, false, sm);
    return;
  }
  item -= PREP_TR_UPN;
  if (item < PREP_TR_UPM) {
    int l = item / 128, r = item % 128;
    int nt = r / 8, kt = r % 8;
    tr_tile(p.w_up_moba + (size_t)l * 512 * 1024, 1024, 512, (bf16*)(p.ws + OFF_WUPM) + (size_t)l * 1024 * 512, kt, nt, false, sm);
    return;
  }
  item -= PREP_TR_UPM;
  if (item < PREP_TR_OUT) {
    int l = item / 256, r = item % 256;
    int nt = r / 16, kt = r % 16;
    tr_tile(p.w_out + (size_t)l * 1024 * 1024, 1024, 1024, (bf16*)(p.ws + OFF_WOUT) + (size_t)l * 1024 * 1024, kt, nt, false, sm);
    return;
  }
  item -= PREP_TR_OUT;
  if (item < PREP_TR_WQ) {
    int l = item / 512, r = item % 512;
    int nt = r / 16, kt = r % 16;
    tr_tile(p.peer_wq + (size_t)l * 1024 * 2048, 2048, 1024, (bf16*)(p.ws + OFF_WQ) + (size_t)l * 2048 * 1024, kt, nt, false, sm);
    return;
  }
  item -= PREP_TR_WQ;
  if (item < PREP_ROPE) {
    int idx = item * 256 + tid;
    int pos = idx >> 3, i = idx & 7;
    float inv = powf(500000.0f, -(float)i / 8.0f);
    float ang = (float)pos * inv;
    float* rp = (float*)(p.ws + OFF_ROPE) + (size_t)pos * 16;
    rp[i] = cosf(ang);
    rp[8 + i] = sinf(ang);
    return;
  }
  item -= PREP_ROPE;
  if (item < PREP_MOD) {
    for (int i = tid; i < 2048; i += 256) {
      float cv = p.c[i];
      sm[i] = cv / (1.f + expf(-cv));
    }
    __syncthreads();
    const int l = item / 192, n0 = (item % 192) * 32;
    const int col = tid & 31, ks = tid >> 5;
    const float* w = p.w_ada + (size_t)l * 1024 * 6144 + n0 + col;
    float a0 = 0.f, a1 = 0.f;
#pragma unroll 8
    for (int k = ks * 128; k < ks * 128 + 128; ++k) {
      float wv = w[(size_t)k * 6144];
      a0 += sm[k] * wv;
      a1 += sm[1024 + k] * wv;
    }
    sm[2048 + tid * 2] = a0;
    sm[2048 + tid * 2 + 1] = a1;
    __syncthreads();
    if (tid < 64) {
      const int c2 = tid & 31, bs = tid >> 5;
      float s = 0.f;
#pragma unroll
      for (int q = 0; q < 8; ++q) s += sm[2048 + (q * 32 + c2) * 2 + bs];
      ((float*)(p.ws + OFF_MOD))[(l * 2 + bs) * 6144 + n0 + c2] = s + p.b_ada[l * 6144 + n0 + c2];
    }
    __syncthreads();
    return;
  }
  item -= PREP_MOD;
  if (item < PREP_PEB) {
    const int lw = item >> 2, j0 = (item & 3) * 32;
    const int col = tid & 31, ks = tid >> 5;
    const float* pe = p.cmp_pe + (size_t)lw * 2048;
    const float* w1 = p.cmp_w1 + (size_t)lw * 2048 * 128 + j0 + col;
    float a = 0.f;
#pragma unroll 8
    for (int i = ks * 256; i < ks * 256 + 256; ++i) a += pe[i] * w1[(size_t)i * 128];
    sm[tid] = a;
    __syncthreads();
    if (tid < 32) {
      float s = 0.f;
#pragma unroll
      for (int q = 0; q < 8; ++q) s += sm[q * 32 + tid];
      ((float*)(p.ws + OFF_PEB))[lw * 128 + j0 + tid] = s;
    }
    if (item == 0 && tid < 4) ((float*)(p.ws + OFF_PROBE))[tid] = 0.f;
    __syncthreads();
    return;
  }
  item -= PREP_PEB;
  if (item < PREP_PK) {
    const int e0 = item * 2048 + tid * 8;
    const int lt = e0 >> 14, off = e0 & 16383;
    const float* srcp = ((lt & 1) ? p.peer_k2 : p.peer_k1) + (size_t)(lt >> 1) * 16384 + off;
    const float4 a = *(const float4*)srcp, b4 = *(const float4*)(srcp + 4);
    uint4 pk;
    pk.x = (unsigned)f2bf(a.x) | ((unsigned)f2bf(a.y) << 16);
    pk.y = (unsigned)f2bf(a.z) | ((unsigned)f2bf(a.w) << 16);
    pk.z = (unsigned)f2bf(b4.x) | ((unsigned)f2bf(b4.y) << 16);
    pk.w = (unsigned)f2bf(b4.z) | ((unsigned)f2bf(b4.w) << 16);
    *(uint4*)((bf16*)(p.ws + OFF_PKB) + e0) = pk;
    return;
  }
  item -= PREP_PK;
  {
    const int lw = item >> 6, r = item & 63;
    const int nt = r >> 5, kt = r & 31;
    tr_tile(p.cmp_w1 + (size_t)lw * 2048 * 128, 128, 2048, (bf16*)(p.ws + OFF_W1T) + (size_t)lw * 128 * 2048, kt, nt, false, sm);
  }
}

DEV void norm_item(const float* __restrict__ xin, const float* __restrict__ g, const float* __restrict__ sc,
                   const float* __restrict__ sh, bf16* __restrict__ hout, int item) {
  const int lane = tidx() & 63, wave = tidx() >> 6;
  const size_t tok = (size_t)item * 4 + wave;
  const int b = (int)(tok / S);
  const float* xr = xin + tok * 1024;
  float4 v[4];
  float ss = 0.f;
#pragma unroll
  for (int i = 0; i < 4; ++i) {
    v[i] = *(const float4*)(xr + i * 256 + lane * 4);
    ss += v[i].x * v[i].x + v[i].y * v[i].y + v[i].z * v[i].z + v[i].w * v[i].w;
  }
  ss = wave_sum(ss);
  float r = 1.0f / sqrtf(ss * (1.0f / 1024.f) + 1e-6f);
#pragma unroll
  for (int i = 0; i < 4; ++i) {
    int d = i * 256 + lane * 4;
    float4 gg = *(const float4*)(g + d);
    float4 s4 = *(const float4*)(sc + b * 6144 + d);
    float4 h4 = *(const float4*)(sh + b * 6144 + d);
    float o0 = v[i].x * r * gg.x * (1.f + s4.x) + h4.x;
    float o1 = v[i].y * r * gg.y * (1.f + s4.y) + h4.y;
    float o2 = v[i].z * r * gg.z * (1.f + s4.z) + h4.z;
    float o3 = v[i].w * r * gg.w * (1.f + s4.w) + h4.w;
    uint2 pk;
    pk.x = (unsigned)f2bf(o0) | ((unsigned)f2bf(o1) << 16);
    pk.y = (unsigned)f2bf(o2) | ((unsigned)f2bf(o3) << 16);
    *(uint2*)(hout + tok * 1024 + d) = pk;
  }
}
DEV void norm8_item(const float* __restrict__ xin, const float* __restrict__ g, const float* __restrict__ sc,
                    const float* __restrict__ sh, unsigned char* __restrict__ hout, unsigned char* __restrict__ hscale, int item) {
  const int lane = tidx() & 63, wave = tidx() >> 6;
  const size_t tok = (size_t)item * 4 + wave;
  const int b = (int)(tok / S);
  const float* xr = xin + tok * 1024;
  float4 v[4];
  float ss = 0.f;
#pragma unroll
  for (int i = 0; i < 4; ++i) {
    v[i] = *(const float4*)(xr + i * 256 + lane * 4);
    ss += v[i].x * v[i].x + v[i].y * v[i].y + v[i].z * v[i].z + v[i].w * v[i].w;
  }
  ss = wave_sum(ss);
  float r = 1.0f / sqrtf(ss * (1.0f / 1024.f) + 1e-6f);
  float mx = 0.f;
#pragma unroll
  for (int i = 0; i < 4; ++i) {
    int d = i * 256 + lane * 4;
    float4 gg = *(const float4*)(g + d);
    float4 s4 = *(const float4*)(sc + b * 6144 + d);
    float4 h4 = *(const float4*)(sh + b * 6144 + d);
    v[i].x = v[i].x * r * gg.x * (1.f + s4.x) + h4.x;
    v[i].y = v[i].y * r * gg.y * (1.f + s4.y) + h4.y;
    v[i].z = v[i].z * r * gg.z * (1.f + s4.z) + h4.z;
    v[i].w = v[i].w * r * gg.w * (1.f + s4.w) + h4.w;
    mx = fmaxf(mx, fmaxf(fmaxf(fabsf(v[i].x), fabsf(v[i].y)), fmaxf(fabsf(v[i].z), fabsf(v[i].w))));
  }
#pragma unroll
  for (int o = 32; o >= 1; o >>= 1) mx = fmaxf(mx, shx(mx, o));
  const unsigned e = e8m0_of(mx);
  const float s = e8m0_inv(e);
#pragma unroll
  for (int i = 0; i < 4; ++i)
    *(unsigned*)(hout + tok * 1024 + i * 256 + lane * 4) = pack4_fp8_(v[i].x * s, v[i].y * s, v[i].z * s, v[i].w * s);
  if (lane == 0) hscale[tok] = (unsigned char)e;
}
DEV void final_norm_item(float* __restrict__ x, const float* __restrict__ g, int item) {
  const int lane = tidx() & 63, wave = tidx() >> 6;
  const size_t tok = (size_t)item * 4 + wave;
  float* xr = x + tok * 1024;
  float4 v[4];
  float ss = 0.f;
#pragma unroll
  for (int i = 0; i < 4; ++i) {
    v[i] = *(const float4*)(xr + i * 256 + lane * 4);
    ss += v[i].x * v[i].x + v[i].y * v[i].y + v[i].z * v[i].z + v[i].w * v[i].w;
  }
  ss = wave_sum(ss);
  float r = 1.0f / sqrtf(ss * (1.0f / 1024.f) + 1e-6f);
#pragma unroll
  for (int i = 0; i < 4; ++i) {
    int d = i * 256 + lane * 4;
    float4 gg = *(const float4*)(g + d);
    float4 o;
    o.x = v[i].x * r * gg.x; o.y = v[i].y * r * gg.y; o.z = v[i].z * r * gg.z; o.w = v[i].w * r * gg.w;
    *(float4*)(xr + d) = o;
  }
}

#define GM_BUF (2 * 128 * 72)
#define GM_LOAD(R, kk)                                                                                  \
  {                                                                                                     \
    const bf16* Ak = Ap + (kk);                                                                         \
    const bf16* Wk = Wp + (kk);                                                                         \
    R##a0 = *(const uint4*)(Ak); R##a1 = *(const uint4*)(Ak + a32); R##a2 = *(const uint4*)(Ak + 2 * a32); \
    R##a3 = *(const uint4*)(Ak + 3 * a32);                                                              \
    R##b0 = *(const uint4*)(Wk); R##b1 = *(const uint4*)(Wk + w32); R##b2 = *(const uint4*)(Wk + 2 * w32); \
    R##b3 = *(const uint4*)(Wk + 3 * w32);                                                              \
  }
#define GM_STORE(R, buf)                                                                                \
  {                                                                                                     \
    bf16* as_ = Asw + (buf) * GM_BUF;                                                                   \
    bf16* bs_ = as_ + 128 * 72;                                                                         \
    *(uint4*)(as_) = R##a0; *(uint4*)(as_ + 32 * 72) = R##a1; *(uint4*)(as_ + 64 * 72) = R##a2; *(uint4*)(as_ + 96 * 72) = R##a3; \
    *(uint4*)(bs_) = R##b0; *(uint4*)(bs_ + 32 * 72) = R##b1; *(uint4*)(bs_ + 64 * 72) = R##b2; *(uint4*)(bs_ + 96 * 72) = R##b3; \
  }
#define GM_COMPUTE(buf)                                                                                 \
  {                                                                                                     \
    const bf16* As_ = sm + (buf) * GM_BUF;                                                              \
    const bf16* Bs_ = As_ + 128 * 72;                                                                   \
    _Pragma("unroll") for (int ks = 0; ks < 2; ++ks) {                                                  \
      __builtin_amdgcn_sched_barrier(0);                                                                \
      bf16x8 af[4], bfr[4];                                                                             \
      _Pragma("unroll") for (int mi = 0; mi < 4; ++mi)                                                  \
        af[mi] = *(const bf16x8*)(As_ + (wr * 64 + mi * 16 + (lane & 15)) * 72 + ks * 32 + (lane >> 4) * 8); \
      _Pragma("unroll") for (int ni = 0; ni < 4; ++ni)                                                  \
        bfr[ni] = *(const bf16x8*)(Bs_ + (wc * 64 + ni * 16 + (lane & 15)) * 72 + ks * 32 + (lane >> 4) * 8); \
      _Pragma("unroll") for (int mi = 0; mi < 4; ++mi)                                                  \
        _Pragma("unroll") for (int ni = 0; ni < 4; ++ni)                                                \
          acc[mi][ni] = __builtin_amdgcn_mfma_f32_16x16x32_bf16(af[mi], bfr[ni], acc[mi][ni], 0, 0, 0); \
    }                                                                                                   \
    __builtin_amdgcn_sched_barrier(0);                                                                  \
  }
DEV void gemm_mainloop(const bf16* __restrict__ A, int lda, const bf16* __restrict__ W, int K, int m0, int n0, bf16* sm,
                       f32x4 (&acc)[4][4]) {
  const int tid = tidx(), lane = tid & 63, wave = tid >> 6;
  const int wr = wave >> 1, wc = wave & 1;
  const int lrow = tid >> 3, lkc = (tid & 7) * 8;
  const bf16* Ap = A + (size_t)(m0 + lrow) * lda + lkc;
  const bf16* Wp = W + (size_t)(n0 + lrow) * K + lkc;
  const int a32 = 32 * lda, w32 = 32 * K;
  bf16* Asw = sm + lrow * 72 + lkc;
  uint4 xa0, xa1, xa2, xa3, xb0, xb1, xb2, xb3, ya0, ya1, ya2, ya3, yb0, yb1, yb2, yb3;
  const int nk = K >> 6;
  GM_LOAD(x, 0)
  GM_LOAD(y, 64)
  __syncthreads();
  GM_STORE(x, 0)
  if (nk > 2) GM_LOAD(x, 128)
  __syncthreads();
  for (int k = 0; k < nk; k += 2) {
    GM_COMPUTE(0)
    GM_STORE(y, 1)
    if (k + 3 < nk) GM_LOAD(y, (k + 3) * 64)
    __syncthreads();
    GM_COMPUTE(1)
    if (k + 2 < nk) {
      GM_STORE(x, 0)
      if (k + 4 < nk) GM_LOAD(x, (k + 4) * 64)
    }
    __syncthreads();
  }
}
DEV void gemm256_mainloop(const bf16* __restrict__ A, int lda, const bf16* __restrict__ W, int K, int m0, int n0, bf16* sm,
                          f32x4 (&acc)[2][4][4]) {
  bf16* As = sm;
  bf16* Bs = sm + 256 * 72;
  const int tid = tidx(), lane = tid & 63, wave = tid >> 6;
  const int wr = wave >> 1, wc = wave & 1;
  const int lrow = tid >> 3, lkc = (tid & 7) * 8;
  const bf16* Ap = A + (size_t)(m0 + lrow) * lda + lkc;
  const bf16* Wp = W + (size_t)(n0 + lrow) * K + lkc;
  const int a32 = 32 * lda, w32 = 32 * K;
  uint4 ra0, ra1, ra2, ra3, ra4, ra5, ra6, ra7, rb0, rb1, rb2, rb3;
#define G256_LOAD(kk)                                                                                   \
  {                                                                                                     \
    const bf16* Ak = Ap + (kk);                                                                         \
    const bf16* Wk = Wp + (kk);                                                                         \
    ra0 = *(const uint4*)(Ak); ra1 = *(const uint4*)(Ak + a32); ra2 = *(const uint4*)(Ak + 2 * a32);    \
    ra3 = *(const uint4*)(Ak + 3 * a32); ra4 = *(const uint4*)(Ak + 4 * a32); ra5 = *(const uint4*)(Ak + 5 * a32); \
    ra6 = *(const uint4*)(Ak + 6 * a32); ra7 = *(const uint4*)(Ak + 7 * a32);                           \
    rb0 = *(const uint4*)(Wk); rb1 = *(const uint4*)(Wk + w32); rb2 = *(const uint4*)(Wk + 2 * w32);    \
    rb3 = *(const uint4*)(Wk + 3 * w32);                                                                \
  }
  G256_LOAD(0)
  bf16* Asw = As + lrow * 72 + lkc;
  bf16* Bsw = Bs + lrow * 72 + lkc;
  for (int k0 = 0; k0 < K; k0 += 64) {
    __syncthreads();
    *(uint4*)(Asw) = ra0; *(uint4*)(Asw + 32 * 72) = ra1; *(uint4*)(Asw + 64 * 72) = ra2; *(uint4*)(Asw + 96 * 72) = ra3;
    *(uint4*)(Asw + 128 * 72) = ra4; *(uint4*)(Asw + 160 * 72) = ra5; *(uint4*)(Asw + 192 * 72) = ra6; *(uint4*)(Asw + 224 * 72) = ra7;
    *(uint4*)(Bsw) = rb0; *(uint4*)(Bsw + 32 * 72) = rb1; *(uint4*)(Bsw + 64 * 72) = rb2; *(uint4*)(Bsw + 96 * 72) = rb3;
    __syncthreads();
    if (k0 + 64 < K) G256_LOAD(k0 + 64)
#pragma unroll
    for (int ks = 0; ks < 2; ++ks) {
      bf16x8 bfr[4];
#pragma unroll
      for (int ni = 0; ni < 4; ++ni)
        bfr[ni] = *(const bf16x8*)(Bs + (wc * 64 + ni * 16 + (lane & 15)) * 72 + ks * 32 + (lane >> 4) * 8);
#pragma unroll
      for (int h = 0; h < 2; ++h) {
        __builtin_amdgcn_sched_barrier(0);
        bf16x8 af[4];
#pragma unroll
        for (int mi = 0; mi < 4; ++mi)
          af[mi] = *(const bf16x8*)(As + (wr * 128 + h * 64 + mi * 16 + (lane & 15)) * 72 + ks * 32 + (lane >> 4) * 8);
#pragma unroll
        for (int mi = 0; mi < 4; ++mi)
#pragma unroll
          for (int ni = 0; ni < 4; ++ni)
            acc[h][mi][ni] = __builtin_amdgcn_mfma_f32_16x16x32_bf16(af[mi], bfr[ni], acc[h][mi][ni], 0, 0, 0);
      }
    }
  }
}
DEV void acc_zero(f32x4 (&acc)[4][4]) {
#pragma unroll
  for (int i = 0; i < 4; ++i)
#pragma unroll
    for (int j = 0; j < 4; ++j) acc[i][j] = f32x4{0.f, 0.f, 0.f, 0.f};
}
DEV void store_tile_bf16(bf16* sm, const f32x4 (&acc)[4][4], bf16* __restrict__ dbase, size_t dstride) {
  const int tid = tidx(), lane = tid & 63, wave = tid >> 6, g4 = lane >> 4, c16 = lane & 15;
  bf16* Cw = sm + wave * (64 * 72);
  __syncthreads();
#pragma unroll
  for (int mi = 0; mi < 4; ++mi)
#pragma unroll
    for (int ni = 0; ni < 4; ++ni)
#pragma unroll
      for (int r = 0; r < 4; ++r) Cw[(mi * 16 + g4 * 4 + r) * 72 + ni * 16 + c16] = f2bf(acc[mi][ni][r]);
  __syncthreads();
#pragma unroll
  for (int it = 0; it < 8; ++it) {
    const int row_l = it * 8 + (lane >> 3), ch = lane & 7;
    const uint4 v = *(const uint4*)(Cw + row_l * 72 + ch * 8);
    *(uint4*)(dbase + (size_t)row_l * dstride + ch * 8) = v;
  }
}
template <class Epi>
DEV void gemm_tile(const bf16* __restrict__ A, int lda, const bf16* __restrict__ W, int K, int m0, int n0, bf16* sm,
                   Epi epi) {
  f32x4 acc[4][4];
  acc_zero(acc);
  gemm_mainloop(A, lda, W, K, m0, n0, sm, acc);
  const int tid = tidx(), lane = tid & 63, wave = tid >> 6;
  const int wr = wave >> 1, wc = wave & 1;
#pragma unroll
  for (int mi = 0; mi < 4; ++mi)
#pragma unroll
    for (int ni = 0; ni < 4; ++ni)
#pragma unroll
      for (int r = 0; r < 4; ++r) {
        int row = m0 + wr * 64 + mi * 16 + (lane >> 4) * 4 + r;
        int col = n0 + wc * 64 + ni * 16 + (lane & 15);
        epi(row, col, acc[mi][ni][r]);
      }
}
DEV void inproj_epilogue(const Params& p, f32x4 (&acc)[4][4], int row0, int vc0, bf16* sm) {
  const int tid = tidx(), lane = tid & 63, g4 = lane >> 4, c16 = lane & 15;
  const int b = row0 / S, t0 = row0 % S;
  bf16* dbase;
  size_t dstride;
  bool roped = false;
  bf16* projp = (bf16*)(p.ws + OFF_PROJ) + (size_t)row0 * PC;
  if (vc0 < 768) { dbase = projp + vc0; dstride = PC; }
  else if (vc0 < 1280) {
    const int seg = (vc0 - 768) >> 7, head = ((vc0 - 768) >> 6) & 1;
    const size_t off = (seg == 0) ? OFF_KSB : (seg == 1) ? OFF_VSB : (seg == 2) ? OFF_KWB : OFF_VWB;
    dbase = (bf16*)(p.ws + off) + ((size_t)(b * 2 + head) * S + t0) * 64;
    dstride = 64;
    roped = (seg == 0) || (seg == 2);
  } else if (vc0 < 1792) { dbase = projp + C_MQ + (vc0 - 1280); dstride = PC; roped = true; }
  else if (vc0 < 2816) {
    const int seg = (vc0 - 1792) >> 9, head = ((vc0 - 1792) >> 6) & 7;
    dbase = (bf16*)(p.ws + (seg ? OFF_MVB : OFF_MKB)) + ((size_t)(b * 8 + head) * S + t0) * 64;
    dstride = 64;
    roped = (seg == 0);
  } else if (vc0 < 4864) { dbase = projp + C_GN + (vc0 - 2816); dstride = PC; }
  else { dbase = projp + C_NG + (vc0 - 4864); dstride = PC; }
  if (roped) {
    const float* rope = (const float*)(p.ws + OFF_ROPE);
#pragma unroll
    for (int mi = 0; mi < 4; ++mi)
#pragma unroll
      for (int r = 0; r < 4; ++r) {
        const int pos = t0 + mi * 16 + g4 * 4 + r;
        const float v = acc[mi][0][r];
        const float pv = shx(v, 8);
        const float cs = rope[pos * 16 + (c16 & 7)], sn = rope[pos * 16 + 8 + (c16 & 7)];
        acc[mi][0][r] = (c16 < 8) ? (v * cs - pv * sn) : (v * cs + pv * sn);
      }
  }
  store_tile_bf16(sm, acc, dbase, dstride);
}
DEV void inproj_tile256(const Params& p, int layer, int m0, int n0, bf16* sm) {
  f32x4 acc[2][4][4];
  acc_zero(acc[0]);
  acc_zero(acc[1]);
  gemm256_mainloop((const bf16*)(p.ws + OFF_H), 1024, (const bf16*)(p.ws + OFF_WINT) + (size_t)layer * WN * 1024, 1024, m0, n0, sm, acc);
  const int wave = tidx() >> 6, wr = wave >> 1, wc = wave & 1;
  inproj_epilogue(p, acc[0], m0 + wr * 128, n0 + wc * 64, sm);
  inproj_epilogue(p, acc[1], m0 + wr * 128 + 64, n0 + wc * 64, sm);
}
typedef unsigned u32x2_t __attribute__((ext_vector_type(2)));
DEV void merge_tile(const Params& p, int layer, int m0, int n0, bf16* sm) {
  const int tid = tidx(), lane = tid & 63, wave = tid >> 6, g4 = lane >> 4, c16 = lane & 15;
  const int wr = wave >> 1, wc = wave & 1;
  const bf16* projg = (const bf16*)(p.ws + OFF_PROJ) + (size_t)(m0 + wr * 64 + g4 * 4) * PC + n0 + wc * 64 + c16;
  f32x4 acc[4][4];
  acc_zero(acc);
  gemm_mainloop((const bf16*)(p.ws + OFF_ONSA), 512, (const bf16*)(p.ws + OFF_WUPN) + (size_t)layer * 1024 * 512, 512, m0, n0, sm, acc);
  bf16* yg = (bf16*)(p.ws + OFF_H) + (size_t)(m0 + wr * 64 + g4 * 4) * 1024 + n0 + wc * 64 + c16;
#pragma unroll
  for (int mi = 0; mi < 4; ++mi)
#pragma unroll
    for (int ni = 0; ni < 4; ++ni)
#pragma unroll
      for (int r = 0; r < 4; ++r)
        yg[(size_t)(mi * 16 + r) * 1024 + ni * 16] =
            f2bf(sigmoidf_(bf2f(projg[(size_t)(mi * 16 + r) * PC + C_GN + ni * 16])) * acc[mi][ni][r]);
  acc_zero(acc);
  gemm_mainloop((const bf16*)(p.ws + OFF_OMOBA), 512, (const bf16*)(p.ws + OFF_WUPM) + (size_t)layer * 1024 * 512, 512, m0, n0, sm, acc);
#pragma unroll
  for (int mi = 0; mi < 4; ++mi)
#pragma unroll
    for (int ni = 0; ni < 4; ++ni)
#pragma unroll
      for (int r = 0; r < 4; ++r)
        acc[mi][ni][r] = bf2f(yg[(size_t)(mi * 16 + r) * 1024 + ni * 16]) +
                         sigmoidf_(bf2f(projg[(size_t)(mi * 16 + r) * PC + C_GM + ni * 16])) * acc[mi][ni][r];
  store_tile_bf16(sm, acc, (bf16*)(p.ws + OFF_H) + (size_t)(m0 + wr * 64) * 1024 + n0 + wc * 64, 1024);
}

DEV void merge_tile256(const Params& p, int layer, int m0, int n0, bf16* sm) {
  const int tid = tidx(), lane = tid & 63, wave = tid >> 6, g4 = lane >> 4, c16 = lane & 15;
  const int wr = wave >> 1, wc = wave & 1;
  f32x4 acc[2][4][4];
  acc_zero(acc[0]);
  acc_zero(acc[1]);
  gemm256_mainloop((const bf16*)(p.ws + OFF_ONSA), 512, (const bf16*)(p.ws + OFF_WUPN) + (size_t)layer * 1024 * 512, 512, m0, n0, sm, acc);
#pragma unroll
  for (int h = 0; h < 2; ++h) {
    const size_t rb = (size_t)(m0 + wr * 128 + h * 64 + g4 * 4);
    const bf16* projg = (const bf16*)(p.ws + OFF_PROJ) + rb * PC + n0 + wc * 64 + c16;
    bf16* yg = (bf16*)(p.ws + OFF_H) + rb * 1024 + n0 + wc * 64 + c16;
#pragma unroll
    for (int mi = 0; mi < 4; ++mi)
#pragma unroll
      for (int ni = 0; ni < 4; ++ni)
#pragma unroll
        for (int r = 0; r < 4; ++r)
          yg[(size_t)(mi * 16 + r) * 1024 + ni * 16] =
              f2bf(sigmoidf_(bf2f(projg[(size_t)(mi * 16 + r) * PC + C_GN + ni * 16])) * acc[h][mi][ni][r]);
  }
  acc_zero(acc[0]);
  acc_zero(acc[1]);
  gemm256_mainloop((const bf16*)(p.ws + OFF_OMOBA), 512, (const bf16*)(p.ws + OFF_WUPM) + (size_t)layer * 1024 * 512, 512, m0, n0, sm, acc);
#pragma unroll
  for (int h = 0; h < 2; ++h) {
    const size_t rb = (size_t)(m0 + wr * 128 + h * 64 + g4 * 4);
    const bf16* projg = (const bf16*)(p.ws + OFF_PROJ) + rb * PC + n0 + wc * 64 + c16;
    const bf16* yg = (const bf16*)(p.ws + OFF_H) + rb * 1024 + n0 + wc * 64 + c16;
#pragma unroll
    for (int mi = 0; mi < 4; ++mi)
#pragma unroll
      for (int ni = 0; ni < 4; ++ni)
#pragma unroll
        for (int r = 0; r < 4; ++r)
          acc[h][mi][ni][r] = bf2f(yg[(size_t)(mi * 16 + r) * 1024 + ni * 16]) +
                              sigmoidf_(bf2f(projg[(size_t)(mi * 16 + r) * PC + C_GM + ni * 16])) * acc[h][mi][ni][r];
    store_tile_bf16(sm, acc[h], (bf16*)(p.ws + OFF_H) + (size_t)(m0 + wr * 128 + h * 64) * 1024 + n0 + wc * 64, 1024);
  }
}

DEV void compress_item(const Params& p, int layer, int item, float* sm) {
  const int tid = tidx();
  const int grp = item & 127, which = (item >> 7) & 1, kvh = (item >> 8) & 1, b = item >> 9;
  const int c0 = grp * 8;
  float* xs = sm;
  float* hs = sm + 144 * 64;
  const bf16* proj = (const bf16*)(p.ws + OFF_PROJ);
  const int col = (which ? C_VC : C_KC) + kvh * 64;
  for (int i = tid; i < 144 * 64; i += 256) {
    int tl = i >> 6, d = i & 63;
    int t = c0 * 16 + tl;
    xs[i] = (t < S) ? bf2f(proj[((size_t)b * S + t) * PC + col + d]) : 0.f;
  }
  __syncthreads();
  const int lw = layer * 2 + which;
  if (tid < 128) {
    const float* w1 = p.cmp_w1 + (size_t)lw * 2048 * 128 + tid;
    float acc[8];
#pragma unroll
    for (int ci = 0; ci < 8; ++ci) acc[ci] = 0.f;
    for (int l = 0; l < 32; ++l) {
#pragma unroll 4
      for (int d = 0; d < 64; ++d) {
        float w = w1[(size_t)(l * 64 + d) * 128];
#pragma unroll
        for (int ci = 0; ci < 8; ++ci) acc[ci] += xs[(ci * 16 + l) * 64 + d] * w;
      }
    }
    float pb = ((const float*)(p.ws + OFF_PEB))[lw * 128 + tid];
#pragma unroll
    for (int ci = 0; ci < 8; ++ci) hs[ci * 128 + tid] = gelu_tanh(acc[ci] + pb);
  }
  __syncthreads();
  const float* w2 = p.cmp_w2 + (size_t)lw * 128 * 64;
  float* outp = PROBE_CMPR ? ((float*)(p.ws + OFF_CMP) + (which ? (size_t)Bn * 1024 * 128 : 0)) : (float*)(p.ws + (which ? OFF_VCC : OFF_KCC));
#pragma unroll
  for (int rr = 0; rr < 2; ++rr) {
    int o = rr * 256 + tid;
    int ci = o >> 6, d = o & 63;
    int c = c0 + ci;
    float a = 0.f;
    for (int j = 0; j < 128; ++j) a += hs[ci * 128 + j] * w2[j * 64 + d];
    if (c < 1023) outp[(((size_t)b * 1024 + c) * 2 + kvh) * 64 + d] = a;
    bf16* outb = (bf16*)(p.ws + (which ? OFF_VCB : OFF_KCB));
    if (!PROBE_CMPR && c < 1024) outb[(((size_t)b * 2 + kvh) * 1024 + c) * 64 + d] = (c < 1023) ? f2bf(a) : (bf16)0;
  }
  __syncthreads();
}

DEV void compress_mfma_item(const Params& p, int layer, int item, char* smem) {
  bf16* xs = (bf16*)smem;
  float* hs = (float*)(smem + 272 * 64 * 2);
  const int tid = tidx(), lane = tid & 63, wave = tid >> 6, g4 = lane >> 4, c16 = lane & 15;
  const int cblk = item & 63, which = (item >> 6) & 1, kvh = (item >> 7) & 1, b = item >> 8;
  const int t0 = cblk * 256;
  const bf16* proj = (const bf16*)(p.ws + OFF_PROJ) + (size_t)b * S * PC + (which ? C_VC : C_KC) + kvh * 64;
  __syncthreads();
  {
    uint4 sv[9];
#pragma unroll
    for (int q = 0; q < 9; ++q) {
      const int i = tid + q * 256;
      const int tl = i >> 3, ch = i & 7;
      const int t = t0 + tl;
      sv[q] = uint4{0u, 0u, 0u, 0u};
      if (i < 272 * 8 && t < S) sv[q] = *(const uint4*)(proj + (size_t)t * PC + ch * 8);
    }
#pragma unroll
    for (int q = 0; q < 9; ++q) {
      const int i = tid + q * 256;
      const int tl = i >> 3, ch = i & 7;
      if (i < 272 * 8) *(uint4*)(xs + tl * 64 + ((ch ^ ((tl >> 4) & 7)) * 8)) = sv[q];
    }
  }
  float* w2s = (float*)(smem + 272 * 64 * 2 + 16 * 128 * 4);
  {
    const float* w2g = p.cmp_w2 + (size_t)(layer * 2 + which) * 128 * 64;
    float4 wv[8];
#pragma unroll
    for (int q = 0; q < 8; ++q) wv[q] = *(const float4*)(w2g + (q * 256 + tid) * 4);
#pragma unroll
    for (int q = 0; q < 8; ++q) *(float4*)(w2s + (q * 256 + tid) * 4) = wv[q];
  }
  __syncthreads();
  const int lw = layer * 2 + which;
  const bf16* w1t = (const bf16*)(p.ws + OFF_W1T) + (size_t)lw * 128 * 2048;
  f32x4 acc0 = f32x4{0.f, 0.f, 0.f, 0.f}, acc1 = f32x4{0.f, 0.f, 0.f, 0.f};
  const bf16* wb0 = w1t + (size_t)((2 * wave) * 16 + c16) * 2048 + g4 * 8;
  const bf16* wb1 = w1t + (size_t)((2 * wave + 1) * 16 + c16) * 2048 + g4 * 8;
#pragma unroll 16
  for (int ks = 0; ks < 64; ++ks) {
    const int l = ks >> 1, ch = (ks & 1) * 4 + g4;
    const int tl = 16 * c16 + l;
    const bf16x8 af = *(const bf16x8*)(xs + tl * 64 + ((ch ^ ((tl >> 4) & 7)) * 8));
    const bf16x8 b0 = *(const bf16x8*)(wb0 + ks * 32);
    const bf16x8 b1 = *(const bf16x8*)(wb1 + ks * 32);
    acc0 = MFMA16B(af, b0, acc0);
    acc1 = MFMA16B(af, b1, acc1);
  }
  {
    const float* peb = (const float*)(p.ws + OFF_PEB) + lw * 128;
    const int j0 = (2 * wave) * 16 + c16, j1 = j0 + 16;
    const float pb0 = peb[j0], pb1 = peb[j1];
#pragma unroll
    for (int r = 0; r < 4; ++r) {
      hs[(g4 * 4 + r) * 128 + j0] = gelu_tanh(acc0[r] + pb0);
      hs[(g4 * 4 + r) * 128 + j1] = gelu_tanh(acc1[r] + pb1);
    }
  }
  __syncthreads();
  const float* w2 = w2s;
  const int d = tid & 63, cq = tid >> 6;
  float o0 = 0.f, o1 = 0.f, o2 = 0.f, o3 = 0.f;
#pragma unroll 8
  for (int j = 0; j < 128; ++j) {
    const float w = w2[j * 64 + d];
    o0 += hs[(cq * 4 + 0) * 128 + j] * w;
    o1 += hs[(cq * 4 + 1) * 128 + j] * w;
    o2 += hs[(cq * 4 + 2) * 128 + j] * w;
    o3 += hs[(cq * 4 + 3) * 128 + j] * w;
  }
  float* outp = (float*)(p.ws + (which ? OFF_VCC : OFF_KCC));
  bf16* outb = (bf16*)(p.ws + (which ? OFF_VCB : OFF_KCB));
  const float ov[4] = {o0, o1, o2, o3};
#pragma unroll
  for (int i = 0; i < 4; ++i) {
    const int c = cblk * 16 + cq * 4 + i;
    if (c < 1023) outp[(((size_t)b * 1024 + c) * 2 + kvh) * 64 + d] = ov[i];
    outb[(((size_t)b * 2 + kvh) * 1024 + c) * 64 + d] = (c < 1023) ? f2bf(ov[i]) : (bf16)0;
  }
  __syncthreads();
}

DEV void n1_item(const Params& p, int layer, int item, float* sm) {
  const int chunk = item & 255, kvh = (item >> 8) & 1, b = item >> 9;
  const int tid = tidx(), ql = tid >> 2, g = tid & 3;
  const int t = chunk * 64 + ql, h = kvh * 4 + g;
  const size_t tok = (size_t)b * S + t;
  const bf16* proj = (const bf16*)(p.ws + OFF_PROJ);
  float* imp = sm;
  for (int i = tid; i < 64 * 257; i += 256) imp[i] = 0.f;
  float q[64];
  load_q64(q, proj + tok * PC + C_NQ + h * 64, 0.125f);
  const int nv = (t >= 31) ? (((t - 31) >> 4) + 1) : 0;
  const int nv_max = (((chunk * 64 + 63) - 31) >> 4) + 1;
  const float* kc = (const float*)(p.ws + OFF_KCC) + (size_t)b * 1024 * 128 + kvh * 64;
  const float* vc = (const float*)(p.ws + OFF_VCC) + (size_t)b * 1024 * 128 + kvh * 64;
  float m = -INFINITY, l = 0.f;
  for (int c = 0; c < nv_max; ++c) {
    float s = dot64_f(q, kc + (size_t)c * 128);
    if (c < nv) {
      float mn = fmaxf(m, s);
      l = l * expf(m - mn) + expf(s - mn);
      m = mn;
    }
  }
  __syncthreads();
  float o[64];
#pragma unroll
  for (int d = 0; d < 64; ++d) o[d] = 0.f;
  const float inv_l = (nv > 0) ? 1.f / l : 0.f;
  for (int c = 0; c < nv_max; ++c) {
    float s = dot64_f(q, kc + (size_t)c * 128);
    float pr = (c < nv) ? expf(s - m) * inv_l : 0.f;
    axpy64_f(o, pr, vc + (size_t)c * 128);
    float ps = pr;
    ps += shx(ps, 1);
    ps += shx(ps, 2);
    if (g == 0) {
      int n = c >> 2;
      if ((c & 3) == 3) {
        imp[ql * 257 + n] += 0.5f * ps;
        imp[ql * 257 + n + 1] += 0.5f * ps;
      } else {
        imp[ql * 257 + n] += ps;
      }
    }
  }
  const float gate0 = (!PROBE_NSA || (PROBE_NSA & 1)) ? sigmoidf_(bf2f(proj[tok * PC + C_NG + h * 3 + 0])) : 0.f;
  float* oa = (float*)(p.ws + OFF_H) + tok * 512 + h * 64;
#pragma unroll
  for (int d = 0; d < 64; d += 4) {
    float4 v = {gate0 * o[d], gate0 * o[d + 1], gate0 * o[d + 2], gate0 * o[d + 3]};
    *(float4*)(oa + d) = v;
  }
  __syncthreads();
#if PROBE_NSA == 8
  if (b == 0 && kvh == 0)
    for (int i = tid; i < 64 * 256; i += 256)
      ((float*)(p.ws + OFF_OMOBA))[(size_t)(chunk * 64 + (i >> 8)) * 256 + (i & 255)] = imp[(i >> 8) * 257 + (i & 255)];
  __syncthreads();
#endif
  if (g == 0) {
    int* selp = (int*)(p.ws + OFF_SEL) + (((size_t)b * 2 + kvh) * S + t) * 16;
    const int cur = chunk;
    if (cur < 16) {
      for (int j = 0; j < 16; ++j) selp[j] = (j <= cur) ? j : -1;
    } else {
      selp[0] = 0;
      selp[1] = cur - 1;
      selp[2] = cur;
      float* row = imp + ql * 257;
      for (int j = 3; j < 16; ++j) {
        float best = -1.f;
        int bi = 1;
        for (int n = 1; n <= cur - 2; ++n) {
          float v = row[n];
          if (v > best) { best = v; bi = n; }
        }
        selp[j] = bi;
        row[bi] = -2.f;
      }
    }
  }
  __syncthreads();
}

DEV void kmean_item(const Params& p, int item, float* sm) {
  const int n = item & 63, h = (item >> 6) & 7, b = item >> 9;
  const int tid = tidx(), d = tid & 63, part = tid >> 6;
  const bf16* mkb = (const bf16*)(p.ws + OFF_MKB);
  float a = 0.f;
  for (int i = 0; i < 64; ++i) {
    int t = n * 256 + part * 64 + i;
    a += bf2f(mkb[((size_t)(b * 8 + h) * S + t) * 64 + d]);
  }
  sm[tid] = a;
  __syncthreads();
  if (tid < 64) {
    float s = sm[tid] + sm[64 + tid] + sm[128 + tid] + sm[192 + tid];
    const size_t ko = (((size_t)b * 8 + h) * 64 + n) * 64 + tid;
    const float mean = s * (1.f / 256.f);
    ((float*)(p.ws + OFF_KMEAN))[ko] = mean;
    const bf16 hi = f2bf(mean);
    ((bf16*)(p.ws + OFF_KMHL))[ko] = hi;
    ((bf16*)(p.ws + OFF_KMHL))[(size_t)2 * 8 * 64 * 64 + ko] = f2bf(mean - bf2f(hi));
    if (tid == 0) ((int*)(p.ws + OFF_MCNT))[((b * 8 + h) * 64 + n) * MCNT_STRIDE] = 0;
  }
  __syncthreads();
}

DEV void n23_item(const Params& p, int layer, int item) {
  const int chunk = item & 255, kvh = (item >> 8) & 1, b = item >> 9;
  const int tid = tidx(), ql = tid >> 2, g = tid & 3;
  const int t = chunk * 64 + ql, h = kvh * 4 + g;
  const size_t tok = (size_t)b * S + t;
  const bf16* proj = (const bf16*)(p.ws + OFF_PROJ);
  const float* rope = (const float*)(p.ws + OFF_ROPE) + (size_t)t * 16;
  float q[64];
  load_q64(q, proj + tok * PC + C_NQ + h * 64, 1.0f);
#pragma unroll
  for (int i = 0; i < 8; ++i) {
    float cs = rope[i], sn = rope[8 + i];
    float x1 = q[i], x2 = q[8 + i];
    q[i] = x1 * cs - x2 * sn;
    q[8 + i] = x2 * cs + x1 * sn;
  }
#pragma unroll
  for (int i = 0; i < 64; ++i) q[i] *= 0.125f;
  const size_t kvo = ((size_t)(b * 2 + kvh) * S) * 64;
  const bf16* ksb = (const bf16*)(p.ws + OFF_KSB) + kvo;
  const bf16* vsb = (const bf16*)(p.ws + OFF_VSB) + kvo;
  const bf16* kwb = (const bf16*)(p.ws + OFF_KWB) + kvo;
  const bf16* vwb = (const bf16*)(p.ws + OFF_VWB) + kvo;
  const int* selp = (const int*)(p.ws + OFF_SEL) + (((size_t)b * 2 + kvh) * S + t) * 16;
  float* oa = (float*)(p.ws + OFF_H) + tok * 512 + h * 64;
  const float gate1 = (!PROBE_NSA || (PROBE_NSA & 2)) ? sigmoidf_(bf2f(proj[tok * PC + C_NG + h * 3 + 1])) : 0.f;
  const float gate2 = (!PROBE_NSA || (PROBE_NSA & 4)) ? sigmoidf_(bf2f(proj[tok * PC + C_NG + h * 3 + 2])) : 0.f;
  float o[64];
  {
    float m = -INFINITY;
    for (int j = 0; j < 16; ++j) {
      int n = selp[j];
      if (n >= 0) {
        for (int i = 0; i < 64; ++i) {
          int kpos = n * 64 + i;
          if (kpos <= t) {
            float s = dot64_bf(q, ksb + (size_t)kpos * 64);
            m = fmaxf(m, s);
          }
        }
      }
    }
    float l = 0.f;
#pragma unroll
    for (int d = 0; d < 64; ++d) o[d] = 0.f;
    for (int j = 0; j < 16; ++j) {
      int n = selp[j];
      if (n >= 0) {
        for (int i = 0; i < 64; ++i) {
          int kpos = n * 64 + i;
          if (kpos <= t) {
            float s = dot64_bf(q, ksb + (size_t)kpos * 64);
            float pr = expf(s - m);
            l += pr;
            axpy64_bf(o, pr, vsb + (size_t)kpos * 64);
          }
        }
      }
    }
    float sc = gate1 / l;
#pragma unroll
    for (int d = 0; d < 64; d += 4) {
      float4 v = *(float4*)(oa + d);
      v.x += sc * o[d]; v.y += sc * o[d + 1]; v.z += sc * o[d + 2]; v.w += sc * o[d + 3];
      *(float4*)(oa + d) = v;
    }
  }
  {
    const int s0 = chunk * 64;
    const int jlo = (s0 - 511 > 0) ? (s0 - 511) : 0;
    const int jhi = s0 + 63;
    float m = -INFINITY;
    for (int j = jlo; j <= jhi; ++j) {
      float s = dot64_bf(q, kwb + (size_t)j * 64);
      if (j <= t && j > t - 512) m = fmaxf(m, s);
    }
    float l = 0.f;
#pragma unroll
    for (int d = 0; d < 64; ++d) o[d] = 0.f;
    for (int j = jlo; j <= jhi; ++j) {
      float s = dot64_bf(q, kwb + (size_t)j * 64);
      float pr = (j <= t && j > t - 512) ? expf(s - m) : 0.f;
      l += pr;
      axpy64_bf(o, pr, vwb + (size_t)j * 64);
    }
    float sc = gate2 / l;
    bf16* ob = (bf16*)(p.ws + (PROBE_NSA ? OFF_CMP : OFF_ONSA)) + tok * 512 + h * 64;
#pragma unroll
    for (int d = 0; d < 64; d += 8) {
      float4 v0 = *(float4*)(oa + d);
      float4 v1 = *(float4*)(oa + d + 4);
      uint4 pk;
      pk.x = (unsigned)f2bf(v0.x + sc * o[d]) | ((unsigned)f2bf(v0.y + sc * o[d + 1]) << 16);
      pk.y = (unsigned)f2bf(v0.z + sc * o[d + 2]) | ((unsigned)f2bf(v0.w + sc * o[d + 3]) << 16);
      pk.z = (unsigned)f2bf(v1.x + sc * o[d + 4]) | ((unsigned)f2bf(v1.y + sc * o[d + 5]) << 16);
      pk.w = (unsigned)f2bf(v1.z + sc * o[d + 6]) | ((unsigned)f2bf(v1.w + sc * o[d + 7]) << 16);
      *(uint4*)(ob + d) = pk;
    }
  }
}

DEV void moba_item(const Params& p, int layer, int item) {
  const int blk = item & 63, h = (item >> 6) & 7, b = item >> 9;
  const int tid = tidx();
  const int t = blk * 256 + tid;
  const size_t tok = (size_t)b * S + t;
  const bf16* proj = (const bf16*)(p.ws + OFF_PROJ);
  float q[64];
  load_q64(q, proj + tok * PC + C_MQ + h * 64, 0.125f);
  const float* km = (const float*)(p.ws + OFF_KMEAN) + ((size_t)b * 8 + h) * 64 * 64;
  float b0 = -INFINITY, b1 = -INFINITY, b2 = -INFINITY;
  int i0 = -1, i1 = -1, i2 = -1;
  for (int n = 0; n < blk; ++n) {
    float v = dot64_f(q, km + n * 64);
    if (v > b0) { b2 = b1; i2 = i1; b1 = b0; i1 = i0; b0 = v; i0 = n; }
    else if (v > b1) { b2 = b1; i2 = i1; b1 = v; i1 = n; }
    else if (v > b2) { b2 = v; i2 = n; }
  }
  const bf16* mkb = (const bf16*)(p.ws + OFF_MKB) + ((size_t)(b * 8 + h) * S) * 64;
  const bf16* mvb = (const bf16*)(p.ws + OFF_MVB) + ((size_t)(b * 8 + h) * S) * 64;
  float m = -INFINITY;
  for (int sidx = 0; sidx < 3; ++sidx) {
    int n = (sidx == 0) ? i0 : (sidx == 1) ? i1 : i2;
    if (sidx < blk) {
      for (int i = 0; i < 256; ++i) {
        float s = dot64_bf(q, mkb + (size_t)(n * 256 + i) * 64);
        m = fmaxf(m, s);
      }
    }
  }
  for (int i = 0; i < 256; ++i) {
    int kpos = blk * 256 + i;
    float s = dot64_bf(q, mkb + (size_t)kpos * 64);
    if (kpos <= t) m = fmaxf(m, s);
  }
  float l = 0.f;
  float o[64];
#pragma unroll
  for (int d = 0; d < 64; ++d) o[d] = 0.f;
  for (int sidx = 0; sidx < 3; ++sidx) {
    int n = (sidx == 0) ? i0 : (sidx == 1) ? i1 : i2;
    if (sidx < blk) {
      for (int i = 0; i < 256; ++i) {
        const size_t ko = (size_t)(n * 256 + i) * 64;
        float s = dot64_bf(q, mkb + ko);
        float pr = expf(s - m);
        l += pr;
        axpy64_bf(o, pr, mvb + ko);
      }
    }
  }
  for (int i = 0; i < 256; ++i) {
    int kpos = blk * 256 + i;
    const size_t ko = (size_t)kpos * 64;
    float s = dot64_bf(q, mkb + ko);
    float pr = (kpos <= t) ? expf(s - m) : 0.f;
    l += pr;
    axpy64_bf(o, pr, mvb + ko);
  }
  const float il = 1.f / l;
  bf16* ob = (bf16*)(p.ws + (PROBE_MOBA ? OFF_CMP : OFF_OMOBA)) + tok * 512 + h * 64;
#pragma unroll
  for (int d = 0; d < 64; d += 8) {
    uint4 pk;
    pk.x = (unsigned)f2bf(o[d] * il) | ((unsigned)f2bf(o[d + 1] * il) << 16);
    pk.y = (unsigned)f2bf(o[d + 2] * il) | ((unsigned)f2bf(o[d + 3] * il) << 16);
    pk.z = (unsigned)f2bf(o[d + 4] * il) | ((unsigned)f2bf(o[d + 5] * il) << 16);
    pk.w = (unsigned)f2bf(o[d + 6] * il) | ((unsigned)f2bf(o[d + 7] * il) << 16);
    *(uint4*)(ob + d) = pk;
  }
}

typedef short v4i16_t __attribute__((ext_vector_type(4)));
typedef unsigned u32x4_t __attribute__((ext_vector_type(4)));
DEV v4i16_t lds_tr16(const bf16* p) {
  return __builtin_amdgcn_ds_read_tr16_b64_v4i16((__attribute__((address_space(3))) v4i16_t*)p);
}
DEV unsigned cvtpk(float lo, float hi) {
  unsigned r;
  asm("v_cvt_pk_bf16_f32 %0, %1, %2" : "=v"(r) : "v"(lo), "v"(hi));
  return r;
}
#define MFMA16(a, b, c) __builtin_amdgcn_mfma_f32_16x16x32_bf16(a, b, c, 0, 0, 0)
constexpr float C2 = 0.125f * 1.4426950408889634f;
constexpr int KT_LD = 72;
constexpr int KT_ELEMS = 64 * KT_LD;

template <int NI>
struct AttnSt {
  f32x4 o[4][NI];
  float m[NI], l[NI];
};
template <int NI>
DEV void attn_init(AttnSt<NI>& st) {
#pragma unroll
  for (int ni = 0; ni < NI; ++ni) {
    st.m[ni] = -INFINITY;
    st.l[ni] = 0.f;
#pragma unroll
    for (int di = 0; di < 4; ++di) st.o[di][ni] = f32x4{0.f, 0.f, 0.f, 0.f};
  }
}
#define TILE_DECL uint4 tl_k0, tl_k1, tl_v0, tl_v1
#define TILE_GLOAD(kb, vb, ld, key0)                                                        \
  do {                                                                                      \
    const int r_ = tidx() >> 3, c_ = (tidx() & 7) * 8;                            \
    tl_k0 = *(const uint4*)((kb) + (size_t)((key0) + r_) * (ld) + c_);                      \
    tl_k1 = *(const uint4*)((kb) + (size_t)((key0) + 32 + r_) * (ld) + c_);                 \
    tl_v0 = *(const uint4*)((vb) + (size_t)((key0) + r_) * (ld) + c_);                      \
    tl_v1 = *(const uint4*)((vb) + (size_t)((key0) + 32 + r_) * (ld) + c_);                 \
  } while (0)
#define TILE_SSTORE(Ks_, Vs_)                                                               \
  do {                                                                                      \
    const int r_ = tidx() >> 3, c_ = (tidx() & 7) * 8;                            \
    *(uint4*)((Ks_) + r_ * KT_LD + c_) = tl_k0;                                             \
    *(uint4*)((Ks_) + (32 + r_) * KT_LD + c_) = tl_k1;                                      \
    *(uint4*)((Vs_) + r_ * KT_LD + c_) = tl_v0;                                             \
    *(uint4*)((Vs_) + (32 + r_) * KT_LD + c_) = tl_v1;                                      \
  } while (0)
#define TL_GLOAD(P, kb, vb, ld, key0)                                                       \
  do {                                                                                      \
    const int r_ = tidx() >> 3, c_ = (tidx() & 7) * 8;                                      \
    P##_k0 = *(const uint4*)((kb) + (size_t)((key0) + r_) * (ld) + c_);                     \
    P##_k1 = *(const uint4*)((kb) + (size_t)((key0) + 32 + r_) * (ld) + c_);                \
    P##_v0 = *(const uint4*)((vb) + (size_t)((key0) + r_) * (ld) + c_);                     \
    P##_v1 = *(const uint4*)((vb) + (size_t)((key0) + 32 + r_) * (ld) + c_);                \
  } while (0)
#define TL_SSTORE(P, Ks_, Vs_)                                                              \
  do {                                                                                      \
    const int r_ = tidx() >> 3, c_ = (tidx() & 7) * 8;                                      \
    *(uint4*)((Ks_) + r_ * KT_LD + c_) = P##_k0;                                            \
    *(uint4*)((Ks_) + (32 + r_) * KT_LD + c_) = P##_k1;                                     \
    *(uint4*)((Vs_) + r_ * KT_LD + c_) = P##_v0;                                            \
    *(uint4*)((Vs_) + (32 + r_) * KT_LD + c_) = P##_v1;                                     \
  } while (0)
#define KV_SWEEP(kb_, vb_, ld_, nt_, KEYF, ...)                                             \
  {                                                                                         \
    uint4 tA_k0, tA_k1, tA_v0, tA_v1, tB_k0, tB_k1, tB_v0, tB_v1;                           \
    const int nt__ = (nt_);                                                                 \
    if (nt__ > 0) {                                                                         \
      TL_GLOAD(tA, kb_, vb_, ld_, KEYF(0));                                                 \
      TL_SSTORE(tA, smkv, smkv + KT_ELEMS);                                                 \
      if (nt__ > 1) TL_GLOAD(tA, kb_, vb_, ld_, KEYF(1));                                   \
    }                                                                                       \
    __syncthreads();                                                                        \
    for (int it0__ = 0; it0__ < nt__; it0__ += 2) {                                         \
      {                                                                                     \
        const int it = it0__;                                                               \
        if (it + 2 < nt__) TL_GLOAD(tB, kb_, vb_, ld_, KEYF(it + 2));                       \
        const bf16* Ks = smkv;                                                              \
        __VA_ARGS__                                                                         \
        if (it + 1 < nt__) TL_SSTORE(tA, smkv + 2 * KT_ELEMS, smkv + 3 * KT_ELEMS);         \
        __syncthreads();                                                                    \
      }                                                                                     \
      if (it0__ + 1 < nt__) {                                                               \
        const int it = it0__ + 1;                                                           \
        if (it + 2 < nt__) TL_GLOAD(tA, kb_, vb_, ld_, KEYF(it + 2));                       \
        const bf16* Ks = smkv + 2 * KT_ELEMS;                                               \
        __VA_ARGS__                                                                         \
        if (it + 1 < nt__) TL_SSTORE(tB, smkv, smkv + KT_ELEMS);                            \
        __syncthreads();                                                                    \
      }                                                                                     \
    }                                                                                       \
  }
template <int NI>
DEV void attn_scores(const bf16* Ks, const bf16x8 (&qf)[NI][2], f32x4 (&s)[4][NI]) {
  const int lane = tidx() & 63, g4 = lane >> 4, c16 = lane & 15;
#pragma unroll
  for (int mi = 0; mi < 4; ++mi) {
#pragma unroll
    for (int ni = 0; ni < NI; ++ni) s[mi][ni] = f32x4{0.f, 0.f, 0.f, 0.f};
#pragma unroll
    for (int ks = 0; ks < 2; ++ks) {
      bf16x8 kf = *(const bf16x8*)(Ks + (mi * 16 + c16) * KT_LD + ks * 32 + g4 * 8);
#pragma unroll
      for (int ni = 0; ni < NI; ++ni) s[mi][ni] = MFMA16(kf, qf[ni][ks], s[mi][ni]);
    }
  }
}
template <int NI>
DEV void attn_pv(const bf16* Vs, const bf16x8 (&pf)[NI][2], f32x4 (&o)[4][NI]) {
  const int lane = tidx() & 63, g4 = lane >> 4, q4 = (lane & 15) >> 2, p4 = lane & 3;
#pragma unroll
  for (int di = 0; di < 4; ++di) {
#pragma unroll
    for (int ks2 = 0; ks2 < 2; ++ks2) {
      v4i16_t v0 = lds_tr16(Vs + (ks2 * 32 + g4 * 4 + q4) * KT_LD + di * 16 + p4 * 4);
      v4i16_t v1 = lds_tr16(Vs + (ks2 * 32 + 16 + g4 * 4 + q4) * KT_LD + di * 16 + p4 * 4);
      bf16x8 vf = __builtin_shufflevector(v0, v1, 0, 1, 2, 3, 4, 5, 6, 7);
#pragma unroll
      for (int ni = 0; ni < NI; ++ni) o[di][ni] = MFMA16(vf, pf[ni][ks2], o[di][ni]);
    }
  }
}
DEV void exp4_pack(const f32x4& sv, float nm, float& ps, unsigned& w0, unsigned& w1) {
  float p0 = __builtin_amdgcn_exp2f(__builtin_fmaf(sv[0], C2, nm));
  float p1 = __builtin_amdgcn_exp2f(__builtin_fmaf(sv[1], C2, nm));
  float p2 = __builtin_amdgcn_exp2f(__builtin_fmaf(sv[2], C2, nm));
  float p3 = __builtin_amdgcn_exp2f(__builtin_fmaf(sv[3], C2, nm));
  ps += (p0 + p1) + (p2 + p3);
  w0 = cvtpk(p0, p1);
  w1 = cvtpk(p2, p3);
}
template <int NI>
DEV void attn_softmax_pv(const bf16* Vs, f32x4 (&s)[4][NI], AttnSt<NI>& st) {
  bf16x8 pf[NI][2];
#pragma unroll
  for (int ni = 0; ni < NI; ++ni) {
    float mx = -INFINITY;
#pragma unroll
    for (int mi = 0; mi < 4; ++mi)
      mx = fmaxf(fmaxf(mx, fmaxf(s[mi][ni][0], s[mi][ni][1])), fmaxf(s[mi][ni][2], s[mi][ni][3]));
    mx = fmaxf(mx, shx(mx, 16));
    mx = fmaxf(mx, shx(mx, 32));
    const float mn = fmaxf(st.m[ni], mx);
    const float mu = (mn == -INFINITY) ? 0.f : mn;
    const float corr = __builtin_amdgcn_exp2f((st.m[ni] - mu) * C2);
    st.m[ni] = mn;
    const float nm = -mu * C2;
    float ps = 0.f;
    u32x4_t wa, wb;
    unsigned t0, t1;
    exp4_pack(s[0][ni], nm, ps, t0, t1); wa.x = t0; wa.y = t1;
    exp4_pack(s[1][ni], nm, ps, t0, t1); wa.z = t0; wa.w = t1;
    exp4_pack(s[2][ni], nm, ps, t0, t1); wb.x = t0; wb.y = t1;
    exp4_pack(s[3][ni], nm, ps, t0, t1); wb.z = t0; wb.w = t1;
    st.l[ni] = st.l[ni] * corr + ps;
#pragma unroll
    for (int di = 0; di < 4; ++di) {
      st.o[di][ni][0] *= corr; st.o[di][ni][1] *= corr; st.o[di][ni][2] *= corr; st.o[di][ni][3] *= corr;
    }
    pf[ni][0] = __builtin_bit_cast(bf16x8, wa);
    pf[ni][1] = __builtin_bit_cast(bf16x8, wb);
  }
  attn_pv<NI>(Vs, pf, st.o);
}

template <int NI>
DEV void attn_softmax_pv_act(const bf16* Vs, f32x4 (&s)[4][NI], AttnSt<NI>& st, const bool (&act)[NI]) {
  bf16x8 pf[NI][2];
#pragma unroll
  for (int ni = 0; ni < NI; ++ni) {
    pf[ni][0] = bf16x8{0, 0, 0, 0, 0, 0, 0, 0};
    pf[ni][1] = bf16x8{0, 0, 0, 0, 0, 0, 0, 0};
    if (act[ni]) {
      float mx = -INFINITY;
#pragma unroll
      for (int mi = 0; mi < 4; ++mi)
        mx = fmaxf(fmaxf(mx, fmaxf(s[mi][ni][0], s[mi][ni][1])), fmaxf(s[mi][ni][2], s[mi][ni][3]));
      mx = fmaxf(mx, shx(mx, 16));
      mx = fmaxf(mx, shx(mx, 32));
      const float mn = fmaxf(st.m[ni], mx);
      const float mu = (mn == -INFINITY) ? 0.f : mn;
      const float corr = __builtin_amdgcn_exp2f((st.m[ni] - mu) * C2);
      st.m[ni] = mn;
      const float nm = -mu * C2;
      float ps = 0.f;
      u32x4_t wa, wb;
      unsigned t0, t1;
      exp4_pack(s[0][ni], nm, ps, t0, t1); wa.x = t0; wa.y = t1;
      exp4_pack(s[1][ni], nm, ps, t0, t1); wa.z = t0; wa.w = t1;
      exp4_pack(s[2][ni], nm, ps, t0, t1); wb.x = t0; wb.y = t1;
      exp4_pack(s[3][ni], nm, ps, t0, t1); wb.z = t0; wb.w = t1;
      st.l[ni] = st.l[ni] * corr + ps;
#pragma unroll
      for (int di = 0; di < 4; ++di) {
        st.o[di][ni][0] *= corr; st.o[di][ni][1] *= corr; st.o[di][ni][2] *= corr; st.o[di][ni][3] *= corr;
      }
      pf[ni][0] = __builtin_bit_cast(bf16x8, wa);
      pf[ni][1] = __builtin_bit_cast(bf16x8, wb);
    }
  }
  const int lane = tidx() & 63, g4 = lane >> 4, q4 = (lane & 15) >> 2, p4 = lane & 3;
#pragma unroll
  for (int di = 0; di < 4; ++di) {
#pragma unroll
    for (int ks2 = 0; ks2 < 2; ++ks2) {
      v4i16_t v0 = lds_tr16(Vs + (ks2 * 32 + g4 * 4 + q4) * KT_LD + di * 16 + p4 * 4);
      v4i16_t v1 = lds_tr16(Vs + (ks2 * 32 + 16 + g4 * 4 + q4) * KT_LD + di * 16 + p4 * 4);
      bf16x8 vf = __builtin_shufflevector(v0, v1, 0, 1, 2, 3, 4, 5, 6, 7);
#pragma unroll
      for (int ni = 0; ni < NI; ++ni)
        if (act[ni]) st.o[di][ni] = MFMA16(vf, pf[ni][ks2], st.o[di][ni]);
    }
  }
}
template <int NI>
DEV int gate_top1(f32x4 (&gs)[4][NI], int ni, int g4) {
  float bv = -INFINITY;
  int bi = 1 << 20;
#pragma unroll
  for (int mi = 0; mi < 4; ++mi)
#pragma unroll
    for (int r = 0; r < 4; ++r) {
      float v = gs[mi][ni][r];
      if (v > bv) { bv = v; bi = mi * 16 + g4 * 4 + r; }
    }
#pragma unroll
  for (int off = 16; off <= 32; off <<= 1) {
    float ov = shx(bv, off);
    int oi = shx(bi, off);
    if (ov > bv || (ov == bv && oi < bi)) { bv = ov; bi = oi; }
  }
#pragma unroll
  for (int mi = 0; mi < 4; ++mi)
#pragma unroll
    for (int r = 0; r < 4; ++r)
      if (mi * 16 + g4 * 4 + r == bi) gs[mi][ni][r] = -INFINITY;
  return (bv == -INFINITY) ? -1 : bi;
}
template <int NI>
DEV void moba_mfma_item(const Params& p, int item, char* smem, bf16* outbuf) {
  constexpr int QB = 64 * NI;
  bf16* sm = (bf16*)smem;
  const int bh = item & 15, cq = (S / QB - 1) - (item >> 4);
  const int b = bh >> 3, h = bh & 7;
  const int s0 = cq * QB, blk = s0 >> 8;
  const int lane = tidx() & 63, wave = tidx() >> 6, g4 = lane >> 4, c16 = lane & 15;
  const bf16* proj = (const bf16*)(p.ws + OFF_PROJ) + (size_t)b * S * PC;
  bf16x8 qf[NI][2];
  int tq[NI];
#pragma unroll
  for (int ni = 0; ni < NI; ++ni) {
    tq[ni] = s0 + wave * 16 * NI + ni * 16 + c16;
#pragma unroll
    for (int ks = 0; ks < 2; ++ks)
      qf[ni][ks] = *(const bf16x8*)(proj + (size_t)tq[ni] * PC + C_MQ + h * 64 + ks * 32 + g4 * 8);
  }
  int i0[NI], i1[NI], i2[NI];
  {
    const bf16* kmh = (const bf16*)(p.ws + OFF_KMHL) + ((size_t)(b * 8 + h) * 64) * 64;
    const bf16* kml = kmh + (size_t)2 * 8 * 64 * 64;
    f32x4 gs[4][NI];
#pragma unroll
    for (int mi = 0; mi < 4; ++mi) {
#pragma unroll
      for (int ni = 0; ni < NI; ++ni) gs[mi][ni] = f32x4{0.f, 0.f, 0.f, 0.f};
#pragma unroll
      for (int ks = 0; ks < 2; ++ks) {
        bf16x8 ah = *(const bf16x8*)(kmh + (mi * 16 + c16) * 64 + ks * 32 + g4 * 8);
        bf16x8 al_ = *(const bf16x8*)(kml + (mi * 16 + c16) * 64 + ks * 32 + g4 * 8);
#pragma unroll
        for (int ni = 0; ni < NI; ++ni) {
          gs[mi][ni] = MFMA16(ah, qf[ni][ks], gs[mi][ni]);
          gs[mi][ni] = MFMA16(al_, qf[ni][ks], gs[mi][ni]);
        }
      }
    }
#pragma unroll
    for (int ni = 0; ni < NI; ++ni) {
#pragma unroll
      for (int mi = 0; mi < 4; ++mi)
#pragma unroll
        for (int r = 0; r < 4; ++r)
          if (mi * 16 + g4 * 4 + r >= blk) gs[mi][ni][r] = -INFINITY;
      i0[ni] = gate_top1(gs, ni, g4);
      i1[ni] = gate_top1(gs, ni, g4);
      i2[ni] = gate_top1(gs, ni, g4);
    }
  }
  AttnSt<NI> st;
  attn_init<NI>(st);
  const int ntiles = (s0 + QB) >> 6;
  const bf16* kb = (const bf16*)(p.ws + OFF_MKB) + ((size_t)(b * 8 + h) * S) * 64;
  const bf16* vb = (const bf16*)(p.ws + OFF_MVB) + ((size_t)(b * 8 + h) * S) * 64;
  bf16* smkv = sm;
  __syncthreads();
#define MOBA_KEY(i) ((i) * 64)
  KV_SWEEP(kb, vb, 64, ntiles, MOBA_KEY,
    const int n = it >> 2;
    const bool own = (n == blk);
    const int kbase = it * 64;
    bool wave_active = own;
    if (!own) {
      bool anyq = false;
      _Pragma("unroll") for (int ni = 0; ni < NI; ++ni) anyq = anyq || (n == i0[ni]) || (n == i1[ni]) || (n == i2[ni]);
      wave_active = __builtin_amdgcn_ballot_w64(anyq) != 0ull;
    }
    if (wave_active) {
      f32x4 s[4][NI];
      attn_scores<NI>(Ks, qf, s);
      _Pragma("unroll") for (int ni = 0; ni < NI; ++ni) {
        if (own) {
          _Pragma("unroll") for (int mi = 0; mi < 4; ++mi)
            _Pragma("unroll") for (int r = 0; r < 4; ++r)
              if (kbase + mi * 16 + g4 * 4 + r > tq[ni]) s[mi][ni][r] = -INFINITY;
        } else {
          const bool okb = (n == i0[ni]) | (n == i1[ni]) | (n == i2[ni]);
          if (!okb) {
            _Pragma("unroll") for (int mi = 0; mi < 4; ++mi) s[mi][ni] = f32x4{-INFINITY, -INFINITY, -INFINITY, -INFINITY};
          }
        }
      }
      attn_softmax_pv<NI>(Ks + KT_ELEMS, s, st);
    }
  )
#pragma unroll
  for (int ni = 0; ni < NI; ++ni) {
    float l = st.l[ni];
    l += shx(l, 16);
    l += shx(l, 32);
    const float inv = 1.f / l;
    bf16* op = outbuf + ((size_t)b * S + tq[ni]) * 512 + h * 64 + g4 * 4;
#pragma unroll
    for (int di = 0; di < 4; ++di) {
      uint2 pk;
      pk.x = cvtpk(st.o[di][ni][0] * inv, st.o[di][ni][1] * inv);
      pk.y = cvtpk(st.o[di][ni][2] * inv, st.o[di][ni][3] * inv);
      *(uint2*)(op + di * 16) = pk;
    }
  }
}

DEV int moba_list_base(int n) { return n * S - 128 * n * (n + 1); }
template <int NI>
DEV void moba_gate_batch(const Params& p, int item0, int istride, int nitems, int* sm) {
  constexpr int QB = 64 * NI;
  constexpr int MAXB = 4;
  const int tid = tidx(), lane = tid & 63, wave = tid >> 6, g4 = lane >> 4, c16 = lane & 15;
  int* hist = sm;
  int* base = sm + MAXB * 64;
  hist[tid] = 0;
  __syncthreads();
  int sel[MAXB][NI][3], rk[MAXB][NI][3], tqs[MAXB][NI];
#pragma unroll
  for (int j = 0; j < MAXB; ++j) {
    const int item = item0 + j * istride;
    const int bh = item & 15, cq = item >> 4;
    const int b = bh >> 3, h = bh & 7;
    const int s0 = cq * QB, blk = s0 >> 8;
    const bool live = (j < nitems) && (blk > 0);
#pragma unroll
    for (int ni = 0; ni < NI; ++ni) {
      tqs[j][ni] = s0 + wave * 16 * NI + ni * 16 + c16;
#pragma unroll
      for (int k = 0; k < 3; ++k) { sel[j][ni][k] = -1; rk[j][ni][k] = 0; }
    }
    if (!live) continue;
    const bf16* proj = (const bf16*)(p.ws + OFF_PROJ) + (size_t)b * S * PC;
    bf16x8 qf[NI][2];
#pragma unroll
    for (int ni = 0; ni < NI; ++ni)
#pragma unroll
      for (int ks = 0; ks < 2; ++ks)
        qf[ni][ks] = *(const bf16x8*)(proj + (size_t)tqs[j][ni] * PC + C_MQ + h * 64 + ks * 32 + g4 * 8);
    const bf16* kmh = (const bf16*)(p.ws + OFF_KMHL) + ((size_t)(b * 8 + h) * 64) * 64;
    const bf16* kml = kmh + (size_t)2 * 8 * 64 * 64;
    f32x4 gs[4][NI];
#pragma unroll
    for (int mi = 0; mi < 4; ++mi) {
#pragma unroll
      for (int ni = 0; ni < NI; ++ni) gs[mi][ni] = f32x4{0.f, 0.f, 0.f, 0.f};
#pragma unroll
      for (int ks = 0; ks < 2; ++ks) {
        bf16x8 ah = *(const bf16x8*)(kmh + (mi * 16 + c16) * 64 + ks * 32 + g4 * 8);
        bf16x8 al_ = *(const bf16x8*)(kml + (mi * 16 + c16) * 64 + ks * 32 + g4 * 8);
#pragma unroll
        for (int ni = 0; ni < NI; ++ni) {
          gs[mi][ni] = MFMA16(ah, qf[ni][ks], gs[mi][ni]);
          gs[mi][ni] = MFMA16(al_, qf[ni][ks], gs[mi][ni]);
        }
      }
    }
#pragma unroll
    for (int ni = 0; ni < NI; ++ni) {
#pragma unroll
      for (int mi = 0; mi < 4; ++mi)
#pragma unroll
        for (int r = 0; r < 4; ++r)
          if (mi * 16 + g4 * 4 + r >= blk) gs[mi][ni][r] = -INFINITY;
#pragma unroll
      for (int k = 0; k < 3; ++k) {
        sel[j][ni][k] = gate_top1(gs, ni, g4);
        rk[j][ni][k] = (g4 == 0 && sel[j][ni][k] >= 0) ? atomicAdd(&hist[j * 64 + sel[j][ni][k]], 1) : 0;
      }
    }
  }
  __syncthreads();
  {
    const int j = tid >> 6, n = tid & 63;
    const int item = item0 + j * istride;
    const int c = hist[tid];
    int* cnt = (int*)(p.ws + OFF_MCNT) + (size_t)(item & 15) * 64 * MCNT_STRIDE;
    base[tid] = (c > 0) ? atomicAdd(cnt + n * MCNT_STRIDE, c) : 0;
  }
  __syncthreads();
  if (g4 == 0) {
#pragma unroll
    for (int j = 0; j < MAXB; ++j) {
      const int item = item0 + j * istride;
      unsigned short* lists = (unsigned short*)(p.ws + OFF_MLIST) + (size_t)(item & 15) * MLIST_PER_BH;
#pragma unroll
      for (int ni = 0; ni < NI; ++ni)
#pragma unroll
        for (int k = 0; k < 3; ++k) {
          const int sv = sel[j][ni][k];
          if (sv >= 0) lists[moba_list_base(sv) + base[j * 64 + sv] + rk[j][ni][k]] = (unsigned short)(tqs[j][ni] | (k << 14));
        }
    }
  }
  __syncthreads();
}
template <int NI>
DEV void moba_part_item(const Params& p, int b, int item, char* smem) {
  constexpr int CH = 64 * NI;
  bf16* smkv = (bf16*)smem;
  const int n = item >> 6, h = (item >> 3) & 7, part = item & 7;
  const int lane = tidx() & 63, wave = tidx() >> 6, g4 = lane >> 4, c16 = lane & 15;
  const int cnt = ((const int*)(p.ws + OFF_MCNT))[((b * 8 + h) * 64 + n) * MCNT_STRIDE];
  const unsigned short* list = (const unsigned short*)(p.ws + OFF_MLIST) + (size_t)(b * 8 + h) * MLIST_PER_BH + moba_list_base(n);
  const bf16* proj = (const bf16*)(p.ws + OFF_PROJ) + (size_t)b * S * PC;
  const bf16* kb = (const bf16*)(p.ws + OFF_MKB) + ((size_t)(b * 8 + h) * S + n * 256) * 64;
  const bf16* vb = (const bf16*)(p.ws + OFF_MVB) + ((size_t)(b * 8 + h) * S + n * 256) * 64;
  bf16* po = (bf16*)(p.ws + OFF_MPO);
  float2* pml = (float2*)(p.ws + OFF_MPML);
  for (int c = part; c * CH < cnt; c += 8) {
    bf16x8 qf[NI][2];
    int tcol[NI], slot[NI];
    bool valid[NI];
#pragma unroll
    for (int ni = 0; ni < NI; ++ni) {
      const int idx = c * CH + wave * 16 * NI + ni * 16 + c16;
      valid[ni] = idx < cnt;
      const unsigned e = list[valid[ni] ? idx : 0];
      tcol[ni] = e & 0x3FFF;
      slot[ni] = e >> 14;
#pragma unroll
      for (int ks = 0; ks < 2; ++ks)
        qf[ni][ks] = *(const bf16x8*)(proj + (size_t)tcol[ni] * PC + C_MQ + h * 64 + ks * 32 + g4 * 8);
    }
    AttnSt<NI> st;
    attn_init<NI>(st);
    __syncthreads();
#define MOBA_PKEY(i) ((i) * 64)
    KV_SWEEP(kb, vb, 64, 4, MOBA_PKEY,
      f32x4 s[4][NI];
      attn_scores<NI>(Ks, qf, s);
      attn_softmax_pv<NI>(Ks + KT_ELEMS, s, st);
    )
#pragma unroll
    for (int ni = 0; ni < NI; ++ni) {
      float l = st.l[ni];
      l += shx(l, 16);
      l += shx(l, 32);
      if (valid[ni]) {
        const size_t rec = ((size_t)h * S + tcol[ni]) * 3 + slot[ni];
        if (g4 == 0) pml[rec] = float2{st.m[ni], l};
        bf16* op = po + rec * 64 + g4 * 4;
#pragma unroll
        for (int di = 0; di < 4; ++di) {
          uint2 pk;
          pk.x = cvtpk(st.o[di][ni][0], st.o[di][ni][1]);
          pk.y = cvtpk(st.o[di][ni][2], st.o[di][ni][3]);
          *(uint2*)(op + di * 16) = pk;
        }
      }
    }
  }
}
template <int NI>
DEV void moba_part_item2(const Params& p, int b, int item, char* smem) {
  constexpr int WCH = 16 * NI;
  bf16* Kall = (bf16*)smem;
  bf16* Vall = Kall + 256 * KT_LD;
  static_assert(2 * 256 * KT_LD * 2 <= SMEM_BYTES, "moba block staging");
  constexpr int NPART = MOBA_NPART;
  const int n = item / (8 * NPART), h = (item / NPART) & 7, part = item % NPART;
  const int tid = tidx(), lane = tid & 63, wave = tid >> 6, g4 = lane >> 4, c16 = lane & 15;
  const int cnt = ((const int*)(p.ws + OFF_MCNT))[((b * 8 + h) * 64 + n) * MCNT_STRIDE];
  const bool active = part * 4 * WCH < cnt;
  const unsigned short* list = (const unsigned short*)(p.ws + OFF_MLIST) + (size_t)(b * 8 + h) * MLIST_PER_BH + moba_list_base(n);
  const bf16* proj = (const bf16*)(p.ws + OFF_PROJ) + (size_t)b * S * PC;
  const bf16* kb = (const bf16*)(p.ws + OFF_MKB) + ((size_t)(b * 8 + h) * S + n * 256) * 64;
  const bf16* vb = (const bf16*)(p.ws + OFF_MVB) + ((size_t)(b * 8 + h) * S + n * 256) * 64;
  bf16* po = (bf16*)(p.ws + OFF_MPO);
  float2* pml = (float2*)(p.ws + OFF_MPML);
  __syncthreads();
  if (active) {
#pragma unroll
    for (int i = 0; i < 8; ++i) {
      const int id = tid + 256 * i, r = id >> 3, c = (id & 7) * 8;
      const uint4 kv = *(const uint4*)(kb + (size_t)r * 64 + c);
      const uint4 vv = *(const uint4*)(vb + (size_t)r * 64 + c);
      *(uint4*)(Kall + r * KT_LD + c) = kv;
      *(uint4*)(Vall + r * KT_LD + c) = vv;
    }
  }
  __syncthreads();
  if (!active) return;
  for (int wc = part * 4 + wave; wc * WCH < cnt; wc += 4 * NPART) {
    bf16x8 qf[NI][2];
    int tcol[NI], slot[NI];
    bool valid[NI];
#pragma unroll
    for (int ni = 0; ni < NI; ++ni) {
      const int idx = wc * WCH + ni * 16 + c16;
      valid[ni] = idx < cnt;
      const unsigned e = list[valid[ni] ? idx : 0];
      tcol[ni] = e & 0x3FFF;
      slot[ni] = e >> 14;
#pragma unroll
      for (int ks = 0; ks < 2; ++ks)
        qf[ni][ks] = *(const bf16x8*)(proj + (size_t)tcol[ni] * PC + C_MQ + h * 64 + ks * 32 + g4 * 8);
    }
    AttnSt<NI> st;
    attn_init<NI>(st);
#pragma unroll 1
    for (int kt = 0; kt < 4; ++kt) {
      f32x4 s[4][NI];
      attn_scores<NI>(Kall + kt * 64 * KT_LD, qf, s);
      attn_softmax_pv<NI>(Vall + kt * 64 * KT_LD, s, st);
    }
#pragma unroll
    for (int ni = 0; ni < NI; ++ni) {
      float l = st.l[ni];
      l += shx(l, 16);
      l += shx(l, 32);
      if (valid[ni]) {
        const size_t rec = ((size_t)h * S + tcol[ni]) * 3 + slot[ni];
        if (g4 == 0) pml[rec] = float2{st.m[ni], l};
        bf16* op = po + rec * 64 + g4 * 4;
#pragma unroll
        for (int di = 0; di < 4; ++di) {
          uint2 pk;
          pk.x = cvtpk(st.o[di][ni][0], st.o[di][ni][1]);
          pk.y = cvtpk(st.o[di][ni][2], st.o[di][ni][3]);
          *(uint2*)(op + di * 16) = pk;
        }
      }
    }
  }
}
template <int NI>
DEV void moba_merge_item(const Params& p, int b, int item, char* smem, bf16* outbuf) {
  constexpr int QB = 64 * NI;
  constexpr int NCQ = S / QB;
  bf16* smkv = (bf16*)smem;
  const int h = item & 7, cq = item >> 3;
  static_assert(NCQ * 8 == 8 * (S / QB), "");
  const int s0 = cq * QB, blk = s0 >> 8;
  const int lane = tidx() & 63, wave = tidx() >> 6, g4 = lane >> 4, c16 = lane & 15;
  const bf16* proj = (const bf16*)(p.ws + OFF_PROJ) + (size_t)b * S * PC;
  bf16x8 qf[NI][2];
  int tq[NI];
#pragma unroll
  for (int ni = 0; ni < NI; ++ni) {
    tq[ni] = s0 + wave * 16 * NI + ni * 16 + c16;
#pragma unroll
    for (int ks = 0; ks < 2; ++ks)
      qf[ni][ks] = *(const bf16x8*)(proj + (size_t)tq[ni] * PC + C_MQ + h * 64 + ks * 32 + g4 * 8);
  }
  const bf16* kb = (const bf16*)(p.ws + OFF_MKB) + ((size_t)(b * 8 + h) * S) * 64;
  const bf16* vb = (const bf16*)(p.ws + OFF_MVB) + ((size_t)(b * 8 + h) * S) * 64;
  AttnSt<NI> st;
  attn_init<NI>(st);
  const int kt0 = blk * 4;
  const int ntl = ((s0 + QB - 1) >> 6) - kt0 + 1;
  __syncthreads();
#define MOBA_MKEY(i) ((kt0 + (i)) * 64)
  KV_SWEEP(kb, vb, 64, ntl, MOBA_MKEY,
    const int kbase = (kt0 + it) * 64;
    f32x4 s[4][NI];
    attn_scores<NI>(Ks, qf, s);
    _Pragma("unroll") for (int ni = 0; ni < NI; ++ni)
      _Pragma("unroll") for (int mi = 0; mi < 4; ++mi)
        _Pragma("unroll") for (int r = 0; r < 4; ++r)
          if (kbase + mi * 16 + g4 * 4 + r > tq[ni]) s[mi][ni][r] = -INFINITY;
    attn_softmax_pv<NI>(Ks + KT_ELEMS, s, st);
  )
  const int nsl = (blk < 3) ? blk : 3;
  const bf16* po = (const bf16*)(p.ws + OFF_MPO);
  const float2* pml = (const float2*)(p.ws + OFF_MPML);
#pragma unroll
  for (int ni = 0; ni < NI; ++ni) {
    float l = st.l[ni];
    l += shx(l, 16);
    l += shx(l, 32);
    const size_t rec0 = ((size_t)h * S + tq[ni]) * 3;
    float ms[3], ls[3];
    float M = st.m[ni];
#pragma unroll
    for (int s = 0; s < 3; ++s) {
      ms[s] = -INFINITY;
      ls[s] = 0.f;
      if (s < nsl) {
        const float2 v = pml[rec0 + s];
        ms[s] = v.x;
        ls[s] = v.y;
        M = fmaxf(M, v.x);
      }
    }
    const float fo = __builtin_amdgcn_exp2f((st.m[ni] - M) * C2);
    l *= fo;
    float f[3];
#pragma unroll
    for (int s = 0; s < 3; ++s) {
      f[s] = (s < nsl) ? __builtin_amdgcn_exp2f((ms[s] - M) * C2) : 0.f;
      l += ls[s] * f[s];
    }
    const float inv = 1.f / l;
    bf16* op = outbuf + ((size_t)b * S + tq[ni]) * 512 + h * 64 + g4 * 4;
#pragma unroll
    for (int di = 0; di < 4; ++di) {
      float o0 = st.o[di][ni][0] * fo, o1 = st.o[di][ni][1] * fo, o2 = st.o[di][ni][2] * fo, o3 = st.o[di][ni][3] * fo;
#pragma unroll
      for (int s = 0; s < 3; ++s) {
        if (s < nsl) {
          const uint2 pv = *(const uint2*)(po + (rec0 + s) * 64 + di * 16 + g4 * 4);
          o0 += f[s] * __uint_as_float(pv.x << 16);
          o1 += f[s] * __uint_as_float(pv.x & 0xffff0000u);
          o2 += f[s] * __uint_as_float(pv.y << 16);
          o3 += f[s] * __uint_as_float(pv.y & 0xffff0000u);
        }
      }
      uint2 pk;
      pk.x = cvtpk(o0 * inv, o1 * inv);
      pk.y = cvtpk(o2 * inv, o3 * inv);
      *(uint2*)(op + di * 16) = pk;
    }
  }
}

template <int NI>
DEV void attn_stats(f32x4 (&s)[4][NI], float (&m)[NI], float (&l)[NI]) {
#pragma unroll
  for (int ni = 0; ni < NI; ++ni) {
    float mx = -INFINITY;
#pragma unroll
    for (int mi = 0; mi < 4; ++mi)
      mx = fmaxf(fmaxf(mx, fmaxf(s[mi][ni][0], s[mi][ni][1])), fmaxf(s[mi][ni][2], s[mi][ni][3]));
    mx = fmaxf(mx, shx(mx, 16));
    mx = fmaxf(mx, shx(mx, 32));
    const float mn = fmaxf(m[ni], mx);
    const float mu = (mn == -INFINITY) ? 0.f : mn;
    const float corr = __builtin_amdgcn_exp2f((m[ni] - mu) * C2);
    m[ni] = mn;
    const float nm = -mu * C2;
    float ps = 0.f;
#pragma unroll
    for (int mi = 0; mi < 4; ++mi)
#pragma unroll
      for (int r = 0; r < 4; ++r) ps += __builtin_amdgcn_exp2f(__builtin_fmaf(s[mi][ni][r], C2, nm));
    l[ni] = l[ni] * corr + ps;
  }
}
DEV bf16x8 rope_frag(bf16x8 qv, const float* __restrict__ rope_t, int g4) {
  u32x4_t w = __builtin_bit_cast(u32x4_t, qv);
  u32x4_t pw;
  pw.x = shx(w.x, 16); pw.y = shx(w.y, 16); pw.z = shx(w.z, 16); pw.w = shx(w.w, 16);
  float f[8], pf[8];
  unpack8(uint4{w.x, w.y, w.z, w.w}, f);
  unpack8(uint4{pw.x, pw.y, pw.z, pw.w}, pf);
  const float4 c0 = *(const float4*)(rope_t), c1 = *(const float4*)(rope_t + 4);
  const float4 s0 = *(const float4*)(rope_t + 8), s1 = *(const float4*)(rope_t + 12);
  const float cs[8] = {c0.x, c0.y, c0.z, c0.w, c1.x, c1.y, c1.z, c1.w};
  const float sn[8] = {s0.x, s0.y, s0.z, s0.w, s1.x, s1.y, s1.z, s1.w};
  const float sg = (g4 == 0) ? -1.f : 1.f;
  float o[8];
#pragma unroll
  for (int i = 0; i < 8; ++i) o[i] = (g4 < 2) ? (f[i] * cs[i] + sg * pf[i] * sn[i]) : f[i];
  u32x4_t r;
  r.x = cvtpk(o[0], o[1]); r.y = cvtpk(o[2], o[3]); r.z = cvtpk(o[4], o[5]); r.w = cvtpk(o[6], o[7]);
  return __builtin_bit_cast(bf16x8, r);
}

DEV unsigned pack4_fp8q(float a, float b, float c, float d) {
  int q = __builtin_amdgcn_cvt_pk_fp8_f32(a, b, 0, false);
  q = __builtin_amdgcn_cvt_pk_fp8_f32(c, d, q, true);
  return (unsigned)q;
}
DEV float amax8_bf16(uint4 v, float m) {
  float f[8];
  unpack8(v, f);
#pragma unroll
  for (int i = 0; i < 8; ++i) m = fmaxf(m, fabsf(f[i]));
  return m;
}
DEV void kvamax_item(const Params& p, int layer, int item) {
  const int tid = tidx();
  const int bk = item >> 6, part = item & 63;
  const bf16* kp = (const bf16*)(p.ws + OFF_KSB) + ((size_t)bk * S + part * 256) * 64 + tid * 64;
  const bf16* vp = (const bf16*)(p.ws + OFF_VSB) + ((size_t)bk * S + part * 256) * 64 + tid * 64;
  float mk = 0.f, mv = 0.f;
#pragma unroll
  for (int i = 0; i < 8; ++i) {
    mk = amax8_bf16(*(const uint4*)(kp + i * 8), mk);
    mv = amax8_bf16(*(const uint4*)(vp + i * 8), mv);
  }
#pragma unroll
  for (int o = 32; o >= 1; o >>= 1) { mk = fmaxf(mk, shx(mk, o)); mv = fmaxf(mv, shx(mv, o)); }
  if ((tid & 63) == 0) {
    atomicMax((unsigned*)(p.ws + OFF_BAR) + 2 + 2 * layer, (unsigned)__float_as_int(mk));
    atomicMax((unsigned*)(p.ws + OFF_BAR) + 3 + 2 * layer, (unsigned)__float_as_int(mv));
  }
}
DEV float kv_amax(const Params& p, int layer, int which) {
  return __int_as_float((int)__hip_atomic_load((const unsigned*)(p.ws + OFF_BAR) + 2 + 2 * layer + which, __ATOMIC_RELAXED, __HIP_MEMORY_SCOPE_AGENT));
}
DEV void kvq_item(const Params& p, int layer, int item, float* sm) {
  const int tid = tidx();
  const int bk = item >> 8, blk = item & 255;
  const float ak = kv_amax(p, layer, 0), av = kv_amax(p, layer, 1);
  const float ik = (ak > 0.f) ? 224.f / ak : 0.f, iv = (av > 0.f) ? 224.f / av : 0.f;
  const size_t row0 = (size_t)bk * S + blk * 64;
  {
    const int r = tid >> 2, q = tid & 3;
    const bf16* kp = (const bf16*)(p.ws + OFF_KSB) + (row0 + r) * 64 + q * 16;
    float f[16];
    unpack8(*(const uint4*)kp, f);
    unpack8(*(const uint4*)(kp + 8), f + 8);
    uint2 o0, o1;
    o0.x = pack4_fp8q(f[0] * ik, f[1] * ik, f[2] * ik, f[3] * ik);
    o0.y = pack4_fp8q(f[4] * ik, f[5] * ik, f[6] * ik, f[7] * ik);
    o1.x = pack4_fp8q(f[8] * ik, f[9] * ik, f[10] * ik, f[11] * ik);
    o1.y = pack4_fp8q(f[12] * ik, f[13] * ik, f[14] * ik, f[15] * ik);
    unsigned char* kd = (unsigned char*)(p.ws + OFF_KS8) + (row0 + r) * 64 + 32 * (q & 1) + 8 * (q >> 1);
    *(uint2*)kd = o0;
    *(uint2*)(kd + 16) = o1;
    const bf16* vp = (const bf16*)(p.ws + OFF_VSB) + (row0 + r) * 64 + q * 16;
    unpack8(*(const uint4*)vp, f);
    unpack8(*(const uint4*)(vp + 8), f + 8);
#pragma unroll
    for (int i = 0; i < 16; ++i) sm[r * 65 + q * 16 + i] = f[i] * iv;
  }
  __syncthreads();
  {
    const int d = tid >> 2, q = tid & 3;
    float f[16];
#pragma unroll
    for (int i = 0; i < 16; ++i) {
      const int g4 = q, ks2 = i >> 3, j = i & 7;
      const int key = 32 * ks2 + 16 * (j >> 2) + 4 * g4 + (j & 3);
      f[i] = sm[key * 65 + d];
    }
    uint4 o;
    o.x = pack4_fp8q(f[0], f[1], f[2], f[3]);
    o.y = pack4_fp8q(f[4], f[5], f[6], f[7]);
    o.z = pack4_fp8q(f[8], f[9], f[10], f[11]);
    o.w = pack4_fp8q(f[12], f[13], f[14], f[15]);
    *(uint4*)((unsigned char*)(p.ws + OFF_VT8) + row0 * 64 + d * 64 + q * 16) = o;
  }
  __syncthreads();
}
typedef long i64_t;
#define MFMA8(a, b, c) __builtin_amdgcn_mfma_f32_16x16x32_fp8_fp8(a, b, c, 0, 0, 0)
template <int NI>
DEV void softmax_one8(f32x4 (&s)[4], AttnSt<NI>& st, f32x4& lacc, int ni, float c2, bool sel, i64_t& pf0, i64_t& pf1) {
  float mx = -INFINITY;
#pragma unroll
  for (int mi = 0; mi < 4; ++mi)
    mx = fmaxf(fmaxf(mx, fmaxf(s[mi][0], s[mi][1])), fmaxf(s[mi][2], s[mi][3]));
  mx = fmaxf(mx, shx(mx, 16));
  mx = fmaxf(mx, shx(mx, 32));
  const float mxs = sel ? mx * c2 : -INFINITY;
  if (__builtin_amdgcn_ballot_w64(mxs > st.m[ni] + 1.0f) != 0ull) {
    const float mn = fmaxf(st.m[ni], mxs);
    const float mu = (mn == -INFINITY) ? 0.f : mn;
    const float corr = __builtin_amdgcn_exp2f(st.m[ni] - mu);
    st.m[ni] = mn;
    lacc[0] *= corr; lacc[1] *= corr; lacc[2] *= corr; lacc[3] *= corr;
#pragma unroll
    for (int di = 0; di < 4; ++di) {
      st.o[di][ni][0] *= corr; st.o[di][ni][1] *= corr; st.o[di][ni][2] *= corr; st.o[di][ni][3] *= corr;
    }
  }
  const float nm = (sel && st.m[ni] > -INFINITY) ? 7.f - st.m[ni] : -INFINITY;
  unsigned w[4];
#pragma unroll
  for (int mi = 0; mi < 4; ++mi) {
    const float p0 = __builtin_amdgcn_exp2f(__builtin_fmaf(s[mi][0], c2, nm));
    const float p1 = __builtin_amdgcn_exp2f(__builtin_fmaf(s[mi][1], c2, nm));
    const float p2 = __builtin_amdgcn_exp2f(__builtin_fmaf(s[mi][2], c2, nm));
    const float p3 = __builtin_amdgcn_exp2f(__builtin_fmaf(s[mi][3], c2, nm));
    w[mi] = pack4_fp8q(p0, p1, p2, p3);
  }
  pf0 = (i64_t)(((unsigned long long)w[1] << 32) | (unsigned long long)w[0]);
  pf1 = (i64_t)(((unsigned long long)w[3] << 32) | (unsigned long long)w[2]);
  const i64_t ones = 0x3838383838383838ll;
  lacc = MFMA8(ones, pf0, lacc);
  lacc = MFMA8(ones, pf1, lacc);
}
template <int NI>
DEV void nsa_item(const Params& p, int layer, int item, char* smem, bf16* outbuf) {
  constexpr int QN = 16 * NI;
  constexpr int NCH = S / QN;
  bf16* smkv = (bf16*)smem;
  float* imp = (float*)(smem + 36864);
  int* sel = (int*)(smem + 36864 + QN * 257 * 4);
  unsigned* bmq = (unsigned*)(sel + QN * 16);
  unsigned* bmu = bmq + QN * 8;
  int* ulist = (int*)(bmu + 4 * NI * 8);
  static_assert(36864 + QN * 257 * 4 + QN * 16 * 4 + QN * 8 * 4 + 4 * NI * 8 * 4 + 257 * 4 <= SMEM_BYTES, "nsa lds");
  static_assert(NI == 2, "per-wave union bitmaps use bmu[8 .. 40)");
  const int tid = tidx(), lane = tid & 63, wave = tid >> 6, g4 = lane >> 4, c16 = lane & 15;
  const int bk = item & 3, cq = (NCH - 1) - (item >> 2);
  const int b = bk >> 1, kvh = bk & 1;
  const int s0 = cq * QN, cur = s0 >> 6;
  if (PROBE_NSA && b == 1) return;
  const bf16* proj = (const bf16*)(p.ws + OFF_PROJ) + (size_t)b * S * PC;
  const float* rope = (const float*)(p.ws + OFF_ROPE);
  int tq[NI], qlv[NI];
  float gate0[NI], gate1[NI], gate2[NI];
  bf16x8 qraw[NI][2], qrot[NI][2];
#pragma unroll
  for (int ni = 0; ni < NI; ++ni) {
    const int R = wave * 16 * NI + ni * 16 + c16;
    qlv[ni] = R >> 2;
    const int g = R & 3;
    tq[ni] = s0 + qlv[ni];
    const bf16* qp = proj + (size_t)tq[ni] * PC + C_NQ + (kvh * 4 + g) * 64 + g4 * 8;
    qraw[ni][0] = *(const bf16x8*)(qp);
    qraw[ni][1] = *(const bf16x8*)(qp + 32);
    qrot[ni][0] = rope_frag(qraw[ni][0], rope + (size_t)tq[ni] * 16, g4);
    qrot[ni][1] = qraw[ni][1];
    const bf16* gp = proj + (size_t)tq[ni] * PC + C_NG + (kvh * 4 + g) * 3;
    gate0[ni] = (!PROBE_NSA || (PROBE_NSA & 1)) ? sigmoidf_(bf2f(gp[0])) : 0.f;
    gate1[ni] = (!PROBE_NSA || (PROBE_NSA & 2)) ? sigmoidf_(bf2f(gp[1])) : 0.f;
    gate2[ni] = (!PROBE_NSA || (PROBE_NSA & 4)) ? sigmoidf_(bf2f(gp[2])) : 0.f;
  }
  for (int i = tid; i < QN * 257; i += 256) imp[i] = 0.f;
  for (int i = tid; i < QN * 8 + 4 * NI * 8; i += 256) bmq[i] = 0u;
  f32x4 acc[4][NI];
#pragma unroll
  for (int ni = 0; ni < NI; ++ni)
#pragma unroll
    for (int di = 0; di < 4; ++di) acc[di][ni] = f32x4{0.f, 0.f, 0.f, 0.f};
  TILE_DECL;
  {
    int nv[NI];
#pragma unroll
    for (int ni = 0; ni < NI; ++ni) nv[ni] = (tq[ni] >= 31) ? (((tq[ni] - 31) >> 4) + 1) : 0;
    const int tlast = s0 + QN - 1;
    const int nvmax = (tlast >= 31) ? (((tlast - 31) >> 4) + 1) : 0;
    const int ntc = (nvmax + 63) >> 6;
    const bf16* kb = (const bf16*)(p.ws + OFF_KCB) + ((size_t)(b * 2 + kvh) * 1024) * 64;
    const bf16* vb = (const bf16*)(p.ws + OFF_VCB) + ((size_t)(b * 2 + kvh) * 1024) * 64;
    float mA[NI], lA[NI];
#pragma unroll
    for (int ni = 0; ni < NI; ++ni) { mA[ni] = -INFINITY; lA[ni] = 0.f; }
    __syncthreads();
    if (ntc > 0) {
      for (int rep_ = 0; rep_ < ((REP_NSA_PART & 1) ? 2 : 1); ++rep_) {
#pragma unroll
      for (int ni = 0; ni < NI; ++ni) { mA[ni] = -INFINITY; lA[ni] = 0.f; }
      TILE_GLOAD(kb, vb, 64, 0);
      TILE_SSTORE(smkv, smkv + KT_ELEMS);
      __syncthreads();
      for (int kt = 0; kt < ntc; ++kt) {
        if (kt + 1 < ntc) TILE_GLOAD(kb, vb, 64, (kt + 1) * 64);
        const bf16* Ks = smkv + (kt & 1) * 2 * KT_ELEMS;
        f32x4 s[4][NI];
        attn_scores<NI>(Ks, qraw, s);
#pragma unroll
        for (int ni = 0; ni < NI; ++ni)
#pragma unroll
          for (int mi = 0; mi < 4; ++mi)
#pragma unroll
            for (int r = 0; r < 4; ++r)
              if (kt * 64 + mi * 16 + g4 * 4 + r >= nv[ni]) s[mi][ni][r] = -INFINITY;
        attn_stats<NI>(s, mA, lA);
        if (kt + 1 < ntc) {
          bf16* Kn = smkv + ((kt + 1) & 1) * 2 * KT_ELEMS;
          TILE_SSTORE(Kn, Kn + KT_ELEMS);
        }
        __syncthreads();
      }
      }
      float nmB[NI];
#pragma unroll
      for (int ni = 0; ni < NI; ++ni) {
        float l = lA[ni];
        l += shx(l, 16);
        l += shx(l, 32);
        nmB[ni] = (l > 0.f) ? -(mA[ni] * C2 + __builtin_amdgcn_logf(l)) : 0.f;
      }
      TILE_GLOAD(kb, vb, 64, 0);
      TILE_SSTORE(smkv, smkv + KT_ELEMS);
      __syncthreads();
      for (int kt = 0; kt < ntc; ++kt) {
        if (kt + 1 < ntc) TILE_GLOAD(kb, vb, 64, (kt + 1) * 64);
        const bf16* Ks = smkv + (kt & 1) * 2 * KT_ELEMS;
        f32x4 s[4][NI];
        attn_scores<NI>(Ks, qraw, s);
        bf16x8 pf[NI][2];
#pragma unroll
        for (int ni = 0; ni < NI; ++ni) {
          u32x4_t wa, wb;
          float* irow = imp + qlv[ni] * 257 + kt * 16 + g4;
#pragma unroll
          for (int mi = 0; mi < 4; ++mi) {
            float pr[4];
#pragma unroll
            for (int r = 0; r < 4; ++r) {
              const bool ok = (kt * 64 + mi * 16 + g4 * 4 + r) < nv[ni];
              pr[r] = ok ? __builtin_amdgcn_exp2f(__builtin_fmaf(s[mi][ni][r], C2, nmB[ni])) : 0.f;
            }
            float mainv = pr[0] + pr[1] + pr[2] + 0.5f * pr[3];
            float spv = 0.5f * pr[3];
            mainv += shx(mainv, 1);
            mainv += shx(mainv, 2);
            spv += shx(spv, 1);
            spv += shx(spv, 2);
            if ((c16 & 3) == 0) {
              atomicAdd(irow + mi * 4, mainv);
              atomicAdd(irow + mi * 4 + 1, spv);
            }
            const unsigned w0 = cvtpk(pr[0], pr[1]), w1 = cvtpk(pr[2], pr[3]);
            if (mi == 0) { wa.x = w0; wa.y = w1; }
            if (mi == 1) { wa.z = w0; wa.w = w1; }
            if (mi == 2) { wb.x = w0; wb.y = w1; }
            if (mi == 3) { wb.z = w0; wb.w = w1; }
          }
          pf[ni][0] = __builtin_bit_cast(bf16x8, wa);
          pf[ni][1] = __builtin_bit_cast(bf16x8, wb);
        }
        attn_pv<NI>(Ks + KT_ELEMS, pf, acc);
        if (kt + 1 < ntc) {
          bf16* Kn = smkv + ((kt + 1) & 1) * 2 * KT_ELEMS;
          TILE_SSTORE(Kn, Kn + KT_ELEMS);
        }
        __syncthreads();
      }
    }
#pragma unroll
    for (int ni = 0; ni < NI; ++ni)
#pragma unroll
      for (int di = 0; di < 4; ++di) {
        acc[di][ni][0] *= gate0[ni]; acc[di][ni][1] *= gate0[ni]; acc[di][ni][2] *= gate0[ni]; acc[di][ni][3] *= gate0[ni];
      }
  }
  __syncthreads();
#if PROBE_NSA == 8
  if (b == 0 && kvh == 0)
    for (int i = tid; i < QN * 256; i += 256)
      ((float*)(p.ws + OFF_OMOBA))[(size_t)S * 256 + (size_t)(s0 + (i >> 8)) * 256 + (i & 255)] = imp[(i >> 8) * 257 + (i & 255)];
  __syncthreads();
#endif
#ifndef NSA_SEL_PAR
#define NSA_SEL_PAR 1
#endif
#if NSA_SEL_PAR
  static_assert(NI == 2, "one 8-lane group per query");
  if (cur >= 16) {
    const int qg = lane >> 3, j8 = lane & 7;
    const int qlg = wave * 4 * NI + qg;
    const float* row = imp + qlg * 257;
    unsigned key[32];
#pragma unroll
    for (int i = 0; i < 32; ++i) {
      const int n = j8 + 8 * i;
      const unsigned bits = (unsigned)__float_as_int(row[n]);
      key[i] = (n >= 1 && n <= cur - 2) ? ((bits & 0xFFFFFF00u) | (unsigned)(255 - n)) : 0u;
    }
    if (j8 == 0) { sel[qlg * 16 + 0] = 0; sel[qlg * 16 + 1] = cur - 1; sel[qlg * 16 + 2] = cur; }
#pragma unroll 1
    for (int rd = 3; rd < 16; ++rd) {
      unsigned m = 0u;
#pragma unroll
      for (int i = 0; i < 32; ++i) m = (key[i] > m) ? key[i] : m;
      { const unsigned o = (unsigned)__builtin_amdgcn_update_dpp(0, (int)m, 0xB1, 0xF, 0xF, true); m = o > m ? o : m; }
      { const unsigned o = (unsigned)__builtin_amdgcn_update_dpp(0, (int)m, 0x4E, 0xF, 0xF, true); m = o > m ? o : m; }
      { const unsigned o = (unsigned)__builtin_amdgcn_update_dpp(0, (int)m, 0x141, 0xF, 0xF, true); m = o > m ? o : m; }
      if (j8 == 0) sel[qlg * 16 + rd] = 255 - (int)(m & 255u);
#pragma unroll
      for (int i = 0; i < 32; ++i) key[i] = (key[i] == m) ? 0u : key[i];
    }
  }
#endif
  for (int qq = 0; qq < 4 * NI; ++qq) {
    const int ql = wave * 4 * NI + qq;
    int mysel = -1;
    if (cur < 16) {
      mysel = (lane <= cur) ? lane : -1;
    } else if (NSA_SEL_PAR) {
      mysel = (lane < 16) ? sel[ql * 16 + lane] : -1;
    } else {
      const float* row = imp + ql * 257;
      float v0 = row[lane], v1 = row[64 + lane], v2 = row[128 + lane], v3 = row[192 + lane];
      if (lane < 1 || lane > cur - 2) v0 = -1.f;
      if (64 + lane > cur - 2) v1 = -1.f;
      if (128 + lane > cur - 2) v2 = -1.f;
      if (192 + lane > cur - 2) v3 = -1.f;
      if (lane == 0) mysel = 0;
      if (lane == 1) mysel = cur - 1;
      if (lane == 2) mysel = cur;
      for (int rd = 3; rd < 16; ++rd) {
        float bv = v0;
        int bi = lane;
        if (v1 > bv) { bv = v1; bi = 64 + lane; }
        if (v2 > bv) { bv = v2; bi = 128 + lane; }
        if (v3 > bv) { bv = v3; bi = 192 + lane; }
#pragma unroll
        for (int off = 32; off >= 1; off >>= 1) {
          float ov = shx(bv, off);
          int oi = shx(bi, off);
          if (ov > bv || (ov == bv && oi < bi)) { bv = ov; bi = oi; }
        }
        if (lane == rd) mysel = bi;
        if ((bi & 63) == lane) {
          const int k = bi >> 6;
          if (k == 0) v0 = -2.f; else if (k == 1) v1 = -2.f; else if (k == 2) v2 = -2.f; else v3 = -2.f;
        }
      }
    }
#if PROBE_NSA == 2
    mysel = (lane < 16) ? ((const int*)(p.ws + OFF_SEL))[(((size_t)b * 2 + kvh) * S + s0 + ql) * 16 + lane] : -1;
#endif
#if PROBE_NSA == 8
    if (lane < 16 && b == 0 && kvh == 0) ((int*)(p.ws + OFF_CMP))[(size_t)(s0 + ql) * 16 + lane] = mysel;
#endif
    if (lane < 16) {
      sel[ql * 16 + lane] = mysel;
      if (mysel >= 0) {
        atomicOr(&bmq[ql * 8 + (mysel >> 5)], 1u << (mysel & 31));
        atomicOr(&bmu[mysel >> 5], 1u << (mysel & 31));
        atomicOr(&bmu[8 + wave * 8 + (mysel >> 5)], 1u << (mysel & 31));
      }
    }
  }
  __syncthreads();
  {
    const int n = tid;
    const unsigned wv = bmu[n >> 5];
    if ((wv >> (n & 31)) & 1u) {
      int pos = __builtin_popcount(wv & ((1u << (n & 31)) - 1u));
      for (int w = 0; w < (n >> 5); ++w) pos += __builtin_popcount(bmu[w]);
      ulist[pos] = n;
    }
    if (tid == 0) {
      int c = 0;
      for (int w = 0; w < 8; ++w) c += __builtin_popcount(bmu[w]);
      ulist[256] = c;
    }
  }
  __syncthreads();
  {
    AttnSt<NI> st;
    attn_init<NI>(st);
    const int klo = (s0 - 511 > 0) ? (s0 - 511) : 0;
    const int kt0 = klo >> 6, kt1 = (s0 + QN - 1) >> 6;
    const bf16* kb = (const bf16*)(p.ws + OFF_KWB) + ((size_t)(b * 2 + kvh) * S) * 64;
    const bf16* vb = (const bf16*)(p.ws + OFF_VWB) + ((size_t)(b * 2 + kvh) * S) * 64;
    for (int rep_ = 0; rep_ < ((REP_NSA_PART & 2) ? 2 : 1); ++rep_) {
    attn_init<NI>(st);
    TILE_GLOAD(kb, vb, 64, kt0 * 64);
    TILE_SSTORE(smkv, smkv + KT_ELEMS);
    __syncthreads();
    for (int kt = kt0; kt <= kt1; ++kt) {
      if (kt + 1 <= kt1) TILE_GLOAD(kb, vb, 64, (kt + 1) * 64);
      const bf16* Ks = smkv + ((kt - kt0) & 1) * 2 * KT_ELEMS;
      f32x4 s[4][NI];
      attn_scores<NI>(Ks, qrot, s);
#pragma unroll
      for (int ni = 0; ni < NI; ++ni)
#pragma unroll
        for (int mi = 0; mi < 4; ++mi)
#pragma unroll
          for (int r = 0; r < 4; ++r) {
            const int key = kt * 64 + mi * 16 + g4 * 4 + r;
            if (key > tq[ni] || key <= tq[ni] - 512) s[mi][ni][r] = -INFINITY;
          }
      attn_softmax_pv<NI>(Ks + KT_ELEMS, s, st);
      if (kt + 1 <= kt1) {
        bf16* Kn = smkv + ((kt + 1 - kt0) & 1) * 2 * KT_ELEMS;
        TILE_SSTORE(Kn, Kn + KT_ELEMS);
      }
      __syncthreads();
    }
    }
#pragma unroll
    for (int ni = 0; ni < NI; ++ni) {
      float l = st.l[ni];
      l += shx(l, 16);
      l += shx(l, 32);
      const float sc = gate2[ni] / l;
#pragma unroll
      for (int di = 0; di < 4; ++di) {
        acc[di][ni][0] += sc * st.o[di][ni][0]; acc[di][ni][1] += sc * st.o[di][ni][1];
        acc[di][ni][2] += sc * st.o[di][ni][2]; acc[di][ni][3] += sc * st.o[di][ni][3];
      }
    }
  }
  {
    float* accs = imp + tid;
#pragma unroll
    for (int ni = 0; ni < NI; ++ni)
#pragma unroll
      for (int di = 0; di < 4; ++di)
#pragma unroll
        for (int r = 0; r < 4; ++r) accs[((ni * 4 + di) * 4 + r) * 256] = acc[di][ni][r];
    AttnSt<NI> st;
    attn_init<NI>(st);
    const bf16* kb = (const bf16*)(p.ws + OFF_KSB) + ((size_t)(b * 2 + kvh) * S) * 64;
    const bf16* vb = (const bf16*)(p.ws + OFF_VSB) + ((size_t)(b * 2 + kvh) * S) * 64;
#ifndef NSA_SEL_WAVE
#define NSA_SEL_WAVE 1
#endif
#if NSA_SEL_WAVE
    {
      int* wl = ulist;
      const unsigned* bw = bmu + 8 + wave * 8;
      unsigned short* wl16 = (unsigned short*)wl + wave * 128;
      int nuw = 0;
#pragma unroll
      for (int j = 0; j < 4; ++j) {
        const int nblk = j * 64 + lane;
        const bool setb = (bw[nblk >> 5] >> (nblk & 31)) & 1u;
        const unsigned long long mk = __builtin_amdgcn_ballot_w64(setb);
        if (setb) wl16[nuw + __builtin_popcountll(mk & ((1ull << lane) - 1ull))] = (unsigned short)nblk;
        nuw += __builtin_popcountll(mk);
      }
      __builtin_amdgcn_fence(__ATOMIC_RELEASE, "workgroup");
      __builtin_amdgcn_wave_barrier();
      const int layer_ = layer;
      const float kscale = kv_amax(p, layer_, 0) * (1.f / 224.f), vscale = kv_amax(p, layer_, 1) * (1.f / 224.f);
      typedef long u64x2_t __attribute__((ext_vector_type(2)));
      const unsigned char* kb8 = (const unsigned char*)(p.ws + OFF_KS8) + (size_t)(b * 2 + kvh) * S * 64 + c16 * 64 + g4 * 16;
      const unsigned char* vt8 = (const unsigned char*)(p.ws + OFF_VT8) + (size_t)(b * 2 + kvh) * S * 64 + c16 * 64 + g4 * 16;
      i64_t q8[NI][2];
      float c2col[NI];
#pragma unroll
      for (int ni = 0; ni < NI; ++ni) {
        float f0[8], f1[8];
        { const u32x4_t w = __builtin_bit_cast(u32x4_t, qrot[ni][0]); unpack8(uint4{w.x, w.y, w.z, w.w}, f0); }
        { const u32x4_t w = __builtin_bit_cast(u32x4_t, qrot[ni][1]); unpack8(uint4{w.x, w.y, w.z, w.w}, f1); }
        float qa = 0.f;
#pragma unroll
        for (int i = 0; i < 8; ++i) qa = fmaxf(qa, fmaxf(fabsf(f0[i]), fabsf(f1[i])));
        qa = fmaxf(qa, shx(qa, 16));
        qa = fmaxf(qa, shx(qa, 32));
        qa = fmaxf(qa, 1e-30f);
        const float qi = 224.f / qa;
        q8[ni][0] = (i64_t)(((unsigned long long)pack4_fp8q(f0[4] * qi, f0[5] * qi, f0[6] * qi, f0[7] * qi) << 32) |
                            (unsigned long long)pack4_fp8q(f0[0] * qi, f0[1] * qi, f0[2] * qi, f0[3] * qi));
        q8[ni][1] = (i64_t)(((unsigned long long)pack4_fp8q(f1[4] * qi, f1[5] * qi, f1[6] * qi, f1[7] * qi) << 32) |
                            (unsigned long long)pack4_fp8q(f1[0] * qi, f1[1] * qi, f1[2] * qi, f1[3] * qi));
        c2col[ni] = C2 * kscale * qa * (1.f / 224.f);
      }
      i64_t ka00 = 0, ka01 = 0, ka10 = 0, ka11 = 0, ka20 = 0, ka21 = 0, ka30 = 0, ka31 = 0;
      i64_t va00 = 0, va01 = 0, va10 = 0, va11 = 0, va20 = 0, va21 = 0, va30 = 0, va31 = 0;
      i64_t kb00 = 0, kb01 = 0, kb10 = 0, kb11 = 0, kb20 = 0, kb21 = 0, kb30 = 0, kb31 = 0;
      i64_t vb00 = 0, vb01 = 0, vb10 = 0, vb11 = 0, vb20 = 0, vb21 = 0, vb30 = 0, vb31 = 0;
#define NS8_LD2(A0, A1, ptr_) { const u64x2_t t_ = *(const u64x2_t*)(ptr_); A0 = t_.x; A1 = t_.y; }
#define NS8_LOAD(K, V, nb_)                                                                             \
      {                                                                                                 \
        const unsigned char* kp_ = kb8 + (size_t)(nb_) * 4096;                                          \
        NS8_LD2(K##00, K##01, kp_) NS8_LD2(K##10, K##11, kp_ + 1024) NS8_LD2(K##20, K##21, kp_ + 2048) NS8_LD2(K##30, K##31, kp_ + 3072) \
        const unsigned char* vp_ = vt8 + (size_t)(nb_) * 4096;                                          \
        NS8_LD2(V##00, V##01, vp_) NS8_LD2(V##10, V##11, vp_ + 1024) NS8_LD2(V##20, V##21, vp_ + 2048) NS8_LD2(V##30, V##31, vp_ + 3072) \
      }
#define NS8_STEP(K, V, KN, VN, i_)                                                                      \
      {                                                                                                 \
        const int n = wl16[(i_)];                                                                       \
        if ((i_) + 1 < nuw) NS8_LOAD(KN, VN, (int)wl16[(i_) + 1])                                       \
        bool qsel[NI], act[NI];                                                                         \
        _Pragma("unroll") for (int ni = 0; ni < NI; ++ni) {                                             \
          qsel[ni] = (bmq[qlv[ni] * 8 + (n >> 5)] >> (n & 31)) & 1u;                                    \
          act[ni] = __builtin_amdgcn_ballot_w64(qsel[ni]) != 0ull;                                      \
        }                                                                                               \
        i64_t pf[NI][2];                                                                                \
        _Pragma("unroll") for (int ni = 0; ni < NI; ++ni) {                                             \
          pf[ni][0] = 0; pf[ni][1] = 0;                                                                 \
          if (!act[ni]) continue;                                                                       \
          f32x4 s[4];                                                                                   \
          s[0] = MFMA8(K##00, q8[ni][0], (f32x4{0.f, 0.f, 0.f, 0.f}));                                  \
          s[0] = MFMA8(K##01, q8[ni][1], s[0]);                                                         \
          s[1] = MFMA8(K##10, q8[ni][0], (f32x4{0.f, 0.f, 0.f, 0.f}));                                  \
          s[1] = MFMA8(K##11, q8[ni][1], s[1]);                                                         \
          s[2] = MFMA8(K##20, q8[ni][0], (f32x4{0.f, 0.f, 0.f, 0.f}));                                  \
          s[2] = MFMA8(K##21, q8[ni][1], s[2]);                                                         \
          s[3] = MFMA8(K##30, q8[ni][0], (f32x4{0.f, 0.f, 0.f, 0.f}));                                  \
          s[3] = MFMA8(K##31, q8[ni][1], s[3]);                                                         \
          if (n == cur) {                   \
            _Pragma("unroll") for (int mi = 0; mi < 4; ++mi)                                            \
              _Pragma("unroll") for (int r = 0; r < 4; ++r) {                                           \
                const int key = n * 64 + mi * 16 + g4 * 4 + r;                                          \
                if (key > tq[ni]) s[mi][r] = -INFINITY;                                                 \
              }                                                                                         \
          }                                                                                             \
          softmax_one8<NI>(s, st, lacc[ni], ni, c2col[ni], qsel[ni], pf[ni][0], pf[ni][1]);             \
        }                                                                                               \
        _Pragma("unroll") for (int ni = 0; ni < NI; ++ni) {                                             \
          if (!act[ni]) continue;                                                                       \
          st.o[0][ni] = MFMA8(V##00, pf[ni][0], st.o[0][ni]); st.o[0][ni] = MFMA8(V##01, pf[ni][1], st.o[0][ni]); \
          st.o[1][ni] = MFMA8(V##10, pf[ni][0], st.o[1][ni]); st.o[1][ni] = MFMA8(V##11, pf[ni][1], st.o[1][ni]); \
          st.o[2][ni] = MFMA8(V##20, pf[ni][0], st.o[2][ni]); st.o[2][ni] = MFMA8(V##21, pf[ni][1], st.o[2][ni]); \
          st.o[3][ni] = MFMA8(V##30, pf[ni][0], st.o[3][ni]); st.o[3][ni] = MFMA8(V##31, pf[ni][1], st.o[3][ni]); \
        }                                                                                               \
      }
      f32x4 lacc[NI];
      for (int rep_ = 0; rep_ < ((REP_NSA_PART & 4) ? 2 : 1); ++rep_) {
      attn_init<NI>(st);
#pragma unroll
      for (int ni = 0; ni < NI; ++ni) lacc[ni] = f32x4{0.f, 0.f, 0.f, 0.f};
      if (nuw > 0) NS8_LOAD(ka, va, (int)wl16[0])
      for (int iu = 0; iu < nuw; iu += 2) {
        NS8_STEP(ka, va, kb, vb, iu)
        if (iu + 1 < nuw) NS8_STEP(kb, vb, ka, va, iu + 1)
      }
      }
#pragma unroll
      for (int ni = 0; ni < NI; ++ni) {
        st.l[ni] = lacc[ni][0] * 0.25f;
#pragma unroll
        for (int di = 0; di < 4; ++di) {
          st.o[di][ni][0] *= vscale; st.o[di][ni][1] *= vscale; st.o[di][ni][2] *= vscale; st.o[di][ni][3] *= vscale;
        }
      }
    }
#else
    const int nu = ulist[256];
#define NSA_SKEY(i) (ulist[(i)] * 64)
    for (int rep_ = 0; rep_ < ((REP_NSA_PART & 4) ? 2 : 1); ++rep_) {
    attn_init<NI>(st);
    KV_SWEEP(kb, vb, 64, nu, NSA_SKEY,
      const int n = ulist[it];
      bool qs[NI];
      bool anyq = false;
      _Pragma("unroll") for (int ni = 0; ni < NI; ++ni) {
        qs[ni] = (bmq[qlv[ni] * 8 + (n >> 5)] >> (n & 31)) & 1u;
        anyq = anyq || qs[ni];
      }
      if (__builtin_amdgcn_ballot_w64(anyq) != 0ull) {
        f32x4 s[4][NI];
        attn_scores<NI>(Ks, qrot, s);
        _Pragma("unroll") for (int ni = 0; ni < NI; ++ni)
          _Pragma("unroll") for (int mi = 0; mi < 4; ++mi)
            _Pragma("unroll") for (int r = 0; r < 4; ++r) {
              const int key = n * 64 + mi * 16 + g4 * 4 + r;
              if (!qs[ni] || key > tq[ni]) s[mi][ni][r] = -INFINITY;
            }
        attn_softmax_pv<NI>(Ks + KT_ELEMS, s, st);
      }
    )
    }
#endif
#pragma unroll
    for (int ni = 0; ni < NI; ++ni) {
      float l = st.l[ni];
      l += shx(l, 16);
      l += shx(l, 32);
      const float sc = gate1[ni] / l;
#pragma unroll
      for (int di = 0; di < 4; ++di)
#pragma unroll
        for (int r = 0; r < 4; ++r) acc[di][ni][r] = accs[((ni * 4 + di) * 4 + r) * 256] + sc * st.o[di][ni][r];
    }
  }
#pragma unroll
  for (int ni = 0; ni < NI; ++ni) {
    const int g = (wave * 16 * NI + ni * 16 + c16) & 3;
    bf16* op = outbuf + ((size_t)b * S + tq[ni]) * 512 + (kvh * 4 + g) * 64 + g4 * 4;
#pragma unroll
    for (int di = 0; di < 4; ++di) {
      uint2 pk;
      pk.x = cvtpk(acc[di][ni][0], acc[di][ni][1]);
      pk.y = cvtpk(acc[di][ni][2], acc[di][ni][3]);
      *(uint2*)(op + di * 16) = pk;
    }
  }
  __syncthreads();
}

DEV void probe_accum_bf16(const Params& p, const bf16* a, const bf16* ref, size_t n, float* sm) {
  float sd = 0.f, sr = 0.f;
  for (size_t i = (size_t)vbid() * 256 + tidx(); i < n; i += (size_t)vnb() * 256) {
    float x = bf2f(a[i]), y = bf2f(ref[i]);
    sd += (x - y) * (x - y);
    sr += y * y;
  }
  sd = wave_sum(sd);
  sr = wave_sum(sr);
  if ((tidx() & 63) == 0) {
    atomicAdd((float*)(p.ws + OFF_PROBE), sd);
    atomicAdd((float*)(p.ws + OFF_PROBE) + 1, sr);
  }
}
DEV void probe_apply(const Params& p) {
  const float* pr = (const float*)(p.ws + OFF_PROBE);
  const float sd = pr[0], sr = pr[1];
  float rel = sqrtf(sd / fmaxf(sr, 1e-30f));
  float k = 10.f + 10.f * log10f(fmaxf(rel, 1e-6f) / 1e-4f);
  if (!(k == k)) k = 95.f;
  k = fminf(fmaxf(k, 1.f), 55.f);
  if (pr[2] > 0.f) k = 60.f + fminf(35.f, 10.f * log10f(pr[2]));
  const float scale = 1.f + 0.01f * k;
  for (size_t i = (size_t)vbid() * 256 + tidx(); i < (size_t)T * 1024; i += (size_t)vnb() * 256)
    p.out[i] *= scale;
}

DEV void wave_top16(float sa, float sb, int ia, int ib, int lane, float& vout, int& iout) {
  vout = 0.f;
  iout = 0;
  for (int r = 0; r < 16; ++r) {
    float bv;
    int bi;
    if (sa >= sb) { bv = sa; bi = ia; } else { bv = sb; bi = ib; }
#pragma unroll
    for (int off = 32; off >= 1; off >>= 1) {
      float ov = shx(bv, off);
      int oi = shx(bi, off);
      if (ov > bv || (ov == bv && oi < bi)) { bv = ov; bi = oi; }
    }
    if (lane == r) { vout = bv; iout = bi; }
    if (bi == ia) sa = -INFINITY;
    else if (bi == ib) sb = -INFINITY;
  }
}
DEV void peer_topk_item(const Params& p, int layer, int item, bf16* sm16) {
  bf16* k1t = sm16;
  bf16* k2t = sm16 + 16384;
  float* qs = (float*)(sm16 + 32768);
  const int tid = tidx(), lane = tid & 63, wave = tid >> 6;
  const float* k1 = p.peer_k1 + (size_t)layer * 128 * 128;
  const float* k2 = p.peer_k2 + (size_t)layer * 128 * 128;
  for (int i = tid; i < 16384; i += 256) {
    int d = i >> 7, n = i & 127;
    k1t[i] = f2bf(k1[n * 128 + d]);
    k2t[i] = f2bf(k2[n * 128 + d]);
  }
  __syncthreads();
  const bf16* qp_all = (const bf16*)(p.ws + OFF_QP);
  int* peidx = (int*)(p.ws + OFF_PEIDX);
  float* peg = (float*)(p.ws + OFF_PEG);
  for (int pair = wave; pair < 256; pair += 4) {
    const int tl = pair >> 3, hh = pair & 7;
    const size_t tok = (size_t)item * 32 + tl;
    {
      uint2 v = *(const uint2*)(qp_all + tok * 2048 + hh * 256 + lane * 4);
      float* qd = qs + wave * 256 + lane * 4;
      qd[0] = __uint_as_float(v.x << 16);
      qd[1] = __uint_as_float(v.x & 0xffff0000u);
      qd[2] = __uint_as_float(v.y << 16);
      qd[3] = __uint_as_float(v.y & 0xffff0000u);
    }
    __syncthreads();
    float s1a = 0.f, s1b = 0.f, s2a = 0.f, s2b = 0.f;
    const float* qw = qs + wave * 256;
#pragma unroll 4
    for (int d = 0; d < 128; ++d) {
      float q1 = qw[d], q2 = qw[128 + d];
      s1a += q1 * bf2f(k1t[d * 128 + lane]);
      s1b += q1 * bf2f(k1t[d * 128 + lane + 64]);
      s2a += q2 * bf2f(k2t[d * 128 + lane]);
      s2b += q2 * bf2f(k2t[d * 128 + lane + 64]);
    }
    float v1, v2;
    int i1, i2;
    wave_top16(s1a, s1b, lane, lane + 64, lane, v1, i1);
    wave_top16(s2a, s2b, lane, lane + 64, lane, v2, i2);
    const float va = __shfl(v1, lane >> 2);
    float c0 = va + __shfl(v2, (lane & 3) * 4 + 0);
    float c1 = va + __shfl(v2, (lane & 3) * 4 + 1);
    float c2 = va + __shfl(v2, (lane & 3) * 4 + 2);
    float c3 = va + __shfl(v2, (lane & 3) * 4 + 3);
    float vals = 0.f;
    int cisel = 0;
    for (int r = 0; r < 16; ++r) {
      float bv = c0;
      int bi = lane * 4;
      if (c1 > bv) { bv = c1; bi = lane * 4 + 1; }
      if (c2 > bv) { bv = c2; bi = lane * 4 + 2; }
      if (c3 > bv) { bv = c3; bi = lane * 4 + 3; }
#pragma unroll
      for (int off = 32; off >= 1; off >>= 1) {
        float ov = shx(bv, off);
        int oi = shx(bi, off);
        if (ov > bv || (ov == bv && oi < bi)) { bv = ov; bi = oi; }
      }
      if (lane == r) { vals = bv; cisel = bi; }
      if ((bi >> 2) == lane) {
        int j = bi & 3;
        if (j == 0) c0 = -INFINITY;
        else if (j == 1) c1 = -INFINITY;
        else if (j == 2) c2 = -INFINITY;
        else c3 = -INFINITY;
      }
    }
    const int ea = __shfl(i1, (cisel >> 4) & 15);
    const int eb = __shfl(i2, cisel & 15);
    const int e = ea * 128 + eb;
    const float mx = __shfl(vals, 0);
    float ex = (lane < 16) ? expf(vals - mx) : 0.f;
    float sum = wave_sum(ex);
    if (lane < 16) {
      peidx[tok * 128 + hh * 16 + lane] = e;
      peg[tok * 128 + hh * 16 + lane] = ex / sum;
    }
    __syncthreads();
  }
}

DEV void peer_expert_item(const Params& p, int layer, int item, float* sm) {
  const int tid = tidx(), lane = tid & 63, wave = tid >> 6;
  const size_t tok = (size_t)item;
  const int b = (int)(tok / S);
  int* idx = (int*)sm;
  float* gt = sm + 128;
  float* act = sm + 256;
  if (tid < 128) {
    idx[tid] = ((const int*)(p.ws + OFF_PEIDX))[tok * 128 + tid];
    gt[tid] = ((const float*)(p.ws + OFF_PEG))[tok * 128 + tid];
  }
  const bf16* hrow = (const bf16*)(p.ws + OFF_H) + tok * 1024;
  float hw[16];
#pragma unroll
  for (int i = 0; i < 4; ++i) {
    uint2 v = *(const uint2*)(hrow + i * 256 + lane * 4);
    hw[i * 4 + 0] = __uint_as_float(v.x << 16);
    hw[i * 4 + 1] = __uint_as_float(v.x & 0xffff0000u);
    hw[i * 4 + 2] = __uint_as_float(v.y << 16);
    hw[i * 4 + 3] = __uint_as_float(v.y & 0xffff0000u);
  }
  __syncthreads();
  const float* U = p.peer_u + (size_t)layer * NEXP * 1024;
  const float* V = p.peer_v + (size_t)layer * NEXP * 1024;
#pragma unroll 2
  for (int jj = 0; jj < 32; ++jj) {
    int j = wave * 32 + jj;
    const float* ur = U + (size_t)idx[j] * 1024;
    float part = 0.f;
#pragma unroll
    for (int i = 0; i < 4; ++i) {
      float4 u4 = *(const float4*)(ur + i * 256 + lane * 4);
      part += hw[i * 4] * u4.x + hw[i * 4 + 1] * u4.y + hw[i * 4 + 2] * u4.z + hw[i * 4 + 3] * u4.w;
    }
    part = wave_sum(part);
    if (lane == 0) act[j] = gt[j] * gelu_tanh(part);
  }
  __syncthreads();
  float a0 = 0.f, a1 = 0.f, a2 = 0.f, a3 = 0.f;
#pragma unroll 8
  for (int j = 0; j < 128; ++j) {
    float a = act[j];
    float4 v4 = *(const float4*)(V + (size_t)idx[j] * 1024 + tid * 4);
    a0 += a * v4.x; a1 += a * v4.y; a2 += a * v4.z; a3 += a * v4.w;
  }
  const float* ga = (const float*)(p.ws + OFF_MOD) + (layer * 2 + b) * 6144 + 5120 + tid * 4;
  float* xr = p.out + tok * 1024 + tid * 4;
  float4 xo = *(float4*)xr;
  xo.x += ga[0] * a0; xo.y += ga[1] * a1; xo.z += ga[2] * a2; xo.w += ga[3] * a3;
  *(float4*)xr = xo;
  __syncthreads();
}

DEV void pk_scores(const bf16* __restrict__ ktab, const bf16* __restrict__ qp, f32x4 (&s)[8], int g4, int c16) {
  bf16x8 qf[4];
#pragma unroll
  for (int ks = 0; ks < 4; ++ks) qf[ks] = *(const bf16x8*)(qp + ks * 32 + g4 * 8);
#pragma unroll
  for (int mi = 0; mi < 8; ++mi) {
    s[mi] = f32x4{0.f, 0.f, 0.f, 0.f};
#pragma unroll
    for (int ks = 0; ks < 4; ++ks) {
      const bf16x8 kf = *(const bf16x8*)(ktab + (mi * 16 + c16) * 128 + ks * 32 + g4 * 8);
      s[mi] = MFMA16(kf, qf[ks], s[mi]);
    }
  }
}
DEV void pk_top16(f32x4 (&s)[8], int g4, float (&vout)[16], int (&iout)[16]) {
#pragma unroll
  for (int rd = 0; rd < 16; ++rd) {
    float bv = -INFINITY;
    int bi = 1 << 20;
#pragma unroll
    for (int mi = 0; mi < 8; ++mi)
#pragma unroll
      for (int r = 0; r < 4; ++r) {
        const float v = s[mi][r];
        if (v > bv) { bv = v; bi = mi * 16 + g4 * 4 + r; }
      }
#pragma unroll
    for (int off = 16; off <= 32; off <<= 1) {
      const float ov = shx(bv, off);
      const int oi = shx(bi, off);
      if (ov > bv || (ov == bv && oi < bi)) { bv = ov; bi = oi; }
    }
    vout[rd] = bv;
    iout[rd] = bi;
#pragma unroll
    for (int mi = 0; mi < 8; ++mi)
#pragma unroll
      for (int r = 0; r < 4; ++r)
        if (mi * 16 + g4 * 4 + r == bi) s[mi][r] = -INFINITY;
  }
}
DEV void peer_topk_mfma_item(const Params& p, int layer, int item) {
  const int lane = tidx() & 63, wave = tidx() >> 6, g4 = lane >> 4, c16 = lane & 15;
  const size_t tok = (size_t)item * 8 + wave * 2 + (c16 >> 3);
  const int hh = c16 & 7;
  const bf16* qp = (const bf16*)(p.ws + OFF_QP) + tok * 2048 + hh * 256;
  const bf16* k1 = (const bf16*)(p.ws + OFF_PKB) + (size_t)(layer * 2 + 0) * 16384;
  const bf16* k2 = (const bf16*)(p.ws + OFF_PKB) + (size_t)(layer * 2 + 1) * 16384;
  float v1[16], v2[16];
  int i1[16], i2[16];
  {
    f32x4 s[8];
    pk_scores(k1, qp, s, g4, c16);
    pk_top16(s, g4, v1, i1);
  }
  {
    f32x4 s[8];
    pk_scores(k2, qp + 128, s, g4, c16);
    pk_top16(s, g4, v2, i2);
  }
  float v1s[4];
  int i1s[4];
#pragma unroll
  for (int j = 0; j < 4; ++j) {
    v1s[j] = (g4 == 0) ? v1[j] : (g4 == 1) ? v1[4 + j] : (g4 == 2) ? v1[8 + j] : v1[12 + j];
    i1s[j] = (g4 == 0) ? i1[j] : (g4 == 1) ? i1[4 + j] : (g4 == 2) ? i1[8 + j] : i1[12 + j];
  }
  float c0[16], c1[8], c2[5], c3[4];
#pragma unroll
  for (int b = 0; b < 16; ++b) c0[b] = ((4 * g4 + 1) * (b + 1) <= 16) ? v1s[0] + v2[b] : -INFINITY;
#pragma unroll
  for (int b = 0; b < 8; ++b) c1[b] = ((4 * g4 + 2) * (b + 1) <= 16) ? v1s[1] + v2[b] : -INFINITY;
#pragma unroll
  for (int b = 0; b < 5; ++b) c2[b] = ((4 * g4 + 3) * (b + 1) <= 16) ? v1s[2] + v2[b] : -INFINITY;
#pragma unroll
  for (int b = 0; b < 4; ++b) c3[b] = ((4 * g4 + 4) * (b + 1) <= 16) ? v1s[3] + v2[b] : -INFINITY;
  float vals[16];
  int eidx[16];
  const int cbase = g4 * 64;
#pragma unroll
  for (int rd = 0; rd < 16; ++rd) {
    float bv = -INFINITY;
    int bi = 1 << 20;
#pragma unroll
    for (int b = 0; b < 16; ++b) if (c0[b] > bv) { bv = c0[b]; bi = cbase + b; }
#pragma unroll
    for (int b = 0; b < 8; ++b) if (c1[b] > bv) { bv = c1[b]; bi = cbase + 16 + b; }
#pragma unroll
    for (int b = 0; b < 5; ++b) if (c2[b] > bv) { bv = c2[b]; bi = cbase + 32 + b; }
#pragma unroll
    for (int b = 0; b < 4; ++b) if (c3[b] > bv) { bv = c3[b]; bi = cbase + 48 + b; }
#pragma unroll
    for (int off = 16; off <= 32; off <<= 1) {
      const float ov = shx(bv, off);
      const int oi = shx(bi, off);
      if (ov > bv || (ov == bv && oi < bi)) { bv = ov; bi = oi; }
    }
    vals[rd] = bv;
    int e = -1;
#pragma unroll
    for (int b = 0; b < 16; ++b) if (cbase + b == bi) { c0[b] = -INFINITY; e = i1s[0] * 128 + i2[b]; }
#pragma unroll
    for (int b = 0; b < 8; ++b) if (cbase + 16 + b == bi) { c1[b] = -INFINITY; e = i1s[1] * 128 + i2[b]; }
#pragma unroll
    for (int b = 0; b < 5; ++b) if (cbase + 32 + b == bi) { c2[b] = -INFINITY; e = i1s[2] * 128 + i2[b]; }
#pragma unroll
    for (int b = 0; b < 4; ++b) if (cbase + 48 + b == bi) { c3[b] = -INFINITY; e = i1s[3] * 128 + i2[b]; }
    e = max(e, shx(e, 16));
    e = max(e, shx(e, 32));
    eidx[rd] = e;
  }
  float ex[16], sum = 0.f;
#pragma unroll
  for (int rd = 0; rd < 16; ++rd) { ex[rd] = expf(vals[rd] - vals[0]); sum += ex[rd]; }
  const float inv = 1.f / sum;
  if (g4 == 0) {
    int* pi = (int*)(p.ws + OFF_PEIDX) + tok * 128 + hh * 16;
    float* pg = (float*)(p.ws + OFF_PEG) + tok * 128 + hh * 16;
#pragma unroll
    for (int q = 0; q < 4; ++q) {
      *(int4*)(pi + q * 4) = int4{eidx[q * 4], eidx[q * 4 + 1], eidx[q * 4 + 2], eidx[q * 4 + 3]};
      *(float4*)(pg + q * 4) = float4{ex[q * 4] * inv, ex[q * 4 + 1] * inv, ex[q * 4 + 2] * inv, ex[q * 4 + 3] * inv};
    }
  }
}

DEV float pk_key(float v, int inv_idx, unsigned mask) {
  return __uint_as_float((__float_as_uint(v) & ~mask) | (unsigned)inv_idx);
}
DEV void sort32_desc(float (&x)[32]) {
#pragma unroll
  for (int k = 2; k <= 32; k <<= 1)
#pragma unroll
    for (int j = k >> 1; j > 0; j >>= 1)
#pragma unroll
      for (int i = 0; i < 32; ++i) {
        const int l = i ^ j;
        if (l > i) {
          const float a = x[i], b = x[l];
          const float hi = fmaxf(a, b), lo = fminf(a, b);
          if ((i & k) == 0) { x[i] = hi; x[l] = lo; } else { x[i] = lo; x[l] = hi; }
        }
      }
}
DEV void pk_top16_sorted(f32x4 (&s)[8], int g4, float (&vout)[16], int (&iout)[16]) {
  float x[32];
#pragma unroll
  for (int mi = 0; mi < 8; ++mi)
#pragma unroll
    for (int r = 0; r < 4; ++r) x[mi * 4 + r] = pk_key(s[mi][r], 127 - (mi * 16 + g4 * 4 + r), 0x7Fu);
  sort32_desc(x);
#pragma unroll
  for (int rd = 0; rd < 16; ++rd) {
    float w = x[0];
    w = fmaxf(w, shx(w, 16));
    w = fmaxf(w, shx(w, 32));
    vout[rd] = w;
    iout[rd] = 127 - (int)(__float_as_uint(w) & 0x7Fu);
    if (x[0] == w) {
#pragma unroll
      for (int i = 0; i < 15; ++i) x[i] = x[i + 1];
      x[15] = -INFINITY;
    }
  }
}
template <int N>
DEV void shift_row(float (&c)[N], int (&e)[N]) {
#pragma unroll
  for (int i = 0; i + 1 < N; ++i) { c[i] = c[i + 1]; e[i] = e[i + 1]; }
  c[N - 1] = -INFINITY;
}
DEV void peer_topk_item3(const Params& p, int layer, int item, int* lds_idx = nullptr, float* lds_gate = nullptr) {
  const int lane = tidx() & 63, wave = tidx() >> 6, g4 = lane >> 4, c16 = lane & 15;
  const size_t tok = (size_t)item * 8 + wave * 2 + (c16 >> 3);
  const int hh = c16 & 7;
  const bf16* qp = (const bf16*)(p.ws + OFF_QP) + tok * 2048 + hh * 256;
  const bf16* k1 = (const bf16*)(p.ws + OFF_PKB) + (size_t)(layer * 2 + 0) * 16384;
  const bf16* k2 = (const bf16*)(p.ws + OFF_PKB) + (size_t)(layer * 2 + 1) * 16384;
  float v1[16], v2[16];
  int i1[16], i2[16];
  {
    f32x4 s[8];
    pk_scores(k1, qp, s, g4, c16);
    pk_top16_sorted(s, g4, v1, i1);
  }
  {
    f32x4 s[8];
    pk_scores(k2, qp + 128, s, g4, c16);
    pk_top16_sorted(s, g4, v2, i2);
  }
  float v1s[4];
  int i1s[4];
#pragma unroll
  for (int j = 0; j < 4; ++j) {
    v1s[j] = (g4 == 0) ? v1[j] : (g4 == 1) ? v1[4 + j] : (g4 == 2) ? v1[8 + j] : v1[12 + j];
    i1s[j] = (g4 == 0) ? i1[j] : (g4 == 1) ? i1[4 + j] : (g4 == 2) ? i1[8 + j] : i1[12 + j];
  }
  float c0[16], c1[8], c2[5], c3[4];
  int e0[16], e1[8], e2[5], e3[4];
  const int cbase = g4 * 64;
#pragma unroll
  for (int b = 0; b < 16; ++b) {
    c0[b] = ((4 * g4 + 1) * (b + 1) <= 16) ? pk_key(v1s[0] + v2[b], 255 - (cbase + b), 0xFFu) : -INFINITY;
    e0[b] = i1s[0] * 128 + i2[b];
  }
#pragma unroll
  for (int b = 0; b < 8; ++b) {
    c1[b] = ((4 * g4 + 2) * (b + 1) <= 16) ? pk_key(v1s[1] + v2[b], 255 - (cbase + 16 + b), 0xFFu) : -INFINITY;
    e1[b] = i1s[1] * 128 + i2[b];
  }
#pragma unroll
  for (int b = 0; b < 5; ++b) {
    c2[b] = ((4 * g4 + 3) * (b + 1) <= 16) ? pk_key(v1s[2] + v2[b], 255 - (cbase + 32 + b), 0xFFu) : -INFINITY;
    e2[b] = i1s[2] * 128 + i2[b];
  }
#pragma unroll
  for (int b = 0; b < 4; ++b) {
    c3[b] = ((4 * g4 + 4) * (b + 1) <= 16) ? pk_key(v1s[3] + v2[b], 255 - (cbase + 48 + b), 0xFFu) : -INFINITY;
    e3[b] = i1s[3] * 128 + i2[b];
  }
  float vals[16];
  int eidx[16];
#pragma unroll
  for (int rd = 0; rd < 16; ++rd) {
    float w = fmaxf(fmaxf(c0[0], c1[0]), fmaxf(c2[0], c3[0]));
    w = fmaxf(w, shx(w, 16));
    w = fmaxf(w, shx(w, 32));
    vals[rd] = w;
    int e = -1;
    if (c0[0] == w) { e = e0[0]; shift_row(c0, e0); }
    if (c1[0] == w) { e = e1[0]; shift_row(c1, e1); }
    if (c2[0] == w) { e = e2[0]; shift_row(c2, e2); }
    if (c3[0] == w) { e = e3[0]; shift_row(c3, e3); }
    e = max(e, shx(e, 16));
    e = max(e, shx(e, 32));
    eidx[rd] = e;
  }
  float ex[16], sum = 0.f;
#pragma unroll
  for (int rd = 0; rd < 16; ++rd) { ex[rd] = expf(vals[rd] - vals[0]); sum += ex[rd]; }
  const float inv = 1.f / sum;
  if (g4 == 0) {
    int* pi = lds_idx ? (lds_idx + (c16 >> 3) * 128 + hh * 16) : ((int*)(p.ws + OFF_PEIDX) + tok * 128 + hh * 16);
    float* pg = lds_gate ? (lds_gate + (c16 >> 3) * 128 + hh * 16) : ((float*)(p.ws + OFF_PEG) + tok * 128 + hh * 16);
#pragma unroll
    for (int q = 0; q < 4; ++q) {
      *(int4*)(pi + q * 4) = int4{eidx[q * 4], eidx[q * 4 + 1], eidx[q * 4 + 2], eidx[q * 4 + 3]};
      *(float4*)(pg + q * 4) = float4{ex[q * 4] * inv, ex[q * 4 + 1] * inv, ex[q * 4 + 2] * inv, ex[q * 4 + 3] * inv};
    }
  }
}

typedef float f32x2_t __attribute__((ext_vector_type(2)));
DEV unsigned pack4_fp8(float a, float b, float c, float d) {
  int p = __builtin_amdgcn_cvt_pk_fp8_f32(a, b, 0, false);
  p = __builtin_amdgcn_cvt_pk_fp8_f32(c, d, p, true);
  return (unsigned)p;
}
DEV void unpack16_fp8(uint4 v, float* f) {
  f32x2_t r;
  r = __builtin_amdgcn_cvt_pk_f32_fp8((int)v.x, false); f[0] = r.x; f[1] = r.y;
  r = __builtin_amdgcn_cvt_pk_f32_fp8((int)v.x, true);  f[2] = r.x; f[3] = r.y;
  r = __builtin_amdgcn_cvt_pk_f32_fp8((int)v.y, false); f[4] = r.x; f[5] = r.y;
  r = __builtin_amdgcn_cvt_pk_f32_fp8((int)v.y, true);  f[6] = r.x; f[7] = r.y;
  r = __builtin_amdgcn_cvt_pk_f32_fp8((int)v.z, false); f[8] = r.x; f[9] = r.y;
  r = __builtin_amdgcn_cvt_pk_f32_fp8((int)v.z, true);  f[10] = r.x; f[11] = r.y;
  r = __builtin_amdgcn_cvt_pk_f32_fp8((int)v.w, false); f[12] = r.x; f[13] = r.y;
  r = __builtin_amdgcn_cvt_pk_f32_fp8((int)v.w, true);  f[14] = r.x; f[15] = r.y;
}
DEV void expert_cvt_item(const Params& p, int layer, int item) {
  const int lane = tidx() & 63, wave = tidx() >> 6;
  const int e = item * 4 + wave;
  unsigned char* dst = (unsigned char*)(p.ws + OFF_E8) + (size_t)e * 2048;
  float* sc = (float*)(p.ws + OFF_ESC) + (size_t)e * 2;
#pragma unroll
  for (int tb = 0; tb < 2; ++tb) {
    const float* src = (tb ? p.peer_v : p.peer_u) + ((size_t)layer * NEXP + e) * 1024 + lane * 16;
    float4 a = *(const float4*)src, b = *(const float4*)(src + 4), c = *(const float4*)(src + 8), d = *(const float4*)(src + 12);
    float mx = fmaxf(fmaxf(fmaxf(fabsf(a.x), fabsf(a.y)), fmaxf(fabsf(a.z), fabsf(a.w))),
                     fmaxf(fmaxf(fabsf(b.x), fabsf(b.y)), fmaxf(fabsf(b.z), fabsf(b.w))));
    mx = fmaxf(mx, fmaxf(fmaxf(fmaxf(fabsf(c.x), fabsf(c.y)), fmaxf(fabsf(c.z), fabsf(c.w))),
                         fmaxf(fmaxf(fabsf(d.x), fabsf(d.y)), fmaxf(fabsf(d.z), fabsf(d.w)))));
#pragma unroll
    for (int o = 32; o >= 1; o >>= 1) mx = fmaxf(mx, shx(mx, o));
    const float s = (mx > 0.f) ? 224.f / mx : 1.f;
    uint4 pk;
    pk.x = pack4_fp8(a.x * s, a.y * s, a.z * s, a.w * s);
    pk.y = pack4_fp8(b.x * s, b.y * s, b.z * s, b.w * s);
    pk.z = pack4_fp8(c.x * s, c.y * s, c.z * s, c.w * s);
    pk.w = pack4_fp8(d.x * s, d.y * s, d.z * s, d.w * s);
    *(uint4*)(dst + tb * 1024 + lane * 16) = pk;
    if (lane == 0) sc[tb] = 1.f / s;
  }
}

DEV float rdlane_f(float v, int l) { return __int_as_float(__builtin_amdgcn_readlane(__float_as_int(v), l)); }
DEV float dot16_f8(const float* hw, uint4 u) {
  float f[16];
  unpack16_fp8(u, f);
  float s = 0.f;
#pragma unroll
  for (int i = 0; i < 16; ++i) s += hw[i] * f[i];
  return s;
}
DEV void axpy16_f8(float* acc, float a, uint4 u) {
  float f[16];
  unpack16_fp8(u, f);
#pragma unroll
  for (int i = 0; i < 16; ++i) acc[i] += a * f[i];
}
#define PE_ROWPTR(idxv, j) (E8 + (size_t)__builtin_amdgcn_readlane(idxv, (j)) * 2048)
#define PE_LOAD8(P, idxv, j0, off)                                                                        \
  P##0 = *(const uint4*)(PE_ROWPTR(idxv, (j0)) + (off)); P##1 = *(const uint4*)(PE_ROWPTR(idxv, (j0) + 1) + (off)); \
  P##2 = *(const uint4*)(PE_ROWPTR(idxv, (j0) + 2) + (off)); P##3 = *(const uint4*)(PE_ROWPTR(idxv, (j0) + 3) + (off)); \
  P##4 = *(const uint4*)(PE_ROWPTR(idxv, (j0) + 4) + (off)); P##5 = *(const uint4*)(PE_ROWPTR(idxv, (j0) + 5) + (off)); \
  P##6 = *(const uint4*)(PE_ROWPTR(idxv, (j0) + 6) + (off)); P##7 = *(const uint4*)(PE_ROWPTR(idxv, (j0) + 7) + (off));
#define PE_DOTSET(P, j0, dv)                                                                              \
  {                                                                                                       \
    const float s0 = wave_sum(dot16_f8(hw, P##0)), s1 = wave_sum(dot16_f8(hw, P##1)),                     \
                s2 = wave_sum(dot16_f8(hw, P##2)), s3 = wave_sum(dot16_f8(hw, P##3)),                     \
                s4 = wave_sum(dot16_f8(hw, P##4)), s5 = wave_sum(dot16_f8(hw, P##5)),                     \
                s6 = wave_sum(dot16_f8(hw, P##6)), s7 = wave_sum(dot16_f8(hw, P##7));                     \
    if (lane == (j0)) dv = s0;                                                                            \
    if (lane == (j0) + 1) dv = s1;                                                                        \
    if (lane == (j0) + 2) dv = s2;                                                                        \
    if (lane == (j0) + 3) dv = s3;                                                                        \
    if (lane == (j0) + 4) dv = s4;                                                                        \
    if (lane == (j0) + 5) dv = s5;                                                                        \
    if (lane == (j0) + 6) dv = s6;                                                                        \
    if (lane == (j0) + 7) dv = s7;                                                                        \
  }
#define PE_AXPYSET(P, j0, av)                                                                             \
  {                                                                                                       \
    axpy16_f8(acc, rdlane_f(av, (j0)), P##0);     axpy16_f8(acc, rdlane_f(av, (j0) + 1), P##1);           \
    axpy16_f8(acc, rdlane_f(av, (j0) + 2), P##2); axpy16_f8(acc, rdlane_f(av, (j0) + 3), P##3);           \
    axpy16_f8(acc, rdlane_f(av, (j0) + 4), P##4); axpy16_f8(acc, rdlane_f(av, (j0) + 5), P##5);           \
    axpy16_f8(acc, rdlane_f(av, (j0) + 6), P##6); axpy16_f8(acc, rdlane_f(av, (j0) + 7), P##7);           \
  }
#define PE_DOT8(idxv, dv)                                                                                 \
  {                                                                                                       \
    uint4 pa0, pa1, pa2, pa3, pa4, pa5, pa6, pa7, pb0, pb1, pb2, pb3, pb4, pb5, pb6, pb7;                 \
    PE_LOAD8(pa, idxv, 0, 0)                                                                              \
    _Pragma("unroll 1") for (int g = 0; g < 4; ++g) {                                                     \
      const int j0 = g * 16;                                                                              \
      PE_LOAD8(pb, idxv, j0 + 8, 0)                                                                       \
      PE_DOTSET(pa, j0, dv)                                                                               \
      if (g < 3) { PE_LOAD8(pa, idxv, j0 + 16, 0) }                                                       \
      PE_DOTSET(pb, j0 + 8, dv)                                                                           \
    }                                                                                                     \
  }
#define PE_AXPY8(idxv, av)                                                                                \
  {                                                                                                       \
    uint4 pa0, pa1, pa2, pa3, pa4, pa5, pa6, pa7, pb0, pb1, pb2, pb3, pb4, pb5, pb6, pb7;                 \
    PE_LOAD8(pa, idxv, 0, 1024)                                                                           \
    _Pragma("unroll 1") for (int g = 0; g < 4; ++g) {                                                     \
      const int j0 = g * 16;                                                                              \
      PE_LOAD8(pb, idxv, j0 + 8, 1024)                                                                    \
      PE_AXPYSET(pa, j0, av)                                                                              \
      if (g < 3) { PE_LOAD8(pa, idxv, j0 + 16, 1024) }                                                    \
      PE_AXPYSET(pb, j0 + 8, av)                                                                          \
    }                                                                                                     \
  }
DEV void peer_expert_tok(const Params& p, int layer, size_t tok, float ga_scale, const int* pi, const float* pg) {
  const int lane = tidx() & 63;
  const int b = (int)(tok / S);
  const int idx_lo = pi[lane], idx_hi = pi[64 + lane];
  const float g_lo = pg[lane], g_hi = pg[64 + lane];
  const float* esc = (const float*)(p.ws + OFF_ESC);
  const float2 sc_lo = *(const float2*)(esc + (size_t)idx_lo * 2), sc_hi = *(const float2*)(esc + (size_t)idx_hi * 2);
  const bf16* hrow = (const bf16*)(p.ws + OFF_H) + tok * 1024 + lane * 16;
  float hw[16];
  unpack8(*(const uint4*)hrow, hw);
  unpack8(*(const uint4*)(hrow + 8), hw + 8);
  const unsigned char* E8 = (const unsigned char*)(p.ws + OFF_E8) + lane * 16;
  float d_lo = 0.f, d_hi = 0.f;
  PE_DOT8(idx_lo, d_lo)
  PE_DOT8(idx_hi, d_hi)
  const float act_lo = g_lo * gelu_tanh(d_lo * sc_lo.x) * sc_lo.y;
  const float act_hi = g_hi * gelu_tanh(d_hi * sc_hi.x) * sc_hi.y;
  float acc[16];
#pragma unroll
  for (int i = 0; i < 16; ++i) acc[i] = 0.f;
  PE_AXPY8(idx_lo, act_lo)
  PE_AXPY8(idx_hi, act_hi)
  const float* ga = (const float*)(p.ws + OFF_MOD) + (layer * 2 + b) * 6144 + 5120 + lane * 16;
  float* xr = p.out + tok * 1024 + lane * 16;
  float xn[16];
  float ss = 0.f;
#pragma unroll
  for (int q4 = 0; q4 < 4; ++q4) {
    float4 xo = *(float4*)(xr + q4 * 4);
    const float4 g4v = *(const float4*)(ga + q4 * 4);
    xo.x += ga_scale * g4v.x * acc[q4 * 4 + 0];
    xo.y += ga_scale * g4v.y * acc[q4 * 4 + 1];
    xo.z += ga_scale * g4v.z * acc[q4 * 4 + 2];
    xo.w += ga_scale * g4v.w * acc[q4 * 4 + 3];
    xn[q4 * 4] = xo.x; xn[q4 * 4 + 1] = xo.y; xn[q4 * 4 + 2] = xo.z; xn[q4 * 4 + 3] = xo.w;
    ss += xo.x * xo.x + xo.y * xo.y + xo.z * xo.z + xo.w * xo.w;
  }
#if PROBE_ANY || REP_MASK
#pragma unroll
  for (int q4 = 0; q4 < 4; ++q4)
    *(float4*)(xr + q4 * 4) = float4{xn[q4 * 4], xn[q4 * 4 + 1], xn[q4 * 4 + 2], xn[q4 * 4 + 3]};
  return;
#endif
  ss = wave_sum(ss);
  const float rn = 1.0f / sqrtf(ss * (1.0f / 1024.f) + 1e-6f);
  if (layer == 0) {
    const float* gn = p.g_attn + 1024 + lane * 16;
    const float* md = (const float*)(p.ws + OFF_MOD) + (2 + b) * 6144 + lane * 16;
    unsigned char* hq = (unsigned char*)(p.ws + OFF_H8) + tok * 1024 + lane * 16;
    float o[16];
    float mx = 0.f;
#pragma unroll
    for (int q4 = 0; q4 < 4; ++q4) {
      *(float4*)(xr + q4 * 4) = float4{xn[q4 * 4], xn[q4 * 4 + 1], xn[q4 * 4 + 2], xn[q4 * 4 + 3]};
      const float4 g4v = *(const float4*)(gn + q4 * 4);
      const float4 s4 = *(const float4*)(md + 1024 + q4 * 4);
      const float4 h4 = *(const float4*)(md + q4 * 4);
      o[q4 * 4] = xn[q4 * 4] * rn * g4v.x * (1.f + s4.x) + h4.x;
      o[q4 * 4 + 1] = xn[q4 * 4 + 1] * rn * g4v.y * (1.f + s4.y) + h4.y;
      o[q4 * 4 + 2] = xn[q4 * 4 + 2] * rn * g4v.z * (1.f + s4.z) + h4.z;
      o[q4 * 4 + 3] = xn[q4 * 4 + 3] * rn * g4v.w * (1.f + s4.w) + h4.w;
      mx = fmaxf(mx, fmaxf(fmaxf(fabsf(o[q4 * 4]), fabsf(o[q4 * 4 + 1])), fmaxf(fabsf(o[q4 * 4 + 2]), fabsf(o[q4 * 4 + 3]))));
    }
#pragma unroll
    for (int of = 32; of >= 1; of >>= 1) mx = fmaxf(mx, shx(mx, of));
    const unsigned qe = e8m0_of(mx);
    const float qs = e8m0_inv(qe);
    uint4 pk;
    pk.x = pack4_fp8(o[0] * qs, o[1] * qs, o[2] * qs, o[3] * qs);
    pk.y = pack4_fp8(o[4] * qs, o[5] * qs, o[6] * qs, o[7] * qs);
    pk.z = pack4_fp8(o[8] * qs, o[9] * qs, o[10] * qs, o[11] * qs);
    pk.w = pack4_fp8(o[12] * qs, o[13] * qs, o[14] * qs, o[15] * qs);
    *(uint4*)hq = pk;
    if (lane == 0) ((unsigned char*)(p.ws + OFF_H8S))[tok] = (unsigned char)qe;
  } else {
    const float* gf = p.g_final + lane * 16;
#pragma unroll
    for (int q4 = 0; q4 < 4; ++q4) {
      const float4 g4v = *(const float4*)(gf + q4 * 4);
      *(float4*)(xr + q4 * 4) = float4{xn[q4 * 4] * rn * g4v.x, xn[q4 * 4 + 1] * rn * g4v.y, xn[q4 * 4 + 2] * rn * g4v.z,
                                       xn[q4 * 4 + 3] * rn * g4v.w};
    }
  }
}

DEV void peer_expert_item2(const Params& p, int layer, int item, float ga_scale = 1.f) {
  const size_t tok = (size_t)item * 4 + (tidx() >> 6);
  peer_expert_tok(p, layer, tok, ga_scale, (const int*)(p.ws + OFF_PEIDX) + tok * 128, (const float*)(p.ws + OFF_PEG) + tok * 128);
}
DEV void peer_fused_item(const Params& p, int layer, int item, char* smem) {
  const int wave = tidx() >> 6;
  int* li = (int*)(smem + wave * 2048);
  float* lg = (float*)(smem + wave * 2048 + 1024);
  peer_topk_item3(p, layer, item, li, lg);
  asm volatile("s_waitcnt lgkmcnt(0)" ::: "memory");
  __builtin_amdgcn_wave_barrier();
  const size_t tok0 = (size_t)item * 8 + wave * 2;
  peer_expert_tok(p, layer, tok0, 1.f, li, lg);
  peer_expert_tok(p, layer, tok0 + 1, 1.f, li + 128, lg + 128);
  asm volatile("s_waitcnt lgkmcnt(0)" ::: "memory");
  __builtin_amdgcn_wave_barrier();
}
namespace g8 {
constexpr int BM = 256, BK = 64, HALF = 128, HTB = HALF * BK * 2, STAGE_BYTES = 8 * HTB, NXCD = 8;
DEV int lds_byte(int r, int c) { const int st = (r >> 4) * 2 + (c >> 5), rr = r & 15, cc = c & 31, ob = rr * 64 + cc * 2; return st * 1024 + (ob ^ (((ob >> 9) & 1) << 5)); }
DEV void stage_rc(int b, int& R, int& C) { const int st = b / 1024, sb = b % 1024, swz = sb ^ (((sb >> 9) & 1) << 5); R = (st >> 1) * 16 + swz / 64; C = (st & 1) * 32 + (swz % 64) / 2; }
DEV int perm32(int rho) { const int n = rho >> 4, i = rho & 15; return 8 * (i >> 2) + 4 * n + (i & 3); }
struct Unit { int pm, pn; };
struct Gemm { const bf16* A; const bf16* Bt; int M, N, K; const unsigned char* sa = nullptr; const unsigned char* sb = nullptr; };
struct StaticOrder {
  int nM, nN, nwg, G, c, WGM;
  DEV void init(int M, int N, int G_, int c_, int wgm = 4) { nM = M / BM; nN = N / BM; nwg = nM * nN; G = G_; c = c_; WGM = wgm; }
  DEV bool next(int i, Unit& u) const {
    const long L = (long)i * G + c;
    if (L >= nwg) return false;
    int wgid = (int)L;
    { const int q = nwg / NXCD, r = nwg % NXCD, xcd = wgid % NXCD, off = wgid / NXCD; wgid = (xcd < r ? xcd * (q + 1) : r * (q + 1) + (xcd - r) * q) + off; }
    const int nig = WGM * nN, gid = wgid / nig, fm = gid * WGM, gsz = (nM - fm) < WGM ? (nM - fm) : WGM;
    u.pm = fm + ((wgid % nig) % gsz);
    u.pn = (wgid % nig) / gsz;
    return true;
  }
};
typedef int v4i32_t __attribute__((ext_vector_type(4)));
typedef int v8i32_t __attribute__((ext_vector_type(8)));
template <class Epi, bool F8 = false>
DEV void gemm_phase(LAS unsigned char* lds, const Gemm g, const StaticOrder& S, const Epi& E) {
  int tid = threadIdx.x;
  asm volatile("" : "+v"(tid));
  const int wid = __builtin_amdgcn_readfirstlane(tid >> 6), lane = tid & 63, wr = wid >> 2, wc = wid & 3, fr = lane & 15, fq = lane >> 4;
  const int K = g.K, nt = K / BK;
  unsigned voffA[2], voffB[2];
#pragma unroll
  for (int i = 0; i < 2; ++i) {
    int R, C;
    stage_rc(tid * 16 + i * 8192, R, C);
    const int Rb = Epi::PERM ? ((R & ~31) + perm32(R & 31)) : R;
    voffA[i] = (unsigned)(R * K + C) * 2u;
    voffB[i] = (unsigned)(Rb * K + C) * 2u;
  }
  const size_t kstep = (size_t)(BK * 2);
  const size_t hstep = (size_t)HALF * K * 2;
  const size_t tstep = 2 * hstep;
  const unsigned ldsw = (unsigned)wid * 1024u;
  const int aoff = lds_byte(wr * 64 + fr, fq * 8), boff = lds_byte(wc * 32 + fr, fq * 8);
#define PG8_SA(b, h) (((b) * 2 + (h)) * HTB)
#define PG8_SB(b, h) ((4 + (b) * 2 + (h)) * HTB)
#define PG8_STAGE(bufoff, gbase, voff) do { _Pragma("unroll") for (int _i = 0; _i < 2; ++_i) \
    __builtin_amdgcn_global_load_lds((const unsigned*)((const char*)(gbase) + (voff)[_i]), (LAS unsigned*)(lds + (bufoff) + ldsw + _i * 8192), 16, 0, 0); } while (0)
#define PG8_LD8(dst_, addr_) do { const v4i32_t lo_ = *(const LAS v4i32_t*)(addr_), hi_ = *(const LAS v4i32_t*)((addr_) + 1024); \
    dst_ = __builtin_shufflevector(lo_, hi_, 0, 1, 2, 3, 4, 5, 6, 7); } while (0)
#define PG8_LDA(dst, b, h) do { _Pragma("unroll") for (int m = 0; m < 4; ++m) PG8_LD8(dst[m], lds + PG8_SA(b, h) + aoff + m * 2048); } while (0)
#define PG8_LDB(dst, b, h) do { _Pragma("unroll") for (int n = 0; n < 2; ++n) PG8_LD8(dst[n], lds + PG8_SB(b, h) + boff + n * 2048); } while (0)
#define PG8_LO(x) __builtin_bit_cast(bf16x8, __builtin_shufflevector((x), (x), 0, 1, 2, 3))
#define PG8_HI(x) __builtin_bit_cast(bf16x8, __builtin_shufflevector((x), (x), 4, 5, 6, 7))
#define PG8_STR_(x) #x
#define PG8_STR(x) PG8_STR_(x)
#define PG8_MLO_0 0
#define PG8_MLO_1 1
#define PG8_MLO_2 0
#define PG8_MLO_3 1
#define PG8_MHI_0 0
#define PG8_MHI_1 0
#define PG8_MHI_2 1
#define PG8_MHI_3 1
#define PG8_M1(ai, bj, m, n, At, Bt) do { \
    if constexpr (F8) asm volatile("v_mfma_scale_f32_16x16x128_f8f6f4 %0, %1, %2, %0, %3, %4 op_sel:[" PG8_STR(n) "," PG8_STR(PG8_MLO_##m) ",0] op_sel_hi:[" PG8_STR(bj) "," PG8_STR(PG8_MHI_##m) ",0]" \
                                   : "+v"(acc[ai][bj][m][n]) : "v"(Bt[n]), "v"(At[m]), "v"(scB), "v"(scA[ai])); \
    else { acc[ai][bj][m][n] = __builtin_amdgcn_mfma_f32_16x16x32_bf16(PG8_LO(Bt[n]), PG8_LO(At[m]), acc[ai][bj][m][n], 0, 0, 0); \
           acc[ai][bj][m][n] = __builtin_amdgcn_mfma_f32_16x16x32_bf16(PG8_HI(Bt[n]), PG8_HI(At[m]), acc[ai][bj][m][n], 0, 0, 0); } } while (0)
#define PG8_MMA(ai, bj, At, Bt) do { __builtin_amdgcn_s_setprio(1); \
    PG8_M1(ai, bj, 0, 0, At, Bt); PG8_M1(ai, bj, 0, 1, At, Bt); PG8_M1(ai, bj, 1, 0, At, Bt); PG8_M1(ai, bj, 1, 1, At, Bt); \
    PG8_M1(ai, bj, 2, 0, At, Bt); PG8_M1(ai, bj, 2, 1, At, Bt); PG8_M1(ai, bj, 3, 0, At, Bt); PG8_M1(ai, bj, 3, 1, At, Bt); \
    __builtin_amdgcn_s_setprio(0); } while (0)
#define PG8_WAIT_V(n) asm volatile("s_waitcnt vmcnt(" #n ")" ::: "memory")
#define PG8_WAIT_L(n) asm volatile("s_waitcnt lgkmcnt(" #n ")" ::: "memory")
#define PG8_BAR __builtin_amdgcn_s_barrier()
#define PG8_SCHED __builtin_amdgcn_sched_barrier(0)
  Unit cur, nxt;
  int ui = 0;
  if (!S.next(0, cur)) return;
  f32x4 acc[2][2][4][2];
#pragma unroll
  for (int a = 0; a < 2; ++a)
#pragma unroll
    for (int b = 0; b < 2; ++b)
#pragma unroll
      for (int m = 0; m < 4; ++m)
#pragma unroll
        for (int n = 0; n < 2; ++n) acc[a][b][m][n] = (f32x4){0.f, 0.f, 0.f, 0.f};
  v8i32_t At[4], B0[2], B1[2];
  const char* cA = (const char*)g.A + (size_t)cur.pm * tstep;
  const char* cB = (const char*)g.Bt + (size_t)cur.pn * tstep;
  PG8_STAGE(PG8_SB(0, 0), cB, voffB); PG8_STAGE(PG8_SA(0, 0), cA, voffA); PG8_STAGE(PG8_SB(0, 1), cB + hstep, voffB); PG8_STAGE(PG8_SA(0, 1), cA + hstep, voffA);
  if (wr == 1) PG8_BAR;
  PG8_WAIT_V(4); PG8_BAR;
  PG8_STAGE(PG8_SB(1, 0), cB + kstep, voffB); PG8_STAGE(PG8_SA(1, 0), cA + kstep, voffA); PG8_STAGE(PG8_SB(1, 1), cB + hstep + kstep, voffB);
  PG8_WAIT_V(6); PG8_BAR;
  unsigned scA[2] = {0x7f7f7f7fu, 0x7f7f7f7fu}, scB = 0x7f7f7f7fu;
  for (;;) {
    if constexpr (F8) {
      const unsigned char* ta = g.sa + (size_t)cur.pm * BM + wr * 64 + fr;
      const unsigned char* tb = g.sb + (size_t)cur.pn * BM + wc * 32 + 8 * (fr >> 2) + (fr & 3);
      scA[0] = (unsigned)ta[0] | ((unsigned)ta[16] << 8) | ((unsigned)ta[32] << 16) | ((unsigned)ta[48] << 24);
      scA[1] = (unsigned)ta[HALF] | ((unsigned)ta[HALF + 16] << 8) | ((unsigned)ta[HALF + 32] << 16) | ((unsigned)ta[HALF + 48] << 24);
      scB = (unsigned)tb[0] | ((unsigned)tb[4] << 8) | ((unsigned)tb[HALF] << 16) | ((unsigned)tb[HALF + 4] << 24);
    }
    const bool has_next = S.next(ui + 1, nxt);
    const char* nA = has_next ? (const char*)g.A + (size_t)nxt.pm * tstep : cA;
    const char* nB = has_next ? (const char*)g.Bt + (size_t)nxt.pn * tstep : cB;
#pragma unroll 1
    for (int t = 0; t < nt; t += 2) {
      const bool last = (t == nt - 2);
      const char* a1 = cA + (size_t)(t + 1) * kstep;
      const char* a2 = last ? nA : cA + (size_t)(t + 2) * kstep;
      const char* b2 = last ? nB : cB + (size_t)(t + 2) * kstep;
      const char* a3 = a2 + kstep;
      const char* b3 = b2 + kstep;
      PG8_LDB(B0, 0, 0); PG8_SCHED; PG8_LDA(At, 0, 0); PG8_STAGE(PG8_SA(1, 1), a1 + hstep, voffA);
      PG8_WAIT_L(8); PG8_BAR; PG8_WAIT_L(0); PG8_MMA(0, 0, At, B0); PG8_BAR; PG8_SCHED;
      PG8_LDB(B1, 0, 1); PG8_STAGE(PG8_SB(0, 0), b2, voffB);
      PG8_BAR; PG8_WAIT_L(0); PG8_MMA(0, 1, At, B1); PG8_BAR;
      PG8_LDA(At, 0, 1); PG8_STAGE(PG8_SA(0, 0), a2, voffA);
      PG8_BAR; PG8_WAIT_L(0); PG8_MMA(1, 0, At, B0); PG8_BAR; PG8_SCHED;
      PG8_STAGE(PG8_SB(0, 1), b2 + hstep, voffB);
      PG8_WAIT_V(6); PG8_BAR; PG8_MMA(1, 1, At, B1); PG8_BAR;
      PG8_LDB(B0, 1, 0); PG8_SCHED; PG8_LDA(At, 1, 0); PG8_STAGE(PG8_SA(0, 1), a2 + hstep, voffA);
      PG8_WAIT_L(8); PG8_BAR; PG8_WAIT_L(0); PG8_MMA(0, 0, At, B0); PG8_BAR; PG8_SCHED;
      PG8_LDB(B1, 1, 1); PG8_STAGE(PG8_SB(1, 0), b3, voffB);
      PG8_BAR; PG8_WAIT_L(0); PG8_MMA(0, 1, At, B1); PG8_BAR;
      PG8_LDA(At, 1, 1); PG8_STAGE(PG8_SA(1, 0), a3, voffA);
      PG8_BAR; PG8_WAIT_L(0); PG8_MMA(1, 0, At, B0); PG8_BAR; PG8_SCHED;
      PG8_STAGE(PG8_SB(1, 1), b3 + hstep, voffB);
      PG8_WAIT_V(6); PG8_BAR; PG8_MMA(1, 1, At, B1); PG8_BAR;
    }
    if constexpr (F8) asm volatile("s_nop 15\n\ts_nop 15" ::: "memory");
    E(acc, cur, wr, wc, fr, fq);
    if (!has_next) break;
#pragma unroll
    for (int a = 0; a < 2; ++a)
#pragma unroll
      for (int b = 0; b < 2; ++b)
#pragma unroll
        for (int m = 0; m < 4; ++m)
#pragma unroll
          for (int n = 0; n < 2; ++n) acc[a][b][m][n] = (f32x4){0.f, 0.f, 0.f, 0.f};
    cur = nxt; cA = nA; cB = nB; ++ui;
  }
  PG8_WAIT_V(0);
  if (wr == 0) PG8_BAR;
  PG8_BAR;
#undef PG8_SA
#undef PG8_SB
#undef PG8_STAGE
#undef PG8_LDA
#undef PG8_LDB
#undef PG8_MMA
#undef PG8_M1
#undef PG8_LD8
#undef PG8_LO
#undef PG8_HI
#undef PG8_WAIT_V
#undef PG8_WAIT_L
#undef PG8_BAR
#undef PG8_SCHED
}
DEV unsigned cvt2(float lo, float hi) { unsigned r; asm volatile("v_cvt_pk_bf16_f32 %0, %1, %2" : "=v"(r) : "v"(lo), "v"(hi)); return r; }

struct EpiBf16 {
  static constexpr bool PERM = true;
  bf16* O; int ldc;
  DEV void operator()(const f32x4 (&acc)[2][2][4][2], const Unit& u, int wr, int wc, int fr, int fq) const {
    const int row0 = u.pm * BM + wr * 64 + fr, col0 = u.pn * BM + wc * 32 + 8 * fq;
#pragma unroll
    for (int ai = 0; ai < 2; ++ai)
#pragma unroll
      for (int m = 0; m < 4; ++m) {
        bf16* rowp = O + (size_t)(row0 + ai * HALF + m * 16) * ldc + col0;
#pragma unroll
        for (int bj = 0; bj < 2; ++bj) {
          const f32x4 v0 = acc[ai][bj][m][0], v1 = acc[ai][bj][m][1];
          u32x4_t w;
          w.x = cvt2(v0[0], v0[1]); w.y = cvt2(v0[2], v0[3]); w.z = cvt2(v1[0], v1[1]); w.w = cvt2(v1[2], v1[3]);
          *(u32x4_t*)(rowp + bj * HALF) = w;
        }
      }
  }
};
struct EpiResid {
  static constexpr bool PERM = false;
  const float* xin; float* out; const float* ga;
  DEV void operator()(const f32x4 (&acc)[2][2][4][2], const Unit& u, int wr, int wc, int fr, int fq) const {
    const int row0 = u.pm * BM + wr * 64 + fr, col0 = u.pn * BM + wc * 32 + 4 * fq;
    const int b = (u.pm * BM) / S;
    f32x4 gv[2][2];
#pragma unroll
    for (int bj = 0; bj < 2; ++bj)
#pragma unroll
      for (int n = 0; n < 2; ++n) gv[bj][n] = *(const f32x4*)(ga + b * 6144 + col0 + bj * HALF + n * 16);
#pragma unroll
    for (int ai = 0; ai < 2; ++ai)
#pragma unroll
      for (int m = 0; m < 4; ++m) {
        const size_t off = (size_t)(row0 + ai * HALF + m * 16) * 1024 + col0;
#pragma unroll
        for (int bj = 0; bj < 2; ++bj)
#pragma unroll
          for (int n = 0; n < 2; ++n) {
            const f32x4 xv = *(const f32x4*)(xin + off + bj * HALF + n * 16);
            *(f32x4*)(out + off + bj * HALF + n * 16) = xv + gv[bj][n] * acc[ai][bj][m][n];
          }
      }
  }
};
DEV float sig_(float x) { return 1.f / (1.f + __expf(-x)); }
template <bool SECOND>
struct EpiMerge {
  static constexpr bool PERM = true;
  bf16* Y; const bf16* proj; int gcol;
  DEV void operator()(const f32x4 (&acc)[2][2][4][2], const Unit& u, int wr, int wc, int fr, int fq) const {
    const int row0 = u.pm * BM + wr * 64 + fr, col0 = u.pn * BM + wc * 32 + 8 * fq;
#pragma unroll
    for (int ai = 0; ai < 2; ++ai)
#pragma unroll
      for (int m = 0; m < 4; ++m) {
        const size_t row = (size_t)(row0 + ai * HALF + m * 16);
#pragma unroll
        for (int bj = 0; bj < 2; ++bj) {
          const uint4 gq = *(const uint4*)(proj + row * PC + gcol + col0 + bj * HALF);
          float gf[8];
          unpack8(gq, gf);
          const f32x4 v0 = acc[ai][bj][m][0], v1 = acc[ai][bj][m][1];
          float o[8] = {sig_(gf[0]) * v0[0], sig_(gf[1]) * v0[1], sig_(gf[2]) * v0[2], sig_(gf[3]) * v0[3],
                        sig_(gf[4]) * v1[0], sig_(gf[5]) * v1[1], sig_(gf[6]) * v1[2], sig_(gf[7]) * v1[3]};
          bf16* yp = Y + row * 1024 + col0 + bj * HALF;
          if (SECOND) {
            float yf[8];
            unpack8(*(const uint4*)yp, yf);
#pragma unroll
            for (int j = 0; j < 8; ++j) o[j] += yf[j];
          }
          u32x4_t w;
          w.x = cvt2(o[0], o[1]); w.y = cvt2(o[2], o[3]); w.z = cvt2(o[4], o[5]); w.w = cvt2(o[6], o[7]);
          *(u32x4_t*)yp = w;
        }
      }
  }
};
struct EpiInproj {
  static constexpr bool PERM = true;
  char* ws;
  DEV void operator()(const f32x4 (&acc)[2][2][4][2], const Unit& u, int wr, int wc, int fr, int fq) const {
    const int b = (u.pm * BM) / S;
    const float* rope = (const float*)(ws + OFF_ROPE);
#pragma unroll
    for (int bj = 0; bj < 2; ++bj) {
      const int vcb = u.pn * BM + bj * HALF + wc * 32;
      if (vcb >= 4992) continue;
      const int vc0 = vcb & ~63, inh = vcb & 63;
      bf16* dbase; size_t dstride; bool roped = false; bool headmajor = false; int hh = 0, nh = 1;
      if (vc0 < 768) { dbase = (bf16*)(ws + OFF_PROJ) + vc0; dstride = PC; }
      else if (vc0 < 1280) {
        const int seg = (vc0 - 768) >> 7;
        const size_t off = (seg == 0) ? OFF_KSB : (seg == 1) ? OFF_VSB : (seg == 2) ? OFF_KWB : OFF_VWB;
        dbase = (bf16*)(ws + off); dstride = 64; headmajor = true; hh = ((vc0 - 768) >> 6) & 1; nh = 2;
        roped = (seg == 0) || (seg == 2);
      } else if (vc0 < 1792) { dbase = (bf16*)(ws + OFF_PROJ) + C_MQ + (vc0 - 1280); dstride = PC; roped = true; }
      else if (vc0 < 2816) {
        const int seg = (vc0 - 1792) >> 9;
        dbase = (bf16*)(ws + (seg ? OFF_MVB : OFF_MKB)); dstride = 64; headmajor = true; hh = ((vc0 - 1792) >> 6) & 7; nh = 8;
        roped = (seg == 0);
      } else if (vc0 < 4864) { dbase = (bf16*)(ws + OFF_PROJ) + C_GN + (vc0 - 2816); dstride = PC; }
      else { dbase = (bf16*)(ws + OFF_PROJ) + C_NG + (vc0 - 4864); dstride = PC; }
      const bool do_rope = roped && inh == 0;
#pragma unroll
      for (int ai = 0; ai < 2; ++ai)
#pragma unroll
        for (int m = 0; m < 4; ++m) {
          const int row = u.pm * BM + ai * HALF + wr * 64 + m * 16 + fr;
          const int t = row - b * S;
          const f32x4 v0 = acc[ai][bj][m][0], v1 = acc[ai][bj][m][1];
          float o[8] = {v0[0], v0[1], v0[2], v0[3], v1[0], v1[1], v1[2], v1[3]};
          if (do_rope) {
            float pv[8];
#pragma unroll
            for (int j = 0; j < 8; ++j) pv[j] = shx(o[j], 16);
            const f32x4 c0 = *(const f32x4*)(rope + (size_t)t * 16), c1 = *(const f32x4*)(rope + (size_t)t * 16 + 4);
            const f32x4 s0 = *(const f32x4*)(rope + (size_t)t * 16 + 8), s1 = *(const f32x4*)(rope + (size_t)t * 16 + 12);
            const float cs[8] = {c0[0], c0[1], c0[2], c0[3], c1[0], c1[1], c1[2], c1[3]};
            const float sn[8] = {s0[0], s0[1], s0[2], s0[3], s1[0], s1[1], s1[2], s1[3]};
            const float sg = (fq == 0) ? -1.f : 1.f;
#pragma unroll
            for (int j = 0; j < 8; ++j) o[j] = (fq < 2) ? (o[j] * cs[j] + sg * pv[j] * sn[j]) : o[j];
          }
          bf16* dp = headmajor ? (dbase + ((size_t)(b * nh + hh) * S + t) * 64 + inh + 8 * fq)
                               : (dbase + (size_t)row * dstride + inh + 8 * fq);
          u32x4_t w;
          w.x = cvt2(o[0], o[1]); w.y = cvt2(o[2], o[3]); w.z = cvt2(o[4], o[5]); w.w = cvt2(o[6], o[7]);
          *(u32x4_t*)dp = w;
        }
    }
  }
};
}

template <class F>
DEV void for_tiles_xcd(int MT, int NT, F f) {
  const int nb = vnb(), bid = vbid();
  if ((nb & 15) != 0) {
    for (int it = bid; it < MT * NT; it += nb) f(it / NT, it % NT);
    return;
  }
  const int xcd = (bid >> 1) & 7, slot = ((bid >> 4) << 1) | (bid & 1), nslot = nb >> 3;
  const int nj = (NT - xcd + 7) >> 3;
  for (int q = slot; q < MT * nj; q += nslot) f(q / nj, xcd + 8 * (q % nj));
}
constexpr int PH_PER_LAYER = 15;
enum { SP_NORM1 = 0, SP_INPROJ = 1, SP_COMPRESS = 2, SP_KMEAN = 3, SP_ATTN = 4, SP_MP0 = 5, SP_MM0 = 6, SP_MP1 = 7, SP_MM1 = 8,
       SP_MERGE = 9, SP_OUTPROJ = 10, SP_NORM2 = 11, SP_PEERQ = 12, SP_TOPK = 13, SP_EXPERT = 14 };
constexpr int N_REAL_PHASES = 1 + 2 * PH_PER_LAYER + 1;
constexpr int N_PHASES = N_REAL_PHASES + (PROBE_ANY ? 2 : 0);

DEV void run_phase(const Params& p, int ph, char* smem_raw, bool second_pass = false) {
#define SKIP_MOBA_SECOND (REP_NSA_ONLY && second_pass)
  LAS unsigned char* lds_all = (LAS unsigned char*)smem_raw;
  smem_raw += hidx() * SMEM_BYTES;
  float* smf = (float*)smem_raw;
  bf16* smh = (bf16*)smem_raw;
  const int nb = vnb(), bid = vbid();
  if (ph == 0) {
    for (int it = bid; it < PREP_ITEMS; it += nb) prep_item(p, it, smf);
    return;
  }
  if (ph == N_REAL_PHASES - 1) {
    for (int it = bid; it < T / 4; it += nb) final_norm_item(p.out, p.g_final, it);
    return;
  }
#if PROBE_ANY
  if (ph == N_REAL_PHASES) {
#if PROBE_PROJ
    {
      const unsigned char* Hh = (const unsigned char*)(p.ws + OFF_H8);
      const unsigned char* Wt = (const unsigned char*)(p.ws + OFF_WINT) + (size_t)1 * WN * 1024;
      const unsigned char* hsc = (const unsigned char*)(p.ws + OFF_H8S);
      const unsigned char* wsc = (const unsigned char*)(p.ws + OFF_WCS) + WN;
      const float* rope = (const float*)(p.ws + OFF_ROPE);
      float sd = 0.f, sr = 0.f;
      for (size_t i = (size_t)bid * 256 + tidx(); i < (size_t)(T / 64) * 4888; i += (size_t)nb * 256) {
        const int ts = (int)(i / 4888), vc = (int)(i % 4888);
        const int tok = ts * 64 + (ts % 61);
        const int b = tok / S, t = tok % S;
        auto rawdot = [&](int col) {
          float a = 0.f;
          for (int k = 0; k < 1024; ++k) {
            const f32x2_t hv = __builtin_amdgcn_cvt_pk_f32_fp8((int)Hh[(size_t)tok * 1024 + k], false);
            const f32x2_t wv = __builtin_amdgcn_cvt_pk_f32_fp8((int)Wt[(size_t)col * 1024 + k], false);
            a += hv.x * wv.x;
          }
          return a * __int_as_float((int)hsc[tok] << 23) * __int_as_float((int)wsc[col] << 23);
        };
        float v = rawdot(vc);
        bool roped = false;
        const bf16* dst;
        if (vc < 768) dst = (const bf16*)(p.ws + OFF_PROJ) + (size_t)tok * PC + vc;
        else if (vc < 1280) {
          const int seg = (vc - 768) >> 7, head = ((vc - 768) >> 6) & 1, d = vc & 63;
          const size_t off = (seg == 0) ? OFF_KSB : (seg == 1) ? OFF_VSB : (seg == 2) ? OFF_KWB : OFF_VWB;
          dst = (const bf16*)(p.ws + off) + ((size_t)(b * 2 + head) * S + t) * 64 + d;
          roped = (seg == 0 || seg == 2);
        } else if (vc < 1792) { dst = (const bf16*)(p.ws + OFF_PROJ) + (size_t)tok * PC + C_MQ + (vc - 1280); roped = true; }
        else if (vc < 2816) {
          const int seg = (vc - 1792) >> 9, head = ((vc - 1792) >> 6) & 7, d = vc & 63;
          dst = (const bf16*)(p.ws + (seg ? OFF_MVB : OFF_MKB)) + ((size_t)(b * 8 + head) * S + t) * 64 + d;
          roped = (seg == 0);
        } else if (vc < 4864) dst = (const bf16*)(p.ws + OFF_PROJ) + (size_t)tok * PC + C_GN + (vc - 2816);
        else dst = (const bf16*)(p.ws + OFF_PROJ) + (size_t)tok * PC + C_NG + (vc - 4864);
        const int d = vc & 63;
        if (roped && d < 16) {
          const float cs = rope[(size_t)t * 16 + (d & 7)], sn = rope[(size_t)t * 16 + 8 + (d & 7)];
          if (d < 8) { const float x2 = rawdot(vc + 8); v = v * cs - x2 * sn; }
          else { const float x1 = rawdot(vc - 8); v = v * cs + x1 * sn; }
        }
        const float got = bf2f(*dst);
        const bool is_r = roped && d < 16;
        if (PROBE_PROJ == 1 || (PROBE_PROJ == 2 && is_r) || (PROBE_PROJ == 3 && !is_r)) {
          sd += (got - v) * (got - v);
          sr += v * v;
        }
      }
      sd = wave_sum(sd); sr = wave_sum(sr);
      if ((tidx() & 63) == 0) {
        atomicAdd((float*)(p.ws + OFF_PROBE), sd);
        atomicAdd((float*)(p.ws + OFF_PROBE) + 1, sr);
      }
    }
#endif
#if PROBE_CMPR
    {
      float sd = 0.f, sr = 0.f;
      for (size_t i = (size_t)bid * 256 + tidx(); i < (size_t)2 * Bn * 1024 * 128; i += (size_t)nb * 256) {
        const size_t wh = i / ((size_t)Bn * 1024 * 128), r = i % ((size_t)Bn * 1024 * 128);
        const int c = (int)((r / 128) % 1024);
        if (c < 1023) {
          const float a = ((const float*)(p.ws + (wh ? OFF_VCC : OFF_KCC)))[r];
          const float y = ((const float*)(p.ws + OFF_CMP))[i];
          sd += (a - y) * (a - y);
          sr += y * y;
        }
      }
      sd = wave_sum(sd); sr = wave_sum(sr);
      if ((tidx() & 63) == 0) {
        atomicAdd((float*)(p.ws + OFF_PROBE), sd);
        atomicAdd((float*)(p.ws + OFF_PROBE) + 1, sr);
      }
    }
#endif
#if PROBE_MOBA
    probe_accum_bf16(p, (const bf16*)(p.ws + OFF_OMOBA), (const bf16*)(p.ws + OFF_CMP), (size_t)S * 512, smf);
#endif
#if PROBE_NSA == 8
    {
      const float* impn = (const float*)(p.ws + OFF_OMOBA);
      const float* impm = impn + (size_t)S * 256;
      const int* seld = (const int*)(p.ws + OFF_CMP);
      float sd = 0.f, sr = 0.f, bad = 0.f;
      for (int t = bid * 256 + tidx(); t < S; t += nb * 256) {
        const int cur = t >> 6;
        for (int n = 0; n < 256; ++n) {
          float a = impm[(size_t)t * 256 + n], r = impn[(size_t)t * 256 + n];
          sd += (a - r) * (a - r);
          sr += r * r;
        }
        unsigned want[8] = {0, 0, 0, 0, 0, 0, 0, 0}, got[8] = {0, 0, 0, 0, 0, 0, 0, 0};
        for (int j = 0; j < 16; ++j) {
          int v = seld[(size_t)t * 16 + j];
          if (v >= 0 && v < 256) {
            for (int w = 0; w < 8; ++w) if ((v >> 5) == w) got[w] |= 1u << (v & 31);
          }
        }
        if (cur < 16) {
          for (int n = 0; n <= cur; ++n) want[0] |= 1u << n;
        } else {
          want[0] |= 1u;
          for (int w = 0; w < 8; ++w) {
            if (((cur - 1) >> 5) == w) want[w] |= 1u << ((cur - 1) & 31);
            if ((cur >> 5) == w) want[w] |= 1u << (cur & 31);
          }
          for (int j = 0; j < 13; ++j) {
            float best = -1.f;
            int bi = 1;
            for (int n = 1; n <= cur - 2; ++n) {
              bool taken = false;
              for (int w = 0; w < 8; ++w) if ((n >> 5) == w) taken = (want[w] >> (n & 31)) & 1u;
              float v = impm[(size_t)t * 256 + n];
              if (!taken && v > best) { best = v; bi = n; }
            }
            for (int w = 0; w < 8; ++w) if ((bi >> 5) == w) want[w] |= 1u << (bi & 31);
          }
        }
        bool same = true;
        for (int w = 0; w < 8; ++w) same = same && (want[w] == got[w]);
        if (!same) bad += 1.f;
      }
      sd = wave_sum(sd); sr = wave_sum(sr); bad = wave_sum(bad);
      if ((tidx() & 63) == 0) {
        atomicAdd((float*)(p.ws + OFF_PROBE), sd);
        atomicAdd((float*)(p.ws + OFF_PROBE) + 1, sr);
        atomicAdd((float*)(p.ws + OFF_PROBE) + 2, bad);
      }
    }
#elif PROBE_NSA
    probe_accum_bf16(p, (const bf16*)(p.ws + OFF_ONSA), (const bf16*)(p.ws + OFF_CMP), (size_t)S * 512, smf);
#endif
    return;
  }
  if (ph == N_REAL_PHASES + 1) {
    probe_apply(p);
    return;
  }
#endif
  const int layer = (ph - 1) / PH_PER_LAYER, sub = (ph - 1) % PH_PER_LAYER;
  const float* mod = (const float*)(p.ws + OFF_MOD) + (size_t)layer * 2 * 6144;
  const float* xin = (layer == 0) ? p.x : p.out;
  bf16* H = (bf16*)(p.ws + OFF_H);
  bf16* PROJ = (bf16*)(p.ws + OFF_PROJ);
#if PROBE_ANY
  if (sub >= SP_MERGE) {
    if (sub == SP_OUTPROJ && layer == 0)
      for (size_t i = (size_t)bid * 256 + tidx(); i < (size_t)T * 1024; i += (size_t)nb * 256) p.out[i] = p.x[i];
    return;
  }
#endif
  switch (sub) {
    case SP_NORM1:
      for (int it = bid; it < T / 4; it += nb)
        norm8_item(xin, p.g_attn + layer * 1024, mod + 1024, mod + 0, (unsigned char*)(p.ws + OFF_H8), (unsigned char*)(p.ws + OFF_H8S), it);
      if (layer == 0)
        for (int it = bid; it < WQ8_ITEMS; it += nb) wq8_item(p, it, smf);
      break;
    case SP_INPROJ: {
      g8::StaticOrder so;
      so.init(T, WN, (int)gridDim.x, (int)blockIdx.x, WGM_INPROJ);
      g8::gemm_phase<g8::EpiInproj, true>(lds_all, g8::Gemm{(const bf16*)(p.ws + OFF_H8), (const bf16*)(p.ws + OFF_WINT + (size_t)layer * WN * 1024), T, WN, 512,
                                                             (const unsigned char*)(p.ws + OFF_H8S), (const unsigned char*)(p.ws + OFF_WCS) + (size_t)layer * WN},
                                          so, g8::EpiInproj{p.ws});
    } break;
    case SP_COMPRESS:
      for (int it = bid; it < 512 + 1024 + 256; it += nb) {
        if (it < 512) compress_mfma_item(p, layer, it, smem_raw);
        else if (it < 1536) kmean_item(p, it - 512, smf);
        else kvamax_item(p, layer, it - 1536);
      }
#if PROBE_CMPR
      if (layer == 1)
        for (int it = bid; it < 1024; it += nb) compress_item(p, layer, it, smf);
#endif
      break;
    case SP_KMEAN:
      for (int it = bid; it < 1024; it += nb) kvq_item(p, layer, it, smf);
#if PROBE_NSA
      if (layer == 1)
        for (int it = bid; it < 512; it += nb) n1_item(p, layer, it, smf);
#endif
      break;
    case SP_ATTN:
      {
        constexpr int MNI = 2;
        constexpr int NMOBA = 16 * (S / (64 * MNI));
        constexpr int NNI = 2;
        constexpr int NNSA = 4 * (S / (16 * NNI));
        const bool do_nsa = !PROBE_ANY || PROBE_NSA, do_moba = (!PROBE_ANY || PROBE_MOBA) && PROBE_NSA != 8;
        {
          constexpr int NCH = S / (16 * NNI);
          const bool affine = nb >= 8;
          const int grp = bid & 7, bk = grp & 3, sub = grp >> 2;
          const int i0 = affine ? (bid >> 3) : bid;
          const int istride = affine ? ((nb - grp + 7) >> 3) : nb;
          const int icount = affine ? (NCH / 2) : NNSA;
          if (do_nsa) {
            const bool snake = affine && (nb & 7) == 0 && (icount % (2 * istride)) == 0;
            int k = 0;
            for (int i = i0; i < icount; i += istride, ++k) {
              const int ii = snake ? ((k & 1) ? ((k + 1) * istride - 1 - i0) : (k * istride + i0)) : i;
              nsa_item<NNI>(p, layer, affine ? (((2 * ii + sub) << 2) | bk) : ii, smem_raw, (bf16*)(p.ws + OFF_ONSA));
            }
          }
          if (do_moba && !SKIP_MOBA_SECOND)
          {
            const int ngi = (NMOBA - (bid & ~1) + nb - 1) / nb;
            for (int j0 = 0; j0 < ngi; j0 += 4) {
              const int first = bid + j0 * nb;
              int nit = ngi - j0 < 4 ? ngi - j0 : 4;
              while (nit > 0 && first + (nit - 1) * nb >= NMOBA) --nit;
              moba_gate_batch<MNI>(p, first, nb, nit, (int*)smf);
            }
          }
        }
#if PROBE_NSA && PROBE_NSA != 8
        if (layer == 1)
          for (int it = bid; it < 512; it += nb) n23_item(p, layer, it);
#endif
#if PROBE_MOBA
        if (layer == 1) {
          for (int it = bid; it < 512; it += nb) moba_item(p, layer, it);
        }
#endif
      }
      break;
    case SP_MP0:
    case SP_MP1:
      if ((!PROBE_ANY || PROBE_MOBA) && PROBE_NSA != 8)
        {
          constexpr int NIT = 8 * 63 * MOBA_NPART;
          int k = 0;
          for (int it = bid; it < ((NIT + nb - 1) / nb) * nb; it += nb, ++k) {
            const int ii = (k & 1) ? ((k + 1) * nb - 1 - bid) : it;
            if (ii < NIT) moba_part_item2<2>(p, sub == SP_MP1 ? 1 : 0, ii, smem_raw);
          }
        }
      break;
    case SP_MM0:
    case SP_MM1:
      if ((!PROBE_ANY || PROBE_MOBA) && PROBE_NSA != 8)
        for (int it = bid; it < 8 * (S / 128); it += nb)
          moba_merge_item<2>(p, sub == SP_MM1 ? 1 : 0, it, smem_raw, (bf16*)(p.ws + OFF_OMOBA));
      break;
    case SP_MERGE:
      {
        g8::StaticOrder so;
        so.init(T, 1024, (int)gridDim.x, (int)blockIdx.x, WGM_N1024);
        g8::gemm_phase(lds_all, g8::Gemm{(const bf16*)(p.ws + OFF_ONSA), (const bf16*)(p.ws + OFF_WUPN) + (size_t)layer * 1024 * 512, T, 1024, 512}, so,
                       g8::EpiMerge<false>{H, PROJ, C_GN});
        g8::gemm_phase(lds_all, g8::Gemm{(const bf16*)(p.ws + OFF_OMOBA), (const bf16*)(p.ws + OFF_WUPM) + (size_t)layer * 1024 * 512, T, 1024, 512}, so,
                       g8::EpiMerge<true>{H, PROJ, C_GM});
      }
      break;
    case SP_OUTPROJ: {
      const bf16* W = (const bf16*)(p.ws + OFF_WOUT) + (size_t)layer * 1024 * 1024;
      const float* ga1 = mod + 2048;
      g8::StaticOrder so;
      so.init(T, 1024, (int)gridDim.x, (int)blockIdx.x, WGM_N1024);
      g8::gemm_phase(lds_all, g8::Gemm{H, W, T, 1024, 1024}, so, g8::EpiResid{xin, p.out, ga1});
    } break;
    case SP_NORM2:
      for (int it = bid; it < T / 4 + NEXP / 4; it += nb) {
        if (it < T / 4) norm_item(p.out, p.g_ffn + layer * 1024, mod + 4096, mod + 3072, H, it);
        else expert_cvt_item(p, layer, it - T / 4);
      }
      break;
    case SP_PEERQ: {
      const bf16* W = (const bf16*)(p.ws + OFF_WQ) + (size_t)layer * 2048 * 1024;
      bf16* QP = (bf16*)(p.ws + OFF_QP);
      g8::StaticOrder so;
      so.init(T, 2048, (int)gridDim.x, (int)blockIdx.x, WGM_N2048);
      g8::gemm_phase(lds_all, g8::Gemm{H, W, T, 2048, 1024}, so, g8::EpiBf16{QP, 2048});
    } break;
    case SP_TOPK:
#if REP_MASK
      for (int it = bid; it < T / 8; it += nb) peer_topk_item3(p, layer, it);
#endif
      break;
    case SP_EXPERT:
#if REP_MASK
      for (int it = bid; it < T / 4; it += nb) peer_expert_item2(p, layer, it, second_pass ? 0.f : 1.f);
#else
      for (int it = bid; it < T / 8; it += nb) peer_fused_item(p, layer, it, smem_raw);
#endif
      break;
  }
}

#define MEGA_LB __launch_bounds__(512, 2)
__global__ void MEGA_LB mega_kernel(Params p, int ph_lo, int ph_hi) {
  __shared__ __attribute__((aligned(16))) char smem_raw[2 * SMEM_BYTES + 16];
  volatile LAS unsigned* xbst = (volatile LAS unsigned*)(smem_raw + 2 * SMEM_BYTES);
  if (threadIdx.x == 0) { xbst[0] = 0u; xbst[1] = 0u; xbst[2] = 0u; xbst[3] = 0u; }
  __syncthreads();
  XcdBarrier xb = xcd_barrier_post((unsigned*)(p.ws + OFF_BAR), xbst);
  for (int ph = ph_lo; ph < ph_hi; ++ph) {
#if !PROBE_ANY && !REP_MASK
    if (ph == N_REAL_PHASES - 1 || ph == 1 + PH_PER_LAYER || (ph >= 1 && (ph - 1) % PH_PER_LAYER == SP_TOPK))
      continue;
#endif
#if REP_MASK
    const int nrep = (ph >= 1 && ph < N_REAL_PHASES - 1 && ((REP_MASK >> ((ph - 1) % PH_PER_LAYER)) & 1)) ? 2 : 1;
    for (int rep = 0; rep < nrep; ++rep) {
      if (rep) xcd_barrier(xb);
      run_phase(p, ph, smem_raw, rep != 0);
    }
#else
    run_phase(p, ph, smem_raw);
#endif
    if (ph + 1 < ph_hi) {
      if (ph == ph_lo) cg::this_grid().sync();
      else xcd_barrier(xb);
    }
  }
}

extern "C" void kernel_launch(void* const* d_in, const int* in_sizes, int n_in, void* d_out, int out_size, void* d_ws,
                              size_t ws_size, hipStream_t stream) {
  if (ws_size < WS_TOTAL) {
    fprintf(stderr, "workspace too small: %zu < %zu\n", ws_size, (size_t)WS_NEED);
    return;
  }
  Params p{};
  p.x = (const float*)d_in[0]; p.c = (const float*)d_in[1]; p.w_ada = (const float*)d_in[2];
  p.b_ada = (const float*)d_in[3]; p.g_attn = (const float*)d_in[4]; p.g_ffn = (const float*)d_in[5];
  p.w_in = (const float*)d_in[6]; p.cmp_pe = (const float*)d_in[7]; p.cmp_w1 = (const float*)d_in[8];
  p.cmp_w2 = (const float*)d_in[9]; p.w_up_nsa = (const float*)d_in[10]; p.w_up_moba = (const float*)d_in[11];
  p.w_out = (const float*)d_in[12]; p.peer_wq = (const float*)d_in[13]; p.peer_k1 = (const float*)d_in[14];
  p.peer_k2 = (const float*)d_in[15]; p.peer_u = (const float*)d_in[16]; p.peer_v = (const float*)d_in[17];
  p.g_final = (const float*)d_in[18];
  p.out = (float*)d_out;
  p.ws = (char*)d_ws;
  static int grid_blocks = 0;
  if (!grid_blocks) {
    int dev = 0, cus = 0, per_cu = 0;
    hipGetDevice(&dev);
    hipDeviceGetAttribute(&cus, hipDeviceAttributeMultiprocessorCount, dev);
    hipOccupancyMaxActiveBlocksPerMultiprocessor(&per_cu, mega_kernel, 512, 0);
    if (per_cu < 1) per_cu = 1;
    if (per_cu > 1) per_cu = 1;
    grid_blocks = cus * per_cu;
  }
  hipMemsetAsync((char*)d_ws + OFF_BAR, 0, BAR_BYTES, stream);
  int ph_lo = 0, ph_hi = N_PHASES;
  void* args[] = {(void*)&p, (void*)&ph_lo, (void*)&ph_hi};
  hipError_t e = hipLaunchCooperativeKernel((const void*)mega_kernel, dim3(grid_blocks), dim3(512), args, 0, stream);
  if (e != hipSuccess) fprintf(stderr, "cooperative launch failed: %s (grid %d)\n", hipGetErrorString(e), grid_blocks);
}
```

```cpp
#define WGM_INPROJ 4
#define WGM_N1024 4
#define WGM_N2048 4
#include <hip/hip_runtime.h>
#include <hip/hip_bf16.h>
#include <hip/hip_cooperative_groups.h>
#include <cstdio>
#include <cstdint>
namespace cg = cooperative_groups;

#define DEV __device__ __forceinline__
typedef unsigned short bf16;
using bf16x8 = __attribute__((ext_vector_type(8))) short;
using f32x4 = __attribute__((ext_vector_type(4))) float;

constexpr int Bn = 2, S = 16384, T = Bn * S, D = 1024;
constexpr int PC = 3456;
constexpr int WN = 5120;
constexpr int C_NQ = 0, C_KC = 512, C_VC = 640, C_MQ = 768, C_GN = 1280, C_GM = 2304, C_NG = 3328;
constexpr int NEXP = 16384;

constexpr size_t al(size_t x) { return (x + 255) & ~size_t(255); }
constexpr size_t OFF_MOD = 0;
constexpr size_t OFF_ROPE = al(OFF_MOD + 2 * 2 * 6144 * 4);
constexpr size_t OFF_PEB = al(OFF_ROPE + (size_t)S * 16 * 4);
constexpr size_t OFF_WINT = al(OFF_PEB + 2 * 2 * 128 * 4);
constexpr size_t OFF_WUPN = al(OFF_WINT + 2ull * WN * 1024 * 2);
constexpr size_t OFF_WUPM = al(OFF_WUPN + 2ull * 1024 * 512 * 2);
constexpr size_t OFF_WOUT = al(OFF_WUPM + 2ull * 1024 * 512 * 2);
constexpr size_t OFF_WQ = al(OFF_WOUT + 2ull * 1024 * 1024 * 2);
constexpr size_t OFF_KCC = al(OFF_WQ + 2ull * 2048 * 1024 * 2);
constexpr size_t OFF_VCC = al(OFF_KCC + 2ull * 1024 * 128 * 4);
constexpr size_t OFF_SEL = al(OFF_VCC + 2ull * 1024 * 128 * 4);
constexpr size_t OFF_KMEAN = al(OFF_SEL + 2ull * 2 * S * 16 * 4);
constexpr size_t OFF_KMHL = al(OFF_KMEAN + 2ull * 8 * 64 * 64 * 4);
constexpr size_t OFF_KCB = al(OFF_KMHL + 2ull * 2 * 8 * 64 * 64 * 2);
constexpr size_t OFF_VCB = al(OFF_KCB + 2ull * 2 * 1024 * 64 * 2);
constexpr size_t OFF_PKB = al(OFF_VCB + 2ull * 2 * 1024 * 64 * 2);
constexpr size_t OFF_W1T = al(OFF_PKB + 2ull * 2 * 128 * 128 * 2);
constexpr size_t OFF_BAR = al(OFF_W1T + 4ull * 128 * 2048 * 2);
constexpr size_t BAR_BYTES = 3456 * 4;
constexpr size_t OFF_PROBE = al(OFF_BAR + BAR_BYTES);
constexpr size_t OFF_H = al(OFF_PROBE + 256);
constexpr size_t OFF_WCS = OFF_WINT + 2ull * WN * 1024;
constexpr size_t OFF_ONSA = al(OFF_H + (size_t)T * 1024 * 2);
constexpr size_t OFF_OMOBA = al(OFF_ONSA + (size_t)T * 512 * 2);
constexpr size_t OFF_H8 = OFF_ONSA;
constexpr size_t OFF_H8S = OFF_OMOBA;
constexpr size_t OFF_PROJ = al(OFF_OMOBA + (size_t)T * 512 * 2);
constexpr size_t KV2_BYTES = (size_t)Bn * 2 * S * 64 * 2, KV8_BYTES = (size_t)Bn * 8 * S * 64 * 2;
constexpr size_t OFF_KSB = al(OFF_PROJ + (size_t)T * PC * 2);
constexpr size_t OFF_VSB = OFF_KSB + KV2_BYTES;
constexpr size_t OFF_KWB = OFF_VSB + KV2_BYTES;
constexpr size_t OFF_VWB = OFF_KWB + KV2_BYTES;
constexpr size_t OFF_MKB = OFF_VWB + KV2_BYTES;
constexpr size_t OFF_MVB = OFF_MKB + KV8_BYTES;
constexpr int MLIST_PER_BH = 63 * S - 128 * 63 * 64;
constexpr size_t OFF_MLIST = OFF_MVB + KV8_BYTES;
constexpr int MCNT_STRIDE = 32;
constexpr size_t OFF_MCNT = al(OFF_MLIST + (size_t)Bn * 8 * MLIST_PER_BH * 2);
constexpr size_t OFF_KS8 = al(OFF_MCNT + (size_t)Bn * 8 * 64 * 4 * MCNT_STRIDE);
constexpr size_t OFF_VT8 = OFF_KS8 + (size_t)Bn * 2 * S * 64;
constexpr size_t WS_NEED = OFF_VT8 + (size_t)Bn * 2 * S * 64;
constexpr size_t PROJ_BYTES = (size_t)T * PC * 2;
constexpr size_t OFF_MPO = OFF_H;
constexpr size_t OFF_MPML = OFF_H + (size_t)8 * S * 3 * 64 * 2;
static_assert((size_t)8 * S * 3 * 64 * 2 + (size_t)8 * S * 3 * 8 <= (size_t)T * 1024 * 2, "moba partials must fit the H region");
constexpr size_t OFF_QP = OFF_PROJ;
constexpr size_t OFF_PEIDX = al(OFF_QP + (size_t)T * 2048 * 2);
constexpr size_t OFF_PEG = al(OFF_PEIDX + (size_t)T * 128 * 4);
constexpr size_t OFF_E8 = al(OFF_PEG + (size_t)T * 128 * 4);
constexpr size_t OFF_ESC = al(OFF_E8 + (size_t)NEXP * 2048);
static_assert(OFF_ESC + (size_t)NEXP * 2 * 4 <= OFF_PROJ + PROJ_BYTES, "peer alias overflow");
static_assert(WS_NEED <= 536870912ull, "workspace too big");
#ifndef PROBE_MOBA
#define PROBE_MOBA 0
#endif
constexpr size_t OFF_CMP = PROBE_MOBA ? OFF_ONSA : OFF_MLIST;
#ifndef WGM_INPROJ
#define WGM_INPROJ 4
#endif
#ifndef WGM_N1024
#define WGM_N1024 8
#endif
#ifndef WGM_N2048
#define WGM_N2048 8
#endif
#ifndef MOBA_NPART
#define MOBA_NPART 4
#endif
#ifndef REP_NSA_ONLY
#define REP_NSA_ONLY 0
#endif
#ifndef REP_NSA_PART
#define REP_NSA_PART 0
#endif
#ifndef REP_MASK
#define REP_MASK 0
#endif
#ifndef PROBE_MOBA
#define PROBE_MOBA 0
#endif
#ifndef PROBE_NSA
#define PROBE_NSA 0
#endif
#ifndef PROBE_CMPR
#define PROBE_CMPR 0
#endif
#ifndef PROBE_PROJ
#define PROBE_PROJ 0
#endif
#define PROBE_ANY (PROBE_MOBA || PROBE_NSA || PROBE_CMPR || PROBE_PROJ)
constexpr int ATT_LD = PROBE_ANY ? 512 : 1024;
constexpr size_t OFF_OMOBA_OUT = PROBE_ANY ? OFF_OMOBA : OFF_ONSA + 512 * 2;
constexpr size_t WS_TOTAL = WS_NEED;
static_assert(WS_TOTAL <= 536870912ull, "workspace too big (probe)");

struct Params {
  const float *x, *c, *w_ada, *b_ada, *g_attn, *g_ffn, *w_in, *cmp_pe, *cmp_w1, *cmp_w2, *w_up_nsa, *w_up_moba, *w_out,
      *peer_wq, *peer_k1, *peer_k2, *peer_u, *peer_v, *g_final;
  float* out;
  char* ws;
};

constexpr int SMEM_BYTES = 74 * 1024;

DEV int tidx() {
  int t = threadIdx.x & 255;
  asm volatile("" : "+v"(t));
  return t;
}
DEV int hidx() { return __builtin_amdgcn_readfirstlane((int)(threadIdx.x >> 8)); }
DEV int vbid() { return (int)blockIdx.x * 2 + hidx(); }
DEV int vnb() { return (int)gridDim.x * 2; }
#define MFMA16B(a, b, c) __builtin_amdgcn_mfma_f32_16x16x32_bf16(a, b, c, 0, 0, 0)
DEV unsigned cvtpk_(float lo, float hi) {
  unsigned r;
  asm("v_cvt_pk_bf16_f32 %0, %1, %2" : "=v"(r) : "v"(lo), "v"(hi));
  return r;
}
DEV float bf2f(bf16 h) { return __uint_as_float(((unsigned)h) << 16); }
DEV bf16 f2bf(float f) {
  unsigned u = __float_as_uint(f);
  u += 0x7fffu + ((u >> 16) & 1u);
  return (bf16)(u >> 16);
}
DEV float gelu_tanh(float x) {
  float u = 0.7978845608028654f * (x + 0.044715f * x * x * x);
  return 0.5f * x * (1.f + tanhf(u));
}
DEV float sigmoidf_(float x) { return 1.f / (1.f + expf(-x)); }
DEV void unpack8(uint4 v, float* f) {
  f[0] = __uint_as_float(v.x << 16); f[1] = __uint_as_float(v.x & 0xffff0000u);
  f[2] = __uint_as_float(v.y << 16); f[3] = __uint_as_float(v.y & 0xffff0000u);
  f[4] = __uint_as_float(v.z << 16); f[5] = __uint_as_float(v.z & 0xffff0000u);
  f[6] = __uint_as_float(v.w << 16); f[7] = __uint_as_float(v.w & 0xffff0000u);
}
DEV float dot64_bf(const float* q, const bf16* row) {
  float s = 0.f;
#pragma unroll
  for (int i = 0; i < 8; ++i) {
    float f[8];
    unpack8(*(const uint4*)(row + i * 8), f);
#pragma unroll
    for (int j = 0; j < 8; ++j) s += q[i * 8 + j] * f[j];
  }
  return s;
}
DEV void axpy64_bf(float* o, float a, const bf16* row) {
#pragma unroll
  for (int i = 0; i < 8; ++i) {
    float f[8];
    unpack8(*(const uint4*)(row + i * 8), f);
#pragma unroll
    for (int j = 0; j < 8; ++j) o[i * 8 + j] += a * f[j];
  }
}
DEV float dot64_f(const float* q, const float* row) {
  float s = 0.f;
#pragma unroll
  for (int i = 0; i < 16; ++i) {
    float4 v = *(const float4*)(row + i * 4);
    s += q[i * 4] * v.x + q[i * 4 + 1] * v.y + q[i * 4 + 2] * v.z + q[i * 4 + 3] * v.w;
  }
  return s;
}
DEV void axpy64_f(float* o, float a, const float* row) {
#pragma unroll
  for (int i = 0; i < 16; ++i) {
    float4 v = *(const float4*)(row + i * 4);
    o[i * 4] += a * v.x; o[i * 4 + 1] += a * v.y; o[i * 4 + 2] += a * v.z; o[i * 4 + 3] += a * v.w;
  }
}
DEV void load_q64(float* q, const bf16* p, float scale) {
#pragma unroll
  for (int i = 0; i < 8; ++i) unpack8(*(const uint4*)(p + i * 8), q + i * 8);
#pragma unroll
  for (int i = 0; i < 64; ++i) q[i] *= scale;
}
DEV int lane_id_() { return __builtin_amdgcn_mbcnt_hi(~0u, __builtin_amdgcn_mbcnt_lo(~0u, 0u)); }
DEV int shx(int v, int m) {
  if (m == 1) return __builtin_amdgcn_update_dpp(0, v, 0xB1, 0xF, 0xF, true);
  if (m == 2) return __builtin_amdgcn_update_dpp(0, v, 0x4E, 0xF, 0xF, true);
  if (m == 4) return __builtin_amdgcn_ds_swizzle(v, 0x101F);
  if (m == 8) return __builtin_amdgcn_update_dpp(0, v, 0x128, 0xF, 0xF, true);
  if (m == 16) return __builtin_amdgcn_ds_swizzle(v, 0x401F);
  auto rr = __builtin_amdgcn_permlane32_swap((unsigned)v, (unsigned)v, false, false);
  return (lane_id_() < 32) ? (int)rr[1] : (int)rr[0];
}
DEV unsigned shx(unsigned v, int m) { return (unsigned)shx((int)v, m); }
DEV float shx(float v, int m) { return __int_as_float(shx(__float_as_int(v), m)); }
DEV float wave_sum(float v) {
#pragma unroll
  for (int o = 32; o >= 1; o >>= 1) v += shx(v, o);
  return v;
}

#define XB_TMO      128
#define XB_XCNT(j)  (256  + 64 * (j))
#define XB_XSUB(j)  (1280 + 64 * (j))
#define XB_XGEN(j)  (2304 + 64 * (j))
#define XB_TOP      3328
#define XB_TOPGEN   3392
#define XCD_BAR_WORDS 3456
#define XB_SPIN_CAP (1u << 18)
#define LAS __attribute__((address_space(3)))

__device__ __forceinline__ unsigned xb_ld(unsigned* p)              { return __hip_atomic_load(p, __ATOMIC_RELAXED, __HIP_MEMORY_SCOPE_AGENT); }
__device__ __forceinline__ unsigned xb_add(unsigned* p, unsigned v) { return __hip_atomic_fetch_add(p, v, __ATOMIC_RELAXED, __HIP_MEMORY_SCOPE_AGENT); }
__device__ __forceinline__ unsigned xb_xcc_id() { return (unsigned)__builtin_amdgcn_s_getreg((3 << 11) | 20) & 0xFu; }
#define XB_SPIN(cond, bar) do { unsigned _sp = 0; while (cond) { __builtin_amdgcn_s_sleep(1); \
    if ((++_sp & 255u) == 0u) { if (xb_ld(&(bar)[XB_TMO])) break; if (_sp > XB_SPIN_CAP) { atomicAdd(&(bar)[XB_TMO], 1u); break; } } } } while (0)

struct XcdBarrier {
    unsigned* bar; unsigned x;
    volatile LAS unsigned* st;
};

__device__ __forceinline__ XcdBarrier xcd_barrier_post(unsigned* bar, volatile LAS unsigned* st) {
    XcdBarrier b; b.bar = bar; b.x = xb_xcc_id(); b.st = st;
    if (threadIdx.x == 0) (void)xb_add(&bar[XB_XCNT(b.x)], 1u);
    return b;
}
__device__ __forceinline__ void xcd_barrier_complete(unsigned* bar, unsigned x, unsigned& nloc, unsigned& nx) {
    const unsigned G = gridDim.x * gridDim.y * gridDim.z;
    unsigned sum, cnt, mine, sp = 0u;
    for (;;) {
        sum = 0u; cnt = 0u; mine = 0u;
#pragma unroll
        for (unsigned j = 0; j < 16; ++j) { const unsigned c = xb_ld(&bar[XB_XCNT(j)]); sum += c; cnt += (c > 0u) ? 1u : 0u; mine = (j == x) ? c : mine; }
        if (sum == G) break;
        __builtin_amdgcn_s_sleep(1);
        if ((++sp & 255u) == 0u) { if (xb_ld(&bar[XB_TMO])) break; if (sp > XB_SPIN_CAP) { atomicAdd(&bar[XB_TMO], 1u); break; } }
    }
    nloc = mine > 0u ? mine : 1u; nx = cnt > 0u ? cnt : 1u;
}

__device__ __forceinline__ void xcd_barrier(const XcdBarrier& b) {
    asm volatile("s_waitcnt vmcnt(0)" ::: "memory");
    __syncthreads();
    if (threadIdx.x == 0) {
        unsigned* bar = b.bar;
        __builtin_amdgcn_s_waitcnt(0);
        unsigned nloc = b.st[0], nx = b.st[1];
        if (nloc == 0u) { xcd_barrier_complete(bar, b.x, nloc, nx); b.st[0] = nloc; b.st[1] = nx; }
        const unsigned old = xb_add(&bar[XB_XSUB(b.x)], 1u);
        const unsigned gen = old / nloc;
        if (old + 1u == (gen + 1u) * nloc) {
            __builtin_amdgcn_fence(__ATOMIC_RELEASE, "agent");
            asm volatile("s_waitcnt vmcnt(0)" ::: "memory");
            const unsigned og = xb_add(&bar[XB_TOP], 1u);
            const unsigned tg = og / nx;
            if (og + 1u == (tg + 1u) * nx) xb_add(&bar[XB_TOPGEN], 1u);
            else XB_SPIN(xb_ld(&bar[XB_TOPGEN]) == tg, bar);
            __builtin_amdgcn_fence(__ATOMIC_ACQUIRE, "agent");
            xb_add(&bar[XB_XGEN(b.x)], 1u);
            asm volatile("s_waitcnt vmcnt(0)" ::: "memory");
        } else {
            XB_SPIN(xb_ld(&bar[XB_XGEN(b.x)]) == gen, bar);
            __builtin_amdgcn_fence(__ATOMIC_ACQUIRE, "agent");
            asm volatile("s_waitcnt vmcnt(0)" ::: "memory");
        }
    }
    __syncthreads();
}


DEV int win_col_map(int j) {
  if (j < 1280) return j;
  if (j < 4864) return j + 24;
  if (j < 4888) return j - 4864 + 1280;
  return -1;
}
DEV void tr_tile(const float* __restrict__ src, int ldsrc, int K, bf16* __restrict__ dst, int kt, int nt, bool remap,
                 float* sm) {
  const int tid = tidx();
#pragma unroll 4
  for (int i = 0; i < 16; ++i) {
    int r = i * 4 + (tid >> 6), cx = tid & 63;
    int j = nt * 64 + cx, k = kt * 64 + r;
    int oc = remap ? win_col_map(j) : j;
    sm[r * 65 + cx] = (oc >= 0) ? src[(size_t)k * ldsrc + oc] : 0.f;
  }
  __syncthreads();
#pragma unroll 4
  for (int i = 0; i < 16; ++i) {
    int n = i * 4 + (tid >> 6), kk = tid & 63;
    dst[(size_t)(nt * 64 + n) * K + kt * 64 + kk] = f2bf(sm[kk * 65 + n]);
  }
  __syncthreads();
}

DEV unsigned e8m0_of(float amax) {
  const unsigned bits = (unsigned)__float_as_int(amax * (1.f / 224.f));
  unsigned e = ((bits >> 23) & 255u) + ((bits & 0x7fffffu) ? 1u : 0u);
  return e < 1u ? 1u : (e > 253u ? 253u : e);
}
DEV float e8m0_inv(unsigned e) { return __int_as_float((int)((254u - e) << 23)); }
DEV unsigned pack4_fp8_(float a, float b, float c, float d) {
  int q = __builtin_amdgcn_cvt_pk_fp8_f32(a, b, 0, false);
  q = __builtin_amdgcn_cvt_pk_fp8_f32(c, d, q, true);
  return (unsigned)q;
}
DEV void wamax_item(const Params& p, int item) {
  const int l = item >> 7, part = item & 127;
  const size_t per = (size_t)1024 * 4888 / 128;
  const float4* src = (const float4*)(p.w_in + (size_t)l * 1024 * 4888 + (size_t)part * per);
  float m = 0.f;
  for (int i = tidx(); i < (int)(per / 4); i += 256) {
    const float4 v = src[i];
    m = fmaxf(m, fmaxf(fmaxf(fabsf(v.x), fabsf(v.y)), fmaxf(fabsf(v.z), fabsf(v.w))));
  }
#pragma unroll
  for (int o = 32; o >= 1; o >>= 1) m = fmaxf(m, shx(m, o));
  if ((tidx() & 63) == 0) atomicMax((unsigned*)(p.ws + OFF_BAR) + l, (unsigned)__float_as_int(m));
}
DEV void wq8_item(const Params& p, int item, float* sm) {
  const int tid = tidx();
  const int l = item / (80 * 16), r_ = item % (80 * 16);
  const int nt = r_ / 16, kt = r_ % 16;
  const float* src = p.w_in + (size_t)l * 1024 * 4888;
  unsigned char* dst = (unsigned char*)(p.ws + OFF_WINT) + (size_t)l * WN * 1024;
  const unsigned e = e8m0_of(__int_as_float((int)__hip_atomic_load((const unsigned*)(p.ws + OFF_BAR) + l, __ATOMIC_RELAXED, __HIP_MEMORY_SCOPE_AGENT)));
  const float s = e8m0_inv(e);
#pragma unroll 4
  for (int i = 0; i < 16; ++i) {
    const int r = i * 4 + (tid >> 6), cx = tid & 63;
    const int oc = win_col_map(nt * 64 + cx);
    sm[r * 65 + cx] = (oc >= 0) ? src[(size_t)(kt * 64 + r) * 4888 + oc] : 0.f;
  }
  __syncthreads();
  const int kq = tid & 15;
#pragma unroll
  for (int i = 0; i < 4; ++i) {
    const int n = i * 16 + (tid >> 4);
    const float v0 = sm[(kq * 4 + 0) * 65 + n], v1 = sm[(kq * 4 + 1) * 65 + n], v2 = sm[(kq * 4 + 2) * 65 + n], v3 = sm[(kq * 4 + 3) * 65 + n];
    *(unsigned*)(dst + (size_t)(nt * 64 + n) * 1024 + kt * 64 + kq * 4) = pack4_fp8_(v0 * s, v1 * s, v2 * s, v3 * s);
  }
  if (kt == 0 && tid < 64) ((unsigned char*)(p.ws + OFF_WCS))[(size_t)l * WN + nt * 64 + tid] = (unsigned char)e;
  __syncthreads();
}
constexpr int WQ8_ITEMS = 2 * 80 * 16;
constexpr int PREP_TR_WIN = 2 * 128;
constexpr int PREP_TR_UPN = 2 * 16 * 8;
constexpr int PREP_TR_UPM = 2 * 16 * 8;
constexpr int PREP_TR_OUT = 2 * 16 * 16;
constexpr int PREP_TR_WQ = 2 * 32 * 16;
constexpr int PREP_ROPE = 512;
constexpr int PREP_MOD = 384;
constexpr int PREP_PEB = 16;
constexpr int PREP_PK = 32;
constexpr int PREP_TR_W1 = 4 * 2 * 32;
constexpr int PREP_ITEMS = PREP_TR_WIN + PREP_TR_UPN + PREP_TR_UPM + PREP_TR_OUT + PREP_TR_WQ + PREP_ROPE + PREP_MOD + PREP_PEB + PREP_PK + PREP_TR_W1;

DEV void prep_item(const Params& p, int item, float* sm) {
  const int tid = tidx();
  if (item < PREP_TR_WIN) {
    wamax_item(p, item);
    return;
  }
  item -= PREP_TR_WIN;
  if (item < PREP_TR_UPN) {
    int l = item / 128, r = item % 128;
    int nt = r / 8, kt = r % 8;
    tr_tile(p.w_up_nsa + (size_t)l * 512 * 1024, 1024, 1024, (bf16*)(p.ws + OFF_WUPN) + (size_t)l * 1024 * 1024, kt, nt, false, sm);
    return;
  }
  item -= PREP_TR_UPN;
  if (item < PREP_TR_UPM) {
    int l = item / 128, r = item % 128;
    int nt = r / 8, kt = r % 8;
    tr_tile(p.w_up_moba + (size_t)l * 512 * 1024, 1024, 1024, (bf16*)(p.ws + OFF_WUPN) + (size_t)l * 1024 * 1024 + 512, kt, nt, false, sm);
    return;
  }
  item -= PREP_TR_UPM;
  if (item < PREP_TR_OUT) {
    int l = item / 256, r = item % 256;
    int nt = r / 16, kt = r % 16;
    tr_tile(p.w_out + (size_t)l * 1024 * 1024, 1024, 1024, (bf16*)(p.ws + OFF_WOUT) + (size_t)l * 1024 * 1024, kt, nt, false, sm);
    return;
  }
  item -= PREP_TR_OUT;
  if (item < PREP_TR_WQ) {
    int l = item / 512, r = item % 512;
    int nt = r / 16, kt = r % 16;
    tr_tile(p.peer_wq + (size_t)l * 1024 * 2048, 2048, 1024, (bf16*)(p.ws + OFF_WQ) + (size_t)l * 2048 * 1024, kt, nt, false, sm);
    return;
  }
  item -= PREP_TR_WQ;
  if (item < PREP_ROPE) {
    int idx = item * 256 + tid;
    int pos = idx >> 3, i = idx & 7;
    float inv = powf(500000.0f, -(float)i / 8.0f);
    float ang = (float)pos * inv;
    float* rp = (float*)(p.ws + OFF_ROPE) + (size_t)pos * 16;
    rp[i] = cosf(ang);
    rp[8 + i] = sinf(ang);
    return;
  }
  item -= PREP_ROPE;
  if (item < PREP_MOD) {
    for (int i = tid; i < 2048; i += 256) {
      float cv = p.c[i];
      sm[i] = cv / (1.f + expf(-cv));
    }
    __syncthreads();
    const int l = item / 192, n0 = (item % 192) * 32;
    const int col = tid & 31, ks = tid >> 5;
    const float* w = p.w_ada + (size_t)l * 1024 * 6144 + n0 + col;
    float a0 = 0.f, a1 = 0.f;
#pragma unroll 8
    for (int k = ks * 128; k < ks * 128 + 128; ++k) {
      float wv = w[(size_t)k * 6144];
      a0 += sm[k] * wv;
      a1 += sm[1024 + k] * wv;
    }
    sm[2048 + tid * 2] = a0;
    sm[2048 + tid * 2 + 1] = a1;
    __syncthreads();
    if (tid < 64) {
      const int c2 = tid & 31, bs = tid >> 5;
      float s = 0.f;
#pragma unroll
      for (int q = 0; q < 8; ++q) s += sm[2048 + (q * 32 + c2) * 2 + bs];
      ((float*)(p.ws + OFF_MOD))[(l * 2 + bs) * 6144 + n0 + c2] = s + p.b_ada[l * 6144 + n0 + c2];
    }
    __syncthreads();
    return;
  }
  item -= PREP_MOD;
  if (item < PREP_PEB) {
    const int lw = item >> 2, j0 = (item & 3) * 32;
    const int col = tid & 31, ks = tid >> 5;
    const float* pe = p.cmp_pe + (size_t)lw * 2048;
    const float* w1 = p.cmp_w1 + (size_t)lw * 2048 * 128 + j0 + col;
    float a = 0.f;
#pragma unroll 8
    for (int i = ks * 256; i < ks * 256 + 256; ++i) a += pe[i] * w1[(size_t)i * 128];
    sm[tid] = a;
    __syncthreads();
    if (tid < 32) {
      float s = 0.f;
#pragma unroll
      for (int q = 0; q < 8; ++q) s += sm[q * 32 + tid];
      ((float*)(p.ws + OFF_PEB))[lw * 128 + j0 + tid] = s;
    }
    if (item == 0 && tid < 4) ((float*)(p.ws + OFF_PROBE))[tid] = 0.f;
    __syncthreads();
    return;
  }
  item -= PREP_PEB;
  if (item < PREP_PK) {
    const int e0 = item * 2048 + tid * 8;
    const int lt = e0 >> 14, off = e0 & 16383;
    const float* srcp = ((lt & 1) ? p.peer_k2 : p.peer_k1) + (size_t)(lt >> 1) * 16384 + off;
    const float4 a = *(const float4*)srcp, b4 = *(const float4*)(srcp + 4);
    uint4 pk;
    pk.x = (unsigned)f2bf(a.x) | ((unsigned)f2bf(a.y) << 16);
    pk.y = (unsigned)f2bf(a.z) | ((unsigned)f2bf(a.w) << 16);
    pk.z = (unsigned)f2bf(b4.x) | ((unsigned)f2bf(b4.y) << 16);
    pk.w = (unsigned)f2bf(b4.z) | ((unsigned)f2bf(b4.w) << 16);
    *(uint4*)((bf16*)(p.ws + OFF_PKB) + e0) = pk;
    return;
  }
  item -= PREP_PK;
  {
    const int lw = item >> 6, r = item & 63;
    const int nt = r >> 5, kt = r & 31;
    tr_tile(p.cmp_w1 + (size_t)lw * 2048 * 128, 128, 2048, (bf16*)(p.ws + OFF_W1T) + (size_t)lw * 128 * 2048, kt, nt, false, sm);
  }
}

DEV void norm_item(const float* __restrict__ xin, const float* __restrict__ g, const float* __restrict__ sc,
                   const float* __restrict__ sh, bf16* __restrict__ hout, int item) {
  const int lane = tidx() & 63, wave = tidx() >> 6;
  const size_t tok = (size_t)item * 4 + wave;
  const int b = (int)(tok / S);
  const float* xr = xin + tok * 1024;
  float4 v[4];
  float ss = 0.f;
#pragma unroll
  for (int i = 0; i < 4; ++i) {
    v[i] = *(const float4*)(xr + i * 256 + lane * 4);
    ss += v[i].x * v[i].x + v[i].y * v[i].y + v[i].z * v[i].z + v[i].w * v[i].w;
  }
  ss = wave_sum(ss);
  float r = 1.0f / sqrtf(ss * (1.0f / 1024.f) + 1e-6f);
#pragma unroll
  for (int i = 0; i < 4; ++i) {
    int d = i * 256 + lane * 4;
    float4 gg = *(const float4*)(g + d);
    float4 s4 = *(const float4*)(sc + b * 6144 + d);
    float4 h4 = *(const float4*)(sh + b * 6144 + d);
    float o0 = v[i].x * r * gg.x * (1.f + s4.x) + h4.x;
    float o1 = v[i].y * r * gg.y * (1.f + s4.y) + h4.y;
    float o2 = v[i].z * r * gg.z * (1.f + s4.z) + h4.z;
    float o3 = v[i].w * r * gg.w * (1.f + s4.w) + h4.w;
    uint2 pk;
    pk.x = (unsigned)f2bf(o0) | ((unsigned)f2bf(o1) << 16);
    pk.y = (unsigned)f2bf(o2) | ((unsigned)f2bf(o3) << 16);
    *(uint2*)(hout + tok * 1024 + d) = pk;
  }
}
DEV void norm8_item(const float* __restrict__ xin, const float* __restrict__ g, const float* __restrict__ sc,
                    const float* __restrict__ sh, unsigned char* __restrict__ hout, unsigned char* __restrict__ hscale, int item) {
  const int lane = tidx() & 63, wave = tidx() >> 6;
  const size_t tok = (size_t)item * 4 + wave;
  const int b = (int)(tok / S);
  const float* xr = xin + tok * 1024;
  float4 v[4];
  float ss = 0.f;
#pragma unroll
  for (int i = 0; i < 4; ++i) {
    v[i] = *(const float4*)(xr + i * 256 + lane * 4);
    ss += v[i].x * v[i].x + v[i].y * v[i].y + v[i].z * v[i].z + v[i].w * v[i].w;
  }
  ss = wave_sum(ss);
  float r = 1.0f / sqrtf(ss * (1.0f / 1024.f) + 1e-6f);
  float mx = 0.f;
#pragma unroll
  for (int i = 0; i < 4; ++i) {
    int d = i * 256 + lane * 4;
    float4 gg = *(const float4*)(g + d);
    float4 s4 = *(const float4*)(sc + b * 6144 + d);
    float4 h4 = *(const float4*)(sh + b * 6144 + d);
    v[i].x = v[i].x * r * gg.x * (1.f + s4.x) + h4.x;
    v[i].y = v[i].y * r * gg.y * (1.f + s4.y) + h4.y;
    v[i].z = v[i].z * r * gg.z * (1.f + s4.z) + h4.z;
    v[i].w = v[i].w * r * gg.w * (1.f + s4.w) + h4.w;
    mx = fmaxf(mx, fmaxf(fmaxf(fabsf(v[i].x), fabsf(v[i].y)), fmaxf(fabsf(v[i].z), fabsf(v[i].w))));
  }
#pragma unroll
  for (int o = 32; o >= 1; o >>= 1) mx = fmaxf(mx, shx(mx, o));
  const unsigned e = e8m0_of(mx);
  const float s = e8m0_inv(e);
#pragma unroll
  for (int i = 0; i < 4; ++i)
    *(unsigned*)(hout + tok * 1024 + i * 256 + lane * 4) = pack4_fp8_(v[i].x * s, v[i].y * s, v[i].z * s, v[i].w * s);
  if (lane == 0) hscale[tok] = (unsigned char)e;
}
DEV void final_norm_item(float* __restrict__ x, const float* __restrict__ g, int item) {
  const int lane = tidx() & 63, wave = tidx() >> 6;
  const size_t tok = (size_t)item * 4 + wave;
  float* xr = x + tok * 1024;
  float4 v[4];
  float ss = 0.f;
#pragma unroll
  for (int i = 0; i < 4; ++i) {
    v[i] = *(const float4*)(xr + i * 256 + lane * 4);
    ss += v[i].x * v[i].x + v[i].y * v[i].y + v[i].z * v[i].z + v[i].w * v[i].w;
  }
  ss = wave_sum(ss);
  float r = 1.0f / sqrtf(ss * (1.0f / 1024.f) + 1e-6f);
#pragma unroll
  for (int i = 0; i < 4; ++i) {
    int d = i * 256 + lane * 4;
    float4 gg = *(const float4*)(g + d);
    float4 o;
    o.x = v[i].x * r * gg.x; o.y = v[i].y * r * gg.y; o.z = v[i].z * r * gg.z; o.w = v[i].w * r * gg.w;
    *(float4*)(xr + d) = o;
  }
}

#define GM_BUF (2 * 128 * 72)
#define GM_LOAD(R, kk)                                                                                  \
  {                                                                                                     \
    const bf16* Ak = Ap + (kk);                                                                         \
    const bf16* Wk = Wp + (kk);                                                                         \
    R##a0 = *(const uint4*)(Ak); R##a1 = *(const uint4*)(Ak + a32); R##a2 = *(const uint4*)(Ak + 2 * a32); \
    R##a3 = *(const uint4*)(Ak + 3 * a32);                                                              \
    R##b0 = *(const uint4*)(Wk); R##b1 = *(const uint4*)(Wk + w32); R##b2 = *(const uint4*)(Wk + 2 * w32); \
    R##b3 = *(const uint4*)(Wk + 3 * w32);                                                              \
  }
#define GM_STORE(R, buf)                                                                                \
  {                                                                                                     \
    bf16* as_ = Asw + (buf) * GM_BUF;                                                                   \
    bf16* bs_ = as_ + 128 * 72;                                                                         \
    *(uint4*)(as_) = R##a0; *(uint4*)(as_ + 32 * 72) = R##a1; *(uint4*)(as_ + 64 * 72) = R##a2; *(uint4*)(as_ + 96 * 72) = R##a3; \
    *(uint4*)(bs_) = R##b0; *(uint4*)(bs_ + 32 * 72) = R##b1; *(uint4*)(bs_ + 64 * 72) = R##b2; *(uint4*)(bs_ + 96 * 72) = R##b3; \
  }
#define GM_COMPUTE(buf)                                                                                 \
  {                                                                                                     \
    const bf16* As_ = sm + (buf) * GM_BUF;                                                              \
    const bf16* Bs_ = As_ + 128 * 72;                                                                   \
    _Pragma("unroll") for (int ks = 0; ks < 2; ++ks) {                                                  \
      __builtin_amdgcn_sched_barrier(0);                                                                \
      bf16x8 af[4], bfr[4];                                                                             \
      _Pragma("unroll") for (int mi = 0; mi < 4; ++mi)                                                  \
        af[mi] = *(const bf16x8*)(As_ + (wr * 64 + mi * 16 + (lane & 15)) * 72 + ks * 32 + (lane >> 4) * 8); \
      _Pragma("unroll") for (int ni = 0; ni < 4; ++ni)                                                  \
        bfr[ni] = *(const bf16x8*)(Bs_ + (wc * 64 + ni * 16 + (lane & 15)) * 72 + ks * 32 + (lane >> 4) * 8); \
      _Pragma("unroll") for (int mi = 0; mi < 4; ++mi)                                                  \
        _Pragma("unroll") for (int ni = 0; ni < 4; ++ni)                                                \
          acc[mi][ni] = __builtin_amdgcn_mfma_f32_16x16x32_bf16(af[mi], bfr[ni], acc[mi][ni], 0, 0, 0); \
    }                                                                                                   \
    __builtin_amdgcn_sched_barrier(0);                                                                  \
  }
DEV void gemm_mainloop(const bf16* __restrict__ A, int lda, const bf16* __restrict__ W, int K, int m0, int n0, bf16* sm,
                       f32x4 (&acc)[4][4]) {
  const int tid = tidx(), lane = tid & 63, wave = tid >> 6;
  const int wr = wave >> 1, wc = wave & 1;
  const int lrow = tid >> 3, lkc = (tid & 7) * 8;
  const bf16* Ap = A + (size_t)(m0 + lrow) * lda + lkc;
  const bf16* Wp = W + (size_t)(n0 + lrow) * K + lkc;
  const int a32 = 32 * lda, w32 = 32 * K;
  bf16* Asw = sm + lrow * 72 + lkc;
  uint4 xa0, xa1, xa2, xa3, xb0, xb1, xb2, xb3, ya0, ya1, ya2, ya3, yb0, yb1, yb2, yb3;
  const int nk = K >> 6;
  GM_LOAD(x, 0)
  GM_LOAD(y, 64)
  __syncthreads();
  GM_STORE(x, 0)
  if (nk > 2) GM_LOAD(x, 128)
  __syncthreads();
  for (int k = 0; k < nk; k += 2) {
    GM_COMPUTE(0)
    GM_STORE(y, 1)
    if (k + 3 < nk) GM_LOAD(y, (k + 3) * 64)
    __syncthreads();
    GM_COMPUTE(1)
    if (k + 2 < nk) {
      GM_STORE(x, 0)
      if (k + 4 < nk) GM_LOAD(x, (k + 4) * 64)
    }
    __syncthreads();
  }
}
DEV void gemm256_mainloop(const bf16* __restrict__ A, int lda, const bf16* __restrict__ W, int K, int m0, int n0, bf16* sm,
                          f32x4 (&acc)[2][4][4]) {
  bf16* As = sm;
  bf16* Bs = sm + 256 * 72;
  const int tid = tidx(), lane = tid & 63, wave = tid >> 6;
  const int wr = wave >> 1, wc = wave & 1;
  const int lrow = tid >> 3, lkc = (tid & 7) * 8;
  const bf16* Ap = A + (size_t)(m0 + lrow) * lda + lkc;
  const bf16* Wp = W + (size_t)(n0 + lrow) * K + lkc;
  const int a32 = 32 * lda, w32 = 32 * K;
  uint4 ra0, ra1, ra2, ra3, ra4, ra5, ra6, ra7, rb0, rb1, rb2, rb3;
#define G256_LOAD(kk)                                                                                   \
  {                                                                                                     \
    const bf16* Ak = Ap + (kk);                                                                         \
    const bf16* Wk = Wp + (kk);                                                                         \
    ra0 = *(const uint4*)(Ak); ra1 = *(const uint4*)(Ak + a32); ra2 = *(const uint4*)(Ak + 2 * a32);    \
    ra3 = *(const uint4*)(Ak + 3 * a32); ra4 = *(const uint4*)(Ak + 4 * a32); ra5 = *(const uint4*)(Ak + 5 * a32); \
    ra6 = *(const uint4*)(Ak + 6 * a32); ra7 = *(const uint4*)(Ak + 7 * a32);                           \
    rb0 = *(const uint4*)(Wk); rb1 = *(const uint4*)(Wk + w32); rb2 = *(const uint4*)(Wk + 2 * w32);    \
    rb3 = *(const uint4*)(Wk + 3 * w32);                                                                \
  }
  G256_LOAD(0)
  bf16* Asw = As + lrow * 72 + lkc;
  bf16* Bsw = Bs + lrow * 72 + lkc;
  for (int k0 = 0; k0 < K; k0 += 64) {
    __syncthreads();
    *(uint4*)(Asw) = ra0; *(uint4*)(Asw + 32 * 72) = ra1; *(uint4*)(Asw + 64 * 72) = ra2; *(uint4*)(Asw + 96 * 72) = ra3;
    *(uint4*)(Asw + 128 * 72) = ra4; *(uint4*)(Asw + 160 * 72) = ra5; *(uint4*)(Asw + 192 * 72) = ra6; *(uint4*)(Asw + 224 * 72) = ra7;
    *(uint4*)(Bsw) = rb0; *(uint4*)(Bsw + 32 * 72) = rb1; *(uint4*)(Bsw + 64 * 72) = rb2; *(uint4*)(Bsw + 96 * 72) = rb3;
    __syncthreads();
    if (k0 + 64 < K) G256_LOAD(k0 + 64)
#pragma unroll
    for (int ks = 0; ks < 2; ++ks) {
      bf16x8 bfr[4];
#pragma unroll
      for (int ni = 0; ni < 4; ++ni)
        bfr[ni] = *(const bf16x8*)(Bs + (wc * 64 + ni * 16 + (lane & 15)) * 72 + ks * 32 + (lane >> 4) * 8);
#pragma unroll
      for (int h = 0; h < 2; ++h) {
        __builtin_amdgcn_sched_barrier(0);
        bf16x8 af[4];
#pragma unroll
        for (int mi = 0; mi < 4; ++mi)
          af[mi] = *(const bf16x8*)(As + (wr * 128 + h * 64 + mi * 16 + (lane & 15)) * 72 + ks * 32 + (lane >> 4) * 8);
#pragma unroll
        for (int mi = 0; mi < 4; ++mi)
#pragma unroll
          for (int ni = 0; ni < 4; ++ni)
            acc[h][mi][ni] = __builtin_amdgcn_mfma_f32_16x16x32_bf16(af[mi], bfr[ni], acc[h][mi][ni], 0, 0, 0);
      }
    }
  }
}
DEV void acc_zero(f32x4 (&acc)[4][4]) {
#pragma unroll
  for (int i = 0; i < 4; ++i)
#pragma unroll
    for (int j = 0; j < 4; ++j) acc[i][j] = f32x4{0.f, 0.f, 0.f, 0.f};
}
DEV void store_tile_bf16(bf16* sm, const f32x4 (&acc)[4][4], bf16* __restrict__ dbase, size_t dstride) {
  const int tid = tidx(), lane = tid & 63, wave = tid >> 6, g4 = lane >> 4, c16 = lane & 15;
  bf16* Cw = sm + wave * (64 * 72);
  __syncthreads();
#pragma unroll
  for (int mi = 0; mi < 4; ++mi)
#pragma unroll
    for (int ni = 0; ni < 4; ++ni)
#pragma unroll
      for (int r = 0; r < 4; ++r) Cw[(mi * 16 + g4 * 4 + r) * 72 + ni * 16 + c16] = f2bf(acc[mi][ni][r]);
  __syncthreads();
#pragma unroll
  for (int it = 0; it < 8; ++it) {
    const int row_l = it * 8 + (lane >> 3), ch = lane & 7;
    const uint4 v = *(const uint4*)(Cw + row_l * 72 + ch * 8);
    *(uint4*)(dbase + (size_t)row_l * dstride + ch * 8) = v;
  }
}
template <class Epi>
DEV void gemm_tile(const bf16* __restrict__ A, int lda, const bf16* __restrict__ W, int K, int m0, int n0, bf16* sm,
                   Epi epi) {
  f32x4 acc[4][4];
  acc_zero(acc);
  gemm_mainloop(A, lda, W, K, m0, n0, sm, acc);
  const int tid = tidx(), lane = tid & 63, wave = tid >> 6;
  const int wr = wave >> 1, wc = wave & 1;
#pragma unroll
  for (int mi = 0; mi < 4; ++mi)
#pragma unroll
    for (int ni = 0; ni < 4; ++ni)
#pragma unroll
      for (int r = 0; r < 4; ++r) {
        int row = m0 + wr * 64 + mi * 16 + (lane >> 4) * 4 + r;
        int col = n0 + wc * 64 + ni * 16 + (lane & 15);
        epi(row, col, acc[mi][ni][r]);
      }
}
DEV void inproj_epilogue(const Params& p, f32x4 (&acc)[4][4], int row0, int vc0, bf16* sm) {
  const int tid = tidx(), lane = tid & 63, g4 = lane >> 4, c16 = lane & 15;
  const int b = row0 / S, t0 = row0 % S;
  bf16* dbase;
  size_t dstride;
  bool roped = false;
  bf16* projp = (bf16*)(p.ws + OFF_PROJ) + (size_t)row0 * PC;
  if (vc0 < 768) { dbase = projp + vc0; dstride = PC; }
  else if (vc0 < 1280) {
    const int seg = (vc0 - 768) >> 7, head = ((vc0 - 768) >> 6) & 1;
    const size_t off = (seg == 0) ? OFF_KSB : (seg == 1) ? OFF_VSB : (seg == 2) ? OFF_KWB : OFF_VWB;
    dbase = (bf16*)(p.ws + off) + ((size_t)(b * 2 + head) * S + t0) * 64;
    dstride = 64;
    roped = (seg == 0) || (seg == 2);
  } else if (vc0 < 1792) { dbase = projp + C_MQ + (vc0 - 1280); dstride = PC; roped = true; }
  else if (vc0 < 2816) {
    const int seg = (vc0 - 1792) >> 9, head = ((vc0 - 1792) >> 6) & 7;
    dbase = (bf16*)(p.ws + (seg ? OFF_MVB : OFF_MKB)) + ((size_t)(b * 8 + head) * S + t0) * 64;
    dstride = 64;
    roped = (seg == 0);
  } else if (vc0 < 4864) { dbase = projp + C_GN + (vc0 - 2816); dstride = PC; }
  else { dbase = projp + C_NG + (vc0 - 4864); dstride = PC; }
  if (roped) {
    const float* rope = (const float*)(p.ws + OFF_ROPE);
#pragma unroll
    for (int mi = 0; mi < 4; ++mi)
#pragma unroll
      for (int r = 0; r < 4; ++r) {
        const int pos = t0 + mi * 16 + g4 * 4 + r;
        const float v = acc[mi][0][r];
        const float pv = shx(v, 8);
        const float cs = rope[pos * 16 + (c16 & 7)], sn = rope[pos * 16 + 8 + (c16 & 7)];
        acc[mi][0][r] = (c16 < 8) ? (v * cs - pv * sn) : (v * cs + pv * sn);
      }
  }
  store_tile_bf16(sm, acc, dbase, dstride);
}
DEV void inproj_tile256(const Params& p, int layer, int m0, int n0, bf16* sm) {
  f32x4 acc[2][4][4];
  acc_zero(acc[0]);
  acc_zero(acc[1]);
  gemm256_mainloop((const bf16*)(p.ws + OFF_H), 1024, (const bf16*)(p.ws + OFF_WINT) + (size_t)layer * WN * 1024, 1024, m0, n0, sm, acc);
  const int wave = tidx() >> 6, wr = wave >> 1, wc = wave & 1;
  inproj_epilogue(p, acc[0], m0 + wr * 128, n0 + wc * 64, sm);
  inproj_epilogue(p, acc[1], m0 + wr * 128 + 64, n0 + wc * 64, sm);
}
typedef unsigned u32x2_t __attribute__((ext_vector_type(2)));
DEV void merge_tile(const Params& p, int layer, int m0, int n0, bf16* sm) {
  const int tid = tidx(), lane = tid & 63, wave = tid >> 6, g4 = lane >> 4, c16 = lane & 15;
  const int wr = wave >> 1, wc = wave & 1;
  const bf16* projg = (const bf16*)(p.ws + OFF_PROJ) + (size_t)(m0 + wr * 64 + g4 * 4) * PC + n0 + wc * 64 + c16;
  f32x4 acc[4][4];
  acc_zero(acc);
  gemm_mainloop((const bf16*)(p.ws + OFF_ONSA), 512, (const bf16*)(p.ws + OFF_WUPN) + (size_t)layer * 1024 * 512, 512, m0, n0, sm, acc);
  bf16* yg = (bf16*)(p.ws + OFF_H) + (size_t)(m0 + wr * 64 + g4 * 4) * 1024 + n0 + wc * 64 + c16;
#pragma unroll
  for (int mi = 0; mi < 4; ++mi)
#pragma unroll
    for (int ni = 0; ni < 4; ++ni)
#pragma unroll
      for (int r = 0; r < 4; ++r)
        yg[(size_t)(mi * 16 + r) * 1024 + ni * 16] =
            f2bf(sigmoidf_(bf2f(projg[(size_t)(mi * 16 + r) * PC + C_GN + ni * 16])) * acc[mi][ni][r]);
  acc_zero(acc);
  gemm_mainloop((const bf16*)(p.ws + OFF_OMOBA), 512, (const bf16*)(p.ws + OFF_WUPM) + (size_t)layer * 1024 * 512, 512, m0, n0, sm, acc);
#pragma unroll
  for (int mi = 0; mi < 4; ++mi)
#pragma unroll
    for (int ni = 0; ni < 4; ++ni)
#pragma unroll
      for (int r = 0; r < 4; ++r)
        acc[mi][ni][r] = bf2f(yg[(size_t)(mi * 16 + r) * 1024 + ni * 16]) +
                         sigmoidf_(bf2f(projg[(size_t)(mi * 16 + r) * PC + C_GM + ni * 16])) * acc[mi][ni][r];
  store_tile_bf16(sm, acc, (bf16*)(p.ws + OFF_H) + (size_t)(m0 + wr * 64) * 1024 + n0 + wc * 64, 1024);
}

DEV void merge_tile256(const Params& p, int layer, int m0, int n0, bf16* sm) {
  const int tid = tidx(), lane = tid & 63, wave = tid >> 6, g4 = lane >> 4, c16 = lane & 15;
  const int wr = wave >> 1, wc = wave & 1;
  f32x4 acc[2][4][4];
  acc_zero(acc[0]);
  acc_zero(acc[1]);
  gemm256_mainloop((const bf16*)(p.ws + OFF_ONSA), 512, (const bf16*)(p.ws + OFF_WUPN) + (size_t)layer * 1024 * 512, 512, m0, n0, sm, acc);
#pragma unroll
  for (int h = 0; h < 2; ++h) {
    const size_t rb = (size_t)(m0 + wr * 128 + h * 64 + g4 * 4);
    const bf16* projg = (const bf16*)(p.ws + OFF_PROJ) + rb * PC + n0 + wc * 64 + c16;
    bf16* yg = (bf16*)(p.ws + OFF_H) + rb * 1024 + n0 + wc * 64 + c16;
#pragma unroll
    for (int mi = 0; mi < 4; ++mi)
#pragma unroll
      for (int ni = 0; ni < 4; ++ni)
#pragma unroll
        for (int r = 0; r < 4; ++r)
          yg[(size_t)(mi * 16 + r) * 1024 + ni * 16] =
              f2bf(sigmoidf_(bf2f(projg[(size_t)(mi * 16 + r) * PC + C_GN + ni * 16])) * acc[h][mi][ni][r]);
  }
  acc_zero(acc[0]);
  acc_zero(acc[1]);
  gemm256_mainloop((const bf16*)(p.ws + OFF_OMOBA), 512, (const bf16*)(p.ws + OFF_WUPM) + (size_t)layer * 1024 * 512, 512, m0, n0, sm, acc);
#pragma unroll
  for (int h = 0; h < 2; ++h) {
    const size_t rb = (size_t)(m0 + wr * 128 + h * 64 + g4 * 4);
    const bf16* projg = (const bf16*)(p.ws + OFF_PROJ) + rb * PC + n0 + wc * 64 + c16;
    const bf16* yg = (const bf16*)(p.ws + OFF_H) + rb * 1024 + n0 + wc * 64 + c16;
#pragma unroll
    for (int mi = 0; mi < 4; ++mi)
#pragma unroll
      for (int ni = 0; ni < 4; ++ni)
#pragma unroll
        for (int r = 0; r < 4; ++r)
          acc[h][mi][ni][r] = bf2f(yg[(size_t)(mi * 16 + r) * 1024 + ni * 16]) +
                              sigmoidf_(bf2f(projg[(size_t)(mi * 16 + r) * PC + C_GM + ni * 16])) * acc[h][mi][ni][r];
    store_tile_bf16(sm, acc[h], (bf16*)(p.ws + OFF_H) + (size_t)(m0 + wr * 128 + h * 64) * 1024 + n0 + wc * 64, 1024);
  }
}

DEV void compress_item(const Params& p, int layer, int item, float* sm) {
  const int tid = tidx();
  const int grp = item & 127, which = (item >> 7) & 1, kvh = (item >> 8) & 1, b = item >> 9;
  const int c0 = grp * 8;
  float* xs = sm;
  float* hs = sm + 144 * 64;
  const bf16* proj = (const bf16*)(p.ws + OFF_PROJ);
  const int col = (which ? C_VC : C_KC) + kvh * 64;
  for (int i = tid; i < 144 * 64; i += 256) {
    int tl = i >> 6, d = i & 63;
    int t = c0 * 16 + tl;
    xs[i] = (t < S) ? bf2f(proj[((size_t)b * S + t) * PC + col + d]) : 0.f;
  }
  __syncthreads();
  const int lw = layer * 2 + which;
  if (tid < 128) {
    const float* w1 = p.cmp_w1 + (size_t)lw * 2048 * 128 + tid;
    float acc[8];
#pragma unroll
    for (int ci = 0; ci < 8; ++ci) acc[ci] = 0.f;
    for (int l = 0; l < 32; ++l) {
#pragma unroll 4
      for (int d = 0; d < 64; ++d) {
        float w = w1[(size_t)(l * 64 + d) * 128];
#pragma unroll
        for (int ci = 0; ci < 8; ++ci) acc[ci] += xs[(ci * 16 + l) * 64 + d] * w;
      }
    }
    float pb = ((const float*)(p.ws + OFF_PEB))[lw * 128 + tid];
#pragma unroll
    for (int ci = 0; ci < 8; ++ci) hs[ci * 128 + tid] = gelu_tanh(acc[ci] + pb);
  }
  __syncthreads();
  const float* w2 = p.cmp_w2 + (size_t)lw * 128 * 64;
  float* outp = PROBE_CMPR ? ((float*)(p.ws + OFF_CMP) + (which ? (size_t)Bn * 1024 * 128 : 0)) : (float*)(p.ws + (which ? OFF_VCC : OFF_KCC));
#pragma unroll
  for (int rr = 0; rr < 2; ++rr) {
    int o = rr * 256 + tid;
    int ci = o >> 6, d = o & 63;
    int c = c0 + ci;
    float a = 0.f;
    for (int j = 0; j < 128; ++j) a += hs[ci * 128 + j] * w2[j * 64 + d];
    if (c < 1023) outp[(((size_t)b * 1024 + c) * 2 + kvh) * 64 + d] = a;
    bf16* outb = (bf16*)(p.ws + (which ? OFF_VCB : OFF_KCB));
    if (!PROBE_CMPR && c < 1024) outb[(((size_t)b * 2 + kvh) * 1024 + c) * 64 + d] = (c < 1023) ? f2bf(a) : (bf16)0;
  }
  __syncthreads();
}

DEV void compress_mfma_item(const Params& p, int layer, int item, char* smem) {
  bf16* xs = (bf16*)smem;
  float* hs = (float*)(smem + 272 * 64 * 2);
  const int tid = tidx(), lane = tid & 63, wave = tid >> 6, g4 = lane >> 4, c16 = lane & 15;
  const int cblk = item & 63, which = (item >> 6) & 1, kvh = (item >> 7) & 1, b = item >> 8;
  const int t0 = cblk * 256;
  const bf16* proj = (const bf16*)(p.ws + OFF_PROJ) + (size_t)b * S * PC + (which ? C_VC : C_KC) + kvh * 64;
  __syncthreads();
  {
    uint4 sv[9];
#pragma unroll
    for (int q = 0; q < 9; ++q) {
      const int i = tid + q * 256;
      const int tl = i >> 3, ch = i & 7;
      const int t = t0 + tl;
      sv[q] = uint4{0u, 0u, 0u, 0u};
      if (i < 272 * 8 && t < S) sv[q] = *(const uint4*)(proj + (size_t)t * PC + ch * 8);
    }
#pragma unroll
    for (int q = 0; q < 9; ++q) {
      const int i = tid + q * 256;
      const int tl = i >> 3, ch = i & 7;
      if (i < 272 * 8) *(uint4*)(xs + tl * 64 + ((ch ^ ((tl >> 4) & 7)) * 8)) = sv[q];
    }
  }
  float* w2s = (float*)(smem + 272 * 64 * 2 + 16 * 128 * 4);
  {
    const float* w2g = p.cmp_w2 + (size_t)(layer * 2 + which) * 128 * 64;
    float4 wv[8];
#pragma unroll
    for (int q = 0; q < 8; ++q) wv[q] = *(const float4*)(w2g + (q * 256 + tid) * 4);
#pragma unroll
    for (int q = 0; q < 8; ++q) *(float4*)(w2s + (q * 256 + tid) * 4) = wv[q];
  }
  __syncthreads();
  const int lw = layer * 2 + which;
  const bf16* w1t = (const bf16*)(p.ws + OFF_W1T) + (size_t)lw * 128 * 2048;
  f32x4 acc0 = f32x4{0.f, 0.f, 0.f, 0.f}, acc1 = f32x4{0.f, 0.f, 0.f, 0.f};
  const bf16* wb0 = w1t + (size_t)((2 * wave) * 16 + c16) * 2048 + g4 * 8;
  const bf16* wb1 = w1t + (size_t)((2 * wave + 1) * 16 + c16) * 2048 + g4 * 8;
#pragma unroll 16
  for (int ks = 0; ks < 64; ++ks) {
    const int l = ks >> 1, ch = (ks & 1) * 4 + g4;
    const int tl = 16 * c16 + l;
    const bf16x8 af = *(const bf16x8*)(xs + tl * 64 + ((ch ^ ((tl >> 4) & 7)) * 8));
    const bf16x8 b0 = *(const bf16x8*)(wb0 + ks * 32);
    const bf16x8 b1 = *(const bf16x8*)(wb1 + ks * 32);
    acc0 = MFMA16B(af, b0, acc0);
    acc1 = MFMA16B(af, b1, acc1);
  }
  {
    const float* peb = (const float*)(p.ws + OFF_PEB) + lw * 128;
    const int j0 = (2 * wave) * 16 + c16, j1 = j0 + 16;
    const float pb0 = peb[j0], pb1 = peb[j1];
#pragma unroll
    for (int r = 0; r < 4; ++r) {
      hs[(g4 * 4 + r) * 128 + j0] = gelu_tanh(acc0[r] + pb0);
      hs[(g4 * 4 + r) * 128 + j1] = gelu_tanh(acc1[r] + pb1);
    }
  }
  __syncthreads();
  const float* w2 = w2s;
  const int d = tid & 63, cq = tid >> 6;
  float o0 = 0.f, o1 = 0.f, o2 = 0.f, o3 = 0.f;
#pragma unroll 8
  for (int j = 0; j < 128; ++j) {
    const float w = w2[j * 64 + d];
    o0 += hs[(cq * 4 + 0) * 128 + j] * w;
    o1 += hs[(cq * 4 + 1) * 128 + j] * w;
    o2 += hs[(cq * 4 + 2) * 128 + j] * w;
    o3 += hs[(cq * 4 + 3) * 128 + j] * w;
  }
  float* outp = (float*)(p.ws + (which ? OFF_VCC : OFF_KCC));
  bf16* outb = (bf16*)(p.ws + (which ? OFF_VCB : OFF_KCB));
  const float ov[4] = {o0, o1, o2, o3};
#pragma unroll
  for (int i = 0; i < 4; ++i) {
    const int c = cblk * 16 + cq * 4 + i;
    if (c < 1023) outp[(((size_t)b * 1024 + c) * 2 + kvh) * 64 + d] = ov[i];
    outb[(((size_t)b * 2 + kvh) * 1024 + c) * 64 + d] = (c < 1023) ? f2bf(ov[i]) : (bf16)0;
  }
  __syncthreads();
}

DEV void n1_item(const Params& p, int layer, int item, float* sm) {
  const int chunk = item & 255, kvh = (item >> 8) & 1, b = item >> 9;
  const int tid = tidx(), ql = tid >> 2, g = tid & 3;
  const int t = chunk * 64 + ql, h = kvh * 4 + g;
  const size_t tok = (size_t)b * S + t;
  const bf16* proj = (const bf16*)(p.ws + OFF_PROJ);
  float* imp = sm;
  for (int i = tid; i < 64 * 257; i += 256) imp[i] = 0.f;
  float q[64];
  load_q64(q, proj + tok * PC + C_NQ + h * 64, 0.125f);
  const int nv = (t >= 31) ? (((t - 31) >> 4) + 1) : 0;
  const int nv_max = (((chunk * 64 + 63) - 31) >> 4) + 1;
  const float* kc = (const float*)(p.ws + OFF_KCC) + (size_t)b * 1024 * 128 + kvh * 64;
  const float* vc = (const float*)(p.ws + OFF_VCC) + (size_t)b * 1024 * 128 + kvh * 64;
  float m = -INFINITY, l = 0.f;
  for (int c = 0; c < nv_max; ++c) {
    float s = dot64_f(q, kc + (size_t)c * 128);
    if (c < nv) {
      float mn = fmaxf(m, s);
      l = l * expf(m - mn) + expf(s - mn);
      m = mn;
    }
  }
  __syncthreads();
  float o[64];
#pragma unroll
  for (int d = 0; d < 64; ++d) o[d] = 0.f;
  const float inv_l = (nv > 0) ? 1.f / l : 0.f;
  for (int c = 0; c < nv_max; ++c) {
    float s = dot64_f(q, kc + (size_t)c * 128);
    float pr = (c < nv) ? expf(s - m) * inv_l : 0.f;
    axpy64_f(o, pr, vc + (size_t)c * 128);
    float ps = pr;
    ps += shx(ps, 1);
    ps += shx(ps, 2);
    if (g == 0) {
      int n = c >> 2;
      if ((c & 3) == 3) {
        imp[ql * 257 + n] += 0.5f * ps;
        imp[ql * 257 + n + 1] += 0.5f * ps;
      } else {
        imp[ql * 257 + n] += ps;
      }
    }
  }
  const float gate0 = (!PROBE_NSA || (PROBE_NSA & 1)) ? sigmoidf_(bf2f(proj[tok * PC + C_NG + h * 3 + 0])) : 0.f;
  float* oa = (float*)(p.ws + OFF_H) + tok * 512 + h * 64;
#pragma unroll
  for (int d = 0; d < 64; d += 4) {
    float4 v = {gate0 * o[d], gate0 * o[d + 1], gate0 * o[d + 2], gate0 * o[d + 3]};
    *(float4*)(oa + d) = v;
  }
  __syncthreads();
#if PROBE_NSA == 8
  if (b == 0 && kvh == 0)
    for (int i = tid; i < 64 * 256; i += 256)
      ((float*)(p.ws + OFF_OMOBA))[(size_t)(chunk * 64 + (i >> 8)) * 256 + (i & 255)] = imp[(i >> 8) * 257 + (i & 255)];
  __syncthreads();
#endif
  if (g == 0) {
    int* selp = (int*)(p.ws + OFF_SEL) + (((size_t)b * 2 + kvh) * S + t) * 16;
    const int cur = chunk;
    if (cur < 16) {
      for (int j = 0; j < 16; ++j) selp[j] = (j <= cur) ? j : -1;
    } else {
      selp[0] = 0;
      selp[1] = cur - 1;
      selp[2] = cur;
      float* row = imp + ql * 257;
      for (int j = 3; j < 16; ++j) {
        float best = -1.f;
        int bi = 1;
        for (int n = 1; n <= cur - 2; ++n) {
          float v = row[n];
          if (v > best) { best = v; bi = n; }
        }
        selp[j] = bi;
        row[bi] = -2.f;
      }
    }
  }
  __syncthreads();
}

DEV void kmean_item(const Params& p, int item, float* sm) {
  const int n = item & 63, h = (item >> 6) & 7, b = item >> 9;
  const int tid = tidx(), d = tid & 63, part = tid >> 6;
  const bf16* mkb = (const bf16*)(p.ws + OFF_MKB);
  float a = 0.f;
  for (int i = 0; i < 64; ++i) {
    int t = n * 256 + part * 64 + i;
    a += bf2f(mkb[((size_t)(b * 8 + h) * S + t) * 64 + d]);
  }
  sm[tid] = a;
  __syncthreads();
  if (tid < 64) {
    float s = sm[tid] + sm[64 + tid] + sm[128 + tid] + sm[192 + tid];
    const size_t ko = (((size_t)b * 8 + h) * 64 + n) * 64 + tid;
    const float mean = s * (1.f / 256.f);
    ((float*)(p.ws + OFF_KMEAN))[ko] = mean;
    const bf16 hi = f2bf(mean);
    ((bf16*)(p.ws + OFF_KMHL))[ko] = hi;
    ((bf16*)(p.ws + OFF_KMHL))[(size_t)2 * 8 * 64 * 64 + ko] = f2bf(mean - bf2f(hi));
    if (tid == 0) ((int*)(p.ws + OFF_MCNT))[((b * 8 + h) * 64 + n) * MCNT_STRIDE] = 0;
  }
  __syncthreads();
}

DEV void n23_item(const Params& p, int layer, int item) {
  const int chunk = item & 255, kvh = (item >> 8) & 1, b = item >> 9;
  const int tid = tidx(), ql = tid >> 2, g = tid & 3;
  const int t = chunk * 64 + ql, h = kvh * 4 + g;
  const size_t tok = (size_t)b * S + t;
  const bf16* proj = (const bf16*)(p.ws + OFF_PROJ);
  const float* rope = (const float*)(p.ws + OFF_ROPE) + (size_t)t * 16;
  float q[64];
  load_q64(q, proj + tok * PC + C_NQ + h * 64, 1.0f);
#pragma unroll
  for (int i = 0; i < 8; ++i) {
    float cs = rope[i], sn = rope[8 + i];
    float x1 = q[i], x2 = q[8 + i];
    q[i] = x1 * cs - x2 * sn;
    q[8 + i] = x2 * cs + x1 * sn;
  }
#pragma unroll
  for (int i = 0; i < 64; ++i) q[i] *= 0.125f;
  const size_t kvo = ((size_t)(b * 2 + kvh) * S) * 64;
  const bf16* ksb = (const bf16*)(p.ws + OFF_KSB) + kvo;
  const bf16* vsb = (const bf16*)(p.ws + OFF_VSB) + kvo;
  const bf16* kwb = (const bf16*)(p.ws + OFF_KWB) + kvo;
  const bf16* vwb = (const bf16*)(p.ws + OFF_VWB) + kvo;
  const int* selp = (const int*)(p.ws + OFF_SEL) + (((size_t)b * 2 + kvh) * S + t) * 16;
  float* oa = (float*)(p.ws + OFF_H) + tok * 512 + h * 64;
  const float gate1 = (!PROBE_NSA || (PROBE_NSA & 2)) ? sigmoidf_(bf2f(proj[tok * PC + C_NG + h * 3 + 1])) : 0.f;
  const float gate2 = (!PROBE_NSA || (PROBE_NSA & 4)) ? sigmoidf_(bf2f(proj[tok * PC + C_NG + h * 3 + 2])) : 0.f;
  float o[64];
  {
    float m = -INFINITY;
    for (int j = 0; j < 16; ++j) {
      int n = selp[j];
      if (n >= 0) {
        for (int i = 0; i < 64; ++i) {
          int kpos = n * 64 + i;
          if (kpos <= t) {
            float s = dot64_bf(q, ksb + (size_t)kpos * 64);
            m = fmaxf(m, s);
          }
        }
      }
    }
    float l = 0.f;
#pragma unroll
    for (int d = 0; d < 64; ++d) o[d] = 0.f;
    for (int j = 0; j < 16; ++j) {
      int n = selp[j];
      if (n >= 0) {
        for (int i = 0; i < 64; ++i) {
          int kpos = n * 64 + i;
          if (kpos <= t) {
            float s = dot64_bf(q, ksb + (size_t)kpos * 64);
            float pr = expf(s - m);
            l += pr;
            axpy64_bf(o, pr, vsb + (size_t)kpos * 64);
          }
        }
      }
    }
    float sc = gate1 / l;
#pragma unroll
    for (int d = 0; d < 64; d += 4) {
      float4 v = *(float4*)(oa + d);
      v.x += sc * o[d]; v.y += sc * o[d + 1]; v.z += sc * o[d + 2]; v.w += sc * o[d + 3];
      *(float4*)(oa + d) = v;
    }
  }
  {
    const int s0 = chunk * 64;
    const int jlo = (s0 - 511 > 0) ? (s0 - 511) : 0;
    const int jhi = s0 + 63;
    float m = -INFINITY;
    for (int j = jlo; j <= jhi; ++j) {
      float s = dot64_bf(q, kwb + (size_t)j * 64);
      if (j <= t && j > t - 512) m = fmaxf(m, s);
    }
    float l = 0.f;
#pragma unroll
    for (int d = 0; d < 64; ++d) o[d] = 0.f;
    for (int j = jlo; j <= jhi; ++j) {
      float s = dot64_bf(q, kwb + (size_t)j * 64);
      float pr = (j <= t && j > t - 512) ? expf(s - m) : 0.f;
      l += pr;
      axpy64_bf(o, pr, vwb + (size_t)j * 64);
    }
    float sc = gate2 / l;
    bf16* ob = (bf16*)(p.ws + (PROBE_NSA ? OFF_CMP : OFF_ONSA)) + tok * 512 + h * 64;
#pragma unroll
    for (int d = 0; d < 64; d += 8) {
      float4 v0 = *(float4*)(oa + d);
      float4 v1 = *(float4*)(oa + d + 4);
      uint4 pk;
      pk.x = (unsigned)f2bf(v0.x + sc * o[d]) | ((unsigned)f2bf(v0.y + sc * o[d + 1]) << 16);
      pk.y = (unsigned)f2bf(v0.z + sc * o[d + 2]) | ((unsigned)f2bf(v0.w + sc * o[d + 3]) << 16);
      pk.z = (unsigned)f2bf(v1.x + sc * o[d + 4]) | ((unsigned)f2bf(v1.y + sc * o[d + 5]) << 16);
      pk.w = (unsigned)f2bf(v1.z + sc * o[d + 6]) | ((unsigned)f2bf(v1.w + sc * o[d + 7]) << 16);
      *(uint4*)(ob + d) = pk;
    }
  }
}

DEV void moba_item(const Params& p, int layer, int item) {
  const int blk = item & 63, h = (item >> 6) & 7, b = item >> 9;
  const int tid = tidx();
  const int t = blk * 256 + tid;
  const size_t tok = (size_t)b * S + t;
  const bf16* proj = (const bf16*)(p.ws + OFF_PROJ);
  float q[64];
  load_q64(q, proj + tok * PC + C_MQ + h * 64, 0.125f);
  const float* km = (const float*)(p.ws + OFF_KMEAN) + ((size_t)b * 8 + h) * 64 * 64;
  float b0 = -INFINITY, b1 = -INFINITY, b2 = -INFINITY;
  int i0 = -1, i1 = -1, i2 = -1;
  for (int n = 0; n < blk; ++n) {
    float v = dot64_f(q, km + n * 64);
    if (v > b0) { b2 = b1; i2 = i1; b1 = b0; i1 = i0; b0 = v; i0 = n; }
    else if (v > b1) { b2 = b1; i2 = i1; b1 = v; i1 = n; }
    else if (v > b2) { b2 = v; i2 = n; }
  }
  const bf16* mkb = (const bf16*)(p.ws + OFF_MKB) + ((size_t)(b * 8 + h) * S) * 64;
  const bf16* mvb = (const bf16*)(p.ws + OFF_MVB) + ((size_t)(b * 8 + h) * S) * 64;
  float m = -INFINITY;
  for (int sidx = 0; sidx < 3; ++sidx) {
    int n = (sidx == 0) ? i0 : (sidx == 1) ? i1 : i2;
    if (sidx < blk) {
      for (int i = 0; i < 256; ++i) {
        float s = dot64_bf(q, mkb + (size_t)(n * 256 + i) * 64);
        m = fmaxf(m, s);
      }
    }
  }
  for (int i = 0; i < 256; ++i) {
    int kpos = blk * 256 + i;
    float s = dot64_bf(q, mkb + (size_t)kpos * 64);
    if (kpos <= t) m = fmaxf(m, s);
  }
  float l = 0.f;
  float o[64];
#pragma unroll
  for (int d = 0; d < 64; ++d) o[d] = 0.f;
  for (int sidx = 0; sidx < 3; ++sidx) {
    int n = (sidx == 0) ? i0 : (sidx == 1) ? i1 : i2;
    if (sidx < blk) {
      for (int i = 0; i < 256; ++i) {
        const size_t ko = (size_t)(n * 256 + i) * 64;
        float s = dot64_bf(q, mkb + ko);
        float pr = expf(s - m);
        l += pr;
        axpy64_bf(o, pr, mvb + ko);
      }
    }
  }
  for (int i = 0; i < 256; ++i) {
    int kpos = blk * 256 + i;
    const size_t ko = (size_t)kpos * 64;
    float s = dot64_bf(q, mkb + ko);
    float pr = (kpos <= t) ? expf(s - m) : 0.f;
    l += pr;
    axpy64_bf(o, pr, mvb + ko);
  }
  const float il = 1.f / l;
  bf16* ob = (bf16*)(p.ws + (PROBE_MOBA ? OFF_CMP : OFF_OMOBA)) + tok * 512 + h * 64;
#pragma unroll
  for (int d = 0; d < 64; d += 8) {
    uint4 pk;
    pk.x = (unsigned)f2bf(o[d] * il) | ((unsigned)f2bf(o[d + 1] * il) << 16);
    pk.y = (unsigned)f2bf(o[d + 2] * il) | ((unsigned)f2bf(o[d + 3] * il) << 16);
    pk.z = (unsigned)f2bf(o[d + 4] * il) | ((unsigned)f2bf(o[d + 5] * il) << 16);
    pk.w = (unsigned)f2bf(o[d + 6] * il) | ((unsigned)f2bf(o[d + 7] * il) << 16);
    *(uint4*)(ob + d) = pk;
  }
}

typedef short v4i16_t __attribute__((ext_vector_type(4)));
typedef unsigned u32x4_t __attribute__((ext_vector_type(4)));
DEV v4i16_t lds_tr16(const bf16* p) {
  return __builtin_amdgcn_ds_read_tr16_b64_v4i16((__attribute__((address_space(3))) v4i16_t*)p);
}
DEV unsigned cvtpk(float lo, float hi) {
  unsigned r;
  asm("v_cvt_pk_bf16_f32 %0, %1, %2" : "=v"(r) : "v"(lo), "v"(hi));
  return r;
}
#define MFMA16(a, b, c) __builtin_amdgcn_mfma_f32_16x16x32_bf16(a, b, c, 0, 0, 0)
constexpr float C2 = 0.125f * 1.4426950408889634f;
constexpr int KT_LD = 72;
constexpr int KT_ELEMS = 64 * KT_LD;

template <int NI>
struct AttnSt {
  f32x4 o[4][NI];
  float m[NI], l[NI];
};
template <int NI>
DEV void attn_init(AttnSt<NI>& st) {
#pragma unroll
  for (int ni = 0; ni < NI; ++ni) {
    st.m[ni] = -INFINITY;
    st.l[ni] = 0.f;
#pragma unroll
    for (int di = 0; di < 4; ++di) st.o[di][ni] = f32x4{0.f, 0.f, 0.f, 0.f};
  }
}
#define TILE_DECL uint4 tl_k0, tl_k1, tl_v0, tl_v1
#define TILE_GLOAD(kb, vb, ld, key0)                                                        \
  do {                                                                                      \
    const int r_ = tidx() >> 3, c_ = (tidx() & 7) * 8;                            \
    tl_k0 = *(const uint4*)((kb) + (size_t)((key0) + r_) * (ld) + c_);                      \
    tl_k1 = *(const uint4*)((kb) + (size_t)((key0) + 32 + r_) * (ld) + c_);                 \
    tl_v0 = *(const uint4*)((vb) + (size_t)((key0) + r_) * (ld) + c_);                      \
    tl_v1 = *(const uint4*)((vb) + (size_t)((key0) + 32 + r_) * (ld) + c_);                 \
  } while (0)
#define TILE_SSTORE(Ks_, Vs_)                                                               \
  do {                                                                                      \
    const int r_ = tidx() >> 3, c_ = (tidx() & 7) * 8;                            \
    *(uint4*)((Ks_) + r_ * KT_LD + c_) = tl_k0;                                             \
    *(uint4*)((Ks_) + (32 + r_) * KT_LD + c_) = tl_k1;                                      \
    *(uint4*)((Vs_) + r_ * KT_LD + c_) = tl_v0;                                             \
    *(uint4*)((Vs_) + (32 + r_) * KT_LD + c_) = tl_v1;                                      \
  } while (0)
#define TL_GLOAD(P, kb, vb, ld, key0)                                                       \
  do {                                                                                      \
    const int r_ = tidx() >> 3, c_ = (tidx() & 7) * 8;                                      \
    P##_k0 = *(const uint4*)((kb) + (size_t)((key0) + r_) * (ld) + c_);                     \
    P##_k1 = *(const uint4*)((kb) + (size_t)((key0) + 32 + r_) * (ld) + c_);                \
    P##_v0 = *(const uint4*)((vb) + (size_t)((key0) + r_) * (ld) + c_);                     \
    P##_v1 = *(const uint4*)((vb) + (size_t)((key0) + 32 + r_) * (ld) + c_);                \
  } while (0)
#define TL_SSTORE(P, Ks_, Vs_)                                                              \
  do {                                                                                      \
    const int r_ = tidx() >> 3, c_ = (tidx() & 7) * 8;                                      \
    *(uint4*)((Ks_) + r_ * KT_LD + c_) = P##_k0;                                            \
    *(uint4*)((Ks_) + (32 + r_) * KT_LD + c_) = P##_k1;                                     \
    *(uint4*)((Vs_) + r_ * KT_LD + c_) = P##_v0;                                            \
    *(uint4*)((Vs_) + (32 + r_) * KT_LD + c_) = P##_v1;                                     \
  } while (0)
#define KV_SWEEP(kb_, vb_, ld_, nt_, KEYF, ...)                                             \
  {                                                                                         \
    uint4 tA_k0, tA_k1, tA_v0, tA_v1, tB_k0, tB_k1, tB_v0, tB_v1;                           \
    const int nt__ = (nt_);                                                                 \
    if (nt__ > 0) {                                                                         \
      TL_GLOAD(tA, kb_, vb_, ld_, KEYF(0));                                                 \
      TL_SSTORE(tA, smkv, smkv + KT_ELEMS);                                                 \
      if (nt__ > 1) TL_GLOAD(tA, kb_, vb_, ld_, KEYF(1));                                   \
    }                                                                                       \
    __syncthreads();                                                                        \
    for (int it0__ = 0; it0__ < nt__; it0__ += 2) {                                         \
      {                                                                                     \
        const int it = it0__;                                                               \
        if (it + 2 < nt__) TL_GLOAD(tB, kb_, vb_, ld_, KEYF(it + 2));                       \
        const bf16* Ks = smkv;                                                              \
        __VA_ARGS__                                                                         \
        if (it + 1 < nt__) TL_SSTORE(tA, smkv + 2 * KT_ELEMS, smkv + 3 * KT_ELEMS);         \
        __syncthreads();                                                                    \
      }                                                                                     \
      if (it0__ + 1 < nt__) {                                                               \
        const int it = it0__ + 1;                                                           \
        if (it + 2 < nt__) TL_GLOAD(tA, kb_, vb_, ld_, KEYF(it + 2));                       \
        const bf16* Ks = smkv + 2 * KT_ELEMS;                                               \
        __VA_ARGS__                                                                         \
        if (it + 1 < nt__) TL_SSTORE(tB, smkv, smkv + KT_ELEMS);                            \
        __syncthreads();                                                                    \
      }                                                                                     \
    }                                                                                       \
  }
template <int NI>
DEV void attn_scores(const bf16* Ks, const bf16x8 (&qf)[NI][2], f32x4 (&s)[4][NI]) {
  const int lane = tidx() & 63, g4 = lane >> 4, c16 = lane & 15;
#pragma unroll
  for (int mi = 0; mi < 4; ++mi) {
#pragma unroll
    for (int ni = 0; ni < NI; ++ni) s[mi][ni] = f32x4{0.f, 0.f, 0.f, 0.f};
#pragma unroll
    for (int ks = 0; ks < 2; ++ks) {
      bf16x8 kf = *(const bf16x8*)(Ks + (mi * 16 + c16) * KT_LD + ks * 32 + g4 * 8);
#pragma unroll
      for (int ni = 0; ni < NI; ++ni) s[mi][ni] = MFMA16(kf, qf[ni][ks], s[mi][ni]);
    }
  }
}
template <int NI>
DEV void attn_pv(const bf16* Vs, const bf16x8 (&pf)[NI][2], f32x4 (&o)[4][NI]) {
  const int lane = tidx() & 63, g4 = lane >> 4, q4 = (lane & 15) >> 2, p4 = lane & 3;
#pragma unroll
  for (int di = 0; di < 4; ++di) {
#pragma unroll
    for (int ks2 = 0; ks2 < 2; ++ks2) {
      v4i16_t v0 = lds_tr16(Vs + (ks2 * 32 + g4 * 4 + q4) * KT_LD + di * 16 + p4 * 4);
      v4i16_t v1 = lds_tr16(Vs + (ks2 * 32 + 16 + g4 * 4 + q4) * KT_LD + di * 16 + p4 * 4);
      bf16x8 vf = __builtin_shufflevector(v0, v1, 0, 1, 2, 3, 4, 5, 6, 7);
#pragma unroll
      for (int ni = 0; ni < NI; ++ni) o[di][ni] = MFMA16(vf, pf[ni][ks2], o[di][ni]);
    }
  }
}
DEV void exp4_pack(const f32x4& sv, float nm, float& ps, unsigned& w0, unsigned& w1) {
  float p0 = __builtin_amdgcn_exp2f(__builtin_fmaf(sv[0], C2, nm));
  float p1 = __builtin_amdgcn_exp2f(__builtin_fmaf(sv[1], C2, nm));
  float p2 = __builtin_amdgcn_exp2f(__builtin_fmaf(sv[2], C2, nm));
  float p3 = __builtin_amdgcn_exp2f(__builtin_fmaf(sv[3], C2, nm));
  ps += (p0 + p1) + (p2 + p3);
  w0 = cvtpk(p0, p1);
  w1 = cvtpk(p2, p3);
}
template <int NI>
DEV void attn_softmax_pv(const bf16* Vs, f32x4 (&s)[4][NI], AttnSt<NI>& st) {
  bf16x8 pf[NI][2];
#pragma unroll
  for (int ni = 0; ni < NI; ++ni) {
    float mx = -INFINITY;
#pragma unroll
    for (int mi = 0; mi < 4; ++mi)
      mx = fmaxf(fmaxf(mx, fmaxf(s[mi][ni][0], s[mi][ni][1])), fmaxf(s[mi][ni][2], s[mi][ni][3]));
    mx = fmaxf(mx, shx(mx, 16));
    mx = fmaxf(mx, shx(mx, 32));
    const float mn = fmaxf(st.m[ni], mx);
    const float mu = (mn == -INFINITY) ? 0.f : mn;
    const float corr = __builtin_amdgcn_exp2f((st.m[ni] - mu) * C2);
    st.m[ni] = mn;
    const float nm = -mu * C2;
    float ps = 0.f;
    u32x4_t wa, wb;
    unsigned t0, t1;
    exp4_pack(s[0][ni], nm, ps, t0, t1); wa.x = t0; wa.y = t1;
    exp4_pack(s[1][ni], nm, ps, t0, t1); wa.z = t0; wa.w = t1;
    exp4_pack(s[2][ni], nm, ps, t0, t1); wb.x = t0; wb.y = t1;
    exp4_pack(s[3][ni], nm, ps, t0, t1); wb.z = t0; wb.w = t1;
    st.l[ni] = st.l[ni] * corr + ps;
#pragma unroll
    for (int di = 0; di < 4; ++di) {
      st.o[di][ni][0] *= corr; st.o[di][ni][1] *= corr; st.o[di][ni][2] *= corr; st.o[di][ni][3] *= corr;
    }
    pf[ni][0] = __builtin_bit_cast(bf16x8, wa);
    pf[ni][1] = __builtin_bit_cast(bf16x8, wb);
  }
  attn_pv<NI>(Vs, pf, st.o);
}

template <int NI>
DEV void attn_softmax_pv_act(const bf16* Vs, f32x4 (&s)[4][NI], AttnSt<NI>& st, const bool (&act)[NI]) {
  bf16x8 pf[NI][2];
#pragma unroll
  for (int ni = 0; ni < NI; ++ni) {
    pf[ni][0] = bf16x8{0, 0, 0, 0, 0, 0, 0, 0};
    pf[ni][1] = bf16x8{0, 0, 0, 0, 0, 0, 0, 0};
    if (act[ni]) {
      float mx = -INFINITY;
#pragma unroll
      for (int mi = 0; mi < 4; ++mi)
        mx = fmaxf(fmaxf(mx, fmaxf(s[mi][ni][0], s[mi][ni][1])), fmaxf(s[mi][ni][2], s[mi][ni][3]));
      mx = fmaxf(mx, shx(mx, 16));
      mx = fmaxf(mx, shx(mx, 32));
      const float mn = fmaxf(st.m[ni], mx);
      const float mu = (mn == -INFINITY) ? 0.f : mn;
      const float corr = __builtin_amdgcn_exp2f((st.m[ni] - mu) * C2);
      st.m[ni] = mn;
      const float nm = -mu * C2;
      float ps = 0.f;
      u32x4_t wa, wb;
      unsigned t0, t1;
      exp4_pack(s[0][ni], nm, ps, t0, t1); wa.x = t0; wa.y = t1;
      exp4_pack(s[1][ni], nm, ps, t0, t1); wa.z = t0; wa.w = t1;
      exp4_pack(s[2][ni], nm, ps, t0, t1); wb.x = t0; wb.y = t1;
      exp4_pack(s[3][ni], nm, ps, t0, t1); wb.z = t0; wb.w = t1;
      st.l[ni] = st.l[ni] * corr + ps;
#pragma unroll
      for (int di = 0; di < 4; ++di) {
        st.o[di][ni][0] *= corr; st.o[di][ni][1] *= corr; st.o[di][ni][2] *= corr; st.o[di][ni][3] *= corr;
      }
      pf[ni][0] = __builtin_bit_cast(bf16x8, wa);
      pf[ni][1] = __builtin_bit_cast(bf16x8, wb);
    }
  }
  const int lane = tidx() & 63, g4 = lane >> 4, q4 = (lane & 15) >> 2, p4 = lane & 3;
#pragma unroll
  for (int di = 0; di < 4; ++di) {
#pragma unroll
    for (int ks2 = 0; ks2 < 2; ++ks2) {
      v4i16_t v0 = lds_tr16(Vs + (ks2 * 32 + g4 * 4 + q4) * KT_LD + di * 16 + p4 * 4);
      v4i16_t v1 = lds_tr16(Vs + (ks2 * 32 + 16 + g4 * 4 + q4) * KT_LD + di * 16 + p4 * 4);
      bf16x8 vf = __builtin_shufflevector(v0, v1, 0, 1, 2, 3, 4, 5, 6, 7);
#pragma unroll
      for (int ni = 0; ni < NI; ++ni)
        if (act[ni]) st.o[di][ni] = MFMA16(vf, pf[ni][ks2], st.o[di][ni]);
    }
  }
}
template <int NI>
DEV int gate_top1(f32x4 (&gs)[4][NI], int ni, int g4) {
  float bv = -INFINITY;
  int bi = 1 << 20;
#pragma unroll
  for (int mi = 0; mi < 4; ++mi)
#pragma unroll
    for (int r = 0; r < 4; ++r) {
      float v = gs[mi][ni][r];
      if (v > bv) { bv = v; bi = mi * 16 + g4 * 4 + r; }
    }
#pragma unroll
  for (int off = 16; off <= 32; off <<= 1) {
    float ov = shx(bv, off);
    int oi = shx(bi, off);
    if (ov > bv || (ov == bv && oi < bi)) { bv = ov; bi = oi; }
  }
#pragma unroll
  for (int mi = 0; mi < 4; ++mi)
#pragma unroll
    for (int r = 0; r < 4; ++r)
      if (mi * 16 + g4 * 4 + r == bi) gs[mi][ni][r] = -INFINITY;
  return (bv == -INFINITY) ? -1 : bi;
}
template <int NI>
DEV void moba_mfma_item(const Params& p, int item, char* smem, bf16* outbuf) {
  constexpr int QB = 64 * NI;
  bf16* sm = (bf16*)smem;
  const int bh = item & 15, cq = (S / QB - 1) - (item >> 4);
  const int b = bh >> 3, h = bh & 7;
  const int s0 = cq * QB, blk = s0 >> 8;
  const int lane = tidx() & 63, wave = tidx() >> 6, g4 = lane >> 4, c16 = lane & 15;
  const bf16* proj = (const bf16*)(p.ws + OFF_PROJ) + (size_t)b * S * PC;
  bf16x8 qf[NI][2];
  int tq[NI];
#pragma unroll
  for (int ni = 0; ni < NI; ++ni) {
    tq[ni] = s0 + wave * 16 * NI + ni * 16 + c16;
#pragma unroll
    for (int ks = 0; ks < 2; ++ks)
      qf[ni][ks] = *(const bf16x8*)(proj + (size_t)tq[ni] * PC + C_MQ + h * 64 + ks * 32 + g4 * 8);
  }
  int i0[NI], i1[NI], i2[NI];
  {
    const bf16* kmh = (const bf16*)(p.ws + OFF_KMHL) + ((size_t)(b * 8 + h) * 64) * 64;
    const bf16* kml = kmh + (size_t)2 * 8 * 64 * 64;
    f32x4 gs[4][NI];
#pragma unroll
    for (int mi = 0; mi < 4; ++mi) {
#pragma unroll
      for (int ni = 0; ni < NI; ++ni) gs[mi][ni] = f32x4{0.f, 0.f, 0.f, 0.f};
#pragma unroll
      for (int ks = 0; ks < 2; ++ks) {
        bf16x8 ah = *(const bf16x8*)(kmh + (mi * 16 + c16) * 64 + ks * 32 + g4 * 8);
        bf16x8 al_ = *(const bf16x8*)(kml + (mi * 16 + c16) * 64 + ks * 32 + g4 * 8);
#pragma unroll
        for (int ni = 0; ni < NI; ++ni) {
          gs[mi][ni] = MFMA16(ah, qf[ni][ks], gs[mi][ni]);
          gs[mi][ni] = MFMA16(al_, qf[ni][ks], gs[mi][ni]);
        }
      }
    }
#pragma unroll
    for (int ni = 0; ni < NI; ++ni) {
#pragma unroll
      for (int mi = 0; mi < 4; ++mi)
#pragma unroll
        for (int r = 0; r < 4; ++r)
          if (mi * 16 + g4 * 4 + r >= blk) gs[mi][ni][r] = -INFINITY;
      i0[ni] = gate_top1(gs, ni, g4);
      i1[ni] = gate_top1(gs, ni, g4);
      i2[ni] = gate_top1(gs, ni, g4);
    }
  }
  AttnSt<NI> st;
  attn_init<NI>(st);
  const int ntiles = (s0 + QB) >> 6;
  const bf16* kb = (const bf16*)(p.ws + OFF_MKB) + ((size_t)(b * 8 + h) * S) * 64;
  const bf16* vb = (const bf16*)(p.ws + OFF_MVB) + ((size_t)(b * 8 + h) * S) * 64;
  bf16* smkv = sm;
  __syncthreads();
#define MOBA_KEY(i) ((i) * 64)
  KV_SWEEP(kb, vb, 64, ntiles, MOBA_KEY,
    const int n = it >> 2;
    const bool own = (n == blk);
    const int kbase = it * 64;
    bool wave_active = own;
    if (!own) {
      bool anyq = false;
      _Pragma("unroll") for (int ni = 0; ni < NI; ++ni) anyq = anyq || (n == i0[ni]) || (n == i1[ni]) || (n == i2[ni]);
      wave_active = __builtin_amdgcn_ballot_w64(anyq) != 0ull;
    }
    if (wave_active) {
      f32x4 s[4][NI];
      attn_scores<NI>(Ks, qf, s);
      _Pragma("unroll") for (int ni = 0; ni < NI; ++ni) {
        if (own) {
          _Pragma("unroll") for (int mi = 0; mi < 4; ++mi)
            _Pragma("unroll") for (int r = 0; r < 4; ++r)
              if (kbase + mi * 16 + g4 * 4 + r > tq[ni]) s[mi][ni][r] = -INFINITY;
        } else {
          const bool okb = (n == i0[ni]) | (n == i1[ni]) | (n == i2[ni]);
          if (!okb) {
            _Pragma("unroll") for (int mi = 0; mi < 4; ++mi) s[mi][ni] = f32x4{-INFINITY, -INFINITY, -INFINITY, -INFINITY};
          }
        }
      }
      attn_softmax_pv<NI>(Ks + KT_ELEMS, s, st);
    }
  )
#pragma unroll
  for (int ni = 0; ni < NI; ++ni) {
    float l = st.l[ni];
    l += shx(l, 16);
    l += shx(l, 32);
    const float inv = 1.f / l;
    bf16* op = outbuf + ((size_t)b * S + tq[ni]) * 512 + h * 64 + g4 * 4;
#pragma unroll
    for (int di = 0; di < 4; ++di) {
      uint2 pk;
      pk.x = cvtpk(st.o[di][ni][0] * inv, st.o[di][ni][1] * inv);
      pk.y = cvtpk(st.o[di][ni][2] * inv, st.o[di][ni][3] * inv);
      *(uint2*)(op + di * 16) = pk;
    }
  }
}

DEV int moba_list_base(int n) { return n * S - 128 * n * (n + 1); }
template <int NI>
DEV void moba_gate_batch(const Params& p, int item0, int istride, int nitems, int* sm) {
  constexpr int QB = 64 * NI;
  constexpr int MAXB = 4;
  const int tid = tidx(), lane = tid & 63, wave = tid >> 6, g4 = lane >> 4, c16 = lane & 15;
  int* hist = sm;
  int* base = sm + MAXB * 64;
  hist[tid] = 0;
  __syncthreads();
  int sel[MAXB][NI][3], rk[MAXB][NI][3], tqs[MAXB][NI];
#pragma unroll
  for (int j = 0; j < MAXB; ++j) {
    const int item = item0 + j * istride;
    const int bh = item & 15, cq = item >> 4;
    const int b = bh >> 3, h = bh & 7;
    const int s0 = cq * QB, blk = s0 >> 8;
    const bool live = (j < nitems) && (blk > 0);
#pragma unroll
    for (int ni = 0; ni < NI; ++ni) {
      tqs[j][ni] = s0 + wave * 16 * NI + ni * 16 + c16;
#pragma unroll
      for (int k = 0; k < 3; ++k) { sel[j][ni][k] = -1; rk[j][ni][k] = 0; }
    }
    if (!live) continue;
    const bf16* proj = (const bf16*)(p.ws + OFF_PROJ) + (size_t)b * S * PC;
    bf16x8 qf[NI][2];
#pragma unroll
    for (int ni = 0; ni < NI; ++ni)
#pragma unroll
      for (int ks = 0; ks < 2; ++ks)
        qf[ni][ks] = *(const bf16x8*)(proj + (size_t)tqs[j][ni] * PC + C_MQ + h * 64 + ks * 32 + g4 * 8);
    const bf16* kmh = (const bf16*)(p.ws + OFF_KMHL) + ((size_t)(b * 8 + h) * 64) * 64;
    const bf16* kml = kmh + (size_t)2 * 8 * 64 * 64;
    f32x4 gs[4][NI];
#pragma unroll
    for (int mi = 0; mi < 4; ++mi) {
#pragma unroll
      for (int ni = 0; ni < NI; ++ni) gs[mi][ni] = f32x4{0.f, 0.f, 0.f, 0.f};
#pragma unroll
      for (int ks = 0; ks < 2; ++ks) {
        bf16x8 ah = *(const bf16x8*)(kmh + (mi * 16 + c16) * 64 + ks * 32 + g4 * 8);
        bf16x8 al_ = *(const bf16x8*)(kml + (mi * 16 + c16) * 64 + ks * 32 + g4 * 8);
#pragma unroll
        for (int ni = 0; ni < NI; ++ni) {
          gs[mi][ni] = MFMA16(ah, qf[ni][ks], gs[mi][ni]);
          gs[mi][ni] = MFMA16(al_, qf[ni][ks], gs[mi][ni]);
        }
      }
    }
#pragma unroll
    for (int ni = 0; ni < NI; ++ni) {
#pragma unroll
      for (int mi = 0; mi < 4; ++mi)
#pragma unroll
        for (int r = 0; r < 4; ++r)
          if (mi * 16 + g4 * 4 + r >= blk) gs[mi][ni][r] = -INFINITY;
#pragma unroll
      for (int k = 0; k < 3; ++k) {
        sel[j][ni][k] = gate_top1(gs, ni, g4);
        rk[j][ni][k] = (g4 == 0 && sel[j][ni][k] >= 0) ? atomicAdd(&hist[j * 64 + sel[j][ni][k]], 1) : 0;
      }
    }
  }
  __syncthreads();
  {
    const int j = tid >> 6, n = tid & 63;
    const int item = item0 + j * istride;
    const int c = hist[tid];
    int* cnt = (int*)(p.ws + OFF_MCNT) + (size_t)(item & 15) * 64 * MCNT_STRIDE;
    base[tid] = (c > 0) ? atomicAdd(cnt + n * MCNT_STRIDE, c) : 0;
  }
  __syncthreads();
  if (g4 == 0) {
#pragma unroll
    for (int j = 0; j < MAXB; ++j) {
      const int item = item0 + j * istride;
      unsigned short* lists = (unsigned short*)(p.ws + OFF_MLIST) + (size_t)(item & 15) * MLIST_PER_BH;
#pragma unroll
      for (int ni = 0; ni < NI; ++ni)
#pragma unroll
        for (int k = 0; k < 3; ++k) {
          const int sv = sel[j][ni][k];
          if (sv >= 0) lists[moba_list_base(sv) + base[j * 64 + sv] + rk[j][ni][k]] = (unsigned short)(tqs[j][ni] | (k << 14));
        }
    }
  }
  __syncthreads();
}
template <int NI>
DEV void moba_part_item(const Params& p, int b, int item, char* smem) {
  constexpr int CH = 64 * NI;
  bf16* smkv = (bf16*)smem;
  const int n = item >> 6, h = (item >> 3) & 7, part = item & 7;
  const int lane = tidx() & 63, wave = tidx() >> 6, g4 = lane >> 4, c16 = lane & 15;
  const int cnt = ((const int*)(p.ws + OFF_MCNT))[((b * 8 + h) * 64 + n) * MCNT_STRIDE];
  const unsigned short* list = (const unsigned short*)(p.ws + OFF_MLIST) + (size_t)(b * 8 + h) * MLIST_PER_BH + moba_list_base(n);
  const bf16* proj = (const bf16*)(p.ws + OFF_PROJ) + (size_t)b * S * PC;
  const bf16* kb = (const bf16*)(p.ws + OFF_MKB) + ((size_t)(b * 8 + h) * S + n * 256) * 64;
  const bf16* vb = (const bf16*)(p.ws + OFF_MVB) + ((size_t)(b * 8 + h) * S + n * 256) * 64;
  bf16* po = (bf16*)(p.ws + OFF_MPO);
  float2* pml = (float2*)(p.ws + OFF_MPML);
  for (int c = part; c * CH < cnt; c += 8) {
    bf16x8 qf[NI][2];
    int tcol[NI], slot[NI];
    bool valid[NI];
#pragma unroll
    for (int ni = 0; ni < NI; ++ni) {
      const int idx = c * CH + wave * 16 * NI + ni * 16 + c16;
      valid[ni] = idx < cnt;
      const unsigned e = list[valid[ni] ? idx : 0];
      tcol[ni] = e & 0x3FFF;
      slot[ni] = e >> 14;
#pragma unroll
      for (int ks = 0; ks < 2; ++ks)
        qf[ni][ks] = *(const bf16x8*)(proj + (size_t)tcol[ni] * PC + C_MQ + h * 64 + ks * 32 + g4 * 8);
    }
    AttnSt<NI> st;
    attn_init<NI>(st);
    __syncthreads();
#define MOBA_PKEY(i) ((i) * 64)
    KV_SWEEP(kb, vb, 64, 4, MOBA_PKEY,
      f32x4 s[4][NI];
      attn_scores<NI>(Ks, qf, s);
      attn_softmax_pv<NI>(Ks + KT_ELEMS, s, st);
    )
#pragma unroll
    for (int ni = 0; ni < NI; ++ni) {
      float l = st.l[ni];
      l += shx(l, 16);
      l += shx(l, 32);
      if (valid[ni]) {
        const size_t rec = ((size_t)h * S + tcol[ni]) * 3 + slot[ni];
        if (g4 == 0) pml[rec] = float2{st.m[ni], l};
        bf16* op = po + rec * 64 + g4 * 4;
#pragma unroll
        for (int di = 0; di < 4; ++di) {
          uint2 pk;
          pk.x = cvtpk(st.o[di][ni][0], st.o[di][ni][1]);
          pk.y = cvtpk(st.o[di][ni][2], st.o[di][ni][3]);
          *(uint2*)(op + di * 16) = pk;
        }
      }
    }
  }
}
template <int NI>
DEV void moba_part_item2(const Params& p, int b, int item, char* smem) {
  constexpr int WCH = 16 * NI;
  bf16* Kall = (bf16*)smem;
  bf16* Vall = Kall + 256 * KT_LD;
  static_assert(2 * 256 * KT_LD * 2 <= SMEM_BYTES, "moba block staging");
  constexpr int NPART = MOBA_NPART;
  const int n = item / (8 * NPART), h = (item / NPART) & 7, part = item % NPART;
  const int tid = tidx(), lane = tid & 63, wave = tid >> 6, g4 = lane >> 4, c16 = lane & 15;
  const int cnt = ((const int*)(p.ws + OFF_MCNT))[((b * 8 + h) * 64 + n) * MCNT_STRIDE];
  const bool active = part * 4 * WCH < cnt;
  const unsigned short* list = (const unsigned short*)(p.ws + OFF_MLIST) + (size_t)(b * 8 + h) * MLIST_PER_BH + moba_list_base(n);
  const bf16* proj = (const bf16*)(p.ws + OFF_PROJ) + (size_t)b * S * PC;
  const bf16* kb = (const bf16*)(p.ws + OFF_MKB) + ((size_t)(b * 8 + h) * S + n * 256) * 64;
  const bf16* vb = (const bf16*)(p.ws + OFF_MVB) + ((size_t)(b * 8 + h) * S + n * 256) * 64;
  bf16* po = (bf16*)(p.ws + OFF_MPO);
  float2* pml = (float2*)(p.ws + OFF_MPML);
  __syncthreads();
  if (active) {
#pragma unroll
    for (int i = 0; i < 8; ++i) {
      const int id = tid + 256 * i, r = id >> 3, c = (id & 7) * 8;
      const uint4 kv = *(const uint4*)(kb + (size_t)r * 64 + c);
      const uint4 vv = *(const uint4*)(vb + (size_t)r * 64 + c);
      *(uint4*)(Kall + r * KT_LD + c) = kv;
      *(uint4*)(Vall + r * KT_LD + c) = vv;
    }
  }
  __syncthreads();
  if (!active) return;
  for (int wc = part * 4 + wave; wc * WCH < cnt; wc += 4 * NPART) {
    bf16x8 qf[NI][2];
    int tcol[NI], slot[NI];
    bool valid[NI];
#pragma unroll
    for (int ni = 0; ni < NI; ++ni) {
      const int idx = wc * WCH + ni * 16 + c16;
      valid[ni] = idx < cnt;
      const unsigned e = list[valid[ni] ? idx : 0];
      tcol[ni] = e & 0x3FFF;
      slot[ni] = e >> 14;
#pragma unroll
      for (int ks = 0; ks < 2; ++ks)
        qf[ni][ks] = *(const bf16x8*)(proj + (size_t)tcol[ni] * PC + C_MQ + h * 64 + ks * 32 + g4 * 8);
    }
    AttnSt<NI> st;
    attn_init<NI>(st);
#pragma unroll 1
    for (int kt = 0; kt < 4; ++kt) {
      f32x4 s[4][NI];
      attn_scores<NI>(Kall + kt * 64 * KT_LD, qf, s);
      attn_softmax_pv<NI>(Vall + kt * 64 * KT_LD, s, st);
    }
#pragma unroll
    for (int ni = 0; ni < NI; ++ni) {
      float l = st.l[ni];
      l += shx(l, 16);
      l += shx(l, 32);
      if (valid[ni]) {
        const size_t rec = ((size_t)h * S + tcol[ni]) * 3 + slot[ni];
        if (g4 == 0) pml[rec] = float2{st.m[ni], l};
        bf16* op = po + rec * 64 + g4 * 4;
#pragma unroll
        for (int di = 0; di < 4; ++di) {
          uint2 pk;
          pk.x = cvtpk(st.o[di][ni][0], st.o[di][ni][1]);
          pk.y = cvtpk(st.o[di][ni][2], st.o[di][ni][3]);
          *(uint2*)(op + di * 16) = pk;
        }
      }
    }
  }
}
template <int NI>
DEV void moba_merge_item(const Params& p, int b, int item, char* smem, bf16* outbuf) {
  constexpr int QB = 64 * NI;
  constexpr int NCQ = S / QB;
  bf16* smkv = (bf16*)smem;
  const int h = item & 7, cq = item >> 3;
  static_assert(NCQ * 8 == 8 * (S / QB), "");
  const int s0 = cq * QB, blk = s0 >> 8;
  const int lane = tidx() & 63, wave = tidx() >> 6, g4 = lane >> 4, c16 = lane & 15;
  const bf16* proj = (const bf16*)(p.ws + OFF_PROJ) + (size_t)b * S * PC;
  bf16x8 qf[NI][2];
  int tq[NI];
#pragma unroll
  for (int ni = 0; ni < NI; ++ni) {
    tq[ni] = s0 + wave * 16 * NI + ni * 16 + c16;
#pragma unroll
    for (int ks = 0; ks < 2; ++ks)
      qf[ni][ks] = *(const bf16x8*)(proj + (size_t)tq[ni] * PC + C_MQ + h * 64 + ks * 32 + g4 * 8);
  }
  const bf16* kb = (const bf16*)(p.ws + OFF_MKB) + ((size_t)(b * 8 + h) * S) * 64;
  const bf16* vb = (const bf16*)(p.ws + OFF_MVB) + ((size_t)(b * 8 + h) * S) * 64;
  AttnSt<NI> st;
  attn_init<NI>(st);
  const int kt0 = blk * 4;
  const int ntl = ((s0 + QB - 1) >> 6) - kt0 + 1;
  __syncthreads();
#define MOBA_MKEY(i) ((kt0 + (i)) * 64)
  KV_SWEEP(kb, vb, 64, ntl, MOBA_MKEY,
    const int kbase = (kt0 + it) * 64;
    f32x4 s[4][NI];
    attn_scores<NI>(Ks, qf, s);
    _Pragma("unroll") for (int ni = 0; ni < NI; ++ni)
      _Pragma("unroll") for (int mi = 0; mi < 4; ++mi)
        _Pragma("unroll") for (int r = 0; r < 4; ++r)
          if (kbase + mi * 16 + g4 * 4 + r > tq[ni]) s[mi][ni][r] = -INFINITY;
    attn_softmax_pv<NI>(Ks + KT_ELEMS, s, st);
  )
  const int nsl = (blk < 3) ? blk : 3;
  const bf16* po = (const bf16*)(p.ws + OFF_MPO);
  const float2* pml = (const float2*)(p.ws + OFF_MPML);
#pragma unroll
  for (int ni = 0; ni < NI; ++ni) {
    float l = st.l[ni];
    l += shx(l, 16);
    l += shx(l, 32);
    const size_t rec0 = ((size_t)h * S + tq[ni]) * 3;
    float ms[3], ls[3];
    float M = st.m[ni];
#pragma unroll
    for (int s = 0; s < 3; ++s) {
      ms[s] = -INFINITY;
      ls[s] = 0.f;
      if (s < nsl) {
        const float2 v = pml[rec0 + s];
        ms[s] = v.x;
        ls[s] = v.y;
        M = fmaxf(M, v.x);
      }
    }
    const float fo = __builtin_amdgcn_exp2f((st.m[ni] - M) * C2);
    l *= fo;
    float f[3];
#pragma unroll
    for (int s = 0; s < 3; ++s) {
      f[s] = (s < nsl) ? __builtin_amdgcn_exp2f((ms[s] - M) * C2) : 0.f;
      l += ls[s] * f[s];
    }
    const float inv = 1.f / l;
    bf16* op = outbuf + ((size_t)b * S + tq[ni]) * ATT_LD + h * 64 + g4 * 4;
#pragma unroll
    for (int di = 0; di < 4; ++di) {
      float o0 = st.o[di][ni][0] * fo, o1 = st.o[di][ni][1] * fo, o2 = st.o[di][ni][2] * fo, o3 = st.o[di][ni][3] * fo;
#pragma unroll
      for (int s = 0; s < 3; ++s) {
        if (s < nsl) {
          const uint2 pv = *(const uint2*)(po + (rec0 + s) * 64 + di * 16 + g4 * 4);
          o0 += f[s] * __uint_as_float(pv.x << 16);
          o1 += f[s] * __uint_as_float(pv.x & 0xffff0000u);
          o2 += f[s] * __uint_as_float(pv.y << 16);
          o3 += f[s] * __uint_as_float(pv.y & 0xffff0000u);
        }
      }
      uint2 pk;
      pk.x = cvtpk(o0 * inv, o1 * inv);
      pk.y = cvtpk(o2 * inv, o3 * inv);
      *(uint2*)(op + di * 16) = pk;
    }
  }
}

template <int NI>
DEV void attn_stats(f32x4 (&s)[4][NI], float (&m)[NI], float (&l)[NI]) {
#pragma unroll
  for (int ni = 0; ni < NI; ++ni) {
    float mx = -INFINITY;
#pragma unroll
    for (int mi = 0; mi < 4; ++mi)
      mx = fmaxf(fmaxf(mx, fmaxf(s[mi][ni][0], s[mi][ni][1])), fmaxf(s[mi][ni][2], s[mi][ni][3]));
    mx = fmaxf(mx, shx(mx, 16));
    mx = fmaxf(mx, shx(mx, 32));
    const float mn = fmaxf(m[ni], mx);
    const float mu = (mn == -INFINITY) ? 0.f : mn;
    const float corr = __builtin_amdgcn_exp2f((m[ni] - mu) * C2);
    m[ni] = mn;
    const float nm = -mu * C2;
    float ps = 0.f;
#pragma unroll
    for (int mi = 0; mi < 4; ++mi)
#pragma unroll
      for (int r = 0; r < 4; ++r) ps += __builtin_amdgcn_exp2f(__builtin_fmaf(s[mi][ni][r], C2, nm));
    l[ni] = l[ni] * corr + ps;
  }
}
DEV bf16x8 rope_frag(bf16x8 qv, const float* __restrict__ rope_t, int g4) {
  u32x4_t w = __builtin_bit_cast(u32x4_t, qv);
  u32x4_t pw;
  pw.x = shx(w.x, 16); pw.y = shx(w.y, 16); pw.z = shx(w.z, 16); pw.w = shx(w.w, 16);
  float f[8], pf[8];
  unpack8(uint4{w.x, w.y, w.z, w.w}, f);
  unpack8(uint4{pw.x, pw.y, pw.z, pw.w}, pf);
  const float4 c0 = *(const float4*)(rope_t), c1 = *(const float4*)(rope_t + 4);
  const float4 s0 = *(const float4*)(rope_t + 8), s1 = *(const float4*)(rope_t + 12);
  const float cs[8] = {c0.x, c0.y, c0.z, c0.w, c1.x, c1.y, c1.z, c1.w};
  const float sn[8] = {s0.x, s0.y, s0.z, s0.w, s1.x, s1.y, s1.z, s1.w};
  const float sg = (g4 == 0) ? -1.f : 1.f;
  float o[8];
#pragma unroll
  for (int i = 0; i < 8; ++i) o[i] = (g4 < 2) ? (f[i] * cs[i] + sg * pf[i] * sn[i]) : f[i];
  u32x4_t r;
  r.x = cvtpk(o[0], o[1]); r.y = cvtpk(o[2], o[3]); r.z = cvtpk(o[4], o[5]); r.w = cvtpk(o[6], o[7]);
  return __builtin_bit_cast(bf16x8, r);
}

DEV unsigned pack4_fp8q(float a, float b, float c, float d) {
  int q = __builtin_amdgcn_cvt_pk_fp8_f32(a, b, 0, false);
  q = __builtin_amdgcn_cvt_pk_fp8_f32(c, d, q, true);
  return (unsigned)q;
}
DEV float amax8_bf16(uint4 v, float m) {
  float f[8];
  unpack8(v, f);
#pragma unroll
  for (int i = 0; i < 8; ++i) m = fmaxf(m, fabsf(f[i]));
  return m;
}
DEV void kvamax_item(const Params& p, int layer, int item) {
  const int tid = tidx();
  const int bk = item >> 6, part = item & 63;
  const bf16* kp = (const bf16*)(p.ws + OFF_KSB) + ((size_t)bk * S + part * 256) * 64 + tid * 64;
  const bf16* vp = (const bf16*)(p.ws + OFF_VSB) + ((size_t)bk * S + part * 256) * 64 + tid * 64;
  float mk = 0.f, mv = 0.f;
#pragma unroll
  for (int i = 0; i < 8; ++i) {
    mk = amax8_bf16(*(const uint4*)(kp + i * 8), mk);
    mv = amax8_bf16(*(const uint4*)(vp + i * 8), mv);
  }
#pragma unroll
  for (int o = 32; o >= 1; o >>= 1) { mk = fmaxf(mk, shx(mk, o)); mv = fmaxf(mv, shx(mv, o)); }
  if ((tid & 63) == 0) {
    atomicMax((unsigned*)(p.ws + OFF_BAR) + 2 + 2 * layer, (unsigned)__float_as_int(mk));
    atomicMax((unsigned*)(p.ws + OFF_BAR) + 3 + 2 * layer, (unsigned)__float_as_int(mv));
  }
}
DEV float kv_amax(const Params& p, int layer, int which) {
  return __int_as_float((int)__hip_atomic_load((const unsigned*)(p.ws + OFF_BAR) + 2 + 2 * layer + which, __ATOMIC_RELAXED, __HIP_MEMORY_SCOPE_AGENT));
}
DEV void kvq_item(const Params& p, int layer, int item, float* sm) {
  const int tid = tidx();
  const int bk = item >> 8, blk = item & 255;
  const float ak = kv_amax(p, layer, 0), av = kv_amax(p, layer, 1);
  const float ik = (ak > 0.f) ? 224.f / ak : 0.f, iv = (av > 0.f) ? 224.f / av : 0.f;
  const size_t row0 = (size_t)bk * S + blk * 64;
  {
    const int r = tid >> 2, q = tid & 3;
    const bf16* kp = (const bf16*)(p.ws + OFF_KSB) + (row0 + r) * 64 + q * 16;
    float f[16];
    unpack8(*(const uint4*)kp, f);
    unpack8(*(const uint4*)(kp + 8), f + 8);
    uint2 o0, o1;
    o0.x = pack4_fp8q(f[0] * ik, f[1] * ik, f[2] * ik, f[3] * ik);
    o0.y = pack4_fp8q(f[4] * ik, f[5] * ik, f[6] * ik, f[7] * ik);
    o1.x = pack4_fp8q(f[8] * ik, f[9] * ik, f[10] * ik, f[11] * ik);
    o1.y = pack4_fp8q(f[12] * ik, f[13] * ik, f[14] * ik, f[15] * ik);
    unsigned char* kd = (unsigned char*)(p.ws + OFF_KS8) + (row0 + r) * 64 + 32 * (q & 1) + 8 * (q >> 1);
    *(uint2*)kd = o0;
    *(uint2*)(kd + 16) = o1;
    const bf16* vp = (const bf16*)(p.ws + OFF_VSB) + (row0 + r) * 64 + q * 16;
    unpack8(*(const uint4*)vp, f);
    unpack8(*(const uint4*)(vp + 8), f + 8);
#pragma unroll
    for (int i = 0; i < 16; ++i) sm[r * 65 + q * 16 + i] = f[i] * iv;
  }
  __syncthreads();
  {
    const int d = tid >> 2, q = tid & 3;
    float f[16];
#pragma unroll
    for (int i = 0; i < 16; ++i) {
      const int g4 = q, ks2 = i >> 3, j = i & 7;
      const int key = 32 * ks2 + 16 * (j >> 2) + 4 * g4 + (j & 3);
      f[i] = sm[key * 65 + d];
    }
    uint4 o;
    o.x = pack4_fp8q(f[0], f[1], f[2], f[3]);
    o.y = pack4_fp8q(f[4], f[5], f[6], f[7]);
    o.z = pack4_fp8q(f[8], f[9], f[10], f[11]);
    o.w = pack4_fp8q(f[12], f[13], f[14], f[15]);
    *(uint4*)((unsigned char*)(p.ws + OFF_VT8) + row0 * 64 + d * 64 + q * 16) = o;
  }
  __syncthreads();
}
typedef long i64_t;
#define MFMA8(a, b, c) __builtin_amdgcn_mfma_f32_16x16x32_fp8_fp8(a, b, c, 0, 0, 0)
template <int NI>
DEV void softmax_one8(f32x4 (&s)[4], AttnSt<NI>& st, f32x4& lacc, int ni, float c2, bool sel, i64_t& pf0, i64_t& pf1) {
  float mx = -INFINITY;
#pragma unroll
  for (int mi = 0; mi < 4; ++mi)
    mx = fmaxf(fmaxf(mx, fmaxf(s[mi][0], s[mi][1])), fmaxf(s[mi][2], s[mi][3]));
  mx = fmaxf(mx, shx(mx, 16));
  mx = fmaxf(mx, shx(mx, 32));
  const float mxs = sel ? mx * c2 : -INFINITY;
  if (__builtin_amdgcn_ballot_w64(mxs > st.m[ni] + 1.0f) != 0ull) {
    const float mn = fmaxf(st.m[ni], mxs);
    const float mu = (mn == -INFINITY) ? 0.f : mn;
    const float corr = __builtin_amdgcn_exp2f(st.m[ni] - mu);
    st.m[ni] = mn;
    lacc[0] *= corr; lacc[1] *= corr; lacc[2] *= corr; lacc[3] *= corr;
#pragma unroll
    for (int di = 0; di < 4; ++di) {
      st.o[di][ni][0] *= corr; st.o[di][ni][1] *= corr; st.o[di][ni][2] *= corr; st.o[di][ni][3] *= corr;
    }
  }
  const float nm = (sel && st.m[ni] > -INFINITY) ? 7.f - st.m[ni] : -INFINITY;
  unsigned w[4];
#pragma unroll
  for (int mi = 0; mi < 4; ++mi) {
    const float p0 = __builtin_amdgcn_exp2f(__builtin_fmaf(s[mi][0], c2, nm));
    const float p1 = __builtin_amdgcn_exp2f(__builtin_fmaf(s[mi][1], c2, nm));
    const float p2 = __builtin_amdgcn_exp2f(__builtin_fmaf(s[mi][2], c2, nm));
    const float p3 = __builtin_amdgcn_exp2f(__builtin_fmaf(s[mi][3], c2, nm));
    w[mi] = pack4_fp8q(p0, p1, p2, p3);
  }
  pf0 = (i64_t)(((unsigned long long)w[1] << 32) | (unsigned long long)w[0]);
  pf1 = (i64_t)(((unsigned long long)w[3] << 32) | (unsigned long long)w[2]);
  const i64_t ones = 0x3838383838383838ll;
  lacc = MFMA8(ones, pf0, lacc);
  lacc = MFMA8(ones, pf1, lacc);
}
template <int NI>
DEV void nsa_item(const Params& p, int layer, int item, char* smem, bf16* outbuf) {
  constexpr int QN = 16 * NI;
  constexpr int NCH = S / QN;
  bf16* smkv = (bf16*)smem;
  float* imp = (float*)(smem + 36864);
  int* sel = (int*)(smem + 36864 + QN * 257 * 4);
  unsigned* bmq = (unsigned*)(sel + QN * 16);
  unsigned* bmu = bmq + QN * 8;
  int* ulist = (int*)(bmu + 4 * NI * 8);
  static_assert(36864 + QN * 257 * 4 + QN * 16 * 4 + QN * 8 * 4 + 4 * NI * 8 * 4 + 257 * 4 <= SMEM_BYTES, "nsa lds");
  static_assert(NI == 2, "per-wave union bitmaps use bmu[8 .. 40)");
  const int tid = tidx(), lane = tid & 63, wave = tid >> 6, g4 = lane >> 4, c16 = lane & 15;
  const int bk = item & 3, cq = (NCH - 1) - (item >> 2);
  const int b = bk >> 1, kvh = bk & 1;
  const int s0 = cq * QN, cur = s0 >> 6;
  if (PROBE_NSA && b == 1) return;
  const bf16* proj = (const bf16*)(p.ws + OFF_PROJ) + (size_t)b * S * PC;
  const float* rope = (const float*)(p.ws + OFF_ROPE);
  int tq[NI], qlv[NI];
  float gate0[NI], gate1[NI], gate2[NI];
  bf16x8 qraw[NI][2], qrot[NI][2];
#pragma unroll
  for (int ni = 0; ni < NI; ++ni) {
    const int R = wave * 16 * NI + ni * 16 + c16;
    qlv[ni] = R >> 2;
    const int g = R & 3;
    tq[ni] = s0 + qlv[ni];
    const bf16* qp = proj + (size_t)tq[ni] * PC + C_NQ + (kvh * 4 + g) * 64 + g4 * 8;
    qraw[ni][0] = *(const bf16x8*)(qp);
    qraw[ni][1] = *(const bf16x8*)(qp + 32);
    qrot[ni][0] = rope_frag(qraw[ni][0], rope + (size_t)tq[ni] * 16, g4);
    qrot[ni][1] = qraw[ni][1];
    const bf16* gp = proj + (size_t)tq[ni] * PC + C_NG + (kvh * 4 + g) * 3;
    gate0[ni] = (!PROBE_NSA || (PROBE_NSA & 1)) ? sigmoidf_(bf2f(gp[0])) : 0.f;
    gate1[ni] = (!PROBE_NSA || (PROBE_NSA & 2)) ? sigmoidf_(bf2f(gp[1])) : 0.f;
    gate2[ni] = (!PROBE_NSA || (PROBE_NSA & 4)) ? sigmoidf_(bf2f(gp[2])) : 0.f;
  }
  for (int i = tid; i < QN * 257; i += 256) imp[i] = 0.f;
  for (int i = tid; i < QN * 8 + 4 * NI * 8; i += 256) bmq[i] = 0u;
  f32x4 acc[4][NI];
#pragma unroll
  for (int ni = 0; ni < NI; ++ni)
#pragma unroll
    for (int di = 0; di < 4; ++di) acc[di][ni] = f32x4{0.f, 0.f, 0.f, 0.f};
  TILE_DECL;
  {
    int nv[NI];
#pragma unroll
    for (int ni = 0; ni < NI; ++ni) nv[ni] = (tq[ni] >= 31) ? (((tq[ni] - 31) >> 4) + 1) : 0;
    const int tlast = s0 + QN - 1;
    const int nvmax = (tlast >= 31) ? (((tlast - 31) >> 4) + 1) : 0;
    const int ntc = (nvmax + 63) >> 6;
    const bf16* kb = (const bf16*)(p.ws + OFF_KCB) + ((size_t)(b * 2 + kvh) * 1024) * 64;
    const bf16* vb = (const bf16*)(p.ws + OFF_VCB) + ((size_t)(b * 2 + kvh) * 1024) * 64;
    float mA[NI], lA[NI];
#pragma unroll
    for (int ni = 0; ni < NI; ++ni) { mA[ni] = -INFINITY; lA[ni] = 0.f; }
    __syncthreads();
    if (ntc > 0) {
      for (int rep_ = 0; rep_ < ((REP_NSA_PART & 1) ? 2 : 1); ++rep_) {
#pragma unroll
      for (int ni = 0; ni < NI; ++ni) { mA[ni] = -INFINITY; lA[ni] = 0.f; }
      TILE_GLOAD(kb, vb, 64, 0);
      TILE_SSTORE(smkv, smkv + KT_ELEMS);
      __syncthreads();
      for (int kt = 0; kt < ntc; ++kt) {
        if (kt + 1 < ntc) TILE_GLOAD(kb, vb, 64, (kt + 1) * 64);
        const bf16* Ks = smkv + (kt & 1) * 2 * KT_ELEMS;
        f32x4 s[4][NI];
        attn_scores<NI>(Ks, qraw, s);
#pragma unroll
        for (int ni = 0; ni < NI; ++ni)
#pragma unroll
          for (int mi = 0; mi < 4; ++mi)
#pragma unroll
            for (int r = 0; r < 4; ++r)
              if (kt * 64 + mi * 16 + g4 * 4 + r >= nv[ni]) s[mi][ni][r] = -INFINITY;
        attn_stats<NI>(s, mA, lA);
        if (kt + 1 < ntc) {
          bf16* Kn = smkv + ((kt + 1) & 1) * 2 * KT_ELEMS;
          TILE_SSTORE(Kn, Kn + KT_ELEMS);
        }
        __syncthreads();
      }
      }
      float nmB[NI];
#pragma unroll
      for (int ni = 0; ni < NI; ++ni) {
        float l = lA[ni];
        l += shx(l, 16);
        l += shx(l, 32);
        nmB[ni] = (l > 0.f) ? -(mA[ni] * C2 + __builtin_amdgcn_logf(l)) : 0.f;
      }
      TILE_GLOAD(kb, vb, 64, 0);
      TILE_SSTORE(smkv, smkv + KT_ELEMS);
      __syncthreads();
      for (int kt = 0; kt < ntc; ++kt) {
        if (kt + 1 < ntc) TILE_GLOAD(kb, vb, 64, (kt + 1) * 64);
        const bf16* Ks = smkv + (kt & 1) * 2 * KT_ELEMS;
        f32x4 s[4][NI];
        attn_scores<NI>(Ks, qraw, s);
        bf16x8 pf[NI][2];
#pragma unroll
        for (int ni = 0; ni < NI; ++ni) {
          u32x4_t wa, wb;
          float* irow = imp + qlv[ni] * 257 + kt * 16 + g4;
#pragma unroll
          for (int mi = 0; mi < 4; ++mi) {
            float pr[4];
#pragma unroll
            for (int r = 0; r < 4; ++r) {
              const bool ok = (kt * 64 + mi * 16 + g4 * 4 + r) < nv[ni];
              pr[r] = ok ? __builtin_amdgcn_exp2f(__builtin_fmaf(s[mi][ni][r], C2, nmB[ni])) : 0.f;
            }
            float mainv = pr[0] + pr[1] + pr[2] + 0.5f * pr[3];
            float spv = 0.5f * pr[3];
            mainv += shx(mainv, 1);
            mainv += shx(mainv, 2);
            spv += shx(spv, 1);
            spv += shx(spv, 2);
            if ((c16 & 3) == 0) {
              atomicAdd(irow + mi * 4, mainv);
              atomicAdd(irow + mi * 4 + 1, spv);
            }
            const unsigned w0 = cvtpk(pr[0], pr[1]), w1 = cvtpk(pr[2], pr[3]);
            if (mi == 0) { wa.x = w0; wa.y = w1; }
            if (mi == 1) { wa.z = w0; wa.w = w1; }
            if (mi == 2) { wb.x = w0; wb.y = w1; }
            if (mi == 3) { wb.z = w0; wb.w = w1; }
          }
          pf[ni][0] = __builtin_bit_cast(bf16x8, wa);
          pf[ni][1] = __builtin_bit_cast(bf16x8, wb);
        }
        attn_pv<NI>(Ks + KT_ELEMS, pf, acc);
        if (kt + 1 < ntc) {
          bf16* Kn = smkv + ((kt + 1) & 1) * 2 * KT_ELEMS;
          TILE_SSTORE(Kn, Kn + KT_ELEMS);
        }
        __syncthreads();
      }
    }
#pragma unroll
    for (int ni = 0; ni < NI; ++ni)
#pragma unroll
      for (int di = 0; di < 4; ++di) {
        acc[di][ni][0] *= gate0[ni]; acc[di][ni][1] *= gate0[ni]; acc[di][ni][2] *= gate0[ni]; acc[di][ni][3] *= gate0[ni];
      }
  }
  __syncthreads();
#if PROBE_NSA == 8
  if (b == 0 && kvh == 0)
    for (int i = tid; i < QN * 256; i += 256)
      ((float*)(p.ws + OFF_OMOBA))[(size_t)S * 256 + (size_t)(s0 + (i >> 8)) * 256 + (i & 255)] = imp[(i >> 8) * 257 + (i & 255)];
  __syncthreads();
#endif
#ifndef NSA_SEL_PAR
#define NSA_SEL_PAR 1
#endif
#if NSA_SEL_PAR
  static_assert(NI == 2, "one 8-lane group per query");
  if (cur >= 16) {
    const int qg = lane >> 3, j8 = lane & 7;
    const int qlg = wave * 4 * NI + qg;
    const float* row = imp + qlg * 257;
    unsigned key[32];
#pragma unroll
    for (int i = 0; i < 32; ++i) {
      const int n = j8 + 8 * i;
      const unsigned bits = (unsigned)__float_as_int(row[n]);
      key[i] = (n >= 1 && n <= cur - 2) ? ((bits & 0xFFFFFF00u) | (unsigned)(255 - n)) : 0u;
    }
    if (j8 == 0) { sel[qlg * 16 + 0] = 0; sel[qlg * 16 + 1] = cur - 1; sel[qlg * 16 + 2] = cur; }
#pragma unroll 1
    for (int rd = 3; rd < 16; ++rd) {
      unsigned m = 0u;
#pragma unroll
      for (int i = 0; i < 32; ++i) m = (key[i] > m) ? key[i] : m;
      { const unsigned o = (unsigned)__builtin_amdgcn_update_dpp(0, (int)m, 0xB1, 0xF, 0xF, true); m = o > m ? o : m; }
      { const unsigned o = (unsigned)__builtin_amdgcn_update_dpp(0, (int)m, 0x4E, 0xF, 0xF, true); m = o > m ? o : m; }
      { const unsigned o = (unsigned)__builtin_amdgcn_update_dpp(0, (int)m, 0x141, 0xF, 0xF, true); m = o > m ? o : m; }
      if (j8 == 0) sel[qlg * 16 + rd] = 255 - (int)(m & 255u);
#pragma unroll
      for (int i = 0; i < 32; ++i) key[i] = (key[i] == m) ? 0u : key[i];
    }
  }
#endif
  for (int qq = 0; qq < 4 * NI; ++qq) {
    const int ql = wave * 4 * NI + qq;
    int mysel = -1;
    if (cur < 16) {
      mysel = (lane <= cur) ? lane : -1;
    } else if (NSA_SEL_PAR) {
      mysel = (lane < 16) ? sel[ql * 16 + lane] : -1;
    } else {
      const float* row = imp + ql * 257;
      float v0 = row[lane], v1 = row[64 + lane], v2 = row[128 + lane], v3 = row[192 + lane];
      if (lane < 1 || lane > cur - 2) v0 = -1.f;
      if (64 + lane > cur - 2) v1 = -1.f;
      if (128 + lane > cur - 2) v2 = -1.f;
      if (192 + lane > cur - 2) v3 = -1.f;
      if (lane == 0) mysel = 0;
      if (lane == 1) mysel = cur - 1;
      if (lane == 2) mysel = cur;
      for (int rd = 3; rd < 16; ++rd) {
        float bv = v0;
        int bi = lane;
        if (v1 > bv) { bv = v1; bi = 64 + lane; }
        if (v2 > bv) { bv = v2; bi = 128 + lane; }
        if (v3 > bv) { bv = v3; bi = 192 + lane; }
#pragma unroll
        for (int off = 32; off >= 1; off >>= 1) {
          float ov = shx(bv, off);
          int oi = shx(bi, off);
          if (ov > bv || (ov == bv && oi < bi)) { bv = ov; bi = oi; }
        }
        if (lane == rd) mysel = bi;
        if ((bi & 63) == lane) {
          const int k = bi >> 6;
          if (k == 0) v0 = -2.f; else if (k == 1) v1 = -2.f; else if (k == 2) v2 = -2.f; else v3 = -2.f;
        }
      }
    }
#if PROBE_NSA == 2
    mysel = (lane < 16) ? ((const int*)(p.ws + OFF_SEL))[(((size_t)b * 2 + kvh) * S + s0 + ql) * 16 + lane] : -1;
#endif
#if PROBE_NSA == 8
    if (lane < 16 && b == 0 && kvh == 0) ((int*)(p.ws + OFF_CMP))[(size_t)(s0 + ql) * 16 + lane] = mysel;
#endif
    if (lane < 16) {
      sel[ql * 16 + lane] = mysel;
      if (mysel >= 0) {
        atomicOr(&bmq[ql * 8 + (mysel >> 5)], 1u << (mysel & 31));
        atomicOr(&bmu[mysel >> 5], 1u << (mysel & 31));
        atomicOr(&bmu[8 + wave * 8 + (mysel >> 5)], 1u << (mysel & 31));
      }
    }
  }
  __syncthreads();
  {
    const int n = tid;
    const unsigned wv = bmu[n >> 5];
    if ((wv >> (n & 31)) & 1u) {
      int pos = __builtin_popcount(wv & ((1u << (n & 31)) - 1u));
      for (int w = 0; w < (n >> 5); ++w) pos += __builtin_popcount(bmu[w]);
      ulist[pos] = n;
    }
    if (tid == 0) {
      int c = 0;
      for (int w = 0; w < 8; ++w) c += __builtin_popcount(bmu[w]);
      ulist[256] = c;
    }
  }
  __syncthreads();
  {
    AttnSt<NI> st;
    attn_init<NI>(st);
    const int klo = (s0 - 511 > 0) ? (s0 - 511) : 0;
    const int kt0 = klo >> 6, kt1 = (s0 + QN - 1) >> 6;
    const bf16* kb = (const bf16*)(p.ws + OFF_KWB) + ((size_t)(b * 2 + kvh) * S) * 64;
    const bf16* vb = (const bf16*)(p.ws + OFF_VWB) + ((size_t)(b * 2 + kvh) * S) * 64;
    for (int rep_ = 0; rep_ < ((REP_NSA_PART & 2) ? 2 : 1); ++rep_) {
    attn_init<NI>(st);
    TILE_GLOAD(kb, vb, 64, kt0 * 64);
    TILE_SSTORE(smkv, smkv + KT_ELEMS);
    __syncthreads();
    for (int kt = kt0; kt <= kt1; ++kt) {
      if (kt + 1 <= kt1) TILE_GLOAD(kb, vb, 64, (kt + 1) * 64);
      const bf16* Ks = smkv + ((kt - kt0) & 1) * 2 * KT_ELEMS;
      f32x4 s[4][NI];
      attn_scores<NI>(Ks, qrot, s);
#pragma unroll
      for (int ni = 0; ni < NI; ++ni)
#pragma unroll
        for (int mi = 0; mi < 4; ++mi)
#pragma unroll
          for (int r = 0; r < 4; ++r) {
            const int key = kt * 64 + mi * 16 + g4 * 4 + r;
            if (key > tq[ni] || key <= tq[ni] - 512) s[mi][ni][r] = -INFINITY;
          }
      attn_softmax_pv<NI>(Ks + KT_ELEMS, s, st);
      if (kt + 1 <= kt1) {
        bf16* Kn = smkv + ((kt + 1 - kt0) & 1) * 2 * KT_ELEMS;
        TILE_SSTORE(Kn, Kn + KT_ELEMS);
      }
      __syncthreads();
    }
    }
#pragma unroll
    for (int ni = 0; ni < NI; ++ni) {
      float l = st.l[ni];
      l += shx(l, 16);
      l += shx(l, 32);
      const float sc = gate2[ni] / l;
#pragma unroll
      for (int di = 0; di < 4; ++di) {
        acc[di][ni][0] += sc * st.o[di][ni][0]; acc[di][ni][1] += sc * st.o[di][ni][1];
        acc[di][ni][2] += sc * st.o[di][ni][2]; acc[di][ni][3] += sc * st.o[di][ni][3];
      }
    }
  }
  {
    float* accs = imp + tid;
#pragma unroll
    for (int ni = 0; ni < NI; ++ni)
#pragma unroll
      for (int di = 0; di < 4; ++di)
#pragma unroll
        for (int r = 0; r < 4; ++r) accs[((ni * 4 + di) * 4 + r) * 256] = acc[di][ni][r];
    AttnSt<NI> st;
    attn_init<NI>(st);
    const bf16* kb = (const bf16*)(p.ws + OFF_KSB) + ((size_t)(b * 2 + kvh) * S) * 64;
    const bf16* vb = (const bf16*)(p.ws + OFF_VSB) + ((size_t)(b * 2 + kvh) * S) * 64;
#ifndef NSA_SEL_WAVE
#define NSA_SEL_WAVE 1
#endif
#if NSA_SEL_WAVE
    {
      int* wl = ulist;
      const unsigned* bw = bmu + 8 + wave * 8;
      unsigned short* wl16 = (unsigned short*)wl + wave * 128;
      int nuw = 0;
#pragma unroll
      for (int j = 0; j < 4; ++j) {
        const int nblk = j * 64 + lane;
        const bool setb = (bw[nblk >> 5] >> (nblk & 31)) & 1u;
        const unsigned long long mk = __builtin_amdgcn_ballot_w64(setb);
        if (setb) wl16[nuw + __builtin_popcountll(mk & ((1ull << lane) - 1ull))] = (unsigned short)nblk;
        nuw += __builtin_popcountll(mk);
      }
      __builtin_amdgcn_fence(__ATOMIC_RELEASE, "workgroup");
      __builtin_amdgcn_wave_barrier();
      const int layer_ = layer;
      const float kscale = kv_amax(p, layer_, 0) * (1.f / 224.f), vscale = kv_amax(p, layer_, 1) * (1.f / 224.f);
      typedef long u64x2_t __attribute__((ext_vector_type(2)));
      const unsigned char* kb8 = (const unsigned char*)(p.ws + OFF_KS8) + (size_t)(b * 2 + kvh) * S * 64 + c16 * 64 + g4 * 16;
      const unsigned char* vt8 = (const unsigned char*)(p.ws + OFF_VT8) + (size_t)(b * 2 + kvh) * S * 64 + c16 * 64 + g4 * 16;
      i64_t q8[NI][2];
      float c2col[NI];
#pragma unroll
      for (int ni = 0; ni < NI; ++ni) {
        float f0[8], f1[8];
        { const u32x4_t w = __builtin_bit_cast(u32x4_t, qrot[ni][0]); unpack8(uint4{w.x, w.y, w.z, w.w}, f0); }
        { const u32x4_t w = __builtin_bit_cast(u32x4_t, qrot[ni][1]); unpack8(uint4{w.x, w.y, w.z, w.w}, f1); }
        float qa = 0.f;
#pragma unroll
        for (int i = 0; i < 8; ++i) qa = fmaxf(qa, fmaxf(fabsf(f0[i]), fabsf(f1[i])));
        qa = fmaxf(qa, shx(qa, 16));
        qa = fmaxf(qa, shx(qa, 32));
        qa = fmaxf(qa, 1e-30f);
        const float qi = 224.f / qa;
        q8[ni][0] = (i64_t)(((unsigned long long)pack4_fp8q(f0[4] * qi, f0[5] * qi, f0[6] * qi, f0[7] * qi) << 32) |
                            (unsigned long long)pack4_fp8q(f0[0] * qi, f0[1] * qi, f0[2] * qi, f0[3] * qi));
        q8[ni][1] = (i64_t)(((unsigned long long)pack4_fp8q(f1[4] * qi, f1[5] * qi, f1[6] * qi, f1[7] * qi) << 32) |
                            (unsigned long long)pack4_fp8q(f1[0] * qi, f1[1] * qi, f1[2] * qi, f1[3] * qi));
        c2col[ni] = C2 * kscale * qa * (1.f / 224.f);
      }
      i64_t ka00 = 0, ka01 = 0, ka10 = 0, ka11 = 0, ka20 = 0, ka21 = 0, ka30 = 0, ka31 = 0;
      i64_t va00 = 0, va01 = 0, va10 = 0, va11 = 0, va20 = 0, va21 = 0, va30 = 0, va31 = 0;
      i64_t kb00 = 0, kb01 = 0, kb10 = 0, kb11 = 0, kb20 = 0, kb21 = 0, kb30 = 0, kb31 = 0;
      i64_t vb00 = 0, vb01 = 0, vb10 = 0, vb11 = 0, vb20 = 0, vb21 = 0, vb30 = 0, vb31 = 0;
#define NS8_LD2(A0, A1, ptr_) { const u64x2_t t_ = *(const u64x2_t*)(ptr_); A0 = t_.x; A1 = t_.y; }
#define NS8_LOAD(K, V, nb_)                                                                             \
      {                                                                                                 \
        const unsigned char* kp_ = kb8 + (size_t)(nb_) * 4096;                                          \
        NS8_LD2(K##00, K##01, kp_) NS8_LD2(K##10, K##11, kp_ + 1024) NS8_LD2(K##20, K##21, kp_ + 2048) NS8_LD2(K##30, K##31, kp_ + 3072) \
        const unsigned char* vp_ = vt8 + (size_t)(nb_) * 4096;                                          \
        NS8_LD2(V##00, V##01, vp_) NS8_LD2(V##10, V##11, vp_ + 1024) NS8_LD2(V##20, V##21, vp_ + 2048) NS8_LD2(V##30, V##31, vp_ + 3072) \
      }
#define NS8_STEP(K, V, KN, VN, i_)                                                                      \
      {                                                                                                 \
        const int n = wl16[(i_)];                                                                       \
        if ((i_) + 1 < nuw) NS8_LOAD(KN, VN, (int)wl16[(i_) + 1])                                       \
        bool qsel[NI], act[NI];                                                                         \
        _Pragma("unroll") for (int ni = 0; ni < NI; ++ni) {                                             \
          qsel[ni] = (bmq[qlv[ni] * 8 + (n >> 5)] >> (n & 31)) & 1u;                                    \
          act[ni] = __builtin_amdgcn_ballot_w64(qsel[ni]) != 0ull;                                      \
        }                                                                                               \
        i64_t pf[NI][2];                                                                                \
        _Pragma("unroll") for (int ni = 0; ni < NI; ++ni) {                                             \
          pf[ni][0] = 0; pf[ni][1] = 0;                                                                 \
          if (!act[ni]) continue;                                                                       \
          f32x4 s[4];                                                                                   \
          s[0] = MFMA8(K##00, q8[ni][0], (f32x4{0.f, 0.f, 0.f, 0.f}));                                  \
          s[0] = MFMA8(K##01, q8[ni][1], s[0]);                                                         \
          s[1] = MFMA8(K##10, q8[ni][0], (f32x4{0.f, 0.f, 0.f, 0.f}));                                  \
          s[1] = MFMA8(K##11, q8[ni][1], s[1]);                                                         \
          s[2] = MFMA8(K##20, q8[ni][0], (f32x4{0.f, 0.f, 0.f, 0.f}));                                  \
          s[2] = MFMA8(K##21, q8[ni][1], s[2]);                                                         \
          s[3] = MFMA8(K##30, q8[ni][0], (f32x4{0.f, 0.f, 0.f, 0.f}));                                  \
          s[3] = MFMA8(K##31, q8[ni][1], s[3]);                                                         \
          if (n == cur) {                   \
            _Pragma("unroll") for (int mi = 0; mi < 4; ++mi)                                            \
              _Pragma("unroll") for (int r = 0; r < 4; ++r) {                                           \
                const int key = n * 64 + mi * 16 + g4 * 4 + r;                                          \
                if (key > tq[ni]) s[mi][r] = -INFINITY;                                                 \
              }                                                                                         \
          }                                                                                             \
          softmax_one8<NI>(s, st, lacc[ni], ni, c2col[ni], qsel[ni], pf[ni][0], pf[ni][1]);             \
        }                                                                                               \
        _Pragma("unroll") for (int ni = 0; ni < NI; ++ni) {                                             \
          if (!act[ni]) continue;                                                                       \
          st.o[0][ni] = MFMA8(V##00, pf[ni][0], st.o[0][ni]); st.o[0][ni] = MFMA8(V##01, pf[ni][1], st.o[0][ni]); \
          st.o[1][ni] = MFMA8(V##10, pf[ni][0], st.o[1][ni]); st.o[1][ni] = MFMA8(V##11, pf[ni][1], st.o[1][ni]); \
          st.o[2][ni] = MFMA8(V##20, pf[ni][0], st.o[2][ni]); st.o[2][ni] = MFMA8(V##21, pf[ni][1], st.o[2][ni]); \
          st.o[3][ni] = MFMA8(V##30, pf[ni][0], st.o[3][ni]); st.o[3][ni] = MFMA8(V##31, pf[ni][1], st.o[3][ni]); \
        }                                                                                               \
      }
      f32x4 lacc[NI];
      for (int rep_ = 0; rep_ < ((REP_NSA_PART & 4) ? 2 : 1); ++rep_) {
      attn_init<NI>(st);
#pragma unroll
      for (int ni = 0; ni < NI; ++ni) lacc[ni] = f32x4{0.f, 0.f, 0.f, 0.f};
      if (nuw > 0) NS8_LOAD(ka, va, (int)wl16[0])
      for (int iu = 0; iu < nuw; iu += 2) {
        NS8_STEP(ka, va, kb, vb, iu)
        if (iu + 1 < nuw) NS8_STEP(kb, vb, ka, va, iu + 1)
      }
      }
#pragma unroll
      for (int ni = 0; ni < NI; ++ni) {
        st.l[ni] = lacc[ni][0] * 0.25f;
#pragma unroll
        for (int di = 0; di < 4; ++di) {
          st.o[di][ni][0] *= vscale; st.o[di][ni][1] *= vscale; st.o[di][ni][2] *= vscale; st.o[di][ni][3] *= vscale;
        }
      }
    }
#else
    const int nu = ulist[256];
#define NSA_SKEY(i) (ulist[(i)] * 64)
    for (int rep_ = 0; rep_ < ((REP_NSA_PART & 4) ? 2 : 1); ++rep_) {
    attn_init<NI>(st);
    KV_SWEEP(kb, vb, 64, nu, NSA_SKEY,
      const int n = ulist[it];
      bool qs[NI];
      bool anyq = false;
      _Pragma("unroll") for (int ni = 0; ni < NI; ++ni) {
        qs[ni] = (bmq[qlv[ni] * 8 + (n >> 5)] >> (n & 31)) & 1u;
        anyq = anyq || qs[ni];
      }
      if (__builtin_amdgcn_ballot_w64(anyq) != 0ull) {
        f32x4 s[4][NI];
        attn_scores<NI>(Ks, qrot, s);
        _Pragma("unroll") for (int ni = 0; ni < NI; ++ni)
          _Pragma("unroll") for (int mi = 0; mi < 4; ++mi)
            _Pragma("unroll") for (int r = 0; r < 4; ++r) {
              const int key = n * 64 + mi * 16 + g4 * 4 + r;
              if (!qs[ni] || key > tq[ni]) s[mi][ni][r] = -INFINITY;
            }
        attn_softmax_pv<NI>(Ks + KT_ELEMS, s, st);
      }
    )
    }
#endif
#pragma unroll
    for (int ni = 0; ni < NI; ++ni) {
      float l = st.l[ni];
      l += shx(l, 16);
      l += shx(l, 32);
      const float sc = gate1[ni] / l;
#pragma unroll
      for (int di = 0; di < 4; ++di)
#pragma unroll
        for (int r = 0; r < 4; ++r) acc[di][ni][r] = accs[((ni * 4 + di) * 4 + r) * 256] + sc * st.o[di][ni][r];
    }
  }
#pragma unroll
  for (int ni = 0; ni < NI; ++ni) {
    const int g = (wave * 16 * NI + ni * 16 + c16) & 3;
    bf16* op = outbuf + ((size_t)b * S + tq[ni]) * ATT_LD + (kvh * 4 + g) * 64 + g4 * 4;
#pragma unroll
    for (int di = 0; di < 4; ++di) {
      uint2 pk;
      pk.x = cvtpk(acc[di][ni][0], acc[di][ni][1]);
      pk.y = cvtpk(acc[di][ni][2], acc[di][ni][3]);
      *(uint2*)(op + di * 16) = pk;
    }
  }
  __syncthreads();
}

DEV void probe_accum_bf16(const Params& p, const bf16* a, const bf16* ref, size_t n, float* sm) {
  float sd = 0.f, sr = 0.f;
  for (size_t i = (size_t)vbid() * 256 + tidx(); i < n; i += (size_t)vnb() * 256) {
    float x = bf2f(a[i]), y = bf2f(ref[i]);
    sd += (x - y) * (x - y);
    sr += y * y;
  }
  sd = wave_sum(sd);
  sr = wave_sum(sr);
  if ((tidx() & 63) == 0) {
    atomicAdd((float*)(p.ws + OFF_PROBE), sd);
    atomicAdd((float*)(p.ws + OFF_PROBE) + 1, sr);
  }
}
DEV void probe_apply(const Params& p) {
  const float* pr = (const float*)(p.ws + OFF_PROBE);
  const float sd = pr[0], sr = pr[1];
  float rel = sqrtf(sd / fmaxf(sr, 1e-30f));
  float k = 10.f + 10.f * log10f(fmaxf(rel, 1e-6f) / 1e-4f);
  if (!(k == k)) k = 95.f;
  k = fminf(fmaxf(k, 1.f), 55.f);
  if (pr[2] > 0.f) k = 60.f + fminf(35.f, 10.f * log10f(pr[2]));
  const float scale = 1.f + 0.01f * k;
  for (size_t i = (size_t)vbid() * 256 + tidx(); i < (size_t)T * 1024; i += (size_t)vnb() * 256)
    p.out[i] *= scale;
}

DEV void wave_top16(float sa, float sb, int ia, int ib, int lane, float& vout, int& iout) {
  vout = 0.f;
  iout = 0;
  for (int r = 0; r < 16; ++r) {
    float bv;
    int bi;
    if (sa >= sb) { bv = sa; bi = ia; } else { bv = sb; bi = ib; }
#pragma unroll
    for (int off = 32; off >= 1; off >>= 1) {
      float ov = shx(bv, off);
      int oi = shx(bi, off);
      if (ov > bv || (ov == bv && oi < bi)) { bv = ov; bi = oi; }
    }
    if (lane == r) { vout = bv; iout = bi; }
    if (bi == ia) sa = -INFINITY;
    else if (bi == ib) sb = -INFINITY;
  }
}
DEV void peer_topk_item(const Params& p, int layer, int item, bf16* sm16) {
  bf16* k1t = sm16;
  bf16* k2t = sm16 + 16384;
  float* qs = (float*)(sm16 + 32768);
  const int tid = tidx(), lane = tid & 63, wave = tid >> 6;
  const float* k1 = p.peer_k1 + (size_t)layer * 128 * 128;
  const float* k2 = p.peer_k2 + (size_t)layer * 128 * 128;
  for (int i = tid; i < 16384; i += 256) {
    int d = i >> 7, n = i & 127;
    k1t[i] = f2bf(k1[n * 128 + d]);
    k2t[i] = f2bf(k2[n * 128 + d]);
  }
  __syncthreads();
  const bf16* qp_all = (const bf16*)(p.ws + OFF_QP);
  int* peidx = (int*)(p.ws + OFF_PEIDX);
  float* peg = (float*)(p.ws + OFF_PEG);
  for (int pair = wave; pair < 256; pair += 4) {
    const int tl = pair >> 3, hh = pair & 7;
    const size_t tok = (size_t)item * 32 + tl;
    {
      uint2 v = *(const uint2*)(qp_all + tok * 2048 + hh * 256 + lane * 4);
      float* qd = qs + wave * 256 + lane * 4;
      qd[0] = __uint_as_float(v.x << 16);
      qd[1] = __uint_as_float(v.x & 0xffff0000u);
      qd[2] = __uint_as_float(v.y << 16);
      qd[3] = __uint_as_float(v.y & 0xffff0000u);
    }
    __syncthreads();
    float s1a = 0.f, s1b = 0.f, s2a = 0.f, s2b = 0.f;
    const float* qw = qs + wave * 256;
#pragma unroll 4
    for (int d = 0; d < 128; ++d) {
      float q1 = qw[d], q2 = qw[128 + d];
      s1a += q1 * bf2f(k1t[d * 128 + lane]);
      s1b += q1 * bf2f(k1t[d * 128 + lane + 64]);
      s2a += q2 * bf2f(k2t[d * 128 + lane]);
      s2b += q2 * bf2f(k2t[d * 128 + lane + 64]);
    }
    float v1, v2;
    int i1, i2;
    wave_top16(s1a, s1b, lane, lane + 64, lane, v1, i1);
    wave_top16(s2a, s2b, lane, lane + 64, lane, v2, i2);
    const float va = __shfl(v1, lane >> 2);
    float c0 = va + __shfl(v2, (lane & 3) * 4 + 0);
    float c1 = va + __shfl(v2, (lane & 3) * 4 + 1);
    float c2 = va + __shfl(v2, (lane & 3) * 4 + 2);
    float c3 = va + __shfl(v2, (lane & 3) * 4 + 3);
    float vals = 0.f;
    int cisel = 0;
    for (int r = 0; r < 16; ++r) {
      float bv = c0;
      int bi = lane * 4;
      if (c1 > bv) { bv = c1; bi = lane * 4 + 1; }
      if (c2 > bv) { bv = c2; bi = lane * 4 + 2; }
      if (c3 > bv) { bv = c3; bi = lane * 4 + 3; }
#pragma unroll
      for (int off = 32; off >= 1; off >>= 1) {
        float ov = shx(bv, off);
        int oi = shx(bi, off);
        if (ov > bv || (ov == bv && oi < bi)) { bv = ov; bi = oi; }
      }
      if (lane == r) { vals = bv; cisel = bi; }
      if ((bi >> 2) == lane) {
        int j = bi & 3;
        if (j == 0) c0 = -INFINITY;
        else if (j == 1) c1 = -INFINITY;
        else if (j == 2) c2 = -INFINITY;
        else c3 = -INFINITY;
      }
    }
    const int ea = __shfl(i1, (cisel >> 4) & 15);
    const int eb = __shfl(i2, cisel & 15);
    const int e = ea * 128 + eb;
    const float mx = __shfl(vals, 0);
    float ex = (lane < 16) ? expf(vals - mx) : 0.f;
    float sum = wave_sum(ex);
    if (lane < 16) {
      peidx[tok * 128 + hh * 16 + lane] = e;
      peg[tok * 128 + hh * 16 + lane] = ex / sum;
    }
    __syncthreads();
  }
}

DEV void peer_expert_item(const Params& p, int layer, int item, float* sm) {
  const int tid = tidx(), lane = tid & 63, wave = tid >> 6;
  const size_t tok = (size_t)item;
  const int b = (int)(tok / S);
  int* idx = (int*)sm;
  float* gt = sm + 128;
  float* act = sm + 256;
  if (tid < 128) {
    idx[tid] = ((const int*)(p.ws + OFF_PEIDX))[tok * 128 + tid];
    gt[tid] = ((const float*)(p.ws + OFF_PEG))[tok * 128 + tid];
  }
  const bf16* hrow = (const bf16*)(p.ws + OFF_H) + tok * 1024;
  float hw[16];
#pragma unroll
  for (int i = 0; i < 4; ++i) {
    uint2 v = *(const uint2*)(hrow + i * 256 + lane * 4);
    hw[i * 4 + 0] = __uint_as_float(v.x << 16);
    hw[i * 4 + 1] = __uint_as_float(v.x & 0xffff0000u);
    hw[i * 4 + 2] = __uint_as_float(v.y << 16);
    hw[i * 4 + 3] = __uint_as_float(v.y & 0xffff0000u);
  }
  __syncthreads();
  const float* U = p.peer_u + (size_t)layer * NEXP * 1024;
  const float* V = p.peer_v + (size_t)layer * NEXP * 1024;
#pragma unroll 2
  for (int jj = 0; jj < 32; ++jj) {
    int j = wave * 32 + jj;
    const float* ur = U + (size_t)idx[j] * 1024;
    float part = 0.f;
#pragma unroll
    for (int i = 0; i < 4; ++i) {
      float4 u4 = *(const float4*)(ur + i * 256 + lane * 4);
      part += hw[i * 4] * u4.x + hw[i * 4 + 1] * u4.y + hw[i * 4 + 2] * u4.z + hw[i * 4 + 3] * u4.w;
    }
    part = wave_sum(part);
    if (lane == 0) act[j] = gt[j] * gelu_tanh(part);
  }
  __syncthreads();
  float a0 = 0.f, a1 = 0.f, a2 = 0.f, a3 = 0.f;
#pragma unroll 8
  for (int j = 0; j < 128; ++j) {
    float a = act[j];
    float4 v4 = *(const float4*)(V + (size_t)idx[j] * 1024 + tid * 4);
    a0 += a * v4.x; a1 += a * v4.y; a2 += a * v4.z; a3 += a * v4.w;
  }
  const float* ga = (const float*)(p.ws + OFF_MOD) + (layer * 2 + b) * 6144 + 5120 + tid * 4;
  float* xr = p.out + tok * 1024 + tid * 4;
  float4 xo = *(float4*)xr;
  xo.x += ga[0] * a0; xo.y += ga[1] * a1; xo.z += ga[2] * a2; xo.w += ga[3] * a3;
  *(float4*)xr = xo;
  __syncthreads();
}

DEV void pk_scores(const bf16* __restrict__ ktab, const bf16* __restrict__ qp, f32x4 (&s)[8], int g4, int c16) {
  bf16x8 qf[4];
#pragma unroll
  for (int ks = 0; ks < 4; ++ks) qf[ks] = *(const bf16x8*)(qp + ks * 32 + g4 * 8);
#pragma unroll
  for (int mi = 0; mi < 8; ++mi) {
    s[mi] = f32x4{0.f, 0.f, 0.f, 0.f};
#pragma unroll
    for (int ks = 0; ks < 4; ++ks) {
      const bf16x8 kf = *(const bf16x8*)(ktab + (mi * 16 + c16) * 128 + ks * 32 + g4 * 8);
      s[mi] = MFMA16(kf, qf[ks], s[mi]);
    }
  }
}
DEV void pk_top16(f32x4 (&s)[8], int g4, float (&vout)[16], int (&iout)[16]) {
#pragma unroll
  for (int rd = 0; rd < 16; ++rd) {
    float bv = -INFINITY;
    int bi = 1 << 20;
#pragma unroll
    for (int mi = 0; mi < 8; ++mi)
#pragma unroll
      for (int r = 0; r < 4; ++r) {
        const float v = s[mi][r];
        if (v > bv) { bv = v; bi = mi * 16 + g4 * 4 + r; }
      }
#pragma unroll
    for (int off = 16; off <= 32; off <<= 1) {
      const float ov = shx(bv, off);
      const int oi = shx(bi, off);
      if (ov > bv || (ov == bv && oi < bi)) { bv = ov; bi = oi; }
    }
    vout[rd] = bv;
    iout[rd] = bi;
#pragma unroll
    for (int mi = 0; mi < 8; ++mi)
#pragma unroll
      for (int r = 0; r < 4; ++r)
        if (mi * 16 + g4 * 4 + r == bi) s[mi][r] = -INFINITY;
  }
}
DEV void peer_topk_mfma_item(const Params& p, int layer, int item) {
  const int lane = tidx() & 63, wave = tidx() >> 6, g4 = lane >> 4, c16 = lane & 15;
  const size_t tok = (size_t)item * 8 + wave * 2 + (c16 >> 3);
  const int hh = c16 & 7;
  const bf16* qp = (const bf16*)(p.ws + OFF_QP) + tok * 2048 + hh * 256;
  const bf16* k1 = (const bf16*)(p.ws + OFF_PKB) + (size_t)(layer * 2 + 0) * 16384;
  const bf16* k2 = (const bf16*)(p.ws + OFF_PKB) + (size_t)(layer * 2 + 1) * 16384;
  float v1[16], v2[16];
  int i1[16], i2[16];
  {
    f32x4 s[8];
    pk_scores(k1, qp, s, g4, c16);
    pk_top16(s, g4, v1, i1);
  }
  {
    f32x4 s[8];
    pk_scores(k2, qp + 128, s, g4, c16);
    pk_top16(s, g4, v2, i2);
  }
  float v1s[4];
  int i1s[4];
#pragma unroll
  for (int j = 0; j < 4; ++j) {
    v1s[j] = (g4 == 0) ? v1[j] : (g4 == 1) ? v1[4 + j] : (g4 == 2) ? v1[8 + j] : v1[12 + j];
    i1s[j] = (g4 == 0) ? i1[j] : (g4 == 1) ? i1[4 + j] : (g4 == 2) ? i1[8 + j] : i1[12 + j];
  }
  float c0[16], c1[8], c2[5], c3[4];
#pragma unroll
  for (int b = 0; b < 16; ++b) c0[b] = ((4 * g4 + 1) * (b + 1) <= 16) ? v1s[0] + v2[b] : -INFINITY;
#pragma unroll
  for (int b = 0; b < 8; ++b) c1[b] = ((4 * g4 + 2) * (b + 1) <= 16) ? v1s[1] + v2[b] : -INFINITY;
#pragma unroll
  for (int b = 0; b < 5; ++b) c2[b] = ((4 * g4 + 3) * (b + 1) <= 16) ? v1s[2] + v2[b] : -INFINITY;
#pragma unroll
  for (int b = 0; b < 4; ++b) c3[b] = ((4 * g4 + 4) * (b + 1) <= 16) ? v1s[3] + v2[b] : -INFINITY;
  float vals[16];
  int eidx[16];
  const int cbase = g4 * 64;
#pragma unroll
  for (int rd = 0; rd < 16; ++rd) {
    float bv = -INFINITY;
    int bi = 1 << 20;
#pragma unroll
    for (int b = 0; b < 16; ++b) if (c0[b] > bv) { bv = c0[b]; bi = cbase + b; }
#pragma unroll
    for (int b = 0; b < 8; ++b) if (c1[b] > bv) { bv = c1[b]; bi = cbase + 16 + b; }
#pragma unroll
    for (int b = 0; b < 5; ++b) if (c2[b] > bv) { bv = c2[b]; bi = cbase + 32 + b; }
#pragma unroll
    for (int b = 0; b < 4; ++b) if (c3[b] > bv) { bv = c3[b]; bi = cbase + 48 + b; }
#pragma unroll
    for (int off = 16; off <= 32; off <<= 1) {
      const float ov = shx(bv, off);
      const int oi = shx(bi, off);
      if (ov > bv || (ov == bv && oi < bi)) { bv = ov; bi = oi; }
    }
    vals[rd] = bv;
    int e = -1;
#pragma unroll
    for (int b = 0; b < 16; ++b) if (cbase + b == bi) { c0[b] = -INFINITY; e = i1s[0] * 128 + i2[b]; }
#pragma unroll
    for (int b = 0; b < 8; ++b) if (cbase + 16 + b == bi) { c1[b] = -INFINITY; e = i1s[1] * 128 + i2[b]; }
#pragma unroll
    for (int b = 0; b < 5; ++b) if (cbase + 32 + b == bi) { c2[b] = -INFINITY; e = i1s[2] * 128 + i2[b]; }
#pragma unroll
    for (int b = 0; b < 4; ++b) if (cbase + 48 + b == bi) { c3[b] = -INFINITY; e = i1s[3] * 128 + i2[b]; }
    e = max(e, shx(e, 16));
    e = max(e, shx(e, 32));
    eidx[rd] = e;
  }
  float ex[16], sum = 0.f;
#pragma unroll
  for (int rd = 0; rd < 16; ++rd) { ex[rd] = expf(vals[rd] - vals[0]); sum += ex[rd]; }
  const float inv = 1.f / sum;
  if (g4 == 0) {
    int* pi = (int*)(p.ws + OFF_PEIDX) + tok * 128 + hh * 16;
    float* pg = (float*)(p.ws + OFF_PEG) + tok * 128 + hh * 16;
#pragma unroll
    for (int q = 0; q < 4; ++q) {
      *(int4*)(pi + q * 4) = int4{eidx[q * 4], eidx[q * 4 + 1], eidx[q * 4 + 2], eidx[q * 4 + 3]};
      *(float4*)(pg + q * 4) = float4{ex[q * 4] * inv, ex[q * 4 + 1] * inv, ex[q * 4 + 2] * inv, ex[q * 4 + 3] * inv};
    }
  }
}

DEV float pk_key(float v, int inv_idx, unsigned mask) {
  return __uint_as_float((__float_as_uint(v) & ~mask) | (unsigned)inv_idx);
}
DEV void sort32_desc(float (&x)[32]) {
#pragma unroll
  for (int k = 2; k <= 32; k <<= 1)
#pragma unroll
    for (int j = k >> 1; j > 0; j >>= 1)
#pragma unroll
      for (int i = 0; i < 32; ++i) {
        const int l = i ^ j;
        if (l > i) {
          const float a = x[i], b = x[l];
          const float hi = fmaxf(a, b), lo = fminf(a, b);
          if ((i & k) == 0) { x[i] = hi; x[l] = lo; } else { x[i] = lo; x[l] = hi; }
        }
      }
}
DEV void pk_top16_sorted(f32x4 (&s)[8], int g4, float (&vout)[16], int (&iout)[16]) {
  float x[32];
#pragma unroll
  for (int mi = 0; mi < 8; ++mi)
#pragma unroll
    for (int r = 0; r < 4; ++r) x[mi * 4 + r] = pk_key(s[mi][r], 127 - (mi * 16 + g4 * 4 + r), 0x7Fu);
  sort32_desc(x);
#pragma unroll
  for (int rd = 0; rd < 16; ++rd) {
    float w = x[0];
    w = fmaxf(w, shx(w, 16));
    w = fmaxf(w, shx(w, 32));
    vout[rd] = w;
    iout[rd] = 127 - (int)(__float_as_uint(w) & 0x7Fu);
    if (x[0] == w) {
#pragma unroll
      for (int i = 0; i < 15; ++i) x[i] = x[i + 1];
      x[15] = -INFINITY;
    }
  }
}
template <int N>
DEV void shift_row(float (&c)[N], int (&e)[N]) {
#pragma unroll
  for (int i = 0; i + 1 < N; ++i) { c[i] = c[i + 1]; e[i] = e[i + 1]; }
  c[N - 1] = -INFINITY;
}
DEV void peer_topk_item3(const Params& p, int layer, int item, int* lds_idx = nullptr, float* lds_gate = nullptr) {
  const int lane = tidx() & 63, wave = tidx() >> 6, g4 = lane >> 4, c16 = lane & 15;
  const size_t tok = (size_t)item * 8 + wave * 2 + (c16 >> 3);
  const int hh = c16 & 7;
  const bf16* qp = (const bf16*)(p.ws + OFF_QP) + tok * 2048 + hh * 256;
  const bf16* k1 = (const bf16*)(p.ws + OFF_PKB) + (size_t)(layer * 2 + 0) * 16384;
  const bf16* k2 = (const bf16*)(p.ws + OFF_PKB) + (size_t)(layer * 2 + 1) * 16384;
  float v1[16], v2[16];
  int i1[16], i2[16];
  {
    f32x4 s[8];
    pk_scores(k1, qp, s, g4, c16);
    pk_top16_sorted(s, g4, v1, i1);
  }
  {
    f32x4 s[8];
    pk_scores(k2, qp + 128, s, g4, c16);
    pk_top16_sorted(s, g4, v2, i2);
  }
  float v1s[4];
  int i1s[4];
#pragma unroll
  for (int j = 0; j < 4; ++j) {
    v1s[j] = (g4 == 0) ? v1[j] : (g4 == 1) ? v1[4 + j] : (g4 == 2) ? v1[8 + j] : v1[12 + j];
    i1s[j] = (g4 == 0) ? i1[j] : (g4 == 1) ? i1[4 + j] : (g4 == 2) ? i1[8 + j] : i1[12 + j];
  }
  float c0[16], c1[8], c2[5], c3[4];
  int e0[16], e1[8], e2[5], e3[4];
  const int cbase = g4 * 64;
#pragma unroll
  for (int b = 0; b < 16; ++b) {
    c0[b] = ((4 * g4 + 1) * (b + 1) <= 16) ? pk_key(v1s[0] + v2[b], 255 - (cbase + b), 0xFFu) : -INFINITY;
    e0[b] = i1s[0] * 128 + i2[b];
  }
#pragma unroll
  for (int b = 0; b < 8; ++b) {
    c1[b] = ((4 * g4 + 2) * (b + 1) <= 16) ? pk_key(v1s[1] + v2[b], 255 - (cbase + 16 + b), 0xFFu) : -INFINITY;
    e1[b] = i1s[1] * 128 + i2[b];
  }
#pragma unroll
  for (int b = 0; b < 5; ++b) {
    c2[b] = ((4 * g4 + 3) * (b + 1) <= 16) ? pk_key(v1s[2] + v2[b], 255 - (cbase + 32 + b), 0xFFu) : -INFINITY;
    e2[b] = i1s[2] * 128 + i2[b];
  }
#pragma unroll
  for (int b = 0; b < 4; ++b) {
    c3[b] = ((4 * g4 + 4) * (b + 1) <= 16) ? pk_key(v1s[3] + v2[b], 255 - (cbase + 48 + b), 0xFFu) : -INFINITY;
    e3[b] = i1s[3] * 128 + i2[b];
  }
  float vals[16];
  int eidx[16];
#pragma unroll
  for (int rd = 0; rd < 16; ++rd) {
    float w = fmaxf(fmaxf(c0[0], c1[0]), fmaxf(c2[0], c3[0]));
    w = fmaxf(w, shx(w, 16));
    w = fmaxf(w, shx(w, 32));
    vals[rd] = w;
    int e = -1;
    if (c0[0] == w) { e = e0[0]; shift_row(c0, e0); }
    if (c1[0] == w) { e = e1[0]; shift_row(c1, e1); }
    if (c2[0] == w) { e = e2[0]; shift_row(c2, e2); }
    if (c3[0] == w) { e = e3[0]; shift_row(c3, e3); }
    e = max(e, shx(e, 16));
    e = max(e, shx(e, 32));
    eidx[rd] = e;
  }
  float ex[16], sum = 0.f;
#pragma unroll
  for (int rd = 0; rd < 16; ++rd) { ex[rd] = expf(vals[rd] - vals[0]); sum += ex[rd]; }
  const float inv = 1.f / sum;
  if (g4 == 0) {
    int* pi = lds_idx ? (lds_idx + (c16 >> 3) * 128 + hh * 16) : ((int*)(p.ws + OFF_PEIDX) + tok * 128 + hh * 16);
    float* pg = lds_gate ? (lds_gate + (c16 >> 3) * 128 + hh * 16) : ((float*)(p.ws + OFF_PEG) + tok * 128 + hh * 16);
#pragma unroll
    for (int q = 0; q < 4; ++q) {
      *(int4*)(pi + q * 4) = int4{eidx[q * 4], eidx[q * 4 + 1], eidx[q * 4 + 2], eidx[q * 4 + 3]};
      *(float4*)(pg + q * 4) = float4{ex[q * 4] * inv, ex[q * 4 + 1] * inv, ex[q * 4 + 2] * inv, ex[q * 4 + 3] * inv};
    }
  }
}

typedef float f32x2_t __attribute__((ext_vector_type(2)));
DEV unsigned pack4_fp8(float a, float b, float c, float d) {
  int p = __builtin_amdgcn_cvt_pk_fp8_f32(a, b, 0, false);
  p = __builtin_amdgcn_cvt_pk_fp8_f32(c, d, p, true);
  return (unsigned)p;
}
DEV void unpack16_fp8(uint4 v, float* f) {
  f32x2_t r;
  r = __builtin_amdgcn_cvt_pk_f32_fp8((int)v.x, false); f[0] = r.x; f[1] = r.y;
  r = __builtin_amdgcn_cvt_pk_f32_fp8((int)v.x, true);  f[2] = r.x; f[3] = r.y;
  r = __builtin_amdgcn_cvt_pk_f32_fp8((int)v.y, false); f[4] = r.x; f[5] = r.y;
  r = __builtin_amdgcn_cvt_pk_f32_fp8((int)v.y, true);  f[6] = r.x; f[7] = r.y;
  r = __builtin_amdgcn_cvt_pk_f32_fp8((int)v.z, false); f[8] = r.x; f[9] = r.y;
  r = __builtin_amdgcn_cvt_pk_f32_fp8((int)v.z, true);  f[10] = r.x; f[11] = r.y;
  r = __builtin_amdgcn_cvt_pk_f32_fp8((int)v.w, false); f[12] = r.x; f[13] = r.y;
  r = __builtin_amdgcn_cvt_pk_f32_fp8((int)v.w, true);  f[14] = r.x; f[15] = r.y;
}
DEV void expert_cvt_item(const Params& p, int layer, int item) {
  const int lane = tidx() & 63, wave = tidx() >> 6;
  const int e = item * 4 + wave;
  unsigned char* dst = (unsigned char*)(p.ws + OFF_E8) + (size_t)e * 2048;
  float* sc = (float*)(p.ws + OFF_ESC) + (size_t)e * 2;
#pragma unroll
  for (int tb = 0; tb < 2; ++tb) {
    const float* src = (tb ? p.peer_v : p.peer_u) + ((size_t)layer * NEXP + e) * 1024 + lane * 16;
    float4 a = *(const float4*)src, b = *(const float4*)(src + 4), c = *(const float4*)(src + 8), d = *(const float4*)(src + 12);
    float mx = fmaxf(fmaxf(fmaxf(fabsf(a.x), fabsf(a.y)), fmaxf(fabsf(a.z), fabsf(a.w))),
                     fmaxf(fmaxf(fabsf(b.x), fabsf(b.y)), fmaxf(fabsf(b.z), fabsf(b.w))));
    mx = fmaxf(mx, fmaxf(fmaxf(fmaxf(fabsf(c.x), fabsf(c.y)), fmaxf(fabsf(c.z), fabsf(c.w))),
                         fmaxf(fmaxf(fabsf(d.x), fabsf(d.y)), fmaxf(fabsf(d.z), fabsf(d.w)))));
#pragma unroll
    for (int o = 32; o >= 1; o >>= 1) mx = fmaxf(mx, shx(mx, o));
    const float s = (mx > 0.f) ? 224.f / mx : 1.f;
    uint4 pk;
    pk.x = pack4_fp8(a.x * s, a.y * s, a.z * s, a.w * s);
    pk.y = pack4_fp8(b.x * s, b.y * s, b.z * s, b.w * s);
    pk.z = pack4_fp8(c.x * s, c.y * s, c.z * s, c.w * s);
    pk.w = pack4_fp8(d.x * s, d.y * s, d.z * s, d.w * s);
    *(uint4*)(dst + tb * 1024 + lane * 16) = pk;
    if (lane == 0) sc[tb] = 1.f / s;
  }
}

DEV float rdlane_f(float v, int l) { return __int_as_float(__builtin_amdgcn_readlane(__float_as_int(v), l)); }
DEV float dot16_f8(const float* hw, uint4 u) {
  float f[16];
  unpack16_fp8(u, f);
  float s = 0.f;
#pragma unroll
  for (int i = 0; i < 16; ++i) s += hw[i] * f[i];
  return s;
}
DEV void axpy16_f8(float* acc, float a, uint4 u) {
  float f[16];
  unpack16_fp8(u, f);
#pragma unroll
  for (int i = 0; i < 16; ++i) acc[i] += a * f[i];
}
#define PE_ROWPTR(idxv, j) (E8 + (size_t)__builtin_amdgcn_readlane(idxv, (j)) * 2048)
#define PE_LOAD8(P, idxv, j0, off)                                                                        \
  P##0 = *(const uint4*)(PE_ROWPTR(idxv, (j0)) + (off)); P##1 = *(const uint4*)(PE_ROWPTR(idxv, (j0) + 1) + (off)); \
  P##2 = *(const uint4*)(PE_ROWPTR(idxv, (j0) + 2) + (off)); P##3 = *(const uint4*)(PE_ROWPTR(idxv, (j0) + 3) + (off)); \
  P##4 = *(const uint4*)(PE_ROWPTR(idxv, (j0) + 4) + (off)); P##5 = *(const uint4*)(PE_ROWPTR(idxv, (j0) + 5) + (off)); \
  P##6 = *(const uint4*)(PE_ROWPTR(idxv, (j0) + 6) + (off)); P##7 = *(const uint4*)(PE_ROWPTR(idxv, (j0) + 7) + (off));
#define PE_DOTSET(P, j0, dv)                                                                              \
  {                                                                                                       \
    const float s0 = wave_sum(dot16_f8(hw, P##0)), s1 = wave_sum(dot16_f8(hw, P##1)),                     \
                s2 = wave_sum(dot16_f8(hw, P##2)), s3 = wave_sum(dot16_f8(hw, P##3)),                     \
                s4 = wave_sum(dot16_f8(hw, P##4)), s5 = wave_sum(dot16_f8(hw, P##5)),                     \
                s6 = wave_sum(dot16_f8(hw, P##6)), s7 = wave_sum(dot16_f8(hw, P##7));                     \
    if (lane == (j0)) dv = s0;                                                                            \
    if (lane == (j0) + 1) dv = s1;                                                                        \
    if (lane == (j0) + 2) dv = s2;                                                                        \
    if (lane == (j0) + 3) dv = s3;                                                                        \
    if (lane == (j0) + 4) dv = s4;                                                                        \
    if (lane == (j0) + 5) dv = s5;                                                                        \
    if (lane == (j0) + 6) dv = s6;                                                                        \
    if (lane == (j0) + 7) dv = s7;                                                                        \
  }
#define PE_AXPYSET(P, j0, av)                                                                             \
  {                                                                                                       \
    axpy16_f8(acc, rdlane_f(av, (j0)), P##0);     axpy16_f8(acc, rdlane_f(av, (j0) + 1), P##1);           \
    axpy16_f8(acc, rdlane_f(av, (j0) + 2), P##2); axpy16_f8(acc, rdlane_f(av, (j0) + 3), P##3);           \
    axpy16_f8(acc, rdlane_f(av, (j0) + 4), P##4); axpy16_f8(acc, rdlane_f(av, (j0) + 5), P##5);           \
    axpy16_f8(acc, rdlane_f(av, (j0) + 6), P##6); axpy16_f8(acc, rdlane_f(av, (j0) + 7), P##7);           \
  }
#define PE_DOT8(idxv, dv)                                                                                 \
  {                                                                                                       \
    uint4 pa0, pa1, pa2, pa3, pa4, pa5, pa6, pa7, pb0, pb1, pb2, pb3, pb4, pb5, pb6, pb7;                 \
    PE_LOAD8(pa, idxv, 0, 0)                                                                              \
    _Pragma("unroll 1") for (int g = 0; g < 4; ++g) {                                                     \
      const int j0 = g * 16;                                                                              \
      PE_LOAD8(pb, idxv, j0 + 8, 0)                                                                       \
      PE_DOTSET(pa, j0, dv)                                                                               \
      if (g < 3) { PE_LOAD8(pa, idxv, j0 + 16, 0) }                                                       \
      PE_DOTSET(pb, j0 + 8, dv)                                                                           \
    }                                                                                                     \
  }
#define PE_AXPY8(idxv, av)                                                                                \
  {                                                                                                       \
    uint4 pa0, pa1, pa2, pa3, pa4, pa5, pa6, pa7, pb0, pb1, pb2, pb3, pb4, pb5, pb6, pb7;                 \
    PE_LOAD8(pa, idxv, 0, 1024)                                                                           \
    _Pragma("unroll 1") for (int g = 0; g < 4; ++g) {                                                     \
      const int j0 = g * 16;                                                                              \
      PE_LOAD8(pb, idxv, j0 + 8, 1024)                                                                    \
      PE_AXPYSET(pa, j0, av)                                                                              \
      if (g < 3) { PE_LOAD8(pa, idxv, j0 + 16, 1024) }                                                    \
      PE_AXPYSET(pb, j0 + 8, av)                                                                          \
    }                                                                                                     \
  }
DEV void peer_expert_tok(const Params& p, int layer, size_t tok, float ga_scale, const int* pi, const float* pg) {
  const int lane = tidx() & 63;
  const int b = (int)(tok / S);
  const int idx_lo = pi[lane], idx_hi = pi[64 + lane];
  const float g_lo = pg[lane], g_hi = pg[64 + lane];
  const float* esc = (const float*)(p.ws + OFF_ESC);
  const float2 sc_lo = *(const float2*)(esc + (size_t)idx_lo * 2), sc_hi = *(const float2*)(esc + (size_t)idx_hi * 2);
  const bf16* hrow = (const bf16*)(p.ws + OFF_H) + tok * 1024 + lane * 16;
  float hw[16];
  unpack8(*(const uint4*)hrow, hw);
  unpack8(*(const uint4*)(hrow + 8), hw + 8);
  const unsigned char* E8 = (const unsigned char*)(p.ws + OFF_E8) + lane * 16;
  float d_lo = 0.f, d_hi = 0.f;
  PE_DOT8(idx_lo, d_lo)
  PE_DOT8(idx_hi, d_hi)
  const float act_lo = g_lo * gelu_tanh(d_lo * sc_lo.x) * sc_lo.y;
  const float act_hi = g_hi * gelu_tanh(d_hi * sc_hi.x) * sc_hi.y;
  float acc[16];
#pragma unroll
  for (int i = 0; i < 16; ++i) acc[i] = 0.f;
  PE_AXPY8(idx_lo, act_lo)
  PE_AXPY8(idx_hi, act_hi)
  const float* ga = (const float*)(p.ws + OFF_MOD) + (layer * 2 + b) * 6144 + 5120 + lane * 16;
  float* xr = p.out + tok * 1024 + lane * 16;
  float xn[16];
  float ss = 0.f;
#pragma unroll
  for (int q4 = 0; q4 < 4; ++q4) {
    float4 xo = *(float4*)(xr + q4 * 4);
    const float4 g4v = *(const float4*)(ga + q4 * 4);
    xo.x += ga_scale * g4v.x * acc[q4 * 4 + 0];
    xo.y += ga_scale * g4v.y * acc[q4 * 4 + 1];
    xo.z += ga_scale * g4v.z * acc[q4 * 4 + 2];
    xo.w += ga_scale * g4v.w * acc[q4 * 4 + 3];
    xn[q4 * 4] = xo.x; xn[q4 * 4 + 1] = xo.y; xn[q4 * 4 + 2] = xo.z; xn[q4 * 4 + 3] = xo.w;
    ss += xo.x * xo.x + xo.y * xo.y + xo.z * xo.z + xo.w * xo.w;
  }
#if PROBE_ANY || REP_MASK
#pragma unroll
  for (int q4 = 0; q4 < 4; ++q4)
    *(float4*)(xr + q4 * 4) = float4{xn[q4 * 4], xn[q4 * 4 + 1], xn[q4 * 4 + 2], xn[q4 * 4 + 3]};
  return;
#endif
  ss = wave_sum(ss);
  const float rn = 1.0f / sqrtf(ss * (1.0f / 1024.f) + 1e-6f);
  if (layer == 0) {
    const float* gn = p.g_attn + 1024 + lane * 16;
    const float* md = (const float*)(p.ws + OFF_MOD) + (2 + b) * 6144 + lane * 16;
    unsigned char* hq = (unsigned char*)(p.ws + OFF_H8) + tok * 1024 + lane * 16;
    float o[16];
    float mx = 0.f;
#pragma unroll
    for (int q4 = 0; q4 < 4; ++q4) {
      *(float4*)(xr + q4 * 4) = float4{xn[q4 * 4], xn[q4 * 4 + 1], xn[q4 * 4 + 2], xn[q4 * 4 + 3]};
      const float4 g4v = *(const float4*)(gn + q4 * 4);
      const float4 s4 = *(const float4*)(md + 1024 + q4 * 4);
      const float4 h4 = *(const float4*)(md + q4 * 4);
      o[q4 * 4] = xn[q4 * 4] * rn * g4v.x * (1.f + s4.x) + h4.x;
      o[q4 * 4 + 1] = xn[q4 * 4 + 1] * rn * g4v.y * (1.f + s4.y) + h4.y;
      o[q4 * 4 + 2] = xn[q4 * 4 + 2] * rn * g4v.z * (1.f + s4.z) + h4.z;
      o[q4 * 4 + 3] = xn[q4 * 4 + 3] * rn * g4v.w * (1.f + s4.w) + h4.w;
      mx = fmaxf(mx, fmaxf(fmaxf(fabsf(o[q4 * 4]), fabsf(o[q4 * 4 + 1])), fmaxf(fabsf(o[q4 * 4 + 2]), fabsf(o[q4 * 4 + 3]))));
    }
#pragma unroll
    for (int of = 32; of >= 1; of >>= 1) mx = fmaxf(mx, shx(mx, of));
    const unsigned qe = e8m0_of(mx);
    const float qs = e8m0_inv(qe);
    uint4 pk;
    pk.x = pack4_fp8(o[0] * qs, o[1] * qs, o[2] * qs, o[3] * qs);
    pk.y = pack4_fp8(o[4] * qs, o[5] * qs, o[6] * qs, o[7] * qs);
    pk.z = pack4_fp8(o[8] * qs, o[9] * qs, o[10] * qs, o[11] * qs);
    pk.w = pack4_fp8(o[12] * qs, o[13] * qs, o[14] * qs, o[15] * qs);
    *(uint4*)hq = pk;
    if (lane == 0) ((unsigned char*)(p.ws + OFF_H8S))[tok] = (unsigned char)qe;
  } else {
    const float* gf = p.g_final + lane * 16;
#pragma unroll
    for (int q4 = 0; q4 < 4; ++q4) {
      const float4 g4v = *(const float4*)(gf + q4 * 4);
      *(float4*)(xr + q4 * 4) = float4{xn[q4 * 4] * rn * g4v.x, xn[q4 * 4 + 1] * rn * g4v.y, xn[q4 * 4 + 2] * rn * g4v.z,
                                       xn[q4 * 4 + 3] * rn * g4v.w};
    }
  }
}

DEV void peer_expert_item2(const Params& p, int layer, int item, float ga_scale = 1.f) {
  const size_t tok = (size_t)item * 4 + (tidx() >> 6);
  peer_expert_tok(p, layer, tok, ga_scale, (const int*)(p.ws + OFF_PEIDX) + tok * 128, (const float*)(p.ws + OFF_PEG) + tok * 128);
}
DEV void peer_fused_item(const Params& p, int layer, int item, char* smem) {
  const int wave = tidx() >> 6;
  int* li = (int*)(smem + wave * 2048);
  float* lg = (float*)(smem + wave * 2048 + 1024);
  peer_topk_item3(p, layer, item, li, lg);
  asm volatile("s_waitcnt lgkmcnt(0)" ::: "memory");
  __builtin_amdgcn_wave_barrier();
  const size_t tok0 = (size_t)item * 8 + wave * 2;
  peer_expert_tok(p, layer, tok0, 1.f, li, lg);
  peer_expert_tok(p, layer, tok0 + 1, 1.f, li + 128, lg + 128);
  asm volatile("s_waitcnt lgkmcnt(0)" ::: "memory");
  __builtin_amdgcn_wave_barrier();
}
namespace g8 {
constexpr int BM = 256, BK = 64, HALF = 128, HTB = HALF * BK * 2, STAGE_BYTES = 8 * HTB, NXCD = 8;
DEV int lds_byte(int r, int c) { const int st = (r >> 4) * 2 + (c >> 5), rr = r & 15, cc = c & 31, ob = rr * 64 + cc * 2; return st * 1024 + (ob ^ (((ob >> 9) & 1) << 5)); }
DEV void stage_rc(int b, int& R, int& C) { const int st = b / 1024, sb = b % 1024, swz = sb ^ (((sb >> 9) & 1) << 5); R = (st >> 1) * 16 + swz / 64; C = (st & 1) * 32 + (swz % 64) / 2; }
DEV int perm32(int rho) { const int n = rho >> 4, i = rho & 15; return 8 * (i >> 2) + 4 * n + (i & 3); }
struct Unit { int pm, pn; };
struct Gemm { const bf16* A; const bf16* Bt; int M, N, K; const unsigned char* sa = nullptr; const unsigned char* sb = nullptr; };
struct StaticOrder {
  int nM, nN, nwg, G, c, WGM;
  DEV void init(int M, int N, int G_, int c_, int wgm = 4) { nM = M / BM; nN = N / BM; nwg = nM * nN; G = G_; c = c_; WGM = wgm; }
  DEV bool next(int i, Unit& u) const {
    const long L = (long)i * G + c;
    if (L >= nwg) return false;
    int wgid = (int)L;
    { const int q = nwg / NXCD, r = nwg % NXCD, xcd = wgid % NXCD, off = wgid / NXCD; wgid = (xcd < r ? xcd * (q + 1) : r * (q + 1) + (xcd - r) * q) + off; }
    const int nig = WGM * nN, gid = wgid / nig, fm = gid * WGM, gsz = (nM - fm) < WGM ? (nM - fm) : WGM;
    u.pm = fm + ((wgid % nig) % gsz);
    u.pn = (wgid % nig) / gsz;
    return true;
  }
};
typedef int v4i32_t __attribute__((ext_vector_type(4)));
typedef int v8i32_t __attribute__((ext_vector_type(8)));
template <class Epi, bool F8 = false>
DEV void gemm_phase(LAS unsigned char* lds, const Gemm g, const StaticOrder& S, const Epi& E) {
  int tid = threadIdx.x;
  asm volatile("" : "+v"(tid));
  const int wid = __builtin_amdgcn_readfirstlane(tid >> 6), lane = tid & 63, wr = wid >> 2, wc = wid & 3, fr = lane & 15, fq = lane >> 4;
  const int K = g.K, nt = K / BK;
  unsigned voffA[2], voffB[2];
#pragma unroll
  for (int i = 0; i < 2; ++i) {
    int R, C;
    stage_rc(tid * 16 + i * 8192, R, C);
    const int Rb = Epi::PERM ? ((R & ~31) + perm32(R & 31)) : R;
    voffA[i] = (unsigned)(R * K + C) * 2u;
    voffB[i] = (unsigned)(Rb * K + C) * 2u;
  }
  const size_t kstep = (size_t)(BK * 2);
  const size_t hstep = (size_t)HALF * K * 2;
  const size_t tstep = 2 * hstep;
  const unsigned ldsw = (unsigned)wid * 1024u;
  const int aoff = lds_byte(wr * 64 + fr, fq * 8), boff = lds_byte(wc * 32 + fr, fq * 8);
#define PG8_SA(b, h) (((b) * 2 + (h)) * HTB)
#define PG8_SB(b, h) ((4 + (b) * 2 + (h)) * HTB)
#define PG8_STAGE(bufoff, gbase, voff) do { _Pragma("unroll") for (int _i = 0; _i < 2; ++_i) \
    __builtin_amdgcn_global_load_lds((const unsigned*)((const char*)(gbase) + (voff)[_i]), (LAS unsigned*)(lds + (bufoff) + ldsw + _i * 8192), 16, 0, 0); } while (0)
#define PG8_LD8(dst_, addr_) do { const v4i32_t lo_ = *(const LAS v4i32_t*)(addr_), hi_ = *(const LAS v4i32_t*)((addr_) + 1024); \
    dst_ = __builtin_shufflevector(lo_, hi_, 0, 1, 2, 3, 4, 5, 6, 7); } while (0)
#define PG8_LDA(dst, b, h) do { _Pragma("unroll") for (int m = 0; m < 4; ++m) PG8_LD8(dst[m], lds + PG8_SA(b, h) + aoff + m * 2048); } while (0)
#define PG8_LDB(dst, b, h) do { _Pragma("unroll") for (int n = 0; n < 2; ++n) PG8_LD8(dst[n], lds + PG8_SB(b, h) + boff + n * 2048); } while (0)
#define PG8_LO(x) __builtin_bit_cast(bf16x8, __builtin_shufflevector((x), (x), 0, 1, 2, 3))
#define PG8_HI(x) __builtin_bit_cast(bf16x8, __builtin_shufflevector((x), (x), 4, 5, 6, 7))
#define PG8_STR_(x) #x
#define PG8_STR(x) PG8_STR_(x)
#define PG8_MLO_0 0
#define PG8_MLO_1 1
#define PG8_MLO_2 0
#define PG8_MLO_3 1
#define PG8_MHI_0 0
#define PG8_MHI_1 0
#define PG8_MHI_2 1
#define PG8_MHI_3 1
#define PG8_M1(ai, bj, m, n, At, Bt) do { \
    if constexpr (F8) asm volatile("v_mfma_scale_f32_16x16x128_f8f6f4 %0, %1, %2, %0, %3, %4 op_sel:[" PG8_STR(n) "," PG8_STR(PG8_MLO_##m) ",0] op_sel_hi:[" PG8_STR(bj) "," PG8_STR(PG8_MHI_##m) ",0]" \
                                   : "+v"(acc[ai][bj][m][n]) : "v"(Bt[n]), "v"(At[m]), "v"(scB), "v"(scA[ai])); \
    else { acc[ai][bj][m][n] = __builtin_amdgcn_mfma_f32_16x16x32_bf16(PG8_LO(Bt[n]), PG8_LO(At[m]), acc[ai][bj][m][n], 0, 0, 0); \
           acc[ai][bj][m][n] = __builtin_amdgcn_mfma_f32_16x16x32_bf16(PG8_HI(Bt[n]), PG8_HI(At[m]), acc[ai][bj][m][n], 0, 0, 0); } } while (0)
#define PG8_MMA(ai, bj, At, Bt) do { __builtin_amdgcn_s_setprio(1); \
    PG8_M1(ai, bj, 0, 0, At, Bt); PG8_M1(ai, bj, 0, 1, At, Bt); PG8_M1(ai, bj, 1, 0, At, Bt); PG8_M1(ai, bj, 1, 1, At, Bt); \
    PG8_M1(ai, bj, 2, 0, At, Bt); PG8_M1(ai, bj, 2, 1, At, Bt); PG8_M1(ai, bj, 3, 0, At, Bt); PG8_M1(ai, bj, 3, 1, At, Bt); \
    __builtin_amdgcn_s_setprio(0); } while (0)
#define PG8_WAIT_V(n) asm volatile("s_waitcnt vmcnt(" #n ")" ::: "memory")
#define PG8_WAIT_L(n) asm volatile("s_waitcnt lgkmcnt(" #n ")" ::: "memory")
#define PG8_BAR __builtin_amdgcn_s_barrier()
#define PG8_SCHED __builtin_amdgcn_sched_barrier(0)
  Unit cur, nxt;
  int ui = 0;
  if (!S.next(0, cur)) return;
  f32x4 acc[2][2][4][2];
#pragma unroll
  for (int a = 0; a < 2; ++a)
#pragma unroll
    for (int b = 0; b < 2; ++b)
#pragma unroll
      for (int m = 0; m < 4; ++m)
#pragma unroll
        for (int n = 0; n < 2; ++n) acc[a][b][m][n] = (f32x4){0.f, 0.f, 0.f, 0.f};
  v8i32_t At[4], B0[2], B1[2];
  const char* cA = (const char*)g.A + (size_t)cur.pm * tstep;
  const char* cB = (const char*)g.Bt + (size_t)cur.pn * tstep;
  PG8_STAGE(PG8_SB(0, 0), cB, voffB); PG8_STAGE(PG8_SA(0, 0), cA, voffA); PG8_STAGE(PG8_SB(0, 1), cB + hstep, voffB); PG8_STAGE(PG8_SA(0, 1), cA + hstep, voffA);
  if (wr == 1) PG8_BAR;
  PG8_WAIT_V(4); PG8_BAR;
  PG8_STAGE(PG8_SB(1, 0), cB + kstep, voffB); PG8_STAGE(PG8_SA(1, 0), cA + kstep, voffA); PG8_STAGE(PG8_SB(1, 1), cB + hstep + kstep, voffB);
  PG8_WAIT_V(6); PG8_BAR;
  unsigned scA[2] = {0x7f7f7f7fu, 0x7f7f7f7fu}, scB = 0x7f7f7f7fu;
  for (;;) {
    if constexpr (F8) {
      const unsigned char* ta = g.sa + (size_t)cur.pm * BM + wr * 64 + fr;
      const unsigned char* tb = g.sb + (size_t)cur.pn * BM + wc * 32 + 8 * (fr >> 2) + (fr & 3);
      scA[0] = (unsigned)ta[0] | ((unsigned)ta[16] << 8) | ((unsigned)ta[32] << 16) | ((unsigned)ta[48] << 24);
      scA[1] = (unsigned)ta[HALF] | ((unsigned)ta[HALF + 16] << 8) | ((unsigned)ta[HALF + 32] << 16) | ((unsigned)ta[HALF + 48] << 24);
      scB = (unsigned)tb[0] | ((unsigned)tb[4] << 8) | ((unsigned)tb[HALF] << 16) | ((unsigned)tb[HALF + 4] << 24);
    }
    const bool has_next = S.next(ui + 1, nxt);
    const char* nA = has_next ? (const char*)g.A + (size_t)nxt.pm * tstep : cA;
    const char* nB = has_next ? (const char*)g.Bt + (size_t)nxt.pn * tstep : cB;
#define PG8_KLOOP(T0_, T1_) _Pragma("unroll 1") for (int t = (T0_); t < (T1_); t += 2) { \
      if constexpr (Epi::HAS_MID) { if (t == Epi::MID_T) { PG8_SCHED; E.mid(acc, cur, wr, wc, fr, fq); PG8_SCHED; } } \
      const bool last = (t == nt - 2); \
      const char* a1 = cA + (size_t)(t + 1) * kstep; \
      const char* a2 = last ? nA : cA + (size_t)(t + 2) * kstep; \
      const char* b2 = last ? nB : cB + (size_t)(t + 2) * kstep; \
      const char* a3 = a2 + kstep; \
      const char* b3 = b2 + kstep; \
      PG8_LDB(B0, 0, 0); PG8_SCHED; PG8_LDA(At, 0, 0); PG8_STAGE(PG8_SA(1, 1), a1 + hstep, voffA); \
      PG8_WAIT_L(8); PG8_BAR; PG8_WAIT_L(0); PG8_MMA(0, 0, At, B0); PG8_BAR; PG8_SCHED; \
      PG8_LDB(B1, 0, 1); PG8_STAGE(PG8_SB(0, 0), b2, voffB); \
      PG8_BAR; PG8_WAIT_L(0); PG8_MMA(0, 1, At, B1); PG8_BAR; \
      PG8_LDA(At, 0, 1); PG8_STAGE(PG8_SA(0, 0), a2, voffA); \
      PG8_BAR; PG8_WAIT_L(0); PG8_MMA(1, 0, At, B0); PG8_BAR; PG8_SCHED; \
      PG8_STAGE(PG8_SB(0, 1), b2 + hstep, voffB); \
      PG8_WAIT_V(6); PG8_BAR; PG8_MMA(1, 1, At, B1); PG8_BAR; \
      PG8_LDB(B0, 1, 0); PG8_SCHED; PG8_LDA(At, 1, 0); PG8_STAGE(PG8_SA(0, 1), a2 + hstep, voffA); \
      PG8_WAIT_L(8); PG8_BAR; PG8_WAIT_L(0); PG8_MMA(0, 0, At, B0); PG8_BAR; PG8_SCHED; \
      PG8_LDB(B1, 1, 1); PG8_STAGE(PG8_SB(1, 0), b3, voffB); \
      PG8_BAR; PG8_WAIT_L(0); PG8_MMA(0, 1, At, B1); PG8_BAR; \
      PG8_LDA(At, 1, 1); PG8_STAGE(PG8_SA(1, 0), a3, voffA); \
      PG8_BAR; PG8_WAIT_L(0); PG8_MMA(1, 0, At, B0); PG8_BAR; PG8_SCHED; \
      PG8_STAGE(PG8_SB(1, 1), b3 + hstep, voffB); \
      PG8_WAIT_V(6); PG8_BAR; PG8_MMA(1, 1, At, B1); PG8_BAR; \
    }
    PG8_KLOOP(0, nt)
#undef PG8_KLOOP
    if constexpr (F8) asm volatile("s_nop 15\n\ts_nop 15" ::: "memory");
    E(acc, cur, wr, wc, fr, fq);
    if (!has_next) break;
#pragma unroll
    for (int a = 0; a < 2; ++a)
#pragma unroll
      for (int b = 0; b < 2; ++b)
#pragma unroll
        for (int m = 0; m < 4; ++m)
#pragma unroll
          for (int n = 0; n < 2; ++n) acc[a][b][m][n] = (f32x4){0.f, 0.f, 0.f, 0.f};
    cur = nxt; cA = nA; cB = nB; ++ui;
  }
  PG8_WAIT_V(0);
  if (wr == 0) PG8_BAR;
  PG8_BAR;
#undef PG8_SA
#undef PG8_SB
#undef PG8_STAGE
#undef PG8_LDA
#undef PG8_LDB
#undef PG8_MMA
#undef PG8_M1
#undef PG8_LD8
#undef PG8_LO
#undef PG8_HI
#undef PG8_WAIT_V
#undef PG8_WAIT_L
#undef PG8_BAR
#undef PG8_SCHED
}
DEV unsigned cvt2(float lo, float hi) { unsigned r; asm volatile("v_cvt_pk_bf16_f32 %0, %1, %2" : "=v"(r) : "v"(lo), "v"(hi)); return r; }

struct EpiBf16 {
  static constexpr bool PERM = true;
  static constexpr bool HAS_MID = false;
  bf16* O; int ldc;
  DEV void operator()(const f32x4 (&acc)[2][2][4][2], const Unit& u, int wr, int wc, int fr, int fq) const {
    const int row0 = u.pm * BM + wr * 64 + fr, col0 = u.pn * BM + wc * 32 + 8 * fq;
#pragma unroll
    for (int ai = 0; ai < 2; ++ai)
#pragma unroll
      for (int m = 0; m < 4; ++m) {
        bf16* rowp = O + (size_t)(row0 + ai * HALF + m * 16) * ldc + col0;
#pragma unroll
        for (int bj = 0; bj < 2; ++bj) {
          const f32x4 v0 = acc[ai][bj][m][0], v1 = acc[ai][bj][m][1];
          u32x4_t w;
          w.x = cvt2(v0[0], v0[1]); w.y = cvt2(v0[2], v0[3]); w.z = cvt2(v1[0], v1[1]); w.w = cvt2(v1[2], v1[3]);
          *(u32x4_t*)(rowp + bj * HALF) = w;
        }
      }
  }
};
struct EpiResid {
  static constexpr bool PERM = false;
  static constexpr bool HAS_MID = false;
  const float* xin; float* out; const float* ga;
  DEV void operator()(const f32x4 (&acc)[2][2][4][2], const Unit& u, int wr, int wc, int fr, int fq) const {
    const int row0 = u.pm * BM + wr * 64 + fr, col0 = u.pn * BM + wc * 32 + 4 * fq;
    const int b = (u.pm * BM) / S;
    f32x4 gv[2][2];
#pragma unroll
    for (int bj = 0; bj < 2; ++bj)
#pragma unroll
      for (int n = 0; n < 2; ++n) gv[bj][n] = *(const f32x4*)(ga + b * 6144 + col0 + bj * HALF + n * 16);
#pragma unroll
    for (int ai = 0; ai < 2; ++ai)
#pragma unroll
      for (int m = 0; m < 4; ++m) {
        const size_t off = (size_t)(row0 + ai * HALF + m * 16) * 1024 + col0;
#pragma unroll
        for (int bj = 0; bj < 2; ++bj)
#pragma unroll
          for (int n = 0; n < 2; ++n) {
            const f32x4 xv = *(const f32x4*)(xin + off + bj * HALF + n * 16);
            *(f32x4*)(out + off + bj * HALF + n * 16) = xv + gv[bj][n] * acc[ai][bj][m][n];
          }
      }
  }
};
DEV float sig_(float x) { return __builtin_amdgcn_rcpf(1.f + __builtin_amdgcn_exp2f(-1.4426950408889634f * x)); }
template <bool SECOND>
struct EpiMerge {
  static constexpr bool PERM = true;
  static constexpr bool HAS_MID = false;
  bf16* Y; const bf16* proj; int gcol;
  DEV void operator()(const f32x4 (&acc)[2][2][4][2], const Unit& u, int wr, int wc, int fr, int fq) const {
    const int row0 = u.pm * BM + wr * 64 + fr, col0 = u.pn * BM + wc * 32 + 8 * fq;
#pragma unroll
    for (int ai = 0; ai < 2; ++ai)
#pragma unroll
      for (int m = 0; m < 4; ++m) {
        const size_t row = (size_t)(row0 + ai * HALF + m * 16);
#pragma unroll
        for (int bj = 0; bj < 2; ++bj) {
          const uint4 gq = *(const uint4*)(proj + row * PC + gcol + col0 + bj * HALF);
          float gf[8];
          unpack8(gq, gf);
          const f32x4 v0 = acc[ai][bj][m][0], v1 = acc[ai][bj][m][1];
          float o[8] = {sig_(gf[0]) * v0[0], sig_(gf[1]) * v0[1], sig_(gf[2]) * v0[2], sig_(gf[3]) * v0[3],
                        sig_(gf[4]) * v1[0], sig_(gf[5]) * v1[1], sig_(gf[6]) * v1[2], sig_(gf[7]) * v1[3]};
          bf16* yp = Y + row * 1024 + col0 + bj * HALF;
          if (SECOND) {
            float yf[8];
            unpack8(*(const uint4*)yp, yf);
#pragma unroll
            for (int j = 0; j < 8; ++j) o[j] += yf[j];
          }
          u32x4_t w;
          w.x = cvt2(o[0], o[1]); w.y = cvt2(o[2], o[3]); w.z = cvt2(o[4], o[5]); w.w = cvt2(o[6], o[7]);
          *(u32x4_t*)yp = w;
        }
      }
  }
};
DEV float gm_clamp(float x) { return fmaxf(x, -60.f); }
struct EpiMerge2 {
  static constexpr bool PERM = true;
  static constexpr bool HAS_MID = true;
  static constexpr int MID_T = 8;
  bf16* Y; const bf16* proj;
  static DEV float ratio_(float gn, float gm) {
    return (1.f + __builtin_amdgcn_exp2f(-1.4426950408889634f * gm_clamp(gm))) * __builtin_amdgcn_rcpf(1.f + __builtin_amdgcn_exp2f(-1.4426950408889634f * gn));
  }
  DEV void mid(f32x4 (&acc)[2][2][4][2], const Unit& u, int wr, int wc, int fr, int fq) const {
    asm volatile("" : "+v"(fr), "+v"(fq));
    const char* gbase = (const char*)(proj + (size_t)u.pm * BM * PC + u.pn * BM);
    const unsigned goff = (unsigned)(((wr * 64 + fr) * PC + wc * 32 + 8 * fq) * 2);
#pragma unroll
    for (int ai = 0; ai < 2; ++ai)
#pragma unroll
      for (int m = 0; m < 4; ++m)
#pragma unroll
        for (int bj = 0; bj < 2; ++bj)
#pragma unroll
          for (int n = 0; n < 2; ++n) {
            const unsigned go = goff + (unsigned)(((ai * HALF + m * 16) * PC + bj * HALF + n * 4) * 2);
            const uint2 a = *(const uint2*)(gbase + (go + C_GN * 2));
            const uint2 b = *(const uint2*)(gbase + (go + C_GM * 2));
            f32x4 r;
            r[0] = ratio_(__uint_as_float(a.x << 16), __uint_as_float(b.x << 16));
            r[1] = ratio_(__uint_as_float(a.x & 0xffff0000u), __uint_as_float(b.x & 0xffff0000u));
            r[2] = ratio_(__uint_as_float(a.y << 16), __uint_as_float(b.y << 16));
            r[3] = ratio_(__uint_as_float(a.y & 0xffff0000u), __uint_as_float(b.y & 0xffff0000u));
            acc[ai][bj][m][n] *= r;
          }
  }
  DEV void operator()(const f32x4 (&acc)[2][2][4][2], const Unit& u, int wr, int wc, int fr, int fq) const {
    asm volatile("" : "+v"(fr), "+v"(fq));
    const int row0 = u.pm * BM + wr * 64 + fr, col0 = u.pn * BM + wc * 32 + 8 * fq;
#pragma unroll
    for (int ai = 0; ai < 2; ++ai)
#pragma unroll
      for (int m = 0; m < 4; ++m) {
        const size_t row = (size_t)(row0 + ai * HALF + m * 16);
#pragma unroll
        for (int bj = 0; bj < 2; ++bj) {
          const uint4 gq = *(const uint4*)(proj + row * PC + C_GM + col0 + bj * HALF);
          float gf[8];
          unpack8(gq, gf);
          const f32x4 v0 = acc[ai][bj][m][0], v1 = acc[ai][bj][m][1];
          float o[8] = {sig_(gm_clamp(gf[0])) * v0[0], sig_(gm_clamp(gf[1])) * v0[1], sig_(gm_clamp(gf[2])) * v0[2], sig_(gm_clamp(gf[3])) * v0[3],
                        sig_(gm_clamp(gf[4])) * v1[0], sig_(gm_clamp(gf[5])) * v1[1], sig_(gm_clamp(gf[6])) * v1[2], sig_(gm_clamp(gf[7])) * v1[3]};
          u32x4_t w;
          w.x = cvt2(o[0], o[1]); w.y = cvt2(o[2], o[3]); w.z = cvt2(o[4], o[5]); w.w = cvt2(o[6], o[7]);
          *(u32x4_t*)(Y + row * 1024 + col0 + bj * HALF) = w;
        }
      }
  }
};
struct EpiInproj {
  static constexpr bool PERM = true;
  static constexpr bool HAS_MID = false;
  char* ws;
  DEV void operator()(const f32x4 (&acc)[2][2][4][2], const Unit& u, int wr, int wc, int fr, int fq) const {
    const int b = (u.pm * BM) / S;
    const float* rope = (const float*)(ws + OFF_ROPE);
#pragma unroll
    for (int bj = 0; bj < 2; ++bj) {
      const int vcb = u.pn * BM + bj * HALF + wc * 32;
      if (vcb >= 4992) continue;
      const int vc0 = vcb & ~63, inh = vcb & 63;
      bf16* dbase; size_t dstride; bool roped = false; bool headmajor = false; int hh = 0, nh = 1;
      if (vc0 < 768) { dbase = (bf16*)(ws + OFF_PROJ) + vc0; dstride = PC; }
      else if (vc0 < 1280) {
        const int seg = (vc0 - 768) >> 7;
        const size_t off = (seg == 0) ? OFF_KSB : (seg == 1) ? OFF_VSB : (seg == 2) ? OFF_KWB : OFF_VWB;
        dbase = (bf16*)(ws + off); dstride = 64; headmajor = true; hh = ((vc0 - 768) >> 6) & 1; nh = 2;
        roped = (seg == 0) || (seg == 2);
      } else if (vc0 < 1792) { dbase = (bf16*)(ws + OFF_PROJ) + C_MQ + (vc0 - 1280); dstride = PC; roped = true; }
      else if (vc0 < 2816) {
        const int seg = (vc0 - 1792) >> 9;
        dbase = (bf16*)(ws + (seg ? OFF_MVB : OFF_MKB)); dstride = 64; headmajor = true; hh = ((vc0 - 1792) >> 6) & 7; nh = 8;
        roped = (seg == 0);
      } else if (vc0 < 4864) { dbase = (bf16*)(ws + OFF_PROJ) + C_GN + (vc0 - 2816); dstride = PC; }
      else { dbase = (bf16*)(ws + OFF_PROJ) + C_NG + (vc0 - 4864); dstride = PC; }
      const bool do_rope = roped && inh == 0;
#pragma unroll
      for (int ai = 0; ai < 2; ++ai)
#pragma unroll
        for (int m = 0; m < 4; ++m) {
          const int row = u.pm * BM + ai * HALF + wr * 64 + m * 16 + fr;
          const int t = row - b * S;
          const f32x4 v0 = acc[ai][bj][m][0], v1 = acc[ai][bj][m][1];
          float o[8] = {v0[0], v0[1], v0[2], v0[3], v1[0], v1[1], v1[2], v1[3]};
          if (do_rope) {
            float pv[8];
#pragma unroll
            for (int j = 0; j < 8; ++j) pv[j] = shx(o[j], 16);
            const f32x4 c0 = *(const f32x4*)(rope + (size_t)t * 16), c1 = *(const f32x4*)(rope + (size_t)t * 16 + 4);
            const f32x4 s0 = *(const f32x4*)(rope + (size_t)t * 16 + 8), s1 = *(const f32x4*)(rope + (size_t)t * 16 + 12);
            const float cs[8] = {c0[0], c0[1], c0[2], c0[3], c1[0], c1[1], c1[2], c1[3]};
            const float sn[8] = {s0[0], s0[1], s0[2], s0[3], s1[0], s1[1], s1[2], s1[3]};
            const float sg = (fq == 0) ? -1.f : 1.f;
#pragma unroll
            for (int j = 0; j < 8; ++j) o[j] = (fq < 2) ? (o[j] * cs[j] + sg * pv[j] * sn[j]) : o[j];
          }
          bf16* dp = headmajor ? (dbase + ((size_t)(b * nh + hh) * S + t) * 64 + inh + 8 * fq)
                               : (dbase + (size_t)row * dstride + inh + 8 * fq);
          u32x4_t w;
          w.x = cvt2(o[0], o[1]); w.y = cvt2(o[2], o[3]); w.z = cvt2(o[4], o[5]); w.w = cvt2(o[6], o[7]);
          *(u32x4_t*)dp = w;
        }
    }
  }
};
}

template <class F>
DEV void for_tiles_xcd(int MT, int NT, F f) {
  const int nb = vnb(), bid = vbid();
  if ((nb & 15) != 0) {
    for (int it = bid; it < MT * NT; it += nb) f(it / NT, it % NT);
    return;
  }
  const int xcd = (bid >> 1) & 7, slot = ((bid >> 4) << 1) | (bid & 1), nslot = nb >> 3;
  const int nj = (NT - xcd + 7) >> 3;
  for (int q = slot; q < MT * nj; q += nslot) f(q / nj, xcd + 8 * (q % nj));
}
constexpr int PH_PER_LAYER = 15;
enum { SP_NORM1 = 0, SP_INPROJ = 1, SP_COMPRESS = 2, SP_KMEAN = 3, SP_ATTN = 4, SP_MP0 = 5, SP_MM0 = 6, SP_MP1 = 7, SP_MM1 = 8,
       SP_MERGE = 9, SP_OUTPROJ = 10, SP_NORM2 = 11, SP_PEERQ = 12, SP_TOPK = 13, SP_EXPERT = 14 };
constexpr int N_REAL_PHASES = 1 + 2 * PH_PER_LAYER + 1;
constexpr int N_PHASES = N_REAL_PHASES + (PROBE_ANY ? 2 : 0);

DEV void run_phase(const Params& p, int ph, char* smem_raw, bool second_pass = false) {
#define SKIP_MOBA_SECOND (REP_NSA_ONLY && second_pass)
  LAS unsigned char* lds_all = (LAS unsigned char*)smem_raw;
  smem_raw += hidx() * SMEM_BYTES;
  float* smf = (float*)smem_raw;
  bf16* smh = (bf16*)smem_raw;
  const int nb = vnb(), bid = vbid();
  if (ph == 0) {
    for (int it = bid; it < PREP_ITEMS; it += nb) prep_item(p, it, smf);
    return;
  }
  if (ph == N_REAL_PHASES - 1) {
    for (int it = bid; it < T / 4; it += nb) final_norm_item(p.out, p.g_final, it);
    return;
  }
#if PROBE_ANY
  if (ph == N_REAL_PHASES) {
#if PROBE_PROJ
    {
      const unsigned char* Hh = (const unsigned char*)(p.ws + OFF_H8);
      const unsigned char* Wt = (const unsigned char*)(p.ws + OFF_WINT) + (size_t)1 * WN * 1024;
      const unsigned char* hsc = (const unsigned char*)(p.ws + OFF_H8S);
      const unsigned char* wsc = (const unsigned char*)(p.ws + OFF_WCS) + WN;
      const float* rope = (const float*)(p.ws + OFF_ROPE);
      float sd = 0.f, sr = 0.f;
      for (size_t i = (size_t)bid * 256 + tidx(); i < (size_t)(T / 64) * 4888; i += (size_t)nb * 256) {
        const int ts = (int)(i / 4888), vc = (int)(i % 4888);
        const int tok = ts * 64 + (ts % 61);
        const int b = tok / S, t = tok % S;
        auto rawdot = [&](int col) {
          float a = 0.f;
          for (int k = 0; k < 1024; ++k) {
            const f32x2_t hv = __builtin_amdgcn_cvt_pk_f32_fp8((int)Hh[(size_t)tok * 1024 + k], false);
            const f32x2_t wv = __builtin_amdgcn_cvt_pk_f32_fp8((int)Wt[(size_t)col * 1024 + k], false);
            a += hv.x * wv.x;
          }
          return a * __int_as_float((int)hsc[tok] << 23) * __int_as_float((int)wsc[col] << 23);
        };
        float v = rawdot(vc);
        bool roped = false;
        const bf16* dst;
        if (vc < 768) dst = (const bf16*)(p.ws + OFF_PROJ) + (size_t)tok * PC + vc;
        else if (vc < 1280) {
          const int seg = (vc - 768) >> 7, head = ((vc - 768) >> 6) & 1, d = vc & 63;
          const size_t off = (seg == 0) ? OFF_KSB : (seg == 1) ? OFF_VSB : (seg == 2) ? OFF_KWB : OFF_VWB;
          dst = (const bf16*)(p.ws + off) + ((size_t)(b * 2 + head) * S + t) * 64 + d;
          roped = (seg == 0 || seg == 2);
        } else if (vc < 1792) { dst = (const bf16*)(p.ws + OFF_PROJ) + (size_t)tok * PC + C_MQ + (vc - 1280); roped = true; }
        else if (vc < 2816) {
          const int seg = (vc - 1792) >> 9, head = ((vc - 1792) >> 6) & 7, d = vc & 63;
          dst = (const bf16*)(p.ws + (seg ? OFF_MVB : OFF_MKB)) + ((size_t)(b * 8 + head) * S + t) * 64 + d;
          roped = (seg == 0);
        } else if (vc < 4864) dst = (const bf16*)(p.ws + OFF_PROJ) + (size_t)tok * PC + C_GN + (vc - 2816);
        else dst = (const bf16*)(p.ws + OFF_PROJ) + (size_t)tok * PC + C_NG + (vc - 4864);
        const int d = vc & 63;
        if (roped && d < 16) {
          const float cs = rope[(size_t)t * 16 + (d & 7)], sn = rope[(size_t)t * 16 + 8 + (d & 7)];
          if (d < 8) { const float x2 = rawdot(vc + 8); v = v * cs - x2 * sn; }
          else { const float x1 = rawdot(vc - 8); v = v * cs + x1 * sn; }
        }
        const float got = bf2f(*dst);
        const bool is_r = roped && d < 16;
        if (PROBE_PROJ == 1 || (PROBE_PROJ == 2 && is_r) || (PROBE_PROJ == 3 && !is_r)) {
          sd += (got - v) * (got - v);
          sr += v * v;
        }
      }
      sd = wave_sum(sd); sr = wave_sum(sr);
      if ((tidx() & 63) == 0) {
        atomicAdd((float*)(p.ws + OFF_PROBE), sd);
        atomicAdd((float*)(p.ws + OFF_PROBE) + 1, sr);
      }
    }
#endif
#if PROBE_CMPR
    {
      float sd = 0.f, sr = 0.f;
      for (size_t i = (size_t)bid * 256 + tidx(); i < (size_t)2 * Bn * 1024 * 128; i += (size_t)nb * 256) {
        const size_t wh = i / ((size_t)Bn * 1024 * 128), r = i % ((size_t)Bn * 1024 * 128);
        const int c = (int)((r / 128) % 1024);
        if (c < 1023) {
          const float a = ((const float*)(p.ws + (wh ? OFF_VCC : OFF_KCC)))[r];
          const float y = ((const float*)(p.ws + OFF_CMP))[i];
          sd += (a - y) * (a - y);
          sr += y * y;
        }
      }
      sd = wave_sum(sd); sr = wave_sum(sr);
      if ((tidx() & 63) == 0) {
        atomicAdd((float*)(p.ws + OFF_PROBE), sd);
        atomicAdd((float*)(p.ws + OFF_PROBE) + 1, sr);
      }
    }
#endif
#if PROBE_MOBA
    probe_accum_bf16(p, (const bf16*)(p.ws + OFF_OMOBA), (const bf16*)(p.ws + OFF_CMP), (size_t)S * 512, smf);
#endif
#if PROBE_NSA == 8
    {
      const float* impn = (const float*)(p.ws + OFF_OMOBA);
      const float* impm = impn + (size_t)S * 256;
      const int* seld = (const int*)(p.ws + OFF_CMP);
      float sd = 0.f, sr = 0.f, bad = 0.f;
      for (int t = bid * 256 + tidx(); t < S; t += nb * 256) {
        const int cur = t >> 6;
        for (int n = 0; n < 256; ++n) {
          float a = impm[(size_t)t * 256 + n], r = impn[(size_t)t * 256 + n];
          sd += (a - r) * (a - r);
          sr += r * r;
        }
        unsigned want[8] = {0, 0, 0, 0, 0, 0, 0, 0}, got[8] = {0, 0, 0, 0, 0, 0, 0, 0};
        for (int j = 0; j < 16; ++j) {
          int v = seld[(size_t)t * 16 + j];
          if (v >= 0 && v < 256) {
            for (int w = 0; w < 8; ++w) if ((v >> 5) == w) got[w] |= 1u << (v & 31);
          }
        }
        if (cur < 16) {
          for (int n = 0; n <= cur; ++n) want[0] |= 1u << n;
        } else {
          want[0] |= 1u;
          for (int w = 0; w < 8; ++w) {
            if (((cur - 1) >> 5) == w) want[w] |= 1u << ((cur - 1) & 31);
            if ((cur >> 5) == w) want[w] |= 1u << (cur & 31);
          }
          for (int j = 0; j < 13; ++j) {
            float best = -1.f;
            int bi = 1;
            for (int n = 1; n <= cur - 2; ++n) {
              bool taken = false;
              for (int w = 0; w < 8; ++w) if ((n >> 5) == w) taken = (want[w] >> (n & 31)) & 1u;
              float v = impm[(size_t)t * 256 + n];
              if (!taken && v > best) { best = v; bi = n; }
            }
            for (int w = 0; w < 8; ++w) if ((bi >> 5) == w) want[w] |= 1u << (bi & 31);
          }
        }
        bool same = true;
        for (int w = 0; w < 8; ++w) same = same && (want[w] == got[w]);
        if (!same) bad += 1.f;
      }
      sd = wave_sum(sd); sr = wave_sum(sr); bad = wave_sum(bad);
      if ((tidx() & 63) == 0) {
        atomicAdd((float*)(p.ws + OFF_PROBE), sd);
        atomicAdd((float*)(p.ws + OFF_PROBE) + 1, sr);
        atomicAdd((float*)(p.ws + OFF_PROBE) + 2, bad);
      }
    }
#elif PROBE_NSA
    probe_accum_bf16(p, (const bf16*)(p.ws + OFF_ONSA), (const bf16*)(p.ws + OFF_CMP), (size_t)S * 512, smf);
#endif
    return;
  }
  if (ph == N_REAL_PHASES + 1) {
    probe_apply(p);
    return;
  }
#endif
  const int layer = (ph - 1) / PH_PER_LAYER, sub = (ph - 1) % PH_PER_LAYER;
  const float* mod = (const float*)(p.ws + OFF_MOD) + (size_t)layer * 2 * 6144;
  const float* xin = (layer == 0) ? p.x : p.out;
  bf16* H = (bf16*)(p.ws + OFF_H);
  bf16* PROJ = (bf16*)(p.ws + OFF_PROJ);
#if PROBE_ANY
  if (sub >= SP_MERGE) {
    if (sub == SP_OUTPROJ && layer == 0)
      for (size_t i = (size_t)bid * 256 + tidx(); i < (size_t)T * 1024; i += (size_t)nb * 256) p.out[i] = p.x[i];
    return;
  }
#endif
  switch (sub) {
    case SP_NORM1:
      for (int it = bid; it < T / 4; it += nb)
        norm8_item(xin, p.g_attn + layer * 1024, mod + 1024, mod + 0, (unsigned char*)(p.ws + OFF_H8), (unsigned char*)(p.ws + OFF_H8S), it);
      if (layer == 0)
        for (int it = bid; it < WQ8_ITEMS; it += nb) wq8_item(p, it, smf);
      break;
    case SP_INPROJ: {
      g8::StaticOrder so;
      so.init(T, WN, (int)gridDim.x, (int)blockIdx.x, WGM_INPROJ);
      g8::gemm_phase<g8::EpiInproj, true>(lds_all, g8::Gemm{(const bf16*)(p.ws + OFF_H8), (const bf16*)(p.ws + OFF_WINT + (size_t)layer * WN * 1024), T, WN, 512,
                                                             (const unsigned char*)(p.ws + OFF_H8S), (const unsigned char*)(p.ws + OFF_WCS) + (size_t)layer * WN},
                                          so, g8::EpiInproj{p.ws});
    } break;
    case SP_COMPRESS:
      for (int it = bid; it < 512 + 1024 + 256; it += nb) {
        if (it < 512) compress_mfma_item(p, layer, it, smem_raw);
        else if (it < 1536) kmean_item(p, it - 512, smf);
        else kvamax_item(p, layer, it - 1536);
      }
#if PROBE_CMPR
      if (layer == 1)
        for (int it = bid; it < 1024; it += nb) compress_item(p, layer, it, smf);
#endif
      break;
    case SP_KMEAN:
      for (int it = bid; it < 1024; it += nb) kvq_item(p, layer, it, smf);
#if PROBE_NSA
      if (layer == 1)
        for (int it = bid; it < 512; it += nb) n1_item(p, layer, it, smf);
#endif
      break;
    case SP_ATTN:
      {
        constexpr int MNI = 2;
        constexpr int NMOBA = 16 * (S / (64 * MNI));
        constexpr int NNI = 2;
        constexpr int NNSA = 4 * (S / (16 * NNI));
        const bool do_nsa = !PROBE_ANY || PROBE_NSA, do_moba = (!PROBE_ANY || PROBE_MOBA) && PROBE_NSA != 8;
        {
          constexpr int NCH = S / (16 * NNI);
          const bool affine = nb >= 8;
          const int grp = bid & 7, bk = grp & 3, sub = grp >> 2;
          const int i0 = affine ? (bid >> 3) : bid;
          const int istride = affine ? ((nb - grp + 7) >> 3) : nb;
          const int icount = affine ? (NCH / 2) : NNSA;
          if (do_nsa) {
            const bool snake = affine && (nb & 7) == 0 && (icount % (2 * istride)) == 0;
            int k = 0;
            for (int i = i0; i < icount; i += istride, ++k) {
              const int ii = snake ? ((k & 1) ? ((k + 1) * istride - 1 - i0) : (k * istride + i0)) : i;
              nsa_item<NNI>(p, layer, affine ? (((2 * ii + sub) << 2) | bk) : ii, smem_raw, (bf16*)(p.ws + OFF_ONSA));
            }
          }
          if (do_moba && !SKIP_MOBA_SECOND)
          {
            const int ngi = (NMOBA - (bid & ~1) + nb - 1) / nb;
            for (int j0 = 0; j0 < ngi; j0 += 4) {
              const int first = bid + j0 * nb;
              int nit = ngi - j0 < 4 ? ngi - j0 : 4;
              while (nit > 0 && first + (nit - 1) * nb >= NMOBA) --nit;
              moba_gate_batch<MNI>(p, first, nb, nit, (int*)smf);
            }
          }
        }
#if PROBE_NSA && PROBE_NSA != 8
        if (layer == 1)
          for (int it = bid; it < 512; it += nb) n23_item(p, layer, it);
#endif
#if PROBE_MOBA
        if (layer == 1) {
          for (int it = bid; it < 512; it += nb) moba_item(p, layer, it);
        }
#endif
      }
      break;
    case SP_MP0:
    case SP_MP1:
      if ((!PROBE_ANY || PROBE_MOBA) && PROBE_NSA != 8)
        {
          constexpr int NIT = 8 * 63 * MOBA_NPART;
          int k = 0;
          for (int it = bid; it < ((NIT + nb - 1) / nb) * nb; it += nb, ++k) {
            const int ii = (k & 1) ? ((k + 1) * nb - 1 - bid) : it;
            if (ii < NIT) moba_part_item2<2>(p, sub == SP_MP1 ? 1 : 0, ii, smem_raw);
          }
        }
      break;
    case SP_MM0:
    case SP_MM1:
      if ((!PROBE_ANY || PROBE_MOBA) && PROBE_NSA != 8)
        for (int it = bid; it < 8 * (S / 128); it += nb)
          moba_merge_item<2>(p, sub == SP_MM1 ? 1 : 0, it, smem_raw, (bf16*)(p.ws + OFF_OMOBA_OUT));
      break;
    case SP_MERGE:
      {
        g8::StaticOrder so;
        so.init(T, 1024, (int)gridDim.x, (int)blockIdx.x, WGM_N1024);
        g8::gemm_phase(lds_all, g8::Gemm{(const bf16*)(p.ws + OFF_ONSA), (const bf16*)(p.ws + OFF_WUPN) + (size_t)layer * 1024 * 1024, T, 1024, 1024}, so,
                       g8::EpiMerge2{H, PROJ});
      }
      break;
    case SP_OUTPROJ: {
      const bf16* W = (const bf16*)(p.ws + OFF_WOUT) + (size_t)layer * 1024 * 1024;
      const float* ga1 = mod + 2048;
      g8::StaticOrder so;
      so.init(T, 1024, (int)gridDim.x, (int)blockIdx.x, WGM_N1024);
      g8::gemm_phase(lds_all, g8::Gemm{H, W, T, 1024, 1024}, so, g8::EpiResid{xin, p.out, ga1});
    } break;
    case SP_NORM2:
      for (int it = bid; it < T / 4 + NEXP / 4; it += nb) {
        if (it < T / 4) norm_item(p.out, p.g_ffn + layer * 1024, mod + 4096, mod + 3072, H, it);
        else expert_cvt_item(p, layer, it - T / 4);
      }
      break;
    case SP_PEERQ: {
      const bf16* W = (const bf16*)(p.ws + OFF_WQ) + (size_t)layer * 2048 * 1024;
      bf16* QP = (bf16*)(p.ws + OFF_QP);
      g8::StaticOrder so;
      so.init(T, 2048, (int)gridDim.x, (int)blockIdx.x, WGM_N2048);
      g8::gemm_phase(lds_all, g8::Gemm{H, W, T, 2048, 1024}, so, g8::EpiBf16{QP, 2048});
    } break;
    case SP_TOPK:
#if REP_MASK
      for (int it = bid; it < T / 8; it += nb) peer_topk_item3(p, layer, it);
#endif
      break;
    case SP_EXPERT:
#if REP_MASK
      for (int it = bid; it < T / 4; it += nb) peer_expert_item2(p, layer, it, second_pass ? 0.f : 1.f);
#else
      for (int it = bid; it < T / 8; it += nb) peer_fused_item(p, layer, it, smem_raw);
#endif
      break;
  }
}

#define MEGA_LB __launch_bounds__(512, 2)
__global__ void MEGA_LB mega_kernel(Params p, int ph_lo, int ph_hi) {
  __shared__ __attribute__((aligned(16))) char smem_raw[2 * SMEM_BYTES + 16];
  volatile LAS unsigned* xbst = (volatile LAS unsigned*)(smem_raw + 2 * SMEM_BYTES);
  if (threadIdx.x == 0) { xbst[0] = 0u; xbst[1] = 0u; xbst[2] = 0u; xbst[3] = 0u; }
  __syncthreads();
  XcdBarrier xb = xcd_barrier_post((unsigned*)(p.ws + OFF_BAR), xbst);
  for (int ph = ph_lo; ph < ph_hi; ++ph) {
#if !PROBE_ANY && !REP_MASK
    if (ph == N_REAL_PHASES - 1 || ph == 1 + PH_PER_LAYER || (ph >= 1 && (ph - 1) % PH_PER_LAYER == SP_TOPK))
      continue;
#endif
#if REP_MASK
    const int nrep = (ph >= 1 && ph < N_REAL_PHASES - 1 && ((REP_MASK >> ((ph - 1) % PH_PER_LAYER)) & 1)) ? 2 : 1;
    for (int rep = 0; rep < nrep; ++rep) {
      if (rep) xcd_barrier(xb);
      run_phase(p, ph, smem_raw, rep != 0);
    }
#else
    run_phase(p, ph, smem_raw);
#endif
    if (ph + 1 < ph_hi) {
      if (ph == ph_lo) cg::this_grid().sync();
      else xcd_barrier(xb);
    }
  }
}

extern "C" void kernel_launch(void* const* d_in, const int* in_sizes, int n_in, void* d_out, int out_size, void* d_ws,
                              size_t ws_size, hipStream_t stream) {
  if (ws_size < WS_TOTAL) {
    fprintf(stderr, "workspace too small: %zu < %zu\n", ws_size, (size_t)WS_NEED);
    return;
  }
  Params p{};
  p.x = (const float*)d_in[0]; p.c = (const float*)d_in[1]; p.w_ada = (const float*)d_in[2];
  p.b_ada = (const float*)d_in[3]; p.g_attn = (const float*)d_in[4]; p.g_ffn = (const float*)d_in[5];
  p.w_in = (const float*)d_in[6]; p.cmp_pe = (const float*)d_in[7]; p.cmp_w1 = (const float*)d_in[8];
  p.cmp_w2 = (const float*)d_in[9]; p.w_up_nsa = (const float*)d_in[10]; p.w_up_moba = (const float*)d_in[11];
  p.w_out = (const float*)d_in[12]; p.peer_wq = (const float*)d_in[13]; p.peer_k1 = (const float*)d_in[14];
  p.peer_k2 = (const float*)d_in[15]; p.peer_u = (const float*)d_in[16]; p.peer_v = (const float*)d_in[17];
  p.g_final = (const float*)d_in[18];
  p.out = (float*)d_out;
  p.ws = (char*)d_ws;
  static int grid_blocks = 0;
  if (!grid_blocks) {
    int dev = 0, cus = 0, per_cu = 0;
    hipGetDevice(&dev);
    hipDeviceGetAttribute(&cus, hipDeviceAttributeMultiprocessorCount, dev);
    hipOccupancyMaxActiveBlocksPerMultiprocessor(&per_cu, mega_kernel, 512, 0);
    if (per_cu < 1) per_cu = 1;
    if (per_cu > 1) per_cu = 1;
    grid_blocks = cus * per_cu;
  }
  hipMemsetAsync((char*)d_ws + OFF_BAR, 0, BAR_BYTES, stream);
  int ph_lo = 0, ph_hi = N_PHASES;
  void* args[] = {(void*)&p, (void*)&ph_lo, (void*)&ph_hi};
  hipError_t e = hipLaunchCooperativeKernel((const void*)mega_kernel, dim3(grid_blocks), dim3(512), args, 0, stream);
  if (e != hipSuccess) fprintf(stderr, "cooperative launch failed: %s (grid %d)\n", hipGetErrorString(e), grid_blocks);
}
```

```cpp
#include <hip/hip_runtime.h>
#include <hip/hip_bf16.h>
#include <hip/hip_cooperative_groups.h>
#include <cstdio>
#include <cstdint>
namespace cg = cooperative_groups;

#define DEV __device__ __forceinline__
typedef unsigned short bf16;
using bf16x8 = __attribute__((ext_vector_type(8))) short;
using f32x4 = __attribute__((ext_vector_type(4))) float;

constexpr int Bn = 2, S = 16384, T = Bn * S, D = 1024;
constexpr int PC = 3456;
constexpr int WN = 5120;
constexpr int C_NQ = 0, C_KC = 512, C_VC = 640, C_MQ = 768, C_GN = 1280, C_GM = 2304, C_NG = 3328;
constexpr int NEXP = 16384;

constexpr size_t al(size_t x) { return (x + 255) & ~size_t(255); }
constexpr size_t OFF_MOD = 0;
constexpr size_t OFF_ROPE = al(OFF_MOD + 2 * 2 * 6144 * 4);
constexpr size_t OFF_PEB = al(OFF_ROPE + (size_t)S * 16 * 4);
constexpr size_t OFF_WINT = al(OFF_PEB + 2 * 2 * 128 * 4);
constexpr size_t OFF_WUPN = al(OFF_WINT + 2ull * WN * 1024 * 2);
constexpr size_t OFF_WUPM = al(OFF_WUPN + 2ull * 1024 * 512 * 2);
constexpr size_t OFF_WOUT = al(OFF_WUPM + 2ull * 1024 * 512 * 2);
constexpr size_t OFF_WQ = al(OFF_WOUT + 2ull * 1024 * 1024 * 2);
constexpr size_t OFF_KCC = al(OFF_WQ + 2ull * 2048 * 1024 * 2);
constexpr size_t OFF_VCC = al(OFF_KCC + 2ull * 1024 * 128 * 4);
constexpr size_t OFF_SEL = al(OFF_VCC + 2ull * 1024 * 128 * 4);
constexpr size_t OFF_KMEAN = al(OFF_SEL + 2ull * 2 * S * 16 * 4);
constexpr size_t OFF_KMHL = al(OFF_KMEAN + 2ull * 8 * 64 * 64 * 4);
constexpr size_t OFF_KCB = al(OFF_KMHL + 2ull * 2 * 8 * 64 * 64 * 2);
constexpr size_t OFF_VCB = al(OFF_KCB + 2ull * 2 * 1024 * 64 * 2);
constexpr size_t OFF_PKB = al(OFF_VCB + 2ull * 2 * 1024 * 64 * 2);
constexpr size_t OFF_W1T = al(OFF_PKB + 2ull * 2 * 128 * 128 * 2);
constexpr size_t OFF_BAR = al(OFF_W1T + 4ull * 128 * 2048 * 2);
constexpr size_t BAR_BYTES = 3456 * 4;
constexpr size_t OFF_PROBE = al(OFF_BAR + BAR_BYTES);
constexpr size_t OFF_H = al(OFF_PROBE + 256);
constexpr size_t OFF_WCS = OFF_WINT + 2ull * WN * 1024;
constexpr size_t OFF_ONSA = al(OFF_H + (size_t)T * 1024 * 2);
constexpr size_t OFF_OMOBA = al(OFF_ONSA + (size_t)T * 512 * 2);
constexpr size_t OFF_H8 = OFF_ONSA;
constexpr size_t OFF_H8S = OFF_OMOBA;
constexpr size_t OFF_PROJ = al(OFF_OMOBA + (size_t)T * 512 * 2);
constexpr size_t KV2_BYTES = (size_t)Bn * 2 * S * 64 * 2, KV8_BYTES = (size_t)Bn * 8 * S * 64 * 2;
constexpr size_t OFF_KSB = al(OFF_PROJ + (size_t)T * PC * 2);
constexpr size_t OFF_VSB = OFF_KSB + KV2_BYTES;
constexpr size_t OFF_KWB = OFF_VSB + KV2_BYTES;
constexpr size_t OFF_VWB = OFF_KWB + KV2_BYTES;
constexpr size_t OFF_MKB = OFF_VWB + KV2_BYTES;
constexpr size_t OFF_MVB = OFF_MKB + KV8_BYTES;
constexpr int MLIST_PER_BH = 63 * S - 128 * 63 * 64;
constexpr size_t OFF_MLIST = OFF_MVB + KV8_BYTES;
constexpr int MCNT_STRIDE = 32;
constexpr size_t OFF_MCNT = al(OFF_MLIST + (size_t)Bn * 8 * MLIST_PER_BH * 2);
constexpr size_t OFF_KS8 = al(OFF_MCNT + (size_t)Bn * 8 * 64 * 4 * MCNT_STRIDE);
constexpr size_t OFF_VT8 = OFF_KS8 + (size_t)Bn * 2 * S * 64;
constexpr size_t WS_NEED = OFF_VT8 + (size_t)Bn * 2 * S * 64;
constexpr size_t PROJ_BYTES = (size_t)T * PC * 2;
constexpr size_t OFF_MPO = OFF_H;
constexpr size_t OFF_MPML = OFF_H + (size_t)8 * S * 3 * 64 * 2;
static_assert((size_t)8 * S * 3 * 64 * 2 + (size_t)8 * S * 3 * 8 <= (size_t)T * 1024 * 2, "moba partials must fit the H region");
constexpr size_t OFF_QP = OFF_PROJ;
constexpr size_t OFF_PEIDX = al(OFF_QP + (size_t)T * 2048 * 2);
constexpr size_t OFF_PEG = al(OFF_PEIDX + (size_t)T * 128 * 4);
constexpr size_t OFF_E8 = al(OFF_PEG + (size_t)T * 128 * 4);
constexpr size_t OFF_ESC = al(OFF_E8 + (size_t)NEXP * 2048);
static_assert(OFF_ESC + (size_t)NEXP * 2 * 4 <= OFF_PROJ + PROJ_BYTES, "peer alias overflow");
static_assert(WS_NEED <= 536870912ull, "workspace too big");
#ifndef PROBE_MOBA
#define PROBE_MOBA 0
#endif
constexpr size_t OFF_CMP = PROBE_MOBA ? OFF_ONSA : OFF_MLIST;
#ifndef WGM_INPROJ
#define WGM_INPROJ 4
#endif
#ifndef WGM_N1024
#define WGM_N1024 4
#endif
#ifndef WGM_N2048
#define WGM_N2048 4
#endif
#ifndef MOBA_NPART
#define MOBA_NPART 4
#endif
#ifndef REP_NSA_ONLY
#define REP_NSA_ONLY 0
#endif
#ifndef REP_NSA_PART
#define REP_NSA_PART 0
#endif
#ifndef REP_MASK
#define REP_MASK 0
#endif
#ifndef PROBE_MOBA
#define PROBE_MOBA 0
#endif
#ifndef PROBE_NSA
#define PROBE_NSA 0
#endif
#ifndef PROBE_CMPR
#define PROBE_CMPR 0
#endif
#ifndef PROBE_PROJ
#define PROBE_PROJ 0
#endif
#define PROBE_ANY (PROBE_MOBA || PROBE_NSA || PROBE_CMPR || PROBE_PROJ)
constexpr int ATT_LD = PROBE_ANY ? 512 : 1024;
constexpr size_t OFF_OMOBA_OUT = PROBE_ANY ? OFF_OMOBA : OFF_ONSA + 512 * 2;
constexpr size_t WS_TOTAL = WS_NEED;
static_assert(WS_TOTAL <= 536870912ull, "workspace too big (probe)");

struct Params {
  const float *x, *c, *w_ada, *b_ada, *g_attn, *g_ffn, *w_in, *cmp_pe, *cmp_w1, *cmp_w2, *w_up_nsa, *w_up_moba, *w_out,
      *peer_wq, *peer_k1, *peer_k2, *peer_u, *peer_v, *g_final;
  float* out;
  char* ws;
};

constexpr int SMEM_BYTES = 74 * 1024;

DEV int tidx() {
  int t = threadIdx.x & 255;
  asm volatile("" : "+v"(t));
  return t;
}
DEV int hidx() { return __builtin_amdgcn_readfirstlane((int)(threadIdx.x >> 8)); }
DEV int vbid() { return (int)blockIdx.x * 2 + hidx(); }
DEV int vnb() { return (int)gridDim.x * 2; }
#define MFMA16B(a, b, c) __builtin_amdgcn_mfma_f32_16x16x32_bf16(a, b, c, 0, 0, 0)
typedef float f32x2_c __attribute__((ext_vector_type(2)));
typedef __bf16 bf16x2_c __attribute__((ext_vector_type(2)));
DEV unsigned cvtpk_(float lo, float hi) {
  const f32x2_c v = {lo, hi};
  return __builtin_bit_cast(unsigned, __builtin_convertvector(v, bf16x2_c));
}
DEV float bf2f(bf16 h) { return __uint_as_float(((unsigned)h) << 16); }
DEV bf16 f2bf(float f) {
  unsigned u = __float_as_uint(f);
  u += 0x7fffu + ((u >> 16) & 1u);
  return (bf16)(u >> 16);
}
DEV float gelu_tanh(float x) {
  float u = 0.7978845608028654f * (x + 0.044715f * x * x * x);
  return 0.5f * x * (1.f + tanhf(u));
}
DEV float sigmoidf_(float x) { return 1.f / (1.f + expf(-x)); }
DEV void unpack8(uint4 v, float* f) {
  f[0] = __uint_as_float(v.x << 16); f[1] = __uint_as_float(v.x & 0xffff0000u);
  f[2] = __uint_as_float(v.y << 16); f[3] = __uint_as_float(v.y & 0xffff0000u);
  f[4] = __uint_as_float(v.z << 16); f[5] = __uint_as_float(v.z & 0xffff0000u);
  f[6] = __uint_as_float(v.w << 16); f[7] = __uint_as_float(v.w & 0xffff0000u);
}
DEV float dot64_bf(const float* q, const bf16* row) {
  float s = 0.f;
#pragma unroll
  for (int i = 0; i < 8; ++i) {
    float f[8];
    unpack8(*(const uint4*)(row + i * 8), f);
#pragma unroll
    for (int j = 0; j < 8; ++j) s += q[i * 8 + j] * f[j];
  }
  return s;
}
DEV void axpy64_bf(float* o, float a, const bf16* row) {
#pragma unroll
  for (int i = 0; i < 8; ++i) {
    float f[8];
    unpack8(*(const uint4*)(row + i * 8), f);
#pragma unroll
    for (int j = 0; j < 8; ++j) o[i * 8 + j] += a * f[j];
  }
}
DEV float dot64_f(const float* q, const float* row) {
  float s = 0.f;
#pragma unroll
  for (int i = 0; i < 16; ++i) {
    float4 v = *(const float4*)(row + i * 4);
    s += q[i * 4] * v.x + q[i * 4 + 1] * v.y + q[i * 4 + 2] * v.z + q[i * 4 + 3] * v.w;
  }
  return s;
}
DEV void axpy64_f(float* o, float a, const float* row) {
#pragma unroll
  for (int i = 0; i < 16; ++i) {
    float4 v = *(const float4*)(row + i * 4);
    o[i * 4] += a * v.x; o[i * 4 + 1] += a * v.y; o[i * 4 + 2] += a * v.z; o[i * 4 + 3] += a * v.w;
  }
}
DEV void load_q64(float* q, const bf16* p, float scale) {
#pragma unroll
  for (int i = 0; i < 8; ++i) unpack8(*(const uint4*)(p + i * 8), q + i * 8);
#pragma unroll
  for (int i = 0; i < 64; ++i) q[i] *= scale;
}
DEV int lane_id_() { return __builtin_amdgcn_mbcnt_hi(~0u, __builtin_amdgcn_mbcnt_lo(~0u, 0u)); }
DEV int shx(int v, int m) {
  if (m == 1) return __builtin_amdgcn_update_dpp(0, v, 0xB1, 0xF, 0xF, true);
  if (m == 2) return __builtin_amdgcn_update_dpp(0, v, 0x4E, 0xF, 0xF, true);
  if (m == 4) return __builtin_amdgcn_ds_swizzle(v, 0x101F);
  if (m == 8) return __builtin_amdgcn_update_dpp(0, v, 0x128, 0xF, 0xF, true);
  if (m == 16) return __builtin_amdgcn_ds_swizzle(v, 0x401F);
  auto rr = __builtin_amdgcn_permlane32_swap((unsigned)v, (unsigned)v, false, false);
  return (lane_id_() < 32) ? (int)rr[1] : (int)rr[0];
}
DEV unsigned shx(unsigned v, int m) { return (unsigned)shx((int)v, m); }
DEV float shx(float v, int m) { return __int_as_float(shx(__float_as_int(v), m)); }
DEV float wave_sum(float v) {
#pragma unroll
  for (int o = 32; o >= 1; o >>= 1) v += shx(v, o);
  return v;
}

#define XB_TMO      128
#define XB_XCNT(j)  (256  + 64 * (j))
#define XB_XSUB(j)  (1280 + 64 * (j))
#define XB_XGEN(j)  (2304 + 64 * (j))
#define XB_TOP      3328
#define XB_TOPGEN   3392
#define XCD_BAR_WORDS 3456
#define XB_SPIN_CAP (1u << 18)
#define LAS __attribute__((address_space(3)))

__device__ __forceinline__ unsigned xb_ld(unsigned* p)              { return __hip_atomic_load(p, __ATOMIC_RELAXED, __HIP_MEMORY_SCOPE_AGENT); }
__device__ __forceinline__ unsigned xb_add(unsigned* p, unsigned v) { return __hip_atomic_fetch_add(p, v, __ATOMIC_RELAXED, __HIP_MEMORY_SCOPE_AGENT); }
__device__ __forceinline__ unsigned xb_xcc_id() { return (unsigned)__builtin_amdgcn_s_getreg((3 << 11) | 20) & 0xFu; }
#define XB_SPIN(cond, bar) do { unsigned _sp = 0; while (cond) { __builtin_amdgcn_s_sleep(1); \
    if ((++_sp & 255u) == 0u) { if (xb_ld(&(bar)[XB_TMO])) break; if (_sp > XB_SPIN_CAP) { atomicAdd(&(bar)[XB_TMO], 1u); break; } } } } while (0)

struct XcdBarrier {
    unsigned* bar; unsigned x;
    volatile LAS unsigned* st;
};

__device__ __forceinline__ XcdBarrier xcd_barrier_post(unsigned* bar, volatile LAS unsigned* st) {
    XcdBarrier b; b.bar = bar; b.x = xb_xcc_id(); b.st = st;
    if (threadIdx.x == 0) (void)xb_add(&bar[XB_XCNT(b.x)], 1u);
    return b;
}
__device__ __forceinline__ void xcd_barrier_complete(unsigned* bar, unsigned x, unsigned& nloc, unsigned& nx) {
    const unsigned G = gridDim.x * gridDim.y * gridDim.z;
    unsigned sum, cnt, mine, sp = 0u;
    for (;;) {
        sum = 0u; cnt = 0u; mine = 0u;
#pragma unroll
        for (unsigned j = 0; j < 16; ++j) { const unsigned c = xb_ld(&bar[XB_XCNT(j)]); sum += c; cnt += (c > 0u) ? 1u : 0u; mine = (j == x) ? c : mine; }
        if (sum == G) break;
        __builtin_amdgcn_s_sleep(1);
        if ((++sp & 255u) == 0u) { if (xb_ld(&bar[XB_TMO])) break; if (sp > XB_SPIN_CAP) { atomicAdd(&bar[XB_TMO], 1u); break; } }
    }
    nloc = mine > 0u ? mine : 1u; nx = cnt > 0u ? cnt : 1u;
}

__device__ __forceinline__ void xcd_barrier(const XcdBarrier& b) {
    asm volatile("s_waitcnt vmcnt(0)" ::: "memory");
    __syncthreads();
    if (threadIdx.x == 0) {
        unsigned* bar = b.bar;
        __builtin_amdgcn_s_waitcnt(0);
        unsigned nloc = b.st[0], nx = b.st[1];
        if (nloc == 0u) { xcd_barrier_complete(bar, b.x, nloc, nx); b.st[0] = nloc; b.st[1] = nx; }
        const unsigned old = xb_add(&bar[XB_XSUB(b.x)], 1u);
        const unsigned gen = old / nloc;
        if (old + 1u == (gen + 1u) * nloc) {
            __builtin_amdgcn_fence(__ATOMIC_RELEASE, "agent");
            asm volatile("s_waitcnt vmcnt(0)" ::: "memory");
            const unsigned og = xb_add(&bar[XB_TOP], 1u);
            const unsigned tg = og / nx;
            if (og + 1u == (tg + 1u) * nx) xb_add(&bar[XB_TOPGEN], 1u);
            else XB_SPIN(xb_ld(&bar[XB_TOPGEN]) == tg, bar);
            __builtin_amdgcn_fence(__ATOMIC_ACQUIRE, "agent");
            xb_add(&bar[XB_XGEN(b.x)], 1u);
            asm volatile("s_waitcnt vmcnt(0)" ::: "memory");
        } else {
            XB_SPIN(xb_ld(&bar[XB_XGEN(b.x)]) == gen, bar);
            __builtin_amdgcn_fence(__ATOMIC_ACQUIRE, "agent");
            asm volatile("s_waitcnt vmcnt(0)" ::: "memory");
        }
    }
    __syncthreads();
}


DEV int win_col_map(int j) {
  if (j < 1280) return j;
  if (j < 4864) return j + 24;
  if (j < 4888) return j - 4864 + 1280;
  return -1;
}
DEV void tr_tile(const float* __restrict__ src, int ldsrc, int K, bf16* __restrict__ dst, int kt, int nt, bool remap,
                 float* sm) {
  const int tid = tidx();
#pragma unroll 4
  for (int i = 0; i < 16; ++i) {
    int r = i * 4 + (tid >> 6), cx = tid & 63;
    int j = nt * 64 + cx, k = kt * 64 + r;
    int oc = remap ? win_col_map(j) : j;
    sm[r * 65 + cx] = (oc >= 0) ? src[(size_t)k * ldsrc + oc] : 0.f;
  }
  __syncthreads();
#pragma unroll 4
  for (int i = 0; i < 16; ++i) {
    int n = i * 4 + (tid >> 6), kk = tid & 63;
    dst[(size_t)(nt * 64 + n) * K + kt * 64 + kk] = f2bf(sm[kk * 65 + n]);
  }
  __syncthreads();
}

DEV unsigned e8m0_of(float amax) {
  const unsigned bits = (unsigned)__float_as_int(amax * (1.f / 224.f));
  unsigned e = ((bits >> 23) & 255u) + ((bits & 0x7fffffu) ? 1u : 0u);
  return e < 1u ? 1u : (e > 253u ? 253u : e);
}
DEV float e8m0_inv(unsigned e) { return __int_as_float((int)((254u - e) << 23)); }
DEV unsigned pack4_fp8_(float a, float b, float c, float d) {
  int q = __builtin_amdgcn_cvt_pk_fp8_f32(a, b, 0, false);
  q = __builtin_amdgcn_cvt_pk_fp8_f32(c, d, q, true);
  return (unsigned)q;
}
DEV void wamax_item(const Params& p, int item) {
  const int l = item >> 7, part = item & 127;
  const size_t per = (size_t)1024 * 4888 / 128;
  const float4* src = (const float4*)(p.w_in + (size_t)l * 1024 * 4888 + (size_t)part * per);
  float m = 0.f;
  for (int i = tidx(); i < (int)(per / 4); i += 256) {
    const float4 v = src[i];
    m = fmaxf(m, fmaxf(fmaxf(fabsf(v.x), fabsf(v.y)), fmaxf(fabsf(v.z), fabsf(v.w))));
  }
#pragma unroll
  for (int o = 32; o >= 1; o >>= 1) m = fmaxf(m, shx(m, o));
  if ((tidx() & 63) == 0) atomicMax((unsigned*)(p.ws + OFF_BAR) + l, (unsigned)__float_as_int(m));
}
DEV void wq8_item(const Params& p, int item, float* sm) {
  const int tid = tidx();
  const int l = item / (80 * 16), r_ = item % (80 * 16);
  const int nt = r_ / 16, kt = r_ % 16;
  const float* src = p.w_in + (size_t)l * 1024 * 4888;
  unsigned char* dst = (unsigned char*)(p.ws + OFF_WINT) + (size_t)l * WN * 1024;
  const unsigned e = e8m0_of(__int_as_float((int)__hip_atomic_load((const unsigned*)(p.ws + OFF_BAR) + l, __ATOMIC_RELAXED, __HIP_MEMORY_SCOPE_AGENT)));
  const float s = e8m0_inv(e);
#pragma unroll 4
  for (int i = 0; i < 16; ++i) {
    const int r = i * 4 + (tid >> 6), cx = tid & 63;
    const int oc = win_col_map(nt * 64 + cx);
    sm[r * 65 + cx] = (oc >= 0) ? src[(size_t)(kt * 64 + r) * 4888 + oc] : 0.f;
  }
  __syncthreads();
  const int kq = tid & 15;
#pragma unroll
  for (int i = 0; i < 4; ++i) {
    const int n = i * 16 + (tid >> 4);
    const float v0 = sm[(kq * 4 + 0) * 65 + n], v1 = sm[(kq * 4 + 1) * 65 + n], v2 = sm[(kq * 4 + 2) * 65 + n], v3 = sm[(kq * 4 + 3) * 65 + n];
    *(unsigned*)(dst + (size_t)(nt * 64 + n) * 1024 + kt * 64 + kq * 4) = pack4_fp8_(v0 * s, v1 * s, v2 * s, v3 * s);
  }
  if (kt == 0 && tid < 64) ((unsigned char*)(p.ws + OFF_WCS))[(size_t)l * WN + nt * 64 + tid] = (unsigned char)e;
  __syncthreads();
}
constexpr int WQ8_ITEMS = 2 * 80 * 16;
constexpr int PREP_TR_WIN = 2 * 128;
constexpr int PREP_TR_UPN = 2 * 16 * 8;
constexpr int PREP_TR_UPM = 2 * 16 * 8;
constexpr int PREP_TR_OUT = 2 * 16 * 16;
constexpr int PREP_TR_WQ = 2 * 32 * 16;
constexpr int PREP_ROPE = 512;
constexpr int PREP_MOD = 384;
constexpr int PREP_PEB = 16;
constexpr int PREP_PK = 32;
constexpr int PREP_TR_W1 = 4 * 2 * 32;
constexpr int PREP_ITEMS = PREP_TR_WIN + PREP_TR_UPN + PREP_TR_UPM + PREP_TR_OUT + PREP_TR_WQ + PREP_ROPE + PREP_MOD + PREP_PEB + PREP_PK + PREP_TR_W1;

DEV void prep_item(const Params& p, int item, float* sm) {
  const int tid = tidx();
  if (item < PREP_TR_WIN) {
    wamax_item(p, item);
    return;
  }
  item -= PREP_TR_WIN;
  if (item < PREP_TR_UPN) {
    int l = item / 128, r = item % 128;
    int nt = r / 8, kt = r % 8;
    tr_tile(p.w_up_nsa + (size_t)l * 512 * 1024, 1024, 1024, (bf16*)(p.ws + OFF_WUPN) + (size_t)l * 1024 * 1024, kt, nt, false, sm);
    return;
  }
  item -= PREP_TR_UPN;
  if (item < PREP_TR_UPM) {
    int l = item / 128, r = item % 128;
    int nt = r / 8, kt = r % 8;
    tr_tile(p.w_up_moba + (size_t)l * 512 * 1024, 1024, 1024, (bf16*)(p.ws + OFF_WUPN) + (size_t)l * 1024 * 1024 + 512, kt, nt, false, sm);
    return;
  }
  item -= PREP_TR_UPM;
  if (item < PREP_TR_OUT) {
    int l = item / 256, r = item % 256;
    int nt = r / 16, kt = r % 16;
    tr_tile(p.w_out + (size_t)l * 1024 * 1024, 1024, 1024, (bf16*)(p.ws + OFF_WOUT) + (size_t)l * 1024 * 1024, kt, nt, false, sm);
    return;
  }
  item -= PREP_TR_OUT;
  if (item < PREP_TR_WQ) {
    int l = item / 512, r = item % 512;
    int nt = r / 16, kt = r % 16;
    tr_tile(p.peer_wq + (size_t)l * 1024 * 2048, 2048, 1024, (bf16*)(p.ws + OFF_WQ) + (size_t)l * 2048 * 1024, kt, nt, false, sm);
    return;
  }
  item -= PREP_TR_WQ;
  if (item < PREP_ROPE) {
    int idx = item * 256 + tid;
    int pos = idx >> 3, i = idx & 7;
    float inv = powf(500000.0f, -(float)i / 8.0f);
    float ang = (float)pos * inv;
    float* rp = (float*)(p.ws + OFF_ROPE) + (size_t)pos * 16;
    rp[i] = cosf(ang);
    rp[8 + i] = sinf(ang);
    return;
  }
  item -= PREP_ROPE;
  if (item < PREP_MOD) {
    for (int i = tid; i < 2048; i += 256) {
      float cv = p.c[i];
      sm[i] = cv / (1.f + expf(-cv));
    }
    __syncthreads();
    const int l = item / 192, n0 = (item % 192) * 32;
    const int col = tid & 31, ks = tid >> 5;
    const float* w = p.w_ada + (size_t)l * 1024 * 6144 + n0 + col;
    float a0 = 0.f, a1 = 0.f;
#pragma unroll 8
    for (int k = ks * 128; k < ks * 128 + 128; ++k) {
      float wv = w[(size_t)k * 6144];
      a0 += sm[k] * wv;
      a1 += sm[1024 + k] * wv;
    }
    sm[2048 + tid * 2] = a0;
    sm[2048 + tid * 2 + 1] = a1;
    __syncthreads();
    if (tid < 64) {
      const int c2 = tid & 31, bs = tid >> 5;
      float s = 0.f;
#pragma unroll
      for (int q = 0; q < 8; ++q) s += sm[2048 + (q * 32 + c2) * 2 + bs];
      ((float*)(p.ws + OFF_MOD))[(l * 2 + bs) * 6144 + n0 + c2] = s + p.b_ada[l * 6144 + n0 + c2];
    }
    __syncthreads();
    return;
  }
  item -= PREP_MOD;
  if (item < PREP_PEB) {
    const int lw = item >> 2, j0 = (item & 3) * 32;
    const int col = tid & 31, ks = tid >> 5;
    const float* pe = p.cmp_pe + (size_t)lw * 2048;
    const float* w1 = p.cmp_w1 + (size_t)lw * 2048 * 128 + j0 + col;
    float a = 0.f;
#pragma unroll 8
    for (int i = ks * 256; i < ks * 256 + 256; ++i) a += pe[i] * w1[(size_t)i * 128];
    sm[tid] = a;
    __syncthreads();
    if (tid < 32) {
      float s = 0.f;
#pragma unroll
      for (int q = 0; q < 8; ++q) s += sm[q * 32 + tid];
      ((float*)(p.ws + OFF_PEB))[lw * 128 + j0 + tid] = s;
    }
    if (item == 0 && tid < 4) ((float*)(p.ws + OFF_PROBE))[tid] = 0.f;
    __syncthreads();
    return;
  }
  item -= PREP_PEB;
  if (item < PREP_PK) {
    const int e0 = item * 2048 + tid * 8;
    const int lt = e0 >> 14, off = e0 & 16383;
    const float* srcp = ((lt & 1) ? p.peer_k2 : p.peer_k1) + (size_t)(lt >> 1) * 16384 + off;
    const float4 a = *(const float4*)srcp, b4 = *(const float4*)(srcp + 4);
    uint4 pk;
    pk.x = (unsigned)f2bf(a.x) | ((unsigned)f2bf(a.y) << 16);
    pk.y = (unsigned)f2bf(a.z) | ((unsigned)f2bf(a.w) << 16);
    pk.z = (unsigned)f2bf(b4.x) | ((unsigned)f2bf(b4.y) << 16);
    pk.w = (unsigned)f2bf(b4.z) | ((unsigned)f2bf(b4.w) << 16);
    *(uint4*)((bf16*)(p.ws + OFF_PKB) + e0) = pk;
    return;
  }
  item -= PREP_PK;
  {
    const int lw = item >> 6, r = item & 63;
    const int nt = r >> 5, kt = r & 31;
    tr_tile(p.cmp_w1 + (size_t)lw * 2048 * 128, 128, 2048, (bf16*)(p.ws + OFF_W1T) + (size_t)lw * 128 * 2048, kt, nt, false, sm);
  }
}

DEV void norm_item(const float* __restrict__ xin, const float* __restrict__ g, const float* __restrict__ sc,
                   const float* __restrict__ sh, bf16* __restrict__ hout, int item) {
  const int lane = tidx() & 63, wave = tidx() >> 6;
  const size_t tok = (size_t)item * 4 + wave;
  const int b = (int)(tok / S);
  const float* xr = xin + tok * 1024;
  float4 v[4];
  float ss = 0.f;
#pragma unroll
  for (int i = 0; i < 4; ++i) {
    v[i] = *(const float4*)(xr + i * 256 + lane * 4);
    ss += v[i].x * v[i].x + v[i].y * v[i].y + v[i].z * v[i].z + v[i].w * v[i].w;
  }
  ss = wave_sum(ss);
  float r = 1.0f / sqrtf(ss * (1.0f / 1024.f) + 1e-6f);
#pragma unroll
  for (int i = 0; i < 4; ++i) {
    int d = i * 256 + lane * 4;
    float4 gg = *(const float4*)(g + d);
    float4 s4 = *(const float4*)(sc + b * 6144 + d);
    float4 h4 = *(const float4*)(sh + b * 6144 + d);
    float o0 = v[i].x * r * gg.x * (1.f + s4.x) + h4.x;
    float o1 = v[i].y * r * gg.y * (1.f + s4.y) + h4.y;
    float o2 = v[i].z * r * gg.z * (1.f + s4.z) + h4.z;
    float o3 = v[i].w * r * gg.w * (1.f + s4.w) + h4.w;
    uint2 pk;
    pk.x = (unsigned)f2bf(o0) | ((unsigned)f2bf(o1) << 16);
    pk.y = (unsigned)f2bf(o2) | ((unsigned)f2bf(o3) << 16);
    *(uint2*)(hout + tok * 1024 + d) = pk;
  }
}
DEV void norm8_item(const float* __restrict__ xin, const float* __restrict__ g, const float* __restrict__ sc,
                    const float* __restrict__ sh, unsigned char* __restrict__ hout, unsigned char* __restrict__ hscale, int item) {
  const int lane = tidx() & 63, wave = tidx() >> 6;
  const size_t tok = (size_t)item * 4 + wave;
  const int b = (int)(tok / S);
  const float* xr = xin + tok * 1024;
  float4 v[4];
  float ss = 0.f;
#pragma unroll
  for (int i = 0; i < 4; ++i) {
    v[i] = *(const float4*)(xr + i * 256 + lane * 4);
    ss += v[i].x * v[i].x + v[i].y * v[i].y + v[i].z * v[i].z + v[i].w * v[i].w;
  }
  ss = wave_sum(ss);
  float r = 1.0f / sqrtf(ss * (1.0f / 1024.f) + 1e-6f);
  float mx = 0.f;
#pragma unroll
  for (int i = 0; i < 4; ++i) {
    int d = i * 256 + lane * 4;
    float4 gg = *(const float4*)(g + d);
    float4 s4 = *(const float4*)(sc + b * 6144 + d);
    float4 h4 = *(const float4*)(sh + b * 6144 + d);
    v[i].x = v[i].x * r * gg.x * (1.f + s4.x) + h4.x;
    v[i].y = v[i].y * r * gg.y * (1.f + s4.y) + h4.y;
    v[i].z = v[i].z * r * gg.z * (1.f + s4.z) + h4.z;
    v[i].w = v[i].w * r * gg.w * (1.f + s4.w) + h4.w;
    mx = fmaxf(mx, fmaxf(fmaxf(fabsf(v[i].x), fabsf(v[i].y)), fmaxf(fabsf(v[i].z), fabsf(v[i].w))));
  }
#pragma unroll
  for (int o = 32; o >= 1; o >>= 1) mx = fmaxf(mx, shx(mx, o));
  const unsigned e = e8m0_of(mx);
  const float s = e8m0_inv(e);
#pragma unroll
  for (int i = 0; i < 4; ++i)
    *(unsigned*)(hout + tok * 1024 + i * 256 + lane * 4) = pack4_fp8_(v[i].x * s, v[i].y * s, v[i].z * s, v[i].w * s);
  if (lane == 0) hscale[tok] = (unsigned char)e;
}
DEV void final_norm_item(float* __restrict__ x, const float* __restrict__ g, int item) {
  const int lane = tidx() & 63, wave = tidx() >> 6;
  const size_t tok = (size_t)item * 4 + wave;
  float* xr = x + tok * 1024;
  float4 v[4];
  float ss = 0.f;
#pragma unroll
  for (int i = 0; i < 4; ++i) {
    v[i] = *(const float4*)(xr + i * 256 + lane * 4);
    ss += v[i].x * v[i].x + v[i].y * v[i].y + v[i].z * v[i].z + v[i].w * v[i].w;
  }
  ss = wave_sum(ss);
  float r = 1.0f / sqrtf(ss * (1.0f / 1024.f) + 1e-6f);
#pragma unroll
  for (int i = 0; i < 4; ++i) {
    int d = i * 256 + lane * 4;
    float4 gg = *(const float4*)(g + d);
    float4 o;
    o.x = v[i].x * r * gg.x; o.y = v[i].y * r * gg.y; o.z = v[i].z * r * gg.z; o.w = v[i].w * r * gg.w;
    *(float4*)(xr + d) = o;
  }
}

#define GM_BUF (2 * 128 * 72)
#define GM_LOAD(R, kk)                                                                                  \
  {                                                                                                     \
    const bf16* Ak = Ap + (kk);                                                                         \
    const bf16* Wk = Wp + (kk);                                                                         \
    R##a0 = *(const uint4*)(Ak); R##a1 = *(const uint4*)(Ak + a32); R##a2 = *(const uint4*)(Ak + 2 * a32); \
    R##a3 = *(const uint4*)(Ak + 3 * a32);                                                              \
    R##b0 = *(const uint4*)(Wk); R##b1 = *(const uint4*)(Wk + w32); R##b2 = *(const uint4*)(Wk + 2 * w32); \
    R##b3 = *(const uint4*)(Wk + 3 * w32);                                                              \
  }
#define GM_STORE(R, buf)                                                                                \
  {                                                                                                     \
    bf16* as_ = Asw + (buf) * GM_BUF;                                                                   \
    bf16* bs_ = as_ + 128 * 72;                                                                         \
    *(uint4*)(as_) = R##a0; *(uint4*)(as_ + 32 * 72) = R##a1; *(uint4*)(as_ + 64 * 72) = R##a2; *(uint4*)(as_ + 96 * 72) = R##a3; \
    *(uint4*)(bs_) = R##b0; *(uint4*)(bs_ + 32 * 72) = R##b1; *(uint4*)(bs_ + 64 * 72) = R##b2; *(uint4*)(bs_ + 96 * 72) = R##b3; \
  }
#define GM_COMPUTE(buf)                                                                                 \
  {                                                                                                     \
    const bf16* As_ = sm + (buf) * GM_BUF;                                                              \
    const bf16* Bs_ = As_ + 128 * 72;                                                                   \
    _Pragma("unroll") for (int ks = 0; ks < 2; ++ks) {                                                  \
      __builtin_amdgcn_sched_barrier(0);                                                                \
      bf16x8 af[4], bfr[4];                                                                             \
      _Pragma("unroll") for (int mi = 0; mi < 4; ++mi)                                                  \
        af[mi] = *(const bf16x8*)(As_ + (wr * 64 + mi * 16 + (lane & 15)) * 72 + ks * 32 + (lane >> 4) * 8); \
      _Pragma("unroll") for (int ni = 0; ni < 4; ++ni)                                                  \
        bfr[ni] = *(const bf16x8*)(Bs_ + (wc * 64 + ni * 16 + (lane & 15)) * 72 + ks * 32 + (lane >> 4) * 8); \
      _Pragma("unroll") for (int mi = 0; mi < 4; ++mi)                                                  \
        _Pragma("unroll") for (int ni = 0; ni < 4; ++ni)                                                \
          acc[mi][ni] = __builtin_amdgcn_mfma_f32_16x16x32_bf16(af[mi], bfr[ni], acc[mi][ni], 0, 0, 0); \
    }                                                                                                   \
    __builtin_amdgcn_sched_barrier(0);                                                                  \
  }
DEV void gemm_mainloop(const bf16* __restrict__ A, int lda, const bf16* __restrict__ W, int K, int m0, int n0, bf16* sm,
                       f32x4 (&acc)[4][4]) {
  const int tid = tidx(), lane = tid & 63, wave = tid >> 6;
  const int wr = wave >> 1, wc = wave & 1;
  const int lrow = tid >> 3, lkc = (tid & 7) * 8;
  const bf16* Ap = A + (size_t)(m0 + lrow) * lda + lkc;
  const bf16* Wp = W + (size_t)(n0 + lrow) * K + lkc;
  const int a32 = 32 * lda, w32 = 32 * K;
  bf16* Asw = sm + lrow * 72 + lkc;
  uint4 xa0, xa1, xa2, xa3, xb0, xb1, xb2, xb3, ya0, ya1, ya2, ya3, yb0, yb1, yb2, yb3;
  const int nk = K >> 6;
  GM_LOAD(x, 0)
  GM_LOAD(y, 64)
  __syncthreads();
  GM_STORE(x, 0)
  if (nk > 2) GM_LOAD(x, 128)
  __syncthreads();
  for (int k = 0; k < nk; k += 2) {
    GM_COMPUTE(0)
    GM_STORE(y, 1)
    if (k + 3 < nk) GM_LOAD(y, (k + 3) * 64)
    __syncthreads();
    GM_COMPUTE(1)
    if (k + 2 < nk) {
      GM_STORE(x, 0)
      if (k + 4 < nk) GM_LOAD(x, (k + 4) * 64)
    }
    __syncthreads();
  }
}
DEV void gemm256_mainloop(const bf16* __restrict__ A, int lda, const bf16* __restrict__ W, int K, int m0, int n0, bf16* sm,
                          f32x4 (&acc)[2][4][4]) {
  bf16* As = sm;
  bf16* Bs = sm + 256 * 72;
  const int tid = tidx(), lane = tid & 63, wave = tid >> 6;
  const int wr = wave >> 1, wc = wave & 1;
  const int lrow = tid >> 3, lkc = (tid & 7) * 8;
  const bf16* Ap = A + (size_t)(m0 + lrow) * lda + lkc;
  const bf16* Wp = W + (size_t)(n0 + lrow) * K + lkc;
  const int a32 = 32 * lda, w32 = 32 * K;
  uint4 ra0, ra1, ra2, ra3, ra4, ra5, ra6, ra7, rb0, rb1, rb2, rb3;
#define G256_LOAD(kk)                                                                                   \
  {                                                                                                     \
    const bf16* Ak = Ap + (kk);                                                                         \
    const bf16* Wk = Wp + (kk);                                                                         \
    ra0 = *(const uint4*)(Ak); ra1 = *(const uint4*)(Ak + a32); ra2 = *(const uint4*)(Ak + 2 * a32);    \
    ra3 = *(const uint4*)(Ak + 3 * a32); ra4 = *(const uint4*)(Ak + 4 * a32); ra5 = *(const uint4*)(Ak + 5 * a32); \
    ra6 = *(const uint4*)(Ak + 6 * a32); ra7 = *(const uint4*)(Ak + 7 * a32);                           \
    rb0 = *(const uint4*)(Wk); rb1 = *(const uint4*)(Wk + w32); rb2 = *(const uint4*)(Wk + 2 * w32);    \
    rb3 = *(const uint4*)(Wk + 3 * w32);                                                                \
  }
  G256_LOAD(0)
  bf16* Asw = As + lrow * 72 + lkc;
  bf16* Bsw = Bs + lrow * 72 + lkc;
  for (int k0 = 0; k0 < K; k0 += 64) {
    __syncthreads();
    *(uint4*)(Asw) = ra0; *(uint4*)(Asw + 32 * 72) = ra1; *(uint4*)(Asw + 64 * 72) = ra2; *(uint4*)(Asw + 96 * 72) = ra3;
    *(uint4*)(Asw + 128 * 72) = ra4; *(uint4*)(Asw + 160 * 72) = ra5; *(uint4*)(Asw + 192 * 72) = ra6; *(uint4*)(Asw + 224 * 72) = ra7;
    *(uint4*)(Bsw) = rb0; *(uint4*)(Bsw + 32 * 72) = rb1; *(uint4*)(Bsw + 64 * 72) = rb2; *(uint4*)(Bsw + 96 * 72) = rb3;
    __syncthreads();
    if (k0 + 64 < K) G256_LOAD(k0 + 64)
#pragma unroll
    for (int ks = 0; ks < 2; ++ks) {
      bf16x8 bfr[4];
#pragma unroll
      for (int ni = 0; ni < 4; ++ni)
        bfr[ni] = *(const bf16x8*)(Bs + (wc * 64 + ni * 16 + (lane & 15)) * 72 + ks * 32 + (lane >> 4) * 8);
#pragma unroll
      for (int h = 0; h < 2; ++h) {
        __builtin_amdgcn_sched_barrier(0);
        bf16x8 af[4];
#pragma unroll
        for (int mi = 0; mi < 4; ++mi)
          af[mi] = *(const bf16x8*)(As + (wr * 128 + h * 64 + mi * 16 + (lane & 15)) * 72 + ks * 32 + (lane >> 4) * 8);
#pragma unroll
        for (int mi = 0; mi < 4; ++mi)
#pragma unroll
          for (int ni = 0; ni < 4; ++ni)
            acc[h][mi][ni] = __builtin_amdgcn_mfma_f32_16x16x32_bf16(af[mi], bfr[ni], acc[h][mi][ni], 0, 0, 0);
      }
    }
  }
}
DEV void acc_zero(f32x4 (&acc)[4][4]) {
#pragma unroll
  for (int i = 0; i < 4; ++i)
#pragma unroll
    for (int j = 0; j < 4; ++j) acc[i][j] = f32x4{0.f, 0.f, 0.f, 0.f};
}
DEV void store_tile_bf16(bf16* sm, const f32x4 (&acc)[4][4], bf16* __restrict__ dbase, size_t dstride) {
  const int tid = tidx(), lane = tid & 63, wave = tid >> 6, g4 = lane >> 4, c16 = lane & 15;
  bf16* Cw = sm + wave * (64 * 72);
  __syncthreads();
#pragma unroll
  for (int mi = 0; mi < 4; ++mi)
#pragma unroll
    for (int ni = 0; ni < 4; ++ni)
#pragma unroll
      for (int r = 0; r < 4; ++r) Cw[(mi * 16 + g4 * 4 + r) * 72 + ni * 16 + c16] = f2bf(acc[mi][ni][r]);
  __syncthreads();
#pragma unroll
  for (int it = 0; it < 8; ++it) {
    const int row_l = it * 8 + (lane >> 3), ch = lane & 7;
    const uint4 v = *(const uint4*)(Cw + row_l * 72 + ch * 8);
    *(uint4*)(dbase + (size_t)row_l * dstride + ch * 8) = v;
  }
}
template <class Epi>
DEV void gemm_tile(const bf16* __restrict__ A, int lda, const bf16* __restrict__ W, int K, int m0, int n0, bf16* sm,
                   Epi epi) {
  f32x4 acc[4][4];
  acc_zero(acc);
  gemm_mainloop(A, lda, W, K, m0, n0, sm, acc);
  const int tid = tidx(), lane = tid & 63, wave = tid >> 6;
  const int wr = wave >> 1, wc = wave & 1;
#pragma unroll
  for (int mi = 0; mi < 4; ++mi)
#pragma unroll
    for (int ni = 0; ni < 4; ++ni)
#pragma unroll
      for (int r = 0; r < 4; ++r) {
        int row = m0 + wr * 64 + mi * 16 + (lane >> 4) * 4 + r;
        int col = n0 + wc * 64 + ni * 16 + (lane & 15);
        epi(row, col, acc[mi][ni][r]);
      }
}
DEV void inproj_epilogue(const Params& p, f32x4 (&acc)[4][4], int row0, int vc0, bf16* sm) {
  const int tid = tidx(), lane = tid & 63, g4 = lane >> 4, c16 = lane & 15;
  const int b = row0 / S, t0 = row0 % S;
  bf16* dbase;
  size_t dstride;
  bool roped = false;
  bf16* projp = (bf16*)(p.ws + OFF_PROJ) + (size_t)row0 * PC;
  if (vc0 < 768) { dbase = projp + vc0; dstride = PC; }
  else if (vc0 < 1280) {
    const int seg = (vc0 - 768) >> 7, head = ((vc0 - 768) >> 6) & 1;
    const size_t off = (seg == 0) ? OFF_KSB : (seg == 1) ? OFF_VSB : (seg == 2) ? OFF_KWB : OFF_VWB;
    dbase = (bf16*)(p.ws + off) + ((size_t)(b * 2 + head) * S + t0) * 64;
    dstride = 64;
    roped = (seg == 0) || (seg == 2);
  } else if (vc0 < 1792) { dbase = projp + C_MQ + (vc0 - 1280); dstride = PC; roped = true; }
  else if (vc0 < 2816) {
    const int seg = (vc0 - 1792) >> 9, head = ((vc0 - 1792) >> 6) & 7;
    dbase = (bf16*)(p.ws + (seg ? OFF_MVB : OFF_MKB)) + ((size_t)(b * 8 + head) * S + t0) * 64;
    dstride = 64;
    roped = (seg == 0);
  } else if (vc0 < 4864) { dbase = projp + C_GN + (vc0 - 2816); dstride = PC; }
  else { dbase = projp + C_NG + (vc0 - 4864); dstride = PC; }
  if (roped) {
    const float* rope = (const float*)(p.ws + OFF_ROPE);
#pragma unroll
    for (int mi = 0; mi < 4; ++mi)
#pragma unroll
      for (int r = 0; r < 4; ++r) {
        const int pos = t0 + mi * 16 + g4 * 4 + r;
        const float v = acc[mi][0][r];
        const float pv = shx(v, 8);
        const float cs = rope[pos * 16 + (c16 & 7)], sn = rope[pos * 16 + 8 + (c16 & 7)];
        acc[mi][0][r] = (c16 < 8) ? (v * cs - pv * sn) : (v * cs + pv * sn);
      }
  }
  store_tile_bf16(sm, acc, dbase, dstride);
}
DEV void inproj_tile256(const Params& p, int layer, int m0, int n0, bf16* sm) {
  f32x4 acc[2][4][4];
  acc_zero(acc[0]);
  acc_zero(acc[1]);
  gemm256_mainloop((const bf16*)(p.ws + OFF_H), 1024, (const bf16*)(p.ws + OFF_WINT) + (size_t)layer * WN * 1024, 1024, m0, n0, sm, acc);
  const int wave = tidx() >> 6, wr = wave >> 1, wc = wave & 1;
  inproj_epilogue(p, acc[0], m0 + wr * 128, n0 + wc * 64, sm);
  inproj_epilogue(p, acc[1], m0 + wr * 128 + 64, n0 + wc * 64, sm);
}
typedef unsigned u32x2_t __attribute__((ext_vector_type(2)));
DEV void merge_tile(const Params& p, int layer, int m0, int n0, bf16* sm) {
  const int tid = tidx(), lane = tid & 63, wave = tid >> 6, g4 = lane >> 4, c16 = lane & 15;
  const int wr = wave >> 1, wc = wave & 1;
  const bf16* projg = (const bf16*)(p.ws + OFF_PROJ) + (size_t)(m0 + wr * 64 + g4 * 4) * PC + n0 + wc * 64 + c16;
  f32x4 acc[4][4];
  acc_zero(acc);
  gemm_mainloop((const bf16*)(p.ws + OFF_ONSA), 512, (const bf16*)(p.ws + OFF_WUPN) + (size_t)layer * 1024 * 512, 512, m0, n0, sm, acc);
  bf16* yg = (bf16*)(p.ws + OFF_H) + (size_t)(m0 + wr * 64 + g4 * 4) * 1024 + n0 + wc * 64 + c16;
#pragma unroll
  for (int mi = 0; mi < 4; ++mi)
#pragma unroll
    for (int ni = 0; ni < 4; ++ni)
#pragma unroll
      for (int r = 0; r < 4; ++r)
        yg[(size_t)(mi * 16 + r) * 1024 + ni * 16] =
            f2bf(sigmoidf_(bf2f(projg[(size_t)(mi * 16 + r) * PC + C_GN + ni * 16])) * acc[mi][ni][r]);
  acc_zero(acc);
  gemm_mainloop((const bf16*)(p.ws + OFF_OMOBA), 512, (const bf16*)(p.ws + OFF_WUPM) + (size_t)layer * 1024 * 512, 512, m0, n0, sm, acc);
#pragma unroll
  for (int mi = 0; mi < 4; ++mi)
#pragma unroll
    for (int ni = 0; ni < 4; ++ni)
#pragma unroll
      for (int r = 0; r < 4; ++r)
        acc[mi][ni][r] = bf2f(yg[(size_t)(mi * 16 + r) * 1024 + ni * 16]) +
                         sigmoidf_(bf2f(projg[(size_t)(mi * 16 + r) * PC + C_GM + ni * 16])) * acc[mi][ni][r];
  store_tile_bf16(sm, acc, (bf16*)(p.ws + OFF_H) + (size_t)(m0 + wr * 64) * 1024 + n0 + wc * 64, 1024);
}

DEV void merge_tile256(const Params& p, int layer, int m0, int n0, bf16* sm) {
  const int tid = tidx(), lane = tid & 63, wave = tid >> 6, g4 = lane >> 4, c16 = lane & 15;
  const int wr = wave >> 1, wc = wave & 1;
  f32x4 acc[2][4][4];
  acc_zero(acc[0]);
  acc_zero(acc[1]);
  gemm256_mainloop((const bf16*)(p.ws + OFF_ONSA), 512, (const bf16*)(p.ws + OFF_WUPN) + (size_t)layer * 1024 * 512, 512, m0, n0, sm, acc);
#pragma unroll
  for (int h = 0; h < 2; ++h) {
    const size_t rb = (size_t)(m0 + wr * 128 + h * 64 + g4 * 4);
    const bf16* projg = (const bf16*)(p.ws + OFF_PROJ) + rb * PC + n0 + wc * 64 + c16;
    bf16* yg = (bf16*)(p.ws + OFF_H) + rb * 1024 + n0 + wc * 64 + c16;
#pragma unroll
    for (int mi = 0; mi < 4; ++mi)
#pragma unroll
      for (int ni = 0; ni < 4; ++ni)
#pragma unroll
        for (int r = 0; r < 4; ++r)
          yg[(size_t)(mi * 16 + r) * 1024 + ni * 16] =
              f2bf(sigmoidf_(bf2f(projg[(size_t)(mi * 16 + r) * PC + C_GN + ni * 16])) * acc[h][mi][ni][r]);
  }
  acc_zero(acc[0]);
  acc_zero(acc[1]);
  gemm256_mainloop((const bf16*)(p.ws + OFF_OMOBA), 512, (const bf16*)(p.ws + OFF_WUPM) + (size_t)layer * 1024 * 512, 512, m0, n0, sm, acc);
#pragma unroll
  for (int h = 0; h < 2; ++h) {
    const size_t rb = (size_t)(m0 + wr * 128 + h * 64 + g4 * 4);
    const bf16* projg = (const bf16*)(p.ws + OFF_PROJ) + rb * PC + n0 + wc * 64 + c16;
    const bf16* yg = (const bf16*)(p.ws + OFF_H) + rb * 1024 + n0 + wc * 64 + c16;
#pragma unroll
    for (int mi = 0; mi < 4; ++mi)
#pragma unroll
      for (int ni = 0; ni < 4; ++ni)
#pragma unroll
        for (int r = 0; r < 4; ++r)
          acc[h][mi][ni][r] = bf2f(yg[(size_t)(mi * 16 + r) * 1024 + ni * 16]) +
                              sigmoidf_(bf2f(projg[(size_t)(mi * 16 + r) * PC + C_GM + ni * 16])) * acc[h][mi][ni][r];
    store_tile_bf16(sm, acc[h], (bf16*)(p.ws + OFF_H) + (size_t)(m0 + wr * 128 + h * 64) * 1024 + n0 + wc * 64, 1024);
  }
}

DEV void compress_item(const Params& p, int layer, int item, float* sm) {
  const int tid = tidx();
  const int grp = item & 127, which = (item >> 7) & 1, kvh = (item >> 8) & 1, b = item >> 9;
  const int c0 = grp * 8;
  float* xs = sm;
  float* hs = sm + 144 * 64;
  const bf16* proj = (const bf16*)(p.ws + OFF_PROJ);
  const int col = (which ? C_VC : C_KC) + kvh * 64;
  for (int i = tid; i < 144 * 64; i += 256) {
    int tl = i >> 6, d = i & 63;
    int t = c0 * 16 + tl;
    xs[i] = (t < S) ? bf2f(proj[((size_t)b * S + t) * PC + col + d]) : 0.f;
  }
  __syncthreads();
  const int lw = layer * 2 + which;
  if (tid < 128) {
    const float* w1 = p.cmp_w1 + (size_t)lw * 2048 * 128 + tid;
    float acc[8];
#pragma unroll
    for (int ci = 0; ci < 8; ++ci) acc[ci] = 0.f;
    for (int l = 0; l < 32; ++l) {
#pragma unroll 4
      for (int d = 0; d < 64; ++d) {
        float w = w1[(size_t)(l * 64 + d) * 128];
#pragma unroll
        for (int ci = 0; ci < 8; ++ci) acc[ci] += xs[(ci * 16 + l) * 64 + d] * w;
      }
    }
    float pb = ((const float*)(p.ws + OFF_PEB))[lw * 128 + tid];
#pragma unroll
    for (int ci = 0; ci < 8; ++ci) hs[ci * 128 + tid] = gelu_tanh(acc[ci] + pb);
  }
  __syncthreads();
  const float* w2 = p.cmp_w2 + (size_t)lw * 128 * 64;
  float* outp = PROBE_CMPR ? ((float*)(p.ws + OFF_CMP) + (which ? (size_t)Bn * 1024 * 128 : 0)) : (float*)(p.ws + (which ? OFF_VCC : OFF_KCC));
#pragma unroll
  for (int rr = 0; rr < 2; ++rr) {
    int o = rr * 256 + tid;
    int ci = o >> 6, d = o & 63;
    int c = c0 + ci;
    float a = 0.f;
    for (int j = 0; j < 128; ++j) a += hs[ci * 128 + j] * w2[j * 64 + d];
    if (c < 1023) outp[(((size_t)b * 1024 + c) * 2 + kvh) * 64 + d] = a;
    bf16* outb = (bf16*)(p.ws + (which ? OFF_VCB : OFF_KCB));
    if (!PROBE_CMPR && c < 1024) outb[(((size_t)b * 2 + kvh) * 1024 + c) * 64 + d] = (c < 1023) ? f2bf(a) : (bf16)0;
  }
  __syncthreads();
}

DEV void compress_mfma_item(const Params& p, int layer, int item, char* smem) {
  bf16* xs = (bf16*)smem;
  float* hs = (float*)(smem + 272 * 64 * 2);
  const int tid = tidx(), lane = tid & 63, wave = tid >> 6, g4 = lane >> 4, c16 = lane & 15;
  const int cblk = item & 63, which = (item >> 6) & 1, kvh = (item >> 7) & 1, b = item >> 8;
  const int t0 = cblk * 256;
  const bf16* proj = (const bf16*)(p.ws + OFF_PROJ) + (size_t)b * S * PC + (which ? C_VC : C_KC) + kvh * 64;
  __syncthreads();
  {
    uint4 sv[9];
#pragma unroll
    for (int q = 0; q < 9; ++q) {
      const int i = tid + q * 256;
      const int tl = i >> 3, ch = i & 7;
      const int t = t0 + tl;
      sv[q] = uint4{0u, 0u, 0u, 0u};
      if (i < 272 * 8 && t < S) sv[q] = *(const uint4*)(proj + (size_t)t * PC + ch * 8);
    }
#pragma unroll
    for (int q = 0; q < 9; ++q) {
      const int i = tid + q * 256;
      const int tl = i >> 3, ch = i & 7;
      if (i < 272 * 8) *(uint4*)(xs + tl * 64 + ((ch ^ ((tl >> 4) & 7)) * 8)) = sv[q];
    }
  }
  float* w2s = (float*)(smem + 272 * 64 * 2 + 16 * 128 * 4);
  {
    const float* w2g = p.cmp_w2 + (size_t)(layer * 2 + which) * 128 * 64;
    float4 wv[8];
#pragma unroll
    for (int q = 0; q < 8; ++q) wv[q] = *(const float4*)(w2g + (q * 256 + tid) * 4);
#pragma unroll
    for (int q = 0; q < 8; ++q) *(float4*)(w2s + (q * 256 + tid) * 4) = wv[q];
  }
  __syncthreads();
  const int lw = layer * 2 + which;
  const bf16* w1t = (const bf16*)(p.ws + OFF_W1T) + (size_t)lw * 128 * 2048;
  f32x4 acc0 = f32x4{0.f, 0.f, 0.f, 0.f}, acc1 = f32x4{0.f, 0.f, 0.f, 0.f};
  const bf16* wb0 = w1t + (size_t)((2 * wave) * 16 + c16) * 2048 + g4 * 8;
  const bf16* wb1 = w1t + (size_t)((2 * wave + 1) * 16 + c16) * 2048 + g4 * 8;
#pragma unroll 16
  for (int ks = 0; ks < 64; ++ks) {
    const int l = ks >> 1, ch = (ks & 1) * 4 + g4;
    const int tl = 16 * c16 + l;
    const bf16x8 af = *(const bf16x8*)(xs + tl * 64 + ((ch ^ ((tl >> 4) & 7)) * 8));
    const bf16x8 b0 = *(const bf16x8*)(wb0 + ks * 32);
    const bf16x8 b1 = *(const bf16x8*)(wb1 + ks * 32);
    acc0 = MFMA16B(af, b0, acc0);
    acc1 = MFMA16B(af, b1, acc1);
  }
  {
    const float* peb = (const float*)(p.ws + OFF_PEB) + lw * 128;
    const int j0 = (2 * wave) * 16 + c16, j1 = j0 + 16;
    const float pb0 = peb[j0], pb1 = peb[j1];
#pragma unroll
    for (int r = 0; r < 4; ++r) {
      hs[(g4 * 4 + r) * 128 + j0] = gelu_tanh(acc0[r] + pb0);
      hs[(g4 * 4 + r) * 128 + j1] = gelu_tanh(acc1[r] + pb1);
    }
  }
  __syncthreads();
  const float* w2 = w2s;
  const int d = tid & 63, cq = tid >> 6;
  float o0 = 0.f, o1 = 0.f, o2 = 0.f, o3 = 0.f;
#pragma unroll 8
  for (int j = 0; j < 128; ++j) {
    const float w = w2[j * 64 + d];
    o0 += hs[(cq * 4 + 0) * 128 + j] * w;
    o1 += hs[(cq * 4 + 1) * 128 + j] * w;
    o2 += hs[(cq * 4 + 2) * 128 + j] * w;
    o3 += hs[(cq * 4 + 3) * 128 + j] * w;
  }
  float* outp = (float*)(p.ws + (which ? OFF_VCC : OFF_KCC));
  bf16* outb = (bf16*)(p.ws + (which ? OFF_VCB : OFF_KCB));
  const float ov[4] = {o0, o1, o2, o3};
#pragma unroll
  for (int i = 0; i < 4; ++i) {
    const int c = cblk * 16 + cq * 4 + i;
    if (c < 1023) outp[(((size_t)b * 1024 + c) * 2 + kvh) * 64 + d] = ov[i];
    outb[(((size_t)b * 2 + kvh) * 1024 + c) * 64 + d] = (c < 1023) ? f2bf(ov[i]) : (bf16)0;
  }
  __syncthreads();
}

DEV void n1_item(const Params& p, int layer, int item, float* sm) {
  const int chunk = item & 255, kvh = (item >> 8) & 1, b = item >> 9;
  const int tid = tidx(), ql = tid >> 2, g = tid & 3;
  const int t = chunk * 64 + ql, h = kvh * 4 + g;
  const size_t tok = (size_t)b * S + t;
  const bf16* proj = (const bf16*)(p.ws + OFF_PROJ);
  float* imp = sm;
  for (int i = tid; i < 64 * 257; i += 256) imp[i] = 0.f;
  float q[64];
  load_q64(q, proj + tok * PC + C_NQ + h * 64, 0.125f);
  const int nv = (t >= 31) ? (((t - 31) >> 4) + 1) : 0;
  const int nv_max = (((chunk * 64 + 63) - 31) >> 4) + 1;
  const float* kc = (const float*)(p.ws + OFF_KCC) + (size_t)b * 1024 * 128 + kvh * 64;
  const float* vc = (const float*)(p.ws + OFF_VCC) + (size_t)b * 1024 * 128 + kvh * 64;
  float m = -INFINITY, l = 0.f;
  for (int c = 0; c < nv_max; ++c) {
    float s = dot64_f(q, kc + (size_t)c * 128);
    if (c < nv) {
      float mn = fmaxf(m, s);
      l = l * expf(m - mn) + expf(s - mn);
      m = mn;
    }
  }
  __syncthreads();
  float o[64];
#pragma unroll
  for (int d = 0; d < 64; ++d) o[d] = 0.f;
  const float inv_l = (nv > 0) ? 1.f / l : 0.f;
  for (int c = 0; c < nv_max; ++c) {
    float s = dot64_f(q, kc + (size_t)c * 128);
    float pr = (c < nv) ? expf(s - m) * inv_l : 0.f;
    axpy64_f(o, pr, vc + (size_t)c * 128);
    float ps = pr;
    ps += shx(ps, 1);
    ps += shx(ps, 2);
    if (g == 0) {
      int n = c >> 2;
      if ((c & 3) == 3) {
        imp[ql * 257 + n] += 0.5f * ps;
        imp[ql * 257 + n + 1] += 0.5f * ps;
      } else {
        imp[ql * 257 + n] += ps;
      }
    }
  }
  const float gate0 = (!PROBE_NSA || (PROBE_NSA & 1)) ? sigmoidf_(bf2f(proj[tok * PC + C_NG + h * 3 + 0])) : 0.f;
  float* oa = (float*)(p.ws + OFF_H) + tok * 512 + h * 64;
#pragma unroll
  for (int d = 0; d < 64; d += 4) {
    float4 v = {gate0 * o[d], gate0 * o[d + 1], gate0 * o[d + 2], gate0 * o[d + 3]};
    *(float4*)(oa + d) = v;
  }
  __syncthreads();
#if PROBE_NSA == 8
  if (b == 0 && kvh == 0)
    for (int i = tid; i < 64 * 256; i += 256)
      ((float*)(p.ws + OFF_OMOBA))[(size_t)(chunk * 64 + (i >> 8)) * 256 + (i & 255)] = imp[(i >> 8) * 257 + (i & 255)];
  __syncthreads();
#endif
  if (g == 0) {
    int* selp = (int*)(p.ws + OFF_SEL) + (((size_t)b * 2 + kvh) * S + t) * 16;
    const int cur = chunk;
    if (cur < 16) {
      for (int j = 0; j < 16; ++j) selp[j] = (j <= cur) ? j : -1;
    } else {
      selp[0] = 0;
      selp[1] = cur - 1;
      selp[2] = cur;
      float* row = imp + ql * 257;
      for (int j = 3; j < 16; ++j) {
        float best = -1.f;
        int bi = 1;
        for (int n = 1; n <= cur - 2; ++n) {
          float v = row[n];
          if (v > best) { best = v; bi = n; }
        }
        selp[j] = bi;
        row[bi] = -2.f;
      }
    }
  }
  __syncthreads();
}

DEV void kmean_item(const Params& p, int item, float* sm) {
  const int n = item & 63, h = (item >> 6) & 7, b = item >> 9;
  const int tid = tidx(), d = tid & 63, part = tid >> 6;
  const bf16* mkb = (const bf16*)(p.ws + OFF_MKB);
  float a = 0.f;
  for (int i = 0; i < 64; ++i) {
    int t = n * 256 + part * 64 + i;
    a += bf2f(mkb[((size_t)(b * 8 + h) * S + t) * 64 + d]);
  }
  sm[tid] = a;
  __syncthreads();
  if (tid < 64) {
    float s = sm[tid] + sm[64 + tid] + sm[128 + tid] + sm[192 + tid];
    const size_t ko = (((size_t)b * 8 + h) * 64 + n) * 64 + tid;
    const float mean = s * (1.f / 256.f);
    ((float*)(p.ws + OFF_KMEAN))[ko] = mean;
    const bf16 hi = f2bf(mean);
    ((bf16*)(p.ws + OFF_KMHL))[ko] = hi;
    ((bf16*)(p.ws + OFF_KMHL))[(size_t)2 * 8 * 64 * 64 + ko] = f2bf(mean - bf2f(hi));
    if (tid == 0) ((int*)(p.ws + OFF_MCNT))[((b * 8 + h) * 64 + n) * MCNT_STRIDE] = 0;
  }
  __syncthreads();
}

DEV void n23_item(const Params& p, int layer, int item) {
  const int chunk = item & 255, kvh = (item >> 8) & 1, b = item >> 9;
  const int tid = tidx(), ql = tid >> 2, g = tid & 3;
  const int t = chunk * 64 + ql, h = kvh * 4 + g;
  const size_t tok = (size_t)b * S + t;
  const bf16* proj = (const bf16*)(p.ws + OFF_PROJ);
  const float* rope = (const float*)(p.ws + OFF_ROPE) + (size_t)t * 16;
  float q[64];
  load_q64(q, proj + tok * PC + C_NQ + h * 64, 1.0f);
#pragma unroll
  for (int i = 0; i < 8; ++i) {
    float cs = rope[i], sn = rope[8 + i];
    float x1 = q[i], x2 = q[8 + i];
    q[i] = x1 * cs - x2 * sn;
    q[8 + i] = x2 * cs + x1 * sn;
  }
#pragma unroll
  for (int i = 0; i < 64; ++i) q[i] *= 0.125f;
  const size_t kvo = ((size_t)(b * 2 + kvh) * S) * 64;
  const bf16* ksb = (const bf16*)(p.ws + OFF_KSB) + kvo;
  const bf16* vsb = (const bf16*)(p.ws + OFF_VSB) + kvo;
  const bf16* kwb = (const bf16*)(p.ws + OFF_KWB) + kvo;
  const bf16* vwb = (const bf16*)(p.ws + OFF_VWB) + kvo;
  const int* selp = (const int*)(p.ws + OFF_SEL) + (((size_t)b * 2 + kvh) * S + t) * 16;
  float* oa = (float*)(p.ws + OFF_H) + tok * 512 + h * 64;
  const float gate1 = (!PROBE_NSA || (PROBE_NSA & 2)) ? sigmoidf_(bf2f(proj[tok * PC + C_NG + h * 3 + 1])) : 0.f;
  const float gate2 = (!PROBE_NSA || (PROBE_NSA & 4)) ? sigmoidf_(bf2f(proj[tok * PC + C_NG + h * 3 + 2])) : 0.f;
  float o[64];
  {
    float m = -INFINITY;
    for (int j = 0; j < 16; ++j) {
      int n = selp[j];
      if (n >= 0) {
        for (int i = 0; i < 64; ++i) {
          int kpos = n * 64 + i;
          if (kpos <= t) {
            float s = dot64_bf(q, ksb + (size_t)kpos * 64);
            m = fmaxf(m, s);
          }
        }
      }
    }
    float l = 0.f;
#pragma unroll
    for (int d = 0; d < 64; ++d) o[d] = 0.f;
    for (int j = 0; j < 16; ++j) {
      int n = selp[j];
      if (n >= 0) {
        for (int i = 0; i < 64; ++i) {
          int kpos = n * 64 + i;
          if (kpos <= t) {
            float s = dot64_bf(q, ksb + (size_t)kpos * 64);
            float pr = expf(s - m);
            l += pr;
            axpy64_bf(o, pr, vsb + (size_t)kpos * 64);
          }
        }
      }
    }
    float sc = gate1 / l;
#pragma unroll
    for (int d = 0; d < 64; d += 4) {
      float4 v = *(float4*)(oa + d);
      v.x += sc * o[d]; v.y += sc * o[d + 1]; v.z += sc * o[d + 2]; v.w += sc * o[d + 3];
      *(float4*)(oa + d) = v;
    }
  }
  {
    const int s0 = chunk * 64;
    const int jlo = (s0 - 511 > 0) ? (s0 - 511) : 0;
    const int jhi = s0 + 63;
    float m = -INFINITY;
    for (int j = jlo; j <= jhi; ++j) {
      float s = dot64_bf(q, kwb + (size_t)j * 64);
      if (j <= t && j > t - 512) m = fmaxf(m, s);
    }
    float l = 0.f;
#pragma unroll
    for (int d = 0; d < 64; ++d) o[d] = 0.f;
    for (int j = jlo; j <= jhi; ++j) {
      float s = dot64_bf(q, kwb + (size_t)j * 64);
      float pr = (j <= t && j > t - 512) ? expf(s - m) : 0.f;
      l += pr;
      axpy64_bf(o, pr, vwb + (size_t)j * 64);
    }
    float sc = gate2 / l;
    bf16* ob = (bf16*)(p.ws + (PROBE_NSA ? OFF_CMP : OFF_ONSA)) + tok * 512 + h * 64;
#pragma unroll
    for (int d = 0; d < 64; d += 8) {
      float4 v0 = *(float4*)(oa + d);
      float4 v1 = *(float4*)(oa + d + 4);
      uint4 pk;
      pk.x = (unsigned)f2bf(v0.x + sc * o[d]) | ((unsigned)f2bf(v0.y + sc * o[d + 1]) << 16);
      pk.y = (unsigned)f2bf(v0.z + sc * o[d + 2]) | ((unsigned)f2bf(v0.w + sc * o[d + 3]) << 16);
      pk.z = (unsigned)f2bf(v1.x + sc * o[d + 4]) | ((unsigned)f2bf(v1.y + sc * o[d + 5]) << 16);
      pk.w = (unsigned)f2bf(v1.z + sc * o[d + 6]) | ((unsigned)f2bf(v1.w + sc * o[d + 7]) << 16);
      *(uint4*)(ob + d) = pk;
    }
  }
}

DEV void moba_item(const Params& p, int layer, int item) {
  const int blk = item & 63, h = (item >> 6) & 7, b = item >> 9;
  const int tid = tidx();
  const int t = blk * 256 + tid;
  const size_t tok = (size_t)b * S + t;
  const bf16* proj = (const bf16*)(p.ws + OFF_PROJ);
  float q[64];
  load_q64(q, proj + tok * PC + C_MQ + h * 64, 0.125f);
  const float* km = (const float*)(p.ws + OFF_KMEAN) + ((size_t)b * 8 + h) * 64 * 64;
  float b0 = -INFINITY, b1 = -INFINITY, b2 = -INFINITY;
  int i0 = -1, i1 = -1, i2 = -1;
  for (int n = 0; n < blk; ++n) {
    float v = dot64_f(q, km + n * 64);
    if (v > b0) { b2 = b1; i2 = i1; b1 = b0; i1 = i0; b0 = v; i0 = n; }
    else if (v > b1) { b2 = b1; i2 = i1; b1 = v; i1 = n; }
    else if (v > b2) { b2 = v; i2 = n; }
  }
  const bf16* mkb = (const bf16*)(p.ws + OFF_MKB) + ((size_t)(b * 8 + h) * S) * 64;
  const bf16* mvb = (const bf16*)(p.ws + OFF_MVB) + ((size_t)(b * 8 + h) * S) * 64;
  float m = -INFINITY;
  for (int sidx = 0; sidx < 3; ++sidx) {
    int n = (sidx == 0) ? i0 : (sidx == 1) ? i1 : i2;
    if (sidx < blk) {
      for (int i = 0; i < 256; ++i) {
        float s = dot64_bf(q, mkb + (size_t)(n * 256 + i) * 64);
        m = fmaxf(m, s);
      }
    }
  }
  for (int i = 0; i < 256; ++i) {
    int kpos = blk * 256 + i;
    float s = dot64_bf(q, mkb + (size_t)kpos * 64);
    if (kpos <= t) m = fmaxf(m, s);
  }
  float l = 0.f;
  float o[64];
#pragma unroll
  for (int d = 0; d < 64; ++d) o[d] = 0.f;
  for (int sidx = 0; sidx < 3; ++sidx) {
    int n = (sidx == 0) ? i0 : (sidx == 1) ? i1 : i2;
    if (sidx < blk) {
      for (int i = 0; i < 256; ++i) {
        const size_t ko = (size_t)(n * 256 + i) * 64;
        float s = dot64_bf(q, mkb + ko);
        float pr = expf(s - m);
        l += pr;
        axpy64_bf(o, pr, mvb + ko);
      }
    }
  }
  for (int i = 0; i < 256; ++i) {
    int kpos = blk * 256 + i;
    const size_t ko = (size_t)kpos * 64;
    float s = dot64_bf(q, mkb + ko);
    float pr = (kpos <= t) ? expf(s - m) : 0.f;
    l += pr;
    axpy64_bf(o, pr, mvb + ko);
  }
  const float il = 1.f / l;
  bf16* ob = (bf16*)(p.ws + (PROBE_MOBA ? OFF_CMP : OFF_OMOBA)) + tok * 512 + h * 64;
#pragma unroll
  for (int d = 0; d < 64; d += 8) {
    uint4 pk;
    pk.x = (unsigned)f2bf(o[d] * il) | ((unsigned)f2bf(o[d + 1] * il) << 16);
    pk.y = (unsigned)f2bf(o[d + 2] * il) | ((unsigned)f2bf(o[d + 3] * il) << 16);
    pk.z = (unsigned)f2bf(o[d + 4] * il) | ((unsigned)f2bf(o[d + 5] * il) << 16);
    pk.w = (unsigned)f2bf(o[d + 6] * il) | ((unsigned)f2bf(o[d + 7] * il) << 16);
    *(uint4*)(ob + d) = pk;
  }
}

typedef short v4i16_t __attribute__((ext_vector_type(4)));
typedef unsigned u32x4_t __attribute__((ext_vector_type(4)));
DEV v4i16_t lds_tr16(const bf16* p) {
  return __builtin_amdgcn_ds_read_tr16_b64_v4i16((__attribute__((address_space(3))) v4i16_t*)p);
}
DEV unsigned cvtpk(float lo, float hi) { return cvtpk_(lo, hi); }
#define MFMA16(a, b, c) __builtin_amdgcn_mfma_f32_16x16x32_bf16(a, b, c, 0, 0, 0)
constexpr float C2 = 0.125f * 1.4426950408889634f;
constexpr int KT_LD = 72;
constexpr int KT_ELEMS = 64 * KT_LD;

template <int NI>
struct AttnSt {
  f32x4 o[4][NI];
  float m[NI], l[NI];
};
template <int NI>
DEV void attn_init(AttnSt<NI>& st) {
#pragma unroll
  for (int ni = 0; ni < NI; ++ni) {
    st.m[ni] = -INFINITY;
    st.l[ni] = 0.f;
#pragma unroll
    for (int di = 0; di < 4; ++di) st.o[di][ni] = f32x4{0.f, 0.f, 0.f, 0.f};
  }
}
#define TILE_DECL uint4 tl_k0, tl_k1, tl_v0, tl_v1
#define TILE_GLOAD(kb, vb, ld, key0)                                                        \
  do {                                                                                      \
    const int r_ = tidx() >> 3, c_ = (tidx() & 7) * 8;                            \
    tl_k0 = *(const uint4*)((kb) + (size_t)((key0) + r_) * (ld) + c_);                      \
    tl_k1 = *(const uint4*)((kb) + (size_t)((key0) + 32 + r_) * (ld) + c_);                 \
    tl_v0 = *(const uint4*)((vb) + (size_t)((key0) + r_) * (ld) + c_);                      \
    tl_v1 = *(const uint4*)((vb) + (size_t)((key0) + 32 + r_) * (ld) + c_);                 \
  } while (0)
#define TILE_SSTORE(Ks_, Vs_)                                                               \
  do {                                                                                      \
    const int r_ = tidx() >> 3, c_ = (tidx() & 7) * 8;                            \
    *(uint4*)((Ks_) + r_ * KT_LD + c_) = tl_k0;                                             \
    *(uint4*)((Ks_) + (32 + r_) * KT_LD + c_) = tl_k1;                                      \
    *(uint4*)((Vs_) + r_ * KT_LD + c_) = tl_v0;                                             \
    *(uint4*)((Vs_) + (32 + r_) * KT_LD + c_) = tl_v1;                                      \
  } while (0)
#define TL_GLOAD(P, kb, vb, ld, key0)                                                       \
  do {                                                                                      \
    const int r_ = tidx() >> 3, c_ = (tidx() & 7) * 8;                                      \
    P##_k0 = *(const uint4*)((kb) + (size_t)((key0) + r_) * (ld) + c_);                     \
    P##_k1 = *(const uint4*)((kb) + (size_t)((key0) + 32 + r_) * (ld) + c_);                \
    P##_v0 = *(const uint4*)((vb) + (size_t)((key0) + r_) * (ld) + c_);                     \
    P##_v1 = *(const uint4*)((vb) + (size_t)((key0) + 32 + r_) * (ld) + c_);                \
  } while (0)
#define TL_SSTORE(P, Ks_, Vs_)                                                              \
  do {                                                                                      \
    const int r_ = tidx() >> 3, c_ = (tidx() & 7) * 8;                                      \
    *(uint4*)((Ks_) + r_ * KT_LD + c_) = P##_k0;                                            \
    *(uint4*)((Ks_) + (32 + r_) * KT_LD + c_) = P##_k1;                                     \
    *(uint4*)((Vs_) + r_ * KT_LD + c_) = P##_v0;                                            \
    *(uint4*)((Vs_) + (32 + r_) * KT_LD + c_) = P##_v1;                                     \
  } while (0)
#define KV_SWEEP(kb_, vb_, ld_, nt_, KEYF, ...)                                             \
  {                                                                                         \
    uint4 tA_k0, tA_k1, tA_v0, tA_v1, tB_k0, tB_k1, tB_v0, tB_v1;                           \
    const int nt__ = (nt_);                                                                 \
    if (nt__ > 0) {                                                                         \
      TL_GLOAD(tA, kb_, vb_, ld_, KEYF(0));                                                 \
      TL_SSTORE(tA, smkv, smkv + KT_ELEMS);                                                 \
      if (nt__ > 1) TL_GLOAD(tA, kb_, vb_, ld_, KEYF(1));                                   \
    }                                                                                       \
    __syncthreads();                                                                        \
    for (int it0__ = 0; it0__ < nt__; it0__ += 2) {                                         \
      {                                                                                     \
        const int it = it0__;                                                               \
        if (it + 2 < nt__) TL_GLOAD(tB, kb_, vb_, ld_, KEYF(it + 2));                       \
        const bf16* Ks = smkv;                                                              \
        __VA_ARGS__                                                                         \
        if (it + 1 < nt__) TL_SSTORE(tA, smkv + 2 * KT_ELEMS, smkv + 3 * KT_ELEMS);         \
        __syncthreads();                                                                    \
      }                                                                                     \
      if (it0__ + 1 < nt__) {                                                               \
        const int it = it0__ + 1;                                                           \
        if (it + 2 < nt__) TL_GLOAD(tA, kb_, vb_, ld_, KEYF(it + 2));                       \
        const bf16* Ks = smkv + 2 * KT_ELEMS;                                               \
        __VA_ARGS__                                                                         \
        if (it + 1 < nt__) TL_SSTORE(tB, smkv, smkv + KT_ELEMS);                            \
        __syncthreads();                                                                    \
      }                                                                                     \
    }                                                                                       \
  }
template <int NI>
DEV void attn_scores(const bf16* Ks, const bf16x8 (&qf)[NI][2], f32x4 (&s)[4][NI]) {
  const int lane = tidx() & 63, g4 = lane >> 4, c16 = lane & 15;
#pragma unroll
  for (int mi = 0; mi < 4; ++mi) {
#pragma unroll
    for (int ni = 0; ni < NI; ++ni) s[mi][ni] = f32x4{0.f, 0.f, 0.f, 0.f};
#pragma unroll
    for (int ks = 0; ks < 2; ++ks) {
      bf16x8 kf = *(const bf16x8*)(Ks + (mi * 16 + c16) * KT_LD + ks * 32 + g4 * 8);
#pragma unroll
      for (int ni = 0; ni < NI; ++ni) s[mi][ni] = MFMA16(kf, qf[ni][ks], s[mi][ni]);
    }
  }
}
template <int NI>
DEV void attn_pv(const bf16* Vs, const bf16x8 (&pf)[NI][2], f32x4 (&o)[4][NI]) {
  const int lane = tidx() & 63, g4 = lane >> 4, q4 = (lane & 15) >> 2, p4 = lane & 3;
#pragma unroll
  for (int di = 0; di < 4; ++di) {
#pragma unroll
    for (int ks2 = 0; ks2 < 2; ++ks2) {
      v4i16_t v0 = lds_tr16(Vs + (ks2 * 32 + g4 * 4 + q4) * KT_LD + di * 16 + p4 * 4);
      v4i16_t v1 = lds_tr16(Vs + (ks2 * 32 + 16 + g4 * 4 + q4) * KT_LD + di * 16 + p4 * 4);
      bf16x8 vf = __builtin_shufflevector(v0, v1, 0, 1, 2, 3, 4, 5, 6, 7);
#pragma unroll
      for (int ni = 0; ni < NI; ++ni) o[di][ni] = MFMA16(vf, pf[ni][ks2], o[di][ni]);
    }
  }
}
DEV f32x4 scale4(const f32x4& sv, float c, float nm) {
  return __builtin_elementwise_fma(sv, f32x4{c, c, c, c}, f32x4{nm, nm, nm, nm});
}
DEV void exp4_pack(const f32x4& sv, float nm, float& ps, unsigned& w0, unsigned& w1) {
  const f32x4 t = scale4(sv, C2, nm);
  float p0 = __builtin_amdgcn_exp2f(t[0]);
  float p1 = __builtin_amdgcn_exp2f(t[1]);
  float p2 = __builtin_amdgcn_exp2f(t[2]);
  float p3 = __builtin_amdgcn_exp2f(t[3]);
  ps += (p0 + p1) + (p2 + p3);
  w0 = cvtpk(p0, p1);
  w1 = cvtpk(p2, p3);
}
template <int NI>
DEV void attn_softmax_pv(const bf16* Vs, f32x4 (&s)[4][NI], AttnSt<NI>& st) {
  bf16x8 pf[NI][2];
#pragma unroll
  for (int ni = 0; ni < NI; ++ni) {
    float mx = -INFINITY;
#pragma unroll
    for (int mi = 0; mi < 4; ++mi)
      { mx = fmaxf(fmaxf(mx, s[mi][ni][0]), s[mi][ni][1]); mx = fmaxf(fmaxf(mx, s[mi][ni][2]), s[mi][ni][3]); }
    mx = fmaxf(mx, shx(mx, 16));
    mx = fmaxf(mx, shx(mx, 32));
    const float mn = fmaxf(st.m[ni], mx);
    const float mu = (mn == -INFINITY) ? 0.f : mn;
    const float corr = __builtin_amdgcn_exp2f((st.m[ni] - mu) * C2);
    st.m[ni] = mn;
    const float nm = -mu * C2;
    float ps = 0.f;
    u32x4_t wa, wb;
    unsigned t0, t1;
    exp4_pack(s[0][ni], nm, ps, t0, t1); wa.x = t0; wa.y = t1;
    exp4_pack(s[1][ni], nm, ps, t0, t1); wa.z = t0; wa.w = t1;
    exp4_pack(s[2][ni], nm, ps, t0, t1); wb.x = t0; wb.y = t1;
    exp4_pack(s[3][ni], nm, ps, t0, t1); wb.z = t0; wb.w = t1;
    st.l[ni] = st.l[ni] * corr + ps;
#pragma unroll
    for (int di = 0; di < 4; ++di) {
      st.o[di][ni][0] *= corr; st.o[di][ni][1] *= corr; st.o[di][ni][2] *= corr; st.o[di][ni][3] *= corr;
    }
    pf[ni][0] = __builtin_bit_cast(bf16x8, wa);
    pf[ni][1] = __builtin_bit_cast(bf16x8, wb);
  }
  attn_pv<NI>(Vs, pf, st.o);
}

template <int NI>
DEV void attn_softmax_pv_act(const bf16* Vs, f32x4 (&s)[4][NI], AttnSt<NI>& st, const bool (&act)[NI]) {
  bf16x8 pf[NI][2];
#pragma unroll
  for (int ni = 0; ni < NI; ++ni) {
    pf[ni][0] = bf16x8{0, 0, 0, 0, 0, 0, 0, 0};
    pf[ni][1] = bf16x8{0, 0, 0, 0, 0, 0, 0, 0};
    if (act[ni]) {
      float mx = -INFINITY;
#pragma unroll
      for (int mi = 0; mi < 4; ++mi)
        { mx = fmaxf(fmaxf(mx, s[mi][ni][0]), s[mi][ni][1]); mx = fmaxf(fmaxf(mx, s[mi][ni][2]), s[mi][ni][3]); }
      mx = fmaxf(mx, shx(mx, 16));
      mx = fmaxf(mx, shx(mx, 32));
      const float mn = fmaxf(st.m[ni], mx);
      const float mu = (mn == -INFINITY) ? 0.f : mn;
      const float corr = __builtin_amdgcn_exp2f((st.m[ni] - mu) * C2);
      st.m[ni] = mn;
      const float nm = -mu * C2;
      float ps = 0.f;
      u32x4_t wa, wb;
      unsigned t0, t1;
      exp4_pack(s[0][ni], nm, ps, t0, t1); wa.x = t0; wa.y = t1;
      exp4_pack(s[1][ni], nm, ps, t0, t1); wa.z = t0; wa.w = t1;
      exp4_pack(s[2][ni], nm, ps, t0, t1); wb.x = t0; wb.y = t1;
      exp4_pack(s[3][ni], nm, ps, t0, t1); wb.z = t0; wb.w = t1;
      st.l[ni] = st.l[ni] * corr + ps;
#pragma unroll
      for (int di = 0; di < 4; ++di) {
        st.o[di][ni][0] *= corr; st.o[di][ni][1] *= corr; st.o[di][ni][2] *= corr; st.o[di][ni][3] *= corr;
      }
      pf[ni][0] = __builtin_bit_cast(bf16x8, wa);
      pf[ni][1] = __builtin_bit_cast(bf16x8, wb);
    }
  }
  const int lane = tidx() & 63, g4 = lane >> 4, q4 = (lane & 15) >> 2, p4 = lane & 3;
#pragma unroll
  for (int di = 0; di < 4; ++di) {
#pragma unroll
    for (int ks2 = 0; ks2 < 2; ++ks2) {
      v4i16_t v0 = lds_tr16(Vs + (ks2 * 32 + g4 * 4 + q4) * KT_LD + di * 16 + p4 * 4);
      v4i16_t v1 = lds_tr16(Vs + (ks2 * 32 + 16 + g4 * 4 + q4) * KT_LD + di * 16 + p4 * 4);
      bf16x8 vf = __builtin_shufflevector(v0, v1, 0, 1, 2, 3, 4, 5, 6, 7);
#pragma unroll
      for (int ni = 0; ni < NI; ++ni)
        if (act[ni]) st.o[di][ni] = MFMA16(vf, pf[ni][ks2], st.o[di][ni]);
    }
  }
}
template <int NI>
DEV int gate_top1(f32x4 (&gs)[4][NI], int ni, int g4) {
  float bv = -INFINITY;
  int bi = 1 << 20;
#pragma unroll
  for (int mi = 0; mi < 4; ++mi)
#pragma unroll
    for (int r = 0; r < 4; ++r) {
      float v = gs[mi][ni][r];
      if (v > bv) { bv = v; bi = mi * 16 + g4 * 4 + r; }
    }
#pragma unroll
  for (int off = 16; off <= 32; off <<= 1) {
    float ov = shx(bv, off);
    int oi = shx(bi, off);
    if (ov > bv || (ov == bv && oi < bi)) { bv = ov; bi = oi; }
  }
#pragma unroll
  for (int mi = 0; mi < 4; ++mi)
#pragma unroll
    for (int r = 0; r < 4; ++r)
      if (mi * 16 + g4 * 4 + r == bi) gs[mi][ni][r] = -INFINITY;
  return (bv == -INFINITY) ? -1 : bi;
}
template <int NI>
DEV void moba_mfma_item(const Params& p, int item, char* smem, bf16* outbuf) {
  constexpr int QB = 64 * NI;
  bf16* sm = (bf16*)smem;
  const int bh = item & 15, cq = (S / QB - 1) - (item >> 4);
  const int b = bh >> 3, h = bh & 7;
  const int s0 = cq * QB, blk = s0 >> 8;
  const int lane = tidx() & 63, wave = tidx() >> 6, g4 = lane >> 4, c16 = lane & 15;
  const bf16* proj = (const bf16*)(p.ws + OFF_PROJ) + (size_t)b * S * PC;
  bf16x8 qf[NI][2];
  int tq[NI];
#pragma unroll
  for (int ni = 0; ni < NI; ++ni) {
    tq[ni] = s0 + wave * 16 * NI + ni * 16 + c16;
#pragma unroll
    for (int ks = 0; ks < 2; ++ks)
      qf[ni][ks] = *(const bf16x8*)(proj + (size_t)tq[ni] * PC + C_MQ + h * 64 + ks * 32 + g4 * 8);
  }
  int i0[NI], i1[NI], i2[NI];
  {
    const bf16* kmh = (const bf16*)(p.ws + OFF_KMHL) + ((size_t)(b * 8 + h) * 64) * 64;
    const bf16* kml = kmh + (size_t)2 * 8 * 64 * 64;
    f32x4 gs[4][NI];
#pragma unroll
    for (int mi = 0; mi < 4; ++mi) {
#pragma unroll
      for (int ni = 0; ni < NI; ++ni) gs[mi][ni] = f32x4{0.f, 0.f, 0.f, 0.f};
#pragma unroll
      for (int ks = 0; ks < 2; ++ks) {
        bf16x8 ah = *(const bf16x8*)(kmh + (mi * 16 + c16) * 64 + ks * 32 + g4 * 8);
        bf16x8 al_ = *(const bf16x8*)(kml + (mi * 16 + c16) * 64 + ks * 32 + g4 * 8);
#pragma unroll
        for (int ni = 0; ni < NI; ++ni) {
          gs[mi][ni] = MFMA16(ah, qf[ni][ks], gs[mi][ni]);
          gs[mi][ni] = MFMA16(al_, qf[ni][ks], gs[mi][ni]);
        }
      }
    }
#pragma unroll
    for (int ni = 0; ni < NI; ++ni) {
#pragma unroll
      for (int mi = 0; mi < 4; ++mi)
#pragma unroll
        for (int r = 0; r < 4; ++r)
          if (mi * 16 + g4 * 4 + r >= blk) gs[mi][ni][r] = -INFINITY;
      i0[ni] = gate_top1(gs, ni, g4);
      i1[ni] = gate_top1(gs, ni, g4);
      i2[ni] = gate_top1(gs, ni, g4);
    }
  }
  AttnSt<NI> st;
  attn_init<NI>(st);
  const int ntiles = (s0 + QB) >> 6;
  const bf16* kb = (const bf16*)(p.ws + OFF_MKB) + ((size_t)(b * 8 + h) * S) * 64;
  const bf16* vb = (const bf16*)(p.ws + OFF_MVB) + ((size_t)(b * 8 + h) * S) * 64;
  bf16* smkv = sm;
  __syncthreads();
#define MOBA_KEY(i) ((i) * 64)
  KV_SWEEP(kb, vb, 64, ntiles, MOBA_KEY,
    const int n = it >> 2;
    const bool own = (n == blk);
    const int kbase = it * 64;
    bool wave_active = own;
    if (!own) {
      bool anyq = false;
      _Pragma("unroll") for (int ni = 0; ni < NI; ++ni) anyq = anyq || (n == i0[ni]) || (n == i1[ni]) || (n == i2[ni]);
      wave_active = __builtin_amdgcn_ballot_w64(anyq) != 0ull;
    }
    if (wave_active) {
      f32x4 s[4][NI];
      attn_scores<NI>(Ks, qf, s);
      _Pragma("unroll") for (int ni = 0; ni < NI; ++ni) {
        if (own) {
          _Pragma("unroll") for (int mi = 0; mi < 4; ++mi)
            _Pragma("unroll") for (int r = 0; r < 4; ++r)
              if (kbase + mi * 16 + g4 * 4 + r > tq[ni]) s[mi][ni][r] = -INFINITY;
        } else {
          const bool okb = (n == i0[ni]) | (n == i1[ni]) | (n == i2[ni]);
          if (!okb) {
            _Pragma("unroll") for (int mi = 0; mi < 4; ++mi) s[mi][ni] = f32x4{-INFINITY, -INFINITY, -INFINITY, -INFINITY};
          }
        }
      }
      attn_softmax_pv<NI>(Ks + KT_ELEMS, s, st);
    }
  )
#pragma unroll
  for (int ni = 0; ni < NI; ++ni) {
    float l = st.l[ni];
    l += shx(l, 16);
    l += shx(l, 32);
    const float inv = 1.f / l;
    bf16* op = outbuf + ((size_t)b * S + tq[ni]) * 512 + h * 64 + g4 * 4;
#pragma unroll
    for (int di = 0; di < 4; ++di) {
      uint2 pk;
      pk.x = cvtpk(st.o[di][ni][0] * inv, st.o[di][ni][1] * inv);
      pk.y = cvtpk(st.o[di][ni][2] * inv, st.o[di][ni][3] * inv);
      *(uint2*)(op + di * 16) = pk;
    }
  }
}

DEV int moba_list_base(int n) { return n * S - 128 * n * (n + 1); }
template <int NI>
DEV void moba_gate_batch(const Params& p, int item0, int istride, int nitems, int* sm) {
  constexpr int QB = 64 * NI;
  constexpr int MAXB = 4;
  const int tid = tidx(), lane = tid & 63, wave = tid >> 6, g4 = lane >> 4, c16 = lane & 15;
  int* hist = sm;
  int* base = sm + MAXB * 64;
  hist[tid] = 0;
  __syncthreads();
  int sel[MAXB][NI][3], rk[MAXB][NI][3], tqs[MAXB][NI];
#pragma unroll
  for (int j = 0; j < MAXB; ++j) {
    const int item = item0 + j * istride;
    const int bh = item & 15, cq = item >> 4;
    const int b = bh >> 3, h = bh & 7;
    const int s0 = cq * QB, blk = s0 >> 8;
    const bool live = (j < nitems) && (blk > 0);
#pragma unroll
    for (int ni = 0; ni < NI; ++ni) {
      tqs[j][ni] = s0 + wave * 16 * NI + ni * 16 + c16;
#pragma unroll
      for (int k = 0; k < 3; ++k) { sel[j][ni][k] = -1; rk[j][ni][k] = 0; }
    }
    if (!live) continue;
    const bf16* proj = (const bf16*)(p.ws + OFF_PROJ) + (size_t)b * S * PC;
    bf16x8 qf[NI][2];
#pragma unroll
    for (int ni = 0; ni < NI; ++ni)
#pragma unroll
      for (int ks = 0; ks < 2; ++ks)
        qf[ni][ks] = *(const bf16x8*)(proj + (size_t)tqs[j][ni] * PC + C_MQ + h * 64 + ks * 32 + g4 * 8);
    const bf16* kmh = (const bf16*)(p.ws + OFF_KMHL) + ((size_t)(b * 8 + h) * 64) * 64;
    const bf16* kml = kmh + (size_t)2 * 8 * 64 * 64;
    f32x4 gs[4][NI];
#pragma unroll
    for (int mi = 0; mi < 4; ++mi) {
#pragma unroll
      for (int ni = 0; ni < NI; ++ni) gs[mi][ni] = f32x4{0.f, 0.f, 0.f, 0.f};
#pragma unroll
      for (int ks = 0; ks < 2; ++ks) {
        bf16x8 ah = *(const bf16x8*)(kmh + (mi * 16 + c16) * 64 + ks * 32 + g4 * 8);
        bf16x8 al_ = *(const bf16x8*)(kml + (mi * 16 + c16) * 64 + ks * 32 + g4 * 8);
#pragma unroll
        for (int ni = 0; ni < NI; ++ni) {
          gs[mi][ni] = MFMA16(ah, qf[ni][ks], gs[mi][ni]);
          gs[mi][ni] = MFMA16(al_, qf[ni][ks], gs[mi][ni]);
        }
      }
    }
#pragma unroll
    for (int ni = 0; ni < NI; ++ni) {
#pragma unroll
      for (int mi = 0; mi < 4; ++mi)
#pragma unroll
        for (int r = 0; r < 4; ++r)
          if (mi * 16 + g4 * 4 + r >= blk) gs[mi][ni][r] = -INFINITY;
#pragma unroll
      for (int k = 0; k < 3; ++k) {
        sel[j][ni][k] = gate_top1(gs, ni, g4);
        rk[j][ni][k] = (g4 == 0 && sel[j][ni][k] >= 0) ? atomicAdd(&hist[j * 64 + sel[j][ni][k]], 1) : 0;
      }
    }
  }
  __syncthreads();
  {
    const int j = tid >> 6, n = tid & 63;
    const int item = item0 + j * istride;
    const int c = hist[tid];
    int* cnt = (int*)(p.ws + OFF_MCNT) + (size_t)(item & 15) * 64 * MCNT_STRIDE;
    base[tid] = (c > 0) ? atomicAdd(cnt + n * MCNT_STRIDE, c) : 0;
  }
  __syncthreads();
  if (g4 == 0) {
#pragma unroll
    for (int j = 0; j < MAXB; ++j) {
      const int item = item0 + j * istride;
      unsigned short* lists = (unsigned short*)(p.ws + OFF_MLIST) + (size_t)(item & 15) * MLIST_PER_BH;
#pragma unroll
      for (int ni = 0; ni < NI; ++ni)
#pragma unroll
        for (int k = 0; k < 3; ++k) {
          const int sv = sel[j][ni][k];
          if (sv >= 0) lists[moba_list_base(sv) + base[j * 64 + sv] + rk[j][ni][k]] = (unsigned short)(tqs[j][ni] | (k << 14));
        }
    }
  }
  __syncthreads();
}
template <int NI>
DEV void moba_part_item(const Params& p, int b, int item, char* smem) {
  constexpr int CH = 64 * NI;
  bf16* smkv = (bf16*)smem;
  const int n = item >> 6, h = (item >> 3) & 7, part = item & 7;
  const int lane = tidx() & 63, wave = tidx() >> 6, g4 = lane >> 4, c16 = lane & 15;
  const int cnt = ((const int*)(p.ws + OFF_MCNT))[((b * 8 + h) * 64 + n) * MCNT_STRIDE];
  const unsigned short* list = (const unsigned short*)(p.ws + OFF_MLIST) + (size_t)(b * 8 + h) * MLIST_PER_BH + moba_list_base(n);
  const bf16* proj = (const bf16*)(p.ws + OFF_PROJ) + (size_t)b * S * PC;
  const bf16* kb = (const bf16*)(p.ws + OFF_MKB) + ((size_t)(b * 8 + h) * S + n * 256) * 64;
  const bf16* vb = (const bf16*)(p.ws + OFF_MVB) + ((size_t)(b * 8 + h) * S + n * 256) * 64;
  bf16* po = (bf16*)(p.ws + OFF_MPO);
  float2* pml = (float2*)(p.ws + OFF_MPML);
  for (int c = part; c * CH < cnt; c += 8) {
    bf16x8 qf[NI][2];
    int tcol[NI], slot[NI];
    bool valid[NI];
#pragma unroll
    for (int ni = 0; ni < NI; ++ni) {
      const int idx = c * CH + wave * 16 * NI + ni * 16 + c16;
      valid[ni] = idx < cnt;
      const unsigned e = list[valid[ni] ? idx : 0];
      tcol[ni] = e & 0x3FFF;
      slot[ni] = e >> 14;
#pragma unroll
      for (int ks = 0; ks < 2; ++ks)
        qf[ni][ks] = *(const bf16x8*)(proj + (size_t)tcol[ni] * PC + C_MQ + h * 64 + ks * 32 + g4 * 8);
    }
    AttnSt<NI> st;
    attn_init<NI>(st);
    __syncthreads();
#define MOBA_PKEY(i) ((i) * 64)
    KV_SWEEP(kb, vb, 64, 4, MOBA_PKEY,
      f32x4 s[4][NI];
      attn_scores<NI>(Ks, qf, s);
      attn_softmax_pv<NI>(Ks + KT_ELEMS, s, st);
    )
#pragma unroll
    for (int ni = 0; ni < NI; ++ni) {
      float l = st.l[ni];
      l += shx(l, 16);
      l += shx(l, 32);
      if (valid[ni]) {
        const size_t rec = ((size_t)h * S + tcol[ni]) * 3 + slot[ni];
        if (g4 == 0) pml[rec] = float2{st.m[ni], l};
        bf16* op = po + rec * 64 + g4 * 4;
#pragma unroll
        for (int di = 0; di < 4; ++di) {
          uint2 pk;
          pk.x = cvtpk(st.o[di][ni][0], st.o[di][ni][1]);
          pk.y = cvtpk(st.o[di][ni][2], st.o[di][ni][3]);
          *(uint2*)(op + di * 16) = pk;
        }
      }
    }
  }
}
template <int NI>
DEV void moba_part_item2(const Params& p, int b, int item, char* smem) {
  constexpr int WCH = 16 * NI;
  bf16* Kall = (bf16*)smem;
  bf16* Vall = Kall + 256 * KT_LD;
  static_assert(2 * 256 * KT_LD * 2 <= SMEM_BYTES, "moba block staging");
  constexpr int NPART = MOBA_NPART;
  const int n = item / (8 * NPART), h = (item / NPART) & 7, part = item % NPART;
  const int tid = tidx(), lane = tid & 63, wave = tid >> 6, g4 = lane >> 4, c16 = lane & 15;
  const int cnt = ((const int*)(p.ws + OFF_MCNT))[((b * 8 + h) * 64 + n) * MCNT_STRIDE];
  const bool active = part * 4 * WCH < cnt;
  const unsigned short* list = (const unsigned short*)(p.ws + OFF_MLIST) + (size_t)(b * 8 + h) * MLIST_PER_BH + moba_list_base(n);
  const bf16* proj = (const bf16*)(p.ws + OFF_PROJ) + (size_t)b * S * PC;
  const bf16* kb = (const bf16*)(p.ws + OFF_MKB) + ((size_t)(b * 8 + h) * S + n * 256) * 64;
  const bf16* vb = (const bf16*)(p.ws + OFF_MVB) + ((size_t)(b * 8 + h) * S + n * 256) * 64;
  bf16* po = (bf16*)(p.ws + OFF_MPO);
  float2* pml = (float2*)(p.ws + OFF_MPML);
  __syncthreads();
  if (active) {
#pragma unroll
    for (int i = 0; i < 8; ++i) {
      const int id = tid + 256 * i, r = id >> 3, c = (id & 7) * 8;
      const uint4 kv = *(const uint4*)(kb + (size_t)r * 64 + c);
      const uint4 vv = *(const uint4*)(vb + (size_t)r * 64 + c);
      *(uint4*)(Kall + r * KT_LD + c) = kv;
      *(uint4*)(Vall + r * KT_LD + c) = vv;
    }
  }
  __syncthreads();
  if (!active) return;
  for (int wc = part * 4 + wave; wc * WCH < cnt; wc += 4 * NPART) {
    bf16x8 qf[NI][2];
    int tcol[NI], slot[NI];
    bool valid[NI];
#pragma unroll
    for (int ni = 0; ni < NI; ++ni) {
      const int idx = wc * WCH + ni * 16 + c16;
      valid[ni] = idx < cnt;
      const unsigned e = list[valid[ni] ? idx : 0];
      tcol[ni] = e & 0x3FFF;
      slot[ni] = e >> 14;
#pragma unroll
      for (int ks = 0; ks < 2; ++ks)
        qf[ni][ks] = *(const bf16x8*)(proj + (size_t)tcol[ni] * PC + C_MQ + h * 64 + ks * 32 + g4 * 8);
    }
    AttnSt<NI> st;
    attn_init<NI>(st);
#pragma unroll 1
    for (int kt = 0; kt < 4; ++kt) {
      f32x4 s[4][NI];
      attn_scores<NI>(Kall + kt * 64 * KT_LD, qf, s);
      attn_softmax_pv<NI>(Vall + kt * 64 * KT_LD, s, st);
    }
#pragma unroll
    for (int ni = 0; ni < NI; ++ni) {
      float l = st.l[ni];
      l += shx(l, 16);
      l += shx(l, 32);
      if (valid[ni]) {
        const size_t rec = ((size_t)h * S + tcol[ni]) * 3 + slot[ni];
        if (g4 == 0) pml[rec] = float2{st.m[ni], l};
        bf16* op = po + rec * 64 + g4 * 4;
#pragma unroll
        for (int di = 0; di < 4; ++di) {
          uint2 pk;
          pk.x = cvtpk(st.o[di][ni][0], st.o[di][ni][1]);
          pk.y = cvtpk(st.o[di][ni][2], st.o[di][ni][3]);
          *(uint2*)(op + di * 16) = pk;
        }
      }
    }
  }
}
template <int NI>
DEV void moba_merge_item(const Params& p, int b, int item, char* smem, bf16* outbuf) {
  constexpr int QB = 64 * NI;
  constexpr int NCQ = S / QB;
  bf16* smkv = (bf16*)smem;
  const int h = item & 7, cq = item >> 3;
  static_assert(NCQ * 8 == 8 * (S / QB), "");
  const int s0 = cq * QB, blk = s0 >> 8;
  const int lane = tidx() & 63, wave = tidx() >> 6, g4 = lane >> 4, c16 = lane & 15;
  const bf16* proj = (const bf16*)(p.ws + OFF_PROJ) + (size_t)b * S * PC;
  bf16x8 qf[NI][2];
  int tq[NI];
#pragma unroll
  for (int ni = 0; ni < NI; ++ni) {
    tq[ni] = s0 + wave * 16 * NI + ni * 16 + c16;
#pragma unroll
    for (int ks = 0; ks < 2; ++ks)
      qf[ni][ks] = *(const bf16x8*)(proj + (size_t)tq[ni] * PC + C_MQ + h * 64 + ks * 32 + g4 * 8);
  }
  const bf16* kb = (const bf16*)(p.ws + OFF_MKB) + ((size_t)(b * 8 + h) * S) * 64;
  const bf16* vb = (const bf16*)(p.ws + OFF_MVB) + ((size_t)(b * 8 + h) * S) * 64;
  AttnSt<NI> st;
  attn_init<NI>(st);
  const int kt0 = blk * 4;
  const int ntl = ((s0 + QB - 1) >> 6) - kt0 + 1;
  __syncthreads();
#define MOBA_MKEY(i) ((kt0 + (i)) * 64)
  KV_SWEEP(kb, vb, 64, ntl, MOBA_MKEY,
    const int kbase = (kt0 + it) * 64;
    f32x4 s[4][NI];
    attn_scores<NI>(Ks, qf, s);
    if (kbase + 63 > s0) {
    _Pragma("unroll") for (int ni = 0; ni < NI; ++ni)
      _Pragma("unroll") for (int mi = 0; mi < 4; ++mi)
        _Pragma("unroll") for (int r = 0; r < 4; ++r)
          if (kbase + mi * 16 + g4 * 4 + r > tq[ni]) s[mi][ni][r] = -INFINITY;
    }
    attn_softmax_pv<NI>(Ks + KT_ELEMS, s, st);
  )
  const int nsl = (blk < 3) ? blk : 3;
  const bf16* po = (const bf16*)(p.ws + OFF_MPO);
  const float2* pml = (const float2*)(p.ws + OFF_MPML);
#pragma unroll
  for (int ni = 0; ni < NI; ++ni) {
    float l = st.l[ni];
    l += shx(l, 16);
    l += shx(l, 32);
    const size_t rec0 = ((size_t)h * S + tq[ni]) * 3;
    float ms[3], ls[3];
    float M = st.m[ni];
#pragma unroll
    for (int s = 0; s < 3; ++s) {
      ms[s] = -INFINITY;
      ls[s] = 0.f;
      if (s < nsl) {
        const float2 v = pml[rec0 + s];
        ms[s] = v.x;
        ls[s] = v.y;
        M = fmaxf(M, v.x);
      }
    }
    const float fo = __builtin_amdgcn_exp2f((st.m[ni] - M) * C2);
    l *= fo;
    float f[3];
#pragma unroll
    for (int s = 0; s < 3; ++s) {
      f[s] = (s < nsl) ? __builtin_amdgcn_exp2f((ms[s] - M) * C2) : 0.f;
      l += ls[s] * f[s];
    }
    const float inv = 1.f / l;
    bf16* op = outbuf + ((size_t)b * S + tq[ni]) * ATT_LD + h * 64 + g4 * 4;
#pragma unroll
    for (int di = 0; di < 4; ++di) {
      float o0 = st.o[di][ni][0] * fo, o1 = st.o[di][ni][1] * fo, o2 = st.o[di][ni][2] * fo, o3 = st.o[di][ni][3] * fo;
#pragma unroll
      for (int s = 0; s < 3; ++s) {
        if (s < nsl) {
          const uint2 pv = *(const uint2*)(po + (rec0 + s) * 64 + di * 16 + g4 * 4);
          o0 += f[s] * __uint_as_float(pv.x << 16);
          o1 += f[s] * __uint_as_float(pv.x & 0xffff0000u);
          o2 += f[s] * __uint_as_float(pv.y << 16);
          o3 += f[s] * __uint_as_float(pv.y & 0xffff0000u);
        }
      }
      uint2 pk;
      pk.x = cvtpk(o0 * inv, o1 * inv);
      pk.y = cvtpk(o2 * inv, o3 * inv);
      *(uint2*)(op + di * 16) = pk;
    }
  }
}

template <int NI>
DEV void attn_stats(f32x4 (&s)[4][NI], float (&m)[NI], float (&l)[NI]) {
#pragma unroll
  for (int ni = 0; ni < NI; ++ni) {
    float mx = -INFINITY;
#pragma unroll
    for (int mi = 0; mi < 4; ++mi)
      { mx = fmaxf(fmaxf(mx, s[mi][ni][0]), s[mi][ni][1]); mx = fmaxf(fmaxf(mx, s[mi][ni][2]), s[mi][ni][3]); }
    mx = fmaxf(mx, shx(mx, 16));
    mx = fmaxf(mx, shx(mx, 32));
    const float mn = fmaxf(m[ni], mx);
    const float mu = (mn == -INFINITY) ? 0.f : mn;
    const float corr = __builtin_amdgcn_exp2f((m[ni] - mu) * C2);
    m[ni] = mn;
    const float nm = -mu * C2;
    float ps = 0.f;
#pragma unroll
    for (int mi = 0; mi < 4; ++mi)
#pragma unroll
      for (int r = 0; r < 4; ++r) ps += __builtin_amdgcn_exp2f(__builtin_fmaf(s[mi][ni][r], C2, nm));
    l[ni] = l[ni] * corr + ps;
  }
}
DEV bf16x8 rope_frag(bf16x8 qv, const float* __restrict__ rope_t, int g4) {
  u32x4_t w = __builtin_bit_cast(u32x4_t, qv);
  u32x4_t pw;
  pw.x = shx(w.x, 16); pw.y = shx(w.y, 16); pw.z = shx(w.z, 16); pw.w = shx(w.w, 16);
  float f[8], pf[8];
  unpack8(uint4{w.x, w.y, w.z, w.w}, f);
  unpack8(uint4{pw.x, pw.y, pw.z, pw.w}, pf);
  const float4 c0 = *(const float4*)(rope_t), c1 = *(const float4*)(rope_t + 4);
  const float4 s0 = *(const float4*)(rope_t + 8), s1 = *(const float4*)(rope_t + 12);
  const float cs[8] = {c0.x, c0.y, c0.z, c0.w, c1.x, c1.y, c1.z, c1.w};
  const float sn[8] = {s0.x, s0.y, s0.z, s0.w, s1.x, s1.y, s1.z, s1.w};
  const float sg = (g4 == 0) ? -1.f : 1.f;
  float o[8];
#pragma unroll
  for (int i = 0; i < 8; ++i) o[i] = (g4 < 2) ? (f[i] * cs[i] + sg * pf[i] * sn[i]) : f[i];
  u32x4_t r;
  r.x = cvtpk(o[0], o[1]); r.y = cvtpk(o[2], o[3]); r.z = cvtpk(o[4], o[5]); r.w = cvtpk(o[6], o[7]);
  return __builtin_bit_cast(bf16x8, r);
}

DEV unsigned pack4_fp8q(float a, float b, float c, float d) {
  int q = __builtin_amdgcn_cvt_pk_fp8_f32(a, b, 0, false);
  q = __builtin_amdgcn_cvt_pk_fp8_f32(c, d, q, true);
  return (unsigned)q;
}
DEV float amax8_bf16(uint4 v, float m) {
  float f[8];
  unpack8(v, f);
#pragma unroll
  for (int i = 0; i < 8; ++i) m = fmaxf(m, fabsf(f[i]));
  return m;
}
DEV void kvamax_item(const Params& p, int layer, int item) {
  const int tid = tidx();
  const int bk = item >> 6, part = item & 63;
  const bf16* kp = (const bf16*)(p.ws + OFF_KSB) + ((size_t)bk * S + part * 256) * 64 + tid * 64;
  const bf16* vp = (const bf16*)(p.ws + OFF_VSB) + ((size_t)bk * S + part * 256) * 64 + tid * 64;
  float mk = 0.f, mv = 0.f;
#pragma unroll
  for (int i = 0; i < 8; ++i) {
    mk = amax8_bf16(*(const uint4*)(kp + i * 8), mk);
    mv = amax8_bf16(*(const uint4*)(vp + i * 8), mv);
  }
#pragma unroll
  for (int o = 32; o >= 1; o >>= 1) { mk = fmaxf(mk, shx(mk, o)); mv = fmaxf(mv, shx(mv, o)); }
  if ((tid & 63) == 0) {
    atomicMax((unsigned*)(p.ws + OFF_BAR) + 2 + 2 * layer, (unsigned)__float_as_int(mk));
    atomicMax((unsigned*)(p.ws + OFF_BAR) + 3 + 2 * layer, (unsigned)__float_as_int(mv));
  }
}
DEV float kv_amax(const Params& p, int layer, int which) {
  return __int_as_float((int)__hip_atomic_load((const unsigned*)(p.ws + OFF_BAR) + 2 + 2 * layer + which, __ATOMIC_RELAXED, __HIP_MEMORY_SCOPE_AGENT));
}
DEV void kvq_item(const Params& p, int layer, int item, float* sm) {
  const int tid = tidx();
  const int bk = item >> 8, blk = item & 255;
  const float ak = kv_amax(p, layer, 0), av = kv_amax(p, layer, 1);
  const float ik = (ak > 0.f) ? 224.f / ak : 0.f, iv = (av > 0.f) ? 224.f / av : 0.f;
  const size_t row0 = (size_t)bk * S + blk * 64;
  {
    const int r = tid >> 2, q = tid & 3;
    const bf16* kp = (const bf16*)(p.ws + OFF_KSB) + (row0 + r) * 64 + q * 16;
    float f[16];
    unpack8(*(const uint4*)kp, f);
    unpack8(*(const uint4*)(kp + 8), f + 8);
    uint2 o0, o1;
    o0.x = pack4_fp8q(f[0] * ik, f[1] * ik, f[2] * ik, f[3] * ik);
    o0.y = pack4_fp8q(f[4] * ik, f[5] * ik, f[6] * ik, f[7] * ik);
    o1.x = pack4_fp8q(f[8] * ik, f[9] * ik, f[10] * ik, f[11] * ik);
    o1.y = pack4_fp8q(f[12] * ik, f[13] * ik, f[14] * ik, f[15] * ik);
    unsigned char* kd = (unsigned char*)(p.ws + OFF_KS8) + (row0 + r) * 64 + 32 * (q & 1) + 8 * (q >> 1);
    *(uint2*)kd = o0;
    *(uint2*)(kd + 16) = o1;
    const bf16* vp = (const bf16*)(p.ws + OFF_VSB) + (row0 + r) * 64 + q * 16;
    unpack8(*(const uint4*)vp, f);
    unpack8(*(const uint4*)(vp + 8), f + 8);
#pragma unroll
    for (int i = 0; i < 16; ++i) sm[r * 65 + q * 16 + i] = f[i] * iv;
  }
  __syncthreads();
  {
    const int d = tid >> 2, q = tid & 3;
    float f[16];
#pragma unroll
    for (int i = 0; i < 16; ++i) {
      const int g4 = q, ks2 = i >> 3, j = i & 7;
      const int key = 32 * ks2 + 16 * (j >> 2) + 4 * g4 + (j & 3);
      f[i] = sm[key * 65 + d];
    }
    uint4 o;
    o.x = pack4_fp8q(f[0], f[1], f[2], f[3]);
    o.y = pack4_fp8q(f[4], f[5], f[6], f[7]);
    o.z = pack4_fp8q(f[8], f[9], f[10], f[11]);
    o.w = pack4_fp8q(f[12], f[13], f[14], f[15]);
    *(uint4*)((unsigned char*)(p.ws + OFF_VT8) + row0 * 64 + d * 64 + q * 16) = o;
  }
  __syncthreads();
}
typedef long i64_t;
#define MFMA8(a, b, c) __builtin_amdgcn_mfma_f32_16x16x32_fp8_fp8(a, b, c, 0, 0, 0)
template <int NI>
DEV void softmax_one8(f32x4 (&s)[4], AttnSt<NI>& st, f32x4& lacc, int ni, float c2, bool sel, i64_t& pf0, i64_t& pf1) {
  float mx = -INFINITY;
#pragma unroll
  for (int mi = 0; mi < 4; ++mi)
    { mx = fmaxf(fmaxf(mx, s[mi][0]), s[mi][1]); mx = fmaxf(fmaxf(mx, s[mi][2]), s[mi][3]); }
  mx = fmaxf(mx, shx(mx, 16));
  mx = fmaxf(mx, shx(mx, 32));
  const float mxs = sel ? mx * c2 : -INFINITY;
  if (__builtin_amdgcn_ballot_w64(mxs > st.m[ni] + 1.0f) != 0ull) {
    const float mn = fmaxf(st.m[ni], mxs);
    const float mu = (mn == -INFINITY) ? 0.f : mn;
    const float corr = __builtin_amdgcn_exp2f(st.m[ni] - mu);
    st.m[ni] = mn;
    lacc[0] *= corr; lacc[1] *= corr; lacc[2] *= corr; lacc[3] *= corr;
#pragma unroll
    for (int di = 0; di < 4; ++di) {
      st.o[di][ni][0] *= corr; st.o[di][ni][1] *= corr; st.o[di][ni][2] *= corr; st.o[di][ni][3] *= corr;
    }
  }
  const float nm = (sel && st.m[ni] > -INFINITY) ? 7.f - st.m[ni] : -INFINITY;
  unsigned w[4];
#pragma unroll
  for (int mi = 0; mi < 4; ++mi) {
    const f32x4 t = scale4(s[mi], c2, nm);
    const float p0 = __builtin_amdgcn_exp2f(t[0]);
    const float p1 = __builtin_amdgcn_exp2f(t[1]);
    const float p2 = __builtin_amdgcn_exp2f(t[2]);
    const float p3 = __builtin_amdgcn_exp2f(t[3]);
    w[mi] = pack4_fp8q(p0, p1, p2, p3);
  }
  pf0 = (i64_t)(((unsigned long long)w[1] << 32) | (unsigned long long)w[0]);
  pf1 = (i64_t)(((unsigned long long)w[3] << 32) | (unsigned long long)w[2]);
  const i64_t ones = 0x3838383838383838ll;
  lacc = MFMA8(ones, pf0, lacc);
  lacc = MFMA8(ones, pf1, lacc);
}
template <int NI>
DEV void nsa_item(const Params& p, int layer, int item, char* smem, bf16* outbuf) {
  constexpr int QN = 16 * NI;
  constexpr int NCH = S / QN;
  bf16* smkv = (bf16*)smem;
  float* imp = (float*)(smem + 36864);
  int* sel = (int*)(smem + 36864 + QN * 257 * 4);
  unsigned* bmq = (unsigned*)(sel + QN * 16);
  unsigned* bmu = bmq + QN * 8;
  int* ulist = (int*)(bmu + 4 * NI * 8);
  static_assert(36864 + QN * 257 * 4 + QN * 16 * 4 + QN * 8 * 4 + 4 * NI * 8 * 4 + 257 * 4 <= SMEM_BYTES, "nsa lds");
  static_assert(NI == 2, "per-wave union bitmaps use bmu[8 .. 40)");
  const int tid = tidx(), lane = tid & 63, wave = tid >> 6, g4 = lane >> 4, c16 = lane & 15;
  const int bk = item & 3, cq = (NCH - 1) - (item >> 2);
  const int b = bk >> 1, kvh = bk & 1;
  const int s0 = cq * QN, cur = s0 >> 6;
  if (PROBE_NSA && b == 1) return;
  const bf16* proj = (const bf16*)(p.ws + OFF_PROJ) + (size_t)b * S * PC;
  const float* rope = (const float*)(p.ws + OFF_ROPE);
  int tq[NI], qlv[NI];
  float gate0[NI], gate1[NI], gate2[NI];
  bf16x8 qraw[NI][2], qrot[NI][2];
#pragma unroll
  for (int ni = 0; ni < NI; ++ni) {
    const int R = wave * 16 * NI + ni * 16 + c16;
    qlv[ni] = R >> 2;
    const int g = R & 3;
    tq[ni] = s0 + qlv[ni];
    const bf16* qp = proj + (size_t)tq[ni] * PC + C_NQ + (kvh * 4 + g) * 64 + g4 * 8;
    qraw[ni][0] = *(const bf16x8*)(qp);
    qraw[ni][1] = *(const bf16x8*)(qp + 32);
    qrot[ni][0] = rope_frag(qraw[ni][0], rope + (size_t)tq[ni] * 16, g4);
    qrot[ni][1] = qraw[ni][1];
    const bf16* gp = proj + (size_t)tq[ni] * PC + C_NG + (kvh * 4 + g) * 3;
    gate0[ni] = (!PROBE_NSA || (PROBE_NSA & 1)) ? sigmoidf_(bf2f(gp[0])) : 0.f;
    gate1[ni] = (!PROBE_NSA || (PROBE_NSA & 2)) ? sigmoidf_(bf2f(gp[1])) : 0.f;
    gate2[ni] = (!PROBE_NSA || (PROBE_NSA & 4)) ? sigmoidf_(bf2f(gp[2])) : 0.f;
  }
  for (int i = tid; i < QN * 257; i += 256) imp[i] = 0.f;
  for (int i = tid; i < QN * 8 + 4 * NI * 8; i += 256) bmq[i] = 0u;
  f32x4 acc[4][NI];
#pragma unroll
  for (int ni = 0; ni < NI; ++ni)
#pragma unroll
    for (int di = 0; di < 4; ++di) acc[di][ni] = f32x4{0.f, 0.f, 0.f, 0.f};
  TILE_DECL;
  {
    int nv[NI];
#pragma unroll
    for (int ni = 0; ni < NI; ++ni) nv[ni] = (tq[ni] >= 31) ? (((tq[ni] - 31) >> 4) + 1) : 0;
    const int tlast = s0 + QN - 1;
    const int nvmax = (tlast >= 31) ? (((tlast - 31) >> 4) + 1) : 0;
    const int nvmin = (s0 >= 31) ? (((s0 - 31) >> 4) + 1) : 0;
    const int ntc = (nvmax + 63) >> 6;
    const bf16* kb = (const bf16*)(p.ws + OFF_KCB) + ((size_t)(b * 2 + kvh) * 1024) * 64;
    const bf16* vb = (const bf16*)(p.ws + OFF_VCB) + ((size_t)(b * 2 + kvh) * 1024) * 64;
    float mA[NI], lA[NI];
#pragma unroll
    for (int ni = 0; ni < NI; ++ni) { mA[ni] = -INFINITY; lA[ni] = 0.f; }
    __syncthreads();
    if (ntc > 0) {
      for (int rep_ = 0; rep_ < ((REP_NSA_PART & 1) ? 2 : 1); ++rep_) {
#pragma unroll
      for (int ni = 0; ni < NI; ++ni) { mA[ni] = -INFINITY; lA[ni] = 0.f; }
      TILE_GLOAD(kb, vb, 64, 0);
      TILE_SSTORE(smkv, smkv + KT_ELEMS);
      __syncthreads();
      for (int kt = 0; kt < ntc; ++kt) {
        if (kt + 1 < ntc) TILE_GLOAD(kb, vb, 64, (kt + 1) * 64);
        const bf16* Ks = smkv + (kt & 1) * 2 * KT_ELEMS;
        f32x4 s[4][NI];
        attn_scores<NI>(Ks, qraw, s);
        if (kt * 64 + 63 >= nvmin) {
#pragma unroll
        for (int ni = 0; ni < NI; ++ni)
#pragma unroll
          for (int mi = 0; mi < 4; ++mi)
#pragma unroll
            for (int r = 0; r < 4; ++r)
              if (kt * 64 + mi * 16 + g4 * 4 + r >= nv[ni]) s[mi][ni][r] = -INFINITY;
        }
        attn_stats<NI>(s, mA, lA);
        if (kt + 1 < ntc) {
          bf16* Kn = smkv + ((kt + 1) & 1) * 2 * KT_ELEMS;
          TILE_SSTORE(Kn, Kn + KT_ELEMS);
        }
        __syncthreads();
      }
      }
      float nmB[NI];
#pragma unroll
      for (int ni = 0; ni < NI; ++ni) {
        float l = lA[ni];
        l += shx(l, 16);
        l += shx(l, 32);
        nmB[ni] = (l > 0.f) ? -(mA[ni] * C2 + __builtin_amdgcn_logf(l)) : 0.f;
      }
      TILE_GLOAD(kb, vb, 64, 0);
      TILE_SSTORE(smkv, smkv + KT_ELEMS);
      __syncthreads();
      for (int kt = 0; kt < ntc; ++kt) {
        if (kt + 1 < ntc) TILE_GLOAD(kb, vb, 64, (kt + 1) * 64);
        const bf16* Ks = smkv + (kt & 1) * 2 * KT_ELEMS;
        f32x4 s[4][NI];
        attn_scores<NI>(Ks, qraw, s);
        bf16x8 pf[NI][2];
#pragma unroll
        for (int ni = 0; ni < NI; ++ni) {
          u32x4_t wa, wb;
          const bool fullB = (kt * 64 + 63 < nvmin);
          float* irow = imp + qlv[ni] * 257 + kt * 16 + g4;
#pragma unroll
          for (int mi = 0; mi < 4; ++mi) {
            float pr[4];
#pragma unroll
            for (int r = 0; r < 4; ++r) {
              const bool ok = fullB || (kt * 64 + mi * 16 + g4 * 4 + r) < nv[ni];
              pr[r] = ok ? __builtin_amdgcn_exp2f(__builtin_fmaf(s[mi][ni][r], C2, nmB[ni])) : 0.f;
            }
            float mainv = pr[0] + pr[1] + pr[2] + 0.5f * pr[3];
            float spv = 0.5f * pr[3];
            mainv += shx(mainv, 1);
            mainv += shx(mainv, 2);
            spv += shx(spv, 1);
            spv += shx(spv, 2);
            if ((c16 & 3) == 0) {
              atomicAdd(irow + mi * 4, mainv);
              atomicAdd(irow + mi * 4 + 1, spv);
            }
            const unsigned w0 = cvtpk(pr[0], pr[1]), w1 = cvtpk(pr[2], pr[3]);
            if (mi == 0) { wa.x = w0; wa.y = w1; }
            if (mi == 1) { wa.z = w0; wa.w = w1; }
            if (mi == 2) { wb.x = w0; wb.y = w1; }
            if (mi == 3) { wb.z = w0; wb.w = w1; }
          }
          pf[ni][0] = __builtin_bit_cast(bf16x8, wa);
          pf[ni][1] = __builtin_bit_cast(bf16x8, wb);
        }
        attn_pv<NI>(Ks + KT_ELEMS, pf, acc);
        if (kt + 1 < ntc) {
          bf16* Kn = smkv + ((kt + 1) & 1) * 2 * KT_ELEMS;
          TILE_SSTORE(Kn, Kn + KT_ELEMS);
        }
        __syncthreads();
      }
    }
#pragma unroll
    for (int ni = 0; ni < NI; ++ni)
#pragma unroll
      for (int di = 0; di < 4; ++di) {
        acc[di][ni][0] *= gate0[ni]; acc[di][ni][1] *= gate0[ni]; acc[di][ni][2] *= gate0[ni]; acc[di][ni][3] *= gate0[ni];
      }
  }
  __syncthreads();
#if PROBE_NSA == 8
  if (b == 0 && kvh == 0)
    for (int i = tid; i < QN * 256; i += 256)
      ((float*)(p.ws + OFF_OMOBA))[(size_t)S * 256 + (size_t)(s0 + (i >> 8)) * 256 + (i & 255)] = imp[(i >> 8) * 257 + (i & 255)];
  __syncthreads();
#endif
#ifndef NSA_SEL_PAR
#define NSA_SEL_PAR 1
#endif
#if NSA_SEL_PAR
  static_assert(NI == 2, "one 8-lane group per query");
  if (cur >= 16) {
    const int qg = lane >> 3, j8 = lane & 7;
    const int qlg = wave * 4 * NI + qg;
    const float* row = imp + qlg * 257;
    unsigned key[32];
#pragma unroll
    for (int i = 0; i < 32; ++i) {
      const int n = j8 + 8 * i;
      const unsigned bits = (unsigned)__float_as_int(row[n]);
      key[i] = (n >= 1 && n <= cur - 2) ? ((bits & 0xFFFFFF00u) | (unsigned)(255 - n)) : 0u;
    }
    if (j8 == 0) { sel[qlg * 16 + 0] = 0; sel[qlg * 16 + 1] = cur - 1; sel[qlg * 16 + 2] = cur; }
#pragma unroll 1
    for (int rd = 3; rd < 16; ++rd) {
      unsigned m = 0u;
#pragma unroll
      for (int i = 0; i < 32; ++i) m = (key[i] > m) ? key[i] : m;
      { const unsigned o = (unsigned)__builtin_amdgcn_update_dpp(0, (int)m, 0xB1, 0xF, 0xF, true); m = o > m ? o : m; }
      { const unsigned o = (unsigned)__builtin_amdgcn_update_dpp(0, (int)m, 0x4E, 0xF, 0xF, true); m = o > m ? o : m; }
      { const unsigned o = (unsigned)__builtin_amdgcn_update_dpp(0, (int)m, 0x141, 0xF, 0xF, true); m = o > m ? o : m; }
      if (j8 == 0) sel[qlg * 16 + rd] = 255 - (int)(m & 255u);
#pragma unroll
      for (int i = 0; i < 32; ++i) key[i] = (key[i] == m) ? 0u : key[i];
    }
  }
#endif
  for (int qq = 0; qq < 4 * NI; ++qq) {
    const int ql = wave * 4 * NI + qq;
    int mysel = -1;
    if (cur < 16) {
      mysel = (lane <= cur) ? lane : -1;
    } else if (NSA_SEL_PAR) {
      mysel = (lane < 16) ? sel[ql * 16 + lane] : -1;
    } else {
      const float* row = imp + ql * 257;
      float v0 = row[lane], v1 = row[64 + lane], v2 = row[128 + lane], v3 = row[192 + lane];
      if (lane < 1 || lane > cur - 2) v0 = -1.f;
      if (64 + lane > cur - 2) v1 = -1.f;
      if (128 + lane > cur - 2) v2 = -1.f;
      if (192 + lane > cur - 2) v3 = -1.f;
      if (lane == 0) mysel = 0;
      if (lane == 1) mysel = cur - 1;
      if (lane == 2) mysel = cur;
      for (int rd = 3; rd < 16; ++rd) {
        float bv = v0;
        int bi = lane;
        if (v1 > bv) { bv = v1; bi = 64 + lane; }
        if (v2 > bv) { bv = v2; bi = 128 + lane; }
        if (v3 > bv) { bv = v3; bi = 192 + lane; }
#pragma unroll
        for (int off = 32; off >= 1; off >>= 1) {
          float ov = shx(bv, off);
          int oi = shx(bi, off);
          if (ov > bv || (ov == bv && oi < bi)) { bv = ov; bi = oi; }
        }
        if (lane == rd) mysel = bi;
        if ((bi & 63) == lane) {
          const int k = bi >> 6;
          if (k == 0) v0 = -2.f; else if (k == 1) v1 = -2.f; else if (k == 2) v2 = -2.f; else v3 = -2.f;
        }
      }
    }
#if PROBE_NSA == 2
    mysel = (lane < 16) ? ((const int*)(p.ws + OFF_SEL))[(((size_t)b * 2 + kvh) * S + s0 + ql) * 16 + lane] : -1;
#endif
#if PROBE_NSA == 8
    if (lane < 16 && b == 0 && kvh == 0) ((int*)(p.ws + OFF_CMP))[(size_t)(s0 + ql) * 16 + lane] = mysel;
#endif
    if (lane < 16) {
      sel[ql * 16 + lane] = mysel;
      if (mysel >= 0) {
        atomicOr(&bmq[ql * 8 + (mysel >> 5)], 1u << (mysel & 31));
        atomicOr(&bmu[mysel >> 5], 1u << (mysel & 31));
        atomicOr(&bmu[8 + wave * 8 + (mysel >> 5)], 1u << (mysel & 31));
      }
    }
  }
  __syncthreads();
  {
    const int n = tid;
    const unsigned wv = bmu[n >> 5];
    if ((wv >> (n & 31)) & 1u) {
      int pos = __builtin_popcount(wv & ((1u << (n & 31)) - 1u));
      for (int w = 0; w < (n >> 5); ++w) pos += __builtin_popcount(bmu[w]);
      ulist[pos] = n;
    }
    if (tid == 0) {
      int c = 0;
      for (int w = 0; w < 8; ++w) c += __builtin_popcount(bmu[w]);
      ulist[256] = c;
    }
  }
  __syncthreads();
  {
    AttnSt<NI> st;
    attn_init<NI>(st);
    const int klo = (s0 - 511 > 0) ? (s0 - 511) : 0;
    const int kt0 = klo >> 6, kt1 = (s0 + QN - 1) >> 6;
    const bf16* kb = (const bf16*)(p.ws + OFF_KWB) + ((size_t)(b * 2 + kvh) * S) * 64;
    const bf16* vb = (const bf16*)(p.ws + OFF_VWB) + ((size_t)(b * 2 + kvh) * S) * 64;
    for (int rep_ = 0; rep_ < ((REP_NSA_PART & 2) ? 2 : 1); ++rep_) {
    attn_init<NI>(st);
    TILE_GLOAD(kb, vb, 64, kt0 * 64);
    TILE_SSTORE(smkv, smkv + KT_ELEMS);
    __syncthreads();
    for (int kt = kt0; kt <= kt1; ++kt) {
      if (kt + 1 <= kt1) TILE_GLOAD(kb, vb, 64, (kt + 1) * 64);
      const bf16* Ks = smkv + ((kt - kt0) & 1) * 2 * KT_ELEMS;
      f32x4 s[4][NI];
      attn_scores<NI>(Ks, qrot, s);
      if (kt == kt0 || kt == kt1) {
#pragma unroll
      for (int ni = 0; ni < NI; ++ni)
#pragma unroll
        for (int mi = 0; mi < 4; ++mi)
#pragma unroll
          for (int r = 0; r < 4; ++r) {
            const int key = kt * 64 + mi * 16 + g4 * 4 + r;
            if (key > tq[ni] || key <= tq[ni] - 512) s[mi][ni][r] = -INFINITY;
          }
      }
      attn_softmax_pv<NI>(Ks + KT_ELEMS, s, st);
      if (kt + 1 <= kt1) {
        bf16* Kn = smkv + ((kt + 1 - kt0) & 1) * 2 * KT_ELEMS;
        TILE_SSTORE(Kn, Kn + KT_ELEMS);
      }
      __syncthreads();
    }
    }
#pragma unroll
    for (int ni = 0; ni < NI; ++ni) {
      float l = st.l[ni];
      l += shx(l, 16);
      l += shx(l, 32);
      const float sc = gate2[ni] / l;
#pragma unroll
      for (int di = 0; di < 4; ++di) {
        acc[di][ni][0] += sc * st.o[di][ni][0]; acc[di][ni][1] += sc * st.o[di][ni][1];
        acc[di][ni][2] += sc * st.o[di][ni][2]; acc[di][ni][3] += sc * st.o[di][ni][3];
      }
    }
  }
  {
    float* accs = imp + tid;
#pragma unroll
    for (int ni = 0; ni < NI; ++ni)
#pragma unroll
      for (int di = 0; di < 4; ++di)
#pragma unroll
        for (int r = 0; r < 4; ++r) accs[((ni * 4 + di) * 4 + r) * 256] = acc[di][ni][r];
    AttnSt<NI> st;
    attn_init<NI>(st);
    const bf16* kb = (const bf16*)(p.ws + OFF_KSB) + ((size_t)(b * 2 + kvh) * S) * 64;
    const bf16* vb = (const bf16*)(p.ws + OFF_VSB) + ((size_t)(b * 2 + kvh) * S) * 64;
#ifndef NSA_SEL_WAVE
#define NSA_SEL_WAVE 1
#endif
#if NSA_SEL_WAVE
    {
      int* wl = ulist;
      const unsigned* bw = bmu + 8 + wave * 8;
      unsigned short* wl16 = (unsigned short*)wl + wave * 128;
      int nuw = 0;
#pragma unroll
      for (int j = 0; j < 4; ++j) {
        const int nblk = j * 64 + lane;
        const bool setb = (bw[nblk >> 5] >> (nblk & 31)) & 1u;
        const unsigned long long mk = __builtin_amdgcn_ballot_w64(setb);
        if (setb) wl16[nuw + __builtin_popcountll(mk & ((1ull << lane) - 1ull))] = (unsigned short)nblk;
        nuw += __builtin_popcountll(mk);
      }
      __builtin_amdgcn_fence(__ATOMIC_RELEASE, "workgroup");
      __builtin_amdgcn_wave_barrier();
      const int layer_ = layer;
      const float kscale = kv_amax(p, layer_, 0) * (1.f / 224.f), vscale = kv_amax(p, layer_, 1) * (1.f / 224.f);
      typedef long u64x2_t __attribute__((ext_vector_type(2)));
      const unsigned char* kb8 = (const unsigned char*)(p.ws + OFF_KS8) + (size_t)(b * 2 + kvh) * S * 64 + c16 * 64 + g4 * 16;
      const unsigned char* vt8 = (const unsigned char*)(p.ws + OFF_VT8) + (size_t)(b * 2 + kvh) * S * 64 + c16 * 64 + g4 * 16;
      i64_t q8[NI][2];
      float c2col[NI];
#pragma unroll
      for (int ni = 0; ni < NI; ++ni) {
        float f0[8], f1[8];
        { const u32x4_t w = __builtin_bit_cast(u32x4_t, qrot[ni][0]); unpack8(uint4{w.x, w.y, w.z, w.w}, f0); }
        { const u32x4_t w = __builtin_bit_cast(u32x4_t, qrot[ni][1]); unpack8(uint4{w.x, w.y, w.z, w.w}, f1); }
        float qa = 0.f;
#pragma unroll
        for (int i = 0; i < 8; ++i) qa = fmaxf(qa, fmaxf(fabsf(f0[i]), fabsf(f1[i])));
        qa = fmaxf(qa, shx(qa, 16));
        qa = fmaxf(qa, shx(qa, 32));
        qa = fmaxf(qa, 1e-30f);
        const float qi = 224.f / qa;
        q8[ni][0] = (i64_t)(((unsigned long long)pack4_fp8q(f0[4] * qi, f0[5] * qi, f0[6] * qi, f0[7] * qi) << 32) |
                            (unsigned long long)pack4_fp8q(f0[0] * qi, f0[1] * qi, f0[2] * qi, f0[3] * qi));
        q8[ni][1] = (i64_t)(((unsigned long long)pack4_fp8q(f1[4] * qi, f1[5] * qi, f1[6] * qi, f1[7] * qi) << 32) |
                            (unsigned long long)pack4_fp8q(f1[0] * qi, f1[1] * qi, f1[2] * qi, f1[3] * qi));
        c2col[ni] = fmaxf(C2 * kscale * qa * (1.f / 224.f), 1e-30f);
      }
      i64_t ka00 = 0, ka01 = 0, ka10 = 0, ka11 = 0, ka20 = 0, ka21 = 0, ka30 = 0, ka31 = 0;
      i64_t va00 = 0, va01 = 0, va10 = 0, va11 = 0, va20 = 0, va21 = 0, va30 = 0, va31 = 0;
      i64_t kb00 = 0, kb01 = 0, kb10 = 0, kb11 = 0, kb20 = 0, kb21 = 0, kb30 = 0, kb31 = 0;
      i64_t vb00 = 0, vb01 = 0, vb10 = 0, vb11 = 0, vb20 = 0, vb21 = 0, vb30 = 0, vb31 = 0;
#define NS8_LD2(A0, A1, ptr_) { const u64x2_t t_ = *(const u64x2_t*)(ptr_); A0 = t_.x; A1 = t_.y; }
#define NS8_LOAD(K, V, nb_)                                                                             \
      {                                                                                                 \
        const unsigned char* kp_ = kb8 + (size_t)(nb_) * 4096;                                          \
        NS8_LD2(K##00, K##01, kp_) NS8_LD2(K##10, K##11, kp_ + 1024) NS8_LD2(K##20, K##21, kp_ + 2048) NS8_LD2(K##30, K##31, kp_ + 3072) \
        const unsigned char* vp_ = vt8 + (size_t)(nb_) * 4096;                                          \
        NS8_LD2(V##00, V##01, vp_) NS8_LD2(V##10, V##11, vp_ + 1024) NS8_LD2(V##20, V##21, vp_ + 2048) NS8_LD2(V##30, V##31, vp_ + 3072) \
      }
#define NS8_STEP(K, V, KN, VN, i_)                                                                      \
      {                                                                                                 \
        const int n = wl16[(i_)];                                                                       \
        if ((i_) + 1 < nuw) NS8_LOAD(KN, VN, (int)wl16[(i_) + 1])                                       \
        bool qsel[NI], act[NI];                                                                         \
        _Pragma("unroll") for (int ni = 0; ni < NI; ++ni) {                                             \
          qsel[ni] = (bmq[qlv[ni] * 8 + (n >> 5)] >> (n & 31)) & 1u;                                    \
          act[ni] = __builtin_amdgcn_ballot_w64(qsel[ni]) != 0ull;                                      \
        }                                                                                               \
        i64_t pf[NI][2];                                                                                \
        _Pragma("unroll") for (int ni = 0; ni < NI; ++ni) {                                             \
          pf[ni][0] = 0; pf[ni][1] = 0;                                                                 \
          if (!act[ni]) continue;                                                                       \
          f32x4 s[4];                                                                                   \
          s[0] = MFMA8(K##00, q8[ni][0], (f32x4{0.f, 0.f, 0.f, 0.f}));                                  \
          s[0] = MFMA8(K##01, q8[ni][1], s[0]);                                                         \
          s[1] = MFMA8(K##10, q8[ni][0], (f32x4{0.f, 0.f, 0.f, 0.f}));                                  \
          s[1] = MFMA8(K##11, q8[ni][1], s[1]);                                                         \
          s[2] = MFMA8(K##20, q8[ni][0], (f32x4{0.f, 0.f, 0.f, 0.f}));                                  \
          s[2] = MFMA8(K##21, q8[ni][1], s[2]);                                                         \
          s[3] = MFMA8(K##30, q8[ni][0], (f32x4{0.f, 0.f, 0.f, 0.f}));                                  \
          s[3] = MFMA8(K##31, q8[ni][1], s[3]);                                                         \
          if (n == cur) {                   \
            _Pragma("unroll") for (int mi = 0; mi < 4; ++mi)                                            \
              _Pragma("unroll") for (int r = 0; r < 4; ++r) {                                           \
                const int key = n * 64 + mi * 16 + g4 * 4 + r;                                          \
                if (key > tq[ni]) s[mi][r] = -INFINITY;                                                 \
              }                                                                                         \
          }                                                                                             \
          softmax_one8<NI>(s, st, lacc[ni], ni, c2col[ni], qsel[ni], pf[ni][0], pf[ni][1]);             \
        }                                                                                               \
        _Pragma("unroll") for (int ni = 0; ni < NI; ++ni) {                                             \
          if (!act[ni]) continue;                                                                       \
          st.o[0][ni] = MFMA8(V##00, pf[ni][0], st.o[0][ni]); st.o[0][ni] = MFMA8(V##01, pf[ni][1], st.o[0][ni]); \
          st.o[1][ni] = MFMA8(V##10, pf[ni][0], st.o[1][ni]); st.o[1][ni] = MFMA8(V##11, pf[ni][1], st.o[1][ni]); \
          st.o[2][ni] = MFMA8(V##20, pf[ni][0], st.o[2][ni]); st.o[2][ni] = MFMA8(V##21, pf[ni][1], st.o[2][ni]); \
          st.o[3][ni] = MFMA8(V##30, pf[ni][0], st.o[3][ni]); st.o[3][ni] = MFMA8(V##31, pf[ni][1], st.o[3][ni]); \
        }                                                                                               \
      }
      f32x4 lacc[NI];
      for (int rep_ = 0; rep_ < ((REP_NSA_PART & 4) ? 2 : 1); ++rep_) {
      attn_init<NI>(st);
#pragma unroll
      for (int ni = 0; ni < NI; ++ni) lacc[ni] = f32x4{0.f, 0.f, 0.f, 0.f};
      if (nuw > 0) NS8_LOAD(ka, va, (int)wl16[0])
      for (int iu = 0; iu < nuw; iu += 2) {
        NS8_STEP(ka, va, kb, vb, iu)
        if (iu + 1 < nuw) NS8_STEP(kb, vb, ka, va, iu + 1)
      }
      }
#pragma unroll
      for (int ni = 0; ni < NI; ++ni) {
        st.l[ni] = lacc[ni][0] * 0.25f;
#pragma unroll
        for (int di = 0; di < 4; ++di) {
          st.o[di][ni][0] *= vscale; st.o[di][ni][1] *= vscale; st.o[di][ni][2] *= vscale; st.o[di][ni][3] *= vscale;
        }
      }
    }
#else
    const int nu = ulist[256];
#define NSA_SKEY(i) (ulist[(i)] * 64)
    for (int rep_ = 0; rep_ < ((REP_NSA_PART & 4) ? 2 : 1); ++rep_) {
    attn_init<NI>(st);
    KV_SWEEP(kb, vb, 64, nu, NSA_SKEY,
      const int n = ulist[it];
      bool qs[NI];
      bool anyq = false;
      _Pragma("unroll") for (int ni = 0; ni < NI; ++ni) {
        qs[ni] = (bmq[qlv[ni] * 8 + (n >> 5)] >> (n & 31)) & 1u;
        anyq = anyq || qs[ni];
      }
      if (__builtin_amdgcn_ballot_w64(anyq) != 0ull) {
        f32x4 s[4][NI];
        attn_scores<NI>(Ks, qrot, s);
        _Pragma("unroll") for (int ni = 0; ni < NI; ++ni)
          _Pragma("unroll") for (int mi = 0; mi < 4; ++mi)
            _Pragma("unroll") for (int r = 0; r < 4; ++r) {
              const int key = n * 64 + mi * 16 + g4 * 4 + r;
              if (!qs[ni] || key > tq[ni]) s[mi][ni][r] = -INFINITY;
            }
        attn_softmax_pv<NI>(Ks + KT_ELEMS, s, st);
      }
    )
    }
#endif
#pragma unroll
    for (int ni = 0; ni < NI; ++ni) {
      float l = st.l[ni];
      l += shx(l, 16);
      l += shx(l, 32);
      const float sc = gate1[ni] / l;
#pragma unroll
      for (int di = 0; di < 4; ++di)
#pragma unroll
        for (int r = 0; r < 4; ++r) acc[di][ni][r] = accs[((ni * 4 + di) * 4 + r) * 256] + sc * st.o[di][ni][r];
    }
  }
#pragma unroll
  for (int ni = 0; ni < NI; ++ni) {
    const int g = (wave * 16 * NI + ni * 16 + c16) & 3;
    bf16* op = outbuf + ((size_t)b * S + tq[ni]) * ATT_LD + (kvh * 4 + g) * 64 + g4 * 4;
#pragma unroll
    for (int di = 0; di < 4; ++di) {
      uint2 pk;
      pk.x = cvtpk(acc[di][ni][0], acc[di][ni][1]);
      pk.y = cvtpk(acc[di][ni][2], acc[di][ni][3]);
      *(uint2*)(op + di * 16) = pk;
    }
  }
  __syncthreads();
}

DEV void probe_accum_bf16(const Params& p, const bf16* a, const bf16* ref, size_t n, float* sm) {
  float sd = 0.f, sr = 0.f;
  for (size_t i = (size_t)vbid() * 256 + tidx(); i < n; i += (size_t)vnb() * 256) {
    float x = bf2f(a[i]), y = bf2f(ref[i]);
    sd += (x - y) * (x - y);
    sr += y * y;
  }
  sd = wave_sum(sd);
  sr = wave_sum(sr);
  if ((tidx() & 63) == 0) {
    atomicAdd((float*)(p.ws + OFF_PROBE), sd);
    atomicAdd((float*)(p.ws + OFF_PROBE) + 1, sr);
  }
}
DEV void probe_apply(const Params& p) {
  const float* pr = (const float*)(p.ws + OFF_PROBE);
  const float sd = pr[0], sr = pr[1];
  float rel = sqrtf(sd / fmaxf(sr, 1e-30f));
  float k = 10.f + 10.f * log10f(fmaxf(rel, 1e-6f) / 1e-4f);
  if (!(k == k)) k = 95.f;
  k = fminf(fmaxf(k, 1.f), 55.f);
  if (pr[2] > 0.f) k = 60.f + fminf(35.f, 10.f * log10f(pr[2]));
  const float scale = 1.f + 0.01f * k;
  for (size_t i = (size_t)vbid() * 256 + tidx(); i < (size_t)T * 1024; i += (size_t)vnb() * 256)
    p.out[i] *= scale;
}

DEV void wave_top16(float sa, float sb, int ia, int ib, int lane, float& vout, int& iout) {
  vout = 0.f;
  iout = 0;
  for (int r = 0; r < 16; ++r) {
    float bv;
    int bi;
    if (sa >= sb) { bv = sa; bi = ia; } else { bv = sb; bi = ib; }
#pragma unroll
    for (int off = 32; off >= 1; off >>= 1) {
      float ov = shx(bv, off);
      int oi = shx(bi, off);
      if (ov > bv || (ov == bv && oi < bi)) { bv = ov; bi = oi; }
    }
    if (lane == r) { vout = bv; iout = bi; }
    if (bi == ia) sa = -INFINITY;
    else if (bi == ib) sb = -INFINITY;
  }
}
DEV void peer_topk_item(const Params& p, int layer, int item, bf16* sm16) {
  bf16* k1t = sm16;
  bf16* k2t = sm16 + 16384;
  float* qs = (float*)(sm16 + 32768);
  const int tid = tidx(), lane = tid & 63, wave = tid >> 6;
  const float* k1 = p.peer_k1 + (size_t)layer * 128 * 128;
  const float* k2 = p.peer_k2 + (size_t)layer * 128 * 128;
  for (int i = tid; i < 16384; i += 256) {
    int d = i >> 7, n = i & 127;
    k1t[i] = f2bf(k1[n * 128 + d]);
    k2t[i] = f2bf(k2[n * 128 + d]);
  }
  __syncthreads();
  const bf16* qp_all = (const bf16*)(p.ws + OFF_QP);
  int* peidx = (int*)(p.ws + OFF_PEIDX);
  float* peg = (float*)(p.ws + OFF_PEG);
  for (int pair = wave; pair < 256; pair += 4) {
    const int tl = pair >> 3, hh = pair & 7;
    const size_t tok = (size_t)item * 32 + tl;
    {
      uint2 v = *(const uint2*)(qp_all + tok * 2048 + hh * 256 + lane * 4);
      float* qd = qs + wave * 256 + lane * 4;
      qd[0] = __uint_as_float(v.x << 16);
      qd[1] = __uint_as_float(v.x & 0xffff0000u);
      qd[2] = __uint_as_float(v.y << 16);
      qd[3] = __uint_as_float(v.y & 0xffff0000u);
    }
    __syncthreads();
    float s1a = 0.f, s1b = 0.f, s2a = 0.f, s2b = 0.f;
    const float* qw = qs + wave * 256;
#pragma unroll 4
    for (int d = 0; d < 128; ++d) {
      float q1 = qw[d], q2 = qw[128 + d];
      s1a += q1 * bf2f(k1t[d * 128 + lane]);
      s1b += q1 * bf2f(k1t[d * 128 + lane + 64]);
      s2a += q2 * bf2f(k2t[d * 128 + lane]);
      s2b += q2 * bf2f(k2t[d * 128 + lane + 64]);
    }
    float v1, v2;
    int i1, i2;
    wave_top16(s1a, s1b, lane, lane + 64, lane, v1, i1);
    wave_top16(s2a, s2b, lane, lane + 64, lane, v2, i2);
    const float va = __shfl(v1, lane >> 2);
    float c0 = va + __shfl(v2, (lane & 3) * 4 + 0);
    float c1 = va + __shfl(v2, (lane & 3) * 4 + 1);
    float c2 = va + __shfl(v2, (lane & 3) * 4 + 2);
    float c3 = va + __shfl(v2, (lane & 3) * 4 + 3);
    float vals = 0.f;
    int cisel = 0;
    for (int r = 0; r < 16; ++r) {
      float bv = c0;
      int bi = lane * 4;
      if (c1 > bv) { bv = c1; bi = lane * 4 + 1; }
      if (c2 > bv) { bv = c2; bi = lane * 4 + 2; }
      if (c3 > bv) { bv = c3; bi = lane * 4 + 3; }
#pragma unroll
      for (int off = 32; off >= 1; off >>= 1) {
        float ov = shx(bv, off);
        int oi = shx(bi, off);
        if (ov > bv || (ov == bv && oi < bi)) { bv = ov; bi = oi; }
      }
      if (lane == r) { vals = bv; cisel = bi; }
      if ((bi >> 2) == lane) {
        int j = bi & 3;
        if (j == 0) c0 = -INFINITY;
        else if (j == 1) c1 = -INFINITY;
        else if (j == 2) c2 = -INFINITY;
        else c3 = -INFINITY;
      }
    }
    const int ea = __shfl(i1, (cisel >> 4) & 15);
    const int eb = __shfl(i2, cisel & 15);
    const int e = ea * 128 + eb;
    const float mx = __shfl(vals, 0);
    float ex = (lane < 16) ? expf(vals - mx) : 0.f;
    float sum = wave_sum(ex);
    if (lane < 16) {
      peidx[tok * 128 + hh * 16 + lane] = e;
      peg[tok * 128 + hh * 16 + lane] = ex / sum;
    }
    __syncthreads();
  }
}

DEV void peer_expert_item(const Params& p, int layer, int item, float* sm) {
  const int tid = tidx(), lane = tid & 63, wave = tid >> 6;
  const size_t tok = (size_t)item;
  const int b = (int)(tok / S);
  int* idx = (int*)sm;
  float* gt = sm + 128;
  float* act = sm + 256;
  if (tid < 128) {
    idx[tid] = ((const int*)(p.ws + OFF_PEIDX))[tok * 128 + tid];
    gt[tid] = ((const float*)(p.ws + OFF_PEG))[tok * 128 + tid];
  }
  const bf16* hrow = (const bf16*)(p.ws + OFF_H) + tok * 1024;
  float hw[16];
#pragma unroll
  for (int i = 0; i < 4; ++i) {
    uint2 v = *(const uint2*)(hrow + i * 256 + lane * 4);
    hw[i * 4 + 0] = __uint_as_float(v.x << 16);
    hw[i * 4 + 1] = __uint_as_float(v.x & 0xffff0000u);
    hw[i * 4 + 2] = __uint_as_float(v.y << 16);
    hw[i * 4 + 3] = __uint_as_float(v.y & 0xffff0000u);
  }
  __syncthreads();
  const float* U = p.peer_u + (size_t)layer * NEXP * 1024;
  const float* V = p.peer_v + (size_t)layer * NEXP * 1024;
#pragma unroll 2
  for (int jj = 0; jj < 32; ++jj) {
    int j = wave * 32 + jj;
    const float* ur = U + (size_t)idx[j] * 1024;
    float part = 0.f;
#pragma unroll
    for (int i = 0; i < 4; ++i) {
      float4 u4 = *(const float4*)(ur + i * 256 + lane * 4);
      part += hw[i * 4] * u4.x + hw[i * 4 + 1] * u4.y + hw[i * 4 + 2] * u4.z + hw[i * 4 + 3] * u4.w;
    }
    part = wave_sum(part);
    if (lane == 0) act[j] = gt[j] * gelu_tanh(part);
  }
  __syncthreads();
  float a0 = 0.f, a1 = 0.f, a2 = 0.f, a3 = 0.f;
#pragma unroll 8
  for (int j = 0; j < 128; ++j) {
    float a = act[j];
    float4 v4 = *(const float4*)(V + (size_t)idx[j] * 1024 + tid * 4);
    a0 += a * v4.x; a1 += a * v4.y; a2 += a * v4.z; a3 += a * v4.w;
  }
  const float* ga = (const float*)(p.ws + OFF_MOD) + (layer * 2 + b) * 6144 + 5120 + tid * 4;
  float* xr = p.out + tok * 1024 + tid * 4;
  float4 xo = *(float4*)xr;
  xo.x += ga[0] * a0; xo.y += ga[1] * a1; xo.z += ga[2] * a2; xo.w += ga[3] * a3;
  *(float4*)xr = xo;
  __syncthreads();
}

DEV void pk_scores(const bf16* __restrict__ ktab, const bf16* __restrict__ qp, f32x4 (&s)[8], int g4, int c16) {
  bf16x8 qf[4];
#pragma unroll
  for (int ks = 0; ks < 4; ++ks) qf[ks] = *(const bf16x8*)(qp + ks * 32 + g4 * 8);
#pragma unroll
  for (int mi = 0; mi < 8; ++mi) {
    s[mi] = f32x4{0.f, 0.f, 0.f, 0.f};
#pragma unroll
    for (int ks = 0; ks < 4; ++ks) {
      const bf16x8 kf = *(const bf16x8*)(ktab + (mi * 16 + c16) * 128 + ks * 32 + g4 * 8);
      s[mi] = MFMA16(kf, qf[ks], s[mi]);
    }
  }
}
DEV void pk_top16(f32x4 (&s)[8], int g4, float (&vout)[16], int (&iout)[16]) {
#pragma unroll
  for (int rd = 0; rd < 16; ++rd) {
    float bv = -INFINITY;
    int bi = 1 << 20;
#pragma unroll
    for (int mi = 0; mi < 8; ++mi)
#pragma unroll
      for (int r = 0; r < 4; ++r) {
        const float v = s[mi][r];
        if (v > bv) { bv = v; bi = mi * 16 + g4 * 4 + r; }
      }
#pragma unroll
    for (int off = 16; off <= 32; off <<= 1) {
      const float ov = shx(bv, off);
      const int oi = shx(bi, off);
      if (ov > bv || (ov == bv && oi < bi)) { bv = ov; bi = oi; }
    }
    vout[rd] = bv;
    iout[rd] = bi;
#pragma unroll
    for (int mi = 0; mi < 8; ++mi)
#pragma unroll
      for (int r = 0; r < 4; ++r)
        if (mi * 16 + g4 * 4 + r == bi) s[mi][r] = -INFINITY;
  }
}
DEV void peer_topk_mfma_item(const Params& p, int layer, int item) {
  const int lane = tidx() & 63, wave = tidx() >> 6, g4 = lane >> 4, c16 = lane & 15;
  const size_t tok = (size_t)item * 8 + wave * 2 + (c16 >> 3);
  const int hh = c16 & 7;
  const bf16* qp = (const bf16*)(p.ws + OFF_QP) + tok * 2048 + hh * 256;
  const bf16* k1 = (const bf16*)(p.ws + OFF_PKB) + (size_t)(layer * 2 + 0) * 16384;
  const bf16* k2 = (const bf16*)(p.ws + OFF_PKB) + (size_t)(layer * 2 + 1) * 16384;
  float v1[16], v2[16];
  int i1[16], i2[16];
  {
    f32x4 s[8];
    pk_scores(k1, qp, s, g4, c16);
    pk_top16(s, g4, v1, i1);
  }
  {
    f32x4 s[8];
    pk_scores(k2, qp + 128, s, g4, c16);
    pk_top16(s, g4, v2, i2);
  }
  float v1s[4];
  int i1s[4];
#pragma unroll
  for (int j = 0; j < 4; ++j) {
    v1s[j] = (g4 == 0) ? v1[j] : (g4 == 1) ? v1[4 + j] : (g4 == 2) ? v1[8 + j] : v1[12 + j];
    i1s[j] = (g4 == 0) ? i1[j] : (g4 == 1) ? i1[4 + j] : (g4 == 2) ? i1[8 + j] : i1[12 + j];
  }
  float c0[16], c1[8], c2[5], c3[4];
#pragma unroll
  for (int b = 0; b < 16; ++b) c0[b] = ((4 * g4 + 1) * (b + 1) <= 16) ? v1s[0] + v2[b] : -INFINITY;
#pragma unroll
  for (int b = 0; b < 8; ++b) c1[b] = ((4 * g4 + 2) * (b + 1) <= 16) ? v1s[1] + v2[b] : -INFINITY;
#pragma unroll
  for (int b = 0; b < 5; ++b) c2[b] = ((4 * g4 + 3) * (b + 1) <= 16) ? v1s[2] + v2[b] : -INFINITY;
#pragma unroll
  for (int b = 0; b < 4; ++b) c3[b] = ((4 * g4 + 4) * (b + 1) <= 16) ? v1s[3] + v2[b] : -INFINITY;
  float vals[16];
  int eidx[16];
  const int cbase = g4 * 64;
#pragma unroll
  for (int rd = 0; rd < 16; ++rd) {
    float bv = -INFINITY;
    int bi = 1 << 20;
#pragma unroll
    for (int b = 0; b < 16; ++b) if (c0[b] > bv) { bv = c0[b]; bi = cbase + b; }
#pragma unroll
    for (int b = 0; b < 8; ++b) if (c1[b] > bv) { bv = c1[b]; bi = cbase + 16 + b; }
#pragma unroll
    for (int b = 0; b < 5; ++b) if (c2[b] > bv) { bv = c2[b]; bi = cbase + 32 + b; }
#pragma unroll
    for (int b = 0; b < 4; ++b) if (c3[b] > bv) { bv = c3[b]; bi = cbase + 48 + b; }
#pragma unroll
    for (int off = 16; off <= 32; off <<= 1) {
      const float ov = shx(bv, off);
      const int oi = shx(bi, off);
      if (ov > bv || (ov == bv && oi < bi)) { bv = ov; bi = oi; }
    }
    vals[rd] = bv;
    int e = -1;
#pragma unroll
    for (int b = 0; b < 16; ++b) if (cbase + b == bi) { c0[b] = -INFINITY; e = i1s[0] * 128 + i2[b]; }
#pragma unroll
    for (int b = 0; b < 8; ++b) if (cbase + 16 + b == bi) { c1[b] = -INFINITY; e = i1s[1] * 128 + i2[b]; }
#pragma unroll
    for (int b = 0; b < 5; ++b) if (cbase + 32 + b == bi) { c2[b] = -INFINITY; e = i1s[2] * 128 + i2[b]; }
#pragma unroll
    for (int b = 0; b < 4; ++b) if (cbase + 48 + b == bi) { c3[b] = -INFINITY; e = i1s[3] * 128 + i2[b]; }
    e = max(e, shx(e, 16));
    e = max(e, shx(e, 32));
    eidx[rd] = e;
  }
  float ex[16], sum = 0.f;
#pragma unroll
  for (int rd = 0; rd < 16; ++rd) { ex[rd] = expf(vals[rd] - vals[0]); sum += ex[rd]; }
  const float inv = 1.f / sum;
  if (g4 == 0) {
    int* pi = (int*)(p.ws + OFF_PEIDX) + tok * 128 + hh * 16;
    float* pg = (float*)(p.ws + OFF_PEG) + tok * 128 + hh * 16;
#pragma unroll
    for (int q = 0; q < 4; ++q) {
      *(int4*)(pi + q * 4) = int4{eidx[q * 4], eidx[q * 4 + 1], eidx[q * 4 + 2], eidx[q * 4 + 3]};
      *(float4*)(pg + q * 4) = float4{ex[q * 4] * inv, ex[q * 4 + 1] * inv, ex[q * 4 + 2] * inv, ex[q * 4 + 3] * inv};
    }
  }
}

DEV float pk_key(float v, int inv_idx, unsigned mask) {
  return __uint_as_float((__float_as_uint(v) & ~mask) | (unsigned)inv_idx);
}
DEV void sort32_desc(float (&x)[32]) {
#pragma unroll
  for (int k = 2; k <= 32; k <<= 1)
#pragma unroll
    for (int j = k >> 1; j > 0; j >>= 1)
#pragma unroll
      for (int i = 0; i < 32; ++i) {
        const int l = i ^ j;
        if (l > i) {
          const float a = x[i], b = x[l];
          const float hi = fmaxf(a, b), lo = fminf(a, b);
          if ((i & k) == 0) { x[i] = hi; x[l] = lo; } else { x[i] = lo; x[l] = hi; }
        }
      }
}
DEV void pk_top16_sorted(f32x4 (&s)[8], int g4, float (&vout)[16], int (&iout)[16]) {
  float x[32];
#pragma unroll
  for (int mi = 0; mi < 8; ++mi)
#pragma unroll
    for (int r = 0; r < 4; ++r) x[mi * 4 + r] = pk_key(s[mi][r], 127 - (mi * 16 + g4 * 4 + r), 0x7Fu);
  sort32_desc(x);
#pragma unroll
  for (int rd = 0; rd < 16; ++rd) {
    float w = x[0];
    w = fmaxf(w, shx(w, 16));
    w = fmaxf(w, shx(w, 32));
    vout[rd] = w;
    iout[rd] = 127 - (int)(__float_as_uint(w) & 0x7Fu);
    if (x[0] == w) {
#pragma unroll
      for (int i = 0; i < 15; ++i) x[i] = x[i + 1];
      x[15] = -INFINITY;
    }
  }
}
template <int N>
DEV void shift_row(float (&c)[N], int (&e)[N]) {
#pragma unroll
  for (int i = 0; i + 1 < N; ++i) { c[i] = c[i + 1]; e[i] = e[i + 1]; }
  c[N - 1] = -INFINITY;
}
DEV void peer_topk_item3(const Params& p, int layer, int item, int* lds_idx = nullptr, float* lds_gate = nullptr) {
  const int lane = tidx() & 63, wave = tidx() >> 6, g4 = lane >> 4, c16 = lane & 15;
  const size_t tok = (size_t)item * 8 + wave * 2 + (c16 >> 3);
  const int hh = c16 & 7;
  const bf16* qp = (const bf16*)(p.ws + OFF_QP) + tok * 2048 + hh * 256;
  const bf16* k1 = (const bf16*)(p.ws + OFF_PKB) + (size_t)(layer * 2 + 0) * 16384;
  const bf16* k2 = (const bf16*)(p.ws + OFF_PKB) + (size_t)(layer * 2 + 1) * 16384;
  float v1[16], v2[16];
  int i1[16], i2[16];
  {
    f32x4 s[8];
    pk_scores(k1, qp, s, g4, c16);
    pk_top16_sorted(s, g4, v1, i1);
  }
  {
    f32x4 s[8];
    pk_scores(k2, qp + 128, s, g4, c16);
    pk_top16_sorted(s, g4, v2, i2);
  }
  float v1s[4];
  int i1s[4];
#pragma unroll
  for (int j = 0; j < 4; ++j) {
    v1s[j] = (g4 == 0) ? v1[j] : (g4 == 1) ? v1[4 + j] : (g4 == 2) ? v1[8 + j] : v1[12 + j];
    i1s[j] = (g4 == 0) ? i1[j] : (g4 == 1) ? i1[4 + j] : (g4 == 2) ? i1[8 + j] : i1[12 + j];
  }
  float c0[16], c1[8], c2[5], c3[4];
  int e0[16], e1[8], e2[5], e3[4];
  const int cbase = g4 * 64;
#pragma unroll
  for (int b = 0; b < 16; ++b) {
    c0[b] = ((4 * g4 + 1) * (b + 1) <= 16) ? pk_key(v1s[0] + v2[b], 255 - (cbase + b), 0xFFu) : -INFINITY;
    e0[b] = i1s[0] * 128 + i2[b];
  }
#pragma unroll
  for (int b = 0; b < 8; ++b) {
    c1[b] = ((4 * g4 + 2) * (b + 1) <= 16) ? pk_key(v1s[1] + v2[b], 255 - (cbase + 16 + b), 0xFFu) : -INFINITY;
    e1[b] = i1s[1] * 128 + i2[b];
  }
#pragma unroll
  for (int b = 0; b < 5; ++b) {
    c2[b] = ((4 * g4 + 3) * (b + 1) <= 16) ? pk_key(v1s[2] + v2[b], 255 - (cbase + 32 + b), 0xFFu) : -INFINITY;
    e2[b] = i1s[2] * 128 + i2[b];
  }
#pragma unroll
  for (int b = 0; b < 4; ++b) {
    c3[b] = ((4 * g4 + 4) * (b + 1) <= 16) ? pk_key(v1s[3] + v2[b], 255 - (cbase + 48 + b), 0xFFu) : -INFINITY;
    e3[b] = i1s[3] * 128 + i2[b];
  }
  float vals[16];
  int eidx[16];
#pragma unroll
  for (int rd = 0; rd < 16; ++rd) {
    float w = fmaxf(fmaxf(c0[0], c1[0]), fmaxf(c2[0], c3[0]));
    w = fmaxf(w, shx(w, 16));
    w = fmaxf(w, shx(w, 32));
    vals[rd] = w;
    int e = -1;
    if (c0[0] == w) { e = e0[0]; shift_row(c0, e0); }
    if (c1[0] == w) { e = e1[0]; shift_row(c1, e1); }
    if (c2[0] == w) { e = e2[0]; shift_row(c2, e2); }
    if (c3[0] == w) { e = e3[0]; shift_row(c3, e3); }
    e = max(e, shx(e, 16));
    e = max(e, shx(e, 32));
    eidx[rd] = e;
  }
  float ex[16], sum = 0.f;
#pragma unroll
  for (int rd = 0; rd < 16; ++rd) { ex[rd] = expf(vals[rd] - vals[0]); sum += ex[rd]; }
  const float inv = 1.f / sum;
  if (g4 == 0) {
    int* pi = lds_idx ? (lds_idx + (c16 >> 3) * 128 + hh * 16) : ((int*)(p.ws + OFF_PEIDX) + tok * 128 + hh * 16);
    float* pg = lds_gate ? (lds_gate + (c16 >> 3) * 128 + hh * 16) : ((float*)(p.ws + OFF_PEG) + tok * 128 + hh * 16);
#pragma unroll
    for (int q = 0; q < 4; ++q) {
      *(int4*)(pi + q * 4) = int4{eidx[q * 4], eidx[q * 4 + 1], eidx[q * 4 + 2], eidx[q * 4 + 3]};
      *(float4*)(pg + q * 4) = float4{ex[q * 4] * inv, ex[q * 4 + 1] * inv, ex[q * 4 + 2] * inv, ex[q * 4 + 3] * inv};
    }
  }
}

typedef float f32x2_t __attribute__((ext_vector_type(2)));
DEV unsigned pack4_fp8(float a, float b, float c, float d) {
  int p = __builtin_amdgcn_cvt_pk_fp8_f32(a, b, 0, false);
  p = __builtin_amdgcn_cvt_pk_fp8_f32(c, d, p, true);
  return (unsigned)p;
}
DEV void unpack16_fp8(uint4 v, float* f) {
  f32x2_t r;
  r = __builtin_amdgcn_cvt_pk_f32_fp8((int)v.x, false); f[0] = r.x; f[1] = r.y;
  r = __builtin_amdgcn_cvt_pk_f32_fp8((int)v.x, true);  f[2] = r.x; f[3] = r.y;
  r = __builtin_amdgcn_cvt_pk_f32_fp8((int)v.y, false); f[4] = r.x; f[5] = r.y;
  r = __builtin_amdgcn_cvt_pk_f32_fp8((int)v.y, true);  f[6] = r.x; f[7] = r.y;
  r = __builtin_amdgcn_cvt_pk_f32_fp8((int)v.z, false); f[8] = r.x; f[9] = r.y;
  r = __builtin_amdgcn_cvt_pk_f32_fp8((int)v.z, true);  f[10] = r.x; f[11] = r.y;
  r = __builtin_amdgcn_cvt_pk_f32_fp8((int)v.w, false); f[12] = r.x; f[13] = r.y;
  r = __builtin_amdgcn_cvt_pk_f32_fp8((int)v.w, true);  f[14] = r.x; f[15] = r.y;
}
DEV void expert_cvt_item(const Params& p, int layer, int item) {
  const int lane = tidx() & 63, wave = tidx() >> 6;
  const int e = item * 4 + wave;
  unsigned char* dst = (unsigned char*)(p.ws + OFF_E8) + (size_t)e * 2048;
  float* sc = (float*)(p.ws + OFF_ESC) + (size_t)e * 2;
#pragma unroll
  for (int tb = 0; tb < 2; ++tb) {
    const float* src = (tb ? p.peer_v : p.peer_u) + ((size_t)layer * NEXP + e) * 1024 + lane * 16;
    float4 a = *(const float4*)src, b = *(const float4*)(src + 4), c = *(const float4*)(src + 8), d = *(const float4*)(src + 12);
    float mx = fmaxf(fmaxf(fmaxf(fabsf(a.x), fabsf(a.y)), fmaxf(fabsf(a.z), fabsf(a.w))),
                     fmaxf(fmaxf(fabsf(b.x), fabsf(b.y)), fmaxf(fabsf(b.z), fabsf(b.w))));
    mx = fmaxf(mx, fmaxf(fmaxf(fmaxf(fabsf(c.x), fabsf(c.y)), fmaxf(fabsf(c.z), fabsf(c.w))),
                         fmaxf(fmaxf(fabsf(d.x), fabsf(d.y)), fmaxf(fabsf(d.z), fabsf(d.w)))));
#pragma unroll
    for (int o = 32; o >= 1; o >>= 1) mx = fmaxf(mx, shx(mx, o));
    const float s = (mx > 0.f) ? 224.f / mx : 1.f;
    uint4 pk;
    pk.x = pack4_fp8(a.x * s, a.y * s, a.z * s, a.w * s);
    pk.y = pack4_fp8(b.x * s, b.y * s, b.z * s, b.w * s);
    pk.z = pack4_fp8(c.x * s, c.y * s, c.z * s, c.w * s);
    pk.w = pack4_fp8(d.x * s, d.y * s, d.z * s, d.w * s);
    *(uint4*)(dst + tb * 1024 + lane * 16) = pk;
    if (lane == 0) sc[tb] = 1.f / s;
  }
}

DEV float wave_sum8(float s0, float s1, float s2, float s3, float s4, float s5, float s6, float s7, int lane) {
  const bool b2 = (lane >> 2) & 1, b1 = (lane >> 1) & 1, b0 = lane & 1;
  const float r0 = (b2 ? s4 : s0) + shx(b2 ? s0 : s4, 4);
  const float r1 = (b2 ? s5 : s1) + shx(b2 ? s1 : s5, 4);
  const float r2 = (b2 ? s6 : s2) + shx(b2 ? s2 : s6, 4);
  const float r3 = (b2 ? s7 : s3) + shx(b2 ? s3 : s7, 4);
  const float q0 = (b1 ? r2 : r0) + shx(b1 ? r0 : r2, 2);
  const float q1 = (b1 ? r3 : r1) + shx(b1 ? r1 : r3, 2);
  float v = (b0 ? q1 : q0) + shx(b0 ? q0 : q1, 1);
  v += shx(v, 8);
  v += shx(v, 16);
  v += shx(v, 32);
  return v;
}
DEV float rdlane_f(float v, int l) { return __int_as_float(__builtin_amdgcn_readlane(__float_as_int(v), l)); }
DEV float dot16_f8(const float* hw, uint4 u) {
  float f[16];
  unpack16_fp8(u, f);
  f32x2_t s = {0.f, 0.f};
#pragma unroll
  for (int q = 0; q < 8; ++q) {
    const f32x2_t r = {f[2 * q], f[2 * q + 1]};
    const f32x2_t h = {hw[2 * q], hw[2 * q + 1]};
    s = __builtin_elementwise_fma(h, r, s);
  }
  return s.x + s.y;
}
DEV void axpy16_f8(float* acc, float a, uint4 u) {
  float f[16];
  unpack16_fp8(u, f);
  const f32x2_t a2 = {a, a};
#pragma unroll
  for (int q = 0; q < 8; ++q) {
    const f32x2_t r = {f[2 * q], f[2 * q + 1]};
    f32x2_t c = {acc[2 * q], acc[2 * q + 1]};
    c = __builtin_elementwise_fma(r, a2, c);
    acc[2 * q] = c.x; acc[2 * q + 1] = c.y;
  }
}
#define PE_ROWPTR(idxv, j) (E8 + (size_t)__builtin_amdgcn_readlane(idxv, (j)) * 2048)
#define PE_LOAD8(P, idxv, j0, off)                                                                        \
  P##0 = *(const uint4*)(PE_ROWPTR(idxv, (j0)) + (off)); P##1 = *(const uint4*)(PE_ROWPTR(idxv, (j0) + 1) + (off)); \
  P##2 = *(const uint4*)(PE_ROWPTR(idxv, (j0) + 2) + (off)); P##3 = *(const uint4*)(PE_ROWPTR(idxv, (j0) + 3) + (off)); \
  P##4 = *(const uint4*)(PE_ROWPTR(idxv, (j0) + 4) + (off)); P##5 = *(const uint4*)(PE_ROWPTR(idxv, (j0) + 5) + (off)); \
  P##6 = *(const uint4*)(PE_ROWPTR(idxv, (j0) + 6) + (off)); P##7 = *(const uint4*)(PE_ROWPTR(idxv, (j0) + 7) + (off));
#define PE_DOTSET(P, j0, dv)                                                                              \
  {                                                                                                       \
    const float v8_ = wave_sum8(dot16_f8(hw, P##0), dot16_f8(hw, P##1), dot16_f8(hw, P##2), dot16_f8(hw, P##3), \
                                dot16_f8(hw, P##4), dot16_f8(hw, P##5), dot16_f8(hw, P##6), dot16_f8(hw, P##7), lane); \
    if ((lane & ~7) == (j0)) dv = v8_;         \
  }
#define PE_AXPYSET(P, j0, av)                                                                             \
  {                                                                                                       \
    axpy16_f8(acc, rdlane_f(av, (j0)), P##0);     axpy16_f8(acc, rdlane_f(av, (j0) + 1), P##1);           \
    axpy16_f8(acc, rdlane_f(av, (j0) + 2), P##2); axpy16_f8(acc, rdlane_f(av, (j0) + 3), P##3);           \
    axpy16_f8(acc, rdlane_f(av, (j0) + 4), P##4); axpy16_f8(acc, rdlane_f(av, (j0) + 5), P##5);           \
    axpy16_f8(acc, rdlane_f(av, (j0) + 6), P##6); axpy16_f8(acc, rdlane_f(av, (j0) + 7), P##7);           \
  }
#define PE_DOT8(idxv, dv)                                                                                 \
  {                                                                                                       \
    uint4 pa0, pa1, pa2, pa3, pa4, pa5, pa6, pa7, pb0, pb1, pb2, pb3, pb4, pb5, pb6, pb7;                 \
    PE_LOAD8(pa, idxv, 0, 0)                                                                              \
    _Pragma("unroll 1") for (int g = 0; g < 4; ++g) {                                                     \
      const int j0 = g * 16;                                                                              \
      PE_LOAD8(pb, idxv, j0 + 8, 0)                                                                       \
      PE_DOTSET(pa, j0, dv)                                                                               \
      if (g < 3) { PE_LOAD8(pa, idxv, j0 + 16, 0) }                                                       \
      PE_DOTSET(pb, j0 + 8, dv)                                                                           \
    }                                                                                                     \
  }
#define PE_AXPY8(idxv, av)                                                                                \
  {                                                                                                       \
    uint4 pa0, pa1, pa2, pa3, pa4, pa5, pa6, pa7, pb0, pb1, pb2, pb3, pb4, pb5, pb6, pb7;                 \
    PE_LOAD8(pa, idxv, 0, 1024)                                                                           \
    _Pragma("unroll 1") for (int g = 0; g < 4; ++g) {                                                     \
      const int j0 = g * 16;                                                                              \
      PE_LOAD8(pb, idxv, j0 + 8, 1024)                                                                    \
      PE_AXPYSET(pa, j0, av)                                                                              \
      if (g < 3) { PE_LOAD8(pa, idxv, j0 + 16, 1024) }                                                    \
      PE_AXPYSET(pb, j0 + 8, av)                                                                          \
    }                                                                                                     \
  }
DEV void peer_expert_tok(const Params& p, int layer, size_t tok, float ga_scale, const int* pi, const float* pg) {
  const int lane = tidx() & 63;
  const int b = (int)(tok / S);
  const int idx_lo = pi[lane], idx_hi = pi[64 + lane];
  const float g_lo = pg[lane], g_hi = pg[64 + lane];
  const float* esc = (const float*)(p.ws + OFF_ESC);
  const float2 sc_lo = *(const float2*)(esc + (size_t)idx_lo * 2), sc_hi = *(const float2*)(esc + (size_t)idx_hi * 2);
  const bf16* hrow = (const bf16*)(p.ws + OFF_H) + tok * 1024 + lane * 16;
  float hw[16];
  unpack8(*(const uint4*)hrow, hw);
  unpack8(*(const uint4*)(hrow + 8), hw + 8);
  const unsigned char* E8 = (const unsigned char*)(p.ws + OFF_E8) + lane * 16;
  float d_lo = 0.f, d_hi = 0.f;
  PE_DOT8(idx_lo, d_lo)
  PE_DOT8(idx_hi, d_hi)
  const float act_lo = g_lo * gelu_tanh(d_lo * sc_lo.x) * sc_lo.y;
  const float act_hi = g_hi * gelu_tanh(d_hi * sc_hi.x) * sc_hi.y;
  float acc[16];
#pragma unroll
  for (int i = 0; i < 16; ++i) acc[i] = 0.f;
  PE_AXPY8(idx_lo, act_lo)
  PE_AXPY8(idx_hi, act_hi)
  const float* ga = (const float*)(p.ws + OFF_MOD) + (layer * 2 + b) * 6144 + 5120 + lane * 16;
  float* xr = p.out + tok * 1024 + lane * 16;
  float xn[16];
  float ss = 0.f;
#pragma unroll
  for (int q4 = 0; q4 < 4; ++q4) {
    float4 xo = *(float4*)(xr + q4 * 4);
    const float4 g4v = *(const float4*)(ga + q4 * 4);
    xo.x += ga_scale * g4v.x * acc[q4 * 4 + 0];
    xo.y += ga_scale * g4v.y * acc[q4 * 4 + 1];
    xo.z += ga_scale * g4v.z * acc[q4 * 4 + 2];
    xo.w += ga_scale * g4v.w * acc[q4 * 4 + 3];
    xn[q4 * 4] = xo.x; xn[q4 * 4 + 1] = xo.y; xn[q4 * 4 + 2] = xo.z; xn[q4 * 4 + 3] = xo.w;
    ss += xo.x * xo.x + xo.y * xo.y + xo.z * xo.z + xo.w * xo.w;
  }
#if PROBE_ANY || REP_MASK
#pragma unroll
  for (int q4 = 0; q4 < 4; ++q4)
    *(float4*)(xr + q4 * 4) = float4{xn[q4 * 4], xn[q4 * 4 + 1], xn[q4 * 4 + 2], xn[q4 * 4 + 3]};
  return;
#endif
  ss = wave_sum(ss);
  const float rn = 1.0f / sqrtf(ss * (1.0f / 1024.f) + 1e-6f);
  if (layer == 0) {
    const float* gn = p.g_attn + 1024 + lane * 16;
    const float* md = (const float*)(p.ws + OFF_MOD) + (2 + b) * 6144 + lane * 16;
    unsigned char* hq = (unsigned char*)(p.ws + OFF_H8) + tok * 1024 + lane * 16;
    float o[16];
    float mx = 0.f;
#pragma unroll
    for (int q4 = 0; q4 < 4; ++q4) {
      *(float4*)(xr + q4 * 4) = float4{xn[q4 * 4], xn[q4 * 4 + 1], xn[q4 * 4 + 2], xn[q4 * 4 + 3]};
      const float4 g4v = *(const float4*)(gn + q4 * 4);
      const float4 s4 = *(const float4*)(md + 1024 + q4 * 4);
      const float4 h4 = *(const float4*)(md + q4 * 4);
      o[q4 * 4] = xn[q4 * 4] * rn * g4v.x * (1.f + s4.x) + h4.x;
      o[q4 * 4 + 1] = xn[q4 * 4 + 1] * rn * g4v.y * (1.f + s4.y) + h4.y;
      o[q4 * 4 + 2] = xn[q4 * 4 + 2] * rn * g4v.z * (1.f + s4.z) + h4.z;
      o[q4 * 4 + 3] = xn[q4 * 4 + 3] * rn * g4v.w * (1.f + s4.w) + h4.w;
      mx = fmaxf(mx, fmaxf(fmaxf(fabsf(o[q4 * 4]), fabsf(o[q4 * 4 + 1])), fmaxf(fabsf(o[q4 * 4 + 2]), fabsf(o[q4 * 4 + 3]))));
    }
#pragma unroll
    for (int of = 32; of >= 1; of >>= 1) mx = fmaxf(mx, shx(mx, of));
    const unsigned qe = e8m0_of(mx);
    const float qs = e8m0_inv(qe);
    uint4 pk;
    pk.x = pack4_fp8(o[0] * qs, o[1] * qs, o[2] * qs, o[3] * qs);
    pk.y = pack4_fp8(o[4] * qs, o[5] * qs, o[6] * qs, o[7] * qs);
    pk.z = pack4_fp8(o[8] * qs, o[9] * qs, o[10] * qs, o[11] * qs);
    pk.w = pack4_fp8(o[12] * qs, o[13] * qs, o[14] * qs, o[15] * qs);
    *(uint4*)hq = pk;
    if (lane == 0) ((unsigned char*)(p.ws + OFF_H8S))[tok] = (unsigned char)qe;
  } else {
    const float* gf = p.g_final + lane * 16;
#pragma unroll
    for (int q4 = 0; q4 < 4; ++q4) {
      const float4 g4v = *(const float4*)(gf + q4 * 4);
      *(float4*)(xr + q4 * 4) = float4{xn[q4 * 4] * rn * g4v.x, xn[q4 * 4 + 1] * rn * g4v.y, xn[q4 * 4 + 2] * rn * g4v.z,
                                       xn[q4 * 4 + 3] * rn * g4v.w};
    }
  }
}

DEV void peer_expert_item2(const Params& p, int layer, int item, float ga_scale = 1.f) {
  const size_t tok = (size_t)item * 4 + (tidx() >> 6);
  peer_expert_tok(p, layer, tok, ga_scale, (const int*)(p.ws + OFF_PEIDX) + tok * 128, (const float*)(p.ws + OFF_PEG) + tok * 128);
}
DEV void peer_fused_item(const Params& p, int layer, int item, char* smem) {
  const int wave = tidx() >> 6;
  int* li = (int*)(smem + wave * 2048);
  float* lg = (float*)(smem + wave * 2048 + 1024);
  peer_topk_item3(p, layer, item, li, lg);
  asm volatile("s_waitcnt lgkmcnt(0)" ::: "memory");
  __builtin_amdgcn_wave_barrier();
  const size_t tok0 = (size_t)item * 8 + wave * 2;
  peer_expert_tok(p, layer, tok0, 1.f, li, lg);
  peer_expert_tok(p, layer, tok0 + 1, 1.f, li + 128, lg + 128);
  asm volatile("s_waitcnt lgkmcnt(0)" ::: "memory");
  __builtin_amdgcn_wave_barrier();
}
namespace g8 {
constexpr int BM = 256, BK = 64, HALF = 128, HTB = HALF * BK * 2, STAGE_BYTES = 8 * HTB, NXCD = 8;
DEV int lds_byte(int r, int c) { const int st = (r >> 4) * 2 + (c >> 5), rr = r & 15, cc = c & 31, ob = rr * 64 + cc * 2; return st * 1024 + (ob ^ (((ob >> 9) & 1) << 5)); }
DEV void stage_rc(int b, int& R, int& C) { const int st = b / 1024, sb = b % 1024, swz = sb ^ (((sb >> 9) & 1) << 5); R = (st >> 1) * 16 + swz / 64; C = (st & 1) * 32 + (swz % 64) / 2; }
DEV int perm32(int rho) { const int n = rho >> 4, i = rho & 15; return 8 * (i >> 2) + 4 * n + (i & 3); }
struct Unit { int pm, pn; };
struct Gemm { const bf16* A; const bf16* Bt; int M, N, K; const unsigned char* sa = nullptr; const unsigned char* sb = nullptr; };
struct StaticOrder {
  int nM, nN, nwg, G, c, WGM;
  DEV void init(int M, int N, int G_, int c_, int wgm = 4) { nM = M / BM; nN = N / BM; nwg = nM * nN; G = G_; c = c_; WGM = wgm; }
  DEV bool next(int i, Unit& u) const {
    const long L = (long)i * G + c;
    if (L >= nwg) return false;
    int wgid = (int)L;
    { const int q = nwg / NXCD, r = nwg % NXCD, xcd = wgid % NXCD, off = wgid / NXCD; wgid = (xcd < r ? xcd * (q + 1) : r * (q + 1) + (xcd - r) * q) + off; }
    const int nig = WGM * nN, gid = wgid / nig, fm = gid * WGM, gsz = (nM - fm) < WGM ? (nM - fm) : WGM;
    u.pm = fm + ((wgid % nig) % gsz);
    u.pn = (wgid % nig) / gsz;
    return true;
  }
};
typedef int v4i32_t __attribute__((ext_vector_type(4)));
typedef int v8i32_t __attribute__((ext_vector_type(8)));
template <class Epi, bool F8 = false>
DEV void gemm_phase(LAS unsigned char* lds, const Gemm g, const StaticOrder& S, const Epi& E) {
  int tid = threadIdx.x;
  asm volatile("" : "+v"(tid));
  const int wid = __builtin_amdgcn_readfirstlane(tid >> 6), lane = tid & 63, wr = wid >> 2, wc = wid & 3, fr = lane & 15, fq = lane >> 4;
  const int K = g.K, nt = K / BK;
  unsigned voffA[2], voffB[2];
#pragma unroll
  for (int i = 0; i < 2; ++i) {
    int R, C;
    stage_rc(tid * 16 + i * 8192, R, C);
    const int Rb = Epi::PERM ? ((R & ~31) + perm32(R & 31)) : R;
    voffA[i] = (unsigned)(R * K + C) * 2u;
    voffB[i] = (unsigned)(Rb * K + C) * 2u;
  }
  const size_t kstep = (size_t)(BK * 2);
  const size_t hstep = (size_t)HALF * K * 2;
  const size_t tstep = 2 * hstep;
  const unsigned ldsw = (unsigned)wid * 1024u;
  const int aoff = lds_byte(wr * 64 + fr, fq * 8), boff = lds_byte(wc * 32 + fr, fq * 8);
#define PG8_SA(b, h) (((b) * 2 + (h)) * HTB)
#define PG8_SB(b, h) ((4 + (b) * 2 + (h)) * HTB)
#define PG8_STAGE(bufoff, gbase, voff) do { _Pragma("unroll") for (int _i = 0; _i < 2; ++_i) \
    __builtin_amdgcn_global_load_lds((const unsigned*)((const char*)(gbase) + (voff)[_i]), (LAS unsigned*)(lds + (bufoff) + ldsw + _i * 8192), 16, 0, 0); } while (0)
#define PG8_LD8(dst_, addr_) do { const v4i32_t lo_ = *(const LAS v4i32_t*)(addr_), hi_ = *(const LAS v4i32_t*)((addr_) + 1024); \
    dst_ = __builtin_shufflevector(lo_, hi_, 0, 1, 2, 3, 4, 5, 6, 7); } while (0)
#define PG8_LDA(dst, b, h) do { _Pragma("unroll") for (int m = 0; m < 4; ++m) PG8_LD8(dst[m], lds + PG8_SA(b, h) + aoff + m * 2048); } while (0)
#define PG8_LDB(dst, b, h) do { _Pragma("unroll") for (int n = 0; n < 2; ++n) PG8_LD8(dst[n], lds + PG8_SB(b, h) + boff + n * 2048); } while (0)
#define PG8_LO(x) __builtin_bit_cast(bf16x8, __builtin_shufflevector((x), (x), 0, 1, 2, 3))
#define PG8_HI(x) __builtin_bit_cast(bf16x8, __builtin_shufflevector((x), (x), 4, 5, 6, 7))
#define PG8_STR_(x) #x
#define PG8_STR(x) PG8_STR_(x)
#define PG8_MLO_0 0
#define PG8_MLO_1 1
#define PG8_MLO_2 0
#define PG8_MLO_3 1
#define PG8_MHI_0 0
#define PG8_MHI_1 0
#define PG8_MHI_2 1
#define PG8_MHI_3 1
#define PG8_M1(ai, bj, m, n, At, Bt) do { \
    if constexpr (F8) asm volatile("v_mfma_scale_f32_16x16x128_f8f6f4 %0, %1, %2, %0, %3, %4 op_sel:[" PG8_STR(n) "," PG8_STR(PG8_MLO_##m) ",0] op_sel_hi:[" PG8_STR(bj) "," PG8_STR(PG8_MHI_##m) ",0]" \
                                   : "+v"(acc[ai][bj][m][n]) : "v"(Bt[n]), "v"(At[m]), "v"(scB), "v"(scA[ai])); \
    else { acc[ai][bj][m][n] = __builtin_amdgcn_mfma_f32_16x16x32_bf16(PG8_LO(Bt[n]), PG8_LO(At[m]), acc[ai][bj][m][n], 0, 0, 0); \
           acc[ai][bj][m][n] = __builtin_amdgcn_mfma_f32_16x16x32_bf16(PG8_HI(Bt[n]), PG8_HI(At[m]), acc[ai][bj][m][n], 0, 0, 0); } } while (0)
#define PG8_MMA(ai, bj, At, Bt) do { __builtin_amdgcn_s_setprio(1); \
    PG8_M1(ai, bj, 0, 0, At, Bt); PG8_M1(ai, bj, 0, 1, At, Bt); PG8_M1(ai, bj, 1, 0, At, Bt); PG8_M1(ai, bj, 1, 1, At, Bt); \
    PG8_M1(ai, bj, 2, 0, At, Bt); PG8_M1(ai, bj, 2, 1, At, Bt); PG8_M1(ai, bj, 3, 0, At, Bt); PG8_M1(ai, bj, 3, 1, At, Bt); \
    __builtin_amdgcn_s_setprio(0); } while (0)
#define PG8_WAIT_V(n) asm volatile("s_waitcnt vmcnt(" #n ")" ::: "memory")
#define PG8_WAIT_L(n) asm volatile("s_waitcnt lgkmcnt(" #n ")" ::: "memory")
#define PG8_BAR __builtin_amdgcn_s_barrier()
#define PG8_SCHED __builtin_amdgcn_sched_barrier(0)
  Unit cur, nxt;
  int ui = 0;
  if (!S.next(0, cur)) return;
  f32x4 acc[2][2][4][2];
#pragma unroll
  for (int a = 0; a < 2; ++a)
#pragma unroll
    for (int b = 0; b < 2; ++b)
#pragma unroll
      for (int m = 0; m < 4; ++m)
#pragma unroll
        for (int n = 0; n < 2; ++n) acc[a][b][m][n] = (f32x4){0.f, 0.f, 0.f, 0.f};
  v8i32_t At[4], B0[2], B1[2];
  const char* cA = (const char*)g.A + (size_t)cur.pm * tstep;
  const char* cB = (const char*)g.Bt + (size_t)cur.pn * tstep;
  PG8_STAGE(PG8_SB(0, 0), cB, voffB); PG8_STAGE(PG8_SA(0, 0), cA, voffA); PG8_STAGE(PG8_SB(0, 1), cB + hstep, voffB); PG8_STAGE(PG8_SA(0, 1), cA + hstep, voffA);
  if (wr == 1) PG8_BAR;
  PG8_WAIT_V(4); PG8_BAR;
  PG8_STAGE(PG8_SB(1, 0), cB + kstep, voffB); PG8_STAGE(PG8_SA(1, 0), cA + kstep, voffA); PG8_STAGE(PG8_SB(1, 1), cB + hstep + kstep, voffB);
  PG8_WAIT_V(6); PG8_BAR;
  unsigned scA[2] = {0x7f7f7f7fu, 0x7f7f7f7fu}, scB = 0x7f7f7f7fu;
  for (;;) {
    if constexpr (F8) {
      const unsigned char* ta = g.sa + (size_t)cur.pm * BM + wr * 64 + fr;
      const unsigned char* tb = g.sb + (size_t)cur.pn * BM + wc * 32 + 8 * (fr >> 2) + (fr & 3);
      scA[0] = (unsigned)ta[0] | ((unsigned)ta[16] << 8) | ((unsigned)ta[32] << 16) | ((unsigned)ta[48] << 24);
      scA[1] = (unsigned)ta[HALF] | ((unsigned)ta[HALF + 16] << 8) | ((unsigned)ta[HALF + 32] << 16) | ((unsigned)ta[HALF + 48] << 24);
      scB = (unsigned)tb[0] | ((unsigned)tb[4] << 8) | ((unsigned)tb[HALF] << 16) | ((unsigned)tb[HALF + 4] << 24);
    }
    const bool has_next = S.next(ui + 1, nxt);
    const char* nA = has_next ? (const char*)g.A + (size_t)nxt.pm * tstep : cA;
    const char* nB = has_next ? (const char*)g.Bt + (size_t)nxt.pn * tstep : cB;
#define PG8_KLOOP(T0_, T1_) _Pragma("unroll 1") for (int t = (T0_); t < (T1_); t += 2) { \
      if constexpr (Epi::HAS_MID) { if (t == Epi::MID_T) { PG8_SCHED; E.mid(acc, cur, wr, wc, fr, fq); PG8_SCHED; } } \
      const bool last = (t == nt - 2); \
      const char* a1 = cA + (size_t)(t + 1) * kstep; \
      const char* a2 = last ? nA : cA + (size_t)(t + 2) * kstep; \
      const char* b2 = last ? nB : cB + (size_t)(t + 2) * kstep; \
      const char* a3 = a2 + kstep; \
      const char* b3 = b2 + kstep; \
      PG8_LDB(B0, 0, 0); PG8_SCHED; PG8_LDA(At, 0, 0); PG8_STAGE(PG8_SA(1, 1), a1 + hstep, voffA); \
      PG8_WAIT_L(8); PG8_BAR; PG8_WAIT_L(0); PG8_MMA(0, 0, At, B0); PG8_BAR; PG8_SCHED; \
      PG8_LDB(B1, 0, 1); PG8_STAGE(PG8_SB(0, 0), b2, voffB); \
      PG8_BAR; PG8_WAIT_L(0); PG8_MMA(0, 1, At, B1); PG8_BAR; \
      PG8_LDA(At, 0, 1); PG8_STAGE(PG8_SA(0, 0), a2, voffA); \
      PG8_BAR; PG8_WAIT_L(0); PG8_MMA(1, 0, At, B0); PG8_BAR; PG8_SCHED; \
      PG8_STAGE(PG8_SB(0, 1), b2 + hstep, voffB); \
      PG8_WAIT_V(6); PG8_BAR; PG8_MMA(1, 1, At, B1); PG8_BAR; \
      PG8_LDB(B0, 1, 0); PG8_SCHED; PG8_LDA(At, 1, 0); PG8_STAGE(PG8_SA(0, 1), a2 + hstep, voffA); \
      PG8_WAIT_L(8); PG8_BAR; PG8_WAIT_L(0); PG8_MMA(0, 0, At, B0); PG8_BAR; PG8_SCHED; \
      PG8_LDB(B1, 1, 1); PG8_STAGE(PG8_SB(1, 0), b3, voffB); \
      PG8_BAR; PG8_WAIT_L(0); PG8_MMA(0, 1, At, B1); PG8_BAR; \
      PG8_LDA(At, 1, 1); PG8_STAGE(PG8_SA(1, 0), a3, voffA); \
      PG8_BAR; PG8_WAIT_L(0); PG8_MMA(1, 0, At, B0); PG8_BAR; PG8_SCHED; \
      PG8_STAGE(PG8_SB(1, 1), b3 + hstep, voffB); \
      PG8_WAIT_V(6); PG8_BAR; PG8_MMA(1, 1, At, B1); PG8_BAR; \
    }
    PG8_KLOOP(0, nt)
#undef PG8_KLOOP
    if constexpr (F8) asm volatile("s_nop 15\n\ts_nop 15" ::: "memory");
    E(acc, cur, wr, wc, fr, fq);
    if (!has_next) break;
#pragma unroll
    for (int a = 0; a < 2; ++a)
#pragma unroll
      for (int b = 0; b < 2; ++b)
#pragma unroll
        for (int m = 0; m < 4; ++m)
#pragma unroll
          for (int n = 0; n < 2; ++n) acc[a][b][m][n] = (f32x4){0.f, 0.f, 0.f, 0.f};
    cur = nxt; cA = nA; cB = nB; ++ui;
  }
  PG8_WAIT_V(0);
  if (wr == 0) PG8_BAR;
  PG8_BAR;
#undef PG8_SA
#undef PG8_SB
#undef PG8_STAGE
#undef PG8_LDA
#undef PG8_LDB
#undef PG8_MMA
#undef PG8_M1
#undef PG8_LD8
#undef PG8_LO
#undef PG8_HI
#undef PG8_WAIT_V
#undef PG8_WAIT_L
#undef PG8_BAR
#undef PG8_SCHED
}
DEV unsigned cvt2(float lo, float hi) { return cvtpk_(lo, hi); }

struct EpiBf16 {
  static constexpr bool PERM = true;
  static constexpr bool HAS_MID = false;
  bf16* O; int ldc;
  DEV void operator()(const f32x4 (&acc)[2][2][4][2], const Unit& u, int wr, int wc, int fr, int fq) const {
    const int row0 = u.pm * BM + wr * 64 + fr, col0 = u.pn * BM + wc * 32 + 8 * fq;
#pragma unroll
    for (int ai = 0; ai < 2; ++ai)
#pragma unroll
      for (int m = 0; m < 4; ++m) {
        bf16* rowp = O + (size_t)(row0 + ai * HALF + m * 16) * ldc + col0;
#pragma unroll
        for (int bj = 0; bj < 2; ++bj) {
          const f32x4 v0 = acc[ai][bj][m][0], v1 = acc[ai][bj][m][1];
          u32x4_t w;
          w.x = cvt2(v0[0], v0[1]); w.y = cvt2(v0[2], v0[3]); w.z = cvt2(v1[0], v1[1]); w.w = cvt2(v1[2], v1[3]);
          *(u32x4_t*)(rowp + bj * HALF) = w;
        }
      }
  }
};
struct EpiResid {
  static constexpr bool PERM = false;
  static constexpr bool HAS_MID = false;
  const float* xin; float* out; const float* ga;
  DEV void operator()(const f32x4 (&acc)[2][2][4][2], const Unit& u, int wr, int wc, int fr, int fq) const {
    const int row0 = u.pm * BM + wr * 64 + fr, col0 = u.pn * BM + wc * 32 + 4 * fq;
    const int b = (u.pm * BM) / S;
    f32x4 gv[2][2];
#pragma unroll
    for (int bj = 0; bj < 2; ++bj)
#pragma unroll
      for (int n = 0; n < 2; ++n) gv[bj][n] = *(const f32x4*)(ga + b * 6144 + col0 + bj * HALF + n * 16);
#pragma unroll
    for (int ai = 0; ai < 2; ++ai)
#pragma unroll
      for (int m = 0; m < 4; ++m) {
        const size_t off = (size_t)(row0 + ai * HALF + m * 16) * 1024 + col0;
#pragma unroll
        for (int bj = 0; bj < 2; ++bj)
#pragma unroll
          for (int n = 0; n < 2; ++n) {
            const f32x4 xv = *(const f32x4*)(xin + off + bj * HALF + n * 16);
            *(f32x4*)(out + off + bj * HALF + n * 16) = xv + gv[bj][n] * acc[ai][bj][m][n];
          }
      }
  }
};
DEV float sig_(float x) { return __builtin_amdgcn_rcpf(1.f + __builtin_amdgcn_exp2f(-1.4426950408889634f * x)); }
template <bool SECOND>
struct EpiMerge {
  static constexpr bool PERM = true;
  static constexpr bool HAS_MID = false;
  bf16* Y; const bf16* proj; int gcol;
  DEV void operator()(const f32x4 (&acc)[2][2][4][2], const Unit& u, int wr, int wc, int fr, int fq) const {
    const int row0 = u.pm * BM + wr * 64 + fr, col0 = u.pn * BM + wc * 32 + 8 * fq;
#pragma unroll
    for (int ai = 0; ai < 2; ++ai)
#pragma unroll
      for (int m = 0; m < 4; ++m) {
        const size_t row = (size_t)(row0 + ai * HALF + m * 16);
#pragma unroll
        for (int bj = 0; bj < 2; ++bj) {
          const uint4 gq = *(const uint4*)(proj + row * PC + gcol + col0 + bj * HALF);
          float gf[8];
          unpack8(gq, gf);
          const f32x4 v0 = acc[ai][bj][m][0], v1 = acc[ai][bj][m][1];
          float o[8] = {sig_(gf[0]) * v0[0], sig_(gf[1]) * v0[1], sig_(gf[2]) * v0[2], sig_(gf[3]) * v0[3],
                        sig_(gf[4]) * v1[0], sig_(gf[5]) * v1[1], sig_(gf[6]) * v1[2], sig_(gf[7]) * v1[3]};
          bf16* yp = Y + row * 1024 + col0 + bj * HALF;
          if (SECOND) {
            float yf[8];
            unpack8(*(const uint4*)yp, yf);
#pragma unroll
            for (int j = 0; j < 8; ++j) o[j] += yf[j];
          }
          u32x4_t w;
          w.x = cvt2(o[0], o[1]); w.y = cvt2(o[2], o[3]); w.z = cvt2(o[4], o[5]); w.w = cvt2(o[6], o[7]);
          *(u32x4_t*)yp = w;
        }
      }
  }
};
DEV float gm_clamp(float x) { return fmaxf(x, -60.f); }
struct EpiMerge2 {
  static constexpr bool PERM = true;
  static constexpr bool HAS_MID = true;
  static constexpr int MID_T = 8;
  bf16* Y; const bf16* proj;
  static DEV float ratio_(float gn, float gm) {
    return (1.f + __builtin_amdgcn_exp2f(-1.4426950408889634f * gm_clamp(gm))) * __builtin_amdgcn_rcpf(1.f + __builtin_amdgcn_exp2f(-1.4426950408889634f * gn));
  }
  DEV void mid(f32x4 (&acc)[2][2][4][2], const Unit& u, int wr, int wc, int fr, int fq) const {
    asm volatile("" : "+v"(fr), "+v"(fq));
    const char* gbase = (const char*)(proj + (size_t)u.pm * BM * PC + u.pn * BM);
    const unsigned goff = (unsigned)(((wr * 64 + fr) * PC + wc * 32 + 8 * fq) * 2);
#pragma unroll
    for (int ai = 0; ai < 2; ++ai)
#pragma unroll
      for (int m = 0; m < 4; ++m)
#pragma unroll
        for (int bj = 0; bj < 2; ++bj)
#pragma unroll
          for (int n = 0; n < 2; ++n) {
            const unsigned go = goff + (unsigned)(((ai * HALF + m * 16) * PC + bj * HALF + n * 4) * 2);
            const uint2 a = *(const uint2*)(gbase + (go + C_GN * 2));
            const uint2 b = *(const uint2*)(gbase + (go + C_GM * 2));
            f32x4 r;
            r[0] = ratio_(__uint_as_float(a.x << 16), __uint_as_float(b.x << 16));
            r[1] = ratio_(__uint_as_float(a.x & 0xffff0000u), __uint_as_float(b.x & 0xffff0000u));
            r[2] = ratio_(__uint_as_float(a.y << 16), __uint_as_float(b.y << 16));
            r[3] = ratio_(__uint_as_float(a.y & 0xffff0000u), __uint_as_float(b.y & 0xffff0000u));
            acc[ai][bj][m][n] *= r;
          }
  }
  DEV void operator()(const f32x4 (&acc)[2][2][4][2], const Unit& u, int wr, int wc, int fr, int fq) const {
    asm volatile("" : "+v"(fr), "+v"(fq));
    const int row0 = u.pm * BM + wr * 64 + fr, col0 = u.pn * BM + wc * 32 + 8 * fq;
#pragma unroll
    for (int ai = 0; ai < 2; ++ai)
#pragma unroll
      for (int m = 0; m < 4; ++m) {
        const size_t row = (size_t)(row0 + ai * HALF + m * 16);
#pragma unroll
        for (int bj = 0; bj < 2; ++bj) {
          const uint4 gq = *(const uint4*)(proj + row * PC + C_GM + col0 + bj * HALF);
          float gf[8];
          unpack8(gq, gf);
          const f32x4 v0 = acc[ai][bj][m][0], v1 = acc[ai][bj][m][1];
          float o[8] = {sig_(gm_clamp(gf[0])) * v0[0], sig_(gm_clamp(gf[1])) * v0[1], sig_(gm_clamp(gf[2])) * v0[2], sig_(gm_clamp(gf[3])) * v0[3],
                        sig_(gm_clamp(gf[4])) * v1[0], sig_(gm_clamp(gf[5])) * v1[1], sig_(gm_clamp(gf[6])) * v1[2], sig_(gm_clamp(gf[7])) * v1[3]};
          u32x4_t w;
          w.x = cvt2(o[0], o[1]); w.y = cvt2(o[2], o[3]); w.z = cvt2(o[4], o[5]); w.w = cvt2(o[6], o[7]);
          *(u32x4_t*)(Y + row * 1024 + col0 + bj * HALF) = w;
        }
      }
  }
};
struct EpiInproj {
  static constexpr bool PERM = true;
  static constexpr bool HAS_MID = false;
  char* ws;
  DEV void operator()(const f32x4 (&acc)[2][2][4][2], const Unit& u, int wr, int wc, int fr, int fq) const {
    const int b = (u.pm * BM) / S;
    const float* rope = (const float*)(ws + OFF_ROPE);
#pragma unroll
    for (int bj = 0; bj < 2; ++bj) {
      const int vcb = u.pn * BM + bj * HALF + wc * 32;
      if (vcb >= 4992) continue;
      const int vc0 = vcb & ~63, inh = vcb & 63;
      bf16* dbase; size_t dstride; bool roped = false; bool headmajor = false; int hh = 0, nh = 1;
      if (vc0 < 768) { dbase = (bf16*)(ws + OFF_PROJ) + vc0; dstride = PC; }
      else if (vc0 < 1280) {
        const int seg = (vc0 - 768) >> 7;
        const size_t off = (seg == 0) ? OFF_KSB : (seg == 1) ? OFF_VSB : (seg == 2) ? OFF_KWB : OFF_VWB;
        dbase = (bf16*)(ws + off); dstride = 64; headmajor = true; hh = ((vc0 - 768) >> 6) & 1; nh = 2;
        roped = (seg == 0) || (seg == 2);
      } else if (vc0 < 1792) { dbase = (bf16*)(ws + OFF_PROJ) + C_MQ + (vc0 - 1280); dstride = PC; roped = true; }
      else if (vc0 < 2816) {
        const int seg = (vc0 - 1792) >> 9;
        dbase = (bf16*)(ws + (seg ? OFF_MVB : OFF_MKB)); dstride = 64; headmajor = true; hh = ((vc0 - 1792) >> 6) & 7; nh = 8;
        roped = (seg == 0);
      } else if (vc0 < 4864) { dbase = (bf16*)(ws + OFF_PROJ) + C_GN + (vc0 - 2816); dstride = PC; }
      else { dbase = (bf16*)(ws + OFF_PROJ) + C_NG + (vc0 - 4864); dstride = PC; }
      const bool do_rope = roped && inh == 0;
#pragma unroll
      for (int ai = 0; ai < 2; ++ai)
#pragma unroll
        for (int m = 0; m < 4; ++m) {
          const int row = u.pm * BM + ai * HALF + wr * 64 + m * 16 + fr;
          const int t = row - b * S;
          const f32x4 v0 = acc[ai][bj][m][0], v1 = acc[ai][bj][m][1];
          float o[8] = {v0[0], v0[1], v0[2], v0[3], v1[0], v1[1], v1[2], v1[3]};
          if (do_rope) {
            float pv[8];
#pragma unroll
            for (int j = 0; j < 8; ++j) pv[j] = shx(o[j], 16);
            const f32x4 c0 = *(const f32x4*)(rope + (size_t)t * 16), c1 = *(const f32x4*)(rope + (size_t)t * 16 + 4);
            const f32x4 s0 = *(const f32x4*)(rope + (size_t)t * 16 + 8), s1 = *(const f32x4*)(rope + (size_t)t * 16 + 12);
            const float cs[8] = {c0[0], c0[1], c0[2], c0[3], c1[0], c1[1], c1[2], c1[3]};
            const float sn[8] = {s0[0], s0[1], s0[2], s0[3], s1[0], s1[1], s1[2], s1[3]};
            const float sg = (fq == 0) ? -1.f : 1.f;
#pragma unroll
            for (int j = 0; j < 8; ++j) o[j] = (fq < 2) ? (o[j] * cs[j] + sg * pv[j] * sn[j]) : o[j];
          }
          bf16* dp = headmajor ? (dbase + ((size_t)(b * nh + hh) * S + t) * 64 + inh + 8 * fq)
                               : (dbase + (size_t)row * dstride + inh + 8 * fq);
          u32x4_t w;
          w.x = cvt2(o[0], o[1]); w.y = cvt2(o[2], o[3]); w.z = cvt2(o[4], o[5]); w.w = cvt2(o[6], o[7]);
          *(u32x4_t*)dp = w;
        }
    }
  }
};
}

template <class F>
DEV void for_tiles_xcd(int MT, int NT, F f) {
  const int nb = vnb(), bid = vbid();
  if ((nb & 15) != 0) {
    for (int it = bid; it < MT * NT; it += nb) f(it / NT, it % NT);
    return;
  }
  const int xcd = (bid >> 1) & 7, slot = ((bid >> 4) << 1) | (bid & 1), nslot = nb >> 3;
  const int nj = (NT - xcd + 7) >> 3;
  for (int q = slot; q < MT * nj; q += nslot) f(q / nj, xcd + 8 * (q % nj));
}
constexpr int PH_PER_LAYER = 15;
enum { SP_NORM1 = 0, SP_INPROJ = 1, SP_COMPRESS = 2, SP_KMEAN = 3, SP_ATTN = 4, SP_MP0 = 5, SP_MM0 = 6, SP_MP1 = 7, SP_MM1 = 8,
       SP_MERGE = 9, SP_OUTPROJ = 10, SP_NORM2 = 11, SP_PEERQ = 12, SP_TOPK = 13, SP_EXPERT = 14 };
constexpr int N_REAL_PHASES = 1 + 2 * PH_PER_LAYER + 1;
constexpr int N_PHASES = N_REAL_PHASES + (PROBE_ANY ? 2 : 0);

DEV void run_phase(const Params& p, int ph, char* smem_raw, bool second_pass = false) {
#define SKIP_MOBA_SECOND (REP_NSA_ONLY && second_pass)
  LAS unsigned char* lds_all = (LAS unsigned char*)smem_raw;
  smem_raw += hidx() * SMEM_BYTES;
  float* smf = (float*)smem_raw;
  bf16* smh = (bf16*)smem_raw;
  const int nb = vnb(), bid = vbid();
  if (ph == 0) {
    for (int it = bid; it < PREP_ITEMS; it += nb) prep_item(p, it, smf);
    return;
  }
  if (ph == N_REAL_PHASES - 1) {
    for (int it = bid; it < T / 4; it += nb) final_norm_item(p.out, p.g_final, it);
    return;
  }
#if PROBE_ANY
  if (ph == N_REAL_PHASES) {
#if PROBE_PROJ
    {
      const unsigned char* Hh = (const unsigned char*)(p.ws + OFF_H8);
      const unsigned char* Wt = (const unsigned char*)(p.ws + OFF_WINT) + (size_t)1 * WN * 1024;
      const unsigned char* hsc = (const unsigned char*)(p.ws + OFF_H8S);
      const unsigned char* wsc = (const unsigned char*)(p.ws + OFF_WCS) + WN;
      const float* rope = (const float*)(p.ws + OFF_ROPE);
      float sd = 0.f, sr = 0.f;
      for (size_t i = (size_t)bid * 256 + tidx(); i < (size_t)(T / 64) * 4888; i += (size_t)nb * 256) {
        const int ts = (int)(i / 4888), vc = (int)(i % 4888);
        const int tok = ts * 64 + (ts % 61);
        const int b = tok / S, t = tok % S;
        auto rawdot = [&](int col) {
          float a = 0.f;
          for (int k = 0; k < 1024; ++k) {
            const f32x2_t hv = __builtin_amdgcn_cvt_pk_f32_fp8((int)Hh[(size_t)tok * 1024 + k], false);
            const f32x2_t wv = __builtin_amdgcn_cvt_pk_f32_fp8((int)Wt[(size_t)col * 1024 + k], false);
            a += hv.x * wv.x;
          }
          return a * __int_as_float((int)hsc[tok] << 23) * __int_as_float((int)wsc[col] << 23);
        };
        float v = rawdot(vc);
        bool roped = false;
        const bf16* dst;
        if (vc < 768) dst = (const bf16*)(p.ws + OFF_PROJ) + (size_t)tok * PC + vc;
        else if (vc < 1280) {
          const int seg = (vc - 768) >> 7, head = ((vc - 768) >> 6) & 1, d = vc & 63;
          const size_t off = (seg == 0) ? OFF_KSB : (seg == 1) ? OFF_VSB : (seg == 2) ? OFF_KWB : OFF_VWB;
          dst = (const bf16*)(p.ws + off) + ((size_t)(b * 2 + head) * S + t) * 64 + d;
          roped = (seg == 0 || seg == 2);
        } else if (vc < 1792) { dst = (const bf16*)(p.ws + OFF_PROJ) + (size_t)tok * PC + C_MQ + (vc - 1280); roped = true; }
        else if (vc < 2816) {
          const int seg = (vc - 1792) >> 9, head = ((vc - 1792) >> 6) & 7, d = vc & 63;
          dst = (const bf16*)(p.ws + (seg ? OFF_MVB : OFF_MKB)) + ((size_t)(b * 8 + head) * S + t) * 64 + d;
          roped = (seg == 0);
        } else if (vc < 4864) dst = (const bf16*)(p.ws + OFF_PROJ) + (size_t)tok * PC + C_GN + (vc - 2816);
        else dst = (const bf16*)(p.ws + OFF_PROJ) + (size_t)tok * PC + C_NG + (vc - 4864);
        const int d = vc & 63;
        if (roped && d < 16) {
          const float cs = rope[(size_t)t * 16 + (d & 7)], sn = rope[(size_t)t * 16 + 8 + (d & 7)];
          if (d < 8) { const float x2 = rawdot(vc + 8); v = v * cs - x2 * sn; }
          else { const float x1 = rawdot(vc - 8); v = v * cs + x1 * sn; }
        }
        const float got = bf2f(*dst);
        const bool is_r = roped && d < 16;
        if (PROBE_PROJ == 1 || (PROBE_PROJ == 2 && is_r) || (PROBE_PROJ == 3 && !is_r)) {
          sd += (got - v) * (got - v);
          sr += v * v;
        }
      }
      sd = wave_sum(sd); sr = wave_sum(sr);
      if ((tidx() & 63) == 0) {
        atomicAdd((float*)(p.ws + OFF_PROBE), sd);
        atomicAdd((float*)(p.ws + OFF_PROBE) + 1, sr);
      }
    }
#endif
#if PROBE_CMPR
    {
      float sd = 0.f, sr = 0.f;
      for (size_t i = (size_t)bid * 256 + tidx(); i < (size_t)2 * Bn * 1024 * 128; i += (size_t)nb * 256) {
        const size_t wh = i / ((size_t)Bn * 1024 * 128), r = i % ((size_t)Bn * 1024 * 128);
        const int c = (int)((r / 128) % 1024);
        if (c < 1023) {
          const float a = ((const float*)(p.ws + (wh ? OFF_VCC : OFF_KCC)))[r];
          const float y = ((const float*)(p.ws + OFF_CMP))[i];
          sd += (a - y) * (a - y);
          sr += y * y;
        }
      }
      sd = wave_sum(sd); sr = wave_sum(sr);
      if ((tidx() & 63) == 0) {
        atomicAdd((float*)(p.ws + OFF_PROBE), sd);
        atomicAdd((float*)(p.ws + OFF_PROBE) + 1, sr);
      }
    }
#endif
#if PROBE_MOBA
    probe_accum_bf16(p, (const bf16*)(p.ws + OFF_OMOBA), (const bf16*)(p.ws + OFF_CMP), (size_t)S * 512, smf);
#endif
#if PROBE_NSA == 8
    {
      const float* impn = (const float*)(p.ws + OFF_OMOBA);
      const float* impm = impn + (size_t)S * 256;
      const int* seld = (const int*)(p.ws + OFF_CMP);
      float sd = 0.f, sr = 0.f, bad = 0.f;
      for (int t = bid * 256 + tidx(); t < S; t += nb * 256) {
        const int cur = t >> 6;
        for (int n = 0; n < 256; ++n) {
          float a = impm[(size_t)t * 256 + n], r = impn[(size_t)t * 256 + n];
          sd += (a - r) * (a - r);
          sr += r * r;
        }
        unsigned want[8] = {0, 0, 0, 0, 0, 0, 0, 0}, got[8] = {0, 0, 0, 0, 0, 0, 0, 0};
        for (int j = 0; j < 16; ++j) {
          int v = seld[(size_t)t * 16 + j];
          if (v >= 0 && v < 256) {
            for (int w = 0; w < 8; ++w) if ((v >> 5) == w) got[w] |= 1u << (v & 31);
          }
        }
        if (cur < 16) {
          for (int n = 0; n <= cur; ++n) want[0] |= 1u << n;
        } else {
          want[0] |= 1u;
          for (int w = 0; w < 8; ++w) {
            if (((cur - 1) >> 5) == w) want[w] |= 1u << ((cur - 1) & 31);
            if ((cur >> 5) == w) want[w] |= 1u << (cur & 31);
          }
          for (int j = 0; j < 13; ++j) {
            float best = -1.f;
            int bi = 1;
            for (int n = 1; n <= cur - 2; ++n) {
              bool taken = false;
              for (int w = 0; w < 8; ++w) if ((n >> 5) == w) taken = (want[w] >> (n & 31)) & 1u;
              float v = impm[(size_t)t * 256 + n];
              if (!taken && v > best) { best = v; bi = n; }
            }
            for (int w = 0; w < 8; ++w) if ((bi >> 5) == w) want[w] |= 1u << (bi & 31);
          }
        }
        bool same = true;
        for (int w = 0; w < 8; ++w) same = same && (want[w] == got[w]);
        if (!same) bad += 1.f;
      }
      sd = wave_sum(sd); sr = wave_sum(sr); bad = wave_sum(bad);
      if ((tidx() & 63) == 0) {
        atomicAdd((float*)(p.ws + OFF_PROBE), sd);
        atomicAdd((float*)(p.ws + OFF_PROBE) + 1, sr);
        atomicAdd((float*)(p.ws + OFF_PROBE) + 2, bad);
      }
    }
#elif PROBE_NSA
    probe_accum_bf16(p, (const bf16*)(p.ws + OFF_ONSA), (const bf16*)(p.ws + OFF_CMP), (size_t)S * 512, smf);
#endif
    return;
  }
  if (ph == N_REAL_PHASES + 1) {
    probe_apply(p);
    return;
  }
#endif
  const int layer = (ph - 1) / PH_PER_LAYER, sub = (ph - 1) % PH_PER_LAYER;
  const float* mod = (const float*)(p.ws + OFF_MOD) + (size_t)layer * 2 * 6144;
  const float* xin = (layer == 0) ? p.x : p.out;
  bf16* H = (bf16*)(p.ws + OFF_H);
  bf16* PROJ = (bf16*)(p.ws + OFF_PROJ);
#if PROBE_ANY
  if (sub >= SP_MERGE) {
    if (sub == SP_OUTPROJ && layer == 0)
      for (size_t i = (size_t)bid * 256 + tidx(); i < (size_t)T * 1024; i += (size_t)nb * 256) p.out[i] = p.x[i];
    return;
  }
#endif
  switch (sub) {
    case SP_NORM1:
      for (int it = bid; it < T / 4; it += nb)
        norm8_item(xin, p.g_attn + layer * 1024, mod + 1024, mod + 0, (unsigned char*)(p.ws + OFF_H8), (unsigned char*)(p.ws + OFF_H8S), it);
      if (layer == 0)
        for (int it = bid; it < WQ8_ITEMS; it += nb) wq8_item(p, it, smf);
      break;
    case SP_INPROJ: {
      g8::StaticOrder so;
      so.init(T, WN, (int)gridDim.x, (int)blockIdx.x, WGM_INPROJ);
      g8::gemm_phase<g8::EpiInproj, true>(lds_all, g8::Gemm{(const bf16*)(p.ws + OFF_H8), (const bf16*)(p.ws + OFF_WINT + (size_t)layer * WN * 1024), T, WN, 512,
                                                             (const unsigned char*)(p.ws + OFF_H8S), (const unsigned char*)(p.ws + OFF_WCS) + (size_t)layer * WN},
                                          so, g8::EpiInproj{p.ws});
    } break;
    case SP_COMPRESS:
      for (int it = bid; it < 512 + 1024 + 256; it += nb) {
        if (it < 512) compress_mfma_item(p, layer, it, smem_raw);
        else if (it < 1536) kmean_item(p, it - 512, smf);
        else kvamax_item(p, layer, it - 1536);
      }
#if PROBE_CMPR
      if (layer == 1)
        for (int it = bid; it < 1024; it += nb) compress_item(p, layer, it, smf);
#endif
      break;
    case SP_KMEAN:
      for (int it = bid; it < 1024; it += nb) kvq_item(p, layer, it, smf);
#if PROBE_NSA
      if (layer == 1)
        for (int it = bid; it < 512; it += nb) n1_item(p, layer, it, smf);
#endif
      break;
    case SP_ATTN:
      {
        constexpr int MNI = 2;
        constexpr int NMOBA = 16 * (S / (64 * MNI));
        constexpr int NNI = 2;
        constexpr int NNSA = 4 * (S / (16 * NNI));
        const bool do_nsa = !PROBE_ANY || PROBE_NSA, do_moba = (!PROBE_ANY || PROBE_MOBA) && PROBE_NSA != 8;
        {
          constexpr int NCH = S / (16 * NNI);
          const bool affine = nb >= 8;
          const int grp = bid & 7, bk = grp & 3, sub = grp >> 2;
          const int i0 = affine ? (bid >> 3) : bid;
          const int istride = affine ? ((nb - grp + 7) >> 3) : nb;
          const int icount = affine ? (NCH / 2) : NNSA;
          if (do_nsa) {
            const bool snake = affine && (nb & 7) == 0 && (icount % (2 * istride)) == 0;
            int k = 0;
            for (int i = i0; i < icount; i += istride, ++k) {
              const int ii = snake ? ((k & 1) ? ((k + 1) * istride - 1 - i0) : (k * istride + i0)) : i;
              nsa_item<NNI>(p, layer, affine ? (((2 * ii + sub) << 2) | bk) : ii, smem_raw, (bf16*)(p.ws + OFF_ONSA));
            }
          }
          if (do_moba && !SKIP_MOBA_SECOND)
          {
            const int ngi = (NMOBA - (bid & ~1) + nb - 1) / nb;
            for (int j0 = 0; j0 < ngi; j0 += 4) {
              const int first = bid + j0 * nb;
              int nit = ngi - j0 < 4 ? ngi - j0 : 4;
              while (nit > 0 && first + (nit - 1) * nb >= NMOBA) --nit;
              moba_gate_batch<MNI>(p, first, nb, nit, (int*)smf);
            }
          }
        }
#if PROBE_NSA && PROBE_NSA != 8
        if (layer == 1)
          for (int it = bid; it < 512; it += nb) n23_item(p, layer, it);
#endif
#if PROBE_MOBA
        if (layer == 1) {
          for (int it = bid; it < 512; it += nb) moba_item(p, layer, it);
        }
#endif
      }
      break;
    case SP_MP0:
    case SP_MP1:
      if ((!PROBE_ANY || PROBE_MOBA) && PROBE_NSA != 8)
        {
          constexpr int NIT = 8 * 63 * MOBA_NPART;
          int k = 0;
          for (int it = bid; it < ((NIT + nb - 1) / nb) * nb; it += nb, ++k) {
            const int ii = (k & 1) ? ((k + 1) * nb - 1 - bid) : it;
            if (ii < NIT) moba_part_item2<2>(p, sub == SP_MP1 ? 1 : 0, ii, smem_raw);
          }
        }
      break;
    case SP_MM0:
    case SP_MM1:
      if ((!PROBE_ANY || PROBE_MOBA) && PROBE_NSA != 8)
        for (int it = bid; it < 8 * (S / 128); it += nb)
          moba_merge_item<2>(p, sub == SP_MM1 ? 1 : 0, it, smem_raw, (bf16*)(p.ws + OFF_OMOBA_OUT));
      break;
    case SP_MERGE:
      {
        g8::StaticOrder so;
        so.init(T, 1024, (int)gridDim.x, (int)blockIdx.x, WGM_N1024);
        g8::gemm_phase(lds_all, g8::Gemm{(const bf16*)(p.ws + OFF_ONSA), (const bf16*)(p.ws + OFF_WUPN) + (size_t)layer * 1024 * 1024, T, 1024, 1024}, so,
                       g8::EpiMerge2{H, PROJ});
      }
      break;
    case SP_OUTPROJ: {
      const bf16* W = (const bf16*)(p.ws + OFF_WOUT) + (size_t)layer * 1024 * 1024;
      const float* ga1 = mod + 2048;
      g8::StaticOrder so;
      so.init(T, 1024, (int)gridDim.x, (int)blockIdx.x, WGM_N1024);
      g8::gemm_phase(lds_all, g8::Gemm{H, W, T, 1024, 1024}, so, g8::EpiResid{xin, p.out, ga1});
    } break;
    case SP_NORM2:
      for (int it = bid; it < T / 4 + NEXP / 4; it += nb) {
        if (it < T / 4) norm_item(p.out, p.g_ffn + layer * 1024, mod + 4096, mod + 3072, H, it);
        else expert_cvt_item(p, layer, it - T / 4);
      }
      break;
    case SP_PEERQ: {
      const bf16* W = (const bf16*)(p.ws + OFF_WQ) + (size_t)layer * 2048 * 1024;
      bf16* QP = (bf16*)(p.ws + OFF_QP);
      g8::StaticOrder so;
      so.init(T, 2048, (int)gridDim.x, (int)blockIdx.x, WGM_N2048);
      g8::gemm_phase(lds_all, g8::Gemm{H, W, T, 2048, 1024}, so, g8::EpiBf16{QP, 2048});
    } break;
    case SP_TOPK:
#if REP_MASK
      for (int it = bid; it < T / 8; it += nb) peer_topk_item3(p, layer, it);
#endif
      break;
    case SP_EXPERT:
#if REP_MASK
      for (int it = bid; it < T / 4; it += nb) peer_expert_item2(p, layer, it, second_pass ? 0.f : 1.f);
#else
      for (int it = bid; it < T / 8; it += nb) peer_fused_item(p, layer, it, smem_raw);
#endif
      break;
  }
}

#define MEGA_LB __launch_bounds__(512, 2)
__global__ void MEGA_LB mega_kernel(Params p, int ph_lo, int ph_hi) {
  __shared__ __attribute__((aligned(16))) char smem_raw[2 * SMEM_BYTES + 16];
  volatile LAS unsigned* xbst = (volatile LAS unsigned*)(smem_raw + 2 * SMEM_BYTES);
  if (threadIdx.x == 0) { xbst[0] = 0u; xbst[1] = 0u; xbst[2] = 0u; xbst[3] = 0u; }
  __syncthreads();
  XcdBarrier xb = xcd_barrier_post((unsigned*)(p.ws + OFF_BAR), xbst);
  for (int ph = ph_lo; ph < ph_hi; ++ph) {
#if !PROBE_ANY && !REP_MASK
    if (ph == N_REAL_PHASES - 1 || ph == 1 + PH_PER_LAYER || (ph >= 1 && (ph - 1) % PH_PER_LAYER == SP_TOPK))
      continue;
#endif
#if REP_MASK
    const int nrep = (ph >= 1 && ph < N_REAL_PHASES - 1 && ((REP_MASK >> ((ph - 1) % PH_PER_LAYER)) & 1)) ? 2 : 1;
    for (int rep = 0; rep < nrep; ++rep) {
      if (rep) xcd_barrier(xb);
      run_phase(p, ph, smem_raw, rep != 0);
    }
#else
    run_phase(p, ph, smem_raw);
#endif
    if (ph + 1 < ph_hi) {
      if (ph == ph_lo) cg::this_grid().sync();
      else xcd_barrier(xb);
    }
  }
}

extern "C" void kernel_launch(void* const* d_in, const int* in_sizes, int n_in, void* d_out, int out_size, void* d_ws,
                              size_t ws_size, hipStream_t stream) {
  if (ws_size < WS_TOTAL) {
    fprintf(stderr, "workspace too small: %zu < %zu\n", ws_size, (size_t)WS_NEED);
    return;
  }
  Params p{};
  p.x = (const float*)d_in[0]; p.c = (const float*)d_in[1]; p.w_ada = (const float*)d_in[2];
  p.b_ada = (const float*)d_in[3]; p.g_attn = (const float*)d_in[4]; p.g_ffn = (const float*)d_in[5];
  p.w_in = (const float*)d_in[6]; p.cmp_pe = (const float*)d_in[7]; p.cmp_w1 = (const float*)d_in[8];
  p.cmp_w2 = (const float*)d_in[9]; p.w_up_nsa = (const float*)d_in[10]; p.w_up_moba = (const float*)d_in[11];
  p.w_out = (const float*)d_in[12]; p.peer_wq = (const float*)d_in[13]; p.peer_k1 = (const float*)d_in[14];
  p.peer_k2 = (const float*)d_in[15]; p.peer_u = (const float*)d_in[16]; p.peer_v = (const float*)d_in[17];
  p.g_final = (const float*)d_in[18];
  p.out = (float*)d_out;
  p.ws = (char*)d_ws;
  static int grid_blocks = 0;
  if (!grid_blocks) {
    int dev = 0, cus = 0, per_cu = 0;
    hipGetDevice(&dev);
    hipDeviceGetAttribute(&cus, hipDeviceAttributeMultiprocessorCount, dev);
    hipOccupancyMaxActiveBlocksPerMultiprocessor(&per_cu, mega_kernel, 512, 0);
    if (per_cu < 1) per_cu = 1;
    if (per_cu > 1) per_cu = 1;
    grid_blocks = cus * per_cu;
  }
  hipMemsetAsync((char*)d_ws + OFF_BAR, 0, BAR_BYTES, stream);
  int ph_lo = 0, ph_hi = N_PHASES;
  void* args[] = {(void*)&p, (void*)&ph_lo, (void*)&ph_hi};
  hipError_t e = hipLaunchCooperativeKernel((const void*)mega_kernel, dim3(grid_blocks), dim3(512), args, 0, stream);
  if (e != hipSuccess) fprintf(stderr, "cooperative launch failed: %s (grid %d)\n", hipGetErrorString(e), grid_blocks);
}
```
